# Optimizing an MI355X kernel written in HIP

```python
import math
import jax, jax.numpy as jnp
from jax import lax
import numpy as np

D_MODEL = 1024
BATCH = 4
SEQ = 4096
DEPTH = 2
DEC_BATCH = 32
DEC_SEQ = 4
PAST_LEN = 8192
PAGE_SIZE = 128

N_MIXERS = 2
N_HGRN = (DEPTH + 1) // 2
N_DSA = DEPTH // 2
MEM_WIDTH = D_MODEL // 4
TOK_WIDTH = D_MODEL - MEM_WIDTH
MEM_HEADS = 4
MEM_HD = MEM_WIDTH // MEM_HEADS
N_MEM = 256
HGRN_DK = 128
HGRN_HEADS = TOK_WIDTH // HGRN_DK
HGRN_CHUNK = 32
HEAD_DIM = 128
N_Q_HEADS = TOK_WIDTH // HEAD_DIM
N_KV_HEADS = 2
IDX_HEADS = 8
IDX_DIM = 64
TOPK_MAX = 256
Q_BLOCK = 128
ROPE_THETA = 10000.0
D_FF = 2816
CONV_W = 3
EPS = 1e-6
HGRN_COLS = 4 * TOK_WIDTH + MEM_WIDTH
DSA_SIZES = (N_Q_HEADS * HEAD_DIM, N_KV_HEADS * HEAD_DIM, N_KV_HEADS * HEAD_DIM,
             IDX_HEADS * IDX_DIM, IDX_DIM, IDX_HEADS)
DSA_COLS = sum(DSA_SIZES) + MEM_WIDTH

kernel_name = 'hgrn2_dsa_memory_hybrid_step'


def rms_norm(x, gain):
    xf = x.astype(jnp.float32)
    y = xf * lax.rsqrt(jnp.mean(xf * xf, axis=-1, keepdims=True) + EPS)
    return (y * gain.astype(jnp.float32)).astype(x.dtype)


def rope(x, pos):
    half = x.shape[-1] // 2
    inv_freq = ROPE_THETA ** (-jnp.arange(half, dtype=jnp.float32) / half)
    ang = pos.astype(jnp.float32)[:, None] * inv_freq[None, :]
    cos = jnp.cos(ang)[:, None, :]
    sin = jnp.sin(ang)[:, None, :]
    xf = x.astype(jnp.float32)
    x1, x2 = xf[..., :half], xf[..., half:]
    return jnp.concatenate([x1 * cos - x2 * sin, x2 * cos + x1 * sin], axis=-1).astype(x.dtype)


def hgrn2_recurrence(q, k, v, log_f, s0):
    B, T, H, DK = q.shape
    DV = v.shape[-1]
    c = math.gcd(T, HGRN_CHUNK)
    n = T // c

    def chunks(a):
        return a.astype(jnp.float32).reshape(B, n, c, H, a.shape[-1]).transpose(1, 0, 3, 2, 4)

    causal = jnp.tril(jnp.ones((c, c), dtype=bool))

    def step(S, inp):
        qc, kc, vc, gc = inp
        b = jnp.cumsum(gc, axis=2)
        b_last = b[:, :, -1:, :]
        q_dec = qc * jnp.exp(b)
        k_dec = kc * jnp.exp(-b)
        scores = jnp.where(causal, jnp.einsum('bhtk,bhsk->bhts', q_dec, k_dec), 0.0)
        o = jnp.einsum('bhtk,bhkv->bhtv', q_dec, S) + jnp.einsum('bhts,bhsv->bhtv', scores, vc)
        S_new = (jnp.exp(b_last[:, :, 0, :])[..., None] * S
                 + jnp.einsum('bhsk,bhsv->bhkv', kc * jnp.exp(b_last - b), vc))
        return S_new, o

    S, o = lax.scan(step, s0.astype(jnp.float32), tuple(chunks(a) for a in (q, k, v, log_f)))
    return o.transpose(1, 0, 3, 2, 4).reshape(B, T, H, DV), S


def hgrn2_mixer(z, s0, lower_bound, out_norm):
    B, T, _ = z.shape
    heads = lambda a: a.reshape(B, T, HGRN_HEADS, HGRN_DK)
    q, f_pre, i, g = jnp.split(z, 4, axis=-1)
    lb = lower_bound.reshape(HGRN_HEADS, HGRN_DK)
    f = lb + (1.0 - lb) * jax.nn.sigmoid(heads(f_pre).astype(jnp.float32))
    o, s = hgrn2_recurrence(heads(jax.nn.silu(q)), 1.0 - f, heads(i), jnp.log(f), s0)
    o = rms_norm(o, out_norm) * jax.nn.silu(heads(g).astype(jnp.float32))
    return o.reshape(B, T, TOK_WIDTH).astype(z.dtype), s


def dsa_project(z, pos, q_norm, k_norm, ik_norm):
    B, T, _ = z.shape
    q, k, v, iq, ik, iw = jnp.split(z, np.cumsum(DSA_SIZES)[:-1].tolist(), axis=-1)
    q = rope(rms_norm(q.reshape(B, T, N_Q_HEADS, HEAD_DIM), q_norm), pos)
    k = rope(rms_norm(k.reshape(B, T, N_KV_HEADS, HEAD_DIM), k_norm), pos)
    v = v.reshape(B, T, N_KV_HEADS, HEAD_DIM)
    iq = rope(iq.reshape(B, T, IDX_HEADS, IDX_DIM), pos)
    ik = rope(rms_norm(ik, ik_norm)[:, :, None, :], pos)[:, :, 0, :]
    return q, k, v, iq, ik, iw


def indexer_select(iq, iw, ik, q_pos, n_sel):
    dots = jnp.einsum('bthd,bsd->bths', iq.astype(jnp.float32), ik.astype(jnp.float32)) * (IDX_DIM ** -0.5)
    score = jnp.einsum('bth,bths->bts', iw.astype(jnp.float32) * (IDX_HEADS ** -0.5), jax.nn.relu(dots))
    allowed = jnp.arange(ik.shape[1])[None, :] <= q_pos[:, None]
    score = jnp.where(allowed[None], score, -jnp.inf)
    vals, idx = lax.top_k(score, n_sel)
    return idx, jnp.isfinite(vals)


def gathered_attention(q, kg, vg, valid):
    B, T, H, D = q.shape
    qg = q.reshape(B, T, N_KV_HEADS, H // N_KV_HEADS, D)
    s = jnp.einsum('btgrd,btkgd->btgrk', qg, kg).astype(jnp.float32) * (D ** -0.5)
    s = jnp.where(valid[:, :, None, None, :], s, -jnp.inf)
    p = jax.nn.softmax(s, axis=-1).astype(vg.dtype)
    return jnp.einsum('btgrk,btkgd->btgrd', p, vg).reshape(B, T, H, D)


def dsa_prompt(q, k, v, iq, ik, iw):
    B, T = q.shape[:2]
    n_sel = min(TOPK_MAX, T // 4)
    bidx = jnp.arange(B)[:, None, None]

    def block(start):
        qb = lax.dynamic_slice_in_dim(q, start, Q_BLOCK, axis=1)
        iqb = lax.dynamic_slice_in_dim(iq, start, Q_BLOCK, axis=1)
        iwb = lax.dynamic_slice_in_dim(iw, start, Q_BLOCK, axis=1)
        idx, valid = indexer_select(iqb, iwb, ik, start + jnp.arange(Q_BLOCK), n_sel)
        return gathered_attention(qb, k[bidx, idx], v[bidx, idx], valid)

    o = lax.map(block, jnp.arange(0, T, Q_BLOCK))
    return o.transpose(1, 0, 2, 3, 4).reshape(B, T, N_Q_HEADS * HEAD_DIM)


def dsa_sample(q, k_new, v_new, iq, ik_new, iw, pool_k, pool_v, pool_ik, page_table):
    B, T = q.shape[:2]
    n_sel = min(TOPK_MAX, (PAST_LEN + T) // 4)
    ik_past = pool_ik[page_table].reshape(B, PAST_LEN, IDX_DIM)
    ik_all = jnp.concatenate([ik_past, ik_new.astype(ik_past.dtype)], axis=1)
    idx, valid = indexer_select(iq, iw, ik_all, PAST_LEN + jnp.arange(T), n_sel)
    bidx = jnp.arange(B)[:, None, None]
    is_past = (idx < PAST_LEN)[..., None, None]
    pi = jnp.minimum(idx, PAST_LEN - 1)
    phys = page_table[bidx, pi // PAGE_SIZE]
    row = pi % PAGE_SIZE
    ni = jnp.clip(idx - PAST_LEN, 0, T - 1)
    kg = jnp.where(is_past, pool_k[phys, row], k_new[bidx, ni])
    vg = jnp.where(is_past, pool_v[phys, row], v_new[bidx, ni])
    return gathered_attention(q, kg, vg, valid).reshape(B, T, N_Q_HEADS * HEAD_DIM)


def memory_keys_values(mem, w_kv, k_norm):
    B, M, _ = mem.shape
    k, v = jnp.split(mem @ w_kv, 2, axis=-1)
    return (rms_norm(k.reshape(B, M, MEM_HEADS, MEM_HD), k_norm),
            v.reshape(B, M, MEM_HEADS, MEM_HD))


def memory_attention(zq, q_norm, mk, mv):
    B, T, _ = zq.shape
    q = rms_norm(zq.reshape(B, T, MEM_HEADS, MEM_HD), q_norm)
    s = jnp.einsum('bthd,bmhd->bhtm', q, mk).astype(jnp.float32) * (MEM_HD ** -0.5)
    p = jax.nn.softmax(s, axis=-1).astype(mv.dtype)
    return jnp.einsum('bhtm,bmhd->bthd', p, mv).reshape(B, T, MEM_WIDTH)


def conv_ffn(h, conv_state, w_gate, w_up, conv_w, conv_b, w_down):
    T = h.shape[1]
    u = h @ w_gate
    ext = jnp.concatenate([conv_state.astype(u.dtype), u], axis=1)
    c = conv_b + sum(ext[:, j:j + T] * conv_w[j] for j in range(CONV_W))
    y = (jax.nn.silu(c) * (h @ w_up)) @ w_down
    return y, ext[:, T:]


def setup_inputs(seed: int = 0) -> dict:
    key = jax.random.key(seed)
    ks = list(jax.random.split(key, 40))
    nrm = lambda shape, scale=1.0: jax.random.normal(ks.pop(), shape, jnp.float32) * scale
    gain = lambda shape: 1.0 + 0.1 * jax.random.normal(ks.pop(), shape, jnp.float32)
    n_pages = PAST_LEN // PAGE_SIZE
    n_used = DEC_BATCH * n_pages
    n_pool = n_used + max(1, n_used // 4)
    page_table = jax.random.permutation(ks.pop(), n_pool)[:n_used].reshape(DEC_BATCH, n_pages).astype(jnp.int32)
    d = {}
    d['x_prompt'] = nrm((BATCH, SEQ, D_MODEL))
    d['x_sample'] = nrm((DEC_BATCH, DEC_SEQ, D_MODEL))
    d['cache_k'] = nrm((N_DSA, n_pool, PAGE_SIZE, N_KV_HEADS, HEAD_DIM))
    d['cache_v'] = nrm((N_DSA, n_pool, PAGE_SIZE, N_KV_HEADS, HEAD_DIM))
    d['cache_idx_k'] = nrm((N_DSA, n_pool, PAGE_SIZE, IDX_DIM))
    d['cache_mem_k'] = nrm((DEPTH, DEC_BATCH, N_MEM, MEM_HEADS, MEM_HD))
    d['cache_mem_v'] = nrm((DEPTH, DEC_BATCH, N_MEM, MEM_HEADS, MEM_HD))
    d['state_hgrn'] = nrm((N_HGRN, DEC_BATCH, HGRN_HEADS, HGRN_DK, HGRN_DK), 0.5)
    d['state_ffn_conv'] = nrm((DEPTH, DEC_BATCH, CONV_W - 1, D_FF))
    d['page_table'] = page_table
    d['mem_prompt'] = nrm((BATCH, N_MEM, D_MODEL))
    d['norm_mix'] = gain((DEPTH, D_MODEL))
    d['norm_ffn'] = gain((DEPTH, D_MODEL))
    d['w_in_hgrn'] = nrm((N_HGRN, D_MODEL, HGRN_COLS), D_MODEL ** -0.5)
    d['hgrn_lb_logits'] = nrm((N_HGRN + 1, TOK_WIDTH), 0.5)
    d['hgrn_out_norm'] = gain((N_HGRN, HGRN_DK))
    d['w_in_dsa'] = nrm((N_DSA, D_MODEL, DSA_COLS), D_MODEL ** -0.5)
    d['dsa_q_norm'] = gain((N_DSA, HEAD_DIM))
    d['dsa_k_norm'] = gain((N_DSA, HEAD_DIM))
    d['idx_k_norm'] = gain((N_DSA, IDX_DIM))
    d['w_mem_kv'] = nrm((DEPTH, D_MODEL, 2 * MEM_WIDTH), D_MODEL ** -0.5)
    d['mem_q_norm'] = gain((DEPTH, MEM_HD))
    d['mem_k_norm'] = gain((DEPTH, MEM_HD))
    d['w_out'] = nrm((DEPTH, D_MODEL, D_MODEL), D_MODEL ** -0.5)
    d['w_ffn_gate'] = nrm((DEPTH, D_MODEL, D_FF), D_MODEL ** -0.5)
    d['w_ffn_up'] = nrm((DEPTH, D_MODEL, D_FF), D_MODEL ** -0.5)
    d['ffn_conv_w'] = nrm((DEPTH, CONV_W, D_FF), CONV_W ** -0.5)
    d['ffn_conv_b'] = nrm((DEPTH, D_FF), 0.02)
    d['w_ffn_down'] = nrm((DEPTH, D_FF, D_MODEL), D_FF ** -0.5)
    return d


def reference(x_prompt, x_sample, cache_k, cache_v, cache_idx_k, cache_mem_k, cache_mem_v,
              state_hgrn, state_ffn_conv, page_table, mem_prompt,
              norm_mix, norm_ffn, w_in_hgrn, hgrn_lb_logits, hgrn_out_norm,
              w_in_dsa, dsa_q_norm, dsa_k_norm, idx_k_norm,
              w_mem_kv, mem_q_norm, mem_k_norm, w_out,
              w_ffn_gate, w_ffn_up, ffn_conv_w, ffn_conv_b, w_ffn_down):
    pos_p = jnp.arange(SEQ)
    pos_s = PAST_LEN + jnp.arange(DEC_SEQ)
    lower_bounds = jnp.cumsum(jax.nn.softmax(hgrn_lb_logits.astype(jnp.float32), axis=0), axis=0)
    xp, xs = x_prompt, x_sample
    bp = xp.shape[0]
    hgrn_p, hgrn_s = [], []
    kp_l, vp_l, ikp_l, ks_l, vs_l, iks_l = [], [], [], [], [], []
    mk_l, mv_l, cvp_l, cvs_l = [], [], [], []
    for layer in range(DEPTH):
        j = layer // N_MIXERS
        hp = rms_norm(xp, norm_mix[layer])
        hs = rms_norm(xs, norm_mix[layer])
        if layer % N_MIXERS == 0:
            zp = hp @ w_in_hgrn[j]
            zs = hs @ w_in_hgrn[j]
            s0 = jnp.zeros((bp, HGRN_HEADS, HGRN_DK, HGRN_DK), jnp.float32)
            tp, sp = hgrn2_mixer(zp[..., :-MEM_WIDTH], s0, lower_bounds[j], hgrn_out_norm[j])
            ts, ss = hgrn2_mixer(zs[..., :-MEM_WIDTH], state_hgrn[j], lower_bounds[j], hgrn_out_norm[j])
            hgrn_p.append(sp.astype(state_hgrn.dtype))
            hgrn_s.append(ss.astype(state_hgrn.dtype))
        else:
            zp = hp @ w_in_dsa[j]
            zs = hs @ w_in_dsa[j]
            qp, kp, vp, iqp, ikp, iwp = dsa_project(zp[..., :-MEM_WIDTH], pos_p, dsa_q_norm[j], dsa_k_norm[j], idx_k_norm[j])
            tp = dsa_prompt(qp, kp, vp, iqp, ikp, iwp)
            qs, kn, vn, iqs, ikn, iws = dsa_project(zs[..., :-MEM_WIDTH], pos_s, dsa_q_norm[j], dsa_k_norm[j], idx_k_norm[j])
            ts = dsa_sample(qs, kn, vn, iqs, ikn, iws, cache_k[j], cache_v[j], cache_idx_k[j], page_table)
            kp_l.append(kp); vp_l.append(vp); ikp_l.append(ikp)
            ks_l.append(kn); vs_l.append(vn); iks_l.append(ikn)
        mkp, mvp = memory_keys_values(mem_prompt, w_mem_kv[layer], mem_k_norm[layer])
        mk_l.append(mkp); mv_l.append(mvp)
        cp = memory_attention(zp[..., -MEM_WIDTH:], mem_q_norm[layer], mkp, mvp)
        cs = memory_attention(zs[..., -MEM_WIDTH:], mem_q_norm[layer], cache_mem_k[layer], cache_mem_v[layer])
        xp = xp + jnp.concatenate([tp, cp], axis=-1) @ w_out[layer]
        xs = xs + jnp.concatenate([ts, cs], axis=-1) @ w_out[layer]
        fp, cvp = conv_ffn(rms_norm(xp, norm_ffn[layer]), jnp.zeros((bp, CONV_W - 1, D_FF), xp.dtype),
                           w_ffn_gate[layer], w_ffn_up[layer], ffn_conv_w[layer], ffn_conv_b[layer], w_ffn_down[layer])
        fs, cvs = conv_ffn(rms_norm(xs, norm_ffn[layer]), state_ffn_conv[layer],
                           w_ffn_gate[layer], w_ffn_up[layer], ffn_conv_w[layer], ffn_conv_b[layer], w_ffn_down[layer])
        xp = xp + fp
        xs = xs + fs
        cvp_l.append(cvp); cvs_l.append(cvs)
    return (xp, xs,
            jnp.stack(hgrn_p), jnp.stack(hgrn_s),
            jnp.stack(kp_l), jnp.stack(vp_l), jnp.stack(ikp_l),
            jnp.stack(ks_l), jnp.stack(vs_l), jnp.stack(iks_l),
            jnp.stack(mk_l), jnp.stack(mv_l),
            jnp.stack(cvp_l), jnp.stack(cvs_l))
```

```cpp
#include <hip/hip_runtime.h>
#include <cstdio>
#include <cstdint>

namespace pg8 {
#define PG8_LAS __attribute__((address_space(3)))
typedef unsigned short bf16_t;
typedef short bf16x8 __attribute__((ext_vector_type(8)));
typedef float f32x4 __attribute__((ext_vector_type(4)));
typedef unsigned u32x4 __attribute__((ext_vector_type(4)));
constexpr int BM = 256, BK = 64, HALF = 128, HTB = HALF * BK * 2  , STAGE_BYTES = 8 * HTB, NXCD = 8, WGM = 8;

__host__ __device__ __forceinline__ int lds_byte(int r, int c) { const int st = (r >> 4) * 2 + (c >> 5), rr = r & 15, cc = c & 31, ob = rr * 64 + cc * 2; return st * 1024 + (ob ^ (((ob >> 9) & 1) << 5)); }
__host__ __device__ __forceinline__ void stage_rc(int b, int& R, int& C) { const int st = b / 1024, sb = b % 1024, swz = sb ^ (((sb >> 9) & 1) << 5); R = (st >> 1) * 16 + swz / 64; C = (st & 1) * 32 + (swz % 64) / 2; }
__host__ __device__ __forceinline__ int perm32(int rho) { const int n = rho >> 4, i = rho & 15; return 8 * (i >> 2) + 4 * n + (i & 3); }

struct Unit { int pm, pn; };
struct Gemm { const bf16_t* A; const bf16_t* Bt; int M, N, K; };

struct StaticOrder {
    int nM, nN, nwg, G, c;
    __host__ __device__ void init(int M, int N, int G_, int c_) { nM = M / BM; nN = N / BM; nwg = nM * nN; G = G_; c = c_; }
    __host__ __device__ bool next(int i, Unit& u) const {
        const long L = (long)i * G + c; if (L >= nwg) return false;
        int wgid = (int)L; { const int q = nwg / NXCD, r = nwg % NXCD, xcd = wgid % NXCD, off = wgid / NXCD; wgid = (xcd < r ? xcd * (q + 1) : r * (q + 1) + (xcd - r) * q) + off; }
        const int nig = WGM * nN, gid = wgid / nig, fm = gid * WGM, gsz = (nM - fm) < WGM ? (nM - fm) : WGM;
        u.pm = fm + ((wgid % nig) % gsz); u.pn = (wgid % nig) / gsz; return true;
    }
    __device__ __forceinline__ void a_ready(const Unit&) const {}
    __device__ __forceinline__ void done(const Unit&) const {}
};


constexpr int MP = 16384, MS = 128, MVALID = MP + MS, MT = 16640, DM = 1024, DFF = 2816;
constexpr float RMS_EPS = 1e-6f;
__device__ __forceinline__ unsigned cvt_pk_bf16(float lo, float hi) { unsigned r; asm volatile("v_cvt_pk_bf16_f32 %0, %1, %2" : "=v"(r) : "v"(lo), "v"(hi)); return r; }

struct SchedX {
    StaticOrder so; int nextra, e_pm0, e_nm, e_pn0;
    __device__ void init(int M, int N, int G_, int c_, int nextra_, int e_pm0_, int e_nm_, int e_pn0_) { so.init(M, N, G_, c_); nextra = nextra_; e_pm0 = e_pm0_; e_nm = e_nm_; e_pn0 = e_pn0_; }
    __device__ bool next(int i, Unit& u) const {
        const long L = (long)i * so.G + so.c;
        if (L < so.nwg) return so.next(i, u);
        const int e = (int)(L - so.nwg); if (e >= nextra) return false;
        u.pm = e_pm0 + e % e_nm; u.pn = e_pn0 + e / e_nm; return true;
    }
    __device__ __forceinline__ void a_ready(const Unit&) const {}
    __device__ __forceinline__ void done(const Unit&) const {}
};

struct EpiZ {
    static constexpr bool PERM = true, AFTER_DRAIN = false;
    bf16_t* Z; int ldz; const float* ss; int nmain; float* memkv; int memrow0;
    __device__ __forceinline__ void operator()(const f32x4 (&acc)[2][2][4][2], const Unit& u, int wr, int wc, int fr, int fq) const {
        const int row0 = u.pm * BM + wr * 64 + fr;
        if (u.pn < nmain) {
            const int col0 = u.pn * BM + wc * 32 + 8 * fq;
#pragma unroll
            for (int ai = 0; ai < 2; ++ai)
#pragma unroll
                for (int m = 0; m < 4; ++m) { const int row = row0 + ai * HALF + m * 16; const float rs = rsqrtf(ss[row] * (1.0f / DM) + RMS_EPS);
#pragma unroll
                    for (int bj = 0; bj < 2; ++bj) { const f32x4 v0 = acc[ai][bj][m][0] * rs, v1 = acc[ai][bj][m][1] * rs;
                        u32x4 w; w.x = cvt_pk_bf16(v0[0], v0[1]); w.y = cvt_pk_bf16(v0[2], v0[3]); w.z = cvt_pk_bf16(v1[0], v1[1]); w.w = cvt_pk_bf16(v1[2], v1[3]);
                        *(u32x4*)(Z + (size_t)row * ldz + col0 + bj * HALF) = w; } }
        } else {
            const int col0 = (u.pn - nmain) * BM + wc * 32 + 8 * fq;
#pragma unroll
            for (int ai = 0; ai < 2; ++ai)
#pragma unroll
                for (int m = 0; m < 4; ++m) { const int row = row0 + ai * HALF + m * 16 - memrow0;
#pragma unroll
                    for (int bj = 0; bj < 2; ++bj) { float* p = memkv + (size_t)row * 1024 + col0 + bj * HALF; *(f32x4*)p = acc[ai][bj][m][0]; *(f32x4*)(p + 4) = acc[ai][bj][m][1]; } }
        }
    }
};

struct EpiResid {
    static constexpr bool PERM = true, AFTER_DRAIN = false;
    const float* rp; const float* rs; float* y; bf16_t* xb; float* ssout;
    __device__ __forceinline__ void operator()(const f32x4 (&acc)[2][2][4][2], const Unit& u, int wr, int wc, int fr, int fq) const {
        const int row0 = u.pm * BM + wr * 64 + fr, col0 = u.pn * BM + wc * 32 + 8 * fq;
#pragma unroll
        for (int ai = 0; ai < 2; ++ai)
#pragma unroll
            for (int m = 0; m < 4; ++m) { const int row = row0 + ai * HALF + m * 16; float part = 0.f;
                if (row < MVALID) { const float* src = row < MP ? rp + (size_t)row * DM : rs + (size_t)(row - MP) * DM;
#pragma unroll
                    for (int bj = 0; bj < 2; ++bj) { const int c = col0 + bj * HALF;
                        const f32x4 v0 = acc[ai][bj][m][0] + *(const f32x4*)(src + c), v1 = acc[ai][bj][m][1] + *(const f32x4*)(src + c + 4);
                        *(f32x4*)(y + (size_t)row * DM + c) = v0; *(f32x4*)(y + (size_t)row * DM + c + 4) = v1;
                        part += (v0[0] * v0[0] + v0[1] * v0[1]) + (v0[2] * v0[2] + v0[3] * v0[3]) + (v1[0] * v1[0] + v1[1] * v1[1]) + (v1[2] * v1[2] + v1[3] * v1[3]);
                        if (xb) { u32x4 w; w.x = cvt_pk_bf16(v0[0], v0[1]); w.y = cvt_pk_bf16(v0[2], v0[3]); w.z = cvt_pk_bf16(v1[0], v1[1]); w.w = cvt_pk_bf16(v1[2], v1[3]);
                            *(u32x4*)(xb + (size_t)row * DM + c) = w; } } }
                part += __shfl_xor(part, 16); part += __shfl_xor(part, 32);
                if (ssout && fq == 0 && row < MVALID) atomicAdd(ssout + row, part); }
    }
};

struct EpiGU {
    static constexpr bool PERM = true, AFTER_DRAIN = false;
    bf16_t* U; bf16_t* UP; const float* ss; float* cvp; float* cvs;
    __device__ __forceinline__ void operator()(const f32x4 (&acc)[2][2][4][2], const Unit& u, int wr, int wc, int fr, int fq) const {
        const int row0 = u.pm * BM + wr * 64 + fr, colg = u.pn * HALF + wc * 32 + 8 * fq;
#pragma unroll
        for (int ai = 0; ai < 2; ++ai)
#pragma unroll
            for (int m = 0; m < 4; ++m) { const int row = row0 + ai * HALF + m * 16; const float rs = rsqrtf(ss[row] * (1.0f / DM) + RMS_EPS);
                const f32x4 g0 = acc[ai][0][m][0] * rs, g1 = acc[ai][0][m][1] * rs, p0 = acc[ai][1][m][0] * rs, p1 = acc[ai][1][m][1] * rs;
                u32x4 w; w.x = cvt_pk_bf16(g0[0], g0[1]); w.y = cvt_pk_bf16(g0[2], g0[3]); w.z = cvt_pk_bf16(g1[0], g1[1]); w.w = cvt_pk_bf16(g1[2], g1[3]);
                *(u32x4*)(U + (size_t)row * DFF + colg) = w;
                w.x = cvt_pk_bf16(p0[0], p0[1]); w.y = cvt_pk_bf16(p0[2], p0[3]); w.z = cvt_pk_bf16(p1[0], p1[1]); w.w = cvt_pk_bf16(p1[2], p1[3]);
                *(u32x4*)(UP + (size_t)row * DFF + colg) = w;
                float* cv = nullptr;
                if (row < MP) { const int t = row & 4095; if (t >= 4094) cv = cvp + (size_t)((row >> 12) * 2 + (t - 4094)) * DFF; }
                else if (row < MVALID) { const int r2 = row - MP, t = r2 & 3; if (t >= 2) cv = cvs + (size_t)((r2 >> 2) * 2 + (t - 2)) * DFF; }
                if (cv) { *(f32x4*)(cv + colg) = g0; *(f32x4*)(cv + colg + 4) = g1; } }
    }
};

template <class Epi, class Sched, bool ALIGN_EPI = false, bool SP2 = false>
__device__ __forceinline__ void gemm_phase(PG8_LAS unsigned char* lds, const Gemm g, const Sched& S, const Epi& E) {
    int tid_ = threadIdx.x; asm volatile("" : "+v"(tid_));
    const int tid = tid_, wid = __builtin_amdgcn_readfirstlane(tid >> 6), lane = tid & 63, wr = wid >> 2, wc = wid & 3, fr = lane & 15, fq = lane >> 4;
    const int K = g.K, nt = K / BK;
    unsigned voffA[2], voffB[2];
#pragma unroll
    for (int i = 0; i < 2; ++i) { int R, C; stage_rc(tid * 16 + i * 8192, R, C); const int Rb = Epi::PERM ? ((R & ~31) + perm32(R & 31)) : R;
        voffA[i] = (unsigned)(R * K + C) * 2u; voffB[i] = (unsigned)(Rb * K + C) * 2u; }
    const size_t kstep = (size_t)(BK * 2);
    const size_t hstep = (size_t)HALF * K * 2;
    const size_t tstep = 2 * hstep;
    const unsigned ldsw = (unsigned)wid * 1024u;
    const int aoff = lds_byte(wr * 64 + fr, fq * 8), boff = lds_byte(wc * 32 + fr, fq * 8);
#define PG8_SA(b, h) (((b) * 2 + (h)) * HTB)
#define PG8_SB(b, h) ((4 + (b) * 2 + (h)) * HTB)
#define PG8_STAGE(bufoff, gbase, voff) do { _Pragma("unroll") for (int _i = 0; _i < 2; ++_i) \
        __builtin_amdgcn_global_load_lds((const unsigned*)((const char*)(gbase) + (voff)[_i]), (PG8_LAS unsigned*)(lds + (bufoff) + ldsw + _i * 8192), 16, 0, 0); } while (0)
#define PG8_LDA(dst, b, h) do { _Pragma("unroll") for (int m = 0; m < 4; ++m) _Pragma("unroll") for (int k = 0; k < 2; ++k) dst[m][k] = *(const PG8_LAS bf16x8*)(lds + PG8_SA(b, h) + aoff + m * 2048 + k * 1024); } while (0)
#define PG8_LDB(dst, b, h) do { _Pragma("unroll") for (int n = 0; n < 2; ++n) _Pragma("unroll") for (int k = 0; k < 2; ++k) dst[n][k] = *(const PG8_LAS bf16x8*)(lds + PG8_SB(b, h) + boff + n * 2048 + k * 1024); } while (0)
#define PG8_MMA(ai, bj, At, Bt) do { __builtin_amdgcn_s_setprio(1); _Pragma("unroll") for (int m = 0; m < 4; ++m) _Pragma("unroll") for (int n = 0; n < 2; ++n) _Pragma("unroll") for (int k = 0; k < 2; ++k) \
        acc[ai][bj][m][n] = __builtin_amdgcn_mfma_f32_16x16x32_bf16(Bt[n][k], At[m][k], acc[ai][bj][m][n], 0, 0, 0); __builtin_amdgcn_s_setprio(0); } while (0)
#define PG8_WAIT_V(n) asm volatile("s_waitcnt vmcnt(" #n ")" ::: "memory")
#define PG8_WAIT_L(n) asm volatile("s_waitcnt lgkmcnt(" #n ")" ::: "memory")
#define PG8_BAR __builtin_amdgcn_s_barrier()
#define PG8_SCHED __builtin_amdgcn_sched_barrier(0)
    Unit cur, nxt; int ui = 0;
    if (!S.next(0, cur)) return;
    f32x4 acc[2][2][4][2];
#pragma unroll
    for (int a = 0; a < 2; ++a)
#pragma unroll
        for (int b = 0; b < 2; ++b)
#pragma unroll
            for (int m = 0; m < 4; ++m)
#pragma unroll
                for (int n = 0; n < 2; ++n) acc[a][b][m][n] = (f32x4){0.f, 0.f, 0.f, 0.f};
    bf16x8 At[4][2], B0[2][2], B1[2][2];
    const char* cA = (const char*)g.A + (size_t)cur.pm * tstep; const char* cB = (const char*)g.Bt + (size_t)cur.pn * tstep;
    S.a_ready(cur);
    if constexpr (SP2) {
        PG8_STAGE(PG8_SB(0, 0), cB, voffB); PG8_STAGE(PG8_SB(0, 1), cB + hstep, voffB); PG8_STAGE(PG8_SA(0, 0), cA, voffA); PG8_STAGE(PG8_SA(0, 1), cA + hstep, voffA);
        if (wr == 1) PG8_BAR;
        PG8_WAIT_V(2); PG8_BAR;
        PG8_STAGE(PG8_SB(1, 0), cB + kstep, voffB); PG8_STAGE(PG8_SA(1, 0), cA + kstep, voffA); PG8_STAGE(PG8_SB(1, 1), cB + hstep + kstep, voffB);
        PG8_WAIT_V(6); PG8_BAR;
    } else {
        PG8_STAGE(PG8_SB(0, 0), cB, voffB); PG8_STAGE(PG8_SA(0, 0), cA, voffA); PG8_STAGE(PG8_SB(0, 1), cB + hstep, voffB); PG8_STAGE(PG8_SA(0, 1), cA + hstep, voffA);
        if (wr == 1) PG8_BAR;
        PG8_WAIT_V(4); PG8_BAR;
        PG8_STAGE(PG8_SB(1, 0), cB + kstep, voffB); PG8_STAGE(PG8_SA(1, 0), cA + kstep, voffA); PG8_STAGE(PG8_SB(1, 1), cB + hstep + kstep, voffB);
        PG8_WAIT_V(6); PG8_BAR;
    }
    for (;;) {
        const bool has_next = S.next(ui + 1, nxt);
        const char* nA = has_next ? (const char*)g.A + (size_t)nxt.pm * tstep : cA; const char* nB = has_next ? (const char*)g.Bt + (size_t)nxt.pn * tstep : cB;
        for (int t = 0; t < nt; t += 2) {
            const bool last = (t == nt - 2);
            const char* a1 = cA + (size_t)(t + 1) * kstep;
            const char* a2 = last ? nA : cA + (size_t)(t + 2) * kstep; const char* b2 = last ? nB : cB + (size_t)(t + 2) * kstep;
            const char* a3 = a2 + kstep; const char* b3 = b2 + kstep;
            if (last && has_next) S.a_ready(nxt);
            if constexpr (SP2) {
            PG8_LDB(B0, 0, 0); PG8_LDB(B1, 0, 1); PG8_SCHED; PG8_LDA(At, 0, 0); PG8_STAGE(PG8_SA(1, 1), a1 + hstep, voffA);
            PG8_WAIT_V(8); PG8_WAIT_L(0); PG8_BAR; PG8_MMA(0, 0, At, B0); PG8_MMA(0, 1, At, B1); PG8_BAR; PG8_SCHED;
            PG8_LDA(At, 0, 1); PG8_STAGE(PG8_SB(0, 0), b2, voffB); PG8_STAGE(PG8_SB(0, 1), b2 + hstep, voffB); PG8_STAGE(PG8_SA(0, 0), a2, voffA);
            PG8_WAIT_V(8); PG8_WAIT_L(0); PG8_BAR; PG8_MMA(1, 0, At, B0); PG8_MMA(1, 1, At, B1); PG8_BAR; PG8_SCHED;
            PG8_LDB(B0, 1, 0); PG8_LDB(B1, 1, 1); PG8_SCHED; PG8_LDA(At, 1, 0); PG8_STAGE(PG8_SA(0, 1), a2 + hstep, voffA);
            PG8_WAIT_V(8); PG8_WAIT_L(0); PG8_BAR; PG8_MMA(0, 0, At, B0); PG8_MMA(0, 1, At, B1); PG8_BAR; PG8_SCHED;
            PG8_LDA(At, 1, 1); PG8_STAGE(PG8_SB(1, 0), b3, voffB); PG8_STAGE(PG8_SB(1, 1), b3 + hstep, voffB); PG8_STAGE(PG8_SA(1, 0), a3, voffA);
            PG8_WAIT_V(8); PG8_WAIT_L(0); PG8_BAR; PG8_MMA(1, 0, At, B0); PG8_MMA(1, 1, At, B1); PG8_BAR; PG8_SCHED;
            } else {
            PG8_LDB(B0, 0, 0); PG8_SCHED; PG8_LDA(At, 0, 0); PG8_STAGE(PG8_SA(1, 1), a1 + hstep, voffA);
            PG8_WAIT_L(8); PG8_BAR; PG8_WAIT_L(0); PG8_MMA(0, 0, At, B0); PG8_BAR; PG8_SCHED;
            PG8_LDB(B1, 0, 1); PG8_STAGE(PG8_SB(0, 0), b2, voffB);
            PG8_BAR; PG8_WAIT_L(0); PG8_MMA(0, 1, At, B1); PG8_BAR;
            PG8_LDA(At, 0, 1); PG8_STAGE(PG8_SA(0, 0), a2, voffA);
            PG8_BAR; PG8_WAIT_L(0); PG8_MMA(1, 0, At, B0); PG8_BAR; PG8_SCHED;
            PG8_STAGE(PG8_SB(0, 1), b2 + hstep, voffB);
            PG8_WAIT_V(6); PG8_BAR; PG8_MMA(1, 1, At, B1); PG8_BAR;
            PG8_LDB(B0, 1, 0); PG8_SCHED; PG8_LDA(At, 1, 0); PG8_STAGE(PG8_SA(0, 1), a2 + hstep, voffA);
            PG8_WAIT_L(8); PG8_BAR; PG8_WAIT_L(0); PG8_MMA(0, 0, At, B0); PG8_BAR; PG8_SCHED;
            PG8_LDB(B1, 1, 1); PG8_STAGE(PG8_SB(1, 0), b3, voffB);
            PG8_BAR; PG8_WAIT_L(0); PG8_MMA(0, 1, At, B1); PG8_BAR;
            PG8_LDA(At, 1, 1); PG8_STAGE(PG8_SA(1, 0), a3, voffA);
            PG8_BAR; PG8_WAIT_L(0); PG8_MMA(1, 0, At, B0); PG8_BAR; PG8_SCHED;
            PG8_STAGE(PG8_SB(1, 1), b3 + hstep, voffB);
            PG8_WAIT_V(6); PG8_BAR; PG8_MMA(1, 1, At, B1); PG8_BAR;
            }
        }
        if constexpr (ALIGN_EPI) { if (wr == 0) PG8_BAR; }
        if constexpr (!Epi::AFTER_DRAIN) { E(acc, cur, wr, wc, fr, fq); S.done(cur); }
        if (!has_next) break;
#pragma unroll
        for (int a = 0; a < 2; ++a)
#pragma unroll
            for (int b = 0; b < 2; ++b)
#pragma unroll
                for (int m = 0; m < 4; ++m)
#pragma unroll
                    for (int n = 0; n < 2; ++n) acc[a][b][m][n] = (f32x4){0.f, 0.f, 0.f, 0.f};
        cur = nxt; cA = nA; cB = nB; ++ui;
        if constexpr (ALIGN_EPI) { if (wr == 1) PG8_BAR; }
    }
    PG8_WAIT_V(0);
    if constexpr (!ALIGN_EPI) { if (wr == 0) PG8_BAR; }
    PG8_BAR;
    if constexpr (Epi::AFTER_DRAIN) { E.fused(acc, cur, wr, wc, fr, fq, lds, wid, lane); S.done(cur); }
#undef PG8_SA
#undef PG8_SB
#undef PG8_STAGE
#undef PG8_LDA
#undef PG8_LDB
#undef PG8_MMA
#undef PG8_WAIT_V
#undef PG8_WAIT_L
#undef PG8_BAR
#undef PG8_SCHED
}
}


#ifndef PG8_SP2
#define PG8_SP2 true
#endif
#ifndef PG8_ALIGN
#define PG8_ALIGN true
#endif
constexpr int NWAVES = 8;
constexpr int MP = pg8::MP, MS = pg8::MS, MVALID = pg8::MVALID, MT = pg8::MT, DM = 1024, DFF = 2816;
constexpr int SEQ = 4096, NB = 4, NSB = 32, PAST = 8192, NPOOL = 2560;
constexpr int ZC0 = 3328, ZC1 = 2304;
constexpr int Z1_Q = 0, Z1_K = 768, Z1_V = 1024, Z1_IQ = 1280, Z1_IK = 1792, Z1_IW = 1856, Z1_MQ = 1920;
constexpr int NMEMROWS = 1024, MEMROW0 = MT;
constexpr float EPS = 1e-6f;
constexpr size_t MiB = 1u << 20;
constexpr size_t WS_CTL = 0, CTL_ZERO_BYTES = 2 * MiB;
constexpr size_t WS_WIN0 = 2 * MiB, WS_WIN1 = 11 * MiB, WS_WOUT = 16 * MiB, WS_WGU = 20 * MiB, WS_WD = 42 * MiB;
constexpr size_t WS_XB = 54 * MiB, WS_MEMKV = 89 * MiB, WS_MIX = 94 * MiB, WS_Z = 128 * MiB, WS_U = 234 * MiB, WS_UP = 324 * MiB, WS_ACT = 414 * MiB;
constexpr size_t WS_QB = 504 * MiB, WS_KB = 528 * MiB, WS_VB = 536 * MiB, WS_IQB = 544 * MiB, WS_IKB = 560 * MiB, WS_IW = 562 * MiB;
constexpr size_t WS_SQ = 563 * MiB, WS_SIQ = WS_SQ + 512 * 1024, WS_SIW = WS_SIQ + 384 * 1024, WS_SSC = 564 * MiB, WS_SIDX = 569 * MiB, WS_MASK = 570 * MiB, WS_SC = 578 * MiB, WS_END = 834 * MiB;
constexpr int SSC_LD = 8256;
constexpr int CW_TMO = 0, CW_BAR = 4096, CW_Q = 8192, CW_SS = 16384;
constexpr size_t O_YP = 0, O_YS = O_YP + (size_t)MP * DM, O_HP = O_YS + (size_t)MS * DM, O_HS = O_HP + 4 * 6 * 16384, O_KP = O_HS + 32 * 6 * 16384,
    O_VP = O_KP + (size_t)MP * 256, O_IKP = O_VP + (size_t)MP * 256, O_KS = O_IKP + (size_t)MP * 64, O_VS = O_KS + MS * 256, O_IKS = O_VS + MS * 256,
    O_MK = O_IKS + MS * 64, O_MV = O_MK + 2 * 1024 * 256, O_CVP = O_MV + 2 * 1024 * 256, O_CVS = O_CVP + 2 * 4 * 2 * DFF, O_END = O_CVS + 2 * 32 * 2 * DFF;
static_assert(O_END == 31412224, "output size");
constexpr int RING_OFF = 0, RING_BYTES = 131072;
constexpr int LDSCTL_OFF = RING_BYTES, MISC_OFF = LDSCTL_OFF + 320;
constexpr int LDS_BYTES = 147456;

#define GAS __attribute__((address_space(1)))
#define LAS __attribute__((address_space(3)))
typedef unsigned short bf16;
typedef unsigned v4u __attribute__((ext_vector_type(4)));
typedef float f32x4 __attribute__((ext_vector_type(4)));
typedef short bf16x8 __attribute__((ext_vector_type(8)));
typedef GAS unsigned gu32;
typedef GAS unsigned long long gu64;
#define RLX_AGENT __ATOMIC_RELAXED, __HIP_MEMORY_SCOPE_AGENT
#define LDS_WAIT() asm volatile("s_waitcnt lgkmcnt(0)" ::: "memory")
#define VM_WAIT() asm volatile("s_waitcnt vmcnt(0)" ::: "memory")
__device__ __forceinline__ unsigned long long rt() { return __builtin_amdgcn_s_memrealtime(); }
__device__ __forceinline__ unsigned f2bf(float f) { unsigned u = __builtin_bit_cast(unsigned, f); return (u + 0x7fffu + ((u >> 16) & 1u)) >> 16; }
__device__ __forceinline__ unsigned pk2(float lo, float hi) { return f2bf(lo) | (f2bf(hi) << 16); }

#define XB_TMO      128
#define XB_XCNT(j)  (256  + 64 * (j))
#define XB_XSUB(j)  (1280 + 64 * (j))
#define XB_XGEN(j)  (2304 + 64 * (j))
#define XB_TOP      3328
#define XB_TOPGEN   3392
#define XCD_BAR_WORDS 3456
#define XB_SPIN_CAP (1u << 18)

__device__ __forceinline__ unsigned xb_ld(unsigned* p)              { return __hip_atomic_load(p, __ATOMIC_RELAXED, __HIP_MEMORY_SCOPE_AGENT); }
__device__ __forceinline__ unsigned xb_add(unsigned* p, unsigned v) { return __hip_atomic_fetch_add(p, v, __ATOMIC_RELAXED, __HIP_MEMORY_SCOPE_AGENT); }
__device__ __forceinline__ unsigned xb_xcc_id() { return (unsigned)__builtin_amdgcn_s_getreg((3 << 11) | 20) & 0xFu; }
#define XB_SPIN(cond, bar) do { unsigned _sp = 0; while (cond) { __builtin_amdgcn_s_sleep(1); \
    if ((++_sp & 255u) == 0u) { if (xb_ld(&(bar)[XB_TMO])) break; if (_sp > XB_SPIN_CAP) { atomicAdd(&(bar)[XB_TMO], 1u); break; } } } } while (0)

struct XcdBarrier {
    unsigned* bar; unsigned x;
    volatile LAS unsigned* st;
};

__device__ __forceinline__ XcdBarrier xcd_barrier_post(unsigned* bar, volatile LAS unsigned* st) {
    XcdBarrier b; b.bar = bar; b.x = xb_xcc_id(); b.st = st;
    if (threadIdx.x == 0) (void)xb_add(&bar[XB_XCNT(b.x)], 1u);
    return b;
}
__device__ __forceinline__ void xcd_barrier_complete(unsigned* bar, unsigned x, unsigned& nloc, unsigned& nx) {
    const unsigned G = gridDim.x * gridDim.y * gridDim.z;
    unsigned sum, cnt, mine, sp = 0u;
    for (;;) {
        sum = 0u; cnt = 0u; mine = 0u;
#pragma unroll
        for (unsigned j = 0; j < 16; ++j) { const unsigned c = xb_ld(&bar[XB_XCNT(j)]); sum += c; cnt += (c > 0u) ? 1u : 0u; mine = (j == x) ? c : mine; }
        if (sum == G) break;
        __builtin_amdgcn_s_sleep(1);
        if ((++sp & 255u) == 0u) { if (xb_ld(&bar[XB_TMO])) break; if (sp > XB_SPIN_CAP) { atomicAdd(&bar[XB_TMO], 1u); break; } }
    }
    nloc = mine > 0u ? mine : 1u; nx = cnt > 0u ? cnt : 1u;
}

__device__ __forceinline__ void xcd_barrier(const XcdBarrier& b) {
    asm volatile("s_waitcnt vmcnt(0)" ::: "memory");
    __syncthreads();
    if (threadIdx.x == 0) {
        unsigned* bar = b.bar;
        __builtin_amdgcn_s_waitcnt(0);
        unsigned nloc = b.st[0], nx = b.st[1];
        if (nloc == 0u) { xcd_barrier_complete(bar, b.x, nloc, nx); b.st[0] = nloc; b.st[1] = nx; }
        const unsigned old = xb_add(&bar[XB_XSUB(b.x)], 1u);
        const unsigned gen = old / nloc;
        if (old + 1u == (gen + 1u) * nloc) {
            __builtin_amdgcn_fence(__ATOMIC_RELEASE, "agent");
            asm volatile("s_waitcnt vmcnt(0)" ::: "memory");
            const unsigned og = xb_add(&bar[XB_TOP], 1u);
            const unsigned tg = og / nx;
            if (og + 1u == (tg + 1u) * nx) xb_add(&bar[XB_TOPGEN], 1u);
            else XB_SPIN(xb_ld(&bar[XB_TOPGEN]) == tg, bar);
            __builtin_amdgcn_fence(__ATOMIC_ACQUIRE, "agent");
            xb_add(&bar[XB_XGEN(b.x)], 1u);
            asm volatile("s_waitcnt vmcnt(0)" ::: "memory");
        } else {
            XB_SPIN(xb_ld(&bar[XB_XGEN(b.x)]) == gen, bar);
            __builtin_amdgcn_fence(__ATOMIC_ACQUIRE, "agent");
            asm volatile("s_waitcnt vmcnt(0)" ::: "memory");
        }
    }
    __syncthreads();
}


struct Args { const float* in[29]; const int* page_table; float* out; unsigned char* ws; int ph_lo, ph_hi; };
struct Ctx { LAS unsigned char* lds; volatile LAS unsigned* MISC; gu32* ctl; int tid, lane, wave, vcu, G; };
typedef float f32x16 __attribute__((ext_vector_type(16)));
typedef unsigned long long u64;

__device__ __forceinline__ float bf2f(unsigned b) { return __builtin_bit_cast(float, b << 16); }
__device__ __forceinline__ float wave_sum(float v) {
#pragma unroll
    for (int o = 1; o < 64; o <<= 1) v += __shfl_xor(v, o);
    return v;
}
__device__ __forceinline__ int crow(int r, int hi) { return (r & 3) + 8 * (r >> 2) + 4 * hi; }
__device__ __forceinline__ float sigmoidf_(float x) { return 1.0f / (1.0f + __expf(-x)); }
__device__ __forceinline__ float* ssptr(const Ctx& c, int i) { return (float*)(c.ctl + CW_SS) + (size_t)i * MT; }

__device__ __forceinline__ int q_next(Ctx& c, int qi) {
    __syncthreads();
    if (c.tid == 0) c.MISC[16] = atomicAdd((unsigned*)(c.ctl + CW_Q + 64 * qi), 1u);
    __syncthreads();
    return (int)c.MISC[16];
}

template <int K>
__device__ __forceinline__ f32x16 mm32(const LAS bf16* A, int lda, const LAS bf16* Bt, int ldb, f32x16 acc, int lane) {
    const int r = lane & 31, h = lane >> 5;
#pragma unroll
    for (int ks = 0; ks < K; ks += 16) {
        const bf16x8 a = *(const LAS bf16x8*)(A + r * lda + ks + 8 * h);
        const bf16x8 b = *(const LAS bf16x8*)(Bt + r * ldb + ks + 8 * h);
        acc = __builtin_amdgcn_mfma_f32_32x32x16_bf16(a, b, acc, 0, 0, 0);
    }
    return acc;
}

__device__ __forceinline__ int map_row(int mapid, int n, int row_off) {
    if (mapid == 0) return n + row_off;
    if (mapid == 1) return n < 1864 ? n : n + 56;
    if (mapid == 2) return (n >> 7) * 256 + (n & 127);
    return (n >> 7) * 256 + 128 + (n & 127);
}
__device__ __forceinline__ void transpose_item(const float* W, int K, int N, const float* kscale, bf16* WT, int mapid, int row_off, LAS float* scr, int item, int lane) {
    const int nblk = (N + 31) / 32, kb = item / nblk, nb = item % nblk, k0 = 64 * kb, n0 = 32 * nb;
#pragma unroll 8
    for (int i = 0; i < 32; ++i) { const int kk = 2 * i + (lane >> 5), n = n0 + (lane & 31);
        float v = n < N ? W[(size_t)(k0 + kk) * N + n] : 0.f; if (kscale) v *= kscale[k0 + kk];
        scr[kk * 33 + (lane & 31)] = v; }
    LDS_WAIT(); asm volatile("" ::: "memory");
    const int cc = lane & 7;
#pragma unroll
    for (int j = 0; j < 4; ++j) { const int nl = (lane >> 3) + 8 * j, n = n0 + nl; const LAS float* s = scr + (8 * cc) * 33 + nl;
        v4u o; o.x = pk2(s[0 * 33], s[1 * 33]); o.y = pk2(s[2 * 33], s[3 * 33]); o.z = pk2(s[4 * 33], s[5 * 33]); o.w = pk2(s[6 * 33], s[7 * 33]);
        if (n < N) *(GAS v4u*)(WT + (size_t)map_row(mapid, n, row_off) * K + k0 + 8 * cc) = o; }
    LDS_WAIT(); asm volatile("" ::: "memory");
}
__device__ __forceinline__ void p0_prologue(Ctx& c, const Args& a) {
    LAS float* scr = (LAS float*)(c.lds + RING_OFF + c.wave * 16384);
    const int gw = c.vcu * NWAVES + c.wave, NGW = c.G * NWAVES, lane = c.lane;
    unsigned char* ws = a.ws;
    constexpr int I_INH = 16 * 104, I_MKV = 16 * 16, I_DSA = 16 * 67, I_OUT = 16 * 32, I_G = 16 * 88, I_D = 44 * 32;
    constexpr int NITEMS = I_INH + 2 * I_MKV + I_DSA + 2 * I_OUT + 4 * I_G + 2 * I_D;
    for (int it = gw; it < NITEMS; it += NGW) {
        int r = it;
        if (r < I_INH) { transpose_item(a.in[13], 1024, 3328, a.in[11], (bf16*)(ws + WS_WIN0), 0, 0, scr, r, lane); continue; } r -= I_INH;
        if (r < I_MKV) { transpose_item(a.in[20], 1024, 512, nullptr, (bf16*)(ws + WS_WIN0), 0, 3328, scr, r, lane); continue; } r -= I_MKV;
        if (r < I_MKV) { transpose_item(a.in[20] + 1024 * 512, 1024, 512, nullptr, (bf16*)(ws + WS_WIN0), 0, 3840, scr, r, lane); continue; } r -= I_MKV;
        if (r < I_DSA) { transpose_item(a.in[16], 1024, 2120, a.in[11] + 1024, (bf16*)(ws + WS_WIN1), 1, 0, scr, r, lane); continue; } r -= I_DSA;
        if (r < 2 * I_OUT) { const int l = r / I_OUT; transpose_item(a.in[23] + (size_t)l * 1024 * 1024, 1024, 1024, nullptr, (bf16*)(ws + WS_WOUT) + (size_t)l * 1024 * 1024, 0, 0, scr, r % I_OUT, lane); continue; } r -= 2 * I_OUT;
        if (r < 2 * I_G) { const int l = r / I_G; transpose_item(a.in[24] + (size_t)l * 1024 * DFF, 1024, DFF, a.in[12] + l * 1024, (bf16*)(ws + WS_WGU) + (size_t)l * 5632 * 1024, 2, 0, scr, r % I_G, lane); continue; } r -= 2 * I_G;
        if (r < 2 * I_G) { const int l = r / I_G; transpose_item(a.in[25] + (size_t)l * 1024 * DFF, 1024, DFF, a.in[12] + l * 1024, (bf16*)(ws + WS_WGU) + (size_t)l * 5632 * 1024, 3, 0, scr, r % I_G, lane); continue; } r -= 2 * I_G;
        { const int l = r / I_D; transpose_item(a.in[28] + (size_t)l * DFF * 1024, DFF, 1024, nullptr, (bf16*)(ws + WS_WD) + (size_t)l * 1024 * DFF, 0, 0, scr, r % I_D, lane); }
    }
    for (int rr = gw; rr < 184; rr += NGW) { const int row = rr < 56 ? 1864 + rr : 2176 + (rr - 56);
        GAS v4u* p = (GAS v4u*)((bf16*)(ws + WS_WIN1) + (size_t)row * 1024); p[lane] = (v4u){0u, 0u, 0u, 0u}; p[64 + lane] = (v4u){0u, 0u, 0u, 0u}; }
    float* ss0 = ssptr(c, 0);
    for (int m = gw; m < MT + NMEMROWS; m += NGW) {
        GAS u64* o8 = (GAS u64*)((bf16*)(ws + WS_XB) + (size_t)m * DM) + lane;
        if (m >= MVALID && m < MT) {
#pragma unroll
            for (int j = 0; j < 4; ++j) o8[64 * j] = 0ull;
            continue; }
        const float* src = m < MP ? a.in[0] + (size_t)m * DM : (m < MVALID ? a.in[1] + (size_t)(m - MP) * DM : a.in[10] + (size_t)(m - MT) * DM);
        const GAS f32x4* xr = (const GAS f32x4*)src + lane; f32x4 v[4]; float s = 0.f;
#pragma unroll
        for (int j = 0; j < 4; ++j) { v[j] = xr[64 * j]; s += (v[j].x * v[j].x + v[j].y * v[j].y) + (v[j].z * v[j].z + v[j].w * v[j].w); }
        s = wave_sum(s);
#pragma unroll
        for (int j = 0; j < 4; ++j) o8[64 * j] = (u64)pk2(v[j].x, v[j].y) | ((u64)pk2(v[j].z, v[j].w) << 32);
        if (m < MVALID && lane == 0) ss0[m] = s;
    }
}

__device__ __forceinline__ void memattn_unit(Ctx& c, const bf16* Zq  , int ldz, int nrows_valid, const float* Kp, const float* Vp, int kstride,
                                             bool normk, const float* kgain, const float* qgain, bf16* Out  ) {
    LAS bf16* KN = (LAS bf16*)(c.lds);
    LAS bf16* VTm = (LAS bf16*)(c.lds + 36864);
    LAS bf16* QN = (LAS bf16*)(c.lds + 70656) + c.wave * (32 * 72);
    LAS float* LI = (LAS float*)(c.lds + 107520) + c.wave * 32;
    int tid = c.tid; asm volatile("" : "+v"(tid));
    const int lane = tid & 63, w = c.wave;
    {
        const int m = tid >> 1, dh = (tid & 1) * 32;
        f32x4 kv[8]; float s = 0.f;
#pragma unroll
        for (int j = 0; j < 8; ++j) { kv[j] = *(const f32x4*)(Kp + (size_t)m * kstride + dh + 4 * j); s += (kv[j].x * kv[j].x + kv[j].y * kv[j].y) + (kv[j].z * kv[j].z + kv[j].w * kv[j].w); }
        s += __shfl_xor(s, 1);
        const float rs = normk ? rsqrtf(s * (1.0f / 64.0f) + EPS) : 1.0f;
#pragma unroll
        for (int j = 0; j < 8; j += 2) { f32x4 g0 = {1.f, 1.f, 1.f, 1.f}, g1 = g0;
            if (normk) { g0 = *(const f32x4*)(kgain + dh + 4 * j); g1 = *(const f32x4*)(kgain + dh + 4 * j + 4); }
            const f32x4 x0 = kv[j] * rs * g0, x1 = kv[j + 1] * rs * g1;
            v4u o; o.x = pk2(x0.x, x0.y); o.y = pk2(x0.z, x0.w); o.z = pk2(x1.x, x1.y); o.w = pk2(x1.z, x1.w);
            *(LAS v4u*)(KN + m * 72 + dh + 4 * j) = o; }
#pragma unroll
        for (int j = 0; j < 8; ++j) { const f32x4 vv = *(const f32x4*)(Vp + (size_t)m * kstride + dh + 4 * j);
            VTm[(dh + 4 * j + 0) * 264 + m] = (bf16)f2bf(vv.x); VTm[(dh + 4 * j + 1) * 264 + m] = (bf16)f2bf(vv.y);
            VTm[(dh + 4 * j + 2) * 264 + m] = (bf16)f2bf(vv.z); VTm[(dh + 4 * j + 3) * 264 + m] = (bf16)f2bf(vv.w); }
    }
    {
        const int row = lane >> 1, hf = lane & 1, grow = w * 32 + row;
        float x[32]; float s = 0.f;
        if (grow < nrows_valid) {
#pragma unroll
            for (int j = 0; j < 4; ++j) { const v4u q = *(const v4u*)(Zq + (size_t)grow * ldz + hf * 32 + 8 * j);
                x[8 * j + 0] = bf2f(q.x & 0xffffu); x[8 * j + 1] = bf2f(q.x >> 16); x[8 * j + 2] = bf2f(q.y & 0xffffu); x[8 * j + 3] = bf2f(q.y >> 16);
                x[8 * j + 4] = bf2f(q.z & 0xffffu); x[8 * j + 5] = bf2f(q.z >> 16); x[8 * j + 6] = bf2f(q.w & 0xffffu); x[8 * j + 7] = bf2f(q.w >> 16); }
        } else {
#pragma unroll
            for (int j = 0; j < 32; ++j) x[j] = 0.f;
        }
#pragma unroll
        for (int j = 0; j < 32; ++j) s += x[j] * x[j];
        s += __shfl_xor(s, 1);
        const float rs = rsqrtf(s * (1.0f / 64.0f) + EPS) * 0.125f;
#pragma unroll
        for (int j = 0; j < 32; j += 8) { v4u o;
            o.x = pk2(x[j] * rs * qgain[hf * 32 + j], x[j + 1] * rs * qgain[hf * 32 + j + 1]); o.y = pk2(x[j + 2] * rs * qgain[hf * 32 + j + 2], x[j + 3] * rs * qgain[hf * 32 + j + 3]);
            o.z = pk2(x[j + 4] * rs * qgain[hf * 32 + j + 4], x[j + 5] * rs * qgain[hf * 32 + j + 5]); o.w = pk2(x[j + 6] * rs * qgain[hf * 32 + j + 6], x[j + 7] * rs * qgain[hf * 32 + j + 7]);
            *(LAS v4u*)(QN + row * 72 + hf * 32 + j) = o; }
    }
    __syncthreads();
    if (w * 32 < nrows_valid) {
        const int r32 = lane & 31, hh = lane >> 5;
        f32x16 s[8];
#pragma unroll
        for (int mt = 0; mt < 8; ++mt) { f32x16 z = {}; s[mt] = mm32<64>(KN + mt * 32 * 72, 72, QN, 72, z, lane); }
        float mx = -1e30f;
#pragma unroll
        for (int mt = 0; mt < 8; ++mt)
#pragma unroll
            for (int r = 0; r < 16; ++r) mx = fmaxf(mx, s[mt][r]);
        mx = fmaxf(mx, __shfl_xor(mx, 32));
        float l = 0.f;
#pragma unroll
        for (int mt = 0; mt < 8; ++mt)
#pragma unroll
            for (int r = 0; r < 16; ++r) { const float p = __expf(s[mt][r] - mx); s[mt][r] = p; l += p; }
        l += __shfl_xor(l, 32);
        if (hh == 0) LI[r32] = l;
        f32x16 o[2] = {};
#pragma unroll
        for (int mt = 0; mt < 8; ++mt)
#pragma unroll
            for (int sx = 0; sx < 2; ++sx) {
                v4u pa; pa.x = pk2(s[mt][8 * sx + 0], s[mt][8 * sx + 1]); pa.y = pk2(s[mt][8 * sx + 2], s[mt][8 * sx + 3]);
                pa.z = pk2(s[mt][8 * sx + 4], s[mt][8 * sx + 5]); pa.w = pk2(s[mt][8 * sx + 6], s[mt][8 * sx + 7]);
                const bf16x8 af = __builtin_bit_cast(bf16x8, pa);
#pragma unroll
                for (int dt = 0; dt < 2; ++dt) { const LAS bf16* vp = VTm + (dt * 32 + r32) * 264 + mt * 32 + 16 * sx + 4 * hh;
                    const u64 lo = *(const LAS u64*)vp, hi = *(const LAS u64*)(vp + 8);
                    v4u bw; bw.x = (unsigned)lo; bw.y = (unsigned)(lo >> 32); bw.z = (unsigned)hi; bw.w = (unsigned)(hi >> 32);
                    o[dt] = __builtin_amdgcn_mfma_f32_32x32x16_bf16(af, __builtin_bit_cast(bf16x8, bw), o[dt], 0, 0, 0); }
            }
        LDS_WAIT();
#pragma unroll
        for (int r = 0; r < 16; ++r) { const int qr = crow(r, hh), grow = w * 32 + qr; const float il = 1.0f / LI[qr];
            if (grow < nrows_valid) {
#pragma unroll
                for (int dt = 0; dt < 2; ++dt) Out[(size_t)grow * DM + dt * 32 + r32] = (bf16)f2bf(o[dt][r] * il); } }
    }
}

__device__ __forceinline__ void hgrn_unit(Ctx& c, const Args& a, bool sample, int b, int h) {
    LAS unsigned char* L = c.lds;
    LAS float* LF = (LAS float*)(L + 0);
    LAS float* BL = (LAS float*)(L + 16384);
    LAS float* DVv = (LAS float*)(L + 16896);
    LAS bf16* QD = (LAS bf16*)(L + 17408);
    LAS bf16* KD = (LAS bf16*)(L + 26112);
    LAS bf16* KET = (LAS bf16*)(L + 34816);
    LAS bf16* VT = (LAS bf16*)(L + 45056);
    LAS bf16* SCB = (LAS bf16*)(L + 55296);
    LAS bf16* STt = (LAS bf16*)(L + 57856);
    int tid = c.tid; asm volatile("" : "+v"(tid));
    const int lane = tid & 63, w = c.wave, r32 = lane & 31, hh = lane >> 5;
    const int te = tid >> 4, k8 = (tid & 15) * 8;
    const bf16* Z = (const bf16*)(a.ws + WS_Z);
    bf16* MIX = (bf16*)(a.ws + WS_MIX);
    const int nch = sample ? 1 : 128, nvalid = sample ? 4 : 32;
    const int kt = w >> 1, vt0 = 2 * (w & 1);
    f32x16 S0 = {}, S1 = {};
    if (sample) { const float* sp = a.in[7] + (size_t)(b * 6 + h) * 16384;
#pragma unroll
        for (int r = 0; r < 16; ++r) { const int k = 32 * kt + crow(r, hh); S0[r] = sp[k * 128 + 32 * vt0 + r32]; S1[r] = sp[k * 128 + 32 * (vt0 + 1) + r32]; } }
    float lbv[8], onv[8];
#pragma unroll
    for (int j = 0; j < 8; ++j) { const float l0 = a.in[14][h * 128 + k8 + j], l1 = a.in[14][768 + h * 128 + k8 + j]; lbv[j] = 1.0f / (1.0f + __expf(l1 - l0)); onv[j] = a.in[15][k8 + j]; }
    __syncthreads();
#define HG_WRITE_ST() do { _Pragma("unroll") for (int g = 0; g < 4; ++g) { const int k0 = 32 * kt + 8 * g + 4 * hh; \
        *(LAS u64*)(STt + (32 * vt0 + r32) * 136 + k0) = (u64)pk2(S0[4 * g], S0[4 * g + 1]) | ((u64)pk2(S0[4 * g + 2], S0[4 * g + 3]) << 32); \
        *(LAS u64*)(STt + (32 * (vt0 + 1) + r32) * 136 + k0) = (u64)pk2(S1[4 * g], S1[4 * g + 1]) | ((u64)pk2(S1[4 * g + 2], S1[4 * g + 3]) << 32); } } while (0)
    HG_WRITE_ST();
    for (int ch = 0; ch < nch; ++ch) {
        const int row0 = sample ? MP + 4 * b : b * SEQ + 32 * ch, row = row0 + te;
        const bool valid = te < nvalid;
        float qs[8], kk[8]; v4u gz = {0u, 0u, 0u, 0u};
        {
            v4u zq = {0u, 0u, 0u, 0u}, zf = zq, zi = zq;
            if (valid) { const bf16* zr = Z + (size_t)row * ZC0 + h * 128 + k8;
                zq = *(const v4u*)zr; zf = *(const v4u*)(zr + 768); zi = *(const v4u*)(zr + 1536); gz = *(const v4u*)(zr + 2304); }
            const unsigned qw[4] = {zq.x, zq.y, zq.z, zq.w}, fw[4] = {zf.x, zf.y, zf.z, zf.w}, iw[4] = {zi.x, zi.y, zi.z, zi.w};
            float lf[8];
#pragma unroll
            for (int j = 0; j < 8; ++j) { const float q = bf2f((qw[j >> 1] >> (16 * (j & 1))) & 0xffffu), fp = bf2f((fw[j >> 1] >> (16 * (j & 1))) & 0xffffu);
                const float sg = sigmoidf_(fp), f = lbv[j] + (1.0f - lbv[j]) * sg;
                qs[j] = valid ? q * sigmoidf_(q) : 0.f; kk[j] = valid ? (1.0f - f) : 0.f; lf[j] = valid ? __logf(f) : 0.f;
                VT[(k8 + j) * 40 + te] = (bf16)((iw[j >> 1] >> (16 * (j & 1))) & 0xffffu); }
            *(LAS f32x4*)(LF + te * 128 + k8) = (f32x4){lf[0], lf[1], lf[2], lf[3]}; *(LAS f32x4*)(LF + te * 128 + k8 + 4) = (f32x4){lf[4], lf[5], lf[6], lf[7]};
        }
        __syncthreads();
        if (tid < 128) { float bsum = 0.f;
#pragma unroll
            for (int t = 0; t < 32; ++t) { bsum += LF[t * 128 + tid]; LF[t * 128 + tid] = bsum; }
            BL[tid] = bsum; }
        __syncthreads();
        {
            const f32x4 b0 = *(const LAS f32x4*)(LF + te * 128 + k8), b1 = *(const LAS f32x4*)(LF + te * 128 + k8 + 4);
            const f32x4 l0 = *(const LAS f32x4*)(BL + k8), l1 = *(const LAS f32x4*)(BL + k8 + 4);
            const float bb[8] = {b0.x, b0.y, b0.z, b0.w, b1.x, b1.y, b1.z, b1.w}, bl[8] = {l0.x, l0.y, l0.z, l0.w, l1.x, l1.y, l1.z, l1.w};
            float qd[8], kd[8];
#pragma unroll
            for (int j = 0; j < 8; ++j) { qd[j] = qs[j] * __expf(bb[j]); kd[j] = kk[j] * __expf(-bb[j]); KET[(k8 + j) * 40 + te] = (bf16)f2bf(kk[j] * __expf(bl[j] - bb[j])); }
            v4u o; o.x = pk2(qd[0], qd[1]); o.y = pk2(qd[2], qd[3]); o.z = pk2(qd[4], qd[5]); o.w = pk2(qd[6], qd[7]); *(LAS v4u*)(QD + te * 136 + k8) = o;
            o.x = pk2(kd[0], kd[1]); o.y = pk2(kd[2], kd[3]); o.z = pk2(kd[4], kd[5]); o.w = pk2(kd[6], kd[7]); *(LAS v4u*)(KD + te * 136 + k8) = o;
            if (te == 0) {
#pragma unroll
                for (int j = 0; j < 8; ++j) DVv[k8 + j] = __expf(bl[j]); }
        }
        __syncthreads();
        f32x16 oacc = {};
        if (w == 0) { f32x16 z = {}; const f32x16 sc = mm32<128>(QD, 136, KD, 136, z, lane);
#pragma unroll
            for (int r = 0; r < 16; ++r) { const int t = crow(r, hh); SCB[t * 40 + r32] = (bf16)f2bf(r32 <= t ? sc[r] : 0.f); } }
        if (w < 4) oacc = mm32<128>(QD, 136, STt + (w * 32) * 136, 136, oacc, lane);
        __syncthreads();
        if (w < 4) { oacc = mm32<32>(SCB, 40, VT + (w * 32) * 40, 40, oacc, lane);
#pragma unroll
            for (int r = 0; r < 16; ++r) LF[crow(r, hh) * 128 + w * 32 + r32] = oacc[r]; }
        {
#pragma unroll
            for (int r = 0; r < 16; ++r) { const float d = DVv[32 * kt + crow(r, hh)]; S0[r] *= d; S1[r] *= d; }
            S0 = mm32<32>(KET + (kt * 32) * 40, 40, VT + (vt0 * 32) * 40, 40, S0, lane);
            S1 = mm32<32>(KET + (kt * 32) * 40, 40, VT + ((vt0 + 1) * 32) * 40, 40, S1, lane);
        }
        __syncthreads();
        HG_WRITE_ST();
        {
            const f32x4 o0 = *(const LAS f32x4*)(LF + te * 128 + k8), o1 = *(const LAS f32x4*)(LF + te * 128 + k8 + 4);
            float ov[8] = {o0.x, o0.y, o0.z, o0.w, o1.x, o1.y, o1.z, o1.w}; float s = 0.f;
#pragma unroll
            for (int j = 0; j < 8; ++j) s += ov[j] * ov[j];
            s += __shfl_xor(s, 1); s += __shfl_xor(s, 2); s += __shfl_xor(s, 4); s += __shfl_xor(s, 8);
            const float rs = rsqrtf(s * (1.0f / 128.0f) + EPS);
            const unsigned gw_[4] = {gz.x, gz.y, gz.z, gz.w}; float y[8];
#pragma unroll
            for (int j = 0; j < 8; ++j) { const float g = bf2f((gw_[j >> 1] >> (16 * (j & 1))) & 0xffffu); y[j] = ov[j] * rs * onv[j] * (g * sigmoidf_(g)); }
            if (valid) { v4u o; o.x = pk2(y[0], y[1]); o.y = pk2(y[2], y[3]); o.z = pk2(y[4], y[5]); o.w = pk2(y[6], y[7]); *(v4u*)(MIX + (size_t)row * DM + h * 128 + k8) = o; }
        }
        __syncthreads();
    }
#undef HG_WRITE_ST
    float* so = a.out + (sample ? O_HS : O_HP) + (size_t)(b * 6 + h) * 16384;
#pragma unroll
    for (int r = 0; r < 16; ++r) { const int k = 32 * kt + crow(r, hh); so[k * 128 + 32 * vt0 + r32] = S0[r]; so[k * 128 + 32 * (vt0 + 1) + r32] = S1[r]; }
}

__device__ __forceinline__ void memkv_finalize_row(const Args& a, int layer, int row, int lane) {
    const float* src = (const float*)(a.ws + WS_MEMKV) + (size_t)row * 1024 + layer * 512;
    const int hd = lane >> 4, d4 = (lane & 15) * 4;
    const f32x4 k = *(const f32x4*)(src + hd * 64 + d4), v = *(const f32x4*)(src + 256 + hd * 64 + d4);
    float s = (k.x * k.x + k.y * k.y) + (k.z * k.z + k.w * k.w);
    s += __shfl_xor(s, 1); s += __shfl_xor(s, 2); s += __shfl_xor(s, 4); s += __shfl_xor(s, 8);
    const float rs = rsqrtf(s * (1.0f / 64.0f) + EPS); const f32x4 g = *(const f32x4*)(a.in[22] + layer * 64 + d4);
    *(f32x4*)(a.out + O_MK + ((size_t)layer * 1024 + row) * 256 + hd * 64 + d4) = k * rs * g;
    *(f32x4*)(a.out + O_MV + ((size_t)layer * 1024 + row) * 256 + hd * 64 + d4) = v;
}

__device__ __forceinline__ void memattn_prompt_unit(Ctx& c, const Args& a, int layer, int u) {
    const int blk = u & 15, hd = (u >> 4) & 3, b = u >> 6;
    const bf16* Z = (const bf16*)(a.ws + WS_Z); const int ldz = layer ? ZC1 : ZC0, qc = layer ? Z1_MQ : 3072;
    const float* kv = (const float*)(a.ws + WS_MEMKV) + (size_t)(b * 256) * 1024 + layer * 512 + hd * 64;
    const int row0 = b * SEQ + blk * 256;
    memattn_unit(c, Z + (size_t)row0 * ldz + qc + hd * 64, ldz, 256, kv, kv + 256, 1024, true, a.in[22] + layer * 64, a.in[21] + layer * 64,
                 (bf16*)(a.ws + WS_MIX) + (size_t)row0 * DM + 768 + hd * 64);
}
__device__ __forceinline__ void memattn_sample_unit(Ctx& c, const Args& a, int layer, int u) {
    const int hd = u & 3, sb = u >> 2;
    const bf16* Z = (const bf16*)(a.ws + WS_Z); const int ldz = layer ? ZC1 : ZC0, qc = layer ? Z1_MQ : 3072;
    const size_t off = ((size_t)(layer * 32 + sb) * 256) * 256 + hd * 64;
    const int row0 = MP + sb * 4;
    memattn_unit(c, Z + (size_t)row0 * ldz + qc + hd * 64, ldz, 4, a.in[5] + off, a.in[6] + off, 256, false, nullptr, a.in[21] + layer * 64,
                 (bf16*)(a.ws + WS_MIX) + (size_t)row0 * DM + 768 + hd * 64);
}

__device__ __forceinline__ void p2_mixer0(Ctx& c, const Args& a) {
    constexpr int U_HP = 24, U_MAP = U_HP + 256, U_HS = U_MAP + 192, U_MAS = U_HS + 128, U_FIN = U_MAS + 256;
    for (;;) {
        const int u = q_next(c, 0);
        if (u >= U_FIN) break;
        if (u < U_HP) hgrn_unit(c, a, false, u / 6, u % 6);
        else if (u < U_MAP) memattn_prompt_unit(c, a, 0, u - U_HP);
        else if (u < U_HS) { const int v = u - U_MAP; hgrn_unit(c, a, true, v / 6, v % 6); }
        else if (u < U_MAS) memattn_sample_unit(c, a, 0, u - U_HS);
        else { const int v = (u - U_MAS) * 8 + c.wave; memkv_finalize_row(a, v >> 10, v & 1023, c.lane); }
    }
}

__device__ __forceinline__ void p5_convact(Ctx& c, const Args& a, int layer) {
    const bf16* U = (const bf16*)(a.ws + WS_U); const bf16* UP = (const bf16*)(a.ws + WS_UP); bf16* ACT = (bf16*)(a.ws + WS_ACT);
    const float* cw = a.in[26] + (size_t)layer * 3 * DFF; const float* cb = a.in[27] + (size_t)layer * DFF; const float* cst = a.in[8] + (size_t)layer * 32 * 2 * DFF;
    constexpr int CPR = DFF / 8;
    const long total = (long)MVALID * CPR;
    for (long i = (long)c.vcu * 512 + c.tid; i < total; i += (long)c.G * 512) {
        const int row = (int)(i / CPR), c8 = (int)(i % CPR) * 8;
        int t, sb = 0; const bool smp = row >= MP; if (smp) { t = (row - MP) & 3; sb = (row - MP) >> 2; } else t = row & 4095;
        float u0[8], u1[8], u2[8], up[8];
        { const v4u x = *(const v4u*)(U + (size_t)row * DFF + c8); const unsigned xw[4] = {x.x, x.y, x.z, x.w};
#pragma unroll
          for (int j = 0; j < 8; ++j) u2[j] = bf2f((xw[j >> 1] >> (16 * (j & 1))) & 0xffffu); }
        { const v4u x = *(const v4u*)(UP + (size_t)row * DFF + c8); const unsigned xw[4] = {x.x, x.y, x.z, x.w};
#pragma unroll
          for (int j = 0; j < 8; ++j) up[j] = bf2f((xw[j >> 1] >> (16 * (j & 1))) & 0xffffu); }
        if (t >= 1) { const v4u x = *(const v4u*)(U + (size_t)(row - 1) * DFF + c8); const unsigned xw[4] = {x.x, x.y, x.z, x.w};
#pragma unroll
            for (int j = 0; j < 8; ++j) u1[j] = bf2f((xw[j >> 1] >> (16 * (j & 1))) & 0xffffu); }
        else {
#pragma unroll
            for (int j = 0; j < 8; ++j) u1[j] = smp ? cst[(size_t)(sb * 2 + 1) * DFF + c8 + j] : 0.f; }
        if (t >= 2) { const v4u x = *(const v4u*)(U + (size_t)(row - 2) * DFF + c8); const unsigned xw[4] = {x.x, x.y, x.z, x.w};
#pragma unroll
            for (int j = 0; j < 8; ++j) u0[j] = bf2f((xw[j >> 1] >> (16 * (j & 1))) & 0xffffu); }
        else {
#pragma unroll
            for (int j = 0; j < 8; ++j) u0[j] = smp ? cst[(size_t)(sb * 2 + t) * DFF + c8 + j] : 0.f; }
        float y[8];
#pragma unroll
        for (int j = 0; j < 8; ++j) { const float cv = cb[c8 + j] + cw[c8 + j] * u0[j] + cw[DFF + c8 + j] * u1[j] + cw[2 * DFF + c8 + j] * u2[j]; y[j] = cv * sigmoidf_(cv) * up[j]; }
        v4u o; o.x = pk2(y[0], y[1]); o.y = pk2(y[2], y[3]); o.z = pk2(y[4], y[5]); o.w = pk2(y[6], y[7]);
        *(v4u*)(ACT + (size_t)row * DFF + c8) = o;
    }
    for (long i = (long)c.vcu * 512 + c.tid; i < (long)(MT - MVALID) * CPR; i += (long)c.G * 512)
        *(v4u*)(ACT + (size_t)(MVALID + i / CPR) * DFF + (i % CPR) * 8) = (v4u){0u, 0u, 0u, 0u};
}


__device__ __forceinline__ void dsa_post_row(const Args& a, int row, int lane) {
    const bf16* z = (const bf16*)(a.ws + WS_Z) + (size_t)row * ZC1;
    const bool smp = row >= MP; const int b = smp ? (row - MP) >> 2 : row >> 12, t = smp ? (row - MP) & 3 : row & 4095;
    const float pos = (float)(smp ? PAST + t : t);
    float c128, s128, c64, s64;
    { const float f1 = exp2f(-(float)lane * (13.287712379549449f / 64.0f)); sincosf(pos * f1, &s128, &c128);
      const float f2 = exp2f(-(float)(lane & 31) * (13.287712379549449f / 32.0f)); sincosf(pos * f2, &s64, &c64); }
#pragma unroll 1
    for (int hd = 0; hd < 8; ++hd) {
        const float x1 = bf2f(z[hd * 128 + lane]), x2 = bf2f(z[hd * 128 + 64 + lane]);
        const float rs = rsqrtf(wave_sum(x1 * x1 + x2 * x2) * (1.0f / 128.0f) + EPS);
        const float* gn = hd < 6 ? a.in[17] : a.in[18];
        const float y1 = x1 * rs * gn[lane], y2 = x2 * rs * gn[64 + lane];
        const float o1 = y1 * c128 - y2 * s128, o2 = y2 * c128 + y1 * s128;
        if (hd < 6) {
            if (smp) { float* q = (float*)(a.ws + WS_SQ) + (size_t)(row - MP) * 768 + hd * 128; q[lane] = o1; q[64 + lane] = o2; }
            else { bf16* q = (bf16*)(a.ws + WS_QB) + ((size_t)(b * 6 + hd) * SEQ + t) * 128; q[lane] = (bf16)f2bf(o1); q[64 + lane] = (bf16)f2bf(o2); }
        } else {
            const int kvh = hd - 6;
            float* ko = smp ? a.out + O_KS + (size_t)(row - MP) * 256 + kvh * 128 : a.out + O_KP + (size_t)row * 256 + kvh * 128;
            ko[lane] = o1; ko[64 + lane] = o2;
            if (!smp) { bf16* kb = (bf16*)(a.ws + WS_KB) + ((size_t)(b * 2 + kvh) * SEQ + t) * 128; kb[lane] = (bf16)f2bf(o1); kb[64 + lane] = (bf16)f2bf(o2); }
        }
    }
    {
        const u64 vv = *(const u64*)(z + Z1_V + 4 * lane);
        const f32x4 v = {bf2f((unsigned)vv & 0xffffu), bf2f(((unsigned)vv) >> 16), bf2f((unsigned)(vv >> 32) & 0xffffu), bf2f((unsigned)(vv >> 48))};
        float* vo = smp ? a.out + O_VS + (size_t)(row - MP) * 256 : a.out + O_VP + (size_t)row * 256;
        *(f32x4*)(vo + 4 * lane) = v;
        if (!smp) { const int kvh = lane >> 5, d = (lane & 31) * 4; *(u64*)((bf16*)(a.ws + WS_VB) + ((size_t)(b * 2 + kvh) * SEQ + t) * 128 + d) = vv; }
    }
    {
        const int i = lane & 31;
#pragma unroll
        for (int p = 0; p < 4; ++p) { const int hd = 2 * p + (lane >> 5);
            const float x1 = bf2f(z[Z1_IQ + hd * 64 + i]), x2 = bf2f(z[Z1_IQ + hd * 64 + 32 + i]);
            const float o1 = x1 * c64 - x2 * s64, o2 = x2 * c64 + x1 * s64;
            if (smp) { float* q = (float*)(a.ws + WS_SIQ) + (size_t)(row - MP) * 512 + hd * 64; q[i] = o1; q[32 + i] = o2; }
            else { bf16* q = (bf16*)(a.ws + WS_IQB) + (size_t)row * 512 + hd * 64; q[i] = (bf16)f2bf(o1); q[32 + i] = (bf16)f2bf(o2); } }
        float x1 = 0.f, x2 = 0.f; if (lane < 32) { x1 = bf2f(z[Z1_IK + i]); x2 = bf2f(z[Z1_IK + 32 + i]); }
        const float rs = rsqrtf(wave_sum(x1 * x1 + x2 * x2) * (1.0f / 64.0f) + EPS);
        const float y1 = x1 * rs * a.in[19][i], y2 = x2 * rs * a.in[19][32 + i];
        const float o1 = y1 * c64 - y2 * s64, o2 = y2 * c64 + y1 * s64;
        if (lane < 32) {
            float* ko = smp ? a.out + O_IKS + (size_t)(row - MP) * 64 : a.out + O_IKP + (size_t)row * 64; ko[i] = o1; ko[32 + i] = o2;
            if (!smp) { bf16* kb = (bf16*)(a.ws + WS_IKB) + (size_t)row * 64; kb[i] = (bf16)f2bf(o1); kb[32 + i] = (bf16)f2bf(o2); } }
        if (lane < 8) { const float wv = bf2f(z[Z1_IW + lane]) * (0.35355339059327373f * 0.125f);
            if (smp) ((float*)(a.ws + WS_SIW))[(row - MP) * 8 + lane] = wv; else ((float*)(a.ws + WS_IW))[(size_t)row * 8 + lane] = wv; }
    }
}
__device__ __forceinline__ void p8_dsa_post(Ctx& c, const Args& a) {
    for (;;) { const int u = q_next(c, 1); if (u >= 384) break; if (u < 256) memattn_prompt_unit(c, a, 1, u); else memattn_sample_unit(c, a, 1, u - 256); }
    const int gw = c.vcu * NWAVES + c.wave, NGW = c.G * NWAVES;
    for (int row = gw; row < MVALID; row += NGW) dsa_post_row(a, row, c.lane);
}

__device__ __forceinline__ void idx_prompt_unit(Ctx& c, const Args& a, int b, int qb) {
    int tid = c.tid; asm volatile("" : "+v"(tid));
    const int lane = tid & 63, r32 = lane & 31, hh = lane >> 5, w = c.wave;
    const int q0 = b * SEQ + qb * 32;
    LAS bf16* IQL = (LAS bf16*)(c.lds);
    { const bf16* src = (const bf16*)(a.ws + WS_IQB) + (size_t)q0 * 512;
#pragma unroll
      for (int i = 0; i < 4; ++i) { const int row = tid >> 4, ch = (tid & 15) + 16 * i; *(LAS v4u*)(IQL + row * 520 + ch * 8) = *(const v4u*)(src + (size_t)row * 512 + ch * 8); } }
    __syncthreads();
    const bf16* IK = (const bf16*)(a.ws + WS_IKB) + (size_t)(b * SEQ) * 64;
    float* SC = (float*)(a.ws + WS_SC) + (size_t)(q0 + r32) * SEQ;
    float wv[8];
#pragma unroll
    for (int h = 0; h < 8; ++h) wv[h] = ((const float*)(a.ws + WS_IW))[(size_t)(q0 + r32) * 8 + h];
#pragma unroll 1
    for (int kt = w; kt <= qb; kt += 8) {
        bf16x8 ak[4];
#pragma unroll
        for (int ks = 0; ks < 4; ++ks) ak[ks] = *(const bf16x8*)(IK + (size_t)(kt * 32 + r32) * 64 + ks * 16 + 8 * hh);
        f32x16 sc = {};
        int qoff = r32 * 520 + 8 * hh; asm volatile("" : "+v"(qoff));
#pragma unroll
        for (int h = 0; h < 8; ++h) { f32x16 d = {};
#pragma unroll
            for (int ks = 0; ks < 4; ++ks) d = __builtin_amdgcn_mfma_f32_32x32x16_bf16(ak[ks], *(const LAS bf16x8*)(IQL + qoff + h * 64 + ks * 16), d, 0, 0, 0);
#pragma unroll
            for (int r = 0; r < 16; ++r) sc[r] = fmaf(wv[h], fmaxf(d[r], 0.f), sc[r]); }
#pragma unroll
        for (int g = 0; g < 4; ++g) *(f32x4*)(SC + kt * 32 + 8 * g + 4 * hh) = (f32x4){sc[4 * g], sc[4 * g + 1], sc[4 * g + 2], sc[4 * g + 3]};
    }
}
__device__ __forceinline__ void idx_sample_unit(Ctx& c, const Args& a, int sb, int pg) {
    LAS float* IKL = (LAS float*)(c.lds);
    LAS float* IQL = (LAS float*)(c.lds + 33280);
    LAS float* WL = (LAS float*)(c.lds + 33280 + 8192);
    int tid = c.tid; asm volatile("" : "+v"(tid));
    const int nk = pg < 64 ? 128 : 4;
    const float* src = pg < 64 ? a.in[4] + ((size_t)a.page_table[sb * 64 + pg] * 128) * 64 : a.out + O_IKS + (size_t)(sb * 4) * 64;
    for (int i = tid; i < nk * 16; i += 512) { const f32x4 v = *(const f32x4*)(src + (size_t)i * 4); const int k = i >> 4, d = (i & 15) * 4;
        IKL[k * 65 + d] = v.x; IKL[k * 65 + d + 1] = v.y; IKL[k * 65 + d + 2] = v.z; IKL[k * 65 + d + 3] = v.w; }
    for (int i = tid; i < 2048; i += 512) IQL[i] = ((const float*)(a.ws + WS_SIQ))[(size_t)(sb * 4) * 512 + i];
    if (tid < 32) WL[tid] = ((const float*)(a.ws + WS_SIW))[sb * 32 + tid];
    __syncthreads();
    const int k = tid & 127, t = tid >> 7;
    if (k < nk) {
        float acc = 0.f;
#pragma unroll 1
        for (int h = 0; h < 8; ++h) { float d = 0.f;
#pragma unroll 16
            for (int e = 0; e < 64; ++e) d = fmaf(IQL[(t * 8 + h) * 64 + e], IKL[k * 65 + e], d);
            acc = fmaf(WL[t * 8 + h], fmaxf(d, 0.f), acc); }
        ((float*)(a.ws + WS_SSC))[(size_t)(sb * 4 + t) * SSC_LD + pg * 128 + k] = acc;
    }
}
__device__ __forceinline__ void p9_indexer(Ctx& c, const Args& a) {
    constexpr int U_P = 512, U_S = U_P + 32 * 65;
    for (;;) { const int u = q_next(c, 2); if (u >= U_S) break;
        if (u < U_P) idx_prompt_unit(c, a, u & 3, 127 - (u >> 2));
        else { const int v = u - U_P; idx_sample_unit(c, a, v / 65, v % 65); } }
}

__device__ __forceinline__ unsigned fkey(float f) { const unsigned u = __builtin_bit_cast(unsigned, f + 0.0f); return (u & 0x80000000u) ? ~u : (u | 0x80000000u); }
__device__ __forceinline__ int wave_sum_i(int v) {
#pragma unroll
    for (int o = 1; o < 64; o <<= 1) v += __shfl_xor(v, o);
    return v;
}
__device__ __forceinline__ void topk_prompt_row(const Args& a, int row, int lane_) {
    int lane = lane_; asm volatile("" : "+v"(lane));
    const int t = row & 4095; const float* sc = (const float*)(a.ws + WS_SC) + (size_t)row * SEQ;
    u64* mk = (u64*)(a.ws + WS_MASK) + (size_t)row * 64;
    u64 myword = 0ull;
    if (t < 256) {
#pragma unroll 1
        for (int j = 0; j < 64; ++j) { const u64 m = __ballot(64 * j + lane <= t); if (lane == j) myword = m; }
        mk[lane] = myword; return; }
    unsigned key[64];
#pragma unroll
    for (int j = 0; j < 64; ++j) { unsigned k = 0u; if (64 * j <= t) { if (64 * j + lane <= t) k = fkey(sc[64 * j + lane]); } key[j] = k; }
    unsigned T = 0u;
#pragma unroll 1
    for (int bit = 31; bit >= 0; --bit) { const unsigned cand = T | (1u << bit); int cnt = 0;
#pragma unroll
        for (int j = 0; j < 64; ++j) cnt += key[j] >= cand ? 1 : 0;
        if (wave_sum_i(cnt) >= 256) T = cand; }
    int cgt = 0;
#pragma unroll
    for (int j = 0; j < 64; ++j) cgt += key[j] > T ? 1 : 0;
    const int need = 256 - wave_sum_i(cgt);
    int P = 0;
#pragma unroll 1
    for (int bit = 11; bit >= 0; --bit) { const int cand = P | (1 << bit); int cnt = 0;
#pragma unroll
        for (int j = 0; j < 64; ++j) cnt += (key[j] == T && 64 * j + lane < cand) ? 1 : 0;
        if (wave_sum_i(cnt) < need) P = cand; }
#pragma unroll
    for (int j = 0; j < 64; ++j) { const bool sel = key[j] > T || (key[j] == T && 64 * j + lane <= P); const u64 m = __ballot(sel); if (lane == j) myword = m; }
    mk[lane] = myword;
}
__device__ __forceinline__ int block_sum_i(LAS int* red, int v, int lane, int w) {
    v = wave_sum_i(v);
    __syncthreads();
    if (lane == 0) red[w] = v;
    __syncthreads();
    int s = 0;
#pragma unroll
    for (int i = 0; i < 8; ++i) s += red[i];
    return s;
}
__device__ __forceinline__ void topk_sample_unit(Ctx& c, const Args& a, int q) {
    int tid = c.tid; asm volatile("" : "+v"(tid));
    const int lane = tid & 63, w = c.wave;
    LAS int* red = (LAS int*)(c.lds);
    const int t = q & 3, n = PAST + t + 1; const float* sc = (const float*)(a.ws + WS_SSC) + (size_t)q * SSC_LD;
    int* out = (int*)(a.ws + WS_SIDX) + q * 256;
    unsigned key[17];
#pragma unroll
    for (int j = 0; j < 17; ++j) { const int s = tid + 512 * j; key[j] = s < n ? fkey(sc[s]) : 0u; }
    unsigned T = 0u;
#pragma unroll 1
    for (int bit = 31; bit >= 0; --bit) { const unsigned cand = T | (1u << bit); int cnt = 0;
#pragma unroll
        for (int j = 0; j < 17; ++j) cnt += key[j] >= cand ? 1 : 0;
        if (block_sum_i(red, cnt, lane, w) >= 256) T = cand; }
    int cgt = 0;
#pragma unroll
    for (int j = 0; j < 17; ++j) cgt += key[j] > T ? 1 : 0;
    const int need = 256 - block_sum_i(red, cgt, lane, w);
    int P = 0;
#pragma unroll 1
    for (int bit = 13; bit >= 0; --bit) { const int cand = P | (1 << bit); int cnt = 0;
#pragma unroll
        for (int j = 0; j < 17; ++j) cnt += (key[j] == T && tid + 512 * j < cand) ? 1 : 0;
        if (block_sum_i(red, cnt, lane, w) < need) P = cand; }
    int mine = 0;
#pragma unroll
    for (int j = 0; j < 17; ++j) mine += (key[j] > T || (key[j] == T && tid + 512 * j <= P)) ? 1 : 0;
    int inc = mine;
#pragma unroll
    for (int o = 1; o < 64; o <<= 1) { const int v = __shfl_up(inc, o); if (lane >= o) inc += v; }
    __syncthreads();
    if (lane == 63) red[w] = inc;
    __syncthreads();
    int base = inc - mine;
#pragma unroll
    for (int i = 0; i < 8; ++i) base += i < w ? red[i] : 0;
#pragma unroll
    for (int j = 0; j < 17; ++j) { if (key[j] > T || (key[j] == T && tid + 512 * j <= P)) { if (base < 256) out[base] = tid + 512 * j; ++base; } }
    __syncthreads();
}
__device__ __forceinline__ void p10_topk(Ctx& c, const Args& a) {
    const int gw = c.vcu * NWAVES + c.wave, NGW = c.G * NWAVES;
    for (int row = gw; row < MP; row += NGW) topk_prompt_row(a, row, c.lane);
    for (int q = c.G - 1 - c.vcu; q < MS; q += c.G) topk_sample_unit(c, a, q);
}

__device__ __forceinline__ void attn_sample_unit(Ctx& c, const Args& a, int sb, int t) {
    LAS bf16* KV = (LAS bf16*)(c.lds);
    LAS float* QL = (LAS float*)(c.lds + 69632);
    LAS float* SL = (LAS float*)(c.lds + 69632 + 3072);
    LAS float* OL = (LAS float*)(c.lds + 69632 + 6144);
    LAS int* IL = (LAS int*)(c.lds + 69632 + 12288);
    int tid = c.tid; asm volatile("" : "+v"(tid));
    const int lane = tid & 63, w = c.wave, q = sb * 4 + t;
    __syncthreads();
    if (tid < 256) IL[tid] = ((const int*)(a.ws + WS_SIDX))[q * 256 + tid];
    for (int i = tid; i < 768; i += 512) QL[i] = ((const float*)(a.ws + WS_SQ))[(size_t)q * 768 + i];
    __syncthreads();
    bf16* MIX = (bf16*)(a.ws + WS_MIX) + (size_t)(MP + q) * DM;
#pragma unroll 1
    for (int kvh = 0; kvh < 2; ++kvh) {
#pragma unroll 1
        for (int pass = 0; pass < 2; ++pass) {
            const float* pool = pass ? a.in[3] : a.in[2]; const float* nw = a.out + (pass ? O_VS : O_KS);
            for (int i = tid >> 5; i < 256; i += 16) { const int idx = IL[i]; const float* src;
                if (idx < PAST) src = pool + (((size_t)a.page_table[sb * 64 + (idx >> 7)] * 128 + (idx & 127)) * 2 + kvh) * 128;
                else src = nw + (size_t)(sb * 4 + (idx - PAST)) * 256 + kvh * 128;
                const f32x4 v = *(const f32x4*)(src + (tid & 31) * 4);
                *(LAS u64*)(KV + i * 136 + (tid & 31) * 4) = (u64)pk2(v.x, v.y) | ((u64)pk2(v.z, v.w) << 32); }
            __syncthreads();
            if (pass == 0) {
                const int i = tid >> 1, dh = (tid & 1) * 64; float s0 = 0.f, s1 = 0.f, s2 = 0.f;
#pragma unroll 8
                for (int d = 0; d < 64; ++d) { const float kx = bf2f(KV[i * 136 + dh + d]);
                    s0 = fmaf(QL[(3 * kvh + 0) * 128 + dh + d], kx, s0); s1 = fmaf(QL[(3 * kvh + 1) * 128 + dh + d], kx, s1); s2 = fmaf(QL[(3 * kvh + 2) * 128 + dh + d], kx, s2); }
                s0 += __shfl_xor(s0, 1); s1 += __shfl_xor(s1, 1); s2 += __shfl_xor(s2, 1);
                if ((tid & 1) == 0) { SL[i] = s0 * 0.08838834764831845f; SL[256 + i] = s1 * 0.08838834764831845f; SL[512 + i] = s2 * 0.08838834764831845f; }
                __syncthreads();
                if (w < 3) { float v[4], mx = -1e30f;
#pragma unroll
                    for (int j = 0; j < 4; ++j) { v[j] = SL[w * 256 + 64 * j + lane]; mx = fmaxf(mx, v[j]); }
#pragma unroll
                    for (int o = 1; o < 64; o <<= 1) mx = fmaxf(mx, __shfl_xor(mx, o));
                    float l = 0.f;
#pragma unroll
                    for (int j = 0; j < 4; ++j) { v[j] = __expf(v[j] - mx); l += v[j]; }
                    l = wave_sum(l); const float il = 1.0f / l;
#pragma unroll
                    for (int j = 0; j < 4; ++j) SL[w * 256 + 64 * j + lane] = v[j] * il; }
                __syncthreads();
            } else {
                const int d = tid & 127, part = tid >> 7; float o0 = 0.f, o1 = 0.f, o2 = 0.f;
#pragma unroll 8
                for (int i = part * 64; i < part * 64 + 64; ++i) { const float vx = bf2f(KV[i * 136 + d]); o0 = fmaf(SL[i], vx, o0); o1 = fmaf(SL[256 + i], vx, o1); o2 = fmaf(SL[512 + i], vx, o2); }
                OL[(part * 3 + 0) * 128 + d] = o0; OL[(part * 3 + 1) * 128 + d] = o1; OL[(part * 3 + 2) * 128 + d] = o2;
                __syncthreads();
                if (tid < 384) { const int hq = tid >> 7, dd = tid & 127; const float o = (OL[hq * 128 + dd] + OL[(3 + hq) * 128 + dd]) + (OL[(6 + hq) * 128 + dd] + OL[(9 + hq) * 128 + dd]);
                    MIX[(3 * kvh + hq) * 128 + dd] = (bf16)f2bf(o); }
                __syncthreads();
            }
        }
    }
}


namespace attn {
using bf16 = unsigned short;
typedef short bf16x8 __attribute__((ext_vector_type(8)));
typedef short s16x4 __attribute__((ext_vector_type(4)));
typedef float f32x16 __attribute__((ext_vector_type(16)));
typedef float f32x4 __attribute__((ext_vector_type(4)));
typedef unsigned u32x4 __attribute__((ext_vector_type(4)));
typedef unsigned u32x2 __attribute__((ext_vector_type(2)));
constexpr int D = 128, OS = 1024;
constexpr float THR = 8.f;
constexpr float SCALE = 0.08838834764831845f;
constexpr int NW = 8, QBLK = 32, KVBLK = 64, QB = NW * QBLK;
constexpr int SHM_V = KVBLK * D * 2, SHM_K = KVBLK * D * 2;
constexpr int LDS_BYTES = 2 * SHM_V + 2 * SHM_K + NW * 64 * 4;

#define KSWZ(row, colB) ((row) * 256 + ((colB) ^ (((row) & 7) << 4)))
#define SBAR() __builtin_amdgcn_sched_barrier(0)
__device__ __forceinline__ int v_st(int k, int c) { const int kk = (k & ~0xC) | ((k & 4) << 1) | ((k & 8) >> 1); return ((kk >> 3) * 4 + (c >> 5)) * 512 + ((kk & 7) * 32 + (c & 31)) * 2; }
__device__ __forceinline__ int v_rd_base(int lane) { return ((lane & 3) << 3) | (((lane >> 2) & 3) << 6) | (((lane >> 4) & 1) << 5) | (((lane >> 5) & 1) << 8); }
constexpr int v_rd_off(int d0, int ks, int half) { return d0 * 512 + ks * 4096 + half * 2048; }
__device__ __forceinline__ int crow(int r, int hi) { return (r & 3) + 8 * (r >> 2) + 4 * hi; }
__device__ __forceinline__ unsigned cvtpk(float lo, float hi) {
    unsigned r; asm volatile("v_cvt_pk_bf16_f32 %0, %1, %2" : "=v"(r) : "v"(lo), "v"(hi)); return r;
}
__device__ __forceinline__ bf16x8 pack8(f32x4 a, f32x4 b) {
    u32x4 w = {cvtpk(a[0], a[1]), cvtpk(a[2], a[3]), cvtpk(b[0], b[1]), cvtpk(b[2], b[3])};
    return *reinterpret_cast<bf16x8*>(&w);
}

__device__ __forceinline__ void partialSM(f32x16& p0, f32x16& p1, float& m_reg, float& mn, float& alpha) {
    float pmax = p0[0]; for (int r = 1; r < 16; ++r) pmax = fmaxf(pmax, p0[r]); for (int r = 0; r < 16; ++r) pmax = fmaxf(pmax, p1[r]);
    { auto rr = __builtin_amdgcn_permlane32_swap(__float_as_uint(pmax), __float_as_uint(pmax), false, false);
      pmax = fmaxf(__uint_as_float(rr[0]), __uint_as_float(rr[1])); }
    constexpr float C2 = 1.4426950408889634f * SCALE;
    if (__builtin_expect(__all((pmax - m_reg) * SCALE <= THR), 1)) { mn = m_reg; alpha = 1.f; }
    else { mn = fmaxf(m_reg, pmax); alpha = __builtin_amdgcn_exp2f((m_reg - mn) * C2); m_reg = mn; }
    const float mnL = -mn * C2;
    for (int r = 0; r < 16; ++r) p0[r] = fmaf(p0[r], C2, mnL); for (int r = 0; r < 16; ++r) p1[r] = fmaf(p1[r], C2, mnL);
    for (int r = 0; r < 16; ++r) p0[r] = __builtin_amdgcn_exp2f(p0[r]);
}
__device__ __forceinline__ void finishSM(f32x16& p0, f32x16& p1, float alpha, float& l_reg, bf16x8& pa0, bf16x8& pa1, bf16x8& pa2, bf16x8& pa3) {
    for (int r = 0; r < 16; ++r) p1[r] = __builtin_amdgcn_exp2f(p1[r]);
    float ps = 0; for (int r = 0; r < 16; ++r) ps += p0[r]; for (int r = 0; r < 16; ++r) ps += p1[r];
    { auto rr = __builtin_amdgcn_permlane32_swap(__float_as_uint(ps), __float_as_uint(ps), false, false);
      ps = __uint_as_float(rr[0]) + __uint_as_float(rr[1]); }
    l_reg = l_reg * alpha + ps;
#define PK4(P, B_, OUT) do { unsigned a0 = cvtpk(P[B_+0], P[B_+1]), a1 = cvtpk(P[B_+2], P[B_+3]);                          \
        unsigned b0 = cvtpk(P[B_+4], P[B_+5]), b1 = cvtpk(P[B_+6], P[B_+7]);                                             \
        auto r0 = __builtin_amdgcn_permlane32_swap(a0, b0, false, false); auto r1 = __builtin_amdgcn_permlane32_swap(a1, b1, false, false); \
        u32x4 w = {r0[0], r1[0], r0[1], r1[1]}; OUT = *reinterpret_cast<bf16x8*>(&w); } while (0)
    PK4(p0, 0, pa0); PK4(p0, 8, pa1); PK4(p1, 0, pa2); PK4(p1, 8, pa3);
#undef PK4
}
template <int KB, bool SK>
__device__ __forceinline__ void qkt(f32x16& p0, f32x16& p1, const char* K_lds, int r32, int hi, const bf16x8* qr, bool act) {
    if (SK && !act) { const float NEG = -__builtin_inff();
#pragma unroll
        for (int r = 0; r < 16; ++r) { p0[r] = NEG; p1[r] = NEG; } return; }
    p0 = f32x16{}; p1 = f32x16{};
    const char* kb[4];
#pragma unroll
    for (int dd = 0; dd < 4; ++dd) kb[dd] = K_lds + KB * SHM_K + KSWZ(r32, (dd * 16 + hi * 8) * 2);
#pragma unroll
    for (int d0 = 0; d0 < 8; ++d0) { const char* a = kb[d0 & 3] + (d0 >> 2) * 128;
        bf16x8 b0 = *reinterpret_cast<const bf16x8*>(a);
        bf16x8 b1 = *reinterpret_cast<const bf16x8*>(a + 32 * 256);
        p0 = __builtin_amdgcn_mfma_f32_32x32x16_bf16(b0, qr[d0], p0, 0, 0, 0);
        p1 = __builtin_amdgcn_mfma_f32_32x32x16_bf16(b1, qr[d0], p1, 0, 0, 0); }
}
template <int VB, bool SK>
__device__ __forceinline__ void pv_tile(f32x16* o, int vb0, bf16x8 pa0, bf16x8 pa1, bf16x8 pa2, bf16x8 pa3, bool act) {
    if (SK && !act) return;
#define TRRD(dst, off) asm volatile("ds_read_b64_tr_b16 %0, %1 offset:%2" : "=&v"(dst) : "v"(vb0), "i"(off) : "memory")
#define PV_D0(d0) do { s16x4 l0, l1, l2, l3, h0, h1, h2, h3; constexpr int b_ = VB * SHM_V + v_rd_off(d0, 0, 0);     \
        TRRD(l0, b_); TRRD(h0, b_ + 2048); TRRD(l1, b_ + 4096); TRRD(h1, b_ + 6144); TRRD(l2, b_ + 8192); TRRD(h2, b_ + 10240); TRRD(l3, b_ + 12288); TRRD(h3, b_ + 14336); \
        asm volatile("s_waitcnt lgkmcnt(0)" ::: "memory"); SBAR();                 \
        o[d0] = __builtin_amdgcn_mfma_f32_32x32x16_bf16(pa0, (bf16x8){l0[0], l0[1], l0[2], l0[3], h0[0], h0[1], h0[2], h0[3]}, o[d0], 0, 0, 0);   \
        o[d0] = __builtin_amdgcn_mfma_f32_32x32x16_bf16(pa1, (bf16x8){l1[0], l1[1], l1[2], l1[3], h1[0], h1[1], h1[2], h1[3]}, o[d0], 0, 0, 0);   \
        o[d0] = __builtin_amdgcn_mfma_f32_32x32x16_bf16(pa2, (bf16x8){l2[0], l2[1], l2[2], l2[3], h2[0], h2[1], h2[2], h2[3]}, o[d0], 0, 0, 0);   \
        o[d0] = __builtin_amdgcn_mfma_f32_32x32x16_bf16(pa3, (bf16x8){l3[0], l3[1], l3[2], l3[3], h3[0], h3[1], h3[2], h3[3]}, o[d0], 0, 0, 0); } while (0)
    PV_D0(0); PV_D0(1); PV_D0(2); PV_D0(3);
#undef PV_D0
#undef TRRD
}

__device__ __forceinline__ bf16x8 load8(const bf16* p) { return *reinterpret_cast<const bf16x8*>(p); }
__device__ __forceinline__ void mask_bits(f32x16& p0, f32x16& p1, u32x2 w, int hi) {
    const float NEG = -__builtin_inff();
    asm volatile("" : "+v"(w.x), "+v"(w.y));
    const unsigned lo = w.x >> (4 * hi), up = w.y >> (4 * hi);
#pragma unroll
    for (int r = 0; r < 16; ++r) { const int c = (r & 3) + 8 * (r >> 2);
        if (!((lo >> c) & 1u)) p0[r] = NEG;
        if (!((up >> c) & 1u)) p1[r] = NEG; }
}
struct BlockRef { const bf16* Q; const bf16* K; const bf16* V; bf16* O; const u32x2* M; int P0; };
struct Seam { bf16x8 qr[8]; bf16x8 st_v0, st_v1, st_k0, st_k1; };
#define ROW(p, k0, rr) ((p) + (size_t)((k0) + (rr)) * D + sc)
#define VMW() asm volatile("s_waitcnt vmcnt(0)" ::: "memory")
#define VMWN(n) asm volatile("s_waitcnt vmcnt(%0)" :: "i"(n) : "memory")
#define SLOAD_H(Kp, Vp, k0) do { S.st_v0 = load8(ROW(Vp, k0, sr)); S.st_v1 = load8(ROW(Vp, k0, 32 + sr));              \
                         S.st_k0 = load8(ROW(Kp, k0, sr)); S.st_k1 = load8(ROW(Kp, k0, 32 + sr)); } while (0)
#define SWRITE_HK(bf) do { *(bf16x8*)(K_lds + (bf) * SHM_K + kws) = S.st_k0; *(bf16x8*)(K_lds + (bf) * SHM_K + kws + 32 * 256) = S.st_k1; } while (0)
#define SWRITE_HV(bf) do { *(bf16x8*)(V_lds + (bf) * SHM_V + vst0) = S.st_v0; *(bf16x8*)(V_lds + (bf) * SHM_V + vst1) = S.st_v1; } while (0)
#define SWRITE_H(bf) do { SWRITE_HV(bf); SWRITE_HK(bf); } while (0)
__device__ __forceinline__ void sel_prime(const BlockRef& cur, char* lds, Seam& S) {
    int tid_ = threadIdx.x; asm volatile("" : "+v"(tid_));
    const int tid = tid_, wid = __builtin_amdgcn_readfirstlane(tid >> 6), lane = tid & 63, r32 = lane & 31, hi = lane >> 5;
    const int sr = tid >> 4, sc = (tid & 15) * 8, kws = KSWZ(sr, sc * 2); char* K_lds = lds + 2 * SHM_V;
    for (int d0 = 0; d0 < 8; ++d0) S.qr[d0] = load8(cur.Q + (size_t)(wid * QBLK + r32) * D + d0 * 16 + hi * 8);
    SLOAD_H(cur.K, cur.V, 0); VMW(); SWRITE_HK(0);
    __syncthreads();
}
__device__ __forceinline__ void sel_block(const BlockRef& cur, const BlockRef& nxt, char* lds, Seam& S) {
    int tid_ = threadIdx.x; asm volatile("" : "+v"(tid_));
    const int tid = tid_, wid = __builtin_amdgcn_readfirstlane(tid >> 6), lane = tid & 63, r32 = lane & 31, hi = lane >> 5;
    const int NT = (cur.P0 + QB) / KVBLK;
    char* V_lds = lds; char* K_lds = lds + 2 * SHM_V;
    float* ws = (float*)(lds + 2 * SHM_V + 2 * SHM_K) + wid * 64; float* li_l = ws, * al_l = ws + 32;
    float m_reg = -1e30f, l_reg = 0; f32x16 o[4] = {};
    const int sr = tid >> 4, sc = (tid & 15) * 8, vst0 = v_st(sr, sc), vst1 = v_st(32 + sr, sc), kws = KSWZ(sr, sc * 2);
    const int vb0 = (int)(uintptr_t)V_lds + v_rd_base(lane);
    const bf16* Kh = cur.K; const bf16* Vh = cur.V;
    const u32x2* Mrow = cur.M + (size_t)(wid * QBLK + r32) * 64;
#define RESC(a) do { if (__any((a) < 1.f)) { if (hi == 0) al_l[r32] = (a); asm volatile("s_waitcnt lgkmcnt(0)" ::: "memory");              \
                     for (int d_ = 0; d_ < 4; ++d_) for (int r = 0; r < 16; ++r) o[d_][r] *= al_l[crow(r, hi)]; } } while (0)
#define KBASE(t) ((t) * KVBLK)
    f32x16 pA0, pA1, pB0, pB1; float mnA, mnB, alA, alB; bf16x8 pa0, pa1, pa2, pa3; u32x2 mw;
    SWRITE_HV(0); SBAR();
    if (NT > 1) SLOAD_H(Kh, Vh, KBASE(1));
    mw = Mrow[0];
    SBAR(); qkt<0, false>(pA0, pA1, K_lds, r32, hi, S.qr, true);
    mask_bits(pA0, pA1, mw, hi); partialSM(pA0, pA1, m_reg, mnA, alA);
    if (NT > 1) { VMW(); SWRITE_H(1); }
    __syncthreads();
#define HALF_STEP(PX0, PX1, mnX, alX, PY0, PY1, alY, t, KB, VB, SB) do {                                                      \
        SBAR(); mw = Mrow[(t)]; qkt<KB, false>(PX0, PX1, K_lds, r32, hi, S.qr, true);                                          \
        finishSM(PY0, PY1, alY, l_reg, pa0, pa1, pa2, pa3); SBAR();                                                           \
        if ((t) + 1 < NT) { SLOAD_H(Kh, Vh, KBASE((t) + 1)); SBAR(); }                                                        \
        pv_tile<VB, false>(o, vb0, pa0, pa1, pa2, pa3, true); mask_bits(PX0, PX1, mw, hi); partialSM(PX0, PX1, m_reg, mnX, alX); \
        __syncthreads();                                                                                                      \
        if ((t) + 1 < NT) { VMW(); SWRITE_H(SB); }                                                                            \
        RESC(alX); __syncthreads(); } while (0)
    for (int t = 1; t + 1 < NT; t += 2) {
        HALF_STEP(pB0, pB1, mnB, alB, pA0, pA1, alA, t, 1, 0, 0);
        HALF_STEP(pA0, pA1, mnA, alA, pB0, pB1, alB, t + 1, 0, 1, 1);
    }
    const bool even = (NT & 1) == 0;
    if (even) { SBAR(); mw = Mrow[NT - 1]; qkt<1, false>(pB0, pB1, K_lds, r32, hi, S.qr, true); SBAR(); }
    SLOAD_H(nxt.K, nxt.V, 0); SBAR();
#pragma unroll
    for (int d0 = 0; d0 < 8; ++d0) S.qr[d0] = load8(nxt.Q + (size_t)(wid * QBLK + r32) * D + d0 * 16 + hi * 8);
    SBAR();
    finishSM(pA0, pA1, alA, l_reg, pa0, pa1, pa2, pa3); SBAR();
    pv_tile<0, false>(o, vb0, pa0, pa1, pa2, pa3, true);
    if (even) { mask_bits(pB0, pB1, mw, hi); partialSM(pB0, pB1, m_reg, mnB, alB); __syncthreads(); RESC(alB);
        finishSM(pB0, pB1, alB, l_reg, pa0, pa1, pa2, pa3); SBAR(); pv_tile<1, false>(o, vb0, pa0, pa1, pa2, pa3, true); }
    SBAR(); VMWN(8); SWRITE_HK(0); SBAR();
    if (hi == 0) li_l[r32] = l_reg; asm volatile("s_waitcnt lgkmcnt(0)" ::: "memory");
    float rli[16];
#pragma unroll
    for (int r = 0; r < 16; ++r) rli[r] = __builtin_amdgcn_rcpf(li_l[crow(r, hi)]);
    bf16* Ow = cur.O + (size_t)(wid * QBLK) * OS;
#pragma unroll
    for (int r = 0; r < 16; ++r) { const int orow = crow(r, hi);
#pragma unroll
        for (int d0 = 0; d0 < 4; ++d0) { const float v = o[d0][r] * rli[r];
            const float vn = __shfl_xor(v, 1);
            if ((r32 & 1) == 0) *(unsigned*)(Ow + (size_t)orow * OS + d0 * 32 + r32) = cvtpk(v, vn); } }
    __syncthreads();
#undef RESC
#undef KBASE
#undef HALF_STEP
}
#undef ROW
#undef VMW
#undef VMWN
#undef SLOAD_H
#undef SWRITE_HK
#undef SWRITE_HV
#undef SWRITE_H
#undef KSWZ
#undef SBAR
}


__device__ __forceinline__ attn::BlockRef attn_ref(const Args& a, int b, int h, int qb) {
    attn::BlockRef r; const int kvh = h / 3;
    r.Q = (const attn::bf16*)(a.ws + WS_QB) + ((size_t)(b * 6 + h) * SEQ + (size_t)qb * 256) * 128;
    r.K = (const attn::bf16*)(a.ws + WS_KB) + (size_t)(b * 2 + kvh) * SEQ * 128;
    r.V = (const attn::bf16*)(a.ws + WS_VB) + (size_t)(b * 2 + kvh) * SEQ * 128;
    r.O = (attn::bf16*)(a.ws + WS_MIX) + (size_t)(b * SEQ + qb * 256) * DM + h * 128;
    r.M = (const attn::u32x2*)(a.ws + WS_MASK) + (size_t)(b * SEQ + qb * 256) * 64;
    r.P0 = qb * 256; return r;
}
__device__ __forceinline__ void p11_attention(Ctx& c, const Args& a) {
    constexpr int NITEM = 192;
#pragma unroll 1
    for (int it = c.vcu; it < NITEM; it += c.G) {
        const int p = it & 7, bh = it >> 3, b = bh / 6, h = bh % 6;
        attn::Seam S;
        attn::BlockRef cur = attn_ref(a, b, h, p), nxt = attn_ref(a, b, h, 15 - p);
        __syncthreads();
        attn::sel_prime(cur, (char*)c.lds, S);
        attn::sel_block(cur, nxt, (char*)c.lds, S);
        attn::sel_block(nxt, nxt, (char*)c.lds, S);
    }
    const int spare = c.G - NITEM;
    if (spare > 0) { if (c.vcu >= NITEM) for (int u = c.vcu - NITEM; u < MS; u += spare) attn_sample_unit(c, a, u >> 2, u & 3); }
    else for (int u = c.vcu; u < MS; u += c.G) attn_sample_unit(c, a, u >> 2, u & 3);
}

constexpr int NPHASE = 16;
#ifndef ONLYPH
#define ONLYPH -1
#endif
#define PHON(x) (ONLYPH < 0 || ONLYPH == (x))
__global__ void __launch_bounds__(NWAVES * 64, 2) fwd_kernel(Args args) {
    extern __shared__ __attribute__((aligned(16))) unsigned char lds[];
    Ctx c;
    c.lds = (LAS unsigned char*)lds;
    c.MISC = (volatile LAS unsigned*)(c.lds + MISC_OFF);
    c.tid = threadIdx.x; c.lane = c.tid & 63; c.wave = __builtin_amdgcn_readfirstlane(c.tid >> 6);
    c.G = gridDim.x; { const int bx = blockIdx.x; c.vcu = (c.G % 8 == 0) ? (bx % 8) * (c.G / 8) + bx / 8 : bx; }
    unsigned char* ws = args.ws;
    c.ctl = (gu32*)(ws + WS_CTL);
    for (int u = c.tid; u < (LDS_BYTES - LDSCTL_OFF) / 4; u += NWAVES * 64) ((LAS unsigned*)(c.lds + LDSCTL_OFF))[u] = 0u;
    __syncthreads();
    const int lo = args.ph_lo, hi = args.ph_hi;
    XcdBarrier bar; bar.bar = (unsigned*)(c.ctl + CW_BAR); bar.x = 0; bar.st = nullptr;
    if (hi - lo > 1) bar = xcd_barrier_post((unsigned*)(c.ctl + CW_BAR), c.MISC + 8);
    float* const out = args.out;
#pragma unroll 1
    for (int ph = lo; ph < hi; ++ph) {
        const int layer = ph >= 7 ? 1 : 0;
        { int t_ = threadIdx.x; asm volatile("" : "+v"(t_)); c.tid = t_; c.lane = t_ & 63; c.wave = __builtin_amdgcn_readfirstlane(t_ >> 6); }
        if (ph == 0 && PHON(0)) p0_prologue(c, args);
        else if ((ph == 1 || ph == 7) && PHON(1)) {
            pg8::Gemm g{(const pg8::bf16_t*)(ws + WS_XB), (const pg8::bf16_t*)(ws + (ph == 1 ? WS_WIN0 : WS_WIN1)), MT, 0, 1024};
            pg8::SchedX S; if (ph == 1) S.init(MT, ZC0, c.G, (int)blockIdx.x, 16, MT / 256, 4, 13); else S.init(MT, ZC1, c.G, (int)blockIdx.x, 0, 0, 1, 0);
            pg8::EpiZ E{(pg8::bf16_t*)(ws + WS_Z), ph == 1 ? ZC0 : ZC1, ssptr(c, ph == 1 ? 0 : 2), ph == 1 ? 13 : 9, (float*)(ws + WS_MEMKV), MEMROW0};
            pg8::gemm_phase<pg8::EpiZ, pg8::SchedX, PG8_ALIGN, PG8_SP2>(c.lds + RING_OFF, g, S, E);
        }
        else if (ph == 2 && PHON(2)) p2_mixer0(c, args);
        else if ((ph == 3 || ph == 6 || ph == 12 || ph == 15) && PHON(3)) {
            const bool isout = (ph == 3 || ph == 12);
            pg8::Gemm g{(const pg8::bf16_t*)(ws + (isout ? WS_MIX : WS_ACT)), (const pg8::bf16_t*)(ws + (isout ? WS_WOUT + (size_t)layer * 1024 * 1024 * 2 : WS_WD + (size_t)layer * 1024 * DFF * 2)), MT, 1024, isout ? 1024 : DFF};
            pg8::SchedX S; S.init(MT, 1024, c.G, (int)blockIdx.x, 0, 0, 1, 0);
            pg8::EpiResid E;
            E.rp = ph == 3 ? args.in[0] : out + O_YP; E.rs = ph == 3 ? args.in[1] : out + O_YS; E.y = out + O_YP;
            E.xb = ph == 15 ? nullptr : (pg8::bf16_t*)(ws + WS_XB); E.ssout = ph == 15 ? nullptr : ssptr(c, ph == 3 ? 1 : (ph == 6 ? 2 : 3));
            pg8::gemm_phase<pg8::EpiResid, pg8::SchedX, PG8_ALIGN, PG8_SP2>(c.lds + RING_OFF, g, S, E);
        }
        else if ((ph == 4 || ph == 13) && PHON(4)) {
            pg8::Gemm g{(const pg8::bf16_t*)(ws + WS_XB), (const pg8::bf16_t*)(ws + WS_WGU + (size_t)layer * 5632 * 1024 * 2), MT, 5632, 1024};
            pg8::SchedX S; S.init(MT, 5632, c.G, (int)blockIdx.x, 0, 0, 1, 0);
            pg8::EpiGU E{(pg8::bf16_t*)(ws + WS_U), (pg8::bf16_t*)(ws + WS_UP), ssptr(c, layer ? 3 : 1), out + O_CVP + (size_t)layer * 4 * 2 * DFF, out + O_CVS + (size_t)layer * 32 * 2 * DFF};
            pg8::gemm_phase<pg8::EpiGU, pg8::SchedX, PG8_ALIGN, PG8_SP2>(c.lds + RING_OFF, g, S, E);
        }
        else if ((ph == 5 || ph == 14) && PHON(5)) p5_convact(c, args, layer);
        else if (ph == 8 && PHON(8)) p8_dsa_post(c, args);
        else if (ph == 9 && PHON(9)) p9_indexer(c, args);
        else if (ph == 10 && PHON(10)) p10_topk(c, args);
        else if (ph == 11 && PHON(11)) p11_attention(c, args);
        if (ph + 1 < hi) xcd_barrier(bar);
    }
}

#ifndef MK_ONE_LAUNCH
#define MK_ONE_LAUNCH 0
#endif
extern "C" void kernel_launch(void* const* d_in, const int* in_sizes, int n_in, void* d_out, int out_size, void* d_ws, size_t ws_size, hipStream_t stream) {
    static int grid = 0;
    if (grid == 0) {
        if (n_in != 29 || out_size != (int)O_END || ws_size < WS_END) { fprintf(stderr, "kernel_launch: unexpected problem (n_in %d, out %d, ws %zu)\n", n_in, out_size, ws_size); grid = -1; return; }
        int dev = 0, cus = 0;
        if (hipGetDevice(&dev) != hipSuccess || hipDeviceGetAttribute(&cus, hipDeviceAttributeMultiprocessorCount, dev) != hipSuccess) { grid = -1; return; }
        if (hipFuncSetAttribute((const void*)fwd_kernel, hipFuncAttributeMaxDynamicSharedMemorySize, LDS_BYTES) != hipSuccess) { fprintf(stderr, "kernel_launch: hipFuncSetAttribute failed\n"); grid = -1; return; }
        (void)hipGetLastError();
        grid = cus;
    }
    if (grid < 0) return;
    if (hipMemsetAsync((char*)d_ws + WS_CTL, 0, CTL_ZERO_BYTES, stream) != hipSuccess) { fprintf(stderr, "kernel_launch: memset failed\n"); return; }
    Args a{};
    for (int i = 0; i < 29; ++i) a.in[i] = (const float*)d_in[i];
    a.page_table = (const int*)d_in[9]; a.out = (float*)d_out; a.ws = (unsigned char*)d_ws;
#if MK_ONE_LAUNCH
    a.ph_lo = 0; a.ph_hi = NPHASE;
    hipLaunchKernelGGL(fwd_kernel, dim3(grid), dim3(NWAVES * 64), LDS_BYTES, stream, a);
#else
    for (int ph = 0; ph < NPHASE; ++ph) { a.ph_lo = ph; a.ph_hi = ph + 1; hipLaunchKernelGGL(fwd_kernel, dim3(grid), dim3(NWAVES * 64), LDS_BYTES, stream, a); }
#endif
}
```

```cpp
#include <hip/hip_runtime.h>
#include <cstdio>
#include <cstdint>

namespace pg8 {
#define PG8_LAS __attribute__((address_space(3)))
typedef unsigned short bf16_t;
typedef short bf16x8 __attribute__((ext_vector_type(8)));
typedef float f32x4 __attribute__((ext_vector_type(4)));
typedef unsigned u32x4 __attribute__((ext_vector_type(4)));
constexpr int BM = 256, BK = 64, HALF = 128, HTB = HALF * BK * 2  , STAGE_BYTES = 8 * HTB, NXCD = 8, WGM = 8;

__host__ __device__ __forceinline__ int lds_byte(int r, int c) { const int st = (r >> 4) * 2 + (c >> 5), rr = r & 15, cc = c & 31, ob = rr * 64 + cc * 2; return st * 1024 + (ob ^ (((ob >> 9) & 1) << 5)); }
__host__ __device__ __forceinline__ void stage_rc(int b, int& R, int& C) { const int st = b / 1024, sb = b % 1024, swz = sb ^ (((sb >> 9) & 1) << 5); R = (st >> 1) * 16 + swz / 64; C = (st & 1) * 32 + (swz % 64) / 2; }
__host__ __device__ __forceinline__ int perm32(int rho) { const int n = rho >> 4, i = rho & 15; return 8 * (i >> 2) + 4 * n + (i & 3); }

struct Unit { int pm, pn; };
struct Gemm { const bf16_t* A; const bf16_t* Bt; int M, N, K; };

struct StaticOrder {
    int nM, nN, nwg, G, c;
    __host__ __device__ void init(int M, int N, int G_, int c_) { nM = M / BM; nN = N / BM; nwg = nM * nN; G = G_; c = c_; }
    __host__ __device__ bool next(int i, Unit& u) const {
        const long L = (long)i * G + c; if (L >= nwg) return false;
        int wgid = (int)L; { const int q = nwg / NXCD, r = nwg % NXCD, xcd = wgid % NXCD, off = wgid / NXCD; wgid = (xcd < r ? xcd * (q + 1) : r * (q + 1) + (xcd - r) * q) + off; }
        const int nig = WGM * nN, gid = wgid / nig, fm = gid * WGM, gsz = (nM - fm) < WGM ? (nM - fm) : WGM;
        u.pm = fm + ((wgid % nig) % gsz); u.pn = (wgid % nig) / gsz; return true;
    }
    __device__ __forceinline__ void a_ready(const Unit&) const {}
    __device__ __forceinline__ void done(const Unit&) const {}
};


constexpr int MP = 16384, MS = 128, MVALID = MP + MS, MT = 16640, DM = 1024, DFF = 2816;
constexpr float RMS_EPS = 1e-6f;
__device__ __forceinline__ unsigned cvt_pk_bf16(float lo, float hi) { unsigned r; asm volatile("v_cvt_pk_bf16_f32 %0, %1, %2" : "=v"(r) : "v"(lo), "v"(hi)); return r; }

struct SchedX {
    StaticOrder so; int nextra, e_pm0, e_nm, e_pn0;
    __device__ void init(int M, int N, int G_, int c_, int nextra_, int e_pm0_, int e_nm_, int e_pn0_) { so.init(M, N, G_, c_); nextra = nextra_; e_pm0 = e_pm0_; e_nm = e_nm_; e_pn0 = e_pn0_; }
    __device__ bool next(int i, Unit& u) const {
        const long L = (long)i * so.G + so.c;
        if (L < so.nwg) return so.next(i, u);
        const int e = (int)(L - so.nwg); if (e >= nextra) return false;
        u.pm = e_pm0 + e % e_nm; u.pn = e_pn0 + e / e_nm; return true;
    }
    __device__ __forceinline__ void a_ready(const Unit&) const {}
    __device__ __forceinline__ void done(const Unit&) const {}
};

struct EpiZ {
    static constexpr bool PERM = true, AFTER_DRAIN = false;
    bf16_t* Z; int ldz; const float* ss; int nmain; float* memkv; int memrow0;
    __device__ __forceinline__ void operator()(const f32x4 (&acc)[2][2][4][2], const Unit& u, int wr, int wc, int fr, int fq) const {
        const int row0 = u.pm * BM + wr * 64 + fr;
        if (u.pn < nmain) {
            const int col0 = u.pn * BM + wc * 32 + 8 * fq;
#pragma unroll
            for (int ai = 0; ai < 2; ++ai)
#pragma unroll
                for (int m = 0; m < 4; ++m) { const int row = row0 + ai * HALF + m * 16; const float rs = rsqrtf(ss[row] * (1.0f / DM) + RMS_EPS);
#pragma unroll
                    for (int bj = 0; bj < 2; ++bj) { const f32x4 v0 = acc[ai][bj][m][0] * rs, v1 = acc[ai][bj][m][1] * rs;
                        u32x4 w; w.x = cvt_pk_bf16(v0[0], v0[1]); w.y = cvt_pk_bf16(v0[2], v0[3]); w.z = cvt_pk_bf16(v1[0], v1[1]); w.w = cvt_pk_bf16(v1[2], v1[3]);
                        *(u32x4*)(Z + (size_t)row * ldz + col0 + bj * HALF) = w; } }
        } else {
            const int col0 = (u.pn - nmain) * BM + wc * 32 + 8 * fq;
#pragma unroll
            for (int ai = 0; ai < 2; ++ai)
#pragma unroll
                for (int m = 0; m < 4; ++m) { const int row = row0 + ai * HALF + m * 16 - memrow0;
#pragma unroll
                    for (int bj = 0; bj < 2; ++bj) { float* p = memkv + (size_t)row * 1024 + col0 + bj * HALF; *(f32x4*)p = acc[ai][bj][m][0]; *(f32x4*)(p + 4) = acc[ai][bj][m][1]; } }
        }
    }
};

struct EpiResid {
    static constexpr bool PERM = true, AFTER_DRAIN = false;
    const float* rp; const float* rs; float* y; bf16_t* xb; float* ssout;
    __device__ __forceinline__ void operator()(const f32x4 (&acc)[2][2][4][2], const Unit& u, int wr, int wc, int fr, int fq) const {
        const int row0 = u.pm * BM + wr * 64 + fr, col0 = u.pn * BM + wc * 32 + 8 * fq;
#pragma unroll
        for (int ai = 0; ai < 2; ++ai)
#pragma unroll
            for (int m = 0; m < 4; ++m) { const int row = row0 + ai * HALF + m * 16; float part = 0.f;
                if (row < MVALID) { const float* src = row < MP ? rp + (size_t)row * DM : rs + (size_t)(row - MP) * DM;
#pragma unroll
                    for (int bj = 0; bj < 2; ++bj) { const int c = col0 + bj * HALF;
                        const f32x4 v0 = acc[ai][bj][m][0] + *(const f32x4*)(src + c), v1 = acc[ai][bj][m][1] + *(const f32x4*)(src + c + 4);
                        *(f32x4*)(y + (size_t)row * DM + c) = v0; *(f32x4*)(y + (size_t)row * DM + c + 4) = v1;
                        part += (v0[0] * v0[0] + v0[1] * v0[1]) + (v0[2] * v0[2] + v0[3] * v0[3]) + (v1[0] * v1[0] + v1[1] * v1[1]) + (v1[2] * v1[2] + v1[3] * v1[3]);
                        if (xb) { u32x4 w; w.x = cvt_pk_bf16(v0[0], v0[1]); w.y = cvt_pk_bf16(v0[2], v0[3]); w.z = cvt_pk_bf16(v1[0], v1[1]); w.w = cvt_pk_bf16(v1[2], v1[3]);
                            *(u32x4*)(xb + (size_t)row * DM + c) = w; } } }
                part += __shfl_xor(part, 16); part += __shfl_xor(part, 32);
                if (ssout && fq == 0 && row < MVALID) atomicAdd(ssout + row, part); }
    }
};

struct EpiGU {
    static constexpr bool PERM = true, AFTER_DRAIN = false;
    bf16_t* U; bf16_t* UP; const float* ss; float* cvp; float* cvs;
    __device__ __forceinline__ void operator()(const f32x4 (&acc)[2][2][4][2], const Unit& u, int wr, int wc, int fr, int fq) const {
        const int row0 = u.pm * BM + wr * 64 + fr, colg = u.pn * HALF + wc * 32 + 8 * fq;
#pragma unroll
        for (int ai = 0; ai < 2; ++ai)
#pragma unroll
            for (int m = 0; m < 4; ++m) { const int row = row0 + ai * HALF + m * 16; const float rs = rsqrtf(ss[row] * (1.0f / DM) + RMS_EPS);
                const f32x4 g0 = acc[ai][0][m][0] * rs, g1 = acc[ai][0][m][1] * rs, p0 = acc[ai][1][m][0] * rs, p1 = acc[ai][1][m][1] * rs;
                u32x4 w; w.x = cvt_pk_bf16(g0[0], g0[1]); w.y = cvt_pk_bf16(g0[2], g0[3]); w.z = cvt_pk_bf16(g1[0], g1[1]); w.w = cvt_pk_bf16(g1[2], g1[3]);
                *(u32x4*)(U + (size_t)row * DFF + colg) = w;
                w.x = cvt_pk_bf16(p0[0], p0[1]); w.y = cvt_pk_bf16(p0[2], p0[3]); w.z = cvt_pk_bf16(p1[0], p1[1]); w.w = cvt_pk_bf16(p1[2], p1[3]);
                *(u32x4*)(UP + (size_t)row * DFF + colg) = w;
                float* cv = nullptr;
                if (row < MP) { const int t = row & 4095; if (t >= 4094) cv = cvp + (size_t)((row >> 12) * 2 + (t - 4094)) * DFF; }
                else if (row < MVALID) { const int r2 = row - MP, t = r2 & 3; if (t >= 2) cv = cvs + (size_t)((r2 >> 2) * 2 + (t - 2)) * DFF; }
                if (cv) { *(f32x4*)(cv + colg) = g0; *(f32x4*)(cv + colg + 4) = g1; } }
    }
};

template <class Epi, class Sched, bool ALIGN_EPI = false, bool SP2 = false>
__device__ __forceinline__ void gemm_phase(PG8_LAS unsigned char* lds, const Gemm g, const Sched& S, const Epi& E) {
    int tid_ = threadIdx.x; asm volatile("" : "+v"(tid_));
    const int tid = tid_, wid = __builtin_amdgcn_readfirstlane(tid >> 6), lane = tid & 63, wr = wid >> 2, wc = wid & 3, fr = lane & 15, fq = lane >> 4;
    const int K = g.K, nt = K / BK;
    unsigned voffA[2], voffB[2];
#pragma unroll
    for (int i = 0; i < 2; ++i) { int R, C; stage_rc(tid * 16 + i * 8192, R, C); const int Rb = Epi::PERM ? ((R & ~31) + perm32(R & 31)) : R;
        voffA[i] = (unsigned)(R * K + C) * 2u; voffB[i] = (unsigned)(Rb * K + C) * 2u; }
    const size_t kstep = (size_t)(BK * 2);
    const size_t hstep = (size_t)HALF * K * 2;
    const size_t tstep = 2 * hstep;
    const unsigned ldsw = (unsigned)wid * 1024u;
    const int aoff = lds_byte(wr * 64 + fr, fq * 8), boff = lds_byte(wc * 32 + fr, fq * 8);
#define PG8_SA(b, h) (((b) * 2 + (h)) * HTB)
#define PG8_SB(b, h) ((4 + (b) * 2 + (h)) * HTB)
#define PG8_STAGE(bufoff, gbase, voff) do { _Pragma("unroll") for (int _i = 0; _i < 2; ++_i) \
        __builtin_amdgcn_global_load_lds((const unsigned*)((const char*)(gbase) + (voff)[_i]), (PG8_LAS unsigned*)(lds + (bufoff) + ldsw + _i * 8192), 16, 0, 0); } while (0)
#define PG8_LDA(dst, b, h) do { _Pragma("unroll") for (int m = 0; m < 4; ++m) _Pragma("unroll") for (int k = 0; k < 2; ++k) dst[m][k] = *(const PG8_LAS bf16x8*)(lds + PG8_SA(b, h) + aoff + m * 2048 + k * 1024); } while (0)
#define PG8_LDB(dst, b, h) do { _Pragma("unroll") for (int n = 0; n < 2; ++n) _Pragma("unroll") for (int k = 0; k < 2; ++k) dst[n][k] = *(const PG8_LAS bf16x8*)(lds + PG8_SB(b, h) + boff + n * 2048 + k * 1024); } while (0)
#define PG8_MMA(ai, bj, At, Bt) do { __builtin_amdgcn_s_setprio(1); _Pragma("unroll") for (int m = 0; m < 4; ++m) _Pragma("unroll") for (int n = 0; n < 2; ++n) _Pragma("unroll") for (int k = 0; k < 2; ++k) \
        acc[ai][bj][m][n] = __builtin_amdgcn_mfma_f32_16x16x32_bf16(Bt[n][k], At[m][k], acc[ai][bj][m][n], 0, 0, 0); __builtin_amdgcn_s_setprio(0); } while (0)
#define PG8_WAIT_V(n) asm volatile("s_waitcnt vmcnt(" #n ")" ::: "memory")
#define PG8_WAIT_L(n) asm volatile("s_waitcnt lgkmcnt(" #n ")" ::: "memory")
#define PG8_BAR __builtin_amdgcn_s_barrier()
#define PG8_SCHED __builtin_amdgcn_sched_barrier(0)
    Unit cur, nxt; int ui = 0;
    if (!S.next(0, cur)) return;
    f32x4 acc[2][2][4][2];
#pragma unroll
    for (int a = 0; a < 2; ++a)
#pragma unroll
        for (int b = 0; b < 2; ++b)
#pragma unroll
            for (int m = 0; m < 4; ++m)
#pragma unroll
                for (int n = 0; n < 2; ++n) acc[a][b][m][n] = (f32x4){0.f, 0.f, 0.f, 0.f};
    bf16x8 At[4][2], B0[2][2], B1[2][2];
    const char* cA = (const char*)g.A + (size_t)cur.pm * tstep; const char* cB = (const char*)g.Bt + (size_t)cur.pn * tstep;
    S.a_ready(cur);
    if constexpr (SP2) {
        PG8_STAGE(PG8_SB(0, 0), cB, voffB); PG8_STAGE(PG8_SB(0, 1), cB + hstep, voffB); PG8_STAGE(PG8_SA(0, 0), cA, voffA); PG8_STAGE(PG8_SA(0, 1), cA + hstep, voffA);
        if (wr == 1) PG8_BAR;
        PG8_WAIT_V(2); PG8_BAR;
        PG8_STAGE(PG8_SB(1, 0), cB + kstep, voffB); PG8_STAGE(PG8_SA(1, 0), cA + kstep, voffA); PG8_STAGE(PG8_SB(1, 1), cB + hstep + kstep, voffB);
        PG8_WAIT_V(6); PG8_BAR;
    } else {
        PG8_STAGE(PG8_SB(0, 0), cB, voffB); PG8_STAGE(PG8_SA(0, 0), cA, voffA); PG8_STAGE(PG8_SB(0, 1), cB + hstep, voffB); PG8_STAGE(PG8_SA(0, 1), cA + hstep, voffA);
        if (wr == 1) PG8_BAR;
        PG8_WAIT_V(4); PG8_BAR;
        PG8_STAGE(PG8_SB(1, 0), cB + kstep, voffB); PG8_STAGE(PG8_SA(1, 0), cA + kstep, voffA); PG8_STAGE(PG8_SB(1, 1), cB + hstep + kstep, voffB);
        PG8_WAIT_V(6); PG8_BAR;
    }
    for (;;) {
        const bool has_next = S.next(ui + 1, nxt);
        const char* nA = has_next ? (const char*)g.A + (size_t)nxt.pm * tstep : cA; const char* nB = has_next ? (const char*)g.Bt + (size_t)nxt.pn * tstep : cB;
        for (int t = 0; t < nt; t += 2) {
            const bool last = (t == nt - 2);
            const char* a1 = cA + (size_t)(t + 1) * kstep;
            const char* a2 = last ? nA : cA + (size_t)(t + 2) * kstep; const char* b2 = last ? nB : cB + (size_t)(t + 2) * kstep;
            const char* a3 = a2 + kstep; const char* b3 = b2 + kstep;
            if (last && has_next) S.a_ready(nxt);
            if constexpr (SP2) {
            PG8_LDB(B0, 0, 0); PG8_LDB(B1, 0, 1); PG8_SCHED; PG8_LDA(At, 0, 0); PG8_STAGE(PG8_SA(1, 1), a1 + hstep, voffA);
            PG8_WAIT_V(8); PG8_WAIT_L(0); PG8_BAR; PG8_MMA(0, 0, At, B0); PG8_MMA(0, 1, At, B1); PG8_BAR; PG8_SCHED;
            PG8_LDA(At, 0, 1); PG8_STAGE(PG8_SB(0, 0), b2, voffB); PG8_STAGE(PG8_SB(0, 1), b2 + hstep, voffB); PG8_STAGE(PG8_SA(0, 0), a2, voffA);
            PG8_WAIT_V(8); PG8_WAIT_L(0); PG8_BAR; PG8_MMA(1, 0, At, B0); PG8_MMA(1, 1, At, B1); PG8_BAR; PG8_SCHED;
            PG8_LDB(B0, 1, 0); PG8_LDB(B1, 1, 1); PG8_SCHED; PG8_LDA(At, 1, 0); PG8_STAGE(PG8_SA(0, 1), a2 + hstep, voffA);
            PG8_WAIT_V(8); PG8_WAIT_L(0); PG8_BAR; PG8_MMA(0, 0, At, B0); PG8_MMA(0, 1, At, B1); PG8_BAR; PG8_SCHED;
            PG8_LDA(At, 1, 1); PG8_STAGE(PG8_SB(1, 0), b3, voffB); PG8_STAGE(PG8_SB(1, 1), b3 + hstep, voffB); PG8_STAGE(PG8_SA(1, 0), a3, voffA);
            PG8_WAIT_V(8); PG8_WAIT_L(0); PG8_BAR; PG8_MMA(1, 0, At, B0); PG8_MMA(1, 1, At, B1); PG8_BAR; PG8_SCHED;
            } else {
            PG8_LDB(B0, 0, 0); PG8_SCHED; PG8_LDA(At, 0, 0); PG8_STAGE(PG8_SA(1, 1), a1 + hstep, voffA);
            PG8_WAIT_L(8); PG8_BAR; PG8_WAIT_L(0); PG8_MMA(0, 0, At, B0); PG8_BAR; PG8_SCHED;
            PG8_LDB(B1, 0, 1); PG8_STAGE(PG8_SB(0, 0), b2, voffB);
            PG8_BAR; PG8_WAIT_L(0); PG8_MMA(0, 1, At, B1); PG8_BAR;
            PG8_LDA(At, 0, 1); PG8_STAGE(PG8_SA(0, 0), a2, voffA);
            PG8_BAR; PG8_WAIT_L(0); PG8_MMA(1, 0, At, B0); PG8_BAR; PG8_SCHED;
            PG8_STAGE(PG8_SB(0, 1), b2 + hstep, voffB);
            PG8_WAIT_V(6); PG8_BAR; PG8_MMA(1, 1, At, B1); PG8_BAR;
            PG8_LDB(B0, 1, 0); PG8_SCHED; PG8_LDA(At, 1, 0); PG8_STAGE(PG8_SA(0, 1), a2 + hstep, voffA);
            PG8_WAIT_L(8); PG8_BAR; PG8_WAIT_L(0); PG8_MMA(0, 0, At, B0); PG8_BAR; PG8_SCHED;
            PG8_LDB(B1, 1, 1); PG8_STAGE(PG8_SB(1, 0), b3, voffB);
            PG8_BAR; PG8_WAIT_L(0); PG8_MMA(0, 1, At, B1); PG8_BAR;
            PG8_LDA(At, 1, 1); PG8_STAGE(PG8_SA(1, 0), a3, voffA);
            PG8_BAR; PG8_WAIT_L(0); PG8_MMA(1, 0, At, B0); PG8_BAR; PG8_SCHED;
            PG8_STAGE(PG8_SB(1, 1), b3 + hstep, voffB);
            PG8_WAIT_V(6); PG8_BAR; PG8_MMA(1, 1, At, B1); PG8_BAR;
            }
        }
        if constexpr (ALIGN_EPI) { if (wr == 0) PG8_BAR; }
        if constexpr (!Epi::AFTER_DRAIN) { E(acc, cur, wr, wc, fr, fq); S.done(cur); }
        if (!has_next) break;
#pragma unroll
        for (int a = 0; a < 2; ++a)
#pragma unroll
            for (int b = 0; b < 2; ++b)
#pragma unroll
                for (int m = 0; m < 4; ++m)
#pragma unroll
                    for (int n = 0; n < 2; ++n) acc[a][b][m][n] = (f32x4){0.f, 0.f, 0.f, 0.f};
        cur = nxt; cA = nA; cB = nB; ++ui;
        if constexpr (ALIGN_EPI) { if (wr == 1) PG8_BAR; }
    }
    PG8_WAIT_V(0);
    if constexpr (!ALIGN_EPI) { if (wr == 0) PG8_BAR; }
    PG8_BAR;
    if constexpr (Epi::AFTER_DRAIN) { E.fused(acc, cur, wr, wc, fr, fq, lds, wid, lane); S.done(cur); }
#undef PG8_SA
#undef PG8_SB
#undef PG8_STAGE
#undef PG8_LDA
#undef PG8_LDB
#undef PG8_MMA
#undef PG8_WAIT_V
#undef PG8_WAIT_L
#undef PG8_BAR
#undef PG8_SCHED
}
}


#ifndef PG8_SP2
#define PG8_SP2 true
#endif
#ifndef PG8_ALIGN
#define PG8_ALIGN true
#endif
constexpr int NWAVES = 8;
constexpr int MP = pg8::MP, MS = pg8::MS, MVALID = pg8::MVALID, MT = pg8::MT, DM = 1024, DFF = 2816;
constexpr int SEQ = 4096, NB = 4, NSB = 32, PAST = 8192, NPOOL = 2560;
constexpr int ZC0 = 3328, ZC1 = 2304;
constexpr int Z1_Q = 0, Z1_K = 768, Z1_V = 1024, Z1_IQ = 1280, Z1_IK = 1792, Z1_IW = 1856, Z1_MQ = 1920;
constexpr int NMEMROWS = 1024, MEMROW0 = MT;
constexpr float EPS = 1e-6f;
constexpr size_t MiB = 1u << 20;
constexpr size_t WS_CTL = 0, CTL_ZERO_BYTES = 2 * MiB;
constexpr size_t WS_WIN0 = 2 * MiB, WS_WIN1 = 11 * MiB, WS_WOUT = 16 * MiB, WS_WGU = 20 * MiB, WS_WD = 42 * MiB;
constexpr size_t WS_XB = 54 * MiB, WS_MEMKV = 89 * MiB, WS_MIX = 94 * MiB, WS_Z = 128 * MiB, WS_U = 234 * MiB, WS_UP = 324 * MiB, WS_ACT = 414 * MiB;
constexpr size_t WS_QB = 504 * MiB, WS_KB = 528 * MiB, WS_VB = 536 * MiB, WS_IQB = 544 * MiB, WS_IKB = 560 * MiB, WS_IW = 562 * MiB;
constexpr size_t WS_SQ = 563 * MiB, WS_SIQ = WS_SQ + 512 * 1024, WS_SIW = WS_SIQ + 384 * 1024, WS_SSC = 564 * MiB, WS_SIDX = 569 * MiB, WS_MASK = 570 * MiB, WS_SC = 578 * MiB, WS_END = 834 * MiB;
constexpr int SSC_LD = 8256;
constexpr int CW_TMO = 0, CW_BAR = 4096, CW_Q = 8192, CW_SS = 16384;
constexpr size_t O_YP = 0, O_YS = O_YP + (size_t)MP * DM, O_HP = O_YS + (size_t)MS * DM, O_HS = O_HP + 4 * 6 * 16384, O_KP = O_HS + 32 * 6 * 16384,
    O_VP = O_KP + (size_t)MP * 256, O_IKP = O_VP + (size_t)MP * 256, O_KS = O_IKP + (size_t)MP * 64, O_VS = O_KS + MS * 256, O_IKS = O_VS + MS * 256,
    O_MK = O_IKS + MS * 64, O_MV = O_MK + 2 * 1024 * 256, O_CVP = O_MV + 2 * 1024 * 256, O_CVS = O_CVP + 2 * 4 * 2 * DFF, O_END = O_CVS + 2 * 32 * 2 * DFF;
static_assert(O_END == 31412224, "output size");
constexpr int RING_OFF = 0, RING_BYTES = 131072;
constexpr int LDSCTL_OFF = RING_BYTES, MISC_OFF = LDSCTL_OFF + 320;
constexpr int LDS_BYTES = 147456;

#define GAS __attribute__((address_space(1)))
#define LAS __attribute__((address_space(3)))
typedef unsigned short bf16;
typedef unsigned v4u __attribute__((ext_vector_type(4)));
typedef float f32x4 __attribute__((ext_vector_type(4)));
typedef short bf16x8 __attribute__((ext_vector_type(8)));
typedef GAS unsigned gu32;
typedef GAS unsigned long long gu64;
#define RLX_AGENT __ATOMIC_RELAXED, __HIP_MEMORY_SCOPE_AGENT
#define LDS_WAIT() asm volatile("s_waitcnt lgkmcnt(0)" ::: "memory")
#define VM_WAIT() asm volatile("s_waitcnt vmcnt(0)" ::: "memory")
__device__ __forceinline__ unsigned long long rt() { return __builtin_amdgcn_s_memrealtime(); }
__device__ __forceinline__ unsigned f2bf(float f) { unsigned u = __builtin_bit_cast(unsigned, f); return (u + 0x7fffu + ((u >> 16) & 1u)) >> 16; }
__device__ __forceinline__ unsigned pk2(float lo, float hi) { return f2bf(lo) | (f2bf(hi) << 16); }

#define XB_TMO      128
#define XB_XCNT(j)  (256  + 64 * (j))
#define XB_XSUB(j)  (1280 + 64 * (j))
#define XB_XGEN(j)  (2304 + 64 * (j))
#define XB_TOP      3328
#define XB_TOPGEN   3392
#define XCD_BAR_WORDS 3456
#define XB_SPIN_CAP (1u << 18)

__device__ __forceinline__ unsigned xb_ld(unsigned* p)              { return __hip_atomic_load(p, __ATOMIC_RELAXED, __HIP_MEMORY_SCOPE_AGENT); }
__device__ __forceinline__ unsigned xb_add(unsigned* p, unsigned v) { return __hip_atomic_fetch_add(p, v, __ATOMIC_RELAXED, __HIP_MEMORY_SCOPE_AGENT); }
__device__ __forceinline__ unsigned xb_xcc_id() { return (unsigned)__builtin_amdgcn_s_getreg((3 << 11) | 20) & 0xFu; }
#define XB_SPIN(cond, bar) do { unsigned _sp = 0; while (cond) { __builtin_amdgcn_s_sleep(1); \
    if ((++_sp & 255u) == 0u) { if (xb_ld(&(bar)[XB_TMO])) break; if (_sp > XB_SPIN_CAP) { atomicAdd(&(bar)[XB_TMO], 1u); break; } } } } while (0)

struct XcdBarrier {
    unsigned* bar; unsigned x;
    volatile LAS unsigned* st;
};

__device__ __forceinline__ XcdBarrier xcd_barrier_post(unsigned* bar, volatile LAS unsigned* st) {
    XcdBarrier b; b.bar = bar; b.x = xb_xcc_id(); b.st = st;
    if (threadIdx.x == 0) (void)xb_add(&bar[XB_XCNT(b.x)], 1u);
    return b;
}
__device__ __forceinline__ void xcd_barrier_complete(unsigned* bar, unsigned x, unsigned& nloc, unsigned& nx) {
    const unsigned G = gridDim.x * gridDim.y * gridDim.z;
    unsigned sum, cnt, mine, sp = 0u;
    for (;;) {
        sum = 0u; cnt = 0u; mine = 0u;
#pragma unroll
        for (unsigned j = 0; j < 16; ++j) { const unsigned c = xb_ld(&bar[XB_XCNT(j)]); sum += c; cnt += (c > 0u) ? 1u : 0u; mine = (j == x) ? c : mine; }
        if (sum == G) break;
        __builtin_amdgcn_s_sleep(1);
        if ((++sp & 255u) == 0u) { if (xb_ld(&bar[XB_TMO])) break; if (sp > XB_SPIN_CAP) { atomicAdd(&bar[XB_TMO], 1u); break; } }
    }
    nloc = mine > 0u ? mine : 1u; nx = cnt > 0u ? cnt : 1u;
}

__device__ __forceinline__ void xcd_barrier(const XcdBarrier& b) {
    asm volatile("s_waitcnt vmcnt(0)" ::: "memory");
    __syncthreads();
    if (threadIdx.x == 0) {
        unsigned* bar = b.bar;
        __builtin_amdgcn_s_waitcnt(0);
        unsigned nloc = b.st[0], nx = b.st[1];
        if (nloc == 0u) { xcd_barrier_complete(bar, b.x, nloc, nx); b.st[0] = nloc; b.st[1] = nx; }
        const unsigned old = xb_add(&bar[XB_XSUB(b.x)], 1u);
        const unsigned gen = old / nloc;
        if (old + 1u == (gen + 1u) * nloc) {
            __builtin_amdgcn_fence(__ATOMIC_RELEASE, "agent");
            asm volatile("s_waitcnt vmcnt(0)" ::: "memory");
            const unsigned og = xb_add(&bar[XB_TOP], 1u);
            const unsigned tg = og / nx;
            if (og + 1u == (tg + 1u) * nx) xb_add(&bar[XB_TOPGEN], 1u);
            else XB_SPIN(xb_ld(&bar[XB_TOPGEN]) == tg, bar);
            __builtin_amdgcn_fence(__ATOMIC_ACQUIRE, "agent");
            xb_add(&bar[XB_XGEN(b.x)], 1u);
            asm volatile("s_waitcnt vmcnt(0)" ::: "memory");
        } else {
            XB_SPIN(xb_ld(&bar[XB_XGEN(b.x)]) == gen, bar);
            __builtin_amdgcn_fence(__ATOMIC_ACQUIRE, "agent");
            asm volatile("s_waitcnt vmcnt(0)" ::: "memory");
        }
    }
    __syncthreads();
}


struct Args { const float* in[29]; const int* page_table; float* out; unsigned char* ws; int ph_lo, ph_hi; };
struct Ctx { LAS unsigned char* lds; volatile LAS unsigned* MISC; gu32* ctl; int tid, lane, wave, vcu, G; };
typedef float f32x16 __attribute__((ext_vector_type(16)));
typedef unsigned long long u64;

__device__ __forceinline__ float bf2f(unsigned b) { return __builtin_bit_cast(float, b << 16); }
__device__ __forceinline__ float wave_sum(float v) {
#pragma unroll
    for (int o = 1; o < 64; o <<= 1) v += __shfl_xor(v, o);
    return v;
}
__device__ __forceinline__ int crow(int r, int hi) { return (r & 3) + 8 * (r >> 2) + 4 * hi; }
__device__ __forceinline__ float sigmoidf_(float x) { return 1.0f / (1.0f + __expf(-x)); }
__device__ __forceinline__ float* ssptr(const Ctx& c, int i) { return (float*)(c.ctl + CW_SS) + (size_t)i * MT; }

__device__ __forceinline__ int q_next(Ctx& c, int qi) {
    __syncthreads();
    if (c.tid == 0) c.MISC[16] = atomicAdd((unsigned*)(c.ctl + CW_Q + 64 * qi), 1u);
    __syncthreads();
    return (int)c.MISC[16];
}

template <int K>
__device__ __forceinline__ f32x16 mm32(const LAS bf16* A, int lda, const LAS bf16* Bt, int ldb, f32x16 acc, int lane) {
    const int r = lane & 31, h = lane >> 5;
#pragma unroll
    for (int ks = 0; ks < K; ks += 16) {
        const bf16x8 a = *(const LAS bf16x8*)(A + r * lda + ks + 8 * h);
        const bf16x8 b = *(const LAS bf16x8*)(Bt + r * ldb + ks + 8 * h);
        acc = __builtin_amdgcn_mfma_f32_32x32x16_bf16(a, b, acc, 0, 0, 0);
    }
    return acc;
}

__device__ __forceinline__ int map_row(int mapid, int n, int row_off) {
    if (mapid == 0) return n + row_off;
    if (mapid == 1) return n < 1864 ? n : n + 56;
    if (mapid == 2) return (n >> 7) * 256 + (n & 127);
    return (n >> 7) * 256 + 128 + (n & 127);
}
__device__ __forceinline__ void transpose_item(const float* W, int K, int N, const float* kscale, bf16* WT, int mapid, int row_off, LAS float* scr, int item, int lane) {
    const int nblk = (N + 31) / 32, kb = item / nblk, nb = item % nblk, k0 = 64 * kb, n0 = 32 * nb;
#pragma unroll 8
    for (int i = 0; i < 32; ++i) { const int kk = 2 * i + (lane >> 5), n = n0 + (lane & 31);
        float v = n < N ? W[(size_t)(k0 + kk) * N + n] : 0.f; if (kscale) v *= kscale[k0 + kk];
        scr[kk * 33 + (lane & 31)] = v; }
    LDS_WAIT(); asm volatile("" ::: "memory");
    const int cc = lane & 7;
#pragma unroll
    for (int j = 0; j < 4; ++j) { const int nl = (lane >> 3) + 8 * j, n = n0 + nl; const LAS float* s = scr + (8 * cc) * 33 + nl;
        v4u o; o.x = pk2(s[0 * 33], s[1 * 33]); o.y = pk2(s[2 * 33], s[3 * 33]); o.z = pk2(s[4 * 33], s[5 * 33]); o.w = pk2(s[6 * 33], s[7 * 33]);
        if (n < N) *(GAS v4u*)(WT + (size_t)map_row(mapid, n, row_off) * K + k0 + 8 * cc) = o; }
    LDS_WAIT(); asm volatile("" ::: "memory");
}
__device__ __forceinline__ void p0_prologue(Ctx& c, const Args& a) {
    LAS float* scr = (LAS float*)(c.lds + RING_OFF + c.wave * 16384);
    const int gw = c.vcu * NWAVES + c.wave, NGW = c.G * NWAVES, lane = c.lane;
    unsigned char* ws = a.ws;
    constexpr int I_INH = 16 * 104, I_MKV = 16 * 16, I_DSA = 16 * 67, I_OUT = 16 * 32, I_G = 16 * 88, I_D = 44 * 32;
    constexpr int NITEMS = I_INH + 2 * I_MKV + I_DSA + 2 * I_OUT + 4 * I_G + 2 * I_D;
    for (int it = gw; it < NITEMS; it += NGW) {
        int r = it;
        if (r < I_INH) { transpose_item(a.in[13], 1024, 3328, a.in[11], (bf16*)(ws + WS_WIN0), 0, 0, scr, r, lane); continue; } r -= I_INH;
        if (r < I_MKV) { transpose_item(a.in[20], 1024, 512, nullptr, (bf16*)(ws + WS_WIN0), 0, 3328, scr, r, lane); continue; } r -= I_MKV;
        if (r < I_MKV) { transpose_item(a.in[20] + 1024 * 512, 1024, 512, nullptr, (bf16*)(ws + WS_WIN0), 0, 3840, scr, r, lane); continue; } r -= I_MKV;
        if (r < I_DSA) { transpose_item(a.in[16], 1024, 2120, a.in[11] + 1024, (bf16*)(ws + WS_WIN1), 1, 0, scr, r, lane); continue; } r -= I_DSA;
        if (r < 2 * I_OUT) { const int l = r / I_OUT; transpose_item(a.in[23] + (size_t)l * 1024 * 1024, 1024, 1024, nullptr, (bf16*)(ws + WS_WOUT) + (size_t)l * 1024 * 1024, 0, 0, scr, r % I_OUT, lane); continue; } r -= 2 * I_OUT;
        if (r < 2 * I_G) { const int l = r / I_G; transpose_item(a.in[24] + (size_t)l * 1024 * DFF, 1024, DFF, a.in[12] + l * 1024, (bf16*)(ws + WS_WGU) + (size_t)l * 5632 * 1024, 2, 0, scr, r % I_G, lane); continue; } r -= 2 * I_G;
        if (r < 2 * I_G) { const int l = r / I_G; transpose_item(a.in[25] + (size_t)l * 1024 * DFF, 1024, DFF, a.in[12] + l * 1024, (bf16*)(ws + WS_WGU) + (size_t)l * 5632 * 1024, 3, 0, scr, r % I_G, lane); continue; } r -= 2 * I_G;
        { const int l = r / I_D; transpose_item(a.in[28] + (size_t)l * DFF * 1024, DFF, 1024, nullptr, (bf16*)(ws + WS_WD) + (size_t)l * 1024 * DFF, 0, 0, scr, r % I_D, lane); }
    }
    for (int rr = gw; rr < 184; rr += NGW) { const int row = rr < 56 ? 1864 + rr : 2176 + (rr - 56);
        GAS v4u* p = (GAS v4u*)((bf16*)(ws + WS_WIN1) + (size_t)row * 1024); p[lane] = (v4u){0u, 0u, 0u, 0u}; p[64 + lane] = (v4u){0u, 0u, 0u, 0u}; }
    float* ss0 = ssptr(c, 0);
    for (int m = gw; m < MT + NMEMROWS; m += NGW) {
        GAS u64* o8 = (GAS u64*)((bf16*)(ws + WS_XB) + (size_t)m * DM) + lane;
        if (m >= MVALID && m < MT) {
#pragma unroll
            for (int j = 0; j < 4; ++j) o8[64 * j] = 0ull;
            continue; }
        const float* src = m < MP ? a.in[0] + (size_t)m * DM : (m < MVALID ? a.in[1] + (size_t)(m - MP) * DM : a.in[10] + (size_t)(m - MT) * DM);
        const GAS f32x4* xr = (const GAS f32x4*)src + lane; f32x4 v[4]; float s = 0.f;
#pragma unroll
        for (int j = 0; j < 4; ++j) { v[j] = xr[64 * j]; s += (v[j].x * v[j].x + v[j].y * v[j].y) + (v[j].z * v[j].z + v[j].w * v[j].w); }
        s = wave_sum(s);
#pragma unroll
        for (int j = 0; j < 4; ++j) o8[64 * j] = (u64)pk2(v[j].x, v[j].y) | ((u64)pk2(v[j].z, v[j].w) << 32);
        if (m < MVALID && lane == 0) ss0[m] = s;
    }
}

__device__ __forceinline__ void memattn_unit(Ctx& c, const bf16* Zq  , int ldz, int nrows_valid, const float* Kp, const float* Vp, int kstride,
                                             bool normk, const float* kgain, const float* qgain, bf16* Out  ) {
    LAS bf16* KN = (LAS bf16*)(c.lds);
    LAS bf16* VTm = (LAS bf16*)(c.lds + 36864);
    LAS bf16* QN = (LAS bf16*)(c.lds + 70656) + c.wave * (32 * 72);
    LAS float* LI = (LAS float*)(c.lds + 107520) + c.wave * 32;
    int tid = c.tid; asm volatile("" : "+v"(tid));
    const int lane = tid & 63, w = c.wave;
    {
        const int m = tid >> 1, dh = (tid & 1) * 32;
        f32x4 kv[8]; float s = 0.f;
#pragma unroll
        for (int j = 0; j < 8; ++j) { kv[j] = *(const f32x4*)(Kp + (size_t)m * kstride + dh + 4 * j); s += (kv[j].x * kv[j].x + kv[j].y * kv[j].y) + (kv[j].z * kv[j].z + kv[j].w * kv[j].w); }
        s += __shfl_xor(s, 1);
        const float rs = normk ? rsqrtf(s * (1.0f / 64.0f) + EPS) : 1.0f;
#pragma unroll
        for (int j = 0; j < 8; j += 2) { f32x4 g0 = {1.f, 1.f, 1.f, 1.f}, g1 = g0;
            if (normk) { g0 = *(const f32x4*)(kgain + dh + 4 * j); g1 = *(const f32x4*)(kgain + dh + 4 * j + 4); }
            const f32x4 x0 = kv[j] * rs * g0, x1 = kv[j + 1] * rs * g1;
            v4u o; o.x = pk2(x0.x, x0.y); o.y = pk2(x0.z, x0.w); o.z = pk2(x1.x, x1.y); o.w = pk2(x1.z, x1.w);
            *(LAS v4u*)(KN + m * 72 + dh + 4 * j) = o; }
#pragma unroll
        for (int j = 0; j < 8; ++j) { const f32x4 vv = *(const f32x4*)(Vp + (size_t)m * kstride + dh + 4 * j);
            VTm[(dh + 4 * j + 0) * 264 + m] = (bf16)f2bf(vv.x); VTm[(dh + 4 * j + 1) * 264 + m] = (bf16)f2bf(vv.y);
            VTm[(dh + 4 * j + 2) * 264 + m] = (bf16)f2bf(vv.z); VTm[(dh + 4 * j + 3) * 264 + m] = (bf16)f2bf(vv.w); }
    }
    {
        const int row = lane >> 1, hf = lane & 1, grow = w * 32 + row;
        float x[32]; float s = 0.f;
        if (grow < nrows_valid) {
#pragma unroll
            for (int j = 0; j < 4; ++j) { const v4u q = *(const v4u*)(Zq + (size_t)grow * ldz + hf * 32 + 8 * j);
                x[8 * j + 0] = bf2f(q.x & 0xffffu); x[8 * j + 1] = bf2f(q.x >> 16); x[8 * j + 2] = bf2f(q.y & 0xffffu); x[8 * j + 3] = bf2f(q.y >> 16);
                x[8 * j + 4] = bf2f(q.z & 0xffffu); x[8 * j + 5] = bf2f(q.z >> 16); x[8 * j + 6] = bf2f(q.w & 0xffffu); x[8 * j + 7] = bf2f(q.w >> 16); }
        } else {
#pragma unroll
            for (int j = 0; j < 32; ++j) x[j] = 0.f;
        }
#pragma unroll
        for (int j = 0; j < 32; ++j) s += x[j] * x[j];
        s += __shfl_xor(s, 1);
        const float rs = rsqrtf(s * (1.0f / 64.0f) + EPS) * 0.125f;
#pragma unroll
        for (int j = 0; j < 32; j += 8) { v4u o;
            o.x = pk2(x[j] * rs * qgain[hf * 32 + j], x[j + 1] * rs * qgain[hf * 32 + j + 1]); o.y = pk2(x[j + 2] * rs * qgain[hf * 32 + j + 2], x[j + 3] * rs * qgain[hf * 32 + j + 3]);
            o.z = pk2(x[j + 4] * rs * qgain[hf * 32 + j + 4], x[j + 5] * rs * qgain[hf * 32 + j + 5]); o.w = pk2(x[j + 6] * rs * qgain[hf * 32 + j + 6], x[j + 7] * rs * qgain[hf * 32 + j + 7]);
            *(LAS v4u*)(QN + row * 72 + hf * 32 + j) = o; }
    }
    __syncthreads();
    if (w * 32 < nrows_valid) {
        const int r32 = lane & 31, hh = lane >> 5;
        f32x16 s[8];
#pragma unroll
        for (int mt = 0; mt < 8; ++mt) { f32x16 z = {}; s[mt] = mm32<64>(KN + mt * 32 * 72, 72, QN, 72, z, lane); }
        float mx = -1e30f;
#pragma unroll
        for (int mt = 0; mt < 8; ++mt)
#pragma unroll
            for (int r = 0; r < 16; ++r) mx = fmaxf(mx, s[mt][r]);
        mx = fmaxf(mx, __shfl_xor(mx, 32));
        float l = 0.f;
#pragma unroll
        for (int mt = 0; mt < 8; ++mt)
#pragma unroll
            for (int r = 0; r < 16; ++r) { const float p = __expf(s[mt][r] - mx); s[mt][r] = p; l += p; }
        l += __shfl_xor(l, 32);
        if (hh == 0) LI[r32] = l;
        f32x16 o[2] = {};
#pragma unroll
        for (int mt = 0; mt < 8; ++mt)
#pragma unroll
            for (int sx = 0; sx < 2; ++sx) {
                v4u pa; pa.x = pk2(s[mt][8 * sx + 0], s[mt][8 * sx + 1]); pa.y = pk2(s[mt][8 * sx + 2], s[mt][8 * sx + 3]);
                pa.z = pk2(s[mt][8 * sx + 4], s[mt][8 * sx + 5]); pa.w = pk2(s[mt][8 * sx + 6], s[mt][8 * sx + 7]);
                const bf16x8 af = __builtin_bit_cast(bf16x8, pa);
#pragma unroll
                for (int dt = 0; dt < 2; ++dt) { const LAS bf16* vp = VTm + (dt * 32 + r32) * 264 + mt * 32 + 16 * sx + 4 * hh;
                    const u64 lo = *(const LAS u64*)vp, hi = *(const LAS u64*)(vp + 8);
                    v4u bw; bw.x = (unsigned)lo; bw.y = (unsigned)(lo >> 32); bw.z = (unsigned)hi; bw.w = (unsigned)(hi >> 32);
                    o[dt] = __builtin_amdgcn_mfma_f32_32x32x16_bf16(af, __builtin_bit_cast(bf16x8, bw), o[dt], 0, 0, 0); }
            }
        LDS_WAIT();
#pragma unroll
        for (int r = 0; r < 16; ++r) { const int qr = crow(r, hh), grow = w * 32 + qr; const float il = 1.0f / LI[qr];
            if (grow < nrows_valid) {
#pragma unroll
                for (int dt = 0; dt < 2; ++dt) Out[(size_t)grow * DM + dt * 32 + r32] = (bf16)f2bf(o[dt][r] * il); } }
    }
}

__device__ __forceinline__ void hgrn_unit(Ctx& c, const Args& a, bool sample, int b, int h) {
    LAS unsigned char* L = c.lds;
    LAS float* LF = (LAS float*)(L + 0);
    LAS float* BL = (LAS float*)(L + 16384);
    LAS float* DVv = (LAS float*)(L + 16896);
    LAS bf16* QD = (LAS bf16*)(L + 17408);
    LAS bf16* KD = (LAS bf16*)(L + 26112);
    LAS bf16* KET = (LAS bf16*)(L + 34816);
    LAS bf16* VT = (LAS bf16*)(L + 45056);
    LAS bf16* SCB = (LAS bf16*)(L + 55296);
    LAS bf16* STt = (LAS bf16*)(L + 57856);
    int tid = c.tid; asm volatile("" : "+v"(tid));
    const int lane = tid & 63, w = c.wave, r32 = lane & 31, hh = lane >> 5;
    const int te = tid >> 4, k8 = (tid & 15) * 8;
    const bf16* Z = (const bf16*)(a.ws + WS_Z);
    bf16* MIX = (bf16*)(a.ws + WS_MIX);
    const int nch = sample ? 1 : 128, nvalid = sample ? 4 : 32;
    const int kt = w >> 1, vt0 = 2 * (w & 1);
    f32x16 S0 = {}, S1 = {};
    if (sample) { const float* sp = a.in[7] + (size_t)(b * 6 + h) * 16384;
#pragma unroll
        for (int r = 0; r < 16; ++r) { const int k = 32 * kt + crow(r, hh); S0[r] = sp[k * 128 + 32 * vt0 + r32]; S1[r] = sp[k * 128 + 32 * (vt0 + 1) + r32]; } }
    float lbv[8], onv[8];
#pragma unroll
    for (int j = 0; j < 8; ++j) { const float l0 = a.in[14][h * 128 + k8 + j], l1 = a.in[14][768 + h * 128 + k8 + j]; lbv[j] = 1.0f / (1.0f + __expf(l1 - l0)); onv[j] = a.in[15][k8 + j]; }
    __syncthreads();
#define HG_WRITE_ST() do { _Pragma("unroll") for (int g = 0; g < 4; ++g) { const int k0 = 32 * kt + 8 * g + 4 * hh; \
        *(LAS u64*)(STt + (32 * vt0 + r32) * 136 + k0) = (u64)pk2(S0[4 * g], S0[4 * g + 1]) | ((u64)pk2(S0[4 * g + 2], S0[4 * g + 3]) << 32); \
        *(LAS u64*)(STt + (32 * (vt0 + 1) + r32) * 136 + k0) = (u64)pk2(S1[4 * g], S1[4 * g + 1]) | ((u64)pk2(S1[4 * g + 2], S1[4 * g + 3]) << 32); } } while (0)
    HG_WRITE_ST();
    for (int ch = 0; ch < nch; ++ch) {
        const int row0 = sample ? MP + 4 * b : b * SEQ + 32 * ch, row = row0 + te;
        const bool valid = te < nvalid;
        float qs[8], kk[8]; v4u gz = {0u, 0u, 0u, 0u};
        {
            v4u zq = {0u, 0u, 0u, 0u}, zf = zq, zi = zq;
            if (valid) { const bf16* zr = Z + (size_t)row * ZC0 + h * 128 + k8;
                zq = *(const v4u*)zr; zf = *(const v4u*)(zr + 768); zi = *(const v4u*)(zr + 1536); gz = *(const v4u*)(zr + 2304); }
            const unsigned qw[4] = {zq.x, zq.y, zq.z, zq.w}, fw[4] = {zf.x, zf.y, zf.z, zf.w}, iw[4] = {zi.x, zi.y, zi.z, zi.w};
            float lf[8];
#pragma unroll
            for (int j = 0; j < 8; ++j) { const float q = bf2f((qw[j >> 1] >> (16 * (j & 1))) & 0xffffu), fp = bf2f((fw[j >> 1] >> (16 * (j & 1))) & 0xffffu);
                const float sg = sigmoidf_(fp), f = lbv[j] + (1.0f - lbv[j]) * sg;
                qs[j] = valid ? q * sigmoidf_(q) : 0.f; kk[j] = valid ? (1.0f - f) : 0.f; lf[j] = valid ? __logf(f) : 0.f;
                VT[(k8 + j) * 40 + te] = (bf16)((iw[j >> 1] >> (16 * (j & 1))) & 0xffffu); }
            *(LAS f32x4*)(LF + te * 128 + k8) = (f32x4){lf[0], lf[1], lf[2], lf[3]}; *(LAS f32x4*)(LF + te * 128 + k8 + 4) = (f32x4){lf[4], lf[5], lf[6], lf[7]};
        }
        __syncthreads();
        if (tid < 128) { float bsum = 0.f;
#pragma unroll
            for (int t = 0; t < 32; ++t) { bsum += LF[t * 128 + tid]; LF[t * 128 + tid] = bsum; }
            BL[tid] = bsum; }
        __syncthreads();
        {
            const f32x4 b0 = *(const LAS f32x4*)(LF + te * 128 + k8), b1 = *(const LAS f32x4*)(LF + te * 128 + k8 + 4);
            const f32x4 l0 = *(const LAS f32x4*)(BL + k8), l1 = *(const LAS f32x4*)(BL + k8 + 4);
            const float bb[8] = {b0.x, b0.y, b0.z, b0.w, b1.x, b1.y, b1.z, b1.w}, bl[8] = {l0.x, l0.y, l0.z, l0.w, l1.x, l1.y, l1.z, l1.w};
            float qd[8], kd[8];
#pragma unroll
            for (int j = 0; j < 8; ++j) { qd[j] = qs[j] * __expf(bb[j]); kd[j] = kk[j] * __expf(-bb[j]); KET[(k8 + j) * 40 + te] = (bf16)f2bf(kk[j] * __expf(bl[j] - bb[j])); }
            v4u o; o.x = pk2(qd[0], qd[1]); o.y = pk2(qd[2], qd[3]); o.z = pk2(qd[4], qd[5]); o.w = pk2(qd[6], qd[7]); *(LAS v4u*)(QD + te * 136 + k8) = o;
            o.x = pk2(kd[0], kd[1]); o.y = pk2(kd[2], kd[3]); o.z = pk2(kd[4], kd[5]); o.w = pk2(kd[6], kd[7]); *(LAS v4u*)(KD + te * 136 + k8) = o;
            if (te == 0) {
#pragma unroll
                for (int j = 0; j < 8; ++j) DVv[k8 + j] = __expf(bl[j]); }
        }
        __syncthreads();
        f32x16 oacc = {};
        if (w == 0) { f32x16 z = {}; const f32x16 sc = mm32<128>(QD, 136, KD, 136, z, lane);
#pragma unroll
            for (int r = 0; r < 16; ++r) { const int t = crow(r, hh); SCB[t * 40 + r32] = (bf16)f2bf(r32 <= t ? sc[r] : 0.f); } }
        if (w < 4) oacc = mm32<128>(QD, 136, STt + (w * 32) * 136, 136, oacc, lane);
        __syncthreads();
        if (w < 4) { oacc = mm32<32>(SCB, 40, VT + (w * 32) * 40, 40, oacc, lane);
#pragma unroll
            for (int r = 0; r < 16; ++r) LF[crow(r, hh) * 128 + w * 32 + r32] = oacc[r]; }
        {
#pragma unroll
            for (int r = 0; r < 16; ++r) { const float d = DVv[32 * kt + crow(r, hh)]; S0[r] *= d; S1[r] *= d; }
            S0 = mm32<32>(KET + (kt * 32) * 40, 40, VT + (vt0 * 32) * 40, 40, S0, lane);
            S1 = mm32<32>(KET + (kt * 32) * 40, 40, VT + ((vt0 + 1) * 32) * 40, 40, S1, lane);
        }
        __syncthreads();
        HG_WRITE_ST();
        {
            const f32x4 o0 = *(const LAS f32x4*)(LF + te * 128 + k8), o1 = *(const LAS f32x4*)(LF + te * 128 + k8 + 4);
            float ov[8] = {o0.x, o0.y, o0.z, o0.w, o1.x, o1.y, o1.z, o1.w}; float s = 0.f;
#pragma unroll
            for (int j = 0; j < 8; ++j) s += ov[j] * ov[j];
            s += __shfl_xor(s, 1); s += __shfl_xor(s, 2); s += __shfl_xor(s, 4); s += __shfl_xor(s, 8);
            const float rs = rsqrtf(s * (1.0f / 128.0f) + EPS);
            const unsigned gw_[4] = {gz.x, gz.y, gz.z, gz.w}; float y[8];
#pragma unroll
            for (int j = 0; j < 8; ++j) { const float g = bf2f((gw_[j >> 1] >> (16 * (j & 1))) & 0xffffu); y[j] = ov[j] * rs * onv[j] * (g * sigmoidf_(g)); }
            if (valid) { v4u o; o.x = pk2(y[0], y[1]); o.y = pk2(y[2], y[3]); o.z = pk2(y[4], y[5]); o.w = pk2(y[6], y[7]); *(v4u*)(MIX + (size_t)row * DM + h * 128 + k8) = o; }
        }
        __syncthreads();
    }
#undef HG_WRITE_ST
    float* so = a.out + (sample ? O_HS : O_HP) + (size_t)(b * 6 + h) * 16384;
#pragma unroll
    for (int r = 0; r < 16; ++r) { const int k = 32 * kt + crow(r, hh); so[k * 128 + 32 * vt0 + r32] = S0[r]; so[k * 128 + 32 * (vt0 + 1) + r32] = S1[r]; }
}

__device__ __forceinline__ void memkv_finalize_row(const Args& a, int layer, int row, int lane) {
    const float* src = (const float*)(a.ws + WS_MEMKV) + (size_t)row * 1024 + layer * 512;
    const int hd = lane >> 4, d4 = (lane & 15) * 4;
    const f32x4 k = *(const f32x4*)(src + hd * 64 + d4), v = *(const f32x4*)(src + 256 + hd * 64 + d4);
    float s = (k.x * k.x + k.y * k.y) + (k.z * k.z + k.w * k.w);
    s += __shfl_xor(s, 1); s += __shfl_xor(s, 2); s += __shfl_xor(s, 4); s += __shfl_xor(s, 8);
    const float rs = rsqrtf(s * (1.0f / 64.0f) + EPS); const f32x4 g = *(const f32x4*)(a.in[22] + layer * 64 + d4);
    *(f32x4*)(a.out + O_MK + ((size_t)layer * 1024 + row) * 256 + hd * 64 + d4) = k * rs * g;
    *(f32x4*)(a.out + O_MV + ((size_t)layer * 1024 + row) * 256 + hd * 64 + d4) = v;
}

__device__ __forceinline__ void memattn_prompt_unit(Ctx& c, const Args& a, int layer, int u) {
    const int blk = u & 15, hd = (u >> 4) & 3, b = u >> 6;
    const bf16* Z = (const bf16*)(a.ws + WS_Z); const int ldz = layer ? ZC1 : ZC0, qc = layer ? Z1_MQ : 3072;
    const float* kv = (const float*)(a.ws + WS_MEMKV) + (size_t)(b * 256) * 1024 + layer * 512 + hd * 64;
    const int row0 = b * SEQ + blk * 256;
    memattn_unit(c, Z + (size_t)row0 * ldz + qc + hd * 64, ldz, 256, kv, kv + 256, 1024, true, a.in[22] + layer * 64, a.in[21] + layer * 64,
                 (bf16*)(a.ws + WS_MIX) + (size_t)row0 * DM + 768 + hd * 64);
}
__device__ __forceinline__ void memattn_sample_unit(Ctx& c, const Args& a, int layer, int u) {
    const int hd = u & 3, sb = u >> 2;
    const bf16* Z = (const bf16*)(a.ws + WS_Z); const int ldz = layer ? ZC1 : ZC0, qc = layer ? Z1_MQ : 3072;
    const size_t off = ((size_t)(layer * 32 + sb) * 256) * 256 + hd * 64;
    const int row0 = MP + sb * 4;
    memattn_unit(c, Z + (size_t)row0 * ldz + qc + hd * 64, ldz, 4, a.in[5] + off, a.in[6] + off, 256, false, nullptr, a.in[21] + layer * 64,
                 (bf16*)(a.ws + WS_MIX) + (size_t)row0 * DM + 768 + hd * 64);
}

__device__ __forceinline__ void p2_mixer0(Ctx& c, const Args& a) {
    constexpr int U_HP = 24, U_MAP = U_HP + 256, U_HS = U_MAP + 192, U_MAS = U_HS + 128, U_FIN = U_MAS + 256;
    for (;;) {
        const int u = q_next(c, 0);
        if (u >= U_FIN) break;
        if (u < U_HP) hgrn_unit(c, a, false, u / 6, u % 6);
        else if (u < U_MAP) memattn_prompt_unit(c, a, 0, u - U_HP);
        else if (u < U_HS) { const int v = u - U_MAP; hgrn_unit(c, a, true, v / 6, v % 6); }
        else if (u < U_MAS) memattn_sample_unit(c, a, 0, u - U_HS);
        else { const int v = (u - U_MAS) * 8 + c.wave; memkv_finalize_row(a, v >> 10, v & 1023, c.lane); }
    }
}

__device__ __forceinline__ void p5_convact(Ctx& c, const Args& a, int layer) {
    const bf16* U = (const bf16*)(a.ws + WS_U); const bf16* UP = (const bf16*)(a.ws + WS_UP); bf16* ACT = (bf16*)(a.ws + WS_ACT);
    const float* cw = a.in[26] + (size_t)layer * 3 * DFF; const float* cb = a.in[27] + (size_t)layer * DFF; const float* cst = a.in[8] + (size_t)layer * 32 * 2 * DFF;
    constexpr int CPR = DFF / 8;
    const long total = (long)MVALID * CPR;
    for (long i = (long)c.vcu * 512 + c.tid; i < total; i += (long)c.G * 512) {
        const int row = (int)(i / CPR), c8 = (int)(i % CPR) * 8;
        int t, sb = 0; const bool smp = row >= MP; if (smp) { t = (row - MP) & 3; sb = (row - MP) >> 2; } else t = row & 4095;
        float u0[8], u1[8], u2[8], up[8];
        { const v4u x = *(const v4u*)(U + (size_t)row * DFF + c8); const unsigned xw[4] = {x.x, x.y, x.z, x.w};
#pragma unroll
          for (int j = 0; j < 8; ++j) u2[j] = bf2f((xw[j >> 1] >> (16 * (j & 1))) & 0xffffu); }
        { const v4u x = *(const v4u*)(UP + (size_t)row * DFF + c8); const unsigned xw[4] = {x.x, x.y, x.z, x.w};
#pragma unroll
          for (int j = 0; j < 8; ++j) up[j] = bf2f((xw[j >> 1] >> (16 * (j & 1))) & 0xffffu); }
        if (t >= 1) { const v4u x = *(const v4u*)(U + (size_t)(row - 1) * DFF + c8); const unsigned xw[4] = {x.x, x.y, x.z, x.w};
#pragma unroll
            for (int j = 0; j < 8; ++j) u1[j] = bf2f((xw[j >> 1] >> (16 * (j & 1))) & 0xffffu); }
        else {
#pragma unroll
            for (int j = 0; j < 8; ++j) u1[j] = smp ? cst[(size_t)(sb * 2 + 1) * DFF + c8 + j] : 0.f; }
        if (t >= 2) { const v4u x = *(const v4u*)(U + (size_t)(row - 2) * DFF + c8); const unsigned xw[4] = {x.x, x.y, x.z, x.w};
#pragma unroll
            for (int j = 0; j < 8; ++j) u0[j] = bf2f((xw[j >> 1] >> (16 * (j & 1))) & 0xffffu); }
        else {
#pragma unroll
            for (int j = 0; j < 8; ++j) u0[j] = smp ? cst[(size_t)(sb * 2 + t) * DFF + c8 + j] : 0.f; }
        float y[8];
#pragma unroll
        for (int j = 0; j < 8; ++j) { const float cv = cb[c8 + j] + cw[c8 + j] * u0[j] + cw[DFF + c8 + j] * u1[j] + cw[2 * DFF + c8 + j] * u2[j]; y[j] = cv * sigmoidf_(cv) * up[j]; }
        v4u o; o.x = pk2(y[0], y[1]); o.y = pk2(y[2], y[3]); o.z = pk2(y[4], y[5]); o.w = pk2(y[6], y[7]);
        *(v4u*)(ACT + (size_t)row * DFF + c8) = o;
    }
    for (long i = (long)c.vcu * 512 + c.tid; i < (long)(MT - MVALID) * CPR; i += (long)c.G * 512)
        *(v4u*)(ACT + (size_t)(MVALID + i / CPR) * DFF + (i % CPR) * 8) = (v4u){0u, 0u, 0u, 0u};
}


__device__ __forceinline__ void dsa_post_row(const Args& a, int row, int lane) {
    const bf16* z = (const bf16*)(a.ws + WS_Z) + (size_t)row * ZC1;
    const bool smp = row >= MP; const int b = smp ? (row - MP) >> 2 : row >> 12, t = smp ? (row - MP) & 3 : row & 4095;
    const float pos = (float)(smp ? PAST + t : t);
    float c128, s128, c64, s64;
    { const float f1 = exp2f(-(float)lane * (13.287712379549449f / 64.0f)); sincosf(pos * f1, &s128, &c128);
      const float f2 = exp2f(-(float)(lane & 31) * (13.287712379549449f / 32.0f)); sincosf(pos * f2, &s64, &c64); }
#pragma unroll 1
    for (int hd = 0; hd < 8; ++hd) {
        const float x1 = bf2f(z[hd * 128 + lane]), x2 = bf2f(z[hd * 128 + 64 + lane]);
        const float rs = rsqrtf(wave_sum(x1 * x1 + x2 * x2) * (1.0f / 128.0f) + EPS);
        const float* gn = hd < 6 ? a.in[17] : a.in[18];
        const float y1 = x1 * rs * gn[lane], y2 = x2 * rs * gn[64 + lane];
        const float o1 = y1 * c128 - y2 * s128, o2 = y2 * c128 + y1 * s128;
        if (hd < 6) {
            if (smp) { float* q = (float*)(a.ws + WS_SQ) + (size_t)(row - MP) * 768 + hd * 128; q[lane] = o1; q[64 + lane] = o2; }
            else { bf16* q = (bf16*)(a.ws + WS_QB) + ((size_t)(b * 6 + hd) * SEQ + t) * 128; q[lane] = (bf16)f2bf(o1); q[64 + lane] = (bf16)f2bf(o2); }
        } else {
            const int kvh = hd - 6;
            float* ko = smp ? a.out + O_KS + (size_t)(row - MP) * 256 + kvh * 128 : a.out + O_KP + (size_t)row * 256 + kvh * 128;
            ko[lane] = o1; ko[64 + lane] = o2;
            if (!smp) { bf16* kb = (bf16*)(a.ws + WS_KB) + ((size_t)(b * 2 + kvh) * SEQ + t) * 128; kb[lane] = (bf16)f2bf(o1); kb[64 + lane] = (bf16)f2bf(o2); }
        }
    }
    {
        const u64 vv = *(const u64*)(z + Z1_V + 4 * lane);
        const f32x4 v = {bf2f((unsigned)vv & 0xffffu), bf2f(((unsigned)vv) >> 16), bf2f((unsigned)(vv >> 32) & 0xffffu), bf2f((unsigned)(vv >> 48))};
        float* vo = smp ? a.out + O_VS + (size_t)(row - MP) * 256 : a.out + O_VP + (size_t)row * 256;
        *(f32x4*)(vo + 4 * lane) = v;
        if (!smp) { const int kvh = lane >> 5, d = (lane & 31) * 4; *(u64*)((bf16*)(a.ws + WS_VB) + ((size_t)(b * 2 + kvh) * SEQ + t) * 128 + d) = vv; }
    }
    {
        const int i = lane & 31;
#pragma unroll
        for (int p = 0; p < 4; ++p) { const int hd = 2 * p + (lane >> 5);
            const float x1 = bf2f(z[Z1_IQ + hd * 64 + i]), x2 = bf2f(z[Z1_IQ + hd * 64 + 32 + i]);
            const float o1 = x1 * c64 - x2 * s64, o2 = x2 * c64 + x1 * s64;
            if (smp) { float* q = (float*)(a.ws + WS_SIQ) + (size_t)(row - MP) * 512 + hd * 64; q[i] = o1; q[32 + i] = o2; }
            else { bf16* q = (bf16*)(a.ws + WS_IQB) + (size_t)row * 512 + hd * 64; q[i] = (bf16)f2bf(o1); q[32 + i] = (bf16)f2bf(o2); } }
        float x1 = 0.f, x2 = 0.f; if (lane < 32) { x1 = bf2f(z[Z1_IK + i]); x2 = bf2f(z[Z1_IK + 32 + i]); }
        const float rs = rsqrtf(wave_sum(x1 * x1 + x2 * x2) * (1.0f / 64.0f) + EPS);
        const float y1 = x1 * rs * a.in[19][i], y2 = x2 * rs * a.in[19][32 + i];
        const float o1 = y1 * c64 - y2 * s64, o2 = y2 * c64 + y1 * s64;
        if (lane < 32) {
            float* ko = smp ? a.out + O_IKS + (size_t)(row - MP) * 64 : a.out + O_IKP + (size_t)row * 64; ko[i] = o1; ko[32 + i] = o2;
            if (!smp) { bf16* kb = (bf16*)(a.ws + WS_IKB) + (size_t)row * 64; kb[i] = (bf16)f2bf(o1); kb[32 + i] = (bf16)f2bf(o2); } }
        if (lane < 8) { const float wv = bf2f(z[Z1_IW + lane]) * (0.35355339059327373f * 0.125f);
            if (smp) ((float*)(a.ws + WS_SIW))[(row - MP) * 8 + lane] = wv; else ((float*)(a.ws + WS_IW))[(size_t)row * 8 + lane] = wv; }
    }
}
__device__ __forceinline__ void p8_dsa_post(Ctx& c, const Args& a) {
    for (;;) { const int u = q_next(c, 1); if (u >= 384) break; if (u < 256) memattn_prompt_unit(c, a, 1, u); else memattn_sample_unit(c, a, 1, u - 256); }
    const int gw = c.vcu * NWAVES + c.wave, NGW = c.G * NWAVES;
    for (int row = gw; row < MVALID; row += NGW) dsa_post_row(a, row, c.lane);
}

__device__ __forceinline__ void idx_prompt_unit(Ctx& c, const Args& a, int b, int qb) {
    int tid = c.tid; asm volatile("" : "+v"(tid));
    const int lane = tid & 63, r32 = lane & 31, hh = lane >> 5, w = c.wave;
    const int q0 = b * SEQ + qb * 32;
    LAS bf16* IQL = (LAS bf16*)(c.lds);
    { const bf16* src = (const bf16*)(a.ws + WS_IQB) + (size_t)q0 * 512;
#pragma unroll
      for (int i = 0; i < 4; ++i) { const int row = tid >> 4, ch = (tid & 15) + 16 * i; *(LAS v4u*)(IQL + row * 520 + ch * 8) = *(const v4u*)(src + (size_t)row * 512 + ch * 8); } }
    __syncthreads();
    const bf16* IK = (const bf16*)(a.ws + WS_IKB) + (size_t)(b * SEQ) * 64;
    float* SC = (float*)(a.ws + WS_SC) + (size_t)(q0 + r32) * SEQ;
    float wv[8];
#pragma unroll
    for (int h = 0; h < 8; ++h) wv[h] = ((const float*)(a.ws + WS_IW))[(size_t)(q0 + r32) * 8 + h];
#pragma unroll 1
    for (int kt = w; kt <= qb; kt += 8) {
        bf16x8 ak[4];
#pragma unroll
        for (int ks = 0; ks < 4; ++ks) ak[ks] = *(const bf16x8*)(IK + (size_t)(kt * 32 + r32) * 64 + ks * 16 + 8 * hh);
        f32x16 sc = {};
        int qoff = r32 * 520 + 8 * hh; asm volatile("" : "+v"(qoff));
#pragma unroll
        for (int h = 0; h < 8; ++h) { f32x16 d = {};
#pragma unroll
            for (int ks = 0; ks < 4; ++ks) d = __builtin_amdgcn_mfma_f32_32x32x16_bf16(ak[ks], *(const LAS bf16x8*)(IQL + qoff + h * 64 + ks * 16), d, 0, 0, 0);
#pragma unroll
            for (int r = 0; r < 16; ++r) sc[r] = fmaf(wv[h], fmaxf(d[r], 0.f), sc[r]); }
#pragma unroll
        for (int g = 0; g < 4; ++g) *(f32x4*)(SC + kt * 32 + 8 * g + 4 * hh) = (f32x4){sc[4 * g], sc[4 * g + 1], sc[4 * g + 2], sc[4 * g + 3]};
    }
}
__device__ __forceinline__ void idx_sample_unit(Ctx& c, const Args& a, int sb, int pg) {
    LAS float* IKL = (LAS float*)(c.lds);
    LAS float* IQL = (LAS float*)(c.lds + 33280);
    LAS float* WL = (LAS float*)(c.lds + 33280 + 8192);
    int tid = c.tid; asm volatile("" : "+v"(tid));
    const int nk = pg < 64 ? 128 : 4;
    const float* src = pg < 64 ? a.in[4] + ((size_t)a.page_table[sb * 64 + pg] * 128) * 64 : a.out + O_IKS + (size_t)(sb * 4) * 64;
    for (int i = tid; i < nk * 16; i += 512) { const f32x4 v = *(const f32x4*)(src + (size_t)i * 4); const int k = i >> 4, d = (i & 15) * 4;
        IKL[k * 65 + d] = v.x; IKL[k * 65 + d + 1] = v.y; IKL[k * 65 + d + 2] = v.z; IKL[k * 65 + d + 3] = v.w; }
    for (int i = tid; i < 2048; i += 512) IQL[i] = ((const float*)(a.ws + WS_SIQ))[(size_t)(sb * 4) * 512 + i];
    if (tid < 32) WL[tid] = ((const float*)(a.ws + WS_SIW))[sb * 32 + tid];
    __syncthreads();
    const int k = tid & 127, t = tid >> 7;
    if (k < nk) {
        float acc = 0.f;
#pragma unroll 1
        for (int h = 0; h < 8; ++h) { float d = 0.f;
#pragma unroll 16
            for (int e = 0; e < 64; ++e) d = fmaf(IQL[(t * 8 + h) * 64 + e], IKL[k * 65 + e], d);
            acc = fmaf(WL[t * 8 + h], fmaxf(d, 0.f), acc); }
        ((float*)(a.ws + WS_SSC))[(size_t)(sb * 4 + t) * SSC_LD + pg * 128 + k] = acc;
    }
}
__device__ __forceinline__ void p9_indexer(Ctx& c, const Args& a) {
    constexpr int U_P = 512, U_S = U_P + 32 * 65;
    for (;;) { const int u = q_next(c, 2); if (u >= U_S) break;
        if (u < U_P) idx_prompt_unit(c, a, u & 3, 127 - (u >> 2));
        else { const int v = u - U_P; idx_sample_unit(c, a, v / 65, v % 65); } }
}

__device__ __forceinline__ unsigned fkey(float f) { const unsigned u = __builtin_bit_cast(unsigned, f + 0.0f); return (u & 0x80000000u) ? ~u : (u | 0x80000000u); }
__device__ __forceinline__ int wave_sum_i(int v) {
#pragma unroll
    for (int o = 1; o < 64; o <<= 1) v += __shfl_xor(v, o);
    return v;
}
__device__ __forceinline__ void topk_prompt_row(const Args& a, int row, int lane_) {
    int lane = lane_; asm volatile("" : "+v"(lane));
    const int t = row & 4095; const float* sc = (const float*)(a.ws + WS_SC) + (size_t)row * SEQ;
    u64* mk = (u64*)(a.ws + WS_MASK) + (size_t)row * 64;
    u64 myword = 0ull;
    if (t < 256) {
#pragma unroll 1
        for (int j = 0; j < 64; ++j) { const u64 m = __ballot(64 * j + lane <= t); if (lane == j) myword = m; }
        mk[lane] = myword; return; }
    unsigned key[64];
#pragma unroll
    for (int j = 0; j < 64; ++j) { unsigned k = 0u; if (64 * j <= t) { if (64 * j + lane <= t) k = fkey(sc[64 * j + lane]); } key[j] = k; }
    unsigned T = 0u;
#pragma unroll 1
    for (int bit = 31; bit >= 0; --bit) { const unsigned cand = T | (1u << bit); int cnt = 0;
#pragma unroll
        for (int j = 0; j < 64; ++j) cnt += key[j] >= cand ? 1 : 0;
        if (wave_sum_i(cnt) >= 256) T = cand; }
    int cgt = 0;
#pragma unroll
    for (int j = 0; j < 64; ++j) cgt += key[j] > T ? 1 : 0;
    const int need = 256 - wave_sum_i(cgt);
    int P = 0;
#pragma unroll 1
    for (int bit = 11; bit >= 0; --bit) { const int cand = P | (1 << bit); int cnt = 0;
#pragma unroll
        for (int j = 0; j < 64; ++j) cnt += (key[j] == T && 64 * j + lane < cand) ? 1 : 0;
        if (wave_sum_i(cnt) < need) P = cand; }
#pragma unroll
    for (int j = 0; j < 64; ++j) { const bool sel = key[j] > T || (key[j] == T && 64 * j + lane <= P); const u64 m = __ballot(sel); if (lane == j) myword = m; }
    mk[lane] = myword;
}
__device__ __forceinline__ int block_sum_i(LAS int* red, int v, int lane, int w) {
    v = wave_sum_i(v);
    __syncthreads();
    if (lane == 0) red[w] = v;
    __syncthreads();
    int s = 0;
#pragma unroll
    for (int i = 0; i < 8; ++i) s += red[i];
    return s;
}
__device__ __forceinline__ void topk_sample_unit(Ctx& c, const Args& a, int q) {
    int tid = c.tid; asm volatile("" : "+v"(tid));
    const int lane = tid & 63, w = c.wave;
    LAS int* red = (LAS int*)(c.lds);
    const int t = q & 3, n = PAST + t + 1; const float* sc = (const float*)(a.ws + WS_SSC) + (size_t)q * SSC_LD;
    int* out = (int*)(a.ws + WS_SIDX) + q * 256;
    unsigned key[17];
#pragma unroll
    for (int j = 0; j < 17; ++j) { const int s = tid + 512 * j; key[j] = s < n ? fkey(sc[s]) : 0u; }
    unsigned T = 0u;
#pragma unroll 1
    for (int bit = 31; bit >= 0; --bit) { const unsigned cand = T | (1u << bit); int cnt = 0;
#pragma unroll
        for (int j = 0; j < 17; ++j) cnt += key[j] >= cand ? 1 : 0;
        if (block_sum_i(red, cnt, lane, w) >= 256) T = cand; }
    int cgt = 0;
#pragma unroll
    for (int j = 0; j < 17; ++j) cgt += key[j] > T ? 1 : 0;
    const int need = 256 - block_sum_i(red, cgt, lane, w);
    int P = 0;
#pragma unroll 1
    for (int bit = 13; bit >= 0; --bit) { const int cand = P | (1 << bit); int cnt = 0;
#pragma unroll
        for (int j = 0; j < 17; ++j) cnt += (key[j] == T && tid + 512 * j < cand) ? 1 : 0;
        if (block_sum_i(red, cnt, lane, w) < need) P = cand; }
    int mine = 0;
#pragma unroll
    for (int j = 0; j < 17; ++j) mine += (key[j] > T || (key[j] == T && tid + 512 * j <= P)) ? 1 : 0;
    int inc = mine;
#pragma unroll
    for (int o = 1; o < 64; o <<= 1) { const int v = __shfl_up(inc, o); if (lane >= o) inc += v; }
    __syncthreads();
    if (lane == 63) red[w] = inc;
    __syncthreads();
    int base = inc - mine;
#pragma unroll
    for (int i = 0; i < 8; ++i) base += i < w ? red[i] : 0;
#pragma unroll
    for (int j = 0; j < 17; ++j) { if (key[j] > T || (key[j] == T && tid + 512 * j <= P)) { if (base < 256) out[base] = tid + 512 * j; ++base; } }
    __syncthreads();
}
__device__ __forceinline__ void p10_topk(Ctx& c, const Args& a) {
    const int gw = c.vcu * NWAVES + c.wave, NGW = c.G * NWAVES;
    for (int row = gw; row < MP; row += NGW) topk_prompt_row(a, row, c.lane);
    for (int q = c.G - 1 - c.vcu; q < MS; q += c.G) topk_sample_unit(c, a, q);
}

__device__ __forceinline__ void attn_sample_unit(Ctx& c, const Args& a, int sb, int t) {
    LAS bf16* KV = (LAS bf16*)(c.lds);
    LAS float* QL = (LAS float*)(c.lds + 69632);
    LAS float* SL = (LAS float*)(c.lds + 69632 + 3072);
    LAS float* OL = (LAS float*)(c.lds + 69632 + 6144);
    LAS int* IL = (LAS int*)(c.lds + 69632 + 12288);
    int tid = c.tid; asm volatile("" : "+v"(tid));
    const int lane = tid & 63, w = c.wave, q = sb * 4 + t;
    __syncthreads();
    if (tid < 256) IL[tid] = ((const int*)(a.ws + WS_SIDX))[q * 256 + tid];
    for (int i = tid; i < 768; i += 512) QL[i] = ((const float*)(a.ws + WS_SQ))[(size_t)q * 768 + i];
    __syncthreads();
    bf16* MIX = (bf16*)(a.ws + WS_MIX) + (size_t)(MP + q) * DM;
#pragma unroll 1
    for (int kvh = 0; kvh < 2; ++kvh) {
#pragma unroll 1
        for (int pass = 0; pass < 2; ++pass) {
            const float* pool = pass ? a.in[3] : a.in[2]; const float* nw = a.out + (pass ? O_VS : O_KS);
            for (int i = tid >> 5; i < 256; i += 16) { const int idx = IL[i]; const float* src;
                if (idx < PAST) src = pool + (((size_t)a.page_table[sb * 64 + (idx >> 7)] * 128 + (idx & 127)) * 2 + kvh) * 128;
                else src = nw + (size_t)(sb * 4 + (idx - PAST)) * 256 + kvh * 128;
                const f32x4 v = *(const f32x4*)(src + (tid & 31) * 4);
                *(LAS u64*)(KV + i * 136 + (tid & 31) * 4) = (u64)pk2(v.x, v.y) | ((u64)pk2(v.z, v.w) << 32); }
            __syncthreads();
            if (pass == 0) {
                const int i = tid >> 1, dh = (tid & 1) * 64; float s0 = 0.f, s1 = 0.f, s2 = 0.f;
#pragma unroll 8
                for (int d = 0; d < 64; ++d) { const float kx = bf2f(KV[i * 136 + dh + d]);
                    s0 = fmaf(QL[(3 * kvh + 0) * 128 + dh + d], kx, s0); s1 = fmaf(QL[(3 * kvh + 1) * 128 + dh + d], kx, s1); s2 = fmaf(QL[(3 * kvh + 2) * 128 + dh + d], kx, s2); }
                s0 += __shfl_xor(s0, 1); s1 += __shfl_xor(s1, 1); s2 += __shfl_xor(s2, 1);
                if ((tid & 1) == 0) { SL[i] = s0 * 0.08838834764831845f; SL[256 + i] = s1 * 0.08838834764831845f; SL[512 + i] = s2 * 0.08838834764831845f; }
                __syncthreads();
                if (w < 3) { float v[4], mx = -1e30f;
#pragma unroll
                    for (int j = 0; j < 4; ++j) { v[j] = SL[w * 256 + 64 * j + lane]; mx = fmaxf(mx, v[j]); }
#pragma unroll
                    for (int o = 1; o < 64; o <<= 1) mx = fmaxf(mx, __shfl_xor(mx, o));
                    float l = 0.f;
#pragma unroll
                    for (int j = 0; j < 4; ++j) { v[j] = __expf(v[j] - mx); l += v[j]; }
                    l = wave_sum(l); const float il = 1.0f / l;
#pragma unroll
                    for (int j = 0; j < 4; ++j) SL[w * 256 + 64 * j + lane] = v[j] * il; }
                __syncthreads();
            } else {
                const int d = tid & 127, part = tid >> 7; float o0 = 0.f, o1 = 0.f, o2 = 0.f;
#pragma unroll 8
                for (int i = part * 64; i < part * 64 + 64; ++i) { const float vx = bf2f(KV[i * 136 + d]); o0 = fmaf(SL[i], vx, o0); o1 = fmaf(SL[256 + i], vx, o1); o2 = fmaf(SL[512 + i], vx, o2); }
                OL[(part * 3 + 0) * 128 + d] = o0; OL[(part * 3 + 1) * 128 + d] = o1; OL[(part * 3 + 2) * 128 + d] = o2;
                __syncthreads();
                if (tid < 384) { const int hq = tid >> 7, dd = tid & 127; const float o = (OL[hq * 128 + dd] + OL[(3 + hq) * 128 + dd]) + (OL[(6 + hq) * 128 + dd] + OL[(9 + hq) * 128 + dd]);
                    MIX[(3 * kvh + hq) * 128 + dd] = (bf16)f2bf(o); }
                __syncthreads();
            }
        }
    }
}


namespace attn {
using bf16 = unsigned short;
typedef short bf16x8 __attribute__((ext_vector_type(8)));
typedef short s16x4 __attribute__((ext_vector_type(4)));
typedef float f32x16 __attribute__((ext_vector_type(16)));
typedef float f32x4 __attribute__((ext_vector_type(4)));
typedef unsigned u32x4 __attribute__((ext_vector_type(4)));
typedef unsigned u32x2 __attribute__((ext_vector_type(2)));
constexpr int D = 128, OS = 1024;
constexpr float THR = 8.f;
constexpr float SCALE = 0.08838834764831845f;
constexpr int NW = 8, QBLK = 32, KVBLK = 64, QB = NW * QBLK;
constexpr int SHM_V = KVBLK * D * 2, SHM_K = KVBLK * D * 2;
constexpr int LDS_BYTES = 2 * SHM_V + 2 * SHM_K + NW * 64 * 4;

#define KSWZ(row, colB) ((row) * 256 + ((colB) ^ (((row) & 7) << 4)))
#define SBAR() __builtin_amdgcn_sched_barrier(0)
__device__ __forceinline__ int v_st(int k, int c) { const int kk = (k & ~0xC) | ((k & 4) << 1) | ((k & 8) >> 1); return ((kk >> 3) * 4 + (c >> 5)) * 512 + ((kk & 7) * 32 + (c & 31)) * 2; }
__device__ __forceinline__ int v_rd_base(int lane) { return ((lane & 3) << 3) | (((lane >> 2) & 3) << 6) | (((lane >> 4) & 1) << 5) | (((lane >> 5) & 1) << 8); }
constexpr int v_rd_off(int d0, int ks, int half) { return d0 * 512 + ks * 4096 + half * 2048; }
__device__ __forceinline__ int crow(int r, int hi) { return (r & 3) + 8 * (r >> 2) + 4 * hi; }
__device__ __forceinline__ unsigned cvtpk(float lo, float hi) {
    unsigned r; asm volatile("v_cvt_pk_bf16_f32 %0, %1, %2" : "=v"(r) : "v"(lo), "v"(hi)); return r;
}
__device__ __forceinline__ bf16x8 pack8(f32x4 a, f32x4 b) {
    u32x4 w = {cvtpk(a[0], a[1]), cvtpk(a[2], a[3]), cvtpk(b[0], b[1]), cvtpk(b[2], b[3])};
    return *reinterpret_cast<bf16x8*>(&w);
}

__device__ __forceinline__ void partialSM(f32x16& p0, f32x16& p1, float& m_reg, float& mn, float& alpha) {
    float pmax = p0[0]; for (int r = 1; r < 16; ++r) pmax = fmaxf(pmax, p0[r]); for (int r = 0; r < 16; ++r) pmax = fmaxf(pmax, p1[r]);
    { auto rr = __builtin_amdgcn_permlane32_swap(__float_as_uint(pmax), __float_as_uint(pmax), false, false);
      pmax = fmaxf(__uint_as_float(rr[0]), __uint_as_float(rr[1])); }
    constexpr float C2 = 1.4426950408889634f * SCALE;
    if (__builtin_expect(__all((pmax - m_reg) * SCALE <= THR), 1)) { mn = m_reg; alpha = 1.f; }
    else { mn = fmaxf(m_reg, pmax); alpha = __builtin_amdgcn_exp2f((m_reg - mn) * C2); m_reg = mn; }
    const float mnL = -mn * C2;
    for (int r = 0; r < 16; ++r) p0[r] = fmaf(p0[r], C2, mnL); for (int r = 0; r < 16; ++r) p1[r] = fmaf(p1[r], C2, mnL);
    for (int r = 0; r < 16; ++r) p0[r] = __builtin_amdgcn_exp2f(p0[r]);
}
__device__ __forceinline__ void finishSM(f32x16& p0, f32x16& p1, float alpha, float& l_reg, bf16x8& pa0, bf16x8& pa1, bf16x8& pa2, bf16x8& pa3) {
    for (int r = 0; r < 16; ++r) p1[r] = __builtin_amdgcn_exp2f(p1[r]);
    float ps = 0; for (int r = 0; r < 16; ++r) ps += p0[r]; for (int r = 0; r < 16; ++r) ps += p1[r];
    { auto rr = __builtin_amdgcn_permlane32_swap(__float_as_uint(ps), __float_as_uint(ps), false, false);
      ps = __uint_as_float(rr[0]) + __uint_as_float(rr[1]); }
    l_reg = l_reg * alpha + ps;
#define PK4(P, B_, OUT) do { unsigned a0 = cvtpk(P[B_+0], P[B_+1]), a1 = cvtpk(P[B_+2], P[B_+3]);                          \
        unsigned b0 = cvtpk(P[B_+4], P[B_+5]), b1 = cvtpk(P[B_+6], P[B_+7]);                                             \
        auto r0 = __builtin_amdgcn_permlane32_swap(a0, b0, false, false); auto r1 = __builtin_amdgcn_permlane32_swap(a1, b1, false, false); \
        u32x4 w = {r0[0], r1[0], r0[1], r1[1]}; OUT = *reinterpret_cast<bf16x8*>(&w); } while (0)
    PK4(p0, 0, pa0); PK4(p0, 8, pa1); PK4(p1, 0, pa2); PK4(p1, 8, pa3);
#undef PK4
}
template <int KB, bool SK>
__device__ __forceinline__ void qkt(f32x16& p0, f32x16& p1, const char* K_lds, int r32, int hi, const bf16x8* qr, bool act) {
    if (SK && !act) { const float NEG = -__builtin_inff();
#pragma unroll
        for (int r = 0; r < 16; ++r) { p0[r] = NEG; p1[r] = NEG; } return; }
    p0 = f32x16{}; p1 = f32x16{};
    const char* kb[4];
#pragma unroll
    for (int dd = 0; dd < 4; ++dd) kb[dd] = K_lds + KB * SHM_K + KSWZ(r32, (dd * 16 + hi * 8) * 2);
#pragma unroll
    for (int d0 = 0; d0 < 8; ++d0) { const char* a = kb[d0 & 3] + (d0 >> 2) * 128;
        bf16x8 b0 = *reinterpret_cast<const bf16x8*>(a);
        bf16x8 b1 = *reinterpret_cast<const bf16x8*>(a + 32 * 256);
        p0 = __builtin_amdgcn_mfma_f32_32x32x16_bf16(b0, qr[d0], p0, 0, 0, 0);
        p1 = __builtin_amdgcn_mfma_f32_32x32x16_bf16(b1, qr[d0], p1, 0, 0, 0); }
}
template <int VB, bool SK>
__device__ __forceinline__ void pv_tile(f32x16* o, int vb0, bf16x8 pa0, bf16x8 pa1, bf16x8 pa2, bf16x8 pa3, bool act) {
    if (SK && !act) return;
#define TRRD(dst, off) asm volatile("ds_read_b64_tr_b16 %0, %1 offset:%2" : "=&v"(dst) : "v"(vb0), "i"(off) : "memory")
#define PV_D0(d0) do { s16x4 l0, l1, l2, l3, h0, h1, h2, h3; constexpr int b_ = VB * SHM_V + v_rd_off(d0, 0, 0);     \
        TRRD(l0, b_); TRRD(h0, b_ + 2048); TRRD(l1, b_ + 4096); TRRD(h1, b_ + 6144); TRRD(l2, b_ + 8192); TRRD(h2, b_ + 10240); TRRD(l3, b_ + 12288); TRRD(h3, b_ + 14336); \
        asm volatile("s_waitcnt lgkmcnt(0)" ::: "memory"); SBAR();                 \
        o[d0] = __builtin_amdgcn_mfma_f32_32x32x16_bf16(pa0, (bf16x8){l0[0], l0[1], l0[2], l0[3], h0[0], h0[1], h0[2], h0[3]}, o[d0], 0, 0, 0);   \
        o[d0] = __builtin_amdgcn_mfma_f32_32x32x16_bf16(pa1, (bf16x8){l1[0], l1[1], l1[2], l1[3], h1[0], h1[1], h1[2], h1[3]}, o[d0], 0, 0, 0);   \
        o[d0] = __builtin_amdgcn_mfma_f32_32x32x16_bf16(pa2, (bf16x8){l2[0], l2[1], l2[2], l2[3], h2[0], h2[1], h2[2], h2[3]}, o[d0], 0, 0, 0);   \
        o[d0] = __builtin_amdgcn_mfma_f32_32x32x16_bf16(pa3, (bf16x8){l3[0], l3[1], l3[2], l3[3], h3[0], h3[1], h3[2], h3[3]}, o[d0], 0, 0, 0); } while (0)
    PV_D0(0); PV_D0(1); PV_D0(2); PV_D0(3);
#undef PV_D0
#undef TRRD
}

__device__ __forceinline__ bf16x8 load8(const bf16* p) { return *reinterpret_cast<const bf16x8*>(p); }
__device__ __forceinline__ void mask_bits(f32x16& p0, f32x16& p1, u32x2 w, int hi) {
    const float NEG = -__builtin_inff();
    asm volatile("" : "+v"(w.x), "+v"(w.y));
    const unsigned lo = w.x >> (4 * hi), up = w.y >> (4 * hi);
#pragma unroll
    for (int r = 0; r < 16; ++r) { const int c = (r & 3) + 8 * (r >> 2);
        if (!((lo >> c) & 1u)) p0[r] = NEG;
        if (!((up >> c) & 1u)) p1[r] = NEG; }
}
struct BlockRef { const bf16* Q; const bf16* K; const bf16* V; bf16* O; const u32x2* M; int P0; };
struct Seam { bf16x8 qr[8]; bf16x8 st_v0, st_v1, st_k0, st_k1; };
#define ROW(p, k0, rr) ((p) + (size_t)((k0) + (rr)) * D + sc)
#define VMW() asm volatile("s_waitcnt vmcnt(0)" ::: "memory")
#define VMWN(n) asm volatile("s_waitcnt vmcnt(%0)" :: "i"(n) : "memory")
#define SLOAD_H(Kp, Vp, k0) do { S.st_v0 = load8(ROW(Vp, k0, sr)); S.st_v1 = load8(ROW(Vp, k0, 32 + sr));              \
                         S.st_k0 = load8(ROW(Kp, k0, sr)); S.st_k1 = load8(ROW(Kp, k0, 32 + sr)); } while (0)
#define SWRITE_HK(bf) do { *(bf16x8*)(K_lds + (bf) * SHM_K + kws) = S.st_k0; *(bf16x8*)(K_lds + (bf) * SHM_K + kws + 32 * 256) = S.st_k1; } while (0)
#define SWRITE_HV(bf) do { *(bf16x8*)(V_lds + (bf) * SHM_V + vst0) = S.st_v0; *(bf16x8*)(V_lds + (bf) * SHM_V + vst1) = S.st_v1; } while (0)
#define SWRITE_H(bf) do { SWRITE_HV(bf); SWRITE_HK(bf); } while (0)
__device__ __forceinline__ void sel_prime(const BlockRef& cur, char* lds, Seam& S) {
    int tid_ = threadIdx.x; asm volatile("" : "+v"(tid_));
    const int tid = tid_, wid = __builtin_amdgcn_readfirstlane(tid >> 6), lane = tid & 63, r32 = lane & 31, hi = lane >> 5;
    const int sr = tid >> 4, sc = (tid & 15) * 8, kws = KSWZ(sr, sc * 2); char* K_lds = lds + 2 * SHM_V;
    for (int d0 = 0; d0 < 8; ++d0) S.qr[d0] = load8(cur.Q + (size_t)(wid * QBLK + r32) * D + d0 * 16 + hi * 8);
    SLOAD_H(cur.K, cur.V, 0); VMW(); SWRITE_HK(0);
    __syncthreads();
}
__device__ __forceinline__ void sel_block(const BlockRef& cur, const BlockRef& nxt, char* lds, Seam& S) {
    int tid_ = threadIdx.x; asm volatile("" : "+v"(tid_));
    const int tid = tid_, wid = __builtin_amdgcn_readfirstlane(tid >> 6), lane = tid & 63, r32 = lane & 31, hi = lane >> 5;
    const int NT = (cur.P0 + QB) / KVBLK;
    char* V_lds = lds; char* K_lds = lds + 2 * SHM_V;
    float* ws = (float*)(lds + 2 * SHM_V + 2 * SHM_K) + wid * 64; float* li_l = ws, * al_l = ws + 32;
    float m_reg = -1e30f, l_reg = 0; f32x16 o[4] = {};
    const int sr = tid >> 4, sc = (tid & 15) * 8, vst0 = v_st(sr, sc), vst1 = v_st(32 + sr, sc), kws = KSWZ(sr, sc * 2);
    const int vb0 = (int)(uintptr_t)V_lds + v_rd_base(lane);
    const bf16* Kh = cur.K; const bf16* Vh = cur.V;
    const u32x2* Mrow = cur.M + (size_t)(wid * QBLK + r32) * 64;
#define RESC(a) do { if (__any((a) < 1.f)) { if (hi == 0) al_l[r32] = (a); asm volatile("s_waitcnt lgkmcnt(0)" ::: "memory");              \
                     for (int d_ = 0; d_ < 4; ++d_) for (int r = 0; r < 16; ++r) o[d_][r] *= al_l[crow(r, hi)]; } } while (0)
#define KBASE(t) ((t) * KVBLK)
    f32x16 pA0, pA1, pB0, pB1; float mnA, mnB, alA, alB; bf16x8 pa0, pa1, pa2, pa3; u32x2 mw;
    SWRITE_HV(0); SBAR();
    if (NT > 1) SLOAD_H(Kh, Vh, KBASE(1));
    mw = Mrow[0];
    SBAR(); qkt<0, false>(pA0, pA1, K_lds, r32, hi, S.qr, true);
    mask_bits(pA0, pA1, mw, hi); partialSM(pA0, pA1, m_reg, mnA, alA);
    if (NT > 1) { VMW(); SWRITE_H(1); }
    __syncthreads();
#define HALF_STEP(PX0, PX1, mnX, alX, PY0, PY1, alY, t, KB, VB, SB) do {                                                      \
        SBAR(); mw = Mrow[(t)]; qkt<KB, false>(PX0, PX1, K_lds, r32, hi, S.qr, true);                                          \
        finishSM(PY0, PY1, alY, l_reg, pa0, pa1, pa2, pa3); SBAR();                                                           \
        if ((t) + 1 < NT) { SLOAD_H(Kh, Vh, KBASE((t) + 1)); SBAR(); }                                                        \
        pv_tile<VB, false>(o, vb0, pa0, pa1, pa2, pa3, true); mask_bits(PX0, PX1, mw, hi); partialSM(PX0, PX1, m_reg, mnX, alX); \
        __syncthreads();                                                                                                      \
        if ((t) + 1 < NT) { VMW(); SWRITE_H(SB); }                                                                            \
        RESC(alX); __syncthreads(); } while (0)
    for (int t = 1; t + 1 < NT; t += 2) {
        HALF_STEP(pB0, pB1, mnB, alB, pA0, pA1, alA, t, 1, 0, 0);
        HALF_STEP(pA0, pA1, mnA, alA, pB0, pB1, alB, t + 1, 0, 1, 1);
    }
    const bool even = (NT & 1) == 0;
    if (even) { SBAR(); mw = Mrow[NT - 1]; qkt<1, false>(pB0, pB1, K_lds, r32, hi, S.qr, true); SBAR(); }
    SLOAD_H(nxt.K, nxt.V, 0); SBAR();
#pragma unroll
    for (int d0 = 0; d0 < 8; ++d0) S.qr[d0] = load8(nxt.Q + (size_t)(wid * QBLK + r32) * D + d0 * 16 + hi * 8);
    SBAR();
    finishSM(pA0, pA1, alA, l_reg, pa0, pa1, pa2, pa3); SBAR();
    pv_tile<0, false>(o, vb0, pa0, pa1, pa2, pa3, true);
    if (even) { mask_bits(pB0, pB1, mw, hi); partialSM(pB0, pB1, m_reg, mnB, alB); __syncthreads(); RESC(alB);
        finishSM(pB0, pB1, alB, l_reg, pa0, pa1, pa2, pa3); SBAR(); pv_tile<1, false>(o, vb0, pa0, pa1, pa2, pa3, true); }
    SBAR(); VMWN(8); SWRITE_HK(0); SBAR();
    if (hi == 0) li_l[r32] = l_reg; asm volatile("s_waitcnt lgkmcnt(0)" ::: "memory");
    float rli[16];
#pragma unroll
    for (int r = 0; r < 16; ++r) rli[r] = __builtin_amdgcn_rcpf(li_l[crow(r, hi)]);
    bf16* Ow = cur.O + (size_t)(wid * QBLK) * OS;
#pragma unroll
    for (int r = 0; r < 16; ++r) { const int orow = crow(r, hi);
#pragma unroll
        for (int d0 = 0; d0 < 4; ++d0) { const float v = o[d0][r] * rli[r];
            const float vn = __shfl_xor(v, 1);
            if ((r32 & 1) == 0) *(unsigned*)(Ow + (size_t)orow * OS + d0 * 32 + r32) = cvtpk(v, vn); } }
    __syncthreads();
#undef RESC
#undef KBASE
#undef HALF_STEP
}
#undef ROW
#undef VMW
#undef VMWN
#undef SLOAD_H
#undef SWRITE_HK
#undef SWRITE_HV
#undef SWRITE_H
#undef KSWZ
#undef SBAR
}


__device__ __forceinline__ attn::BlockRef attn_ref(const Args& a, int b, int h, int qb) {
    attn::BlockRef r; const int kvh = h / 3;
    r.Q = (const attn::bf16*)(a.ws + WS_QB) + ((size_t)(b * 6 + h) * SEQ + (size_t)qb * 256) * 128;
    r.K = (const attn::bf16*)(a.ws + WS_KB) + (size_t)(b * 2 + kvh) * SEQ * 128;
    r.V = (const attn::bf16*)(a.ws + WS_VB) + (size_t)(b * 2 + kvh) * SEQ * 128;
    r.O = (attn::bf16*)(a.ws + WS_MIX) + (size_t)(b * SEQ + qb * 256) * DM + h * 128;
    r.M = (const attn::u32x2*)(a.ws + WS_MASK) + (size_t)(b * SEQ + qb * 256) * 64;
    r.P0 = qb * 256; return r;
}
__device__ __forceinline__ void p11_attention(Ctx& c, const Args& a) {
    constexpr int NITEM = 192;
#pragma unroll 1
    for (int it = c.vcu; it < NITEM; it += c.G) {
        const int p = it & 7, bh = it >> 3, b = bh / 6, h = bh % 6;
        attn::Seam S;
        attn::BlockRef cur = attn_ref(a, b, h, p), nxt = attn_ref(a, b, h, 15 - p);
        __syncthreads();
        attn::sel_prime(cur, (char*)c.lds, S);
        attn::sel_block(cur, nxt, (char*)c.lds, S);
        attn::sel_block(nxt, nxt, (char*)c.lds, S);
    }
    const int spare = c.G - NITEM;
    if (spare > 0) { if (c.vcu >= NITEM) for (int u = c.vcu - NITEM; u < MS; u += spare) attn_sample_unit(c, a, u >> 2, u & 3); }
    else for (int u = c.vcu; u < MS; u += c.G) attn_sample_unit(c, a, u >> 2, u & 3);
}

constexpr int NPHASE = 16;
#ifndef ONLYPH
#define ONLYPH -1
#endif
#define PHON(x) (ONLYPH < 0 || ONLYPH == (x))
__global__ void __launch_bounds__(NWAVES * 64, 2) fwd_kernel(Args args) {
    extern __shared__ __attribute__((aligned(16))) unsigned char lds[];
    Ctx c;
    c.lds = (LAS unsigned char*)lds;
    c.MISC = (volatile LAS unsigned*)(c.lds + MISC_OFF);
    c.tid = threadIdx.x; c.lane = c.tid & 63; c.wave = __builtin_amdgcn_readfirstlane(c.tid >> 6);
    c.G = gridDim.x; { const int bx = blockIdx.x; c.vcu = (c.G % 8 == 0) ? (bx % 8) * (c.G / 8) + bx / 8 : bx; }
    unsigned char* ws = args.ws;
    c.ctl = (gu32*)(ws + WS_CTL);
    for (int u = c.tid; u < (LDS_BYTES - LDSCTL_OFF) / 4; u += NWAVES * 64) ((LAS unsigned*)(c.lds + LDSCTL_OFF))[u] = 0u;
    __syncthreads();
    const int lo = args.ph_lo, hi = args.ph_hi;
    XcdBarrier bar; bar.bar = (unsigned*)(c.ctl + CW_BAR); bar.x = 0; bar.st = nullptr;
    if (hi - lo > 1) bar = xcd_barrier_post((unsigned*)(c.ctl + CW_BAR), c.MISC + 8);
    float* const out = args.out;
#pragma unroll 1
    for (int ph = lo; ph < hi; ++ph) {
        const int layer = ph >= 7 ? 1 : 0;
        { int t_ = threadIdx.x; asm volatile("" : "+v"(t_)); c.tid = t_; c.lane = t_ & 63; c.wave = __builtin_amdgcn_readfirstlane(t_ >> 6); }
        if (ph == 0 && PHON(0)) p0_prologue(c, args);
        else if ((ph == 1 || ph == 7) && PHON(1)) {
            pg8::Gemm g{(const pg8::bf16_t*)(ws + WS_XB), (const pg8::bf16_t*)(ws + (ph == 1 ? WS_WIN0 : WS_WIN1)), MT, 0, 1024};
            pg8::SchedX S; if (ph == 1) S.init(MT, ZC0, c.G, (int)blockIdx.x, 16, MT / 256, 4, 13); else S.init(MT, ZC1, c.G, (int)blockIdx.x, 0, 0, 1, 0);
            pg8::EpiZ E{(pg8::bf16_t*)(ws + WS_Z), ph == 1 ? ZC0 : ZC1, ssptr(c, ph == 1 ? 0 : 2), ph == 1 ? 13 : 9, (float*)(ws + WS_MEMKV), MEMROW0};
            pg8::gemm_phase<pg8::EpiZ, pg8::SchedX, PG8_ALIGN, PG8_SP2>(c.lds + RING_OFF, g, S, E);
        }
        else if (ph == 2 && PHON(2)) p2_mixer0(c, args);
        else if ((ph == 3 || ph == 6 || ph == 12 || ph == 15) && PHON(3)) {
            const bool isout = (ph == 3 || ph == 12);
            pg8::Gemm g{(const pg8::bf16_t*)(ws + (isout ? WS_MIX : WS_ACT)), (const pg8::bf16_t*)(ws + (isout ? WS_WOUT + (size_t)layer * 1024 * 1024 * 2 : WS_WD + (size_t)layer * 1024 * DFF * 2)), MT, 1024, isout ? 1024 : DFF};
            pg8::SchedX S; S.init(MT, 1024, c.G, (int)blockIdx.x, 0, 0, 1, 0);
            pg8::EpiResid E;
            E.rp = ph == 3 ? args.in[0] : out + O_YP; E.rs = ph == 3 ? args.in[1] : out + O_YS; E.y = out + O_YP;
            E.xb = ph == 15 ? nullptr : (pg8::bf16_t*)(ws + WS_XB); E.ssout = ph == 15 ? nullptr : ssptr(c, ph == 3 ? 1 : (ph == 6 ? 2 : 3));
            pg8::gemm_phase<pg8::EpiResid, pg8::SchedX, PG8_ALIGN, PG8_SP2>(c.lds + RING_OFF, g, S, E);
        }
        else if ((ph == 4 || ph == 13) && PHON(4)) {
            pg8::Gemm g{(const pg8::bf16_t*)(ws + WS_XB), (const pg8::bf16_t*)(ws + WS_WGU + (size_t)layer * 5632 * 1024 * 2), MT, 5632, 1024};
            pg8::SchedX S; S.init(MT, 5632, c.G, (int)blockIdx.x, 0, 0, 1, 0);
            pg8::EpiGU E{(pg8::bf16_t*)(ws + WS_U), (pg8::bf16_t*)(ws + WS_UP), ssptr(c, layer ? 3 : 1), out + O_CVP + (size_t)layer * 4 * 2 * DFF, out + O_CVS + (size_t)layer * 32 * 2 * DFF};
            pg8::gemm_phase<pg8::EpiGU, pg8::SchedX, PG8_ALIGN, PG8_SP2>(c.lds + RING_OFF, g, S, E);
        }
        else if ((ph == 5 || ph == 14) && PHON(5)) p5_convact(c, args, layer);
        else if (ph == 8 && PHON(8)) p8_dsa_post(c, args);
        else if (ph == 9 && PHON(9)) p9_indexer(c, args);
        else if (ph == 10 && PHON(10)) p10_topk(c, args);
        else if (ph == 11 && PHON(11)) p11_attention(c, args);
        if (ph + 1 < hi) xcd_barrier(bar);
    }
}

#ifndef MK_ONE_LAUNCH
#define MK_ONE_LAUNCH 1
#endif
extern "C" void kernel_launch(void* const* d_in, const int* in_sizes, int n_in, void* d_out, int out_size, void* d_ws, size_t ws_size, hipStream_t stream) {
    static int grid = 0;
    if (grid == 0) {
        if (n_in != 29 || out_size != (int)O_END || ws_size < WS_END) { fprintf(stderr, "kernel_launch: unexpected problem (n_in %d, out %d, ws %zu)\n", n_in, out_size, ws_size); grid = -1; return; }
        int dev = 0, cus = 0;
        if (hipGetDevice(&dev) != hipSuccess || hipDeviceGetAttribute(&cus, hipDeviceAttributeMultiprocessorCount, dev) != hipSuccess) { grid = -1; return; }
        if (hipFuncSetAttribute((const void*)fwd_kernel, hipFuncAttributeMaxDynamicSharedMemorySize, LDS_BYTES) != hipSuccess) { fprintf(stderr, "kernel_launch: hipFuncSetAttribute failed\n"); grid = -1; return; }
        (void)hipGetLastError();
        grid = cus;
    }
    if (grid < 0) return;
    if (hipMemsetAsync((char*)d_ws + WS_CTL, 0, CTL_ZERO_BYTES, stream) != hipSuccess) { fprintf(stderr, "kernel_launch: memset failed\n"); return; }
    Args a{};
    for (int i = 0; i < 29; ++i) a.in[i] = (const float*)d_in[i];
    a.page_table = (const int*)d_in[9]; a.out = (float*)d_out; a.ws = (unsigned char*)d_ws;
#if MK_ONE_LAUNCH
    a.ph_lo = 0; a.ph_hi = NPHASE;
    hipLaunchKernelGGL(fwd_kernel, dim3(grid), dim3(NWAVES * 64), LDS_BYTES, stream, a);
#else
    for (int ph = 0; ph < NPHASE; ++ph) { a.ph_lo = ph; a.ph_hi = ph + 1; hipLaunchKernelGGL(fwd_kernel, dim3(grid), dim3(NWAVES * 64), LDS_BYTES, stream, a); }
#endif
}
```

```cpp
#include <hip/hip_runtime.h>
#include <cstdio>
#include <cstdint>


namespace pg8 {
#define PG8_LAS __attribute__((address_space(3)))
typedef unsigned short bf16_t;
typedef short bf16x8 __attribute__((ext_vector_type(8)));
typedef float f32x4 __attribute__((ext_vector_type(4)));
typedef unsigned u32x4 __attribute__((ext_vector_type(4)));
constexpr int BM = 256, BK = 64, HALF = 128, HTB = HALF * BK * 2  , STAGE_BYTES = 8 * HTB, NXCD = 8, WGM = 8;

__host__ __device__ __forceinline__ int lds_byte(int r, int c) { const int st = (r >> 4) * 2 + (c >> 5), rr = r & 15, cc = c & 31, ob = rr * 64 + cc * 2; return st * 1024 + (ob ^ (((ob >> 9) & 1) << 5)); }
__host__ __device__ __forceinline__ void stage_rc(int b, int& R, int& C) { const int st = b / 1024, sb = b % 1024, swz = sb ^ (((sb >> 9) & 1) << 5); R = (st >> 1) * 16 + swz / 64; C = (st & 1) * 32 + (swz % 64) / 2; }
__host__ __device__ __forceinline__ int perm32(int rho) { const int n = rho >> 4, i = rho & 15; return 8 * (i >> 2) + 4 * n + (i & 3); }

struct Unit { int pm, pn; };
struct Gemm { const bf16_t* A; const bf16_t* Bt; int M, N, K; };

struct StaticOrder {
    int nM, nN, nwg, G, c;
    __host__ __device__ void init(int M, int N, int G_, int c_) { nM = M / BM; nN = N / BM; nwg = nM * nN; G = G_; c = c_; }
    __host__ __device__ bool next(int i, Unit& u) const {
        const long L = (long)i * G + c; if (L >= nwg) return false;
        int wgid = (int)L; { const int q = nwg / NXCD, r = nwg % NXCD, xcd = wgid % NXCD, off = wgid / NXCD; wgid = (xcd < r ? xcd * (q + 1) : r * (q + 1) + (xcd - r) * q) + off; }
        const int nig = WGM * nN, gid = wgid / nig, fm = gid * WGM, gsz = (nM - fm) < WGM ? (nM - fm) : WGM;
        u.pm = fm + ((wgid % nig) % gsz); u.pn = (wgid % nig) / gsz; return true;
    }
    __device__ __forceinline__ void a_ready(const Unit&) const {}
    __device__ __forceinline__ void done(const Unit&) const {}
};


constexpr int MP = 16384, MS = 128, MVALID = MP + MS, MT = 16640, DM = 1024, DFF = 2816;
constexpr float RMS_EPS = 1e-6f;
__device__ __forceinline__ unsigned cvt_pk_bf16(float lo, float hi) { unsigned r; asm volatile("v_cvt_pk_bf16_f32 %0, %1, %2" : "=v"(r) : "v"(lo), "v"(hi)); return r; }

struct SchedX {
    StaticOrder so; int nextra, e_pm0, e_nm, e_pn0;
    __device__ void init(int M, int N, int G_, int c_, int nextra_, int e_pm0_, int e_nm_, int e_pn0_) { so.init(M, N, G_, c_); nextra = nextra_; e_pm0 = e_pm0_; e_nm = e_nm_; e_pn0 = e_pn0_; }
    __device__ bool next(int i, Unit& u) const {
        const long L = (long)i * so.G + so.c;
        if (L < so.nwg) return so.next(i, u);
        const int e = (int)(L - so.nwg); if (e >= nextra) return false;
        u.pm = e_pm0 + e % e_nm; u.pn = e_pn0 + e / e_nm; return true;
    }
    __device__ __forceinline__ void a_ready(const Unit&) const {}
    __device__ __forceinline__ void done(const Unit&) const {}
};

struct EpiZ {
    static constexpr bool PERM = true, AFTER_DRAIN = false;
    bf16_t* Z; int ldz; const float* ss; int nmain; float* memkv; int memrow0;
    __device__ __forceinline__ void operator()(const f32x4 (&acc)[2][2][4][2], const Unit& u, int wr, int wc, int fr, int fq) const {
        const int row0 = u.pm * BM + wr * 64 + fr;
        if (u.pn < nmain) {
            const int col0 = u.pn * BM + wc * 32 + 8 * fq;
#pragma unroll
            for (int ai = 0; ai < 2; ++ai)
#pragma unroll
                for (int m = 0; m < 4; ++m) { const int row = row0 + ai * HALF + m * 16; const float rs = rsqrtf(ss[row] * (1.0f / DM) + RMS_EPS);
#pragma unroll
                    for (int bj = 0; bj < 2; ++bj) { const f32x4 v0 = acc[ai][bj][m][0] * rs, v1 = acc[ai][bj][m][1] * rs;
                        u32x4 w; w.x = cvt_pk_bf16(v0[0], v0[1]); w.y = cvt_pk_bf16(v0[2], v0[3]); w.z = cvt_pk_bf16(v1[0], v1[1]); w.w = cvt_pk_bf16(v1[2], v1[3]);
                        *(u32x4*)(Z + (size_t)row * ldz + col0 + bj * HALF) = w; } }
        } else {
            const int col0 = (u.pn - nmain) * BM + wc * 32 + 8 * fq;
#pragma unroll
            for (int ai = 0; ai < 2; ++ai)
#pragma unroll
                for (int m = 0; m < 4; ++m) { const int row = row0 + ai * HALF + m * 16 - memrow0;
#pragma unroll
                    for (int bj = 0; bj < 2; ++bj) { float* p = memkv + (size_t)row * 1024 + col0 + bj * HALF; *(f32x4*)p = acc[ai][bj][m][0]; *(f32x4*)(p + 4) = acc[ai][bj][m][1]; } }
        }
    }
};

struct EpiResid {
    static constexpr bool PERM = true, AFTER_DRAIN = false;
    const float* rp; const float* rs; float* y; bf16_t* xb; float* ssout;
    __device__ __forceinline__ void operator()(const f32x4 (&acc)[2][2][4][2], const Unit& u, int wr, int wc, int fr, int fq) const {
        const int row0 = u.pm * BM + wr * 64 + fr, col0 = u.pn * BM + wc * 32 + 8 * fq;
#pragma unroll
        for (int ai = 0; ai < 2; ++ai)
#pragma unroll
            for (int m = 0; m < 4; ++m) { const int row = row0 + ai * HALF + m * 16; float part = 0.f;
                if (row < MVALID) { const float* src = row < MP ? rp + (size_t)row * DM : rs + (size_t)(row - MP) * DM;
#pragma unroll
                    for (int bj = 0; bj < 2; ++bj) { const int c = col0 + bj * HALF;
                        const f32x4 v0 = acc[ai][bj][m][0] + *(const f32x4*)(src + c), v1 = acc[ai][bj][m][1] + *(const f32x4*)(src + c + 4);
                        *(f32x4*)(y + (size_t)row * DM + c) = v0; *(f32x4*)(y + (size_t)row * DM + c + 4) = v1;
                        part += (v0[0] * v0[0] + v0[1] * v0[1]) + (v0[2] * v0[2] + v0[3] * v0[3]) + (v1[0] * v1[0] + v1[1] * v1[1]) + (v1[2] * v1[2] + v1[3] * v1[3]);
                        if (xb) { u32x4 w; w.x = cvt_pk_bf16(v0[0], v0[1]); w.y = cvt_pk_bf16(v0[2], v0[3]); w.z = cvt_pk_bf16(v1[0], v1[1]); w.w = cvt_pk_bf16(v1[2], v1[3]);
                            *(u32x4*)(xb + (size_t)row * DM + c) = w; } } }
                part += __shfl_xor(part, 16); part += __shfl_xor(part, 32);
                if (ssout && fq == 0 && row < MVALID) atomicAdd(ssout + row, part); }
    }
};

struct EpiGU {
    static constexpr bool PERM = true, AFTER_DRAIN = false;
    bf16_t* U; bf16_t* UP; const float* ss; float* cvp; float* cvs;
    __device__ __forceinline__ void operator()(const f32x4 (&acc)[2][2][4][2], const Unit& u, int wr, int wc, int fr, int fq) const {
        const int row0 = u.pm * BM + wr * 64 + fr, colg = u.pn * HALF + wc * 32 + 8 * fq;
#pragma unroll
        for (int ai = 0; ai < 2; ++ai)
#pragma unroll
            for (int m = 0; m < 4; ++m) { const int row = row0 + ai * HALF + m * 16; const float rs = rsqrtf(ss[row] * (1.0f / DM) + RMS_EPS);
                const f32x4 g0 = acc[ai][0][m][0] * rs, g1 = acc[ai][0][m][1] * rs, p0 = acc[ai][1][m][0] * rs, p1 = acc[ai][1][m][1] * rs;
                u32x4 w; w.x = cvt_pk_bf16(g0[0], g0[1]); w.y = cvt_pk_bf16(g0[2], g0[3]); w.z = cvt_pk_bf16(g1[0], g1[1]); w.w = cvt_pk_bf16(g1[2], g1[3]);
                *(u32x4*)(U + (size_t)row * DFF + colg) = w;
                w.x = cvt_pk_bf16(p0[0], p0[1]); w.y = cvt_pk_bf16(p0[2], p0[3]); w.z = cvt_pk_bf16(p1[0], p1[1]); w.w = cvt_pk_bf16(p1[2], p1[3]);
                *(u32x4*)(UP + (size_t)row * DFF + colg) = w;
                float* cv = nullptr;
                if (row < MP) { const int t = row & 4095; if (t >= 4094) cv = cvp + (size_t)((row >> 12) * 2 + (t - 4094)) * DFF; }
                else if (row < MVALID) { const int r2 = row - MP, t = r2 & 3; if (t >= 2) cv = cvs + (size_t)((r2 >> 2) * 2 + (t - 2)) * DFF; }
                if (cv) { *(f32x4*)(cv + colg) = g0; *(f32x4*)(cv + colg + 4) = g1; } }
    }
};

template <class Epi, class Sched, bool ALIGN_EPI = false, bool SP2 = false>
__device__ __forceinline__ void gemm_phase(PG8_LAS unsigned char* lds, const Gemm g, const Sched& S, const Epi& E) {
    int tid_ = threadIdx.x; asm volatile("" : "+v"(tid_));
    const int tid = tid_, wid = __builtin_amdgcn_readfirstlane(tid >> 6), lane = tid & 63, wr = wid >> 2, wc = wid & 3, fr = lane & 15, fq = lane >> 4;
    const int K = g.K, nt = K / BK;
    unsigned voffA[2], voffB[2];
#pragma unroll
    for (int i = 0; i < 2; ++i) { int R, C; stage_rc(tid * 16 + i * 8192, R, C); const int Rb = Epi::PERM ? ((R & ~31) + perm32(R & 31)) : R;
        voffA[i] = (unsigned)(R * K + C) * 2u; voffB[i] = (unsigned)(Rb * K + C) * 2u; }
    const size_t kstep = (size_t)(BK * 2);
    const size_t hstep = (size_t)HALF * K * 2;
    const size_t tstep = 2 * hstep;
    const unsigned ldsw = (unsigned)wid * 1024u;
    const int aoff = lds_byte(wr * 64 + fr, fq * 8), boff = lds_byte(wc * 32 + fr, fq * 8);
#define PG8_SA(b, h) (((b) * 2 + (h)) * HTB)
#define PG8_SB(b, h) ((4 + (b) * 2 + (h)) * HTB)
#define PG8_STAGE(bufoff, gbase, voff) do { _Pragma("unroll") for (int _i = 0; _i < 2; ++_i) \
        __builtin_amdgcn_global_load_lds((const unsigned*)((const char*)(gbase) + (voff)[_i]), (PG8_LAS unsigned*)(lds + (bufoff) + ldsw + _i * 8192), 16, 0, 0); } while (0)
#define PG8_LDA(dst, b, h) do { _Pragma("unroll") for (int m = 0; m < 4; ++m) _Pragma("unroll") for (int k = 0; k < 2; ++k) dst[m][k] = *(const PG8_LAS bf16x8*)(lds + PG8_SA(b, h) + aoff + m * 2048 + k * 1024); } while (0)
#define PG8_LDB(dst, b, h) do { _Pragma("unroll") for (int n = 0; n < 2; ++n) _Pragma("unroll") for (int k = 0; k < 2; ++k) dst[n][k] = *(const PG8_LAS bf16x8*)(lds + PG8_SB(b, h) + boff + n * 2048 + k * 1024); } while (0)
#define PG8_MMA(ai, bj, At, Bt) do { __builtin_amdgcn_s_setprio(1); _Pragma("unroll") for (int m = 0; m < 4; ++m) _Pragma("unroll") for (int n = 0; n < 2; ++n) _Pragma("unroll") for (int k = 0; k < 2; ++k) \
        acc[ai][bj][m][n] = __builtin_amdgcn_mfma_f32_16x16x32_bf16(Bt[n][k], At[m][k], acc[ai][bj][m][n], 0, 0, 0); __builtin_amdgcn_s_setprio(0); } while (0)
#define PG8_WAIT_V(n) asm volatile("s_waitcnt vmcnt(" #n ")" ::: "memory")
#define PG8_WAIT_L(n) asm volatile("s_waitcnt lgkmcnt(" #n ")" ::: "memory")
#define PG8_BAR __builtin_amdgcn_s_barrier()
#define PG8_SCHED __builtin_amdgcn_sched_barrier(0)
    Unit cur, nxt; int ui = 0;
    if (!S.next(0, cur)) return;
    f32x4 acc[2][2][4][2];
#pragma unroll
    for (int a = 0; a < 2; ++a)
#pragma unroll
        for (int b = 0; b < 2; ++b)
#pragma unroll
            for (int m = 0; m < 4; ++m)
#pragma unroll
                for (int n = 0; n < 2; ++n) acc[a][b][m][n] = (f32x4){0.f, 0.f, 0.f, 0.f};
    bf16x8 At[4][2], B0[2][2], B1[2][2];
    const char* cA = (const char*)g.A + (size_t)cur.pm * tstep; const char* cB = (const char*)g.Bt + (size_t)cur.pn * tstep;
    S.a_ready(cur);
    if constexpr (SP2) {
        PG8_STAGE(PG8_SB(0, 0), cB, voffB); PG8_STAGE(PG8_SB(0, 1), cB + hstep, voffB); PG8_STAGE(PG8_SA(0, 0), cA, voffA); PG8_STAGE(PG8_SA(0, 1), cA + hstep, voffA);
        if (wr == 1) PG8_BAR;
        PG8_WAIT_V(2); PG8_BAR;
        PG8_STAGE(PG8_SB(1, 0), cB + kstep, voffB); PG8_STAGE(PG8_SA(1, 0), cA + kstep, voffA); PG8_STAGE(PG8_SB(1, 1), cB + hstep + kstep, voffB);
        PG8_WAIT_V(6); PG8_BAR;
    } else {
        PG8_STAGE(PG8_SB(0, 0), cB, voffB); PG8_STAGE(PG8_SA(0, 0), cA, voffA); PG8_STAGE(PG8_SB(0, 1), cB + hstep, voffB); PG8_STAGE(PG8_SA(0, 1), cA + hstep, voffA);
        if (wr == 1) PG8_BAR;
        PG8_WAIT_V(4); PG8_BAR;
        PG8_STAGE(PG8_SB(1, 0), cB + kstep, voffB); PG8_STAGE(PG8_SA(1, 0), cA + kstep, voffA); PG8_STAGE(PG8_SB(1, 1), cB + hstep + kstep, voffB);
        PG8_WAIT_V(6); PG8_BAR;
    }
    for (;;) {
        const bool has_next = S.next(ui + 1, nxt);
        const char* nA = has_next ? (const char*)g.A + (size_t)nxt.pm * tstep : cA; const char* nB = has_next ? (const char*)g.Bt + (size_t)nxt.pn * tstep : cB;
        for (int t = 0; t < nt; t += 2) {
            const bool last = (t == nt - 2);
            const char* a1 = cA + (size_t)(t + 1) * kstep;
            const char* a2 = last ? nA : cA + (size_t)(t + 2) * kstep; const char* b2 = last ? nB : cB + (size_t)(t + 2) * kstep;
            const char* a3 = a2 + kstep; const char* b3 = b2 + kstep;
            if (last && has_next) S.a_ready(nxt);
            if constexpr (SP2) {
            PG8_LDB(B0, 0, 0); PG8_LDB(B1, 0, 1); PG8_SCHED; PG8_LDA(At, 0, 0); PG8_STAGE(PG8_SA(1, 1), a1 + hstep, voffA);
            PG8_WAIT_V(8); PG8_WAIT_L(0); PG8_BAR; PG8_MMA(0, 0, At, B0); PG8_MMA(0, 1, At, B1); PG8_BAR; PG8_SCHED;
            PG8_LDA(At, 0, 1); PG8_STAGE(PG8_SB(0, 0), b2, voffB); PG8_STAGE(PG8_SB(0, 1), b2 + hstep, voffB); PG8_STAGE(PG8_SA(0, 0), a2, voffA);
            PG8_WAIT_V(8); PG8_WAIT_L(0); PG8_BAR; PG8_MMA(1, 0, At, B0); PG8_MMA(1, 1, At, B1); PG8_BAR; PG8_SCHED;
            PG8_LDB(B0, 1, 0); PG8_LDB(B1, 1, 1); PG8_SCHED; PG8_LDA(At, 1, 0); PG8_STAGE(PG8_SA(0, 1), a2 + hstep, voffA);
            PG8_WAIT_V(8); PG8_WAIT_L(0); PG8_BAR; PG8_MMA(0, 0, At, B0); PG8_MMA(0, 1, At, B1); PG8_BAR; PG8_SCHED;
            PG8_LDA(At, 1, 1); PG8_STAGE(PG8_SB(1, 0), b3, voffB); PG8_STAGE(PG8_SB(1, 1), b3 + hstep, voffB); PG8_STAGE(PG8_SA(1, 0), a3, voffA);
            PG8_WAIT_V(8); PG8_WAIT_L(0); PG8_BAR; PG8_MMA(1, 0, At, B0); PG8_MMA(1, 1, At, B1); PG8_BAR; PG8_SCHED;
            } else {
            PG8_LDB(B0, 0, 0); PG8_SCHED; PG8_LDA(At, 0, 0); PG8_STAGE(PG8_SA(1, 1), a1 + hstep, voffA);
            PG8_WAIT_L(8); PG8_BAR; PG8_WAIT_L(0); PG8_MMA(0, 0, At, B0); PG8_BAR; PG8_SCHED;
            PG8_LDB(B1, 0, 1); PG8_STAGE(PG8_SB(0, 0), b2, voffB);
            PG8_BAR; PG8_WAIT_L(0); PG8_MMA(0, 1, At, B1); PG8_BAR;
            PG8_LDA(At, 0, 1); PG8_STAGE(PG8_SA(0, 0), a2, voffA);
            PG8_BAR; PG8_WAIT_L(0); PG8_MMA(1, 0, At, B0); PG8_BAR; PG8_SCHED;
            PG8_STAGE(PG8_SB(0, 1), b2 + hstep, voffB);
            PG8_WAIT_V(6); PG8_BAR; PG8_MMA(1, 1, At, B1); PG8_BAR;
            PG8_LDB(B0, 1, 0); PG8_SCHED; PG8_LDA(At, 1, 0); PG8_STAGE(PG8_SA(0, 1), a2 + hstep, voffA);
            PG8_WAIT_L(8); PG8_BAR; PG8_WAIT_L(0); PG8_MMA(0, 0, At, B0); PG8_BAR; PG8_SCHED;
            PG8_LDB(B1, 1, 1); PG8_STAGE(PG8_SB(1, 0), b3, voffB);
            PG8_BAR; PG8_WAIT_L(0); PG8_MMA(0, 1, At, B1); PG8_BAR;
            PG8_LDA(At, 1, 1); PG8_STAGE(PG8_SA(1, 0), a3, voffA);
            PG8_BAR; PG8_WAIT_L(0); PG8_MMA(1, 0, At, B0); PG8_BAR; PG8_SCHED;
            PG8_STAGE(PG8_SB(1, 1), b3 + hstep, voffB);
            PG8_WAIT_V(6); PG8_BAR; PG8_MMA(1, 1, At, B1); PG8_BAR;
            }
        }
        if constexpr (ALIGN_EPI) { if (wr == 0) PG8_BAR; }
        if constexpr (!Epi::AFTER_DRAIN) { E(acc, cur, wr, wc, fr, fq); S.done(cur); }
        if (!has_next) break;
#pragma unroll
        for (int a = 0; a < 2; ++a)
#pragma unroll
            for (int b = 0; b < 2; ++b)
#pragma unroll
                for (int m = 0; m < 4; ++m)
#pragma unroll
                    for (int n = 0; n < 2; ++n) acc[a][b][m][n] = (f32x4){0.f, 0.f, 0.f, 0.f};
        cur = nxt; cA = nA; cB = nB; ++ui;
        if constexpr (ALIGN_EPI) { if (wr == 1) PG8_BAR; }
    }
    PG8_WAIT_V(0);
    if constexpr (!ALIGN_EPI) { if (wr == 0) PG8_BAR; }
    PG8_BAR;
    if constexpr (Epi::AFTER_DRAIN) { E.fused(acc, cur, wr, wc, fr, fq, lds, wid, lane); S.done(cur); }
#undef PG8_SA
#undef PG8_SB
#undef PG8_STAGE
#undef PG8_LDA
#undef PG8_LDB
#undef PG8_MMA
#undef PG8_WAIT_V
#undef PG8_WAIT_L
#undef PG8_BAR
#undef PG8_SCHED
}
}


#ifndef PG8_SP2
#define PG8_SP2 true
#endif
#ifndef PG8_ALIGN
#define PG8_ALIGN true
#endif
constexpr int NWAVES = 8;
constexpr int MP = pg8::MP, MS = pg8::MS, MVALID = pg8::MVALID, MT = pg8::MT, DM = 1024, DFF = 2816;
constexpr int SEQ = 4096, NB = 4, NSB = 32, PAST = 8192, NPOOL = 2560;
constexpr int ZC0 = 3328, ZC1 = 2304;
constexpr int Z1_Q = 0, Z1_K = 768, Z1_V = 1024, Z1_IQ = 1280, Z1_IK = 1792, Z1_IW = 1856, Z1_MQ = 1920;
constexpr int NMEMROWS = 1024, MEMROW0 = MT;
constexpr float EPS = 1e-6f;
constexpr size_t MiB = 1u << 20;
constexpr size_t WS_CTL = 0, CTL_ZERO_BYTES = 2 * MiB;
constexpr size_t WS_WIN0 = 2 * MiB, WS_WIN1 = 11 * MiB, WS_WOUT = 16 * MiB, WS_WGU = 20 * MiB, WS_WD = 42 * MiB;
constexpr size_t WS_XB = 54 * MiB, WS_MEMKV = 89 * MiB, WS_MIX = 94 * MiB, WS_Z = 128 * MiB, WS_U = 234 * MiB, WS_UP = 324 * MiB, WS_ACT = 414 * MiB;
constexpr size_t WS_QB = 504 * MiB, WS_KB = 528 * MiB, WS_VB = 536 * MiB, WS_IQB = 544 * MiB, WS_IKB = 560 * MiB, WS_IW = 562 * MiB;
constexpr size_t WS_SQ = 563 * MiB, WS_SIQ = WS_SQ + 512 * 1024, WS_SIW = WS_SIQ + 384 * 1024, WS_SSC = 564 * MiB, WS_SIDX = 569 * MiB, WS_MASK = 570 * MiB, WS_SC = 578 * MiB, WS_END = 834 * MiB;
constexpr int SSC_LD = 8256;
constexpr int CW_TMO = 0, CW_BAR = 4096, CW_Q = 8192, CW_SS = 16384;
constexpr size_t O_YP = 0, O_YS = O_YP + (size_t)MP * DM, O_HP = O_YS + (size_t)MS * DM, O_HS = O_HP + 4 * 6 * 16384, O_KP = O_HS + 32 * 6 * 16384,
    O_VP = O_KP + (size_t)MP * 256, O_IKP = O_VP + (size_t)MP * 256, O_KS = O_IKP + (size_t)MP * 64, O_VS = O_KS + MS * 256, O_IKS = O_VS + MS * 256,
    O_MK = O_IKS + MS * 64, O_MV = O_MK + 2 * 1024 * 256, O_CVP = O_MV + 2 * 1024 * 256, O_CVS = O_CVP + 2 * 4 * 2 * DFF, O_END = O_CVS + 2 * 32 * 2 * DFF;
static_assert(O_END == 31412224, "output size");
constexpr int RING_OFF = 0, RING_BYTES = 131072;
constexpr int LDSCTL_OFF = RING_BYTES, MISC_OFF = LDSCTL_OFF + 320;
constexpr int LDS_BYTES = 147456;

#define GAS __attribute__((address_space(1)))
#define LAS __attribute__((address_space(3)))
typedef unsigned short bf16;
typedef unsigned v4u __attribute__((ext_vector_type(4)));
typedef float f32x4 __attribute__((ext_vector_type(4)));
typedef short bf16x8 __attribute__((ext_vector_type(8)));
typedef GAS unsigned gu32;
typedef GAS unsigned long long gu64;
#define RLX_AGENT __ATOMIC_RELAXED, __HIP_MEMORY_SCOPE_AGENT
#define LDS_WAIT() asm volatile("s_waitcnt lgkmcnt(0)" ::: "memory")
#define VM_WAIT() asm volatile("s_waitcnt vmcnt(0)" ::: "memory")
__device__ __forceinline__ unsigned long long rt() { return __builtin_amdgcn_s_memrealtime(); }
__device__ __forceinline__ unsigned f2bf(float f) { unsigned u = __builtin_bit_cast(unsigned, f); return (u + 0x7fffu + ((u >> 16) & 1u)) >> 16; }
__device__ __forceinline__ unsigned pk2(float lo, float hi) { return f2bf(lo) | (f2bf(hi) << 16); }

#define XB_TMO      128
#define XB_XCNT(j)  (256  + 64 * (j))
#define XB_XSUB(j)  (1280 + 64 * (j))
#define XB_XGEN(j)  (2304 + 64 * (j))
#define XB_TOP      3328
#define XB_TOPGEN   3392
#define XCD_BAR_WORDS 3456
#define XB_SPIN_CAP (1u << 18)

__device__ __forceinline__ unsigned xb_ld(unsigned* p)              { return __hip_atomic_load(p, __ATOMIC_RELAXED, __HIP_MEMORY_SCOPE_AGENT); }
__device__ __forceinline__ unsigned xb_add(unsigned* p, unsigned v) { return __hip_atomic_fetch_add(p, v, __ATOMIC_RELAXED, __HIP_MEMORY_SCOPE_AGENT); }
__device__ __forceinline__ unsigned xb_xcc_id() { return (unsigned)__builtin_amdgcn_s_getreg((3 << 11) | 20) & 0xFu; }
#define XB_SPIN(cond, bar) do { unsigned _sp = 0; while (cond) { __builtin_amdgcn_s_sleep(1); \
    if ((++_sp & 255u) == 0u) { if (xb_ld(&(bar)[XB_TMO])) break; if (_sp > XB_SPIN_CAP) { atomicAdd(&(bar)[XB_TMO], 1u); break; } } } } while (0)

struct XcdBarrier {
    unsigned* bar; unsigned x;
    volatile LAS unsigned* st;
};

__device__ __forceinline__ XcdBarrier xcd_barrier_post(unsigned* bar, volatile LAS unsigned* st) {
    XcdBarrier b; b.bar = bar; b.x = xb_xcc_id(); b.st = st;
    if (threadIdx.x == 0) (void)xb_add(&bar[XB_XCNT(b.x)], 1u);
    return b;
}
__device__ __forceinline__ void xcd_barrier_complete(unsigned* bar, unsigned x, unsigned& nloc, unsigned& nx) {
    const unsigned G = gridDim.x * gridDim.y * gridDim.z;
    unsigned sum, cnt, mine, sp = 0u;
    for (;;) {
        sum = 0u; cnt = 0u; mine = 0u;
#pragma unroll
        for (unsigned j = 0; j < 16; ++j) { const unsigned c = xb_ld(&bar[XB_XCNT(j)]); sum += c; cnt += (c > 0u) ? 1u : 0u; mine = (j == x) ? c : mine; }
        if (sum == G) break;
        __builtin_amdgcn_s_sleep(1);
        if ((++sp & 255u) == 0u) { if (xb_ld(&bar[XB_TMO])) break; if (sp > XB_SPIN_CAP) { atomicAdd(&bar[XB_TMO], 1u); break; } }
    }
    nloc = mine > 0u ? mine : 1u; nx = cnt > 0u ? cnt : 1u;
}

__device__ __forceinline__ void xcd_barrier(const XcdBarrier& b) {
    asm volatile("s_waitcnt vmcnt(0)" ::: "memory");
    __syncthreads();
    if (threadIdx.x == 0) {
        unsigned* bar = b.bar;
        __builtin_amdgcn_s_waitcnt(0);
        unsigned nloc = b.st[0], nx = b.st[1];
        if (nloc == 0u) { xcd_barrier_complete(bar, b.x, nloc, nx); b.st[0] = nloc; b.st[1] = nx; }
        const unsigned old = xb_add(&bar[XB_XSUB(b.x)], 1u);
        const unsigned gen = old / nloc;
        if (old + 1u == (gen + 1u) * nloc) {
            __builtin_amdgcn_fence(__ATOMIC_RELEASE, "agent");
            asm volatile("s_waitcnt vmcnt(0)" ::: "memory");
            const unsigned og = xb_add(&bar[XB_TOP], 1u);
            const unsigned tg = og / nx;
            if (og + 1u == (tg + 1u) * nx) xb_add(&bar[XB_TOPGEN], 1u);
            else XB_SPIN(xb_ld(&bar[XB_TOPGEN]) == tg, bar);
            __builtin_amdgcn_fence(__ATOMIC_ACQUIRE, "agent");
            xb_add(&bar[XB_XGEN(b.x)], 1u);
            asm volatile("s_waitcnt vmcnt(0)" ::: "memory");
        } else {
            XB_SPIN(xb_ld(&bar[XB_XGEN(b.x)]) == gen, bar);
            __builtin_amdgcn_fence(__ATOMIC_ACQUIRE, "agent");
            asm volatile("s_waitcnt vmcnt(0)" ::: "memory");
        }
    }
    __syncthreads();
}


struct Args { const float* in[29]; const int* page_table; float* out; unsigned char* ws; int ph_lo, ph_hi; };
struct Ctx { LAS unsigned char* lds; volatile LAS unsigned* MISC; gu32* ctl; int tid, lane, wave, vcu, G, qoff; };
typedef float f32x16 __attribute__((ext_vector_type(16)));
typedef unsigned long long u64;

__device__ __forceinline__ float bf2f(unsigned b) { return __builtin_bit_cast(float, b << 16); }
__device__ __forceinline__ float wave_sum(float v) {
#pragma unroll
    for (int o = 1; o < 64; o <<= 1) v += __shfl_xor(v, o);
    return v;
}
__device__ __forceinline__ int crow(int r, int hi) { return (r & 3) + 8 * (r >> 2) + 4 * hi; }
__device__ __forceinline__ float sigmoidf_(float x) { return 1.0f / (1.0f + __expf(-x)); }
__device__ __forceinline__ float* ssptr(const Ctx& c, int i) { return (float*)(c.ctl + CW_SS) + (size_t)i * MT; }

__device__ __forceinline__ int q_next(Ctx& c, int qi) {
    __syncthreads();
    if (c.tid == 0) c.MISC[16] = atomicAdd((unsigned*)(c.ctl + CW_Q + 64 * (qi + c.qoff)), 1u);
    __syncthreads();
    return (int)c.MISC[16];
}

template <int K>
__device__ __forceinline__ f32x16 mm32(const LAS bf16* A, int lda, const LAS bf16* Bt, int ldb, f32x16 acc, int lane) {
    const int r = lane & 31, h = lane >> 5;
#pragma unroll
    for (int ks = 0; ks < K; ks += 16) {
        const bf16x8 a = *(const LAS bf16x8*)(A + r * lda + ks + 8 * h);
        const bf16x8 b = *(const LAS bf16x8*)(Bt + r * ldb + ks + 8 * h);
        acc = __builtin_amdgcn_mfma_f32_32x32x16_bf16(a, b, acc, 0, 0, 0);
    }
    return acc;
}

__device__ __forceinline__ int map_row(int mapid, int n, int row_off) {
    if (mapid == 0) return n + row_off;
    if (mapid == 1) return n < 1864 ? n : n + 56;
    if (mapid == 2) return (n >> 7) * 256 + (n & 127);
    return (n >> 7) * 256 + 128 + (n & 127);
}
__device__ __forceinline__ void transpose_item(const float* W, int K, int N, const float* kscale, bf16* WT, int mapid, int row_off, LAS float* scr, int item, int lane) {
    const int nblk = (N + 31) / 32, kb = item / nblk, nb = item % nblk, k0 = 64 * kb, n0 = 32 * nb;
#pragma unroll 8
    for (int i = 0; i < 32; ++i) { const int kk = 2 * i + (lane >> 5), n = n0 + (lane & 31);
        float v = n < N ? W[(size_t)(k0 + kk) * N + n] : 0.f; if (kscale) v *= kscale[k0 + kk];
        scr[kk * 33 + (lane & 31)] = v; }
    LDS_WAIT(); asm volatile("" ::: "memory");
    const int cc = lane & 7;
#pragma unroll
    for (int j = 0; j < 4; ++j) { const int nl = (lane >> 3) + 8 * j, n = n0 + nl; const LAS float* s = scr + (8 * cc) * 33 + nl;
        v4u o; o.x = pk2(s[0 * 33], s[1 * 33]); o.y = pk2(s[2 * 33], s[3 * 33]); o.z = pk2(s[4 * 33], s[5 * 33]); o.w = pk2(s[6 * 33], s[7 * 33]);
        if (n < N) *(GAS v4u*)(WT + (size_t)map_row(mapid, n, row_off) * K + k0 + 8 * cc) = o; }
    LDS_WAIT(); asm volatile("" ::: "memory");
}
__device__ __forceinline__ void p0_prologue(Ctx& c, const Args& a) {
    LAS float* scr = (LAS float*)(c.lds + RING_OFF + c.wave * 16384);
    const int gw = c.vcu * NWAVES + c.wave, NGW = c.G * NWAVES, lane = c.lane;
    unsigned char* ws = a.ws;
    constexpr int I_INH = 16 * 104, I_MKV = 16 * 16, I_DSA = 16 * 67, I_OUT = 16 * 32, I_G = 16 * 88, I_D = 44 * 32;
    constexpr int NITEMS = I_INH + 2 * I_MKV + I_DSA + 2 * I_OUT + 4 * I_G + 2 * I_D;
    for (int it = gw; it < NITEMS; it += NGW) {
        int r = it;
        if (r < I_INH) { transpose_item(a.in[13], 1024, 3328, a.in[11], (bf16*)(ws + WS_WIN0), 0, 0, scr, r, lane); continue; } r -= I_INH;
        if (r < I_MKV) { transpose_item(a.in[20], 1024, 512, nullptr, (bf16*)(ws + WS_WIN0), 0, 3328, scr, r, lane); continue; } r -= I_MKV;
        if (r < I_MKV) { transpose_item(a.in[20] + 1024 * 512, 1024, 512, nullptr, (bf16*)(ws + WS_WIN0), 0, 3840, scr, r, lane); continue; } r -= I_MKV;
        if (r < I_DSA) { transpose_item(a.in[16], 1024, 2120, a.in[11] + 1024, (bf16*)(ws + WS_WIN1), 1, 0, scr, r, lane); continue; } r -= I_DSA;
        if (r < 2 * I_OUT) { const int l = r / I_OUT; transpose_item(a.in[23] + (size_t)l * 1024 * 1024, 1024, 1024, nullptr, (bf16*)(ws + WS_WOUT) + (size_t)l * 1024 * 1024, 0, 0, scr, r % I_OUT, lane); continue; } r -= 2 * I_OUT;
        if (r < 2 * I_G) { const int l = r / I_G; transpose_item(a.in[24] + (size_t)l * 1024 * DFF, 1024, DFF, a.in[12] + l * 1024, (bf16*)(ws + WS_WGU) + (size_t)l * 5632 * 1024, 2, 0, scr, r % I_G, lane); continue; } r -= 2 * I_G;
        if (r < 2 * I_G) { const int l = r / I_G; transpose_item(a.in[25] + (size_t)l * 1024 * DFF, 1024, DFF, a.in[12] + l * 1024, (bf16*)(ws + WS_WGU) + (size_t)l * 5632 * 1024, 3, 0, scr, r % I_G, lane); continue; } r -= 2 * I_G;
        { const int l = r / I_D; transpose_item(a.in[28] + (size_t)l * DFF * 1024, DFF, 1024, nullptr, (bf16*)(ws + WS_WD) + (size_t)l * 1024 * DFF, 0, 0, scr, r % I_D, lane); }
    }
    for (int rr = gw; rr < 184; rr += NGW) { const int row = rr < 56 ? 1864 + rr : 2176 + (rr - 56);
        GAS v4u* p = (GAS v4u*)((bf16*)(ws + WS_WIN1) + (size_t)row * 1024); p[lane] = (v4u){0u, 0u, 0u, 0u}; p[64 + lane] = (v4u){0u, 0u, 0u, 0u}; }
    float* ss0 = ssptr(c, 0);
    for (int m = gw; m < MT + NMEMROWS; m += NGW) {
        GAS u64* o8 = (GAS u64*)((bf16*)(ws + WS_XB) + (size_t)m * DM) + lane;
        if (m >= MVALID && m < MT) {
#pragma unroll
            for (int j = 0; j < 4; ++j) o8[64 * j] = 0ull;
            continue; }
        const float* src = m < MP ? a.in[0] + (size_t)m * DM : (m < MVALID ? a.in[1] + (size_t)(m - MP) * DM : a.in[10] + (size_t)(m - MT) * DM);
        const GAS f32x4* xr = (const GAS f32x4*)src + lane; f32x4 v[4]; float s = 0.f;
#pragma unroll
        for (int j = 0; j < 4; ++j) { v[j] = xr[64 * j]; s += (v[j].x * v[j].x + v[j].y * v[j].y) + (v[j].z * v[j].z + v[j].w * v[j].w); }
        s = wave_sum(s);
#pragma unroll
        for (int j = 0; j < 4; ++j) o8[64 * j] = (u64)pk2(v[j].x, v[j].y) | ((u64)pk2(v[j].z, v[j].w) << 32);
        if (m < MVALID && lane == 0) ss0[m] = s;
    }
}

__device__ __forceinline__ void memattn_unit(Ctx& c, const bf16* Zq  , int ldz, int nrows_valid, const float* Kp, const float* Vp, int kstride,
                                             bool normk, const float* kgain, const float* qgain, bf16* Out  ) {
    LAS bf16* KN = (LAS bf16*)(c.lds);
    LAS bf16* VTm = (LAS bf16*)(c.lds + 36864);
    LAS bf16* QN = (LAS bf16*)(c.lds + 70656) + c.wave * (32 * 72);
    LAS float* LI = (LAS float*)(c.lds + 107520) + c.wave * 32;
    int tid = c.tid; asm volatile("" : "+v"(tid));
    const int lane = tid & 63, w = c.wave;
    {
        const int m = tid >> 1, dh = (tid & 1) * 32;
        f32x4 kv[8]; float s = 0.f;
#pragma unroll
        for (int j = 0; j < 8; ++j) { kv[j] = *(const f32x4*)(Kp + (size_t)m * kstride + dh + 4 * j); s += (kv[j].x * kv[j].x + kv[j].y * kv[j].y) + (kv[j].z * kv[j].z + kv[j].w * kv[j].w); }
        s += __shfl_xor(s, 1);
        const float rs = normk ? rsqrtf(s * (1.0f / 64.0f) + EPS) : 1.0f;
#pragma unroll
        for (int j = 0; j < 8; j += 2) { f32x4 g0 = {1.f, 1.f, 1.f, 1.f}, g1 = g0;
            if (normk) { g0 = *(const f32x4*)(kgain + dh + 4 * j); g1 = *(const f32x4*)(kgain + dh + 4 * j + 4); }
            const f32x4 x0 = kv[j] * rs * g0, x1 = kv[j + 1] * rs * g1;
            v4u o; o.x = pk2(x0.x, x0.y); o.y = pk2(x0.z, x0.w); o.z = pk2(x1.x, x1.y); o.w = pk2(x1.z, x1.w);
            *(LAS v4u*)(KN + m * 72 + dh + 4 * j) = o; }
#pragma unroll
        for (int j = 0; j < 8; ++j) { const f32x4 vv = *(const f32x4*)(Vp + (size_t)m * kstride + dh + 4 * j);
            VTm[(dh + 4 * j + 0) * 264 + m] = (bf16)f2bf(vv.x); VTm[(dh + 4 * j + 1) * 264 + m] = (bf16)f2bf(vv.y);
            VTm[(dh + 4 * j + 2) * 264 + m] = (bf16)f2bf(vv.z); VTm[(dh + 4 * j + 3) * 264 + m] = (bf16)f2bf(vv.w); }
    }
    {
        const int row = lane >> 1, hf = lane & 1, grow = w * 32 + row;
        float x[32]; float s = 0.f;
        if (grow < nrows_valid) {
#pragma unroll
            for (int j = 0; j < 4; ++j) { const v4u q = *(const v4u*)(Zq + (size_t)grow * ldz + hf * 32 + 8 * j);
                x[8 * j + 0] = bf2f(q.x & 0xffffu); x[8 * j + 1] = bf2f(q.x >> 16); x[8 * j + 2] = bf2f(q.y & 0xffffu); x[8 * j + 3] = bf2f(q.y >> 16);
                x[8 * j + 4] = bf2f(q.z & 0xffffu); x[8 * j + 5] = bf2f(q.z >> 16); x[8 * j + 6] = bf2f(q.w & 0xffffu); x[8 * j + 7] = bf2f(q.w >> 16); }
        } else {
#pragma unroll
            for (int j = 0; j < 32; ++j) x[j] = 0.f;
        }
#pragma unroll
        for (int j = 0; j < 32; ++j) s += x[j] * x[j];
        s += __shfl_xor(s, 1);
        const float rs = rsqrtf(s * (1.0f / 64.0f) + EPS) * 0.125f;
#pragma unroll
        for (int j = 0; j < 32; j += 8) { v4u o;
            o.x = pk2(x[j] * rs * qgain[hf * 32 + j], x[j + 1] * rs * qgain[hf * 32 + j + 1]); o.y = pk2(x[j + 2] * rs * qgain[hf * 32 + j + 2], x[j + 3] * rs * qgain[hf * 32 + j + 3]);
            o.z = pk2(x[j + 4] * rs * qgain[hf * 32 + j + 4], x[j + 5] * rs * qgain[hf * 32 + j + 5]); o.w = pk2(x[j + 6] * rs * qgain[hf * 32 + j + 6], x[j + 7] * rs * qgain[hf * 32 + j + 7]);
            *(LAS v4u*)(QN + row * 72 + hf * 32 + j) = o; }
    }
    __syncthreads();
    if (w * 32 < nrows_valid) {
        const int r32 = lane & 31, hh = lane >> 5;
        f32x16 s[8];
#pragma unroll
        for (int mt = 0; mt < 8; ++mt) { f32x16 z = {}; s[mt] = mm32<64>(KN + mt * 32 * 72, 72, QN, 72, z, lane); }
        float mx = -1e30f;
#pragma unroll
        for (int mt = 0; mt < 8; ++mt)
#pragma unroll
            for (int r = 0; r < 16; ++r) mx = fmaxf(mx, s[mt][r]);
        mx = fmaxf(mx, __shfl_xor(mx, 32));
        float l = 0.f;
#pragma unroll
        for (int mt = 0; mt < 8; ++mt)
#pragma unroll
            for (int r = 0; r < 16; ++r) { const float p = __expf(s[mt][r] - mx); s[mt][r] = p; l += p; }
        l += __shfl_xor(l, 32);
        if (hh == 0) LI[r32] = l;
        f32x16 o[2] = {};
#pragma unroll
        for (int mt = 0; mt < 8; ++mt)
#pragma unroll
            for (int sx = 0; sx < 2; ++sx) {
                v4u pa; pa.x = pk2(s[mt][8 * sx + 0], s[mt][8 * sx + 1]); pa.y = pk2(s[mt][8 * sx + 2], s[mt][8 * sx + 3]);
                pa.z = pk2(s[mt][8 * sx + 4], s[mt][8 * sx + 5]); pa.w = pk2(s[mt][8 * sx + 6], s[mt][8 * sx + 7]);
                const bf16x8 af = __builtin_bit_cast(bf16x8, pa);
#pragma unroll
                for (int dt = 0; dt < 2; ++dt) { const LAS bf16* vp = VTm + (dt * 32 + r32) * 264 + mt * 32 + 16 * sx + 4 * hh;
                    const u64 lo = *(const LAS u64*)vp, hi = *(const LAS u64*)(vp + 8);
                    v4u bw; bw.x = (unsigned)lo; bw.y = (unsigned)(lo >> 32); bw.z = (unsigned)hi; bw.w = (unsigned)(hi >> 32);
                    o[dt] = __builtin_amdgcn_mfma_f32_32x32x16_bf16(af, __builtin_bit_cast(bf16x8, bw), o[dt], 0, 0, 0); }
            }
        LDS_WAIT();
#pragma unroll
        for (int r = 0; r < 16; ++r) { const int qr = crow(r, hh), grow = w * 32 + qr; const float il = 1.0f / LI[qr];
            if (grow < nrows_valid) {
#pragma unroll
                for (int dt = 0; dt < 2; ++dt) Out[(size_t)grow * DM + dt * 32 + r32] = (bf16)f2bf(o[dt][r] * il); } }
    }
}

__device__ __forceinline__ void hgrn_unit(Ctx& c, const Args& a, bool sample, int b, int h) {
    LAS unsigned char* L = c.lds;
    LAS float* LF = (LAS float*)(L + 0);
    LAS float* BL = (LAS float*)(L + 16384);
    LAS float* DVv = (LAS float*)(L + 16896);
    LAS bf16* QD = (LAS bf16*)(L + 17408);
    LAS bf16* KD = (LAS bf16*)(L + 26112);
    LAS bf16* KET = (LAS bf16*)(L + 34816);
    LAS bf16* VT = (LAS bf16*)(L + 45056);
    LAS bf16* SCB = (LAS bf16*)(L + 55296);
    LAS bf16* STt = (LAS bf16*)(L + 57856);
    int tid = c.tid; asm volatile("" : "+v"(tid));
    const int lane = tid & 63, w = c.wave, r32 = lane & 31, hh = lane >> 5;
    const int te = tid >> 4, k8 = (tid & 15) * 8;
    const bf16* Z = (const bf16*)(a.ws + WS_Z);
    bf16* MIX = (bf16*)(a.ws + WS_MIX);
    const int nch = sample ? 1 : 128, nvalid = sample ? 4 : 32;
    const int kt = w >> 1, vt0 = 2 * (w & 1);
    f32x16 S0 = {}, S1 = {};
    if (sample) { const float* sp = a.in[7] + (size_t)(b * 6 + h) * 16384;
#pragma unroll
        for (int r = 0; r < 16; ++r) { const int k = 32 * kt + crow(r, hh); S0[r] = sp[k * 128 + 32 * vt0 + r32]; S1[r] = sp[k * 128 + 32 * (vt0 + 1) + r32]; } }
    float lbv[8], onv[8];
#pragma unroll
    for (int j = 0; j < 8; ++j) { const float l0 = a.in[14][h * 128 + k8 + j], l1 = a.in[14][768 + h * 128 + k8 + j]; lbv[j] = 1.0f / (1.0f + __expf(l1 - l0)); onv[j] = a.in[15][k8 + j]; }
    __syncthreads();
#define HG_WRITE_ST() do { _Pragma("unroll") for (int g = 0; g < 4; ++g) { const int k0 = 32 * kt + 8 * g + 4 * hh; \
        *(LAS u64*)(STt + (32 * vt0 + r32) * 136 + k0) = (u64)pk2(S0[4 * g], S0[4 * g + 1]) | ((u64)pk2(S0[4 * g + 2], S0[4 * g + 3]) << 32); \
        *(LAS u64*)(STt + (32 * (vt0 + 1) + r32) * 136 + k0) = (u64)pk2(S1[4 * g], S1[4 * g + 1]) | ((u64)pk2(S1[4 * g + 2], S1[4 * g + 3]) << 32); } } while (0)
    HG_WRITE_ST();
    for (int ch = 0; ch < nch; ++ch) {
        const int row0 = sample ? MP + 4 * b : b * SEQ + 32 * ch, row = row0 + te;
        const bool valid = te < nvalid;
        float qs[8], kk[8]; v4u gz = {0u, 0u, 0u, 0u};
        {
            v4u zq = {0u, 0u, 0u, 0u}, zf = zq, zi = zq;
            if (valid) { const bf16* zr = Z + (size_t)row * ZC0 + h * 128 + k8;
                zq = *(const v4u*)zr; zf = *(const v4u*)(zr + 768); zi = *(const v4u*)(zr + 1536); gz = *(const v4u*)(zr + 2304); }
            const unsigned qw[4] = {zq.x, zq.y, zq.z, zq.w}, fw[4] = {zf.x, zf.y, zf.z, zf.w}, iw[4] = {zi.x, zi.y, zi.z, zi.w};
            float lf[8];
#pragma unroll
            for (int j = 0; j < 8; ++j) { const float q = bf2f((qw[j >> 1] >> (16 * (j & 1))) & 0xffffu), fp = bf2f((fw[j >> 1] >> (16 * (j & 1))) & 0xffffu);
                const float sg = sigmoidf_(fp), f = lbv[j] + (1.0f - lbv[j]) * sg;
                qs[j] = valid ? q * sigmoidf_(q) : 0.f; kk[j] = valid ? (1.0f - f) : 0.f; lf[j] = valid ? __logf(f) : 0.f;
                VT[(k8 + j) * 40 + te] = (bf16)((iw[j >> 1] >> (16 * (j & 1))) & 0xffffu); }
            *(LAS f32x4*)(LF + te * 128 + k8) = (f32x4){lf[0], lf[1], lf[2], lf[3]}; *(LAS f32x4*)(LF + te * 128 + k8 + 4) = (f32x4){lf[4], lf[5], lf[6], lf[7]};
        }
        __syncthreads();
        if (tid < 128) { float bsum = 0.f;
#pragma unroll
            for (int t = 0; t < 32; ++t) { bsum += LF[t * 128 + tid]; LF[t * 128 + tid] = bsum; }
            BL[tid] = bsum; }
        __syncthreads();
        {
            const f32x4 b0 = *(const LAS f32x4*)(LF + te * 128 + k8), b1 = *(const LAS f32x4*)(LF + te * 128 + k8 + 4);
            const f32x4 l0 = *(const LAS f32x4*)(BL + k8), l1 = *(const LAS f32x4*)(BL + k8 + 4);
            const float bb[8] = {b0.x, b0.y, b0.z, b0.w, b1.x, b1.y, b1.z, b1.w}, bl[8] = {l0.x, l0.y, l0.z, l0.w, l1.x, l1.y, l1.z, l1.w};
            float qd[8], kd[8];
#pragma unroll
            for (int j = 0; j < 8; ++j) { qd[j] = qs[j] * __expf(bb[j]); kd[j] = kk[j] * __expf(-bb[j]); KET[(k8 + j) * 40 + te] = (bf16)f2bf(kk[j] * __expf(bl[j] - bb[j])); }
            v4u o; o.x = pk2(qd[0], qd[1]); o.y = pk2(qd[2], qd[3]); o.z = pk2(qd[4], qd[5]); o.w = pk2(qd[6], qd[7]); *(LAS v4u*)(QD + te * 136 + k8) = o;
            o.x = pk2(kd[0], kd[1]); o.y = pk2(kd[2], kd[3]); o.z = pk2(kd[4], kd[5]); o.w = pk2(kd[6], kd[7]); *(LAS v4u*)(KD + te * 136 + k8) = o;
            if (te == 0) {
#pragma unroll
                for (int j = 0; j < 8; ++j) DVv[k8 + j] = __expf(bl[j]); }
        }
        __syncthreads();
        f32x16 oacc = {};
        if (w == 0) { f32x16 z = {}; const f32x16 sc = mm32<128>(QD, 136, KD, 136, z, lane);
#pragma unroll
            for (int r = 0; r < 16; ++r) { const int t = crow(r, hh); SCB[t * 40 + r32] = (bf16)f2bf(r32 <= t ? sc[r] : 0.f); } }
        if (w < 4) oacc = mm32<128>(QD, 136, STt + (w * 32) * 136, 136, oacc, lane);
        __syncthreads();
        if (w < 4) { oacc = mm32<32>(SCB, 40, VT + (w * 32) * 40, 40, oacc, lane);
#pragma unroll
            for (int r = 0; r < 16; ++r) LF[crow(r, hh) * 128 + w * 32 + r32] = oacc[r]; }
        {
#pragma unroll
            for (int r = 0; r < 16; ++r) { const float d = DVv[32 * kt + crow(r, hh)]; S0[r] *= d; S1[r] *= d; }
            S0 = mm32<32>(KET + (kt * 32) * 40, 40, VT + (vt0 * 32) * 40, 40, S0, lane);
            S1 = mm32<32>(KET + (kt * 32) * 40, 40, VT + ((vt0 + 1) * 32) * 40, 40, S1, lane);
        }
        __syncthreads();
        HG_WRITE_ST();
        {
            const f32x4 o0 = *(const LAS f32x4*)(LF + te * 128 + k8), o1 = *(const LAS f32x4*)(LF + te * 128 + k8 + 4);
            float ov[8] = {o0.x, o0.y, o0.z, o0.w, o1.x, o1.y, o1.z, o1.w}; float s = 0.f;
#pragma unroll
            for (int j = 0; j < 8; ++j) s += ov[j] * ov[j];
            s += __shfl_xor(s, 1); s += __shfl_xor(s, 2); s += __shfl_xor(s, 4); s += __shfl_xor(s, 8);
            const float rs = rsqrtf(s * (1.0f / 128.0f) + EPS);
            const unsigned gw_[4] = {gz.x, gz.y, gz.z, gz.w}; float y[8];
#pragma unroll
            for (int j = 0; j < 8; ++j) { const float g = bf2f((gw_[j >> 1] >> (16 * (j & 1))) & 0xffffu); y[j] = ov[j] * rs * onv[j] * (g * sigmoidf_(g)); }
            if (valid) { v4u o; o.x = pk2(y[0], y[1]); o.y = pk2(y[2], y[3]); o.z = pk2(y[4], y[5]); o.w = pk2(y[6], y[7]); *(v4u*)(MIX + (size_t)row * DM + h * 128 + k8) = o; }
        }
        __syncthreads();
    }
#undef HG_WRITE_ST
    float* so = a.out + (sample ? O_HS : O_HP) + (size_t)(b * 6 + h) * 16384;
#pragma unroll
    for (int r = 0; r < 16; ++r) { const int k = 32 * kt + crow(r, hh); so[k * 128 + 32 * vt0 + r32] = S0[r]; so[k * 128 + 32 * (vt0 + 1) + r32] = S1[r]; }
}

__device__ __forceinline__ void memkv_finalize_row(const Args& a, int layer, int row, int lane) {
    const float* src = (const float*)(a.ws + WS_MEMKV) + (size_t)row * 1024 + layer * 512;
    const int hd = lane >> 4, d4 = (lane & 15) * 4;
    const f32x4 k = *(const f32x4*)(src + hd * 64 + d4), v = *(const f32x4*)(src + 256 + hd * 64 + d4);
    float s = (k.x * k.x + k.y * k.y) + (k.z * k.z + k.w * k.w);
    s += __shfl_xor(s, 1); s += __shfl_xor(s, 2); s += __shfl_xor(s, 4); s += __shfl_xor(s, 8);
    const float rs = rsqrtf(s * (1.0f / 64.0f) + EPS); const f32x4 g = *(const f32x4*)(a.in[22] + layer * 64 + d4);
    *(f32x4*)(a.out + O_MK + ((size_t)layer * 1024 + row) * 256 + hd * 64 + d4) = k * rs * g;
    *(f32x4*)(a.out + O_MV + ((size_t)layer * 1024 + row) * 256 + hd * 64 + d4) = v;
}

__device__ __forceinline__ void memattn_prompt_unit(Ctx& c, const Args& a, int layer, int u) {
    const int blk = u & 15, hd = (u >> 4) & 3, b = u >> 6;
    const bf16* Z = (const bf16*)(a.ws + WS_Z); const int ldz = layer ? ZC1 : ZC0, qc = layer ? Z1_MQ : 3072;
    const float* kv = (const float*)(a.ws + WS_MEMKV) + (size_t)(b * 256) * 1024 + layer * 512 + hd * 64;
    const int row0 = b * SEQ + blk * 256;
    memattn_unit(c, Z + (size_t)row0 * ldz + qc + hd * 64, ldz, 256, kv, kv + 256, 1024, true, a.in[22] + layer * 64, a.in[21] + layer * 64,
                 (bf16*)(a.ws + WS_MIX) + (size_t)row0 * DM + 768 + hd * 64);
}
__device__ __forceinline__ void memattn_sample_unit(Ctx& c, const Args& a, int layer, int u) {
    const int hd = u & 3, sb = u >> 2;
    const bf16* Z = (const bf16*)(a.ws + WS_Z); const int ldz = layer ? ZC1 : ZC0, qc = layer ? Z1_MQ : 3072;
    const size_t off = ((size_t)(layer * 32 + sb) * 256) * 256 + hd * 64;
    const int row0 = MP + sb * 4;
    memattn_unit(c, Z + (size_t)row0 * ldz + qc + hd * 64, ldz, 4, a.in[5] + off, a.in[6] + off, 256, false, nullptr, a.in[21] + layer * 64,
                 (bf16*)(a.ws + WS_MIX) + (size_t)row0 * DM + 768 + hd * 64);
}

__device__ __forceinline__ void p2_mixer0(Ctx& c, const Args& a) {
    constexpr int U_HP = 24, U_MAP = U_HP + 256, U_HS = U_MAP + 192, U_MAS = U_HS + 128, U_FIN = U_MAS + 256;
    for (;;) {
        const int u = q_next(c, 0);
        if (u >= U_FIN) break;
        if (u < U_HP) hgrn_unit(c, a, false, u / 6, u % 6);
        else if (u < U_MAP) memattn_prompt_unit(c, a, 0, u - U_HP);
        else if (u < U_HS) { const int v = u - U_MAP; hgrn_unit(c, a, true, v / 6, v % 6); }
        else if (u < U_MAS) memattn_sample_unit(c, a, 0, u - U_HS);
        else { const int v = (u - U_MAS) * 8 + c.wave; memkv_finalize_row(a, v >> 10, v & 1023, c.lane); }
    }
}

__device__ __forceinline__ void p5_convact(Ctx& c, const Args& a, int layer) {
    const bf16* U = (const bf16*)(a.ws + WS_U); const bf16* UP = (const bf16*)(a.ws + WS_UP); bf16* ACT = (bf16*)(a.ws + WS_ACT);
    const float* cw = a.in[26] + (size_t)layer * 3 * DFF; const float* cb = a.in[27] + (size_t)layer * DFF; const float* cst = a.in[8] + (size_t)layer * 32 * 2 * DFF;
    constexpr int CPR = DFF / 8;
    const long total = (long)MVALID * CPR;
    for (long i = (long)c.vcu * 512 + c.tid; i < total; i += (long)c.G * 512) {
        const int row = (int)(i / CPR), c8 = (int)(i % CPR) * 8;
        int t, sb = 0; const bool smp = row >= MP; if (smp) { t = (row - MP) & 3; sb = (row - MP) >> 2; } else t = row & 4095;
        float u0[8], u1[8], u2[8], up[8];
        { const v4u x = *(const v4u*)(U + (size_t)row * DFF + c8); const unsigned xw[4] = {x.x, x.y, x.z, x.w};
#pragma unroll
          for (int j = 0; j < 8; ++j) u2[j] = bf2f((xw[j >> 1] >> (16 * (j & 1))) & 0xffffu); }
        { const v4u x = *(const v4u*)(UP + (size_t)row * DFF + c8); const unsigned xw[4] = {x.x, x.y, x.z, x.w};
#pragma unroll
          for (int j = 0; j < 8; ++j) up[j] = bf2f((xw[j >> 1] >> (16 * (j & 1))) & 0xffffu); }
        if (t >= 1) { const v4u x = *(const v4u*)(U + (size_t)(row - 1) * DFF + c8); const unsigned xw[4] = {x.x, x.y, x.z, x.w};
#pragma unroll
            for (int j = 0; j < 8; ++j) u1[j] = bf2f((xw[j >> 1] >> (16 * (j & 1))) & 0xffffu); }
        else {
#pragma unroll
            for (int j = 0; j < 8; ++j) u1[j] = smp ? cst[(size_t)(sb * 2 + 1) * DFF + c8 + j] : 0.f; }
        if (t >= 2) { const v4u x = *(const v4u*)(U + (size_t)(row - 2) * DFF + c8); const unsigned xw[4] = {x.x, x.y, x.z, x.w};
#pragma unroll
            for (int j = 0; j < 8; ++j) u0[j] = bf2f((xw[j >> 1] >> (16 * (j & 1))) & 0xffffu); }
        else {
#pragma unroll
            for (int j = 0; j < 8; ++j) u0[j] = smp ? cst[(size_t)(sb * 2 + t) * DFF + c8 + j] : 0.f; }
        float y[8];
#pragma unroll
        for (int j = 0; j < 8; ++j) { const float cv = cb[c8 + j] + cw[c8 + j] * u0[j] + cw[DFF + c8 + j] * u1[j] + cw[2 * DFF + c8 + j] * u2[j]; y[j] = cv * sigmoidf_(cv) * up[j]; }
        v4u o; o.x = pk2(y[0], y[1]); o.y = pk2(y[2], y[3]); o.z = pk2(y[4], y[5]); o.w = pk2(y[6], y[7]);
        *(v4u*)(ACT + (size_t)row * DFF + c8) = o;
    }
    for (long i = (long)c.vcu * 512 + c.tid; i < (long)(MT - MVALID) * CPR; i += (long)c.G * 512)
        *(v4u*)(ACT + (size_t)(MVALID + i / CPR) * DFF + (i % CPR) * 8) = (v4u){0u, 0u, 0u, 0u};
}


__device__ __forceinline__ void dsa_post_row(const Args& a, int row, int lane) {
    const bf16* z = (const bf16*)(a.ws + WS_Z) + (size_t)row * ZC1;
    const bool smp = row >= MP; const int b = smp ? (row - MP) >> 2 : row >> 12, t = smp ? (row - MP) & 3 : row & 4095;
    const float pos = (float)(smp ? PAST + t : t);
    float c128, s128, c64, s64;
    { const float f1 = exp2f(-(float)lane * (13.287712379549449f / 64.0f)); sincosf(pos * f1, &s128, &c128);
      const float f2 = exp2f(-(float)(lane & 31) * (13.287712379549449f / 32.0f)); sincosf(pos * f2, &s64, &c64); }
#pragma unroll 1
    for (int hd = 0; hd < 8; ++hd) {
        const float x1 = bf2f(z[hd * 128 + lane]), x2 = bf2f(z[hd * 128 + 64 + lane]);
        const float rs = rsqrtf(wave_sum(x1 * x1 + x2 * x2) * (1.0f / 128.0f) + EPS);
        const float* gn = hd < 6 ? a.in[17] : a.in[18];
        const float y1 = x1 * rs * gn[lane], y2 = x2 * rs * gn[64 + lane];
        const float o1 = y1 * c128 - y2 * s128, o2 = y2 * c128 + y1 * s128;
        if (hd < 6) {
            if (smp) { float* q = (float*)(a.ws + WS_SQ) + (size_t)(row - MP) * 768 + hd * 128; q[lane] = o1; q[64 + lane] = o2; }
            else { bf16* q = (bf16*)(a.ws + WS_QB) + ((size_t)(b * 6 + hd) * SEQ + t) * 128; q[lane] = (bf16)f2bf(o1); q[64 + lane] = (bf16)f2bf(o2); }
        } else {
            const int kvh = hd - 6;
            float* ko = smp ? a.out + O_KS + (size_t)(row - MP) * 256 + kvh * 128 : a.out + O_KP + (size_t)row * 256 + kvh * 128;
            ko[lane] = o1; ko[64 + lane] = o2;
            if (!smp) { bf16* kb = (bf16*)(a.ws + WS_KB) + ((size_t)(b * 2 + kvh) * SEQ + t) * 128; kb[lane] = (bf16)f2bf(o1); kb[64 + lane] = (bf16)f2bf(o2); }
        }
    }
    {
        const u64 vv = *(const u64*)(z + Z1_V + 4 * lane);
        const f32x4 v = {bf2f((unsigned)vv & 0xffffu), bf2f(((unsigned)vv) >> 16), bf2f((unsigned)(vv >> 32) & 0xffffu), bf2f((unsigned)(vv >> 48))};
        float* vo = smp ? a.out + O_VS + (size_t)(row - MP) * 256 : a.out + O_VP + (size_t)row * 256;
        *(f32x4*)(vo + 4 * lane) = v;
        if (!smp) { const int kvh = lane >> 5, d = (lane & 31) * 4; *(u64*)((bf16*)(a.ws + WS_VB) + ((size_t)(b * 2 + kvh) * SEQ + t) * 128 + d) = vv; }
    }
    {
        const int i = lane & 31;
#pragma unroll
        for (int p = 0; p < 4; ++p) { const int hd = 2 * p + (lane >> 5);
            const float x1 = bf2f(z[Z1_IQ + hd * 64 + i]), x2 = bf2f(z[Z1_IQ + hd * 64 + 32 + i]);
            const float o1 = x1 * c64 - x2 * s64, o2 = x2 * c64 + x1 * s64;
            if (smp) { float* q = (float*)(a.ws + WS_SIQ) + (size_t)(row - MP) * 512 + hd * 64; q[i] = o1; q[32 + i] = o2; }
            else { bf16* q = (bf16*)(a.ws + WS_IQB) + (size_t)row * 512 + hd * 64; q[i] = (bf16)f2bf(o1); q[32 + i] = (bf16)f2bf(o2); } }
        float x1 = 0.f, x2 = 0.f; if (lane < 32) { x1 = bf2f(z[Z1_IK + i]); x2 = bf2f(z[Z1_IK + 32 + i]); }
        const float rs = rsqrtf(wave_sum(x1 * x1 + x2 * x2) * (1.0f / 64.0f) + EPS);
        const float y1 = x1 * rs * a.in[19][i], y2 = x2 * rs * a.in[19][32 + i];
        const float o1 = y1 * c64 - y2 * s64, o2 = y2 * c64 + y1 * s64;
        if (lane < 32) {
            float* ko = smp ? a.out + O_IKS + (size_t)(row - MP) * 64 : a.out + O_IKP + (size_t)row * 64; ko[i] = o1; ko[32 + i] = o2;
            if (!smp) { bf16* kb = (bf16*)(a.ws + WS_IKB) + (size_t)row * 64; kb[i] = (bf16)f2bf(o1); kb[32 + i] = (bf16)f2bf(o2); } }
        if (lane < 8) { const float wv = bf2f(z[Z1_IW + lane]) * (0.35355339059327373f * 0.125f);
            if (smp) ((float*)(a.ws + WS_SIW))[(row - MP) * 8 + lane] = wv; else ((float*)(a.ws + WS_IW))[(size_t)row * 8 + lane] = wv; }
    }
}
__device__ __forceinline__ void p8_dsa_post(Ctx& c, const Args& a) {
    for (;;) { const int u = q_next(c, 1); if (u >= 384) break; if (u < 256) memattn_prompt_unit(c, a, 1, u); else memattn_sample_unit(c, a, 1, u - 256); }
    const int gw = c.vcu * NWAVES + c.wave, NGW = c.G * NWAVES;
    for (int row = gw; row < MVALID; row += NGW) dsa_post_row(a, row, c.lane);
}

__device__ __forceinline__ void idx_prompt_unit(Ctx& c, const Args& a, int b, int qb) {
    int tid = c.tid; asm volatile("" : "+v"(tid));
    const int lane = tid & 63, r32 = lane & 31, hh = lane >> 5, w = c.wave;
    const int q0 = b * SEQ + qb * 32;
    LAS bf16* IQL = (LAS bf16*)(c.lds);
    { const bf16* src = (const bf16*)(a.ws + WS_IQB) + (size_t)q0 * 512;
#pragma unroll
      for (int i = 0; i < 4; ++i) { const int row = tid >> 4, ch = (tid & 15) + 16 * i; *(LAS v4u*)(IQL + row * 520 + ch * 8) = *(const v4u*)(src + (size_t)row * 512 + ch * 8); } }
    __syncthreads();
    const bf16* IK = (const bf16*)(a.ws + WS_IKB) + (size_t)(b * SEQ) * 64;
    float* SC = (float*)(a.ws + WS_SC) + (size_t)(q0 + r32) * SEQ;
    float wv[8];
#pragma unroll
    for (int h = 0; h < 8; ++h) wv[h] = ((const float*)(a.ws + WS_IW))[(size_t)(q0 + r32) * 8 + h];
#pragma unroll 1
    for (int kt = w; kt <= qb; kt += 8) {
        bf16x8 ak[4];
#pragma unroll
        for (int ks = 0; ks < 4; ++ks) ak[ks] = *(const bf16x8*)(IK + (size_t)(kt * 32 + r32) * 64 + ks * 16 + 8 * hh);
        f32x16 sc = {};
        int qoff = r32 * 520 + 8 * hh; asm volatile("" : "+v"(qoff));
#pragma unroll
        for (int h = 0; h < 8; ++h) { f32x16 d = {};
#pragma unroll
            for (int ks = 0; ks < 4; ++ks) d = __builtin_amdgcn_mfma_f32_32x32x16_bf16(ak[ks], *(const LAS bf16x8*)(IQL + qoff + h * 64 + ks * 16), d, 0, 0, 0);
#pragma unroll
            for (int r = 0; r < 16; ++r) sc[r] = fmaf(wv[h], fmaxf(d[r], 0.f), sc[r]); }
#pragma unroll
        for (int g = 0; g < 4; ++g) *(f32x4*)(SC + kt * 32 + 8 * g + 4 * hh) = (f32x4){sc[4 * g], sc[4 * g + 1], sc[4 * g + 2], sc[4 * g + 3]};
    }
}
__device__ __forceinline__ void idx_sample_unit(Ctx& c, const Args& a, int sb, int pg) {
    LAS float* IKL = (LAS float*)(c.lds);
    LAS float* IQL = (LAS float*)(c.lds + 33280);
    LAS float* WL = (LAS float*)(c.lds + 33280 + 8192);
    int tid = c.tid; asm volatile("" : "+v"(tid));
    const int nk = pg < 64 ? 128 : 4;
    const float* src = pg < 64 ? a.in[4] + ((size_t)a.page_table[sb * 64 + pg] * 128) * 64 : a.out + O_IKS + (size_t)(sb * 4) * 64;
    for (int i = tid; i < nk * 16; i += 512) { const f32x4 v = *(const f32x4*)(src + (size_t)i * 4); const int k = i >> 4, d = (i & 15) * 4;
        IKL[k * 65 + d] = v.x; IKL[k * 65 + d + 1] = v.y; IKL[k * 65 + d + 2] = v.z; IKL[k * 65 + d + 3] = v.w; }
    for (int i = tid; i < 2048; i += 512) IQL[i] = ((const float*)(a.ws + WS_SIQ))[(size_t)(sb * 4) * 512 + i];
    if (tid < 32) WL[tid] = ((const float*)(a.ws + WS_SIW))[sb * 32 + tid];
    __syncthreads();
    const int k = tid & 127, t = tid >> 7;
    if (k < nk) {
        float acc = 0.f;
#pragma unroll 1
        for (int h = 0; h < 8; ++h) { float d = 0.f;
#pragma unroll 16
            for (int e = 0; e < 64; ++e) d = fmaf(IQL[(t * 8 + h) * 64 + e], IKL[k * 65 + e], d);
            acc = fmaf(WL[t * 8 + h], fmaxf(d, 0.f), acc); }
        ((float*)(a.ws + WS_SSC))[(size_t)(sb * 4 + t) * SSC_LD + pg * 128 + k] = acc;
    }
}
__device__ __forceinline__ void p9_indexer(Ctx& c, const Args& a) {
    constexpr int U_P = 512, U_S = U_P + 32 * 65;
    for (;;) { const int u = q_next(c, 2); if (u >= U_S) break;
        if (u < U_P) idx_prompt_unit(c, a, u & 3, 127 - (u >> 2));
        else { const int v = u - U_P; idx_sample_unit(c, a, v / 65, v % 65); } }
}


__device__ __forceinline__ unsigned fkey(float f) { const unsigned u = __builtin_bit_cast(unsigned, f + 0.0f); return (u & 0x80000000u) ? ~u : (u | 0x80000000u); }
__device__ __forceinline__ void acc_ge(int& cnt, unsigned key, unsigned cand) { asm volatile("v_cmp_le_u32_e32 vcc, %1, %2\n\tv_addc_co_u32_e32 %0, vcc, 0, %0, vcc" : "+v"(cnt) : "s"(cand), "v"(key) : "vcc"); }
__device__ __forceinline__ u64 ballot_nz(unsigned v) { u64 m; asm volatile("v_cmp_ne_u32_e64 %0, 0, %1" : "=s"(m) : "v"(v)); return m; }
__device__ __forceinline__ int wave_sum_dpp(int x) {
    x += __builtin_amdgcn_update_dpp(0, x, 0xB1, 0xF, 0xF, false);
    x += __builtin_amdgcn_update_dpp(0, x, 0x4E, 0xF, 0xF, false);
    x += __builtin_amdgcn_update_dpp(0, x, 0x141, 0xF, 0xF, false);
    x += __builtin_amdgcn_update_dpp(0, x, 0x140, 0xF, 0xF, false);
    return (__builtin_amdgcn_readlane(x, 0) + __builtin_amdgcn_readlane(x, 16)) + (__builtin_amdgcn_readlane(x, 32) + __builtin_amdgcn_readlane(x, 48));
}
__device__ __forceinline__ int mbcnt64(u64 m) { return (int)__builtin_amdgcn_mbcnt_hi((unsigned)(m >> 32), __builtin_amdgcn_mbcnt_lo((unsigned)m, 0u)); }
constexpr int TK_LOWBITS = 18;
__device__ __forceinline__ void topk_finish(unsigned ck, int cp, int A, int posmax, unsigned& T, int& P) {
#pragma unroll 1
    for (int bit = TK_LOWBITS - 1; bit >= 0; --bit) { const unsigned cand = T | (1u << bit); if (A + __builtin_popcountll(__ballot(ck >= cand)) >= 256) T = cand; }
    const int need = 256 - (A + __builtin_popcountll(__ballot(ck > T))), ceq = __builtin_popcountll(__ballot(ck == T));
    P = posmax;
    if (ceq != need) { P = 0;
#pragma unroll 1
        for (int bit = 13; bit >= 0; --bit) { const int cand = P | (1 << bit); if (__builtin_popcountll(__ballot(ck == T && cp < cand)) < need) P = cand; } }
}
__device__ __forceinline__ void topk_prompt_row(const Args& a, int row, int lane_, LAS unsigned* cl  ) {
    int lane = lane_; asm volatile("" : "+v"(lane));
    const int t = row & 4095; const float* sc = (const float*)(a.ws + WS_SC) + (size_t)row * SEQ;
    u64* mk = (u64*)(a.ws + WS_MASK) + (size_t)row * 64;
    u64 myword = 0ull;
    if (t < 256) {
#pragma unroll 1
        for (int j = 0; j < 64; ++j) { const u64 m = __ballot(64 * j + lane <= t); if (lane == j) myword = m; }
        mk[lane] = myword; return; }
    unsigned key[64];
#pragma unroll
    for (int j = 0; j < 64; ++j) { unsigned k = 0u; if (64 * j <= t) { if (64 * j + lane <= t) k = fkey(sc[64 * j + lane]); } key[j] = k; }
#define TK_FULLCOUNT(CAND, OUT) do { const unsigned cs_ = __builtin_amdgcn_readfirstlane(CAND); int cnt_ = 0; _Pragma("unroll") for (int j = 0; j < 64; ++j) acc_ge(cnt_, key[j], cs_); OUT = wave_sum_dpp(cnt_); } while (0)
    unsigned T = 0u;
#pragma unroll 1
    for (int bit = 31; bit >= TK_LOWBITS; --bit) { const unsigned cand = T | (1u << bit); int tot; TK_FULLCOUNT(cand, tot); if (tot >= 256) T = cand; }
    const unsigned hib = T + (1u << TK_LOWBITS);
    int A = 0, cT; if (hib != 0u) TK_FULLCOUNT(hib, A); TK_FULLCOUNT(T, cT);
    int P;
    if (cT - A <= 64) {
        int base = 0;
#pragma unroll
        for (int j = 0; j < 64; ++j) { const unsigned und = (key[j] - T) < (1u << TK_LOWBITS) ? 1u : 0u; const u64 m = ballot_nz(und); const int pos = base + mbcnt64(m);
            if (und) { cl[pos] = key[j]; cl[64 + pos] = (unsigned)(64 * j + lane); }
            base += __builtin_popcountll(m); asm volatile("" : "+s"(base)); }
        const unsigned ck = lane < base ? cl[lane] : 0u; const int cp = (int)cl[64 + lane];
        topk_finish(ck, cp, A, 4095, T, P);
    } else {
#pragma unroll 1
        for (int bit = TK_LOWBITS - 1; bit >= 0; --bit) { const unsigned cand = T | (1u << bit); int tot; TK_FULLCOUNT(cand, tot); if (tot >= 256) T = cand; }
        int cge, cgt; TK_FULLCOUNT(T, cge); cgt = 0; if (T != 0xffffffffu) TK_FULLCOUNT(T + 1u, cgt);
        const int need = 256 - cgt, ceq = cge - cgt; P = 4095;
        if (ceq != need) { P = 0;
#pragma unroll 1
            for (int bit = 11; bit >= 0; --bit) { const int cand = P | (1 << bit); int cnt = 0;
#pragma unroll
                for (int j = 0; j < 64; ++j) cnt += (key[j] == T && 64 * j + lane < cand) ? 1 : 0;
                if (wave_sum_dpp(cnt) < need) P = cand; } }
    }
#undef TK_FULLCOUNT
#pragma unroll
    for (int j = 0; j < 64; ++j) { const unsigned selv = (key[j] > T || (key[j] == T && 64 * j + lane <= P)) ? 1u : 0u; const u64 m = ballot_nz(selv); if (lane == j) myword = m; asm volatile("" : "+v"(myword)); }
    mk[lane] = myword;
}
__device__ __forceinline__ void topk_sample_row(const Args& a, int q, int lane_, LAS unsigned* K, LAS unsigned* cl) {
    int lane = lane_; asm volatile("" : "+v"(lane));
    const int t = q & 3, n = PAST + t + 1; const float* sc = (const float*)(a.ws + WS_SSC) + (size_t)q * SSC_LD;
    int* out = (int*)(a.ws + WS_SIDX) + q * 256;
#pragma unroll 4
    for (int j = 0; j < 129; ++j) { const int s = 64 * j + lane; K[s] = s < n ? fkey(sc[s]) : 0u; }
#define TK_FULLCOUNT(CAND, OUT) do { const unsigned cs_ = __builtin_amdgcn_readfirstlane(CAND); int cnt_ = 0; _Pragma("unroll 8") for (int j = 0; j < 129; ++j) acc_ge(cnt_, K[64 * j + lane], cs_); OUT = wave_sum_dpp(cnt_); } while (0)
    unsigned T = 0u;
#pragma unroll 1
    for (int bit = 31; bit >= TK_LOWBITS; --bit) { const unsigned cand = T | (1u << bit); int tot; TK_FULLCOUNT(cand, tot); if (tot >= 256) T = cand; }
    const unsigned hib = T + (1u << TK_LOWBITS);
    int A = 0, cT; if (hib != 0u) TK_FULLCOUNT(hib, A); TK_FULLCOUNT(T, cT);
    int P;
    if (cT - A <= 64) {
        int base = 0;
#pragma unroll 4
        for (int j = 0; j < 129; ++j) { const unsigned kj = K[64 * j + lane]; const unsigned und = (kj - T) < (1u << TK_LOWBITS) ? 1u : 0u; const u64 m = ballot_nz(und); const int pos = base + mbcnt64(m);
            if (und) { cl[pos] = kj; cl[64 + pos] = (unsigned)(64 * j + lane); }
            base += __builtin_popcountll(m); }
        const unsigned ck = lane < base ? cl[lane] : 0u; const int cp = (int)cl[64 + lane];
        topk_finish(ck, cp, A, 16383, T, P);
    } else {
#pragma unroll 1
        for (int bit = TK_LOWBITS - 1; bit >= 0; --bit) { const unsigned cand = T | (1u << bit); int tot; TK_FULLCOUNT(cand, tot); if (tot >= 256) T = cand; }
        int cge, cgt; TK_FULLCOUNT(T, cge); cgt = 0; if (T != 0xffffffffu) TK_FULLCOUNT(T + 1u, cgt);
        const int need = 256 - cgt, ceq = cge - cgt; P = 16383;
        if (ceq != need) { P = 0;
#pragma unroll 1
            for (int bit = 13; bit >= 0; --bit) { const int cand = P | (1 << bit); int cnt = 0;
#pragma unroll 4
                for (int j = 0; j < 129; ++j) cnt += (K[64 * j + lane] == T && 64 * j + lane < cand) ? 1 : 0;
                if (wave_sum_dpp(cnt) < need) P = cand; } }
    }
#undef TK_FULLCOUNT
    int base = 0;
#pragma unroll 4
    for (int j = 0; j < 129; ++j) { const unsigned kj = K[64 * j + lane]; const unsigned selv = (kj > T || (kj == T && 64 * j + lane <= P)) ? 1u : 0u; const u64 m = ballot_nz(selv);
        const int pos = base + mbcnt64(m);
        if (selv && pos < 256) out[pos] = 64 * j + lane;
        base += __builtin_popcountll(m); }
}
__device__ __forceinline__ void p10_topk(Ctx& c, const Args& a) {
    const int gw = c.vcu * NWAVES + c.wave, NGW = c.G * NWAVES;
    LAS unsigned* cl = (LAS unsigned*)(c.lds) + c.wave * 128;
    if (c.wave == 0 && c.vcu < MS) topk_sample_row(a, c.vcu, c.lane, (LAS unsigned*)(c.lds + 4096), cl);
    for (int row = gw; row < MP; row += NGW) topk_prompt_row(a, row, c.lane, cl);
}


__device__ __forceinline__ void attn_sample_unit(Ctx& c, const Args& a, int sb, int t) {
    LAS bf16* KV = (LAS bf16*)(c.lds);
    LAS float* QL = (LAS float*)(c.lds + 69632);
    LAS float* SL = (LAS float*)(c.lds + 69632 + 3072);
    LAS float* OL = (LAS float*)(c.lds + 69632 + 6144);
    LAS int* IL = (LAS int*)(c.lds + 69632 + 12288);
    int tid = c.tid; asm volatile("" : "+v"(tid));
    const int lane = tid & 63, w = c.wave, q = sb * 4 + t;
    __syncthreads();
    if (tid < 256) IL[tid] = ((const int*)(a.ws + WS_SIDX))[q * 256 + tid];
    for (int i = tid; i < 768; i += 512) QL[i] = ((const float*)(a.ws + WS_SQ))[(size_t)q * 768 + i];
    __syncthreads();
    bf16* MIX = (bf16*)(a.ws + WS_MIX) + (size_t)(MP + q) * DM;
#pragma unroll 1
    for (int kvh = 0; kvh < 2; ++kvh) {
#pragma unroll 1
        for (int pass = 0; pass < 2; ++pass) {
            const float* pool = pass ? a.in[3] : a.in[2]; const float* nw = a.out + (pass ? O_VS : O_KS);
            for (int i = tid >> 5; i < 256; i += 16) { const int idx = IL[i]; const float* src;
                if (idx < PAST) src = pool + (((size_t)a.page_table[sb * 64 + (idx >> 7)] * 128 + (idx & 127)) * 2 + kvh) * 128;
                else src = nw + (size_t)(sb * 4 + (idx - PAST)) * 256 + kvh * 128;
                const f32x4 v = *(const f32x4*)(src + (tid & 31) * 4);
                *(LAS u64*)(KV + i * 136 + (tid & 31) * 4) = (u64)pk2(v.x, v.y) | ((u64)pk2(v.z, v.w) << 32); }
            __syncthreads();
            if (pass == 0) {
                const int i = tid >> 1, dh = (tid & 1) * 64; float s0 = 0.f, s1 = 0.f, s2 = 0.f;
#pragma unroll 8
                for (int d = 0; d < 64; ++d) { const float kx = bf2f(KV[i * 136 + dh + d]);
                    s0 = fmaf(QL[(3 * kvh + 0) * 128 + dh + d], kx, s0); s1 = fmaf(QL[(3 * kvh + 1) * 128 + dh + d], kx, s1); s2 = fmaf(QL[(3 * kvh + 2) * 128 + dh + d], kx, s2); }
                s0 += __shfl_xor(s0, 1); s1 += __shfl_xor(s1, 1); s2 += __shfl_xor(s2, 1);
                if ((tid & 1) == 0) { SL[i] = s0 * 0.08838834764831845f; SL[256 + i] = s1 * 0.08838834764831845f; SL[512 + i] = s2 * 0.08838834764831845f; }
                __syncthreads();
                if (w < 3) { float v[4], mx = -1e30f;
#pragma unroll
                    for (int j = 0; j < 4; ++j) { v[j] = SL[w * 256 + 64 * j + lane]; mx = fmaxf(mx, v[j]); }
#pragma unroll
                    for (int o = 1; o < 64; o <<= 1) mx = fmaxf(mx, __shfl_xor(mx, o));
                    float l = 0.f;
#pragma unroll
                    for (int j = 0; j < 4; ++j) { v[j] = __expf(v[j] - mx); l += v[j]; }
                    l = wave_sum(l); const float il = 1.0f / l;
#pragma unroll
                    for (int j = 0; j < 4; ++j) SL[w * 256 + 64 * j + lane] = v[j] * il; }
                __syncthreads();
            } else {
                const int d = tid & 127, part = tid >> 7; float o0 = 0.f, o1 = 0.f, o2 = 0.f;
#pragma unroll 8
                for (int i = part * 64; i < part * 64 + 64; ++i) { const float vx = bf2f(KV[i * 136 + d]); o0 = fmaf(SL[i], vx, o0); o1 = fmaf(SL[256 + i], vx, o1); o2 = fmaf(SL[512 + i], vx, o2); }
                OL[(part * 3 + 0) * 128 + d] = o0; OL[(part * 3 + 1) * 128 + d] = o1; OL[(part * 3 + 2) * 128 + d] = o2;
                __syncthreads();
                if (tid < 384) { const int hq = tid >> 7, dd = tid & 127; const float o = (OL[hq * 128 + dd] + OL[(3 + hq) * 128 + dd]) + (OL[(6 + hq) * 128 + dd] + OL[(9 + hq) * 128 + dd]);
                    MIX[(3 * kvh + hq) * 128 + dd] = (bf16)f2bf(o); }
                __syncthreads();
            }
        }
    }
}


namespace attn {
using bf16 = unsigned short;
typedef short bf16x8 __attribute__((ext_vector_type(8)));
typedef short s16x4 __attribute__((ext_vector_type(4)));
typedef float f32x16 __attribute__((ext_vector_type(16)));
typedef float f32x4 __attribute__((ext_vector_type(4)));
typedef unsigned u32x4 __attribute__((ext_vector_type(4)));
typedef unsigned u32x2 __attribute__((ext_vector_type(2)));
constexpr int D = 128, OS = 1024;
constexpr float THR = 8.f;
constexpr float SCALE = 0.08838834764831845f;
constexpr int NW = 8, QBLK = 32, KVBLK = 64, QB = NW * QBLK;
constexpr int SHM_V = KVBLK * D * 2, SHM_K = KVBLK * D * 2;
constexpr int LDS_BYTES = 2 * SHM_V + 2 * SHM_K + NW * 64 * 4;

#define KSWZ(row, colB) ((row) * 256 + ((colB) ^ (((row) & 7) << 4)))
#define SBAR() __builtin_amdgcn_sched_barrier(0)
__device__ __forceinline__ int v_st(int k, int c) { const int kk = (k & ~0xC) | ((k & 4) << 1) | ((k & 8) >> 1); return ((kk >> 3) * 4 + (c >> 5)) * 512 + ((kk & 7) * 32 + (c & 31)) * 2; }
__device__ __forceinline__ int v_rd_base(int lane) { return ((lane & 3) << 3) | (((lane >> 2) & 3) << 6) | (((lane >> 4) & 1) << 5) | (((lane >> 5) & 1) << 8); }
constexpr int v_rd_off(int d0, int ks, int half) { return d0 * 512 + ks * 4096 + half * 2048; }
__device__ __forceinline__ int crow(int r, int hi) { return (r & 3) + 8 * (r >> 2) + 4 * hi; }
__device__ __forceinline__ unsigned cvtpk(float lo, float hi) {
    unsigned r; asm volatile("v_cvt_pk_bf16_f32 %0, %1, %2" : "=v"(r) : "v"(lo), "v"(hi)); return r;
}
__device__ __forceinline__ bf16x8 pack8(f32x4 a, f32x4 b) {
    u32x4 w = {cvtpk(a[0], a[1]), cvtpk(a[2], a[3]), cvtpk(b[0], b[1]), cvtpk(b[2], b[3])};
    return *reinterpret_cast<bf16x8*>(&w);
}

__device__ __forceinline__ void partialSM(f32x16& p0, f32x16& p1, float& m_reg, float& mn, float& alpha) {
    float pmax = p0[0]; for (int r = 1; r < 16; ++r) pmax = fmaxf(pmax, p0[r]); for (int r = 0; r < 16; ++r) pmax = fmaxf(pmax, p1[r]);
    { auto rr = __builtin_amdgcn_permlane32_swap(__float_as_uint(pmax), __float_as_uint(pmax), false, false);
      pmax = fmaxf(__uint_as_float(rr[0]), __uint_as_float(rr[1])); }
    constexpr float C2 = 1.4426950408889634f * SCALE;
    if (__builtin_expect(__all((pmax - m_reg) * SCALE <= THR), 1)) { mn = m_reg; alpha = 1.f; }
    else { mn = fmaxf(m_reg, pmax); alpha = __builtin_amdgcn_exp2f((m_reg - mn) * C2); m_reg = mn; }
    const float mnL = -mn * C2;
    for (int r = 0; r < 16; ++r) p0[r] = fmaf(p0[r], C2, mnL); for (int r = 0; r < 16; ++r) p1[r] = fmaf(p1[r], C2, mnL);
    for (int r = 0; r < 16; ++r) p0[r] = __builtin_amdgcn_exp2f(p0[r]);
}
__device__ __forceinline__ void finishSM(f32x16& p0, f32x16& p1, float alpha, float& l_reg, bf16x8& pa0, bf16x8& pa1, bf16x8& pa2, bf16x8& pa3) {
    for (int r = 0; r < 16; ++r) p1[r] = __builtin_amdgcn_exp2f(p1[r]);
    float ps = 0; for (int r = 0; r < 16; ++r) ps += p0[r]; for (int r = 0; r < 16; ++r) ps += p1[r];
    { auto rr = __builtin_amdgcn_permlane32_swap(__float_as_uint(ps), __float_as_uint(ps), false, false);
      ps = __uint_as_float(rr[0]) + __uint_as_float(rr[1]); }
    l_reg = l_reg * alpha + ps;
#define PK4(P, B_, OUT) do { unsigned a0 = cvtpk(P[B_+0], P[B_+1]), a1 = cvtpk(P[B_+2], P[B_+3]);                          \
        unsigned b0 = cvtpk(P[B_+4], P[B_+5]), b1 = cvtpk(P[B_+6], P[B_+7]);                                             \
        auto r0 = __builtin_amdgcn_permlane32_swap(a0, b0, false, false); auto r1 = __builtin_amdgcn_permlane32_swap(a1, b1, false, false); \
        u32x4 w = {r0[0], r1[0], r0[1], r1[1]}; OUT = *reinterpret_cast<bf16x8*>(&w); } while (0)
    PK4(p0, 0, pa0); PK4(p0, 8, pa1); PK4(p1, 0, pa2); PK4(p1, 8, pa3);
#undef PK4
}
template <int KB, bool SK>
__device__ __forceinline__ void qkt(f32x16& p0, f32x16& p1, const char* K_lds, int r32, int hi, const bf16x8* qr, bool act) {
    if (SK && !act) { const float NEG = -__builtin_inff();
#pragma unroll
        for (int r = 0; r < 16; ++r) { p0[r] = NEG; p1[r] = NEG; } return; }
    p0 = f32x16{}; p1 = f32x16{};
    const char* kb[4];
#pragma unroll
    for (int dd = 0; dd < 4; ++dd) kb[dd] = K_lds + KB * SHM_K + KSWZ(r32, (dd * 16 + hi * 8) * 2);
#pragma unroll
    for (int d0 = 0; d0 < 8; ++d0) { const char* a = kb[d0 & 3] + (d0 >> 2) * 128;
        bf16x8 b0 = *reinterpret_cast<const bf16x8*>(a);
        bf16x8 b1 = *reinterpret_cast<const bf16x8*>(a + 32 * 256);
        p0 = __builtin_amdgcn_mfma_f32_32x32x16_bf16(b0, qr[d0], p0, 0, 0, 0);
        p1 = __builtin_amdgcn_mfma_f32_32x32x16_bf16(b1, qr[d0], p1, 0, 0, 0); }
}
template <int VB, bool SK>
__device__ __forceinline__ void pv_tile(f32x16* o, int vb0, bf16x8 pa0, bf16x8 pa1, bf16x8 pa2, bf16x8 pa3, bool act) {
    if (SK && !act) return;
#define TRRD(dst, off) asm volatile("ds_read_b64_tr_b16 %0, %1 offset:%2" : "=&v"(dst) : "v"(vb0), "i"(off) : "memory")
#define PV_D0(d0) do { s16x4 l0, l1, l2, l3, h0, h1, h2, h3; constexpr int b_ = VB * SHM_V + v_rd_off(d0, 0, 0);     \
        TRRD(l0, b_); TRRD(h0, b_ + 2048); TRRD(l1, b_ + 4096); TRRD(h1, b_ + 6144); TRRD(l2, b_ + 8192); TRRD(h2, b_ + 10240); TRRD(l3, b_ + 12288); TRRD(h3, b_ + 14336); \
        asm volatile("s_waitcnt lgkmcnt(0)" ::: "memory"); SBAR();                 \
        o[d0] = __builtin_amdgcn_mfma_f32_32x32x16_bf16(pa0, (bf16x8){l0[0], l0[1], l0[2], l0[3], h0[0], h0[1], h0[2], h0[3]}, o[d0], 0, 0, 0);   \
        o[d0] = __builtin_amdgcn_mfma_f32_32x32x16_bf16(pa1, (bf16x8){l1[0], l1[1], l1[2], l1[3], h1[0], h1[1], h1[2], h1[3]}, o[d0], 0, 0, 0);   \
        o[d0] = __builtin_amdgcn_mfma_f32_32x32x16_bf16(pa2, (bf16x8){l2[0], l2[1], l2[2], l2[3], h2[0], h2[1], h2[2], h2[3]}, o[d0], 0, 0, 0);   \
        o[d0] = __builtin_amdgcn_mfma_f32_32x32x16_bf16(pa3, (bf16x8){l3[0], l3[1], l3[2], l3[3], h3[0], h3[1], h3[2], h3[3]}, o[d0], 0, 0, 0); } while (0)
    PV_D0(0); PV_D0(1); PV_D0(2); PV_D0(3);
#undef PV_D0
#undef TRRD
}

__device__ __forceinline__ bf16x8 load8(const bf16* p) { return *reinterpret_cast<const bf16x8*>(p); }
__device__ __forceinline__ void mask_bits(f32x16& p0, f32x16& p1, u32x2 w, int hi) {
    const float NEG = -__builtin_inff();
    asm volatile("" : "+v"(w.x), "+v"(w.y));
    const unsigned lo = w.x >> (4 * hi), up = w.y >> (4 * hi);
#pragma unroll
    for (int r = 0; r < 16; ++r) { const int c = (r & 3) + 8 * (r >> 2);
        if (!((lo >> c) & 1u)) p0[r] = NEG;
        if (!((up >> c) & 1u)) p1[r] = NEG; }
}
struct BlockRef { const bf16* Q; const bf16* K; const bf16* V; bf16* O; const u32x2* M; int P0; };
struct Seam { bf16x8 qr[8]; bf16x8 st_v0, st_v1, st_k0, st_k1; };
#define ROW(p, k0, rr) ((p) + (size_t)((k0) + (rr)) * D + sc)
#define VMW() asm volatile("s_waitcnt vmcnt(0)" ::: "memory")
#define VMWN(n) asm volatile("s_waitcnt vmcnt(%0)" :: "i"(n) : "memory")
#define SLOAD_H(Kp, Vp, k0) do { S.st_v0 = load8(ROW(Vp, k0, sr)); S.st_v1 = load8(ROW(Vp, k0, 32 + sr));              \
                         S.st_k0 = load8(ROW(Kp, k0, sr)); S.st_k1 = load8(ROW(Kp, k0, 32 + sr)); } while (0)
#define SWRITE_HK(bf) do { *(bf16x8*)(K_lds + (bf) * SHM_K + kws) = S.st_k0; *(bf16x8*)(K_lds + (bf) * SHM_K + kws + 32 * 256) = S.st_k1; } while (0)
#define SWRITE_HV(bf) do { *(bf16x8*)(V_lds + (bf) * SHM_V + vst0) = S.st_v0; *(bf16x8*)(V_lds + (bf) * SHM_V + vst1) = S.st_v1; } while (0)
#define SWRITE_H(bf) do { SWRITE_HV(bf); SWRITE_HK(bf); } while (0)
__device__ __forceinline__ void sel_prime(const BlockRef& cur, char* lds, Seam& S) {
    int tid_ = threadIdx.x; asm volatile("" : "+v"(tid_));
    const int tid = tid_, wid = __builtin_amdgcn_readfirstlane(tid >> 6), lane = tid & 63, r32 = lane & 31, hi = lane >> 5;
    const int sr = tid >> 4, sc = (tid & 15) * 8, kws = KSWZ(sr, sc * 2); char* K_lds = lds + 2 * SHM_V;
    for (int d0 = 0; d0 < 8; ++d0) S.qr[d0] = load8(cur.Q + (size_t)(wid * QBLK + r32) * D + d0 * 16 + hi * 8);
    SLOAD_H(cur.K, cur.V, 0); VMW(); SWRITE_HK(0);
    __syncthreads();
}
__device__ __forceinline__ void sel_block(const BlockRef& cur, const BlockRef& nxt, char* lds, Seam& S) {
    int tid_ = threadIdx.x; asm volatile("" : "+v"(tid_));
    const int tid = tid_, wid = __builtin_amdgcn_readfirstlane(tid >> 6), lane = tid & 63, r32 = lane & 31, hi = lane >> 5;
    const int NT = (cur.P0 + QB) / KVBLK;
    char* V_lds = lds; char* K_lds = lds + 2 * SHM_V;
    float* ws = (float*)(lds + 2 * SHM_V + 2 * SHM_K) + wid * 64; float* li_l = ws, * al_l = ws + 32;
    float m_reg = -1e30f, l_reg = 0; f32x16 o[4] = {};
    const int sr = tid >> 4, sc = (tid & 15) * 8, vst0 = v_st(sr, sc), vst1 = v_st(32 + sr, sc), kws = KSWZ(sr, sc * 2);
    const int vb0 = (int)(uintptr_t)V_lds + v_rd_base(lane);
    const bf16* Kh = cur.K; const bf16* Vh = cur.V;
    const u32x2* Mrow = cur.M + (size_t)(wid * QBLK + r32) * 64;
#define RESC(a) do { if (__any((a) < 1.f)) { if (hi == 0) al_l[r32] = (a); asm volatile("s_waitcnt lgkmcnt(0)" ::: "memory");              \
                     for (int d_ = 0; d_ < 4; ++d_) for (int r = 0; r < 16; ++r) o[d_][r] *= al_l[crow(r, hi)]; } } while (0)
#define KBASE(t) ((t) * KVBLK)
    f32x16 pA0, pA1, pB0, pB1; float mnA, mnB, alA, alB; bf16x8 pa0, pa1, pa2, pa3; u32x2 mw;
    SWRITE_HV(0); SBAR();
    if (NT > 1) SLOAD_H(Kh, Vh, KBASE(1));
    mw = Mrow[0];
    SBAR(); qkt<0, false>(pA0, pA1, K_lds, r32, hi, S.qr, true);
    mask_bits(pA0, pA1, mw, hi); partialSM(pA0, pA1, m_reg, mnA, alA);
    if (NT > 1) { VMW(); SWRITE_H(1); }
    __syncthreads();
#define HALF_STEP(PX0, PX1, mnX, alX, PY0, PY1, alY, t, KB, VB, SB) do {                                                      \
        SBAR(); mw = Mrow[(t)]; qkt<KB, false>(PX0, PX1, K_lds, r32, hi, S.qr, true);                                          \
        finishSM(PY0, PY1, alY, l_reg, pa0, pa1, pa2, pa3); SBAR();                                                           \
        if ((t) + 1 < NT) { SLOAD_H(Kh, Vh, KBASE((t) + 1)); SBAR(); }                                                        \
        pv_tile<VB, false>(o, vb0, pa0, pa1, pa2, pa3, true); mask_bits(PX0, PX1, mw, hi); partialSM(PX0, PX1, m_reg, mnX, alX); \
        __syncthreads();                                                                                                      \
        if ((t) + 1 < NT) { VMW(); SWRITE_H(SB); }                                                                            \
        RESC(alX); __syncthreads(); } while (0)
    for (int t = 1; t + 1 < NT; t += 2) {
        HALF_STEP(pB0, pB1, mnB, alB, pA0, pA1, alA, t, 1, 0, 0);
        HALF_STEP(pA0, pA1, mnA, alA, pB0, pB1, alB, t + 1, 0, 1, 1);
    }
    const bool even = (NT & 1) == 0;
    if (even) { SBAR(); mw = Mrow[NT - 1]; qkt<1, false>(pB0, pB1, K_lds, r32, hi, S.qr, true); SBAR(); }
    SLOAD_H(nxt.K, nxt.V, 0); SBAR();
#pragma unroll
    for (int d0 = 0; d0 < 8; ++d0) S.qr[d0] = load8(nxt.Q + (size_t)(wid * QBLK + r32) * D + d0 * 16 + hi * 8);
    SBAR();
    finishSM(pA0, pA1, alA, l_reg, pa0, pa1, pa2, pa3); SBAR();
    pv_tile<0, false>(o, vb0, pa0, pa1, pa2, pa3, true);
    if (even) { mask_bits(pB0, pB1, mw, hi); partialSM(pB0, pB1, m_reg, mnB, alB); __syncthreads(); RESC(alB);
        finishSM(pB0, pB1, alB, l_reg, pa0, pa1, pa2, pa3); SBAR(); pv_tile<1, false>(o, vb0, pa0, pa1, pa2, pa3, true); }
    SBAR(); VMWN(8); SWRITE_HK(0); SBAR();
    if (hi == 0) li_l[r32] = l_reg; asm volatile("s_waitcnt lgkmcnt(0)" ::: "memory");
    float rli[16];
#pragma unroll
    for (int r = 0; r < 16; ++r) rli[r] = __builtin_amdgcn_rcpf(li_l[crow(r, hi)]);
    bf16* Ow = cur.O + (size_t)(wid * QBLK) * OS;
#pragma unroll
    for (int r = 0; r < 16; ++r) { const int orow = crow(r, hi);
#pragma unroll
        for (int d0 = 0; d0 < 4; ++d0) { const float v = o[d0][r] * rli[r];
            const float vn = __shfl_xor(v, 1);
            if ((r32 & 1) == 0) *(unsigned*)(Ow + (size_t)orow * OS + d0 * 32 + r32) = cvtpk(v, vn); } }
    __syncthreads();
#undef RESC
#undef KBASE
#undef HALF_STEP
}
#undef ROW
#undef VMW
#undef VMWN
#undef SLOAD_H
#undef SWRITE_HK
#undef SWRITE_HV
#undef SWRITE_H
#undef KSWZ
#undef SBAR
}


__device__ __forceinline__ attn::BlockRef attn_ref(const Args& a, int b, int h, int qb) {
    attn::BlockRef r; const int kvh = h / 3;
    r.Q = (const attn::bf16*)(a.ws + WS_QB) + ((size_t)(b * 6 + h) * SEQ + (size_t)qb * 256) * 128;
    r.K = (const attn::bf16*)(a.ws + WS_KB) + (size_t)(b * 2 + kvh) * SEQ * 128;
    r.V = (const attn::bf16*)(a.ws + WS_VB) + (size_t)(b * 2 + kvh) * SEQ * 128;
    r.O = (attn::bf16*)(a.ws + WS_MIX) + (size_t)(b * SEQ + qb * 256) * DM + h * 128;
    r.M = (const attn::u32x2*)(a.ws + WS_MASK) + (size_t)(b * SEQ + qb * 256) * 64;
    r.P0 = qb * 256; return r;
}
__device__ __forceinline__ void p11_attention(Ctx& c, const Args& a) {
    constexpr int NITEM = 192;
#pragma unroll 1
    for (int it = c.vcu; it < NITEM; it += c.G) {
        const int p = it & 7, bh = it >> 3, b = bh / 6, h = bh % 6;
        attn::Seam S;
        attn::BlockRef cur = attn_ref(a, b, h, p), nxt = attn_ref(a, b, h, 15 - p);
        __syncthreads();
        attn::sel_prime(cur, (char*)c.lds, S);
        attn::sel_block(cur, nxt, (char*)c.lds, S);
        attn::sel_block(nxt, nxt, (char*)c.lds, S);
    }
    const int spare = c.G - NITEM;
    if (spare > 0) { if (c.vcu >= NITEM) for (int u = c.vcu - NITEM; u < MS; u += spare) attn_sample_unit(c, a, u >> 2, u & 3); }
    else for (int u = c.vcu; u < MS; u += c.G) attn_sample_unit(c, a, u >> 2, u & 3);
}

constexpr int NPHASE = 16;
#ifndef ONLYPH
#define ONLYPH -1
#endif
#define PHON(x) (ONLYPH < 0 || ONLYPH == (x))
#ifndef REP_PH
#define REP_PH -1
#endif
#ifndef REP_N
#define REP_N 1
#endif
__global__ void __launch_bounds__(NWAVES * 64, 2) fwd_kernel(Args args) {
    extern __shared__ __attribute__((aligned(16))) unsigned char lds[];
    Ctx c;
    c.lds = (LAS unsigned char*)lds;
    c.MISC = (volatile LAS unsigned*)(c.lds + MISC_OFF);
    c.tid = threadIdx.x; c.lane = c.tid & 63; c.wave = __builtin_amdgcn_readfirstlane(c.tid >> 6);
    c.G = gridDim.x; { const int bx = blockIdx.x; c.vcu = (c.G % 8 == 0) ? (bx % 8) * (c.G / 8) + bx / 8 : bx; }
    unsigned char* ws = args.ws;
    c.ctl = (gu32*)(ws + WS_CTL);
    for (int u = c.tid; u < (LDS_BYTES - LDSCTL_OFF) / 4; u += NWAVES * 64) ((LAS unsigned*)(c.lds + LDSCTL_OFF))[u] = 0u;
    __syncthreads();
    const int lo = args.ph_lo, hi = args.ph_hi;
    XcdBarrier bar; bar.bar = (unsigned*)(c.ctl + CW_BAR); bar.x = 0; bar.st = nullptr;
    if (hi - lo > 1 || REP_N > 1) bar = xcd_barrier_post((unsigned*)(c.ctl + CW_BAR), c.MISC + 8);
    float* const out = args.out;
#pragma unroll 1
    for (int ph = lo; ph < hi; ++ph) {
        const int layer = ph >= 7 ? 1 : 0;
        const int nrep = (ph == REP_PH) ? REP_N : 1;
#pragma unroll 1
        for (int rep = 0; rep < nrep; ++rep) {
        c.qoff = 4 * rep;
        { int t_ = threadIdx.x; asm volatile("" : "+v"(t_)); c.tid = t_; c.lane = t_ & 63; c.wave = __builtin_amdgcn_readfirstlane(t_ >> 6); }
        if (ph == 0 && PHON(0)) p0_prologue(c, args);
        else if ((ph == 1 || ph == 7) && PHON(1)) {
            pg8::Gemm g{(const pg8::bf16_t*)(ws + WS_XB), (const pg8::bf16_t*)(ws + (ph == 1 ? WS_WIN0 : WS_WIN1)), MT, 0, 1024};
            pg8::SchedX S; if (ph == 1) S.init(MT, ZC0, c.G, (int)blockIdx.x, 16, MT / 256, 4, 13); else S.init(MT, ZC1, c.G, (int)blockIdx.x, 0, 0, 1, 0);
            pg8::EpiZ E{(pg8::bf16_t*)(ws + WS_Z), ph == 1 ? ZC0 : ZC1, ssptr(c, ph == 1 ? 0 : 2), ph == 1 ? 13 : 9, (float*)(ws + WS_MEMKV), MEMROW0};
            pg8::gemm_phase<pg8::EpiZ, pg8::SchedX, PG8_ALIGN, PG8_SP2>(c.lds + RING_OFF, g, S, E);
        }
        else if (ph == 2 && PHON(2)) p2_mixer0(c, args);
        else if ((ph == 3 || ph == 6 || ph == 12 || ph == 15) && PHON(3)) {
            const bool isout = (ph == 3 || ph == 12);
            pg8::Gemm g{(const pg8::bf16_t*)(ws + (isout ? WS_MIX : WS_ACT)), (const pg8::bf16_t*)(ws + (isout ? WS_WOUT + (size_t)layer * 1024 * 1024 * 2 : WS_WD + (size_t)layer * 1024 * DFF * 2)), MT, 1024, isout ? 1024 : DFF};
            pg8::SchedX S; S.init(MT, 1024, c.G, (int)blockIdx.x, 0, 0, 1, 0);
            pg8::EpiResid E;
            E.rp = ph == 3 ? args.in[0] : out + O_YP; E.rs = ph == 3 ? args.in[1] : out + O_YS; E.y = out + O_YP;
            E.xb = ph == 15 ? nullptr : (pg8::bf16_t*)(ws + WS_XB); E.ssout = ph == 15 ? nullptr : ssptr(c, ph == 3 ? 1 : (ph == 6 ? 2 : 3));
            pg8::gemm_phase<pg8::EpiResid, pg8::SchedX, PG8_ALIGN, PG8_SP2>(c.lds + RING_OFF, g, S, E);
        }
        else if ((ph == 4 || ph == 13) && PHON(4)) {
            pg8::Gemm g{(const pg8::bf16_t*)(ws + WS_XB), (const pg8::bf16_t*)(ws + WS_WGU + (size_t)layer * 5632 * 1024 * 2), MT, 5632, 1024};
            pg8::SchedX S; S.init(MT, 5632, c.G, (int)blockIdx.x, 0, 0, 1, 0);
            pg8::EpiGU E{(pg8::bf16_t*)(ws + WS_U), (pg8::bf16_t*)(ws + WS_UP), ssptr(c, layer ? 3 : 1), out + O_CVP + (size_t)layer * 4 * 2 * DFF, out + O_CVS + (size_t)layer * 32 * 2 * DFF};
            pg8::gemm_phase<pg8::EpiGU, pg8::SchedX, PG8_ALIGN, PG8_SP2>(c.lds + RING_OFF, g, S, E);
        }
        else if ((ph == 5 || ph == 14) && PHON(5)) p5_convact(c, args, layer);
        else if (ph == 8 && PHON(8)) p8_dsa_post(c, args);
        else if (ph == 9 && PHON(9)) p9_indexer(c, args);
        else if (ph == 10 && PHON(10)) p10_topk(c, args);
        else if (ph == 11 && PHON(11)) p11_attention(c, args);
        if (rep + 1 < nrep) xcd_barrier(bar);
        }
        if (ph + 1 < hi) xcd_barrier(bar);
    }
}

#ifndef MK_ONE_LAUNCH
#define MK_ONE_LAUNCH 1
#endif
extern "C" void kernel_launch(void* const* d_in, const int* in_sizes, int n_in, void* d_out, int out_size, void* d_ws, size_t ws_size, hipStream_t stream) {
    static int grid = 0;
    if (grid == 0) {
        if (n_in != 29 || out_size != (int)O_END || ws_size < WS_END) { fprintf(stderr, "kernel_launch: unexpected problem (n_in %d, out %d, ws %zu)\n", n_in, out_size, ws_size); grid = -1; return; }
        int dev = 0, cus = 0;
        if (hipGetDevice(&dev) != hipSuccess || hipDeviceGetAttribute(&cus, hipDeviceAttributeMultiprocessorCount, dev) != hipSuccess) { grid = -1; return; }
        if (hipFuncSetAttribute((const void*)fwd_kernel, hipFuncAttributeMaxDynamicSharedMemorySize, LDS_BYTES) != hipSuccess) { fprintf(stderr, "kernel_launch: hipFuncSetAttribute failed\n"); grid = -1; return; }
        (void)hipGetLastError();
        grid = cus;
    }
    if (grid < 0) return;
    if (hipMemsetAsync((char*)d_ws + WS_CTL, 0, CTL_ZERO_BYTES, stream) != hipSuccess) { fprintf(stderr, "kernel_launch: memset failed\n"); return; }
    Args a{};
    for (int i = 0; i < 29; ++i) a.in[i] = (const float*)d_in[i];
    a.page_table = (const int*)d_in[9]; a.out = (float*)d_out; a.ws = (unsigned char*)d_ws;
#if MK_ONE_LAUNCH
    a.ph_lo = 0; a.ph_hi = NPHASE;
    hipLaunchKernelGGL(fwd_kernel, dim3(grid), dim3(NWAVES * 64), LDS_BYTES, stream, a);
#else
    for (int ph = 0; ph < NPHASE; ++ph) { a.ph_lo = ph; a.ph_hi = ph + 1; hipLaunchKernelGGL(fwd_kernel, dim3(grid), dim3(NWAVES * 64), LDS_BYTES, stream, a); }
#endif
}
```

```cpp
#include <hip/hip_runtime.h>
#include <cstdio>
#include <cstdint>


namespace pg8 {
#define PG8_LAS __attribute__((address_space(3)))
typedef unsigned short bf16_t;
typedef short bf16x8 __attribute__((ext_vector_type(8)));
typedef float f32x4 __attribute__((ext_vector_type(4)));
typedef unsigned u32x4 __attribute__((ext_vector_type(4)));
constexpr int BM = 256, BK = 64, HALF = 128, HTB = HALF * BK * 2  , STAGE_BYTES = 8 * HTB, NXCD = 8, WGM = 8;

__host__ __device__ __forceinline__ int lds_byte(int r, int c) { const int st = (r >> 4) * 2 + (c >> 5), rr = r & 15, cc = c & 31, ob = rr * 64 + cc * 2; return st * 1024 + (ob ^ (((ob >> 9) & 1) << 5)); }
__host__ __device__ __forceinline__ void stage_rc(int b, int& R, int& C) { const int st = b / 1024, sb = b % 1024, swz = sb ^ (((sb >> 9) & 1) << 5); R = (st >> 1) * 16 + swz / 64; C = (st & 1) * 32 + (swz % 64) / 2; }
__host__ __device__ __forceinline__ int perm32(int rho) { const int n = rho >> 4, i = rho & 15; return 8 * (i >> 2) + 4 * n + (i & 3); }

struct Unit { int pm, pn; };
struct Gemm { const bf16_t* A; const bf16_t* Bt; int M, N, K; };

struct StaticOrder {
    int nM, nN, nwg, G, c;
    __host__ __device__ void init(int M, int N, int G_, int c_) { nM = M / BM; nN = N / BM; nwg = nM * nN; G = G_; c = c_; }
    __host__ __device__ bool next(int i, Unit& u) const {
        const long L = (long)i * G + c; if (L >= nwg) return false;
        int wgid = (int)L; { const int q = nwg / NXCD, r = nwg % NXCD, xcd = wgid % NXCD, off = wgid / NXCD; wgid = (xcd < r ? xcd * (q + 1) : r * (q + 1) + (xcd - r) * q) + off; }
        const int nig = WGM * nN, gid = wgid / nig, fm = gid * WGM, gsz = (nM - fm) < WGM ? (nM - fm) : WGM;
        u.pm = fm + ((wgid % nig) % gsz); u.pn = (wgid % nig) / gsz; return true;
    }
    __device__ __forceinline__ void a_ready(const Unit&) const {}
    __device__ __forceinline__ void done(const Unit&) const {}
};


constexpr int MP = 16384, MS = 128, MVALID = MP + MS, MT = 16640, DM = 1024, DFF = 2816;
constexpr float RMS_EPS = 1e-6f;
__device__ __forceinline__ unsigned cvt_pk_bf16(float lo, float hi) { unsigned r; asm volatile("v_cvt_pk_bf16_f32 %0, %1, %2" : "=v"(r) : "v"(lo), "v"(hi)); return r; }

struct SchedX {
    StaticOrder so; int nextra, e_pm0, e_nm, e_pn0;
    __device__ void init(int M, int N, int G_, int c_, int nextra_, int e_pm0_, int e_nm_, int e_pn0_) { so.init(M, N, G_, c_); nextra = nextra_; e_pm0 = e_pm0_; e_nm = e_nm_; e_pn0 = e_pn0_; }
    __device__ bool next(int i, Unit& u) const {
        const long L = (long)i * so.G + so.c;
        if (L < so.nwg) return so.next(i, u);
        const int e = (int)(L - so.nwg); if (e >= nextra) return false;
        u.pm = e_pm0 + e % e_nm; u.pn = e_pn0 + e / e_nm; return true;
    }
    __device__ __forceinline__ void a_ready(const Unit&) const {}
    __device__ __forceinline__ void done(const Unit&) const {}
};

struct EpiZ {
    static constexpr bool PERM = true, AFTER_DRAIN = false;
    bf16_t* Z; int ldz; const float* ss; int nmain; float* memkv; int memrow0;
    __device__ __forceinline__ void operator()(const f32x4 (&acc)[2][2][4][2], const Unit& u, int wr, int wc, int fr, int fq) const {
        const int row0 = u.pm * BM + wr * 64 + fr;
        if (u.pn < nmain) {
            const int col0 = u.pn * BM + wc * 32 + 8 * fq;
#pragma unroll
            for (int ai = 0; ai < 2; ++ai)
#pragma unroll
                for (int m = 0; m < 4; ++m) { const int row = row0 + ai * HALF + m * 16; const float rs = rsqrtf(ss[row] * (1.0f / DM) + RMS_EPS);
#pragma unroll
                    for (int bj = 0; bj < 2; ++bj) { const f32x4 v0 = acc[ai][bj][m][0] * rs, v1 = acc[ai][bj][m][1] * rs;
                        u32x4 w; w.x = cvt_pk_bf16(v0[0], v0[1]); w.y = cvt_pk_bf16(v0[2], v0[3]); w.z = cvt_pk_bf16(v1[0], v1[1]); w.w = cvt_pk_bf16(v1[2], v1[3]);
                        *(u32x4*)(Z + (size_t)row * ldz + col0 + bj * HALF) = w; } }
        } else {
            const int col0 = (u.pn - nmain) * BM + wc * 32 + 8 * fq;
#pragma unroll
            for (int ai = 0; ai < 2; ++ai)
#pragma unroll
                for (int m = 0; m < 4; ++m) { const int row = row0 + ai * HALF + m * 16 - memrow0;
#pragma unroll
                    for (int bj = 0; bj < 2; ++bj) { float* p = memkv + (size_t)row * 1024 + col0 + bj * HALF; *(f32x4*)p = acc[ai][bj][m][0]; *(f32x4*)(p + 4) = acc[ai][bj][m][1]; } }
        }
    }
};

struct EpiResid {
    static constexpr bool PERM = true, AFTER_DRAIN = false;
    const float* rp; const float* rs; float* y; bf16_t* xb; float* ssout;
    __device__ __forceinline__ void operator()(const f32x4 (&acc)[2][2][4][2], const Unit& u, int wr, int wc, int fr, int fq) const {
        const int row0 = u.pm * BM + wr * 64 + fr, col0 = u.pn * BM + wc * 32 + 8 * fq;
#pragma unroll
        for (int ai = 0; ai < 2; ++ai)
#pragma unroll
            for (int m = 0; m < 4; ++m) { const int row = row0 + ai * HALF + m * 16; float part = 0.f;
                if (row < MVALID) { const float* src = row < MP ? rp + (size_t)row * DM : rs + (size_t)(row - MP) * DM;
#pragma unroll
                    for (int bj = 0; bj < 2; ++bj) { const int c = col0 + bj * HALF;
                        const f32x4 v0 = acc[ai][bj][m][0] + *(const f32x4*)(src + c), v1 = acc[ai][bj][m][1] + *(const f32x4*)(src + c + 4);
                        *(f32x4*)(y + (size_t)row * DM + c) = v0; *(f32x4*)(y + (size_t)row * DM + c + 4) = v1;
                        part += (v0[0] * v0[0] + v0[1] * v0[1]) + (v0[2] * v0[2] + v0[3] * v0[3]) + (v1[0] * v1[0] + v1[1] * v1[1]) + (v1[2] * v1[2] + v1[3] * v1[3]);
                        if (xb) { u32x4 w; w.x = cvt_pk_bf16(v0[0], v0[1]); w.y = cvt_pk_bf16(v0[2], v0[3]); w.z = cvt_pk_bf16(v1[0], v1[1]); w.w = cvt_pk_bf16(v1[2], v1[3]);
                            *(u32x4*)(xb + (size_t)row * DM + c) = w; } } }
                part += __shfl_xor(part, 16); part += __shfl_xor(part, 32);
                if (ssout && fq == 0 && row < MVALID) atomicAdd(ssout + row, part); }
    }
};

struct EpiGU {
    static constexpr bool PERM = true, AFTER_DRAIN = false;
    bf16_t* U; bf16_t* UP; const float* ss; float* cvp; float* cvs;
    __device__ __forceinline__ void operator()(const f32x4 (&acc)[2][2][4][2], const Unit& u, int wr, int wc, int fr, int fq) const {
        const int row0 = u.pm * BM + wr * 64 + fr, colg = u.pn * HALF + wc * 32 + 8 * fq;
#pragma unroll
        for (int ai = 0; ai < 2; ++ai)
#pragma unroll
            for (int m = 0; m < 4; ++m) { const int row = row0 + ai * HALF + m * 16; const float rs = rsqrtf(ss[row] * (1.0f / DM) + RMS_EPS);
                const f32x4 g0 = acc[ai][0][m][0] * rs, g1 = acc[ai][0][m][1] * rs, p0 = acc[ai][1][m][0] * rs, p1 = acc[ai][1][m][1] * rs;
                u32x4 w; w.x = cvt_pk_bf16(g0[0], g0[1]); w.y = cvt_pk_bf16(g0[2], g0[3]); w.z = cvt_pk_bf16(g1[0], g1[1]); w.w = cvt_pk_bf16(g1[2], g1[3]);
                *(u32x4*)(U + (size_t)row * DFF + colg) = w;
                w.x = cvt_pk_bf16(p0[0], p0[1]); w.y = cvt_pk_bf16(p0[2], p0[3]); w.z = cvt_pk_bf16(p1[0], p1[1]); w.w = cvt_pk_bf16(p1[2], p1[3]);
                *(u32x4*)(UP + (size_t)row * DFF + colg) = w;
                float* cv = nullptr;
                if (row < MP) { const int t = row & 4095; if (t >= 4094) cv = cvp + (size_t)((row >> 12) * 2 + (t - 4094)) * DFF; }
                else if (row < MVALID) { const int r2 = row - MP, t = r2 & 3; if (t >= 2) cv = cvs + (size_t)((r2 >> 2) * 2 + (t - 2)) * DFF; }
                if (cv) { *(f32x4*)(cv + colg) = g0; *(f32x4*)(cv + colg + 4) = g1; } }
    }
};

template <class Epi, class Sched, bool ALIGN_EPI = false, bool SP2 = false>
__device__ __forceinline__ void gemm_phase(PG8_LAS unsigned char* lds, const Gemm g, const Sched& S, const Epi& E) {
    int tid_ = threadIdx.x; asm volatile("" : "+v"(tid_));
    const int tid = tid_, wid = __builtin_amdgcn_readfirstlane(tid >> 6), lane = tid & 63, wr = wid >> 2, wc = wid & 3, fr = lane & 15, fq = lane >> 4;
    const int K = g.K, nt = K / BK;
    unsigned voffA[2], voffB[2];
#pragma unroll
    for (int i = 0; i < 2; ++i) { int R, C; stage_rc(tid * 16 + i * 8192, R, C); const int Rb = Epi::PERM ? ((R & ~31) + perm32(R & 31)) : R;
        voffA[i] = (unsigned)(R * K + C) * 2u; voffB[i] = (unsigned)(Rb * K + C) * 2u; }
    const size_t kstep = (size_t)(BK * 2);
    const size_t hstep = (size_t)HALF * K * 2;
    const size_t tstep = 2 * hstep;
    const unsigned ldsw = (unsigned)wid * 1024u;
    const int aoff = lds_byte(wr * 64 + fr, fq * 8), boff = lds_byte(wc * 32 + fr, fq * 8);
#define PG8_SA(b, h) (((b) * 2 + (h)) * HTB)
#define PG8_SB(b, h) ((4 + (b) * 2 + (h)) * HTB)
#define PG8_STAGE(bufoff, gbase, voff) do { _Pragma("unroll") for (int _i = 0; _i < 2; ++_i) \
        __builtin_amdgcn_global_load_lds((const unsigned*)((const char*)(gbase) + (voff)[_i]), (PG8_LAS unsigned*)(lds + (bufoff) + ldsw + _i * 8192), 16, 0, 0); } while (0)
#define PG8_LDA(dst, b, h) do { _Pragma("unroll") for (int m = 0; m < 4; ++m) _Pragma("unroll") for (int k = 0; k < 2; ++k) dst[m][k] = *(const PG8_LAS bf16x8*)(lds + PG8_SA(b, h) + aoff + m * 2048 + k * 1024); } while (0)
#define PG8_LDB(dst, b, h) do { _Pragma("unroll") for (int n = 0; n < 2; ++n) _Pragma("unroll") for (int k = 0; k < 2; ++k) dst[n][k] = *(const PG8_LAS bf16x8*)(lds + PG8_SB(b, h) + boff + n * 2048 + k * 1024); } while (0)
#define PG8_MMA(ai, bj, At, Bt) do { __builtin_amdgcn_s_setprio(1); _Pragma("unroll") for (int m = 0; m < 4; ++m) _Pragma("unroll") for (int n = 0; n < 2; ++n) _Pragma("unroll") for (int k = 0; k < 2; ++k) \
        acc[ai][bj][m][n] = __builtin_amdgcn_mfma_f32_16x16x32_bf16(Bt[n][k], At[m][k], acc[ai][bj][m][n], 0, 0, 0); __builtin_amdgcn_s_setprio(0); } while (0)
#define PG8_WAIT_V(n) asm volatile("s_waitcnt vmcnt(" #n ")" ::: "memory")
#define PG8_WAIT_L(n) asm volatile("s_waitcnt lgkmcnt(" #n ")" ::: "memory")
#define PG8_BAR __builtin_amdgcn_s_barrier()
#define PG8_SCHED __builtin_amdgcn_sched_barrier(0)
    Unit cur, nxt; int ui = 0;
    if (!S.next(0, cur)) return;
    f32x4 acc[2][2][4][2];
#pragma unroll
    for (int a = 0; a < 2; ++a)
#pragma unroll
        for (int b = 0; b < 2; ++b)
#pragma unroll
            for (int m = 0; m < 4; ++m)
#pragma unroll
                for (int n = 0; n < 2; ++n) acc[a][b][m][n] = (f32x4){0.f, 0.f, 0.f, 0.f};
    bf16x8 At[4][2], B0[2][2], B1[2][2];
    const char* cA = (const char*)g.A + (size_t)cur.pm * tstep; const char* cB = (const char*)g.Bt + (size_t)cur.pn * tstep;
    S.a_ready(cur);
    if constexpr (SP2) {
        PG8_STAGE(PG8_SB(0, 0), cB, voffB); PG8_STAGE(PG8_SB(0, 1), cB + hstep, voffB); PG8_STAGE(PG8_SA(0, 0), cA, voffA); PG8_STAGE(PG8_SA(0, 1), cA + hstep, voffA);
        if (wr == 1) PG8_BAR;
        PG8_WAIT_V(2); PG8_BAR;
        PG8_STAGE(PG8_SB(1, 0), cB + kstep, voffB); PG8_STAGE(PG8_SA(1, 0), cA + kstep, voffA); PG8_STAGE(PG8_SB(1, 1), cB + hstep + kstep, voffB);
        PG8_WAIT_V(6); PG8_BAR;
    } else {
        PG8_STAGE(PG8_SB(0, 0), cB, voffB); PG8_STAGE(PG8_SA(0, 0), cA, voffA); PG8_STAGE(PG8_SB(0, 1), cB + hstep, voffB); PG8_STAGE(PG8_SA(0, 1), cA + hstep, voffA);
        if (wr == 1) PG8_BAR;
        PG8_WAIT_V(4); PG8_BAR;
        PG8_STAGE(PG8_SB(1, 0), cB + kstep, voffB); PG8_STAGE(PG8_SA(1, 0), cA + kstep, voffA); PG8_STAGE(PG8_SB(1, 1), cB + hstep + kstep, voffB);
        PG8_WAIT_V(6); PG8_BAR;
    }
    for (;;) {
        const bool has_next = S.next(ui + 1, nxt);
        const char* nA = has_next ? (const char*)g.A + (size_t)nxt.pm * tstep : cA; const char* nB = has_next ? (const char*)g.Bt + (size_t)nxt.pn * tstep : cB;
        for (int t = 0; t < nt; t += 2) {
            const bool last = (t == nt - 2);
            const char* a1 = cA + (size_t)(t + 1) * kstep;
            const char* a2 = last ? nA : cA + (size_t)(t + 2) * kstep; const char* b2 = last ? nB : cB + (size_t)(t + 2) * kstep;
            const char* a3 = a2 + kstep; const char* b3 = b2 + kstep;
            if (last && has_next) S.a_ready(nxt);
            if constexpr (SP2) {
            PG8_LDB(B0, 0, 0); PG8_LDB(B1, 0, 1); PG8_SCHED; PG8_LDA(At, 0, 0); PG8_STAGE(PG8_SA(1, 1), a1 + hstep, voffA);
            PG8_WAIT_V(8); PG8_WAIT_L(0); PG8_BAR; PG8_MMA(0, 0, At, B0); PG8_MMA(0, 1, At, B1); PG8_BAR; PG8_SCHED;
            PG8_LDA(At, 0, 1); PG8_STAGE(PG8_SB(0, 0), b2, voffB); PG8_STAGE(PG8_SB(0, 1), b2 + hstep, voffB); PG8_STAGE(PG8_SA(0, 0), a2, voffA);
            PG8_WAIT_V(8); PG8_WAIT_L(0); PG8_BAR; PG8_MMA(1, 0, At, B0); PG8_MMA(1, 1, At, B1); PG8_BAR; PG8_SCHED;
            PG8_LDB(B0, 1, 0); PG8_LDB(B1, 1, 1); PG8_SCHED; PG8_LDA(At, 1, 0); PG8_STAGE(PG8_SA(0, 1), a2 + hstep, voffA);
            PG8_WAIT_V(8); PG8_WAIT_L(0); PG8_BAR; PG8_MMA(0, 0, At, B0); PG8_MMA(0, 1, At, B1); PG8_BAR; PG8_SCHED;
            PG8_LDA(At, 1, 1); PG8_STAGE(PG8_SB(1, 0), b3, voffB); PG8_STAGE(PG8_SB(1, 1), b3 + hstep, voffB); PG8_STAGE(PG8_SA(1, 0), a3, voffA);
            PG8_WAIT_V(8); PG8_WAIT_L(0); PG8_BAR; PG8_MMA(1, 0, At, B0); PG8_MMA(1, 1, At, B1); PG8_BAR; PG8_SCHED;
            } else {
            PG8_LDB(B0, 0, 0); PG8_SCHED; PG8_LDA(At, 0, 0); PG8_STAGE(PG8_SA(1, 1), a1 + hstep, voffA);
            PG8_WAIT_L(8); PG8_BAR; PG8_WAIT_L(0); PG8_MMA(0, 0, At, B0); PG8_BAR; PG8_SCHED;
            PG8_LDB(B1, 0, 1); PG8_STAGE(PG8_SB(0, 0), b2, voffB);
            PG8_BAR; PG8_WAIT_L(0); PG8_MMA(0, 1, At, B1); PG8_BAR;
            PG8_LDA(At, 0, 1); PG8_STAGE(PG8_SA(0, 0), a2, voffA);
            PG8_BAR; PG8_WAIT_L(0); PG8_MMA(1, 0, At, B0); PG8_BAR; PG8_SCHED;
            PG8_STAGE(PG8_SB(0, 1), b2 + hstep, voffB);
            PG8_WAIT_V(6); PG8_BAR; PG8_MMA(1, 1, At, B1); PG8_BAR;
            PG8_LDB(B0, 1, 0); PG8_SCHED; PG8_LDA(At, 1, 0); PG8_STAGE(PG8_SA(0, 1), a2 + hstep, voffA);
            PG8_WAIT_L(8); PG8_BAR; PG8_WAIT_L(0); PG8_MMA(0, 0, At, B0); PG8_BAR; PG8_SCHED;
            PG8_LDB(B1, 1, 1); PG8_STAGE(PG8_SB(1, 0), b3, voffB);
            PG8_BAR; PG8_WAIT_L(0); PG8_MMA(0, 1, At, B1); PG8_BAR;
            PG8_LDA(At, 1, 1); PG8_STAGE(PG8_SA(1, 0), a3, voffA);
            PG8_BAR; PG8_WAIT_L(0); PG8_MMA(1, 0, At, B0); PG8_BAR; PG8_SCHED;
            PG8_STAGE(PG8_SB(1, 1), b3 + hstep, voffB);
            PG8_WAIT_V(6); PG8_BAR; PG8_MMA(1, 1, At, B1); PG8_BAR;
            }
        }
        if constexpr (ALIGN_EPI) { if (wr == 0) PG8_BAR; }
        if constexpr (!Epi::AFTER_DRAIN) { E(acc, cur, wr, wc, fr, fq); S.done(cur); }
        if (!has_next) break;
#pragma unroll
        for (int a = 0; a < 2; ++a)
#pragma unroll
            for (int b = 0; b < 2; ++b)
#pragma unroll
                for (int m = 0; m < 4; ++m)
#pragma unroll
                    for (int n = 0; n < 2; ++n) acc[a][b][m][n] = (f32x4){0.f, 0.f, 0.f, 0.f};
        cur = nxt; cA = nA; cB = nB; ++ui;
        if constexpr (ALIGN_EPI) { if (wr == 1) PG8_BAR; }
    }
    PG8_WAIT_V(0);
    if constexpr (!ALIGN_EPI) { if (wr == 0) PG8_BAR; }
    PG8_BAR;
    if constexpr (Epi::AFTER_DRAIN) { E.fused(acc, cur, wr, wc, fr, fq, lds, wid, lane); S.done(cur); }
#undef PG8_SA
#undef PG8_SB
#undef PG8_STAGE
#undef PG8_LDA
#undef PG8_LDB
#undef PG8_MMA
#undef PG8_WAIT_V
#undef PG8_WAIT_L
#undef PG8_BAR
#undef PG8_SCHED
}
}


#ifndef PG8_SP2
#define PG8_SP2 true
#endif
#ifndef PG8_ALIGN
#define PG8_ALIGN true
#endif
constexpr int NWAVES = 8;
constexpr int MP = pg8::MP, MS = pg8::MS, MVALID = pg8::MVALID, MT = pg8::MT, DM = 1024, DFF = 2816;
constexpr int SEQ = 4096, NB = 4, NSB = 32, PAST = 8192, NPOOL = 2560;
constexpr int ZC0 = 3328, ZC1 = 2304;
constexpr int Z1_Q = 0, Z1_K = 768, Z1_V = 1024, Z1_IQ = 1280, Z1_IK = 1792, Z1_IW = 1856, Z1_MQ = 1920;
constexpr int NMEMROWS = 1024, MEMROW0 = MT;
constexpr float EPS = 1e-6f;
constexpr size_t MiB = 1u << 20;
constexpr size_t WS_CTL = 0, CTL_ZERO_BYTES = 2 * MiB;
constexpr size_t WS_WIN0 = 2 * MiB, WS_WIN1 = 11 * MiB, WS_WOUT = 16 * MiB, WS_WGU = 20 * MiB, WS_WD = 42 * MiB;
constexpr size_t WS_XB = 54 * MiB, WS_MEMKV = 89 * MiB, WS_MIX = 94 * MiB, WS_Z = 128 * MiB, WS_U = 234 * MiB, WS_UP = 324 * MiB, WS_ACT = 414 * MiB;
constexpr size_t WS_QB = 504 * MiB, WS_KB = 528 * MiB, WS_VB = 536 * MiB, WS_IQB = 544 * MiB, WS_IKB = 560 * MiB, WS_IW = 562 * MiB;
constexpr size_t WS_SQ = 563 * MiB, WS_SIQ = WS_SQ + 512 * 1024, WS_SIW = WS_SIQ + 384 * 1024, WS_SSC = 564 * MiB, WS_SIDX = 569 * MiB, WS_MASK = 570 * MiB, WS_SC = 578 * MiB, WS_END = 834 * MiB;
constexpr int SSC_LD = 8256;
constexpr int CW_TMO = 0, CW_BAR = 4096, CW_Q = 8192, CW_SS = 16384;
constexpr size_t O_YP = 0, O_YS = O_YP + (size_t)MP * DM, O_HP = O_YS + (size_t)MS * DM, O_HS = O_HP + 4 * 6 * 16384, O_KP = O_HS + 32 * 6 * 16384,
    O_VP = O_KP + (size_t)MP * 256, O_IKP = O_VP + (size_t)MP * 256, O_KS = O_IKP + (size_t)MP * 64, O_VS = O_KS + MS * 256, O_IKS = O_VS + MS * 256,
    O_MK = O_IKS + MS * 64, O_MV = O_MK + 2 * 1024 * 256, O_CVP = O_MV + 2 * 1024 * 256, O_CVS = O_CVP + 2 * 4 * 2 * DFF, O_END = O_CVS + 2 * 32 * 2 * DFF;
static_assert(O_END == 31412224, "output size");
constexpr int RING_OFF = 0, RING_BYTES = 131072;
constexpr int LDSCTL_OFF = RING_BYTES, MISC_OFF = LDSCTL_OFF + 320;
constexpr int LDS_BYTES = 147456;

#define GAS __attribute__((address_space(1)))
#define LAS __attribute__((address_space(3)))
typedef unsigned short bf16;
typedef unsigned v4u __attribute__((ext_vector_type(4)));
typedef float f32x4 __attribute__((ext_vector_type(4)));
typedef short bf16x8 __attribute__((ext_vector_type(8)));
typedef GAS unsigned gu32;
typedef GAS unsigned long long gu64;
#define RLX_AGENT __ATOMIC_RELAXED, __HIP_MEMORY_SCOPE_AGENT
#define LDS_WAIT() asm volatile("s_waitcnt lgkmcnt(0)" ::: "memory")
#define VM_WAIT() asm volatile("s_waitcnt vmcnt(0)" ::: "memory")
__device__ __forceinline__ unsigned long long rt() { return __builtin_amdgcn_s_memrealtime(); }
__device__ __forceinline__ unsigned f2bf(float f) { unsigned u = __builtin_bit_cast(unsigned, f); return (u + 0x7fffu + ((u >> 16) & 1u)) >> 16; }
__device__ __forceinline__ unsigned pk2(float lo, float hi) { return f2bf(lo) | (f2bf(hi) << 16); }

#define XB_TMO      128
#define XB_XCNT(j)  (256  + 64 * (j))
#define XB_XSUB(j)  (1280 + 64 * (j))
#define XB_XGEN(j)  (2304 + 64 * (j))
#define XB_TOP      3328
#define XB_TOPGEN   3392
#define XCD_BAR_WORDS 3456
#define XB_SPIN_CAP (1u << 18)

__device__ __forceinline__ unsigned xb_ld(unsigned* p)              { return __hip_atomic_load(p, __ATOMIC_RELAXED, __HIP_MEMORY_SCOPE_AGENT); }
__device__ __forceinline__ unsigned xb_add(unsigned* p, unsigned v) { return __hip_atomic_fetch_add(p, v, __ATOMIC_RELAXED, __HIP_MEMORY_SCOPE_AGENT); }
__device__ __forceinline__ unsigned xb_xcc_id() { return (unsigned)__builtin_amdgcn_s_getreg((3 << 11) | 20) & 0xFu; }
#define XB_SPIN(cond, bar) do { unsigned _sp = 0; while (cond) { __builtin_amdgcn_s_sleep(1); \
    if ((++_sp & 255u) == 0u) { if (xb_ld(&(bar)[XB_TMO])) break; if (_sp > XB_SPIN_CAP) { atomicAdd(&(bar)[XB_TMO], 1u); break; } } } } while (0)

struct XcdBarrier {
    unsigned* bar; unsigned x;
    volatile LAS unsigned* st;
};

__device__ __forceinline__ XcdBarrier xcd_barrier_post(unsigned* bar, volatile LAS unsigned* st) {
    XcdBarrier b; b.bar = bar; b.x = xb_xcc_id(); b.st = st;
    if (threadIdx.x == 0) (void)xb_add(&bar[XB_XCNT(b.x)], 1u);
    return b;
}
__device__ __forceinline__ void xcd_barrier_complete(unsigned* bar, unsigned x, unsigned& nloc, unsigned& nx) {
    const unsigned G = gridDim.x * gridDim.y * gridDim.z;
    unsigned sum, cnt, mine, sp = 0u;
    for (;;) {
        sum = 0u; cnt = 0u; mine = 0u;
#pragma unroll
        for (unsigned j = 0; j < 16; ++j) { const unsigned c = xb_ld(&bar[XB_XCNT(j)]); sum += c; cnt += (c > 0u) ? 1u : 0u; mine = (j == x) ? c : mine; }
        if (sum == G) break;
        __builtin_amdgcn_s_sleep(1);
        if ((++sp & 255u) == 0u) { if (xb_ld(&bar[XB_TMO])) break; if (sp > XB_SPIN_CAP) { atomicAdd(&bar[XB_TMO], 1u); break; } }
    }
    nloc = mine > 0u ? mine : 1u; nx = cnt > 0u ? cnt : 1u;
}

__device__ __forceinline__ void xcd_barrier(const XcdBarrier& b) {
    asm volatile("s_waitcnt vmcnt(0)" ::: "memory");
    __syncthreads();
    if (threadIdx.x == 0) {
        unsigned* bar = b.bar;
        __builtin_amdgcn_s_waitcnt(0);
        unsigned nloc = b.st[0], nx = b.st[1];
        if (nloc == 0u) { xcd_barrier_complete(bar, b.x, nloc, nx); b.st[0] = nloc; b.st[1] = nx; }
        const unsigned old = xb_add(&bar[XB_XSUB(b.x)], 1u);
        const unsigned gen = old / nloc;
        if (old + 1u == (gen + 1u) * nloc) {
            __builtin_amdgcn_fence(__ATOMIC_RELEASE, "agent");
            asm volatile("s_waitcnt vmcnt(0)" ::: "memory");
            const unsigned og = xb_add(&bar[XB_TOP], 1u);
            const unsigned tg = og / nx;
            if (og + 1u == (tg + 1u) * nx) xb_add(&bar[XB_TOPGEN], 1u);
            else XB_SPIN(xb_ld(&bar[XB_TOPGEN]) == tg, bar);
            __builtin_amdgcn_fence(__ATOMIC_ACQUIRE, "agent");
            xb_add(&bar[XB_XGEN(b.x)], 1u);
            asm volatile("s_waitcnt vmcnt(0)" ::: "memory");
        } else {
            XB_SPIN(xb_ld(&bar[XB_XGEN(b.x)]) == gen, bar);
            __builtin_amdgcn_fence(__ATOMIC_ACQUIRE, "agent");
            asm volatile("s_waitcnt vmcnt(0)" ::: "memory");
        }
    }
    __syncthreads();
}


struct Args { const float* in[29]; const int* page_table; float* out; unsigned char* ws; int ph_lo, ph_hi; };
struct Ctx { LAS unsigned char* lds; volatile LAS unsigned* MISC; gu32* ctl; int tid, lane, wave, vcu, G, qoff; };
typedef float f32x16 __attribute__((ext_vector_type(16)));
typedef unsigned long long u64;

__device__ __forceinline__ float bf2f(unsigned b) { return __builtin_bit_cast(float, b << 16); }
__device__ __forceinline__ float wave_sum(float v) {
#pragma unroll
    for (int o = 1; o < 64; o <<= 1) v += __shfl_xor(v, o);
    return v;
}
__device__ __forceinline__ int crow(int r, int hi) { return (r & 3) + 8 * (r >> 2) + 4 * hi; }
__device__ __forceinline__ float sigmoidf_(float x) { return 1.0f / (1.0f + __expf(-x)); }
__device__ __forceinline__ float* ssptr(const Ctx& c, int i) { return (float*)(c.ctl + CW_SS) + (size_t)i * MT; }

__device__ __forceinline__ int q_next(Ctx& c, int qi) {
    __syncthreads();
    if (c.tid == 0) c.MISC[16] = atomicAdd((unsigned*)(c.ctl + CW_Q + 64 * (qi + c.qoff)), 1u);
    __syncthreads();
    return (int)c.MISC[16];
}

template <int K>
__device__ __forceinline__ f32x16 mm32(const LAS bf16* A, int lda, const LAS bf16* Bt, int ldb, f32x16 acc, int lane) {
    const int r = lane & 31, h = lane >> 5;
#pragma unroll
    for (int ks = 0; ks < K; ks += 16) {
        const bf16x8 a = *(const LAS bf16x8*)(A + r * lda + ks + 8 * h);
        const bf16x8 b = *(const LAS bf16x8*)(Bt + r * ldb + ks + 8 * h);
        acc = __builtin_amdgcn_mfma_f32_32x32x16_bf16(a, b, acc, 0, 0, 0);
    }
    return acc;
}

__device__ __forceinline__ int map_row(int mapid, int n, int row_off) {
    if (mapid == 0) return n + row_off;
    if (mapid == 1) return n < 1864 ? n : n + 56;
    if (mapid == 2) return (n >> 7) * 256 + (n & 127);
    return (n >> 7) * 256 + 128 + (n & 127);
}
__device__ __forceinline__ void transpose_item(const float* W, int K, int N, const float* kscale, bf16* WT, int mapid, int row_off, LAS float* scr, int item, int lane) {
    const int nblk = (N + 31) / 32, kb = item / nblk, nb = item % nblk, k0 = 64 * kb, n0 = 32 * nb;
#pragma unroll 8
    for (int i = 0; i < 32; ++i) { const int kk = 2 * i + (lane >> 5), n = n0 + (lane & 31);
        float v = W[(size_t)(k0 + kk) * N + (n < N ? n : N - 1)]; if (kscale) v *= kscale[k0 + kk];
        scr[kk * 33 + (lane & 31)] = v; }
    LDS_WAIT(); asm volatile("" ::: "memory");
    const int cc = lane & 7;
#pragma unroll
    for (int j = 0; j < 4; ++j) { const int nl = (lane >> 3) + 8 * j, n = n0 + nl; const LAS float* s = scr + (8 * cc) * 33 + nl;
        v4u o; o.x = pk2(s[0 * 33], s[1 * 33]); o.y = pk2(s[2 * 33], s[3 * 33]); o.z = pk2(s[4 * 33], s[5 * 33]); o.w = pk2(s[6 * 33], s[7 * 33]);
        if (n < N) *(GAS v4u*)(WT + (size_t)map_row(mapid, n, row_off) * K + k0 + 8 * cc) = o; }
    LDS_WAIT(); asm volatile("" ::: "memory");
}
__device__ __forceinline__ void p0_prologue(Ctx& c, const Args& a) {
    LAS float* scr = (LAS float*)(c.lds + RING_OFF + c.wave * 16384);
    const int gw = c.vcu * NWAVES + c.wave, NGW = c.G * NWAVES, lane = c.lane;
    unsigned char* ws = a.ws;
    constexpr int I_INH = 16 * 104, I_MKV = 16 * 16, I_DSA = 16 * 67, I_OUT = 16 * 32, I_G = 16 * 88, I_D = 44 * 32;
    constexpr int NITEMS = I_INH + 2 * I_MKV + I_DSA + 2 * I_OUT + 4 * I_G + 2 * I_D;
    for (int it = gw; it < NITEMS; it += NGW) {
        int r = it;
        if (r < I_INH) { transpose_item(a.in[13], 1024, 3328, a.in[11], (bf16*)(ws + WS_WIN0), 0, 0, scr, r, lane); continue; } r -= I_INH;
        if (r < I_MKV) { transpose_item(a.in[20], 1024, 512, nullptr, (bf16*)(ws + WS_WIN0), 0, 3328, scr, r, lane); continue; } r -= I_MKV;
        if (r < I_MKV) { transpose_item(a.in[20] + 1024 * 512, 1024, 512, nullptr, (bf16*)(ws + WS_WIN0), 0, 3840, scr, r, lane); continue; } r -= I_MKV;
        if (r < I_DSA) { transpose_item(a.in[16], 1024, 2120, a.in[11] + 1024, (bf16*)(ws + WS_WIN1), 1, 0, scr, r, lane); continue; } r -= I_DSA;
        if (r < 2 * I_OUT) { const int l = r / I_OUT; transpose_item(a.in[23] + (size_t)l * 1024 * 1024, 1024, 1024, nullptr, (bf16*)(ws + WS_WOUT) + (size_t)l * 1024 * 1024, 0, 0, scr, r % I_OUT, lane); continue; } r -= 2 * I_OUT;
        if (r < 2 * I_G) { const int l = r / I_G; transpose_item(a.in[24] + (size_t)l * 1024 * DFF, 1024, DFF, a.in[12] + l * 1024, (bf16*)(ws + WS_WGU) + (size_t)l * 5632 * 1024, 2, 0, scr, r % I_G, lane); continue; } r -= 2 * I_G;
        if (r < 2 * I_G) { const int l = r / I_G; transpose_item(a.in[25] + (size_t)l * 1024 * DFF, 1024, DFF, a.in[12] + l * 1024, (bf16*)(ws + WS_WGU) + (size_t)l * 5632 * 1024, 3, 0, scr, r % I_G, lane); continue; } r -= 2 * I_G;
        { const int l = r / I_D; transpose_item(a.in[28] + (size_t)l * DFF * 1024, DFF, 1024, nullptr, (bf16*)(ws + WS_WD) + (size_t)l * 1024 * DFF, 0, 0, scr, r % I_D, lane); }
    }
    for (int rr = gw; rr < 184; rr += NGW) { const int row = rr < 56 ? 1864 + rr : 2176 + (rr - 56);
        GAS v4u* p = (GAS v4u*)((bf16*)(ws + WS_WIN1) + (size_t)row * 1024); p[lane] = (v4u){0u, 0u, 0u, 0u}; p[64 + lane] = (v4u){0u, 0u, 0u, 0u}; }
    float* ss0 = ssptr(c, 0);
    for (int m = gw; m < MT + NMEMROWS; m += NGW) {
        GAS u64* o8 = (GAS u64*)((bf16*)(ws + WS_XB) + (size_t)m * DM) + lane;
        if (m >= MVALID && m < MT) {
#pragma unroll
            for (int j = 0; j < 4; ++j) o8[64 * j] = 0ull;
            continue; }
        const float* src = m < MP ? a.in[0] + (size_t)m * DM : (m < MVALID ? a.in[1] + (size_t)(m - MP) * DM : a.in[10] + (size_t)(m - MT) * DM);
        const GAS f32x4* xr = (const GAS f32x4*)src + lane; f32x4 v[4]; float s = 0.f;
#pragma unroll
        for (int j = 0; j < 4; ++j) { v[j] = xr[64 * j]; s += (v[j].x * v[j].x + v[j].y * v[j].y) + (v[j].z * v[j].z + v[j].w * v[j].w); }
        s = wave_sum(s);
#pragma unroll
        for (int j = 0; j < 4; ++j) o8[64 * j] = (u64)pk2(v[j].x, v[j].y) | ((u64)pk2(v[j].z, v[j].w) << 32);
        if (m < MVALID && lane == 0) ss0[m] = s;
    }
}

__device__ __forceinline__ void memattn_unit(Ctx& c, const bf16* Zq  , int ldz, int nrows_valid, const float* Kp, const float* Vp, int kstride,
                                             bool normk, const float* kgain, const float* qgain, bf16* Out  ) {
    LAS bf16* KN = (LAS bf16*)(c.lds);
    LAS bf16* VTm = (LAS bf16*)(c.lds + 36864);
    LAS bf16* QN = (LAS bf16*)(c.lds + 70656) + c.wave * (32 * 72);
    LAS float* LI = (LAS float*)(c.lds + 107520) + c.wave * 32;
    int tid = c.tid; asm volatile("" : "+v"(tid));
    const int lane = tid & 63, w = c.wave;
    {
        const int m = tid >> 1, dh = (tid & 1) * 32;
        f32x4 kv[8]; float s = 0.f;
#pragma unroll
        for (int j = 0; j < 8; ++j) { kv[j] = *(const f32x4*)(Kp + (size_t)m * kstride + dh + 4 * j); s += (kv[j].x * kv[j].x + kv[j].y * kv[j].y) + (kv[j].z * kv[j].z + kv[j].w * kv[j].w); }
        s += __shfl_xor(s, 1);
        const float rs = normk ? rsqrtf(s * (1.0f / 64.0f) + EPS) : 1.0f;
#pragma unroll
        for (int j = 0; j < 8; j += 2) { f32x4 g0 = {1.f, 1.f, 1.f, 1.f}, g1 = g0;
            if (normk) { g0 = *(const f32x4*)(kgain + dh + 4 * j); g1 = *(const f32x4*)(kgain + dh + 4 * j + 4); }
            const f32x4 x0 = kv[j] * rs * g0, x1 = kv[j + 1] * rs * g1;
            v4u o; o.x = pk2(x0.x, x0.y); o.y = pk2(x0.z, x0.w); o.z = pk2(x1.x, x1.y); o.w = pk2(x1.z, x1.w);
            *(LAS v4u*)(KN + m * 72 + dh + 4 * j) = o; }
#pragma unroll
        for (int j = 0; j < 8; ++j) { const f32x4 vv = *(const f32x4*)(Vp + (size_t)m * kstride + dh + 4 * j);
            VTm[(dh + 4 * j + 0) * 264 + m] = (bf16)f2bf(vv.x); VTm[(dh + 4 * j + 1) * 264 + m] = (bf16)f2bf(vv.y);
            VTm[(dh + 4 * j + 2) * 264 + m] = (bf16)f2bf(vv.z); VTm[(dh + 4 * j + 3) * 264 + m] = (bf16)f2bf(vv.w); }
    }
    {
        const int row = lane >> 1, hf = lane & 1, grow = w * 32 + row;
        float x[32]; float s = 0.f;
        if (grow < nrows_valid) {
#pragma unroll
            for (int j = 0; j < 4; ++j) { const v4u q = *(const v4u*)(Zq + (size_t)grow * ldz + hf * 32 + 8 * j);
                x[8 * j + 0] = bf2f(q.x & 0xffffu); x[8 * j + 1] = bf2f(q.x >> 16); x[8 * j + 2] = bf2f(q.y & 0xffffu); x[8 * j + 3] = bf2f(q.y >> 16);
                x[8 * j + 4] = bf2f(q.z & 0xffffu); x[8 * j + 5] = bf2f(q.z >> 16); x[8 * j + 6] = bf2f(q.w & 0xffffu); x[8 * j + 7] = bf2f(q.w >> 16); }
        } else {
#pragma unroll
            for (int j = 0; j < 32; ++j) x[j] = 0.f;
        }
#pragma unroll
        for (int j = 0; j < 32; ++j) s += x[j] * x[j];
        s += __shfl_xor(s, 1);
        const float rs = rsqrtf(s * (1.0f / 64.0f) + EPS) * 0.125f;
#pragma unroll
        for (int j = 0; j < 32; j += 8) { v4u o;
            o.x = pk2(x[j] * rs * qgain[hf * 32 + j], x[j + 1] * rs * qgain[hf * 32 + j + 1]); o.y = pk2(x[j + 2] * rs * qgain[hf * 32 + j + 2], x[j + 3] * rs * qgain[hf * 32 + j + 3]);
            o.z = pk2(x[j + 4] * rs * qgain[hf * 32 + j + 4], x[j + 5] * rs * qgain[hf * 32 + j + 5]); o.w = pk2(x[j + 6] * rs * qgain[hf * 32 + j + 6], x[j + 7] * rs * qgain[hf * 32 + j + 7]);
            *(LAS v4u*)(QN + row * 72 + hf * 32 + j) = o; }
    }
    __syncthreads();
    if (w * 32 < nrows_valid) {
        const int r32 = lane & 31, hh = lane >> 5;
        f32x16 s[8];
#pragma unroll
        for (int mt = 0; mt < 8; ++mt) { f32x16 z = {}; s[mt] = mm32<64>(KN + mt * 32 * 72, 72, QN, 72, z, lane); }
        float mx = -1e30f;
#pragma unroll
        for (int mt = 0; mt < 8; ++mt)
#pragma unroll
            for (int r = 0; r < 16; ++r) mx = fmaxf(mx, s[mt][r]);
        mx = fmaxf(mx, __shfl_xor(mx, 32));
        float l = 0.f;
#pragma unroll
        for (int mt = 0; mt < 8; ++mt)
#pragma unroll
            for (int r = 0; r < 16; ++r) { const float p = __expf(s[mt][r] - mx); s[mt][r] = p; l += p; }
        l += __shfl_xor(l, 32);
        if (hh == 0) LI[r32] = l;
        f32x16 o[2] = {};
#pragma unroll
        for (int mt = 0; mt < 8; ++mt)
#pragma unroll
            for (int sx = 0; sx < 2; ++sx) {
                v4u pa; pa.x = pk2(s[mt][8 * sx + 0], s[mt][8 * sx + 1]); pa.y = pk2(s[mt][8 * sx + 2], s[mt][8 * sx + 3]);
                pa.z = pk2(s[mt][8 * sx + 4], s[mt][8 * sx + 5]); pa.w = pk2(s[mt][8 * sx + 6], s[mt][8 * sx + 7]);
                const bf16x8 af = __builtin_bit_cast(bf16x8, pa);
#pragma unroll
                for (int dt = 0; dt < 2; ++dt) { const LAS bf16* vp = VTm + (dt * 32 + r32) * 264 + mt * 32 + 16 * sx + 4 * hh;
                    const u64 lo = *(const LAS u64*)vp, hi = *(const LAS u64*)(vp + 8);
                    v4u bw; bw.x = (unsigned)lo; bw.y = (unsigned)(lo >> 32); bw.z = (unsigned)hi; bw.w = (unsigned)(hi >> 32);
                    o[dt] = __builtin_amdgcn_mfma_f32_32x32x16_bf16(af, __builtin_bit_cast(bf16x8, bw), o[dt], 0, 0, 0); }
            }
        LDS_WAIT();
#pragma unroll
        for (int r = 0; r < 16; ++r) { const int qr = crow(r, hh), grow = w * 32 + qr; const float il = 1.0f / LI[qr];
            if (grow < nrows_valid) {
#pragma unroll
                for (int dt = 0; dt < 2; ++dt) Out[(size_t)grow * DM + dt * 32 + r32] = (bf16)f2bf(o[dt][r] * il); } }
    }
}

__device__ __forceinline__ void hgrn_unit(Ctx& c, const Args& a, bool sample, int b, int h) {
    LAS unsigned char* L = c.lds;
    LAS float* LF = (LAS float*)(L + 0);
    LAS float* BL = (LAS float*)(L + 16384);
    LAS float* DVv = (LAS float*)(L + 16896);
    LAS bf16* QD = (LAS bf16*)(L + 17408);
    LAS bf16* KD = (LAS bf16*)(L + 26112);
    LAS bf16* KET = (LAS bf16*)(L + 34816);
    LAS bf16* VT = (LAS bf16*)(L + 45056);
    LAS bf16* SCB = (LAS bf16*)(L + 55296);
    LAS bf16* STt = (LAS bf16*)(L + 57856);
    int tid = c.tid; asm volatile("" : "+v"(tid));
    const int lane = tid & 63, w = c.wave, r32 = lane & 31, hh = lane >> 5;
    const int te = tid >> 4, k8 = (tid & 15) * 8;
    const bf16* Z = (const bf16*)(a.ws + WS_Z);
    bf16* MIX = (bf16*)(a.ws + WS_MIX);
    const int nch = sample ? 1 : 128, nvalid = sample ? 4 : 32;
    const int kt = w >> 1, vt0 = 2 * (w & 1);
    f32x16 S0 = {}, S1 = {};
    if (sample) { const float* sp = a.in[7] + (size_t)(b * 6 + h) * 16384;
#pragma unroll
        for (int r = 0; r < 16; ++r) { const int k = 32 * kt + crow(r, hh); S0[r] = sp[k * 128 + 32 * vt0 + r32]; S1[r] = sp[k * 128 + 32 * (vt0 + 1) + r32]; } }
    float lbv[8], onv[8];
#pragma unroll
    for (int j = 0; j < 8; ++j) { const float l0 = a.in[14][h * 128 + k8 + j], l1 = a.in[14][768 + h * 128 + k8 + j]; lbv[j] = 1.0f / (1.0f + __expf(l1 - l0)); onv[j] = a.in[15][k8 + j]; }
    __syncthreads();
#define HG_WRITE_ST() do { _Pragma("unroll") for (int g = 0; g < 4; ++g) { const int k0 = 32 * kt + 8 * g + 4 * hh; \
        *(LAS u64*)(STt + (32 * vt0 + r32) * 136 + k0) = (u64)pk2(S0[4 * g], S0[4 * g + 1]) | ((u64)pk2(S0[4 * g + 2], S0[4 * g + 3]) << 32); \
        *(LAS u64*)(STt + (32 * (vt0 + 1) + r32) * 136 + k0) = (u64)pk2(S1[4 * g], S1[4 * g + 1]) | ((u64)pk2(S1[4 * g + 2], S1[4 * g + 3]) << 32); } } while (0)
    HG_WRITE_ST();
    for (int ch = 0; ch < nch; ++ch) {
        const int row0 = sample ? MP + 4 * b : b * SEQ + 32 * ch, row = row0 + te;
        const bool valid = te < nvalid;
        float qs[8], kk[8]; v4u gz = {0u, 0u, 0u, 0u};
        {
            v4u zq = {0u, 0u, 0u, 0u}, zf = zq, zi = zq;
            if (valid) { const bf16* zr = Z + (size_t)row * ZC0 + h * 128 + k8;
                zq = *(const v4u*)zr; zf = *(const v4u*)(zr + 768); zi = *(const v4u*)(zr + 1536); gz = *(const v4u*)(zr + 2304); }
            const unsigned qw[4] = {zq.x, zq.y, zq.z, zq.w}, fw[4] = {zf.x, zf.y, zf.z, zf.w}, iw[4] = {zi.x, zi.y, zi.z, zi.w};
            float lf[8];
#pragma unroll
            for (int j = 0; j < 8; ++j) { const float q = bf2f((qw[j >> 1] >> (16 * (j & 1))) & 0xffffu), fp = bf2f((fw[j >> 1] >> (16 * (j & 1))) & 0xffffu);
                const float sg = sigmoidf_(fp), f = lbv[j] + (1.0f - lbv[j]) * sg;
                qs[j] = valid ? q * sigmoidf_(q) : 0.f; kk[j] = valid ? (1.0f - f) : 0.f; lf[j] = valid ? __logf(f) : 0.f;
                VT[(k8 + j) * 40 + te] = (bf16)((iw[j >> 1] >> (16 * (j & 1))) & 0xffffu); }
            *(LAS f32x4*)(LF + te * 128 + k8) = (f32x4){lf[0], lf[1], lf[2], lf[3]}; *(LAS f32x4*)(LF + te * 128 + k8 + 4) = (f32x4){lf[4], lf[5], lf[6], lf[7]};
        }
        __syncthreads();
        if (tid < 128) { float bsum = 0.f;
#pragma unroll
            for (int t = 0; t < 32; ++t) { bsum += LF[t * 128 + tid]; LF[t * 128 + tid] = bsum; }
            BL[tid] = bsum; }
        __syncthreads();
        {
            const f32x4 b0 = *(const LAS f32x4*)(LF + te * 128 + k8), b1 = *(const LAS f32x4*)(LF + te * 128 + k8 + 4);
            const f32x4 l0 = *(const LAS f32x4*)(BL + k8), l1 = *(const LAS f32x4*)(BL + k8 + 4);
            const float bb[8] = {b0.x, b0.y, b0.z, b0.w, b1.x, b1.y, b1.z, b1.w}, bl[8] = {l0.x, l0.y, l0.z, l0.w, l1.x, l1.y, l1.z, l1.w};
            float qd[8], kd[8];
#pragma unroll
            for (int j = 0; j < 8; ++j) { qd[j] = qs[j] * __expf(bb[j]); kd[j] = kk[j] * __expf(-bb[j]); KET[(k8 + j) * 40 + te] = (bf16)f2bf(kk[j] * __expf(bl[j] - bb[j])); }
            v4u o; o.x = pk2(qd[0], qd[1]); o.y = pk2(qd[2], qd[3]); o.z = pk2(qd[4], qd[5]); o.w = pk2(qd[6], qd[7]); *(LAS v4u*)(QD + te * 136 + k8) = o;
            o.x = pk2(kd[0], kd[1]); o.y = pk2(kd[2], kd[3]); o.z = pk2(kd[4], kd[5]); o.w = pk2(kd[6], kd[7]); *(LAS v4u*)(KD + te * 136 + k8) = o;
            if (te == 0) {
#pragma unroll
                for (int j = 0; j < 8; ++j) DVv[k8 + j] = __expf(bl[j]); }
        }
        __syncthreads();
        f32x16 oacc = {};
        if (w == 0) { f32x16 z = {}; const f32x16 sc = mm32<128>(QD, 136, KD, 136, z, lane);
#pragma unroll
            for (int r = 0; r < 16; ++r) { const int t = crow(r, hh); SCB[t * 40 + r32] = (bf16)f2bf(r32 <= t ? sc[r] : 0.f); } }
        if (w < 4) oacc = mm32<128>(QD, 136, STt + (w * 32) * 136, 136, oacc, lane);
        __syncthreads();
        if (w < 4) { oacc = mm32<32>(SCB, 40, VT + (w * 32) * 40, 40, oacc, lane);
#pragma unroll
            for (int r = 0; r < 16; ++r) LF[crow(r, hh) * 128 + w * 32 + r32] = oacc[r]; }
        {
#pragma unroll
            for (int r = 0; r < 16; ++r) { const float d = DVv[32 * kt + crow(r, hh)]; S0[r] *= d; S1[r] *= d; }
            S0 = mm32<32>(KET + (kt * 32) * 40, 40, VT + (vt0 * 32) * 40, 40, S0, lane);
            S1 = mm32<32>(KET + (kt * 32) * 40, 40, VT + ((vt0 + 1) * 32) * 40, 40, S1, lane);
        }
        __syncthreads();
        HG_WRITE_ST();
        {
            const f32x4 o0 = *(const LAS f32x4*)(LF + te * 128 + k8), o1 = *(const LAS f32x4*)(LF + te * 128 + k8 + 4);
            float ov[8] = {o0.x, o0.y, o0.z, o0.w, o1.x, o1.y, o1.z, o1.w}; float s = 0.f;
#pragma unroll
            for (int j = 0; j < 8; ++j) s += ov[j] * ov[j];
            s += __shfl_xor(s, 1); s += __shfl_xor(s, 2); s += __shfl_xor(s, 4); s += __shfl_xor(s, 8);
            const float rs = rsqrtf(s * (1.0f / 128.0f) + EPS);
            const unsigned gw_[4] = {gz.x, gz.y, gz.z, gz.w}; float y[8];
#pragma unroll
            for (int j = 0; j < 8; ++j) { const float g = bf2f((gw_[j >> 1] >> (16 * (j & 1))) & 0xffffu); y[j] = ov[j] * rs * onv[j] * (g * sigmoidf_(g)); }
            if (valid) { v4u o; o.x = pk2(y[0], y[1]); o.y = pk2(y[2], y[3]); o.z = pk2(y[4], y[5]); o.w = pk2(y[6], y[7]); *(v4u*)(MIX + (size_t)row * DM + h * 128 + k8) = o; }
        }
        __syncthreads();
    }
#undef HG_WRITE_ST
    float* so = a.out + (sample ? O_HS : O_HP) + (size_t)(b * 6 + h) * 16384;
#pragma unroll
    for (int r = 0; r < 16; ++r) { const int k = 32 * kt + crow(r, hh); so[k * 128 + 32 * vt0 + r32] = S0[r]; so[k * 128 + 32 * (vt0 + 1) + r32] = S1[r]; }
}

__device__ __forceinline__ void memkv_finalize_row(const Args& a, int layer, int row, int lane) {
    const float* src = (const float*)(a.ws + WS_MEMKV) + (size_t)row * 1024 + layer * 512;
    const int hd = lane >> 4, d4 = (lane & 15) * 4;
    const f32x4 k = *(const f32x4*)(src + hd * 64 + d4), v = *(const f32x4*)(src + 256 + hd * 64 + d4);
    float s = (k.x * k.x + k.y * k.y) + (k.z * k.z + k.w * k.w);
    s += __shfl_xor(s, 1); s += __shfl_xor(s, 2); s += __shfl_xor(s, 4); s += __shfl_xor(s, 8);
    const float rs = rsqrtf(s * (1.0f / 64.0f) + EPS); const f32x4 g = *(const f32x4*)(a.in[22] + layer * 64 + d4);
    *(f32x4*)(a.out + O_MK + ((size_t)layer * 1024 + row) * 256 + hd * 64 + d4) = k * rs * g;
    *(f32x4*)(a.out + O_MV + ((size_t)layer * 1024 + row) * 256 + hd * 64 + d4) = v;
}

__device__ __forceinline__ void memattn_prompt_unit(Ctx& c, const Args& a, int layer, int u) {
    const int blk = u & 15, hd = (u >> 4) & 3, b = u >> 6;
    const bf16* Z = (const bf16*)(a.ws + WS_Z); const int ldz = layer ? ZC1 : ZC0, qc = layer ? Z1_MQ : 3072;
    const float* kv = (const float*)(a.ws + WS_MEMKV) + (size_t)(b * 256) * 1024 + layer * 512 + hd * 64;
    const int row0 = b * SEQ + blk * 256;
    memattn_unit(c, Z + (size_t)row0 * ldz + qc + hd * 64, ldz, 256, kv, kv + 256, 1024, true, a.in[22] + layer * 64, a.in[21] + layer * 64,
                 (bf16*)(a.ws + WS_MIX) + (size_t)row0 * DM + 768 + hd * 64);
}
__device__ __forceinline__ void memattn_sample_unit(Ctx& c, const Args& a, int layer, int u) {
    const int hd = u & 3, sb = u >> 2;
    const bf16* Z = (const bf16*)(a.ws + WS_Z); const int ldz = layer ? ZC1 : ZC0, qc = layer ? Z1_MQ : 3072;
    const size_t off = ((size_t)(layer * 32 + sb) * 256) * 256 + hd * 64;
    const int row0 = MP + sb * 4;
    memattn_unit(c, Z + (size_t)row0 * ldz + qc + hd * 64, ldz, 4, a.in[5] + off, a.in[6] + off, 256, false, nullptr, a.in[21] + layer * 64,
                 (bf16*)(a.ws + WS_MIX) + (size_t)row0 * DM + 768 + hd * 64);
}

__device__ __forceinline__ void p2_mixer0(Ctx& c, const Args& a) {
    constexpr int U_HP = 24, U_MAP = U_HP + 256, U_HS = U_MAP + 192, U_MAS = U_HS + 128, U_FIN = U_MAS + 256;
    for (;;) {
        const int u = q_next(c, 0);
        if (u >= U_FIN) break;
        if (u < U_HP) hgrn_unit(c, a, false, u / 6, u % 6);
        else if (u < U_MAP) memattn_prompt_unit(c, a, 0, u - U_HP);
        else if (u < U_HS) { const int v = u - U_MAP; hgrn_unit(c, a, true, v / 6, v % 6); }
        else if (u < U_MAS) memattn_sample_unit(c, a, 0, u - U_HS);
        else { const int v = (u - U_MAS) * 8 + c.wave; memkv_finalize_row(a, v >> 10, v & 1023, c.lane); }
    }
}

__device__ __forceinline__ void p5_convact(Ctx& c, const Args& a, int layer) {
    const bf16* U = (const bf16*)(a.ws + WS_U); const bf16* UP = (const bf16*)(a.ws + WS_UP); bf16* ACT = (bf16*)(a.ws + WS_ACT);
    const float* cw = a.in[26] + (size_t)layer * 3 * DFF; const float* cb = a.in[27] + (size_t)layer * DFF; const float* cst = a.in[8] + (size_t)layer * 32 * 2 * DFF;
    constexpr int CPR = DFF / 8, NG = MVALID / 4;
    const int total = NG * CPR;
#pragma unroll 1
    for (int i = c.vcu * 512 + c.tid; i < total; i += c.G * 512) {
        const int g = i / CPR, c8 = (i - g * CPR) * 8, r0 = g * 4;
        const bool smp = r0 >= MP; const bool first = smp || (r0 & 4095) == 0;
        const int rm2 = first ? r0 : r0 - 2, rm1 = first ? r0 : r0 - 1;
        v4u ur[6], pr[4];
        ur[0] = *(const v4u*)(U + (size_t)rm2 * DFF + c8); ur[1] = *(const v4u*)(U + (size_t)rm1 * DFF + c8);
#pragma unroll
        for (int k = 0; k < 4; ++k) { ur[2 + k] = *(const v4u*)(U + (size_t)(r0 + k) * DFF + c8); pr[k] = *(const v4u*)(UP + (size_t)(r0 + k) * DFF + c8); }
        const f32x4 w0a = *(const f32x4*)(cw + c8), w0b = *(const f32x4*)(cw + c8 + 4), w1a = *(const f32x4*)(cw + DFF + c8), w1b = *(const f32x4*)(cw + DFF + c8 + 4),
                    w2a = *(const f32x4*)(cw + 2 * DFF + c8), w2b = *(const f32x4*)(cw + 2 * DFF + c8 + 4), cba = *(const f32x4*)(cb + c8), cbb = *(const f32x4*)(cb + c8 + 4);
        const float w0[8] = {w0a.x, w0a.y, w0a.z, w0a.w, w0b.x, w0b.y, w0b.z, w0b.w}, w1[8] = {w1a.x, w1a.y, w1a.z, w1a.w, w1b.x, w1b.y, w1b.z, w1b.w},
                    w2[8] = {w2a.x, w2a.y, w2a.z, w2a.w, w2b.x, w2b.y, w2b.z, w2b.w}, bb[8] = {cba.x, cba.y, cba.z, cba.w, cbb.x, cbb.y, cbb.z, cbb.w};
        float uf[6][8];
#pragma unroll
        for (int k = 0; k < 6; ++k) { const unsigned xw[4] = {ur[k].x, ur[k].y, ur[k].z, ur[k].w};
#pragma unroll
            for (int j = 0; j < 8; ++j) uf[k][j] = bf2f((xw[j >> 1] >> (16 * (j & 1))) & 0xffffu); }
        if (first) {
            if (smp) { const float* s0 = cst + (size_t)(((r0 - MP) >> 2) * 2) * DFF + c8;
#pragma unroll
                for (int j = 0; j < 8; ++j) { uf[0][j] = s0[j]; uf[1][j] = s0[DFF + j]; } }
            else {
#pragma unroll
                for (int j = 0; j < 8; ++j) { uf[0][j] = 0.f; uf[1][j] = 0.f; } }
        }
#pragma unroll
        for (int k = 0; k < 4; ++k) { const unsigned pw[4] = {pr[k].x, pr[k].y, pr[k].z, pr[k].w}; float y[8];
#pragma unroll
            for (int j = 0; j < 8; ++j) { const float cv = bb[j] + w0[j] * uf[k][j] + w1[j] * uf[k + 1][j] + w2[j] * uf[k + 2][j]; y[j] = cv * sigmoidf_(cv) * bf2f((pw[j >> 1] >> (16 * (j & 1))) & 0xffffu); }
            v4u o; o.x = pk2(y[0], y[1]); o.y = pk2(y[2], y[3]); o.z = pk2(y[4], y[5]); o.w = pk2(y[6], y[7]);
            *(v4u*)(ACT + (size_t)(r0 + k) * DFF + c8) = o; }
    }
    for (int i = c.vcu * 512 + c.tid; i < (MT - MVALID) * CPR; i += c.G * 512)
        *(v4u*)(ACT + (size_t)(MVALID + i / CPR) * DFF + (i % CPR) * 8) = (v4u){0u, 0u, 0u, 0u};
}


__device__ __forceinline__ void dsa_post_row(const Args& a, int row, int lane) {
    const bf16* z = (const bf16*)(a.ws + WS_Z) + (size_t)row * ZC1;
    const bool smp = row >= MP; const int b = smp ? (row - MP) >> 2 : row >> 12, t = smp ? (row - MP) & 3 : row & 4095;
    const float pos = (float)(smp ? PAST + t : t);
    float c128, s128, c64, s64;
    { const float f1 = exp2f(-(float)lane * (13.287712379549449f / 64.0f)); sincosf(pos * f1, &s128, &c128);
      const float f2 = exp2f(-(float)(lane & 31) * (13.287712379549449f / 32.0f)); sincosf(pos * f2, &s64, &c64); }
#pragma unroll 1
    for (int hd = 0; hd < 8; ++hd) {
        const float x1 = bf2f(z[hd * 128 + lane]), x2 = bf2f(z[hd * 128 + 64 + lane]);
        const float rs = rsqrtf(wave_sum(x1 * x1 + x2 * x2) * (1.0f / 128.0f) + EPS);
        const float* gn = hd < 6 ? a.in[17] : a.in[18];
        const float y1 = x1 * rs * gn[lane], y2 = x2 * rs * gn[64 + lane];
        const float o1 = y1 * c128 - y2 * s128, o2 = y2 * c128 + y1 * s128;
        if (hd < 6) {
            if (smp) { float* q = (float*)(a.ws + WS_SQ) + (size_t)(row - MP) * 768 + hd * 128; q[lane] = o1; q[64 + lane] = o2; }
            else { bf16* q = (bf16*)(a.ws + WS_QB) + ((size_t)(b * 6 + hd) * SEQ + t) * 128; q[lane] = (bf16)f2bf(o1); q[64 + lane] = (bf16)f2bf(o2); }
        } else {
            const int kvh = hd - 6;
            float* ko = smp ? a.out + O_KS + (size_t)(row - MP) * 256 + kvh * 128 : a.out + O_KP + (size_t)row * 256 + kvh * 128;
            ko[lane] = o1; ko[64 + lane] = o2;
            if (!smp) { bf16* kb = (bf16*)(a.ws + WS_KB) + ((size_t)(b * 2 + kvh) * SEQ + t) * 128; kb[lane] = (bf16)f2bf(o1); kb[64 + lane] = (bf16)f2bf(o2); }
        }
    }
    {
        const u64 vv = *(const u64*)(z + Z1_V + 4 * lane);
        const f32x4 v = {bf2f((unsigned)vv & 0xffffu), bf2f(((unsigned)vv) >> 16), bf2f((unsigned)(vv >> 32) & 0xffffu), bf2f((unsigned)(vv >> 48))};
        float* vo = smp ? a.out + O_VS + (size_t)(row - MP) * 256 : a.out + O_VP + (size_t)row * 256;
        *(f32x4*)(vo + 4 * lane) = v;
        if (!smp) { const int kvh = lane >> 5, d = (lane & 31) * 4; *(u64*)((bf16*)(a.ws + WS_VB) + ((size_t)(b * 2 + kvh) * SEQ + t) * 128 + d) = vv; }
    }
    {
        const int i = lane & 31;
#pragma unroll
        for (int p = 0; p < 4; ++p) { const int hd = 2 * p + (lane >> 5);
            const float x1 = bf2f(z[Z1_IQ + hd * 64 + i]), x2 = bf2f(z[Z1_IQ + hd * 64 + 32 + i]);
            const float o1 = x1 * c64 - x2 * s64, o2 = x2 * c64 + x1 * s64;
            if (smp) { float* q = (float*)(a.ws + WS_SIQ) + (size_t)(row - MP) * 512 + hd * 64; q[i] = o1; q[32 + i] = o2; }
            else { bf16* q = (bf16*)(a.ws + WS_IQB) + (size_t)row * 512 + hd * 64; q[i] = (bf16)f2bf(o1); q[32 + i] = (bf16)f2bf(o2); } }
        float x1 = 0.f, x2 = 0.f; if (lane < 32) { x1 = bf2f(z[Z1_IK + i]); x2 = bf2f(z[Z1_IK + 32 + i]); }
        const float rs = rsqrtf(wave_sum(x1 * x1 + x2 * x2) * (1.0f / 64.0f) + EPS);
        const float y1 = x1 * rs * a.in[19][i], y2 = x2 * rs * a.in[19][32 + i];
        const float o1 = y1 * c64 - y2 * s64, o2 = y2 * c64 + y1 * s64;
        if (lane < 32) {
            float* ko = smp ? a.out + O_IKS + (size_t)(row - MP) * 64 : a.out + O_IKP + (size_t)row * 64; ko[i] = o1; ko[32 + i] = o2;
            if (!smp) { bf16* kb = (bf16*)(a.ws + WS_IKB) + (size_t)row * 64; kb[i] = (bf16)f2bf(o1); kb[32 + i] = (bf16)f2bf(o2); } }
        if (lane < 8) { const float wv = bf2f(z[Z1_IW + lane]) * (0.35355339059327373f * 0.125f);
            if (smp) ((float*)(a.ws + WS_SIW))[(row - MP) * 8 + lane] = wv; else ((float*)(a.ws + WS_IW))[(size_t)row * 8 + lane] = wv; }
    }
}
__device__ __forceinline__ void p8_dsa_post(Ctx& c, const Args& a) {
    for (;;) { const int u = q_next(c, 1); if (u >= 384) break; if (u < 256) memattn_prompt_unit(c, a, 1, u); else memattn_sample_unit(c, a, 1, u - 256); }
    const int gw = c.vcu * NWAVES + c.wave, NGW = c.G * NWAVES;
    for (int row = gw; row < MVALID; row += NGW) dsa_post_row(a, row, c.lane);
}

__device__ __forceinline__ void idx_prompt_unit(Ctx& c, const Args& a, int b, int qb) {
    int tid = c.tid; asm volatile("" : "+v"(tid));
    const int lane = tid & 63, r32 = lane & 31, hh = lane >> 5, w = c.wave;
    const int q0 = b * SEQ + qb * 32;
    LAS bf16* IQL = (LAS bf16*)(c.lds);
    { const bf16* src = (const bf16*)(a.ws + WS_IQB) + (size_t)q0 * 512;
#pragma unroll
      for (int i = 0; i < 4; ++i) { const int row = tid >> 4, ch = (tid & 15) + 16 * i; *(LAS v4u*)(IQL + row * 520 + ch * 8) = *(const v4u*)(src + (size_t)row * 512 + ch * 8); } }
    __syncthreads();
    const bf16* IK = (const bf16*)(a.ws + WS_IKB) + (size_t)(b * SEQ) * 64;
    float* SC = (float*)(a.ws + WS_SC) + (size_t)(q0 + r32) * SEQ;
    float wv[8];
#pragma unroll
    for (int h = 0; h < 8; ++h) wv[h] = ((const float*)(a.ws + WS_IW))[(size_t)(q0 + r32) * 8 + h];
#pragma unroll 1
    for (int kt = w; kt <= qb; kt += 8) {
        bf16x8 ak[4];
#pragma unroll
        for (int ks = 0; ks < 4; ++ks) ak[ks] = *(const bf16x8*)(IK + (size_t)(kt * 32 + r32) * 64 + ks * 16 + 8 * hh);
        f32x16 sc = {};
        int qoff = r32 * 520 + 8 * hh; asm volatile("" : "+v"(qoff));
#pragma unroll
        for (int h = 0; h < 8; ++h) { f32x16 d = {};
#pragma unroll
            for (int ks = 0; ks < 4; ++ks) d = __builtin_amdgcn_mfma_f32_32x32x16_bf16(ak[ks], *(const LAS bf16x8*)(IQL + qoff + h * 64 + ks * 16), d, 0, 0, 0);
#pragma unroll
            for (int r = 0; r < 16; ++r) sc[r] = fmaf(wv[h], fmaxf(d[r], 0.f), sc[r]); }
#pragma unroll
        for (int g = 0; g < 4; ++g) *(f32x4*)(SC + kt * 32 + 8 * g + 4 * hh) = (f32x4){sc[4 * g], sc[4 * g + 1], sc[4 * g + 2], sc[4 * g + 3]};
    }
}
__device__ __forceinline__ void idx_sample_unit(Ctx& c, const Args& a, int sb, int pg) {
    LAS float* IKL = (LAS float*)(c.lds);
    LAS float* IQL = (LAS float*)(c.lds + 33280);
    LAS float* WL = (LAS float*)(c.lds + 33280 + 8192);
    int tid = c.tid; asm volatile("" : "+v"(tid));
    const int nk = pg < 64 ? 128 : 4;
    const float* src = pg < 64 ? a.in[4] + ((size_t)a.page_table[sb * 64 + pg] * 128) * 64 : a.out + O_IKS + (size_t)(sb * 4) * 64;
    for (int i = tid; i < nk * 16; i += 512) { const f32x4 v = *(const f32x4*)(src + (size_t)i * 4); const int k = i >> 4, d = (i & 15) * 4;
        IKL[k * 65 + d] = v.x; IKL[k * 65 + d + 1] = v.y; IKL[k * 65 + d + 2] = v.z; IKL[k * 65 + d + 3] = v.w; }
    for (int i = tid; i < 2048; i += 512) IQL[i] = ((const float*)(a.ws + WS_SIQ))[(size_t)(sb * 4) * 512 + i];
    if (tid < 32) WL[tid] = ((const float*)(a.ws + WS_SIW))[sb * 32 + tid];
    __syncthreads();
    const int k = tid & 127, t = tid >> 7;
    if (k < nk) {
        float acc = 0.f;
#pragma unroll 1
        for (int h = 0; h < 8; ++h) { float d = 0.f;
#pragma unroll 16
            for (int e = 0; e < 64; ++e) d = fmaf(IQL[(t * 8 + h) * 64 + e], IKL[k * 65 + e], d);
            acc = fmaf(WL[t * 8 + h], fmaxf(d, 0.f), acc); }
        ((float*)(a.ws + WS_SSC))[(size_t)(sb * 4 + t) * SSC_LD + pg * 128 + k] = acc;
    }
}
__device__ __forceinline__ void p9_indexer(Ctx& c, const Args& a) {
    constexpr int U_P = 512, U_S = U_P + 32 * 65;
    for (;;) { const int u = q_next(c, 2); if (u >= U_S) break;
        if (u < U_P) idx_prompt_unit(c, a, u & 3, 127 - (u >> 2));
        else { const int v = u - U_P; idx_sample_unit(c, a, v / 65, v % 65); } }
}


__device__ __forceinline__ unsigned fkey(float f) { const unsigned u = __builtin_bit_cast(unsigned, f + 0.0f); return (u & 0x80000000u) ? ~u : (u | 0x80000000u); }
__device__ __forceinline__ void acc_ge(int& cnt, unsigned key, unsigned cand) { asm volatile("v_cmp_le_u32_e32 vcc, %1, %2\n\tv_addc_co_u32_e32 %0, vcc, 0, %0, vcc" : "+v"(cnt) : "s"(cand), "v"(key) : "vcc"); }
__device__ __forceinline__ u64 ballot_nz(unsigned v) { u64 m; asm volatile("v_cmp_ne_u32_e64 %0, 0, %1" : "=s"(m) : "v"(v)); return m; }
__device__ __forceinline__ int wave_sum_dpp(int x) {
    x += __builtin_amdgcn_update_dpp(0, x, 0xB1, 0xF, 0xF, false);
    x += __builtin_amdgcn_update_dpp(0, x, 0x4E, 0xF, 0xF, false);
    x += __builtin_amdgcn_update_dpp(0, x, 0x141, 0xF, 0xF, false);
    x += __builtin_amdgcn_update_dpp(0, x, 0x140, 0xF, 0xF, false);
    return (__builtin_amdgcn_readlane(x, 0) + __builtin_amdgcn_readlane(x, 16)) + (__builtin_amdgcn_readlane(x, 32) + __builtin_amdgcn_readlane(x, 48));
}
__device__ __forceinline__ int mbcnt64(u64 m) { return (int)__builtin_amdgcn_mbcnt_hi((unsigned)(m >> 32), __builtin_amdgcn_mbcnt_lo((unsigned)m, 0u)); }
constexpr int TK_LOWBITS = 18;
__device__ __forceinline__ void topk_finish(unsigned ck, int cp, int A, int posmax, unsigned& T, int& P) {
#pragma unroll 1
    for (int bit = TK_LOWBITS - 1; bit >= 0; --bit) { const unsigned cand = T | (1u << bit); if (A + __builtin_popcountll(__ballot(ck >= cand)) >= 256) T = cand; }
    const int need = 256 - (A + __builtin_popcountll(__ballot(ck > T))), ceq = __builtin_popcountll(__ballot(ck == T));
    P = posmax;
    if (ceq != need) { P = 0;
#pragma unroll 1
        for (int bit = 13; bit >= 0; --bit) { const int cand = P | (1 << bit); if (__builtin_popcountll(__ballot(ck == T && cp < cand)) < need) P = cand; } }
}
__device__ __forceinline__ void topk_prompt_row(const Args& a, int row, int lane_, LAS unsigned* cl  ) {
    int lane = lane_; asm volatile("" : "+v"(lane));
    const int t = row & 4095; const float* sc = (const float*)(a.ws + WS_SC) + (size_t)row * SEQ;
    u64* mk = (u64*)(a.ws + WS_MASK) + (size_t)row * 64;
    u64 myword = 0ull;
    if (t < 256) {
#pragma unroll 1
        for (int j = 0; j < 64; ++j) { const u64 m = __ballot(64 * j + lane <= t); if (lane == j) myword = m; }
        mk[lane] = myword; return; }
    unsigned key[64];
#pragma unroll
    for (int j = 0; j < 64; ++j) { const float v = sc[64 * j + lane]; key[j] = (64 * j + lane <= t) ? fkey(v) : 0u; }
#define TK_FULLCOUNT(CAND, OUT) do { const unsigned cs_ = __builtin_amdgcn_readfirstlane(CAND); int cnt_ = 0; _Pragma("unroll") for (int j = 0; j < 64; ++j) acc_ge(cnt_, key[j], cs_); OUT = wave_sum_dpp(cnt_); } while (0)
    unsigned T = 0u;
#pragma unroll 1
    for (int bit = 31; bit >= TK_LOWBITS; --bit) { const unsigned cand = T | (1u << bit); int tot; TK_FULLCOUNT(cand, tot); if (tot >= 256) T = cand; }
    const unsigned hib = T + (1u << TK_LOWBITS);
    int A = 0, cT; if (hib != 0u) TK_FULLCOUNT(hib, A); TK_FULLCOUNT(T, cT);
    int P;
    if (cT - A <= 64) {
        int base = 0;
#pragma unroll
        for (int j = 0; j < 64; ++j) { const unsigned und = (key[j] - T) < (1u << TK_LOWBITS) ? 1u : 0u; const u64 m = ballot_nz(und); const int pos = base + mbcnt64(m);
            if (und) { cl[pos] = key[j]; cl[64 + pos] = (unsigned)(64 * j + lane); }
            base += __builtin_popcountll(m); asm volatile("" : "+s"(base)); }
        const unsigned ck = lane < base ? cl[lane] : 0u; const int cp = (int)cl[64 + lane];
        topk_finish(ck, cp, A, 4095, T, P);
    } else {
#pragma unroll 1
        for (int bit = TK_LOWBITS - 1; bit >= 0; --bit) { const unsigned cand = T | (1u << bit); int tot; TK_FULLCOUNT(cand, tot); if (tot >= 256) T = cand; }
        int cge, cgt; TK_FULLCOUNT(T, cge); cgt = 0; if (T != 0xffffffffu) TK_FULLCOUNT(T + 1u, cgt);
        const int need = 256 - cgt, ceq = cge - cgt; P = 4095;
        if (ceq != need) { P = 0;
#pragma unroll 1
            for (int bit = 11; bit >= 0; --bit) { const int cand = P | (1 << bit); int cnt = 0;
#pragma unroll
                for (int j = 0; j < 64; ++j) cnt += (key[j] == T && 64 * j + lane < cand) ? 1 : 0;
                if (wave_sum_dpp(cnt) < need) P = cand; } }
    }
#undef TK_FULLCOUNT
#pragma unroll
    for (int j = 0; j < 64; ++j) { const unsigned selv = (key[j] > T || (key[j] == T && 64 * j + lane <= P)) ? 1u : 0u; const u64 m = ballot_nz(selv); if (lane == j) myword = m; asm volatile("" : "+v"(myword)); }
    mk[lane] = myword;
}
__device__ __forceinline__ void topk_sample_row(const Args& a, int q, int lane_, LAS unsigned* K, LAS unsigned* cl) {
    int lane = lane_; asm volatile("" : "+v"(lane));
    const int t = q & 3, n = PAST + t + 1; const float* sc = (const float*)(a.ws + WS_SSC) + (size_t)q * SSC_LD;
    int* out = (int*)(a.ws + WS_SIDX) + q * 256;
    unsigned key[129];
#pragma unroll
    for (int j = 0; j < 129; ++j) { const float v = sc[64 * j + lane]; key[j] = (64 * j + lane < n) ? fkey(v) : 0u; }
#pragma unroll
    for (int j = 0; j < 129; ++j) K[64 * j + lane] = key[j];
#define TK_FULLCOUNT(CAND, OUT) do { const unsigned cs_ = __builtin_amdgcn_readfirstlane(CAND); int cnt_ = 0; _Pragma("unroll") for (int j = 0; j < 129; ++j) acc_ge(cnt_, key[j], cs_); OUT = wave_sum_dpp(cnt_); } while (0)
    unsigned T = 0u;
#pragma unroll 1
    for (int bit = 31; bit >= TK_LOWBITS; --bit) { const unsigned cand = T | (1u << bit); int tot; TK_FULLCOUNT(cand, tot); if (tot >= 256) T = cand; }
    const unsigned hib = T + (1u << TK_LOWBITS);
    int A = 0, cT; if (hib != 0u) TK_FULLCOUNT(hib, A); TK_FULLCOUNT(T, cT);
    int P;
    if (cT - A <= 64) {
        int base = 0;
#pragma unroll 1
        for (int j0 = 0; j0 < 128; j0 += 8) { unsigned kk[8];
#pragma unroll
            for (int i = 0; i < 8; ++i) kk[i] = K[64 * (j0 + i) + lane];
#pragma unroll
            for (int i = 0; i < 8; ++i) { const unsigned und = (kk[i] - T) < (1u << TK_LOWBITS) ? 1u : 0u; const u64 m = ballot_nz(und); const int pos = base + mbcnt64(m);
                if (und) { cl[pos] = kk[i]; cl[64 + pos] = (unsigned)(64 * (j0 + i) + lane); }
                base += __builtin_popcountll(m); } }
        { const unsigned kj = K[64 * 128 + lane]; const unsigned und = (kj - T) < (1u << TK_LOWBITS) ? 1u : 0u; const u64 m = ballot_nz(und); const int pos = base + mbcnt64(m);
          if (und) { cl[pos] = kj; cl[64 + pos] = (unsigned)(64 * 128 + lane); } base += __builtin_popcountll(m); }
        const unsigned ck = lane < base ? cl[lane] : 0u; const int cp = (int)cl[64 + lane];
        topk_finish(ck, cp, A, 16383, T, P);
    } else {
#pragma unroll 1
        for (int bit = TK_LOWBITS - 1; bit >= 0; --bit) { const unsigned cand = T | (1u << bit); int tot; TK_FULLCOUNT(cand, tot); if (tot >= 256) T = cand; }
        int cge, cgt; TK_FULLCOUNT(T, cge); cgt = 0; if (T != 0xffffffffu) TK_FULLCOUNT(T + 1u, cgt);
        const int need = 256 - cgt, ceq = cge - cgt; P = 16383;
        if (ceq != need) { P = 0;
#pragma unroll 1
            for (int bit = 13; bit >= 0; --bit) { const int cand = P | (1 << bit); int cnt = 0;
#pragma unroll 4
                for (int j = 0; j < 129; ++j) cnt += (K[64 * j + lane] == T && 64 * j + lane < cand) ? 1 : 0;
                if (wave_sum_dpp(cnt) < need) P = cand; } }
    }
#undef TK_FULLCOUNT
    int base = 0;
#pragma unroll 1
    for (int j0 = 0; j0 < 136; j0 += 8) { unsigned kk[8];
#pragma unroll
        for (int i = 0; i < 8; ++i) kk[i] = (j0 + i < 129) ? K[64 * (j0 + i) + lane] : 0u;
#pragma unroll
        for (int i = 0; i < 8; ++i) { const int ps = 64 * (j0 + i) + lane; const unsigned selv = (kk[i] > T || (kk[i] == T && ps <= P)) ? 1u : 0u; const u64 m = ballot_nz(selv);
            const int pos = base + mbcnt64(m);
            if (selv && pos < 256) out[pos] = ps;
            base += __builtin_popcountll(m); } }
}
__device__ __forceinline__ void p10_topk(Ctx& c, const Args& a) {
    const int gw = c.vcu * NWAVES + c.wave, NGW = c.G * NWAVES;
    LAS unsigned* cl = (LAS unsigned*)(c.lds) + c.wave * 128;
    if (c.wave == 0 && c.vcu < MS) topk_sample_row(a, c.vcu, c.lane, (LAS unsigned*)(c.lds + 4096), cl);
    for (int row = gw; row < MP; row += NGW) topk_prompt_row(a, row, c.lane, cl);
}


__device__ __forceinline__ void attn_sample_unit(Ctx& c, const Args& a, int sb, int t) {
    LAS bf16* KV = (LAS bf16*)(c.lds);
    LAS float* QL = (LAS float*)(c.lds + 69632);
    LAS float* SL = (LAS float*)(c.lds + 69632 + 3072);
    LAS float* OL = (LAS float*)(c.lds + 69632 + 6144);
    LAS int* IL = (LAS int*)(c.lds + 69632 + 12288);
    int tid = c.tid; asm volatile("" : "+v"(tid));
    const int lane = tid & 63, w = c.wave, q = sb * 4 + t;
    __syncthreads();
    if (tid < 256) IL[tid] = ((const int*)(a.ws + WS_SIDX))[q * 256 + tid];
    for (int i = tid; i < 768; i += 512) QL[i] = ((const float*)(a.ws + WS_SQ))[(size_t)q * 768 + i];
    __syncthreads();
    bf16* MIX = (bf16*)(a.ws + WS_MIX) + (size_t)(MP + q) * DM;
#pragma unroll 1
    for (int kvh = 0; kvh < 2; ++kvh) {
#pragma unroll 1
        for (int pass = 0; pass < 2; ++pass) {
            const float* pool = pass ? a.in[3] : a.in[2]; const float* nw = a.out + (pass ? O_VS : O_KS);
            for (int i = tid >> 5; i < 256; i += 16) { const int idx = IL[i]; const float* src;
                if (idx < PAST) src = pool + (((size_t)a.page_table[sb * 64 + (idx >> 7)] * 128 + (idx & 127)) * 2 + kvh) * 128;
                else src = nw + (size_t)(sb * 4 + (idx - PAST)) * 256 + kvh * 128;
                const f32x4 v = *(const f32x4*)(src + (tid & 31) * 4);
                *(LAS u64*)(KV + i * 136 + (tid & 31) * 4) = (u64)pk2(v.x, v.y) | ((u64)pk2(v.z, v.w) << 32); }
            __syncthreads();
            if (pass == 0) {
                const int i = tid >> 1, dh = (tid & 1) * 64; float s0 = 0.f, s1 = 0.f, s2 = 0.f;
#pragma unroll 8
                for (int d = 0; d < 64; ++d) { const float kx = bf2f(KV[i * 136 + dh + d]);
                    s0 = fmaf(QL[(3 * kvh + 0) * 128 + dh + d], kx, s0); s1 = fmaf(QL[(3 * kvh + 1) * 128 + dh + d], kx, s1); s2 = fmaf(QL[(3 * kvh + 2) * 128 + dh + d], kx, s2); }
                s0 += __shfl_xor(s0, 1); s1 += __shfl_xor(s1, 1); s2 += __shfl_xor(s2, 1);
                if ((tid & 1) == 0) { SL[i] = s0 * 0.08838834764831845f; SL[256 + i] = s1 * 0.08838834764831845f; SL[512 + i] = s2 * 0.08838834764831845f; }
                __syncthreads();
                if (w < 3) { float v[4], mx = -1e30f;
#pragma unroll
                    for (int j = 0; j < 4; ++j) { v[j] = SL[w * 256 + 64 * j + lane]; mx = fmaxf(mx, v[j]); }
#pragma unroll
                    for (int o = 1; o < 64; o <<= 1) mx = fmaxf(mx, __shfl_xor(mx, o));
                    float l = 0.f;
#pragma unroll
                    for (int j = 0; j < 4; ++j) { v[j] = __expf(v[j] - mx); l += v[j]; }
                    l = wave_sum(l); const float il = 1.0f / l;
#pragma unroll
                    for (int j = 0; j < 4; ++j) SL[w * 256 + 64 * j + lane] = v[j] * il; }
                __syncthreads();
            } else {
                const int d = tid & 127, part = tid >> 7; float o0 = 0.f, o1 = 0.f, o2 = 0.f;
#pragma unroll 8
                for (int i = part * 64; i < part * 64 + 64; ++i) { const float vx = bf2f(KV[i * 136 + d]); o0 = fmaf(SL[i], vx, o0); o1 = fmaf(SL[256 + i], vx, o1); o2 = fmaf(SL[512 + i], vx, o2); }
                OL[(part * 3 + 0) * 128 + d] = o0; OL[(part * 3 + 1) * 128 + d] = o1; OL[(part * 3 + 2) * 128 + d] = o2;
                __syncthreads();
                if (tid < 384) { const int hq = tid >> 7, dd = tid & 127; const float o = (OL[hq * 128 + dd] + OL[(3 + hq) * 128 + dd]) + (OL[(6 + hq) * 128 + dd] + OL[(9 + hq) * 128 + dd]);
                    MIX[(3 * kvh + hq) * 128 + dd] = (bf16)f2bf(o); }
                __syncthreads();
            }
        }
    }
}


namespace attn {
using bf16 = unsigned short;
typedef short bf16x8 __attribute__((ext_vector_type(8)));
typedef short s16x4 __attribute__((ext_vector_type(4)));
typedef float f32x16 __attribute__((ext_vector_type(16)));
typedef float f32x4 __attribute__((ext_vector_type(4)));
typedef unsigned u32x4 __attribute__((ext_vector_type(4)));
typedef unsigned u32x2 __attribute__((ext_vector_type(2)));
constexpr int D = 128, OS = 1024;
constexpr float THR = 8.f;
constexpr float SCALE = 0.08838834764831845f;
constexpr int NW = 8, QBLK = 32, KVBLK = 64, QB = NW * QBLK;
constexpr int SHM_V = KVBLK * D * 2, SHM_K = KVBLK * D * 2;
constexpr int LDS_BYTES = 2 * SHM_V + 2 * SHM_K + NW * 64 * 4;

#define KSWZ(row, colB) ((row) * 256 + ((colB) ^ (((row) & 7) << 4)))
#define SBAR() __builtin_amdgcn_sched_barrier(0)
__device__ __forceinline__ int v_st(int k, int c) { const int kk = (k & ~0xC) | ((k & 4) << 1) | ((k & 8) >> 1); return ((kk >> 3) * 4 + (c >> 5)) * 512 + ((kk & 7) * 32 + (c & 31)) * 2; }
__device__ __forceinline__ int v_rd_base(int lane) { return ((lane & 3) << 3) | (((lane >> 2) & 3) << 6) | (((lane >> 4) & 1) << 5) | (((lane >> 5) & 1) << 8); }
constexpr int v_rd_off(int d0, int ks, int half) { return d0 * 512 + ks * 4096 + half * 2048; }
__device__ __forceinline__ int crow(int r, int hi) { return (r & 3) + 8 * (r >> 2) + 4 * hi; }
__device__ __forceinline__ unsigned cvtpk(float lo, float hi) {
    unsigned r; asm volatile("v_cvt_pk_bf16_f32 %0, %1, %2" : "=v"(r) : "v"(lo), "v"(hi)); return r;
}
__device__ __forceinline__ bf16x8 pack8(f32x4 a, f32x4 b) {
    u32x4 w = {cvtpk(a[0], a[1]), cvtpk(a[2], a[3]), cvtpk(b[0], b[1]), cvtpk(b[2], b[3])};
    return *reinterpret_cast<bf16x8*>(&w);
}

__device__ __forceinline__ void partialSM(f32x16& p0, f32x16& p1, float& m_reg, float& mn, float& alpha) {
    float pmax = p0[0]; for (int r = 1; r < 16; ++r) pmax = fmaxf(pmax, p0[r]); for (int r = 0; r < 16; ++r) pmax = fmaxf(pmax, p1[r]);
    { auto rr = __builtin_amdgcn_permlane32_swap(__float_as_uint(pmax), __float_as_uint(pmax), false, false);
      pmax = fmaxf(__uint_as_float(rr[0]), __uint_as_float(rr[1])); }
    constexpr float C2 = 1.4426950408889634f * SCALE;
    if (__builtin_expect(__all((pmax - m_reg) * SCALE <= THR), 1)) { mn = m_reg; alpha = 1.f; }
    else { mn = fmaxf(m_reg, pmax); alpha = __builtin_amdgcn_exp2f((m_reg - mn) * C2); m_reg = mn; }
    const float mnL = -mn * C2;
    for (int r = 0; r < 16; ++r) p0[r] = fmaf(p0[r], C2, mnL); for (int r = 0; r < 16; ++r) p1[r] = fmaf(p1[r], C2, mnL);
    for (int r = 0; r < 16; ++r) p0[r] = __builtin_amdgcn_exp2f(p0[r]);
}
__device__ __forceinline__ void finishSM(f32x16& p0, f32x16& p1, float alpha, float& l_reg, bf16x8& pa0, bf16x8& pa1, bf16x8& pa2, bf16x8& pa3) {
    for (int r = 0; r < 16; ++r) p1[r] = __builtin_amdgcn_exp2f(p1[r]);
    float ps = 0; for (int r = 0; r < 16; ++r) ps += p0[r]; for (int r = 0; r < 16; ++r) ps += p1[r];
    { auto rr = __builtin_amdgcn_permlane32_swap(__float_as_uint(ps), __float_as_uint(ps), false, false);
      ps = __uint_as_float(rr[0]) + __uint_as_float(rr[1]); }
    l_reg = l_reg * alpha + ps;
#define PK4(P, B_, OUT) do { unsigned a0 = cvtpk(P[B_+0], P[B_+1]), a1 = cvtpk(P[B_+2], P[B_+3]);                          \
        unsigned b0 = cvtpk(P[B_+4], P[B_+5]), b1 = cvtpk(P[B_+6], P[B_+7]);                                             \
        auto r0 = __builtin_amdgcn_permlane32_swap(a0, b0, false, false); auto r1 = __builtin_amdgcn_permlane32_swap(a1, b1, false, false); \
        u32x4 w = {r0[0], r1[0], r0[1], r1[1]}; OUT = *reinterpret_cast<bf16x8*>(&w); } while (0)
    PK4(p0, 0, pa0); PK4(p0, 8, pa1); PK4(p1, 0, pa2); PK4(p1, 8, pa3);
#undef PK4
}
template <int KB, bool SK>
__device__ __forceinline__ void qkt(f32x16& p0, f32x16& p1, const char* K_lds, int r32, int hi, const bf16x8* qr, bool act) {
    if (SK && !act) { const float NEG = -__builtin_inff();
#pragma unroll
        for (int r = 0; r < 16; ++r) { p0[r] = NEG; p1[r] = NEG; } return; }
    p0 = f32x16{}; p1 = f32x16{};
    const char* kb[4];
#pragma unroll
    for (int dd = 0; dd < 4; ++dd) kb[dd] = K_lds + KB * SHM_K + KSWZ(r32, (dd * 16 + hi * 8) * 2);
#pragma unroll
    for (int d0 = 0; d0 < 8; ++d0) { const char* a = kb[d0 & 3] + (d0 >> 2) * 128;
        bf16x8 b0 = *reinterpret_cast<const bf16x8*>(a);
        bf16x8 b1 = *reinterpret_cast<const bf16x8*>(a + 32 * 256);
        p0 = __builtin_amdgcn_mfma_f32_32x32x16_bf16(b0, qr[d0], p0, 0, 0, 0);
        p1 = __builtin_amdgcn_mfma_f32_32x32x16_bf16(b1, qr[d0], p1, 0, 0, 0); }
}
template <int VB, bool SK>
__device__ __forceinline__ void pv_tile(f32x16* o, int vb0, bf16x8 pa0, bf16x8 pa1, bf16x8 pa2, bf16x8 pa3, bool act) {
    if (SK && !act) return;
#define TRRD(dst, off) asm volatile("ds_read_b64_tr_b16 %0, %1 offset:%2" : "=&v"(dst) : "v"(vb0), "i"(off) : "memory")
#define PV_D0(d0) do { s16x4 l0, l1, l2, l3, h0, h1, h2, h3; constexpr int b_ = VB * SHM_V + v_rd_off(d0, 0, 0);     \
        TRRD(l0, b_); TRRD(h0, b_ + 2048); TRRD(l1, b_ + 4096); TRRD(h1, b_ + 6144); TRRD(l2, b_ + 8192); TRRD(h2, b_ + 10240); TRRD(l3, b_ + 12288); TRRD(h3, b_ + 14336); \
        asm volatile("s_waitcnt lgkmcnt(0)" ::: "memory"); SBAR();                 \
        o[d0] = __builtin_amdgcn_mfma_f32_32x32x16_bf16(pa0, (bf16x8){l0[0], l0[1], l0[2], l0[3], h0[0], h0[1], h0[2], h0[3]}, o[d0], 0, 0, 0);   \
        o[d0] = __builtin_amdgcn_mfma_f32_32x32x16_bf16(pa1, (bf16x8){l1[0], l1[1], l1[2], l1[3], h1[0], h1[1], h1[2], h1[3]}, o[d0], 0, 0, 0);   \
        o[d0] = __builtin_amdgcn_mfma_f32_32x32x16_bf16(pa2, (bf16x8){l2[0], l2[1], l2[2], l2[3], h2[0], h2[1], h2[2], h2[3]}, o[d0], 0, 0, 0);   \
        o[d0] = __builtin_amdgcn_mfma_f32_32x32x16_bf16(pa3, (bf16x8){l3[0], l3[1], l3[2], l3[3], h3[0], h3[1], h3[2], h3[3]}, o[d0], 0, 0, 0); } while (0)
    PV_D0(0); PV_D0(1); PV_D0(2); PV_D0(3);
#undef PV_D0
#undef TRRD
}

__device__ __forceinline__ bf16x8 load8(const bf16* p) { return *reinterpret_cast<const bf16x8*>(p); }
__device__ __forceinline__ void mask_bits(f32x16& p0, f32x16& p1, u32x2 w, int hi) {
    const float NEG = -__builtin_inff();
    asm volatile("" : "+v"(w.x), "+v"(w.y));
    const unsigned lo = w.x >> (4 * hi), up = w.y >> (4 * hi);
#pragma unroll
    for (int r = 0; r < 16; ++r) { const int c = (r & 3) + 8 * (r >> 2);
        if (!((lo >> c) & 1u)) p0[r] = NEG;
        if (!((up >> c) & 1u)) p1[r] = NEG; }
}
struct BlockRef { const bf16* Q; const bf16* K; const bf16* V; bf16* O; const u32x2* M; int P0; };
struct Seam { bf16x8 qr[8]; bf16x8 st_v0, st_v1, st_k0, st_k1; };
#define ROW(p, k0, rr) ((p) + (size_t)((k0) + (rr)) * D + sc)
#define VMW() asm volatile("s_waitcnt vmcnt(0)" ::: "memory")
#define VMWN(n) asm volatile("s_waitcnt vmcnt(%0)" :: "i"(n) : "memory")
#define SLOAD_H(Kp, Vp, k0) do { S.st_v0 = load8(ROW(Vp, k0, sr)); S.st_v1 = load8(ROW(Vp, k0, 32 + sr));              \
                         S.st_k0 = load8(ROW(Kp, k0, sr)); S.st_k1 = load8(ROW(Kp, k0, 32 + sr)); } while (0)
#define SWRITE_HK(bf) do { *(bf16x8*)(K_lds + (bf) * SHM_K + kws) = S.st_k0; *(bf16x8*)(K_lds + (bf) * SHM_K + kws + 32 * 256) = S.st_k1; } while (0)
#define SWRITE_HV(bf) do { *(bf16x8*)(V_lds + (bf) * SHM_V + vst0) = S.st_v0; *(bf16x8*)(V_lds + (bf) * SHM_V + vst1) = S.st_v1; } while (0)
#define SWRITE_H(bf) do { SWRITE_HV(bf); SWRITE_HK(bf); } while (0)
__device__ __forceinline__ void sel_prime(const BlockRef& cur, char* lds, Seam& S) {
    int tid_ = threadIdx.x; asm volatile("" : "+v"(tid_));
    const int tid = tid_, wid = __builtin_amdgcn_readfirstlane(tid >> 6), lane = tid & 63, r32 = lane & 31, hi = lane >> 5;
    const int sr = tid >> 4, sc = (tid & 15) * 8, kws = KSWZ(sr, sc * 2); char* K_lds = lds + 2 * SHM_V;
    for (int d0 = 0; d0 < 8; ++d0) S.qr[d0] = load8(cur.Q + (size_t)(wid * QBLK + r32) * D + d0 * 16 + hi * 8);
    SLOAD_H(cur.K, cur.V, 0); VMW(); SWRITE_HK(0);
    __syncthreads();
}
__device__ __forceinline__ void sel_block(const BlockRef& cur, const BlockRef& nxt, char* lds, Seam& S) {
    int tid_ = threadIdx.x; asm volatile("" : "+v"(tid_));
    const int tid = tid_, wid = __builtin_amdgcn_readfirstlane(tid >> 6), lane = tid & 63, r32 = lane & 31, hi = lane >> 5;
    const int NT = (cur.P0 + QB) / KVBLK;
    char* V_lds = lds; char* K_lds = lds + 2 * SHM_V;
    float* ws = (float*)(lds + 2 * SHM_V + 2 * SHM_K) + wid * 64; float* li_l = ws, * al_l = ws + 32;
    float m_reg = -1e30f, l_reg = 0; f32x16 o[4] = {};
    const int sr = tid >> 4, sc = (tid & 15) * 8, vst0 = v_st(sr, sc), vst1 = v_st(32 + sr, sc), kws = KSWZ(sr, sc * 2);
    const int vb0 = (int)(uintptr_t)V_lds + v_rd_base(lane);
    const bf16* Kh = cur.K; const bf16* Vh = cur.V;
    const u32x2* Mrow = cur.M + (size_t)(wid * QBLK + r32) * 64;
#define RESC(a) do { if (__any((a) < 1.f)) { if (hi == 0) al_l[r32] = (a); asm volatile("s_waitcnt lgkmcnt(0)" ::: "memory");              \
                     for (int d_ = 0; d_ < 4; ++d_) for (int r = 0; r < 16; ++r) o[d_][r] *= al_l[crow(r, hi)]; } } while (0)
#define KBASE(t) ((t) * KVBLK)
    f32x16 pA0, pA1, pB0, pB1; float mnA, mnB, alA, alB; bf16x8 pa0, pa1, pa2, pa3; u32x2 mw;
    SWRITE_HV(0); SBAR();
    if (NT > 1) SLOAD_H(Kh, Vh, KBASE(1));
    mw = Mrow[0];
    SBAR(); qkt<0, false>(pA0, pA1, K_lds, r32, hi, S.qr, true);
    mask_bits(pA0, pA1, mw, hi); partialSM(pA0, pA1, m_reg, mnA, alA);
    if (NT > 1) { VMW(); SWRITE_H(1); }
    __syncthreads();
#define HALF_STEP(PX0, PX1, mnX, alX, PY0, PY1, alY, t, KB, VB, SB) do {                                                      \
        SBAR(); mw = Mrow[(t)]; qkt<KB, false>(PX0, PX1, K_lds, r32, hi, S.qr, true);                                          \
        finishSM(PY0, PY1, alY, l_reg, pa0, pa1, pa2, pa3); SBAR();                                                           \
        if ((t) + 1 < NT) { SLOAD_H(Kh, Vh, KBASE((t) + 1)); SBAR(); }                                                        \
        pv_tile<VB, false>(o, vb0, pa0, pa1, pa2, pa3, true); mask_bits(PX0, PX1, mw, hi); partialSM(PX0, PX1, m_reg, mnX, alX); \
        __syncthreads();                                                                                                      \
        if ((t) + 1 < NT) { VMW(); SWRITE_H(SB); }                                                                            \
        RESC(alX); __syncthreads(); } while (0)
    for (int t = 1; t + 1 < NT; t += 2) {
        HALF_STEP(pB0, pB1, mnB, alB, pA0, pA1, alA, t, 1, 0, 0);
        HALF_STEP(pA0, pA1, mnA, alA, pB0, pB1, alB, t + 1, 0, 1, 1);
    }
    const bool even = (NT & 1) == 0;
    if (even) { SBAR(); mw = Mrow[NT - 1]; qkt<1, false>(pB0, pB1, K_lds, r32, hi, S.qr, true); SBAR(); }
    SLOAD_H(nxt.K, nxt.V, 0); SBAR();
#pragma unroll
    for (int d0 = 0; d0 < 8; ++d0) S.qr[d0] = load8(nxt.Q + (size_t)(wid * QBLK + r32) * D + d0 * 16 + hi * 8);
    SBAR();
    finishSM(pA0, pA1, alA, l_reg, pa0, pa1, pa2, pa3); SBAR();
    pv_tile<0, false>(o, vb0, pa0, pa1, pa2, pa3, true);
    if (even) { mask_bits(pB0, pB1, mw, hi); partialSM(pB0, pB1, m_reg, mnB, alB); __syncthreads(); RESC(alB);
        finishSM(pB0, pB1, alB, l_reg, pa0, pa1, pa2, pa3); SBAR(); pv_tile<1, false>(o, vb0, pa0, pa1, pa2, pa3, true); }
    SBAR(); VMWN(8); SWRITE_HK(0); SBAR();
    if (hi == 0) li_l[r32] = l_reg; asm volatile("s_waitcnt lgkmcnt(0)" ::: "memory");
    float rli[16];
#pragma unroll
    for (int r = 0; r < 16; ++r) rli[r] = __builtin_amdgcn_rcpf(li_l[crow(r, hi)]);
    bf16* Ow = cur.O + (size_t)(wid * QBLK) * OS;
#pragma unroll
    for (int r = 0; r < 16; ++r) { const int orow = crow(r, hi);
#pragma unroll
        for (int d0 = 0; d0 < 4; ++d0) { const float v = o[d0][r] * rli[r];
            const float vn = __shfl_xor(v, 1);
            if ((r32 & 1) == 0) *(unsigned*)(Ow + (size_t)orow * OS + d0 * 32 + r32) = cvtpk(v, vn); } }
    __syncthreads();
#undef RESC
#undef KBASE
#undef HALF_STEP
}
#undef ROW
#undef VMW
#undef VMWN
#undef SLOAD_H
#undef SWRITE_HK
#undef SWRITE_HV
#undef SWRITE_H
#undef KSWZ
#undef SBAR
}


__device__ __forceinline__ attn::BlockRef attn_ref(const Args& a, int b, int h, int qb) {
    attn::BlockRef r; const int kvh = h / 3;
    r.Q = (const attn::bf16*)(a.ws + WS_QB) + ((size_t)(b * 6 + h) * SEQ + (size_t)qb * 256) * 128;
    r.K = (const attn::bf16*)(a.ws + WS_KB) + (size_t)(b * 2 + kvh) * SEQ * 128;
    r.V = (const attn::bf16*)(a.ws + WS_VB) + (size_t)(b * 2 + kvh) * SEQ * 128;
    r.O = (attn::bf16*)(a.ws + WS_MIX) + (size_t)(b * SEQ + qb * 256) * DM + h * 128;
    r.M = (const attn::u32x2*)(a.ws + WS_MASK) + (size_t)(b * SEQ + qb * 256) * 64;
    r.P0 = qb * 256; return r;
}
__device__ __forceinline__ void p11_attention(Ctx& c, const Args& a) {
    constexpr int NITEM = 192;
#pragma unroll 1
    for (int it = c.vcu; it < NITEM; it += c.G) {
        const int p = it & 7, bh = it >> 3, b = bh / 6, h = bh % 6;
        attn::Seam S;
        attn::BlockRef cur = attn_ref(a, b, h, p), nxt = attn_ref(a, b, h, 15 - p);
        __syncthreads();
        attn::sel_prime(cur, (char*)c.lds, S);
        attn::sel_block(cur, nxt, (char*)c.lds, S);
        attn::sel_block(nxt, nxt, (char*)c.lds, S);
    }
    const int spare = c.G - NITEM;
    if (spare > 0) { if (c.vcu >= NITEM) for (int u = c.vcu - NITEM; u < MS; u += spare) attn_sample_unit(c, a, u >> 2, u & 3); }
    else for (int u = c.vcu; u < MS; u += c.G) attn_sample_unit(c, a, u >> 2, u & 3);
}

constexpr int NPHASE = 16;
#ifndef ONLYPH
#define ONLYPH -1
#endif
#define PHON(x) (ONLYPH < 0 || ONLYPH == (x))
#ifndef REP_PH
#define REP_PH -1
#endif
#ifndef REP_N
#define REP_N 1
#endif
__global__ void __launch_bounds__(NWAVES * 64, 2) fwd_kernel(Args args) {
    extern __shared__ __attribute__((aligned(16))) unsigned char lds[];
    Ctx c;
    c.lds = (LAS unsigned char*)lds;
    c.MISC = (volatile LAS unsigned*)(c.lds + MISC_OFF);
    c.tid = threadIdx.x; c.lane = c.tid & 63; c.wave = __builtin_amdgcn_readfirstlane(c.tid >> 6);
    c.G = gridDim.x; { const int bx = blockIdx.x; c.vcu = (c.G % 8 == 0) ? (bx % 8) * (c.G / 8) + bx / 8 : bx; }
    unsigned char* ws = args.ws;
    c.ctl = (gu32*)(ws + WS_CTL);
    for (int u = c.tid; u < (LDS_BYTES - LDSCTL_OFF) / 4; u += NWAVES * 64) ((LAS unsigned*)(c.lds + LDSCTL_OFF))[u] = 0u;
    __syncthreads();
    const int lo = args.ph_lo, hi = args.ph_hi;
    XcdBarrier bar; bar.bar = (unsigned*)(c.ctl + CW_BAR); bar.x = 0; bar.st = nullptr;
    if (hi - lo > 1 || REP_N > 1) bar = xcd_barrier_post((unsigned*)(c.ctl + CW_BAR), c.MISC + 8);
    float* const out = args.out;
#pragma unroll 1
    for (int ph = lo; ph < hi; ++ph) {
        const int layer = ph >= 7 ? 1 : 0;
        const int nrep = (ph == REP_PH) ? REP_N : 1;
#pragma unroll 1
        for (int rep = 0; rep < nrep; ++rep) {
        c.qoff = 4 * rep;
        { int t_ = threadIdx.x; asm volatile("" : "+v"(t_)); c.tid = t_; c.lane = t_ & 63; c.wave = __builtin_amdgcn_readfirstlane(t_ >> 6); }
        if (ph == 0 && PHON(0)) p0_prologue(c, args);
        else if ((ph == 1 || ph == 7) && PHON(1)) {
            pg8::Gemm g{(const pg8::bf16_t*)(ws + WS_XB), (const pg8::bf16_t*)(ws + (ph == 1 ? WS_WIN0 : WS_WIN1)), MT, 0, 1024};
            pg8::SchedX S; if (ph == 1) S.init(MT, ZC0, c.G, (int)blockIdx.x, 16, MT / 256, 4, 13); else S.init(MT, ZC1, c.G, (int)blockIdx.x, 0, 0, 1, 0);
            pg8::EpiZ E{(pg8::bf16_t*)(ws + WS_Z), ph == 1 ? ZC0 : ZC1, ssptr(c, ph == 1 ? 0 : 2), ph == 1 ? 13 : 9, (float*)(ws + WS_MEMKV), MEMROW0};
            pg8::gemm_phase<pg8::EpiZ, pg8::SchedX, PG8_ALIGN, PG8_SP2>(c.lds + RING_OFF, g, S, E);
        }
        else if (ph == 2 && PHON(2)) p2_mixer0(c, args);
        else if ((ph == 3 || ph == 6 || ph == 12 || ph == 15) && PHON(3)) {
            const bool isout = (ph == 3 || ph == 12);
            pg8::Gemm g{(const pg8::bf16_t*)(ws + (isout ? WS_MIX : WS_ACT)), (const pg8::bf16_t*)(ws + (isout ? WS_WOUT + (size_t)layer * 1024 * 1024 * 2 : WS_WD + (size_t)layer * 1024 * DFF * 2)), MT, 1024, isout ? 1024 : DFF};
            pg8::SchedX S; S.init(MT, 1024, c.G, (int)blockIdx.x, 0, 0, 1, 0);
            pg8::EpiResid E;
            E.rp = ph == 3 ? args.in[0] : out + O_YP; E.rs = ph == 3 ? args.in[1] : out + O_YS; E.y = out + O_YP;
            E.xb = ph == 15 ? nullptr : (pg8::bf16_t*)(ws + WS_XB); E.ssout = ph == 15 ? nullptr : ssptr(c, ph == 3 ? 1 : (ph == 6 ? 2 : 3));
            pg8::gemm_phase<pg8::EpiResid, pg8::SchedX, PG8_ALIGN, PG8_SP2>(c.lds + RING_OFF, g, S, E);
        }
        else if ((ph == 4 || ph == 13) && PHON(4)) {
            pg8::Gemm g{(const pg8::bf16_t*)(ws + WS_XB), (const pg8::bf16_t*)(ws + WS_WGU + (size_t)layer * 5632 * 1024 * 2), MT, 5632, 1024};
            pg8::SchedX S; S.init(MT, 5632, c.G, (int)blockIdx.x, 0, 0, 1, 0);
            pg8::EpiGU E{(pg8::bf16_t*)(ws + WS_U), (pg8::bf16_t*)(ws + WS_UP), ssptr(c, layer ? 3 : 1), out + O_CVP + (size_t)layer * 4 * 2 * DFF, out + O_CVS + (size_t)layer * 32 * 2 * DFF};
            pg8::gemm_phase<pg8::EpiGU, pg8::SchedX, PG8_ALIGN, PG8_SP2>(c.lds + RING_OFF, g, S, E);
        }
        else if ((ph == 5 || ph == 14) && PHON(5)) p5_convact(c, args, layer);
        else if (ph == 8 && PHON(8)) p8_dsa_post(c, args);
        else if (ph == 9 && PHON(9)) p9_indexer(c, args);
        else if (ph == 10 && PHON(10)) p10_topk(c, args);
        else if (ph == 11 && PHON(11)) p11_attention(c, args);
        if (rep + 1 < nrep) xcd_barrier(bar);
        }
        if (ph + 1 < hi) xcd_barrier(bar);
    }
}

#ifndef MK_ONE_LAUNCH
#define MK_ONE_LAUNCH 1
#endif
extern "C" void kernel_launch(void* const* d_in, const int* in_sizes, int n_in, void* d_out, int out_size, void* d_ws, size_t ws_size, hipStream_t stream) {
    static int grid = 0;
    if (grid == 0) {
        if (n_in != 29 || out_size != (int)O_END || ws_size < WS_END) { fprintf(stderr, "kernel_launch: unexpected problem (n_in %d, out %d, ws %zu)\n", n_in, out_size, ws_size); grid = -1; return; }
        int dev = 0, cus = 0;
        if (hipGetDevice(&dev) != hipSuccess || hipDeviceGetAttribute(&cus, hipDeviceAttributeMultiprocessorCount, dev) != hipSuccess) { grid = -1; return; }
        if (hipFuncSetAttribute((const void*)fwd_kernel, hipFuncAttributeMaxDynamicSharedMemorySize, LDS_BYTES) != hipSuccess) { fprintf(stderr, "kernel_launch: hipFuncSetAttribute failed\n"); grid = -1; return; }
        (void)hipGetLastError();
        grid = cus;
    }
    if (grid < 0) return;
    if (hipMemsetAsync((char*)d_ws + WS_CTL, 0, CTL_ZERO_BYTES, stream) != hipSuccess) { fprintf(stderr, "kernel_launch: memset failed\n"); return; }
    Args a{};
    for (int i = 0; i < 29; ++i) a.in[i] = (const float*)d_in[i];
    a.page_table = (const int*)d_in[9]; a.out = (float*)d_out; a.ws = (unsigned char*)d_ws;
#if MK_ONE_LAUNCH
    a.ph_lo = 0; a.ph_hi = NPHASE;
    hipLaunchKernelGGL(fwd_kernel, dim3(grid), dim3(NWAVES * 64), LDS_BYTES, stream, a);
#else
    for (int ph = 0; ph < NPHASE; ++ph) { a.ph_lo = ph; a.ph_hi = ph + 1; hipLaunchKernelGGL(fwd_kernel, dim3(grid), dim3(NWAVES * 64), LDS_BYTES, stream, a); }
#endif
}
```

```cpp
#include <hip/hip_runtime.h>
#include <cstdio>
#include <cstdint>


namespace pg8 {
#define PG8_LAS __attribute__((address_space(3)))
typedef unsigned short bf16_t;
typedef short bf16x8 __attribute__((ext_vector_type(8)));
typedef float f32x4 __attribute__((ext_vector_type(4)));
typedef unsigned u32x4 __attribute__((ext_vector_type(4)));
constexpr int BM = 256, BK = 64, HALF = 128, HTB = HALF * BK * 2  , STAGE_BYTES = 8 * HTB, NXCD = 8, WGM = 8;

__host__ __device__ __forceinline__ int lds_byte(int r, int c) { const int st = (r >> 4) * 2 + (c >> 5), rr = r & 15, cc = c & 31, ob = rr * 64 + cc * 2; return st * 1024 + (ob ^ (((ob >> 9) & 1) << 5)); }
__host__ __device__ __forceinline__ void stage_rc(int b, int& R, int& C) { const int st = b / 1024, sb = b % 1024, swz = sb ^ (((sb >> 9) & 1) << 5); R = (st >> 1) * 16 + swz / 64; C = (st & 1) * 32 + (swz % 64) / 2; }
__host__ __device__ __forceinline__ int perm32(int rho) { const int n = rho >> 4, i = rho & 15; return 8 * (i >> 2) + 4 * n + (i & 3); }

struct Unit { int pm, pn; };
struct Gemm { const bf16_t* A; const bf16_t* Bt; int M, N, K; };

struct StaticOrder {
    int nM, nN, nwg, G, c;
    __host__ __device__ void init(int M, int N, int G_, int c_) { nM = M / BM; nN = N / BM; nwg = nM * nN; G = G_; c = c_; }
    __host__ __device__ bool next(int i, Unit& u) const {
        const long L = (long)i * G + c; if (L >= nwg) return false;
        int wgid = (int)L; { const int q = nwg / NXCD, r = nwg % NXCD, xcd = wgid % NXCD, off = wgid / NXCD; wgid = (xcd < r ? xcd * (q + 1) : r * (q + 1) + (xcd - r) * q) + off; }
        const int nig = WGM * nN, gid = wgid / nig, fm = gid * WGM, gsz = (nM - fm) < WGM ? (nM - fm) : WGM;
        u.pm = fm + ((wgid % nig) % gsz); u.pn = (wgid % nig) / gsz; return true;
    }
    __device__ __forceinline__ void a_ready(const Unit&) const {}
    __device__ __forceinline__ void done(const Unit&) const {}
};


constexpr int MP = 16384, MS = 128, MVALID = MP + MS, MT = 16640, DM = 1024, DFF = 2816;
constexpr float RMS_EPS = 1e-6f;
__device__ __forceinline__ unsigned cvt_pk_bf16(float lo, float hi) { unsigned r; asm volatile("v_cvt_pk_bf16_f32 %0, %1, %2" : "=v"(r) : "v"(lo), "v"(hi)); return r; }

struct SchedX {
    StaticOrder so; int nextra, e_pm0, e_nm, e_pn0;
    __device__ void init(int M, int N, int G_, int c_, int nextra_, int e_pm0_, int e_nm_, int e_pn0_) { so.init(M, N, G_, c_); nextra = nextra_; e_pm0 = e_pm0_; e_nm = e_nm_; e_pn0 = e_pn0_; }
    __device__ bool next(int i, Unit& u) const {
        const long L = (long)i * so.G + so.c;
        if (L < so.nwg) return so.next(i, u);
        const int e = (int)(L - so.nwg); if (e >= nextra) return false;
        u.pm = e_pm0 + e % e_nm; u.pn = e_pn0 + e / e_nm; return true;
    }
    __device__ __forceinline__ void a_ready(const Unit&) const {}
    __device__ __forceinline__ void done(const Unit&) const {}
};

struct EpiZ {
    static constexpr bool PERM = true, AFTER_DRAIN = false;
    bf16_t* Z; int ldz; const float* ss; int nmain; float* memkv; int memrow0;
    __device__ __forceinline__ void operator()(const f32x4 (&acc)[2][2][4][2], const Unit& u, int wr, int wc, int fr, int fq) const {
        const int row0 = u.pm * BM + wr * 64 + fr;
        if (u.pn < nmain) {
            const int col0 = u.pn * BM + wc * 32 + 8 * fq;
#pragma unroll
            for (int ai = 0; ai < 2; ++ai)
#pragma unroll
                for (int m = 0; m < 4; ++m) { const int row = row0 + ai * HALF + m * 16; const float rs = rsqrtf(ss[row] * (1.0f / DM) + RMS_EPS);
#pragma unroll
                    for (int bj = 0; bj < 2; ++bj) { const f32x4 v0 = acc[ai][bj][m][0] * rs, v1 = acc[ai][bj][m][1] * rs;
                        u32x4 w; w.x = cvt_pk_bf16(v0[0], v0[1]); w.y = cvt_pk_bf16(v0[2], v0[3]); w.z = cvt_pk_bf16(v1[0], v1[1]); w.w = cvt_pk_bf16(v1[2], v1[3]);
                        *(u32x4*)(Z + (size_t)row * ldz + col0 + bj * HALF) = w; } }
        } else {
            const int col0 = (u.pn - nmain) * BM + wc * 32 + 8 * fq;
#pragma unroll
            for (int ai = 0; ai < 2; ++ai)
#pragma unroll
                for (int m = 0; m < 4; ++m) { const int row = row0 + ai * HALF + m * 16 - memrow0;
#pragma unroll
                    for (int bj = 0; bj < 2; ++bj) { float* p = memkv + (size_t)row * 1024 + col0 + bj * HALF; *(f32x4*)p = acc[ai][bj][m][0]; *(f32x4*)(p + 4) = acc[ai][bj][m][1]; } }
        }
    }
};

struct EpiResid {
    static constexpr bool PERM = true, AFTER_DRAIN = false;
    const float* rp; const float* rs; float* y; bf16_t* xb; float* ssout;
    __device__ __forceinline__ void operator()(const f32x4 (&acc)[2][2][4][2], const Unit& u, int wr, int wc, int fr, int fq) const {
        const int row0 = u.pm * BM + wr * 64 + fr, col0 = u.pn * BM + wc * 32 + 8 * fq;
#pragma unroll
        for (int ai = 0; ai < 2; ++ai)
#pragma unroll
            for (int m = 0; m < 4; ++m) { const int row = row0 + ai * HALF + m * 16; float part = 0.f;
                if (row < MVALID) { const float* src = row < MP ? rp + (size_t)row * DM : rs + (size_t)(row - MP) * DM;
#pragma unroll
                    for (int bj = 0; bj < 2; ++bj) { const int c = col0 + bj * HALF;
                        const f32x4 v0 = acc[ai][bj][m][0] + *(const f32x4*)(src + c), v1 = acc[ai][bj][m][1] + *(const f32x4*)(src + c + 4);
                        *(f32x4*)(y + (size_t)row * DM + c) = v0; *(f32x4*)(y + (size_t)row * DM + c + 4) = v1;
                        part += (v0[0] * v0[0] + v0[1] * v0[1]) + (v0[2] * v0[2] + v0[3] * v0[3]) + (v1[0] * v1[0] + v1[1] * v1[1]) + (v1[2] * v1[2] + v1[3] * v1[3]);
                        if (xb) { u32x4 w; w.x = cvt_pk_bf16(v0[0], v0[1]); w.y = cvt_pk_bf16(v0[2], v0[3]); w.z = cvt_pk_bf16(v1[0], v1[1]); w.w = cvt_pk_bf16(v1[2], v1[3]);
                            *(u32x4*)(xb + (size_t)row * DM + c) = w; } } }
                part += __shfl_xor(part, 16); part += __shfl_xor(part, 32);
                if (ssout && fq == 0 && row < MVALID) atomicAdd(ssout + row, part); }
    }
};

struct EpiGU {
    static constexpr bool PERM = true, AFTER_DRAIN = false;
    bf16_t* U; bf16_t* UP; const float* ss; float* cvp; float* cvs;
    __device__ __forceinline__ void operator()(const f32x4 (&acc)[2][2][4][2], const Unit& u, int wr, int wc, int fr, int fq) const {
        const int row0 = u.pm * BM + wr * 64 + fr, colg = u.pn * HALF + wc * 32 + 8 * fq;
#pragma unroll
        for (int ai = 0; ai < 2; ++ai)
#pragma unroll
            for (int m = 0; m < 4; ++m) { const int row = row0 + ai * HALF + m * 16; const float rs = rsqrtf(ss[row] * (1.0f / DM) + RMS_EPS);
                const f32x4 g0 = acc[ai][0][m][0] * rs, g1 = acc[ai][0][m][1] * rs, p0 = acc[ai][1][m][0] * rs, p1 = acc[ai][1][m][1] * rs;
                u32x4 w; w.x = cvt_pk_bf16(g0[0], g0[1]); w.y = cvt_pk_bf16(g0[2], g0[3]); w.z = cvt_pk_bf16(g1[0], g1[1]); w.w = cvt_pk_bf16(g1[2], g1[3]);
                *(u32x4*)(U + (size_t)row * DFF + colg) = w;
                w.x = cvt_pk_bf16(p0[0], p0[1]); w.y = cvt_pk_bf16(p0[2], p0[3]); w.z = cvt_pk_bf16(p1[0], p1[1]); w.w = cvt_pk_bf16(p1[2], p1[3]);
                *(u32x4*)(UP + (size_t)row * DFF + colg) = w;
                float* cv = nullptr;
                if (row < MP) { const int t = row & 4095; if (t >= 4094) cv = cvp + (size_t)((row >> 12) * 2 + (t - 4094)) * DFF; }
                else if (row < MVALID) { const int r2 = row - MP, t = r2 & 3; if (t >= 2) cv = cvs + (size_t)((r2 >> 2) * 2 + (t - 2)) * DFF; }
                if (cv) { *(f32x4*)(cv + colg) = g0; *(f32x4*)(cv + colg + 4) = g1; } }
    }
};

template <class Epi, class Sched, bool ALIGN_EPI = false, bool SP2 = false>
__device__ __forceinline__ void gemm_phase(PG8_LAS unsigned char* lds, const Gemm g, const Sched& S, const Epi& E) {
    int tid_ = threadIdx.x; asm volatile("" : "+v"(tid_));
    const int tid = tid_, wid = __builtin_amdgcn_readfirstlane(tid >> 6), lane = tid & 63, wr = wid >> 2, wc = wid & 3, fr = lane & 15, fq = lane >> 4;
    const int K = g.K, nt = K / BK;
    unsigned voffA[2], voffB[2];
#pragma unroll
    for (int i = 0; i < 2; ++i) { int R, C; stage_rc(tid * 16 + i * 8192, R, C); const int Rb = Epi::PERM ? ((R & ~31) + perm32(R & 31)) : R;
        voffA[i] = (unsigned)(R * K + C) * 2u; voffB[i] = (unsigned)(Rb * K + C) * 2u; }
    const size_t kstep = (size_t)(BK * 2);
    const size_t hstep = (size_t)HALF * K * 2;
    const size_t tstep = 2 * hstep;
    const unsigned ldsw = (unsigned)wid * 1024u;
    const int aoff = lds_byte(wr * 64 + fr, fq * 8), boff = lds_byte(wc * 32 + fr, fq * 8);
#define PG8_SA(b, h) (((b) * 2 + (h)) * HTB)
#define PG8_SB(b, h) ((4 + (b) * 2 + (h)) * HTB)
#define PG8_STAGE(bufoff, gbase, voff) do { _Pragma("unroll") for (int _i = 0; _i < 2; ++_i) \
        __builtin_amdgcn_global_load_lds((const unsigned*)((const char*)(gbase) + (voff)[_i]), (PG8_LAS unsigned*)(lds + (bufoff) + ldsw + _i * 8192), 16, 0, 0); } while (0)
#define PG8_LDA(dst, b, h) do { _Pragma("unroll") for (int m = 0; m < 4; ++m) _Pragma("unroll") for (int k = 0; k < 2; ++k) dst[m][k] = *(const PG8_LAS bf16x8*)(lds + PG8_SA(b, h) + aoff + m * 2048 + k * 1024); } while (0)
#define PG8_LDB(dst, b, h) do { _Pragma("unroll") for (int n = 0; n < 2; ++n) _Pragma("unroll") for (int k = 0; k < 2; ++k) dst[n][k] = *(const PG8_LAS bf16x8*)(lds + PG8_SB(b, h) + boff + n * 2048 + k * 1024); } while (0)
#define PG8_MMA(ai, bj, At, Bt) do { __builtin_amdgcn_s_setprio(1); _Pragma("unroll") for (int m = 0; m < 4; ++m) _Pragma("unroll") for (int n = 0; n < 2; ++n) _Pragma("unroll") for (int k = 0; k < 2; ++k) \
        acc[ai][bj][m][n] = __builtin_amdgcn_mfma_f32_16x16x32_bf16(Bt[n][k], At[m][k], acc[ai][bj][m][n], 0, 0, 0); __builtin_amdgcn_s_setprio(0); } while (0)
#define PG8_WAIT_V(n) asm volatile("s_waitcnt vmcnt(" #n ")" ::: "memory")
#define PG8_WAIT_L(n) asm volatile("s_waitcnt lgkmcnt(" #n ")" ::: "memory")
#define PG8_BAR __builtin_amdgcn_s_barrier()
#define PG8_SCHED __builtin_amdgcn_sched_barrier(0)
    Unit cur, nxt; int ui = 0;
    if (!S.next(0, cur)) return;
    f32x4 acc[2][2][4][2];
#pragma unroll
    for (int a = 0; a < 2; ++a)
#pragma unroll
        for (int b = 0; b < 2; ++b)
#pragma unroll
            for (int m = 0; m < 4; ++m)
#pragma unroll
                for (int n = 0; n < 2; ++n) acc[a][b][m][n] = (f32x4){0.f, 0.f, 0.f, 0.f};
    bf16x8 At[4][2], B0[2][2], B1[2][2];
    const char* cA = (const char*)g.A + (size_t)cur.pm * tstep; const char* cB = (const char*)g.Bt + (size_t)cur.pn * tstep;
    S.a_ready(cur);
    if constexpr (SP2) {
        PG8_STAGE(PG8_SB(0, 0), cB, voffB); PG8_STAGE(PG8_SB(0, 1), cB + hstep, voffB); PG8_STAGE(PG8_SA(0, 0), cA, voffA); PG8_STAGE(PG8_SA(0, 1), cA + hstep, voffA);
        if (wr == 1) PG8_BAR;
        PG8_WAIT_V(2); PG8_BAR;
        PG8_STAGE(PG8_SB(1, 0), cB + kstep, voffB); PG8_STAGE(PG8_SA(1, 0), cA + kstep, voffA); PG8_STAGE(PG8_SB(1, 1), cB + hstep + kstep, voffB);
        PG8_WAIT_V(6); PG8_BAR;
    } else {
        PG8_STAGE(PG8_SB(0, 0), cB, voffB); PG8_STAGE(PG8_SA(0, 0), cA, voffA); PG8_STAGE(PG8_SB(0, 1), cB + hstep, voffB); PG8_STAGE(PG8_SA(0, 1), cA + hstep, voffA);
        if (wr == 1) PG8_BAR;
        PG8_WAIT_V(4); PG8_BAR;
        PG8_STAGE(PG8_SB(1, 0), cB + kstep, voffB); PG8_STAGE(PG8_SA(1, 0), cA + kstep, voffA); PG8_STAGE(PG8_SB(1, 1), cB + hstep + kstep, voffB);
        PG8_WAIT_V(6); PG8_BAR;
    }
    for (;;) {
        const bool has_next = S.next(ui + 1, nxt);
        const char* nA = has_next ? (const char*)g.A + (size_t)nxt.pm * tstep : cA; const char* nB = has_next ? (const char*)g.Bt + (size_t)nxt.pn * tstep : cB;
        for (int t = 0; t < nt; t += 2) {
            const bool last = (t == nt - 2);
            const char* a1 = cA + (size_t)(t + 1) * kstep;
            const char* a2 = last ? nA : cA + (size_t)(t + 2) * kstep; const char* b2 = last ? nB : cB + (size_t)(t + 2) * kstep;
            const char* a3 = a2 + kstep; const char* b3 = b2 + kstep;
            if (last && has_next) S.a_ready(nxt);
            if constexpr (SP2) {
            PG8_LDB(B0, 0, 0); PG8_LDB(B1, 0, 1); PG8_SCHED; PG8_LDA(At, 0, 0); PG8_STAGE(PG8_SA(1, 1), a1 + hstep, voffA);
            PG8_WAIT_V(8); PG8_WAIT_L(0); PG8_BAR; PG8_MMA(0, 0, At, B0); PG8_MMA(0, 1, At, B1); PG8_BAR; PG8_SCHED;
            PG8_LDA(At, 0, 1); PG8_STAGE(PG8_SB(0, 0), b2, voffB); PG8_STAGE(PG8_SB(0, 1), b2 + hstep, voffB); PG8_STAGE(PG8_SA(0, 0), a2, voffA);
            PG8_WAIT_V(8); PG8_WAIT_L(0); PG8_BAR; PG8_MMA(1, 0, At, B0); PG8_MMA(1, 1, At, B1); PG8_BAR; PG8_SCHED;
            PG8_LDB(B0, 1, 0); PG8_LDB(B1, 1, 1); PG8_SCHED; PG8_LDA(At, 1, 0); PG8_STAGE(PG8_SA(0, 1), a2 + hstep, voffA);
            PG8_WAIT_V(8); PG8_WAIT_L(0); PG8_BAR; PG8_MMA(0, 0, At, B0); PG8_MMA(0, 1, At, B1); PG8_BAR; PG8_SCHED;
            PG8_LDA(At, 1, 1); PG8_STAGE(PG8_SB(1, 0), b3, voffB); PG8_STAGE(PG8_SB(1, 1), b3 + hstep, voffB); PG8_STAGE(PG8_SA(1, 0), a3, voffA);
            PG8_WAIT_V(8); PG8_WAIT_L(0); PG8_BAR; PG8_MMA(1, 0, At, B0); PG8_MMA(1, 1, At, B1); PG8_BAR; PG8_SCHED;
            } else {
            PG8_LDB(B0, 0, 0); PG8_SCHED; PG8_LDA(At, 0, 0); PG8_STAGE(PG8_SA(1, 1), a1 + hstep, voffA);
            PG8_WAIT_L(8); PG8_BAR; PG8_WAIT_L(0); PG8_MMA(0, 0, At, B0); PG8_BAR; PG8_SCHED;
            PG8_LDB(B1, 0, 1); PG8_STAGE(PG8_SB(0, 0), b2, voffB);
            PG8_BAR; PG8_WAIT_L(0); PG8_MMA(0, 1, At, B1); PG8_BAR;
            PG8_LDA(At, 0, 1); PG8_STAGE(PG8_SA(0, 0), a2, voffA);
            PG8_BAR; PG8_WAIT_L(0); PG8_MMA(1, 0, At, B0); PG8_BAR; PG8_SCHED;
            PG8_STAGE(PG8_SB(0, 1), b2 + hstep, voffB);
            PG8_WAIT_V(6); PG8_BAR; PG8_MMA(1, 1, At, B1); PG8_BAR;
            PG8_LDB(B0, 1, 0); PG8_SCHED; PG8_LDA(At, 1, 0); PG8_STAGE(PG8_SA(0, 1), a2 + hstep, voffA);
            PG8_WAIT_L(8); PG8_BAR; PG8_WAIT_L(0); PG8_MMA(0, 0, At, B0); PG8_BAR; PG8_SCHED;
            PG8_LDB(B1, 1, 1); PG8_STAGE(PG8_SB(1, 0), b3, voffB);
            PG8_BAR; PG8_WAIT_L(0); PG8_MMA(0, 1, At, B1); PG8_BAR;
            PG8_LDA(At, 1, 1); PG8_STAGE(PG8_SA(1, 0), a3, voffA);
            PG8_BAR; PG8_WAIT_L(0); PG8_MMA(1, 0, At, B0); PG8_BAR; PG8_SCHED;
            PG8_STAGE(PG8_SB(1, 1), b3 + hstep, voffB);
            PG8_WAIT_V(6); PG8_BAR; PG8_MMA(1, 1, At, B1); PG8_BAR;
            }
        }
        if constexpr (ALIGN_EPI) { if (wr == 0) PG8_BAR; }
        if constexpr (!Epi::AFTER_DRAIN) { E(acc, cur, wr, wc, fr, fq); S.done(cur); }
        if (!has_next) break;
#pragma unroll
        for (int a = 0; a < 2; ++a)
#pragma unroll
            for (int b = 0; b < 2; ++b)
#pragma unroll
                for (int m = 0; m < 4; ++m)
#pragma unroll
                    for (int n = 0; n < 2; ++n) acc[a][b][m][n] = (f32x4){0.f, 0.f, 0.f, 0.f};
        cur = nxt; cA = nA; cB = nB; ++ui;
        if constexpr (ALIGN_EPI) { if (wr == 1) PG8_BAR; }
    }
    PG8_WAIT_V(0);
    if constexpr (!ALIGN_EPI) { if (wr == 0) PG8_BAR; }
    PG8_BAR;
    if constexpr (Epi::AFTER_DRAIN) { E.fused(acc, cur, wr, wc, fr, fq, lds, wid, lane); S.done(cur); }
#undef PG8_SA
#undef PG8_SB
#undef PG8_STAGE
#undef PG8_LDA
#undef PG8_LDB
#undef PG8_MMA
#undef PG8_WAIT_V
#undef PG8_WAIT_L
#undef PG8_BAR
#undef PG8_SCHED
}
}


#ifndef PG8_SP2
#define PG8_SP2 true
#endif
#ifndef PG8_ALIGN
#define PG8_ALIGN true
#endif
constexpr int NWAVES = 8;
constexpr int MP = pg8::MP, MS = pg8::MS, MVALID = pg8::MVALID, MT = pg8::MT, DM = 1024, DFF = 2816;
constexpr int SEQ = 4096, NB = 4, NSB = 32, PAST = 8192, NPOOL = 2560;
constexpr int ZC0 = 3328, ZC1 = 2304;
constexpr int Z1_Q = 0, Z1_K = 768, Z1_V = 1024, Z1_IQ = 1280, Z1_IK = 1792, Z1_IW = 1856, Z1_MQ = 1920;
constexpr int NMEMROWS = 1024, MEMROW0 = MT;
constexpr float EPS = 1e-6f;
constexpr size_t MiB = 1u << 20;
constexpr size_t WS_CTL = 0, CTL_ZERO_BYTES = 2 * MiB;
constexpr size_t WS_WIN0 = 2 * MiB, WS_WIN1 = 11 * MiB, WS_WOUT = 16 * MiB, WS_WGU = 20 * MiB, WS_WD = 42 * MiB;
constexpr size_t WS_XB = 54 * MiB, WS_MEMKV = 89 * MiB, WS_MIX = 94 * MiB, WS_Z = 128 * MiB, WS_U = 234 * MiB, WS_UP = 324 * MiB, WS_ACT = 414 * MiB;
constexpr size_t WS_QB = 504 * MiB, WS_KB = 528 * MiB, WS_VB = 536 * MiB, WS_IQB = 544 * MiB, WS_IKB = 560 * MiB, WS_IW = 562 * MiB;
constexpr size_t WS_SQ = 563 * MiB, WS_SIQ = WS_SQ + 512 * 1024, WS_SIW = WS_SIQ + 384 * 1024, WS_SSC = 564 * MiB, WS_SIDX = 569 * MiB, WS_MASK = 570 * MiB, WS_SC = 578 * MiB, WS_END = 834 * MiB;
constexpr int SSC_LD = 8256;
constexpr int CW_TMO = 0, CW_BAR = 4096, CW_Q = 8192, CW_SS = 16384;
constexpr size_t O_YP = 0, O_YS = O_YP + (size_t)MP * DM, O_HP = O_YS + (size_t)MS * DM, O_HS = O_HP + 4 * 6 * 16384, O_KP = O_HS + 32 * 6 * 16384,
    O_VP = O_KP + (size_t)MP * 256, O_IKP = O_VP + (size_t)MP * 256, O_KS = O_IKP + (size_t)MP * 64, O_VS = O_KS + MS * 256, O_IKS = O_VS + MS * 256,
    O_MK = O_IKS + MS * 64, O_MV = O_MK + 2 * 1024 * 256, O_CVP = O_MV + 2 * 1024 * 256, O_CVS = O_CVP + 2 * 4 * 2 * DFF, O_END = O_CVS + 2 * 32 * 2 * DFF;
static_assert(O_END == 31412224, "output size");
constexpr int RING_OFF = 0, RING_BYTES = 131072;
constexpr int LDSCTL_OFF = RING_BYTES, MISC_OFF = LDSCTL_OFF + 320;
constexpr int LDS_BYTES = 147456;

#define GAS __attribute__((address_space(1)))
#define LAS __attribute__((address_space(3)))
typedef unsigned short bf16;
typedef unsigned v4u __attribute__((ext_vector_type(4)));
typedef float f32x4 __attribute__((ext_vector_type(4)));
typedef short bf16x8 __attribute__((ext_vector_type(8)));
typedef GAS unsigned gu32;
typedef GAS unsigned long long gu64;
#define RLX_AGENT __ATOMIC_RELAXED, __HIP_MEMORY_SCOPE_AGENT
#define LDS_WAIT() asm volatile("s_waitcnt lgkmcnt(0)" ::: "memory")
#define VM_WAIT() asm volatile("s_waitcnt vmcnt(0)" ::: "memory")
__device__ __forceinline__ unsigned long long rt() { return __builtin_amdgcn_s_memrealtime(); }
__device__ __forceinline__ unsigned f2bf(float f) { unsigned u = __builtin_bit_cast(unsigned, f); return (u + 0x7fffu + ((u >> 16) & 1u)) >> 16; }
__device__ __forceinline__ unsigned pk2(float lo, float hi) { return f2bf(lo) | (f2bf(hi) << 16); }

#define XB_TMO      128
#define XB_XCNT(j)  (256  + 64 * (j))
#define XB_XSUB(j)  (1280 + 64 * (j))
#define XB_XGEN(j)  (2304 + 64 * (j))
#define XB_TOP      3328
#define XB_TOPGEN   3392
#define XCD_BAR_WORDS 3456
#define XB_SPIN_CAP (1u << 18)

__device__ __forceinline__ unsigned xb_ld(unsigned* p)              { return __hip_atomic_load(p, __ATOMIC_RELAXED, __HIP_MEMORY_SCOPE_AGENT); }
__device__ __forceinline__ unsigned xb_add(unsigned* p, unsigned v) { return __hip_atomic_fetch_add(p, v, __ATOMIC_RELAXED, __HIP_MEMORY_SCOPE_AGENT); }
__device__ __forceinline__ unsigned xb_xcc_id() { return (unsigned)__builtin_amdgcn_s_getreg((3 << 11) | 20) & 0xFu; }
#define XB_SPIN(cond, bar) do { unsigned _sp = 0; while (cond) { __builtin_amdgcn_s_sleep(1); \
    if ((++_sp & 255u) == 0u) { if (xb_ld(&(bar)[XB_TMO])) break; if (_sp > XB_SPIN_CAP) { atomicAdd(&(bar)[XB_TMO], 1u); break; } } } } while (0)

struct XcdBarrier {
    unsigned* bar; unsigned x;
    volatile LAS unsigned* st;
};

__device__ __forceinline__ XcdBarrier xcd_barrier_post(unsigned* bar, volatile LAS unsigned* st) {
    XcdBarrier b; b.bar = bar; b.x = xb_xcc_id(); b.st = st;
    if (threadIdx.x == 0) (void)xb_add(&bar[XB_XCNT(b.x)], 1u);
    return b;
}
__device__ __forceinline__ void xcd_barrier_complete(unsigned* bar, unsigned x, unsigned& nloc, unsigned& nx) {
    const unsigned G = gridDim.x * gridDim.y * gridDim.z;
    unsigned sum, cnt, mine, sp = 0u;
    for (;;) {
        sum = 0u; cnt = 0u; mine = 0u;
#pragma unroll
        for (unsigned j = 0; j < 16; ++j) { const unsigned c = xb_ld(&bar[XB_XCNT(j)]); sum += c; cnt += (c > 0u) ? 1u : 0u; mine = (j == x) ? c : mine; }
        if (sum == G) break;
        __builtin_amdgcn_s_sleep(1);
        if ((++sp & 255u) == 0u) { if (xb_ld(&bar[XB_TMO])) break; if (sp > XB_SPIN_CAP) { atomicAdd(&bar[XB_TMO], 1u); break; } }
    }
    nloc = mine > 0u ? mine : 1u; nx = cnt > 0u ? cnt : 1u;
}

__device__ __forceinline__ void xcd_barrier(const XcdBarrier& b) {
    asm volatile("s_waitcnt vmcnt(0)" ::: "memory");
    __syncthreads();
    if (threadIdx.x == 0) {
        unsigned* bar = b.bar;
        __builtin_amdgcn_s_waitcnt(0);
        unsigned nloc = b.st[0], nx = b.st[1];
        if (nloc == 0u) { xcd_barrier_complete(bar, b.x, nloc, nx); b.st[0] = nloc; b.st[1] = nx; }
        const unsigned old = xb_add(&bar[XB_XSUB(b.x)], 1u);
        const unsigned gen = old / nloc;
        if (old + 1u == (gen + 1u) * nloc) {
            __builtin_amdgcn_fence(__ATOMIC_RELEASE, "agent");
            asm volatile("s_waitcnt vmcnt(0)" ::: "memory");
            const unsigned og = xb_add(&bar[XB_TOP], 1u);
            const unsigned tg = og / nx;
            if (og + 1u == (tg + 1u) * nx) xb_add(&bar[XB_TOPGEN], 1u);
            else XB_SPIN(xb_ld(&bar[XB_TOPGEN]) == tg, bar);
            __builtin_amdgcn_fence(__ATOMIC_ACQUIRE, "agent");
            xb_add(&bar[XB_XGEN(b.x)], 1u);
            asm volatile("s_waitcnt vmcnt(0)" ::: "memory");
        } else {
            XB_SPIN(xb_ld(&bar[XB_XGEN(b.x)]) == gen, bar);
            __builtin_amdgcn_fence(__ATOMIC_ACQUIRE, "agent");
            asm volatile("s_waitcnt vmcnt(0)" ::: "memory");
        }
    }
    __syncthreads();
}


struct Args { const float* in[29]; const int* page_table; float* out; unsigned char* ws; int ph_lo, ph_hi; };
struct Ctx { LAS unsigned char* lds; volatile LAS unsigned* MISC; gu32* ctl; int tid, lane, wave, vcu, G, qoff; };
typedef float f32x16 __attribute__((ext_vector_type(16)));
typedef unsigned long long u64;

__device__ __forceinline__ float bf2f(unsigned b) { return __builtin_bit_cast(float, b << 16); }
__device__ __forceinline__ float wave_sum(float v) {
#pragma unroll
    for (int o = 1; o < 64; o <<= 1) v += __shfl_xor(v, o);
    return v;
}
__device__ __forceinline__ int crow(int r, int hi) { return (r & 3) + 8 * (r >> 2) + 4 * hi; }
__device__ __forceinline__ float sigmoidf_(float x) { return 1.0f / (1.0f + __expf(-x)); }
__device__ __forceinline__ float* ssptr(const Ctx& c, int i) { return (float*)(c.ctl + CW_SS) + (size_t)i * MT; }

__device__ __forceinline__ int q_next(Ctx& c, int qi) {
    __syncthreads();
    if (c.tid == 0) c.MISC[16] = atomicAdd((unsigned*)(c.ctl + CW_Q + 64 * (qi + c.qoff)), 1u);
    __syncthreads();
    return (int)c.MISC[16];
}

template <int K>
__device__ __forceinline__ f32x16 mm32(const LAS bf16* A, int lda, const LAS bf16* Bt, int ldb, f32x16 acc, int lane) {
    const int r = lane & 31, h = lane >> 5;
#pragma unroll
    for (int ks = 0; ks < K; ks += 16) {
        const bf16x8 a = *(const LAS bf16x8*)(A + r * lda + ks + 8 * h);
        const bf16x8 b = *(const LAS bf16x8*)(Bt + r * ldb + ks + 8 * h);
        acc = __builtin_amdgcn_mfma_f32_32x32x16_bf16(a, b, acc, 0, 0, 0);
    }
    return acc;
}

__device__ __forceinline__ int map_row(int mapid, int n, int row_off) {
    if (mapid == 0) return n + row_off;
    if (mapid == 1) return n < 1864 ? n : n + 56;
    if (mapid == 2) return (n >> 7) * 256 + (n & 127);
    return (n >> 7) * 256 + 128 + (n & 127);
}
__device__ __forceinline__ void transpose_item(const float* W, int K, int N, const float* kscale, bf16* WT, int mapid, int row_off, LAS float* scr, int item, int lane) {
    const int nblk = (N + 31) / 32, kb = item / nblk, nb = item % nblk, k0 = 64 * kb, n0 = 32 * nb;
#pragma unroll 8
    for (int i = 0; i < 32; ++i) { const int kk = 2 * i + (lane >> 5), n = n0 + (lane & 31);
        float v = W[(size_t)(k0 + kk) * N + (n < N ? n : N - 1)]; if (kscale) v *= kscale[k0 + kk];
        scr[kk * 33 + (lane & 31)] = v; }
    LDS_WAIT(); asm volatile("" ::: "memory");
    const int cc = lane & 7;
#pragma unroll
    for (int j = 0; j < 4; ++j) { const int nl = (lane >> 3) + 8 * j, n = n0 + nl; const LAS float* s = scr + (8 * cc) * 33 + nl;
        v4u o; o.x = pk2(s[0 * 33], s[1 * 33]); o.y = pk2(s[2 * 33], s[3 * 33]); o.z = pk2(s[4 * 33], s[5 * 33]); o.w = pk2(s[6 * 33], s[7 * 33]);
        if (n < N) *(GAS v4u*)(WT + (size_t)map_row(mapid, n, row_off) * K + k0 + 8 * cc) = o; }
    LDS_WAIT(); asm volatile("" ::: "memory");
}
__device__ __forceinline__ void p0_prologue(Ctx& c, const Args& a) {
    LAS float* scr = (LAS float*)(c.lds + RING_OFF + c.wave * 16384);
    const int gw = c.vcu * NWAVES + c.wave, NGW = c.G * NWAVES, lane = c.lane;
    unsigned char* ws = a.ws;
    constexpr int I_INH = 16 * 104, I_MKV = 16 * 16, I_DSA = 16 * 67, I_OUT = 16 * 32, I_G = 16 * 88, I_D = 44 * 32;
    constexpr int NITEMS = I_INH + 2 * I_MKV + I_DSA + 2 * I_OUT + 4 * I_G + 2 * I_D;
    for (int it = gw; it < NITEMS; it += NGW) {
        int r = it;
        if (r < I_INH) { transpose_item(a.in[13], 1024, 3328, a.in[11], (bf16*)(ws + WS_WIN0), 0, 0, scr, r, lane); continue; } r -= I_INH;
        if (r < I_MKV) { transpose_item(a.in[20], 1024, 512, nullptr, (bf16*)(ws + WS_WIN0), 0, 3328, scr, r, lane); continue; } r -= I_MKV;
        if (r < I_MKV) { transpose_item(a.in[20] + 1024 * 512, 1024, 512, nullptr, (bf16*)(ws + WS_WIN0), 0, 3840, scr, r, lane); continue; } r -= I_MKV;
        if (r < I_DSA) { transpose_item(a.in[16], 1024, 2120, a.in[11] + 1024, (bf16*)(ws + WS_WIN1), 1, 0, scr, r, lane); continue; } r -= I_DSA;
        if (r < 2 * I_OUT) { const int l = r / I_OUT; transpose_item(a.in[23] + (size_t)l * 1024 * 1024, 1024, 1024, nullptr, (bf16*)(ws + WS_WOUT) + (size_t)l * 1024 * 1024, 0, 0, scr, r % I_OUT, lane); continue; } r -= 2 * I_OUT;
        if (r < 2 * I_G) { const int l = r / I_G; transpose_item(a.in[24] + (size_t)l * 1024 * DFF, 1024, DFF, a.in[12] + l * 1024, (bf16*)(ws + WS_WGU) + (size_t)l * 5632 * 1024, 2, 0, scr, r % I_G, lane); continue; } r -= 2 * I_G;
        if (r < 2 * I_G) { const int l = r / I_G; transpose_item(a.in[25] + (size_t)l * 1024 * DFF, 1024, DFF, a.in[12] + l * 1024, (bf16*)(ws + WS_WGU) + (size_t)l * 5632 * 1024, 3, 0, scr, r % I_G, lane); continue; } r -= 2 * I_G;
        { const int l = r / I_D; transpose_item(a.in[28] + (size_t)l * DFF * 1024, DFF, 1024, nullptr, (bf16*)(ws + WS_WD) + (size_t)l * 1024 * DFF, 0, 0, scr, r % I_D, lane); }
    }
    for (int rr = gw; rr < 184; rr += NGW) { const int row = rr < 56 ? 1864 + rr : 2176 + (rr - 56);
        GAS v4u* p = (GAS v4u*)((bf16*)(ws + WS_WIN1) + (size_t)row * 1024); p[lane] = (v4u){0u, 0u, 0u, 0u}; p[64 + lane] = (v4u){0u, 0u, 0u, 0u}; }
    float* ss0 = ssptr(c, 0);
    for (int m = gw; m < MT + NMEMROWS; m += NGW) {
        GAS u64* o8 = (GAS u64*)((bf16*)(ws + WS_XB) + (size_t)m * DM) + lane;
        if (m >= MVALID && m < MT) {
#pragma unroll
            for (int j = 0; j < 4; ++j) o8[64 * j] = 0ull;
            continue; }
        const float* src = m < MP ? a.in[0] + (size_t)m * DM : (m < MVALID ? a.in[1] + (size_t)(m - MP) * DM : a.in[10] + (size_t)(m - MT) * DM);
        const GAS f32x4* xr = (const GAS f32x4*)src + lane; f32x4 v[4]; float s = 0.f;
#pragma unroll
        for (int j = 0; j < 4; ++j) { v[j] = xr[64 * j]; s += (v[j].x * v[j].x + v[j].y * v[j].y) + (v[j].z * v[j].z + v[j].w * v[j].w); }
        s = wave_sum(s);
#pragma unroll
        for (int j = 0; j < 4; ++j) o8[64 * j] = (u64)pk2(v[j].x, v[j].y) | ((u64)pk2(v[j].z, v[j].w) << 32);
        if (m < MVALID && lane == 0) ss0[m] = s;
    }
}

__device__ __forceinline__ void memattn_unit(Ctx& c, const bf16* Zq  , int ldz, int nrows_valid, const float* Kp, const float* Vp, int kstride,
                                             bool normk, const float* kgain, const float* qgain, bf16* Out  ) {
    LAS bf16* KN = (LAS bf16*)(c.lds);
    LAS bf16* VTm = (LAS bf16*)(c.lds + 36864);
    LAS bf16* QN = (LAS bf16*)(c.lds + 70656) + c.wave * (32 * 72);
    LAS float* LI = (LAS float*)(c.lds + 107520) + c.wave * 32;
    int tid = c.tid; asm volatile("" : "+v"(tid));
    const int lane = tid & 63, w = c.wave;
    {
        const int m = tid >> 1, dh = (tid & 1) * 32;
        f32x4 kv[8]; float s = 0.f;
#pragma unroll
        for (int j = 0; j < 8; ++j) { kv[j] = *(const f32x4*)(Kp + (size_t)m * kstride + dh + 4 * j); s += (kv[j].x * kv[j].x + kv[j].y * kv[j].y) + (kv[j].z * kv[j].z + kv[j].w * kv[j].w); }
        s += __shfl_xor(s, 1);
        const float rs = normk ? rsqrtf(s * (1.0f / 64.0f) + EPS) : 1.0f;
#pragma unroll
        for (int j = 0; j < 8; j += 2) { f32x4 g0 = {1.f, 1.f, 1.f, 1.f}, g1 = g0;
            if (normk) { g0 = *(const f32x4*)(kgain + dh + 4 * j); g1 = *(const f32x4*)(kgain + dh + 4 * j + 4); }
            const f32x4 x0 = kv[j] * rs * g0, x1 = kv[j + 1] * rs * g1;
            v4u o; o.x = pk2(x0.x, x0.y); o.y = pk2(x0.z, x0.w); o.z = pk2(x1.x, x1.y); o.w = pk2(x1.z, x1.w);
            *(LAS v4u*)(KN + m * 72 + dh + 4 * j) = o; }
#pragma unroll
        for (int j = 0; j < 8; ++j) { const f32x4 vv = *(const f32x4*)(Vp + (size_t)m * kstride + dh + 4 * j);
            VTm[(dh + 4 * j + 0) * 264 + m] = (bf16)f2bf(vv.x); VTm[(dh + 4 * j + 1) * 264 + m] = (bf16)f2bf(vv.y);
            VTm[(dh + 4 * j + 2) * 264 + m] = (bf16)f2bf(vv.z); VTm[(dh + 4 * j + 3) * 264 + m] = (bf16)f2bf(vv.w); }
    }
    {
        const int row = lane >> 1, hf = lane & 1, grow = w * 32 + row;
        float x[32]; float s = 0.f;
        if (grow < nrows_valid) {
#pragma unroll
            for (int j = 0; j < 4; ++j) { const v4u q = *(const v4u*)(Zq + (size_t)grow * ldz + hf * 32 + 8 * j);
                x[8 * j + 0] = bf2f(q.x & 0xffffu); x[8 * j + 1] = bf2f(q.x >> 16); x[8 * j + 2] = bf2f(q.y & 0xffffu); x[8 * j + 3] = bf2f(q.y >> 16);
                x[8 * j + 4] = bf2f(q.z & 0xffffu); x[8 * j + 5] = bf2f(q.z >> 16); x[8 * j + 6] = bf2f(q.w & 0xffffu); x[8 * j + 7] = bf2f(q.w >> 16); }
        } else {
#pragma unroll
            for (int j = 0; j < 32; ++j) x[j] = 0.f;
        }
#pragma unroll
        for (int j = 0; j < 32; ++j) s += x[j] * x[j];
        s += __shfl_xor(s, 1);
        const float rs = rsqrtf(s * (1.0f / 64.0f) + EPS) * 0.125f;
#pragma unroll
        for (int j = 0; j < 32; j += 8) { v4u o;
            o.x = pk2(x[j] * rs * qgain[hf * 32 + j], x[j + 1] * rs * qgain[hf * 32 + j + 1]); o.y = pk2(x[j + 2] * rs * qgain[hf * 32 + j + 2], x[j + 3] * rs * qgain[hf * 32 + j + 3]);
            o.z = pk2(x[j + 4] * rs * qgain[hf * 32 + j + 4], x[j + 5] * rs * qgain[hf * 32 + j + 5]); o.w = pk2(x[j + 6] * rs * qgain[hf * 32 + j + 6], x[j + 7] * rs * qgain[hf * 32 + j + 7]);
            *(LAS v4u*)(QN + row * 72 + hf * 32 + j) = o; }
    }
    __syncthreads();
    if (w * 32 < nrows_valid) {
        const int r32 = lane & 31, hh = lane >> 5;
        f32x16 s[8];
#pragma unroll
        for (int mt = 0; mt < 8; ++mt) { f32x16 z = {}; s[mt] = mm32<64>(KN + mt * 32 * 72, 72, QN, 72, z, lane); }
        float mx = -1e30f;
#pragma unroll
        for (int mt = 0; mt < 8; ++mt)
#pragma unroll
            for (int r = 0; r < 16; ++r) mx = fmaxf(mx, s[mt][r]);
        mx = fmaxf(mx, __shfl_xor(mx, 32));
        float l = 0.f;
#pragma unroll
        for (int mt = 0; mt < 8; ++mt)
#pragma unroll
            for (int r = 0; r < 16; ++r) { const float p = __expf(s[mt][r] - mx); s[mt][r] = p; l += p; }
        l += __shfl_xor(l, 32);
        if (hh == 0) LI[r32] = l;
        f32x16 o[2] = {};
#pragma unroll
        for (int mt = 0; mt < 8; ++mt)
#pragma unroll
            for (int sx = 0; sx < 2; ++sx) {
                v4u pa; pa.x = pk2(s[mt][8 * sx + 0], s[mt][8 * sx + 1]); pa.y = pk2(s[mt][8 * sx + 2], s[mt][8 * sx + 3]);
                pa.z = pk2(s[mt][8 * sx + 4], s[mt][8 * sx + 5]); pa.w = pk2(s[mt][8 * sx + 6], s[mt][8 * sx + 7]);
                const bf16x8 af = __builtin_bit_cast(bf16x8, pa);
#pragma unroll
                for (int dt = 0; dt < 2; ++dt) { const LAS bf16* vp = VTm + (dt * 32 + r32) * 264 + mt * 32 + 16 * sx + 4 * hh;
                    const u64 lo = *(const LAS u64*)vp, hi = *(const LAS u64*)(vp + 8);
                    v4u bw; bw.x = (unsigned)lo; bw.y = (unsigned)(lo >> 32); bw.z = (unsigned)hi; bw.w = (unsigned)(hi >> 32);
                    o[dt] = __builtin_amdgcn_mfma_f32_32x32x16_bf16(af, __builtin_bit_cast(bf16x8, bw), o[dt], 0, 0, 0); }
            }
        LDS_WAIT();
#pragma unroll
        for (int r = 0; r < 16; ++r) { const int qr = crow(r, hh), grow = w * 32 + qr; const float il = 1.0f / LI[qr];
            if (grow < nrows_valid) {
#pragma unroll
                for (int dt = 0; dt < 2; ++dt) Out[(size_t)grow * DM + dt * 32 + r32] = (bf16)f2bf(o[dt][r] * il); } }
    }
}

constexpr int HG_GS = 4, HG_NG = SEQ / (32 * HG_GS);
constexpr size_t WS_HOL = WS_U, WS_HQC = WS_UP, WS_HUT = WS_ACT, WS_HST = WS_ACT + 64 * MiB, WS_HDG = WS_ACT + 50 * MiB;
template <bool PROMPT>
__device__ __forceinline__ void hgrn_unit(Ctx& c, const Args& a, int b, int h, int g) {
    LAS unsigned char* L = c.lds;
    LAS float* LF = (LAS float*)(L + 0);
    LAS float* BL = (LAS float*)(L + 16384);
    LAS float* DVv = (LAS float*)(L + 16896);
    LAS bf16* QD = (LAS bf16*)(L + 17408);
    LAS bf16* KD = (LAS bf16*)(L + 26112);
    LAS bf16* KET = (LAS bf16*)(L + 34816);
    LAS bf16* VT = (LAS bf16*)(L + 45056);
    LAS bf16* SCB = (LAS bf16*)(L + 55296);
    LAS bf16* STt = (LAS bf16*)(L + 57856);
    LAS float* BOFF = (LAS float*)(L + 92672);
    int tid = c.tid; asm volatile("" : "+v"(tid));
    const int lane = tid & 63, w = c.wave, r32 = lane & 31, hh = lane >> 5;
    const int te = tid >> 4, k8 = (tid & 15) * 8;
    const bf16* Z = (const bf16*)(a.ws + WS_Z);
    bf16* MIX = (bf16*)(a.ws + WS_MIX);
    const int nch = PROMPT ? HG_GS : 1, nvalid = PROMPT ? 32 : 4;
    const int kt = w >> 1, vt0 = 2 * (w & 1);
    const int unit = (b * 6 + h) * HG_NG + g;
    f32x16 S0 = {}, S1 = {};
    if (!PROMPT) { const float* sp = a.in[7] + (size_t)(b * 6 + h) * 16384;
#pragma unroll
        for (int r = 0; r < 16; ++r) { const int k = 32 * kt + crow(r, hh); S0[r] = sp[k * 128 + 32 * vt0 + r32]; S1[r] = sp[k * 128 + 32 * (vt0 + 1) + r32]; } }
    float lbv[8], onv[8];
#pragma unroll
    for (int j = 0; j < 8; ++j) { const float l0 = a.in[14][h * 128 + k8 + j], l1 = a.in[14][768 + h * 128 + k8 + j]; lbv[j] = 1.0f / (1.0f + __expf(l1 - l0)); onv[j] = a.in[15][k8 + j]; }
    __syncthreads();
    if (tid < 128) BOFF[tid] = 0.f;
#define HG_WRITE_ST() do { _Pragma("unroll") for (int g4 = 0; g4 < 4; ++g4) { const int k0 = 32 * kt + 8 * g4 + 4 * hh; \
        *(LAS u64*)(STt + (32 * vt0 + r32) * 136 + k0) = (u64)pk2(S0[4 * g4], S0[4 * g4 + 1]) | ((u64)pk2(S0[4 * g4 + 2], S0[4 * g4 + 3]) << 32); \
        *(LAS u64*)(STt + (32 * (vt0 + 1) + r32) * 136 + k0) = (u64)pk2(S1[4 * g4], S1[4 * g4 + 1]) | ((u64)pk2(S1[4 * g4 + 2], S1[4 * g4 + 3]) << 32); } } while (0)
    HG_WRITE_ST();
#pragma unroll 1
    for (int ch = 0; ch < nch; ++ch) {
        const int row0 = PROMPT ? b * SEQ + (g * HG_GS + ch) * 32 : MP + 4 * b, row = row0 + te;
        const bool valid = te < nvalid;
        float qs[8], kk[8]; v4u gz = {0u, 0u, 0u, 0u};
        {
            v4u zq = {0u, 0u, 0u, 0u}, zf = zq, zi = zq;
            if (valid) { const bf16* zr = Z + (size_t)row * ZC0 + h * 128 + k8;
                zq = *(const v4u*)zr; zf = *(const v4u*)(zr + 768); zi = *(const v4u*)(zr + 1536); if (!PROMPT) gz = *(const v4u*)(zr + 2304); }
            const unsigned qw[4] = {zq.x, zq.y, zq.z, zq.w}, fw[4] = {zf.x, zf.y, zf.z, zf.w}, iw[4] = {zi.x, zi.y, zi.z, zi.w};
            float lf[8];
#pragma unroll
            for (int j = 0; j < 8; ++j) { const float q = bf2f((qw[j >> 1] >> (16 * (j & 1))) & 0xffffu), fp = bf2f((fw[j >> 1] >> (16 * (j & 1))) & 0xffffu);
                const float sg = sigmoidf_(fp), f = lbv[j] + (1.0f - lbv[j]) * sg;
                qs[j] = valid ? q * sigmoidf_(q) : 0.f; kk[j] = valid ? (1.0f - f) : 0.f; lf[j] = valid ? __logf(f) : 0.f;
                VT[(k8 + j) * 40 + te] = (bf16)((iw[j >> 1] >> (16 * (j & 1))) & 0xffffu); }
            *(LAS f32x4*)(LF + te * 128 + k8) = (f32x4){lf[0], lf[1], lf[2], lf[3]}; *(LAS f32x4*)(LF + te * 128 + k8 + 4) = (f32x4){lf[4], lf[5], lf[6], lf[7]};
        }
        __syncthreads();
        if (tid < 128) { float bsum = 0.f;
#pragma unroll
            for (int t = 0; t < 32; ++t) { bsum += LF[t * 128 + tid]; LF[t * 128 + tid] = bsum; }
            BL[tid] = bsum; }
        __syncthreads();
        {
            const f32x4 b0 = *(const LAS f32x4*)(LF + te * 128 + k8), b1 = *(const LAS f32x4*)(LF + te * 128 + k8 + 4);
            const f32x4 l0 = *(const LAS f32x4*)(BL + k8), l1 = *(const LAS f32x4*)(BL + k8 + 4);
            const float bb[8] = {b0.x, b0.y, b0.z, b0.w, b1.x, b1.y, b1.z, b1.w}, bl[8] = {l0.x, l0.y, l0.z, l0.w, l1.x, l1.y, l1.z, l1.w};
            float qd[8], kd[8];
#pragma unroll
            for (int j = 0; j < 8; ++j) { qd[j] = qs[j] * __expf(bb[j]); kd[j] = kk[j] * __expf(-bb[j]); KET[(k8 + j) * 40 + te] = (bf16)f2bf(kk[j] * __expf(bl[j] - bb[j])); }
            v4u o; o.x = pk2(qd[0], qd[1]); o.y = pk2(qd[2], qd[3]); o.z = pk2(qd[4], qd[5]); o.w = pk2(qd[6], qd[7]); *(LAS v4u*)(QD + te * 136 + k8) = o;
            if (PROMPT) { const f32x4 f0 = *(const LAS f32x4*)(BOFF + k8), f1 = *(const LAS f32x4*)(BOFF + k8 + 4);
                const float bo[8] = {f0.x, f0.y, f0.z, f0.w, f1.x, f1.y, f1.z, f1.w}; float qc[8];
#pragma unroll
                for (int j = 0; j < 8; ++j) qc[j] = qd[j] * __expf(bo[j]);
                v4u oc; oc.x = pk2(qc[0], qc[1]); oc.y = pk2(qc[2], qc[3]); oc.z = pk2(qc[4], qc[5]); oc.w = pk2(qc[6], qc[7]);
                *(v4u*)((bf16*)(a.ws + WS_HQC) + (size_t)row * 768 + h * 128 + k8) = oc; }
            o.x = pk2(kd[0], kd[1]); o.y = pk2(kd[2], kd[3]); o.z = pk2(kd[4], kd[5]); o.w = pk2(kd[6], kd[7]); *(LAS v4u*)(KD + te * 136 + k8) = o;
            if (te == 0) {
#pragma unroll
                for (int j = 0; j < 8; ++j) DVv[k8 + j] = __expf(bl[j]); }
        }
        __syncthreads();
        f32x16 oacc = {};
        if (w == 0) { f32x16 z = {}; const f32x16 sc = mm32<128>(QD, 136, KD, 136, z, lane);
#pragma unroll
            for (int r = 0; r < 16; ++r) { const int t = crow(r, hh); SCB[t * 40 + r32] = (bf16)f2bf(r32 <= t ? sc[r] : 0.f); } }
        if (w < 4) oacc = mm32<128>(QD, 136, STt + (w * 32) * 136, 136, oacc, lane);
        if (PROMPT && tid >= 384) BOFF[tid - 384] += BL[tid - 384];
        __syncthreads();
        if (w < 4) { oacc = mm32<32>(SCB, 40, VT + (w * 32) * 40, 40, oacc, lane);
#pragma unroll
            for (int r = 0; r < 16; ++r) LF[crow(r, hh) * 128 + w * 32 + r32] = oacc[r]; }
        {
#pragma unroll
            for (int r = 0; r < 16; ++r) { const float d = DVv[32 * kt + crow(r, hh)]; S0[r] *= d; S1[r] *= d; }
            S0 = mm32<32>(KET + (kt * 32) * 40, 40, VT + (vt0 * 32) * 40, 40, S0, lane);
            S1 = mm32<32>(KET + (kt * 32) * 40, 40, VT + ((vt0 + 1) * 32) * 40, 40, S1, lane);
        }
        __syncthreads();
        HG_WRITE_ST();
        {
            const f32x4 o0 = *(const LAS f32x4*)(LF + te * 128 + k8), o1 = *(const LAS f32x4*)(LF + te * 128 + k8 + 4);
            if (PROMPT) { float* ol = (float*)(a.ws + WS_HOL) + (size_t)row * 768 + h * 128 + k8; *(f32x4*)ol = o0; *(f32x4*)(ol + 4) = o1; }
            else {
                float ov[8] = {o0.x, o0.y, o0.z, o0.w, o1.x, o1.y, o1.z, o1.w}; float s = 0.f;
#pragma unroll
                for (int j = 0; j < 8; ++j) s += ov[j] * ov[j];
                s += __shfl_xor(s, 1); s += __shfl_xor(s, 2); s += __shfl_xor(s, 4); s += __shfl_xor(s, 8);
                const float rs = rsqrtf(s * (1.0f / 128.0f) + EPS);
                const unsigned gw_[4] = {gz.x, gz.y, gz.z, gz.w}; float y[8];
#pragma unroll
                for (int j = 0; j < 8; ++j) { const float gg = bf2f((gw_[j >> 1] >> (16 * (j & 1))) & 0xffffu); y[j] = ov[j] * rs * onv[j] * (gg * sigmoidf_(gg)); }
                if (valid) { v4u o; o.x = pk2(y[0], y[1]); o.y = pk2(y[2], y[3]); o.z = pk2(y[4], y[5]); o.w = pk2(y[6], y[7]); *(v4u*)(MIX + (size_t)row * DM + h * 128 + k8) = o; }
            }
        }
        __syncthreads();
    }
#undef HG_WRITE_ST
    if (PROMPT) {
        float* ut = (float*)(a.ws + WS_HUT) + (size_t)unit * 16384;
#pragma unroll
        for (int g4 = 0; g4 < 4; ++g4) { const int k0 = 32 * kt + 8 * g4 + 4 * hh;
            *(f32x4*)(ut + (32 * vt0 + r32) * 128 + k0) = (f32x4){S0[4 * g4], S0[4 * g4 + 1], S0[4 * g4 + 2], S0[4 * g4 + 3]};
            *(f32x4*)(ut + (32 * (vt0 + 1) + r32) * 128 + k0) = (f32x4){S1[4 * g4], S1[4 * g4 + 1], S1[4 * g4 + 2], S1[4 * g4 + 3]}; }
        if (tid < 128) ((float*)(a.ws + WS_HDG))[(size_t)unit * 128 + tid] = __expf(BOFF[tid]);
    } else {
        float* so = a.out + O_HS + (size_t)(b * 6 + h) * 16384;
#pragma unroll
        for (int r = 0; r < 16; ++r) { const int k = 32 * kt + crow(r, hh); so[k * 128 + 32 * vt0 + r32] = S0[r]; so[k * 128 + 32 * (vt0 + 1) + r32] = S1[r]; }
    }
}
__device__ __forceinline__ void hgrn_scan(Ctx& c, const Args& a) {
    const float* UT = (const float*)(a.ws + WS_HUT); const float* DG = (const float*)(a.ws + WS_HDG); bf16* STo = (bf16*)(a.ws + WS_HST);
    for (int idx = c.vcu * 512 + c.tid; idx < 24 * 16384; idx += c.G * 512) {
        const int bh = idx >> 14, e = idx & 16383, k = e & 127, v = e >> 7;
        float s = 0.f;
#pragma unroll 8
        for (int g = 0; g < HG_NG; ++g) { const size_t u = (size_t)(bh * HG_NG + g); STo[u * 16384 + e] = (bf16)f2bf(s); s = DG[u * 128 + k] * s + UT[u * 16384 + e]; }
        a.out[O_HP + (size_t)bh * 16384 + k * 128 + v] = s;
    }
}
__device__ __forceinline__ void hgrn_fix_unit(Ctx& c, const Args& a, int b, int h, int g) {
    LAS bf16* STt = (LAS bf16*)(c.lds);
    LAS bf16* QCl = (LAS bf16*)(c.lds + 34816);
    LAS float* OB = (LAS float*)(c.lds + 34816 + 17408);
    int tid = c.tid; asm volatile("" : "+v"(tid));
    const int lane = tid & 63, w = c.wave, r32 = lane & 31, hh = lane >> 5;
    const int unit = (b * 6 + h) * HG_NG + g, row0 = b * SEQ + g * 128;
    const bf16* Z = (const bf16*)(a.ws + WS_Z); bf16* MIX = (bf16*)(a.ws + WS_MIX);
    const bf16* QC = (const bf16*)(a.ws + WS_HQC); const float* OL = (const float*)(a.ws + WS_HOL);
    const bf16* stg = (const bf16*)(a.ws + WS_HST) + (size_t)unit * 16384;
    __syncthreads();
#pragma unroll
    for (int i = 0; i < 4; ++i) { const int cidx = tid + 512 * i, v = cidx >> 4, kc = (cidx & 15) * 8; *(LAS v4u*)(STt + v * 136 + kc) = *(const v4u*)(stg + v * 128 + kc); }
    const int te = tid >> 4, k8 = (tid & 15) * 8;
    float onv[8];
#pragma unroll
    for (int j = 0; j < 8; ++j) onv[j] = a.in[15][k8 + j];
#pragma unroll 1
    for (int hf = 0; hf < 2; ++hf) {
        const int rb = row0 + hf * 64;
#pragma unroll
        for (int i = 0; i < 2; ++i) { const int cidx = tid + 512 * i, r = cidx >> 4, kc = (cidx & 15) * 8; *(LAS v4u*)(QCl + r * 136 + kc) = *(const v4u*)(QC + (size_t)(rb + r) * 768 + h * 128 + kc); }
        __syncthreads();
        { const int rt = w >> 2, vt = w & 3; f32x16 o = {};
          o = mm32<128>(QCl + (rt * 32) * 136, 136, STt + (vt * 32) * 136, 136, o, lane);
#pragma unroll
          for (int r = 0; r < 16; ++r) OB[(rt * 32 + crow(r, hh)) * 128 + vt * 32 + r32] = o[r]; }
        __syncthreads();
#pragma unroll
        for (int ps = 0; ps < 2; ++ps) { const int r = ps * 32 + te, row = rb + r;
            const f32x4 c0 = *(const LAS f32x4*)(OB + r * 128 + k8), c1 = *(const LAS f32x4*)(OB + r * 128 + k8 + 4);
            const float* ol = OL + (size_t)row * 768 + h * 128 + k8; const f32x4 l0 = *(const f32x4*)ol, l1 = *(const f32x4*)(ol + 4);
            const v4u gz = *(const v4u*)(Z + (size_t)row * ZC0 + 2304 + h * 128 + k8);
            float ov[8] = {c0.x + l0.x, c0.y + l0.y, c0.z + l0.z, c0.w + l0.w, c1.x + l1.x, c1.y + l1.y, c1.z + l1.z, c1.w + l1.w}; float s = 0.f;
#pragma unroll
            for (int j = 0; j < 8; ++j) s += ov[j] * ov[j];
            s += __shfl_xor(s, 1); s += __shfl_xor(s, 2); s += __shfl_xor(s, 4); s += __shfl_xor(s, 8);
            const float rs = rsqrtf(s * (1.0f / 128.0f) + EPS);
            const unsigned gw_[4] = {gz.x, gz.y, gz.z, gz.w}; float y[8];
#pragma unroll
            for (int j = 0; j < 8; ++j) { const float gg = bf2f((gw_[j >> 1] >> (16 * (j & 1))) & 0xffffu); y[j] = ov[j] * rs * onv[j] * (gg * sigmoidf_(gg)); }
            v4u o; o.x = pk2(y[0], y[1]); o.y = pk2(y[2], y[3]); o.z = pk2(y[4], y[5]); o.w = pk2(y[6], y[7]); *(v4u*)(MIX + (size_t)row * DM + h * 128 + k8) = o; }
        __syncthreads();
    }
}

__device__ __forceinline__ void memkv_finalize_row(const Args& a, int layer, int row, int lane) {
    const float* src = (const float*)(a.ws + WS_MEMKV) + (size_t)row * 1024 + layer * 512;
    const int hd = lane >> 4, d4 = (lane & 15) * 4;
    const f32x4 k = *(const f32x4*)(src + hd * 64 + d4), v = *(const f32x4*)(src + 256 + hd * 64 + d4);
    float s = (k.x * k.x + k.y * k.y) + (k.z * k.z + k.w * k.w);
    s += __shfl_xor(s, 1); s += __shfl_xor(s, 2); s += __shfl_xor(s, 4); s += __shfl_xor(s, 8);
    const float rs = rsqrtf(s * (1.0f / 64.0f) + EPS); const f32x4 g = *(const f32x4*)(a.in[22] + layer * 64 + d4);
    *(f32x4*)(a.out + O_MK + ((size_t)layer * 1024 + row) * 256 + hd * 64 + d4) = k * rs * g;
    *(f32x4*)(a.out + O_MV + ((size_t)layer * 1024 + row) * 256 + hd * 64 + d4) = v;
}

__device__ __forceinline__ void memattn_prompt_unit(Ctx& c, const Args& a, int layer, int u) {
    const int blk = u & 15, hd = (u >> 4) & 3, b = u >> 6;
    const bf16* Z = (const bf16*)(a.ws + WS_Z); const int ldz = layer ? ZC1 : ZC0, qc = layer ? Z1_MQ : 3072;
    const float* kv = (const float*)(a.ws + WS_MEMKV) + (size_t)(b * 256) * 1024 + layer * 512 + hd * 64;
    const int row0 = b * SEQ + blk * 256;
    memattn_unit(c, Z + (size_t)row0 * ldz + qc + hd * 64, ldz, 256, kv, kv + 256, 1024, true, a.in[22] + layer * 64, a.in[21] + layer * 64,
                 (bf16*)(a.ws + WS_MIX) + (size_t)row0 * DM + 768 + hd * 64);
}
__device__ __forceinline__ void memattn_sample_unit(Ctx& c, const Args& a, int layer, int u) {
    const int hd = u & 3, sb = u >> 2;
    const bf16* Z = (const bf16*)(a.ws + WS_Z); const int ldz = layer ? ZC1 : ZC0, qc = layer ? Z1_MQ : 3072;
    const size_t off = ((size_t)(layer * 32 + sb) * 256) * 256 + hd * 64;
    const int row0 = MP + sb * 4;
    memattn_unit(c, Z + (size_t)row0 * ldz + qc + hd * 64, ldz, 4, a.in[5] + off, a.in[6] + off, 256, false, nullptr, a.in[21] + layer * 64,
                 (bf16*)(a.ws + WS_MIX) + (size_t)row0 * DM + 768 + hd * 64);
}

__device__ __forceinline__ void p2_mixer0(Ctx& c, const Args& a) {
    constexpr int U_HP = 24 * HG_NG, U_MAP = U_HP + 256, U_HS = U_MAP + 192, U_MAS = U_HS + 128, U_FIN = U_MAS + 256;
    for (;;) {
        const int u = q_next(c, 0);
        if (u >= U_FIN) break;
        if (u < U_HP) hgrn_unit<true>(c, a, u / (6 * HG_NG), (u / HG_NG) % 6, u % HG_NG);
        else if (u < U_MAP) memattn_prompt_unit(c, a, 0, u - U_HP);
        else if (u < U_HS) { const int v = u - U_MAP; hgrn_unit<false>(c, a, v / 6, v % 6, 0); }
        else if (u < U_MAS) memattn_sample_unit(c, a, 0, u - U_HS);
        else { const int v = (u - U_MAS) * 8 + c.wave; memkv_finalize_row(a, v >> 10, v & 1023, c.lane); }
    }
}
__device__ __forceinline__ void p2c_hgrn_fix(Ctx& c, const Args& a) {
    for (int u = c.vcu; u < 24 * HG_NG; u += c.G) hgrn_fix_unit(c, a, u / (6 * HG_NG), (u / HG_NG) % 6, u % HG_NG);
}

__device__ __forceinline__ void p5_convact(Ctx& c, const Args& a, int layer) {
    const bf16* U = (const bf16*)(a.ws + WS_U); const bf16* UP = (const bf16*)(a.ws + WS_UP); bf16* ACT = (bf16*)(a.ws + WS_ACT);
    const float* cw = a.in[26] + (size_t)layer * 3 * DFF; const float* cb = a.in[27] + (size_t)layer * DFF; const float* cst = a.in[8] + (size_t)layer * 32 * 2 * DFF;
    constexpr int CPR = DFF / 8, NG = MVALID / 4;
    const int total = NG * CPR;
#pragma unroll 1
    for (int i = c.vcu * 512 + c.tid; i < total; i += c.G * 512) {
        const int g = i / CPR, c8 = (i - g * CPR) * 8, r0 = g * 4;
        const bool smp = r0 >= MP; const bool first = smp || (r0 & 4095) == 0;
        const int rm2 = first ? r0 : r0 - 2, rm1 = first ? r0 : r0 - 1;
        v4u ur[6], pr[4];
        ur[0] = *(const v4u*)(U + (size_t)rm2 * DFF + c8); ur[1] = *(const v4u*)(U + (size_t)rm1 * DFF + c8);
#pragma unroll
        for (int k = 0; k < 4; ++k) { ur[2 + k] = *(const v4u*)(U + (size_t)(r0 + k) * DFF + c8); pr[k] = *(const v4u*)(UP + (size_t)(r0 + k) * DFF + c8); }
        const f32x4 w0a = *(const f32x4*)(cw + c8), w0b = *(const f32x4*)(cw + c8 + 4), w1a = *(const f32x4*)(cw + DFF + c8), w1b = *(const f32x4*)(cw + DFF + c8 + 4),
                    w2a = *(const f32x4*)(cw + 2 * DFF + c8), w2b = *(const f32x4*)(cw + 2 * DFF + c8 + 4), cba = *(const f32x4*)(cb + c8), cbb = *(const f32x4*)(cb + c8 + 4);
        const float w0[8] = {w0a.x, w0a.y, w0a.z, w0a.w, w0b.x, w0b.y, w0b.z, w0b.w}, w1[8] = {w1a.x, w1a.y, w1a.z, w1a.w, w1b.x, w1b.y, w1b.z, w1b.w},
                    w2[8] = {w2a.x, w2a.y, w2a.z, w2a.w, w2b.x, w2b.y, w2b.z, w2b.w}, bb[8] = {cba.x, cba.y, cba.z, cba.w, cbb.x, cbb.y, cbb.z, cbb.w};
        float uf[6][8];
#pragma unroll
        for (int k = 0; k < 6; ++k) { const unsigned xw[4] = {ur[k].x, ur[k].y, ur[k].z, ur[k].w};
#pragma unroll
            for (int j = 0; j < 8; ++j) uf[k][j] = bf2f((xw[j >> 1] >> (16 * (j & 1))) & 0xffffu); }
        if (first) {
            if (smp) { const float* s0 = cst + (size_t)(((r0 - MP) >> 2) * 2) * DFF + c8;
#pragma unroll
                for (int j = 0; j < 8; ++j) { uf[0][j] = s0[j]; uf[1][j] = s0[DFF + j]; } }
            else {
#pragma unroll
                for (int j = 0; j < 8; ++j) { uf[0][j] = 0.f; uf[1][j] = 0.f; } }
        }
#pragma unroll
        for (int k = 0; k < 4; ++k) { const unsigned pw[4] = {pr[k].x, pr[k].y, pr[k].z, pr[k].w}; float y[8];
#pragma unroll
            for (int j = 0; j < 8; ++j) { const float cv = bb[j] + w0[j] * uf[k][j] + w1[j] * uf[k + 1][j] + w2[j] * uf[k + 2][j]; y[j] = cv * sigmoidf_(cv) * bf2f((pw[j >> 1] >> (16 * (j & 1))) & 0xffffu); }
            v4u o; o.x = pk2(y[0], y[1]); o.y = pk2(y[2], y[3]); o.z = pk2(y[4], y[5]); o.w = pk2(y[6], y[7]);
            *(v4u*)(ACT + (size_t)(r0 + k) * DFF + c8) = o; }
    }
    for (int i = c.vcu * 512 + c.tid; i < (MT - MVALID) * CPR; i += c.G * 512)
        *(v4u*)(ACT + (size_t)(MVALID + i / CPR) * DFF + (i % CPR) * 8) = (v4u){0u, 0u, 0u, 0u};
}


__device__ __forceinline__ void dsa_post_row(const Args& a, int row, int lane) {
    const bf16* z = (const bf16*)(a.ws + WS_Z) + (size_t)row * ZC1;
    const bool smp = row >= MP; const int b = smp ? (row - MP) >> 2 : row >> 12, t = smp ? (row - MP) & 3 : row & 4095;
    const float pos = (float)(smp ? PAST + t : t);
    float c128, s128, c64, s64;
    { const float f1 = exp2f(-(float)lane * (13.287712379549449f / 64.0f)); sincosf(pos * f1, &s128, &c128);
      const float f2 = exp2f(-(float)(lane & 31) * (13.287712379549449f / 32.0f)); sincosf(pos * f2, &s64, &c64); }
#pragma unroll 1
    for (int hd = 0; hd < 8; ++hd) {
        const float x1 = bf2f(z[hd * 128 + lane]), x2 = bf2f(z[hd * 128 + 64 + lane]);
        const float rs = rsqrtf(wave_sum(x1 * x1 + x2 * x2) * (1.0f / 128.0f) + EPS);
        const float* gn = hd < 6 ? a.in[17] : a.in[18];
        const float y1 = x1 * rs * gn[lane], y2 = x2 * rs * gn[64 + lane];
        const float o1 = y1 * c128 - y2 * s128, o2 = y2 * c128 + y1 * s128;
        if (hd < 6) {
            if (smp) { float* q = (float*)(a.ws + WS_SQ) + (size_t)(row - MP) * 768 + hd * 128; q[lane] = o1; q[64 + lane] = o2; }
            else { bf16* q = (bf16*)(a.ws + WS_QB) + ((size_t)(b * 6 + hd) * SEQ + t) * 128; q[lane] = (bf16)f2bf(o1); q[64 + lane] = (bf16)f2bf(o2); }
        } else {
            const int kvh = hd - 6;
            float* ko = smp ? a.out + O_KS + (size_t)(row - MP) * 256 + kvh * 128 : a.out + O_KP + (size_t)row * 256 + kvh * 128;
            ko[lane] = o1; ko[64 + lane] = o2;
            if (!smp) { bf16* kb = (bf16*)(a.ws + WS_KB) + ((size_t)(b * 2 + kvh) * SEQ + t) * 128; kb[lane] = (bf16)f2bf(o1); kb[64 + lane] = (bf16)f2bf(o2); }
        }
    }
    {
        const u64 vv = *(const u64*)(z + Z1_V + 4 * lane);
        const f32x4 v = {bf2f((unsigned)vv & 0xffffu), bf2f(((unsigned)vv) >> 16), bf2f((unsigned)(vv >> 32) & 0xffffu), bf2f((unsigned)(vv >> 48))};
        float* vo = smp ? a.out + O_VS + (size_t)(row - MP) * 256 : a.out + O_VP + (size_t)row * 256;
        *(f32x4*)(vo + 4 * lane) = v;
        if (!smp) { const int kvh = lane >> 5, d = (lane & 31) * 4; *(u64*)((bf16*)(a.ws + WS_VB) + ((size_t)(b * 2 + kvh) * SEQ + t) * 128 + d) = vv; }
    }
    {
        const int i = lane & 31;
#pragma unroll
        for (int p = 0; p < 4; ++p) { const int hd = 2 * p + (lane >> 5);
            const float x1 = bf2f(z[Z1_IQ + hd * 64 + i]), x2 = bf2f(z[Z1_IQ + hd * 64 + 32 + i]);
            const float o1 = x1 * c64 - x2 * s64, o2 = x2 * c64 + x1 * s64;
            if (smp) { float* q = (float*)(a.ws + WS_SIQ) + (size_t)(row - MP) * 512 + hd * 64; q[i] = o1; q[32 + i] = o2; }
            else { bf16* q = (bf16*)(a.ws + WS_IQB) + (size_t)row * 512 + hd * 64; q[i] = (bf16)f2bf(o1); q[32 + i] = (bf16)f2bf(o2); } }
        float x1 = 0.f, x2 = 0.f; if (lane < 32) { x1 = bf2f(z[Z1_IK + i]); x2 = bf2f(z[Z1_IK + 32 + i]); }
        const float rs = rsqrtf(wave_sum(x1 * x1 + x2 * x2) * (1.0f / 64.0f) + EPS);
        const float y1 = x1 * rs * a.in[19][i], y2 = x2 * rs * a.in[19][32 + i];
        const float o1 = y1 * c64 - y2 * s64, o2 = y2 * c64 + y1 * s64;
        if (lane < 32) {
            float* ko = smp ? a.out + O_IKS + (size_t)(row - MP) * 64 : a.out + O_IKP + (size_t)row * 64; ko[i] = o1; ko[32 + i] = o2;
            if (!smp) { bf16* kb = (bf16*)(a.ws + WS_IKB) + (size_t)row * 64; kb[i] = (bf16)f2bf(o1); kb[32 + i] = (bf16)f2bf(o2); } }
        if (lane < 8) { const float wv = bf2f(z[Z1_IW + lane]) * (0.35355339059327373f * 0.125f);
            if (smp) ((float*)(a.ws + WS_SIW))[(row - MP) * 8 + lane] = wv; else ((float*)(a.ws + WS_IW))[(size_t)row * 8 + lane] = wv; }
    }
}
__device__ __forceinline__ void p8_dsa_post(Ctx& c, const Args& a) {
    for (;;) { const int u = q_next(c, 1); if (u >= 384) break; if (u < 256) memattn_prompt_unit(c, a, 1, u); else memattn_sample_unit(c, a, 1, u - 256); }
    const int gw = c.vcu * NWAVES + c.wave, NGW = c.G * NWAVES;
    for (int row = gw; row < MVALID; row += NGW) dsa_post_row(a, row, c.lane);
}

__device__ __forceinline__ void idx_prompt_unit(Ctx& c, const Args& a, int b, int qb) {
    int tid = c.tid; asm volatile("" : "+v"(tid));
    const int lane = tid & 63, r32 = lane & 31, hh = lane >> 5, w = c.wave;
    const int q0 = b * SEQ + qb * 32;
    LAS bf16* IQL = (LAS bf16*)(c.lds);
    { const bf16* src = (const bf16*)(a.ws + WS_IQB) + (size_t)q0 * 512;
#pragma unroll
      for (int i = 0; i < 4; ++i) { const int row = tid >> 4, ch = (tid & 15) + 16 * i; *(LAS v4u*)(IQL + row * 520 + ch * 8) = *(const v4u*)(src + (size_t)row * 512 + ch * 8); } }
    __syncthreads();
    const bf16* IK = (const bf16*)(a.ws + WS_IKB) + (size_t)(b * SEQ) * 64;
    float* SC = (float*)(a.ws + WS_SC) + (size_t)(q0 + r32) * SEQ;
    float wv[8];
#pragma unroll
    for (int h = 0; h < 8; ++h) wv[h] = ((const float*)(a.ws + WS_IW))[(size_t)(q0 + r32) * 8 + h];
#pragma unroll 1
    for (int kt = w; kt <= qb; kt += 8) {
        bf16x8 ak[4];
#pragma unroll
        for (int ks = 0; ks < 4; ++ks) ak[ks] = *(const bf16x8*)(IK + (size_t)(kt * 32 + r32) * 64 + ks * 16 + 8 * hh);
        f32x16 sc = {};
        int qoff = r32 * 520 + 8 * hh; asm volatile("" : "+v"(qoff));
#pragma unroll
        for (int h = 0; h < 8; ++h) { f32x16 d = {};
#pragma unroll
            for (int ks = 0; ks < 4; ++ks) d = __builtin_amdgcn_mfma_f32_32x32x16_bf16(ak[ks], *(const LAS bf16x8*)(IQL + qoff + h * 64 + ks * 16), d, 0, 0, 0);
#pragma unroll
            for (int r = 0; r < 16; ++r) sc[r] = fmaf(wv[h], fmaxf(d[r], 0.f), sc[r]); }
#pragma unroll
        for (int g = 0; g < 4; ++g) *(f32x4*)(SC + kt * 32 + 8 * g + 4 * hh) = (f32x4){sc[4 * g], sc[4 * g + 1], sc[4 * g + 2], sc[4 * g + 3]};
    }
}
__device__ __forceinline__ void idx_sample_unit(Ctx& c, const Args& a, int sb, int pg) {
    LAS float* IKL = (LAS float*)(c.lds);
    LAS float* IQL = (LAS float*)(c.lds + 33280);
    LAS float* WL = (LAS float*)(c.lds + 33280 + 8192);
    int tid = c.tid; asm volatile("" : "+v"(tid));
    const int nk = pg < 64 ? 128 : 4;
    const float* src = pg < 64 ? a.in[4] + ((size_t)a.page_table[sb * 64 + pg] * 128) * 64 : a.out + O_IKS + (size_t)(sb * 4) * 64;
    for (int i = tid; i < nk * 16; i += 512) { const f32x4 v = *(const f32x4*)(src + (size_t)i * 4); const int k = i >> 4, d = (i & 15) * 4;
        IKL[k * 65 + d] = v.x; IKL[k * 65 + d + 1] = v.y; IKL[k * 65 + d + 2] = v.z; IKL[k * 65 + d + 3] = v.w; }
    for (int i = tid; i < 2048; i += 512) IQL[i] = ((const float*)(a.ws + WS_SIQ))[(size_t)(sb * 4) * 512 + i];
    if (tid < 32) WL[tid] = ((const float*)(a.ws + WS_SIW))[sb * 32 + tid];
    __syncthreads();
    const int k = tid & 127, t = tid >> 7;
    if (k < nk) {
        float acc = 0.f;
#pragma unroll 1
        for (int h = 0; h < 8; ++h) { float d = 0.f;
#pragma unroll 16
            for (int e = 0; e < 64; ++e) d = fmaf(IQL[(t * 8 + h) * 64 + e], IKL[k * 65 + e], d);
            acc = fmaf(WL[t * 8 + h], fmaxf(d, 0.f), acc); }
        ((float*)(a.ws + WS_SSC))[(size_t)(sb * 4 + t) * SSC_LD + pg * 128 + k] = acc;
    }
}
__device__ __forceinline__ void p9_indexer(Ctx& c, const Args& a) {
    constexpr int U_P = 512, U_S = U_P + 32 * 65;
    for (;;) { const int u = q_next(c, 2); if (u >= U_S) break;
        if (u < U_P) idx_prompt_unit(c, a, u & 3, 127 - (u >> 2));
        else { const int v = u - U_P; idx_sample_unit(c, a, v / 65, v % 65); } }
}


__device__ __forceinline__ unsigned fkey(float f) { const unsigned u = __builtin_bit_cast(unsigned, f + 0.0f); return (u & 0x80000000u) ? ~u : (u | 0x80000000u); }
__device__ __forceinline__ void acc_ge(int& cnt, unsigned key, unsigned cand) { asm volatile("v_cmp_le_u32_e32 vcc, %1, %2\n\tv_addc_co_u32_e32 %0, vcc, 0, %0, vcc" : "+v"(cnt) : "s"(cand), "v"(key) : "vcc"); }
__device__ __forceinline__ u64 ballot_nz(unsigned v) { u64 m; asm volatile("v_cmp_ne_u32_e64 %0, 0, %1" : "=s"(m) : "v"(v)); return m; }
__device__ __forceinline__ int wave_sum_dpp(int x) {
    x += __builtin_amdgcn_update_dpp(0, x, 0xB1, 0xF, 0xF, false);
    x += __builtin_amdgcn_update_dpp(0, x, 0x4E, 0xF, 0xF, false);
    x += __builtin_amdgcn_update_dpp(0, x, 0x141, 0xF, 0xF, false);
    x += __builtin_amdgcn_update_dpp(0, x, 0x140, 0xF, 0xF, false);
    return (__builtin_amdgcn_readlane(x, 0) + __builtin_amdgcn_readlane(x, 16)) + (__builtin_amdgcn_readlane(x, 32) + __builtin_amdgcn_readlane(x, 48));
}
__device__ __forceinline__ int mbcnt64(u64 m) { return (int)__builtin_amdgcn_mbcnt_hi((unsigned)(m >> 32), __builtin_amdgcn_mbcnt_lo((unsigned)m, 0u)); }
constexpr int TK_LOWBITS = 18;
__device__ __forceinline__ void topk_finish(unsigned ck, int cp, int A, int posmax, unsigned& T, int& P) {
#pragma unroll 1
    for (int bit = TK_LOWBITS - 1; bit >= 0; --bit) { const unsigned cand = T | (1u << bit); if (A + __builtin_popcountll(__ballot(ck >= cand)) >= 256) T = cand; }
    const int need = 256 - (A + __builtin_popcountll(__ballot(ck > T))), ceq = __builtin_popcountll(__ballot(ck == T));
    P = posmax;
    if (ceq != need) { P = 0;
#pragma unroll 1
        for (int bit = 13; bit >= 0; --bit) { const int cand = P | (1 << bit); if (__builtin_popcountll(__ballot(ck == T && cp < cand)) < need) P = cand; } }
}
__device__ __forceinline__ void topk_prompt_row(const Args& a, int row, int lane_, LAS unsigned* cl  ) {
    int lane = lane_; asm volatile("" : "+v"(lane));
    const int t = row & 4095; const float* sc = (const float*)(a.ws + WS_SC) + (size_t)row * SEQ;
    u64* mk = (u64*)(a.ws + WS_MASK) + (size_t)row * 64;
    u64 myword = 0ull;
    if (t < 256) {
#pragma unroll 1
        for (int j = 0; j < 64; ++j) { const u64 m = __ballot(64 * j + lane <= t); if (lane == j) myword = m; }
        mk[lane] = myword; return; }
    unsigned key[64];
#pragma unroll
    for (int j = 0; j < 64; ++j) { const float v = sc[64 * j + lane]; key[j] = (64 * j + lane <= t) ? fkey(v) : 0u; }
#define TK_FULLCOUNT(CAND, OUT) do { const unsigned cs_ = __builtin_amdgcn_readfirstlane(CAND); int cnt_ = 0; _Pragma("unroll") for (int j = 0; j < 64; ++j) acc_ge(cnt_, key[j], cs_); OUT = wave_sum_dpp(cnt_); } while (0)
    unsigned T = 0u;
#pragma unroll 1
    for (int bit = 31; bit >= TK_LOWBITS; --bit) { const unsigned cand = T | (1u << bit); int tot; TK_FULLCOUNT(cand, tot); if (tot >= 256) T = cand; }
    const unsigned hib = T + (1u << TK_LOWBITS);
    int A = 0, cT; if (hib != 0u) TK_FULLCOUNT(hib, A); TK_FULLCOUNT(T, cT);
    int P;
    if (cT - A <= 64) {
        int base = 0;
#pragma unroll
        for (int j = 0; j < 64; ++j) { const unsigned und = (key[j] - T) < (1u << TK_LOWBITS) ? 1u : 0u; const u64 m = ballot_nz(und); const int pos = base + mbcnt64(m);
            if (und) { cl[pos] = key[j]; cl[64 + pos] = (unsigned)(64 * j + lane); }
            base += __builtin_popcountll(m); asm volatile("" : "+s"(base)); }
        const unsigned ck = lane < base ? cl[lane] : 0u; const int cp = (int)cl[64 + lane];
        topk_finish(ck, cp, A, 4095, T, P);
    } else {
#pragma unroll 1
        for (int bit = TK_LOWBITS - 1; bit >= 0; --bit) { const unsigned cand = T | (1u << bit); int tot; TK_FULLCOUNT(cand, tot); if (tot >= 256) T = cand; }
        int cge, cgt; TK_FULLCOUNT(T, cge); cgt = 0; if (T != 0xffffffffu) TK_FULLCOUNT(T + 1u, cgt);
        const int need = 256 - cgt, ceq = cge - cgt; P = 4095;
        if (ceq != need) { P = 0;
#pragma unroll 1
            for (int bit = 11; bit >= 0; --bit) { const int cand = P | (1 << bit); int cnt = 0;
#pragma unroll
                for (int j = 0; j < 64; ++j) cnt += (key[j] == T && 64 * j + lane < cand) ? 1 : 0;
                if (wave_sum_dpp(cnt) < need) P = cand; } }
    }
#undef TK_FULLCOUNT
#pragma unroll
    for (int j = 0; j < 64; ++j) { const unsigned selv = (key[j] > T || (key[j] == T && 64 * j + lane <= P)) ? 1u : 0u; const u64 m = ballot_nz(selv); if (lane == j) myword = m; asm volatile("" : "+v"(myword)); }
    mk[lane] = myword;
}
__device__ __forceinline__ void topk_sample_row(const Args& a, int q, int lane_, LAS unsigned* K, LAS unsigned* cl) {
    int lane = lane_; asm volatile("" : "+v"(lane));
    const int t = q & 3, n = PAST + t + 1; const float* sc = (const float*)(a.ws + WS_SSC) + (size_t)q * SSC_LD;
    int* out = (int*)(a.ws + WS_SIDX) + q * 256;
    unsigned key[129];
#pragma unroll
    for (int j = 0; j < 129; ++j) { const float v = sc[64 * j + lane]; key[j] = (64 * j + lane < n) ? fkey(v) : 0u; }
#pragma unroll
    for (int j = 0; j < 129; ++j) K[64 * j + lane] = key[j];
#define TK_FULLCOUNT(CAND, OUT) do { const unsigned cs_ = __builtin_amdgcn_readfirstlane(CAND); int cnt_ = 0; _Pragma("unroll") for (int j = 0; j < 129; ++j) acc_ge(cnt_, key[j], cs_); OUT = wave_sum_dpp(cnt_); } while (0)
    unsigned T = 0u;
#pragma unroll 1
    for (int bit = 31; bit >= TK_LOWBITS; --bit) { const unsigned cand = T | (1u << bit); int tot; TK_FULLCOUNT(cand, tot); if (tot >= 256) T = cand; }
    const unsigned hib = T + (1u << TK_LOWBITS);
    int A = 0, cT; if (hib != 0u) TK_FULLCOUNT(hib, A); TK_FULLCOUNT(T, cT);
    int P;
    if (cT - A <= 64) {
        int base = 0;
#pragma unroll 1
        for (int j0 = 0; j0 < 128; j0 += 8) { unsigned kk[8];
#pragma unroll
            for (int i = 0; i < 8; ++i) kk[i] = K[64 * (j0 + i) + lane];
#pragma unroll
            for (int i = 0; i < 8; ++i) { const unsigned und = (kk[i] - T) < (1u << TK_LOWBITS) ? 1u : 0u; const u64 m = ballot_nz(und); const int pos = base + mbcnt64(m);
                if (und) { cl[pos] = kk[i]; cl[64 + pos] = (unsigned)(64 * (j0 + i) + lane); }
                base += __builtin_popcountll(m); } }
        { const unsigned kj = K[64 * 128 + lane]; const unsigned und = (kj - T) < (1u << TK_LOWBITS) ? 1u : 0u; const u64 m = ballot_nz(und); const int pos = base + mbcnt64(m);
          if (und) { cl[pos] = kj; cl[64 + pos] = (unsigned)(64 * 128 + lane); } base += __builtin_popcountll(m); }
        const unsigned ck = lane < base ? cl[lane] : 0u; const int cp = (int)cl[64 + lane];
        topk_finish(ck, cp, A, 16383, T, P);
    } else {
#pragma unroll 1
        for (int bit = TK_LOWBITS - 1; bit >= 0; --bit) { const unsigned cand = T | (1u << bit); int tot; TK_FULLCOUNT(cand, tot); if (tot >= 256) T = cand; }
        int cge, cgt; TK_FULLCOUNT(T, cge); cgt = 0; if (T != 0xffffffffu) TK_FULLCOUNT(T + 1u, cgt);
        const int need = 256 - cgt, ceq = cge - cgt; P = 16383;
        if (ceq != need) { P = 0;
#pragma unroll 1
            for (int bit = 13; bit >= 0; --bit) { const int cand = P | (1 << bit); int cnt = 0;
#pragma unroll 4
                for (int j = 0; j < 129; ++j) cnt += (K[64 * j + lane] == T && 64 * j + lane < cand) ? 1 : 0;
                if (wave_sum_dpp(cnt) < need) P = cand; } }
    }
#undef TK_FULLCOUNT
    int base = 0;
#pragma unroll 1
    for (int j0 = 0; j0 < 136; j0 += 8) { unsigned kk[8];
#pragma unroll
        for (int i = 0; i < 8; ++i) kk[i] = (j0 + i < 129) ? K[64 * (j0 + i) + lane] : 0u;
#pragma unroll
        for (int i = 0; i < 8; ++i) { const int ps = 64 * (j0 + i) + lane; const unsigned selv = (kk[i] > T || (kk[i] == T && ps <= P)) ? 1u : 0u; const u64 m = ballot_nz(selv);
            const int pos = base + mbcnt64(m);
            if (selv && pos < 256) out[pos] = ps;
            base += __builtin_popcountll(m); } }
}
__device__ __forceinline__ void p10_topk(Ctx& c, const Args& a) {
    const int gw = c.vcu * NWAVES + c.wave, NGW = c.G * NWAVES;
    LAS unsigned* cl = (LAS unsigned*)(c.lds) + c.wave * 128;
    if (c.wave == 0 && c.vcu < MS) topk_sample_row(a, c.vcu, c.lane, (LAS unsigned*)(c.lds + 4096), cl);
    for (int row = gw; row < MP; row += NGW) topk_prompt_row(a, row, c.lane, cl);
}


__device__ __forceinline__ void attn_sample_unit(Ctx& c, const Args& a, int sb, int t) {
    LAS bf16* KV = (LAS bf16*)(c.lds);
    LAS float* QL = (LAS float*)(c.lds + 69632);
    LAS float* SL = (LAS float*)(c.lds + 69632 + 3072);
    LAS float* OL = (LAS float*)(c.lds + 69632 + 6144);
    LAS int* IL = (LAS int*)(c.lds + 69632 + 12288);
    int tid = c.tid; asm volatile("" : "+v"(tid));
    const int lane = tid & 63, w = c.wave, q = sb * 4 + t;
    __syncthreads();
    if (tid < 256) IL[tid] = ((const int*)(a.ws + WS_SIDX))[q * 256 + tid];
    for (int i = tid; i < 768; i += 512) QL[i] = ((const float*)(a.ws + WS_SQ))[(size_t)q * 768 + i];
    __syncthreads();
    bf16* MIX = (bf16*)(a.ws + WS_MIX) + (size_t)(MP + q) * DM;
#pragma unroll 1
    for (int kvh = 0; kvh < 2; ++kvh) {
#pragma unroll 1
        for (int pass = 0; pass < 2; ++pass) {
            const float* pool = pass ? a.in[3] : a.in[2]; const float* nw = a.out + (pass ? O_VS : O_KS);
            for (int i = tid >> 5; i < 256; i += 16) { const int idx = IL[i]; const float* src;
                if (idx < PAST) src = pool + (((size_t)a.page_table[sb * 64 + (idx >> 7)] * 128 + (idx & 127)) * 2 + kvh) * 128;
                else src = nw + (size_t)(sb * 4 + (idx - PAST)) * 256 + kvh * 128;
                const f32x4 v = *(const f32x4*)(src + (tid & 31) * 4);
                *(LAS u64*)(KV + i * 136 + (tid & 31) * 4) = (u64)pk2(v.x, v.y) | ((u64)pk2(v.z, v.w) << 32); }
            __syncthreads();
            if (pass == 0) {
                const int i = tid >> 1, dh = (tid & 1) * 64; float s0 = 0.f, s1 = 0.f, s2 = 0.f;
#pragma unroll 8
                for (int d = 0; d < 64; ++d) { const float kx = bf2f(KV[i * 136 + dh + d]);
                    s0 = fmaf(QL[(3 * kvh + 0) * 128 + dh + d], kx, s0); s1 = fmaf(QL[(3 * kvh + 1) * 128 + dh + d], kx, s1); s2 = fmaf(QL[(3 * kvh + 2) * 128 + dh + d], kx, s2); }
                s0 += __shfl_xor(s0, 1); s1 += __shfl_xor(s1, 1); s2 += __shfl_xor(s2, 1);
                if ((tid & 1) == 0) { SL[i] = s0 * 0.08838834764831845f; SL[256 + i] = s1 * 0.08838834764831845f; SL[512 + i] = s2 * 0.08838834764831845f; }
                __syncthreads();
                if (w < 3) { float v[4], mx = -1e30f;
#pragma unroll
                    for (int j = 0; j < 4; ++j) { v[j] = SL[w * 256 + 64 * j + lane]; mx = fmaxf(mx, v[j]); }
#pragma unroll
                    for (int o = 1; o < 64; o <<= 1) mx = fmaxf(mx, __shfl_xor(mx, o));
                    float l = 0.f;
#pragma unroll
                    for (int j = 0; j < 4; ++j) { v[j] = __expf(v[j] - mx); l += v[j]; }
                    l = wave_sum(l); const float il = 1.0f / l;
#pragma unroll
                    for (int j = 0; j < 4; ++j) SL[w * 256 + 64 * j + lane] = v[j] * il; }
                __syncthreads();
            } else {
                const int d = tid & 127, part = tid >> 7; float o0 = 0.f, o1 = 0.f, o2 = 0.f;
#pragma unroll 8
                for (int i = part * 64; i < part * 64 + 64; ++i) { const float vx = bf2f(KV[i * 136 + d]); o0 = fmaf(SL[i], vx, o0); o1 = fmaf(SL[256 + i], vx, o1); o2 = fmaf(SL[512 + i], vx, o2); }
                OL[(part * 3 + 0) * 128 + d] = o0; OL[(part * 3 + 1) * 128 + d] = o1; OL[(part * 3 + 2) * 128 + d] = o2;
                __syncthreads();
                if (tid < 384) { const int hq = tid >> 7, dd = tid & 127; const float o = (OL[hq * 128 + dd] + OL[(3 + hq) * 128 + dd]) + (OL[(6 + hq) * 128 + dd] + OL[(9 + hq) * 128 + dd]);
                    MIX[(3 * kvh + hq) * 128 + dd] = (bf16)f2bf(o); }
                __syncthreads();
            }
        }
    }
}


namespace attn {
using bf16 = unsigned short;
typedef short bf16x8 __attribute__((ext_vector_type(8)));
typedef short s16x4 __attribute__((ext_vector_type(4)));
typedef float f32x16 __attribute__((ext_vector_type(16)));
typedef float f32x4 __attribute__((ext_vector_type(4)));
typedef unsigned u32x4 __attribute__((ext_vector_type(4)));
typedef unsigned u32x2 __attribute__((ext_vector_type(2)));
constexpr int D = 128, OS = 1024;
constexpr float THR = 8.f;
constexpr float SCALE = 0.08838834764831845f;
constexpr int NW = 8, QBLK = 32, KVBLK = 64, QB = NW * QBLK;
constexpr int SHM_V = KVBLK * D * 2, SHM_K = KVBLK * D * 2;
constexpr int LDS_BYTES = 2 * SHM_V + 2 * SHM_K + NW * 64 * 4;

#define KSWZ(row, colB) ((row) * 256 + ((colB) ^ (((row) & 7) << 4)))
#define SBAR() __builtin_amdgcn_sched_barrier(0)
__device__ __forceinline__ int v_st(int k, int c) { const int kk = (k & ~0xC) | ((k & 4) << 1) | ((k & 8) >> 1); return ((kk >> 3) * 4 + (c >> 5)) * 512 + ((kk & 7) * 32 + (c & 31)) * 2; }
__device__ __forceinline__ int v_rd_base(int lane) { return ((lane & 3) << 3) | (((lane >> 2) & 3) << 6) | (((lane >> 4) & 1) << 5) | (((lane >> 5) & 1) << 8); }
constexpr int v_rd_off(int d0, int ks, int half) { return d0 * 512 + ks * 4096 + half * 2048; }
__device__ __forceinline__ int crow(int r, int hi) { return (r & 3) + 8 * (r >> 2) + 4 * hi; }
__device__ __forceinline__ unsigned cvtpk(float lo, float hi) {
    unsigned r; asm volatile("v_cvt_pk_bf16_f32 %0, %1, %2" : "=v"(r) : "v"(lo), "v"(hi)); return r;
}
__device__ __forceinline__ bf16x8 pack8(f32x4 a, f32x4 b) {
    u32x4 w = {cvtpk(a[0], a[1]), cvtpk(a[2], a[3]), cvtpk(b[0], b[1]), cvtpk(b[2], b[3])};
    return *reinterpret_cast<bf16x8*>(&w);
}

__device__ __forceinline__ void partialSM(f32x16& p0, f32x16& p1, float& m_reg, float& mn, float& alpha) {
    float pmax = p0[0]; for (int r = 1; r < 16; ++r) pmax = fmaxf(pmax, p0[r]); for (int r = 0; r < 16; ++r) pmax = fmaxf(pmax, p1[r]);
    { auto rr = __builtin_amdgcn_permlane32_swap(__float_as_uint(pmax), __float_as_uint(pmax), false, false);
      pmax = fmaxf(__uint_as_float(rr[0]), __uint_as_float(rr[1])); }
    constexpr float C2 = 1.4426950408889634f * SCALE;
    if (__builtin_expect(__all((pmax - m_reg) * SCALE <= THR), 1)) { mn = m_reg; alpha = 1.f; }
    else { mn = fmaxf(m_reg, pmax); alpha = __builtin_amdgcn_exp2f((m_reg - mn) * C2); m_reg = mn; }
    const float mnL = -mn * C2;
    for (int r = 0; r < 16; ++r) p0[r] = fmaf(p0[r], C2, mnL); for (int r = 0; r < 16; ++r) p1[r] = fmaf(p1[r], C2, mnL);
    for (int r = 0; r < 16; ++r) p0[r] = __builtin_amdgcn_exp2f(p0[r]);
}
__device__ __forceinline__ void finishSM(f32x16& p0, f32x16& p1, float alpha, float& l_reg, bf16x8& pa0, bf16x8& pa1, bf16x8& pa2, bf16x8& pa3) {
    for (int r = 0; r < 16; ++r) p1[r] = __builtin_amdgcn_exp2f(p1[r]);
    float ps = 0; for (int r = 0; r < 16; ++r) ps += p0[r]; for (int r = 0; r < 16; ++r) ps += p1[r];
    { auto rr = __builtin_amdgcn_permlane32_swap(__float_as_uint(ps), __float_as_uint(ps), false, false);
      ps = __uint_as_float(rr[0]) + __uint_as_float(rr[1]); }
    l_reg = l_reg * alpha + ps;
#define PK4(P, B_, OUT) do { unsigned a0 = cvtpk(P[B_+0], P[B_+1]), a1 = cvtpk(P[B_+2], P[B_+3]);                          \
        unsigned b0 = cvtpk(P[B_+4], P[B_+5]), b1 = cvtpk(P[B_+6], P[B_+7]);                                             \
        auto r0 = __builtin_amdgcn_permlane32_swap(a0, b0, false, false); auto r1 = __builtin_amdgcn_permlane32_swap(a1, b1, false, false); \
        u32x4 w = {r0[0], r1[0], r0[1], r1[1]}; OUT = *reinterpret_cast<bf16x8*>(&w); } while (0)
    PK4(p0, 0, pa0); PK4(p0, 8, pa1); PK4(p1, 0, pa2); PK4(p1, 8, pa3);
#undef PK4
}
template <int KB, bool SK>
__device__ __forceinline__ void qkt(f32x16& p0, f32x16& p1, const char* K_lds, int r32, int hi, const bf16x8* qr, bool act) {
    if (SK && !act) { const float NEG = -__builtin_inff();
#pragma unroll
        for (int r = 0; r < 16; ++r) { p0[r] = NEG; p1[r] = NEG; } return; }
    p0 = f32x16{}; p1 = f32x16{};
    const char* kb[4];
#pragma unroll
    for (int dd = 0; dd < 4; ++dd) kb[dd] = K_lds + KB * SHM_K + KSWZ(r32, (dd * 16 + hi * 8) * 2);
#pragma unroll
    for (int d0 = 0; d0 < 8; ++d0) { const char* a = kb[d0 & 3] + (d0 >> 2) * 128;
        bf16x8 b0 = *reinterpret_cast<const bf16x8*>(a);
        bf16x8 b1 = *reinterpret_cast<const bf16x8*>(a + 32 * 256);
        p0 = __builtin_amdgcn_mfma_f32_32x32x16_bf16(b0, qr[d0], p0, 0, 0, 0);
        p1 = __builtin_amdgcn_mfma_f32_32x32x16_bf16(b1, qr[d0], p1, 0, 0, 0); }
}
template <int VB, bool SK>
__device__ __forceinline__ void pv_tile(f32x16* o, int vb0, bf16x8 pa0, bf16x8 pa1, bf16x8 pa2, bf16x8 pa3, bool act) {
    if (SK && !act) return;
#define TRRD(dst, off) asm volatile("ds_read_b64_tr_b16 %0, %1 offset:%2" : "=&v"(dst) : "v"(vb0), "i"(off) : "memory")
#define PV_D0(d0) do { s16x4 l0, l1, l2, l3, h0, h1, h2, h3; constexpr int b_ = VB * SHM_V + v_rd_off(d0, 0, 0);     \
        TRRD(l0, b_); TRRD(h0, b_ + 2048); TRRD(l1, b_ + 4096); TRRD(h1, b_ + 6144); TRRD(l2, b_ + 8192); TRRD(h2, b_ + 10240); TRRD(l3, b_ + 12288); TRRD(h3, b_ + 14336); \
        asm volatile("s_waitcnt lgkmcnt(0)" ::: "memory"); SBAR();                 \
        o[d0] = __builtin_amdgcn_mfma_f32_32x32x16_bf16(pa0, (bf16x8){l0[0], l0[1], l0[2], l0[3], h0[0], h0[1], h0[2], h0[3]}, o[d0], 0, 0, 0);   \
        o[d0] = __builtin_amdgcn_mfma_f32_32x32x16_bf16(pa1, (bf16x8){l1[0], l1[1], l1[2], l1[3], h1[0], h1[1], h1[2], h1[3]}, o[d0], 0, 0, 0);   \
        o[d0] = __builtin_amdgcn_mfma_f32_32x32x16_bf16(pa2, (bf16x8){l2[0], l2[1], l2[2], l2[3], h2[0], h2[1], h2[2], h2[3]}, o[d0], 0, 0, 0);   \
        o[d0] = __builtin_amdgcn_mfma_f32_32x32x16_bf16(pa3, (bf16x8){l3[0], l3[1], l3[2], l3[3], h3[0], h3[1], h3[2], h3[3]}, o[d0], 0, 0, 0); } while (0)
    PV_D0(0); PV_D0(1); PV_D0(2); PV_D0(3);
#undef PV_D0
#undef TRRD
}

__device__ __forceinline__ bf16x8 load8(const bf16* p) { return *reinterpret_cast<const bf16x8*>(p); }
__device__ __forceinline__ void mask_bits(f32x16& p0, f32x16& p1, u32x2 w, int hi) {
    const float NEG = -__builtin_inff();
    asm volatile("" : "+v"(w.x), "+v"(w.y));
    const unsigned lo = w.x >> (4 * hi), up = w.y >> (4 * hi);
#pragma unroll
    for (int r = 0; r < 16; ++r) { const int c = (r & 3) + 8 * (r >> 2);
        if (!((lo >> c) & 1u)) p0[r] = NEG;
        if (!((up >> c) & 1u)) p1[r] = NEG; }
}
struct BlockRef { const bf16* Q; const bf16* K; const bf16* V; bf16* O; const u32x2* M; int P0; };
struct Seam { bf16x8 qr[8]; bf16x8 st_v0, st_v1, st_k0, st_k1; };
#define ROW(p, k0, rr) ((p) + (size_t)((k0) + (rr)) * D + sc)
#define VMW() asm volatile("s_waitcnt vmcnt(0)" ::: "memory")
#define VMWN(n) asm volatile("s_waitcnt vmcnt(%0)" :: "i"(n) : "memory")
#define SLOAD_H(Kp, Vp, k0) do { S.st_v0 = load8(ROW(Vp, k0, sr)); S.st_v1 = load8(ROW(Vp, k0, 32 + sr));              \
                         S.st_k0 = load8(ROW(Kp, k0, sr)); S.st_k1 = load8(ROW(Kp, k0, 32 + sr)); } while (0)
#define SWRITE_HK(bf) do { *(bf16x8*)(K_lds + (bf) * SHM_K + kws) = S.st_k0; *(bf16x8*)(K_lds + (bf) * SHM_K + kws + 32 * 256) = S.st_k1; } while (0)
#define SWRITE_HV(bf) do { *(bf16x8*)(V_lds + (bf) * SHM_V + vst0) = S.st_v0; *(bf16x8*)(V_lds + (bf) * SHM_V + vst1) = S.st_v1; } while (0)
#define SWRITE_H(bf) do { SWRITE_HV(bf); SWRITE_HK(bf); } while (0)
__device__ __forceinline__ void sel_prime(const BlockRef& cur, char* lds, Seam& S) {
    int tid_ = threadIdx.x; asm volatile("" : "+v"(tid_));
    const int tid = tid_, wid = __builtin_amdgcn_readfirstlane(tid >> 6), lane = tid & 63, r32 = lane & 31, hi = lane >> 5;
    const int sr = tid >> 4, sc = (tid & 15) * 8, kws = KSWZ(sr, sc * 2); char* K_lds = lds + 2 * SHM_V;
    for (int d0 = 0; d0 < 8; ++d0) S.qr[d0] = load8(cur.Q + (size_t)(wid * QBLK + r32) * D + d0 * 16 + hi * 8);
    SLOAD_H(cur.K, cur.V, 0); VMW(); SWRITE_HK(0);
    __syncthreads();
}
__device__ __forceinline__ void sel_block(const BlockRef& cur, const BlockRef& nxt, char* lds, Seam& S) {
    int tid_ = threadIdx.x; asm volatile("" : "+v"(tid_));
    const int tid = tid_, wid = __builtin_amdgcn_readfirstlane(tid >> 6), lane = tid & 63, r32 = lane & 31, hi = lane >> 5;
    const int NT = (cur.P0 + QB) / KVBLK;
    char* V_lds = lds; char* K_lds = lds + 2 * SHM_V;
    float* ws = (float*)(lds + 2 * SHM_V + 2 * SHM_K) + wid * 64; float* li_l = ws, * al_l = ws + 32;
    float m_reg = -1e30f, l_reg = 0; f32x16 o[4] = {};
    const int sr = tid >> 4, sc = (tid & 15) * 8, vst0 = v_st(sr, sc), vst1 = v_st(32 + sr, sc), kws = KSWZ(sr, sc * 2);
    const int vb0 = (int)(uintptr_t)V_lds + v_rd_base(lane);
    const bf16* Kh = cur.K; const bf16* Vh = cur.V;
    const u32x2* Mrow = cur.M + (size_t)(wid * QBLK + r32) * 64;
#define RESC(a) do { if (__any((a) < 1.f)) { if (hi == 0) al_l[r32] = (a); asm volatile("s_waitcnt lgkmcnt(0)" ::: "memory");              \
                     for (int d_ = 0; d_ < 4; ++d_) for (int r = 0; r < 16; ++r) o[d_][r] *= al_l[crow(r, hi)]; } } while (0)
#define KBASE(t) ((t) * KVBLK)
    f32x16 pA0, pA1, pB0, pB1; float mnA, mnB, alA, alB; bf16x8 pa0, pa1, pa2, pa3; u32x2 mw;
    SWRITE_HV(0); SBAR();
    if (NT > 1) SLOAD_H(Kh, Vh, KBASE(1));
    mw = Mrow[0];
    SBAR(); qkt<0, false>(pA0, pA1, K_lds, r32, hi, S.qr, true);
    mask_bits(pA0, pA1, mw, hi); partialSM(pA0, pA1, m_reg, mnA, alA);
    if (NT > 1) { VMW(); SWRITE_H(1); }
    __syncthreads();
#define HALF_STEP(PX0, PX1, mnX, alX, PY0, PY1, alY, t, KB, VB, SB) do {                                                      \
        SBAR(); mw = Mrow[(t)]; qkt<KB, false>(PX0, PX1, K_lds, r32, hi, S.qr, true);                                          \
        finishSM(PY0, PY1, alY, l_reg, pa0, pa1, pa2, pa3); SBAR();                                                           \
        if ((t) + 1 < NT) { SLOAD_H(Kh, Vh, KBASE((t) + 1)); SBAR(); }                                                        \
        pv_tile<VB, false>(o, vb0, pa0, pa1, pa2, pa3, true); mask_bits(PX0, PX1, mw, hi); partialSM(PX0, PX1, m_reg, mnX, alX); \
        __syncthreads();                                                                                                      \
        if ((t) + 1 < NT) { VMW(); SWRITE_H(SB); }                                                                            \
        RESC(alX); __syncthreads(); } while (0)
    for (int t = 1; t + 1 < NT; t += 2) {
        HALF_STEP(pB0, pB1, mnB, alB, pA0, pA1, alA, t, 1, 0, 0);
        HALF_STEP(pA0, pA1, mnA, alA, pB0, pB1, alB, t + 1, 0, 1, 1);
    }
    const bool even = (NT & 1) == 0;
    if (even) { SBAR(); mw = Mrow[NT - 1]; qkt<1, false>(pB0, pB1, K_lds, r32, hi, S.qr, true); SBAR(); }
    SLOAD_H(nxt.K, nxt.V, 0); SBAR();
#pragma unroll
    for (int d0 = 0; d0 < 8; ++d0) S.qr[d0] = load8(nxt.Q + (size_t)(wid * QBLK + r32) * D + d0 * 16 + hi * 8);
    SBAR();
    finishSM(pA0, pA1, alA, l_reg, pa0, pa1, pa2, pa3); SBAR();
    pv_tile<0, false>(o, vb0, pa0, pa1, pa2, pa3, true);
    if (even) { mask_bits(pB0, pB1, mw, hi); partialSM(pB0, pB1, m_reg, mnB, alB); __syncthreads(); RESC(alB);
        finishSM(pB0, pB1, alB, l_reg, pa0, pa1, pa2, pa3); SBAR(); pv_tile<1, false>(o, vb0, pa0, pa1, pa2, pa3, true); }
    SBAR(); VMWN(8); SWRITE_HK(0); SBAR();
    if (hi == 0) li_l[r32] = l_reg; asm volatile("s_waitcnt lgkmcnt(0)" ::: "memory");
    float rli[16];
#pragma unroll
    for (int r = 0; r < 16; ++r) rli[r] = __builtin_amdgcn_rcpf(li_l[crow(r, hi)]);
    bf16* Ow = cur.O + (size_t)(wid * QBLK) * OS;
#pragma unroll
    for (int r = 0; r < 16; ++r) { const int orow = crow(r, hi);
#pragma unroll
        for (int d0 = 0; d0 < 4; ++d0) { const float v = o[d0][r] * rli[r];
            const float vn = __shfl_xor(v, 1);
            if ((r32 & 1) == 0) *(unsigned*)(Ow + (size_t)orow * OS + d0 * 32 + r32) = cvtpk(v, vn); } }
    __syncthreads();
#undef RESC
#undef KBASE
#undef HALF_STEP
}
#undef ROW
#undef VMW
#undef VMWN
#undef SLOAD_H
#undef SWRITE_HK
#undef SWRITE_HV
#undef SWRITE_H
#undef KSWZ
#undef SBAR
}


__device__ __forceinline__ attn::BlockRef attn_ref(const Args& a, int b, int h, int qb) {
    attn::BlockRef r; const int kvh = h / 3;
    r.Q = (const attn::bf16*)(a.ws + WS_QB) + ((size_t)(b * 6 + h) * SEQ + (size_t)qb * 256) * 128;
    r.K = (const attn::bf16*)(a.ws + WS_KB) + (size_t)(b * 2 + kvh) * SEQ * 128;
    r.V = (const attn::bf16*)(a.ws + WS_VB) + (size_t)(b * 2 + kvh) * SEQ * 128;
    r.O = (attn::bf16*)(a.ws + WS_MIX) + (size_t)(b * SEQ + qb * 256) * DM + h * 128;
    r.M = (const attn::u32x2*)(a.ws + WS_MASK) + (size_t)(b * SEQ + qb * 256) * 64;
    r.P0 = qb * 256; return r;
}
__device__ __forceinline__ void p11_attention(Ctx& c, const Args& a) {
    constexpr int NITEM = 192;
#pragma unroll 1
    for (int it = c.vcu; it < NITEM; it += c.G) {
        const int p = it & 7, bh = it >> 3, b = bh / 6, h = bh % 6;
        attn::Seam S;
        attn::BlockRef cur = attn_ref(a, b, h, p), nxt = attn_ref(a, b, h, 15 - p);
        __syncthreads();
        attn::sel_prime(cur, (char*)c.lds, S);
        attn::sel_block(cur, nxt, (char*)c.lds, S);
        attn::sel_block(nxt, nxt, (char*)c.lds, S);
    }
    const int spare = c.G - NITEM;
    if (spare > 0) { if (c.vcu >= NITEM) for (int u = c.vcu - NITEM; u < MS; u += spare) attn_sample_unit(c, a, u >> 2, u & 3); }
    else for (int u = c.vcu; u < MS; u += c.G) attn_sample_unit(c, a, u >> 2, u & 3);
}

enum { PH_PRO = 0, PH_IN0, PH_MIX0, PH_HSCAN, PH_HFIX, PH_OUT0, PH_GU0, PH_CONV0, PH_DOWN0, PH_IN1, PH_POST, PH_IDX, PH_TOPK, PH_ATTN, PH_OUT1, PH_GU1, PH_CONV1, PH_DOWN1, NPHASE };
#ifndef ONLYPH
#define ONLYPH -1
#endif
#define PHON(x) (ONLYPH < 0 || ONLYPH == (x))
#ifndef REP_PH
#define REP_PH -1
#endif
#ifndef REP_N
#define REP_N 1
#endif
__global__ void __launch_bounds__(NWAVES * 64, 2) fwd_kernel(Args args) {
    extern __shared__ __attribute__((aligned(16))) unsigned char lds[];
    Ctx c;
    c.lds = (LAS unsigned char*)lds;
    c.MISC = (volatile LAS unsigned*)(c.lds + MISC_OFF);
    c.tid = threadIdx.x; c.lane = c.tid & 63; c.wave = __builtin_amdgcn_readfirstlane(c.tid >> 6);
    c.G = gridDim.x; { const int bx = blockIdx.x; c.vcu = (c.G % 8 == 0) ? (bx % 8) * (c.G / 8) + bx / 8 : bx; }
    unsigned char* ws = args.ws;
    c.ctl = (gu32*)(ws + WS_CTL);
    for (int u = c.tid; u < (LDS_BYTES - LDSCTL_OFF) / 4; u += NWAVES * 64) ((LAS unsigned*)(c.lds + LDSCTL_OFF))[u] = 0u;
    __syncthreads();
    const int lo = args.ph_lo, hi = args.ph_hi;
    XcdBarrier bar; bar.bar = (unsigned*)(c.ctl + CW_BAR); bar.x = 0; bar.st = nullptr;
    if (hi - lo > 1 || REP_N > 1) bar = xcd_barrier_post((unsigned*)(c.ctl + CW_BAR), c.MISC + 8);
    float* const out = args.out;
    c.qoff = 0;
#pragma unroll 1
    for (int ph = lo; ph < hi; ++ph) {
        const int layer = ph >= PH_IN1 ? 1 : 0;
        { int t_ = threadIdx.x; asm volatile("" : "+v"(t_)); c.tid = t_; c.lane = t_ & 63; c.wave = __builtin_amdgcn_readfirstlane(t_ >> 6); }
        if (ph == PH_PRO && PHON(PH_PRO)) p0_prologue(c, args);
        else if ((ph == PH_IN0 || ph == PH_IN1) && PHON(PH_IN0)) {
            pg8::Gemm g{(const pg8::bf16_t*)(ws + WS_XB), (const pg8::bf16_t*)(ws + (ph == PH_IN0 ? WS_WIN0 : WS_WIN1)), MT, 0, 1024};
            pg8::SchedX S; if (ph == PH_IN0) S.init(MT, ZC0, c.G, (int)blockIdx.x, 16, MT / 256, 4, 13); else S.init(MT, ZC1, c.G, (int)blockIdx.x, 0, 0, 1, 0);
            pg8::EpiZ E{(pg8::bf16_t*)(ws + WS_Z), ph == PH_IN0 ? ZC0 : ZC1, ssptr(c, ph == PH_IN0 ? 0 : 2), ph == PH_IN0 ? 13 : 9, (float*)(ws + WS_MEMKV), MEMROW0};
            pg8::gemm_phase<pg8::EpiZ, pg8::SchedX, PG8_ALIGN, PG8_SP2>(c.lds + RING_OFF, g, S, E);
        }
        else if (ph == PH_MIX0 && PHON(PH_MIX0)) p2_mixer0(c, args);
        else if (ph == PH_HSCAN && PHON(PH_HSCAN)) hgrn_scan(c, args);
        else if (ph == PH_HFIX && PHON(PH_HFIX)) p2c_hgrn_fix(c, args);
        else if ((ph == PH_OUT0 || ph == PH_DOWN0 || ph == PH_OUT1 || ph == PH_DOWN1) && PHON(PH_OUT0)) {
            const bool isout = (ph == PH_OUT0 || ph == PH_OUT1);
            pg8::Gemm g{(const pg8::bf16_t*)(ws + (isout ? WS_MIX : WS_ACT)), (const pg8::bf16_t*)(ws + (isout ? WS_WOUT + (size_t)layer * 1024 * 1024 * 2 : WS_WD + (size_t)layer * 1024 * DFF * 2)), MT, 1024, isout ? 1024 : DFF};
            pg8::SchedX S; S.init(MT, 1024, c.G, (int)blockIdx.x, 0, 0, 1, 0);
            pg8::EpiResid E;
            E.rp = ph == PH_OUT0 ? args.in[0] : out + O_YP; E.rs = ph == PH_OUT0 ? args.in[1] : out + O_YS; E.y = out + O_YP;
            E.xb = ph == PH_DOWN1 ? nullptr : (pg8::bf16_t*)(ws + WS_XB); E.ssout = ph == PH_DOWN1 ? nullptr : ssptr(c, ph == PH_OUT0 ? 1 : (ph == PH_DOWN0 ? 2 : 3));
            pg8::gemm_phase<pg8::EpiResid, pg8::SchedX, PG8_ALIGN, PG8_SP2>(c.lds + RING_OFF, g, S, E);
        }
        else if ((ph == PH_GU0 || ph == PH_GU1) && PHON(PH_GU0)) {
            pg8::Gemm g{(const pg8::bf16_t*)(ws + WS_XB), (const pg8::bf16_t*)(ws + WS_WGU + (size_t)layer * 5632 * 1024 * 2), MT, 5632, 1024};
            pg8::SchedX S; S.init(MT, 5632, c.G, (int)blockIdx.x, 0, 0, 1, 0);
            pg8::EpiGU E{(pg8::bf16_t*)(ws + WS_U), (pg8::bf16_t*)(ws + WS_UP), ssptr(c, layer ? 3 : 1), out + O_CVP + (size_t)layer * 4 * 2 * DFF, out + O_CVS + (size_t)layer * 32 * 2 * DFF};
            pg8::gemm_phase<pg8::EpiGU, pg8::SchedX, PG8_ALIGN, PG8_SP2>(c.lds + RING_OFF, g, S, E);
        }
        else if ((ph == PH_CONV0 || ph == PH_CONV1) && PHON(PH_CONV0)) p5_convact(c, args, layer);
        else if (ph == PH_POST && PHON(PH_POST)) p8_dsa_post(c, args);
        else if (ph == PH_IDX && PHON(PH_IDX)) p9_indexer(c, args);
        else if (ph == PH_TOPK && PHON(PH_TOPK)) p10_topk(c, args);
        else if (ph == PH_ATTN && PHON(PH_ATTN)) p11_attention(c, args);
        if (REP_N > 1 && ph == REP_PH && c.qoff < 4 * (REP_N - 1)) { c.qoff += 4; --ph; xcd_barrier(bar); continue; }
        if (REP_N > 1) c.qoff = 0;
        if (ph + 1 < hi) xcd_barrier(bar);
    }
}

#ifndef MK_ONE_LAUNCH
#define MK_ONE_LAUNCH 1
#endif
extern "C" void kernel_launch(void* const* d_in, const int* in_sizes, int n_in, void* d_out, int out_size, void* d_ws, size_t ws_size, hipStream_t stream) {
    static int grid = 0;
    if (grid == 0) {
        if (n_in != 29 || out_size != (int)O_END || ws_size < WS_END) { fprintf(stderr, "kernel_launch: unexpected problem (n_in %d, out %d, ws %zu)\n", n_in, out_size, ws_size); grid = -1; return; }
        int dev = 0, cus = 0;
        if (hipGetDevice(&dev) != hipSuccess || hipDeviceGetAttribute(&cus, hipDeviceAttributeMultiprocessorCount, dev) != hipSuccess) { grid = -1; return; }
        if (hipFuncSetAttribute((const void*)fwd_kernel, hipFuncAttributeMaxDynamicSharedMemorySize, LDS_BYTES) != hipSuccess) { fprintf(stderr, "kernel_launch: hipFuncSetAttribute failed\n"); grid = -1; return; }
        (void)hipGetLastError();
        grid = cus;
    }
    if (grid < 0) return;
    if (hipMemsetAsync((char*)d_ws + WS_CTL, 0, CTL_ZERO_BYTES, stream) != hipSuccess) { fprintf(stderr, "kernel_launch: memset failed\n"); return; }
    Args a{};
    for (int i = 0; i < 29; ++i) a.in[i] = (const float*)d_in[i];
    a.page_table = (const int*)d_in[9]; a.out = (float*)d_out; a.ws = (unsigned char*)d_ws;
#if MK_ONE_LAUNCH
    a.ph_lo = 0; a.ph_hi = NPHASE;
    hipLaunchKernelGGL(fwd_kernel, dim3(grid), dim3(NWAVES * 64), LDS_BYTES, stream, a);
#else
    for (int ph = 0; ph < NPHASE; ++ph) { a.ph_lo = ph; a.ph_hi = ph + 1; hipLaunchKernelGGL(fwd_kernel, dim3(grid), dim3(NWAVES * 64), LDS_BYTES, stream, a); }
#endif
}
```

```cpp
#include <hip/hip_runtime.h>
#include <cstdio>
#include <cstdint>


namespace pg8 {
#define PG8_LAS __attribute__((address_space(3)))
typedef unsigned short bf16_t;
typedef short bf16x8 __attribute__((ext_vector_type(8)));
typedef float f32x4 __attribute__((ext_vector_type(4)));
typedef unsigned u32x4 __attribute__((ext_vector_type(4)));
constexpr int BM = 256, BK = 64, HALF = 128, HTB = HALF * BK * 2  , STAGE_BYTES = 8 * HTB, NXCD = 8, WGM = 8;

__host__ __device__ __forceinline__ int lds_byte(int r, int c) { const int st = (r >> 4) * 2 + (c >> 5), rr = r & 15, cc = c & 31, ob = rr * 64 + cc * 2; return st * 1024 + (ob ^ (((ob >> 9) & 1) << 5)); }
__host__ __device__ __forceinline__ void stage_rc(int b, int& R, int& C) { const int st = b / 1024, sb = b % 1024, swz = sb ^ (((sb >> 9) & 1) << 5); R = (st >> 1) * 16 + swz / 64; C = (st & 1) * 32 + (swz % 64) / 2; }
__host__ __device__ __forceinline__ int perm32(int rho) { const int n = rho >> 4, i = rho & 15; return 8 * (i >> 2) + 4 * n + (i & 3); }

struct Unit { int pm, pn; };
struct Gemm { const bf16_t* A; const bf16_t* Bt; int M, N, K; };

struct StaticOrder {
    int nM, nN, nwg, G, c;
    __host__ __device__ void init(int M, int N, int G_, int c_) { nM = M / BM; nN = N / BM; nwg = nM * nN; G = G_; c = c_; }
    __host__ __device__ bool next(int i, Unit& u) const {
        const long L = (long)i * G + c; if (L >= nwg) return false;
        int wgid = (int)L; { const int q = nwg / NXCD, r = nwg % NXCD, xcd = wgid % NXCD, off = wgid / NXCD; wgid = (xcd < r ? xcd * (q + 1) : r * (q + 1) + (xcd - r) * q) + off; }
        const int nig = WGM * nN, gid = wgid / nig, fm = gid * WGM, gsz = (nM - fm) < WGM ? (nM - fm) : WGM;
        u.pm = fm + ((wgid % nig) % gsz); u.pn = (wgid % nig) / gsz; return true;
    }
    __device__ __forceinline__ void a_ready(const Unit&) const {}
    __device__ __forceinline__ void done(const Unit&) const {}
};


constexpr int MP = 16384, MS = 128, MVALID = MP + MS, MT = 16640, DM = 1024, DFF = 2816;
constexpr float RMS_EPS = 1e-6f;
__device__ __forceinline__ unsigned cvt_pk_bf16(float lo, float hi) { unsigned r; asm volatile("v_cvt_pk_bf16_f32 %0, %1, %2" : "=v"(r) : "v"(lo), "v"(hi)); return r; }

struct SchedX {
    StaticOrder so; int nextra, e_pm0, e_nm, e_pn0;
    __device__ void init(int M, int N, int G_, int c_, int nextra_, int e_pm0_, int e_nm_, int e_pn0_) { so.init(M, N, G_, c_); nextra = nextra_; e_pm0 = e_pm0_; e_nm = e_nm_; e_pn0 = e_pn0_; }
    __device__ bool next(int i, Unit& u) const {
        const long L = (long)i * so.G + so.c;
        if (L < so.nwg) return so.next(i, u);
        const int e = (int)(L - so.nwg); if (e >= nextra) return false;
        u.pm = e_pm0 + e % e_nm; u.pn = e_pn0 + e / e_nm; return true;
    }
    __device__ __forceinline__ void a_ready(const Unit&) const {}
    __device__ __forceinline__ void done(const Unit&) const {}
};

struct EpiZ {
    static constexpr bool PERM = true, AFTER_DRAIN = false;
    bf16_t* Z; int ldz; const float* ss; int nmain; float* memkv; int memrow0;
    __device__ __forceinline__ void operator()(const f32x4 (&acc)[2][2][4][2], const Unit& u, int wr, int wc, int fr, int fq) const {
        const int row0 = u.pm * BM + wr * 64 + fr;
        if (u.pn < nmain) {
            const int col0 = u.pn * BM + wc * 32 + 8 * fq;
#pragma unroll
            for (int ai = 0; ai < 2; ++ai)
#pragma unroll
                for (int m = 0; m < 4; ++m) { const int row = row0 + ai * HALF + m * 16; const float rs = rsqrtf(ss[row] * (1.0f / DM) + RMS_EPS);
#pragma unroll
                    for (int bj = 0; bj < 2; ++bj) { const f32x4 v0 = acc[ai][bj][m][0] * rs, v1 = acc[ai][bj][m][1] * rs;
                        u32x4 w; w.x = cvt_pk_bf16(v0[0], v0[1]); w.y = cvt_pk_bf16(v0[2], v0[3]); w.z = cvt_pk_bf16(v1[0], v1[1]); w.w = cvt_pk_bf16(v1[2], v1[3]);
                        *(u32x4*)(Z + (size_t)row * ldz + col0 + bj * HALF) = w; } }
        } else {
            const int col0 = (u.pn - nmain) * BM + wc * 32 + 8 * fq;
#pragma unroll
            for (int ai = 0; ai < 2; ++ai)
#pragma unroll
                for (int m = 0; m < 4; ++m) { const int row = row0 + ai * HALF + m * 16 - memrow0;
#pragma unroll
                    for (int bj = 0; bj < 2; ++bj) { float* p = memkv + (size_t)row * 1024 + col0 + bj * HALF; *(f32x4*)p = acc[ai][bj][m][0]; *(f32x4*)(p + 4) = acc[ai][bj][m][1]; } }
        }
    }
};

struct EpiResid {
    static constexpr bool PERM = true, AFTER_DRAIN = false;
    const float* rp; const float* rs; float* y; bf16_t* xb; float* ssout;
    __device__ __forceinline__ void operator()(const f32x4 (&acc)[2][2][4][2], const Unit& u, int wr, int wc, int fr, int fq) const {
        const int row0 = u.pm * BM + wr * 64 + fr, col0 = u.pn * BM + wc * 32 + 8 * fq;
#pragma unroll
        for (int ai = 0; ai < 2; ++ai)
#pragma unroll
            for (int m = 0; m < 4; ++m) { const int row = row0 + ai * HALF + m * 16; float part = 0.f;
                if (row < MVALID) { const float* src = row < MP ? rp + (size_t)row * DM : rs + (size_t)(row - MP) * DM;
#pragma unroll
                    for (int bj = 0; bj < 2; ++bj) { const int c = col0 + bj * HALF;
                        const f32x4 v0 = acc[ai][bj][m][0] + *(const f32x4*)(src + c), v1 = acc[ai][bj][m][1] + *(const f32x4*)(src + c + 4);
                        *(f32x4*)(y + (size_t)row * DM + c) = v0; *(f32x4*)(y + (size_t)row * DM + c + 4) = v1;
                        part += (v0[0] * v0[0] + v0[1] * v0[1]) + (v0[2] * v0[2] + v0[3] * v0[3]) + (v1[0] * v1[0] + v1[1] * v1[1]) + (v1[2] * v1[2] + v1[3] * v1[3]);
                        if (xb) { u32x4 w; w.x = cvt_pk_bf16(v0[0], v0[1]); w.y = cvt_pk_bf16(v0[2], v0[3]); w.z = cvt_pk_bf16(v1[0], v1[1]); w.w = cvt_pk_bf16(v1[2], v1[3]);
                            *(u32x4*)(xb + (size_t)row * DM + c) = w; } } }
                part += __shfl_xor(part, 16); part += __shfl_xor(part, 32);
                if (ssout && fq == 0 && row < MVALID) atomicAdd(ssout + row, part); }
    }
};

struct EpiGU {
    static constexpr bool PERM = true, AFTER_DRAIN = false;
    bf16_t* U; bf16_t* UP; const float* ss; float* cvp; float* cvs;
    __device__ __forceinline__ void operator()(const f32x4 (&acc)[2][2][4][2], const Unit& u, int wr, int wc, int fr, int fq) const {
        const int row0 = u.pm * BM + wr * 64 + fr, colg = u.pn * HALF + wc * 32 + 8 * fq;
#pragma unroll
        for (int ai = 0; ai < 2; ++ai)
#pragma unroll
            for (int m = 0; m < 4; ++m) { const int row = row0 + ai * HALF + m * 16; const float rs = rsqrtf(ss[row] * (1.0f / DM) + RMS_EPS);
                const f32x4 g0 = acc[ai][0][m][0] * rs, g1 = acc[ai][0][m][1] * rs, p0 = acc[ai][1][m][0] * rs, p1 = acc[ai][1][m][1] * rs;
                u32x4 w; w.x = cvt_pk_bf16(g0[0], g0[1]); w.y = cvt_pk_bf16(g0[2], g0[3]); w.z = cvt_pk_bf16(g1[0], g1[1]); w.w = cvt_pk_bf16(g1[2], g1[3]);
                *(u32x4*)(U + (size_t)row * DFF + colg) = w;
                w.x = cvt_pk_bf16(p0[0], p0[1]); w.y = cvt_pk_bf16(p0[2], p0[3]); w.z = cvt_pk_bf16(p1[0], p1[1]); w.w = cvt_pk_bf16(p1[2], p1[3]);
                *(u32x4*)(UP + (size_t)row * DFF + colg) = w;
                float* cv = nullptr;
                if (row < MP) { const int t = row & 4095; if (t >= 4094) cv = cvp + (size_t)((row >> 12) * 2 + (t - 4094)) * DFF; }
                else if (row < MVALID) { const int r2 = row - MP, t = r2 & 3; if (t >= 2) cv = cvs + (size_t)((r2 >> 2) * 2 + (t - 2)) * DFF; }
                if (cv) { *(f32x4*)(cv + colg) = g0; *(f32x4*)(cv + colg + 4) = g1; } }
    }
};

template <class Epi, class Sched, bool ALIGN_EPI = false, bool SP2 = false>
__device__ __forceinline__ void gemm_phase(PG8_LAS unsigned char* lds, const Gemm g, const Sched& S, const Epi& E) {
    int tid_ = threadIdx.x; asm volatile("" : "+v"(tid_));
    const int tid = tid_, wid = __builtin_amdgcn_readfirstlane(tid >> 6), lane = tid & 63, wr = wid >> 2, wc = wid & 3, fr = lane & 15, fq = lane >> 4;
    const int K = g.K, nt = K / BK;
    unsigned voffA[2], voffB[2];
#pragma unroll
    for (int i = 0; i < 2; ++i) { int R, C; stage_rc(tid * 16 + i * 8192, R, C); const int Rb = Epi::PERM ? ((R & ~31) + perm32(R & 31)) : R;
        voffA[i] = (unsigned)(R * K + C) * 2u; voffB[i] = (unsigned)(Rb * K + C) * 2u; }
    const size_t kstep = (size_t)(BK * 2);
    const size_t hstep = (size_t)HALF * K * 2;
    const size_t tstep = 2 * hstep;
    const unsigned ldsw = (unsigned)wid * 1024u;
    const int aoff = lds_byte(wr * 64 + fr, fq * 8), boff = lds_byte(wc * 32 + fr, fq * 8);
#define PG8_SA(b, h) (((b) * 2 + (h)) * HTB)
#define PG8_SB(b, h) ((4 + (b) * 2 + (h)) * HTB)
#define PG8_STAGE(bufoff, gbase, voff) do { _Pragma("unroll") for (int _i = 0; _i < 2; ++_i) \
        __builtin_amdgcn_global_load_lds((const unsigned*)((const char*)(gbase) + (voff)[_i]), (PG8_LAS unsigned*)(lds + (bufoff) + ldsw + _i * 8192), 16, 0, 0); } while (0)
#define PG8_LDA(dst, b, h) do { _Pragma("unroll") for (int m = 0; m < 4; ++m) _Pragma("unroll") for (int k = 0; k < 2; ++k) dst[m][k] = *(const PG8_LAS bf16x8*)(lds + PG8_SA(b, h) + aoff + m * 2048 + k * 1024); } while (0)
#define PG8_LDB(dst, b, h) do { _Pragma("unroll") for (int n = 0; n < 2; ++n) _Pragma("unroll") for (int k = 0; k < 2; ++k) dst[n][k] = *(const PG8_LAS bf16x8*)(lds + PG8_SB(b, h) + boff + n * 2048 + k * 1024); } while (0)
#define PG8_MMA(ai, bj, At, Bt) do { __builtin_amdgcn_s_setprio(1); _Pragma("unroll") for (int m = 0; m < 4; ++m) _Pragma("unroll") for (int n = 0; n < 2; ++n) _Pragma("unroll") for (int k = 0; k < 2; ++k) \
        acc[ai][bj][m][n] = __builtin_amdgcn_mfma_f32_16x16x32_bf16(Bt[n][k], At[m][k], acc[ai][bj][m][n], 0, 0, 0); __builtin_amdgcn_s_setprio(0); } while (0)
#define PG8_WAIT_V(n) asm volatile("s_waitcnt vmcnt(" #n ")" ::: "memory")
#define PG8_WAIT_L(n) asm volatile("s_waitcnt lgkmcnt(" #n ")" ::: "memory")
#define PG8_BAR __builtin_amdgcn_s_barrier()
#define PG8_SCHED __builtin_amdgcn_sched_barrier(0)
    Unit cur, nxt; int ui = 0;
    if (!S.next(0, cur)) return;
    f32x4 acc[2][2][4][2];
#pragma unroll
    for (int a = 0; a < 2; ++a)
#pragma unroll
        for (int b = 0; b < 2; ++b)
#pragma unroll
            for (int m = 0; m < 4; ++m)
#pragma unroll
                for (int n = 0; n < 2; ++n) acc[a][b][m][n] = (f32x4){0.f, 0.f, 0.f, 0.f};
    bf16x8 At[4][2], B0[2][2], B1[2][2];
    const char* cA = (const char*)g.A + (size_t)cur.pm * tstep; const char* cB = (const char*)g.Bt + (size_t)cur.pn * tstep;
    S.a_ready(cur);
    if constexpr (SP2) {
        PG8_STAGE(PG8_SB(0, 0), cB, voffB); PG8_STAGE(PG8_SB(0, 1), cB + hstep, voffB); PG8_STAGE(PG8_SA(0, 0), cA, voffA); PG8_STAGE(PG8_SA(0, 1), cA + hstep, voffA);
        if (wr == 1) PG8_BAR;
        PG8_WAIT_V(2); PG8_BAR;
        PG8_STAGE(PG8_SB(1, 0), cB + kstep, voffB); PG8_STAGE(PG8_SA(1, 0), cA + kstep, voffA); PG8_STAGE(PG8_SB(1, 1), cB + hstep + kstep, voffB);
        PG8_WAIT_V(6); PG8_BAR;
    } else {
        PG8_STAGE(PG8_SB(0, 0), cB, voffB); PG8_STAGE(PG8_SA(0, 0), cA, voffA); PG8_STAGE(PG8_SB(0, 1), cB + hstep, voffB); PG8_STAGE(PG8_SA(0, 1), cA + hstep, voffA);
        if (wr == 1) PG8_BAR;
        PG8_WAIT_V(4); PG8_BAR;
        PG8_STAGE(PG8_SB(1, 0), cB + kstep, voffB); PG8_STAGE(PG8_SA(1, 0), cA + kstep, voffA); PG8_STAGE(PG8_SB(1, 1), cB + hstep + kstep, voffB);
        PG8_WAIT_V(6); PG8_BAR;
    }
    for (;;) {
        const bool has_next = S.next(ui + 1, nxt);
        const char* nA = has_next ? (const char*)g.A + (size_t)nxt.pm * tstep : cA; const char* nB = has_next ? (const char*)g.Bt + (size_t)nxt.pn * tstep : cB;
        for (int t = 0; t < nt; t += 2) {
            const bool last = (t == nt - 2);
            const char* a1 = cA + (size_t)(t + 1) * kstep;
            const char* a2 = last ? nA : cA + (size_t)(t + 2) * kstep; const char* b2 = last ? nB : cB + (size_t)(t + 2) * kstep;
            const char* a3 = a2 + kstep; const char* b3 = b2 + kstep;
            if (last && has_next) S.a_ready(nxt);
            if constexpr (SP2) {
            PG8_LDB(B0, 0, 0); PG8_LDB(B1, 0, 1); PG8_SCHED; PG8_LDA(At, 0, 0); PG8_STAGE(PG8_SA(1, 1), a1 + hstep, voffA);
            PG8_WAIT_V(8); PG8_WAIT_L(0); PG8_BAR; PG8_MMA(0, 0, At, B0); PG8_MMA(0, 1, At, B1); PG8_BAR; PG8_SCHED;
            PG8_LDA(At, 0, 1); PG8_STAGE(PG8_SB(0, 0), b2, voffB); PG8_STAGE(PG8_SB(0, 1), b2 + hstep, voffB); PG8_STAGE(PG8_SA(0, 0), a2, voffA);
            PG8_WAIT_V(8); PG8_WAIT_L(0); PG8_BAR; PG8_MMA(1, 0, At, B0); PG8_MMA(1, 1, At, B1); PG8_BAR; PG8_SCHED;
            PG8_LDB(B0, 1, 0); PG8_LDB(B1, 1, 1); PG8_SCHED; PG8_LDA(At, 1, 0); PG8_STAGE(PG8_SA(0, 1), a2 + hstep, voffA);
            PG8_WAIT_V(8); PG8_WAIT_L(0); PG8_BAR; PG8_MMA(0, 0, At, B0); PG8_MMA(0, 1, At, B1); PG8_BAR; PG8_SCHED;
            PG8_LDA(At, 1, 1); PG8_STAGE(PG8_SB(1, 0), b3, voffB); PG8_STAGE(PG8_SB(1, 1), b3 + hstep, voffB); PG8_STAGE(PG8_SA(1, 0), a3, voffA);
            PG8_WAIT_V(8); PG8_WAIT_L(0); PG8_BAR; PG8_MMA(1, 0, At, B0); PG8_MMA(1, 1, At, B1); PG8_BAR; PG8_SCHED;
            } else {
            PG8_LDB(B0, 0, 0); PG8_SCHED; PG8_LDA(At, 0, 0); PG8_STAGE(PG8_SA(1, 1), a1 + hstep, voffA);
            PG8_WAIT_L(8); PG8_BAR; PG8_WAIT_L(0); PG8_MMA(0, 0, At, B0); PG8_BAR; PG8_SCHED;
            PG8_LDB(B1, 0, 1); PG8_STAGE(PG8_SB(0, 0), b2, voffB);
            PG8_BAR; PG8_WAIT_L(0); PG8_MMA(0, 1, At, B1); PG8_BAR;
            PG8_LDA(At, 0, 1); PG8_STAGE(PG8_SA(0, 0), a2, voffA);
            PG8_BAR; PG8_WAIT_L(0); PG8_MMA(1, 0, At, B0); PG8_BAR; PG8_SCHED;
            PG8_STAGE(PG8_SB(0, 1), b2 + hstep, voffB);
            PG8_WAIT_V(6); PG8_BAR; PG8_MMA(1, 1, At, B1); PG8_BAR;
            PG8_LDB(B0, 1, 0); PG8_SCHED; PG8_LDA(At, 1, 0); PG8_STAGE(PG8_SA(0, 1), a2 + hstep, voffA);
            PG8_WAIT_L(8); PG8_BAR; PG8_WAIT_L(0); PG8_MMA(0, 0, At, B0); PG8_BAR; PG8_SCHED;
            PG8_LDB(B1, 1, 1); PG8_STAGE(PG8_SB(1, 0), b3, voffB);
            PG8_BAR; PG8_WAIT_L(0); PG8_MMA(0, 1, At, B1); PG8_BAR;
            PG8_LDA(At, 1, 1); PG8_STAGE(PG8_SA(1, 0), a3, voffA);
            PG8_BAR; PG8_WAIT_L(0); PG8_MMA(1, 0, At, B0); PG8_BAR; PG8_SCHED;
            PG8_STAGE(PG8_SB(1, 1), b3 + hstep, voffB);
            PG8_WAIT_V(6); PG8_BAR; PG8_MMA(1, 1, At, B1); PG8_BAR;
            }
        }
        if constexpr (ALIGN_EPI) { if (wr == 0) PG8_BAR; }
        if constexpr (!Epi::AFTER_DRAIN) { E(acc, cur, wr, wc, fr, fq); S.done(cur); }
        if (!has_next) break;
#pragma unroll
        for (int a = 0; a < 2; ++a)
#pragma unroll
            for (int b = 0; b < 2; ++b)
#pragma unroll
                for (int m = 0; m < 4; ++m)
#pragma unroll
                    for (int n = 0; n < 2; ++n) acc[a][b][m][n] = (f32x4){0.f, 0.f, 0.f, 0.f};
        cur = nxt; cA = nA; cB = nB; ++ui;
        if constexpr (ALIGN_EPI) { if (wr == 1) PG8_BAR; }
    }
    PG8_WAIT_V(0);
    if constexpr (!ALIGN_EPI) { if (wr == 0) PG8_BAR; }
    PG8_BAR;
    if constexpr (Epi::AFTER_DRAIN) { E.fused(acc, cur, wr, wc, fr, fq, lds, wid, lane); S.done(cur); }
#undef PG8_SA
#undef PG8_SB
#undef PG8_STAGE
#undef PG8_LDA
#undef PG8_LDB
#undef PG8_MMA
#undef PG8_WAIT_V
#undef PG8_WAIT_L
#undef PG8_BAR
#undef PG8_SCHED
}
}


#ifndef PG8_SP2
#define PG8_SP2 true
#endif
#ifndef PG8_ALIGN
#define PG8_ALIGN true
#endif
constexpr int NWAVES = 8;
constexpr int MP = pg8::MP, MS = pg8::MS, MVALID = pg8::MVALID, MT = pg8::MT, DM = 1024, DFF = 2816;
constexpr int SEQ = 4096, NB = 4, NSB = 32, PAST = 8192, NPOOL = 2560;
constexpr int ZC0 = 3328, ZC1 = 2304;
constexpr int Z1_Q = 0, Z1_K = 768, Z1_V = 1024, Z1_IQ = 1280, Z1_IK = 1792, Z1_IW = 1856, Z1_MQ = 1920;
constexpr int NMEMROWS = 1024, MEMROW0 = MT;
constexpr float EPS = 1e-6f;
constexpr size_t MiB = 1u << 20;
constexpr size_t WS_CTL = 0, CTL_ZERO_BYTES = 2 * MiB;
constexpr size_t WS_WIN0 = 2 * MiB, WS_WIN1 = 11 * MiB, WS_WOUT = 16 * MiB, WS_WGU = 20 * MiB, WS_WD = 42 * MiB;
constexpr size_t WS_XB = 54 * MiB, WS_MEMKV = 89 * MiB, WS_MIX = 94 * MiB, WS_Z = 128 * MiB, WS_U = 234 * MiB, WS_UP = 324 * MiB, WS_ACT = 414 * MiB;
constexpr size_t WS_QB = 504 * MiB, WS_KB = 528 * MiB, WS_VB = 536 * MiB, WS_IQB = 544 * MiB, WS_IKB = 560 * MiB, WS_IW = 562 * MiB;
constexpr size_t WS_SQ = 563 * MiB, WS_SIQ = WS_SQ + 512 * 1024, WS_SIW = WS_SIQ + 384 * 1024, WS_SSC = 564 * MiB, WS_SIDX = 569 * MiB, WS_MASK = 570 * MiB, WS_SC = 578 * MiB, WS_END = 834 * MiB;
constexpr int SSC_LD = 8256;
constexpr int CW_TMO = 0, CW_BAR = 4096, CW_Q = 8192, CW_SS = 16384;
constexpr size_t O_YP = 0, O_YS = O_YP + (size_t)MP * DM, O_HP = O_YS + (size_t)MS * DM, O_HS = O_HP + 4 * 6 * 16384, O_KP = O_HS + 32 * 6 * 16384,
    O_VP = O_KP + (size_t)MP * 256, O_IKP = O_VP + (size_t)MP * 256, O_KS = O_IKP + (size_t)MP * 64, O_VS = O_KS + MS * 256, O_IKS = O_VS + MS * 256,
    O_MK = O_IKS + MS * 64, O_MV = O_MK + 2 * 1024 * 256, O_CVP = O_MV + 2 * 1024 * 256, O_CVS = O_CVP + 2 * 4 * 2 * DFF, O_END = O_CVS + 2 * 32 * 2 * DFF;
static_assert(O_END == 31412224, "output size");
constexpr int RING_OFF = 0, RING_BYTES = 131072;
constexpr int LDSCTL_OFF = RING_BYTES, MISC_OFF = LDSCTL_OFF + 320;
constexpr int LDS_BYTES = 147456;

#define GAS __attribute__((address_space(1)))
#define LAS __attribute__((address_space(3)))
typedef unsigned short bf16;
typedef unsigned v4u __attribute__((ext_vector_type(4)));
typedef float f32x4 __attribute__((ext_vector_type(4)));
typedef short bf16x8 __attribute__((ext_vector_type(8)));
typedef GAS unsigned gu32;
typedef GAS unsigned long long gu64;
#define RLX_AGENT __ATOMIC_RELAXED, __HIP_MEMORY_SCOPE_AGENT
#define LDS_WAIT() asm volatile("s_waitcnt lgkmcnt(0)" ::: "memory")
#define VM_WAIT() asm volatile("s_waitcnt vmcnt(0)" ::: "memory")
__device__ __forceinline__ unsigned long long rt() { return __builtin_amdgcn_s_memrealtime(); }
__device__ __forceinline__ unsigned f2bf(float f) { unsigned u = __builtin_bit_cast(unsigned, f); return (u + 0x7fffu + ((u >> 16) & 1u)) >> 16; }
__device__ __forceinline__ unsigned pk2(float lo, float hi) { return f2bf(lo) | (f2bf(hi) << 16); }

#define XB_TMO      128
#define XB_XCNT(j)  (256  + 64 * (j))
#define XB_XSUB(j)  (1280 + 64 * (j))
#define XB_XGEN(j)  (2304 + 64 * (j))
#define XB_TOP      3328
#define XB_TOPGEN   3392
#define XCD_BAR_WORDS 3456
#define XB_SPIN_CAP (1u << 18)

__device__ __forceinline__ unsigned xb_ld(unsigned* p)              { return __hip_atomic_load(p, __ATOMIC_RELAXED, __HIP_MEMORY_SCOPE_AGENT); }
__device__ __forceinline__ unsigned xb_add(unsigned* p, unsigned v) { return __hip_atomic_fetch_add(p, v, __ATOMIC_RELAXED, __HIP_MEMORY_SCOPE_AGENT); }
__device__ __forceinline__ unsigned xb_xcc_id() { return (unsigned)__builtin_amdgcn_s_getreg((3 << 11) | 20) & 0xFu; }
#define XB_SPIN(cond, bar) do { unsigned _sp = 0; while (cond) { __builtin_amdgcn_s_sleep(1); \
    if ((++_sp & 255u) == 0u) { if (xb_ld(&(bar)[XB_TMO])) break; if (_sp > XB_SPIN_CAP) { atomicAdd(&(bar)[XB_TMO], 1u); break; } } } } while (0)

struct XcdBarrier {
    unsigned* bar; unsigned x;
    volatile LAS unsigned* st;
};

__device__ __forceinline__ XcdBarrier xcd_barrier_post(unsigned* bar, volatile LAS unsigned* st) {
    XcdBarrier b; b.bar = bar; b.x = xb_xcc_id(); b.st = st;
    if (threadIdx.x == 0) (void)xb_add(&bar[XB_XCNT(b.x)], 1u);
    return b;
}
__device__ __forceinline__ void xcd_barrier_complete(unsigned* bar, unsigned x, unsigned& nloc, unsigned& nx) {
    const unsigned G = gridDim.x * gridDim.y * gridDim.z;
    unsigned sum, cnt, mine, sp = 0u;
    for (;;) {
        sum = 0u; cnt = 0u; mine = 0u;
#pragma unroll
        for (unsigned j = 0; j < 16; ++j) { const unsigned c = xb_ld(&bar[XB_XCNT(j)]); sum += c; cnt += (c > 0u) ? 1u : 0u; mine = (j == x) ? c : mine; }
        if (sum == G) break;
        __builtin_amdgcn_s_sleep(1);
        if ((++sp & 255u) == 0u) { if (xb_ld(&bar[XB_TMO])) break; if (sp > XB_SPIN_CAP) { atomicAdd(&bar[XB_TMO], 1u); break; } }
    }
    nloc = mine > 0u ? mine : 1u; nx = cnt > 0u ? cnt : 1u;
}

__device__ __forceinline__ void xcd_barrier(const XcdBarrier& b) {
    asm volatile("s_waitcnt vmcnt(0)" ::: "memory");
    __syncthreads();
    if (threadIdx.x == 0) {
        unsigned* bar = b.bar;
        __builtin_amdgcn_s_waitcnt(0);
        unsigned nloc = b.st[0], nx = b.st[1];
        if (nloc == 0u) { xcd_barrier_complete(bar, b.x, nloc, nx); b.st[0] = nloc; b.st[1] = nx; }
        const unsigned old = xb_add(&bar[XB_XSUB(b.x)], 1u);
        const unsigned gen = old / nloc;
        if (old + 1u == (gen + 1u) * nloc) {
            __builtin_amdgcn_fence(__ATOMIC_RELEASE, "agent");
            asm volatile("s_waitcnt vmcnt(0)" ::: "memory");
            const unsigned og = xb_add(&bar[XB_TOP], 1u);
            const unsigned tg = og / nx;
            if (og + 1u == (tg + 1u) * nx) xb_add(&bar[XB_TOPGEN], 1u);
            else XB_SPIN(xb_ld(&bar[XB_TOPGEN]) == tg, bar);
            __builtin_amdgcn_fence(__ATOMIC_ACQUIRE, "agent");
            xb_add(&bar[XB_XGEN(b.x)], 1u);
            asm volatile("s_waitcnt vmcnt(0)" ::: "memory");
        } else {
            XB_SPIN(xb_ld(&bar[XB_XGEN(b.x)]) == gen, bar);
            __builtin_amdgcn_fence(__ATOMIC_ACQUIRE, "agent");
            asm volatile("s_waitcnt vmcnt(0)" ::: "memory");
        }
    }
    __syncthreads();
}


struct Args { const float* in[29]; const int* page_table; float* out; unsigned char* ws; int ph_lo, ph_hi; };
struct Ctx { LAS unsigned char* lds; volatile LAS unsigned* MISC; gu32* ctl; int tid, lane, wave, vcu, G, qoff; };
typedef float f32x16 __attribute__((ext_vector_type(16)));
typedef unsigned long long u64;

__device__ __forceinline__ float bf2f(unsigned b) { return __builtin_bit_cast(float, b << 16); }
__device__ __forceinline__ float wave_sum(float v) {
#pragma unroll
    for (int o = 1; o < 64; o <<= 1) v += __shfl_xor(v, o);
    return v;
}
__device__ __forceinline__ int crow(int r, int hi) { return (r & 3) + 8 * (r >> 2) + 4 * hi; }
__device__ __forceinline__ float sigmoidf_(float x) { return 1.0f / (1.0f + __expf(-x)); }
__device__ __forceinline__ float* ssptr(const Ctx& c, int i) { return (float*)(c.ctl + CW_SS) + (size_t)i * MT; }

__device__ __forceinline__ int q_next(Ctx& c, int qi) {
    __syncthreads();
    if (c.tid == 0) c.MISC[16] = atomicAdd((unsigned*)(c.ctl + CW_Q + 64 * (qi + c.qoff)), 1u);
    __syncthreads();
    return (int)c.MISC[16];
}

template <int K>
__device__ __forceinline__ f32x16 mm32(const LAS bf16* A, int lda, const LAS bf16* Bt, int ldb, f32x16 acc, int lane) {
    const int r = lane & 31, h = lane >> 5;
#pragma unroll
    for (int ks = 0; ks < K; ks += 16) {
        const bf16x8 a = *(const LAS bf16x8*)(A + r * lda + ks + 8 * h);
        const bf16x8 b = *(const LAS bf16x8*)(Bt + r * ldb + ks + 8 * h);
        acc = __builtin_amdgcn_mfma_f32_32x32x16_bf16(a, b, acc, 0, 0, 0);
    }
    return acc;
}

__device__ __forceinline__ int map_row(int mapid, int n, int row_off) {
    if (mapid == 0) return n + row_off;
    if (mapid == 1) return n < 1864 ? n : n + 56;
    if (mapid == 2) return (n >> 7) * 256 + (n & 127);
    return (n >> 7) * 256 + 128 + (n & 127);
}
__device__ __forceinline__ void transpose_item(const float* W, int K, int N, const float* kscale, bf16* WT, int mapid, int row_off, LAS float* scr, int item, int lane) {
    const int nblk = (N + 31) / 32, kb = item / nblk, nb = item % nblk, k0 = 64 * kb, n0 = 32 * nb;
#pragma unroll 8
    for (int i = 0; i < 32; ++i) { const int kk = 2 * i + (lane >> 5), n = n0 + (lane & 31);
        float v = W[(size_t)(k0 + kk) * N + (n < N ? n : N - 1)]; if (kscale) v *= kscale[k0 + kk];
        scr[kk * 33 + (lane & 31)] = v; }
    LDS_WAIT(); asm volatile("" ::: "memory");
    const int cc = lane & 7;
#pragma unroll
    for (int j = 0; j < 4; ++j) { const int nl = (lane >> 3) + 8 * j, n = n0 + nl; const LAS float* s = scr + (8 * cc) * 33 + nl;
        v4u o; o.x = pk2(s[0 * 33], s[1 * 33]); o.y = pk2(s[2 * 33], s[3 * 33]); o.z = pk2(s[4 * 33], s[5 * 33]); o.w = pk2(s[6 * 33], s[7 * 33]);
        if (n < N) *(GAS v4u*)(WT + (size_t)map_row(mapid, n, row_off) * K + k0 + 8 * cc) = o; }
    LDS_WAIT(); asm volatile("" ::: "memory");
}
__device__ __forceinline__ void p0_prologue(Ctx& c, const Args& a) {
    LAS float* scr = (LAS float*)(c.lds + RING_OFF + c.wave * 16384);
    const int gw = c.vcu * NWAVES + c.wave, NGW = c.G * NWAVES, lane = c.lane;
    unsigned char* ws = a.ws;
    constexpr int I_INH = 16 * 104, I_MKV = 16 * 16, I_DSA = 16 * 67, I_OUT = 16 * 32, I_G = 16 * 88, I_D = 44 * 32;
    constexpr int NITEMS = I_INH + 2 * I_MKV + I_DSA + 2 * I_OUT + 4 * I_G + 2 * I_D;
    for (int it = gw; it < NITEMS; it += NGW) {
        int r = it;
        if (r < I_INH) { transpose_item(a.in[13], 1024, 3328, a.in[11], (bf16*)(ws + WS_WIN0), 0, 0, scr, r, lane); continue; } r -= I_INH;
        if (r < I_MKV) { transpose_item(a.in[20], 1024, 512, nullptr, (bf16*)(ws + WS_WIN0), 0, 3328, scr, r, lane); continue; } r -= I_MKV;
        if (r < I_MKV) { transpose_item(a.in[20] + 1024 * 512, 1024, 512, nullptr, (bf16*)(ws + WS_WIN0), 0, 3840, scr, r, lane); continue; } r -= I_MKV;
        if (r < I_DSA) { transpose_item(a.in[16], 1024, 2120, a.in[11] + 1024, (bf16*)(ws + WS_WIN1), 1, 0, scr, r, lane); continue; } r -= I_DSA;
        if (r < 2 * I_OUT) { const int l = r / I_OUT; transpose_item(a.in[23] + (size_t)l * 1024 * 1024, 1024, 1024, nullptr, (bf16*)(ws + WS_WOUT) + (size_t)l * 1024 * 1024, 0, 0, scr, r % I_OUT, lane); continue; } r -= 2 * I_OUT;
        if (r < 2 * I_G) { const int l = r / I_G; transpose_item(a.in[24] + (size_t)l * 1024 * DFF, 1024, DFF, a.in[12] + l * 1024, (bf16*)(ws + WS_WGU) + (size_t)l * 5632 * 1024, 2, 0, scr, r % I_G, lane); continue; } r -= 2 * I_G;
        if (r < 2 * I_G) { const int l = r / I_G; transpose_item(a.in[25] + (size_t)l * 1024 * DFF, 1024, DFF, a.in[12] + l * 1024, (bf16*)(ws + WS_WGU) + (size_t)l * 5632 * 1024, 3, 0, scr, r % I_G, lane); continue; } r -= 2 * I_G;
        { const int l = r / I_D; transpose_item(a.in[28] + (size_t)l * DFF * 1024, DFF, 1024, nullptr, (bf16*)(ws + WS_WD) + (size_t)l * 1024 * DFF, 0, 0, scr, r % I_D, lane); }
    }
    for (int rr = gw; rr < 184; rr += NGW) { const int row = rr < 56 ? 1864 + rr : 2176 + (rr - 56);
        GAS v4u* p = (GAS v4u*)((bf16*)(ws + WS_WIN1) + (size_t)row * 1024); p[lane] = (v4u){0u, 0u, 0u, 0u}; p[64 + lane] = (v4u){0u, 0u, 0u, 0u}; }
    float* ss0 = ssptr(c, 0);
    for (int m = gw; m < MT + NMEMROWS; m += NGW) {
        GAS u64* o8 = (GAS u64*)((bf16*)(ws + WS_XB) + (size_t)m * DM) + lane;
        if (m >= MVALID && m < MT) {
#pragma unroll
            for (int j = 0; j < 4; ++j) o8[64 * j] = 0ull;
            continue; }
        const float* src = m < MP ? a.in[0] + (size_t)m * DM : (m < MVALID ? a.in[1] + (size_t)(m - MP) * DM : a.in[10] + (size_t)(m - MT) * DM);
        const GAS f32x4* xr = (const GAS f32x4*)src + lane; f32x4 v[4]; float s = 0.f;
#pragma unroll
        for (int j = 0; j < 4; ++j) { v[j] = xr[64 * j]; s += (v[j].x * v[j].x + v[j].y * v[j].y) + (v[j].z * v[j].z + v[j].w * v[j].w); }
        s = wave_sum(s);
#pragma unroll
        for (int j = 0; j < 4; ++j) o8[64 * j] = (u64)pk2(v[j].x, v[j].y) | ((u64)pk2(v[j].z, v[j].w) << 32);
        if (m < MVALID && lane == 0) ss0[m] = s;
    }
}

__device__ __forceinline__ void memattn_unit(Ctx& c, const bf16* Zq  , int ldz, int nrows_valid, const float* Kp, const float* Vp, int kstride,
                                             bool normk, const float* kgain, const float* qgain, bf16* Out  ) {
    LAS bf16* KN = (LAS bf16*)(c.lds);
    LAS bf16* VTm = (LAS bf16*)(c.lds + 36864);
    LAS bf16* QN = (LAS bf16*)(c.lds + 70656) + c.wave * (32 * 72);
    LAS float* LI = (LAS float*)(c.lds + 107520) + c.wave * 32;
    int tid = c.tid; asm volatile("" : "+v"(tid));
    const int lane = tid & 63, w = c.wave;
    {
        const int m = tid >> 1, dh = (tid & 1) * 32;
        f32x4 kv[8]; float s = 0.f;
#pragma unroll
        for (int j = 0; j < 8; ++j) { kv[j] = *(const f32x4*)(Kp + (size_t)m * kstride + dh + 4 * j); s += (kv[j].x * kv[j].x + kv[j].y * kv[j].y) + (kv[j].z * kv[j].z + kv[j].w * kv[j].w); }
        s += __shfl_xor(s, 1);
        const float rs = normk ? rsqrtf(s * (1.0f / 64.0f) + EPS) : 1.0f;
#pragma unroll
        for (int j = 0; j < 8; j += 2) { f32x4 g0 = {1.f, 1.f, 1.f, 1.f}, g1 = g0;
            if (normk) { g0 = *(const f32x4*)(kgain + dh + 4 * j); g1 = *(const f32x4*)(kgain + dh + 4 * j + 4); }
            const f32x4 x0 = kv[j] * rs * g0, x1 = kv[j + 1] * rs * g1;
            v4u o; o.x = pk2(x0.x, x0.y); o.y = pk2(x0.z, x0.w); o.z = pk2(x1.x, x1.y); o.w = pk2(x1.z, x1.w);
            *(LAS v4u*)(KN + m * 72 + dh + 4 * j) = o; }
#pragma unroll
        for (int j = 0; j < 8; ++j) { const f32x4 vv = *(const f32x4*)(Vp + (size_t)m * kstride + dh + 4 * j);
            VTm[(dh + 4 * j + 0) * 264 + m] = (bf16)f2bf(vv.x); VTm[(dh + 4 * j + 1) * 264 + m] = (bf16)f2bf(vv.y);
            VTm[(dh + 4 * j + 2) * 264 + m] = (bf16)f2bf(vv.z); VTm[(dh + 4 * j + 3) * 264 + m] = (bf16)f2bf(vv.w); }
    }
    {
        const int row = lane >> 1, hf = lane & 1, grow = w * 32 + row;
        float x[32]; float s = 0.f;
        if (grow < nrows_valid) {
#pragma unroll
            for (int j = 0; j < 4; ++j) { const v4u q = *(const v4u*)(Zq + (size_t)grow * ldz + hf * 32 + 8 * j);
                x[8 * j + 0] = bf2f(q.x & 0xffffu); x[8 * j + 1] = bf2f(q.x >> 16); x[8 * j + 2] = bf2f(q.y & 0xffffu); x[8 * j + 3] = bf2f(q.y >> 16);
                x[8 * j + 4] = bf2f(q.z & 0xffffu); x[8 * j + 5] = bf2f(q.z >> 16); x[8 * j + 6] = bf2f(q.w & 0xffffu); x[8 * j + 7] = bf2f(q.w >> 16); }
        } else {
#pragma unroll
            for (int j = 0; j < 32; ++j) x[j] = 0.f;
        }
#pragma unroll
        for (int j = 0; j < 32; ++j) s += x[j] * x[j];
        s += __shfl_xor(s, 1);
        const float rs = rsqrtf(s * (1.0f / 64.0f) + EPS) * 0.125f;
#pragma unroll
        for (int j = 0; j < 32; j += 8) { v4u o;
            o.x = pk2(x[j] * rs * qgain[hf * 32 + j], x[j + 1] * rs * qgain[hf * 32 + j + 1]); o.y = pk2(x[j + 2] * rs * qgain[hf * 32 + j + 2], x[j + 3] * rs * qgain[hf * 32 + j + 3]);
            o.z = pk2(x[j + 4] * rs * qgain[hf * 32 + j + 4], x[j + 5] * rs * qgain[hf * 32 + j + 5]); o.w = pk2(x[j + 6] * rs * qgain[hf * 32 + j + 6], x[j + 7] * rs * qgain[hf * 32 + j + 7]);
            *(LAS v4u*)(QN + row * 72 + hf * 32 + j) = o; }
    }
    __syncthreads();
    if (w * 32 < nrows_valid) {
        const int r32 = lane & 31, hh = lane >> 5;
        f32x16 s[8];
#pragma unroll
        for (int mt = 0; mt < 8; ++mt) { f32x16 z = {}; s[mt] = mm32<64>(KN + mt * 32 * 72, 72, QN, 72, z, lane); }
        float mx = -1e30f;
#pragma unroll
        for (int mt = 0; mt < 8; ++mt)
#pragma unroll
            for (int r = 0; r < 16; ++r) mx = fmaxf(mx, s[mt][r]);
        mx = fmaxf(mx, __shfl_xor(mx, 32));
        float l = 0.f;
#pragma unroll
        for (int mt = 0; mt < 8; ++mt)
#pragma unroll
            for (int r = 0; r < 16; ++r) { const float p = __expf(s[mt][r] - mx); s[mt][r] = p; l += p; }
        l += __shfl_xor(l, 32);
        if (hh == 0) LI[r32] = l;
        f32x16 o[2] = {};
#pragma unroll
        for (int mt = 0; mt < 8; ++mt)
#pragma unroll
            for (int sx = 0; sx < 2; ++sx) {
                v4u pa; pa.x = pk2(s[mt][8 * sx + 0], s[mt][8 * sx + 1]); pa.y = pk2(s[mt][8 * sx + 2], s[mt][8 * sx + 3]);
                pa.z = pk2(s[mt][8 * sx + 4], s[mt][8 * sx + 5]); pa.w = pk2(s[mt][8 * sx + 6], s[mt][8 * sx + 7]);
                const bf16x8 af = __builtin_bit_cast(bf16x8, pa);
#pragma unroll
                for (int dt = 0; dt < 2; ++dt) { const LAS bf16* vp = VTm + (dt * 32 + r32) * 264 + mt * 32 + 16 * sx + 4 * hh;
                    const u64 lo = *(const LAS u64*)vp, hi = *(const LAS u64*)(vp + 8);
                    v4u bw; bw.x = (unsigned)lo; bw.y = (unsigned)(lo >> 32); bw.z = (unsigned)hi; bw.w = (unsigned)(hi >> 32);
                    o[dt] = __builtin_amdgcn_mfma_f32_32x32x16_bf16(af, __builtin_bit_cast(bf16x8, bw), o[dt], 0, 0, 0); }
            }
        LDS_WAIT();
#pragma unroll
        for (int r = 0; r < 16; ++r) { const int qr = crow(r, hh), grow = w * 32 + qr; const float il = 1.0f / LI[qr];
            if (grow < nrows_valid) {
#pragma unroll
                for (int dt = 0; dt < 2; ++dt) Out[(size_t)grow * DM + dt * 32 + r32] = (bf16)f2bf(o[dt][r] * il); } }
    }
}

constexpr int HG_GS = 4, HG_NG = SEQ / (32 * HG_GS);
constexpr size_t WS_HOL = WS_U, WS_HQC = WS_UP, WS_HUT = WS_ACT, WS_HST = WS_ACT + 64 * MiB, WS_HDG = WS_ACT + 50 * MiB;
template <bool PROMPT>
__device__ __forceinline__ void hgrn_unit(Ctx& c, const Args& a, int b, int h, int g) {
    LAS unsigned char* L = c.lds;
    LAS float* LF = (LAS float*)(L + 0);
    LAS float* BL = (LAS float*)(L + 16384);
    LAS float* DVv = (LAS float*)(L + 16896);
    LAS bf16* QD = (LAS bf16*)(L + 17408);
    LAS bf16* KD = (LAS bf16*)(L + 26112);
    LAS bf16* KET = (LAS bf16*)(L + 34816);
    LAS bf16* VT = (LAS bf16*)(L + 45056);
    LAS bf16* SCB = (LAS bf16*)(L + 55296);
    LAS bf16* STt = (LAS bf16*)(L + 57856);
    LAS float* BOFF = (LAS float*)(L + 92672);
    int tid = c.tid; asm volatile("" : "+v"(tid));
    const int lane = tid & 63, w = c.wave, r32 = lane & 31, hh = lane >> 5;
    const int te = tid >> 4, k8 = (tid & 15) * 8;
    const bf16* Z = (const bf16*)(a.ws + WS_Z);
    bf16* MIX = (bf16*)(a.ws + WS_MIX);
    const int nch = PROMPT ? HG_GS : 1, nvalid = PROMPT ? 32 : 4;
    const int kt = w >> 1, vt0 = 2 * (w & 1);
    const int unit = (b * 6 + h) * HG_NG + g;
    f32x16 S0 = {}, S1 = {};
    if (!PROMPT) { const float* sp = a.in[7] + (size_t)(b * 6 + h) * 16384;
#pragma unroll
        for (int r = 0; r < 16; ++r) { const int k = 32 * kt + crow(r, hh); S0[r] = sp[k * 128 + 32 * vt0 + r32]; S1[r] = sp[k * 128 + 32 * (vt0 + 1) + r32]; } }
    float lbv[8], onv[8];
#pragma unroll
    for (int j = 0; j < 8; ++j) { const float l0 = a.in[14][h * 128 + k8 + j], l1 = a.in[14][768 + h * 128 + k8 + j]; lbv[j] = 1.0f / (1.0f + __expf(l1 - l0)); onv[j] = a.in[15][k8 + j]; }
    __syncthreads();
    if (tid < 128) BOFF[tid] = 0.f;
#define HG_WRITE_ST() do { _Pragma("unroll") for (int g4 = 0; g4 < 4; ++g4) { const int k0 = 32 * kt + 8 * g4 + 4 * hh; \
        *(LAS u64*)(STt + (32 * vt0 + r32) * 136 + k0) = (u64)pk2(S0[4 * g4], S0[4 * g4 + 1]) | ((u64)pk2(S0[4 * g4 + 2], S0[4 * g4 + 3]) << 32); \
        *(LAS u64*)(STt + (32 * (vt0 + 1) + r32) * 136 + k0) = (u64)pk2(S1[4 * g4], S1[4 * g4 + 1]) | ((u64)pk2(S1[4 * g4 + 2], S1[4 * g4 + 3]) << 32); } } while (0)
    HG_WRITE_ST();
#pragma unroll 1
    for (int ch = 0; ch < nch; ++ch) {
        const int row0 = PROMPT ? b * SEQ + (g * HG_GS + ch) * 32 : MP + 4 * b, row = row0 + te;
        const bool valid = te < nvalid;
        float qs[8], kk[8]; v4u gz = {0u, 0u, 0u, 0u};
        {
            v4u zq = {0u, 0u, 0u, 0u}, zf = zq, zi = zq;
            if (valid) { const bf16* zr = Z + (size_t)row * ZC0 + h * 128 + k8;
                zq = *(const v4u*)zr; zf = *(const v4u*)(zr + 768); zi = *(const v4u*)(zr + 1536); if (!PROMPT) gz = *(const v4u*)(zr + 2304); }
            const unsigned qw[4] = {zq.x, zq.y, zq.z, zq.w}, fw[4] = {zf.x, zf.y, zf.z, zf.w}, iw[4] = {zi.x, zi.y, zi.z, zi.w};
            float lf[8];
#pragma unroll
            for (int j = 0; j < 8; ++j) { const float q = bf2f((qw[j >> 1] >> (16 * (j & 1))) & 0xffffu), fp = bf2f((fw[j >> 1] >> (16 * (j & 1))) & 0xffffu);
                const float sg = sigmoidf_(fp), f = lbv[j] + (1.0f - lbv[j]) * sg;
                qs[j] = valid ? q * sigmoidf_(q) : 0.f; kk[j] = valid ? (1.0f - f) : 0.f; lf[j] = valid ? __logf(f) : 0.f;
                VT[(k8 + j) * 40 + te] = (bf16)((iw[j >> 1] >> (16 * (j & 1))) & 0xffffu); }
            *(LAS f32x4*)(LF + te * 128 + k8) = (f32x4){lf[0], lf[1], lf[2], lf[3]}; *(LAS f32x4*)(LF + te * 128 + k8 + 4) = (f32x4){lf[4], lf[5], lf[6], lf[7]};
        }
        __syncthreads();
        if (tid < 128) { float bsum = 0.f;
#pragma unroll
            for (int t = 0; t < 32; ++t) { bsum += LF[t * 128 + tid]; LF[t * 128 + tid] = bsum; }
            BL[tid] = bsum; }
        __syncthreads();
        {
            const f32x4 b0 = *(const LAS f32x4*)(LF + te * 128 + k8), b1 = *(const LAS f32x4*)(LF + te * 128 + k8 + 4);
            const f32x4 l0 = *(const LAS f32x4*)(BL + k8), l1 = *(const LAS f32x4*)(BL + k8 + 4);
            const float bb[8] = {b0.x, b0.y, b0.z, b0.w, b1.x, b1.y, b1.z, b1.w}, bl[8] = {l0.x, l0.y, l0.z, l0.w, l1.x, l1.y, l1.z, l1.w};
            float qd[8], kd[8];
#pragma unroll
            for (int j = 0; j < 8; ++j) { qd[j] = qs[j] * __expf(bb[j]); kd[j] = kk[j] * __expf(-bb[j]); KET[(k8 + j) * 40 + te] = (bf16)f2bf(kk[j] * __expf(bl[j] - bb[j])); }
            v4u o; o.x = pk2(qd[0], qd[1]); o.y = pk2(qd[2], qd[3]); o.z = pk2(qd[4], qd[5]); o.w = pk2(qd[6], qd[7]); *(LAS v4u*)(QD + te * 136 + k8) = o;
            if (PROMPT) { const f32x4 f0 = *(const LAS f32x4*)(BOFF + k8), f1 = *(const LAS f32x4*)(BOFF + k8 + 4);
                const float bo[8] = {f0.x, f0.y, f0.z, f0.w, f1.x, f1.y, f1.z, f1.w}; float qc[8];
#pragma unroll
                for (int j = 0; j < 8; ++j) qc[j] = qd[j] * __expf(bo[j]);
                v4u oc; oc.x = pk2(qc[0], qc[1]); oc.y = pk2(qc[2], qc[3]); oc.z = pk2(qc[4], qc[5]); oc.w = pk2(qc[6], qc[7]);
                *(v4u*)((bf16*)(a.ws + WS_HQC) + (size_t)row * 768 + h * 128 + k8) = oc; }
            o.x = pk2(kd[0], kd[1]); o.y = pk2(kd[2], kd[3]); o.z = pk2(kd[4], kd[5]); o.w = pk2(kd[6], kd[7]); *(LAS v4u*)(KD + te * 136 + k8) = o;
            if (te == 0) {
#pragma unroll
                for (int j = 0; j < 8; ++j) DVv[k8 + j] = __expf(bl[j]); }
        }
        __syncthreads();
        f32x16 oacc = {};
        if (w == 0) { f32x16 z = {}; const f32x16 sc = mm32<128>(QD, 136, KD, 136, z, lane);
#pragma unroll
            for (int r = 0; r < 16; ++r) { const int t = crow(r, hh); SCB[t * 40 + r32] = (bf16)f2bf(r32 <= t ? sc[r] : 0.f); } }
        if (w < 4) oacc = mm32<128>(QD, 136, STt + (w * 32) * 136, 136, oacc, lane);
        if (PROMPT && tid >= 384) BOFF[tid - 384] += BL[tid - 384];
        __syncthreads();
        if (w < 4) { oacc = mm32<32>(SCB, 40, VT + (w * 32) * 40, 40, oacc, lane);
#pragma unroll
            for (int r = 0; r < 16; ++r) LF[crow(r, hh) * 128 + w * 32 + r32] = oacc[r]; }
        {
#pragma unroll
            for (int r = 0; r < 16; ++r) { const float d = DVv[32 * kt + crow(r, hh)]; S0[r] *= d; S1[r] *= d; }
            S0 = mm32<32>(KET + (kt * 32) * 40, 40, VT + (vt0 * 32) * 40, 40, S0, lane);
            S1 = mm32<32>(KET + (kt * 32) * 40, 40, VT + ((vt0 + 1) * 32) * 40, 40, S1, lane);
        }
        __syncthreads();
        HG_WRITE_ST();
        {
            const f32x4 o0 = *(const LAS f32x4*)(LF + te * 128 + k8), o1 = *(const LAS f32x4*)(LF + te * 128 + k8 + 4);
            if (PROMPT) { float* ol = (float*)(a.ws + WS_HOL) + (size_t)row * 768 + h * 128 + k8; *(f32x4*)ol = o0; *(f32x4*)(ol + 4) = o1; }
            else {
                float ov[8] = {o0.x, o0.y, o0.z, o0.w, o1.x, o1.y, o1.z, o1.w}; float s = 0.f;
#pragma unroll
                for (int j = 0; j < 8; ++j) s += ov[j] * ov[j];
                s += __shfl_xor(s, 1); s += __shfl_xor(s, 2); s += __shfl_xor(s, 4); s += __shfl_xor(s, 8);
                const float rs = rsqrtf(s * (1.0f / 128.0f) + EPS);
                const unsigned gw_[4] = {gz.x, gz.y, gz.z, gz.w}; float y[8];
#pragma unroll
                for (int j = 0; j < 8; ++j) { const float gg = bf2f((gw_[j >> 1] >> (16 * (j & 1))) & 0xffffu); y[j] = ov[j] * rs * onv[j] * (gg * sigmoidf_(gg)); }
                if (valid) { v4u o; o.x = pk2(y[0], y[1]); o.y = pk2(y[2], y[3]); o.z = pk2(y[4], y[5]); o.w = pk2(y[6], y[7]); *(v4u*)(MIX + (size_t)row * DM + h * 128 + k8) = o; }
            }
        }
        __syncthreads();
    }
#undef HG_WRITE_ST
    if (PROMPT) {
        float* ut = (float*)(a.ws + WS_HUT) + (size_t)unit * 16384;
#pragma unroll
        for (int g4 = 0; g4 < 4; ++g4) { const int k0 = 32 * kt + 8 * g4 + 4 * hh;
            *(f32x4*)(ut + (32 * vt0 + r32) * 128 + k0) = (f32x4){S0[4 * g4], S0[4 * g4 + 1], S0[4 * g4 + 2], S0[4 * g4 + 3]};
            *(f32x4*)(ut + (32 * (vt0 + 1) + r32) * 128 + k0) = (f32x4){S1[4 * g4], S1[4 * g4 + 1], S1[4 * g4 + 2], S1[4 * g4 + 3]}; }
        if (tid < 128) ((float*)(a.ws + WS_HDG))[(size_t)unit * 128 + tid] = __expf(BOFF[tid]);
    } else {
        float* so = a.out + O_HS + (size_t)(b * 6 + h) * 16384;
#pragma unroll
        for (int r = 0; r < 16; ++r) { const int k = 32 * kt + crow(r, hh); so[k * 128 + 32 * vt0 + r32] = S0[r]; so[k * 128 + 32 * (vt0 + 1) + r32] = S1[r]; }
    }
}
__device__ __forceinline__ void hgrn_scan(Ctx& c, const Args& a) {
    const float* UT = (const float*)(a.ws + WS_HUT); const float* DG = (const float*)(a.ws + WS_HDG); bf16* STo = (bf16*)(a.ws + WS_HST);
    for (int idx = c.vcu * 512 + c.tid; idx < 24 * 16384; idx += c.G * 512) {
        const int bh = idx >> 14, e = idx & 16383, k = e & 127, v = e >> 7;
        float s = 0.f;
#pragma unroll 8
        for (int g = 0; g < HG_NG; ++g) { const size_t u = (size_t)(bh * HG_NG + g); STo[u * 16384 + e] = (bf16)f2bf(s); s = DG[u * 128 + k] * s + UT[u * 16384 + e]; }
        a.out[O_HP + (size_t)bh * 16384 + k * 128 + v] = s;
    }
}
__device__ __forceinline__ void hgrn_fix_unit(Ctx& c, const Args& a, int b, int h, int g) {
    LAS bf16* STt = (LAS bf16*)(c.lds);
    LAS bf16* QCl = (LAS bf16*)(c.lds + 34816);
    LAS float* OB = (LAS float*)(c.lds + 34816 + 17408);
    int tid = c.tid; asm volatile("" : "+v"(tid));
    const int lane = tid & 63, w = c.wave, r32 = lane & 31, hh = lane >> 5;
    const int unit = (b * 6 + h) * HG_NG + g, row0 = b * SEQ + g * 128;
    const bf16* Z = (const bf16*)(a.ws + WS_Z); bf16* MIX = (bf16*)(a.ws + WS_MIX);
    const bf16* QC = (const bf16*)(a.ws + WS_HQC); const float* OL = (const float*)(a.ws + WS_HOL);
    const bf16* stg = (const bf16*)(a.ws + WS_HST) + (size_t)unit * 16384;
    __syncthreads();
#pragma unroll
    for (int i = 0; i < 4; ++i) { const int cidx = tid + 512 * i, v = cidx >> 4, kc = (cidx & 15) * 8; *(LAS v4u*)(STt + v * 136 + kc) = *(const v4u*)(stg + v * 128 + kc); }
    const int te = tid >> 4, k8 = (tid & 15) * 8;
    float onv[8];
#pragma unroll
    for (int j = 0; j < 8; ++j) onv[j] = a.in[15][k8 + j];
#pragma unroll 1
    for (int hf = 0; hf < 2; ++hf) {
        const int rb = row0 + hf * 64;
#pragma unroll
        for (int i = 0; i < 2; ++i) { const int cidx = tid + 512 * i, r = cidx >> 4, kc = (cidx & 15) * 8; *(LAS v4u*)(QCl + r * 136 + kc) = *(const v4u*)(QC + (size_t)(rb + r) * 768 + h * 128 + kc); }
        __syncthreads();
        { const int rt = w >> 2, vt = w & 3; f32x16 o = {};
          o = mm32<128>(QCl + (rt * 32) * 136, 136, STt + (vt * 32) * 136, 136, o, lane);
#pragma unroll
          for (int r = 0; r < 16; ++r) OB[(rt * 32 + crow(r, hh)) * 128 + vt * 32 + r32] = o[r]; }
        __syncthreads();
#pragma unroll
        for (int ps = 0; ps < 2; ++ps) { const int r = ps * 32 + te, row = rb + r;
            const f32x4 c0 = *(const LAS f32x4*)(OB + r * 128 + k8), c1 = *(const LAS f32x4*)(OB + r * 128 + k8 + 4);
            const float* ol = OL + (size_t)row * 768 + h * 128 + k8; const f32x4 l0 = *(const f32x4*)ol, l1 = *(const f32x4*)(ol + 4);
            const v4u gz = *(const v4u*)(Z + (size_t)row * ZC0 + 2304 + h * 128 + k8);
            float ov[8] = {c0.x + l0.x, c0.y + l0.y, c0.z + l0.z, c0.w + l0.w, c1.x + l1.x, c1.y + l1.y, c1.z + l1.z, c1.w + l1.w}; float s = 0.f;
#pragma unroll
            for (int j = 0; j < 8; ++j) s += ov[j] * ov[j];
            s += __shfl_xor(s, 1); s += __shfl_xor(s, 2); s += __shfl_xor(s, 4); s += __shfl_xor(s, 8);
            const float rs = rsqrtf(s * (1.0f / 128.0f) + EPS);
            const unsigned gw_[4] = {gz.x, gz.y, gz.z, gz.w}; float y[8];
#pragma unroll
            for (int j = 0; j < 8; ++j) { const float gg = bf2f((gw_[j >> 1] >> (16 * (j & 1))) & 0xffffu); y[j] = ov[j] * rs * onv[j] * (gg * sigmoidf_(gg)); }
            v4u o; o.x = pk2(y[0], y[1]); o.y = pk2(y[2], y[3]); o.z = pk2(y[4], y[5]); o.w = pk2(y[6], y[7]); *(v4u*)(MIX + (size_t)row * DM + h * 128 + k8) = o; }
        __syncthreads();
    }
}

__device__ __forceinline__ void memkv_finalize_row(const Args& a, int layer, int row, int lane) {
    const float* src = (const float*)(a.ws + WS_MEMKV) + (size_t)row * 1024 + layer * 512;
    const int hd = lane >> 4, d4 = (lane & 15) * 4;
    const f32x4 k = *(const f32x4*)(src + hd * 64 + d4), v = *(const f32x4*)(src + 256 + hd * 64 + d4);
    float s = (k.x * k.x + k.y * k.y) + (k.z * k.z + k.w * k.w);
    s += __shfl_xor(s, 1); s += __shfl_xor(s, 2); s += __shfl_xor(s, 4); s += __shfl_xor(s, 8);
    const float rs = rsqrtf(s * (1.0f / 64.0f) + EPS); const f32x4 g = *(const f32x4*)(a.in[22] + layer * 64 + d4);
    *(f32x4*)(a.out + O_MK + ((size_t)layer * 1024 + row) * 256 + hd * 64 + d4) = k * rs * g;
    *(f32x4*)(a.out + O_MV + ((size_t)layer * 1024 + row) * 256 + hd * 64 + d4) = v;
}

__device__ __forceinline__ void memattn_prompt_unit(Ctx& c, const Args& a, int layer, int u) {
    const int blk = u & 15, hd = (u >> 4) & 3, b = u >> 6;
    const bf16* Z = (const bf16*)(a.ws + WS_Z); const int ldz = layer ? ZC1 : ZC0, qc = layer ? Z1_MQ : 3072;
    const float* kv = (const float*)(a.ws + WS_MEMKV) + (size_t)(b * 256) * 1024 + layer * 512 + hd * 64;
    const int row0 = b * SEQ + blk * 256;
    memattn_unit(c, Z + (size_t)row0 * ldz + qc + hd * 64, ldz, 256, kv, kv + 256, 1024, true, a.in[22] + layer * 64, a.in[21] + layer * 64,
                 (bf16*)(a.ws + WS_MIX) + (size_t)row0 * DM + 768 + hd * 64);
}
__device__ __forceinline__ void memattn_sample_unit(Ctx& c, const Args& a, int layer, int u) {
    const int hd = u & 3, sb = u >> 2;
    const bf16* Z = (const bf16*)(a.ws + WS_Z); const int ldz = layer ? ZC1 : ZC0, qc = layer ? Z1_MQ : 3072;
    const size_t off = ((size_t)(layer * 32 + sb) * 256) * 256 + hd * 64;
    const int row0 = MP + sb * 4;
    memattn_unit(c, Z + (size_t)row0 * ldz + qc + hd * 64, ldz, 4, a.in[5] + off, a.in[6] + off, 256, false, nullptr, a.in[21] + layer * 64,
                 (bf16*)(a.ws + WS_MIX) + (size_t)row0 * DM + 768 + hd * 64);
}

__device__ __forceinline__ void p2_mixer0(Ctx& c, const Args& a) {
    constexpr int U_HP = 24 * HG_NG, U_MAP = U_HP + 256, U_HS = U_MAP + 192, U_MAS = U_HS + 128, U_FIN = U_MAS + 256;
    for (;;) {
        const int u = q_next(c, 0);
        if (u >= U_FIN) break;
        if (u < U_HP) hgrn_unit<true>(c, a, u / (6 * HG_NG), (u / HG_NG) % 6, u % HG_NG);
        else if (u < U_MAP) memattn_prompt_unit(c, a, 0, u - U_HP);
        else if (u < U_HS) { const int v = u - U_MAP; hgrn_unit<false>(c, a, v / 6, v % 6, 0); }
        else if (u < U_MAS) memattn_sample_unit(c, a, 0, u - U_HS);
        else { const int v = (u - U_MAS) * 8 + c.wave; memkv_finalize_row(a, v >> 10, v & 1023, c.lane); }
    }
}
__device__ __forceinline__ void p2c_hgrn_fix(Ctx& c, const Args& a) {
    for (int u = c.vcu; u < 24 * HG_NG; u += c.G) hgrn_fix_unit(c, a, u / (6 * HG_NG), (u / HG_NG) % 6, u % HG_NG);
}

__device__ __forceinline__ void p5_convact(Ctx& c, const Args& a, int layer) {
    const bf16* U = (const bf16*)(a.ws + WS_U); const bf16* UP = (const bf16*)(a.ws + WS_UP); bf16* ACT = (bf16*)(a.ws + WS_ACT);
    const float* cw = a.in[26] + (size_t)layer * 3 * DFF; const float* cb = a.in[27] + (size_t)layer * DFF; const float* cst = a.in[8] + (size_t)layer * 32 * 2 * DFF;
    constexpr int CPR = DFF / 8, NG = MVALID / 4;
    const int total = NG * CPR;
#pragma unroll 1
    for (int i = c.vcu * 512 + c.tid; i < total; i += c.G * 512) {
        const int g = i / CPR, c8 = (i - g * CPR) * 8, r0 = g * 4;
        const bool smp = r0 >= MP; const bool first = smp || (r0 & 4095) == 0;
        const int rm2 = first ? r0 : r0 - 2, rm1 = first ? r0 : r0 - 1;
        v4u ur[6], pr[4];
        ur[0] = *(const v4u*)(U + (size_t)rm2 * DFF + c8); ur[1] = *(const v4u*)(U + (size_t)rm1 * DFF + c8);
#pragma unroll
        for (int k = 0; k < 4; ++k) { ur[2 + k] = *(const v4u*)(U + (size_t)(r0 + k) * DFF + c8); pr[k] = *(const v4u*)(UP + (size_t)(r0 + k) * DFF + c8); }
        const f32x4 w0a = *(const f32x4*)(cw + c8), w0b = *(const f32x4*)(cw + c8 + 4), w1a = *(const f32x4*)(cw + DFF + c8), w1b = *(const f32x4*)(cw + DFF + c8 + 4),
                    w2a = *(const f32x4*)(cw + 2 * DFF + c8), w2b = *(const f32x4*)(cw + 2 * DFF + c8 + 4), cba = *(const f32x4*)(cb + c8), cbb = *(const f32x4*)(cb + c8 + 4);
        const float w0[8] = {w0a.x, w0a.y, w0a.z, w0a.w, w0b.x, w0b.y, w0b.z, w0b.w}, w1[8] = {w1a.x, w1a.y, w1a.z, w1a.w, w1b.x, w1b.y, w1b.z, w1b.w},
                    w2[8] = {w2a.x, w2a.y, w2a.z, w2a.w, w2b.x, w2b.y, w2b.z, w2b.w}, bb[8] = {cba.x, cba.y, cba.z, cba.w, cbb.x, cbb.y, cbb.z, cbb.w};
        float uf[6][8];
#pragma unroll
        for (int k = 0; k < 6; ++k) { const unsigned xw[4] = {ur[k].x, ur[k].y, ur[k].z, ur[k].w};
#pragma unroll
            for (int j = 0; j < 8; ++j) uf[k][j] = bf2f((xw[j >> 1] >> (16 * (j & 1))) & 0xffffu); }
        if (first) {
            if (smp) { const float* s0 = cst + (size_t)(((r0 - MP) >> 2) * 2) * DFF + c8;
#pragma unroll
                for (int j = 0; j < 8; ++j) { uf[0][j] = s0[j]; uf[1][j] = s0[DFF + j]; } }
            else {
#pragma unroll
                for (int j = 0; j < 8; ++j) { uf[0][j] = 0.f; uf[1][j] = 0.f; } }
        }
#pragma unroll
        for (int k = 0; k < 4; ++k) { const unsigned pw[4] = {pr[k].x, pr[k].y, pr[k].z, pr[k].w}; float y[8];
#pragma unroll
            for (int j = 0; j < 8; ++j) { const float cv = bb[j] + w0[j] * uf[k][j] + w1[j] * uf[k + 1][j] + w2[j] * uf[k + 2][j]; y[j] = cv * sigmoidf_(cv) * bf2f((pw[j >> 1] >> (16 * (j & 1))) & 0xffffu); }
            v4u o; o.x = pk2(y[0], y[1]); o.y = pk2(y[2], y[3]); o.z = pk2(y[4], y[5]); o.w = pk2(y[6], y[7]);
            *(v4u*)(ACT + (size_t)(r0 + k) * DFF + c8) = o; }
    }
    for (int i = c.vcu * 512 + c.tid; i < (MT - MVALID) * CPR; i += c.G * 512)
        *(v4u*)(ACT + (size_t)(MVALID + i / CPR) * DFF + (i % CPR) * 8) = (v4u){0u, 0u, 0u, 0u};
}


struct SgArgs { const bf16* A; const bf16* Bt; int K; int mode; bf16* Z; int ldz; const float* ssin; const float* resid; float* y; bf16* xb; float* ssout; bf16* U; bf16* UP; float* cvs; };
__device__ __forceinline__ void sgemm_unit(Ctx& c, const SgArgs& g, int n0) {
    int tid = c.tid; asm volatile("" : "+v"(tid));
    const int lane = tid & 63, w = c.wave, r32 = lane & 31, hh = lane >> 5;
    const int K = g.K, ks = K >> 3;
    const bf16* bp = g.Bt + (size_t)(n0 + r32) * K + w * ks + 8 * hh;
    const bf16* ap = g.A + (size_t)r32 * K + w * ks + 8 * hh;
    f32x16 acc[4] = {};
    bf16x8 afA[4][2], bfA[2], afB[4][2], bfB[2];
#define SG_LOAD(AF, BF, kk) do { _Pragma("unroll") for (int i = 0; i < 2; ++i) { BF[i] = *(const bf16x8*)(bp + (kk) + 16 * i); \
        _Pragma("unroll") for (int rt = 0; rt < 4; ++rt) AF[rt][i] = *(const bf16x8*)(ap + (size_t)(rt * 32) * K + (kk) + 16 * i); } } while (0)
#define SG_MMA(AF, BF) do { _Pragma("unroll") for (int i = 0; i < 2; ++i) _Pragma("unroll") for (int rt = 0; rt < 4; ++rt) acc[rt] = __builtin_amdgcn_mfma_f32_32x32x16_bf16(AF[rt][i], BF[i], acc[rt], 0, 0, 0); } while (0)
    SG_LOAD(afA, bfA, 0);
#pragma unroll 1
    for (int k = 0; k < ks; k += 64) {
        if (k + 32 < ks) SG_LOAD(afB, bfB, k + 32);
        SG_MMA(afA, bfA);
        if (k + 32 < ks) { if (k + 64 < ks) SG_LOAD(afA, bfA, k + 64); SG_MMA(afB, bfB); }
    }
#undef SG_LOAD
#undef SG_MMA
    LAS float* RED = (LAS float*)(c.lds);
    __syncthreads();
#pragma unroll
    for (int rt = 0; rt < 4; ++rt)
#pragma unroll
        for (int r = 0; r < 16; ++r) RED[((w * 4 + rt) * 16 + r) * 64 + lane] = acc[rt][r];
    __syncthreads();
    const int rt = w & 3, rh = w >> 2, col = n0 + r32;
    float v[8];
#pragma unroll
    for (int i = 0; i < 8; ++i) { float s = 0.f;
#pragma unroll
        for (int ww = 0; ww < 8; ++ww) s += RED[((ww * 4 + rt) * 16 + 8 * rh + i) * 64 + lane];
        v[i] = s; }
    if (g.mode == 0) {
#pragma unroll
        for (int i = 0; i < 8; ++i) { const int row = MP + rt * 32 + crow(8 * rh + i, hh); const float rs = rsqrtf(g.ssin[row] * (1.0f / DM) + EPS); g.Z[(size_t)row * g.ldz + col] = (bf16)f2bf(v[i] * rs); }
    } else if (g.mode == 1) {
#pragma unroll
        for (int i = 0; i < 8; ++i) { const int lr = rt * 32 + crow(8 * rh + i, hh), row = MP + lr; const float x = v[i] + g.resid[(size_t)lr * DM + col];
            g.y[(size_t)lr * DM + col] = x; if (g.xb) g.xb[(size_t)row * DM + col] = (bf16)f2bf(x);
            float s = x * x; s += __shfl_xor(s, 1); s += __shfl_xor(s, 2); s += __shfl_xor(s, 4); s += __shfl_xor(s, 8); s += __shfl_xor(s, 16);
            if (g.ssout && r32 == 0) atomicAdd(g.ssout + row, s); }
    } else {
        const bool isup = (col & 128) != 0; const int fc = (col >> 8) * 128 + (col & 127); bf16* dst = isup ? g.UP : g.U;
#pragma unroll
        for (int i = 0; i < 8; ++i) { const int lr = rt * 32 + crow(8 * rh + i, hh), row = MP + lr; const float rs = rsqrtf(g.ssin[row] * (1.0f / DM) + EPS); const float x = v[i] * rs;
            dst[(size_t)row * DFF + fc] = (bf16)f2bf(x);
            if (!isup && (lr & 3) >= 2) g.cvs[(size_t)((lr >> 2) * 2 + (lr & 3) - 2) * DFF + fc] = x; }
    }
}
__device__ __forceinline__ void sgemm_phase(Ctx& c, const SgArgs& g, int N) {
#pragma unroll 1
    for (int u = c.G - 1 - (int)blockIdx.x; u < N / 32; u += c.G) sgemm_unit(c, g, u * 32);
}


__device__ __forceinline__ void dsa_post_row(const Args& a, int row, int lane) {
    const bf16* z = (const bf16*)(a.ws + WS_Z) + (size_t)row * ZC1;
    const bool smp = row >= MP; const int b = smp ? (row - MP) >> 2 : row >> 12, t = smp ? (row - MP) & 3 : row & 4095;
    const float pos = (float)(smp ? PAST + t : t);
    float c128, s128, c64, s64;
    { const float f1 = exp2f(-(float)lane * (13.287712379549449f / 64.0f)); sincosf(pos * f1, &s128, &c128);
      const float f2 = exp2f(-(float)(lane & 31) * (13.287712379549449f / 32.0f)); sincosf(pos * f2, &s64, &c64); }
#pragma unroll 1
    for (int hd = 0; hd < 8; ++hd) {
        const float x1 = bf2f(z[hd * 128 + lane]), x2 = bf2f(z[hd * 128 + 64 + lane]);
        const float rs = rsqrtf(wave_sum(x1 * x1 + x2 * x2) * (1.0f / 128.0f) + EPS);
        const float* gn = hd < 6 ? a.in[17] : a.in[18];
        const float y1 = x1 * rs * gn[lane], y2 = x2 * rs * gn[64 + lane];
        const float o1 = y1 * c128 - y2 * s128, o2 = y2 * c128 + y1 * s128;
        if (hd < 6) {
            if (smp) { float* q = (float*)(a.ws + WS_SQ) + (size_t)(row - MP) * 768 + hd * 128; q[lane] = o1; q[64 + lane] = o2; }
            else { bf16* q = (bf16*)(a.ws + WS_QB) + ((size_t)(b * 6 + hd) * SEQ + t) * 128; q[lane] = (bf16)f2bf(o1); q[64 + lane] = (bf16)f2bf(o2); }
        } else {
            const int kvh = hd - 6;
            float* ko = smp ? a.out + O_KS + (size_t)(row - MP) * 256 + kvh * 128 : a.out + O_KP + (size_t)row * 256 + kvh * 128;
            ko[lane] = o1; ko[64 + lane] = o2;
            if (!smp) { bf16* kb = (bf16*)(a.ws + WS_KB) + ((size_t)(b * 2 + kvh) * SEQ + t) * 128; kb[lane] = (bf16)f2bf(o1); kb[64 + lane] = (bf16)f2bf(o2); }
        }
    }
    {
        const u64 vv = *(const u64*)(z + Z1_V + 4 * lane);
        const f32x4 v = {bf2f((unsigned)vv & 0xffffu), bf2f(((unsigned)vv) >> 16), bf2f((unsigned)(vv >> 32) & 0xffffu), bf2f((unsigned)(vv >> 48))};
        float* vo = smp ? a.out + O_VS + (size_t)(row - MP) * 256 : a.out + O_VP + (size_t)row * 256;
        *(f32x4*)(vo + 4 * lane) = v;
        if (!smp) { const int kvh = lane >> 5, d = (lane & 31) * 4; *(u64*)((bf16*)(a.ws + WS_VB) + ((size_t)(b * 2 + kvh) * SEQ + t) * 128 + d) = vv; }
    }
    {
        const int i = lane & 31;
#pragma unroll
        for (int p = 0; p < 4; ++p) { const int hd = 2 * p + (lane >> 5);
            const float x1 = bf2f(z[Z1_IQ + hd * 64 + i]), x2 = bf2f(z[Z1_IQ + hd * 64 + 32 + i]);
            const float o1 = x1 * c64 - x2 * s64, o2 = x2 * c64 + x1 * s64;
            if (smp) { float* q = (float*)(a.ws + WS_SIQ) + (size_t)(row - MP) * 512 + hd * 64; q[i] = o1; q[32 + i] = o2; }
            else { bf16* q = (bf16*)(a.ws + WS_IQB) + (size_t)row * 512 + hd * 64; q[i] = (bf16)f2bf(o1); q[32 + i] = (bf16)f2bf(o2); } }
        float x1 = 0.f, x2 = 0.f; if (lane < 32) { x1 = bf2f(z[Z1_IK + i]); x2 = bf2f(z[Z1_IK + 32 + i]); }
        const float rs = rsqrtf(wave_sum(x1 * x1 + x2 * x2) * (1.0f / 64.0f) + EPS);
        const float y1 = x1 * rs * a.in[19][i], y2 = x2 * rs * a.in[19][32 + i];
        const float o1 = y1 * c64 - y2 * s64, o2 = y2 * c64 + y1 * s64;
        if (lane < 32) {
            float* ko = smp ? a.out + O_IKS + (size_t)(row - MP) * 64 : a.out + O_IKP + (size_t)row * 64; ko[i] = o1; ko[32 + i] = o2;
            if (!smp) { bf16* kb = (bf16*)(a.ws + WS_IKB) + (size_t)row * 64; kb[i] = (bf16)f2bf(o1); kb[32 + i] = (bf16)f2bf(o2); } }
        if (lane < 8) { const float wv = bf2f(z[Z1_IW + lane]) * (0.35355339059327373f * 0.125f);
            if (smp) ((float*)(a.ws + WS_SIW))[(row - MP) * 8 + lane] = wv; else ((float*)(a.ws + WS_IW))[(size_t)row * 8 + lane] = wv; }
    }
}
__device__ __forceinline__ void p8_dsa_post(Ctx& c, const Args& a) {
    for (;;) { const int u = q_next(c, 1); if (u >= 384) break; if (u < 256) memattn_prompt_unit(c, a, 1, u); else memattn_sample_unit(c, a, 1, u - 256); }
    const int gw = c.vcu * NWAVES + c.wave, NGW = c.G * NWAVES;
    for (int row = gw; row < MVALID; row += NGW) dsa_post_row(a, row, c.lane);
}

__device__ __forceinline__ void idx_prompt_unit(Ctx& c, const Args& a, int b, int qb) {
    int tid = c.tid; asm volatile("" : "+v"(tid));
    const int lane = tid & 63, r32 = lane & 31, hh = lane >> 5, w = c.wave;
    const int q0 = b * SEQ + qb * 32;
    LAS bf16* IQL = (LAS bf16*)(c.lds);
    { const bf16* src = (const bf16*)(a.ws + WS_IQB) + (size_t)q0 * 512;
#pragma unroll
      for (int i = 0; i < 4; ++i) { const int row = tid >> 4, ch = (tid & 15) + 16 * i; *(LAS v4u*)(IQL + row * 520 + ch * 8) = *(const v4u*)(src + (size_t)row * 512 + ch * 8); } }
    __syncthreads();
    const bf16* IK = (const bf16*)(a.ws + WS_IKB) + (size_t)(b * SEQ) * 64;
    float* SC = (float*)(a.ws + WS_SC) + (size_t)(q0 + r32) * SEQ;
    float wv[8];
#pragma unroll
    for (int h = 0; h < 8; ++h) wv[h] = ((const float*)(a.ws + WS_IW))[(size_t)(q0 + r32) * 8 + h];
#pragma unroll 1
    for (int kt = w; kt <= qb; kt += 8) {
        bf16x8 ak[4];
#pragma unroll
        for (int ks = 0; ks < 4; ++ks) ak[ks] = *(const bf16x8*)(IK + (size_t)(kt * 32 + r32) * 64 + ks * 16 + 8 * hh);
        f32x16 sc = {};
        int qoff = r32 * 520 + 8 * hh; asm volatile("" : "+v"(qoff));
#pragma unroll
        for (int h = 0; h < 8; ++h) { f32x16 d = {};
#pragma unroll
            for (int ks = 0; ks < 4; ++ks) d = __builtin_amdgcn_mfma_f32_32x32x16_bf16(ak[ks], *(const LAS bf16x8*)(IQL + qoff + h * 64 + ks * 16), d, 0, 0, 0);
#pragma unroll
            for (int r = 0; r < 16; ++r) sc[r] = fmaf(wv[h], fmaxf(d[r], 0.f), sc[r]); }
#pragma unroll
        for (int g = 0; g < 4; ++g) *(f32x4*)(SC + kt * 32 + 8 * g + 4 * hh) = (f32x4){sc[4 * g], sc[4 * g + 1], sc[4 * g + 2], sc[4 * g + 3]};
    }
}
__device__ __forceinline__ void idx_sample_unit(Ctx& c, const Args& a, int sb, int pg) {
    LAS float* IKL = (LAS float*)(c.lds);
    LAS float* IQL = (LAS float*)(c.lds + 33280);
    LAS float* WL = (LAS float*)(c.lds + 33280 + 8192);
    int tid = c.tid; asm volatile("" : "+v"(tid));
    const int nk = pg < 64 ? 128 : 4;
    const float* src = pg < 64 ? a.in[4] + ((size_t)a.page_table[sb * 64 + pg] * 128) * 64 : a.out + O_IKS + (size_t)(sb * 4) * 64;
    for (int i = tid; i < nk * 16; i += 512) { const f32x4 v = *(const f32x4*)(src + (size_t)i * 4); const int k = i >> 4, d = (i & 15) * 4;
        IKL[k * 65 + d] = v.x; IKL[k * 65 + d + 1] = v.y; IKL[k * 65 + d + 2] = v.z; IKL[k * 65 + d + 3] = v.w; }
    for (int i = tid; i < 2048; i += 512) IQL[i] = ((const float*)(a.ws + WS_SIQ))[(size_t)(sb * 4) * 512 + i];
    if (tid < 32) WL[tid] = ((const float*)(a.ws + WS_SIW))[sb * 32 + tid];
    __syncthreads();
    const int k = tid & 127, t = tid >> 7;
    if (k < nk) {
        float acc = 0.f;
#pragma unroll 1
        for (int h = 0; h < 8; ++h) { float d = 0.f;
#pragma unroll 16
            for (int e = 0; e < 64; ++e) d = fmaf(IQL[(t * 8 + h) * 64 + e], IKL[k * 65 + e], d);
            acc = fmaf(WL[t * 8 + h], fmaxf(d, 0.f), acc); }
        ((float*)(a.ws + WS_SSC))[(size_t)(sb * 4 + t) * SSC_LD + pg * 128 + k] = acc;
    }
}
__device__ __forceinline__ void p9_indexer(Ctx& c, const Args& a) {
    constexpr int U_P = 512, U_S = U_P + 32 * 65;
    for (;;) { const int u = q_next(c, 2); if (u >= U_S) break;
        if (u < U_P) idx_prompt_unit(c, a, u & 3, 127 - (u >> 2));
        else { const int v = u - U_P; idx_sample_unit(c, a, v / 65, v % 65); } }
}


__device__ __forceinline__ unsigned fkey(float f) { const unsigned u = __builtin_bit_cast(unsigned, f + 0.0f); return (u & 0x80000000u) ? ~u : (u | 0x80000000u); }
__device__ __forceinline__ void acc_ge(int& cnt, unsigned key, unsigned cand) { asm volatile("v_cmp_le_u32_e32 vcc, %1, %2\n\tv_addc_co_u32_e32 %0, vcc, 0, %0, vcc" : "+v"(cnt) : "s"(cand), "v"(key) : "vcc"); }
__device__ __forceinline__ u64 ballot_nz(unsigned v) { u64 m; asm volatile("v_cmp_ne_u32_e64 %0, 0, %1" : "=s"(m) : "v"(v)); return m; }
__device__ __forceinline__ int wave_sum_dpp(int x) {
    x += __builtin_amdgcn_update_dpp(0, x, 0xB1, 0xF, 0xF, false);
    x += __builtin_amdgcn_update_dpp(0, x, 0x4E, 0xF, 0xF, false);
    x += __builtin_amdgcn_update_dpp(0, x, 0x141, 0xF, 0xF, false);
    x += __builtin_amdgcn_update_dpp(0, x, 0x140, 0xF, 0xF, false);
    return (__builtin_amdgcn_readlane(x, 0) + __builtin_amdgcn_readlane(x, 16)) + (__builtin_amdgcn_readlane(x, 32) + __builtin_amdgcn_readlane(x, 48));
}
__device__ __forceinline__ int mbcnt64(u64 m) { return (int)__builtin_amdgcn_mbcnt_hi((unsigned)(m >> 32), __builtin_amdgcn_mbcnt_lo((unsigned)m, 0u)); }
constexpr int TK_LOWBITS = 18;
__device__ __forceinline__ void topk_finish(unsigned ck, int cp, int A, int posmax, unsigned& T, int& P) {
#pragma unroll 1
    for (int bit = TK_LOWBITS - 1; bit >= 0; --bit) { const unsigned cand = T | (1u << bit); if (A + __builtin_popcountll(__ballot(ck >= cand)) >= 256) T = cand; }
    const int need = 256 - (A + __builtin_popcountll(__ballot(ck > T))), ceq = __builtin_popcountll(__ballot(ck == T));
    P = posmax;
    if (ceq != need) { P = 0;
#pragma unroll 1
        for (int bit = 13; bit >= 0; --bit) { const int cand = P | (1 << bit); if (__builtin_popcountll(__ballot(ck == T && cp < cand)) < need) P = cand; } }
}
__device__ __forceinline__ void topk_prompt_row(const Args& a, int row, int lane_, LAS unsigned* cl  ) {
    int lane = lane_; asm volatile("" : "+v"(lane));
    const int t = row & 4095; const float* sc = (const float*)(a.ws + WS_SC) + (size_t)row * SEQ;
    u64* mk = (u64*)(a.ws + WS_MASK) + (size_t)row * 64;
    u64 myword = 0ull;
    if (t < 256) {
#pragma unroll 1
        for (int j = 0; j < 64; ++j) { const u64 m = __ballot(64 * j + lane <= t); if (lane == j) myword = m; }
        mk[lane] = myword; return; }
    unsigned key[64];
#pragma unroll
    for (int j = 0; j < 64; ++j) { const float v = sc[64 * j + lane]; key[j] = (64 * j + lane <= t) ? fkey(v) : 0u; }
#define TK_FULLCOUNT(CAND, OUT) do { const unsigned cs_ = __builtin_amdgcn_readfirstlane(CAND); int cnt_ = 0; _Pragma("unroll") for (int j = 0; j < 64; ++j) acc_ge(cnt_, key[j], cs_); OUT = wave_sum_dpp(cnt_); } while (0)
    unsigned T = 0u;
#pragma unroll 1
    for (int bit = 31; bit >= TK_LOWBITS; --bit) { const unsigned cand = T | (1u << bit); int tot; TK_FULLCOUNT(cand, tot); if (tot >= 256) T = cand; }
    const unsigned hib = T + (1u << TK_LOWBITS);
    int A = 0, cT; if (hib != 0u) TK_FULLCOUNT(hib, A); TK_FULLCOUNT(T, cT);
    int P;
    if (cT - A <= 64) {
        int base = 0;
#pragma unroll
        for (int j = 0; j < 64; ++j) { const unsigned und = (key[j] - T) < (1u << TK_LOWBITS) ? 1u : 0u; const u64 m = ballot_nz(und); const int pos = base + mbcnt64(m);
            if (und) { cl[pos] = key[j]; cl[64 + pos] = (unsigned)(64 * j + lane); }
            base += __builtin_popcountll(m); asm volatile("" : "+s"(base)); }
        const unsigned ck = lane < base ? cl[lane] : 0u; const int cp = (int)cl[64 + lane];
        topk_finish(ck, cp, A, 4095, T, P);
    } else {
#pragma unroll 1
        for (int bit = TK_LOWBITS - 1; bit >= 0; --bit) { const unsigned cand = T | (1u << bit); int tot; TK_FULLCOUNT(cand, tot); if (tot >= 256) T = cand; }
        int cge, cgt; TK_FULLCOUNT(T, cge); cgt = 0; if (T != 0xffffffffu) TK_FULLCOUNT(T + 1u, cgt);
        const int need = 256 - cgt, ceq = cge - cgt; P = 4095;
        if (ceq != need) { P = 0;
#pragma unroll 1
            for (int bit = 11; bit >= 0; --bit) { const int cand = P | (1 << bit); int cnt = 0;
#pragma unroll
                for (int j = 0; j < 64; ++j) cnt += (key[j] == T && 64 * j + lane < cand) ? 1 : 0;
                if (wave_sum_dpp(cnt) < need) P = cand; } }
    }
#undef TK_FULLCOUNT
#pragma unroll
    for (int j = 0; j < 64; ++j) { const unsigned selv = (key[j] > T || (key[j] == T && 64 * j + lane <= P)) ? 1u : 0u; const u64 m = ballot_nz(selv); if (lane == j) myword = m; asm volatile("" : "+v"(myword)); }
    mk[lane] = myword;
}
__device__ __forceinline__ void topk_sample_row(const Args& a, int q, int lane_, LAS unsigned* K, LAS unsigned* cl) {
    int lane = lane_; asm volatile("" : "+v"(lane));
    const int t = q & 3, n = PAST + t + 1; const float* sc = (const float*)(a.ws + WS_SSC) + (size_t)q * SSC_LD;
    int* out = (int*)(a.ws + WS_SIDX) + q * 256;
    unsigned key[129];
#pragma unroll
    for (int j = 0; j < 129; ++j) { const float v = sc[64 * j + lane]; key[j] = (64 * j + lane < n) ? fkey(v) : 0u; }
#pragma unroll
    for (int j = 0; j < 129; ++j) K[64 * j + lane] = key[j];
#define TK_FULLCOUNT(CAND, OUT) do { const unsigned cs_ = __builtin_amdgcn_readfirstlane(CAND); int cnt_ = 0; _Pragma("unroll") for (int j = 0; j < 129; ++j) acc_ge(cnt_, key[j], cs_); OUT = wave_sum_dpp(cnt_); } while (0)
    unsigned T = 0u;
#pragma unroll 1
    for (int bit = 31; bit >= TK_LOWBITS; --bit) { const unsigned cand = T | (1u << bit); int tot; TK_FULLCOUNT(cand, tot); if (tot >= 256) T = cand; }
    const unsigned hib = T + (1u << TK_LOWBITS);
    int A = 0, cT; if (hib != 0u) TK_FULLCOUNT(hib, A); TK_FULLCOUNT(T, cT);
    int P;
    if (cT - A <= 64) {
        int base = 0;
#pragma unroll 1
        for (int j0 = 0; j0 < 128; j0 += 8) { unsigned kk[8];
#pragma unroll
            for (int i = 0; i < 8; ++i) kk[i] = K[64 * (j0 + i) + lane];
#pragma unroll
            for (int i = 0; i < 8; ++i) { const unsigned und = (kk[i] - T) < (1u << TK_LOWBITS) ? 1u : 0u; const u64 m = ballot_nz(und); const int pos = base + mbcnt64(m);
                if (und) { cl[pos] = kk[i]; cl[64 + pos] = (unsigned)(64 * (j0 + i) + lane); }
                base += __builtin_popcountll(m); } }
        { const unsigned kj = K[64 * 128 + lane]; const unsigned und = (kj - T) < (1u << TK_LOWBITS) ? 1u : 0u; const u64 m = ballot_nz(und); const int pos = base + mbcnt64(m);
          if (und) { cl[pos] = kj; cl[64 + pos] = (unsigned)(64 * 128 + lane); } base += __builtin_popcountll(m); }
        const unsigned ck = lane < base ? cl[lane] : 0u; const int cp = (int)cl[64 + lane];
        topk_finish(ck, cp, A, 16383, T, P);
    } else {
#pragma unroll 1
        for (int bit = TK_LOWBITS - 1; bit >= 0; --bit) { const unsigned cand = T | (1u << bit); int tot; TK_FULLCOUNT(cand, tot); if (tot >= 256) T = cand; }
        int cge, cgt; TK_FULLCOUNT(T, cge); cgt = 0; if (T != 0xffffffffu) TK_FULLCOUNT(T + 1u, cgt);
        const int need = 256 - cgt, ceq = cge - cgt; P = 16383;
        if (ceq != need) { P = 0;
#pragma unroll 1
            for (int bit = 13; bit >= 0; --bit) { const int cand = P | (1 << bit); int cnt = 0;
#pragma unroll 4
                for (int j = 0; j < 129; ++j) cnt += (K[64 * j + lane] == T && 64 * j + lane < cand) ? 1 : 0;
                if (wave_sum_dpp(cnt) < need) P = cand; } }
    }
#undef TK_FULLCOUNT
    int base = 0;
#pragma unroll 1
    for (int j0 = 0; j0 < 136; j0 += 8) { unsigned kk[8];
#pragma unroll
        for (int i = 0; i < 8; ++i) kk[i] = (j0 + i < 129) ? K[64 * (j0 + i) + lane] : 0u;
#pragma unroll
        for (int i = 0; i < 8; ++i) { const int ps = 64 * (j0 + i) + lane; const unsigned selv = (kk[i] > T || (kk[i] == T && ps <= P)) ? 1u : 0u; const u64 m = ballot_nz(selv);
            const int pos = base + mbcnt64(m);
            if (selv && pos < 256) out[pos] = ps;
            base += __builtin_popcountll(m); } }
}
__device__ __forceinline__ void p10_topk(Ctx& c, const Args& a) {
    const int gw = c.vcu * NWAVES + c.wave, NGW = c.G * NWAVES;
    LAS unsigned* cl = (LAS unsigned*)(c.lds) + c.wave * 128;
    if (c.wave == 0 && c.vcu < MS) topk_sample_row(a, c.vcu, c.lane, (LAS unsigned*)(c.lds + 4096), cl);
    for (int row = gw; row < MP; row += NGW) topk_prompt_row(a, row, c.lane, cl);
}


__device__ __forceinline__ void attn_sample_unit(Ctx& c, const Args& a, int sb, int t) {
    LAS bf16* KV = (LAS bf16*)(c.lds);
    LAS float* QL = (LAS float*)(c.lds + 69632);
    LAS float* SL = (LAS float*)(c.lds + 69632 + 3072);
    LAS float* OL = (LAS float*)(c.lds + 69632 + 6144);
    LAS int* IL = (LAS int*)(c.lds + 69632 + 12288);
    int tid = c.tid; asm volatile("" : "+v"(tid));
    const int lane = tid & 63, w = c.wave, q = sb * 4 + t;
    __syncthreads();
    if (tid < 256) IL[tid] = ((const int*)(a.ws + WS_SIDX))[q * 256 + tid];
    for (int i = tid; i < 768; i += 512) QL[i] = ((const float*)(a.ws + WS_SQ))[(size_t)q * 768 + i];
    __syncthreads();
    bf16* MIX = (bf16*)(a.ws + WS_MIX) + (size_t)(MP + q) * DM;
#pragma unroll 1
    for (int kvh = 0; kvh < 2; ++kvh) {
#pragma unroll 1
        for (int pass = 0; pass < 2; ++pass) {
            const float* pool = pass ? a.in[3] : a.in[2]; const float* nw = a.out + (pass ? O_VS : O_KS);
            for (int i = tid >> 5; i < 256; i += 16) { const int idx = IL[i]; const float* src;
                if (idx < PAST) src = pool + (((size_t)a.page_table[sb * 64 + (idx >> 7)] * 128 + (idx & 127)) * 2 + kvh) * 128;
                else src = nw + (size_t)(sb * 4 + (idx - PAST)) * 256 + kvh * 128;
                const f32x4 v = *(const f32x4*)(src + (tid & 31) * 4);
                *(LAS u64*)(KV + i * 136 + (tid & 31) * 4) = (u64)pk2(v.x, v.y) | ((u64)pk2(v.z, v.w) << 32); }
            __syncthreads();
            if (pass == 0) {
                const int i = tid >> 1, dh = (tid & 1) * 64; float s0 = 0.f, s1 = 0.f, s2 = 0.f;
#pragma unroll 8
                for (int d = 0; d < 64; ++d) { const float kx = bf2f(KV[i * 136 + dh + d]);
                    s0 = fmaf(QL[(3 * kvh + 0) * 128 + dh + d], kx, s0); s1 = fmaf(QL[(3 * kvh + 1) * 128 + dh + d], kx, s1); s2 = fmaf(QL[(3 * kvh + 2) * 128 + dh + d], kx, s2); }
                s0 += __shfl_xor(s0, 1); s1 += __shfl_xor(s1, 1); s2 += __shfl_xor(s2, 1);
                if ((tid & 1) == 0) { SL[i] = s0 * 0.08838834764831845f; SL[256 + i] = s1 * 0.08838834764831845f; SL[512 + i] = s2 * 0.08838834764831845f; }
                __syncthreads();
                if (w < 3) { float v[4], mx = -1e30f;
#pragma unroll
                    for (int j = 0; j < 4; ++j) { v[j] = SL[w * 256 + 64 * j + lane]; mx = fmaxf(mx, v[j]); }
#pragma unroll
                    for (int o = 1; o < 64; o <<= 1) mx = fmaxf(mx, __shfl_xor(mx, o));
                    float l = 0.f;
#pragma unroll
                    for (int j = 0; j < 4; ++j) { v[j] = __expf(v[j] - mx); l += v[j]; }
                    l = wave_sum(l); const float il = 1.0f / l;
#pragma unroll
                    for (int j = 0; j < 4; ++j) SL[w * 256 + 64 * j + lane] = v[j] * il; }
                __syncthreads();
            } else {
                const int d = tid & 127, part = tid >> 7; float o0 = 0.f, o1 = 0.f, o2 = 0.f;
#pragma unroll 8
                for (int i = part * 64; i < part * 64 + 64; ++i) { const float vx = bf2f(KV[i * 136 + d]); o0 = fmaf(SL[i], vx, o0); o1 = fmaf(SL[256 + i], vx, o1); o2 = fmaf(SL[512 + i], vx, o2); }
                OL[(part * 3 + 0) * 128 + d] = o0; OL[(part * 3 + 1) * 128 + d] = o1; OL[(part * 3 + 2) * 128 + d] = o2;
                __syncthreads();
                if (tid < 384) { const int hq = tid >> 7, dd = tid & 127; const float o = (OL[hq * 128 + dd] + OL[(3 + hq) * 128 + dd]) + (OL[(6 + hq) * 128 + dd] + OL[(9 + hq) * 128 + dd]);
                    MIX[(3 * kvh + hq) * 128 + dd] = (bf16)f2bf(o); }
                __syncthreads();
            }
        }
    }
}


namespace attn {
using bf16 = unsigned short;
typedef short bf16x8 __attribute__((ext_vector_type(8)));
typedef short s16x4 __attribute__((ext_vector_type(4)));
typedef float f32x16 __attribute__((ext_vector_type(16)));
typedef float f32x4 __attribute__((ext_vector_type(4)));
typedef unsigned u32x4 __attribute__((ext_vector_type(4)));
typedef unsigned u32x2 __attribute__((ext_vector_type(2)));
constexpr int D = 128, OS = 1024;
constexpr float THR = 8.f;
constexpr float SCALE = 0.08838834764831845f;
constexpr int NW = 8, QBLK = 32, KVBLK = 64, QB = NW * QBLK;
constexpr int SHM_V = KVBLK * D * 2, SHM_K = KVBLK * D * 2;
constexpr int LDS_BYTES = 2 * SHM_V + 2 * SHM_K + NW * 64 * 4;

#define KSWZ(row, colB) ((row) * 256 + ((colB) ^ (((row) & 7) << 4)))
#define SBAR() __builtin_amdgcn_sched_barrier(0)
__device__ __forceinline__ int v_st(int k, int c) { const int kk = (k & ~0xC) | ((k & 4) << 1) | ((k & 8) >> 1); return ((kk >> 3) * 4 + (c >> 5)) * 512 + ((kk & 7) * 32 + (c & 31)) * 2; }
__device__ __forceinline__ int v_rd_base(int lane) { return ((lane & 3) << 3) | (((lane >> 2) & 3) << 6) | (((lane >> 4) & 1) << 5) | (((lane >> 5) & 1) << 8); }
constexpr int v_rd_off(int d0, int ks, int half) { return d0 * 512 + ks * 4096 + half * 2048; }
__device__ __forceinline__ int crow(int r, int hi) { return (r & 3) + 8 * (r >> 2) + 4 * hi; }
__device__ __forceinline__ unsigned cvtpk(float lo, float hi) {
    unsigned r; asm volatile("v_cvt_pk_bf16_f32 %0, %1, %2" : "=v"(r) : "v"(lo), "v"(hi)); return r;
}
__device__ __forceinline__ bf16x8 pack8(f32x4 a, f32x4 b) {
    u32x4 w = {cvtpk(a[0], a[1]), cvtpk(a[2], a[3]), cvtpk(b[0], b[1]), cvtpk(b[2], b[3])};
    return *reinterpret_cast<bf16x8*>(&w);
}

__device__ __forceinline__ void partialSM(f32x16& p0, f32x16& p1, float& m_reg, float& mn, float& alpha) {
    float pmax = p0[0]; for (int r = 1; r < 16; ++r) pmax = fmaxf(pmax, p0[r]); for (int r = 0; r < 16; ++r) pmax = fmaxf(pmax, p1[r]);
    { auto rr = __builtin_amdgcn_permlane32_swap(__float_as_uint(pmax), __float_as_uint(pmax), false, false);
      pmax = fmaxf(__uint_as_float(rr[0]), __uint_as_float(rr[1])); }
    constexpr float C2 = 1.4426950408889634f * SCALE;
    if (__builtin_expect(__all((pmax - m_reg) * SCALE <= THR), 1)) { mn = m_reg; alpha = 1.f; }
    else { mn = fmaxf(m_reg, pmax); alpha = __builtin_amdgcn_exp2f((m_reg - mn) * C2); m_reg = mn; }
    const float mnL = -mn * C2;
    for (int r = 0; r < 16; ++r) p0[r] = fmaf(p0[r], C2, mnL); for (int r = 0; r < 16; ++r) p1[r] = fmaf(p1[r], C2, mnL);
    for (int r = 0; r < 16; ++r) p0[r] = __builtin_amdgcn_exp2f(p0[r]);
}
__device__ __forceinline__ void finishSM(f32x16& p0, f32x16& p1, float alpha, float& l_reg, bf16x8& pa0, bf16x8& pa1, bf16x8& pa2, bf16x8& pa3) {
    for (int r = 0; r < 16; ++r) p1[r] = __builtin_amdgcn_exp2f(p1[r]);
    float ps = 0; for (int r = 0; r < 16; ++r) ps += p0[r]; for (int r = 0; r < 16; ++r) ps += p1[r];
    { auto rr = __builtin_amdgcn_permlane32_swap(__float_as_uint(ps), __float_as_uint(ps), false, false);
      ps = __uint_as_float(rr[0]) + __uint_as_float(rr[1]); }
    l_reg = l_reg * alpha + ps;
#define PK4(P, B_, OUT) do { unsigned a0 = cvtpk(P[B_+0], P[B_+1]), a1 = cvtpk(P[B_+2], P[B_+3]);                          \
        unsigned b0 = cvtpk(P[B_+4], P[B_+5]), b1 = cvtpk(P[B_+6], P[B_+7]);                                             \
        auto r0 = __builtin_amdgcn_permlane32_swap(a0, b0, false, false); auto r1 = __builtin_amdgcn_permlane32_swap(a1, b1, false, false); \
        u32x4 w = {r0[0], r1[0], r0[1], r1[1]}; OUT = *reinterpret_cast<bf16x8*>(&w); } while (0)
    PK4(p0, 0, pa0); PK4(p0, 8, pa1); PK4(p1, 0, pa2); PK4(p1, 8, pa3);
#undef PK4
}
template <int KB, bool SK>
__device__ __forceinline__ void qkt(f32x16& p0, f32x16& p1, const char* K_lds, int r32, int hi, const bf16x8* qr, bool act) {
    if (SK && !act) { const float NEG = -__builtin_inff();
#pragma unroll
        for (int r = 0; r < 16; ++r) { p0[r] = NEG; p1[r] = NEG; } return; }
    p0 = f32x16{}; p1 = f32x16{};
    const char* kb[4];
#pragma unroll
    for (int dd = 0; dd < 4; ++dd) kb[dd] = K_lds + KB * SHM_K + KSWZ(r32, (dd * 16 + hi * 8) * 2);
#pragma unroll
    for (int d0 = 0; d0 < 8; ++d0) { const char* a = kb[d0 & 3] + (d0 >> 2) * 128;
        bf16x8 b0 = *reinterpret_cast<const bf16x8*>(a);
        bf16x8 b1 = *reinterpret_cast<const bf16x8*>(a + 32 * 256);
        p0 = __builtin_amdgcn_mfma_f32_32x32x16_bf16(b0, qr[d0], p0, 0, 0, 0);
        p1 = __builtin_amdgcn_mfma_f32_32x32x16_bf16(b1, qr[d0], p1, 0, 0, 0); }
}
template <int VB, bool SK>
__device__ __forceinline__ void pv_tile(f32x16* o, int vb0, bf16x8 pa0, bf16x8 pa1, bf16x8 pa2, bf16x8 pa3, bool act) {
    if (SK && !act) return;
#define TRRD(dst, off) asm volatile("ds_read_b64_tr_b16 %0, %1 offset:%2" : "=&v"(dst) : "v"(vb0), "i"(off) : "memory")
#define PV_D0(d0) do { s16x4 l0, l1, l2, l3, h0, h1, h2, h3; constexpr int b_ = VB * SHM_V + v_rd_off(d0, 0, 0);     \
        TRRD(l0, b_); TRRD(h0, b_ + 2048); TRRD(l1, b_ + 4096); TRRD(h1, b_ + 6144); TRRD(l2, b_ + 8192); TRRD(h2, b_ + 10240); TRRD(l3, b_ + 12288); TRRD(h3, b_ + 14336); \
        asm volatile("s_waitcnt lgkmcnt(0)" ::: "memory"); SBAR();                 \
        o[d0] = __builtin_amdgcn_mfma_f32_32x32x16_bf16(pa0, (bf16x8){l0[0], l0[1], l0[2], l0[3], h0[0], h0[1], h0[2], h0[3]}, o[d0], 0, 0, 0);   \
        o[d0] = __builtin_amdgcn_mfma_f32_32x32x16_bf16(pa1, (bf16x8){l1[0], l1[1], l1[2], l1[3], h1[0], h1[1], h1[2], h1[3]}, o[d0], 0, 0, 0);   \
        o[d0] = __builtin_amdgcn_mfma_f32_32x32x16_bf16(pa2, (bf16x8){l2[0], l2[1], l2[2], l2[3], h2[0], h2[1], h2[2], h2[3]}, o[d0], 0, 0, 0);   \
        o[d0] = __builtin_amdgcn_mfma_f32_32x32x16_bf16(pa3, (bf16x8){l3[0], l3[1], l3[2], l3[3], h3[0], h3[1], h3[2], h3[3]}, o[d0], 0, 0, 0); } while (0)
    PV_D0(0); PV_D0(1); PV_D0(2); PV_D0(3);
#undef PV_D0
#undef TRRD
}

__device__ __forceinline__ bf16x8 load8(const bf16* p) { return *reinterpret_cast<const bf16x8*>(p); }
__device__ __forceinline__ void mask_bits(f32x16& p0, f32x16& p1, u32x2 w, int hi) {
    const float NEG = -__builtin_inff();
    asm volatile("" : "+v"(w.x), "+v"(w.y));
    const unsigned lo = w.x >> (4 * hi), up = w.y >> (4 * hi);
#pragma unroll
    for (int r = 0; r < 16; ++r) { const int c = (r & 3) + 8 * (r >> 2);
        if (!((lo >> c) & 1u)) p0[r] = NEG;
        if (!((up >> c) & 1u)) p1[r] = NEG; }
}
struct BlockRef { const bf16* Q; const bf16* K; const bf16* V; bf16* O; const u32x2* M; int P0; };
struct Seam { bf16x8 qr[8]; bf16x8 st_v0, st_v1, st_k0, st_k1; };
#define ROW(p, k0, rr) ((p) + (size_t)((k0) + (rr)) * D + sc)
#define VMW() asm volatile("s_waitcnt vmcnt(0)" ::: "memory")
#define VMWN(n) asm volatile("s_waitcnt vmcnt(%0)" :: "i"(n) : "memory")
#define SLOAD_H(Kp, Vp, k0) do { S.st_v0 = load8(ROW(Vp, k0, sr)); S.st_v1 = load8(ROW(Vp, k0, 32 + sr));              \
                         S.st_k0 = load8(ROW(Kp, k0, sr)); S.st_k1 = load8(ROW(Kp, k0, 32 + sr)); } while (0)
#define SWRITE_HK(bf) do { *(bf16x8*)(K_lds + (bf) * SHM_K + kws) = S.st_k0; *(bf16x8*)(K_lds + (bf) * SHM_K + kws + 32 * 256) = S.st_k1; } while (0)
#define SWRITE_HV(bf) do { *(bf16x8*)(V_lds + (bf) * SHM_V + vst0) = S.st_v0; *(bf16x8*)(V_lds + (bf) * SHM_V + vst1) = S.st_v1; } while (0)
#define SWRITE_H(bf) do { SWRITE_HV(bf); SWRITE_HK(bf); } while (0)
__device__ __forceinline__ void sel_prime(const BlockRef& cur, char* lds, Seam& S) {
    int tid_ = threadIdx.x; asm volatile("" : "+v"(tid_));
    const int tid = tid_, wid = __builtin_amdgcn_readfirstlane(tid >> 6), lane = tid & 63, r32 = lane & 31, hi = lane >> 5;
    const int sr = tid >> 4, sc = (tid & 15) * 8, kws = KSWZ(sr, sc * 2); char* K_lds = lds + 2 * SHM_V;
    for (int d0 = 0; d0 < 8; ++d0) S.qr[d0] = load8(cur.Q + (size_t)(wid * QBLK + r32) * D + d0 * 16 + hi * 8);
    SLOAD_H(cur.K, cur.V, 0); VMW(); SWRITE_HK(0);
    __syncthreads();
}
__device__ __forceinline__ void sel_block(const BlockRef& cur, const BlockRef& nxt, char* lds, Seam& S) {
    int tid_ = threadIdx.x; asm volatile("" : "+v"(tid_));
    const int tid = tid_, wid = __builtin_amdgcn_readfirstlane(tid >> 6), lane = tid & 63, r32 = lane & 31, hi = lane >> 5;
    const int NT = (cur.P0 + QB) / KVBLK;
    char* V_lds = lds; char* K_lds = lds + 2 * SHM_V;
    float* ws = (float*)(lds + 2 * SHM_V + 2 * SHM_K) + wid * 64; float* li_l = ws, * al_l = ws + 32;
    float m_reg = -1e30f, l_reg = 0; f32x16 o[4] = {};
    const int sr = tid >> 4, sc = (tid & 15) * 8, vst0 = v_st(sr, sc), vst1 = v_st(32 + sr, sc), kws = KSWZ(sr, sc * 2);
    const int vb0 = (int)(uintptr_t)V_lds + v_rd_base(lane);
    const bf16* Kh = cur.K; const bf16* Vh = cur.V;
    const u32x2* Mrow = cur.M + (size_t)(wid * QBLK + r32) * 64;
#define RESC(a) do { if (__any((a) < 1.f)) { if (hi == 0) al_l[r32] = (a); asm volatile("s_waitcnt lgkmcnt(0)" ::: "memory");              \
                     for (int d_ = 0; d_ < 4; ++d_) for (int r = 0; r < 16; ++r) o[d_][r] *= al_l[crow(r, hi)]; } } while (0)
#define KBASE(t) ((t) * KVBLK)
    f32x16 pA0, pA1, pB0, pB1; float mnA, mnB, alA, alB; bf16x8 pa0, pa1, pa2, pa3; u32x2 mw;
    SWRITE_HV(0); SBAR();
    if (NT > 1) SLOAD_H(Kh, Vh, KBASE(1));
    mw = Mrow[0];
    SBAR(); qkt<0, false>(pA0, pA1, K_lds, r32, hi, S.qr, true);
    mask_bits(pA0, pA1, mw, hi); partialSM(pA0, pA1, m_reg, mnA, alA);
    if (NT > 1) { VMW(); SWRITE_H(1); }
    __syncthreads();
#define HALF_STEP(PX0, PX1, mnX, alX, PY0, PY1, alY, t, KB, VB, SB) do {                                                      \
        SBAR(); mw = Mrow[(t)]; qkt<KB, false>(PX0, PX1, K_lds, r32, hi, S.qr, true);                                          \
        finishSM(PY0, PY1, alY, l_reg, pa0, pa1, pa2, pa3); SBAR();                                                           \
        if ((t) + 1 < NT) { SLOAD_H(Kh, Vh, KBASE((t) + 1)); SBAR(); }                                                        \
        pv_tile<VB, false>(o, vb0, pa0, pa1, pa2, pa3, true); mask_bits(PX0, PX1, mw, hi); partialSM(PX0, PX1, m_reg, mnX, alX); \
        __syncthreads();                                                                                                      \
        if ((t) + 1 < NT) { VMW(); SWRITE_H(SB); }                                                                            \
        RESC(alX); __syncthreads(); } while (0)
    for (int t = 1; t + 1 < NT; t += 2) {
        HALF_STEP(pB0, pB1, mnB, alB, pA0, pA1, alA, t, 1, 0, 0);
        HALF_STEP(pA0, pA1, mnA, alA, pB0, pB1, alB, t + 1, 0, 1, 1);
    }
    const bool even = (NT & 1) == 0;
    if (even) { SBAR(); mw = Mrow[NT - 1]; qkt<1, false>(pB0, pB1, K_lds, r32, hi, S.qr, true); SBAR(); }
    SLOAD_H(nxt.K, nxt.V, 0); SBAR();
#pragma unroll
    for (int d0 = 0; d0 < 8; ++d0) S.qr[d0] = load8(nxt.Q + (size_t)(wid * QBLK + r32) * D + d0 * 16 + hi * 8);
    SBAR();
    finishSM(pA0, pA1, alA, l_reg, pa0, pa1, pa2, pa3); SBAR();
    pv_tile<0, false>(o, vb0, pa0, pa1, pa2, pa3, true);
    if (even) { mask_bits(pB0, pB1, mw, hi); partialSM(pB0, pB1, m_reg, mnB, alB); __syncthreads(); RESC(alB);
        finishSM(pB0, pB1, alB, l_reg, pa0, pa1, pa2, pa3); SBAR(); pv_tile<1, false>(o, vb0, pa0, pa1, pa2, pa3, true); }
    SBAR(); VMWN(8); SWRITE_HK(0); SBAR();
    if (hi == 0) li_l[r32] = l_reg; asm volatile("s_waitcnt lgkmcnt(0)" ::: "memory");
    float rli[16];
#pragma unroll
    for (int r = 0; r < 16; ++r) rli[r] = __builtin_amdgcn_rcpf(li_l[crow(r, hi)]);
    bf16* Ow = cur.O + (size_t)(wid * QBLK) * OS;
#pragma unroll
    for (int r = 0; r < 16; ++r) { const int orow = crow(r, hi);
#pragma unroll
        for (int d0 = 0; d0 < 4; ++d0) { const float v = o[d0][r] * rli[r];
            const float vn = __shfl_xor(v, 1);
            if ((r32 & 1) == 0) *(unsigned*)(Ow + (size_t)orow * OS + d0 * 32 + r32) = cvtpk(v, vn); } }
    __syncthreads();
#undef RESC
#undef KBASE
#undef HALF_STEP
}
#undef ROW
#undef VMW
#undef VMWN
#undef SLOAD_H
#undef SWRITE_HK
#undef SWRITE_HV
#undef SWRITE_H
#undef KSWZ
#undef SBAR
}


__device__ __forceinline__ attn::BlockRef attn_ref(const Args& a, int b, int h, int qb) {
    attn::BlockRef r; const int kvh = h / 3;
    r.Q = (const attn::bf16*)(a.ws + WS_QB) + ((size_t)(b * 6 + h) * SEQ + (size_t)qb * 256) * 128;
    r.K = (const attn::bf16*)(a.ws + WS_KB) + (size_t)(b * 2 + kvh) * SEQ * 128;
    r.V = (const attn::bf16*)(a.ws + WS_VB) + (size_t)(b * 2 + kvh) * SEQ * 128;
    r.O = (attn::bf16*)(a.ws + WS_MIX) + (size_t)(b * SEQ + qb * 256) * DM + h * 128;
    r.M = (const attn::u32x2*)(a.ws + WS_MASK) + (size_t)(b * SEQ + qb * 256) * 64;
    r.P0 = qb * 256; return r;
}
__device__ __forceinline__ void p11_attention(Ctx& c, const Args& a) {
    constexpr int NITEM = 192;
#pragma unroll 1
    for (int it = c.vcu; it < NITEM; it += c.G) {
        const int p = it & 7, bh = it >> 3, b = bh / 6, h = bh % 6;
        attn::Seam S;
        attn::BlockRef cur = attn_ref(a, b, h, p), nxt = attn_ref(a, b, h, 15 - p);
        __syncthreads();
        attn::sel_prime(cur, (char*)c.lds, S);
        attn::sel_block(cur, nxt, (char*)c.lds, S);
        attn::sel_block(nxt, nxt, (char*)c.lds, S);
    }
    const int spare = c.G - NITEM;
    if (spare > 0) { if (c.vcu >= NITEM) for (int u = c.vcu - NITEM; u < MS; u += spare) attn_sample_unit(c, a, u >> 2, u & 3); }
    else for (int u = c.vcu; u < MS; u += c.G) attn_sample_unit(c, a, u >> 2, u & 3);
}

enum { PH_PRO = 0, PH_IN0, PH_MIX0, PH_HSCAN, PH_HFIX, PH_OUT0, PH_GU0, PH_CONV0, PH_DOWN0, PH_IN1, PH_POST, PH_IDX, PH_TOPK, PH_ATTN, PH_OUT1, PH_GU1, PH_CONV1, PH_DOWN1, NPHASE };
#ifndef ONLYPH
#define ONLYPH -1
#endif
#define PHON(x) (ONLYPH < 0 || ONLYPH == (x))
#ifndef REP_PH
#define REP_PH -1
#endif
#ifndef REP_N
#define REP_N 1
#endif
__global__ void __launch_bounds__(NWAVES * 64, 2) fwd_kernel(Args args) {
    extern __shared__ __attribute__((aligned(16))) unsigned char lds[];
    Ctx c;
    c.lds = (LAS unsigned char*)lds;
    c.MISC = (volatile LAS unsigned*)(c.lds + MISC_OFF);
    c.tid = threadIdx.x; c.lane = c.tid & 63; c.wave = __builtin_amdgcn_readfirstlane(c.tid >> 6);
    c.G = gridDim.x; { const int bx = blockIdx.x; c.vcu = (c.G % 8 == 0) ? (bx % 8) * (c.G / 8) + bx / 8 : bx; }
    unsigned char* ws = args.ws;
    c.ctl = (gu32*)(ws + WS_CTL);
    for (int u = c.tid; u < (LDS_BYTES - LDSCTL_OFF) / 4; u += NWAVES * 64) ((LAS unsigned*)(c.lds + LDSCTL_OFF))[u] = 0u;
    __syncthreads();
    const int lo = args.ph_lo, hi = args.ph_hi;
    XcdBarrier bar; bar.bar = (unsigned*)(c.ctl + CW_BAR); bar.x = 0; bar.st = nullptr;
    if (hi - lo > 1 || REP_N > 1) bar = xcd_barrier_post((unsigned*)(c.ctl + CW_BAR), c.MISC + 8);
    float* const out = args.out;
    c.qoff = 0;
#pragma unroll 1
    for (int ph = lo; ph < hi; ++ph) {
        const int layer = ph >= PH_IN1 ? 1 : 0;
        { int t_ = threadIdx.x; asm volatile("" : "+v"(t_)); c.tid = t_; c.lane = t_ & 63; c.wave = __builtin_amdgcn_readfirstlane(t_ >> 6); }
        if (ph == PH_PRO && PHON(PH_PRO)) p0_prologue(c, args);
        else if ((ph == PH_IN0 || ph == PH_IN1) && PHON(PH_IN0)) {
            pg8::Gemm g{(const pg8::bf16_t*)(ws + WS_XB), (const pg8::bf16_t*)(ws + (ph == PH_IN0 ? WS_WIN0 : WS_WIN1)), MT, 0, 1024};
            pg8::SchedX S; if (ph == PH_IN0) S.init(MP, ZC0, c.G, (int)blockIdx.x, 16, MT / 256, 4, 13); else S.init(MP, ZC1, c.G, (int)blockIdx.x, 0, 0, 1, 0);
            pg8::EpiZ E{(pg8::bf16_t*)(ws + WS_Z), ph == PH_IN0 ? ZC0 : ZC1, ssptr(c, ph == PH_IN0 ? 0 : 2), ph == PH_IN0 ? 13 : 9, (float*)(ws + WS_MEMKV), MEMROW0};
            pg8::gemm_phase<pg8::EpiZ, pg8::SchedX, PG8_ALIGN, PG8_SP2>(c.lds + RING_OFF, g, S, E);
            { SgArgs sg{}; sg.A = (const bf16*)(ws + WS_XB) + (size_t)MP * DM; sg.Bt = (const bf16*)(ws + (ph == PH_IN0 ? WS_WIN0 : WS_WIN1)); sg.K = 1024; sg.mode = 0; sg.Z = (bf16*)(ws + WS_Z); sg.ldz = ph == PH_IN0 ? ZC0 : ZC1; sg.ssin = ssptr(c, ph == PH_IN0 ? 0 : 2);
              sgemm_phase(c, sg, ph == PH_IN0 ? ZC0 : ZC1); }
        }
        else if (ph == PH_MIX0 && PHON(PH_MIX0)) p2_mixer0(c, args);
        else if (ph == PH_HSCAN && PHON(PH_HSCAN)) hgrn_scan(c, args);
        else if (ph == PH_HFIX && PHON(PH_HFIX)) p2c_hgrn_fix(c, args);
        else if ((ph == PH_OUT0 || ph == PH_DOWN0 || ph == PH_OUT1 || ph == PH_DOWN1) && PHON(PH_OUT0)) {
            const bool isout = (ph == PH_OUT0 || ph == PH_OUT1);
            pg8::Gemm g{(const pg8::bf16_t*)(ws + (isout ? WS_MIX : WS_ACT)), (const pg8::bf16_t*)(ws + (isout ? WS_WOUT + (size_t)layer * 1024 * 1024 * 2 : WS_WD + (size_t)layer * 1024 * DFF * 2)), MT, 1024, isout ? 1024 : DFF};
            pg8::SchedX S; S.init(MP, 1024, c.G, (int)blockIdx.x, 0, 0, 1, 0);
            pg8::EpiResid E;
            E.rp = ph == PH_OUT0 ? args.in[0] : out + O_YP; E.rs = ph == PH_OUT0 ? args.in[1] : out + O_YS; E.y = out + O_YP;
            E.xb = ph == PH_DOWN1 ? nullptr : (pg8::bf16_t*)(ws + WS_XB); E.ssout = ph == PH_DOWN1 ? nullptr : ssptr(c, ph == PH_OUT0 ? 1 : (ph == PH_DOWN0 ? 2 : 3));
            pg8::gemm_phase<pg8::EpiResid, pg8::SchedX, PG8_ALIGN, PG8_SP2>(c.lds + RING_OFF, g, S, E);
            { SgArgs sg{}; sg.A = (const bf16*)(ws + (isout ? WS_MIX : WS_ACT)) + (size_t)MP * (isout ? 1024 : DFF); sg.Bt = (const bf16*)g.Bt; sg.K = isout ? 1024 : DFF; sg.mode = 1; sg.resid = E.rs; sg.y = out + O_YS; sg.xb = (bf16*)E.xb; sg.ssout = E.ssout;
              sgemm_phase(c, sg, 1024); }
        }
        else if ((ph == PH_GU0 || ph == PH_GU1) && PHON(PH_GU0)) {
            pg8::Gemm g{(const pg8::bf16_t*)(ws + WS_XB), (const pg8::bf16_t*)(ws + WS_WGU + (size_t)layer * 5632 * 1024 * 2), MT, 5632, 1024};
            pg8::SchedX S; S.init(MP, 5632, c.G, (int)blockIdx.x, 0, 0, 1, 0);
            pg8::EpiGU E{(pg8::bf16_t*)(ws + WS_U), (pg8::bf16_t*)(ws + WS_UP), ssptr(c, layer ? 3 : 1), out + O_CVP + (size_t)layer * 4 * 2 * DFF, out + O_CVS + (size_t)layer * 32 * 2 * DFF};
            pg8::gemm_phase<pg8::EpiGU, pg8::SchedX, PG8_ALIGN, PG8_SP2>(c.lds + RING_OFF, g, S, E);
            { SgArgs sg{}; sg.A = (const bf16*)(ws + WS_XB) + (size_t)MP * DM; sg.Bt = (const bf16*)g.Bt; sg.K = 1024; sg.mode = 2; sg.ssin = E.ss; sg.U = (bf16*)E.U; sg.UP = (bf16*)E.UP; sg.cvs = E.cvs;
              sgemm_phase(c, sg, 5632); }
        }
        else if ((ph == PH_CONV0 || ph == PH_CONV1) && PHON(PH_CONV0)) p5_convact(c, args, layer);
        else if (ph == PH_POST && PHON(PH_POST)) p8_dsa_post(c, args);
        else if (ph == PH_IDX && PHON(PH_IDX)) p9_indexer(c, args);
        else if (ph == PH_TOPK && PHON(PH_TOPK)) p10_topk(c, args);
        else if (ph == PH_ATTN && PHON(PH_ATTN)) p11_attention(c, args);
        if (REP_N > 1 && ph == REP_PH && c.qoff < 4 * (REP_N - 1)) { c.qoff += 4; --ph; xcd_barrier(bar); continue; }
        if (REP_N > 1) c.qoff = 0;
        if (ph + 1 < hi) xcd_barrier(bar);
    }
}

#ifndef MK_ONE_LAUNCH
#define MK_ONE_LAUNCH 1
#endif
extern "C" void kernel_launch(void* const* d_in, const int* in_sizes, int n_in, void* d_out, int out_size, void* d_ws, size_t ws_size, hipStream_t stream) {
    static int grid = 0;
    if (grid == 0) {
        if (n_in != 29 || out_size != (int)O_END || ws_size < WS_END) { fprintf(stderr, "kernel_launch: unexpected problem (n_in %d, out %d, ws %zu)\n", n_in, out_size, ws_size); grid = -1; return; }
        int dev = 0, cus = 0;
        if (hipGetDevice(&dev) != hipSuccess || hipDeviceGetAttribute(&cus, hipDeviceAttributeMultiprocessorCount, dev) != hipSuccess) { grid = -1; return; }
        if (hipFuncSetAttribute((const void*)fwd_kernel, hipFuncAttributeMaxDynamicSharedMemorySize, LDS_BYTES) != hipSuccess) { fprintf(stderr, "kernel_launch: hipFuncSetAttribute failed\n"); grid = -1; return; }
        (void)hipGetLastError();
        grid = cus;
    }
    if (grid < 0) return;
    if (hipMemsetAsync((char*)d_ws + WS_CTL, 0, CTL_ZERO_BYTES, stream) != hipSuccess) { fprintf(stderr, "kernel_launch: memset failed\n"); return; }
    Args a{};
    for (int i = 0; i < 29; ++i) a.in[i] = (const float*)d_in[i];
    a.page_table = (const int*)d_in[9]; a.out = (float*)d_out; a.ws = (unsigned char*)d_ws;
#if MK_ONE_LAUNCH
    a.ph_lo = 0; a.ph_hi = NPHASE;
    hipLaunchKernelGGL(fwd_kernel, dim3(grid), dim3(NWAVES * 64), LDS_BYTES, stream, a);
#else
    for (int ph = 0; ph < NPHASE; ++ph) { a.ph_lo = ph; a.ph_hi = ph + 1; hipLaunchKernelGGL(fwd_kernel, dim3(grid), dim3(NWAVES * 64), LDS_BYTES, stream, a); }
#endif
}
```

```cpp
#include <hip/hip_runtime.h>
#include <cstdio>
#include <cstdint>


namespace pg8 {
#define PG8_LAS __attribute__((address_space(3)))
typedef unsigned short bf16_t;
typedef short bf16x8 __attribute__((ext_vector_type(8)));
typedef float f32x4 __attribute__((ext_vector_type(4)));
typedef unsigned u32x4 __attribute__((ext_vector_type(4)));
constexpr int BM = 256, BK = 64, HALF = 128, HTB = HALF * BK * 2  , STAGE_BYTES = 8 * HTB, NXCD = 8, WGM = 8;

__host__ __device__ __forceinline__ int lds_byte(int r, int c) { const int st = (r >> 4) * 2 + (c >> 5), rr = r & 15, cc = c & 31, ob = rr * 64 + cc * 2; return st * 1024 + (ob ^ (((ob >> 9) & 1) << 5)); }
__host__ __device__ __forceinline__ void stage_rc(int b, int& R, int& C) { const int st = b / 1024, sb = b % 1024, swz = sb ^ (((sb >> 9) & 1) << 5); R = (st >> 1) * 16 + swz / 64; C = (st & 1) * 32 + (swz % 64) / 2; }
__host__ __device__ __forceinline__ int perm32(int rho) { const int n = rho >> 4, i = rho & 15; return 8 * (i >> 2) + 4 * n + (i & 3); }

struct Unit { int pm, pn; };
struct Gemm { const bf16_t* A; const bf16_t* Bt; int M, N, K; };

struct StaticOrder {
    int nM, nN, nwg, G, c;
    __host__ __device__ void init(int M, int N, int G_, int c_) { nM = M / BM; nN = N / BM; nwg = nM * nN; G = G_; c = c_; }
    __host__ __device__ bool next(int i, Unit& u) const {
        const long L = (long)i * G + c; if (L >= nwg) return false;
        int wgid = (int)L; { const int q = nwg / NXCD, r = nwg % NXCD, xcd = wgid % NXCD, off = wgid / NXCD; wgid = (xcd < r ? xcd * (q + 1) : r * (q + 1) + (xcd - r) * q) + off; }
        const int nig = WGM * nN, gid = wgid / nig, fm = gid * WGM, gsz = (nM - fm) < WGM ? (nM - fm) : WGM;
        u.pm = fm + ((wgid % nig) % gsz); u.pn = (wgid % nig) / gsz; return true;
    }
    __device__ __forceinline__ void a_ready(const Unit&) const {}
    __device__ __forceinline__ void done(const Unit&) const {}
};


constexpr int MP = 16384, MS = 128, MVALID = MP + MS, MT = 16640, DM = 1024, DFF = 2816;
constexpr float RMS_EPS = 1e-6f;
__device__ __forceinline__ unsigned cvt_pk_bf16(float lo, float hi) { unsigned r; asm volatile("v_cvt_pk_bf16_f32 %0, %1, %2" : "=v"(r) : "v"(lo), "v"(hi)); return r; }

struct SchedX {
    StaticOrder so; int nextra, e_pm0, e_nm, e_pn0;
    __device__ void init(int M, int N, int G_, int c_, int nextra_, int e_pm0_, int e_nm_, int e_pn0_) { so.init(M, N, G_, c_); nextra = nextra_; e_pm0 = e_pm0_; e_nm = e_nm_; e_pn0 = e_pn0_; }
    __device__ bool next(int i, Unit& u) const {
        const long L = (long)i * so.G + so.c;
        if (L < so.nwg) return so.next(i, u);
        const int e = (int)(L - so.nwg); if (e >= nextra) return false;
        u.pm = e_pm0 + e % e_nm; u.pn = e_pn0 + e / e_nm; return true;
    }
    __device__ __forceinline__ void a_ready(const Unit&) const {}
    __device__ __forceinline__ void done(const Unit&) const {}
};

struct EpiZ {
    static constexpr bool PERM = true, AFTER_DRAIN = false;
    bf16_t* Z; int ldz; const float* ss; int nmain; float* memkv; int memrow0;
    __device__ __forceinline__ void operator()(const f32x4 (&acc)[2][2][4][2], const Unit& u, int wr, int wc, int fr, int fq) const {
        const int row0 = u.pm * BM + wr * 64 + fr;
        if (u.pn < nmain) {
            const int col0 = u.pn * BM + wc * 32 + 8 * fq;
#pragma unroll
            for (int ai = 0; ai < 2; ++ai)
#pragma unroll
                for (int m = 0; m < 4; ++m) { const int row = row0 + ai * HALF + m * 16; const float rs = rsqrtf(ss[row] * (1.0f / DM) + RMS_EPS);
#pragma unroll
                    for (int bj = 0; bj < 2; ++bj) { const f32x4 v0 = acc[ai][bj][m][0] * rs, v1 = acc[ai][bj][m][1] * rs;
                        u32x4 w; w.x = cvt_pk_bf16(v0[0], v0[1]); w.y = cvt_pk_bf16(v0[2], v0[3]); w.z = cvt_pk_bf16(v1[0], v1[1]); w.w = cvt_pk_bf16(v1[2], v1[3]);
                        *(u32x4*)(Z + (size_t)row * ldz + col0 + bj * HALF) = w; } }
        } else {
            const int col0 = (u.pn - nmain) * BM + wc * 32 + 8 * fq;
#pragma unroll
            for (int ai = 0; ai < 2; ++ai)
#pragma unroll
                for (int m = 0; m < 4; ++m) { const int row = row0 + ai * HALF + m * 16 - memrow0;
#pragma unroll
                    for (int bj = 0; bj < 2; ++bj) { float* p = memkv + (size_t)row * 1024 + col0 + bj * HALF; *(f32x4*)p = acc[ai][bj][m][0]; *(f32x4*)(p + 4) = acc[ai][bj][m][1]; } }
        }
    }
};

struct EpiResid {
    static constexpr bool PERM = true, AFTER_DRAIN = false;
    const float* rp; const float* rs; float* y; bf16_t* xb; float* ssout;
    __device__ __forceinline__ void operator()(const f32x4 (&acc)[2][2][4][2], const Unit& u, int wr, int wc, int fr, int fq) const {
        const int row0 = u.pm * BM + wr * 64 + fr, col0 = u.pn * BM + wc * 32 + 8 * fq;
#pragma unroll
        for (int ai = 0; ai < 2; ++ai)
#pragma unroll
            for (int m = 0; m < 4; ++m) { const int row = row0 + ai * HALF + m * 16; float part = 0.f;
                if (row < MVALID) { const float* src = row < MP ? rp + (size_t)row * DM : rs + (size_t)(row - MP) * DM;
#pragma unroll
                    for (int bj = 0; bj < 2; ++bj) { const int c = col0 + bj * HALF;
                        const f32x4 v0 = acc[ai][bj][m][0] + *(const f32x4*)(src + c), v1 = acc[ai][bj][m][1] + *(const f32x4*)(src + c + 4);
                        *(f32x4*)(y + (size_t)row * DM + c) = v0; *(f32x4*)(y + (size_t)row * DM + c + 4) = v1;
                        part += (v0[0] * v0[0] + v0[1] * v0[1]) + (v0[2] * v0[2] + v0[3] * v0[3]) + (v1[0] * v1[0] + v1[1] * v1[1]) + (v1[2] * v1[2] + v1[3] * v1[3]);
                        if (xb) { u32x4 w; w.x = cvt_pk_bf16(v0[0], v0[1]); w.y = cvt_pk_bf16(v0[2], v0[3]); w.z = cvt_pk_bf16(v1[0], v1[1]); w.w = cvt_pk_bf16(v1[2], v1[3]);
                            *(u32x4*)(xb + (size_t)row * DM + c) = w; } } }
                part += __shfl_xor(part, 16); part += __shfl_xor(part, 32);
                if (ssout && fq == 0 && row < MVALID) atomicAdd(ssout + row, part); }
    }
};

struct EpiGU {
    static constexpr bool PERM = true, AFTER_DRAIN = false;
    bf16_t* U; bf16_t* UP; const float* ss; float* cvp; float* cvs;
    __device__ __forceinline__ void operator()(const f32x4 (&acc)[2][2][4][2], const Unit& u, int wr, int wc, int fr, int fq) const {
        const int row0 = u.pm * BM + wr * 64 + fr, colg = u.pn * HALF + wc * 32 + 8 * fq;
#pragma unroll
        for (int ai = 0; ai < 2; ++ai)
#pragma unroll
            for (int m = 0; m < 4; ++m) { const int row = row0 + ai * HALF + m * 16; const float rs = rsqrtf(ss[row] * (1.0f / DM) + RMS_EPS);
                const f32x4 g0 = acc[ai][0][m][0] * rs, g1 = acc[ai][0][m][1] * rs, p0 = acc[ai][1][m][0] * rs, p1 = acc[ai][1][m][1] * rs;
                u32x4 w; w.x = cvt_pk_bf16(g0[0], g0[1]); w.y = cvt_pk_bf16(g0[2], g0[3]); w.z = cvt_pk_bf16(g1[0], g1[1]); w.w = cvt_pk_bf16(g1[2], g1[3]);
                *(u32x4*)(U + (size_t)row * DFF + colg) = w;
                w.x = cvt_pk_bf16(p0[0], p0[1]); w.y = cvt_pk_bf16(p0[2], p0[3]); w.z = cvt_pk_bf16(p1[0], p1[1]); w.w = cvt_pk_bf16(p1[2], p1[3]);
                *(u32x4*)(UP + (size_t)row * DFF + colg) = w;
                float* cv = nullptr;
                if (row < MP) { const int t = row & 4095; if (t >= 4094) cv = cvp + (size_t)((row >> 12) * 2 + (t - 4094)) * DFF; }
                else if (row < MVALID) { const int r2 = row - MP, t = r2 & 3; if (t >= 2) cv = cvs + (size_t)((r2 >> 2) * 2 + (t - 2)) * DFF; }
                if (cv) { *(f32x4*)(cv + colg) = g0; *(f32x4*)(cv + colg + 4) = g1; } }
    }
};

template <class Epi, class Sched, bool ALIGN_EPI = false, bool SP2 = false>
__device__ __forceinline__ void gemm_phase(PG8_LAS unsigned char* lds, const Gemm g, const Sched& S, const Epi& E) {
    int tid_ = threadIdx.x; asm volatile("" : "+v"(tid_));
    const int tid = tid_, wid = __builtin_amdgcn_readfirstlane(tid >> 6), lane = tid & 63, wr = wid >> 2, wc = wid & 3, fr = lane & 15, fq = lane >> 4;
    const int K = g.K, nt = K / BK;
    unsigned voffA[2], voffB[2];
#pragma unroll
    for (int i = 0; i < 2; ++i) { int R, C; stage_rc(tid * 16 + i * 8192, R, C); const int Rb = Epi::PERM ? ((R & ~31) + perm32(R & 31)) : R;
        voffA[i] = (unsigned)(R * K + C) * 2u; voffB[i] = (unsigned)(Rb * K + C) * 2u; }
    const size_t kstep = (size_t)(BK * 2);
    const size_t hstep = (size_t)HALF * K * 2;
    const size_t tstep = 2 * hstep;
    const unsigned ldsw = (unsigned)wid * 1024u;
    const int aoff = lds_byte(wr * 64 + fr, fq * 8), boff = lds_byte(wc * 32 + fr, fq * 8);
#define PG8_SA(b, h) (((b) * 2 + (h)) * HTB)
#define PG8_SB(b, h) ((4 + (b) * 2 + (h)) * HTB)
#define PG8_STAGE(bufoff, gbase, voff) do { _Pragma("unroll") for (int _i = 0; _i < 2; ++_i) \
        __builtin_amdgcn_global_load_lds((const unsigned*)((const char*)(gbase) + (voff)[_i]), (PG8_LAS unsigned*)(lds + (bufoff) + ldsw + _i * 8192), 16, 0, 0); } while (0)
#define PG8_LDA(dst, b, h) do { _Pragma("unroll") for (int m = 0; m < 4; ++m) _Pragma("unroll") for (int k = 0; k < 2; ++k) dst[m][k] = *(const PG8_LAS bf16x8*)(lds + PG8_SA(b, h) + aoff + m * 2048 + k * 1024); } while (0)
#define PG8_LDB(dst, b, h) do { _Pragma("unroll") for (int n = 0; n < 2; ++n) _Pragma("unroll") for (int k = 0; k < 2; ++k) dst[n][k] = *(const PG8_LAS bf16x8*)(lds + PG8_SB(b, h) + boff + n * 2048 + k * 1024); } while (0)
#define PG8_MMA(ai, bj, At, Bt) do { __builtin_amdgcn_s_setprio(1); _Pragma("unroll") for (int m = 0; m < 4; ++m) _Pragma("unroll") for (int n = 0; n < 2; ++n) _Pragma("unroll") for (int k = 0; k < 2; ++k) \
        acc[ai][bj][m][n] = __builtin_amdgcn_mfma_f32_16x16x32_bf16(Bt[n][k], At[m][k], acc[ai][bj][m][n], 0, 0, 0); __builtin_amdgcn_s_setprio(0); } while (0)
#define PG8_WAIT_V(n) asm volatile("s_waitcnt vmcnt(" #n ")" ::: "memory")
#define PG8_WAIT_L(n) asm volatile("s_waitcnt lgkmcnt(" #n ")" ::: "memory")
#define PG8_BAR __builtin_amdgcn_s_barrier()
#define PG8_SCHED __builtin_amdgcn_sched_barrier(0)
    Unit cur, nxt; int ui = 0;
    if (!S.next(0, cur)) return;
    f32x4 acc[2][2][4][2];
#pragma unroll
    for (int a = 0; a < 2; ++a)
#pragma unroll
        for (int b = 0; b < 2; ++b)
#pragma unroll
            for (int m = 0; m < 4; ++m)
#pragma unroll
                for (int n = 0; n < 2; ++n) acc[a][b][m][n] = (f32x4){0.f, 0.f, 0.f, 0.f};
    bf16x8 At[4][2], B0[2][2], B1[2][2];
    const char* cA = (const char*)g.A + (size_t)cur.pm * tstep; const char* cB = (const char*)g.Bt + (size_t)cur.pn * tstep;
    S.a_ready(cur);
    if constexpr (SP2) {
        PG8_STAGE(PG8_SB(0, 0), cB, voffB); PG8_STAGE(PG8_SB(0, 1), cB + hstep, voffB); PG8_STAGE(PG8_SA(0, 0), cA, voffA); PG8_STAGE(PG8_SA(0, 1), cA + hstep, voffA);
        if (wr == 1) PG8_BAR;
        PG8_WAIT_V(2); PG8_BAR;
        PG8_STAGE(PG8_SB(1, 0), cB + kstep, voffB); PG8_STAGE(PG8_SA(1, 0), cA + kstep, voffA); PG8_STAGE(PG8_SB(1, 1), cB + hstep + kstep, voffB);
        PG8_WAIT_V(6); PG8_BAR;
    } else {
        PG8_STAGE(PG8_SB(0, 0), cB, voffB); PG8_STAGE(PG8_SA(0, 0), cA, voffA); PG8_STAGE(PG8_SB(0, 1), cB + hstep, voffB); PG8_STAGE(PG8_SA(0, 1), cA + hstep, voffA);
        if (wr == 1) PG8_BAR;
        PG8_WAIT_V(4); PG8_BAR;
        PG8_STAGE(PG8_SB(1, 0), cB + kstep, voffB); PG8_STAGE(PG8_SA(1, 0), cA + kstep, voffA); PG8_STAGE(PG8_SB(1, 1), cB + hstep + kstep, voffB);
        PG8_WAIT_V(6); PG8_BAR;
    }
    for (;;) {
        const bool has_next = S.next(ui + 1, nxt);
        const char* nA = has_next ? (const char*)g.A + (size_t)nxt.pm * tstep : cA; const char* nB = has_next ? (const char*)g.Bt + (size_t)nxt.pn * tstep : cB;
        for (int t = 0; t < nt; t += 2) {
            const bool last = (t == nt - 2);
            const char* a1 = cA + (size_t)(t + 1) * kstep;
            const char* a2 = last ? nA : cA + (size_t)(t + 2) * kstep; const char* b2 = last ? nB : cB + (size_t)(t + 2) * kstep;
            const char* a3 = a2 + kstep; const char* b3 = b2 + kstep;
            if (last && has_next) S.a_ready(nxt);
            if constexpr (SP2) {
            PG8_LDB(B0, 0, 0); PG8_LDB(B1, 0, 1); PG8_SCHED; PG8_LDA(At, 0, 0); PG8_STAGE(PG8_SA(1, 1), a1 + hstep, voffA);
            PG8_WAIT_V(8); PG8_WAIT_L(0); PG8_BAR; PG8_MMA(0, 0, At, B0); PG8_MMA(0, 1, At, B1); PG8_BAR; PG8_SCHED;
            PG8_LDA(At, 0, 1); PG8_STAGE(PG8_SB(0, 0), b2, voffB); PG8_STAGE(PG8_SB(0, 1), b2 + hstep, voffB); PG8_STAGE(PG8_SA(0, 0), a2, voffA);
            PG8_WAIT_V(8); PG8_WAIT_L(0); PG8_BAR; PG8_MMA(1, 0, At, B0); PG8_MMA(1, 1, At, B1); PG8_BAR; PG8_SCHED;
            PG8_LDB(B0, 1, 0); PG8_LDB(B1, 1, 1); PG8_SCHED; PG8_LDA(At, 1, 0); PG8_STAGE(PG8_SA(0, 1), a2 + hstep, voffA);
            PG8_WAIT_V(8); PG8_WAIT_L(0); PG8_BAR; PG8_MMA(0, 0, At, B0); PG8_MMA(0, 1, At, B1); PG8_BAR; PG8_SCHED;
            PG8_LDA(At, 1, 1); PG8_STAGE(PG8_SB(1, 0), b3, voffB); PG8_STAGE(PG8_SB(1, 1), b3 + hstep, voffB); PG8_STAGE(PG8_SA(1, 0), a3, voffA);
            PG8_WAIT_V(8); PG8_WAIT_L(0); PG8_BAR; PG8_MMA(1, 0, At, B0); PG8_MMA(1, 1, At, B1); PG8_BAR; PG8_SCHED;
            } else {
            PG8_LDB(B0, 0, 0); PG8_SCHED; PG8_LDA(At, 0, 0); PG8_STAGE(PG8_SA(1, 1), a1 + hstep, voffA);
            PG8_WAIT_L(8); PG8_BAR; PG8_WAIT_L(0); PG8_MMA(0, 0, At, B0); PG8_BAR; PG8_SCHED;
            PG8_LDB(B1, 0, 1); PG8_STAGE(PG8_SB(0, 0), b2, voffB);
            PG8_BAR; PG8_WAIT_L(0); PG8_MMA(0, 1, At, B1); PG8_BAR;
            PG8_LDA(At, 0, 1); PG8_STAGE(PG8_SA(0, 0), a2, voffA);
            PG8_BAR; PG8_WAIT_L(0); PG8_MMA(1, 0, At, B0); PG8_BAR; PG8_SCHED;
            PG8_STAGE(PG8_SB(0, 1), b2 + hstep, voffB);
            PG8_WAIT_V(6); PG8_BAR; PG8_MMA(1, 1, At, B1); PG8_BAR;
            PG8_LDB(B0, 1, 0); PG8_SCHED; PG8_LDA(At, 1, 0); PG8_STAGE(PG8_SA(0, 1), a2 + hstep, voffA);
            PG8_WAIT_L(8); PG8_BAR; PG8_WAIT_L(0); PG8_MMA(0, 0, At, B0); PG8_BAR; PG8_SCHED;
            PG8_LDB(B1, 1, 1); PG8_STAGE(PG8_SB(1, 0), b3, voffB);
            PG8_BAR; PG8_WAIT_L(0); PG8_MMA(0, 1, At, B1); PG8_BAR;
            PG8_LDA(At, 1, 1); PG8_STAGE(PG8_SA(1, 0), a3, voffA);
            PG8_BAR; PG8_WAIT_L(0); PG8_MMA(1, 0, At, B0); PG8_BAR; PG8_SCHED;
            PG8_STAGE(PG8_SB(1, 1), b3 + hstep, voffB);
            PG8_WAIT_V(6); PG8_BAR; PG8_MMA(1, 1, At, B1); PG8_BAR;
            }
        }
        if constexpr (ALIGN_EPI) { if (wr == 0) PG8_BAR; }
        if constexpr (!Epi::AFTER_DRAIN) { E(acc, cur, wr, wc, fr, fq); S.done(cur); }
        if (!has_next) break;
#pragma unroll
        for (int a = 0; a < 2; ++a)
#pragma unroll
            for (int b = 0; b < 2; ++b)
#pragma unroll
                for (int m = 0; m < 4; ++m)
#pragma unroll
                    for (int n = 0; n < 2; ++n) acc[a][b][m][n] = (f32x4){0.f, 0.f, 0.f, 0.f};
        cur = nxt; cA = nA; cB = nB; ++ui;
        if constexpr (ALIGN_EPI) { if (wr == 1) PG8_BAR; }
    }
    PG8_WAIT_V(0);
    if constexpr (!ALIGN_EPI) { if (wr == 0) PG8_BAR; }
    PG8_BAR;
    if constexpr (Epi::AFTER_DRAIN) { E.fused(acc, cur, wr, wc, fr, fq, lds, wid, lane); S.done(cur); }
#undef PG8_SA
#undef PG8_SB
#undef PG8_STAGE
#undef PG8_LDA
#undef PG8_LDB
#undef PG8_MMA
#undef PG8_WAIT_V
#undef PG8_WAIT_L
#undef PG8_BAR
#undef PG8_SCHED
}
}


#ifndef PG8_SP2
#define PG8_SP2 true
#endif
#ifndef PG8_ALIGN
#define PG8_ALIGN true
#endif
constexpr int NWAVES = 8;
constexpr int MP = pg8::MP, MS = pg8::MS, MVALID = pg8::MVALID, MT = pg8::MT, DM = 1024, DFF = 2816;
constexpr int SEQ = 4096, NB = 4, NSB = 32, PAST = 8192, NPOOL = 2560;
constexpr int ZC0 = 3328, ZC1 = 2304;
constexpr int Z1_Q = 0, Z1_K = 768, Z1_V = 1024, Z1_IQ = 1280, Z1_IK = 1792, Z1_IW = 1856, Z1_MQ = 1920;
constexpr int NMEMROWS = 1024, MEMROW0 = MT;
constexpr float EPS = 1e-6f;
constexpr size_t MiB = 1u << 20;
constexpr size_t WS_CTL = 0, CTL_ZERO_BYTES = 2 * MiB;
constexpr size_t WS_WIN0 = 2 * MiB, WS_WIN1 = 11 * MiB, WS_WOUT = 16 * MiB, WS_WGU = 20 * MiB, WS_WD = 42 * MiB;
constexpr size_t WS_XB = 54 * MiB, WS_MEMKV = 89 * MiB, WS_MIX = 94 * MiB, WS_Z = 128 * MiB, WS_U = 234 * MiB, WS_UP = 324 * MiB, WS_ACT = 414 * MiB;
constexpr size_t WS_QB = 504 * MiB, WS_KB = 528 * MiB, WS_VB = 536 * MiB, WS_IQB = 544 * MiB, WS_IKB = 560 * MiB, WS_IW = 562 * MiB;
constexpr size_t WS_SQ = 563 * MiB, WS_SIQ = WS_SQ + 512 * 1024, WS_SIW = WS_SIQ + 384 * 1024, WS_SSC = 564 * MiB, WS_SIDX = 569 * MiB, WS_MASK = 570 * MiB, WS_SC = 578 * MiB, WS_END = 834 * MiB;
constexpr int SSC_LD = 8256;
constexpr int CW_TMO = 0, CW_BAR = 4096, CW_Q = 8192, CW_SS = 16384;
constexpr size_t O_YP = 0, O_YS = O_YP + (size_t)MP * DM, O_HP = O_YS + (size_t)MS * DM, O_HS = O_HP + 4 * 6 * 16384, O_KP = O_HS + 32 * 6 * 16384,
    O_VP = O_KP + (size_t)MP * 256, O_IKP = O_VP + (size_t)MP * 256, O_KS = O_IKP + (size_t)MP * 64, O_VS = O_KS + MS * 256, O_IKS = O_VS + MS * 256,
    O_MK = O_IKS + MS * 64, O_MV = O_MK + 2 * 1024 * 256, O_CVP = O_MV + 2 * 1024 * 256, O_CVS = O_CVP + 2 * 4 * 2 * DFF, O_END = O_CVS + 2 * 32 * 2 * DFF;
static_assert(O_END == 31412224, "output size");
constexpr int RING_OFF = 0, RING_BYTES = 131072;
constexpr int LDSCTL_OFF = RING_BYTES, MISC_OFF = LDSCTL_OFF + 320;
constexpr int LDS_BYTES = 147456;

#define GAS __attribute__((address_space(1)))
#define LAS __attribute__((address_space(3)))
typedef unsigned short bf16;
typedef unsigned v4u __attribute__((ext_vector_type(4)));
typedef float f32x4 __attribute__((ext_vector_type(4)));
typedef short bf16x8 __attribute__((ext_vector_type(8)));
typedef GAS unsigned gu32;
typedef GAS unsigned long long gu64;
#define RLX_AGENT __ATOMIC_RELAXED, __HIP_MEMORY_SCOPE_AGENT
#define LDS_WAIT() asm volatile("s_waitcnt lgkmcnt(0)" ::: "memory")
#define VM_WAIT() asm volatile("s_waitcnt vmcnt(0)" ::: "memory")
__device__ __forceinline__ unsigned long long rt() { return __builtin_amdgcn_s_memrealtime(); }
__device__ __forceinline__ unsigned f2bf(float f) { unsigned u = __builtin_bit_cast(unsigned, f); return (u + 0x7fffu + ((u >> 16) & 1u)) >> 16; }
__device__ __forceinline__ unsigned pk2(float lo, float hi) { return f2bf(lo) | (f2bf(hi) << 16); }

#define XB_TMO      128
#define XB_XCNT(j)  (256  + 64 * (j))
#define XB_XSUB(j)  (1280 + 64 * (j))
#define XB_XGEN(j)  (2304 + 64 * (j))
#define XB_TOP      3328
#define XB_TOPGEN   3392
#define XCD_BAR_WORDS 3456
#define XB_SPIN_CAP (1u << 18)

__device__ __forceinline__ unsigned xb_ld(unsigned* p)              { return __hip_atomic_load(p, __ATOMIC_RELAXED, __HIP_MEMORY_SCOPE_AGENT); }
__device__ __forceinline__ unsigned xb_add(unsigned* p, unsigned v) { return __hip_atomic_fetch_add(p, v, __ATOMIC_RELAXED, __HIP_MEMORY_SCOPE_AGENT); }
__device__ __forceinline__ unsigned xb_xcc_id() { return (unsigned)__builtin_amdgcn_s_getreg((3 << 11) | 20) & 0xFu; }
#define XB_SPIN(cond, bar) do { unsigned _sp = 0; while (cond) { __builtin_amdgcn_s_sleep(1); \
    if ((++_sp & 255u) == 0u) { if (xb_ld(&(bar)[XB_TMO])) break; if (_sp > XB_SPIN_CAP) { atomicAdd(&(bar)[XB_TMO], 1u); break; } } } } while (0)

struct XcdBarrier {
    unsigned* bar; unsigned x;
    volatile LAS unsigned* st;
};

__device__ __forceinline__ XcdBarrier xcd_barrier_post(unsigned* bar, volatile LAS unsigned* st) {
    XcdBarrier b; b.bar = bar; b.x = xb_xcc_id(); b.st = st;
    if (threadIdx.x == 0) (void)xb_add(&bar[XB_XCNT(b.x)], 1u);
    return b;
}
__device__ __forceinline__ void xcd_barrier_complete(unsigned* bar, unsigned x, unsigned& nloc, unsigned& nx) {
    const unsigned G = gridDim.x * gridDim.y * gridDim.z;
    unsigned sum, cnt, mine, sp = 0u;
    for (;;) {
        sum = 0u; cnt = 0u; mine = 0u;
#pragma unroll
        for (unsigned j = 0; j < 16; ++j) { const unsigned c = xb_ld(&bar[XB_XCNT(j)]); sum += c; cnt += (c > 0u) ? 1u : 0u; mine = (j == x) ? c : mine; }
        if (sum == G) break;
        __builtin_amdgcn_s_sleep(1);
        if ((++sp & 255u) == 0u) { if (xb_ld(&bar[XB_TMO])) break; if (sp > XB_SPIN_CAP) { atomicAdd(&bar[XB_TMO], 1u); break; } }
    }
    nloc = mine > 0u ? mine : 1u; nx = cnt > 0u ? cnt : 1u;
}

__device__ __forceinline__ void xcd_barrier(const XcdBarrier& b) {
    asm volatile("s_waitcnt vmcnt(0)" ::: "memory");
    __syncthreads();
    if (threadIdx.x == 0) {
        unsigned* bar = b.bar;
        __builtin_amdgcn_s_waitcnt(0);
        unsigned nloc = b.st[0], nx = b.st[1];
        if (nloc == 0u) { xcd_barrier_complete(bar, b.x, nloc, nx); b.st[0] = nloc; b.st[1] = nx; }
        const unsigned old = xb_add(&bar[XB_XSUB(b.x)], 1u);
        const unsigned gen = old / nloc;
        if (old + 1u == (gen + 1u) * nloc) {
            __builtin_amdgcn_fence(__ATOMIC_RELEASE, "agent");
            asm volatile("s_waitcnt vmcnt(0)" ::: "memory");
            const unsigned og = xb_add(&bar[XB_TOP], 1u);
            const unsigned tg = og / nx;
            if (og + 1u == (tg + 1u) * nx) xb_add(&bar[XB_TOPGEN], 1u);
            else XB_SPIN(xb_ld(&bar[XB_TOPGEN]) == tg, bar);
            __builtin_amdgcn_fence(__ATOMIC_ACQUIRE, "agent");
            xb_add(&bar[XB_XGEN(b.x)], 1u);
            asm volatile("s_waitcnt vmcnt(0)" ::: "memory");
        } else {
            XB_SPIN(xb_ld(&bar[XB_XGEN(b.x)]) == gen, bar);
            __builtin_amdgcn_fence(__ATOMIC_ACQUIRE, "agent");
            asm volatile("s_waitcnt vmcnt(0)" ::: "memory");
        }
    }
    __syncthreads();
}


struct Args { const float* in[29]; const int* page_table; float* out; unsigned char* ws; int ph_lo, ph_hi; };
struct Ctx { LAS unsigned char* lds; volatile LAS unsigned* MISC; gu32* ctl; int tid, lane, wave, vcu, G, qoff; };
typedef float f32x16 __attribute__((ext_vector_type(16)));
typedef unsigned long long u64;

__device__ __forceinline__ float bf2f(unsigned b) { return __builtin_bit_cast(float, b << 16); }
__device__ __forceinline__ float wave_sum(float v) {
#pragma unroll
    for (int o = 1; o < 64; o <<= 1) v += __shfl_xor(v, o);
    return v;
}
__device__ __forceinline__ int crow(int r, int hi) { return (r & 3) + 8 * (r >> 2) + 4 * hi; }
__device__ __forceinline__ float sigmoidf_(float x) { return 1.0f / (1.0f + __expf(-x)); }
__device__ __forceinline__ float* ssptr(const Ctx& c, int i) { return (float*)(c.ctl + CW_SS) + (size_t)i * MT; }

__device__ __forceinline__ int q_next(Ctx& c, int qi) {
    __syncthreads();
    if (c.tid == 0) c.MISC[16] = atomicAdd((unsigned*)(c.ctl + CW_Q + 64 * (qi + c.qoff)), 1u);
    __syncthreads();
    return (int)c.MISC[16];
}

template <int K>
__device__ __forceinline__ f32x16 mm32(const LAS bf16* A, int lda, const LAS bf16* Bt, int ldb, f32x16 acc, int lane) {
    const int r = lane & 31, h = lane >> 5;
#pragma unroll
    for (int ks = 0; ks < K; ks += 16) {
        const bf16x8 a = *(const LAS bf16x8*)(A + r * lda + ks + 8 * h);
        const bf16x8 b = *(const LAS bf16x8*)(Bt + r * ldb + ks + 8 * h);
        acc = __builtin_amdgcn_mfma_f32_32x32x16_bf16(a, b, acc, 0, 0, 0);
    }
    return acc;
}

__device__ __forceinline__ int map_row(int mapid, int n, int row_off) {
    if (mapid == 0) return n + row_off;
    if (mapid == 1) return n < 1864 ? n : n + 56;
    if (mapid == 2) return (n >> 7) * 256 + (n & 127);
    return (n >> 7) * 256 + 128 + (n & 127);
}
__device__ __forceinline__ void transpose_item(const float* W, int K, int N, const float* kscale, bf16* WT, int mapid, int row_off, LAS float* scr, int item, int lane) {
    const int nblk = (N + 31) / 32, kb = item / nblk, nb = item % nblk, k0 = 64 * kb, n0 = 32 * nb;
#pragma unroll 8
    for (int i = 0; i < 32; ++i) { const int kk = 2 * i + (lane >> 5), n = n0 + (lane & 31);
        float v = W[(size_t)(k0 + kk) * N + (n < N ? n : N - 1)]; if (kscale) v *= kscale[k0 + kk];
        scr[kk * 33 + (lane & 31)] = v; }
    LDS_WAIT(); asm volatile("" ::: "memory");
    const int cc = lane & 7;
#pragma unroll
    for (int j = 0; j < 4; ++j) { const int nl = (lane >> 3) + 8 * j, n = n0 + nl; const LAS float* s = scr + (8 * cc) * 33 + nl;
        v4u o; o.x = pk2(s[0 * 33], s[1 * 33]); o.y = pk2(s[2 * 33], s[3 * 33]); o.z = pk2(s[4 * 33], s[5 * 33]); o.w = pk2(s[6 * 33], s[7 * 33]);
        if (n < N) *(GAS v4u*)(WT + (size_t)map_row(mapid, n, row_off) * K + k0 + 8 * cc) = o; }
    LDS_WAIT(); asm volatile("" ::: "memory");
}
__device__ __forceinline__ void p0_prologue(Ctx& c, const Args& a) {
    LAS float* scr = (LAS float*)(c.lds + RING_OFF + c.wave * 16384);
    const int gw = c.vcu * NWAVES + c.wave, NGW = c.G * NWAVES, lane = c.lane;
    unsigned char* ws = a.ws;
    constexpr int I_INH = 16 * 104, I_MKV = 16 * 16, I_DSA = 16 * 67, I_OUT = 16 * 32, I_G = 16 * 88, I_D = 44 * 32;
    constexpr int NITEMS = I_INH + 2 * I_MKV + I_DSA + 2 * I_OUT + 4 * I_G + 2 * I_D;
    for (int it = gw; it < NITEMS; it += NGW) {
        int r = it;
        if (r < I_INH) { transpose_item(a.in[13], 1024, 3328, a.in[11], (bf16*)(ws + WS_WIN0), 0, 0, scr, r, lane); continue; } r -= I_INH;
        if (r < I_MKV) { transpose_item(a.in[20], 1024, 512, nullptr, (bf16*)(ws + WS_WIN0), 0, 3328, scr, r, lane); continue; } r -= I_MKV;
        if (r < I_MKV) { transpose_item(a.in[20] + 1024 * 512, 1024, 512, nullptr, (bf16*)(ws + WS_WIN0), 0, 3840, scr, r, lane); continue; } r -= I_MKV;
        if (r < I_DSA) { transpose_item(a.in[16], 1024, 2120, a.in[11] + 1024, (bf16*)(ws + WS_WIN1), 1, 0, scr, r, lane); continue; } r -= I_DSA;
        if (r < 2 * I_OUT) { const int l = r / I_OUT; transpose_item(a.in[23] + (size_t)l * 1024 * 1024, 1024, 1024, nullptr, (bf16*)(ws + WS_WOUT) + (size_t)l * 1024 * 1024, 0, 0, scr, r % I_OUT, lane); continue; } r -= 2 * I_OUT;
        if (r < 2 * I_G) { const int l = r / I_G; transpose_item(a.in[24] + (size_t)l * 1024 * DFF, 1024, DFF, a.in[12] + l * 1024, (bf16*)(ws + WS_WGU) + (size_t)l * 5632 * 1024, 2, 0, scr, r % I_G, lane); continue; } r -= 2 * I_G;
        if (r < 2 * I_G) { const int l = r / I_G; transpose_item(a.in[25] + (size_t)l * 1024 * DFF, 1024, DFF, a.in[12] + l * 1024, (bf16*)(ws + WS_WGU) + (size_t)l * 5632 * 1024, 3, 0, scr, r % I_G, lane); continue; } r -= 2 * I_G;
        { const int l = r / I_D; transpose_item(a.in[28] + (size_t)l * DFF * 1024, DFF, 1024, nullptr, (bf16*)(ws + WS_WD) + (size_t)l * 1024 * DFF, 0, 0, scr, r % I_D, lane); }
    }
    for (int rr = gw; rr < 184; rr += NGW) { const int row = rr < 56 ? 1864 + rr : 2176 + (rr - 56);
        GAS v4u* p = (GAS v4u*)((bf16*)(ws + WS_WIN1) + (size_t)row * 1024); p[lane] = (v4u){0u, 0u, 0u, 0u}; p[64 + lane] = (v4u){0u, 0u, 0u, 0u}; }
    float* ss0 = ssptr(c, 0);
    for (int m = gw; m < MT + NMEMROWS; m += NGW) {
        GAS u64* o8 = (GAS u64*)((bf16*)(ws + WS_XB) + (size_t)m * DM) + lane;
        if (m >= MVALID && m < MT) {
#pragma unroll
            for (int j = 0; j < 4; ++j) o8[64 * j] = 0ull;
            continue; }
        const float* src = m < MP ? a.in[0] + (size_t)m * DM : (m < MVALID ? a.in[1] + (size_t)(m - MP) * DM : a.in[10] + (size_t)(m - MT) * DM);
        const GAS f32x4* xr = (const GAS f32x4*)src + lane; f32x4 v[4]; float s = 0.f;
#pragma unroll
        for (int j = 0; j < 4; ++j) { v[j] = xr[64 * j]; s += (v[j].x * v[j].x + v[j].y * v[j].y) + (v[j].z * v[j].z + v[j].w * v[j].w); }
        s = wave_sum(s);
#pragma unroll
        for (int j = 0; j < 4; ++j) o8[64 * j] = (u64)pk2(v[j].x, v[j].y) | ((u64)pk2(v[j].z, v[j].w) << 32);
        if (m < MVALID && lane == 0) ss0[m] = s;
    }
}

__device__ __forceinline__ void memattn_unit(Ctx& c, const bf16* Zq  , int ldz, int nrows_valid, const float* Kp, const float* Vp, int kstride,
                                             bool normk, const float* kgain, const float* qgain, bf16* Out  ) {
    LAS bf16* KN = (LAS bf16*)(c.lds);
    LAS bf16* VTm = (LAS bf16*)(c.lds + 36864);
    LAS bf16* QN = (LAS bf16*)(c.lds + 70656) + c.wave * (32 * 72);
    LAS float* LI = (LAS float*)(c.lds + 107520) + c.wave * 32;
    int tid = c.tid; asm volatile("" : "+v"(tid));
    const int lane = tid & 63, w = c.wave;
    {
        const int m = tid >> 1, dh = (tid & 1) * 32;
        f32x4 kv[8]; float s = 0.f;
#pragma unroll
        for (int j = 0; j < 8; ++j) { kv[j] = *(const f32x4*)(Kp + (size_t)m * kstride + dh + 4 * j); s += (kv[j].x * kv[j].x + kv[j].y * kv[j].y) + (kv[j].z * kv[j].z + kv[j].w * kv[j].w); }
        s += __shfl_xor(s, 1);
        const float rs = normk ? rsqrtf(s * (1.0f / 64.0f) + EPS) : 1.0f;
#pragma unroll
        for (int j = 0; j < 8; j += 2) { f32x4 g0 = {1.f, 1.f, 1.f, 1.f}, g1 = g0;
            if (normk) { g0 = *(const f32x4*)(kgain + dh + 4 * j); g1 = *(const f32x4*)(kgain + dh + 4 * j + 4); }
            const f32x4 x0 = kv[j] * rs * g0, x1 = kv[j + 1] * rs * g1;
            v4u o; o.x = pk2(x0.x, x0.y); o.y = pk2(x0.z, x0.w); o.z = pk2(x1.x, x1.y); o.w = pk2(x1.z, x1.w);
            *(LAS v4u*)(KN + m * 72 + dh + 4 * j) = o; }
#pragma unroll
        for (int j = 0; j < 8; ++j) { const f32x4 vv = *(const f32x4*)(Vp + (size_t)m * kstride + dh + 4 * j);
            VTm[(dh + 4 * j + 0) * 264 + m] = (bf16)f2bf(vv.x); VTm[(dh + 4 * j + 1) * 264 + m] = (bf16)f2bf(vv.y);
            VTm[(dh + 4 * j + 2) * 264 + m] = (bf16)f2bf(vv.z); VTm[(dh + 4 * j + 3) * 264 + m] = (bf16)f2bf(vv.w); }
    }
    {
        const int row = lane >> 1, hf = lane & 1, grow = w * 32 + row;
        float x[32]; float s = 0.f;
        if (grow < nrows_valid) {
#pragma unroll
            for (int j = 0; j < 4; ++j) { const v4u q = *(const v4u*)(Zq + (size_t)grow * ldz + hf * 32 + 8 * j);
                x[8 * j + 0] = bf2f(q.x & 0xffffu); x[8 * j + 1] = bf2f(q.x >> 16); x[8 * j + 2] = bf2f(q.y & 0xffffu); x[8 * j + 3] = bf2f(q.y >> 16);
                x[8 * j + 4] = bf2f(q.z & 0xffffu); x[8 * j + 5] = bf2f(q.z >> 16); x[8 * j + 6] = bf2f(q.w & 0xffffu); x[8 * j + 7] = bf2f(q.w >> 16); }
        } else {
#pragma unroll
            for (int j = 0; j < 32; ++j) x[j] = 0.f;
        }
#pragma unroll
        for (int j = 0; j < 32; ++j) s += x[j] * x[j];
        s += __shfl_xor(s, 1);
        const float rs = rsqrtf(s * (1.0f / 64.0f) + EPS) * 0.125f;
#pragma unroll
        for (int j = 0; j < 32; j += 8) { v4u o;
            o.x = pk2(x[j] * rs * qgain[hf * 32 + j], x[j + 1] * rs * qgain[hf * 32 + j + 1]); o.y = pk2(x[j + 2] * rs * qgain[hf * 32 + j + 2], x[j + 3] * rs * qgain[hf * 32 + j + 3]);
            o.z = pk2(x[j + 4] * rs * qgain[hf * 32 + j + 4], x[j + 5] * rs * qgain[hf * 32 + j + 5]); o.w = pk2(x[j + 6] * rs * qgain[hf * 32 + j + 6], x[j + 7] * rs * qgain[hf * 32 + j + 7]);
            *(LAS v4u*)(QN + row * 72 + hf * 32 + j) = o; }
    }
    __syncthreads();
    if (w * 32 < nrows_valid) {
        const int r32 = lane & 31, hh = lane >> 5;
        f32x16 s[8];
#pragma unroll
        for (int mt = 0; mt < 8; ++mt) { f32x16 z = {}; s[mt] = mm32<64>(KN + mt * 32 * 72, 72, QN, 72, z, lane); }
        float mx = -1e30f;
#pragma unroll
        for (int mt = 0; mt < 8; ++mt)
#pragma unroll
            for (int r = 0; r < 16; ++r) mx = fmaxf(mx, s[mt][r]);
        mx = fmaxf(mx, __shfl_xor(mx, 32));
        float l = 0.f;
#pragma unroll
        for (int mt = 0; mt < 8; ++mt)
#pragma unroll
            for (int r = 0; r < 16; ++r) { const float p = __expf(s[mt][r] - mx); s[mt][r] = p; l += p; }
        l += __shfl_xor(l, 32);
        if (hh == 0) LI[r32] = l;
        f32x16 o[2] = {};
#pragma unroll
        for (int mt = 0; mt < 8; ++mt)
#pragma unroll
            for (int sx = 0; sx < 2; ++sx) {
                v4u pa; pa.x = pk2(s[mt][8 * sx + 0], s[mt][8 * sx + 1]); pa.y = pk2(s[mt][8 * sx + 2], s[mt][8 * sx + 3]);
                pa.z = pk2(s[mt][8 * sx + 4], s[mt][8 * sx + 5]); pa.w = pk2(s[mt][8 * sx + 6], s[mt][8 * sx + 7]);
                const bf16x8 af = __builtin_bit_cast(bf16x8, pa);
#pragma unroll
                for (int dt = 0; dt < 2; ++dt) { const LAS bf16* vp = VTm + (dt * 32 + r32) * 264 + mt * 32 + 16 * sx + 4 * hh;
                    const u64 lo = *(const LAS u64*)vp, hi = *(const LAS u64*)(vp + 8);
                    v4u bw; bw.x = (unsigned)lo; bw.y = (unsigned)(lo >> 32); bw.z = (unsigned)hi; bw.w = (unsigned)(hi >> 32);
                    o[dt] = __builtin_amdgcn_mfma_f32_32x32x16_bf16(af, __builtin_bit_cast(bf16x8, bw), o[dt], 0, 0, 0); }
            }
        LDS_WAIT();
#pragma unroll
        for (int r = 0; r < 16; ++r) { const int qr = crow(r, hh), grow = w * 32 + qr; const float il = 1.0f / LI[qr];
            if (grow < nrows_valid) {
#pragma unroll
                for (int dt = 0; dt < 2; ++dt) Out[(size_t)grow * DM + dt * 32 + r32] = (bf16)f2bf(o[dt][r] * il); } }
    }
}

constexpr int HG_GS = 4, HG_NG = SEQ / (32 * HG_GS);
constexpr size_t WS_HOL = WS_U, WS_HQC = WS_UP, WS_HUT = WS_ACT, WS_HST = WS_ACT + 64 * MiB, WS_HDG = WS_ACT + 50 * MiB;
template <bool PROMPT>
__device__ __forceinline__ void hgrn_unit(Ctx& c, const Args& a, int b, int h, int g) {
    LAS unsigned char* L = c.lds;
    LAS float* LF = (LAS float*)(L + 0);
    LAS float* BL = (LAS float*)(L + 16384);
    LAS float* DVv = (LAS float*)(L + 16896);
    LAS bf16* QD = (LAS bf16*)(L + 17408);
    LAS bf16* KD = (LAS bf16*)(L + 26112);
    LAS bf16* KET = (LAS bf16*)(L + 34816);
    LAS bf16* VT = (LAS bf16*)(L + 45056);
    LAS bf16* SCB = (LAS bf16*)(L + 55296);
    LAS bf16* STt = (LAS bf16*)(L + 57856);
    LAS float* BOFF = (LAS float*)(L + 92672);
    int tid = c.tid; asm volatile("" : "+v"(tid));
    const int lane = tid & 63, w = c.wave, r32 = lane & 31, hh = lane >> 5;
    const int te = tid >> 4, k8 = (tid & 15) * 8;
    const bf16* Z = (const bf16*)(a.ws + WS_Z);
    bf16* MIX = (bf16*)(a.ws + WS_MIX);
    const int nch = PROMPT ? HG_GS : 1, nvalid = PROMPT ? 32 : 4;
    const int kt = w >> 1, vt0 = 2 * (w & 1);
    const int unit = (b * 6 + h) * HG_NG + g;
    f32x16 S0 = {}, S1 = {};
    if (!PROMPT) { const float* sp = a.in[7] + (size_t)(b * 6 + h) * 16384;
#pragma unroll
        for (int r = 0; r < 16; ++r) { const int k = 32 * kt + crow(r, hh); S0[r] = sp[k * 128 + 32 * vt0 + r32]; S1[r] = sp[k * 128 + 32 * (vt0 + 1) + r32]; } }
    float lbv[8], onv[8];
#pragma unroll
    for (int j = 0; j < 8; ++j) { const float l0 = a.in[14][h * 128 + k8 + j], l1 = a.in[14][768 + h * 128 + k8 + j]; lbv[j] = 1.0f / (1.0f + __expf(l1 - l0)); onv[j] = a.in[15][k8 + j]; }
    __syncthreads();
    if (tid < 128) BOFF[tid] = 0.f;
#define HG_WRITE_ST() do { _Pragma("unroll") for (int g4 = 0; g4 < 4; ++g4) { const int k0 = 32 * kt + 8 * g4 + 4 * hh; \
        *(LAS u64*)(STt + (32 * vt0 + r32) * 136 + k0) = (u64)pk2(S0[4 * g4], S0[4 * g4 + 1]) | ((u64)pk2(S0[4 * g4 + 2], S0[4 * g4 + 3]) << 32); \
        *(LAS u64*)(STt + (32 * (vt0 + 1) + r32) * 136 + k0) = (u64)pk2(S1[4 * g4], S1[4 * g4 + 1]) | ((u64)pk2(S1[4 * g4 + 2], S1[4 * g4 + 3]) << 32); } } while (0)
    HG_WRITE_ST();
#pragma unroll 1
    for (int ch = 0; ch < nch; ++ch) {
        const int row0 = PROMPT ? b * SEQ + (g * HG_GS + ch) * 32 : MP + 4 * b, row = row0 + te;
        const bool valid = te < nvalid;
        float qs[8], kk[8]; v4u gz = {0u, 0u, 0u, 0u};
        {
            v4u zq = {0u, 0u, 0u, 0u}, zf = zq, zi = zq;
            if (valid) { const bf16* zr = Z + (size_t)row * ZC0 + h * 128 + k8;
                zq = *(const v4u*)zr; zf = *(const v4u*)(zr + 768); zi = *(const v4u*)(zr + 1536); if (!PROMPT) gz = *(const v4u*)(zr + 2304); }
            const unsigned qw[4] = {zq.x, zq.y, zq.z, zq.w}, fw[4] = {zf.x, zf.y, zf.z, zf.w}, iw[4] = {zi.x, zi.y, zi.z, zi.w};
            float lf[8];
#pragma unroll
            for (int j = 0; j < 8; ++j) { const float q = bf2f((qw[j >> 1] >> (16 * (j & 1))) & 0xffffu), fp = bf2f((fw[j >> 1] >> (16 * (j & 1))) & 0xffffu);
                const float sg = sigmoidf_(fp), f = lbv[j] + (1.0f - lbv[j]) * sg;
                qs[j] = valid ? q * sigmoidf_(q) : 0.f; kk[j] = valid ? (1.0f - f) : 0.f; lf[j] = valid ? __logf(f) : 0.f;
                VT[(k8 + j) * 40 + te] = (bf16)((iw[j >> 1] >> (16 * (j & 1))) & 0xffffu); }
            *(LAS f32x4*)(LF + te * 128 + k8) = (f32x4){lf[0], lf[1], lf[2], lf[3]}; *(LAS f32x4*)(LF + te * 128 + k8 + 4) = (f32x4){lf[4], lf[5], lf[6], lf[7]};
        }
        __syncthreads();
        if (tid < 128) { float bsum = 0.f;
#pragma unroll
            for (int t = 0; t < 32; ++t) { bsum += LF[t * 128 + tid]; LF[t * 128 + tid] = bsum; }
            BL[tid] = bsum; }
        __syncthreads();
        {
            const f32x4 b0 = *(const LAS f32x4*)(LF + te * 128 + k8), b1 = *(const LAS f32x4*)(LF + te * 128 + k8 + 4);
            const f32x4 l0 = *(const LAS f32x4*)(BL + k8), l1 = *(const LAS f32x4*)(BL + k8 + 4);
            const float bb[8] = {b0.x, b0.y, b0.z, b0.w, b1.x, b1.y, b1.z, b1.w}, bl[8] = {l0.x, l0.y, l0.z, l0.w, l1.x, l1.y, l1.z, l1.w};
            float qd[8], kd[8];
#pragma unroll
            for (int j = 0; j < 8; ++j) { qd[j] = qs[j] * __expf(bb[j]); kd[j] = kk[j] * __expf(-bb[j]); KET[(k8 + j) * 40 + te] = (bf16)f2bf(kk[j] * __expf(bl[j] - bb[j])); }
            v4u o; o.x = pk2(qd[0], qd[1]); o.y = pk2(qd[2], qd[3]); o.z = pk2(qd[4], qd[5]); o.w = pk2(qd[6], qd[7]); *(LAS v4u*)(QD + te * 136 + k8) = o;
            if (PROMPT) { const f32x4 f0 = *(const LAS f32x4*)(BOFF + k8), f1 = *(const LAS f32x4*)(BOFF + k8 + 4);
                const float bo[8] = {f0.x, f0.y, f0.z, f0.w, f1.x, f1.y, f1.z, f1.w}; float qc[8];
#pragma unroll
                for (int j = 0; j < 8; ++j) qc[j] = qd[j] * __expf(bo[j]);
                v4u oc; oc.x = pk2(qc[0], qc[1]); oc.y = pk2(qc[2], qc[3]); oc.z = pk2(qc[4], qc[5]); oc.w = pk2(qc[6], qc[7]);
                *(v4u*)((bf16*)(a.ws + WS_HQC) + (size_t)row * 768 + h * 128 + k8) = oc; }
            o.x = pk2(kd[0], kd[1]); o.y = pk2(kd[2], kd[3]); o.z = pk2(kd[4], kd[5]); o.w = pk2(kd[6], kd[7]); *(LAS v4u*)(KD + te * 136 + k8) = o;
            if (te == 0) {
#pragma unroll
                for (int j = 0; j < 8; ++j) DVv[k8 + j] = __expf(bl[j]); }
        }
        __syncthreads();
        f32x16 oacc = {};
        if (w == 0) { f32x16 z = {}; const f32x16 sc = mm32<128>(QD, 136, KD, 136, z, lane);
#pragma unroll
            for (int r = 0; r < 16; ++r) { const int t = crow(r, hh); SCB[t * 40 + r32] = (bf16)f2bf(r32 <= t ? sc[r] : 0.f); } }
        if (w < 4) oacc = mm32<128>(QD, 136, STt + (w * 32) * 136, 136, oacc, lane);
        if (PROMPT && tid >= 384) BOFF[tid - 384] += BL[tid - 384];
        __syncthreads();
        if (w < 4) { oacc = mm32<32>(SCB, 40, VT + (w * 32) * 40, 40, oacc, lane);
#pragma unroll
            for (int r = 0; r < 16; ++r) LF[crow(r, hh) * 128 + w * 32 + r32] = oacc[r]; }
        {
#pragma unroll
            for (int r = 0; r < 16; ++r) { const float d = DVv[32 * kt + crow(r, hh)]; S0[r] *= d; S1[r] *= d; }
            S0 = mm32<32>(KET + (kt * 32) * 40, 40, VT + (vt0 * 32) * 40, 40, S0, lane);
            S1 = mm32<32>(KET + (kt * 32) * 40, 40, VT + ((vt0 + 1) * 32) * 40, 40, S1, lane);
        }
        __syncthreads();
        HG_WRITE_ST();
        {
            const f32x4 o0 = *(const LAS f32x4*)(LF + te * 128 + k8), o1 = *(const LAS f32x4*)(LF + te * 128 + k8 + 4);
            if (PROMPT) { float* ol = (float*)(a.ws + WS_HOL) + (size_t)row * 768 + h * 128 + k8; *(f32x4*)ol = o0; *(f32x4*)(ol + 4) = o1; }
            else {
                float ov[8] = {o0.x, o0.y, o0.z, o0.w, o1.x, o1.y, o1.z, o1.w}; float s = 0.f;
#pragma unroll
                for (int j = 0; j < 8; ++j) s += ov[j] * ov[j];
                s += __shfl_xor(s, 1); s += __shfl_xor(s, 2); s += __shfl_xor(s, 4); s += __shfl_xor(s, 8);
                const float rs = rsqrtf(s * (1.0f / 128.0f) + EPS);
                const unsigned gw_[4] = {gz.x, gz.y, gz.z, gz.w}; float y[8];
#pragma unroll
                for (int j = 0; j < 8; ++j) { const float gg = bf2f((gw_[j >> 1] >> (16 * (j & 1))) & 0xffffu); y[j] = ov[j] * rs * onv[j] * (gg * sigmoidf_(gg)); }
                if (valid) { v4u o; o.x = pk2(y[0], y[1]); o.y = pk2(y[2], y[3]); o.z = pk2(y[4], y[5]); o.w = pk2(y[6], y[7]); *(v4u*)(MIX + (size_t)row * DM + h * 128 + k8) = o; }
            }
        }
        __syncthreads();
    }
#undef HG_WRITE_ST
    if (PROMPT) {
        float* ut = (float*)(a.ws + WS_HUT) + (size_t)unit * 16384;
#pragma unroll
        for (int g4 = 0; g4 < 4; ++g4) { const int k0 = 32 * kt + 8 * g4 + 4 * hh;
            *(f32x4*)(ut + (32 * vt0 + r32) * 128 + k0) = (f32x4){S0[4 * g4], S0[4 * g4 + 1], S0[4 * g4 + 2], S0[4 * g4 + 3]};
            *(f32x4*)(ut + (32 * (vt0 + 1) + r32) * 128 + k0) = (f32x4){S1[4 * g4], S1[4 * g4 + 1], S1[4 * g4 + 2], S1[4 * g4 + 3]}; }
        if (tid < 128) ((float*)(a.ws + WS_HDG))[(size_t)unit * 128 + tid] = __expf(BOFF[tid]);
    } else {
        float* so = a.out + O_HS + (size_t)(b * 6 + h) * 16384;
#pragma unroll
        for (int r = 0; r < 16; ++r) { const int k = 32 * kt + crow(r, hh); so[k * 128 + 32 * vt0 + r32] = S0[r]; so[k * 128 + 32 * (vt0 + 1) + r32] = S1[r]; }
    }
}
__device__ __forceinline__ void hgrn_scan(Ctx& c, const Args& a) {
    const float* UT = (const float*)(a.ws + WS_HUT); const float* DG = (const float*)(a.ws + WS_HDG); bf16* STo = (bf16*)(a.ws + WS_HST);
    for (int idx = c.vcu * 512 + c.tid; idx < 24 * 16384; idx += c.G * 512) {
        const int bh = idx >> 14, e = idx & 16383, k = e & 127, v = e >> 7;
        float s = 0.f;
#pragma unroll 8
        for (int g = 0; g < HG_NG; ++g) { const size_t u = (size_t)(bh * HG_NG + g); STo[u * 16384 + e] = (bf16)f2bf(s); s = DG[u * 128 + k] * s + UT[u * 16384 + e]; }
        a.out[O_HP + (size_t)bh * 16384 + k * 128 + v] = s;
    }
}
__device__ __forceinline__ void hgrn_fix_unit(Ctx& c, const Args& a, int b, int h, int g) {
    LAS bf16* STt = (LAS bf16*)(c.lds);
    LAS bf16* QCl = (LAS bf16*)(c.lds + 34816);
    LAS float* OB = (LAS float*)(c.lds + 34816 + 17408);
    int tid = c.tid; asm volatile("" : "+v"(tid));
    const int lane = tid & 63, w = c.wave, r32 = lane & 31, hh = lane >> 5;
    const int unit = (b * 6 + h) * HG_NG + g, row0 = b * SEQ + g * 128;
    const bf16* Z = (const bf16*)(a.ws + WS_Z); bf16* MIX = (bf16*)(a.ws + WS_MIX);
    const bf16* QC = (const bf16*)(a.ws + WS_HQC); const float* OL = (const float*)(a.ws + WS_HOL);
    const bf16* stg = (const bf16*)(a.ws + WS_HST) + (size_t)unit * 16384;
    __syncthreads();
#pragma unroll
    for (int i = 0; i < 4; ++i) { const int cidx = tid + 512 * i, v = cidx >> 4, kc = (cidx & 15) * 8; *(LAS v4u*)(STt + v * 136 + kc) = *(const v4u*)(stg + v * 128 + kc); }
    const int te = tid >> 4, k8 = (tid & 15) * 8;
    float onv[8];
#pragma unroll
    for (int j = 0; j < 8; ++j) onv[j] = a.in[15][k8 + j];
#pragma unroll 1
    for (int hf = 0; hf < 2; ++hf) {
        const int rb = row0 + hf * 64;
#pragma unroll
        for (int i = 0; i < 2; ++i) { const int cidx = tid + 512 * i, r = cidx >> 4, kc = (cidx & 15) * 8; *(LAS v4u*)(QCl + r * 136 + kc) = *(const v4u*)(QC + (size_t)(rb + r) * 768 + h * 128 + kc); }
        __syncthreads();
        { const int rt = w >> 2, vt = w & 3; f32x16 o = {};
          o = mm32<128>(QCl + (rt * 32) * 136, 136, STt + (vt * 32) * 136, 136, o, lane);
#pragma unroll
          for (int r = 0; r < 16; ++r) OB[(rt * 32 + crow(r, hh)) * 128 + vt * 32 + r32] = o[r]; }
        __syncthreads();
#pragma unroll
        for (int ps = 0; ps < 2; ++ps) { const int r = ps * 32 + te, row = rb + r;
            const f32x4 c0 = *(const LAS f32x4*)(OB + r * 128 + k8), c1 = *(const LAS f32x4*)(OB + r * 128 + k8 + 4);
            const float* ol = OL + (size_t)row * 768 + h * 128 + k8; const f32x4 l0 = *(const f32x4*)ol, l1 = *(const f32x4*)(ol + 4);
            const v4u gz = *(const v4u*)(Z + (size_t)row * ZC0 + 2304 + h * 128 + k8);
            float ov[8] = {c0.x + l0.x, c0.y + l0.y, c0.z + l0.z, c0.w + l0.w, c1.x + l1.x, c1.y + l1.y, c1.z + l1.z, c1.w + l1.w}; float s = 0.f;
#pragma unroll
            for (int j = 0; j < 8; ++j) s += ov[j] * ov[j];
            s += __shfl_xor(s, 1); s += __shfl_xor(s, 2); s += __shfl_xor(s, 4); s += __shfl_xor(s, 8);
            const float rs = rsqrtf(s * (1.0f / 128.0f) + EPS);
            const unsigned gw_[4] = {gz.x, gz.y, gz.z, gz.w}; float y[8];
#pragma unroll
            for (int j = 0; j < 8; ++j) { const float gg = bf2f((gw_[j >> 1] >> (16 * (j & 1))) & 0xffffu); y[j] = ov[j] * rs * onv[j] * (gg * sigmoidf_(gg)); }
            v4u o; o.x = pk2(y[0], y[1]); o.y = pk2(y[2], y[3]); o.z = pk2(y[4], y[5]); o.w = pk2(y[6], y[7]); *(v4u*)(MIX + (size_t)row * DM + h * 128 + k8) = o; }
        __syncthreads();
    }
}

__device__ __forceinline__ void memkv_finalize_row(const Args& a, int layer, int row, int lane) {
    const float* src = (const float*)(a.ws + WS_MEMKV) + (size_t)row * 1024 + layer * 512;
    const int hd = lane >> 4, d4 = (lane & 15) * 4;
    const f32x4 k = *(const f32x4*)(src + hd * 64 + d4), v = *(const f32x4*)(src + 256 + hd * 64 + d4);
    float s = (k.x * k.x + k.y * k.y) + (k.z * k.z + k.w * k.w);
    s += __shfl_xor(s, 1); s += __shfl_xor(s, 2); s += __shfl_xor(s, 4); s += __shfl_xor(s, 8);
    const float rs = rsqrtf(s * (1.0f / 64.0f) + EPS); const f32x4 g = *(const f32x4*)(a.in[22] + layer * 64 + d4);
    *(f32x4*)(a.out + O_MK + ((size_t)layer * 1024 + row) * 256 + hd * 64 + d4) = k * rs * g;
    *(f32x4*)(a.out + O_MV + ((size_t)layer * 1024 + row) * 256 + hd * 64 + d4) = v;
}

__device__ __forceinline__ void memattn_prompt_unit(Ctx& c, const Args& a, int layer, int u) {
    const int blk = u & 15, hd = (u >> 4) & 3, b = u >> 6;
    const bf16* Z = (const bf16*)(a.ws + WS_Z); const int ldz = layer ? ZC1 : ZC0, qc = layer ? Z1_MQ : 3072;
    const float* kv = (const float*)(a.ws + WS_MEMKV) + (size_t)(b * 256) * 1024 + layer * 512 + hd * 64;
    const int row0 = b * SEQ + blk * 256;
    memattn_unit(c, Z + (size_t)row0 * ldz + qc + hd * 64, ldz, 256, kv, kv + 256, 1024, true, a.in[22] + layer * 64, a.in[21] + layer * 64,
                 (bf16*)(a.ws + WS_MIX) + (size_t)row0 * DM + 768 + hd * 64);
}
__device__ __forceinline__ void memattn_sample_unit(Ctx& c, const Args& a, int layer, int u) {
    const int hd = u & 3, sb = u >> 2;
    const bf16* Z = (const bf16*)(a.ws + WS_Z); const int ldz = layer ? ZC1 : ZC0, qc = layer ? Z1_MQ : 3072;
    const size_t off = ((size_t)(layer * 32 + sb) * 256) * 256 + hd * 64;
    const int row0 = MP + sb * 4;
    memattn_unit(c, Z + (size_t)row0 * ldz + qc + hd * 64, ldz, 4, a.in[5] + off, a.in[6] + off, 256, false, nullptr, a.in[21] + layer * 64,
                 (bf16*)(a.ws + WS_MIX) + (size_t)row0 * DM + 768 + hd * 64);
}

__device__ __forceinline__ void p2_mixer0(Ctx& c, const Args& a) {
    constexpr int U_HP = 24 * HG_NG, U_MAP = U_HP + 256, U_HS = U_MAP + 192, U_MAS = U_HS + 128, U_FIN = U_MAS + 256;
    for (;;) {
        const int u = q_next(c, 0);
        if (u >= U_FIN) break;
        if (u < U_HP) hgrn_unit<true>(c, a, u / (6 * HG_NG), (u / HG_NG) % 6, u % HG_NG);
        else if (u < U_MAP) memattn_prompt_unit(c, a, 0, u - U_HP);
        else if (u < U_HS) { const int v = u - U_MAP; hgrn_unit<false>(c, a, v / 6, v % 6, 0); }
        else if (u < U_MAS) memattn_sample_unit(c, a, 0, u - U_HS);
        else { const int v = (u - U_MAS) * 8 + c.wave; memkv_finalize_row(a, v >> 10, v & 1023, c.lane); }
    }
}
__device__ __forceinline__ void p2c_hgrn_fix(Ctx& c, const Args& a) {
    for (int u = c.vcu; u < 24 * HG_NG; u += c.G) hgrn_fix_unit(c, a, u / (6 * HG_NG), (u / HG_NG) % 6, u % HG_NG);
}

__device__ __forceinline__ void p5_convact(Ctx& c, const Args& a, int layer) {
    const bf16* U = (const bf16*)(a.ws + WS_U); const bf16* UP = (const bf16*)(a.ws + WS_UP); bf16* ACT = (bf16*)(a.ws + WS_ACT);
    const float* cw = a.in[26] + (size_t)layer * 3 * DFF; const float* cb = a.in[27] + (size_t)layer * DFF; const float* cst = a.in[8] + (size_t)layer * 32 * 2 * DFF;
    constexpr int CPR = DFF / 8, NG = MVALID / 4;
    const int total = NG * CPR;
#pragma unroll 1
    for (int i = c.vcu * 512 + c.tid; i < total; i += c.G * 512) {
        const int g = i / CPR, c8 = (i - g * CPR) * 8, r0 = g * 4;
        const bool smp = r0 >= MP; const bool first = smp || (r0 & 4095) == 0;
        const int rm2 = first ? r0 : r0 - 2, rm1 = first ? r0 : r0 - 1;
        v4u ur[6], pr[4];
        ur[0] = *(const v4u*)(U + (size_t)rm2 * DFF + c8); ur[1] = *(const v4u*)(U + (size_t)rm1 * DFF + c8);
#pragma unroll
        for (int k = 0; k < 4; ++k) { ur[2 + k] = *(const v4u*)(U + (size_t)(r0 + k) * DFF + c8); pr[k] = *(const v4u*)(UP + (size_t)(r0 + k) * DFF + c8); }
        const f32x4 w0a = *(const f32x4*)(cw + c8), w0b = *(const f32x4*)(cw + c8 + 4), w1a = *(const f32x4*)(cw + DFF + c8), w1b = *(const f32x4*)(cw + DFF + c8 + 4),
                    w2a = *(const f32x4*)(cw + 2 * DFF + c8), w2b = *(const f32x4*)(cw + 2 * DFF + c8 + 4), cba = *(const f32x4*)(cb + c8), cbb = *(const f32x4*)(cb + c8 + 4);
        const float w0[8] = {w0a.x, w0a.y, w0a.z, w0a.w, w0b.x, w0b.y, w0b.z, w0b.w}, w1[8] = {w1a.x, w1a.y, w1a.z, w1a.w, w1b.x, w1b.y, w1b.z, w1b.w},
                    w2[8] = {w2a.x, w2a.y, w2a.z, w2a.w, w2b.x, w2b.y, w2b.z, w2b.w}, bb[8] = {cba.x, cba.y, cba.z, cba.w, cbb.x, cbb.y, cbb.z, cbb.w};
        float uf[6][8];
#pragma unroll
        for (int k = 0; k < 6; ++k) { const unsigned xw[4] = {ur[k].x, ur[k].y, ur[k].z, ur[k].w};
#pragma unroll
            for (int j = 0; j < 8; ++j) uf[k][j] = bf2f((xw[j >> 1] >> (16 * (j & 1))) & 0xffffu); }
        if (first) {
            if (smp) { const float* s0 = cst + (size_t)(((r0 - MP) >> 2) * 2) * DFF + c8;
#pragma unroll
                for (int j = 0; j < 8; ++j) { uf[0][j] = s0[j]; uf[1][j] = s0[DFF + j]; } }
            else {
#pragma unroll
                for (int j = 0; j < 8; ++j) { uf[0][j] = 0.f; uf[1][j] = 0.f; } }
        }
#pragma unroll
        for (int k = 0; k < 4; ++k) { const unsigned pw[4] = {pr[k].x, pr[k].y, pr[k].z, pr[k].w}; float y[8];
#pragma unroll
            for (int j = 0; j < 8; ++j) { const float cv = bb[j] + w0[j] * uf[k][j] + w1[j] * uf[k + 1][j] + w2[j] * uf[k + 2][j]; y[j] = cv * sigmoidf_(cv) * bf2f((pw[j >> 1] >> (16 * (j & 1))) & 0xffffu); }
            v4u o; o.x = pk2(y[0], y[1]); o.y = pk2(y[2], y[3]); o.z = pk2(y[4], y[5]); o.w = pk2(y[6], y[7]);
            *(v4u*)(ACT + (size_t)(r0 + k) * DFF + c8) = o; }
    }
    for (int i = c.vcu * 512 + c.tid; i < (MT - MVALID) * CPR; i += c.G * 512)
        *(v4u*)(ACT + (size_t)(MVALID + i / CPR) * DFF + (i % CPR) * 8) = (v4u){0u, 0u, 0u, 0u};
}


struct SgArgs { const bf16* A; const bf16* Bt; int K; int mode; bf16* Z; int ldz; const float* ssin; const float* resid; float* y; bf16* xb; float* ssout; bf16* U; bf16* UP; float* cvs; };
__device__ __forceinline__ void sgemm_unit(Ctx& c, const SgArgs& g, int n0) {
    int tid = c.tid; asm volatile("" : "+v"(tid));
    const int lane = tid & 63, w = c.wave, r32 = lane & 31, hh = lane >> 5;
    const int K = g.K, ks = K >> 3;
    const bf16* bp = g.Bt + (size_t)(n0 + r32) * K + w * ks + 8 * hh;
    const bf16* ap = g.A + (size_t)r32 * K + w * ks + 8 * hh;
    f32x16 acc[4] = {};
    bf16x8 afA[4][2], bfA[2], afB[4][2], bfB[2];
#define SG_LOAD(AF, BF, kk) do { _Pragma("unroll") for (int i = 0; i < 2; ++i) { BF[i] = *(const bf16x8*)(bp + (kk) + 16 * i); \
        _Pragma("unroll") for (int rt = 0; rt < 4; ++rt) AF[rt][i] = *(const bf16x8*)(ap + (size_t)(rt * 32) * K + (kk) + 16 * i); } } while (0)
#define SG_MMA(AF, BF) do { _Pragma("unroll") for (int i = 0; i < 2; ++i) _Pragma("unroll") for (int rt = 0; rt < 4; ++rt) acc[rt] = __builtin_amdgcn_mfma_f32_32x32x16_bf16(AF[rt][i], BF[i], acc[rt], 0, 0, 0); } while (0)
    SG_LOAD(afA, bfA, 0);
#pragma unroll 1
    for (int k = 0; k < ks; k += 64) {
        if (k + 32 < ks) SG_LOAD(afB, bfB, k + 32);
        SG_MMA(afA, bfA);
        if (k + 32 < ks) { if (k + 64 < ks) SG_LOAD(afA, bfA, k + 64); SG_MMA(afB, bfB); }
    }
#undef SG_LOAD
#undef SG_MMA
    LAS float* RED = (LAS float*)(c.lds);
    __syncthreads();
#pragma unroll
    for (int rt = 0; rt < 4; ++rt)
#pragma unroll
        for (int r = 0; r < 16; ++r) RED[((w * 4 + rt) * 16 + r) * 64 + lane] = acc[rt][r];
    __syncthreads();
    const int rt = w & 3, rh = w >> 2, col = n0 + r32;
    float v[8];
#pragma unroll
    for (int i = 0; i < 8; ++i) { float s = 0.f;
#pragma unroll
        for (int ww = 0; ww < 8; ++ww) s += RED[((ww * 4 + rt) * 16 + 8 * rh + i) * 64 + lane];
        v[i] = s; }
    if (g.mode == 0) {
#pragma unroll
        for (int i = 0; i < 8; ++i) { const int row = MP + rt * 32 + crow(8 * rh + i, hh); const float rs = rsqrtf(g.ssin[row] * (1.0f / DM) + EPS); g.Z[(size_t)row * g.ldz + col] = (bf16)f2bf(v[i] * rs); }
    } else if (g.mode == 1) {
#pragma unroll
        for (int i = 0; i < 8; ++i) { const int lr = rt * 32 + crow(8 * rh + i, hh), row = MP + lr; const float x = v[i] + g.resid[(size_t)lr * DM + col];
            g.y[(size_t)lr * DM + col] = x; if (g.xb) g.xb[(size_t)row * DM + col] = (bf16)f2bf(x);
            float s = x * x; s += __shfl_xor(s, 1); s += __shfl_xor(s, 2); s += __shfl_xor(s, 4); s += __shfl_xor(s, 8); s += __shfl_xor(s, 16);
            if (g.ssout && r32 == 0) atomicAdd(g.ssout + row, s); }
    } else {
        const bool isup = (col & 128) != 0; const int fc = (col >> 8) * 128 + (col & 127); bf16* dst = isup ? g.UP : g.U;
#pragma unroll
        for (int i = 0; i < 8; ++i) { const int lr = rt * 32 + crow(8 * rh + i, hh), row = MP + lr; const float rs = rsqrtf(g.ssin[row] * (1.0f / DM) + EPS); const float x = v[i] * rs;
            dst[(size_t)row * DFF + fc] = (bf16)f2bf(x);
            if (!isup && (lr & 3) >= 2) g.cvs[(size_t)((lr >> 2) * 2 + (lr & 3) - 2) * DFF + fc] = x; }
    }
}
__device__ __forceinline__ void sgemm_phase(Ctx& c, const SgArgs& g, int N) {
#pragma unroll 1
    for (int u = c.G - 1 - (int)blockIdx.x; u < N / 32; u += c.G) sgemm_unit(c, g, u * 32);
}


__device__ __forceinline__ void dsa_post_row(const Args& a, int row, int lane) {
    const bf16* z = (const bf16*)(a.ws + WS_Z) + (size_t)row * ZC1;
    const bool smp = row >= MP; const int b = smp ? (row - MP) >> 2 : row >> 12, t = smp ? (row - MP) & 3 : row & 4095;
    const float pos = (float)(smp ? PAST + t : t);
    float c128, s128, c64, s64;
    { const float f1 = exp2f(-(float)lane * (13.287712379549449f / 64.0f)); sincosf(pos * f1, &s128, &c128);
      const float f2 = exp2f(-(float)(lane & 31) * (13.287712379549449f / 32.0f)); sincosf(pos * f2, &s64, &c64); }
#pragma unroll 1
    for (int hd = 0; hd < 8; ++hd) {
        const float x1 = bf2f(z[hd * 128 + lane]), x2 = bf2f(z[hd * 128 + 64 + lane]);
        const float rs = rsqrtf(wave_sum(x1 * x1 + x2 * x2) * (1.0f / 128.0f) + EPS);
        const float* gn = hd < 6 ? a.in[17] : a.in[18];
        const float y1 = x1 * rs * gn[lane], y2 = x2 * rs * gn[64 + lane];
        const float o1 = y1 * c128 - y2 * s128, o2 = y2 * c128 + y1 * s128;
        if (hd < 6) {
            if (smp) { float* q = (float*)(a.ws + WS_SQ) + (size_t)(row - MP) * 768 + hd * 128; q[lane] = o1; q[64 + lane] = o2; }
            else { bf16* q = (bf16*)(a.ws + WS_QB) + ((size_t)(b * 6 + hd) * SEQ + t) * 128; q[lane] = (bf16)f2bf(o1); q[64 + lane] = (bf16)f2bf(o2); }
        } else {
            const int kvh = hd - 6;
            float* ko = smp ? a.out + O_KS + (size_t)(row - MP) * 256 + kvh * 128 : a.out + O_KP + (size_t)row * 256 + kvh * 128;
            ko[lane] = o1; ko[64 + lane] = o2;
            if (!smp) { bf16* kb = (bf16*)(a.ws + WS_KB) + ((size_t)(b * 2 + kvh) * SEQ + t) * 128; kb[lane] = (bf16)f2bf(o1); kb[64 + lane] = (bf16)f2bf(o2); }
        }
    }
    {
        const u64 vv = *(const u64*)(z + Z1_V + 4 * lane);
        const f32x4 v = {bf2f((unsigned)vv & 0xffffu), bf2f(((unsigned)vv) >> 16), bf2f((unsigned)(vv >> 32) & 0xffffu), bf2f((unsigned)(vv >> 48))};
        float* vo = smp ? a.out + O_VS + (size_t)(row - MP) * 256 : a.out + O_VP + (size_t)row * 256;
        *(f32x4*)(vo + 4 * lane) = v;
        if (!smp) { const int kvh = lane >> 5, d = (lane & 31) * 4; *(u64*)((bf16*)(a.ws + WS_VB) + ((size_t)(b * 2 + kvh) * SEQ + t) * 128 + d) = vv; }
    }
    {
        const int i = lane & 31;
#pragma unroll
        for (int p = 0; p < 4; ++p) { const int hd = 2 * p + (lane >> 5);
            const float x1 = bf2f(z[Z1_IQ + hd * 64 + i]), x2 = bf2f(z[Z1_IQ + hd * 64 + 32 + i]);
            const float o1 = x1 * c64 - x2 * s64, o2 = x2 * c64 + x1 * s64;
            if (smp) { float* q = (float*)(a.ws + WS_SIQ) + (size_t)(row - MP) * 512 + hd * 64; q[i] = o1; q[32 + i] = o2; }
            else { bf16* q = (bf16*)(a.ws + WS_IQB) + (size_t)row * 512 + hd * 64; q[i] = (bf16)f2bf(o1); q[32 + i] = (bf16)f2bf(o2); } }
        float x1 = 0.f, x2 = 0.f; if (lane < 32) { x1 = bf2f(z[Z1_IK + i]); x2 = bf2f(z[Z1_IK + 32 + i]); }
        const float rs = rsqrtf(wave_sum(x1 * x1 + x2 * x2) * (1.0f / 64.0f) + EPS);
        const float y1 = x1 * rs * a.in[19][i], y2 = x2 * rs * a.in[19][32 + i];
        const float o1 = y1 * c64 - y2 * s64, o2 = y2 * c64 + y1 * s64;
        if (lane < 32) {
            float* ko = smp ? a.out + O_IKS + (size_t)(row - MP) * 64 : a.out + O_IKP + (size_t)row * 64; ko[i] = o1; ko[32 + i] = o2;
            if (!smp) { bf16* kb = (bf16*)(a.ws + WS_IKB) + (size_t)row * 64; kb[i] = (bf16)f2bf(o1); kb[32 + i] = (bf16)f2bf(o2); } }
        if (lane < 8) { const float wv = bf2f(z[Z1_IW + lane]) * (0.35355339059327373f * 0.125f);
            if (smp) ((float*)(a.ws + WS_SIW))[(row - MP) * 8 + lane] = wv; else ((float*)(a.ws + WS_IW))[(size_t)row * 8 + lane] = wv; }
    }
}
__device__ __forceinline__ void p8_dsa_post(Ctx& c, const Args& a) {
    for (;;) { const int u = q_next(c, 1); if (u >= 384) break; if (u < 256) memattn_prompt_unit(c, a, 1, u); else memattn_sample_unit(c, a, 1, u - 256); }
    const int gw = c.vcu * NWAVES + c.wave, NGW = c.G * NWAVES;
    for (int row = gw; row < MVALID; row += NGW) dsa_post_row(a, row, c.lane);
}

__device__ __forceinline__ void idx_prompt_unit(Ctx& c, const Args& a, int b, int qb) {
    int tid = c.tid; asm volatile("" : "+v"(tid));
    const int lane = tid & 63, r32 = lane & 31, hh = lane >> 5, w = c.wave;
    const int q0 = b * SEQ + qb * 32;
    LAS bf16* IQL = (LAS bf16*)(c.lds);
    { const bf16* src = (const bf16*)(a.ws + WS_IQB) + (size_t)q0 * 512;
#pragma unroll
      for (int i = 0; i < 4; ++i) { const int row = tid >> 4, ch = (tid & 15) + 16 * i; *(LAS v4u*)(IQL + row * 520 + ch * 8) = *(const v4u*)(src + (size_t)row * 512 + ch * 8); } }
    __syncthreads();
    const bf16* IK = (const bf16*)(a.ws + WS_IKB) + (size_t)(b * SEQ) * 64 + (size_t)r32 * 64 + 8 * hh;
    float* SC = (float*)(a.ws + WS_SC) + (size_t)(q0 + r32) * SEQ;
    float wv[8];
#pragma unroll
    for (int h = 0; h < 8; ++h) wv[h] = ((const float*)(a.ws + WS_IW))[(size_t)(q0 + r32) * 8 + h];
    bf16x8 ak[4], an[4];
    if (w <= qb) {
#pragma unroll
        for (int ks = 0; ks < 4; ++ks) ak[ks] = *(const bf16x8*)(IK + (size_t)(w * 32) * 64 + ks * 16); }
#pragma unroll 1
    for (int kt = w; kt <= qb; kt += 8) {
        if (kt + 8 <= qb) {
#pragma unroll
            for (int ks = 0; ks < 4; ++ks) an[ks] = *(const bf16x8*)(IK + (size_t)((kt + 8) * 32) * 64 + ks * 16); }
        f32x16 sc = {};
        int qoff = r32 * 520 + 8 * hh; asm volatile("" : "+v"(qoff));
#pragma unroll
        for (int h = 0; h < 8; ++h) { f32x16 d = {};
#pragma unroll
            for (int ks = 0; ks < 4; ++ks) d = __builtin_amdgcn_mfma_f32_32x32x16_bf16(ak[ks], *(const LAS bf16x8*)(IQL + qoff + h * 64 + ks * 16), d, 0, 0, 0);
#pragma unroll
            for (int r = 0; r < 16; ++r) sc[r] = fmaf(wv[h], fmaxf(d[r], 0.f), sc[r]); }
#pragma unroll
        for (int g = 0; g < 4; ++g) *(f32x4*)(SC + kt * 32 + 8 * g + 4 * hh) = (f32x4){sc[4 * g], sc[4 * g + 1], sc[4 * g + 2], sc[4 * g + 3]};
#pragma unroll
        for (int ks = 0; ks < 4; ++ks) ak[ks] = an[ks];
    }
}
__device__ __forceinline__ v4u pack8f(const float* p) { const f32x4 x = *(const f32x4*)p, y = *(const f32x4*)(p + 4); v4u o; o.x = pk2(x.x, x.y); o.y = pk2(x.z, x.w); o.z = pk2(y.x, y.y); o.w = pk2(y.z, y.w); return o; }
__device__ __forceinline__ void idx_sample_tile(const Args& a, int sb, int tl, int lane_) {
    int lane = lane_; asm volatile("" : "+v"(lane));
    const int r32 = lane & 31, hh = lane >> 5, tk = r32 >> 3, hd = r32 & 7;
    const float* iq = (const float*)(a.ws + WS_SIQ) + (size_t)(sb * 4 + tk) * 512 + hd * 64 + 8 * hh;
    const float wv = ((const float*)(a.ws + WS_SIW))[(sb * 4 + tk) * 8 + hd];
    const float* src;
    if (tl < 256) src = a.in[4] + ((size_t)a.page_table[sb * 64 + (tl >> 2)] * 128 + (tl & 3) * 32 + r32) * 64 + 8 * hh;
    else src = a.out + O_IKS + (size_t)(sb * 4 + (r32 & 3)) * 64 + 8 * hh;
    v4u af[4], bf_[4];
#pragma unroll
    for (int ks = 0; ks < 4; ++ks) { af[ks] = pack8f(src + 16 * ks); bf_[ks] = pack8f(iq + 16 * ks); }
    if (tl == 256 && r32 >= 4) {
#pragma unroll
        for (int ks = 0; ks < 4; ++ks) af[ks] = (v4u){0u, 0u, 0u, 0u}; }
    f32x16 d = {};
#pragma unroll
    for (int ks = 0; ks < 4; ++ks) d = __builtin_amdgcn_mfma_f32_32x32x16_bf16(__builtin_bit_cast(bf16x8, af[ks]), __builtin_bit_cast(bf16x8, bf_[ks]), d, 0, 0, 0);
    float* dst = (float*)(a.ws + WS_SSC) + (size_t)(sb * 4 + tk) * SSC_LD + tl * 32;
#pragma unroll
    for (int r = 0; r < 16; ++r) { float v = wv * fmaxf(d[r], 0.f);
        v += __builtin_bit_cast(float, __builtin_amdgcn_update_dpp(0, __builtin_bit_cast(int, v), 0xB1, 0xF, 0xF, false));
        v += __builtin_bit_cast(float, __builtin_amdgcn_update_dpp(0, __builtin_bit_cast(int, v), 0x4E, 0xF, 0xF, false));
        v += __builtin_bit_cast(float, __builtin_amdgcn_update_dpp(0, __builtin_bit_cast(int, v), 0x141, 0xF, 0xF, false));
        if (hd == 0) dst[crow(r, hh)] = v; }
}
__device__ __forceinline__ void p9_indexer(Ctx& c, const Args& a) {
    const int gw = c.vcu * NWAVES + c.wave, NGW = c.G * NWAVES;
#pragma unroll 1
    for (int wt = gw; wt < 32 * 257; wt += NGW) idx_sample_tile(a, wt / 257, wt % 257, c.lane);
    for (;;) { const int u = q_next(c, 2); if (u >= 512) break; idx_prompt_unit(c, a, u & 3, 127 - (u >> 2)); }
}


__device__ __forceinline__ unsigned fkey(float f) { const unsigned u = __builtin_bit_cast(unsigned, f + 0.0f); return (u & 0x80000000u) ? ~u : (u | 0x80000000u); }
__device__ __forceinline__ void acc_ge(int& cnt, unsigned key, unsigned cand) { asm volatile("v_cmp_le_u32_e32 vcc, %1, %2\n\tv_addc_co_u32_e32 %0, vcc, 0, %0, vcc" : "+v"(cnt) : "s"(cand), "v"(key) : "vcc"); }
__device__ __forceinline__ void acc_ge4(int& c0, int& c1, int& c2, int& c3, unsigned k0, unsigned k1, unsigned k2, unsigned k3, unsigned cand) {
    u64 m0, m1, m2, m3;
    asm volatile("v_cmp_le_u32_e64 %4, %8, %9\n\tv_cmp_le_u32_e64 %5, %8, %10\n\tv_cmp_le_u32_e64 %6, %8, %11\n\tv_cmp_le_u32_e64 %7, %8, %12\n\t"
                 "v_addc_co_u32_e64 %0, %4, 0, %0, %4\n\tv_addc_co_u32_e64 %1, %5, 0, %1, %5\n\tv_addc_co_u32_e64 %2, %6, 0, %2, %6\n\tv_addc_co_u32_e64 %3, %7, 0, %3, %7"
                 : "+v"(c0), "+v"(c1), "+v"(c2), "+v"(c3), "=&s"(m0), "=&s"(m1), "=&s"(m2), "=&s"(m3) : "s"(cand), "v"(k0), "v"(k1), "v"(k2), "v"(k3));
}
__device__ __forceinline__ u64 ballot_nz(unsigned v) { u64 m; asm volatile("v_cmp_ne_u32_e64 %0, 0, %1" : "=s"(m) : "v"(v)); return m; }
__device__ __forceinline__ int wave_sum_dpp(int x) {
    x += __builtin_amdgcn_update_dpp(0, x, 0xB1, 0xF, 0xF, false);
    x += __builtin_amdgcn_update_dpp(0, x, 0x4E, 0xF, 0xF, false);
    x += __builtin_amdgcn_update_dpp(0, x, 0x141, 0xF, 0xF, false);
    x += __builtin_amdgcn_update_dpp(0, x, 0x140, 0xF, 0xF, false);
    return (__builtin_amdgcn_readlane(x, 0) + __builtin_amdgcn_readlane(x, 16)) + (__builtin_amdgcn_readlane(x, 32) + __builtin_amdgcn_readlane(x, 48));
}
__device__ __forceinline__ int mbcnt64(u64 m) { return (int)__builtin_amdgcn_mbcnt_hi((unsigned)(m >> 32), __builtin_amdgcn_mbcnt_lo((unsigned)m, 0u)); }
constexpr int TK_LOWBITS = 18;
__device__ __forceinline__ void topk_finish(unsigned ck, int cp, int A, int posmax, unsigned& T, int& P) {
#pragma unroll 1
    for (int bit = TK_LOWBITS - 1; bit >= 0; --bit) { const unsigned cand = T | (1u << bit); if (A + __builtin_popcountll(__ballot(ck >= cand)) >= 256) T = cand; }
    const int need = 256 - (A + __builtin_popcountll(__ballot(ck > T))), ceq = __builtin_popcountll(__ballot(ck == T));
    P = posmax;
    if (ceq != need) { P = 0;
#pragma unroll 1
        for (int bit = 13; bit >= 0; --bit) { const int cand = P | (1 << bit); if (__builtin_popcountll(__ballot(ck == T && cp < cand)) < need) P = cand; } }
}
__device__ __forceinline__ void topk_prompt_rows(const Args& a, int row0, int stride, int lane_, LAS unsigned* cl  ) {
    int lane = lane_; asm volatile("" : "+v"(lane));
    const float* SCb = (const float*)(a.ws + WS_SC);
    float nx[64];
#define TK_NEEDS(r) ((r) < MP && ((r) & 4095) >= 256)
#define TK_PREFETCH(r) do { const float* sc_ = SCb + (size_t)(r) * SEQ + lane; _Pragma("unroll") for (int j = 0; j < 64; ++j) nx[j] = sc_[64 * j]; } while (0)
    if (TK_NEEDS(row0)) TK_PREFETCH(row0);
#pragma unroll 1
    for (int row = row0; row < MP; row += stride) {
        const int t = row & 4095;
        u64* mk = (u64*)(a.ws + WS_MASK) + (size_t)row * 64;
        u64 myword = 0ull;
        if (t < 256) {
#pragma unroll 1
            for (int j = 0; j < 64; ++j) { const u64 m = __ballot(64 * j + lane <= t); if (lane == j) myword = m; }
            mk[lane] = myword;
            if (TK_NEEDS(row + stride)) TK_PREFETCH(row + stride);
            continue; }
        unsigned key[64];
#pragma unroll
        for (int j = 0; j < 64; ++j) key[j] = (lane <= t - 64 * j) ? fkey(nx[j]) : 0u;
        if (TK_NEEDS(row + stride)) TK_PREFETCH(row + stride);
#define TK_FULLCOUNT(CAND, OUT) do { const unsigned cs_ = __builtin_amdgcn_readfirstlane(CAND); int c0_ = 0, c1_ = 0, c2_ = 0, c3_ = 0; \
        _Pragma("unroll") for (int j = 0; j < 64; j += 4) acc_ge4(c0_, c1_, c2_, c3_, key[j], key[j + 1], key[j + 2], key[j + 3], cs_); OUT = wave_sum_dpp((c0_ + c1_) + (c2_ + c3_)); } while (0)
        unsigned T = 0u;
#pragma unroll 1
        for (int bit = 31; bit >= TK_LOWBITS; --bit) { const unsigned cand = T | (1u << bit); int tot; TK_FULLCOUNT(cand, tot); if (tot >= 256) T = cand; }
        const unsigned hib = T + (1u << TK_LOWBITS);
        int A = 0, cT; if (hib != 0u) TK_FULLCOUNT(hib, A); TK_FULLCOUNT(T, cT);
        int P;
        if (cT - A <= 64) {
            int base = 0;
#pragma unroll
            for (int j = 0; j < 64; ++j) { const unsigned und = (key[j] - T) < (1u << TK_LOWBITS) ? 1u : 0u; const u64 m = ballot_nz(und); const int pos = base + mbcnt64(m);
                if (und) { cl[pos] = key[j]; cl[64 + pos] = (unsigned)(64 * j + lane); }
                base += __builtin_popcountll(m); asm volatile("" : "+s"(base)); }
            const unsigned ck = lane < base ? cl[lane] : 0u; const int cp = (int)cl[64 + lane];
            topk_finish(ck, cp, A, 4095, T, P);
        } else {
#pragma unroll 1
            for (int bit = TK_LOWBITS - 1; bit >= 0; --bit) { const unsigned cand = T | (1u << bit); int tot; TK_FULLCOUNT(cand, tot); if (tot >= 256) T = cand; }
            int cge, cgt; TK_FULLCOUNT(T, cge); cgt = 0; if (T != 0xffffffffu) TK_FULLCOUNT(T + 1u, cgt);
            const int need = 256 - cgt, ceq = cge - cgt; P = 4095;
            if (ceq != need) { P = 0;
#pragma unroll 1
                for (int bit = 11; bit >= 0; --bit) { const int cand = P | (1 << bit); int cnt = 0;
#pragma unroll
                    for (int j = 0; j < 64; ++j) cnt += (key[j] == T && lane < cand - 64 * j) ? 1 : 0;
                    if (wave_sum_dpp(cnt) < need) P = cand; } }
        }
#undef TK_FULLCOUNT
#pragma unroll
        for (int j = 0; j < 64; ++j) { const unsigned selv = (key[j] > T || (key[j] == T && lane <= P - 64 * j)) ? 1u : 0u; const u64 m = ballot_nz(selv); if (lane == j) myword = m; asm volatile("" : "+v"(myword)); }
        mk[lane] = myword;
    }
#undef TK_NEEDS
#undef TK_PREFETCH
}
__device__ __forceinline__ void topk_sample_row(const Args& a, int q, int lane_, LAS unsigned* K, LAS unsigned* cl) {
    int lane = lane_; asm volatile("" : "+v"(lane));
    const int t = q & 3, n = PAST + t + 1; const float* sc = (const float*)(a.ws + WS_SSC) + (size_t)q * SSC_LD;
    int* out = (int*)(a.ws + WS_SIDX) + q * 256;
    unsigned key[129];
#pragma unroll
    for (int j = 0; j < 129; ++j) { const float v = sc[64 * j + lane]; key[j] = (lane < n - 64 * j) ? fkey(v) : 0u; }
#pragma unroll
    for (int j = 0; j < 129; ++j) K[64 * j + lane] = key[j];
#define TK_FULLCOUNT(CAND, OUT) do { const unsigned cs_ = __builtin_amdgcn_readfirstlane(CAND); int c0_ = 0, c1_ = 0, c2_ = 0, c3_ = 0; \
        _Pragma("unroll") for (int j = 0; j < 128; j += 4) acc_ge4(c0_, c1_, c2_, c3_, key[j], key[j + 1], key[j + 2], key[j + 3], cs_); acc_ge(c0_, key[128], cs_); OUT = wave_sum_dpp((c0_ + c1_) + (c2_ + c3_)); } while (0)
    unsigned T = 0u;
#pragma unroll 1
    for (int bit = 31; bit >= TK_LOWBITS; --bit) { const unsigned cand = T | (1u << bit); int tot; TK_FULLCOUNT(cand, tot); if (tot >= 256) T = cand; }
    const unsigned hib = T + (1u << TK_LOWBITS);
    int A = 0, cT; if (hib != 0u) TK_FULLCOUNT(hib, A); TK_FULLCOUNT(T, cT);
    int P;
    if (cT - A <= 64) {
        int base = 0;
#pragma unroll 1
        for (int j0 = 0; j0 < 128; j0 += 8) { unsigned kk[8];
#pragma unroll
            for (int i = 0; i < 8; ++i) kk[i] = K[64 * (j0 + i) + lane];
#pragma unroll
            for (int i = 0; i < 8; ++i) { const unsigned und = (kk[i] - T) < (1u << TK_LOWBITS) ? 1u : 0u; const u64 m = ballot_nz(und); const int pos = base + mbcnt64(m);
                if (und) { cl[pos] = kk[i]; cl[64 + pos] = (unsigned)(64 * (j0 + i) + lane); }
                base += __builtin_popcountll(m); } }
        { const unsigned kj = K[64 * 128 + lane]; const unsigned und = (kj - T) < (1u << TK_LOWBITS) ? 1u : 0u; const u64 m = ballot_nz(und); const int pos = base + mbcnt64(m);
          if (und) { cl[pos] = kj; cl[64 + pos] = (unsigned)(64 * 128 + lane); } base += __builtin_popcountll(m); }
        const unsigned ck = lane < base ? cl[lane] : 0u; const int cp = (int)cl[64 + lane];
        topk_finish(ck, cp, A, 16383, T, P);
    } else {
#pragma unroll 1
        for (int bit = TK_LOWBITS - 1; bit >= 0; --bit) { const unsigned cand = T | (1u << bit); int tot; TK_FULLCOUNT(cand, tot); if (tot >= 256) T = cand; }
        int cge, cgt; TK_FULLCOUNT(T, cge); cgt = 0; if (T != 0xffffffffu) TK_FULLCOUNT(T + 1u, cgt);
        const int need = 256 - cgt, ceq = cge - cgt; P = 16383;
        if (ceq != need) { P = 0;
#pragma unroll 1
            for (int bit = 13; bit >= 0; --bit) { const int cand = P | (1 << bit); int cnt = 0;
#pragma unroll 4
                for (int j = 0; j < 129; ++j) cnt += (K[64 * j + lane] == T && 64 * j + lane < cand) ? 1 : 0;
                if (wave_sum_dpp(cnt) < need) P = cand; } }
    }
#undef TK_FULLCOUNT
    int base = 0;
#pragma unroll 1
    for (int j0 = 0; j0 < 136; j0 += 8) { unsigned kk[8];
#pragma unroll
        for (int i = 0; i < 8; ++i) kk[i] = (j0 + i < 129) ? K[64 * (j0 + i) + lane] : 0u;
#pragma unroll
        for (int i = 0; i < 8; ++i) { const int ps = 64 * (j0 + i) + lane; const unsigned selv = (kk[i] > T || (kk[i] == T && ps <= P)) ? 1u : 0u; const u64 m = ballot_nz(selv);
            const int pos = base + mbcnt64(m);
            if (selv && pos < 256) out[pos] = ps;
            base += __builtin_popcountll(m); } }
}
__device__ __forceinline__ void p10_topk(Ctx& c, const Args& a) {
    const int gw = c.vcu * NWAVES + c.wave, NGW = c.G * NWAVES;
    LAS unsigned* cl = (LAS unsigned*)(c.lds) + c.wave * 128;
    if (c.wave == 0 && c.vcu < MS) topk_sample_row(a, c.vcu, c.lane, (LAS unsigned*)(c.lds + 4096), cl);
    topk_prompt_rows(a, gw, NGW, c.lane, cl);
}


__device__ __forceinline__ void attn_sample_unit(Ctx& c, const Args& a, int sb, int t) {
    LAS bf16* KV = (LAS bf16*)(c.lds);
    LAS float* QL = (LAS float*)(c.lds + 69632);
    LAS float* SL = (LAS float*)(c.lds + 69632 + 3072);
    LAS float* OL = (LAS float*)(c.lds + 69632 + 6144);
    LAS int* IL = (LAS int*)(c.lds + 69632 + 12288);
    int tid = c.tid; asm volatile("" : "+v"(tid));
    const int lane = tid & 63, w = c.wave, q = sb * 4 + t;
    __syncthreads();
    if (tid < 256) IL[tid] = ((const int*)(a.ws + WS_SIDX))[q * 256 + tid];
    for (int i = tid; i < 768; i += 512) QL[i] = ((const float*)(a.ws + WS_SQ))[(size_t)q * 768 + i];
    __syncthreads();
    bf16* MIX = (bf16*)(a.ws + WS_MIX) + (size_t)(MP + q) * DM;
#pragma unroll 1
    for (int kvh = 0; kvh < 2; ++kvh) {
#pragma unroll 1
        for (int pass = 0; pass < 2; ++pass) {
            const float* pool = pass ? a.in[3] : a.in[2]; const float* nw = a.out + (pass ? O_VS : O_KS);
            for (int i = tid >> 5; i < 256; i += 16) { const int idx = IL[i]; const float* src;
                if (idx < PAST) src = pool + (((size_t)a.page_table[sb * 64 + (idx >> 7)] * 128 + (idx & 127)) * 2 + kvh) * 128;
                else src = nw + (size_t)(sb * 4 + (idx - PAST)) * 256 + kvh * 128;
                const f32x4 v = *(const f32x4*)(src + (tid & 31) * 4);
                *(LAS u64*)(KV + i * 136 + (tid & 31) * 4) = (u64)pk2(v.x, v.y) | ((u64)pk2(v.z, v.w) << 32); }
            __syncthreads();
            if (pass == 0) {
                const int i = tid >> 1, dh = (tid & 1) * 64; float s0 = 0.f, s1 = 0.f, s2 = 0.f;
#pragma unroll 8
                for (int d = 0; d < 64; ++d) { const float kx = bf2f(KV[i * 136 + dh + d]);
                    s0 = fmaf(QL[(3 * kvh + 0) * 128 + dh + d], kx, s0); s1 = fmaf(QL[(3 * kvh + 1) * 128 + dh + d], kx, s1); s2 = fmaf(QL[(3 * kvh + 2) * 128 + dh + d], kx, s2); }
                s0 += __shfl_xor(s0, 1); s1 += __shfl_xor(s1, 1); s2 += __shfl_xor(s2, 1);
                if ((tid & 1) == 0) { SL[i] = s0 * 0.08838834764831845f; SL[256 + i] = s1 * 0.08838834764831845f; SL[512 + i] = s2 * 0.08838834764831845f; }
                __syncthreads();
                if (w < 3) { float v[4], mx = -1e30f;
#pragma unroll
                    for (int j = 0; j < 4; ++j) { v[j] = SL[w * 256 + 64 * j + lane]; mx = fmaxf(mx, v[j]); }
#pragma unroll
                    for (int o = 1; o < 64; o <<= 1) mx = fmaxf(mx, __shfl_xor(mx, o));
                    float l = 0.f;
#pragma unroll
                    for (int j = 0; j < 4; ++j) { v[j] = __expf(v[j] - mx); l += v[j]; }
                    l = wave_sum(l); const float il = 1.0f / l;
#pragma unroll
                    for (int j = 0; j < 4; ++j) SL[w * 256 + 64 * j + lane] = v[j] * il; }
                __syncthreads();
            } else {
                const int d = tid & 127, part = tid >> 7; float o0 = 0.f, o1 = 0.f, o2 = 0.f;
#pragma unroll 8
                for (int i = part * 64; i < part * 64 + 64; ++i) { const float vx = bf2f(KV[i * 136 + d]); o0 = fmaf(SL[i], vx, o0); o1 = fmaf(SL[256 + i], vx, o1); o2 = fmaf(SL[512 + i], vx, o2); }
                OL[(part * 3 + 0) * 128 + d] = o0; OL[(part * 3 + 1) * 128 + d] = o1; OL[(part * 3 + 2) * 128 + d] = o2;
                __syncthreads();
                if (tid < 384) { const int hq = tid >> 7, dd = tid & 127; const float o = (OL[hq * 128 + dd] + OL[(3 + hq) * 128 + dd]) + (OL[(6 + hq) * 128 + dd] + OL[(9 + hq) * 128 + dd]);
                    MIX[(3 * kvh + hq) * 128 + dd] = (bf16)f2bf(o); }
                __syncthreads();
            }
        }
    }
}


namespace attn {
using bf16 = unsigned short;
typedef short bf16x8 __attribute__((ext_vector_type(8)));
typedef short s16x4 __attribute__((ext_vector_type(4)));
typedef float f32x16 __attribute__((ext_vector_type(16)));
typedef float f32x4 __attribute__((ext_vector_type(4)));
typedef unsigned u32x4 __attribute__((ext_vector_type(4)));
typedef unsigned u32x2 __attribute__((ext_vector_type(2)));
constexpr int D = 128, OS = 1024;
constexpr float THR = 8.f;
constexpr float SCALE = 0.08838834764831845f;
constexpr int NW = 8, QBLK = 32, KVBLK = 64, QB = NW * QBLK;
constexpr int SHM_V = KVBLK * D * 2, SHM_K = KVBLK * D * 2;
constexpr int LDS_BYTES = 2 * SHM_V + 2 * SHM_K + NW * 64 * 4;

#define KSWZ(row, colB) ((row) * 256 + ((colB) ^ (((row) & 7) << 4)))
#define SBAR() __builtin_amdgcn_sched_barrier(0)
__device__ __forceinline__ int v_st(int k, int c) { const int kk = (k & ~0xC) | ((k & 4) << 1) | ((k & 8) >> 1); return ((kk >> 3) * 4 + (c >> 5)) * 512 + ((kk & 7) * 32 + (c & 31)) * 2; }
__device__ __forceinline__ int v_rd_base(int lane) { return ((lane & 3) << 3) | (((lane >> 2) & 3) << 6) | (((lane >> 4) & 1) << 5) | (((lane >> 5) & 1) << 8); }
constexpr int v_rd_off(int d0, int ks, int half) { return d0 * 512 + ks * 4096 + half * 2048; }
__device__ __forceinline__ int crow(int r, int hi) { return (r & 3) + 8 * (r >> 2) + 4 * hi; }
__device__ __forceinline__ unsigned cvtpk(float lo, float hi) {
    unsigned r; asm volatile("v_cvt_pk_bf16_f32 %0, %1, %2" : "=v"(r) : "v"(lo), "v"(hi)); return r;
}
__device__ __forceinline__ bf16x8 pack8(f32x4 a, f32x4 b) {
    u32x4 w = {cvtpk(a[0], a[1]), cvtpk(a[2], a[3]), cvtpk(b[0], b[1]), cvtpk(b[2], b[3])};
    return *reinterpret_cast<bf16x8*>(&w);
}

__device__ __forceinline__ void partialSM(f32x16& p0, f32x16& p1, float& m_reg, float& mn, float& alpha) {
    float pmax = p0[0]; for (int r = 1; r < 16; ++r) pmax = fmaxf(pmax, p0[r]); for (int r = 0; r < 16; ++r) pmax = fmaxf(pmax, p1[r]);
    { auto rr = __builtin_amdgcn_permlane32_swap(__float_as_uint(pmax), __float_as_uint(pmax), false, false);
      pmax = fmaxf(__uint_as_float(rr[0]), __uint_as_float(rr[1])); }
    constexpr float C2 = 1.4426950408889634f * SCALE;
    if (__builtin_expect(__all((pmax - m_reg) * SCALE <= THR), 1)) { mn = m_reg; alpha = 1.f; }
    else { mn = fmaxf(m_reg, pmax); alpha = __builtin_amdgcn_exp2f((m_reg - mn) * C2); m_reg = mn; }
    const float mnL = -mn * C2;
    for (int r = 0; r < 16; ++r) p0[r] = fmaf(p0[r], C2, mnL); for (int r = 0; r < 16; ++r) p1[r] = fmaf(p1[r], C2, mnL);
    for (int r = 0; r < 16; ++r) p0[r] = __builtin_amdgcn_exp2f(p0[r]);
}
__device__ __forceinline__ void finishSM(f32x16& p0, f32x16& p1, float alpha, float& l_reg, bf16x8& pa0, bf16x8& pa1, bf16x8& pa2, bf16x8& pa3) {
    for (int r = 0; r < 16; ++r) p1[r] = __builtin_amdgcn_exp2f(p1[r]);
    float ps = 0; for (int r = 0; r < 16; ++r) ps += p0[r]; for (int r = 0; r < 16; ++r) ps += p1[r];
    { auto rr = __builtin_amdgcn_permlane32_swap(__float_as_uint(ps), __float_as_uint(ps), false, false);
      ps = __uint_as_float(rr[0]) + __uint_as_float(rr[1]); }
    l_reg = l_reg * alpha + ps;
#define PK4(P, B_, OUT) do { unsigned a0 = cvtpk(P[B_+0], P[B_+1]), a1 = cvtpk(P[B_+2], P[B_+3]);                          \
        unsigned b0 = cvtpk(P[B_+4], P[B_+5]), b1 = cvtpk(P[B_+6], P[B_+7]);                                             \
        auto r0 = __builtin_amdgcn_permlane32_swap(a0, b0, false, false); auto r1 = __builtin_amdgcn_permlane32_swap(a1, b1, false, false); \
        u32x4 w = {r0[0], r1[0], r0[1], r1[1]}; OUT = *reinterpret_cast<bf16x8*>(&w); } while (0)
    PK4(p0, 0, pa0); PK4(p0, 8, pa1); PK4(p1, 0, pa2); PK4(p1, 8, pa3);
#undef PK4
}
template <int KB, bool SK>
__device__ __forceinline__ void qkt(f32x16& p0, f32x16& p1, const char* K_lds, int r32, int hi, const bf16x8* qr, bool act) {
    if (SK && !act) { const float NEG = -__builtin_inff();
#pragma unroll
        for (int r = 0; r < 16; ++r) { p0[r] = NEG; p1[r] = NEG; } return; }
    p0 = f32x16{}; p1 = f32x16{};
    const char* kb[4];
#pragma unroll
    for (int dd = 0; dd < 4; ++dd) kb[dd] = K_lds + KB * SHM_K + KSWZ(r32, (dd * 16 + hi * 8) * 2);
#pragma unroll
    for (int d0 = 0; d0 < 8; ++d0) { const char* a = kb[d0 & 3] + (d0 >> 2) * 128;
        bf16x8 b0 = *reinterpret_cast<const bf16x8*>(a);
        bf16x8 b1 = *reinterpret_cast<const bf16x8*>(a + 32 * 256);
        p0 = __builtin_amdgcn_mfma_f32_32x32x16_bf16(b0, qr[d0], p0, 0, 0, 0);
        p1 = __builtin_amdgcn_mfma_f32_32x32x16_bf16(b1, qr[d0], p1, 0, 0, 0); }
}
template <int VB, bool SK>
__device__ __forceinline__ void pv_tile(f32x16* o, int vb0, bf16x8 pa0, bf16x8 pa1, bf16x8 pa2, bf16x8 pa3, bool act) {
    if (SK && !act) return;
#define TRRD(dst, off) asm volatile("ds_read_b64_tr_b16 %0, %1 offset:%2" : "=&v"(dst) : "v"(vb0), "i"(off) : "memory")
#define PV_D0(d0) do { s16x4 l0, l1, l2, l3, h0, h1, h2, h3; constexpr int b_ = VB * SHM_V + v_rd_off(d0, 0, 0);     \
        TRRD(l0, b_); TRRD(h0, b_ + 2048); TRRD(l1, b_ + 4096); TRRD(h1, b_ + 6144); TRRD(l2, b_ + 8192); TRRD(h2, b_ + 10240); TRRD(l3, b_ + 12288); TRRD(h3, b_ + 14336); \
        asm volatile("s_waitcnt lgkmcnt(0)" ::: "memory"); SBAR();                 \
        o[d0] = __builtin_amdgcn_mfma_f32_32x32x16_bf16(pa0, (bf16x8){l0[0], l0[1], l0[2], l0[3], h0[0], h0[1], h0[2], h0[3]}, o[d0], 0, 0, 0);   \
        o[d0] = __builtin_amdgcn_mfma_f32_32x32x16_bf16(pa1, (bf16x8){l1[0], l1[1], l1[2], l1[3], h1[0], h1[1], h1[2], h1[3]}, o[d0], 0, 0, 0);   \
        o[d0] = __builtin_amdgcn_mfma_f32_32x32x16_bf16(pa2, (bf16x8){l2[0], l2[1], l2[2], l2[3], h2[0], h2[1], h2[2], h2[3]}, o[d0], 0, 0, 0);   \
        o[d0] = __builtin_amdgcn_mfma_f32_32x32x16_bf16(pa3, (bf16x8){l3[0], l3[1], l3[2], l3[3], h3[0], h3[1], h3[2], h3[3]}, o[d0], 0, 0, 0); } while (0)
    PV_D0(0); PV_D0(1); PV_D0(2); PV_D0(3);
#undef PV_D0
#undef TRRD
}

__device__ __forceinline__ bf16x8 load8(const bf16* p) { return *reinterpret_cast<const bf16x8*>(p); }
__device__ __forceinline__ void mask_bits(f32x16& p0, f32x16& p1, u32x2 w, int hi) {
    const float NEG = -__builtin_inff();
    asm volatile("" : "+v"(w.x), "+v"(w.y));
    const unsigned lo = w.x >> (4 * hi), up = w.y >> (4 * hi);
#pragma unroll
    for (int r = 0; r < 16; ++r) { const int c = (r & 3) + 8 * (r >> 2);
        if (!((lo >> c) & 1u)) p0[r] = NEG;
        if (!((up >> c) & 1u)) p1[r] = NEG; }
}
struct BlockRef { const bf16* Q; const bf16* K; const bf16* V; bf16* O; const u32x2* M; int P0; };
struct Seam { bf16x8 qr[8]; bf16x8 st_v0, st_v1, st_k0, st_k1; };
#define ROW(p, k0, rr) ((p) + (size_t)((k0) + (rr)) * D + sc)
#define VMW() asm volatile("s_waitcnt vmcnt(0)" ::: "memory")
#define VMWN(n) asm volatile("s_waitcnt vmcnt(%0)" :: "i"(n) : "memory")
#define SLOAD_H(Kp, Vp, k0) do { S.st_v0 = load8(ROW(Vp, k0, sr)); S.st_v1 = load8(ROW(Vp, k0, 32 + sr));              \
                         S.st_k0 = load8(ROW(Kp, k0, sr)); S.st_k1 = load8(ROW(Kp, k0, 32 + sr)); } while (0)
#define SWRITE_HK(bf) do { *(bf16x8*)(K_lds + (bf) * SHM_K + kws) = S.st_k0; *(bf16x8*)(K_lds + (bf) * SHM_K + kws + 32 * 256) = S.st_k1; } while (0)
#define SWRITE_HV(bf) do { *(bf16x8*)(V_lds + (bf) * SHM_V + vst0) = S.st_v0; *(bf16x8*)(V_lds + (bf) * SHM_V + vst1) = S.st_v1; } while (0)
#define SWRITE_H(bf) do { SWRITE_HV(bf); SWRITE_HK(bf); } while (0)
__device__ __forceinline__ void sel_prime(const BlockRef& cur, char* lds, Seam& S) {
    int tid_ = threadIdx.x; asm volatile("" : "+v"(tid_));
    const int tid = tid_, wid = __builtin_amdgcn_readfirstlane(tid >> 6), lane = tid & 63, r32 = lane & 31, hi = lane >> 5;
    const int sr = tid >> 4, sc = (tid & 15) * 8, kws = KSWZ(sr, sc * 2); char* K_lds = lds + 2 * SHM_V;
    for (int d0 = 0; d0 < 8; ++d0) S.qr[d0] = load8(cur.Q + (size_t)(wid * QBLK + r32) * D + d0 * 16 + hi * 8);
    SLOAD_H(cur.K, cur.V, 0); VMW(); SWRITE_HK(0);
    __syncthreads();
}
__device__ __forceinline__ void sel_block(const BlockRef& cur, const BlockRef& nxt, char* lds, Seam& S) {
    int tid_ = threadIdx.x; asm volatile("" : "+v"(tid_));
    const int tid = tid_, wid = __builtin_amdgcn_readfirstlane(tid >> 6), lane = tid & 63, r32 = lane & 31, hi = lane >> 5;
    const int NT = (cur.P0 + QB) / KVBLK;
    char* V_lds = lds; char* K_lds = lds + 2 * SHM_V;
    float* ws = (float*)(lds + 2 * SHM_V + 2 * SHM_K) + wid * 64; float* li_l = ws, * al_l = ws + 32;
    float m_reg = -1e30f, l_reg = 0; f32x16 o[4] = {};
    const int sr = tid >> 4, sc = (tid & 15) * 8, vst0 = v_st(sr, sc), vst1 = v_st(32 + sr, sc), kws = KSWZ(sr, sc * 2);
    const int vb0 = (int)(uintptr_t)V_lds + v_rd_base(lane);
    const bf16* Kh = cur.K; const bf16* Vh = cur.V;
    const u32x2* Mrow = cur.M + (size_t)(wid * QBLK + r32) * 64;
#define RESC(a) do { if (__any((a) < 1.f)) { if (hi == 0) al_l[r32] = (a); asm volatile("s_waitcnt lgkmcnt(0)" ::: "memory");              \
                     for (int d_ = 0; d_ < 4; ++d_) for (int r = 0; r < 16; ++r) o[d_][r] *= al_l[crow(r, hi)]; } } while (0)
#define KBASE(t) ((t) * KVBLK)
    f32x16 pA0, pA1, pB0, pB1; float mnA, mnB, alA, alB; bf16x8 pa0, pa1, pa2, pa3; u32x2 mw;
    SWRITE_HV(0); SBAR();
    if (NT > 1) SLOAD_H(Kh, Vh, KBASE(1));
    mw = Mrow[0];
    SBAR(); qkt<0, false>(pA0, pA1, K_lds, r32, hi, S.qr, true);
    mask_bits(pA0, pA1, mw, hi); partialSM(pA0, pA1, m_reg, mnA, alA);
    if (NT > 1) { VMW(); SWRITE_H(1); }
    __syncthreads();
#define HALF_STEP(PX0, PX1, mnX, alX, PY0, PY1, alY, t, KB, VB, SB) do {                                                      \
        SBAR(); mw = Mrow[(t)]; qkt<KB, false>(PX0, PX1, K_lds, r32, hi, S.qr, true);                                          \
        finishSM(PY0, PY1, alY, l_reg, pa0, pa1, pa2, pa3); SBAR();                                                           \
        if ((t) + 1 < NT) { SLOAD_H(Kh, Vh, KBASE((t) + 1)); SBAR(); }                                                        \
        pv_tile<VB, false>(o, vb0, pa0, pa1, pa2, pa3, true); mask_bits(PX0, PX1, mw, hi); partialSM(PX0, PX1, m_reg, mnX, alX); \
        __syncthreads();                                                                                                      \
        if ((t) + 1 < NT) { VMW(); SWRITE_H(SB); }                                                                            \
        RESC(alX); __syncthreads(); } while (0)
    for (int t = 1; t + 1 < NT; t += 2) {
        HALF_STEP(pB0, pB1, mnB, alB, pA0, pA1, alA, t, 1, 0, 0);
        HALF_STEP(pA0, pA1, mnA, alA, pB0, pB1, alB, t + 1, 0, 1, 1);
    }
    const bool even = (NT & 1) == 0;
    if (even) { SBAR(); mw = Mrow[NT - 1]; qkt<1, false>(pB0, pB1, K_lds, r32, hi, S.qr, true); SBAR(); }
    SLOAD_H(nxt.K, nxt.V, 0); SBAR();
#pragma unroll
    for (int d0 = 0; d0 < 8; ++d0) S.qr[d0] = load8(nxt.Q + (size_t)(wid * QBLK + r32) * D + d0 * 16 + hi * 8);
    SBAR();
    finishSM(pA0, pA1, alA, l_reg, pa0, pa1, pa2, pa3); SBAR();
    pv_tile<0, false>(o, vb0, pa0, pa1, pa2, pa3, true);
    if (even) { mask_bits(pB0, pB1, mw, hi); partialSM(pB0, pB1, m_reg, mnB, alB); __syncthreads(); RESC(alB);
        finishSM(pB0, pB1, alB, l_reg, pa0, pa1, pa2, pa3); SBAR(); pv_tile<1, false>(o, vb0, pa0, pa1, pa2, pa3, true); }
    SBAR(); VMWN(8); SWRITE_HK(0); SBAR();
    if (hi == 0) li_l[r32] = l_reg; asm volatile("s_waitcnt lgkmcnt(0)" ::: "memory");
    float rli[16];
#pragma unroll
    for (int r = 0; r < 16; ++r) rli[r] = __builtin_amdgcn_rcpf(li_l[crow(r, hi)]);
    bf16* Ow = cur.O + (size_t)(wid * QBLK) * OS;
#pragma unroll
    for (int r = 0; r < 16; ++r) { const int orow = crow(r, hi);
#pragma unroll
        for (int d0 = 0; d0 < 4; ++d0) { const float v = o[d0][r] * rli[r];
            const float vn = __shfl_xor(v, 1);
            if ((r32 & 1) == 0) *(unsigned*)(Ow + (size_t)orow * OS + d0 * 32 + r32) = cvtpk(v, vn); } }
    __syncthreads();
#undef RESC
#undef KBASE
#undef HALF_STEP
}
#undef ROW
#undef VMW
#undef VMWN
#undef SLOAD_H
#undef SWRITE_HK
#undef SWRITE_HV
#undef SWRITE_H
#undef KSWZ
#undef SBAR
}


__device__ __forceinline__ attn::BlockRef attn_ref(const Args& a, int b, int h, int qb) {
    attn::BlockRef r; const int kvh = h / 3;
    r.Q = (const attn::bf16*)(a.ws + WS_QB) + ((size_t)(b * 6 + h) * SEQ + (size_t)qb * 256) * 128;
    r.K = (const attn::bf16*)(a.ws + WS_KB) + (size_t)(b * 2 + kvh) * SEQ * 128;
    r.V = (const attn::bf16*)(a.ws + WS_VB) + (size_t)(b * 2 + kvh) * SEQ * 128;
    r.O = (attn::bf16*)(a.ws + WS_MIX) + (size_t)(b * SEQ + qb * 256) * DM + h * 128;
    r.M = (const attn::u32x2*)(a.ws + WS_MASK) + (size_t)(b * SEQ + qb * 256) * 64;
    r.P0 = qb * 256; return r;
}
__device__ __forceinline__ void p11_attention(Ctx& c, const Args& a) {
    constexpr int NITEM = 192;
#pragma unroll 1
    for (int it = c.vcu; it < NITEM; it += c.G) {
        const int p = it & 7, bh = it >> 3, b = bh / 6, h = bh % 6;
        attn::Seam S;
        attn::BlockRef cur = attn_ref(a, b, h, p), nxt = attn_ref(a, b, h, 15 - p);
        __syncthreads();
        attn::sel_prime(cur, (char*)c.lds, S);
        attn::sel_block(cur, nxt, (char*)c.lds, S);
        attn::sel_block(nxt, nxt, (char*)c.lds, S);
    }
    const int spare = c.G - NITEM;
    if (spare > 0) { if (c.vcu >= NITEM) for (int u = c.vcu - NITEM; u < MS; u += spare) attn_sample_unit(c, a, u >> 2, u & 3); }
    else for (int u = c.vcu; u < MS; u += c.G) attn_sample_unit(c, a, u >> 2, u & 3);
}

enum { PH_PRO = 0, PH_IN0, PH_MIX0, PH_HSCAN, PH_HFIX, PH_OUT0, PH_GU0, PH_CONV0, PH_DOWN0, PH_IN1, PH_POST, PH_IDX, PH_TOPK, PH_ATTN, PH_OUT1, PH_GU1, PH_CONV1, PH_DOWN1, NPHASE };
#ifndef ONLYPH
#define ONLYPH -1
#endif
#define PHON(x) (ONLYPH < 0 || ONLYPH == (x))
#ifndef REP_PH
#define REP_PH -1
#endif
#ifndef REP_N
#define REP_N 1
#endif
__global__ void __launch_bounds__(NWAVES * 64, 2) fwd_kernel(Args args) {
    extern __shared__ __attribute__((aligned(16))) unsigned char lds[];
    Ctx c;
    c.lds = (LAS unsigned char*)lds;
    c.MISC = (volatile LAS unsigned*)(c.lds + MISC_OFF);
    c.tid = threadIdx.x; c.lane = c.tid & 63; c.wave = __builtin_amdgcn_readfirstlane(c.tid >> 6);
    c.G = gridDim.x; { const int bx = blockIdx.x; c.vcu = (c.G % 8 == 0) ? (bx % 8) * (c.G / 8) + bx / 8 : bx; }
    unsigned char* ws = args.ws;
    c.ctl = (gu32*)(ws + WS_CTL);
    for (int u = c.tid; u < (LDS_BYTES - LDSCTL_OFF) / 4; u += NWAVES * 64) ((LAS unsigned*)(c.lds + LDSCTL_OFF))[u] = 0u;
    __syncthreads();
    const int lo = args.ph_lo, hi = args.ph_hi;
    XcdBarrier bar; bar.bar = (unsigned*)(c.ctl + CW_BAR); bar.x = 0; bar.st = nullptr;
    if (hi - lo > 1 || REP_N > 1) bar = xcd_barrier_post((unsigned*)(c.ctl + CW_BAR), c.MISC + 8);
    float* const out = args.out;
    c.qoff = 0;
#pragma unroll 1
    for (int ph = lo; ph < hi; ++ph) {
        const int layer = ph >= PH_IN1 ? 1 : 0;
        { int t_ = threadIdx.x; asm volatile("" : "+v"(t_)); c.tid = t_; c.lane = t_ & 63; c.wave = __builtin_amdgcn_readfirstlane(t_ >> 6); }
        if (ph == PH_PRO && PHON(PH_PRO)) p0_prologue(c, args);
        else if ((ph == PH_IN0 || ph == PH_IN1) && PHON(PH_IN0)) {
            pg8::Gemm g{(const pg8::bf16_t*)(ws + WS_XB), (const pg8::bf16_t*)(ws + (ph == PH_IN0 ? WS_WIN0 : WS_WIN1)), MT, 0, 1024};
            pg8::SchedX S; if (ph == PH_IN0) S.init(MP, ZC0, c.G, (int)blockIdx.x, 16, MT / 256, 4, 13); else S.init(MP, ZC1, c.G, (int)blockIdx.x, 0, 0, 1, 0);
            pg8::EpiZ E{(pg8::bf16_t*)(ws + WS_Z), ph == PH_IN0 ? ZC0 : ZC1, ssptr(c, ph == PH_IN0 ? 0 : 2), ph == PH_IN0 ? 13 : 9, (float*)(ws + WS_MEMKV), MEMROW0};
            pg8::gemm_phase<pg8::EpiZ, pg8::SchedX, PG8_ALIGN, PG8_SP2>(c.lds + RING_OFF, g, S, E);
            { SgArgs sg{}; sg.A = (const bf16*)(ws + WS_XB) + (size_t)MP * DM; sg.Bt = (const bf16*)(ws + (ph == PH_IN0 ? WS_WIN0 : WS_WIN1)); sg.K = 1024; sg.mode = 0; sg.Z = (bf16*)(ws + WS_Z); sg.ldz = ph == PH_IN0 ? ZC0 : ZC1; sg.ssin = ssptr(c, ph == PH_IN0 ? 0 : 2);
              sgemm_phase(c, sg, ph == PH_IN0 ? ZC0 : ZC1); }
        }
        else if (ph == PH_MIX0 && PHON(PH_MIX0)) p2_mixer0(c, args);
        else if (ph == PH_HSCAN && PHON(PH_HSCAN)) hgrn_scan(c, args);
        else if (ph == PH_HFIX && PHON(PH_HFIX)) p2c_hgrn_fix(c, args);
        else if ((ph == PH_OUT0 || ph == PH_DOWN0 || ph == PH_OUT1 || ph == PH_DOWN1) && PHON(PH_OUT0)) {
            const bool isout = (ph == PH_OUT0 || ph == PH_OUT1);
            pg8::Gemm g{(const pg8::bf16_t*)(ws + (isout ? WS_MIX : WS_ACT)), (const pg8::bf16_t*)(ws + (isout ? WS_WOUT + (size_t)layer * 1024 * 1024 * 2 : WS_WD + (size_t)layer * 1024 * DFF * 2)), MT, 1024, isout ? 1024 : DFF};
            pg8::SchedX S; S.init(MP, 1024, c.G, (int)blockIdx.x, 0, 0, 1, 0);
            pg8::EpiResid E;
            E.rp = ph == PH_OUT0 ? args.in[0] : out + O_YP; E.rs = ph == PH_OUT0 ? args.in[1] : out + O_YS; E.y = out + O_YP;
            E.xb = ph == PH_DOWN1 ? nullptr : (pg8::bf16_t*)(ws + WS_XB); E.ssout = ph == PH_DOWN1 ? nullptr : ssptr(c, ph == PH_OUT0 ? 1 : (ph == PH_DOWN0 ? 2 : 3));
            pg8::gemm_phase<pg8::EpiResid, pg8::SchedX, PG8_ALIGN, PG8_SP2>(c.lds + RING_OFF, g, S, E);
            { SgArgs sg{}; sg.A = (const bf16*)(ws + (isout ? WS_MIX : WS_ACT)) + (size_t)MP * (isout ? 1024 : DFF); sg.Bt = (const bf16*)g.Bt; sg.K = isout ? 1024 : DFF; sg.mode = 1; sg.resid = E.rs; sg.y = out + O_YS; sg.xb = (bf16*)E.xb; sg.ssout = E.ssout;
              sgemm_phase(c, sg, 1024); }
        }
        else if ((ph == PH_GU0 || ph == PH_GU1) && PHON(PH_GU0)) {
            pg8::Gemm g{(const pg8::bf16_t*)(ws + WS_XB), (const pg8::bf16_t*)(ws + WS_WGU + (size_t)layer * 5632 * 1024 * 2), MT, 5632, 1024};
            pg8::SchedX S; S.init(MP, 5632, c.G, (int)blockIdx.x, 0, 0, 1, 0);
            pg8::EpiGU E{(pg8::bf16_t*)(ws + WS_U), (pg8::bf16_t*)(ws + WS_UP), ssptr(c, layer ? 3 : 1), out + O_CVP + (size_t)layer * 4 * 2 * DFF, out + O_CVS + (size_t)layer * 32 * 2 * DFF};
            pg8::gemm_phase<pg8::EpiGU, pg8::SchedX, PG8_ALIGN, PG8_SP2>(c.lds + RING_OFF, g, S, E);
            { SgArgs sg{}; sg.A = (const bf16*)(ws + WS_XB) + (size_t)MP * DM; sg.Bt = (const bf16*)g.Bt; sg.K = 1024; sg.mode = 2; sg.ssin = E.ss; sg.U = (bf16*)E.U; sg.UP = (bf16*)E.UP; sg.cvs = E.cvs;
              sgemm_phase(c, sg, 5632); }
        }
        else if ((ph == PH_CONV0 || ph == PH_CONV1) && PHON(PH_CONV0)) p5_convact(c, args, layer);
        else if (ph == PH_POST && PHON(PH_POST)) p8_dsa_post(c, args);
        else if (ph == PH_IDX && PHON(PH_IDX)) p9_indexer(c, args);
        else if (ph == PH_TOPK && PHON(PH_TOPK)) p10_topk(c, args);
        else if (ph == PH_ATTN && PHON(PH_ATTN)) p11_attention(c, args);
        if (REP_N > 1 && ph == REP_PH && c.qoff < 4 * (REP_N - 1)) { c.qoff += 4; --ph; xcd_barrier(bar); continue; }
        if (REP_N > 1) c.qoff = 0;
        if (ph + 1 < hi) xcd_barrier(bar);
    }
}

#ifndef MK_ONE_LAUNCH
#define MK_ONE_LAUNCH 1
#endif
extern "C" void kernel_launch(void* const* d_in, const int* in_sizes, int n_in, void* d_out, int out_size, void* d_ws, size_t ws_size, hipStream_t stream) {
    static int grid = 0;
    if (grid == 0) {
        if (n_in != 29 || out_size != (int)O_END || ws_size < WS_END) { fprintf(stderr, "kernel_launch: unexpected problem (n_in %d, out %d, ws %zu)\n", n_in, out_size, ws_size); grid = -1; return; }
        int dev = 0, cus = 0;
        if (hipGetDevice(&dev) != hipSuccess || hipDeviceGetAttribute(&cus, hipDeviceAttributeMultiprocessorCount, dev) != hipSuccess) { grid = -1; return; }
        if (hipFuncSetAttribute((const void*)fwd_kernel, hipFuncAttributeMaxDynamicSharedMemorySize, LDS_BYTES) != hipSuccess) { fprintf(stderr, "kernel_launch: hipFuncSetAttribute failed\n"); grid = -1; return; }
        (void)hipGetLastError();
        grid = cus;
    }
    if (grid < 0) return;
    if (hipMemsetAsync((char*)d_ws + WS_CTL, 0, CTL_ZERO_BYTES, stream) != hipSuccess) { fprintf(stderr, "kernel_launch: memset failed\n"); return; }
    Args a{};
    for (int i = 0; i < 29; ++i) a.in[i] = (const float*)d_in[i];
    a.page_table = (const int*)d_in[9]; a.out = (float*)d_out; a.ws = (unsigned char*)d_ws;
#if MK_ONE_LAUNCH
    a.ph_lo = 0; a.ph_hi = NPHASE;
    hipLaunchKernelGGL(fwd_kernel, dim3(grid), dim3(NWAVES * 64), LDS_BYTES, stream, a);
#else
    for (int ph = 0; ph < NPHASE; ++ph) { a.ph_lo = ph; a.ph_hi = ph + 1; hipLaunchKernelGGL(fwd_kernel, dim3(grid), dim3(NWAVES * 64), LDS_BYTES, stream, a); }
#endif
}
```

```cpp
#include <hip/hip_runtime.h>
#include <cstdio>
#include <cstdint>


namespace pg8 {
#define PG8_LAS __attribute__((address_space(3)))
typedef unsigned short bf16_t;
typedef short bf16x8 __attribute__((ext_vector_type(8)));
typedef float f32x4 __attribute__((ext_vector_type(4)));
typedef unsigned u32x4 __attribute__((ext_vector_type(4)));
constexpr int BM = 256, BK = 64, HALF = 128, HTB = HALF * BK * 2  , STAGE_BYTES = 8 * HTB, NXCD = 8, WGM = 8;

__host__ __device__ __forceinline__ int lds_byte(int r, int c) { const int st = (r >> 4) * 2 + (c >> 5), rr = r & 15, cc = c & 31, ob = rr * 64 + cc * 2; return st * 1024 + (ob ^ (((ob >> 9) & 1) << 5)); }
__host__ __device__ __forceinline__ void stage_rc(int b, int& R, int& C) { const int st = b / 1024, sb = b % 1024, swz = sb ^ (((sb >> 9) & 1) << 5); R = (st >> 1) * 16 + swz / 64; C = (st & 1) * 32 + (swz % 64) / 2; }
__host__ __device__ __forceinline__ int perm32(int rho) { const int n = rho >> 4, i = rho & 15; return 8 * (i >> 2) + 4 * n + (i & 3); }

struct Unit { int pm, pn; };
struct Gemm { const bf16_t* A; const bf16_t* Bt; int M, N, K; };

struct StaticOrder {
    int nM, nN, nwg, G, c;
    __host__ __device__ void init(int M, int N, int G_, int c_) { nM = M / BM; nN = N / BM; nwg = nM * nN; G = G_; c = c_; }
    __host__ __device__ bool next(int i, Unit& u) const {
        const long L = (long)i * G + c; if (L >= nwg) return false;
        int wgid = (int)L; { const int q = nwg / NXCD, r = nwg % NXCD, xcd = wgid % NXCD, off = wgid / NXCD; wgid = (xcd < r ? xcd * (q + 1) : r * (q + 1) + (xcd - r) * q) + off; }
        const int nig = WGM * nN, gid = wgid / nig, fm = gid * WGM, gsz = (nM - fm) < WGM ? (nM - fm) : WGM;
        u.pm = fm + ((wgid % nig) % gsz); u.pn = (wgid % nig) / gsz; return true;
    }
    __device__ __forceinline__ void a_ready(const Unit&) const {}
    __device__ __forceinline__ void done(const Unit&) const {}
};


constexpr int MP = 16384, MS = 128, MVALID = MP + MS, MT = 16640, DM = 1024, DFF = 2816;
constexpr float RMS_EPS = 1e-6f;
__device__ __forceinline__ unsigned cvt_pk_bf16(float lo, float hi) { unsigned r; asm volatile("v_cvt_pk_bf16_f32 %0, %1, %2" : "=v"(r) : "v"(lo), "v"(hi)); return r; }

struct SchedX {
    StaticOrder so; int nextra, e_pm0, e_nm, e_pn0;
    __device__ void init(int M, int N, int G_, int c_, int nextra_, int e_pm0_, int e_nm_, int e_pn0_) { so.init(M, N, G_, c_); nextra = nextra_; e_pm0 = e_pm0_; e_nm = e_nm_; e_pn0 = e_pn0_; }
    __device__ bool next(int i, Unit& u) const {
        const long L = (long)i * so.G + so.c;
        if (L < so.nwg) return so.next(i, u);
        const int e = (int)(L - so.nwg); if (e >= nextra) return false;
        u.pm = e_pm0 + e % e_nm; u.pn = e_pn0 + e / e_nm; return true;
    }
    __device__ __forceinline__ void a_ready(const Unit&) const {}
    __device__ __forceinline__ void done(const Unit&) const {}
};

struct EpiZ {
    static constexpr bool PERM = true, AFTER_DRAIN = false;
    bf16_t* Z; int ldz; const float* ss; int nmain; float* memkv; int memrow0;
    __device__ __forceinline__ void operator()(const f32x4 (&acc)[2][2][4][2], const Unit& u, int wr, int wc, int fr, int fq) const {
        const int row0 = u.pm * BM + wr * 64 + fr;
        if (u.pn < nmain) {
            const int col0 = u.pn * BM + wc * 32 + 8 * fq;
#pragma unroll
            for (int ai = 0; ai < 2; ++ai)
#pragma unroll
                for (int m = 0; m < 4; ++m) { const int row = row0 + ai * HALF + m * 16; const float rs = rsqrtf(ss[row] * (1.0f / DM) + RMS_EPS);
#pragma unroll
                    for (int bj = 0; bj < 2; ++bj) { const f32x4 v0 = acc[ai][bj][m][0] * rs, v1 = acc[ai][bj][m][1] * rs;
                        u32x4 w; w.x = cvt_pk_bf16(v0[0], v0[1]); w.y = cvt_pk_bf16(v0[2], v0[3]); w.z = cvt_pk_bf16(v1[0], v1[1]); w.w = cvt_pk_bf16(v1[2], v1[3]);
                        *(u32x4*)(Z + (size_t)row * ldz + col0 + bj * HALF) = w; } }
        } else {
            const int col0 = (u.pn - nmain) * BM + wc * 32 + 8 * fq;
#pragma unroll
            for (int ai = 0; ai < 2; ++ai)
#pragma unroll
                for (int m = 0; m < 4; ++m) { const int row = row0 + ai * HALF + m * 16 - memrow0;
#pragma unroll
                    for (int bj = 0; bj < 2; ++bj) { float* p = memkv + (size_t)row * 1024 + col0 + bj * HALF; *(f32x4*)p = acc[ai][bj][m][0]; *(f32x4*)(p + 4) = acc[ai][bj][m][1]; } }
        }
    }
};

struct EpiResid {
    static constexpr bool PERM = true, AFTER_DRAIN = false;
    const float* rp; const float* rs; float* y; bf16_t* xb; float* ssout;
    __device__ __forceinline__ void operator()(const f32x4 (&acc)[2][2][4][2], const Unit& u, int wr, int wc, int fr, int fq) const {
        const int row0 = u.pm * BM + wr * 64 + fr, col0 = u.pn * BM + wc * 32 + 8 * fq;
#pragma unroll
        for (int ai = 0; ai < 2; ++ai)
#pragma unroll
            for (int m = 0; m < 4; ++m) { const int row = row0 + ai * HALF + m * 16; float part = 0.f;
                if (row < MVALID) { const float* src = row < MP ? rp + (size_t)row * DM : rs + (size_t)(row - MP) * DM;
#pragma unroll
                    for (int bj = 0; bj < 2; ++bj) { const int c = col0 + bj * HALF;
                        const f32x4 v0 = acc[ai][bj][m][0] + *(const f32x4*)(src + c), v1 = acc[ai][bj][m][1] + *(const f32x4*)(src + c + 4);
                        *(f32x4*)(y + (size_t)row * DM + c) = v0; *(f32x4*)(y + (size_t)row * DM + c + 4) = v1;
                        part += (v0[0] * v0[0] + v0[1] * v0[1]) + (v0[2] * v0[2] + v0[3] * v0[3]) + (v1[0] * v1[0] + v1[1] * v1[1]) + (v1[2] * v1[2] + v1[3] * v1[3]);
                        if (xb) { u32x4 w; w.x = cvt_pk_bf16(v0[0], v0[1]); w.y = cvt_pk_bf16(v0[2], v0[3]); w.z = cvt_pk_bf16(v1[0], v1[1]); w.w = cvt_pk_bf16(v1[2], v1[3]);
                            *(u32x4*)(xb + (size_t)row * DM + c) = w; } } }
                part += __shfl_xor(part, 16); part += __shfl_xor(part, 32);
                if (ssout && fq == 0 && row < MVALID) atomicAdd(ssout + row, part); }
    }
};

struct EpiGU {
    static constexpr bool PERM = true, AFTER_DRAIN = false;
    bf16_t* U; bf16_t* UP; const float* ss; float* cvp; float* cvs;
    __device__ __forceinline__ void operator()(const f32x4 (&acc)[2][2][4][2], const Unit& u, int wr, int wc, int fr, int fq) const {
        const int row0 = u.pm * BM + wr * 64 + fr, colg = u.pn * HALF + wc * 32 + 8 * fq;
#pragma unroll
        for (int ai = 0; ai < 2; ++ai)
#pragma unroll
            for (int m = 0; m < 4; ++m) { const int row = row0 + ai * HALF + m * 16; const float rs = rsqrtf(ss[row] * (1.0f / DM) + RMS_EPS);
                const f32x4 g0 = acc[ai][0][m][0] * rs, g1 = acc[ai][0][m][1] * rs, p0 = acc[ai][1][m][0] * rs, p1 = acc[ai][1][m][1] * rs;
                u32x4 w; w.x = cvt_pk_bf16(g0[0], g0[1]); w.y = cvt_pk_bf16(g0[2], g0[3]); w.z = cvt_pk_bf16(g1[0], g1[1]); w.w = cvt_pk_bf16(g1[2], g1[3]);
                *(u32x4*)(U + (size_t)row * DFF + colg) = w;
                w.x = cvt_pk_bf16(p0[0], p0[1]); w.y = cvt_pk_bf16(p0[2], p0[3]); w.z = cvt_pk_bf16(p1[0], p1[1]); w.w = cvt_pk_bf16(p1[2], p1[3]);
                *(u32x4*)(UP + (size_t)row * DFF + colg) = w;
                float* cv = nullptr;
                if (row < MP) { const int t = row & 4095; if (t >= 4094) cv = cvp + (size_t)((row >> 12) * 2 + (t - 4094)) * DFF; }
                else if (row < MVALID) { const int r2 = row - MP, t = r2 & 3; if (t >= 2) cv = cvs + (size_t)((r2 >> 2) * 2 + (t - 2)) * DFF; }
                if (cv) { *(f32x4*)(cv + colg) = g0; *(f32x4*)(cv + colg + 4) = g1; } }
    }
};

template <class Epi, class Sched, bool ALIGN_EPI = false, bool SP2 = false>
__device__ __forceinline__ void gemm_phase(PG8_LAS unsigned char* lds, const Gemm g, const Sched& S, const Epi& E) {
    int tid_ = threadIdx.x; asm volatile("" : "+v"(tid_));
    const int tid = tid_, wid = __builtin_amdgcn_readfirstlane(tid >> 6), lane = tid & 63, wr = wid >> 2, wc = wid & 3, fr = lane & 15, fq = lane >> 4;
    const int K = g.K, nt = K / BK;
    unsigned voffA[2], voffB[2];
#pragma unroll
    for (int i = 0; i < 2; ++i) { int R, C; stage_rc(tid * 16 + i * 8192, R, C); const int Rb = Epi::PERM ? ((R & ~31) + perm32(R & 31)) : R;
        voffA[i] = (unsigned)(R * K + C) * 2u; voffB[i] = (unsigned)(Rb * K + C) * 2u; }
    const size_t kstep = (size_t)(BK * 2);
    const size_t hstep = (size_t)HALF * K * 2;
    const size_t tstep = 2 * hstep;
    const unsigned ldsw = (unsigned)wid * 1024u;
    const int aoff = lds_byte(wr * 64 + fr, fq * 8), boff = lds_byte(wc * 32 + fr, fq * 8);
#define PG8_SA(b, h) (((b) * 2 + (h)) * HTB)
#define PG8_SB(b, h) ((4 + (b) * 2 + (h)) * HTB)
#define PG8_STAGE(bufoff, gbase, voff) do { _Pragma("unroll") for (int _i = 0; _i < 2; ++_i) \
        __builtin_amdgcn_global_load_lds((const unsigned*)((const char*)(gbase) + (voff)[_i]), (PG8_LAS unsigned*)(lds + (bufoff) + ldsw + _i * 8192), 16, 0, 0); } while (0)
#define PG8_LDA(dst, b, h) do { _Pragma("unroll") for (int m = 0; m < 4; ++m) _Pragma("unroll") for (int k = 0; k < 2; ++k) dst[m][k] = *(const PG8_LAS bf16x8*)(lds + PG8_SA(b, h) + aoff + m * 2048 + k * 1024); } while (0)
#define PG8_LDB(dst, b, h) do { _Pragma("unroll") for (int n = 0; n < 2; ++n) _Pragma("unroll") for (int k = 0; k < 2; ++k) dst[n][k] = *(const PG8_LAS bf16x8*)(lds + PG8_SB(b, h) + boff + n * 2048 + k * 1024); } while (0)
#define PG8_MMA(ai, bj, At, Bt) do { __builtin_amdgcn_s_setprio(1); _Pragma("unroll") for (int m = 0; m < 4; ++m) _Pragma("unroll") for (int n = 0; n < 2; ++n) _Pragma("unroll") for (int k = 0; k < 2; ++k) \
        acc[ai][bj][m][n] = __builtin_amdgcn_mfma_f32_16x16x32_bf16(Bt[n][k], At[m][k], acc[ai][bj][m][n], 0, 0, 0); __builtin_amdgcn_s_setprio(0); } while (0)
#define PG8_WAIT_V(n) asm volatile("s_waitcnt vmcnt(" #n ")" ::: "memory")
#define PG8_WAIT_L(n) asm volatile("s_waitcnt lgkmcnt(" #n ")" ::: "memory")
#define PG8_BAR __builtin_amdgcn_s_barrier()
#define PG8_SCHED __builtin_amdgcn_sched_barrier(0)
    Unit cur, nxt; int ui = 0;
    if (!S.next(0, cur)) return;
    f32x4 acc[2][2][4][2];
#pragma unroll
    for (int a = 0; a < 2; ++a)
#pragma unroll
        for (int b = 0; b < 2; ++b)
#pragma unroll
            for (int m = 0; m < 4; ++m)
#pragma unroll
                for (int n = 0; n < 2; ++n) acc[a][b][m][n] = (f32x4){0.f, 0.f, 0.f, 0.f};
    bf16x8 At[4][2], B0[2][2], B1[2][2];
    const char* cA = (const char*)g.A + (size_t)cur.pm * tstep; const char* cB = (const char*)g.Bt + (size_t)cur.pn * tstep;
    S.a_ready(cur);
    if constexpr (SP2) {
        PG8_STAGE(PG8_SB(0, 0), cB, voffB); PG8_STAGE(PG8_SB(0, 1), cB + hstep, voffB); PG8_STAGE(PG8_SA(0, 0), cA, voffA); PG8_STAGE(PG8_SA(0, 1), cA + hstep, voffA);
        if (wr == 1) PG8_BAR;
        PG8_WAIT_V(2); PG8_BAR;
        PG8_STAGE(PG8_SB(1, 0), cB + kstep, voffB); PG8_STAGE(PG8_SA(1, 0), cA + kstep, voffA); PG8_STAGE(PG8_SB(1, 1), cB + hstep + kstep, voffB);
        PG8_WAIT_V(6); PG8_BAR;
    } else {
        PG8_STAGE(PG8_SB(0, 0), cB, voffB); PG8_STAGE(PG8_SA(0, 0), cA, voffA); PG8_STAGE(PG8_SB(0, 1), cB + hstep, voffB); PG8_STAGE(PG8_SA(0, 1), cA + hstep, voffA);
        if (wr == 1) PG8_BAR;
        PG8_WAIT_V(4); PG8_BAR;
        PG8_STAGE(PG8_SB(1, 0), cB + kstep, voffB); PG8_STAGE(PG8_SA(1, 0), cA + kstep, voffA); PG8_STAGE(PG8_SB(1, 1), cB + hstep + kstep, voffB);
        PG8_WAIT_V(6); PG8_BAR;
    }
    for (;;) {
        const bool has_next = S.next(ui + 1, nxt);
        const char* nA = has_next ? (const char*)g.A + (size_t)nxt.pm * tstep : cA; const char* nB = has_next ? (const char*)g.Bt + (size_t)nxt.pn * tstep : cB;
        for (int t = 0; t < nt; t += 2) {
            const bool last = (t == nt - 2);
            const char* a1 = cA + (size_t)(t + 1) * kstep;
            const char* a2 = last ? nA : cA + (size_t)(t + 2) * kstep; const char* b2 = last ? nB : cB + (size_t)(t + 2) * kstep;
            const char* a3 = a2 + kstep; const char* b3 = b2 + kstep;
            if (last && has_next) S.a_ready(nxt);
            if constexpr (SP2) {
            PG8_LDB(B0, 0, 0); PG8_LDB(B1, 0, 1); PG8_SCHED; PG8_LDA(At, 0, 0); PG8_STAGE(PG8_SA(1, 1), a1 + hstep, voffA);
            PG8_WAIT_V(8); PG8_WAIT_L(0); PG8_BAR; PG8_MMA(0, 0, At, B0); PG8_MMA(0, 1, At, B1); PG8_BAR; PG8_SCHED;
            PG8_LDA(At, 0, 1); PG8_STAGE(PG8_SB(0, 0), b2, voffB); PG8_STAGE(PG8_SB(0, 1), b2 + hstep, voffB); PG8_STAGE(PG8_SA(0, 0), a2, voffA);
            PG8_WAIT_V(8); PG8_WAIT_L(0); PG8_BAR; PG8_MMA(1, 0, At, B0); PG8_MMA(1, 1, At, B1); PG8_BAR; PG8_SCHED;
            PG8_LDB(B0, 1, 0); PG8_LDB(B1, 1, 1); PG8_SCHED; PG8_LDA(At, 1, 0); PG8_STAGE(PG8_SA(0, 1), a2 + hstep, voffA);
            PG8_WAIT_V(8); PG8_WAIT_L(0); PG8_BAR; PG8_MMA(0, 0, At, B0); PG8_MMA(0, 1, At, B1); PG8_BAR; PG8_SCHED;
            PG8_LDA(At, 1, 1); PG8_STAGE(PG8_SB(1, 0), b3, voffB); PG8_STAGE(PG8_SB(1, 1), b3 + hstep, voffB); PG8_STAGE(PG8_SA(1, 0), a3, voffA);
            PG8_WAIT_V(8); PG8_WAIT_L(0); PG8_BAR; PG8_MMA(1, 0, At, B0); PG8_MMA(1, 1, At, B1); PG8_BAR; PG8_SCHED;
            } else {
            PG8_LDB(B0, 0, 0); PG8_SCHED; PG8_LDA(At, 0, 0); PG8_STAGE(PG8_SA(1, 1), a1 + hstep, voffA);
            PG8_WAIT_L(8); PG8_BAR; PG8_WAIT_L(0); PG8_MMA(0, 0, At, B0); PG8_BAR; PG8_SCHED;
            PG8_LDB(B1, 0, 1); PG8_STAGE(PG8_SB(0, 0), b2, voffB);
            PG8_BAR; PG8_WAIT_L(0); PG8_MMA(0, 1, At, B1); PG8_BAR;
            PG8_LDA(At, 0, 1); PG8_STAGE(PG8_SA(0, 0), a2, voffA);
            PG8_BAR; PG8_WAIT_L(0); PG8_MMA(1, 0, At, B0); PG8_BAR; PG8_SCHED;
            PG8_STAGE(PG8_SB(0, 1), b2 + hstep, voffB);
            PG8_WAIT_V(6); PG8_BAR; PG8_MMA(1, 1, At, B1); PG8_BAR;
            PG8_LDB(B0, 1, 0); PG8_SCHED; PG8_LDA(At, 1, 0); PG8_STAGE(PG8_SA(0, 1), a2 + hstep, voffA);
            PG8_WAIT_L(8); PG8_BAR; PG8_WAIT_L(0); PG8_MMA(0, 0, At, B0); PG8_BAR; PG8_SCHED;
            PG8_LDB(B1, 1, 1); PG8_STAGE(PG8_SB(1, 0), b3, voffB);
            PG8_BAR; PG8_WAIT_L(0); PG8_MMA(0, 1, At, B1); PG8_BAR;
            PG8_LDA(At, 1, 1); PG8_STAGE(PG8_SA(1, 0), a3, voffA);
            PG8_BAR; PG8_WAIT_L(0); PG8_MMA(1, 0, At, B0); PG8_BAR; PG8_SCHED;
            PG8_STAGE(PG8_SB(1, 1), b3 + hstep, voffB);
            PG8_WAIT_V(6); PG8_BAR; PG8_MMA(1, 1, At, B1); PG8_BAR;
            }
        }
        if constexpr (ALIGN_EPI) { if (wr == 0) PG8_BAR; }
        if constexpr (!Epi::AFTER_DRAIN) { E(acc, cur, wr, wc, fr, fq); S.done(cur); }
        if (!has_next) break;
#pragma unroll
        for (int a = 0; a < 2; ++a)
#pragma unroll
            for (int b = 0; b < 2; ++b)
#pragma unroll
                for (int m = 0; m < 4; ++m)
#pragma unroll
                    for (int n = 0; n < 2; ++n) acc[a][b][m][n] = (f32x4){0.f, 0.f, 0.f, 0.f};
        cur = nxt; cA = nA; cB = nB; ++ui;
        if constexpr (ALIGN_EPI) { if (wr == 1) PG8_BAR; }
    }
    PG8_WAIT_V(0);
    if constexpr (!ALIGN_EPI) { if (wr == 0) PG8_BAR; }
    PG8_BAR;
    if constexpr (Epi::AFTER_DRAIN) { E.fused(acc, cur, wr, wc, fr, fq, lds, wid, lane); S.done(cur); }
#undef PG8_SA
#undef PG8_SB
#undef PG8_STAGE
#undef PG8_LDA
#undef PG8_LDB
#undef PG8_MMA
#undef PG8_WAIT_V
#undef PG8_WAIT_L
#undef PG8_BAR
#undef PG8_SCHED
}
}


#ifndef PG8_SP2
#define PG8_SP2 true
#endif
#ifndef PG8_ALIGN
#define PG8_ALIGN true
#endif
constexpr int NWAVES = 8;
constexpr int MP = pg8::MP, MS = pg8::MS, MVALID = pg8::MVALID, MT = pg8::MT, DM = 1024, DFF = 2816;
constexpr int SEQ = 4096, NB = 4, NSB = 32, PAST = 8192, NPOOL = 2560;
constexpr int ZC0 = 3328, ZC1 = 2304;
constexpr int Z1_Q = 0, Z1_K = 768, Z1_V = 1024, Z1_IQ = 1280, Z1_IK = 1792, Z1_IW = 1856, Z1_MQ = 1920;
constexpr int NMEMROWS = 1024, MEMROW0 = MT;
constexpr float EPS = 1e-6f;
constexpr size_t MiB = 1u << 20;
constexpr size_t WS_CTL = 0, CTL_ZERO_BYTES = 2 * MiB;
constexpr size_t WS_WIN0 = 2 * MiB, WS_WIN1 = 11 * MiB, WS_WOUT = 16 * MiB, WS_WGU = 20 * MiB, WS_WD = 42 * MiB;
constexpr size_t WS_XB = 54 * MiB, WS_MEMKV = 89 * MiB, WS_MIX = 94 * MiB, WS_Z = 128 * MiB, WS_U = 234 * MiB, WS_UP = 324 * MiB, WS_ACT = 414 * MiB;
constexpr size_t WS_QB = 504 * MiB, WS_KB = 528 * MiB, WS_VB = 536 * MiB, WS_IQB = 544 * MiB, WS_IKB = 560 * MiB, WS_IW = 562 * MiB;
constexpr size_t WS_SQ = 563 * MiB, WS_SIQ = WS_SQ + 512 * 1024, WS_SIW = WS_SIQ + 384 * 1024, WS_SSC = 564 * MiB, WS_SIDX = 569 * MiB, WS_MASK = 570 * MiB, WS_SC = 578 * MiB, WS_END = 834 * MiB;
constexpr int SSC_LD = 8256;
constexpr int CW_TMO = 0, CW_BAR = 4096, CW_Q = 8192, CW_SS = 16384;
constexpr size_t O_YP = 0, O_YS = O_YP + (size_t)MP * DM, O_HP = O_YS + (size_t)MS * DM, O_HS = O_HP + 4 * 6 * 16384, O_KP = O_HS + 32 * 6 * 16384,
    O_VP = O_KP + (size_t)MP * 256, O_IKP = O_VP + (size_t)MP * 256, O_KS = O_IKP + (size_t)MP * 64, O_VS = O_KS + MS * 256, O_IKS = O_VS + MS * 256,
    O_MK = O_IKS + MS * 64, O_MV = O_MK + 2 * 1024 * 256, O_CVP = O_MV + 2 * 1024 * 256, O_CVS = O_CVP + 2 * 4 * 2 * DFF, O_END = O_CVS + 2 * 32 * 2 * DFF;
static_assert(O_END == 31412224, "output size");
constexpr int RING_OFF = 0, RING_BYTES = 131072;
constexpr int LDSCTL_OFF = RING_BYTES, MISC_OFF = LDSCTL_OFF + 320;
constexpr int LDS_BYTES = 147456;

#define GAS __attribute__((address_space(1)))
#define LAS __attribute__((address_space(3)))
typedef unsigned short bf16;
typedef unsigned v4u __attribute__((ext_vector_type(4)));
typedef float f32x4 __attribute__((ext_vector_type(4)));
typedef short bf16x8 __attribute__((ext_vector_type(8)));
typedef GAS unsigned gu32;
typedef GAS unsigned long long gu64;
#define RLX_AGENT __ATOMIC_RELAXED, __HIP_MEMORY_SCOPE_AGENT
#define LDS_WAIT() asm volatile("s_waitcnt lgkmcnt(0)" ::: "memory")
#define VM_WAIT() asm volatile("s_waitcnt vmcnt(0)" ::: "memory")
__device__ __forceinline__ unsigned long long rt() { return __builtin_amdgcn_s_memrealtime(); }
__device__ __forceinline__ unsigned f2bf(float f) { unsigned u = __builtin_bit_cast(unsigned, f); return (u + 0x7fffu + ((u >> 16) & 1u)) >> 16; }
__device__ __forceinline__ unsigned pk2(float lo, float hi) { return f2bf(lo) | (f2bf(hi) << 16); }

#define XB_TMO      128
#define XB_XCNT(j)  (256  + 64 * (j))
#define XB_XSUB(j)  (1280 + 64 * (j))
#define XB_XGEN(j)  (2304 + 64 * (j))
#define XB_TOP      3328
#define XB_TOPGEN   3392
#define XCD_BAR_WORDS 3456
#define XB_SPIN_CAP (1u << 18)

__device__ __forceinline__ unsigned xb_ld(unsigned* p)              { return __hip_atomic_load(p, __ATOMIC_RELAXED, __HIP_MEMORY_SCOPE_AGENT); }
__device__ __forceinline__ unsigned xb_add(unsigned* p, unsigned v) { return __hip_atomic_fetch_add(p, v, __ATOMIC_RELAXED, __HIP_MEMORY_SCOPE_AGENT); }
__device__ __forceinline__ unsigned xb_xcc_id() { return (unsigned)__builtin_amdgcn_s_getreg((3 << 11) | 20) & 0xFu; }
#define XB_SPIN(cond, bar) do { unsigned _sp = 0; while (cond) { __builtin_amdgcn_s_sleep(1); \
    if ((++_sp & 255u) == 0u) { if (xb_ld(&(bar)[XB_TMO])) break; if (_sp > XB_SPIN_CAP) { atomicAdd(&(bar)[XB_TMO], 1u); break; } } } } while (0)

struct XcdBarrier {
    unsigned* bar; unsigned x;
    volatile LAS unsigned* st;
};

__device__ __forceinline__ XcdBarrier xcd_barrier_post(unsigned* bar, volatile LAS unsigned* st) {
    XcdBarrier b; b.bar = bar; b.x = xb_xcc_id(); b.st = st;
    if (threadIdx.x == 0) (void)xb_add(&bar[XB_XCNT(b.x)], 1u);
    return b;
}
__device__ __forceinline__ void xcd_barrier_complete(unsigned* bar, unsigned x, unsigned& nloc, unsigned& nx) {
    const unsigned G = gridDim.x * gridDim.y * gridDim.z;
    unsigned sum, cnt, mine, sp = 0u;
    for (;;) {
        sum = 0u; cnt = 0u; mine = 0u;
#pragma unroll
        for (unsigned j = 0; j < 16; ++j) { const unsigned c = xb_ld(&bar[XB_XCNT(j)]); sum += c; cnt += (c > 0u) ? 1u : 0u; mine = (j == x) ? c : mine; }
        if (sum == G) break;
        __builtin_amdgcn_s_sleep(1);
        if ((++sp & 255u) == 0u) { if (xb_ld(&bar[XB_TMO])) break; if (sp > XB_SPIN_CAP) { atomicAdd(&bar[XB_TMO], 1u); break; } }
    }
    nloc = mine > 0u ? mine : 1u; nx = cnt > 0u ? cnt : 1u;
}

__device__ __forceinline__ void xcd_barrier(const XcdBarrier& b) {
    asm volatile("s_waitcnt vmcnt(0)" ::: "memory");
    __syncthreads();
    if (threadIdx.x == 0) {
        unsigned* bar = b.bar;
        __builtin_amdgcn_s_waitcnt(0);
        unsigned nloc = b.st[0], nx = b.st[1];
        if (nloc == 0u) { xcd_barrier_complete(bar, b.x, nloc, nx); b.st[0] = nloc; b.st[1] = nx; }
        const unsigned old = xb_add(&bar[XB_XSUB(b.x)], 1u);
        const unsigned gen = old / nloc;
        if (old + 1u == (gen + 1u) * nloc) {
            __builtin_amdgcn_fence(__ATOMIC_RELEASE, "agent");
            asm volatile("s_waitcnt vmcnt(0)" ::: "memory");
            const unsigned og = xb_add(&bar[XB_TOP], 1u);
            const unsigned tg = og / nx;
            if (og + 1u == (tg + 1u) * nx) xb_add(&bar[XB_TOPGEN], 1u);
            else XB_SPIN(xb_ld(&bar[XB_TOPGEN]) == tg, bar);
            __builtin_amdgcn_fence(__ATOMIC_ACQUIRE, "agent");
            xb_add(&bar[XB_XGEN(b.x)], 1u);
            asm volatile("s_waitcnt vmcnt(0)" ::: "memory");
        } else {
            XB_SPIN(xb_ld(&bar[XB_XGEN(b.x)]) == gen, bar);
            __builtin_amdgcn_fence(__ATOMIC_ACQUIRE, "agent");
            asm volatile("s_waitcnt vmcnt(0)" ::: "memory");
        }
    }
    __syncthreads();
}


struct Args { const float* in[29]; const int* page_table; float* out; unsigned char* ws; int ph_lo, ph_hi; };
struct Ctx { LAS unsigned char* lds; volatile LAS unsigned* MISC; gu32* ctl; int tid, lane, wave, vcu, G, qoff; };
typedef float f32x16 __attribute__((ext_vector_type(16)));
typedef unsigned long long u64;

__device__ __forceinline__ float bf2f(unsigned b) { return __builtin_bit_cast(float, b << 16); }
__device__ __forceinline__ float wave_sum(float v) {
#pragma unroll
    for (int o = 1; o < 64; o <<= 1) v += __shfl_xor(v, o);
    return v;
}
__device__ __forceinline__ int crow(int r, int hi) { return (r & 3) + 8 * (r >> 2) + 4 * hi; }
__device__ __forceinline__ float sigmoidf_(float x) { return 1.0f / (1.0f + __expf(-x)); }
__device__ __forceinline__ float* ssptr(const Ctx& c, int i) { return (float*)(c.ctl + CW_SS) + (size_t)i * MT; }

__device__ __forceinline__ int q_next(Ctx& c, int qi) {
    __syncthreads();
    if (c.tid == 0) c.MISC[16] = atomicAdd((unsigned*)(c.ctl + CW_Q + 64 * (qi + c.qoff)), 1u);
    __syncthreads();
    return (int)c.MISC[16];
}

template <int K>
__device__ __forceinline__ f32x16 mm32(const LAS bf16* A, int lda, const LAS bf16* Bt, int ldb, f32x16 acc, int lane) {
    const int r = lane & 31, h = lane >> 5;
#pragma unroll
    for (int ks = 0; ks < K; ks += 16) {
        const bf16x8 a = *(const LAS bf16x8*)(A + r * lda + ks + 8 * h);
        const bf16x8 b = *(const LAS bf16x8*)(Bt + r * ldb + ks + 8 * h);
        acc = __builtin_amdgcn_mfma_f32_32x32x16_bf16(a, b, acc, 0, 0, 0);
    }
    return acc;
}

__device__ __forceinline__ int map_row(int mapid, int n, int row_off) {
    if (mapid == 0) return n + row_off;
    if (mapid == 1) return n < 1864 ? n : n + 56;
    if (mapid == 2) return (n >> 7) * 256 + (n & 127);
    return (n >> 7) * 256 + 128 + (n & 127);
}
__device__ __forceinline__ void transpose_item(const float* W, int K, int N, const float* kscale, bf16* WT, int mapid, int row_off, LAS float* scr, int item, int lane) {
    const int nblk = (N + 31) / 32, kb = item / nblk, nb = item % nblk, k0 = 64 * kb, n0 = 32 * nb;
    { const int n4 = (lane & 7) * 4, nn = n0 + n4 < N ? n0 + n4 : N - 4; f32x4 v[8];
#pragma unroll
      for (int i = 0; i < 8; ++i) v[i] = *(const f32x4*)(W + (size_t)(k0 + 8 * i + (lane >> 3)) * N + nn);
#pragma unroll
      for (int i = 0; i < 8; ++i) { const int kk = 8 * i + (lane >> 3); const float sc = kscale ? kscale[k0 + kk] : 1.0f; LAS float* d = scr + kk * 33 + n4;
          d[0] = v[i].x * sc; d[1] = v[i].y * sc; d[2] = v[i].z * sc; d[3] = v[i].w * sc; } }
    LDS_WAIT(); asm volatile("" ::: "memory");
    const int cc = lane & 7;
#pragma unroll
    for (int j = 0; j < 4; ++j) { const int nl = (lane >> 3) + 8 * j, n = n0 + nl; const LAS float* s = scr + (8 * cc) * 33 + nl;
        v4u o; o.x = pk2(s[0 * 33], s[1 * 33]); o.y = pk2(s[2 * 33], s[3 * 33]); o.z = pk2(s[4 * 33], s[5 * 33]); o.w = pk2(s[6 * 33], s[7 * 33]);
        if (n < N) *(GAS v4u*)(WT + (size_t)map_row(mapid, n, row_off) * K + k0 + 8 * cc) = o; }
    LDS_WAIT(); asm volatile("" ::: "memory");
}
__device__ __forceinline__ void p0_prologue(Ctx& c, const Args& a) {
    LAS float* scr = (LAS float*)(c.lds + RING_OFF + c.wave * 16384);
    const int gw = c.vcu * NWAVES + c.wave, NGW = c.G * NWAVES, lane = c.lane;
    unsigned char* ws = a.ws;
    constexpr int I_INH = 16 * 104, I_MKV = 16 * 16, I_DSA = 16 * 67, I_OUT = 16 * 32, I_G = 16 * 88, I_D = 44 * 32;
    constexpr int NITEMS = I_INH + 2 * I_MKV + I_DSA + 2 * I_OUT + 4 * I_G + 2 * I_D;
    for (int it = gw; it < NITEMS; it += NGW) {
        int r = it;
        if (r < I_INH) { transpose_item(a.in[13], 1024, 3328, a.in[11], (bf16*)(ws + WS_WIN0), 0, 0, scr, r, lane); continue; } r -= I_INH;
        if (r < I_MKV) { transpose_item(a.in[20], 1024, 512, nullptr, (bf16*)(ws + WS_WIN0), 0, 3328, scr, r, lane); continue; } r -= I_MKV;
        if (r < I_MKV) { transpose_item(a.in[20] + 1024 * 512, 1024, 512, nullptr, (bf16*)(ws + WS_WIN0), 0, 3840, scr, r, lane); continue; } r -= I_MKV;
        if (r < I_DSA) { transpose_item(a.in[16], 1024, 2120, a.in[11] + 1024, (bf16*)(ws + WS_WIN1), 1, 0, scr, r, lane); continue; } r -= I_DSA;
        if (r < 2 * I_OUT) { const int l = r / I_OUT; transpose_item(a.in[23] + (size_t)l * 1024 * 1024, 1024, 1024, nullptr, (bf16*)(ws + WS_WOUT) + (size_t)l * 1024 * 1024, 0, 0, scr, r % I_OUT, lane); continue; } r -= 2 * I_OUT;
        if (r < 2 * I_G) { const int l = r / I_G; transpose_item(a.in[24] + (size_t)l * 1024 * DFF, 1024, DFF, a.in[12] + l * 1024, (bf16*)(ws + WS_WGU) + (size_t)l * 5632 * 1024, 2, 0, scr, r % I_G, lane); continue; } r -= 2 * I_G;
        if (r < 2 * I_G) { const int l = r / I_G; transpose_item(a.in[25] + (size_t)l * 1024 * DFF, 1024, DFF, a.in[12] + l * 1024, (bf16*)(ws + WS_WGU) + (size_t)l * 5632 * 1024, 3, 0, scr, r % I_G, lane); continue; } r -= 2 * I_G;
        { const int l = r / I_D; transpose_item(a.in[28] + (size_t)l * DFF * 1024, DFF, 1024, nullptr, (bf16*)(ws + WS_WD) + (size_t)l * 1024 * DFF, 0, 0, scr, r % I_D, lane); }
    }
    for (int rr = gw; rr < 184; rr += NGW) { const int row = rr < 56 ? 1864 + rr : 2176 + (rr - 56);
        GAS v4u* p = (GAS v4u*)((bf16*)(ws + WS_WIN1) + (size_t)row * 1024); p[lane] = (v4u){0u, 0u, 0u, 0u}; p[64 + lane] = (v4u){0u, 0u, 0u, 0u}; }
    float* ss0 = ssptr(c, 0);
    for (int m = gw; m < MT + NMEMROWS; m += NGW) {
        GAS u64* o8 = (GAS u64*)((bf16*)(ws + WS_XB) + (size_t)m * DM) + lane;
        if (m >= MVALID && m < MT) {
#pragma unroll
            for (int j = 0; j < 4; ++j) o8[64 * j] = 0ull;
            continue; }
        const float* src = m < MP ? a.in[0] + (size_t)m * DM : (m < MVALID ? a.in[1] + (size_t)(m - MP) * DM : a.in[10] + (size_t)(m - MT) * DM);
        const GAS f32x4* xr = (const GAS f32x4*)src + lane; f32x4 v[4]; float s = 0.f;
#pragma unroll
        for (int j = 0; j < 4; ++j) { v[j] = xr[64 * j]; s += (v[j].x * v[j].x + v[j].y * v[j].y) + (v[j].z * v[j].z + v[j].w * v[j].w); }
        s = wave_sum(s);
#pragma unroll
        for (int j = 0; j < 4; ++j) o8[64 * j] = (u64)pk2(v[j].x, v[j].y) | ((u64)pk2(v[j].z, v[j].w) << 32);
        if (m < MVALID && lane == 0) ss0[m] = s;
    }
}

__device__ __forceinline__ void memattn_unit(Ctx& c, const bf16* Zq  , int ldz, int nrows_valid, const float* Kp, const float* Vp, int kstride,
                                             bool normk, const float* kgain, const float* qgain, bf16* Out  ) {
    LAS bf16* KN = (LAS bf16*)(c.lds);
    LAS bf16* VTm = (LAS bf16*)(c.lds + 36864);
    LAS bf16* QN = (LAS bf16*)(c.lds + 70656) + c.wave * (32 * 72);
    LAS float* LI = (LAS float*)(c.lds + 107520) + c.wave * 32;
    int tid = c.tid; asm volatile("" : "+v"(tid));
    const int lane = tid & 63, w = c.wave;
    {
        const int m = tid >> 1, dh = (tid & 1) * 32;
        f32x4 kv[8]; float s = 0.f;
#pragma unroll
        for (int j = 0; j < 8; ++j) { kv[j] = *(const f32x4*)(Kp + (size_t)m * kstride + dh + 4 * j); s += (kv[j].x * kv[j].x + kv[j].y * kv[j].y) + (kv[j].z * kv[j].z + kv[j].w * kv[j].w); }
        s += __shfl_xor(s, 1);
        const float rs = normk ? rsqrtf(s * (1.0f / 64.0f) + EPS) : 1.0f;
#pragma unroll
        for (int j = 0; j < 8; j += 2) { f32x4 g0 = {1.f, 1.f, 1.f, 1.f}, g1 = g0;
            if (normk) { g0 = *(const f32x4*)(kgain + dh + 4 * j); g1 = *(const f32x4*)(kgain + dh + 4 * j + 4); }
            const f32x4 x0 = kv[j] * rs * g0, x1 = kv[j + 1] * rs * g1;
            v4u o; o.x = pk2(x0.x, x0.y); o.y = pk2(x0.z, x0.w); o.z = pk2(x1.x, x1.y); o.w = pk2(x1.z, x1.w);
            *(LAS v4u*)(KN + m * 72 + dh + 4 * j) = o; }
#pragma unroll
        for (int j = 0; j < 8; ++j) { const f32x4 vv = *(const f32x4*)(Vp + (size_t)m * kstride + dh + 4 * j);
            VTm[(dh + 4 * j + 0) * 264 + m] = (bf16)f2bf(vv.x); VTm[(dh + 4 * j + 1) * 264 + m] = (bf16)f2bf(vv.y);
            VTm[(dh + 4 * j + 2) * 264 + m] = (bf16)f2bf(vv.z); VTm[(dh + 4 * j + 3) * 264 + m] = (bf16)f2bf(vv.w); }
    }
    {
        const int row = lane >> 1, hf = lane & 1, grow = w * 32 + row;
        float x[32]; float s = 0.f;
        if (grow < nrows_valid) {
#pragma unroll
            for (int j = 0; j < 4; ++j) { const v4u q = *(const v4u*)(Zq + (size_t)grow * ldz + hf * 32 + 8 * j);
                x[8 * j + 0] = bf2f(q.x & 0xffffu); x[8 * j + 1] = bf2f(q.x >> 16); x[8 * j + 2] = bf2f(q.y & 0xffffu); x[8 * j + 3] = bf2f(q.y >> 16);
                x[8 * j + 4] = bf2f(q.z & 0xffffu); x[8 * j + 5] = bf2f(q.z >> 16); x[8 * j + 6] = bf2f(q.w & 0xffffu); x[8 * j + 7] = bf2f(q.w >> 16); }
        } else {
#pragma unroll
            for (int j = 0; j < 32; ++j) x[j] = 0.f;
        }
#pragma unroll
        for (int j = 0; j < 32; ++j) s += x[j] * x[j];
        s += __shfl_xor(s, 1);
        const float rs = rsqrtf(s * (1.0f / 64.0f) + EPS) * 0.125f;
#pragma unroll
        for (int j = 0; j < 32; j += 8) { v4u o;
            o.x = pk2(x[j] * rs * qgain[hf * 32 + j], x[j + 1] * rs * qgain[hf * 32 + j + 1]); o.y = pk2(x[j + 2] * rs * qgain[hf * 32 + j + 2], x[j + 3] * rs * qgain[hf * 32 + j + 3]);
            o.z = pk2(x[j + 4] * rs * qgain[hf * 32 + j + 4], x[j + 5] * rs * qgain[hf * 32 + j + 5]); o.w = pk2(x[j + 6] * rs * qgain[hf * 32 + j + 6], x[j + 7] * rs * qgain[hf * 32 + j + 7]);
            *(LAS v4u*)(QN + row * 72 + hf * 32 + j) = o; }
    }
    __syncthreads();
    if (w * 32 < nrows_valid) {
        const int r32 = lane & 31, hh = lane >> 5;
        f32x16 s[8];
#pragma unroll
        for (int mt = 0; mt < 8; ++mt) { f32x16 z = {}; s[mt] = mm32<64>(KN + mt * 32 * 72, 72, QN, 72, z, lane); }
        float mx = -1e30f;
#pragma unroll
        for (int mt = 0; mt < 8; ++mt)
#pragma unroll
            for (int r = 0; r < 16; ++r) mx = fmaxf(mx, s[mt][r]);
        mx = fmaxf(mx, __shfl_xor(mx, 32));
        float l = 0.f;
#pragma unroll
        for (int mt = 0; mt < 8; ++mt)
#pragma unroll
            for (int r = 0; r < 16; ++r) { const float p = __expf(s[mt][r] - mx); s[mt][r] = p; l += p; }
        l += __shfl_xor(l, 32);
        if (hh == 0) LI[r32] = l;
        f32x16 o[2] = {};
#pragma unroll
        for (int mt = 0; mt < 8; ++mt)
#pragma unroll
            for (int sx = 0; sx < 2; ++sx) {
                v4u pa; pa.x = pk2(s[mt][8 * sx + 0], s[mt][8 * sx + 1]); pa.y = pk2(s[mt][8 * sx + 2], s[mt][8 * sx + 3]);
                pa.z = pk2(s[mt][8 * sx + 4], s[mt][8 * sx + 5]); pa.w = pk2(s[mt][8 * sx + 6], s[mt][8 * sx + 7]);
                const bf16x8 af = __builtin_bit_cast(bf16x8, pa);
#pragma unroll
                for (int dt = 0; dt < 2; ++dt) { const LAS bf16* vp = VTm + (dt * 32 + r32) * 264 + mt * 32 + 16 * sx + 4 * hh;
                    const u64 lo = *(const LAS u64*)vp, hi = *(const LAS u64*)(vp + 8);
                    v4u bw; bw.x = (unsigned)lo; bw.y = (unsigned)(lo >> 32); bw.z = (unsigned)hi; bw.w = (unsigned)(hi >> 32);
                    o[dt] = __builtin_amdgcn_mfma_f32_32x32x16_bf16(af, __builtin_bit_cast(bf16x8, bw), o[dt], 0, 0, 0); }
            }
        LDS_WAIT();
#pragma unroll
        for (int r = 0; r < 16; ++r) { const int qr = crow(r, hh), grow = w * 32 + qr; const float il = 1.0f / LI[qr];
            if (grow < nrows_valid) {
#pragma unroll
                for (int dt = 0; dt < 2; ++dt) Out[(size_t)grow * DM + dt * 32 + r32] = (bf16)f2bf(o[dt][r] * il); } }
    }
}

constexpr int HG_GS = 4, HG_NG = SEQ / (32 * HG_GS);
constexpr size_t WS_HOL = WS_U, WS_HQC = WS_UP, WS_HUT = WS_ACT, WS_HST = WS_ACT + 64 * MiB, WS_HDG = WS_ACT + 50 * MiB;
template <bool PROMPT>
__device__ __forceinline__ void hgrn_unit(Ctx& c, const Args& a, int b, int h, int g) {
    LAS unsigned char* L = c.lds;
    LAS float* LF = (LAS float*)(L + 0);
    LAS float* BL = (LAS float*)(L + 16384);
    LAS float* DVv = (LAS float*)(L + 16896);
    LAS bf16* QD = (LAS bf16*)(L + 17408);
    LAS bf16* KD = (LAS bf16*)(L + 26112);
    LAS bf16* KET = (LAS bf16*)(L + 34816);
    LAS bf16* VT = (LAS bf16*)(L + 45056);
    LAS bf16* SCB = (LAS bf16*)(L + 55296);
    LAS bf16* STt = (LAS bf16*)(L + 57856);
    LAS float* BOFF = (LAS float*)(L + 92672);
    int tid = c.tid; asm volatile("" : "+v"(tid));
    const int lane = tid & 63, w = c.wave, r32 = lane & 31, hh = lane >> 5;
    const int te = tid >> 4, k8 = (tid & 15) * 8;
    const bf16* Z = (const bf16*)(a.ws + WS_Z);
    bf16* MIX = (bf16*)(a.ws + WS_MIX);
    const int nch = PROMPT ? HG_GS : 1, nvalid = PROMPT ? 32 : 4;
    const int kt = w >> 1, vt0 = 2 * (w & 1);
    const int unit = (b * 6 + h) * HG_NG + g;
    f32x16 S0 = {}, S1 = {};
    if (!PROMPT) { const float* sp = a.in[7] + (size_t)(b * 6 + h) * 16384;
#pragma unroll
        for (int r = 0; r < 16; ++r) { const int k = 32 * kt + crow(r, hh); S0[r] = sp[k * 128 + 32 * vt0 + r32]; S1[r] = sp[k * 128 + 32 * (vt0 + 1) + r32]; } }
    float lbv[8], onv[8];
#pragma unroll
    for (int j = 0; j < 8; ++j) { const float l0 = a.in[14][h * 128 + k8 + j], l1 = a.in[14][768 + h * 128 + k8 + j]; lbv[j] = 1.0f / (1.0f + __expf(l1 - l0)); onv[j] = a.in[15][k8 + j]; }
    __syncthreads();
    if (tid < 128) BOFF[tid] = 0.f;
#define HG_WRITE_ST() do { _Pragma("unroll") for (int g4 = 0; g4 < 4; ++g4) { const int k0 = 32 * kt + 8 * g4 + 4 * hh; \
        *(LAS u64*)(STt + (32 * vt0 + r32) * 136 + k0) = (u64)pk2(S0[4 * g4], S0[4 * g4 + 1]) | ((u64)pk2(S0[4 * g4 + 2], S0[4 * g4 + 3]) << 32); \
        *(LAS u64*)(STt + (32 * (vt0 + 1) + r32) * 136 + k0) = (u64)pk2(S1[4 * g4], S1[4 * g4 + 1]) | ((u64)pk2(S1[4 * g4 + 2], S1[4 * g4 + 3]) << 32); } } while (0)
    HG_WRITE_ST();
#pragma unroll 1
    for (int ch = 0; ch < nch; ++ch) {
        const int row0 = PROMPT ? b * SEQ + (g * HG_GS + ch) * 32 : MP + 4 * b, row = row0 + te;
        const bool valid = te < nvalid;
        float qs[8], kk[8]; v4u gz = {0u, 0u, 0u, 0u};
        {
            v4u zq = {0u, 0u, 0u, 0u}, zf = zq, zi = zq;
            if (valid) { const bf16* zr = Z + (size_t)row * ZC0 + h * 128 + k8;
                zq = *(const v4u*)zr; zf = *(const v4u*)(zr + 768); zi = *(const v4u*)(zr + 1536); if (!PROMPT) gz = *(const v4u*)(zr + 2304); }
            const unsigned qw[4] = {zq.x, zq.y, zq.z, zq.w}, fw[4] = {zf.x, zf.y, zf.z, zf.w}, iw[4] = {zi.x, zi.y, zi.z, zi.w};
            float lf[8];
#pragma unroll
            for (int j = 0; j < 8; ++j) { const float q = bf2f((qw[j >> 1] >> (16 * (j & 1))) & 0xffffu), fp = bf2f((fw[j >> 1] >> (16 * (j & 1))) & 0xffffu);
                const float sg = sigmoidf_(fp), f = lbv[j] + (1.0f - lbv[j]) * sg;
                qs[j] = valid ? q * sigmoidf_(q) : 0.f; kk[j] = valid ? (1.0f - f) : 0.f; lf[j] = valid ? __logf(f) : 0.f;
                VT[(k8 + j) * 40 + te] = (bf16)((iw[j >> 1] >> (16 * (j & 1))) & 0xffffu); }
            *(LAS f32x4*)(LF + te * 128 + k8) = (f32x4){lf[0], lf[1], lf[2], lf[3]}; *(LAS f32x4*)(LF + te * 128 + k8 + 4) = (f32x4){lf[4], lf[5], lf[6], lf[7]};
        }
        __syncthreads();
        if (tid < 128) { float bsum = 0.f;
#pragma unroll
            for (int t = 0; t < 32; ++t) { bsum += LF[t * 128 + tid]; LF[t * 128 + tid] = bsum; }
            BL[tid] = bsum; }
        __syncthreads();
        {
            const f32x4 b0 = *(const LAS f32x4*)(LF + te * 128 + k8), b1 = *(const LAS f32x4*)(LF + te * 128 + k8 + 4);
            const f32x4 l0 = *(const LAS f32x4*)(BL + k8), l1 = *(const LAS f32x4*)(BL + k8 + 4);
            const float bb[8] = {b0.x, b0.y, b0.z, b0.w, b1.x, b1.y, b1.z, b1.w}, bl[8] = {l0.x, l0.y, l0.z, l0.w, l1.x, l1.y, l1.z, l1.w};
            float qd[8], kd[8];
#pragma unroll
            for (int j = 0; j < 8; ++j) { qd[j] = qs[j] * __expf(bb[j]); kd[j] = kk[j] * __expf(-bb[j]); KET[(k8 + j) * 40 + te] = (bf16)f2bf(kk[j] * __expf(bl[j] - bb[j])); }
            v4u o; o.x = pk2(qd[0], qd[1]); o.y = pk2(qd[2], qd[3]); o.z = pk2(qd[4], qd[5]); o.w = pk2(qd[6], qd[7]); *(LAS v4u*)(QD + te * 136 + k8) = o;
            if (PROMPT) { const f32x4 f0 = *(const LAS f32x4*)(BOFF + k8), f1 = *(const LAS f32x4*)(BOFF + k8 + 4);
                const float bo[8] = {f0.x, f0.y, f0.z, f0.w, f1.x, f1.y, f1.z, f1.w}; float qc[8];
#pragma unroll
                for (int j = 0; j < 8; ++j) qc[j] = qd[j] * __expf(bo[j]);
                v4u oc; oc.x = pk2(qc[0], qc[1]); oc.y = pk2(qc[2], qc[3]); oc.z = pk2(qc[4], qc[5]); oc.w = pk2(qc[6], qc[7]);
                *(v4u*)((bf16*)(a.ws + WS_HQC) + (size_t)row * 768 + h * 128 + k8) = oc; }
            o.x = pk2(kd[0], kd[1]); o.y = pk2(kd[2], kd[3]); o.z = pk2(kd[4], kd[5]); o.w = pk2(kd[6], kd[7]); *(LAS v4u*)(KD + te * 136 + k8) = o;
            if (te == 0) {
#pragma unroll
                for (int j = 0; j < 8; ++j) DVv[k8 + j] = __expf(bl[j]); }
        }
        __syncthreads();
        f32x16 oacc = {};
        if (w == 0) { f32x16 z = {}; const f32x16 sc = mm32<128>(QD, 136, KD, 136, z, lane);
#pragma unroll
            for (int r = 0; r < 16; ++r) { const int t = crow(r, hh); SCB[t * 40 + r32] = (bf16)f2bf(r32 <= t ? sc[r] : 0.f); } }
        if (w < 4) oacc = mm32<128>(QD, 136, STt + (w * 32) * 136, 136, oacc, lane);
        if (PROMPT && tid >= 384) BOFF[tid - 384] += BL[tid - 384];
        __syncthreads();
        if (w < 4) { oacc = mm32<32>(SCB, 40, VT + (w * 32) * 40, 40, oacc, lane);
#pragma unroll
            for (int r = 0; r < 16; ++r) LF[crow(r, hh) * 128 + w * 32 + r32] = oacc[r]; }
        {
#pragma unroll
            for (int r = 0; r < 16; ++r) { const float d = DVv[32 * kt + crow(r, hh)]; S0[r] *= d; S1[r] *= d; }
            S0 = mm32<32>(KET + (kt * 32) * 40, 40, VT + (vt0 * 32) * 40, 40, S0, lane);
            S1 = mm32<32>(KET + (kt * 32) * 40, 40, VT + ((vt0 + 1) * 32) * 40, 40, S1, lane);
        }
        __syncthreads();
        HG_WRITE_ST();
        {
            const f32x4 o0 = *(const LAS f32x4*)(LF + te * 128 + k8), o1 = *(const LAS f32x4*)(LF + te * 128 + k8 + 4);
            if (PROMPT) { float* ol = (float*)(a.ws + WS_HOL) + (size_t)row * 768 + h * 128 + k8; *(f32x4*)ol = o0; *(f32x4*)(ol + 4) = o1; }
            else {
                float ov[8] = {o0.x, o0.y, o0.z, o0.w, o1.x, o1.y, o1.z, o1.w}; float s = 0.f;
#pragma unroll
                for (int j = 0; j < 8; ++j) s += ov[j] * ov[j];
                s += __shfl_xor(s, 1); s += __shfl_xor(s, 2); s += __shfl_xor(s, 4); s += __shfl_xor(s, 8);
                const float rs = rsqrtf(s * (1.0f / 128.0f) + EPS);
                const unsigned gw_[4] = {gz.x, gz.y, gz.z, gz.w}; float y[8];
#pragma unroll
                for (int j = 0; j < 8; ++j) { const float gg = bf2f((gw_[j >> 1] >> (16 * (j & 1))) & 0xffffu); y[j] = ov[j] * rs * onv[j] * (gg * sigmoidf_(gg)); }
                if (valid) { v4u o; o.x = pk2(y[0], y[1]); o.y = pk2(y[2], y[3]); o.z = pk2(y[4], y[5]); o.w = pk2(y[6], y[7]); *(v4u*)(MIX + (size_t)row * DM + h * 128 + k8) = o; }
            }
        }
        __syncthreads();
    }
#undef HG_WRITE_ST
    if (PROMPT) {
        float* ut = (float*)(a.ws + WS_HUT) + (size_t)unit * 16384;
#pragma unroll
        for (int g4 = 0; g4 < 4; ++g4) { const int k0 = 32 * kt + 8 * g4 + 4 * hh;
            *(f32x4*)(ut + (32 * vt0 + r32) * 128 + k0) = (f32x4){S0[4 * g4], S0[4 * g4 + 1], S0[4 * g4 + 2], S0[4 * g4 + 3]};
            *(f32x4*)(ut + (32 * (vt0 + 1) + r32) * 128 + k0) = (f32x4){S1[4 * g4], S1[4 * g4 + 1], S1[4 * g4 + 2], S1[4 * g4 + 3]}; }
        if (tid < 128) ((float*)(a.ws + WS_HDG))[(size_t)unit * 128 + tid] = __expf(BOFF[tid]);
    } else {
        float* so = a.out + O_HS + (size_t)(b * 6 + h) * 16384;
#pragma unroll
        for (int r = 0; r < 16; ++r) { const int k = 32 * kt + crow(r, hh); so[k * 128 + 32 * vt0 + r32] = S0[r]; so[k * 128 + 32 * (vt0 + 1) + r32] = S1[r]; }
    }
}
__device__ __forceinline__ void hgrn_scan(Ctx& c, const Args& a) {
    const float* UT = (const float*)(a.ws + WS_HUT); const float* DG = (const float*)(a.ws + WS_HDG); bf16* STo = (bf16*)(a.ws + WS_HST);
    for (int idx = c.vcu * 512 + c.tid; idx < 24 * 16384; idx += c.G * 512) {
        const int bh = idx >> 14, e = idx & 16383, k = e & 127, v = e >> 7;
        float s = 0.f;
#pragma unroll 8
        for (int g = 0; g < HG_NG; ++g) { const size_t u = (size_t)(bh * HG_NG + g); STo[u * 16384 + e] = (bf16)f2bf(s); s = DG[u * 128 + k] * s + UT[u * 16384 + e]; }
        a.out[O_HP + (size_t)bh * 16384 + k * 128 + v] = s;
    }
}
__device__ __forceinline__ void hgrn_fix_unit(Ctx& c, const Args& a, int b, int h, int g) {
    LAS bf16* STt = (LAS bf16*)(c.lds);
    LAS bf16* QCl = (LAS bf16*)(c.lds + 34816);
    LAS float* OB = (LAS float*)(c.lds + 34816 + 17408);
    int tid = c.tid; asm volatile("" : "+v"(tid));
    const int lane = tid & 63, w = c.wave, r32 = lane & 31, hh = lane >> 5;
    const int unit = (b * 6 + h) * HG_NG + g, row0 = b * SEQ + g * 128;
    const bf16* Z = (const bf16*)(a.ws + WS_Z); bf16* MIX = (bf16*)(a.ws + WS_MIX);
    const bf16* QC = (const bf16*)(a.ws + WS_HQC); const float* OL = (const float*)(a.ws + WS_HOL);
    const bf16* stg = (const bf16*)(a.ws + WS_HST) + (size_t)unit * 16384;
    __syncthreads();
#pragma unroll
    for (int i = 0; i < 4; ++i) { const int cidx = tid + 512 * i, v = cidx >> 4, kc = (cidx & 15) * 8; *(LAS v4u*)(STt + v * 136 + kc) = *(const v4u*)(stg + v * 128 + kc); }
    const int te = tid >> 4, k8 = (tid & 15) * 8;
    float onv[8];
#pragma unroll
    for (int j = 0; j < 8; ++j) onv[j] = a.in[15][k8 + j];
#pragma unroll 1
    for (int hf = 0; hf < 2; ++hf) {
        const int rb = row0 + hf * 64;
#pragma unroll
        for (int i = 0; i < 2; ++i) { const int cidx = tid + 512 * i, r = cidx >> 4, kc = (cidx & 15) * 8; *(LAS v4u*)(QCl + r * 136 + kc) = *(const v4u*)(QC + (size_t)(rb + r) * 768 + h * 128 + kc); }
        __syncthreads();
        { const int rt = w >> 2, vt = w & 3; f32x16 o = {};
          o = mm32<128>(QCl + (rt * 32) * 136, 136, STt + (vt * 32) * 136, 136, o, lane);
#pragma unroll
          for (int r = 0; r < 16; ++r) OB[(rt * 32 + crow(r, hh)) * 128 + vt * 32 + r32] = o[r]; }
        __syncthreads();
#pragma unroll
        for (int ps = 0; ps < 2; ++ps) { const int r = ps * 32 + te, row = rb + r;
            const f32x4 c0 = *(const LAS f32x4*)(OB + r * 128 + k8), c1 = *(const LAS f32x4*)(OB + r * 128 + k8 + 4);
            const float* ol = OL + (size_t)row * 768 + h * 128 + k8; const f32x4 l0 = *(const f32x4*)ol, l1 = *(const f32x4*)(ol + 4);
            const v4u gz = *(const v4u*)(Z + (size_t)row * ZC0 + 2304 + h * 128 + k8);
            float ov[8] = {c0.x + l0.x, c0.y + l0.y, c0.z + l0.z, c0.w + l0.w, c1.x + l1.x, c1.y + l1.y, c1.z + l1.z, c1.w + l1.w}; float s = 0.f;
#pragma unroll
            for (int j = 0; j < 8; ++j) s += ov[j] * ov[j];
            s += __shfl_xor(s, 1); s += __shfl_xor(s, 2); s += __shfl_xor(s, 4); s += __shfl_xor(s, 8);
            const float rs = rsqrtf(s * (1.0f / 128.0f) + EPS);
            const unsigned gw_[4] = {gz.x, gz.y, gz.z, gz.w}; float y[8];
#pragma unroll
            for (int j = 0; j < 8; ++j) { const float gg = bf2f((gw_[j >> 1] >> (16 * (j & 1))) & 0xffffu); y[j] = ov[j] * rs * onv[j] * (gg * sigmoidf_(gg)); }
            v4u o; o.x = pk2(y[0], y[1]); o.y = pk2(y[2], y[3]); o.z = pk2(y[4], y[5]); o.w = pk2(y[6], y[7]); *(v4u*)(MIX + (size_t)row * DM + h * 128 + k8) = o; }
        __syncthreads();
    }
}

__device__ __forceinline__ void memkv_finalize_row(const Args& a, int layer, int row, int lane) {
    const float* src = (const float*)(a.ws + WS_MEMKV) + (size_t)row * 1024 + layer * 512;
    const int hd = lane >> 4, d4 = (lane & 15) * 4;
    const f32x4 k = *(const f32x4*)(src + hd * 64 + d4), v = *(const f32x4*)(src + 256 + hd * 64 + d4);
    float s = (k.x * k.x + k.y * k.y) + (k.z * k.z + k.w * k.w);
    s += __shfl_xor(s, 1); s += __shfl_xor(s, 2); s += __shfl_xor(s, 4); s += __shfl_xor(s, 8);
    const float rs = rsqrtf(s * (1.0f / 64.0f) + EPS); const f32x4 g = *(const f32x4*)(a.in[22] + layer * 64 + d4);
    *(f32x4*)(a.out + O_MK + ((size_t)layer * 1024 + row) * 256 + hd * 64 + d4) = k * rs * g;
    *(f32x4*)(a.out + O_MV + ((size_t)layer * 1024 + row) * 256 + hd * 64 + d4) = v;
}

__device__ __forceinline__ void memattn_prompt_unit(Ctx& c, const Args& a, int layer, int u) {
    const int blk = u & 15, hd = (u >> 4) & 3, b = u >> 6;
    const bf16* Z = (const bf16*)(a.ws + WS_Z); const int ldz = layer ? ZC1 : ZC0, qc = layer ? Z1_MQ : 3072;
    const float* kv = (const float*)(a.ws + WS_MEMKV) + (size_t)(b * 256) * 1024 + layer * 512 + hd * 64;
    const int row0 = b * SEQ + blk * 256;
    memattn_unit(c, Z + (size_t)row0 * ldz + qc + hd * 64, ldz, 256, kv, kv + 256, 1024, true, a.in[22] + layer * 64, a.in[21] + layer * 64,
                 (bf16*)(a.ws + WS_MIX) + (size_t)row0 * DM + 768 + hd * 64);
}
__device__ __forceinline__ void memattn_sample_unit(Ctx& c, const Args& a, int layer, int u) {
    const int hd = u & 3, sb = u >> 2;
    const bf16* Z = (const bf16*)(a.ws + WS_Z); const int ldz = layer ? ZC1 : ZC0, qc = layer ? Z1_MQ : 3072;
    const size_t off = ((size_t)(layer * 32 + sb) * 256) * 256 + hd * 64;
    const int row0 = MP + sb * 4;
    memattn_unit(c, Z + (size_t)row0 * ldz + qc + hd * 64, ldz, 4, a.in[5] + off, a.in[6] + off, 256, false, nullptr, a.in[21] + layer * 64,
                 (bf16*)(a.ws + WS_MIX) + (size_t)row0 * DM + 768 + hd * 64);
}

__device__ __forceinline__ void p2_mixer0(Ctx& c, const Args& a) {
    constexpr int U_HP = 24 * HG_NG, U_MAP = U_HP + 256, U_HS = U_MAP + 192, U_MAS = U_HS + 128, U_FIN = U_MAS + 256;
    for (;;) {
        const int u = q_next(c, 0);
        if (u >= U_FIN) break;
        if (u < U_HP) hgrn_unit<true>(c, a, u / (6 * HG_NG), (u / HG_NG) % 6, u % HG_NG);
        else if (u < U_MAP) memattn_prompt_unit(c, a, 0, u - U_HP);
        else if (u < U_HS) { const int v = u - U_MAP; hgrn_unit<false>(c, a, v / 6, v % 6, 0); }
        else if (u < U_MAS) memattn_sample_unit(c, a, 0, u - U_HS);
        else { const int v = (u - U_MAS) * 8 + c.wave; memkv_finalize_row(a, v >> 10, v & 1023, c.lane); }
    }
}
__device__ __forceinline__ void p2c_hgrn_fix(Ctx& c, const Args& a) {
    for (int u = c.vcu; u < 24 * HG_NG; u += c.G) hgrn_fix_unit(c, a, u / (6 * HG_NG), (u / HG_NG) % 6, u % HG_NG);
}

__device__ __forceinline__ void p5_convact(Ctx& c, const Args& a, int layer) {
    const bf16* U = (const bf16*)(a.ws + WS_U); const bf16* UP = (const bf16*)(a.ws + WS_UP); bf16* ACT = (bf16*)(a.ws + WS_ACT);
    const float* cw = a.in[26] + (size_t)layer * 3 * DFF; const float* cb = a.in[27] + (size_t)layer * DFF; const float* cst = a.in[8] + (size_t)layer * 32 * 2 * DFF;
    constexpr int CPR = DFF / 8, NG = MVALID / 4;
    const int total = NG * CPR;
#pragma unroll 1
    for (int i = c.vcu * 512 + c.tid; i < total; i += c.G * 512) {
        const int g = i / CPR, c8 = (i - g * CPR) * 8, r0 = g * 4;
        const bool smp = r0 >= MP; const bool first = smp || (r0 & 4095) == 0;
        const int rm2 = first ? r0 : r0 - 2, rm1 = first ? r0 : r0 - 1;
        v4u ur[6], pr[4];
        ur[0] = *(const v4u*)(U + (size_t)rm2 * DFF + c8); ur[1] = *(const v4u*)(U + (size_t)rm1 * DFF + c8);
#pragma unroll
        for (int k = 0; k < 4; ++k) { ur[2 + k] = *(const v4u*)(U + (size_t)(r0 + k) * DFF + c8); pr[k] = *(const v4u*)(UP + (size_t)(r0 + k) * DFF + c8); }
        const f32x4 w0a = *(const f32x4*)(cw + c8), w0b = *(const f32x4*)(cw + c8 + 4), w1a = *(const f32x4*)(cw + DFF + c8), w1b = *(const f32x4*)(cw + DFF + c8 + 4),
                    w2a = *(const f32x4*)(cw + 2 * DFF + c8), w2b = *(const f32x4*)(cw + 2 * DFF + c8 + 4), cba = *(const f32x4*)(cb + c8), cbb = *(const f32x4*)(cb + c8 + 4);
        const float w0[8] = {w0a.x, w0a.y, w0a.z, w0a.w, w0b.x, w0b.y, w0b.z, w0b.w}, w1[8] = {w1a.x, w1a.y, w1a.z, w1a.w, w1b.x, w1b.y, w1b.z, w1b.w},
                    w2[8] = {w2a.x, w2a.y, w2a.z, w2a.w, w2b.x, w2b.y, w2b.z, w2b.w}, bb[8] = {cba.x, cba.y, cba.z, cba.w, cbb.x, cbb.y, cbb.z, cbb.w};
        float uf[6][8];
#pragma unroll
        for (int k = 0; k < 6; ++k) { const unsigned xw[4] = {ur[k].x, ur[k].y, ur[k].z, ur[k].w};
#pragma unroll
            for (int j = 0; j < 8; ++j) uf[k][j] = bf2f((xw[j >> 1] >> (16 * (j & 1))) & 0xffffu); }
        if (first) {
            if (smp) { const float* s0 = cst + (size_t)(((r0 - MP) >> 2) * 2) * DFF + c8;
#pragma unroll
                for (int j = 0; j < 8; ++j) { uf[0][j] = s0[j]; uf[1][j] = s0[DFF + j]; } }
            else {
#pragma unroll
                for (int j = 0; j < 8; ++j) { uf[0][j] = 0.f; uf[1][j] = 0.f; } }
        }
#pragma unroll
        for (int k = 0; k < 4; ++k) { const unsigned pw[4] = {pr[k].x, pr[k].y, pr[k].z, pr[k].w}; float y[8];
#pragma unroll
            for (int j = 0; j < 8; ++j) { const float cv = bb[j] + w0[j] * uf[k][j] + w1[j] * uf[k + 1][j] + w2[j] * uf[k + 2][j]; y[j] = cv * sigmoidf_(cv) * bf2f((pw[j >> 1] >> (16 * (j & 1))) & 0xffffu); }
            v4u o; o.x = pk2(y[0], y[1]); o.y = pk2(y[2], y[3]); o.z = pk2(y[4], y[5]); o.w = pk2(y[6], y[7]);
            *(v4u*)(ACT + (size_t)(r0 + k) * DFF + c8) = o; }
    }
    for (int i = c.vcu * 512 + c.tid; i < (MT - MVALID) * CPR; i += c.G * 512)
        *(v4u*)(ACT + (size_t)(MVALID + i / CPR) * DFF + (i % CPR) * 8) = (v4u){0u, 0u, 0u, 0u};
}


struct SgArgs { const bf16* A; const bf16* Bt; int K; int mode; bf16* Z; int ldz; const float* ssin; const float* resid; float* y; bf16* xb; float* ssout; bf16* U; bf16* UP; float* cvs; };
__device__ __forceinline__ void sgemm_unit(Ctx& c, const SgArgs& g, int n0) {
    int tid = c.tid; asm volatile("" : "+v"(tid));
    const int lane = tid & 63, w = c.wave, r32 = lane & 31, hh = lane >> 5;
    const int K = g.K, ks = K >> 3;
    const bf16* bp = g.Bt + (size_t)(n0 + r32) * K + w * ks + 8 * hh;
    const bf16* ap = g.A + (size_t)r32 * K + w * ks + 8 * hh;
    f32x16 acc[4] = {};
    bf16x8 afA[4][2], bfA[2], afB[4][2], bfB[2];
#define SG_LOAD(AF, BF, kk) do { _Pragma("unroll") for (int i = 0; i < 2; ++i) { BF[i] = *(const bf16x8*)(bp + (kk) + 16 * i); \
        _Pragma("unroll") for (int rt = 0; rt < 4; ++rt) AF[rt][i] = *(const bf16x8*)(ap + (size_t)(rt * 32) * K + (kk) + 16 * i); } } while (0)
#define SG_MMA(AF, BF) do { _Pragma("unroll") for (int i = 0; i < 2; ++i) _Pragma("unroll") for (int rt = 0; rt < 4; ++rt) acc[rt] = __builtin_amdgcn_mfma_f32_32x32x16_bf16(AF[rt][i], BF[i], acc[rt], 0, 0, 0); } while (0)
    SG_LOAD(afA, bfA, 0);
#pragma unroll 1
    for (int k = 0; k < ks; k += 64) {
        if (k + 32 < ks) SG_LOAD(afB, bfB, k + 32);
        SG_MMA(afA, bfA);
        if (k + 32 < ks) { if (k + 64 < ks) SG_LOAD(afA, bfA, k + 64); SG_MMA(afB, bfB); }
    }
#undef SG_LOAD
#undef SG_MMA
    LAS float* RED = (LAS float*)(c.lds);
    __syncthreads();
#pragma unroll
    for (int rt = 0; rt < 4; ++rt)
#pragma unroll
        for (int r = 0; r < 16; ++r) RED[((w * 4 + rt) * 16 + r) * 64 + lane] = acc[rt][r];
    __syncthreads();
    const int rt = w & 3, rh = w >> 2, col = n0 + r32;
    float v[8];
#pragma unroll
    for (int i = 0; i < 8; ++i) { float s = 0.f;
#pragma unroll
        for (int ww = 0; ww < 8; ++ww) s += RED[((ww * 4 + rt) * 16 + 8 * rh + i) * 64 + lane];
        v[i] = s; }
    if (g.mode == 0) {
#pragma unroll
        for (int i = 0; i < 8; ++i) { const int row = MP + rt * 32 + crow(8 * rh + i, hh); const float rs = rsqrtf(g.ssin[row] * (1.0f / DM) + EPS); g.Z[(size_t)row * g.ldz + col] = (bf16)f2bf(v[i] * rs); }
    } else if (g.mode == 1) {
#pragma unroll
        for (int i = 0; i < 8; ++i) { const int lr = rt * 32 + crow(8 * rh + i, hh), row = MP + lr; const float x = v[i] + g.resid[(size_t)lr * DM + col];
            g.y[(size_t)lr * DM + col] = x; if (g.xb) g.xb[(size_t)row * DM + col] = (bf16)f2bf(x);
            float s = x * x; s += __shfl_xor(s, 1); s += __shfl_xor(s, 2); s += __shfl_xor(s, 4); s += __shfl_xor(s, 8); s += __shfl_xor(s, 16);
            if (g.ssout && r32 == 0) atomicAdd(g.ssout + row, s); }
    } else {
        const bool isup = (col & 128) != 0; const int fc = (col >> 8) * 128 + (col & 127); bf16* dst = isup ? g.UP : g.U;
#pragma unroll
        for (int i = 0; i < 8; ++i) { const int lr = rt * 32 + crow(8 * rh + i, hh), row = MP + lr; const float rs = rsqrtf(g.ssin[row] * (1.0f / DM) + EPS); const float x = v[i] * rs;
            dst[(size_t)row * DFF + fc] = (bf16)f2bf(x);
            if (!isup && (lr & 3) >= 2) g.cvs[(size_t)((lr >> 2) * 2 + (lr & 3) - 2) * DFF + fc] = x; }
    }
}
__device__ __forceinline__ void sgemm_phase(Ctx& c, const SgArgs& g, int N) {
#pragma unroll 1
    for (int u = c.G - 1 - (int)blockIdx.x; u < N / 32; u += c.G) sgemm_unit(c, g, u * 32);
}


__device__ __forceinline__ float wave_sum_f(float x) {
    x += __builtin_bit_cast(float, __builtin_amdgcn_update_dpp(0, __builtin_bit_cast(int, x), 0xB1, 0xF, 0xF, false));
    x += __builtin_bit_cast(float, __builtin_amdgcn_update_dpp(0, __builtin_bit_cast(int, x), 0x4E, 0xF, 0xF, false));
    x += __builtin_bit_cast(float, __builtin_amdgcn_update_dpp(0, __builtin_bit_cast(int, x), 0x141, 0xF, 0xF, false));
    x += __builtin_bit_cast(float, __builtin_amdgcn_update_dpp(0, __builtin_bit_cast(int, x), 0x140, 0xF, 0xF, false));
    const int xi = __builtin_bit_cast(int, x);
    return (__builtin_bit_cast(float, __builtin_amdgcn_readlane(xi, 0)) + __builtin_bit_cast(float, __builtin_amdgcn_readlane(xi, 16))) +
           (__builtin_bit_cast(float, __builtin_amdgcn_readlane(xi, 32)) + __builtin_bit_cast(float, __builtin_amdgcn_readlane(xi, 48)));
}
__device__ __forceinline__ void dsa_post_row(const Args& a, int row, int lane_) {
    int lane = lane_; asm volatile("" : "+v"(lane));
    const bf16* z = (const bf16*)(a.ws + WS_Z) + (size_t)row * ZC1;
    const bool smp = row >= MP; const int b = smp ? (row - MP) >> 2 : row >> 12, t = smp ? (row - MP) & 3 : row & 4095;
    const float pos = (float)(smp ? PAST + t : t);
    const int i = lane & 31;
    float x1[8], x2[8], q1[4], q2[4], k1 = 0.f, k2 = 0.f;
#pragma unroll
    for (int hd = 0; hd < 8; ++hd) { x1[hd] = bf2f(z[hd * 128 + lane]); x2[hd] = bf2f(z[hd * 128 + 64 + lane]); }
    const u64 vv = *(const u64*)(z + Z1_V + 4 * lane);
#pragma unroll
    for (int p = 0; p < 4; ++p) { const int hd = 2 * p + (lane >> 5); q1[p] = bf2f(z[Z1_IQ + hd * 64 + i]); q2[p] = bf2f(z[Z1_IQ + hd * 64 + 32 + i]); }
    if (lane < 32) { k1 = bf2f(z[Z1_IK + i]); k2 = bf2f(z[Z1_IK + 32 + i]); }
    const float wraw = bf2f(z[Z1_IW + (lane & 7)]);
    float c128, s128, c64, s64;
    { const float r1 = pos * (exp2f(-(float)lane * (13.287712379549449f / 64.0f)) * 0.15915494309189535f), f1 = r1 - floorf(r1); s128 = __builtin_amdgcn_sinf(f1); c128 = __builtin_amdgcn_cosf(f1);
      const float r2 = pos * (exp2f(-(float)i * (13.287712379549449f / 32.0f)) * 0.15915494309189535f), f2 = r2 - floorf(r2); s64 = __builtin_amdgcn_sinf(f2); c64 = __builtin_amdgcn_cosf(f2); }
#pragma unroll
    for (int hd = 0; hd < 8; ++hd) {
        const float rs = rsqrtf(wave_sum_f(x1[hd] * x1[hd] + x2[hd] * x2[hd]) * (1.0f / 128.0f) + EPS);
        const float* gn = hd < 6 ? a.in[17] : a.in[18];
        const float y1 = x1[hd] * rs * gn[lane], y2 = x2[hd] * rs * gn[64 + lane];
        const float o1 = y1 * c128 - y2 * s128, o2 = y2 * c128 + y1 * s128;
        if (hd < 6) {
            if (smp) { float* q = (float*)(a.ws + WS_SQ) + (size_t)(row - MP) * 768 + hd * 128; q[lane] = o1; q[64 + lane] = o2; }
            else { bf16* q = (bf16*)(a.ws + WS_QB) + ((size_t)(b * 6 + hd) * SEQ + t) * 128; q[lane] = (bf16)f2bf(o1); q[64 + lane] = (bf16)f2bf(o2); }
        } else {
            const int kvh = hd - 6;
            float* ko = smp ? a.out + O_KS + (size_t)(row - MP) * 256 + kvh * 128 : a.out + O_KP + (size_t)row * 256 + kvh * 128;
            ko[lane] = o1; ko[64 + lane] = o2;
            if (!smp) { bf16* kb = (bf16*)(a.ws + WS_KB) + ((size_t)(b * 2 + kvh) * SEQ + t) * 128; kb[lane] = (bf16)f2bf(o1); kb[64 + lane] = (bf16)f2bf(o2); }
        }
    }
    {
        const f32x4 v = {bf2f((unsigned)vv & 0xffffu), bf2f(((unsigned)vv) >> 16), bf2f((unsigned)(vv >> 32) & 0xffffu), bf2f((unsigned)(vv >> 48))};
        float* vo = smp ? a.out + O_VS + (size_t)(row - MP) * 256 : a.out + O_VP + (size_t)row * 256;
        *(f32x4*)(vo + 4 * lane) = v;
        if (!smp) { const int kvh = lane >> 5, d = (lane & 31) * 4; *(u64*)((bf16*)(a.ws + WS_VB) + ((size_t)(b * 2 + kvh) * SEQ + t) * 128 + d) = vv; }
    }
    {
#pragma unroll
        for (int p = 0; p < 4; ++p) { const int hd = 2 * p + (lane >> 5);
            const float o1 = q1[p] * c64 - q2[p] * s64, o2 = q2[p] * c64 + q1[p] * s64;
            if (smp) { float* q = (float*)(a.ws + WS_SIQ) + (size_t)(row - MP) * 512 + hd * 64; q[i] = o1; q[32 + i] = o2; }
            else { bf16* q = (bf16*)(a.ws + WS_IQB) + (size_t)row * 512 + hd * 64; q[i] = (bf16)f2bf(o1); q[32 + i] = (bf16)f2bf(o2); } }
        const float rs = rsqrtf(wave_sum_f(k1 * k1 + k2 * k2) * (1.0f / 64.0f) + EPS);
        const float y1 = k1 * rs * a.in[19][i], y2 = k2 * rs * a.in[19][32 + i];
        const float o1 = y1 * c64 - y2 * s64, o2 = y2 * c64 + y1 * s64;
        if (lane < 32) {
            float* ko = smp ? a.out + O_IKS + (size_t)(row - MP) * 64 : a.out + O_IKP + (size_t)row * 64; ko[i] = o1; ko[32 + i] = o2;
            if (!smp) { bf16* kb = (bf16*)(a.ws + WS_IKB) + (size_t)row * 64; kb[i] = (bf16)f2bf(o1); kb[32 + i] = (bf16)f2bf(o2); } }
        if (lane < 8) { const float wv = wraw * (0.35355339059327373f * 0.125f);
            if (smp) ((float*)(a.ws + WS_SIW))[(row - MP) * 8 + lane] = wv; else ((float*)(a.ws + WS_IW))[(size_t)row * 8 + lane] = wv; }
    }
}
__device__ __forceinline__ void p8_dsa_post(Ctx& c, const Args& a) {
    for (;;) { const int u = q_next(c, 1); if (u >= 384) break; if (u < 256) memattn_prompt_unit(c, a, 1, u); else memattn_sample_unit(c, a, 1, u - 256); }
    const int gw = c.vcu * NWAVES + c.wave, NGW = c.G * NWAVES;
    for (int row = gw; row < MVALID; row += NGW) dsa_post_row(a, row, c.lane);
}

__device__ __forceinline__ void idx_prompt_unit(Ctx& c, const Args& a, int b, int qb) {
    int tid = c.tid; asm volatile("" : "+v"(tid));
    const int lane = tid & 63, r32 = lane & 31, hh = lane >> 5, w = c.wave;
    const int q0 = b * SEQ + qb * 32;
    LAS bf16* IQL = (LAS bf16*)(c.lds);
    { const bf16* src = (const bf16*)(a.ws + WS_IQB) + (size_t)q0 * 512;
#pragma unroll
      for (int i = 0; i < 4; ++i) { const int row = tid >> 4, ch = (tid & 15) + 16 * i; *(LAS v4u*)(IQL + row * 520 + ch * 8) = *(const v4u*)(src + (size_t)row * 512 + ch * 8); } }
    __syncthreads();
    const bf16* IK = (const bf16*)(a.ws + WS_IKB) + (size_t)(b * SEQ) * 64 + (size_t)r32 * 64 + 8 * hh;
    float* SC = (float*)(a.ws + WS_SC) + (size_t)(q0 + r32) * SEQ;
    float wv[8];
#pragma unroll
    for (int h = 0; h < 8; ++h) wv[h] = ((const float*)(a.ws + WS_IW))[(size_t)(q0 + r32) * 8 + h];
    bf16x8 ak[4], an[4];
    if (w <= qb) {
#pragma unroll
        for (int ks = 0; ks < 4; ++ks) ak[ks] = *(const bf16x8*)(IK + (size_t)(w * 32) * 64 + ks * 16); }
#pragma unroll 1
    for (int kt = w; kt <= qb; kt += 8) {
        if (kt + 8 <= qb) {
#pragma unroll
            for (int ks = 0; ks < 4; ++ks) an[ks] = *(const bf16x8*)(IK + (size_t)((kt + 8) * 32) * 64 + ks * 16); }
        f32x16 sc = {};
        int qoff = r32 * 520 + 8 * hh; asm volatile("" : "+v"(qoff));
#pragma unroll
        for (int h = 0; h < 8; ++h) { f32x16 d = {};
#pragma unroll
            for (int ks = 0; ks < 4; ++ks) d = __builtin_amdgcn_mfma_f32_32x32x16_bf16(ak[ks], *(const LAS bf16x8*)(IQL + qoff + h * 64 + ks * 16), d, 0, 0, 0);
#pragma unroll
            for (int r = 0; r < 16; ++r) sc[r] = fmaf(wv[h], fmaxf(d[r], 0.f), sc[r]); }
#pragma unroll
        for (int g = 0; g < 4; ++g) *(f32x4*)(SC + kt * 32 + 8 * g + 4 * hh) = (f32x4){sc[4 * g], sc[4 * g + 1], sc[4 * g + 2], sc[4 * g + 3]};
#pragma unroll
        for (int ks = 0; ks < 4; ++ks) ak[ks] = an[ks];
    }
}
__device__ __forceinline__ v4u pack8f(const float* p) { const f32x4 x = *(const f32x4*)p, y = *(const f32x4*)(p + 4); v4u o; o.x = pk2(x.x, x.y); o.y = pk2(x.z, x.w); o.z = pk2(y.x, y.y); o.w = pk2(y.z, y.w); return o; }
__device__ __forceinline__ void idx_sample_tile(const Args& a, int sb, int tl, int lane_) {
    int lane = lane_; asm volatile("" : "+v"(lane));
    const int r32 = lane & 31, hh = lane >> 5, tk = r32 >> 3, hd = r32 & 7;
    const float* iq = (const float*)(a.ws + WS_SIQ) + (size_t)(sb * 4 + tk) * 512 + hd * 64 + 8 * hh;
    const float wv = ((const float*)(a.ws + WS_SIW))[(sb * 4 + tk) * 8 + hd];
    const float* src;
    if (tl < 256) src = a.in[4] + ((size_t)a.page_table[sb * 64 + (tl >> 2)] * 128 + (tl & 3) * 32 + r32) * 64 + 8 * hh;
    else src = a.out + O_IKS + (size_t)(sb * 4 + (r32 & 3)) * 64 + 8 * hh;
    v4u af[4], bf_[4];
#pragma unroll
    for (int ks = 0; ks < 4; ++ks) { af[ks] = pack8f(src + 16 * ks); bf_[ks] = pack8f(iq + 16 * ks); }
    if (tl == 256 && r32 >= 4) {
#pragma unroll
        for (int ks = 0; ks < 4; ++ks) af[ks] = (v4u){0u, 0u, 0u, 0u}; }
    f32x16 d = {};
#pragma unroll
    for (int ks = 0; ks < 4; ++ks) d = __builtin_amdgcn_mfma_f32_32x32x16_bf16(__builtin_bit_cast(bf16x8, af[ks]), __builtin_bit_cast(bf16x8, bf_[ks]), d, 0, 0, 0);
    float* dst = (float*)(a.ws + WS_SSC) + (size_t)(sb * 4 + tk) * SSC_LD + tl * 32;
#pragma unroll
    for (int r = 0; r < 16; ++r) { float v = wv * fmaxf(d[r], 0.f);
        v += __builtin_bit_cast(float, __builtin_amdgcn_update_dpp(0, __builtin_bit_cast(int, v), 0xB1, 0xF, 0xF, false));
        v += __builtin_bit_cast(float, __builtin_amdgcn_update_dpp(0, __builtin_bit_cast(int, v), 0x4E, 0xF, 0xF, false));
        v += __builtin_bit_cast(float, __builtin_amdgcn_update_dpp(0, __builtin_bit_cast(int, v), 0x141, 0xF, 0xF, false));
        if (hd == 0) dst[crow(r, hh)] = v; }
}
__device__ __forceinline__ void p9_indexer(Ctx& c, const Args& a) {
    const int gw = c.vcu * NWAVES + c.wave, NGW = c.G * NWAVES;
#pragma unroll 1
    for (int wt = gw; wt < 32 * 257; wt += NGW) idx_sample_tile(a, wt / 257, wt % 257, c.lane);
    for (;;) { const int u = q_next(c, 2); if (u >= 512) break; idx_prompt_unit(c, a, u & 3, 127 - (u >> 2)); }
}


__device__ __forceinline__ unsigned fkey(float f) { const unsigned u = __builtin_bit_cast(unsigned, f + 0.0f); return (u & 0x80000000u) ? ~u : (u | 0x80000000u); }
__device__ __forceinline__ void acc_ge(int& cnt, unsigned key, unsigned cand) { asm volatile("v_cmp_le_u32_e32 vcc, %1, %2\n\tv_addc_co_u32_e32 %0, vcc, 0, %0, vcc" : "+v"(cnt) : "s"(cand), "v"(key) : "vcc"); }
__device__ __forceinline__ void acc_ge4(int& c0, int& c1, int& c2, int& c3, unsigned k0, unsigned k1, unsigned k2, unsigned k3, unsigned cand) {
    u64 m0, m1, m2, m3;
    asm volatile("v_cmp_le_u32_e64 %4, %8, %9\n\tv_cmp_le_u32_e64 %5, %8, %10\n\tv_cmp_le_u32_e64 %6, %8, %11\n\tv_cmp_le_u32_e64 %7, %8, %12\n\t"
                 "v_addc_co_u32_e64 %0, %4, 0, %0, %4\n\tv_addc_co_u32_e64 %1, %5, 0, %1, %5\n\tv_addc_co_u32_e64 %2, %6, 0, %2, %6\n\tv_addc_co_u32_e64 %3, %7, 0, %3, %7"
                 : "+v"(c0), "+v"(c1), "+v"(c2), "+v"(c3), "=&s"(m0), "=&s"(m1), "=&s"(m2), "=&s"(m3) : "s"(cand), "v"(k0), "v"(k1), "v"(k2), "v"(k3));
}
__device__ __forceinline__ u64 ballot_nz(unsigned v) { u64 m; asm volatile("v_cmp_ne_u32_e64 %0, 0, %1" : "=s"(m) : "v"(v)); return m; }
__device__ __forceinline__ int wave_sum_dpp(int x) {
    x += __builtin_amdgcn_update_dpp(0, x, 0xB1, 0xF, 0xF, false);
    x += __builtin_amdgcn_update_dpp(0, x, 0x4E, 0xF, 0xF, false);
    x += __builtin_amdgcn_update_dpp(0, x, 0x141, 0xF, 0xF, false);
    x += __builtin_amdgcn_update_dpp(0, x, 0x140, 0xF, 0xF, false);
    return (__builtin_amdgcn_readlane(x, 0) + __builtin_amdgcn_readlane(x, 16)) + (__builtin_amdgcn_readlane(x, 32) + __builtin_amdgcn_readlane(x, 48));
}
__device__ __forceinline__ int mbcnt64(u64 m) { return (int)__builtin_amdgcn_mbcnt_hi((unsigned)(m >> 32), __builtin_amdgcn_mbcnt_lo((unsigned)m, 0u)); }
constexpr int TK_LOWBITS = 18;
__device__ __forceinline__ void topk_finish(unsigned ck, int cp, int A, int posmax, unsigned& T, int& P) {
#pragma unroll 1
    for (int bit = TK_LOWBITS - 1; bit >= 0; --bit) { const unsigned cand = T | (1u << bit); if (A + __builtin_popcountll(__ballot(ck >= cand)) >= 256) T = cand; }
    const int need = 256 - (A + __builtin_popcountll(__ballot(ck > T))), ceq = __builtin_popcountll(__ballot(ck == T));
    P = posmax;
    if (ceq != need) { P = 0;
#pragma unroll 1
        for (int bit = 13; bit >= 0; --bit) { const int cand = P | (1 << bit); if (__builtin_popcountll(__ballot(ck == T && cp < cand)) < need) P = cand; } }
}
__device__ __forceinline__ void topk_prompt_rows(const Args& a, int row0, int stride, int lane_, LAS unsigned* cl  ) {
    int lane = lane_; asm volatile("" : "+v"(lane));
    const float* SCb = (const float*)(a.ws + WS_SC);
    float nx[64];
#define TK_NEEDS(r) ((r) < MP && ((r) & 4095) >= 256)
#define TK_PREFETCH(r) do { const float* sc_ = SCb + (size_t)(r) * SEQ + lane; const int tj_ = ((r) & 4095) >> 6; _Pragma("unroll") for (int j = 0; j < 64; ++j) { if (j <= tj_) nx[j] = sc_[64 * j]; } } while (0)
    if (TK_NEEDS(row0)) TK_PREFETCH(row0);
#pragma unroll 1
    for (int row = row0; row < MP; row += stride) {
        const int t = row & 4095;
        u64* mk = (u64*)(a.ws + WS_MASK) + (size_t)row * 64;
        u64 myword = 0ull;
        if (t < 256) {
#pragma unroll 1
            for (int j = 0; j < 64; ++j) { const u64 m = __ballot(64 * j + lane <= t); if (lane == j) myword = m; }
            mk[lane] = myword;
            if (TK_NEEDS(row + stride)) TK_PREFETCH(row + stride);
            continue; }
        unsigned key[64];
#pragma unroll
        for (int j = 0; j < 64; ++j) key[j] = (lane <= t - 64 * j) ? fkey(nx[j]) : 0u;
        if (TK_NEEDS(row + stride)) TK_PREFETCH(row + stride);
#define TK_FULLCOUNT(CAND, OUT) do { const unsigned cs_ = __builtin_amdgcn_readfirstlane(CAND); int c0_ = 0, c1_ = 0, c2_ = 0, c3_ = 0; \
        _Pragma("unroll") for (int j = 0; j < 64; j += 4) acc_ge4(c0_, c1_, c2_, c3_, key[j], key[j + 1], key[j + 2], key[j + 3], cs_); OUT = wave_sum_dpp((c0_ + c1_) + (c2_ + c3_)); } while (0)
        unsigned T = 0u;
#pragma unroll 1
        for (int bit = 31; bit >= TK_LOWBITS; --bit) { const unsigned cand = T | (1u << bit); int tot; TK_FULLCOUNT(cand, tot); if (tot >= 256) T = cand; }
        const unsigned hib = T + (1u << TK_LOWBITS);
        int A = 0, cT; if (hib != 0u) TK_FULLCOUNT(hib, A); TK_FULLCOUNT(T, cT);
        int P;
        if (cT - A <= 64) {
            int base = 0;
#pragma unroll
            for (int j = 0; j < 64; ++j) { const unsigned und = (key[j] - T) < (1u << TK_LOWBITS) ? 1u : 0u; const u64 m = ballot_nz(und); const int pos = base + mbcnt64(m);
                if (und) { cl[pos] = key[j]; cl[64 + pos] = (unsigned)(64 * j + lane); }
                base += __builtin_popcountll(m); asm volatile("" : "+s"(base)); }
            const unsigned ck = lane < base ? cl[lane] : 0u; const int cp = (int)cl[64 + lane];
            topk_finish(ck, cp, A, 4095, T, P);
        } else {
#pragma unroll 1
            for (int bit = TK_LOWBITS - 1; bit >= 0; --bit) { const unsigned cand = T | (1u << bit); int tot; TK_FULLCOUNT(cand, tot); if (tot >= 256) T = cand; }
            int cge, cgt; TK_FULLCOUNT(T, cge); cgt = 0; if (T != 0xffffffffu) TK_FULLCOUNT(T + 1u, cgt);
            const int need = 256 - cgt, ceq = cge - cgt; P = 4095;
            if (ceq != need) { P = 0;
#pragma unroll 1
                for (int bit = 11; bit >= 0; --bit) { const int cand = P | (1 << bit); int cnt = 0;
#pragma unroll
                    for (int j = 0; j < 64; ++j) cnt += (key[j] == T && lane < cand - 64 * j) ? 1 : 0;
                    if (wave_sum_dpp(cnt) < need) P = cand; } }
        }
#undef TK_FULLCOUNT
#pragma unroll
        for (int j = 0; j < 64; ++j) { const unsigned selv = (key[j] > T || (key[j] == T && lane <= P - 64 * j)) ? 1u : 0u; const u64 m = ballot_nz(selv); if (lane == j) myword = m; asm volatile("" : "+v"(myword)); }
        mk[lane] = myword;
    }
#undef TK_NEEDS
#undef TK_PREFETCH
}
__device__ __forceinline__ void topk_sample_row(const Args& a, int q, int lane_, LAS unsigned* K, LAS unsigned* cl) {
    int lane = lane_; asm volatile("" : "+v"(lane));
    const int t = q & 3, n = PAST + t + 1; const float* sc = (const float*)(a.ws + WS_SSC) + (size_t)q * SSC_LD;
    int* out = (int*)(a.ws + WS_SIDX) + q * 256;
    unsigned key[129];
#pragma unroll
    for (int j = 0; j < 129; ++j) { const float v = sc[64 * j + lane]; key[j] = (lane < n - 64 * j) ? fkey(v) : 0u; }
#pragma unroll
    for (int j = 0; j < 129; ++j) K[64 * j + lane] = key[j];
#define TK_FULLCOUNT(CAND, OUT) do { const unsigned cs_ = __builtin_amdgcn_readfirstlane(CAND); int c0_ = 0, c1_ = 0, c2_ = 0, c3_ = 0; \
        _Pragma("unroll") for (int j = 0; j < 128; j += 4) acc_ge4(c0_, c1_, c2_, c3_, key[j], key[j + 1], key[j + 2], key[j + 3], cs_); acc_ge(c0_, key[128], cs_); OUT = wave_sum_dpp((c0_ + c1_) + (c2_ + c3_)); } while (0)
    unsigned T = 0u;
#pragma unroll 1
    for (int bit = 31; bit >= TK_LOWBITS; --bit) { const unsigned cand = T | (1u << bit); int tot; TK_FULLCOUNT(cand, tot); if (tot >= 256) T = cand; }
    const unsigned hib = T + (1u << TK_LOWBITS);
    int A = 0, cT; if (hib != 0u) TK_FULLCOUNT(hib, A); TK_FULLCOUNT(T, cT);
    int P;
    if (cT - A <= 64) {
        int base = 0;
#pragma unroll 1
        for (int j0 = 0; j0 < 128; j0 += 8) { unsigned kk[8];
#pragma unroll
            for (int i = 0; i < 8; ++i) kk[i] = K[64 * (j0 + i) + lane];
#pragma unroll
            for (int i = 0; i < 8; ++i) { const unsigned und = (kk[i] - T) < (1u << TK_LOWBITS) ? 1u : 0u; const u64 m = ballot_nz(und); const int pos = base + mbcnt64(m);
                if (und) { cl[pos] = kk[i]; cl[64 + pos] = (unsigned)(64 * (j0 + i) + lane); }
                base += __builtin_popcountll(m); } }
        { const unsigned kj = K[64 * 128 + lane]; const unsigned und = (kj - T) < (1u << TK_LOWBITS) ? 1u : 0u; const u64 m = ballot_nz(und); const int pos = base + mbcnt64(m);
          if (und) { cl[pos] = kj; cl[64 + pos] = (unsigned)(64 * 128 + lane); } base += __builtin_popcountll(m); }
        const unsigned ck = lane < base ? cl[lane] : 0u; const int cp = (int)cl[64 + lane];
        topk_finish(ck, cp, A, 16383, T, P);
    } else {
#pragma unroll 1
        for (int bit = TK_LOWBITS - 1; bit >= 0; --bit) { const unsigned cand = T | (1u << bit); int tot; TK_FULLCOUNT(cand, tot); if (tot >= 256) T = cand; }
        int cge, cgt; TK_FULLCOUNT(T, cge); cgt = 0; if (T != 0xffffffffu) TK_FULLCOUNT(T + 1u, cgt);
        const int need = 256 - cgt, ceq = cge - cgt; P = 16383;
        if (ceq != need) { P = 0;
#pragma unroll 1
            for (int bit = 13; bit >= 0; --bit) { const int cand = P | (1 << bit); int cnt = 0;
#pragma unroll 4
                for (int j = 0; j < 129; ++j) cnt += (K[64 * j + lane] == T && 64 * j + lane < cand) ? 1 : 0;
                if (wave_sum_dpp(cnt) < need) P = cand; } }
    }
#undef TK_FULLCOUNT
    int base = 0;
#pragma unroll 1
    for (int j0 = 0; j0 < 136; j0 += 8) { unsigned kk[8];
#pragma unroll
        for (int i = 0; i < 8; ++i) kk[i] = (j0 + i < 129) ? K[64 * (j0 + i) + lane] : 0u;
#pragma unroll
        for (int i = 0; i < 8; ++i) { const int ps = 64 * (j0 + i) + lane; const unsigned selv = (kk[i] > T || (kk[i] == T && ps <= P)) ? 1u : 0u; const u64 m = ballot_nz(selv);
            const int pos = base + mbcnt64(m);
            if (selv && pos < 256) out[pos] = ps;
            base += __builtin_popcountll(m); } }
}
__device__ __forceinline__ void p10_topk(Ctx& c, const Args& a) {
    const int gw = c.vcu * NWAVES + c.wave, NGW = c.G * NWAVES;
    LAS unsigned* cl = (LAS unsigned*)(c.lds) + c.wave * 128;
    if (c.wave == 0 && c.vcu < MS) topk_sample_row(a, c.vcu, c.lane, (LAS unsigned*)(c.lds + 4096), cl);
    topk_prompt_rows(a, gw, NGW, c.lane, cl);
}


__device__ __forceinline__ void attn_sample_unit(Ctx& c, const Args& a, int sb, int t) {
    LAS bf16* KV = (LAS bf16*)(c.lds);
    LAS float* QL = (LAS float*)(c.lds + 69632);
    LAS float* SL = (LAS float*)(c.lds + 69632 + 3072);
    LAS float* OL = (LAS float*)(c.lds + 69632 + 6144);
    LAS int* IL = (LAS int*)(c.lds + 69632 + 12288);
    int tid = c.tid; asm volatile("" : "+v"(tid));
    const int lane = tid & 63, w = c.wave, q = sb * 4 + t;
    __syncthreads();
    if (tid < 256) IL[tid] = ((const int*)(a.ws + WS_SIDX))[q * 256 + tid];
    for (int i = tid; i < 768; i += 512) QL[i] = ((const float*)(a.ws + WS_SQ))[(size_t)q * 768 + i];
    __syncthreads();
    bf16* MIX = (bf16*)(a.ws + WS_MIX) + (size_t)(MP + q) * DM;
#pragma unroll 1
    for (int kvh = 0; kvh < 2; ++kvh) {
#pragma unroll 1
        for (int pass = 0; pass < 2; ++pass) {
            const float* pool = pass ? a.in[3] : a.in[2]; const float* nw = a.out + (pass ? O_VS : O_KS);
            for (int i = tid >> 5; i < 256; i += 16) { const int idx = IL[i]; const float* src;
                if (idx < PAST) src = pool + (((size_t)a.page_table[sb * 64 + (idx >> 7)] * 128 + (idx & 127)) * 2 + kvh) * 128;
                else src = nw + (size_t)(sb * 4 + (idx - PAST)) * 256 + kvh * 128;
                const f32x4 v = *(const f32x4*)(src + (tid & 31) * 4);
                *(LAS u64*)(KV + i * 136 + (tid & 31) * 4) = (u64)pk2(v.x, v.y) | ((u64)pk2(v.z, v.w) << 32); }
            __syncthreads();
            if (pass == 0) {
                const int i = tid >> 1, dh = (tid & 1) * 64; float s0 = 0.f, s1 = 0.f, s2 = 0.f;
#pragma unroll 8
                for (int d = 0; d < 64; ++d) { const float kx = bf2f(KV[i * 136 + dh + d]);
                    s0 = fmaf(QL[(3 * kvh + 0) * 128 + dh + d], kx, s0); s1 = fmaf(QL[(3 * kvh + 1) * 128 + dh + d], kx, s1); s2 = fmaf(QL[(3 * kvh + 2) * 128 + dh + d], kx, s2); }
                s0 += __shfl_xor(s0, 1); s1 += __shfl_xor(s1, 1); s2 += __shfl_xor(s2, 1);
                if ((tid & 1) == 0) { SL[i] = s0 * 0.08838834764831845f; SL[256 + i] = s1 * 0.08838834764831845f; SL[512 + i] = s2 * 0.08838834764831845f; }
                __syncthreads();
                if (w < 3) { float v[4], mx = -1e30f;
#pragma unroll
                    for (int j = 0; j < 4; ++j) { v[j] = SL[w * 256 + 64 * j + lane]; mx = fmaxf(mx, v[j]); }
#pragma unroll
                    for (int o = 1; o < 64; o <<= 1) mx = fmaxf(mx, __shfl_xor(mx, o));
                    float l = 0.f;
#pragma unroll
                    for (int j = 0; j < 4; ++j) { v[j] = __expf(v[j] - mx); l += v[j]; }
                    l = wave_sum(l); const float il = 1.0f / l;
#pragma unroll
                    for (int j = 0; j < 4; ++j) SL[w * 256 + 64 * j + lane] = v[j] * il; }
                __syncthreads();
            } else {
                const int d = tid & 127, part = tid >> 7; float o0 = 0.f, o1 = 0.f, o2 = 0.f;
#pragma unroll 8
                for (int i = part * 64; i < part * 64 + 64; ++i) { const float vx = bf2f(KV[i * 136 + d]); o0 = fmaf(SL[i], vx, o0); o1 = fmaf(SL[256 + i], vx, o1); o2 = fmaf(SL[512 + i], vx, o2); }
                OL[(part * 3 + 0) * 128 + d] = o0; OL[(part * 3 + 1) * 128 + d] = o1; OL[(part * 3 + 2) * 128 + d] = o2;
                __syncthreads();
                if (tid < 384) { const int hq = tid >> 7, dd = tid & 127; const float o = (OL[hq * 128 + dd] + OL[(3 + hq) * 128 + dd]) + (OL[(6 + hq) * 128 + dd] + OL[(9 + hq) * 128 + dd]);
                    MIX[(3 * kvh + hq) * 128 + dd] = (bf16)f2bf(o); }
                __syncthreads();
            }
        }
    }
}


namespace attn {
using bf16 = unsigned short;
typedef short bf16x8 __attribute__((ext_vector_type(8)));
typedef short s16x4 __attribute__((ext_vector_type(4)));
typedef float f32x16 __attribute__((ext_vector_type(16)));
typedef float f32x4 __attribute__((ext_vector_type(4)));
typedef unsigned u32x4 __attribute__((ext_vector_type(4)));
typedef unsigned u32x2 __attribute__((ext_vector_type(2)));
constexpr int D = 128, OS = 1024;
constexpr float THR = 8.f;
constexpr float SCALE = 0.08838834764831845f;
constexpr int NW = 8, QBLK = 32, KVBLK = 64, QB = NW * QBLK;
constexpr int SHM_V = KVBLK * D * 2, SHM_K = KVBLK * D * 2;
constexpr int LDS_BYTES = 2 * SHM_V + 2 * SHM_K + NW * 64 * 4;

#define KSWZ(row, colB) ((row) * 256 + ((colB) ^ (((row) & 7) << 4)))
#define SBAR() __builtin_amdgcn_sched_barrier(0)
__device__ __forceinline__ int v_st(int k, int c) { const int kk = (k & ~0xC) | ((k & 4) << 1) | ((k & 8) >> 1); return ((kk >> 3) * 4 + (c >> 5)) * 512 + ((kk & 7) * 32 + (c & 31)) * 2; }
__device__ __forceinline__ int v_rd_base(int lane) { return ((lane & 3) << 3) | (((lane >> 2) & 3) << 6) | (((lane >> 4) & 1) << 5) | (((lane >> 5) & 1) << 8); }
constexpr int v_rd_off(int d0, int ks, int half) { return d0 * 512 + ks * 4096 + half * 2048; }
__device__ __forceinline__ int crow(int r, int hi) { return (r & 3) + 8 * (r >> 2) + 4 * hi; }
__device__ __forceinline__ unsigned cvtpk(float lo, float hi) {
    unsigned r; asm volatile("v_cvt_pk_bf16_f32 %0, %1, %2" : "=v"(r) : "v"(lo), "v"(hi)); return r;
}
__device__ __forceinline__ bf16x8 pack8(f32x4 a, f32x4 b) {
    u32x4 w = {cvtpk(a[0], a[1]), cvtpk(a[2], a[3]), cvtpk(b[0], b[1]), cvtpk(b[2], b[3])};
    return *reinterpret_cast<bf16x8*>(&w);
}

__device__ __forceinline__ void partialSM(f32x16& p0, f32x16& p1, float& m_reg, float& mn, float& alpha) {
    float pmax = p0[0]; for (int r = 1; r < 16; ++r) pmax = fmaxf(pmax, p0[r]); for (int r = 0; r < 16; ++r) pmax = fmaxf(pmax, p1[r]);
    { auto rr = __builtin_amdgcn_permlane32_swap(__float_as_uint(pmax), __float_as_uint(pmax), false, false);
      pmax = fmaxf(__uint_as_float(rr[0]), __uint_as_float(rr[1])); }
    constexpr float C2 = 1.4426950408889634f * SCALE;
    if (__builtin_expect(__all((pmax - m_reg) * SCALE <= THR), 1)) { mn = m_reg; alpha = 1.f; }
    else { mn = fmaxf(m_reg, pmax); alpha = __builtin_amdgcn_exp2f((m_reg - mn) * C2); m_reg = mn; }
    const float mnL = -mn * C2;
    for (int r = 0; r < 16; ++r) p0[r] = fmaf(p0[r], C2, mnL); for (int r = 0; r < 16; ++r) p1[r] = fmaf(p1[r], C2, mnL);
    for (int r = 0; r < 16; ++r) p0[r] = __builtin_amdgcn_exp2f(p0[r]);
}
__device__ __forceinline__ void finishSM(f32x16& p0, f32x16& p1, float alpha, float& l_reg, bf16x8& pa0, bf16x8& pa1, bf16x8& pa2, bf16x8& pa3) {
    for (int r = 0; r < 16; ++r) p1[r] = __builtin_amdgcn_exp2f(p1[r]);
    float ps = 0; for (int r = 0; r < 16; ++r) ps += p0[r]; for (int r = 0; r < 16; ++r) ps += p1[r];
    { auto rr = __builtin_amdgcn_permlane32_swap(__float_as_uint(ps), __float_as_uint(ps), false, false);
      ps = __uint_as_float(rr[0]) + __uint_as_float(rr[1]); }
    l_reg = l_reg * alpha + ps;
#define PK4(P, B_, OUT) do { unsigned a0 = cvtpk(P[B_+0], P[B_+1]), a1 = cvtpk(P[B_+2], P[B_+3]);                          \
        unsigned b0 = cvtpk(P[B_+4], P[B_+5]), b1 = cvtpk(P[B_+6], P[B_+7]);                                             \
        auto r0 = __builtin_amdgcn_permlane32_swap(a0, b0, false, false); auto r1 = __builtin_amdgcn_permlane32_swap(a1, b1, false, false); \
        u32x4 w = {r0[0], r1[0], r0[1], r1[1]}; OUT = *reinterpret_cast<bf16x8*>(&w); } while (0)
    PK4(p0, 0, pa0); PK4(p0, 8, pa1); PK4(p1, 0, pa2); PK4(p1, 8, pa3);
#undef PK4
}
template <int KB, bool SK>
__device__ __forceinline__ void qkt(f32x16& p0, f32x16& p1, const char* K_lds, int r32, int hi, const bf16x8* qr, bool act) {
    if (SK && !act) { const float NEG = -__builtin_inff();
#pragma unroll
        for (int r = 0; r < 16; ++r) { p0[r] = NEG; p1[r] = NEG; } return; }
    p0 = f32x16{}; p1 = f32x16{};
    const char* kb[4];
#pragma unroll
    for (int dd = 0; dd < 4; ++dd) kb[dd] = K_lds + KB * SHM_K + KSWZ(r32, (dd * 16 + hi * 8) * 2);
#pragma unroll
    for (int d0 = 0; d0 < 8; ++d0) { const char* a = kb[d0 & 3] + (d0 >> 2) * 128;
        bf16x8 b0 = *reinterpret_cast<const bf16x8*>(a);
        bf16x8 b1 = *reinterpret_cast<const bf16x8*>(a + 32 * 256);
        p0 = __builtin_amdgcn_mfma_f32_32x32x16_bf16(b0, qr[d0], p0, 0, 0, 0);
        p1 = __builtin_amdgcn_mfma_f32_32x32x16_bf16(b1, qr[d0], p1, 0, 0, 0); }
}
template <int VB, bool SK>
__device__ __forceinline__ void pv_tile(f32x16* o, int vb0, bf16x8 pa0, bf16x8 pa1, bf16x8 pa2, bf16x8 pa3, bool act) {
    if (SK && !act) return;
#define TRRD(dst, off) asm volatile("ds_read_b64_tr_b16 %0, %1 offset:%2" : "=&v"(dst) : "v"(vb0), "i"(off) : "memory")
#define PV_D0(d0) do { s16x4 l0, l1, l2, l3, h0, h1, h2, h3; constexpr int b_ = VB * SHM_V + v_rd_off(d0, 0, 0);     \
        TRRD(l0, b_); TRRD(h0, b_ + 2048); TRRD(l1, b_ + 4096); TRRD(h1, b_ + 6144); TRRD(l2, b_ + 8192); TRRD(h2, b_ + 10240); TRRD(l3, b_ + 12288); TRRD(h3, b_ + 14336); \
        asm volatile("s_waitcnt lgkmcnt(0)" ::: "memory"); SBAR();                 \
        o[d0] = __builtin_amdgcn_mfma_f32_32x32x16_bf16(pa0, (bf16x8){l0[0], l0[1], l0[2], l0[3], h0[0], h0[1], h0[2], h0[3]}, o[d0], 0, 0, 0);   \
        o[d0] = __builtin_amdgcn_mfma_f32_32x32x16_bf16(pa1, (bf16x8){l1[0], l1[1], l1[2], l1[3], h1[0], h1[1], h1[2], h1[3]}, o[d0], 0, 0, 0);   \
        o[d0] = __builtin_amdgcn_mfma_f32_32x32x16_bf16(pa2, (bf16x8){l2[0], l2[1], l2[2], l2[3], h2[0], h2[1], h2[2], h2[3]}, o[d0], 0, 0, 0);   \
        o[d0] = __builtin_amdgcn_mfma_f32_32x32x16_bf16(pa3, (bf16x8){l3[0], l3[1], l3[2], l3[3], h3[0], h3[1], h3[2], h3[3]}, o[d0], 0, 0, 0); } while (0)
    PV_D0(0); PV_D0(1); PV_D0(2); PV_D0(3);
#undef PV_D0
#undef TRRD
}

__device__ __forceinline__ bf16x8 load8(const bf16* p) { return *reinterpret_cast<const bf16x8*>(p); }
__device__ __forceinline__ void mask_bits(f32x16& p0, f32x16& p1, u32x2 w, int hi) {
    const float NEG = -__builtin_inff();
    asm volatile("" : "+v"(w.x), "+v"(w.y));
    const unsigned lo = w.x >> (4 * hi), up = w.y >> (4 * hi);
#pragma unroll
    for (int r = 0; r < 16; ++r) { const int c = (r & 3) + 8 * (r >> 2);
        if (!((lo >> c) & 1u)) p0[r] = NEG;
        if (!((up >> c) & 1u)) p1[r] = NEG; }
}
struct BlockRef { const bf16* Q; const bf16* K; const bf16* V; bf16* O; const u32x2* M; int P0; };
struct Seam { bf16x8 qr[8]; bf16x8 st_v0, st_v1, st_k0, st_k1; };
#define ROW(p, k0, rr) ((p) + (size_t)((k0) + (rr)) * D + sc)
#define VMW() asm volatile("s_waitcnt vmcnt(0)" ::: "memory")
#define VMWN(n) asm volatile("s_waitcnt vmcnt(%0)" :: "i"(n) : "memory")
#define SLOAD_H(Kp, Vp, k0) do { S.st_v0 = load8(ROW(Vp, k0, sr)); S.st_v1 = load8(ROW(Vp, k0, 32 + sr));              \
                         S.st_k0 = load8(ROW(Kp, k0, sr)); S.st_k1 = load8(ROW(Kp, k0, 32 + sr)); } while (0)
#define SWRITE_HK(bf) do { *(bf16x8*)(K_lds + (bf) * SHM_K + kws) = S.st_k0; *(bf16x8*)(K_lds + (bf) * SHM_K + kws + 32 * 256) = S.st_k1; } while (0)
#define SWRITE_HV(bf) do { *(bf16x8*)(V_lds + (bf) * SHM_V + vst0) = S.st_v0; *(bf16x8*)(V_lds + (bf) * SHM_V + vst1) = S.st_v1; } while (0)
#define SWRITE_H(bf) do { SWRITE_HV(bf); SWRITE_HK(bf); } while (0)
__device__ __forceinline__ void sel_prime(const BlockRef& cur, char* lds, Seam& S) {
    int tid_ = threadIdx.x; asm volatile("" : "+v"(tid_));
    const int tid = tid_, wid = __builtin_amdgcn_readfirstlane(tid >> 6), lane = tid & 63, r32 = lane & 31, hi = lane >> 5;
    const int sr = tid >> 4, sc = (tid & 15) * 8, kws = KSWZ(sr, sc * 2); char* K_lds = lds + 2 * SHM_V;
    for (int d0 = 0; d0 < 8; ++d0) S.qr[d0] = load8(cur.Q + (size_t)(wid * QBLK + r32) * D + d0 * 16 + hi * 8);
    SLOAD_H(cur.K, cur.V, 0); VMW(); SWRITE_HK(0);
    __syncthreads();
}
__device__ __forceinline__ void sel_block(const BlockRef& cur, const BlockRef& nxt, char* lds, Seam& S) {
    int tid_ = threadIdx.x; asm volatile("" : "+v"(tid_));
    const int tid = tid_, wid = __builtin_amdgcn_readfirstlane(tid >> 6), lane = tid & 63, r32 = lane & 31, hi = lane >> 5;
    const int NT = (cur.P0 + QB) / KVBLK;
    char* V_lds = lds; char* K_lds = lds + 2 * SHM_V;
    float* ws = (float*)(lds + 2 * SHM_V + 2 * SHM_K) + wid * 64; float* li_l = ws, * al_l = ws + 32;
    float m_reg = -1e30f, l_reg = 0; f32x16 o[4] = {};
    const int sr = tid >> 4, sc = (tid & 15) * 8, vst0 = v_st(sr, sc), vst1 = v_st(32 + sr, sc), kws = KSWZ(sr, sc * 2);
    const int vb0 = (int)(uintptr_t)V_lds + v_rd_base(lane);
    const bf16* Kh = cur.K; const bf16* Vh = cur.V;
    const u32x2* Mrow = cur.M + (size_t)(wid * QBLK + r32) * 64;
#define RESC(a) do { if (__any((a) < 1.f)) { if (hi == 0) al_l[r32] = (a); asm volatile("s_waitcnt lgkmcnt(0)" ::: "memory");              \
                     for (int d_ = 0; d_ < 4; ++d_) for (int r = 0; r < 16; ++r) o[d_][r] *= al_l[crow(r, hi)]; } } while (0)
#define KBASE(t) ((t) * KVBLK)
    f32x16 pA0, pA1, pB0, pB1; float mnA, mnB, alA, alB; bf16x8 pa0, pa1, pa2, pa3; u32x2 mw;
    SWRITE_HV(0); SBAR();
    if (NT > 1) SLOAD_H(Kh, Vh, KBASE(1));
    mw = Mrow[0];
    SBAR(); qkt<0, false>(pA0, pA1, K_lds, r32, hi, S.qr, true);
    mask_bits(pA0, pA1, mw, hi); partialSM(pA0, pA1, m_reg, mnA, alA);
    if (NT > 1) { VMW(); SWRITE_H(1); }
    __syncthreads();
#define HALF_STEP(PX0, PX1, mnX, alX, PY0, PY1, alY, t, KB, VB, SB) do {                                                      \
        SBAR(); mw = Mrow[(t)]; qkt<KB, false>(PX0, PX1, K_lds, r32, hi, S.qr, true);                                          \
        finishSM(PY0, PY1, alY, l_reg, pa0, pa1, pa2, pa3); SBAR();                                                           \
        if ((t) + 1 < NT) { SLOAD_H(Kh, Vh, KBASE((t) + 1)); SBAR(); }                                                        \
        pv_tile<VB, false>(o, vb0, pa0, pa1, pa2, pa3, true); mask_bits(PX0, PX1, mw, hi); partialSM(PX0, PX1, m_reg, mnX, alX); \
        __syncthreads();                                                                                                      \
        if ((t) + 1 < NT) { VMW(); SWRITE_H(SB); }                                                                            \
        RESC(alX); __syncthreads(); } while (0)
    for (int t = 1; t + 1 < NT; t += 2) {
        HALF_STEP(pB0, pB1, mnB, alB, pA0, pA1, alA, t, 1, 0, 0);
        HALF_STEP(pA0, pA1, mnA, alA, pB0, pB1, alB, t + 1, 0, 1, 1);
    }
    const bool even = (NT & 1) == 0;
    if (even) { SBAR(); mw = Mrow[NT - 1]; qkt<1, false>(pB0, pB1, K_lds, r32, hi, S.qr, true); SBAR(); }
    SLOAD_H(nxt.K, nxt.V, 0); SBAR();
#pragma unroll
    for (int d0 = 0; d0 < 8; ++d0) S.qr[d0] = load8(nxt.Q + (size_t)(wid * QBLK + r32) * D + d0 * 16 + hi * 8);
    SBAR();
    finishSM(pA0, pA1, alA, l_reg, pa0, pa1, pa2, pa3); SBAR();
    pv_tile<0, false>(o, vb0, pa0, pa1, pa2, pa3, true);
    if (even) { mask_bits(pB0, pB1, mw, hi); partialSM(pB0, pB1, m_reg, mnB, alB); __syncthreads(); RESC(alB);
        finishSM(pB0, pB1, alB, l_reg, pa0, pa1, pa2, pa3); SBAR(); pv_tile<1, false>(o, vb0, pa0, pa1, pa2, pa3, true); }
    SBAR(); VMWN(8); SWRITE_HK(0); SBAR();
    if (hi == 0) li_l[r32] = l_reg; asm volatile("s_waitcnt lgkmcnt(0)" ::: "memory");
    float rli[16];
#pragma unroll
    for (int r = 0; r < 16; ++r) rli[r] = __builtin_amdgcn_rcpf(li_l[crow(r, hi)]);
    bf16* Ow = cur.O + (size_t)(wid * QBLK) * OS;
#pragma unroll
    for (int r = 0; r < 16; ++r) { const int orow = crow(r, hi);
#pragma unroll
        for (int d0 = 0; d0 < 4; ++d0) { const float v = o[d0][r] * rli[r];
            const float vn = __shfl_xor(v, 1);
            if ((r32 & 1) == 0) *(unsigned*)(Ow + (size_t)orow * OS + d0 * 32 + r32) = cvtpk(v, vn); } }
    __syncthreads();
#undef RESC
#undef KBASE
#undef HALF_STEP
}
#undef ROW
#undef VMW
#undef VMWN
#undef SLOAD_H
#undef SWRITE_HK
#undef SWRITE_HV
#undef SWRITE_H
#undef KSWZ
#undef SBAR
}


__device__ __forceinline__ attn::BlockRef attn_ref(const Args& a, int b, int h, int qb) {
    attn::BlockRef r; const int kvh = h / 3;
    r.Q = (const attn::bf16*)(a.ws + WS_QB) + ((size_t)(b * 6 + h) * SEQ + (size_t)qb * 256) * 128;
    r.K = (const attn::bf16*)(a.ws + WS_KB) + (size_t)(b * 2 + kvh) * SEQ * 128;
    r.V = (const attn::bf16*)(a.ws + WS_VB) + (size_t)(b * 2 + kvh) * SEQ * 128;
    r.O = (attn::bf16*)(a.ws + WS_MIX) + (size_t)(b * SEQ + qb * 256) * DM + h * 128;
    r.M = (const attn::u32x2*)(a.ws + WS_MASK) + (size_t)(b * SEQ + qb * 256) * 64;
    r.P0 = qb * 256; return r;
}
__device__ __forceinline__ void p11_attention(Ctx& c, const Args& a) {
    constexpr int NITEM = 192;
#pragma unroll 1
    for (int it = c.vcu; it < NITEM; it += c.G) {
        const int p = it & 7, bh = it >> 3, b = bh / 6, h = bh % 6;
        attn::Seam S;
        attn::BlockRef cur = attn_ref(a, b, h, p), nxt = attn_ref(a, b, h, 15 - p);
        __syncthreads();
        attn::sel_prime(cur, (char*)c.lds, S);
        attn::sel_block(cur, nxt, (char*)c.lds, S);
        attn::sel_block(nxt, nxt, (char*)c.lds, S);
    }
    const int spare = c.G - NITEM;
    if (spare > 0) { if (c.vcu >= NITEM) for (int u = c.vcu - NITEM; u < MS; u += spare) attn_sample_unit(c, a, u >> 2, u & 3); }
    else for (int u = c.vcu; u < MS; u += c.G) attn_sample_unit(c, a, u >> 2, u & 3);
}

enum { PH_PRO = 0, PH_IN0, PH_MIX0, PH_HSCAN, PH_HFIX, PH_OUT0, PH_GU0, PH_CONV0, PH_DOWN0, PH_IN1, PH_POST, PH_IDX, PH_TOPK, PH_ATTN, PH_OUT1, PH_GU1, PH_CONV1, PH_DOWN1, NPHASE };
#ifndef ONLYPH
#define ONLYPH -1
#endif
#define PHON(x) (ONLYPH < 0 || ONLYPH == (x))
#ifndef REP_PH
#define REP_PH -1
#endif
#ifndef REP_N
#define REP_N 1
#endif
__global__ void __launch_bounds__(NWAVES * 64, 2) fwd_kernel(Args args) {
    extern __shared__ __attribute__((aligned(16))) unsigned char lds[];
    Ctx c;
    c.lds = (LAS unsigned char*)lds;
    c.MISC = (volatile LAS unsigned*)(c.lds + MISC_OFF);
    c.tid = threadIdx.x; c.lane = c.tid & 63; c.wave = __builtin_amdgcn_readfirstlane(c.tid >> 6);
    c.G = gridDim.x; { const int bx = blockIdx.x; c.vcu = (c.G % 8 == 0) ? (bx % 8) * (c.G / 8) + bx / 8 : bx; }
    unsigned char* ws = args.ws;
    c.ctl = (gu32*)(ws + WS_CTL);
    for (int u = c.tid; u < (LDS_BYTES - LDSCTL_OFF) / 4; u += NWAVES * 64) ((LAS unsigned*)(c.lds + LDSCTL_OFF))[u] = 0u;
    __syncthreads();
    const int lo = args.ph_lo, hi = args.ph_hi;
    XcdBarrier bar; bar.bar = (unsigned*)(c.ctl + CW_BAR); bar.x = 0; bar.st = nullptr;
    if (hi - lo > 1 || REP_N > 1) bar = xcd_barrier_post((unsigned*)(c.ctl + CW_BAR), c.MISC + 8);
    float* const out = args.out;
    c.qoff = 0;
#pragma unroll 1
    for (int ph = lo; ph < hi; ++ph) {
        const int layer = ph >= PH_IN1 ? 1 : 0;
        { int t_ = threadIdx.x; asm volatile("" : "+v"(t_)); c.tid = t_; c.lane = t_ & 63; c.wave = __builtin_amdgcn_readfirstlane(t_ >> 6); }
        if (ph == PH_PRO && PHON(PH_PRO)) p0_prologue(c, args);
        else if ((ph == PH_IN0 || ph == PH_IN1) && PHON(PH_IN0)) {
            pg8::Gemm g{(const pg8::bf16_t*)(ws + WS_XB), (const pg8::bf16_t*)(ws + (ph == PH_IN0 ? WS_WIN0 : WS_WIN1)), MT, 0, 1024};
            pg8::SchedX S; if (ph == PH_IN0) S.init(MP, ZC0, c.G, (int)blockIdx.x, 16, MT / 256, 4, 13); else S.init(MP, ZC1, c.G, (int)blockIdx.x, 0, 0, 1, 0);
            pg8::EpiZ E{(pg8::bf16_t*)(ws + WS_Z), ph == PH_IN0 ? ZC0 : ZC1, ssptr(c, ph == PH_IN0 ? 0 : 2), ph == PH_IN0 ? 13 : 9, (float*)(ws + WS_MEMKV), MEMROW0};
            pg8::gemm_phase<pg8::EpiZ, pg8::SchedX, PG8_ALIGN, PG8_SP2>(c.lds + RING_OFF, g, S, E);
            { SgArgs sg{}; sg.A = (const bf16*)(ws + WS_XB) + (size_t)MP * DM; sg.Bt = (const bf16*)(ws + (ph == PH_IN0 ? WS_WIN0 : WS_WIN1)); sg.K = 1024; sg.mode = 0; sg.Z = (bf16*)(ws + WS_Z); sg.ldz = ph == PH_IN0 ? ZC0 : ZC1; sg.ssin = ssptr(c, ph == PH_IN0 ? 0 : 2);
              sgemm_phase(c, sg, ph == PH_IN0 ? ZC0 : ZC1); }
        }
        else if (ph == PH_MIX0 && PHON(PH_MIX0)) p2_mixer0(c, args);
        else if (ph == PH_HSCAN && PHON(PH_HSCAN)) hgrn_scan(c, args);
        else if (ph == PH_HFIX && PHON(PH_HFIX)) p2c_hgrn_fix(c, args);
        else if ((ph == PH_OUT0 || ph == PH_DOWN0 || ph == PH_OUT1 || ph == PH_DOWN1) && PHON(PH_OUT0)) {
            const bool isout = (ph == PH_OUT0 || ph == PH_OUT1);
            pg8::Gemm g{(const pg8::bf16_t*)(ws + (isout ? WS_MIX : WS_ACT)), (const pg8::bf16_t*)(ws + (isout ? WS_WOUT + (size_t)layer * 1024 * 1024 * 2 : WS_WD + (size_t)layer * 1024 * DFF * 2)), MT, 1024, isout ? 1024 : DFF};
            pg8::SchedX S; S.init(MP, 1024, c.G, (int)blockIdx.x, 0, 0, 1, 0);
            pg8::EpiResid E;
            E.rp = ph == PH_OUT0 ? args.in[0] : out + O_YP; E.rs = ph == PH_OUT0 ? args.in[1] : out + O_YS; E.y = out + O_YP;
            E.xb = ph == PH_DOWN1 ? nullptr : (pg8::bf16_t*)(ws + WS_XB); E.ssout = ph == PH_DOWN1 ? nullptr : ssptr(c, ph == PH_OUT0 ? 1 : (ph == PH_DOWN0 ? 2 : 3));
            pg8::gemm_phase<pg8::EpiResid, pg8::SchedX, PG8_ALIGN, PG8_SP2>(c.lds + RING_OFF, g, S, E);
            { SgArgs sg{}; sg.A = (const bf16*)(ws + (isout ? WS_MIX : WS_ACT)) + (size_t)MP * (isout ? 1024 : DFF); sg.Bt = (const bf16*)g.Bt; sg.K = isout ? 1024 : DFF; sg.mode = 1; sg.resid = E.rs; sg.y = out + O_YS; sg.xb = (bf16*)E.xb; sg.ssout = E.ssout;
              sgemm_phase(c, sg, 1024); }
        }
        else if ((ph == PH_GU0 || ph == PH_GU1) && PHON(PH_GU0)) {
            pg8::Gemm g{(const pg8::bf16_t*)(ws + WS_XB), (const pg8::bf16_t*)(ws + WS_WGU + (size_t)layer * 5632 * 1024 * 2), MT, 5632, 1024};
            pg8::SchedX S; S.init(MP, 5632, c.G, (int)blockIdx.x, 0, 0, 1, 0);
            pg8::EpiGU E{(pg8::bf16_t*)(ws + WS_U), (pg8::bf16_t*)(ws + WS_UP), ssptr(c, layer ? 3 : 1), out + O_CVP + (size_t)layer * 4 * 2 * DFF, out + O_CVS + (size_t)layer * 32 * 2 * DFF};
            pg8::gemm_phase<pg8::EpiGU, pg8::SchedX, PG8_ALIGN, PG8_SP2>(c.lds + RING_OFF, g, S, E);
            { SgArgs sg{}; sg.A = (const bf16*)(ws + WS_XB) + (size_t)MP * DM; sg.Bt = (const bf16*)g.Bt; sg.K = 1024; sg.mode = 2; sg.ssin = E.ss; sg.U = (bf16*)E.U; sg.UP = (bf16*)E.UP; sg.cvs = E.cvs;
              sgemm_phase(c, sg, 5632); }
        }
        else if ((ph == PH_CONV0 || ph == PH_CONV1) && PHON(PH_CONV0)) p5_convact(c, args, layer);
        else if (ph == PH_POST && PHON(PH_POST)) p8_dsa_post(c, args);
        else if (ph == PH_IDX && PHON(PH_IDX)) p9_indexer(c, args);
        else if (ph == PH_TOPK && PHON(PH_TOPK)) p10_topk(c, args);
        else if (ph == PH_ATTN && PHON(PH_ATTN)) p11_attention(c, args);
        if (REP_N > 1 && ph == REP_PH && c.qoff < 4 * (REP_N - 1)) { c.qoff += 4; --ph; xcd_barrier(bar); continue; }
        if (REP_N > 1) c.qoff = 0;
        if (ph + 1 < hi) xcd_barrier(bar);
    }
}

#ifndef MK_ONE_LAUNCH
#define MK_ONE_LAUNCH 1
#endif
extern "C" void kernel_launch(void* const* d_in, const int* in_sizes, int n_in, void* d_out, int out_size, void* d_ws, size_t ws_size, hipStream_t stream) {
    static int grid = 0;
    if (grid == 0) {
        if (n_in != 29 || out_size != (int)O_END || ws_size < WS_END) { fprintf(stderr, "kernel_launch: unexpected problem (n_in %d, out %d, ws %zu)\n", n_in, out_size, ws_size); grid = -1; return; }
        int dev = 0, cus = 0;
        if (hipGetDevice(&dev) != hipSuccess || hipDeviceGetAttribute(&cus, hipDeviceAttributeMultiprocessorCount, dev) != hipSuccess) { grid = -1; return; }
        if (hipFuncSetAttribute((const void*)fwd_kernel, hipFuncAttributeMaxDynamicSharedMemorySize, LDS_BYTES) != hipSuccess) { fprintf(stderr, "kernel_launch: hipFuncSetAttribute failed\n"); grid = -1; return; }
        (void)hipGetLastError();
        grid = cus;
    }
    if (grid < 0) return;
    if (hipMemsetAsync((char*)d_ws + WS_CTL, 0, CTL_ZERO_BYTES, stream) != hipSuccess) { fprintf(stderr, "kernel_launch: memset failed\n"); return; }
    Args a{};
    for (int i = 0; i < 29; ++i) a.in[i] = (const float*)d_in[i];
    a.page_table = (const int*)d_in[9]; a.out = (float*)d_out; a.ws = (unsigned char*)d_ws;
#if MK_ONE_LAUNCH
    a.ph_lo = 0; a.ph_hi = NPHASE;
    hipLaunchKernelGGL(fwd_kernel, dim3(grid), dim3(NWAVES * 64), LDS_BYTES, stream, a);
#else
    for (int ph = 0; ph < NPHASE; ++ph) { a.ph_lo = ph; a.ph_hi = ph + 1; hipLaunchKernelGGL(fwd_kernel, dim3(grid), dim3(NWAVES * 64), LDS_BYTES, stream, a); }
#endif
}
```

```cpp
#include <hip/hip_runtime.h>
#include <cstdio>
#include <cstdint>


namespace pg8 {
#define PG8_LAS __attribute__((address_space(3)))
typedef unsigned short bf16_t;
typedef short bf16x8 __attribute__((ext_vector_type(8)));
typedef float f32x4 __attribute__((ext_vector_type(4)));
typedef unsigned u32x4 __attribute__((ext_vector_type(4)));
constexpr int BM = 256, BK = 64, HALF = 128, HTB = HALF * BK * 2  , STAGE_BYTES = 8 * HTB, NXCD = 8, WGM = 8;

__host__ __device__ __forceinline__ int lds_byte(int r, int c) { const int st = (r >> 4) * 2 + (c >> 5), rr = r & 15, cc = c & 31, ob = rr * 64 + cc * 2; return st * 1024 + (ob ^ (((ob >> 9) & 1) << 5)); }
__host__ __device__ __forceinline__ void stage_rc(int b, int& R, int& C) { const int st = b / 1024, sb = b % 1024, swz = sb ^ (((sb >> 9) & 1) << 5); R = (st >> 1) * 16 + swz / 64; C = (st & 1) * 32 + (swz % 64) / 2; }
__host__ __device__ __forceinline__ int perm32(int rho) { const int n = rho >> 4, i = rho & 15; return 8 * (i >> 2) + 4 * n + (i & 3); }

struct Unit { int pm, pn; };
struct Gemm { const bf16_t* A; const bf16_t* Bt; int M, N, K; };

struct StaticOrder {
    int nM, nN, nwg, G, c;
    __host__ __device__ __forceinline__ void init(int M, int N, int G_, int c_) { nM = M / BM; nN = N / BM; nwg = nM * nN; G = G_; c = c_; }
    __host__ __device__ __forceinline__ bool next(int i, Unit& u) const {
        const long L = (long)i * G + c; if (L >= nwg) return false;
        int wgid = (int)L; { const int q = nwg / NXCD, r = nwg % NXCD, xcd = wgid % NXCD, off = wgid / NXCD; wgid = (xcd < r ? xcd * (q + 1) : r * (q + 1) + (xcd - r) * q) + off; }
        const int nig = WGM * nN, gid = wgid / nig, fm = gid * WGM, gsz = (nM - fm) < WGM ? (nM - fm) : WGM;
        u.pm = fm + ((wgid % nig) % gsz); u.pn = (wgid % nig) / gsz; return true;
    }
    __device__ __forceinline__ void a_ready(const Unit&) const {}
    __device__ __forceinline__ void done(const Unit&) const {}
};


constexpr int MP = 16384, MS = 128, MVALID = MP + MS, MT = 16640, DM = 1024, DFF = 2816;
constexpr float RMS_EPS = 1e-6f;
__device__ __forceinline__ unsigned cvt_pk_bf16(float lo, float hi) { unsigned r; asm volatile("v_cvt_pk_bf16_f32 %0, %1, %2" : "=v"(r) : "v"(lo), "v"(hi)); return r; }

struct SchedX {
    StaticOrder so; int nextra, e_pm0, e_nm, e_pn0;
    __device__ __forceinline__ void init(int M, int N, int G_, int c_, int nextra_, int e_pm0_, int e_nm_, int e_pn0_) { so.init(M, N, G_, c_); nextra = nextra_; e_pm0 = e_pm0_; e_nm = e_nm_; e_pn0 = e_pn0_; }
    __device__ __forceinline__ bool next(int i, Unit& u) const {
        const long L = (long)i * so.G + so.c;
        if (L < so.nwg) return so.next(i, u);
        const int e = (int)(L - so.nwg); if (e >= nextra) return false;
        u.pm = e_pm0 + e % e_nm; u.pn = e_pn0 + e / e_nm; return true;
    }
    __device__ __forceinline__ void a_ready(const Unit&) const {}
    __device__ __forceinline__ void done(const Unit&) const {}
};

struct EpiZ {
    static constexpr bool PERM = true, AFTER_DRAIN = false;
    bf16_t* Z; int ldz; const float* ss; int nmain; float* memkv; int memrow0;
    __device__ __forceinline__ void operator()(const f32x4 (&acc)[2][2][4][2], const Unit& u, int wr, int wc, int fr, int fq) const {
        const int row0 = u.pm * BM + wr * 64 + fr;
        if (u.pn < nmain) {
            const int col0 = u.pn * BM + wc * 32 + 8 * fq;
#pragma unroll
            for (int ai = 0; ai < 2; ++ai)
#pragma unroll
                for (int m = 0; m < 4; ++m) { const int row = row0 + ai * HALF + m * 16; const float rs = rsqrtf(ss[row] * (1.0f / DM) + RMS_EPS);
#pragma unroll
                    for (int bj = 0; bj < 2; ++bj) { const f32x4 v0 = acc[ai][bj][m][0] * rs, v1 = acc[ai][bj][m][1] * rs;
                        u32x4 w; w.x = cvt_pk_bf16(v0[0], v0[1]); w.y = cvt_pk_bf16(v0[2], v0[3]); w.z = cvt_pk_bf16(v1[0], v1[1]); w.w = cvt_pk_bf16(v1[2], v1[3]);
                        *(u32x4*)(Z + (size_t)row * ldz + col0 + bj * HALF) = w; } }
        } else {
            const int col0 = (u.pn - nmain) * BM + wc * 32 + 8 * fq;
#pragma unroll
            for (int ai = 0; ai < 2; ++ai)
#pragma unroll
                for (int m = 0; m < 4; ++m) { const int row = row0 + ai * HALF + m * 16 - memrow0;
#pragma unroll
                    for (int bj = 0; bj < 2; ++bj) { float* p = memkv + (size_t)row * 1024 + col0 + bj * HALF; *(f32x4*)p = acc[ai][bj][m][0]; *(f32x4*)(p + 4) = acc[ai][bj][m][1]; } }
        }
    }
};

struct EpiResid {
    static constexpr bool PERM = true, AFTER_DRAIN = false;
    const float* rp; const float* rs; float* y; bf16_t* xb; float* ssout;
    __device__ __forceinline__ void operator()(const f32x4 (&acc)[2][2][4][2], const Unit& u, int wr, int wc, int fr, int fq) const {
        const int row0 = u.pm * BM + wr * 64 + fr, col0 = u.pn * BM + wc * 32 + 8 * fq;
#pragma unroll
        for (int ai = 0; ai < 2; ++ai)
#pragma unroll
            for (int m = 0; m < 4; ++m) { const int row = row0 + ai * HALF + m * 16; float part = 0.f;
                if (row < MVALID) { const float* src = row < MP ? rp + (size_t)row * DM : rs + (size_t)(row - MP) * DM;
#pragma unroll
                    for (int bj = 0; bj < 2; ++bj) { const int c = col0 + bj * HALF;
                        const f32x4 v0 = acc[ai][bj][m][0] + *(const f32x4*)(src + c), v1 = acc[ai][bj][m][1] + *(const f32x4*)(src + c + 4);
                        *(f32x4*)(y + (size_t)row * DM + c) = v0; *(f32x4*)(y + (size_t)row * DM + c + 4) = v1;
                        part += (v0[0] * v0[0] + v0[1] * v0[1]) + (v0[2] * v0[2] + v0[3] * v0[3]) + (v1[0] * v1[0] + v1[1] * v1[1]) + (v1[2] * v1[2] + v1[3] * v1[3]);
                        if (xb) { u32x4 w; w.x = cvt_pk_bf16(v0[0], v0[1]); w.y = cvt_pk_bf16(v0[2], v0[3]); w.z = cvt_pk_bf16(v1[0], v1[1]); w.w = cvt_pk_bf16(v1[2], v1[3]);
                            *(u32x4*)(xb + (size_t)row * DM + c) = w; } } }
                part += __shfl_xor(part, 16); part += __shfl_xor(part, 32);
                if (ssout && fq == 0 && row < MVALID) atomicAdd(ssout + row, part); }
    }
};

__device__ __forceinline__ void dpp_ror12(const f32x4& v, f32x4& r1, f32x4& r2) {
    float a0, a1, a2, a3, b0, b1, b2, b3;
    asm volatile("s_nop 1\n\t"
                 "v_mov_b32_dpp %0, %8 row_ror:1 row_mask:0xf bank_mask:0xf\n\tv_mov_b32_dpp %1, %9 row_ror:1 row_mask:0xf bank_mask:0xf\n\t"
                 "v_mov_b32_dpp %2, %10 row_ror:1 row_mask:0xf bank_mask:0xf\n\tv_mov_b32_dpp %3, %11 row_ror:1 row_mask:0xf bank_mask:0xf\n\t"
                 "v_mov_b32_dpp %4, %8 row_ror:2 row_mask:0xf bank_mask:0xf\n\tv_mov_b32_dpp %5, %9 row_ror:2 row_mask:0xf bank_mask:0xf\n\t"
                 "v_mov_b32_dpp %6, %10 row_ror:2 row_mask:0xf bank_mask:0xf\n\tv_mov_b32_dpp %7, %11 row_ror:2 row_mask:0xf bank_mask:0xf"
                 : "=&v"(a0), "=&v"(a1), "=&v"(a2), "=&v"(a3), "=&v"(b0), "=&v"(b1), "=&v"(b2), "=&v"(b3) : "v"(v[0]), "v"(v[1]), "v"(v[2]), "v"(v[3]));
    r1 = (f32x4){a0, a1, a2, a3}; r2 = (f32x4){b0, b1, b2, b3};
}
struct EpiGU {
    static constexpr bool PERM = true, AFTER_DRAIN = false;
    bf16_t* ACT; const float* ss; float* cvp; const float* cw; const float* cb; float* G4; float* UP2;
    __device__ __forceinline__ void operator()(const f32x4 (&acc)[2][2][4][2], const Unit& u, int wr, int wc, int fr, int fq) const {
        const int row0 = u.pm * BM + wr * 64 + fr, colg = u.pn * HALF + wc * 32 + 8 * fq;
#pragma unroll
        for (int n = 0; n < 2; ++n) { const int col = colg + 4 * n;
            const f32x4 w0 = *(const f32x4*)(cw + col), w1 = *(const f32x4*)(cw + DFF + col), w2 = *(const f32x4*)(cw + 2 * DFF + col), bb = *(const f32x4*)(cb + col);
#pragma unroll
            for (int ai = 0; ai < 2; ++ai) { f32x4 r1p = {0.f, 0.f, 0.f, 0.f}, r2p = r1p; const int slab = (u.pm * BM + ai * HALF + wr * 64) >> 6;
#pragma unroll
                for (int m = 0; m < 4; ++m) { const int row = row0 + ai * HALF + m * 16; const float rs = rsqrtf(ss[row] * (1.0f / DM) + RMS_EPS);
                    const f32x4 g = acc[ai][0][m][n] * rs, up = acc[ai][1][m][n] * rs;
                    f32x4 r1, r2; dpp_ror12(g, r1, r2);
                    const f32x4 p1 = fr >= 1 ? r1 : r1p, p2 = fr >= 2 ? r2 : r2p;
                    f32x4 cv = bb + w0 * p2 + w1 * p1 + w2 * g, y;
#pragma unroll
                    for (int i = 0; i < 4; ++i) y[i] = cv[i] * __builtin_amdgcn_rcpf(1.0f + __expf(-cv[i])) * up[i];
                    if (m == 0 && fr < 2) { *(f32x4*)(G4 + (size_t)(slab * 4 + fr) * DFF + col) = g; *(f32x4*)(UP2 + (size_t)(slab * 2 + fr) * DFF + col) = up; }
                    else { typedef unsigned u32x2 __attribute__((ext_vector_type(2))); u32x2 w; w.x = cvt_pk_bf16(y[0], y[1]); w.y = cvt_pk_bf16(y[2], y[3]); *(u32x2*)(ACT + (size_t)row * DFF + col) = w; }
                    if (m == 3 && fr >= 14) { *(f32x4*)(G4 + (size_t)(slab * 4 + 2 + (fr - 14)) * DFF + col) = g;
                        const int t = row & 4095; if (t >= 4094) *(f32x4*)(cvp + (size_t)((row >> 12) * 2 + (t - 4094)) * DFF + col) = g; }
                    r1p = r1; r2p = r2; } } }
    }
};

template <class Epi, class Sched, bool ALIGN_EPI = false, bool SP2 = false>
__device__ __forceinline__ void gemm_phase(PG8_LAS unsigned char* lds, const Gemm g, const Sched& S, const Epi& E) {
    int tid_ = threadIdx.x; asm volatile("" : "+v"(tid_));
    const int tid = tid_, wid = __builtin_amdgcn_readfirstlane(tid >> 6), lane = tid & 63, wr = wid >> 2, wc = wid & 3, fr = lane & 15, fq = lane >> 4;
    const int K = g.K, nt = K / BK;
    unsigned voffA[2], voffB[2];
#pragma unroll
    for (int i = 0; i < 2; ++i) { int R, C; stage_rc(tid * 16 + i * 8192, R, C); const int Rb = Epi::PERM ? ((R & ~31) + perm32(R & 31)) : R;
        voffA[i] = (unsigned)(R * K + C) * 2u; voffB[i] = (unsigned)(Rb * K + C) * 2u; }
    const size_t kstep = (size_t)(BK * 2);
    const size_t hstep = (size_t)HALF * K * 2;
    const size_t tstep = 2 * hstep;
    const unsigned ldsw = (unsigned)wid * 1024u;
    const int aoff = lds_byte(wr * 64 + fr, fq * 8), boff = lds_byte(wc * 32 + fr, fq * 8);
#define PG8_SA(b, h) (((b) * 2 + (h)) * HTB)
#define PG8_SB(b, h) ((4 + (b) * 2 + (h)) * HTB)
#define PG8_STAGE(bufoff, gbase, voff) do { _Pragma("unroll") for (int _i = 0; _i < 2; ++_i) \
        __builtin_amdgcn_global_load_lds((const unsigned*)((const char*)(gbase) + (voff)[_i]), (PG8_LAS unsigned*)(lds + (bufoff) + ldsw + _i * 8192), 16, 0, 0); } while (0)
#define PG8_LDA(dst, b, h) do { _Pragma("unroll") for (int m = 0; m < 4; ++m) _Pragma("unroll") for (int k = 0; k < 2; ++k) dst[m][k] = *(const PG8_LAS bf16x8*)(lds + PG8_SA(b, h) + aoff + m * 2048 + k * 1024); } while (0)
#define PG8_LDB(dst, b, h) do { _Pragma("unroll") for (int n = 0; n < 2; ++n) _Pragma("unroll") for (int k = 0; k < 2; ++k) dst[n][k] = *(const PG8_LAS bf16x8*)(lds + PG8_SB(b, h) + boff + n * 2048 + k * 1024); } while (0)
#define PG8_MMA(ai, bj, At, Bt) do { __builtin_amdgcn_s_setprio(1); _Pragma("unroll") for (int m = 0; m < 4; ++m) _Pragma("unroll") for (int n = 0; n < 2; ++n) _Pragma("unroll") for (int k = 0; k < 2; ++k) \
        acc[ai][bj][m][n] = __builtin_amdgcn_mfma_f32_16x16x32_bf16(Bt[n][k], At[m][k], acc[ai][bj][m][n], 0, 0, 0); __builtin_amdgcn_s_setprio(0); } while (0)
#define PG8_WAIT_V(n) asm volatile("s_waitcnt vmcnt(" #n ")" ::: "memory")
#define PG8_WAIT_L(n) asm volatile("s_waitcnt lgkmcnt(" #n ")" ::: "memory")
#define PG8_BAR __builtin_amdgcn_s_barrier()
#define PG8_SCHED __builtin_amdgcn_sched_barrier(0)
    Unit cur, nxt; int ui = 0;
    if (!S.next(0, cur)) return;
    f32x4 acc[2][2][4][2];
#pragma unroll
    for (int a = 0; a < 2; ++a)
#pragma unroll
        for (int b = 0; b < 2; ++b)
#pragma unroll
            for (int m = 0; m < 4; ++m)
#pragma unroll
                for (int n = 0; n < 2; ++n) acc[a][b][m][n] = (f32x4){0.f, 0.f, 0.f, 0.f};
    bf16x8 At[4][2], B0[2][2], B1[2][2];
    const char* cA = (const char*)g.A + (size_t)cur.pm * tstep; const char* cB = (const char*)g.Bt + (size_t)cur.pn * tstep;
    S.a_ready(cur);
    if constexpr (SP2) {
        PG8_STAGE(PG8_SB(0, 0), cB, voffB); PG8_STAGE(PG8_SB(0, 1), cB + hstep, voffB); PG8_STAGE(PG8_SA(0, 0), cA, voffA); PG8_STAGE(PG8_SA(0, 1), cA + hstep, voffA);
        if (wr == 1) PG8_BAR;
        PG8_WAIT_V(2); PG8_BAR;
        PG8_STAGE(PG8_SB(1, 0), cB + kstep, voffB); PG8_STAGE(PG8_SA(1, 0), cA + kstep, voffA); PG8_STAGE(PG8_SB(1, 1), cB + hstep + kstep, voffB);
        PG8_WAIT_V(6); PG8_BAR;
    } else {
        PG8_STAGE(PG8_SB(0, 0), cB, voffB); PG8_STAGE(PG8_SA(0, 0), cA, voffA); PG8_STAGE(PG8_SB(0, 1), cB + hstep, voffB); PG8_STAGE(PG8_SA(0, 1), cA + hstep, voffA);
        if (wr == 1) PG8_BAR;
        PG8_WAIT_V(4); PG8_BAR;
        PG8_STAGE(PG8_SB(1, 0), cB + kstep, voffB); PG8_STAGE(PG8_SA(1, 0), cA + kstep, voffA); PG8_STAGE(PG8_SB(1, 1), cB + hstep + kstep, voffB);
        PG8_WAIT_V(6); PG8_BAR;
    }
    for (;;) {
        const bool has_next = S.next(ui + 1, nxt);
        const char* nA = has_next ? (const char*)g.A + (size_t)nxt.pm * tstep : cA; const char* nB = has_next ? (const char*)g.Bt + (size_t)nxt.pn * tstep : cB;
        for (int t = 0; t < nt; t += 2) {
            const bool last = (t == nt - 2);
            const char* a1 = cA + (size_t)(t + 1) * kstep;
            const char* a2 = last ? nA : cA + (size_t)(t + 2) * kstep; const char* b2 = last ? nB : cB + (size_t)(t + 2) * kstep;
            const char* a3 = a2 + kstep; const char* b3 = b2 + kstep;
            if (last && has_next) S.a_ready(nxt);
            if constexpr (SP2) {
            PG8_LDB(B0, 0, 0); PG8_LDB(B1, 0, 1); PG8_SCHED; PG8_LDA(At, 0, 0); PG8_STAGE(PG8_SA(1, 1), a1 + hstep, voffA);
            PG8_WAIT_V(8); PG8_WAIT_L(0); PG8_BAR; PG8_MMA(0, 0, At, B0); PG8_MMA(0, 1, At, B1); PG8_BAR; PG8_SCHED;
            PG8_LDA(At, 0, 1); PG8_STAGE(PG8_SB(0, 0), b2, voffB); PG8_STAGE(PG8_SB(0, 1), b2 + hstep, voffB); PG8_STAGE(PG8_SA(0, 0), a2, voffA);
            PG8_WAIT_V(8); PG8_WAIT_L(0); PG8_BAR; PG8_MMA(1, 0, At, B0); PG8_MMA(1, 1, At, B1); PG8_BAR; PG8_SCHED;
            PG8_LDB(B0, 1, 0); PG8_LDB(B1, 1, 1); PG8_SCHED; PG8_LDA(At, 1, 0); PG8_STAGE(PG8_SA(0, 1), a2 + hstep, voffA);
            PG8_WAIT_V(8); PG8_WAIT_L(0); PG8_BAR; PG8_MMA(0, 0, At, B0); PG8_MMA(0, 1, At, B1); PG8_BAR; PG8_SCHED;
            PG8_LDA(At, 1, 1); PG8_STAGE(PG8_SB(1, 0), b3, voffB); PG8_STAGE(PG8_SB(1, 1), b3 + hstep, voffB); PG8_STAGE(PG8_SA(1, 0), a3, voffA);
            PG8_WAIT_V(8); PG8_WAIT_L(0); PG8_BAR; PG8_MMA(1, 0, At, B0); PG8_MMA(1, 1, At, B1); PG8_BAR; PG8_SCHED;
            } else {
            PG8_LDB(B0, 0, 0); PG8_SCHED; PG8_LDA(At, 0, 0); PG8_STAGE(PG8_SA(1, 1), a1 + hstep, voffA);
            PG8_WAIT_L(8); PG8_BAR; PG8_WAIT_L(0); PG8_MMA(0, 0, At, B0); PG8_BAR; PG8_SCHED;
            PG8_LDB(B1, 0, 1); PG8_STAGE(PG8_SB(0, 0), b2, voffB);
            PG8_BAR; PG8_WAIT_L(0); PG8_MMA(0, 1, At, B1); PG8_BAR;
            PG8_LDA(At, 0, 1); PG8_STAGE(PG8_SA(0, 0), a2, voffA);
            PG8_BAR; PG8_WAIT_L(0); PG8_MMA(1, 0, At, B0); PG8_BAR; PG8_SCHED;
            PG8_STAGE(PG8_SB(0, 1), b2 + hstep, voffB);
            PG8_WAIT_V(6); PG8_BAR; PG8_MMA(1, 1, At, B1); PG8_BAR;
            PG8_LDB(B0, 1, 0); PG8_SCHED; PG8_LDA(At, 1, 0); PG8_STAGE(PG8_SA(0, 1), a2 + hstep, voffA);
            PG8_WAIT_L(8); PG8_BAR; PG8_WAIT_L(0); PG8_MMA(0, 0, At, B0); PG8_BAR; PG8_SCHED;
            PG8_LDB(B1, 1, 1); PG8_STAGE(PG8_SB(1, 0), b3, voffB);
            PG8_BAR; PG8_WAIT_L(0); PG8_MMA(0, 1, At, B1); PG8_BAR;
            PG8_LDA(At, 1, 1); PG8_STAGE(PG8_SA(1, 0), a3, voffA);
            PG8_BAR; PG8_WAIT_L(0); PG8_MMA(1, 0, At, B0); PG8_BAR; PG8_SCHED;
            PG8_STAGE(PG8_SB(1, 1), b3 + hstep, voffB);
            PG8_WAIT_V(6); PG8_BAR; PG8_MMA(1, 1, At, B1); PG8_BAR;
            }
        }
        if constexpr (ALIGN_EPI) { if (wr == 0) PG8_BAR; }
        if constexpr (!Epi::AFTER_DRAIN) { E(acc, cur, wr, wc, fr, fq); S.done(cur); }
        if (!has_next) break;
#pragma unroll
        for (int a = 0; a < 2; ++a)
#pragma unroll
            for (int b = 0; b < 2; ++b)
#pragma unroll
                for (int m = 0; m < 4; ++m)
#pragma unroll
                    for (int n = 0; n < 2; ++n) acc[a][b][m][n] = (f32x4){0.f, 0.f, 0.f, 0.f};
        cur = nxt; cA = nA; cB = nB; ++ui;
        if constexpr (ALIGN_EPI) { if (wr == 1) PG8_BAR; }
    }
    PG8_WAIT_V(0);
    if constexpr (!ALIGN_EPI) { if (wr == 0) PG8_BAR; }
    PG8_BAR;
    if constexpr (Epi::AFTER_DRAIN) { E.fused(acc, cur, wr, wc, fr, fq, lds, wid, lane); S.done(cur); }
#undef PG8_SA
#undef PG8_SB
#undef PG8_STAGE
#undef PG8_LDA
#undef PG8_LDB
#undef PG8_MMA
#undef PG8_WAIT_V
#undef PG8_WAIT_L
#undef PG8_BAR
#undef PG8_SCHED
}
}


#ifndef PG8_SP2
#define PG8_SP2 true
#endif
#ifndef PG8_ALIGN
#define PG8_ALIGN true
#endif
constexpr int NWAVES = 8;
constexpr int MP = pg8::MP, MS = pg8::MS, MVALID = pg8::MVALID, MT = pg8::MT, DM = 1024, DFF = 2816;
constexpr int SEQ = 4096, NB = 4, NSB = 32, PAST = 8192, NPOOL = 2560;
constexpr int ZC0 = 3328, ZC1 = 2304;
constexpr int Z1_Q = 0, Z1_K = 768, Z1_V = 1024, Z1_IQ = 1280, Z1_IK = 1792, Z1_IW = 1856, Z1_MQ = 1920;
constexpr int NMEMROWS = 1024, MEMROW0 = MT;
constexpr float EPS = 1e-6f;
constexpr size_t MiB = 1u << 20;
constexpr size_t WS_CTL = 0, CTL_ZERO_BYTES = 2 * MiB;
constexpr size_t WS_WIN0 = 2 * MiB, WS_WIN1 = 11 * MiB, WS_WOUT = 16 * MiB, WS_WGU = 20 * MiB, WS_WD = 42 * MiB;
constexpr size_t WS_XB = 54 * MiB, WS_MEMKV = 89 * MiB, WS_MIX = 94 * MiB, WS_Z = 128 * MiB, WS_U = 234 * MiB, WS_UP = 324 * MiB, WS_ACT = 414 * MiB;
constexpr size_t WS_QB = 504 * MiB, WS_KB = 528 * MiB, WS_VB = 536 * MiB, WS_IQB = 544 * MiB, WS_IKB = 560 * MiB, WS_IW = 562 * MiB;
constexpr size_t WS_SQ = 563 * MiB, WS_SIQ = WS_SQ + 512 * 1024, WS_SIW = WS_SIQ + 384 * 1024, WS_SSC = 564 * MiB, WS_SIDX = 569 * MiB, WS_MASK = 570 * MiB, WS_SC = 578 * MiB, WS_END = 834 * MiB;
constexpr int SSC_LD = 8256;
constexpr int CW_TMO = 0, CW_BAR = 4096, CW_Q = 8192, CW_SS = 16384;
constexpr size_t O_YP = 0, O_YS = O_YP + (size_t)MP * DM, O_HP = O_YS + (size_t)MS * DM, O_HS = O_HP + 4 * 6 * 16384, O_KP = O_HS + 32 * 6 * 16384,
    O_VP = O_KP + (size_t)MP * 256, O_IKP = O_VP + (size_t)MP * 256, O_KS = O_IKP + (size_t)MP * 64, O_VS = O_KS + MS * 256, O_IKS = O_VS + MS * 256,
    O_MK = O_IKS + MS * 64, O_MV = O_MK + 2 * 1024 * 256, O_CVP = O_MV + 2 * 1024 * 256, O_CVS = O_CVP + 2 * 4 * 2 * DFF, O_END = O_CVS + 2 * 32 * 2 * DFF;
static_assert(O_END == 31412224, "output size");
constexpr int RING_OFF = 0, RING_BYTES = 131072;
constexpr int LDSCTL_OFF = RING_BYTES, MISC_OFF = LDSCTL_OFF + 320;
constexpr int LDS_BYTES = 147456;

#define GAS __attribute__((address_space(1)))
#define LAS __attribute__((address_space(3)))
typedef unsigned short bf16;
typedef unsigned v4u __attribute__((ext_vector_type(4)));
typedef float f32x4 __attribute__((ext_vector_type(4)));
typedef short bf16x8 __attribute__((ext_vector_type(8)));
typedef GAS unsigned gu32;
typedef GAS unsigned long long gu64;
#define RLX_AGENT __ATOMIC_RELAXED, __HIP_MEMORY_SCOPE_AGENT
#define LDS_WAIT() asm volatile("s_waitcnt lgkmcnt(0)" ::: "memory")
#define VM_WAIT() asm volatile("s_waitcnt vmcnt(0)" ::: "memory")
__device__ __forceinline__ unsigned long long rt() { return __builtin_amdgcn_s_memrealtime(); }
__device__ __forceinline__ unsigned f2bf(float f) { unsigned u = __builtin_bit_cast(unsigned, f); return (u + 0x7fffu + ((u >> 16) & 1u)) >> 16; }
__device__ __forceinline__ unsigned pk2(float lo, float hi) { return f2bf(lo) | (f2bf(hi) << 16); }

#define XB_TMO      128
#define XB_XCNT(j)  (256  + 64 * (j))
#define XB_XSUB(j)  (1280 + 64 * (j))
#define XB_XGEN(j)  (2304 + 64 * (j))
#define XB_TOP      3328
#define XB_TOPGEN   3392
#define XCD_BAR_WORDS 3456
#define XB_SPIN_CAP (1u << 18)

__device__ __forceinline__ unsigned xb_ld(unsigned* p)              { return __hip_atomic_load(p, __ATOMIC_RELAXED, __HIP_MEMORY_SCOPE_AGENT); }
__device__ __forceinline__ unsigned xb_add(unsigned* p, unsigned v) { return __hip_atomic_fetch_add(p, v, __ATOMIC_RELAXED, __HIP_MEMORY_SCOPE_AGENT); }
__device__ __forceinline__ unsigned xb_xcc_id() { return (unsigned)__builtin_amdgcn_s_getreg((3 << 11) | 20) & 0xFu; }
#define XB_SPIN(cond, bar) do { unsigned _sp = 0; while (cond) { __builtin_amdgcn_s_sleep(1); \
    if ((++_sp & 255u) == 0u) { if (xb_ld(&(bar)[XB_TMO])) break; if (_sp > XB_SPIN_CAP) { atomicAdd(&(bar)[XB_TMO], 1u); break; } } } } while (0)

struct XcdBarrier {
    unsigned* bar; unsigned x;
    volatile LAS unsigned* st;
};

__device__ __forceinline__ XcdBarrier xcd_barrier_post(unsigned* bar, volatile LAS unsigned* st) {
    XcdBarrier b; b.bar = bar; b.x = xb_xcc_id(); b.st = st;
    if (threadIdx.x == 0) (void)xb_add(&bar[XB_XCNT(b.x)], 1u);
    return b;
}
__device__ __forceinline__ void xcd_barrier_complete(unsigned* bar, unsigned x, unsigned& nloc, unsigned& nx) {
    const unsigned G = gridDim.x * gridDim.y * gridDim.z;
    unsigned sum, cnt, mine, sp = 0u;
    for (;;) {
        sum = 0u; cnt = 0u; mine = 0u;
#pragma unroll
        for (unsigned j = 0; j < 16; ++j) { const unsigned c = xb_ld(&bar[XB_XCNT(j)]); sum += c; cnt += (c > 0u) ? 1u : 0u; mine = (j == x) ? c : mine; }
        if (sum == G) break;
        __builtin_amdgcn_s_sleep(1);
        if ((++sp & 255u) == 0u) { if (xb_ld(&bar[XB_TMO])) break; if (sp > XB_SPIN_CAP) { atomicAdd(&bar[XB_TMO], 1u); break; } }
    }
    nloc = mine > 0u ? mine : 1u; nx = cnt > 0u ? cnt : 1u;
}

__device__ __forceinline__ void xcd_barrier(const XcdBarrier& b) {
    asm volatile("s_waitcnt vmcnt(0)" ::: "memory");
    __syncthreads();
    if (threadIdx.x == 0) {
        unsigned* bar = b.bar;
        __builtin_amdgcn_s_waitcnt(0);
        unsigned nloc = b.st[0], nx = b.st[1];
        if (nloc == 0u) { xcd_barrier_complete(bar, b.x, nloc, nx); b.st[0] = nloc; b.st[1] = nx; }
        const unsigned old = xb_add(&bar[XB_XSUB(b.x)], 1u);
        const unsigned gen = old / nloc;
        if (old + 1u == (gen + 1u) * nloc) {
            __builtin_amdgcn_fence(__ATOMIC_RELEASE, "agent");
            asm volatile("s_waitcnt vmcnt(0)" ::: "memory");
            const unsigned og = xb_add(&bar[XB_TOP], 1u);
            const unsigned tg = og / nx;
            if (og + 1u == (tg + 1u) * nx) xb_add(&bar[XB_TOPGEN], 1u);
            else XB_SPIN(xb_ld(&bar[XB_TOPGEN]) == tg, bar);
            __builtin_amdgcn_fence(__ATOMIC_ACQUIRE, "agent");
            xb_add(&bar[XB_XGEN(b.x)], 1u);
            asm volatile("s_waitcnt vmcnt(0)" ::: "memory");
        } else {
            XB_SPIN(xb_ld(&bar[XB_XGEN(b.x)]) == gen, bar);
            __builtin_amdgcn_fence(__ATOMIC_ACQUIRE, "agent");
            asm volatile("s_waitcnt vmcnt(0)" ::: "memory");
        }
    }
    __syncthreads();
}


struct Args { const float* in[29]; const int* page_table; float* out; unsigned char* ws; int ph_lo, ph_hi; };
struct Ctx { LAS unsigned char* lds; volatile LAS unsigned* MISC; gu32* ctl; int tid, lane, wave, vcu, G, qoff; };
typedef float f32x16 __attribute__((ext_vector_type(16)));
typedef unsigned long long u64;

__device__ __forceinline__ float bf2f(unsigned b) { return __builtin_bit_cast(float, b << 16); }
__device__ __forceinline__ float wave_sum(float v) {
#pragma unroll
    for (int o = 1; o < 64; o <<= 1) v += __shfl_xor(v, o);
    return v;
}
__device__ __forceinline__ int crow(int r, int hi) { return (r & 3) + 8 * (r >> 2) + 4 * hi; }
__device__ __forceinline__ float sigmoidf_(float x) { return 1.0f / (1.0f + __expf(-x)); }
__device__ __forceinline__ float* ssptr(const Ctx& c, int i) { return (float*)(c.ctl + CW_SS) + (size_t)i * MT; }

__device__ __forceinline__ int q_next(Ctx& c, int qi) {
    __syncthreads();
    if (c.tid == 0) c.MISC[16] = atomicAdd((unsigned*)(c.ctl + CW_Q + 64 * (qi + c.qoff)), 1u);
    __syncthreads();
    return (int)c.MISC[16];
}

template <int K>
__device__ __forceinline__ f32x16 mm32(const LAS bf16* A, int lda, const LAS bf16* Bt, int ldb, f32x16 acc, int lane) {
    const int r = lane & 31, h = lane >> 5;
#pragma unroll
    for (int ks = 0; ks < K; ks += 16) {
        const bf16x8 a = *(const LAS bf16x8*)(A + r * lda + ks + 8 * h);
        const bf16x8 b = *(const LAS bf16x8*)(Bt + r * ldb + ks + 8 * h);
        acc = __builtin_amdgcn_mfma_f32_32x32x16_bf16(a, b, acc, 0, 0, 0);
    }
    return acc;
}

__device__ __forceinline__ int map_row(int mapid, int n, int row_off) {
    if (mapid == 0) return n + row_off;
    if (mapid == 1) return n < 1864 ? n : n + 56;
    if (mapid == 2) return (n >> 7) * 256 + (n & 127);
    return (n >> 7) * 256 + 128 + (n & 127);
}
__device__ __forceinline__ void transpose_item(const float* W, int K, int N, const float* kscale, bf16* WT, int mapid, int row_off, LAS float* scr, int item, int lane) {
    const int nblk = (N + 31) / 32, kb = item / nblk, nb = item % nblk, k0 = 64 * kb, n0 = 32 * nb;
    { const int n4 = (lane & 7) * 4, nn = n0 + n4 < N ? n0 + n4 : N - 4; f32x4 v[8];
#pragma unroll
      for (int i = 0; i < 8; ++i) v[i] = *(const f32x4*)(W + (size_t)(k0 + 8 * i + (lane >> 3)) * N + nn);
#pragma unroll
      for (int i = 0; i < 8; ++i) { const int kk = 8 * i + (lane >> 3); const float sc = kscale ? kscale[k0 + kk] : 1.0f; LAS float* d = scr + kk * 33 + n4;
          d[0] = v[i].x * sc; d[1] = v[i].y * sc; d[2] = v[i].z * sc; d[3] = v[i].w * sc; } }
    LDS_WAIT(); asm volatile("" ::: "memory");
    const int cc = lane & 7;
#pragma unroll
    for (int j = 0; j < 4; ++j) { const int nl = (lane >> 3) + 8 * j, n = n0 + nl; const LAS float* s = scr + (8 * cc) * 33 + nl;
        v4u o; o.x = pk2(s[0 * 33], s[1 * 33]); o.y = pk2(s[2 * 33], s[3 * 33]); o.z = pk2(s[4 * 33], s[5 * 33]); o.w = pk2(s[6 * 33], s[7 * 33]);
        if (n < N) *(GAS v4u*)(WT + (size_t)map_row(mapid, n, row_off) * K + k0 + 8 * cc) = o; }
    LDS_WAIT(); asm volatile("" ::: "memory");
}
__device__ __forceinline__ void p0_prologue(Ctx& c, const Args& a) {
    LAS float* scr = (LAS float*)(c.lds + RING_OFF + c.wave * 16384);
    const int gw = c.vcu * NWAVES + c.wave, NGW = c.G * NWAVES, lane = c.lane;
    unsigned char* ws = a.ws;
    constexpr int I_INH = 16 * 104, I_MKV = 16 * 16, I_DSA = 16 * 67, I_OUT = 16 * 32, I_G = 16 * 88, I_D = 44 * 32;
    constexpr int NITEMS = I_INH + 2 * I_MKV + I_DSA + 2 * I_OUT + 4 * I_G + 2 * I_D;
    for (int it = gw; it < NITEMS; it += NGW) {
        int r = it;
        if (r < I_INH) { transpose_item(a.in[13], 1024, 3328, a.in[11], (bf16*)(ws + WS_WIN0), 0, 0, scr, r, lane); continue; } r -= I_INH;
        if (r < I_MKV) { transpose_item(a.in[20], 1024, 512, nullptr, (bf16*)(ws + WS_WIN0), 0, 3328, scr, r, lane); continue; } r -= I_MKV;
        if (r < I_MKV) { transpose_item(a.in[20] + 1024 * 512, 1024, 512, nullptr, (bf16*)(ws + WS_WIN0), 0, 3840, scr, r, lane); continue; } r -= I_MKV;
        if (r < I_DSA) { transpose_item(a.in[16], 1024, 2120, a.in[11] + 1024, (bf16*)(ws + WS_WIN1), 1, 0, scr, r, lane); continue; } r -= I_DSA;
        if (r < 2 * I_OUT) { const int l = r / I_OUT; transpose_item(a.in[23] + (size_t)l * 1024 * 1024, 1024, 1024, nullptr, (bf16*)(ws + WS_WOUT) + (size_t)l * 1024 * 1024, 0, 0, scr, r % I_OUT, lane); continue; } r -= 2 * I_OUT;
        if (r < 2 * I_G) { const int l = r / I_G; transpose_item(a.in[24] + (size_t)l * 1024 * DFF, 1024, DFF, a.in[12] + l * 1024, (bf16*)(ws + WS_WGU) + (size_t)l * 5632 * 1024, 2, 0, scr, r % I_G, lane); continue; } r -= 2 * I_G;
        if (r < 2 * I_G) { const int l = r / I_G; transpose_item(a.in[25] + (size_t)l * 1024 * DFF, 1024, DFF, a.in[12] + l * 1024, (bf16*)(ws + WS_WGU) + (size_t)l * 5632 * 1024, 3, 0, scr, r % I_G, lane); continue; } r -= 2 * I_G;
        { const int l = r / I_D; transpose_item(a.in[28] + (size_t)l * DFF * 1024, DFF, 1024, nullptr, (bf16*)(ws + WS_WD) + (size_t)l * 1024 * DFF, 0, 0, scr, r % I_D, lane); }
    }
    for (int rr = gw; rr < 184; rr += NGW) { const int row = rr < 56 ? 1864 + rr : 2176 + (rr - 56);
        GAS v4u* p = (GAS v4u*)((bf16*)(ws + WS_WIN1) + (size_t)row * 1024); p[lane] = (v4u){0u, 0u, 0u, 0u}; p[64 + lane] = (v4u){0u, 0u, 0u, 0u}; }
    float* ss0 = ssptr(c, 0);
    for (int m = gw; m < MT + NMEMROWS; m += NGW) {
        GAS u64* o8 = (GAS u64*)((bf16*)(ws + WS_XB) + (size_t)m * DM) + lane;
        if (m >= MVALID && m < MT) {
#pragma unroll
            for (int j = 0; j < 4; ++j) o8[64 * j] = 0ull;
            continue; }
        const float* src = m < MP ? a.in[0] + (size_t)m * DM : (m < MVALID ? a.in[1] + (size_t)(m - MP) * DM : a.in[10] + (size_t)(m - MT) * DM);
        const GAS f32x4* xr = (const GAS f32x4*)src + lane; f32x4 v[4]; float s = 0.f;
#pragma unroll
        for (int j = 0; j < 4; ++j) { v[j] = xr[64 * j]; s += (v[j].x * v[j].x + v[j].y * v[j].y) + (v[j].z * v[j].z + v[j].w * v[j].w); }
        s = wave_sum(s);
#pragma unroll
        for (int j = 0; j < 4; ++j) o8[64 * j] = (u64)pk2(v[j].x, v[j].y) | ((u64)pk2(v[j].z, v[j].w) << 32);
        if (m < MVALID && lane == 0) ss0[m] = s;
    }
}

__device__ __forceinline__ void memattn_unit(Ctx& c, const bf16* Zq  , int ldz, int nrows_valid, const float* Kp, const float* Vp, int kstride,
                                             bool normk, const float* kgain, const float* qgain, bf16* Out  ) {
    LAS bf16* KN = (LAS bf16*)(c.lds);
    LAS bf16* VTm = (LAS bf16*)(c.lds + 36864);
    LAS bf16* QN = (LAS bf16*)(c.lds + 70656) + c.wave * (32 * 72);
    LAS float* LI = (LAS float*)(c.lds + 107520) + c.wave * 32;
    int tid = c.tid; asm volatile("" : "+v"(tid));
    const int lane = tid & 63, w = c.wave;
    {
        const int m = tid >> 1, dh = (tid & 1) * 32;
        f32x4 kv[8]; float s = 0.f;
#pragma unroll
        for (int j = 0; j < 8; ++j) { kv[j] = *(const f32x4*)(Kp + (size_t)m * kstride + dh + 4 * j); s += (kv[j].x * kv[j].x + kv[j].y * kv[j].y) + (kv[j].z * kv[j].z + kv[j].w * kv[j].w); }
        s += __shfl_xor(s, 1);
        const float rs = normk ? rsqrtf(s * (1.0f / 64.0f) + EPS) : 1.0f;
#pragma unroll
        for (int j = 0; j < 8; j += 2) { f32x4 g0 = {1.f, 1.f, 1.f, 1.f}, g1 = g0;
            if (normk) { g0 = *(const f32x4*)(kgain + dh + 4 * j); g1 = *(const f32x4*)(kgain + dh + 4 * j + 4); }
            const f32x4 x0 = kv[j] * rs * g0, x1 = kv[j + 1] * rs * g1;
            v4u o; o.x = pk2(x0.x, x0.y); o.y = pk2(x0.z, x0.w); o.z = pk2(x1.x, x1.y); o.w = pk2(x1.z, x1.w);
            *(LAS v4u*)(KN + m * 72 + dh + 4 * j) = o; }
#pragma unroll
        for (int j = 0; j < 8; ++j) { const f32x4 vv = *(const f32x4*)(Vp + (size_t)m * kstride + dh + 4 * j);
            VTm[(dh + 4 * j + 0) * 264 + m] = (bf16)f2bf(vv.x); VTm[(dh + 4 * j + 1) * 264 + m] = (bf16)f2bf(vv.y);
            VTm[(dh + 4 * j + 2) * 264 + m] = (bf16)f2bf(vv.z); VTm[(dh + 4 * j + 3) * 264 + m] = (bf16)f2bf(vv.w); }
    }
    {
        const int row = lane >> 1, hf = lane & 1, grow = w * 32 + row;
        float x[32]; float s = 0.f;
        if (grow < nrows_valid) {
#pragma unroll
            for (int j = 0; j < 4; ++j) { const v4u q = *(const v4u*)(Zq + (size_t)grow * ldz + hf * 32 + 8 * j);
                x[8 * j + 0] = bf2f(q.x & 0xffffu); x[8 * j + 1] = bf2f(q.x >> 16); x[8 * j + 2] = bf2f(q.y & 0xffffu); x[8 * j + 3] = bf2f(q.y >> 16);
                x[8 * j + 4] = bf2f(q.z & 0xffffu); x[8 * j + 5] = bf2f(q.z >> 16); x[8 * j + 6] = bf2f(q.w & 0xffffu); x[8 * j + 7] = bf2f(q.w >> 16); }
        } else {
#pragma unroll
            for (int j = 0; j < 32; ++j) x[j] = 0.f;
        }
#pragma unroll
        for (int j = 0; j < 32; ++j) s += x[j] * x[j];
        s += __shfl_xor(s, 1);
        const float rs = rsqrtf(s * (1.0f / 64.0f) + EPS) * 0.125f;
#pragma unroll
        for (int j = 0; j < 32; j += 8) { v4u o;
            o.x = pk2(x[j] * rs * qgain[hf * 32 + j], x[j + 1] * rs * qgain[hf * 32 + j + 1]); o.y = pk2(x[j + 2] * rs * qgain[hf * 32 + j + 2], x[j + 3] * rs * qgain[hf * 32 + j + 3]);
            o.z = pk2(x[j + 4] * rs * qgain[hf * 32 + j + 4], x[j + 5] * rs * qgain[hf * 32 + j + 5]); o.w = pk2(x[j + 6] * rs * qgain[hf * 32 + j + 6], x[j + 7] * rs * qgain[hf * 32 + j + 7]);
            *(LAS v4u*)(QN + row * 72 + hf * 32 + j) = o; }
    }
    __syncthreads();
    if (w * 32 < nrows_valid) {
        const int r32 = lane & 31, hh = lane >> 5;
        f32x16 s[8];
#pragma unroll
        for (int mt = 0; mt < 8; ++mt) { f32x16 z = {}; s[mt] = mm32<64>(KN + mt * 32 * 72, 72, QN, 72, z, lane); }
        float mx = -1e30f;
#pragma unroll
        for (int mt = 0; mt < 8; ++mt)
#pragma unroll
            for (int r = 0; r < 16; ++r) mx = fmaxf(mx, s[mt][r]);
        mx = fmaxf(mx, __shfl_xor(mx, 32));
        float l = 0.f;
#pragma unroll
        for (int mt = 0; mt < 8; ++mt)
#pragma unroll
            for (int r = 0; r < 16; ++r) { const float p = __expf(s[mt][r] - mx); s[mt][r] = p; l += p; }
        l += __shfl_xor(l, 32);
        if (hh == 0) LI[r32] = l;
        f32x16 o[2] = {};
#pragma unroll
        for (int mt = 0; mt < 8; ++mt)
#pragma unroll
            for (int sx = 0; sx < 2; ++sx) {
                v4u pa; pa.x = pk2(s[mt][8 * sx + 0], s[mt][8 * sx + 1]); pa.y = pk2(s[mt][8 * sx + 2], s[mt][8 * sx + 3]);
                pa.z = pk2(s[mt][8 * sx + 4], s[mt][8 * sx + 5]); pa.w = pk2(s[mt][8 * sx + 6], s[mt][8 * sx + 7]);
                const bf16x8 af = __builtin_bit_cast(bf16x8, pa);
#pragma unroll
                for (int dt = 0; dt < 2; ++dt) { const LAS bf16* vp = VTm + (dt * 32 + r32) * 264 + mt * 32 + 16 * sx + 4 * hh;
                    const u64 lo = *(const LAS u64*)vp, hi = *(const LAS u64*)(vp + 8);
                    v4u bw; bw.x = (unsigned)lo; bw.y = (unsigned)(lo >> 32); bw.z = (unsigned)hi; bw.w = (unsigned)(hi >> 32);
                    o[dt] = __builtin_amdgcn_mfma_f32_32x32x16_bf16(af, __builtin_bit_cast(bf16x8, bw), o[dt], 0, 0, 0); }
            }
        LDS_WAIT();
#pragma unroll
        for (int r = 0; r < 16; ++r) { const int qr = crow(r, hh), grow = w * 32 + qr; const float il = 1.0f / LI[qr];
            if (grow < nrows_valid) {
#pragma unroll
                for (int dt = 0; dt < 2; ++dt) Out[(size_t)grow * DM + dt * 32 + r32] = (bf16)f2bf(o[dt][r] * il); } }
    }
}

constexpr int HG_GS = 4, HG_NG = SEQ / (32 * HG_GS);
constexpr size_t WS_HOL = WS_U, WS_HQC = WS_UP, WS_HUT = WS_ACT, WS_HST = WS_ACT + 64 * MiB, WS_HDG = WS_ACT + 50 * MiB;
template <bool PROMPT>
__device__ __forceinline__ void hgrn_unit(Ctx& c, const Args& a, int b, int h, int g) {
    LAS unsigned char* L = c.lds;
    LAS float* LF = (LAS float*)(L + 0);
    LAS float* BL = (LAS float*)(L + 16384);
    LAS float* DVv = (LAS float*)(L + 16896);
    LAS bf16* QD = (LAS bf16*)(L + 17408);
    LAS bf16* KD = (LAS bf16*)(L + 26112);
    LAS bf16* KET = (LAS bf16*)(L + 34816);
    LAS bf16* VT = (LAS bf16*)(L + 45056);
    LAS bf16* SCB = (LAS bf16*)(L + 55296);
    LAS bf16* STt = (LAS bf16*)(L + 57856);
    LAS float* BOFF = (LAS float*)(L + 92672);
    int tid = c.tid; asm volatile("" : "+v"(tid));
    const int lane = tid & 63, w = c.wave, r32 = lane & 31, hh = lane >> 5;
    const int te = tid >> 4, k8 = (tid & 15) * 8;
    const bf16* Z = (const bf16*)(a.ws + WS_Z);
    bf16* MIX = (bf16*)(a.ws + WS_MIX);
    const int nch = PROMPT ? HG_GS : 1, nvalid = PROMPT ? 32 : 4;
    const int kt = w >> 1, vt0 = 2 * (w & 1);
    const int unit = (b * 6 + h) * HG_NG + g;
    f32x16 S0 = {}, S1 = {};
    if (!PROMPT) { const float* sp = a.in[7] + (size_t)(b * 6 + h) * 16384;
#pragma unroll
        for (int r = 0; r < 16; ++r) { const int k = 32 * kt + crow(r, hh); S0[r] = sp[k * 128 + 32 * vt0 + r32]; S1[r] = sp[k * 128 + 32 * (vt0 + 1) + r32]; } }
    float lbv[8], onv[8];
#pragma unroll
    for (int j = 0; j < 8; ++j) { const float l0 = a.in[14][h * 128 + k8 + j], l1 = a.in[14][768 + h * 128 + k8 + j]; lbv[j] = 1.0f / (1.0f + __expf(l1 - l0)); onv[j] = a.in[15][k8 + j]; }
    __syncthreads();
    if (tid < 128) BOFF[tid] = 0.f;
#define HG_WRITE_ST() do { _Pragma("unroll") for (int g4 = 0; g4 < 4; ++g4) { const int k0 = 32 * kt + 8 * g4 + 4 * hh; \
        *(LAS u64*)(STt + (32 * vt0 + r32) * 136 + k0) = (u64)pk2(S0[4 * g4], S0[4 * g4 + 1]) | ((u64)pk2(S0[4 * g4 + 2], S0[4 * g4 + 3]) << 32); \
        *(LAS u64*)(STt + (32 * (vt0 + 1) + r32) * 136 + k0) = (u64)pk2(S1[4 * g4], S1[4 * g4 + 1]) | ((u64)pk2(S1[4 * g4 + 2], S1[4 * g4 + 3]) << 32); } } while (0)
    HG_WRITE_ST();
#pragma unroll 1
    for (int ch = 0; ch < nch; ++ch) {
        const int row0 = PROMPT ? b * SEQ + (g * HG_GS + ch) * 32 : MP + 4 * b, row = row0 + te;
        const bool valid = te < nvalid;
        float qs[8], kk[8]; v4u gz = {0u, 0u, 0u, 0u};
        {
            v4u zq = {0u, 0u, 0u, 0u}, zf = zq, zi = zq;
            if (valid) { const bf16* zr = Z + (size_t)row * ZC0 + h * 128 + k8;
                zq = *(const v4u*)zr; zf = *(const v4u*)(zr + 768); zi = *(const v4u*)(zr + 1536); if (!PROMPT) gz = *(const v4u*)(zr + 2304); }
            const unsigned qw[4] = {zq.x, zq.y, zq.z, zq.w}, fw[4] = {zf.x, zf.y, zf.z, zf.w}, iw[4] = {zi.x, zi.y, zi.z, zi.w};
            float lf[8];
#pragma unroll
            for (int j = 0; j < 8; ++j) { const float q = bf2f((qw[j >> 1] >> (16 * (j & 1))) & 0xffffu), fp = bf2f((fw[j >> 1] >> (16 * (j & 1))) & 0xffffu);
                const float sg = sigmoidf_(fp), f = lbv[j] + (1.0f - lbv[j]) * sg;
                qs[j] = valid ? q * sigmoidf_(q) : 0.f; kk[j] = valid ? (1.0f - f) : 0.f; lf[j] = valid ? __logf(f) : 0.f;
                VT[(k8 + j) * 40 + te] = (bf16)((iw[j >> 1] >> (16 * (j & 1))) & 0xffffu); }
            *(LAS f32x4*)(LF + te * 128 + k8) = (f32x4){lf[0], lf[1], lf[2], lf[3]}; *(LAS f32x4*)(LF + te * 128 + k8 + 4) = (f32x4){lf[4], lf[5], lf[6], lf[7]};
        }
        __syncthreads();
        if (tid < 128) { float bsum = 0.f;
#pragma unroll
            for (int t = 0; t < 32; ++t) { bsum += LF[t * 128 + tid]; LF[t * 128 + tid] = bsum; }
            BL[tid] = bsum; }
        __syncthreads();
        {
            const f32x4 b0 = *(const LAS f32x4*)(LF + te * 128 + k8), b1 = *(const LAS f32x4*)(LF + te * 128 + k8 + 4);
            const f32x4 l0 = *(const LAS f32x4*)(BL + k8), l1 = *(const LAS f32x4*)(BL + k8 + 4);
            const float bb[8] = {b0.x, b0.y, b0.z, b0.w, b1.x, b1.y, b1.z, b1.w}, bl[8] = {l0.x, l0.y, l0.z, l0.w, l1.x, l1.y, l1.z, l1.w};
            float qd[8], kd[8];
#pragma unroll
            for (int j = 0; j < 8; ++j) { qd[j] = qs[j] * __expf(bb[j]); kd[j] = kk[j] * __expf(-bb[j]); KET[(k8 + j) * 40 + te] = (bf16)f2bf(kk[j] * __expf(bl[j] - bb[j])); }
            v4u o; o.x = pk2(qd[0], qd[1]); o.y = pk2(qd[2], qd[3]); o.z = pk2(qd[4], qd[5]); o.w = pk2(qd[6], qd[7]); *(LAS v4u*)(QD + te * 136 + k8) = o;
            if (PROMPT) { const f32x4 f0 = *(const LAS f32x4*)(BOFF + k8), f1 = *(const LAS f32x4*)(BOFF + k8 + 4);
                const float bo[8] = {f0.x, f0.y, f0.z, f0.w, f1.x, f1.y, f1.z, f1.w}; float qc[8];
#pragma unroll
                for (int j = 0; j < 8; ++j) qc[j] = qd[j] * __expf(bo[j]);
                v4u oc; oc.x = pk2(qc[0], qc[1]); oc.y = pk2(qc[2], qc[3]); oc.z = pk2(qc[4], qc[5]); oc.w = pk2(qc[6], qc[7]);
                *(v4u*)((bf16*)(a.ws + WS_HQC) + (size_t)row * 768 + h * 128 + k8) = oc; }
            o.x = pk2(kd[0], kd[1]); o.y = pk2(kd[2], kd[3]); o.z = pk2(kd[4], kd[5]); o.w = pk2(kd[6], kd[7]); *(LAS v4u*)(KD + te * 136 + k8) = o;
            if (te == 0) {
#pragma unroll
                for (int j = 0; j < 8; ++j) DVv[k8 + j] = __expf(bl[j]); }
        }
        __syncthreads();
        f32x16 oacc = {};
        if (w == 0) { f32x16 z = {}; const f32x16 sc = mm32<128>(QD, 136, KD, 136, z, lane);
#pragma unroll
            for (int r = 0; r < 16; ++r) { const int t = crow(r, hh); SCB[t * 40 + r32] = (bf16)f2bf(r32 <= t ? sc[r] : 0.f); } }
        if (w < 4) oacc = mm32<128>(QD, 136, STt + (w * 32) * 136, 136, oacc, lane);
        if (PROMPT && tid >= 384) BOFF[tid - 384] += BL[tid - 384];
        __syncthreads();
        if (w < 4) { oacc = mm32<32>(SCB, 40, VT + (w * 32) * 40, 40, oacc, lane);
#pragma unroll
            for (int r = 0; r < 16; ++r) LF[crow(r, hh) * 128 + w * 32 + r32] = oacc[r]; }
        {
#pragma unroll
            for (int r = 0; r < 16; ++r) { const float d = DVv[32 * kt + crow(r, hh)]; S0[r] *= d; S1[r] *= d; }
            S0 = mm32<32>(KET + (kt * 32) * 40, 40, VT + (vt0 * 32) * 40, 40, S0, lane);
            S1 = mm32<32>(KET + (kt * 32) * 40, 40, VT + ((vt0 + 1) * 32) * 40, 40, S1, lane);
        }
        __syncthreads();
        HG_WRITE_ST();
        {
            const f32x4 o0 = *(const LAS f32x4*)(LF + te * 128 + k8), o1 = *(const LAS f32x4*)(LF + te * 128 + k8 + 4);
            if (PROMPT) { float* ol = (float*)(a.ws + WS_HOL) + (size_t)row * 768 + h * 128 + k8; *(f32x4*)ol = o0; *(f32x4*)(ol + 4) = o1; }
            else {
                float ov[8] = {o0.x, o0.y, o0.z, o0.w, o1.x, o1.y, o1.z, o1.w}; float s = 0.f;
#pragma unroll
                for (int j = 0; j < 8; ++j) s += ov[j] * ov[j];
                s += __shfl_xor(s, 1); s += __shfl_xor(s, 2); s += __shfl_xor(s, 4); s += __shfl_xor(s, 8);
                const float rs = rsqrtf(s * (1.0f / 128.0f) + EPS);
                const unsigned gw_[4] = {gz.x, gz.y, gz.z, gz.w}; float y[8];
#pragma unroll
                for (int j = 0; j < 8; ++j) { const float gg = bf2f((gw_[j >> 1] >> (16 * (j & 1))) & 0xffffu); y[j] = ov[j] * rs * onv[j] * (gg * sigmoidf_(gg)); }
                if (valid) { v4u o; o.x = pk2(y[0], y[1]); o.y = pk2(y[2], y[3]); o.z = pk2(y[4], y[5]); o.w = pk2(y[6], y[7]); *(v4u*)(MIX + (size_t)row * DM + h * 128 + k8) = o; }
            }
        }
        __syncthreads();
    }
#undef HG_WRITE_ST
    if (PROMPT) {
        float* ut = (float*)(a.ws + WS_HUT) + (size_t)unit * 16384;
#pragma unroll
        for (int g4 = 0; g4 < 4; ++g4) { const int k0 = 32 * kt + 8 * g4 + 4 * hh;
            *(f32x4*)(ut + (32 * vt0 + r32) * 128 + k0) = (f32x4){S0[4 * g4], S0[4 * g4 + 1], S0[4 * g4 + 2], S0[4 * g4 + 3]};
            *(f32x4*)(ut + (32 * (vt0 + 1) + r32) * 128 + k0) = (f32x4){S1[4 * g4], S1[4 * g4 + 1], S1[4 * g4 + 2], S1[4 * g4 + 3]}; }
        if (tid < 128) ((float*)(a.ws + WS_HDG))[(size_t)unit * 128 + tid] = __expf(BOFF[tid]);
    } else {
        float* so = a.out + O_HS + (size_t)(b * 6 + h) * 16384;
#pragma unroll
        for (int r = 0; r < 16; ++r) { const int k = 32 * kt + crow(r, hh); so[k * 128 + 32 * vt0 + r32] = S0[r]; so[k * 128 + 32 * (vt0 + 1) + r32] = S1[r]; }
    }
}
__device__ __forceinline__ void hgrn_scan(Ctx& c, const Args& a) {
    const float* UT = (const float*)(a.ws + WS_HUT); const float* DG = (const float*)(a.ws + WS_HDG); bf16* STo = (bf16*)(a.ws + WS_HST);
    for (int idx = c.vcu * 512 + c.tid; idx < 24 * 16384; idx += c.G * 512) {
        const int bh = idx >> 14, e = idx & 16383, k = e & 127, v = e >> 7;
        float s = 0.f;
#pragma unroll 8
        for (int g = 0; g < HG_NG; ++g) { const size_t u = (size_t)(bh * HG_NG + g); STo[u * 16384 + e] = (bf16)f2bf(s); s = DG[u * 128 + k] * s + UT[u * 16384 + e]; }
        a.out[O_HP + (size_t)bh * 16384 + k * 128 + v] = s;
    }
}
__device__ __forceinline__ void hgrn_fix_unit(Ctx& c, const Args& a, int b, int h, int g) {
    LAS bf16* STt = (LAS bf16*)(c.lds);
    LAS bf16* QCl = (LAS bf16*)(c.lds + 34816);
    LAS float* OB = (LAS float*)(c.lds + 34816 + 17408);
    int tid = c.tid; asm volatile("" : "+v"(tid));
    const int lane = tid & 63, w = c.wave, r32 = lane & 31, hh = lane >> 5;
    const int unit = (b * 6 + h) * HG_NG + g, row0 = b * SEQ + g * 128;
    const bf16* Z = (const bf16*)(a.ws + WS_Z); bf16* MIX = (bf16*)(a.ws + WS_MIX);
    const bf16* QC = (const bf16*)(a.ws + WS_HQC); const float* OL = (const float*)(a.ws + WS_HOL);
    const bf16* stg = (const bf16*)(a.ws + WS_HST) + (size_t)unit * 16384;
    __syncthreads();
#pragma unroll
    for (int i = 0; i < 4; ++i) { const int cidx = tid + 512 * i, v = cidx >> 4, kc = (cidx & 15) * 8; *(LAS v4u*)(STt + v * 136 + kc) = *(const v4u*)(stg + v * 128 + kc); }
    const int te = tid >> 4, k8 = (tid & 15) * 8;
    float onv[8];
#pragma unroll
    for (int j = 0; j < 8; ++j) onv[j] = a.in[15][k8 + j];
#pragma unroll 1
    for (int hf = 0; hf < 2; ++hf) {
        const int rb = row0 + hf * 64;
#pragma unroll
        for (int i = 0; i < 2; ++i) { const int cidx = tid + 512 * i, r = cidx >> 4, kc = (cidx & 15) * 8; *(LAS v4u*)(QCl + r * 136 + kc) = *(const v4u*)(QC + (size_t)(rb + r) * 768 + h * 128 + kc); }
        __syncthreads();
        { const int rt = w >> 2, vt = w & 3; f32x16 o = {};
          o = mm32<128>(QCl + (rt * 32) * 136, 136, STt + (vt * 32) * 136, 136, o, lane);
#pragma unroll
          for (int r = 0; r < 16; ++r) OB[(rt * 32 + crow(r, hh)) * 128 + vt * 32 + r32] = o[r]; }
        __syncthreads();
#pragma unroll
        for (int ps = 0; ps < 2; ++ps) { const int r = ps * 32 + te, row = rb + r;
            const f32x4 c0 = *(const LAS f32x4*)(OB + r * 128 + k8), c1 = *(const LAS f32x4*)(OB + r * 128 + k8 + 4);
            const float* ol = OL + (size_t)row * 768 + h * 128 + k8; const f32x4 l0 = *(const f32x4*)ol, l1 = *(const f32x4*)(ol + 4);
            const v4u gz = *(const v4u*)(Z + (size_t)row * ZC0 + 2304 + h * 128 + k8);
            float ov[8] = {c0.x + l0.x, c0.y + l0.y, c0.z + l0.z, c0.w + l0.w, c1.x + l1.x, c1.y + l1.y, c1.z + l1.z, c1.w + l1.w}; float s = 0.f;
#pragma unroll
            for (int j = 0; j < 8; ++j) s += ov[j] * ov[j];
            s += __shfl_xor(s, 1); s += __shfl_xor(s, 2); s += __shfl_xor(s, 4); s += __shfl_xor(s, 8);
            const float rs = rsqrtf(s * (1.0f / 128.0f) + EPS);
            const unsigned gw_[4] = {gz.x, gz.y, gz.z, gz.w}; float y[8];
#pragma unroll
            for (int j = 0; j < 8; ++j) { const float gg = bf2f((gw_[j >> 1] >> (16 * (j & 1))) & 0xffffu); y[j] = ov[j] * rs * onv[j] * (gg * sigmoidf_(gg)); }
            v4u o; o.x = pk2(y[0], y[1]); o.y = pk2(y[2], y[3]); o.z = pk2(y[4], y[5]); o.w = pk2(y[6], y[7]); *(v4u*)(MIX + (size_t)row * DM + h * 128 + k8) = o; }
        __syncthreads();
    }
}

__device__ __forceinline__ void memkv_finalize_row(const Args& a, int layer, int row, int lane) {
    const float* src = (const float*)(a.ws + WS_MEMKV) + (size_t)row * 1024 + layer * 512;
    const int hd = lane >> 4, d4 = (lane & 15) * 4;
    const f32x4 k = *(const f32x4*)(src + hd * 64 + d4), v = *(const f32x4*)(src + 256 + hd * 64 + d4);
    float s = (k.x * k.x + k.y * k.y) + (k.z * k.z + k.w * k.w);
    s += __shfl_xor(s, 1); s += __shfl_xor(s, 2); s += __shfl_xor(s, 4); s += __shfl_xor(s, 8);
    const float rs = rsqrtf(s * (1.0f / 64.0f) + EPS); const f32x4 g = *(const f32x4*)(a.in[22] + layer * 64 + d4);
    *(f32x4*)(a.out + O_MK + ((size_t)layer * 1024 + row) * 256 + hd * 64 + d4) = k * rs * g;
    *(f32x4*)(a.out + O_MV + ((size_t)layer * 1024 + row) * 256 + hd * 64 + d4) = v;
}

__device__ __forceinline__ void memattn_prompt_unit(Ctx& c, const Args& a, int layer, int u) {
    const int blk = u & 15, hd = (u >> 4) & 3, b = u >> 6;
    const bf16* Z = (const bf16*)(a.ws + WS_Z); const int ldz = layer ? ZC1 : ZC0, qc = layer ? Z1_MQ : 3072;
    const float* kv = (const float*)(a.ws + WS_MEMKV) + (size_t)(b * 256) * 1024 + layer * 512 + hd * 64;
    const int row0 = b * SEQ + blk * 256;
    memattn_unit(c, Z + (size_t)row0 * ldz + qc + hd * 64, ldz, 256, kv, kv + 256, 1024, true, a.in[22] + layer * 64, a.in[21] + layer * 64,
                 (bf16*)(a.ws + WS_MIX) + (size_t)row0 * DM + 768 + hd * 64);
}
__device__ __forceinline__ void memattn_sample_unit(Ctx& c, const Args& a, int layer, int u) {
    const int hd = u & 3, sb = u >> 2;
    const bf16* Z = (const bf16*)(a.ws + WS_Z); const int ldz = layer ? ZC1 : ZC0, qc = layer ? Z1_MQ : 3072;
    const size_t off = ((size_t)(layer * 32 + sb) * 256) * 256 + hd * 64;
    const int row0 = MP + sb * 4;
    memattn_unit(c, Z + (size_t)row0 * ldz + qc + hd * 64, ldz, 4, a.in[5] + off, a.in[6] + off, 256, false, nullptr, a.in[21] + layer * 64,
                 (bf16*)(a.ws + WS_MIX) + (size_t)row0 * DM + 768 + hd * 64);
}

__device__ __forceinline__ void p2_mixer0(Ctx& c, const Args& a) {
    constexpr int U_HP = 24 * HG_NG, U_MAP = U_HP + 256, U_HS = U_MAP + 192, U_MAS = U_HS + 128, U_FIN = U_MAS + 256;
    for (;;) {
        const int u = q_next(c, 0);
        if (u >= U_FIN) break;
        if (u < U_HP) hgrn_unit<true>(c, a, u / (6 * HG_NG), (u / HG_NG) % 6, u % HG_NG);
        else if (u < U_MAP) memattn_prompt_unit(c, a, 0, u - U_HP);
        else if (u < U_HS) { const int v = u - U_MAP; hgrn_unit<false>(c, a, v / 6, v % 6, 0); }
        else if (u < U_MAS) memattn_sample_unit(c, a, 0, u - U_HS);
        else { const int v = (u - U_MAS) * 8 + c.wave; memkv_finalize_row(a, v >> 10, v & 1023, c.lane); }
    }
}
__device__ __forceinline__ void p2c_hgrn_fix(Ctx& c, const Args& a) {
    for (int u = c.vcu; u < 24 * HG_NG; u += c.G) hgrn_fix_unit(c, a, u / (6 * HG_NG), (u / HG_NG) % 6, u % HG_NG);
}

constexpr size_t WS_G4 = WS_UP + 64 * MiB, WS_UP2 = WS_UP + 80 * MiB;
__device__ __forceinline__ void conv_fixup_tile(Ctx& c, const Args& a, int layer, int pm) {
    const float* G4 = (const float*)(a.ws + WS_G4); const float* UP2 = (const float*)(a.ws + WS_UP2); bf16* ACT = (bf16*)(a.ws + WS_ACT);
    const float* cw = a.in[26] + (size_t)layer * 3 * DFF; const float* cb = a.in[27] + (size_t)layer * DFF;
    for (int idx = c.tid; idx < 8 * (DFF / 4); idx += 512) {
        const int rr = idx / (DFF / 4), c4 = (idx - rr * (DFF / 4)) * 4;
        const int slab = 4 * pm + (rr >> 1), fr = rr & 1, row = slab * 64 + fr, t = row & 4095, sl1 = slab > 0 ? slab - 1 : 0;
        const f32x4 ut = *(const f32x4*)(G4 + (size_t)(slab * 4 + fr) * DFF + c4), up = *(const f32x4*)(UP2 + (size_t)(slab * 2 + fr) * DFF + c4);
        const f32x4 a0 = *(const f32x4*)(G4 + (size_t)(slab * 4 + 0) * DFF + c4), b3 = *(const f32x4*)(G4 + (size_t)(sl1 * 4 + 3) * DFF + c4), b2 = *(const f32x4*)(G4 + (size_t)(sl1 * 4 + 2) * DFF + c4);
        f32x4 u1, u2;
        { const bool f1 = fr == 1, t0 = t == 0, t1 = t == 1;
          u1.x = f1 ? a0.x : (t0 ? 0.f : b3.x); u1.y = f1 ? a0.y : (t0 ? 0.f : b3.y); u1.z = f1 ? a0.z : (t0 ? 0.f : b3.z); u1.w = f1 ? a0.w : (t0 ? 0.f : b3.w);
          u2.x = f1 ? (t1 ? 0.f : b3.x) : (t0 ? 0.f : b2.x); u2.y = f1 ? (t1 ? 0.f : b3.y) : (t0 ? 0.f : b2.y); u2.z = f1 ? (t1 ? 0.f : b3.z) : (t0 ? 0.f : b2.z); u2.w = f1 ? (t1 ? 0.f : b3.w) : (t0 ? 0.f : b2.w); }
        const f32x4 w0 = *(const f32x4*)(cw + c4), w1 = *(const f32x4*)(cw + DFF + c4), w2 = *(const f32x4*)(cw + 2 * DFF + c4), bb = *(const f32x4*)(cb + c4);
        const f32x4 cv = bb + w0 * u2 + w1 * u1 + w2 * ut;
        const float y0 = cv.x * sigmoidf_(cv.x) * up.x, y1 = cv.y * sigmoidf_(cv.y) * up.y, y2 = cv.z * sigmoidf_(cv.z) * up.z, y3 = cv.w * sigmoidf_(cv.w) * up.w;
        *(u64*)(ACT + (size_t)row * DFF + c4) = (u64)pk2(y0, y1) | ((u64)pk2(y2, y3) << 32);
    }
}


struct SgArgs { const bf16* A; const bf16* Bt; int K; int mode; bf16* Z; int ldz; const float* ssin; const float* resid; float* y; bf16* xb; float* ssout; bf16* ACT; float* cvs; const float* cst; const float* cw; const float* cb; };
__device__ __forceinline__ void sgemm_unit(Ctx& c, const SgArgs& g, int n0) {
    int tid = c.tid; asm volatile("" : "+v"(tid));
    const int lane = tid & 63, w = c.wave, r32 = lane & 31, hh = lane >> 5;
    const int K = g.K, ks = K >> 3;
    const int f2 = (n0 >> 1) + (r32 & 15), brow = g.mode == 2 ? (f2 >> 7) * 256 + (f2 & 127) + (r32 >= 16 ? 128 : 0) : n0 + r32;
    const bf16* bp = g.Bt + (size_t)brow * K + w * ks + 8 * hh;
    const bf16* ap = g.A + (size_t)r32 * K + w * ks + 8 * hh;
    f32x16 acc[4] = {};
    bf16x8 afA[4][2], bfA[2], afB[4][2], bfB[2];
#define SG_LOAD(AF, BF, kk) do { _Pragma("unroll") for (int i = 0; i < 2; ++i) { BF[i] = *(const bf16x8*)(bp + (kk) + 16 * i); \
        _Pragma("unroll") for (int rt = 0; rt < 4; ++rt) AF[rt][i] = *(const bf16x8*)(ap + (size_t)(rt * 32) * K + (kk) + 16 * i); } } while (0)
#define SG_MMA(AF, BF) do { _Pragma("unroll") for (int i = 0; i < 2; ++i) _Pragma("unroll") for (int rt = 0; rt < 4; ++rt) acc[rt] = __builtin_amdgcn_mfma_f32_32x32x16_bf16(AF[rt][i], BF[i], acc[rt], 0, 0, 0); } while (0)
    SG_LOAD(afA, bfA, 0);
#pragma unroll 1
    for (int k = 0; k < ks; k += 64) {
        if (k + 32 < ks) SG_LOAD(afB, bfB, k + 32);
        SG_MMA(afA, bfA);
        if (k + 32 < ks) { if (k + 64 < ks) SG_LOAD(afA, bfA, k + 64); SG_MMA(afB, bfB); }
    }
#undef SG_LOAD
#undef SG_MMA
    LAS float* RED = (LAS float*)(c.lds);
    __syncthreads();
#pragma unroll
    for (int rt = 0; rt < 4; ++rt)
#pragma unroll
        for (int r = 0; r < 16; ++r) RED[((w * 4 + rt) * 16 + r) * 64 + lane] = acc[rt][r];
    __syncthreads();
    const int rt = w & 3, rh = w >> 2, col = n0 + r32;
    float v[8];
#pragma unroll
    for (int i = 0; i < 8; ++i) { float s = 0.f;
#pragma unroll
        for (int ww = 0; ww < 8; ++ww) s += RED[((ww * 4 + rt) * 16 + 8 * rh + i) * 64 + lane];
        v[i] = s; }
    if (g.mode == 0) {
#pragma unroll
        for (int i = 0; i < 8; ++i) { const int row = MP + rt * 32 + crow(8 * rh + i, hh); const float rs = rsqrtf(g.ssin[row] * (1.0f / DM) + EPS); g.Z[(size_t)row * g.ldz + col] = (bf16)f2bf(v[i] * rs); }
    } else if (g.mode == 1) {
#pragma unroll
        for (int i = 0; i < 8; ++i) { const int lr = rt * 32 + crow(8 * rh + i, hh), row = MP + lr; const float x = v[i] + g.resid[(size_t)lr * DM + col];
            g.y[(size_t)lr * DM + col] = x; if (g.xb) g.xb[(size_t)row * DM + col] = (bf16)f2bf(x);
            float s = x * x; s += __shfl_xor(s, 1); s += __shfl_xor(s, 2); s += __shfl_xor(s, 4); s += __shfl_xor(s, 8); s += __shfl_xor(s, 16);
            if (g.ssout && r32 == 0) atomicAdd(g.ssout + row, s); }
    } else {
        float gu[8], upv[8];
#pragma unroll
        for (int i = 0; i < 8; ++i) { const int row = MP + rt * 32 + crow(8 * rh + i, hh); gu[i] = v[i] * rsqrtf(g.ssin[row] * (1.0f / DM) + EPS); upv[i] = __shfl_xor(gu[i], 16); }
        if (r32 < 16) { const float w0 = g.cw[f2], w1 = g.cw[DFF + f2], w2 = g.cw[2 * DFF + f2], bb = g.cb[f2];
#pragma unroll
            for (int aa = 0; aa < 2; ++aa) { const int lr0 = rt * 32 + 8 * (2 * rh + aa) + 4 * hh, sb = lr0 >> 2;
                const float s0 = g.cst[(size_t)(sb * 2) * DFF + f2], s1 = g.cst[(size_t)(sb * 2 + 1) * DFF + f2];
                const float u0 = gu[4 * aa], u1 = gu[4 * aa + 1], u2 = gu[4 * aa + 2], u3 = gu[4 * aa + 3];
                const float cv[4] = {bb + w0 * s0 + w1 * s1 + w2 * u0, bb + w0 * s1 + w1 * u0 + w2 * u1, bb + w0 * u0 + w1 * u1 + w2 * u2, bb + w0 * u1 + w1 * u2 + w2 * u3};
#pragma unroll
                for (int t = 0; t < 4; ++t) g.ACT[(size_t)(MP + lr0 + t) * DFF + f2] = (bf16)f2bf(cv[t] * sigmoidf_(cv[t]) * upv[4 * aa + t]);
                g.cvs[(size_t)(sb * 2) * DFF + f2] = u2; g.cvs[(size_t)(sb * 2 + 1) * DFF + f2] = u3; } }
    }
}
__device__ __forceinline__ void sgemm_phase(Ctx& c, const SgArgs& g, int N) {
#pragma unroll 1
    for (int u = c.G - 1 - (int)blockIdx.x; u < N / 32; u += c.G) sgemm_unit(c, g, u * 32);
}


__device__ __forceinline__ float wave_sum_f(float x) {
    x += __builtin_bit_cast(float, __builtin_amdgcn_update_dpp(0, __builtin_bit_cast(int, x), 0xB1, 0xF, 0xF, false));
    x += __builtin_bit_cast(float, __builtin_amdgcn_update_dpp(0, __builtin_bit_cast(int, x), 0x4E, 0xF, 0xF, false));
    x += __builtin_bit_cast(float, __builtin_amdgcn_update_dpp(0, __builtin_bit_cast(int, x), 0x141, 0xF, 0xF, false));
    x += __builtin_bit_cast(float, __builtin_amdgcn_update_dpp(0, __builtin_bit_cast(int, x), 0x140, 0xF, 0xF, false));
    const int xi = __builtin_bit_cast(int, x);
    return (__builtin_bit_cast(float, __builtin_amdgcn_readlane(xi, 0)) + __builtin_bit_cast(float, __builtin_amdgcn_readlane(xi, 16))) +
           (__builtin_bit_cast(float, __builtin_amdgcn_readlane(xi, 32)) + __builtin_bit_cast(float, __builtin_amdgcn_readlane(xi, 48)));
}
__device__ __forceinline__ void dsa_post_row(const Args& a, int row, int lane_) {
    int lane = lane_; asm volatile("" : "+v"(lane));
    const bf16* z = (const bf16*)(a.ws + WS_Z) + (size_t)row * ZC1;
    const bool smp = row >= MP; const int b = smp ? (row - MP) >> 2 : row >> 12, t = smp ? (row - MP) & 3 : row & 4095;
    const float pos = (float)(smp ? PAST + t : t);
    const int i = lane & 31;
    float x1[8], x2[8], q1[4], q2[4], k1 = 0.f, k2 = 0.f;
#pragma unroll
    for (int hd = 0; hd < 8; ++hd) { x1[hd] = bf2f(z[hd * 128 + lane]); x2[hd] = bf2f(z[hd * 128 + 64 + lane]); }
    const u64 vv = *(const u64*)(z + Z1_V + 4 * lane);
#pragma unroll
    for (int p = 0; p < 4; ++p) { const int hd = 2 * p + (lane >> 5); q1[p] = bf2f(z[Z1_IQ + hd * 64 + i]); q2[p] = bf2f(z[Z1_IQ + hd * 64 + 32 + i]); }
    if (lane < 32) { k1 = bf2f(z[Z1_IK + i]); k2 = bf2f(z[Z1_IK + 32 + i]); }
    const float wraw = bf2f(z[Z1_IW + (lane & 7)]);
    float c128, s128, c64, s64;
    { const float r1 = pos * (exp2f(-(float)lane * (13.287712379549449f / 64.0f)) * 0.15915494309189535f), f1 = r1 - floorf(r1); s128 = __builtin_amdgcn_sinf(f1); c128 = __builtin_amdgcn_cosf(f1);
      const float r2 = pos * (exp2f(-(float)i * (13.287712379549449f / 32.0f)) * 0.15915494309189535f), f2 = r2 - floorf(r2); s64 = __builtin_amdgcn_sinf(f2); c64 = __builtin_amdgcn_cosf(f2); }
#pragma unroll
    for (int hd = 0; hd < 8; ++hd) {
        const float rs = rsqrtf(wave_sum_f(x1[hd] * x1[hd] + x2[hd] * x2[hd]) * (1.0f / 128.0f) + EPS);
        const float* gn = hd < 6 ? a.in[17] : a.in[18];
        const float y1 = x1[hd] * rs * gn[lane], y2 = x2[hd] * rs * gn[64 + lane];
        const float o1 = y1 * c128 - y2 * s128, o2 = y2 * c128 + y1 * s128;
        if (hd < 6) {
            if (smp) { float* q = (float*)(a.ws + WS_SQ) + (size_t)(row - MP) * 768 + hd * 128; q[lane] = o1; q[64 + lane] = o2; }
            else { bf16* q = (bf16*)(a.ws + WS_QB) + ((size_t)(b * 6 + hd) * SEQ + t) * 128; q[lane] = (bf16)f2bf(o1); q[64 + lane] = (bf16)f2bf(o2); }
        } else {
            const int kvh = hd - 6;
            float* ko = smp ? a.out + O_KS + (size_t)(row - MP) * 256 + kvh * 128 : a.out + O_KP + (size_t)row * 256 + kvh * 128;
            ko[lane] = o1; ko[64 + lane] = o2;
            if (!smp) { bf16* kb = (bf16*)(a.ws + WS_KB) + ((size_t)(b * 2 + kvh) * SEQ + t) * 128; kb[lane] = (bf16)f2bf(o1); kb[64 + lane] = (bf16)f2bf(o2); }
        }
    }
    {
        const f32x4 v = {bf2f((unsigned)vv & 0xffffu), bf2f(((unsigned)vv) >> 16), bf2f((unsigned)(vv >> 32) & 0xffffu), bf2f((unsigned)(vv >> 48))};
        float* vo = smp ? a.out + O_VS + (size_t)(row - MP) * 256 : a.out + O_VP + (size_t)row * 256;
        *(f32x4*)(vo + 4 * lane) = v;
        if (!smp) { const int kvh = lane >> 5, d = (lane & 31) * 4; *(u64*)((bf16*)(a.ws + WS_VB) + ((size_t)(b * 2 + kvh) * SEQ + t) * 128 + d) = vv; }
    }
    {
#pragma unroll
        for (int p = 0; p < 4; ++p) { const int hd = 2 * p + (lane >> 5);
            const float o1 = q1[p] * c64 - q2[p] * s64, o2 = q2[p] * c64 + q1[p] * s64;
            if (smp) { float* q = (float*)(a.ws + WS_SIQ) + (size_t)(row - MP) * 512 + hd * 64; q[i] = o1; q[32 + i] = o2; }
            else { bf16* q = (bf16*)(a.ws + WS_IQB) + (size_t)row * 512 + hd * 64; q[i] = (bf16)f2bf(o1); q[32 + i] = (bf16)f2bf(o2); } }
        const float rs = rsqrtf(wave_sum_f(k1 * k1 + k2 * k2) * (1.0f / 64.0f) + EPS);
        const float y1 = k1 * rs * a.in[19][i], y2 = k2 * rs * a.in[19][32 + i];
        const float o1 = y1 * c64 - y2 * s64, o2 = y2 * c64 + y1 * s64;
        if (lane < 32) {
            float* ko = smp ? a.out + O_IKS + (size_t)(row - MP) * 64 : a.out + O_IKP + (size_t)row * 64; ko[i] = o1; ko[32 + i] = o2;
            if (!smp) { bf16* kb = (bf16*)(a.ws + WS_IKB) + (size_t)row * 64; kb[i] = (bf16)f2bf(o1); kb[32 + i] = (bf16)f2bf(o2); } }
        if (lane < 8) { const float wv = wraw * (0.35355339059327373f * 0.125f);
            if (smp) ((float*)(a.ws + WS_SIW))[(row - MP) * 8 + lane] = wv; else ((float*)(a.ws + WS_IW))[(size_t)row * 8 + lane] = wv; }
    }
}
__device__ __forceinline__ void p8_dsa_post(Ctx& c, const Args& a) {
    for (;;) { const int u = q_next(c, 1); if (u >= 384) break; if (u < 256) memattn_prompt_unit(c, a, 1, u); else memattn_sample_unit(c, a, 1, u - 256); }
    const int gw = c.vcu * NWAVES + c.wave, NGW = c.G * NWAVES;
    for (int row = gw; row < MVALID; row += NGW) dsa_post_row(a, row, c.lane);
}

__device__ __forceinline__ void idx_prompt_unit(Ctx& c, const Args& a, int b, int qb) {
    int tid = c.tid; asm volatile("" : "+v"(tid));
    const int lane = tid & 63, r32 = lane & 31, hh = lane >> 5, w = c.wave;
    const int q0 = b * SEQ + qb * 32;
    LAS bf16* IQL = (LAS bf16*)(c.lds);
    { const bf16* src = (const bf16*)(a.ws + WS_IQB) + (size_t)q0 * 512;
#pragma unroll
      for (int i = 0; i < 4; ++i) { const int row = tid >> 4, ch = (tid & 15) + 16 * i; *(LAS v4u*)(IQL + row * 520 + ch * 8) = *(const v4u*)(src + (size_t)row * 512 + ch * 8); } }
    __syncthreads();
    const bf16* IK = (const bf16*)(a.ws + WS_IKB) + (size_t)(b * SEQ) * 64 + (size_t)r32 * 64 + 8 * hh;
    float* SC = (float*)(a.ws + WS_SC) + (size_t)(q0 + r32) * SEQ;
    float wv[8];
#pragma unroll
    for (int h = 0; h < 8; ++h) wv[h] = ((const float*)(a.ws + WS_IW))[(size_t)(q0 + r32) * 8 + h];
    bf16x8 ak[4], an[4];
    if (w <= qb) {
#pragma unroll
        for (int ks = 0; ks < 4; ++ks) ak[ks] = *(const bf16x8*)(IK + (size_t)(w * 32) * 64 + ks * 16); }
#pragma unroll 1
    for (int kt = w; kt <= qb; kt += 8) {
        if (kt + 8 <= qb) {
#pragma unroll
            for (int ks = 0; ks < 4; ++ks) an[ks] = *(const bf16x8*)(IK + (size_t)((kt + 8) * 32) * 64 + ks * 16); }
        f32x16 sc = {};
        int qoff = r32 * 520 + 8 * hh; asm volatile("" : "+v"(qoff));
#pragma unroll
        for (int h = 0; h < 8; ++h) { f32x16 d = {};
#pragma unroll
            for (int ks = 0; ks < 4; ++ks) d = __builtin_amdgcn_mfma_f32_32x32x16_bf16(ak[ks], *(const LAS bf16x8*)(IQL + qoff + h * 64 + ks * 16), d, 0, 0, 0);
#pragma unroll
            for (int r = 0; r < 16; ++r) sc[r] = fmaf(wv[h], fmaxf(d[r], 0.f), sc[r]); }
#pragma unroll
        for (int g = 0; g < 4; ++g) *(f32x4*)(SC + kt * 32 + 8 * g + 4 * hh) = (f32x4){sc[4 * g], sc[4 * g + 1], sc[4 * g + 2], sc[4 * g + 3]};
#pragma unroll
        for (int ks = 0; ks < 4; ++ks) ak[ks] = an[ks];
    }
}
__device__ __forceinline__ v4u pack8f(const float* p) { const f32x4 x = *(const f32x4*)p, y = *(const f32x4*)(p + 4); v4u o; o.x = pk2(x.x, x.y); o.y = pk2(x.z, x.w); o.z = pk2(y.x, y.y); o.w = pk2(y.z, y.w); return o; }
__device__ __forceinline__ void idx_sample_tile(const Args& a, int sb, int tl, int lane_) {
    int lane = lane_; asm volatile("" : "+v"(lane));
    const int r32 = lane & 31, hh = lane >> 5, tk = r32 >> 3, hd = r32 & 7;
    const float* iq = (const float*)(a.ws + WS_SIQ) + (size_t)(sb * 4 + tk) * 512 + hd * 64 + 8 * hh;
    const float wv = ((const float*)(a.ws + WS_SIW))[(sb * 4 + tk) * 8 + hd];
    const float* src;
    if (tl < 256) src = a.in[4] + ((size_t)a.page_table[sb * 64 + (tl >> 2)] * 128 + (tl & 3) * 32 + r32) * 64 + 8 * hh;
    else src = a.out + O_IKS + (size_t)(sb * 4 + (r32 & 3)) * 64 + 8 * hh;
    v4u af[4], bf_[4];
#pragma unroll
    for (int ks = 0; ks < 4; ++ks) { af[ks] = pack8f(src + 16 * ks); bf_[ks] = pack8f(iq + 16 * ks); }
    if (tl == 256 && r32 >= 4) {
#pragma unroll
        for (int ks = 0; ks < 4; ++ks) af[ks] = (v4u){0u, 0u, 0u, 0u}; }
    f32x16 d = {};
#pragma unroll
    for (int ks = 0; ks < 4; ++ks) d = __builtin_amdgcn_mfma_f32_32x32x16_bf16(__builtin_bit_cast(bf16x8, af[ks]), __builtin_bit_cast(bf16x8, bf_[ks]), d, 0, 0, 0);
    float* dst = (float*)(a.ws + WS_SSC) + (size_t)(sb * 4 + tk) * SSC_LD + tl * 32;
#pragma unroll
    for (int r = 0; r < 16; ++r) { float v = wv * fmaxf(d[r], 0.f);
        v += __builtin_bit_cast(float, __builtin_amdgcn_update_dpp(0, __builtin_bit_cast(int, v), 0xB1, 0xF, 0xF, false));
        v += __builtin_bit_cast(float, __builtin_amdgcn_update_dpp(0, __builtin_bit_cast(int, v), 0x4E, 0xF, 0xF, false));
        v += __builtin_bit_cast(float, __builtin_amdgcn_update_dpp(0, __builtin_bit_cast(int, v), 0x141, 0xF, 0xF, false));
        if (hd == 0) dst[crow(r, hh)] = v; }
}
__device__ __forceinline__ void p9_indexer(Ctx& c, const Args& a) {
    const int gw = c.vcu * NWAVES + c.wave, NGW = c.G * NWAVES;
#pragma unroll 1
    for (int wt = gw; wt < 32 * 257; wt += NGW) idx_sample_tile(a, wt / 257, wt % 257, c.lane);
    for (;;) { const int u = q_next(c, 2); if (u >= 512) break; idx_prompt_unit(c, a, u & 3, 127 - (u >> 2)); }
}


__device__ __forceinline__ unsigned fkey(float f) { const unsigned u = __builtin_bit_cast(unsigned, f + 0.0f); return (u & 0x80000000u) ? ~u : (u | 0x80000000u); }
__device__ __forceinline__ void acc_ge(int& cnt, unsigned key, unsigned cand) { asm volatile("v_cmp_le_u32_e32 vcc, %1, %2\n\tv_addc_co_u32_e32 %0, vcc, 0, %0, vcc" : "+v"(cnt) : "s"(cand), "v"(key) : "vcc"); }
__device__ __forceinline__ void acc_ge4(int& c0, int& c1, int& c2, int& c3, unsigned k0, unsigned k1, unsigned k2, unsigned k3, unsigned cand) {
    u64 m0, m1, m2, m3;
    asm volatile("v_cmp_le_u32_e64 %4, %8, %9\n\tv_cmp_le_u32_e64 %5, %8, %10\n\tv_cmp_le_u32_e64 %6, %8, %11\n\tv_cmp_le_u32_e64 %7, %8, %12\n\t"
                 "v_addc_co_u32_e64 %0, %4, 0, %0, %4\n\tv_addc_co_u32_e64 %1, %5, 0, %1, %5\n\tv_addc_co_u32_e64 %2, %6, 0, %2, %6\n\tv_addc_co_u32_e64 %3, %7, 0, %3, %7"
                 : "+v"(c0), "+v"(c1), "+v"(c2), "+v"(c3), "=&s"(m0), "=&s"(m1), "=&s"(m2), "=&s"(m3) : "s"(cand), "v"(k0), "v"(k1), "v"(k2), "v"(k3));
}
__device__ __forceinline__ u64 ballot_nz(unsigned v) { u64 m; asm volatile("v_cmp_ne_u32_e64 %0, 0, %1" : "=s"(m) : "v"(v)); return m; }
__device__ __forceinline__ int wave_sum_dpp(int x) {
    x += __builtin_amdgcn_update_dpp(0, x, 0xB1, 0xF, 0xF, false);
    x += __builtin_amdgcn_update_dpp(0, x, 0x4E, 0xF, 0xF, false);
    x += __builtin_amdgcn_update_dpp(0, x, 0x141, 0xF, 0xF, false);
    x += __builtin_amdgcn_update_dpp(0, x, 0x140, 0xF, 0xF, false);
    return (__builtin_amdgcn_readlane(x, 0) + __builtin_amdgcn_readlane(x, 16)) + (__builtin_amdgcn_readlane(x, 32) + __builtin_amdgcn_readlane(x, 48));
}
__device__ __forceinline__ int mbcnt64(u64 m) { return (int)__builtin_amdgcn_mbcnt_hi((unsigned)(m >> 32), __builtin_amdgcn_mbcnt_lo((unsigned)m, 0u)); }
constexpr int TK_LOWBITS = 18;
__device__ __forceinline__ void topk_finish(unsigned ck, int cp, int A, int posmax, unsigned& T, int& P) {
#pragma unroll 1
    for (int bit = TK_LOWBITS - 1; bit >= 0; --bit) { const unsigned cand = T | (1u << bit); if (A + __builtin_popcountll(__ballot(ck >= cand)) >= 256) T = cand; }
    const int need = 256 - (A + __builtin_popcountll(__ballot(ck > T))), ceq = __builtin_popcountll(__ballot(ck == T));
    P = posmax;
    if (ceq != need) { P = 0;
#pragma unroll 1
        for (int bit = 13; bit >= 0; --bit) { const int cand = P | (1 << bit); if (__builtin_popcountll(__ballot(ck == T && cp < cand)) < need) P = cand; } }
}
__device__ __forceinline__ void topk_prompt_rows(const Args& a, int row0, int stride, int lane_, LAS unsigned* cl  ) {
    int lane = lane_; asm volatile("" : "+v"(lane));
    const float* SCb = (const float*)(a.ws + WS_SC);
#define TK_NEEDS(r) ((r) < MP && ((r) & 4095) >= 256)
#define TK_PREFETCH(r) do { const float* sc_ = SCb + (size_t)(r) * SEQ + lane; const int tj_ = ((r) & 4095) >> 6; _Pragma("unroll") for (int j = 0; j < 64; ++j) nx[j] = sc_[64 * (j < tj_ ? j : tj_)]; } while (0)
#pragma unroll 1
    for (int row = row0; row < MP; row += stride) {
        const int t = row & 4095;
        u64* mk = (u64*)(a.ws + WS_MASK) + (size_t)row * 64;
        u64 myword = 0ull;
        if (t < 256) {
#pragma unroll 1
            for (int j = 0; j < 64; ++j) { const u64 m = __ballot(64 * j + lane <= t); if (lane == j) myword = m; }
            mk[lane] = myword;
            continue; }
        unsigned key[64];
        { const float* sc_ = SCb + (size_t)row * SEQ + lane; const int tj_ = t >> 6;
          float v[64];
#pragma unroll
          for (int j = 0; j < 64; ++j) v[j] = sc_[64 * (j < tj_ ? j : tj_)];
          int pj = lane;
#pragma unroll
          for (int j = 0; j < 64; ++j) { key[j] = (pj <= t) ? fkey(v[j]) : 0u; pj += 64; asm volatile("" : "+v"(pj)); } }
#define TK_FULLCOUNT(CAND, OUT) do { const unsigned cs_ = __builtin_amdgcn_readfirstlane(CAND); int c0_ = 0, c1_ = 0, c2_ = 0, c3_ = 0; \
        _Pragma("unroll") for (int j = 0; j < 64; j += 4) acc_ge4(c0_, c1_, c2_, c3_, key[j], key[j + 1], key[j + 2], key[j + 3], cs_); OUT = wave_sum_dpp((c0_ + c1_) + (c2_ + c3_)); } while (0)
        unsigned T = 0u;
#pragma unroll 1
        for (int bit = 31; bit >= TK_LOWBITS; --bit) { const unsigned cand = T | (1u << bit); int tot; TK_FULLCOUNT(cand, tot); if (tot >= 256) T = cand; }
        const unsigned hib = T + (1u << TK_LOWBITS);
        int A = 0, cT; if (hib != 0u) TK_FULLCOUNT(hib, A); TK_FULLCOUNT(T, cT);
        int P;
        if (cT - A <= 64) {
            int base = 0;
            int pj = lane;
#pragma unroll
            for (int j = 0; j < 64; ++j) { const unsigned und = (key[j] - T) < (1u << TK_LOWBITS) ? 1u : 0u; const u64 m = ballot_nz(und); const int pos = base + mbcnt64(m);
                if (und) { cl[pos] = key[j]; cl[64 + pos] = (unsigned)pj; }
                base += __builtin_popcountll(m); pj += 64; asm volatile("" : "+s"(base), "+v"(pj)); }
            const unsigned ck = lane < base ? cl[lane] : 0u; const int cp = (int)cl[64 + lane];
            topk_finish(ck, cp, A, 4095, T, P);
        } else {
#pragma unroll 1
            for (int bit = TK_LOWBITS - 1; bit >= 0; --bit) { const unsigned cand = T | (1u << bit); int tot; TK_FULLCOUNT(cand, tot); if (tot >= 256) T = cand; }
            int cge, cgt; TK_FULLCOUNT(T, cge); cgt = 0; if (T != 0xffffffffu) TK_FULLCOUNT(T + 1u, cgt);
            const int need = 256 - cgt, ceq = cge - cgt; P = 4095;
            if (ceq != need) { P = 0;
#pragma unroll 1
                for (int bit = 11; bit >= 0; --bit) { const int cand = P | (1 << bit); int cnt = 0; int pj = lane;
#pragma unroll
                    for (int j = 0; j < 64; ++j) { cnt += (key[j] == T && pj < cand) ? 1 : 0; pj += 64; asm volatile("" : "+v"(pj)); }
                    if (wave_sum_dpp(cnt) < need) P = cand; } }
        }
#undef TK_FULLCOUNT
        int pq = lane;
#pragma unroll
        for (int j = 0; j < 64; ++j) { const unsigned selv = (key[j] > T || (key[j] == T && pq <= P)) ? 1u : 0u; const u64 m = ballot_nz(selv); if (lane == j) myword = m; pq += 64; asm volatile("" : "+v"(myword), "+v"(pq)); }
        mk[lane] = myword;
    }
#undef TK_NEEDS
#undef TK_PREFETCH
}
__device__ __forceinline__ void topk_sample_row(const Args& a, int q, int lane_, LAS unsigned* K, LAS unsigned* cl) {
    int lane = lane_; asm volatile("" : "+v"(lane));
    const int t = q & 3, n = PAST + t + 1; const float* sc = (const float*)(a.ws + WS_SSC) + (size_t)q * SSC_LD;
    int* out = (int*)(a.ws + WS_SIDX) + q * 256;
    unsigned key[129];
#pragma unroll
    for (int j = 0; j < 129; ++j) { const float v = sc[64 * j + lane]; key[j] = (j < 128 || lane < n - 8192) ? fkey(v) : 0u; }
#pragma unroll
    for (int j = 0; j < 129; ++j) K[64 * j + lane] = key[j];
#define TK_FULLCOUNT(CAND, OUT) do { const unsigned cs_ = __builtin_amdgcn_readfirstlane(CAND); int c0_ = 0, c1_ = 0, c2_ = 0, c3_ = 0; \
        _Pragma("unroll") for (int j = 0; j < 128; j += 4) acc_ge4(c0_, c1_, c2_, c3_, key[j], key[j + 1], key[j + 2], key[j + 3], cs_); acc_ge(c0_, key[128], cs_); OUT = wave_sum_dpp((c0_ + c1_) + (c2_ + c3_)); } while (0)
    unsigned T = 0u;
#pragma unroll 1
    for (int bit = 31; bit >= TK_LOWBITS; --bit) { const unsigned cand = T | (1u << bit); int tot; TK_FULLCOUNT(cand, tot); if (tot >= 256) T = cand; }
    const unsigned hib = T + (1u << TK_LOWBITS);
    int A = 0, cT; if (hib != 0u) TK_FULLCOUNT(hib, A); TK_FULLCOUNT(T, cT);
    int P;
    if (cT - A <= 64) {
        int base = 0;
#pragma unroll 1
        for (int j0 = 0; j0 < 128; j0 += 8) { unsigned kk[8];
#pragma unroll
            for (int i = 0; i < 8; ++i) kk[i] = K[64 * (j0 + i) + lane];
#pragma unroll
            for (int i = 0; i < 8; ++i) { const unsigned und = (kk[i] - T) < (1u << TK_LOWBITS) ? 1u : 0u; const u64 m = ballot_nz(und); const int pos = base + mbcnt64(m);
                if (und) { cl[pos] = kk[i]; cl[64 + pos] = (unsigned)(64 * (j0 + i) + lane); }
                base += __builtin_popcountll(m); } }
        { const unsigned kj = K[64 * 128 + lane]; const unsigned und = (kj - T) < (1u << TK_LOWBITS) ? 1u : 0u; const u64 m = ballot_nz(und); const int pos = base + mbcnt64(m);
          if (und) { cl[pos] = kj; cl[64 + pos] = (unsigned)(64 * 128 + lane); } base += __builtin_popcountll(m); }
        const unsigned ck = lane < base ? cl[lane] : 0u; const int cp = (int)cl[64 + lane];
        topk_finish(ck, cp, A, 16383, T, P);
    } else {
#pragma unroll 1
        for (int bit = TK_LOWBITS - 1; bit >= 0; --bit) { const unsigned cand = T | (1u << bit); int tot; TK_FULLCOUNT(cand, tot); if (tot >= 256) T = cand; }
        int cge, cgt; TK_FULLCOUNT(T, cge); cgt = 0; if (T != 0xffffffffu) TK_FULLCOUNT(T + 1u, cgt);
        const int need = 256 - cgt, ceq = cge - cgt; P = 16383;
        if (ceq != need) { P = 0;
#pragma unroll 1
            for (int bit = 13; bit >= 0; --bit) { const int cand = P | (1 << bit); int cnt = 0;
#pragma unroll 4
                for (int j = 0; j < 129; ++j) cnt += (K[64 * j + lane] == T && 64 * j + lane < cand) ? 1 : 0;
                if (wave_sum_dpp(cnt) < need) P = cand; } }
    }
#undef TK_FULLCOUNT
    int base = 0;
#pragma unroll 1
    for (int j0 = 0; j0 < 136; j0 += 8) { unsigned kk[8];
#pragma unroll
        for (int i = 0; i < 8; ++i) kk[i] = (j0 + i < 129) ? K[64 * (j0 + i) + lane] : 0u;
#pragma unroll
        for (int i = 0; i < 8; ++i) { const int ps = 64 * (j0 + i) + lane; const unsigned selv = (kk[i] > T || (kk[i] == T && ps <= P)) ? 1u : 0u; const u64 m = ballot_nz(selv);
            const int pos = base + mbcnt64(m);
            if (selv && pos < 256) out[pos] = ps;
            base += __builtin_popcountll(m); } }
}
__device__ __forceinline__ void p10_topk(Ctx& c, const Args& a) {
    const int gw = c.vcu * NWAVES + c.wave, NGW = c.G * NWAVES;
    LAS unsigned* cl = (LAS unsigned*)(c.lds) + c.wave * 128;
    if (c.wave == 0 && c.vcu < MS) topk_sample_row(a, c.vcu, c.lane, (LAS unsigned*)(c.lds + 4096), cl);
    topk_prompt_rows(a, gw, NGW, c.lane, cl);
}


__device__ __forceinline__ void attn_sample_unit(Ctx& c, const Args& a, int sb, int t) {
    LAS bf16* KV = (LAS bf16*)(c.lds);
    LAS float* QL = (LAS float*)(c.lds + 69632);
    LAS float* SL = (LAS float*)(c.lds + 69632 + 3072);
    LAS float* OL = (LAS float*)(c.lds + 69632 + 6144);
    LAS int* IL = (LAS int*)(c.lds + 69632 + 12288);
    int tid = c.tid; asm volatile("" : "+v"(tid));
    const int lane = tid & 63, w = c.wave, q = sb * 4 + t;
    __syncthreads();
    if (tid < 256) IL[tid] = ((const int*)(a.ws + WS_SIDX))[q * 256 + tid];
    for (int i = tid; i < 768; i += 512) QL[i] = ((const float*)(a.ws + WS_SQ))[(size_t)q * 768 + i];
    __syncthreads();
    bf16* MIX = (bf16*)(a.ws + WS_MIX) + (size_t)(MP + q) * DM;
#pragma unroll 1
    for (int kvh = 0; kvh < 2; ++kvh) {
#pragma unroll 1
        for (int pass = 0; pass < 2; ++pass) {
            const float* pool = pass ? a.in[3] : a.in[2]; const float* nw = a.out + (pass ? O_VS : O_KS);
            for (int i = tid >> 5; i < 256; i += 16) { const int idx = IL[i]; const float* src;
                if (idx < PAST) src = pool + (((size_t)a.page_table[sb * 64 + (idx >> 7)] * 128 + (idx & 127)) * 2 + kvh) * 128;
                else src = nw + (size_t)(sb * 4 + (idx - PAST)) * 256 + kvh * 128;
                const f32x4 v = *(const f32x4*)(src + (tid & 31) * 4);
                *(LAS u64*)(KV + i * 136 + (tid & 31) * 4) = (u64)pk2(v.x, v.y) | ((u64)pk2(v.z, v.w) << 32); }
            __syncthreads();
            if (pass == 0) {
                const int i = tid >> 1, dh = (tid & 1) * 64; float s0 = 0.f, s1 = 0.f, s2 = 0.f;
#pragma unroll 8
                for (int d = 0; d < 64; ++d) { const float kx = bf2f(KV[i * 136 + dh + d]);
                    s0 = fmaf(QL[(3 * kvh + 0) * 128 + dh + d], kx, s0); s1 = fmaf(QL[(3 * kvh + 1) * 128 + dh + d], kx, s1); s2 = fmaf(QL[(3 * kvh + 2) * 128 + dh + d], kx, s2); }
                s0 += __shfl_xor(s0, 1); s1 += __shfl_xor(s1, 1); s2 += __shfl_xor(s2, 1);
                if ((tid & 1) == 0) { SL[i] = s0 * 0.08838834764831845f; SL[256 + i] = s1 * 0.08838834764831845f; SL[512 + i] = s2 * 0.08838834764831845f; }
                __syncthreads();
                if (w < 3) { float v[4], mx = -1e30f;
#pragma unroll
                    for (int j = 0; j < 4; ++j) { v[j] = SL[w * 256 + 64 * j + lane]; mx = fmaxf(mx, v[j]); }
#pragma unroll
                    for (int o = 1; o < 64; o <<= 1) mx = fmaxf(mx, __shfl_xor(mx, o));
                    float l = 0.f;
#pragma unroll
                    for (int j = 0; j < 4; ++j) { v[j] = __expf(v[j] - mx); l += v[j]; }
                    l = wave_sum(l); const float il = 1.0f / l;
#pragma unroll
                    for (int j = 0; j < 4; ++j) SL[w * 256 + 64 * j + lane] = v[j] * il; }
                __syncthreads();
            } else {
                const int d = tid & 127, part = tid >> 7; float o0 = 0.f, o1 = 0.f, o2 = 0.f;
#pragma unroll 8
                for (int i = part * 64; i < part * 64 + 64; ++i) { const float vx = bf2f(KV[i * 136 + d]); o0 = fmaf(SL[i], vx, o0); o1 = fmaf(SL[256 + i], vx, o1); o2 = fmaf(SL[512 + i], vx, o2); }
                OL[(part * 3 + 0) * 128 + d] = o0; OL[(part * 3 + 1) * 128 + d] = o1; OL[(part * 3 + 2) * 128 + d] = o2;
                __syncthreads();
                if (tid < 384) { const int hq = tid >> 7, dd = tid & 127; const float o = (OL[hq * 128 + dd] + OL[(3 + hq) * 128 + dd]) + (OL[(6 + hq) * 128 + dd] + OL[(9 + hq) * 128 + dd]);
                    MIX[(3 * kvh + hq) * 128 + dd] = (bf16)f2bf(o); }
                __syncthreads();
            }
        }
    }
}


namespace attn {
using bf16 = unsigned short;
typedef short bf16x8 __attribute__((ext_vector_type(8)));
typedef short s16x4 __attribute__((ext_vector_type(4)));
typedef float f32x16 __attribute__((ext_vector_type(16)));
typedef float f32x4 __attribute__((ext_vector_type(4)));
typedef unsigned u32x4 __attribute__((ext_vector_type(4)));
typedef unsigned u32x2 __attribute__((ext_vector_type(2)));
constexpr int D = 128, OS = 1024;
constexpr float THR = 8.f;
constexpr float SCALE = 0.08838834764831845f;
constexpr int NW = 8, QBLK = 32, KVBLK = 64, QB = NW * QBLK;
constexpr int SHM_V = KVBLK * D * 2, SHM_K = KVBLK * D * 2;
constexpr int LDS_BYTES = 2 * SHM_V + 2 * SHM_K + NW * 64 * 4;

#define KSWZ(row, colB) ((row) * 256 + ((colB) ^ (((row) & 7) << 4)))
#define SBAR() __builtin_amdgcn_sched_barrier(0)
__device__ __forceinline__ int v_st(int k, int c) { const int kk = (k & ~0xC) | ((k & 4) << 1) | ((k & 8) >> 1); return ((kk >> 3) * 4 + (c >> 5)) * 512 + ((kk & 7) * 32 + (c & 31)) * 2; }
__device__ __forceinline__ int v_rd_base(int lane) { return ((lane & 3) << 3) | (((lane >> 2) & 3) << 6) | (((lane >> 4) & 1) << 5) | (((lane >> 5) & 1) << 8); }
constexpr int v_rd_off(int d0, int ks, int half) { return d0 * 512 + ks * 4096 + half * 2048; }
__device__ __forceinline__ int crow(int r, int hi) { return (r & 3) + 8 * (r >> 2) + 4 * hi; }
__device__ __forceinline__ unsigned cvtpk(float lo, float hi) {
    unsigned r; asm volatile("v_cvt_pk_bf16_f32 %0, %1, %2" : "=v"(r) : "v"(lo), "v"(hi)); return r;
}
__device__ __forceinline__ bf16x8 pack8(f32x4 a, f32x4 b) {
    u32x4 w = {cvtpk(a[0], a[1]), cvtpk(a[2], a[3]), cvtpk(b[0], b[1]), cvtpk(b[2], b[3])};
    return *reinterpret_cast<bf16x8*>(&w);
}

__device__ __forceinline__ void partialSM(f32x16& p0, f32x16& p1, float& m_reg, float& mn, float& alpha) {
    float pmax = p0[0]; for (int r = 1; r < 16; ++r) pmax = fmaxf(pmax, p0[r]); for (int r = 0; r < 16; ++r) pmax = fmaxf(pmax, p1[r]);
    { auto rr = __builtin_amdgcn_permlane32_swap(__float_as_uint(pmax), __float_as_uint(pmax), false, false);
      pmax = fmaxf(__uint_as_float(rr[0]), __uint_as_float(rr[1])); }
    constexpr float C2 = 1.4426950408889634f * SCALE;
    if (__builtin_expect(__all((pmax - m_reg) * SCALE <= THR), 1)) { mn = m_reg; alpha = 1.f; }
    else { mn = fmaxf(m_reg, pmax); alpha = __builtin_amdgcn_exp2f((m_reg - mn) * C2); m_reg = mn; }
    const float mnL = -mn * C2;
    for (int r = 0; r < 16; ++r) p0[r] = fmaf(p0[r], C2, mnL); for (int r = 0; r < 16; ++r) p1[r] = fmaf(p1[r], C2, mnL);
    for (int r = 0; r < 16; ++r) p0[r] = __builtin_amdgcn_exp2f(p0[r]);
}
__device__ __forceinline__ void finishSM(f32x16& p0, f32x16& p1, float alpha, float& l_reg, bf16x8& pa0, bf16x8& pa1, bf16x8& pa2, bf16x8& pa3) {
    for (int r = 0; r < 16; ++r) p1[r] = __builtin_amdgcn_exp2f(p1[r]);
    float ps = 0; for (int r = 0; r < 16; ++r) ps += p0[r]; for (int r = 0; r < 16; ++r) ps += p1[r];
    { auto rr = __builtin_amdgcn_permlane32_swap(__float_as_uint(ps), __float_as_uint(ps), false, false);
      ps = __uint_as_float(rr[0]) + __uint_as_float(rr[1]); }
    l_reg = l_reg * alpha + ps;
#define PK4(P, B_, OUT) do { unsigned a0 = cvtpk(P[B_+0], P[B_+1]), a1 = cvtpk(P[B_+2], P[B_+3]);                          \
        unsigned b0 = cvtpk(P[B_+4], P[B_+5]), b1 = cvtpk(P[B_+6], P[B_+7]);                                             \
        auto r0 = __builtin_amdgcn_permlane32_swap(a0, b0, false, false); auto r1 = __builtin_amdgcn_permlane32_swap(a1, b1, false, false); \
        u32x4 w = {r0[0], r1[0], r0[1], r1[1]}; OUT = *reinterpret_cast<bf16x8*>(&w); } while (0)
    PK4(p0, 0, pa0); PK4(p0, 8, pa1); PK4(p1, 0, pa2); PK4(p1, 8, pa3);
#undef PK4
}
template <int KB, bool SK>
__device__ __forceinline__ void qkt(f32x16& p0, f32x16& p1, const char* K_lds, int r32, int hi, const bf16x8* qr, bool act) {
    if (SK && !act) { const float NEG = -__builtin_inff();
#pragma unroll
        for (int r = 0; r < 16; ++r) { p0[r] = NEG; p1[r] = NEG; } return; }
    p0 = f32x16{}; p1 = f32x16{};
    const char* kb[4];
#pragma unroll
    for (int dd = 0; dd < 4; ++dd) kb[dd] = K_lds + KB * SHM_K + KSWZ(r32, (dd * 16 + hi * 8) * 2);
#pragma unroll
    for (int d0 = 0; d0 < 8; ++d0) { const char* a = kb[d0 & 3] + (d0 >> 2) * 128;
        bf16x8 b0 = *reinterpret_cast<const bf16x8*>(a);
        bf16x8 b1 = *reinterpret_cast<const bf16x8*>(a + 32 * 256);
        p0 = __builtin_amdgcn_mfma_f32_32x32x16_bf16(b0, qr[d0], p0, 0, 0, 0);
        p1 = __builtin_amdgcn_mfma_f32_32x32x16_bf16(b1, qr[d0], p1, 0, 0, 0); }
}
template <int VB, bool SK>
__device__ __forceinline__ void pv_tile(f32x16* o, int vb0, bf16x8 pa0, bf16x8 pa1, bf16x8 pa2, bf16x8 pa3, bool act) {
    if (SK && !act) return;
#define TRRD(dst, off) asm volatile("ds_read_b64_tr_b16 %0, %1 offset:%2" : "=&v"(dst) : "v"(vb0), "i"(off) : "memory")
#define PV_D0(d0) do { s16x4 l0, l1, l2, l3, h0, h1, h2, h3; constexpr int b_ = VB * SHM_V + v_rd_off(d0, 0, 0);     \
        TRRD(l0, b_); TRRD(h0, b_ + 2048); TRRD(l1, b_ + 4096); TRRD(h1, b_ + 6144); TRRD(l2, b_ + 8192); TRRD(h2, b_ + 10240); TRRD(l3, b_ + 12288); TRRD(h3, b_ + 14336); \
        asm volatile("s_waitcnt lgkmcnt(0)" ::: "memory"); SBAR();                 \
        o[d0] = __builtin_amdgcn_mfma_f32_32x32x16_bf16(pa0, (bf16x8){l0[0], l0[1], l0[2], l0[3], h0[0], h0[1], h0[2], h0[3]}, o[d0], 0, 0, 0);   \
        o[d0] = __builtin_amdgcn_mfma_f32_32x32x16_bf16(pa1, (bf16x8){l1[0], l1[1], l1[2], l1[3], h1[0], h1[1], h1[2], h1[3]}, o[d0], 0, 0, 0);   \
        o[d0] = __builtin_amdgcn_mfma_f32_32x32x16_bf16(pa2, (bf16x8){l2[0], l2[1], l2[2], l2[3], h2[0], h2[1], h2[2], h2[3]}, o[d0], 0, 0, 0);   \
        o[d0] = __builtin_amdgcn_mfma_f32_32x32x16_bf16(pa3, (bf16x8){l3[0], l3[1], l3[2], l3[3], h3[0], h3[1], h3[2], h3[3]}, o[d0], 0, 0, 0); } while (0)
    PV_D0(0); PV_D0(1); PV_D0(2); PV_D0(3);
#undef PV_D0
#undef TRRD
}

__device__ __forceinline__ bf16x8 load8(const bf16* p) { return *reinterpret_cast<const bf16x8*>(p); }
__device__ __forceinline__ void mask_bits(f32x16& p0, f32x16& p1, u32x2 w, int hi) {
    const float NEG = -__builtin_inff();
    asm volatile("" : "+v"(w.x), "+v"(w.y));
    const unsigned lo = w.x >> (4 * hi), up = w.y >> (4 * hi);
#pragma unroll
    for (int r = 0; r < 16; ++r) { const int c = (r & 3) + 8 * (r >> 2);
        if (!((lo >> c) & 1u)) p0[r] = NEG;
        if (!((up >> c) & 1u)) p1[r] = NEG; }
}
struct BlockRef { const bf16* Q; const bf16* K; const bf16* V; bf16* O; const u32x2* M; int P0; };
struct Seam { bf16x8 qr[8]; bf16x8 st_v0, st_v1, st_k0, st_k1; };
#define ROW(p, k0, rr) ((p) + (size_t)((k0) + (rr)) * D + sc)
#define VMW() asm volatile("s_waitcnt vmcnt(0)" ::: "memory")
#define VMWN(n) asm volatile("s_waitcnt vmcnt(%0)" :: "i"(n) : "memory")
#define SLOAD_H(Kp, Vp, k0) do { S.st_v0 = load8(ROW(Vp, k0, sr)); S.st_v1 = load8(ROW(Vp, k0, 32 + sr));              \
                         S.st_k0 = load8(ROW(Kp, k0, sr)); S.st_k1 = load8(ROW(Kp, k0, 32 + sr)); } while (0)
#define SWRITE_HK(bf) do { *(bf16x8*)(K_lds + (bf) * SHM_K + kws) = S.st_k0; *(bf16x8*)(K_lds + (bf) * SHM_K + kws + 32 * 256) = S.st_k1; } while (0)
#define SWRITE_HV(bf) do { *(bf16x8*)(V_lds + (bf) * SHM_V + vst0) = S.st_v0; *(bf16x8*)(V_lds + (bf) * SHM_V + vst1) = S.st_v1; } while (0)
#define SWRITE_H(bf) do { SWRITE_HV(bf); SWRITE_HK(bf); } while (0)
__device__ __forceinline__ void sel_prime(const BlockRef& cur, char* lds, Seam& S) {
    int tid_ = threadIdx.x; asm volatile("" : "+v"(tid_));
    const int tid = tid_, wid = __builtin_amdgcn_readfirstlane(tid >> 6), lane = tid & 63, r32 = lane & 31, hi = lane >> 5;
    const int sr = tid >> 4, sc = (tid & 15) * 8, kws = KSWZ(sr, sc * 2); char* K_lds = lds + 2 * SHM_V;
    for (int d0 = 0; d0 < 8; ++d0) S.qr[d0] = load8(cur.Q + (size_t)(wid * QBLK + r32) * D + d0 * 16 + hi * 8);
    SLOAD_H(cur.K, cur.V, 0); VMW(); SWRITE_HK(0);
    __syncthreads();
}
__device__ __forceinline__ void sel_block(const BlockRef& cur, const BlockRef& nxt, char* lds, Seam& S) {
    int tid_ = threadIdx.x; asm volatile("" : "+v"(tid_));
    const int tid = tid_, wid = __builtin_amdgcn_readfirstlane(tid >> 6), lane = tid & 63, r32 = lane & 31, hi = lane >> 5;
    const int NT = (cur.P0 + QB) / KVBLK;
    char* V_lds = lds; char* K_lds = lds + 2 * SHM_V;
    float* ws = (float*)(lds + 2 * SHM_V + 2 * SHM_K) + wid * 64; float* li_l = ws, * al_l = ws + 32;
    float m_reg = -1e30f, l_reg = 0; f32x16 o[4] = {};
    const int sr = tid >> 4, sc = (tid & 15) * 8, vst0 = v_st(sr, sc), vst1 = v_st(32 + sr, sc), kws = KSWZ(sr, sc * 2);
    const int vb0 = (int)(uintptr_t)V_lds + v_rd_base(lane);
    const bf16* Kh = cur.K; const bf16* Vh = cur.V;
    const u32x2* Mrow = cur.M + (size_t)(wid * QBLK + r32) * 64;
#define RESC(a) do { if (__any((a) < 1.f)) { if (hi == 0) al_l[r32] = (a); asm volatile("s_waitcnt lgkmcnt(0)" ::: "memory");              \
                     for (int d_ = 0; d_ < 4; ++d_) for (int r = 0; r < 16; ++r) o[d_][r] *= al_l[crow(r, hi)]; } } while (0)
#define KBASE(t) ((t) * KVBLK)
    f32x16 pA0, pA1, pB0, pB1; float mnA, mnB, alA, alB; bf16x8 pa0, pa1, pa2, pa3; u32x2 mw;
    SWRITE_HV(0); SBAR();
    if (NT > 1) SLOAD_H(Kh, Vh, KBASE(1));
    mw = Mrow[0];
    SBAR(); qkt<0, false>(pA0, pA1, K_lds, r32, hi, S.qr, true);
    mask_bits(pA0, pA1, mw, hi); partialSM(pA0, pA1, m_reg, mnA, alA);
    if (NT > 1) { VMW(); SWRITE_H(1); }
    __syncthreads();
#define HALF_STEP(PX0, PX1, mnX, alX, PY0, PY1, alY, t, KB, VB, SB) do {                                                      \
        SBAR(); mw = Mrow[(t)]; qkt<KB, false>(PX0, PX1, K_lds, r32, hi, S.qr, true);                                          \
        finishSM(PY0, PY1, alY, l_reg, pa0, pa1, pa2, pa3); SBAR();                                                           \
        if ((t) + 1 < NT) { SLOAD_H(Kh, Vh, KBASE((t) + 1)); SBAR(); }                                                        \
        pv_tile<VB, false>(o, vb0, pa0, pa1, pa2, pa3, true); mask_bits(PX0, PX1, mw, hi); partialSM(PX0, PX1, m_reg, mnX, alX); \
        __syncthreads();                                                                                                      \
        if ((t) + 1 < NT) { VMW(); SWRITE_H(SB); }                                                                            \
        RESC(alX); __syncthreads(); } while (0)
    for (int t = 1; t + 1 < NT; t += 2) {
        HALF_STEP(pB0, pB1, mnB, alB, pA0, pA1, alA, t, 1, 0, 0);
        HALF_STEP(pA0, pA1, mnA, alA, pB0, pB1, alB, t + 1, 0, 1, 1);
    }
    const bool even = (NT & 1) == 0;
    if (even) { SBAR(); mw = Mrow[NT - 1]; qkt<1, false>(pB0, pB1, K_lds, r32, hi, S.qr, true); SBAR(); }
    SLOAD_H(nxt.K, nxt.V, 0); SBAR();
#pragma unroll
    for (int d0 = 0; d0 < 8; ++d0) S.qr[d0] = load8(nxt.Q + (size_t)(wid * QBLK + r32) * D + d0 * 16 + hi * 8);
    SBAR();
    finishSM(pA0, pA1, alA, l_reg, pa0, pa1, pa2, pa3); SBAR();
    pv_tile<0, false>(o, vb0, pa0, pa1, pa2, pa3, true);
    if (even) { mask_bits(pB0, pB1, mw, hi); partialSM(pB0, pB1, m_reg, mnB, alB); __syncthreads(); RESC(alB);
        finishSM(pB0, pB1, alB, l_reg, pa0, pa1, pa2, pa3); SBAR(); pv_tile<1, false>(o, vb0, pa0, pa1, pa2, pa3, true); }
    SBAR(); VMWN(8); SWRITE_HK(0); SBAR();
    if (hi == 0) li_l[r32] = l_reg; asm volatile("s_waitcnt lgkmcnt(0)" ::: "memory");
    float rli[16];
#pragma unroll
    for (int r = 0; r < 16; ++r) rli[r] = __builtin_amdgcn_rcpf(li_l[crow(r, hi)]);
    bf16* Ow = cur.O + (size_t)(wid * QBLK) * OS;
#pragma unroll
    for (int r = 0; r < 16; ++r) { const int orow = crow(r, hi);
#pragma unroll
        for (int d0 = 0; d0 < 4; ++d0) { const float v = o[d0][r] * rli[r];
            const float vn = __shfl_xor(v, 1);
            if ((r32 & 1) == 0) *(unsigned*)(Ow + (size_t)orow * OS + d0 * 32 + r32) = cvtpk(v, vn); } }
    __syncthreads();
#undef RESC
#undef KBASE
#undef HALF_STEP
}
#undef ROW
#undef VMW
#undef VMWN
#undef SLOAD_H
#undef SWRITE_HK
#undef SWRITE_HV
#undef SWRITE_H
#undef KSWZ
#undef SBAR
}


__device__ __forceinline__ attn::BlockRef attn_ref(const Args& a, int b, int h, int qb) {
    attn::BlockRef r; const int kvh = h / 3;
    r.Q = (const attn::bf16*)(a.ws + WS_QB) + ((size_t)(b * 6 + h) * SEQ + (size_t)qb * 256) * 128;
    r.K = (const attn::bf16*)(a.ws + WS_KB) + (size_t)(b * 2 + kvh) * SEQ * 128;
    r.V = (const attn::bf16*)(a.ws + WS_VB) + (size_t)(b * 2 + kvh) * SEQ * 128;
    r.O = (attn::bf16*)(a.ws + WS_MIX) + (size_t)(b * SEQ + qb * 256) * DM + h * 128;
    r.M = (const attn::u32x2*)(a.ws + WS_MASK) + (size_t)(b * SEQ + qb * 256) * 64;
    r.P0 = qb * 256; return r;
}
__device__ __forceinline__ void p11_attention(Ctx& c, const Args& a) {
    constexpr int NITEM = 192;
#pragma unroll 1
    for (int it = c.vcu; it < NITEM; it += c.G) {
        const int p = it & 7, bh = it >> 3, b = bh / 6, h = bh % 6;
        attn::Seam S;
        attn::BlockRef cur = attn_ref(a, b, h, p), nxt = attn_ref(a, b, h, 15 - p);
        __syncthreads();
        attn::sel_prime(cur, (char*)c.lds, S);
        attn::sel_block(cur, nxt, (char*)c.lds, S);
        attn::sel_block(nxt, nxt, (char*)c.lds, S);
    }
    const int spare = c.G - NITEM;
    if (spare > 0) { if (c.vcu >= NITEM) for (int u = c.vcu - NITEM; u < MS; u += spare) attn_sample_unit(c, a, u >> 2, u & 3); }
    else for (int u = c.vcu; u < MS; u += c.G) attn_sample_unit(c, a, u >> 2, u & 3);
}

enum { PH_PRO = 0, PH_IN0, PH_MIX0, PH_HSCAN, PH_HFIX, PH_OUT0, PH_GU0, PH_DOWN0, PH_IN1, PH_POST, PH_IDX, PH_TOPK, PH_ATTN, PH_OUT1, PH_GU1, PH_DOWN1, NPHASE };
#ifndef ONLYPH
#define ONLYPH -1
#endif
#define PHON(x) (ONLYPH < 0 || ONLYPH == (x))
#ifndef REP_PH
#define REP_PH -1
#endif
#ifndef REP_N
#define REP_N 1
#endif
__global__ void __launch_bounds__(NWAVES * 64, 2) fwd_kernel(Args args) {
    extern __shared__ __attribute__((aligned(16))) unsigned char lds[];
    Ctx c;
    c.lds = (LAS unsigned char*)lds;
    c.MISC = (volatile LAS unsigned*)(c.lds + MISC_OFF);
    c.tid = threadIdx.x; c.lane = c.tid & 63; c.wave = __builtin_amdgcn_readfirstlane(c.tid >> 6);
    c.G = gridDim.x; { const int bx = blockIdx.x; c.vcu = (c.G % 8 == 0) ? (bx % 8) * (c.G / 8) + bx / 8 : bx; }
    c.ctl = (gu32*)(args.ws + WS_CTL);
    for (int u = c.tid; u < (LDS_BYTES - LDSCTL_OFF) / 4; u += NWAVES * 64) ((LAS unsigned*)(c.lds + LDSCTL_OFF))[u] = 0u;
    __syncthreads();
    const int lo = args.ph_lo, hi = args.ph_hi;
    XcdBarrier bar; bar.bar = (unsigned*)(c.ctl + CW_BAR); bar.x = 0; bar.st = nullptr;
    if (hi - lo > 1 || REP_N > 1) bar = xcd_barrier_post((unsigned*)(c.ctl + CW_BAR), c.MISC + 8);
    c.qoff = 0;
#pragma unroll 1
    for (int ph = lo; ph < hi; ++ph) {
        const int layer = ph >= PH_IN1 ? 1 : 0;
        Args la = args; asm volatile("" : "+s"(la.ws), "+s"(la.out));
        unsigned char* const ws = la.ws; float* const out = la.out;
        { int t_ = threadIdx.x; asm volatile("" : "+v"(t_)); c.tid = t_; c.lane = t_ & 63; c.wave = __builtin_amdgcn_readfirstlane(t_ >> 6); }
        if ((ph == PH_DOWN0 || ph == PH_DOWN1) && PHON(PH_OUT0)) {
            pg8::SchedX S0; S0.init(MP, 1024, c.G, (int)blockIdx.x, 0, 0, 1, 0); pg8::Unit u0; if (S0.next(0, u0)) conv_fixup_tile(c, la, layer, u0.pm); VM_WAIT(); __syncthreads(); }
        if (ph == PH_PRO && PHON(PH_PRO)) p0_prologue(c, la);
        else if ((ph == PH_IN0 || ph == PH_IN1) && PHON(PH_IN0)) {
            pg8::Gemm g{(const pg8::bf16_t*)(ws + WS_XB), (const pg8::bf16_t*)(ws + (ph == PH_IN0 ? WS_WIN0 : WS_WIN1)), MT, 0, 1024};
            pg8::SchedX S; if (ph == PH_IN0) S.init(MP, ZC0, c.G, (int)blockIdx.x, 16, MT / 256, 4, 13); else S.init(MP, ZC1, c.G, (int)blockIdx.x, 0, 0, 1, 0);
            pg8::EpiZ E{(pg8::bf16_t*)(ws + WS_Z), ph == PH_IN0 ? ZC0 : ZC1, ssptr(c, ph == PH_IN0 ? 0 : 2), ph == PH_IN0 ? 13 : 9, (float*)(ws + WS_MEMKV), MEMROW0};
            pg8::gemm_phase<pg8::EpiZ, pg8::SchedX, PG8_ALIGN, PG8_SP2>(c.lds + RING_OFF, g, S, E);
            { SgArgs sg{}; sg.A = (const bf16*)(ws + WS_XB) + (size_t)MP * DM; sg.Bt = (const bf16*)(ws + (ph == PH_IN0 ? WS_WIN0 : WS_WIN1)); sg.K = 1024; sg.mode = 0; sg.Z = (bf16*)(ws + WS_Z); sg.ldz = ph == PH_IN0 ? ZC0 : ZC1; sg.ssin = ssptr(c, ph == PH_IN0 ? 0 : 2);
              sgemm_phase(c, sg, ph == PH_IN0 ? ZC0 : ZC1); }
        }
        else if (ph == PH_MIX0 && PHON(PH_MIX0)) p2_mixer0(c, la);
        else if (ph == PH_HSCAN && PHON(PH_HSCAN)) hgrn_scan(c, la);
        else if (ph == PH_HFIX && PHON(PH_HFIX)) p2c_hgrn_fix(c, la);
        else if ((ph == PH_OUT0 || ph == PH_DOWN0 || ph == PH_OUT1 || ph == PH_DOWN1) && PHON(PH_OUT0)) {
            const bool isout = (ph == PH_OUT0 || ph == PH_OUT1);
            pg8::Gemm g{(const pg8::bf16_t*)(ws + (isout ? WS_MIX : WS_ACT)), (const pg8::bf16_t*)(ws + (isout ? WS_WOUT + (size_t)layer * 1024 * 1024 * 2 : WS_WD + (size_t)layer * 1024 * DFF * 2)), MT, 1024, isout ? 1024 : DFF};
            pg8::SchedX S; S.init(MP, 1024, c.G, (int)blockIdx.x, 0, 0, 1, 0);
            pg8::EpiResid E;
            E.rp = ph == PH_OUT0 ? la.in[0] : out + O_YP; E.rs = ph == PH_OUT0 ? la.in[1] : out + O_YS; E.y = out + O_YP;
            E.xb = ph == PH_DOWN1 ? nullptr : (pg8::bf16_t*)(ws + WS_XB); E.ssout = ph == PH_DOWN1 ? nullptr : ssptr(c, ph == PH_OUT0 ? 1 : (ph == PH_DOWN0 ? 2 : 3));
            pg8::gemm_phase<pg8::EpiResid, pg8::SchedX, PG8_ALIGN, PG8_SP2>(c.lds + RING_OFF, g, S, E);
            { SgArgs sg{}; sg.A = (const bf16*)(ws + (isout ? WS_MIX : WS_ACT)) + (size_t)MP * (isout ? 1024 : DFF); sg.Bt = (const bf16*)g.Bt; sg.K = isout ? 1024 : DFF; sg.mode = 1; sg.resid = E.rs; sg.y = out + O_YS; sg.xb = (bf16*)E.xb; sg.ssout = E.ssout;
              sgemm_phase(c, sg, 1024); }
        }
        else if ((ph == PH_GU0 || ph == PH_GU1) && PHON(PH_GU0)) {
            pg8::Gemm g{(const pg8::bf16_t*)(ws + WS_XB), (const pg8::bf16_t*)(ws + WS_WGU + (size_t)layer * 5632 * 1024 * 2), MT, 5632, 1024};
            pg8::SchedX S; S.init(MP, 5632, c.G, (int)blockIdx.x, 0, 0, 1, 0);
            pg8::EpiGU E{(pg8::bf16_t*)(ws + WS_ACT), ssptr(c, layer ? 3 : 1), out + O_CVP + (size_t)layer * 4 * 2 * DFF, la.in[26] + (size_t)layer * 3 * DFF, la.in[27] + (size_t)layer * DFF, (float*)(ws + WS_G4), (float*)(ws + WS_UP2)};
            pg8::gemm_phase<pg8::EpiGU, pg8::SchedX, PG8_ALIGN, PG8_SP2>(c.lds + RING_OFF, g, S, E);
            { SgArgs sg{}; sg.A = (const bf16*)(ws + WS_XB) + (size_t)MP * DM; sg.Bt = (const bf16*)g.Bt; sg.K = 1024; sg.mode = 2; sg.ssin = E.ss; sg.ACT = (bf16*)E.ACT; sg.cvs = out + O_CVS + (size_t)layer * 32 * 2 * DFF; sg.cst = la.in[8] + (size_t)layer * 32 * 2 * DFF; sg.cw = E.cw; sg.cb = E.cb;
              sgemm_phase(c, sg, 5632); }
        }
        else if (ph == PH_POST && PHON(PH_POST)) p8_dsa_post(c, la);
        else if (ph == PH_IDX && PHON(PH_IDX)) p9_indexer(c, la);
        else if (ph == PH_TOPK && PHON(PH_TOPK)) p10_topk(c, la);
        else if (ph == PH_ATTN && PHON(PH_ATTN)) p11_attention(c, la);
        if (REP_N > 1 && ph == REP_PH && c.qoff < 4 * (REP_N - 1)) { c.qoff += 4; --ph; xcd_barrier(bar); continue; }
        if (REP_N > 1) c.qoff = 0;
        if (ph + 1 < hi) xcd_barrier(bar);
    }
}

#ifndef MK_ONE_LAUNCH
#define MK_ONE_LAUNCH 1
#endif
extern "C" void kernel_launch(void* const* d_in, const int* in_sizes, int n_in, void* d_out, int out_size, void* d_ws, size_t ws_size, hipStream_t stream) {
    static int grid = 0;
    if (grid == 0) {
        if (n_in != 29 || out_size != (int)O_END || ws_size < WS_END) { fprintf(stderr, "kernel_launch: unexpected problem (n_in %d, out %d, ws %zu)\n", n_in, out_size, ws_size); grid = -1; return; }
        int dev = 0, cus = 0;
        if (hipGetDevice(&dev) != hipSuccess || hipDeviceGetAttribute(&cus, hipDeviceAttributeMultiprocessorCount, dev) != hipSuccess) { grid = -1; return; }
        if (hipFuncSetAttribute((const void*)fwd_kernel, hipFuncAttributeMaxDynamicSharedMemorySize, LDS_BYTES) != hipSuccess) { fprintf(stderr, "kernel_launch: hipFuncSetAttribute failed\n"); grid = -1; return; }
        (void)hipGetLastError();
        grid = cus;
    }
    if (grid < 0) return;
    if (hipMemsetAsync((char*)d_ws + WS_CTL, 0, CTL_ZERO_BYTES, stream) != hipSuccess) { fprintf(stderr, "kernel_launch: memset failed\n"); return; }
    Args a{};
    for (int i = 0; i < 29; ++i) a.in[i] = (const float*)d_in[i];
    a.page_table = (const int*)d_in[9]; a.out = (float*)d_out; a.ws = (unsigned char*)d_ws;
#if MK_ONE_LAUNCH
    a.ph_lo = 0; a.ph_hi = NPHASE;
    hipLaunchKernelGGL(fwd_kernel, dim3(grid), dim3(NWAVES * 64), LDS_BYTES, stream, a);
#else
    for (int ph = 0; ph < NPHASE; ++ph) { a.ph_lo = ph; a.ph_hi = ph + 1; hipLaunchKernelGGL(fwd_kernel, dim3(grid), dim3(NWAVES * 64), LDS_BYTES, stream, a); }
#endif
}
```

```cpp
#include <hip/hip_runtime.h>
#include <cstdio>
#include <cstdint>


namespace pg8 {
#define PG8_LAS __attribute__((address_space(3)))
typedef unsigned short bf16_t;
typedef short bf16x8 __attribute__((ext_vector_type(8)));
typedef float f32x4 __attribute__((ext_vector_type(4)));
typedef unsigned u32x4 __attribute__((ext_vector_type(4)));
constexpr int BM = 256, BK = 64, HALF = 128, HTB = HALF * BK * 2  , STAGE_BYTES = 8 * HTB, NXCD = 8, WGM = 8;

__host__ __device__ __forceinline__ int lds_byte(int r, int c) { const int st = (r >> 4) * 2 + (c >> 5), rr = r & 15, cc = c & 31, ob = rr * 64 + cc * 2; return st * 1024 + (ob ^ (((ob >> 9) & 1) << 5)); }
__host__ __device__ __forceinline__ void stage_rc(int b, int& R, int& C) { const int st = b / 1024, sb = b % 1024, swz = sb ^ (((sb >> 9) & 1) << 5); R = (st >> 1) * 16 + swz / 64; C = (st & 1) * 32 + (swz % 64) / 2; }
__host__ __device__ __forceinline__ int perm32(int rho) { const int n = rho >> 4, i = rho & 15; return 8 * (i >> 2) + 4 * n + (i & 3); }

struct Unit { int pm, pn; };
struct Gemm { const bf16_t* A; const bf16_t* Bt; int M, N, K; };

struct StaticOrder {
    int nM, nN, nwg, G, c;
    __host__ __device__ __forceinline__ void init(int M, int N, int G_, int c_) { nM = M / BM; nN = N / BM; nwg = nM * nN; G = G_; c = c_; }
    __host__ __device__ __forceinline__ bool next(int i, Unit& u) const {
        const long L = (long)i * G + c; if (L >= nwg) return false;
        int wgid = (int)L; { const int q = nwg / NXCD, r = nwg % NXCD, xcd = wgid % NXCD, off = wgid / NXCD; wgid = (xcd < r ? xcd * (q + 1) : r * (q + 1) + (xcd - r) * q) + off; }
        const int nig = WGM * nN, gid = wgid / nig, fm = gid * WGM, gsz = (nM - fm) < WGM ? (nM - fm) : WGM;
        u.pm = fm + ((wgid % nig) % gsz); u.pn = (wgid % nig) / gsz; return true;
    }
    __device__ __forceinline__ void a_ready(const Unit&) const {}
    __device__ __forceinline__ void done(const Unit&) const {}
};


constexpr int MP = 16384, MS = 128, MVALID = MP + MS, MT = 16640, DM = 1024, DFF = 2816;
constexpr float RMS_EPS = 1e-6f;
__device__ __forceinline__ unsigned cvt_pk_bf16(float lo, float hi) { unsigned r; asm volatile("v_cvt_pk_bf16_f32 %0, %1, %2" : "=v"(r) : "v"(lo), "v"(hi)); return r; }

struct SchedX {
    StaticOrder so; int nextra, e_pm0, e_nm, e_pn0;
    __device__ __forceinline__ void init(int M, int N, int G_, int c_, int nextra_, int e_pm0_, int e_nm_, int e_pn0_) { so.init(M, N, G_, c_); nextra = nextra_; e_pm0 = e_pm0_; e_nm = e_nm_; e_pn0 = e_pn0_; }
    __device__ __forceinline__ bool next(int i, Unit& u) const {
        const long L = (long)i * so.G + so.c;
        if (L < so.nwg) return so.next(i, u);
        const int e = (int)(L - so.nwg); if (e >= nextra) return false;
        u.pm = e_pm0 + e % e_nm; u.pn = e_pn0 + e / e_nm; return true;
    }
    __device__ __forceinline__ void a_ready(const Unit&) const {}
    __device__ __forceinline__ void done(const Unit&) const {}
};

struct EpiZ {
    static constexpr bool PERM = true, AFTER_DRAIN = false;
    bf16_t* Z; int ldz; const float* ss; int nmain; float* memkv; int memrow0;
    __device__ __forceinline__ void operator()(const f32x4 (&acc)[2][2][4][2], const Unit& u, int wr, int wc, int fr, int fq) const {
        const int row0 = u.pm * BM + wr * 64 + fr;
        if (u.pn < nmain) {
            const int col0 = u.pn * BM + wc * 32 + 8 * fq;
#pragma unroll
            for (int ai = 0; ai < 2; ++ai)
#pragma unroll
                for (int m = 0; m < 4; ++m) { const int row = row0 + ai * HALF + m * 16; const float rs = rsqrtf(ss[row] * (1.0f / DM) + RMS_EPS);
#pragma unroll
                    for (int bj = 0; bj < 2; ++bj) { const f32x4 v0 = acc[ai][bj][m][0] * rs, v1 = acc[ai][bj][m][1] * rs;
                        u32x4 w; w.x = cvt_pk_bf16(v0[0], v0[1]); w.y = cvt_pk_bf16(v0[2], v0[3]); w.z = cvt_pk_bf16(v1[0], v1[1]); w.w = cvt_pk_bf16(v1[2], v1[3]);
                        *(u32x4*)(Z + (size_t)row * ldz + col0 + bj * HALF) = w; } }
        } else {
            const int col0 = (u.pn - nmain) * BM + wc * 32 + 8 * fq;
#pragma unroll
            for (int ai = 0; ai < 2; ++ai)
#pragma unroll
                for (int m = 0; m < 4; ++m) { const int row = row0 + ai * HALF + m * 16 - memrow0;
#pragma unroll
                    for (int bj = 0; bj < 2; ++bj) { float* p = memkv + (size_t)row * 1024 + col0 + bj * HALF; *(f32x4*)p = acc[ai][bj][m][0]; *(f32x4*)(p + 4) = acc[ai][bj][m][1]; } }
        }
    }
};

struct EpiResid {
    static constexpr bool PERM = true, AFTER_DRAIN = false;
    const float* rp; const bf16_t* rb; float* y; bf16_t* xb; float* ssout;
    __device__ __forceinline__ void operator()(const f32x4 (&acc)[2][2][4][2], const Unit& u, int wr, int wc, int fr, int fq) const {
        const int row0 = u.pm * BM + wr * 64 + fr, col0 = u.pn * BM + wc * 32 + 8 * fq;
#pragma unroll
        for (int ai = 0; ai < 2; ++ai)
#pragma unroll
            for (int m = 0; m < 4; ++m) { const int row = row0 + ai * HALF + m * 16; float part = 0.f;
#pragma unroll
                for (int bj = 0; bj < 2; ++bj) { const int c = col0 + bj * HALF; f32x4 r0, r1;
                    if (rp) { r0 = *(const f32x4*)(rp + (size_t)row * DM + c); r1 = *(const f32x4*)(rp + (size_t)row * DM + c + 4); }
                    else { const u32x4 q = *(const u32x4*)(rb + (size_t)row * DM + c);
                        r0 = (f32x4){__builtin_bit_cast(float, q.x << 16), __builtin_bit_cast(float, q.x & 0xffff0000u), __builtin_bit_cast(float, q.y << 16), __builtin_bit_cast(float, q.y & 0xffff0000u)};
                        r1 = (f32x4){__builtin_bit_cast(float, q.z << 16), __builtin_bit_cast(float, q.z & 0xffff0000u), __builtin_bit_cast(float, q.w << 16), __builtin_bit_cast(float, q.w & 0xffff0000u)}; }
                    const f32x4 v0 = acc[ai][bj][m][0] + r0, v1 = acc[ai][bj][m][1] + r1;
                    if (y) { *(f32x4*)(y + (size_t)row * DM + c) = v0; *(f32x4*)(y + (size_t)row * DM + c + 4) = v1; }
                    part += (v0[0] * v0[0] + v0[1] * v0[1]) + (v0[2] * v0[2] + v0[3] * v0[3]) + (v1[0] * v1[0] + v1[1] * v1[1]) + (v1[2] * v1[2] + v1[3] * v1[3]);
                    if (xb) { u32x4 w; w.x = cvt_pk_bf16(v0[0], v0[1]); w.y = cvt_pk_bf16(v0[2], v0[3]); w.z = cvt_pk_bf16(v1[0], v1[1]); w.w = cvt_pk_bf16(v1[2], v1[3]);
                        *(u32x4*)(xb + (size_t)row * DM + c) = w; } }
                part += __shfl_xor(part, 16); part += __shfl_xor(part, 32);
                if (ssout && fq == 0) atomicAdd(ssout + row, part); }
    }
};

__device__ __forceinline__ void dpp_ror12(const f32x4& v, f32x4& r1, f32x4& r2) {
    float a0, a1, a2, a3, b0, b1, b2, b3;
    asm volatile("s_nop 1\n\t"
                 "v_mov_b32_dpp %0, %8 row_ror:1 row_mask:0xf bank_mask:0xf\n\tv_mov_b32_dpp %1, %9 row_ror:1 row_mask:0xf bank_mask:0xf\n\t"
                 "v_mov_b32_dpp %2, %10 row_ror:1 row_mask:0xf bank_mask:0xf\n\tv_mov_b32_dpp %3, %11 row_ror:1 row_mask:0xf bank_mask:0xf\n\t"
                 "v_mov_b32_dpp %4, %8 row_ror:2 row_mask:0xf bank_mask:0xf\n\tv_mov_b32_dpp %5, %9 row_ror:2 row_mask:0xf bank_mask:0xf\n\t"
                 "v_mov_b32_dpp %6, %10 row_ror:2 row_mask:0xf bank_mask:0xf\n\tv_mov_b32_dpp %7, %11 row_ror:2 row_mask:0xf bank_mask:0xf"
                 : "=&v"(a0), "=&v"(a1), "=&v"(a2), "=&v"(a3), "=&v"(b0), "=&v"(b1), "=&v"(b2), "=&v"(b3) : "v"(v[0]), "v"(v[1]), "v"(v[2]), "v"(v[3]));
    r1 = (f32x4){a0, a1, a2, a3}; r2 = (f32x4){b0, b1, b2, b3};
}
struct EpiGU {
    static constexpr bool PERM = true, AFTER_DRAIN = false;
    bf16_t* ACT; const float* ss; float* cvp; const float* cw; const float* cb; float* G4; float* UP2;
    __device__ __forceinline__ void operator()(const f32x4 (&acc)[2][2][4][2], const Unit& u, int wr, int wc, int fr, int fq) const {
        const int row0 = u.pm * BM + wr * 64 + fr, colg = u.pn * HALF + wc * 32 + 8 * fq;
#pragma unroll
        for (int n = 0; n < 2; ++n) { const int col = colg + 4 * n;
            const f32x4 w0 = *(const f32x4*)(cw + col), w1 = *(const f32x4*)(cw + DFF + col), w2 = *(const f32x4*)(cw + 2 * DFF + col), bb = *(const f32x4*)(cb + col);
#pragma unroll
            for (int ai = 0; ai < 2; ++ai) { f32x4 r1p = {0.f, 0.f, 0.f, 0.f}, r2p = r1p; const int slab = (u.pm * BM + ai * HALF + wr * 64) >> 6;
#pragma unroll
                for (int m = 0; m < 4; ++m) { const int row = row0 + ai * HALF + m * 16; const float rs = rsqrtf(ss[row] * (1.0f / DM) + RMS_EPS);
                    const f32x4 g = acc[ai][0][m][n] * rs, up = acc[ai][1][m][n] * rs;
                    f32x4 r1, r2; dpp_ror12(g, r1, r2);
                    const f32x4 p1 = fr >= 1 ? r1 : r1p, p2 = fr >= 2 ? r2 : r2p;
                    f32x4 cv = bb + w0 * p2 + w1 * p1 + w2 * g, y;
#pragma unroll
                    for (int i = 0; i < 4; ++i) y[i] = cv[i] * __builtin_amdgcn_rcpf(1.0f + __expf(-cv[i])) * up[i];
                    if (m == 0 && fr < 2) { *(f32x4*)(G4 + (size_t)(slab * 4 + fr) * DFF + col) = g; *(f32x4*)(UP2 + (size_t)(slab * 2 + fr) * DFF + col) = up; }
                    else { typedef unsigned u32x2 __attribute__((ext_vector_type(2))); u32x2 w; w.x = cvt_pk_bf16(y[0], y[1]); w.y = cvt_pk_bf16(y[2], y[3]); *(u32x2*)(ACT + (size_t)row * DFF + col) = w; }
                    if (m == 3 && fr >= 14) { *(f32x4*)(G4 + (size_t)(slab * 4 + 2 + (fr - 14)) * DFF + col) = g;
                        const int t = row & 4095; if (t >= 4094) *(f32x4*)(cvp + (size_t)((row >> 12) * 2 + (t - 4094)) * DFF + col) = g; }
                    r1p = r1; r2p = r2; } } }
    }
};

template <class Epi, class Sched, bool ALIGN_EPI = false, bool SP2 = false>
__device__ __forceinline__ void gemm_phase(PG8_LAS unsigned char* lds, const Gemm g, const Sched& S, const Epi& E) {
    int tid_ = threadIdx.x; asm volatile("" : "+v"(tid_));
    const int tid = tid_, wid = __builtin_amdgcn_readfirstlane(tid >> 6), lane = tid & 63, wr = wid >> 2, wc = wid & 3, fr = lane & 15, fq = lane >> 4;
    const int K = g.K, nt = K / BK;
    unsigned voffA[2], voffB[2];
#pragma unroll
    for (int i = 0; i < 2; ++i) { int R, C; stage_rc(tid * 16 + i * 8192, R, C); const int Rb = Epi::PERM ? ((R & ~31) + perm32(R & 31)) : R;
        voffA[i] = (unsigned)(R * K + C) * 2u; voffB[i] = (unsigned)(Rb * K + C) * 2u; }
    const size_t kstep = (size_t)(BK * 2);
    const size_t hstep = (size_t)HALF * K * 2;
    const size_t tstep = 2 * hstep;
    const unsigned ldsw = (unsigned)wid * 1024u;
    const int aoff = lds_byte(wr * 64 + fr, fq * 8), boff = lds_byte(wc * 32 + fr, fq * 8);
#define PG8_SA(b, h) (((b) * 2 + (h)) * HTB)
#define PG8_SB(b, h) ((4 + (b) * 2 + (h)) * HTB)
#define PG8_STAGE(bufoff, gbase, voff) do { _Pragma("unroll") for (int _i = 0; _i < 2; ++_i) \
        __builtin_amdgcn_global_load_lds((const unsigned*)((const char*)(gbase) + (voff)[_i]), (PG8_LAS unsigned*)(lds + (bufoff) + ldsw + _i * 8192), 16, 0, 0); } while (0)
#define PG8_LDA(dst, b, h) do { _Pragma("unroll") for (int m = 0; m < 4; ++m) _Pragma("unroll") for (int k = 0; k < 2; ++k) dst[m][k] = *(const PG8_LAS bf16x8*)(lds + PG8_SA(b, h) + aoff + m * 2048 + k * 1024); } while (0)
#define PG8_LDB(dst, b, h) do { _Pragma("unroll") for (int n = 0; n < 2; ++n) _Pragma("unroll") for (int k = 0; k < 2; ++k) dst[n][k] = *(const PG8_LAS bf16x8*)(lds + PG8_SB(b, h) + boff + n * 2048 + k * 1024); } while (0)
#define PG8_MMA(ai, bj, At, Bt) do { __builtin_amdgcn_s_setprio(1); _Pragma("unroll") for (int m = 0; m < 4; ++m) _Pragma("unroll") for (int n = 0; n < 2; ++n) _Pragma("unroll") for (int k = 0; k < 2; ++k) \
        acc[ai][bj][m][n] = __builtin_amdgcn_mfma_f32_16x16x32_bf16(Bt[n][k], At[m][k], acc[ai][bj][m][n], 0, 0, 0); __builtin_amdgcn_s_setprio(0); } while (0)
#define PG8_WAIT_V(n) asm volatile("s_waitcnt vmcnt(" #n ")" ::: "memory")
#define PG8_WAIT_L(n) asm volatile("s_waitcnt lgkmcnt(" #n ")" ::: "memory")
#define PG8_BAR __builtin_amdgcn_s_barrier()
#define PG8_SCHED __builtin_amdgcn_sched_barrier(0)
    Unit cur, nxt; int ui = 0;
    if (!S.next(0, cur)) return;
    f32x4 acc[2][2][4][2];
#pragma unroll
    for (int a = 0; a < 2; ++a)
#pragma unroll
        for (int b = 0; b < 2; ++b)
#pragma unroll
            for (int m = 0; m < 4; ++m)
#pragma unroll
                for (int n = 0; n < 2; ++n) acc[a][b][m][n] = (f32x4){0.f, 0.f, 0.f, 0.f};
    bf16x8 At[4][2], B0[2][2], B1[2][2];
    const char* cA = (const char*)g.A + (size_t)cur.pm * tstep; const char* cB = (const char*)g.Bt + (size_t)cur.pn * tstep;
    S.a_ready(cur);
    if constexpr (SP2) {
        PG8_STAGE(PG8_SB(0, 0), cB, voffB); PG8_STAGE(PG8_SB(0, 1), cB + hstep, voffB); PG8_STAGE(PG8_SA(0, 0), cA, voffA); PG8_STAGE(PG8_SA(0, 1), cA + hstep, voffA);
        if (wr == 1) PG8_BAR;
        PG8_WAIT_V(2); PG8_BAR;
        PG8_STAGE(PG8_SB(1, 0), cB + kstep, voffB); PG8_STAGE(PG8_SA(1, 0), cA + kstep, voffA); PG8_STAGE(PG8_SB(1, 1), cB + hstep + kstep, voffB);
        PG8_WAIT_V(6); PG8_BAR;
    } else {
        PG8_STAGE(PG8_SB(0, 0), cB, voffB); PG8_STAGE(PG8_SA(0, 0), cA, voffA); PG8_STAGE(PG8_SB(0, 1), cB + hstep, voffB); PG8_STAGE(PG8_SA(0, 1), cA + hstep, voffA);
        if (wr == 1) PG8_BAR;
        PG8_WAIT_V(4); PG8_BAR;
        PG8_STAGE(PG8_SB(1, 0), cB + kstep, voffB); PG8_STAGE(PG8_SA(1, 0), cA + kstep, voffA); PG8_STAGE(PG8_SB(1, 1), cB + hstep + kstep, voffB);
        PG8_WAIT_V(6); PG8_BAR;
    }
    for (;;) {
        const bool has_next = S.next(ui + 1, nxt);
        const char* nA = has_next ? (const char*)g.A + (size_t)nxt.pm * tstep : cA; const char* nB = has_next ? (const char*)g.Bt + (size_t)nxt.pn * tstep : cB;
        for (int t = 0; t < nt; t += 2) {
            const bool last = (t == nt - 2);
            const char* a1 = cA + (size_t)(t + 1) * kstep;
            const char* a2 = last ? nA : cA + (size_t)(t + 2) * kstep; const char* b2 = last ? nB : cB + (size_t)(t + 2) * kstep;
            const char* a3 = a2 + kstep; const char* b3 = b2 + kstep;
            if (last && has_next) S.a_ready(nxt);
            if constexpr (SP2) {
            PG8_LDB(B0, 0, 0); PG8_LDB(B1, 0, 1); PG8_SCHED; PG8_LDA(At, 0, 0); PG8_STAGE(PG8_SA(1, 1), a1 + hstep, voffA);
            PG8_WAIT_V(8); PG8_WAIT_L(0); PG8_BAR; PG8_MMA(0, 0, At, B0); PG8_MMA(0, 1, At, B1); PG8_BAR; PG8_SCHED;
            PG8_LDA(At, 0, 1); PG8_STAGE(PG8_SB(0, 0), b2, voffB); PG8_STAGE(PG8_SB(0, 1), b2 + hstep, voffB); PG8_STAGE(PG8_SA(0, 0), a2, voffA);
            PG8_WAIT_V(8); PG8_WAIT_L(0); PG8_BAR; PG8_MMA(1, 0, At, B0); PG8_MMA(1, 1, At, B1); PG8_BAR; PG8_SCHED;
            PG8_LDB(B0, 1, 0); PG8_LDB(B1, 1, 1); PG8_SCHED; PG8_LDA(At, 1, 0); PG8_STAGE(PG8_SA(0, 1), a2 + hstep, voffA);
            PG8_WAIT_V(8); PG8_WAIT_L(0); PG8_BAR; PG8_MMA(0, 0, At, B0); PG8_MMA(0, 1, At, B1); PG8_BAR; PG8_SCHED;
            PG8_LDA(At, 1, 1); PG8_STAGE(PG8_SB(1, 0), b3, voffB); PG8_STAGE(PG8_SB(1, 1), b3 + hstep, voffB); PG8_STAGE(PG8_SA(1, 0), a3, voffA);
            PG8_WAIT_V(8); PG8_WAIT_L(0); PG8_BAR; PG8_MMA(1, 0, At, B0); PG8_MMA(1, 1, At, B1); PG8_BAR; PG8_SCHED;
            } else {
            PG8_LDB(B0, 0, 0); PG8_SCHED; PG8_LDA(At, 0, 0); PG8_STAGE(PG8_SA(1, 1), a1 + hstep, voffA);
            PG8_WAIT_L(8); PG8_BAR; PG8_WAIT_L(0); PG8_MMA(0, 0, At, B0); PG8_BAR; PG8_SCHED;
            PG8_LDB(B1, 0, 1); PG8_STAGE(PG8_SB(0, 0), b2, voffB);
            PG8_BAR; PG8_WAIT_L(0); PG8_MMA(0, 1, At, B1); PG8_BAR;
            PG8_LDA(At, 0, 1); PG8_STAGE(PG8_SA(0, 0), a2, voffA);
            PG8_BAR; PG8_WAIT_L(0); PG8_MMA(1, 0, At, B0); PG8_BAR; PG8_SCHED;
            PG8_STAGE(PG8_SB(0, 1), b2 + hstep, voffB);
            PG8_WAIT_V(6); PG8_BAR; PG8_MMA(1, 1, At, B1); PG8_BAR;
            PG8_LDB(B0, 1, 0); PG8_SCHED; PG8_LDA(At, 1, 0); PG8_STAGE(PG8_SA(0, 1), a2 + hstep, voffA);
            PG8_WAIT_L(8); PG8_BAR; PG8_WAIT_L(0); PG8_MMA(0, 0, At, B0); PG8_BAR; PG8_SCHED;
            PG8_LDB(B1, 1, 1); PG8_STAGE(PG8_SB(1, 0), b3, voffB);
            PG8_BAR; PG8_WAIT_L(0); PG8_MMA(0, 1, At, B1); PG8_BAR;
            PG8_LDA(At, 1, 1); PG8_STAGE(PG8_SA(1, 0), a3, voffA);
            PG8_BAR; PG8_WAIT_L(0); PG8_MMA(1, 0, At, B0); PG8_BAR; PG8_SCHED;
            PG8_STAGE(PG8_SB(1, 1), b3 + hstep, voffB);
            PG8_WAIT_V(6); PG8_BAR; PG8_MMA(1, 1, At, B1); PG8_BAR;
            }
        }
        if constexpr (ALIGN_EPI) { if (wr == 0) PG8_BAR; }
        if constexpr (!Epi::AFTER_DRAIN) { E(acc, cur, wr, wc, fr, fq); S.done(cur); }
        if (!has_next) break;
#pragma unroll
        for (int a = 0; a < 2; ++a)
#pragma unroll
            for (int b = 0; b < 2; ++b)
#pragma unroll
                for (int m = 0; m < 4; ++m)
#pragma unroll
                    for (int n = 0; n < 2; ++n) acc[a][b][m][n] = (f32x4){0.f, 0.f, 0.f, 0.f};
        cur = nxt; cA = nA; cB = nB; ++ui;
        if constexpr (ALIGN_EPI) { if (wr == 1) PG8_BAR; }
    }
    PG8_WAIT_V(0);
    if constexpr (!ALIGN_EPI) { if (wr == 0) PG8_BAR; }
    PG8_BAR;
    if constexpr (Epi::AFTER_DRAIN) { E.fused(acc, cur, wr, wc, fr, fq, lds, wid, lane); S.done(cur); }
#undef PG8_SA
#undef PG8_SB
#undef PG8_STAGE
#undef PG8_LDA
#undef PG8_LDB
#undef PG8_MMA
#undef PG8_WAIT_V
#undef PG8_WAIT_L
#undef PG8_BAR
#undef PG8_SCHED
}
}


#ifndef PG8_SP2
#define PG8_SP2 true
#endif
#ifndef PG8_ALIGN
#define PG8_ALIGN true
#endif
constexpr int NWAVES = 8;
constexpr int MP = pg8::MP, MS = pg8::MS, MVALID = pg8::MVALID, MT = pg8::MT, DM = 1024, DFF = 2816;
constexpr int SEQ = 4096, NB = 4, NSB = 32, PAST = 8192, NPOOL = 2560;
constexpr int ZC0 = 3328, ZC1 = 2304;
constexpr int Z1_Q = 0, Z1_K = 768, Z1_V = 1024, Z1_IQ = 1280, Z1_IK = 1792, Z1_IW = 1856, Z1_MQ = 1920;
constexpr int NMEMROWS = 1024, MEMROW0 = MT;
constexpr float EPS = 1e-6f;
constexpr size_t MiB = 1u << 20;
constexpr size_t WS_CTL = 0, CTL_ZERO_BYTES = 2 * MiB;
constexpr size_t WS_WIN0 = 2 * MiB, WS_WIN1 = 11 * MiB, WS_WOUT = 16 * MiB, WS_WGU = 20 * MiB, WS_WD = 42 * MiB;
constexpr size_t WS_XB = 54 * MiB, WS_MEMKV = 89 * MiB, WS_MIX = 94 * MiB, WS_Z = 128 * MiB, WS_U = 234 * MiB, WS_UP = 324 * MiB, WS_ACT = 414 * MiB;
constexpr size_t WS_QB = 504 * MiB, WS_KB = 528 * MiB, WS_VB = 536 * MiB, WS_IQB = 544 * MiB, WS_IKB = 560 * MiB, WS_IW = 562 * MiB;
constexpr size_t WS_SQ = 563 * MiB, WS_SIQ = WS_SQ + 512 * 1024, WS_SIW = WS_SIQ + 384 * 1024, WS_SSC = 564 * MiB, WS_SIDX = 569 * MiB, WS_MASK = 570 * MiB, WS_SC = 578 * MiB, WS_END = 834 * MiB;
constexpr int SSC_LD = 8256;
constexpr int CW_TMO = 0, CW_BAR = 4096, CW_Q = 8192, CW_SS = 16384;
constexpr size_t O_YP = 0, O_YS = O_YP + (size_t)MP * DM, O_HP = O_YS + (size_t)MS * DM, O_HS = O_HP + 4 * 6 * 16384, O_KP = O_HS + 32 * 6 * 16384,
    O_VP = O_KP + (size_t)MP * 256, O_IKP = O_VP + (size_t)MP * 256, O_KS = O_IKP + (size_t)MP * 64, O_VS = O_KS + MS * 256, O_IKS = O_VS + MS * 256,
    O_MK = O_IKS + MS * 64, O_MV = O_MK + 2 * 1024 * 256, O_CVP = O_MV + 2 * 1024 * 256, O_CVS = O_CVP + 2 * 4 * 2 * DFF, O_END = O_CVS + 2 * 32 * 2 * DFF;
static_assert(O_END == 31412224, "output size");
constexpr int RING_OFF = 0, RING_BYTES = 131072;
constexpr int LDSCTL_OFF = RING_BYTES, MISC_OFF = LDSCTL_OFF + 320;
constexpr int LDS_BYTES = 147456;

#define GAS __attribute__((address_space(1)))
#define LAS __attribute__((address_space(3)))
typedef unsigned short bf16;
typedef unsigned v4u __attribute__((ext_vector_type(4)));
typedef float f32x4 __attribute__((ext_vector_type(4)));
typedef short bf16x8 __attribute__((ext_vector_type(8)));
typedef GAS unsigned gu32;
typedef GAS unsigned long long gu64;
#define RLX_AGENT __ATOMIC_RELAXED, __HIP_MEMORY_SCOPE_AGENT
#define LDS_WAIT() asm volatile("s_waitcnt lgkmcnt(0)" ::: "memory")
#define VM_WAIT() asm volatile("s_waitcnt vmcnt(0)" ::: "memory")
__device__ __forceinline__ unsigned long long rt() { return __builtin_amdgcn_s_memrealtime(); }
__device__ __forceinline__ unsigned f2bf(float f) { unsigned u = __builtin_bit_cast(unsigned, f); return (u + 0x7fffu + ((u >> 16) & 1u)) >> 16; }
__device__ __forceinline__ unsigned pk2(float lo, float hi) { return f2bf(lo) | (f2bf(hi) << 16); }

#define XB_TMO      128
#define XB_XCNT(j)  (256  + 64 * (j))
#define XB_XSUB(j)  (1280 + 64 * (j))
#define XB_XGEN(j)  (2304 + 64 * (j))
#define XB_TOP      3328
#define XB_TOPGEN   3392
#define XCD_BAR_WORDS 3456
#define XB_SPIN_CAP (1u << 18)

__device__ __forceinline__ unsigned xb_ld(unsigned* p)              { return __hip_atomic_load(p, __ATOMIC_RELAXED, __HIP_MEMORY_SCOPE_AGENT); }
__device__ __forceinline__ unsigned xb_add(unsigned* p, unsigned v) { return __hip_atomic_fetch_add(p, v, __ATOMIC_RELAXED, __HIP_MEMORY_SCOPE_AGENT); }
__device__ __forceinline__ unsigned xb_xcc_id() { return (unsigned)__builtin_amdgcn_s_getreg((3 << 11) | 20) & 0xFu; }
#define XB_SPIN(cond, bar) do { unsigned _sp = 0; while (cond) { __builtin_amdgcn_s_sleep(1); \
    if ((++_sp & 255u) == 0u) { if (xb_ld(&(bar)[XB_TMO])) break; if (_sp > XB_SPIN_CAP) { atomicAdd(&(bar)[XB_TMO], 1u); break; } } } } while (0)

struct XcdBarrier {
    unsigned* bar; unsigned x;
    volatile LAS unsigned* st;
};

__device__ __forceinline__ XcdBarrier xcd_barrier_post(unsigned* bar, volatile LAS unsigned* st) {
    XcdBarrier b; b.bar = bar; b.x = xb_xcc_id(); b.st = st;
    if (threadIdx.x == 0) (void)xb_add(&bar[XB_XCNT(b.x)], 1u);
    return b;
}
__device__ __forceinline__ void xcd_barrier_complete(unsigned* bar, unsigned x, unsigned& nloc, unsigned& nx) {
    const unsigned G = gridDim.x * gridDim.y * gridDim.z;
    unsigned sum, cnt, mine, sp = 0u;
    for (;;) {
        sum = 0u; cnt = 0u; mine = 0u;
#pragma unroll
        for (unsigned j = 0; j < 16; ++j) { const unsigned c = xb_ld(&bar[XB_XCNT(j)]); sum += c; cnt += (c > 0u) ? 1u : 0u; mine = (j == x) ? c : mine; }
        if (sum == G) break;
        __builtin_amdgcn_s_sleep(1);
        if ((++sp & 255u) == 0u) { if (xb_ld(&bar[XB_TMO])) break; if (sp > XB_SPIN_CAP) { atomicAdd(&bar[XB_TMO], 1u); break; } }
    }
    nloc = mine > 0u ? mine : 1u; nx = cnt > 0u ? cnt : 1u;
}

__device__ __forceinline__ void xcd_barrier(const XcdBarrier& b) {
    asm volatile("s_waitcnt vmcnt(0)" ::: "memory");
    __syncthreads();
    if (threadIdx.x == 0) {
        unsigned* bar = b.bar;
        __builtin_amdgcn_s_waitcnt(0);
        unsigned nloc = b.st[0], nx = b.st[1];
        if (nloc == 0u) { xcd_barrier_complete(bar, b.x, nloc, nx); b.st[0] = nloc; b.st[1] = nx; }
        const unsigned old = xb_add(&bar[XB_XSUB(b.x)], 1u);
        const unsigned gen = old / nloc;
        if (old + 1u == (gen + 1u) * nloc) {
            __builtin_amdgcn_fence(__ATOMIC_RELEASE, "agent");
            asm volatile("s_waitcnt vmcnt(0)" ::: "memory");
            const unsigned og = xb_add(&bar[XB_TOP], 1u);
            const unsigned tg = og / nx;
            if (og + 1u == (tg + 1u) * nx) xb_add(&bar[XB_TOPGEN], 1u);
            else XB_SPIN(xb_ld(&bar[XB_TOPGEN]) == tg, bar);
            __builtin_amdgcn_fence(__ATOMIC_ACQUIRE, "agent");
            xb_add(&bar[XB_XGEN(b.x)], 1u);
            asm volatile("s_waitcnt vmcnt(0)" ::: "memory");
        } else {
            XB_SPIN(xb_ld(&bar[XB_XGEN(b.x)]) == gen, bar);
            __builtin_amdgcn_fence(__ATOMIC_ACQUIRE, "agent");
            asm volatile("s_waitcnt vmcnt(0)" ::: "memory");
        }
    }
    __syncthreads();
}


struct Args { const float* in[29]; const int* page_table; float* out; unsigned char* ws; int ph_lo, ph_hi; };
typedef const __attribute__((address_space(4))) Args& ARGREF;
struct Ctx { LAS unsigned char* lds; volatile LAS unsigned* MISC; gu32* ctl; int tid, lane, wave, vcu, G, qoff; };
typedef float f32x16 __attribute__((ext_vector_type(16)));
typedef unsigned long long u64;

__device__ __forceinline__ float bf2f(unsigned b) { return __builtin_bit_cast(float, b << 16); }
__device__ __forceinline__ float wave_sum(float v) {
#pragma unroll
    for (int o = 1; o < 64; o <<= 1) v += __shfl_xor(v, o);
    return v;
}
__device__ __forceinline__ int crow(int r, int hi) { return (r & 3) + 8 * (r >> 2) + 4 * hi; }
__device__ __forceinline__ float sigmoidf_(float x) { return 1.0f / (1.0f + __expf(-x)); }
__device__ __forceinline__ float* ssptr(const Ctx& c, int i) { return (float*)(c.ctl + CW_SS) + (size_t)i * MT; }

__device__ __forceinline__ int q_next(Ctx& c, int qi) {
    __syncthreads();
    if (c.tid == 0) c.MISC[16] = atomicAdd((unsigned*)(c.ctl + CW_Q + 64 * (qi + c.qoff)), 1u);
    __syncthreads();
    return (int)c.MISC[16];
}

template <int K>
__device__ __forceinline__ f32x16 mm32(const LAS bf16* A, int lda, const LAS bf16* Bt, int ldb, f32x16 acc, int lane) {
    const int r = lane & 31, h = lane >> 5;
#pragma unroll
    for (int ks = 0; ks < K; ks += 16) {
        const bf16x8 a = *(const LAS bf16x8*)(A + r * lda + ks + 8 * h);
        const bf16x8 b = *(const LAS bf16x8*)(Bt + r * ldb + ks + 8 * h);
        acc = __builtin_amdgcn_mfma_f32_32x32x16_bf16(a, b, acc, 0, 0, 0);
    }
    return acc;
}

__device__ __forceinline__ int map_row(int mapid, int n, int row_off) {
    if (mapid == 0) return n + row_off;
    if (mapid == 1) return n < 1864 ? n : n + 56;
    if (mapid == 2) return (n >> 7) * 256 + (n & 127);
    return (n >> 7) * 256 + 128 + (n & 127);
}
__device__ __forceinline__ void transpose_item(const float* W, int K, int N, const float* kscale, bf16* WT, int mapid, int row_off, LAS float* scr, int item, int lane) {
    const int nblk = (N + 31) / 32, kb = item / nblk, nb = item % nblk, k0 = 64 * kb, n0 = 32 * nb;
    { const int n4 = (lane & 7) * 4, nn = n0 + n4 < N ? n0 + n4 : N - 4; f32x4 v[8];
#pragma unroll
      for (int i = 0; i < 8; ++i) v[i] = *(const f32x4*)(W + (size_t)(k0 + 8 * i + (lane >> 3)) * N + nn);
#pragma unroll
      for (int i = 0; i < 8; ++i) { const int kk = 8 * i + (lane >> 3); const float sc = kscale ? kscale[k0 + kk] : 1.0f; LAS float* d = scr + kk * 33 + n4;
          d[0] = v[i].x * sc; d[1] = v[i].y * sc; d[2] = v[i].z * sc; d[3] = v[i].w * sc; } }
    LDS_WAIT(); asm volatile("" ::: "memory");
    const int cc = lane & 7;
#pragma unroll
    for (int j = 0; j < 4; ++j) { const int nl = (lane >> 3) + 8 * j, n = n0 + nl; const LAS float* s = scr + (8 * cc) * 33 + nl;
        v4u o; o.x = pk2(s[0 * 33], s[1 * 33]); o.y = pk2(s[2 * 33], s[3 * 33]); o.z = pk2(s[4 * 33], s[5 * 33]); o.w = pk2(s[6 * 33], s[7 * 33]);
        if (n < N) *(GAS v4u*)(WT + (size_t)map_row(mapid, n, row_off) * K + k0 + 8 * cc) = o; }
    LDS_WAIT(); asm volatile("" ::: "memory");
}
__device__ __forceinline__ void p0_prologue(Ctx& c, ARGREF a) {
    LAS float* scr = (LAS float*)(c.lds + RING_OFF + c.wave * 16384);
    const int gw = c.vcu * NWAVES + c.wave, NGW = c.G * NWAVES, lane = c.lane;
    unsigned char* ws = a.ws;
    constexpr int I_INH = 16 * 104, I_MKV = 16 * 16, I_DSA = 16 * 67, I_OUT = 16 * 32, I_G = 16 * 88, I_D = 44 * 32;
    constexpr int NITEMS = I_INH + 2 * I_MKV + I_DSA + 2 * I_OUT + 4 * I_G + 2 * I_D;
    for (int it = gw; it < NITEMS; it += NGW) {
        int r = it;
        if (r < I_INH) { transpose_item(a.in[13], 1024, 3328, a.in[11], (bf16*)(ws + WS_WIN0), 0, 0, scr, r, lane); continue; } r -= I_INH;
        if (r < I_MKV) { transpose_item(a.in[20], 1024, 512, nullptr, (bf16*)(ws + WS_WIN0), 0, 3328, scr, r, lane); continue; } r -= I_MKV;
        if (r < I_MKV) { transpose_item(a.in[20] + 1024 * 512, 1024, 512, nullptr, (bf16*)(ws + WS_WIN0), 0, 3840, scr, r, lane); continue; } r -= I_MKV;
        if (r < I_DSA) { transpose_item(a.in[16], 1024, 2120, a.in[11] + 1024, (bf16*)(ws + WS_WIN1), 1, 0, scr, r, lane); continue; } r -= I_DSA;
        if (r < 2 * I_OUT) { const int l = r / I_OUT; transpose_item(a.in[23] + (size_t)l * 1024 * 1024, 1024, 1024, nullptr, (bf16*)(ws + WS_WOUT) + (size_t)l * 1024 * 1024, 0, 0, scr, r % I_OUT, lane); continue; } r -= 2 * I_OUT;
        if (r < 2 * I_G) { const int l = r / I_G; transpose_item(a.in[24] + (size_t)l * 1024 * DFF, 1024, DFF, a.in[12] + l * 1024, (bf16*)(ws + WS_WGU) + (size_t)l * 5632 * 1024, 2, 0, scr, r % I_G, lane); continue; } r -= 2 * I_G;
        if (r < 2 * I_G) { const int l = r / I_G; transpose_item(a.in[25] + (size_t)l * 1024 * DFF, 1024, DFF, a.in[12] + l * 1024, (bf16*)(ws + WS_WGU) + (size_t)l * 5632 * 1024, 3, 0, scr, r % I_G, lane); continue; } r -= 2 * I_G;
        { const int l = r / I_D; transpose_item(a.in[28] + (size_t)l * DFF * 1024, DFF, 1024, nullptr, (bf16*)(ws + WS_WD) + (size_t)l * 1024 * DFF, 0, 0, scr, r % I_D, lane); }
    }
    for (int rr = gw; rr < 184; rr += NGW) { const int row = rr < 56 ? 1864 + rr : 2176 + (rr - 56);
        GAS v4u* p = (GAS v4u*)((bf16*)(ws + WS_WIN1) + (size_t)row * 1024); p[lane] = (v4u){0u, 0u, 0u, 0u}; p[64 + lane] = (v4u){0u, 0u, 0u, 0u}; }
    float* ss0 = ssptr(c, 0);
    for (int m = gw; m < MT + NMEMROWS; m += NGW) {
        GAS u64* o8 = (GAS u64*)((bf16*)(ws + WS_XB) + (size_t)m * DM) + lane;
        if (m >= MVALID && m < MT) {
#pragma unroll
            for (int j = 0; j < 4; ++j) o8[64 * j] = 0ull;
            continue; }
        const float* src = m < MP ? a.in[0] + (size_t)m * DM : (m < MVALID ? a.in[1] + (size_t)(m - MP) * DM : a.in[10] + (size_t)(m - MT) * DM);
        const GAS f32x4* xr = (const GAS f32x4*)src + lane; f32x4 v[4]; float s = 0.f;
#pragma unroll
        for (int j = 0; j < 4; ++j) { v[j] = xr[64 * j]; s += (v[j].x * v[j].x + v[j].y * v[j].y) + (v[j].z * v[j].z + v[j].w * v[j].w); }
        s = wave_sum(s);
#pragma unroll
        for (int j = 0; j < 4; ++j) o8[64 * j] = (u64)pk2(v[j].x, v[j].y) | ((u64)pk2(v[j].z, v[j].w) << 32);
        if (m < MVALID && lane == 0) ss0[m] = s;
    }
}

__device__ __forceinline__ void memattn_unit(Ctx& c, const bf16* Zq  , int ldz, int nrows_valid, const float* Kp, const float* Vp, int kstride,
                                             bool normk, const float* kgain, const float* qgain, bf16* Out  ) {
    LAS bf16* KN = (LAS bf16*)(c.lds);
    LAS bf16* VTm = (LAS bf16*)(c.lds + 36864);
    LAS bf16* QN = (LAS bf16*)(c.lds + 70656) + c.wave * (32 * 72);
    LAS float* LI = (LAS float*)(c.lds + 107520) + c.wave * 32;
    int tid = c.tid; asm volatile("" : "+v"(tid));
    const int lane = tid & 63, w = c.wave;
    {
        const int m = tid >> 1, dh = (tid & 1) * 32;
        f32x4 kv[8]; float s = 0.f;
#pragma unroll
        for (int j = 0; j < 8; ++j) { kv[j] = *(const f32x4*)(Kp + (size_t)m * kstride + dh + 4 * j); s += (kv[j].x * kv[j].x + kv[j].y * kv[j].y) + (kv[j].z * kv[j].z + kv[j].w * kv[j].w); }
        s += __shfl_xor(s, 1);
        const float rs = normk ? rsqrtf(s * (1.0f / 64.0f) + EPS) : 1.0f;
#pragma unroll
        for (int j = 0; j < 8; j += 2) { f32x4 g0 = {1.f, 1.f, 1.f, 1.f}, g1 = g0;
            if (normk) { g0 = *(const f32x4*)(kgain + dh + 4 * j); g1 = *(const f32x4*)(kgain + dh + 4 * j + 4); }
            const f32x4 x0 = kv[j] * rs * g0, x1 = kv[j + 1] * rs * g1;
            v4u o; o.x = pk2(x0.x, x0.y); o.y = pk2(x0.z, x0.w); o.z = pk2(x1.x, x1.y); o.w = pk2(x1.z, x1.w);
            *(LAS v4u*)(KN + m * 72 + dh + 4 * j) = o; }
#pragma unroll
        for (int j = 0; j < 8; ++j) { const f32x4 vv = *(const f32x4*)(Vp + (size_t)m * kstride + dh + 4 * j);
            VTm[(dh + 4 * j + 0) * 264 + m] = (bf16)f2bf(vv.x); VTm[(dh + 4 * j + 1) * 264 + m] = (bf16)f2bf(vv.y);
            VTm[(dh + 4 * j + 2) * 264 + m] = (bf16)f2bf(vv.z); VTm[(dh + 4 * j + 3) * 264 + m] = (bf16)f2bf(vv.w); }
    }
    {
        const int row = lane >> 1, hf = lane & 1, grow = w * 32 + row;
        float x[32]; float s = 0.f;
        if (grow < nrows_valid) {
#pragma unroll
            for (int j = 0; j < 4; ++j) { const v4u q = *(const v4u*)(Zq + (size_t)grow * ldz + hf * 32 + 8 * j);
                x[8 * j + 0] = bf2f(q.x & 0xffffu); x[8 * j + 1] = bf2f(q.x >> 16); x[8 * j + 2] = bf2f(q.y & 0xffffu); x[8 * j + 3] = bf2f(q.y >> 16);
                x[8 * j + 4] = bf2f(q.z & 0xffffu); x[8 * j + 5] = bf2f(q.z >> 16); x[8 * j + 6] = bf2f(q.w & 0xffffu); x[8 * j + 7] = bf2f(q.w >> 16); }
        } else {
#pragma unroll
            for (int j = 0; j < 32; ++j) x[j] = 0.f;
        }
#pragma unroll
        for (int j = 0; j < 32; ++j) s += x[j] * x[j];
        s += __shfl_xor(s, 1);
        const float rs = rsqrtf(s * (1.0f / 64.0f) + EPS) * 0.125f;
#pragma unroll
        for (int j = 0; j < 32; j += 8) { v4u o;
            o.x = pk2(x[j] * rs * qgain[hf * 32 + j], x[j + 1] * rs * qgain[hf * 32 + j + 1]); o.y = pk2(x[j + 2] * rs * qgain[hf * 32 + j + 2], x[j + 3] * rs * qgain[hf * 32 + j + 3]);
            o.z = pk2(x[j + 4] * rs * qgain[hf * 32 + j + 4], x[j + 5] * rs * qgain[hf * 32 + j + 5]); o.w = pk2(x[j + 6] * rs * qgain[hf * 32 + j + 6], x[j + 7] * rs * qgain[hf * 32 + j + 7]);
            *(LAS v4u*)(QN + row * 72 + hf * 32 + j) = o; }
    }
    __syncthreads();
    if (w * 32 < nrows_valid) {
        const int r32 = lane & 31, hh = lane >> 5;
        f32x16 s[8];
#pragma unroll
        for (int mt = 0; mt < 8; ++mt) { f32x16 z = {}; s[mt] = mm32<64>(KN + mt * 32 * 72, 72, QN, 72, z, lane); }
        float mx = -1e30f;
#pragma unroll
        for (int mt = 0; mt < 8; ++mt)
#pragma unroll
            for (int r = 0; r < 16; ++r) mx = fmaxf(mx, s[mt][r]);
        mx = fmaxf(mx, __shfl_xor(mx, 32));
        float l = 0.f;
#pragma unroll
        for (int mt = 0; mt < 8; ++mt)
#pragma unroll
            for (int r = 0; r < 16; ++r) { const float p = __expf(s[mt][r] - mx); s[mt][r] = p; l += p; }
        l += __shfl_xor(l, 32);
        if (hh == 0) LI[r32] = l;
        f32x16 o[2] = {};
#pragma unroll
        for (int mt = 0; mt < 8; ++mt)
#pragma unroll
            for (int sx = 0; sx < 2; ++sx) {
                v4u pa; pa.x = pk2(s[mt][8 * sx + 0], s[mt][8 * sx + 1]); pa.y = pk2(s[mt][8 * sx + 2], s[mt][8 * sx + 3]);
                pa.z = pk2(s[mt][8 * sx + 4], s[mt][8 * sx + 5]); pa.w = pk2(s[mt][8 * sx + 6], s[mt][8 * sx + 7]);
                const bf16x8 af = __builtin_bit_cast(bf16x8, pa);
#pragma unroll
                for (int dt = 0; dt < 2; ++dt) { const LAS bf16* vp = VTm + (dt * 32 + r32) * 264 + mt * 32 + 16 * sx + 4 * hh;
                    const u64 lo = *(const LAS u64*)vp, hi = *(const LAS u64*)(vp + 8);
                    v4u bw; bw.x = (unsigned)lo; bw.y = (unsigned)(lo >> 32); bw.z = (unsigned)hi; bw.w = (unsigned)(hi >> 32);
                    o[dt] = __builtin_amdgcn_mfma_f32_32x32x16_bf16(af, __builtin_bit_cast(bf16x8, bw), o[dt], 0, 0, 0); }
            }
        LDS_WAIT();
#pragma unroll
        for (int r = 0; r < 16; ++r) { const int qr = crow(r, hh), grow = w * 32 + qr; const float il = 1.0f / LI[qr];
            if (grow < nrows_valid) {
#pragma unroll
                for (int dt = 0; dt < 2; ++dt) Out[(size_t)grow * DM + dt * 32 + r32] = (bf16)f2bf(o[dt][r] * il); } }
    }
}

constexpr int HG_GS = 4, HG_NG = SEQ / (32 * HG_GS);
constexpr size_t WS_HOL = WS_U, WS_HQC = WS_UP, WS_HUT = WS_ACT, WS_HST = WS_ACT + 64 * MiB, WS_HDG = WS_ACT + 50 * MiB;
template <bool PROMPT>
__device__ __forceinline__ void hgrn_unit(Ctx& c, ARGREF a, int b, int h, int g) {
    LAS unsigned char* L = c.lds;
    LAS float* LF = (LAS float*)(L + 0);
    LAS float* BL = (LAS float*)(L + 16384);
    LAS float* DVv = (LAS float*)(L + 16896);
    LAS bf16* QD = (LAS bf16*)(L + 17408);
    LAS bf16* KD = (LAS bf16*)(L + 26112);
    LAS bf16* KET = (LAS bf16*)(L + 34816);
    LAS bf16* VT = (LAS bf16*)(L + 45056);
    LAS bf16* SCB = (LAS bf16*)(L + 55296);
    LAS bf16* STt = (LAS bf16*)(L + 57856);
    LAS float* BOFF = (LAS float*)(L + 92672);
    int tid = c.tid; asm volatile("" : "+v"(tid));
    const int lane = tid & 63, w = c.wave, r32 = lane & 31, hh = lane >> 5;
    const int te = tid >> 4, k8 = (tid & 15) * 8;
    const bf16* Z = (const bf16*)(a.ws + WS_Z);
    bf16* MIX = (bf16*)(a.ws + WS_MIX);
    const int nch = PROMPT ? HG_GS : 1, nvalid = PROMPT ? 32 : 4;
    const int kt = w >> 1, vt0 = 2 * (w & 1);
    const int unit = (b * 6 + h) * HG_NG + g;
    f32x16 S0 = {}, S1 = {};
    if (!PROMPT) { const float* sp = a.in[7] + (size_t)(b * 6 + h) * 16384;
#pragma unroll
        for (int r = 0; r < 16; ++r) { const int k = 32 * kt + crow(r, hh); S0[r] = sp[k * 128 + 32 * vt0 + r32]; S1[r] = sp[k * 128 + 32 * (vt0 + 1) + r32]; } }
    float lbv[8], onv[8];
#pragma unroll
    for (int j = 0; j < 8; ++j) { const float l0 = a.in[14][h * 128 + k8 + j], l1 = a.in[14][768 + h * 128 + k8 + j]; lbv[j] = 1.0f / (1.0f + __expf(l1 - l0)); onv[j] = a.in[15][k8 + j]; }
    __syncthreads();
    if (tid < 128) BOFF[tid] = 0.f;
#define HG_WRITE_ST() do { _Pragma("unroll") for (int g4 = 0; g4 < 4; ++g4) { const int k0 = 32 * kt + 8 * g4 + 4 * hh; \
        *(LAS u64*)(STt + (32 * vt0 + r32) * 136 + k0) = (u64)pk2(S0[4 * g4], S0[4 * g4 + 1]) | ((u64)pk2(S0[4 * g4 + 2], S0[4 * g4 + 3]) << 32); \
        *(LAS u64*)(STt + (32 * (vt0 + 1) + r32) * 136 + k0) = (u64)pk2(S1[4 * g4], S1[4 * g4 + 1]) | ((u64)pk2(S1[4 * g4 + 2], S1[4 * g4 + 3]) << 32); } } while (0)
    HG_WRITE_ST();
#pragma unroll 1
    for (int ch = 0; ch < nch; ++ch) {
        const int row0 = PROMPT ? b * SEQ + (g * HG_GS + ch) * 32 : MP + 4 * b, row = row0 + te;
        const bool valid = te < nvalid;
        float qs[8], kk[8]; v4u gz = {0u, 0u, 0u, 0u};
        {
            v4u zq = {0u, 0u, 0u, 0u}, zf = zq, zi = zq;
            if (valid) { const bf16* zr = Z + (size_t)row * ZC0 + h * 128 + k8;
                zq = *(const v4u*)zr; zf = *(const v4u*)(zr + 768); zi = *(const v4u*)(zr + 1536); if (!PROMPT) gz = *(const v4u*)(zr + 2304); }
            const unsigned qw[4] = {zq.x, zq.y, zq.z, zq.w}, fw[4] = {zf.x, zf.y, zf.z, zf.w}, iw[4] = {zi.x, zi.y, zi.z, zi.w};
            float lf[8];
#pragma unroll
            for (int j = 0; j < 8; ++j) { const float q = bf2f((qw[j >> 1] >> (16 * (j & 1))) & 0xffffu), fp = bf2f((fw[j >> 1] >> (16 * (j & 1))) & 0xffffu);
                const float sg = sigmoidf_(fp), f = lbv[j] + (1.0f - lbv[j]) * sg;
                qs[j] = valid ? q * sigmoidf_(q) : 0.f; kk[j] = valid ? (1.0f - f) : 0.f; lf[j] = valid ? __logf(f) : 0.f;
                VT[(k8 + j) * 40 + te] = (bf16)((iw[j >> 1] >> (16 * (j & 1))) & 0xffffu); }
            *(LAS f32x4*)(LF + te * 128 + k8) = (f32x4){lf[0], lf[1], lf[2], lf[3]}; *(LAS f32x4*)(LF + te * 128 + k8 + 4) = (f32x4){lf[4], lf[5], lf[6], lf[7]};
        }
        __syncthreads();
        if (tid < 128) { float bsum = 0.f;
#pragma unroll
            for (int t = 0; t < 32; ++t) { bsum += LF[t * 128 + tid]; LF[t * 128 + tid] = bsum; }
            BL[tid] = bsum; }
        __syncthreads();
        {
            const f32x4 b0 = *(const LAS f32x4*)(LF + te * 128 + k8), b1 = *(const LAS f32x4*)(LF + te * 128 + k8 + 4);
            const f32x4 l0 = *(const LAS f32x4*)(BL + k8), l1 = *(const LAS f32x4*)(BL + k8 + 4);
            const float bb[8] = {b0.x, b0.y, b0.z, b0.w, b1.x, b1.y, b1.z, b1.w}, bl[8] = {l0.x, l0.y, l0.z, l0.w, l1.x, l1.y, l1.z, l1.w};
            float qd[8], kd[8];
#pragma unroll
            for (int j = 0; j < 8; ++j) { qd[j] = qs[j] * __expf(bb[j]); kd[j] = kk[j] * __expf(-bb[j]); KET[(k8 + j) * 40 + te] = (bf16)f2bf(kk[j] * __expf(bl[j] - bb[j])); }
            v4u o; o.x = pk2(qd[0], qd[1]); o.y = pk2(qd[2], qd[3]); o.z = pk2(qd[4], qd[5]); o.w = pk2(qd[6], qd[7]); *(LAS v4u*)(QD + te * 136 + k8) = o;
            if (PROMPT) { const f32x4 f0 = *(const LAS f32x4*)(BOFF + k8), f1 = *(const LAS f32x4*)(BOFF + k8 + 4);
                const float bo[8] = {f0.x, f0.y, f0.z, f0.w, f1.x, f1.y, f1.z, f1.w}; float qc[8];
#pragma unroll
                for (int j = 0; j < 8; ++j) qc[j] = qd[j] * __expf(bo[j]);
                v4u oc; oc.x = pk2(qc[0], qc[1]); oc.y = pk2(qc[2], qc[3]); oc.z = pk2(qc[4], qc[5]); oc.w = pk2(qc[6], qc[7]);
                *(v4u*)((bf16*)(a.ws + WS_HQC) + (size_t)row * 768 + h * 128 + k8) = oc; }
            o.x = pk2(kd[0], kd[1]); o.y = pk2(kd[2], kd[3]); o.z = pk2(kd[4], kd[5]); o.w = pk2(kd[6], kd[7]); *(LAS v4u*)(KD + te * 136 + k8) = o;
            if (te == 0) {
#pragma unroll
                for (int j = 0; j < 8; ++j) DVv[k8 + j] = __expf(bl[j]); }
        }
        __syncthreads();
        f32x16 oacc = {};
        if (w == 0) { f32x16 z = {}; const f32x16 sc = mm32<128>(QD, 136, KD, 136, z, lane);
#pragma unroll
            for (int r = 0; r < 16; ++r) { const int t = crow(r, hh); SCB[t * 40 + r32] = (bf16)f2bf(r32 <= t ? sc[r] : 0.f); } }
        if (w < 4) oacc = mm32<128>(QD, 136, STt + (w * 32) * 136, 136, oacc, lane);
        if (PROMPT && tid >= 384) BOFF[tid - 384] += BL[tid - 384];
        __syncthreads();
        if (w < 4) { oacc = mm32<32>(SCB, 40, VT + (w * 32) * 40, 40, oacc, lane);
#pragma unroll
            for (int r = 0; r < 16; ++r) LF[crow(r, hh) * 128 + w * 32 + r32] = oacc[r]; }
        {
#pragma unroll
            for (int r = 0; r < 16; ++r) { const float d = DVv[32 * kt + crow(r, hh)]; S0[r] *= d; S1[r] *= d; }
            S0 = mm32<32>(KET + (kt * 32) * 40, 40, VT + (vt0 * 32) * 40, 40, S0, lane);
            S1 = mm32<32>(KET + (kt * 32) * 40, 40, VT + ((vt0 + 1) * 32) * 40, 40, S1, lane);
        }
        __syncthreads();
        HG_WRITE_ST();
        {
            const f32x4 o0 = *(const LAS f32x4*)(LF + te * 128 + k8), o1 = *(const LAS f32x4*)(LF + te * 128 + k8 + 4);
            if (PROMPT) { float* ol = (float*)(a.ws + WS_HOL) + (size_t)row * 768 + h * 128 + k8; *(f32x4*)ol = o0; *(f32x4*)(ol + 4) = o1; }
            else {
                float ov[8] = {o0.x, o0.y, o0.z, o0.w, o1.x, o1.y, o1.z, o1.w}; float s = 0.f;
#pragma unroll
                for (int j = 0; j < 8; ++j) s += ov[j] * ov[j];
                s += __shfl_xor(s, 1); s += __shfl_xor(s, 2); s += __shfl_xor(s, 4); s += __shfl_xor(s, 8);
                const float rs = rsqrtf(s * (1.0f / 128.0f) + EPS);
                const unsigned gw_[4] = {gz.x, gz.y, gz.z, gz.w}; float y[8];
#pragma unroll
                for (int j = 0; j < 8; ++j) { const float gg = bf2f((gw_[j >> 1] >> (16 * (j & 1))) & 0xffffu); y[j] = ov[j] * rs * onv[j] * (gg * sigmoidf_(gg)); }
                if (valid) { v4u o; o.x = pk2(y[0], y[1]); o.y = pk2(y[2], y[3]); o.z = pk2(y[4], y[5]); o.w = pk2(y[6], y[7]); *(v4u*)(MIX + (size_t)row * DM + h * 128 + k8) = o; }
            }
        }
        __syncthreads();
    }
#undef HG_WRITE_ST
    if (PROMPT) {
        float* ut = (float*)(a.ws + WS_HUT) + (size_t)unit * 16384;
#pragma unroll
        for (int g4 = 0; g4 < 4; ++g4) { const int k0 = 32 * kt + 8 * g4 + 4 * hh;
            *(f32x4*)(ut + (32 * vt0 + r32) * 128 + k0) = (f32x4){S0[4 * g4], S0[4 * g4 + 1], S0[4 * g4 + 2], S0[4 * g4 + 3]};
            *(f32x4*)(ut + (32 * (vt0 + 1) + r32) * 128 + k0) = (f32x4){S1[4 * g4], S1[4 * g4 + 1], S1[4 * g4 + 2], S1[4 * g4 + 3]}; }
        if (tid < 128) ((float*)(a.ws + WS_HDG))[(size_t)unit * 128 + tid] = __expf(BOFF[tid]);
    } else {
        float* so = a.out + O_HS + (size_t)(b * 6 + h) * 16384;
#pragma unroll
        for (int r = 0; r < 16; ++r) { const int k = 32 * kt + crow(r, hh); so[k * 128 + 32 * vt0 + r32] = S0[r]; so[k * 128 + 32 * (vt0 + 1) + r32] = S1[r]; }
    }
}
__device__ __forceinline__ void hgrn_scan(Ctx& c, ARGREF a) {
    const float* UT = (const float*)(a.ws + WS_HUT); const float* DG = (const float*)(a.ws + WS_HDG); bf16* STo = (bf16*)(a.ws + WS_HST);
    for (int idx = c.vcu * 512 + c.tid; idx < 24 * 16384; idx += c.G * 512) {
        const int bh = idx >> 14, e = idx & 16383, k = e & 127, v = e >> 7;
        float s = 0.f;
#pragma unroll 8
        for (int g = 0; g < HG_NG; ++g) { const size_t u = (size_t)(bh * HG_NG + g); STo[u * 16384 + e] = (bf16)f2bf(s); s = DG[u * 128 + k] * s + UT[u * 16384 + e]; }
        a.out[O_HP + (size_t)bh * 16384 + k * 128 + v] = s;
    }
}
__device__ __forceinline__ void hgrn_fix_unit(Ctx& c, ARGREF a, int b, int h, int g) {
    LAS bf16* STt = (LAS bf16*)(c.lds);
    LAS bf16* QCl = (LAS bf16*)(c.lds + 34816);
    LAS float* OB = (LAS float*)(c.lds + 34816 + 17408);
    int tid = c.tid; asm volatile("" : "+v"(tid));
    const int lane = tid & 63, w = c.wave, r32 = lane & 31, hh = lane >> 5;
    const int unit = (b * 6 + h) * HG_NG + g, row0 = b * SEQ + g * 128;
    const bf16* Z = (const bf16*)(a.ws + WS_Z); bf16* MIX = (bf16*)(a.ws + WS_MIX);
    const bf16* QC = (const bf16*)(a.ws + WS_HQC); const float* OL = (const float*)(a.ws + WS_HOL);
    const bf16* stg = (const bf16*)(a.ws + WS_HST) + (size_t)unit * 16384;
    __syncthreads();
#pragma unroll
    for (int i = 0; i < 4; ++i) { const int cidx = tid + 512 * i, v = cidx >> 4, kc = (cidx & 15) * 8; *(LAS v4u*)(STt + v * 136 + kc) = *(const v4u*)(stg + v * 128 + kc); }
    const int te = tid >> 4, k8 = (tid & 15) * 8;
    float onv[8];
#pragma unroll
    for (int j = 0; j < 8; ++j) onv[j] = a.in[15][k8 + j];
#pragma unroll 1
    for (int hf = 0; hf < 2; ++hf) {
        const int rb = row0 + hf * 64;
#pragma unroll
        for (int i = 0; i < 2; ++i) { const int cidx = tid + 512 * i, r = cidx >> 4, kc = (cidx & 15) * 8; *(LAS v4u*)(QCl + r * 136 + kc) = *(const v4u*)(QC + (size_t)(rb + r) * 768 + h * 128 + kc); }
        __syncthreads();
        { const int rt = w >> 2, vt = w & 3; f32x16 o = {};
          o = mm32<128>(QCl + (rt * 32) * 136, 136, STt + (vt * 32) * 136, 136, o, lane);
#pragma unroll
          for (int r = 0; r < 16; ++r) OB[(rt * 32 + crow(r, hh)) * 128 + vt * 32 + r32] = o[r]; }
        __syncthreads();
#pragma unroll
        for (int ps = 0; ps < 2; ++ps) { const int r = ps * 32 + te, row = rb + r;
            const f32x4 c0 = *(const LAS f32x4*)(OB + r * 128 + k8), c1 = *(const LAS f32x4*)(OB + r * 128 + k8 + 4);
            const float* ol = OL + (size_t)row * 768 + h * 128 + k8; const f32x4 l0 = *(const f32x4*)ol, l1 = *(const f32x4*)(ol + 4);
            const v4u gz = *(const v4u*)(Z + (size_t)row * ZC0 + 2304 + h * 128 + k8);
            float ov[8] = {c0.x + l0.x, c0.y + l0.y, c0.z + l0.z, c0.w + l0.w, c1.x + l1.x, c1.y + l1.y, c1.z + l1.z, c1.w + l1.w}; float s = 0.f;
#pragma unroll
            for (int j = 0; j < 8; ++j) s += ov[j] * ov[j];
            s += __shfl_xor(s, 1); s += __shfl_xor(s, 2); s += __shfl_xor(s, 4); s += __shfl_xor(s, 8);
            const float rs = rsqrtf(s * (1.0f / 128.0f) + EPS);
            const unsigned gw_[4] = {gz.x, gz.y, gz.z, gz.w}; float y[8];
#pragma unroll
            for (int j = 0; j < 8; ++j) { const float gg = bf2f((gw_[j >> 1] >> (16 * (j & 1))) & 0xffffu); y[j] = ov[j] * rs * onv[j] * (gg * sigmoidf_(gg)); }
            v4u o; o.x = pk2(y[0], y[1]); o.y = pk2(y[2], y[3]); o.z = pk2(y[4], y[5]); o.w = pk2(y[6], y[7]); *(v4u*)(MIX + (size_t)row * DM + h * 128 + k8) = o; }
        __syncthreads();
    }
}

__device__ __forceinline__ void memkv_finalize_row(ARGREF a, int layer, int row, int lane) {
    const float* src = (const float*)(a.ws + WS_MEMKV) + (size_t)row * 1024 + layer * 512;
    const int hd = lane >> 4, d4 = (lane & 15) * 4;
    const f32x4 k = *(const f32x4*)(src + hd * 64 + d4), v = *(const f32x4*)(src + 256 + hd * 64 + d4);
    float s = (k.x * k.x + k.y * k.y) + (k.z * k.z + k.w * k.w);
    s += __shfl_xor(s, 1); s += __shfl_xor(s, 2); s += __shfl_xor(s, 4); s += __shfl_xor(s, 8);
    const float rs = rsqrtf(s * (1.0f / 64.0f) + EPS); const f32x4 g = *(const f32x4*)(a.in[22] + layer * 64 + d4);
    *(f32x4*)(a.out + O_MK + ((size_t)layer * 1024 + row) * 256 + hd * 64 + d4) = k * rs * g;
    *(f32x4*)(a.out + O_MV + ((size_t)layer * 1024 + row) * 256 + hd * 64 + d4) = v;
}

__device__ __forceinline__ void memattn_prompt_unit(Ctx& c, ARGREF a, int layer, int u) {
    const int blk = u & 15, hd = (u >> 4) & 3, b = u >> 6;
    const bf16* Z = (const bf16*)(a.ws + WS_Z); const int ldz = layer ? ZC1 : ZC0, qc = layer ? Z1_MQ : 3072;
    const float* kv = (const float*)(a.ws + WS_MEMKV) + (size_t)(b * 256) * 1024 + layer * 512 + hd * 64;
    const int row0 = b * SEQ + blk * 256;
    memattn_unit(c, Z + (size_t)row0 * ldz + qc + hd * 64, ldz, 256, kv, kv + 256, 1024, true, a.in[22] + layer * 64, a.in[21] + layer * 64,
                 (bf16*)(a.ws + WS_MIX) + (size_t)row0 * DM + 768 + hd * 64);
}
__device__ __forceinline__ void memattn_sample_unit(Ctx& c, ARGREF a, int layer, int u) {
    const int hd = u & 3, sb = u >> 2;
    const bf16* Z = (const bf16*)(a.ws + WS_Z); const int ldz = layer ? ZC1 : ZC0, qc = layer ? Z1_MQ : 3072;
    const size_t off = ((size_t)(layer * 32 + sb) * 256) * 256 + hd * 64;
    const int row0 = MP + sb * 4;
    memattn_unit(c, Z + (size_t)row0 * ldz + qc + hd * 64, ldz, 4, a.in[5] + off, a.in[6] + off, 256, false, nullptr, a.in[21] + layer * 64,
                 (bf16*)(a.ws + WS_MIX) + (size_t)row0 * DM + 768 + hd * 64);
}

__device__ __forceinline__ void p2_mixer0(Ctx& c, ARGREF a) {
    constexpr int U_HP = 24 * HG_NG, U_MAP = U_HP + 256, U_HS = U_MAP + 192, U_MAS = U_HS + 128, U_FIN = U_MAS + 256;
    for (;;) {
        const int u = q_next(c, 0);
        if (u >= U_FIN) break;
        if (u < U_HP) hgrn_unit<true>(c, a, u / (6 * HG_NG), (u / HG_NG) % 6, u % HG_NG);
        else if (u < U_MAP) memattn_prompt_unit(c, a, 0, u - U_HP);
        else if (u < U_HS) { const int v = u - U_MAP; hgrn_unit<false>(c, a, v / 6, v % 6, 0); }
        else if (u < U_MAS) memattn_sample_unit(c, a, 0, u - U_HS);
        else { const int v = (u - U_MAS) * 8 + c.wave; memkv_finalize_row(a, v >> 10, v & 1023, c.lane); }
    }
}
__device__ __forceinline__ void p2c_hgrn_fix(Ctx& c, ARGREF a) {
    for (int u = c.vcu; u < 24 * HG_NG; u += c.G) hgrn_fix_unit(c, a, u / (6 * HG_NG), (u / HG_NG) % 6, u % HG_NG);
}

constexpr size_t WS_G4 = WS_UP + 64 * MiB, WS_UP2 = WS_UP + 80 * MiB;
__device__ __forceinline__ void conv_fixup_tile(Ctx& c, ARGREF a, int layer, int pm) {
    const float* G4 = (const float*)(a.ws + WS_G4); const float* UP2 = (const float*)(a.ws + WS_UP2); bf16* ACT = (bf16*)(a.ws + WS_ACT);
    const float* cw = a.in[26] + (size_t)layer * 3 * DFF; const float* cb = a.in[27] + (size_t)layer * DFF;
    for (int idx = c.tid; idx < 8 * (DFF / 4); idx += 512) {
        const int rr = idx / (DFF / 4), c4 = (idx - rr * (DFF / 4)) * 4;
        const int slab = 4 * pm + (rr >> 1), fr = rr & 1, row = slab * 64 + fr, t = row & 4095, sl1 = slab > 0 ? slab - 1 : 0;
        const f32x4 ut = *(const f32x4*)(G4 + (size_t)(slab * 4 + fr) * DFF + c4), up = *(const f32x4*)(UP2 + (size_t)(slab * 2 + fr) * DFF + c4);
        const f32x4 a0 = *(const f32x4*)(G4 + (size_t)(slab * 4 + 0) * DFF + c4), b3 = *(const f32x4*)(G4 + (size_t)(sl1 * 4 + 3) * DFF + c4), b2 = *(const f32x4*)(G4 + (size_t)(sl1 * 4 + 2) * DFF + c4);
        f32x4 u1, u2;
        { const bool f1 = fr == 1, t0 = t == 0, t1 = t == 1;
          u1.x = f1 ? a0.x : (t0 ? 0.f : b3.x); u1.y = f1 ? a0.y : (t0 ? 0.f : b3.y); u1.z = f1 ? a0.z : (t0 ? 0.f : b3.z); u1.w = f1 ? a0.w : (t0 ? 0.f : b3.w);
          u2.x = f1 ? (t1 ? 0.f : b3.x) : (t0 ? 0.f : b2.x); u2.y = f1 ? (t1 ? 0.f : b3.y) : (t0 ? 0.f : b2.y); u2.z = f1 ? (t1 ? 0.f : b3.z) : (t0 ? 0.f : b2.z); u2.w = f1 ? (t1 ? 0.f : b3.w) : (t0 ? 0.f : b2.w); }
        const f32x4 w0 = *(const f32x4*)(cw + c4), w1 = *(const f32x4*)(cw + DFF + c4), w2 = *(const f32x4*)(cw + 2 * DFF + c4), bb = *(const f32x4*)(cb + c4);
        const f32x4 cv = bb + w0 * u2 + w1 * u1 + w2 * ut;
        const float y0 = cv.x * sigmoidf_(cv.x) * up.x, y1 = cv.y * sigmoidf_(cv.y) * up.y, y2 = cv.z * sigmoidf_(cv.z) * up.z, y3 = cv.w * sigmoidf_(cv.w) * up.w;
        *(u64*)(ACT + (size_t)row * DFF + c4) = (u64)pk2(y0, y1) | ((u64)pk2(y2, y3) << 32);
    }
}


struct SgArgs { const bf16* A; const bf16* Bt; int K; int mode; bf16* Z; int ldz; const float* ssin; const float* resid; const bf16* rb; float* y; bf16* xb; float* ssout; bf16* ACT; float* cvs; const float* cst; const float* cw; const float* cb; };
__device__ __forceinline__ void sgemm_unit(Ctx& c, const SgArgs& g, int n0) {
    int tid = c.tid; asm volatile("" : "+v"(tid));
    const int lane = tid & 63, w = c.wave, r32 = lane & 31, hh = lane >> 5;
    const int K = g.K, ks = K >> 3;
    const int f2 = (n0 >> 1) + (r32 & 15), brow = g.mode == 2 ? (f2 >> 7) * 256 + (f2 & 127) + (r32 >= 16 ? 128 : 0) : n0 + r32;
    const bf16* bp = g.Bt + (size_t)brow * K + w * ks + 8 * hh;
    const bf16* ap = g.A + (size_t)r32 * K + w * ks + 8 * hh;
    f32x16 acc[4] = {};
    bf16x8 afA[4][2], bfA[2], afB[4][2], bfB[2];
#define SG_LOAD(AF, BF, kk) do { _Pragma("unroll") for (int i = 0; i < 2; ++i) { BF[i] = *(const bf16x8*)(bp + (kk) + 16 * i); \
        _Pragma("unroll") for (int rt = 0; rt < 4; ++rt) AF[rt][i] = *(const bf16x8*)(ap + (size_t)(rt * 32) * K + (kk) + 16 * i); } } while (0)
#define SG_MMA(AF, BF) do { _Pragma("unroll") for (int i = 0; i < 2; ++i) _Pragma("unroll") for (int rt = 0; rt < 4; ++rt) acc[rt] = __builtin_amdgcn_mfma_f32_32x32x16_bf16(AF[rt][i], BF[i], acc[rt], 0, 0, 0); } while (0)
    SG_LOAD(afA, bfA, 0);
#pragma unroll 1
    for (int k = 0; k < ks; k += 64) {
        if (k + 32 < ks) SG_LOAD(afB, bfB, k + 32);
        SG_MMA(afA, bfA);
        if (k + 32 < ks) { if (k + 64 < ks) SG_LOAD(afA, bfA, k + 64); SG_MMA(afB, bfB); }
    }
#undef SG_LOAD
#undef SG_MMA
    LAS float* RED = (LAS float*)(c.lds);
    __syncthreads();
#pragma unroll
    for (int rt = 0; rt < 4; ++rt)
#pragma unroll
        for (int r = 0; r < 16; ++r) RED[((w * 4 + rt) * 16 + r) * 64 + lane] = acc[rt][r];
    __syncthreads();
    const int rt = w & 3, rh = w >> 2, col = n0 + r32;
    float v[8];
#pragma unroll
    for (int i = 0; i < 8; ++i) { float s = 0.f;
#pragma unroll
        for (int ww = 0; ww < 8; ++ww) s += RED[((ww * 4 + rt) * 16 + 8 * rh + i) * 64 + lane];
        v[i] = s; }
    if (g.mode == 0) {
#pragma unroll
        for (int i = 0; i < 8; ++i) { const int row = MP + rt * 32 + crow(8 * rh + i, hh); const float rs = rsqrtf(g.ssin[row] * (1.0f / DM) + EPS); g.Z[(size_t)row * g.ldz + col] = (bf16)f2bf(v[i] * rs); }
    } else if (g.mode == 1) {
#pragma unroll
        for (int i = 0; i < 8; ++i) { const int lr = rt * 32 + crow(8 * rh + i, hh), row = MP + lr;
            const float x = v[i] + (g.resid ? g.resid[(size_t)lr * DM + col] : bf2f(g.rb[(size_t)row * DM + col]));
            if (g.y) g.y[(size_t)lr * DM + col] = x; if (g.xb) g.xb[(size_t)row * DM + col] = (bf16)f2bf(x);
            float s = x * x; s += __shfl_xor(s, 1); s += __shfl_xor(s, 2); s += __shfl_xor(s, 4); s += __shfl_xor(s, 8); s += __shfl_xor(s, 16);
            if (g.ssout && r32 == 0) atomicAdd(g.ssout + row, s); }
    } else {
        float gu[8], upv[8];
#pragma unroll
        for (int i = 0; i < 8; ++i) { const int row = MP + rt * 32 + crow(8 * rh + i, hh); gu[i] = v[i] * rsqrtf(g.ssin[row] * (1.0f / DM) + EPS); upv[i] = __shfl_xor(gu[i], 16); }
        if (r32 < 16) { const float w0 = g.cw[f2], w1 = g.cw[DFF + f2], w2 = g.cw[2 * DFF + f2], bb = g.cb[f2];
#pragma unroll
            for (int aa = 0; aa < 2; ++aa) { const int lr0 = rt * 32 + 8 * (2 * rh + aa) + 4 * hh, sb = lr0 >> 2;
                const float s0 = g.cst[(size_t)(sb * 2) * DFF + f2], s1 = g.cst[(size_t)(sb * 2 + 1) * DFF + f2];
                const float u0 = gu[4 * aa], u1 = gu[4 * aa + 1], u2 = gu[4 * aa + 2], u3 = gu[4 * aa + 3];
                const float cv[4] = {bb + w0 * s0 + w1 * s1 + w2 * u0, bb + w0 * s1 + w1 * u0 + w2 * u1, bb + w0 * u0 + w1 * u1 + w2 * u2, bb + w0 * u1 + w1 * u2 + w2 * u3};
#pragma unroll
                for (int t = 0; t < 4; ++t) g.ACT[(size_t)(MP + lr0 + t) * DFF + f2] = (bf16)f2bf(cv[t] * sigmoidf_(cv[t]) * upv[4 * aa + t]);
                g.cvs[(size_t)(sb * 2) * DFF + f2] = u2; g.cvs[(size_t)(sb * 2 + 1) * DFF + f2] = u3; } }
    }
}
__device__ __forceinline__ void sgemm_phase(Ctx& c, const SgArgs& g, int N) {
#pragma unroll 1
    for (int u = c.G - 1 - (int)blockIdx.x; u < N / 32; u += c.G) sgemm_unit(c, g, u * 32);
}


__device__ __forceinline__ float wave_sum_f(float x) {
    x += __builtin_bit_cast(float, __builtin_amdgcn_update_dpp(0, __builtin_bit_cast(int, x), 0xB1, 0xF, 0xF, false));
    x += __builtin_bit_cast(float, __builtin_amdgcn_update_dpp(0, __builtin_bit_cast(int, x), 0x4E, 0xF, 0xF, false));
    x += __builtin_bit_cast(float, __builtin_amdgcn_update_dpp(0, __builtin_bit_cast(int, x), 0x141, 0xF, 0xF, false));
    x += __builtin_bit_cast(float, __builtin_amdgcn_update_dpp(0, __builtin_bit_cast(int, x), 0x140, 0xF, 0xF, false));
    const int xi = __builtin_bit_cast(int, x);
    return (__builtin_bit_cast(float, __builtin_amdgcn_readlane(xi, 0)) + __builtin_bit_cast(float, __builtin_amdgcn_readlane(xi, 16))) +
           (__builtin_bit_cast(float, __builtin_amdgcn_readlane(xi, 32)) + __builtin_bit_cast(float, __builtin_amdgcn_readlane(xi, 48)));
}
__device__ __forceinline__ void dsa_post_row(ARGREF a, int row, int lane_) {
    int lane = lane_; asm volatile("" : "+v"(lane));
    const bf16* z = (const bf16*)(a.ws + WS_Z) + (size_t)row * ZC1;
    const bool smp = row >= MP; const int b = smp ? (row - MP) >> 2 : row >> 12, t = smp ? (row - MP) & 3 : row & 4095;
    const float pos = (float)(smp ? PAST + t : t);
    const int i = lane & 31;
    float x1[8], x2[8], q1[4], q2[4], k1 = 0.f, k2 = 0.f;
#pragma unroll
    for (int hd = 0; hd < 8; ++hd) { x1[hd] = bf2f(z[hd * 128 + lane]); x2[hd] = bf2f(z[hd * 128 + 64 + lane]); }
    const u64 vv = *(const u64*)(z + Z1_V + 4 * lane);
#pragma unroll
    for (int p = 0; p < 4; ++p) { const int hd = 2 * p + (lane >> 5); q1[p] = bf2f(z[Z1_IQ + hd * 64 + i]); q2[p] = bf2f(z[Z1_IQ + hd * 64 + 32 + i]); }
    if (lane < 32) { k1 = bf2f(z[Z1_IK + i]); k2 = bf2f(z[Z1_IK + 32 + i]); }
    const float wraw = bf2f(z[Z1_IW + (lane & 7)]);
    float c128, s128, c64, s64;
    { const float r1 = pos * (exp2f(-(float)lane * (13.287712379549449f / 64.0f)) * 0.15915494309189535f), f1 = r1 - floorf(r1); s128 = __builtin_amdgcn_sinf(f1); c128 = __builtin_amdgcn_cosf(f1);
      const float r2 = pos * (exp2f(-(float)i * (13.287712379549449f / 32.0f)) * 0.15915494309189535f), f2 = r2 - floorf(r2); s64 = __builtin_amdgcn_sinf(f2); c64 = __builtin_amdgcn_cosf(f2); }
#pragma unroll
    for (int hd = 0; hd < 8; ++hd) {
        const float rs = rsqrtf(wave_sum_f(x1[hd] * x1[hd] + x2[hd] * x2[hd]) * (1.0f / 128.0f) + EPS);
        const float* gn = hd < 6 ? a.in[17] : a.in[18];
        const float y1 = x1[hd] * rs * gn[lane], y2 = x2[hd] * rs * gn[64 + lane];
        const float o1 = y1 * c128 - y2 * s128, o2 = y2 * c128 + y1 * s128;
        if (hd < 6) {
            if (smp) { float* q = (float*)(a.ws + WS_SQ) + (size_t)(row - MP) * 768 + hd * 128; q[lane] = o1; q[64 + lane] = o2; }
            else { bf16* q = (bf16*)(a.ws + WS_QB) + ((size_t)(b * 6 + hd) * SEQ + t) * 128; q[lane] = (bf16)f2bf(o1); q[64 + lane] = (bf16)f2bf(o2); }
        } else {
            const int kvh = hd - 6;
            float* ko = smp ? a.out + O_KS + (size_t)(row - MP) * 256 + kvh * 128 : a.out + O_KP + (size_t)row * 256 + kvh * 128;
            ko[lane] = o1; ko[64 + lane] = o2;
            if (!smp) { bf16* kb = (bf16*)(a.ws + WS_KB) + ((size_t)(b * 2 + kvh) * SEQ + t) * 128; kb[lane] = (bf16)f2bf(o1); kb[64 + lane] = (bf16)f2bf(o2); }
        }
    }
    {
        const f32x4 v = {bf2f((unsigned)vv & 0xffffu), bf2f(((unsigned)vv) >> 16), bf2f((unsigned)(vv >> 32) & 0xffffu), bf2f((unsigned)(vv >> 48))};
        float* vo = smp ? a.out + O_VS + (size_t)(row - MP) * 256 : a.out + O_VP + (size_t)row * 256;
        *(f32x4*)(vo + 4 * lane) = v;
        if (!smp) { const int kvh = lane >> 5, d = (lane & 31) * 4; *(u64*)((bf16*)(a.ws + WS_VB) + ((size_t)(b * 2 + kvh) * SEQ + t) * 128 + d) = vv; }
    }
    {
#pragma unroll
        for (int p = 0; p < 4; ++p) { const int hd = 2 * p + (lane >> 5);
            const float o1 = q1[p] * c64 - q2[p] * s64, o2 = q2[p] * c64 + q1[p] * s64;
            if (smp) { float* q = (float*)(a.ws + WS_SIQ) + (size_t)(row - MP) * 512 + hd * 64; q[i] = o1; q[32 + i] = o2; }
            else { bf16* q = (bf16*)(a.ws + WS_IQB) + (size_t)row * 512 + hd * 64; q[i] = (bf16)f2bf(o1); q[32 + i] = (bf16)f2bf(o2); } }
        const float rs = rsqrtf(wave_sum_f(k1 * k1 + k2 * k2) * (1.0f / 64.0f) + EPS);
        const float y1 = k1 * rs * a.in[19][i], y2 = k2 * rs * a.in[19][32 + i];
        const float o1 = y1 * c64 - y2 * s64, o2 = y2 * c64 + y1 * s64;
        if (lane < 32) {
            float* ko = smp ? a.out + O_IKS + (size_t)(row - MP) * 64 : a.out + O_IKP + (size_t)row * 64; ko[i] = o1; ko[32 + i] = o2;
            if (!smp) { bf16* kb = (bf16*)(a.ws + WS_IKB) + (size_t)row * 64; kb[i] = (bf16)f2bf(o1); kb[32 + i] = (bf16)f2bf(o2); } }
        if (lane < 8) { const float wv = wraw * (0.35355339059327373f * 0.125f);
            if (smp) ((float*)(a.ws + WS_SIW))[(row - MP) * 8 + lane] = wv; else ((float*)(a.ws + WS_IW))[(size_t)row * 8 + lane] = wv; }
    }
}
__device__ __forceinline__ void p8_dsa_post(Ctx& c, ARGREF a) {
    for (;;) { const int u = q_next(c, 1); if (u >= 384) break; if (u < 256) memattn_prompt_unit(c, a, 1, u); else memattn_sample_unit(c, a, 1, u - 256); }
    const int gw = c.vcu * NWAVES + c.wave, NGW = c.G * NWAVES;
    for (int row = gw; row < MVALID; row += NGW) dsa_post_row(a, row, c.lane);
}

__device__ __forceinline__ void idx_prompt_unit(Ctx& c, ARGREF a, int b, int qb) {
    int tid = c.tid; asm volatile("" : "+v"(tid));
    const int lane = tid & 63, r32 = lane & 31, hh = lane >> 5, w = c.wave;
    const int q0 = b * SEQ + qb * 32;
    LAS bf16* IQL = (LAS bf16*)(c.lds);
    { const bf16* src = (const bf16*)(a.ws + WS_IQB) + (size_t)q0 * 512;
#pragma unroll
      for (int i = 0; i < 4; ++i) { const int row = tid >> 4, ch = (tid & 15) + 16 * i; *(LAS v4u*)(IQL + row * 520 + ch * 8) = *(const v4u*)(src + (size_t)row * 512 + ch * 8); } }
    __syncthreads();
    const bf16* IK = (const bf16*)(a.ws + WS_IKB) + (size_t)(b * SEQ) * 64 + (size_t)r32 * 64 + 8 * hh;
    float* SC = (float*)(a.ws + WS_SC) + (size_t)(q0 + r32) * SEQ;
    float wv[8];
#pragma unroll
    for (int h = 0; h < 8; ++h) wv[h] = ((const float*)(a.ws + WS_IW))[(size_t)(q0 + r32) * 8 + h];
    bf16x8 ak[4], an[4];
    if (w <= qb) {
#pragma unroll
        for (int ks = 0; ks < 4; ++ks) ak[ks] = *(const bf16x8*)(IK + (size_t)(w * 32) * 64 + ks * 16); }
#pragma unroll 1
    for (int kt = w; kt <= qb; kt += 8) {
        if (kt + 8 <= qb) {
#pragma unroll
            for (int ks = 0; ks < 4; ++ks) an[ks] = *(const bf16x8*)(IK + (size_t)((kt + 8) * 32) * 64 + ks * 16); }
        f32x16 sc = {};
        int qoff = r32 * 520 + 8 * hh; asm volatile("" : "+v"(qoff));
#pragma unroll
        for (int h = 0; h < 8; ++h) { f32x16 d = {};
#pragma unroll
            for (int ks = 0; ks < 4; ++ks) d = __builtin_amdgcn_mfma_f32_32x32x16_bf16(ak[ks], *(const LAS bf16x8*)(IQL + qoff + h * 64 + ks * 16), d, 0, 0, 0);
#pragma unroll
            for (int r = 0; r < 16; ++r) sc[r] = fmaf(wv[h], fmaxf(d[r], 0.f), sc[r]); }
#pragma unroll
        for (int g = 0; g < 4; ++g) *(f32x4*)(SC + kt * 32 + 8 * g + 4 * hh) = (f32x4){sc[4 * g], sc[4 * g + 1], sc[4 * g + 2], sc[4 * g + 3]};
#pragma unroll
        for (int ks = 0; ks < 4; ++ks) ak[ks] = an[ks];
    }
}
__device__ __forceinline__ v4u pack8f(const float* p) { const f32x4 x = *(const f32x4*)p, y = *(const f32x4*)(p + 4); v4u o; o.x = pk2(x.x, x.y); o.y = pk2(x.z, x.w); o.z = pk2(y.x, y.y); o.w = pk2(y.z, y.w); return o; }
__device__ __forceinline__ void idx_sample_tile(ARGREF a, int sb, int tl, int lane_) {
    int lane = lane_; asm volatile("" : "+v"(lane));
    const int r32 = lane & 31, hh = lane >> 5, tk = r32 >> 3, hd = r32 & 7;
    const float* iq = (const float*)(a.ws + WS_SIQ) + (size_t)(sb * 4 + tk) * 512 + hd * 64 + 8 * hh;
    const float wv = ((const float*)(a.ws + WS_SIW))[(sb * 4 + tk) * 8 + hd];
    const float* src;
    if (tl < 256) src = a.in[4] + ((size_t)a.page_table[sb * 64 + (tl >> 2)] * 128 + (tl & 3) * 32 + r32) * 64 + 8 * hh;
    else src = a.out + O_IKS + (size_t)(sb * 4 + (r32 & 3)) * 64 + 8 * hh;
    v4u af[4], bf_[4];
#pragma unroll
    for (int ks = 0; ks < 4; ++ks) { af[ks] = pack8f(src + 16 * ks); bf_[ks] = pack8f(iq + 16 * ks); }
    if (tl == 256 && r32 >= 4) {
#pragma unroll
        for (int ks = 0; ks < 4; ++ks) af[ks] = (v4u){0u, 0u, 0u, 0u}; }
    f32x16 d = {};
#pragma unroll
    for (int ks = 0; ks < 4; ++ks) d = __builtin_amdgcn_mfma_f32_32x32x16_bf16(__builtin_bit_cast(bf16x8, af[ks]), __builtin_bit_cast(bf16x8, bf_[ks]), d, 0, 0, 0);
    float* dst = (float*)(a.ws + WS_SSC) + (size_t)(sb * 4 + tk) * SSC_LD + tl * 32;
#pragma unroll
    for (int r = 0; r < 16; ++r) { float v = wv * fmaxf(d[r], 0.f);
        v += __builtin_bit_cast(float, __builtin_amdgcn_update_dpp(0, __builtin_bit_cast(int, v), 0xB1, 0xF, 0xF, false));
        v += __builtin_bit_cast(float, __builtin_amdgcn_update_dpp(0, __builtin_bit_cast(int, v), 0x4E, 0xF, 0xF, false));
        v += __builtin_bit_cast(float, __builtin_amdgcn_update_dpp(0, __builtin_bit_cast(int, v), 0x141, 0xF, 0xF, false));
        if (hd == 0) dst[crow(r, hh)] = v; }
}
__device__ __forceinline__ void p9_indexer(Ctx& c, ARGREF a) {
    const int gw = c.vcu * NWAVES + c.wave, NGW = c.G * NWAVES;
#pragma unroll 1
    for (int wt = gw; wt < 32 * 257; wt += NGW) idx_sample_tile(a, wt / 257, wt % 257, c.lane);
    for (;;) { const int u = q_next(c, 2); if (u >= 512) break; idx_prompt_unit(c, a, u & 3, 127 - (u >> 2)); }
}


__device__ __forceinline__ unsigned fkey(float f) { const unsigned u = __builtin_bit_cast(unsigned, f + 0.0f); return (u & 0x80000000u) ? ~u : (u | 0x80000000u); }
__device__ __forceinline__ void acc_ge(int& cnt, unsigned key, unsigned cand) { asm volatile("v_cmp_le_u32_e32 vcc, %1, %2\n\tv_addc_co_u32_e32 %0, vcc, 0, %0, vcc" : "+v"(cnt) : "s"(cand), "v"(key) : "vcc"); }
__device__ __forceinline__ void acc_ge4(int& c0, int& c1, int& c2, int& c3, unsigned k0, unsigned k1, unsigned k2, unsigned k3, unsigned cand) {
    u64 m0, m1, m2, m3;
    asm volatile("v_cmp_le_u32_e64 %4, %8, %9\n\tv_cmp_le_u32_e64 %5, %8, %10\n\tv_cmp_le_u32_e64 %6, %8, %11\n\tv_cmp_le_u32_e64 %7, %8, %12\n\t"
                 "v_addc_co_u32_e64 %0, %4, 0, %0, %4\n\tv_addc_co_u32_e64 %1, %5, 0, %1, %5\n\tv_addc_co_u32_e64 %2, %6, 0, %2, %6\n\tv_addc_co_u32_e64 %3, %7, 0, %3, %7"
                 : "+v"(c0), "+v"(c1), "+v"(c2), "+v"(c3), "=&s"(m0), "=&s"(m1), "=&s"(m2), "=&s"(m3) : "s"(cand), "v"(k0), "v"(k1), "v"(k2), "v"(k3));
}
__device__ __forceinline__ u64 ballot_nz(unsigned v) { u64 m; asm volatile("v_cmp_ne_u32_e64 %0, 0, %1" : "=s"(m) : "v"(v)); return m; }
__device__ __forceinline__ int wave_sum_dpp(int x) {
    x += __builtin_amdgcn_update_dpp(0, x, 0xB1, 0xF, 0xF, false);
    x += __builtin_amdgcn_update_dpp(0, x, 0x4E, 0xF, 0xF, false);
    x += __builtin_amdgcn_update_dpp(0, x, 0x141, 0xF, 0xF, false);
    x += __builtin_amdgcn_update_dpp(0, x, 0x140, 0xF, 0xF, false);
    return (__builtin_amdgcn_readlane(x, 0) + __builtin_amdgcn_readlane(x, 16)) + (__builtin_amdgcn_readlane(x, 32) + __builtin_amdgcn_readlane(x, 48));
}
__device__ __forceinline__ int mbcnt64(u64 m) { return (int)__builtin_amdgcn_mbcnt_hi((unsigned)(m >> 32), __builtin_amdgcn_mbcnt_lo((unsigned)m, 0u)); }
constexpr int TK_LOWBITS = 18;
__device__ __forceinline__ void topk_finish(unsigned ck, int cp, int A, int posmax, unsigned& T, int& P) {
#pragma unroll 1
    for (int bit = TK_LOWBITS - 1; bit >= 0; --bit) { const unsigned cand = T | (1u << bit); if (A + __builtin_popcountll(__ballot(ck >= cand)) >= 256) T = cand; }
    const int need = 256 - (A + __builtin_popcountll(__ballot(ck > T))), ceq = __builtin_popcountll(__ballot(ck == T));
    P = posmax;
    if (ceq != need) { P = 0;
#pragma unroll 1
        for (int bit = 13; bit >= 0; --bit) { const int cand = P | (1 << bit); if (__builtin_popcountll(__ballot(ck == T && cp < cand)) < need) P = cand; } }
}
__device__ __forceinline__ void topk_prompt_rows(ARGREF a, int row0, int stride, int lane_, LAS unsigned* cl  ) {
    int lane = lane_; asm volatile("" : "+v"(lane));
    const float* SCb = (const float*)(a.ws + WS_SC);
#define TK_NEEDS(r) ((r) < MP && ((r) & 4095) >= 256)
#define TK_PREFETCH(r) do { const float* sc_ = SCb + (size_t)(r) * SEQ + lane; const int tj_ = ((r) & 4095) >> 6; _Pragma("unroll") for (int j = 0; j < 64; ++j) nx[j] = sc_[64 * (j < tj_ ? j : tj_)]; } while (0)
#pragma unroll 1
    for (int row = row0; row < MP; row += stride) {
        const int t = row & 4095;
        u64* mk = (u64*)(a.ws + WS_MASK) + (size_t)row * 64;
        u64 myword = 0ull;
        if (t < 256) {
#pragma unroll 1
            for (int j = 0; j < 64; ++j) { const u64 m = __ballot(64 * j + lane <= t); if (lane == j) myword = m; }
            mk[lane] = myword;
            continue; }
        unsigned key[64];
        { const float* sc_ = SCb + (size_t)row * SEQ + lane; const int tj_ = t >> 6;
          float v[64];
#pragma unroll
          for (int j = 0; j < 64; ++j) v[j] = sc_[64 * (j < tj_ ? j : tj_)];
          int pj = lane;
#pragma unroll
          for (int j = 0; j < 64; ++j) { key[j] = (pj <= t) ? fkey(v[j]) : 0u; pj += 64; asm volatile("" : "+v"(pj)); } }
#define TK_FULLCOUNT(CAND, OUT) do { const unsigned cs_ = __builtin_amdgcn_readfirstlane(CAND); int c0_ = 0, c1_ = 0, c2_ = 0, c3_ = 0; \
        _Pragma("unroll") for (int j = 0; j < 64; j += 4) acc_ge4(c0_, c1_, c2_, c3_, key[j], key[j + 1], key[j + 2], key[j + 3], cs_); OUT = wave_sum_dpp((c0_ + c1_) + (c2_ + c3_)); } while (0)
        unsigned T = 0u;
#pragma unroll 1
        for (int bit = 31; bit >= TK_LOWBITS; --bit) { const unsigned cand = T | (1u << bit); int tot; TK_FULLCOUNT(cand, tot); if (tot >= 256) T = cand; }
        const unsigned hib = T + (1u << TK_LOWBITS);
        int A = 0, cT; if (hib != 0u) TK_FULLCOUNT(hib, A); TK_FULLCOUNT(T, cT);
        int P;
        if (cT - A <= 64) {
            int base = 0;
            int pj = lane;
#pragma unroll
            for (int j = 0; j < 64; ++j) { const unsigned und = (key[j] - T) < (1u << TK_LOWBITS) ? 1u : 0u; const u64 m = ballot_nz(und); const int pos = base + mbcnt64(m);
                if (und) { cl[pos] = key[j]; cl[64 + pos] = (unsigned)pj; }
                base += __builtin_popcountll(m); pj += 64; asm volatile("" : "+s"(base), "+v"(pj)); }
            const unsigned ck = lane < base ? cl[lane] : 0u; const int cp = (int)cl[64 + lane];
            topk_finish(ck, cp, A, 4095, T, P);
        } else {
#pragma unroll 1
            for (int bit = TK_LOWBITS - 1; bit >= 0; --bit) { const unsigned cand = T | (1u << bit); int tot; TK_FULLCOUNT(cand, tot); if (tot >= 256) T = cand; }
            int cge, cgt; TK_FULLCOUNT(T, cge); cgt = 0; if (T != 0xffffffffu) TK_FULLCOUNT(T + 1u, cgt);
            const int need = 256 - cgt, ceq = cge - cgt; P = 4095;
            if (ceq != need) { P = 0;
#pragma unroll 1
                for (int bit = 11; bit >= 0; --bit) { const int cand = P | (1 << bit); int cnt = 0; int pj = lane;
#pragma unroll
                    for (int j = 0; j < 64; ++j) { cnt += (key[j] == T && pj < cand) ? 1 : 0; pj += 64; asm volatile("" : "+v"(pj)); }
                    if (wave_sum_dpp(cnt) < need) P = cand; } }
        }
#undef TK_FULLCOUNT
        int pq = lane;
#pragma unroll
        for (int j = 0; j < 64; ++j) { const unsigned selv = (key[j] > T || (key[j] == T && pq <= P)) ? 1u : 0u; const u64 m = ballot_nz(selv); if (lane == j) myword = m; pq += 64; asm volatile("" : "+v"(myword), "+v"(pq)); }
        mk[lane] = myword;
    }
#undef TK_NEEDS
#undef TK_PREFETCH
}
__device__ __forceinline__ void topk_sample_row(ARGREF a, int q, int lane_, LAS unsigned* K, LAS unsigned* cl) {
    int lane = lane_; asm volatile("" : "+v"(lane));
    const int t = q & 3, n = PAST + t + 1; const float* sc = (const float*)(a.ws + WS_SSC) + (size_t)q * SSC_LD;
    int* out = (int*)(a.ws + WS_SIDX) + q * 256;
    unsigned key[129];
#pragma unroll
    for (int j = 0; j < 129; ++j) { const float v = sc[64 * j + lane]; key[j] = (j < 128 || lane < n - 8192) ? fkey(v) : 0u; }
#pragma unroll
    for (int j = 0; j < 129; ++j) K[64 * j + lane] = key[j];
#define TK_FULLCOUNT(CAND, OUT) do { const unsigned cs_ = __builtin_amdgcn_readfirstlane(CAND); int c0_ = 0, c1_ = 0, c2_ = 0, c3_ = 0; \
        _Pragma("unroll") for (int j = 0; j < 128; j += 4) acc_ge4(c0_, c1_, c2_, c3_, key[j], key[j + 1], key[j + 2], key[j + 3], cs_); acc_ge(c0_, key[128], cs_); OUT = wave_sum_dpp((c0_ + c1_) + (c2_ + c3_)); } while (0)
    unsigned T = 0u;
#pragma unroll 1
    for (int bit = 31; bit >= TK_LOWBITS; --bit) { const unsigned cand = T | (1u << bit); int tot; TK_FULLCOUNT(cand, tot); if (tot >= 256) T = cand; }
    const unsigned hib = T + (1u << TK_LOWBITS);
    int A = 0, cT; if (hib != 0u) TK_FULLCOUNT(hib, A); TK_FULLCOUNT(T, cT);
    int P;
    if (cT - A <= 64) {
        int base = 0;
#pragma unroll 1
        for (int j0 = 0; j0 < 128; j0 += 8) { unsigned kk[8];
#pragma unroll
            for (int i = 0; i < 8; ++i) kk[i] = K[64 * (j0 + i) + lane];
#pragma unroll
            for (int i = 0; i < 8; ++i) { const unsigned und = (kk[i] - T) < (1u << TK_LOWBITS) ? 1u : 0u; const u64 m = ballot_nz(und); const int pos = base + mbcnt64(m);
                if (und) { cl[pos] = kk[i]; cl[64 + pos] = (unsigned)(64 * (j0 + i) + lane); }
                base += __builtin_popcountll(m); } }
        { const unsigned kj = K[64 * 128 + lane]; const unsigned und = (kj - T) < (1u << TK_LOWBITS) ? 1u : 0u; const u64 m = ballot_nz(und); const int pos = base + mbcnt64(m);
          if (und) { cl[pos] = kj; cl[64 + pos] = (unsigned)(64 * 128 + lane); } base += __builtin_popcountll(m); }
        const unsigned ck = lane < base ? cl[lane] : 0u; const int cp = (int)cl[64 + lane];
        topk_finish(ck, cp, A, 16383, T, P);
    } else {
#pragma unroll 1
        for (int bit = TK_LOWBITS - 1; bit >= 0; --bit) { const unsigned cand = T | (1u << bit); int tot; TK_FULLCOUNT(cand, tot); if (tot >= 256) T = cand; }
        int cge, cgt; TK_FULLCOUNT(T, cge); cgt = 0; if (T != 0xffffffffu) TK_FULLCOUNT(T + 1u, cgt);
        const int need = 256 - cgt, ceq = cge - cgt; P = 16383;
        if (ceq != need) { P = 0;
#pragma unroll 1
            for (int bit = 13; bit >= 0; --bit) { const int cand = P | (1 << bit); int cnt = 0;
#pragma unroll 4
                for (int j = 0; j < 129; ++j) cnt += (K[64 * j + lane] == T && 64 * j + lane < cand) ? 1 : 0;
                if (wave_sum_dpp(cnt) < need) P = cand; } }
    }
#undef TK_FULLCOUNT
    int base = 0;
#pragma unroll 1
    for (int j0 = 0; j0 < 136; j0 += 8) { unsigned kk[8];
#pragma unroll
        for (int i = 0; i < 8; ++i) kk[i] = (j0 + i < 129) ? K[64 * (j0 + i) + lane] : 0u;
#pragma unroll
        for (int i = 0; i < 8; ++i) { const int ps = 64 * (j0 + i) + lane; const unsigned selv = (kk[i] > T || (kk[i] == T && ps <= P)) ? 1u : 0u; const u64 m = ballot_nz(selv);
            const int pos = base + mbcnt64(m);
            if (selv && pos < 256) out[pos] = ps;
            base += __builtin_popcountll(m); } }
}
__device__ __forceinline__ void p10_topk(Ctx& c, ARGREF a) {
    const int gw = c.vcu * NWAVES + c.wave, NGW = c.G * NWAVES;
    LAS unsigned* cl = (LAS unsigned*)(c.lds) + c.wave * 128;
    if (c.wave == 0 && c.vcu < MS) topk_sample_row(a, c.vcu, c.lane, (LAS unsigned*)(c.lds + 4096), cl);
    topk_prompt_rows(a, gw, NGW, c.lane, cl);
}


__device__ __forceinline__ void attn_sample_unit(Ctx& c, ARGREF a, int sb, int t) {
    LAS bf16* KV = (LAS bf16*)(c.lds);
    LAS float* QL = (LAS float*)(c.lds + 69632);
    LAS float* SL = (LAS float*)(c.lds + 69632 + 3072);
    LAS float* OL = (LAS float*)(c.lds + 69632 + 6144);
    LAS int* IL = (LAS int*)(c.lds + 69632 + 12288);
    int tid = c.tid; asm volatile("" : "+v"(tid));
    const int lane = tid & 63, w = c.wave, q = sb * 4 + t;
    __syncthreads();
    if (tid < 256) IL[tid] = ((const int*)(a.ws + WS_SIDX))[q * 256 + tid];
    for (int i = tid; i < 768; i += 512) QL[i] = ((const float*)(a.ws + WS_SQ))[(size_t)q * 768 + i];
    __syncthreads();
    bf16* MIX = (bf16*)(a.ws + WS_MIX) + (size_t)(MP + q) * DM;
#pragma unroll 1
    for (int kvh = 0; kvh < 2; ++kvh) {
#pragma unroll 1
        for (int pass = 0; pass < 2; ++pass) {
            const float* pool = pass ? a.in[3] : a.in[2]; const float* nw = a.out + (pass ? O_VS : O_KS);
            for (int i = tid >> 5; i < 256; i += 16) { const int idx = IL[i]; const float* src;
                if (idx < PAST) src = pool + (((size_t)a.page_table[sb * 64 + (idx >> 7)] * 128 + (idx & 127)) * 2 + kvh) * 128;
                else src = nw + (size_t)(sb * 4 + (idx - PAST)) * 256 + kvh * 128;
                const f32x4 v = *(const f32x4*)(src + (tid & 31) * 4);
                *(LAS u64*)(KV + i * 136 + (tid & 31) * 4) = (u64)pk2(v.x, v.y) | ((u64)pk2(v.z, v.w) << 32); }
            __syncthreads();
            if (pass == 0) {
                const int i = tid >> 1, dh = (tid & 1) * 64; float s0 = 0.f, s1 = 0.f, s2 = 0.f;
#pragma unroll 8
                for (int d = 0; d < 64; ++d) { const float kx = bf2f(KV[i * 136 + dh + d]);
                    s0 = fmaf(QL[(3 * kvh + 0) * 128 + dh + d], kx, s0); s1 = fmaf(QL[(3 * kvh + 1) * 128 + dh + d], kx, s1); s2 = fmaf(QL[(3 * kvh + 2) * 128 + dh + d], kx, s2); }
                s0 += __shfl_xor(s0, 1); s1 += __shfl_xor(s1, 1); s2 += __shfl_xor(s2, 1);
                if ((tid & 1) == 0) { SL[i] = s0 * 0.08838834764831845f; SL[256 + i] = s1 * 0.08838834764831845f; SL[512 + i] = s2 * 0.08838834764831845f; }
                __syncthreads();
                if (w < 3) { float v[4], mx = -1e30f;
#pragma unroll
                    for (int j = 0; j < 4; ++j) { v[j] = SL[w * 256 + 64 * j + lane]; mx = fmaxf(mx, v[j]); }
#pragma unroll
                    for (int o = 1; o < 64; o <<= 1) mx = fmaxf(mx, __shfl_xor(mx, o));
                    float l = 0.f;
#pragma unroll
                    for (int j = 0; j < 4; ++j) { v[j] = __expf(v[j] - mx); l += v[j]; }
                    l = wave_sum(l); const float il = 1.0f / l;
#pragma unroll
                    for (int j = 0; j < 4; ++j) SL[w * 256 + 64 * j + lane] = v[j] * il; }
                __syncthreads();
            } else {
                const int d = tid & 127, part = tid >> 7; float o0 = 0.f, o1 = 0.f, o2 = 0.f;
#pragma unroll 8
                for (int i = part * 64; i < part * 64 + 64; ++i) { const float vx = bf2f(KV[i * 136 + d]); o0 = fmaf(SL[i], vx, o0); o1 = fmaf(SL[256 + i], vx, o1); o2 = fmaf(SL[512 + i], vx, o2); }
                OL[(part * 3 + 0) * 128 + d] = o0; OL[(part * 3 + 1) * 128 + d] = o1; OL[(part * 3 + 2) * 128 + d] = o2;
                __syncthreads();
                if (tid < 384) { const int hq = tid >> 7, dd = tid & 127; const float o = (OL[hq * 128 + dd] + OL[(3 + hq) * 128 + dd]) + (OL[(6 + hq) * 128 + dd] + OL[(9 + hq) * 128 + dd]);
                    MIX[(3 * kvh + hq) * 128 + dd] = (bf16)f2bf(o); }
                __syncthreads();
            }
        }
    }
}


namespace attn {
using bf16 = unsigned short;
typedef short bf16x8 __attribute__((ext_vector_type(8)));
typedef short s16x4 __attribute__((ext_vector_type(4)));
typedef float f32x16 __attribute__((ext_vector_type(16)));
typedef float f32x4 __attribute__((ext_vector_type(4)));
typedef unsigned u32x4 __attribute__((ext_vector_type(4)));
typedef unsigned u32x2 __attribute__((ext_vector_type(2)));
constexpr int D = 128, OS = 1024;
constexpr float THR = 8.f;
constexpr float SCALE = 0.08838834764831845f;
constexpr int NW = 8, QBLK = 32, KVBLK = 64, QB = NW * QBLK;
constexpr int SHM_V = KVBLK * D * 2, SHM_K = KVBLK * D * 2;
constexpr int LDS_BYTES = 2 * SHM_V + 2 * SHM_K + NW * 64 * 4;

#define KSWZ(row, colB) ((row) * 256 + ((colB) ^ (((row) & 7) << 4)))
#define SBAR() __builtin_amdgcn_sched_barrier(0)
__device__ __forceinline__ int v_st(int k, int c) { const int kk = (k & ~0xC) | ((k & 4) << 1) | ((k & 8) >> 1); return ((kk >> 3) * 4 + (c >> 5)) * 512 + ((kk & 7) * 32 + (c & 31)) * 2; }
__device__ __forceinline__ int v_rd_base(int lane) { return ((lane & 3) << 3) | (((lane >> 2) & 3) << 6) | (((lane >> 4) & 1) << 5) | (((lane >> 5) & 1) << 8); }
constexpr int v_rd_off(int d0, int ks, int half) { return d0 * 512 + ks * 4096 + half * 2048; }
__device__ __forceinline__ int crow(int r, int hi) { return (r & 3) + 8 * (r >> 2) + 4 * hi; }
__device__ __forceinline__ unsigned cvtpk(float lo, float hi) {
    unsigned r; asm volatile("v_cvt_pk_bf16_f32 %0, %1, %2" : "=v"(r) : "v"(lo), "v"(hi)); return r;
}
__device__ __forceinline__ bf16x8 pack8(f32x4 a, f32x4 b) {
    u32x4 w = {cvtpk(a[0], a[1]), cvtpk(a[2], a[3]), cvtpk(b[0], b[1]), cvtpk(b[2], b[3])};
    return *reinterpret_cast<bf16x8*>(&w);
}

__device__ __forceinline__ void partialSM(f32x16& p0, f32x16& p1, float& m_reg, float& mn, float& alpha) {
    float pmax = p0[0]; for (int r = 1; r < 16; ++r) pmax = fmaxf(pmax, p0[r]); for (int r = 0; r < 16; ++r) pmax = fmaxf(pmax, p1[r]);
    { auto rr = __builtin_amdgcn_permlane32_swap(__float_as_uint(pmax), __float_as_uint(pmax), false, false);
      pmax = fmaxf(__uint_as_float(rr[0]), __uint_as_float(rr[1])); }
    constexpr float C2 = 1.4426950408889634f * SCALE;
    if (__builtin_expect(__all((pmax - m_reg) * SCALE <= THR), 1)) { mn = m_reg; alpha = 1.f; }
    else { mn = fmaxf(m_reg, pmax); alpha = __builtin_amdgcn_exp2f((m_reg - mn) * C2); m_reg = mn; }
    const float mnL = -mn * C2;
    for (int r = 0; r < 16; ++r) p0[r] = fmaf(p0[r], C2, mnL); for (int r = 0; r < 16; ++r) p1[r] = fmaf(p1[r], C2, mnL);
    for (int r = 0; r < 16; ++r) p0[r] = __builtin_amdgcn_exp2f(p0[r]);
}
__device__ __forceinline__ void finishSM(f32x16& p0, f32x16& p1, float alpha, float& l_reg, bf16x8& pa0, bf16x8& pa1, bf16x8& pa2, bf16x8& pa3) {
    for (int r = 0; r < 16; ++r) p1[r] = __builtin_amdgcn_exp2f(p1[r]);
    float ps = 0; for (int r = 0; r < 16; ++r) ps += p0[r]; for (int r = 0; r < 16; ++r) ps += p1[r];
    { auto rr = __builtin_amdgcn_permlane32_swap(__float_as_uint(ps), __float_as_uint(ps), false, false);
      ps = __uint_as_float(rr[0]) + __uint_as_float(rr[1]); }
    l_reg = l_reg * alpha + ps;
#define PK4(P, B_, OUT) do { unsigned a0 = cvtpk(P[B_+0], P[B_+1]), a1 = cvtpk(P[B_+2], P[B_+3]);                          \
        unsigned b0 = cvtpk(P[B_+4], P[B_+5]), b1 = cvtpk(P[B_+6], P[B_+7]);                                             \
        auto r0 = __builtin_amdgcn_permlane32_swap(a0, b0, false, false); auto r1 = __builtin_amdgcn_permlane32_swap(a1, b1, false, false); \
        u32x4 w = {r0[0], r1[0], r0[1], r1[1]}; OUT = *reinterpret_cast<bf16x8*>(&w); } while (0)
    PK4(p0, 0, pa0); PK4(p0, 8, pa1); PK4(p1, 0, pa2); PK4(p1, 8, pa3);
#undef PK4
}
template <int KB, bool SK>
__device__ __forceinline__ void qkt(f32x16& p0, f32x16& p1, const char* K_lds, int r32, int hi, const bf16x8* qr, bool act) {
    if (SK && !act) { const float NEG = -__builtin_inff();
#pragma unroll
        for (int r = 0; r < 16; ++r) { p0[r] = NEG; p1[r] = NEG; } return; }
    p0 = f32x16{}; p1 = f32x16{};
    const char* kb[4];
#pragma unroll
    for (int dd = 0; dd < 4; ++dd) kb[dd] = K_lds + KB * SHM_K + KSWZ(r32, (dd * 16 + hi * 8) * 2);
#pragma unroll
    for (int d0 = 0; d0 < 8; ++d0) { const char* a = kb[d0 & 3] + (d0 >> 2) * 128;
        bf16x8 b0 = *reinterpret_cast<const bf16x8*>(a);
        bf16x8 b1 = *reinterpret_cast<const bf16x8*>(a + 32 * 256);
        p0 = __builtin_amdgcn_mfma_f32_32x32x16_bf16(b0, qr[d0], p0, 0, 0, 0);
        p1 = __builtin_amdgcn_mfma_f32_32x32x16_bf16(b1, qr[d0], p1, 0, 0, 0); }
}
template <int VB, bool SK>
__device__ __forceinline__ void pv_tile(f32x16* o, int vb0, bf16x8 pa0, bf16x8 pa1, bf16x8 pa2, bf16x8 pa3, bool act) {
    if (SK && !act) return;
#define TRRD(dst, off) asm volatile("ds_read_b64_tr_b16 %0, %1 offset:%2" : "=&v"(dst) : "v"(vb0), "i"(off) : "memory")
#define PV_D0(d0) do { s16x4 l0, l1, l2, l3, h0, h1, h2, h3; constexpr int b_ = VB * SHM_V + v_rd_off(d0, 0, 0);     \
        TRRD(l0, b_); TRRD(h0, b_ + 2048); TRRD(l1, b_ + 4096); TRRD(h1, b_ + 6144); TRRD(l2, b_ + 8192); TRRD(h2, b_ + 10240); TRRD(l3, b_ + 12288); TRRD(h3, b_ + 14336); \
        asm volatile("s_waitcnt lgkmcnt(0)" ::: "memory"); SBAR();                 \
        o[d0] = __builtin_amdgcn_mfma_f32_32x32x16_bf16(pa0, (bf16x8){l0[0], l0[1], l0[2], l0[3], h0[0], h0[1], h0[2], h0[3]}, o[d0], 0, 0, 0);   \
        o[d0] = __builtin_amdgcn_mfma_f32_32x32x16_bf16(pa1, (bf16x8){l1[0], l1[1], l1[2], l1[3], h1[0], h1[1], h1[2], h1[3]}, o[d0], 0, 0, 0);   \
        o[d0] = __builtin_amdgcn_mfma_f32_32x32x16_bf16(pa2, (bf16x8){l2[0], l2[1], l2[2], l2[3], h2[0], h2[1], h2[2], h2[3]}, o[d0], 0, 0, 0);   \
        o[d0] = __builtin_amdgcn_mfma_f32_32x32x16_bf16(pa3, (bf16x8){l3[0], l3[1], l3[2], l3[3], h3[0], h3[1], h3[2], h3[3]}, o[d0], 0, 0, 0); } while (0)
    PV_D0(0); PV_D0(1); PV_D0(2); PV_D0(3);
#undef PV_D0
#undef TRRD
}

__device__ __forceinline__ bf16x8 load8(const bf16* p) { return *reinterpret_cast<const bf16x8*>(p); }
__device__ __forceinline__ void mask_bits(f32x16& p0, f32x16& p1, u32x2 w, int hi) {
    const float NEG = -__builtin_inff();
    asm volatile("" : "+v"(w.x), "+v"(w.y));
    const unsigned lo = w.x >> (4 * hi), up = w.y >> (4 * hi);
#pragma unroll
    for (int r = 0; r < 16; ++r) { const int c = (r & 3) + 8 * (r >> 2);
        if (!((lo >> c) & 1u)) p0[r] = NEG;
        if (!((up >> c) & 1u)) p1[r] = NEG; }
}
struct BlockRef { const bf16* Q; const bf16* K; const bf16* V; bf16* O; const u32x2* M; int P0; };
struct Seam { bf16x8 qr[8]; bf16x8 st_v0, st_v1, st_k0, st_k1; };
#define ROW(p, k0, rr) ((p) + (size_t)((k0) + (rr)) * D + sc)
#define VMW() asm volatile("s_waitcnt vmcnt(0)" ::: "memory")
#define VMWN(n) asm volatile("s_waitcnt vmcnt(%0)" :: "i"(n) : "memory")
#define SLOAD_H(Kp, Vp, k0) do { S.st_v0 = load8(ROW(Vp, k0, sr)); S.st_v1 = load8(ROW(Vp, k0, 32 + sr));              \
                         S.st_k0 = load8(ROW(Kp, k0, sr)); S.st_k1 = load8(ROW(Kp, k0, 32 + sr)); } while (0)
#define SWRITE_HK(bf) do { *(bf16x8*)(K_lds + (bf) * SHM_K + kws) = S.st_k0; *(bf16x8*)(K_lds + (bf) * SHM_K + kws + 32 * 256) = S.st_k1; } while (0)
#define SWRITE_HV(bf) do { *(bf16x8*)(V_lds + (bf) * SHM_V + vst0) = S.st_v0; *(bf16x8*)(V_lds + (bf) * SHM_V + vst1) = S.st_v1; } while (0)
#define SWRITE_H(bf) do { SWRITE_HV(bf); SWRITE_HK(bf); } while (0)
__device__ __forceinline__ void sel_prime(const BlockRef& cur, char* lds, Seam& S) {
    int tid_ = threadIdx.x; asm volatile("" : "+v"(tid_));
    const int tid = tid_, wid = __builtin_amdgcn_readfirstlane(tid >> 6), lane = tid & 63, r32 = lane & 31, hi = lane >> 5;
    const int sr = tid >> 4, sc = (tid & 15) * 8, kws = KSWZ(sr, sc * 2); char* K_lds = lds + 2 * SHM_V;
    for (int d0 = 0; d0 < 8; ++d0) S.qr[d0] = load8(cur.Q + (size_t)(wid * QBLK + r32) * D + d0 * 16 + hi * 8);
    SLOAD_H(cur.K, cur.V, 0); VMW(); SWRITE_HK(0);
    __syncthreads();
}
__device__ __forceinline__ void sel_block(const BlockRef& cur, const BlockRef& nxt, char* lds, Seam& S) {
    int tid_ = threadIdx.x; asm volatile("" : "+v"(tid_));
    const int tid = tid_, wid = __builtin_amdgcn_readfirstlane(tid >> 6), lane = tid & 63, r32 = lane & 31, hi = lane >> 5;
    const int NT = (cur.P0 + QB) / KVBLK;
    char* V_lds = lds; char* K_lds = lds + 2 * SHM_V;
    float* ws = (float*)(lds + 2 * SHM_V + 2 * SHM_K) + wid * 64; float* li_l = ws, * al_l = ws + 32;
    float m_reg = -1e30f, l_reg = 0; f32x16 o[4] = {};
    const int sr = tid >> 4, sc = (tid & 15) * 8, vst0 = v_st(sr, sc), vst1 = v_st(32 + sr, sc), kws = KSWZ(sr, sc * 2);
    const int vb0 = (int)(uintptr_t)V_lds + v_rd_base(lane);
    const bf16* Kh = cur.K; const bf16* Vh = cur.V;
    const u32x2* Mrow = cur.M + (size_t)(wid * QBLK + r32) * 64;
#define RESC(a) do { if (__any((a) < 1.f)) { if (hi == 0) al_l[r32] = (a); asm volatile("s_waitcnt lgkmcnt(0)" ::: "memory");              \
                     for (int d_ = 0; d_ < 4; ++d_) for (int r = 0; r < 16; ++r) o[d_][r] *= al_l[crow(r, hi)]; } } while (0)
#define KBASE(t) ((t) * KVBLK)
    f32x16 pA0, pA1, pB0, pB1; float mnA, mnB, alA, alB; bf16x8 pa0, pa1, pa2, pa3; u32x2 mw;
    SWRITE_HV(0); SBAR();
    if (NT > 1) SLOAD_H(Kh, Vh, KBASE(1));
    mw = Mrow[0];
    SBAR(); qkt<0, false>(pA0, pA1, K_lds, r32, hi, S.qr, true);
    mask_bits(pA0, pA1, mw, hi); partialSM(pA0, pA1, m_reg, mnA, alA);
    if (NT > 1) { VMW(); SWRITE_H(1); }
    __syncthreads();
#define HALF_STEP(PX0, PX1, mnX, alX, PY0, PY1, alY, t, KB, VB, SB) do {                                                      \
        SBAR(); mw = Mrow[(t)]; qkt<KB, false>(PX0, PX1, K_lds, r32, hi, S.qr, true);                                          \
        finishSM(PY0, PY1, alY, l_reg, pa0, pa1, pa2, pa3); SBAR();                                                           \
        if ((t) + 1 < NT) { SLOAD_H(Kh, Vh, KBASE((t) + 1)); SBAR(); }                                                        \
        pv_tile<VB, false>(o, vb0, pa0, pa1, pa2, pa3, true); mask_bits(PX0, PX1, mw, hi); partialSM(PX0, PX1, m_reg, mnX, alX); \
        __syncthreads();                                                                                                      \
        if ((t) + 1 < NT) { VMW(); SWRITE_H(SB); }                                                                            \
        RESC(alX); __syncthreads(); } while (0)
    for (int t = 1; t + 1 < NT; t += 2) {
        HALF_STEP(pB0, pB1, mnB, alB, pA0, pA1, alA, t, 1, 0, 0);
        HALF_STEP(pA0, pA1, mnA, alA, pB0, pB1, alB, t + 1, 0, 1, 1);
    }
    const bool even = (NT & 1) == 0;
    if (even) { SBAR(); mw = Mrow[NT - 1]; qkt<1, false>(pB0, pB1, K_lds, r32, hi, S.qr, true); SBAR(); }
    SLOAD_H(nxt.K, nxt.V, 0); SBAR();
#pragma unroll
    for (int d0 = 0; d0 < 8; ++d0) S.qr[d0] = load8(nxt.Q + (size_t)(wid * QBLK + r32) * D + d0 * 16 + hi * 8);
    SBAR();
    finishSM(pA0, pA1, alA, l_reg, pa0, pa1, pa2, pa3); SBAR();
    pv_tile<0, false>(o, vb0, pa0, pa1, pa2, pa3, true);
    if (even) { mask_bits(pB0, pB1, mw, hi); partialSM(pB0, pB1, m_reg, mnB, alB); __syncthreads(); RESC(alB);
        finishSM(pB0, pB1, alB, l_reg, pa0, pa1, pa2, pa3); SBAR(); pv_tile<1, false>(o, vb0, pa0, pa1, pa2, pa3, true); }
    SBAR(); VMWN(8); SWRITE_HK(0); SBAR();
    if (hi == 0) li_l[r32] = l_reg; asm volatile("s_waitcnt lgkmcnt(0)" ::: "memory");
    float rli[16];
#pragma unroll
    for (int r = 0; r < 16; ++r) rli[r] = __builtin_amdgcn_rcpf(li_l[crow(r, hi)]);
    bf16* Ow = cur.O + (size_t)(wid * QBLK) * OS;
#pragma unroll
    for (int r = 0; r < 16; ++r) { const int orow = crow(r, hi);
#pragma unroll
        for (int d0 = 0; d0 < 4; ++d0) { const float v = o[d0][r] * rli[r];
            const float vn = __shfl_xor(v, 1);
            if ((r32 & 1) == 0) *(unsigned*)(Ow + (size_t)orow * OS + d0 * 32 + r32) = cvtpk(v, vn); } }
    __syncthreads();
#undef RESC
#undef KBASE
#undef HALF_STEP
}
#undef ROW
#undef VMW
#undef VMWN
#undef SLOAD_H
#undef SWRITE_HK
#undef SWRITE_HV
#undef SWRITE_H
#undef KSWZ
#undef SBAR
}


__device__ __forceinline__ attn::BlockRef attn_ref(ARGREF a, int b, int h, int qb) {
    attn::BlockRef r; const int kvh = h / 3;
    r.Q = (const attn::bf16*)(a.ws + WS_QB) + ((size_t)(b * 6 + h) * SEQ + (size_t)qb * 256) * 128;
    r.K = (const attn::bf16*)(a.ws + WS_KB) + (size_t)(b * 2 + kvh) * SEQ * 128;
    r.V = (const attn::bf16*)(a.ws + WS_VB) + (size_t)(b * 2 + kvh) * SEQ * 128;
    r.O = (attn::bf16*)(a.ws + WS_MIX) + (size_t)(b * SEQ + qb * 256) * DM + h * 128;
    r.M = (const attn::u32x2*)(a.ws + WS_MASK) + (size_t)(b * SEQ + qb * 256) * 64;
    r.P0 = qb * 256; return r;
}
__device__ __forceinline__ void p11_attention(Ctx& c, ARGREF a) {
    constexpr int NITEM = 192;
#pragma unroll 1
    for (int it = c.vcu; it < NITEM; it += c.G) {
        const int p = it & 7, bh = it >> 3, b = bh / 6, h = bh % 6;
        attn::Seam S;
        attn::BlockRef cur = attn_ref(a, b, h, p), nxt = attn_ref(a, b, h, 15 - p);
        __syncthreads();
        attn::sel_prime(cur, (char*)c.lds, S);
        attn::sel_block(cur, nxt, (char*)c.lds, S);
        attn::sel_block(nxt, nxt, (char*)c.lds, S);
    }
    const int spare = c.G - NITEM;
    if (spare > 0) { if (c.vcu >= NITEM) for (int u = c.vcu - NITEM; u < MS; u += spare) attn_sample_unit(c, a, u >> 2, u & 3); }
    else for (int u = c.vcu; u < MS; u += c.G) attn_sample_unit(c, a, u >> 2, u & 3);
}

enum { PH_PRO = 0, PH_IN0, PH_MIX0, PH_HSCAN, PH_HFIX, PH_OUT0, PH_GU0, PH_DOWN0, PH_IN1, PH_POST, PH_IDX, PH_TOPK, PH_ATTN, PH_OUT1, PH_GU1, PH_DOWN1, NPHASE };
#ifndef ONLYPH
#define ONLYPH -1
#endif
#define PHON(x) (ONLYPH < 0 || ONLYPH == (x))
#ifndef REP_PH
#define REP_PH -1
#endif
#ifndef REP_N
#define REP_N 1
#endif
__global__ void __launch_bounds__(NWAVES * 64, 2) fwd_kernel(Args args) {
    extern __shared__ __attribute__((aligned(16))) unsigned char lds[];
    Ctx c;
    c.lds = (LAS unsigned char*)lds;
    c.MISC = (volatile LAS unsigned*)(c.lds + MISC_OFF);
    c.tid = threadIdx.x; c.lane = c.tid & 63; c.wave = __builtin_amdgcn_readfirstlane(c.tid >> 6);
    c.G = gridDim.x; { const int bx = blockIdx.x; c.vcu = (c.G % 8 == 0) ? (bx % 8) * (c.G / 8) + bx / 8 : bx; }
    c.ctl = (gu32*)(args.ws + WS_CTL);
    for (int u = c.tid; u < (LDS_BYTES - LDSCTL_OFF) / 4; u += NWAVES * 64) ((LAS unsigned*)(c.lds + LDSCTL_OFF))[u] = 0u;
    __syncthreads();
    const int lo = args.ph_lo, hi = args.ph_hi;
    XcdBarrier bar; bar.bar = (unsigned*)(c.ctl + CW_BAR); bar.x = 0; bar.st = nullptr;
    if (hi - lo > 1 || REP_N > 1) bar = xcd_barrier_post((unsigned*)(c.ctl + CW_BAR), c.MISC + 8);
    c.qoff = 0;
#pragma unroll 1
    for (int ph = lo; ph < hi; ++ph) {
        const int layer = ph >= PH_IN1 ? 1 : 0;
        const __attribute__((address_space(4))) Args* ap = (const __attribute__((address_space(4))) Args*)__builtin_amdgcn_kernarg_segment_ptr(); asm volatile("" : "+s"(ap));
        ARGREF la = *ap; unsigned char* const ws = la.ws; float* const out = la.out;
        { int t_ = threadIdx.x; asm volatile("" : "+v"(t_)); c.tid = t_; c.lane = t_ & 63; c.wave = __builtin_amdgcn_readfirstlane(t_ >> 6); }
        if ((ph == PH_DOWN0 || ph == PH_DOWN1) && PHON(PH_OUT0)) {
            pg8::SchedX S0; S0.init(MP, 1024, c.G, (int)blockIdx.x, 0, 0, 1, 0); pg8::Unit u0; if (S0.next(0, u0)) conv_fixup_tile(c, la, layer, u0.pm); VM_WAIT(); __syncthreads(); }
        if (ph == PH_PRO && PHON(PH_PRO)) p0_prologue(c, la);
        else if ((ph == PH_IN0 || ph == PH_IN1) && PHON(PH_IN0)) {
            pg8::Gemm g{(const pg8::bf16_t*)(ws + WS_XB), (const pg8::bf16_t*)(ws + (ph == PH_IN0 ? WS_WIN0 : WS_WIN1)), MT, 0, 1024};
            pg8::SchedX S; if (ph == PH_IN0) S.init(MP, ZC0, c.G, (int)blockIdx.x, 16, MT / 256, 4, 13); else S.init(MP, ZC1, c.G, (int)blockIdx.x, 0, 0, 1, 0);
            pg8::EpiZ E{(pg8::bf16_t*)(ws + WS_Z), ph == PH_IN0 ? ZC0 : ZC1, ssptr(c, ph == PH_IN0 ? 0 : 2), ph == PH_IN0 ? 13 : 9, (float*)(ws + WS_MEMKV), MEMROW0};
            pg8::gemm_phase<pg8::EpiZ, pg8::SchedX, PG8_ALIGN, PG8_SP2>(c.lds + RING_OFF, g, S, E);
            { SgArgs sg{}; sg.A = (const bf16*)(ws + WS_XB) + (size_t)MP * DM; sg.Bt = (const bf16*)(ws + (ph == PH_IN0 ? WS_WIN0 : WS_WIN1)); sg.K = 1024; sg.mode = 0; sg.Z = (bf16*)(ws + WS_Z); sg.ldz = ph == PH_IN0 ? ZC0 : ZC1; sg.ssin = ssptr(c, ph == PH_IN0 ? 0 : 2);
              sgemm_phase(c, sg, ph == PH_IN0 ? ZC0 : ZC1); }
        }
        else if (ph == PH_MIX0 && PHON(PH_MIX0)) p2_mixer0(c, la);
        else if (ph == PH_HSCAN && PHON(PH_HSCAN)) hgrn_scan(c, la);
        else if (ph == PH_HFIX && PHON(PH_HFIX)) p2c_hgrn_fix(c, la);
        else if ((ph == PH_OUT0 || ph == PH_DOWN0 || ph == PH_OUT1 || ph == PH_DOWN1) && PHON(PH_OUT0)) {
            const bool isout = (ph == PH_OUT0 || ph == PH_OUT1);
            pg8::Gemm g{(const pg8::bf16_t*)(ws + (isout ? WS_MIX : WS_ACT)), (const pg8::bf16_t*)(ws + (isout ? WS_WOUT + (size_t)layer * 1024 * 1024 * 2 : WS_WD + (size_t)layer * 1024 * DFF * 2)), MT, 1024, isout ? 1024 : DFF};
            pg8::SchedX S; S.init(MP, 1024, c.G, (int)blockIdx.x, 0, 0, 1, 0);
            pg8::EpiResid E;
            E.rp = ph == PH_OUT0 ? la.in[0] : nullptr; E.rb = (const pg8::bf16_t*)(ws + WS_XB); E.y = ph == PH_DOWN1 ? out + O_YP : nullptr;
            E.xb = ph == PH_DOWN1 ? nullptr : (pg8::bf16_t*)(ws + WS_XB); E.ssout = ph == PH_DOWN1 ? nullptr : ssptr(c, ph == PH_OUT0 ? 1 : (ph == PH_DOWN0 ? 2 : 3));
            pg8::gemm_phase<pg8::EpiResid, pg8::SchedX, PG8_ALIGN, PG8_SP2>(c.lds + RING_OFF, g, S, E);
            { SgArgs sg{}; sg.A = (const bf16*)(ws + (isout ? WS_MIX : WS_ACT)) + (size_t)MP * (isout ? 1024 : DFF); sg.Bt = (const bf16*)g.Bt; sg.K = isout ? 1024 : DFF; sg.mode = 1; sg.rb = (const bf16*)(ws + WS_XB); sg.resid = ph == PH_OUT0 ? la.in[1] : nullptr; sg.y = ph == PH_DOWN1 ? out + O_YS : nullptr; sg.xb = (bf16*)E.xb; sg.ssout = E.ssout;
              sgemm_phase(c, sg, 1024); }
        }
        else if ((ph == PH_GU0 || ph == PH_GU1) && PHON(PH_GU0)) {
            pg8::Gemm g{(const pg8::bf16_t*)(ws + WS_XB), (const pg8::bf16_t*)(ws + WS_WGU + (size_t)layer * 5632 * 1024 * 2), MT, 5632, 1024};
            pg8::SchedX S; S.init(MP, 5632, c.G, (int)blockIdx.x, 0, 0, 1, 0);
            pg8::EpiGU E{(pg8::bf16_t*)(ws + WS_ACT), ssptr(c, layer ? 3 : 1), out + O_CVP + (size_t)layer * 4 * 2 * DFF, la.in[26] + (size_t)layer * 3 * DFF, la.in[27] + (size_t)layer * DFF, (float*)(ws + WS_G4), (float*)(ws + WS_UP2)};
            pg8::gemm_phase<pg8::EpiGU, pg8::SchedX, PG8_ALIGN, PG8_SP2>(c.lds + RING_OFF, g, S, E);
            { SgArgs sg{}; sg.A = (const bf16*)(ws + WS_XB) + (size_t)MP * DM; sg.Bt = (const bf16*)g.Bt; sg.K = 1024; sg.mode = 2; sg.ssin = E.ss; sg.ACT = (bf16*)E.ACT; sg.cvs = out + O_CVS + (size_t)layer * 32 * 2 * DFF; sg.cst = la.in[8] + (size_t)layer * 32 * 2 * DFF; sg.cw = E.cw; sg.cb = E.cb;
              sgemm_phase(c, sg, 5632); }
        }
        else if (ph == PH_POST && PHON(PH_POST)) p8_dsa_post(c, la);
        else if (ph == PH_IDX && PHON(PH_IDX)) p9_indexer(c, la);
        else if (ph == PH_TOPK && PHON(PH_TOPK)) p10_topk(c, la);
        else if (ph == PH_ATTN && PHON(PH_ATTN)) p11_attention(c, la);
        if (REP_N > 1 && ph == REP_PH && c.qoff < 4 * (REP_N - 1)) { c.qoff += 4; --ph; xcd_barrier(bar); continue; }
        if (REP_N > 1) c.qoff = 0;
        if (ph + 1 < hi) xcd_barrier(bar);
    }
}

#ifndef MK_ONE_LAUNCH
#define MK_ONE_LAUNCH 1
#endif
extern "C" void kernel_launch(void* const* d_in, const int* in_sizes, int n_in, void* d_out, int out_size, void* d_ws, size_t ws_size, hipStream_t stream) {
    static int grid = 0;
    if (grid == 0) {
        if (n_in != 29 || out_size != (int)O_END || ws_size < WS_END) { fprintf(stderr, "kernel_launch: unexpected problem (n_in %d, out %d, ws %zu)\n", n_in, out_size, ws_size); grid = -1; return; }
        int dev = 0, cus = 0;
        if (hipGetDevice(&dev) != hipSuccess || hipDeviceGetAttribute(&cus, hipDeviceAttributeMultiprocessorCount, dev) != hipSuccess) { grid = -1; return; }
        if (hipFuncSetAttribute((const void*)fwd_kernel, hipFuncAttributeMaxDynamicSharedMemorySize, LDS_BYTES) != hipSuccess) { fprintf(stderr, "kernel_launch: hipFuncSetAttribute failed\n"); grid = -1; return; }
        (void)hipGetLastError();
        grid = cus;
    }
    if (grid < 0) return;
    if (hipMemsetAsync((char*)d_ws + WS_CTL, 0, CTL_ZERO_BYTES, stream) != hipSuccess) { fprintf(stderr, "kernel_launch: memset failed\n"); return; }
    Args a{};
    for (int i = 0; i < 29; ++i) a.in[i] = (const float*)d_in[i];
    a.page_table = (const int*)d_in[9]; a.out = (float*)d_out; a.ws = (unsigned char*)d_ws;
#if MK_ONE_LAUNCH
    a.ph_lo = 0; a.ph_hi = NPHASE;
    hipLaunchKernelGGL(fwd_kernel, dim3(grid), dim3(NWAVES * 64), LDS_BYTES, stream, a);
#else
    for (int ph = 0; ph < NPHASE; ++ph) { a.ph_lo = ph; a.ph_hi = ph + 1; hipLaunchKernelGGL(fwd_kernel, dim3(grid), dim3(NWAVES * 64), LDS_BYTES, stream, a); }
#endif
}
```

```cpp
#include <hip/hip_runtime.h>
#include <cstdio>
#include <cstdint>


namespace pg8 {
#define PG8_LAS __attribute__((address_space(3)))
typedef unsigned short bf16_t;
typedef short bf16x8 __attribute__((ext_vector_type(8)));
typedef float f32x4 __attribute__((ext_vector_type(4)));
typedef unsigned u32x4 __attribute__((ext_vector_type(4)));
constexpr int BM = 256, BK = 64, HALF = 128, HTB = HALF * BK * 2  , STAGE_BYTES = 8 * HTB, NXCD = 8, WGM = 8;

__host__ __device__ __forceinline__ int lds_byte(int r, int c) { const int st = (r >> 4) * 2 + (c >> 5), rr = r & 15, cc = c & 31, ob = rr * 64 + cc * 2; return st * 1024 + (ob ^ (((ob >> 9) & 1) << 5)); }
__host__ __device__ __forceinline__ void stage_rc(int b, int& R, int& C) { const int st = b / 1024, sb = b % 1024, swz = sb ^ (((sb >> 9) & 1) << 5); R = (st >> 1) * 16 + swz / 64; C = (st & 1) * 32 + (swz % 64) / 2; }
__host__ __device__ __forceinline__ int perm32(int rho) { const int n = rho >> 4, i = rho & 15; return 8 * (i >> 2) + 4 * n + (i & 3); }

struct Unit { int pm, pn; };
struct Gemm { const bf16_t* A; const bf16_t* Bt; int M, N, K; };

struct StaticOrder {
    int nM, nN, nwg, G, c;
    __host__ __device__ __forceinline__ void init(int M, int N, int G_, int c_) { nM = M / BM; nN = N / BM; nwg = nM * nN; G = G_; c = c_; }
    __host__ __device__ __forceinline__ bool next(int i, Unit& u) const {
        const long L = (long)i * G + c; if (L >= nwg) return false;
        int wgid = (int)L; { const int q = nwg / NXCD, r = nwg % NXCD, xcd = wgid % NXCD, off = wgid / NXCD; wgid = (xcd < r ? xcd * (q + 1) : r * (q + 1) + (xcd - r) * q) + off; }
        const int nig = WGM * nN, gid = wgid / nig, fm = gid * WGM, gsz = (nM - fm) < WGM ? (nM - fm) : WGM;
        u.pm = fm + ((wgid % nig) % gsz); u.pn = (wgid % nig) / gsz; return true;
    }
    __device__ __forceinline__ void a_ready(const Unit&) const {}
    __device__ __forceinline__ void done(const Unit&) const {}
};


constexpr int MP = 16384, MS = 128, MVALID = MP + MS, MT = 16640, DM = 1024, DFF = 2816;
constexpr float RMS_EPS = 1e-6f;
__device__ __forceinline__ unsigned cvt_pk_bf16(float lo, float hi) { unsigned r; asm volatile("v_cvt_pk_bf16_f32 %0, %1, %2" : "=v"(r) : "v"(lo), "v"(hi)); return r; }

struct SchedX {
    StaticOrder so; int nextra, e_pm0, e_nm, e_pn0;
    __device__ __forceinline__ void init(int M, int N, int G_, int c_, int nextra_, int e_pm0_, int e_nm_, int e_pn0_) { so.init(M, N, G_, c_); nextra = nextra_; e_pm0 = e_pm0_; e_nm = e_nm_; e_pn0 = e_pn0_; }
    __device__ __forceinline__ bool next(int i, Unit& u) const {
        const long L = (long)i * so.G + so.c;
        if (L < so.nwg) return so.next(i, u);
        const int e = (int)(L - so.nwg); if (e >= nextra) return false;
        u.pm = e_pm0 + e % e_nm; u.pn = e_pn0 + e / e_nm; return true;
    }
    __device__ __forceinline__ void a_ready(const Unit&) const {}
    __device__ __forceinline__ void done(const Unit&) const {}
};

struct EpiZ {
    static constexpr bool PERM = true, AFTER_DRAIN = false;
    bf16_t* Z; int ldz; const float* ss; int nmain; float* memkv; int memrow0;
    __device__ __forceinline__ void operator()(const f32x4 (&acc)[2][2][4][2], const Unit& u, int wr, int wc, int fr, int fq) const {
        const int row0 = u.pm * BM + wr * 64 + fr;
        if (u.pn < nmain) {
            const int col0 = u.pn * BM + wc * 32 + 8 * fq;
#pragma unroll
            for (int ai = 0; ai < 2; ++ai)
#pragma unroll
                for (int m = 0; m < 4; ++m) { const int row = row0 + ai * HALF + m * 16; const float rs = rsqrtf(ss[row] * (1.0f / DM) + RMS_EPS);
#pragma unroll
                    for (int bj = 0; bj < 2; ++bj) { const f32x4 v0 = acc[ai][bj][m][0] * rs, v1 = acc[ai][bj][m][1] * rs;
                        u32x4 w; w.x = cvt_pk_bf16(v0[0], v0[1]); w.y = cvt_pk_bf16(v0[2], v0[3]); w.z = cvt_pk_bf16(v1[0], v1[1]); w.w = cvt_pk_bf16(v1[2], v1[3]);
                        *(u32x4*)(Z + (size_t)row * ldz + col0 + bj * HALF) = w; } }
        } else {
            const int col0 = (u.pn - nmain) * BM + wc * 32 + 8 * fq;
#pragma unroll
            for (int ai = 0; ai < 2; ++ai)
#pragma unroll
                for (int m = 0; m < 4; ++m) { const int row = row0 + ai * HALF + m * 16 - memrow0;
#pragma unroll
                    for (int bj = 0; bj < 2; ++bj) { float* p = memkv + (size_t)row * 1024 + col0 + bj * HALF; *(f32x4*)p = acc[ai][bj][m][0]; *(f32x4*)(p + 4) = acc[ai][bj][m][1]; } }
        }
    }
};

struct EpiResid {
    static constexpr bool PERM = true, AFTER_DRAIN = false;
    const float* rp; const bf16_t* rb; float* y; bf16_t* xb; float* ssout;
    __device__ __forceinline__ void operator()(const f32x4 (&acc)[2][2][4][2], const Unit& u, int wr, int wc, int fr, int fq) const {
        const int row0 = u.pm * BM + wr * 64 + fr, col0 = u.pn * BM + wc * 32 + 8 * fq;
#pragma unroll
        for (int ai = 0; ai < 2; ++ai)
#pragma unroll
            for (int m = 0; m < 4; ++m) { const int row = row0 + ai * HALF + m * 16; float part = 0.f;
#pragma unroll
                for (int bj = 0; bj < 2; ++bj) { const int c = col0 + bj * HALF; f32x4 r0, r1;
                    if (rp) { r0 = *(const f32x4*)(rp + (size_t)row * DM + c); r1 = *(const f32x4*)(rp + (size_t)row * DM + c + 4); }
                    else { const u32x4 q = *(const u32x4*)(rb + (size_t)row * DM + c);
                        r0 = (f32x4){__builtin_bit_cast(float, q.x << 16), __builtin_bit_cast(float, q.x & 0xffff0000u), __builtin_bit_cast(float, q.y << 16), __builtin_bit_cast(float, q.y & 0xffff0000u)};
                        r1 = (f32x4){__builtin_bit_cast(float, q.z << 16), __builtin_bit_cast(float, q.z & 0xffff0000u), __builtin_bit_cast(float, q.w << 16), __builtin_bit_cast(float, q.w & 0xffff0000u)}; }
                    const f32x4 v0 = acc[ai][bj][m][0] + r0, v1 = acc[ai][bj][m][1] + r1;
                    if (y) { *(f32x4*)(y + (size_t)row * DM + c) = v0; *(f32x4*)(y + (size_t)row * DM + c + 4) = v1; }
                    part += (v0[0] * v0[0] + v0[1] * v0[1]) + (v0[2] * v0[2] + v0[3] * v0[3]) + (v1[0] * v1[0] + v1[1] * v1[1]) + (v1[2] * v1[2] + v1[3] * v1[3]);
                    if (xb) { u32x4 w; w.x = cvt_pk_bf16(v0[0], v0[1]); w.y = cvt_pk_bf16(v0[2], v0[3]); w.z = cvt_pk_bf16(v1[0], v1[1]); w.w = cvt_pk_bf16(v1[2], v1[3]);
                        *(u32x4*)(xb + (size_t)row * DM + c) = w; } }
                part += __shfl_xor(part, 16); part += __shfl_xor(part, 32);
                if (ssout && fq == 0) atomicAdd(ssout + row, part); }
    }
};

__device__ __forceinline__ void dpp_ror12(const f32x4& v, f32x4& r1, f32x4& r2) {
    float a0, a1, a2, a3, b0, b1, b2, b3;
    asm volatile("s_nop 1\n\t"
                 "v_mov_b32_dpp %0, %8 row_ror:1 row_mask:0xf bank_mask:0xf\n\tv_mov_b32_dpp %1, %9 row_ror:1 row_mask:0xf bank_mask:0xf\n\t"
                 "v_mov_b32_dpp %2, %10 row_ror:1 row_mask:0xf bank_mask:0xf\n\tv_mov_b32_dpp %3, %11 row_ror:1 row_mask:0xf bank_mask:0xf\n\t"
                 "v_mov_b32_dpp %4, %8 row_ror:2 row_mask:0xf bank_mask:0xf\n\tv_mov_b32_dpp %5, %9 row_ror:2 row_mask:0xf bank_mask:0xf\n\t"
                 "v_mov_b32_dpp %6, %10 row_ror:2 row_mask:0xf bank_mask:0xf\n\tv_mov_b32_dpp %7, %11 row_ror:2 row_mask:0xf bank_mask:0xf"
                 : "=&v"(a0), "=&v"(a1), "=&v"(a2), "=&v"(a3), "=&v"(b0), "=&v"(b1), "=&v"(b2), "=&v"(b3) : "v"(v[0]), "v"(v[1]), "v"(v[2]), "v"(v[3]));
    r1 = (f32x4){a0, a1, a2, a3}; r2 = (f32x4){b0, b1, b2, b3};
}
struct EpiGU {
    static constexpr bool PERM = true, AFTER_DRAIN = false;
    bf16_t* ACT; const float* ss; float* cvp; const float* cw; const float* cb; float* G4; float* UP2;
    __device__ __forceinline__ void operator()(const f32x4 (&acc)[2][2][4][2], const Unit& u, int wr, int wc, int fr, int fq) const {
        const int row0 = u.pm * BM + wr * 64 + fr, colg = u.pn * HALF + wc * 32 + 8 * fq;
#pragma unroll
        for (int n = 0; n < 2; ++n) { const int col = colg + 4 * n;
            const f32x4 w0 = *(const f32x4*)(cw + col), w1 = *(const f32x4*)(cw + DFF + col), w2 = *(const f32x4*)(cw + 2 * DFF + col), bb = *(const f32x4*)(cb + col);
#pragma unroll
            for (int ai = 0; ai < 2; ++ai) { f32x4 r1p = {0.f, 0.f, 0.f, 0.f}, r2p = r1p; const int slab = (u.pm * BM + ai * HALF + wr * 64) >> 6;
#pragma unroll
                for (int m = 0; m < 4; ++m) { const int row = row0 + ai * HALF + m * 16; const float rs = rsqrtf(ss[row] * (1.0f / DM) + RMS_EPS);
                    const f32x4 g = acc[ai][0][m][n] * rs, up = acc[ai][1][m][n] * rs;
                    f32x4 r1, r2; dpp_ror12(g, r1, r2);
                    const f32x4 p1 = fr >= 1 ? r1 : r1p, p2 = fr >= 2 ? r2 : r2p;
                    f32x4 cv = bb + w0 * p2 + w1 * p1 + w2 * g, y;
#pragma unroll
                    for (int i = 0; i < 4; ++i) y[i] = cv[i] * __builtin_amdgcn_rcpf(1.0f + __expf(-cv[i])) * up[i];
                    if (m == 0 && fr < 2) { *(f32x4*)(G4 + (size_t)(slab * 4 + fr) * DFF + col) = g; *(f32x4*)(UP2 + (size_t)(slab * 2 + fr) * DFF + col) = up; }
                    else { typedef unsigned u32x2 __attribute__((ext_vector_type(2))); u32x2 w; w.x = cvt_pk_bf16(y[0], y[1]); w.y = cvt_pk_bf16(y[2], y[3]); *(u32x2*)(ACT + (size_t)row * DFF + col) = w; }
                    if (m == 3 && fr >= 14) { *(f32x4*)(G4 + (size_t)(slab * 4 + 2 + (fr - 14)) * DFF + col) = g;
                        const int t = row & 4095; if (t >= 4094) *(f32x4*)(cvp + (size_t)((row >> 12) * 2 + (t - 4094)) * DFF + col) = g; }
                    r1p = r1; r2p = r2; } } }
    }
};

template <class Epi, class Sched, bool ALIGN_EPI = false, bool SP2 = false>
__device__ __forceinline__ void gemm_phase(PG8_LAS unsigned char* lds, const Gemm g, const Sched& S, const Epi& E) {
    int tid_ = threadIdx.x; asm volatile("" : "+v"(tid_));
    const int tid = tid_, wid = __builtin_amdgcn_readfirstlane(tid >> 6), lane = tid & 63, wr = wid >> 2, wc = wid & 3, fr = lane & 15, fq = lane >> 4;
    const int K = g.K, nt = K / BK;
    unsigned voffA[2], voffB[2];
#pragma unroll
    for (int i = 0; i < 2; ++i) { int R, C; stage_rc(tid * 16 + i * 8192, R, C); const int Rb = Epi::PERM ? ((R & ~31) + perm32(R & 31)) : R;
        voffA[i] = (unsigned)(R * K + C) * 2u; voffB[i] = (unsigned)(Rb * K + C) * 2u; }
    const size_t kstep = (size_t)(BK * 2);
    const size_t hstep = (size_t)HALF * K * 2;
    const size_t tstep = 2 * hstep;
    const unsigned ldsw = (unsigned)wid * 1024u;
    const int aoff = lds_byte(wr * 64 + fr, fq * 8), boff = lds_byte(wc * 32 + fr, fq * 8);
#define PG8_SA(b, h) (((b) * 2 + (h)) * HTB)
#define PG8_SB(b, h) ((4 + (b) * 2 + (h)) * HTB)
#define PG8_STAGE(bufoff, gbase, voff) do { _Pragma("unroll") for (int _i = 0; _i < 2; ++_i) \
        __builtin_amdgcn_global_load_lds((const unsigned*)((const char*)(gbase) + (voff)[_i]), (PG8_LAS unsigned*)(lds + (bufoff) + ldsw + _i * 8192), 16, 0, 0); } while (0)
#define PG8_LDA(dst, b, h) do { _Pragma("unroll") for (int m = 0; m < 4; ++m) _Pragma("unroll") for (int k = 0; k < 2; ++k) dst[m][k] = *(const PG8_LAS bf16x8*)(lds + PG8_SA(b, h) + aoff + m * 2048 + k * 1024); } while (0)
#define PG8_LDB(dst, b, h) do { _Pragma("unroll") for (int n = 0; n < 2; ++n) _Pragma("unroll") for (int k = 0; k < 2; ++k) dst[n][k] = *(const PG8_LAS bf16x8*)(lds + PG8_SB(b, h) + boff + n * 2048 + k * 1024); } while (0)
#define PG8_MMA(ai, bj, At, Bt) do { __builtin_amdgcn_s_setprio(1); _Pragma("unroll") for (int m = 0; m < 4; ++m) _Pragma("unroll") for (int n = 0; n < 2; ++n) _Pragma("unroll") for (int k = 0; k < 2; ++k) \
        acc[ai][bj][m][n] = __builtin_amdgcn_mfma_f32_16x16x32_bf16(Bt[n][k], At[m][k], acc[ai][bj][m][n], 0, 0, 0); __builtin_amdgcn_s_setprio(0); } while (0)
#define PG8_WAIT_V(n) asm volatile("s_waitcnt vmcnt(" #n ")" ::: "memory")
#define PG8_WAIT_L(n) asm volatile("s_waitcnt lgkmcnt(" #n ")" ::: "memory")
#define PG8_BAR __builtin_amdgcn_s_barrier()
#define PG8_SCHED __builtin_amdgcn_sched_barrier(0)
    Unit cur, nxt; int ui = 0;
    if (!S.next(0, cur)) return;
    f32x4 acc[2][2][4][2];
#pragma unroll
    for (int a = 0; a < 2; ++a)
#pragma unroll
        for (int b = 0; b < 2; ++b)
#pragma unroll
            for (int m = 0; m < 4; ++m)
#pragma unroll
                for (int n = 0; n < 2; ++n) acc[a][b][m][n] = (f32x4){0.f, 0.f, 0.f, 0.f};
    bf16x8 At[4][2], B0[2][2], B1[2][2];
    const char* cA = (const char*)g.A + (size_t)cur.pm * tstep; const char* cB = (const char*)g.Bt + (size_t)cur.pn * tstep;
    S.a_ready(cur);
    if constexpr (SP2) {
        PG8_STAGE(PG8_SB(0, 0), cB, voffB); PG8_STAGE(PG8_SB(0, 1), cB + hstep, voffB); PG8_STAGE(PG8_SA(0, 0), cA, voffA); PG8_STAGE(PG8_SA(0, 1), cA + hstep, voffA);
        if (wr == 1) PG8_BAR;
        PG8_WAIT_V(2); PG8_BAR;
        PG8_STAGE(PG8_SB(1, 0), cB + kstep, voffB); PG8_STAGE(PG8_SA(1, 0), cA + kstep, voffA); PG8_STAGE(PG8_SB(1, 1), cB + hstep + kstep, voffB);
        PG8_WAIT_V(6); PG8_BAR;
    } else {
        PG8_STAGE(PG8_SB(0, 0), cB, voffB); PG8_STAGE(PG8_SA(0, 0), cA, voffA); PG8_STAGE(PG8_SB(0, 1), cB + hstep, voffB); PG8_STAGE(PG8_SA(0, 1), cA + hstep, voffA);
        if (wr == 1) PG8_BAR;
        PG8_WAIT_V(4); PG8_BAR;
        PG8_STAGE(PG8_SB(1, 0), cB + kstep, voffB); PG8_STAGE(PG8_SA(1, 0), cA + kstep, voffA); PG8_STAGE(PG8_SB(1, 1), cB + hstep + kstep, voffB);
        PG8_WAIT_V(6); PG8_BAR;
    }
    for (;;) {
        const bool has_next = S.next(ui + 1, nxt);
        const char* nA = has_next ? (const char*)g.A + (size_t)nxt.pm * tstep : cA; const char* nB = has_next ? (const char*)g.Bt + (size_t)nxt.pn * tstep : cB;
        for (int t = 0; t < nt; t += 2) {
            const bool last = (t == nt - 2);
            const char* a1 = cA + (size_t)(t + 1) * kstep;
            const char* a2 = last ? nA : cA + (size_t)(t + 2) * kstep; const char* b2 = last ? nB : cB + (size_t)(t + 2) * kstep;
            const char* a3 = a2 + kstep; const char* b3 = b2 + kstep;
            if (last && has_next) S.a_ready(nxt);
            if constexpr (SP2) {
            PG8_LDB(B0, 0, 0); PG8_LDB(B1, 0, 1); PG8_SCHED; PG8_LDA(At, 0, 0); PG8_STAGE(PG8_SA(1, 1), a1 + hstep, voffA);
            PG8_WAIT_V(8); PG8_WAIT_L(0); PG8_BAR; PG8_MMA(0, 0, At, B0); PG8_MMA(0, 1, At, B1); PG8_BAR; PG8_SCHED;
            PG8_LDA(At, 0, 1); PG8_STAGE(PG8_SB(0, 0), b2, voffB); PG8_STAGE(PG8_SB(0, 1), b2 + hstep, voffB); PG8_STAGE(PG8_SA(0, 0), a2, voffA);
            PG8_WAIT_V(8); PG8_WAIT_L(0); PG8_BAR; PG8_MMA(1, 0, At, B0); PG8_MMA(1, 1, At, B1); PG8_BAR; PG8_SCHED;
            PG8_LDB(B0, 1, 0); PG8_LDB(B1, 1, 1); PG8_SCHED; PG8_LDA(At, 1, 0); PG8_STAGE(PG8_SA(0, 1), a2 + hstep, voffA);
            PG8_WAIT_V(8); PG8_WAIT_L(0); PG8_BAR; PG8_MMA(0, 0, At, B0); PG8_MMA(0, 1, At, B1); PG8_BAR; PG8_SCHED;
            PG8_LDA(At, 1, 1); PG8_STAGE(PG8_SB(1, 0), b3, voffB); PG8_STAGE(PG8_SB(1, 1), b3 + hstep, voffB); PG8_STAGE(PG8_SA(1, 0), a3, voffA);
            PG8_WAIT_V(8); PG8_WAIT_L(0); PG8_BAR; PG8_MMA(1, 0, At, B0); PG8_MMA(1, 1, At, B1); PG8_BAR; PG8_SCHED;
            } else {
            PG8_LDB(B0, 0, 0); PG8_SCHED; PG8_LDA(At, 0, 0); PG8_STAGE(PG8_SA(1, 1), a1 + hstep, voffA);
            PG8_WAIT_L(8); PG8_BAR; PG8_WAIT_L(0); PG8_MMA(0, 0, At, B0); PG8_BAR; PG8_SCHED;
            PG8_LDB(B1, 0, 1); PG8_STAGE(PG8_SB(0, 0), b2, voffB);
            PG8_BAR; PG8_WAIT_L(0); PG8_MMA(0, 1, At, B1); PG8_BAR;
            PG8_LDA(At, 0, 1); PG8_STAGE(PG8_SA(0, 0), a2, voffA);
            PG8_BAR; PG8_WAIT_L(0); PG8_MMA(1, 0, At, B0); PG8_BAR; PG8_SCHED;
            PG8_STAGE(PG8_SB(0, 1), b2 + hstep, voffB);
            PG8_WAIT_V(6); PG8_BAR; PG8_MMA(1, 1, At, B1); PG8_BAR;
            PG8_LDB(B0, 1, 0); PG8_SCHED; PG8_LDA(At, 1, 0); PG8_STAGE(PG8_SA(0, 1), a2 + hstep, voffA);
            PG8_WAIT_L(8); PG8_BAR; PG8_WAIT_L(0); PG8_MMA(0, 0, At, B0); PG8_BAR; PG8_SCHED;
            PG8_LDB(B1, 1, 1); PG8_STAGE(PG8_SB(1, 0), b3, voffB);
            PG8_BAR; PG8_WAIT_L(0); PG8_MMA(0, 1, At, B1); PG8_BAR;
            PG8_LDA(At, 1, 1); PG8_STAGE(PG8_SA(1, 0), a3, voffA);
            PG8_BAR; PG8_WAIT_L(0); PG8_MMA(1, 0, At, B0); PG8_BAR; PG8_SCHED;
            PG8_STAGE(PG8_SB(1, 1), b3 + hstep, voffB);
            PG8_WAIT_V(6); PG8_BAR; PG8_MMA(1, 1, At, B1); PG8_BAR;
            }
        }
        if constexpr (ALIGN_EPI) { if (wr == 0) PG8_BAR; }
        if constexpr (!Epi::AFTER_DRAIN) { E(acc, cur, wr, wc, fr, fq); S.done(cur); }
        if (!has_next) break;
#pragma unroll
        for (int a = 0; a < 2; ++a)
#pragma unroll
            for (int b = 0; b < 2; ++b)
#pragma unroll
                for (int m = 0; m < 4; ++m)
#pragma unroll
                    for (int n = 0; n < 2; ++n) acc[a][b][m][n] = (f32x4){0.f, 0.f, 0.f, 0.f};
        cur = nxt; cA = nA; cB = nB; ++ui;
        if constexpr (ALIGN_EPI) { if (wr == 1) PG8_BAR; }
    }
    PG8_WAIT_V(0);
    if constexpr (!ALIGN_EPI) { if (wr == 0) PG8_BAR; }
    PG8_BAR;
    if constexpr (Epi::AFTER_DRAIN) { E.fused(acc, cur, wr, wc, fr, fq, lds, wid, lane); S.done(cur); }
#undef PG8_SA
#undef PG8_SB
#undef PG8_STAGE
#undef PG8_LDA
#undef PG8_LDB
#undef PG8_MMA
#undef PG8_WAIT_V
#undef PG8_WAIT_L
#undef PG8_BAR
#undef PG8_SCHED
}
}


#ifndef PG8_SP2
#define PG8_SP2 true
#endif
#ifndef PG8_ALIGN
#define PG8_ALIGN true
#endif
constexpr int NWAVES = 8;
constexpr int MP = pg8::MP, MS = pg8::MS, MVALID = pg8::MVALID, MT = pg8::MT, DM = 1024, DFF = 2816;
constexpr int SEQ = 4096, NB = 4, NSB = 32, PAST = 8192, NPOOL = 2560;
constexpr int ZC0 = 3328, ZC1 = 2304;
constexpr int Z1_Q = 0, Z1_K = 768, Z1_V = 1024, Z1_IQ = 1280, Z1_IK = 1792, Z1_IW = 1856, Z1_MQ = 1920;
constexpr int NMEMROWS = 1024, MEMROW0 = MT;
constexpr float EPS = 1e-6f;
constexpr size_t MiB = 1u << 20;
constexpr size_t WS_CTL = 0, CTL_ZERO_BYTES = 2 * MiB;
constexpr size_t WS_WIN0 = 2 * MiB, WS_WIN1 = 11 * MiB, WS_WOUT = 16 * MiB, WS_WGU = 20 * MiB, WS_WD = 42 * MiB;
constexpr size_t WS_XB = 54 * MiB, WS_MEMKV = 89 * MiB, WS_MIX = 94 * MiB, WS_Z = 128 * MiB, WS_U = 234 * MiB, WS_UP = 324 * MiB, WS_ACT = 414 * MiB;
constexpr size_t WS_QB = 504 * MiB, WS_KB = 528 * MiB, WS_VB = 536 * MiB, WS_IQB = 544 * MiB, WS_IKB = 560 * MiB, WS_IW = 562 * MiB;
constexpr size_t WS_SQ = 563 * MiB, WS_SIQ = WS_SQ + 512 * 1024, WS_SIW = WS_SIQ + 384 * 1024, WS_SSC = 564 * MiB, WS_SIDX = 569 * MiB, WS_MASK = 570 * MiB, WS_SC = 578 * MiB, WS_END = 834 * MiB;
constexpr int SSC_LD = 8256;
constexpr int CW_TMO = 0, CW_BAR = 4096, CW_Q = 8192, CW_SS = 16384;
constexpr size_t O_YP = 0, O_YS = O_YP + (size_t)MP * DM, O_HP = O_YS + (size_t)MS * DM, O_HS = O_HP + 4 * 6 * 16384, O_KP = O_HS + 32 * 6 * 16384,
    O_VP = O_KP + (size_t)MP * 256, O_IKP = O_VP + (size_t)MP * 256, O_KS = O_IKP + (size_t)MP * 64, O_VS = O_KS + MS * 256, O_IKS = O_VS + MS * 256,
    O_MK = O_IKS + MS * 64, O_MV = O_MK + 2 * 1024 * 256, O_CVP = O_MV + 2 * 1024 * 256, O_CVS = O_CVP + 2 * 4 * 2 * DFF, O_END = O_CVS + 2 * 32 * 2 * DFF;
static_assert(O_END == 31412224, "output size");
constexpr int RING_OFF = 0, RING_BYTES = 131072;
constexpr int LDSCTL_OFF = RING_BYTES, MISC_OFF = LDSCTL_OFF + 320;
constexpr int LDS_BYTES = 147456;

#define GAS __attribute__((address_space(1)))
#define LAS __attribute__((address_space(3)))
typedef unsigned short bf16;
typedef unsigned v4u __attribute__((ext_vector_type(4)));
typedef float f32x4 __attribute__((ext_vector_type(4)));
typedef short bf16x8 __attribute__((ext_vector_type(8)));
typedef GAS unsigned gu32;
typedef GAS unsigned long long gu64;
#define RLX_AGENT __ATOMIC_RELAXED, __HIP_MEMORY_SCOPE_AGENT
#define LDS_WAIT() asm volatile("s_waitcnt lgkmcnt(0)" ::: "memory")
#define VM_WAIT() asm volatile("s_waitcnt vmcnt(0)" ::: "memory")
__device__ __forceinline__ unsigned long long rt() { return __builtin_amdgcn_s_memrealtime(); }
__device__ __forceinline__ unsigned f2bf(float f) { unsigned u = __builtin_bit_cast(unsigned, f); return (u + 0x7fffu + ((u >> 16) & 1u)) >> 16; }
__device__ __forceinline__ unsigned pk2(float lo, float hi) { return f2bf(lo) | (f2bf(hi) << 16); }

#define XB_TMO      128
#define XB_XCNT(j)  (256  + 64 * (j))
#define XB_XSUB(j)  (1280 + 64 * (j))
#define XB_XGEN(j)  (2304 + 64 * (j))
#define XB_TOP      3328
#define XB_TOPGEN   3392
#define XCD_BAR_WORDS 3456
#define XB_SPIN_CAP (1u << 18)

__device__ __forceinline__ unsigned xb_ld(unsigned* p)              { return __hip_atomic_load(p, __ATOMIC_RELAXED, __HIP_MEMORY_SCOPE_AGENT); }
__device__ __forceinline__ unsigned xb_add(unsigned* p, unsigned v) { return __hip_atomic_fetch_add(p, v, __ATOMIC_RELAXED, __HIP_MEMORY_SCOPE_AGENT); }
__device__ __forceinline__ unsigned xb_xcc_id() { return (unsigned)__builtin_amdgcn_s_getreg((3 << 11) | 20) & 0xFu; }
#define XB_SPIN(cond, bar) do { unsigned _sp = 0; while (cond) { __builtin_amdgcn_s_sleep(1); \
    if ((++_sp & 255u) == 0u) { if (xb_ld(&(bar)[XB_TMO])) break; if (_sp > XB_SPIN_CAP) { atomicAdd(&(bar)[XB_TMO], 1u); break; } } } } while (0)

struct XcdBarrier {
    unsigned* bar; unsigned x;
    volatile LAS unsigned* st;
};

__device__ __forceinline__ XcdBarrier xcd_barrier_post(unsigned* bar, volatile LAS unsigned* st) {
    XcdBarrier b; b.bar = bar; b.x = xb_xcc_id(); b.st = st;
    if (threadIdx.x == 0) (void)xb_add(&bar[XB_XCNT(b.x)], 1u);
    return b;
}
__device__ __forceinline__ void xcd_barrier_complete(unsigned* bar, unsigned x, unsigned& nloc, unsigned& nx) {
    const unsigned G = gridDim.x * gridDim.y * gridDim.z;
    unsigned sum, cnt, mine, sp = 0u;
    for (;;) {
        sum = 0u; cnt = 0u; mine = 0u;
#pragma unroll
        for (unsigned j = 0; j < 16; ++j) { const unsigned c = xb_ld(&bar[XB_XCNT(j)]); sum += c; cnt += (c > 0u) ? 1u : 0u; mine = (j == x) ? c : mine; }
        if (sum == G) break;
        __builtin_amdgcn_s_sleep(1);
        if ((++sp & 255u) == 0u) { if (xb_ld(&bar[XB_TMO])) break; if (sp > XB_SPIN_CAP) { atomicAdd(&bar[XB_TMO], 1u); break; } }
    }
    nloc = mine > 0u ? mine : 1u; nx = cnt > 0u ? cnt : 1u;
}

__device__ __forceinline__ void xcd_barrier(const XcdBarrier& b) {
    asm volatile("s_waitcnt vmcnt(0)" ::: "memory");
    __syncthreads();
    if (threadIdx.x == 0) {
        unsigned* bar = b.bar;
        __builtin_amdgcn_s_waitcnt(0);
        unsigned nloc = b.st[0], nx = b.st[1];
        if (nloc == 0u) { xcd_barrier_complete(bar, b.x, nloc, nx); b.st[0] = nloc; b.st[1] = nx; }
        const unsigned old = xb_add(&bar[XB_XSUB(b.x)], 1u);
        const unsigned gen = old / nloc;
        if (old + 1u == (gen + 1u) * nloc) {
            __builtin_amdgcn_fence(__ATOMIC_RELEASE, "agent");
            asm volatile("s_waitcnt vmcnt(0)" ::: "memory");
            const unsigned og = xb_add(&bar[XB_TOP], 1u);
            const unsigned tg = og / nx;
            if (og + 1u == (tg + 1u) * nx) xb_add(&bar[XB_TOPGEN], 1u);
            else XB_SPIN(xb_ld(&bar[XB_TOPGEN]) == tg, bar);
            __builtin_amdgcn_fence(__ATOMIC_ACQUIRE, "agent");
            xb_add(&bar[XB_XGEN(b.x)], 1u);
            asm volatile("s_waitcnt vmcnt(0)" ::: "memory");
        } else {
            XB_SPIN(xb_ld(&bar[XB_XGEN(b.x)]) == gen, bar);
            __builtin_amdgcn_fence(__ATOMIC_ACQUIRE, "agent");
            asm volatile("s_waitcnt vmcnt(0)" ::: "memory");
        }
    }
    __syncthreads();
}


struct Args { const float* in[29]; const int* page_table; float* out; unsigned char* ws; int ph_lo, ph_hi; };
typedef const __attribute__((address_space(4))) Args& ARGREF;
struct Ctx { LAS unsigned char* lds; volatile LAS unsigned* MISC; gu32* ctl; int tid, lane, wave, vcu, G, qoff; };
typedef float f32x16 __attribute__((ext_vector_type(16)));
typedef unsigned long long u64;

__device__ __forceinline__ float bf2f(unsigned b) { return __builtin_bit_cast(float, b << 16); }
__device__ __forceinline__ float wave_sum(float v) {
#pragma unroll
    for (int o = 1; o < 64; o <<= 1) v += __shfl_xor(v, o);
    return v;
}
__device__ __forceinline__ int crow(int r, int hi) { return (r & 3) + 8 * (r >> 2) + 4 * hi; }
__device__ __forceinline__ float sigmoidf_(float x) { return 1.0f / (1.0f + __expf(-x)); }
__device__ __forceinline__ float* ssptr(const Ctx& c, int i) { return (float*)(c.ctl + CW_SS) + (size_t)i * MT; }

__device__ __forceinline__ int q_next(Ctx& c, int qi) {
    __syncthreads();
    if (c.tid == 0) c.MISC[16] = atomicAdd((unsigned*)(c.ctl + CW_Q + 64 * (qi + c.qoff)), 1u);
    __syncthreads();
    return (int)c.MISC[16];
}

template <int K>
__device__ __forceinline__ f32x16 mm32(const LAS bf16* A, int lda, const LAS bf16* Bt, int ldb, f32x16 acc, int lane) {
    const int r = lane & 31, h = lane >> 5;
#pragma unroll
    for (int ks = 0; ks < K; ks += 16) {
        const bf16x8 a = *(const LAS bf16x8*)(A + r * lda + ks + 8 * h);
        const bf16x8 b = *(const LAS bf16x8*)(Bt + r * ldb + ks + 8 * h);
        acc = __builtin_amdgcn_mfma_f32_32x32x16_bf16(a, b, acc, 0, 0, 0);
    }
    return acc;
}

__device__ __forceinline__ int map_row(int mapid, int n, int row_off) {
    if (mapid == 0) return n + row_off;
    if (mapid == 1) return n < 1864 ? n : n + 56;
    if (mapid == 2) return (n >> 7) * 256 + (n & 127);
    return (n >> 7) * 256 + 128 + (n & 127);
}
__device__ __forceinline__ void transpose_item(const float* W, int K, int N, const float* kscale, bf16* WT, int mapid, int row_off, LAS float* scr, int item, int lane) {
    const int nblk = (N + 31) / 32, kb = item / nblk, nb = item % nblk, k0 = 64 * kb, n0 = 32 * nb;
    { const int n4 = (lane & 7) * 4, nn = n0 + n4 < N ? n0 + n4 : N - 4; f32x4 v[8];
#pragma unroll
      for (int i = 0; i < 8; ++i) v[i] = *(const f32x4*)(W + (size_t)(k0 + 8 * i + (lane >> 3)) * N + nn);
#pragma unroll
      for (int i = 0; i < 8; ++i) { const int kk = 8 * i + (lane >> 3); const float sc = kscale ? kscale[k0 + kk] : 1.0f; LAS float* d = scr + kk * 33 + n4;
          d[0] = v[i].x * sc; d[1] = v[i].y * sc; d[2] = v[i].z * sc; d[3] = v[i].w * sc; } }
    LDS_WAIT(); asm volatile("" ::: "memory");
    const int cc = lane & 7;
#pragma unroll
    for (int j = 0; j < 4; ++j) { const int nl = (lane >> 3) + 8 * j, n = n0 + nl; const LAS float* s = scr + (8 * cc) * 33 + nl;
        v4u o; o.x = pk2(s[0 * 33], s[1 * 33]); o.y = pk2(s[2 * 33], s[3 * 33]); o.z = pk2(s[4 * 33], s[5 * 33]); o.w = pk2(s[6 * 33], s[7 * 33]);
        if (n < N) *(GAS v4u*)(WT + (size_t)map_row(mapid, n, row_off) * K + k0 + 8 * cc) = o; }
    LDS_WAIT(); asm volatile("" ::: "memory");
}
__device__ __forceinline__ void p0_prologue(Ctx& c, ARGREF a) {
    LAS float* scr = (LAS float*)(c.lds + RING_OFF + c.wave * 16384);
    const int gw = c.vcu * NWAVES + c.wave, NGW = c.G * NWAVES, lane = c.lane;
    unsigned char* ws = a.ws;
    constexpr int I_INH = 16 * 104, I_MKV = 16 * 16, I_DSA = 16 * 67, I_OUT = 16 * 32, I_G = 16 * 88, I_D = 44 * 32;
    constexpr int NITEMS = I_INH + 2 * I_MKV + I_DSA + 2 * I_OUT + 4 * I_G + 2 * I_D;
    for (int it = gw; it < NITEMS; it += NGW) {
        int r = it;
        if (r < I_INH) { transpose_item(a.in[13], 1024, 3328, a.in[11], (bf16*)(ws + WS_WIN0), 0, 0, scr, r, lane); continue; } r -= I_INH;
        if (r < I_MKV) { transpose_item(a.in[20], 1024, 512, nullptr, (bf16*)(ws + WS_WIN0), 0, 3328, scr, r, lane); continue; } r -= I_MKV;
        if (r < I_MKV) { transpose_item(a.in[20] + 1024 * 512, 1024, 512, nullptr, (bf16*)(ws + WS_WIN0), 0, 3840, scr, r, lane); continue; } r -= I_MKV;
        if (r < I_DSA) { transpose_item(a.in[16], 1024, 2120, a.in[11] + 1024, (bf16*)(ws + WS_WIN1), 1, 0, scr, r, lane); continue; } r -= I_DSA;
        if (r < 2 * I_OUT) { const int l = r / I_OUT; transpose_item(a.in[23] + (size_t)l * 1024 * 1024, 1024, 1024, nullptr, (bf16*)(ws + WS_WOUT) + (size_t)l * 1024 * 1024, 0, 0, scr, r % I_OUT, lane); continue; } r -= 2 * I_OUT;
        if (r < 2 * I_G) { const int l = r / I_G; transpose_item(a.in[24] + (size_t)l * 1024 * DFF, 1024, DFF, a.in[12] + l * 1024, (bf16*)(ws + WS_WGU) + (size_t)l * 5632 * 1024, 2, 0, scr, r % I_G, lane); continue; } r -= 2 * I_G;
        if (r < 2 * I_G) { const int l = r / I_G; transpose_item(a.in[25] + (size_t)l * 1024 * DFF, 1024, DFF, a.in[12] + l * 1024, (bf16*)(ws + WS_WGU) + (size_t)l * 5632 * 1024, 3, 0, scr, r % I_G, lane); continue; } r -= 2 * I_G;
        { const int l = r / I_D; transpose_item(a.in[28] + (size_t)l * DFF * 1024, DFF, 1024, nullptr, (bf16*)(ws + WS_WD) + (size_t)l * 1024 * DFF, 0, 0, scr, r % I_D, lane); }
    }
    for (int rr = gw; rr < 184; rr += NGW) { const int row = rr < 56 ? 1864 + rr : 2176 + (rr - 56);
        GAS v4u* p = (GAS v4u*)((bf16*)(ws + WS_WIN1) + (size_t)row * 1024); p[lane] = (v4u){0u, 0u, 0u, 0u}; p[64 + lane] = (v4u){0u, 0u, 0u, 0u}; }
    float* ss0 = ssptr(c, 0);
    for (int m = gw; m < MT + NMEMROWS; m += NGW) {
        GAS u64* o8 = (GAS u64*)((bf16*)(ws + WS_XB) + (size_t)m * DM) + lane;
        if (m >= MVALID && m < MT) {
#pragma unroll
            for (int j = 0; j < 4; ++j) o8[64 * j] = 0ull;
            continue; }
        const float* src = m < MP ? a.in[0] + (size_t)m * DM : (m < MVALID ? a.in[1] + (size_t)(m - MP) * DM : a.in[10] + (size_t)(m - MT) * DM);
        const GAS f32x4* xr = (const GAS f32x4*)src + lane; f32x4 v[4]; float s = 0.f;
#pragma unroll
        for (int j = 0; j < 4; ++j) { v[j] = xr[64 * j]; s += (v[j].x * v[j].x + v[j].y * v[j].y) + (v[j].z * v[j].z + v[j].w * v[j].w); }
        s = wave_sum(s);
#pragma unroll
        for (int j = 0; j < 4; ++j) o8[64 * j] = (u64)pk2(v[j].x, v[j].y) | ((u64)pk2(v[j].z, v[j].w) << 32);
        if (m < MVALID && lane == 0) ss0[m] = s;
    }
}

__device__ __forceinline__ void memattn_unit(Ctx& c, const bf16* Zq  , int ldz, int nrows_valid, const float* Kp, const float* Vp, int kstride,
                                             bool normk, const float* kgain, const float* qgain, bf16* Out  ) {
    LAS bf16* KN = (LAS bf16*)(c.lds);
    LAS bf16* VTm = (LAS bf16*)(c.lds + 36864);
    LAS bf16* QN = (LAS bf16*)(c.lds + 70656) + c.wave * (32 * 72);
    LAS float* LI = (LAS float*)(c.lds + 107520) + c.wave * 32;
    int tid = c.tid; asm volatile("" : "+v"(tid));
    const int lane = tid & 63, w = c.wave;
    {
        const int m = tid >> 1, dh = (tid & 1) * 32;
        f32x4 kv[8]; float s = 0.f;
#pragma unroll
        for (int j = 0; j < 8; ++j) { kv[j] = *(const f32x4*)(Kp + (size_t)m * kstride + dh + 4 * j); s += (kv[j].x * kv[j].x + kv[j].y * kv[j].y) + (kv[j].z * kv[j].z + kv[j].w * kv[j].w); }
        s += __shfl_xor(s, 1);
        const float rs = normk ? rsqrtf(s * (1.0f / 64.0f) + EPS) : 1.0f;
#pragma unroll
        for (int j = 0; j < 8; j += 2) { f32x4 g0 = {1.f, 1.f, 1.f, 1.f}, g1 = g0;
            if (normk) { g0 = *(const f32x4*)(kgain + dh + 4 * j); g1 = *(const f32x4*)(kgain + dh + 4 * j + 4); }
            const f32x4 x0 = kv[j] * rs * g0, x1 = kv[j + 1] * rs * g1;
            v4u o; o.x = pk2(x0.x, x0.y); o.y = pk2(x0.z, x0.w); o.z = pk2(x1.x, x1.y); o.w = pk2(x1.z, x1.w);
            *(LAS v4u*)(KN + m * 72 + dh + 4 * j) = o; }
#pragma unroll
        for (int j = 0; j < 8; ++j) { const f32x4 vv = *(const f32x4*)(Vp + (size_t)m * kstride + dh + 4 * j);
            VTm[(dh + 4 * j + 0) * 264 + m] = (bf16)f2bf(vv.x); VTm[(dh + 4 * j + 1) * 264 + m] = (bf16)f2bf(vv.y);
            VTm[(dh + 4 * j + 2) * 264 + m] = (bf16)f2bf(vv.z); VTm[(dh + 4 * j + 3) * 264 + m] = (bf16)f2bf(vv.w); }
    }
    {
        const int row = lane >> 1, hf = lane & 1, grow = w * 32 + row;
        float x[32]; float s = 0.f;
        if (grow < nrows_valid) {
#pragma unroll
            for (int j = 0; j < 4; ++j) { const v4u q = *(const v4u*)(Zq + (size_t)grow * ldz + hf * 32 + 8 * j);
                x[8 * j + 0] = bf2f(q.x & 0xffffu); x[8 * j + 1] = bf2f(q.x >> 16); x[8 * j + 2] = bf2f(q.y & 0xffffu); x[8 * j + 3] = bf2f(q.y >> 16);
                x[8 * j + 4] = bf2f(q.z & 0xffffu); x[8 * j + 5] = bf2f(q.z >> 16); x[8 * j + 6] = bf2f(q.w & 0xffffu); x[8 * j + 7] = bf2f(q.w >> 16); }
        } else {
#pragma unroll
            for (int j = 0; j < 32; ++j) x[j] = 0.f;
        }
#pragma unroll
        for (int j = 0; j < 32; ++j) s += x[j] * x[j];
        s += __shfl_xor(s, 1);
        const float rs = rsqrtf(s * (1.0f / 64.0f) + EPS) * 0.125f;
#pragma unroll
        for (int j = 0; j < 32; j += 8) { v4u o;
            o.x = pk2(x[j] * rs * qgain[hf * 32 + j], x[j + 1] * rs * qgain[hf * 32 + j + 1]); o.y = pk2(x[j + 2] * rs * qgain[hf * 32 + j + 2], x[j + 3] * rs * qgain[hf * 32 + j + 3]);
            o.z = pk2(x[j + 4] * rs * qgain[hf * 32 + j + 4], x[j + 5] * rs * qgain[hf * 32 + j + 5]); o.w = pk2(x[j + 6] * rs * qgain[hf * 32 + j + 6], x[j + 7] * rs * qgain[hf * 32 + j + 7]);
            *(LAS v4u*)(QN + row * 72 + hf * 32 + j) = o; }
    }
    __syncthreads();
    if (w * 32 < nrows_valid) {
        const int r32 = lane & 31, hh = lane >> 5;
        f32x16 s[8];
#pragma unroll
        for (int mt = 0; mt < 8; ++mt) { f32x16 z = {}; s[mt] = mm32<64>(KN + mt * 32 * 72, 72, QN, 72, z, lane); }
        float mx = -1e30f;
#pragma unroll
        for (int mt = 0; mt < 8; ++mt)
#pragma unroll
            for (int r = 0; r < 16; ++r) mx = fmaxf(mx, s[mt][r]);
        mx = fmaxf(mx, __shfl_xor(mx, 32));
        float l = 0.f;
#pragma unroll
        for (int mt = 0; mt < 8; ++mt)
#pragma unroll
            for (int r = 0; r < 16; ++r) { const float p = __expf(s[mt][r] - mx); s[mt][r] = p; l += p; }
        l += __shfl_xor(l, 32);
        if (hh == 0) LI[r32] = l;
        f32x16 o[2] = {};
#pragma unroll
        for (int mt = 0; mt < 8; ++mt)
#pragma unroll
            for (int sx = 0; sx < 2; ++sx) {
                v4u pa; pa.x = pk2(s[mt][8 * sx + 0], s[mt][8 * sx + 1]); pa.y = pk2(s[mt][8 * sx + 2], s[mt][8 * sx + 3]);
                pa.z = pk2(s[mt][8 * sx + 4], s[mt][8 * sx + 5]); pa.w = pk2(s[mt][8 * sx + 6], s[mt][8 * sx + 7]);
                const bf16x8 af = __builtin_bit_cast(bf16x8, pa);
#pragma unroll
                for (int dt = 0; dt < 2; ++dt) { const LAS bf16* vp = VTm + (dt * 32 + r32) * 264 + mt * 32 + 16 * sx + 4 * hh;
                    const u64 lo = *(const LAS u64*)vp, hi = *(const LAS u64*)(vp + 8);
                    v4u bw; bw.x = (unsigned)lo; bw.y = (unsigned)(lo >> 32); bw.z = (unsigned)hi; bw.w = (unsigned)(hi >> 32);
                    o[dt] = __builtin_amdgcn_mfma_f32_32x32x16_bf16(af, __builtin_bit_cast(bf16x8, bw), o[dt], 0, 0, 0); }
            }
        LDS_WAIT();
#pragma unroll
        for (int r = 0; r < 16; ++r) { const int qr = crow(r, hh), grow = w * 32 + qr; const float il = 1.0f / LI[qr];
            if (grow < nrows_valid) {
#pragma unroll
                for (int dt = 0; dt < 2; ++dt) Out[(size_t)grow * DM + dt * 32 + r32] = (bf16)f2bf(o[dt][r] * il); } }
    }
}

constexpr int HG_GS = 4, HG_NG = SEQ / (32 * HG_GS);
constexpr size_t WS_HOL = WS_U, WS_HQC = WS_UP, WS_HUT = WS_ACT, WS_HST = WS_ACT + 64 * MiB, WS_HDG = WS_ACT + 50 * MiB;
template <bool PROMPT>
__device__ __forceinline__ void hgrn_unit(Ctx& c, ARGREF a, int b, int h, int g) {
    LAS unsigned char* L = c.lds;
    LAS float* LF = (LAS float*)(L + 0);
    LAS float* BL = (LAS float*)(L + 16384);
    LAS float* DVv = (LAS float*)(L + 16896);
    LAS bf16* QD = (LAS bf16*)(L + 17408);
    LAS bf16* KD = (LAS bf16*)(L + 26112);
    LAS bf16* KET = (LAS bf16*)(L + 34816);
    LAS bf16* VT = (LAS bf16*)(L + 45056);
    LAS bf16* SCB = (LAS bf16*)(L + 55296);
    LAS bf16* STt = (LAS bf16*)(L + 57856);
    LAS float* BOFF = (LAS float*)(L + 92672);
    int tid = c.tid; asm volatile("" : "+v"(tid));
    const int lane = tid & 63, w = c.wave, r32 = lane & 31, hh = lane >> 5;
    const int te = tid >> 4, k8 = (tid & 15) * 8;
    const bf16* Z = (const bf16*)(a.ws + WS_Z);
    bf16* MIX = (bf16*)(a.ws + WS_MIX);
    const int nch = PROMPT ? HG_GS : 1, nvalid = PROMPT ? 32 : 4;
    const int kt = w >> 1, vt0 = 2 * (w & 1);
    const int unit = (b * 6 + h) * HG_NG + g;
    f32x16 S0 = {}, S1 = {};
    if (!PROMPT) { const float* sp = a.in[7] + (size_t)(b * 6 + h) * 16384;
#pragma unroll
        for (int r = 0; r < 16; ++r) { const int k = 32 * kt + crow(r, hh); S0[r] = sp[k * 128 + 32 * vt0 + r32]; S1[r] = sp[k * 128 + 32 * (vt0 + 1) + r32]; } }
    float lbv[8], onv[8];
#pragma unroll
    for (int j = 0; j < 8; ++j) { const float l0 = a.in[14][h * 128 + k8 + j], l1 = a.in[14][768 + h * 128 + k8 + j]; lbv[j] = 1.0f / (1.0f + __expf(l1 - l0)); onv[j] = a.in[15][k8 + j]; }
    __syncthreads();
    if (tid < 128) BOFF[tid] = 0.f;
#define HG_WRITE_ST() do { _Pragma("unroll") for (int g4 = 0; g4 < 4; ++g4) { const int k0 = 32 * kt + 8 * g4 + 4 * hh; \
        *(LAS u64*)(STt + (32 * vt0 + r32) * 136 + k0) = (u64)pk2(S0[4 * g4], S0[4 * g4 + 1]) | ((u64)pk2(S0[4 * g4 + 2], S0[4 * g4 + 3]) << 32); \
        *(LAS u64*)(STt + (32 * (vt0 + 1) + r32) * 136 + k0) = (u64)pk2(S1[4 * g4], S1[4 * g4 + 1]) | ((u64)pk2(S1[4 * g4 + 2], S1[4 * g4 + 3]) << 32); } } while (0)
    HG_WRITE_ST();
#pragma unroll 1
    for (int ch = 0; ch < nch; ++ch) {
        const int row0 = PROMPT ? b * SEQ + (g * HG_GS + ch) * 32 : MP + 4 * b, row = row0 + te;
        const bool valid = te < nvalid;
        float qs[8], kk[8]; v4u gz = {0u, 0u, 0u, 0u};
        {
            v4u zq = {0u, 0u, 0u, 0u}, zf = zq, zi = zq;
            if (valid) { const bf16* zr = Z + (size_t)row * ZC0 + h * 128 + k8;
                zq = *(const v4u*)zr; zf = *(const v4u*)(zr + 768); zi = *(const v4u*)(zr + 1536); if (!PROMPT) gz = *(const v4u*)(zr + 2304); }
            const unsigned qw[4] = {zq.x, zq.y, zq.z, zq.w}, fw[4] = {zf.x, zf.y, zf.z, zf.w}, iw[4] = {zi.x, zi.y, zi.z, zi.w};
            float lf[8];
#pragma unroll
            for (int j = 0; j < 8; ++j) { const float q = bf2f((qw[j >> 1] >> (16 * (j & 1))) & 0xffffu), fp = bf2f((fw[j >> 1] >> (16 * (j & 1))) & 0xffffu);
                const float sg = sigmoidf_(fp), f = lbv[j] + (1.0f - lbv[j]) * sg;
                qs[j] = valid ? q * sigmoidf_(q) : 0.f; kk[j] = valid ? (1.0f - f) : 0.f; lf[j] = valid ? __logf(f) : 0.f;
                VT[(k8 + j) * 40 + te] = (bf16)((iw[j >> 1] >> (16 * (j & 1))) & 0xffffu); }
            *(LAS f32x4*)(LF + te * 128 + k8) = (f32x4){lf[0], lf[1], lf[2], lf[3]}; *(LAS f32x4*)(LF + te * 128 + k8 + 4) = (f32x4){lf[4], lf[5], lf[6], lf[7]};
        }
        __syncthreads();
        if (tid < 128) { float bsum = 0.f;
#pragma unroll
            for (int t = 0; t < 32; ++t) { bsum += LF[t * 128 + tid]; LF[t * 128 + tid] = bsum; }
            BL[tid] = bsum; }
        __syncthreads();
        {
            const f32x4 b0 = *(const LAS f32x4*)(LF + te * 128 + k8), b1 = *(const LAS f32x4*)(LF + te * 128 + k8 + 4);
            const f32x4 l0 = *(const LAS f32x4*)(BL + k8), l1 = *(const LAS f32x4*)(BL + k8 + 4);
            const float bb[8] = {b0.x, b0.y, b0.z, b0.w, b1.x, b1.y, b1.z, b1.w}, bl[8] = {l0.x, l0.y, l0.z, l0.w, l1.x, l1.y, l1.z, l1.w};
            float qd[8], kd[8];
#pragma unroll
            for (int j = 0; j < 8; ++j) { qd[j] = qs[j] * __expf(bb[j]); kd[j] = kk[j] * __expf(-bb[j]); KET[(k8 + j) * 40 + te] = (bf16)f2bf(kk[j] * __expf(bl[j] - bb[j])); }
            v4u o; o.x = pk2(qd[0], qd[1]); o.y = pk2(qd[2], qd[3]); o.z = pk2(qd[4], qd[5]); o.w = pk2(qd[6], qd[7]); *(LAS v4u*)(QD + te * 136 + k8) = o;
            if (PROMPT) { const f32x4 f0 = *(const LAS f32x4*)(BOFF + k8), f1 = *(const LAS f32x4*)(BOFF + k8 + 4);
                const float bo[8] = {f0.x, f0.y, f0.z, f0.w, f1.x, f1.y, f1.z, f1.w}; float qc[8];
#pragma unroll
                for (int j = 0; j < 8; ++j) qc[j] = qd[j] * __expf(bo[j]);
                v4u oc; oc.x = pk2(qc[0], qc[1]); oc.y = pk2(qc[2], qc[3]); oc.z = pk2(qc[4], qc[5]); oc.w = pk2(qc[6], qc[7]);
                *(v4u*)((bf16*)(a.ws + WS_HQC) + (size_t)row * 768 + h * 128 + k8) = oc; }
            o.x = pk2(kd[0], kd[1]); o.y = pk2(kd[2], kd[3]); o.z = pk2(kd[4], kd[5]); o.w = pk2(kd[6], kd[7]); *(LAS v4u*)(KD + te * 136 + k8) = o;
            if (te == 0) {
#pragma unroll
                for (int j = 0; j < 8; ++j) DVv[k8 + j] = __expf(bl[j]); }
        }
        __syncthreads();
        f32x16 oacc = {};
        if (w == 0) { f32x16 z = {}; const f32x16 sc = mm32<128>(QD, 136, KD, 136, z, lane);
#pragma unroll
            for (int r = 0; r < 16; ++r) { const int t = crow(r, hh); SCB[t * 40 + r32] = (bf16)f2bf(r32 <= t ? sc[r] : 0.f); } }
        if (w < 4) oacc = mm32<128>(QD, 136, STt + (w * 32) * 136, 136, oacc, lane);
        if (PROMPT && tid >= 384) BOFF[tid - 384] += BL[tid - 384];
        __syncthreads();
        if (w < 4) { oacc = mm32<32>(SCB, 40, VT + (w * 32) * 40, 40, oacc, lane);
#pragma unroll
            for (int r = 0; r < 16; ++r) LF[crow(r, hh) * 128 + w * 32 + r32] = oacc[r]; }
        {
#pragma unroll
            for (int r = 0; r < 16; ++r) { const float d = DVv[32 * kt + crow(r, hh)]; S0[r] *= d; S1[r] *= d; }
            S0 = mm32<32>(KET + (kt * 32) * 40, 40, VT + (vt0 * 32) * 40, 40, S0, lane);
            S1 = mm32<32>(KET + (kt * 32) * 40, 40, VT + ((vt0 + 1) * 32) * 40, 40, S1, lane);
        }
        __syncthreads();
        HG_WRITE_ST();
        {
            const f32x4 o0 = *(const LAS f32x4*)(LF + te * 128 + k8), o1 = *(const LAS f32x4*)(LF + te * 128 + k8 + 4);
            if (PROMPT) { float* ol = (float*)(a.ws + WS_HOL) + (size_t)row * 768 + h * 128 + k8; *(f32x4*)ol = o0; *(f32x4*)(ol + 4) = o1; }
            else {
                float ov[8] = {o0.x, o0.y, o0.z, o0.w, o1.x, o1.y, o1.z, o1.w}; float s = 0.f;
#pragma unroll
                for (int j = 0; j < 8; ++j) s += ov[j] * ov[j];
                s += __shfl_xor(s, 1); s += __shfl_xor(s, 2); s += __shfl_xor(s, 4); s += __shfl_xor(s, 8);
                const float rs = rsqrtf(s * (1.0f / 128.0f) + EPS);
                const unsigned gw_[4] = {gz.x, gz.y, gz.z, gz.w}; float y[8];
#pragma unroll
                for (int j = 0; j < 8; ++j) { const float gg = bf2f((gw_[j >> 1] >> (16 * (j & 1))) & 0xffffu); y[j] = ov[j] * rs * onv[j] * (gg * sigmoidf_(gg)); }
                if (valid) { v4u o; o.x = pk2(y[0], y[1]); o.y = pk2(y[2], y[3]); o.z = pk2(y[4], y[5]); o.w = pk2(y[6], y[7]); *(v4u*)(MIX + (size_t)row * DM + h * 128 + k8) = o; }
            }
        }
        __syncthreads();
    }
#undef HG_WRITE_ST
    if (PROMPT) {
        float* ut = (float*)(a.ws + WS_HUT) + (size_t)unit * 16384;
#pragma unroll
        for (int g4 = 0; g4 < 4; ++g4) { const int k0 = 32 * kt + 8 * g4 + 4 * hh;
            *(f32x4*)(ut + (32 * vt0 + r32) * 128 + k0) = (f32x4){S0[4 * g4], S0[4 * g4 + 1], S0[4 * g4 + 2], S0[4 * g4 + 3]};
            *(f32x4*)(ut + (32 * (vt0 + 1) + r32) * 128 + k0) = (f32x4){S1[4 * g4], S1[4 * g4 + 1], S1[4 * g4 + 2], S1[4 * g4 + 3]}; }
        if (tid < 128) ((float*)(a.ws + WS_HDG))[(size_t)unit * 128 + tid] = __expf(BOFF[tid]);
    } else {
        float* so = a.out + O_HS + (size_t)(b * 6 + h) * 16384;
#pragma unroll
        for (int r = 0; r < 16; ++r) { const int k = 32 * kt + crow(r, hh); so[k * 128 + 32 * vt0 + r32] = S0[r]; so[k * 128 + 32 * (vt0 + 1) + r32] = S1[r]; }
    }
}
__device__ __forceinline__ void hgrn_scan(Ctx& c, ARGREF a) {
    const float* UT = (const float*)(a.ws + WS_HUT); const float* DG = (const float*)(a.ws + WS_HDG); bf16* STo = (bf16*)(a.ws + WS_HST);
    for (int idx = c.vcu * 512 + c.tid; idx < 24 * 16384; idx += c.G * 512) {
        const int bh = idx >> 14, e = idx & 16383, k = e & 127, v = e >> 7;
        float s = 0.f;
#pragma unroll 8
        for (int g = 0; g < HG_NG; ++g) { const size_t u = (size_t)(bh * HG_NG + g); STo[u * 16384 + e] = (bf16)f2bf(s); s = DG[u * 128 + k] * s + UT[u * 16384 + e]; }
        a.out[O_HP + (size_t)bh * 16384 + k * 128 + v] = s;
    }
}
__device__ __forceinline__ void hgrn_fix_unit(Ctx& c, ARGREF a, int b, int h, int g) {
    LAS bf16* STt = (LAS bf16*)(c.lds);
    LAS bf16* QCl = (LAS bf16*)(c.lds + 34816);
    LAS float* OB = (LAS float*)(c.lds + 34816 + 17408);
    int tid = c.tid; asm volatile("" : "+v"(tid));
    const int lane = tid & 63, w = c.wave, r32 = lane & 31, hh = lane >> 5;
    const int unit = (b * 6 + h) * HG_NG + g, row0 = b * SEQ + g * 128;
    const bf16* Z = (const bf16*)(a.ws + WS_Z); bf16* MIX = (bf16*)(a.ws + WS_MIX);
    const bf16* QC = (const bf16*)(a.ws + WS_HQC); const float* OL = (const float*)(a.ws + WS_HOL);
    const bf16* stg = (const bf16*)(a.ws + WS_HST) + (size_t)unit * 16384;
    __syncthreads();
#pragma unroll
    for (int i = 0; i < 4; ++i) { const int cidx = tid + 512 * i, v = cidx >> 4, kc = (cidx & 15) * 8; *(LAS v4u*)(STt + v * 136 + kc) = *(const v4u*)(stg + v * 128 + kc); }
    const int te = tid >> 4, k8 = (tid & 15) * 8;
    float onv[8];
#pragma unroll
    for (int j = 0; j < 8; ++j) onv[j] = a.in[15][k8 + j];
#pragma unroll 1
    for (int hf = 0; hf < 2; ++hf) {
        const int rb = row0 + hf * 64;
#pragma unroll
        for (int i = 0; i < 2; ++i) { const int cidx = tid + 512 * i, r = cidx >> 4, kc = (cidx & 15) * 8; *(LAS v4u*)(QCl + r * 136 + kc) = *(const v4u*)(QC + (size_t)(rb + r) * 768 + h * 128 + kc); }
        __syncthreads();
        { const int rt = w >> 2, vt = w & 3; f32x16 o = {};
          o = mm32<128>(QCl + (rt * 32) * 136, 136, STt + (vt * 32) * 136, 136, o, lane);
#pragma unroll
          for (int r = 0; r < 16; ++r) OB[(rt * 32 + crow(r, hh)) * 128 + vt * 32 + r32] = o[r]; }
        __syncthreads();
#pragma unroll
        for (int ps = 0; ps < 2; ++ps) { const int r = ps * 32 + te, row = rb + r;
            const f32x4 c0 = *(const LAS f32x4*)(OB + r * 128 + k8), c1 = *(const LAS f32x4*)(OB + r * 128 + k8 + 4);
            const float* ol = OL + (size_t)row * 768 + h * 128 + k8; const f32x4 l0 = *(const f32x4*)ol, l1 = *(const f32x4*)(ol + 4);
            const v4u gz = *(const v4u*)(Z + (size_t)row * ZC0 + 2304 + h * 128 + k8);
            float ov[8] = {c0.x + l0.x, c0.y + l0.y, c0.z + l0.z, c0.w + l0.w, c1.x + l1.x, c1.y + l1.y, c1.z + l1.z, c1.w + l1.w}; float s = 0.f;
#pragma unroll
            for (int j = 0; j < 8; ++j) s += ov[j] * ov[j];
            s += __shfl_xor(s, 1); s += __shfl_xor(s, 2); s += __shfl_xor(s, 4); s += __shfl_xor(s, 8);
            const float rs = rsqrtf(s * (1.0f / 128.0f) + EPS);
            const unsigned gw_[4] = {gz.x, gz.y, gz.z, gz.w}; float y[8];
#pragma unroll
            for (int j = 0; j < 8; ++j) { const float gg = bf2f((gw_[j >> 1] >> (16 * (j & 1))) & 0xffffu); y[j] = ov[j] * rs * onv[j] * (gg * sigmoidf_(gg)); }
            v4u o; o.x = pk2(y[0], y[1]); o.y = pk2(y[2], y[3]); o.z = pk2(y[4], y[5]); o.w = pk2(y[6], y[7]); *(v4u*)(MIX + (size_t)row * DM + h * 128 + k8) = o; }
        __syncthreads();
    }
}

__device__ __forceinline__ void memkv_finalize_row(ARGREF a, int layer, int row, int lane) {
    const float* src = (const float*)(a.ws + WS_MEMKV) + (size_t)row * 1024 + layer * 512;
    const int hd = lane >> 4, d4 = (lane & 15) * 4;
    const f32x4 k = *(const f32x4*)(src + hd * 64 + d4), v = *(const f32x4*)(src + 256 + hd * 64 + d4);
    float s = (k.x * k.x + k.y * k.y) + (k.z * k.z + k.w * k.w);
    s += __shfl_xor(s, 1); s += __shfl_xor(s, 2); s += __shfl_xor(s, 4); s += __shfl_xor(s, 8);
    const float rs = rsqrtf(s * (1.0f / 64.0f) + EPS); const f32x4 g = *(const f32x4*)(a.in[22] + layer * 64 + d4);
    *(f32x4*)(a.out + O_MK + ((size_t)layer * 1024 + row) * 256 + hd * 64 + d4) = k * rs * g;
    *(f32x4*)(a.out + O_MV + ((size_t)layer * 1024 + row) * 256 + hd * 64 + d4) = v;
}

__device__ __forceinline__ void memattn_prompt_unit(Ctx& c, ARGREF a, int layer, int u) {
    const int blk = u & 15, hd = (u >> 4) & 3, b = u >> 6;
    const bf16* Z = (const bf16*)(a.ws + WS_Z); const int ldz = layer ? ZC1 : ZC0, qc = layer ? Z1_MQ : 3072;
    const float* kv = (const float*)(a.ws + WS_MEMKV) + (size_t)(b * 256) * 1024 + layer * 512 + hd * 64;
    const int row0 = b * SEQ + blk * 256;
    memattn_unit(c, Z + (size_t)row0 * ldz + qc + hd * 64, ldz, 256, kv, kv + 256, 1024, true, a.in[22] + layer * 64, a.in[21] + layer * 64,
                 (bf16*)(a.ws + WS_MIX) + (size_t)row0 * DM + 768 + hd * 64);
}
__device__ __forceinline__ void memattn_sample_unit(Ctx& c, ARGREF a, int layer, int u) {
    const int hd = u & 3, sb = u >> 2;
    const bf16* Z = (const bf16*)(a.ws + WS_Z); const int ldz = layer ? ZC1 : ZC0, qc = layer ? Z1_MQ : 3072;
    const size_t off = ((size_t)(layer * 32 + sb) * 256) * 256 + hd * 64;
    const int row0 = MP + sb * 4;
    memattn_unit(c, Z + (size_t)row0 * ldz + qc + hd * 64, ldz, 4, a.in[5] + off, a.in[6] + off, 256, false, nullptr, a.in[21] + layer * 64,
                 (bf16*)(a.ws + WS_MIX) + (size_t)row0 * DM + 768 + hd * 64);
}

__device__ __forceinline__ void p2_mixer0(Ctx& c, ARGREF a) {
    constexpr int U_HP = 24 * HG_NG, U_MAP = U_HP + 256, U_HS = U_MAP + 192, U_MAS = U_HS + 128, U_FIN = U_MAS + 256;
    for (;;) {
        const int u = q_next(c, 0);
        if (u >= U_FIN) break;
        if (u < U_HP) hgrn_unit<true>(c, a, u / (6 * HG_NG), (u / HG_NG) % 6, u % HG_NG);
        else if (u < U_MAP) memattn_prompt_unit(c, a, 0, u - U_HP);
        else if (u < U_HS) { const int v = u - U_MAP; hgrn_unit<false>(c, a, v / 6, v % 6, 0); }
        else if (u < U_MAS) memattn_sample_unit(c, a, 0, u - U_HS);
        else { const int v = (u - U_MAS) * 8 + c.wave; memkv_finalize_row(a, v >> 10, v & 1023, c.lane); }
    }
}
__device__ __forceinline__ void p2c_hgrn_fix(Ctx& c, ARGREF a) {
    for (int u = c.vcu; u < 24 * HG_NG; u += c.G) hgrn_fix_unit(c, a, u / (6 * HG_NG), (u / HG_NG) % 6, u % HG_NG);
}

constexpr size_t WS_G4 = WS_UP + 64 * MiB, WS_UP2 = WS_UP + 80 * MiB;
__device__ __forceinline__ void conv_fixup_tile(Ctx& c, ARGREF a, int layer, int pm) {
    const float* G4 = (const float*)(a.ws + WS_G4); const float* UP2 = (const float*)(a.ws + WS_UP2); bf16* ACT = (bf16*)(a.ws + WS_ACT);
    const float* cw = a.in[26] + (size_t)layer * 3 * DFF; const float* cb = a.in[27] + (size_t)layer * DFF;
    for (int idx = c.tid; idx < 8 * (DFF / 4); idx += 512) {
        const int rr = idx / (DFF / 4), c4 = (idx - rr * (DFF / 4)) * 4;
        const int slab = 4 * pm + (rr >> 1), fr = rr & 1, row = slab * 64 + fr, t = row & 4095, sl1 = slab > 0 ? slab - 1 : 0;
        const f32x4 ut = *(const f32x4*)(G4 + (size_t)(slab * 4 + fr) * DFF + c4), up = *(const f32x4*)(UP2 + (size_t)(slab * 2 + fr) * DFF + c4);
        const f32x4 a0 = *(const f32x4*)(G4 + (size_t)(slab * 4 + 0) * DFF + c4), b3 = *(const f32x4*)(G4 + (size_t)(sl1 * 4 + 3) * DFF + c4), b2 = *(const f32x4*)(G4 + (size_t)(sl1 * 4 + 2) * DFF + c4);
        f32x4 u1, u2;
        { const bool f1 = fr == 1, t0 = t == 0, t1 = t == 1;
          u1.x = f1 ? a0.x : (t0 ? 0.f : b3.x); u1.y = f1 ? a0.y : (t0 ? 0.f : b3.y); u1.z = f1 ? a0.z : (t0 ? 0.f : b3.z); u1.w = f1 ? a0.w : (t0 ? 0.f : b3.w);
          u2.x = f1 ? (t1 ? 0.f : b3.x) : (t0 ? 0.f : b2.x); u2.y = f1 ? (t1 ? 0.f : b3.y) : (t0 ? 0.f : b2.y); u2.z = f1 ? (t1 ? 0.f : b3.z) : (t0 ? 0.f : b2.z); u2.w = f1 ? (t1 ? 0.f : b3.w) : (t0 ? 0.f : b2.w); }
        const f32x4 w0 = *(const f32x4*)(cw + c4), w1 = *(const f32x4*)(cw + DFF + c4), w2 = *(const f32x4*)(cw + 2 * DFF + c4), bb = *(const f32x4*)(cb + c4);
        const f32x4 cv = bb + w0 * u2 + w1 * u1 + w2 * ut;
        const float y0 = cv.x * sigmoidf_(cv.x) * up.x, y1 = cv.y * sigmoidf_(cv.y) * up.y, y2 = cv.z * sigmoidf_(cv.z) * up.z, y3 = cv.w * sigmoidf_(cv.w) * up.w;
        *(u64*)(ACT + (size_t)row * DFF + c4) = (u64)pk2(y0, y1) | ((u64)pk2(y2, y3) << 32);
    }
}


struct SgArgs { const bf16* A; const bf16* Bt; int K; int mode; bf16* Z; int ldz; const float* ssin; const float* resid; const bf16* rb; float* y; bf16* xb; float* ssout; bf16* ACT; float* cvs; const float* cst; const float* cw; const float* cb; };
__device__ __forceinline__ void sgemm_unit(Ctx& c, const SgArgs& g, int n0) {
    int tid = c.tid; asm volatile("" : "+v"(tid));
    const int lane = tid & 63, w = c.wave, r32 = lane & 31, hh = lane >> 5;
    const int K = g.K, ks = K >> 3;
    const int f2 = (n0 >> 1) + (r32 & 15), brow = g.mode == 2 ? (f2 >> 7) * 256 + (f2 & 127) + (r32 >= 16 ? 128 : 0) : n0 + r32;
    const bf16* bp = g.Bt + (size_t)brow * K + w * ks + 8 * hh;
    const bf16* ap = g.A + (size_t)r32 * K + w * ks + 8 * hh;
    f32x16 acc[4] = {};
    bf16x8 afA[4][2], bfA[2], afB[4][2], bfB[2];
#define SG_LOAD(AF, BF, kk) do { _Pragma("unroll") for (int i = 0; i < 2; ++i) { BF[i] = *(const bf16x8*)(bp + (kk) + 16 * i); \
        _Pragma("unroll") for (int rt = 0; rt < 4; ++rt) AF[rt][i] = *(const bf16x8*)(ap + (size_t)(rt * 32) * K + (kk) + 16 * i); } } while (0)
#define SG_MMA(AF, BF) do { _Pragma("unroll") for (int i = 0; i < 2; ++i) _Pragma("unroll") for (int rt = 0; rt < 4; ++rt) acc[rt] = __builtin_amdgcn_mfma_f32_32x32x16_bf16(AF[rt][i], BF[i], acc[rt], 0, 0, 0); } while (0)
    SG_LOAD(afA, bfA, 0);
#pragma unroll 1
    for (int k = 0; k < ks; k += 64) {
        if (k + 32 < ks) SG_LOAD(afB, bfB, k + 32);
        SG_MMA(afA, bfA);
        if (k + 32 < ks) { if (k + 64 < ks) SG_LOAD(afA, bfA, k + 64); SG_MMA(afB, bfB); }
    }
#undef SG_LOAD
#undef SG_MMA
    LAS float* RED = (LAS float*)(c.lds);
    __syncthreads();
#pragma unroll
    for (int rt = 0; rt < 4; ++rt)
#pragma unroll
        for (int r = 0; r < 16; ++r) RED[((w * 4 + rt) * 16 + r) * 64 + lane] = acc[rt][r];
    __syncthreads();
    const int rt = w & 3, rh = w >> 2, col = n0 + r32;
    float v[8];
#pragma unroll
    for (int i = 0; i < 8; ++i) { float s = 0.f;
#pragma unroll
        for (int ww = 0; ww < 8; ++ww) s += RED[((ww * 4 + rt) * 16 + 8 * rh + i) * 64 + lane];
        v[i] = s; }
    if (g.mode == 0) {
#pragma unroll
        for (int i = 0; i < 8; ++i) { const int row = MP + rt * 32 + crow(8 * rh + i, hh); const float rs = rsqrtf(g.ssin[row] * (1.0f / DM) + EPS); g.Z[(size_t)row * g.ldz + col] = (bf16)f2bf(v[i] * rs); }
    } else if (g.mode == 1) {
#pragma unroll
        for (int i = 0; i < 8; ++i) { const int lr = rt * 32 + crow(8 * rh + i, hh), row = MP + lr;
            const float x = v[i] + (g.resid ? g.resid[(size_t)lr * DM + col] : bf2f(g.rb[(size_t)row * DM + col]));
            if (g.y) g.y[(size_t)lr * DM + col] = x; if (g.xb) g.xb[(size_t)row * DM + col] = (bf16)f2bf(x);
            float s = x * x; s += __shfl_xor(s, 1); s += __shfl_xor(s, 2); s += __shfl_xor(s, 4); s += __shfl_xor(s, 8); s += __shfl_xor(s, 16);
            if (g.ssout && r32 == 0) atomicAdd(g.ssout + row, s); }
    } else {
        float gu[8], upv[8];
#pragma unroll
        for (int i = 0; i < 8; ++i) { const int row = MP + rt * 32 + crow(8 * rh + i, hh); gu[i] = v[i] * rsqrtf(g.ssin[row] * (1.0f / DM) + EPS); upv[i] = __shfl_xor(gu[i], 16); }
        if (r32 < 16) { const float w0 = g.cw[f2], w1 = g.cw[DFF + f2], w2 = g.cw[2 * DFF + f2], bb = g.cb[f2];
#pragma unroll
            for (int aa = 0; aa < 2; ++aa) { const int lr0 = rt * 32 + 8 * (2 * rh + aa) + 4 * hh, sb = lr0 >> 2;
                const float s0 = g.cst[(size_t)(sb * 2) * DFF + f2], s1 = g.cst[(size_t)(sb * 2 + 1) * DFF + f2];
                const float u0 = gu[4 * aa], u1 = gu[4 * aa + 1], u2 = gu[4 * aa + 2], u3 = gu[4 * aa + 3];
                const float cv[4] = {bb + w0 * s0 + w1 * s1 + w2 * u0, bb + w0 * s1 + w1 * u0 + w2 * u1, bb + w0 * u0 + w1 * u1 + w2 * u2, bb + w0 * u1 + w1 * u2 + w2 * u3};
#pragma unroll
                for (int t = 0; t < 4; ++t) g.ACT[(size_t)(MP + lr0 + t) * DFF + f2] = (bf16)f2bf(cv[t] * sigmoidf_(cv[t]) * upv[4 * aa + t]);
                g.cvs[(size_t)(sb * 2) * DFF + f2] = u2; g.cvs[(size_t)(sb * 2 + 1) * DFF + f2] = u3; } }
    }
}
__device__ __forceinline__ void sgemm_phase(Ctx& c, const SgArgs& g, int N) {
#pragma unroll 1
    for (int u = c.G - 1 - (int)blockIdx.x; u < N / 32; u += c.G) sgemm_unit(c, g, u * 32);
}


__device__ __forceinline__ float wave_sum_f(float x) {
    x += __builtin_bit_cast(float, __builtin_amdgcn_update_dpp(0, __builtin_bit_cast(int, x), 0xB1, 0xF, 0xF, false));
    x += __builtin_bit_cast(float, __builtin_amdgcn_update_dpp(0, __builtin_bit_cast(int, x), 0x4E, 0xF, 0xF, false));
    x += __builtin_bit_cast(float, __builtin_amdgcn_update_dpp(0, __builtin_bit_cast(int, x), 0x141, 0xF, 0xF, false));
    x += __builtin_bit_cast(float, __builtin_amdgcn_update_dpp(0, __builtin_bit_cast(int, x), 0x140, 0xF, 0xF, false));
    const int xi = __builtin_bit_cast(int, x);
    return (__builtin_bit_cast(float, __builtin_amdgcn_readlane(xi, 0)) + __builtin_bit_cast(float, __builtin_amdgcn_readlane(xi, 16))) +
           (__builtin_bit_cast(float, __builtin_amdgcn_readlane(xi, 32)) + __builtin_bit_cast(float, __builtin_amdgcn_readlane(xi, 48)));
}
__device__ __forceinline__ void dsa_post_row(ARGREF a, int row, int lane_) {
    int lane = lane_; asm volatile("" : "+v"(lane));
    const bf16* z = (const bf16*)(a.ws + WS_Z) + (size_t)row * ZC1;
    const bool smp = row >= MP; const int b = smp ? (row - MP) >> 2 : row >> 12, t = smp ? (row - MP) & 3 : row & 4095;
    const float pos = (float)(smp ? PAST + t : t);
    const int i = lane & 31;
    float x1[8], x2[8], q1[4], q2[4], k1 = 0.f, k2 = 0.f;
#pragma unroll
    for (int hd = 0; hd < 8; ++hd) { x1[hd] = bf2f(z[hd * 128 + lane]); x2[hd] = bf2f(z[hd * 128 + 64 + lane]); }
    const u64 vv = *(const u64*)(z + Z1_V + 4 * lane);
#pragma unroll
    for (int p = 0; p < 4; ++p) { const int hd = 2 * p + (lane >> 5); q1[p] = bf2f(z[Z1_IQ + hd * 64 + i]); q2[p] = bf2f(z[Z1_IQ + hd * 64 + 32 + i]); }
    if (lane < 32) { k1 = bf2f(z[Z1_IK + i]); k2 = bf2f(z[Z1_IK + 32 + i]); }
    const float wraw = bf2f(z[Z1_IW + (lane & 7)]);
    float c128, s128, c64, s64;
    { const float r1 = pos * (exp2f(-(float)lane * (13.287712379549449f / 64.0f)) * 0.15915494309189535f), f1 = r1 - floorf(r1); s128 = __builtin_amdgcn_sinf(f1); c128 = __builtin_amdgcn_cosf(f1);
      const float r2 = pos * (exp2f(-(float)i * (13.287712379549449f / 32.0f)) * 0.15915494309189535f), f2 = r2 - floorf(r2); s64 = __builtin_amdgcn_sinf(f2); c64 = __builtin_amdgcn_cosf(f2); }
#pragma unroll
    for (int hd = 0; hd < 8; ++hd) {
        const float rs = rsqrtf(wave_sum_f(x1[hd] * x1[hd] + x2[hd] * x2[hd]) * (1.0f / 128.0f) + EPS);
        const float* gn = hd < 6 ? a.in[17] : a.in[18];
        const float y1 = x1[hd] * rs * gn[lane], y2 = x2[hd] * rs * gn[64 + lane];
        const float o1 = y1 * c128 - y2 * s128, o2 = y2 * c128 + y1 * s128;
        if (hd < 6) {
            if (smp) { float* q = (float*)(a.ws + WS_SQ) + (size_t)(row - MP) * 768 + hd * 128; q[lane] = o1; q[64 + lane] = o2; }
            else { bf16* q = (bf16*)(a.ws + WS_QB) + ((size_t)(b * 6 + hd) * SEQ + t) * 128; q[lane] = (bf16)f2bf(o1); q[64 + lane] = (bf16)f2bf(o2); }
        } else {
            const int kvh = hd - 6;
            float* ko = smp ? a.out + O_KS + (size_t)(row - MP) * 256 + kvh * 128 : a.out + O_KP + (size_t)row * 256 + kvh * 128;
            ko[lane] = o1; ko[64 + lane] = o2;
            if (!smp) { bf16* kb = (bf16*)(a.ws + WS_KB) + ((size_t)(b * 2 + kvh) * SEQ + t) * 128; kb[lane] = (bf16)f2bf(o1); kb[64 + lane] = (bf16)f2bf(o2); }
        }
    }
    {
        const f32x4 v = {bf2f((unsigned)vv & 0xffffu), bf2f(((unsigned)vv) >> 16), bf2f((unsigned)(vv >> 32) & 0xffffu), bf2f((unsigned)(vv >> 48))};
        float* vo = smp ? a.out + O_VS + (size_t)(row - MP) * 256 : a.out + O_VP + (size_t)row * 256;
        *(f32x4*)(vo + 4 * lane) = v;
        if (!smp) { const int kvh = lane >> 5, d = (lane & 31) * 4; *(u64*)((bf16*)(a.ws + WS_VB) + ((size_t)(b * 2 + kvh) * SEQ + t) * 128 + d) = vv; }
    }
    {
#pragma unroll
        for (int p = 0; p < 4; ++p) { const int hd = 2 * p + (lane >> 5);
            const float o1 = q1[p] * c64 - q2[p] * s64, o2 = q2[p] * c64 + q1[p] * s64;
            if (smp) { float* q = (float*)(a.ws + WS_SIQ) + (size_t)(row - MP) * 512 + hd * 64; q[i] = o1; q[32 + i] = o2; }
            else { bf16* q = (bf16*)(a.ws + WS_IQB) + (size_t)row * 512 + hd * 64; q[i] = (bf16)f2bf(o1); q[32 + i] = (bf16)f2bf(o2); } }
        const float rs = rsqrtf(wave_sum_f(k1 * k1 + k2 * k2) * (1.0f / 64.0f) + EPS);
        const float y1 = k1 * rs * a.in[19][i], y2 = k2 * rs * a.in[19][32 + i];
        const float o1 = y1 * c64 - y2 * s64, o2 = y2 * c64 + y1 * s64;
        if (lane < 32) {
            float* ko = smp ? a.out + O_IKS + (size_t)(row - MP) * 64 : a.out + O_IKP + (size_t)row * 64; ko[i] = o1; ko[32 + i] = o2;
            if (!smp) { bf16* kb = (bf16*)(a.ws + WS_IKB) + (size_t)row * 64; kb[i] = (bf16)f2bf(o1); kb[32 + i] = (bf16)f2bf(o2); } }
        if (lane < 8) { const float wv = wraw * (0.35355339059327373f * 0.125f);
            if (smp) ((float*)(a.ws + WS_SIW))[(row - MP) * 8 + lane] = wv; else ((float*)(a.ws + WS_IW))[(size_t)row * 8 + lane] = wv; }
    }
}
__device__ __forceinline__ void p8_dsa_post(Ctx& c, ARGREF a) {
    for (;;) { const int u = q_next(c, 1); if (u >= 384) break; if (u < 256) memattn_prompt_unit(c, a, 1, u); else memattn_sample_unit(c, a, 1, u - 256); }
    const int gw = c.vcu * NWAVES + c.wave, NGW = c.G * NWAVES;
    for (int row = gw; row < MVALID; row += NGW) dsa_post_row(a, row, c.lane);
}

__device__ __forceinline__ void idx_prompt_unit(Ctx& c, ARGREF a, int b, int qb) {
    int tid = c.tid; asm volatile("" : "+v"(tid));
    const int lane = tid & 63, r32 = lane & 31, hh = lane >> 5, w = c.wave;
    const int q0 = b * SEQ + qb * 32;
    LAS bf16* IQL = (LAS bf16*)(c.lds);
    { const bf16* src = (const bf16*)(a.ws + WS_IQB) + (size_t)q0 * 512;
#pragma unroll
      for (int i = 0; i < 4; ++i) { const int row = tid >> 4, ch = (tid & 15) + 16 * i; *(LAS v4u*)(IQL + row * 520 + ch * 8) = *(const v4u*)(src + (size_t)row * 512 + ch * 8); } }
    __syncthreads();
    const bf16* IK = (const bf16*)(a.ws + WS_IKB) + (size_t)(b * SEQ) * 64 + (size_t)r32 * 64 + 8 * hh;
    float* SC = (float*)(a.ws + WS_SC) + (size_t)(q0 + r32) * SEQ;
    float wv[8];
#pragma unroll
    for (int h = 0; h < 8; ++h) wv[h] = ((const float*)(a.ws + WS_IW))[(size_t)(q0 + r32) * 8 + h];
    bf16x8 ak[4], an[4];
    if (w <= qb) {
#pragma unroll
        for (int ks = 0; ks < 4; ++ks) ak[ks] = *(const bf16x8*)(IK + (size_t)(w * 32) * 64 + ks * 16); }
#pragma unroll 1
    for (int kt = w; kt <= qb; kt += 8) {
        if (kt + 8 <= qb) {
#pragma unroll
            for (int ks = 0; ks < 4; ++ks) an[ks] = *(const bf16x8*)(IK + (size_t)((kt + 8) * 32) * 64 + ks * 16); }
        f32x16 sc = {};
        int qoff = r32 * 520 + 8 * hh; asm volatile("" : "+v"(qoff));
#pragma unroll
        for (int h = 0; h < 8; ++h) { f32x16 d = {};
#pragma unroll
            for (int ks = 0; ks < 4; ++ks) d = __builtin_amdgcn_mfma_f32_32x32x16_bf16(ak[ks], *(const LAS bf16x8*)(IQL + qoff + h * 64 + ks * 16), d, 0, 0, 0);
#pragma unroll
            for (int r = 0; r < 16; ++r) sc[r] = fmaf(wv[h], fmaxf(d[r], 0.f), sc[r]); }
#pragma unroll
        for (int g = 0; g < 4; ++g) *(f32x4*)(SC + kt * 32 + 8 * g + 4 * hh) = (f32x4){sc[4 * g], sc[4 * g + 1], sc[4 * g + 2], sc[4 * g + 3]};
#pragma unroll
        for (int ks = 0; ks < 4; ++ks) ak[ks] = an[ks];
    }
}
__device__ __forceinline__ v4u pack8f(const float* p) { const f32x4 x = *(const f32x4*)p, y = *(const f32x4*)(p + 4); v4u o; o.x = pk2(x.x, x.y); o.y = pk2(x.z, x.w); o.z = pk2(y.x, y.y); o.w = pk2(y.z, y.w); return o; }
__device__ __forceinline__ void idx_sample_tile(ARGREF a, int sb, int tl, int lane_) {
    int lane = lane_; asm volatile("" : "+v"(lane));
    const int r32 = lane & 31, hh = lane >> 5, tk = r32 >> 3, hd = r32 & 7;
    const float* iq = (const float*)(a.ws + WS_SIQ) + (size_t)(sb * 4 + tk) * 512 + hd * 64 + 8 * hh;
    const float wv = ((const float*)(a.ws + WS_SIW))[(sb * 4 + tk) * 8 + hd];
    const float* src;
    if (tl < 256) src = a.in[4] + ((size_t)a.page_table[sb * 64 + (tl >> 2)] * 128 + (tl & 3) * 32 + r32) * 64 + 8 * hh;
    else src = a.out + O_IKS + (size_t)(sb * 4 + (r32 & 3)) * 64 + 8 * hh;
    v4u af[4], bf_[4];
#pragma unroll
    for (int ks = 0; ks < 4; ++ks) { af[ks] = pack8f(src + 16 * ks); bf_[ks] = pack8f(iq + 16 * ks); }
    if (tl == 256 && r32 >= 4) {
#pragma unroll
        for (int ks = 0; ks < 4; ++ks) af[ks] = (v4u){0u, 0u, 0u, 0u}; }
    f32x16 d = {};
#pragma unroll
    for (int ks = 0; ks < 4; ++ks) d = __builtin_amdgcn_mfma_f32_32x32x16_bf16(__builtin_bit_cast(bf16x8, af[ks]), __builtin_bit_cast(bf16x8, bf_[ks]), d, 0, 0, 0);
    float* dst = (float*)(a.ws + WS_SSC) + (size_t)(sb * 4 + tk) * SSC_LD + tl * 32;
#pragma unroll
    for (int r = 0; r < 16; ++r) { float v = wv * fmaxf(d[r], 0.f);
        v += __builtin_bit_cast(float, __builtin_amdgcn_update_dpp(0, __builtin_bit_cast(int, v), 0xB1, 0xF, 0xF, false));
        v += __builtin_bit_cast(float, __builtin_amdgcn_update_dpp(0, __builtin_bit_cast(int, v), 0x4E, 0xF, 0xF, false));
        v += __builtin_bit_cast(float, __builtin_amdgcn_update_dpp(0, __builtin_bit_cast(int, v), 0x141, 0xF, 0xF, false));
        if (hd == 0) dst[crow(r, hh)] = v; }
}
__device__ __forceinline__ void p9_indexer(Ctx& c, ARGREF a) {
    const int gw = c.vcu * NWAVES + c.wave, NGW = c.G * NWAVES;
#pragma unroll 1
    for (int wt = gw; wt < 32 * 257; wt += NGW) idx_sample_tile(a, wt / 257, wt % 257, c.lane);
    for (;;) { const int u = q_next(c, 2); if (u >= 512) break; idx_prompt_unit(c, a, u & 3, 127 - (u >> 2)); }
}


__device__ __forceinline__ unsigned fkey(float f) { const unsigned u = __builtin_bit_cast(unsigned, f + 0.0f); return (u & 0x80000000u) ? ~u : (u | 0x80000000u); }
__device__ __forceinline__ void acc_ge(int& cnt, unsigned key, unsigned cand) { asm volatile("v_cmp_le_u32_e32 vcc, %1, %2\n\tv_addc_co_u32_e32 %0, vcc, 0, %0, vcc" : "+v"(cnt) : "s"(cand), "v"(key) : "vcc"); }
__device__ __forceinline__ void acc_ge4(int& c0, int& c1, int& c2, int& c3, unsigned k0, unsigned k1, unsigned k2, unsigned k3, unsigned cand) {
    u64 m0, m1, m2, m3;
    asm volatile("v_cmp_le_u32_e64 %4, %8, %9\n\tv_cmp_le_u32_e64 %5, %8, %10\n\tv_cmp_le_u32_e64 %6, %8, %11\n\tv_cmp_le_u32_e64 %7, %8, %12\n\t"
                 "v_addc_co_u32_e64 %0, %4, 0, %0, %4\n\tv_addc_co_u32_e64 %1, %5, 0, %1, %5\n\tv_addc_co_u32_e64 %2, %6, 0, %2, %6\n\tv_addc_co_u32_e64 %3, %7, 0, %3, %7"
                 : "+v"(c0), "+v"(c1), "+v"(c2), "+v"(c3), "=&s"(m0), "=&s"(m1), "=&s"(m2), "=&s"(m3) : "s"(cand), "v"(k0), "v"(k1), "v"(k2), "v"(k3));
}
__device__ __forceinline__ u64 ballot_nz(unsigned v) { u64 m; asm volatile("v_cmp_ne_u32_e64 %0, 0, %1" : "=s"(m) : "v"(v)); return m; }
__device__ __forceinline__ int wave_sum_dpp(int x) {
    x += __builtin_amdgcn_update_dpp(0, x, 0xB1, 0xF, 0xF, false);
    x += __builtin_amdgcn_update_dpp(0, x, 0x4E, 0xF, 0xF, false);
    x += __builtin_amdgcn_update_dpp(0, x, 0x141, 0xF, 0xF, false);
    x += __builtin_amdgcn_update_dpp(0, x, 0x140, 0xF, 0xF, false);
    return (__builtin_amdgcn_readlane(x, 0) + __builtin_amdgcn_readlane(x, 16)) + (__builtin_amdgcn_readlane(x, 32) + __builtin_amdgcn_readlane(x, 48));
}
__device__ __forceinline__ int mbcnt64(u64 m) { return (int)__builtin_amdgcn_mbcnt_hi((unsigned)(m >> 32), __builtin_amdgcn_mbcnt_lo((unsigned)m, 0u)); }
constexpr int TK_LOWBITS = 18;
__device__ __forceinline__ void topk_finish(unsigned ck, int cp, int A, int posmax, unsigned& T, int& P) {
#pragma unroll 1
    for (int bit = TK_LOWBITS - 1; bit >= 0; --bit) { const unsigned cand = T | (1u << bit); if (A + __builtin_popcountll(__ballot(ck >= cand)) >= 256) T = cand; }
    const int need = 256 - (A + __builtin_popcountll(__ballot(ck > T))), ceq = __builtin_popcountll(__ballot(ck == T));
    P = posmax;
    if (ceq != need) { P = 0;
#pragma unroll 1
        for (int bit = 13; bit >= 0; --bit) { const int cand = P | (1 << bit); if (__builtin_popcountll(__ballot(ck == T && cp < cand)) < need) P = cand; } }
}
__device__ __forceinline__ unsigned wave_min_u(unsigned x) {
    x = min(x, (unsigned)__builtin_amdgcn_update_dpp(0, (int)x, 0xB1, 0xF, 0xF, false)); x = min(x, (unsigned)__builtin_amdgcn_update_dpp(0, (int)x, 0x4E, 0xF, 0xF, false));
    x = min(x, (unsigned)__builtin_amdgcn_update_dpp(0, (int)x, 0x141, 0xF, 0xF, false)); x = min(x, (unsigned)__builtin_amdgcn_update_dpp(0, (int)x, 0x140, 0xF, 0xF, false));
    return min(min((unsigned)__builtin_amdgcn_readlane((int)x, 0), (unsigned)__builtin_amdgcn_readlane((int)x, 16)), min((unsigned)__builtin_amdgcn_readlane((int)x, 32), (unsigned)__builtin_amdgcn_readlane((int)x, 48)));
}
__device__ __forceinline__ unsigned wave_max_u(unsigned x) {
    x = max(x, (unsigned)__builtin_amdgcn_update_dpp(0, (int)x, 0xB1, 0xF, 0xF, false)); x = max(x, (unsigned)__builtin_amdgcn_update_dpp(0, (int)x, 0x4E, 0xF, 0xF, false));
    x = max(x, (unsigned)__builtin_amdgcn_update_dpp(0, (int)x, 0x141, 0xF, 0xF, false)); x = max(x, (unsigned)__builtin_amdgcn_update_dpp(0, (int)x, 0x140, 0xF, 0xF, false));
    return max(max((unsigned)__builtin_amdgcn_readlane((int)x, 0), (unsigned)__builtin_amdgcn_readlane((int)x, 16)), max((unsigned)__builtin_amdgcn_readlane((int)x, 32), (unsigned)__builtin_amdgcn_readlane((int)x, 48)));
}
__device__ __forceinline__ void topk_prompt_rows(ARGREF a, int row0, int stride, int lane_, LAS unsigned* cl) {
    int lane = lane_; asm volatile("" : "+v"(lane));
    const float* SCb = (const float*)(a.ws + WS_SC);
#pragma unroll 1
    for (int row = row0; row < MP; row += stride) {
        const int t = row & 4095;
        u64* mk = (u64*)(a.ws + WS_MASK) + (size_t)row * 64;
        if (t < 256) { u64 myword = 0ull;
#pragma unroll 1
            for (int j = 0; j < 64; ++j) { const u64 m = __ballot(64 * j + lane <= t); if (lane == j) myword = m; }
            mk[lane] = myword;
            continue; }
        unsigned key[64];
        { const float* sc_ = SCb + (size_t)row * SEQ + lane; const int tj_ = t >> 6;
          float v[64];
#pragma unroll
          for (int j = 0; j < 64; ++j) v[j] = sc_[64 * (j < tj_ ? j : tj_)];
          int pj = lane;
#pragma unroll
          for (int j = 0; j < 64; ++j) { const int u = __builtin_bit_cast(int, v[j] + 0.0f); const unsigned k = (unsigned)u ^ ((unsigned)(u >> 31) | 0x80000000u); key[j] = (pj <= t) ? k : 0u; pj += 64; asm volatile("" : "+v"(pj)); } }
        unsigned T; int hb;
        {
            unsigned b0 = 0u, b1 = 0u, b2 = 0u, b3 = 0u;
#pragma unroll
            for (int j = 0; j < 64; ++j) { unsigned x = key[j]; const unsigned m0 = max(b0, x); x = min(b0, x); b0 = m0; const unsigned m1 = max(b1, x); x = min(b1, x); b1 = m1; const unsigned m2 = max(b2, x); x = min(b2, x); b2 = m2; b3 = max(b3, x); }
            const unsigned L = wave_min_u(b3), H = wave_max_u(b3), df = L ^ H;
            hb = df ? 31 - __builtin_clz(df) : -1;
            T = hb >= 31 ? 0u : (L & ~((2u << (hb < 0 ? 0 : hb)) - 1u)); if (hb < 0) T = L;
        }
#define TK_FULLCOUNT(CAND, OUT) do { const unsigned cs_ = __builtin_amdgcn_readfirstlane(CAND); int c0_ = 0, c1_ = 0, c2_ = 0, c3_ = 0; \
        _Pragma("unroll") for (int j = 0; j < 64; j += 4) acc_ge4(c0_, c1_, c2_, c3_, key[j], key[j + 1], key[j + 2], key[j + 3], cs_); OUT = wave_sum_dpp((c0_ + c1_) + (c2_ + c3_)); } while (0)
#pragma unroll 1
        for (int bit = hb; bit >= TK_LOWBITS; --bit) { const unsigned cand = T | (1u << bit); int tot; TK_FULLCOUNT(cand, tot); if (tot >= 256) T = cand; }
        const unsigned Tb = T & ~((1u << TK_LOWBITS) - 1u), hib = Tb + (1u << TK_LOWBITS);
        int A = 0, cT; if (hib != 0u) TK_FULLCOUNT(hib, A); TK_FULLCOUNT(Tb, cT);
        int P;
        if (cT - A <= 64) {
            if (lane == 0) cl[128] = 0u;
            int pj = lane;
#pragma unroll
            for (int j = 0; j < 64; ++j) { if ((key[j] - Tb) < (1u << TK_LOWBITS)) { const unsigned pos = __hip_atomic_fetch_add(cl + 128, 1u, __ATOMIC_RELAXED, __HIP_MEMORY_SCOPE_WORKGROUP); if (pos < 64u) { cl[pos] = key[j]; cl[64 + pos] = (unsigned)pj; } }
                pj += 64; asm volatile("" : "+v"(pj)); }
            const int nund = cT - A;
            const unsigned ck = lane < nund ? cl[lane] : 0u; const int cp = (int)cl[64 + lane];
            topk_finish(ck, cp, A, 4095, T, P);
        } else {
#pragma unroll 1
            for (int bit = TK_LOWBITS - 1; bit >= 0; --bit) { const unsigned cand = T | (1u << bit); int tot; TK_FULLCOUNT(cand, tot); if (tot >= 256) T = cand; }
            int cge, cgt; TK_FULLCOUNT(T, cge); cgt = 0; if (T != 0xffffffffu) TK_FULLCOUNT(T + 1u, cgt);
            const int need = 256 - cgt, ceq = cge - cgt; P = 4095;
            if (ceq != need) { P = 0;
#pragma unroll 1
                for (int bit = 11; bit >= 0; --bit) { const int cand = P | (1 << bit); int cnt = 0; int pj = lane;
#pragma unroll
                    for (int j = 0; j < 64; ++j) { cnt += (key[j] == T && pj < cand) ? 1 : 0; pj += 64; asm volatile("" : "+v"(pj)); }
                    if (wave_sum_dpp(cnt) < need) P = cand; } }
        }
#undef TK_FULLCOUNT
        if (P != 4095) {
            int pq = lane;
#pragma unroll
            for (int j = 0; j < 64; ++j) { if (key[j] == T && pq > P) key[j] = 0u; pq += 64; asm volatile("" : "+v"(pq)); } }
        unsigned wlo = 0u, whi = 0u; const unsigned Ts = __builtin_amdgcn_readfirstlane(T);
#pragma unroll
        for (int j = 0; j < 64; ++j) asm volatile("v_cmp_le_u32_e32 vcc, %2, %3\n\ts_nop 3\n\tv_writelane_b32 %0, vcc_lo, %4\n\tv_writelane_b32 %1, vcc_hi, %4" : "+v"(wlo), "+v"(whi) : "s"(Ts), "v"(key[j]), "i"(j) : "vcc");
        mk[lane] = ((u64)whi << 32) | (u64)wlo;
    }
}
__device__ __forceinline__ void topk_sample_row(ARGREF a, int q, int lane_, LAS unsigned* K, LAS unsigned* cl) {
    int lane = lane_; asm volatile("" : "+v"(lane));
    const int t = q & 3, n = PAST + t + 1; const float* sc = (const float*)(a.ws + WS_SSC) + (size_t)q * SSC_LD;
    int* out = (int*)(a.ws + WS_SIDX) + q * 256;
    unsigned key[129];
#pragma unroll
    for (int j = 0; j < 129; ++j) { const float v = sc[64 * j + lane]; key[j] = (j < 128 || lane < n - 8192) ? fkey(v) : 0u; }
#pragma unroll
    for (int j = 0; j < 129; ++j) K[64 * j + lane] = key[j];
#define TK_FULLCOUNT(CAND, OUT) do { const unsigned cs_ = __builtin_amdgcn_readfirstlane(CAND); int c0_ = 0, c1_ = 0, c2_ = 0, c3_ = 0; \
        _Pragma("unroll") for (int j = 0; j < 128; j += 4) acc_ge4(c0_, c1_, c2_, c3_, key[j], key[j + 1], key[j + 2], key[j + 3], cs_); acc_ge(c0_, key[128], cs_); OUT = wave_sum_dpp((c0_ + c1_) + (c2_ + c3_)); } while (0)
    unsigned T = 0u;
#pragma unroll 1
    for (int bit = 31; bit >= TK_LOWBITS; --bit) { const unsigned cand = T | (1u << bit); int tot; TK_FULLCOUNT(cand, tot); if (tot >= 256) T = cand; }
    const unsigned hib = T + (1u << TK_LOWBITS);
    int A = 0, cT; if (hib != 0u) TK_FULLCOUNT(hib, A); TK_FULLCOUNT(T, cT);
    int P;
    if (cT - A <= 64) {
        int base = 0;
#pragma unroll 1
        for (int j0 = 0; j0 < 128; j0 += 8) { unsigned kk[8];
#pragma unroll
            for (int i = 0; i < 8; ++i) kk[i] = K[64 * (j0 + i) + lane];
#pragma unroll
            for (int i = 0; i < 8; ++i) { const unsigned und = (kk[i] - T) < (1u << TK_LOWBITS) ? 1u : 0u; const u64 m = ballot_nz(und); const int pos = base + mbcnt64(m);
                if (und) { cl[pos] = kk[i]; cl[64 + pos] = (unsigned)(64 * (j0 + i) + lane); }
                base += __builtin_popcountll(m); } }
        { const unsigned kj = K[64 * 128 + lane]; const unsigned und = (kj - T) < (1u << TK_LOWBITS) ? 1u : 0u; const u64 m = ballot_nz(und); const int pos = base + mbcnt64(m);
          if (und) { cl[pos] = kj; cl[64 + pos] = (unsigned)(64 * 128 + lane); } base += __builtin_popcountll(m); }
        const unsigned ck = lane < base ? cl[lane] : 0u; const int cp = (int)cl[64 + lane];
        topk_finish(ck, cp, A, 16383, T, P);
    } else {
#pragma unroll 1
        for (int bit = TK_LOWBITS - 1; bit >= 0; --bit) { const unsigned cand = T | (1u << bit); int tot; TK_FULLCOUNT(cand, tot); if (tot >= 256) T = cand; }
        int cge, cgt; TK_FULLCOUNT(T, cge); cgt = 0; if (T != 0xffffffffu) TK_FULLCOUNT(T + 1u, cgt);
        const int need = 256 - cgt, ceq = cge - cgt; P = 16383;
        if (ceq != need) { P = 0;
#pragma unroll 1
            for (int bit = 13; bit >= 0; --bit) { const int cand = P | (1 << bit); int cnt = 0;
#pragma unroll 4
                for (int j = 0; j < 129; ++j) cnt += (K[64 * j + lane] == T && 64 * j + lane < cand) ? 1 : 0;
                if (wave_sum_dpp(cnt) < need) P = cand; } }
    }
#undef TK_FULLCOUNT
    int base = 0;
#pragma unroll 1
    for (int j0 = 0; j0 < 136; j0 += 8) { unsigned kk[8];
#pragma unroll
        for (int i = 0; i < 8; ++i) kk[i] = (j0 + i < 129) ? K[64 * (j0 + i) + lane] : 0u;
#pragma unroll
        for (int i = 0; i < 8; ++i) { const int ps = 64 * (j0 + i) + lane; const unsigned selv = (kk[i] > T || (kk[i] == T && ps <= P)) ? 1u : 0u; const u64 m = ballot_nz(selv);
            const int pos = base + mbcnt64(m);
            if (selv && pos < 256) out[pos] = ps;
            base += __builtin_popcountll(m); } }
}
__device__ __forceinline__ void p10_topk(Ctx& c, ARGREF a) {
    const int gw = c.vcu * NWAVES + c.wave, NGW = c.G * NWAVES;
    LAS unsigned* cl = (LAS unsigned*)(c.lds) + c.wave * 192;
    if (c.wave == 0 && c.vcu < MS) topk_sample_row(a, c.vcu, c.lane, (LAS unsigned*)(c.lds + 8192), cl);
    topk_prompt_rows(a, gw, NGW, c.lane, cl);
}


__device__ __forceinline__ void attn_sample_unit(Ctx& c, ARGREF a, int sb, int t) {
    LAS bf16* KV = (LAS bf16*)(c.lds);
    LAS float* QL = (LAS float*)(c.lds + 69632);
    LAS float* SL = (LAS float*)(c.lds + 69632 + 3072);
    LAS float* OL = (LAS float*)(c.lds + 69632 + 6144);
    LAS int* IL = (LAS int*)(c.lds + 69632 + 12288);
    int tid = c.tid; asm volatile("" : "+v"(tid));
    const int lane = tid & 63, w = c.wave, q = sb * 4 + t;
    __syncthreads();
    if (tid < 256) IL[tid] = ((const int*)(a.ws + WS_SIDX))[q * 256 + tid];
    for (int i = tid; i < 768; i += 512) QL[i] = ((const float*)(a.ws + WS_SQ))[(size_t)q * 768 + i];
    __syncthreads();
    bf16* MIX = (bf16*)(a.ws + WS_MIX) + (size_t)(MP + q) * DM;
#pragma unroll 1
    for (int kvh = 0; kvh < 2; ++kvh) {
#pragma unroll 1
        for (int pass = 0; pass < 2; ++pass) {
            const float* pool = pass ? a.in[3] : a.in[2]; const float* nw = a.out + (pass ? O_VS : O_KS);
            for (int i = tid >> 5; i < 256; i += 16) { const int idx = IL[i]; const float* src;
                if (idx < PAST) src = pool + (((size_t)a.page_table[sb * 64 + (idx >> 7)] * 128 + (idx & 127)) * 2 + kvh) * 128;
                else src = nw + (size_t)(sb * 4 + (idx - PAST)) * 256 + kvh * 128;
                const f32x4 v = *(const f32x4*)(src + (tid & 31) * 4);
                *(LAS u64*)(KV + i * 136 + (tid & 31) * 4) = (u64)pk2(v.x, v.y) | ((u64)pk2(v.z, v.w) << 32); }
            __syncthreads();
            if (pass == 0) {
                const int i = tid >> 1, dh = (tid & 1) * 64; float s0 = 0.f, s1 = 0.f, s2 = 0.f;
#pragma unroll 8
                for (int d = 0; d < 64; ++d) { const float kx = bf2f(KV[i * 136 + dh + d]);
                    s0 = fmaf(QL[(3 * kvh + 0) * 128 + dh + d], kx, s0); s1 = fmaf(QL[(3 * kvh + 1) * 128 + dh + d], kx, s1); s2 = fmaf(QL[(3 * kvh + 2) * 128 + dh + d], kx, s2); }
                s0 += __shfl_xor(s0, 1); s1 += __shfl_xor(s1, 1); s2 += __shfl_xor(s2, 1);
                if ((tid & 1) == 0) { SL[i] = s0 * 0.08838834764831845f; SL[256 + i] = s1 * 0.08838834764831845f; SL[512 + i] = s2 * 0.08838834764831845f; }
                __syncthreads();
                if (w < 3) { float v[4], mx = -1e30f;
#pragma unroll
                    for (int j = 0; j < 4; ++j) { v[j] = SL[w * 256 + 64 * j + lane]; mx = fmaxf(mx, v[j]); }
#pragma unroll
                    for (int o = 1; o < 64; o <<= 1) mx = fmaxf(mx, __shfl_xor(mx, o));
                    float l = 0.f;
#pragma unroll
                    for (int j = 0; j < 4; ++j) { v[j] = __expf(v[j] - mx); l += v[j]; }
                    l = wave_sum(l); const float il = 1.0f / l;
#pragma unroll
                    for (int j = 0; j < 4; ++j) SL[w * 256 + 64 * j + lane] = v[j] * il; }
                __syncthreads();
            } else {
                const int d = tid & 127, part = tid >> 7; float o0 = 0.f, o1 = 0.f, o2 = 0.f;
#pragma unroll 8
                for (int i = part * 64; i < part * 64 + 64; ++i) { const float vx = bf2f(KV[i * 136 + d]); o0 = fmaf(SL[i], vx, o0); o1 = fmaf(SL[256 + i], vx, o1); o2 = fmaf(SL[512 + i], vx, o2); }
                OL[(part * 3 + 0) * 128 + d] = o0; OL[(part * 3 + 1) * 128 + d] = o1; OL[(part * 3 + 2) * 128 + d] = o2;
                __syncthreads();
                if (tid < 384) { const int hq = tid >> 7, dd = tid & 127; const float o = (OL[hq * 128 + dd] + OL[(3 + hq) * 128 + dd]) + (OL[(6 + hq) * 128 + dd] + OL[(9 + hq) * 128 + dd]);
                    MIX[(3 * kvh + hq) * 128 + dd] = (bf16)f2bf(o); }
                __syncthreads();
            }
        }
    }
}


namespace attn {
using bf16 = unsigned short;
typedef short bf16x8 __attribute__((ext_vector_type(8)));
typedef short s16x4 __attribute__((ext_vector_type(4)));
typedef float f32x16 __attribute__((ext_vector_type(16)));
typedef float f32x4 __attribute__((ext_vector_type(4)));
typedef unsigned u32x4 __attribute__((ext_vector_type(4)));
typedef unsigned u32x2 __attribute__((ext_vector_type(2)));
constexpr int D = 128, OS = 1024;
constexpr float THR = 8.f;
constexpr float SCALE = 0.08838834764831845f;
constexpr int NW = 8, QBLK = 32, KVBLK = 64, QB = NW * QBLK;
constexpr int SHM_V = KVBLK * D * 2, SHM_K = KVBLK * D * 2;
constexpr int LDS_BYTES = 2 * SHM_V + 2 * SHM_K + NW * 64 * 4;

#define KSWZ(row, colB) ((row) * 256 + ((colB) ^ (((row) & 7) << 4)))
#define SBAR() __builtin_amdgcn_sched_barrier(0)
__device__ __forceinline__ int v_st(int k, int c) { const int kk = (k & ~0xC) | ((k & 4) << 1) | ((k & 8) >> 1); return ((kk >> 3) * 4 + (c >> 5)) * 512 + ((kk & 7) * 32 + (c & 31)) * 2; }
__device__ __forceinline__ int v_rd_base(int lane) { return ((lane & 3) << 3) | (((lane >> 2) & 3) << 6) | (((lane >> 4) & 1) << 5) | (((lane >> 5) & 1) << 8); }
constexpr int v_rd_off(int d0, int ks, int half) { return d0 * 512 + ks * 4096 + half * 2048; }
__device__ __forceinline__ int crow(int r, int hi) { return (r & 3) + 8 * (r >> 2) + 4 * hi; }
__device__ __forceinline__ unsigned cvtpk(float lo, float hi) {
    unsigned r; asm volatile("v_cvt_pk_bf16_f32 %0, %1, %2" : "=v"(r) : "v"(lo), "v"(hi)); return r;
}
__device__ __forceinline__ bf16x8 pack8(f32x4 a, f32x4 b) {
    u32x4 w = {cvtpk(a[0], a[1]), cvtpk(a[2], a[3]), cvtpk(b[0], b[1]), cvtpk(b[2], b[3])};
    return *reinterpret_cast<bf16x8*>(&w);
}

__device__ __forceinline__ void partialSM(f32x16& p0, f32x16& p1, float& m_reg, float& mn, float& alpha) {
    float pmax = p0[0]; for (int r = 1; r < 16; ++r) pmax = fmaxf(pmax, p0[r]); for (int r = 0; r < 16; ++r) pmax = fmaxf(pmax, p1[r]);
    { auto rr = __builtin_amdgcn_permlane32_swap(__float_as_uint(pmax), __float_as_uint(pmax), false, false);
      pmax = fmaxf(__uint_as_float(rr[0]), __uint_as_float(rr[1])); }
    constexpr float C2 = 1.4426950408889634f * SCALE;
    if (__builtin_expect(__all((pmax - m_reg) * SCALE <= THR), 1)) { mn = m_reg; alpha = 1.f; }
    else { mn = fmaxf(m_reg, pmax); alpha = __builtin_amdgcn_exp2f((m_reg - mn) * C2); m_reg = mn; }
    const float mnL = -mn * C2;
    for (int r = 0; r < 16; ++r) p0[r] = fmaf(p0[r], C2, mnL); for (int r = 0; r < 16; ++r) p1[r] = fmaf(p1[r], C2, mnL);
    for (int r = 0; r < 16; ++r) p0[r] = __builtin_amdgcn_exp2f(p0[r]);
}
__device__ __forceinline__ void finishSM(f32x16& p0, f32x16& p1, float alpha, float& l_reg, bf16x8& pa0, bf16x8& pa1, bf16x8& pa2, bf16x8& pa3) {
    for (int r = 0; r < 16; ++r) p1[r] = __builtin_amdgcn_exp2f(p1[r]);
    float ps = 0; for (int r = 0; r < 16; ++r) ps += p0[r]; for (int r = 0; r < 16; ++r) ps += p1[r];
    { auto rr = __builtin_amdgcn_permlane32_swap(__float_as_uint(ps), __float_as_uint(ps), false, false);
      ps = __uint_as_float(rr[0]) + __uint_as_float(rr[1]); }
    l_reg = l_reg * alpha + ps;
#define PK4(P, B_, OUT) do { unsigned a0 = cvtpk(P[B_+0], P[B_+1]), a1 = cvtpk(P[B_+2], P[B_+3]);                          \
        unsigned b0 = cvtpk(P[B_+4], P[B_+5]), b1 = cvtpk(P[B_+6], P[B_+7]);                                             \
        auto r0 = __builtin_amdgcn_permlane32_swap(a0, b0, false, false); auto r1 = __builtin_amdgcn_permlane32_swap(a1, b1, false, false); \
        u32x4 w = {r0[0], r1[0], r0[1], r1[1]}; OUT = *reinterpret_cast<bf16x8*>(&w); } while (0)
    PK4(p0, 0, pa0); PK4(p0, 8, pa1); PK4(p1, 0, pa2); PK4(p1, 8, pa3);
#undef PK4
}
template <int KB, bool SK>
__device__ __forceinline__ void qkt(f32x16& p0, f32x16& p1, const char* K_lds, int r32, int hi, const bf16x8* qr, bool act) {
    if (SK && !act) { const float NEG = -__builtin_inff();
#pragma unroll
        for (int r = 0; r < 16; ++r) { p0[r] = NEG; p1[r] = NEG; } return; }
    p0 = f32x16{}; p1 = f32x16{};
    const char* kb[4];
#pragma unroll
    for (int dd = 0; dd < 4; ++dd) kb[dd] = K_lds + KB * SHM_K + KSWZ(r32, (dd * 16 + hi * 8) * 2);
#pragma unroll
    for (int d0 = 0; d0 < 8; ++d0) { const char* a = kb[d0 & 3] + (d0 >> 2) * 128;
        bf16x8 b0 = *reinterpret_cast<const bf16x8*>(a);
        bf16x8 b1 = *reinterpret_cast<const bf16x8*>(a + 32 * 256);
        p0 = __builtin_amdgcn_mfma_f32_32x32x16_bf16(b0, qr[d0], p0, 0, 0, 0);
        p1 = __builtin_amdgcn_mfma_f32_32x32x16_bf16(b1, qr[d0], p1, 0, 0, 0); }
}
template <int VB, bool SK>
__device__ __forceinline__ void pv_tile(f32x16* o, int vb0, bf16x8 pa0, bf16x8 pa1, bf16x8 pa2, bf16x8 pa3, bool act) {
    if (SK && !act) return;
#define TRRD(dst, off) asm volatile("ds_read_b64_tr_b16 %0, %1 offset:%2" : "=&v"(dst) : "v"(vb0), "i"(off) : "memory")
#define PV_D0(d0) do { s16x4 l0, l1, l2, l3, h0, h1, h2, h3; constexpr int b_ = VB * SHM_V + v_rd_off(d0, 0, 0);     \
        TRRD(l0, b_); TRRD(h0, b_ + 2048); TRRD(l1, b_ + 4096); TRRD(h1, b_ + 6144); TRRD(l2, b_ + 8192); TRRD(h2, b_ + 10240); TRRD(l3, b_ + 12288); TRRD(h3, b_ + 14336); \
        asm volatile("s_waitcnt lgkmcnt(0)" ::: "memory"); SBAR();                 \
        o[d0] = __builtin_amdgcn_mfma_f32_32x32x16_bf16(pa0, (bf16x8){l0[0], l0[1], l0[2], l0[3], h0[0], h0[1], h0[2], h0[3]}, o[d0], 0, 0, 0);   \
        o[d0] = __builtin_amdgcn_mfma_f32_32x32x16_bf16(pa1, (bf16x8){l1[0], l1[1], l1[2], l1[3], h1[0], h1[1], h1[2], h1[3]}, o[d0], 0, 0, 0);   \
        o[d0] = __builtin_amdgcn_mfma_f32_32x32x16_bf16(pa2, (bf16x8){l2[0], l2[1], l2[2], l2[3], h2[0], h2[1], h2[2], h2[3]}, o[d0], 0, 0, 0);   \
        o[d0] = __builtin_amdgcn_mfma_f32_32x32x16_bf16(pa3, (bf16x8){l3[0], l3[1], l3[2], l3[3], h3[0], h3[1], h3[2], h3[3]}, o[d0], 0, 0, 0); } while (0)
    PV_D0(0); PV_D0(1); PV_D0(2); PV_D0(3);
#undef PV_D0
#undef TRRD
}

__device__ __forceinline__ bf16x8 load8(const bf16* p) { return *reinterpret_cast<const bf16x8*>(p); }
__device__ __forceinline__ void mask_bits(f32x16& p0, f32x16& p1, u32x2 w, int hi) {
    const float NEG = -__builtin_inff();
    asm volatile("" : "+v"(w.x), "+v"(w.y));
    const unsigned lo = w.x >> (4 * hi), up = w.y >> (4 * hi);
#pragma unroll
    for (int r = 0; r < 16; ++r) { const int c = (r & 3) + 8 * (r >> 2);
        if (!((lo >> c) & 1u)) p0[r] = NEG;
        if (!((up >> c) & 1u)) p1[r] = NEG; }
}
struct BlockRef { const bf16* Q; const bf16* K; const bf16* V; bf16* O; const u32x2* M; int P0; };
struct Seam { bf16x8 qr[8]; bf16x8 st_v0, st_v1, st_k0, st_k1; };
#define ROW(p, k0, rr) ((p) + (size_t)((k0) + (rr)) * D + sc)
#define VMW() asm volatile("s_waitcnt vmcnt(0)" ::: "memory")
#define VMWN(n) asm volatile("s_waitcnt vmcnt(%0)" :: "i"(n) : "memory")
#define SLOAD_H(Kp, Vp, k0) do { S.st_v0 = load8(ROW(Vp, k0, sr)); S.st_v1 = load8(ROW(Vp, k0, 32 + sr));              \
                         S.st_k0 = load8(ROW(Kp, k0, sr)); S.st_k1 = load8(ROW(Kp, k0, 32 + sr)); } while (0)
#define SWRITE_HK(bf) do { *(bf16x8*)(K_lds + (bf) * SHM_K + kws) = S.st_k0; *(bf16x8*)(K_lds + (bf) * SHM_K + kws + 32 * 256) = S.st_k1; } while (0)
#define SWRITE_HV(bf) do { *(bf16x8*)(V_lds + (bf) * SHM_V + vst0) = S.st_v0; *(bf16x8*)(V_lds + (bf) * SHM_V + vst1) = S.st_v1; } while (0)
#define SWRITE_H(bf) do { SWRITE_HV(bf); SWRITE_HK(bf); } while (0)
__device__ __forceinline__ void sel_prime(const BlockRef& cur, char* lds, Seam& S) {
    int tid_ = threadIdx.x; asm volatile("" : "+v"(tid_));
    const int tid = tid_, wid = __builtin_amdgcn_readfirstlane(tid >> 6), lane = tid & 63, r32 = lane & 31, hi = lane >> 5;
    const int sr = tid >> 4, sc = (tid & 15) * 8, kws = KSWZ(sr, sc * 2); char* K_lds = lds + 2 * SHM_V;
    for (int d0 = 0; d0 < 8; ++d0) S.qr[d0] = load8(cur.Q + (size_t)(wid * QBLK + r32) * D + d0 * 16 + hi * 8);
    SLOAD_H(cur.K, cur.V, 0); VMW(); SWRITE_HK(0);
    __syncthreads();
}
__device__ __forceinline__ void sel_block(const BlockRef& cur, const BlockRef& nxt, char* lds, Seam& S) {
    int tid_ = threadIdx.x; asm volatile("" : "+v"(tid_));
    const int tid = tid_, wid = __builtin_amdgcn_readfirstlane(tid >> 6), lane = tid & 63, r32 = lane & 31, hi = lane >> 5;
    const int NT = (cur.P0 + QB) / KVBLK;
    char* V_lds = lds; char* K_lds = lds + 2 * SHM_V;
    float* ws = (float*)(lds + 2 * SHM_V + 2 * SHM_K) + wid * 64; float* li_l = ws, * al_l = ws + 32;
    float m_reg = -1e30f, l_reg = 0; f32x16 o[4] = {};
    const int sr = tid >> 4, sc = (tid & 15) * 8, vst0 = v_st(sr, sc), vst1 = v_st(32 + sr, sc), kws = KSWZ(sr, sc * 2);
    const int vb0 = (int)(uintptr_t)V_lds + v_rd_base(lane);
    const bf16* Kh = cur.K; const bf16* Vh = cur.V;
    const char* Mbase = (const char*)cur.M; const unsigned moff = (unsigned)(wid * QBLK + r32) * 512u;
#define MROW(t) (*(const u32x2*)(Mbase + (moff + (unsigned)(t) * 8u)))
#define RESC(a) do { if (__any((a) < 1.f)) { if (hi == 0) al_l[r32] = (a); asm volatile("s_waitcnt lgkmcnt(0)" ::: "memory");              \
                     for (int d_ = 0; d_ < 4; ++d_) for (int r = 0; r < 16; ++r) o[d_][r] *= al_l[crow(r, hi)]; } } while (0)
#define KBASE(t) ((t) * KVBLK)
    f32x16 pA0, pA1, pB0, pB1; float mnA, mnB, alA, alB; bf16x8 pa0, pa1, pa2, pa3; u32x2 mw;
    SWRITE_HV(0); SBAR();
    if (NT > 1) SLOAD_H(Kh, Vh, KBASE(1));
    mw = MROW(0);
    SBAR(); qkt<0, false>(pA0, pA1, K_lds, r32, hi, S.qr, true);
    mask_bits(pA0, pA1, mw, hi); partialSM(pA0, pA1, m_reg, mnA, alA);
    if (NT > 1) { VMW(); SWRITE_H(1); }
    __syncthreads();
#define HALF_STEP(PX0, PX1, mnX, alX, PY0, PY1, alY, t, KB, VB, SB) do {                                                      \
        SBAR(); mw = MROW(t); qkt<KB, false>(PX0, PX1, K_lds, r32, hi, S.qr, true);                                          \
        finishSM(PY0, PY1, alY, l_reg, pa0, pa1, pa2, pa3); SBAR();                                                           \
        if ((t) + 1 < NT) { SLOAD_H(Kh, Vh, KBASE((t) + 1)); SBAR(); }                                                        \
        pv_tile<VB, false>(o, vb0, pa0, pa1, pa2, pa3, true); mask_bits(PX0, PX1, mw, hi); partialSM(PX0, PX1, m_reg, mnX, alX); \
        __syncthreads();                                                                                                      \
        if ((t) + 1 < NT) { VMW(); SWRITE_H(SB); }                                                                            \
        RESC(alX); __syncthreads(); } while (0)
    for (int t = 1; t + 1 < NT; t += 2) {
        HALF_STEP(pB0, pB1, mnB, alB, pA0, pA1, alA, t, 1, 0, 0);
        HALF_STEP(pA0, pA1, mnA, alA, pB0, pB1, alB, t + 1, 0, 1, 1);
    }
    const bool even = (NT & 1) == 0;
    if (even) { SBAR(); mw = MROW(NT - 1); qkt<1, false>(pB0, pB1, K_lds, r32, hi, S.qr, true); SBAR(); }
    SLOAD_H(nxt.K, nxt.V, 0); SBAR();
#pragma unroll
    for (int d0 = 0; d0 < 8; ++d0) S.qr[d0] = load8(nxt.Q + (size_t)(wid * QBLK + r32) * D + d0 * 16 + hi * 8);
    SBAR();
    finishSM(pA0, pA1, alA, l_reg, pa0, pa1, pa2, pa3); SBAR();
    pv_tile<0, false>(o, vb0, pa0, pa1, pa2, pa3, true);
    if (even) { mask_bits(pB0, pB1, mw, hi); partialSM(pB0, pB1, m_reg, mnB, alB); __syncthreads(); RESC(alB);
        finishSM(pB0, pB1, alB, l_reg, pa0, pa1, pa2, pa3); SBAR(); pv_tile<1, false>(o, vb0, pa0, pa1, pa2, pa3, true); }
    SBAR(); VMWN(8); SWRITE_HK(0); SBAR();
    if (hi == 0) li_l[r32] = l_reg; asm volatile("s_waitcnt lgkmcnt(0)" ::: "memory");
    float rli[16];
#pragma unroll
    for (int r = 0; r < 16; ++r) rli[r] = __builtin_amdgcn_rcpf(li_l[crow(r, hi)]);
    bf16* Ow = cur.O + (size_t)(wid * QBLK) * OS;
#pragma unroll
    for (int r = 0; r < 16; ++r) { const int orow = crow(r, hi);
#pragma unroll
        for (int d0 = 0; d0 < 4; ++d0) { const float v = o[d0][r] * rli[r];
            const float vn = __shfl_xor(v, 1);
            if ((r32 & 1) == 0) *(unsigned*)(Ow + (size_t)orow * OS + d0 * 32 + r32) = cvtpk(v, vn); } }
    __syncthreads();
#undef RESC
#undef KBASE
#undef HALF_STEP
#undef MROW
}
#undef ROW
#undef VMW
#undef VMWN
#undef SLOAD_H
#undef SWRITE_HK
#undef SWRITE_HV
#undef SWRITE_H
#undef KSWZ
#undef SBAR
}


__device__ __forceinline__ attn::BlockRef attn_ref(ARGREF a, int b, int h, int qb) {
    attn::BlockRef r; const int kvh = h / 3;
    r.Q = (const attn::bf16*)(a.ws + WS_QB) + ((size_t)(b * 6 + h) * SEQ + (size_t)qb * 256) * 128;
    r.K = (const attn::bf16*)(a.ws + WS_KB) + (size_t)(b * 2 + kvh) * SEQ * 128;
    r.V = (const attn::bf16*)(a.ws + WS_VB) + (size_t)(b * 2 + kvh) * SEQ * 128;
    r.O = (attn::bf16*)(a.ws + WS_MIX) + (size_t)(b * SEQ + qb * 256) * DM + h * 128;
    r.M = (const attn::u32x2*)(a.ws + WS_MASK) + (size_t)(b * SEQ + qb * 256) * 64;
    r.P0 = qb * 256; return r;
}
__device__ __forceinline__ void p11_attention(Ctx& c, ARGREF a) {
    constexpr int NITEM = 192;
#pragma unroll 1
    for (int it = c.vcu; it < NITEM; it += c.G) {
        const int p = it & 7, bh = it >> 3, b = bh / 6, h = bh % 6;
        attn::Seam S;
        attn::BlockRef cur = attn_ref(a, b, h, p), nxt = attn_ref(a, b, h, 15 - p);
        __syncthreads();
        attn::sel_prime(cur, (char*)c.lds, S);
        attn::sel_block(cur, nxt, (char*)c.lds, S);
        attn::sel_block(nxt, nxt, (char*)c.lds, S);
    }
    const int spare = c.G - NITEM;
    if (spare > 0) { if (c.vcu >= NITEM) for (int u = c.vcu - NITEM; u < MS; u += spare) attn_sample_unit(c, a, u >> 2, u & 3); }
    else for (int u = c.vcu; u < MS; u += c.G) attn_sample_unit(c, a, u >> 2, u & 3);
}

enum { PH_PRO = 0, PH_IN0, PH_MIX0, PH_HSCAN, PH_HFIX, PH_OUT0, PH_GU0, PH_DOWN0, PH_IN1, PH_POST, PH_IDX, PH_TOPK, PH_ATTN, PH_OUT1, PH_GU1, PH_DOWN1, NPHASE };
#ifndef ONLYPH
#define ONLYPH -1
#endif
#define PHON(x) (ONLYPH < 0 || ONLYPH == (x))
#ifndef REP_PH
#define REP_PH -1
#endif
#ifndef REP_N
#define REP_N 1
#endif
__global__ void __launch_bounds__(NWAVES * 64, 2) fwd_kernel(Args args) {
    extern __shared__ __attribute__((aligned(16))) unsigned char lds[];
    Ctx c;
    c.lds = (LAS unsigned char*)lds;
    c.MISC = (volatile LAS unsigned*)(c.lds + MISC_OFF);
    c.tid = threadIdx.x; c.lane = c.tid & 63; c.wave = __builtin_amdgcn_readfirstlane(c.tid >> 6);
    c.G = gridDim.x; { const int bx = blockIdx.x; c.vcu = (c.G % 8 == 0) ? (bx % 8) * (c.G / 8) + bx / 8 : bx; }
    c.ctl = (gu32*)(args.ws + WS_CTL);
    for (int u = c.tid; u < (LDS_BYTES - LDSCTL_OFF) / 4; u += NWAVES * 64) ((LAS unsigned*)(c.lds + LDSCTL_OFF))[u] = 0u;
    __syncthreads();
    const int lo = args.ph_lo, hi = args.ph_hi;
    XcdBarrier bar; bar.bar = (unsigned*)(c.ctl + CW_BAR); bar.x = 0; bar.st = nullptr;
    if (hi - lo > 1 || REP_N > 1) bar = xcd_barrier_post((unsigned*)(c.ctl + CW_BAR), c.MISC + 8);
    c.qoff = 0;
#pragma unroll 1
    for (int ph = lo; ph < hi; ++ph) {
        const int layer = ph >= PH_IN1 ? 1 : 0;
        const __attribute__((address_space(4))) Args* ap = (const __attribute__((address_space(4))) Args*)__builtin_amdgcn_kernarg_segment_ptr(); asm volatile("" : "+s"(ap));
        ARGREF la = *ap; unsigned char* const ws = la.ws; float* const out = la.out;
        { int t_ = threadIdx.x; asm volatile("" : "+v"(t_)); c.tid = t_; c.lane = t_ & 63; c.wave = __builtin_amdgcn_readfirstlane(t_ >> 6); }
        if ((ph == PH_DOWN0 || ph == PH_DOWN1) && PHON(PH_OUT0)) {
            pg8::SchedX S0; S0.init(MP, 1024, c.G, (int)blockIdx.x, 0, 0, 1, 0); pg8::Unit u0; if (S0.next(0, u0)) conv_fixup_tile(c, la, layer, u0.pm); VM_WAIT(); __syncthreads(); }
        if (ph == PH_PRO && PHON(PH_PRO)) p0_prologue(c, la);
        else if ((ph == PH_IN0 || ph == PH_IN1) && PHON(PH_IN0)) {
            pg8::Gemm g{(const pg8::bf16_t*)(ws + WS_XB), (const pg8::bf16_t*)(ws + (ph == PH_IN0 ? WS_WIN0 : WS_WIN1)), MT, 0, 1024};
            pg8::SchedX S; if (ph == PH_IN0) S.init(MP, ZC0, c.G, (int)blockIdx.x, 16, MT / 256, 4, 13); else S.init(MP, ZC1, c.G, (int)blockIdx.x, 0, 0, 1, 0);
            pg8::EpiZ E{(pg8::bf16_t*)(ws + WS_Z), ph == PH_IN0 ? ZC0 : ZC1, ssptr(c, ph == PH_IN0 ? 0 : 2), ph == PH_IN0 ? 13 : 9, (float*)(ws + WS_MEMKV), MEMROW0};
            pg8::gemm_phase<pg8::EpiZ, pg8::SchedX, PG8_ALIGN, PG8_SP2>(c.lds + RING_OFF, g, S, E);
            { SgArgs sg{}; sg.A = (const bf16*)(ws + WS_XB) + (size_t)MP * DM; sg.Bt = (const bf16*)(ws + (ph == PH_IN0 ? WS_WIN0 : WS_WIN1)); sg.K = 1024; sg.mode = 0; sg.Z = (bf16*)(ws + WS_Z); sg.ldz = ph == PH_IN0 ? ZC0 : ZC1; sg.ssin = ssptr(c, ph == PH_IN0 ? 0 : 2);
              sgemm_phase(c, sg, ph == PH_IN0 ? ZC0 : ZC1); }
        }
        else if (ph == PH_MIX0 && PHON(PH_MIX0)) p2_mixer0(c, la);
        else if (ph == PH_HSCAN && PHON(PH_HSCAN)) hgrn_scan(c, la);
        else if (ph == PH_HFIX && PHON(PH_HFIX)) p2c_hgrn_fix(c, la);
        else if ((ph == PH_OUT0 || ph == PH_DOWN0 || ph == PH_OUT1 || ph == PH_DOWN1) && PHON(PH_OUT0)) {
            const bool isout = (ph == PH_OUT0 || ph == PH_OUT1);
            pg8::Gemm g{(const pg8::bf16_t*)(ws + (isout ? WS_MIX : WS_ACT)), (const pg8::bf16_t*)(ws + (isout ? WS_WOUT + (size_t)layer * 1024 * 1024 * 2 : WS_WD + (size_t)layer * 1024 * DFF * 2)), MT, 1024, isout ? 1024 : DFF};
            pg8::SchedX S; S.init(MP, 1024, c.G, (int)blockIdx.x, 0, 0, 1, 0);
            pg8::EpiResid E;
            E.rp = ph == PH_OUT0 ? la.in[0] : nullptr; E.rb = (const pg8::bf16_t*)(ws + WS_XB); E.y = ph == PH_DOWN1 ? out + O_YP : nullptr;
            E.xb = ph == PH_DOWN1 ? nullptr : (pg8::bf16_t*)(ws + WS_XB); E.ssout = ph == PH_DOWN1 ? nullptr : ssptr(c, ph == PH_OUT0 ? 1 : (ph == PH_DOWN0 ? 2 : 3));
            pg8::gemm_phase<pg8::EpiResid, pg8::SchedX, PG8_ALIGN, PG8_SP2>(c.lds + RING_OFF, g, S, E);
            { SgArgs sg{}; sg.A = (const bf16*)(ws + (isout ? WS_MIX : WS_ACT)) + (size_t)MP * (isout ? 1024 : DFF); sg.Bt = (const bf16*)g.Bt; sg.K = isout ? 1024 : DFF; sg.mode = 1; sg.rb = (const bf16*)(ws + WS_XB); sg.resid = ph == PH_OUT0 ? la.in[1] : nullptr; sg.y = ph == PH_DOWN1 ? out + O_YS : nullptr; sg.xb = (bf16*)E.xb; sg.ssout = E.ssout;
              sgemm_phase(c, sg, 1024); }
        }
        else if ((ph == PH_GU0 || ph == PH_GU1) && PHON(PH_GU0)) {
            pg8::Gemm g{(const pg8::bf16_t*)(ws + WS_XB), (const pg8::bf16_t*)(ws + WS_WGU + (size_t)layer * 5632 * 1024 * 2), MT, 5632, 1024};
            pg8::SchedX S; S.init(MP, 5632, c.G, (int)blockIdx.x, 0, 0, 1, 0);
            pg8::EpiGU E{(pg8::bf16_t*)(ws + WS_ACT), ssptr(c, layer ? 3 : 1), out + O_CVP + (size_t)layer * 4 * 2 * DFF, la.in[26] + (size_t)layer * 3 * DFF, la.in[27] + (size_t)layer * DFF, (float*)(ws + WS_G4), (float*)(ws + WS_UP2)};
            pg8::gemm_phase<pg8::EpiGU, pg8::SchedX, PG8_ALIGN, PG8_SP2>(c.lds + RING_OFF, g, S, E);
            { SgArgs sg{}; sg.A = (const bf16*)(ws + WS_XB) + (size_t)MP * DM; sg.Bt = (const bf16*)g.Bt; sg.K = 1024; sg.mode = 2; sg.ssin = E.ss; sg.ACT = (bf16*)E.ACT; sg.cvs = out + O_CVS + (size_t)layer * 32 * 2 * DFF; sg.cst = la.in[8] + (size_t)layer * 32 * 2 * DFF; sg.cw = E.cw; sg.cb = E.cb;
              sgemm_phase(c, sg, 5632); }
        }
        else if (ph == PH_POST && PHON(PH_POST)) p8_dsa_post(c, la);
        else if (ph == PH_IDX && PHON(PH_IDX)) p9_indexer(c, la);
        else if (ph == PH_TOPK && PHON(PH_TOPK)) p10_topk(c, la);
        else if (ph == PH_ATTN && PHON(PH_ATTN)) p11_attention(c, la);
        if (REP_N > 1 && ph == REP_PH && c.qoff < 4 * (REP_N - 1)) { c.qoff += 4; --ph; xcd_barrier(bar); continue; }
        if (REP_N > 1) c.qoff = 0;
        if (ph + 1 < hi) xcd_barrier(bar);
    }
}

#ifndef MK_ONE_LAUNCH
#define MK_ONE_LAUNCH 1
#endif
extern "C" void kernel_launch(void* const* d_in, const int* in_sizes, int n_in, void* d_out, int out_size, void* d_ws, size_t ws_size, hipStream_t stream) {
    static int grid = 0;
    if (grid == 0) {
        if (n_in != 29 || out_size != (int)O_END || ws_size < WS_END) { fprintf(stderr, "kernel_launch: unexpected problem (n_in %d, out %d, ws %zu)\n", n_in, out_size, ws_size); grid = -1; return; }
        int dev = 0, cus = 0;
        if (hipGetDevice(&dev) != hipSuccess || hipDeviceGetAttribute(&cus, hipDeviceAttributeMultiprocessorCount, dev) != hipSuccess) { grid = -1; return; }
        if (hipFuncSetAttribute((const void*)fwd_kernel, hipFuncAttributeMaxDynamicSharedMemorySize, LDS_BYTES) != hipSuccess) { fprintf(stderr, "kernel_launch: hipFuncSetAttribute failed\n"); grid = -1; return; }
        (void)hipGetLastError();
        grid = cus;
    }
    if (grid < 0) return;
    if (hipMemsetAsync((char*)d_ws + WS_CTL, 0, CTL_ZERO_BYTES, stream) != hipSuccess) { fprintf(stderr, "kernel_launch: memset failed\n"); return; }
    Args a{};
    for (int i = 0; i < 29; ++i) a.in[i] = (const float*)d_in[i];
    a.page_table = (const int*)d_in[9]; a.out = (float*)d_out; a.ws = (unsigned char*)d_ws;
#if MK_ONE_LAUNCH
    a.ph_lo = 0; a.ph_hi = NPHASE;
    hipLaunchKernelGGL(fwd_kernel, dim3(grid), dim3(NWAVES * 64), LDS_BYTES, stream, a);
#else
    for (int ph = 0; ph < NPHASE; ++ph) { a.ph_lo = ph; a.ph_hi = ph + 1; hipLaunchKernelGGL(fwd_kernel, dim3(grid), dim3(NWAVES * 64), LDS_BYTES, stream, a); }
#endif
}
```

```cpp
#include <hip/hip_runtime.h>
#include <cstdio>
#include <cstdint>


namespace pg8 {
#define PG8_LAS __attribute__((address_space(3)))
typedef unsigned short bf16_t;
typedef short bf16x8 __attribute__((ext_vector_type(8)));
typedef float f32x4 __attribute__((ext_vector_type(4)));
typedef unsigned u32x4 __attribute__((ext_vector_type(4)));
constexpr int BM = 256, BK = 64, HALF = 128, HTB = HALF * BK * 2  , STAGE_BYTES = 8 * HTB, NXCD = 8, WGM = 8;

__host__ __device__ __forceinline__ int lds_byte(int r, int c) { const int st = (r >> 4) * 2 + (c >> 5), rr = r & 15, cc = c & 31, ob = rr * 64 + cc * 2; return st * 1024 + (ob ^ (((ob >> 9) & 1) << 5)); }
__host__ __device__ __forceinline__ void stage_rc(int b, int& R, int& C) { const int st = b / 1024, sb = b % 1024, swz = sb ^ (((sb >> 9) & 1) << 5); R = (st >> 1) * 16 + swz / 64; C = (st & 1) * 32 + (swz % 64) / 2; }
__host__ __device__ __forceinline__ int perm32(int rho) { const int n = rho >> 4, i = rho & 15; return 8 * (i >> 2) + 4 * n + (i & 3); }

struct Unit { int pm, pn; };
struct Gemm { const bf16_t* A; const bf16_t* Bt; int M, N, K; };

struct StaticOrder {
    int nM, nN, nwg, G, c;
    __host__ __device__ __forceinline__ void init(int M, int N, int G_, int c_) { nM = M / BM; nN = N / BM; nwg = nM * nN; G = G_; c = c_; }
    __host__ __device__ __forceinline__ bool next(int i, Unit& u) const {
        const long L = (long)i * G + c; if (L >= nwg) return false;
        int wgid = (int)L; { const int q = nwg / NXCD, r = nwg % NXCD, xcd = wgid % NXCD, off = wgid / NXCD; wgid = (xcd < r ? xcd * (q + 1) : r * (q + 1) + (xcd - r) * q) + off; }
        const int nig = WGM * nN, gid = wgid / nig, fm = gid * WGM, gsz = (nM - fm) < WGM ? (nM - fm) : WGM;
        u.pm = fm + ((wgid % nig) % gsz); u.pn = (wgid % nig) / gsz; return true;
    }
    __device__ __forceinline__ void a_ready(const Unit&) const {}
    __device__ __forceinline__ void done(const Unit&) const {}
};


constexpr int MP = 16384, MS = 128, MVALID = MP + MS, MT = 16640, DM = 1024, DFF = 2816;
constexpr float RMS_EPS = 1e-6f;
__device__ __forceinline__ unsigned cvt_pk_bf16(float lo, float hi) { unsigned r; asm volatile("v_cvt_pk_bf16_f32 %0, %1, %2" : "=v"(r) : "v"(lo), "v"(hi)); return r; }

struct SchedX {
    StaticOrder so; int nextra, e_pm0, e_nm, e_pn0;
    __device__ __forceinline__ void init(int M, int N, int G_, int c_, int nextra_, int e_pm0_, int e_nm_, int e_pn0_) { so.init(M, N, G_, c_); nextra = nextra_; e_pm0 = e_pm0_; e_nm = e_nm_; e_pn0 = e_pn0_; }
    __device__ __forceinline__ bool next(int i, Unit& u) const {
        const long L = (long)i * so.G + so.c;
        if (L < so.nwg) return so.next(i, u);
        const int e = (int)(L - so.nwg); if (e >= nextra) return false;
        u.pm = e_pm0 + e % e_nm; u.pn = e_pn0 + e / e_nm; return true;
    }
    __device__ __forceinline__ void a_ready(const Unit&) const {}
    __device__ __forceinline__ void done(const Unit&) const {}
};

struct EpiZ {
    static constexpr bool PERM = true, AFTER_DRAIN = false;
    bf16_t* Z; int ldz; const float* ss; int nmain; float* memkv; int memrow0;
    __device__ __forceinline__ void operator()(const f32x4 (&acc)[2][2][4][2], const Unit& u, int wr, int wc, int fr, int fq) const {
        const int row0 = u.pm * BM + wr * 64 + fr;
        if (u.pn < nmain) {
            const int col0 = u.pn * BM + wc * 32 + 8 * fq;
#pragma unroll
            for (int ai = 0; ai < 2; ++ai)
#pragma unroll
                for (int m = 0; m < 4; ++m) { const int row = row0 + ai * HALF + m * 16; const float rs = rsqrtf(ss[row] * (1.0f / DM) + RMS_EPS);
#pragma unroll
                    for (int bj = 0; bj < 2; ++bj) { const f32x4 v0 = acc[ai][bj][m][0] * rs, v1 = acc[ai][bj][m][1] * rs;
                        u32x4 w; w.x = cvt_pk_bf16(v0[0], v0[1]); w.y = cvt_pk_bf16(v0[2], v0[3]); w.z = cvt_pk_bf16(v1[0], v1[1]); w.w = cvt_pk_bf16(v1[2], v1[3]);
                        *(u32x4*)(Z + (size_t)row * ldz + col0 + bj * HALF) = w; } }
        } else {
            const int col0 = (u.pn - nmain) * BM + wc * 32 + 8 * fq;
#pragma unroll
            for (int ai = 0; ai < 2; ++ai)
#pragma unroll
                for (int m = 0; m < 4; ++m) { const int row = row0 + ai * HALF + m * 16 - memrow0;
#pragma unroll
                    for (int bj = 0; bj < 2; ++bj) { float* p = memkv + (size_t)row * 1024 + col0 + bj * HALF; *(f32x4*)p = acc[ai][bj][m][0]; *(f32x4*)(p + 4) = acc[ai][bj][m][1]; } }
        }
    }
};

struct EpiResid {
    static constexpr bool PERM = true, AFTER_DRAIN = false;
    const float* rp; const bf16_t* rb; float* y; bf16_t* xb; float* ssout;
    __device__ __forceinline__ void operator()(const f32x4 (&acc)[2][2][4][2], const Unit& u, int wr, int wc, int fr, int fq) const {
        const int row0 = u.pm * BM + wr * 64 + fr, col0 = u.pn * BM + wc * 32 + 8 * fq;
#pragma unroll
        for (int ai = 0; ai < 2; ++ai)
#pragma unroll
            for (int m = 0; m < 4; ++m) { const int row = row0 + ai * HALF + m * 16; float part = 0.f;
#pragma unroll
                for (int bj = 0; bj < 2; ++bj) { const int c = col0 + bj * HALF; f32x4 r0, r1;
                    if (rp) { r0 = *(const f32x4*)(rp + (size_t)row * DM + c); r1 = *(const f32x4*)(rp + (size_t)row * DM + c + 4); }
                    else { const u32x4 q = *(const u32x4*)(rb + (size_t)row * DM + c);
                        r0 = (f32x4){__builtin_bit_cast(float, q.x << 16), __builtin_bit_cast(float, q.x & 0xffff0000u), __builtin_bit_cast(float, q.y << 16), __builtin_bit_cast(float, q.y & 0xffff0000u)};
                        r1 = (f32x4){__builtin_bit_cast(float, q.z << 16), __builtin_bit_cast(float, q.z & 0xffff0000u), __builtin_bit_cast(float, q.w << 16), __builtin_bit_cast(float, q.w & 0xffff0000u)}; }
                    const f32x4 v0 = acc[ai][bj][m][0] + r0, v1 = acc[ai][bj][m][1] + r1;
                    if (y) { *(f32x4*)(y + (size_t)row * DM + c) = v0; *(f32x4*)(y + (size_t)row * DM + c + 4) = v1; }
                    part += (v0[0] * v0[0] + v0[1] * v0[1]) + (v0[2] * v0[2] + v0[3] * v0[3]) + (v1[0] * v1[0] + v1[1] * v1[1]) + (v1[2] * v1[2] + v1[3] * v1[3]);
                    if (xb) { u32x4 w; w.x = cvt_pk_bf16(v0[0], v0[1]); w.y = cvt_pk_bf16(v0[2], v0[3]); w.z = cvt_pk_bf16(v1[0], v1[1]); w.w = cvt_pk_bf16(v1[2], v1[3]);
                        *(u32x4*)(xb + (size_t)row * DM + c) = w; } }
                part += __shfl_xor(part, 16); part += __shfl_xor(part, 32);
                if (ssout && fq == 0) atomicAdd(ssout + row, part); }
    }
};

__device__ __forceinline__ void dpp_ror12(const f32x4& v, f32x4& r1, f32x4& r2) {
    float a0, a1, a2, a3, b0, b1, b2, b3;
    asm volatile("s_nop 1\n\t"
                 "v_mov_b32_dpp %0, %8 row_ror:1 row_mask:0xf bank_mask:0xf\n\tv_mov_b32_dpp %1, %9 row_ror:1 row_mask:0xf bank_mask:0xf\n\t"
                 "v_mov_b32_dpp %2, %10 row_ror:1 row_mask:0xf bank_mask:0xf\n\tv_mov_b32_dpp %3, %11 row_ror:1 row_mask:0xf bank_mask:0xf\n\t"
                 "v_mov_b32_dpp %4, %8 row_ror:2 row_mask:0xf bank_mask:0xf\n\tv_mov_b32_dpp %5, %9 row_ror:2 row_mask:0xf bank_mask:0xf\n\t"
                 "v_mov_b32_dpp %6, %10 row_ror:2 row_mask:0xf bank_mask:0xf\n\tv_mov_b32_dpp %7, %11 row_ror:2 row_mask:0xf bank_mask:0xf"
                 : "=&v"(a0), "=&v"(a1), "=&v"(a2), "=&v"(a3), "=&v"(b0), "=&v"(b1), "=&v"(b2), "=&v"(b3) : "v"(v[0]), "v"(v[1]), "v"(v[2]), "v"(v[3]));
    r1 = (f32x4){a0, a1, a2, a3}; r2 = (f32x4){b0, b1, b2, b3};
}
struct EpiGU {
    static constexpr bool PERM = true, AFTER_DRAIN = false;
    bf16_t* ACT; const float* ss; float* cvp; const float* cw; const float* cb; float* G4; float* UP2;
    __device__ __forceinline__ void operator()(const f32x4 (&acc)[2][2][4][2], const Unit& u, int wr, int wc, int fr, int fq) const {
        const int row0 = u.pm * BM + wr * 64 + fr, colg = u.pn * HALF + wc * 32 + 8 * fq;
#pragma unroll
        for (int n = 0; n < 2; ++n) { const int col = colg + 4 * n;
            const f32x4 w0 = *(const f32x4*)(cw + col), w1 = *(const f32x4*)(cw + DFF + col), w2 = *(const f32x4*)(cw + 2 * DFF + col), bb = *(const f32x4*)(cb + col);
#pragma unroll
            for (int ai = 0; ai < 2; ++ai) { f32x4 r1p = {0.f, 0.f, 0.f, 0.f}, r2p = r1p; const int slab = (u.pm * BM + ai * HALF + wr * 64) >> 6;
#pragma unroll
                for (int m = 0; m < 4; ++m) { const int row = row0 + ai * HALF + m * 16; const float rs = rsqrtf(ss[row] * (1.0f / DM) + RMS_EPS);
                    const f32x4 g = acc[ai][0][m][n] * rs, up = acc[ai][1][m][n] * rs;
                    f32x4 r1, r2; dpp_ror12(g, r1, r2);
                    const f32x4 p1 = fr >= 1 ? r1 : r1p, p2 = fr >= 2 ? r2 : r2p;
                    f32x4 cv = bb + w0 * p2 + w1 * p1 + w2 * g, y;
#pragma unroll
                    for (int i = 0; i < 4; ++i) y[i] = cv[i] * __builtin_amdgcn_rcpf(1.0f + __expf(-cv[i])) * up[i];
                    if (m == 0 && fr < 2) { *(f32x4*)(G4 + (size_t)(slab * 4 + fr) * DFF + col) = g; *(f32x4*)(UP2 + (size_t)(slab * 2 + fr) * DFF + col) = up; }
                    else { typedef unsigned u32x2 __attribute__((ext_vector_type(2))); u32x2 w; w.x = cvt_pk_bf16(y[0], y[1]); w.y = cvt_pk_bf16(y[2], y[3]); *(u32x2*)(ACT + (size_t)row * DFF + col) = w; }
                    if (m == 3 && fr >= 14) { *(f32x4*)(G4 + (size_t)(slab * 4 + 2 + (fr - 14)) * DFF + col) = g;
                        const int t = row & 4095; if (t >= 4094) *(f32x4*)(cvp + (size_t)((row >> 12) * 2 + (t - 4094)) * DFF + col) = g; }
                    r1p = r1; r2p = r2; } } }
    }
};

template <class Epi, class Sched, bool ALIGN_EPI = false, bool SP2 = false>
__device__ __forceinline__ void gemm_phase(PG8_LAS unsigned char* lds, const Gemm g, const Sched& S, const Epi& E) {
    int tid_ = threadIdx.x; asm volatile("" : "+v"(tid_));
    const int tid = tid_, wid = __builtin_amdgcn_readfirstlane(tid >> 6), lane = tid & 63, wr = wid >> 2, wc = wid & 3, fr = lane & 15, fq = lane >> 4;
    const int K = g.K, nt = K / BK;
    unsigned voffA[2], voffB[2];
#pragma unroll
    for (int i = 0; i < 2; ++i) { int R, C; stage_rc(tid * 16 + i * 8192, R, C); const int Rb = Epi::PERM ? ((R & ~31) + perm32(R & 31)) : R;
        voffA[i] = (unsigned)(R * K + C) * 2u; voffB[i] = (unsigned)(Rb * K + C) * 2u; }
    const size_t kstep = (size_t)(BK * 2);
    const size_t hstep = (size_t)HALF * K * 2;
    const size_t tstep = 2 * hstep;
    const unsigned ldsw = (unsigned)wid * 1024u;
    const int aoff = lds_byte(wr * 64 + fr, fq * 8), boff = lds_byte(wc * 32 + fr, fq * 8);
#define PG8_SA(b, h) (((b) * 2 + (h)) * HTB)
#define PG8_SB(b, h) ((4 + (b) * 2 + (h)) * HTB)
#define PG8_STAGE(bufoff, gbase, voff) do { _Pragma("unroll") for (int _i = 0; _i < 2; ++_i) \
        __builtin_amdgcn_global_load_lds((const unsigned*)((const char*)(gbase) + (voff)[_i]), (PG8_LAS unsigned*)(lds + (bufoff) + ldsw + _i * 8192), 16, 0, 0); } while (0)
#define PG8_LDA(dst, b, h) do { _Pragma("unroll") for (int m = 0; m < 4; ++m) _Pragma("unroll") for (int k = 0; k < 2; ++k) dst[m][k] = *(const PG8_LAS bf16x8*)(lds + PG8_SA(b, h) + aoff + m * 2048 + k * 1024); } while (0)
#define PG8_LDB(dst, b, h) do { _Pragma("unroll") for (int n = 0; n < 2; ++n) _Pragma("unroll") for (int k = 0; k < 2; ++k) dst[n][k] = *(const PG8_LAS bf16x8*)(lds + PG8_SB(b, h) + boff + n * 2048 + k * 1024); } while (0)
#define PG8_MMA(ai, bj, At, Bt) do { __builtin_amdgcn_s_setprio(1); _Pragma("unroll") for (int m = 0; m < 4; ++m) _Pragma("unroll") for (int n = 0; n < 2; ++n) _Pragma("unroll") for (int k = 0; k < 2; ++k) \
        acc[ai][bj][m][n] = __builtin_amdgcn_mfma_f32_16x16x32_bf16(Bt[n][k], At[m][k], acc[ai][bj][m][n], 0, 0, 0); __builtin_amdgcn_s_setprio(0); } while (0)
#define PG8_WAIT_V(n) asm volatile("s_waitcnt vmcnt(" #n ")" ::: "memory")
#define PG8_WAIT_L(n) asm volatile("s_waitcnt lgkmcnt(" #n ")" ::: "memory")
#define PG8_BAR __builtin_amdgcn_s_barrier()
#define PG8_SCHED __builtin_amdgcn_sched_barrier(0)
    Unit cur, nxt; int ui = 0;
    if (!S.next(0, cur)) return;
    f32x4 acc[2][2][4][2];
#pragma unroll
    for (int a = 0; a < 2; ++a)
#pragma unroll
        for (int b = 0; b < 2; ++b)
#pragma unroll
            for (int m = 0; m < 4; ++m)
#pragma unroll
                for (int n = 0; n < 2; ++n) acc[a][b][m][n] = (f32x4){0.f, 0.f, 0.f, 0.f};
    bf16x8 At[4][2], B0[2][2], B1[2][2];
    const char* cA = (const char*)g.A + (size_t)cur.pm * tstep; const char* cB = (const char*)g.Bt + (size_t)cur.pn * tstep;
    S.a_ready(cur);
    if constexpr (SP2) {
        PG8_STAGE(PG8_SB(0, 0), cB, voffB); PG8_STAGE(PG8_SB(0, 1), cB + hstep, voffB); PG8_STAGE(PG8_SA(0, 0), cA, voffA); PG8_STAGE(PG8_SA(0, 1), cA + hstep, voffA);
        if (wr == 1) PG8_BAR;
        PG8_WAIT_V(2); PG8_BAR;
        PG8_STAGE(PG8_SB(1, 0), cB + kstep, voffB); PG8_STAGE(PG8_SA(1, 0), cA + kstep, voffA); PG8_STAGE(PG8_SB(1, 1), cB + hstep + kstep, voffB);
        PG8_WAIT_V(6); PG8_BAR;
    } else {
        PG8_STAGE(PG8_SB(0, 0), cB, voffB); PG8_STAGE(PG8_SA(0, 0), cA, voffA); PG8_STAGE(PG8_SB(0, 1), cB + hstep, voffB); PG8_STAGE(PG8_SA(0, 1), cA + hstep, voffA);
        if (wr == 1) PG8_BAR;
        PG8_WAIT_V(4); PG8_BAR;
        PG8_STAGE(PG8_SB(1, 0), cB + kstep, voffB); PG8_STAGE(PG8_SA(1, 0), cA + kstep, voffA); PG8_STAGE(PG8_SB(1, 1), cB + hstep + kstep, voffB);
        PG8_WAIT_V(6); PG8_BAR;
    }
    for (;;) {
        const bool has_next = S.next(ui + 1, nxt);
        const char* nA = has_next ? (const char*)g.A + (size_t)nxt.pm * tstep : cA; const char* nB = has_next ? (const char*)g.Bt + (size_t)nxt.pn * tstep : cB;
        for (int t = 0; t < nt; t += 2) {
            const bool last = (t == nt - 2);
            const char* a1 = cA + (size_t)(t + 1) * kstep;
            const char* a2 = last ? nA : cA + (size_t)(t + 2) * kstep; const char* b2 = last ? nB : cB + (size_t)(t + 2) * kstep;
            const char* a3 = a2 + kstep; const char* b3 = b2 + kstep;
            if (last && has_next) S.a_ready(nxt);
            if constexpr (SP2) {
            PG8_LDB(B0, 0, 0); PG8_LDB(B1, 0, 1); PG8_SCHED; PG8_LDA(At, 0, 0); PG8_STAGE(PG8_SA(1, 1), a1 + hstep, voffA);
            PG8_WAIT_V(8); PG8_WAIT_L(0); PG8_BAR; PG8_MMA(0, 0, At, B0); PG8_MMA(0, 1, At, B1); PG8_BAR; PG8_SCHED;
            PG8_LDA(At, 0, 1); PG8_STAGE(PG8_SB(0, 0), b2, voffB); PG8_STAGE(PG8_SB(0, 1), b2 + hstep, voffB); PG8_STAGE(PG8_SA(0, 0), a2, voffA);
            PG8_WAIT_V(8); PG8_WAIT_L(0); PG8_BAR; PG8_MMA(1, 0, At, B0); PG8_MMA(1, 1, At, B1); PG8_BAR; PG8_SCHED;
            PG8_LDB(B0, 1, 0); PG8_LDB(B1, 1, 1); PG8_SCHED; PG8_LDA(At, 1, 0); PG8_STAGE(PG8_SA(0, 1), a2 + hstep, voffA);
            PG8_WAIT_V(8); PG8_WAIT_L(0); PG8_BAR; PG8_MMA(0, 0, At, B0); PG8_MMA(0, 1, At, B1); PG8_BAR; PG8_SCHED;
            PG8_LDA(At, 1, 1); PG8_STAGE(PG8_SB(1, 0), b3, voffB); PG8_STAGE(PG8_SB(1, 1), b3 + hstep, voffB); PG8_STAGE(PG8_SA(1, 0), a3, voffA);
            PG8_WAIT_V(8); PG8_WAIT_L(0); PG8_BAR; PG8_MMA(1, 0, At, B0); PG8_MMA(1, 1, At, B1); PG8_BAR; PG8_SCHED;
            } else {
            PG8_LDB(B0, 0, 0); PG8_SCHED; PG8_LDA(At, 0, 0); PG8_STAGE(PG8_SA(1, 1), a1 + hstep, voffA);
            PG8_WAIT_L(8); PG8_BAR; PG8_WAIT_L(0); PG8_MMA(0, 0, At, B0); PG8_BAR; PG8_SCHED;
            PG8_LDB(B1, 0, 1); PG8_STAGE(PG8_SB(0, 0), b2, voffB);
            PG8_BAR; PG8_WAIT_L(0); PG8_MMA(0, 1, At, B1); PG8_BAR;
            PG8_LDA(At, 0, 1); PG8_STAGE(PG8_SA(0, 0), a2, voffA);
            PG8_BAR; PG8_WAIT_L(0); PG8_MMA(1, 0, At, B0); PG8_BAR; PG8_SCHED;
            PG8_STAGE(PG8_SB(0, 1), b2 + hstep, voffB);
            PG8_WAIT_V(6); PG8_BAR; PG8_MMA(1, 1, At, B1); PG8_BAR;
            PG8_LDB(B0, 1, 0); PG8_SCHED; PG8_LDA(At, 1, 0); PG8_STAGE(PG8_SA(0, 1), a2 + hstep, voffA);
            PG8_WAIT_L(8); PG8_BAR; PG8_WAIT_L(0); PG8_MMA(0, 0, At, B0); PG8_BAR; PG8_SCHED;
            PG8_LDB(B1, 1, 1); PG8_STAGE(PG8_SB(1, 0), b3, voffB);
            PG8_BAR; PG8_WAIT_L(0); PG8_MMA(0, 1, At, B1); PG8_BAR;
            PG8_LDA(At, 1, 1); PG8_STAGE(PG8_SA(1, 0), a3, voffA);
            PG8_BAR; PG8_WAIT_L(0); PG8_MMA(1, 0, At, B0); PG8_BAR; PG8_SCHED;
            PG8_STAGE(PG8_SB(1, 1), b3 + hstep, voffB);
            PG8_WAIT_V(6); PG8_BAR; PG8_MMA(1, 1, At, B1); PG8_BAR;
            }
        }
        if constexpr (ALIGN_EPI) { if (wr == 0) PG8_BAR; }
        if constexpr (!Epi::AFTER_DRAIN) { E(acc, cur, wr, wc, fr, fq); S.done(cur); }
        if (!has_next) break;
#pragma unroll
        for (int a = 0; a < 2; ++a)
#pragma unroll
            for (int b = 0; b < 2; ++b)
#pragma unroll
                for (int m = 0; m < 4; ++m)
#pragma unroll
                    for (int n = 0; n < 2; ++n) acc[a][b][m][n] = (f32x4){0.f, 0.f, 0.f, 0.f};
        cur = nxt; cA = nA; cB = nB; ++ui;
        if constexpr (ALIGN_EPI) { if (wr == 1) PG8_BAR; }
    }
    PG8_WAIT_V(0);
    if constexpr (!ALIGN_EPI) { if (wr == 0) PG8_BAR; }
    PG8_BAR;
    if constexpr (Epi::AFTER_DRAIN) { E.fused(acc, cur, wr, wc, fr, fq, lds, wid, lane); S.done(cur); }
#undef PG8_SA
#undef PG8_SB
#undef PG8_STAGE
#undef PG8_LDA
#undef PG8_LDB
#undef PG8_MMA
#undef PG8_WAIT_V
#undef PG8_WAIT_L
#undef PG8_BAR
#undef PG8_SCHED
}
}


#ifndef PG8_SP2
#define PG8_SP2 true
#endif
#ifndef PG8_ALIGN
#define PG8_ALIGN true
#endif
constexpr int NWAVES = 8;
constexpr int MP = pg8::MP, MS = pg8::MS, MVALID = pg8::MVALID, MT = pg8::MT, DM = 1024, DFF = 2816;
constexpr int SEQ = 4096, NB = 4, NSB = 32, PAST = 8192, NPOOL = 2560;
constexpr int ZC0 = 3328, ZC1 = 2304;
constexpr int Z1_Q = 0, Z1_K = 768, Z1_V = 1024, Z1_IQ = 1280, Z1_IK = 1792, Z1_IW = 1856, Z1_MQ = 1920;
constexpr int NMEMROWS = 1024, MEMROW0 = MT;
constexpr float EPS = 1e-6f;
constexpr size_t MiB = 1u << 20;
constexpr size_t WS_CTL = 0, CTL_ZERO_BYTES = 2 * MiB;
constexpr size_t WS_WIN0 = 2 * MiB, WS_WIN1 = 11 * MiB, WS_WOUT = 16 * MiB, WS_WGU = 20 * MiB, WS_WD = 42 * MiB;
constexpr size_t WS_XB = 54 * MiB, WS_MEMKV = 89 * MiB, WS_MIX = 94 * MiB, WS_Z = 128 * MiB, WS_U = 234 * MiB, WS_UP = 324 * MiB, WS_ACT = 414 * MiB;
constexpr size_t WS_QB = 504 * MiB, WS_KB = 528 * MiB, WS_VB = 536 * MiB, WS_IQB = 544 * MiB, WS_IKB = 560 * MiB, WS_IW = 562 * MiB;
constexpr size_t WS_SQ = 563 * MiB, WS_SIQ = WS_SQ + 512 * 1024, WS_SIW = WS_SIQ + 384 * 1024, WS_SSC = 564 * MiB, WS_SIDX = 569 * MiB, WS_MASK = 570 * MiB, WS_SC = 578 * MiB, WS_END = 834 * MiB;
constexpr int SSC_LD = 8256;
constexpr int CW_TMO = 0, CW_BAR = 4096, CW_Q = 8192, CW_SS = 16384;
constexpr size_t O_YP = 0, O_YS = O_YP + (size_t)MP * DM, O_HP = O_YS + (size_t)MS * DM, O_HS = O_HP + 4 * 6 * 16384, O_KP = O_HS + 32 * 6 * 16384,
    O_VP = O_KP + (size_t)MP * 256, O_IKP = O_VP + (size_t)MP * 256, O_KS = O_IKP + (size_t)MP * 64, O_VS = O_KS + MS * 256, O_IKS = O_VS + MS * 256,
    O_MK = O_IKS + MS * 64, O_MV = O_MK + 2 * 1024 * 256, O_CVP = O_MV + 2 * 1024 * 256, O_CVS = O_CVP + 2 * 4 * 2 * DFF, O_END = O_CVS + 2 * 32 * 2 * DFF;
static_assert(O_END == 31412224, "output size");
constexpr int RING_OFF = 0, RING_BYTES = 131072;
constexpr int LDSCTL_OFF = RING_BYTES, MISC_OFF = LDSCTL_OFF + 320;
constexpr int LDS_BYTES = 147456;

#define GAS __attribute__((address_space(1)))
#define LAS __attribute__((address_space(3)))
typedef unsigned short bf16;
typedef unsigned v4u __attribute__((ext_vector_type(4)));
typedef float f32x4 __attribute__((ext_vector_type(4)));
typedef short bf16x8 __attribute__((ext_vector_type(8)));
typedef GAS unsigned gu32;
typedef GAS unsigned long long gu64;
#define RLX_AGENT __ATOMIC_RELAXED, __HIP_MEMORY_SCOPE_AGENT
#define LDS_WAIT() asm volatile("s_waitcnt lgkmcnt(0)" ::: "memory")
#define VM_WAIT() asm volatile("s_waitcnt vmcnt(0)" ::: "memory")
__device__ __forceinline__ unsigned long long rt() { return __builtin_amdgcn_s_memrealtime(); }
__device__ __forceinline__ unsigned f2bf(float f) { unsigned u = __builtin_bit_cast(unsigned, f); return (u + 0x7fffu + ((u >> 16) & 1u)) >> 16; }
__device__ __forceinline__ unsigned pk2(float lo, float hi) { return f2bf(lo) | (f2bf(hi) << 16); }

#define XB_TMO      128
#define XB_XCNT(j)  (256  + 64 * (j))
#define XB_XSUB(j)  (1280 + 64 * (j))
#define XB_XGEN(j)  (2304 + 64 * (j))
#define XB_TOP      3328
#define XB_TOPGEN   3392
#define XCD_BAR_WORDS 3456
#define XB_SPIN_CAP (1u << 18)

__device__ __forceinline__ unsigned xb_ld(unsigned* p)              { return __hip_atomic_load(p, __ATOMIC_RELAXED, __HIP_MEMORY_SCOPE_AGENT); }
__device__ __forceinline__ unsigned xb_add(unsigned* p, unsigned v) { return __hip_atomic_fetch_add(p, v, __ATOMIC_RELAXED, __HIP_MEMORY_SCOPE_AGENT); }
__device__ __forceinline__ unsigned xb_xcc_id() { return (unsigned)__builtin_amdgcn_s_getreg((3 << 11) | 20) & 0xFu; }
#define XB_SPIN(cond, bar) do { unsigned _sp = 0; while (cond) { __builtin_amdgcn_s_sleep(1); \
    if ((++_sp & 255u) == 0u) { if (xb_ld(&(bar)[XB_TMO])) break; if (_sp > XB_SPIN_CAP) { atomicAdd(&(bar)[XB_TMO], 1u); break; } } } } while (0)

struct XcdBarrier {
    unsigned* bar; unsigned x;
    volatile LAS unsigned* st;
};

__device__ __forceinline__ XcdBarrier xcd_barrier_post(unsigned* bar, volatile LAS unsigned* st) {
    XcdBarrier b; b.bar = bar; b.x = xb_xcc_id(); b.st = st;
    if (threadIdx.x == 0) (void)xb_add(&bar[XB_XCNT(b.x)], 1u);
    return b;
}
__device__ __forceinline__ void xcd_barrier_complete(unsigned* bar, unsigned x, unsigned& nloc, unsigned& nx) {
    const unsigned G = gridDim.x * gridDim.y * gridDim.z;
    unsigned sum, cnt, mine, sp = 0u;
    for (;;) {
        sum = 0u; cnt = 0u; mine = 0u;
#pragma unroll
        for (unsigned j = 0; j < 16; ++j) { const unsigned c = xb_ld(&bar[XB_XCNT(j)]); sum += c; cnt += (c > 0u) ? 1u : 0u; mine = (j == x) ? c : mine; }
        if (sum == G) break;
        __builtin_amdgcn_s_sleep(1);
        if ((++sp & 255u) == 0u) { if (xb_ld(&bar[XB_TMO])) break; if (sp > XB_SPIN_CAP) { atomicAdd(&bar[XB_TMO], 1u); break; } }
    }
    nloc = mine > 0u ? mine : 1u; nx = cnt > 0u ? cnt : 1u;
}

__device__ __forceinline__ void xcd_barrier(const XcdBarrier& b) {
    asm volatile("s_waitcnt vmcnt(0)" ::: "memory");
    __syncthreads();
    if (threadIdx.x == 0) {
        unsigned* bar = b.bar;
        __builtin_amdgcn_s_waitcnt(0);
        unsigned nloc = b.st[0], nx = b.st[1];
        if (nloc == 0u) { xcd_barrier_complete(bar, b.x, nloc, nx); b.st[0] = nloc; b.st[1] = nx; }
        const unsigned old = xb_add(&bar[XB_XSUB(b.x)], 1u);
        const unsigned gen = old / nloc;
        if (old + 1u == (gen + 1u) * nloc) {
            __builtin_amdgcn_fence(__ATOMIC_RELEASE, "agent");
            asm volatile("s_waitcnt vmcnt(0)" ::: "memory");
            const unsigned og = xb_add(&bar[XB_TOP], 1u);
            const unsigned tg = og / nx;
            if (og + 1u == (tg + 1u) * nx) xb_add(&bar[XB_TOPGEN], 1u);
            else XB_SPIN(xb_ld(&bar[XB_TOPGEN]) == tg, bar);
            __builtin_amdgcn_fence(__ATOMIC_ACQUIRE, "agent");
            xb_add(&bar[XB_XGEN(b.x)], 1u);
            asm volatile("s_waitcnt vmcnt(0)" ::: "memory");
        } else {
            XB_SPIN(xb_ld(&bar[XB_XGEN(b.x)]) == gen, bar);
            __builtin_amdgcn_fence(__ATOMIC_ACQUIRE, "agent");
            asm volatile("s_waitcnt vmcnt(0)" ::: "memory");
        }
    }
    __syncthreads();
}


struct Args { const float* in[29]; const int* page_table; float* out; unsigned char* ws; int ph_lo, ph_hi; };
typedef const __attribute__((address_space(4))) Args& ARGREF;
struct Ctx { LAS unsigned char* lds; volatile LAS unsigned* MISC; gu32* ctl; int tid, lane, wave, vcu, G, qoff; };
typedef float f32x16 __attribute__((ext_vector_type(16)));
typedef unsigned long long u64;

__device__ __forceinline__ float bf2f(unsigned b) { return __builtin_bit_cast(float, b << 16); }
__device__ __forceinline__ float wave_sum(float v) {
#pragma unroll
    for (int o = 1; o < 64; o <<= 1) v += __shfl_xor(v, o);
    return v;
}
__device__ __forceinline__ int crow(int r, int hi) { return (r & 3) + 8 * (r >> 2) + 4 * hi; }
__device__ __forceinline__ float sigmoidf_(float x) { return 1.0f / (1.0f + __expf(-x)); }
__device__ __forceinline__ float* ssptr(const Ctx& c, int i) { return (float*)(c.ctl + CW_SS) + (size_t)i * MT; }

__device__ __forceinline__ int q_next(Ctx& c, int qi) {
    __syncthreads();
    if (c.tid == 0) c.MISC[16] = atomicAdd((unsigned*)(c.ctl + CW_Q + 64 * (qi + c.qoff)), 1u);
    __syncthreads();
    return (int)c.MISC[16];
}

template <int K>
__device__ __forceinline__ f32x16 mm32(const LAS bf16* A, int lda, const LAS bf16* Bt, int ldb, f32x16 acc, int lane) {
    const int r = lane & 31, h = lane >> 5;
#pragma unroll
    for (int ks = 0; ks < K; ks += 16) {
        const bf16x8 a = *(const LAS bf16x8*)(A + r * lda + ks + 8 * h);
        const bf16x8 b = *(const LAS bf16x8*)(Bt + r * ldb + ks + 8 * h);
        acc = __builtin_amdgcn_mfma_f32_32x32x16_bf16(a, b, acc, 0, 0, 0);
    }
    return acc;
}

__device__ __forceinline__ int map_row(int mapid, int n, int row_off) {
    if (mapid == 0) return n + row_off;
    if (mapid == 1) return n < 1864 ? n : n + 56;
    if (mapid == 2) return (n >> 7) * 256 + (n & 127);
    return (n >> 7) * 256 + 128 + (n & 127);
}
__device__ __forceinline__ void transpose_item(const float* W, int K, int N, const float* kscale, bf16* WT, int mapid, int row_off, LAS float* scr, int item, int lane) {
    const int nblk = (N + 31) / 32, kb = item / nblk, nb = item % nblk, k0 = 64 * kb, n0 = 32 * nb;
    { const int n4 = (lane & 7) * 4, nn = n0 + n4 < N ? n0 + n4 : N - 4; f32x4 v[8];
#pragma unroll
      for (int i = 0; i < 8; ++i) v[i] = *(const f32x4*)(W + (size_t)(k0 + 8 * i + (lane >> 3)) * N + nn);
#pragma unroll
      for (int i = 0; i < 8; ++i) { const int kk = 8 * i + (lane >> 3); const float sc = kscale ? kscale[k0 + kk] : 1.0f; LAS float* d = scr + kk * 33 + n4;
          d[0] = v[i].x * sc; d[1] = v[i].y * sc; d[2] = v[i].z * sc; d[3] = v[i].w * sc; } }
    LDS_WAIT(); asm volatile("" ::: "memory");
    const int cc = lane & 7;
#pragma unroll
    for (int j = 0; j < 4; ++j) { const int nl = (lane >> 3) + 8 * j, n = n0 + nl; const LAS float* s = scr + (8 * cc) * 33 + nl;
        v4u o; o.x = pk2(s[0 * 33], s[1 * 33]); o.y = pk2(s[2 * 33], s[3 * 33]); o.z = pk2(s[4 * 33], s[5 * 33]); o.w = pk2(s[6 * 33], s[7 * 33]);
        if (n < N) *(GAS v4u*)(WT + (size_t)map_row(mapid, n, row_off) * K + k0 + 8 * cc) = o; }
    LDS_WAIT(); asm volatile("" ::: "memory");
}
__device__ __forceinline__ void p0_prologue(Ctx& c, ARGREF a) {
    LAS float* scr = (LAS float*)(c.lds + RING_OFF + c.wave * 16384);
    const int gw = c.vcu * NWAVES + c.wave, NGW = c.G * NWAVES, lane = c.lane;
    unsigned char* ws = a.ws;
    constexpr int I_INH = 16 * 104, I_MKV = 16 * 16, I_DSA = 16 * 67, I_OUT = 16 * 32, I_G = 16 * 88, I_D = 44 * 32;
    constexpr int NITEMS = I_INH + 2 * I_MKV + I_DSA + 2 * I_OUT + 4 * I_G + 2 * I_D;
    for (int it = gw; it < NITEMS; it += NGW) {
        int r = it;
        if (r < I_INH) { transpose_item(a.in[13], 1024, 3328, a.in[11], (bf16*)(ws + WS_WIN0), 0, 0, scr, r, lane); continue; } r -= I_INH;
        if (r < I_MKV) { transpose_item(a.in[20], 1024, 512, nullptr, (bf16*)(ws + WS_WIN0), 0, 3328, scr, r, lane); continue; } r -= I_MKV;
        if (r < I_MKV) { transpose_item(a.in[20] + 1024 * 512, 1024, 512, nullptr, (bf16*)(ws + WS_WIN0), 0, 3840, scr, r, lane); continue; } r -= I_MKV;
        if (r < I_DSA) { transpose_item(a.in[16], 1024, 2120, a.in[11] + 1024, (bf16*)(ws + WS_WIN1), 1, 0, scr, r, lane); continue; } r -= I_DSA;
        if (r < 2 * I_OUT) { const int l = r / I_OUT; transpose_item(a.in[23] + (size_t)l * 1024 * 1024, 1024, 1024, nullptr, (bf16*)(ws + WS_WOUT) + (size_t)l * 1024 * 1024, 0, 0, scr, r % I_OUT, lane); continue; } r -= 2 * I_OUT;
        if (r < 2 * I_G) { const int l = r / I_G; transpose_item(a.in[24] + (size_t)l * 1024 * DFF, 1024, DFF, a.in[12] + l * 1024, (bf16*)(ws + WS_WGU) + (size_t)l * 5632 * 1024, 2, 0, scr, r % I_G, lane); continue; } r -= 2 * I_G;
        if (r < 2 * I_G) { const int l = r / I_G; transpose_item(a.in[25] + (size_t)l * 1024 * DFF, 1024, DFF, a.in[12] + l * 1024, (bf16*)(ws + WS_WGU) + (size_t)l * 5632 * 1024, 3, 0, scr, r % I_G, lane); continue; } r -= 2 * I_G;
        { const int l = r / I_D; transpose_item(a.in[28] + (size_t)l * DFF * 1024, DFF, 1024, nullptr, (bf16*)(ws + WS_WD) + (size_t)l * 1024 * DFF, 0, 0, scr, r % I_D, lane); }
    }
    for (int rr = gw; rr < 184; rr += NGW) { const int row = rr < 56 ? 1864 + rr : 2176 + (rr - 56);
        GAS v4u* p = (GAS v4u*)((bf16*)(ws + WS_WIN1) + (size_t)row * 1024); p[lane] = (v4u){0u, 0u, 0u, 0u}; p[64 + lane] = (v4u){0u, 0u, 0u, 0u}; }
    float* ss0 = ssptr(c, 0);
    for (int m = gw; m < MT + NMEMROWS; m += NGW) {
        GAS u64* o8 = (GAS u64*)((bf16*)(ws + WS_XB) + (size_t)m * DM) + lane;
        if (m >= MVALID && m < MT) {
#pragma unroll
            for (int j = 0; j < 4; ++j) o8[64 * j] = 0ull;
            continue; }
        const float* src = m < MP ? a.in[0] + (size_t)m * DM : (m < MVALID ? a.in[1] + (size_t)(m - MP) * DM : a.in[10] + (size_t)(m - MT) * DM);
        const GAS f32x4* xr = (const GAS f32x4*)src + lane; f32x4 v[4]; float s = 0.f;
#pragma unroll
        for (int j = 0; j < 4; ++j) { v[j] = xr[64 * j]; s += (v[j].x * v[j].x + v[j].y * v[j].y) + (v[j].z * v[j].z + v[j].w * v[j].w); }
        s = wave_sum(s);
#pragma unroll
        for (int j = 0; j < 4; ++j) o8[64 * j] = (u64)pk2(v[j].x, v[j].y) | ((u64)pk2(v[j].z, v[j].w) << 32);
        if (m < MVALID && lane == 0) ss0[m] = s;
    }
}

__device__ __forceinline__ void memattn_unit(Ctx& c, const bf16* Zq  , int ldz, int nrows_valid, const float* Kp, const float* Vp, int kstride,
                                             bool normk, const float* kgain, const float* qgain, bf16* Out  ) {
    LAS bf16* KN = (LAS bf16*)(c.lds);
    LAS bf16* VTm = (LAS bf16*)(c.lds + 36864);
    LAS bf16* QN = (LAS bf16*)(c.lds + 70656) + c.wave * (32 * 72);
    LAS float* LI = (LAS float*)(c.lds + 107520) + c.wave * 32;
    int tid = c.tid; asm volatile("" : "+v"(tid));
    const int lane = tid & 63, w = c.wave;
    {
        const int m = tid >> 1, dh = (tid & 1) * 32;
        f32x4 kv[8]; float s = 0.f;
#pragma unroll
        for (int j = 0; j < 8; ++j) { kv[j] = *(const f32x4*)(Kp + (size_t)m * kstride + dh + 4 * j); s += (kv[j].x * kv[j].x + kv[j].y * kv[j].y) + (kv[j].z * kv[j].z + kv[j].w * kv[j].w); }
        s += __shfl_xor(s, 1);
        const float rs = normk ? rsqrtf(s * (1.0f / 64.0f) + EPS) : 1.0f;
#pragma unroll
        for (int j = 0; j < 8; j += 2) { f32x4 g0 = {1.f, 1.f, 1.f, 1.f}, g1 = g0;
            if (normk) { g0 = *(const f32x4*)(kgain + dh + 4 * j); g1 = *(const f32x4*)(kgain + dh + 4 * j + 4); }
            const f32x4 x0 = kv[j] * rs * g0, x1 = kv[j + 1] * rs * g1;
            v4u o; o.x = pk2(x0.x, x0.y); o.y = pk2(x0.z, x0.w); o.z = pk2(x1.x, x1.y); o.w = pk2(x1.z, x1.w);
            *(LAS v4u*)(KN + m * 72 + dh + 4 * j) = o; }
#pragma unroll
        for (int j = 0; j < 8; ++j) { const f32x4 vv = *(const f32x4*)(Vp + (size_t)m * kstride + dh + 4 * j);
            VTm[(dh + 4 * j + 0) * 264 + m] = (bf16)f2bf(vv.x); VTm[(dh + 4 * j + 1) * 264 + m] = (bf16)f2bf(vv.y);
            VTm[(dh + 4 * j + 2) * 264 + m] = (bf16)f2bf(vv.z); VTm[(dh + 4 * j + 3) * 264 + m] = (bf16)f2bf(vv.w); }
    }
    {
        const int row = lane >> 1, hf = lane & 1, grow = w * 32 + row;
        float x[32]; float s = 0.f;
        if (grow < nrows_valid) {
#pragma unroll
            for (int j = 0; j < 4; ++j) { const v4u q = *(const v4u*)(Zq + (size_t)grow * ldz + hf * 32 + 8 * j);
                x[8 * j + 0] = bf2f(q.x & 0xffffu); x[8 * j + 1] = bf2f(q.x >> 16); x[8 * j + 2] = bf2f(q.y & 0xffffu); x[8 * j + 3] = bf2f(q.y >> 16);
                x[8 * j + 4] = bf2f(q.z & 0xffffu); x[8 * j + 5] = bf2f(q.z >> 16); x[8 * j + 6] = bf2f(q.w & 0xffffu); x[8 * j + 7] = bf2f(q.w >> 16); }
        } else {
#pragma unroll
            for (int j = 0; j < 32; ++j) x[j] = 0.f;
        }
#pragma unroll
        for (int j = 0; j < 32; ++j) s += x[j] * x[j];
        s += __shfl_xor(s, 1);
        const float rs = rsqrtf(s * (1.0f / 64.0f) + EPS) * 0.125f;
#pragma unroll
        for (int j = 0; j < 32; j += 8) { v4u o;
            o.x = pk2(x[j] * rs * qgain[hf * 32 + j], x[j + 1] * rs * qgain[hf * 32 + j + 1]); o.y = pk2(x[j + 2] * rs * qgain[hf * 32 + j + 2], x[j + 3] * rs * qgain[hf * 32 + j + 3]);
            o.z = pk2(x[j + 4] * rs * qgain[hf * 32 + j + 4], x[j + 5] * rs * qgain[hf * 32 + j + 5]); o.w = pk2(x[j + 6] * rs * qgain[hf * 32 + j + 6], x[j + 7] * rs * qgain[hf * 32 + j + 7]);
            *(LAS v4u*)(QN + row * 72 + hf * 32 + j) = o; }
    }
    __syncthreads();
    if (w * 32 < nrows_valid) {
        const int r32 = lane & 31, hh = lane >> 5;
        f32x16 s[8];
#pragma unroll
        for (int mt = 0; mt < 8; ++mt) { f32x16 z = {}; s[mt] = mm32<64>(KN + mt * 32 * 72, 72, QN, 72, z, lane); }
        float mx = -1e30f;
#pragma unroll
        for (int mt = 0; mt < 8; ++mt)
#pragma unroll
            for (int r = 0; r < 16; ++r) mx = fmaxf(mx, s[mt][r]);
        mx = fmaxf(mx, __shfl_xor(mx, 32));
        float l = 0.f;
#pragma unroll
        for (int mt = 0; mt < 8; ++mt)
#pragma unroll
            for (int r = 0; r < 16; ++r) { const float p = __expf(s[mt][r] - mx); s[mt][r] = p; l += p; }
        l += __shfl_xor(l, 32);
        if (hh == 0) LI[r32] = l;
        f32x16 o[2] = {};
#pragma unroll
        for (int mt = 0; mt < 8; ++mt)
#pragma unroll
            for (int sx = 0; sx < 2; ++sx) {
                v4u pa; pa.x = pk2(s[mt][8 * sx + 0], s[mt][8 * sx + 1]); pa.y = pk2(s[mt][8 * sx + 2], s[mt][8 * sx + 3]);
                pa.z = pk2(s[mt][8 * sx + 4], s[mt][8 * sx + 5]); pa.w = pk2(s[mt][8 * sx + 6], s[mt][8 * sx + 7]);
                const bf16x8 af = __builtin_bit_cast(bf16x8, pa);
#pragma unroll
                for (int dt = 0; dt < 2; ++dt) { const LAS bf16* vp = VTm + (dt * 32 + r32) * 264 + mt * 32 + 16 * sx + 4 * hh;
                    const u64 lo = *(const LAS u64*)vp, hi = *(const LAS u64*)(vp + 8);
                    v4u bw; bw.x = (unsigned)lo; bw.y = (unsigned)(lo >> 32); bw.z = (unsigned)hi; bw.w = (unsigned)(hi >> 32);
                    o[dt] = __builtin_amdgcn_mfma_f32_32x32x16_bf16(af, __builtin_bit_cast(bf16x8, bw), o[dt], 0, 0, 0); }
            }
        LDS_WAIT();
#pragma unroll
        for (int r = 0; r < 16; ++r) { const int qr = crow(r, hh), grow = w * 32 + qr; const float il = 1.0f / LI[qr];
            if (grow < nrows_valid) {
#pragma unroll
                for (int dt = 0; dt < 2; ++dt) Out[(size_t)grow * DM + dt * 32 + r32] = (bf16)f2bf(o[dt][r] * il); } }
    }
}

constexpr int HG_GS = 4, HG_NG = SEQ / (32 * HG_GS);
constexpr size_t WS_HOL = WS_U, WS_HQC = WS_UP, WS_HUT = WS_ACT, WS_HST = WS_ACT + 64 * MiB, WS_HDG = WS_ACT + 50 * MiB;
template <bool PROMPT>
__device__ __forceinline__ void hgrn_unit(Ctx& c, ARGREF a, int b, int h, int g) {
    LAS unsigned char* L = c.lds;
    LAS float* LF = (LAS float*)(L + 0);
    LAS float* BL = (LAS float*)(L + 16384);
    LAS float* DVv = (LAS float*)(L + 16896);
    LAS bf16* QD = (LAS bf16*)(L + 17408);
    LAS bf16* KD = (LAS bf16*)(L + 26112);
    LAS bf16* KET = (LAS bf16*)(L + 34816);
    LAS bf16* VT = (LAS bf16*)(L + 45056);
    LAS bf16* SCB = (LAS bf16*)(L + 55296);
    LAS bf16* STt = (LAS bf16*)(L + 57856);
    LAS float* BOFF = (LAS float*)(L + 92672);
    int tid = c.tid; asm volatile("" : "+v"(tid));
    const int lane = tid & 63, w = c.wave, r32 = lane & 31, hh = lane >> 5;
    const int te = tid >> 4, k8 = (tid & 15) * 8;
    const bf16* Z = (const bf16*)(a.ws + WS_Z);
    bf16* MIX = (bf16*)(a.ws + WS_MIX);
    const int nch = PROMPT ? HG_GS : 1, nvalid = PROMPT ? 32 : 4;
    const int kt = w >> 1, vt0 = 2 * (w & 1);
    const int unit = (b * 6 + h) * HG_NG + g;
    f32x16 S0 = {}, S1 = {};
    if (!PROMPT) { const float* sp = a.in[7] + (size_t)(b * 6 + h) * 16384;
#pragma unroll
        for (int r = 0; r < 16; ++r) { const int k = 32 * kt + crow(r, hh); S0[r] = sp[k * 128 + 32 * vt0 + r32]; S1[r] = sp[k * 128 + 32 * (vt0 + 1) + r32]; } }
    float lbv[8], onv[8];
#pragma unroll
    for (int j = 0; j < 8; ++j) { const float l0 = a.in[14][h * 128 + k8 + j], l1 = a.in[14][768 + h * 128 + k8 + j]; lbv[j] = 1.0f / (1.0f + __expf(l1 - l0)); onv[j] = a.in[15][k8 + j]; }
    __syncthreads();
    if (tid < 128) BOFF[tid] = 0.f;
#define HG_WRITE_ST() do { _Pragma("unroll") for (int g4 = 0; g4 < 4; ++g4) { const int k0 = 32 * kt + 8 * g4 + 4 * hh; \
        *(LAS u64*)(STt + (32 * vt0 + r32) * 136 + k0) = (u64)pk2(S0[4 * g4], S0[4 * g4 + 1]) | ((u64)pk2(S0[4 * g4 + 2], S0[4 * g4 + 3]) << 32); \
        *(LAS u64*)(STt + (32 * (vt0 + 1) + r32) * 136 + k0) = (u64)pk2(S1[4 * g4], S1[4 * g4 + 1]) | ((u64)pk2(S1[4 * g4 + 2], S1[4 * g4 + 3]) << 32); } } while (0)
    HG_WRITE_ST();
#pragma unroll 1
    for (int ch = 0; ch < nch; ++ch) {
        const int row0 = PROMPT ? b * SEQ + (g * HG_GS + ch) * 32 : MP + 4 * b, row = row0 + te;
        const bool valid = te < nvalid;
        float qs[8], kk[8]; v4u gz = {0u, 0u, 0u, 0u};
        {
            v4u zq = {0u, 0u, 0u, 0u}, zf = zq, zi = zq;
            if (valid) { const bf16* zr = Z + (size_t)row * ZC0 + h * 128 + k8;
                zq = *(const v4u*)zr; zf = *(const v4u*)(zr + 768); zi = *(const v4u*)(zr + 1536); if (!PROMPT) gz = *(const v4u*)(zr + 2304); }
            const unsigned qw[4] = {zq.x, zq.y, zq.z, zq.w}, fw[4] = {zf.x, zf.y, zf.z, zf.w}, iw[4] = {zi.x, zi.y, zi.z, zi.w};
            float lf[8];
#pragma unroll
            for (int j = 0; j < 8; ++j) { const float q = bf2f((qw[j >> 1] >> (16 * (j & 1))) & 0xffffu), fp = bf2f((fw[j >> 1] >> (16 * (j & 1))) & 0xffffu);
                const float sg = sigmoidf_(fp), f = lbv[j] + (1.0f - lbv[j]) * sg;
                qs[j] = valid ? q * sigmoidf_(q) : 0.f; kk[j] = valid ? (1.0f - f) : 0.f; lf[j] = valid ? __logf(f) : 0.f;
                VT[(k8 + j) * 40 + te] = (bf16)((iw[j >> 1] >> (16 * (j & 1))) & 0xffffu); }
            *(LAS f32x4*)(LF + te * 128 + k8) = (f32x4){lf[0], lf[1], lf[2], lf[3]}; *(LAS f32x4*)(LF + te * 128 + k8 + 4) = (f32x4){lf[4], lf[5], lf[6], lf[7]};
        }
        __syncthreads();
        if (tid < 128) { float bsum = 0.f;
#pragma unroll
            for (int t = 0; t < 32; ++t) { bsum += LF[t * 128 + tid]; LF[t * 128 + tid] = bsum; }
            BL[tid] = bsum; }
        __syncthreads();
        {
            const f32x4 b0 = *(const LAS f32x4*)(LF + te * 128 + k8), b1 = *(const LAS f32x4*)(LF + te * 128 + k8 + 4);
            const f32x4 l0 = *(const LAS f32x4*)(BL + k8), l1 = *(const LAS f32x4*)(BL + k8 + 4);
            const float bb[8] = {b0.x, b0.y, b0.z, b0.w, b1.x, b1.y, b1.z, b1.w}, bl[8] = {l0.x, l0.y, l0.z, l0.w, l1.x, l1.y, l1.z, l1.w};
            float qd[8], kd[8];
#pragma unroll
            for (int j = 0; j < 8; ++j) { qd[j] = qs[j] * __expf(bb[j]); kd[j] = kk[j] * __expf(-bb[j]); KET[(k8 + j) * 40 + te] = (bf16)f2bf(kk[j] * __expf(bl[j] - bb[j])); }
            v4u o; o.x = pk2(qd[0], qd[1]); o.y = pk2(qd[2], qd[3]); o.z = pk2(qd[4], qd[5]); o.w = pk2(qd[6], qd[7]); *(LAS v4u*)(QD + te * 136 + k8) = o;
            if (PROMPT) { const f32x4 f0 = *(const LAS f32x4*)(BOFF + k8), f1 = *(const LAS f32x4*)(BOFF + k8 + 4);
                const float bo[8] = {f0.x, f0.y, f0.z, f0.w, f1.x, f1.y, f1.z, f1.w}; float qc[8];
#pragma unroll
                for (int j = 0; j < 8; ++j) qc[j] = qd[j] * __expf(bo[j]);
                v4u oc; oc.x = pk2(qc[0], qc[1]); oc.y = pk2(qc[2], qc[3]); oc.z = pk2(qc[4], qc[5]); oc.w = pk2(qc[6], qc[7]);
                *(v4u*)((bf16*)(a.ws + WS_HQC) + (size_t)row * 768 + h * 128 + k8) = oc; }
            o.x = pk2(kd[0], kd[1]); o.y = pk2(kd[2], kd[3]); o.z = pk2(kd[4], kd[5]); o.w = pk2(kd[6], kd[7]); *(LAS v4u*)(KD + te * 136 + k8) = o;
            if (te == 0) {
#pragma unroll
                for (int j = 0; j < 8; ++j) DVv[k8 + j] = __expf(bl[j]); }
        }
        __syncthreads();
        f32x16 oacc = {};
        if (w == 0) { f32x16 z = {}; const f32x16 sc = mm32<128>(QD, 136, KD, 136, z, lane);
#pragma unroll
            for (int r = 0; r < 16; ++r) { const int t = crow(r, hh); SCB[t * 40 + r32] = (bf16)f2bf(r32 <= t ? sc[r] : 0.f); } }
        if (w < 4) oacc = mm32<128>(QD, 136, STt + (w * 32) * 136, 136, oacc, lane);
        if (PROMPT && tid >= 384) BOFF[tid - 384] += BL[tid - 384];
        __syncthreads();
        if (w < 4) { oacc = mm32<32>(SCB, 40, VT + (w * 32) * 40, 40, oacc, lane);
#pragma unroll
            for (int r = 0; r < 16; ++r) LF[crow(r, hh) * 128 + w * 32 + r32] = oacc[r]; }
        {
#pragma unroll
            for (int r = 0; r < 16; ++r) { const float d = DVv[32 * kt + crow(r, hh)]; S0[r] *= d; S1[r] *= d; }
            S0 = mm32<32>(KET + (kt * 32) * 40, 40, VT + (vt0 * 32) * 40, 40, S0, lane);
            S1 = mm32<32>(KET + (kt * 32) * 40, 40, VT + ((vt0 + 1) * 32) * 40, 40, S1, lane);
        }
        __syncthreads();
        HG_WRITE_ST();
        {
            const f32x4 o0 = *(const LAS f32x4*)(LF + te * 128 + k8), o1 = *(const LAS f32x4*)(LF + te * 128 + k8 + 4);
            if (PROMPT) { float* ol = (float*)(a.ws + WS_HOL) + (size_t)row * 768 + h * 128 + k8; *(f32x4*)ol = o0; *(f32x4*)(ol + 4) = o1; }
            else {
                float ov[8] = {o0.x, o0.y, o0.z, o0.w, o1.x, o1.y, o1.z, o1.w}; float s = 0.f;
#pragma unroll
                for (int j = 0; j < 8; ++j) s += ov[j] * ov[j];
                s += __shfl_xor(s, 1); s += __shfl_xor(s, 2); s += __shfl_xor(s, 4); s += __shfl_xor(s, 8);
                const float rs = rsqrtf(s * (1.0f / 128.0f) + EPS);
                const unsigned gw_[4] = {gz.x, gz.y, gz.z, gz.w}; float y[8];
#pragma unroll
                for (int j = 0; j < 8; ++j) { const float gg = bf2f((gw_[j >> 1] >> (16 * (j & 1))) & 0xffffu); y[j] = ov[j] * rs * onv[j] * (gg * sigmoidf_(gg)); }
                if (valid) { v4u o; o.x = pk2(y[0], y[1]); o.y = pk2(y[2], y[3]); o.z = pk2(y[4], y[5]); o.w = pk2(y[6], y[7]); *(v4u*)(MIX + (size_t)row * DM + h * 128 + k8) = o; }
            }
        }
        __syncthreads();
    }
#undef HG_WRITE_ST
    if (PROMPT) {
        float* ut = (float*)(a.ws + WS_HUT) + (size_t)unit * 16384;
#pragma unroll
        for (int g4 = 0; g4 < 4; ++g4) { const int k0 = 32 * kt + 8 * g4 + 4 * hh;
            *(f32x4*)(ut + (32 * vt0 + r32) * 128 + k0) = (f32x4){S0[4 * g4], S0[4 * g4 + 1], S0[4 * g4 + 2], S0[4 * g4 + 3]};
            *(f32x4*)(ut + (32 * (vt0 + 1) + r32) * 128 + k0) = (f32x4){S1[4 * g4], S1[4 * g4 + 1], S1[4 * g4 + 2], S1[4 * g4 + 3]}; }
        if (tid < 128) ((float*)(a.ws + WS_HDG))[(size_t)unit * 128 + tid] = __expf(BOFF[tid]);
    } else {
        float* so = a.out + O_HS + (size_t)(b * 6 + h) * 16384;
#pragma unroll
        for (int r = 0; r < 16; ++r) { const int k = 32 * kt + crow(r, hh); so[k * 128 + 32 * vt0 + r32] = S0[r]; so[k * 128 + 32 * (vt0 + 1) + r32] = S1[r]; }
    }
}
__device__ __forceinline__ void hgrn_scan(Ctx& c, ARGREF a) {
    const float* UT = (const float*)(a.ws + WS_HUT); const float* DG = (const float*)(a.ws + WS_HDG); bf16* STo = (bf16*)(a.ws + WS_HST);
    for (int idx = c.vcu * 512 + c.tid; idx < 24 * 16384; idx += c.G * 512) {
        const int bh = idx >> 14, e = idx & 16383, k = e & 127, v = e >> 7;
        float s = 0.f;
#pragma unroll 8
        for (int g = 0; g < HG_NG; ++g) { const size_t u = (size_t)(bh * HG_NG + g); STo[u * 16384 + e] = (bf16)f2bf(s); s = DG[u * 128 + k] * s + UT[u * 16384 + e]; }
        a.out[O_HP + (size_t)bh * 16384 + k * 128 + v] = s;
    }
}
__device__ __forceinline__ void hgrn_fix_unit(Ctx& c, ARGREF a, int b, int h, int g) {
    LAS bf16* STt = (LAS bf16*)(c.lds);
    LAS bf16* QCl = (LAS bf16*)(c.lds + 34816);
    LAS float* OB = (LAS float*)(c.lds + 34816 + 17408);
    int tid = c.tid; asm volatile("" : "+v"(tid));
    const int lane = tid & 63, w = c.wave, r32 = lane & 31, hh = lane >> 5;
    const int unit = (b * 6 + h) * HG_NG + g, row0 = b * SEQ + g * 128;
    const bf16* Z = (const bf16*)(a.ws + WS_Z); bf16* MIX = (bf16*)(a.ws + WS_MIX);
    const bf16* QC = (const bf16*)(a.ws + WS_HQC); const float* OL = (const float*)(a.ws + WS_HOL);
    const bf16* stg = (const bf16*)(a.ws + WS_HST) + (size_t)unit * 16384;
    __syncthreads();
#pragma unroll
    for (int i = 0; i < 4; ++i) { const int cidx = tid + 512 * i, v = cidx >> 4, kc = (cidx & 15) * 8; *(LAS v4u*)(STt + v * 136 + kc) = *(const v4u*)(stg + v * 128 + kc); }
    const int te = tid >> 4, k8 = (tid & 15) * 8;
    float onv[8];
#pragma unroll
    for (int j = 0; j < 8; ++j) onv[j] = a.in[15][k8 + j];
#pragma unroll 1
    for (int hf = 0; hf < 2; ++hf) {
        const int rb = row0 + hf * 64;
#pragma unroll
        for (int i = 0; i < 2; ++i) { const int cidx = tid + 512 * i, r = cidx >> 4, kc = (cidx & 15) * 8; *(LAS v4u*)(QCl + r * 136 + kc) = *(const v4u*)(QC + (size_t)(rb + r) * 768 + h * 128 + kc); }
        __syncthreads();
        { const int rt = w >> 2, vt = w & 3; f32x16 o = {};
          o = mm32<128>(QCl + (rt * 32) * 136, 136, STt + (vt * 32) * 136, 136, o, lane);
#pragma unroll
          for (int r = 0; r < 16; ++r) OB[(rt * 32 + crow(r, hh)) * 128 + vt * 32 + r32] = o[r]; }
        __syncthreads();
#pragma unroll
        for (int ps = 0; ps < 2; ++ps) { const int r = ps * 32 + te, row = rb + r;
            const f32x4 c0 = *(const LAS f32x4*)(OB + r * 128 + k8), c1 = *(const LAS f32x4*)(OB + r * 128 + k8 + 4);
            const float* ol = OL + (size_t)row * 768 + h * 128 + k8; const f32x4 l0 = *(const f32x4*)ol, l1 = *(const f32x4*)(ol + 4);
            const v4u gz = *(const v4u*)(Z + (size_t)row * ZC0 + 2304 + h * 128 + k8);
            float ov[8] = {c0.x + l0.x, c0.y + l0.y, c0.z + l0.z, c0.w + l0.w, c1.x + l1.x, c1.y + l1.y, c1.z + l1.z, c1.w + l1.w}; float s = 0.f;
#pragma unroll
            for (int j = 0; j < 8; ++j) s += ov[j] * ov[j];
            s += __shfl_xor(s, 1); s += __shfl_xor(s, 2); s += __shfl_xor(s, 4); s += __shfl_xor(s, 8);
            const float rs = rsqrtf(s * (1.0f / 128.0f) + EPS);
            const unsigned gw_[4] = {gz.x, gz.y, gz.z, gz.w}; float y[8];
#pragma unroll
            for (int j = 0; j < 8; ++j) { const float gg = bf2f((gw_[j >> 1] >> (16 * (j & 1))) & 0xffffu); y[j] = ov[j] * rs * onv[j] * (gg * sigmoidf_(gg)); }
            v4u o; o.x = pk2(y[0], y[1]); o.y = pk2(y[2], y[3]); o.z = pk2(y[4], y[5]); o.w = pk2(y[6], y[7]); *(v4u*)(MIX + (size_t)row * DM + h * 128 + k8) = o; }
        __syncthreads();
    }
}

__device__ __forceinline__ void memkv_finalize_row(ARGREF a, int layer, int row, int lane) {
    const float* src = (const float*)(a.ws + WS_MEMKV) + (size_t)row * 1024 + layer * 512;
    const int hd = lane >> 4, d4 = (lane & 15) * 4;
    const f32x4 k = *(const f32x4*)(src + hd * 64 + d4), v = *(const f32x4*)(src + 256 + hd * 64 + d4);
    float s = (k.x * k.x + k.y * k.y) + (k.z * k.z + k.w * k.w);
    s += __shfl_xor(s, 1); s += __shfl_xor(s, 2); s += __shfl_xor(s, 4); s += __shfl_xor(s, 8);
    const float rs = rsqrtf(s * (1.0f / 64.0f) + EPS); const f32x4 g = *(const f32x4*)(a.in[22] + layer * 64 + d4);
    *(f32x4*)(a.out + O_MK + ((size_t)layer * 1024 + row) * 256 + hd * 64 + d4) = k * rs * g;
    *(f32x4*)(a.out + O_MV + ((size_t)layer * 1024 + row) * 256 + hd * 64 + d4) = v;
}

__device__ __forceinline__ void memattn_prompt_unit(Ctx& c, ARGREF a, int layer, int u) {
    const int blk = u & 15, hd = (u >> 4) & 3, b = u >> 6;
    const bf16* Z = (const bf16*)(a.ws + WS_Z); const int ldz = layer ? ZC1 : ZC0, qc = layer ? Z1_MQ : 3072;
    const float* kv = (const float*)(a.ws + WS_MEMKV) + (size_t)(b * 256) * 1024 + layer * 512 + hd * 64;
    const int row0 = b * SEQ + blk * 256;
    memattn_unit(c, Z + (size_t)row0 * ldz + qc + hd * 64, ldz, 256, kv, kv + 256, 1024, true, a.in[22] + layer * 64, a.in[21] + layer * 64,
                 (bf16*)(a.ws + WS_MIX) + (size_t)row0 * DM + 768 + hd * 64);
}
__device__ __forceinline__ void memattn_sample_unit(Ctx& c, ARGREF a, int layer, int u) {
    const int hd = u & 3, sb = u >> 2;
    const bf16* Z = (const bf16*)(a.ws + WS_Z); const int ldz = layer ? ZC1 : ZC0, qc = layer ? Z1_MQ : 3072;
    const size_t off = ((size_t)(layer * 32 + sb) * 256) * 256 + hd * 64;
    const int row0 = MP + sb * 4;
    memattn_unit(c, Z + (size_t)row0 * ldz + qc + hd * 64, ldz, 4, a.in[5] + off, a.in[6] + off, 256, false, nullptr, a.in[21] + layer * 64,
                 (bf16*)(a.ws + WS_MIX) + (size_t)row0 * DM + 768 + hd * 64);
}

__device__ __forceinline__ void p2_mixer0(Ctx& c, ARGREF a) {
    constexpr int U_HP = 24 * HG_NG, U_MAP = U_HP + 256, U_HS = U_MAP + 192, U_MAS = U_HS + 128, U_FIN = U_MAS + 256;
    for (;;) {
        const int u = q_next(c, 0);
        if (u >= U_FIN) break;
        if (u < U_HP) hgrn_unit<true>(c, a, u / (6 * HG_NG), (u / HG_NG) % 6, u % HG_NG);
        else if (u < U_MAP) memattn_prompt_unit(c, a, 0, u - U_HP);
        else if (u < U_HS) { const int v = u - U_MAP; hgrn_unit<false>(c, a, v / 6, v % 6, 0); }
        else if (u < U_MAS) memattn_sample_unit(c, a, 0, u - U_HS);
        else { const int v = (u - U_MAS) * 8 + c.wave; memkv_finalize_row(a, v >> 10, v & 1023, c.lane); }
    }
}
__device__ __forceinline__ void p2c_hgrn_fix(Ctx& c, ARGREF a) {
    for (int u = c.vcu; u < 24 * HG_NG; u += c.G) hgrn_fix_unit(c, a, u / (6 * HG_NG), (u / HG_NG) % 6, u % HG_NG);
}

constexpr size_t WS_G4 = WS_UP + 64 * MiB, WS_UP2 = WS_UP + 80 * MiB;
__device__ __forceinline__ void conv_fixup_tile(Ctx& c, ARGREF a, int layer, int pm) {
    const float* G4 = (const float*)(a.ws + WS_G4); const float* UP2 = (const float*)(a.ws + WS_UP2); bf16* ACT = (bf16*)(a.ws + WS_ACT);
    const float* cw = a.in[26] + (size_t)layer * 3 * DFF; const float* cb = a.in[27] + (size_t)layer * DFF;
    for (int idx = c.tid; idx < 8 * (DFF / 4); idx += 512) {
        const int rr = idx / (DFF / 4), c4 = (idx - rr * (DFF / 4)) * 4;
        const int slab = 4 * pm + (rr >> 1), fr = rr & 1, row = slab * 64 + fr, t = row & 4095, sl1 = slab > 0 ? slab - 1 : 0;
        const f32x4 ut = *(const f32x4*)(G4 + (size_t)(slab * 4 + fr) * DFF + c4), up = *(const f32x4*)(UP2 + (size_t)(slab * 2 + fr) * DFF + c4);
        const f32x4 a0 = *(const f32x4*)(G4 + (size_t)(slab * 4 + 0) * DFF + c4), b3 = *(const f32x4*)(G4 + (size_t)(sl1 * 4 + 3) * DFF + c4), b2 = *(const f32x4*)(G4 + (size_t)(sl1 * 4 + 2) * DFF + c4);
        f32x4 u1, u2;
        { const bool f1 = fr == 1, t0 = t == 0, t1 = t == 1;
          u1.x = f1 ? a0.x : (t0 ? 0.f : b3.x); u1.y = f1 ? a0.y : (t0 ? 0.f : b3.y); u1.z = f1 ? a0.z : (t0 ? 0.f : b3.z); u1.w = f1 ? a0.w : (t0 ? 0.f : b3.w);
          u2.x = f1 ? (t1 ? 0.f : b3.x) : (t0 ? 0.f : b2.x); u2.y = f1 ? (t1 ? 0.f : b3.y) : (t0 ? 0.f : b2.y); u2.z = f1 ? (t1 ? 0.f : b3.z) : (t0 ? 0.f : b2.z); u2.w = f1 ? (t1 ? 0.f : b3.w) : (t0 ? 0.f : b2.w); }
        const f32x4 w0 = *(const f32x4*)(cw + c4), w1 = *(const f32x4*)(cw + DFF + c4), w2 = *(const f32x4*)(cw + 2 * DFF + c4), bb = *(const f32x4*)(cb + c4);
        const f32x4 cv = bb + w0 * u2 + w1 * u1 + w2 * ut;
        const float y0 = cv.x * sigmoidf_(cv.x) * up.x, y1 = cv.y * sigmoidf_(cv.y) * up.y, y2 = cv.z * sigmoidf_(cv.z) * up.z, y3 = cv.w * sigmoidf_(cv.w) * up.w;
        *(u64*)(ACT + (size_t)row * DFF + c4) = (u64)pk2(y0, y1) | ((u64)pk2(y2, y3) << 32);
    }
}


struct SgArgs { const bf16* A; const bf16* Bt; int K; int mode; bf16* Z; int ldz; const float* ssin; const float* resid; const bf16* rb; float* y; bf16* xb; float* ssout; bf16* ACT; float* cvs; const float* cst; const float* cw; const float* cb; };
__device__ __forceinline__ void sgemm_unit(Ctx& c, const SgArgs& g, int n0) {
    int tid = c.tid; asm volatile("" : "+v"(tid));
    const int lane = tid & 63, w = c.wave, r32 = lane & 31, hh = lane >> 5;
    const int K = g.K, ks = K >> 3;
    const int f2 = (n0 >> 1) + (r32 & 15), brow = g.mode == 2 ? (f2 >> 7) * 256 + (f2 & 127) + (r32 >= 16 ? 128 : 0) : n0 + r32;
    const bf16* bp = g.Bt + (size_t)brow * K + w * ks + 8 * hh;
    const bf16* ap = g.A + (size_t)r32 * K + w * ks + 8 * hh;
    f32x16 acc[4] = {};
    bf16x8 afA[4][2], bfA[2], afB[4][2], bfB[2];
#define SG_LOAD(AF, BF, kk) do { _Pragma("unroll") for (int i = 0; i < 2; ++i) { BF[i] = *(const bf16x8*)(bp + (kk) + 16 * i); \
        _Pragma("unroll") for (int rt = 0; rt < 4; ++rt) AF[rt][i] = *(const bf16x8*)(ap + (size_t)(rt * 32) * K + (kk) + 16 * i); } } while (0)
#define SG_MMA(AF, BF) do { _Pragma("unroll") for (int i = 0; i < 2; ++i) _Pragma("unroll") for (int rt = 0; rt < 4; ++rt) acc[rt] = __builtin_amdgcn_mfma_f32_32x32x16_bf16(AF[rt][i], BF[i], acc[rt], 0, 0, 0); } while (0)
    SG_LOAD(afA, bfA, 0);
#pragma unroll 1
    for (int k = 0; k < ks; k += 64) {
        if (k + 32 < ks) SG_LOAD(afB, bfB, k + 32);
        SG_MMA(afA, bfA);
        if (k + 32 < ks) { if (k + 64 < ks) SG_LOAD(afA, bfA, k + 64); SG_MMA(afB, bfB); }
    }
#undef SG_LOAD
#undef SG_MMA
    LAS float* RED = (LAS float*)(c.lds);
    __syncthreads();
#pragma unroll
    for (int rt = 0; rt < 4; ++rt)
#pragma unroll
        for (int r = 0; r < 16; ++r) RED[((w * 4 + rt) * 16 + r) * 64 + lane] = acc[rt][r];
    __syncthreads();
    const int rt = w & 3, rh = w >> 2, col = n0 + r32;
    float v[8];
#pragma unroll
    for (int i = 0; i < 8; ++i) { float s = 0.f;
#pragma unroll
        for (int ww = 0; ww < 8; ++ww) s += RED[((ww * 4 + rt) * 16 + 8 * rh + i) * 64 + lane];
        v[i] = s; }
    if (g.mode == 0) {
#pragma unroll
        for (int i = 0; i < 8; ++i) { const int row = MP + rt * 32 + crow(8 * rh + i, hh); const float rs = rsqrtf(g.ssin[row] * (1.0f / DM) + EPS); g.Z[(size_t)row * g.ldz + col] = (bf16)f2bf(v[i] * rs); }
    } else if (g.mode == 1) {
#pragma unroll
        for (int i = 0; i < 8; ++i) { const int lr = rt * 32 + crow(8 * rh + i, hh), row = MP + lr;
            const float x = v[i] + (g.resid ? g.resid[(size_t)lr * DM + col] : bf2f(g.rb[(size_t)row * DM + col]));
            if (g.y) g.y[(size_t)lr * DM + col] = x; if (g.xb) g.xb[(size_t)row * DM + col] = (bf16)f2bf(x);
            float s = x * x; s += __shfl_xor(s, 1); s += __shfl_xor(s, 2); s += __shfl_xor(s, 4); s += __shfl_xor(s, 8); s += __shfl_xor(s, 16);
            if (g.ssout && r32 == 0) atomicAdd(g.ssout + row, s); }
    } else {
        float gu[8], upv[8];
#pragma unroll
        for (int i = 0; i < 8; ++i) { const int row = MP + rt * 32 + crow(8 * rh + i, hh); gu[i] = v[i] * rsqrtf(g.ssin[row] * (1.0f / DM) + EPS); upv[i] = __shfl_xor(gu[i], 16); }
        if (r32 < 16) { const float w0 = g.cw[f2], w1 = g.cw[DFF + f2], w2 = g.cw[2 * DFF + f2], bb = g.cb[f2];
#pragma unroll
            for (int aa = 0; aa < 2; ++aa) { const int lr0 = rt * 32 + 8 * (2 * rh + aa) + 4 * hh, sb = lr0 >> 2;
                const float s0 = g.cst[(size_t)(sb * 2) * DFF + f2], s1 = g.cst[(size_t)(sb * 2 + 1) * DFF + f2];
                const float u0 = gu[4 * aa], u1 = gu[4 * aa + 1], u2 = gu[4 * aa + 2], u3 = gu[4 * aa + 3];
                const float cv[4] = {bb + w0 * s0 + w1 * s1 + w2 * u0, bb + w0 * s1 + w1 * u0 + w2 * u1, bb + w0 * u0 + w1 * u1 + w2 * u2, bb + w0 * u1 + w1 * u2 + w2 * u3};
#pragma unroll
                for (int t = 0; t < 4; ++t) g.ACT[(size_t)(MP + lr0 + t) * DFF + f2] = (bf16)f2bf(cv[t] * sigmoidf_(cv[t]) * upv[4 * aa + t]);
                g.cvs[(size_t)(sb * 2) * DFF + f2] = u2; g.cvs[(size_t)(sb * 2 + 1) * DFF + f2] = u3; } }
    }
}
__device__ __forceinline__ void sgemm_phase(Ctx& c, const SgArgs& g, int N) {
#pragma unroll 1
    for (int u = c.G - 1 - (int)blockIdx.x; u < N / 32; u += c.G) sgemm_unit(c, g, u * 32);
}


__device__ __forceinline__ float wave_sum_f(float x) {
    x += __builtin_bit_cast(float, __builtin_amdgcn_update_dpp(0, __builtin_bit_cast(int, x), 0xB1, 0xF, 0xF, false));
    x += __builtin_bit_cast(float, __builtin_amdgcn_update_dpp(0, __builtin_bit_cast(int, x), 0x4E, 0xF, 0xF, false));
    x += __builtin_bit_cast(float, __builtin_amdgcn_update_dpp(0, __builtin_bit_cast(int, x), 0x141, 0xF, 0xF, false));
    x += __builtin_bit_cast(float, __builtin_amdgcn_update_dpp(0, __builtin_bit_cast(int, x), 0x140, 0xF, 0xF, false));
    const int xi = __builtin_bit_cast(int, x);
    return (__builtin_bit_cast(float, __builtin_amdgcn_readlane(xi, 0)) + __builtin_bit_cast(float, __builtin_amdgcn_readlane(xi, 16))) +
           (__builtin_bit_cast(float, __builtin_amdgcn_readlane(xi, 32)) + __builtin_bit_cast(float, __builtin_amdgcn_readlane(xi, 48)));
}
__device__ __forceinline__ void dsa_post_row(ARGREF a, int row, int lane_) {
    int lane = lane_; asm volatile("" : "+v"(lane));
    const bf16* z = (const bf16*)(a.ws + WS_Z) + (size_t)row * ZC1;
    const bool smp = row >= MP; const int b = smp ? (row - MP) >> 2 : row >> 12, t = smp ? (row - MP) & 3 : row & 4095;
    const float pos = (float)(smp ? PAST + t : t);
    const int i = lane & 31;
    float x1[8], x2[8], q1[4], q2[4], k1 = 0.f, k2 = 0.f;
#pragma unroll
    for (int hd = 0; hd < 8; ++hd) { x1[hd] = bf2f(z[hd * 128 + lane]); x2[hd] = bf2f(z[hd * 128 + 64 + lane]); }
    const u64 vv = *(const u64*)(z + Z1_V + 4 * lane);
#pragma unroll
    for (int p = 0; p < 4; ++p) { const int hd = 2 * p + (lane >> 5); q1[p] = bf2f(z[Z1_IQ + hd * 64 + i]); q2[p] = bf2f(z[Z1_IQ + hd * 64 + 32 + i]); }
    if (lane < 32) { k1 = bf2f(z[Z1_IK + i]); k2 = bf2f(z[Z1_IK + 32 + i]); }
    const float wraw = bf2f(z[Z1_IW + (lane & 7)]);
    float c128, s128, c64, s64;
    { const float r1 = pos * (exp2f(-(float)lane * (13.287712379549449f / 64.0f)) * 0.15915494309189535f), f1 = r1 - floorf(r1); s128 = __builtin_amdgcn_sinf(f1); c128 = __builtin_amdgcn_cosf(f1);
      const float r2 = pos * (exp2f(-(float)i * (13.287712379549449f / 32.0f)) * 0.15915494309189535f), f2 = r2 - floorf(r2); s64 = __builtin_amdgcn_sinf(f2); c64 = __builtin_amdgcn_cosf(f2); }
#pragma unroll
    for (int hd = 0; hd < 8; ++hd) {
        const float rs = rsqrtf(wave_sum_f(x1[hd] * x1[hd] + x2[hd] * x2[hd]) * (1.0f / 128.0f) + EPS);
        const float* gn = hd < 6 ? a.in[17] : a.in[18];
        const float y1 = x1[hd] * rs * gn[lane], y2 = x2[hd] * rs * gn[64 + lane];
        const float o1 = y1 * c128 - y2 * s128, o2 = y2 * c128 + y1 * s128;
        if (hd < 6) {
            if (smp) { float* q = (float*)(a.ws + WS_SQ) + (size_t)(row - MP) * 768 + hd * 128; q[lane] = o1; q[64 + lane] = o2; }
            else { bf16* q = (bf16*)(a.ws + WS_QB) + ((size_t)(b * 6 + hd) * SEQ + t) * 128; q[lane] = (bf16)f2bf(o1); q[64 + lane] = (bf16)f2bf(o2); }
        } else {
            const int kvh = hd - 6;
            float* ko = smp ? a.out + O_KS + (size_t)(row - MP) * 256 + kvh * 128 : a.out + O_KP + (size_t)row * 256 + kvh * 128;
            ko[lane] = o1; ko[64 + lane] = o2;
            if (!smp) { bf16* kb = (bf16*)(a.ws + WS_KB) + ((size_t)(b * 2 + kvh) * SEQ + t) * 128; kb[lane] = (bf16)f2bf(o1); kb[64 + lane] = (bf16)f2bf(o2); }
        }
    }
    {
        const f32x4 v = {bf2f((unsigned)vv & 0xffffu), bf2f(((unsigned)vv) >> 16), bf2f((unsigned)(vv >> 32) & 0xffffu), bf2f((unsigned)(vv >> 48))};
        float* vo = smp ? a.out + O_VS + (size_t)(row - MP) * 256 : a.out + O_VP + (size_t)row * 256;
        *(f32x4*)(vo + 4 * lane) = v;
        if (!smp) { const int kvh = lane >> 5, d = (lane & 31) * 4; *(u64*)((bf16*)(a.ws + WS_VB) + ((size_t)(b * 2 + kvh) * SEQ + t) * 128 + d) = vv; }
    }
    {
#pragma unroll
        for (int p = 0; p < 4; ++p) { const int hd = 2 * p + (lane >> 5);
            const float o1 = q1[p] * c64 - q2[p] * s64, o2 = q2[p] * c64 + q1[p] * s64;
            if (smp) { float* q = (float*)(a.ws + WS_SIQ) + (size_t)(row - MP) * 512 + hd * 64; q[i] = o1; q[32 + i] = o2; }
            else { bf16* q = (bf16*)(a.ws + WS_IQB) + (size_t)row * 512 + hd * 64; q[i] = (bf16)f2bf(o1); q[32 + i] = (bf16)f2bf(o2); } }
        const float rs = rsqrtf(wave_sum_f(k1 * k1 + k2 * k2) * (1.0f / 64.0f) + EPS);
        const float y1 = k1 * rs * a.in[19][i], y2 = k2 * rs * a.in[19][32 + i];
        const float o1 = y1 * c64 - y2 * s64, o2 = y2 * c64 + y1 * s64;
        if (lane < 32) {
            float* ko = smp ? a.out + O_IKS + (size_t)(row - MP) * 64 : a.out + O_IKP + (size_t)row * 64; ko[i] = o1; ko[32 + i] = o2;
            if (!smp) { bf16* kb = (bf16*)(a.ws + WS_IKB) + (size_t)row * 64; kb[i] = (bf16)f2bf(o1); kb[32 + i] = (bf16)f2bf(o2); } }
        if (lane < 8) { const float wv = wraw * (0.35355339059327373f * 0.125f);
            if (smp) ((float*)(a.ws + WS_SIW))[(row - MP) * 8 + lane] = wv; else ((float*)(a.ws + WS_IW))[(size_t)row * 8 + lane] = wv; }
    }
}
__device__ __forceinline__ void p8_dsa_post(Ctx& c, ARGREF a) {
    for (;;) { const int u = q_next(c, 1); if (u >= 384) break; if (u < 256) memattn_prompt_unit(c, a, 1, u); else memattn_sample_unit(c, a, 1, u - 256); }
    const int gw = c.vcu * NWAVES + c.wave, NGW = c.G * NWAVES;
    for (int row = gw; row < MVALID; row += NGW) dsa_post_row(a, row, c.lane);
}

__device__ __forceinline__ void idx_prompt_unit(Ctx& c, ARGREF a, int b, int qb) {
    int tid = c.tid; asm volatile("" : "+v"(tid));
    const int lane = tid & 63, r32 = lane & 31, hh = lane >> 5, w = c.wave;
    const int q0 = b * SEQ + qb * 32;
    LAS bf16* IQL = (LAS bf16*)(c.lds);
    { const bf16* src = (const bf16*)(a.ws + WS_IQB) + (size_t)q0 * 512;
#pragma unroll
      for (int i = 0; i < 4; ++i) { const int row = tid >> 4, ch = (tid & 15) + 16 * i; *(LAS v4u*)(IQL + row * 520 + ch * 8) = *(const v4u*)(src + (size_t)row * 512 + ch * 8); } }
    __syncthreads();
    const bf16* IK = (const bf16*)(a.ws + WS_IKB) + (size_t)(b * SEQ) * 64 + (size_t)r32 * 64 + 8 * hh;
    float* SC = (float*)(a.ws + WS_SC) + (size_t)(q0 + r32) * SEQ;
    float wv[8];
#pragma unroll
    for (int h = 0; h < 8; ++h) wv[h] = ((const float*)(a.ws + WS_IW))[(size_t)(q0 + r32) * 8 + h];
    bf16x8 ak[4], an[4];
    if (w <= qb) {
#pragma unroll
        for (int ks = 0; ks < 4; ++ks) ak[ks] = *(const bf16x8*)(IK + (size_t)(w * 32) * 64 + ks * 16); }
#pragma unroll 1
    for (int kt = w; kt <= qb; kt += 8) {
        if (kt + 8 <= qb) {
#pragma unroll
            for (int ks = 0; ks < 4; ++ks) an[ks] = *(const bf16x8*)(IK + (size_t)((kt + 8) * 32) * 64 + ks * 16); }
        f32x16 sc = {};
        int qoff = r32 * 520 + 8 * hh; asm volatile("" : "+v"(qoff));
#pragma unroll
        for (int h = 0; h < 8; ++h) { f32x16 d = {};
#pragma unroll
            for (int ks = 0; ks < 4; ++ks) d = __builtin_amdgcn_mfma_f32_32x32x16_bf16(ak[ks], *(const LAS bf16x8*)(IQL + qoff + h * 64 + ks * 16), d, 0, 0, 0);
#pragma unroll
            for (int r = 0; r < 16; ++r) sc[r] = fmaf(wv[h], fmaxf(d[r], 0.f), sc[r]); }
#pragma unroll
        for (int g = 0; g < 4; ++g) *(f32x4*)(SC + kt * 32 + 8 * g + 4 * hh) = (f32x4){sc[4 * g], sc[4 * g + 1], sc[4 * g + 2], sc[4 * g + 3]};
#pragma unroll
        for (int ks = 0; ks < 4; ++ks) ak[ks] = an[ks];
    }
}
__device__ __forceinline__ v4u pack8f(const float* p) { const f32x4 x = *(const f32x4*)p, y = *(const f32x4*)(p + 4); v4u o; o.x = pk2(x.x, x.y); o.y = pk2(x.z, x.w); o.z = pk2(y.x, y.y); o.w = pk2(y.z, y.w); return o; }
__device__ __forceinline__ void idx_sample_tile(ARGREF a, int sb, int tl, int lane_) {
    int lane = lane_; asm volatile("" : "+v"(lane));
    const int r32 = lane & 31, hh = lane >> 5, tk = r32 >> 3, hd = r32 & 7;
    const float* iq = (const float*)(a.ws + WS_SIQ) + (size_t)(sb * 4 + tk) * 512 + hd * 64 + 8 * hh;
    const float wv = ((const float*)(a.ws + WS_SIW))[(sb * 4 + tk) * 8 + hd];
    const float* src;
    if (tl < 256) src = a.in[4] + ((size_t)a.page_table[sb * 64 + (tl >> 2)] * 128 + (tl & 3) * 32 + r32) * 64 + 8 * hh;
    else src = a.out + O_IKS + (size_t)(sb * 4 + (r32 & 3)) * 64 + 8 * hh;
    v4u af[4], bf_[4];
#pragma unroll
    for (int ks = 0; ks < 4; ++ks) { af[ks] = pack8f(src + 16 * ks); bf_[ks] = pack8f(iq + 16 * ks); }
    if (tl == 256 && r32 >= 4) {
#pragma unroll
        for (int ks = 0; ks < 4; ++ks) af[ks] = (v4u){0u, 0u, 0u, 0u}; }
    f32x16 d = {};
#pragma unroll
    for (int ks = 0; ks < 4; ++ks) d = __builtin_amdgcn_mfma_f32_32x32x16_bf16(__builtin_bit_cast(bf16x8, af[ks]), __builtin_bit_cast(bf16x8, bf_[ks]), d, 0, 0, 0);
    float* dst = (float*)(a.ws + WS_SSC) + (size_t)(sb * 4 + tk) * SSC_LD + tl * 32;
#pragma unroll
    for (int r = 0; r < 16; ++r) { float v = wv * fmaxf(d[r], 0.f);
        v += __builtin_bit_cast(float, __builtin_amdgcn_update_dpp(0, __builtin_bit_cast(int, v), 0xB1, 0xF, 0xF, false));
        v += __builtin_bit_cast(float, __builtin_amdgcn_update_dpp(0, __builtin_bit_cast(int, v), 0x4E, 0xF, 0xF, false));
        v += __builtin_bit_cast(float, __builtin_amdgcn_update_dpp(0, __builtin_bit_cast(int, v), 0x141, 0xF, 0xF, false));
        if (hd == 0) dst[crow(r, hh)] = v; }
}
__device__ __forceinline__ void p9_indexer(Ctx& c, ARGREF a) {
    const int gw = c.vcu * NWAVES + c.wave, NGW = c.G * NWAVES;
#pragma unroll 1
    for (int wt = gw; wt < 32 * 257; wt += NGW) idx_sample_tile(a, wt / 257, wt % 257, c.lane);
    for (;;) { const int u = q_next(c, 2); if (u >= 512) break; idx_prompt_unit(c, a, u & 3, 127 - (u >> 2)); }
}


__device__ __forceinline__ unsigned fkey(float f) { const unsigned u = __builtin_bit_cast(unsigned, f + 0.0f); return (u & 0x80000000u) ? ~u : (u | 0x80000000u); }
__device__ __forceinline__ void acc_ge(int& cnt, unsigned key, unsigned cand) { asm volatile("v_cmp_le_u32_e32 vcc, %1, %2\n\tv_addc_co_u32_e32 %0, vcc, 0, %0, vcc" : "+v"(cnt) : "s"(cand), "v"(key) : "vcc"); }
__device__ __forceinline__ void acc_ge4(int& c0, int& c1, int& c2, int& c3, unsigned k0, unsigned k1, unsigned k2, unsigned k3, unsigned cand) {
    u64 m0, m1, m2, m3;
    asm volatile("v_cmp_le_u32_e64 %4, %8, %9\n\tv_cmp_le_u32_e64 %5, %8, %10\n\tv_cmp_le_u32_e64 %6, %8, %11\n\tv_cmp_le_u32_e64 %7, %8, %12\n\t"
                 "v_addc_co_u32_e64 %0, %4, 0, %0, %4\n\tv_addc_co_u32_e64 %1, %5, 0, %1, %5\n\tv_addc_co_u32_e64 %2, %6, 0, %2, %6\n\tv_addc_co_u32_e64 %3, %7, 0, %3, %7"
                 : "+v"(c0), "+v"(c1), "+v"(c2), "+v"(c3), "=&s"(m0), "=&s"(m1), "=&s"(m2), "=&s"(m3) : "s"(cand), "v"(k0), "v"(k1), "v"(k2), "v"(k3));
}
__device__ __forceinline__ u64 ballot_nz(unsigned v) { u64 m; asm volatile("v_cmp_ne_u32_e64 %0, 0, %1" : "=s"(m) : "v"(v)); return m; }
__device__ __forceinline__ int wave_sum_dpp(int x) {
    x += __builtin_amdgcn_update_dpp(0, x, 0xB1, 0xF, 0xF, false);
    x += __builtin_amdgcn_update_dpp(0, x, 0x4E, 0xF, 0xF, false);
    x += __builtin_amdgcn_update_dpp(0, x, 0x141, 0xF, 0xF, false);
    x += __builtin_amdgcn_update_dpp(0, x, 0x140, 0xF, 0xF, false);
    return (__builtin_amdgcn_readlane(x, 0) + __builtin_amdgcn_readlane(x, 16)) + (__builtin_amdgcn_readlane(x, 32) + __builtin_amdgcn_readlane(x, 48));
}
__device__ __forceinline__ int mbcnt64(u64 m) { return (int)__builtin_amdgcn_mbcnt_hi((unsigned)(m >> 32), __builtin_amdgcn_mbcnt_lo((unsigned)m, 0u)); }
constexpr int TK_LOWBITS = 18;
__device__ __forceinline__ void topk_finish(unsigned ck, int cp, int A, int posmax, unsigned& T, int& P) {
#pragma unroll 1
    for (int bit = TK_LOWBITS - 1; bit >= 0; --bit) { const unsigned cand = T | (1u << bit); if (A + __builtin_popcountll(__ballot(ck >= cand)) >= 256) T = cand; }
    const int need = 256 - (A + __builtin_popcountll(__ballot(ck > T))), ceq = __builtin_popcountll(__ballot(ck == T));
    P = posmax;
    if (ceq != need) { P = 0;
#pragma unroll 1
        for (int bit = 13; bit >= 0; --bit) { const int cand = P | (1 << bit); if (__builtin_popcountll(__ballot(ck == T && cp < cand)) < need) P = cand; } }
}
__device__ __forceinline__ unsigned wave_min_u(unsigned x) {
    x = min(x, (unsigned)__builtin_amdgcn_update_dpp(0, (int)x, 0xB1, 0xF, 0xF, false)); x = min(x, (unsigned)__builtin_amdgcn_update_dpp(0, (int)x, 0x4E, 0xF, 0xF, false));
    x = min(x, (unsigned)__builtin_amdgcn_update_dpp(0, (int)x, 0x141, 0xF, 0xF, false)); x = min(x, (unsigned)__builtin_amdgcn_update_dpp(0, (int)x, 0x140, 0xF, 0xF, false));
    return min(min((unsigned)__builtin_amdgcn_readlane((int)x, 0), (unsigned)__builtin_amdgcn_readlane((int)x, 16)), min((unsigned)__builtin_amdgcn_readlane((int)x, 32), (unsigned)__builtin_amdgcn_readlane((int)x, 48)));
}
__device__ __forceinline__ unsigned wave_max_u(unsigned x) {
    x = max(x, (unsigned)__builtin_amdgcn_update_dpp(0, (int)x, 0xB1, 0xF, 0xF, false)); x = max(x, (unsigned)__builtin_amdgcn_update_dpp(0, (int)x, 0x4E, 0xF, 0xF, false));
    x = max(x, (unsigned)__builtin_amdgcn_update_dpp(0, (int)x, 0x141, 0xF, 0xF, false)); x = max(x, (unsigned)__builtin_amdgcn_update_dpp(0, (int)x, 0x140, 0xF, 0xF, false));
    return max(max((unsigned)__builtin_amdgcn_readlane((int)x, 0), (unsigned)__builtin_amdgcn_readlane((int)x, 16)), max((unsigned)__builtin_amdgcn_readlane((int)x, 32), (unsigned)__builtin_amdgcn_readlane((int)x, 48)));
}
__device__ __forceinline__ void topk_prompt_rows(ARGREF a, int row0, int stride, int lane_, LAS unsigned* cl) {
    int lane = lane_; asm volatile("" : "+v"(lane));
    const float* SCb = (const float*)(a.ws + WS_SC);
#pragma unroll 1
    for (int row = row0; row < MP; row += stride) {
        const int t = row & 4095;
        u64* mk = (u64*)(a.ws + WS_MASK) + (size_t)row * 64;
        if (t < 256) { u64 myword = 0ull;
#pragma unroll 1
            for (int j = 0; j < 64; ++j) { const u64 m = __ballot(64 * j + lane <= t); if (lane == j) myword = m; }
            mk[lane] = myword;
            continue; }
        unsigned key[64];
        { const float* sc_ = SCb + (size_t)row * SEQ + lane; const int tj_ = t >> 6;
          float v[64];
#pragma unroll
          for (int j = 0; j < 64; ++j) v[j] = sc_[64 * (j < tj_ ? j : tj_)];
          int pj = lane;
#pragma unroll
          for (int j = 0; j < 64; ++j) { const int u = __builtin_bit_cast(int, v[j] + 0.0f); const unsigned k = (unsigned)u ^ ((unsigned)(u >> 31) | 0x80000000u); key[j] = (pj <= t) ? k : 0u; pj += 64; asm volatile("" : "+v"(pj)); } }
        unsigned kh[64];
#pragma unroll
        for (int j = 0; j < 64; ++j) { kh[j] = key[j] >> 1; asm volatile("" : "+v"(kh[j])); }
        unsigned T; int hb;
        {
            unsigned b0 = 0u, b1 = 0u, b2 = 0u, b3 = 0u;
#pragma unroll
            for (int j = 0; j < 64; ++j) { unsigned x = key[j]; const unsigned m0 = max(b0, x); x = min(b0, x); b0 = m0; const unsigned m1 = max(b1, x); x = min(b1, x); b1 = m1; const unsigned m2 = max(b2, x); x = min(b2, x); b2 = m2; b3 = max(b3, x); }
            const unsigned L = wave_min_u(b3), H = wave_max_u(b3), df = L ^ H;
            hb = df ? 31 - __builtin_clz(df) : -1;
            T = hb >= 31 ? 0u : (L & ~((2u << (hb < 0 ? 0 : hb)) - 1u)); if (hb < 0) T = L;
        }
#define TK_FULLCOUNT(CAND, OUT) do { const unsigned cs_ = __builtin_amdgcn_readfirstlane(CAND); int c0_ = 0, c1_ = 0, c2_ = 0, c3_ = 0; \
        _Pragma("unroll") for (int j = 0; j < 64; j += 4) acc_ge4(c0_, c1_, c2_, c3_, key[j], key[j + 1], key[j + 2], key[j + 3], cs_); OUT = wave_sum_dpp((c0_ + c1_) + (c2_ + c3_)); } while (0)
#define TK_FASTCOUNT(CAND, OUT) do { const unsigned ch_ = __builtin_amdgcn_readfirstlane((CAND) >> 1); unsigned a0_ = 0u, a1_ = 0u, a2_ = 0u, a3_ = 0u; \
        _Pragma("unroll") for (int j = 0; j < 64; j += 4) { a0_ = __builtin_amdgcn_alignbit(a0_, kh[j] - ch_, 31); a1_ = __builtin_amdgcn_alignbit(a1_, kh[j + 1] - ch_, 31); \
            a2_ = __builtin_amdgcn_alignbit(a2_, kh[j + 2] - ch_, 31); a3_ = __builtin_amdgcn_alignbit(a3_, kh[j + 3] - ch_, 31); } \
        OUT = 4096 - wave_sum_dpp((__builtin_popcount(a0_) + __builtin_popcount(a1_)) + (__builtin_popcount(a2_) + __builtin_popcount(a3_))); } while (0)
#pragma unroll 1
        for (int bit = hb; bit >= TK_LOWBITS; --bit) { const unsigned cand = T | (1u << bit); int tot; TK_FASTCOUNT(cand, tot); if (tot >= 256) T = cand; }
        const unsigned Tb = T & ~((1u << TK_LOWBITS) - 1u), hib = Tb + (1u << TK_LOWBITS);
        int A = 0, cT; if (hib != 0u) TK_FASTCOUNT(hib, A); TK_FASTCOUNT(Tb, cT);
#undef TK_FASTCOUNT
        int P;
        if (cT - A <= 64) {
            if (lane == 0) cl[128] = 0u;
            int pj = lane;
#pragma unroll
            for (int j = 0; j < 64; ++j) { if ((key[j] - Tb) < (1u << TK_LOWBITS)) { const unsigned pos = __hip_atomic_fetch_add(cl + 128, 1u, __ATOMIC_RELAXED, __HIP_MEMORY_SCOPE_WORKGROUP); if (pos < 64u) { cl[pos] = key[j]; cl[64 + pos] = (unsigned)pj; } }
                pj += 64; asm volatile("" : "+v"(pj)); }
            const int nund = cT - A;
            const unsigned ck = lane < nund ? cl[lane] : 0u; const int cp = (int)cl[64 + lane];
            topk_finish(ck, cp, A, 4095, T, P);
        } else {
#pragma unroll 1
            for (int bit = TK_LOWBITS - 1; bit >= 0; --bit) { const unsigned cand = T | (1u << bit); int tot; TK_FULLCOUNT(cand, tot); if (tot >= 256) T = cand; }
            int cge, cgt; TK_FULLCOUNT(T, cge); cgt = 0; if (T != 0xffffffffu) TK_FULLCOUNT(T + 1u, cgt);
            const int need = 256 - cgt, ceq = cge - cgt; P = 4095;
            if (ceq != need) { P = 0;
#pragma unroll 1
                for (int bit = 11; bit >= 0; --bit) { const int cand = P | (1 << bit); int cnt = 0; int pj = lane;
#pragma unroll
                    for (int j = 0; j < 64; ++j) { cnt += (key[j] == T && pj < cand) ? 1 : 0; pj += 64; asm volatile("" : "+v"(pj)); }
                    if (wave_sum_dpp(cnt) < need) P = cand; } }
        }
#undef TK_FULLCOUNT
        if (P != 4095) {
            int pq = lane;
#pragma unroll
            for (int j = 0; j < 64; ++j) { if (key[j] == T && pq > P) key[j] = 0u; pq += 64; asm volatile("" : "+v"(pq)); } }
        unsigned wlo = 0u, whi = 0u; const unsigned Ts = __builtin_amdgcn_readfirstlane(T);
#pragma unroll
        for (int j = 0; j < 64; ++j) asm volatile("v_cmp_le_u32_e32 vcc, %2, %3\n\ts_nop 3\n\tv_writelane_b32 %0, vcc_lo, %4\n\tv_writelane_b32 %1, vcc_hi, %4" : "+v"(wlo), "+v"(whi) : "s"(Ts), "v"(key[j]), "i"(j) : "vcc");
        mk[lane] = ((u64)whi << 32) | (u64)wlo;
    }
}
__device__ __forceinline__ void topk_sample_row(ARGREF a, int q, int lane_, LAS unsigned* K, LAS unsigned* cl) {
    int lane = lane_; asm volatile("" : "+v"(lane));
    const int t = q & 3, n = PAST + t + 1; const float* sc = (const float*)(a.ws + WS_SSC) + (size_t)q * SSC_LD;
    int* out = (int*)(a.ws + WS_SIDX) + q * 256;
    unsigned key[129];
#pragma unroll
    for (int j = 0; j < 129; ++j) { const float v = sc[64 * j + lane]; key[j] = (j < 128 || lane < n - 8192) ? fkey(v) : 0u; }
#pragma unroll
    for (int j = 0; j < 129; ++j) K[64 * j + lane] = key[j];
#define TK_FULLCOUNT(CAND, OUT) do { const unsigned cs_ = __builtin_amdgcn_readfirstlane(CAND); int c0_ = 0, c1_ = 0, c2_ = 0, c3_ = 0; \
        _Pragma("unroll") for (int j = 0; j < 128; j += 4) acc_ge4(c0_, c1_, c2_, c3_, key[j], key[j + 1], key[j + 2], key[j + 3], cs_); acc_ge(c0_, key[128], cs_); OUT = wave_sum_dpp((c0_ + c1_) + (c2_ + c3_)); } while (0)
    unsigned T = 0u;
#pragma unroll 1
    for (int bit = 31; bit >= TK_LOWBITS; --bit) { const unsigned cand = T | (1u << bit); int tot; TK_FULLCOUNT(cand, tot); if (tot >= 256) T = cand; }
    const unsigned hib = T + (1u << TK_LOWBITS);
    int A = 0, cT; if (hib != 0u) TK_FULLCOUNT(hib, A); TK_FULLCOUNT(T, cT);
    int P;
    if (cT - A <= 64) {
        int base = 0;
#pragma unroll 1
        for (int j0 = 0; j0 < 128; j0 += 8) { unsigned kk[8];
#pragma unroll
            for (int i = 0; i < 8; ++i) kk[i] = K[64 * (j0 + i) + lane];
#pragma unroll
            for (int i = 0; i < 8; ++i) { const unsigned und = (kk[i] - T) < (1u << TK_LOWBITS) ? 1u : 0u; const u64 m = ballot_nz(und); const int pos = base + mbcnt64(m);
                if (und) { cl[pos] = kk[i]; cl[64 + pos] = (unsigned)(64 * (j0 + i) + lane); }
                base += __builtin_popcountll(m); } }
        { const unsigned kj = K[64 * 128 + lane]; const unsigned und = (kj - T) < (1u << TK_LOWBITS) ? 1u : 0u; const u64 m = ballot_nz(und); const int pos = base + mbcnt64(m);
          if (und) { cl[pos] = kj; cl[64 + pos] = (unsigned)(64 * 128 + lane); } base += __builtin_popcountll(m); }
        const unsigned ck = lane < base ? cl[lane] : 0u; const int cp = (int)cl[64 + lane];
        topk_finish(ck, cp, A, 16383, T, P);
    } else {
#pragma unroll 1
        for (int bit = TK_LOWBITS - 1; bit >= 0; --bit) { const unsigned cand = T | (1u << bit); int tot; TK_FULLCOUNT(cand, tot); if (tot >= 256) T = cand; }
        int cge, cgt; TK_FULLCOUNT(T, cge); cgt = 0; if (T != 0xffffffffu) TK_FULLCOUNT(T + 1u, cgt);
        const int need = 256 - cgt, ceq = cge - cgt; P = 16383;
        if (ceq != need) { P = 0;
#pragma unroll 1
            for (int bit = 13; bit >= 0; --bit) { const int cand = P | (1 << bit); int cnt = 0;
#pragma unroll 4
                for (int j = 0; j < 129; ++j) cnt += (K[64 * j + lane] == T && 64 * j + lane < cand) ? 1 : 0;
                if (wave_sum_dpp(cnt) < need) P = cand; } }
    }
#undef TK_FULLCOUNT
    int base = 0;
#pragma unroll 1
    for (int j0 = 0; j0 < 136; j0 += 8) { unsigned kk[8];
#pragma unroll
        for (int i = 0; i < 8; ++i) kk[i] = (j0 + i < 129) ? K[64 * (j0 + i) + lane] : 0u;
#pragma unroll
        for (int i = 0; i < 8; ++i) { const int ps = 64 * (j0 + i) + lane; const unsigned selv = (kk[i] > T || (kk[i] == T && ps <= P)) ? 1u : 0u; const u64 m = ballot_nz(selv);
            const int pos = base + mbcnt64(m);
            if (selv && pos < 256) out[pos] = ps;
            base += __builtin_popcountll(m); } }
}
__device__ __forceinline__ void p10_topk(Ctx& c, ARGREF a) {
    const int gw = c.vcu * NWAVES + c.wave, NGW = c.G * NWAVES;
    LAS unsigned* cl = (LAS unsigned*)(c.lds) + c.wave * 192;
    if (c.wave == 0 && c.vcu < MS) topk_sample_row(a, c.vcu, c.lane, (LAS unsigned*)(c.lds + 8192), cl);
    topk_prompt_rows(a, gw, NGW, c.lane, cl);
}


__device__ __forceinline__ void attn_sample_unit(Ctx& c, ARGREF a, int sb, int t) {
    LAS bf16* KV = (LAS bf16*)(c.lds);
    LAS float* QL = (LAS float*)(c.lds + 69632);
    LAS float* SL = (LAS float*)(c.lds + 69632 + 3072);
    LAS float* OL = (LAS float*)(c.lds + 69632 + 6144);
    LAS int* IL = (LAS int*)(c.lds + 69632 + 12288);
    int tid = c.tid; asm volatile("" : "+v"(tid));
    const int lane = tid & 63, w = c.wave, q = sb * 4 + t;
    __syncthreads();
    if (tid < 256) IL[tid] = ((const int*)(a.ws + WS_SIDX))[q * 256 + tid];
    for (int i = tid; i < 768; i += 512) QL[i] = ((const float*)(a.ws + WS_SQ))[(size_t)q * 768 + i];
    __syncthreads();
    bf16* MIX = (bf16*)(a.ws + WS_MIX) + (size_t)(MP + q) * DM;
#pragma unroll 1
    for (int kvh = 0; kvh < 2; ++kvh) {
#pragma unroll 1
        for (int pass = 0; pass < 2; ++pass) {
            const float* pool = pass ? a.in[3] : a.in[2]; const float* nw = a.out + (pass ? O_VS : O_KS);
            for (int i = tid >> 5; i < 256; i += 16) { const int idx = IL[i]; const float* src;
                if (idx < PAST) src = pool + (((size_t)a.page_table[sb * 64 + (idx >> 7)] * 128 + (idx & 127)) * 2 + kvh) * 128;
                else src = nw + (size_t)(sb * 4 + (idx - PAST)) * 256 + kvh * 128;
                const f32x4 v = *(const f32x4*)(src + (tid & 31) * 4);
                *(LAS u64*)(KV + i * 136 + (tid & 31) * 4) = (u64)pk2(v.x, v.y) | ((u64)pk2(v.z, v.w) << 32); }
            __syncthreads();
            if (pass == 0) {
                const int i = tid >> 1, dh = (tid & 1) * 64; float s0 = 0.f, s1 = 0.f, s2 = 0.f;
#pragma unroll 8
                for (int d = 0; d < 64; ++d) { const float kx = bf2f(KV[i * 136 + dh + d]);
                    s0 = fmaf(QL[(3 * kvh + 0) * 128 + dh + d], kx, s0); s1 = fmaf(QL[(3 * kvh + 1) * 128 + dh + d], kx, s1); s2 = fmaf(QL[(3 * kvh + 2) * 128 + dh + d], kx, s2); }
                s0 += __shfl_xor(s0, 1); s1 += __shfl_xor(s1, 1); s2 += __shfl_xor(s2, 1);
                if ((tid & 1) == 0) { SL[i] = s0 * 0.08838834764831845f; SL[256 + i] = s1 * 0.08838834764831845f; SL[512 + i] = s2 * 0.08838834764831845f; }
                __syncthreads();
                if (w < 3) { float v[4], mx = -1e30f;
#pragma unroll
                    for (int j = 0; j < 4; ++j) { v[j] = SL[w * 256 + 64 * j + lane]; mx = fmaxf(mx, v[j]); }
#pragma unroll
                    for (int o = 1; o < 64; o <<= 1) mx = fmaxf(mx, __shfl_xor(mx, o));
                    float l = 0.f;
#pragma unroll
                    for (int j = 0; j < 4; ++j) { v[j] = __expf(v[j] - mx); l += v[j]; }
                    l = wave_sum(l); const float il = 1.0f / l;
#pragma unroll
                    for (int j = 0; j < 4; ++j) SL[w * 256 + 64 * j + lane] = v[j] * il; }
                __syncthreads();
            } else {
                const int d = tid & 127, part = tid >> 7; float o0 = 0.f, o1 = 0.f, o2 = 0.f;
#pragma unroll 8
                for (int i = part * 64; i < part * 64 + 64; ++i) { const float vx = bf2f(KV[i * 136 + d]); o0 = fmaf(SL[i], vx, o0); o1 = fmaf(SL[256 + i], vx, o1); o2 = fmaf(SL[512 + i], vx, o2); }
                OL[(part * 3 + 0) * 128 + d] = o0; OL[(part * 3 + 1) * 128 + d] = o1; OL[(part * 3 + 2) * 128 + d] = o2;
                __syncthreads();
                if (tid < 384) { const int hq = tid >> 7, dd = tid & 127; const float o = (OL[hq * 128 + dd] + OL[(3 + hq) * 128 + dd]) + (OL[(6 + hq) * 128 + dd] + OL[(9 + hq) * 128 + dd]);
                    MIX[(3 * kvh + hq) * 128 + dd] = (bf16)f2bf(o); }
                __syncthreads();
            }
        }
    }
}


namespace attn {
using bf16 = unsigned short;
typedef short bf16x8 __attribute__((ext_vector_type(8)));
typedef short s16x4 __attribute__((ext_vector_type(4)));
typedef float f32x16 __attribute__((ext_vector_type(16)));
typedef float f32x4 __attribute__((ext_vector_type(4)));
typedef unsigned u32x4 __attribute__((ext_vector_type(4)));
typedef unsigned u32x2 __attribute__((ext_vector_type(2)));
constexpr int D = 128, OS = 1024;
constexpr float THR = 8.f;
constexpr float SCALE = 0.08838834764831845f;
constexpr int NW = 8, QBLK = 32, KVBLK = 64, QB = NW * QBLK;
constexpr int SHM_V = KVBLK * D * 2, SHM_K = KVBLK * D * 2;
constexpr int LDS_BYTES = 2 * SHM_V + 2 * SHM_K + NW * 64 * 4;

#define KSWZ(row, colB) ((row) * 256 + ((colB) ^ (((row) & 7) << 4)))
#define SBAR() __builtin_amdgcn_sched_barrier(0)
__device__ __forceinline__ int v_st(int k, int c) { const int kk = (k & ~0xC) | ((k & 4) << 1) | ((k & 8) >> 1); return ((kk >> 3) * 4 + (c >> 5)) * 512 + ((kk & 7) * 32 + (c & 31)) * 2; }
__device__ __forceinline__ int v_rd_base(int lane) { return ((lane & 3) << 3) | (((lane >> 2) & 3) << 6) | (((lane >> 4) & 1) << 5) | (((lane >> 5) & 1) << 8); }
constexpr int v_rd_off(int d0, int ks, int half) { return d0 * 512 + ks * 4096 + half * 2048; }
__device__ __forceinline__ int crow(int r, int hi) { return (r & 3) + 8 * (r >> 2) + 4 * hi; }
__device__ __forceinline__ unsigned cvtpk(float lo, float hi) {
    unsigned r; asm volatile("v_cvt_pk_bf16_f32 %0, %1, %2" : "=v"(r) : "v"(lo), "v"(hi)); return r;
}
__device__ __forceinline__ bf16x8 pack8(f32x4 a, f32x4 b) {
    u32x4 w = {cvtpk(a[0], a[1]), cvtpk(a[2], a[3]), cvtpk(b[0], b[1]), cvtpk(b[2], b[3])};
    return *reinterpret_cast<bf16x8*>(&w);
}

__device__ __forceinline__ void partialSM(f32x16& p0, f32x16& p1, float& m_reg, float& mn, float& alpha) {
    float pmax = p0[0]; for (int r = 1; r < 16; ++r) pmax = fmaxf(pmax, p0[r]); for (int r = 0; r < 16; ++r) pmax = fmaxf(pmax, p1[r]);
    { auto rr = __builtin_amdgcn_permlane32_swap(__float_as_uint(pmax), __float_as_uint(pmax), false, false);
      pmax = fmaxf(__uint_as_float(rr[0]), __uint_as_float(rr[1])); }
    constexpr float C2 = 1.4426950408889634f * SCALE;
    if (__builtin_expect(__all((pmax - m_reg) * SCALE <= THR), 1)) { mn = m_reg; alpha = 1.f; }
    else { mn = fmaxf(m_reg, pmax); alpha = __builtin_amdgcn_exp2f((m_reg - mn) * C2); m_reg = mn; }
    const float mnL = -mn * C2;
    for (int r = 0; r < 16; ++r) p0[r] = fmaf(p0[r], C2, mnL); for (int r = 0; r < 16; ++r) p1[r] = fmaf(p1[r], C2, mnL);
    for (int r = 0; r < 16; ++r) p0[r] = __builtin_amdgcn_exp2f(p0[r]);
}
__device__ __forceinline__ void finishSM(f32x16& p0, f32x16& p1, float alpha, float& l_reg, bf16x8& pa0, bf16x8& pa1, bf16x8& pa2, bf16x8& pa3) {
    for (int r = 0; r < 16; ++r) p1[r] = __builtin_amdgcn_exp2f(p1[r]);
    float ps = 0; for (int r = 0; r < 16; ++r) ps += p0[r]; for (int r = 0; r < 16; ++r) ps += p1[r];
    { auto rr = __builtin_amdgcn_permlane32_swap(__float_as_uint(ps), __float_as_uint(ps), false, false);
      ps = __uint_as_float(rr[0]) + __uint_as_float(rr[1]); }
    l_reg = l_reg * alpha + ps;
#define PK4(P, B_, OUT) do { unsigned a0 = cvtpk(P[B_+0], P[B_+1]), a1 = cvtpk(P[B_+2], P[B_+3]);                          \
        unsigned b0 = cvtpk(P[B_+4], P[B_+5]), b1 = cvtpk(P[B_+6], P[B_+7]);                                             \
        auto r0 = __builtin_amdgcn_permlane32_swap(a0, b0, false, false); auto r1 = __builtin_amdgcn_permlane32_swap(a1, b1, false, false); \
        u32x4 w = {r0[0], r1[0], r0[1], r1[1]}; OUT = *reinterpret_cast<bf16x8*>(&w); } while (0)
    PK4(p0, 0, pa0); PK4(p0, 8, pa1); PK4(p1, 0, pa2); PK4(p1, 8, pa3);
#undef PK4
}
template <int KB, bool SK>
__device__ __forceinline__ void qkt(f32x16& p0, f32x16& p1, const char* K_lds, int r32, int hi, const bf16x8* qr, bool act) {
    if (SK && !act) { const float NEG = -__builtin_inff();
#pragma unroll
        for (int r = 0; r < 16; ++r) { p0[r] = NEG; p1[r] = NEG; } return; }
    p0 = f32x16{}; p1 = f32x16{};
    const char* kb[4];
#pragma unroll
    for (int dd = 0; dd < 4; ++dd) kb[dd] = K_lds + KB * SHM_K + KSWZ(r32, (dd * 16 + hi * 8) * 2);
#pragma unroll
    for (int d0 = 0; d0 < 8; ++d0) { const char* a = kb[d0 & 3] + (d0 >> 2) * 128;
        bf16x8 b0 = *reinterpret_cast<const bf16x8*>(a);
        bf16x8 b1 = *reinterpret_cast<const bf16x8*>(a + 32 * 256);
        p0 = __builtin_amdgcn_mfma_f32_32x32x16_bf16(b0, qr[d0], p0, 0, 0, 0);
        p1 = __builtin_amdgcn_mfma_f32_32x32x16_bf16(b1, qr[d0], p1, 0, 0, 0); }
}
template <int VB, bool SK>
__device__ __forceinline__ void pv_tile(f32x16* o, int vb0, bf16x8 pa0, bf16x8 pa1, bf16x8 pa2, bf16x8 pa3, bool act) {
    if (SK && !act) return;
#define TRRD(dst, off) asm volatile("ds_read_b64_tr_b16 %0, %1 offset:%2" : "=&v"(dst) : "v"(vb0), "i"(off) : "memory")
#define PV_D0(d0) do { s16x4 l0, l1, l2, l3, h0, h1, h2, h3; constexpr int b_ = VB * SHM_V + v_rd_off(d0, 0, 0);     \
        TRRD(l0, b_); TRRD(h0, b_ + 2048); TRRD(l1, b_ + 4096); TRRD(h1, b_ + 6144); TRRD(l2, b_ + 8192); TRRD(h2, b_ + 10240); TRRD(l3, b_ + 12288); TRRD(h3, b_ + 14336); \
        asm volatile("s_waitcnt lgkmcnt(0)" ::: "memory"); SBAR();                 \
        o[d0] = __builtin_amdgcn_mfma_f32_32x32x16_bf16(pa0, (bf16x8){l0[0], l0[1], l0[2], l0[3], h0[0], h0[1], h0[2], h0[3]}, o[d0], 0, 0, 0);   \
        o[d0] = __builtin_amdgcn_mfma_f32_32x32x16_bf16(pa1, (bf16x8){l1[0], l1[1], l1[2], l1[3], h1[0], h1[1], h1[2], h1[3]}, o[d0], 0, 0, 0);   \
        o[d0] = __builtin_amdgcn_mfma_f32_32x32x16_bf16(pa2, (bf16x8){l2[0], l2[1], l2[2], l2[3], h2[0], h2[1], h2[2], h2[3]}, o[d0], 0, 0, 0);   \
        o[d0] = __builtin_amdgcn_mfma_f32_32x32x16_bf16(pa3, (bf16x8){l3[0], l3[1], l3[2], l3[3], h3[0], h3[1], h3[2], h3[3]}, o[d0], 0, 0, 0); } while (0)
    PV_D0(0); PV_D0(1); PV_D0(2); PV_D0(3);
#undef PV_D0
#undef TRRD
}

__device__ __forceinline__ bf16x8 load8(const bf16* p) { return *reinterpret_cast<const bf16x8*>(p); }
__device__ __forceinline__ void mask_bits(f32x16& p0, f32x16& p1, u32x2 w, int hi) {
    const float NEG = -__builtin_inff();
    asm volatile("" : "+v"(w.x), "+v"(w.y));
    const unsigned lo = w.x >> (4 * hi), up = w.y >> (4 * hi);
#pragma unroll
    for (int r = 0; r < 16; ++r) { const int c = (r & 3) + 8 * (r >> 2);
        if (!((lo >> c) & 1u)) p0[r] = NEG;
        if (!((up >> c) & 1u)) p1[r] = NEG; }
}
struct BlockRef { const bf16* Q; const bf16* K; const bf16* V; bf16* O; const u32x2* M; int P0; };
struct Seam { bf16x8 qr[8]; bf16x8 st_v0, st_v1, st_k0, st_k1; };
#define ROW(p, k0, rr) ((p) + (size_t)((k0) + (rr)) * D + sc)
#define VMW() asm volatile("s_waitcnt vmcnt(0)" ::: "memory")
#define VMWN(n) asm volatile("s_waitcnt vmcnt(%0)" :: "i"(n) : "memory")
#define SLOAD_H(Kp, Vp, k0) do { S.st_v0 = load8(ROW(Vp, k0, sr)); S.st_v1 = load8(ROW(Vp, k0, 32 + sr));              \
                         S.st_k0 = load8(ROW(Kp, k0, sr)); S.st_k1 = load8(ROW(Kp, k0, 32 + sr)); } while (0)
#define SWRITE_HK(bf) do { *(bf16x8*)(K_lds + (bf) * SHM_K + kws) = S.st_k0; *(bf16x8*)(K_lds + (bf) * SHM_K + kws + 32 * 256) = S.st_k1; } while (0)
#define SWRITE_HV(bf) do { *(bf16x8*)(V_lds + (bf) * SHM_V + vst0) = S.st_v0; *(bf16x8*)(V_lds + (bf) * SHM_V + vst1) = S.st_v1; } while (0)
#define SWRITE_H(bf) do { SWRITE_HV(bf); SWRITE_HK(bf); } while (0)
__device__ __forceinline__ void sel_prime(const BlockRef& cur, char* lds, Seam& S) {
    int tid_ = threadIdx.x; asm volatile("" : "+v"(tid_));
    const int tid = tid_, wid = __builtin_amdgcn_readfirstlane(tid >> 6), lane = tid & 63, r32 = lane & 31, hi = lane >> 5;
    const int sr = tid >> 4, sc = (tid & 15) * 8, kws = KSWZ(sr, sc * 2); char* K_lds = lds + 2 * SHM_V;
    for (int d0 = 0; d0 < 8; ++d0) S.qr[d0] = load8(cur.Q + (size_t)(wid * QBLK + r32) * D + d0 * 16 + hi * 8);
    SLOAD_H(cur.K, cur.V, 0); VMW(); SWRITE_HK(0);
    __syncthreads();
}
__device__ __forceinline__ void sel_block(const BlockRef& cur, const BlockRef& nxt, char* lds, Seam& S) {
    int tid_ = threadIdx.x; asm volatile("" : "+v"(tid_));
    const int tid = tid_, wid = __builtin_amdgcn_readfirstlane(tid >> 6), lane = tid & 63, r32 = lane & 31, hi = lane >> 5;
    const int NT = (cur.P0 + QB) / KVBLK;
    char* V_lds = lds; char* K_lds = lds + 2 * SHM_V;
    float* ws = (float*)(lds + 2 * SHM_V + 2 * SHM_K) + wid * 64; float* li_l = ws, * al_l = ws + 32;
    float m_reg = -1e30f, l_reg = 0; f32x16 o[4] = {};
    const int sr = tid >> 4, sc = (tid & 15) * 8, vst0 = v_st(sr, sc), vst1 = v_st(32 + sr, sc), kws = KSWZ(sr, sc * 2);
    const int vb0 = (int)(uintptr_t)V_lds + v_rd_base(lane);
    const bf16* Kh = cur.K; const bf16* Vh = cur.V;
    const char* Mbase = (const char*)cur.M; const unsigned moff = (unsigned)(wid * QBLK + r32) * 512u;
#define MROW(t) (*(const u32x2*)(Mbase + (moff + (unsigned)(t) * 8u)))
#define RESC(a) do { if (__any((a) < 1.f)) { if (hi == 0) al_l[r32] = (a); asm volatile("s_waitcnt lgkmcnt(0)" ::: "memory");              \
                     for (int d_ = 0; d_ < 4; ++d_) for (int r = 0; r < 16; ++r) o[d_][r] *= al_l[crow(r, hi)]; } } while (0)
#define KBASE(t) ((t) * KVBLK)
    f32x16 pA0, pA1, pB0, pB1; float mnA, mnB, alA, alB; bf16x8 pa0, pa1, pa2, pa3; u32x2 mw;
    SWRITE_HV(0); SBAR();
    if (NT > 1) SLOAD_H(Kh, Vh, KBASE(1));
    mw = MROW(0);
    SBAR(); qkt<0, false>(pA0, pA1, K_lds, r32, hi, S.qr, true);
    mask_bits(pA0, pA1, mw, hi); partialSM(pA0, pA1, m_reg, mnA, alA);
    if (NT > 1) { VMW(); SWRITE_H(1); }
    __syncthreads();
#define HALF_STEP(PX0, PX1, mnX, alX, PY0, PY1, alY, t, KB, VB, SB) do {                                                      \
        SBAR(); mw = MROW(t); qkt<KB, false>(PX0, PX1, K_lds, r32, hi, S.qr, true);                                          \
        finishSM(PY0, PY1, alY, l_reg, pa0, pa1, pa2, pa3); SBAR();                                                           \
        if ((t) + 1 < NT) { SLOAD_H(Kh, Vh, KBASE((t) + 1)); SBAR(); }                                                        \
        pv_tile<VB, false>(o, vb0, pa0, pa1, pa2, pa3, true); mask_bits(PX0, PX1, mw, hi); partialSM(PX0, PX1, m_reg, mnX, alX); \
        __syncthreads();                                                                                                      \
        if ((t) + 1 < NT) { VMW(); SWRITE_H(SB); }                                                                            \
        RESC(alX); __syncthreads(); } while (0)
    for (int t = 1; t + 1 < NT; t += 2) {
        HALF_STEP(pB0, pB1, mnB, alB, pA0, pA1, alA, t, 1, 0, 0);
        HALF_STEP(pA0, pA1, mnA, alA, pB0, pB1, alB, t + 1, 0, 1, 1);
    }
    const bool even = (NT & 1) == 0;
    if (even) { SBAR(); mw = MROW(NT - 1); qkt<1, false>(pB0, pB1, K_lds, r32, hi, S.qr, true); SBAR(); }
    SLOAD_H(nxt.K, nxt.V, 0); SBAR();
#pragma unroll
    for (int d0 = 0; d0 < 8; ++d0) S.qr[d0] = load8(nxt.Q + (size_t)(wid * QBLK + r32) * D + d0 * 16 + hi * 8);
    SBAR();
    finishSM(pA0, pA1, alA, l_reg, pa0, pa1, pa2, pa3); SBAR();
    pv_tile<0, false>(o, vb0, pa0, pa1, pa2, pa3, true);
    if (even) { mask_bits(pB0, pB1, mw, hi); partialSM(pB0, pB1, m_reg, mnB, alB); __syncthreads(); RESC(alB);
        finishSM(pB0, pB1, alB, l_reg, pa0, pa1, pa2, pa3); SBAR(); pv_tile<1, false>(o, vb0, pa0, pa1, pa2, pa3, true); }
    SBAR(); VMWN(8); SWRITE_HK(0); SBAR();
    if (hi == 0) li_l[r32] = l_reg; asm volatile("s_waitcnt lgkmcnt(0)" ::: "memory");
    float rli[16];
#pragma unroll
    for (int r = 0; r < 16; ++r) rli[r] = __builtin_amdgcn_rcpf(li_l[crow(r, hi)]);
    bf16* Ow = cur.O + (size_t)(wid * QBLK) * OS;
#pragma unroll
    for (int r = 0; r < 16; ++r) { const int orow = crow(r, hi);
#pragma unroll
        for (int d0 = 0; d0 < 4; ++d0) { const float v = o[d0][r] * rli[r];
            const float vn = __shfl_xor(v, 1);
            if ((r32 & 1) == 0) *(unsigned*)(Ow + (size_t)orow * OS + d0 * 32 + r32) = cvtpk(v, vn); } }
    __syncthreads();
#undef RESC
#undef KBASE
#undef HALF_STEP
#undef MROW
}
#undef ROW
#undef VMW
#undef VMWN
#undef SLOAD_H
#undef SWRITE_HK
#undef SWRITE_HV
#undef SWRITE_H
#undef KSWZ
#undef SBAR
}


__device__ __forceinline__ attn::BlockRef attn_ref(ARGREF a, int b, int h, int qb) {
    attn::BlockRef r; const int kvh = h / 3;
    r.Q = (const attn::bf16*)(a.ws + WS_QB) + ((size_t)(b * 6 + h) * SEQ + (size_t)qb * 256) * 128;
    r.K = (const attn::bf16*)(a.ws + WS_KB) + (size_t)(b * 2 + kvh) * SEQ * 128;
    r.V = (const attn::bf16*)(a.ws + WS_VB) + (size_t)(b * 2 + kvh) * SEQ * 128;
    r.O = (attn::bf16*)(a.ws + WS_MIX) + (size_t)(b * SEQ + qb * 256) * DM + h * 128;
    r.M = (const attn::u32x2*)(a.ws + WS_MASK) + (size_t)(b * SEQ + qb * 256) * 64;
    r.P0 = qb * 256; return r;
}
__device__ __forceinline__ void p11_attention(Ctx& c, ARGREF a) {
    constexpr int NITEM = 192;
#pragma unroll 1
    for (int it = c.vcu; it < NITEM; it += c.G) {
        const int p = it & 7, bh = it >> 3, b = bh / 6, h = bh % 6;
        attn::Seam S;
        attn::BlockRef cur = attn_ref(a, b, h, p), nxt = attn_ref(a, b, h, 15 - p);
        __syncthreads();
        attn::sel_prime(cur, (char*)c.lds, S);
        attn::sel_block(cur, nxt, (char*)c.lds, S);
        attn::sel_block(nxt, nxt, (char*)c.lds, S);
    }
    const int spare = c.G - NITEM;
    if (spare > 0) { if (c.vcu >= NITEM) for (int u = c.vcu - NITEM; u < MS; u += spare) attn_sample_unit(c, a, u >> 2, u & 3); }
    else for (int u = c.vcu; u < MS; u += c.G) attn_sample_unit(c, a, u >> 2, u & 3);
}

enum { PH_PRO = 0, PH_IN0, PH_MIX0, PH_HSCAN, PH_HFIX, PH_OUT0, PH_GU0, PH_DOWN0, PH_IN1, PH_POST, PH_IDX, PH_TOPK, PH_ATTN, PH_OUT1, PH_GU1, PH_DOWN1, NPHASE };
#ifndef ONLYPH
#define ONLYPH -1
#endif
#define PHON(x) (ONLYPH < 0 || ONLYPH == (x))
#ifndef REP_PH
#define REP_PH -1
#endif
#ifndef REP_N
#define REP_N 1
#endif
__global__ void __launch_bounds__(NWAVES * 64, 2) fwd_kernel(Args args) {
    extern __shared__ __attribute__((aligned(16))) unsigned char lds[];
    Ctx c;
    c.lds = (LAS unsigned char*)lds;
    c.MISC = (volatile LAS unsigned*)(c.lds + MISC_OFF);
    c.tid = threadIdx.x; c.lane = c.tid & 63; c.wave = __builtin_amdgcn_readfirstlane(c.tid >> 6);
    c.G = gridDim.x; { const int bx = blockIdx.x; c.vcu = (c.G % 8 == 0) ? (bx % 8) * (c.G / 8) + bx / 8 : bx; }
    c.ctl = (gu32*)(args.ws + WS_CTL);
    for (int u = c.tid; u < (LDS_BYTES - LDSCTL_OFF) / 4; u += NWAVES * 64) ((LAS unsigned*)(c.lds + LDSCTL_OFF))[u] = 0u;
    __syncthreads();
    const int lo = args.ph_lo, hi = args.ph_hi;
    XcdBarrier bar; bar.bar = (unsigned*)(c.ctl + CW_BAR); bar.x = 0; bar.st = nullptr;
    if (hi - lo > 1 || REP_N > 1) bar = xcd_barrier_post((unsigned*)(c.ctl + CW_BAR), c.MISC + 8);
    c.qoff = 0;
#pragma unroll 1
    for (int ph = lo; ph < hi; ++ph) {
        const int layer = ph >= PH_IN1 ? 1 : 0;
        const __attribute__((address_space(4))) Args* ap = (const __attribute__((address_space(4))) Args*)__builtin_amdgcn_kernarg_segment_ptr(); asm volatile("" : "+s"(ap));
        ARGREF la = *ap; unsigned char* const ws = la.ws; float* const out = la.out;
        { int t_ = threadIdx.x; asm volatile("" : "+v"(t_)); c.tid = t_; c.lane = t_ & 63; c.wave = __builtin_amdgcn_readfirstlane(t_ >> 6); }
        if ((ph == PH_DOWN0 || ph == PH_DOWN1) && PHON(PH_OUT0)) {
            pg8::SchedX S0; S0.init(MP, 1024, c.G, (int)blockIdx.x, 0, 0, 1, 0); pg8::Unit u0; if (S0.next(0, u0)) conv_fixup_tile(c, la, layer, u0.pm); VM_WAIT(); __syncthreads(); }
        if (ph == PH_PRO && PHON(PH_PRO)) p0_prologue(c, la);
        else if ((ph == PH_IN0 || ph == PH_IN1) && PHON(PH_IN0)) {
            pg8::Gemm g{(const pg8::bf16_t*)(ws + WS_XB), (const pg8::bf16_t*)(ws + (ph == PH_IN0 ? WS_WIN0 : WS_WIN1)), MT, 0, 1024};
            pg8::SchedX S; if (ph == PH_IN0) S.init(MP, ZC0, c.G, (int)blockIdx.x, 16, MT / 256, 4, 13); else S.init(MP, ZC1, c.G, (int)blockIdx.x, 0, 0, 1, 0);
            pg8::EpiZ E{(pg8::bf16_t*)(ws + WS_Z), ph == PH_IN0 ? ZC0 : ZC1, ssptr(c, ph == PH_IN0 ? 0 : 2), ph == PH_IN0 ? 13 : 9, (float*)(ws + WS_MEMKV), MEMROW0};
            pg8::gemm_phase<pg8::EpiZ, pg8::SchedX, PG8_ALIGN, PG8_SP2>(c.lds + RING_OFF, g, S, E);
            { SgArgs sg{}; sg.A = (const bf16*)(ws + WS_XB) + (size_t)MP * DM; sg.Bt = (const bf16*)(ws + (ph == PH_IN0 ? WS_WIN0 : WS_WIN1)); sg.K = 1024; sg.mode = 0; sg.Z = (bf16*)(ws + WS_Z); sg.ldz = ph == PH_IN0 ? ZC0 : ZC1; sg.ssin = ssptr(c, ph == PH_IN0 ? 0 : 2);
              sgemm_phase(c, sg, ph == PH_IN0 ? ZC0 : ZC1); }
        }
        else if (ph == PH_MIX0 && PHON(PH_MIX0)) p2_mixer0(c, la);
        else if (ph == PH_HSCAN && PHON(PH_HSCAN)) hgrn_scan(c, la);
        else if (ph == PH_HFIX && PHON(PH_HFIX)) p2c_hgrn_fix(c, la);
        else if ((ph == PH_OUT0 || ph == PH_DOWN0 || ph == PH_OUT1 || ph == PH_DOWN1) && PHON(PH_OUT0)) {
            const bool isout = (ph == PH_OUT0 || ph == PH_OUT1);
            pg8::Gemm g{(const pg8::bf16_t*)(ws + (isout ? WS_MIX : WS_ACT)), (const pg8::bf16_t*)(ws + (isout ? WS_WOUT + (size_t)layer * 1024 * 1024 * 2 : WS_WD + (size_t)layer * 1024 * DFF * 2)), MT, 1024, isout ? 1024 : DFF};
            pg8::SchedX S; S.init(MP, 1024, c.G, (int)blockIdx.x, 0, 0, 1, 0);
            pg8::EpiResid E;
            E.rp = ph == PH_OUT0 ? la.in[0] : nullptr; E.rb = (const pg8::bf16_t*)(ws + WS_XB); E.y = ph == PH_DOWN1 ? out + O_YP : nullptr;
            E.xb = ph == PH_DOWN1 ? nullptr : (pg8::bf16_t*)(ws + WS_XB); E.ssout = ph == PH_DOWN1 ? nullptr : ssptr(c, ph == PH_OUT0 ? 1 : (ph == PH_DOWN0 ? 2 : 3));
            pg8::gemm_phase<pg8::EpiResid, pg8::SchedX, PG8_ALIGN, PG8_SP2>(c.lds + RING_OFF, g, S, E);
            { SgArgs sg{}; sg.A = (const bf16*)(ws + (isout ? WS_MIX : WS_ACT)) + (size_t)MP * (isout ? 1024 : DFF); sg.Bt = (const bf16*)g.Bt; sg.K = isout ? 1024 : DFF; sg.mode = 1; sg.rb = (const bf16*)(ws + WS_XB); sg.resid = ph == PH_OUT0 ? la.in[1] : nullptr; sg.y = ph == PH_DOWN1 ? out + O_YS : nullptr; sg.xb = (bf16*)E.xb; sg.ssout = E.ssout;
              sgemm_phase(c, sg, 1024); }
        }
        else if ((ph == PH_GU0 || ph == PH_GU1) && PHON(PH_GU0)) {
            pg8::Gemm g{(const pg8::bf16_t*)(ws + WS_XB), (const pg8::bf16_t*)(ws + WS_WGU + (size_t)layer * 5632 * 1024 * 2), MT, 5632, 1024};
            pg8::SchedX S; S.init(MP, 5632, c.G, (int)blockIdx.x, 0, 0, 1, 0);
            pg8::EpiGU E{(pg8::bf16_t*)(ws + WS_ACT), ssptr(c, layer ? 3 : 1), out + O_CVP + (size_t)layer * 4 * 2 * DFF, la.in[26] + (size_t)layer * 3 * DFF, la.in[27] + (size_t)layer * DFF, (float*)(ws + WS_G4), (float*)(ws + WS_UP2)};
            pg8::gemm_phase<pg8::EpiGU, pg8::SchedX, PG8_ALIGN, PG8_SP2>(c.lds + RING_OFF, g, S, E);
            { SgArgs sg{}; sg.A = (const bf16*)(ws + WS_XB) + (size_t)MP * DM; sg.Bt = (const bf16*)g.Bt; sg.K = 1024; sg.mode = 2; sg.ssin = E.ss; sg.ACT = (bf16*)E.ACT; sg.cvs = out + O_CVS + (size_t)layer * 32 * 2 * DFF; sg.cst = la.in[8] + (size_t)layer * 32 * 2 * DFF; sg.cw = E.cw; sg.cb = E.cb;
              sgemm_phase(c, sg, 5632); }
        }
        else if (ph == PH_POST && PHON(PH_POST)) p8_dsa_post(c, la);
        else if (ph == PH_IDX && PHON(PH_IDX)) p9_indexer(c, la);
        else if (ph == PH_TOPK && PHON(PH_TOPK)) p10_topk(c, la);
        else if (ph == PH_ATTN && PHON(PH_ATTN)) p11_attention(c, la);
        if (REP_N > 1 && ph == REP_PH && c.qoff < 4 * (REP_N - 1)) { c.qoff += 4; --ph; xcd_barrier(bar); continue; }
        if (REP_N > 1) c.qoff = 0;
        if (ph + 1 < hi) xcd_barrier(bar);
    }
}

#ifndef MK_ONE_LAUNCH
#define MK_ONE_LAUNCH 1
#endif
extern "C" void kernel_launch(void* const* d_in, const int* in_sizes, int n_in, void* d_out, int out_size, void* d_ws, size_t ws_size, hipStream_t stream) {
    static int grid = 0;
    if (grid == 0) {
        if (n_in != 29 || out_size != (int)O_END || ws_size < WS_END) { fprintf(stderr, "kernel_launch: unexpected problem (n_in %d, out %d, ws %zu)\n", n_in, out_size, ws_size); grid = -1; return; }
        int dev = 0, cus = 0;
        if (hipGetDevice(&dev) != hipSuccess || hipDeviceGetAttribute(&cus, hipDeviceAttributeMultiprocessorCount, dev) != hipSuccess) { grid = -1; return; }
        if (hipFuncSetAttribute((const void*)fwd_kernel, hipFuncAttributeMaxDynamicSharedMemorySize, LDS_BYTES) != hipSuccess) { fprintf(stderr, "kernel_launch: hipFuncSetAttribute failed\n"); grid = -1; return; }
        (void)hipGetLastError();
        grid = cus;
    }
    if (grid < 0) return;
    if (hipMemsetAsync((char*)d_ws + WS_CTL, 0, CTL_ZERO_BYTES, stream) != hipSuccess) { fprintf(stderr, "kernel_launch: memset failed\n"); return; }
    Args a{};
    for (int i = 0; i < 29; ++i) a.in[i] = (const float*)d_in[i];
    a.page_table = (const int*)d_in[9]; a.out = (float*)d_out; a.ws = (unsigned char*)d_ws;
#if MK_ONE_LAUNCH
    a.ph_lo = 0; a.ph_hi = NPHASE;
    hipLaunchKernelGGL(fwd_kernel, dim3(grid), dim3(NWAVES * 64), LDS_BYTES, stream, a);
#else
    for (int ph = 0; ph < NPHASE; ++ph) { a.ph_lo = ph; a.ph_hi = ph + 1; hipLaunchKernelGGL(fwd_kernel, dim3(grid), dim3(NWAVES * 64), LDS_BYTES, stream, a); }
#endif
}
```

```cpp
#include <hip/hip_runtime.h>
#include <cstdio>
#include <cstdint>


namespace pg8 {
#define PG8_LAS __attribute__((address_space(3)))
typedef unsigned short bf16_t;
typedef short bf16x8 __attribute__((ext_vector_type(8)));
typedef float f32x4 __attribute__((ext_vector_type(4)));
typedef unsigned u32x4 __attribute__((ext_vector_type(4)));
constexpr int BM = 256, BK = 64, HALF = 128, HTB = HALF * BK * 2  , STAGE_BYTES = 8 * HTB, NXCD = 8, WGM = 8;

__host__ __device__ __forceinline__ int lds_byte(int r, int c) { const int st = (r >> 4) * 2 + (c >> 5), rr = r & 15, cc = c & 31, ob = rr * 64 + cc * 2; return st * 1024 + (ob ^ (((ob >> 9) & 1) << 5)); }
__host__ __device__ __forceinline__ void stage_rc(int b, int& R, int& C) { const int st = b / 1024, sb = b % 1024, swz = sb ^ (((sb >> 9) & 1) << 5); R = (st >> 1) * 16 + swz / 64; C = (st & 1) * 32 + (swz % 64) / 2; }
__host__ __device__ __forceinline__ int perm32(int rho) { const int n = rho >> 4, i = rho & 15; return 8 * (i >> 2) + 4 * n + (i & 3); }

struct Unit { int pm, pn; };
struct Gemm { const bf16_t* A; const bf16_t* Bt; int M, N, K; };

struct StaticOrder {
    int nM, nN, nwg, G, c;
    __host__ __device__ __forceinline__ void init(int M, int N, int G_, int c_) { nM = M / BM; nN = N / BM; nwg = nM * nN; G = G_; c = c_; }
    __host__ __device__ __forceinline__ bool next(int i, Unit& u) const {
        const long L = (long)i * G + c; if (L >= nwg) return false;
        int wgid = (int)L; { const int q = nwg / NXCD, r = nwg % NXCD, xcd = wgid % NXCD, off = wgid / NXCD; wgid = (xcd < r ? xcd * (q + 1) : r * (q + 1) + (xcd - r) * q) + off; }
        const int nig = WGM * nN, gid = wgid / nig, fm = gid * WGM, gsz = (nM - fm) < WGM ? (nM - fm) : WGM;
        u.pm = fm + ((wgid % nig) % gsz); u.pn = (wgid % nig) / gsz; return true;
    }
    __device__ __forceinline__ void a_ready(const Unit&) const {}
    __device__ __forceinline__ void done(const Unit&) const {}
};


constexpr int MP = 16384, MS = 128, MVALID = MP + MS, MT = 16640, DM = 1024, DFF = 2816;
constexpr float RMS_EPS = 1e-6f;
__device__ __forceinline__ unsigned cvt_pk_bf16(float lo, float hi) { unsigned r; asm volatile("v_cvt_pk_bf16_f32 %0, %1, %2" : "=v"(r) : "v"(lo), "v"(hi)); return r; }

struct SchedX {
    StaticOrder so; int nextra, e_pm0, e_nm, e_pn0;
    __device__ __forceinline__ void init(int M, int N, int G_, int c_, int nextra_, int e_pm0_, int e_nm_, int e_pn0_) { so.init(M, N, G_, c_); nextra = nextra_; e_pm0 = e_pm0_; e_nm = e_nm_; e_pn0 = e_pn0_; }
    __device__ __forceinline__ bool next(int i, Unit& u) const {
        const long L = (long)i * so.G + so.c;
        if (L < so.nwg) return so.next(i, u);
        const int e = (int)(L - so.nwg); if (e >= nextra) return false;
        u.pm = e_pm0 + e % e_nm; u.pn = e_pn0 + e / e_nm; return true;
    }
    __device__ __forceinline__ void a_ready(const Unit&) const {}
    __device__ __forceinline__ void done(const Unit&) const {}
};

struct EpiZ {
    static constexpr bool PERM = true, AFTER_DRAIN = false;
    bf16_t* Z; int ldz; const float* ss; int nmain; float* memkv; int memrow0;
    __device__ __forceinline__ void operator()(const f32x4 (&acc)[2][2][4][2], const Unit& u, int wr, int wc, int fr, int fq) const {
        const int row0 = u.pm * BM + wr * 64 + fr;
        if (u.pn < nmain) {
            const int col0 = u.pn * BM + wc * 32 + 8 * fq;
#pragma unroll
            for (int ai = 0; ai < 2; ++ai)
#pragma unroll
                for (int m = 0; m < 4; ++m) { const int row = row0 + ai * HALF + m * 16; const float rs = rsqrtf(ss[row] * (1.0f / DM) + RMS_EPS);
#pragma unroll
                    for (int bj = 0; bj < 2; ++bj) { const f32x4 v0 = acc[ai][bj][m][0] * rs, v1 = acc[ai][bj][m][1] * rs;
                        u32x4 w; w.x = cvt_pk_bf16(v0[0], v0[1]); w.y = cvt_pk_bf16(v0[2], v0[3]); w.z = cvt_pk_bf16(v1[0], v1[1]); w.w = cvt_pk_bf16(v1[2], v1[3]);
                        *(u32x4*)(Z + (size_t)row * ldz + col0 + bj * HALF) = w; } }
        } else {
            const int col0 = (u.pn - nmain) * BM + wc * 32 + 8 * fq;
#pragma unroll
            for (int ai = 0; ai < 2; ++ai)
#pragma unroll
                for (int m = 0; m < 4; ++m) { const int row = row0 + ai * HALF + m * 16 - memrow0;
#pragma unroll
                    for (int bj = 0; bj < 2; ++bj) { float* p = memkv + (size_t)row * 1024 + col0 + bj * HALF; *(f32x4*)p = acc[ai][bj][m][0]; *(f32x4*)(p + 4) = acc[ai][bj][m][1]; } }
        }
    }
};

struct EpiResid {
    static constexpr bool PERM = true, AFTER_DRAIN = false;
    const float* rp; const bf16_t* rb; float* y; bf16_t* xb; float* ssout;
    __device__ __forceinline__ void operator()(const f32x4 (&acc)[2][2][4][2], const Unit& u, int wr, int wc, int fr, int fq) const {
        const int row0 = u.pm * BM + wr * 64 + fr, col0 = u.pn * BM + wc * 32 + 8 * fq;
#pragma unroll
        for (int ai = 0; ai < 2; ++ai)
#pragma unroll
            for (int m = 0; m < 4; ++m) { const int row = row0 + ai * HALF + m * 16; float part = 0.f;
#pragma unroll
                for (int bj = 0; bj < 2; ++bj) { const int c = col0 + bj * HALF; f32x4 r0, r1;
                    if (rp) { r0 = *(const f32x4*)(rp + (size_t)row * DM + c); r1 = *(const f32x4*)(rp + (size_t)row * DM + c + 4); }
                    else { const u32x4 q = *(const u32x4*)(rb + (size_t)row * DM + c);
                        r0 = (f32x4){__builtin_bit_cast(float, q.x << 16), __builtin_bit_cast(float, q.x & 0xffff0000u), __builtin_bit_cast(float, q.y << 16), __builtin_bit_cast(float, q.y & 0xffff0000u)};
                        r1 = (f32x4){__builtin_bit_cast(float, q.z << 16), __builtin_bit_cast(float, q.z & 0xffff0000u), __builtin_bit_cast(float, q.w << 16), __builtin_bit_cast(float, q.w & 0xffff0000u)}; }
                    const f32x4 v0 = acc[ai][bj][m][0] + r0, v1 = acc[ai][bj][m][1] + r1;
                    if (y) { *(f32x4*)(y + (size_t)row * DM + c) = v0; *(f32x4*)(y + (size_t)row * DM + c + 4) = v1; }
                    part += (v0[0] * v0[0] + v0[1] * v0[1]) + (v0[2] * v0[2] + v0[3] * v0[3]) + (v1[0] * v1[0] + v1[1] * v1[1]) + (v1[2] * v1[2] + v1[3] * v1[3]);
                    if (xb) { u32x4 w; w.x = cvt_pk_bf16(v0[0], v0[1]); w.y = cvt_pk_bf16(v0[2], v0[3]); w.z = cvt_pk_bf16(v1[0], v1[1]); w.w = cvt_pk_bf16(v1[2], v1[3]);
                        *(u32x4*)(xb + (size_t)row * DM + c) = w; } }
                part += __shfl_xor(part, 16); part += __shfl_xor(part, 32);
                if (ssout && fq == 0) atomicAdd(ssout + row, part); }
    }
};

__device__ __forceinline__ void dpp_ror12(const f32x4& v, f32x4& r1, f32x4& r2) {
    float a0, a1, a2, a3, b0, b1, b2, b3;
    asm volatile("s_nop 1\n\t"
                 "v_mov_b32_dpp %0, %8 row_ror:1 row_mask:0xf bank_mask:0xf\n\tv_mov_b32_dpp %1, %9 row_ror:1 row_mask:0xf bank_mask:0xf\n\t"
                 "v_mov_b32_dpp %2, %10 row_ror:1 row_mask:0xf bank_mask:0xf\n\tv_mov_b32_dpp %3, %11 row_ror:1 row_mask:0xf bank_mask:0xf\n\t"
                 "v_mov_b32_dpp %4, %8 row_ror:2 row_mask:0xf bank_mask:0xf\n\tv_mov_b32_dpp %5, %9 row_ror:2 row_mask:0xf bank_mask:0xf\n\t"
                 "v_mov_b32_dpp %6, %10 row_ror:2 row_mask:0xf bank_mask:0xf\n\tv_mov_b32_dpp %7, %11 row_ror:2 row_mask:0xf bank_mask:0xf"
                 : "=&v"(a0), "=&v"(a1), "=&v"(a2), "=&v"(a3), "=&v"(b0), "=&v"(b1), "=&v"(b2), "=&v"(b3) : "v"(v[0]), "v"(v[1]), "v"(v[2]), "v"(v[3]));
    r1 = (f32x4){a0, a1, a2, a3}; r2 = (f32x4){b0, b1, b2, b3};
}
struct EpiGU {
    static constexpr bool PERM = true, AFTER_DRAIN = false;
    bf16_t* ACT; const float* ss; float* cvp; const float* cw; const float* cb; float* G4; float* UP2;
    __device__ __forceinline__ void operator()(const f32x4 (&acc)[2][2][4][2], const Unit& u, int wr, int wc, int fr, int fq) const {
        const int row0 = u.pm * BM + wr * 64 + fr, colg = u.pn * HALF + wc * 32 + 8 * fq;
#pragma unroll
        for (int n = 0; n < 2; ++n) { const int col = colg + 4 * n;
            const f32x4 w0 = *(const f32x4*)(cw + col), w1 = *(const f32x4*)(cw + DFF + col), w2 = *(const f32x4*)(cw + 2 * DFF + col), bb = *(const f32x4*)(cb + col);
#pragma unroll
            for (int ai = 0; ai < 2; ++ai) { f32x4 r1p = {0.f, 0.f, 0.f, 0.f}, r2p = r1p; const int slab = (u.pm * BM + ai * HALF + wr * 64) >> 6;
#pragma unroll
                for (int m = 0; m < 4; ++m) { const int row = row0 + ai * HALF + m * 16; const float rs = rsqrtf(ss[row] * (1.0f / DM) + RMS_EPS);
                    const f32x4 g = acc[ai][0][m][n] * rs, up = acc[ai][1][m][n] * rs;
                    f32x4 r1, r2; dpp_ror12(g, r1, r2);
                    const f32x4 p1 = fr >= 1 ? r1 : r1p, p2 = fr >= 2 ? r2 : r2p;
                    f32x4 cv = bb + w0 * p2 + w1 * p1 + w2 * g, y;
#pragma unroll
                    for (int i = 0; i < 4; ++i) y[i] = cv[i] * __builtin_amdgcn_rcpf(1.0f + __expf(-cv[i])) * up[i];
                    if (m == 0 && fr < 2) { *(f32x4*)(G4 + (size_t)(slab * 4 + fr) * DFF + col) = g; *(f32x4*)(UP2 + (size_t)(slab * 2 + fr) * DFF + col) = up; }
                    else { typedef unsigned u32x2 __attribute__((ext_vector_type(2))); u32x2 w; w.x = cvt_pk_bf16(y[0], y[1]); w.y = cvt_pk_bf16(y[2], y[3]); *(u32x2*)(ACT + (size_t)row * DFF + col) = w; }
                    if (m == 3 && fr >= 14) { *(f32x4*)(G4 + (size_t)(slab * 4 + 2 + (fr - 14)) * DFF + col) = g;
                        const int t = row & 4095; if (t >= 4094) *(f32x4*)(cvp + (size_t)((row >> 12) * 2 + (t - 4094)) * DFF + col) = g; }
                    r1p = r1; r2p = r2; } } }
    }
};

template <class Epi, class Sched, bool ALIGN_EPI = false, bool SP2 = false>
__device__ __forceinline__ void gemm_phase(PG8_LAS unsigned char* lds, const Gemm g, const Sched& S, const Epi& E) {
    int tid_ = threadIdx.x; asm volatile("" : "+v"(tid_));
    const int tid = tid_, wid = __builtin_amdgcn_readfirstlane(tid >> 6), lane = tid & 63, wr = wid >> 2, wc = wid & 3, fr = lane & 15, fq = lane >> 4;
    const int K = g.K, nt = K / BK;
    unsigned voffA[2], voffB[2];
#pragma unroll
    for (int i = 0; i < 2; ++i) { int R, C; stage_rc(tid * 16 + i * 8192, R, C); const int Rb = Epi::PERM ? ((R & ~31) + perm32(R & 31)) : R;
        voffA[i] = (unsigned)(R * K + C) * 2u; voffB[i] = (unsigned)(Rb * K + C) * 2u; }
    const size_t kstep = (size_t)(BK * 2);
    const size_t hstep = (size_t)HALF * K * 2;
    const size_t tstep = 2 * hstep;
    const unsigned ldsw = (unsigned)wid * 1024u;
    const int aoff = lds_byte(wr * 64 + fr, fq * 8), boff = lds_byte(wc * 32 + fr, fq * 8);
#define PG8_SA(b, h) (((b) * 2 + (h)) * HTB)
#define PG8_SB(b, h) ((4 + (b) * 2 + (h)) * HTB)
#define PG8_STAGE(bufoff, gbase, voff) do { _Pragma("unroll") for (int _i = 0; _i < 2; ++_i) \
        __builtin_amdgcn_global_load_lds((const unsigned*)((const char*)(gbase) + (voff)[_i]), (PG8_LAS unsigned*)(lds + (bufoff) + ldsw + _i * 8192), 16, 0, 0); } while (0)
#define PG8_LDA(dst, b, h) do { _Pragma("unroll") for (int m = 0; m < 4; ++m) _Pragma("unroll") for (int k = 0; k < 2; ++k) dst[m][k] = *(const PG8_LAS bf16x8*)(lds + PG8_SA(b, h) + aoff + m * 2048 + k * 1024); } while (0)
#define PG8_LDB(dst, b, h) do { _Pragma("unroll") for (int n = 0; n < 2; ++n) _Pragma("unroll") for (int k = 0; k < 2; ++k) dst[n][k] = *(const PG8_LAS bf16x8*)(lds + PG8_SB(b, h) + boff + n * 2048 + k * 1024); } while (0)
#define PG8_MMA(ai, bj, At, Bt) do { __builtin_amdgcn_s_setprio(1); _Pragma("unroll") for (int m = 0; m < 4; ++m) _Pragma("unroll") for (int n = 0; n < 2; ++n) _Pragma("unroll") for (int k = 0; k < 2; ++k) \
        acc[ai][bj][m][n] = __builtin_amdgcn_mfma_f32_16x16x32_bf16(Bt[n][k], At[m][k], acc[ai][bj][m][n], 0, 0, 0); __builtin_amdgcn_s_setprio(0); } while (0)
#define PG8_WAIT_V(n) asm volatile("s_waitcnt vmcnt(" #n ")" ::: "memory")
#define PG8_WAIT_L(n) asm volatile("s_waitcnt lgkmcnt(" #n ")" ::: "memory")
#define PG8_BAR __builtin_amdgcn_s_barrier()
#define PG8_SCHED __builtin_amdgcn_sched_barrier(0)
    Unit cur, nxt; int ui = 0;
    if (!S.next(0, cur)) return;
    f32x4 acc[2][2][4][2];
#pragma unroll
    for (int a = 0; a < 2; ++a)
#pragma unroll
        for (int b = 0; b < 2; ++b)
#pragma unroll
            for (int m = 0; m < 4; ++m)
#pragma unroll
                for (int n = 0; n < 2; ++n) acc[a][b][m][n] = (f32x4){0.f, 0.f, 0.f, 0.f};
    bf16x8 At[4][2], B0[2][2], B1[2][2];
    const char* cA = (const char*)g.A + (size_t)cur.pm * tstep; const char* cB = (const char*)g.Bt + (size_t)cur.pn * tstep;
    S.a_ready(cur);
    if constexpr (SP2) {
        PG8_STAGE(PG8_SB(0, 0), cB, voffB); PG8_STAGE(PG8_SB(0, 1), cB + hstep, voffB); PG8_STAGE(PG8_SA(0, 0), cA, voffA); PG8_STAGE(PG8_SA(0, 1), cA + hstep, voffA);
        if (wr == 1) PG8_BAR;
        PG8_WAIT_V(2); PG8_BAR;
        PG8_STAGE(PG8_SB(1, 0), cB + kstep, voffB); PG8_STAGE(PG8_SA(1, 0), cA + kstep, voffA); PG8_STAGE(PG8_SB(1, 1), cB + hstep + kstep, voffB);
        PG8_WAIT_V(6); PG8_BAR;
    } else {
        PG8_STAGE(PG8_SB(0, 0), cB, voffB); PG8_STAGE(PG8_SA(0, 0), cA, voffA); PG8_STAGE(PG8_SB(0, 1), cB + hstep, voffB); PG8_STAGE(PG8_SA(0, 1), cA + hstep, voffA);
        if (wr == 1) PG8_BAR;
        PG8_WAIT_V(4); PG8_BAR;
        PG8_STAGE(PG8_SB(1, 0), cB + kstep, voffB); PG8_STAGE(PG8_SA(1, 0), cA + kstep, voffA); PG8_STAGE(PG8_SB(1, 1), cB + hstep + kstep, voffB);
        PG8_WAIT_V(6); PG8_BAR;
    }
    for (;;) {
        const bool has_next = S.next(ui + 1, nxt);
        const char* nA = has_next ? (const char*)g.A + (size_t)nxt.pm * tstep : cA; const char* nB = has_next ? (const char*)g.Bt + (size_t)nxt.pn * tstep : cB;
        for (int t = 0; t < nt; t += 2) {
            const bool last = (t == nt - 2);
            const char* a1 = cA + (size_t)(t + 1) * kstep;
            const char* a2 = last ? nA : cA + (size_t)(t + 2) * kstep; const char* b2 = last ? nB : cB + (size_t)(t + 2) * kstep;
            const char* a3 = a2 + kstep; const char* b3 = b2 + kstep;
            if (last && has_next) S.a_ready(nxt);
            if constexpr (SP2) {
            PG8_LDB(B0, 0, 0); PG8_LDB(B1, 0, 1); PG8_SCHED; PG8_LDA(At, 0, 0); PG8_STAGE(PG8_SA(1, 1), a1 + hstep, voffA);
            PG8_WAIT_V(8); PG8_WAIT_L(0); PG8_BAR; PG8_MMA(0, 0, At, B0); PG8_MMA(0, 1, At, B1); PG8_BAR; PG8_SCHED;
            PG8_LDA(At, 0, 1); PG8_STAGE(PG8_SB(0, 0), b2, voffB); PG8_STAGE(PG8_SB(0, 1), b2 + hstep, voffB); PG8_STAGE(PG8_SA(0, 0), a2, voffA);
            PG8_WAIT_V(8); PG8_WAIT_L(0); PG8_BAR; PG8_MMA(1, 0, At, B0); PG8_MMA(1, 1, At, B1); PG8_BAR; PG8_SCHED;
            PG8_LDB(B0, 1, 0); PG8_LDB(B1, 1, 1); PG8_SCHED; PG8_LDA(At, 1, 0); PG8_STAGE(PG8_SA(0, 1), a2 + hstep, voffA);
            PG8_WAIT_V(8); PG8_WAIT_L(0); PG8_BAR; PG8_MMA(0, 0, At, B0); PG8_MMA(0, 1, At, B1); PG8_BAR; PG8_SCHED;
            PG8_LDA(At, 1, 1); PG8_STAGE(PG8_SB(1, 0), b3, voffB); PG8_STAGE(PG8_SB(1, 1), b3 + hstep, voffB); PG8_STAGE(PG8_SA(1, 0), a3, voffA);
            PG8_WAIT_V(8); PG8_WAIT_L(0); PG8_BAR; PG8_MMA(1, 0, At, B0); PG8_MMA(1, 1, At, B1); PG8_BAR; PG8_SCHED;
            } else {
            PG8_LDB(B0, 0, 0); PG8_SCHED; PG8_LDA(At, 0, 0); PG8_STAGE(PG8_SA(1, 1), a1 + hstep, voffA);
            PG8_WAIT_L(8); PG8_BAR; PG8_WAIT_L(0); PG8_MMA(0, 0, At, B0); PG8_BAR; PG8_SCHED;
            PG8_LDB(B1, 0, 1); PG8_STAGE(PG8_SB(0, 0), b2, voffB);
            PG8_BAR; PG8_WAIT_L(0); PG8_MMA(0, 1, At, B1); PG8_BAR;
            PG8_LDA(At, 0, 1); PG8_STAGE(PG8_SA(0, 0), a2, voffA);
            PG8_BAR; PG8_WAIT_L(0); PG8_MMA(1, 0, At, B0); PG8_BAR; PG8_SCHED;
            PG8_STAGE(PG8_SB(0, 1), b2 + hstep, voffB);
            PG8_WAIT_V(6); PG8_BAR; PG8_MMA(1, 1, At, B1); PG8_BAR;
            PG8_LDB(B0, 1, 0); PG8_SCHED; PG8_LDA(At, 1, 0); PG8_STAGE(PG8_SA(0, 1), a2 + hstep, voffA);
            PG8_WAIT_L(8); PG8_BAR; PG8_WAIT_L(0); PG8_MMA(0, 0, At, B0); PG8_BAR; PG8_SCHED;
            PG8_LDB(B1, 1, 1); PG8_STAGE(PG8_SB(1, 0), b3, voffB);
            PG8_BAR; PG8_WAIT_L(0); PG8_MMA(0, 1, At, B1); PG8_BAR;
            PG8_LDA(At, 1, 1); PG8_STAGE(PG8_SA(1, 0), a3, voffA);
            PG8_BAR; PG8_WAIT_L(0); PG8_MMA(1, 0, At, B0); PG8_BAR; PG8_SCHED;
            PG8_STAGE(PG8_SB(1, 1), b3 + hstep, voffB);
            PG8_WAIT_V(6); PG8_BAR; PG8_MMA(1, 1, At, B1); PG8_BAR;
            }
        }
        if constexpr (ALIGN_EPI) { if (wr == 0) PG8_BAR; }
        if constexpr (!Epi::AFTER_DRAIN) { E(acc, cur, wr, wc, fr, fq); S.done(cur); }
        if (!has_next) break;
#pragma unroll
        for (int a = 0; a < 2; ++a)
#pragma unroll
            for (int b = 0; b < 2; ++b)
#pragma unroll
                for (int m = 0; m < 4; ++m)
#pragma unroll
                    for (int n = 0; n < 2; ++n) acc[a][b][m][n] = (f32x4){0.f, 0.f, 0.f, 0.f};
        cur = nxt; cA = nA; cB = nB; ++ui;
        if constexpr (ALIGN_EPI) { if (wr == 1) PG8_BAR; }
    }
    PG8_WAIT_V(0);
    if constexpr (!ALIGN_EPI) { if (wr == 0) PG8_BAR; }
    PG8_BAR;
    if constexpr (Epi::AFTER_DRAIN) { E.fused(acc, cur, wr, wc, fr, fq, lds, wid, lane); S.done(cur); }
#undef PG8_SA
#undef PG8_SB
#undef PG8_STAGE
#undef PG8_LDA
#undef PG8_LDB
#undef PG8_MMA
#undef PG8_WAIT_V
#undef PG8_WAIT_L
#undef PG8_BAR
#undef PG8_SCHED
}
}


#ifndef PG8_SP2
#define PG8_SP2 true
#endif
#ifndef PG8_ALIGN
#define PG8_ALIGN true
#endif
constexpr int NWAVES = 8;
constexpr int MP = pg8::MP, MS = pg8::MS, MVALID = pg8::MVALID, MT = pg8::MT, DM = 1024, DFF = 2816;
constexpr int SEQ = 4096, NB = 4, NSB = 32, PAST = 8192, NPOOL = 2560;
constexpr int ZC0 = 3328, ZC1 = 2304;
constexpr int Z1_Q = 0, Z1_K = 768, Z1_V = 1024, Z1_IQ = 1280, Z1_IK = 1792, Z1_IW = 1856, Z1_MQ = 1920;
constexpr int NMEMROWS = 1024, MEMROW0 = MT;
constexpr float EPS = 1e-6f;
constexpr size_t MiB = 1u << 20;
constexpr size_t WS_CTL = 0, CTL_ZERO_BYTES = 2 * MiB;
constexpr size_t WS_WIN0 = 2 * MiB, WS_WIN1 = 11 * MiB, WS_WOUT = 16 * MiB, WS_WGU = 20 * MiB, WS_WD = 42 * MiB;
constexpr size_t WS_XB = 54 * MiB, WS_MEMKV = 89 * MiB, WS_MIX = 94 * MiB, WS_Z = 128 * MiB, WS_U = 234 * MiB, WS_UP = 324 * MiB, WS_ACT = 414 * MiB;
constexpr size_t WS_QB = 504 * MiB, WS_KB = 528 * MiB, WS_VB = 536 * MiB, WS_IQB = 544 * MiB, WS_IKB = 560 * MiB, WS_IW = 562 * MiB;
constexpr size_t WS_SQ = 563 * MiB, WS_SIQ = WS_SQ + 512 * 1024, WS_SIW = WS_SIQ + 384 * 1024, WS_SSC = 564 * MiB, WS_SIDX = 569 * MiB, WS_MASK = 570 * MiB, WS_SC = 578 * MiB, WS_END = 834 * MiB;
constexpr int SSC_LD = 8256;
constexpr int CW_TMO = 0, CW_BAR = 4096, CW_Q = 8192, CW_SS = 16384;
constexpr size_t O_YP = 0, O_YS = O_YP + (size_t)MP * DM, O_HP = O_YS + (size_t)MS * DM, O_HS = O_HP + 4 * 6 * 16384, O_KP = O_HS + 32 * 6 * 16384,
    O_VP = O_KP + (size_t)MP * 256, O_IKP = O_VP + (size_t)MP * 256, O_KS = O_IKP + (size_t)MP * 64, O_VS = O_KS + MS * 256, O_IKS = O_VS + MS * 256,
    O_MK = O_IKS + MS * 64, O_MV = O_MK + 2 * 1024 * 256, O_CVP = O_MV + 2 * 1024 * 256, O_CVS = O_CVP + 2 * 4 * 2 * DFF, O_END = O_CVS + 2 * 32 * 2 * DFF;
static_assert(O_END == 31412224, "output size");
constexpr int RING_OFF = 0, RING_BYTES = 131072;
constexpr int LDSCTL_OFF = RING_BYTES, MISC_OFF = LDSCTL_OFF + 320;
constexpr int LDS_BYTES = 147456;

#define GAS __attribute__((address_space(1)))
#define LAS __attribute__((address_space(3)))
typedef unsigned short bf16;
typedef unsigned v4u __attribute__((ext_vector_type(4)));
typedef float f32x4 __attribute__((ext_vector_type(4)));
typedef short bf16x8 __attribute__((ext_vector_type(8)));
typedef GAS unsigned gu32;
typedef GAS unsigned long long gu64;
#define RLX_AGENT __ATOMIC_RELAXED, __HIP_MEMORY_SCOPE_AGENT
#define LDS_WAIT() asm volatile("s_waitcnt lgkmcnt(0)" ::: "memory")
#define VM_WAIT() asm volatile("s_waitcnt vmcnt(0)" ::: "memory")
__device__ __forceinline__ unsigned long long rt() { return __builtin_amdgcn_s_memrealtime(); }
__device__ __forceinline__ unsigned f2bf(float f) { unsigned u = __builtin_bit_cast(unsigned, f); return (u + 0x7fffu + ((u >> 16) & 1u)) >> 16; }
__device__ __forceinline__ unsigned pk2(float lo, float hi) { return f2bf(lo) | (f2bf(hi) << 16); }

#define XB_TMO      128
#define XB_XCNT(j)  (256  + 64 * (j))
#define XB_XSUB(j)  (1280 + 64 * (j))
#define XB_XGEN(j)  (2304 + 64 * (j))
#define XB_TOP      3328
#define XB_TOPGEN   3392
#define XCD_BAR_WORDS 3456
#define XB_SPIN_CAP (1u << 18)

__device__ __forceinline__ unsigned xb_ld(unsigned* p)              { return __hip_atomic_load(p, __ATOMIC_RELAXED, __HIP_MEMORY_SCOPE_AGENT); }
__device__ __forceinline__ unsigned xb_add(unsigned* p, unsigned v) { return __hip_atomic_fetch_add(p, v, __ATOMIC_RELAXED, __HIP_MEMORY_SCOPE_AGENT); }
__device__ __forceinline__ unsigned xb_xcc_id() { return (unsigned)__builtin_amdgcn_s_getreg((3 << 11) | 20) & 0xFu; }
#define XB_SPIN(cond, bar) do { unsigned _sp = 0; while (cond) { __builtin_amdgcn_s_sleep(1); \
    if ((++_sp & 255u) == 0u) { if (xb_ld(&(bar)[XB_TMO])) break; if (_sp > XB_SPIN_CAP) { atomicAdd(&(bar)[XB_TMO], 1u); break; } } } } while (0)

struct XcdBarrier {
    unsigned* bar; unsigned x;
    volatile LAS unsigned* st;
};

__device__ __forceinline__ XcdBarrier xcd_barrier_post(unsigned* bar, volatile LAS unsigned* st) {
    XcdBarrier b; b.bar = bar; b.x = xb_xcc_id(); b.st = st;
    if (threadIdx.x == 0) (void)xb_add(&bar[XB_XCNT(b.x)], 1u);
    return b;
}
__device__ __forceinline__ void xcd_barrier_complete(unsigned* bar, unsigned x, unsigned& nloc, unsigned& nx) {
    const unsigned G = gridDim.x * gridDim.y * gridDim.z;
    unsigned sum, cnt, mine, sp = 0u;
    for (;;) {
        sum = 0u; cnt = 0u; mine = 0u;
#pragma unroll
        for (unsigned j = 0; j < 16; ++j) { const unsigned c = xb_ld(&bar[XB_XCNT(j)]); sum += c; cnt += (c > 0u) ? 1u : 0u; mine = (j == x) ? c : mine; }
        if (sum == G) break;
        __builtin_amdgcn_s_sleep(1);
        if ((++sp & 255u) == 0u) { if (xb_ld(&bar[XB_TMO])) break; if (sp > XB_SPIN_CAP) { atomicAdd(&bar[XB_TMO], 1u); break; } }
    }
    nloc = mine > 0u ? mine : 1u; nx = cnt > 0u ? cnt : 1u;
}

__device__ __forceinline__ void xcd_barrier(const XcdBarrier& b) {
    asm volatile("s_waitcnt vmcnt(0)" ::: "memory");
    __syncthreads();
    if (threadIdx.x == 0) {
        unsigned* bar = b.bar;
        __builtin_amdgcn_s_waitcnt(0);
        unsigned nloc = b.st[0], nx = b.st[1];
        if (nloc == 0u) { xcd_barrier_complete(bar, b.x, nloc, nx); b.st[0] = nloc; b.st[1] = nx; }
        const unsigned old = xb_add(&bar[XB_XSUB(b.x)], 1u);
        const unsigned gen = old / nloc;
        if (old + 1u == (gen + 1u) * nloc) {
            __builtin_amdgcn_fence(__ATOMIC_RELEASE, "agent");
            asm volatile("s_waitcnt vmcnt(0)" ::: "memory");
            const unsigned og = xb_add(&bar[XB_TOP], 1u);
            const unsigned tg = og / nx;
            if (og + 1u == (tg + 1u) * nx) xb_add(&bar[XB_TOPGEN], 1u);
            else XB_SPIN(xb_ld(&bar[XB_TOPGEN]) == tg, bar);
            __builtin_amdgcn_fence(__ATOMIC_ACQUIRE, "agent");
            xb_add(&bar[XB_XGEN(b.x)], 1u);
            asm volatile("s_waitcnt vmcnt(0)" ::: "memory");
        } else {
            XB_SPIN(xb_ld(&bar[XB_XGEN(b.x)]) == gen, bar);
            __builtin_amdgcn_fence(__ATOMIC_ACQUIRE, "agent");
            asm volatile("s_waitcnt vmcnt(0)" ::: "memory");
        }
    }
    __syncthreads();
}


struct Args { const float* in[29]; const int* page_table; float* out; unsigned char* ws; int ph_lo, ph_hi; };
typedef const __attribute__((address_space(4))) Args& ARGREF;
struct Ctx { LAS unsigned char* lds; volatile LAS unsigned* MISC; gu32* ctl; int tid, lane, wave, vcu, G, qoff; };
typedef float f32x16 __attribute__((ext_vector_type(16)));
typedef unsigned long long u64;

__device__ __forceinline__ float bf2f(unsigned b) { return __builtin_bit_cast(float, b << 16); }
__device__ __forceinline__ float wave_sum(float v) {
#pragma unroll
    for (int o = 1; o < 64; o <<= 1) v += __shfl_xor(v, o);
    return v;
}
__device__ __forceinline__ int crow(int r, int hi) { return (r & 3) + 8 * (r >> 2) + 4 * hi; }
__device__ __forceinline__ float sigmoidf_(float x) { return 1.0f / (1.0f + __expf(-x)); }
__device__ __forceinline__ float* ssptr(const Ctx& c, int i) { return (float*)(c.ctl + CW_SS) + (size_t)i * MT; }

__device__ __forceinline__ int q_next(Ctx& c, int qi) {
    __syncthreads();
    if (c.tid == 0) c.MISC[16] = atomicAdd((unsigned*)(c.ctl + CW_Q + 64 * (qi + c.qoff)), 1u);
    __syncthreads();
    return (int)c.MISC[16];
}

template <int K>
__device__ __forceinline__ f32x16 mm32(const LAS bf16* A, int lda, const LAS bf16* Bt, int ldb, f32x16 acc, int lane) {
    const int r = lane & 31, h = lane >> 5;
#pragma unroll
    for (int ks = 0; ks < K; ks += 16) {
        const bf16x8 a = *(const LAS bf16x8*)(A + r * lda + ks + 8 * h);
        const bf16x8 b = *(const LAS bf16x8*)(Bt + r * ldb + ks + 8 * h);
        acc = __builtin_amdgcn_mfma_f32_32x32x16_bf16(a, b, acc, 0, 0, 0);
    }
    return acc;
}

__device__ __forceinline__ int map_row(int mapid, int n, int row_off) {
    if (mapid == 0) return n + row_off;
    if (mapid == 1) return n < 1864 ? n : n + 56;
    if (mapid == 2) return (n >> 7) * 256 + (n & 127);
    return (n >> 7) * 256 + 128 + (n & 127);
}
__device__ __forceinline__ void transpose_item(const float* W, int K, int N, const float* kscale, bf16* WT, int mapid, int row_off, LAS float* scr, int item, int lane) {
    const int nblk = (N + 31) / 32, kb = item / nblk, nb = item % nblk, k0 = 64 * kb, n0 = 32 * nb;
    { const int n4 = (lane & 7) * 4, nn = n0 + n4 < N ? n0 + n4 : N - 4; f32x4 v[8];
#pragma unroll
      for (int i = 0; i < 8; ++i) v[i] = *(const f32x4*)(W + (size_t)(k0 + 8 * i + (lane >> 3)) * N + nn);
#pragma unroll
      for (int i = 0; i < 8; ++i) { const int kk = 8 * i + (lane >> 3); const float sc = kscale ? kscale[k0 + kk] : 1.0f; LAS float* d = scr + kk * 33 + n4;
          d[0] = v[i].x * sc; d[1] = v[i].y * sc; d[2] = v[i].z * sc; d[3] = v[i].w * sc; } }
    LDS_WAIT(); asm volatile("" ::: "memory");
    const int cc = lane & 7;
#pragma unroll
    for (int j = 0; j < 4; ++j) { const int nl = (lane >> 3) + 8 * j, n = n0 + nl; const LAS float* s = scr + (8 * cc) * 33 + nl;
        v4u o; o.x = pk2(s[0 * 33], s[1 * 33]); o.y = pk2(s[2 * 33], s[3 * 33]); o.z = pk2(s[4 * 33], s[5 * 33]); o.w = pk2(s[6 * 33], s[7 * 33]);
        if (n < N) *(GAS v4u*)(WT + (size_t)map_row(mapid, n, row_off) * K + k0 + 8 * cc) = o; }
    LDS_WAIT(); asm volatile("" ::: "memory");
}
constexpr int I_INH = 16 * 104, I_MKV = 16 * 16, I_DSA = 16 * 67, I_OUT = 16 * 32, I_G = 16 * 88, I_D = 44 * 32;
constexpr int W_N0 = I_INH + 2 * I_MKV + I_OUT + 2 * I_G + I_D, W_NITEMS = W_N0 + I_DSA + I_OUT + 2 * I_G + I_D;
__device__ __forceinline__ void convert_item(ARGREF a, int it, LAS float* scr, int lane) {
    unsigned char* ws = a.ws; int r = it;
    if (r < I_INH) { transpose_item(a.in[13], 1024, 3328, a.in[11], (bf16*)(ws + WS_WIN0), 0, 0, scr, r, lane); return; } r -= I_INH;
    if (r < 2 * I_MKV) { const int l = r / I_MKV; transpose_item(a.in[20] + (size_t)l * 1024 * 512, 1024, 512, nullptr, (bf16*)(ws + WS_WIN0), 0, 3328 + 512 * l, scr, r % I_MKV, lane); return; } r -= 2 * I_MKV;
    int l = 0;
    if (r >= I_OUT + 2 * I_G + I_D) { r -= I_OUT + 2 * I_G + I_D; l = 1;
        if (r < I_DSA) { transpose_item(a.in[16], 1024, 2120, a.in[11] + 1024, (bf16*)(ws + WS_WIN1), 1, 0, scr, r, lane); return; } r -= I_DSA; }
    if (r < I_OUT) { transpose_item(a.in[23] + (size_t)l * 1024 * 1024, 1024, 1024, nullptr, (bf16*)(ws + WS_WOUT) + (size_t)l * 1024 * 1024, 0, 0, scr, r, lane); return; } r -= I_OUT;
    if (r < I_G) { transpose_item(a.in[24] + (size_t)l * 1024 * DFF, 1024, DFF, a.in[12] + l * 1024, (bf16*)(ws + WS_WGU) + (size_t)l * 5632 * 1024, 2, 0, scr, r, lane); return; } r -= I_G;
    if (r < I_G) { transpose_item(a.in[25] + (size_t)l * 1024 * DFF, 1024, DFF, a.in[12] + l * 1024, (bf16*)(ws + WS_WGU) + (size_t)l * 5632 * 1024, 3, 0, scr, r, lane); return; } r -= I_G;
    transpose_item(a.in[28] + (size_t)l * DFF * 1024, DFF, 1024, nullptr, (bf16*)(ws + WS_WD) + (size_t)l * 1024 * DFF, 0, 0, scr, r, lane);
}
__device__ __forceinline__ void convert_layer1_tail(Ctx& c, ARGREF a, int first_idle) {
    LAS float* scr = (LAS float*)(c.lds + RING_OFF + c.wave * 16384);
    const int bx = (int)blockIdx.x; if (bx < first_idle) return;
    const int nw = (c.G - first_idle) * NWAVES;
    for (int it = W_N0 + (bx - first_idle) * NWAVES + c.wave; it < W_NITEMS; it += nw) convert_item(a, it, scr, c.lane);
}
__device__ __forceinline__ void p0_prologue(Ctx& c, ARGREF a) {
    LAS float* scr = (LAS float*)(c.lds + RING_OFF + c.wave * 16384);
    const int gw = c.vcu * NWAVES + c.wave, NGW = c.G * NWAVES, lane = c.lane;
    unsigned char* ws = a.ws;
    for (int it = gw; it < W_N0; it += NGW) convert_item(a, it, scr, lane);
    for (int rr = gw; rr < 184; rr += NGW) { const int row = rr < 56 ? 1864 + rr : 2176 + (rr - 56);
        GAS v4u* p = (GAS v4u*)((bf16*)(ws + WS_WIN1) + (size_t)row * 1024); p[lane] = (v4u){0u, 0u, 0u, 0u}; p[64 + lane] = (v4u){0u, 0u, 0u, 0u}; }
    float* ss0 = ssptr(c, 0);
    for (int m = gw; m < MT + NMEMROWS; m += NGW) {
        GAS u64* o8 = (GAS u64*)((bf16*)(ws + WS_XB) + (size_t)m * DM) + lane;
        if (m >= MVALID && m < MT) {
#pragma unroll
            for (int j = 0; j < 4; ++j) o8[64 * j] = 0ull;
            continue; }
        const float* src = m < MP ? a.in[0] + (size_t)m * DM : (m < MVALID ? a.in[1] + (size_t)(m - MP) * DM : a.in[10] + (size_t)(m - MT) * DM);
        const GAS f32x4* xr = (const GAS f32x4*)src + lane; f32x4 v[4]; float s = 0.f;
#pragma unroll
        for (int j = 0; j < 4; ++j) { v[j] = xr[64 * j]; s += (v[j].x * v[j].x + v[j].y * v[j].y) + (v[j].z * v[j].z + v[j].w * v[j].w); }
        s = wave_sum(s);
#pragma unroll
        for (int j = 0; j < 4; ++j) o8[64 * j] = (u64)pk2(v[j].x, v[j].y) | ((u64)pk2(v[j].z, v[j].w) << 32);
        if (m < MVALID && lane == 0) ss0[m] = s;
    }
}

__device__ __forceinline__ void memattn_unit(Ctx& c, const bf16* Zq  , int ldz, int nrows_valid, const float* Kp, const float* Vp, int kstride,
                                             bool normk, const float* kgain, const float* qgain, bf16* Out  ) {
    LAS bf16* KN = (LAS bf16*)(c.lds);
    LAS bf16* VTm = (LAS bf16*)(c.lds + 36864);
    LAS bf16* QN = (LAS bf16*)(c.lds + 70656) + c.wave * (32 * 72);
    LAS float* LI = (LAS float*)(c.lds + 107520) + c.wave * 32;
    int tid = c.tid; asm volatile("" : "+v"(tid));
    const int lane = tid & 63, w = c.wave;
    {
        const int m = tid >> 1, dh = (tid & 1) * 32;
        f32x4 kv[8]; float s = 0.f;
#pragma unroll
        for (int j = 0; j < 8; ++j) { kv[j] = *(const f32x4*)(Kp + (size_t)m * kstride + dh + 4 * j); s += (kv[j].x * kv[j].x + kv[j].y * kv[j].y) + (kv[j].z * kv[j].z + kv[j].w * kv[j].w); }
        s += __shfl_xor(s, 1);
        const float rs = normk ? rsqrtf(s * (1.0f / 64.0f) + EPS) : 1.0f;
#pragma unroll
        for (int j = 0; j < 8; j += 2) { f32x4 g0 = {1.f, 1.f, 1.f, 1.f}, g1 = g0;
            if (normk) { g0 = *(const f32x4*)(kgain + dh + 4 * j); g1 = *(const f32x4*)(kgain + dh + 4 * j + 4); }
            const f32x4 x0 = kv[j] * rs * g0, x1 = kv[j + 1] * rs * g1;
            v4u o; o.x = pk2(x0.x, x0.y); o.y = pk2(x0.z, x0.w); o.z = pk2(x1.x, x1.y); o.w = pk2(x1.z, x1.w);
            *(LAS v4u*)(KN + m * 72 + dh + 4 * j) = o; }
#pragma unroll
        for (int j = 0; j < 8; ++j) { const f32x4 vv = *(const f32x4*)(Vp + (size_t)m * kstride + dh + 4 * j);
            VTm[(dh + 4 * j + 0) * 264 + m] = (bf16)f2bf(vv.x); VTm[(dh + 4 * j + 1) * 264 + m] = (bf16)f2bf(vv.y);
            VTm[(dh + 4 * j + 2) * 264 + m] = (bf16)f2bf(vv.z); VTm[(dh + 4 * j + 3) * 264 + m] = (bf16)f2bf(vv.w); }
    }
    {
        const int row = lane >> 1, hf = lane & 1, grow = w * 32 + row;
        float x[32]; float s = 0.f;
        if (grow < nrows_valid) {
#pragma unroll
            for (int j = 0; j < 4; ++j) { const v4u q = *(const v4u*)(Zq + (size_t)grow * ldz + hf * 32 + 8 * j);
                x[8 * j + 0] = bf2f(q.x & 0xffffu); x[8 * j + 1] = bf2f(q.x >> 16); x[8 * j + 2] = bf2f(q.y & 0xffffu); x[8 * j + 3] = bf2f(q.y >> 16);
                x[8 * j + 4] = bf2f(q.z & 0xffffu); x[8 * j + 5] = bf2f(q.z >> 16); x[8 * j + 6] = bf2f(q.w & 0xffffu); x[8 * j + 7] = bf2f(q.w >> 16); }
        } else {
#pragma unroll
            for (int j = 0; j < 32; ++j) x[j] = 0.f;
        }
#pragma unroll
        for (int j = 0; j < 32; ++j) s += x[j] * x[j];
        s += __shfl_xor(s, 1);
        const float rs = rsqrtf(s * (1.0f / 64.0f) + EPS) * 0.125f;
#pragma unroll
        for (int j = 0; j < 32; j += 8) { v4u o;
            o.x = pk2(x[j] * rs * qgain[hf * 32 + j], x[j + 1] * rs * qgain[hf * 32 + j + 1]); o.y = pk2(x[j + 2] * rs * qgain[hf * 32 + j + 2], x[j + 3] * rs * qgain[hf * 32 + j + 3]);
            o.z = pk2(x[j + 4] * rs * qgain[hf * 32 + j + 4], x[j + 5] * rs * qgain[hf * 32 + j + 5]); o.w = pk2(x[j + 6] * rs * qgain[hf * 32 + j + 6], x[j + 7] * rs * qgain[hf * 32 + j + 7]);
            *(LAS v4u*)(QN + row * 72 + hf * 32 + j) = o; }
    }
    __syncthreads();
    if (w * 32 < nrows_valid) {
        const int r32 = lane & 31, hh = lane >> 5;
        f32x16 s[8];
#pragma unroll
        for (int mt = 0; mt < 8; ++mt) { f32x16 z = {}; s[mt] = mm32<64>(KN + mt * 32 * 72, 72, QN, 72, z, lane); }
        float mx = -1e30f;
#pragma unroll
        for (int mt = 0; mt < 8; ++mt)
#pragma unroll
            for (int r = 0; r < 16; ++r) mx = fmaxf(mx, s[mt][r]);
        mx = fmaxf(mx, __shfl_xor(mx, 32));
        float l = 0.f;
#pragma unroll
        for (int mt = 0; mt < 8; ++mt)
#pragma unroll
            for (int r = 0; r < 16; ++r) { const float p = __expf(s[mt][r] - mx); s[mt][r] = p; l += p; }
        l += __shfl_xor(l, 32);
        if (hh == 0) LI[r32] = l;
        f32x16 o[2] = {};
#pragma unroll
        for (int mt = 0; mt < 8; ++mt)
#pragma unroll
            for (int sx = 0; sx < 2; ++sx) {
                v4u pa; pa.x = pk2(s[mt][8 * sx + 0], s[mt][8 * sx + 1]); pa.y = pk2(s[mt][8 * sx + 2], s[mt][8 * sx + 3]);
                pa.z = pk2(s[mt][8 * sx + 4], s[mt][8 * sx + 5]); pa.w = pk2(s[mt][8 * sx + 6], s[mt][8 * sx + 7]);
                const bf16x8 af = __builtin_bit_cast(bf16x8, pa);
#pragma unroll
                for (int dt = 0; dt < 2; ++dt) { const LAS bf16* vp = VTm + (dt * 32 + r32) * 264 + mt * 32 + 16 * sx + 4 * hh;
                    const u64 lo = *(const LAS u64*)vp, hi = *(const LAS u64*)(vp + 8);
                    v4u bw; bw.x = (unsigned)lo; bw.y = (unsigned)(lo >> 32); bw.z = (unsigned)hi; bw.w = (unsigned)(hi >> 32);
                    o[dt] = __builtin_amdgcn_mfma_f32_32x32x16_bf16(af, __builtin_bit_cast(bf16x8, bw), o[dt], 0, 0, 0); }
            }
        LDS_WAIT();
#pragma unroll
        for (int r = 0; r < 16; ++r) { const int qr = crow(r, hh), grow = w * 32 + qr; const float il = 1.0f / LI[qr];
            if (grow < nrows_valid) {
#pragma unroll
                for (int dt = 0; dt < 2; ++dt) Out[(size_t)grow * DM + dt * 32 + r32] = (bf16)f2bf(o[dt][r] * il); } }
    }
}

constexpr int HG_GS = 4, HG_NG = SEQ / (32 * HG_GS);
constexpr size_t WS_HOL = WS_U, WS_HQC = WS_UP, WS_HUT = WS_ACT, WS_HST = WS_ACT + 64 * MiB, WS_HDG = WS_ACT + 50 * MiB;
template <bool PROMPT>
__device__ __forceinline__ void hgrn_unit(Ctx& c, ARGREF a, int b, int h, int g) {
    LAS unsigned char* L = c.lds;
    LAS float* LF = (LAS float*)(L + 0);
    LAS float* BL = (LAS float*)(L + 16384);
    LAS float* DVv = (LAS float*)(L + 16896);
    LAS bf16* QD = (LAS bf16*)(L + 17408);
    LAS bf16* KD = (LAS bf16*)(L + 26112);
    LAS bf16* KET = (LAS bf16*)(L + 34816);
    LAS bf16* VT = (LAS bf16*)(L + 45056);
    LAS bf16* SCB = (LAS bf16*)(L + 55296);
    LAS bf16* STt = (LAS bf16*)(L + 57856);
    LAS float* BOFF = (LAS float*)(L + 92672);
    int tid = c.tid; asm volatile("" : "+v"(tid));
    const int lane = tid & 63, w = c.wave, r32 = lane & 31, hh = lane >> 5;
    const int te = tid >> 4, k8 = (tid & 15) * 8;
    const bf16* Z = (const bf16*)(a.ws + WS_Z);
    bf16* MIX = (bf16*)(a.ws + WS_MIX);
    const int nch = PROMPT ? HG_GS : 1, nvalid = PROMPT ? 32 : 4;
    const int kt = w >> 1, vt0 = 2 * (w & 1);
    const int unit = (b * 6 + h) * HG_NG + g;
    f32x16 S0 = {}, S1 = {};
    if (!PROMPT) { const float* sp = a.in[7] + (size_t)(b * 6 + h) * 16384;
#pragma unroll
        for (int r = 0; r < 16; ++r) { const int k = 32 * kt + crow(r, hh); S0[r] = sp[k * 128 + 32 * vt0 + r32]; S1[r] = sp[k * 128 + 32 * (vt0 + 1) + r32]; } }
    float lbv[8], onv[8];
#pragma unroll
    for (int j = 0; j < 8; ++j) { const float l0 = a.in[14][h * 128 + k8 + j], l1 = a.in[14][768 + h * 128 + k8 + j]; lbv[j] = 1.0f / (1.0f + __expf(l1 - l0)); onv[j] = a.in[15][k8 + j]; }
    __syncthreads();
    if (tid < 128) BOFF[tid] = 0.f;
#define HG_WRITE_ST() do { _Pragma("unroll") for (int g4 = 0; g4 < 4; ++g4) { const int k0 = 32 * kt + 8 * g4 + 4 * hh; \
        *(LAS u64*)(STt + (32 * vt0 + r32) * 136 + k0) = (u64)pk2(S0[4 * g4], S0[4 * g4 + 1]) | ((u64)pk2(S0[4 * g4 + 2], S0[4 * g4 + 3]) << 32); \
        *(LAS u64*)(STt + (32 * (vt0 + 1) + r32) * 136 + k0) = (u64)pk2(S1[4 * g4], S1[4 * g4 + 1]) | ((u64)pk2(S1[4 * g4 + 2], S1[4 * g4 + 3]) << 32); } } while (0)
    HG_WRITE_ST();
#pragma unroll 1
    for (int ch = 0; ch < nch; ++ch) {
        const int row0 = PROMPT ? b * SEQ + (g * HG_GS + ch) * 32 : MP + 4 * b, row = row0 + te;
        const bool valid = te < nvalid;
        float qs[8], kk[8]; v4u gz = {0u, 0u, 0u, 0u};
        {
            v4u zq = {0u, 0u, 0u, 0u}, zf = zq, zi = zq;
            if (valid) { const bf16* zr = Z + (size_t)row * ZC0 + h * 128 + k8;
                zq = *(const v4u*)zr; zf = *(const v4u*)(zr + 768); zi = *(const v4u*)(zr + 1536); if (!PROMPT) gz = *(const v4u*)(zr + 2304); }
            const unsigned qw[4] = {zq.x, zq.y, zq.z, zq.w}, fw[4] = {zf.x, zf.y, zf.z, zf.w}, iw[4] = {zi.x, zi.y, zi.z, zi.w};
            float lf[8];
#pragma unroll
            for (int j = 0; j < 8; ++j) { const float q = bf2f((qw[j >> 1] >> (16 * (j & 1))) & 0xffffu), fp = bf2f((fw[j >> 1] >> (16 * (j & 1))) & 0xffffu);
                const float sg = sigmoidf_(fp), f = lbv[j] + (1.0f - lbv[j]) * sg;
                qs[j] = valid ? q * sigmoidf_(q) : 0.f; kk[j] = valid ? (1.0f - f) : 0.f; lf[j] = valid ? __logf(f) : 0.f;
                VT[(k8 + j) * 40 + te] = (bf16)((iw[j >> 1] >> (16 * (j & 1))) & 0xffffu); }
            *(LAS f32x4*)(LF + te * 128 + k8) = (f32x4){lf[0], lf[1], lf[2], lf[3]}; *(LAS f32x4*)(LF + te * 128 + k8 + 4) = (f32x4){lf[4], lf[5], lf[6], lf[7]};
        }
        __syncthreads();
        if (tid < 128) { float bsum = 0.f;
#pragma unroll
            for (int t = 0; t < 32; ++t) { bsum += LF[t * 128 + tid]; LF[t * 128 + tid] = bsum; }
            BL[tid] = bsum; }
        __syncthreads();
        {
            const f32x4 b0 = *(const LAS f32x4*)(LF + te * 128 + k8), b1 = *(const LAS f32x4*)(LF + te * 128 + k8 + 4);
            const f32x4 l0 = *(const LAS f32x4*)(BL + k8), l1 = *(const LAS f32x4*)(BL + k8 + 4);
            const float bb[8] = {b0.x, b0.y, b0.z, b0.w, b1.x, b1.y, b1.z, b1.w}, bl[8] = {l0.x, l0.y, l0.z, l0.w, l1.x, l1.y, l1.z, l1.w};
            float qd[8], kd[8];
#pragma unroll
            for (int j = 0; j < 8; ++j) { qd[j] = qs[j] * __expf(bb[j]); kd[j] = kk[j] * __expf(-bb[j]); KET[(k8 + j) * 40 + te] = (bf16)f2bf(kk[j] * __expf(bl[j] - bb[j])); }
            v4u o; o.x = pk2(qd[0], qd[1]); o.y = pk2(qd[2], qd[3]); o.z = pk2(qd[4], qd[5]); o.w = pk2(qd[6], qd[7]); *(LAS v4u*)(QD + te * 136 + k8) = o;
            if (PROMPT) { const f32x4 f0 = *(const LAS f32x4*)(BOFF + k8), f1 = *(const LAS f32x4*)(BOFF + k8 + 4);
                const float bo[8] = {f0.x, f0.y, f0.z, f0.w, f1.x, f1.y, f1.z, f1.w}; float qc[8];
#pragma unroll
                for (int j = 0; j < 8; ++j) qc[j] = qd[j] * __expf(bo[j]);
                v4u oc; oc.x = pk2(qc[0], qc[1]); oc.y = pk2(qc[2], qc[3]); oc.z = pk2(qc[4], qc[5]); oc.w = pk2(qc[6], qc[7]);
                *(v4u*)((bf16*)(a.ws + WS_HQC) + (size_t)row * 768 + h * 128 + k8) = oc; }
            o.x = pk2(kd[0], kd[1]); o.y = pk2(kd[2], kd[3]); o.z = pk2(kd[4], kd[5]); o.w = pk2(kd[6], kd[7]); *(LAS v4u*)(KD + te * 136 + k8) = o;
            if (te == 0) {
#pragma unroll
                for (int j = 0; j < 8; ++j) DVv[k8 + j] = __expf(bl[j]); }
        }
        __syncthreads();
        f32x16 oacc = {};
        if (w == 0) { f32x16 z = {}; const f32x16 sc = mm32<128>(QD, 136, KD, 136, z, lane);
#pragma unroll
            for (int r = 0; r < 16; ++r) { const int t = crow(r, hh); SCB[t * 40 + r32] = (bf16)f2bf(r32 <= t ? sc[r] : 0.f); } }
        if (w < 4) oacc = mm32<128>(QD, 136, STt + (w * 32) * 136, 136, oacc, lane);
        if (PROMPT && tid >= 384) BOFF[tid - 384] += BL[tid - 384];
        __syncthreads();
        if (w < 4) { oacc = mm32<32>(SCB, 40, VT + (w * 32) * 40, 40, oacc, lane);
#pragma unroll
            for (int r = 0; r < 16; ++r) LF[crow(r, hh) * 128 + w * 32 + r32] = oacc[r]; }
        {
#pragma unroll
            for (int r = 0; r < 16; ++r) { const float d = DVv[32 * kt + crow(r, hh)]; S0[r] *= d; S1[r] *= d; }
            S0 = mm32<32>(KET + (kt * 32) * 40, 40, VT + (vt0 * 32) * 40, 40, S0, lane);
            S1 = mm32<32>(KET + (kt * 32) * 40, 40, VT + ((vt0 + 1) * 32) * 40, 40, S1, lane);
        }
        __syncthreads();
        HG_WRITE_ST();
        {
            const f32x4 o0 = *(const LAS f32x4*)(LF + te * 128 + k8), o1 = *(const LAS f32x4*)(LF + te * 128 + k8 + 4);
            if (PROMPT) { float* ol = (float*)(a.ws + WS_HOL) + (size_t)row * 768 + h * 128 + k8; *(f32x4*)ol = o0; *(f32x4*)(ol + 4) = o1; }
            else {
                float ov[8] = {o0.x, o0.y, o0.z, o0.w, o1.x, o1.y, o1.z, o1.w}; float s = 0.f;
#pragma unroll
                for (int j = 0; j < 8; ++j) s += ov[j] * ov[j];
                s += __shfl_xor(s, 1); s += __shfl_xor(s, 2); s += __shfl_xor(s, 4); s += __shfl_xor(s, 8);
                const float rs = rsqrtf(s * (1.0f / 128.0f) + EPS);
                const unsigned gw_[4] = {gz.x, gz.y, gz.z, gz.w}; float y[8];
#pragma unroll
                for (int j = 0; j < 8; ++j) { const float gg = bf2f((gw_[j >> 1] >> (16 * (j & 1))) & 0xffffu); y[j] = ov[j] * rs * onv[j] * (gg * sigmoidf_(gg)); }
                if (valid) { v4u o; o.x = pk2(y[0], y[1]); o.y = pk2(y[2], y[3]); o.z = pk2(y[4], y[5]); o.w = pk2(y[6], y[7]); *(v4u*)(MIX + (size_t)row * DM + h * 128 + k8) = o; }
            }
        }
        __syncthreads();
    }
#undef HG_WRITE_ST
    if (PROMPT) {
        float* ut = (float*)(a.ws + WS_HUT) + (size_t)unit * 16384;
#pragma unroll
        for (int g4 = 0; g4 < 4; ++g4) { const int k0 = 32 * kt + 8 * g4 + 4 * hh;
            *(f32x4*)(ut + (32 * vt0 + r32) * 128 + k0) = (f32x4){S0[4 * g4], S0[4 * g4 + 1], S0[4 * g4 + 2], S0[4 * g4 + 3]};
            *(f32x4*)(ut + (32 * (vt0 + 1) + r32) * 128 + k0) = (f32x4){S1[4 * g4], S1[4 * g4 + 1], S1[4 * g4 + 2], S1[4 * g4 + 3]}; }
        if (tid < 128) ((float*)(a.ws + WS_HDG))[(size_t)unit * 128 + tid] = __expf(BOFF[tid]);
    } else {
        float* so = a.out + O_HS + (size_t)(b * 6 + h) * 16384;
#pragma unroll
        for (int r = 0; r < 16; ++r) { const int k = 32 * kt + crow(r, hh); so[k * 128 + 32 * vt0 + r32] = S0[r]; so[k * 128 + 32 * (vt0 + 1) + r32] = S1[r]; }
    }
}
__device__ __forceinline__ void hgrn_scan(Ctx& c, ARGREF a) {
    const float* UT = (const float*)(a.ws + WS_HUT); const float* DG = (const float*)(a.ws + WS_HDG); bf16* STo = (bf16*)(a.ws + WS_HST);
    for (int idx = c.vcu * 512 + c.tid; idx < 24 * 16384; idx += c.G * 512) {
        const int bh = idx >> 14, e = idx & 16383, k = e & 127, v = e >> 7;
        float s = 0.f;
#pragma unroll 8
        for (int g = 0; g < HG_NG; ++g) { const size_t u = (size_t)(bh * HG_NG + g); STo[u * 16384 + e] = (bf16)f2bf(s); s = DG[u * 128 + k] * s + UT[u * 16384 + e]; }
        a.out[O_HP + (size_t)bh * 16384 + k * 128 + v] = s;
    }
}
__device__ __forceinline__ void hgrn_fix_unit(Ctx& c, ARGREF a, int b, int h, int g) {
    LAS bf16* STt = (LAS bf16*)(c.lds);
    LAS bf16* QCl = (LAS bf16*)(c.lds + 34816);
    LAS float* OB = (LAS float*)(c.lds + 34816 + 17408);
    int tid = c.tid; asm volatile("" : "+v"(tid));
    const int lane = tid & 63, w = c.wave, r32 = lane & 31, hh = lane >> 5;
    const int unit = (b * 6 + h) * HG_NG + g, row0 = b * SEQ + g * 128;
    const bf16* Z = (const bf16*)(a.ws + WS_Z); bf16* MIX = (bf16*)(a.ws + WS_MIX);
    const bf16* QC = (const bf16*)(a.ws + WS_HQC); const float* OL = (const float*)(a.ws + WS_HOL);
    const bf16* stg = (const bf16*)(a.ws + WS_HST) + (size_t)unit * 16384;
    __syncthreads();
#pragma unroll
    for (int i = 0; i < 4; ++i) { const int cidx = tid + 512 * i, v = cidx >> 4, kc = (cidx & 15) * 8; *(LAS v4u*)(STt + v * 136 + kc) = *(const v4u*)(stg + v * 128 + kc); }
    const int te = tid >> 4, k8 = (tid & 15) * 8;
    float onv[8];
#pragma unroll
    for (int j = 0; j < 8; ++j) onv[j] = a.in[15][k8 + j];
#pragma unroll 1
    for (int hf = 0; hf < 2; ++hf) {
        const int rb = row0 + hf * 64;
#pragma unroll
        for (int i = 0; i < 2; ++i) { const int cidx = tid + 512 * i, r = cidx >> 4, kc = (cidx & 15) * 8; *(LAS v4u*)(QCl + r * 136 + kc) = *(const v4u*)(QC + (size_t)(rb + r) * 768 + h * 128 + kc); }
        __syncthreads();
        { const int rt = w >> 2, vt = w & 3; f32x16 o = {};
          o = mm32<128>(QCl + (rt * 32) * 136, 136, STt + (vt * 32) * 136, 136, o, lane);
#pragma unroll
          for (int r = 0; r < 16; ++r) OB[(rt * 32 + crow(r, hh)) * 128 + vt * 32 + r32] = o[r]; }
        __syncthreads();
#pragma unroll
        for (int ps = 0; ps < 2; ++ps) { const int r = ps * 32 + te, row = rb + r;
            const f32x4 c0 = *(const LAS f32x4*)(OB + r * 128 + k8), c1 = *(const LAS f32x4*)(OB + r * 128 + k8 + 4);
            const float* ol = OL + (size_t)row * 768 + h * 128 + k8; const f32x4 l0 = *(const f32x4*)ol, l1 = *(const f32x4*)(ol + 4);
            const v4u gz = *(const v4u*)(Z + (size_t)row * ZC0 + 2304 + h * 128 + k8);
            float ov[8] = {c0.x + l0.x, c0.y + l0.y, c0.z + l0.z, c0.w + l0.w, c1.x + l1.x, c1.y + l1.y, c1.z + l1.z, c1.w + l1.w}; float s = 0.f;
#pragma unroll
            for (int j = 0; j < 8; ++j) s += ov[j] * ov[j];
            s += __shfl_xor(s, 1); s += __shfl_xor(s, 2); s += __shfl_xor(s, 4); s += __shfl_xor(s, 8);
            const float rs = rsqrtf(s * (1.0f / 128.0f) + EPS);
            const unsigned gw_[4] = {gz.x, gz.y, gz.z, gz.w}; float y[8];
#pragma unroll
            for (int j = 0; j < 8; ++j) { const float gg = bf2f((gw_[j >> 1] >> (16 * (j & 1))) & 0xffffu); y[j] = ov[j] * rs * onv[j] * (gg * sigmoidf_(gg)); }
            v4u o; o.x = pk2(y[0], y[1]); o.y = pk2(y[2], y[3]); o.z = pk2(y[4], y[5]); o.w = pk2(y[6], y[7]); *(v4u*)(MIX + (size_t)row * DM + h * 128 + k8) = o; }
        __syncthreads();
    }
}

__device__ __forceinline__ void memkv_finalize_row(ARGREF a, int layer, int row, int lane) {
    const float* src = (const float*)(a.ws + WS_MEMKV) + (size_t)row * 1024 + layer * 512;
    const int hd = lane >> 4, d4 = (lane & 15) * 4;
    const f32x4 k = *(const f32x4*)(src + hd * 64 + d4), v = *(const f32x4*)(src + 256 + hd * 64 + d4);
    float s = (k.x * k.x + k.y * k.y) + (k.z * k.z + k.w * k.w);
    s += __shfl_xor(s, 1); s += __shfl_xor(s, 2); s += __shfl_xor(s, 4); s += __shfl_xor(s, 8);
    const float rs = rsqrtf(s * (1.0f / 64.0f) + EPS); const f32x4 g = *(const f32x4*)(a.in[22] + layer * 64 + d4);
    *(f32x4*)(a.out + O_MK + ((size_t)layer * 1024 + row) * 256 + hd * 64 + d4) = k * rs * g;
    *(f32x4*)(a.out + O_MV + ((size_t)layer * 1024 + row) * 256 + hd * 64 + d4) = v;
}

__device__ __forceinline__ void memattn_prompt_unit(Ctx& c, ARGREF a, int layer, int u) {
    const int blk = u & 15, hd = (u >> 4) & 3, b = u >> 6;
    const bf16* Z = (const bf16*)(a.ws + WS_Z); const int ldz = layer ? ZC1 : ZC0, qc = layer ? Z1_MQ : 3072;
    const float* kv = (const float*)(a.ws + WS_MEMKV) + (size_t)(b * 256) * 1024 + layer * 512 + hd * 64;
    const int row0 = b * SEQ + blk * 256;
    memattn_unit(c, Z + (size_t)row0 * ldz + qc + hd * 64, ldz, 256, kv, kv + 256, 1024, true, a.in[22] + layer * 64, a.in[21] + layer * 64,
                 (bf16*)(a.ws + WS_MIX) + (size_t)row0 * DM + 768 + hd * 64);
}
__device__ __forceinline__ void memattn_sample_unit(Ctx& c, ARGREF a, int layer, int u) {
    const int hd = u & 3, sb = u >> 2;
    const bf16* Z = (const bf16*)(a.ws + WS_Z); const int ldz = layer ? ZC1 : ZC0, qc = layer ? Z1_MQ : 3072;
    const size_t off = ((size_t)(layer * 32 + sb) * 256) * 256 + hd * 64;
    const int row0 = MP + sb * 4;
    memattn_unit(c, Z + (size_t)row0 * ldz + qc + hd * 64, ldz, 4, a.in[5] + off, a.in[6] + off, 256, false, nullptr, a.in[21] + layer * 64,
                 (bf16*)(a.ws + WS_MIX) + (size_t)row0 * DM + 768 + hd * 64);
}

__device__ __forceinline__ void p2_mixer0(Ctx& c, ARGREF a) {
    constexpr int U_HP = 24 * HG_NG, U_MAP = U_HP + 256, U_HS = U_MAP + 192, U_MAS = U_HS + 128, U_FIN = U_MAS + 256;
    for (;;) {
        const int u = q_next(c, 0);
        if (u >= U_FIN) break;
        if (u < U_HP) hgrn_unit<true>(c, a, u / (6 * HG_NG), (u / HG_NG) % 6, u % HG_NG);
        else if (u < U_MAP) memattn_prompt_unit(c, a, 0, u - U_HP);
        else if (u < U_HS) { const int v = u - U_MAP; hgrn_unit<false>(c, a, v / 6, v % 6, 0); }
        else if (u < U_MAS) memattn_sample_unit(c, a, 0, u - U_HS);
        else { const int v = (u - U_MAS) * 8 + c.wave; memkv_finalize_row(a, v >> 10, v & 1023, c.lane); }
    }
}
__device__ __forceinline__ void p2c_hgrn_fix(Ctx& c, ARGREF a) {
    for (int u = c.vcu; u < 24 * HG_NG; u += c.G) hgrn_fix_unit(c, a, u / (6 * HG_NG), (u / HG_NG) % 6, u % HG_NG);
}

constexpr size_t WS_G4 = WS_UP + 64 * MiB, WS_UP2 = WS_UP + 80 * MiB;
__device__ __forceinline__ void conv_fixup_tile(Ctx& c, ARGREF a, int layer, int pm) {
    const float* G4 = (const float*)(a.ws + WS_G4); const float* UP2 = (const float*)(a.ws + WS_UP2); bf16* ACT = (bf16*)(a.ws + WS_ACT);
    const float* cw = a.in[26] + (size_t)layer * 3 * DFF; const float* cb = a.in[27] + (size_t)layer * DFF;
    for (int idx = c.tid; idx < 8 * (DFF / 4); idx += 512) {
        const int rr = idx / (DFF / 4), c4 = (idx - rr * (DFF / 4)) * 4;
        const int slab = 4 * pm + (rr >> 1), fr = rr & 1, row = slab * 64 + fr, t = row & 4095, sl1 = slab > 0 ? slab - 1 : 0;
        const f32x4 ut = *(const f32x4*)(G4 + (size_t)(slab * 4 + fr) * DFF + c4), up = *(const f32x4*)(UP2 + (size_t)(slab * 2 + fr) * DFF + c4);
        const f32x4 a0 = *(const f32x4*)(G4 + (size_t)(slab * 4 + 0) * DFF + c4), b3 = *(const f32x4*)(G4 + (size_t)(sl1 * 4 + 3) * DFF + c4), b2 = *(const f32x4*)(G4 + (size_t)(sl1 * 4 + 2) * DFF + c4);
        f32x4 u1, u2;
        { const bool f1 = fr == 1, t0 = t == 0, t1 = t == 1;
          u1.x = f1 ? a0.x : (t0 ? 0.f : b3.x); u1.y = f1 ? a0.y : (t0 ? 0.f : b3.y); u1.z = f1 ? a0.z : (t0 ? 0.f : b3.z); u1.w = f1 ? a0.w : (t0 ? 0.f : b3.w);
          u2.x = f1 ? (t1 ? 0.f : b3.x) : (t0 ? 0.f : b2.x); u2.y = f1 ? (t1 ? 0.f : b3.y) : (t0 ? 0.f : b2.y); u2.z = f1 ? (t1 ? 0.f : b3.z) : (t0 ? 0.f : b2.z); u2.w = f1 ? (t1 ? 0.f : b3.w) : (t0 ? 0.f : b2.w); }
        const f32x4 w0 = *(const f32x4*)(cw + c4), w1 = *(const f32x4*)(cw + DFF + c4), w2 = *(const f32x4*)(cw + 2 * DFF + c4), bb = *(const f32x4*)(cb + c4);
        const f32x4 cv = bb + w0 * u2 + w1 * u1 + w2 * ut;
        const float y0 = cv.x * sigmoidf_(cv.x) * up.x, y1 = cv.y * sigmoidf_(cv.y) * up.y, y2 = cv.z * sigmoidf_(cv.z) * up.z, y3 = cv.w * sigmoidf_(cv.w) * up.w;
        *(u64*)(ACT + (size_t)row * DFF + c4) = (u64)pk2(y0, y1) | ((u64)pk2(y2, y3) << 32);
    }
}


struct SgArgs { const bf16* A; const bf16* Bt; int K; int mode; bf16* Z; int ldz; const float* ssin; const float* resid; const bf16* rb; float* y; bf16* xb; float* ssout; bf16* ACT; float* cvs; const float* cst; const float* cw; const float* cb; };
__device__ __forceinline__ void sgemm_unit(Ctx& c, const SgArgs& g, int n0) {
    int tid = c.tid; asm volatile("" : "+v"(tid));
    const int lane = tid & 63, w = c.wave, r32 = lane & 31, hh = lane >> 5;
    const int K = g.K, ks = K >> 3;
    const int f2 = (n0 >> 1) + (r32 & 15), brow = g.mode == 2 ? (f2 >> 7) * 256 + (f2 & 127) + (r32 >= 16 ? 128 : 0) : n0 + r32;
    const bf16* bp = g.Bt + (size_t)brow * K + w * ks + 8 * hh;
    const bf16* ap = g.A + (size_t)r32 * K + w * ks + 8 * hh;
    f32x16 acc[4] = {};
    bf16x8 afA[4][2], bfA[2], afB[4][2], bfB[2];
#define SG_LOAD(AF, BF, kk) do { _Pragma("unroll") for (int i = 0; i < 2; ++i) { BF[i] = *(const bf16x8*)(bp + (kk) + 16 * i); \
        _Pragma("unroll") for (int rt = 0; rt < 4; ++rt) AF[rt][i] = *(const bf16x8*)(ap + (size_t)(rt * 32) * K + (kk) + 16 * i); } } while (0)
#define SG_MMA(AF, BF) do { _Pragma("unroll") for (int i = 0; i < 2; ++i) _Pragma("unroll") for (int rt = 0; rt < 4; ++rt) acc[rt] = __builtin_amdgcn_mfma_f32_32x32x16_bf16(AF[rt][i], BF[i], acc[rt], 0, 0, 0); } while (0)
    SG_LOAD(afA, bfA, 0);
#pragma unroll 1
    for (int k = 0; k < ks; k += 64) {
        if (k + 32 < ks) SG_LOAD(afB, bfB, k + 32);
        SG_MMA(afA, bfA);
        if (k + 32 < ks) { if (k + 64 < ks) SG_LOAD(afA, bfA, k + 64); SG_MMA(afB, bfB); }
    }
#undef SG_LOAD
#undef SG_MMA
    LAS float* RED = (LAS float*)(c.lds);
    __syncthreads();
#pragma unroll
    for (int rt = 0; rt < 4; ++rt)
#pragma unroll
        for (int r = 0; r < 16; ++r) RED[((w * 4 + rt) * 16 + r) * 64 + lane] = acc[rt][r];
    __syncthreads();
    const int rt = w & 3, rh = w >> 2, col = n0 + r32;
    float v[8];
#pragma unroll
    for (int i = 0; i < 8; ++i) { float s = 0.f;
#pragma unroll
        for (int ww = 0; ww < 8; ++ww) s += RED[((ww * 4 + rt) * 16 + 8 * rh + i) * 64 + lane];
        v[i] = s; }
    if (g.mode == 0) {
#pragma unroll
        for (int i = 0; i < 8; ++i) { const int row = MP + rt * 32 + crow(8 * rh + i, hh); const float rs = rsqrtf(g.ssin[row] * (1.0f / DM) + EPS); g.Z[(size_t)row * g.ldz + col] = (bf16)f2bf(v[i] * rs); }
    } else if (g.mode == 1) {
#pragma unroll
        for (int i = 0; i < 8; ++i) { const int lr = rt * 32 + crow(8 * rh + i, hh), row = MP + lr;
            const float x = v[i] + (g.resid ? g.resid[(size_t)lr * DM + col] : bf2f(g.rb[(size_t)row * DM + col]));
            if (g.y) g.y[(size_t)lr * DM + col] = x; if (g.xb) g.xb[(size_t)row * DM + col] = (bf16)f2bf(x);
            float s = x * x; s += __shfl_xor(s, 1); s += __shfl_xor(s, 2); s += __shfl_xor(s, 4); s += __shfl_xor(s, 8); s += __shfl_xor(s, 16);
            if (g.ssout && r32 == 0) atomicAdd(g.ssout + row, s); }
    } else {
        float gu[8], upv[8];
#pragma unroll
        for (int i = 0; i < 8; ++i) { const int row = MP + rt * 32 + crow(8 * rh + i, hh); gu[i] = v[i] * rsqrtf(g.ssin[row] * (1.0f / DM) + EPS); upv[i] = __shfl_xor(gu[i], 16); }
        if (r32 < 16) { const float w0 = g.cw[f2], w1 = g.cw[DFF + f2], w2 = g.cw[2 * DFF + f2], bb = g.cb[f2];
#pragma unroll
            for (int aa = 0; aa < 2; ++aa) { const int lr0 = rt * 32 + 8 * (2 * rh + aa) + 4 * hh, sb = lr0 >> 2;
                const float s0 = g.cst[(size_t)(sb * 2) * DFF + f2], s1 = g.cst[(size_t)(sb * 2 + 1) * DFF + f2];
                const float u0 = gu[4 * aa], u1 = gu[4 * aa + 1], u2 = gu[4 * aa + 2], u3 = gu[4 * aa + 3];
                const float cv[4] = {bb + w0 * s0 + w1 * s1 + w2 * u0, bb + w0 * s1 + w1 * u0 + w2 * u1, bb + w0 * u0 + w1 * u1 + w2 * u2, bb + w0 * u1 + w1 * u2 + w2 * u3};
#pragma unroll
                for (int t = 0; t < 4; ++t) g.ACT[(size_t)(MP + lr0 + t) * DFF + f2] = (bf16)f2bf(cv[t] * sigmoidf_(cv[t]) * upv[4 * aa + t]);
                g.cvs[(size_t)(sb * 2) * DFF + f2] = u2; g.cvs[(size_t)(sb * 2 + 1) * DFF + f2] = u3; } }
    }
}
__device__ __forceinline__ void sgemm_phase(Ctx& c, const SgArgs& g, int N) {
#pragma unroll 1
    for (int u = c.G - 1 - (int)blockIdx.x; u < N / 32; u += c.G) sgemm_unit(c, g, u * 32);
}


__device__ __forceinline__ float wave_sum_f(float x) {
    x += __builtin_bit_cast(float, __builtin_amdgcn_update_dpp(0, __builtin_bit_cast(int, x), 0xB1, 0xF, 0xF, false));
    x += __builtin_bit_cast(float, __builtin_amdgcn_update_dpp(0, __builtin_bit_cast(int, x), 0x4E, 0xF, 0xF, false));
    x += __builtin_bit_cast(float, __builtin_amdgcn_update_dpp(0, __builtin_bit_cast(int, x), 0x141, 0xF, 0xF, false));
    x += __builtin_bit_cast(float, __builtin_amdgcn_update_dpp(0, __builtin_bit_cast(int, x), 0x140, 0xF, 0xF, false));
    const int xi = __builtin_bit_cast(int, x);
    return (__builtin_bit_cast(float, __builtin_amdgcn_readlane(xi, 0)) + __builtin_bit_cast(float, __builtin_amdgcn_readlane(xi, 16))) +
           (__builtin_bit_cast(float, __builtin_amdgcn_readlane(xi, 32)) + __builtin_bit_cast(float, __builtin_amdgcn_readlane(xi, 48)));
}
__device__ __forceinline__ void dsa_post_row(ARGREF a, int row, int lane_) {
    int lane = lane_; asm volatile("" : "+v"(lane));
    const bf16* z = (const bf16*)(a.ws + WS_Z) + (size_t)row * ZC1;
    const bool smp = row >= MP; const int b = smp ? (row - MP) >> 2 : row >> 12, t = smp ? (row - MP) & 3 : row & 4095;
    const float pos = (float)(smp ? PAST + t : t);
    const int i = lane & 31;
    float x1[8], x2[8], q1[4], q2[4], k1 = 0.f, k2 = 0.f;
#pragma unroll
    for (int hd = 0; hd < 8; ++hd) { x1[hd] = bf2f(z[hd * 128 + lane]); x2[hd] = bf2f(z[hd * 128 + 64 + lane]); }
    const u64 vv = *(const u64*)(z + Z1_V + 4 * lane);
#pragma unroll
    for (int p = 0; p < 4; ++p) { const int hd = 2 * p + (lane >> 5); q1[p] = bf2f(z[Z1_IQ + hd * 64 + i]); q2[p] = bf2f(z[Z1_IQ + hd * 64 + 32 + i]); }
    if (lane < 32) { k1 = bf2f(z[Z1_IK + i]); k2 = bf2f(z[Z1_IK + 32 + i]); }
    const float wraw = bf2f(z[Z1_IW + (lane & 7)]);
    float c128, s128, c64, s64;
    { const float r1 = pos * (exp2f(-(float)lane * (13.287712379549449f / 64.0f)) * 0.15915494309189535f), f1 = r1 - floorf(r1); s128 = __builtin_amdgcn_sinf(f1); c128 = __builtin_amdgcn_cosf(f1);
      const float r2 = pos * (exp2f(-(float)i * (13.287712379549449f / 32.0f)) * 0.15915494309189535f), f2 = r2 - floorf(r2); s64 = __builtin_amdgcn_sinf(f2); c64 = __builtin_amdgcn_cosf(f2); }
#pragma unroll
    for (int hd = 0; hd < 8; ++hd) {
        const float rs = rsqrtf(wave_sum_f(x1[hd] * x1[hd] + x2[hd] * x2[hd]) * (1.0f / 128.0f) + EPS);
        const float* gn = hd < 6 ? a.in[17] : a.in[18];
        const float y1 = x1[hd] * rs * gn[lane], y2 = x2[hd] * rs * gn[64 + lane];
        const float o1 = y1 * c128 - y2 * s128, o2 = y2 * c128 + y1 * s128;
        if (hd < 6) {
            if (smp) { float* q = (float*)(a.ws + WS_SQ) + (size_t)(row - MP) * 768 + hd * 128; q[lane] = o1; q[64 + lane] = o2; }
            else { bf16* q = (bf16*)(a.ws + WS_QB) + ((size_t)(b * 6 + hd) * SEQ + t) * 128; q[lane] = (bf16)f2bf(o1); q[64 + lane] = (bf16)f2bf(o2); }
        } else {
            const int kvh = hd - 6;
            float* ko = smp ? a.out + O_KS + (size_t)(row - MP) * 256 + kvh * 128 : a.out + O_KP + (size_t)row * 256 + kvh * 128;
            ko[lane] = o1; ko[64 + lane] = o2;
            if (!smp) { bf16* kb = (bf16*)(a.ws + WS_KB) + ((size_t)(b * 2 + kvh) * SEQ + t) * 128; kb[lane] = (bf16)f2bf(o1); kb[64 + lane] = (bf16)f2bf(o2); }
        }
    }
    {
        const f32x4 v = {bf2f((unsigned)vv & 0xffffu), bf2f(((unsigned)vv) >> 16), bf2f((unsigned)(vv >> 32) & 0xffffu), bf2f((unsigned)(vv >> 48))};
        float* vo = smp ? a.out + O_VS + (size_t)(row - MP) * 256 : a.out + O_VP + (size_t)row * 256;
        *(f32x4*)(vo + 4 * lane) = v;
        if (!smp) { const int kvh = lane >> 5, d = (lane & 31) * 4; *(u64*)((bf16*)(a.ws + WS_VB) + ((size_t)(b * 2 + kvh) * SEQ + t) * 128 + d) = vv; }
    }
    {
#pragma unroll
        for (int p = 0; p < 4; ++p) { const int hd = 2 * p + (lane >> 5);
            const float o1 = q1[p] * c64 - q2[p] * s64, o2 = q2[p] * c64 + q1[p] * s64;
            if (smp) { float* q = (float*)(a.ws + WS_SIQ) + (size_t)(row - MP) * 512 + hd * 64; q[i] = o1; q[32 + i] = o2; }
            else { bf16* q = (bf16*)(a.ws + WS_IQB) + (size_t)row * 512 + hd * 64; q[i] = (bf16)f2bf(o1); q[32 + i] = (bf16)f2bf(o2); } }
        const float rs = rsqrtf(wave_sum_f(k1 * k1 + k2 * k2) * (1.0f / 64.0f) + EPS);
        const float y1 = k1 * rs * a.in[19][i], y2 = k2 * rs * a.in[19][32 + i];
        const float o1 = y1 * c64 - y2 * s64, o2 = y2 * c64 + y1 * s64;
        if (lane < 32) {
            float* ko = smp ? a.out + O_IKS + (size_t)(row - MP) * 64 : a.out + O_IKP + (size_t)row * 64; ko[i] = o1; ko[32 + i] = o2;
            if (!smp) { bf16* kb = (bf16*)(a.ws + WS_IKB) + (size_t)row * 64; kb[i] = (bf16)f2bf(o1); kb[32 + i] = (bf16)f2bf(o2); } }
        if (lane < 8) { const float wv = wraw * (0.35355339059327373f * 0.125f);
            if (smp) ((float*)(a.ws + WS_SIW))[(row - MP) * 8 + lane] = wv; else ((float*)(a.ws + WS_IW))[(size_t)row * 8 + lane] = wv; }
    }
}
__device__ __forceinline__ void p8_dsa_post(Ctx& c, ARGREF a) {
    for (;;) { const int u = q_next(c, 1); if (u >= 384) break; if (u < 256) memattn_prompt_unit(c, a, 1, u); else memattn_sample_unit(c, a, 1, u - 256); }
    const int gw = c.vcu * NWAVES + c.wave, NGW = c.G * NWAVES;
    for (int row = gw; row < MVALID; row += NGW) dsa_post_row(a, row, c.lane);
}

__device__ __forceinline__ void idx_prompt_unit(Ctx& c, ARGREF a, int b, int qb) {
    int tid = c.tid; asm volatile("" : "+v"(tid));
    const int lane = tid & 63, r32 = lane & 31, hh = lane >> 5, w = c.wave;
    const int q0 = b * SEQ + qb * 32;
    LAS bf16* IQL = (LAS bf16*)(c.lds);
    { const bf16* src = (const bf16*)(a.ws + WS_IQB) + (size_t)q0 * 512;
#pragma unroll
      for (int i = 0; i < 4; ++i) { const int row = tid >> 4, ch = (tid & 15) + 16 * i; *(LAS v4u*)(IQL + row * 520 + ch * 8) = *(const v4u*)(src + (size_t)row * 512 + ch * 8); } }
    __syncthreads();
    const bf16* IK = (const bf16*)(a.ws + WS_IKB) + (size_t)(b * SEQ) * 64 + (size_t)r32 * 64 + 8 * hh;
    float* SC = (float*)(a.ws + WS_SC) + (size_t)(q0 + r32) * SEQ;
    float wv[8];
#pragma unroll
    for (int h = 0; h < 8; ++h) wv[h] = ((const float*)(a.ws + WS_IW))[(size_t)(q0 + r32) * 8 + h];
    bf16x8 ak[4], an[4];
    if (w <= qb) {
#pragma unroll
        for (int ks = 0; ks < 4; ++ks) ak[ks] = *(const bf16x8*)(IK + (size_t)(w * 32) * 64 + ks * 16); }
#pragma unroll 1
    for (int kt = w; kt <= qb; kt += 8) {
        if (kt + 8 <= qb) {
#pragma unroll
            for (int ks = 0; ks < 4; ++ks) an[ks] = *(const bf16x8*)(IK + (size_t)((kt + 8) * 32) * 64 + ks * 16); }
        f32x16 sc = {};
        int qoff = r32 * 520 + 8 * hh; asm volatile("" : "+v"(qoff));
#pragma unroll
        for (int h = 0; h < 8; ++h) { f32x16 d = {};
#pragma unroll
            for (int ks = 0; ks < 4; ++ks) d = __builtin_amdgcn_mfma_f32_32x32x16_bf16(ak[ks], *(const LAS bf16x8*)(IQL + qoff + h * 64 + ks * 16), d, 0, 0, 0);
#pragma unroll
            for (int r = 0; r < 16; ++r) sc[r] = fmaf(wv[h], fmaxf(d[r], 0.f), sc[r]); }
#pragma unroll
        for (int g = 0; g < 4; ++g) *(f32x4*)(SC + kt * 32 + 8 * g + 4 * hh) = (f32x4){sc[4 * g], sc[4 * g + 1], sc[4 * g + 2], sc[4 * g + 3]};
#pragma unroll
        for (int ks = 0; ks < 4; ++ks) ak[ks] = an[ks];
    }
}
__device__ __forceinline__ v4u pack8f(const float* p) { const f32x4 x = *(const f32x4*)p, y = *(const f32x4*)(p + 4); v4u o; o.x = pk2(x.x, x.y); o.y = pk2(x.z, x.w); o.z = pk2(y.x, y.y); o.w = pk2(y.z, y.w); return o; }
__device__ __forceinline__ void idx_sample_tile(ARGREF a, int sb, int tl, int lane_) {
    int lane = lane_; asm volatile("" : "+v"(lane));
    const int r32 = lane & 31, hh = lane >> 5, tk = r32 >> 3, hd = r32 & 7;
    const float* iq = (const float*)(a.ws + WS_SIQ) + (size_t)(sb * 4 + tk) * 512 + hd * 64 + 8 * hh;
    const float wv = ((const float*)(a.ws + WS_SIW))[(sb * 4 + tk) * 8 + hd];
    const float* src;
    if (tl < 256) src = a.in[4] + ((size_t)a.page_table[sb * 64 + (tl >> 2)] * 128 + (tl & 3) * 32 + r32) * 64 + 8 * hh;
    else src = a.out + O_IKS + (size_t)(sb * 4 + (r32 & 3)) * 64 + 8 * hh;
    v4u af[4], bf_[4];
#pragma unroll
    for (int ks = 0; ks < 4; ++ks) { af[ks] = pack8f(src + 16 * ks); bf_[ks] = pack8f(iq + 16 * ks); }
    if (tl == 256 && r32 >= 4) {
#pragma unroll
        for (int ks = 0; ks < 4; ++ks) af[ks] = (v4u){0u, 0u, 0u, 0u}; }
    f32x16 d = {};
#pragma unroll
    for (int ks = 0; ks < 4; ++ks) d = __builtin_amdgcn_mfma_f32_32x32x16_bf16(__builtin_bit_cast(bf16x8, af[ks]), __builtin_bit_cast(bf16x8, bf_[ks]), d, 0, 0, 0);
    float* dst = (float*)(a.ws + WS_SSC) + (size_t)(sb * 4 + tk) * SSC_LD + tl * 32;
#pragma unroll
    for (int r = 0; r < 16; ++r) { float v = wv * fmaxf(d[r], 0.f);
        v += __builtin_bit_cast(float, __builtin_amdgcn_update_dpp(0, __builtin_bit_cast(int, v), 0xB1, 0xF, 0xF, false));
        v += __builtin_bit_cast(float, __builtin_amdgcn_update_dpp(0, __builtin_bit_cast(int, v), 0x4E, 0xF, 0xF, false));
        v += __builtin_bit_cast(float, __builtin_amdgcn_update_dpp(0, __builtin_bit_cast(int, v), 0x141, 0xF, 0xF, false));
        if (hd == 0) dst[crow(r, hh)] = v; }
}
__device__ __forceinline__ void p9_indexer(Ctx& c, ARGREF a) {
    const int gw = c.vcu * NWAVES + c.wave, NGW = c.G * NWAVES;
#pragma unroll 1
    for (int wt = gw; wt < 32 * 257; wt += NGW) idx_sample_tile(a, wt / 257, wt % 257, c.lane);
    for (;;) { const int u = q_next(c, 2); if (u >= 512) break; idx_prompt_unit(c, a, u & 3, 127 - (u >> 2)); }
}


__device__ __forceinline__ unsigned fkey(float f) { const unsigned u = __builtin_bit_cast(unsigned, f + 0.0f); return (u & 0x80000000u) ? ~u : (u | 0x80000000u); }
__device__ __forceinline__ void acc_ge(int& cnt, unsigned key, unsigned cand) { asm volatile("v_cmp_le_u32_e32 vcc, %1, %2\n\tv_addc_co_u32_e32 %0, vcc, 0, %0, vcc" : "+v"(cnt) : "s"(cand), "v"(key) : "vcc"); }
__device__ __forceinline__ void acc_ge4(int& c0, int& c1, int& c2, int& c3, unsigned k0, unsigned k1, unsigned k2, unsigned k3, unsigned cand) {
    u64 m0, m1, m2, m3;
    asm volatile("v_cmp_le_u32_e64 %4, %8, %9\n\tv_cmp_le_u32_e64 %5, %8, %10\n\tv_cmp_le_u32_e64 %6, %8, %11\n\tv_cmp_le_u32_e64 %7, %8, %12\n\t"
                 "v_addc_co_u32_e64 %0, %4, 0, %0, %4\n\tv_addc_co_u32_e64 %1, %5, 0, %1, %5\n\tv_addc_co_u32_e64 %2, %6, 0, %2, %6\n\tv_addc_co_u32_e64 %3, %7, 0, %3, %7"
                 : "+v"(c0), "+v"(c1), "+v"(c2), "+v"(c3), "=&s"(m0), "=&s"(m1), "=&s"(m2), "=&s"(m3) : "s"(cand), "v"(k0), "v"(k1), "v"(k2), "v"(k3));
}
__device__ __forceinline__ u64 ballot_nz(unsigned v) { u64 m; asm volatile("v_cmp_ne_u32_e64 %0, 0, %1" : "=s"(m) : "v"(v)); return m; }
__device__ __forceinline__ int wave_sum_dpp(int x) {
    x += __builtin_amdgcn_update_dpp(0, x, 0xB1, 0xF, 0xF, false);
    x += __builtin_amdgcn_update_dpp(0, x, 0x4E, 0xF, 0xF, false);
    x += __builtin_amdgcn_update_dpp(0, x, 0x141, 0xF, 0xF, false);
    x += __builtin_amdgcn_update_dpp(0, x, 0x140, 0xF, 0xF, false);
    return (__builtin_amdgcn_readlane(x, 0) + __builtin_amdgcn_readlane(x, 16)) + (__builtin_amdgcn_readlane(x, 32) + __builtin_amdgcn_readlane(x, 48));
}
__device__ __forceinline__ int mbcnt64(u64 m) { return (int)__builtin_amdgcn_mbcnt_hi((unsigned)(m >> 32), __builtin_amdgcn_mbcnt_lo((unsigned)m, 0u)); }
constexpr int TK_LOWBITS = 18;
__device__ __forceinline__ void topk_finish(unsigned ck, int cp, int A, int posmax, unsigned& T, int& P) {
#pragma unroll 1
    for (int bit = TK_LOWBITS - 1; bit >= 0; --bit) { const unsigned cand = T | (1u << bit); if (A + __builtin_popcountll(__ballot(ck >= cand)) >= 256) T = cand; }
    const int need = 256 - (A + __builtin_popcountll(__ballot(ck > T))), ceq = __builtin_popcountll(__ballot(ck == T));
    P = posmax;
    if (ceq != need) { P = 0;
#pragma unroll 1
        for (int bit = 13; bit >= 0; --bit) { const int cand = P | (1 << bit); if (__builtin_popcountll(__ballot(ck == T && cp < cand)) < need) P = cand; } }
}
__device__ __forceinline__ unsigned wave_min_u(unsigned x) {
    x = min(x, (unsigned)__builtin_amdgcn_update_dpp(0, (int)x, 0xB1, 0xF, 0xF, false)); x = min(x, (unsigned)__builtin_amdgcn_update_dpp(0, (int)x, 0x4E, 0xF, 0xF, false));
    x = min(x, (unsigned)__builtin_amdgcn_update_dpp(0, (int)x, 0x141, 0xF, 0xF, false)); x = min(x, (unsigned)__builtin_amdgcn_update_dpp(0, (int)x, 0x140, 0xF, 0xF, false));
    return min(min((unsigned)__builtin_amdgcn_readlane((int)x, 0), (unsigned)__builtin_amdgcn_readlane((int)x, 16)), min((unsigned)__builtin_amdgcn_readlane((int)x, 32), (unsigned)__builtin_amdgcn_readlane((int)x, 48)));
}
__device__ __forceinline__ unsigned wave_max_u(unsigned x) {
    x = max(x, (unsigned)__builtin_amdgcn_update_dpp(0, (int)x, 0xB1, 0xF, 0xF, false)); x = max(x, (unsigned)__builtin_amdgcn_update_dpp(0, (int)x, 0x4E, 0xF, 0xF, false));
    x = max(x, (unsigned)__builtin_amdgcn_update_dpp(0, (int)x, 0x141, 0xF, 0xF, false)); x = max(x, (unsigned)__builtin_amdgcn_update_dpp(0, (int)x, 0x140, 0xF, 0xF, false));
    return max(max((unsigned)__builtin_amdgcn_readlane((int)x, 0), (unsigned)__builtin_amdgcn_readlane((int)x, 16)), max((unsigned)__builtin_amdgcn_readlane((int)x, 32), (unsigned)__builtin_amdgcn_readlane((int)x, 48)));
}
__device__ __forceinline__ void topk_prompt_rows(ARGREF a, int row0, int stride, int lane_, LAS unsigned* cl) {
    int lane = lane_; asm volatile("" : "+v"(lane));
    const float* SCb = (const float*)(a.ws + WS_SC);
#pragma unroll 1
    for (int row = row0; row < MP; row += stride) {
        const int t = row & 4095;
        u64* mk = (u64*)(a.ws + WS_MASK) + (size_t)row * 64;
        if (t < 256) { u64 myword = 0ull;
#pragma unroll 1
            for (int j = 0; j < 64; ++j) { const u64 m = __ballot(64 * j + lane <= t); if (lane == j) myword = m; }
            mk[lane] = myword;
            continue; }
        unsigned key[64];
        { const float* sc_ = SCb + (size_t)row * SEQ + lane; const int tj_ = t >> 6;
          float v[64];
#pragma unroll
          for (int j = 0; j < 64; ++j) v[j] = sc_[64 * (j < tj_ ? j : tj_)];
          int pj = lane;
#pragma unroll
          for (int j = 0; j < 64; ++j) { const int u = __builtin_bit_cast(int, v[j] + 0.0f); const unsigned k = (unsigned)u ^ ((unsigned)(u >> 31) | 0x80000000u); key[j] = (pj <= t) ? k : 0u; pj += 64; asm volatile("" : "+v"(pj)); } }
        unsigned kh[64];
#pragma unroll
        for (int j = 0; j < 64; ++j) { kh[j] = key[j] >> 1; asm volatile("" : "+v"(kh[j])); }
        unsigned T; int hb;
        {
            unsigned b0 = 0u, b1 = 0u, b2 = 0u, b3 = 0u;
#pragma unroll
            for (int j = 0; j < 64; ++j) { unsigned x = key[j]; const unsigned m0 = max(b0, x); x = min(b0, x); b0 = m0; const unsigned m1 = max(b1, x); x = min(b1, x); b1 = m1; const unsigned m2 = max(b2, x); x = min(b2, x); b2 = m2; b3 = max(b3, x); }
            const unsigned L = wave_min_u(b3), H = wave_max_u(b3), df = L ^ H;
            hb = df ? 31 - __builtin_clz(df) : -1;
            T = hb >= 31 ? 0u : (L & ~((2u << (hb < 0 ? 0 : hb)) - 1u)); if (hb < 0) T = L;
        }
#define TK_FULLCOUNT(CAND, OUT) do { const unsigned cs_ = __builtin_amdgcn_readfirstlane(CAND); int c0_ = 0, c1_ = 0, c2_ = 0, c3_ = 0; \
        _Pragma("unroll") for (int j = 0; j < 64; j += 4) acc_ge4(c0_, c1_, c2_, c3_, key[j], key[j + 1], key[j + 2], key[j + 3], cs_); OUT = wave_sum_dpp((c0_ + c1_) + (c2_ + c3_)); } while (0)
#define TK_FASTCOUNT(CAND, OUT) do { const unsigned ch_ = __builtin_amdgcn_readfirstlane((CAND) >> 1); unsigned a0_ = 0u, a1_ = 0u, a2_ = 0u, a3_ = 0u; \
        _Pragma("unroll") for (int j = 0; j < 64; j += 4) { a0_ = __builtin_amdgcn_alignbit(a0_, kh[j] - ch_, 31); a1_ = __builtin_amdgcn_alignbit(a1_, kh[j + 1] - ch_, 31); \
            a2_ = __builtin_amdgcn_alignbit(a2_, kh[j + 2] - ch_, 31); a3_ = __builtin_amdgcn_alignbit(a3_, kh[j + 3] - ch_, 31); } \
        OUT = 4096 - wave_sum_dpp((__builtin_popcount(a0_) + __builtin_popcount(a1_)) + (__builtin_popcount(a2_) + __builtin_popcount(a3_))); } while (0)
#pragma unroll 1
        for (int bit = hb; bit >= TK_LOWBITS; --bit) { const unsigned cand = T | (1u << bit); int tot; TK_FASTCOUNT(cand, tot); if (tot >= 256) T = cand; }
        const unsigned Tb = T & ~((1u << TK_LOWBITS) - 1u), hib = Tb + (1u << TK_LOWBITS);
        int A = 0, cT; if (hib != 0u) TK_FASTCOUNT(hib, A); TK_FASTCOUNT(Tb, cT);
#undef TK_FASTCOUNT
        int P;
        if (cT - A <= 64) {
            if (lane == 0) cl[128] = 0u;
            int pj = lane;
#pragma unroll
            for (int j = 0; j < 64; ++j) { if ((key[j] - Tb) < (1u << TK_LOWBITS)) { const unsigned pos = __hip_atomic_fetch_add(cl + 128, 1u, __ATOMIC_RELAXED, __HIP_MEMORY_SCOPE_WORKGROUP); if (pos < 64u) { cl[pos] = key[j]; cl[64 + pos] = (unsigned)pj; } }
                pj += 64; asm volatile("" : "+v"(pj)); }
            const int nund = cT - A;
            const unsigned ck = lane < nund ? cl[lane] : 0u; const int cp = (int)cl[64 + lane];
            topk_finish(ck, cp, A, 4095, T, P);
        } else {
#pragma unroll 1
            for (int bit = TK_LOWBITS - 1; bit >= 0; --bit) { const unsigned cand = T | (1u << bit); int tot; TK_FULLCOUNT(cand, tot); if (tot >= 256) T = cand; }
            int cge, cgt; TK_FULLCOUNT(T, cge); cgt = 0; if (T != 0xffffffffu) TK_FULLCOUNT(T + 1u, cgt);
            const int need = 256 - cgt, ceq = cge - cgt; P = 4095;
            if (ceq != need) { P = 0;
#pragma unroll 1
                for (int bit = 11; bit >= 0; --bit) { const int cand = P | (1 << bit); int cnt = 0; int pj = lane;
#pragma unroll
                    for (int j = 0; j < 64; ++j) { cnt += (key[j] == T && pj < cand) ? 1 : 0; pj += 64; asm volatile("" : "+v"(pj)); }
                    if (wave_sum_dpp(cnt) < need) P = cand; } }
        }
#undef TK_FULLCOUNT
        if (P != 4095) {
            int pq = lane;
#pragma unroll
            for (int j = 0; j < 64; ++j) { if (key[j] == T && pq > P) key[j] = 0u; pq += 64; asm volatile("" : "+v"(pq)); } }
        unsigned wlo = 0u, whi = 0u; const unsigned Ts = __builtin_amdgcn_readfirstlane(T);
#pragma unroll
        for (int j = 0; j < 64; ++j) asm volatile("v_cmp_le_u32_e32 vcc, %2, %3\n\ts_nop 3\n\tv_writelane_b32 %0, vcc_lo, %4\n\tv_writelane_b32 %1, vcc_hi, %4" : "+v"(wlo), "+v"(whi) : "s"(Ts), "v"(key[j]), "i"(j) : "vcc");
        mk[lane] = ((u64)whi << 32) | (u64)wlo;
    }
}
__device__ __forceinline__ void topk_sample_row(ARGREF a, int q, int lane_, LAS unsigned* K, LAS unsigned* cl) {
    int lane = lane_; asm volatile("" : "+v"(lane));
    const int t = q & 3, n = PAST + t + 1; const float* sc = (const float*)(a.ws + WS_SSC) + (size_t)q * SSC_LD;
    int* out = (int*)(a.ws + WS_SIDX) + q * 256;
    unsigned key[129];
#pragma unroll
    for (int j = 0; j < 129; ++j) { const float v = sc[64 * j + lane]; key[j] = (j < 128 || lane < n - 8192) ? fkey(v) : 0u; }
#pragma unroll
    for (int j = 0; j < 129; ++j) K[64 * j + lane] = key[j];
#define TK_FULLCOUNT(CAND, OUT) do { const unsigned cs_ = __builtin_amdgcn_readfirstlane(CAND); int c0_ = 0, c1_ = 0, c2_ = 0, c3_ = 0; \
        _Pragma("unroll") for (int j = 0; j < 128; j += 4) acc_ge4(c0_, c1_, c2_, c3_, key[j], key[j + 1], key[j + 2], key[j + 3], cs_); acc_ge(c0_, key[128], cs_); OUT = wave_sum_dpp((c0_ + c1_) + (c2_ + c3_)); } while (0)
    unsigned T = 0u;
#pragma unroll 1
    for (int bit = 31; bit >= TK_LOWBITS; --bit) { const unsigned cand = T | (1u << bit); int tot; TK_FULLCOUNT(cand, tot); if (tot >= 256) T = cand; }
    const unsigned hib = T + (1u << TK_LOWBITS);
    int A = 0, cT; if (hib != 0u) TK_FULLCOUNT(hib, A); TK_FULLCOUNT(T, cT);
    int P;
    if (cT - A <= 64) {
        int base = 0;
#pragma unroll 1
        for (int j0 = 0; j0 < 128; j0 += 8) { unsigned kk[8];
#pragma unroll
            for (int i = 0; i < 8; ++i) kk[i] = K[64 * (j0 + i) + lane];
#pragma unroll
            for (int i = 0; i < 8; ++i) { const unsigned und = (kk[i] - T) < (1u << TK_LOWBITS) ? 1u : 0u; const u64 m = ballot_nz(und); const int pos = base + mbcnt64(m);
                if (und) { cl[pos] = kk[i]; cl[64 + pos] = (unsigned)(64 * (j0 + i) + lane); }
                base += __builtin_popcountll(m); } }
        { const unsigned kj = K[64 * 128 + lane]; const unsigned und = (kj - T) < (1u << TK_LOWBITS) ? 1u : 0u; const u64 m = ballot_nz(und); const int pos = base + mbcnt64(m);
          if (und) { cl[pos] = kj; cl[64 + pos] = (unsigned)(64 * 128 + lane); } base += __builtin_popcountll(m); }
        const unsigned ck = lane < base ? cl[lane] : 0u; const int cp = (int)cl[64 + lane];
        topk_finish(ck, cp, A, 16383, T, P);
    } else {
#pragma unroll 1
        for (int bit = TK_LOWBITS - 1; bit >= 0; --bit) { const unsigned cand = T | (1u << bit); int tot; TK_FULLCOUNT(cand, tot); if (tot >= 256) T = cand; }
        int cge, cgt; TK_FULLCOUNT(T, cge); cgt = 0; if (T != 0xffffffffu) TK_FULLCOUNT(T + 1u, cgt);
        const int need = 256 - cgt, ceq = cge - cgt; P = 16383;
        if (ceq != need) { P = 0;
#pragma unroll 1
            for (int bit = 13; bit >= 0; --bit) { const int cand = P | (1 << bit); int cnt = 0;
#pragma unroll 4
                for (int j = 0; j < 129; ++j) cnt += (K[64 * j + lane] == T && 64 * j + lane < cand) ? 1 : 0;
                if (wave_sum_dpp(cnt) < need) P = cand; } }
    }
#undef TK_FULLCOUNT
    int base = 0;
#pragma unroll 1
    for (int j0 = 0; j0 < 136; j0 += 8) { unsigned kk[8];
#pragma unroll
        for (int i = 0; i < 8; ++i) kk[i] = (j0 + i < 129) ? K[64 * (j0 + i) + lane] : 0u;
#pragma unroll
        for (int i = 0; i < 8; ++i) { const int ps = 64 * (j0 + i) + lane; const unsigned selv = (kk[i] > T || (kk[i] == T && ps <= P)) ? 1u : 0u; const u64 m = ballot_nz(selv);
            const int pos = base + mbcnt64(m);
            if (selv && pos < 256) out[pos] = ps;
            base += __builtin_popcountll(m); } }
}
__device__ __forceinline__ void p10_topk(Ctx& c, ARGREF a) {
    const int gw = c.vcu * NWAVES + c.wave, NGW = c.G * NWAVES;
    LAS unsigned* cl = (LAS unsigned*)(c.lds) + c.wave * 192;
    if (c.wave == 0 && c.vcu < MS) topk_sample_row(a, c.vcu, c.lane, (LAS unsigned*)(c.lds + 8192), cl);
    topk_prompt_rows(a, gw, NGW, c.lane, cl);
}


__device__ __forceinline__ void attn_sample_unit(Ctx& c, ARGREF a, int sb, int t) {
    LAS bf16* KV = (LAS bf16*)(c.lds);
    LAS float* QL = (LAS float*)(c.lds + 69632);
    LAS float* SL = (LAS float*)(c.lds + 69632 + 3072);
    LAS float* OL = (LAS float*)(c.lds + 69632 + 6144);
    LAS int* IL = (LAS int*)(c.lds + 69632 + 12288);
    int tid = c.tid; asm volatile("" : "+v"(tid));
    const int lane = tid & 63, w = c.wave, q = sb * 4 + t;
    __syncthreads();
    if (tid < 256) IL[tid] = ((const int*)(a.ws + WS_SIDX))[q * 256 + tid];
    for (int i = tid; i < 768; i += 512) QL[i] = ((const float*)(a.ws + WS_SQ))[(size_t)q * 768 + i];
    __syncthreads();
    bf16* MIX = (bf16*)(a.ws + WS_MIX) + (size_t)(MP + q) * DM;
#pragma unroll 1
    for (int kvh = 0; kvh < 2; ++kvh) {
#pragma unroll 1
        for (int pass = 0; pass < 2; ++pass) {
            const float* pool = pass ? a.in[3] : a.in[2]; const float* nw = a.out + (pass ? O_VS : O_KS);
            for (int i = tid >> 5; i < 256; i += 16) { const int idx = IL[i]; const float* src;
                if (idx < PAST) src = pool + (((size_t)a.page_table[sb * 64 + (idx >> 7)] * 128 + (idx & 127)) * 2 + kvh) * 128;
                else src = nw + (size_t)(sb * 4 + (idx - PAST)) * 256 + kvh * 128;
                const f32x4 v = *(const f32x4*)(src + (tid & 31) * 4);
                *(LAS u64*)(KV + i * 136 + (tid & 31) * 4) = (u64)pk2(v.x, v.y) | ((u64)pk2(v.z, v.w) << 32); }
            __syncthreads();
            if (pass == 0) {
                const int i = tid >> 1, dh = (tid & 1) * 64; float s0 = 0.f, s1 = 0.f, s2 = 0.f;
#pragma unroll 8
                for (int d = 0; d < 64; ++d) { const float kx = bf2f(KV[i * 136 + dh + d]);
                    s0 = fmaf(QL[(3 * kvh + 0) * 128 + dh + d], kx, s0); s1 = fmaf(QL[(3 * kvh + 1) * 128 + dh + d], kx, s1); s2 = fmaf(QL[(3 * kvh + 2) * 128 + dh + d], kx, s2); }
                s0 += __shfl_xor(s0, 1); s1 += __shfl_xor(s1, 1); s2 += __shfl_xor(s2, 1);
                if ((tid & 1) == 0) { SL[i] = s0 * 0.08838834764831845f; SL[256 + i] = s1 * 0.08838834764831845f; SL[512 + i] = s2 * 0.08838834764831845f; }
                __syncthreads();
                if (w < 3) { float v[4], mx = -1e30f;
#pragma unroll
                    for (int j = 0; j < 4; ++j) { v[j] = SL[w * 256 + 64 * j + lane]; mx = fmaxf(mx, v[j]); }
#pragma unroll
                    for (int o = 1; o < 64; o <<= 1) mx = fmaxf(mx, __shfl_xor(mx, o));
                    float l = 0.f;
#pragma unroll
                    for (int j = 0; j < 4; ++j) { v[j] = __expf(v[j] - mx); l += v[j]; }
                    l = wave_sum(l); const float il = 1.0f / l;
#pragma unroll
                    for (int j = 0; j < 4; ++j) SL[w * 256 + 64 * j + lane] = v[j] * il; }
                __syncthreads();
            } else {
                const int d = tid & 127, part = tid >> 7; float o0 = 0.f, o1 = 0.f, o2 = 0.f;
#pragma unroll 8
                for (int i = part * 64; i < part * 64 + 64; ++i) { const float vx = bf2f(KV[i * 136 + d]); o0 = fmaf(SL[i], vx, o0); o1 = fmaf(SL[256 + i], vx, o1); o2 = fmaf(SL[512 + i], vx, o2); }
                OL[(part * 3 + 0) * 128 + d] = o0; OL[(part * 3 + 1) * 128 + d] = o1; OL[(part * 3 + 2) * 128 + d] = o2;
                __syncthreads();
                if (tid < 384) { const int hq = tid >> 7, dd = tid & 127; const float o = (OL[hq * 128 + dd] + OL[(3 + hq) * 128 + dd]) + (OL[(6 + hq) * 128 + dd] + OL[(9 + hq) * 128 + dd]);
                    MIX[(3 * kvh + hq) * 128 + dd] = (bf16)f2bf(o); }
                __syncthreads();
            }
        }
    }
}


namespace attn {
using bf16 = unsigned short;
typedef short bf16x8 __attribute__((ext_vector_type(8)));
typedef short s16x4 __attribute__((ext_vector_type(4)));
typedef float f32x16 __attribute__((ext_vector_type(16)));
typedef float f32x4 __attribute__((ext_vector_type(4)));
typedef unsigned u32x4 __attribute__((ext_vector_type(4)));
typedef unsigned u32x2 __attribute__((ext_vector_type(2)));
constexpr int D = 128, OS = 1024;
constexpr float THR = 8.f;
constexpr float SCALE = 0.08838834764831845f;
constexpr int NW = 8, QBLK = 32, KVBLK = 64, QB = NW * QBLK;
constexpr int SHM_V = KVBLK * D * 2, SHM_K = KVBLK * D * 2;
constexpr int LDS_BYTES = 2 * SHM_V + 2 * SHM_K + NW * 64 * 4;

#define KSWZ(row, colB) ((row) * 256 + ((colB) ^ (((row) & 7) << 4)))
#define SBAR() __builtin_amdgcn_sched_barrier(0)
__device__ __forceinline__ int v_st(int k, int c) { const int kk = (k & ~0xC) | ((k & 4) << 1) | ((k & 8) >> 1); return ((kk >> 3) * 4 + (c >> 5)) * 512 + ((kk & 7) * 32 + (c & 31)) * 2; }
__device__ __forceinline__ int v_rd_base(int lane) { return ((lane & 3) << 3) | (((lane >> 2) & 3) << 6) | (((lane >> 4) & 1) << 5) | (((lane >> 5) & 1) << 8); }
constexpr int v_rd_off(int d0, int ks, int half) { return d0 * 512 + ks * 4096 + half * 2048; }
__device__ __forceinline__ int crow(int r, int hi) { return (r & 3) + 8 * (r >> 2) + 4 * hi; }
__device__ __forceinline__ unsigned cvtpk(float lo, float hi) {
    unsigned r; asm volatile("v_cvt_pk_bf16_f32 %0, %1, %2" : "=v"(r) : "v"(lo), "v"(hi)); return r;
}
__device__ __forceinline__ bf16x8 pack8(f32x4 a, f32x4 b) {
    u32x4 w = {cvtpk(a[0], a[1]), cvtpk(a[2], a[3]), cvtpk(b[0], b[1]), cvtpk(b[2], b[3])};
    return *reinterpret_cast<bf16x8*>(&w);
}

__device__ __forceinline__ void partialSM(f32x16& p0, f32x16& p1, float& m_reg, float& mn, float& alpha) {
    float pmax = p0[0]; for (int r = 1; r < 16; ++r) pmax = fmaxf(pmax, p0[r]); for (int r = 0; r < 16; ++r) pmax = fmaxf(pmax, p1[r]);
    { auto rr = __builtin_amdgcn_permlane32_swap(__float_as_uint(pmax), __float_as_uint(pmax), false, false);
      pmax = fmaxf(__uint_as_float(rr[0]), __uint_as_float(rr[1])); }
    constexpr float C2 = 1.4426950408889634f * SCALE;
    if (__builtin_expect(__all((pmax - m_reg) * SCALE <= THR), 1)) { mn = m_reg; alpha = 1.f; }
    else { mn = fmaxf(m_reg, pmax); alpha = __builtin_amdgcn_exp2f((m_reg - mn) * C2); m_reg = mn; }
    const float mnL = -mn * C2;
    for (int r = 0; r < 16; ++r) p0[r] = fmaf(p0[r], C2, mnL); for (int r = 0; r < 16; ++r) p1[r] = fmaf(p1[r], C2, mnL);
    for (int r = 0; r < 16; ++r) p0[r] = __builtin_amdgcn_exp2f(p0[r]);
}
__device__ __forceinline__ void finishSM(f32x16& p0, f32x16& p1, float alpha, float& l_reg, bf16x8& pa0, bf16x8& pa1, bf16x8& pa2, bf16x8& pa3) {
    for (int r = 0; r < 16; ++r) p1[r] = __builtin_amdgcn_exp2f(p1[r]);
    float ps = 0; for (int r = 0; r < 16; ++r) ps += p0[r]; for (int r = 0; r < 16; ++r) ps += p1[r];
    { auto rr = __builtin_amdgcn_permlane32_swap(__float_as_uint(ps), __float_as_uint(ps), false, false);
      ps = __uint_as_float(rr[0]) + __uint_as_float(rr[1]); }
    l_reg = l_reg * alpha + ps;
#define PK4(P, B_, OUT) do { unsigned a0 = cvtpk(P[B_+0], P[B_+1]), a1 = cvtpk(P[B_+2], P[B_+3]);                          \
        unsigned b0 = cvtpk(P[B_+4], P[B_+5]), b1 = cvtpk(P[B_+6], P[B_+7]);                                             \
        auto r0 = __builtin_amdgcn_permlane32_swap(a0, b0, false, false); auto r1 = __builtin_amdgcn_permlane32_swap(a1, b1, false, false); \
        u32x4 w = {r0[0], r1[0], r0[1], r1[1]}; OUT = *reinterpret_cast<bf16x8*>(&w); } while (0)
    PK4(p0, 0, pa0); PK4(p0, 8, pa1); PK4(p1, 0, pa2); PK4(p1, 8, pa3);
#undef PK4
}
template <int KB, bool SK>
__device__ __forceinline__ void qkt(f32x16& p0, f32x16& p1, const char* K_lds, int r32, int hi, const bf16x8* qr, bool act) {
    if (SK && !act) { const float NEG = -__builtin_inff();
#pragma unroll
        for (int r = 0; r < 16; ++r) { p0[r] = NEG; p1[r] = NEG; } return; }
    p0 = f32x16{}; p1 = f32x16{};
    const char* kb[4];
#pragma unroll
    for (int dd = 0; dd < 4; ++dd) kb[dd] = K_lds + KB * SHM_K + KSWZ(r32, (dd * 16 + hi * 8) * 2);
#pragma unroll
    for (int d0 = 0; d0 < 8; ++d0) { const char* a = kb[d0 & 3] + (d0 >> 2) * 128;
        bf16x8 b0 = *reinterpret_cast<const bf16x8*>(a);
        bf16x8 b1 = *reinterpret_cast<const bf16x8*>(a + 32 * 256);
        p0 = __builtin_amdgcn_mfma_f32_32x32x16_bf16(b0, qr[d0], p0, 0, 0, 0);
        p1 = __builtin_amdgcn_mfma_f32_32x32x16_bf16(b1, qr[d0], p1, 0, 0, 0); }
}
template <int VB, bool SK>
__device__ __forceinline__ void pv_tile(f32x16* o, int vb0, bf16x8 pa0, bf16x8 pa1, bf16x8 pa2, bf16x8 pa3, bool act) {
    if (SK && !act) return;
#define TRRD(dst, off) asm volatile("ds_read_b64_tr_b16 %0, %1 offset:%2" : "=&v"(dst) : "v"(vb0), "i"(off) : "memory")
#define PV_D0(d0) do { s16x4 l0, l1, l2, l3, h0, h1, h2, h3; constexpr int b_ = VB * SHM_V + v_rd_off(d0, 0, 0);     \
        TRRD(l0, b_); TRRD(h0, b_ + 2048); TRRD(l1, b_ + 4096); TRRD(h1, b_ + 6144); TRRD(l2, b_ + 8192); TRRD(h2, b_ + 10240); TRRD(l3, b_ + 12288); TRRD(h3, b_ + 14336); \
        asm volatile("s_waitcnt lgkmcnt(0)" ::: "memory"); SBAR();                 \
        o[d0] = __builtin_amdgcn_mfma_f32_32x32x16_bf16(pa0, (bf16x8){l0[0], l0[1], l0[2], l0[3], h0[0], h0[1], h0[2], h0[3]}, o[d0], 0, 0, 0);   \
        o[d0] = __builtin_amdgcn_mfma_f32_32x32x16_bf16(pa1, (bf16x8){l1[0], l1[1], l1[2], l1[3], h1[0], h1[1], h1[2], h1[3]}, o[d0], 0, 0, 0);   \
        o[d0] = __builtin_amdgcn_mfma_f32_32x32x16_bf16(pa2, (bf16x8){l2[0], l2[1], l2[2], l2[3], h2[0], h2[1], h2[2], h2[3]}, o[d0], 0, 0, 0);   \
        o[d0] = __builtin_amdgcn_mfma_f32_32x32x16_bf16(pa3, (bf16x8){l3[0], l3[1], l3[2], l3[3], h3[0], h3[1], h3[2], h3[3]}, o[d0], 0, 0, 0); } while (0)
    PV_D0(0); PV_D0(1); PV_D0(2); PV_D0(3);
#undef PV_D0
#undef TRRD
}

__device__ __forceinline__ bf16x8 load8(const bf16* p) { return *reinterpret_cast<const bf16x8*>(p); }
__device__ __forceinline__ void mask_bits(f32x16& p0, f32x16& p1, u32x2 w, int hi) {
    const float NEG = -__builtin_inff();
    asm volatile("" : "+v"(w.x), "+v"(w.y));
    const unsigned lo = w.x >> (4 * hi), up = w.y >> (4 * hi);
#pragma unroll
    for (int r = 0; r < 16; ++r) { const int c = (r & 3) + 8 * (r >> 2);
        if (!((lo >> c) & 1u)) p0[r] = NEG;
        if (!((up >> c) & 1u)) p1[r] = NEG; }
}
struct BlockRef { const bf16* Q; const bf16* K; const bf16* V; bf16* O; const u32x2* M; int P0; };
struct Seam { bf16x8 qr[8]; bf16x8 st_v0, st_v1, st_k0, st_k1; };
#define ROW(p, k0, rr) ((p) + (size_t)((k0) + (rr)) * D + sc)
#define VMW() asm volatile("s_waitcnt vmcnt(0)" ::: "memory")
#define VMWN(n) asm volatile("s_waitcnt vmcnt(%0)" :: "i"(n) : "memory")
#define SLOAD_H(Kp, Vp, k0) do { S.st_v0 = load8(ROW(Vp, k0, sr)); S.st_v1 = load8(ROW(Vp, k0, 32 + sr));              \
                         S.st_k0 = load8(ROW(Kp, k0, sr)); S.st_k1 = load8(ROW(Kp, k0, 32 + sr)); } while (0)
#define SWRITE_HK(bf) do { *(bf16x8*)(K_lds + (bf) * SHM_K + kws) = S.st_k0; *(bf16x8*)(K_lds + (bf) * SHM_K + kws + 32 * 256) = S.st_k1; } while (0)
#define SWRITE_HV(bf) do { *(bf16x8*)(V_lds + (bf) * SHM_V + vst0) = S.st_v0; *(bf16x8*)(V_lds + (bf) * SHM_V + vst1) = S.st_v1; } while (0)
#define SWRITE_H(bf) do { SWRITE_HV(bf); SWRITE_HK(bf); } while (0)
__device__ __forceinline__ void sel_prime(const BlockRef& cur, char* lds, Seam& S) {
    int tid_ = threadIdx.x; asm volatile("" : "+v"(tid_));
    const int tid = tid_, wid = __builtin_amdgcn_readfirstlane(tid >> 6), lane = tid & 63, r32 = lane & 31, hi = lane >> 5;
    const int sr = tid >> 4, sc = (tid & 15) * 8, kws = KSWZ(sr, sc * 2); char* K_lds = lds + 2 * SHM_V;
    for (int d0 = 0; d0 < 8; ++d0) S.qr[d0] = load8(cur.Q + (size_t)(wid * QBLK + r32) * D + d0 * 16 + hi * 8);
    SLOAD_H(cur.K, cur.V, 0); VMW(); SWRITE_HK(0);
    __syncthreads();
}
__device__ __forceinline__ void sel_block(const BlockRef& cur, const BlockRef& nxt, char* lds, Seam& S) {
    int tid_ = threadIdx.x; asm volatile("" : "+v"(tid_));
    const int tid = tid_, wid = __builtin_amdgcn_readfirstlane(tid >> 6), lane = tid & 63, r32 = lane & 31, hi = lane >> 5;
    const int NT = (cur.P0 + QB) / KVBLK;
    char* V_lds = lds; char* K_lds = lds + 2 * SHM_V;
    float* ws = (float*)(lds + 2 * SHM_V + 2 * SHM_K) + wid * 64; float* li_l = ws, * al_l = ws + 32;
    float m_reg = -1e30f, l_reg = 0; f32x16 o[4] = {};
    const int sr = tid >> 4, sc = (tid & 15) * 8, vst0 = v_st(sr, sc), vst1 = v_st(32 + sr, sc), kws = KSWZ(sr, sc * 2);
    const int vb0 = (int)(uintptr_t)V_lds + v_rd_base(lane);
    const bf16* Kh = cur.K; const bf16* Vh = cur.V;
    const char* Mbase = (const char*)cur.M; const unsigned moff = (unsigned)(wid * QBLK + r32) * 512u;
#define MROW(t) (*(const u32x2*)(Mbase + (moff + (unsigned)(t) * 8u)))
#define RESC(a) do { if (__any((a) < 1.f)) { if (hi == 0) al_l[r32] = (a); asm volatile("s_waitcnt lgkmcnt(0)" ::: "memory");              \
                     for (int d_ = 0; d_ < 4; ++d_) for (int r = 0; r < 16; ++r) o[d_][r] *= al_l[crow(r, hi)]; } } while (0)
#define KBASE(t) ((t) * KVBLK)
    f32x16 pA0, pA1, pB0, pB1; float mnA, mnB, alA, alB; bf16x8 pa0, pa1, pa2, pa3; u32x2 mw;
    SWRITE_HV(0); SBAR();
    if (NT > 1) SLOAD_H(Kh, Vh, KBASE(1));
    mw = MROW(0);
    SBAR(); qkt<0, false>(pA0, pA1, K_lds, r32, hi, S.qr, true);
    mask_bits(pA0, pA1, mw, hi); partialSM(pA0, pA1, m_reg, mnA, alA);
    if (NT > 1) { VMW(); SWRITE_H(1); }
    __syncthreads();
#define HALF_STEP(PX0, PX1, mnX, alX, PY0, PY1, alY, t, KB, VB, SB) do {                                                      \
        SBAR(); mw = MROW(t); qkt<KB, false>(PX0, PX1, K_lds, r32, hi, S.qr, true);                                          \
        finishSM(PY0, PY1, alY, l_reg, pa0, pa1, pa2, pa3); SBAR();                                                           \
        if ((t) + 1 < NT) { SLOAD_H(Kh, Vh, KBASE((t) + 1)); SBAR(); }                                                        \
        pv_tile<VB, false>(o, vb0, pa0, pa1, pa2, pa3, true); mask_bits(PX0, PX1, mw, hi); partialSM(PX0, PX1, m_reg, mnX, alX); \
        __syncthreads();                                                                                                      \
        if ((t) + 1 < NT) { VMW(); SWRITE_H(SB); }                                                                            \
        RESC(alX); __syncthreads(); } while (0)
    for (int t = 1; t + 1 < NT; t += 2) {
        HALF_STEP(pB0, pB1, mnB, alB, pA0, pA1, alA, t, 1, 0, 0);
        HALF_STEP(pA0, pA1, mnA, alA, pB0, pB1, alB, t + 1, 0, 1, 1);
    }
    const bool even = (NT & 1) == 0;
    if (even) { SBAR(); mw = MROW(NT - 1); qkt<1, false>(pB0, pB1, K_lds, r32, hi, S.qr, true); SBAR(); }
    SLOAD_H(nxt.K, nxt.V, 0); SBAR();
#pragma unroll
    for (int d0 = 0; d0 < 8; ++d0) S.qr[d0] = load8(nxt.Q + (size_t)(wid * QBLK + r32) * D + d0 * 16 + hi * 8);
    SBAR();
    finishSM(pA0, pA1, alA, l_reg, pa0, pa1, pa2, pa3); SBAR();
    pv_tile<0, false>(o, vb0, pa0, pa1, pa2, pa3, true);
    if (even) { mask_bits(pB0, pB1, mw, hi); partialSM(pB0, pB1, m_reg, mnB, alB); __syncthreads(); RESC(alB);
        finishSM(pB0, pB1, alB, l_reg, pa0, pa1, pa2, pa3); SBAR(); pv_tile<1, false>(o, vb0, pa0, pa1, pa2, pa3, true); }
    SBAR(); VMWN(8); SWRITE_HK(0); SBAR();
    if (hi == 0) li_l[r32] = l_reg; asm volatile("s_waitcnt lgkmcnt(0)" ::: "memory");
    float rli[16];
#pragma unroll
    for (int r = 0; r < 16; ++r) rli[r] = __builtin_amdgcn_rcpf(li_l[crow(r, hi)]);
    bf16* Ow = cur.O + (size_t)(wid * QBLK) * OS;
#pragma unroll
    for (int r = 0; r < 16; ++r) { const int orow = crow(r, hi);
#pragma unroll
        for (int d0 = 0; d0 < 4; ++d0) { const float v = o[d0][r] * rli[r];
            const float vn = __shfl_xor(v, 1);
            if ((r32 & 1) == 0) *(unsigned*)(Ow + (size_t)orow * OS + d0 * 32 + r32) = cvtpk(v, vn); } }
    __syncthreads();
#undef RESC
#undef KBASE
#undef HALF_STEP
#undef MROW
}
#undef ROW
#undef VMW
#undef VMWN
#undef SLOAD_H
#undef SWRITE_HK
#undef SWRITE_HV
#undef SWRITE_H
#undef KSWZ
#undef SBAR
}


__device__ __forceinline__ attn::BlockRef attn_ref(ARGREF a, int b, int h, int qb) {
    attn::BlockRef r; const int kvh = h / 3;
    r.Q = (const attn::bf16*)(a.ws + WS_QB) + ((size_t)(b * 6 + h) * SEQ + (size_t)qb * 256) * 128;
    r.K = (const attn::bf16*)(a.ws + WS_KB) + (size_t)(b * 2 + kvh) * SEQ * 128;
    r.V = (const attn::bf16*)(a.ws + WS_VB) + (size_t)(b * 2 + kvh) * SEQ * 128;
    r.O = (attn::bf16*)(a.ws + WS_MIX) + (size_t)(b * SEQ + qb * 256) * DM + h * 128;
    r.M = (const attn::u32x2*)(a.ws + WS_MASK) + (size_t)(b * SEQ + qb * 256) * 64;
    r.P0 = qb * 256; return r;
}
__device__ __forceinline__ void p11_attention(Ctx& c, ARGREF a) {
    constexpr int NITEM = 192;
#pragma unroll 1
    for (int it = c.vcu; it < NITEM; it += c.G) {
        const int p = it & 7, bh = it >> 3, b = bh / 6, h = bh % 6;
        attn::Seam S;
        attn::BlockRef cur = attn_ref(a, b, h, p), nxt = attn_ref(a, b, h, 15 - p);
        __syncthreads();
        attn::sel_prime(cur, (char*)c.lds, S);
        attn::sel_block(cur, nxt, (char*)c.lds, S);
        attn::sel_block(nxt, nxt, (char*)c.lds, S);
    }
    const int spare = c.G - NITEM;
    if (spare > 0) { if (c.vcu >= NITEM) for (int u = c.vcu - NITEM; u < MS; u += spare) attn_sample_unit(c, a, u >> 2, u & 3); }
    else for (int u = c.vcu; u < MS; u += c.G) attn_sample_unit(c, a, u >> 2, u & 3);
}

enum { PH_PRO = 0, PH_IN0, PH_MIX0, PH_HSCAN, PH_HFIX, PH_OUT0, PH_GU0, PH_DOWN0, PH_IN1, PH_POST, PH_IDX, PH_TOPK, PH_ATTN, PH_OUT1, PH_GU1, PH_DOWN1, NPHASE };
#ifndef ONLYPH
#define ONLYPH -1
#endif
#define PHON(x) (ONLYPH < 0 || ONLYPH == (x))
#ifndef REP_PH
#define REP_PH -1
#endif
#ifndef REP_N
#define REP_N 1
#endif
__global__ void __launch_bounds__(NWAVES * 64, 2) fwd_kernel(Args args) {
    extern __shared__ __attribute__((aligned(16))) unsigned char lds[];
    Ctx c;
    c.lds = (LAS unsigned char*)lds;
    c.MISC = (volatile LAS unsigned*)(c.lds + MISC_OFF);
    c.tid = threadIdx.x; c.lane = c.tid & 63; c.wave = __builtin_amdgcn_readfirstlane(c.tid >> 6);
    c.G = gridDim.x; { const int bx = blockIdx.x; c.vcu = (c.G % 8 == 0) ? (bx % 8) * (c.G / 8) + bx / 8 : bx; }
    c.ctl = (gu32*)(args.ws + WS_CTL);
    for (int u = c.tid; u < (LDS_BYTES - LDSCTL_OFF) / 4; u += NWAVES * 64) ((LAS unsigned*)(c.lds + LDSCTL_OFF))[u] = 0u;
    __syncthreads();
    const int lo = args.ph_lo, hi = args.ph_hi;
    XcdBarrier bar; bar.bar = (unsigned*)(c.ctl + CW_BAR); bar.x = 0; bar.st = nullptr;
    if (hi - lo > 1 || REP_N > 1) bar = xcd_barrier_post((unsigned*)(c.ctl + CW_BAR), c.MISC + 8);
    c.qoff = 0;
#pragma unroll 1
    for (int ph = lo; ph < hi; ++ph) {
        const int layer = ph >= PH_IN1 ? 1 : 0;
        const __attribute__((address_space(4))) Args* ap = (const __attribute__((address_space(4))) Args*)__builtin_amdgcn_kernarg_segment_ptr(); asm volatile("" : "+s"(ap));
        ARGREF la = *ap; unsigned char* const ws = la.ws; float* const out = la.out;
        { int t_ = threadIdx.x; asm volatile("" : "+v"(t_)); c.tid = t_; c.lane = t_ & 63; c.wave = __builtin_amdgcn_readfirstlane(t_ >> 6); }
        if ((ph == PH_DOWN0 || ph == PH_DOWN1) && PHON(PH_OUT0)) {
            pg8::SchedX S0; S0.init(MP, 1024, c.G, (int)blockIdx.x, 0, 0, 1, 0); pg8::Unit u0; if (S0.next(0, u0)) conv_fixup_tile(c, la, layer, u0.pm); VM_WAIT(); __syncthreads(); }
        if (ph == PH_PRO && PHON(PH_PRO)) p0_prologue(c, la);
        else if ((ph == PH_IN0 || ph == PH_IN1) && PHON(PH_IN0)) {
            pg8::Gemm g{(const pg8::bf16_t*)(ws + WS_XB), (const pg8::bf16_t*)(ws + (ph == PH_IN0 ? WS_WIN0 : WS_WIN1)), MT, 0, 1024};
            pg8::SchedX S; if (ph == PH_IN0) S.init(MP, ZC0, c.G, (int)blockIdx.x, 16, MT / 256, 4, 13); else S.init(MP, ZC1, c.G, (int)blockIdx.x, 0, 0, 1, 0);
            pg8::EpiZ E{(pg8::bf16_t*)(ws + WS_Z), ph == PH_IN0 ? ZC0 : ZC1, ssptr(c, ph == PH_IN0 ? 0 : 2), ph == PH_IN0 ? 13 : 9, (float*)(ws + WS_MEMKV), MEMROW0};
            pg8::gemm_phase<pg8::EpiZ, pg8::SchedX, PG8_ALIGN, PG8_SP2>(c.lds + RING_OFF, g, S, E);
            { SgArgs sg{}; sg.A = (const bf16*)(ws + WS_XB) + (size_t)MP * DM; sg.Bt = (const bf16*)(ws + (ph == PH_IN0 ? WS_WIN0 : WS_WIN1)); sg.K = 1024; sg.mode = 0; sg.Z = (bf16*)(ws + WS_Z); sg.ldz = ph == PH_IN0 ? ZC0 : ZC1; sg.ssin = ssptr(c, ph == PH_IN0 ? 0 : 2);
              sgemm_phase(c, sg, ph == PH_IN0 ? ZC0 : ZC1); }
            if (ph == PH_IN0) { __syncthreads(); convert_layer1_tail(c, la, (64 * 13 + 16) % c.G); }
        }
        else if (ph == PH_MIX0 && PHON(PH_MIX0)) p2_mixer0(c, la);
        else if (ph == PH_HSCAN && PHON(PH_HSCAN)) hgrn_scan(c, la);
        else if (ph == PH_HFIX && PHON(PH_HFIX)) p2c_hgrn_fix(c, la);
        else if ((ph == PH_OUT0 || ph == PH_DOWN0 || ph == PH_OUT1 || ph == PH_DOWN1) && PHON(PH_OUT0)) {
            const bool isout = (ph == PH_OUT0 || ph == PH_OUT1);
            pg8::Gemm g{(const pg8::bf16_t*)(ws + (isout ? WS_MIX : WS_ACT)), (const pg8::bf16_t*)(ws + (isout ? WS_WOUT + (size_t)layer * 1024 * 1024 * 2 : WS_WD + (size_t)layer * 1024 * DFF * 2)), MT, 1024, isout ? 1024 : DFF};
            pg8::SchedX S; S.init(MP, 1024, c.G, (int)blockIdx.x, 0, 0, 1, 0);
            pg8::EpiResid E;
            E.rp = ph == PH_OUT0 ? la.in[0] : nullptr; E.rb = (const pg8::bf16_t*)(ws + WS_XB); E.y = ph == PH_DOWN1 ? out + O_YP : nullptr;
            E.xb = ph == PH_DOWN1 ? nullptr : (pg8::bf16_t*)(ws + WS_XB); E.ssout = ph == PH_DOWN1 ? nullptr : ssptr(c, ph == PH_OUT0 ? 1 : (ph == PH_DOWN0 ? 2 : 3));
            pg8::gemm_phase<pg8::EpiResid, pg8::SchedX, PG8_ALIGN, PG8_SP2>(c.lds + RING_OFF, g, S, E);
            { SgArgs sg{}; sg.A = (const bf16*)(ws + (isout ? WS_MIX : WS_ACT)) + (size_t)MP * (isout ? 1024 : DFF); sg.Bt = (const bf16*)g.Bt; sg.K = isout ? 1024 : DFF; sg.mode = 1; sg.rb = (const bf16*)(ws + WS_XB); sg.resid = ph == PH_OUT0 ? la.in[1] : nullptr; sg.y = ph == PH_DOWN1 ? out + O_YS : nullptr; sg.xb = (bf16*)E.xb; sg.ssout = E.ssout;
              sgemm_phase(c, sg, 1024); }
        }
        else if ((ph == PH_GU0 || ph == PH_GU1) && PHON(PH_GU0)) {
            pg8::Gemm g{(const pg8::bf16_t*)(ws + WS_XB), (const pg8::bf16_t*)(ws + WS_WGU + (size_t)layer * 5632 * 1024 * 2), MT, 5632, 1024};
            pg8::SchedX S; S.init(MP, 5632, c.G, (int)blockIdx.x, 0, 0, 1, 0);
            pg8::EpiGU E{(pg8::bf16_t*)(ws + WS_ACT), ssptr(c, layer ? 3 : 1), out + O_CVP + (size_t)layer * 4 * 2 * DFF, la.in[26] + (size_t)layer * 3 * DFF, la.in[27] + (size_t)layer * DFF, (float*)(ws + WS_G4), (float*)(ws + WS_UP2)};
            pg8::gemm_phase<pg8::EpiGU, pg8::SchedX, PG8_ALIGN, PG8_SP2>(c.lds + RING_OFF, g, S, E);
            { SgArgs sg{}; sg.A = (const bf16*)(ws + WS_XB) + (size_t)MP * DM; sg.Bt = (const bf16*)g.Bt; sg.K = 1024; sg.mode = 2; sg.ssin = E.ss; sg.ACT = (bf16*)E.ACT; sg.cvs = out + O_CVS + (size_t)layer * 32 * 2 * DFF; sg.cst = la.in[8] + (size_t)layer * 32 * 2 * DFF; sg.cw = E.cw; sg.cb = E.cb;
              sgemm_phase(c, sg, 5632); }
        }
        else if (ph == PH_POST && PHON(PH_POST)) p8_dsa_post(c, la);
        else if (ph == PH_IDX && PHON(PH_IDX)) p9_indexer(c, la);
        else if (ph == PH_TOPK && PHON(PH_TOPK)) p10_topk(c, la);
        else if (ph == PH_ATTN && PHON(PH_ATTN)) p11_attention(c, la);
        if (REP_N > 1 && ph == REP_PH && c.qoff < 4 * (REP_N - 1)) { c.qoff += 4; --ph; xcd_barrier(bar); continue; }
        if (REP_N > 1) c.qoff = 0;
        if (ph + 1 < hi) xcd_barrier(bar);
    }
}

#ifndef MK_ONE_LAUNCH
#define MK_ONE_LAUNCH 1
#endif
extern "C" void kernel_launch(void* const* d_in, const int* in_sizes, int n_in, void* d_out, int out_size, void* d_ws, size_t ws_size, hipStream_t stream) {
    static int grid = 0;
    if (grid == 0) {
        if (n_in != 29 || out_size != (int)O_END || ws_size < WS_END) { fprintf(stderr, "kernel_launch: unexpected problem (n_in %d, out %d, ws %zu)\n", n_in, out_size, ws_size); grid = -1; return; }
        int dev = 0, cus = 0;
        if (hipGetDevice(&dev) != hipSuccess || hipDeviceGetAttribute(&cus, hipDeviceAttributeMultiprocessorCount, dev) != hipSuccess) { grid = -1; return; }
        if (hipFuncSetAttribute((const void*)fwd_kernel, hipFuncAttributeMaxDynamicSharedMemorySize, LDS_BYTES) != hipSuccess) { fprintf(stderr, "kernel_launch: hipFuncSetAttribute failed\n"); grid = -1; return; }
        (void)hipGetLastError();
        grid = cus;
    }
    if (grid < 0) return;
    if (hipMemsetAsync((char*)d_ws + WS_CTL, 0, CTL_ZERO_BYTES, stream) != hipSuccess) { fprintf(stderr, "kernel_launch: memset failed\n"); return; }
    Args a{};
    for (int i = 0; i < 29; ++i) a.in[i] = (const float*)d_in[i];
    a.page_table = (const int*)d_in[9]; a.out = (float*)d_out; a.ws = (unsigned char*)d_ws;
#if MK_ONE_LAUNCH
    a.ph_lo = 0; a.ph_hi = NPHASE;
    hipLaunchKernelGGL(fwd_kernel, dim3(grid), dim3(NWAVES * 64), LDS_BYTES, stream, a);
#else
    for (int ph = 0; ph < NPHASE; ++ph) { a.ph_lo = ph; a.ph_hi = ph + 1; hipLaunchKernelGGL(fwd_kernel, dim3(grid), dim3(NWAVES * 64), LDS_BYTES, stream, a); }
#endif
}
```

```cpp
#include <hip/hip_runtime.h>
#include <cstdio>
#include <cstdint>


namespace pg8 {
#define PG8_LAS __attribute__((address_space(3)))
typedef unsigned short bf16_t;
typedef short bf16x8 __attribute__((ext_vector_type(8)));
typedef float f32x4 __attribute__((ext_vector_type(4)));
typedef unsigned u32x4 __attribute__((ext_vector_type(4)));
constexpr int BM = 256, BK = 64, HALF = 128, HTB = HALF * BK * 2  , STAGE_BYTES = 8 * HTB, NXCD = 8, WGM = 8;

__host__ __device__ __forceinline__ int lds_byte(int r, int c) { const int st = (r >> 4) * 2 + (c >> 5), rr = r & 15, cc = c & 31, ob = rr * 64 + cc * 2; return st * 1024 + (ob ^ (((ob >> 9) & 1) << 5)); }
__host__ __device__ __forceinline__ void stage_rc(int b, int& R, int& C) { const int st = b / 1024, sb = b % 1024, swz = sb ^ (((sb >> 9) & 1) << 5); R = (st >> 1) * 16 + swz / 64; C = (st & 1) * 32 + (swz % 64) / 2; }
__host__ __device__ __forceinline__ int perm32(int rho) { const int n = rho >> 4, i = rho & 15; return 8 * (i >> 2) + 4 * n + (i & 3); }

struct Unit { int pm, pn; };
struct Gemm { const bf16_t* A; const bf16_t* Bt; int M, N, K; };

struct StaticOrder {
    int nM, nN, nwg, G, c;
    __host__ __device__ __forceinline__ void init(int M, int N, int G_, int c_) { nM = M / BM; nN = N / BM; nwg = nM * nN; G = G_; c = c_; }
    __host__ __device__ __forceinline__ bool next(int i, Unit& u) const {
        const long L = (long)i * G + c; if (L >= nwg) return false;
        int wgid = (int)L; { const int q = nwg / NXCD, r = nwg % NXCD, xcd = wgid % NXCD, off = wgid / NXCD; wgid = (xcd < r ? xcd * (q + 1) : r * (q + 1) + (xcd - r) * q) + off; }
        const int nig = WGM * nN, gid = wgid / nig, fm = gid * WGM, gsz = (nM - fm) < WGM ? (nM - fm) : WGM;
        u.pm = fm + ((wgid % nig) % gsz); u.pn = (wgid % nig) / gsz; return true;
    }
    __device__ __forceinline__ void a_ready(const Unit&) const {}
    __device__ __forceinline__ void done(const Unit&) const {}
};


constexpr int MP = 16384, MS = 128, MVALID = MP + MS, MT = 16640, DM = 1024, DFF = 2816;
constexpr float RMS_EPS = 1e-6f;
__device__ __forceinline__ unsigned cvt_pk_bf16(float lo, float hi) { unsigned r; asm volatile("v_cvt_pk_bf16_f32 %0, %1, %2" : "=v"(r) : "v"(lo), "v"(hi)); return r; }

struct SchedX {
    StaticOrder so; int nextra, e_pm0, e_nm, e_pn0;
    __device__ __forceinline__ void init(int M, int N, int G_, int c_, int nextra_, int e_pm0_, int e_nm_, int e_pn0_) { so.init(M, N, G_, c_); nextra = nextra_; e_pm0 = e_pm0_; e_nm = e_nm_; e_pn0 = e_pn0_; }
    __device__ __forceinline__ bool next(int i, Unit& u) const {
        const long L = (long)i * so.G + so.c;
        if (L < so.nwg) return so.next(i, u);
        const int e = (int)(L - so.nwg); if (e >= nextra) return false;
        u.pm = e_pm0 + e % e_nm; u.pn = e_pn0 + e / e_nm; return true;
    }
    __device__ __forceinline__ void a_ready(const Unit&) const {}
    __device__ __forceinline__ void done(const Unit&) const {}
};

struct EpiZ {
    static constexpr bool PERM = true, AFTER_DRAIN = false;
    bf16_t* Z; int ldz; const float* ss; int nmain; float* memkv; int memrow0;
    __device__ __forceinline__ void operator()(const f32x4 (&acc)[2][2][4][2], const Unit& u, int wr, int wc, int fr, int fq) const {
        const int row0 = u.pm * BM + wr * 64 + fr;
        if (u.pn < nmain) {
            const int col0 = u.pn * BM + wc * 32 + 8 * fq;
#pragma unroll
            for (int ai = 0; ai < 2; ++ai)
#pragma unroll
                for (int m = 0; m < 4; ++m) { const int row = row0 + ai * HALF + m * 16; const float rs = rsqrtf(ss[row] * (1.0f / DM) + RMS_EPS);
#pragma unroll
                    for (int bj = 0; bj < 2; ++bj) { const f32x4 v0 = acc[ai][bj][m][0] * rs, v1 = acc[ai][bj][m][1] * rs;
                        u32x4 w; w.x = cvt_pk_bf16(v0[0], v0[1]); w.y = cvt_pk_bf16(v0[2], v0[3]); w.z = cvt_pk_bf16(v1[0], v1[1]); w.w = cvt_pk_bf16(v1[2], v1[3]);
                        *(u32x4*)(Z + (size_t)row * ldz + col0 + bj * HALF) = w; } }
        } else {
            const int col0 = (u.pn - nmain) * BM + wc * 32 + 8 * fq;
#pragma unroll
            for (int ai = 0; ai < 2; ++ai)
#pragma unroll
                for (int m = 0; m < 4; ++m) { const int row = row0 + ai * HALF + m * 16 - memrow0;
#pragma unroll
                    for (int bj = 0; bj < 2; ++bj) { float* p = memkv + (size_t)row * 1024 + col0 + bj * HALF; *(f32x4*)p = acc[ai][bj][m][0]; *(f32x4*)(p + 4) = acc[ai][bj][m][1]; } }
        }
    }
};

struct EpiResid {
    static constexpr bool PERM = true, AFTER_DRAIN = false;
    const float* rp; const bf16_t* rb; float* y; bf16_t* xb; float* ssout;
    __device__ __forceinline__ void operator()(const f32x4 (&acc)[2][2][4][2], const Unit& u, int wr, int wc, int fr, int fq) const {
        const int row0 = u.pm * BM + wr * 64 + fr, col0 = u.pn * BM + wc * 32 + 8 * fq;
#pragma unroll
        for (int ai = 0; ai < 2; ++ai)
#pragma unroll
            for (int m = 0; m < 4; ++m) { const int row = row0 + ai * HALF + m * 16; float part = 0.f;
#pragma unroll
                for (int bj = 0; bj < 2; ++bj) { const int c = col0 + bj * HALF; f32x4 r0, r1;
                    if (rp) { r0 = *(const f32x4*)(rp + (size_t)row * DM + c); r1 = *(const f32x4*)(rp + (size_t)row * DM + c + 4); }
                    else { const u32x4 q = *(const u32x4*)(rb + (size_t)row * DM + c);
                        r0 = (f32x4){__builtin_bit_cast(float, q.x << 16), __builtin_bit_cast(float, q.x & 0xffff0000u), __builtin_bit_cast(float, q.y << 16), __builtin_bit_cast(float, q.y & 0xffff0000u)};
                        r1 = (f32x4){__builtin_bit_cast(float, q.z << 16), __builtin_bit_cast(float, q.z & 0xffff0000u), __builtin_bit_cast(float, q.w << 16), __builtin_bit_cast(float, q.w & 0xffff0000u)}; }
                    const f32x4 v0 = acc[ai][bj][m][0] + r0, v1 = acc[ai][bj][m][1] + r1;
                    if (y) { *(f32x4*)(y + (size_t)row * DM + c) = v0; *(f32x4*)(y + (size_t)row * DM + c + 4) = v1; }
                    part += (v0[0] * v0[0] + v0[1] * v0[1]) + (v0[2] * v0[2] + v0[3] * v0[3]) + (v1[0] * v1[0] + v1[1] * v1[1]) + (v1[2] * v1[2] + v1[3] * v1[3]);
                    if (xb) { u32x4 w; w.x = cvt_pk_bf16(v0[0], v0[1]); w.y = cvt_pk_bf16(v0[2], v0[3]); w.z = cvt_pk_bf16(v1[0], v1[1]); w.w = cvt_pk_bf16(v1[2], v1[3]);
                        *(u32x4*)(xb + (size_t)row * DM + c) = w; } }
                part += __shfl_xor(part, 16); part += __shfl_xor(part, 32);
                if (ssout && fq == 0) atomicAdd(ssout + row, part); }
    }
};

__device__ __forceinline__ void dpp_ror12(const f32x4& v, f32x4& r1, f32x4& r2) {
    float a0, a1, a2, a3, b0, b1, b2, b3;
    asm volatile("s_nop 1\n\t"
                 "v_mov_b32_dpp %0, %8 row_ror:1 row_mask:0xf bank_mask:0xf\n\tv_mov_b32_dpp %1, %9 row_ror:1 row_mask:0xf bank_mask:0xf\n\t"
                 "v_mov_b32_dpp %2, %10 row_ror:1 row_mask:0xf bank_mask:0xf\n\tv_mov_b32_dpp %3, %11 row_ror:1 row_mask:0xf bank_mask:0xf\n\t"
                 "v_mov_b32_dpp %4, %8 row_ror:2 row_mask:0xf bank_mask:0xf\n\tv_mov_b32_dpp %5, %9 row_ror:2 row_mask:0xf bank_mask:0xf\n\t"
                 "v_mov_b32_dpp %6, %10 row_ror:2 row_mask:0xf bank_mask:0xf\n\tv_mov_b32_dpp %7, %11 row_ror:2 row_mask:0xf bank_mask:0xf"
                 : "=&v"(a0), "=&v"(a1), "=&v"(a2), "=&v"(a3), "=&v"(b0), "=&v"(b1), "=&v"(b2), "=&v"(b3) : "v"(v[0]), "v"(v[1]), "v"(v[2]), "v"(v[3]));
    r1 = (f32x4){a0, a1, a2, a3}; r2 = (f32x4){b0, b1, b2, b3};
}
struct EpiGU {
    static constexpr bool PERM = true, AFTER_DRAIN = false;
    bf16_t* ACT; const float* ss; float* cvp; const float* cw; const float* cb; float* G4; float* UP2;
    __device__ __forceinline__ void operator()(const f32x4 (&acc)[2][2][4][2], const Unit& u, int wr, int wc, int fr, int fq) const {
        const int row0 = u.pm * BM + wr * 64 + fr, colg = u.pn * HALF + wc * 32 + 8 * fq;
#pragma unroll
        for (int n = 0; n < 2; ++n) { const int col = colg + 4 * n;
            const f32x4 w0 = *(const f32x4*)(cw + col), w1 = *(const f32x4*)(cw + DFF + col), w2 = *(const f32x4*)(cw + 2 * DFF + col), bb = *(const f32x4*)(cb + col);
#pragma unroll
            for (int ai = 0; ai < 2; ++ai) { f32x4 r1p = {0.f, 0.f, 0.f, 0.f}, r2p = r1p; const int slab = (u.pm * BM + ai * HALF + wr * 64) >> 6;
#pragma unroll
                for (int m = 0; m < 4; ++m) { const int row = row0 + ai * HALF + m * 16; const float rs = rsqrtf(ss[row] * (1.0f / DM) + RMS_EPS);
                    const f32x4 g = acc[ai][0][m][n] * rs, up = acc[ai][1][m][n] * rs;
                    f32x4 r1, r2; dpp_ror12(g, r1, r2);
                    const f32x4 p1 = fr >= 1 ? r1 : r1p, p2 = fr >= 2 ? r2 : r2p;
                    f32x4 cv = bb + w0 * p2 + w1 * p1 + w2 * g, y;
#pragma unroll
                    for (int i = 0; i < 4; ++i) y[i] = cv[i] * __builtin_amdgcn_rcpf(1.0f + __expf(-cv[i])) * up[i];
                    if (m == 0 && fr < 2) { *(f32x4*)(G4 + (size_t)(slab * 4 + fr) * DFF + col) = g; *(f32x4*)(UP2 + (size_t)(slab * 2 + fr) * DFF + col) = up; }
                    else { typedef unsigned u32x2 __attribute__((ext_vector_type(2))); u32x2 w; w.x = cvt_pk_bf16(y[0], y[1]); w.y = cvt_pk_bf16(y[2], y[3]); *(u32x2*)(ACT + (size_t)row * DFF + col) = w; }
                    if (m == 3 && fr >= 14) { *(f32x4*)(G4 + (size_t)(slab * 4 + 2 + (fr - 14)) * DFF + col) = g;
                        const int t = row & 4095; if (t >= 4094) *(f32x4*)(cvp + (size_t)((row >> 12) * 2 + (t - 4094)) * DFF + col) = g; }
                    r1p = r1; r2p = r2; } } }
    }
};

template <class Epi, class Sched, bool ALIGN_EPI = false, bool SP2 = false>
__device__ __forceinline__ void gemm_phase(PG8_LAS unsigned char* lds, const Gemm g, const Sched& S, const Epi& E) {
    int tid_ = threadIdx.x; asm volatile("" : "+v"(tid_));
    const int tid = tid_, wid = __builtin_amdgcn_readfirstlane(tid >> 6), lane = tid & 63, wr = wid >> 2, wc = wid & 3, fr = lane & 15, fq = lane >> 4;
    const int K = g.K, nt = K / BK;
    unsigned voffA[2], voffB[2];
#pragma unroll
    for (int i = 0; i < 2; ++i) { int R, C; stage_rc(tid * 16 + i * 8192, R, C); const int Rb = Epi::PERM ? ((R & ~31) + perm32(R & 31)) : R;
        voffA[i] = (unsigned)(R * K + C) * 2u; voffB[i] = (unsigned)(Rb * K + C) * 2u; }
    const size_t kstep = (size_t)(BK * 2);
    const size_t hstep = (size_t)HALF * K * 2;
    const size_t tstep = 2 * hstep;
    const unsigned ldsw = (unsigned)wid * 1024u;
    const int aoff = lds_byte(wr * 64 + fr, fq * 8), boff = lds_byte(wc * 32 + fr, fq * 8);
#define PG8_SA(b, h) (((b) * 2 + (h)) * HTB)
#define PG8_SB(b, h) ((4 + (b) * 2 + (h)) * HTB)
#define PG8_STAGE(bufoff, gbase, voff) do { _Pragma("unroll") for (int _i = 0; _i < 2; ++_i) \
        __builtin_amdgcn_global_load_lds((const unsigned*)((const char*)(gbase) + (voff)[_i]), (PG8_LAS unsigned*)(lds + (bufoff) + ldsw + _i * 8192), 16, 0, 0); } while (0)
#define PG8_LDA(dst, b, h) do { _Pragma("unroll") for (int m = 0; m < 4; ++m) _Pragma("unroll") for (int k = 0; k < 2; ++k) dst[m][k] = *(const PG8_LAS bf16x8*)(lds + PG8_SA(b, h) + aoff + m * 2048 + k * 1024); } while (0)
#define PG8_LDB(dst, b, h) do { _Pragma("unroll") for (int n = 0; n < 2; ++n) _Pragma("unroll") for (int k = 0; k < 2; ++k) dst[n][k] = *(const PG8_LAS bf16x8*)(lds + PG8_SB(b, h) + boff + n * 2048 + k * 1024); } while (0)
#define PG8_MMA(ai, bj, At, Bt) do { __builtin_amdgcn_s_setprio(1); _Pragma("unroll") for (int m = 0; m < 4; ++m) _Pragma("unroll") for (int n = 0; n < 2; ++n) _Pragma("unroll") for (int k = 0; k < 2; ++k) \
        acc[ai][bj][m][n] = __builtin_amdgcn_mfma_f32_16x16x32_bf16(Bt[n][k], At[m][k], acc[ai][bj][m][n], 0, 0, 0); __builtin_amdgcn_s_setprio(0); } while (0)
#define PG8_WAIT_V(n) asm volatile("s_waitcnt vmcnt(" #n ")" ::: "memory")
#define PG8_WAIT_L(n) asm volatile("s_waitcnt lgkmcnt(" #n ")" ::: "memory")
#define PG8_BAR __builtin_amdgcn_s_barrier()
#define PG8_SCHED __builtin_amdgcn_sched_barrier(0)
    Unit cur, nxt; int ui = 0;
    if (!S.next(0, cur)) return;
    f32x4 acc[2][2][4][2];
#pragma unroll
    for (int a = 0; a < 2; ++a)
#pragma unroll
        for (int b = 0; b < 2; ++b)
#pragma unroll
            for (int m = 0; m < 4; ++m)
#pragma unroll
                for (int n = 0; n < 2; ++n) acc[a][b][m][n] = (f32x4){0.f, 0.f, 0.f, 0.f};
    bf16x8 At[4][2], B0[2][2], B1[2][2];
    const char* cA = (const char*)g.A + (size_t)cur.pm * tstep; const char* cB = (const char*)g.Bt + (size_t)cur.pn * tstep;
    S.a_ready(cur);
    if constexpr (SP2) {
        PG8_STAGE(PG8_SB(0, 0), cB, voffB); PG8_STAGE(PG8_SB(0, 1), cB + hstep, voffB); PG8_STAGE(PG8_SA(0, 0), cA, voffA); PG8_STAGE(PG8_SA(0, 1), cA + hstep, voffA);
        if (wr == 1) PG8_BAR;
        PG8_WAIT_V(2); PG8_BAR;
        PG8_STAGE(PG8_SB(1, 0), cB + kstep, voffB); PG8_STAGE(PG8_SA(1, 0), cA + kstep, voffA); PG8_STAGE(PG8_SB(1, 1), cB + hstep + kstep, voffB);
        PG8_WAIT_V(6); PG8_BAR;
    } else {
        PG8_STAGE(PG8_SB(0, 0), cB, voffB); PG8_STAGE(PG8_SA(0, 0), cA, voffA); PG8_STAGE(PG8_SB(0, 1), cB + hstep, voffB); PG8_STAGE(PG8_SA(0, 1), cA + hstep, voffA);
        if (wr == 1) PG8_BAR;
        PG8_WAIT_V(4); PG8_BAR;
        PG8_STAGE(PG8_SB(1, 0), cB + kstep, voffB); PG8_STAGE(PG8_SA(1, 0), cA + kstep, voffA); PG8_STAGE(PG8_SB(1, 1), cB + hstep + kstep, voffB);
        PG8_WAIT_V(6); PG8_BAR;
    }
    for (;;) {
        const bool has_next = S.next(ui + 1, nxt);
        const char* nA = has_next ? (const char*)g.A + (size_t)nxt.pm * tstep : cA; const char* nB = has_next ? (const char*)g.Bt + (size_t)nxt.pn * tstep : cB;
        for (int t = 0; t < nt; t += 2) {
            const bool last = (t == nt - 2);
            const char* a1 = cA + (size_t)(t + 1) * kstep;
            const char* a2 = last ? nA : cA + (size_t)(t + 2) * kstep; const char* b2 = last ? nB : cB + (size_t)(t + 2) * kstep;
            const char* a3 = a2 + kstep; const char* b3 = b2 + kstep;
            if (last && has_next) S.a_ready(nxt);
            if constexpr (SP2) {
            PG8_LDB(B0, 0, 0); PG8_LDB(B1, 0, 1); PG8_SCHED; PG8_LDA(At, 0, 0); PG8_STAGE(PG8_SA(1, 1), a1 + hstep, voffA);
            PG8_WAIT_V(8); PG8_WAIT_L(0); PG8_BAR; PG8_MMA(0, 0, At, B0); PG8_MMA(0, 1, At, B1); PG8_BAR; PG8_SCHED;
            PG8_LDA(At, 0, 1); PG8_STAGE(PG8_SB(0, 0), b2, voffB); PG8_STAGE(PG8_SB(0, 1), b2 + hstep, voffB); PG8_STAGE(PG8_SA(0, 0), a2, voffA);
            PG8_WAIT_V(8); PG8_WAIT_L(0); PG8_BAR; PG8_MMA(1, 0, At, B0); PG8_MMA(1, 1, At, B1); PG8_BAR; PG8_SCHED;
            PG8_LDB(B0, 1, 0); PG8_LDB(B1, 1, 1); PG8_SCHED; PG8_LDA(At, 1, 0); PG8_STAGE(PG8_SA(0, 1), a2 + hstep, voffA);
            PG8_WAIT_V(8); PG8_WAIT_L(0); PG8_BAR; PG8_MMA(0, 0, At, B0); PG8_MMA(0, 1, At, B1); PG8_BAR; PG8_SCHED;
            PG8_LDA(At, 1, 1); PG8_STAGE(PG8_SB(1, 0), b3, voffB); PG8_STAGE(PG8_SB(1, 1), b3 + hstep, voffB); PG8_STAGE(PG8_SA(1, 0), a3, voffA);
            PG8_WAIT_V(8); PG8_WAIT_L(0); PG8_BAR; PG8_MMA(1, 0, At, B0); PG8_MMA(1, 1, At, B1); PG8_BAR; PG8_SCHED;
            } else {
            PG8_LDB(B0, 0, 0); PG8_SCHED; PG8_LDA(At, 0, 0); PG8_STAGE(PG8_SA(1, 1), a1 + hstep, voffA);
            PG8_WAIT_L(8); PG8_BAR; PG8_WAIT_L(0); PG8_MMA(0, 0, At, B0); PG8_BAR; PG8_SCHED;
            PG8_LDB(B1, 0, 1); PG8_STAGE(PG8_SB(0, 0), b2, voffB);
            PG8_BAR; PG8_WAIT_L(0); PG8_MMA(0, 1, At, B1); PG8_BAR;
            PG8_LDA(At, 0, 1); PG8_STAGE(PG8_SA(0, 0), a2, voffA);
            PG8_BAR; PG8_WAIT_L(0); PG8_MMA(1, 0, At, B0); PG8_BAR; PG8_SCHED;
            PG8_STAGE(PG8_SB(0, 1), b2 + hstep, voffB);
            PG8_WAIT_V(6); PG8_BAR; PG8_MMA(1, 1, At, B1); PG8_BAR;
            PG8_LDB(B0, 1, 0); PG8_SCHED; PG8_LDA(At, 1, 0); PG8_STAGE(PG8_SA(0, 1), a2 + hstep, voffA);
            PG8_WAIT_L(8); PG8_BAR; PG8_WAIT_L(0); PG8_MMA(0, 0, At, B0); PG8_BAR; PG8_SCHED;
            PG8_LDB(B1, 1, 1); PG8_STAGE(PG8_SB(1, 0), b3, voffB);
            PG8_BAR; PG8_WAIT_L(0); PG8_MMA(0, 1, At, B1); PG8_BAR;
            PG8_LDA(At, 1, 1); PG8_STAGE(PG8_SA(1, 0), a3, voffA);
            PG8_BAR; PG8_WAIT_L(0); PG8_MMA(1, 0, At, B0); PG8_BAR; PG8_SCHED;
            PG8_STAGE(PG8_SB(1, 1), b3 + hstep, voffB);
            PG8_WAIT_V(6); PG8_BAR; PG8_MMA(1, 1, At, B1); PG8_BAR;
            }
        }
        if constexpr (ALIGN_EPI) { if (wr == 0) PG8_BAR; }
        if constexpr (!Epi::AFTER_DRAIN) { E(acc, cur, wr, wc, fr, fq); S.done(cur); }
        if (!has_next) break;
#pragma unroll
        for (int a = 0; a < 2; ++a)
#pragma unroll
            for (int b = 0; b < 2; ++b)
#pragma unroll
                for (int m = 0; m < 4; ++m)
#pragma unroll
                    for (int n = 0; n < 2; ++n) acc[a][b][m][n] = (f32x4){0.f, 0.f, 0.f, 0.f};
        cur = nxt; cA = nA; cB = nB; ++ui;
        if constexpr (ALIGN_EPI) { if (wr == 1) PG8_BAR; }
    }
    PG8_WAIT_V(0);
    if constexpr (!ALIGN_EPI) { if (wr == 0) PG8_BAR; }
    PG8_BAR;
    if constexpr (Epi::AFTER_DRAIN) { E.fused(acc, cur, wr, wc, fr, fq, lds, wid, lane); S.done(cur); }
#undef PG8_SA
#undef PG8_SB
#undef PG8_STAGE
#undef PG8_LDA
#undef PG8_LDB
#undef PG8_MMA
#undef PG8_WAIT_V
#undef PG8_WAIT_L
#undef PG8_BAR
#undef PG8_SCHED
}
}


#ifndef PG8_SP2
#define PG8_SP2 true
#endif
#ifndef PG8_ALIGN
#define PG8_ALIGN true
#endif
constexpr int NWAVES = 8;
constexpr int MP = pg8::MP, MS = pg8::MS, MVALID = pg8::MVALID, MT = pg8::MT, DM = 1024, DFF = 2816;
constexpr int SEQ = 4096, NB = 4, NSB = 32, PAST = 8192, NPOOL = 2560;
constexpr int ZC0 = 3328, ZC1 = 2304;
constexpr int Z1_Q = 0, Z1_K = 768, Z1_V = 1024, Z1_IQ = 1280, Z1_IK = 1792, Z1_IW = 1856, Z1_MQ = 1920;
constexpr int NMEMROWS = 1024, MEMROW0 = MT;
constexpr float EPS = 1e-6f;
constexpr size_t MiB = 1u << 20;
constexpr size_t WS_CTL = 0, CTL_ZERO_BYTES = 2 * MiB;
constexpr size_t WS_WIN0 = 2 * MiB, WS_WIN1 = 11 * MiB, WS_WOUT = 16 * MiB, WS_WGU = 20 * MiB, WS_WD = 42 * MiB;
constexpr size_t WS_XB = 54 * MiB, WS_MEMKV = 89 * MiB, WS_MIX = 94 * MiB, WS_Z = 128 * MiB, WS_U = 234 * MiB, WS_UP = 324 * MiB, WS_ACT = 414 * MiB;
constexpr size_t WS_QB = 504 * MiB, WS_KB = 528 * MiB, WS_VB = 536 * MiB, WS_IQB = 544 * MiB, WS_IKB = 560 * MiB, WS_IW = 562 * MiB;
constexpr size_t WS_SQ = 563 * MiB, WS_SIQ = WS_SQ + 512 * 1024, WS_SIW = WS_SIQ + 384 * 1024, WS_SSC = 564 * MiB, WS_SIDX = 569 * MiB, WS_MASK = 570 * MiB, WS_SC = 578 * MiB, WS_END = 834 * MiB;
constexpr int SSC_LD = 8256;
constexpr int CW_TMO = 0, CW_BAR = 4096, CW_Q = 8192, CW_SS = 16384;
constexpr size_t O_YP = 0, O_YS = O_YP + (size_t)MP * DM, O_HP = O_YS + (size_t)MS * DM, O_HS = O_HP + 4 * 6 * 16384, O_KP = O_HS + 32 * 6 * 16384,
    O_VP = O_KP + (size_t)MP * 256, O_IKP = O_VP + (size_t)MP * 256, O_KS = O_IKP + (size_t)MP * 64, O_VS = O_KS + MS * 256, O_IKS = O_VS + MS * 256,
    O_MK = O_IKS + MS * 64, O_MV = O_MK + 2 * 1024 * 256, O_CVP = O_MV + 2 * 1024 * 256, O_CVS = O_CVP + 2 * 4 * 2 * DFF, O_END = O_CVS + 2 * 32 * 2 * DFF;
static_assert(O_END == 31412224, "output size");
constexpr int RING_OFF = 0, RING_BYTES = 131072;
constexpr int LDSCTL_OFF = RING_BYTES, MISC_OFF = LDSCTL_OFF + 320;
constexpr int LDS_BYTES = 147456;

#define GAS __attribute__((address_space(1)))
#define LAS __attribute__((address_space(3)))
typedef unsigned short bf16;
typedef unsigned v4u __attribute__((ext_vector_type(4)));
typedef float f32x4 __attribute__((ext_vector_type(4)));
typedef short bf16x8 __attribute__((ext_vector_type(8)));
typedef GAS unsigned gu32;
typedef GAS unsigned long long gu64;
#define RLX_AGENT __ATOMIC_RELAXED, __HIP_MEMORY_SCOPE_AGENT
#define LDS_WAIT() asm volatile("s_waitcnt lgkmcnt(0)" ::: "memory")
#define VM_WAIT() asm volatile("s_waitcnt vmcnt(0)" ::: "memory")
__device__ __forceinline__ unsigned long long rt() { return __builtin_amdgcn_s_memrealtime(); }
__device__ __forceinline__ unsigned f2bf(float f) { unsigned u = __builtin_bit_cast(unsigned, f); return (u + 0x7fffu + ((u >> 16) & 1u)) >> 16; }
__device__ __forceinline__ unsigned pk2(float lo, float hi) { return f2bf(lo) | (f2bf(hi) << 16); }

#define XB_TMO      128
#define XB_XCNT(j)  (256  + 64 * (j))
#define XB_XSUB(j)  (1280 + 64 * (j))
#define XB_XGEN(j)  (2304 + 64 * (j))
#define XB_TOP      3328
#define XB_TOPGEN   3392
#define XCD_BAR_WORDS 3456
#define XB_SPIN_CAP (1u << 18)

__device__ __forceinline__ unsigned xb_ld(unsigned* p)              { return __hip_atomic_load(p, __ATOMIC_RELAXED, __HIP_MEMORY_SCOPE_AGENT); }
__device__ __forceinline__ unsigned xb_add(unsigned* p, unsigned v) { return __hip_atomic_fetch_add(p, v, __ATOMIC_RELAXED, __HIP_MEMORY_SCOPE_AGENT); }
__device__ __forceinline__ unsigned xb_xcc_id() { return (unsigned)__builtin_amdgcn_s_getreg((3 << 11) | 20) & 0xFu; }
#define XB_SPIN(cond, bar) do { unsigned _sp = 0; while (cond) { __builtin_amdgcn_s_sleep(1); \
    if ((++_sp & 255u) == 0u) { if (xb_ld(&(bar)[XB_TMO])) break; if (_sp > XB_SPIN_CAP) { atomicAdd(&(bar)[XB_TMO], 1u); break; } } } } while (0)

struct XcdBarrier {
    unsigned* bar; unsigned x;
    volatile LAS unsigned* st;
};

__device__ __forceinline__ XcdBarrier xcd_barrier_post(unsigned* bar, volatile LAS unsigned* st) {
    XcdBarrier b; b.bar = bar; b.x = xb_xcc_id(); b.st = st;
    if (threadIdx.x == 0) (void)xb_add(&bar[XB_XCNT(b.x)], 1u);
    return b;
}
__device__ __forceinline__ void xcd_barrier_complete(unsigned* bar, unsigned x, unsigned& nloc, unsigned& nx) {
    const unsigned G = gridDim.x * gridDim.y * gridDim.z;
    unsigned sum, cnt, mine, sp = 0u;
    for (;;) {
        sum = 0u; cnt = 0u; mine = 0u;
#pragma unroll
        for (unsigned j = 0; j < 16; ++j) { const unsigned c = xb_ld(&bar[XB_XCNT(j)]); sum += c; cnt += (c > 0u) ? 1u : 0u; mine = (j == x) ? c : mine; }
        if (sum == G) break;
        __builtin_amdgcn_s_sleep(1);
        if ((++sp & 255u) == 0u) { if (xb_ld(&bar[XB_TMO])) break; if (sp > XB_SPIN_CAP) { atomicAdd(&bar[XB_TMO], 1u); break; } }
    }
    nloc = mine > 0u ? mine : 1u; nx = cnt > 0u ? cnt : 1u;
}

__device__ __forceinline__ void xcd_barrier(const XcdBarrier& b) {
    asm volatile("s_waitcnt vmcnt(0)" ::: "memory");
    __syncthreads();
    if (threadIdx.x == 0) {
        unsigned* bar = b.bar;
        __builtin_amdgcn_s_waitcnt(0);
        unsigned nloc = b.st[0], nx = b.st[1];
        if (nloc == 0u) { xcd_barrier_complete(bar, b.x, nloc, nx); b.st[0] = nloc; b.st[1] = nx; }
        const unsigned old = xb_add(&bar[XB_XSUB(b.x)], 1u);
        const unsigned gen = old / nloc;
        if (old + 1u == (gen + 1u) * nloc) {
            __builtin_amdgcn_fence(__ATOMIC_RELEASE, "agent");
            asm volatile("s_waitcnt vmcnt(0)" ::: "memory");
            const unsigned og = xb_add(&bar[XB_TOP], 1u);
            const unsigned tg = og / nx;
            if (og + 1u == (tg + 1u) * nx) xb_add(&bar[XB_TOPGEN], 1u);
            else XB_SPIN(xb_ld(&bar[XB_TOPGEN]) == tg, bar);
            __builtin_amdgcn_fence(__ATOMIC_ACQUIRE, "agent");
            xb_add(&bar[XB_XGEN(b.x)], 1u);
            asm volatile("s_waitcnt vmcnt(0)" ::: "memory");
        } else {
            XB_SPIN(xb_ld(&bar[XB_XGEN(b.x)]) == gen, bar);
            __builtin_amdgcn_fence(__ATOMIC_ACQUIRE, "agent");
            asm volatile("s_waitcnt vmcnt(0)" ::: "memory");
        }
    }
    __syncthreads();
}


struct Args { const float* in[29]; const int* page_table; float* out; unsigned char* ws; int ph_lo, ph_hi; };
typedef const __attribute__((address_space(4))) Args& ARGREF;
struct Ctx { LAS unsigned char* lds; volatile LAS unsigned* MISC; gu32* ctl; int tid, lane, wave, vcu, G, qoff; };
typedef float f32x16 __attribute__((ext_vector_type(16)));
typedef unsigned long long u64;

__device__ __forceinline__ float bf2f(unsigned b) { return __builtin_bit_cast(float, b << 16); }
__device__ __forceinline__ float wave_sum(float v) {
#pragma unroll
    for (int o = 1; o < 64; o <<= 1) v += __shfl_xor(v, o);
    return v;
}
__device__ __forceinline__ int crow(int r, int hi) { return (r & 3) + 8 * (r >> 2) + 4 * hi; }
__device__ __forceinline__ float sigmoidf_(float x) { return 1.0f / (1.0f + __expf(-x)); }
__device__ __forceinline__ float* ssptr(const Ctx& c, int i) { return (float*)(c.ctl + CW_SS) + (size_t)i * MT; }

__device__ __forceinline__ int q_next(Ctx& c, int qi) {
    __syncthreads();
    if (c.tid == 0) c.MISC[16] = atomicAdd((unsigned*)(c.ctl + CW_Q + 64 * (qi + c.qoff)), 1u);
    __syncthreads();
    return (int)c.MISC[16];
}

template <int K>
__device__ __forceinline__ f32x16 mm32(const LAS bf16* A, int lda, const LAS bf16* Bt, int ldb, f32x16 acc, int lane) {
    const int r = lane & 31, h = lane >> 5;
#pragma unroll
    for (int ks = 0; ks < K; ks += 16) {
        const bf16x8 a = *(const LAS bf16x8*)(A + r * lda + ks + 8 * h);
        const bf16x8 b = *(const LAS bf16x8*)(Bt + r * ldb + ks + 8 * h);
        acc = __builtin_amdgcn_mfma_f32_32x32x16_bf16(a, b, acc, 0, 0, 0);
    }
    return acc;
}

__device__ __forceinline__ int map_row(int mapid, int n, int row_off) {
    if (mapid == 0) return n + row_off;
    if (mapid == 1) return n < 1864 ? n : n + 56;
    if (mapid == 2) return (n >> 7) * 256 + (n & 127);
    return (n >> 7) * 256 + 128 + (n & 127);
}
__device__ __forceinline__ void transpose_item(const float* W, int K, int N, const float* kscale, bf16* WT, int mapid, int row_off, LAS float* scr, int item, int lane) {
    const int nblk = (N + 31) / 32, kb = item / nblk, nb = item % nblk, k0 = 64 * kb, n0 = 32 * nb;
    { const int n4 = (lane & 7) * 4, nn = n0 + n4 < N ? n0 + n4 : N - 4; f32x4 v[8];
#pragma unroll
      for (int i = 0; i < 8; ++i) v[i] = *(const f32x4*)(W + (size_t)(k0 + 8 * i + (lane >> 3)) * N + nn);
#pragma unroll
      for (int i = 0; i < 8; ++i) { const int kk = 8 * i + (lane >> 3); const float sc = kscale ? kscale[k0 + kk] : 1.0f; LAS float* d = scr + kk * 33 + n4;
          d[0] = v[i].x * sc; d[1] = v[i].y * sc; d[2] = v[i].z * sc; d[3] = v[i].w * sc; } }
    LDS_WAIT(); asm volatile("" ::: "memory");
    const int cc = lane & 7;
#pragma unroll
    for (int j = 0; j < 4; ++j) { const int nl = (lane >> 3) + 8 * j, n = n0 + nl; const LAS float* s = scr + (8 * cc) * 33 + nl;
        v4u o; o.x = pk2(s[0 * 33], s[1 * 33]); o.y = pk2(s[2 * 33], s[3 * 33]); o.z = pk2(s[4 * 33], s[5 * 33]); o.w = pk2(s[6 * 33], s[7 * 33]);
        if (n < N) *(GAS v4u*)(WT + (size_t)map_row(mapid, n, row_off) * K + k0 + 8 * cc) = o; }
    LDS_WAIT(); asm volatile("" ::: "memory");
}
constexpr int I_INH = 16 * 104, I_MKV = 16 * 16, I_DSA = 16 * 67, I_OUT = 16 * 32, I_G = 16 * 88, I_D = 44 * 32;
constexpr int W_N0 = I_INH + 2 * I_MKV + I_OUT + 2 * I_G + I_D, W_NITEMS = W_N0 + I_DSA + I_OUT + 2 * I_G + I_D;
__device__ __forceinline__ void convert_item(ARGREF a, int it, LAS float* scr, int lane) {
    unsigned char* ws = a.ws; int r = it;
    if (r < I_INH) { transpose_item(a.in[13], 1024, 3328, a.in[11], (bf16*)(ws + WS_WIN0), 0, 0, scr, r, lane); return; } r -= I_INH;
    if (r < 2 * I_MKV) { const int l = r / I_MKV; transpose_item(a.in[20] + (size_t)l * 1024 * 512, 1024, 512, nullptr, (bf16*)(ws + WS_WIN0), 0, 3328 + 512 * l, scr, r % I_MKV, lane); return; } r -= 2 * I_MKV;
    int l = 0;
    if (r >= I_OUT + 2 * I_G + I_D) { r -= I_OUT + 2 * I_G + I_D; l = 1;
        if (r < I_DSA) { transpose_item(a.in[16], 1024, 2120, a.in[11] + 1024, (bf16*)(ws + WS_WIN1), 1, 0, scr, r, lane); return; } r -= I_DSA; }
    if (r < I_OUT) { transpose_item(a.in[23] + (size_t)l * 1024 * 1024, 1024, 1024, nullptr, (bf16*)(ws + WS_WOUT) + (size_t)l * 1024 * 1024, 0, 0, scr, r, lane); return; } r -= I_OUT;
    if (r < I_G) { transpose_item(a.in[24] + (size_t)l * 1024 * DFF, 1024, DFF, a.in[12] + l * 1024, (bf16*)(ws + WS_WGU) + (size_t)l * 5632 * 1024, 2, 0, scr, r, lane); return; } r -= I_G;
    if (r < I_G) { transpose_item(a.in[25] + (size_t)l * 1024 * DFF, 1024, DFF, a.in[12] + l * 1024, (bf16*)(ws + WS_WGU) + (size_t)l * 5632 * 1024, 3, 0, scr, r, lane); return; } r -= I_G;
    transpose_item(a.in[28] + (size_t)l * DFF * 1024, DFF, 1024, nullptr, (bf16*)(ws + WS_WD) + (size_t)l * 1024 * DFF, 0, 0, scr, r, lane);
}
__device__ __forceinline__ void convert_layer1_tail(Ctx& c, ARGREF a, int first_idle) {
    LAS float* scr = (LAS float*)(c.lds + RING_OFF + c.wave * 16384);
    const int bx = (int)blockIdx.x; if (bx < first_idle) return;
    const int nw = (c.G - first_idle) * NWAVES;
    for (int it = W_N0 + (bx - first_idle) * NWAVES + c.wave; it < W_NITEMS; it += nw) convert_item(a, it, scr, c.lane);
}
__device__ __forceinline__ void p0_prologue(Ctx& c, ARGREF a) {
    LAS float* scr = (LAS float*)(c.lds + RING_OFF + c.wave * 16384);
    const int gw = c.vcu * NWAVES + c.wave, NGW = c.G * NWAVES, lane = c.lane;
    unsigned char* ws = a.ws;
    for (int it = gw; it < W_N0; it += NGW) convert_item(a, it, scr, lane);
    for (int rr = gw; rr < 184; rr += NGW) { const int row = rr < 56 ? 1864 + rr : 2176 + (rr - 56);
        GAS v4u* p = (GAS v4u*)((bf16*)(ws + WS_WIN1) + (size_t)row * 1024); p[lane] = (v4u){0u, 0u, 0u, 0u}; p[64 + lane] = (v4u){0u, 0u, 0u, 0u}; }
    float* ss0 = ssptr(c, 0);
    for (int m = gw; m < MT + NMEMROWS; m += NGW) {
        GAS u64* o8 = (GAS u64*)((bf16*)(ws + WS_XB) + (size_t)m * DM) + lane;
        if (m >= MVALID && m < MT) {
#pragma unroll
            for (int j = 0; j < 4; ++j) o8[64 * j] = 0ull;
            continue; }
        const float* src = m < MP ? a.in[0] + (size_t)m * DM : (m < MVALID ? a.in[1] + (size_t)(m - MP) * DM : a.in[10] + (size_t)(m - MT) * DM);
        const GAS f32x4* xr = (const GAS f32x4*)src + lane; f32x4 v[4]; float s = 0.f;
#pragma unroll
        for (int j = 0; j < 4; ++j) { v[j] = xr[64 * j]; s += (v[j].x * v[j].x + v[j].y * v[j].y) + (v[j].z * v[j].z + v[j].w * v[j].w); }
        s = wave_sum(s);
#pragma unroll
        for (int j = 0; j < 4; ++j) o8[64 * j] = (u64)pk2(v[j].x, v[j].y) | ((u64)pk2(v[j].z, v[j].w) << 32);
        if (m < MVALID && lane == 0) ss0[m] = s;
    }
}

__device__ __forceinline__ void memattn_unit(Ctx& c, const bf16* Zq  , int ldz, int nrows_valid, const float* Kp, const float* Vp, int kstride,
                                             bool normk, const float* kgain, const float* qgain, bf16* Out  ) {
    LAS bf16* KN = (LAS bf16*)(c.lds);
    LAS bf16* VTm = (LAS bf16*)(c.lds + 36864);
    LAS bf16* QN = (LAS bf16*)(c.lds + 70656) + c.wave * (32 * 72);
    LAS float* LI = (LAS float*)(c.lds + 107520) + c.wave * 32;
    int tid = c.tid; asm volatile("" : "+v"(tid));
    const int lane = tid & 63, w = c.wave;
    {
        const int m = tid >> 1, dh = (tid & 1) * 32;
        f32x4 kv[8]; float s = 0.f;
#pragma unroll
        for (int j = 0; j < 8; ++j) { kv[j] = *(const f32x4*)(Kp + (size_t)m * kstride + dh + 4 * j); s += (kv[j].x * kv[j].x + kv[j].y * kv[j].y) + (kv[j].z * kv[j].z + kv[j].w * kv[j].w); }
        s += __shfl_xor(s, 1);
        const float rs = normk ? rsqrtf(s * (1.0f / 64.0f) + EPS) : 1.0f;
#pragma unroll
        for (int j = 0; j < 8; j += 2) { f32x4 g0 = {1.f, 1.f, 1.f, 1.f}, g1 = g0;
            if (normk) { g0 = *(const f32x4*)(kgain + dh + 4 * j); g1 = *(const f32x4*)(kgain + dh + 4 * j + 4); }
            const f32x4 x0 = kv[j] * rs * g0, x1 = kv[j + 1] * rs * g1;
            v4u o; o.x = pk2(x0.x, x0.y); o.y = pk2(x0.z, x0.w); o.z = pk2(x1.x, x1.y); o.w = pk2(x1.z, x1.w);
            *(LAS v4u*)(KN + m * 72 + dh + 4 * j) = o; }
#pragma unroll
        for (int j = 0; j < 8; ++j) { const f32x4 vv = *(const f32x4*)(Vp + (size_t)m * kstride + dh + 4 * j);
            VTm[(dh + 4 * j + 0) * 264 + m] = (bf16)f2bf(vv.x); VTm[(dh + 4 * j + 1) * 264 + m] = (bf16)f2bf(vv.y);
            VTm[(dh + 4 * j + 2) * 264 + m] = (bf16)f2bf(vv.z); VTm[(dh + 4 * j + 3) * 264 + m] = (bf16)f2bf(vv.w); }
    }
    {
        const int row = lane >> 1, hf = lane & 1, grow = w * 32 + row;
        float x[32]; float s = 0.f;
        if (grow < nrows_valid) {
#pragma unroll
            for (int j = 0; j < 4; ++j) { const v4u q = *(const v4u*)(Zq + (size_t)grow * ldz + hf * 32 + 8 * j);
                x[8 * j + 0] = bf2f(q.x & 0xffffu); x[8 * j + 1] = bf2f(q.x >> 16); x[8 * j + 2] = bf2f(q.y & 0xffffu); x[8 * j + 3] = bf2f(q.y >> 16);
                x[8 * j + 4] = bf2f(q.z & 0xffffu); x[8 * j + 5] = bf2f(q.z >> 16); x[8 * j + 6] = bf2f(q.w & 0xffffu); x[8 * j + 7] = bf2f(q.w >> 16); }
        } else {
#pragma unroll
            for (int j = 0; j < 32; ++j) x[j] = 0.f;
        }
#pragma unroll
        for (int j = 0; j < 32; ++j) s += x[j] * x[j];
        s += __shfl_xor(s, 1);
        const float rs = rsqrtf(s * (1.0f / 64.0f) + EPS) * 0.125f;
#pragma unroll
        for (int j = 0; j < 32; j += 8) { v4u o;
            o.x = pk2(x[j] * rs * qgain[hf * 32 + j], x[j + 1] * rs * qgain[hf * 32 + j + 1]); o.y = pk2(x[j + 2] * rs * qgain[hf * 32 + j + 2], x[j + 3] * rs * qgain[hf * 32 + j + 3]);
            o.z = pk2(x[j + 4] * rs * qgain[hf * 32 + j + 4], x[j + 5] * rs * qgain[hf * 32 + j + 5]); o.w = pk2(x[j + 6] * rs * qgain[hf * 32 + j + 6], x[j + 7] * rs * qgain[hf * 32 + j + 7]);
            *(LAS v4u*)(QN + row * 72 + hf * 32 + j) = o; }
    }
    __syncthreads();
    if (w * 32 < nrows_valid) {
        const int r32 = lane & 31, hh = lane >> 5;
        f32x16 s[8];
#pragma unroll
        for (int mt = 0; mt < 8; ++mt) { f32x16 z = {}; s[mt] = mm32<64>(KN + mt * 32 * 72, 72, QN, 72, z, lane); }
        float mx = -1e30f;
#pragma unroll
        for (int mt = 0; mt < 8; ++mt)
#pragma unroll
            for (int r = 0; r < 16; ++r) mx = fmaxf(mx, s[mt][r]);
        mx = fmaxf(mx, __shfl_xor(mx, 32));
        float l = 0.f;
#pragma unroll
        for (int mt = 0; mt < 8; ++mt)
#pragma unroll
            for (int r = 0; r < 16; ++r) { const float p = __expf(s[mt][r] - mx); s[mt][r] = p; l += p; }
        l += __shfl_xor(l, 32);
        if (hh == 0) LI[r32] = l;
        f32x16 o[2] = {};
#pragma unroll
        for (int mt = 0; mt < 8; ++mt)
#pragma unroll
            for (int sx = 0; sx < 2; ++sx) {
                v4u pa; pa.x = pk2(s[mt][8 * sx + 0], s[mt][8 * sx + 1]); pa.y = pk2(s[mt][8 * sx + 2], s[mt][8 * sx + 3]);
                pa.z = pk2(s[mt][8 * sx + 4], s[mt][8 * sx + 5]); pa.w = pk2(s[mt][8 * sx + 6], s[mt][8 * sx + 7]);
                const bf16x8 af = __builtin_bit_cast(bf16x8, pa);
#pragma unroll
                for (int dt = 0; dt < 2; ++dt) { const LAS bf16* vp = VTm + (dt * 32 + r32) * 264 + mt * 32 + 16 * sx + 4 * hh;
                    const u64 lo = *(const LAS u64*)vp, hi = *(const LAS u64*)(vp + 8);
                    v4u bw; bw.x = (unsigned)lo; bw.y = (unsigned)(lo >> 32); bw.z = (unsigned)hi; bw.w = (unsigned)(hi >> 32);
                    o[dt] = __builtin_amdgcn_mfma_f32_32x32x16_bf16(af, __builtin_bit_cast(bf16x8, bw), o[dt], 0, 0, 0); }
            }
        LDS_WAIT();
#pragma unroll
        for (int r = 0; r < 16; ++r) { const int qr = crow(r, hh), grow = w * 32 + qr; const float il = 1.0f / LI[qr];
            if (grow < nrows_valid) {
#pragma unroll
                for (int dt = 0; dt < 2; ++dt) Out[(size_t)grow * DM + dt * 32 + r32] = (bf16)f2bf(o[dt][r] * il); } }
    }
}

constexpr int HG_GS = 4, HG_NG = SEQ / (32 * HG_GS);
constexpr size_t WS_HOL = WS_U, WS_HQC = WS_UP, WS_HUT = WS_ACT, WS_HST = WS_ACT + 64 * MiB, WS_HDG = WS_ACT + 50 * MiB;
template <bool PROMPT>
__device__ __forceinline__ void hgrn_unit(Ctx& c, ARGREF a, int b, int h, int g) {
    LAS unsigned char* L = c.lds;
    LAS float* LF = (LAS float*)(L + 0);
    LAS float* BL = (LAS float*)(L + 16384);
    LAS float* DVv = (LAS float*)(L + 16896);
    LAS bf16* QD = (LAS bf16*)(L + 17408);
    LAS bf16* KD = (LAS bf16*)(L + 26112);
    LAS bf16* KET = (LAS bf16*)(L + 34816);
    LAS bf16* VT = (LAS bf16*)(L + 45056);
    LAS bf16* SCB = (LAS bf16*)(L + 55296);
    LAS bf16* STt = (LAS bf16*)(L + 57856);
    LAS float* BOFF = (LAS float*)(L + 92672);
    int tid = c.tid; asm volatile("" : "+v"(tid));
    const int lane = tid & 63, w = c.wave, r32 = lane & 31, hh = lane >> 5;
    const int te = tid >> 4, k8 = (tid & 15) * 8;
    const bf16* Z = (const bf16*)(a.ws + WS_Z);
    bf16* MIX = (bf16*)(a.ws + WS_MIX);
    const int nch = PROMPT ? HG_GS : 1, nvalid = PROMPT ? 32 : 4;
    const int kt = w >> 1, vt0 = 2 * (w & 1);
    const int unit = (b * 6 + h) * HG_NG + g;
    f32x16 S0 = {}, S1 = {};
    if (!PROMPT) { const float* sp = a.in[7] + (size_t)(b * 6 + h) * 16384;
#pragma unroll
        for (int r = 0; r < 16; ++r) { const int k = 32 * kt + crow(r, hh); S0[r] = sp[k * 128 + 32 * vt0 + r32]; S1[r] = sp[k * 128 + 32 * (vt0 + 1) + r32]; } }
    float lbv[8], onv[8];
#pragma unroll
    for (int j = 0; j < 8; ++j) { const float l0 = a.in[14][h * 128 + k8 + j], l1 = a.in[14][768 + h * 128 + k8 + j]; lbv[j] = 1.0f / (1.0f + __expf(l1 - l0)); onv[j] = a.in[15][k8 + j]; }
    __syncthreads();
    if (tid < 128) BOFF[tid] = 0.f;
#define HG_WRITE_ST() do { _Pragma("unroll") for (int g4 = 0; g4 < 4; ++g4) { const int k0 = 32 * kt + 8 * g4 + 4 * hh; \
        *(LAS u64*)(STt + (32 * vt0 + r32) * 136 + k0) = (u64)pk2(S0[4 * g4], S0[4 * g4 + 1]) | ((u64)pk2(S0[4 * g4 + 2], S0[4 * g4 + 3]) << 32); \
        *(LAS u64*)(STt + (32 * (vt0 + 1) + r32) * 136 + k0) = (u64)pk2(S1[4 * g4], S1[4 * g4 + 1]) | ((u64)pk2(S1[4 * g4 + 2], S1[4 * g4 + 3]) << 32); } } while (0)
    HG_WRITE_ST();
#pragma unroll 1
    for (int ch = 0; ch < nch; ++ch) {
        const int row0 = PROMPT ? b * SEQ + (g * HG_GS + ch) * 32 : MP + 4 * b, row = row0 + te;
        const bool valid = te < nvalid;
        float qs[8], kk[8]; v4u gz = {0u, 0u, 0u, 0u};
        {
            v4u zq = {0u, 0u, 0u, 0u}, zf = zq, zi = zq;
            if (valid) { const bf16* zr = Z + (size_t)row * ZC0 + h * 128 + k8;
                zq = *(const v4u*)zr; zf = *(const v4u*)(zr + 768); zi = *(const v4u*)(zr + 1536); if (!PROMPT) gz = *(const v4u*)(zr + 2304); }
            const unsigned qw[4] = {zq.x, zq.y, zq.z, zq.w}, fw[4] = {zf.x, zf.y, zf.z, zf.w}, iw[4] = {zi.x, zi.y, zi.z, zi.w};
            float lf[8];
#pragma unroll
            for (int j = 0; j < 8; ++j) { const float q = bf2f((qw[j >> 1] >> (16 * (j & 1))) & 0xffffu), fp = bf2f((fw[j >> 1] >> (16 * (j & 1))) & 0xffffu);
                const float sg = sigmoidf_(fp), f = lbv[j] + (1.0f - lbv[j]) * sg;
                qs[j] = valid ? q * sigmoidf_(q) : 0.f; kk[j] = valid ? (1.0f - f) : 0.f; lf[j] = valid ? __logf(f) : 0.f;
                VT[(k8 + j) * 40 + te] = (bf16)((iw[j >> 1] >> (16 * (j & 1))) & 0xffffu); }
            *(LAS f32x4*)(LF + te * 128 + k8) = (f32x4){lf[0], lf[1], lf[2], lf[3]}; *(LAS f32x4*)(LF + te * 128 + k8 + 4) = (f32x4){lf[4], lf[5], lf[6], lf[7]};
        }
        __syncthreads();
        if (tid < 128) { float bsum = 0.f;
#pragma unroll
            for (int t = 0; t < 32; ++t) { bsum += LF[t * 128 + tid]; LF[t * 128 + tid] = bsum; }
            BL[tid] = bsum; }
        __syncthreads();
        {
            const f32x4 b0 = *(const LAS f32x4*)(LF + te * 128 + k8), b1 = *(const LAS f32x4*)(LF + te * 128 + k8 + 4);
            const f32x4 l0 = *(const LAS f32x4*)(BL + k8), l1 = *(const LAS f32x4*)(BL + k8 + 4);
            const float bb[8] = {b0.x, b0.y, b0.z, b0.w, b1.x, b1.y, b1.z, b1.w}, bl[8] = {l0.x, l0.y, l0.z, l0.w, l1.x, l1.y, l1.z, l1.w};
            float qd[8], kd[8];
#pragma unroll
            for (int j = 0; j < 8; ++j) { qd[j] = qs[j] * __expf(bb[j]); kd[j] = kk[j] * __expf(-bb[j]); KET[(k8 + j) * 40 + te] = (bf16)f2bf(kk[j] * __expf(bl[j] - bb[j])); }
            v4u o; o.x = pk2(qd[0], qd[1]); o.y = pk2(qd[2], qd[3]); o.z = pk2(qd[4], qd[5]); o.w = pk2(qd[6], qd[7]); *(LAS v4u*)(QD + te * 136 + k8) = o;
            if (PROMPT) { const f32x4 f0 = *(const LAS f32x4*)(BOFF + k8), f1 = *(const LAS f32x4*)(BOFF + k8 + 4);
                const float bo[8] = {f0.x, f0.y, f0.z, f0.w, f1.x, f1.y, f1.z, f1.w}; float qc[8];
#pragma unroll
                for (int j = 0; j < 8; ++j) qc[j] = qd[j] * __expf(bo[j]);
                v4u oc; oc.x = pk2(qc[0], qc[1]); oc.y = pk2(qc[2], qc[3]); oc.z = pk2(qc[4], qc[5]); oc.w = pk2(qc[6], qc[7]);
                *(v4u*)((bf16*)(a.ws + WS_HQC) + (size_t)row * 768 + h * 128 + k8) = oc; }
            o.x = pk2(kd[0], kd[1]); o.y = pk2(kd[2], kd[3]); o.z = pk2(kd[4], kd[5]); o.w = pk2(kd[6], kd[7]); *(LAS v4u*)(KD + te * 136 + k8) = o;
            if (te == 0) {
#pragma unroll
                for (int j = 0; j < 8; ++j) DVv[k8 + j] = __expf(bl[j]); }
        }
        __syncthreads();
        f32x16 oacc = {};
        if (w == 0) { f32x16 z = {}; const f32x16 sc = mm32<128>(QD, 136, KD, 136, z, lane);
#pragma unroll
            for (int r = 0; r < 16; ++r) { const int t = crow(r, hh); SCB[t * 40 + r32] = (bf16)f2bf(r32 <= t ? sc[r] : 0.f); } }
        if (w < 4) oacc = mm32<128>(QD, 136, STt + (w * 32) * 136, 136, oacc, lane);
        if (PROMPT && tid >= 384) BOFF[tid - 384] += BL[tid - 384];
        __syncthreads();
        if (w < 4) { oacc = mm32<32>(SCB, 40, VT + (w * 32) * 40, 40, oacc, lane);
#pragma unroll
            for (int r = 0; r < 16; ++r) LF[crow(r, hh) * 128 + w * 32 + r32] = oacc[r]; }
        {
#pragma unroll
            for (int r = 0; r < 16; ++r) { const float d = DVv[32 * kt + crow(r, hh)]; S0[r] *= d; S1[r] *= d; }
            S0 = mm32<32>(KET + (kt * 32) * 40, 40, VT + (vt0 * 32) * 40, 40, S0, lane);
            S1 = mm32<32>(KET + (kt * 32) * 40, 40, VT + ((vt0 + 1) * 32) * 40, 40, S1, lane);
        }
        __syncthreads();
        HG_WRITE_ST();
        {
            const f32x4 o0 = *(const LAS f32x4*)(LF + te * 128 + k8), o1 = *(const LAS f32x4*)(LF + te * 128 + k8 + 4);
            if (PROMPT) { float* ol = (float*)(a.ws + WS_HOL) + (size_t)row * 768 + h * 128 + k8; *(f32x4*)ol = o0; *(f32x4*)(ol + 4) = o1; }
            else {
                float ov[8] = {o0.x, o0.y, o0.z, o0.w, o1.x, o1.y, o1.z, o1.w}; float s = 0.f;
#pragma unroll
                for (int j = 0; j < 8; ++j) s += ov[j] * ov[j];
                s += __shfl_xor(s, 1); s += __shfl_xor(s, 2); s += __shfl_xor(s, 4); s += __shfl_xor(s, 8);
                const float rs = rsqrtf(s * (1.0f / 128.0f) + EPS);
                const unsigned gw_[4] = {gz.x, gz.y, gz.z, gz.w}; float y[8];
#pragma unroll
                for (int j = 0; j < 8; ++j) { const float gg = bf2f((gw_[j >> 1] >> (16 * (j & 1))) & 0xffffu); y[j] = ov[j] * rs * onv[j] * (gg * sigmoidf_(gg)); }
                if (valid) { v4u o; o.x = pk2(y[0], y[1]); o.y = pk2(y[2], y[3]); o.z = pk2(y[4], y[5]); o.w = pk2(y[6], y[7]); *(v4u*)(MIX + (size_t)row * DM + h * 128 + k8) = o; }
            }
        }
        __syncthreads();
    }
#undef HG_WRITE_ST
    if (PROMPT) {
        float* ut = (float*)(a.ws + WS_HUT) + (size_t)unit * 16384;
#pragma unroll
        for (int g4 = 0; g4 < 4; ++g4) { const int k0 = 32 * kt + 8 * g4 + 4 * hh;
            *(f32x4*)(ut + (32 * vt0 + r32) * 128 + k0) = (f32x4){S0[4 * g4], S0[4 * g4 + 1], S0[4 * g4 + 2], S0[4 * g4 + 3]};
            *(f32x4*)(ut + (32 * (vt0 + 1) + r32) * 128 + k0) = (f32x4){S1[4 * g4], S1[4 * g4 + 1], S1[4 * g4 + 2], S1[4 * g4 + 3]}; }
        if (tid < 128) ((float*)(a.ws + WS_HDG))[(size_t)unit * 128 + tid] = __expf(BOFF[tid]);
    } else {
        float* so = a.out + O_HS + (size_t)(b * 6 + h) * 16384;
#pragma unroll
        for (int r = 0; r < 16; ++r) { const int k = 32 * kt + crow(r, hh); so[k * 128 + 32 * vt0 + r32] = S0[r]; so[k * 128 + 32 * (vt0 + 1) + r32] = S1[r]; }
    }
}
__device__ __forceinline__ void hgrn_scan(Ctx& c, ARGREF a) {
    const float* UT = (const float*)(a.ws + WS_HUT); const float* DG = (const float*)(a.ws + WS_HDG); bf16* STo = (bf16*)(a.ws + WS_HST);
    for (int idx = c.vcu * 512 + c.tid; idx < 24 * 16384; idx += c.G * 512) {
        const int bh = idx >> 14, e = idx & 16383, k = e & 127, v = e >> 7;
        float s = 0.f;
#pragma unroll 8
        for (int g = 0; g < HG_NG; ++g) { const size_t u = (size_t)(bh * HG_NG + g); STo[u * 16384 + e] = (bf16)f2bf(s); s = DG[u * 128 + k] * s + UT[u * 16384 + e]; }
        a.out[O_HP + (size_t)bh * 16384 + k * 128 + v] = s;
    }
}
__device__ __forceinline__ void hgrn_fix_unit(Ctx& c, ARGREF a, int b, int h, int g) {
    LAS bf16* STt = (LAS bf16*)(c.lds);
    LAS bf16* QCl = (LAS bf16*)(c.lds + 34816);
    LAS float* OB = (LAS float*)(c.lds + 34816 + 17408);
    int tid = c.tid; asm volatile("" : "+v"(tid));
    const int lane = tid & 63, w = c.wave, r32 = lane & 31, hh = lane >> 5;
    const int unit = (b * 6 + h) * HG_NG + g, row0 = b * SEQ + g * 128;
    const bf16* Z = (const bf16*)(a.ws + WS_Z); bf16* MIX = (bf16*)(a.ws + WS_MIX);
    const bf16* QC = (const bf16*)(a.ws + WS_HQC); const float* OL = (const float*)(a.ws + WS_HOL);
    const bf16* stg = (const bf16*)(a.ws + WS_HST) + (size_t)unit * 16384;
    __syncthreads();
#pragma unroll
    for (int i = 0; i < 4; ++i) { const int cidx = tid + 512 * i, v = cidx >> 4, kc = (cidx & 15) * 8; *(LAS v4u*)(STt + v * 136 + kc) = *(const v4u*)(stg + v * 128 + kc); }
    const int te = tid >> 4, k8 = (tid & 15) * 8;
    float onv[8];
#pragma unroll
    for (int j = 0; j < 8; ++j) onv[j] = a.in[15][k8 + j];
#pragma unroll 1
    for (int hf = 0; hf < 2; ++hf) {
        const int rb = row0 + hf * 64;
#pragma unroll
        for (int i = 0; i < 2; ++i) { const int cidx = tid + 512 * i, r = cidx >> 4, kc = (cidx & 15) * 8; *(LAS v4u*)(QCl + r * 136 + kc) = *(const v4u*)(QC + (size_t)(rb + r) * 768 + h * 128 + kc); }
        __syncthreads();
        { const int rt = w >> 2, vt = w & 3; f32x16 o = {};
          o = mm32<128>(QCl + (rt * 32) * 136, 136, STt + (vt * 32) * 136, 136, o, lane);
#pragma unroll
          for (int r = 0; r < 16; ++r) OB[(rt * 32 + crow(r, hh)) * 128 + vt * 32 + r32] = o[r]; }
        __syncthreads();
#pragma unroll
        for (int ps = 0; ps < 2; ++ps) { const int r = ps * 32 + te, row = rb + r;
            const f32x4 c0 = *(const LAS f32x4*)(OB + r * 128 + k8), c1 = *(const LAS f32x4*)(OB + r * 128 + k8 + 4);
            const float* ol = OL + (size_t)row * 768 + h * 128 + k8; const f32x4 l0 = *(const f32x4*)ol, l1 = *(const f32x4*)(ol + 4);
            const v4u gz = *(const v4u*)(Z + (size_t)row * ZC0 + 2304 + h * 128 + k8);
            float ov[8] = {c0.x + l0.x, c0.y + l0.y, c0.z + l0.z, c0.w + l0.w, c1.x + l1.x, c1.y + l1.y, c1.z + l1.z, c1.w + l1.w}; float s = 0.f;
#pragma unroll
            for (int j = 0; j < 8; ++j) s += ov[j] * ov[j];
            s += __shfl_xor(s, 1); s += __shfl_xor(s, 2); s += __shfl_xor(s, 4); s += __shfl_xor(s, 8);
            const float rs = rsqrtf(s * (1.0f / 128.0f) + EPS);
            const unsigned gw_[4] = {gz.x, gz.y, gz.z, gz.w}; float y[8];
#pragma unroll
            for (int j = 0; j < 8; ++j) { const float gg = bf2f((gw_[j >> 1] >> (16 * (j & 1))) & 0xffffu); y[j] = ov[j] * rs * onv[j] * (gg * sigmoidf_(gg)); }
            v4u o; o.x = pk2(y[0], y[1]); o.y = pk2(y[2], y[3]); o.z = pk2(y[4], y[5]); o.w = pk2(y[6], y[7]); *(v4u*)(MIX + (size_t)row * DM + h * 128 + k8) = o; }
        __syncthreads();
    }
}

__device__ __forceinline__ void memkv_finalize_row(ARGREF a, int layer, int row, int lane) {
    const float* src = (const float*)(a.ws + WS_MEMKV) + (size_t)row * 1024 + layer * 512;
    const int hd = lane >> 4, d4 = (lane & 15) * 4;
    const f32x4 k = *(const f32x4*)(src + hd * 64 + d4), v = *(const f32x4*)(src + 256 + hd * 64 + d4);
    float s = (k.x * k.x + k.y * k.y) + (k.z * k.z + k.w * k.w);
    s += __shfl_xor(s, 1); s += __shfl_xor(s, 2); s += __shfl_xor(s, 4); s += __shfl_xor(s, 8);
    const float rs = rsqrtf(s * (1.0f / 64.0f) + EPS); const f32x4 g = *(const f32x4*)(a.in[22] + layer * 64 + d4);
    *(f32x4*)(a.out + O_MK + ((size_t)layer * 1024 + row) * 256 + hd * 64 + d4) = k * rs * g;
    *(f32x4*)(a.out + O_MV + ((size_t)layer * 1024 + row) * 256 + hd * 64 + d4) = v;
}

__device__ __forceinline__ void memattn_prompt_unit(Ctx& c, ARGREF a, int layer, int u) {
    const int blk = u & 15, hd = (u >> 4) & 3, b = u >> 6;
    const bf16* Z = (const bf16*)(a.ws + WS_Z); const int ldz = layer ? ZC1 : ZC0, qc = layer ? Z1_MQ : 3072;
    const float* kv = (const float*)(a.ws + WS_MEMKV) + (size_t)(b * 256) * 1024 + layer * 512 + hd * 64;
    const int row0 = b * SEQ + blk * 256;
    memattn_unit(c, Z + (size_t)row0 * ldz + qc + hd * 64, ldz, 256, kv, kv + 256, 1024, true, a.in[22] + layer * 64, a.in[21] + layer * 64,
                 (bf16*)(a.ws + WS_MIX) + (size_t)row0 * DM + 768 + hd * 64);
}
__device__ __forceinline__ void memattn_sample_unit(Ctx& c, ARGREF a, int layer, int u) {
    const int hd = u & 3, sb = u >> 2;
    const bf16* Z = (const bf16*)(a.ws + WS_Z); const int ldz = layer ? ZC1 : ZC0, qc = layer ? Z1_MQ : 3072;
    const size_t off = ((size_t)(layer * 32 + sb) * 256) * 256 + hd * 64;
    const int row0 = MP + sb * 4;
    memattn_unit(c, Z + (size_t)row0 * ldz + qc + hd * 64, ldz, 4, a.in[5] + off, a.in[6] + off, 256, false, nullptr, a.in[21] + layer * 64,
                 (bf16*)(a.ws + WS_MIX) + (size_t)row0 * DM + 768 + hd * 64);
}

__device__ __forceinline__ void p2_mixer0(Ctx& c, ARGREF a) {
    constexpr int U_HP = 24 * HG_NG, U_MAP = U_HP + 256, U_HS = U_MAP + 192, U_MAS = U_HS + 128, U_FIN = U_MAS + 256;
    for (;;) {
        const int u = q_next(c, 0);
        if (u >= U_FIN) break;
        if (u < U_HP) hgrn_unit<true>(c, a, u / (6 * HG_NG), (u / HG_NG) % 6, u % HG_NG);
        else if (u < U_MAP) memattn_prompt_unit(c, a, 0, u - U_HP);
        else if (u < U_HS) { const int v = u - U_MAP; hgrn_unit<false>(c, a, v / 6, v % 6, 0); }
        else if (u < U_MAS) memattn_sample_unit(c, a, 0, u - U_HS);
        else { const int v = (u - U_MAS) * 8 + c.wave; memkv_finalize_row(a, v >> 10, v & 1023, c.lane); }
    }
}
__device__ __forceinline__ void p2c_hgrn_fix(Ctx& c, ARGREF a) {
    for (int u = c.vcu; u < 24 * HG_NG; u += c.G) hgrn_fix_unit(c, a, u / (6 * HG_NG), (u / HG_NG) % 6, u % HG_NG);
}

constexpr size_t WS_G4 = WS_UP + 64 * MiB, WS_UP2 = WS_UP + 80 * MiB;
__device__ __forceinline__ void conv_fixup_tile(Ctx& c, ARGREF a, int layer, int pm) {
    const float* G4 = (const float*)(a.ws + WS_G4); const float* UP2 = (const float*)(a.ws + WS_UP2); bf16* ACT = (bf16*)(a.ws + WS_ACT);
    const float* cw = a.in[26] + (size_t)layer * 3 * DFF; const float* cb = a.in[27] + (size_t)layer * DFF;
    for (int idx = c.tid; idx < 8 * (DFF / 4); idx += 512) {
        const int rr = idx / (DFF / 4), c4 = (idx - rr * (DFF / 4)) * 4;
        const int slab = 4 * pm + (rr >> 1), fr = rr & 1, row = slab * 64 + fr, t = row & 4095, sl1 = slab > 0 ? slab - 1 : 0;
        const f32x4 ut = *(const f32x4*)(G4 + (size_t)(slab * 4 + fr) * DFF + c4), up = *(const f32x4*)(UP2 + (size_t)(slab * 2 + fr) * DFF + c4);
        const f32x4 a0 = *(const f32x4*)(G4 + (size_t)(slab * 4 + 0) * DFF + c4), b3 = *(const f32x4*)(G4 + (size_t)(sl1 * 4 + 3) * DFF + c4), b2 = *(const f32x4*)(G4 + (size_t)(sl1 * 4 + 2) * DFF + c4);
        f32x4 u1, u2;
        { const bool f1 = fr == 1, t0 = t == 0, t1 = t == 1;
          u1.x = f1 ? a0.x : (t0 ? 0.f : b3.x); u1.y = f1 ? a0.y : (t0 ? 0.f : b3.y); u1.z = f1 ? a0.z : (t0 ? 0.f : b3.z); u1.w = f1 ? a0.w : (t0 ? 0.f : b3.w);
          u2.x = f1 ? (t1 ? 0.f : b3.x) : (t0 ? 0.f : b2.x); u2.y = f1 ? (t1 ? 0.f : b3.y) : (t0 ? 0.f : b2.y); u2.z = f1 ? (t1 ? 0.f : b3.z) : (t0 ? 0.f : b2.z); u2.w = f1 ? (t1 ? 0.f : b3.w) : (t0 ? 0.f : b2.w); }
        const f32x4 w0 = *(const f32x4*)(cw + c4), w1 = *(const f32x4*)(cw + DFF + c4), w2 = *(const f32x4*)(cw + 2 * DFF + c4), bb = *(const f32x4*)(cb + c4);
        const f32x4 cv = bb + w0 * u2 + w1 * u1 + w2 * ut;
        const float y0 = cv.x * sigmoidf_(cv.x) * up.x, y1 = cv.y * sigmoidf_(cv.y) * up.y, y2 = cv.z * sigmoidf_(cv.z) * up.z, y3 = cv.w * sigmoidf_(cv.w) * up.w;
        *(u64*)(ACT + (size_t)row * DFF + c4) = (u64)pk2(y0, y1) | ((u64)pk2(y2, y3) << 32);
    }
}


struct SgArgs { const bf16* A; const bf16* Bt; int K; int mode; bf16* Z; int ldz; const float* ssin; const float* resid; const bf16* rb; float* y; bf16* xb; float* ssout; bf16* ACT; float* cvs; const float* cst; const float* cw; const float* cb; };
__device__ __forceinline__ void sgemm_unit(Ctx& c, const SgArgs& g, int n0) {
    int tid = c.tid; asm volatile("" : "+v"(tid));
    const int lane = tid & 63, w = c.wave, r32 = lane & 31, hh = lane >> 5;
    const int K = g.K, ks = K >> 3;
    const int f2 = (n0 >> 1) + (r32 & 15), brow = g.mode == 2 ? (f2 >> 7) * 256 + (f2 & 127) + (r32 >= 16 ? 128 : 0) : n0 + r32;
    const bf16* bp = g.Bt + (size_t)brow * K + w * ks + 8 * hh;
    const bf16* ap = g.A + (size_t)r32 * K + w * ks + 8 * hh;
    f32x16 acc[4] = {};
    bf16x8 afA[4][2], bfA[2], afB[4][2], bfB[2];
#define SG_LOAD(AF, BF, kk) do { _Pragma("unroll") for (int i = 0; i < 2; ++i) { BF[i] = *(const bf16x8*)(bp + (kk) + 16 * i); \
        _Pragma("unroll") for (int rt = 0; rt < 4; ++rt) AF[rt][i] = *(const bf16x8*)(ap + (size_t)(rt * 32) * K + (kk) + 16 * i); } } while (0)
#define SG_MMA(AF, BF) do { _Pragma("unroll") for (int i = 0; i < 2; ++i) _Pragma("unroll") for (int rt = 0; rt < 4; ++rt) acc[rt] = __builtin_amdgcn_mfma_f32_32x32x16_bf16(AF[rt][i], BF[i], acc[rt], 0, 0, 0); } while (0)
    SG_LOAD(afA, bfA, 0);
#pragma unroll 1
    for (int k = 0; k < ks; k += 64) {
        if (k + 32 < ks) SG_LOAD(afB, bfB, k + 32);
        SG_MMA(afA, bfA);
        if (k + 32 < ks) { if (k + 64 < ks) SG_LOAD(afA, bfA, k + 64); SG_MMA(afB, bfB); }
    }
#undef SG_LOAD
#undef SG_MMA
    LAS float* RED = (LAS float*)(c.lds);
    __syncthreads();
#pragma unroll
    for (int rt = 0; rt < 4; ++rt)
#pragma unroll
        for (int r = 0; r < 16; ++r) RED[((w * 4 + rt) * 16 + r) * 64 + lane] = acc[rt][r];
    __syncthreads();
    const int rt = w & 3, rh = w >> 2, col = n0 + r32;
    float v[8];
#pragma unroll
    for (int i = 0; i < 8; ++i) { float s = 0.f;
#pragma unroll
        for (int ww = 0; ww < 8; ++ww) s += RED[((ww * 4 + rt) * 16 + 8 * rh + i) * 64 + lane];
        v[i] = s; }
    if (g.mode == 0) {
#pragma unroll
        for (int i = 0; i < 8; ++i) { const int row = MP + rt * 32 + crow(8 * rh + i, hh); const float rs = rsqrtf(g.ssin[row] * (1.0f / DM) + EPS); g.Z[(size_t)row * g.ldz + col] = (bf16)f2bf(v[i] * rs); }
    } else if (g.mode == 1) {
#pragma unroll
        for (int i = 0; i < 8; ++i) { const int lr = rt * 32 + crow(8 * rh + i, hh), row = MP + lr;
            const float x = v[i] + (g.resid ? g.resid[(size_t)lr * DM + col] : bf2f(g.rb[(size_t)row * DM + col]));
            if (g.y) g.y[(size_t)lr * DM + col] = x; if (g.xb) g.xb[(size_t)row * DM + col] = (bf16)f2bf(x);
            float s = x * x; s += __shfl_xor(s, 1); s += __shfl_xor(s, 2); s += __shfl_xor(s, 4); s += __shfl_xor(s, 8); s += __shfl_xor(s, 16);
            if (g.ssout && r32 == 0) atomicAdd(g.ssout + row, s); }
    } else {
        float gu[8], upv[8];
#pragma unroll
        for (int i = 0; i < 8; ++i) { const int row = MP + rt * 32 + crow(8 * rh + i, hh); gu[i] = v[i] * rsqrtf(g.ssin[row] * (1.0f / DM) + EPS); upv[i] = __shfl_xor(gu[i], 16); }
        if (r32 < 16) { const float w0 = g.cw[f2], w1 = g.cw[DFF + f2], w2 = g.cw[2 * DFF + f2], bb = g.cb[f2];
#pragma unroll
            for (int aa = 0; aa < 2; ++aa) { const int lr0 = rt * 32 + 8 * (2 * rh + aa) + 4 * hh, sb = lr0 >> 2;
                const float s0 = g.cst[(size_t)(sb * 2) * DFF + f2], s1 = g.cst[(size_t)(sb * 2 + 1) * DFF + f2];
                const float u0 = gu[4 * aa], u1 = gu[4 * aa + 1], u2 = gu[4 * aa + 2], u3 = gu[4 * aa + 3];
                const float cv[4] = {bb + w0 * s0 + w1 * s1 + w2 * u0, bb + w0 * s1 + w1 * u0 + w2 * u1, bb + w0 * u0 + w1 * u1 + w2 * u2, bb + w0 * u1 + w1 * u2 + w2 * u3};
#pragma unroll
                for (int t = 0; t < 4; ++t) g.ACT[(size_t)(MP + lr0 + t) * DFF + f2] = (bf16)f2bf(cv[t] * sigmoidf_(cv[t]) * upv[4 * aa + t]);
                g.cvs[(size_t)(sb * 2) * DFF + f2] = u2; g.cvs[(size_t)(sb * 2 + 1) * DFF + f2] = u3; } }
    }
}
__device__ __forceinline__ void sgemm_phase(Ctx& c, const SgArgs& g, int N) {
#pragma unroll 1
    for (int u = c.G - 1 - (int)blockIdx.x; u < N / 32; u += c.G) sgemm_unit(c, g, u * 32);
}


__device__ __forceinline__ float wave_sum_f(float x) {
    x += __builtin_bit_cast(float, __builtin_amdgcn_update_dpp(0, __builtin_bit_cast(int, x), 0xB1, 0xF, 0xF, false));
    x += __builtin_bit_cast(float, __builtin_amdgcn_update_dpp(0, __builtin_bit_cast(int, x), 0x4E, 0xF, 0xF, false));
    x += __builtin_bit_cast(float, __builtin_amdgcn_update_dpp(0, __builtin_bit_cast(int, x), 0x141, 0xF, 0xF, false));
    x += __builtin_bit_cast(float, __builtin_amdgcn_update_dpp(0, __builtin_bit_cast(int, x), 0x140, 0xF, 0xF, false));
    const int xi = __builtin_bit_cast(int, x);
    return (__builtin_bit_cast(float, __builtin_amdgcn_readlane(xi, 0)) + __builtin_bit_cast(float, __builtin_amdgcn_readlane(xi, 16))) +
           (__builtin_bit_cast(float, __builtin_amdgcn_readlane(xi, 32)) + __builtin_bit_cast(float, __builtin_amdgcn_readlane(xi, 48)));
}
__device__ __forceinline__ void dsa_post_row(ARGREF a, int row, int lane_) {
    int lane = lane_; asm volatile("" : "+v"(lane));
    const bf16* z = (const bf16*)(a.ws + WS_Z) + (size_t)row * ZC1;
    const bool smp = row >= MP; const int b = smp ? (row - MP) >> 2 : row >> 12, t = smp ? (row - MP) & 3 : row & 4095;
    const float pos = (float)(smp ? PAST + t : t);
    const int i = lane & 31;
    float x1[8], x2[8], q1[4], q2[4], k1 = 0.f, k2 = 0.f;
#pragma unroll
    for (int hd = 0; hd < 8; ++hd) { x1[hd] = bf2f(z[hd * 128 + lane]); x2[hd] = bf2f(z[hd * 128 + 64 + lane]); }
    const u64 vv = *(const u64*)(z + Z1_V + 4 * lane);
#pragma unroll
    for (int p = 0; p < 4; ++p) { const int hd = 2 * p + (lane >> 5); q1[p] = bf2f(z[Z1_IQ + hd * 64 + i]); q2[p] = bf2f(z[Z1_IQ + hd * 64 + 32 + i]); }
    if (lane < 32) { k1 = bf2f(z[Z1_IK + i]); k2 = bf2f(z[Z1_IK + 32 + i]); }
    const float wraw = bf2f(z[Z1_IW + (lane & 7)]);
    float c128, s128, c64, s64;
    { const float r1 = pos * (exp2f(-(float)lane * (13.287712379549449f / 64.0f)) * 0.15915494309189535f), f1 = r1 - floorf(r1); s128 = __builtin_amdgcn_sinf(f1); c128 = __builtin_amdgcn_cosf(f1);
      const float r2 = pos * (exp2f(-(float)i * (13.287712379549449f / 32.0f)) * 0.15915494309189535f), f2 = r2 - floorf(r2); s64 = __builtin_amdgcn_sinf(f2); c64 = __builtin_amdgcn_cosf(f2); }
#pragma unroll
    for (int hd = 0; hd < 8; ++hd) {
        const float rs = rsqrtf(wave_sum_f(x1[hd] * x1[hd] + x2[hd] * x2[hd]) * (1.0f / 128.0f) + EPS);
        const float* gn = hd < 6 ? a.in[17] : a.in[18];
        const float y1 = x1[hd] * rs * gn[lane], y2 = x2[hd] * rs * gn[64 + lane];
        const float o1 = y1 * c128 - y2 * s128, o2 = y2 * c128 + y1 * s128;
        if (hd < 6) {
            if (smp) { float* q = (float*)(a.ws + WS_SQ) + (size_t)(row - MP) * 768 + hd * 128; q[lane] = o1; q[64 + lane] = o2; }
            else { bf16* q = (bf16*)(a.ws + WS_QB) + ((size_t)(b * 6 + hd) * SEQ + t) * 128; q[lane] = (bf16)f2bf(o1); q[64 + lane] = (bf16)f2bf(o2); }
        } else {
            const int kvh = hd - 6;
            float* ko = smp ? a.out + O_KS + (size_t)(row - MP) * 256 + kvh * 128 : a.out + O_KP + (size_t)row * 256 + kvh * 128;
            ko[lane] = o1; ko[64 + lane] = o2;
            if (!smp) { bf16* kb = (bf16*)(a.ws + WS_KB) + ((size_t)(b * 2 + kvh) * SEQ + t) * 128; kb[lane] = (bf16)f2bf(o1); kb[64 + lane] = (bf16)f2bf(o2); }
        }
    }
    {
        const f32x4 v = {bf2f((unsigned)vv & 0xffffu), bf2f(((unsigned)vv) >> 16), bf2f((unsigned)(vv >> 32) & 0xffffu), bf2f((unsigned)(vv >> 48))};
        float* vo = smp ? a.out + O_VS + (size_t)(row - MP) * 256 : a.out + O_VP + (size_t)row * 256;
        *(f32x4*)(vo + 4 * lane) = v;
        if (!smp) { const int kvh = lane >> 5, d = (lane & 31) * 4; *(u64*)((bf16*)(a.ws + WS_VB) + ((size_t)(b * 2 + kvh) * SEQ + t) * 128 + d) = vv; }
    }
    {
#pragma unroll
        for (int p = 0; p < 4; ++p) { const int hd = 2 * p + (lane >> 5);
            const float o1 = q1[p] * c64 - q2[p] * s64, o2 = q2[p] * c64 + q1[p] * s64;
            if (smp) { float* q = (float*)(a.ws + WS_SIQ) + (size_t)(row - MP) * 512 + hd * 64; q[i] = o1; q[32 + i] = o2; }
            else { bf16* q = (bf16*)(a.ws + WS_IQB) + (size_t)row * 512 + hd * 64; q[i] = (bf16)f2bf(o1); q[32 + i] = (bf16)f2bf(o2); } }
        const float rs = rsqrtf(wave_sum_f(k1 * k1 + k2 * k2) * (1.0f / 64.0f) + EPS);
        const float y1 = k1 * rs * a.in[19][i], y2 = k2 * rs * a.in[19][32 + i];
        const float o1 = y1 * c64 - y2 * s64, o2 = y2 * c64 + y1 * s64;
        if (lane < 32) {
            float* ko = smp ? a.out + O_IKS + (size_t)(row - MP) * 64 : a.out + O_IKP + (size_t)row * 64; ko[i] = o1; ko[32 + i] = o2;
            if (!smp) { bf16* kb = (bf16*)(a.ws + WS_IKB) + (size_t)row * 64; kb[i] = (bf16)f2bf(o1); kb[32 + i] = (bf16)f2bf(o2); } }
        if (lane < 8) { const float wv = wraw * (0.35355339059327373f * 0.125f);
            if (smp) ((float*)(a.ws + WS_SIW))[(row - MP) * 8 + lane] = wv; else ((float*)(a.ws + WS_IW))[(size_t)row * 8 + lane] = wv; }
    }
}
__device__ __forceinline__ void p8_dsa_post(Ctx& c, ARGREF a) {
    for (;;) { const int u = q_next(c, 1); if (u >= 384) break; if (u < 256) memattn_prompt_unit(c, a, 1, u); else memattn_sample_unit(c, a, 1, u - 256); }
    const int gw = c.vcu * NWAVES + c.wave, NGW = c.G * NWAVES;
    for (int row = gw; row < MVALID; row += NGW) dsa_post_row(a, row, c.lane);
}

__device__ __forceinline__ void idx_prompt_unit(Ctx& c, ARGREF a, int b, int qb) {
    int tid = c.tid; asm volatile("" : "+v"(tid));
    const int lane = tid & 63, r32 = lane & 31, hh = lane >> 5, w = c.wave;
    const int q0 = b * SEQ + qb * 32;
    LAS bf16* IQL = (LAS bf16*)(c.lds);
    { const bf16* src = (const bf16*)(a.ws + WS_IQB) + (size_t)q0 * 512;
#pragma unroll
      for (int i = 0; i < 4; ++i) { const int row = tid >> 4, ch = (tid & 15) + 16 * i; *(LAS v4u*)(IQL + row * 520 + ch * 8) = *(const v4u*)(src + (size_t)row * 512 + ch * 8); } }
    __syncthreads();
    const bf16* IK = (const bf16*)(a.ws + WS_IKB) + (size_t)(b * SEQ) * 64 + (size_t)r32 * 64 + 8 * hh;
    float* SC = (float*)(a.ws + WS_SC) + (size_t)(q0 + r32) * SEQ;
    float wv[8];
#pragma unroll
    for (int h = 0; h < 8; ++h) wv[h] = ((const float*)(a.ws + WS_IW))[(size_t)(q0 + r32) * 8 + h];
    bf16x8 ak[4], an[4];
    if (w <= qb) {
#pragma unroll
        for (int ks = 0; ks < 4; ++ks) ak[ks] = *(const bf16x8*)(IK + (size_t)(w * 32) * 64 + ks * 16); }
#pragma unroll 1
    for (int kt = w; kt <= qb; kt += 8) {
        if (kt + 8 <= qb) {
#pragma unroll
            for (int ks = 0; ks < 4; ++ks) an[ks] = *(const bf16x8*)(IK + (size_t)((kt + 8) * 32) * 64 + ks * 16); }
        f32x16 sc = {};
        int qoff = r32 * 520 + 8 * hh; asm volatile("" : "+v"(qoff));
#pragma unroll
        for (int h = 0; h < 8; ++h) { f32x16 d = {};
#pragma unroll
            for (int ks = 0; ks < 4; ++ks) d = __builtin_amdgcn_mfma_f32_32x32x16_bf16(ak[ks], *(const LAS bf16x8*)(IQL + qoff + h * 64 + ks * 16), d, 0, 0, 0);
#pragma unroll
            for (int r = 0; r < 16; ++r) sc[r] = fmaf(wv[h], fmaxf(d[r], 0.f), sc[r]); }
#pragma unroll
        for (int g = 0; g < 4; ++g) *(f32x4*)(SC + kt * 32 + 8 * g + 4 * hh) = (f32x4){sc[4 * g], sc[4 * g + 1], sc[4 * g + 2], sc[4 * g + 3]};
#pragma unroll
        for (int ks = 0; ks < 4; ++ks) ak[ks] = an[ks];
    }
}
__device__ __forceinline__ v4u pack8f(const float* p) { const f32x4 x = *(const f32x4*)p, y = *(const f32x4*)(p + 4); v4u o; o.x = pk2(x.x, x.y); o.y = pk2(x.z, x.w); o.z = pk2(y.x, y.y); o.w = pk2(y.z, y.w); return o; }
__device__ __forceinline__ void idx_sample_tile(ARGREF a, int sb, int tl, int lane_) {
    int lane = lane_; asm volatile("" : "+v"(lane));
    const int r32 = lane & 31, hh = lane >> 5, tk = r32 >> 3, hd = r32 & 7;
    const float* iq = (const float*)(a.ws + WS_SIQ) + (size_t)(sb * 4 + tk) * 512 + hd * 64 + 8 * hh;
    const float wv = ((const float*)(a.ws + WS_SIW))[(sb * 4 + tk) * 8 + hd];
    const float* src;
    if (tl < 256) src = a.in[4] + ((size_t)a.page_table[sb * 64 + (tl >> 2)] * 128 + (tl & 3) * 32 + r32) * 64 + 8 * hh;
    else src = a.out + O_IKS + (size_t)(sb * 4 + (r32 & 3)) * 64 + 8 * hh;
    v4u af[4], bf_[4];
#pragma unroll
    for (int ks = 0; ks < 4; ++ks) { af[ks] = pack8f(src + 16 * ks); bf_[ks] = pack8f(iq + 16 * ks); }
    if (tl == 256 && r32 >= 4) {
#pragma unroll
        for (int ks = 0; ks < 4; ++ks) af[ks] = (v4u){0u, 0u, 0u, 0u}; }
    f32x16 d = {};
#pragma unroll
    for (int ks = 0; ks < 4; ++ks) d = __builtin_amdgcn_mfma_f32_32x32x16_bf16(__builtin_bit_cast(bf16x8, af[ks]), __builtin_bit_cast(bf16x8, bf_[ks]), d, 0, 0, 0);
    float* dst = (float*)(a.ws + WS_SSC) + (size_t)(sb * 4 + tk) * SSC_LD + tl * 32;
#pragma unroll
    for (int r = 0; r < 16; ++r) { float v = wv * fmaxf(d[r], 0.f);
        v += __builtin_bit_cast(float, __builtin_amdgcn_update_dpp(0, __builtin_bit_cast(int, v), 0xB1, 0xF, 0xF, false));
        v += __builtin_bit_cast(float, __builtin_amdgcn_update_dpp(0, __builtin_bit_cast(int, v), 0x4E, 0xF, 0xF, false));
        v += __builtin_bit_cast(float, __builtin_amdgcn_update_dpp(0, __builtin_bit_cast(int, v), 0x141, 0xF, 0xF, false));
        if (hd == 0) dst[crow(r, hh)] = v; }
}
__device__ __forceinline__ void p9_indexer(Ctx& c, ARGREF a) {
    const int gw = c.vcu * NWAVES + c.wave, NGW = c.G * NWAVES;
#pragma unroll 1
    for (int wt = gw; wt < 32 * 257; wt += NGW) idx_sample_tile(a, wt / 257, wt % 257, c.lane);
    for (;;) { const int u = q_next(c, 2); if (u >= 512) break; idx_prompt_unit(c, a, u & 3, 127 - (u >> 2)); }
}


__device__ __forceinline__ unsigned fkey(float f) { const unsigned u = __builtin_bit_cast(unsigned, f + 0.0f); return (u & 0x80000000u) ? ~u : (u | 0x80000000u); }
__device__ __forceinline__ void acc_ge(int& cnt, unsigned key, unsigned cand) { asm volatile("v_cmp_le_u32_e32 vcc, %1, %2\n\tv_addc_co_u32_e32 %0, vcc, 0, %0, vcc" : "+v"(cnt) : "s"(cand), "v"(key) : "vcc"); }
__device__ __forceinline__ void acc_ge4(int& c0, int& c1, int& c2, int& c3, unsigned k0, unsigned k1, unsigned k2, unsigned k3, unsigned cand) {
    u64 m0, m1, m2, m3;
    asm volatile("v_cmp_le_u32_e64 %4, %8, %9\n\tv_cmp_le_u32_e64 %5, %8, %10\n\tv_cmp_le_u32_e64 %6, %8, %11\n\tv_cmp_le_u32_e64 %7, %8, %12\n\t"
                 "v_addc_co_u32_e64 %0, %4, 0, %0, %4\n\tv_addc_co_u32_e64 %1, %5, 0, %1, %5\n\tv_addc_co_u32_e64 %2, %6, 0, %2, %6\n\tv_addc_co_u32_e64 %3, %7, 0, %3, %7"
                 : "+v"(c0), "+v"(c1), "+v"(c2), "+v"(c3), "=&s"(m0), "=&s"(m1), "=&s"(m2), "=&s"(m3) : "s"(cand), "v"(k0), "v"(k1), "v"(k2), "v"(k3));
}
__device__ __forceinline__ u64 ballot_nz(unsigned v) { u64 m; asm volatile("v_cmp_ne_u32_e64 %0, 0, %1" : "=s"(m) : "v"(v)); return m; }
__device__ __forceinline__ int wave_sum_dpp(int x) {
    x += __builtin_amdgcn_update_dpp(0, x, 0xB1, 0xF, 0xF, false);
    x += __builtin_amdgcn_update_dpp(0, x, 0x4E, 0xF, 0xF, false);
    x += __builtin_amdgcn_update_dpp(0, x, 0x141, 0xF, 0xF, false);
    x += __builtin_amdgcn_update_dpp(0, x, 0x140, 0xF, 0xF, false);
    return (__builtin_amdgcn_readlane(x, 0) + __builtin_amdgcn_readlane(x, 16)) + (__builtin_amdgcn_readlane(x, 32) + __builtin_amdgcn_readlane(x, 48));
}
__device__ __forceinline__ int mbcnt64(u64 m) { return (int)__builtin_amdgcn_mbcnt_hi((unsigned)(m >> 32), __builtin_amdgcn_mbcnt_lo((unsigned)m, 0u)); }
constexpr int TK_LOWBITS = 18;
__device__ __forceinline__ void topk_finish(unsigned ck, int cp, int A, int posmax, unsigned& T, int& P) {
#pragma unroll 1
    for (int bit = TK_LOWBITS - 1; bit >= 0; --bit) { const unsigned cand = T | (1u << bit); if (A + __builtin_popcountll(__ballot(ck >= cand)) >= 256) T = cand; }
    const int need = 256 - (A + __builtin_popcountll(__ballot(ck > T))), ceq = __builtin_popcountll(__ballot(ck == T));
    P = posmax;
    if (ceq != need) { P = 0;
#pragma unroll 1
        for (int bit = 13; bit >= 0; --bit) { const int cand = P | (1 << bit); if (__builtin_popcountll(__ballot(ck == T && cp < cand)) < need) P = cand; } }
}
__device__ __forceinline__ unsigned wave_min_u(unsigned x) {
    x = min(x, (unsigned)__builtin_amdgcn_update_dpp(0, (int)x, 0xB1, 0xF, 0xF, false)); x = min(x, (unsigned)__builtin_amdgcn_update_dpp(0, (int)x, 0x4E, 0xF, 0xF, false));
    x = min(x, (unsigned)__builtin_amdgcn_update_dpp(0, (int)x, 0x141, 0xF, 0xF, false)); x = min(x, (unsigned)__builtin_amdgcn_update_dpp(0, (int)x, 0x140, 0xF, 0xF, false));
    return min(min((unsigned)__builtin_amdgcn_readlane((int)x, 0), (unsigned)__builtin_amdgcn_readlane((int)x, 16)), min((unsigned)__builtin_amdgcn_readlane((int)x, 32), (unsigned)__builtin_amdgcn_readlane((int)x, 48)));
}
__device__ __forceinline__ unsigned wave_max_u(unsigned x) {
    x = max(x, (unsigned)__builtin_amdgcn_update_dpp(0, (int)x, 0xB1, 0xF, 0xF, false)); x = max(x, (unsigned)__builtin_amdgcn_update_dpp(0, (int)x, 0x4E, 0xF, 0xF, false));
    x = max(x, (unsigned)__builtin_amdgcn_update_dpp(0, (int)x, 0x141, 0xF, 0xF, false)); x = max(x, (unsigned)__builtin_amdgcn_update_dpp(0, (int)x, 0x140, 0xF, 0xF, false));
    return max(max((unsigned)__builtin_amdgcn_readlane((int)x, 0), (unsigned)__builtin_amdgcn_readlane((int)x, 16)), max((unsigned)__builtin_amdgcn_readlane((int)x, 32), (unsigned)__builtin_amdgcn_readlane((int)x, 48)));
}
__device__ __forceinline__ void topk_prompt_rows(ARGREF a, int row0, int stride, int lane_, LAS unsigned* cl) {
    int lane = lane_; asm volatile("" : "+v"(lane));
    const float* SCb = (const float*)(a.ws + WS_SC);
#pragma unroll 1
    for (int row = row0; row < MP; row += stride) {
        const int t = row & 4095;
        u64* mk = (u64*)(a.ws + WS_MASK) + (size_t)row * 64;
        if (t < 256) { u64 myword = 0ull;
#pragma unroll 1
            for (int j = 0; j < 64; ++j) { const u64 m = __ballot(64 * j + lane <= t); if (lane == j) myword = m; }
            mk[lane] = myword;
            continue; }
        unsigned key[64];
        { const float* sc_ = SCb + (size_t)row * SEQ + lane; const int tj_ = t >> 6;
          float v[64];
#pragma unroll
          for (int j = 0; j < 64; ++j) v[j] = sc_[64 * (j < tj_ ? j : tj_)];
          int pj = lane;
#pragma unroll
          for (int j = 0; j < 64; ++j) { const int u = __builtin_bit_cast(int, v[j] + 0.0f); const unsigned k = (unsigned)u ^ ((unsigned)(u >> 31) | 0x80000000u); key[j] = (pj <= t) ? k : 0u; pj += 64; asm volatile("" : "+v"(pj)); } }
        unsigned kh[64];
#pragma unroll
        for (int j = 0; j < 64; ++j) { kh[j] = key[j] >> 1; asm volatile("" : "+v"(kh[j])); }
        unsigned T; int hb;
        {
            unsigned b0 = 0u, b1 = 0u, b2 = 0u, b3 = 0u;
#pragma unroll
            for (int j = 0; j < 64; ++j) { unsigned x = key[j]; const unsigned m0 = max(b0, x); x = min(b0, x); b0 = m0; const unsigned m1 = max(b1, x); x = min(b1, x); b1 = m1; const unsigned m2 = max(b2, x); x = min(b2, x); b2 = m2; b3 = max(b3, x); }
            const unsigned L = wave_min_u(b3), H = wave_max_u(b3), df = L ^ H;
            hb = df ? 31 - __builtin_clz(df) : -1;
            T = hb >= 31 ? 0u : (L & ~((2u << (hb < 0 ? 0 : hb)) - 1u)); if (hb < 0) T = L;
        }
#define TK_FULLCOUNT(CAND, OUT) do { const unsigned cs_ = __builtin_amdgcn_readfirstlane(CAND); int c0_ = 0, c1_ = 0, c2_ = 0, c3_ = 0; \
        _Pragma("unroll") for (int j = 0; j < 64; j += 4) acc_ge4(c0_, c1_, c2_, c3_, key[j], key[j + 1], key[j + 2], key[j + 3], cs_); OUT = wave_sum_dpp((c0_ + c1_) + (c2_ + c3_)); } while (0)
#define TK_FASTCOUNT(CAND, OUT) do { const unsigned ch_ = __builtin_amdgcn_readfirstlane((CAND) >> 1); unsigned a0_ = 0u, a1_ = 0u, a2_ = 0u, a3_ = 0u; \
        _Pragma("unroll") for (int j = 0; j < 64; j += 4) { a0_ = __builtin_amdgcn_alignbit(a0_, kh[j] - ch_, 31); a1_ = __builtin_amdgcn_alignbit(a1_, kh[j + 1] - ch_, 31); \
            a2_ = __builtin_amdgcn_alignbit(a2_, kh[j + 2] - ch_, 31); a3_ = __builtin_amdgcn_alignbit(a3_, kh[j + 3] - ch_, 31); } \
        OUT = 4096 - wave_sum_dpp((__builtin_popcount(a0_) + __builtin_popcount(a1_)) + (__builtin_popcount(a2_) + __builtin_popcount(a3_))); } while (0)
#pragma unroll 1
        for (int bit = hb; bit >= TK_LOWBITS; --bit) { const unsigned cand = T | (1u << bit); int tot; TK_FASTCOUNT(cand, tot); if (tot >= 256) T = cand; }
        const unsigned Tb = T & ~((1u << TK_LOWBITS) - 1u), hib = Tb + (1u << TK_LOWBITS);
        int A = 0, cT; if (hib != 0u) TK_FASTCOUNT(hib, A); TK_FASTCOUNT(Tb, cT);
#undef TK_FASTCOUNT
        int P;
        if (cT - A <= 64) {
            if (lane == 0) cl[128] = 0u;
            int pj = lane;
#pragma unroll
            for (int j = 0; j < 64; ++j) { if ((key[j] - Tb) < (1u << TK_LOWBITS)) { const unsigned pos = __hip_atomic_fetch_add(cl + 128, 1u, __ATOMIC_RELAXED, __HIP_MEMORY_SCOPE_WORKGROUP); if (pos < 64u) { cl[pos] = key[j]; cl[64 + pos] = (unsigned)pj; } }
                pj += 64; asm volatile("" : "+v"(pj)); }
            const int nund = cT - A;
            const unsigned ck = lane < nund ? cl[lane] : 0u; const int cp = (int)cl[64 + lane];
            topk_finish(ck, cp, A, 4095, T, P);
        } else {
#pragma unroll 1
            for (int bit = TK_LOWBITS - 1; bit >= 0; --bit) { const unsigned cand = T | (1u << bit); int tot; TK_FULLCOUNT(cand, tot); if (tot >= 256) T = cand; }
            int cge, cgt; TK_FULLCOUNT(T, cge); cgt = 0; if (T != 0xffffffffu) TK_FULLCOUNT(T + 1u, cgt);
            const int need = 256 - cgt, ceq = cge - cgt; P = 4095;
            if (ceq != need) { P = 0;
#pragma unroll 1
                for (int bit = 11; bit >= 0; --bit) { const int cand = P | (1 << bit); int cnt = 0; int pj = lane;
#pragma unroll
                    for (int j = 0; j < 64; ++j) { cnt += (key[j] == T && pj < cand) ? 1 : 0; pj += 64; asm volatile("" : "+v"(pj)); }
                    if (wave_sum_dpp(cnt) < need) P = cand; } }
        }
#undef TK_FULLCOUNT
        if (P != 4095) {
            int pq = lane;
#pragma unroll
            for (int j = 0; j < 64; ++j) { if (key[j] == T && pq > P) key[j] = 0u; pq += 64; asm volatile("" : "+v"(pq)); } }
        unsigned wlo = 0u, whi = 0u; const unsigned Ts = __builtin_amdgcn_readfirstlane(T);
#pragma unroll
        for (int j = 0; j < 64; ++j) asm volatile("v_cmp_le_u32_e32 vcc, %2, %3\n\ts_nop 3\n\tv_writelane_b32 %0, vcc_lo, %4\n\tv_writelane_b32 %1, vcc_hi, %4" : "+v"(wlo), "+v"(whi) : "s"(Ts), "v"(key[j]), "i"(j) : "vcc");
        mk[lane] = ((u64)whi << 32) | (u64)wlo;
    }
}
__device__ __forceinline__ void topk_sample_row(ARGREF a, int q, int lane_, LAS unsigned* K, LAS unsigned* cl) {
    int lane = lane_; asm volatile("" : "+v"(lane));
    const int t = q & 3, n = PAST + t + 1; const float* sc = (const float*)(a.ws + WS_SSC) + (size_t)q * SSC_LD;
    int* out = (int*)(a.ws + WS_SIDX) + q * 256;
    unsigned key[129];
#pragma unroll
    for (int j = 0; j < 129; ++j) { const float v = sc[64 * j + lane]; key[j] = (j < 128 || lane < n - 8192) ? fkey(v) : 0u; }
#pragma unroll
    for (int j = 0; j < 129; ++j) K[64 * j + lane] = key[j];
#define TK_FULLCOUNT(CAND, OUT) do { const unsigned cs_ = __builtin_amdgcn_readfirstlane(CAND); int c0_ = 0, c1_ = 0, c2_ = 0, c3_ = 0; \
        _Pragma("unroll") for (int j = 0; j < 128; j += 4) acc_ge4(c0_, c1_, c2_, c3_, key[j], key[j + 1], key[j + 2], key[j + 3], cs_); acc_ge(c0_, key[128], cs_); OUT = wave_sum_dpp((c0_ + c1_) + (c2_ + c3_)); } while (0)
    unsigned T = 0u;
#pragma unroll 1
    for (int bit = 31; bit >= TK_LOWBITS; --bit) { const unsigned cand = T | (1u << bit); int tot; TK_FULLCOUNT(cand, tot); if (tot >= 256) T = cand; }
    const unsigned hib = T + (1u << TK_LOWBITS);
    int A = 0, cT; if (hib != 0u) TK_FULLCOUNT(hib, A); TK_FULLCOUNT(T, cT);
    int P;
    if (cT - A <= 64) {
        int base = 0;
#pragma unroll 1
        for (int j0 = 0; j0 < 128; j0 += 8) { unsigned kk[8];
#pragma unroll
            for (int i = 0; i < 8; ++i) kk[i] = K[64 * (j0 + i) + lane];
#pragma unroll
            for (int i = 0; i < 8; ++i) { const unsigned und = (kk[i] - T) < (1u << TK_LOWBITS) ? 1u : 0u; const u64 m = ballot_nz(und); const int pos = base + mbcnt64(m);
                if (und) { cl[pos] = kk[i]; cl[64 + pos] = (unsigned)(64 * (j0 + i) + lane); }
                base += __builtin_popcountll(m); } }
        { const unsigned kj = K[64 * 128 + lane]; const unsigned und = (kj - T) < (1u << TK_LOWBITS) ? 1u : 0u; const u64 m = ballot_nz(und); const int pos = base + mbcnt64(m);
          if (und) { cl[pos] = kj; cl[64 + pos] = (unsigned)(64 * 128 + lane); } base += __builtin_popcountll(m); }
        const unsigned ck = lane < base ? cl[lane] : 0u; const int cp = (int)cl[64 + lane];
        topk_finish(ck, cp, A, 16383, T, P);
    } else {
#pragma unroll 1
        for (int bit = TK_LOWBITS - 1; bit >= 0; --bit) { const unsigned cand = T | (1u << bit); int tot; TK_FULLCOUNT(cand, tot); if (tot >= 256) T = cand; }
        int cge, cgt; TK_FULLCOUNT(T, cge); cgt = 0; if (T != 0xffffffffu) TK_FULLCOUNT(T + 1u, cgt);
        const int need = 256 - cgt, ceq = cge - cgt; P = 16383;
        if (ceq != need) { P = 0;
#pragma unroll 1
            for (int bit = 13; bit >= 0; --bit) { const int cand = P | (1 << bit); int cnt = 0;
#pragma unroll 4
                for (int j = 0; j < 129; ++j) cnt += (K[64 * j + lane] == T && 64 * j + lane < cand) ? 1 : 0;
                if (wave_sum_dpp(cnt) < need) P = cand; } }
    }
#undef TK_FULLCOUNT
    int base = 0;
#pragma unroll 1
    for (int j0 = 0; j0 < 136; j0 += 8) { unsigned kk[8];
#pragma unroll
        for (int i = 0; i < 8; ++i) kk[i] = (j0 + i < 129) ? K[64 * (j0 + i) + lane] : 0u;
#pragma unroll
        for (int i = 0; i < 8; ++i) { const int ps = 64 * (j0 + i) + lane; const unsigned selv = (kk[i] > T || (kk[i] == T && ps <= P)) ? 1u : 0u; const u64 m = ballot_nz(selv);
            const int pos = base + mbcnt64(m);
            if (selv && pos < 256) out[pos] = ps;
            base += __builtin_popcountll(m); } }
}
__device__ __forceinline__ void p10_topk(Ctx& c, ARGREF a) {
    const int gw = c.vcu * NWAVES + c.wave, NGW = c.G * NWAVES;
    LAS unsigned* cl = (LAS unsigned*)(c.lds) + c.wave * 192;
    if (c.wave == 0 && c.vcu < MS) topk_sample_row(a, c.vcu, c.lane, (LAS unsigned*)(c.lds + 8192), cl);
    topk_prompt_rows(a, gw, NGW, c.lane, cl);
}


__device__ __forceinline__ void attn_sample_unit(Ctx& c, ARGREF a, int sb, int t) {
    LAS bf16* KV = (LAS bf16*)(c.lds);
    LAS float* QL = (LAS float*)(c.lds + 69632);
    LAS float* SL = (LAS float*)(c.lds + 69632 + 3072);
    LAS float* OL = (LAS float*)(c.lds + 69632 + 6144);
    LAS int* IL = (LAS int*)(c.lds + 69632 + 12288);
    LAS unsigned* OFFL = (LAS unsigned*)(c.lds + 69632 + 12288 + 1024);
    int tid = c.tid; asm volatile("" : "+v"(tid));
    const int lane = tid & 63, w = c.wave, q = sb * 4 + t;
    __syncthreads();
    if (tid < 256) IL[tid] = ((const int*)(a.ws + WS_SIDX))[q * 256 + tid];
    for (int i = tid; i < 768; i += 512) QL[i] = ((const float*)(a.ws + WS_SQ))[(size_t)q * 768 + i];
    __syncthreads();
    if (tid < 256) { const int idx = IL[tid];
        OFFL[tid] = idx < PAST ? (unsigned)(((a.page_table[sb * 64 + (idx >> 7)] * 128 + (idx & 127)) * 2) * 128) : (0x80000000u | (unsigned)((sb * 4 + (idx - PAST)) * 256)); }
    __syncthreads();
    bf16* MIX = (bf16*)(a.ws + WS_MIX) + (size_t)(MP + q) * DM;
#pragma unroll 1
    for (int kvh = 0; kvh < 2; ++kvh) {
#pragma unroll 1
        for (int pass = 0; pass < 2; ++pass) {
            const float* pool = pass ? a.in[3] : a.in[2]; const float* nw = a.out + (pass ? O_VS : O_KS);
            { f32x4 gv[16];
#pragma unroll
              for (int r = 0; r < 16; ++r) { const int i = (tid >> 5) + 16 * r; const unsigned off = OFFL[i]; const float* src = (off & 0x80000000u) ? nw + (size_t)(off & 0x7fffffffu) : pool + (size_t)off;
                  gv[r] = *(const f32x4*)(src + kvh * 128 + (tid & 31) * 4); }
#pragma unroll
              for (int r = 0; r < 16; ++r) { const int i = (tid >> 5) + 16 * r; *(LAS u64*)(KV + i * 136 + (tid & 31) * 4) = (u64)pk2(gv[r].x, gv[r].y) | ((u64)pk2(gv[r].z, gv[r].w) << 32); } }
            __syncthreads();
            if (pass == 0) {
                const int i = tid >> 1, dh = (tid & 1) * 64; float s0 = 0.f, s1 = 0.f, s2 = 0.f;
#pragma unroll 8
                for (int d = 0; d < 64; ++d) { const float kx = bf2f(KV[i * 136 + dh + d]);
                    s0 = fmaf(QL[(3 * kvh + 0) * 128 + dh + d], kx, s0); s1 = fmaf(QL[(3 * kvh + 1) * 128 + dh + d], kx, s1); s2 = fmaf(QL[(3 * kvh + 2) * 128 + dh + d], kx, s2); }
                s0 += __shfl_xor(s0, 1); s1 += __shfl_xor(s1, 1); s2 += __shfl_xor(s2, 1);
                if ((tid & 1) == 0) { SL[i] = s0 * 0.08838834764831845f; SL[256 + i] = s1 * 0.08838834764831845f; SL[512 + i] = s2 * 0.08838834764831845f; }
                __syncthreads();
                if (w < 3) { float v[4], mx = -1e30f;
#pragma unroll
                    for (int j = 0; j < 4; ++j) { v[j] = SL[w * 256 + 64 * j + lane]; mx = fmaxf(mx, v[j]); }
#pragma unroll
                    for (int o = 1; o < 64; o <<= 1) mx = fmaxf(mx, __shfl_xor(mx, o));
                    float l = 0.f;
#pragma unroll
                    for (int j = 0; j < 4; ++j) { v[j] = __expf(v[j] - mx); l += v[j]; }
                    l = wave_sum(l); const float il = 1.0f / l;
#pragma unroll
                    for (int j = 0; j < 4; ++j) SL[w * 256 + 64 * j + lane] = v[j] * il; }
                __syncthreads();
            } else {
                const int d = tid & 127, part = tid >> 7; float o0 = 0.f, o1 = 0.f, o2 = 0.f;
#pragma unroll 8
                for (int i = part * 64; i < part * 64 + 64; ++i) { const float vx = bf2f(KV[i * 136 + d]); o0 = fmaf(SL[i], vx, o0); o1 = fmaf(SL[256 + i], vx, o1); o2 = fmaf(SL[512 + i], vx, o2); }
                OL[(part * 3 + 0) * 128 + d] = o0; OL[(part * 3 + 1) * 128 + d] = o1; OL[(part * 3 + 2) * 128 + d] = o2;
                __syncthreads();
                if (tid < 384) { const int hq = tid >> 7, dd = tid & 127; const float o = (OL[hq * 128 + dd] + OL[(3 + hq) * 128 + dd]) + (OL[(6 + hq) * 128 + dd] + OL[(9 + hq) * 128 + dd]);
                    MIX[(3 * kvh + hq) * 128 + dd] = (bf16)f2bf(o); }
                __syncthreads();
            }
        }
    }
}


namespace attn {
using bf16 = unsigned short;
typedef short bf16x8 __attribute__((ext_vector_type(8)));
typedef short s16x4 __attribute__((ext_vector_type(4)));
typedef float f32x16 __attribute__((ext_vector_type(16)));
typedef float f32x4 __attribute__((ext_vector_type(4)));
typedef unsigned u32x4 __attribute__((ext_vector_type(4)));
typedef unsigned u32x2 __attribute__((ext_vector_type(2)));
constexpr int D = 128, OS = 1024;
constexpr float THR = 8.f;
constexpr float SCALE = 0.08838834764831845f;
constexpr int NW = 8, QBLK = 32, KVBLK = 64, QB = NW * QBLK;
constexpr int SHM_V = KVBLK * D * 2, SHM_K = KVBLK * D * 2;
constexpr int LDS_BYTES = 2 * SHM_V + 2 * SHM_K + NW * 64 * 4;

#define KSWZ(row, colB) ((row) * 256 + ((colB) ^ (((row) & 7) << 4)))
#define SBAR() __builtin_amdgcn_sched_barrier(0)
__device__ __forceinline__ int v_st(int k, int c) { const int kk = (k & ~0xC) | ((k & 4) << 1) | ((k & 8) >> 1); return ((kk >> 3) * 4 + (c >> 5)) * 512 + ((kk & 7) * 32 + (c & 31)) * 2; }
__device__ __forceinline__ int v_rd_base(int lane) { return ((lane & 3) << 3) | (((lane >> 2) & 3) << 6) | (((lane >> 4) & 1) << 5) | (((lane >> 5) & 1) << 8); }
constexpr int v_rd_off(int d0, int ks, int half) { return d0 * 512 + ks * 4096 + half * 2048; }
__device__ __forceinline__ int crow(int r, int hi) { return (r & 3) + 8 * (r >> 2) + 4 * hi; }
__device__ __forceinline__ unsigned cvtpk(float lo, float hi) {
    unsigned r; asm volatile("v_cvt_pk_bf16_f32 %0, %1, %2" : "=v"(r) : "v"(lo), "v"(hi)); return r;
}
__device__ __forceinline__ bf16x8 pack8(f32x4 a, f32x4 b) {
    u32x4 w = {cvtpk(a[0], a[1]), cvtpk(a[2], a[3]), cvtpk(b[0], b[1]), cvtpk(b[2], b[3])};
    return *reinterpret_cast<bf16x8*>(&w);
}

__device__ __forceinline__ void partialSM(f32x16& p0, f32x16& p1, float& m_reg, float& mn, float& alpha) {
    float pmax = p0[0]; for (int r = 1; r < 16; ++r) pmax = fmaxf(pmax, p0[r]); for (int r = 0; r < 16; ++r) pmax = fmaxf(pmax, p1[r]);
    { auto rr = __builtin_amdgcn_permlane32_swap(__float_as_uint(pmax), __float_as_uint(pmax), false, false);
      pmax = fmaxf(__uint_as_float(rr[0]), __uint_as_float(rr[1])); }
    constexpr float C2 = 1.4426950408889634f * SCALE;
    if (__builtin_expect(__all((pmax - m_reg) * SCALE <= THR), 1)) { mn = m_reg; alpha = 1.f; }
    else { mn = fmaxf(m_reg, pmax); alpha = __builtin_amdgcn_exp2f((m_reg - mn) * C2); m_reg = mn; }
    const float mnL = -mn * C2;
    for (int r = 0; r < 16; ++r) p0[r] = fmaf(p0[r], C2, mnL); for (int r = 0; r < 16; ++r) p1[r] = fmaf(p1[r], C2, mnL);
    for (int r = 0; r < 16; ++r) p0[r] = __builtin_amdgcn_exp2f(p0[r]);
}
__device__ __forceinline__ void finishSM(f32x16& p0, f32x16& p1, float alpha, float& l_reg, bf16x8& pa0, bf16x8& pa1, bf16x8& pa2, bf16x8& pa3) {
    for (int r = 0; r < 16; ++r) p1[r] = __builtin_amdgcn_exp2f(p1[r]);
    float ps = 0; for (int r = 0; r < 16; ++r) ps += p0[r]; for (int r = 0; r < 16; ++r) ps += p1[r];
    { auto rr = __builtin_amdgcn_permlane32_swap(__float_as_uint(ps), __float_as_uint(ps), false, false);
      ps = __uint_as_float(rr[0]) + __uint_as_float(rr[1]); }
    l_reg = l_reg * alpha + ps;
#define PK4(P, B_, OUT) do { unsigned a0 = cvtpk(P[B_+0], P[B_+1]), a1 = cvtpk(P[B_+2], P[B_+3]);                          \
        unsigned b0 = cvtpk(P[B_+4], P[B_+5]), b1 = cvtpk(P[B_+6], P[B_+7]);                                             \
        auto r0 = __builtin_amdgcn_permlane32_swap(a0, b0, false, false); auto r1 = __builtin_amdgcn_permlane32_swap(a1, b1, false, false); \
        u32x4 w = {r0[0], r1[0], r0[1], r1[1]}; OUT = *reinterpret_cast<bf16x8*>(&w); } while (0)
    PK4(p0, 0, pa0); PK4(p0, 8, pa1); PK4(p1, 0, pa2); PK4(p1, 8, pa3);
#undef PK4
}
template <int KB, bool SK>
__device__ __forceinline__ void qkt(f32x16& p0, f32x16& p1, const char* K_lds, int r32, int hi, const bf16x8* qr, bool act) {
    if (SK && !act) { const float NEG = -__builtin_inff();
#pragma unroll
        for (int r = 0; r < 16; ++r) { p0[r] = NEG; p1[r] = NEG; } return; }
    p0 = f32x16{}; p1 = f32x16{};
    const char* kb[4];
#pragma unroll
    for (int dd = 0; dd < 4; ++dd) kb[dd] = K_lds + KB * SHM_K + KSWZ(r32, (dd * 16 + hi * 8) * 2);
#pragma unroll
    for (int d0 = 0; d0 < 8; ++d0) { const char* a = kb[d0 & 3] + (d0 >> 2) * 128;
        bf16x8 b0 = *reinterpret_cast<const bf16x8*>(a);
        bf16x8 b1 = *reinterpret_cast<const bf16x8*>(a + 32 * 256);
        p0 = __builtin_amdgcn_mfma_f32_32x32x16_bf16(b0, qr[d0], p0, 0, 0, 0);
        p1 = __builtin_amdgcn_mfma_f32_32x32x16_bf16(b1, qr[d0], p1, 0, 0, 0); }
}
template <int VB, bool SK>
__device__ __forceinline__ void pv_tile(f32x16* o, int vb0, bf16x8 pa0, bf16x8 pa1, bf16x8 pa2, bf16x8 pa3, bool act) {
    if (SK && !act) return;
#define TRRD(dst, off) asm volatile("ds_read_b64_tr_b16 %0, %1 offset:%2" : "=&v"(dst) : "v"(vb0), "i"(off) : "memory")
#define PV_D0(d0) do { s16x4 l0, l1, l2, l3, h0, h1, h2, h3; constexpr int b_ = VB * SHM_V + v_rd_off(d0, 0, 0);     \
        TRRD(l0, b_); TRRD(h0, b_ + 2048); TRRD(l1, b_ + 4096); TRRD(h1, b_ + 6144); TRRD(l2, b_ + 8192); TRRD(h2, b_ + 10240); TRRD(l3, b_ + 12288); TRRD(h3, b_ + 14336); \
        asm volatile("s_waitcnt lgkmcnt(0)" ::: "memory"); SBAR();                 \
        o[d0] = __builtin_amdgcn_mfma_f32_32x32x16_bf16(pa0, (bf16x8){l0[0], l0[1], l0[2], l0[3], h0[0], h0[1], h0[2], h0[3]}, o[d0], 0, 0, 0);   \
        o[d0] = __builtin_amdgcn_mfma_f32_32x32x16_bf16(pa1, (bf16x8){l1[0], l1[1], l1[2], l1[3], h1[0], h1[1], h1[2], h1[3]}, o[d0], 0, 0, 0);   \
        o[d0] = __builtin_amdgcn_mfma_f32_32x32x16_bf16(pa2, (bf16x8){l2[0], l2[1], l2[2], l2[3], h2[0], h2[1], h2[2], h2[3]}, o[d0], 0, 0, 0);   \
        o[d0] = __builtin_amdgcn_mfma_f32_32x32x16_bf16(pa3, (bf16x8){l3[0], l3[1], l3[2], l3[3], h3[0], h3[1], h3[2], h3[3]}, o[d0], 0, 0, 0); } while (0)
    PV_D0(0); PV_D0(1); PV_D0(2); PV_D0(3);
#undef PV_D0
#undef TRRD
}

__device__ __forceinline__ bf16x8 load8(const bf16* p) { return *reinterpret_cast<const bf16x8*>(p); }
__device__ __forceinline__ void mask_bits(f32x16& p0, f32x16& p1, u32x2 w, int hi) {
    const float NEG = -__builtin_inff();
    asm volatile("" : "+v"(w.x), "+v"(w.y));
    const unsigned lo = w.x >> (4 * hi), up = w.y >> (4 * hi);
#pragma unroll
    for (int r = 0; r < 16; ++r) { const int c = (r & 3) + 8 * (r >> 2);
        if (!((lo >> c) & 1u)) p0[r] = NEG;
        if (!((up >> c) & 1u)) p1[r] = NEG; }
}
struct BlockRef { const bf16* Q; const bf16* K; const bf16* V; bf16* O; const u32x2* M; int P0; };
struct Seam { bf16x8 qr[8]; bf16x8 st_v0, st_v1, st_k0, st_k1; };
#define ROW(p, k0, rr) ((p) + (size_t)((k0) + (rr)) * D + sc)
#define VMW() asm volatile("s_waitcnt vmcnt(0)" ::: "memory")
#define VMWN(n) asm volatile("s_waitcnt vmcnt(%0)" :: "i"(n) : "memory")
#define SLOAD_H(Kp, Vp, k0) do { S.st_v0 = load8(ROW(Vp, k0, sr)); S.st_v1 = load8(ROW(Vp, k0, 32 + sr));              \
                         S.st_k0 = load8(ROW(Kp, k0, sr)); S.st_k1 = load8(ROW(Kp, k0, 32 + sr)); } while (0)
#define SWRITE_HK(bf) do { *(bf16x8*)(K_lds + (bf) * SHM_K + kws) = S.st_k0; *(bf16x8*)(K_lds + (bf) * SHM_K + kws + 32 * 256) = S.st_k1; } while (0)
#define SWRITE_HV(bf) do { *(bf16x8*)(V_lds + (bf) * SHM_V + vst0) = S.st_v0; *(bf16x8*)(V_lds + (bf) * SHM_V + vst1) = S.st_v1; } while (0)
#define SWRITE_H(bf) do { SWRITE_HV(bf); SWRITE_HK(bf); } while (0)
__device__ __forceinline__ void sel_prime(const BlockRef& cur, char* lds, Seam& S) {
    int tid_ = threadIdx.x; asm volatile("" : "+v"(tid_));
    const int tid = tid_, wid = __builtin_amdgcn_readfirstlane(tid >> 6), lane = tid & 63, r32 = lane & 31, hi = lane >> 5;
    const int sr = tid >> 4, sc = (tid & 15) * 8, kws = KSWZ(sr, sc * 2); char* K_lds = lds + 2 * SHM_V;
    for (int d0 = 0; d0 < 8; ++d0) S.qr[d0] = load8(cur.Q + (size_t)(wid * QBLK + r32) * D + d0 * 16 + hi * 8);
    SLOAD_H(cur.K, cur.V, 0); VMW(); SWRITE_HK(0);
    __syncthreads();
}
__device__ __forceinline__ void sel_block(const BlockRef& cur, const BlockRef& nxt, char* lds, Seam& S) {
    int tid_ = threadIdx.x; asm volatile("" : "+v"(tid_));
    const int tid = tid_, wid = __builtin_amdgcn_readfirstlane(tid >> 6), lane = tid & 63, r32 = lane & 31, hi = lane >> 5;
    const int NT = (cur.P0 + QB) / KVBLK;
    char* V_lds = lds; char* K_lds = lds + 2 * SHM_V;
    float* ws = (float*)(lds + 2 * SHM_V + 2 * SHM_K) + wid * 64; float* li_l = ws, * al_l = ws + 32;
    float m_reg = -1e30f, l_reg = 0; f32x16 o[4] = {};
    const int sr = tid >> 4, sc = (tid & 15) * 8, vst0 = v_st(sr, sc), vst1 = v_st(32 + sr, sc), kws = KSWZ(sr, sc * 2);
    const int vb0 = (int)(uintptr_t)V_lds + v_rd_base(lane);
    const bf16* Kh = cur.K; const bf16* Vh = cur.V;
    const char* Mbase = (const char*)cur.M; const unsigned moff = (unsigned)(wid * QBLK + r32) * 512u;
#define MROW(t) (*(const u32x2*)(Mbase + (moff + (unsigned)(t) * 8u)))
#define RESC(a) do { if (__any((a) < 1.f)) { if (hi == 0) al_l[r32] = (a); asm volatile("s_waitcnt lgkmcnt(0)" ::: "memory");              \
                     for (int d_ = 0; d_ < 4; ++d_) for (int r = 0; r < 16; ++r) o[d_][r] *= al_l[crow(r, hi)]; } } while (0)
#define KBASE(t) ((t) * KVBLK)
    f32x16 pA0, pA1, pB0, pB1; float mnA, mnB, alA, alB; bf16x8 pa0, pa1, pa2, pa3; u32x2 mw;
    SWRITE_HV(0); SBAR();
    if (NT > 1) SLOAD_H(Kh, Vh, KBASE(1));
    mw = MROW(0);
    SBAR(); qkt<0, false>(pA0, pA1, K_lds, r32, hi, S.qr, true);
    mask_bits(pA0, pA1, mw, hi); partialSM(pA0, pA1, m_reg, mnA, alA);
    if (NT > 1) { VMW(); SWRITE_H(1); }
    __syncthreads();
#define HALF_STEP(PX0, PX1, mnX, alX, PY0, PY1, alY, t, KB, VB, SB) do {                                                      \
        SBAR(); mw = MROW(t); qkt<KB, false>(PX0, PX1, K_lds, r32, hi, S.qr, true);                                          \
        finishSM(PY0, PY1, alY, l_reg, pa0, pa1, pa2, pa3); SBAR();                                                           \
        if ((t) + 1 < NT) { SLOAD_H(Kh, Vh, KBASE((t) + 1)); SBAR(); }                                                        \
        pv_tile<VB, false>(o, vb0, pa0, pa1, pa2, pa3, true); mask_bits(PX0, PX1, mw, hi); partialSM(PX0, PX1, m_reg, mnX, alX); \
        __syncthreads();                                                                                                      \
        if ((t) + 1 < NT) { VMW(); SWRITE_H(SB); }                                                                            \
        RESC(alX); __syncthreads(); } while (0)
    for (int t = 1; t + 1 < NT; t += 2) {
        HALF_STEP(pB0, pB1, mnB, alB, pA0, pA1, alA, t, 1, 0, 0);
        HALF_STEP(pA0, pA1, mnA, alA, pB0, pB1, alB, t + 1, 0, 1, 1);
    }
    const bool even = (NT & 1) == 0;
    if (even) { SBAR(); mw = MROW(NT - 1); qkt<1, false>(pB0, pB1, K_lds, r32, hi, S.qr, true); SBAR(); }
    SLOAD_H(nxt.K, nxt.V, 0); SBAR();
#pragma unroll
    for (int d0 = 0; d0 < 8; ++d0) S.qr[d0] = load8(nxt.Q + (size_t)(wid * QBLK + r32) * D + d0 * 16 + hi * 8);
    SBAR();
    finishSM(pA0, pA1, alA, l_reg, pa0, pa1, pa2, pa3); SBAR();
    pv_tile<0, false>(o, vb0, pa0, pa1, pa2, pa3, true);
    if (even) { mask_bits(pB0, pB1, mw, hi); partialSM(pB0, pB1, m_reg, mnB, alB); __syncthreads(); RESC(alB);
        finishSM(pB0, pB1, alB, l_reg, pa0, pa1, pa2, pa3); SBAR(); pv_tile<1, false>(o, vb0, pa0, pa1, pa2, pa3, true); }
    SBAR(); VMWN(8); SWRITE_HK(0); SBAR();
    if (hi == 0) li_l[r32] = l_reg; asm volatile("s_waitcnt lgkmcnt(0)" ::: "memory");
    float rli[16];
#pragma unroll
    for (int r = 0; r < 16; ++r) rli[r] = __builtin_amdgcn_rcpf(li_l[crow(r, hi)]);
    bf16* Ow = cur.O + (size_t)(wid * QBLK) * OS;
#pragma unroll
    for (int r = 0; r < 16; ++r) { const int orow = crow(r, hi);
#pragma unroll
        for (int d0 = 0; d0 < 4; ++d0) { const float v = o[d0][r] * rli[r];
            const float vn = __shfl_xor(v, 1);
            if ((r32 & 1) == 0) *(unsigned*)(Ow + (size_t)orow * OS + d0 * 32 + r32) = cvtpk(v, vn); } }
    __syncthreads();
#undef RESC
#undef KBASE
#undef HALF_STEP
#undef MROW
}
#undef ROW
#undef VMW
#undef VMWN
#undef SLOAD_H
#undef SWRITE_HK
#undef SWRITE_HV
#undef SWRITE_H
#undef KSWZ
#undef SBAR
}


__device__ __forceinline__ attn::BlockRef attn_ref(ARGREF a, int b, int h, int qb) {
    attn::BlockRef r; const int kvh = h / 3;
    r.Q = (const attn::bf16*)(a.ws + WS_QB) + ((size_t)(b * 6 + h) * SEQ + (size_t)qb * 256) * 128;
    r.K = (const attn::bf16*)(a.ws + WS_KB) + (size_t)(b * 2 + kvh) * SEQ * 128;
    r.V = (const attn::bf16*)(a.ws + WS_VB) + (size_t)(b * 2 + kvh) * SEQ * 128;
    r.O = (attn::bf16*)(a.ws + WS_MIX) + (size_t)(b * SEQ + qb * 256) * DM + h * 128;
    r.M = (const attn::u32x2*)(a.ws + WS_MASK) + (size_t)(b * SEQ + qb * 256) * 64;
    r.P0 = qb * 256; return r;
}
__device__ __forceinline__ void p11_attention(Ctx& c, ARGREF a) {
    constexpr int NITEM = 240;
#pragma unroll 1
    for (int it = c.vcu; it < NITEM; it += c.G) {
        const int bh = it / 10, slot = it % 10, b = bh / 6, h = bh % 6;
        const int q0 = slot < 3 ? 15 - slot : (slot == 9 ? 6 : slot - 3), q1 = slot < 3 ? q0 : (slot == 9 ? 6 : 15 - slot);
        attn::Seam S;
        attn::BlockRef cur = attn_ref(a, b, h, q0), nxt = attn_ref(a, b, h, q1);
        __syncthreads();
        attn::sel_prime(cur, (char*)c.lds, S);
        if (q0 != q1) attn::sel_block(cur, nxt, (char*)c.lds, S);
        attn::sel_block(nxt, nxt, (char*)c.lds, S);
    }
    if (c.G == 256) {
        if (c.vcu >= NITEM) { for (int j = 0; j < 4; ++j) { const int u = (c.vcu - NITEM) * 4 + j; attn_sample_unit(c, a, u >> 2, u & 3); } }
        else if (c.vcu % 10 == 9) { for (int j = 0; j < 3; ++j) { const int u = 64 + (c.vcu / 10) * 3 + j; if (u < MS) attn_sample_unit(c, a, u >> 2, u & 3); } }
    } else for (int u = c.vcu; u < MS; u += c.G) attn_sample_unit(c, a, u >> 2, u & 3);
}

enum { PH_PRO = 0, PH_IN0, PH_MIX0, PH_HSCAN, PH_HFIX, PH_OUT0, PH_GU0, PH_DOWN0, PH_IN1, PH_POST, PH_IDX, PH_TOPK, PH_ATTN, PH_OUT1, PH_GU1, PH_DOWN1, NPHASE };
#ifndef ONLYPH
#define ONLYPH -1
#endif
#define PHON(x) (ONLYPH < 0 || ONLYPH == (x))
#ifndef REP_PH
#define REP_PH -1
#endif
#ifndef REP_N
#define REP_N 1
#endif
__global__ void __launch_bounds__(NWAVES * 64, 2) fwd_kernel(Args args) {
    extern __shared__ __attribute__((aligned(16))) unsigned char lds[];
    Ctx c;
    c.lds = (LAS unsigned char*)lds;
    c.MISC = (volatile LAS unsigned*)(c.lds + MISC_OFF);
    c.tid = threadIdx.x; c.lane = c.tid & 63; c.wave = __builtin_amdgcn_readfirstlane(c.tid >> 6);
    c.G = gridDim.x; { const int bx = blockIdx.x; c.vcu = (c.G % 8 == 0) ? (bx % 8) * (c.G / 8) + bx / 8 : bx; }
    c.ctl = (gu32*)(args.ws + WS_CTL);
    for (int u = c.tid; u < (LDS_BYTES - LDSCTL_OFF) / 4; u += NWAVES * 64) ((LAS unsigned*)(c.lds + LDSCTL_OFF))[u] = 0u;
    __syncthreads();
    const int lo = args.ph_lo, hi = args.ph_hi;
    XcdBarrier bar; bar.bar = (unsigned*)(c.ctl + CW_BAR); bar.x = 0; bar.st = nullptr;
    if (hi - lo > 1 || REP_N > 1) bar = xcd_barrier_post((unsigned*)(c.ctl + CW_BAR), c.MISC + 8);
    c.qoff = 0;
#pragma unroll 1
    for (int ph = lo; ph < hi; ++ph) {
        const int layer = ph >= PH_IN1 ? 1 : 0;
        const __attribute__((address_space(4))) Args* ap = (const __attribute__((address_space(4))) Args*)__builtin_amdgcn_kernarg_segment_ptr(); asm volatile("" : "+s"(ap));
        ARGREF la = *ap; unsigned char* const ws = la.ws; float* const out = la.out;
        { int t_ = threadIdx.x; asm volatile("" : "+v"(t_)); c.tid = t_; c.lane = t_ & 63; c.wave = __builtin_amdgcn_readfirstlane(t_ >> 6); }
        if ((ph == PH_DOWN0 || ph == PH_DOWN1) && PHON(PH_OUT0)) {
            pg8::SchedX S0; S0.init(MP, 1024, c.G, (int)blockIdx.x, 0, 0, 1, 0); pg8::Unit u0; if (S0.next(0, u0)) conv_fixup_tile(c, la, layer, u0.pm); VM_WAIT(); __syncthreads(); }
        if (ph == PH_PRO && PHON(PH_PRO)) p0_prologue(c, la);
        else if ((ph == PH_IN0 || ph == PH_IN1) && PHON(PH_IN0)) {
            pg8::Gemm g{(const pg8::bf16_t*)(ws + WS_XB), (const pg8::bf16_t*)(ws + (ph == PH_IN0 ? WS_WIN0 : WS_WIN1)), MT, 0, 1024};
            pg8::SchedX S; if (ph == PH_IN0) S.init(MP, ZC0, c.G, (int)blockIdx.x, 16, MT / 256, 4, 13); else S.init(MP, ZC1, c.G, (int)blockIdx.x, 0, 0, 1, 0);
            pg8::EpiZ E{(pg8::bf16_t*)(ws + WS_Z), ph == PH_IN0 ? ZC0 : ZC1, ssptr(c, ph == PH_IN0 ? 0 : 2), ph == PH_IN0 ? 13 : 9, (float*)(ws + WS_MEMKV), MEMROW0};
            pg8::gemm_phase<pg8::EpiZ, pg8::SchedX, PG8_ALIGN, PG8_SP2>(c.lds + RING_OFF, g, S, E);
            { SgArgs sg{}; sg.A = (const bf16*)(ws + WS_XB) + (size_t)MP * DM; sg.Bt = (const bf16*)(ws + (ph == PH_IN0 ? WS_WIN0 : WS_WIN1)); sg.K = 1024; sg.mode = 0; sg.Z = (bf16*)(ws + WS_Z); sg.ldz = ph == PH_IN0 ? ZC0 : ZC1; sg.ssin = ssptr(c, ph == PH_IN0 ? 0 : 2);
              sgemm_phase(c, sg, ph == PH_IN0 ? ZC0 : ZC1); }
            if (ph == PH_IN0) { __syncthreads(); convert_layer1_tail(c, la, (64 * 13 + 16) % c.G); }
        }
        else if (ph == PH_MIX0 && PHON(PH_MIX0)) p2_mixer0(c, la);
        else if (ph == PH_HSCAN && PHON(PH_HSCAN)) hgrn_scan(c, la);
        else if (ph == PH_HFIX && PHON(PH_HFIX)) p2c_hgrn_fix(c, la);
        else if ((ph == PH_OUT0 || ph == PH_DOWN0 || ph == PH_OUT1 || ph == PH_DOWN1) && PHON(PH_OUT0)) {
            const bool isout = (ph == PH_OUT0 || ph == PH_OUT1);
            pg8::Gemm g{(const pg8::bf16_t*)(ws + (isout ? WS_MIX : WS_ACT)), (const pg8::bf16_t*)(ws + (isout ? WS_WOUT + (size_t)layer * 1024 * 1024 * 2 : WS_WD + (size_t)layer * 1024 * DFF * 2)), MT, 1024, isout ? 1024 : DFF};
            pg8::SchedX S; S.init(MP, 1024, c.G, (int)blockIdx.x, 0, 0, 1, 0);
            pg8::EpiResid E;
            E.rp = ph == PH_OUT0 ? la.in[0] : nullptr; E.rb = (const pg8::bf16_t*)(ws + WS_XB); E.y = ph == PH_DOWN1 ? out + O_YP : nullptr;
            E.xb = ph == PH_DOWN1 ? nullptr : (pg8::bf16_t*)(ws + WS_XB); E.ssout = ph == PH_DOWN1 ? nullptr : ssptr(c, ph == PH_OUT0 ? 1 : (ph == PH_DOWN0 ? 2 : 3));
            pg8::gemm_phase<pg8::EpiResid, pg8::SchedX, PG8_ALIGN, PG8_SP2>(c.lds + RING_OFF, g, S, E);
            { SgArgs sg{}; sg.A = (const bf16*)(ws + (isout ? WS_MIX : WS_ACT)) + (size_t)MP * (isout ? 1024 : DFF); sg.Bt = (const bf16*)g.Bt; sg.K = isout ? 1024 : DFF; sg.mode = 1; sg.rb = (const bf16*)(ws + WS_XB); sg.resid = ph == PH_OUT0 ? la.in[1] : nullptr; sg.y = ph == PH_DOWN1 ? out + O_YS : nullptr; sg.xb = (bf16*)E.xb; sg.ssout = E.ssout;
              sgemm_phase(c, sg, 1024); }
        }
        else if ((ph == PH_GU0 || ph == PH_GU1) && PHON(PH_GU0)) {
            pg8::Gemm g{(const pg8::bf16_t*)(ws + WS_XB), (const pg8::bf16_t*)(ws + WS_WGU + (size_t)layer * 5632 * 1024 * 2), MT, 5632, 1024};
            pg8::SchedX S; S.init(MP, 5632, c.G, (int)blockIdx.x, 0, 0, 1, 0);
            pg8::EpiGU E{(pg8::bf16_t*)(ws + WS_ACT), ssptr(c, layer ? 3 : 1), out + O_CVP + (size_t)layer * 4 * 2 * DFF, la.in[26] + (size_t)layer * 3 * DFF, la.in[27] + (size_t)layer * DFF, (float*)(ws + WS_G4), (float*)(ws + WS_UP2)};
            pg8::gemm_phase<pg8::EpiGU, pg8::SchedX, PG8_ALIGN, PG8_SP2>(c.lds + RING_OFF, g, S, E);
            { SgArgs sg{}; sg.A = (const bf16*)(ws + WS_XB) + (size_t)MP * DM; sg.Bt = (const bf16*)g.Bt; sg.K = 1024; sg.mode = 2; sg.ssin = E.ss; sg.ACT = (bf16*)E.ACT; sg.cvs = out + O_CVS + (size_t)layer * 32 * 2 * DFF; sg.cst = la.in[8] + (size_t)layer * 32 * 2 * DFF; sg.cw = E.cw; sg.cb = E.cb;
              sgemm_phase(c, sg, 5632); }
        }
        else if (ph == PH_POST && PHON(PH_POST)) p8_dsa_post(c, la);
        else if (ph == PH_IDX && PHON(PH_IDX)) p9_indexer(c, la);
        else if (ph == PH_TOPK && PHON(PH_TOPK)) p10_topk(c, la);
        else if (ph == PH_ATTN && PHON(PH_ATTN)) p11_attention(c, la);
        if (REP_N > 1 && ph == REP_PH && c.qoff < 4 * (REP_N - 1)) { c.qoff += 4; --ph; xcd_barrier(bar); continue; }
        if (REP_N > 1) c.qoff = 0;
        if (ph + 1 < hi) xcd_barrier(bar);
    }
}

#ifndef MK_ONE_LAUNCH
#define MK_ONE_LAUNCH 1
#endif
extern "C" void kernel_launch(void* const* d_in, const int* in_sizes, int n_in, void* d_out, int out_size, void* d_ws, size_t ws_size, hipStream_t stream) {
    static int grid = 0;
    if (grid == 0) {
        if (n_in != 29 || out_size != (int)O_END || ws_size < WS_END) { fprintf(stderr, "kernel_launch: unexpected problem (n_in %d, out %d, ws %zu)\n", n_in, out_size, ws_size); grid = -1; return; }
        int dev = 0, cus = 0;
        if (hipGetDevice(&dev) != hipSuccess || hipDeviceGetAttribute(&cus, hipDeviceAttributeMultiprocessorCount, dev) != hipSuccess) { grid = -1; return; }
        if (hipFuncSetAttribute((const void*)fwd_kernel, hipFuncAttributeMaxDynamicSharedMemorySize, LDS_BYTES) != hipSuccess) { fprintf(stderr, "kernel_launch: hipFuncSetAttribute failed\n"); grid = -1; return; }
        (void)hipGetLastError();
        grid = cus;
    }
    if (grid < 0) return;
    if (hipMemsetAsync((char*)d_ws + WS_CTL, 0, CTL_ZERO_BYTES, stream) != hipSuccess) { fprintf(stderr, "kernel_launch: memset failed\n"); return; }
    Args a{};
    for (int i = 0; i < 29; ++i) a.in[i] = (const float*)d_in[i];
    a.page_table = (const int*)d_in[9]; a.out = (float*)d_out; a.ws = (unsigned char*)d_ws;
#if MK_ONE_LAUNCH
    a.ph_lo = 0; a.ph_hi = NPHASE;
    hipLaunchKernelGGL(fwd_kernel, dim3(grid), dim3(NWAVES * 64), LDS_BYTES, stream, a);
#else
    for (int ph = 0; ph < NPHASE; ++ph) { a.ph_lo = ph; a.ph_hi = ph + 1; hipLaunchKernelGGL(fwd_kernel, dim3(grid), dim3(NWAVES * 64), LDS_BYTES, stream, a); }
#endif
}
```

```cpp
#include <hip/hip_runtime.h>
#include <cstdio>
#include <cstdint>


namespace pg8 {
#define PG8_LAS __attribute__((address_space(3)))
typedef unsigned short bf16_t;
typedef short bf16x8 __attribute__((ext_vector_type(8)));
typedef float f32x4 __attribute__((ext_vector_type(4)));
typedef unsigned u32x4 __attribute__((ext_vector_type(4)));
constexpr int BM = 256, BK = 64, HALF = 128, HTB = HALF * BK * 2  , STAGE_BYTES = 8 * HTB, NXCD = 8, WGM = 8;

__host__ __device__ __forceinline__ int lds_byte(int r, int c) { const int st = (r >> 4) * 2 + (c >> 5), rr = r & 15, cc = c & 31, ob = rr * 64 + cc * 2; return st * 1024 + (ob ^ (((ob >> 9) & 1) << 5)); }
__host__ __device__ __forceinline__ void stage_rc(int b, int& R, int& C) { const int st = b / 1024, sb = b % 1024, swz = sb ^ (((sb >> 9) & 1) << 5); R = (st >> 1) * 16 + swz / 64; C = (st & 1) * 32 + (swz % 64) / 2; }
__host__ __device__ __forceinline__ int perm32(int rho) { const int n = rho >> 4, i = rho & 15; return 8 * (i >> 2) + 4 * n + (i & 3); }

struct Unit { int pm, pn; };
struct Gemm { const bf16_t* A; const bf16_t* Bt; int M, N, K; };

struct StaticOrder {
    int nM, nN, nwg, G, c;
    __host__ __device__ __forceinline__ void init(int M, int N, int G_, int c_) { nM = M / BM; nN = N / BM; nwg = nM * nN; G = G_; c = c_; }
    __host__ __device__ __forceinline__ bool next(int i, Unit& u) const {
        const long L = (long)i * G + c; if (L >= nwg) return false;
        int wgid = (int)L; { const int q = nwg / NXCD, r = nwg % NXCD, xcd = wgid % NXCD, off = wgid / NXCD; wgid = (xcd < r ? xcd * (q + 1) : r * (q + 1) + (xcd - r) * q) + off; }
        const int nig = WGM * nN, gid = wgid / nig, fm = gid * WGM, gsz = (nM - fm) < WGM ? (nM - fm) : WGM;
        u.pm = fm + ((wgid % nig) % gsz); u.pn = (wgid % nig) / gsz; return true;
    }
    __device__ __forceinline__ void a_ready(const Unit&) const {}
    __device__ __forceinline__ void done(const Unit&) const {}
};


constexpr int MP = 16384, MS = 128, MVALID = MP + MS, MT = 16640, DM = 1024, DFF = 2816;
constexpr float RMS_EPS = 1e-6f;
__device__ __forceinline__ unsigned cvt_pk_bf16(float lo, float hi) { unsigned r; asm volatile("v_cvt_pk_bf16_f32 %0, %1, %2" : "=v"(r) : "v"(lo), "v"(hi)); return r; }

struct SchedX {
    StaticOrder so; int nextra, e_pm0, e_nm, e_pn0;
    __device__ __forceinline__ void init(int M, int N, int G_, int c_, int nextra_, int e_pm0_, int e_nm_, int e_pn0_) { so.init(M, N, G_, c_); nextra = nextra_; e_pm0 = e_pm0_; e_nm = e_nm_; e_pn0 = e_pn0_; }
    __device__ __forceinline__ bool next(int i, Unit& u) const {
        const long L = (long)i * so.G + so.c;
        if (L < so.nwg) return so.next(i, u);
        const int e = (int)(L - so.nwg); if (e >= nextra) return false;
        u.pm = e_pm0 + e % e_nm; u.pn = e_pn0 + e / e_nm; return true;
    }
    __device__ __forceinline__ void a_ready(const Unit&) const {}
    __device__ __forceinline__ void done(const Unit&) const {}
};

struct EpiZ {
    static constexpr bool PERM = true, AFTER_DRAIN = false;
    bf16_t* Z; int ldz; const float* ss; int nmain; float* memkv; int memrow0;
    __device__ __forceinline__ void operator()(const f32x4 (&acc)[2][2][4][2], const Unit& u, int wr, int wc, int fr, int fq) const {
        const int row0 = u.pm * BM + wr * 64 + fr;
        if (u.pn < nmain) {
            const int col0 = u.pn * BM + wc * 32 + 8 * fq;
#pragma unroll
            for (int ai = 0; ai < 2; ++ai)
#pragma unroll
                for (int m = 0; m < 4; ++m) { const int row = row0 + ai * HALF + m * 16; const float rs = rsqrtf(ss[row] * (1.0f / DM) + RMS_EPS);
#pragma unroll
                    for (int bj = 0; bj < 2; ++bj) { const f32x4 v0 = acc[ai][bj][m][0] * rs, v1 = acc[ai][bj][m][1] * rs;
                        u32x4 w; w.x = cvt_pk_bf16(v0[0], v0[1]); w.y = cvt_pk_bf16(v0[2], v0[3]); w.z = cvt_pk_bf16(v1[0], v1[1]); w.w = cvt_pk_bf16(v1[2], v1[3]);
                        *(u32x4*)(Z + (size_t)row * ldz + col0 + bj * HALF) = w; } }
        } else {
            const int col0 = (u.pn - nmain) * BM + wc * 32 + 8 * fq;
#pragma unroll
            for (int ai = 0; ai < 2; ++ai)
#pragma unroll
                for (int m = 0; m < 4; ++m) { const int row = row0 + ai * HALF + m * 16 - memrow0;
#pragma unroll
                    for (int bj = 0; bj < 2; ++bj) { float* p = memkv + (size_t)row * 1024 + col0 + bj * HALF; *(f32x4*)p = acc[ai][bj][m][0]; *(f32x4*)(p + 4) = acc[ai][bj][m][1]; } }
        }
    }
};

struct EpiResid {
    static constexpr bool PERM = true, AFTER_DRAIN = false;
    const float* rp; const bf16_t* rb; float* y; bf16_t* xb; float* ssout;
    __device__ __forceinline__ void operator()(const f32x4 (&acc)[2][2][4][2], const Unit& u, int wr, int wc, int fr, int fq) const {
        const int row0 = u.pm * BM + wr * 64 + fr, col0 = u.pn * BM + wc * 32 + 8 * fq;
#pragma unroll
        for (int ai = 0; ai < 2; ++ai)
#pragma unroll
            for (int m = 0; m < 4; ++m) { const int row = row0 + ai * HALF + m * 16; float part = 0.f;
#pragma unroll
                for (int bj = 0; bj < 2; ++bj) { const int c = col0 + bj * HALF; f32x4 r0, r1;
                    if (rp) { r0 = *(const f32x4*)(rp + (size_t)row * DM + c); r1 = *(const f32x4*)(rp + (size_t)row * DM + c + 4); }
                    else { const u32x4 q = *(const u32x4*)(rb + (size_t)row * DM + c);
                        r0 = (f32x4){__builtin_bit_cast(float, q.x << 16), __builtin_bit_cast(float, q.x & 0xffff0000u), __builtin_bit_cast(float, q.y << 16), __builtin_bit_cast(float, q.y & 0xffff0000u)};
                        r1 = (f32x4){__builtin_bit_cast(float, q.z << 16), __builtin_bit_cast(float, q.z & 0xffff0000u), __builtin_bit_cast(float, q.w << 16), __builtin_bit_cast(float, q.w & 0xffff0000u)}; }
                    const f32x4 v0 = acc[ai][bj][m][0] + r0, v1 = acc[ai][bj][m][1] + r1;
                    if (y) { *(f32x4*)(y + (size_t)row * DM + c) = v0; *(f32x4*)(y + (size_t)row * DM + c + 4) = v1; }
                    part += (v0[0] * v0[0] + v0[1] * v0[1]) + (v0[2] * v0[2] + v0[3] * v0[3]) + (v1[0] * v1[0] + v1[1] * v1[1]) + (v1[2] * v1[2] + v1[3] * v1[3]);
                    if (xb) { u32x4 w; w.x = cvt_pk_bf16(v0[0], v0[1]); w.y = cvt_pk_bf16(v0[2], v0[3]); w.z = cvt_pk_bf16(v1[0], v1[1]); w.w = cvt_pk_bf16(v1[2], v1[3]);
                        *(u32x4*)(xb + (size_t)row * DM + c) = w; } }
                part += __shfl_xor(part, 16); part += __shfl_xor(part, 32);
                if (ssout && fq == 0) atomicAdd(ssout + row, part); }
    }
};

__device__ __forceinline__ void dpp_ror12(const f32x4& v, f32x4& r1, f32x4& r2) {
    float a0, a1, a2, a3, b0, b1, b2, b3;
    asm volatile("s_nop 1\n\t"
                 "v_mov_b32_dpp %0, %8 row_ror:1 row_mask:0xf bank_mask:0xf\n\tv_mov_b32_dpp %1, %9 row_ror:1 row_mask:0xf bank_mask:0xf\n\t"
                 "v_mov_b32_dpp %2, %10 row_ror:1 row_mask:0xf bank_mask:0xf\n\tv_mov_b32_dpp %3, %11 row_ror:1 row_mask:0xf bank_mask:0xf\n\t"
                 "v_mov_b32_dpp %4, %8 row_ror:2 row_mask:0xf bank_mask:0xf\n\tv_mov_b32_dpp %5, %9 row_ror:2 row_mask:0xf bank_mask:0xf\n\t"
                 "v_mov_b32_dpp %6, %10 row_ror:2 row_mask:0xf bank_mask:0xf\n\tv_mov_b32_dpp %7, %11 row_ror:2 row_mask:0xf bank_mask:0xf"
                 : "=&v"(a0), "=&v"(a1), "=&v"(a2), "=&v"(a3), "=&v"(b0), "=&v"(b1), "=&v"(b2), "=&v"(b3) : "v"(v[0]), "v"(v[1]), "v"(v[2]), "v"(v[3]));
    r1 = (f32x4){a0, a1, a2, a3}; r2 = (f32x4){b0, b1, b2, b3};
}
struct EpiGU {
    static constexpr bool PERM = true, AFTER_DRAIN = false;
    bf16_t* ACT; const float* ss; float* cvp; const float* cw; const float* cb; float* G4; float* UP2;
    __device__ __forceinline__ void operator()(const f32x4 (&acc)[2][2][4][2], const Unit& u, int wr, int wc, int fr, int fq) const {
        const int row0 = u.pm * BM + wr * 64 + fr, colg = u.pn * HALF + wc * 32 + 8 * fq;
#pragma unroll
        for (int n = 0; n < 2; ++n) { const int col = colg + 4 * n;
            const f32x4 w0 = *(const f32x4*)(cw + col), w1 = *(const f32x4*)(cw + DFF + col), w2 = *(const f32x4*)(cw + 2 * DFF + col), bb = *(const f32x4*)(cb + col);
#pragma unroll
            for (int ai = 0; ai < 2; ++ai) { f32x4 r1p = {0.f, 0.f, 0.f, 0.f}, r2p = r1p; const int slab = (u.pm * BM + ai * HALF + wr * 64) >> 6;
#pragma unroll
                for (int m = 0; m < 4; ++m) { const int row = row0 + ai * HALF + m * 16; const float rs = rsqrtf(ss[row] * (1.0f / DM) + RMS_EPS);
                    const f32x4 g = acc[ai][0][m][n] * rs, up = acc[ai][1][m][n] * rs;
                    f32x4 r1, r2; dpp_ror12(g, r1, r2);
                    const f32x4 p1 = fr >= 1 ? r1 : r1p, p2 = fr >= 2 ? r2 : r2p;
                    f32x4 cv = bb + w0 * p2 + w1 * p1 + w2 * g, y;
#pragma unroll
                    for (int i = 0; i < 4; ++i) y[i] = cv[i] * __builtin_amdgcn_rcpf(1.0f + __expf(-cv[i])) * up[i];
                    if (m == 0 && fr < 2) { *(f32x4*)(G4 + (size_t)(slab * 4 + fr) * DFF + col) = g; *(f32x4*)(UP2 + (size_t)(slab * 2 + fr) * DFF + col) = up; }
                    else { typedef unsigned u32x2 __attribute__((ext_vector_type(2))); u32x2 w; w.x = cvt_pk_bf16(y[0], y[1]); w.y = cvt_pk_bf16(y[2], y[3]); *(u32x2*)(ACT + (size_t)row * DFF + col) = w; }
                    if (m == 3 && fr >= 14) { *(f32x4*)(G4 + (size_t)(slab * 4 + 2 + (fr - 14)) * DFF + col) = g;
                        const int t = row & 4095; if (t >= 4094) *(f32x4*)(cvp + (size_t)((row >> 12) * 2 + (t - 4094)) * DFF + col) = g; }
                    r1p = r1; r2p = r2; } } }
    }
};

template <class Epi, class Sched, bool ALIGN_EPI = false, bool SP2 = false>
__device__ __forceinline__ void gemm_phase(PG8_LAS unsigned char* lds, const Gemm g, const Sched& S, const Epi& E) {
    int tid_ = threadIdx.x; asm volatile("" : "+v"(tid_));
    const int tid = tid_, wid = __builtin_amdgcn_readfirstlane(tid >> 6), lane = tid & 63, wr = wid >> 2, wc = wid & 3, fr = lane & 15, fq = lane >> 4;
    const int K = g.K, nt = K / BK;
    unsigned voffA[2], voffB[2];
#pragma unroll
    for (int i = 0; i < 2; ++i) { int R, C; stage_rc(tid * 16 + i * 8192, R, C); const int Rb = Epi::PERM ? ((R & ~31) + perm32(R & 31)) : R;
        voffA[i] = (unsigned)(R * K + C) * 2u; voffB[i] = (unsigned)(Rb * K + C) * 2u; }
    const size_t kstep = (size_t)(BK * 2);
    const size_t hstep = (size_t)HALF * K * 2;
    const size_t tstep = 2 * hstep;
    const unsigned ldsw = (unsigned)wid * 1024u;
    const int aoff = lds_byte(wr * 64 + fr, fq * 8), boff = lds_byte(wc * 32 + fr, fq * 8);
#define PG8_SA(b, h) (((b) * 2 + (h)) * HTB)
#define PG8_SB(b, h) ((4 + (b) * 2 + (h)) * HTB)
#define PG8_STAGE(bufoff, gbase, voff) do { _Pragma("unroll") for (int _i = 0; _i < 2; ++_i) \
        __builtin_amdgcn_global_load_lds((const unsigned*)((const char*)(gbase) + (voff)[_i]), (PG8_LAS unsigned*)(lds + (bufoff) + ldsw + _i * 8192), 16, 0, 0); } while (0)
#define PG8_LDA(dst, b, h) do { _Pragma("unroll") for (int m = 0; m < 4; ++m) _Pragma("unroll") for (int k = 0; k < 2; ++k) dst[m][k] = *(const PG8_LAS bf16x8*)(lds + PG8_SA(b, h) + aoff + m * 2048 + k * 1024); } while (0)
#define PG8_LDB(dst, b, h) do { _Pragma("unroll") for (int n = 0; n < 2; ++n) _Pragma("unroll") for (int k = 0; k < 2; ++k) dst[n][k] = *(const PG8_LAS bf16x8*)(lds + PG8_SB(b, h) + boff + n * 2048 + k * 1024); } while (0)
#define PG8_MMA(ai, bj, At, Bt) do { __builtin_amdgcn_s_setprio(1); _Pragma("unroll") for (int m = 0; m < 4; ++m) _Pragma("unroll") for (int n = 0; n < 2; ++n) _Pragma("unroll") for (int k = 0; k < 2; ++k) \
        acc[ai][bj][m][n] = __builtin_amdgcn_mfma_f32_16x16x32_bf16(Bt[n][k], At[m][k], acc[ai][bj][m][n], 0, 0, 0); __builtin_amdgcn_s_setprio(0); } while (0)
#define PG8_WAIT_V(n) asm volatile("s_waitcnt vmcnt(" #n ")" ::: "memory")
#define PG8_WAIT_L(n) asm volatile("s_waitcnt lgkmcnt(" #n ")" ::: "memory")
#define PG8_BAR __builtin_amdgcn_s_barrier()
#define PG8_SCHED __builtin_amdgcn_sched_barrier(0)
    Unit cur, nxt; int ui = 0;
    if (!S.next(0, cur)) return;
    f32x4 acc[2][2][4][2];
#pragma unroll
    for (int a = 0; a < 2; ++a)
#pragma unroll
        for (int b = 0; b < 2; ++b)
#pragma unroll
            for (int m = 0; m < 4; ++m)
#pragma unroll
                for (int n = 0; n < 2; ++n) acc[a][b][m][n] = (f32x4){0.f, 0.f, 0.f, 0.f};
    bf16x8 At[4][2], B0[2][2], B1[2][2];
    const char* cA = (const char*)g.A + (size_t)cur.pm * tstep; const char* cB = (const char*)g.Bt + (size_t)cur.pn * tstep;
    S.a_ready(cur);
    if constexpr (SP2) {
        PG8_STAGE(PG8_SB(0, 0), cB, voffB); PG8_STAGE(PG8_SB(0, 1), cB + hstep, voffB); PG8_STAGE(PG8_SA(0, 0), cA, voffA); PG8_STAGE(PG8_SA(0, 1), cA + hstep, voffA);
        if (wr == 1) PG8_BAR;
        PG8_WAIT_V(2); PG8_BAR;
        PG8_STAGE(PG8_SB(1, 0), cB + kstep, voffB); PG8_STAGE(PG8_SA(1, 0), cA + kstep, voffA); PG8_STAGE(PG8_SB(1, 1), cB + hstep + kstep, voffB);
        PG8_WAIT_V(6); PG8_BAR;
    } else {
        PG8_STAGE(PG8_SB(0, 0), cB, voffB); PG8_STAGE(PG8_SA(0, 0), cA, voffA); PG8_STAGE(PG8_SB(0, 1), cB + hstep, voffB); PG8_STAGE(PG8_SA(0, 1), cA + hstep, voffA);
        if (wr == 1) PG8_BAR;
        PG8_WAIT_V(4); PG8_BAR;
        PG8_STAGE(PG8_SB(1, 0), cB + kstep, voffB); PG8_STAGE(PG8_SA(1, 0), cA + kstep, voffA); PG8_STAGE(PG8_SB(1, 1), cB + hstep + kstep, voffB);
        PG8_WAIT_V(6); PG8_BAR;
    }
    for (;;) {
        const bool has_next = S.next(ui + 1, nxt);
        const char* nA = has_next ? (const char*)g.A + (size_t)nxt.pm * tstep : cA; const char* nB = has_next ? (const char*)g.Bt + (size_t)nxt.pn * tstep : cB;
        for (int t = 0; t < nt; t += 2) {
            const bool last = (t == nt - 2);
            const char* a1 = cA + (size_t)(t + 1) * kstep;
            const char* a2 = last ? nA : cA + (size_t)(t + 2) * kstep; const char* b2 = last ? nB : cB + (size_t)(t + 2) * kstep;
            const char* a3 = a2 + kstep; const char* b3 = b2 + kstep;
            if (last && has_next) S.a_ready(nxt);
            if constexpr (SP2) {
            PG8_LDB(B0, 0, 0); PG8_LDB(B1, 0, 1); PG8_SCHED; PG8_LDA(At, 0, 0); PG8_STAGE(PG8_SA(1, 1), a1 + hstep, voffA);
            PG8_WAIT_V(8); PG8_WAIT_L(0); PG8_BAR; PG8_MMA(0, 0, At, B0); PG8_MMA(0, 1, At, B1); PG8_BAR; PG8_SCHED;
            PG8_LDA(At, 0, 1); PG8_STAGE(PG8_SB(0, 0), b2, voffB); PG8_STAGE(PG8_SB(0, 1), b2 + hstep, voffB); PG8_STAGE(PG8_SA(0, 0), a2, voffA);
            PG8_WAIT_V(8); PG8_WAIT_L(0); PG8_BAR; PG8_MMA(1, 0, At, B0); PG8_MMA(1, 1, At, B1); PG8_BAR; PG8_SCHED;
            PG8_LDB(B0, 1, 0); PG8_LDB(B1, 1, 1); PG8_SCHED; PG8_LDA(At, 1, 0); PG8_STAGE(PG8_SA(0, 1), a2 + hstep, voffA);
            PG8_WAIT_V(8); PG8_WAIT_L(0); PG8_BAR; PG8_MMA(0, 0, At, B0); PG8_MMA(0, 1, At, B1); PG8_BAR; PG8_SCHED;
            PG8_LDA(At, 1, 1); PG8_STAGE(PG8_SB(1, 0), b3, voffB); PG8_STAGE(PG8_SB(1, 1), b3 + hstep, voffB); PG8_STAGE(PG8_SA(1, 0), a3, voffA);
            PG8_WAIT_V(8); PG8_WAIT_L(0); PG8_BAR; PG8_MMA(1, 0, At, B0); PG8_MMA(1, 1, At, B1); PG8_BAR; PG8_SCHED;
            } else {
            PG8_LDB(B0, 0, 0); PG8_SCHED; PG8_LDA(At, 0, 0); PG8_STAGE(PG8_SA(1, 1), a1 + hstep, voffA);
            PG8_WAIT_L(8); PG8_BAR; PG8_WAIT_L(0); PG8_MMA(0, 0, At, B0); PG8_BAR; PG8_SCHED;
            PG8_LDB(B1, 0, 1); PG8_STAGE(PG8_SB(0, 0), b2, voffB);
            PG8_BAR; PG8_WAIT_L(0); PG8_MMA(0, 1, At, B1); PG8_BAR;
            PG8_LDA(At, 0, 1); PG8_STAGE(PG8_SA(0, 0), a2, voffA);
            PG8_BAR; PG8_WAIT_L(0); PG8_MMA(1, 0, At, B0); PG8_BAR; PG8_SCHED;
            PG8_STAGE(PG8_SB(0, 1), b2 + hstep, voffB);
            PG8_WAIT_V(6); PG8_BAR; PG8_MMA(1, 1, At, B1); PG8_BAR;
            PG8_LDB(B0, 1, 0); PG8_SCHED; PG8_LDA(At, 1, 0); PG8_STAGE(PG8_SA(0, 1), a2 + hstep, voffA);
            PG8_WAIT_L(8); PG8_BAR; PG8_WAIT_L(0); PG8_MMA(0, 0, At, B0); PG8_BAR; PG8_SCHED;
            PG8_LDB(B1, 1, 1); PG8_STAGE(PG8_SB(1, 0), b3, voffB);
            PG8_BAR; PG8_WAIT_L(0); PG8_MMA(0, 1, At, B1); PG8_BAR;
            PG8_LDA(At, 1, 1); PG8_STAGE(PG8_SA(1, 0), a3, voffA);
            PG8_BAR; PG8_WAIT_L(0); PG8_MMA(1, 0, At, B0); PG8_BAR; PG8_SCHED;
            PG8_STAGE(PG8_SB(1, 1), b3 + hstep, voffB);
            PG8_WAIT_V(6); PG8_BAR; PG8_MMA(1, 1, At, B1); PG8_BAR;
            }
        }
        if constexpr (ALIGN_EPI) { if (wr == 0) PG8_BAR; }
        if constexpr (!Epi::AFTER_DRAIN) { E(acc, cur, wr, wc, fr, fq); S.done(cur); }
        if (!has_next) break;
#pragma unroll
        for (int a = 0; a < 2; ++a)
#pragma unroll
            for (int b = 0; b < 2; ++b)
#pragma unroll
                for (int m = 0; m < 4; ++m)
#pragma unroll
                    for (int n = 0; n < 2; ++n) acc[a][b][m][n] = (f32x4){0.f, 0.f, 0.f, 0.f};
        cur = nxt; cA = nA; cB = nB; ++ui;
        if constexpr (ALIGN_EPI) { if (wr == 1) PG8_BAR; }
    }
    PG8_WAIT_V(0);
    if constexpr (!ALIGN_EPI) { if (wr == 0) PG8_BAR; }
    PG8_BAR;
    if constexpr (Epi::AFTER_DRAIN) { E.fused(acc, cur, wr, wc, fr, fq, lds, wid, lane); S.done(cur); }
#undef PG8_SA
#undef PG8_SB
#undef PG8_STAGE
#undef PG8_LDA
#undef PG8_LDB
#undef PG8_MMA
#undef PG8_WAIT_V
#undef PG8_WAIT_L
#undef PG8_BAR
#undef PG8_SCHED
}
}


#ifndef PG8_SP2
#define PG8_SP2 true
#endif
#ifndef PG8_ALIGN
#define PG8_ALIGN true
#endif
constexpr int NWAVES = 8;
constexpr int MP = pg8::MP, MS = pg8::MS, MVALID = pg8::MVALID, MT = pg8::MT, DM = 1024, DFF = 2816;
constexpr int SEQ = 4096, NB = 4, NSB = 32, PAST = 8192, NPOOL = 2560;
constexpr int ZC0 = 3328, ZC1 = 2304;
constexpr int Z1_Q = 0, Z1_K = 768, Z1_V = 1024, Z1_IQ = 1280, Z1_IK = 1792, Z1_IW = 1856, Z1_MQ = 1920;
constexpr int NMEMROWS = 1024, MEMROW0 = MT;
constexpr float EPS = 1e-6f;
constexpr size_t MiB = 1u << 20;
constexpr size_t WS_CTL = 0, CTL_ZERO_BYTES = 2 * MiB;
constexpr size_t WS_WIN0 = 2 * MiB, WS_WIN1 = 11 * MiB, WS_WOUT = 16 * MiB, WS_WGU = 20 * MiB, WS_WD = 42 * MiB;
constexpr size_t WS_XB = 54 * MiB, WS_MEMKV = 89 * MiB, WS_MIX = 94 * MiB, WS_Z = 128 * MiB, WS_U = 234 * MiB, WS_UP = 324 * MiB, WS_ACT = 414 * MiB;
constexpr size_t WS_QB = 504 * MiB, WS_KB = 528 * MiB, WS_VB = 536 * MiB, WS_IQB = 544 * MiB, WS_IKB = 560 * MiB, WS_IW = 562 * MiB;
constexpr size_t WS_SQ = 563 * MiB, WS_SIQ = WS_SQ + 512 * 1024, WS_SIW = WS_SIQ + 384 * 1024, WS_SSC = 564 * MiB, WS_SIDX = 569 * MiB, WS_MASK = 570 * MiB, WS_SC = 578 * MiB, WS_END = 834 * MiB;
constexpr int SSC_LD = 8256;
constexpr int CW_TMO = 0, CW_BAR = 4096, CW_Q = 8192, CW_SS = 16384;
constexpr size_t O_YP = 0, O_YS = O_YP + (size_t)MP * DM, O_HP = O_YS + (size_t)MS * DM, O_HS = O_HP + 4 * 6 * 16384, O_KP = O_HS + 32 * 6 * 16384,
    O_VP = O_KP + (size_t)MP * 256, O_IKP = O_VP + (size_t)MP * 256, O_KS = O_IKP + (size_t)MP * 64, O_VS = O_KS + MS * 256, O_IKS = O_VS + MS * 256,
    O_MK = O_IKS + MS * 64, O_MV = O_MK + 2 * 1024 * 256, O_CVP = O_MV + 2 * 1024 * 256, O_CVS = O_CVP + 2 * 4 * 2 * DFF, O_END = O_CVS + 2 * 32 * 2 * DFF;
static_assert(O_END == 31412224, "output size");
constexpr int RING_OFF = 0, RING_BYTES = 131072;
constexpr int LDSCTL_OFF = RING_BYTES, MISC_OFF = LDSCTL_OFF + 320;
constexpr int LDS_BYTES = 147456;

#define GAS __attribute__((address_space(1)))
#define LAS __attribute__((address_space(3)))
typedef unsigned short bf16;
typedef unsigned v4u __attribute__((ext_vector_type(4)));
typedef float f32x4 __attribute__((ext_vector_type(4)));
typedef short bf16x8 __attribute__((ext_vector_type(8)));
typedef GAS unsigned gu32;
typedef GAS unsigned long long gu64;
#define RLX_AGENT __ATOMIC_RELAXED, __HIP_MEMORY_SCOPE_AGENT
#define LDS_WAIT() asm volatile("s_waitcnt lgkmcnt(0)" ::: "memory")
#define VM_WAIT() asm volatile("s_waitcnt vmcnt(0)" ::: "memory")
__device__ __forceinline__ unsigned long long rt() { return __builtin_amdgcn_s_memrealtime(); }
__device__ __forceinline__ unsigned f2bf(float f) { unsigned u = __builtin_bit_cast(unsigned, f); return (u + 0x7fffu + ((u >> 16) & 1u)) >> 16; }
__device__ __forceinline__ unsigned pk2(float lo, float hi) { return f2bf(lo) | (f2bf(hi) << 16); }

#define XB_TMO      128
#define XB_XCNT(j)  (256  + 64 * (j))
#define XB_XSUB(j)  (1280 + 64 * (j))
#define XB_XGEN(j)  (2304 + 64 * (j))
#define XB_TOP      3328
#define XB_TOPGEN   3392
#define XCD_BAR_WORDS 3456
#define XB_SPIN_CAP (1u << 18)

__device__ __forceinline__ unsigned xb_ld(unsigned* p)              { return __hip_atomic_load(p, __ATOMIC_RELAXED, __HIP_MEMORY_SCOPE_AGENT); }
__device__ __forceinline__ unsigned xb_add(unsigned* p, unsigned v) { return __hip_atomic_fetch_add(p, v, __ATOMIC_RELAXED, __HIP_MEMORY_SCOPE_AGENT); }
__device__ __forceinline__ unsigned xb_xcc_id() { return (unsigned)__builtin_amdgcn_s_getreg((3 << 11) | 20) & 0xFu; }
#define XB_SPIN(cond, bar) do { unsigned _sp = 0; while (cond) { __builtin_amdgcn_s_sleep(1); \
    if ((++_sp & 255u) == 0u) { if (xb_ld(&(bar)[XB_TMO])) break; if (_sp > XB_SPIN_CAP) { atomicAdd(&(bar)[XB_TMO], 1u); break; } } } } while (0)

struct XcdBarrier {
    unsigned* bar; unsigned x;
    volatile LAS unsigned* st;
};

__device__ __forceinline__ XcdBarrier xcd_barrier_post(unsigned* bar, volatile LAS unsigned* st) {
    XcdBarrier b; b.bar = bar; b.x = xb_xcc_id(); b.st = st;
    if (threadIdx.x == 0) (void)xb_add(&bar[XB_XCNT(b.x)], 1u);
    return b;
}
__device__ __forceinline__ void xcd_barrier_complete(unsigned* bar, unsigned x, unsigned& nloc, unsigned& nx) {
    const unsigned G = gridDim.x * gridDim.y * gridDim.z;
    unsigned sum, cnt, mine, sp = 0u;
    for (;;) {
        sum = 0u; cnt = 0u; mine = 0u;
#pragma unroll
        for (unsigned j = 0; j < 16; ++j) { const unsigned c = xb_ld(&bar[XB_XCNT(j)]); sum += c; cnt += (c > 0u) ? 1u : 0u; mine = (j == x) ? c : mine; }
        if (sum == G) break;
        __builtin_amdgcn_s_sleep(1);
        if ((++sp & 255u) == 0u) { if (xb_ld(&bar[XB_TMO])) break; if (sp > XB_SPIN_CAP) { atomicAdd(&bar[XB_TMO], 1u); break; } }
    }
    nloc = mine > 0u ? mine : 1u; nx = cnt > 0u ? cnt : 1u;
}

__device__ __forceinline__ void xcd_barrier(const XcdBarrier& b) {
    asm volatile("s_waitcnt vmcnt(0)" ::: "memory");
    __syncthreads();
    if (threadIdx.x == 0) {
        unsigned* bar = b.bar;
        __builtin_amdgcn_s_waitcnt(0);
        unsigned nloc = b.st[0], nx = b.st[1];
        if (nloc == 0u) { xcd_barrier_complete(bar, b.x, nloc, nx); b.st[0] = nloc; b.st[1] = nx; }
        const unsigned old = xb_add(&bar[XB_XSUB(b.x)], 1u);
        const unsigned gen = old / nloc;
        if (old + 1u == (gen + 1u) * nloc) {
            __builtin_amdgcn_fence(__ATOMIC_RELEASE, "agent");
            asm volatile("s_waitcnt vmcnt(0)" ::: "memory");
            const unsigned og = xb_add(&bar[XB_TOP], 1u);
            const unsigned tg = og / nx;
            if (og + 1u == (tg + 1u) * nx) xb_add(&bar[XB_TOPGEN], 1u);
            else XB_SPIN(xb_ld(&bar[XB_TOPGEN]) == tg, bar);
            __builtin_amdgcn_fence(__ATOMIC_ACQUIRE, "agent");
            xb_add(&bar[XB_XGEN(b.x)], 1u);
            asm volatile("s_waitcnt vmcnt(0)" ::: "memory");
        } else {
            XB_SPIN(xb_ld(&bar[XB_XGEN(b.x)]) == gen, bar);
            __builtin_amdgcn_fence(__ATOMIC_ACQUIRE, "agent");
            asm volatile("s_waitcnt vmcnt(0)" ::: "memory");
        }
    }
    __syncthreads();
}


struct Args { const float* in[29]; const int* page_table; float* out; unsigned char* ws; int ph_lo, ph_hi; };
typedef const __attribute__((address_space(4))) Args& ARGREF;
struct Ctx { LAS unsigned char* lds; volatile LAS unsigned* MISC; gu32* ctl; int tid, lane, wave, vcu, G, qoff; };
typedef float f32x16 __attribute__((ext_vector_type(16)));
typedef unsigned long long u64;

__device__ __forceinline__ float bf2f(unsigned b) { return __builtin_bit_cast(float, b << 16); }
__device__ __forceinline__ float wave_sum(float v) {
#pragma unroll
    for (int o = 1; o < 64; o <<= 1) v += __shfl_xor(v, o);
    return v;
}
__device__ __forceinline__ int crow(int r, int hi) { return (r & 3) + 8 * (r >> 2) + 4 * hi; }
__device__ __forceinline__ float sigmoidf_(float x) { return 1.0f / (1.0f + __expf(-x)); }
__device__ __forceinline__ float* ssptr(const Ctx& c, int i) { return (float*)(c.ctl + CW_SS) + (size_t)i * MT; }

__device__ __forceinline__ int q_next(Ctx& c, int qi) {
    __syncthreads();
    if (c.tid == 0) c.MISC[16] = atomicAdd((unsigned*)(c.ctl + CW_Q + 64 * (qi + c.qoff)), 1u);
    __syncthreads();
    return (int)c.MISC[16];
}

template <int K>
__device__ __forceinline__ f32x16 mm32(const LAS bf16* A, int lda, const LAS bf16* Bt, int ldb, f32x16 acc, int lane) {
    const int r = lane & 31, h = lane >> 5;
#pragma unroll
    for (int ks = 0; ks < K; ks += 16) {
        const bf16x8 a = *(const LAS bf16x8*)(A + r * lda + ks + 8 * h);
        const bf16x8 b = *(const LAS bf16x8*)(Bt + r * ldb + ks + 8 * h);
        acc = __builtin_amdgcn_mfma_f32_32x32x16_bf16(a, b, acc, 0, 0, 0);
    }
    return acc;
}

__device__ __forceinline__ int map_row(int mapid, int n, int row_off) {
    if (mapid == 0) return n + row_off;
    if (mapid == 1) return n < 1864 ? n : n + 56;
    if (mapid == 2) return (n >> 7) * 256 + (n & 127);
    return (n >> 7) * 256 + 128 + (n & 127);
}
__device__ __forceinline__ void transpose_item(const float* W, int K, int N, const float* kscale, bf16* WT, int mapid, int row_off, LAS float* scr, int item, int lane) {
    const int nblk = (N + 31) / 32, kb = item / nblk, nb = item % nblk, k0 = 64 * kb, n0 = 32 * nb;
    { const int n4 = (lane & 7) * 4, nn = n0 + n4 < N ? n0 + n4 : N - 4; f32x4 v[8];
#pragma unroll
      for (int i = 0; i < 8; ++i) v[i] = *(const f32x4*)(W + (size_t)(k0 + 8 * i + (lane >> 3)) * N + nn);
#pragma unroll
      for (int i = 0; i < 8; ++i) { const int kk = 8 * i + (lane >> 3); const float sc = kscale ? kscale[k0 + kk] : 1.0f; LAS float* d = scr + kk * 33 + n4;
          d[0] = v[i].x * sc; d[1] = v[i].y * sc; d[2] = v[i].z * sc; d[3] = v[i].w * sc; } }
    LDS_WAIT(); asm volatile("" ::: "memory");
    const int cc = lane & 7;
#pragma unroll
    for (int j = 0; j < 4; ++j) { const int nl = (lane >> 3) + 8 * j, n = n0 + nl; const LAS float* s = scr + (8 * cc) * 33 + nl;
        v4u o; o.x = pk2(s[0 * 33], s[1 * 33]); o.y = pk2(s[2 * 33], s[3 * 33]); o.z = pk2(s[4 * 33], s[5 * 33]); o.w = pk2(s[6 * 33], s[7 * 33]);
        if (n < N) *(GAS v4u*)(WT + (size_t)map_row(mapid, n, row_off) * K + k0 + 8 * cc) = o; }
    LDS_WAIT(); asm volatile("" ::: "memory");
}
constexpr int I_INH = 16 * 104, I_MKV = 16 * 16, I_DSA = 16 * 67, I_OUT = 16 * 32, I_G = 16 * 88, I_D = 44 * 32;
constexpr int W_N0 = I_INH + 2 * I_MKV + I_OUT + 2 * I_G + I_D, W_NITEMS = W_N0 + I_DSA + I_OUT + 2 * I_G + I_D;
__device__ __forceinline__ void convert_item(ARGREF a, int it, LAS float* scr, int lane) {
    unsigned char* ws = a.ws; int r = it;
    if (r < I_INH) { transpose_item(a.in[13], 1024, 3328, a.in[11], (bf16*)(ws + WS_WIN0), 0, 0, scr, r, lane); return; } r -= I_INH;
    if (r < 2 * I_MKV) { const int l = r / I_MKV; transpose_item(a.in[20] + (size_t)l * 1024 * 512, 1024, 512, nullptr, (bf16*)(ws + WS_WIN0), 0, 3328 + 512 * l, scr, r % I_MKV, lane); return; } r -= 2 * I_MKV;
    int l = 0;
    if (r >= I_OUT + 2 * I_G + I_D) { r -= I_OUT + 2 * I_G + I_D; l = 1;
        if (r < I_DSA) { transpose_item(a.in[16], 1024, 2120, a.in[11] + 1024, (bf16*)(ws + WS_WIN1), 1, 0, scr, r, lane); return; } r -= I_DSA; }
    if (r < I_OUT) { transpose_item(a.in[23] + (size_t)l * 1024 * 1024, 1024, 1024, nullptr, (bf16*)(ws + WS_WOUT) + (size_t)l * 1024 * 1024, 0, 0, scr, r, lane); return; } r -= I_OUT;
    if (r < I_G) { transpose_item(a.in[24] + (size_t)l * 1024 * DFF, 1024, DFF, a.in[12] + l * 1024, (bf16*)(ws + WS_WGU) + (size_t)l * 5632 * 1024, 2, 0, scr, r, lane); return; } r -= I_G;
    if (r < I_G) { transpose_item(a.in[25] + (size_t)l * 1024 * DFF, 1024, DFF, a.in[12] + l * 1024, (bf16*)(ws + WS_WGU) + (size_t)l * 5632 * 1024, 3, 0, scr, r, lane); return; } r -= I_G;
    transpose_item(a.in[28] + (size_t)l * DFF * 1024, DFF, 1024, nullptr, (bf16*)(ws + WS_WD) + (size_t)l * 1024 * DFF, 0, 0, scr, r, lane);
}
__device__ __forceinline__ void convert_layer1_tail(Ctx& c, ARGREF a, int first_idle) {
    LAS float* scr = (LAS float*)(c.lds + RING_OFF + c.wave * 16384);
    const int bx = (int)blockIdx.x; if (bx < first_idle) return;
    const int nw = (c.G - first_idle) * NWAVES;
    for (int it = W_N0 + (bx - first_idle) * NWAVES + c.wave; it < W_NITEMS; it += nw) convert_item(a, it, scr, c.lane);
}
__device__ __forceinline__ void p0_prologue(Ctx& c, ARGREF a) {
    LAS float* scr = (LAS float*)(c.lds + RING_OFF + c.wave * 16384);
    const int gw = c.vcu * NWAVES + c.wave, NGW = c.G * NWAVES, lane = c.lane;
    unsigned char* ws = a.ws;
    for (int it = gw; it < W_N0; it += NGW) convert_item(a, it, scr, lane);
    for (int rr = gw; rr < 184; rr += NGW) { const int row = rr < 56 ? 1864 + rr : 2176 + (rr - 56);
        GAS v4u* p = (GAS v4u*)((bf16*)(ws + WS_WIN1) + (size_t)row * 1024); p[lane] = (v4u){0u, 0u, 0u, 0u}; p[64 + lane] = (v4u){0u, 0u, 0u, 0u}; }
    float* ss0 = ssptr(c, 0);
    for (int m = gw; m < MT + NMEMROWS; m += NGW) {
        GAS u64* o8 = (GAS u64*)((bf16*)(ws + WS_XB) + (size_t)m * DM) + lane;
        if (m >= MVALID && m < MT) {
#pragma unroll
            for (int j = 0; j < 4; ++j) o8[64 * j] = 0ull;
            continue; }
        const float* src = m < MP ? a.in[0] + (size_t)m * DM : (m < MVALID ? a.in[1] + (size_t)(m - MP) * DM : a.in[10] + (size_t)(m - MT) * DM);
        const GAS f32x4* xr = (const GAS f32x4*)src + lane; f32x4 v[4]; float s = 0.f;
#pragma unroll
        for (int j = 0; j < 4; ++j) { v[j] = xr[64 * j]; s += (v[j].x * v[j].x + v[j].y * v[j].y) + (v[j].z * v[j].z + v[j].w * v[j].w); }
        s = wave_sum(s);
#pragma unroll
        for (int j = 0; j < 4; ++j) o8[64 * j] = (u64)pk2(v[j].x, v[j].y) | ((u64)pk2(v[j].z, v[j].w) << 32);
        if (m < MVALID && lane == 0) ss0[m] = s;
    }
}

__device__ __forceinline__ void memattn_unit(Ctx& c, const bf16* Zq  , int ldz, int nrows_valid, const float* Kp, const float* Vp, int kstride,
                                             bool normk, const float* kgain, const float* qgain, bf16* Out  ) {
    LAS bf16* KN = (LAS bf16*)(c.lds);
    LAS bf16* VTm = (LAS bf16*)(c.lds + 36864);
    LAS bf16* QN = (LAS bf16*)(c.lds + 70656) + c.wave * (32 * 72);
    LAS float* LI = (LAS float*)(c.lds + 107520) + c.wave * 32;
    int tid = c.tid; asm volatile("" : "+v"(tid));
    const int lane = tid & 63, w = c.wave;
    {
        const int m = tid >> 1, dh = (tid & 1) * 32;
        f32x4 kv[8]; float s = 0.f;
#pragma unroll
        for (int j = 0; j < 8; ++j) { kv[j] = *(const f32x4*)(Kp + (size_t)m * kstride + dh + 4 * j); s += (kv[j].x * kv[j].x + kv[j].y * kv[j].y) + (kv[j].z * kv[j].z + kv[j].w * kv[j].w); }
        s += __shfl_xor(s, 1);
        const float rs = normk ? rsqrtf(s * (1.0f / 64.0f) + EPS) : 1.0f;
#pragma unroll
        for (int j = 0; j < 8; j += 2) { f32x4 g0 = {1.f, 1.f, 1.f, 1.f}, g1 = g0;
            if (normk) { g0 = *(const f32x4*)(kgain + dh + 4 * j); g1 = *(const f32x4*)(kgain + dh + 4 * j + 4); }
            const f32x4 x0 = kv[j] * rs * g0, x1 = kv[j + 1] * rs * g1;
            v4u o; o.x = pk2(x0.x, x0.y); o.y = pk2(x0.z, x0.w); o.z = pk2(x1.x, x1.y); o.w = pk2(x1.z, x1.w);
            *(LAS v4u*)(KN + m * 72 + dh + 4 * j) = o; }
#pragma unroll
        for (int j = 0; j < 8; ++j) { const f32x4 vv = *(const f32x4*)(Vp + (size_t)m * kstride + dh + 4 * j);
            VTm[(dh + 4 * j + 0) * 264 + m] = (bf16)f2bf(vv.x); VTm[(dh + 4 * j + 1) * 264 + m] = (bf16)f2bf(vv.y);
            VTm[(dh + 4 * j + 2) * 264 + m] = (bf16)f2bf(vv.z); VTm[(dh + 4 * j + 3) * 264 + m] = (bf16)f2bf(vv.w); }
    }
    {
        const int row = lane >> 1, hf = lane & 1, grow = w * 32 + row;
        float x[32]; float s = 0.f;
        if (grow < nrows_valid) {
#pragma unroll
            for (int j = 0; j < 4; ++j) { const v4u q = *(const v4u*)(Zq + (size_t)grow * ldz + hf * 32 + 8 * j);
                x[8 * j + 0] = bf2f(q.x & 0xffffu); x[8 * j + 1] = bf2f(q.x >> 16); x[8 * j + 2] = bf2f(q.y & 0xffffu); x[8 * j + 3] = bf2f(q.y >> 16);
                x[8 * j + 4] = bf2f(q.z & 0xffffu); x[8 * j + 5] = bf2f(q.z >> 16); x[8 * j + 6] = bf2f(q.w & 0xffffu); x[8 * j + 7] = bf2f(q.w >> 16); }
        } else {
#pragma unroll
            for (int j = 0; j < 32; ++j) x[j] = 0.f;
        }
#pragma unroll
        for (int j = 0; j < 32; ++j) s += x[j] * x[j];
        s += __shfl_xor(s, 1);
        const float rs = rsqrtf(s * (1.0f / 64.0f) + EPS) * 0.125f;
#pragma unroll
        for (int j = 0; j < 32; j += 8) { v4u o;
            o.x = pk2(x[j] * rs * qgain[hf * 32 + j], x[j + 1] * rs * qgain[hf * 32 + j + 1]); o.y = pk2(x[j + 2] * rs * qgain[hf * 32 + j + 2], x[j + 3] * rs * qgain[hf * 32 + j + 3]);
            o.z = pk2(x[j + 4] * rs * qgain[hf * 32 + j + 4], x[j + 5] * rs * qgain[hf * 32 + j + 5]); o.w = pk2(x[j + 6] * rs * qgain[hf * 32 + j + 6], x[j + 7] * rs * qgain[hf * 32 + j + 7]);
            *(LAS v4u*)(QN + row * 72 + hf * 32 + j) = o; }
    }
    __syncthreads();
    if (w * 32 < nrows_valid) {
        const int r32 = lane & 31, hh = lane >> 5;
        f32x16 s[8];
#pragma unroll
        for (int mt = 0; mt < 8; ++mt) { f32x16 z = {}; s[mt] = mm32<64>(KN + mt * 32 * 72, 72, QN, 72, z, lane); }
        float mx = -1e30f;
#pragma unroll
        for (int mt = 0; mt < 8; ++mt)
#pragma unroll
            for (int r = 0; r < 16; ++r) mx = fmaxf(mx, s[mt][r]);
        mx = fmaxf(mx, __shfl_xor(mx, 32));
        float l = 0.f;
#pragma unroll
        for (int mt = 0; mt < 8; ++mt)
#pragma unroll
            for (int r = 0; r < 16; ++r) { const float p = __expf(s[mt][r] - mx); s[mt][r] = p; l += p; }
        l += __shfl_xor(l, 32);
        if (hh == 0) LI[r32] = l;
        f32x16 o[2] = {};
#pragma unroll
        for (int mt = 0; mt < 8; ++mt)
#pragma unroll
            for (int sx = 0; sx < 2; ++sx) {
                v4u pa; pa.x = pk2(s[mt][8 * sx + 0], s[mt][8 * sx + 1]); pa.y = pk2(s[mt][8 * sx + 2], s[mt][8 * sx + 3]);
                pa.z = pk2(s[mt][8 * sx + 4], s[mt][8 * sx + 5]); pa.w = pk2(s[mt][8 * sx + 6], s[mt][8 * sx + 7]);
                const bf16x8 af = __builtin_bit_cast(bf16x8, pa);
#pragma unroll
                for (int dt = 0; dt < 2; ++dt) { const LAS bf16* vp = VTm + (dt * 32 + r32) * 264 + mt * 32 + 16 * sx + 4 * hh;
                    const u64 lo = *(const LAS u64*)vp, hi = *(const LAS u64*)(vp + 8);
                    v4u bw; bw.x = (unsigned)lo; bw.y = (unsigned)(lo >> 32); bw.z = (unsigned)hi; bw.w = (unsigned)(hi >> 32);
                    o[dt] = __builtin_amdgcn_mfma_f32_32x32x16_bf16(af, __builtin_bit_cast(bf16x8, bw), o[dt], 0, 0, 0); }
            }
        LDS_WAIT();
#pragma unroll
        for (int r = 0; r < 16; ++r) { const int qr = crow(r, hh), grow = w * 32 + qr; const float il = 1.0f / LI[qr];
            if (grow < nrows_valid) {
#pragma unroll
                for (int dt = 0; dt < 2; ++dt) Out[(size_t)grow * DM + dt * 32 + r32] = (bf16)f2bf(o[dt][r] * il); } }
    }
}

constexpr int HG_GS = 4, HG_NG = SEQ / (32 * HG_GS);
constexpr size_t WS_HOL = WS_U, WS_HQC = WS_UP, WS_HUT = WS_ACT, WS_HST = WS_ACT + 64 * MiB, WS_HDG = WS_ACT + 50 * MiB;
template <bool PROMPT>
__device__ __forceinline__ void hgrn_unit(Ctx& c, ARGREF a, int b, int h, int g) {
    LAS unsigned char* L = c.lds;
    LAS float* LF = (LAS float*)(L + 0);
    LAS float* BL = (LAS float*)(L + 16384);
    LAS float* DVv = (LAS float*)(L + 16896);
    LAS bf16* QD = (LAS bf16*)(L + 17408);
    LAS bf16* KD = (LAS bf16*)(L + 26112);
    LAS bf16* KET = (LAS bf16*)(L + 34816);
    LAS bf16* VT = (LAS bf16*)(L + 45056);
    LAS bf16* SCB = (LAS bf16*)(L + 55296);
    LAS bf16* STt = (LAS bf16*)(L + 57856);
    LAS float* BOFF = (LAS float*)(L + 92672);
    int tid = c.tid; asm volatile("" : "+v"(tid));
    const int lane = tid & 63, w = c.wave, r32 = lane & 31, hh = lane >> 5;
    const int te = tid >> 4, k8 = (tid & 15) * 8;
    const bf16* Z = (const bf16*)(a.ws + WS_Z);
    bf16* MIX = (bf16*)(a.ws + WS_MIX);
    const int nch = PROMPT ? HG_GS : 1, nvalid = PROMPT ? 32 : 4;
    const int kt = w >> 1, vt0 = 2 * (w & 1);
    const int unit = (b * 6 + h) * HG_NG + g;
    f32x16 S0 = {}, S1 = {};
    if (!PROMPT) { const float* sp = a.in[7] + (size_t)(b * 6 + h) * 16384;
#pragma unroll
        for (int r = 0; r < 16; ++r) { const int k = 32 * kt + crow(r, hh); S0[r] = sp[k * 128 + 32 * vt0 + r32]; S1[r] = sp[k * 128 + 32 * (vt0 + 1) + r32]; } }
    float lbv[8], onv[8];
#pragma unroll
    for (int j = 0; j < 8; ++j) { const float l0 = a.in[14][h * 128 + k8 + j], l1 = a.in[14][768 + h * 128 + k8 + j]; lbv[j] = 1.0f / (1.0f + __expf(l1 - l0)); onv[j] = a.in[15][k8 + j]; }
    __syncthreads();
    if (tid < 128) BOFF[tid] = 0.f;
#define HG_WRITE_ST() do { _Pragma("unroll") for (int g4 = 0; g4 < 4; ++g4) { const int k0 = 32 * kt + 8 * g4 + 4 * hh; \
        *(LAS u64*)(STt + (32 * vt0 + r32) * 136 + k0) = (u64)pk2(S0[4 * g4], S0[4 * g4 + 1]) | ((u64)pk2(S0[4 * g4 + 2], S0[4 * g4 + 3]) << 32); \
        *(LAS u64*)(STt + (32 * (vt0 + 1) + r32) * 136 + k0) = (u64)pk2(S1[4 * g4], S1[4 * g4 + 1]) | ((u64)pk2(S1[4 * g4 + 2], S1[4 * g4 + 3]) << 32); } } while (0)
    HG_WRITE_ST();
    v4u zq = {0u, 0u, 0u, 0u}, zf = zq, zi = zq, gz = zq;
    { const int row = (PROMPT ? b * SEQ + (g * HG_GS) * 32 : MP + 4 * b) + te;
      if (te < nvalid) { const bf16* zr = Z + (size_t)row * ZC0 + h * 128 + k8; zq = *(const v4u*)zr; zf = *(const v4u*)(zr + 768); zi = *(const v4u*)(zr + 1536); if (!PROMPT) gz = *(const v4u*)(zr + 2304); } }
#pragma unroll 1
    for (int ch = 0; ch < nch; ++ch) {
        const int row0 = PROMPT ? b * SEQ + (g * HG_GS + ch) * 32 : MP + 4 * b, row = row0 + te;
        const bool valid = te < nvalid;
        float qs[8], kk[8];
        {
            const unsigned qw[4] = {zq.x, zq.y, zq.z, zq.w}, fw[4] = {zf.x, zf.y, zf.z, zf.w}, iw[4] = {zi.x, zi.y, zi.z, zi.w};
            float lf[8];
#pragma unroll
            for (int j = 0; j < 8; ++j) { const float q = bf2f((qw[j >> 1] >> (16 * (j & 1))) & 0xffffu), fp = bf2f((fw[j >> 1] >> (16 * (j & 1))) & 0xffffu);
                const float sg = sigmoidf_(fp), f = lbv[j] + (1.0f - lbv[j]) * sg;
                qs[j] = valid ? q * sigmoidf_(q) : 0.f; kk[j] = valid ? (1.0f - f) : 0.f; lf[j] = valid ? __logf(f) : 0.f;
                VT[(k8 + j) * 40 + te] = (bf16)((iw[j >> 1] >> (16 * (j & 1))) & 0xffffu); }
            *(LAS f32x4*)(LF + te * 128 + k8) = (f32x4){lf[0], lf[1], lf[2], lf[3]}; *(LAS f32x4*)(LF + te * 128 + k8 + 4) = (f32x4){lf[4], lf[5], lf[6], lf[7]};
            if (PROMPT && ch + 1 < nch) { const bf16* zr = Z + (size_t)(row + 32) * ZC0 + h * 128 + k8; zq = *(const v4u*)zr; zf = *(const v4u*)(zr + 768); zi = *(const v4u*)(zr + 1536); }
        }
        __syncthreads();
        if (tid < 128) { float bsum = 0.f;
#pragma unroll
            for (int t = 0; t < 32; ++t) { bsum += LF[t * 128 + tid]; LF[t * 128 + tid] = bsum; }
            BL[tid] = bsum; }
        __syncthreads();
        {
            const f32x4 b0 = *(const LAS f32x4*)(LF + te * 128 + k8), b1 = *(const LAS f32x4*)(LF + te * 128 + k8 + 4);
            const f32x4 l0 = *(const LAS f32x4*)(BL + k8), l1 = *(const LAS f32x4*)(BL + k8 + 4);
            const float bb[8] = {b0.x, b0.y, b0.z, b0.w, b1.x, b1.y, b1.z, b1.w}, bl[8] = {l0.x, l0.y, l0.z, l0.w, l1.x, l1.y, l1.z, l1.w};
            float qd[8], kd[8];
#pragma unroll
            for (int j = 0; j < 8; ++j) { qd[j] = qs[j] * __expf(bb[j]); kd[j] = kk[j] * __expf(-bb[j]); KET[(k8 + j) * 40 + te] = (bf16)f2bf(kk[j] * __expf(bl[j] - bb[j])); }
            v4u o; o.x = pk2(qd[0], qd[1]); o.y = pk2(qd[2], qd[3]); o.z = pk2(qd[4], qd[5]); o.w = pk2(qd[6], qd[7]); *(LAS v4u*)(QD + te * 136 + k8) = o;
            if (PROMPT) { const f32x4 f0 = *(const LAS f32x4*)(BOFF + k8), f1 = *(const LAS f32x4*)(BOFF + k8 + 4);
                const float bo[8] = {f0.x, f0.y, f0.z, f0.w, f1.x, f1.y, f1.z, f1.w}; float qc[8];
#pragma unroll
                for (int j = 0; j < 8; ++j) qc[j] = qd[j] * __expf(bo[j]);
                v4u oc; oc.x = pk2(qc[0], qc[1]); oc.y = pk2(qc[2], qc[3]); oc.z = pk2(qc[4], qc[5]); oc.w = pk2(qc[6], qc[7]);
                *(v4u*)((bf16*)(a.ws + WS_HQC) + (size_t)row * 768 + h * 128 + k8) = oc; }
            o.x = pk2(kd[0], kd[1]); o.y = pk2(kd[2], kd[3]); o.z = pk2(kd[4], kd[5]); o.w = pk2(kd[6], kd[7]); *(LAS v4u*)(KD + te * 136 + k8) = o;
            if (te == 0) {
#pragma unroll
                for (int j = 0; j < 8; ++j) DVv[k8 + j] = __expf(bl[j]); }
        }
        __syncthreads();
        f32x16 oacc = {};
        if (w == 4) { f32x16 z = {}; const f32x16 sc = mm32<128>(QD, 136, KD, 136, z, lane);
#pragma unroll
            for (int r = 0; r < 16; ++r) { const int t = crow(r, hh); SCB[t * 40 + r32] = (bf16)f2bf(r32 <= t ? sc[r] : 0.f); } }
        if (w < 4) oacc = mm32<128>(QD, 136, STt + (w * 32) * 136, 136, oacc, lane);
        if (PROMPT && tid >= 384) BOFF[tid - 384] += BL[tid - 384];
        __syncthreads();
        if (w < 4) { oacc = mm32<32>(SCB, 40, VT + (w * 32) * 40, 40, oacc, lane);
#pragma unroll
            for (int r = 0; r < 16; ++r) LF[crow(r, hh) * 128 + w * 32 + r32] = oacc[r]; }
        {
#pragma unroll
            for (int r = 0; r < 16; ++r) { const float d = DVv[32 * kt + crow(r, hh)]; S0[r] *= d; S1[r] *= d; }
            S0 = mm32<32>(KET + (kt * 32) * 40, 40, VT + (vt0 * 32) * 40, 40, S0, lane);
            S1 = mm32<32>(KET + (kt * 32) * 40, 40, VT + ((vt0 + 1) * 32) * 40, 40, S1, lane);
        }
        __syncthreads();
        HG_WRITE_ST();
        {
            const f32x4 o0 = *(const LAS f32x4*)(LF + te * 128 + k8), o1 = *(const LAS f32x4*)(LF + te * 128 + k8 + 4);
            if (PROMPT) { float* ol = (float*)(a.ws + WS_HOL) + (size_t)row * 768 + h * 128 + k8; *(f32x4*)ol = o0; *(f32x4*)(ol + 4) = o1; }
            else {
                float ov[8] = {o0.x, o0.y, o0.z, o0.w, o1.x, o1.y, o1.z, o1.w}; float s = 0.f;
#pragma unroll
                for (int j = 0; j < 8; ++j) s += ov[j] * ov[j];
                s += __shfl_xor(s, 1); s += __shfl_xor(s, 2); s += __shfl_xor(s, 4); s += __shfl_xor(s, 8);
                const float rs = rsqrtf(s * (1.0f / 128.0f) + EPS);
                const unsigned gw_[4] = {gz.x, gz.y, gz.z, gz.w}; float y[8];
#pragma unroll
                for (int j = 0; j < 8; ++j) { const float gg = bf2f((gw_[j >> 1] >> (16 * (j & 1))) & 0xffffu); y[j] = ov[j] * rs * onv[j] * (gg * sigmoidf_(gg)); }
                if (valid) { v4u o; o.x = pk2(y[0], y[1]); o.y = pk2(y[2], y[3]); o.z = pk2(y[4], y[5]); o.w = pk2(y[6], y[7]); *(v4u*)(MIX + (size_t)row * DM + h * 128 + k8) = o; }
            }
        }
        __syncthreads();
    }
#undef HG_WRITE_ST
    if (PROMPT) {
        float* ut = (float*)(a.ws + WS_HUT) + (size_t)unit * 16384;
#pragma unroll
        for (int g4 = 0; g4 < 4; ++g4) { const int k0 = 32 * kt + 8 * g4 + 4 * hh;
            *(f32x4*)(ut + (32 * vt0 + r32) * 128 + k0) = (f32x4){S0[4 * g4], S0[4 * g4 + 1], S0[4 * g4 + 2], S0[4 * g4 + 3]};
            *(f32x4*)(ut + (32 * (vt0 + 1) + r32) * 128 + k0) = (f32x4){S1[4 * g4], S1[4 * g4 + 1], S1[4 * g4 + 2], S1[4 * g4 + 3]}; }
        if (tid < 128) ((float*)(a.ws + WS_HDG))[(size_t)unit * 128 + tid] = __expf(BOFF[tid]);
    } else {
        float* so = a.out + O_HS + (size_t)(b * 6 + h) * 16384;
#pragma unroll
        for (int r = 0; r < 16; ++r) { const int k = 32 * kt + crow(r, hh); so[k * 128 + 32 * vt0 + r32] = S0[r]; so[k * 128 + 32 * (vt0 + 1) + r32] = S1[r]; }
    }
}
__device__ __forceinline__ void hgrn_scan(Ctx& c, ARGREF a) {
    const float* UT = (const float*)(a.ws + WS_HUT); const float* DG = (const float*)(a.ws + WS_HDG); bf16* STo = (bf16*)(a.ws + WS_HST);
    for (int idx = c.vcu * 512 + c.tid; idx < 24 * 16384; idx += c.G * 512) {
        const int bh = idx >> 14, e = idx & 16383, k = e & 127, v = e >> 7;
        float s = 0.f;
#pragma unroll 8
        for (int g = 0; g < HG_NG; ++g) { const size_t u = (size_t)(bh * HG_NG + g); STo[u * 16384 + e] = (bf16)f2bf(s); s = DG[u * 128 + k] * s + UT[u * 16384 + e]; }
        a.out[O_HP + (size_t)bh * 16384 + k * 128 + v] = s;
    }
}
__device__ __forceinline__ void hgrn_fix_unit(Ctx& c, ARGREF a, int b, int h, int g) {
    LAS bf16* STt = (LAS bf16*)(c.lds);
    LAS bf16* QCl = (LAS bf16*)(c.lds + 34816);
    LAS float* OB = (LAS float*)(c.lds + 34816 + 17408);
    int tid = c.tid; asm volatile("" : "+v"(tid));
    const int lane = tid & 63, w = c.wave, r32 = lane & 31, hh = lane >> 5;
    const int unit = (b * 6 + h) * HG_NG + g, row0 = b * SEQ + g * 128;
    const bf16* Z = (const bf16*)(a.ws + WS_Z); bf16* MIX = (bf16*)(a.ws + WS_MIX);
    const bf16* QC = (const bf16*)(a.ws + WS_HQC); const float* OL = (const float*)(a.ws + WS_HOL);
    const bf16* stg = (const bf16*)(a.ws + WS_HST) + (size_t)unit * 16384;
    __syncthreads();
#pragma unroll
    for (int i = 0; i < 4; ++i) { const int cidx = tid + 512 * i, v = cidx >> 4, kc = (cidx & 15) * 8; *(LAS v4u*)(STt + v * 136 + kc) = *(const v4u*)(stg + v * 128 + kc); }
    const int te = tid >> 4, k8 = (tid & 15) * 8;
    float onv[8];
#pragma unroll
    for (int j = 0; j < 8; ++j) onv[j] = a.in[15][k8 + j];
#pragma unroll 1
    for (int hf = 0; hf < 2; ++hf) {
        const int rb = row0 + hf * 64;
#pragma unroll
        for (int i = 0; i < 2; ++i) { const int cidx = tid + 512 * i, r = cidx >> 4, kc = (cidx & 15) * 8; *(LAS v4u*)(QCl + r * 136 + kc) = *(const v4u*)(QC + (size_t)(rb + r) * 768 + h * 128 + kc); }
        __syncthreads();
        { const int rt = w >> 2, vt = w & 3; f32x16 o = {};
          o = mm32<128>(QCl + (rt * 32) * 136, 136, STt + (vt * 32) * 136, 136, o, lane);
#pragma unroll
          for (int r = 0; r < 16; ++r) OB[(rt * 32 + crow(r, hh)) * 128 + vt * 32 + r32] = o[r]; }
        __syncthreads();
#pragma unroll
        for (int ps = 0; ps < 2; ++ps) { const int r = ps * 32 + te, row = rb + r;
            const f32x4 c0 = *(const LAS f32x4*)(OB + r * 128 + k8), c1 = *(const LAS f32x4*)(OB + r * 128 + k8 + 4);
            const float* ol = OL + (size_t)row * 768 + h * 128 + k8; const f32x4 l0 = *(const f32x4*)ol, l1 = *(const f32x4*)(ol + 4);
            const v4u gz = *(const v4u*)(Z + (size_t)row * ZC0 + 2304 + h * 128 + k8);
            float ov[8] = {c0.x + l0.x, c0.y + l0.y, c0.z + l0.z, c0.w + l0.w, c1.x + l1.x, c1.y + l1.y, c1.z + l1.z, c1.w + l1.w}; float s = 0.f;
#pragma unroll
            for (int j = 0; j < 8; ++j) s += ov[j] * ov[j];
            s += __shfl_xor(s, 1); s += __shfl_xor(s, 2); s += __shfl_xor(s, 4); s += __shfl_xor(s, 8);
            const float rs = rsqrtf(s * (1.0f / 128.0f) + EPS);
            const unsigned gw_[4] = {gz.x, gz.y, gz.z, gz.w}; float y[8];
#pragma unroll
            for (int j = 0; j < 8; ++j) { const float gg = bf2f((gw_[j >> 1] >> (16 * (j & 1))) & 0xffffu); y[j] = ov[j] * rs * onv[j] * (gg * sigmoidf_(gg)); }
            v4u o; o.x = pk2(y[0], y[1]); o.y = pk2(y[2], y[3]); o.z = pk2(y[4], y[5]); o.w = pk2(y[6], y[7]); *(v4u*)(MIX + (size_t)row * DM + h * 128 + k8) = o; }
        __syncthreads();
    }
}

__device__ __forceinline__ void memkv_finalize_row(ARGREF a, int layer, int row, int lane) {
    const float* src = (const float*)(a.ws + WS_MEMKV) + (size_t)row * 1024 + layer * 512;
    const int hd = lane >> 4, d4 = (lane & 15) * 4;
    const f32x4 k = *(const f32x4*)(src + hd * 64 + d4), v = *(const f32x4*)(src + 256 + hd * 64 + d4);
    float s = (k.x * k.x + k.y * k.y) + (k.z * k.z + k.w * k.w);
    s += __shfl_xor(s, 1); s += __shfl_xor(s, 2); s += __shfl_xor(s, 4); s += __shfl_xor(s, 8);
    const float rs = rsqrtf(s * (1.0f / 64.0f) + EPS); const f32x4 g = *(const f32x4*)(a.in[22] + layer * 64 + d4);
    *(f32x4*)(a.out + O_MK + ((size_t)layer * 1024 + row) * 256 + hd * 64 + d4) = k * rs * g;
    *(f32x4*)(a.out + O_MV + ((size_t)layer * 1024 + row) * 256 + hd * 64 + d4) = v;
}

__device__ __forceinline__ void memattn_prompt_unit(Ctx& c, ARGREF a, int layer, int u) {
    const int blk = u & 15, hd = (u >> 4) & 3, b = u >> 6;
    const bf16* Z = (const bf16*)(a.ws + WS_Z); const int ldz = layer ? ZC1 : ZC0, qc = layer ? Z1_MQ : 3072;
    const float* kv = (const float*)(a.ws + WS_MEMKV) + (size_t)(b * 256) * 1024 + layer * 512 + hd * 64;
    const int row0 = b * SEQ + blk * 256;
    memattn_unit(c, Z + (size_t)row0 * ldz + qc + hd * 64, ldz, 256, kv, kv + 256, 1024, true, a.in[22] + layer * 64, a.in[21] + layer * 64,
                 (bf16*)(a.ws + WS_MIX) + (size_t)row0 * DM + 768 + hd * 64);
}
__device__ __forceinline__ void memattn_sample_unit(Ctx& c, ARGREF a, int layer, int u) {
    const int hd = u & 3, sb = u >> 2;
    const bf16* Z = (const bf16*)(a.ws + WS_Z); const int ldz = layer ? ZC1 : ZC0, qc = layer ? Z1_MQ : 3072;
    const size_t off = ((size_t)(layer * 32 + sb) * 256) * 256 + hd * 64;
    const int row0 = MP + sb * 4;
    memattn_unit(c, Z + (size_t)row0 * ldz + qc + hd * 64, ldz, 4, a.in[5] + off, a.in[6] + off, 256, false, nullptr, a.in[21] + layer * 64,
                 (bf16*)(a.ws + WS_MIX) + (size_t)row0 * DM + 768 + hd * 64);
}

__device__ __forceinline__ void p2_mixer0(Ctx& c, ARGREF a) {
    constexpr int U_HP = 24 * HG_NG, U_MAP = U_HP + 256, U_HS = U_MAP + 192, U_MAS = U_HS + 128, U_FIN = U_MAS + 256;
    for (;;) {
        const int u = q_next(c, 0);
        if (u >= U_FIN) break;
        if (u < U_HP) hgrn_unit<true>(c, a, u / (6 * HG_NG), (u / HG_NG) % 6, u % HG_NG);
        else if (u < U_MAP) memattn_prompt_unit(c, a, 0, u - U_HP);
        else if (u < U_HS) { const int v = u - U_MAP; hgrn_unit<false>(c, a, v / 6, v % 6, 0); }
        else if (u < U_MAS) memattn_sample_unit(c, a, 0, u - U_HS);
        else { const int v = (u - U_MAS) * 8 + c.wave; memkv_finalize_row(a, v >> 10, v & 1023, c.lane); }
    }
}
__device__ __forceinline__ void p2c_hgrn_fix(Ctx& c, ARGREF a) {
    for (int u = c.vcu; u < 24 * HG_NG; u += c.G) hgrn_fix_unit(c, a, u / (6 * HG_NG), (u / HG_NG) % 6, u % HG_NG);
}

constexpr size_t WS_G4 = WS_UP + 64 * MiB, WS_UP2 = WS_UP + 80 * MiB;
__device__ __forceinline__ void conv_fixup_tile(Ctx& c, ARGREF a, int layer, int pm) {
    const float* G4 = (const float*)(a.ws + WS_G4); const float* UP2 = (const float*)(a.ws + WS_UP2); bf16* ACT = (bf16*)(a.ws + WS_ACT);
    const float* cw = a.in[26] + (size_t)layer * 3 * DFF; const float* cb = a.in[27] + (size_t)layer * DFF;
    for (int idx = c.tid; idx < 8 * (DFF / 4); idx += 512) {
        const int rr = idx / (DFF / 4), c4 = (idx - rr * (DFF / 4)) * 4;
        const int slab = 4 * pm + (rr >> 1), fr = rr & 1, row = slab * 64 + fr, t = row & 4095, sl1 = slab > 0 ? slab - 1 : 0;
        const f32x4 ut = *(const f32x4*)(G4 + (size_t)(slab * 4 + fr) * DFF + c4), up = *(const f32x4*)(UP2 + (size_t)(slab * 2 + fr) * DFF + c4);
        const f32x4 a0 = *(const f32x4*)(G4 + (size_t)(slab * 4 + 0) * DFF + c4), b3 = *(const f32x4*)(G4 + (size_t)(sl1 * 4 + 3) * DFF + c4), b2 = *(const f32x4*)(G4 + (size_t)(sl1 * 4 + 2) * DFF + c4);
        f32x4 u1, u2;
        { const bool f1 = fr == 1, t0 = t == 0, t1 = t == 1;
          u1.x = f1 ? a0.x : (t0 ? 0.f : b3.x); u1.y = f1 ? a0.y : (t0 ? 0.f : b3.y); u1.z = f1 ? a0.z : (t0 ? 0.f : b3.z); u1.w = f1 ? a0.w : (t0 ? 0.f : b3.w);
          u2.x = f1 ? (t1 ? 0.f : b3.x) : (t0 ? 0.f : b2.x); u2.y = f1 ? (t1 ? 0.f : b3.y) : (t0 ? 0.f : b2.y); u2.z = f1 ? (t1 ? 0.f : b3.z) : (t0 ? 0.f : b2.z); u2.w = f1 ? (t1 ? 0.f : b3.w) : (t0 ? 0.f : b2.w); }
        const f32x4 w0 = *(const f32x4*)(cw + c4), w1 = *(const f32x4*)(cw + DFF + c4), w2 = *(const f32x4*)(cw + 2 * DFF + c4), bb = *(const f32x4*)(cb + c4);
        const f32x4 cv = bb + w0 * u2 + w1 * u1 + w2 * ut;
        const float y0 = cv.x * sigmoidf_(cv.x) * up.x, y1 = cv.y * sigmoidf_(cv.y) * up.y, y2 = cv.z * sigmoidf_(cv.z) * up.z, y3 = cv.w * sigmoidf_(cv.w) * up.w;
        *(u64*)(ACT + (size_t)row * DFF + c4) = (u64)pk2(y0, y1) | ((u64)pk2(y2, y3) << 32);
    }
}


struct SgArgs { const bf16* A; const bf16* Bt; int K; int mode; bf16* Z; int ldz; const float* ssin; const float* resid; const bf16* rb; float* y; bf16* xb; float* ssout; bf16* ACT; float* cvs; const float* cst; const float* cw; const float* cb; };
__device__ __forceinline__ void sgemm_unit(Ctx& c, const SgArgs& g, int n0) {
    int tid = c.tid; asm volatile("" : "+v"(tid));
    const int lane = tid & 63, w = c.wave, r32 = lane & 31, hh = lane >> 5;
    const int K = g.K, ks = K >> 3;
    const int f2 = (n0 >> 1) + (r32 & 15), brow = g.mode == 2 ? (f2 >> 7) * 256 + (f2 & 127) + (r32 >= 16 ? 128 : 0) : n0 + r32;
    const bf16* bp = g.Bt + (size_t)brow * K + w * ks + 8 * hh;
    const bf16* ap = g.A + (size_t)r32 * K + w * ks + 8 * hh;
    f32x16 acc[4] = {};
    bf16x8 afA[4][2], bfA[2], afB[4][2], bfB[2];
#define SG_LOAD(AF, BF, kk) do { _Pragma("unroll") for (int i = 0; i < 2; ++i) { BF[i] = *(const bf16x8*)(bp + (kk) + 16 * i); \
        _Pragma("unroll") for (int rt = 0; rt < 4; ++rt) AF[rt][i] = *(const bf16x8*)(ap + (size_t)(rt * 32) * K + (kk) + 16 * i); } } while (0)
#define SG_MMA(AF, BF) do { _Pragma("unroll") for (int i = 0; i < 2; ++i) _Pragma("unroll") for (int rt = 0; rt < 4; ++rt) acc[rt] = __builtin_amdgcn_mfma_f32_32x32x16_bf16(AF[rt][i], BF[i], acc[rt], 0, 0, 0); } while (0)
    SG_LOAD(afA, bfA, 0);
#pragma unroll 1
    for (int k = 0; k < ks; k += 64) {
        if (k + 32 < ks) SG_LOAD(afB, bfB, k + 32);
        SG_MMA(afA, bfA);
        if (k + 32 < ks) { if (k + 64 < ks) SG_LOAD(afA, bfA, k + 64); SG_MMA(afB, bfB); }
    }
#undef SG_LOAD
#undef SG_MMA
    LAS float* RED = (LAS float*)(c.lds);
    __syncthreads();
#pragma unroll
    for (int rt = 0; rt < 4; ++rt)
#pragma unroll
        for (int r = 0; r < 16; ++r) RED[((w * 4 + rt) * 16 + r) * 64 + lane] = acc[rt][r];
    __syncthreads();
    const int rt = w & 3, rh = w >> 2, col = n0 + r32;
    float v[8];
#pragma unroll
    for (int i = 0; i < 8; ++i) { float s = 0.f;
#pragma unroll
        for (int ww = 0; ww < 8; ++ww) s += RED[((ww * 4 + rt) * 16 + 8 * rh + i) * 64 + lane];
        v[i] = s; }
    if (g.mode == 0) {
#pragma unroll
        for (int i = 0; i < 8; ++i) { const int row = MP + rt * 32 + crow(8 * rh + i, hh); const float rs = rsqrtf(g.ssin[row] * (1.0f / DM) + EPS); g.Z[(size_t)row * g.ldz + col] = (bf16)f2bf(v[i] * rs); }
    } else if (g.mode == 1) {
#pragma unroll
        for (int i = 0; i < 8; ++i) { const int lr = rt * 32 + crow(8 * rh + i, hh), row = MP + lr;
            const float x = v[i] + (g.resid ? g.resid[(size_t)lr * DM + col] : bf2f(g.rb[(size_t)row * DM + col]));
            if (g.y) g.y[(size_t)lr * DM + col] = x; if (g.xb) g.xb[(size_t)row * DM + col] = (bf16)f2bf(x);
            float s = x * x; s += __shfl_xor(s, 1); s += __shfl_xor(s, 2); s += __shfl_xor(s, 4); s += __shfl_xor(s, 8); s += __shfl_xor(s, 16);
            if (g.ssout && r32 == 0) atomicAdd(g.ssout + row, s); }
    } else {
        float gu[8], upv[8];
#pragma unroll
        for (int i = 0; i < 8; ++i) { const int row = MP + rt * 32 + crow(8 * rh + i, hh); gu[i] = v[i] * rsqrtf(g.ssin[row] * (1.0f / DM) + EPS); upv[i] = __shfl_xor(gu[i], 16); }
        if (r32 < 16) { const float w0 = g.cw[f2], w1 = g.cw[DFF + f2], w2 = g.cw[2 * DFF + f2], bb = g.cb[f2];
#pragma unroll
            for (int aa = 0; aa < 2; ++aa) { const int lr0 = rt * 32 + 8 * (2 * rh + aa) + 4 * hh, sb = lr0 >> 2;
                const float s0 = g.cst[(size_t)(sb * 2) * DFF + f2], s1 = g.cst[(size_t)(sb * 2 + 1) * DFF + f2];
                const float u0 = gu[4 * aa], u1 = gu[4 * aa + 1], u2 = gu[4 * aa + 2], u3 = gu[4 * aa + 3];
                const float cv[4] = {bb + w0 * s0 + w1 * s1 + w2 * u0, bb + w0 * s1 + w1 * u0 + w2 * u1, bb + w0 * u0 + w1 * u1 + w2 * u2, bb + w0 * u1 + w1 * u2 + w2 * u3};
#pragma unroll
                for (int t = 0; t < 4; ++t) g.ACT[(size_t)(MP + lr0 + t) * DFF + f2] = (bf16)f2bf(cv[t] * sigmoidf_(cv[t]) * upv[4 * aa + t]);
                g.cvs[(size_t)(sb * 2) * DFF + f2] = u2; g.cvs[(size_t)(sb * 2 + 1) * DFF + f2] = u3; } }
    }
}
__device__ __forceinline__ void sgemm_phase(Ctx& c, const SgArgs& g, int N) {
#pragma unroll 1
    for (int u = c.G - 1 - (int)blockIdx.x; u < N / 32; u += c.G) sgemm_unit(c, g, u * 32);
}


__device__ __forceinline__ float wave_sum_f(float x) {
    x += __builtin_bit_cast(float, __builtin_amdgcn_update_dpp(0, __builtin_bit_cast(int, x), 0xB1, 0xF, 0xF, false));
    x += __builtin_bit_cast(float, __builtin_amdgcn_update_dpp(0, __builtin_bit_cast(int, x), 0x4E, 0xF, 0xF, false));
    x += __builtin_bit_cast(float, __builtin_amdgcn_update_dpp(0, __builtin_bit_cast(int, x), 0x141, 0xF, 0xF, false));
    x += __builtin_bit_cast(float, __builtin_amdgcn_update_dpp(0, __builtin_bit_cast(int, x), 0x140, 0xF, 0xF, false));
    const int xi = __builtin_bit_cast(int, x);
    return (__builtin_bit_cast(float, __builtin_amdgcn_readlane(xi, 0)) + __builtin_bit_cast(float, __builtin_amdgcn_readlane(xi, 16))) +
           (__builtin_bit_cast(float, __builtin_amdgcn_readlane(xi, 32)) + __builtin_bit_cast(float, __builtin_amdgcn_readlane(xi, 48)));
}
__device__ __forceinline__ void dsa_post_row(ARGREF a, int row, int lane_) {
    int lane = lane_; asm volatile("" : "+v"(lane));
    const bf16* z = (const bf16*)(a.ws + WS_Z) + (size_t)row * ZC1;
    const bool smp = row >= MP; const int b = smp ? (row - MP) >> 2 : row >> 12, t = smp ? (row - MP) & 3 : row & 4095;
    const float pos = (float)(smp ? PAST + t : t);
    const int i = lane & 31;
    float x1[8], x2[8], q1[4], q2[4], k1 = 0.f, k2 = 0.f;
#pragma unroll
    for (int hd = 0; hd < 8; ++hd) { x1[hd] = bf2f(z[hd * 128 + lane]); x2[hd] = bf2f(z[hd * 128 + 64 + lane]); }
    const u64 vv = *(const u64*)(z + Z1_V + 4 * lane);
#pragma unroll
    for (int p = 0; p < 4; ++p) { const int hd = 2 * p + (lane >> 5); q1[p] = bf2f(z[Z1_IQ + hd * 64 + i]); q2[p] = bf2f(z[Z1_IQ + hd * 64 + 32 + i]); }
    if (lane < 32) { k1 = bf2f(z[Z1_IK + i]); k2 = bf2f(z[Z1_IK + 32 + i]); }
    const float wraw = bf2f(z[Z1_IW + (lane & 7)]);
    float c128, s128, c64, s64;
    { const float r1 = pos * (exp2f(-(float)lane * (13.287712379549449f / 64.0f)) * 0.15915494309189535f), f1 = r1 - floorf(r1); s128 = __builtin_amdgcn_sinf(f1); c128 = __builtin_amdgcn_cosf(f1);
      const float r2 = pos * (exp2f(-(float)i * (13.287712379549449f / 32.0f)) * 0.15915494309189535f), f2 = r2 - floorf(r2); s64 = __builtin_amdgcn_sinf(f2); c64 = __builtin_amdgcn_cosf(f2); }
#pragma unroll
    for (int hd = 0; hd < 8; ++hd) {
        const float rs = rsqrtf(wave_sum_f(x1[hd] * x1[hd] + x2[hd] * x2[hd]) * (1.0f / 128.0f) + EPS);
        const float* gn = hd < 6 ? a.in[17] : a.in[18];
        const float y1 = x1[hd] * rs * gn[lane], y2 = x2[hd] * rs * gn[64 + lane];
        const float o1 = y1 * c128 - y2 * s128, o2 = y2 * c128 + y1 * s128;
        if (hd < 6) {
            if (smp) { float* q = (float*)(a.ws + WS_SQ) + (size_t)(row - MP) * 768 + hd * 128; q[lane] = o1; q[64 + lane] = o2; }
            else { bf16* q = (bf16*)(a.ws + WS_QB) + ((size_t)(b * 6 + hd) * SEQ + t) * 128; q[lane] = (bf16)f2bf(o1); q[64 + lane] = (bf16)f2bf(o2); }
        } else {
            const int kvh = hd - 6;
            float* ko = smp ? a.out + O_KS + (size_t)(row - MP) * 256 + kvh * 128 : a.out + O_KP + (size_t)row * 256 + kvh * 128;
            ko[lane] = o1; ko[64 + lane] = o2;
            if (!smp) { bf16* kb = (bf16*)(a.ws + WS_KB) + ((size_t)(b * 2 + kvh) * SEQ + t) * 128; kb[lane] = (bf16)f2bf(o1); kb[64 + lane] = (bf16)f2bf(o2); }
        }
    }
    {
        const f32x4 v = {bf2f((unsigned)vv & 0xffffu), bf2f(((unsigned)vv) >> 16), bf2f((unsigned)(vv >> 32) & 0xffffu), bf2f((unsigned)(vv >> 48))};
        float* vo = smp ? a.out + O_VS + (size_t)(row - MP) * 256 : a.out + O_VP + (size_t)row * 256;
        *(f32x4*)(vo + 4 * lane) = v;
        if (!smp) { const int kvh = lane >> 5, d = (lane & 31) * 4; *(u64*)((bf16*)(a.ws + WS_VB) + ((size_t)(b * 2 + kvh) * SEQ + t) * 128 + d) = vv; }
    }
    {
#pragma unroll
        for (int p = 0; p < 4; ++p) { const int hd = 2 * p + (lane >> 5);
            const float o1 = q1[p] * c64 - q2[p] * s64, o2 = q2[p] * c64 + q1[p] * s64;
            if (smp) { float* q = (float*)(a.ws + WS_SIQ) + (size_t)(row - MP) * 512 + hd * 64; q[i] = o1; q[32 + i] = o2; }
            else { bf16* q = (bf16*)(a.ws + WS_IQB) + (size_t)row * 512 + hd * 64; q[i] = (bf16)f2bf(o1); q[32 + i] = (bf16)f2bf(o2); } }
        const float rs = rsqrtf(wave_sum_f(k1 * k1 + k2 * k2) * (1.0f / 64.0f) + EPS);
        const float y1 = k1 * rs * a.in[19][i], y2 = k2 * rs * a.in[19][32 + i];
        const float o1 = y1 * c64 - y2 * s64, o2 = y2 * c64 + y1 * s64;
        if (lane < 32) {
            float* ko = smp ? a.out + O_IKS + (size_t)(row - MP) * 64 : a.out + O_IKP + (size_t)row * 64; ko[i] = o1; ko[32 + i] = o2;
            if (!smp) { bf16* kb = (bf16*)(a.ws + WS_IKB) + (size_t)row * 64; kb[i] = (bf16)f2bf(o1); kb[32 + i] = (bf16)f2bf(o2); } }
        if (lane < 8) { const float wv = wraw * (0.35355339059327373f * 0.125f);
            if (smp) ((float*)(a.ws + WS_SIW))[(row - MP) * 8 + lane] = wv; else ((float*)(a.ws + WS_IW))[(size_t)row * 8 + lane] = wv; }
    }
}
__device__ __forceinline__ void p8_dsa_post(Ctx& c, ARGREF a) {
    constexpr int NRB = (MVALID + 63) / 64;
    for (;;) { const int u = q_next(c, 1); if (u >= 384 + NRB) break;
        if (u < 256) memattn_prompt_unit(c, a, 1, u);
        else if (u < 256 + NRB) { const int r0 = (u - 256) * 64 + c.wave;
#pragma unroll 1
            for (int i = 0; i < 8; ++i) { const int row = r0 + 8 * i; if (row < MVALID) dsa_post_row(a, row, c.lane); } }
        else memattn_sample_unit(c, a, 1, u - 256 - NRB); }
}

__device__ __forceinline__ void idx_prompt_unit(Ctx& c, ARGREF a, int b, int qb) {
    int tid = c.tid; asm volatile("" : "+v"(tid));
    const int lane = tid & 63, r32 = lane & 31, hh = lane >> 5, w = c.wave;
    const int q0 = b * SEQ + qb * 32;
    LAS bf16* IQL = (LAS bf16*)(c.lds);
    { const bf16* src = (const bf16*)(a.ws + WS_IQB) + (size_t)q0 * 512;
#pragma unroll
      for (int i = 0; i < 4; ++i) { const int row = tid >> 4, ch = (tid & 15) + 16 * i; *(LAS v4u*)(IQL + row * 520 + ch * 8) = *(const v4u*)(src + (size_t)row * 512 + ch * 8); } }
    __syncthreads();
    const bf16* IK = (const bf16*)(a.ws + WS_IKB) + (size_t)(b * SEQ) * 64 + (size_t)r32 * 64 + 8 * hh;
    float* SC = (float*)(a.ws + WS_SC) + (size_t)(q0 + r32) * SEQ;
    float wv[8];
#pragma unroll
    for (int h = 0; h < 8; ++h) wv[h] = ((const float*)(a.ws + WS_IW))[(size_t)(q0 + r32) * 8 + h];
    bf16x8 ak[4], an[4];
    if (w <= qb) {
#pragma unroll
        for (int ks = 0; ks < 4; ++ks) ak[ks] = *(const bf16x8*)(IK + (size_t)(w * 32) * 64 + ks * 16); }
#pragma unroll 1
    for (int kt = w; kt <= qb; kt += 8) {
        if (kt + 8 <= qb) {
#pragma unroll
            for (int ks = 0; ks < 4; ++ks) an[ks] = *(const bf16x8*)(IK + (size_t)((kt + 8) * 32) * 64 + ks * 16); }
        f32x16 sc = {};
        int qoff = r32 * 520 + 8 * hh; asm volatile("" : "+v"(qoff));
#pragma unroll
        for (int h = 0; h < 8; ++h) { f32x16 d = {};
#pragma unroll
            for (int ks = 0; ks < 4; ++ks) d = __builtin_amdgcn_mfma_f32_32x32x16_bf16(ak[ks], *(const LAS bf16x8*)(IQL + qoff + h * 64 + ks * 16), d, 0, 0, 0);
#pragma unroll
            for (int r = 0; r < 16; ++r) sc[r] = fmaf(wv[h], fmaxf(d[r], 0.f), sc[r]); }
#pragma unroll
        for (int g = 0; g < 4; ++g) *(f32x4*)(SC + kt * 32 + 8 * g + 4 * hh) = (f32x4){sc[4 * g], sc[4 * g + 1], sc[4 * g + 2], sc[4 * g + 3]};
#pragma unroll
        for (int ks = 0; ks < 4; ++ks) ak[ks] = an[ks];
    }
}
__device__ __forceinline__ v4u pack8f(const float* p) { const f32x4 x = *(const f32x4*)p, y = *(const f32x4*)(p + 4); v4u o; o.x = pk2(x.x, x.y); o.y = pk2(x.z, x.w); o.z = pk2(y.x, y.y); o.w = pk2(y.z, y.w); return o; }
__device__ __forceinline__ void idx_sample_tile(ARGREF a, int sb, int tl, int lane_) {
    int lane = lane_; asm volatile("" : "+v"(lane));
    const int r32 = lane & 31, hh = lane >> 5, tk = r32 >> 3, hd = r32 & 7;
    const float* iq = (const float*)(a.ws + WS_SIQ) + (size_t)(sb * 4 + tk) * 512 + hd * 64 + 8 * hh;
    const float wv = ((const float*)(a.ws + WS_SIW))[(sb * 4 + tk) * 8 + hd];
    const float* src;
    if (tl < 256) src = a.in[4] + ((size_t)a.page_table[sb * 64 + (tl >> 2)] * 128 + (tl & 3) * 32 + r32) * 64 + 8 * hh;
    else src = a.out + O_IKS + (size_t)(sb * 4 + (r32 & 3)) * 64 + 8 * hh;
    v4u af[4], bf_[4];
#pragma unroll
    for (int ks = 0; ks < 4; ++ks) { af[ks] = pack8f(src + 16 * ks); bf_[ks] = pack8f(iq + 16 * ks); }
    if (tl == 256 && r32 >= 4) {
#pragma unroll
        for (int ks = 0; ks < 4; ++ks) af[ks] = (v4u){0u, 0u, 0u, 0u}; }
    f32x16 d = {};
#pragma unroll
    for (int ks = 0; ks < 4; ++ks) d = __builtin_amdgcn_mfma_f32_32x32x16_bf16(__builtin_bit_cast(bf16x8, af[ks]), __builtin_bit_cast(bf16x8, bf_[ks]), d, 0, 0, 0);
    float* dst = (float*)(a.ws + WS_SSC) + (size_t)(sb * 4 + tk) * SSC_LD + tl * 32;
#pragma unroll
    for (int r = 0; r < 16; ++r) { float v = wv * fmaxf(d[r], 0.f);
        v += __builtin_bit_cast(float, __builtin_amdgcn_update_dpp(0, __builtin_bit_cast(int, v), 0xB1, 0xF, 0xF, false));
        v += __builtin_bit_cast(float, __builtin_amdgcn_update_dpp(0, __builtin_bit_cast(int, v), 0x4E, 0xF, 0xF, false));
        v += __builtin_bit_cast(float, __builtin_amdgcn_update_dpp(0, __builtin_bit_cast(int, v), 0x141, 0xF, 0xF, false));
        if (hd == 0) dst[crow(r, hh)] = v; }
}
__device__ __forceinline__ void p9_indexer(Ctx& c, ARGREF a) {
    const int gw = c.vcu * NWAVES + c.wave, NGW = c.G * NWAVES;
#pragma unroll 1
    for (int wt = gw; wt < 32 * 257; wt += NGW) idx_sample_tile(a, wt / 257, wt % 257, c.lane);
    for (;;) { const int u = q_next(c, 2); if (u >= 512) break; idx_prompt_unit(c, a, u & 3, 127 - (u >> 2)); }
}


__device__ __forceinline__ unsigned fkey(float f) { const unsigned u = __builtin_bit_cast(unsigned, f + 0.0f); return (u & 0x80000000u) ? ~u : (u | 0x80000000u); }
__device__ __forceinline__ void acc_ge(int& cnt, unsigned key, unsigned cand) { asm volatile("v_cmp_le_u32_e32 vcc, %1, %2\n\tv_addc_co_u32_e32 %0, vcc, 0, %0, vcc" : "+v"(cnt) : "s"(cand), "v"(key) : "vcc"); }
__device__ __forceinline__ void acc_ge4(int& c0, int& c1, int& c2, int& c3, unsigned k0, unsigned k1, unsigned k2, unsigned k3, unsigned cand) {
    u64 m0, m1, m2, m3;
    asm volatile("v_cmp_le_u32_e64 %4, %8, %9\n\tv_cmp_le_u32_e64 %5, %8, %10\n\tv_cmp_le_u32_e64 %6, %8, %11\n\tv_cmp_le_u32_e64 %7, %8, %12\n\t"
                 "v_addc_co_u32_e64 %0, %4, 0, %0, %4\n\tv_addc_co_u32_e64 %1, %5, 0, %1, %5\n\tv_addc_co_u32_e64 %2, %6, 0, %2, %6\n\tv_addc_co_u32_e64 %3, %7, 0, %3, %7"
                 : "+v"(c0), "+v"(c1), "+v"(c2), "+v"(c3), "=&s"(m0), "=&s"(m1), "=&s"(m2), "=&s"(m3) : "s"(cand), "v"(k0), "v"(k1), "v"(k2), "v"(k3));
}
__device__ __forceinline__ u64 ballot_nz(unsigned v) { u64 m; asm volatile("v_cmp_ne_u32_e64 %0, 0, %1" : "=s"(m) : "v"(v)); return m; }
__device__ __forceinline__ int wave_sum_dpp(int x) {
    x += __builtin_amdgcn_update_dpp(0, x, 0xB1, 0xF, 0xF, false);
    x += __builtin_amdgcn_update_dpp(0, x, 0x4E, 0xF, 0xF, false);
    x += __builtin_amdgcn_update_dpp(0, x, 0x141, 0xF, 0xF, false);
    x += __builtin_amdgcn_update_dpp(0, x, 0x140, 0xF, 0xF, false);
    return (__builtin_amdgcn_readlane(x, 0) + __builtin_amdgcn_readlane(x, 16)) + (__builtin_amdgcn_readlane(x, 32) + __builtin_amdgcn_readlane(x, 48));
}
__device__ __forceinline__ int mbcnt64(u64 m) { return (int)__builtin_amdgcn_mbcnt_hi((unsigned)(m >> 32), __builtin_amdgcn_mbcnt_lo((unsigned)m, 0u)); }
constexpr int TK_LOWBITS = 18;
__device__ __forceinline__ void topk_finish(unsigned ck, int cp, int A, int posmax, unsigned& T, int& P) {
#pragma unroll 1
    for (int bit = TK_LOWBITS - 1; bit >= 0; --bit) { const unsigned cand = T | (1u << bit); if (A + __builtin_popcountll(__ballot(ck >= cand)) >= 256) T = cand; }
    const int need = 256 - (A + __builtin_popcountll(__ballot(ck > T))), ceq = __builtin_popcountll(__ballot(ck == T));
    P = posmax;
    if (ceq != need) { P = 0;
#pragma unroll 1
        for (int bit = 13; bit >= 0; --bit) { const int cand = P | (1 << bit); if (__builtin_popcountll(__ballot(ck == T && cp < cand)) < need) P = cand; } }
}
__device__ __forceinline__ unsigned wave_min_u(unsigned x) {
    x = min(x, (unsigned)__builtin_amdgcn_update_dpp(0, (int)x, 0xB1, 0xF, 0xF, false)); x = min(x, (unsigned)__builtin_amdgcn_update_dpp(0, (int)x, 0x4E, 0xF, 0xF, false));
    x = min(x, (unsigned)__builtin_amdgcn_update_dpp(0, (int)x, 0x141, 0xF, 0xF, false)); x = min(x, (unsigned)__builtin_amdgcn_update_dpp(0, (int)x, 0x140, 0xF, 0xF, false));
    return min(min((unsigned)__builtin_amdgcn_readlane((int)x, 0), (unsigned)__builtin_amdgcn_readlane((int)x, 16)), min((unsigned)__builtin_amdgcn_readlane((int)x, 32), (unsigned)__builtin_amdgcn_readlane((int)x, 48)));
}
__device__ __forceinline__ unsigned wave_max_u(unsigned x) {
    x = max(x, (unsigned)__builtin_amdgcn_update_dpp(0, (int)x, 0xB1, 0xF, 0xF, false)); x = max(x, (unsigned)__builtin_amdgcn_update_dpp(0, (int)x, 0x4E, 0xF, 0xF, false));
    x = max(x, (unsigned)__builtin_amdgcn_update_dpp(0, (int)x, 0x141, 0xF, 0xF, false)); x = max(x, (unsigned)__builtin_amdgcn_update_dpp(0, (int)x, 0x140, 0xF, 0xF, false));
    return max(max((unsigned)__builtin_amdgcn_readlane((int)x, 0), (unsigned)__builtin_amdgcn_readlane((int)x, 16)), max((unsigned)__builtin_amdgcn_readlane((int)x, 32), (unsigned)__builtin_amdgcn_readlane((int)x, 48)));
}
__device__ __forceinline__ void topk_prompt_rows(ARGREF a, int row0, int stride, int lane_, LAS unsigned* cl) {
    int lane = lane_; asm volatile("" : "+v"(lane));
    const float* SCb = (const float*)(a.ws + WS_SC);
#pragma unroll 1
    for (int row = row0; row < MP; row += stride) {
        const int t = row & 4095;
        u64* mk = (u64*)(a.ws + WS_MASK) + (size_t)row * 64;
        if (t < 256) { u64 myword = 0ull;
#pragma unroll 1
            for (int j = 0; j < 64; ++j) { const u64 m = __ballot(64 * j + lane <= t); if (lane == j) myword = m; }
            mk[lane] = myword;
            continue; }
        unsigned key[64];
        { const float* sc_ = SCb + (size_t)row * SEQ + lane; const int tj_ = t >> 6;
          float v[64];
#pragma unroll
          for (int j = 0; j < 64; ++j) v[j] = sc_[64 * (j < tj_ ? j : tj_)];
          int pj = lane;
#pragma unroll
          for (int j = 0; j < 64; ++j) { const int u = __builtin_bit_cast(int, v[j] + 0.0f); const unsigned k = (unsigned)u ^ ((unsigned)(u >> 31) | 0x80000000u); key[j] = (pj <= t) ? k : 0u; pj += 64; asm volatile("" : "+v"(pj)); } }
        unsigned kh[64];
#pragma unroll
        for (int j = 0; j < 64; ++j) { kh[j] = key[j] >> 1; asm volatile("" : "+v"(kh[j])); }
        unsigned T; int hb;
        {
            unsigned b0 = 0u, b1 = 0u, b2 = 0u, b3 = 0u;
#pragma unroll
            for (int j = 0; j < 64; ++j) { unsigned x = key[j]; const unsigned m0 = max(b0, x); x = min(b0, x); b0 = m0; const unsigned m1 = max(b1, x); x = min(b1, x); b1 = m1; const unsigned m2 = max(b2, x); x = min(b2, x); b2 = m2; b3 = max(b3, x); }
            const unsigned L = wave_min_u(b3), H = wave_max_u(b3), df = L ^ H;
            hb = df ? 31 - __builtin_clz(df) : -1;
            T = hb >= 31 ? 0u : (L & ~((2u << (hb < 0 ? 0 : hb)) - 1u)); if (hb < 0) T = L;
        }
#define TK_FULLCOUNT(CAND, OUT) do { const unsigned cs_ = __builtin_amdgcn_readfirstlane(CAND); int c0_ = 0, c1_ = 0, c2_ = 0, c3_ = 0; \
        _Pragma("unroll") for (int j = 0; j < 64; j += 4) acc_ge4(c0_, c1_, c2_, c3_, key[j], key[j + 1], key[j + 2], key[j + 3], cs_); OUT = wave_sum_dpp((c0_ + c1_) + (c2_ + c3_)); } while (0)
#define TK_FASTCOUNT(CAND, OUT) do { const unsigned ch_ = __builtin_amdgcn_readfirstlane((CAND) >> 1); unsigned a0_ = 0u, a1_ = 0u, a2_ = 0u, a3_ = 0u; \
        _Pragma("unroll") for (int j = 0; j < 64; j += 4) { a0_ = __builtin_amdgcn_alignbit(a0_, kh[j] - ch_, 31); a1_ = __builtin_amdgcn_alignbit(a1_, kh[j + 1] - ch_, 31); \
            a2_ = __builtin_amdgcn_alignbit(a2_, kh[j + 2] - ch_, 31); a3_ = __builtin_amdgcn_alignbit(a3_, kh[j + 3] - ch_, 31); } \
        OUT = 4096 - wave_sum_dpp((__builtin_popcount(a0_) + __builtin_popcount(a1_)) + (__builtin_popcount(a2_) + __builtin_popcount(a3_))); } while (0)
#pragma unroll 1
        for (int bit = hb; bit >= TK_LOWBITS; --bit) { const unsigned cand = T | (1u << bit); int tot; TK_FASTCOUNT(cand, tot); if (tot >= 256) T = cand; }
        const unsigned Tb = T & ~((1u << TK_LOWBITS) - 1u), hib = Tb + (1u << TK_LOWBITS);
        int A = 0, cT; if (hib != 0u) TK_FASTCOUNT(hib, A); TK_FASTCOUNT(Tb, cT);
#undef TK_FASTCOUNT
        int P;
        if (cT - A <= 64) {
            if (lane == 0) cl[128] = 0u;
            int pj = lane;
#pragma unroll
            for (int j = 0; j < 64; ++j) { if ((key[j] - Tb) < (1u << TK_LOWBITS)) { const unsigned pos = __hip_atomic_fetch_add(cl + 128, 1u, __ATOMIC_RELAXED, __HIP_MEMORY_SCOPE_WORKGROUP); if (pos < 64u) { cl[pos] = key[j]; cl[64 + pos] = (unsigned)pj; } }
                pj += 64; asm volatile("" : "+v"(pj)); }
            const int nund = cT - A;
            const unsigned ck = lane < nund ? cl[lane] : 0u; const int cp = (int)cl[64 + lane];
            topk_finish(ck, cp, A, 4095, T, P);
        } else {
#pragma unroll 1
            for (int bit = TK_LOWBITS - 1; bit >= 0; --bit) { const unsigned cand = T | (1u << bit); int tot; TK_FULLCOUNT(cand, tot); if (tot >= 256) T = cand; }
            int cge, cgt; TK_FULLCOUNT(T, cge); cgt = 0; if (T != 0xffffffffu) TK_FULLCOUNT(T + 1u, cgt);
            const int need = 256 - cgt, ceq = cge - cgt; P = 4095;
            if (ceq != need) { P = 0;
#pragma unroll 1
                for (int bit = 11; bit >= 0; --bit) { const int cand = P | (1 << bit); int cnt = 0; int pj = lane;
#pragma unroll
                    for (int j = 0; j < 64; ++j) { cnt += (key[j] == T && pj < cand) ? 1 : 0; pj += 64; asm volatile("" : "+v"(pj)); }
                    if (wave_sum_dpp(cnt) < need) P = cand; } }
        }
#undef TK_FULLCOUNT
        if (P != 4095) {
            int pq = lane;
#pragma unroll
            for (int j = 0; j < 64; ++j) { if (key[j] == T && pq > P) key[j] = 0u; pq += 64; asm volatile("" : "+v"(pq)); } }
        unsigned wlo = 0u, whi = 0u; const unsigned Ts = __builtin_amdgcn_readfirstlane(T);
#pragma unroll
        for (int j = 0; j < 64; ++j) asm volatile("v_cmp_le_u32_e32 vcc, %2, %3\n\ts_nop 3\n\tv_writelane_b32 %0, vcc_lo, %4\n\tv_writelane_b32 %1, vcc_hi, %4" : "+v"(wlo), "+v"(whi) : "s"(Ts), "v"(key[j]), "i"(j) : "vcc");
        mk[lane] = ((u64)whi << 32) | (u64)wlo;
    }
}
__device__ __forceinline__ void topk_sample_row(ARGREF a, int q, int lane_, LAS unsigned* K, LAS unsigned* cl) {
    int lane = lane_; asm volatile("" : "+v"(lane));
    const int t = q & 3, n = PAST + t + 1; const float* sc = (const float*)(a.ws + WS_SSC) + (size_t)q * SSC_LD;
    int* out = (int*)(a.ws + WS_SIDX) + q * 256;
    unsigned key[129];
#pragma unroll
    for (int j = 0; j < 129; ++j) { const float v = sc[64 * j + lane]; key[j] = (j < 128 || lane < n - 8192) ? fkey(v) : 0u; }
#pragma unroll
    for (int j = 0; j < 129; ++j) K[64 * j + lane] = key[j];
#define TK_FULLCOUNT(CAND, OUT) do { const unsigned cs_ = __builtin_amdgcn_readfirstlane(CAND); int c0_ = 0, c1_ = 0, c2_ = 0, c3_ = 0; \
        _Pragma("unroll") for (int j = 0; j < 128; j += 4) acc_ge4(c0_, c1_, c2_, c3_, key[j], key[j + 1], key[j + 2], key[j + 3], cs_); acc_ge(c0_, key[128], cs_); OUT = wave_sum_dpp((c0_ + c1_) + (c2_ + c3_)); } while (0)
    unsigned T = 0u;
#pragma unroll 1
    for (int bit = 31; bit >= TK_LOWBITS; --bit) { const unsigned cand = T | (1u << bit); int tot; TK_FULLCOUNT(cand, tot); if (tot >= 256) T = cand; }
    const unsigned hib = T + (1u << TK_LOWBITS);
    int A = 0, cT; if (hib != 0u) TK_FULLCOUNT(hib, A); TK_FULLCOUNT(T, cT);
    int P;
    if (cT - A <= 64) {
        int base = 0;
#pragma unroll 1
        for (int j0 = 0; j0 < 128; j0 += 8) { unsigned kk[8];
#pragma unroll
            for (int i = 0; i < 8; ++i) kk[i] = K[64 * (j0 + i) + lane];
#pragma unroll
            for (int i = 0; i < 8; ++i) { const unsigned und = (kk[i] - T) < (1u << TK_LOWBITS) ? 1u : 0u; const u64 m = ballot_nz(und); const int pos = base + mbcnt64(m);
                if (und) { cl[pos] = kk[i]; cl[64 + pos] = (unsigned)(64 * (j0 + i) + lane); }
                base += __builtin_popcountll(m); } }
        { const unsigned kj = K[64 * 128 + lane]; const unsigned und = (kj - T) < (1u << TK_LOWBITS) ? 1u : 0u; const u64 m = ballot_nz(und); const int pos = base + mbcnt64(m);
          if (und) { cl[pos] = kj; cl[64 + pos] = (unsigned)(64 * 128 + lane); } base += __builtin_popcountll(m); }
        const unsigned ck = lane < base ? cl[lane] : 0u; const int cp = (int)cl[64 + lane];
        topk_finish(ck, cp, A, 16383, T, P);
    } else {
#pragma unroll 1
        for (int bit = TK_LOWBITS - 1; bit >= 0; --bit) { const unsigned cand = T | (1u << bit); int tot; TK_FULLCOUNT(cand, tot); if (tot >= 256) T = cand; }
        int cge, cgt; TK_FULLCOUNT(T, cge); cgt = 0; if (T != 0xffffffffu) TK_FULLCOUNT(T + 1u, cgt);
        const int need = 256 - cgt, ceq = cge - cgt; P = 16383;
        if (ceq != need) { P = 0;
#pragma unroll 1
            for (int bit = 13; bit >= 0; --bit) { const int cand = P | (1 << bit); int cnt = 0;
#pragma unroll 4
                for (int j = 0; j < 129; ++j) cnt += (K[64 * j + lane] == T && 64 * j + lane < cand) ? 1 : 0;
                if (wave_sum_dpp(cnt) < need) P = cand; } }
    }
#undef TK_FULLCOUNT
    int base = 0;
#pragma unroll 1
    for (int j0 = 0; j0 < 136; j0 += 8) { unsigned kk[8];
#pragma unroll
        for (int i = 0; i < 8; ++i) kk[i] = (j0 + i < 129) ? K[64 * (j0 + i) + lane] : 0u;
#pragma unroll
        for (int i = 0; i < 8; ++i) { const int ps = 64 * (j0 + i) + lane; const unsigned selv = (kk[i] > T || (kk[i] == T && ps <= P)) ? 1u : 0u; const u64 m = ballot_nz(selv);
            const int pos = base + mbcnt64(m);
            if (selv && pos < 256) out[pos] = ps;
            base += __builtin_popcountll(m); } }
}
__device__ __forceinline__ void p10_topk(Ctx& c, ARGREF a) {
    const int gw = c.vcu * NWAVES + c.wave, NGW = c.G * NWAVES;
    LAS unsigned* cl = (LAS unsigned*)(c.lds) + c.wave * 192;
    if (c.wave == 0 && c.vcu < MS) topk_sample_row(a, c.vcu, c.lane, (LAS unsigned*)(c.lds + 8192), cl);
    topk_prompt_rows(a, gw, NGW, c.lane, cl);
}


__device__ __forceinline__ void attn_sample_unit(Ctx& c, ARGREF a, int sb, int t) {
    LAS bf16* KV = (LAS bf16*)(c.lds);
    LAS float* QL = (LAS float*)(c.lds + 69632);
    LAS float* SL = (LAS float*)(c.lds + 69632 + 3072);
    LAS float* OL = (LAS float*)(c.lds + 69632 + 6144);
    LAS int* IL = (LAS int*)(c.lds + 69632 + 12288);
    LAS unsigned* OFFL = (LAS unsigned*)(c.lds + 69632 + 12288 + 1024);
    int tid = c.tid; asm volatile("" : "+v"(tid));
    const int lane = tid & 63, w = c.wave, q = sb * 4 + t;
    __syncthreads();
    if (tid < 256) IL[tid] = ((const int*)(a.ws + WS_SIDX))[q * 256 + tid];
    for (int i = tid; i < 768; i += 512) QL[i] = ((const float*)(a.ws + WS_SQ))[(size_t)q * 768 + i];
    __syncthreads();
    if (tid < 256) { const int idx = IL[tid];
        OFFL[tid] = idx < PAST ? (unsigned)(((a.page_table[sb * 64 + (idx >> 7)] * 128 + (idx & 127)) * 2) * 128) : (0x80000000u | (unsigned)((sb * 4 + (idx - PAST)) * 256)); }
    __syncthreads();
    bf16* MIX = (bf16*)(a.ws + WS_MIX) + (size_t)(MP + q) * DM;
#pragma unroll 1
    for (int kvh = 0; kvh < 2; ++kvh) {
#pragma unroll 1
        for (int pass = 0; pass < 2; ++pass) {
            const float* pool = pass ? a.in[3] : a.in[2]; const float* nw = a.out + (pass ? O_VS : O_KS);
            { f32x4 gv[16];
#pragma unroll
              for (int r = 0; r < 16; ++r) { const int i = (tid >> 5) + 16 * r; const unsigned off = OFFL[i]; const float* src = (off & 0x80000000u) ? nw + (size_t)(off & 0x7fffffffu) : pool + (size_t)off;
                  gv[r] = *(const f32x4*)(src + kvh * 128 + (tid & 31) * 4); }
#pragma unroll
              for (int r = 0; r < 16; ++r) { const int i = (tid >> 5) + 16 * r; *(LAS u64*)(KV + i * 136 + (tid & 31) * 4) = (u64)pk2(gv[r].x, gv[r].y) | ((u64)pk2(gv[r].z, gv[r].w) << 32); } }
            __syncthreads();
            if (pass == 0) {
                const int i = tid >> 1, dh = (tid & 1) * 64; float s0 = 0.f, s1 = 0.f, s2 = 0.f;
#pragma unroll 8
                for (int d = 0; d < 64; ++d) { const float kx = bf2f(KV[i * 136 + dh + d]);
                    s0 = fmaf(QL[(3 * kvh + 0) * 128 + dh + d], kx, s0); s1 = fmaf(QL[(3 * kvh + 1) * 128 + dh + d], kx, s1); s2 = fmaf(QL[(3 * kvh + 2) * 128 + dh + d], kx, s2); }
                s0 += __shfl_xor(s0, 1); s1 += __shfl_xor(s1, 1); s2 += __shfl_xor(s2, 1);
                if ((tid & 1) == 0) { SL[i] = s0 * 0.08838834764831845f; SL[256 + i] = s1 * 0.08838834764831845f; SL[512 + i] = s2 * 0.08838834764831845f; }
                __syncthreads();
                if (w < 3) { float v[4], mx = -1e30f;
#pragma unroll
                    for (int j = 0; j < 4; ++j) { v[j] = SL[w * 256 + 64 * j + lane]; mx = fmaxf(mx, v[j]); }
#pragma unroll
                    for (int o = 1; o < 64; o <<= 1) mx = fmaxf(mx, __shfl_xor(mx, o));
                    float l = 0.f;
#pragma unroll
                    for (int j = 0; j < 4; ++j) { v[j] = __expf(v[j] - mx); l += v[j]; }
                    l = wave_sum(l); const float il = 1.0f / l;
#pragma unroll
                    for (int j = 0; j < 4; ++j) SL[w * 256 + 64 * j + lane] = v[j] * il; }
                __syncthreads();
            } else {
                const int d = tid & 127, part = tid >> 7; float o0 = 0.f, o1 = 0.f, o2 = 0.f;
#pragma unroll 8
                for (int i = part * 64; i < part * 64 + 64; ++i) { const float vx = bf2f(KV[i * 136 + d]); o0 = fmaf(SL[i], vx, o0); o1 = fmaf(SL[256 + i], vx, o1); o2 = fmaf(SL[512 + i], vx, o2); }
                OL[(part * 3 + 0) * 128 + d] = o0; OL[(part * 3 + 1) * 128 + d] = o1; OL[(part * 3 + 2) * 128 + d] = o2;
                __syncthreads();
                if (tid < 384) { const int hq = tid >> 7, dd = tid & 127; const float o = (OL[hq * 128 + dd] + OL[(3 + hq) * 128 + dd]) + (OL[(6 + hq) * 128 + dd] + OL[(9 + hq) * 128 + dd]);
                    MIX[(3 * kvh + hq) * 128 + dd] = (bf16)f2bf(o); }
                __syncthreads();
            }
        }
    }
}


namespace attn {
using bf16 = unsigned short;
typedef short bf16x8 __attribute__((ext_vector_type(8)));
typedef short s16x4 __attribute__((ext_vector_type(4)));
typedef float f32x16 __attribute__((ext_vector_type(16)));
typedef float f32x4 __attribute__((ext_vector_type(4)));
typedef unsigned u32x4 __attribute__((ext_vector_type(4)));
typedef unsigned u32x2 __attribute__((ext_vector_type(2)));
constexpr int D = 128, OS = 1024;
constexpr float THR = 8.f;
constexpr float SCALE = 0.08838834764831845f;
constexpr int NW = 8, QBLK = 32, KVBLK = 64, QB = NW * QBLK;
constexpr int SHM_V = KVBLK * D * 2, SHM_K = KVBLK * D * 2;
constexpr int LDS_BYTES = 2 * SHM_V + 2 * SHM_K + NW * 64 * 4;

#define KSWZ(row, colB) ((row) * 256 + ((colB) ^ (((row) & 7) << 4)))
#define SBAR() __builtin_amdgcn_sched_barrier(0)
__device__ __forceinline__ int v_st(int k, int c) { const int kk = (k & ~0xC) | ((k & 4) << 1) | ((k & 8) >> 1); return ((kk >> 3) * 4 + (c >> 5)) * 512 + ((kk & 7) * 32 + (c & 31)) * 2; }
__device__ __forceinline__ int v_rd_base(int lane) { return ((lane & 3) << 3) | (((lane >> 2) & 3) << 6) | (((lane >> 4) & 1) << 5) | (((lane >> 5) & 1) << 8); }
constexpr int v_rd_off(int d0, int ks, int half) { return d0 * 512 + ks * 4096 + half * 2048; }
__device__ __forceinline__ int crow(int r, int hi) { return (r & 3) + 8 * (r >> 2) + 4 * hi; }
__device__ __forceinline__ unsigned cvtpk(float lo, float hi) {
    unsigned r; asm volatile("v_cvt_pk_bf16_f32 %0, %1, %2" : "=v"(r) : "v"(lo), "v"(hi)); return r;
}
__device__ __forceinline__ bf16x8 pack8(f32x4 a, f32x4 b) {
    u32x4 w = {cvtpk(a[0], a[1]), cvtpk(a[2], a[3]), cvtpk(b[0], b[1]), cvtpk(b[2], b[3])};
    return *reinterpret_cast<bf16x8*>(&w);
}

__device__ __forceinline__ void partialSM(f32x16& p0, f32x16& p1, float& m_reg, float& mn, float& alpha) {
    float pmax = p0[0]; for (int r = 1; r < 16; ++r) pmax = fmaxf(pmax, p0[r]); for (int r = 0; r < 16; ++r) pmax = fmaxf(pmax, p1[r]);
    { auto rr = __builtin_amdgcn_permlane32_swap(__float_as_uint(pmax), __float_as_uint(pmax), false, false);
      pmax = fmaxf(__uint_as_float(rr[0]), __uint_as_float(rr[1])); }
    constexpr float C2 = 1.4426950408889634f * SCALE;
    if (__builtin_expect(__all((pmax - m_reg) * SCALE <= THR), 1)) { mn = m_reg; alpha = 1.f; }
    else { mn = fmaxf(m_reg, pmax); alpha = __builtin_amdgcn_exp2f((m_reg - mn) * C2); m_reg = mn; }
    const float mnL = -mn * C2;
    for (int r = 0; r < 16; ++r) p0[r] = fmaf(p0[r], C2, mnL); for (int r = 0; r < 16; ++r) p1[r] = fmaf(p1[r], C2, mnL);
    for (int r = 0; r < 16; ++r) p0[r] = __builtin_amdgcn_exp2f(p0[r]);
}
__device__ __forceinline__ void finishSM(f32x16& p0, f32x16& p1, float alpha, float& l_reg, bf16x8& pa0, bf16x8& pa1, bf16x8& pa2, bf16x8& pa3) {
    for (int r = 0; r < 16; ++r) p1[r] = __builtin_amdgcn_exp2f(p1[r]);
    float ps = 0; for (int r = 0; r < 16; ++r) ps += p0[r]; for (int r = 0; r < 16; ++r) ps += p1[r];
    { auto rr = __builtin_amdgcn_permlane32_swap(__float_as_uint(ps), __float_as_uint(ps), false, false);
      ps = __uint_as_float(rr[0]) + __uint_as_float(rr[1]); }
    l_reg = l_reg * alpha + ps;
#define PK4(P, B_, OUT) do { unsigned a0 = cvtpk(P[B_+0], P[B_+1]), a1 = cvtpk(P[B_+2], P[B_+3]);                          \
        unsigned b0 = cvtpk(P[B_+4], P[B_+5]), b1 = cvtpk(P[B_+6], P[B_+7]);                                             \
        auto r0 = __builtin_amdgcn_permlane32_swap(a0, b0, false, false); auto r1 = __builtin_amdgcn_permlane32_swap(a1, b1, false, false); \
        u32x4 w = {r0[0], r1[0], r0[1], r1[1]}; OUT = *reinterpret_cast<bf16x8*>(&w); } while (0)
    PK4(p0, 0, pa0); PK4(p0, 8, pa1); PK4(p1, 0, pa2); PK4(p1, 8, pa3);
#undef PK4
}
template <int KB, bool SK>
__device__ __forceinline__ void qkt(f32x16& p0, f32x16& p1, const char* K_lds, int r32, int hi, const bf16x8* qr, bool act) {
    if (SK && !act) { const float NEG = -__builtin_inff();
#pragma unroll
        for (int r = 0; r < 16; ++r) { p0[r] = NEG; p1[r] = NEG; } return; }
    p0 = f32x16{}; p1 = f32x16{};
    const char* kb[4];
#pragma unroll
    for (int dd = 0; dd < 4; ++dd) kb[dd] = K_lds + KB * SHM_K + KSWZ(r32, (dd * 16 + hi * 8) * 2);
#pragma unroll
    for (int d0 = 0; d0 < 8; ++d0) { const char* a = kb[d0 & 3] + (d0 >> 2) * 128;
        bf16x8 b0 = *reinterpret_cast<const bf16x8*>(a);
        bf16x8 b1 = *reinterpret_cast<const bf16x8*>(a + 32 * 256);
        p0 = __builtin_amdgcn_mfma_f32_32x32x16_bf16(b0, qr[d0], p0, 0, 0, 0);
        p1 = __builtin_amdgcn_mfma_f32_32x32x16_bf16(b1, qr[d0], p1, 0, 0, 0); }
}
template <int VB, bool SK>
__device__ __forceinline__ void pv_tile(f32x16* o, int vb0, bf16x8 pa0, bf16x8 pa1, bf16x8 pa2, bf16x8 pa3, bool act) {
    if (SK && !act) return;
#define TRRD(dst, off) asm volatile("ds_read_b64_tr_b16 %0, %1 offset:%2" : "=&v"(dst) : "v"(vb0), "i"(off) : "memory")
#define PV_D0(d0) do { s16x4 l0, l1, l2, l3, h0, h1, h2, h3; constexpr int b_ = VB * SHM_V + v_rd_off(d0, 0, 0);     \
        TRRD(l0, b_); TRRD(h0, b_ + 2048); TRRD(l1, b_ + 4096); TRRD(h1, b_ + 6144); TRRD(l2, b_ + 8192); TRRD(h2, b_ + 10240); TRRD(l3, b_ + 12288); TRRD(h3, b_ + 14336); \
        asm volatile("s_waitcnt lgkmcnt(0)" ::: "memory"); SBAR();                 \
        o[d0] = __builtin_amdgcn_mfma_f32_32x32x16_bf16(pa0, (bf16x8){l0[0], l0[1], l0[2], l0[3], h0[0], h0[1], h0[2], h0[3]}, o[d0], 0, 0, 0);   \
        o[d0] = __builtin_amdgcn_mfma_f32_32x32x16_bf16(pa1, (bf16x8){l1[0], l1[1], l1[2], l1[3], h1[0], h1[1], h1[2], h1[3]}, o[d0], 0, 0, 0);   \
        o[d0] = __builtin_amdgcn_mfma_f32_32x32x16_bf16(pa2, (bf16x8){l2[0], l2[1], l2[2], l2[3], h2[0], h2[1], h2[2], h2[3]}, o[d0], 0, 0, 0);   \
        o[d0] = __builtin_amdgcn_mfma_f32_32x32x16_bf16(pa3, (bf16x8){l3[0], l3[1], l3[2], l3[3], h3[0], h3[1], h3[2], h3[3]}, o[d0], 0, 0, 0); } while (0)
    PV_D0(0); PV_D0(1); PV_D0(2); PV_D0(3);
#undef PV_D0
#undef TRRD
}

__device__ __forceinline__ bf16x8 load8(const bf16* p) { return *reinterpret_cast<const bf16x8*>(p); }
__device__ __forceinline__ void mask_bits(f32x16& p0, f32x16& p1, u32x2 w, int hi) {
    const float NEG = -__builtin_inff();
    asm volatile("" : "+v"(w.x), "+v"(w.y));
    const unsigned lo = w.x >> (4 * hi), up = w.y >> (4 * hi);
#pragma unroll
    for (int r = 0; r < 16; ++r) { const int c = (r & 3) + 8 * (r >> 2);
        if (!((lo >> c) & 1u)) p0[r] = NEG;
        if (!((up >> c) & 1u)) p1[r] = NEG; }
}
struct BlockRef { const bf16* Q; const bf16* K; const bf16* V; bf16* O; const u32x2* M; int P0; };
struct Seam { bf16x8 qr[8]; bf16x8 st_v0, st_v1, st_k0, st_k1; };
#define ROW(p, k0, rr) ((p) + (size_t)((k0) + (rr)) * D + sc)
#define VMW() asm volatile("s_waitcnt vmcnt(0)" ::: "memory")
#define VMWN(n) asm volatile("s_waitcnt vmcnt(%0)" :: "i"(n) : "memory")
#define SLOAD_H(Kp, Vp, k0) do { S.st_v0 = load8(ROW(Vp, k0, sr)); S.st_v1 = load8(ROW(Vp, k0, 32 + sr));              \
                         S.st_k0 = load8(ROW(Kp, k0, sr)); S.st_k1 = load8(ROW(Kp, k0, 32 + sr)); } while (0)
#define SWRITE_HK(bf) do { *(bf16x8*)(K_lds + (bf) * SHM_K + kws) = S.st_k0; *(bf16x8*)(K_lds + (bf) * SHM_K + kws + 32 * 256) = S.st_k1; } while (0)
#define SWRITE_HV(bf) do { *(bf16x8*)(V_lds + (bf) * SHM_V + vst0) = S.st_v0; *(bf16x8*)(V_lds + (bf) * SHM_V + vst1) = S.st_v1; } while (0)
#define SWRITE_H(bf) do { SWRITE_HV(bf); SWRITE_HK(bf); } while (0)
__device__ __forceinline__ void sel_prime(const BlockRef& cur, char* lds, Seam& S) {
    int tid_ = threadIdx.x; asm volatile("" : "+v"(tid_));
    const int tid = tid_, wid = __builtin_amdgcn_readfirstlane(tid >> 6), lane = tid & 63, r32 = lane & 31, hi = lane >> 5;
    const int sr = tid >> 4, sc = (tid & 15) * 8, kws = KSWZ(sr, sc * 2); char* K_lds = lds + 2 * SHM_V;
    for (int d0 = 0; d0 < 8; ++d0) S.qr[d0] = load8(cur.Q + (size_t)(wid * QBLK + r32) * D + d0 * 16 + hi * 8);
    SLOAD_H(cur.K, cur.V, 0); VMW(); SWRITE_HK(0);
    __syncthreads();
}
__device__ __forceinline__ void sel_block(const BlockRef& cur, const BlockRef& nxt, char* lds, Seam& S) {
    int tid_ = threadIdx.x; asm volatile("" : "+v"(tid_));
    const int tid = tid_, wid = __builtin_amdgcn_readfirstlane(tid >> 6), lane = tid & 63, r32 = lane & 31, hi = lane >> 5;
    const int NT = (cur.P0 + QB) / KVBLK;
    char* V_lds = lds; char* K_lds = lds + 2 * SHM_V;
    float* ws = (float*)(lds + 2 * SHM_V + 2 * SHM_K) + wid * 64; float* li_l = ws, * al_l = ws + 32;
    float m_reg = -1e30f, l_reg = 0; f32x16 o[4] = {};
    const int sr = tid >> 4, sc = (tid & 15) * 8, vst0 = v_st(sr, sc), vst1 = v_st(32 + sr, sc), kws = KSWZ(sr, sc * 2);
    const int vb0 = (int)(uintptr_t)V_lds + v_rd_base(lane);
    const bf16* Kh = cur.K; const bf16* Vh = cur.V;
    const char* Mbase = (const char*)cur.M; const unsigned moff = (unsigned)(wid * QBLK + r32) * 512u;
#define MROW(t) (*(const u32x2*)(Mbase + (moff + (unsigned)(t) * 8u)))
#define RESC(a) do { if (__any((a) < 1.f)) { if (hi == 0) al_l[r32] = (a); asm volatile("s_waitcnt lgkmcnt(0)" ::: "memory");              \
                     for (int d_ = 0; d_ < 4; ++d_) for (int r = 0; r < 16; ++r) o[d_][r] *= al_l[crow(r, hi)]; } } while (0)
#define KBASE(t) ((t) * KVBLK)
    f32x16 pA0, pA1, pB0, pB1; float mnA, mnB, alA, alB; bf16x8 pa0, pa1, pa2, pa3; u32x2 mw;
    SWRITE_HV(0); SBAR();
    if (NT > 1) SLOAD_H(Kh, Vh, KBASE(1));
    mw = MROW(0);
    SBAR(); qkt<0, false>(pA0, pA1, K_lds, r32, hi, S.qr, true);
    mask_bits(pA0, pA1, mw, hi); partialSM(pA0, pA1, m_reg, mnA, alA);
    if (NT > 1) { VMW(); SWRITE_H(1); }
    __syncthreads();
#define HALF_STEP(PX0, PX1, mnX, alX, PY0, PY1, alY, t, KB, VB, SB) do {                                                      \
        SBAR(); mw = MROW(t); qkt<KB, false>(PX0, PX1, K_lds, r32, hi, S.qr, true);                                          \
        finishSM(PY0, PY1, alY, l_reg, pa0, pa1, pa2, pa3); SBAR();                                                           \
        if ((t) + 1 < NT) { SLOAD_H(Kh, Vh, KBASE((t) + 1)); SBAR(); }                                                        \
        pv_tile<VB, false>(o, vb0, pa0, pa1, pa2, pa3, true); mask_bits(PX0, PX1, mw, hi); partialSM(PX0, PX1, m_reg, mnX, alX); \
        __syncthreads();                                                                                                      \
        if ((t) + 1 < NT) { VMW(); SWRITE_H(SB); }                                                                            \
        RESC(alX); __syncthreads(); } while (0)
    for (int t = 1; t + 1 < NT; t += 2) {
        HALF_STEP(pB0, pB1, mnB, alB, pA0, pA1, alA, t, 1, 0, 0);
        HALF_STEP(pA0, pA1, mnA, alA, pB0, pB1, alB, t + 1, 0, 1, 1);
    }
    const bool even = (NT & 1) == 0;
    if (even) { SBAR(); mw = MROW(NT - 1); qkt<1, false>(pB0, pB1, K_lds, r32, hi, S.qr, true); SBAR(); }
    SLOAD_H(nxt.K, nxt.V, 0); SBAR();
#pragma unroll
    for (int d0 = 0; d0 < 8; ++d0) S.qr[d0] = load8(nxt.Q + (size_t)(wid * QBLK + r32) * D + d0 * 16 + hi * 8);
    SBAR();
    finishSM(pA0, pA1, alA, l_reg, pa0, pa1, pa2, pa3); SBAR();
    pv_tile<0, false>(o, vb0, pa0, pa1, pa2, pa3, true);
    if (even) { mask_bits(pB0, pB1, mw, hi); partialSM(pB0, pB1, m_reg, mnB, alB); __syncthreads(); RESC(alB);
        finishSM(pB0, pB1, alB, l_reg, pa0, pa1, pa2, pa3); SBAR(); pv_tile<1, false>(o, vb0, pa0, pa1, pa2, pa3, true); }
    SBAR(); VMWN(8); SWRITE_HK(0); SBAR();
    if (hi == 0) li_l[r32] = l_reg; asm volatile("s_waitcnt lgkmcnt(0)" ::: "memory");
    float rli[16];
#pragma unroll
    for (int r = 0; r < 16; ++r) rli[r] = __builtin_amdgcn_rcpf(li_l[crow(r, hi)]);
    bf16* Ow = cur.O + (size_t)(wid * QBLK) * OS;
#pragma unroll
    for (int r = 0; r < 16; ++r) { const int orow = crow(r, hi);
#pragma unroll
        for (int d0 = 0; d0 < 4; ++d0) { const float v = o[d0][r] * rli[r];
            const float vn = __shfl_xor(v, 1);
            if ((r32 & 1) == 0) *(unsigned*)(Ow + (size_t)orow * OS + d0 * 32 + r32) = cvtpk(v, vn); } }
    __syncthreads();
#undef RESC
#undef KBASE
#undef HALF_STEP
#undef MROW
}
#undef ROW
#undef VMW
#undef VMWN
#undef SLOAD_H
#undef SWRITE_HK
#undef SWRITE_HV
#undef SWRITE_H
#undef KSWZ
#undef SBAR
}


__device__ __forceinline__ attn::BlockRef attn_ref(ARGREF a, int b, int h, int qb) {
    attn::BlockRef r; const int kvh = h / 3;
    r.Q = (const attn::bf16*)(a.ws + WS_QB) + ((size_t)(b * 6 + h) * SEQ + (size_t)qb * 256) * 128;
    r.K = (const attn::bf16*)(a.ws + WS_KB) + (size_t)(b * 2 + kvh) * SEQ * 128;
    r.V = (const attn::bf16*)(a.ws + WS_VB) + (size_t)(b * 2 + kvh) * SEQ * 128;
    r.O = (attn::bf16*)(a.ws + WS_MIX) + (size_t)(b * SEQ + qb * 256) * DM + h * 128;
    r.M = (const attn::u32x2*)(a.ws + WS_MASK) + (size_t)(b * SEQ + qb * 256) * 64;
    r.P0 = qb * 256; return r;
}
__device__ __forceinline__ void p11_attention(Ctx& c, ARGREF a) {
    constexpr int NITEM = 240;
#pragma unroll 1
    for (int it = c.vcu; it < NITEM; it += c.G) {
        const int bh = it / 10, slot = it % 10, b = bh / 6, h = bh % 6;
        const int q0 = slot < 3 ? 15 - slot : (slot == 9 ? 6 : slot - 3), q1 = slot < 3 ? q0 : (slot == 9 ? 6 : 15 - slot);
        attn::Seam S;
        attn::BlockRef cur = attn_ref(a, b, h, q0), nxt = attn_ref(a, b, h, q1);
        __syncthreads();
        attn::sel_prime(cur, (char*)c.lds, S);
        if (q0 != q1) attn::sel_block(cur, nxt, (char*)c.lds, S);
        attn::sel_block(nxt, nxt, (char*)c.lds, S);
    }
    if (c.G == 256) {
        if (c.vcu >= NITEM) { for (int j = 0; j < 4; ++j) { const int u = (c.vcu - NITEM) * 4 + j; attn_sample_unit(c, a, u >> 2, u & 3); } }
        else if (c.vcu % 10 == 9) { for (int j = 0; j < 3; ++j) { const int u = 64 + (c.vcu / 10) * 3 + j; if (u < MS) attn_sample_unit(c, a, u >> 2, u & 3); } }
    } else for (int u = c.vcu; u < MS; u += c.G) attn_sample_unit(c, a, u >> 2, u & 3);
}

enum { PH_PRO = 0, PH_IN0, PH_MIX0, PH_HSCAN, PH_HFIX, PH_OUT0, PH_GU0, PH_DOWN0, PH_IN1, PH_POST, PH_IDX, PH_TOPK, PH_ATTN, PH_OUT1, PH_GU1, PH_DOWN1, NPHASE };
#ifndef ONLYPH
#define ONLYPH -1
#endif
#define PHON(x) (ONLYPH < 0 || ONLYPH == (x))
#ifndef REP_PH
#define REP_PH -1
#endif
#ifndef REP_N
#define REP_N 1
#endif
__global__ void __launch_bounds__(NWAVES * 64, 2) fwd_kernel(Args args) {
    extern __shared__ __attribute__((aligned(16))) unsigned char lds[];
    Ctx c;
    c.lds = (LAS unsigned char*)lds;
    c.MISC = (volatile LAS unsigned*)(c.lds + MISC_OFF);
    c.tid = threadIdx.x; c.lane = c.tid & 63; c.wave = __builtin_amdgcn_readfirstlane(c.tid >> 6);
    c.G = gridDim.x; { const int bx = blockIdx.x; c.vcu = (c.G % 8 == 0) ? (bx % 8) * (c.G / 8) + bx / 8 : bx; }
    c.ctl = (gu32*)(args.ws + WS_CTL);
    for (int u = c.tid; u < (LDS_BYTES - LDSCTL_OFF) / 4; u += NWAVES * 64) ((LAS unsigned*)(c.lds + LDSCTL_OFF))[u] = 0u;
    __syncthreads();
    const int lo = args.ph_lo, hi = args.ph_hi;
    XcdBarrier bar; bar.bar = (unsigned*)(c.ctl + CW_BAR); bar.x = 0; bar.st = nullptr;
    if (hi - lo > 1 || REP_N > 1) bar = xcd_barrier_post((unsigned*)(c.ctl + CW_BAR), c.MISC + 8);
    c.qoff = 0;
#pragma unroll 1
    for (int ph = lo; ph < hi; ++ph) {
        const int layer = ph >= PH_IN1 ? 1 : 0;
        const __attribute__((address_space(4))) Args* ap = (const __attribute__((address_space(4))) Args*)__builtin_amdgcn_kernarg_segment_ptr(); asm volatile("" : "+s"(ap));
        ARGREF la = *ap; unsigned char* const ws = la.ws; float* const out = la.out;
        { int t_ = threadIdx.x; asm volatile("" : "+v"(t_)); c.tid = t_; c.lane = t_ & 63; c.wave = __builtin_amdgcn_readfirstlane(t_ >> 6); }
        if ((ph == PH_DOWN0 || ph == PH_DOWN1) && PHON(PH_OUT0)) {
            pg8::SchedX S0; S0.init(MP, 1024, c.G, (int)blockIdx.x, 0, 0, 1, 0); pg8::Unit u0; if (S0.next(0, u0)) conv_fixup_tile(c, la, layer, u0.pm); VM_WAIT(); __syncthreads(); }
        if (ph == PH_PRO && PHON(PH_PRO)) p0_prologue(c, la);
        else if ((ph == PH_IN0 || ph == PH_IN1) && PHON(PH_IN0)) {
            pg8::Gemm g{(const pg8::bf16_t*)(ws + WS_XB), (const pg8::bf16_t*)(ws + (ph == PH_IN0 ? WS_WIN0 : WS_WIN1)), MT, 0, 1024};
            pg8::SchedX S; if (ph == PH_IN0) S.init(MP, ZC0, c.G, (int)blockIdx.x, 16, MT / 256, 4, 13); else S.init(MP, ZC1, c.G, (int)blockIdx.x, 0, 0, 1, 0);
            pg8::EpiZ E{(pg8::bf16_t*)(ws + WS_Z), ph == PH_IN0 ? ZC0 : ZC1, ssptr(c, ph == PH_IN0 ? 0 : 2), ph == PH_IN0 ? 13 : 9, (float*)(ws + WS_MEMKV), MEMROW0};
            pg8::gemm_phase<pg8::EpiZ, pg8::SchedX, PG8_ALIGN, PG8_SP2>(c.lds + RING_OFF, g, S, E);
            { SgArgs sg{}; sg.A = (const bf16*)(ws + WS_XB) + (size_t)MP * DM; sg.Bt = (const bf16*)(ws + (ph == PH_IN0 ? WS_WIN0 : WS_WIN1)); sg.K = 1024; sg.mode = 0; sg.Z = (bf16*)(ws + WS_Z); sg.ldz = ph == PH_IN0 ? ZC0 : ZC1; sg.ssin = ssptr(c, ph == PH_IN0 ? 0 : 2);
              sgemm_phase(c, sg, ph == PH_IN0 ? ZC0 : ZC1); }
            if (ph == PH_IN0) { __syncthreads(); convert_layer1_tail(c, la, (64 * 13 + 16) % c.G); }
        }
        else if (ph == PH_MIX0 && PHON(PH_MIX0)) p2_mixer0(c, la);
        else if (ph == PH_HSCAN && PHON(PH_HSCAN)) hgrn_scan(c, la);
        else if (ph == PH_HFIX && PHON(PH_HFIX)) p2c_hgrn_fix(c, la);
        else if ((ph == PH_OUT0 || ph == PH_DOWN0 || ph == PH_OUT1 || ph == PH_DOWN1) && PHON(PH_OUT0)) {
            const bool isout = (ph == PH_OUT0 || ph == PH_OUT1);
            pg8::Gemm g{(const pg8::bf16_t*)(ws + (isout ? WS_MIX : WS_ACT)), (const pg8::bf16_t*)(ws + (isout ? WS_WOUT + (size_t)layer * 1024 * 1024 * 2 : WS_WD + (size_t)layer * 1024 * DFF * 2)), MT, 1024, isout ? 1024 : DFF};
            pg8::SchedX S; S.init(MP, 1024, c.G, (int)blockIdx.x, 0, 0, 1, 0);
            pg8::EpiResid E;
            E.rp = ph == PH_OUT0 ? la.in[0] : nullptr; E.rb = (const pg8::bf16_t*)(ws + WS_XB); E.y = ph == PH_DOWN1 ? out + O_YP : nullptr;
            E.xb = ph == PH_DOWN1 ? nullptr : (pg8::bf16_t*)(ws + WS_XB); E.ssout = ph == PH_DOWN1 ? nullptr : ssptr(c, ph == PH_OUT0 ? 1 : (ph == PH_DOWN0 ? 2 : 3));
            pg8::gemm_phase<pg8::EpiResid, pg8::SchedX, PG8_ALIGN, PG8_SP2>(c.lds + RING_OFF, g, S, E);
            { SgArgs sg{}; sg.A = (const bf16*)(ws + (isout ? WS_MIX : WS_ACT)) + (size_t)MP * (isout ? 1024 : DFF); sg.Bt = (const bf16*)g.Bt; sg.K = isout ? 1024 : DFF; sg.mode = 1; sg.rb = (const bf16*)(ws + WS_XB); sg.resid = ph == PH_OUT0 ? la.in[1] : nullptr; sg.y = ph == PH_DOWN1 ? out + O_YS : nullptr; sg.xb = (bf16*)E.xb; sg.ssout = E.ssout;
              sgemm_phase(c, sg, 1024); }
        }
        else if ((ph == PH_GU0 || ph == PH_GU1) && PHON(PH_GU0)) {
            pg8::Gemm g{(const pg8::bf16_t*)(ws + WS_XB), (const pg8::bf16_t*)(ws + WS_WGU + (size_t)layer * 5632 * 1024 * 2), MT, 5632, 1024};
            pg8::SchedX S; S.init(MP, 5632, c.G, (int)blockIdx.x, 0, 0, 1, 0);
            pg8::EpiGU E{(pg8::bf16_t*)(ws + WS_ACT), ssptr(c, layer ? 3 : 1), out + O_CVP + (size_t)layer * 4 * 2 * DFF, la.in[26] + (size_t)layer * 3 * DFF, la.in[27] + (size_t)layer * DFF, (float*)(ws + WS_G4), (float*)(ws + WS_UP2)};
            pg8::gemm_phase<pg8::EpiGU, pg8::SchedX, PG8_ALIGN, PG8_SP2>(c.lds + RING_OFF, g, S, E);
            { SgArgs sg{}; sg.A = (const bf16*)(ws + WS_XB) + (size_t)MP * DM; sg.Bt = (const bf16*)g.Bt; sg.K = 1024; sg.mode = 2; sg.ssin = E.ss; sg.ACT = (bf16*)E.ACT; sg.cvs = out + O_CVS + (size_t)layer * 32 * 2 * DFF; sg.cst = la.in[8] + (size_t)layer * 32 * 2 * DFF; sg.cw = E.cw; sg.cb = E.cb;
              sgemm_phase(c, sg, 5632); }
        }
        else if (ph == PH_POST && PHON(PH_POST)) p8_dsa_post(c, la);
        else if (ph == PH_IDX && PHON(PH_IDX)) p9_indexer(c, la);
        else if (ph == PH_TOPK && PHON(PH_TOPK)) p10_topk(c, la);
        else if (ph == PH_ATTN && PHON(PH_ATTN)) p11_attention(c, la);
        if (REP_N > 1 && ph == REP_PH && c.qoff < 4 * (REP_N - 1)) { c.qoff += 4; --ph; xcd_barrier(bar); continue; }
        if (REP_N > 1) c.qoff = 0;
        if (ph + 1 < hi) xcd_barrier(bar);
    }
}

#ifndef MK_ONE_LAUNCH
#define MK_ONE_LAUNCH 1
#endif
extern "C" void kernel_launch(void* const* d_in, const int* in_sizes, int n_in, void* d_out, int out_size, void* d_ws, size_t ws_size, hipStream_t stream) {
    static int grid = 0;
    if (grid == 0) {
        if (n_in != 29 || out_size != (int)O_END || ws_size < WS_END) { fprintf(stderr, "kernel_launch: unexpected problem (n_in %d, out %d, ws %zu)\n", n_in, out_size, ws_size); grid = -1; return; }
        int dev = 0, cus = 0;
        if (hipGetDevice(&dev) != hipSuccess || hipDeviceGetAttribute(&cus, hipDeviceAttributeMultiprocessorCount, dev) != hipSuccess) { grid = -1; return; }
        if (hipFuncSetAttribute((const void*)fwd_kernel, hipFuncAttributeMaxDynamicSharedMemorySize, LDS_BYTES) != hipSuccess) { fprintf(stderr, "kernel_launch: hipFuncSetAttribute failed\n"); grid = -1; return; }
        (void)hipGetLastError();
        grid = cus;
    }
    if (grid < 0) return;
    if (hipMemsetAsync((char*)d_ws + WS_CTL, 0, CTL_ZERO_BYTES, stream) != hipSuccess) { fprintf(stderr, "kernel_launch: memset failed\n"); return; }
    Args a{};
    for (int i = 0; i < 29; ++i) a.in[i] = (const float*)d_in[i];
    a.page_table = (const int*)d_in[9]; a.out = (float*)d_out; a.ws = (unsigned char*)d_ws;
#if MK_ONE_LAUNCH
    a.ph_lo = 0; a.ph_hi = NPHASE;
    hipLaunchKernelGGL(fwd_kernel, dim3(grid), dim3(NWAVES * 64), LDS_BYTES, stream, a);
#else
    for (int ph = 0; ph < NPHASE; ++ph) { a.ph_lo = ph; a.ph_hi = ph + 1; hipLaunchKernelGGL(fwd_kernel, dim3(grid), dim3(NWAVES * 64), LDS_BYTES, stream, a); }
#endif
}
```

```cpp
#include <hip/hip_runtime.h>
#include <cstdio>
#include <cstdint>


namespace pg8 {
#define PG8_LAS __attribute__((address_space(3)))
typedef unsigned short bf16_t;
typedef short bf16x8 __attribute__((ext_vector_type(8)));
typedef float f32x4 __attribute__((ext_vector_type(4)));
typedef unsigned u32x4 __attribute__((ext_vector_type(4)));
constexpr int BM = 256, BK = 64, HALF = 128, HTB = HALF * BK * 2  , STAGE_BYTES = 8 * HTB, NXCD = 8, WGM = 8;

__host__ __device__ __forceinline__ int lds_byte(int r, int c) { const int st = (r >> 4) * 2 + (c >> 5), rr = r & 15, cc = c & 31, ob = rr * 64 + cc * 2; return st * 1024 + (ob ^ (((ob >> 9) & 1) << 5)); }
__host__ __device__ __forceinline__ void stage_rc(int b, int& R, int& C) { const int st = b / 1024, sb = b % 1024, swz = sb ^ (((sb >> 9) & 1) << 5); R = (st >> 1) * 16 + swz / 64; C = (st & 1) * 32 + (swz % 64) / 2; }
__host__ __device__ __forceinline__ int perm32(int rho) { const int n = rho >> 4, i = rho & 15; return 8 * (i >> 2) + 4 * n + (i & 3); }

struct Unit { int pm, pn; };
struct Gemm { const bf16_t* A; const bf16_t* Bt; int M, N, K; };

struct StaticOrder {
    int nM, nN, nwg, G, c;
    __host__ __device__ __forceinline__ void init(int M, int N, int G_, int c_) { nM = M / BM; nN = N / BM; nwg = nM * nN; G = G_; c = c_; }
    __host__ __device__ __forceinline__ bool next(int i, Unit& u) const {
        const long L = (long)i * G + c; if (L >= nwg) return false;
        int wgid = (int)L; { const int q = nwg / NXCD, r = nwg % NXCD, xcd = wgid % NXCD, off = wgid / NXCD; wgid = (xcd < r ? xcd * (q + 1) : r * (q + 1) + (xcd - r) * q) + off; }
        const int nig = WGM * nN, gid = wgid / nig, fm = gid * WGM, gsz = (nM - fm) < WGM ? (nM - fm) : WGM;
        u.pm = fm + ((wgid % nig) % gsz); u.pn = (wgid % nig) / gsz; return true;
    }
    __device__ __forceinline__ void a_ready(const Unit&) const {}
    __device__ __forceinline__ void done(const Unit&) const {}
};


constexpr int MP = 16384, MS = 128, MVALID = MP + MS, MT = 16640, DM = 1024, DFF = 2816;
constexpr float RMS_EPS = 1e-6f;
__device__ __forceinline__ unsigned cvt_pk_bf16(float lo, float hi) { unsigned r; asm volatile("v_cvt_pk_bf16_f32 %0, %1, %2" : "=v"(r) : "v"(lo), "v"(hi)); return r; }

struct SchedX {
    StaticOrder so; int nextra, e_pm0, e_nm, e_pn0;
    __device__ __forceinline__ void init(int M, int N, int G_, int c_, int nextra_, int e_pm0_, int e_nm_, int e_pn0_) { so.init(M, N, G_, c_); nextra = nextra_; e_pm0 = e_pm0_; e_nm = e_nm_; e_pn0 = e_pn0_; }
    __device__ __forceinline__ bool next(int i, Unit& u) const {
        const long L = (long)i * so.G + so.c;
        if (L < so.nwg) return so.next(i, u);
        const int e = (int)(L - so.nwg); if (e >= nextra) return false;
        u.pm = e_pm0 + e % e_nm; u.pn = e_pn0 + e / e_nm; return true;
    }
    __device__ __forceinline__ void a_ready(const Unit&) const {}
    __device__ __forceinline__ void done(const Unit&) const {}
};

struct EpiZ {
    static constexpr bool PERM = true, AFTER_DRAIN = false;
    bf16_t* Z; int ldz; const float* ss; int nmain; float* memkv; int memrow0;
    __device__ __forceinline__ void operator()(const f32x4 (&acc)[2][2][4][2], const Unit& u, int wr, int wc, int fr, int fq) const {
        const int row0 = u.pm * BM + wr * 64 + fr;
        if (u.pn < nmain) {
            const int col0 = u.pn * BM + wc * 32 + 8 * fq;
#pragma unroll
            for (int ai = 0; ai < 2; ++ai)
#pragma unroll
                for (int m = 0; m < 4; ++m) { const int row = row0 + ai * HALF + m * 16; const float rs = rsqrtf(ss[row] * (1.0f / DM) + RMS_EPS);
#pragma unroll
                    for (int bj = 0; bj < 2; ++bj) { const f32x4 v0 = acc[ai][bj][m][0] * rs, v1 = acc[ai][bj][m][1] * rs;
                        u32x4 w; w.x = cvt_pk_bf16(v0[0], v0[1]); w.y = cvt_pk_bf16(v0[2], v0[3]); w.z = cvt_pk_bf16(v1[0], v1[1]); w.w = cvt_pk_bf16(v1[2], v1[3]);
                        *(u32x4*)(Z + (size_t)row * ldz + col0 + bj * HALF) = w; } }
        } else {
            const int col0 = (u.pn - nmain) * BM + wc * 32 + 8 * fq;
#pragma unroll
            for (int ai = 0; ai < 2; ++ai)
#pragma unroll
                for (int m = 0; m < 4; ++m) { const int row = row0 + ai * HALF + m * 16 - memrow0;
#pragma unroll
                    for (int bj = 0; bj < 2; ++bj) { float* p = memkv + (size_t)row * 1024 + col0 + bj * HALF; *(f32x4*)p = acc[ai][bj][m][0]; *(f32x4*)(p + 4) = acc[ai][bj][m][1]; } }
        }
    }
};

struct EpiResid {
    static constexpr bool PERM = true, AFTER_DRAIN = false;
    const float* rp; const bf16_t* rb; float* y; bf16_t* xb; float* ssout;
    __device__ __forceinline__ void operator()(const f32x4 (&acc)[2][2][4][2], const Unit& u, int wr, int wc, int fr, int fq) const {
        const int row0 = u.pm * BM + wr * 64 + fr, col0 = u.pn * BM + wc * 32 + 8 * fq;
#pragma unroll
        for (int ai = 0; ai < 2; ++ai)
#pragma unroll
            for (int m = 0; m < 4; ++m) { const int row = row0 + ai * HALF + m * 16; float part = 0.f;
#pragma unroll
                for (int bj = 0; bj < 2; ++bj) { const int c = col0 + bj * HALF; f32x4 r0, r1;
                    if (rp) { r0 = *(const f32x4*)(rp + (size_t)row * DM + c); r1 = *(const f32x4*)(rp + (size_t)row * DM + c + 4); }
                    else { const u32x4 q = *(const u32x4*)(rb + (size_t)row * DM + c);
                        r0 = (f32x4){__builtin_bit_cast(float, q.x << 16), __builtin_bit_cast(float, q.x & 0xffff0000u), __builtin_bit_cast(float, q.y << 16), __builtin_bit_cast(float, q.y & 0xffff0000u)};
                        r1 = (f32x4){__builtin_bit_cast(float, q.z << 16), __builtin_bit_cast(float, q.z & 0xffff0000u), __builtin_bit_cast(float, q.w << 16), __builtin_bit_cast(float, q.w & 0xffff0000u)}; }
                    const f32x4 v0 = acc[ai][bj][m][0] + r0, v1 = acc[ai][bj][m][1] + r1;
                    if (y) { *(f32x4*)(y + (size_t)row * DM + c) = v0; *(f32x4*)(y + (size_t)row * DM + c + 4) = v1; }
                    part += (v0[0] * v0[0] + v0[1] * v0[1]) + (v0[2] * v0[2] + v0[3] * v0[3]) + (v1[0] * v1[0] + v1[1] * v1[1]) + (v1[2] * v1[2] + v1[3] * v1[3]);
                    if (xb) { u32x4 w; w.x = cvt_pk_bf16(v0[0], v0[1]); w.y = cvt_pk_bf16(v0[2], v0[3]); w.z = cvt_pk_bf16(v1[0], v1[1]); w.w = cvt_pk_bf16(v1[2], v1[3]);
                        *(u32x4*)(xb + (size_t)row * DM + c) = w; } }
                part += __shfl_xor(part, 16); part += __shfl_xor(part, 32);
                if (ssout && fq == 0) atomicAdd(ssout + row, part); }
    }
};

__device__ __forceinline__ void dpp_ror12(const f32x4& v, f32x4& r1, f32x4& r2) {
    float a0, a1, a2, a3, b0, b1, b2, b3;
    asm volatile("s_nop 1\n\t"
                 "v_mov_b32_dpp %0, %8 row_ror:1 row_mask:0xf bank_mask:0xf\n\tv_mov_b32_dpp %1, %9 row_ror:1 row_mask:0xf bank_mask:0xf\n\t"
                 "v_mov_b32_dpp %2, %10 row_ror:1 row_mask:0xf bank_mask:0xf\n\tv_mov_b32_dpp %3, %11 row_ror:1 row_mask:0xf bank_mask:0xf\n\t"
                 "v_mov_b32_dpp %4, %8 row_ror:2 row_mask:0xf bank_mask:0xf\n\tv_mov_b32_dpp %5, %9 row_ror:2 row_mask:0xf bank_mask:0xf\n\t"
                 "v_mov_b32_dpp %6, %10 row_ror:2 row_mask:0xf bank_mask:0xf\n\tv_mov_b32_dpp %7, %11 row_ror:2 row_mask:0xf bank_mask:0xf"
                 : "=&v"(a0), "=&v"(a1), "=&v"(a2), "=&v"(a3), "=&v"(b0), "=&v"(b1), "=&v"(b2), "=&v"(b3) : "v"(v[0]), "v"(v[1]), "v"(v[2]), "v"(v[3]));
    r1 = (f32x4){a0, a1, a2, a3}; r2 = (f32x4){b0, b1, b2, b3};
}
struct EpiGU {
    static constexpr bool PERM = true, AFTER_DRAIN = false;
    bf16_t* ACT; const float* ss; float* cvp; const float* cw; const float* cb; float* G4; float* UP2;
    __device__ __forceinline__ void operator()(const f32x4 (&acc)[2][2][4][2], const Unit& u, int wr, int wc, int fr, int fq) const {
        const int row0 = u.pm * BM + wr * 64 + fr, colg = u.pn * HALF + wc * 32 + 8 * fq;
#pragma unroll
        for (int n = 0; n < 2; ++n) { const int col = colg + 4 * n;
            const f32x4 w0 = *(const f32x4*)(cw + col), w1 = *(const f32x4*)(cw + DFF + col), w2 = *(const f32x4*)(cw + 2 * DFF + col), bb = *(const f32x4*)(cb + col);
#pragma unroll
            for (int ai = 0; ai < 2; ++ai) { f32x4 r1p = {0.f, 0.f, 0.f, 0.f}, r2p = r1p; const int slab = (u.pm * BM + ai * HALF + wr * 64) >> 6;
#pragma unroll
                for (int m = 0; m < 4; ++m) { const int row = row0 + ai * HALF + m * 16; const float rs = rsqrtf(ss[row] * (1.0f / DM) + RMS_EPS);
                    const f32x4 g = acc[ai][0][m][n] * rs, up = acc[ai][1][m][n] * rs;
                    f32x4 r1, r2; dpp_ror12(g, r1, r2);
                    const f32x4 p1 = fr >= 1 ? r1 : r1p, p2 = fr >= 2 ? r2 : r2p;
                    f32x4 cv = bb + w0 * p2 + w1 * p1 + w2 * g, y;
#pragma unroll
                    for (int i = 0; i < 4; ++i) y[i] = cv[i] * __builtin_amdgcn_rcpf(1.0f + __expf(-cv[i])) * up[i];
                    if (m == 0 && fr < 2) { *(f32x4*)(G4 + (size_t)(slab * 4 + fr) * DFF + col) = g; *(f32x4*)(UP2 + (size_t)(slab * 2 + fr) * DFF + col) = up; }
                    else { typedef unsigned u32x2 __attribute__((ext_vector_type(2))); u32x2 w; w.x = cvt_pk_bf16(y[0], y[1]); w.y = cvt_pk_bf16(y[2], y[3]); *(u32x2*)(ACT + (size_t)row * DFF + col) = w; }
                    if (m == 3 && fr >= 14) { *(f32x4*)(G4 + (size_t)(slab * 4 + 2 + (fr - 14)) * DFF + col) = g;
                        const int t = row & 4095; if (t >= 4094) *(f32x4*)(cvp + (size_t)((row >> 12) * 2 + (t - 4094)) * DFF + col) = g; }
                    r1p = r1; r2p = r2; } } }
    }
};

template <class Epi, class Sched, bool ALIGN_EPI = false, bool SP2 = false>
__device__ __forceinline__ void gemm_phase(PG8_LAS unsigned char* lds, const Gemm g, const Sched& S, const Epi& E) {
    int tid_ = threadIdx.x; asm volatile("" : "+v"(tid_));
    const int tid = tid_, wid = __builtin_amdgcn_readfirstlane(tid >> 6), lane = tid & 63, wr = wid >> 2, wc = wid & 3, fr = lane & 15, fq = lane >> 4;
    const int K = g.K, nt = K / BK;
    unsigned voffA[2], voffB[2];
#pragma unroll
    for (int i = 0; i < 2; ++i) { int R, C; stage_rc(tid * 16 + i * 8192, R, C); const int Rb = Epi::PERM ? ((R & ~31) + perm32(R & 31)) : R;
        voffA[i] = (unsigned)(R * K + C) * 2u; voffB[i] = (unsigned)(Rb * K + C) * 2u; }
    const size_t kstep = (size_t)(BK * 2);
    const size_t hstep = (size_t)HALF * K * 2;
    const size_t tstep = 2 * hstep;
    const unsigned ldsw = (unsigned)wid * 1024u;
    const int aoff = lds_byte(wr * 64 + fr, fq * 8), boff = lds_byte(wc * 32 + fr, fq * 8);
#define PG8_SA(b, h) (((b) * 2 + (h)) * HTB)
#define PG8_SB(b, h) ((4 + (b) * 2 + (h)) * HTB)
#define PG8_STAGE(bufoff, gbase, voff) do { _Pragma("unroll") for (int _i = 0; _i < 2; ++_i) \
        __builtin_amdgcn_global_load_lds((const unsigned*)((const char*)(gbase) + (voff)[_i]), (PG8_LAS unsigned*)(lds + (bufoff) + ldsw + _i * 8192), 16, 0, 0); } while (0)
#define PG8_LDA(dst, b, h) do { _Pragma("unroll") for (int m = 0; m < 4; ++m) _Pragma("unroll") for (int k = 0; k < 2; ++k) dst[m][k] = *(const PG8_LAS bf16x8*)(lds + PG8_SA(b, h) + aoff + m * 2048 + k * 1024); } while (0)
#define PG8_LDB(dst, b, h) do { _Pragma("unroll") for (int n = 0; n < 2; ++n) _Pragma("unroll") for (int k = 0; k < 2; ++k) dst[n][k] = *(const PG8_LAS bf16x8*)(lds + PG8_SB(b, h) + boff + n * 2048 + k * 1024); } while (0)
#define PG8_MMA(ai, bj, At, Bt) do { __builtin_amdgcn_s_setprio(1); _Pragma("unroll") for (int m = 0; m < 4; ++m) _Pragma("unroll") for (int n = 0; n < 2; ++n) _Pragma("unroll") for (int k = 0; k < 2; ++k) \
        acc[ai][bj][m][n] = __builtin_amdgcn_mfma_f32_16x16x32_bf16(Bt[n][k], At[m][k], acc[ai][bj][m][n], 0, 0, 0); __builtin_amdgcn_s_setprio(0); } while (0)
#define PG8_WAIT_V(n) asm volatile("s_waitcnt vmcnt(" #n ")" ::: "memory")
#define PG8_WAIT_L(n) asm volatile("s_waitcnt lgkmcnt(" #n ")" ::: "memory")
#define PG8_BAR __builtin_amdgcn_s_barrier()
#define PG8_SCHED __builtin_amdgcn_sched_barrier(0)
    Unit cur, nxt; int ui = 0;
    if (!S.next(0, cur)) return;
    f32x4 acc[2][2][4][2];
#pragma unroll
    for (int a = 0; a < 2; ++a)
#pragma unroll
        for (int b = 0; b < 2; ++b)
#pragma unroll
            for (int m = 0; m < 4; ++m)
#pragma unroll
                for (int n = 0; n < 2; ++n) acc[a][b][m][n] = (f32x4){0.f, 0.f, 0.f, 0.f};
    bf16x8 At[4][2], B0[2][2], B1[2][2];
    const char* cA = (const char*)g.A + (size_t)cur.pm * tstep; const char* cB = (const char*)g.Bt + (size_t)cur.pn * tstep;
    S.a_ready(cur);
    if constexpr (SP2) {
        PG8_STAGE(PG8_SB(0, 0), cB, voffB); PG8_STAGE(PG8_SB(0, 1), cB + hstep, voffB); PG8_STAGE(PG8_SA(0, 0), cA, voffA); PG8_STAGE(PG8_SA(0, 1), cA + hstep, voffA);
        if (wr == 1) PG8_BAR;
        PG8_WAIT_V(2); PG8_BAR;
        PG8_STAGE(PG8_SB(1, 0), cB + kstep, voffB); PG8_STAGE(PG8_SA(1, 0), cA + kstep, voffA); PG8_STAGE(PG8_SB(1, 1), cB + hstep + kstep, voffB);
        PG8_WAIT_V(6); PG8_BAR;
    } else {
        PG8_STAGE(PG8_SB(0, 0), cB, voffB); PG8_STAGE(PG8_SA(0, 0), cA, voffA); PG8_STAGE(PG8_SB(0, 1), cB + hstep, voffB); PG8_STAGE(PG8_SA(0, 1), cA + hstep, voffA);
        if (wr == 1) PG8_BAR;
        PG8_WAIT_V(4); PG8_BAR;
        PG8_STAGE(PG8_SB(1, 0), cB + kstep, voffB); PG8_STAGE(PG8_SA(1, 0), cA + kstep, voffA); PG8_STAGE(PG8_SB(1, 1), cB + hstep + kstep, voffB);
        PG8_WAIT_V(6); PG8_BAR;
    }
    for (;;) {
        const bool has_next = S.next(ui + 1, nxt);
        const char* nA = has_next ? (const char*)g.A + (size_t)nxt.pm * tstep : cA; const char* nB = has_next ? (const char*)g.Bt + (size_t)nxt.pn * tstep : cB;
        for (int t = 0; t < nt; t += 2) {
            const bool last = (t == nt - 2);
            const char* a1 = cA + (size_t)(t + 1) * kstep;
            const char* a2 = last ? nA : cA + (size_t)(t + 2) * kstep; const char* b2 = last ? nB : cB + (size_t)(t + 2) * kstep;
            const char* a3 = a2 + kstep; const char* b3 = b2 + kstep;
            if (last && has_next) S.a_ready(nxt);
            if constexpr (SP2) {
            PG8_LDB(B0, 0, 0); PG8_LDB(B1, 0, 1); PG8_SCHED; PG8_LDA(At, 0, 0); PG8_STAGE(PG8_SA(1, 1), a1 + hstep, voffA);
            PG8_WAIT_V(8); PG8_WAIT_L(0); PG8_BAR; PG8_MMA(0, 0, At, B0); PG8_MMA(0, 1, At, B1); PG8_BAR; PG8_SCHED;
            PG8_LDA(At, 0, 1); PG8_STAGE(PG8_SB(0, 0), b2, voffB); PG8_STAGE(PG8_SB(0, 1), b2 + hstep, voffB); PG8_STAGE(PG8_SA(0, 0), a2, voffA);
            PG8_WAIT_V(8); PG8_WAIT_L(0); PG8_BAR; PG8_MMA(1, 0, At, B0); PG8_MMA(1, 1, At, B1); PG8_BAR; PG8_SCHED;
            PG8_LDB(B0, 1, 0); PG8_LDB(B1, 1, 1); PG8_SCHED; PG8_LDA(At, 1, 0); PG8_STAGE(PG8_SA(0, 1), a2 + hstep, voffA);
            PG8_WAIT_V(8); PG8_WAIT_L(0); PG8_BAR; PG8_MMA(0, 0, At, B0); PG8_MMA(0, 1, At, B1); PG8_BAR; PG8_SCHED;
            PG8_LDA(At, 1, 1); PG8_STAGE(PG8_SB(1, 0), b3, voffB); PG8_STAGE(PG8_SB(1, 1), b3 + hstep, voffB); PG8_STAGE(PG8_SA(1, 0), a3, voffA);
            PG8_WAIT_V(8); PG8_WAIT_L(0); PG8_BAR; PG8_MMA(1, 0, At, B0); PG8_MMA(1, 1, At, B1); PG8_BAR; PG8_SCHED;
            } else {
            PG8_LDB(B0, 0, 0); PG8_SCHED; PG8_LDA(At, 0, 0); PG8_STAGE(PG8_SA(1, 1), a1 + hstep, voffA);
            PG8_WAIT_L(8); PG8_BAR; PG8_WAIT_L(0); PG8_MMA(0, 0, At, B0); PG8_BAR; PG8_SCHED;
            PG8_LDB(B1, 0, 1); PG8_STAGE(PG8_SB(0, 0), b2, voffB);
            PG8_BAR; PG8_WAIT_L(0); PG8_MMA(0, 1, At, B1); PG8_BAR;
            PG8_LDA(At, 0, 1); PG8_STAGE(PG8_SA(0, 0), a2, voffA);
            PG8_BAR; PG8_WAIT_L(0); PG8_MMA(1, 0, At, B0); PG8_BAR; PG8_SCHED;
            PG8_STAGE(PG8_SB(0, 1), b2 + hstep, voffB);
            PG8_WAIT_V(6); PG8_BAR; PG8_MMA(1, 1, At, B1); PG8_BAR;
            PG8_LDB(B0, 1, 0); PG8_SCHED; PG8_LDA(At, 1, 0); PG8_STAGE(PG8_SA(0, 1), a2 + hstep, voffA);
            PG8_WAIT_L(8); PG8_BAR; PG8_WAIT_L(0); PG8_MMA(0, 0, At, B0); PG8_BAR; PG8_SCHED;
            PG8_LDB(B1, 1, 1); PG8_STAGE(PG8_SB(1, 0), b3, voffB);
            PG8_BAR; PG8_WAIT_L(0); PG8_MMA(0, 1, At, B1); PG8_BAR;
            PG8_LDA(At, 1, 1); PG8_STAGE(PG8_SA(1, 0), a3, voffA);
            PG8_BAR; PG8_WAIT_L(0); PG8_MMA(1, 0, At, B0); PG8_BAR; PG8_SCHED;
            PG8_STAGE(PG8_SB(1, 1), b3 + hstep, voffB);
            PG8_WAIT_V(6); PG8_BAR; PG8_MMA(1, 1, At, B1); PG8_BAR;
            }
        }
        if constexpr (ALIGN_EPI) { if (wr == 0) PG8_BAR; }
        if constexpr (!Epi::AFTER_DRAIN) { E(acc, cur, wr, wc, fr, fq); S.done(cur); }
        if (!has_next) break;
#pragma unroll
        for (int a = 0; a < 2; ++a)
#pragma unroll
            for (int b = 0; b < 2; ++b)
#pragma unroll
                for (int m = 0; m < 4; ++m)
#pragma unroll
                    for (int n = 0; n < 2; ++n) acc[a][b][m][n] = (f32x4){0.f, 0.f, 0.f, 0.f};
        cur = nxt; cA = nA; cB = nB; ++ui;
        if constexpr (ALIGN_EPI) { if (wr == 1) PG8_BAR; }
    }
    PG8_WAIT_V(0);
    if constexpr (!ALIGN_EPI) { if (wr == 0) PG8_BAR; }
    PG8_BAR;
    if constexpr (Epi::AFTER_DRAIN) { E.fused(acc, cur, wr, wc, fr, fq, lds, wid, lane); S.done(cur); }
#undef PG8_SA
#undef PG8_SB
#undef PG8_STAGE
#undef PG8_LDA
#undef PG8_LDB
#undef PG8_MMA
#undef PG8_WAIT_V
#undef PG8_WAIT_L
#undef PG8_BAR
#undef PG8_SCHED
}
}


#ifndef PG8_SP2
#define PG8_SP2 true
#endif
#ifndef PG8_ALIGN
#define PG8_ALIGN true
#endif
constexpr int NWAVES = 8;
constexpr int MP = pg8::MP, MS = pg8::MS, MVALID = pg8::MVALID, MT = pg8::MT, DM = 1024, DFF = 2816;
constexpr int SEQ = 4096, NB = 4, NSB = 32, PAST = 8192, NPOOL = 2560;
constexpr int ZC0 = 3328, ZC1 = 2304;
constexpr int Z1_Q = 0, Z1_K = 768, Z1_V = 1024, Z1_IQ = 1280, Z1_IK = 1792, Z1_IW = 1856, Z1_MQ = 1920;
constexpr int NMEMROWS = 1024, MEMROW0 = MT;
constexpr float EPS = 1e-6f;
constexpr size_t MiB = 1u << 20;
constexpr size_t WS_CTL = 0, CTL_ZERO_BYTES = 2 * MiB;
constexpr size_t WS_WIN0 = 2 * MiB, WS_WIN1 = 11 * MiB, WS_WOUT = 16 * MiB, WS_WGU = 20 * MiB, WS_WD = 42 * MiB;
constexpr size_t WS_XB = 54 * MiB, WS_MEMKV = 89 * MiB, WS_MIX = 94 * MiB, WS_Z = 128 * MiB, WS_U = 234 * MiB, WS_UP = 324 * MiB, WS_ACT = 414 * MiB;
constexpr size_t WS_QB = 504 * MiB, WS_KB = 528 * MiB, WS_VB = 536 * MiB, WS_IQB = 544 * MiB, WS_IKB = 560 * MiB, WS_IW = 562 * MiB;
constexpr size_t WS_SQ = 563 * MiB, WS_SIQ = WS_SQ + 512 * 1024, WS_SIW = WS_SIQ + 384 * 1024, WS_SSC = 564 * MiB, WS_SIDX = 569 * MiB, WS_MASK = 570 * MiB, WS_SC = 578 * MiB, WS_END = 834 * MiB;
constexpr int SSC_LD = 8256;
constexpr int CW_TMO = 0, CW_BAR = 4096, CW_Q = 8192, CW_SS = 16384;
constexpr size_t O_YP = 0, O_YS = O_YP + (size_t)MP * DM, O_HP = O_YS + (size_t)MS * DM, O_HS = O_HP + 4 * 6 * 16384, O_KP = O_HS + 32 * 6 * 16384,
    O_VP = O_KP + (size_t)MP * 256, O_IKP = O_VP + (size_t)MP * 256, O_KS = O_IKP + (size_t)MP * 64, O_VS = O_KS + MS * 256, O_IKS = O_VS + MS * 256,
    O_MK = O_IKS + MS * 64, O_MV = O_MK + 2 * 1024 * 256, O_CVP = O_MV + 2 * 1024 * 256, O_CVS = O_CVP + 2 * 4 * 2 * DFF, O_END = O_CVS + 2 * 32 * 2 * DFF;
static_assert(O_END == 31412224, "output size");
constexpr int RING_OFF = 0, RING_BYTES = 131072;
constexpr int LDSCTL_OFF = RING_BYTES, MISC_OFF = LDSCTL_OFF + 320;
constexpr int LDS_BYTES = 147456;

#define GAS __attribute__((address_space(1)))
#define LAS __attribute__((address_space(3)))
typedef unsigned short bf16;
typedef unsigned v4u __attribute__((ext_vector_type(4)));
typedef float f32x4 __attribute__((ext_vector_type(4)));
typedef short bf16x8 __attribute__((ext_vector_type(8)));
typedef GAS unsigned gu32;
typedef GAS unsigned long long gu64;
#define RLX_AGENT __ATOMIC_RELAXED, __HIP_MEMORY_SCOPE_AGENT
#define LDS_WAIT() asm volatile("s_waitcnt lgkmcnt(0)" ::: "memory")
#define VM_WAIT() asm volatile("s_waitcnt vmcnt(0)" ::: "memory")
__device__ __forceinline__ unsigned long long rt() { return __builtin_amdgcn_s_memrealtime(); }
__device__ __forceinline__ unsigned f2bf(float f) { unsigned u = __builtin_bit_cast(unsigned, f); return (u + 0x7fffu + ((u >> 16) & 1u)) >> 16; }
__device__ __forceinline__ unsigned pk2(float lo, float hi) { return f2bf(lo) | (f2bf(hi) << 16); }

#define XB_TMO      128
#define XB_XCNT(j)  (256  + 64 * (j))
#define XB_XSUB(j)  (1280 + 64 * (j))
#define XB_XGEN(j)  (2304 + 64 * (j))
#define XB_TOP      3328
#define XB_TOPGEN   3392
#define XCD_BAR_WORDS 3456
#define XB_SPIN_CAP (1u << 18)

__device__ __forceinline__ unsigned xb_ld(unsigned* p)              { return __hip_atomic_load(p, __ATOMIC_RELAXED, __HIP_MEMORY_SCOPE_AGENT); }
__device__ __forceinline__ unsigned xb_add(unsigned* p, unsigned v) { return __hip_atomic_fetch_add(p, v, __ATOMIC_RELAXED, __HIP_MEMORY_SCOPE_AGENT); }
__device__ __forceinline__ unsigned xb_xcc_id() { return (unsigned)__builtin_amdgcn_s_getreg((3 << 11) | 20) & 0xFu; }
#define XB_SPIN(cond, bar) do { unsigned _sp = 0; while (cond) { __builtin_amdgcn_s_sleep(1); \
    if ((++_sp & 255u) == 0u) { if (xb_ld(&(bar)[XB_TMO])) break; if (_sp > XB_SPIN_CAP) { atomicAdd(&(bar)[XB_TMO], 1u); break; } } } } while (0)

struct XcdBarrier {
    unsigned* bar; unsigned x;
    volatile LAS unsigned* st;
};

__device__ __forceinline__ XcdBarrier xcd_barrier_post(unsigned* bar, volatile LAS unsigned* st) {
    XcdBarrier b; b.bar = bar; b.x = xb_xcc_id(); b.st = st;
    if (threadIdx.x == 0) (void)xb_add(&bar[XB_XCNT(b.x)], 1u);
    return b;
}
__device__ __forceinline__ void xcd_barrier_complete(unsigned* bar, unsigned x, unsigned& nloc, unsigned& nx) {
    const unsigned G = gridDim.x * gridDim.y * gridDim.z;
    unsigned sum, cnt, mine, sp = 0u;
    for (;;) {
        sum = 0u; cnt = 0u; mine = 0u;
#pragma unroll
        for (unsigned j = 0; j < 16; ++j) { const unsigned c = xb_ld(&bar[XB_XCNT(j)]); sum += c; cnt += (c > 0u) ? 1u : 0u; mine = (j == x) ? c : mine; }
        if (sum == G) break;
        __builtin_amdgcn_s_sleep(1);
        if ((++sp & 255u) == 0u) { if (xb_ld(&bar[XB_TMO])) break; if (sp > XB_SPIN_CAP) { atomicAdd(&bar[XB_TMO], 1u); break; } }
    }
    nloc = mine > 0u ? mine : 1u; nx = cnt > 0u ? cnt : 1u;
}

__device__ __forceinline__ void xcd_barrier(const XcdBarrier& b) {
    asm volatile("s_waitcnt vmcnt(0)" ::: "memory");
    __syncthreads();
    if (threadIdx.x == 0) {
        unsigned* bar = b.bar;
        __builtin_amdgcn_s_waitcnt(0);
        unsigned nloc = b.st[0], nx = b.st[1];
        if (nloc == 0u) { xcd_barrier_complete(bar, b.x, nloc, nx); b.st[0] = nloc; b.st[1] = nx; }
        const unsigned old = xb_add(&bar[XB_XSUB(b.x)], 1u);
        const unsigned gen = old / nloc;
        if (old + 1u == (gen + 1u) * nloc) {
            __builtin_amdgcn_fence(__ATOMIC_RELEASE, "agent");
            asm volatile("s_waitcnt vmcnt(0)" ::: "memory");
            const unsigned og = xb_add(&bar[XB_TOP], 1u);
            const unsigned tg = og / nx;
            if (og + 1u == (tg + 1u) * nx) xb_add(&bar[XB_TOPGEN], 1u);
            else XB_SPIN(xb_ld(&bar[XB_TOPGEN]) == tg, bar);
            __builtin_amdgcn_fence(__ATOMIC_ACQUIRE, "agent");
            xb_add(&bar[XB_XGEN(b.x)], 1u);
            asm volatile("s_waitcnt vmcnt(0)" ::: "memory");
        } else {
            XB_SPIN(xb_ld(&bar[XB_XGEN(b.x)]) == gen, bar);
            __builtin_amdgcn_fence(__ATOMIC_ACQUIRE, "agent");
            asm volatile("s_waitcnt vmcnt(0)" ::: "memory");
        }
    }
    __syncthreads();
}


struct Args { const float* in[29]; const int* page_table; float* out; unsigned char* ws; int ph_lo, ph_hi; };
typedef const __attribute__((address_space(4))) Args& ARGREF;
struct Ctx { LAS unsigned char* lds; volatile LAS unsigned* MISC; gu32* ctl; int tid, lane, wave, vcu, G, qoff; };
typedef float f32x16 __attribute__((ext_vector_type(16)));
typedef unsigned long long u64;

__device__ __forceinline__ float bf2f(unsigned b) { return __builtin_bit_cast(float, b << 16); }
__device__ __forceinline__ float wave_sum(float v) {
#pragma unroll
    for (int o = 1; o < 64; o <<= 1) v += __shfl_xor(v, o);
    return v;
}
__device__ __forceinline__ int crow(int r, int hi) { return (r & 3) + 8 * (r >> 2) + 4 * hi; }
__device__ __forceinline__ float sigmoidf_(float x) { return 1.0f / (1.0f + __expf(-x)); }
__device__ __forceinline__ float* ssptr(const Ctx& c, int i) { return (float*)(c.ctl + CW_SS) + (size_t)i * MT; }

__device__ __forceinline__ int q_next(Ctx& c, int qi) {
    __syncthreads();
    if (c.tid == 0) c.MISC[16] = atomicAdd((unsigned*)(c.ctl + CW_Q + 64 * (qi + c.qoff)), 1u);
    __syncthreads();
    return (int)c.MISC[16];
}

template <int K>
__device__ __forceinline__ f32x16 mm32(const LAS bf16* A, int lda, const LAS bf16* Bt, int ldb, f32x16 acc, int lane) {
    const int r = lane & 31, h = lane >> 5;
#pragma unroll
    for (int ks = 0; ks < K; ks += 16) {
        const bf16x8 a = *(const LAS bf16x8*)(A + r * lda + ks + 8 * h);
        const bf16x8 b = *(const LAS bf16x8*)(Bt + r * ldb + ks + 8 * h);
        acc = __builtin_amdgcn_mfma_f32_32x32x16_bf16(a, b, acc, 0, 0, 0);
    }
    return acc;
}

__device__ __forceinline__ int map_row(int mapid, int n, int row_off) {
    if (mapid == 0) return n + row_off;
    if (mapid == 1) return n < 1864 ? n : n + 56;
    if (mapid == 2) return (n >> 7) * 256 + (n & 127);
    return (n >> 7) * 256 + 128 + (n & 127);
}
__device__ __forceinline__ void transpose_item(const float* W, int K, int N, const float* kscale, bf16* WT, int mapid, int row_off, LAS float* scr, int item, int lane) {
    const int nblk = (N + 31) / 32, kb = item / nblk, nb = item % nblk, k0 = 64 * kb, n0 = 32 * nb;
    { const int n4 = (lane & 7) * 4, nn = n0 + n4 < N ? n0 + n4 : N - 4; f32x4 v[8];
#pragma unroll
      for (int i = 0; i < 8; ++i) v[i] = *(const f32x4*)(W + (size_t)(k0 + 8 * i + (lane >> 3)) * N + nn);
#pragma unroll
      for (int i = 0; i < 8; ++i) { const int kk = 8 * i + (lane >> 3); const float sc = kscale ? kscale[k0 + kk] : 1.0f; LAS float* d = scr + kk * 33 + n4;
          d[0] = v[i].x * sc; d[1] = v[i].y * sc; d[2] = v[i].z * sc; d[3] = v[i].w * sc; } }
    LDS_WAIT(); asm volatile("" ::: "memory");
    const int cc = lane & 7;
#pragma unroll
    for (int j = 0; j < 4; ++j) { const int nl = (lane >> 3) + 8 * j, n = n0 + nl; const LAS float* s = scr + (8 * cc) * 33 + nl;
        v4u o; o.x = pk2(s[0 * 33], s[1 * 33]); o.y = pk2(s[2 * 33], s[3 * 33]); o.z = pk2(s[4 * 33], s[5 * 33]); o.w = pk2(s[6 * 33], s[7 * 33]);
        if (n < N) *(GAS v4u*)(WT + (size_t)map_row(mapid, n, row_off) * K + k0 + 8 * cc) = o; }
    LDS_WAIT(); asm volatile("" ::: "memory");
}
constexpr int I_INH = 16 * 104, I_MKV = 16 * 16, I_DSA = 16 * 67, I_OUT = 16 * 32, I_G = 16 * 88, I_D = 44 * 32;
constexpr int W_N0 = I_INH + 2 * I_MKV + I_OUT + 2 * I_G + I_D, W_NITEMS = W_N0 + I_DSA + I_OUT + 2 * I_G + I_D;
__device__ __forceinline__ void convert_item(ARGREF a, int it, LAS float* scr, int lane) {
    unsigned char* ws = a.ws; int r = it;
    if (r < I_INH) { transpose_item(a.in[13], 1024, 3328, a.in[11], (bf16*)(ws + WS_WIN0), 0, 0, scr, r, lane); return; } r -= I_INH;
    if (r < 2 * I_MKV) { const int l = r / I_MKV; transpose_item(a.in[20] + (size_t)l * 1024 * 512, 1024, 512, nullptr, (bf16*)(ws + WS_WIN0), 0, 3328 + 512 * l, scr, r % I_MKV, lane); return; } r -= 2 * I_MKV;
    int l = 0;
    if (r >= I_OUT + 2 * I_G + I_D) { r -= I_OUT + 2 * I_G + I_D; l = 1;
        if (r < I_DSA) { transpose_item(a.in[16], 1024, 2120, a.in[11] + 1024, (bf16*)(ws + WS_WIN1), 1, 0, scr, r, lane); return; } r -= I_DSA; }
    if (r < I_OUT) { transpose_item(a.in[23] + (size_t)l * 1024 * 1024, 1024, 1024, nullptr, (bf16*)(ws + WS_WOUT) + (size_t)l * 1024 * 1024, 0, 0, scr, r, lane); return; } r -= I_OUT;
    if (r < I_G) { transpose_item(a.in[24] + (size_t)l * 1024 * DFF, 1024, DFF, a.in[12] + l * 1024, (bf16*)(ws + WS_WGU) + (size_t)l * 5632 * 1024, 2, 0, scr, r, lane); return; } r -= I_G;
    if (r < I_G) { transpose_item(a.in[25] + (size_t)l * 1024 * DFF, 1024, DFF, a.in[12] + l * 1024, (bf16*)(ws + WS_WGU) + (size_t)l * 5632 * 1024, 3, 0, scr, r, lane); return; } r -= I_G;
    transpose_item(a.in[28] + (size_t)l * DFF * 1024, DFF, 1024, nullptr, (bf16*)(ws + WS_WD) + (size_t)l * 1024 * DFF, 0, 0, scr, r, lane);
}
__device__ __forceinline__ void convert_layer1_tail(Ctx& c, ARGREF a, int first_idle) {
    LAS float* scr = (LAS float*)(c.lds + RING_OFF + c.wave * 16384);
    const int bx = (int)blockIdx.x; if (bx < first_idle) return;
    const int nw = (c.G - first_idle) * NWAVES;
    for (int it = W_N0 + (bx - first_idle) * NWAVES + c.wave; it < W_NITEMS; it += nw) convert_item(a, it, scr, c.lane);
}
__device__ __forceinline__ void p0_prologue(Ctx& c, ARGREF a) {
    LAS float* scr = (LAS float*)(c.lds + RING_OFF + c.wave * 16384);
    const int gw = c.vcu * NWAVES + c.wave, NGW = c.G * NWAVES, lane = c.lane;
    unsigned char* ws = a.ws;
    for (int it = gw; it < W_N0; it += NGW) convert_item(a, it, scr, lane);
    for (int rr = gw; rr < 184; rr += NGW) { const int row = rr < 56 ? 1864 + rr : 2176 + (rr - 56);
        GAS v4u* p = (GAS v4u*)((bf16*)(ws + WS_WIN1) + (size_t)row * 1024); p[lane] = (v4u){0u, 0u, 0u, 0u}; p[64 + lane] = (v4u){0u, 0u, 0u, 0u}; }
    float* ss0 = ssptr(c, 0);
    for (int m = gw; m < MT + NMEMROWS; m += NGW) {
        GAS u64* o8 = (GAS u64*)((bf16*)(ws + WS_XB) + (size_t)m * DM) + lane;
        if (m >= MVALID && m < MT) {
#pragma unroll
            for (int j = 0; j < 4; ++j) o8[64 * j] = 0ull;
            continue; }
        const float* src = m < MP ? a.in[0] + (size_t)m * DM : (m < MVALID ? a.in[1] + (size_t)(m - MP) * DM : a.in[10] + (size_t)(m - MT) * DM);
        const GAS f32x4* xr = (const GAS f32x4*)src + lane; f32x4 v[4]; float s = 0.f;
#pragma unroll
        for (int j = 0; j < 4; ++j) { v[j] = xr[64 * j]; s += (v[j].x * v[j].x + v[j].y * v[j].y) + (v[j].z * v[j].z + v[j].w * v[j].w); }
        s = wave_sum(s);
#pragma unroll
        for (int j = 0; j < 4; ++j) o8[64 * j] = (u64)pk2(v[j].x, v[j].y) | ((u64)pk2(v[j].z, v[j].w) << 32);
        if (m < MVALID && lane == 0) ss0[m] = s;
    }
}

__device__ __forceinline__ void memattn_unit(Ctx& c, const bf16* Zq  , int ldz, int nrows_valid, const float* Kp, const float* Vp, int kstride,
                                             bool normk, const float* kgain, const float* qgain, bf16* Out  ) {
    LAS bf16* KN = (LAS bf16*)(c.lds);
    LAS bf16* VTm = (LAS bf16*)(c.lds + 36864);
    LAS bf16* QN = (LAS bf16*)(c.lds + 70656) + c.wave * (32 * 72);
    LAS float* LI = (LAS float*)(c.lds + 107520) + c.wave * 32;
    int tid = c.tid; asm volatile("" : "+v"(tid));
    const int lane = tid & 63, w = c.wave;
    {
        const int m = tid >> 1, dh = (tid & 1) * 32;
        f32x4 kv[8]; float s = 0.f;
#pragma unroll
        for (int j = 0; j < 8; ++j) { kv[j] = *(const f32x4*)(Kp + (size_t)m * kstride + dh + 4 * j); s += (kv[j].x * kv[j].x + kv[j].y * kv[j].y) + (kv[j].z * kv[j].z + kv[j].w * kv[j].w); }
        s += __shfl_xor(s, 1);
        const float rs = normk ? rsqrtf(s * (1.0f / 64.0f) + EPS) : 1.0f;
#pragma unroll
        for (int j = 0; j < 8; j += 2) { f32x4 g0 = {1.f, 1.f, 1.f, 1.f}, g1 = g0;
            if (normk) { g0 = *(const f32x4*)(kgain + dh + 4 * j); g1 = *(const f32x4*)(kgain + dh + 4 * j + 4); }
            const f32x4 x0 = kv[j] * rs * g0, x1 = kv[j + 1] * rs * g1;
            v4u o; o.x = pk2(x0.x, x0.y); o.y = pk2(x0.z, x0.w); o.z = pk2(x1.x, x1.y); o.w = pk2(x1.z, x1.w);
            *(LAS v4u*)(KN + m * 72 + dh + 4 * j) = o; }
#pragma unroll
        for (int j = 0; j < 8; ++j) { const f32x4 vv = *(const f32x4*)(Vp + (size_t)m * kstride + dh + 4 * j);
            VTm[(dh + 4 * j + 0) * 264 + m] = (bf16)f2bf(vv.x); VTm[(dh + 4 * j + 1) * 264 + m] = (bf16)f2bf(vv.y);
            VTm[(dh + 4 * j + 2) * 264 + m] = (bf16)f2bf(vv.z); VTm[(dh + 4 * j + 3) * 264 + m] = (bf16)f2bf(vv.w); }
    }
    {
        const int row = lane >> 1, hf = lane & 1, grow = w * 32 + row;
        float x[32]; float s = 0.f;
        if (grow < nrows_valid) {
#pragma unroll
            for (int j = 0; j < 4; ++j) { const v4u q = *(const v4u*)(Zq + (size_t)grow * ldz + hf * 32 + 8 * j);
                x[8 * j + 0] = bf2f(q.x & 0xffffu); x[8 * j + 1] = bf2f(q.x >> 16); x[8 * j + 2] = bf2f(q.y & 0xffffu); x[8 * j + 3] = bf2f(q.y >> 16);
                x[8 * j + 4] = bf2f(q.z & 0xffffu); x[8 * j + 5] = bf2f(q.z >> 16); x[8 * j + 6] = bf2f(q.w & 0xffffu); x[8 * j + 7] = bf2f(q.w >> 16); }
        } else {
#pragma unroll
            for (int j = 0; j < 32; ++j) x[j] = 0.f;
        }
#pragma unroll
        for (int j = 0; j < 32; ++j) s += x[j] * x[j];
        s += __shfl_xor(s, 1);
        const float rs = rsqrtf(s * (1.0f / 64.0f) + EPS) * 0.125f;
#pragma unroll
        for (int j = 0; j < 32; j += 8) { v4u o;
            o.x = pk2(x[j] * rs * qgain[hf * 32 + j], x[j + 1] * rs * qgain[hf * 32 + j + 1]); o.y = pk2(x[j + 2] * rs * qgain[hf * 32 + j + 2], x[j + 3] * rs * qgain[hf * 32 + j + 3]);
            o.z = pk2(x[j + 4] * rs * qgain[hf * 32 + j + 4], x[j + 5] * rs * qgain[hf * 32 + j + 5]); o.w = pk2(x[j + 6] * rs * qgain[hf * 32 + j + 6], x[j + 7] * rs * qgain[hf * 32 + j + 7]);
            *(LAS v4u*)(QN + row * 72 + hf * 32 + j) = o; }
    }
    __syncthreads();
    if (w * 32 < nrows_valid) {
        const int r32 = lane & 31, hh = lane >> 5;
        f32x16 s[8];
#pragma unroll
        for (int mt = 0; mt < 8; ++mt) { f32x16 z = {}; s[mt] = mm32<64>(KN + mt * 32 * 72, 72, QN, 72, z, lane); }
        float mx = -1e30f;
#pragma unroll
        for (int mt = 0; mt < 8; ++mt)
#pragma unroll
            for (int r = 0; r < 16; ++r) mx = fmaxf(mx, s[mt][r]);
        mx = fmaxf(mx, __shfl_xor(mx, 32));
        float l = 0.f;
#pragma unroll
        for (int mt = 0; mt < 8; ++mt)
#pragma unroll
            for (int r = 0; r < 16; ++r) { const float p = __expf(s[mt][r] - mx); s[mt][r] = p; l += p; }
        l += __shfl_xor(l, 32);
        if (hh == 0) LI[r32] = l;
        f32x16 o[2] = {};
#pragma unroll
        for (int mt = 0; mt < 8; ++mt)
#pragma unroll
            for (int sx = 0; sx < 2; ++sx) {
                v4u pa; pa.x = pk2(s[mt][8 * sx + 0], s[mt][8 * sx + 1]); pa.y = pk2(s[mt][8 * sx + 2], s[mt][8 * sx + 3]);
                pa.z = pk2(s[mt][8 * sx + 4], s[mt][8 * sx + 5]); pa.w = pk2(s[mt][8 * sx + 6], s[mt][8 * sx + 7]);
                const bf16x8 af = __builtin_bit_cast(bf16x8, pa);
#pragma unroll
                for (int dt = 0; dt < 2; ++dt) { const LAS bf16* vp = VTm + (dt * 32 + r32) * 264 + mt * 32 + 16 * sx + 4 * hh;
                    const u64 lo = *(const LAS u64*)vp, hi = *(const LAS u64*)(vp + 8);
                    v4u bw; bw.x = (unsigned)lo; bw.y = (unsigned)(lo >> 32); bw.z = (unsigned)hi; bw.w = (unsigned)(hi >> 32);
                    o[dt] = __builtin_amdgcn_mfma_f32_32x32x16_bf16(af, __builtin_bit_cast(bf16x8, bw), o[dt], 0, 0, 0); }
            }
        LDS_WAIT();
#pragma unroll
        for (int r = 0; r < 16; ++r) { const int qr = crow(r, hh), grow = w * 32 + qr; const float il = 1.0f / LI[qr];
            if (grow < nrows_valid) {
#pragma unroll
                for (int dt = 0; dt < 2; ++dt) Out[(size_t)grow * DM + dt * 32 + r32] = (bf16)f2bf(o[dt][r] * il); } }
    }
}

constexpr int HG_GS = 4, HG_NG = SEQ / (32 * HG_GS);
constexpr size_t WS_HOL = WS_U, WS_HQC = WS_UP, WS_HUT = WS_ACT, WS_HST = WS_ACT + 64 * MiB, WS_HDG = WS_ACT + 50 * MiB;
template <bool PROMPT>
__device__ __forceinline__ void hgrn_unit(Ctx& c, ARGREF a, int b, int h, int g) {
    LAS unsigned char* L = c.lds;
    LAS float* LFt = (LAS float*)(L + 0);
    LAS float* OB = (LAS float*)(L + 0);
    LAS float* SEG = (LAS float*)(L + 16896);
    LAS float* DVv = (LAS float*)(L + 18944);
    LAS bf16* QD = (LAS bf16*)(L + 19456);
    LAS bf16* KD = (LAS bf16*)(L + 28160);
    LAS bf16* KET = (LAS bf16*)(L + 36864);
    LAS bf16* VT = (LAS bf16*)(L + 47104);
    LAS bf16* SCB = (LAS bf16*)(L + 57344);
    LAS bf16* STt = (LAS bf16*)(L + 59904);
    LAS float* BOFF = (LAS float*)(L + 94720);
    int tid = c.tid; asm volatile("" : "+v"(tid));
    const int lane = tid & 63, w = c.wave, r32 = lane & 31, hh = lane >> 5;
    const int te = tid & 31, k8 = (tid >> 5) * 8;
    const int tf = tid >> 4, v8 = (tid & 15) * 8;
    const bf16* Z = (const bf16*)(a.ws + WS_Z);
    bf16* MIX = (bf16*)(a.ws + WS_MIX);
    const int nch = PROMPT ? HG_GS : 1, nvalid = PROMPT ? 32 : 4;
    const int kt = w >> 1, vt0 = 2 * (w & 1);
    const int unit = (b * 6 + h) * HG_NG + g;
    f32x16 S0 = {}, S1 = {};
    if (!PROMPT) { const float* sp = a.in[7] + (size_t)(b * 6 + h) * 16384;
#pragma unroll
        for (int r = 0; r < 16; ++r) { const int k = 32 * kt + crow(r, hh); S0[r] = sp[k * 128 + 32 * vt0 + r32]; S1[r] = sp[k * 128 + 32 * (vt0 + 1) + r32]; } }
    float lbv[8];
#pragma unroll
    for (int j = 0; j < 8; ++j) { const float l0 = a.in[14][h * 128 + k8 + j], l1 = a.in[14][768 + h * 128 + k8 + j]; lbv[j] = 1.0f / (1.0f + __expf(l1 - l0)); }
    __syncthreads();
    if (tid < 128) BOFF[tid] = 0.f;
#define HG_WRITE_ST() do { _Pragma("unroll") for (int g4 = 0; g4 < 4; ++g4) { const int k0 = 32 * kt + 8 * g4 + 4 * hh; \
        *(LAS u64*)(STt + (32 * vt0 + r32) * 136 + k0) = (u64)pk2(S0[4 * g4], S0[4 * g4 + 1]) | ((u64)pk2(S0[4 * g4 + 2], S0[4 * g4 + 3]) << 32); \
        *(LAS u64*)(STt + (32 * (vt0 + 1) + r32) * 136 + k0) = (u64)pk2(S1[4 * g4], S1[4 * g4 + 1]) | ((u64)pk2(S1[4 * g4 + 2], S1[4 * g4 + 3]) << 32); } } while (0)
    HG_WRITE_ST();
    v4u zq = {0u, 0u, 0u, 0u}, zf = zq, zi = zq;
    { const int row = (PROMPT ? b * SEQ + (g * HG_GS) * 32 : MP + 4 * b) + te;
      if (te < nvalid) { const bf16* zr = Z + (size_t)row * ZC0 + h * 128 + k8; zq = *(const v4u*)zr; zf = *(const v4u*)(zr + 768); zi = *(const v4u*)(zr + 1536); } }
#pragma unroll 1
    for (int ch = 0; ch < nch; ++ch) {
        const int row0 = PROMPT ? b * SEQ + (g * HG_GS + ch) * 32 : MP + 4 * b, row = row0 + te;
        const bool valid = te < nvalid;
        float qs[8], kk[8];
        {
            const unsigned qw[4] = {zq.x, zq.y, zq.z, zq.w}, fw[4] = {zf.x, zf.y, zf.z, zf.w}, iw[4] = {zi.x, zi.y, zi.z, zi.w};
#pragma unroll
            for (int j = 0; j < 8; ++j) { const float q = bf2f((qw[j >> 1] >> (16 * (j & 1))) & 0xffffu), fp = bf2f((fw[j >> 1] >> (16 * (j & 1))) & 0xffffu);
                const float sg = sigmoidf_(fp), f = lbv[j] + (1.0f - lbv[j]) * sg;
                qs[j] = valid ? q * sigmoidf_(q) : 0.f; kk[j] = valid ? (1.0f - f) : 0.f;
                LFt[(k8 + j) * 33 + te] = valid ? __logf(f) : 0.f;
                VT[(k8 + j) * 40 + te] = (bf16)((iw[j >> 1] >> (16 * (j & 1))) & 0xffffu); }
            if (PROMPT && ch + 1 < nch) { const bf16* zr = Z + (size_t)(row + 32) * ZC0 + h * 128 + k8; zq = *(const v4u*)zr; zf = *(const v4u*)(zr + 768); zi = *(const v4u*)(zr + 1536); }
        }
        __syncthreads();
        {
            const int k = tid & 127, sg_ = tid >> 7; float bsum = 0.f;
#pragma unroll
            for (int i = 0; i < 8; ++i) { bsum += LFt[k * 33 + 8 * sg_ + i]; LFt[k * 33 + 8 * sg_ + i] = bsum; }
            SEG[sg_ * 128 + k] = bsum; }
        __syncthreads();
        {
            float bb[8], bl[8];
            { f32x4 t0[4], t1[4];
#pragma unroll
              for (int s_ = 0; s_ < 4; ++s_) { t0[s_] = *(const LAS f32x4*)(SEG + s_ * 128 + k8); t1[s_] = *(const LAS f32x4*)(SEG + s_ * 128 + k8 + 4); }
              const int sgt = te >> 3; f32x4 o0 = {0.f, 0.f, 0.f, 0.f}, o1 = o0;
#pragma unroll
              for (int s_ = 0; s_ < 3; ++s_) if (s_ < sgt) { o0 += t0[s_]; o1 += t1[s_]; }
              const f32x4 l0 = (t0[0] + t0[1]) + (t0[2] + t0[3]), l1 = (t1[0] + t1[1]) + (t1[2] + t1[3]);
              const float of[8] = {o0.x, o0.y, o0.z, o0.w, o1.x, o1.y, o1.z, o1.w}; const float lt[8] = {l0.x, l0.y, l0.z, l0.w, l1.x, l1.y, l1.z, l1.w};
#pragma unroll
              for (int j = 0; j < 8; ++j) { bb[j] = LFt[(k8 + j) * 33 + te] + of[j]; bl[j] = lt[j]; } }
            float qd[8], kd[8];
#pragma unroll
            for (int j = 0; j < 8; ++j) { qd[j] = qs[j] * __expf(bb[j]); kd[j] = kk[j] * __expf(-bb[j]); KET[(k8 + j) * 40 + te] = (bf16)f2bf(kk[j] * __expf(bl[j] - bb[j])); }
            v4u o; o.x = pk2(qd[0], qd[1]); o.y = pk2(qd[2], qd[3]); o.z = pk2(qd[4], qd[5]); o.w = pk2(qd[6], qd[7]); *(LAS v4u*)(QD + te * 136 + k8) = o;
            if (PROMPT) { const f32x4 f0 = *(const LAS f32x4*)(BOFF + k8), f1 = *(const LAS f32x4*)(BOFF + k8 + 4);
                const float bo[8] = {f0.x, f0.y, f0.z, f0.w, f1.x, f1.y, f1.z, f1.w}; float qc[8];
#pragma unroll
                for (int j = 0; j < 8; ++j) qc[j] = qd[j] * __expf(bo[j]);
                v4u oc; oc.x = pk2(qc[0], qc[1]); oc.y = pk2(qc[2], qc[3]); oc.z = pk2(qc[4], qc[5]); oc.w = pk2(qc[6], qc[7]);
                *(v4u*)((bf16*)(a.ws + WS_HQC) + (size_t)row * 768 + h * 128 + k8) = oc; }
            o.x = pk2(kd[0], kd[1]); o.y = pk2(kd[2], kd[3]); o.z = pk2(kd[4], kd[5]); o.w = pk2(kd[6], kd[7]); *(LAS v4u*)(KD + te * 136 + k8) = o;
            if (te == 0) {
#pragma unroll
                for (int j = 0; j < 8; ++j) DVv[k8 + j] = __expf(bl[j]); }
        }
        __syncthreads();
        f32x16 oacc = {};
        if (w == 4) { f32x16 z = {}; const f32x16 sc = mm32<128>(QD, 136, KD, 136, z, lane);
#pragma unroll
            for (int r = 0; r < 16; ++r) { const int t = crow(r, hh); SCB[t * 40 + r32] = (bf16)f2bf(r32 <= t ? sc[r] : 0.f); } }
        if (w < 4) oacc = mm32<128>(QD, 136, STt + (w * 32) * 136, 136, oacc, lane);
        if (PROMPT && tid >= 384) { const int k = tid - 384; BOFF[k] += (SEG[k] + SEG[128 + k]) + (SEG[256 + k] + SEG[384 + k]); }
        __syncthreads();
        if (w < 4) { oacc = mm32<32>(SCB, 40, VT + (w * 32) * 40, 40, oacc, lane);
#pragma unroll
            for (int r = 0; r < 16; ++r) OB[crow(r, hh) * 128 + w * 32 + r32] = oacc[r]; }
        {
#pragma unroll
            for (int r = 0; r < 16; ++r) { const float d = DVv[32 * kt + crow(r, hh)]; S0[r] *= d; S1[r] *= d; }
            S0 = mm32<32>(KET + (kt * 32) * 40, 40, VT + (vt0 * 32) * 40, 40, S0, lane);
            S1 = mm32<32>(KET + (kt * 32) * 40, 40, VT + ((vt0 + 1) * 32) * 40, 40, S1, lane);
        }
        __syncthreads();
        HG_WRITE_ST();
        {
            const int orow = row0 + tf;
            const f32x4 o0 = *(const LAS f32x4*)(OB + tf * 128 + v8), o1 = *(const LAS f32x4*)(OB + tf * 128 + v8 + 4);
            if (PROMPT) { float* ol = (float*)(a.ws + WS_HOL) + (size_t)orow * 768 + h * 128 + v8; *(f32x4*)ol = o0; *(f32x4*)(ol + 4) = o1; }
            else {
                float ov[8] = {o0.x, o0.y, o0.z, o0.w, o1.x, o1.y, o1.z, o1.w}; float s = 0.f;
#pragma unroll
                for (int j = 0; j < 8; ++j) s += ov[j] * ov[j];
                s += __shfl_xor(s, 1); s += __shfl_xor(s, 2); s += __shfl_xor(s, 4); s += __shfl_xor(s, 8);
                const float rs = rsqrtf(s * (1.0f / 128.0f) + EPS);
                if (tf < nvalid) { const v4u gz = *(const v4u*)(Z + (size_t)orow * ZC0 + 2304 + h * 128 + v8); const unsigned gw_[4] = {gz.x, gz.y, gz.z, gz.w}; float y[8];
#pragma unroll
                    for (int j = 0; j < 8; ++j) { const float gg = bf2f((gw_[j >> 1] >> (16 * (j & 1))) & 0xffffu); y[j] = ov[j] * rs * a.in[15][v8 + j] * (gg * sigmoidf_(gg)); }
                    v4u o; o.x = pk2(y[0], y[1]); o.y = pk2(y[2], y[3]); o.z = pk2(y[4], y[5]); o.w = pk2(y[6], y[7]); *(v4u*)(MIX + (size_t)orow * DM + h * 128 + v8) = o; }
            }
        }
        __syncthreads();
    }
#undef HG_WRITE_ST
    if (PROMPT) {
        float* ut = (float*)(a.ws + WS_HUT) + (size_t)unit * 16384;
#pragma unroll
        for (int g4 = 0; g4 < 4; ++g4) { const int k0 = 32 * kt + 8 * g4 + 4 * hh;
            *(f32x4*)(ut + (32 * vt0 + r32) * 128 + k0) = (f32x4){S0[4 * g4], S0[4 * g4 + 1], S0[4 * g4 + 2], S0[4 * g4 + 3]};
            *(f32x4*)(ut + (32 * (vt0 + 1) + r32) * 128 + k0) = (f32x4){S1[4 * g4], S1[4 * g4 + 1], S1[4 * g4 + 2], S1[4 * g4 + 3]}; }
        if (tid < 128) ((float*)(a.ws + WS_HDG))[(size_t)unit * 128 + tid] = __expf(BOFF[tid]);
    } else {
        float* so = a.out + O_HS + (size_t)(b * 6 + h) * 16384;
#pragma unroll
        for (int r = 0; r < 16; ++r) { const int k = 32 * kt + crow(r, hh); so[k * 128 + 32 * vt0 + r32] = S0[r]; so[k * 128 + 32 * (vt0 + 1) + r32] = S1[r]; }
    }
}
__device__ __forceinline__ void hgrn_scan(Ctx& c, ARGREF a) {
    const float* UT = (const float*)(a.ws + WS_HUT); const float* DG = (const float*)(a.ws + WS_HDG); bf16* STo = (bf16*)(a.ws + WS_HST);
    for (int idx = c.vcu * 512 + c.tid; idx < 24 * 16384; idx += c.G * 512) {
        const int bh = idx >> 14, e = idx & 16383, k = e & 127, v = e >> 7;
        float s = 0.f;
#pragma unroll 8
        for (int g = 0; g < HG_NG; ++g) { const size_t u = (size_t)(bh * HG_NG + g); STo[u * 16384 + e] = (bf16)f2bf(s); s = DG[u * 128 + k] * s + UT[u * 16384 + e]; }
        a.out[O_HP + (size_t)bh * 16384 + k * 128 + v] = s;
    }
}
__device__ __forceinline__ void hgrn_fix_unit(Ctx& c, ARGREF a, int b, int h, int g) {
    LAS bf16* STt = (LAS bf16*)(c.lds);
    LAS bf16* QCl = (LAS bf16*)(c.lds + 34816);
    LAS float* OB = (LAS float*)(c.lds + 34816 + 17408);
    int tid = c.tid; asm volatile("" : "+v"(tid));
    const int lane = tid & 63, w = c.wave, r32 = lane & 31, hh = lane >> 5;
    const int unit = (b * 6 + h) * HG_NG + g, row0 = b * SEQ + g * 128;
    const bf16* Z = (const bf16*)(a.ws + WS_Z); bf16* MIX = (bf16*)(a.ws + WS_MIX);
    const bf16* QC = (const bf16*)(a.ws + WS_HQC); const float* OL = (const float*)(a.ws + WS_HOL);
    const bf16* stg = (const bf16*)(a.ws + WS_HST) + (size_t)unit * 16384;
    __syncthreads();
#pragma unroll
    for (int i = 0; i < 4; ++i) { const int cidx = tid + 512 * i, v = cidx >> 4, kc = (cidx & 15) * 8; *(LAS v4u*)(STt + v * 136 + kc) = *(const v4u*)(stg + v * 128 + kc); }
    const int te = tid >> 4, k8 = (tid & 15) * 8;
    float onv[8];
#pragma unroll
    for (int j = 0; j < 8; ++j) onv[j] = a.in[15][k8 + j];
#pragma unroll 1
    for (int hf = 0; hf < 2; ++hf) {
        const int rb = row0 + hf * 64;
#pragma unroll
        for (int i = 0; i < 2; ++i) { const int cidx = tid + 512 * i, r = cidx >> 4, kc = (cidx & 15) * 8; *(LAS v4u*)(QCl + r * 136 + kc) = *(const v4u*)(QC + (size_t)(rb + r) * 768 + h * 128 + kc); }
        __syncthreads();
        { const int rt = w >> 2, vt = w & 3; f32x16 o = {};
          o = mm32<128>(QCl + (rt * 32) * 136, 136, STt + (vt * 32) * 136, 136, o, lane);
#pragma unroll
          for (int r = 0; r < 16; ++r) OB[(rt * 32 + crow(r, hh)) * 128 + vt * 32 + r32] = o[r]; }
        __syncthreads();
#pragma unroll
        for (int ps = 0; ps < 2; ++ps) { const int r = ps * 32 + te, row = rb + r;
            const f32x4 c0 = *(const LAS f32x4*)(OB + r * 128 + k8), c1 = *(const LAS f32x4*)(OB + r * 128 + k8 + 4);
            const float* ol = OL + (size_t)row * 768 + h * 128 + k8; const f32x4 l0 = *(const f32x4*)ol, l1 = *(const f32x4*)(ol + 4);
            const v4u gz = *(const v4u*)(Z + (size_t)row * ZC0 + 2304 + h * 128 + k8);
            float ov[8] = {c0.x + l0.x, c0.y + l0.y, c0.z + l0.z, c0.w + l0.w, c1.x + l1.x, c1.y + l1.y, c1.z + l1.z, c1.w + l1.w}; float s = 0.f;
#pragma unroll
            for (int j = 0; j < 8; ++j) s += ov[j] * ov[j];
            s += __shfl_xor(s, 1); s += __shfl_xor(s, 2); s += __shfl_xor(s, 4); s += __shfl_xor(s, 8);
            const float rs = rsqrtf(s * (1.0f / 128.0f) + EPS);
            const unsigned gw_[4] = {gz.x, gz.y, gz.z, gz.w}; float y[8];
#pragma unroll
            for (int j = 0; j < 8; ++j) { const float gg = bf2f((gw_[j >> 1] >> (16 * (j & 1))) & 0xffffu); y[j] = ov[j] * rs * onv[j] * (gg * sigmoidf_(gg)); }
            v4u o; o.x = pk2(y[0], y[1]); o.y = pk2(y[2], y[3]); o.z = pk2(y[4], y[5]); o.w = pk2(y[6], y[7]); *(v4u*)(MIX + (size_t)row * DM + h * 128 + k8) = o; }
        __syncthreads();
    }
}

__device__ __forceinline__ void memkv_finalize_row(ARGREF a, int layer, int row, int lane) {
    const float* src = (const float*)(a.ws + WS_MEMKV) + (size_t)row * 1024 + layer * 512;
    const int hd = lane >> 4, d4 = (lane & 15) * 4;
    const f32x4 k = *(const f32x4*)(src + hd * 64 + d4), v = *(const f32x4*)(src + 256 + hd * 64 + d4);
    float s = (k.x * k.x + k.y * k.y) + (k.z * k.z + k.w * k.w);
    s += __shfl_xor(s, 1); s += __shfl_xor(s, 2); s += __shfl_xor(s, 4); s += __shfl_xor(s, 8);
    const float rs = rsqrtf(s * (1.0f / 64.0f) + EPS); const f32x4 g = *(const f32x4*)(a.in[22] + layer * 64 + d4);
    *(f32x4*)(a.out + O_MK + ((size_t)layer * 1024 + row) * 256 + hd * 64 + d4) = k * rs * g;
    *(f32x4*)(a.out + O_MV + ((size_t)layer * 1024 + row) * 256 + hd * 64 + d4) = v;
}

__device__ __forceinline__ void memattn_prompt_unit(Ctx& c, ARGREF a, int layer, int u) {
    const int blk = u & 15, hd = (u >> 4) & 3, b = u >> 6;
    const bf16* Z = (const bf16*)(a.ws + WS_Z); const int ldz = layer ? ZC1 : ZC0, qc = layer ? Z1_MQ : 3072;
    const float* kv = (const float*)(a.ws + WS_MEMKV) + (size_t)(b * 256) * 1024 + layer * 512 + hd * 64;
    const int row0 = b * SEQ + blk * 256;
    memattn_unit(c, Z + (size_t)row0 * ldz + qc + hd * 64, ldz, 256, kv, kv + 256, 1024, true, a.in[22] + layer * 64, a.in[21] + layer * 64,
                 (bf16*)(a.ws + WS_MIX) + (size_t)row0 * DM + 768 + hd * 64);
}
__device__ __forceinline__ void memattn_sample_unit(Ctx& c, ARGREF a, int layer, int u) {
    const int hd = u & 3, sb = u >> 2;
    const bf16* Z = (const bf16*)(a.ws + WS_Z); const int ldz = layer ? ZC1 : ZC0, qc = layer ? Z1_MQ : 3072;
    const size_t off = ((size_t)(layer * 32 + sb) * 256) * 256 + hd * 64;
    const int row0 = MP + sb * 4;
    memattn_unit(c, Z + (size_t)row0 * ldz + qc + hd * 64, ldz, 4, a.in[5] + off, a.in[6] + off, 256, false, nullptr, a.in[21] + layer * 64,
                 (bf16*)(a.ws + WS_MIX) + (size_t)row0 * DM + 768 + hd * 64);
}

__device__ __forceinline__ void p2_mixer0(Ctx& c, ARGREF a) {
    constexpr int U_HP = 24 * HG_NG, U_MAP = U_HP + 256, U_HS = U_MAP + 192, U_MAS = U_HS + 128, U_FIN = U_MAS + 256;
    for (;;) {
        const int u = q_next(c, 0);
        if (u >= U_FIN) break;
        if (u < U_HP) hgrn_unit<true>(c, a, u / (6 * HG_NG), (u / HG_NG) % 6, u % HG_NG);
        else if (u < U_MAP) memattn_prompt_unit(c, a, 0, u - U_HP);
        else if (u < U_HS) { const int v = u - U_MAP; hgrn_unit<false>(c, a, v / 6, v % 6, 0); }
        else if (u < U_MAS) memattn_sample_unit(c, a, 0, u - U_HS);
        else { const int v = (u - U_MAS) * 8 + c.wave; memkv_finalize_row(a, v >> 10, v & 1023, c.lane); }
    }
}
__device__ __forceinline__ void p2c_hgrn_fix(Ctx& c, ARGREF a) {
    for (int u = c.vcu; u < 24 * HG_NG; u += c.G) hgrn_fix_unit(c, a, u / (6 * HG_NG), (u / HG_NG) % 6, u % HG_NG);
}

constexpr size_t WS_G4 = WS_UP + 64 * MiB, WS_UP2 = WS_UP + 80 * MiB;
__device__ __forceinline__ void conv_fixup_tile(Ctx& c, ARGREF a, int layer, int pm) {
    const float* G4 = (const float*)(a.ws + WS_G4); const float* UP2 = (const float*)(a.ws + WS_UP2); bf16* ACT = (bf16*)(a.ws + WS_ACT);
    const float* cw = a.in[26] + (size_t)layer * 3 * DFF; const float* cb = a.in[27] + (size_t)layer * DFF;
    for (int idx = c.tid; idx < 8 * (DFF / 4); idx += 512) {
        const int rr = idx / (DFF / 4), c4 = (idx - rr * (DFF / 4)) * 4;
        const int slab = 4 * pm + (rr >> 1), fr = rr & 1, row = slab * 64 + fr, t = row & 4095, sl1 = slab > 0 ? slab - 1 : 0;
        const f32x4 ut = *(const f32x4*)(G4 + (size_t)(slab * 4 + fr) * DFF + c4), up = *(const f32x4*)(UP2 + (size_t)(slab * 2 + fr) * DFF + c4);
        const f32x4 a0 = *(const f32x4*)(G4 + (size_t)(slab * 4 + 0) * DFF + c4), b3 = *(const f32x4*)(G4 + (size_t)(sl1 * 4 + 3) * DFF + c4), b2 = *(const f32x4*)(G4 + (size_t)(sl1 * 4 + 2) * DFF + c4);
        f32x4 u1, u2;
        { const bool f1 = fr == 1, t0 = t == 0, t1 = t == 1;
          u1.x = f1 ? a0.x : (t0 ? 0.f : b3.x); u1.y = f1 ? a0.y : (t0 ? 0.f : b3.y); u1.z = f1 ? a0.z : (t0 ? 0.f : b3.z); u1.w = f1 ? a0.w : (t0 ? 0.f : b3.w);
          u2.x = f1 ? (t1 ? 0.f : b3.x) : (t0 ? 0.f : b2.x); u2.y = f1 ? (t1 ? 0.f : b3.y) : (t0 ? 0.f : b2.y); u2.z = f1 ? (t1 ? 0.f : b3.z) : (t0 ? 0.f : b2.z); u2.w = f1 ? (t1 ? 0.f : b3.w) : (t0 ? 0.f : b2.w); }
        const f32x4 w0 = *(const f32x4*)(cw + c4), w1 = *(const f32x4*)(cw + DFF + c4), w2 = *(const f32x4*)(cw + 2 * DFF + c4), bb = *(const f32x4*)(cb + c4);
        const f32x4 cv = bb + w0 * u2 + w1 * u1 + w2 * ut;
        const float y0 = cv.x * sigmoidf_(cv.x) * up.x, y1 = cv.y * sigmoidf_(cv.y) * up.y, y2 = cv.z * sigmoidf_(cv.z) * up.z, y3 = cv.w * sigmoidf_(cv.w) * up.w;
        *(u64*)(ACT + (size_t)row * DFF + c4) = (u64)pk2(y0, y1) | ((u64)pk2(y2, y3) << 32);
    }
}


struct SgArgs { const bf16* A; const bf16* Bt; int K; int mode; bf16* Z; int ldz; const float* ssin; const float* resid; const bf16* rb; float* y; bf16* xb; float* ssout; bf16* ACT; float* cvs; const float* cst; const float* cw; const float* cb; };
__device__ __forceinline__ void sgemm_unit(Ctx& c, const SgArgs& g, int n0) {
    int tid = c.tid; asm volatile("" : "+v"(tid));
    const int lane = tid & 63, w = c.wave, r32 = lane & 31, hh = lane >> 5;
    const int K = g.K, ks = K >> 3;
    const int f2 = (n0 >> 1) + (r32 & 15), brow = g.mode == 2 ? (f2 >> 7) * 256 + (f2 & 127) + (r32 >= 16 ? 128 : 0) : n0 + r32;
    const bf16* bp = g.Bt + (size_t)brow * K + w * ks + 8 * hh;
    const bf16* ap = g.A + (size_t)r32 * K + w * ks + 8 * hh;
    f32x16 acc[4] = {};
    bf16x8 afA[4][2], bfA[2], afB[4][2], bfB[2];
#define SG_LOAD(AF, BF, kk) do { _Pragma("unroll") for (int i = 0; i < 2; ++i) { BF[i] = *(const bf16x8*)(bp + (kk) + 16 * i); \
        _Pragma("unroll") for (int rt = 0; rt < 4; ++rt) AF[rt][i] = *(const bf16x8*)(ap + (size_t)(rt * 32) * K + (kk) + 16 * i); } } while (0)
#define SG_MMA(AF, BF) do { _Pragma("unroll") for (int i = 0; i < 2; ++i) _Pragma("unroll") for (int rt = 0; rt < 4; ++rt) acc[rt] = __builtin_amdgcn_mfma_f32_32x32x16_bf16(AF[rt][i], BF[i], acc[rt], 0, 0, 0); } while (0)
    SG_LOAD(afA, bfA, 0);
#pragma unroll 1
    for (int k = 0; k < ks; k += 64) {
        if (k + 32 < ks) SG_LOAD(afB, bfB, k + 32);
        SG_MMA(afA, bfA);
        if (k + 32 < ks) { if (k + 64 < ks) SG_LOAD(afA, bfA, k + 64); SG_MMA(afB, bfB); }
    }
#undef SG_LOAD
#undef SG_MMA
    LAS float* RED = (LAS float*)(c.lds);
    __syncthreads();
#pragma unroll
    for (int rt = 0; rt < 4; ++rt)
#pragma unroll
        for (int r = 0; r < 16; ++r) RED[((w * 4 + rt) * 16 + r) * 64 + lane] = acc[rt][r];
    __syncthreads();
    const int rt = w & 3, rh = w >> 2, col = n0 + r32;
    float v[8];
#pragma unroll
    for (int i = 0; i < 8; ++i) { float s = 0.f;
#pragma unroll
        for (int ww = 0; ww < 8; ++ww) s += RED[((ww * 4 + rt) * 16 + 8 * rh + i) * 64 + lane];
        v[i] = s; }
    if (g.mode == 0) {
#pragma unroll
        for (int i = 0; i < 8; ++i) { const int row = MP + rt * 32 + crow(8 * rh + i, hh); const float rs = rsqrtf(g.ssin[row] * (1.0f / DM) + EPS); g.Z[(size_t)row * g.ldz + col] = (bf16)f2bf(v[i] * rs); }
    } else if (g.mode == 1) {
#pragma unroll
        for (int i = 0; i < 8; ++i) { const int lr = rt * 32 + crow(8 * rh + i, hh), row = MP + lr;
            const float x = v[i] + (g.resid ? g.resid[(size_t)lr * DM + col] : bf2f(g.rb[(size_t)row * DM + col]));
            if (g.y) g.y[(size_t)lr * DM + col] = x; if (g.xb) g.xb[(size_t)row * DM + col] = (bf16)f2bf(x);
            float s = x * x; s += __shfl_xor(s, 1); s += __shfl_xor(s, 2); s += __shfl_xor(s, 4); s += __shfl_xor(s, 8); s += __shfl_xor(s, 16);
            if (g.ssout && r32 == 0) atomicAdd(g.ssout + row, s); }
    } else {
        float gu[8], upv[8];
#pragma unroll
        for (int i = 0; i < 8; ++i) { const int row = MP + rt * 32 + crow(8 * rh + i, hh); gu[i] = v[i] * rsqrtf(g.ssin[row] * (1.0f / DM) + EPS); upv[i] = __shfl_xor(gu[i], 16); }
        if (r32 < 16) { const float w0 = g.cw[f2], w1 = g.cw[DFF + f2], w2 = g.cw[2 * DFF + f2], bb = g.cb[f2];
#pragma unroll
            for (int aa = 0; aa < 2; ++aa) { const int lr0 = rt * 32 + 8 * (2 * rh + aa) + 4 * hh, sb = lr0 >> 2;
                const float s0 = g.cst[(size_t)(sb * 2) * DFF + f2], s1 = g.cst[(size_t)(sb * 2 + 1) * DFF + f2];
                const float u0 = gu[4 * aa], u1 = gu[4 * aa + 1], u2 = gu[4 * aa + 2], u3 = gu[4 * aa + 3];
                const float cv[4] = {bb + w0 * s0 + w1 * s1 + w2 * u0, bb + w0 * s1 + w1 * u0 + w2 * u1, bb + w0 * u0 + w1 * u1 + w2 * u2, bb + w0 * u1 + w1 * u2 + w2 * u3};
#pragma unroll
                for (int t = 0; t < 4; ++t) g.ACT[(size_t)(MP + lr0 + t) * DFF + f2] = (bf16)f2bf(cv[t] * sigmoidf_(cv[t]) * upv[4 * aa + t]);
                g.cvs[(size_t)(sb * 2) * DFF + f2] = u2; g.cvs[(size_t)(sb * 2 + 1) * DFF + f2] = u3; } }
    }
}
__device__ __forceinline__ void sgemm_phase(Ctx& c, const SgArgs& g, int N) {
#pragma unroll 1
    for (int u = c.G - 1 - (int)blockIdx.x; u < N / 32; u += c.G) sgemm_unit(c, g, u * 32);
}


__device__ __forceinline__ float wave_sum_f(float x) {
    x += __builtin_bit_cast(float, __builtin_amdgcn_update_dpp(0, __builtin_bit_cast(int, x), 0xB1, 0xF, 0xF, false));
    x += __builtin_bit_cast(float, __builtin_amdgcn_update_dpp(0, __builtin_bit_cast(int, x), 0x4E, 0xF, 0xF, false));
    x += __builtin_bit_cast(float, __builtin_amdgcn_update_dpp(0, __builtin_bit_cast(int, x), 0x141, 0xF, 0xF, false));
    x += __builtin_bit_cast(float, __builtin_amdgcn_update_dpp(0, __builtin_bit_cast(int, x), 0x140, 0xF, 0xF, false));
    const int xi = __builtin_bit_cast(int, x);
    return (__builtin_bit_cast(float, __builtin_amdgcn_readlane(xi, 0)) + __builtin_bit_cast(float, __builtin_amdgcn_readlane(xi, 16))) +
           (__builtin_bit_cast(float, __builtin_amdgcn_readlane(xi, 32)) + __builtin_bit_cast(float, __builtin_amdgcn_readlane(xi, 48)));
}
__device__ __forceinline__ void dsa_post_row(ARGREF a, int row, int lane_) {
    int lane = lane_; asm volatile("" : "+v"(lane));
    const bf16* z = (const bf16*)(a.ws + WS_Z) + (size_t)row * ZC1;
    const bool smp = row >= MP; const int b = smp ? (row - MP) >> 2 : row >> 12, t = smp ? (row - MP) & 3 : row & 4095;
    const float pos = (float)(smp ? PAST + t : t);
    const int i = lane & 31;
    float x1[8], x2[8], q1[4], q2[4], k1 = 0.f, k2 = 0.f;
#pragma unroll
    for (int hd = 0; hd < 8; ++hd) { x1[hd] = bf2f(z[hd * 128 + lane]); x2[hd] = bf2f(z[hd * 128 + 64 + lane]); }
    const u64 vv = *(const u64*)(z + Z1_V + 4 * lane);
#pragma unroll
    for (int p = 0; p < 4; ++p) { const int hd = 2 * p + (lane >> 5); q1[p] = bf2f(z[Z1_IQ + hd * 64 + i]); q2[p] = bf2f(z[Z1_IQ + hd * 64 + 32 + i]); }
    if (lane < 32) { k1 = bf2f(z[Z1_IK + i]); k2 = bf2f(z[Z1_IK + 32 + i]); }
    const float wraw = bf2f(z[Z1_IW + (lane & 7)]);
    float c128, s128, c64, s64;
    { const float r1 = pos * (exp2f(-(float)lane * (13.287712379549449f / 64.0f)) * 0.15915494309189535f), f1 = r1 - floorf(r1); s128 = __builtin_amdgcn_sinf(f1); c128 = __builtin_amdgcn_cosf(f1);
      const float r2 = pos * (exp2f(-(float)i * (13.287712379549449f / 32.0f)) * 0.15915494309189535f), f2 = r2 - floorf(r2); s64 = __builtin_amdgcn_sinf(f2); c64 = __builtin_amdgcn_cosf(f2); }
#pragma unroll
    for (int hd = 0; hd < 8; ++hd) {
        const float rs = rsqrtf(wave_sum_f(x1[hd] * x1[hd] + x2[hd] * x2[hd]) * (1.0f / 128.0f) + EPS);
        const float* gn = hd < 6 ? a.in[17] : a.in[18];
        const float y1 = x1[hd] * rs * gn[lane], y2 = x2[hd] * rs * gn[64 + lane];
        const float o1 = y1 * c128 - y2 * s128, o2 = y2 * c128 + y1 * s128;
        if (hd < 6) {
            if (smp) { float* q = (float*)(a.ws + WS_SQ) + (size_t)(row - MP) * 768 + hd * 128; q[lane] = o1; q[64 + lane] = o2; }
            else { bf16* q = (bf16*)(a.ws + WS_QB) + ((size_t)(b * 6 + hd) * SEQ + t) * 128; q[lane] = (bf16)f2bf(o1); q[64 + lane] = (bf16)f2bf(o2); }
        } else {
            const int kvh = hd - 6;
            float* ko = smp ? a.out + O_KS + (size_t)(row - MP) * 256 + kvh * 128 : a.out + O_KP + (size_t)row * 256 + kvh * 128;
            ko[lane] = o1; ko[64 + lane] = o2;
            if (!smp) { bf16* kb = (bf16*)(a.ws + WS_KB) + ((size_t)(b * 2 + kvh) * SEQ + t) * 128; kb[lane] = (bf16)f2bf(o1); kb[64 + lane] = (bf16)f2bf(o2); }
        }
    }
    {
        const f32x4 v = {bf2f((unsigned)vv & 0xffffu), bf2f(((unsigned)vv) >> 16), bf2f((unsigned)(vv >> 32) & 0xffffu), bf2f((unsigned)(vv >> 48))};
        float* vo = smp ? a.out + O_VS + (size_t)(row - MP) * 256 : a.out + O_VP + (size_t)row * 256;
        *(f32x4*)(vo + 4 * lane) = v;
        if (!smp) { const int kvh = lane >> 5, d = (lane & 31) * 4; *(u64*)((bf16*)(a.ws + WS_VB) + ((size_t)(b * 2 + kvh) * SEQ + t) * 128 + d) = vv; }
    }
    {
#pragma unroll
        for (int p = 0; p < 4; ++p) { const int hd = 2 * p + (lane >> 5);
            const float o1 = q1[p] * c64 - q2[p] * s64, o2 = q2[p] * c64 + q1[p] * s64;
            if (smp) { float* q = (float*)(a.ws + WS_SIQ) + (size_t)(row - MP) * 512 + hd * 64; q[i] = o1; q[32 + i] = o2; }
            else { bf16* q = (bf16*)(a.ws + WS_IQB) + (size_t)row * 512 + hd * 64; q[i] = (bf16)f2bf(o1); q[32 + i] = (bf16)f2bf(o2); } }
        const float rs = rsqrtf(wave_sum_f(k1 * k1 + k2 * k2) * (1.0f / 64.0f) + EPS);
        const float y1 = k1 * rs * a.in[19][i], y2 = k2 * rs * a.in[19][32 + i];
        const float o1 = y1 * c64 - y2 * s64, o2 = y2 * c64 + y1 * s64;
        if (lane < 32) {
            float* ko = smp ? a.out + O_IKS + (size_t)(row - MP) * 64 : a.out + O_IKP + (size_t)row * 64; ko[i] = o1; ko[32 + i] = o2;
            if (!smp) { bf16* kb = (bf16*)(a.ws + WS_IKB) + (size_t)row * 64; kb[i] = (bf16)f2bf(o1); kb[32 + i] = (bf16)f2bf(o2); } }
        if (lane < 8) { const float wv = wraw * (0.35355339059327373f * 0.125f);
            if (smp) ((float*)(a.ws + WS_SIW))[(row - MP) * 8 + lane] = wv; else ((float*)(a.ws + WS_IW))[(size_t)row * 8 + lane] = wv; }
    }
}
__device__ __forceinline__ void p8_dsa_post(Ctx& c, ARGREF a) {
    constexpr int NRB = (MVALID + 63) / 64;
    for (;;) { const int u = q_next(c, 1); if (u >= 384 + NRB) break;
        if (u < 256) memattn_prompt_unit(c, a, 1, u);
        else if (u < 256 + NRB) { const int r0 = (u - 256) * 64 + c.wave;
#pragma unroll 1
            for (int i = 0; i < 8; ++i) { const int row = r0 + 8 * i; if (row < MVALID) dsa_post_row(a, row, c.lane); } }
        else memattn_sample_unit(c, a, 1, u - 256 - NRB); }
}

__device__ __forceinline__ void idx_prompt_unit(Ctx& c, ARGREF a, int b, int qb) {
    int tid = c.tid; asm volatile("" : "+v"(tid));
    const int lane = tid & 63, r32 = lane & 31, hh = lane >> 5, w = c.wave;
    const int q0 = b * SEQ + qb * 32;
    LAS bf16* IQL = (LAS bf16*)(c.lds);
    { const bf16* src = (const bf16*)(a.ws + WS_IQB) + (size_t)q0 * 512;
#pragma unroll
      for (int i = 0; i < 4; ++i) { const int row = tid >> 4, ch = (tid & 15) + 16 * i; *(LAS v4u*)(IQL + row * 520 + ch * 8) = *(const v4u*)(src + (size_t)row * 512 + ch * 8); } }
    __syncthreads();
    const bf16* IK = (const bf16*)(a.ws + WS_IKB) + (size_t)(b * SEQ) * 64 + (size_t)r32 * 64 + 8 * hh;
    float* SC = (float*)(a.ws + WS_SC) + (size_t)(q0 + r32) * SEQ;
    float wv[8];
#pragma unroll
    for (int h = 0; h < 8; ++h) wv[h] = ((const float*)(a.ws + WS_IW))[(size_t)(q0 + r32) * 8 + h];
    bf16x8 ak[4], an[4];
    if (w <= qb) {
#pragma unroll
        for (int ks = 0; ks < 4; ++ks) ak[ks] = *(const bf16x8*)(IK + (size_t)(w * 32) * 64 + ks * 16); }
#pragma unroll 1
    for (int kt = w; kt <= qb; kt += 8) {
        if (kt + 8 <= qb) {
#pragma unroll
            for (int ks = 0; ks < 4; ++ks) an[ks] = *(const bf16x8*)(IK + (size_t)((kt + 8) * 32) * 64 + ks * 16); }
        f32x16 sc = {};
        int qoff = r32 * 520 + 8 * hh; asm volatile("" : "+v"(qoff));
#pragma unroll
        for (int h = 0; h < 8; ++h) { f32x16 d = {};
#pragma unroll
            for (int ks = 0; ks < 4; ++ks) d = __builtin_amdgcn_mfma_f32_32x32x16_bf16(ak[ks], *(const LAS bf16x8*)(IQL + qoff + h * 64 + ks * 16), d, 0, 0, 0);
#pragma unroll
            for (int r = 0; r < 16; ++r) sc[r] = fmaf(wv[h], fmaxf(d[r], 0.f), sc[r]); }
#pragma unroll
        for (int g = 0; g < 4; ++g) *(f32x4*)(SC + kt * 32 + 8 * g + 4 * hh) = (f32x4){sc[4 * g], sc[4 * g + 1], sc[4 * g + 2], sc[4 * g + 3]};
#pragma unroll
        for (int ks = 0; ks < 4; ++ks) ak[ks] = an[ks];
    }
}
__device__ __forceinline__ v4u pack8f(const float* p) { const f32x4 x = *(const f32x4*)p, y = *(const f32x4*)(p + 4); v4u o; o.x = pk2(x.x, x.y); o.y = pk2(x.z, x.w); o.z = pk2(y.x, y.y); o.w = pk2(y.z, y.w); return o; }
__device__ __forceinline__ void idx_sample_tile(ARGREF a, int sb, int tl, int lane_) {
    int lane = lane_; asm volatile("" : "+v"(lane));
    const int r32 = lane & 31, hh = lane >> 5, tk = r32 >> 3, hd = r32 & 7;
    const float* iq = (const float*)(a.ws + WS_SIQ) + (size_t)(sb * 4 + tk) * 512 + hd * 64 + 8 * hh;
    const float wv = ((const float*)(a.ws + WS_SIW))[(sb * 4 + tk) * 8 + hd];
    const float* src;
    if (tl < 256) src = a.in[4] + ((size_t)a.page_table[sb * 64 + (tl >> 2)] * 128 + (tl & 3) * 32 + r32) * 64 + 8 * hh;
    else src = a.out + O_IKS + (size_t)(sb * 4 + (r32 & 3)) * 64 + 8 * hh;
    v4u af[4], bf_[4];
#pragma unroll
    for (int ks = 0; ks < 4; ++ks) { af[ks] = pack8f(src + 16 * ks); bf_[ks] = pack8f(iq + 16 * ks); }
    if (tl == 256 && r32 >= 4) {
#pragma unroll
        for (int ks = 0; ks < 4; ++ks) af[ks] = (v4u){0u, 0u, 0u, 0u}; }
    f32x16 d = {};
#pragma unroll
    for (int ks = 0; ks < 4; ++ks) d = __builtin_amdgcn_mfma_f32_32x32x16_bf16(__builtin_bit_cast(bf16x8, af[ks]), __builtin_bit_cast(bf16x8, bf_[ks]), d, 0, 0, 0);
    float* dst = (float*)(a.ws + WS_SSC) + (size_t)(sb * 4 + tk) * SSC_LD + tl * 32;
#pragma unroll
    for (int r = 0; r < 16; ++r) { float v = wv * fmaxf(d[r], 0.f);
        v += __builtin_bit_cast(float, __builtin_amdgcn_update_dpp(0, __builtin_bit_cast(int, v), 0xB1, 0xF, 0xF, false));
        v += __builtin_bit_cast(float, __builtin_amdgcn_update_dpp(0, __builtin_bit_cast(int, v), 0x4E, 0xF, 0xF, false));
        v += __builtin_bit_cast(float, __builtin_amdgcn_update_dpp(0, __builtin_bit_cast(int, v), 0x141, 0xF, 0xF, false));
        if (hd == 0) dst[crow(r, hh)] = v; }
}
__device__ __forceinline__ void p9_indexer(Ctx& c, ARGREF a) {
    const int gw = c.vcu * NWAVES + c.wave, NGW = c.G * NWAVES;
#pragma unroll 1
    for (int wt = gw; wt < 32 * 257; wt += NGW) idx_sample_tile(a, wt / 257, wt % 257, c.lane);
    for (;;) { const int u = q_next(c, 2); if (u >= 512) break; idx_prompt_unit(c, a, u & 3, 127 - (u >> 2)); }
}


__device__ __forceinline__ unsigned fkey(float f) { const unsigned u = __builtin_bit_cast(unsigned, f + 0.0f); return (u & 0x80000000u) ? ~u : (u | 0x80000000u); }
__device__ __forceinline__ void acc_ge(int& cnt, unsigned key, unsigned cand) { asm volatile("v_cmp_le_u32_e32 vcc, %1, %2\n\tv_addc_co_u32_e32 %0, vcc, 0, %0, vcc" : "+v"(cnt) : "s"(cand), "v"(key) : "vcc"); }
__device__ __forceinline__ void acc_ge4(int& c0, int& c1, int& c2, int& c3, unsigned k0, unsigned k1, unsigned k2, unsigned k3, unsigned cand) {
    u64 m0, m1, m2, m3;
    asm volatile("v_cmp_le_u32_e64 %4, %8, %9\n\tv_cmp_le_u32_e64 %5, %8, %10\n\tv_cmp_le_u32_e64 %6, %8, %11\n\tv_cmp_le_u32_e64 %7, %8, %12\n\t"
                 "v_addc_co_u32_e64 %0, %4, 0, %0, %4\n\tv_addc_co_u32_e64 %1, %5, 0, %1, %5\n\tv_addc_co_u32_e64 %2, %6, 0, %2, %6\n\tv_addc_co_u32_e64 %3, %7, 0, %3, %7"
                 : "+v"(c0), "+v"(c1), "+v"(c2), "+v"(c3), "=&s"(m0), "=&s"(m1), "=&s"(m2), "=&s"(m3) : "s"(cand), "v"(k0), "v"(k1), "v"(k2), "v"(k3));
}
__device__ __forceinline__ u64 ballot_nz(unsigned v) { u64 m; asm volatile("v_cmp_ne_u32_e64 %0, 0, %1" : "=s"(m) : "v"(v)); return m; }
__device__ __forceinline__ int wave_sum_dpp(int x) {
    x += __builtin_amdgcn_update_dpp(0, x, 0xB1, 0xF, 0xF, false);
    x += __builtin_amdgcn_update_dpp(0, x, 0x4E, 0xF, 0xF, false);
    x += __builtin_amdgcn_update_dpp(0, x, 0x141, 0xF, 0xF, false);
    x += __builtin_amdgcn_update_dpp(0, x, 0x140, 0xF, 0xF, false);
    return (__builtin_amdgcn_readlane(x, 0) + __builtin_amdgcn_readlane(x, 16)) + (__builtin_amdgcn_readlane(x, 32) + __builtin_amdgcn_readlane(x, 48));
}
__device__ __forceinline__ int mbcnt64(u64 m) { return (int)__builtin_amdgcn_mbcnt_hi((unsigned)(m >> 32), __builtin_amdgcn_mbcnt_lo((unsigned)m, 0u)); }
constexpr int TK_LOWBITS = 18;
__device__ __forceinline__ void topk_finish(unsigned ck, int cp, int A, int posmax, unsigned& T, int& P) {
#pragma unroll 1
    for (int bit = TK_LOWBITS - 1; bit >= 0; --bit) { const unsigned cand = T | (1u << bit); if (A + __builtin_popcountll(__ballot(ck >= cand)) >= 256) T = cand; }
    const int need = 256 - (A + __builtin_popcountll(__ballot(ck > T))), ceq = __builtin_popcountll(__ballot(ck == T));
    P = posmax;
    if (ceq != need) { P = 0;
#pragma unroll 1
        for (int bit = 13; bit >= 0; --bit) { const int cand = P | (1 << bit); if (__builtin_popcountll(__ballot(ck == T && cp < cand)) < need) P = cand; } }
}
__device__ __forceinline__ unsigned wave_min_u(unsigned x) {
    x = min(x, (unsigned)__builtin_amdgcn_update_dpp(0, (int)x, 0xB1, 0xF, 0xF, false)); x = min(x, (unsigned)__builtin_amdgcn_update_dpp(0, (int)x, 0x4E, 0xF, 0xF, false));
    x = min(x, (unsigned)__builtin_amdgcn_update_dpp(0, (int)x, 0x141, 0xF, 0xF, false)); x = min(x, (unsigned)__builtin_amdgcn_update_dpp(0, (int)x, 0x140, 0xF, 0xF, false));
    return min(min((unsigned)__builtin_amdgcn_readlane((int)x, 0), (unsigned)__builtin_amdgcn_readlane((int)x, 16)), min((unsigned)__builtin_amdgcn_readlane((int)x, 32), (unsigned)__builtin_amdgcn_readlane((int)x, 48)));
}
__device__ __forceinline__ unsigned wave_max_u(unsigned x) {
    x = max(x, (unsigned)__builtin_amdgcn_update_dpp(0, (int)x, 0xB1, 0xF, 0xF, false)); x = max(x, (unsigned)__builtin_amdgcn_update_dpp(0, (int)x, 0x4E, 0xF, 0xF, false));
    x = max(x, (unsigned)__builtin_amdgcn_update_dpp(0, (int)x, 0x141, 0xF, 0xF, false)); x = max(x, (unsigned)__builtin_amdgcn_update_dpp(0, (int)x, 0x140, 0xF, 0xF, false));
    return max(max((unsigned)__builtin_amdgcn_readlane((int)x, 0), (unsigned)__builtin_amdgcn_readlane((int)x, 16)), max((unsigned)__builtin_amdgcn_readlane((int)x, 32), (unsigned)__builtin_amdgcn_readlane((int)x, 48)));
}
__device__ __forceinline__ void topk_prompt_rows(ARGREF a, int row0, int stride, int lane_, LAS unsigned* cl) {
    int lane = lane_; asm volatile("" : "+v"(lane));
    const float* SCb = (const float*)(a.ws + WS_SC);
#pragma unroll 1
    for (int row = row0; row < MP; row += stride) {
        const int t = row & 4095;
        u64* mk = (u64*)(a.ws + WS_MASK) + (size_t)row * 64;
        if (t < 256) { u64 myword = 0ull;
#pragma unroll 1
            for (int j = 0; j < 64; ++j) { const u64 m = __ballot(64 * j + lane <= t); if (lane == j) myword = m; }
            mk[lane] = myword;
            continue; }
        unsigned key[64];
        { const float* sc_ = SCb + (size_t)row * SEQ + lane; const int tj_ = t >> 6;
          float v[64];
#pragma unroll
          for (int j = 0; j < 64; ++j) v[j] = sc_[64 * (j < tj_ ? j : tj_)];
          int pj = lane;
#pragma unroll
          for (int j = 0; j < 64; ++j) { const int u = __builtin_bit_cast(int, v[j] + 0.0f); const unsigned k = (unsigned)u ^ ((unsigned)(u >> 31) | 0x80000000u); key[j] = (pj <= t) ? k : 0u; pj += 64; asm volatile("" : "+v"(pj)); } }
        unsigned kh[64];
#pragma unroll
        for (int j = 0; j < 64; ++j) { kh[j] = key[j] >> 1; asm volatile("" : "+v"(kh[j])); }
        unsigned T; int hb;
        {
            unsigned b0 = 0u, b1 = 0u, b2 = 0u, b3 = 0u;
#pragma unroll
            for (int j = 0; j < 64; ++j) { unsigned x = key[j]; const unsigned m0 = max(b0, x); x = min(b0, x); b0 = m0; const unsigned m1 = max(b1, x); x = min(b1, x); b1 = m1; const unsigned m2 = max(b2, x); x = min(b2, x); b2 = m2; b3 = max(b3, x); }
            const unsigned L = wave_min_u(b3), H = wave_max_u(b3), df = L ^ H;
            hb = df ? 31 - __builtin_clz(df) : -1;
            T = hb >= 31 ? 0u : (L & ~((2u << (hb < 0 ? 0 : hb)) - 1u)); if (hb < 0) T = L;
        }
#define TK_FULLCOUNT(CAND, OUT) do { const unsigned cs_ = __builtin_amdgcn_readfirstlane(CAND); int c0_ = 0, c1_ = 0, c2_ = 0, c3_ = 0; \
        _Pragma("unroll") for (int j = 0; j < 64; j += 4) acc_ge4(c0_, c1_, c2_, c3_, key[j], key[j + 1], key[j + 2], key[j + 3], cs_); OUT = wave_sum_dpp((c0_ + c1_) + (c2_ + c3_)); } while (0)
#define TK_FASTCOUNT(CAND, OUT) do { const unsigned ch_ = __builtin_amdgcn_readfirstlane((CAND) >> 1); unsigned a0_ = 0u, a1_ = 0u, a2_ = 0u, a3_ = 0u; \
        _Pragma("unroll") for (int j = 0; j < 64; j += 4) { a0_ = __builtin_amdgcn_alignbit(a0_, kh[j] - ch_, 31); a1_ = __builtin_amdgcn_alignbit(a1_, kh[j + 1] - ch_, 31); \
            a2_ = __builtin_amdgcn_alignbit(a2_, kh[j + 2] - ch_, 31); a3_ = __builtin_amdgcn_alignbit(a3_, kh[j + 3] - ch_, 31); } \
        OUT = 4096 - wave_sum_dpp((__builtin_popcount(a0_) + __builtin_popcount(a1_)) + (__builtin_popcount(a2_) + __builtin_popcount(a3_))); } while (0)
#pragma unroll 1
        for (int bit = hb; bit >= TK_LOWBITS; --bit) { const unsigned cand = T | (1u << bit); int tot; TK_FASTCOUNT(cand, tot); if (tot >= 256) T = cand; }
        const unsigned Tb = T & ~((1u << TK_LOWBITS) - 1u), hib = Tb + (1u << TK_LOWBITS);
        int A = 0, cT; if (hib != 0u) TK_FASTCOUNT(hib, A); TK_FASTCOUNT(Tb, cT);
#undef TK_FASTCOUNT
        int P;
        if (cT - A <= 64) {
            if (lane == 0) cl[128] = 0u;
            int pj = lane;
#pragma unroll
            for (int j = 0; j < 64; ++j) { if ((key[j] - Tb) < (1u << TK_LOWBITS)) { const unsigned pos = __hip_atomic_fetch_add(cl + 128, 1u, __ATOMIC_RELAXED, __HIP_MEMORY_SCOPE_WORKGROUP); if (pos < 64u) { cl[pos] = key[j]; cl[64 + pos] = (unsigned)pj; } }
                pj += 64; asm volatile("" : "+v"(pj)); }
            const int nund = cT - A;
            const unsigned ck = lane < nund ? cl[lane] : 0u; const int cp = (int)cl[64 + lane];
            topk_finish(ck, cp, A, 4095, T, P);
        } else {
#pragma unroll 1
            for (int bit = TK_LOWBITS - 1; bit >= 0; --bit) { const unsigned cand = T | (1u << bit); int tot; TK_FULLCOUNT(cand, tot); if (tot >= 256) T = cand; }
            int cge, cgt; TK_FULLCOUNT(T, cge); cgt = 0; if (T != 0xffffffffu) TK_FULLCOUNT(T + 1u, cgt);
            const int need = 256 - cgt, ceq = cge - cgt; P = 4095;
            if (ceq != need) { P = 0;
#pragma unroll 1
                for (int bit = 11; bit >= 0; --bit) { const int cand = P | (1 << bit); int cnt = 0; int pj = lane;
#pragma unroll
                    for (int j = 0; j < 64; ++j) { cnt += (key[j] == T && pj < cand) ? 1 : 0; pj += 64; asm volatile("" : "+v"(pj)); }
                    if (wave_sum_dpp(cnt) < need) P = cand; } }
        }
#undef TK_FULLCOUNT
        if (P != 4095) {
            int pq = lane;
#pragma unroll
            for (int j = 0; j < 64; ++j) { if (key[j] == T && pq > P) key[j] = 0u; pq += 64; asm volatile("" : "+v"(pq)); } }
        unsigned wlo = 0u, whi = 0u; const unsigned Ts = __builtin_amdgcn_readfirstlane(T);
#pragma unroll
        for (int j = 0; j < 64; ++j) asm volatile("v_cmp_le_u32_e32 vcc, %2, %3\n\ts_nop 3\n\tv_writelane_b32 %0, vcc_lo, %4\n\tv_writelane_b32 %1, vcc_hi, %4" : "+v"(wlo), "+v"(whi) : "s"(Ts), "v"(key[j]), "i"(j) : "vcc");
        mk[lane] = ((u64)whi << 32) | (u64)wlo;
    }
}
__device__ __forceinline__ void topk_sample_row(ARGREF a, int q, int lane_, LAS unsigned* K, LAS unsigned* cl) {
    int lane = lane_; asm volatile("" : "+v"(lane));
    const int t = q & 3, n = PAST + t + 1; const float* sc = (const float*)(a.ws + WS_SSC) + (size_t)q * SSC_LD;
    int* out = (int*)(a.ws + WS_SIDX) + q * 256;
    unsigned key[129];
#pragma unroll
    for (int j = 0; j < 129; ++j) { const float v = sc[64 * j + lane]; key[j] = (j < 128 || lane < n - 8192) ? fkey(v) : 0u; }
#pragma unroll
    for (int j = 0; j < 129; ++j) K[64 * j + lane] = key[j];
#define TK_FULLCOUNT(CAND, OUT) do { const unsigned cs_ = __builtin_amdgcn_readfirstlane(CAND); int c0_ = 0, c1_ = 0, c2_ = 0, c3_ = 0; \
        _Pragma("unroll") for (int j = 0; j < 128; j += 4) acc_ge4(c0_, c1_, c2_, c3_, key[j], key[j + 1], key[j + 2], key[j + 3], cs_); acc_ge(c0_, key[128], cs_); OUT = wave_sum_dpp((c0_ + c1_) + (c2_ + c3_)); } while (0)
    unsigned T = 0u;
#pragma unroll 1
    for (int bit = 31; bit >= TK_LOWBITS; --bit) { const unsigned cand = T | (1u << bit); int tot; TK_FULLCOUNT(cand, tot); if (tot >= 256) T = cand; }
    const unsigned hib = T + (1u << TK_LOWBITS);
    int A = 0, cT; if (hib != 0u) TK_FULLCOUNT(hib, A); TK_FULLCOUNT(T, cT);
    int P;
    if (cT - A <= 64) {
        int base = 0;
#pragma unroll 1
        for (int j0 = 0; j0 < 128; j0 += 8) { unsigned kk[8];
#pragma unroll
            for (int i = 0; i < 8; ++i) kk[i] = K[64 * (j0 + i) + lane];
#pragma unroll
            for (int i = 0; i < 8; ++i) { const unsigned und = (kk[i] - T) < (1u << TK_LOWBITS) ? 1u : 0u; const u64 m = ballot_nz(und); const int pos = base + mbcnt64(m);
                if (und) { cl[pos] = kk[i]; cl[64 + pos] = (unsigned)(64 * (j0 + i) + lane); }
                base += __builtin_popcountll(m); } }
        { const unsigned kj = K[64 * 128 + lane]; const unsigned und = (kj - T) < (1u << TK_LOWBITS) ? 1u : 0u; const u64 m = ballot_nz(und); const int pos = base + mbcnt64(m);
          if (und) { cl[pos] = kj; cl[64 + pos] = (unsigned)(64 * 128 + lane); } base += __builtin_popcountll(m); }
        const unsigned ck = lane < base ? cl[lane] : 0u; const int cp = (int)cl[64 + lane];
        topk_finish(ck, cp, A, 16383, T, P);
    } else {
#pragma unroll 1
        for (int bit = TK_LOWBITS - 1; bit >= 0; --bit) { const unsigned cand = T | (1u << bit); int tot; TK_FULLCOUNT(cand, tot); if (tot >= 256) T = cand; }
        int cge, cgt; TK_FULLCOUNT(T, cge); cgt = 0; if (T != 0xffffffffu) TK_FULLCOUNT(T + 1u, cgt);
        const int need = 256 - cgt, ceq = cge - cgt; P = 16383;
        if (ceq != need) { P = 0;
#pragma unroll 1
            for (int bit = 13; bit >= 0; --bit) { const int cand = P | (1 << bit); int cnt = 0;
#pragma unroll 4
                for (int j = 0; j < 129; ++j) cnt += (K[64 * j + lane] == T && 64 * j + lane < cand) ? 1 : 0;
                if (wave_sum_dpp(cnt) < need) P = cand; } }
    }
#undef TK_FULLCOUNT
    int base = 0;
#pragma unroll 1
    for (int j0 = 0; j0 < 136; j0 += 8) { unsigned kk[8];
#pragma unroll
        for (int i = 0; i < 8; ++i) kk[i] = (j0 + i < 129) ? K[64 * (j0 + i) + lane] : 0u;
#pragma unroll
        for (int i = 0; i < 8; ++i) { const int ps = 64 * (j0 + i) + lane; const unsigned selv = (kk[i] > T || (kk[i] == T && ps <= P)) ? 1u : 0u; const u64 m = ballot_nz(selv);
            const int pos = base + mbcnt64(m);
            if (selv && pos < 256) out[pos] = ps;
            base += __builtin_popcountll(m); } }
}
__device__ __forceinline__ void p10_topk(Ctx& c, ARGREF a) {
    const int gw = c.vcu * NWAVES + c.wave, NGW = c.G * NWAVES;
    LAS unsigned* cl = (LAS unsigned*)(c.lds) + c.wave * 192;
    if (c.wave == 0 && c.vcu < MS) topk_sample_row(a, c.vcu, c.lane, (LAS unsigned*)(c.lds + 8192), cl);
    topk_prompt_rows(a, gw, NGW, c.lane, cl);
}


__device__ __forceinline__ void attn_sample_unit(Ctx& c, ARGREF a, int sb, int t) {
    LAS bf16* KV = (LAS bf16*)(c.lds);
    LAS float* QL = (LAS float*)(c.lds + 69632);
    LAS float* SL = (LAS float*)(c.lds + 69632 + 3072);
    LAS float* OL = (LAS float*)(c.lds + 69632 + 6144);
    LAS int* IL = (LAS int*)(c.lds + 69632 + 12288);
    LAS unsigned* OFFL = (LAS unsigned*)(c.lds + 69632 + 12288 + 1024);
    int tid = c.tid; asm volatile("" : "+v"(tid));
    const int lane = tid & 63, w = c.wave, q = sb * 4 + t;
    __syncthreads();
    if (tid < 256) IL[tid] = ((const int*)(a.ws + WS_SIDX))[q * 256 + tid];
    for (int i = tid; i < 768; i += 512) QL[i] = ((const float*)(a.ws + WS_SQ))[(size_t)q * 768 + i];
    __syncthreads();
    if (tid < 256) { const int idx = IL[tid];
        OFFL[tid] = idx < PAST ? (unsigned)(((a.page_table[sb * 64 + (idx >> 7)] * 128 + (idx & 127)) * 2) * 128) : (0x80000000u | (unsigned)((sb * 4 + (idx - PAST)) * 256)); }
    __syncthreads();
    bf16* MIX = (bf16*)(a.ws + WS_MIX) + (size_t)(MP + q) * DM;
#pragma unroll 1
    for (int kvh = 0; kvh < 2; ++kvh) {
#pragma unroll 1
        for (int pass = 0; pass < 2; ++pass) {
            const float* pool = pass ? a.in[3] : a.in[2]; const float* nw = a.out + (pass ? O_VS : O_KS);
            { f32x4 gv[16];
#pragma unroll
              for (int r = 0; r < 16; ++r) { const int i = (tid >> 5) + 16 * r; const unsigned off = OFFL[i]; const float* src = (off & 0x80000000u) ? nw + (size_t)(off & 0x7fffffffu) : pool + (size_t)off;
                  gv[r] = *(const f32x4*)(src + kvh * 128 + (tid & 31) * 4); }
#pragma unroll
              for (int r = 0; r < 16; ++r) { const int i = (tid >> 5) + 16 * r; *(LAS u64*)(KV + i * 136 + (tid & 31) * 4) = (u64)pk2(gv[r].x, gv[r].y) | ((u64)pk2(gv[r].z, gv[r].w) << 32); } }
            __syncthreads();
            if (pass == 0) {
                const int i = tid >> 1, dh = (tid & 1) * 64; float s0 = 0.f, s1 = 0.f, s2 = 0.f;
#pragma unroll 8
                for (int d = 0; d < 64; ++d) { const float kx = bf2f(KV[i * 136 + dh + d]);
                    s0 = fmaf(QL[(3 * kvh + 0) * 128 + dh + d], kx, s0); s1 = fmaf(QL[(3 * kvh + 1) * 128 + dh + d], kx, s1); s2 = fmaf(QL[(3 * kvh + 2) * 128 + dh + d], kx, s2); }
                s0 += __shfl_xor(s0, 1); s1 += __shfl_xor(s1, 1); s2 += __shfl_xor(s2, 1);
                if ((tid & 1) == 0) { SL[i] = s0 * 0.08838834764831845f; SL[256 + i] = s1 * 0.08838834764831845f; SL[512 + i] = s2 * 0.08838834764831845f; }
                __syncthreads();
                if (w < 3) { float v[4], mx = -1e30f;
#pragma unroll
                    for (int j = 0; j < 4; ++j) { v[j] = SL[w * 256 + 64 * j + lane]; mx = fmaxf(mx, v[j]); }
#pragma unroll
                    for (int o = 1; o < 64; o <<= 1) mx = fmaxf(mx, __shfl_xor(mx, o));
                    float l = 0.f;
#pragma unroll
                    for (int j = 0; j < 4; ++j) { v[j] = __expf(v[j] - mx); l += v[j]; }
                    l = wave_sum(l); const float il = 1.0f / l;
#pragma unroll
                    for (int j = 0; j < 4; ++j) SL[w * 256 + 64 * j + lane] = v[j] * il; }
                __syncthreads();
            } else {
                const int d = tid & 127, part = tid >> 7; float o0 = 0.f, o1 = 0.f, o2 = 0.f;
#pragma unroll 8
                for (int i = part * 64; i < part * 64 + 64; ++i) { const float vx = bf2f(KV[i * 136 + d]); o0 = fmaf(SL[i], vx, o0); o1 = fmaf(SL[256 + i], vx, o1); o2 = fmaf(SL[512 + i], vx, o2); }
                OL[(part * 3 + 0) * 128 + d] = o0; OL[(part * 3 + 1) * 128 + d] = o1; OL[(part * 3 + 2) * 128 + d] = o2;
                __syncthreads();
                if (tid < 384) { const int hq = tid >> 7, dd = tid & 127; const float o = (OL[hq * 128 + dd] + OL[(3 + hq) * 128 + dd]) + (OL[(6 + hq) * 128 + dd] + OL[(9 + hq) * 128 + dd]);
                    MIX[(3 * kvh + hq) * 128 + dd] = (bf16)f2bf(o); }
                __syncthreads();
            }
        }
    }
}


namespace attn {
using bf16 = unsigned short;
typedef short bf16x8 __attribute__((ext_vector_type(8)));
typedef short s16x4 __attribute__((ext_vector_type(4)));
typedef float f32x16 __attribute__((ext_vector_type(16)));
typedef float f32x4 __attribute__((ext_vector_type(4)));
typedef unsigned u32x4 __attribute__((ext_vector_type(4)));
typedef unsigned u32x2 __attribute__((ext_vector_type(2)));
constexpr int D = 128, OS = 1024;
constexpr float THR = 8.f;
constexpr float SCALE = 0.08838834764831845f;
constexpr int NW = 8, QBLK = 32, KVBLK = 64, QB = NW * QBLK;
constexpr int SHM_V = KVBLK * D * 2, SHM_K = KVBLK * D * 2;
constexpr int LDS_BYTES = 2 * SHM_V + 2 * SHM_K + NW * 64 * 4;

#define KSWZ(row, colB) ((row) * 256 + ((colB) ^ (((row) & 7) << 4)))
#define SBAR() __builtin_amdgcn_sched_barrier(0)
__device__ __forceinline__ int v_st(int k, int c) { const int kk = (k & ~0xC) | ((k & 4) << 1) | ((k & 8) >> 1); return ((kk >> 3) * 4 + (c >> 5)) * 512 + ((kk & 7) * 32 + (c & 31)) * 2; }
__device__ __forceinline__ int v_rd_base(int lane) { return ((lane & 3) << 3) | (((lane >> 2) & 3) << 6) | (((lane >> 4) & 1) << 5) | (((lane >> 5) & 1) << 8); }
constexpr int v_rd_off(int d0, int ks, int half) { return d0 * 512 + ks * 4096 + half * 2048; }
__device__ __forceinline__ int crow(int r, int hi) { return (r & 3) + 8 * (r >> 2) + 4 * hi; }
__device__ __forceinline__ unsigned cvtpk(float lo, float hi) {
    unsigned r; asm volatile("v_cvt_pk_bf16_f32 %0, %1, %2" : "=v"(r) : "v"(lo), "v"(hi)); return r;
}
__device__ __forceinline__ bf16x8 pack8(f32x4 a, f32x4 b) {
    u32x4 w = {cvtpk(a[0], a[1]), cvtpk(a[2], a[3]), cvtpk(b[0], b[1]), cvtpk(b[2], b[3])};
    return *reinterpret_cast<bf16x8*>(&w);
}

__device__ __forceinline__ void partialSM(f32x16& p0, f32x16& p1, float& m_reg, float& mn, float& alpha) {
    float pmax = p0[0]; for (int r = 1; r < 16; ++r) pmax = fmaxf(pmax, p0[r]); for (int r = 0; r < 16; ++r) pmax = fmaxf(pmax, p1[r]);
    { auto rr = __builtin_amdgcn_permlane32_swap(__float_as_uint(pmax), __float_as_uint(pmax), false, false);
      pmax = fmaxf(__uint_as_float(rr[0]), __uint_as_float(rr[1])); }
    constexpr float C2 = 1.4426950408889634f * SCALE;
    if (__builtin_expect(__all((pmax - m_reg) * SCALE <= THR), 1)) { mn = m_reg; alpha = 1.f; }
    else { mn = fmaxf(m_reg, pmax); alpha = __builtin_amdgcn_exp2f((m_reg - mn) * C2); m_reg = mn; }
    const float mnL = -mn * C2;
    for (int r = 0; r < 16; ++r) p0[r] = fmaf(p0[r], C2, mnL); for (int r = 0; r < 16; ++r) p1[r] = fmaf(p1[r], C2, mnL);
    for (int r = 0; r < 16; ++r) p0[r] = __builtin_amdgcn_exp2f(p0[r]);
}
__device__ __forceinline__ void finishSM(f32x16& p0, f32x16& p1, float alpha, float& l_reg, bf16x8& pa0, bf16x8& pa1, bf16x8& pa2, bf16x8& pa3) {
    for (int r = 0; r < 16; ++r) p1[r] = __builtin_amdgcn_exp2f(p1[r]);
    float ps = 0; for (int r = 0; r < 16; ++r) ps += p0[r]; for (int r = 0; r < 16; ++r) ps += p1[r];
    { auto rr = __builtin_amdgcn_permlane32_swap(__float_as_uint(ps), __float_as_uint(ps), false, false);
      ps = __uint_as_float(rr[0]) + __uint_as_float(rr[1]); }
    l_reg = l_reg * alpha + ps;
#define PK4(P, B_, OUT) do { unsigned a0 = cvtpk(P[B_+0], P[B_+1]), a1 = cvtpk(P[B_+2], P[B_+3]);                          \
        unsigned b0 = cvtpk(P[B_+4], P[B_+5]), b1 = cvtpk(P[B_+6], P[B_+7]);                                             \
        auto r0 = __builtin_amdgcn_permlane32_swap(a0, b0, false, false); auto r1 = __builtin_amdgcn_permlane32_swap(a1, b1, false, false); \
        u32x4 w = {r0[0], r1[0], r0[1], r1[1]}; OUT = *reinterpret_cast<bf16x8*>(&w); } while (0)
    PK4(p0, 0, pa0); PK4(p0, 8, pa1); PK4(p1, 0, pa2); PK4(p1, 8, pa3);
#undef PK4
}
template <int KB, bool SK>
__device__ __forceinline__ void qkt(f32x16& p0, f32x16& p1, const char* K_lds, int r32, int hi, const bf16x8* qr, bool act) {
    if (SK && !act) { const float NEG = -__builtin_inff();
#pragma unroll
        for (int r = 0; r < 16; ++r) { p0[r] = NEG; p1[r] = NEG; } return; }
    p0 = f32x16{}; p1 = f32x16{};
    const char* kb[4];
#pragma unroll
    for (int dd = 0; dd < 4; ++dd) kb[dd] = K_lds + KB * SHM_K + KSWZ(r32, (dd * 16 + hi * 8) * 2);
#pragma unroll
    for (int d0 = 0; d0 < 8; ++d0) { const char* a = kb[d0 & 3] + (d0 >> 2) * 128;
        bf16x8 b0 = *reinterpret_cast<const bf16x8*>(a);
        bf16x8 b1 = *reinterpret_cast<const bf16x8*>(a + 32 * 256);
        p0 = __builtin_amdgcn_mfma_f32_32x32x16_bf16(b0, qr[d0], p0, 0, 0, 0);
        p1 = __builtin_amdgcn_mfma_f32_32x32x16_bf16(b1, qr[d0], p1, 0, 0, 0); }
}
template <int VB, bool SK>
__device__ __forceinline__ void pv_tile(f32x16* o, int vb0, bf16x8 pa0, bf16x8 pa1, bf16x8 pa2, bf16x8 pa3, bool act) {
    if (SK && !act) return;
#define TRRD(dst, off) asm volatile("ds_read_b64_tr_b16 %0, %1 offset:%2" : "=&v"(dst) : "v"(vb0), "i"(off) : "memory")
#define PV_D0(d0) do { s16x4 l0, l1, l2, l3, h0, h1, h2, h3; constexpr int b_ = VB * SHM_V + v_rd_off(d0, 0, 0);     \
        TRRD(l0, b_); TRRD(h0, b_ + 2048); TRRD(l1, b_ + 4096); TRRD(h1, b_ + 6144); TRRD(l2, b_ + 8192); TRRD(h2, b_ + 10240); TRRD(l3, b_ + 12288); TRRD(h3, b_ + 14336); \
        asm volatile("s_waitcnt lgkmcnt(0)" ::: "memory"); SBAR();                 \
        o[d0] = __builtin_amdgcn_mfma_f32_32x32x16_bf16(pa0, (bf16x8){l0[0], l0[1], l0[2], l0[3], h0[0], h0[1], h0[2], h0[3]}, o[d0], 0, 0, 0);   \
        o[d0] = __builtin_amdgcn_mfma_f32_32x32x16_bf16(pa1, (bf16x8){l1[0], l1[1], l1[2], l1[3], h1[0], h1[1], h1[2], h1[3]}, o[d0], 0, 0, 0);   \
        o[d0] = __builtin_amdgcn_mfma_f32_32x32x16_bf16(pa2, (bf16x8){l2[0], l2[1], l2[2], l2[3], h2[0], h2[1], h2[2], h2[3]}, o[d0], 0, 0, 0);   \
        o[d0] = __builtin_amdgcn_mfma_f32_32x32x16_bf16(pa3, (bf16x8){l3[0], l3[1], l3[2], l3[3], h3[0], h3[1], h3[2], h3[3]}, o[d0], 0, 0, 0); } while (0)
    PV_D0(0); PV_D0(1); PV_D0(2); PV_D0(3);
#undef PV_D0
#undef TRRD
}

__device__ __forceinline__ bf16x8 load8(const bf16* p) { return *reinterpret_cast<const bf16x8*>(p); }
__device__ __forceinline__ void mask_bits(f32x16& p0, f32x16& p1, u32x2 w, int hi) {
    const float NEG = -__builtin_inff();
    asm volatile("" : "+v"(w.x), "+v"(w.y));
    const unsigned lo = w.x >> (4 * hi), up = w.y >> (4 * hi);
#pragma unroll
    for (int r = 0; r < 16; ++r) { const int c = (r & 3) + 8 * (r >> 2);
        if (!((lo >> c) & 1u)) p0[r] = NEG;
        if (!((up >> c) & 1u)) p1[r] = NEG; }
}
struct BlockRef { const bf16* Q; const bf16* K; const bf16* V; bf16* O; const u32x2* M; int P0; };
struct Seam { bf16x8 qr[8]; bf16x8 st_v0, st_v1, st_k0, st_k1; };
#define ROW(p, k0, rr) ((p) + (size_t)((k0) + (rr)) * D + sc)
#define VMW() asm volatile("s_waitcnt vmcnt(0)" ::: "memory")
#define VMWN(n) asm volatile("s_waitcnt vmcnt(%0)" :: "i"(n) : "memory")
#define SLOAD_H(Kp, Vp, k0) do { S.st_v0 = load8(ROW(Vp, k0, sr)); S.st_v1 = load8(ROW(Vp, k0, 32 + sr));              \
                         S.st_k0 = load8(ROW(Kp, k0, sr)); S.st_k1 = load8(ROW(Kp, k0, 32 + sr)); } while (0)
#define SWRITE_HK(bf) do { *(bf16x8*)(K_lds + (bf) * SHM_K + kws) = S.st_k0; *(bf16x8*)(K_lds + (bf) * SHM_K + kws + 32 * 256) = S.st_k1; } while (0)
#define SWRITE_HV(bf) do { *(bf16x8*)(V_lds + (bf) * SHM_V + vst0) = S.st_v0; *(bf16x8*)(V_lds + (bf) * SHM_V + vst1) = S.st_v1; } while (0)
#define SWRITE_H(bf) do { SWRITE_HV(bf); SWRITE_HK(bf); } while (0)
__device__ __forceinline__ void sel_prime(const BlockRef& cur, char* lds, Seam& S) {
    int tid_ = threadIdx.x; asm volatile("" : "+v"(tid_));
    const int tid = tid_, wid = __builtin_amdgcn_readfirstlane(tid >> 6), lane = tid & 63, r32 = lane & 31, hi = lane >> 5;
    const int sr = tid >> 4, sc = (tid & 15) * 8, kws = KSWZ(sr, sc * 2); char* K_lds = lds + 2 * SHM_V;
    for (int d0 = 0; d0 < 8; ++d0) S.qr[d0] = load8(cur.Q + (size_t)(wid * QBLK + r32) * D + d0 * 16 + hi * 8);
    SLOAD_H(cur.K, cur.V, 0); VMW(); SWRITE_HK(0);
    __syncthreads();
}
__device__ __forceinline__ void sel_block(const BlockRef& cur, const BlockRef& nxt, char* lds, Seam& S) {
    int tid_ = threadIdx.x; asm volatile("" : "+v"(tid_));
    const int tid = tid_, wid = __builtin_amdgcn_readfirstlane(tid >> 6), lane = tid & 63, r32 = lane & 31, hi = lane >> 5;
    const int NT = (cur.P0 + QB) / KVBLK;
    char* V_lds = lds; char* K_lds = lds + 2 * SHM_V;
    float* ws = (float*)(lds + 2 * SHM_V + 2 * SHM_K) + wid * 64; float* li_l = ws, * al_l = ws + 32;
    float m_reg = -1e30f, l_reg = 0; f32x16 o[4] = {};
    const int sr = tid >> 4, sc = (tid & 15) * 8, vst0 = v_st(sr, sc), vst1 = v_st(32 + sr, sc), kws = KSWZ(sr, sc * 2);
    const int vb0 = (int)(uintptr_t)V_lds + v_rd_base(lane);
    const bf16* Kh = cur.K; const bf16* Vh = cur.V;
    const char* Mbase = (const char*)cur.M; const unsigned moff = (unsigned)(wid * QBLK + r32) * 512u;
#define MROW(t) (*(const u32x2*)(Mbase + (moff + (unsigned)(t) * 8u)))
#define RESC(a) do { if (__any((a) < 1.f)) { if (hi == 0) al_l[r32] = (a); asm volatile("s_waitcnt lgkmcnt(0)" ::: "memory");              \
                     for (int d_ = 0; d_ < 4; ++d_) for (int r = 0; r < 16; ++r) o[d_][r] *= al_l[crow(r, hi)]; } } while (0)
#define KBASE(t) ((t) * KVBLK)
    f32x16 pA0, pA1, pB0, pB1; float mnA, mnB, alA, alB; bf16x8 pa0, pa1, pa2, pa3; u32x2 mw;
    SWRITE_HV(0); SBAR();
    if (NT > 1) SLOAD_H(Kh, Vh, KBASE(1));
    mw = MROW(0);
    SBAR(); qkt<0, false>(pA0, pA1, K_lds, r32, hi, S.qr, true);
    mask_bits(pA0, pA1, mw, hi); partialSM(pA0, pA1, m_reg, mnA, alA);
    if (NT > 1) { VMW(); SWRITE_H(1); }
    __syncthreads();
#define HALF_STEP(PX0, PX1, mnX, alX, PY0, PY1, alY, t, KB, VB, SB) do {                                                      \
        SBAR(); mw = MROW(t); qkt<KB, false>(PX0, PX1, K_lds, r32, hi, S.qr, true);                                          \
        finishSM(PY0, PY1, alY, l_reg, pa0, pa1, pa2, pa3); SBAR();                                                           \
        if ((t) + 1 < NT) { SLOAD_H(Kh, Vh, KBASE((t) + 1)); SBAR(); }                                                        \
        pv_tile<VB, false>(o, vb0, pa0, pa1, pa2, pa3, true); mask_bits(PX0, PX1, mw, hi); partialSM(PX0, PX1, m_reg, mnX, alX); \
        __syncthreads();                                                                                                      \
        if ((t) + 1 < NT) { VMW(); SWRITE_H(SB); }                                                                            \
        RESC(alX); __syncthreads(); } while (0)
    for (int t = 1; t + 1 < NT; t += 2) {
        HALF_STEP(pB0, pB1, mnB, alB, pA0, pA1, alA, t, 1, 0, 0);
        HALF_STEP(pA0, pA1, mnA, alA, pB0, pB1, alB, t + 1, 0, 1, 1);
    }
    const bool even = (NT & 1) == 0;
    if (even) { SBAR(); mw = MROW(NT - 1); qkt<1, false>(pB0, pB1, K_lds, r32, hi, S.qr, true); SBAR(); }
    SLOAD_H(nxt.K, nxt.V, 0); SBAR();
#pragma unroll
    for (int d0 = 0; d0 < 8; ++d0) S.qr[d0] = load8(nxt.Q + (size_t)(wid * QBLK + r32) * D + d0 * 16 + hi * 8);
    SBAR();
    finishSM(pA0, pA1, alA, l_reg, pa0, pa1, pa2, pa3); SBAR();
    pv_tile<0, false>(o, vb0, pa0, pa1, pa2, pa3, true);
    if (even) { mask_bits(pB0, pB1, mw, hi); partialSM(pB0, pB1, m_reg, mnB, alB); __syncthreads(); RESC(alB);
        finishSM(pB0, pB1, alB, l_reg, pa0, pa1, pa2, pa3); SBAR(); pv_tile<1, false>(o, vb0, pa0, pa1, pa2, pa3, true); }
    SBAR(); VMWN(8); SWRITE_HK(0); SBAR();
    if (hi == 0) li_l[r32] = l_reg; asm volatile("s_waitcnt lgkmcnt(0)" ::: "memory");
    float rli[16];
#pragma unroll
    for (int r = 0; r < 16; ++r) rli[r] = __builtin_amdgcn_rcpf(li_l[crow(r, hi)]);
    bf16* Ow = cur.O + (size_t)(wid * QBLK) * OS;
#pragma unroll
    for (int r = 0; r < 16; ++r) { const int orow = crow(r, hi);
#pragma unroll
        for (int d0 = 0; d0 < 4; ++d0) { const float v = o[d0][r] * rli[r];
            const float vn = __shfl_xor(v, 1);
            if ((r32 & 1) == 0) *(unsigned*)(Ow + (size_t)orow * OS + d0 * 32 + r32) = cvtpk(v, vn); } }
    __syncthreads();
#undef RESC
#undef KBASE
#undef HALF_STEP
#undef MROW
}
#undef ROW
#undef VMW
#undef VMWN
#undef SLOAD_H
#undef SWRITE_HK
#undef SWRITE_HV
#undef SWRITE_H
#undef KSWZ
#undef SBAR
}


__device__ __forceinline__ attn::BlockRef attn_ref(ARGREF a, int b, int h, int qb) {
    attn::BlockRef r; const int kvh = h / 3;
    r.Q = (const attn::bf16*)(a.ws + WS_QB) + ((size_t)(b * 6 + h) * SEQ + (size_t)qb * 256) * 128;
    r.K = (const attn::bf16*)(a.ws + WS_KB) + (size_t)(b * 2 + kvh) * SEQ * 128;
    r.V = (const attn::bf16*)(a.ws + WS_VB) + (size_t)(b * 2 + kvh) * SEQ * 128;
    r.O = (attn::bf16*)(a.ws + WS_MIX) + (size_t)(b * SEQ + qb * 256) * DM + h * 128;
    r.M = (const attn::u32x2*)(a.ws + WS_MASK) + (size_t)(b * SEQ + qb * 256) * 64;
    r.P0 = qb * 256; return r;
}
__device__ __forceinline__ void p11_attention(Ctx& c, ARGREF a) {
    constexpr int NITEM = 240;
#pragma unroll 1
    for (int it = c.vcu; it < NITEM; it += c.G) {
        const int bh = it / 10, slot = it % 10, b = bh / 6, h = bh % 6;
        const int q0 = slot < 3 ? 15 - slot : (slot == 9 ? 6 : slot - 3), q1 = slot < 3 ? q0 : (slot == 9 ? 6 : 15 - slot);
        attn::Seam S;
        attn::BlockRef cur = attn_ref(a, b, h, q0), nxt = attn_ref(a, b, h, q1);
        __syncthreads();
        attn::sel_prime(cur, (char*)c.lds, S);
        if (q0 != q1) attn::sel_block(cur, nxt, (char*)c.lds, S);
        attn::sel_block(nxt, nxt, (char*)c.lds, S);
    }
    if (c.G == 256) {
        if (c.vcu >= NITEM) { for (int j = 0; j < 4; ++j) { const int u = (c.vcu - NITEM) * 4 + j; attn_sample_unit(c, a, u >> 2, u & 3); } }
        else if (c.vcu % 10 == 9) { for (int j = 0; j < 3; ++j) { const int u = 64 + (c.vcu / 10) * 3 + j; if (u < MS) attn_sample_unit(c, a, u >> 2, u & 3); } }
    } else for (int u = c.vcu; u < MS; u += c.G) attn_sample_unit(c, a, u >> 2, u & 3);
}

enum { PH_PRO = 0, PH_IN0, PH_MIX0, PH_HSCAN, PH_HFIX, PH_OUT0, PH_GU0, PH_DOWN0, PH_IN1, PH_POST, PH_IDX, PH_TOPK, PH_ATTN, PH_OUT1, PH_GU1, PH_DOWN1, NPHASE };
#ifndef ONLYPH
#define ONLYPH -1
#endif
#define PHON(x) (ONLYPH < 0 || ONLYPH == (x))
#ifndef REP_PH
#define REP_PH -1
#endif
#ifndef REP_N
#define REP_N 1
#endif
__global__ void __launch_bounds__(NWAVES * 64, 2) fwd_kernel(Args args) {
    extern __shared__ __attribute__((aligned(16))) unsigned char lds[];
    Ctx c;
    c.lds = (LAS unsigned char*)lds;
    c.MISC = (volatile LAS unsigned*)(c.lds + MISC_OFF);
    c.tid = threadIdx.x; c.lane = c.tid & 63; c.wave = __builtin_amdgcn_readfirstlane(c.tid >> 6);
    c.G = gridDim.x; { const int bx = blockIdx.x; c.vcu = (c.G % 8 == 0) ? (bx % 8) * (c.G / 8) + bx / 8 : bx; }
    c.ctl = (gu32*)(args.ws + WS_CTL);
    for (int u = c.tid; u < (LDS_BYTES - LDSCTL_OFF) / 4; u += NWAVES * 64) ((LAS unsigned*)(c.lds + LDSCTL_OFF))[u] = 0u;
    __syncthreads();
    const int lo = args.ph_lo, hi = args.ph_hi;
    XcdBarrier bar; bar.bar = (unsigned*)(c.ctl + CW_BAR); bar.x = 0; bar.st = nullptr;
    if (hi - lo > 1 || REP_N > 1) bar = xcd_barrier_post((unsigned*)(c.ctl + CW_BAR), c.MISC + 8);
    c.qoff = 0;
#pragma unroll 1
    for (int ph = lo; ph < hi; ++ph) {
        const int layer = ph >= PH_IN1 ? 1 : 0;
        const __attribute__((address_space(4))) Args* ap = (const __attribute__((address_space(4))) Args*)__builtin_amdgcn_kernarg_segment_ptr(); asm volatile("" : "+s"(ap));
        ARGREF la = *ap; unsigned char* const ws = la.ws; float* const out = la.out;
        { int t_ = threadIdx.x; asm volatile("" : "+v"(t_)); c.tid = t_; c.lane = t_ & 63; c.wave = __builtin_amdgcn_readfirstlane(t_ >> 6); }
        if ((ph == PH_DOWN0 || ph == PH_DOWN1) && PHON(PH_OUT0)) {
            pg8::SchedX S0; S0.init(MP, 1024, c.G, (int)blockIdx.x, 0, 0, 1, 0); pg8::Unit u0; if (S0.next(0, u0)) conv_fixup_tile(c, la, layer, u0.pm); VM_WAIT(); __syncthreads(); }
        if (ph == PH_PRO && PHON(PH_PRO)) p0_prologue(c, la);
        else if ((ph == PH_IN0 || ph == PH_IN1) && PHON(PH_IN0)) {
            pg8::Gemm g{(const pg8::bf16_t*)(ws + WS_XB), (const pg8::bf16_t*)(ws + (ph == PH_IN0 ? WS_WIN0 : WS_WIN1)), MT, 0, 1024};
            pg8::SchedX S; if (ph == PH_IN0) S.init(MP, ZC0, c.G, (int)blockIdx.x, 16, MT / 256, 4, 13); else S.init(MP, ZC1, c.G, (int)blockIdx.x, 0, 0, 1, 0);
            pg8::EpiZ E{(pg8::bf16_t*)(ws + WS_Z), ph == PH_IN0 ? ZC0 : ZC1, ssptr(c, ph == PH_IN0 ? 0 : 2), ph == PH_IN0 ? 13 : 9, (float*)(ws + WS_MEMKV), MEMROW0};
            pg8::gemm_phase<pg8::EpiZ, pg8::SchedX, PG8_ALIGN, PG8_SP2>(c.lds + RING_OFF, g, S, E);
            { SgArgs sg{}; sg.A = (const bf16*)(ws + WS_XB) + (size_t)MP * DM; sg.Bt = (const bf16*)(ws + (ph == PH_IN0 ? WS_WIN0 : WS_WIN1)); sg.K = 1024; sg.mode = 0; sg.Z = (bf16*)(ws + WS_Z); sg.ldz = ph == PH_IN0 ? ZC0 : ZC1; sg.ssin = ssptr(c, ph == PH_IN0 ? 0 : 2);
              sgemm_phase(c, sg, ph == PH_IN0 ? ZC0 : ZC1); }
            if (ph == PH_IN0) { __syncthreads(); convert_layer1_tail(c, la, (64 * 13 + 16) % c.G); }
        }
        else if (ph == PH_MIX0 && PHON(PH_MIX0)) p2_mixer0(c, la);
        else if (ph == PH_HSCAN && PHON(PH_HSCAN)) hgrn_scan(c, la);
        else if (ph == PH_HFIX && PHON(PH_HFIX)) p2c_hgrn_fix(c, la);
        else if ((ph == PH_OUT0 || ph == PH_DOWN0 || ph == PH_OUT1 || ph == PH_DOWN1) && PHON(PH_OUT0)) {
            const bool isout = (ph == PH_OUT0 || ph == PH_OUT1);
            pg8::Gemm g{(const pg8::bf16_t*)(ws + (isout ? WS_MIX : WS_ACT)), (const pg8::bf16_t*)(ws + (isout ? WS_WOUT + (size_t)layer * 1024 * 1024 * 2 : WS_WD + (size_t)layer * 1024 * DFF * 2)), MT, 1024, isout ? 1024 : DFF};
            pg8::SchedX S; S.init(MP, 1024, c.G, (int)blockIdx.x, 0, 0, 1, 0);
            pg8::EpiResid E;
            E.rp = ph == PH_OUT0 ? la.in[0] : nullptr; E.rb = (const pg8::bf16_t*)(ws + WS_XB); E.y = ph == PH_DOWN1 ? out + O_YP : nullptr;
            E.xb = ph == PH_DOWN1 ? nullptr : (pg8::bf16_t*)(ws + WS_XB); E.ssout = ph == PH_DOWN1 ? nullptr : ssptr(c, ph == PH_OUT0 ? 1 : (ph == PH_DOWN0 ? 2 : 3));
            pg8::gemm_phase<pg8::EpiResid, pg8::SchedX, PG8_ALIGN, PG8_SP2>(c.lds + RING_OFF, g, S, E);
            { SgArgs sg{}; sg.A = (const bf16*)(ws + (isout ? WS_MIX : WS_ACT)) + (size_t)MP * (isout ? 1024 : DFF); sg.Bt = (const bf16*)g.Bt; sg.K = isout ? 1024 : DFF; sg.mode = 1; sg.rb = (const bf16*)(ws + WS_XB); sg.resid = ph == PH_OUT0 ? la.in[1] : nullptr; sg.y = ph == PH_DOWN1 ? out + O_YS : nullptr; sg.xb = (bf16*)E.xb; sg.ssout = E.ssout;
              sgemm_phase(c, sg, 1024); }
        }
        else if ((ph == PH_GU0 || ph == PH_GU1) && PHON(PH_GU0)) {
            pg8::Gemm g{(const pg8::bf16_t*)(ws + WS_XB), (const pg8::bf16_t*)(ws + WS_WGU + (size_t)layer * 5632 * 1024 * 2), MT, 5632, 1024};
            pg8::SchedX S; S.init(MP, 5632, c.G, (int)blockIdx.x, 0, 0, 1, 0);
            pg8::EpiGU E{(pg8::bf16_t*)(ws + WS_ACT), ssptr(c, layer ? 3 : 1), out + O_CVP + (size_t)layer * 4 * 2 * DFF, la.in[26] + (size_t)layer * 3 * DFF, la.in[27] + (size_t)layer * DFF, (float*)(ws + WS_G4), (float*)(ws + WS_UP2)};
            pg8::gemm_phase<pg8::EpiGU, pg8::SchedX, PG8_ALIGN, PG8_SP2>(c.lds + RING_OFF, g, S, E);
            { SgArgs sg{}; sg.A = (const bf16*)(ws + WS_XB) + (size_t)MP * DM; sg.Bt = (const bf16*)g.Bt; sg.K = 1024; sg.mode = 2; sg.ssin = E.ss; sg.ACT = (bf16*)E.ACT; sg.cvs = out + O_CVS + (size_t)layer * 32 * 2 * DFF; sg.cst = la.in[8] + (size_t)layer * 32 * 2 * DFF; sg.cw = E.cw; sg.cb = E.cb;
              sgemm_phase(c, sg, 5632); }
        }
        else if (ph == PH_POST && PHON(PH_POST)) p8_dsa_post(c, la);
        else if (ph == PH_IDX && PHON(PH_IDX)) p9_indexer(c, la);
        else if (ph == PH_TOPK && PHON(PH_TOPK)) p10_topk(c, la);
        else if (ph == PH_ATTN && PHON(PH_ATTN)) p11_attention(c, la);
        if (REP_N > 1 && ph == REP_PH && c.qoff < 4 * (REP_N - 1)) { c.qoff += 4; --ph; xcd_barrier(bar); continue; }
        if (REP_N > 1) c.qoff = 0;
        if (ph + 1 < hi) xcd_barrier(bar);
    }
}

#ifndef MK_ONE_LAUNCH
#define MK_ONE_LAUNCH 1
#endif
extern "C" void kernel_launch(void* const* d_in, const int* in_sizes, int n_in, void* d_out, int out_size, void* d_ws, size_t ws_size, hipStream_t stream) {
    static int grid = 0;
    if (grid == 0) {
        if (n_in != 29 || out_size != (int)O_END || ws_size < WS_END) { fprintf(stderr, "kernel_launch: unexpected problem (n_in %d, out %d, ws %zu)\n", n_in, out_size, ws_size); grid = -1; return; }
        int dev = 0, cus = 0;
        if (hipGetDevice(&dev) != hipSuccess || hipDeviceGetAttribute(&cus, hipDeviceAttributeMultiprocessorCount, dev) != hipSuccess) { grid = -1; return; }
        if (hipFuncSetAttribute((const void*)fwd_kernel, hipFuncAttributeMaxDynamicSharedMemorySize, LDS_BYTES) != hipSuccess) { fprintf(stderr, "kernel_launch: hipFuncSetAttribute failed\n"); grid = -1; return; }
        (void)hipGetLastError();
        grid = cus;
    }
    if (grid < 0) return;
    if (hipMemsetAsync((char*)d_ws + WS_CTL, 0, CTL_ZERO_BYTES, stream) != hipSuccess) { fprintf(stderr, "kernel_launch: memset failed\n"); return; }
    Args a{};
    for (int i = 0; i < 29; ++i) a.in[i] = (const float*)d_in[i];
    a.page_table = (const int*)d_in[9]; a.out = (float*)d_out; a.ws = (unsigned char*)d_ws;
#if MK_ONE_LAUNCH
    a.ph_lo = 0; a.ph_hi = NPHASE;
    hipLaunchKernelGGL(fwd_kernel, dim3(grid), dim3(NWAVES * 64), LDS_BYTES, stream, a);
#else
    for (int ph = 0; ph < NPHASE; ++ph) { a.ph_lo = ph; a.ph_hi = ph + 1; hipLaunchKernelGGL(fwd_kernel, dim3(grid), dim3(NWAVES * 64), LDS_BYTES, stream, a); }
#endif
}
```

```cpp
#include <hip/hip_runtime.h>
#include <cstdio>
#include <cstdint>


namespace pg8 {
#define PG8_LAS __attribute__((address_space(3)))
typedef unsigned short bf16_t;
typedef short bf16x8 __attribute__((ext_vector_type(8)));
typedef float f32x4 __attribute__((ext_vector_type(4)));
typedef unsigned u32x4 __attribute__((ext_vector_type(4)));
constexpr int BM = 256, BK = 64, HALF = 128, HTB = HALF * BK * 2  , STAGE_BYTES = 8 * HTB, NXCD = 8, WGM = 8;

__host__ __device__ __forceinline__ int lds_byte(int r, int c) { const int st = (r >> 4) * 2 + (c >> 5), rr = r & 15, cc = c & 31, ob = rr * 64 + cc * 2; return st * 1024 + (ob ^ (((ob >> 9) & 1) << 5)); }
__host__ __device__ __forceinline__ void stage_rc(int b, int& R, int& C) { const int st = b / 1024, sb = b % 1024, swz = sb ^ (((sb >> 9) & 1) << 5); R = (st >> 1) * 16 + swz / 64; C = (st & 1) * 32 + (swz % 64) / 2; }
__host__ __device__ __forceinline__ int perm32(int rho) { const int n = rho >> 4, i = rho & 15; return 8 * (i >> 2) + 4 * n + (i & 3); }

struct Unit { int pm, pn; };
struct Gemm { const bf16_t* A; const bf16_t* Bt; int M, N, K; };

struct StaticOrder {
    int nM, nN, nwg, G, c;
    __host__ __device__ __forceinline__ void init(int M, int N, int G_, int c_) { nM = M / BM; nN = N / BM; nwg = nM * nN; G = G_; c = c_; }
    __host__ __device__ __forceinline__ bool next(int i, Unit& u) const {
        const long L = (long)i * G + c; if (L >= nwg) return false;
        int wgid = (int)L; { const int q = nwg / NXCD, r = nwg % NXCD, xcd = wgid % NXCD, off = wgid / NXCD; wgid = (xcd < r ? xcd * (q + 1) : r * (q + 1) + (xcd - r) * q) + off; }
        const int nig = WGM * nN, gid = wgid / nig, fm = gid * WGM, gsz = (nM - fm) < WGM ? (nM - fm) : WGM;
        u.pm = fm + ((wgid % nig) % gsz); u.pn = (wgid % nig) / gsz; return true;
    }
    __device__ __forceinline__ void a_ready(const Unit&) const {}
    __device__ __forceinline__ void done(const Unit&) const {}
};


constexpr int MP = 16384, MS = 128, MVALID = MP + MS, MT = 16640, DM = 1024, DFF = 2816;
constexpr float RMS_EPS = 1e-6f;
__device__ __forceinline__ unsigned cvt_pk_bf16(float lo, float hi) { unsigned r; asm volatile("v_cvt_pk_bf16_f32 %0, %1, %2" : "=v"(r) : "v"(lo), "v"(hi)); return r; }

struct SchedX {
    StaticOrder so; int nextra, e_pm0, e_nm, e_pn0;
    __device__ __forceinline__ void init(int M, int N, int G_, int c_, int nextra_, int e_pm0_, int e_nm_, int e_pn0_) { so.init(M, N, G_, c_); nextra = nextra_; e_pm0 = e_pm0_; e_nm = e_nm_; e_pn0 = e_pn0_; }
    __device__ __forceinline__ bool next(int i, Unit& u) const {
        const long L = (long)i * so.G + so.c;
        if (L < so.nwg) return so.next(i, u);
        const int e = (int)(L - so.nwg); if (e >= nextra) return false;
        u.pm = e_pm0 + e % e_nm; u.pn = e_pn0 + e / e_nm; return true;
    }
    __device__ __forceinline__ void a_ready(const Unit&) const {}
    __device__ __forceinline__ void done(const Unit&) const {}
};

struct EpiZ {
    static constexpr bool PERM = true, AFTER_DRAIN = false;
    bf16_t* Z; int ldz; const float* ss; int nmain; float* memkv; int memrow0;
    __device__ __forceinline__ void operator()(const f32x4 (&acc)[2][2][4][2], const Unit& u, int wr, int wc, int fr, int fq) const {
        const int row0 = u.pm * BM + wr * 64 + fr;
        if (u.pn < nmain) {
            const int col0 = u.pn * BM + wc * 32 + 8 * fq;
#pragma unroll
            for (int ai = 0; ai < 2; ++ai)
#pragma unroll
                for (int m = 0; m < 4; ++m) { const int row = row0 + ai * HALF + m * 16; const float rs = rsqrtf(ss[row] * (1.0f / DM) + RMS_EPS);
#pragma unroll
                    for (int bj = 0; bj < 2; ++bj) { const f32x4 v0 = acc[ai][bj][m][0] * rs, v1 = acc[ai][bj][m][1] * rs;
                        u32x4 w; w.x = cvt_pk_bf16(v0[0], v0[1]); w.y = cvt_pk_bf16(v0[2], v0[3]); w.z = cvt_pk_bf16(v1[0], v1[1]); w.w = cvt_pk_bf16(v1[2], v1[3]);
                        *(u32x4*)(Z + (size_t)row * ldz + col0 + bj * HALF) = w; } }
        } else {
            const int col0 = (u.pn - nmain) * BM + wc * 32 + 8 * fq;
#pragma unroll
            for (int ai = 0; ai < 2; ++ai)
#pragma unroll
                for (int m = 0; m < 4; ++m) { const int row = row0 + ai * HALF + m * 16 - memrow0;
#pragma unroll
                    for (int bj = 0; bj < 2; ++bj) { float* p = memkv + (size_t)row * 1024 + col0 + bj * HALF; *(f32x4*)p = acc[ai][bj][m][0]; *(f32x4*)(p + 4) = acc[ai][bj][m][1]; } }
        }
    }
};

struct EpiResid {
    static constexpr bool PERM = true, AFTER_DRAIN = false;
    const float* rp; const bf16_t* rb; float* y; bf16_t* xb; float* ssout;
    __device__ __forceinline__ void operator()(const f32x4 (&acc)[2][2][4][2], const Unit& u, int wr, int wc, int fr, int fq) const {
        const int row0 = u.pm * BM + wr * 64 + fr, col0 = u.pn * BM + wc * 32 + 8 * fq;
#pragma unroll
        for (int ai = 0; ai < 2; ++ai)
#pragma unroll
            for (int m = 0; m < 4; ++m) { const int row = row0 + ai * HALF + m * 16; float part = 0.f;
#pragma unroll
                for (int bj = 0; bj < 2; ++bj) { const int c = col0 + bj * HALF; f32x4 r0, r1;
                    if (rp) { r0 = *(const f32x4*)(rp + (size_t)row * DM + c); r1 = *(const f32x4*)(rp + (size_t)row * DM + c + 4); }
                    else { const u32x4 q = *(const u32x4*)(rb + (size_t)row * DM + c);
                        r0 = (f32x4){__builtin_bit_cast(float, q.x << 16), __builtin_bit_cast(float, q.x & 0xffff0000u), __builtin_bit_cast(float, q.y << 16), __builtin_bit_cast(float, q.y & 0xffff0000u)};
                        r1 = (f32x4){__builtin_bit_cast(float, q.z << 16), __builtin_bit_cast(float, q.z & 0xffff0000u), __builtin_bit_cast(float, q.w << 16), __builtin_bit_cast(float, q.w & 0xffff0000u)}; }
                    const f32x4 v0 = acc[ai][bj][m][0] + r0, v1 = acc[ai][bj][m][1] + r1;
                    if (y) { *(f32x4*)(y + (size_t)row * DM + c) = v0; *(f32x4*)(y + (size_t)row * DM + c + 4) = v1; }
                    part += (v0[0] * v0[0] + v0[1] * v0[1]) + (v0[2] * v0[2] + v0[3] * v0[3]) + (v1[0] * v1[0] + v1[1] * v1[1]) + (v1[2] * v1[2] + v1[3] * v1[3]);
                    if (xb) { u32x4 w; w.x = cvt_pk_bf16(v0[0], v0[1]); w.y = cvt_pk_bf16(v0[2], v0[3]); w.z = cvt_pk_bf16(v1[0], v1[1]); w.w = cvt_pk_bf16(v1[2], v1[3]);
                        *(u32x4*)(xb + (size_t)row * DM + c) = w; } }
                part += __shfl_xor(part, 16); part += __shfl_xor(part, 32);
                if (ssout && fq == 0) atomicAdd(ssout + row, part); }
    }
};

__device__ __forceinline__ void dpp_ror12(const f32x4& v, f32x4& r1, f32x4& r2) {
    float a0, a1, a2, a3, b0, b1, b2, b3;
    asm volatile("s_nop 1\n\t"
                 "v_mov_b32_dpp %0, %8 row_ror:1 row_mask:0xf bank_mask:0xf\n\tv_mov_b32_dpp %1, %9 row_ror:1 row_mask:0xf bank_mask:0xf\n\t"
                 "v_mov_b32_dpp %2, %10 row_ror:1 row_mask:0xf bank_mask:0xf\n\tv_mov_b32_dpp %3, %11 row_ror:1 row_mask:0xf bank_mask:0xf\n\t"
                 "v_mov_b32_dpp %4, %8 row_ror:2 row_mask:0xf bank_mask:0xf\n\tv_mov_b32_dpp %5, %9 row_ror:2 row_mask:0xf bank_mask:0xf\n\t"
                 "v_mov_b32_dpp %6, %10 row_ror:2 row_mask:0xf bank_mask:0xf\n\tv_mov_b32_dpp %7, %11 row_ror:2 row_mask:0xf bank_mask:0xf"
                 : "=&v"(a0), "=&v"(a1), "=&v"(a2), "=&v"(a3), "=&v"(b0), "=&v"(b1), "=&v"(b2), "=&v"(b3) : "v"(v[0]), "v"(v[1]), "v"(v[2]), "v"(v[3]));
    r1 = (f32x4){a0, a1, a2, a3}; r2 = (f32x4){b0, b1, b2, b3};
}
struct EpiGU {
    static constexpr bool PERM = true, AFTER_DRAIN = false;
    bf16_t* ACT; const float* ss; float* cvp; const float* cw; const float* cb; float* G4; float* UP2;
    __device__ __forceinline__ void operator()(const f32x4 (&acc)[2][2][4][2], const Unit& u, int wr, int wc, int fr, int fq) const {
        const int row0 = u.pm * BM + wr * 64 + fr, colg = u.pn * HALF + wc * 32 + 8 * fq;
#pragma unroll
        for (int n = 0; n < 2; ++n) { const int col = colg + 4 * n;
            const f32x4 w0 = *(const f32x4*)(cw + col), w1 = *(const f32x4*)(cw + DFF + col), w2 = *(const f32x4*)(cw + 2 * DFF + col), bb = *(const f32x4*)(cb + col);
#pragma unroll
            for (int ai = 0; ai < 2; ++ai) { f32x4 r1p = {0.f, 0.f, 0.f, 0.f}, r2p = r1p; const int slab = (u.pm * BM + ai * HALF + wr * 64) >> 6;
#pragma unroll
                for (int m = 0; m < 4; ++m) { const int row = row0 + ai * HALF + m * 16; const float rs = rsqrtf(ss[row] * (1.0f / DM) + RMS_EPS);
                    const f32x4 g = acc[ai][0][m][n] * rs, up = acc[ai][1][m][n] * rs;
                    f32x4 r1, r2; dpp_ror12(g, r1, r2);
                    const f32x4 p1 = fr >= 1 ? r1 : r1p, p2 = fr >= 2 ? r2 : r2p;
                    f32x4 cv = bb + w0 * p2 + w1 * p1 + w2 * g, y;
#pragma unroll
                    for (int i = 0; i < 4; ++i) y[i] = cv[i] * __builtin_amdgcn_rcpf(1.0f + __expf(-cv[i])) * up[i];
                    if (m == 0 && fr < 2) { *(f32x4*)(G4 + (size_t)(slab * 4 + fr) * DFF + col) = g; *(f32x4*)(UP2 + (size_t)(slab * 2 + fr) * DFF + col) = up; }
                    else { typedef unsigned u32x2 __attribute__((ext_vector_type(2))); u32x2 w; w.x = cvt_pk_bf16(y[0], y[1]); w.y = cvt_pk_bf16(y[2], y[3]); *(u32x2*)(ACT + (size_t)row * DFF + col) = w; }
                    if (m == 3 && fr >= 14) { *(f32x4*)(G4 + (size_t)(slab * 4 + 2 + (fr - 14)) * DFF + col) = g;
                        const int t = row & 4095; if (t >= 4094) *(f32x4*)(cvp + (size_t)((row >> 12) * 2 + (t - 4094)) * DFF + col) = g; }
                    r1p = r1; r2p = r2; } } }
    }
};

template <class Epi, class Sched, bool ALIGN_EPI = false, bool SP2 = false>
__device__ __forceinline__ void gemm_phase(PG8_LAS unsigned char* lds, const Gemm g, const Sched& S, const Epi& E) {
    int tid_ = threadIdx.x; asm volatile("" : "+v"(tid_));
    const int tid = tid_, wid = __builtin_amdgcn_readfirstlane(tid >> 6), lane = tid & 63, wr = wid >> 2, wc = wid & 3, fr = lane & 15, fq = lane >> 4;
    const int K = g.K, nt = K / BK;
    unsigned voffA[2], voffB[2];
#pragma unroll
    for (int i = 0; i < 2; ++i) { int R, C; stage_rc(tid * 16 + i * 8192, R, C); const int Rb = Epi::PERM ? ((R & ~31) + perm32(R & 31)) : R;
        voffA[i] = (unsigned)(R * K + C) * 2u; voffB[i] = (unsigned)(Rb * K + C) * 2u; }
    const size_t kstep = (size_t)(BK * 2);
    const size_t hstep = (size_t)HALF * K * 2;
    const size_t tstep = 2 * hstep;
    const unsigned ldsw = (unsigned)wid * 1024u;
    const int aoff = lds_byte(wr * 64 + fr, fq * 8), boff = lds_byte(wc * 32 + fr, fq * 8);
#define PG8_SA(b, h) (((b) * 2 + (h)) * HTB)
#define PG8_SB(b, h) ((4 + (b) * 2 + (h)) * HTB)
#define PG8_STAGE(bufoff, gbase, voff) do { _Pragma("unroll") for (int _i = 0; _i < 2; ++_i) \
        __builtin_amdgcn_global_load_lds((const unsigned*)((const char*)(gbase) + (voff)[_i]), (PG8_LAS unsigned*)(lds + (bufoff) + ldsw + _i * 8192), 16, 0, 0); } while (0)
#define PG8_LDA(dst, b, h) do { _Pragma("unroll") for (int m = 0; m < 4; ++m) _Pragma("unroll") for (int k = 0; k < 2; ++k) dst[m][k] = *(const PG8_LAS bf16x8*)(lds + PG8_SA(b, h) + aoff + m * 2048 + k * 1024); } while (0)
#define PG8_LDB(dst, b, h) do { _Pragma("unroll") for (int n = 0; n < 2; ++n) _Pragma("unroll") for (int k = 0; k < 2; ++k) dst[n][k] = *(const PG8_LAS bf16x8*)(lds + PG8_SB(b, h) + boff + n * 2048 + k * 1024); } while (0)
#define PG8_MMA(ai, bj, At, Bt) do { __builtin_amdgcn_s_setprio(1); _Pragma("unroll") for (int m = 0; m < 4; ++m) _Pragma("unroll") for (int n = 0; n < 2; ++n) _Pragma("unroll") for (int k = 0; k < 2; ++k) \
        acc[ai][bj][m][n] = __builtin_amdgcn_mfma_f32_16x16x32_bf16(Bt[n][k], At[m][k], acc[ai][bj][m][n], 0, 0, 0); __builtin_amdgcn_s_setprio(0); } while (0)
#define PG8_WAIT_V(n) asm volatile("s_waitcnt vmcnt(" #n ")" ::: "memory")
#define PG8_WAIT_L(n) asm volatile("s_waitcnt lgkmcnt(" #n ")" ::: "memory")
#define PG8_BAR __builtin_amdgcn_s_barrier()
#define PG8_SCHED __builtin_amdgcn_sched_barrier(0)
    Unit cur, nxt; int ui = 0;
    if (!S.next(0, cur)) return;
    f32x4 acc[2][2][4][2];
#pragma unroll
    for (int a = 0; a < 2; ++a)
#pragma unroll
        for (int b = 0; b < 2; ++b)
#pragma unroll
            for (int m = 0; m < 4; ++m)
#pragma unroll
                for (int n = 0; n < 2; ++n) acc[a][b][m][n] = (f32x4){0.f, 0.f, 0.f, 0.f};
    bf16x8 At[4][2], B0[2][2], B1[2][2];
    const char* cA = (const char*)g.A + (size_t)cur.pm * tstep; const char* cB = (const char*)g.Bt + (size_t)cur.pn * tstep;
    S.a_ready(cur);
    if constexpr (SP2) {
        PG8_STAGE(PG8_SB(0, 0), cB, voffB); PG8_STAGE(PG8_SB(0, 1), cB + hstep, voffB); PG8_STAGE(PG8_SA(0, 0), cA, voffA); PG8_STAGE(PG8_SA(0, 1), cA + hstep, voffA);
        if (wr == 1) PG8_BAR;
        PG8_WAIT_V(2); PG8_BAR;
        PG8_STAGE(PG8_SB(1, 0), cB + kstep, voffB); PG8_STAGE(PG8_SA(1, 0), cA + kstep, voffA); PG8_STAGE(PG8_SB(1, 1), cB + hstep + kstep, voffB);
        PG8_WAIT_V(6); PG8_BAR;
    } else {
        PG8_STAGE(PG8_SB(0, 0), cB, voffB); PG8_STAGE(PG8_SA(0, 0), cA, voffA); PG8_STAGE(PG8_SB(0, 1), cB + hstep, voffB); PG8_STAGE(PG8_SA(0, 1), cA + hstep, voffA);
        if (wr == 1) PG8_BAR;
        PG8_WAIT_V(4); PG8_BAR;
        PG8_STAGE(PG8_SB(1, 0), cB + kstep, voffB); PG8_STAGE(PG8_SA(1, 0), cA + kstep, voffA); PG8_STAGE(PG8_SB(1, 1), cB + hstep + kstep, voffB);
        PG8_WAIT_V(6); PG8_BAR;
    }
    for (;;) {
        const bool has_next = S.next(ui + 1, nxt);
        const char* nA = has_next ? (const char*)g.A + (size_t)nxt.pm * tstep : cA; const char* nB = has_next ? (const char*)g.Bt + (size_t)nxt.pn * tstep : cB;
        for (int t = 0; t < nt; t += 2) {
            const bool last = (t == nt - 2);
            const char* a1 = cA + (size_t)(t + 1) * kstep;
            const char* a2 = last ? nA : cA + (size_t)(t + 2) * kstep; const char* b2 = last ? nB : cB + (size_t)(t + 2) * kstep;
            const char* a3 = a2 + kstep; const char* b3 = b2 + kstep;
            if (last && has_next) S.a_ready(nxt);
            if constexpr (SP2) {
            PG8_LDB(B0, 0, 0); PG8_LDB(B1, 0, 1); PG8_SCHED; PG8_LDA(At, 0, 0); PG8_STAGE(PG8_SA(1, 1), a1 + hstep, voffA);
            PG8_WAIT_V(8); PG8_WAIT_L(0); PG8_BAR; PG8_MMA(0, 0, At, B0); PG8_MMA(0, 1, At, B1); PG8_BAR; PG8_SCHED;
            PG8_LDA(At, 0, 1); PG8_STAGE(PG8_SB(0, 0), b2, voffB); PG8_STAGE(PG8_SB(0, 1), b2 + hstep, voffB); PG8_STAGE(PG8_SA(0, 0), a2, voffA);
            PG8_WAIT_V(8); PG8_WAIT_L(0); PG8_BAR; PG8_MMA(1, 0, At, B0); PG8_MMA(1, 1, At, B1); PG8_BAR; PG8_SCHED;
            PG8_LDB(B0, 1, 0); PG8_LDB(B1, 1, 1); PG8_SCHED; PG8_LDA(At, 1, 0); PG8_STAGE(PG8_SA(0, 1), a2 + hstep, voffA);
            PG8_WAIT_V(8); PG8_WAIT_L(0); PG8_BAR; PG8_MMA(0, 0, At, B0); PG8_MMA(0, 1, At, B1); PG8_BAR; PG8_SCHED;
            PG8_LDA(At, 1, 1); PG8_STAGE(PG8_SB(1, 0), b3, voffB); PG8_STAGE(PG8_SB(1, 1), b3 + hstep, voffB); PG8_STAGE(PG8_SA(1, 0), a3, voffA);
            PG8_WAIT_V(8); PG8_WAIT_L(0); PG8_BAR; PG8_MMA(1, 0, At, B0); PG8_MMA(1, 1, At, B1); PG8_BAR; PG8_SCHED;
            } else {
            PG8_LDB(B0, 0, 0); PG8_SCHED; PG8_LDA(At, 0, 0); PG8_STAGE(PG8_SA(1, 1), a1 + hstep, voffA);
            PG8_WAIT_L(8); PG8_BAR; PG8_WAIT_L(0); PG8_MMA(0, 0, At, B0); PG8_BAR; PG8_SCHED;
            PG8_LDB(B1, 0, 1); PG8_STAGE(PG8_SB(0, 0), b2, voffB);
            PG8_BAR; PG8_WAIT_L(0); PG8_MMA(0, 1, At, B1); PG8_BAR;
            PG8_LDA(At, 0, 1); PG8_STAGE(PG8_SA(0, 0), a2, voffA);
            PG8_BAR; PG8_WAIT_L(0); PG8_MMA(1, 0, At, B0); PG8_BAR; PG8_SCHED;
            PG8_STAGE(PG8_SB(0, 1), b2 + hstep, voffB);
            PG8_WAIT_V(6); PG8_BAR; PG8_MMA(1, 1, At, B1); PG8_BAR;
            PG8_LDB(B0, 1, 0); PG8_SCHED; PG8_LDA(At, 1, 0); PG8_STAGE(PG8_SA(0, 1), a2 + hstep, voffA);
            PG8_WAIT_L(8); PG8_BAR; PG8_WAIT_L(0); PG8_MMA(0, 0, At, B0); PG8_BAR; PG8_SCHED;
            PG8_LDB(B1, 1, 1); PG8_STAGE(PG8_SB(1, 0), b3, voffB);
            PG8_BAR; PG8_WAIT_L(0); PG8_MMA(0, 1, At, B1); PG8_BAR;
            PG8_LDA(At, 1, 1); PG8_STAGE(PG8_SA(1, 0), a3, voffA);
            PG8_BAR; PG8_WAIT_L(0); PG8_MMA(1, 0, At, B0); PG8_BAR; PG8_SCHED;
            PG8_STAGE(PG8_SB(1, 1), b3 + hstep, voffB);
            PG8_WAIT_V(6); PG8_BAR; PG8_MMA(1, 1, At, B1); PG8_BAR;
            }
        }
        if constexpr (ALIGN_EPI) { if (wr == 0) PG8_BAR; }
        if constexpr (!Epi::AFTER_DRAIN) { E(acc, cur, wr, wc, fr, fq); S.done(cur); }
        if (!has_next) break;
#pragma unroll
        for (int a = 0; a < 2; ++a)
#pragma unroll
            for (int b = 0; b < 2; ++b)
#pragma unroll
                for (int m = 0; m < 4; ++m)
#pragma unroll
                    for (int n = 0; n < 2; ++n) acc[a][b][m][n] = (f32x4){0.f, 0.f, 0.f, 0.f};
        cur = nxt; cA = nA; cB = nB; ++ui;
        if constexpr (ALIGN_EPI) { if (wr == 1) PG8_BAR; }
    }
    PG8_WAIT_V(0);
    if constexpr (!ALIGN_EPI) { if (wr == 0) PG8_BAR; }
    PG8_BAR;
    if constexpr (Epi::AFTER_DRAIN) { E.fused(acc, cur, wr, wc, fr, fq, lds, wid, lane); S.done(cur); }
#undef PG8_SA
#undef PG8_SB
#undef PG8_STAGE
#undef PG8_LDA
#undef PG8_LDB
#undef PG8_MMA
#undef PG8_WAIT_V
#undef PG8_WAIT_L
#undef PG8_BAR
#undef PG8_SCHED
}
}


#ifndef PG8_SP2
#define PG8_SP2 true
#endif
#ifndef PG8_ALIGN
#define PG8_ALIGN true
#endif
constexpr int NWAVES = 8;
constexpr int MP = pg8::MP, MS = pg8::MS, MVALID = pg8::MVALID, MT = pg8::MT, DM = 1024, DFF = 2816;
constexpr int SEQ = 4096, NB = 4, NSB = 32, PAST = 8192, NPOOL = 2560;
constexpr int ZC0 = 3328, ZC1 = 2304;
constexpr int Z1_Q = 0, Z1_K = 768, Z1_V = 1024, Z1_IQ = 1280, Z1_IK = 1792, Z1_IW = 1856, Z1_MQ = 1920;
constexpr int NMEMROWS = 1024, MEMROW0 = MT;
constexpr float EPS = 1e-6f;
constexpr size_t MiB = 1u << 20;
constexpr size_t WS_CTL = 0, CTL_ZERO_BYTES = 2 * MiB;
constexpr size_t WS_WIN0 = 2 * MiB, WS_WIN1 = 11 * MiB, WS_WOUT = 16 * MiB, WS_WGU = 20 * MiB, WS_WD = 42 * MiB;
constexpr size_t WS_XB = 54 * MiB, WS_MEMKV = 89 * MiB, WS_MIX = 94 * MiB, WS_Z = 128 * MiB, WS_U = 234 * MiB, WS_UP = 324 * MiB, WS_ACT = 414 * MiB;
constexpr size_t WS_QB = 504 * MiB, WS_KB = 528 * MiB, WS_VB = 536 * MiB, WS_IQB = 544 * MiB, WS_IKB = 560 * MiB, WS_IW = 562 * MiB;
constexpr size_t WS_SQ = 563 * MiB, WS_SIQ = WS_SQ + 512 * 1024, WS_SIW = WS_SIQ + 384 * 1024, WS_SSC = 564 * MiB, WS_SIDX = 569 * MiB, WS_MASK = 570 * MiB, WS_SC = 578 * MiB, WS_END = 834 * MiB;
constexpr int SSC_LD = 8256;
constexpr int CW_TMO = 0, CW_BAR = 4096, CW_Q = 8192, CW_SS = 16384;
constexpr size_t O_YP = 0, O_YS = O_YP + (size_t)MP * DM, O_HP = O_YS + (size_t)MS * DM, O_HS = O_HP + 4 * 6 * 16384, O_KP = O_HS + 32 * 6 * 16384,
    O_VP = O_KP + (size_t)MP * 256, O_IKP = O_VP + (size_t)MP * 256, O_KS = O_IKP + (size_t)MP * 64, O_VS = O_KS + MS * 256, O_IKS = O_VS + MS * 256,
    O_MK = O_IKS + MS * 64, O_MV = O_MK + 2 * 1024 * 256, O_CVP = O_MV + 2 * 1024 * 256, O_CVS = O_CVP + 2 * 4 * 2 * DFF, O_END = O_CVS + 2 * 32 * 2 * DFF;
static_assert(O_END == 31412224, "output size");
constexpr int RING_OFF = 0, RING_BYTES = 131072;
constexpr int LDSCTL_OFF = RING_BYTES, MISC_OFF = LDSCTL_OFF + 320;
constexpr int LDS_BYTES = 147456;

#define GAS __attribute__((address_space(1)))
#define LAS __attribute__((address_space(3)))
typedef unsigned short bf16;
typedef unsigned v4u __attribute__((ext_vector_type(4)));
typedef float f32x4 __attribute__((ext_vector_type(4)));
typedef short bf16x8 __attribute__((ext_vector_type(8)));
typedef GAS unsigned gu32;
typedef GAS unsigned long long gu64;
#define RLX_AGENT __ATOMIC_RELAXED, __HIP_MEMORY_SCOPE_AGENT
#define LDS_WAIT() asm volatile("s_waitcnt lgkmcnt(0)" ::: "memory")
#define VM_WAIT() asm volatile("s_waitcnt vmcnt(0)" ::: "memory")
__device__ __forceinline__ unsigned long long rt() { return __builtin_amdgcn_s_memrealtime(); }
__device__ __forceinline__ unsigned f2bf(float f) { unsigned u = __builtin_bit_cast(unsigned, f); return (u + 0x7fffu + ((u >> 16) & 1u)) >> 16; }
__device__ __forceinline__ unsigned pk2(float lo, float hi) { return f2bf(lo) | (f2bf(hi) << 16); }

#define XB_TMO      128
#define XB_XCNT(j)  (256  + 64 * (j))
#define XB_XSUB(j)  (1280 + 64 * (j))
#define XB_XGEN(j)  (2304 + 64 * (j))
#define XB_TOP      3328
#define XB_TOPGEN   3392
#define XCD_BAR_WORDS 3456
#define XB_SPIN_CAP (1u << 18)

__device__ __forceinline__ unsigned xb_ld(unsigned* p)              { return __hip_atomic_load(p, __ATOMIC_RELAXED, __HIP_MEMORY_SCOPE_AGENT); }
__device__ __forceinline__ unsigned xb_add(unsigned* p, unsigned v) { return __hip_atomic_fetch_add(p, v, __ATOMIC_RELAXED, __HIP_MEMORY_SCOPE_AGENT); }
__device__ __forceinline__ unsigned xb_xcc_id() { return (unsigned)__builtin_amdgcn_s_getreg((3 << 11) | 20) & 0xFu; }
#define XB_SPIN(cond, bar) do { unsigned _sp = 0; while (cond) { __builtin_amdgcn_s_sleep(1); \
    if ((++_sp & 255u) == 0u) { if (xb_ld(&(bar)[XB_TMO])) break; if (_sp > XB_SPIN_CAP) { atomicAdd(&(bar)[XB_TMO], 1u); break; } } } } while (0)

struct XcdBarrier {
    unsigned* bar; unsigned x;
    volatile LAS unsigned* st;
};

__device__ __forceinline__ XcdBarrier xcd_barrier_post(unsigned* bar, volatile LAS unsigned* st) {
    XcdBarrier b; b.bar = bar; b.x = xb_xcc_id(); b.st = st;
    if (threadIdx.x == 0) (void)xb_add(&bar[XB_XCNT(b.x)], 1u);
    return b;
}
__device__ __forceinline__ void xcd_barrier_complete(unsigned* bar, unsigned x, unsigned& nloc, unsigned& nx) {
    const unsigned G = gridDim.x * gridDim.y * gridDim.z;
    unsigned sum, cnt, mine, sp = 0u;
    for (;;) {
        sum = 0u; cnt = 0u; mine = 0u;
#pragma unroll
        for (unsigned j = 0; j < 16; ++j) { const unsigned c = xb_ld(&bar[XB_XCNT(j)]); sum += c; cnt += (c > 0u) ? 1u : 0u; mine = (j == x) ? c : mine; }
        if (sum == G) break;
        __builtin_amdgcn_s_sleep(1);
        if ((++sp & 255u) == 0u) { if (xb_ld(&bar[XB_TMO])) break; if (sp > XB_SPIN_CAP) { atomicAdd(&bar[XB_TMO], 1u); break; } }
    }
    nloc = mine > 0u ? mine : 1u; nx = cnt > 0u ? cnt : 1u;
}

__device__ __forceinline__ void xcd_barrier(const XcdBarrier& b) {
    asm volatile("s_waitcnt vmcnt(0)" ::: "memory");
    __syncthreads();
    if (threadIdx.x == 0) {
        unsigned* bar = b.bar;
        __builtin_amdgcn_s_waitcnt(0);
        unsigned nloc = b.st[0], nx = b.st[1];
        if (nloc == 0u) { xcd_barrier_complete(bar, b.x, nloc, nx); b.st[0] = nloc; b.st[1] = nx; }
        const unsigned old = xb_add(&bar[XB_XSUB(b.x)], 1u);
        const unsigned gen = old / nloc;
        if (old + 1u == (gen + 1u) * nloc) {
            __builtin_amdgcn_fence(__ATOMIC_RELEASE, "agent");
            asm volatile("s_waitcnt vmcnt(0)" ::: "memory");
            const unsigned og = xb_add(&bar[XB_TOP], 1u);
            const unsigned tg = og / nx;
            if (og + 1u == (tg + 1u) * nx) xb_add(&bar[XB_TOPGEN], 1u);
            else XB_SPIN(xb_ld(&bar[XB_TOPGEN]) == tg, bar);
            __builtin_amdgcn_fence(__ATOMIC_ACQUIRE, "agent");
            xb_add(&bar[XB_XGEN(b.x)], 1u);
            asm volatile("s_waitcnt vmcnt(0)" ::: "memory");
        } else {
            XB_SPIN(xb_ld(&bar[XB_XGEN(b.x)]) == gen, bar);
            __builtin_amdgcn_fence(__ATOMIC_ACQUIRE, "agent");
            asm volatile("s_waitcnt vmcnt(0)" ::: "memory");
        }
    }
    __syncthreads();
}


struct Args { const float* in[29]; const int* page_table; float* out; unsigned char* ws; int ph_lo, ph_hi; };
typedef const __attribute__((address_space(4))) Args& ARGREF;
struct Ctx { LAS unsigned char* lds; volatile LAS unsigned* MISC; gu32* ctl; int tid, lane, wave, vcu, G, qoff; };
typedef float f32x16 __attribute__((ext_vector_type(16)));
typedef unsigned long long u64;

__device__ __forceinline__ float bf2f(unsigned b) { return __builtin_bit_cast(float, b << 16); }
__device__ __forceinline__ float wave_sum(float v) {
#pragma unroll
    for (int o = 1; o < 64; o <<= 1) v += __shfl_xor(v, o);
    return v;
}
__device__ __forceinline__ float wave_sum_fast(float x) {
    x += __builtin_bit_cast(float, __builtin_amdgcn_update_dpp(0, __builtin_bit_cast(int, x), 0xB1, 0xF, 0xF, false));
    x += __builtin_bit_cast(float, __builtin_amdgcn_update_dpp(0, __builtin_bit_cast(int, x), 0x4E, 0xF, 0xF, false));
    x += __builtin_bit_cast(float, __builtin_amdgcn_update_dpp(0, __builtin_bit_cast(int, x), 0x141, 0xF, 0xF, false));
    x += __builtin_bit_cast(float, __builtin_amdgcn_update_dpp(0, __builtin_bit_cast(int, x), 0x140, 0xF, 0xF, false));
    const int xi = __builtin_bit_cast(int, x);
    return (__builtin_bit_cast(float, __builtin_amdgcn_readlane(xi, 0)) + __builtin_bit_cast(float, __builtin_amdgcn_readlane(xi, 16))) +
           (__builtin_bit_cast(float, __builtin_amdgcn_readlane(xi, 32)) + __builtin_bit_cast(float, __builtin_amdgcn_readlane(xi, 48)));
}
__device__ __forceinline__ int crow(int r, int hi) { return (r & 3) + 8 * (r >> 2) + 4 * hi; }
__device__ __forceinline__ float sigmoidf_(float x) { return 1.0f / (1.0f + __expf(-x)); }
__device__ __forceinline__ float* ssptr(const Ctx& c, int i) { return (float*)(c.ctl + CW_SS) + (size_t)i * MT; }

__device__ __forceinline__ int q_next(Ctx& c, int qi) {
    __syncthreads();
    if (c.tid == 0) c.MISC[16] = atomicAdd((unsigned*)(c.ctl + CW_Q + 64 * (qi + c.qoff)), 1u);
    __syncthreads();
    return (int)c.MISC[16];
}

template <int K>
__device__ __forceinline__ f32x16 mm32(const LAS bf16* A, int lda, const LAS bf16* Bt, int ldb, f32x16 acc, int lane) {
    const int r = lane & 31, h = lane >> 5;
#pragma unroll
    for (int ks = 0; ks < K; ks += 16) {
        const bf16x8 a = *(const LAS bf16x8*)(A + r * lda + ks + 8 * h);
        const bf16x8 b = *(const LAS bf16x8*)(Bt + r * ldb + ks + 8 * h);
        acc = __builtin_amdgcn_mfma_f32_32x32x16_bf16(a, b, acc, 0, 0, 0);
    }
    return acc;
}

__device__ __forceinline__ int map_row(int mapid, int n, int row_off) {
    if (mapid == 0) return n + row_off;
    if (mapid == 1) return n < 1864 ? n : n + 56;
    if (mapid == 2) return (n >> 7) * 256 + (n & 127);
    return (n >> 7) * 256 + 128 + (n & 127);
}
__device__ __forceinline__ void transpose_item(const float* W, int K, int N, const float* kscale, bf16* WT, int mapid, int row_off, LAS float* scr, int item, int lane) {
    const int nblk = (N + 31) / 32, kb = item / nblk, nb = item % nblk, k0 = 64 * kb, n0 = 32 * nb;
    { const int n4 = (lane & 7) * 4, nn = n0 + n4 < N ? n0 + n4 : N - 4; f32x4 v[8];
#pragma unroll
      for (int i = 0; i < 8; ++i) v[i] = *(const f32x4*)(W + (size_t)(k0 + 8 * i + (lane >> 3)) * N + nn);
#pragma unroll
      for (int i = 0; i < 8; ++i) { const int kk = 8 * i + (lane >> 3); const float sc = kscale ? kscale[k0 + kk] : 1.0f; LAS float* d = scr + kk * 33 + n4;
          d[0] = v[i].x * sc; d[1] = v[i].y * sc; d[2] = v[i].z * sc; d[3] = v[i].w * sc; } }
    LDS_WAIT(); asm volatile("" ::: "memory");
    const int cc = lane & 7;
#pragma unroll
    for (int j = 0; j < 4; ++j) { const int nl = (lane >> 3) + 8 * j, n = n0 + nl; const LAS float* s = scr + (8 * cc) * 33 + nl;
        v4u o; o.x = pk2(s[0 * 33], s[1 * 33]); o.y = pk2(s[2 * 33], s[3 * 33]); o.z = pk2(s[4 * 33], s[5 * 33]); o.w = pk2(s[6 * 33], s[7 * 33]);
        if (n < N) *(GAS v4u*)(WT + (size_t)map_row(mapid, n, row_off) * K + k0 + 8 * cc) = o; }
    LDS_WAIT(); asm volatile("" ::: "memory");
}
constexpr int I_INH = 16 * 104, I_MKV = 16 * 16, I_DSA = 16 * 67, I_OUT = 16 * 32, I_G = 16 * 88, I_D = 44 * 32;
constexpr int W_N0 = I_INH + 2 * I_MKV + I_OUT + 2 * I_G + I_D, W_NITEMS = W_N0 + I_DSA + I_OUT + 2 * I_G + I_D;
__device__ __forceinline__ void convert_item(ARGREF a, int it, LAS float* scr, int lane) {
    unsigned char* ws = a.ws; int r = it;
    if (r < I_INH) { transpose_item(a.in[13], 1024, 3328, a.in[11], (bf16*)(ws + WS_WIN0), 0, 0, scr, r, lane); return; } r -= I_INH;
    if (r < 2 * I_MKV) { const int l = r / I_MKV; transpose_item(a.in[20] + (size_t)l * 1024 * 512, 1024, 512, nullptr, (bf16*)(ws + WS_WIN0), 0, 3328 + 512 * l, scr, r % I_MKV, lane); return; } r -= 2 * I_MKV;
    int l = 0;
    if (r >= I_OUT + 2 * I_G + I_D) { r -= I_OUT + 2 * I_G + I_D; l = 1;
        if (r < I_DSA) { transpose_item(a.in[16], 1024, 2120, a.in[11] + 1024, (bf16*)(ws + WS_WIN1), 1, 0, scr, r, lane); return; } r -= I_DSA; }
    if (r < I_OUT) { transpose_item(a.in[23] + (size_t)l * 1024 * 1024, 1024, 1024, nullptr, (bf16*)(ws + WS_WOUT) + (size_t)l * 1024 * 1024, 0, 0, scr, r, lane); return; } r -= I_OUT;
    if (r < I_G) { transpose_item(a.in[24] + (size_t)l * 1024 * DFF, 1024, DFF, a.in[12] + l * 1024, (bf16*)(ws + WS_WGU) + (size_t)l * 5632 * 1024, 2, 0, scr, r, lane); return; } r -= I_G;
    if (r < I_G) { transpose_item(a.in[25] + (size_t)l * 1024 * DFF, 1024, DFF, a.in[12] + l * 1024, (bf16*)(ws + WS_WGU) + (size_t)l * 5632 * 1024, 3, 0, scr, r, lane); return; } r -= I_G;
    transpose_item(a.in[28] + (size_t)l * DFF * 1024, DFF, 1024, nullptr, (bf16*)(ws + WS_WD) + (size_t)l * 1024 * DFF, 0, 0, scr, r, lane);
}
__device__ __forceinline__ void convert_layer1_tail(Ctx& c, ARGREF a, int first_idle) {
    LAS float* scr = (LAS float*)(c.lds + RING_OFF + c.wave * 16384);
    const int bx = (int)blockIdx.x; if (bx < first_idle) return;
    const int nw = (c.G - first_idle) * NWAVES;
    for (int it = W_N0 + (bx - first_idle) * NWAVES + c.wave; it < W_NITEMS; it += nw) convert_item(a, it, scr, c.lane);
}
__device__ __forceinline__ void p0_prologue(Ctx& c, ARGREF a) {
    LAS float* scr = (LAS float*)(c.lds + RING_OFF + c.wave * 16384);
    const int gw = c.vcu * NWAVES + c.wave, NGW = c.G * NWAVES, lane = c.lane;
    unsigned char* ws = a.ws;
    for (int it = gw; it < W_N0; it += NGW) convert_item(a, it, scr, lane);
    for (int rr = gw; rr < 184; rr += NGW) { const int row = rr < 56 ? 1864 + rr : 2176 + (rr - 56);
        GAS v4u* p = (GAS v4u*)((bf16*)(ws + WS_WIN1) + (size_t)row * 1024); p[lane] = (v4u){0u, 0u, 0u, 0u}; p[64 + lane] = (v4u){0u, 0u, 0u, 0u}; }
    float* ss0 = ssptr(c, 0);
    for (int m = gw; m < MT + NMEMROWS; m += NGW) {
        GAS u64* o8 = (GAS u64*)((bf16*)(ws + WS_XB) + (size_t)m * DM) + lane;
        if (m >= MVALID && m < MT) {
#pragma unroll
            for (int j = 0; j < 4; ++j) o8[64 * j] = 0ull;
            continue; }
        const float* src = m < MP ? a.in[0] + (size_t)m * DM : (m < MVALID ? a.in[1] + (size_t)(m - MP) * DM : a.in[10] + (size_t)(m - MT) * DM);
        const GAS f32x4* xr = (const GAS f32x4*)src + lane; f32x4 v[4]; float s = 0.f;
#pragma unroll
        for (int j = 0; j < 4; ++j) { v[j] = xr[64 * j]; s += (v[j].x * v[j].x + v[j].y * v[j].y) + (v[j].z * v[j].z + v[j].w * v[j].w); }
        s = wave_sum_fast(s);
#pragma unroll
        for (int j = 0; j < 4; ++j) o8[64 * j] = (u64)pk2(v[j].x, v[j].y) | ((u64)pk2(v[j].z, v[j].w) << 32);
        if (m < MVALID && lane == 0) ss0[m] = s;
    }
}

__device__ __forceinline__ void memattn_unit(Ctx& c, const bf16* Zq  , int ldz, int nrows_valid, const float* Kp, const float* Vp, int kstride,
                                             bool normk, const float* kgain, const float* qgain, bf16* Out  ) {
    LAS bf16* KN = (LAS bf16*)(c.lds);
    LAS bf16* VTm = (LAS bf16*)(c.lds + 36864);
    LAS bf16* QN = (LAS bf16*)(c.lds + 70656) + c.wave * (32 * 72);
    LAS float* LI = (LAS float*)(c.lds + 107520) + c.wave * 32;
    int tid = c.tid; asm volatile("" : "+v"(tid));
    const int lane = tid & 63, w = c.wave;
    {
        const int m = tid >> 1, dh = (tid & 1) * 32;
        f32x4 kv[8]; float s = 0.f;
#pragma unroll
        for (int j = 0; j < 8; ++j) { kv[j] = *(const f32x4*)(Kp + (size_t)m * kstride + dh + 4 * j); s += (kv[j].x * kv[j].x + kv[j].y * kv[j].y) + (kv[j].z * kv[j].z + kv[j].w * kv[j].w); }
        s += __shfl_xor(s, 1);
        const float rs = normk ? rsqrtf(s * (1.0f / 64.0f) + EPS) : 1.0f;
#pragma unroll
        for (int j = 0; j < 8; j += 2) { f32x4 g0 = {1.f, 1.f, 1.f, 1.f}, g1 = g0;
            if (normk) { g0 = *(const f32x4*)(kgain + dh + 4 * j); g1 = *(const f32x4*)(kgain + dh + 4 * j + 4); }
            const f32x4 x0 = kv[j] * rs * g0, x1 = kv[j + 1] * rs * g1;
            v4u o; o.x = pk2(x0.x, x0.y); o.y = pk2(x0.z, x0.w); o.z = pk2(x1.x, x1.y); o.w = pk2(x1.z, x1.w);
            *(LAS v4u*)(KN + m * 72 + dh + 4 * j) = o; }
#pragma unroll
        for (int j = 0; j < 8; ++j) { const f32x4 vv = *(const f32x4*)(Vp + (size_t)m * kstride + dh + 4 * j);
            VTm[(dh + 4 * j + 0) * 264 + m] = (bf16)f2bf(vv.x); VTm[(dh + 4 * j + 1) * 264 + m] = (bf16)f2bf(vv.y);
            VTm[(dh + 4 * j + 2) * 264 + m] = (bf16)f2bf(vv.z); VTm[(dh + 4 * j + 3) * 264 + m] = (bf16)f2bf(vv.w); }
    }
    {
        const int row = lane >> 1, hf = lane & 1, grow = w * 32 + row;
        float x[32]; float s = 0.f;
        if (grow < nrows_valid) {
#pragma unroll
            for (int j = 0; j < 4; ++j) { const v4u q = *(const v4u*)(Zq + (size_t)grow * ldz + hf * 32 + 8 * j);
                x[8 * j + 0] = bf2f(q.x & 0xffffu); x[8 * j + 1] = bf2f(q.x >> 16); x[8 * j + 2] = bf2f(q.y & 0xffffu); x[8 * j + 3] = bf2f(q.y >> 16);
                x[8 * j + 4] = bf2f(q.z & 0xffffu); x[8 * j + 5] = bf2f(q.z >> 16); x[8 * j + 6] = bf2f(q.w & 0xffffu); x[8 * j + 7] = bf2f(q.w >> 16); }
        } else {
#pragma unroll
            for (int j = 0; j < 32; ++j) x[j] = 0.f;
        }
#pragma unroll
        for (int j = 0; j < 32; ++j) s += x[j] * x[j];
        s += __shfl_xor(s, 1);
        const float rs = rsqrtf(s * (1.0f / 64.0f) + EPS) * 0.125f;
#pragma unroll
        for (int j = 0; j < 32; j += 8) { v4u o;
            o.x = pk2(x[j] * rs * qgain[hf * 32 + j], x[j + 1] * rs * qgain[hf * 32 + j + 1]); o.y = pk2(x[j + 2] * rs * qgain[hf * 32 + j + 2], x[j + 3] * rs * qgain[hf * 32 + j + 3]);
            o.z = pk2(x[j + 4] * rs * qgain[hf * 32 + j + 4], x[j + 5] * rs * qgain[hf * 32 + j + 5]); o.w = pk2(x[j + 6] * rs * qgain[hf * 32 + j + 6], x[j + 7] * rs * qgain[hf * 32 + j + 7]);
            *(LAS v4u*)(QN + row * 72 + hf * 32 + j) = o; }
    }
    __syncthreads();
    if (w * 32 < nrows_valid) {
        const int r32 = lane & 31, hh = lane >> 5;
        f32x16 s[8];
#pragma unroll
        for (int mt = 0; mt < 8; ++mt) { f32x16 z = {}; s[mt] = mm32<64>(KN + mt * 32 * 72, 72, QN, 72, z, lane); }
        float mx = -1e30f;
#pragma unroll
        for (int mt = 0; mt < 8; ++mt)
#pragma unroll
            for (int r = 0; r < 16; ++r) mx = fmaxf(mx, s[mt][r]);
        mx = fmaxf(mx, __shfl_xor(mx, 32));
        float l = 0.f;
#pragma unroll
        for (int mt = 0; mt < 8; ++mt)
#pragma unroll
            for (int r = 0; r < 16; ++r) { const float p = __expf(s[mt][r] - mx); s[mt][r] = p; l += p; }
        l += __shfl_xor(l, 32);
        if (hh == 0) LI[r32] = l;
        f32x16 o[2] = {};
#pragma unroll
        for (int mt = 0; mt < 8; ++mt)
#pragma unroll
            for (int sx = 0; sx < 2; ++sx) {
                v4u pa; pa.x = pk2(s[mt][8 * sx + 0], s[mt][8 * sx + 1]); pa.y = pk2(s[mt][8 * sx + 2], s[mt][8 * sx + 3]);
                pa.z = pk2(s[mt][8 * sx + 4], s[mt][8 * sx + 5]); pa.w = pk2(s[mt][8 * sx + 6], s[mt][8 * sx + 7]);
                const bf16x8 af = __builtin_bit_cast(bf16x8, pa);
#pragma unroll
                for (int dt = 0; dt < 2; ++dt) { const LAS bf16* vp = VTm + (dt * 32 + r32) * 264 + mt * 32 + 16 * sx + 4 * hh;
                    const u64 lo = *(const LAS u64*)vp, hi = *(const LAS u64*)(vp + 8);
                    v4u bw; bw.x = (unsigned)lo; bw.y = (unsigned)(lo >> 32); bw.z = (unsigned)hi; bw.w = (unsigned)(hi >> 32);
                    o[dt] = __builtin_amdgcn_mfma_f32_32x32x16_bf16(af, __builtin_bit_cast(bf16x8, bw), o[dt], 0, 0, 0); }
            }
        LDS_WAIT();
#pragma unroll
        for (int r = 0; r < 16; ++r) { const int qr = crow(r, hh), grow = w * 32 + qr; const float il = 1.0f / LI[qr];
            if (grow < nrows_valid) {
#pragma unroll
                for (int dt = 0; dt < 2; ++dt) Out[(size_t)grow * DM + dt * 32 + r32] = (bf16)f2bf(o[dt][r] * il); } }
    }
}

constexpr int HG_GS = 4, HG_NG = SEQ / (32 * HG_GS);
constexpr size_t WS_HOL = WS_U, WS_HQC = WS_UP, WS_HUT = WS_ACT, WS_HST = WS_ACT + 64 * MiB, WS_HDG = WS_ACT + 50 * MiB;
template <bool PROMPT>
__device__ __forceinline__ void hgrn_unit(Ctx& c, ARGREF a, int b, int h, int g) {
    LAS unsigned char* L = c.lds;
    LAS float* LFt = (LAS float*)(L + 0);
    LAS float* OB = (LAS float*)(L + 0);
    LAS float* SEG = (LAS float*)(L + 16896);
    LAS float* DVv = (LAS float*)(L + 18944);
    LAS bf16* QD = (LAS bf16*)(L + 19456);
    LAS bf16* KD = (LAS bf16*)(L + 28160);
    LAS bf16* KET = (LAS bf16*)(L + 36864);
    LAS bf16* VT = (LAS bf16*)(L + 47104);
    LAS bf16* SCB = (LAS bf16*)(L + 57344);
    LAS bf16* STt = (LAS bf16*)(L + 59904);
    LAS float* BOFF = (LAS float*)(L + 94720);
    int tid = c.tid; asm volatile("" : "+v"(tid));
    const int lane = tid & 63, w = c.wave, r32 = lane & 31, hh = lane >> 5;
    const int te = tid & 31, k8 = (tid >> 5) * 8;
    const int tf = tid >> 4, v8 = (tid & 15) * 8;
    const bf16* Z = (const bf16*)(a.ws + WS_Z);
    bf16* MIX = (bf16*)(a.ws + WS_MIX);
    const int nch = PROMPT ? HG_GS : 1, nvalid = PROMPT ? 32 : 4;
    const int kt = w >> 1, vt0 = 2 * (w & 1);
    const int unit = (b * 6 + h) * HG_NG + g;
    f32x16 S0 = {}, S1 = {};
    if (!PROMPT) { const float* sp = a.in[7] + (size_t)(b * 6 + h) * 16384;
#pragma unroll
        for (int r = 0; r < 16; ++r) { const int k = 32 * kt + crow(r, hh); S0[r] = sp[k * 128 + 32 * vt0 + r32]; S1[r] = sp[k * 128 + 32 * (vt0 + 1) + r32]; } }
    float lbv[8];
#pragma unroll
    for (int j = 0; j < 8; ++j) { const float l0 = a.in[14][h * 128 + k8 + j], l1 = a.in[14][768 + h * 128 + k8 + j]; lbv[j] = 1.0f / (1.0f + __expf(l1 - l0)); }
    __syncthreads();
    if (tid < 128) BOFF[tid] = 0.f;
#define HG_WRITE_ST() do { _Pragma("unroll") for (int g4 = 0; g4 < 4; ++g4) { const int k0 = 32 * kt + 8 * g4 + 4 * hh; \
        *(LAS u64*)(STt + (32 * vt0 + r32) * 136 + k0) = (u64)pk2(S0[4 * g4], S0[4 * g4 + 1]) | ((u64)pk2(S0[4 * g4 + 2], S0[4 * g4 + 3]) << 32); \
        *(LAS u64*)(STt + (32 * (vt0 + 1) + r32) * 136 + k0) = (u64)pk2(S1[4 * g4], S1[4 * g4 + 1]) | ((u64)pk2(S1[4 * g4 + 2], S1[4 * g4 + 3]) << 32); } } while (0)
    HG_WRITE_ST();
    v4u zq = {0u, 0u, 0u, 0u}, zf = zq, zi = zq;
    { const int row = (PROMPT ? b * SEQ + (g * HG_GS) * 32 : MP + 4 * b) + te;
      if (te < nvalid) { const bf16* zr = Z + (size_t)row * ZC0 + h * 128 + k8; zq = *(const v4u*)zr; zf = *(const v4u*)(zr + 768); zi = *(const v4u*)(zr + 1536); } }
#pragma unroll 1
    for (int ch = 0; ch < nch; ++ch) {
        const int row0 = PROMPT ? b * SEQ + (g * HG_GS + ch) * 32 : MP + 4 * b, row = row0 + te;
        const bool valid = te < nvalid;
        float qs[8], kk[8];
        {
            const unsigned qw[4] = {zq.x, zq.y, zq.z, zq.w}, fw[4] = {zf.x, zf.y, zf.z, zf.w}, iw[4] = {zi.x, zi.y, zi.z, zi.w};
#pragma unroll
            for (int j = 0; j < 8; ++j) { const float q = bf2f((qw[j >> 1] >> (16 * (j & 1))) & 0xffffu), fp = bf2f((fw[j >> 1] >> (16 * (j & 1))) & 0xffffu);
                const float sg = sigmoidf_(fp), f = lbv[j] + (1.0f - lbv[j]) * sg;
                qs[j] = valid ? q * sigmoidf_(q) : 0.f; kk[j] = valid ? (1.0f - f) : 0.f;
                LFt[(k8 + j) * 33 + te] = valid ? __logf(f) : 0.f;
                VT[(k8 + j) * 40 + te] = (bf16)((iw[j >> 1] >> (16 * (j & 1))) & 0xffffu); }
            if (PROMPT && ch + 1 < nch) { const bf16* zr = Z + (size_t)(row + 32) * ZC0 + h * 128 + k8; zq = *(const v4u*)zr; zf = *(const v4u*)(zr + 768); zi = *(const v4u*)(zr + 1536); }
        }
        __syncthreads();
        {
            const int k = tid & 127, sg_ = tid >> 7; float bsum = 0.f;
#pragma unroll
            for (int i = 0; i < 8; ++i) { bsum += LFt[k * 33 + 8 * sg_ + i]; LFt[k * 33 + 8 * sg_ + i] = bsum; }
            SEG[sg_ * 128 + k] = bsum; }
        __syncthreads();
        {
            float bb[8], bl[8];
            { f32x4 t0[4], t1[4];
#pragma unroll
              for (int s_ = 0; s_ < 4; ++s_) { t0[s_] = *(const LAS f32x4*)(SEG + s_ * 128 + k8); t1[s_] = *(const LAS f32x4*)(SEG + s_ * 128 + k8 + 4); }
              const int sgt = te >> 3; f32x4 o0 = {0.f, 0.f, 0.f, 0.f}, o1 = o0;
#pragma unroll
              for (int s_ = 0; s_ < 3; ++s_) if (s_ < sgt) { o0 += t0[s_]; o1 += t1[s_]; }
              const f32x4 l0 = (t0[0] + t0[1]) + (t0[2] + t0[3]), l1 = (t1[0] + t1[1]) + (t1[2] + t1[3]);
              const float of[8] = {o0.x, o0.y, o0.z, o0.w, o1.x, o1.y, o1.z, o1.w}; const float lt[8] = {l0.x, l0.y, l0.z, l0.w, l1.x, l1.y, l1.z, l1.w};
#pragma unroll
              for (int j = 0; j < 8; ++j) { bb[j] = LFt[(k8 + j) * 33 + te] + of[j]; bl[j] = lt[j]; } }
            float qd[8], kd[8];
#pragma unroll
            for (int j = 0; j < 8; ++j) { qd[j] = qs[j] * __expf(bb[j]); kd[j] = kk[j] * __expf(-bb[j]); KET[(k8 + j) * 40 + te] = (bf16)f2bf(kk[j] * __expf(bl[j] - bb[j])); }
            v4u o; o.x = pk2(qd[0], qd[1]); o.y = pk2(qd[2], qd[3]); o.z = pk2(qd[4], qd[5]); o.w = pk2(qd[6], qd[7]); *(LAS v4u*)(QD + te * 136 + k8) = o;
            if (PROMPT) { const f32x4 f0 = *(const LAS f32x4*)(BOFF + k8), f1 = *(const LAS f32x4*)(BOFF + k8 + 4);
                const float bo[8] = {f0.x, f0.y, f0.z, f0.w, f1.x, f1.y, f1.z, f1.w}; float qc[8];
#pragma unroll
                for (int j = 0; j < 8; ++j) qc[j] = qd[j] * __expf(bo[j]);
                v4u oc; oc.x = pk2(qc[0], qc[1]); oc.y = pk2(qc[2], qc[3]); oc.z = pk2(qc[4], qc[5]); oc.w = pk2(qc[6], qc[7]);
                *(v4u*)((bf16*)(a.ws + WS_HQC) + (size_t)row * 768 + h * 128 + k8) = oc; }
            o.x = pk2(kd[0], kd[1]); o.y = pk2(kd[2], kd[3]); o.z = pk2(kd[4], kd[5]); o.w = pk2(kd[6], kd[7]); *(LAS v4u*)(KD + te * 136 + k8) = o;
            if (te == 0) {
#pragma unroll
                for (int j = 0; j < 8; ++j) DVv[k8 + j] = __expf(bl[j]); }
        }
        __syncthreads();
        f32x16 oacc = {};
        if (w == 4) { f32x16 z = {}; const f32x16 sc = mm32<128>(QD, 136, KD, 136, z, lane);
#pragma unroll
            for (int r = 0; r < 16; ++r) { const int t = crow(r, hh); SCB[t * 40 + r32] = (bf16)f2bf(r32 <= t ? sc[r] : 0.f); } }
        if (w < 4) oacc = mm32<128>(QD, 136, STt + (w * 32) * 136, 136, oacc, lane);
        if (PROMPT && tid >= 384) { const int k = tid - 384; BOFF[k] += (SEG[k] + SEG[128 + k]) + (SEG[256 + k] + SEG[384 + k]); }
        __syncthreads();
        if (w < 4) { oacc = mm32<32>(SCB, 40, VT + (w * 32) * 40, 40, oacc, lane);
#pragma unroll
            for (int r = 0; r < 16; ++r) OB[crow(r, hh) * 128 + w * 32 + r32] = oacc[r]; }
        {
#pragma unroll
            for (int r = 0; r < 16; ++r) { const float d = DVv[32 * kt + crow(r, hh)]; S0[r] *= d; S1[r] *= d; }
            S0 = mm32<32>(KET + (kt * 32) * 40, 40, VT + (vt0 * 32) * 40, 40, S0, lane);
            S1 = mm32<32>(KET + (kt * 32) * 40, 40, VT + ((vt0 + 1) * 32) * 40, 40, S1, lane);
        }
        __syncthreads();
        HG_WRITE_ST();
        {
            const int orow = row0 + tf;
            const f32x4 o0 = *(const LAS f32x4*)(OB + tf * 128 + v8), o1 = *(const LAS f32x4*)(OB + tf * 128 + v8 + 4);
            if (PROMPT) { float* ol = (float*)(a.ws + WS_HOL) + (size_t)orow * 768 + h * 128 + v8; *(f32x4*)ol = o0; *(f32x4*)(ol + 4) = o1; }
            else {
                float ov[8] = {o0.x, o0.y, o0.z, o0.w, o1.x, o1.y, o1.z, o1.w}; float s = 0.f;
#pragma unroll
                for (int j = 0; j < 8; ++j) s += ov[j] * ov[j];
                s += __shfl_xor(s, 1); s += __shfl_xor(s, 2); s += __shfl_xor(s, 4); s += __shfl_xor(s, 8);
                const float rs = rsqrtf(s * (1.0f / 128.0f) + EPS);
                if (tf < nvalid) { const v4u gz = *(const v4u*)(Z + (size_t)orow * ZC0 + 2304 + h * 128 + v8); const unsigned gw_[4] = {gz.x, gz.y, gz.z, gz.w}; float y[8];
#pragma unroll
                    for (int j = 0; j < 8; ++j) { const float gg = bf2f((gw_[j >> 1] >> (16 * (j & 1))) & 0xffffu); y[j] = ov[j] * rs * a.in[15][v8 + j] * (gg * sigmoidf_(gg)); }
                    v4u o; o.x = pk2(y[0], y[1]); o.y = pk2(y[2], y[3]); o.z = pk2(y[4], y[5]); o.w = pk2(y[6], y[7]); *(v4u*)(MIX + (size_t)orow * DM + h * 128 + v8) = o; }
            }
        }
        __syncthreads();
    }
#undef HG_WRITE_ST
    if (PROMPT) {
        float* ut = (float*)(a.ws + WS_HUT) + (size_t)unit * 16384;
#pragma unroll
        for (int g4 = 0; g4 < 4; ++g4) { const int k0 = 32 * kt + 8 * g4 + 4 * hh;
            *(f32x4*)(ut + (32 * vt0 + r32) * 128 + k0) = (f32x4){S0[4 * g4], S0[4 * g4 + 1], S0[4 * g4 + 2], S0[4 * g4 + 3]};
            *(f32x4*)(ut + (32 * (vt0 + 1) + r32) * 128 + k0) = (f32x4){S1[4 * g4], S1[4 * g4 + 1], S1[4 * g4 + 2], S1[4 * g4 + 3]}; }
        if (tid < 128) ((float*)(a.ws + WS_HDG))[(size_t)unit * 128 + tid] = __expf(BOFF[tid]);
    } else {
        float* so = a.out + O_HS + (size_t)(b * 6 + h) * 16384;
#pragma unroll
        for (int r = 0; r < 16; ++r) { const int k = 32 * kt + crow(r, hh); so[k * 128 + 32 * vt0 + r32] = S0[r]; so[k * 128 + 32 * (vt0 + 1) + r32] = S1[r]; }
    }
}
__device__ __forceinline__ void hgrn_scan(Ctx& c, ARGREF a) {
    const float* UT = (const float*)(a.ws + WS_HUT); const float* DG = (const float*)(a.ws + WS_HDG); bf16* STo = (bf16*)(a.ws + WS_HST);
    for (int idx = c.vcu * 512 + c.tid; idx < 24 * 16384; idx += c.G * 512) {
        const int bh = idx >> 14, e = idx & 16383, k = e & 127, v = e >> 7;
        float s = 0.f, ut[HG_NG], dg[HG_NG];
#pragma unroll
        for (int g = 0; g < HG_NG; ++g) { const size_t u = (size_t)(bh * HG_NG + g); ut[g] = UT[u * 16384 + e]; dg[g] = DG[u * 128 + k]; }
#pragma unroll
        for (int g = 0; g < HG_NG; ++g) { const size_t u = (size_t)(bh * HG_NG + g); STo[u * 16384 + e] = (bf16)f2bf(s); s = dg[g] * s + ut[g]; }
        a.out[O_HP + (size_t)bh * 16384 + k * 128 + v] = s;
    }
}
__device__ __forceinline__ void hgrn_fix_unit(Ctx& c, ARGREF a, int b, int h, int g) {
    LAS bf16* STt = (LAS bf16*)(c.lds);
    LAS bf16* QCl = (LAS bf16*)(c.lds + 34816);
    LAS float* OB = (LAS float*)(c.lds + 34816 + 17408);
    int tid = c.tid; asm volatile("" : "+v"(tid));
    const int lane = tid & 63, w = c.wave, r32 = lane & 31, hh = lane >> 5;
    const int unit = (b * 6 + h) * HG_NG + g, row0 = b * SEQ + g * 128;
    const bf16* Z = (const bf16*)(a.ws + WS_Z); bf16* MIX = (bf16*)(a.ws + WS_MIX);
    const bf16* QC = (const bf16*)(a.ws + WS_HQC); const float* OL = (const float*)(a.ws + WS_HOL);
    const bf16* stg = (const bf16*)(a.ws + WS_HST) + (size_t)unit * 16384;
    __syncthreads();
#pragma unroll
    for (int i = 0; i < 4; ++i) { const int cidx = tid + 512 * i, v = cidx >> 4, kc = (cidx & 15) * 8; *(LAS v4u*)(STt + v * 136 + kc) = *(const v4u*)(stg + v * 128 + kc); }
    const int te = tid >> 4, k8 = (tid & 15) * 8;
    float onv[8];
#pragma unroll
    for (int j = 0; j < 8; ++j) onv[j] = a.in[15][k8 + j];
#pragma unroll 1
    for (int hf = 0; hf < 2; ++hf) {
        const int rb = row0 + hf * 64;
#pragma unroll
        for (int i = 0; i < 2; ++i) { const int cidx = tid + 512 * i, r = cidx >> 4, kc = (cidx & 15) * 8; *(LAS v4u*)(QCl + r * 136 + kc) = *(const v4u*)(QC + (size_t)(rb + r) * 768 + h * 128 + kc); }
        f32x4 pl0[2], pl1[2]; v4u pgz[2];
#pragma unroll
        for (int ps = 0; ps < 2; ++ps) { const int row = rb + ps * 32 + te; const float* ol = OL + (size_t)row * 768 + h * 128 + k8; pl0[ps] = *(const f32x4*)ol; pl1[ps] = *(const f32x4*)(ol + 4);
            pgz[ps] = *(const v4u*)(Z + (size_t)row * ZC0 + 2304 + h * 128 + k8); }
        __syncthreads();
        { const int rt = w >> 2, vt = w & 3; f32x16 o = {};
          o = mm32<128>(QCl + (rt * 32) * 136, 136, STt + (vt * 32) * 136, 136, o, lane);
#pragma unroll
          for (int r = 0; r < 16; ++r) OB[(rt * 32 + crow(r, hh)) * 128 + vt * 32 + r32] = o[r]; }
        __syncthreads();
#pragma unroll
        for (int ps = 0; ps < 2; ++ps) { const int r = ps * 32 + te, row = rb + r;
            const f32x4 c0 = *(const LAS f32x4*)(OB + r * 128 + k8), c1 = *(const LAS f32x4*)(OB + r * 128 + k8 + 4);
            const f32x4 l0 = pl0[ps], l1 = pl1[ps]; const v4u gz = pgz[ps];
            float ov[8] = {c0.x + l0.x, c0.y + l0.y, c0.z + l0.z, c0.w + l0.w, c1.x + l1.x, c1.y + l1.y, c1.z + l1.z, c1.w + l1.w}; float s = 0.f;
#pragma unroll
            for (int j = 0; j < 8; ++j) s += ov[j] * ov[j];
            s += __shfl_xor(s, 1); s += __shfl_xor(s, 2); s += __shfl_xor(s, 4); s += __shfl_xor(s, 8);
            const float rs = rsqrtf(s * (1.0f / 128.0f) + EPS);
            const unsigned gw_[4] = {gz.x, gz.y, gz.z, gz.w}; float y[8];
#pragma unroll
            for (int j = 0; j < 8; ++j) { const float gg = bf2f((gw_[j >> 1] >> (16 * (j & 1))) & 0xffffu); y[j] = ov[j] * rs * onv[j] * (gg * sigmoidf_(gg)); }
            v4u o; o.x = pk2(y[0], y[1]); o.y = pk2(y[2], y[3]); o.z = pk2(y[4], y[5]); o.w = pk2(y[6], y[7]); *(v4u*)(MIX + (size_t)row * DM + h * 128 + k8) = o; }
        __syncthreads();
    }
}

__device__ __forceinline__ void memkv_finalize_row(ARGREF a, int layer, int row, int lane) {
    const float* src = (const float*)(a.ws + WS_MEMKV) + (size_t)row * 1024 + layer * 512;
    const int hd = lane >> 4, d4 = (lane & 15) * 4;
    const f32x4 k = *(const f32x4*)(src + hd * 64 + d4), v = *(const f32x4*)(src + 256 + hd * 64 + d4);
    float s = (k.x * k.x + k.y * k.y) + (k.z * k.z + k.w * k.w);
    s += __shfl_xor(s, 1); s += __shfl_xor(s, 2); s += __shfl_xor(s, 4); s += __shfl_xor(s, 8);
    const float rs = rsqrtf(s * (1.0f / 64.0f) + EPS); const f32x4 g = *(const f32x4*)(a.in[22] + layer * 64 + d4);
    *(f32x4*)(a.out + O_MK + ((size_t)layer * 1024 + row) * 256 + hd * 64 + d4) = k * rs * g;
    *(f32x4*)(a.out + O_MV + ((size_t)layer * 1024 + row) * 256 + hd * 64 + d4) = v;
}

__device__ __forceinline__ void memattn_prompt_unit(Ctx& c, ARGREF a, int layer, int u) {
    const int blk = u & 15, hd = (u >> 4) & 3, b = u >> 6;
    const bf16* Z = (const bf16*)(a.ws + WS_Z); const int ldz = layer ? ZC1 : ZC0, qc = layer ? Z1_MQ : 3072;
    const float* kv = (const float*)(a.ws + WS_MEMKV) + (size_t)(b * 256) * 1024 + layer * 512 + hd * 64;
    const int row0 = b * SEQ + blk * 256;
    memattn_unit(c, Z + (size_t)row0 * ldz + qc + hd * 64, ldz, 256, kv, kv + 256, 1024, true, a.in[22] + layer * 64, a.in[21] + layer * 64,
                 (bf16*)(a.ws + WS_MIX) + (size_t)row0 * DM + 768 + hd * 64);
}
__device__ __forceinline__ void memattn_sample_unit(Ctx& c, ARGREF a, int layer, int u) {
    const int hd = u & 3, sb = u >> 2;
    const bf16* Z = (const bf16*)(a.ws + WS_Z); const int ldz = layer ? ZC1 : ZC0, qc = layer ? Z1_MQ : 3072;
    const size_t off = ((size_t)(layer * 32 + sb) * 256) * 256 + hd * 64;
    const int row0 = MP + sb * 4;
    memattn_unit(c, Z + (size_t)row0 * ldz + qc + hd * 64, ldz, 4, a.in[5] + off, a.in[6] + off, 256, false, nullptr, a.in[21] + layer * 64,
                 (bf16*)(a.ws + WS_MIX) + (size_t)row0 * DM + 768 + hd * 64);
}

__device__ __forceinline__ void p2_mixer0(Ctx& c, ARGREF a) {
    constexpr int U_HP = 24 * HG_NG, U_MAP = U_HP + 256, U_HS = U_MAP + 192, U_MAS = U_HS + 128, U_FIN = U_MAS + 256;
    for (;;) {
        const int u = q_next(c, 0);
        if (u >= U_FIN) break;
        if (u < U_HP) hgrn_unit<true>(c, a, u / (6 * HG_NG), (u / HG_NG) % 6, u % HG_NG);
        else if (u < U_MAP) memattn_prompt_unit(c, a, 0, u - U_HP);
        else if (u < U_HS) { const int v = u - U_MAP; hgrn_unit<false>(c, a, v / 6, v % 6, 0); }
        else if (u < U_MAS) memattn_sample_unit(c, a, 0, u - U_HS);
        else { const int v = (u - U_MAS) * 8 + c.wave; memkv_finalize_row(a, v >> 10, v & 1023, c.lane); }
    }
}
__device__ __forceinline__ void p2c_hgrn_fix(Ctx& c, ARGREF a) {
    for (int u = c.vcu; u < 24 * HG_NG; u += c.G) hgrn_fix_unit(c, a, u / (6 * HG_NG), (u / HG_NG) % 6, u % HG_NG);
}

constexpr size_t WS_G4 = WS_UP + 64 * MiB, WS_UP2 = WS_UP + 80 * MiB;
__device__ __forceinline__ void conv_fixup_tile(Ctx& c, ARGREF a, int layer, int pm) {
    const float* G4 = (const float*)(a.ws + WS_G4); const float* UP2 = (const float*)(a.ws + WS_UP2); bf16* ACT = (bf16*)(a.ws + WS_ACT);
    const float* cw = a.in[26] + (size_t)layer * 3 * DFF; const float* cb = a.in[27] + (size_t)layer * DFF;
    for (int idx = c.tid; idx < 8 * (DFF / 4); idx += 512) {
        const int rr = idx / (DFF / 4), c4 = (idx - rr * (DFF / 4)) * 4;
        const int slab = 4 * pm + (rr >> 1), fr = rr & 1, row = slab * 64 + fr, t = row & 4095, sl1 = slab > 0 ? slab - 1 : 0;
        const f32x4 ut = *(const f32x4*)(G4 + (size_t)(slab * 4 + fr) * DFF + c4), up = *(const f32x4*)(UP2 + (size_t)(slab * 2 + fr) * DFF + c4);
        const f32x4 a0 = *(const f32x4*)(G4 + (size_t)(slab * 4 + 0) * DFF + c4), b3 = *(const f32x4*)(G4 + (size_t)(sl1 * 4 + 3) * DFF + c4), b2 = *(const f32x4*)(G4 + (size_t)(sl1 * 4 + 2) * DFF + c4);
        f32x4 u1, u2;
        { const bool f1 = fr == 1, t0 = t == 0, t1 = t == 1;
          u1.x = f1 ? a0.x : (t0 ? 0.f : b3.x); u1.y = f1 ? a0.y : (t0 ? 0.f : b3.y); u1.z = f1 ? a0.z : (t0 ? 0.f : b3.z); u1.w = f1 ? a0.w : (t0 ? 0.f : b3.w);
          u2.x = f1 ? (t1 ? 0.f : b3.x) : (t0 ? 0.f : b2.x); u2.y = f1 ? (t1 ? 0.f : b3.y) : (t0 ? 0.f : b2.y); u2.z = f1 ? (t1 ? 0.f : b3.z) : (t0 ? 0.f : b2.z); u2.w = f1 ? (t1 ? 0.f : b3.w) : (t0 ? 0.f : b2.w); }
        const f32x4 w0 = *(const f32x4*)(cw + c4), w1 = *(const f32x4*)(cw + DFF + c4), w2 = *(const f32x4*)(cw + 2 * DFF + c4), bb = *(const f32x4*)(cb + c4);
        const f32x4 cv = bb + w0 * u2 + w1 * u1 + w2 * ut;
        const float y0 = cv.x * sigmoidf_(cv.x) * up.x, y1 = cv.y * sigmoidf_(cv.y) * up.y, y2 = cv.z * sigmoidf_(cv.z) * up.z, y3 = cv.w * sigmoidf_(cv.w) * up.w;
        *(u64*)(ACT + (size_t)row * DFF + c4) = (u64)pk2(y0, y1) | ((u64)pk2(y2, y3) << 32);
    }
}


struct SgArgs { const bf16* A; const bf16* Bt; int K; int mode; bf16* Z; int ldz; const float* ssin; const float* resid; const bf16* rb; float* y; bf16* xb; float* ssout; bf16* ACT; float* cvs; const float* cst; const float* cw; const float* cb; };
__device__ __forceinline__ void sgemm_unit(Ctx& c, const SgArgs& g, int n0) {
    int tid = c.tid; asm volatile("" : "+v"(tid));
    const int lane = tid & 63, w = c.wave, r32 = lane & 31, hh = lane >> 5;
    const int K = g.K, ks = K >> 3;
    const int f2 = (n0 >> 1) + (r32 & 15), brow = g.mode == 2 ? (f2 >> 7) * 256 + (f2 & 127) + (r32 >= 16 ? 128 : 0) : n0 + r32;
    const bf16* bp = g.Bt + (size_t)brow * K + w * ks + 8 * hh;
    const bf16* ap = g.A + (size_t)r32 * K + w * ks + 8 * hh;
    f32x16 acc[4] = {};
    bf16x8 afA[4][2], bfA[2], afB[4][2], bfB[2];
#define SG_LOAD(AF, BF, kk) do { _Pragma("unroll") for (int i = 0; i < 2; ++i) { BF[i] = *(const bf16x8*)(bp + (kk) + 16 * i); \
        _Pragma("unroll") for (int rt = 0; rt < 4; ++rt) AF[rt][i] = *(const bf16x8*)(ap + (size_t)(rt * 32) * K + (kk) + 16 * i); } } while (0)
#define SG_MMA(AF, BF) do { _Pragma("unroll") for (int i = 0; i < 2; ++i) _Pragma("unroll") for (int rt = 0; rt < 4; ++rt) acc[rt] = __builtin_amdgcn_mfma_f32_32x32x16_bf16(AF[rt][i], BF[i], acc[rt], 0, 0, 0); } while (0)
    SG_LOAD(afA, bfA, 0);
#pragma unroll 1
    for (int k = 0; k < ks; k += 64) {
        if (k + 32 < ks) SG_LOAD(afB, bfB, k + 32);
        SG_MMA(afA, bfA);
        if (k + 32 < ks) { if (k + 64 < ks) SG_LOAD(afA, bfA, k + 64); SG_MMA(afB, bfB); }
    }
#undef SG_LOAD
#undef SG_MMA
    LAS float* RED = (LAS float*)(c.lds);
    __syncthreads();
#pragma unroll
    for (int rt = 0; rt < 4; ++rt)
#pragma unroll
        for (int r = 0; r < 16; ++r) RED[((w * 4 + rt) * 16 + r) * 64 + lane] = acc[rt][r];
    __syncthreads();
    const int rt = w & 3, rh = w >> 2, col = n0 + r32;
    float v[8];
#pragma unroll
    for (int i = 0; i < 8; ++i) { float s = 0.f;
#pragma unroll
        for (int ww = 0; ww < 8; ++ww) s += RED[((ww * 4 + rt) * 16 + 8 * rh + i) * 64 + lane];
        v[i] = s; }
    if (g.mode == 0) {
#pragma unroll
        for (int i = 0; i < 8; ++i) { const int row = MP + rt * 32 + crow(8 * rh + i, hh); const float rs = rsqrtf(g.ssin[row] * (1.0f / DM) + EPS); g.Z[(size_t)row * g.ldz + col] = (bf16)f2bf(v[i] * rs); }
    } else if (g.mode == 1) {
#pragma unroll
        for (int i = 0; i < 8; ++i) { const int lr = rt * 32 + crow(8 * rh + i, hh), row = MP + lr;
            const float x = v[i] + (g.resid ? g.resid[(size_t)lr * DM + col] : bf2f(g.rb[(size_t)row * DM + col]));
            if (g.y) g.y[(size_t)lr * DM + col] = x; if (g.xb) g.xb[(size_t)row * DM + col] = (bf16)f2bf(x);
            float s = x * x; s += __shfl_xor(s, 1); s += __shfl_xor(s, 2); s += __shfl_xor(s, 4); s += __shfl_xor(s, 8); s += __shfl_xor(s, 16);
            if (g.ssout && r32 == 0) atomicAdd(g.ssout + row, s); }
    } else {
        float gu[8], upv[8];
#pragma unroll
        for (int i = 0; i < 8; ++i) { const int row = MP + rt * 32 + crow(8 * rh + i, hh); gu[i] = v[i] * rsqrtf(g.ssin[row] * (1.0f / DM) + EPS); upv[i] = __shfl_xor(gu[i], 16); }
        if (r32 < 16) { const float w0 = g.cw[f2], w1 = g.cw[DFF + f2], w2 = g.cw[2 * DFF + f2], bb = g.cb[f2];
#pragma unroll
            for (int aa = 0; aa < 2; ++aa) { const int lr0 = rt * 32 + 8 * (2 * rh + aa) + 4 * hh, sb = lr0 >> 2;
                const float s0 = g.cst[(size_t)(sb * 2) * DFF + f2], s1 = g.cst[(size_t)(sb * 2 + 1) * DFF + f2];
                const float u0 = gu[4 * aa], u1 = gu[4 * aa + 1], u2 = gu[4 * aa + 2], u3 = gu[4 * aa + 3];
                const float cv[4] = {bb + w0 * s0 + w1 * s1 + w2 * u0, bb + w0 * s1 + w1 * u0 + w2 * u1, bb + w0 * u0 + w1 * u1 + w2 * u2, bb + w0 * u1 + w1 * u2 + w2 * u3};
#pragma unroll
                for (int t = 0; t < 4; ++t) g.ACT[(size_t)(MP + lr0 + t) * DFF + f2] = (bf16)f2bf(cv[t] * sigmoidf_(cv[t]) * upv[4 * aa + t]);
                g.cvs[(size_t)(sb * 2) * DFF + f2] = u2; g.cvs[(size_t)(sb * 2 + 1) * DFF + f2] = u3; } }
    }
}
__device__ __forceinline__ void sgemm_phase(Ctx& c, const SgArgs& g, int N) {
#pragma unroll 1
    for (int u = c.G - 1 - (int)blockIdx.x; u < N / 32; u += c.G) sgemm_unit(c, g, u * 32);
}


__device__ __forceinline__ float wave_sum_f(float x) {
    x += __builtin_bit_cast(float, __builtin_amdgcn_update_dpp(0, __builtin_bit_cast(int, x), 0xB1, 0xF, 0xF, false));
    x += __builtin_bit_cast(float, __builtin_amdgcn_update_dpp(0, __builtin_bit_cast(int, x), 0x4E, 0xF, 0xF, false));
    x += __builtin_bit_cast(float, __builtin_amdgcn_update_dpp(0, __builtin_bit_cast(int, x), 0x141, 0xF, 0xF, false));
    x += __builtin_bit_cast(float, __builtin_amdgcn_update_dpp(0, __builtin_bit_cast(int, x), 0x140, 0xF, 0xF, false));
    const int xi = __builtin_bit_cast(int, x);
    return (__builtin_bit_cast(float, __builtin_amdgcn_readlane(xi, 0)) + __builtin_bit_cast(float, __builtin_amdgcn_readlane(xi, 16))) +
           (__builtin_bit_cast(float, __builtin_amdgcn_readlane(xi, 32)) + __builtin_bit_cast(float, __builtin_amdgcn_readlane(xi, 48)));
}
__device__ __forceinline__ void dsa_post_row(ARGREF a, int row, int lane_) {
    int lane = lane_; asm volatile("" : "+v"(lane));
    const bf16* z = (const bf16*)(a.ws + WS_Z) + (size_t)row * ZC1;
    const bool smp = row >= MP; const int b = smp ? (row - MP) >> 2 : row >> 12, t = smp ? (row - MP) & 3 : row & 4095;
    const float pos = (float)(smp ? PAST + t : t);
    const int i = lane & 31;
    float x1[8], x2[8], q1[4], q2[4], k1 = 0.f, k2 = 0.f;
#pragma unroll
    for (int hd = 0; hd < 8; ++hd) { x1[hd] = bf2f(z[hd * 128 + lane]); x2[hd] = bf2f(z[hd * 128 + 64 + lane]); }
    const u64 vv = *(const u64*)(z + Z1_V + 4 * lane);
#pragma unroll
    for (int p = 0; p < 4; ++p) { const int hd = 2 * p + (lane >> 5); q1[p] = bf2f(z[Z1_IQ + hd * 64 + i]); q2[p] = bf2f(z[Z1_IQ + hd * 64 + 32 + i]); }
    if (lane < 32) { k1 = bf2f(z[Z1_IK + i]); k2 = bf2f(z[Z1_IK + 32 + i]); }
    const float wraw = bf2f(z[Z1_IW + (lane & 7)]);
    float c128, s128, c64, s64;
    { const float r1 = pos * (exp2f(-(float)lane * (13.287712379549449f / 64.0f)) * 0.15915494309189535f), f1 = r1 - floorf(r1); s128 = __builtin_amdgcn_sinf(f1); c128 = __builtin_amdgcn_cosf(f1);
      const float r2 = pos * (exp2f(-(float)i * (13.287712379549449f / 32.0f)) * 0.15915494309189535f), f2 = r2 - floorf(r2); s64 = __builtin_amdgcn_sinf(f2); c64 = __builtin_amdgcn_cosf(f2); }
#pragma unroll
    for (int hd = 0; hd < 8; ++hd) {
        const float rs = rsqrtf(wave_sum_f(x1[hd] * x1[hd] + x2[hd] * x2[hd]) * (1.0f / 128.0f) + EPS);
        const float* gn = hd < 6 ? a.in[17] : a.in[18];
        const float y1 = x1[hd] * rs * gn[lane], y2 = x2[hd] * rs * gn[64 + lane];
        const float o1 = y1 * c128 - y2 * s128, o2 = y2 * c128 + y1 * s128;
        if (hd < 6) {
            if (smp) { float* q = (float*)(a.ws + WS_SQ) + (size_t)(row - MP) * 768 + hd * 128; q[lane] = o1; q[64 + lane] = o2; }
            else { bf16* q = (bf16*)(a.ws + WS_QB) + ((size_t)(b * 6 + hd) * SEQ + t) * 128; q[lane] = (bf16)f2bf(o1); q[64 + lane] = (bf16)f2bf(o2); }
        } else {
            const int kvh = hd - 6;
            float* ko = smp ? a.out + O_KS + (size_t)(row - MP) * 256 + kvh * 128 : a.out + O_KP + (size_t)row * 256 + kvh * 128;
            ko[lane] = o1; ko[64 + lane] = o2;
            if (!smp) { bf16* kb = (bf16*)(a.ws + WS_KB) + ((size_t)(b * 2 + kvh) * SEQ + t) * 128; kb[lane] = (bf16)f2bf(o1); kb[64 + lane] = (bf16)f2bf(o2); }
        }
    }
    {
        const f32x4 v = {bf2f((unsigned)vv & 0xffffu), bf2f(((unsigned)vv) >> 16), bf2f((unsigned)(vv >> 32) & 0xffffu), bf2f((unsigned)(vv >> 48))};
        float* vo = smp ? a.out + O_VS + (size_t)(row - MP) * 256 : a.out + O_VP + (size_t)row * 256;
        *(f32x4*)(vo + 4 * lane) = v;
        if (!smp) { const int kvh = lane >> 5, d = (lane & 31) * 4; *(u64*)((bf16*)(a.ws + WS_VB) + ((size_t)(b * 2 + kvh) * SEQ + t) * 128 + d) = vv; }
    }
    {
#pragma unroll
        for (int p = 0; p < 4; ++p) { const int hd = 2 * p + (lane >> 5);
            const float o1 = q1[p] * c64 - q2[p] * s64, o2 = q2[p] * c64 + q1[p] * s64;
            if (smp) { float* q = (float*)(a.ws + WS_SIQ) + (size_t)(row - MP) * 512 + hd * 64; q[i] = o1; q[32 + i] = o2; }
            else { bf16* q = (bf16*)(a.ws + WS_IQB) + (size_t)row * 512 + hd * 64; q[i] = (bf16)f2bf(o1); q[32 + i] = (bf16)f2bf(o2); } }
        const float rs = rsqrtf(wave_sum_f(k1 * k1 + k2 * k2) * (1.0f / 64.0f) + EPS);
        const float y1 = k1 * rs * a.in[19][i], y2 = k2 * rs * a.in[19][32 + i];
        const float o1 = y1 * c64 - y2 * s64, o2 = y2 * c64 + y1 * s64;
        if (lane < 32) {
            float* ko = smp ? a.out + O_IKS + (size_t)(row - MP) * 64 : a.out + O_IKP + (size_t)row * 64; ko[i] = o1; ko[32 + i] = o2;
            if (!smp) { bf16* kb = (bf16*)(a.ws + WS_IKB) + (size_t)row * 64; kb[i] = (bf16)f2bf(o1); kb[32 + i] = (bf16)f2bf(o2); } }
        if (lane < 8) { const float wv = wraw * (0.35355339059327373f * 0.125f);
            if (smp) ((float*)(a.ws + WS_SIW))[(row - MP) * 8 + lane] = wv; else ((float*)(a.ws + WS_IW))[(size_t)row * 8 + lane] = wv; }
    }
}
__device__ __forceinline__ void p8_dsa_post(Ctx& c, ARGREF a) {
    constexpr int NRB = (MVALID + 63) / 64;
    for (;;) { const int u = q_next(c, 1); if (u >= 384 + NRB) break;
        if (u < 256) memattn_prompt_unit(c, a, 1, u);
        else if (u < 256 + NRB) { const int r0 = (u - 256) * 64 + c.wave;
#pragma unroll 1
            for (int i = 0; i < 8; ++i) { const int row = r0 + 8 * i; if (row < MVALID) dsa_post_row(a, row, c.lane); } }
        else memattn_sample_unit(c, a, 1, u - 256 - NRB); }
}

__device__ __forceinline__ void idx_prompt_unit(Ctx& c, ARGREF a, int b, int qb) {
    int tid = c.tid; asm volatile("" : "+v"(tid));
    const int lane = tid & 63, r32 = lane & 31, hh = lane >> 5, w = c.wave;
    const int q0 = b * SEQ + qb * 32;
    LAS bf16* IQL = (LAS bf16*)(c.lds);
    { const bf16* src = (const bf16*)(a.ws + WS_IQB) + (size_t)q0 * 512;
#pragma unroll
      for (int i = 0; i < 4; ++i) { const int row = tid >> 4, ch = (tid & 15) + 16 * i; *(LAS v4u*)(IQL + row * 520 + ch * 8) = *(const v4u*)(src + (size_t)row * 512 + ch * 8); } }
    __syncthreads();
    const bf16* IK = (const bf16*)(a.ws + WS_IKB) + (size_t)(b * SEQ) * 64 + (size_t)r32 * 64 + 8 * hh;
    float* SC = (float*)(a.ws + WS_SC) + (size_t)(q0 + r32) * SEQ;
    float wv[8];
#pragma unroll
    for (int h = 0; h < 8; ++h) wv[h] = ((const float*)(a.ws + WS_IW))[(size_t)(q0 + r32) * 8 + h];
    bf16x8 ak[4], an[4];
    if (w <= qb) {
#pragma unroll
        for (int ks = 0; ks < 4; ++ks) ak[ks] = *(const bf16x8*)(IK + (size_t)(w * 32) * 64 + ks * 16); }
#pragma unroll 1
    for (int kt = w; kt <= qb; kt += 8) {
        if (kt + 8 <= qb) {
#pragma unroll
            for (int ks = 0; ks < 4; ++ks) an[ks] = *(const bf16x8*)(IK + (size_t)((kt + 8) * 32) * 64 + ks * 16); }
        f32x16 sc = {};
        int qoff = r32 * 520 + 8 * hh; asm volatile("" : "+v"(qoff));
#pragma unroll
        for (int h = 0; h < 8; ++h) { f32x16 d = {};
#pragma unroll
            for (int ks = 0; ks < 4; ++ks) d = __builtin_amdgcn_mfma_f32_32x32x16_bf16(ak[ks], *(const LAS bf16x8*)(IQL + qoff + h * 64 + ks * 16), d, 0, 0, 0);
#pragma unroll
            for (int r = 0; r < 16; ++r) sc[r] = fmaf(wv[h], fmaxf(d[r], 0.f), sc[r]); }
#pragma unroll
        for (int g = 0; g < 4; ++g) *(f32x4*)(SC + kt * 32 + 8 * g + 4 * hh) = (f32x4){sc[4 * g], sc[4 * g + 1], sc[4 * g + 2], sc[4 * g + 3]};
#pragma unroll
        for (int ks = 0; ks < 4; ++ks) ak[ks] = an[ks];
    }
}
__device__ __forceinline__ v4u pack8f(const float* p) { const f32x4 x = *(const f32x4*)p, y = *(const f32x4*)(p + 4); v4u o; o.x = pk2(x.x, x.y); o.y = pk2(x.z, x.w); o.z = pk2(y.x, y.y); o.w = pk2(y.z, y.w); return o; }
__device__ __forceinline__ void idx_sample_tile(ARGREF a, int sb, int tl, int lane_) {
    int lane = lane_; asm volatile("" : "+v"(lane));
    const int r32 = lane & 31, hh = lane >> 5, tk = r32 >> 3, hd = r32 & 7;
    const float* iq = (const float*)(a.ws + WS_SIQ) + (size_t)(sb * 4 + tk) * 512 + hd * 64 + 8 * hh;
    const float wv = ((const float*)(a.ws + WS_SIW))[(sb * 4 + tk) * 8 + hd];
    const float* src;
    if (tl < 256) src = a.in[4] + ((size_t)a.page_table[sb * 64 + (tl >> 2)] * 128 + (tl & 3) * 32 + r32) * 64 + 8 * hh;
    else src = a.out + O_IKS + (size_t)(sb * 4 + (r32 & 3)) * 64 + 8 * hh;
    v4u af[4], bf_[4];
#pragma unroll
    for (int ks = 0; ks < 4; ++ks) { af[ks] = pack8f(src + 16 * ks); bf_[ks] = pack8f(iq + 16 * ks); }
    if (tl == 256 && r32 >= 4) {
#pragma unroll
        for (int ks = 0; ks < 4; ++ks) af[ks] = (v4u){0u, 0u, 0u, 0u}; }
    f32x16 d = {};
#pragma unroll
    for (int ks = 0; ks < 4; ++ks) d = __builtin_amdgcn_mfma_f32_32x32x16_bf16(__builtin_bit_cast(bf16x8, af[ks]), __builtin_bit_cast(bf16x8, bf_[ks]), d, 0, 0, 0);
    float* dst = (float*)(a.ws + WS_SSC) + (size_t)(sb * 4 + tk) * SSC_LD + tl * 32;
#pragma unroll
    for (int r = 0; r < 16; ++r) { float v = wv * fmaxf(d[r], 0.f);
        v += __builtin_bit_cast(float, __builtin_amdgcn_update_dpp(0, __builtin_bit_cast(int, v), 0xB1, 0xF, 0xF, false));
        v += __builtin_bit_cast(float, __builtin_amdgcn_update_dpp(0, __builtin_bit_cast(int, v), 0x4E, 0xF, 0xF, false));
        v += __builtin_bit_cast(float, __builtin_amdgcn_update_dpp(0, __builtin_bit_cast(int, v), 0x141, 0xF, 0xF, false));
        if (hd == 0) dst[crow(r, hh)] = v; }
}
__device__ __forceinline__ void p9_indexer(Ctx& c, ARGREF a) {
    const int gw = c.vcu * NWAVES + c.wave, NGW = c.G * NWAVES;
#pragma unroll 1
    for (int wt = gw; wt < 32 * 257; wt += NGW) idx_sample_tile(a, wt / 257, wt % 257, c.lane);
    for (;;) { const int u = q_next(c, 2); if (u >= 512) break; idx_prompt_unit(c, a, u & 3, 127 - (u >> 2)); }
}


__device__ __forceinline__ unsigned fkey(float f) { const unsigned u = __builtin_bit_cast(unsigned, f + 0.0f); return (u & 0x80000000u) ? ~u : (u | 0x80000000u); }
__device__ __forceinline__ void acc_ge(int& cnt, unsigned key, unsigned cand) { asm volatile("v_cmp_le_u32_e32 vcc, %1, %2\n\tv_addc_co_u32_e32 %0, vcc, 0, %0, vcc" : "+v"(cnt) : "s"(cand), "v"(key) : "vcc"); }
__device__ __forceinline__ void acc_ge4(int& c0, int& c1, int& c2, int& c3, unsigned k0, unsigned k1, unsigned k2, unsigned k3, unsigned cand) {
    u64 m0, m1, m2, m3;
    asm volatile("v_cmp_le_u32_e64 %4, %8, %9\n\tv_cmp_le_u32_e64 %5, %8, %10\n\tv_cmp_le_u32_e64 %6, %8, %11\n\tv_cmp_le_u32_e64 %7, %8, %12\n\t"
                 "v_addc_co_u32_e64 %0, %4, 0, %0, %4\n\tv_addc_co_u32_e64 %1, %5, 0, %1, %5\n\tv_addc_co_u32_e64 %2, %6, 0, %2, %6\n\tv_addc_co_u32_e64 %3, %7, 0, %3, %7"
                 : "+v"(c0), "+v"(c1), "+v"(c2), "+v"(c3), "=&s"(m0), "=&s"(m1), "=&s"(m2), "=&s"(m3) : "s"(cand), "v"(k0), "v"(k1), "v"(k2), "v"(k3));
}
__device__ __forceinline__ u64 ballot_nz(unsigned v) { u64 m; asm volatile("v_cmp_ne_u32_e64 %0, 0, %1" : "=s"(m) : "v"(v)); return m; }
__device__ __forceinline__ int wave_sum_dpp(int x) {
    x += __builtin_amdgcn_update_dpp(0, x, 0xB1, 0xF, 0xF, false);
    x += __builtin_amdgcn_update_dpp(0, x, 0x4E, 0xF, 0xF, false);
    x += __builtin_amdgcn_update_dpp(0, x, 0x141, 0xF, 0xF, false);
    x += __builtin_amdgcn_update_dpp(0, x, 0x140, 0xF, 0xF, false);
    return (__builtin_amdgcn_readlane(x, 0) + __builtin_amdgcn_readlane(x, 16)) + (__builtin_amdgcn_readlane(x, 32) + __builtin_amdgcn_readlane(x, 48));
}
__device__ __forceinline__ int mbcnt64(u64 m) { return (int)__builtin_amdgcn_mbcnt_hi((unsigned)(m >> 32), __builtin_amdgcn_mbcnt_lo((unsigned)m, 0u)); }
constexpr int TK_LOWBITS = 18;
__device__ __forceinline__ void topk_finish(unsigned ck, int cp, int A, int posmax, unsigned& T, int& P) {
#pragma unroll 1
    for (int bit = TK_LOWBITS - 1; bit >= 0; --bit) { const unsigned cand = T | (1u << bit); if (A + __builtin_popcountll(__ballot(ck >= cand)) >= 256) T = cand; }
    const int need = 256 - (A + __builtin_popcountll(__ballot(ck > T))), ceq = __builtin_popcountll(__ballot(ck == T));
    P = posmax;
    if (ceq != need) { P = 0;
#pragma unroll 1
        for (int bit = 13; bit >= 0; --bit) { const int cand = P | (1 << bit); if (__builtin_popcountll(__ballot(ck == T && cp < cand)) < need) P = cand; } }
}
__device__ __forceinline__ unsigned wave_min_u(unsigned x) {
    x = min(x, (unsigned)__builtin_amdgcn_update_dpp(0, (int)x, 0xB1, 0xF, 0xF, false)); x = min(x, (unsigned)__builtin_amdgcn_update_dpp(0, (int)x, 0x4E, 0xF, 0xF, false));
    x = min(x, (unsigned)__builtin_amdgcn_update_dpp(0, (int)x, 0x141, 0xF, 0xF, false)); x = min(x, (unsigned)__builtin_amdgcn_update_dpp(0, (int)x, 0x140, 0xF, 0xF, false));
    return min(min((unsigned)__builtin_amdgcn_readlane((int)x, 0), (unsigned)__builtin_amdgcn_readlane((int)x, 16)), min((unsigned)__builtin_amdgcn_readlane((int)x, 32), (unsigned)__builtin_amdgcn_readlane((int)x, 48)));
}
__device__ __forceinline__ unsigned wave_max_u(unsigned x) {
    x = max(x, (unsigned)__builtin_amdgcn_update_dpp(0, (int)x, 0xB1, 0xF, 0xF, false)); x = max(x, (unsigned)__builtin_amdgcn_update_dpp(0, (int)x, 0x4E, 0xF, 0xF, false));
    x = max(x, (unsigned)__builtin_amdgcn_update_dpp(0, (int)x, 0x141, 0xF, 0xF, false)); x = max(x, (unsigned)__builtin_amdgcn_update_dpp(0, (int)x, 0x140, 0xF, 0xF, false));
    return max(max((unsigned)__builtin_amdgcn_readlane((int)x, 0), (unsigned)__builtin_amdgcn_readlane((int)x, 16)), max((unsigned)__builtin_amdgcn_readlane((int)x, 32), (unsigned)__builtin_amdgcn_readlane((int)x, 48)));
}
__device__ __forceinline__ void topk_prompt_rows(ARGREF a, int row0, int stride, int lane_, LAS unsigned* cl) {
    int lane = lane_; asm volatile("" : "+v"(lane));
    const float* SCb = (const float*)(a.ws + WS_SC);
#pragma unroll 1
    for (int row = row0; row < MP; row += stride) {
        const int t = row & 4095;
        u64* mk = (u64*)(a.ws + WS_MASK) + (size_t)row * 64;
        if (t < 256) { u64 myword = 0ull;
#pragma unroll 1
            for (int j = 0; j < 64; ++j) { const u64 m = __ballot(64 * j + lane <= t); if (lane == j) myword = m; }
            mk[lane] = myword;
            continue; }
        unsigned key[64];
        { const float* sc_ = SCb + (size_t)row * SEQ + lane; const int tj_ = t >> 6;
          float v[64];
#pragma unroll
          for (int j = 0; j < 64; ++j) v[j] = sc_[64 * (j < tj_ ? j : tj_)];
          int pj = lane;
#pragma unroll
          for (int j = 0; j < 64; ++j) { const int u = __builtin_bit_cast(int, v[j] + 0.0f); const unsigned k = (unsigned)u ^ ((unsigned)(u >> 31) | 0x80000000u); key[j] = (pj <= t) ? k : 0u; pj += 64; asm volatile("" : "+v"(pj)); } }
        unsigned kh[64];
#pragma unroll
        for (int j = 0; j < 64; ++j) { kh[j] = key[j] >> 1; asm volatile("" : "+v"(kh[j])); }
        unsigned T; int hb;
        {
            unsigned b0 = 0u, b1 = 0u, b2 = 0u, b3 = 0u;
#pragma unroll
            for (int j = 0; j < 64; ++j) { unsigned x = key[j]; const unsigned m0 = max(b0, x); x = min(b0, x); b0 = m0; const unsigned m1 = max(b1, x); x = min(b1, x); b1 = m1; const unsigned m2 = max(b2, x); x = min(b2, x); b2 = m2; b3 = max(b3, x); }
            const unsigned L = wave_min_u(b3), H = wave_max_u(b3), df = L ^ H;
            hb = df ? 31 - __builtin_clz(df) : -1;
            T = hb >= 31 ? 0u : (L & ~((2u << (hb < 0 ? 0 : hb)) - 1u)); if (hb < 0) T = L;
        }
#define TK_FULLCOUNT(CAND, OUT) do { const unsigned cs_ = __builtin_amdgcn_readfirstlane(CAND); int c0_ = 0, c1_ = 0, c2_ = 0, c3_ = 0; \
        _Pragma("unroll") for (int j = 0; j < 64; j += 4) acc_ge4(c0_, c1_, c2_, c3_, key[j], key[j + 1], key[j + 2], key[j + 3], cs_); OUT = wave_sum_dpp((c0_ + c1_) + (c2_ + c3_)); } while (0)
#define TK_FASTCOUNT(CAND, OUT) do { const unsigned ch_ = __builtin_amdgcn_readfirstlane((CAND) >> 1); unsigned a0_ = 0u, a1_ = 0u, a2_ = 0u, a3_ = 0u; \
        _Pragma("unroll") for (int j = 0; j < 64; j += 4) { a0_ = __builtin_amdgcn_alignbit(a0_, kh[j] - ch_, 31); a1_ = __builtin_amdgcn_alignbit(a1_, kh[j + 1] - ch_, 31); \
            a2_ = __builtin_amdgcn_alignbit(a2_, kh[j + 2] - ch_, 31); a3_ = __builtin_amdgcn_alignbit(a3_, kh[j + 3] - ch_, 31); } \
        OUT = 4096 - wave_sum_dpp((__builtin_popcount(a0_) + __builtin_popcount(a1_)) + (__builtin_popcount(a2_) + __builtin_popcount(a3_))); } while (0)
#pragma unroll 1
        for (int bit = hb; bit >= TK_LOWBITS; --bit) { const unsigned cand = T | (1u << bit); int tot; TK_FASTCOUNT(cand, tot); if (tot >= 256) T = cand; }
        const unsigned Tb = T & ~((1u << TK_LOWBITS) - 1u), hib = Tb + (1u << TK_LOWBITS);
        int A = 0, cT; if (hib != 0u) TK_FASTCOUNT(hib, A); TK_FASTCOUNT(Tb, cT);
#undef TK_FASTCOUNT
        int P;
        if (cT - A <= 64) {
            if (lane == 0) cl[128] = 0u;
            int pj = lane;
#pragma unroll
            for (int j = 0; j < 64; ++j) { if ((key[j] - Tb) < (1u << TK_LOWBITS)) { const unsigned pos = __hip_atomic_fetch_add(cl + 128, 1u, __ATOMIC_RELAXED, __HIP_MEMORY_SCOPE_WORKGROUP); if (pos < 64u) { cl[pos] = key[j]; cl[64 + pos] = (unsigned)pj; } }
                pj += 64; asm volatile("" : "+v"(pj)); }
            const int nund = cT - A;
            const unsigned ck = lane < nund ? cl[lane] : 0u; const int cp = (int)cl[64 + lane];
            topk_finish(ck, cp, A, 4095, T, P);
        } else {
#pragma unroll 1
            for (int bit = TK_LOWBITS - 1; bit >= 0; --bit) { const unsigned cand = T | (1u << bit); int tot; TK_FULLCOUNT(cand, tot); if (tot >= 256) T = cand; }
            int cge, cgt; TK_FULLCOUNT(T, cge); cgt = 0; if (T != 0xffffffffu) TK_FULLCOUNT(T + 1u, cgt);
            const int need = 256 - cgt, ceq = cge - cgt; P = 4095;
            if (ceq != need) { P = 0;
#pragma unroll 1
                for (int bit = 11; bit >= 0; --bit) { const int cand = P | (1 << bit); int cnt = 0; int pj = lane;
#pragma unroll
                    for (int j = 0; j < 64; ++j) { cnt += (key[j] == T && pj < cand) ? 1 : 0; pj += 64; asm volatile("" : "+v"(pj)); }
                    if (wave_sum_dpp(cnt) < need) P = cand; } }
        }
#undef TK_FULLCOUNT
        if (P != 4095) {
            int pq = lane;
#pragma unroll
            for (int j = 0; j < 64; ++j) { if (key[j] == T && pq > P) key[j] = 0u; pq += 64; asm volatile("" : "+v"(pq)); } }
        unsigned wlo = 0u, whi = 0u; const unsigned Ts = __builtin_amdgcn_readfirstlane(T);
#pragma unroll
        for (int j = 0; j < 64; ++j) asm volatile("v_cmp_le_u32_e32 vcc, %2, %3\n\ts_nop 3\n\tv_writelane_b32 %0, vcc_lo, %4\n\tv_writelane_b32 %1, vcc_hi, %4" : "+v"(wlo), "+v"(whi) : "s"(Ts), "v"(key[j]), "i"(j) : "vcc");
        mk[lane] = ((u64)whi << 32) | (u64)wlo;
    }
}
__device__ __forceinline__ void topk_sample_row(ARGREF a, int q, int lane_, LAS unsigned* K, LAS unsigned* cl) {
    int lane = lane_; asm volatile("" : "+v"(lane));
    const int t = q & 3, n = PAST + t + 1; const float* sc = (const float*)(a.ws + WS_SSC) + (size_t)q * SSC_LD;
    int* out = (int*)(a.ws + WS_SIDX) + q * 256;
    unsigned key[129];
#pragma unroll
    for (int j = 0; j < 129; ++j) { const float v = sc[64 * j + lane]; key[j] = (j < 128 || lane < n - 8192) ? fkey(v) : 0u; }
#pragma unroll
    for (int j = 0; j < 129; ++j) K[64 * j + lane] = key[j];
#define TK_FULLCOUNT(CAND, OUT) do { const unsigned cs_ = __builtin_amdgcn_readfirstlane(CAND); int c0_ = 0, c1_ = 0, c2_ = 0, c3_ = 0; \
        _Pragma("unroll") for (int j = 0; j < 128; j += 4) acc_ge4(c0_, c1_, c2_, c3_, key[j], key[j + 1], key[j + 2], key[j + 3], cs_); acc_ge(c0_, key[128], cs_); OUT = wave_sum_dpp((c0_ + c1_) + (c2_ + c3_)); } while (0)
    unsigned T = 0u;
#pragma unroll 1
    for (int bit = 31; bit >= TK_LOWBITS; --bit) { const unsigned cand = T | (1u << bit); int tot; TK_FULLCOUNT(cand, tot); if (tot >= 256) T = cand; }
    const unsigned hib = T + (1u << TK_LOWBITS);
    int A = 0, cT; if (hib != 0u) TK_FULLCOUNT(hib, A); TK_FULLCOUNT(T, cT);
    int P;
    if (cT - A <= 64) {
        int base = 0;
#pragma unroll 1
        for (int j0 = 0; j0 < 128; j0 += 8) { unsigned kk[8];
#pragma unroll
            for (int i = 0; i < 8; ++i) kk[i] = K[64 * (j0 + i) + lane];
#pragma unroll
            for (int i = 0; i < 8; ++i) { const unsigned und = (kk[i] - T) < (1u << TK_LOWBITS) ? 1u : 0u; const u64 m = ballot_nz(und); const int pos = base + mbcnt64(m);
                if (und) { cl[pos] = kk[i]; cl[64 + pos] = (unsigned)(64 * (j0 + i) + lane); }
                base += __builtin_popcountll(m); } }
        { const unsigned kj = K[64 * 128 + lane]; const unsigned und = (kj - T) < (1u << TK_LOWBITS) ? 1u : 0u; const u64 m = ballot_nz(und); const int pos = base + mbcnt64(m);
          if (und) { cl[pos] = kj; cl[64 + pos] = (unsigned)(64 * 128 + lane); } base += __builtin_popcountll(m); }
        const unsigned ck = lane < base ? cl[lane] : 0u; const int cp = (int)cl[64 + lane];
        topk_finish(ck, cp, A, 16383, T, P);
    } else {
#pragma unroll 1
        for (int bit = TK_LOWBITS - 1; bit >= 0; --bit) { const unsigned cand = T | (1u << bit); int tot; TK_FULLCOUNT(cand, tot); if (tot >= 256) T = cand; }
        int cge, cgt; TK_FULLCOUNT(T, cge); cgt = 0; if (T != 0xffffffffu) TK_FULLCOUNT(T + 1u, cgt);
        const int need = 256 - cgt, ceq = cge - cgt; P = 16383;
        if (ceq != need) { P = 0;
#pragma unroll 1
            for (int bit = 13; bit >= 0; --bit) { const int cand = P | (1 << bit); int cnt = 0;
#pragma unroll 4
                for (int j = 0; j < 129; ++j) cnt += (K[64 * j + lane] == T && 64 * j + lane < cand) ? 1 : 0;
                if (wave_sum_dpp(cnt) < need) P = cand; } }
    }
#undef TK_FULLCOUNT
    int base = 0;
#pragma unroll 1
    for (int j0 = 0; j0 < 136; j0 += 8) { unsigned kk[8];
#pragma unroll
        for (int i = 0; i < 8; ++i) kk[i] = (j0 + i < 129) ? K[64 * (j0 + i) + lane] : 0u;
#pragma unroll
        for (int i = 0; i < 8; ++i) { const int ps = 64 * (j0 + i) + lane; const unsigned selv = (kk[i] > T || (kk[i] == T && ps <= P)) ? 1u : 0u; const u64 m = ballot_nz(selv);
            const int pos = base + mbcnt64(m);
            if (selv && pos < 256) out[pos] = ps;
            base += __builtin_popcountll(m); } }
}
__device__ __forceinline__ void p10_topk(Ctx& c, ARGREF a) {
    const int gw = c.vcu * NWAVES + c.wave, NGW = c.G * NWAVES;
    LAS unsigned* cl = (LAS unsigned*)(c.lds) + c.wave * 192;
    if (c.wave == 0 && c.vcu < MS) topk_sample_row(a, c.vcu, c.lane, (LAS unsigned*)(c.lds + 8192), cl);
    topk_prompt_rows(a, gw, NGW, c.lane, cl);
}


__device__ __forceinline__ void attn_sample_unit(Ctx& c, ARGREF a, int sb, int t) {
    LAS bf16* KV = (LAS bf16*)(c.lds);
    LAS float* QL = (LAS float*)(c.lds + 69632);
    LAS float* SL = (LAS float*)(c.lds + 69632 + 3072);
    LAS float* OL = (LAS float*)(c.lds + 69632 + 6144);
    LAS int* IL = (LAS int*)(c.lds + 69632 + 12288);
    LAS unsigned* OFFL = (LAS unsigned*)(c.lds + 69632 + 12288 + 1024);
    int tid = c.tid; asm volatile("" : "+v"(tid));
    const int lane = tid & 63, w = c.wave, q = sb * 4 + t;
    __syncthreads();
    if (tid < 256) IL[tid] = ((const int*)(a.ws + WS_SIDX))[q * 256 + tid];
    for (int i = tid; i < 768; i += 512) QL[i] = ((const float*)(a.ws + WS_SQ))[(size_t)q * 768 + i];
    __syncthreads();
    if (tid < 256) { const int idx = IL[tid];
        OFFL[tid] = idx < PAST ? (unsigned)(((a.page_table[sb * 64 + (idx >> 7)] * 128 + (idx & 127)) * 2) * 128) : (0x80000000u | (unsigned)((sb * 4 + (idx - PAST)) * 256)); }
    __syncthreads();
    bf16* MIX = (bf16*)(a.ws + WS_MIX) + (size_t)(MP + q) * DM;
#pragma unroll 1
    for (int kvh = 0; kvh < 2; ++kvh) {
#pragma unroll 1
        for (int pass = 0; pass < 2; ++pass) {
            const float* pool = pass ? a.in[3] : a.in[2]; const float* nw = a.out + (pass ? O_VS : O_KS);
            { f32x4 gv[16];
#pragma unroll
              for (int r = 0; r < 16; ++r) { const int i = (tid >> 5) + 16 * r; const unsigned off = OFFL[i]; const float* src = (off & 0x80000000u) ? nw + (size_t)(off & 0x7fffffffu) : pool + (size_t)off;
                  gv[r] = *(const f32x4*)(src + kvh * 128 + (tid & 31) * 4); }
#pragma unroll
              for (int r = 0; r < 16; ++r) { const int i = (tid >> 5) + 16 * r; *(LAS u64*)(KV + i * 136 + (tid & 31) * 4) = (u64)pk2(gv[r].x, gv[r].y) | ((u64)pk2(gv[r].z, gv[r].w) << 32); } }
            __syncthreads();
            if (pass == 0) {
                const int i = tid >> 1, dh = (tid & 1) * 64; float s0 = 0.f, s1 = 0.f, s2 = 0.f;
#pragma unroll 8
                for (int d = 0; d < 64; ++d) { const float kx = bf2f(KV[i * 136 + dh + d]);
                    s0 = fmaf(QL[(3 * kvh + 0) * 128 + dh + d], kx, s0); s1 = fmaf(QL[(3 * kvh + 1) * 128 + dh + d], kx, s1); s2 = fmaf(QL[(3 * kvh + 2) * 128 + dh + d], kx, s2); }
                s0 += __shfl_xor(s0, 1); s1 += __shfl_xor(s1, 1); s2 += __shfl_xor(s2, 1);
                if ((tid & 1) == 0) { SL[i] = s0 * 0.08838834764831845f; SL[256 + i] = s1 * 0.08838834764831845f; SL[512 + i] = s2 * 0.08838834764831845f; }
                __syncthreads();
                if (w < 3) { float v[4], mx = -1e30f;
#pragma unroll
                    for (int j = 0; j < 4; ++j) { v[j] = SL[w * 256 + 64 * j + lane]; mx = fmaxf(mx, v[j]); }
#pragma unroll
                    for (int o = 1; o < 64; o <<= 1) mx = fmaxf(mx, __shfl_xor(mx, o));
                    float l = 0.f;
#pragma unroll
                    for (int j = 0; j < 4; ++j) { v[j] = __expf(v[j] - mx); l += v[j]; }
                    l = wave_sum(l); const float il = 1.0f / l;
#pragma unroll
                    for (int j = 0; j < 4; ++j) SL[w * 256 + 64 * j + lane] = v[j] * il; }
                __syncthreads();
            } else {
                const int d = tid & 127, part = tid >> 7; float o0 = 0.f, o1 = 0.f, o2 = 0.f;
#pragma unroll 8
                for (int i = part * 64; i < part * 64 + 64; ++i) { const float vx = bf2f(KV[i * 136 + d]); o0 = fmaf(SL[i], vx, o0); o1 = fmaf(SL[256 + i], vx, o1); o2 = fmaf(SL[512 + i], vx, o2); }
                OL[(part * 3 + 0) * 128 + d] = o0; OL[(part * 3 + 1) * 128 + d] = o1; OL[(part * 3 + 2) * 128 + d] = o2;
                __syncthreads();
                if (tid < 384) { const int hq = tid >> 7, dd = tid & 127; const float o = (OL[hq * 128 + dd] + OL[(3 + hq) * 128 + dd]) + (OL[(6 + hq) * 128 + dd] + OL[(9 + hq) * 128 + dd]);
                    MIX[(3 * kvh + hq) * 128 + dd] = (bf16)f2bf(o); }
                __syncthreads();
            }
        }
    }
}


namespace attn {
using bf16 = unsigned short;
typedef short bf16x8 __attribute__((ext_vector_type(8)));
typedef short s16x4 __attribute__((ext_vector_type(4)));
typedef float f32x16 __attribute__((ext_vector_type(16)));
typedef float f32x4 __attribute__((ext_vector_type(4)));
typedef unsigned u32x4 __attribute__((ext_vector_type(4)));
typedef unsigned u32x2 __attribute__((ext_vector_type(2)));
constexpr int D = 128, OS = 1024;
constexpr float THR = 8.f;
constexpr float SCALE = 0.08838834764831845f;
constexpr int NW = 8, QBLK = 32, KVBLK = 64, QB = NW * QBLK;
constexpr int SHM_V = KVBLK * D * 2, SHM_K = KVBLK * D * 2;
constexpr int LDS_BYTES = 2 * SHM_V + 2 * SHM_K + NW * 64 * 4;

#define KSWZ(row, colB) ((row) * 256 + ((colB) ^ (((row) & 7) << 4)))
#define SBAR() __builtin_amdgcn_sched_barrier(0)
__device__ __forceinline__ int v_st(int k, int c) { const int kk = (k & ~0xC) | ((k & 4) << 1) | ((k & 8) >> 1); return ((kk >> 3) * 4 + (c >> 5)) * 512 + ((kk & 7) * 32 + (c & 31)) * 2; }
__device__ __forceinline__ int v_rd_base(int lane) { return ((lane & 3) << 3) | (((lane >> 2) & 3) << 6) | (((lane >> 4) & 1) << 5) | (((lane >> 5) & 1) << 8); }
constexpr int v_rd_off(int d0, int ks, int half) { return d0 * 512 + ks * 4096 + half * 2048; }
__device__ __forceinline__ int crow(int r, int hi) { return (r & 3) + 8 * (r >> 2) + 4 * hi; }
__device__ __forceinline__ unsigned cvtpk(float lo, float hi) {
    unsigned r; asm volatile("v_cvt_pk_bf16_f32 %0, %1, %2" : "=v"(r) : "v"(lo), "v"(hi)); return r;
}
__device__ __forceinline__ bf16x8 pack8(f32x4 a, f32x4 b) {
    u32x4 w = {cvtpk(a[0], a[1]), cvtpk(a[2], a[3]), cvtpk(b[0], b[1]), cvtpk(b[2], b[3])};
    return *reinterpret_cast<bf16x8*>(&w);
}

__device__ __forceinline__ void partialSM(f32x16& p0, f32x16& p1, float& m_reg, float& mn, float& alpha) {
    float pmax = p0[0]; for (int r = 1; r < 16; ++r) pmax = fmaxf(pmax, p0[r]); for (int r = 0; r < 16; ++r) pmax = fmaxf(pmax, p1[r]);
    { auto rr = __builtin_amdgcn_permlane32_swap(__float_as_uint(pmax), __float_as_uint(pmax), false, false);
      pmax = fmaxf(__uint_as_float(rr[0]), __uint_as_float(rr[1])); }
    constexpr float C2 = 1.4426950408889634f * SCALE;
    if (__builtin_expect(__all((pmax - m_reg) * SCALE <= THR), 1)) { mn = m_reg; alpha = 1.f; }
    else { mn = fmaxf(m_reg, pmax); alpha = __builtin_amdgcn_exp2f((m_reg - mn) * C2); m_reg = mn; }
    const float mnL = -mn * C2;
    for (int r = 0; r < 16; ++r) p0[r] = fmaf(p0[r], C2, mnL); for (int r = 0; r < 16; ++r) p1[r] = fmaf(p1[r], C2, mnL);
    for (int r = 0; r < 16; ++r) p0[r] = __builtin_amdgcn_exp2f(p0[r]);
}
__device__ __forceinline__ void finishSM(f32x16& p0, f32x16& p1, float alpha, float& l_reg, bf16x8& pa0, bf16x8& pa1, bf16x8& pa2, bf16x8& pa3) {
    for (int r = 0; r < 16; ++r) p1[r] = __builtin_amdgcn_exp2f(p1[r]);
    float ps = 0; for (int r = 0; r < 16; ++r) ps += p0[r]; for (int r = 0; r < 16; ++r) ps += p1[r];
    { auto rr = __builtin_amdgcn_permlane32_swap(__float_as_uint(ps), __float_as_uint(ps), false, false);
      ps = __uint_as_float(rr[0]) + __uint_as_float(rr[1]); }
    l_reg = l_reg * alpha + ps;
#define PK4(P, B_, OUT) do { unsigned a0 = cvtpk(P[B_+0], P[B_+1]), a1 = cvtpk(P[B_+2], P[B_+3]);                          \
        unsigned b0 = cvtpk(P[B_+4], P[B_+5]), b1 = cvtpk(P[B_+6], P[B_+7]);                                             \
        auto r0 = __builtin_amdgcn_permlane32_swap(a0, b0, false, false); auto r1 = __builtin_amdgcn_permlane32_swap(a1, b1, false, false); \
        u32x4 w = {r0[0], r1[0], r0[1], r1[1]}; OUT = *reinterpret_cast<bf16x8*>(&w); } while (0)
    PK4(p0, 0, pa0); PK4(p0, 8, pa1); PK4(p1, 0, pa2); PK4(p1, 8, pa3);
#undef PK4
}
template <int KB, bool SK>
__device__ __forceinline__ void qkt(f32x16& p0, f32x16& p1, const char* K_lds, int r32, int hi, const bf16x8* qr, bool act) {
    if (SK && !act) { const float NEG = -__builtin_inff();
#pragma unroll
        for (int r = 0; r < 16; ++r) { p0[r] = NEG; p1[r] = NEG; } return; }
    p0 = f32x16{}; p1 = f32x16{};
    const char* kb[4];
#pragma unroll
    for (int dd = 0; dd < 4; ++dd) kb[dd] = K_lds + KB * SHM_K + KSWZ(r32, (dd * 16 + hi * 8) * 2);
#pragma unroll
    for (int d0 = 0; d0 < 8; ++d0) { const char* a = kb[d0 & 3] + (d0 >> 2) * 128;
        bf16x8 b0 = *reinterpret_cast<const bf16x8*>(a);
        bf16x8 b1 = *reinterpret_cast<const bf16x8*>(a + 32 * 256);
        p0 = __builtin_amdgcn_mfma_f32_32x32x16_bf16(b0, qr[d0], p0, 0, 0, 0);
        p1 = __builtin_amdgcn_mfma_f32_32x32x16_bf16(b1, qr[d0], p1, 0, 0, 0); }
}
template <int VB, bool SK>
__device__ __forceinline__ void pv_tile(f32x16* o, int vb0, bf16x8 pa0, bf16x8 pa1, bf16x8 pa2, bf16x8 pa3, bool act) {
    if (SK && !act) return;
#define TRRD(dst, off) asm volatile("ds_read_b64_tr_b16 %0, %1 offset:%2" : "=&v"(dst) : "v"(vb0), "i"(off) : "memory")
#define PV_D0(d0) do { s16x4 l0, l1, l2, l3, h0, h1, h2, h3; constexpr int b_ = VB * SHM_V + v_rd_off(d0, 0, 0);     \
        TRRD(l0, b_); TRRD(h0, b_ + 2048); TRRD(l1, b_ + 4096); TRRD(h1, b_ + 6144); TRRD(l2, b_ + 8192); TRRD(h2, b_ + 10240); TRRD(l3, b_ + 12288); TRRD(h3, b_ + 14336); \
        asm volatile("s_waitcnt lgkmcnt(0)" ::: "memory"); SBAR();                 \
        o[d0] = __builtin_amdgcn_mfma_f32_32x32x16_bf16(pa0, (bf16x8){l0[0], l0[1], l0[2], l0[3], h0[0], h0[1], h0[2], h0[3]}, o[d0], 0, 0, 0);   \
        o[d0] = __builtin_amdgcn_mfma_f32_32x32x16_bf16(pa1, (bf16x8){l1[0], l1[1], l1[2], l1[3], h1[0], h1[1], h1[2], h1[3]}, o[d0], 0, 0, 0);   \
        o[d0] = __builtin_amdgcn_mfma_f32_32x32x16_bf16(pa2, (bf16x8){l2[0], l2[1], l2[2], l2[3], h2[0], h2[1], h2[2], h2[3]}, o[d0], 0, 0, 0);   \
        o[d0] = __builtin_amdgcn_mfma_f32_32x32x16_bf16(pa3, (bf16x8){l3[0], l3[1], l3[2], l3[3], h3[0], h3[1], h3[2], h3[3]}, o[d0], 0, 0, 0); } while (0)
    PV_D0(0); PV_D0(1); PV_D0(2); PV_D0(3);
#undef PV_D0
#undef TRRD
}

__device__ __forceinline__ bf16x8 load8(const bf16* p) { return *reinterpret_cast<const bf16x8*>(p); }
__device__ __forceinline__ void mask_bits(f32x16& p0, f32x16& p1, u32x2 w, int hi) {
    const float NEG = -__builtin_inff();
    asm volatile("" : "+v"(w.x), "+v"(w.y));
    const unsigned lo = w.x >> (4 * hi), up = w.y >> (4 * hi);
#pragma unroll
    for (int r = 0; r < 16; ++r) { const int c = (r & 3) + 8 * (r >> 2);
        if (!((lo >> c) & 1u)) p0[r] = NEG;
        if (!((up >> c) & 1u)) p1[r] = NEG; }
}
struct BlockRef { const bf16* Q; const bf16* K; const bf16* V; bf16* O; const u32x2* M; int P0; };
struct Seam { bf16x8 qr[8]; bf16x8 st_v0, st_v1, st_k0, st_k1; };
#define ROW(p, k0, rr) ((p) + (size_t)((k0) + (rr)) * D + sc)
#define VMW() asm volatile("s_waitcnt vmcnt(0)" ::: "memory")
#define VMWN(n) asm volatile("s_waitcnt vmcnt(%0)" :: "i"(n) : "memory")
#define SLOAD_H(Kp, Vp, k0) do { S.st_v0 = load8(ROW(Vp, k0, sr)); S.st_v1 = load8(ROW(Vp, k0, 32 + sr));              \
                         S.st_k0 = load8(ROW(Kp, k0, sr)); S.st_k1 = load8(ROW(Kp, k0, 32 + sr)); } while (0)
#define SWRITE_HK(bf) do { *(bf16x8*)(K_lds + (bf) * SHM_K + kws) = S.st_k0; *(bf16x8*)(K_lds + (bf) * SHM_K + kws + 32 * 256) = S.st_k1; } while (0)
#define SWRITE_HV(bf) do { *(bf16x8*)(V_lds + (bf) * SHM_V + vst0) = S.st_v0; *(bf16x8*)(V_lds + (bf) * SHM_V + vst1) = S.st_v1; } while (0)
#define SWRITE_H(bf) do { SWRITE_HV(bf); SWRITE_HK(bf); } while (0)
__device__ __forceinline__ void sel_prime(const BlockRef& cur, char* lds, Seam& S) {
    int tid_ = threadIdx.x; asm volatile("" : "+v"(tid_));
    const int tid = tid_, wid = __builtin_amdgcn_readfirstlane(tid >> 6), lane = tid & 63, r32 = lane & 31, hi = lane >> 5;
    const int sr = tid >> 4, sc = (tid & 15) * 8, kws = KSWZ(sr, sc * 2); char* K_lds = lds + 2 * SHM_V;
    for (int d0 = 0; d0 < 8; ++d0) S.qr[d0] = load8(cur.Q + (size_t)(wid * QBLK + r32) * D + d0 * 16 + hi * 8);
    SLOAD_H(cur.K, cur.V, 0); VMW(); SWRITE_HK(0);
    __syncthreads();
}
__device__ __forceinline__ void sel_block(const BlockRef& cur, const BlockRef& nxt, char* lds, Seam& S) {
    int tid_ = threadIdx.x; asm volatile("" : "+v"(tid_));
    const int tid = tid_, wid = __builtin_amdgcn_readfirstlane(tid >> 6), lane = tid & 63, r32 = lane & 31, hi = lane >> 5;
    const int NT = (cur.P0 + QB) / KVBLK;
    char* V_lds = lds; char* K_lds = lds + 2 * SHM_V;
    float* ws = (float*)(lds + 2 * SHM_V + 2 * SHM_K) + wid * 64; float* li_l = ws, * al_l = ws + 32;
    float m_reg = -1e30f, l_reg = 0; f32x16 o[4] = {};
    const int sr = tid >> 4, sc = (tid & 15) * 8, vst0 = v_st(sr, sc), vst1 = v_st(32 + sr, sc), kws = KSWZ(sr, sc * 2);
    const int vb0 = (int)(uintptr_t)V_lds + v_rd_base(lane);
    const bf16* Kh = cur.K; const bf16* Vh = cur.V;
    const char* Mbase = (const char*)cur.M; const unsigned moff = (unsigned)(wid * QBLK + r32) * 512u;
#define MROW(t) (*(const u32x2*)(Mbase + (moff + (unsigned)(t) * 8u)))
#define RESC(a) do { if (__any((a) < 1.f)) { if (hi == 0) al_l[r32] = (a); asm volatile("s_waitcnt lgkmcnt(0)" ::: "memory");              \
                     for (int d_ = 0; d_ < 4; ++d_) for (int r = 0; r < 16; ++r) o[d_][r] *= al_l[crow(r, hi)]; } } while (0)
#define KBASE(t) ((t) * KVBLK)
    f32x16 pA0, pA1, pB0, pB1; float mnA, mnB, alA, alB; bf16x8 pa0, pa1, pa2, pa3; u32x2 mw;
    SWRITE_HV(0); SBAR();
    if (NT > 1) SLOAD_H(Kh, Vh, KBASE(1));
    mw = MROW(0);
    SBAR(); qkt<0, false>(pA0, pA1, K_lds, r32, hi, S.qr, true);
    mask_bits(pA0, pA1, mw, hi); partialSM(pA0, pA1, m_reg, mnA, alA);
    if (NT > 1) { VMW(); SWRITE_H(1); }
    __syncthreads();
#define HALF_STEP(PX0, PX1, mnX, alX, PY0, PY1, alY, t, KB, VB, SB) do {                                                      \
        SBAR(); mw = MROW(t); qkt<KB, false>(PX0, PX1, K_lds, r32, hi, S.qr, true);                                          \
        finishSM(PY0, PY1, alY, l_reg, pa0, pa1, pa2, pa3); SBAR();                                                           \
        if ((t) + 1 < NT) { SLOAD_H(Kh, Vh, KBASE((t) + 1)); SBAR(); }                                                        \
        pv_tile<VB, false>(o, vb0, pa0, pa1, pa2, pa3, true); mask_bits(PX0, PX1, mw, hi); partialSM(PX0, PX1, m_reg, mnX, alX); \
        __syncthreads();                                                                                                      \
        if ((t) + 1 < NT) { VMW(); SWRITE_H(SB); }                                                                            \
        RESC(alX); __syncthreads(); } while (0)
    for (int t = 1; t + 1 < NT; t += 2) {
        HALF_STEP(pB0, pB1, mnB, alB, pA0, pA1, alA, t, 1, 0, 0);
        HALF_STEP(pA0, pA1, mnA, alA, pB0, pB1, alB, t + 1, 0, 1, 1);
    }
    const bool even = (NT & 1) == 0;
    if (even) { SBAR(); mw = MROW(NT - 1); qkt<1, false>(pB0, pB1, K_lds, r32, hi, S.qr, true); SBAR(); }
    SLOAD_H(nxt.K, nxt.V, 0); SBAR();
#pragma unroll
    for (int d0 = 0; d0 < 8; ++d0) S.qr[d0] = load8(nxt.Q + (size_t)(wid * QBLK + r32) * D + d0 * 16 + hi * 8);
    SBAR();
    finishSM(pA0, pA1, alA, l_reg, pa0, pa1, pa2, pa3); SBAR();
    pv_tile<0, false>(o, vb0, pa0, pa1, pa2, pa3, true);
    if (even) { mask_bits(pB0, pB1, mw, hi); partialSM(pB0, pB1, m_reg, mnB, alB); __syncthreads(); RESC(alB);
        finishSM(pB0, pB1, alB, l_reg, pa0, pa1, pa2, pa3); SBAR(); pv_tile<1, false>(o, vb0, pa0, pa1, pa2, pa3, true); }
    SBAR(); VMWN(8); SWRITE_HK(0); SBAR();
    if (hi == 0) li_l[r32] = l_reg; asm volatile("s_waitcnt lgkmcnt(0)" ::: "memory");
    float rli[16];
#pragma unroll
    for (int r = 0; r < 16; ++r) rli[r] = __builtin_amdgcn_rcpf(li_l[crow(r, hi)]);
    bf16* Ow = cur.O + (size_t)(wid * QBLK) * OS;
#pragma unroll
    for (int r = 0; r < 16; ++r) { const int orow = crow(r, hi);
#pragma unroll
        for (int d0 = 0; d0 < 4; ++d0) { const float v = o[d0][r] * rli[r];
            const float vn = __shfl_xor(v, 1);
            if ((r32 & 1) == 0) *(unsigned*)(Ow + (size_t)orow * OS + d0 * 32 + r32) = cvtpk(v, vn); } }
    __syncthreads();
#undef RESC
#undef KBASE
#undef HALF_STEP
#undef MROW
}
#undef ROW
#undef VMW
#undef VMWN
#undef SLOAD_H
#undef SWRITE_HK
#undef SWRITE_HV
#undef SWRITE_H
#undef KSWZ
#undef SBAR
}


__device__ __forceinline__ attn::BlockRef attn_ref(ARGREF a, int b, int h, int qb) {
    attn::BlockRef r; const int kvh = h / 3;
    r.Q = (const attn::bf16*)(a.ws + WS_QB) + ((size_t)(b * 6 + h) * SEQ + (size_t)qb * 256) * 128;
    r.K = (const attn::bf16*)(a.ws + WS_KB) + (size_t)(b * 2 + kvh) * SEQ * 128;
    r.V = (const attn::bf16*)(a.ws + WS_VB) + (size_t)(b * 2 + kvh) * SEQ * 128;
    r.O = (attn::bf16*)(a.ws + WS_MIX) + (size_t)(b * SEQ + qb * 256) * DM + h * 128;
    r.M = (const attn::u32x2*)(a.ws + WS_MASK) + (size_t)(b * SEQ + qb * 256) * 64;
    r.P0 = qb * 256; return r;
}
__device__ __forceinline__ void p11_attention(Ctx& c, ARGREF a) {
    constexpr int NITEM = 240;
#pragma unroll 1
    for (int it = c.vcu; it < NITEM; it += c.G) {
        const int bh = it / 10, slot = it % 10, b = bh / 6, h = bh % 6;
        const int q0 = slot < 3 ? 15 - slot : (slot == 9 ? 6 : slot - 3), q1 = slot < 3 ? q0 : (slot == 9 ? 6 : 15 - slot);
        attn::Seam S;
        attn::BlockRef cur = attn_ref(a, b, h, q0), nxt = attn_ref(a, b, h, q1);
        __syncthreads();
        attn::sel_prime(cur, (char*)c.lds, S);
        if (q0 != q1) attn::sel_block(cur, nxt, (char*)c.lds, S);
        attn::sel_block(nxt, nxt, (char*)c.lds, S);
    }
    if (c.G == 256) {
        if (c.vcu >= NITEM) { for (int j = 0; j < 4; ++j) { const int u = (c.vcu - NITEM) * 4 + j; attn_sample_unit(c, a, u >> 2, u & 3); } }
        else if (c.vcu % 10 == 9) { for (int j = 0; j < 3; ++j) { const int u = 64 + (c.vcu / 10) * 3 + j; if (u < MS) attn_sample_unit(c, a, u >> 2, u & 3); } }
    } else for (int u = c.vcu; u < MS; u += c.G) attn_sample_unit(c, a, u >> 2, u & 3);
}

enum { PH_PRO = 0, PH_IN0, PH_MIX0, PH_HSCAN, PH_HFIX, PH_OUT0, PH_GU0, PH_DOWN0, PH_IN1, PH_POST, PH_IDX, PH_TOPK, PH_ATTN, PH_OUT1, PH_GU1, PH_DOWN1, NPHASE };
#ifndef ONLYPH
#define ONLYPH -1
#endif
#define PHON(x) (ONLYPH < 0 || ONLYPH == (x))
#ifndef REP_PH
#define REP_PH -1
#endif
#ifndef REP_N
#define REP_N 1
#endif
__global__ void __launch_bounds__(NWAVES * 64, 2) fwd_kernel(Args args) {
    extern __shared__ __attribute__((aligned(16))) unsigned char lds[];
    Ctx c;
    c.lds = (LAS unsigned char*)lds;
    c.MISC = (volatile LAS unsigned*)(c.lds + MISC_OFF);
    c.tid = threadIdx.x; c.lane = c.tid & 63; c.wave = __builtin_amdgcn_readfirstlane(c.tid >> 6);
    c.G = gridDim.x; { const int bx = blockIdx.x; c.vcu = (c.G % 8 == 0) ? (bx % 8) * (c.G / 8) + bx / 8 : bx; }
    c.ctl = (gu32*)(args.ws + WS_CTL);
    for (int u = c.tid; u < (LDS_BYTES - LDSCTL_OFF) / 4; u += NWAVES * 64) ((LAS unsigned*)(c.lds + LDSCTL_OFF))[u] = 0u;
    __syncthreads();
    const int lo = args.ph_lo, hi = args.ph_hi;
    XcdBarrier bar; bar.bar = (unsigned*)(c.ctl + CW_BAR); bar.x = 0; bar.st = nullptr;
    if (hi - lo > 1 || REP_N > 1) bar = xcd_barrier_post((unsigned*)(c.ctl + CW_BAR), c.MISC + 8);
    c.qoff = 0;
#pragma unroll 1
    for (int ph = lo; ph < hi; ++ph) {
        const int layer = ph >= PH_IN1 ? 1 : 0;
        const __attribute__((address_space(4))) Args* ap = (const __attribute__((address_space(4))) Args*)__builtin_amdgcn_kernarg_segment_ptr(); asm volatile("" : "+s"(ap));
        ARGREF la = *ap; unsigned char* const ws = la.ws; float* const out = la.out;
        { int t_ = threadIdx.x; asm volatile("" : "+v"(t_)); c.tid = t_; c.lane = t_ & 63; c.wave = __builtin_amdgcn_readfirstlane(t_ >> 6); }
        if ((ph == PH_DOWN0 || ph == PH_DOWN1) && PHON(PH_OUT0)) {
            pg8::SchedX S0; S0.init(MP, 1024, c.G, (int)blockIdx.x, 0, 0, 1, 0); pg8::Unit u0; if (S0.next(0, u0)) conv_fixup_tile(c, la, layer, u0.pm); VM_WAIT(); __syncthreads(); }
        if (ph == PH_PRO && PHON(PH_PRO)) p0_prologue(c, la);
        else if ((ph == PH_IN0 || ph == PH_IN1) && PHON(PH_IN0)) {
            pg8::Gemm g{(const pg8::bf16_t*)(ws + WS_XB), (const pg8::bf16_t*)(ws + (ph == PH_IN0 ? WS_WIN0 : WS_WIN1)), MT, 0, 1024};
            pg8::SchedX S; if (ph == PH_IN0) S.init(MP, ZC0, c.G, (int)blockIdx.x, 16, MT / 256, 4, 13); else S.init(MP, ZC1, c.G, (int)blockIdx.x, 0, 0, 1, 0);
            pg8::EpiZ E{(pg8::bf16_t*)(ws + WS_Z), ph == PH_IN0 ? ZC0 : ZC1, ssptr(c, ph == PH_IN0 ? 0 : 2), ph == PH_IN0 ? 13 : 9, (float*)(ws + WS_MEMKV), MEMROW0};
            pg8::gemm_phase<pg8::EpiZ, pg8::SchedX, PG8_ALIGN, PG8_SP2>(c.lds + RING_OFF, g, S, E);
            { SgArgs sg{}; sg.A = (const bf16*)(ws + WS_XB) + (size_t)MP * DM; sg.Bt = (const bf16*)(ws + (ph == PH_IN0 ? WS_WIN0 : WS_WIN1)); sg.K = 1024; sg.mode = 0; sg.Z = (bf16*)(ws + WS_Z); sg.ldz = ph == PH_IN0 ? ZC0 : ZC1; sg.ssin = ssptr(c, ph == PH_IN0 ? 0 : 2);
              sgemm_phase(c, sg, ph == PH_IN0 ? ZC0 : ZC1); }
            if (ph == PH_IN0) { __syncthreads(); convert_layer1_tail(c, la, (64 * 13 + 16) % c.G); }
        }
        else if (ph == PH_MIX0 && PHON(PH_MIX0)) p2_mixer0(c, la);
        else if (ph == PH_HSCAN && PHON(PH_HSCAN)) hgrn_scan(c, la);
        else if (ph == PH_HFIX && PHON(PH_HFIX)) p2c_hgrn_fix(c, la);
        else if ((ph == PH_OUT0 || ph == PH_DOWN0 || ph == PH_OUT1 || ph == PH_DOWN1) && PHON(PH_OUT0)) {
            const bool isout = (ph == PH_OUT0 || ph == PH_OUT1);
            pg8::Gemm g{(const pg8::bf16_t*)(ws + (isout ? WS_MIX : WS_ACT)), (const pg8::bf16_t*)(ws + (isout ? WS_WOUT + (size_t)layer * 1024 * 1024 * 2 : WS_WD + (size_t)layer * 1024 * DFF * 2)), MT, 1024, isout ? 1024 : DFF};
            pg8::SchedX S; S.init(MP, 1024, c.G, (int)blockIdx.x, 0, 0, 1, 0);
            pg8::EpiResid E;
            E.rp = ph == PH_OUT0 ? la.in[0] : nullptr; E.rb = (const pg8::bf16_t*)(ws + WS_XB); E.y = ph == PH_DOWN1 ? out + O_YP : nullptr;
            E.xb = ph == PH_DOWN1 ? nullptr : (pg8::bf16_t*)(ws + WS_XB); E.ssout = ph == PH_DOWN1 ? nullptr : ssptr(c, ph == PH_OUT0 ? 1 : (ph == PH_DOWN0 ? 2 : 3));
            pg8::gemm_phase<pg8::EpiResid, pg8::SchedX, PG8_ALIGN, PG8_SP2>(c.lds + RING_OFF, g, S, E);
            { SgArgs sg{}; sg.A = (const bf16*)(ws + (isout ? WS_MIX : WS_ACT)) + (size_t)MP * (isout ? 1024 : DFF); sg.Bt = (const bf16*)g.Bt; sg.K = isout ? 1024 : DFF; sg.mode = 1; sg.rb = (const bf16*)(ws + WS_XB); sg.resid = ph == PH_OUT0 ? la.in[1] : nullptr; sg.y = ph == PH_DOWN1 ? out + O_YS : nullptr; sg.xb = (bf16*)E.xb; sg.ssout = E.ssout;
              sgemm_phase(c, sg, 1024); }
        }
        else if ((ph == PH_GU0 || ph == PH_GU1) && PHON(PH_GU0)) {
            pg8::Gemm g{(const pg8::bf16_t*)(ws + WS_XB), (const pg8::bf16_t*)(ws + WS_WGU + (size_t)layer * 5632 * 1024 * 2), MT, 5632, 1024};
            pg8::SchedX S; S.init(MP, 5632, c.G, (int)blockIdx.x, 0, 0, 1, 0);
            pg8::EpiGU E{(pg8::bf16_t*)(ws + WS_ACT), ssptr(c, layer ? 3 : 1), out + O_CVP + (size_t)layer * 4 * 2 * DFF, la.in[26] + (size_t)layer * 3 * DFF, la.in[27] + (size_t)layer * DFF, (float*)(ws + WS_G4), (float*)(ws + WS_UP2)};
            pg8::gemm_phase<pg8::EpiGU, pg8::SchedX, PG8_ALIGN, PG8_SP2>(c.lds + RING_OFF, g, S, E);
            { SgArgs sg{}; sg.A = (const bf16*)(ws + WS_XB) + (size_t)MP * DM; sg.Bt = (const bf16*)g.Bt; sg.K = 1024; sg.mode = 2; sg.ssin = E.ss; sg.ACT = (bf16*)E.ACT; sg.cvs = out + O_CVS + (size_t)layer * 32 * 2 * DFF; sg.cst = la.in[8] + (size_t)layer * 32 * 2 * DFF; sg.cw = E.cw; sg.cb = E.cb;
              sgemm_phase(c, sg, 5632); }
        }
        else if (ph == PH_POST && PHON(PH_POST)) p8_dsa_post(c, la);
        else if (ph == PH_IDX && PHON(PH_IDX)) p9_indexer(c, la);
        else if (ph == PH_TOPK && PHON(PH_TOPK)) p10_topk(c, la);
        else if (ph == PH_ATTN && PHON(PH_ATTN)) p11_attention(c, la);
        if (REP_N > 1 && ph == REP_PH && c.qoff < 4 * (REP_N - 1)) { c.qoff += 4; --ph; xcd_barrier(bar); continue; }
        if (REP_N > 1) c.qoff = 0;
        if (ph + 1 < hi) xcd_barrier(bar);
    }
}

#ifndef MK_ONE_LAUNCH
#define MK_ONE_LAUNCH 1
#endif
extern "C" void kernel_launch(void* const* d_in, const int* in_sizes, int n_in, void* d_out, int out_size, void* d_ws, size_t ws_size, hipStream_t stream) {
    static int grid = 0;
    if (grid == 0) {
        if (n_in != 29 || out_size != (int)O_END || ws_size < WS_END) { fprintf(stderr, "kernel_launch: unexpected problem (n_in %d, out %d, ws %zu)\n", n_in, out_size, ws_size); grid = -1; return; }
        int dev = 0, cus = 0;
        if (hipGetDevice(&dev) != hipSuccess || hipDeviceGetAttribute(&cus, hipDeviceAttributeMultiprocessorCount, dev) != hipSuccess) { grid = -1; return; }
        if (hipFuncSetAttribute((const void*)fwd_kernel, hipFuncAttributeMaxDynamicSharedMemorySize, LDS_BYTES) != hipSuccess) { fprintf(stderr, "kernel_launch: hipFuncSetAttribute failed\n"); grid = -1; return; }
        (void)hipGetLastError();
        grid = cus;
    }
    if (grid < 0) return;
    if (hipMemsetAsync((char*)d_ws + WS_CTL, 0, CTL_ZERO_BYTES, stream) != hipSuccess) { fprintf(stderr, "kernel_launch: memset failed\n"); return; }
    Args a{};
    for (int i = 0; i < 29; ++i) a.in[i] = (const float*)d_in[i];
    a.page_table = (const int*)d_in[9]; a.out = (float*)d_out; a.ws = (unsigned char*)d_ws;
#if MK_ONE_LAUNCH
    a.ph_lo = 0; a.ph_hi = NPHASE;
    hipLaunchKernelGGL(fwd_kernel, dim3(grid), dim3(NWAVES * 64), LDS_BYTES, stream, a);
#else
    for (int ph = 0; ph < NPHASE; ++ph) { a.ph_lo = ph; a.ph_hi = ph + 1; hipLaunchKernelGGL(fwd_kernel, dim3(grid), dim3(NWAVES * 64), LDS_BYTES, stream, a); }
#endif
}
```

```cpp
#include <hip/hip_runtime.h>
#include <cstdio>
#include <cstdint>


namespace pg8 {
#define PG8_LAS __attribute__((address_space(3)))
typedef unsigned short bf16_t;
typedef short bf16x8 __attribute__((ext_vector_type(8)));
typedef float f32x4 __attribute__((ext_vector_type(4)));
typedef unsigned u32x4 __attribute__((ext_vector_type(4)));
constexpr int BM = 256, BK = 64, HALF = 128, HTB = HALF * BK * 2  , STAGE_BYTES = 8 * HTB, NXCD = 8, WGM = 8;

__host__ __device__ __forceinline__ int lds_byte(int r, int c) { const int st = (r >> 4) * 2 + (c >> 5), rr = r & 15, cc = c & 31, ob = rr * 64 + cc * 2; return st * 1024 + (ob ^ (((ob >> 9) & 1) << 5)); }
__host__ __device__ __forceinline__ void stage_rc(int b, int& R, int& C) { const int st = b / 1024, sb = b % 1024, swz = sb ^ (((sb >> 9) & 1) << 5); R = (st >> 1) * 16 + swz / 64; C = (st & 1) * 32 + (swz % 64) / 2; }
__host__ __device__ __forceinline__ int perm32(int rho) { const int n = rho >> 4, i = rho & 15; return 8 * (i >> 2) + 4 * n + (i & 3); }

struct Unit { int pm, pn; };
struct Gemm { const bf16_t* A; const bf16_t* Bt; int M, N, K; };

struct StaticOrder {
    int nM, nN, nwg, G, c;
    __host__ __device__ __forceinline__ void init(int M, int N, int G_, int c_) { nM = M / BM; nN = N / BM; nwg = nM * nN; G = G_; c = c_; }
    __host__ __device__ __forceinline__ bool next(int i, Unit& u) const {
        const long L = (long)i * G + c; if (L >= nwg) return false;
        int wgid = (int)L; { const int q = nwg / NXCD, r = nwg % NXCD, xcd = wgid % NXCD, off = wgid / NXCD; wgid = (xcd < r ? xcd * (q + 1) : r * (q + 1) + (xcd - r) * q) + off; }
        const int nig = WGM * nN, gid = wgid / nig, fm = gid * WGM, gsz = (nM - fm) < WGM ? (nM - fm) : WGM;
        u.pm = fm + ((wgid % nig) % gsz); u.pn = (wgid % nig) / gsz; return true;
    }
    __device__ __forceinline__ void a_ready(const Unit&) const {}
    __device__ __forceinline__ void done(const Unit&) const {}
};


constexpr int MP = 16384, MS = 128, MVALID = MP + MS, MT = 16640, DM = 1024, DFF = 2816;
constexpr float RMS_EPS = 1e-6f;
__device__ __forceinline__ unsigned cvt_pk_bf16(float lo, float hi) { unsigned r; asm volatile("v_cvt_pk_bf16_f32 %0, %1, %2" : "=v"(r) : "v"(lo), "v"(hi)); return r; }

struct SchedX {
    StaticOrder so; int nextra, e_pm0, e_nm, e_pn0;
    __device__ __forceinline__ void init(int M, int N, int G_, int c_, int nextra_, int e_pm0_, int e_nm_, int e_pn0_) { so.init(M, N, G_, c_); nextra = nextra_; e_pm0 = e_pm0_; e_nm = e_nm_; e_pn0 = e_pn0_; }
    __device__ __forceinline__ bool next(int i, Unit& u) const {
        const long L = (long)i * so.G + so.c;
        if (L < so.nwg) return so.next(i, u);
        const int e = (int)(L - so.nwg); if (e >= nextra) return false;
        u.pm = e_pm0 + e % e_nm; u.pn = e_pn0 + e / e_nm; return true;
    }
    __device__ __forceinline__ void a_ready(const Unit&) const {}
    __device__ __forceinline__ void done(const Unit&) const {}
};

struct EpiZ {
    static constexpr bool PERM = true, AFTER_DRAIN = false;
    bf16_t* Z; int ldz; const float* ss; int nmain; float* memkv; int memrow0;
    __device__ __forceinline__ void operator()(const f32x4 (&acc)[2][2][4][2], const Unit& u, int wr, int wc, int fr, int fq) const {
        const int row0 = u.pm * BM + wr * 64 + fr;
        if (u.pn < nmain) {
            const int col0 = u.pn * BM + wc * 32 + 8 * fq;
#pragma unroll
            for (int ai = 0; ai < 2; ++ai)
#pragma unroll
                for (int m = 0; m < 4; ++m) { const int row = row0 + ai * HALF + m * 16; const float rs = rsqrtf(ss[row] * (1.0f / DM) + RMS_EPS);
#pragma unroll
                    for (int bj = 0; bj < 2; ++bj) { const f32x4 v0 = acc[ai][bj][m][0] * rs, v1 = acc[ai][bj][m][1] * rs;
                        u32x4 w; w.x = cvt_pk_bf16(v0[0], v0[1]); w.y = cvt_pk_bf16(v0[2], v0[3]); w.z = cvt_pk_bf16(v1[0], v1[1]); w.w = cvt_pk_bf16(v1[2], v1[3]);
                        *(u32x4*)(Z + (size_t)row * ldz + col0 + bj * HALF) = w; } }
        } else {
            const int col0 = (u.pn - nmain) * BM + wc * 32 + 8 * fq;
#pragma unroll
            for (int ai = 0; ai < 2; ++ai)
#pragma unroll
                for (int m = 0; m < 4; ++m) { const int row = row0 + ai * HALF + m * 16 - memrow0;
#pragma unroll
                    for (int bj = 0; bj < 2; ++bj) { float* p = memkv + (size_t)row * 1024 + col0 + bj * HALF; *(f32x4*)p = acc[ai][bj][m][0]; *(f32x4*)(p + 4) = acc[ai][bj][m][1]; } }
        }
    }
};

struct EpiResid {
    static constexpr bool PERM = true, AFTER_DRAIN = false;
    const float* rp; const bf16_t* rb; float* y; bf16_t* xb; float* ssout;
    __device__ __forceinline__ void operator()(const f32x4 (&acc)[2][2][4][2], const Unit& u, int wr, int wc, int fr, int fq) const {
        const int row0 = u.pm * BM + wr * 64 + fr, col0 = u.pn * BM + wc * 32 + 8 * fq;
#pragma unroll
        for (int ai = 0; ai < 2; ++ai)
#pragma unroll
            for (int m = 0; m < 4; ++m) { const int row = row0 + ai * HALF + m * 16; float part = 0.f;
#pragma unroll
                for (int bj = 0; bj < 2; ++bj) { const int c = col0 + bj * HALF; f32x4 r0, r1;
                    if (rp) { r0 = *(const f32x4*)(rp + (size_t)row * DM + c); r1 = *(const f32x4*)(rp + (size_t)row * DM + c + 4); }
                    else { const u32x4 q = *(const u32x4*)(rb + (size_t)row * DM + c);
                        r0 = (f32x4){__builtin_bit_cast(float, q.x << 16), __builtin_bit_cast(float, q.x & 0xffff0000u), __builtin_bit_cast(float, q.y << 16), __builtin_bit_cast(float, q.y & 0xffff0000u)};
                        r1 = (f32x4){__builtin_bit_cast(float, q.z << 16), __builtin_bit_cast(float, q.z & 0xffff0000u), __builtin_bit_cast(float, q.w << 16), __builtin_bit_cast(float, q.w & 0xffff0000u)}; }
                    const f32x4 v0 = acc[ai][bj][m][0] + r0, v1 = acc[ai][bj][m][1] + r1;
                    if (y) { *(f32x4*)(y + (size_t)row * DM + c) = v0; *(f32x4*)(y + (size_t)row * DM + c + 4) = v1; }
                    part += (v0[0] * v0[0] + v0[1] * v0[1]) + (v0[2] * v0[2] + v0[3] * v0[3]) + (v1[0] * v1[0] + v1[1] * v1[1]) + (v1[2] * v1[2] + v1[3] * v1[3]);
                    if (xb) { u32x4 w; w.x = cvt_pk_bf16(v0[0], v0[1]); w.y = cvt_pk_bf16(v0[2], v0[3]); w.z = cvt_pk_bf16(v1[0], v1[1]); w.w = cvt_pk_bf16(v1[2], v1[3]);
                        *(u32x4*)(xb + (size_t)row * DM + c) = w; } }
                part += __shfl_xor(part, 16); part += __shfl_xor(part, 32);
                if (ssout && fq == 0) atomicAdd(ssout + row, part); }
    }
};

__device__ __forceinline__ void dpp_ror12(const f32x4& v, f32x4& r1, f32x4& r2) {
    float a0, a1, a2, a3, b0, b1, b2, b3;
    asm volatile("s_nop 1\n\t"
                 "v_mov_b32_dpp %0, %8 row_ror:1 row_mask:0xf bank_mask:0xf\n\tv_mov_b32_dpp %1, %9 row_ror:1 row_mask:0xf bank_mask:0xf\n\t"
                 "v_mov_b32_dpp %2, %10 row_ror:1 row_mask:0xf bank_mask:0xf\n\tv_mov_b32_dpp %3, %11 row_ror:1 row_mask:0xf bank_mask:0xf\n\t"
                 "v_mov_b32_dpp %4, %8 row_ror:2 row_mask:0xf bank_mask:0xf\n\tv_mov_b32_dpp %5, %9 row_ror:2 row_mask:0xf bank_mask:0xf\n\t"
                 "v_mov_b32_dpp %6, %10 row_ror:2 row_mask:0xf bank_mask:0xf\n\tv_mov_b32_dpp %7, %11 row_ror:2 row_mask:0xf bank_mask:0xf"
                 : "=&v"(a0), "=&v"(a1), "=&v"(a2), "=&v"(a3), "=&v"(b0), "=&v"(b1), "=&v"(b2), "=&v"(b3) : "v"(v[0]), "v"(v[1]), "v"(v[2]), "v"(v[3]));
    r1 = (f32x4){a0, a1, a2, a3}; r2 = (f32x4){b0, b1, b2, b3};
}
struct EpiGU {
    static constexpr bool PERM = true, AFTER_DRAIN = false;
    bf16_t* ACT; const float* ss; float* cvp; const float* cw; const float* cb; float* G4; float* UP2;
    __device__ __forceinline__ void operator()(const f32x4 (&acc)[2][2][4][2], const Unit& u, int wr, int wc, int fr, int fq) const {
        const int row0 = u.pm * BM + wr * 64 + fr, colg = u.pn * HALF + wc * 32 + 8 * fq;
        f32x4 w0[2], w1[2], w2[2], bb[2];
#pragma unroll
        for (int n = 0; n < 2; ++n) { const int col = colg + 4 * n; w0[n] = *(const f32x4*)(cw + col); w1[n] = *(const f32x4*)(cw + DFF + col); w2[n] = *(const f32x4*)(cw + 2 * DFF + col); bb[n] = *(const f32x4*)(cb + col); }
#pragma unroll
        for (int ai = 0; ai < 2; ++ai) { f32x4 r1p[2] = {{0.f, 0.f, 0.f, 0.f}, {0.f, 0.f, 0.f, 0.f}}, r2p[2] = {{0.f, 0.f, 0.f, 0.f}, {0.f, 0.f, 0.f, 0.f}}; const int slab = (u.pm * BM + ai * HALF + wr * 64) >> 6;
#pragma unroll
            for (int m = 0; m < 4; ++m) { const int row = row0 + ai * HALF + m * 16; const float rs = rsqrtf(ss[row] * (1.0f / DM) + RMS_EPS);
                f32x4 y[2], g[2], up[2];
#pragma unroll
                for (int n = 0; n < 2; ++n) { g[n] = acc[ai][0][m][n] * rs; up[n] = acc[ai][1][m][n] * rs;
                    f32x4 r1, r2; dpp_ror12(g[n], r1, r2);
                    const f32x4 p1 = fr >= 1 ? r1 : r1p[n], p2 = fr >= 2 ? r2 : r2p[n];
                    const f32x4 cv = bb[n] + w0[n] * p2 + w1[n] * p1 + w2[n] * g[n];
#pragma unroll
                    for (int i = 0; i < 4; ++i) y[n][i] = cv[i] * __builtin_amdgcn_rcpf(1.0f + __expf(-cv[i])) * up[n][i];
                    r1p[n] = r1; r2p[n] = r2; }
                if (m == 0 && fr < 2) {
#pragma unroll
                    for (int n = 0; n < 2; ++n) { *(f32x4*)(G4 + (size_t)(slab * 4 + fr) * DFF + colg + 4 * n) = g[n]; *(f32x4*)(UP2 + (size_t)(slab * 2 + fr) * DFF + colg + 4 * n) = up[n]; } }
                else { u32x4 w; w.x = cvt_pk_bf16(y[0][0], y[0][1]); w.y = cvt_pk_bf16(y[0][2], y[0][3]); w.z = cvt_pk_bf16(y[1][0], y[1][1]); w.w = cvt_pk_bf16(y[1][2], y[1][3]); *(u32x4*)(ACT + (size_t)row * DFF + colg) = w; }
                if (m == 3 && fr >= 14) {
#pragma unroll
                    for (int n = 0; n < 2; ++n) { *(f32x4*)(G4 + (size_t)(slab * 4 + 2 + (fr - 14)) * DFF + colg + 4 * n) = g[n];
                        const int t = row & 4095; if (t >= 4094) *(f32x4*)(cvp + (size_t)((row >> 12) * 2 + (t - 4094)) * DFF + colg + 4 * n) = g[n]; } } } }
    }
};

template <class Epi, class Sched, bool ALIGN_EPI = false, bool SP2 = false>
__device__ __forceinline__ void gemm_phase(PG8_LAS unsigned char* lds, const Gemm g, const Sched& S, const Epi& E) {
    int tid_ = threadIdx.x; asm volatile("" : "+v"(tid_));
    const int tid = tid_, wid = __builtin_amdgcn_readfirstlane(tid >> 6), lane = tid & 63, wr = wid >> 2, wc = wid & 3, fr = lane & 15, fq = lane >> 4;
    const int K = g.K, nt = K / BK;
    unsigned voffA[2], voffB[2];
#pragma unroll
    for (int i = 0; i < 2; ++i) { int R, C; stage_rc(tid * 16 + i * 8192, R, C); const int Rb = Epi::PERM ? ((R & ~31) + perm32(R & 31)) : R;
        voffA[i] = (unsigned)(R * K + C) * 2u; voffB[i] = (unsigned)(Rb * K + C) * 2u; }
    const size_t kstep = (size_t)(BK * 2);
    const size_t hstep = (size_t)HALF * K * 2;
    const size_t tstep = 2 * hstep;
    const unsigned ldsw = (unsigned)wid * 1024u;
    const int aoff = lds_byte(wr * 64 + fr, fq * 8), boff = lds_byte(wc * 32 + fr, fq * 8);
#define PG8_SA(b, h) (((b) * 2 + (h)) * HTB)
#define PG8_SB(b, h) ((4 + (b) * 2 + (h)) * HTB)
#define PG8_STAGE(bufoff, gbase, voff) do { _Pragma("unroll") for (int _i = 0; _i < 2; ++_i) \
        __builtin_amdgcn_global_load_lds((const unsigned*)((const char*)(gbase) + (voff)[_i]), (PG8_LAS unsigned*)(lds + (bufoff) + ldsw + _i * 8192), 16, 0, 0); } while (0)
#define PG8_LDA(dst, b, h) do { _Pragma("unroll") for (int m = 0; m < 4; ++m) _Pragma("unroll") for (int k = 0; k < 2; ++k) dst[m][k] = *(const PG8_LAS bf16x8*)(lds + PG8_SA(b, h) + aoff + m * 2048 + k * 1024); } while (0)
#define PG8_LDB(dst, b, h) do { _Pragma("unroll") for (int n = 0; n < 2; ++n) _Pragma("unroll") for (int k = 0; k < 2; ++k) dst[n][k] = *(const PG8_LAS bf16x8*)(lds + PG8_SB(b, h) + boff + n * 2048 + k * 1024); } while (0)
#define PG8_MMA(ai, bj, At, Bt) do { __builtin_amdgcn_s_setprio(1); _Pragma("unroll") for (int m = 0; m < 4; ++m) _Pragma("unroll") for (int n = 0; n < 2; ++n) _Pragma("unroll") for (int k = 0; k < 2; ++k) \
        acc[ai][bj][m][n] = __builtin_amdgcn_mfma_f32_16x16x32_bf16(Bt[n][k], At[m][k], acc[ai][bj][m][n], 0, 0, 0); __builtin_amdgcn_s_setprio(0); } while (0)
#define PG8_WAIT_V(n) asm volatile("s_waitcnt vmcnt(" #n ")" ::: "memory")
#define PG8_WAIT_L(n) asm volatile("s_waitcnt lgkmcnt(" #n ")" ::: "memory")
#define PG8_BAR __builtin_amdgcn_s_barrier()
#define PG8_SCHED __builtin_amdgcn_sched_barrier(0)
    Unit cur, nxt; int ui = 0;
    if (!S.next(0, cur)) return;
    f32x4 acc[2][2][4][2];
#pragma unroll
    for (int a = 0; a < 2; ++a)
#pragma unroll
        for (int b = 0; b < 2; ++b)
#pragma unroll
            for (int m = 0; m < 4; ++m)
#pragma unroll
                for (int n = 0; n < 2; ++n) acc[a][b][m][n] = (f32x4){0.f, 0.f, 0.f, 0.f};
    bf16x8 At[4][2], B0[2][2], B1[2][2];
    const char* cA = (const char*)g.A + (size_t)cur.pm * tstep; const char* cB = (const char*)g.Bt + (size_t)cur.pn * tstep;
    S.a_ready(cur);
    if constexpr (SP2) {
        PG8_STAGE(PG8_SB(0, 0), cB, voffB); PG8_STAGE(PG8_SB(0, 1), cB + hstep, voffB); PG8_STAGE(PG8_SA(0, 0), cA, voffA); PG8_STAGE(PG8_SA(0, 1), cA + hstep, voffA);
        if (wr == 1) PG8_BAR;
        PG8_WAIT_V(2); PG8_BAR;
        PG8_STAGE(PG8_SB(1, 0), cB + kstep, voffB); PG8_STAGE(PG8_SA(1, 0), cA + kstep, voffA); PG8_STAGE(PG8_SB(1, 1), cB + hstep + kstep, voffB);
        PG8_WAIT_V(6); PG8_BAR;
    } else {
        PG8_STAGE(PG8_SB(0, 0), cB, voffB); PG8_STAGE(PG8_SA(0, 0), cA, voffA); PG8_STAGE(PG8_SB(0, 1), cB + hstep, voffB); PG8_STAGE(PG8_SA(0, 1), cA + hstep, voffA);
        if (wr == 1) PG8_BAR;
        PG8_WAIT_V(4); PG8_BAR;
        PG8_STAGE(PG8_SB(1, 0), cB + kstep, voffB); PG8_STAGE(PG8_SA(1, 0), cA + kstep, voffA); PG8_STAGE(PG8_SB(1, 1), cB + hstep + kstep, voffB);
        PG8_WAIT_V(6); PG8_BAR;
    }
    for (;;) {
        const bool has_next = S.next(ui + 1, nxt);
        const char* nA = has_next ? (const char*)g.A + (size_t)nxt.pm * tstep : cA; const char* nB = has_next ? (const char*)g.Bt + (size_t)nxt.pn * tstep : cB;
        for (int t = 0; t < nt; t += 2) {
            const bool last = (t == nt - 2);
            const char* a1 = cA + (size_t)(t + 1) * kstep;
            const char* a2 = last ? nA : cA + (size_t)(t + 2) * kstep; const char* b2 = last ? nB : cB + (size_t)(t + 2) * kstep;
            const char* a3 = a2 + kstep; const char* b3 = b2 + kstep;
            if (last && has_next) S.a_ready(nxt);
            if constexpr (SP2) {
            PG8_LDB(B0, 0, 0); PG8_LDB(B1, 0, 1); PG8_SCHED; PG8_LDA(At, 0, 0); PG8_STAGE(PG8_SA(1, 1), a1 + hstep, voffA);
            PG8_WAIT_V(8); PG8_WAIT_L(0); PG8_BAR; PG8_MMA(0, 0, At, B0); PG8_MMA(0, 1, At, B1); PG8_BAR; PG8_SCHED;
            PG8_LDA(At, 0, 1); PG8_STAGE(PG8_SB(0, 0), b2, voffB); PG8_STAGE(PG8_SB(0, 1), b2 + hstep, voffB); PG8_STAGE(PG8_SA(0, 0), a2, voffA);
            PG8_WAIT_V(8); PG8_WAIT_L(0); PG8_BAR; PG8_MMA(1, 0, At, B0); PG8_MMA(1, 1, At, B1); PG8_BAR; PG8_SCHED;
            PG8_LDB(B0, 1, 0); PG8_LDB(B1, 1, 1); PG8_SCHED; PG8_LDA(At, 1, 0); PG8_STAGE(PG8_SA(0, 1), a2 + hstep, voffA);
            PG8_WAIT_V(8); PG8_WAIT_L(0); PG8_BAR; PG8_MMA(0, 0, At, B0); PG8_MMA(0, 1, At, B1); PG8_BAR; PG8_SCHED;
            PG8_LDA(At, 1, 1); PG8_STAGE(PG8_SB(1, 0), b3, voffB); PG8_STAGE(PG8_SB(1, 1), b3 + hstep, voffB); PG8_STAGE(PG8_SA(1, 0), a3, voffA);
            PG8_WAIT_V(8); PG8_WAIT_L(0); PG8_BAR; PG8_MMA(1, 0, At, B0); PG8_MMA(1, 1, At, B1); PG8_BAR; PG8_SCHED;
            } else {
            PG8_LDB(B0, 0, 0); PG8_SCHED; PG8_LDA(At, 0, 0); PG8_STAGE(PG8_SA(1, 1), a1 + hstep, voffA);
            PG8_WAIT_L(8); PG8_BAR; PG8_WAIT_L(0); PG8_MMA(0, 0, At, B0); PG8_BAR; PG8_SCHED;
            PG8_LDB(B1, 0, 1); PG8_STAGE(PG8_SB(0, 0), b2, voffB);
            PG8_BAR; PG8_WAIT_L(0); PG8_MMA(0, 1, At, B1); PG8_BAR;
            PG8_LDA(At, 0, 1); PG8_STAGE(PG8_SA(0, 0), a2, voffA);
            PG8_BAR; PG8_WAIT_L(0); PG8_MMA(1, 0, At, B0); PG8_BAR; PG8_SCHED;
            PG8_STAGE(PG8_SB(0, 1), b2 + hstep, voffB);
            PG8_WAIT_V(6); PG8_BAR; PG8_MMA(1, 1, At, B1); PG8_BAR;
            PG8_LDB(B0, 1, 0); PG8_SCHED; PG8_LDA(At, 1, 0); PG8_STAGE(PG8_SA(0, 1), a2 + hstep, voffA);
            PG8_WAIT_L(8); PG8_BAR; PG8_WAIT_L(0); PG8_MMA(0, 0, At, B0); PG8_BAR; PG8_SCHED;
            PG8_LDB(B1, 1, 1); PG8_STAGE(PG8_SB(1, 0), b3, voffB);
            PG8_BAR; PG8_WAIT_L(0); PG8_MMA(0, 1, At, B1); PG8_BAR;
            PG8_LDA(At, 1, 1); PG8_STAGE(PG8_SA(1, 0), a3, voffA);
            PG8_BAR; PG8_WAIT_L(0); PG8_MMA(1, 0, At, B0); PG8_BAR; PG8_SCHED;
            PG8_STAGE(PG8_SB(1, 1), b3 + hstep, voffB);
            PG8_WAIT_V(6); PG8_BAR; PG8_MMA(1, 1, At, B1); PG8_BAR;
            }
        }
        if constexpr (ALIGN_EPI) { if (wr == 0) PG8_BAR; }
        if constexpr (!Epi::AFTER_DRAIN) { E(acc, cur, wr, wc, fr, fq); S.done(cur); }
        if (!has_next) break;
#pragma unroll
        for (int a = 0; a < 2; ++a)
#pragma unroll
            for (int b = 0; b < 2; ++b)
#pragma unroll
                for (int m = 0; m < 4; ++m)
#pragma unroll
                    for (int n = 0; n < 2; ++n) acc[a][b][m][n] = (f32x4){0.f, 0.f, 0.f, 0.f};
        cur = nxt; cA = nA; cB = nB; ++ui;
        if constexpr (ALIGN_EPI) { if (wr == 1) PG8_BAR; }
    }
    PG8_WAIT_V(0);
    if constexpr (!ALIGN_EPI) { if (wr == 0) PG8_BAR; }
    PG8_BAR;
    if constexpr (Epi::AFTER_DRAIN) { E.fused(acc, cur, wr, wc, fr, fq, lds, wid, lane); S.done(cur); }
#undef PG8_SA
#undef PG8_SB
#undef PG8_STAGE
#undef PG8_LDA
#undef PG8_LDB
#undef PG8_MMA
#undef PG8_WAIT_V
#undef PG8_WAIT_L
#undef PG8_BAR
#undef PG8_SCHED
}
}


#ifndef PG8_SP2
#define PG8_SP2 true
#endif
#ifndef PG8_ALIGN
#define PG8_ALIGN true
#endif
constexpr int NWAVES = 8;
constexpr int MP = pg8::MP, MS = pg8::MS, MVALID = pg8::MVALID, MT = pg8::MT, DM = 1024, DFF = 2816;
constexpr int SEQ = 4096, NB = 4, NSB = 32, PAST = 8192, NPOOL = 2560;
constexpr int ZC0 = 3328, ZC1 = 2304;
constexpr int Z1_Q = 0, Z1_K = 768, Z1_V = 1024, Z1_IQ = 1280, Z1_IK = 1792, Z1_IW = 1856, Z1_MQ = 1920;
constexpr int NMEMROWS = 1024, MEMROW0 = MT;
constexpr float EPS = 1e-6f;
constexpr size_t MiB = 1u << 20;
constexpr size_t WS_CTL = 0, CTL_ZERO_BYTES = 2 * MiB;
constexpr size_t WS_WIN0 = 2 * MiB, WS_WIN1 = 11 * MiB, WS_WOUT = 16 * MiB, WS_WGU = 20 * MiB, WS_WD = 42 * MiB;
constexpr size_t WS_XB = 54 * MiB, WS_MEMKV = 89 * MiB, WS_MIX = 94 * MiB, WS_Z = 128 * MiB, WS_U = 234 * MiB, WS_UP = 324 * MiB, WS_ACT = 414 * MiB;
constexpr size_t WS_QB = 504 * MiB, WS_KB = 528 * MiB, WS_VB = 536 * MiB, WS_IQB = 544 * MiB, WS_IKB = 560 * MiB, WS_IW = 562 * MiB;
constexpr size_t WS_SQ = 563 * MiB, WS_SIQ = WS_SQ + 512 * 1024, WS_SIW = WS_SIQ + 384 * 1024, WS_SSC = 564 * MiB, WS_SIDX = 569 * MiB, WS_MASK = 570 * MiB, WS_SC = 578 * MiB, WS_END = 834 * MiB;
constexpr int SSC_LD = 8256;
constexpr int CW_TMO = 0, CW_BAR = 4096, CW_Q = 8192, CW_SS = 16384;
constexpr size_t O_YP = 0, O_YS = O_YP + (size_t)MP * DM, O_HP = O_YS + (size_t)MS * DM, O_HS = O_HP + 4 * 6 * 16384, O_KP = O_HS + 32 * 6 * 16384,
    O_VP = O_KP + (size_t)MP * 256, O_IKP = O_VP + (size_t)MP * 256, O_KS = O_IKP + (size_t)MP * 64, O_VS = O_KS + MS * 256, O_IKS = O_VS + MS * 256,
    O_MK = O_IKS + MS * 64, O_MV = O_MK + 2 * 1024 * 256, O_CVP = O_MV + 2 * 1024 * 256, O_CVS = O_CVP + 2 * 4 * 2 * DFF, O_END = O_CVS + 2 * 32 * 2 * DFF;
static_assert(O_END == 31412224, "output size");
constexpr int RING_OFF = 0, RING_BYTES = 131072;
constexpr int LDSCTL_OFF = RING_BYTES, MISC_OFF = LDSCTL_OFF + 320;
constexpr int LDS_BYTES = 147456;

#define GAS __attribute__((address_space(1)))
#define LAS __attribute__((address_space(3)))
typedef unsigned short bf16;
typedef unsigned v4u __attribute__((ext_vector_type(4)));
typedef float f32x4 __attribute__((ext_vector_type(4)));
typedef short bf16x8 __attribute__((ext_vector_type(8)));
typedef GAS unsigned gu32;
typedef GAS unsigned long long gu64;
#define RLX_AGENT __ATOMIC_RELAXED, __HIP_MEMORY_SCOPE_AGENT
#define LDS_WAIT() asm volatile("s_waitcnt lgkmcnt(0)" ::: "memory")
#define VM_WAIT() asm volatile("s_waitcnt vmcnt(0)" ::: "memory")
__device__ __forceinline__ unsigned long long rt() { return __builtin_amdgcn_s_memrealtime(); }
__device__ __forceinline__ unsigned f2bf(float f) { unsigned u = __builtin_bit_cast(unsigned, f); return (u + 0x7fffu + ((u >> 16) & 1u)) >> 16; }
__device__ __forceinline__ unsigned pk2(float lo, float hi) { return f2bf(lo) | (f2bf(hi) << 16); }

#define XB_TMO      128
#define XB_XCNT(j)  (256  + 64 * (j))
#define XB_XSUB(j)  (1280 + 64 * (j))
#define XB_XGEN(j)  (2304 + 64 * (j))
#define XB_TOP      3328
#define XB_TOPGEN   3392
#define XCD_BAR_WORDS 3456
#define XB_SPIN_CAP (1u << 18)

__device__ __forceinline__ unsigned xb_ld(unsigned* p)              { return __hip_atomic_load(p, __ATOMIC_RELAXED, __HIP_MEMORY_SCOPE_AGENT); }
__device__ __forceinline__ unsigned xb_add(unsigned* p, unsigned v) { return __hip_atomic_fetch_add(p, v, __ATOMIC_RELAXED, __HIP_MEMORY_SCOPE_AGENT); }
__device__ __forceinline__ unsigned xb_xcc_id() { return (unsigned)__builtin_amdgcn_s_getreg((3 << 11) | 20) & 0xFu; }
#define XB_SPIN(cond, bar) do { unsigned _sp = 0; while (cond) { __builtin_amdgcn_s_sleep(1); \
    if ((++_sp & 255u) == 0u) { if (xb_ld(&(bar)[XB_TMO])) break; if (_sp > XB_SPIN_CAP) { atomicAdd(&(bar)[XB_TMO], 1u); break; } } } } while (0)

struct XcdBarrier {
    unsigned* bar; unsigned x;
    volatile LAS unsigned* st;
};

__device__ __forceinline__ XcdBarrier xcd_barrier_post(unsigned* bar, volatile LAS unsigned* st) {
    XcdBarrier b; b.bar = bar; b.x = xb_xcc_id(); b.st = st;
    if (threadIdx.x == 0) (void)xb_add(&bar[XB_XCNT(b.x)], 1u);
    return b;
}
__device__ __forceinline__ void xcd_barrier_complete(unsigned* bar, unsigned x, unsigned& nloc, unsigned& nx) {
    const unsigned G = gridDim.x * gridDim.y * gridDim.z;
    unsigned sum, cnt, mine, sp = 0u;
    for (;;) {
        sum = 0u; cnt = 0u; mine = 0u;
#pragma unroll
        for (unsigned j = 0; j < 16; ++j) { const unsigned c = xb_ld(&bar[XB_XCNT(j)]); sum += c; cnt += (c > 0u) ? 1u : 0u; mine = (j == x) ? c : mine; }
        if (sum == G) break;
        __builtin_amdgcn_s_sleep(1);
        if ((++sp & 255u) == 0u) { if (xb_ld(&bar[XB_TMO])) break; if (sp > XB_SPIN_CAP) { atomicAdd(&bar[XB_TMO], 1u); break; } }
    }
    nloc = mine > 0u ? mine : 1u; nx = cnt > 0u ? cnt : 1u;
}

__device__ __forceinline__ void xcd_barrier(const XcdBarrier& b) {
    asm volatile("s_waitcnt vmcnt(0)" ::: "memory");
    __syncthreads();
    if (threadIdx.x == 0) {
        unsigned* bar = b.bar;
        __builtin_amdgcn_s_waitcnt(0);
        unsigned nloc = b.st[0], nx = b.st[1];
        if (nloc == 0u) { xcd_barrier_complete(bar, b.x, nloc, nx); b.st[0] = nloc; b.st[1] = nx; }
        const unsigned old = xb_add(&bar[XB_XSUB(b.x)], 1u);
        const unsigned gen = old / nloc;
        if (old + 1u == (gen + 1u) * nloc) {
            __builtin_amdgcn_fence(__ATOMIC_RELEASE, "agent");
            asm volatile("s_waitcnt vmcnt(0)" ::: "memory");
            const unsigned og = xb_add(&bar[XB_TOP], 1u);
            const unsigned tg = og / nx;
            if (og + 1u == (tg + 1u) * nx) xb_add(&bar[XB_TOPGEN], 1u);
            else XB_SPIN(xb_ld(&bar[XB_TOPGEN]) == tg, bar);
            __builtin_amdgcn_fence(__ATOMIC_ACQUIRE, "agent");
            xb_add(&bar[XB_XGEN(b.x)], 1u);
            asm volatile("s_waitcnt vmcnt(0)" ::: "memory");
        } else {
            XB_SPIN(xb_ld(&bar[XB_XGEN(b.x)]) == gen, bar);
            __builtin_amdgcn_fence(__ATOMIC_ACQUIRE, "agent");
            asm volatile("s_waitcnt vmcnt(0)" ::: "memory");
        }
    }
    __syncthreads();
}


struct Args { const float* in[29]; const int* page_table; float* out; unsigned char* ws; int ph_lo, ph_hi; };
typedef const __attribute__((address_space(4))) Args& ARGREF;
struct Ctx { LAS unsigned char* lds; volatile LAS unsigned* MISC; gu32* ctl; int tid, lane, wave, vcu, G, qoff; };
typedef float f32x16 __attribute__((ext_vector_type(16)));
typedef unsigned long long u64;

__device__ __forceinline__ float bf2f(unsigned b) { return __builtin_bit_cast(float, b << 16); }
__device__ __forceinline__ float wave_sum(float v) {
#pragma unroll
    for (int o = 1; o < 64; o <<= 1) v += __shfl_xor(v, o);
    return v;
}
__device__ __forceinline__ float wave_sum_fast(float x) {
    x += __builtin_bit_cast(float, __builtin_amdgcn_update_dpp(0, __builtin_bit_cast(int, x), 0xB1, 0xF, 0xF, false));
    x += __builtin_bit_cast(float, __builtin_amdgcn_update_dpp(0, __builtin_bit_cast(int, x), 0x4E, 0xF, 0xF, false));
    x += __builtin_bit_cast(float, __builtin_amdgcn_update_dpp(0, __builtin_bit_cast(int, x), 0x141, 0xF, 0xF, false));
    x += __builtin_bit_cast(float, __builtin_amdgcn_update_dpp(0, __builtin_bit_cast(int, x), 0x140, 0xF, 0xF, false));
    const int xi = __builtin_bit_cast(int, x);
    return (__builtin_bit_cast(float, __builtin_amdgcn_readlane(xi, 0)) + __builtin_bit_cast(float, __builtin_amdgcn_readlane(xi, 16))) +
           (__builtin_bit_cast(float, __builtin_amdgcn_readlane(xi, 32)) + __builtin_bit_cast(float, __builtin_amdgcn_readlane(xi, 48)));
}
__device__ __forceinline__ int crow(int r, int hi) { return (r & 3) + 8 * (r >> 2) + 4 * hi; }
__device__ __forceinline__ float sigmoidf_(float x) { return 1.0f / (1.0f + __expf(-x)); }
__device__ __forceinline__ float* ssptr(const Ctx& c, int i) { return (float*)(c.ctl + CW_SS) + (size_t)i * MT; }

__device__ __forceinline__ int q_next(Ctx& c, int qi) {
    __syncthreads();
    if (c.tid == 0) c.MISC[16] = atomicAdd((unsigned*)(c.ctl + CW_Q + 64 * (qi + c.qoff)), 1u);
    __syncthreads();
    return (int)c.MISC[16];
}

template <int K>
__device__ __forceinline__ f32x16 mm32(const LAS bf16* A, int lda, const LAS bf16* Bt, int ldb, f32x16 acc, int lane) {
    const int r = lane & 31, h = lane >> 5;
#pragma unroll
    for (int ks = 0; ks < K; ks += 16) {
        const bf16x8 a = *(const LAS bf16x8*)(A + r * lda + ks + 8 * h);
        const bf16x8 b = *(const LAS bf16x8*)(Bt + r * ldb + ks + 8 * h);
        acc = __builtin_amdgcn_mfma_f32_32x32x16_bf16(a, b, acc, 0, 0, 0);
    }
    return acc;
}

__device__ __forceinline__ int map_row(int mapid, int n, int row_off) {
    if (mapid == 0) return n + row_off;
    if (mapid == 1) return n < 1864 ? n : n + 56;
    if (mapid == 2) return (n >> 7) * 256 + (n & 127);
    return (n >> 7) * 256 + 128 + (n & 127);
}
__device__ __forceinline__ void transpose_item(const float* W, int K, int N, const float* kscale, bf16* WT, int mapid, int row_off, LAS float* scr, int item, int lane) {
    const int nblk = (N + 31) / 32, kb = item / nblk, nb = item % nblk, k0 = 64 * kb, n0 = 32 * nb;
    { const int n4 = (lane & 7) * 4, nn = n0 + n4 < N ? n0 + n4 : N - 4; f32x4 v[8];
#pragma unroll
      for (int i = 0; i < 8; ++i) v[i] = *(const f32x4*)(W + (size_t)(k0 + 8 * i + (lane >> 3)) * N + nn);
#pragma unroll
      for (int i = 0; i < 8; ++i) { const int kk = 8 * i + (lane >> 3); const float sc = kscale ? kscale[k0 + kk] : 1.0f; LAS float* d = scr + kk * 33 + n4;
          d[0] = v[i].x * sc; d[1] = v[i].y * sc; d[2] = v[i].z * sc; d[3] = v[i].w * sc; } }
    LDS_WAIT(); asm volatile("" ::: "memory");
    const int cc = lane & 7;
#pragma unroll
    for (int j = 0; j < 4; ++j) { const int nl = (lane >> 3) + 8 * j, n = n0 + nl; const LAS float* s = scr + (8 * cc) * 33 + nl;
        v4u o; o.x = pk2(s[0 * 33], s[1 * 33]); o.y = pk2(s[2 * 33], s[3 * 33]); o.z = pk2(s[4 * 33], s[5 * 33]); o.w = pk2(s[6 * 33], s[7 * 33]);
        if (n < N) *(GAS v4u*)(WT + (size_t)map_row(mapid, n, row_off) * K + k0 + 8 * cc) = o; }
    LDS_WAIT(); asm volatile("" ::: "memory");
}
constexpr int I_INH = 16 * 104, I_MKV = 16 * 16, I_DSA = 16 * 67, I_OUT = 16 * 32, I_G = 16 * 88, I_D = 44 * 32;
constexpr int W_N0 = I_INH + 2 * I_MKV + I_OUT + 2 * I_G + I_D, W_NITEMS = W_N0 + I_DSA + I_OUT + 2 * I_G + I_D;
__device__ __forceinline__ void convert_item(ARGREF a, int it, LAS float* scr, int lane) {
    unsigned char* ws = a.ws; int r = it;
    if (r < I_INH) { transpose_item(a.in[13], 1024, 3328, a.in[11], (bf16*)(ws + WS_WIN0), 0, 0, scr, r, lane); return; } r -= I_INH;
    if (r < 2 * I_MKV) { const int l = r / I_MKV; transpose_item(a.in[20] + (size_t)l * 1024 * 512, 1024, 512, nullptr, (bf16*)(ws + WS_WIN0), 0, 3328 + 512 * l, scr, r % I_MKV, lane); return; } r -= 2 * I_MKV;
    int l = 0;
    if (r >= I_OUT + 2 * I_G + I_D) { r -= I_OUT + 2 * I_G + I_D; l = 1;
        if (r < I_DSA) { transpose_item(a.in[16], 1024, 2120, a.in[11] + 1024, (bf16*)(ws + WS_WIN1), 1, 0, scr, r, lane); return; } r -= I_DSA; }
    if (r < I_OUT) { transpose_item(a.in[23] + (size_t)l * 1024 * 1024, 1024, 1024, nullptr, (bf16*)(ws + WS_WOUT) + (size_t)l * 1024 * 1024, 0, 0, scr, r, lane); return; } r -= I_OUT;
    if (r < I_G) { transpose_item(a.in[24] + (size_t)l * 1024 * DFF, 1024, DFF, a.in[12] + l * 1024, (bf16*)(ws + WS_WGU) + (size_t)l * 5632 * 1024, 2, 0, scr, r, lane); return; } r -= I_G;
    if (r < I_G) { transpose_item(a.in[25] + (size_t)l * 1024 * DFF, 1024, DFF, a.in[12] + l * 1024, (bf16*)(ws + WS_WGU) + (size_t)l * 5632 * 1024, 3, 0, scr, r, lane); return; } r -= I_G;
    transpose_item(a.in[28] + (size_t)l * DFF * 1024, DFF, 1024, nullptr, (bf16*)(ws + WS_WD) + (size_t)l * 1024 * DFF, 0, 0, scr, r, lane);
}
__device__ __forceinline__ void convert_layer1_tail(Ctx& c, ARGREF a, int first_idle) {
    LAS float* scr = (LAS float*)(c.lds + RING_OFF + c.wave * 16384);
    const int bx = (int)blockIdx.x; if (bx < first_idle) return;
    const int nw = (c.G - first_idle) * NWAVES;
    for (int it = W_N0 + (bx - first_idle) * NWAVES + c.wave; it < W_NITEMS; it += nw) convert_item(a, it, scr, c.lane);
}
__device__ __forceinline__ void p0_prologue(Ctx& c, ARGREF a) {
    LAS float* scr = (LAS float*)(c.lds + RING_OFF + c.wave * 16384);
    const int gw = c.vcu * NWAVES + c.wave, NGW = c.G * NWAVES, lane = c.lane;
    unsigned char* ws = a.ws;
    for (int it = gw; it < W_N0; it += NGW) convert_item(a, it, scr, lane);
    for (int rr = gw; rr < 184; rr += NGW) { const int row = rr < 56 ? 1864 + rr : 2176 + (rr - 56);
        GAS v4u* p = (GAS v4u*)((bf16*)(ws + WS_WIN1) + (size_t)row * 1024); p[lane] = (v4u){0u, 0u, 0u, 0u}; p[64 + lane] = (v4u){0u, 0u, 0u, 0u}; }
    float* ss0 = ssptr(c, 0);
    for (int m = gw; m < MT + NMEMROWS; m += NGW) {
        GAS u64* o8 = (GAS u64*)((bf16*)(ws + WS_XB) + (size_t)m * DM) + lane;
        if (m >= MVALID && m < MT) {
#pragma unroll
            for (int j = 0; j < 4; ++j) o8[64 * j] = 0ull;
            continue; }
        const float* src = m < MP ? a.in[0] + (size_t)m * DM : (m < MVALID ? a.in[1] + (size_t)(m - MP) * DM : a.in[10] + (size_t)(m - MT) * DM);
        const GAS f32x4* xr = (const GAS f32x4*)src + lane; f32x4 v[4]; float s = 0.f;
#pragma unroll
        for (int j = 0; j < 4; ++j) { v[j] = xr[64 * j]; s += (v[j].x * v[j].x + v[j].y * v[j].y) + (v[j].z * v[j].z + v[j].w * v[j].w); }
        s = wave_sum_fast(s);
#pragma unroll
        for (int j = 0; j < 4; ++j) o8[64 * j] = (u64)pk2(v[j].x, v[j].y) | ((u64)pk2(v[j].z, v[j].w) << 32);
        if (m < MVALID && lane == 0) ss0[m] = s;
    }
}

__device__ __forceinline__ void memattn_unit(Ctx& c, const bf16* Zq  , int ldz, int nrows_valid, const float* Kp, const float* Vp, int kstride,
                                             bool normk, const float* kgain, const float* qgain, bf16* Out  ) {
    LAS bf16* KN = (LAS bf16*)(c.lds);
    LAS bf16* VTm = (LAS bf16*)(c.lds + 36864);
    LAS bf16* QN = (LAS bf16*)(c.lds + 70656) + c.wave * (32 * 72);
    LAS float* LI = (LAS float*)(c.lds + 107520) + c.wave * 32;
    int tid = c.tid; asm volatile("" : "+v"(tid));
    const int lane = tid & 63, w = c.wave;
    {
        const int m = tid >> 1, dh = (tid & 1) * 32;
        f32x4 kv[8]; float s = 0.f;
#pragma unroll
        for (int j = 0; j < 8; ++j) { kv[j] = *(const f32x4*)(Kp + (size_t)m * kstride + dh + 4 * j); s += (kv[j].x * kv[j].x + kv[j].y * kv[j].y) + (kv[j].z * kv[j].z + kv[j].w * kv[j].w); }
        s += __shfl_xor(s, 1);
        const float rs = normk ? rsqrtf(s * (1.0f / 64.0f) + EPS) : 1.0f;
#pragma unroll
        for (int j = 0; j < 8; j += 2) { f32x4 g0 = {1.f, 1.f, 1.f, 1.f}, g1 = g0;
            if (normk) { g0 = *(const f32x4*)(kgain + dh + 4 * j); g1 = *(const f32x4*)(kgain + dh + 4 * j + 4); }
            const f32x4 x0 = kv[j] * rs * g0, x1 = kv[j + 1] * rs * g1;
            v4u o; o.x = pk2(x0.x, x0.y); o.y = pk2(x0.z, x0.w); o.z = pk2(x1.x, x1.y); o.w = pk2(x1.z, x1.w);
            *(LAS v4u*)(KN + m * 72 + dh + 4 * j) = o; }
#pragma unroll
        for (int j = 0; j < 8; ++j) { const f32x4 vv = *(const f32x4*)(Vp + (size_t)m * kstride + dh + 4 * j);
            VTm[(dh + 4 * j + 0) * 264 + m] = (bf16)f2bf(vv.x); VTm[(dh + 4 * j + 1) * 264 + m] = (bf16)f2bf(vv.y);
            VTm[(dh + 4 * j + 2) * 264 + m] = (bf16)f2bf(vv.z); VTm[(dh + 4 * j + 3) * 264 + m] = (bf16)f2bf(vv.w); }
    }
    {
        const int row = lane >> 1, hf = lane & 1, grow = w * 32 + row;
        float x[32]; float s = 0.f;
        if (grow < nrows_valid) {
#pragma unroll
            for (int j = 0; j < 4; ++j) { const v4u q = *(const v4u*)(Zq + (size_t)grow * ldz + hf * 32 + 8 * j);
                x[8 * j + 0] = bf2f(q.x & 0xffffu); x[8 * j + 1] = bf2f(q.x >> 16); x[8 * j + 2] = bf2f(q.y & 0xffffu); x[8 * j + 3] = bf2f(q.y >> 16);
                x[8 * j + 4] = bf2f(q.z & 0xffffu); x[8 * j + 5] = bf2f(q.z >> 16); x[8 * j + 6] = bf2f(q.w & 0xffffu); x[8 * j + 7] = bf2f(q.w >> 16); }
        } else {
#pragma unroll
            for (int j = 0; j < 32; ++j) x[j] = 0.f;
        }
#pragma unroll
        for (int j = 0; j < 32; ++j) s += x[j] * x[j];
        s += __shfl_xor(s, 1);
        const float rs = rsqrtf(s * (1.0f / 64.0f) + EPS) * 0.125f;
#pragma unroll
        for (int j = 0; j < 32; j += 8) { v4u o;
            o.x = pk2(x[j] * rs * qgain[hf * 32 + j], x[j + 1] * rs * qgain[hf * 32 + j + 1]); o.y = pk2(x[j + 2] * rs * qgain[hf * 32 + j + 2], x[j + 3] * rs * qgain[hf * 32 + j + 3]);
            o.z = pk2(x[j + 4] * rs * qgain[hf * 32 + j + 4], x[j + 5] * rs * qgain[hf * 32 + j + 5]); o.w = pk2(x[j + 6] * rs * qgain[hf * 32 + j + 6], x[j + 7] * rs * qgain[hf * 32 + j + 7]);
            *(LAS v4u*)(QN + row * 72 + hf * 32 + j) = o; }
    }
    __syncthreads();
    if (w * 32 < nrows_valid) {
        const int r32 = lane & 31, hh = lane >> 5;
        f32x16 s[8];
#pragma unroll
        for (int mt = 0; mt < 8; ++mt) { f32x16 z = {}; s[mt] = mm32<64>(KN + mt * 32 * 72, 72, QN, 72, z, lane); }
        float mx = -1e30f;
#pragma unroll
        for (int mt = 0; mt < 8; ++mt)
#pragma unroll
            for (int r = 0; r < 16; ++r) mx = fmaxf(mx, s[mt][r]);
        mx = fmaxf(mx, __shfl_xor(mx, 32));
        float l = 0.f;
#pragma unroll
        for (int mt = 0; mt < 8; ++mt)
#pragma unroll
            for (int r = 0; r < 16; ++r) { const float p = __expf(s[mt][r] - mx); s[mt][r] = p; l += p; }
        l += __shfl_xor(l, 32);
        if (hh == 0) LI[r32] = l;
        f32x16 o[2] = {};
#pragma unroll
        for (int mt = 0; mt < 8; ++mt)
#pragma unroll
            for (int sx = 0; sx < 2; ++sx) {
                v4u pa; pa.x = pk2(s[mt][8 * sx + 0], s[mt][8 * sx + 1]); pa.y = pk2(s[mt][8 * sx + 2], s[mt][8 * sx + 3]);
                pa.z = pk2(s[mt][8 * sx + 4], s[mt][8 * sx + 5]); pa.w = pk2(s[mt][8 * sx + 6], s[mt][8 * sx + 7]);
                const bf16x8 af = __builtin_bit_cast(bf16x8, pa);
#pragma unroll
                for (int dt = 0; dt < 2; ++dt) { const LAS bf16* vp = VTm + (dt * 32 + r32) * 264 + mt * 32 + 16 * sx + 4 * hh;
                    const u64 lo = *(const LAS u64*)vp, hi = *(const LAS u64*)(vp + 8);
                    v4u bw; bw.x = (unsigned)lo; bw.y = (unsigned)(lo >> 32); bw.z = (unsigned)hi; bw.w = (unsigned)(hi >> 32);
                    o[dt] = __builtin_amdgcn_mfma_f32_32x32x16_bf16(af, __builtin_bit_cast(bf16x8, bw), o[dt], 0, 0, 0); }
            }
        LDS_WAIT();
#pragma unroll
        for (int r = 0; r < 16; ++r) { const int qr = crow(r, hh), grow = w * 32 + qr; const float il = 1.0f / LI[qr];
            if (grow < nrows_valid) {
#pragma unroll
                for (int dt = 0; dt < 2; ++dt) Out[(size_t)grow * DM + dt * 32 + r32] = (bf16)f2bf(o[dt][r] * il); } }
    }
}

constexpr int HG_GS = 4, HG_NG = SEQ / (32 * HG_GS);
constexpr size_t WS_HOL = WS_U, WS_HQC = WS_UP, WS_HUT = WS_ACT, WS_HST = WS_ACT + 64 * MiB, WS_HDG = WS_ACT + 50 * MiB;
template <bool PROMPT>
__device__ __forceinline__ void hgrn_unit(Ctx& c, ARGREF a, int b, int h, int g) {
    LAS unsigned char* L = c.lds;
    LAS float* LFt = (LAS float*)(L + 0);
    LAS float* OB = (LAS float*)(L + 0);
    LAS float* SEG = (LAS float*)(L + 16896);
    LAS float* DVv = (LAS float*)(L + 18944);
    LAS bf16* QD = (LAS bf16*)(L + 19456);
    LAS bf16* KD = (LAS bf16*)(L + 28160);
    LAS bf16* KET = (LAS bf16*)(L + 36864);
    LAS bf16* VT = (LAS bf16*)(L + 47104);
    LAS bf16* SCB = (LAS bf16*)(L + 57344);
    LAS bf16* STt = (LAS bf16*)(L + 59904);
    LAS float* BOFF = (LAS float*)(L + 94720);
    int tid = c.tid; asm volatile("" : "+v"(tid));
    const int lane = tid & 63, w = c.wave, r32 = lane & 31, hh = lane >> 5;
    const int te = tid & 31, k8 = (tid >> 5) * 8;
    const int tf = tid >> 4, v8 = (tid & 15) * 8;
    const bf16* Z = (const bf16*)(a.ws + WS_Z);
    bf16* MIX = (bf16*)(a.ws + WS_MIX);
    const int nch = PROMPT ? HG_GS : 1, nvalid = PROMPT ? 32 : 4;
    const int kt = w >> 1, vt0 = 2 * (w & 1);
    const int unit = (b * 6 + h) * HG_NG + g;
    f32x16 S0 = {}, S1 = {};
    if (!PROMPT) { const float* sp = a.in[7] + (size_t)(b * 6 + h) * 16384;
#pragma unroll
        for (int r = 0; r < 16; ++r) { const int k = 32 * kt + crow(r, hh); S0[r] = sp[k * 128 + 32 * vt0 + r32]; S1[r] = sp[k * 128 + 32 * (vt0 + 1) + r32]; } }
    float lbv[8];
#pragma unroll
    for (int j = 0; j < 8; ++j) { const float l0 = a.in[14][h * 128 + k8 + j], l1 = a.in[14][768 + h * 128 + k8 + j]; lbv[j] = 1.0f / (1.0f + __expf(l1 - l0)); }
    __syncthreads();
    if (tid < 128) BOFF[tid] = 0.f;
#define HG_WRITE_ST() do { _Pragma("unroll") for (int g4 = 0; g4 < 4; ++g4) { const int k0 = 32 * kt + 8 * g4 + 4 * hh; \
        *(LAS u64*)(STt + (32 * vt0 + r32) * 136 + k0) = (u64)pk2(S0[4 * g4], S0[4 * g4 + 1]) | ((u64)pk2(S0[4 * g4 + 2], S0[4 * g4 + 3]) << 32); \
        *(LAS u64*)(STt + (32 * (vt0 + 1) + r32) * 136 + k0) = (u64)pk2(S1[4 * g4], S1[4 * g4 + 1]) | ((u64)pk2(S1[4 * g4 + 2], S1[4 * g4 + 3]) << 32); } } while (0)
    HG_WRITE_ST();
    v4u zq = {0u, 0u, 0u, 0u}, zf = zq, zi = zq;
    { const int row = (PROMPT ? b * SEQ + (g * HG_GS) * 32 : MP + 4 * b) + te;
      if (te < nvalid) { const bf16* zr = Z + (size_t)row * ZC0 + h * 128 + k8; zq = *(const v4u*)zr; zf = *(const v4u*)(zr + 768); zi = *(const v4u*)(zr + 1536); } }
#pragma unroll 1
    for (int ch = 0; ch < nch; ++ch) {
        const int row0 = PROMPT ? b * SEQ + (g * HG_GS + ch) * 32 : MP + 4 * b, row = row0 + te;
        const bool valid = te < nvalid;
        float qs[8], kk[8];
        {
            const unsigned qw[4] = {zq.x, zq.y, zq.z, zq.w}, fw[4] = {zf.x, zf.y, zf.z, zf.w}, iw[4] = {zi.x, zi.y, zi.z, zi.w};
#pragma unroll
            for (int j = 0; j < 8; ++j) { const float q = bf2f((qw[j >> 1] >> (16 * (j & 1))) & 0xffffu), fp = bf2f((fw[j >> 1] >> (16 * (j & 1))) & 0xffffu);
                const float sg = sigmoidf_(fp), f = lbv[j] + (1.0f - lbv[j]) * sg;
                qs[j] = valid ? q * sigmoidf_(q) : 0.f; kk[j] = valid ? (1.0f - f) : 0.f;
                LFt[(k8 + j) * 33 + te] = valid ? __logf(f) : 0.f;
                VT[(k8 + j) * 40 + te] = (bf16)((iw[j >> 1] >> (16 * (j & 1))) & 0xffffu); }
            if (PROMPT && ch + 1 < nch) { const bf16* zr = Z + (size_t)(row + 32) * ZC0 + h * 128 + k8; zq = *(const v4u*)zr; zf = *(const v4u*)(zr + 768); zi = *(const v4u*)(zr + 1536); }
        }
        __syncthreads();
        {
            const int k = tid & 127, sg_ = tid >> 7; float bsum = 0.f;
#pragma unroll
            for (int i = 0; i < 8; ++i) { bsum += LFt[k * 33 + 8 * sg_ + i]; LFt[k * 33 + 8 * sg_ + i] = bsum; }
            SEG[sg_ * 128 + k] = bsum; }
        __syncthreads();
        {
            float bb[8], bl[8];
            { f32x4 t0[4], t1[4];
#pragma unroll
              for (int s_ = 0; s_ < 4; ++s_) { t0[s_] = *(const LAS f32x4*)(SEG + s_ * 128 + k8); t1[s_] = *(const LAS f32x4*)(SEG + s_ * 128 + k8 + 4); }
              const int sgt = te >> 3; f32x4 o0 = {0.f, 0.f, 0.f, 0.f}, o1 = o0;
#pragma unroll
              for (int s_ = 0; s_ < 3; ++s_) if (s_ < sgt) { o0 += t0[s_]; o1 += t1[s_]; }
              const f32x4 l0 = (t0[0] + t0[1]) + (t0[2] + t0[3]), l1 = (t1[0] + t1[1]) + (t1[2] + t1[3]);
              const float of[8] = {o0.x, o0.y, o0.z, o0.w, o1.x, o1.y, o1.z, o1.w}; const float lt[8] = {l0.x, l0.y, l0.z, l0.w, l1.x, l1.y, l1.z, l1.w};
#pragma unroll
              for (int j = 0; j < 8; ++j) { bb[j] = LFt[(k8 + j) * 33 + te] + of[j]; bl[j] = lt[j]; } }
            float qd[8], kd[8];
#pragma unroll
            for (int j = 0; j < 8; ++j) { qd[j] = qs[j] * __expf(bb[j]); kd[j] = kk[j] * __expf(-bb[j]); KET[(k8 + j) * 40 + te] = (bf16)f2bf(kk[j] * __expf(bl[j] - bb[j])); }
            v4u o; o.x = pk2(qd[0], qd[1]); o.y = pk2(qd[2], qd[3]); o.z = pk2(qd[4], qd[5]); o.w = pk2(qd[6], qd[7]); *(LAS v4u*)(QD + te * 136 + k8) = o;
            if (PROMPT) { const f32x4 f0 = *(const LAS f32x4*)(BOFF + k8), f1 = *(const LAS f32x4*)(BOFF + k8 + 4);
                const float bo[8] = {f0.x, f0.y, f0.z, f0.w, f1.x, f1.y, f1.z, f1.w}; float qc[8];
#pragma unroll
                for (int j = 0; j < 8; ++j) qc[j] = qd[j] * __expf(bo[j]);
                v4u oc; oc.x = pk2(qc[0], qc[1]); oc.y = pk2(qc[2], qc[3]); oc.z = pk2(qc[4], qc[5]); oc.w = pk2(qc[6], qc[7]);
                *(v4u*)((bf16*)(a.ws + WS_HQC) + (size_t)row * 768 + h * 128 + k8) = oc; }
            o.x = pk2(kd[0], kd[1]); o.y = pk2(kd[2], kd[3]); o.z = pk2(kd[4], kd[5]); o.w = pk2(kd[6], kd[7]); *(LAS v4u*)(KD + te * 136 + k8) = o;
            if (te == 0) {
#pragma unroll
                for (int j = 0; j < 8; ++j) DVv[k8 + j] = __expf(bl[j]); }
        }
        __syncthreads();
        f32x16 oacc = {};
        if (w == 4) { f32x16 z = {}; const f32x16 sc = mm32<128>(QD, 136, KD, 136, z, lane);
#pragma unroll
            for (int r = 0; r < 16; ++r) { const int t = crow(r, hh); SCB[t * 40 + r32] = (bf16)f2bf(r32 <= t ? sc[r] : 0.f); } }
        if (w < 4) oacc = mm32<128>(QD, 136, STt + (w * 32) * 136, 136, oacc, lane);
        if (PROMPT && tid >= 384) { const int k = tid - 384; BOFF[k] += (SEG[k] + SEG[128 + k]) + (SEG[256 + k] + SEG[384 + k]); }
        __syncthreads();
        if (w < 4) { oacc = mm32<32>(SCB, 40, VT + (w * 32) * 40, 40, oacc, lane);
#pragma unroll
            for (int r = 0; r < 16; ++r) OB[crow(r, hh) * 128 + w * 32 + r32] = oacc[r]; }
        {
#pragma unroll
            for (int r = 0; r < 16; ++r) { const float d = DVv[32 * kt + crow(r, hh)]; S0[r] *= d; S1[r] *= d; }
            S0 = mm32<32>(KET + (kt * 32) * 40, 40, VT + (vt0 * 32) * 40, 40, S0, lane);
            S1 = mm32<32>(KET + (kt * 32) * 40, 40, VT + ((vt0 + 1) * 32) * 40, 40, S1, lane);
        }
        __syncthreads();
        HG_WRITE_ST();
        {
            const int orow = row0 + tf;
            const f32x4 o0 = *(const LAS f32x4*)(OB + tf * 128 + v8), o1 = *(const LAS f32x4*)(OB + tf * 128 + v8 + 4);
            if (PROMPT) { float* ol = (float*)(a.ws + WS_HOL) + (size_t)orow * 768 + h * 128 + v8; *(f32x4*)ol = o0; *(f32x4*)(ol + 4) = o1; }
            else {
                float ov[8] = {o0.x, o0.y, o0.z, o0.w, o1.x, o1.y, o1.z, o1.w}; float s = 0.f;
#pragma unroll
                for (int j = 0; j < 8; ++j) s += ov[j] * ov[j];
                s += __shfl_xor(s, 1); s += __shfl_xor(s, 2); s += __shfl_xor(s, 4); s += __shfl_xor(s, 8);
                const float rs = rsqrtf(s * (1.0f / 128.0f) + EPS);
                if (tf < nvalid) { const v4u gz = *(const v4u*)(Z + (size_t)orow * ZC0 + 2304 + h * 128 + v8); const unsigned gw_[4] = {gz.x, gz.y, gz.z, gz.w}; float y[8];
#pragma unroll
                    for (int j = 0; j < 8; ++j) { const float gg = bf2f((gw_[j >> 1] >> (16 * (j & 1))) & 0xffffu); y[j] = ov[j] * rs * a.in[15][v8 + j] * (gg * sigmoidf_(gg)); }
                    v4u o; o.x = pk2(y[0], y[1]); o.y = pk2(y[2], y[3]); o.z = pk2(y[4], y[5]); o.w = pk2(y[6], y[7]); *(v4u*)(MIX + (size_t)orow * DM + h * 128 + v8) = o; }
            }
        }
        __syncthreads();
    }
#undef HG_WRITE_ST
    if (PROMPT) {
        float* ut = (float*)(a.ws + WS_HUT) + (size_t)unit * 16384;
#pragma unroll
        for (int g4 = 0; g4 < 4; ++g4) { const int k0 = 32 * kt + 8 * g4 + 4 * hh;
            *(f32x4*)(ut + (32 * vt0 + r32) * 128 + k0) = (f32x4){S0[4 * g4], S0[4 * g4 + 1], S0[4 * g4 + 2], S0[4 * g4 + 3]};
            *(f32x4*)(ut + (32 * (vt0 + 1) + r32) * 128 + k0) = (f32x4){S1[4 * g4], S1[4 * g4 + 1], S1[4 * g4 + 2], S1[4 * g4 + 3]}; }
        if (tid < 128) ((float*)(a.ws + WS_HDG))[(size_t)unit * 128 + tid] = __expf(BOFF[tid]);
    } else {
        float* so = a.out + O_HS + (size_t)(b * 6 + h) * 16384;
#pragma unroll
        for (int r = 0; r < 16; ++r) { const int k = 32 * kt + crow(r, hh); so[k * 128 + 32 * vt0 + r32] = S0[r]; so[k * 128 + 32 * (vt0 + 1) + r32] = S1[r]; }
    }
}
__device__ __forceinline__ void hgrn_scan(Ctx& c, ARGREF a) {
    const float* UT = (const float*)(a.ws + WS_HUT); const float* DG = (const float*)(a.ws + WS_HDG); bf16* STo = (bf16*)(a.ws + WS_HST);
    for (int idx = c.vcu * 512 + c.tid; idx < 24 * 16384; idx += c.G * 512) {
        const int bh = idx >> 14, e = idx & 16383, k = e & 127, v = e >> 7;
        float s = 0.f, ut[HG_NG], dg[HG_NG];
#pragma unroll
        for (int g = 0; g < HG_NG; ++g) { const size_t u = (size_t)(bh * HG_NG + g); ut[g] = UT[u * 16384 + e]; dg[g] = DG[u * 128 + k]; }
#pragma unroll
        for (int g = 0; g < HG_NG; ++g) { const size_t u = (size_t)(bh * HG_NG + g); STo[u * 16384 + e] = (bf16)f2bf(s); s = dg[g] * s + ut[g]; }
        a.out[O_HP + (size_t)bh * 16384 + k * 128 + v] = s;
    }
}
__device__ __forceinline__ void hgrn_fix_unit(Ctx& c, ARGREF a, int b, int h, int g) {
    LAS bf16* STt = (LAS bf16*)(c.lds);
    LAS bf16* QCl = (LAS bf16*)(c.lds + 34816);
    LAS float* OB = (LAS float*)(c.lds + 34816 + 17408);
    int tid = c.tid; asm volatile("" : "+v"(tid));
    const int lane = tid & 63, w = c.wave, r32 = lane & 31, hh = lane >> 5;
    const int unit = (b * 6 + h) * HG_NG + g, row0 = b * SEQ + g * 128;
    const bf16* Z = (const bf16*)(a.ws + WS_Z); bf16* MIX = (bf16*)(a.ws + WS_MIX);
    const bf16* QC = (const bf16*)(a.ws + WS_HQC); const float* OL = (const float*)(a.ws + WS_HOL);
    const bf16* stg = (const bf16*)(a.ws + WS_HST) + (size_t)unit * 16384;
    __syncthreads();
#pragma unroll
    for (int i = 0; i < 4; ++i) { const int cidx = tid + 512 * i, v = cidx >> 4, kc = (cidx & 15) * 8; *(LAS v4u*)(STt + v * 136 + kc) = *(const v4u*)(stg + v * 128 + kc); }
    const int te = tid >> 4, k8 = (tid & 15) * 8;
    float onv[8];
#pragma unroll
    for (int j = 0; j < 8; ++j) onv[j] = a.in[15][k8 + j];
#pragma unroll 1
    for (int hf = 0; hf < 2; ++hf) {
        const int rb = row0 + hf * 64;
#pragma unroll
        for (int i = 0; i < 2; ++i) { const int cidx = tid + 512 * i, r = cidx >> 4, kc = (cidx & 15) * 8; *(LAS v4u*)(QCl + r * 136 + kc) = *(const v4u*)(QC + (size_t)(rb + r) * 768 + h * 128 + kc); }
        f32x4 pl0[2], pl1[2]; v4u pgz[2];
#pragma unroll
        for (int ps = 0; ps < 2; ++ps) { const int row = rb + ps * 32 + te; const float* ol = OL + (size_t)row * 768 + h * 128 + k8; pl0[ps] = *(const f32x4*)ol; pl1[ps] = *(const f32x4*)(ol + 4);
            pgz[ps] = *(const v4u*)(Z + (size_t)row * ZC0 + 2304 + h * 128 + k8); }
        __syncthreads();
        { const int rt = w >> 2, vt = w & 3; f32x16 o = {};
          o = mm32<128>(QCl + (rt * 32) * 136, 136, STt + (vt * 32) * 136, 136, o, lane);
#pragma unroll
          for (int r = 0; r < 16; ++r) OB[(rt * 32 + crow(r, hh)) * 128 + vt * 32 + r32] = o[r]; }
        __syncthreads();
#pragma unroll
        for (int ps = 0; ps < 2; ++ps) { const int r = ps * 32 + te, row = rb + r;
            const f32x4 c0 = *(const LAS f32x4*)(OB + r * 128 + k8), c1 = *(const LAS f32x4*)(OB + r * 128 + k8 + 4);
            const f32x4 l0 = pl0[ps], l1 = pl1[ps]; const v4u gz = pgz[ps];
            float ov[8] = {c0.x + l0.x, c0.y + l0.y, c0.z + l0.z, c0.w + l0.w, c1.x + l1.x, c1.y + l1.y, c1.z + l1.z, c1.w + l1.w}; float s = 0.f;
#pragma unroll
            for (int j = 0; j < 8; ++j) s += ov[j] * ov[j];
            s += __shfl_xor(s, 1); s += __shfl_xor(s, 2); s += __shfl_xor(s, 4); s += __shfl_xor(s, 8);
            const float rs = rsqrtf(s * (1.0f / 128.0f) + EPS);
            const unsigned gw_[4] = {gz.x, gz.y, gz.z, gz.w}; float y[8];
#pragma unroll
            for (int j = 0; j < 8; ++j) { const float gg = bf2f((gw_[j >> 1] >> (16 * (j & 1))) & 0xffffu); y[j] = ov[j] * rs * onv[j] * (gg * sigmoidf_(gg)); }
            v4u o; o.x = pk2(y[0], y[1]); o.y = pk2(y[2], y[3]); o.z = pk2(y[4], y[5]); o.w = pk2(y[6], y[7]); *(v4u*)(MIX + (size_t)row * DM + h * 128 + k8) = o; }
        __syncthreads();
    }
}

__device__ __forceinline__ void memkv_finalize_row(ARGREF a, int layer, int row, int lane) {
    const float* src = (const float*)(a.ws + WS_MEMKV) + (size_t)row * 1024 + layer * 512;
    const int hd = lane >> 4, d4 = (lane & 15) * 4;
    const f32x4 k = *(const f32x4*)(src + hd * 64 + d4), v = *(const f32x4*)(src + 256 + hd * 64 + d4);
    float s = (k.x * k.x + k.y * k.y) + (k.z * k.z + k.w * k.w);
    s += __shfl_xor(s, 1); s += __shfl_xor(s, 2); s += __shfl_xor(s, 4); s += __shfl_xor(s, 8);
    const float rs = rsqrtf(s * (1.0f / 64.0f) + EPS); const f32x4 g = *(const f32x4*)(a.in[22] + layer * 64 + d4);
    *(f32x4*)(a.out + O_MK + ((size_t)layer * 1024 + row) * 256 + hd * 64 + d4) = k * rs * g;
    *(f32x4*)(a.out + O_MV + ((size_t)layer * 1024 + row) * 256 + hd * 64 + d4) = v;
}

__device__ __forceinline__ void memattn_prompt_unit(Ctx& c, ARGREF a, int layer, int u) {
    const int blk = u & 15, hd = (u >> 4) & 3, b = u >> 6;
    const bf16* Z = (const bf16*)(a.ws + WS_Z); const int ldz = layer ? ZC1 : ZC0, qc = layer ? Z1_MQ : 3072;
    const float* kv = (const float*)(a.ws + WS_MEMKV) + (size_t)(b * 256) * 1024 + layer * 512 + hd * 64;
    const int row0 = b * SEQ + blk * 256;
    memattn_unit(c, Z + (size_t)row0 * ldz + qc + hd * 64, ldz, 256, kv, kv + 256, 1024, true, a.in[22] + layer * 64, a.in[21] + layer * 64,
                 (bf16*)(a.ws + WS_MIX) + (size_t)row0 * DM + 768 + hd * 64);
}
__device__ __forceinline__ void memattn_sample_unit(Ctx& c, ARGREF a, int layer, int u) {
    const int hd = u & 3, sb = u >> 2;
    const bf16* Z = (const bf16*)(a.ws + WS_Z); const int ldz = layer ? ZC1 : ZC0, qc = layer ? Z1_MQ : 3072;
    const size_t off = ((size_t)(layer * 32 + sb) * 256) * 256 + hd * 64;
    const int row0 = MP + sb * 4;
    memattn_unit(c, Z + (size_t)row0 * ldz + qc + hd * 64, ldz, 4, a.in[5] + off, a.in[6] + off, 256, false, nullptr, a.in[21] + layer * 64,
                 (bf16*)(a.ws + WS_MIX) + (size_t)row0 * DM + 768 + hd * 64);
}

__device__ __forceinline__ void p2_mixer0(Ctx& c, ARGREF a) {
    constexpr int U_HP = 24 * HG_NG, U_MAP = U_HP + 256, U_HS = U_MAP + 192, U_MAS = U_HS + 128, U_FIN = U_MAS + 256;
    for (;;) {
        const int u = q_next(c, 0);
        if (u >= U_FIN) break;
        if (u < U_HP) hgrn_unit<true>(c, a, u / (6 * HG_NG), (u / HG_NG) % 6, u % HG_NG);
        else if (u < U_MAP) memattn_prompt_unit(c, a, 0, u - U_HP);
        else if (u < U_HS) { const int v = u - U_MAP; hgrn_unit<false>(c, a, v / 6, v % 6, 0); }
        else if (u < U_MAS) memattn_sample_unit(c, a, 0, u - U_HS);
        else { const int v = (u - U_MAS) * 8 + c.wave; memkv_finalize_row(a, v >> 10, v & 1023, c.lane); }
    }
}
__device__ __forceinline__ void p2c_hgrn_fix(Ctx& c, ARGREF a) {
    for (int u = c.vcu; u < 24 * HG_NG; u += c.G) hgrn_fix_unit(c, a, u / (6 * HG_NG), (u / HG_NG) % 6, u % HG_NG);
}

constexpr size_t WS_G4 = WS_UP + 64 * MiB, WS_UP2 = WS_UP + 80 * MiB;
__device__ __forceinline__ void conv_fixup_tile(Ctx& c, ARGREF a, int layer, int pm) {
    const float* G4 = (const float*)(a.ws + WS_G4); const float* UP2 = (const float*)(a.ws + WS_UP2); bf16* ACT = (bf16*)(a.ws + WS_ACT);
    const float* cw = a.in[26] + (size_t)layer * 3 * DFF; const float* cb = a.in[27] + (size_t)layer * DFF;
    for (int idx = c.tid; idx < 8 * (DFF / 4); idx += 512) {
        const int rr = idx / (DFF / 4), c4 = (idx - rr * (DFF / 4)) * 4;
        const int slab = 4 * pm + (rr >> 1), fr = rr & 1, row = slab * 64 + fr, t = row & 4095, sl1 = slab > 0 ? slab - 1 : 0;
        const f32x4 ut = *(const f32x4*)(G4 + (size_t)(slab * 4 + fr) * DFF + c4), up = *(const f32x4*)(UP2 + (size_t)(slab * 2 + fr) * DFF + c4);
        const f32x4 a0 = *(const f32x4*)(G4 + (size_t)(slab * 4 + 0) * DFF + c4), b3 = *(const f32x4*)(G4 + (size_t)(sl1 * 4 + 3) * DFF + c4), b2 = *(const f32x4*)(G4 + (size_t)(sl1 * 4 + 2) * DFF + c4);
        f32x4 u1, u2;
        { const bool f1 = fr == 1, t0 = t == 0, t1 = t == 1;
          u1.x = f1 ? a0.x : (t0 ? 0.f : b3.x); u1.y = f1 ? a0.y : (t0 ? 0.f : b3.y); u1.z = f1 ? a0.z : (t0 ? 0.f : b3.z); u1.w = f1 ? a0.w : (t0 ? 0.f : b3.w);
          u2.x = f1 ? (t1 ? 0.f : b3.x) : (t0 ? 0.f : b2.x); u2.y = f1 ? (t1 ? 0.f : b3.y) : (t0 ? 0.f : b2.y); u2.z = f1 ? (t1 ? 0.f : b3.z) : (t0 ? 0.f : b2.z); u2.w = f1 ? (t1 ? 0.f : b3.w) : (t0 ? 0.f : b2.w); }
        const f32x4 w0 = *(const f32x4*)(cw + c4), w1 = *(const f32x4*)(cw + DFF + c4), w2 = *(const f32x4*)(cw + 2 * DFF + c4), bb = *(const f32x4*)(cb + c4);
        const f32x4 cv = bb + w0 * u2 + w1 * u1 + w2 * ut;
        const float y0 = cv.x * sigmoidf_(cv.x) * up.x, y1 = cv.y * sigmoidf_(cv.y) * up.y, y2 = cv.z * sigmoidf_(cv.z) * up.z, y3 = cv.w * sigmoidf_(cv.w) * up.w;
        *(u64*)(ACT + (size_t)row * DFF + c4) = (u64)pk2(y0, y1) | ((u64)pk2(y2, y3) << 32);
    }
}


struct SgArgs { const bf16* A; const bf16* Bt; int K; int mode; bf16* Z; int ldz; const float* ssin; const float* resid; const bf16* rb; float* y; bf16* xb; float* ssout; bf16* ACT; float* cvs; const float* cst; const float* cw; const float* cb; };
__device__ __forceinline__ void sgemm_unit(Ctx& c, const SgArgs& g, int n0) {
    int tid = c.tid; asm volatile("" : "+v"(tid));
    const int lane = tid & 63, w = c.wave, r32 = lane & 31, hh = lane >> 5;
    const int K = g.K, ks = K >> 3;
    const int f2 = (n0 >> 1) + (r32 & 15), brow = g.mode == 2 ? (f2 >> 7) * 256 + (f2 & 127) + (r32 >= 16 ? 128 : 0) : n0 + r32;
    const bf16* bp = g.Bt + (size_t)brow * K + w * ks + 8 * hh;
    const bf16* ap = g.A + (size_t)r32 * K + w * ks + 8 * hh;
    f32x16 acc[4] = {};
    bf16x8 afA[4][2], bfA[2], afB[4][2], bfB[2];
#define SG_LOAD(AF, BF, kk) do { _Pragma("unroll") for (int i = 0; i < 2; ++i) { BF[i] = *(const bf16x8*)(bp + (kk) + 16 * i); \
        _Pragma("unroll") for (int rt = 0; rt < 4; ++rt) AF[rt][i] = *(const bf16x8*)(ap + (size_t)(rt * 32) * K + (kk) + 16 * i); } } while (0)
#define SG_MMA(AF, BF) do { _Pragma("unroll") for (int i = 0; i < 2; ++i) _Pragma("unroll") for (int rt = 0; rt < 4; ++rt) acc[rt] = __builtin_amdgcn_mfma_f32_32x32x16_bf16(AF[rt][i], BF[i], acc[rt], 0, 0, 0); } while (0)
    SG_LOAD(afA, bfA, 0);
#pragma unroll 1
    for (int k = 0; k < ks; k += 64) {
        if (k + 32 < ks) SG_LOAD(afB, bfB, k + 32);
        SG_MMA(afA, bfA);
        if (k + 32 < ks) { if (k + 64 < ks) SG_LOAD(afA, bfA, k + 64); SG_MMA(afB, bfB); }
    }
#undef SG_LOAD
#undef SG_MMA
    LAS float* RED = (LAS float*)(c.lds);
    __syncthreads();
#pragma unroll
    for (int rt = 0; rt < 4; ++rt)
#pragma unroll
        for (int r = 0; r < 16; ++r) RED[((w * 4 + rt) * 16 + r) * 64 + lane] = acc[rt][r];
    __syncthreads();
    const int rt = w & 3, rh = w >> 2, col = n0 + r32;
    float v[8];
#pragma unroll
    for (int i = 0; i < 8; ++i) { float s = 0.f;
#pragma unroll
        for (int ww = 0; ww < 8; ++ww) s += RED[((ww * 4 + rt) * 16 + 8 * rh + i) * 64 + lane];
        v[i] = s; }
    if (g.mode == 0) {
#pragma unroll
        for (int i = 0; i < 8; ++i) { const int row = MP + rt * 32 + crow(8 * rh + i, hh); const float rs = rsqrtf(g.ssin[row] * (1.0f / DM) + EPS); g.Z[(size_t)row * g.ldz + col] = (bf16)f2bf(v[i] * rs); }
    } else if (g.mode == 1) {
#pragma unroll
        for (int i = 0; i < 8; ++i) { const int lr = rt * 32 + crow(8 * rh + i, hh), row = MP + lr;
            const float x = v[i] + (g.resid ? g.resid[(size_t)lr * DM + col] : bf2f(g.rb[(size_t)row * DM + col]));
            if (g.y) g.y[(size_t)lr * DM + col] = x; if (g.xb) g.xb[(size_t)row * DM + col] = (bf16)f2bf(x);
            float s = x * x; s += __shfl_xor(s, 1); s += __shfl_xor(s, 2); s += __shfl_xor(s, 4); s += __shfl_xor(s, 8); s += __shfl_xor(s, 16);
            if (g.ssout && r32 == 0) atomicAdd(g.ssout + row, s); }
    } else {
        float gu[8], upv[8];
#pragma unroll
        for (int i = 0; i < 8; ++i) { const int row = MP + rt * 32 + crow(8 * rh + i, hh); gu[i] = v[i] * rsqrtf(g.ssin[row] * (1.0f / DM) + EPS); upv[i] = __shfl_xor(gu[i], 16); }
        if (r32 < 16) { const float w0 = g.cw[f2], w1 = g.cw[DFF + f2], w2 = g.cw[2 * DFF + f2], bb = g.cb[f2];
#pragma unroll
            for (int aa = 0; aa < 2; ++aa) { const int lr0 = rt * 32 + 8 * (2 * rh + aa) + 4 * hh, sb = lr0 >> 2;
                const float s0 = g.cst[(size_t)(sb * 2) * DFF + f2], s1 = g.cst[(size_t)(sb * 2 + 1) * DFF + f2];
                const float u0 = gu[4 * aa], u1 = gu[4 * aa + 1], u2 = gu[4 * aa + 2], u3 = gu[4 * aa + 3];
                const float cv[4] = {bb + w0 * s0 + w1 * s1 + w2 * u0, bb + w0 * s1 + w1 * u0 + w2 * u1, bb + w0 * u0 + w1 * u1 + w2 * u2, bb + w0 * u1 + w1 * u2 + w2 * u3};
#pragma unroll
                for (int t = 0; t < 4; ++t) g.ACT[(size_t)(MP + lr0 + t) * DFF + f2] = (bf16)f2bf(cv[t] * sigmoidf_(cv[t]) * upv[4 * aa + t]);
                g.cvs[(size_t)(sb * 2) * DFF + f2] = u2; g.cvs[(size_t)(sb * 2 + 1) * DFF + f2] = u3; } }
    }
}
__device__ __forceinline__ void sgemm_phase(Ctx& c, const SgArgs& g, int N) {
#pragma unroll 1
    for (int u = c.G - 1 - (int)blockIdx.x; u < N / 32; u += c.G) sgemm_unit(c, g, u * 32);
}


__device__ __forceinline__ float wave_sum_f(float x) {
    x += __builtin_bit_cast(float, __builtin_amdgcn_update_dpp(0, __builtin_bit_cast(int, x), 0xB1, 0xF, 0xF, false));
    x += __builtin_bit_cast(float, __builtin_amdgcn_update_dpp(0, __builtin_bit_cast(int, x), 0x4E, 0xF, 0xF, false));
    x += __builtin_bit_cast(float, __builtin_amdgcn_update_dpp(0, __builtin_bit_cast(int, x), 0x141, 0xF, 0xF, false));
    x += __builtin_bit_cast(float, __builtin_amdgcn_update_dpp(0, __builtin_bit_cast(int, x), 0x140, 0xF, 0xF, false));
    const int xi = __builtin_bit_cast(int, x);
    return (__builtin_bit_cast(float, __builtin_amdgcn_readlane(xi, 0)) + __builtin_bit_cast(float, __builtin_amdgcn_readlane(xi, 16))) +
           (__builtin_bit_cast(float, __builtin_amdgcn_readlane(xi, 32)) + __builtin_bit_cast(float, __builtin_amdgcn_readlane(xi, 48)));
}
__device__ __forceinline__ void dsa_post_row(ARGREF a, int row, int lane_) {
    int lane = lane_; asm volatile("" : "+v"(lane));
    const bf16* z = (const bf16*)(a.ws + WS_Z) + (size_t)row * ZC1;
    const bool smp = row >= MP; const int b = smp ? (row - MP) >> 2 : row >> 12, t = smp ? (row - MP) & 3 : row & 4095;
    const float pos = (float)(smp ? PAST + t : t);
    const int i = lane & 31;
    float x1[8], x2[8], q1[4], q2[4], k1 = 0.f, k2 = 0.f;
#pragma unroll
    for (int hd = 0; hd < 8; ++hd) { x1[hd] = bf2f(z[hd * 128 + lane]); x2[hd] = bf2f(z[hd * 128 + 64 + lane]); }
    const u64 vv = *(const u64*)(z + Z1_V + 4 * lane);
#pragma unroll
    for (int p = 0; p < 4; ++p) { const int hd = 2 * p + (lane >> 5); q1[p] = bf2f(z[Z1_IQ + hd * 64 + i]); q2[p] = bf2f(z[Z1_IQ + hd * 64 + 32 + i]); }
    if (lane < 32) { k1 = bf2f(z[Z1_IK + i]); k2 = bf2f(z[Z1_IK + 32 + i]); }
    const float wraw = bf2f(z[Z1_IW + (lane & 7)]);
    float c128, s128, c64, s64;
    { const float r1 = pos * (exp2f(-(float)lane * (13.287712379549449f / 64.0f)) * 0.15915494309189535f), f1 = r1 - floorf(r1); s128 = __builtin_amdgcn_sinf(f1); c128 = __builtin_amdgcn_cosf(f1);
      const float r2 = pos * (exp2f(-(float)i * (13.287712379549449f / 32.0f)) * 0.15915494309189535f), f2 = r2 - floorf(r2); s64 = __builtin_amdgcn_sinf(f2); c64 = __builtin_amdgcn_cosf(f2); }
#pragma unroll
    for (int hd = 0; hd < 8; ++hd) {
        const float rs = rsqrtf(wave_sum_f(x1[hd] * x1[hd] + x2[hd] * x2[hd]) * (1.0f / 128.0f) + EPS);
        const float* gn = hd < 6 ? a.in[17] : a.in[18];
        const float y1 = x1[hd] * rs * gn[lane], y2 = x2[hd] * rs * gn[64 + lane];
        const float o1 = y1 * c128 - y2 * s128, o2 = y2 * c128 + y1 * s128;
        if (hd < 6) {
            if (smp) { float* q = (float*)(a.ws + WS_SQ) + (size_t)(row - MP) * 768 + hd * 128; q[lane] = o1; q[64 + lane] = o2; }
            else { bf16* q = (bf16*)(a.ws + WS_QB) + ((size_t)(b * 6 + hd) * SEQ + t) * 128; q[lane] = (bf16)f2bf(o1); q[64 + lane] = (bf16)f2bf(o2); }
        } else {
            const int kvh = hd - 6;
            float* ko = smp ? a.out + O_KS + (size_t)(row - MP) * 256 + kvh * 128 : a.out + O_KP + (size_t)row * 256 + kvh * 128;
            ko[lane] = o1; ko[64 + lane] = o2;
            if (!smp) { bf16* kb = (bf16*)(a.ws + WS_KB) + ((size_t)(b * 2 + kvh) * SEQ + t) * 128; kb[lane] = (bf16)f2bf(o1); kb[64 + lane] = (bf16)f2bf(o2); }
        }
    }
    {
        const f32x4 v = {bf2f((unsigned)vv & 0xffffu), bf2f(((unsigned)vv) >> 16), bf2f((unsigned)(vv >> 32) & 0xffffu), bf2f((unsigned)(vv >> 48))};
        float* vo = smp ? a.out + O_VS + (size_t)(row - MP) * 256 : a.out + O_VP + (size_t)row * 256;
        *(f32x4*)(vo + 4 * lane) = v;
        if (!smp) { const int kvh = lane >> 5, d = (lane & 31) * 4; *(u64*)((bf16*)(a.ws + WS_VB) + ((size_t)(b * 2 + kvh) * SEQ + t) * 128 + d) = vv; }
    }
    {
#pragma unroll
        for (int p = 0; p < 4; ++p) { const int hd = 2 * p + (lane >> 5);
            const float o1 = q1[p] * c64 - q2[p] * s64, o2 = q2[p] * c64 + q1[p] * s64;
            if (smp) { float* q = (float*)(a.ws + WS_SIQ) + (size_t)(row - MP) * 512 + hd * 64; q[i] = o1; q[32 + i] = o2; }
            else { bf16* q = (bf16*)(a.ws + WS_IQB) + (size_t)row * 512 + hd * 64; q[i] = (bf16)f2bf(o1); q[32 + i] = (bf16)f2bf(o2); } }
        const float rs = rsqrtf(wave_sum_f(k1 * k1 + k2 * k2) * (1.0f / 64.0f) + EPS);
        const float y1 = k1 * rs * a.in[19][i], y2 = k2 * rs * a.in[19][32 + i];
        const float o1 = y1 * c64 - y2 * s64, o2 = y2 * c64 + y1 * s64;
        if (lane < 32) {
            float* ko = smp ? a.out + O_IKS + (size_t)(row - MP) * 64 : a.out + O_IKP + (size_t)row * 64; ko[i] = o1; ko[32 + i] = o2;
            if (!smp) { bf16* kb = (bf16*)(a.ws + WS_IKB) + (size_t)row * 64; kb[i] = (bf16)f2bf(o1); kb[32 + i] = (bf16)f2bf(o2); } }
        if (lane < 8) { const float wv = wraw * (0.35355339059327373f * 0.125f);
            if (smp) ((float*)(a.ws + WS_SIW))[(row - MP) * 8 + lane] = wv; else ((float*)(a.ws + WS_IW))[(size_t)row * 8 + lane] = wv; }
    }
}
__device__ __forceinline__ void p8_dsa_post(Ctx& c, ARGREF a) {
    constexpr int NRB = (MVALID + 63) / 64;
    for (;;) { const int u = q_next(c, 1); if (u >= 384 + NRB) break;
        if (u < 256) memattn_prompt_unit(c, a, 1, u);
        else if (u < 256 + NRB) { const int r0 = (u - 256) * 64 + c.wave;
#pragma unroll 1
            for (int i = 0; i < 8; ++i) { const int row = r0 + 8 * i; if (row < MVALID) dsa_post_row(a, row, c.lane); } }
        else memattn_sample_unit(c, a, 1, u - 256 - NRB); }
}

__device__ __forceinline__ void idx_prompt_unit(Ctx& c, ARGREF a, int b, int qb) {
    int tid = c.tid; asm volatile("" : "+v"(tid));
    const int lane = tid & 63, r32 = lane & 31, hh = lane >> 5, w = c.wave;
    const int q0 = b * SEQ + qb * 32;
    LAS bf16* IQL = (LAS bf16*)(c.lds);
    { const bf16* src = (const bf16*)(a.ws + WS_IQB) + (size_t)q0 * 512;
#pragma unroll
      for (int i = 0; i < 4; ++i) { const int row = tid >> 4, ch = (tid & 15) + 16 * i; *(LAS v4u*)(IQL + row * 520 + ch * 8) = *(const v4u*)(src + (size_t)row * 512 + ch * 8); } }
    __syncthreads();
    const bf16* IK = (const bf16*)(a.ws + WS_IKB) + (size_t)(b * SEQ) * 64 + (size_t)r32 * 64 + 8 * hh;
    float* SC = (float*)(a.ws + WS_SC) + (size_t)(q0 + r32) * SEQ;
    float wv[8];
#pragma unroll
    for (int h = 0; h < 8; ++h) wv[h] = ((const float*)(a.ws + WS_IW))[(size_t)(q0 + r32) * 8 + h];
    bf16x8 ak[4], an[4];
    if (w <= qb) {
#pragma unroll
        for (int ks = 0; ks < 4; ++ks) ak[ks] = *(const bf16x8*)(IK + (size_t)(w * 32) * 64 + ks * 16); }
#pragma unroll 1
    for (int kt = w; kt <= qb; kt += 8) {
        if (kt + 8 <= qb) {
#pragma unroll
            for (int ks = 0; ks < 4; ++ks) an[ks] = *(const bf16x8*)(IK + (size_t)((kt + 8) * 32) * 64 + ks * 16); }
        f32x16 sc = {};
        int qoff = r32 * 520 + 8 * hh; asm volatile("" : "+v"(qoff));
#pragma unroll
        for (int h = 0; h < 8; ++h) { f32x16 d = {};
#pragma unroll
            for (int ks = 0; ks < 4; ++ks) d = __builtin_amdgcn_mfma_f32_32x32x16_bf16(ak[ks], *(const LAS bf16x8*)(IQL + qoff + h * 64 + ks * 16), d, 0, 0, 0);
#pragma unroll
            for (int r = 0; r < 16; ++r) sc[r] = fmaf(wv[h], fmaxf(d[r], 0.f), sc[r]); }
#pragma unroll
        for (int g = 0; g < 4; ++g) *(f32x4*)(SC + kt * 32 + 8 * g + 4 * hh) = (f32x4){sc[4 * g], sc[4 * g + 1], sc[4 * g + 2], sc[4 * g + 3]};
#pragma unroll
        for (int ks = 0; ks < 4; ++ks) ak[ks] = an[ks];
    }
}
__device__ __forceinline__ v4u pack8f(const float* p) { const f32x4 x = *(const f32x4*)p, y = *(const f32x4*)(p + 4); v4u o; o.x = pk2(x.x, x.y); o.y = pk2(x.z, x.w); o.z = pk2(y.x, y.y); o.w = pk2(y.z, y.w); return o; }
__device__ __forceinline__ void idx_sample_tile(ARGREF a, int sb, int tl, int lane_) {
    int lane = lane_; asm volatile("" : "+v"(lane));
    const int r32 = lane & 31, hh = lane >> 5, tk = r32 >> 3, hd = r32 & 7;
    const float* iq = (const float*)(a.ws + WS_SIQ) + (size_t)(sb * 4 + tk) * 512 + hd * 64 + 8 * hh;
    const float wv = ((const float*)(a.ws + WS_SIW))[(sb * 4 + tk) * 8 + hd];
    const float* src;
    if (tl < 256) src = a.in[4] + ((size_t)a.page_table[sb * 64 + (tl >> 2)] * 128 + (tl & 3) * 32 + r32) * 64 + 8 * hh;
    else src = a.out + O_IKS + (size_t)(sb * 4 + (r32 & 3)) * 64 + 8 * hh;
    v4u af[4], bf_[4];
#pragma unroll
    for (int ks = 0; ks < 4; ++ks) { af[ks] = pack8f(src + 16 * ks); bf_[ks] = pack8f(iq + 16 * ks); }
    if (tl == 256 && r32 >= 4) {
#pragma unroll
        for (int ks = 0; ks < 4; ++ks) af[ks] = (v4u){0u, 0u, 0u, 0u}; }
    f32x16 d = {};
#pragma unroll
    for (int ks = 0; ks < 4; ++ks) d = __builtin_amdgcn_mfma_f32_32x32x16_bf16(__builtin_bit_cast(bf16x8, af[ks]), __builtin_bit_cast(bf16x8, bf_[ks]), d, 0, 0, 0);
    float* dst = (float*)(a.ws + WS_SSC) + (size_t)(sb * 4 + tk) * SSC_LD + tl * 32;
#pragma unroll
    for (int r = 0; r < 16; ++r) { float v = wv * fmaxf(d[r], 0.f);
        v += __builtin_bit_cast(float, __builtin_amdgcn_update_dpp(0, __builtin_bit_cast(int, v), 0xB1, 0xF, 0xF, false));
        v += __builtin_bit_cast(float, __builtin_amdgcn_update_dpp(0, __builtin_bit_cast(int, v), 0x4E, 0xF, 0xF, false));
        v += __builtin_bit_cast(float, __builtin_amdgcn_update_dpp(0, __builtin_bit_cast(int, v), 0x141, 0xF, 0xF, false));
        if (hd == 0) dst[crow(r, hh)] = v; }
}
__device__ __forceinline__ void p9_indexer(Ctx& c, ARGREF a) {
    const int gw = c.vcu * NWAVES + c.wave, NGW = c.G * NWAVES;
#pragma unroll 1
    for (int wt = gw; wt < 32 * 257; wt += NGW) idx_sample_tile(a, wt / 257, wt % 257, c.lane);
    for (;;) { const int u = q_next(c, 2); if (u >= 512) break; idx_prompt_unit(c, a, u & 3, 127 - (u >> 2)); }
}


__device__ __forceinline__ unsigned fkey(float f) { const unsigned u = __builtin_bit_cast(unsigned, f + 0.0f); return (u & 0x80000000u) ? ~u : (u | 0x80000000u); }
__device__ __forceinline__ void acc_ge(int& cnt, unsigned key, unsigned cand) { asm volatile("v_cmp_le_u32_e32 vcc, %1, %2\n\tv_addc_co_u32_e32 %0, vcc, 0, %0, vcc" : "+v"(cnt) : "s"(cand), "v"(key) : "vcc"); }
__device__ __forceinline__ void acc_ge4(int& c0, int& c1, int& c2, int& c3, unsigned k0, unsigned k1, unsigned k2, unsigned k3, unsigned cand) {
    u64 m0, m1, m2, m3;
    asm volatile("v_cmp_le_u32_e64 %4, %8, %9\n\tv_cmp_le_u32_e64 %5, %8, %10\n\tv_cmp_le_u32_e64 %6, %8, %11\n\tv_cmp_le_u32_e64 %7, %8, %12\n\t"
                 "v_addc_co_u32_e64 %0, %4, 0, %0, %4\n\tv_addc_co_u32_e64 %1, %5, 0, %1, %5\n\tv_addc_co_u32_e64 %2, %6, 0, %2, %6\n\tv_addc_co_u32_e64 %3, %7, 0, %3, %7"
                 : "+v"(c0), "+v"(c1), "+v"(c2), "+v"(c3), "=&s"(m0), "=&s"(m1), "=&s"(m2), "=&s"(m3) : "s"(cand), "v"(k0), "v"(k1), "v"(k2), "v"(k3));
}
__device__ __forceinline__ u64 ballot_nz(unsigned v) { u64 m; asm volatile("v_cmp_ne_u32_e64 %0, 0, %1" : "=s"(m) : "v"(v)); return m; }
__device__ __forceinline__ int wave_sum_dpp(int x) {
    x += __builtin_amdgcn_update_dpp(0, x, 0xB1, 0xF, 0xF, false);
    x += __builtin_amdgcn_update_dpp(0, x, 0x4E, 0xF, 0xF, false);
    x += __builtin_amdgcn_update_dpp(0, x, 0x141, 0xF, 0xF, false);
    x += __builtin_amdgcn_update_dpp(0, x, 0x140, 0xF, 0xF, false);
    return (__builtin_amdgcn_readlane(x, 0) + __builtin_amdgcn_readlane(x, 16)) + (__builtin_amdgcn_readlane(x, 32) + __builtin_amdgcn_readlane(x, 48));
}
__device__ __forceinline__ int mbcnt64(u64 m) { return (int)__builtin_amdgcn_mbcnt_hi((unsigned)(m >> 32), __builtin_amdgcn_mbcnt_lo((unsigned)m, 0u)); }
constexpr int TK_LOWBITS = 18;
__device__ __forceinline__ void topk_finish(unsigned ck, int cp, int A, int posmax, unsigned& T, int& P) {
#pragma unroll 1
    for (int bit = TK_LOWBITS - 1; bit >= 0; --bit) { const unsigned cand = T | (1u << bit); if (A + __builtin_popcountll(__ballot(ck >= cand)) >= 256) T = cand; }
    const int need = 256 - (A + __builtin_popcountll(__ballot(ck > T))), ceq = __builtin_popcountll(__ballot(ck == T));
    P = posmax;
    if (ceq != need) { P = 0;
#pragma unroll 1
        for (int bit = 13; bit >= 0; --bit) { const int cand = P | (1 << bit); if (__builtin_popcountll(__ballot(ck == T && cp < cand)) < need) P = cand; } }
}
__device__ __forceinline__ unsigned wave_min_u(unsigned x) {
    x = min(x, (unsigned)__builtin_amdgcn_update_dpp(0, (int)x, 0xB1, 0xF, 0xF, false)); x = min(x, (unsigned)__builtin_amdgcn_update_dpp(0, (int)x, 0x4E, 0xF, 0xF, false));
    x = min(x, (unsigned)__builtin_amdgcn_update_dpp(0, (int)x, 0x141, 0xF, 0xF, false)); x = min(x, (unsigned)__builtin_amdgcn_update_dpp(0, (int)x, 0x140, 0xF, 0xF, false));
    return min(min((unsigned)__builtin_amdgcn_readlane((int)x, 0), (unsigned)__builtin_amdgcn_readlane((int)x, 16)), min((unsigned)__builtin_amdgcn_readlane((int)x, 32), (unsigned)__builtin_amdgcn_readlane((int)x, 48)));
}
__device__ __forceinline__ unsigned wave_max_u(unsigned x) {
    x = max(x, (unsigned)__builtin_amdgcn_update_dpp(0, (int)x, 0xB1, 0xF, 0xF, false)); x = max(x, (unsigned)__builtin_amdgcn_update_dpp(0, (int)x, 0x4E, 0xF, 0xF, false));
    x = max(x, (unsigned)__builtin_amdgcn_update_dpp(0, (int)x, 0x141, 0xF, 0xF, false)); x = max(x, (unsigned)__builtin_amdgcn_update_dpp(0, (int)x, 0x140, 0xF, 0xF, false));
    return max(max((unsigned)__builtin_amdgcn_readlane((int)x, 0), (unsigned)__builtin_amdgcn_readlane((int)x, 16)), max((unsigned)__builtin_amdgcn_readlane((int)x, 32), (unsigned)__builtin_amdgcn_readlane((int)x, 48)));
}
__device__ __forceinline__ void topk_prompt_rows(ARGREF a, int row0, int stride, int lane_, LAS unsigned* cl) {
    int lane = lane_; asm volatile("" : "+v"(lane));
    const float* SCb = (const float*)(a.ws + WS_SC);
#pragma unroll 1
    for (int row = row0; row < MP; row += stride) {
        const int t = row & 4095;
        u64* mk = (u64*)(a.ws + WS_MASK) + (size_t)row * 64;
        if (t < 256) { u64 myword = 0ull;
#pragma unroll 1
            for (int j = 0; j < 64; ++j) { const u64 m = __ballot(64 * j + lane <= t); if (lane == j) myword = m; }
            mk[lane] = myword;
            continue; }
        unsigned key[64];
        { const float* sc_ = SCb + (size_t)row * SEQ + lane; const int tj_ = t >> 6;
          float v[64];
#pragma unroll
          for (int j = 0; j < 64; ++j) v[j] = sc_[64 * (j < tj_ ? j : tj_)];
          int pj = lane;
#pragma unroll
          for (int j = 0; j < 64; ++j) { const int u = __builtin_bit_cast(int, v[j] + 0.0f); const unsigned k = (unsigned)u ^ ((unsigned)(u >> 31) | 0x80000000u); key[j] = (pj <= t) ? k : 0u; pj += 64; asm volatile("" : "+v"(pj)); } }
        unsigned kh[64];
#pragma unroll
        for (int j = 0; j < 64; ++j) { kh[j] = key[j] >> 1; asm volatile("" : "+v"(kh[j])); }
        unsigned T; int hb;
        {
            unsigned b0 = 0u, b1 = 0u, b2 = 0u, b3 = 0u;
#pragma unroll
            for (int j = 0; j < 64; ++j) { unsigned x = key[j]; const unsigned m0 = max(b0, x); x = min(b0, x); b0 = m0; const unsigned m1 = max(b1, x); x = min(b1, x); b1 = m1; const unsigned m2 = max(b2, x); x = min(b2, x); b2 = m2; b3 = max(b3, x); }
            const unsigned L = wave_min_u(b3), H = wave_max_u(b3), df = L ^ H;
            hb = df ? 31 - __builtin_clz(df) : -1;
            T = hb >= 31 ? 0u : (L & ~((2u << (hb < 0 ? 0 : hb)) - 1u)); if (hb < 0) T = L;
        }
#define TK_FULLCOUNT(CAND, OUT) do { const unsigned cs_ = __builtin_amdgcn_readfirstlane(CAND); int c0_ = 0, c1_ = 0, c2_ = 0, c3_ = 0; \
        _Pragma("unroll") for (int j = 0; j < 64; j += 4) acc_ge4(c0_, c1_, c2_, c3_, key[j], key[j + 1], key[j + 2], key[j + 3], cs_); OUT = wave_sum_dpp((c0_ + c1_) + (c2_ + c3_)); } while (0)
#define TK_FASTCOUNT(CAND, OUT) do { const unsigned ch_ = __builtin_amdgcn_readfirstlane((CAND) >> 1); unsigned a0_ = 0u, a1_ = 0u, a2_ = 0u, a3_ = 0u; \
        _Pragma("unroll") for (int j = 0; j < 64; j += 4) { a0_ = __builtin_amdgcn_alignbit(a0_, kh[j] - ch_, 31); a1_ = __builtin_amdgcn_alignbit(a1_, kh[j + 1] - ch_, 31); \
            a2_ = __builtin_amdgcn_alignbit(a2_, kh[j + 2] - ch_, 31); a3_ = __builtin_amdgcn_alignbit(a3_, kh[j + 3] - ch_, 31); } \
        OUT = 4096 - wave_sum_dpp((__builtin_popcount(a0_) + __builtin_popcount(a1_)) + (__builtin_popcount(a2_) + __builtin_popcount(a3_))); } while (0)
#pragma unroll 1
        for (int bit = hb; bit >= TK_LOWBITS; --bit) { const unsigned cand = T | (1u << bit); int tot; TK_FASTCOUNT(cand, tot); if (tot >= 256) T = cand; }
        const unsigned Tb = T & ~((1u << TK_LOWBITS) - 1u), hib = Tb + (1u << TK_LOWBITS);
        int A = 0, cT; if (hib != 0u) TK_FASTCOUNT(hib, A); TK_FASTCOUNT(Tb, cT);
#undef TK_FASTCOUNT
        int P;
        if (cT - A <= 64) {
            if (lane == 0) cl[128] = 0u;
            int pj = lane;
#pragma unroll
            for (int j = 0; j < 64; ++j) { if ((key[j] - Tb) < (1u << TK_LOWBITS)) { const unsigned pos = __hip_atomic_fetch_add(cl + 128, 1u, __ATOMIC_RELAXED, __HIP_MEMORY_SCOPE_WORKGROUP); if (pos < 64u) { cl[pos] = key[j]; cl[64 + pos] = (unsigned)pj; } }
                pj += 64; asm volatile("" : "+v"(pj)); }
            const int nund = cT - A;
            const unsigned ck = lane < nund ? cl[lane] : 0u; const int cp = (int)cl[64 + lane];
            topk_finish(ck, cp, A, 4095, T, P);
        } else {
#pragma unroll 1
            for (int bit = TK_LOWBITS - 1; bit >= 0; --bit) { const unsigned cand = T | (1u << bit); int tot; TK_FULLCOUNT(cand, tot); if (tot >= 256) T = cand; }
            int cge, cgt; TK_FULLCOUNT(T, cge); cgt = 0; if (T != 0xffffffffu) TK_FULLCOUNT(T + 1u, cgt);
            const int need = 256 - cgt, ceq = cge - cgt; P = 4095;
            if (ceq != need) { P = 0;
#pragma unroll 1
                for (int bit = 11; bit >= 0; --bit) { const int cand = P | (1 << bit); int cnt = 0; int pj = lane;
#pragma unroll
                    for (int j = 0; j < 64; ++j) { cnt += (key[j] == T && pj < cand) ? 1 : 0; pj += 64; asm volatile("" : "+v"(pj)); }
                    if (wave_sum_dpp(cnt) < need) P = cand; } }
        }
#undef TK_FULLCOUNT
        if (P != 4095) {
            int pq = lane;
#pragma unroll
            for (int j = 0; j < 64; ++j) { if (key[j] == T && pq > P) key[j] = 0u; pq += 64; asm volatile("" : "+v"(pq)); } }
        unsigned wlo = 0u, whi = 0u; const unsigned Ts = __builtin_amdgcn_readfirstlane(T);
#pragma unroll
        for (int j = 0; j < 64; ++j) asm volatile("v_cmp_le_u32_e32 vcc, %2, %3\n\ts_nop 3\n\tv_writelane_b32 %0, vcc_lo, %4\n\tv_writelane_b32 %1, vcc_hi, %4" : "+v"(wlo), "+v"(whi) : "s"(Ts), "v"(key[j]), "i"(j) : "vcc");
        mk[lane] = ((u64)whi << 32) | (u64)wlo;
    }
}
__device__ __forceinline__ void topk_sample_row(ARGREF a, int q, int lane_, LAS unsigned* K, LAS unsigned* cl) {
    int lane = lane_; asm volatile("" : "+v"(lane));
    const int t = q & 3, n = PAST + t + 1; const float* sc = (const float*)(a.ws + WS_SSC) + (size_t)q * SSC_LD;
    int* out = (int*)(a.ws + WS_SIDX) + q * 256;
    unsigned key[129];
#pragma unroll
    for (int j = 0; j < 129; ++j) { const float v = sc[64 * j + lane]; key[j] = (j < 128 || lane < n - 8192) ? fkey(v) : 0u; }
#pragma unroll
    for (int j = 0; j < 129; ++j) K[64 * j + lane] = key[j];
#define TK_FULLCOUNT(CAND, OUT) do { const unsigned cs_ = __builtin_amdgcn_readfirstlane(CAND); int c0_ = 0, c1_ = 0, c2_ = 0, c3_ = 0; \
        _Pragma("unroll") for (int j = 0; j < 128; j += 4) acc_ge4(c0_, c1_, c2_, c3_, key[j], key[j + 1], key[j + 2], key[j + 3], cs_); acc_ge(c0_, key[128], cs_); OUT = wave_sum_dpp((c0_ + c1_) + (c2_ + c3_)); } while (0)
    unsigned T = 0u;
#pragma unroll 1
    for (int bit = 31; bit >= TK_LOWBITS; --bit) { const unsigned cand = T | (1u << bit); int tot; TK_FULLCOUNT(cand, tot); if (tot >= 256) T = cand; }
    const unsigned hib = T + (1u << TK_LOWBITS);
    int A = 0, cT; if (hib != 0u) TK_FULLCOUNT(hib, A); TK_FULLCOUNT(T, cT);
    int P;
    if (cT - A <= 64) {
        int base = 0;
#pragma unroll 1
        for (int j0 = 0; j0 < 128; j0 += 8) { unsigned kk[8];
#pragma unroll
            for (int i = 0; i < 8; ++i) kk[i] = K[64 * (j0 + i) + lane];
#pragma unroll
            for (int i = 0; i < 8; ++i) { const unsigned und = (kk[i] - T) < (1u << TK_LOWBITS) ? 1u : 0u; const u64 m = ballot_nz(und); const int pos = base + mbcnt64(m);
                if (und) { cl[pos] = kk[i]; cl[64 + pos] = (unsigned)(64 * (j0 + i) + lane); }
                base += __builtin_popcountll(m); } }
        { const unsigned kj = K[64 * 128 + lane]; const unsigned und = (kj - T) < (1u << TK_LOWBITS) ? 1u : 0u; const u64 m = ballot_nz(und); const int pos = base + mbcnt64(m);
          if (und) { cl[pos] = kj; cl[64 + pos] = (unsigned)(64 * 128 + lane); } base += __builtin_popcountll(m); }
        const unsigned ck = lane < base ? cl[lane] : 0u; const int cp = (int)cl[64 + lane];
        topk_finish(ck, cp, A, 16383, T, P);
    } else {
#pragma unroll 1
        for (int bit = TK_LOWBITS - 1; bit >= 0; --bit) { const unsigned cand = T | (1u << bit); int tot; TK_FULLCOUNT(cand, tot); if (tot >= 256) T = cand; }
        int cge, cgt; TK_FULLCOUNT(T, cge); cgt = 0; if (T != 0xffffffffu) TK_FULLCOUNT(T + 1u, cgt);
        const int need = 256 - cgt, ceq = cge - cgt; P = 16383;
        if (ceq != need) { P = 0;
#pragma unroll 1
            for (int bit = 13; bit >= 0; --bit) { const int cand = P | (1 << bit); int cnt = 0;
#pragma unroll 4
                for (int j = 0; j < 129; ++j) cnt += (K[64 * j + lane] == T && 64 * j + lane < cand) ? 1 : 0;
                if (wave_sum_dpp(cnt) < need) P = cand; } }
    }
#undef TK_FULLCOUNT
    int base = 0;
#pragma unroll 1
    for (int j0 = 0; j0 < 136; j0 += 8) { unsigned kk[8];
#pragma unroll
        for (int i = 0; i < 8; ++i) kk[i] = (j0 + i < 129) ? K[64 * (j0 + i) + lane] : 0u;
#pragma unroll
        for (int i = 0; i < 8; ++i) { const int ps = 64 * (j0 + i) + lane; const unsigned selv = (kk[i] > T || (kk[i] == T && ps <= P)) ? 1u : 0u; const u64 m = ballot_nz(selv);
            const int pos = base + mbcnt64(m);
            if (selv && pos < 256) out[pos] = ps;
            base += __builtin_popcountll(m); } }
}
__device__ __forceinline__ void p10_topk(Ctx& c, ARGREF a) {
    const int gw = c.vcu * NWAVES + c.wave, NGW = c.G * NWAVES;
    LAS unsigned* cl = (LAS unsigned*)(c.lds) + c.wave * 192;
    if (c.wave == 0 && c.vcu < MS) topk_sample_row(a, c.vcu, c.lane, (LAS unsigned*)(c.lds + 8192), cl);
    topk_prompt_rows(a, gw, NGW, c.lane, cl);
}


__device__ __forceinline__ void attn_sample_unit(Ctx& c, ARGREF a, int sb, int t) {
    LAS bf16* KV = (LAS bf16*)(c.lds);
    LAS float* QL = (LAS float*)(c.lds + 69632);
    LAS float* SL = (LAS float*)(c.lds + 69632 + 3072);
    LAS float* OL = (LAS float*)(c.lds + 69632 + 6144);
    LAS int* IL = (LAS int*)(c.lds + 69632 + 12288);
    LAS unsigned* OFFL = (LAS unsigned*)(c.lds + 69632 + 12288 + 1024);
    int tid = c.tid; asm volatile("" : "+v"(tid));
    const int lane = tid & 63, w = c.wave, q = sb * 4 + t;
    __syncthreads();
    if (tid < 256) IL[tid] = ((const int*)(a.ws + WS_SIDX))[q * 256 + tid];
    for (int i = tid; i < 768; i += 512) QL[i] = ((const float*)(a.ws + WS_SQ))[(size_t)q * 768 + i];
    __syncthreads();
    if (tid < 256) { const int idx = IL[tid];
        OFFL[tid] = idx < PAST ? (unsigned)(((a.page_table[sb * 64 + (idx >> 7)] * 128 + (idx & 127)) * 2) * 128) : (0x80000000u | (unsigned)((sb * 4 + (idx - PAST)) * 256)); }
    __syncthreads();
    bf16* MIX = (bf16*)(a.ws + WS_MIX) + (size_t)(MP + q) * DM;
#pragma unroll 1
    for (int kvh = 0; kvh < 2; ++kvh) {
#pragma unroll 1
        for (int pass = 0; pass < 2; ++pass) {
            const float* pool = pass ? a.in[3] : a.in[2]; const float* nw = a.out + (pass ? O_VS : O_KS);
            { f32x4 gv[16];
#pragma unroll
              for (int r = 0; r < 16; ++r) { const int i = (tid >> 5) + 16 * r; const unsigned off = OFFL[i]; const float* src = (off & 0x80000000u) ? nw + (size_t)(off & 0x7fffffffu) : pool + (size_t)off;
                  gv[r] = *(const f32x4*)(src + kvh * 128 + (tid & 31) * 4); }
#pragma unroll
              for (int r = 0; r < 16; ++r) { const int i = (tid >> 5) + 16 * r; *(LAS u64*)(KV + i * 136 + (tid & 31) * 4) = (u64)pk2(gv[r].x, gv[r].y) | ((u64)pk2(gv[r].z, gv[r].w) << 32); } }
            __syncthreads();
            if (pass == 0) {
                const int i = tid >> 1, dh = (tid & 1) * 64; float s0 = 0.f, s1 = 0.f, s2 = 0.f;
#pragma unroll 8
                for (int d = 0; d < 64; ++d) { const float kx = bf2f(KV[i * 136 + dh + d]);
                    s0 = fmaf(QL[(3 * kvh + 0) * 128 + dh + d], kx, s0); s1 = fmaf(QL[(3 * kvh + 1) * 128 + dh + d], kx, s1); s2 = fmaf(QL[(3 * kvh + 2) * 128 + dh + d], kx, s2); }
                s0 += __shfl_xor(s0, 1); s1 += __shfl_xor(s1, 1); s2 += __shfl_xor(s2, 1);
                if ((tid & 1) == 0) { SL[i] = s0 * 0.08838834764831845f; SL[256 + i] = s1 * 0.08838834764831845f; SL[512 + i] = s2 * 0.08838834764831845f; }
                __syncthreads();
                if (w < 3) { float v[4], mx = -1e30f;
#pragma unroll
                    for (int j = 0; j < 4; ++j) { v[j] = SL[w * 256 + 64 * j + lane]; mx = fmaxf(mx, v[j]); }
#pragma unroll
                    for (int o = 1; o < 64; o <<= 1) mx = fmaxf(mx, __shfl_xor(mx, o));
                    float l = 0.f;
#pragma unroll
                    for (int j = 0; j < 4; ++j) { v[j] = __expf(v[j] - mx); l += v[j]; }
                    l = wave_sum(l); const float il = 1.0f / l;
#pragma unroll
                    for (int j = 0; j < 4; ++j) SL[w * 256 + 64 * j + lane] = v[j] * il; }
                __syncthreads();
            } else {
                const int d = tid & 127, part = tid >> 7; float o0 = 0.f, o1 = 0.f, o2 = 0.f;
#pragma unroll 8
                for (int i = part * 64; i < part * 64 + 64; ++i) { const float vx = bf2f(KV[i * 136 + d]); o0 = fmaf(SL[i], vx, o0); o1 = fmaf(SL[256 + i], vx, o1); o2 = fmaf(SL[512 + i], vx, o2); }
                OL[(part * 3 + 0) * 128 + d] = o0; OL[(part * 3 + 1) * 128 + d] = o1; OL[(part * 3 + 2) * 128 + d] = o2;
                __syncthreads();
                if (tid < 384) { const int hq = tid >> 7, dd = tid & 127; const float o = (OL[hq * 128 + dd] + OL[(3 + hq) * 128 + dd]) + (OL[(6 + hq) * 128 + dd] + OL[(9 + hq) * 128 + dd]);
                    MIX[(3 * kvh + hq) * 128 + dd] = (bf16)f2bf(o); }
                __syncthreads();
            }
        }
    }
}


namespace attn {
using bf16 = unsigned short;
typedef short bf16x8 __attribute__((ext_vector_type(8)));
typedef short s16x4 __attribute__((ext_vector_type(4)));
typedef float f32x16 __attribute__((ext_vector_type(16)));
typedef float f32x4 __attribute__((ext_vector_type(4)));
typedef unsigned u32x4 __attribute__((ext_vector_type(4)));
typedef unsigned u32x2 __attribute__((ext_vector_type(2)));
constexpr int D = 128, OS = 1024;
constexpr float THR = 8.f;
constexpr float SCALE = 0.08838834764831845f;
constexpr int NW = 8, QBLK = 32, KVBLK = 64, QB = NW * QBLK;
constexpr int SHM_V = KVBLK * D * 2, SHM_K = KVBLK * D * 2;
constexpr int LDS_BYTES = 2 * SHM_V + 2 * SHM_K + NW * 64 * 4;

#define KSWZ(row, colB) ((row) * 256 + ((colB) ^ (((row) & 7) << 4)))
#define SBAR() __builtin_amdgcn_sched_barrier(0)
__device__ __forceinline__ int v_st(int k, int c) { const int kk = (k & ~0xC) | ((k & 4) << 1) | ((k & 8) >> 1); return ((kk >> 3) * 4 + (c >> 5)) * 512 + ((kk & 7) * 32 + (c & 31)) * 2; }
__device__ __forceinline__ int v_rd_base(int lane) { return ((lane & 3) << 3) | (((lane >> 2) & 3) << 6) | (((lane >> 4) & 1) << 5) | (((lane >> 5) & 1) << 8); }
constexpr int v_rd_off(int d0, int ks, int half) { return d0 * 512 + ks * 4096 + half * 2048; }
__device__ __forceinline__ int crow(int r, int hi) { return (r & 3) + 8 * (r >> 2) + 4 * hi; }
__device__ __forceinline__ unsigned cvtpk(float lo, float hi) {
    unsigned r; asm volatile("v_cvt_pk_bf16_f32 %0, %1, %2" : "=v"(r) : "v"(lo), "v"(hi)); return r;
}
__device__ __forceinline__ bf16x8 pack8(f32x4 a, f32x4 b) {
    u32x4 w = {cvtpk(a[0], a[1]), cvtpk(a[2], a[3]), cvtpk(b[0], b[1]), cvtpk(b[2], b[3])};
    return *reinterpret_cast<bf16x8*>(&w);
}

__device__ __forceinline__ void partialSM(f32x16& p0, f32x16& p1, float& m_reg, float& mn, float& alpha) {
    float pmax = p0[0]; for (int r = 1; r < 16; ++r) pmax = fmaxf(pmax, p0[r]); for (int r = 0; r < 16; ++r) pmax = fmaxf(pmax, p1[r]);
    { auto rr = __builtin_amdgcn_permlane32_swap(__float_as_uint(pmax), __float_as_uint(pmax), false, false);
      pmax = fmaxf(__uint_as_float(rr[0]), __uint_as_float(rr[1])); }
    constexpr float C2 = 1.4426950408889634f * SCALE;
    if (__builtin_expect(__all((pmax - m_reg) * SCALE <= THR), 1)) { mn = m_reg; alpha = 1.f; }
    else { mn = fmaxf(m_reg, pmax); alpha = __builtin_amdgcn_exp2f((m_reg - mn) * C2); m_reg = mn; }
    const float mnL = -mn * C2;
    for (int r = 0; r < 16; ++r) p0[r] = fmaf(p0[r], C2, mnL); for (int r = 0; r < 16; ++r) p1[r] = fmaf(p1[r], C2, mnL);
    for (int r = 0; r < 16; ++r) p0[r] = __builtin_amdgcn_exp2f(p0[r]);
}
__device__ __forceinline__ void finishSM(f32x16& p0, f32x16& p1, float alpha, float& l_reg, bf16x8& pa0, bf16x8& pa1, bf16x8& pa2, bf16x8& pa3) {
    for (int r = 0; r < 16; ++r) p1[r] = __builtin_amdgcn_exp2f(p1[r]);
    float ps = 0; for (int r = 0; r < 16; ++r) ps += p0[r]; for (int r = 0; r < 16; ++r) ps += p1[r];
    { auto rr = __builtin_amdgcn_permlane32_swap(__float_as_uint(ps), __float_as_uint(ps), false, false);
      ps = __uint_as_float(rr[0]) + __uint_as_float(rr[1]); }
    l_reg = l_reg * alpha + ps;
#define PK4(P, B_, OUT) do { unsigned a0 = cvtpk(P[B_+0], P[B_+1]), a1 = cvtpk(P[B_+2], P[B_+3]);                          \
        unsigned b0 = cvtpk(P[B_+4], P[B_+5]), b1 = cvtpk(P[B_+6], P[B_+7]);                                             \
        auto r0 = __builtin_amdgcn_permlane32_swap(a0, b0, false, false); auto r1 = __builtin_amdgcn_permlane32_swap(a1, b1, false, false); \
        u32x4 w = {r0[0], r1[0], r0[1], r1[1]}; OUT = *reinterpret_cast<bf16x8*>(&w); } while (0)
    PK4(p0, 0, pa0); PK4(p0, 8, pa1); PK4(p1, 0, pa2); PK4(p1, 8, pa3);
#undef PK4
}
template <int KB, bool SK>
__device__ __forceinline__ void qkt(f32x16& p0, f32x16& p1, const char* K_lds, int r32, int hi, const bf16x8* qr, bool act) {
    if (SK && !act) { const float NEG = -__builtin_inff();
#pragma unroll
        for (int r = 0; r < 16; ++r) { p0[r] = NEG; p1[r] = NEG; } return; }
    p0 = f32x16{}; p1 = f32x16{};
    const char* kb[4];
#pragma unroll
    for (int dd = 0; dd < 4; ++dd) kb[dd] = K_lds + KB * SHM_K + KSWZ(r32, (dd * 16 + hi * 8) * 2);
#pragma unroll
    for (int d0 = 0; d0 < 8; ++d0) { const char* a = kb[d0 & 3] + (d0 >> 2) * 128;
        bf16x8 b0 = *reinterpret_cast<const bf16x8*>(a);
        bf16x8 b1 = *reinterpret_cast<const bf16x8*>(a + 32 * 256);
        p0 = __builtin_amdgcn_mfma_f32_32x32x16_bf16(b0, qr[d0], p0, 0, 0, 0);
        p1 = __builtin_amdgcn_mfma_f32_32x32x16_bf16(b1, qr[d0], p1, 0, 0, 0); }
}
template <int VB, bool SK>
__device__ __forceinline__ void pv_tile(f32x16* o, int vb0, bf16x8 pa0, bf16x8 pa1, bf16x8 pa2, bf16x8 pa3, bool act) {
    if (SK && !act) return;
#define TRRD(dst, off) asm volatile("ds_read_b64_tr_b16 %0, %1 offset:%2" : "=&v"(dst) : "v"(vb0), "i"(off) : "memory")
#define PV_D0(d0) do { s16x4 l0, l1, l2, l3, h0, h1, h2, h3; constexpr int b_ = VB * SHM_V + v_rd_off(d0, 0, 0);     \
        TRRD(l0, b_); TRRD(h0, b_ + 2048); TRRD(l1, b_ + 4096); TRRD(h1, b_ + 6144); TRRD(l2, b_ + 8192); TRRD(h2, b_ + 10240); TRRD(l3, b_ + 12288); TRRD(h3, b_ + 14336); \
        asm volatile("s_waitcnt lgkmcnt(0)" ::: "memory"); SBAR();                 \
        o[d0] = __builtin_amdgcn_mfma_f32_32x32x16_bf16(pa0, (bf16x8){l0[0], l0[1], l0[2], l0[3], h0[0], h0[1], h0[2], h0[3]}, o[d0], 0, 0, 0);   \
        o[d0] = __builtin_amdgcn_mfma_f32_32x32x16_bf16(pa1, (bf16x8){l1[0], l1[1], l1[2], l1[3], h1[0], h1[1], h1[2], h1[3]}, o[d0], 0, 0, 0);   \
        o[d0] = __builtin_amdgcn_mfma_f32_32x32x16_bf16(pa2, (bf16x8){l2[0], l2[1], l2[2], l2[3], h2[0], h2[1], h2[2], h2[3]}, o[d0], 0, 0, 0);   \
        o[d0] = __builtin_amdgcn_mfma_f32_32x32x16_bf16(pa3, (bf16x8){l3[0], l3[1], l3[2], l3[3], h3[0], h3[1], h3[2], h3[3]}, o[d0], 0, 0, 0); } while (0)
    PV_D0(0); PV_D0(1); PV_D0(2); PV_D0(3);
#undef PV_D0
#undef TRRD
}

__device__ __forceinline__ bf16x8 load8(const bf16* p) { return *reinterpret_cast<const bf16x8*>(p); }
__device__ __forceinline__ void mask_bits(f32x16& p0, f32x16& p1, u32x2 w, int hi) {
    const float NEG = -__builtin_inff();
    asm volatile("" : "+v"(w.x), "+v"(w.y));
    const unsigned lo = w.x >> (4 * hi), up = w.y >> (4 * hi);
#pragma unroll
    for (int r = 0; r < 16; ++r) { const int c = (r & 3) + 8 * (r >> 2);
        if (!((lo >> c) & 1u)) p0[r] = NEG;
        if (!((up >> c) & 1u)) p1[r] = NEG; }
}
struct BlockRef { const bf16* Q; const bf16* K; const bf16* V; bf16* O; const u32x2* M; int P0; };
struct Seam { bf16x8 qr[8]; bf16x8 st_v0, st_v1, st_k0, st_k1; };
#define ROW(p, k0, rr) ((p) + (size_t)((k0) + (rr)) * D + sc)
#define VMW() asm volatile("s_waitcnt vmcnt(0)" ::: "memory")
#define VMWN(n) asm volatile("s_waitcnt vmcnt(%0)" :: "i"(n) : "memory")
#define SLOAD_H(Kp, Vp, k0) do { S.st_v0 = load8(ROW(Vp, k0, sr)); S.st_v1 = load8(ROW(Vp, k0, 32 + sr));              \
                         S.st_k0 = load8(ROW(Kp, k0, sr)); S.st_k1 = load8(ROW(Kp, k0, 32 + sr)); } while (0)
#define SWRITE_HK(bf) do { *(bf16x8*)(K_lds + (bf) * SHM_K + kws) = S.st_k0; *(bf16x8*)(K_lds + (bf) * SHM_K + kws + 32 * 256) = S.st_k1; } while (0)
#define SWRITE_HV(bf) do { *(bf16x8*)(V_lds + (bf) * SHM_V + vst0) = S.st_v0; *(bf16x8*)(V_lds + (bf) * SHM_V + vst1) = S.st_v1; } while (0)
#define SWRITE_H(bf) do { SWRITE_HV(bf); SWRITE_HK(bf); } while (0)
__device__ __forceinline__ void sel_prime(const BlockRef& cur, char* lds, Seam& S) {
    int tid_ = threadIdx.x; asm volatile("" : "+v"(tid_));
    const int tid = tid_, wid = __builtin_amdgcn_readfirstlane(tid >> 6), lane = tid & 63, r32 = lane & 31, hi = lane >> 5;
    const int sr = tid >> 4, sc = (tid & 15) * 8, kws = KSWZ(sr, sc * 2); char* K_lds = lds + 2 * SHM_V;
    for (int d0 = 0; d0 < 8; ++d0) S.qr[d0] = load8(cur.Q + (size_t)(wid * QBLK + r32) * D + d0 * 16 + hi * 8);
    SLOAD_H(cur.K, cur.V, 0); VMW(); SWRITE_HK(0);
    __syncthreads();
}
__device__ __forceinline__ void sel_block(const BlockRef& cur, const BlockRef& nxt, char* lds, Seam& S) {
    int tid_ = threadIdx.x; asm volatile("" : "+v"(tid_));
    const int tid = tid_, wid = __builtin_amdgcn_readfirstlane(tid >> 6), lane = tid & 63, r32 = lane & 31, hi = lane >> 5;
    const int NT = (cur.P0 + QB) / KVBLK;
    char* V_lds = lds; char* K_lds = lds + 2 * SHM_V;
    float* ws = (float*)(lds + 2 * SHM_V + 2 * SHM_K) + wid * 64; float* li_l = ws, * al_l = ws + 32;
    float m_reg = -1e30f, l_reg = 0; f32x16 o[4] = {};
    const int sr = tid >> 4, sc = (tid & 15) * 8, vst0 = v_st(sr, sc), vst1 = v_st(32 + sr, sc), kws = KSWZ(sr, sc * 2);
    const int vb0 = (int)(uintptr_t)V_lds + v_rd_base(lane);
    const bf16* Kh = cur.K; const bf16* Vh = cur.V;
    const char* Mbase = (const char*)cur.M; const unsigned moff = (unsigned)(wid * QBLK + r32) * 512u;
#define MROW(t) (*(const u32x2*)(Mbase + (moff + (unsigned)(t) * 8u)))
#define RESC(a) do { if (__any((a) < 1.f)) { if (hi == 0) al_l[r32] = (a); asm volatile("s_waitcnt lgkmcnt(0)" ::: "memory");              \
                     for (int d_ = 0; d_ < 4; ++d_) for (int r = 0; r < 16; ++r) o[d_][r] *= al_l[crow(r, hi)]; } } while (0)
#define KBASE(t) ((t) * KVBLK)
    f32x16 pA0, pA1, pB0, pB1; float mnA, mnB, alA, alB; bf16x8 pa0, pa1, pa2, pa3; u32x2 mw;
    SWRITE_HV(0); SBAR();
    if (NT > 1) SLOAD_H(Kh, Vh, KBASE(1));
    mw = MROW(0);
    SBAR(); qkt<0, false>(pA0, pA1, K_lds, r32, hi, S.qr, true);
    mask_bits(pA0, pA1, mw, hi); partialSM(pA0, pA1, m_reg, mnA, alA);
    if (NT > 1) { VMW(); SWRITE_H(1); }
    __syncthreads();
#define HALF_STEP(PX0, PX1, mnX, alX, PY0, PY1, alY, t, KB, VB, SB) do {                                                      \
        SBAR(); mw = MROW(t); qkt<KB, false>(PX0, PX1, K_lds, r32, hi, S.qr, true);                                          \
        finishSM(PY0, PY1, alY, l_reg, pa0, pa1, pa2, pa3); SBAR();                                                           \
        if ((t) + 1 < NT) { SLOAD_H(Kh, Vh, KBASE((t) + 1)); SBAR(); }                                                        \
        pv_tile<VB, false>(o, vb0, pa0, pa1, pa2, pa3, true); mask_bits(PX0, PX1, mw, hi); partialSM(PX0, PX1, m_reg, mnX, alX); \
        __syncthreads();                                                                                                      \
        if ((t) + 1 < NT) { VMW(); SWRITE_H(SB); }                                                                            \
        RESC(alX); __syncthreads(); } while (0)
    for (int t = 1; t + 1 < NT; t += 2) {
        HALF_STEP(pB0, pB1, mnB, alB, pA0, pA1, alA, t, 1, 0, 0);
        HALF_STEP(pA0, pA1, mnA, alA, pB0, pB1, alB, t + 1, 0, 1, 1);
    }
    const bool even = (NT & 1) == 0;
    if (even) { SBAR(); mw = MROW(NT - 1); qkt<1, false>(pB0, pB1, K_lds, r32, hi, S.qr, true); SBAR(); }
    SLOAD_H(nxt.K, nxt.V, 0); SBAR();
#pragma unroll
    for (int d0 = 0; d0 < 8; ++d0) S.qr[d0] = load8(nxt.Q + (size_t)(wid * QBLK + r32) * D + d0 * 16 + hi * 8);
    SBAR();
    finishSM(pA0, pA1, alA, l_reg, pa0, pa1, pa2, pa3); SBAR();
    pv_tile<0, false>(o, vb0, pa0, pa1, pa2, pa3, true);
    if (even) { mask_bits(pB0, pB1, mw, hi); partialSM(pB0, pB1, m_reg, mnB, alB); __syncthreads(); RESC(alB);
        finishSM(pB0, pB1, alB, l_reg, pa0, pa1, pa2, pa3); SBAR(); pv_tile<1, false>(o, vb0, pa0, pa1, pa2, pa3, true); }
    SBAR(); VMWN(8); SWRITE_HK(0); SBAR();
    if (hi == 0) li_l[r32] = l_reg; asm volatile("s_waitcnt lgkmcnt(0)" ::: "memory");
    float rli[16];
#pragma unroll
    for (int r = 0; r < 16; ++r) rli[r] = __builtin_amdgcn_rcpf(li_l[crow(r, hi)]);
    bf16* Ow = cur.O + (size_t)(wid * QBLK) * OS;
#pragma unroll
    for (int r = 0; r < 16; ++r) { const int orow = crow(r, hi);
#pragma unroll
        for (int d0 = 0; d0 < 4; ++d0) { const float v = o[d0][r] * rli[r];
            const float vn = __shfl_xor(v, 1);
            if ((r32 & 1) == 0) *(unsigned*)(Ow + (size_t)orow * OS + d0 * 32 + r32) = cvtpk(v, vn); } }
    __syncthreads();
#undef RESC
#undef KBASE
#undef HALF_STEP
#undef MROW
}
#undef ROW
#undef VMW
#undef VMWN
#undef SLOAD_H
#undef SWRITE_HK
#undef SWRITE_HV
#undef SWRITE_H
#undef KSWZ
#undef SBAR
}


__device__ __forceinline__ attn::BlockRef attn_ref(ARGREF a, int b, int h, int qb) {
    attn::BlockRef r; const int kvh = h / 3;
    r.Q = (const attn::bf16*)(a.ws + WS_QB) + ((size_t)(b * 6 + h) * SEQ + (size_t)qb * 256) * 128;
    r.K = (const attn::bf16*)(a.ws + WS_KB) + (size_t)(b * 2 + kvh) * SEQ * 128;
    r.V = (const attn::bf16*)(a.ws + WS_VB) + (size_t)(b * 2 + kvh) * SEQ * 128;
    r.O = (attn::bf16*)(a.ws + WS_MIX) + (size_t)(b * SEQ + qb * 256) * DM + h * 128;
    r.M = (const attn::u32x2*)(a.ws + WS_MASK) + (size_t)(b * SEQ + qb * 256) * 64;
    r.P0 = qb * 256; return r;
}
__device__ __forceinline__ void p11_attention(Ctx& c, ARGREF a) {
    constexpr int NITEM = 240;
#pragma unroll 1
    for (int it = c.vcu; it < NITEM; it += c.G) {
        const int bh = it / 10, slot = it % 10, b = bh / 6, h = bh % 6;
        const int q0 = slot < 3 ? 15 - slot : (slot == 9 ? 6 : slot - 3), q1 = slot < 3 ? q0 : (slot == 9 ? 6 : 15 - slot);
        attn::Seam S;
        attn::BlockRef cur = attn_ref(a, b, h, q0), nxt = attn_ref(a, b, h, q1);
        __syncthreads();
        attn::sel_prime(cur, (char*)c.lds, S);
        if (q0 != q1) attn::sel_block(cur, nxt, (char*)c.lds, S);
        attn::sel_block(nxt, nxt, (char*)c.lds, S);
    }
    if (c.G == 256) {
        if (c.vcu >= NITEM) { for (int j = 0; j < 4; ++j) { const int u = (c.vcu - NITEM) * 4 + j; attn_sample_unit(c, a, u >> 2, u & 3); } }
        else if (c.vcu % 10 == 9) { for (int j = 0; j < 3; ++j) { const int u = 64 + (c.vcu / 10) * 3 + j; if (u < MS) attn_sample_unit(c, a, u >> 2, u & 3); } }
    } else for (int u = c.vcu; u < MS; u += c.G) attn_sample_unit(c, a, u >> 2, u & 3);
}

enum { PH_PRO = 0, PH_IN0, PH_MIX0, PH_HSCAN, PH_HFIX, PH_OUT0, PH_GU0, PH_DOWN0, PH_IN1, PH_POST, PH_IDX, PH_TOPK, PH_ATTN, PH_OUT1, PH_GU1, PH_DOWN1, NPHASE };
#ifndef ONLYPH
#define ONLYPH -1
#endif
#define PHON(x) (ONLYPH < 0 || ONLYPH == (x))
#ifndef REP_PH
#define REP_PH -1
#endif
#ifndef REP_N
#define REP_N 1
#endif
__global__ void __launch_bounds__(NWAVES * 64, 2) fwd_kernel(Args args) {
    extern __shared__ __attribute__((aligned(16))) unsigned char lds[];
    Ctx c;
    c.lds = (LAS unsigned char*)lds;
    c.MISC = (volatile LAS unsigned*)(c.lds + MISC_OFF);
    c.tid = threadIdx.x; c.lane = c.tid & 63; c.wave = __builtin_amdgcn_readfirstlane(c.tid >> 6);
    c.G = gridDim.x; { const int bx = blockIdx.x; c.vcu = (c.G % 8 == 0) ? (bx % 8) * (c.G / 8) + bx / 8 : bx; }
    c.ctl = (gu32*)(args.ws + WS_CTL);
    for (int u = c.tid; u < (LDS_BYTES - LDSCTL_OFF) / 4; u += NWAVES * 64) ((LAS unsigned*)(c.lds + LDSCTL_OFF))[u] = 0u;
    __syncthreads();
    const int lo = args.ph_lo, hi = args.ph_hi;
    XcdBarrier bar; bar.bar = (unsigned*)(c.ctl + CW_BAR); bar.x = 0; bar.st = nullptr;
    if (hi - lo > 1 || REP_N > 1) bar = xcd_barrier_post((unsigned*)(c.ctl + CW_BAR), c.MISC + 8);
    c.qoff = 0;
#pragma unroll 1
    for (int ph = lo; ph < hi; ++ph) {
        const int layer = ph >= PH_IN1 ? 1 : 0;
        const __attribute__((address_space(4))) Args* ap = (const __attribute__((address_space(4))) Args*)__builtin_amdgcn_kernarg_segment_ptr(); asm volatile("" : "+s"(ap));
        ARGREF la = *ap; unsigned char* const ws = la.ws; float* const out = la.out;
        { int t_ = threadIdx.x; asm volatile("" : "+v"(t_)); c.tid = t_; c.lane = t_ & 63; c.wave = __builtin_amdgcn_readfirstlane(t_ >> 6); }
        if ((ph == PH_DOWN0 || ph == PH_DOWN1) && PHON(PH_OUT0)) {
            pg8::SchedX S0; S0.init(MP, 1024, c.G, (int)blockIdx.x, 0, 0, 1, 0); pg8::Unit u0; if (S0.next(0, u0)) conv_fixup_tile(c, la, layer, u0.pm); VM_WAIT(); __syncthreads(); }
        if (ph == PH_PRO && PHON(PH_PRO)) p0_prologue(c, la);
        else if ((ph == PH_IN0 || ph == PH_IN1) && PHON(PH_IN0)) {
            pg8::Gemm g{(const pg8::bf16_t*)(ws + WS_XB), (const pg8::bf16_t*)(ws + (ph == PH_IN0 ? WS_WIN0 : WS_WIN1)), MT, 0, 1024};
            pg8::SchedX S; if (ph == PH_IN0) S.init(MP, ZC0, c.G, (int)blockIdx.x, 16, MT / 256, 4, 13); else S.init(MP, ZC1, c.G, (int)blockIdx.x, 0, 0, 1, 0);
            pg8::EpiZ E{(pg8::bf16_t*)(ws + WS_Z), ph == PH_IN0 ? ZC0 : ZC1, ssptr(c, ph == PH_IN0 ? 0 : 2), ph == PH_IN0 ? 13 : 9, (float*)(ws + WS_MEMKV), MEMROW0};
            pg8::gemm_phase<pg8::EpiZ, pg8::SchedX, PG8_ALIGN, PG8_SP2>(c.lds + RING_OFF, g, S, E);
            { SgArgs sg{}; sg.A = (const bf16*)(ws + WS_XB) + (size_t)MP * DM; sg.Bt = (const bf16*)(ws + (ph == PH_IN0 ? WS_WIN0 : WS_WIN1)); sg.K = 1024; sg.mode = 0; sg.Z = (bf16*)(ws + WS_Z); sg.ldz = ph == PH_IN0 ? ZC0 : ZC1; sg.ssin = ssptr(c, ph == PH_IN0 ? 0 : 2);
              sgemm_phase(c, sg, ph == PH_IN0 ? ZC0 : ZC1); }
            if (ph == PH_IN0) { __syncthreads(); convert_layer1_tail(c, la, (64 * 13 + 16) % c.G); }
        }
        else if (ph == PH_MIX0 && PHON(PH_MIX0)) p2_mixer0(c, la);
        else if (ph == PH_HSCAN && PHON(PH_HSCAN)) hgrn_scan(c, la);
        else if (ph == PH_HFIX && PHON(PH_HFIX)) p2c_hgrn_fix(c, la);
        else if ((ph == PH_OUT0 || ph == PH_DOWN0 || ph == PH_OUT1 || ph == PH_DOWN1) && PHON(PH_OUT0)) {
            const bool isout = (ph == PH_OUT0 || ph == PH_OUT1);
            pg8::Gemm g{(const pg8::bf16_t*)(ws + (isout ? WS_MIX : WS_ACT)), (const pg8::bf16_t*)(ws + (isout ? WS_WOUT + (size_t)layer * 1024 * 1024 * 2 : WS_WD + (size_t)layer * 1024 * DFF * 2)), MT, 1024, isout ? 1024 : DFF};
            pg8::SchedX S; S.init(MP, 1024, c.G, (int)blockIdx.x, 0, 0, 1, 0);
            pg8::EpiResid E;
            E.rp = ph == PH_OUT0 ? la.in[0] : nullptr; E.rb = (const pg8::bf16_t*)(ws + WS_XB); E.y = ph == PH_DOWN1 ? out + O_YP : nullptr;
            E.xb = ph == PH_DOWN1 ? nullptr : (pg8::bf16_t*)(ws + WS_XB); E.ssout = ph == PH_DOWN1 ? nullptr : ssptr(c, ph == PH_OUT0 ? 1 : (ph == PH_DOWN0 ? 2 : 3));
            pg8::gemm_phase<pg8::EpiResid, pg8::SchedX, PG8_ALIGN, PG8_SP2>(c.lds + RING_OFF, g, S, E);
            { SgArgs sg{}; sg.A = (const bf16*)(ws + (isout ? WS_MIX : WS_ACT)) + (size_t)MP * (isout ? 1024 : DFF); sg.Bt = (const bf16*)g.Bt; sg.K = isout ? 1024 : DFF; sg.mode = 1; sg.rb = (const bf16*)(ws + WS_XB); sg.resid = ph == PH_OUT0 ? la.in[1] : nullptr; sg.y = ph == PH_DOWN1 ? out + O_YS : nullptr; sg.xb = (bf16*)E.xb; sg.ssout = E.ssout;
              sgemm_phase(c, sg, 1024); }
        }
        else if ((ph == PH_GU0 || ph == PH_GU1) && PHON(PH_GU0)) {
            pg8::Gemm g{(const pg8::bf16_t*)(ws + WS_XB), (const pg8::bf16_t*)(ws + WS_WGU + (size_t)layer * 5632 * 1024 * 2), MT, 5632, 1024};
            pg8::SchedX S; S.init(MP, 5632, c.G, (int)blockIdx.x, 0, 0, 1, 0);
            pg8::EpiGU E{(pg8::bf16_t*)(ws + WS_ACT), ssptr(c, layer ? 3 : 1), out + O_CVP + (size_t)layer * 4 * 2 * DFF, la.in[26] + (size_t)layer * 3 * DFF, la.in[27] + (size_t)layer * DFF, (float*)(ws + WS_G4), (float*)(ws + WS_UP2)};
            pg8::gemm_phase<pg8::EpiGU, pg8::SchedX, PG8_ALIGN, PG8_SP2>(c.lds + RING_OFF, g, S, E);
            { SgArgs sg{}; sg.A = (const bf16*)(ws + WS_XB) + (size_t)MP * DM; sg.Bt = (const bf16*)g.Bt; sg.K = 1024; sg.mode = 2; sg.ssin = E.ss; sg.ACT = (bf16*)E.ACT; sg.cvs = out + O_CVS + (size_t)layer * 32 * 2 * DFF; sg.cst = la.in[8] + (size_t)layer * 32 * 2 * DFF; sg.cw = E.cw; sg.cb = E.cb;
              sgemm_phase(c, sg, 5632); }
        }
        else if (ph == PH_POST && PHON(PH_POST)) p8_dsa_post(c, la);
        else if (ph == PH_IDX && PHON(PH_IDX)) p9_indexer(c, la);
        else if (ph == PH_TOPK && PHON(PH_TOPK)) p10_topk(c, la);
        else if (ph == PH_ATTN && PHON(PH_ATTN)) p11_attention(c, la);
        if (REP_N > 1 && ph == REP_PH && c.qoff < 4 * (REP_N - 1)) { c.qoff += 4; --ph; xcd_barrier(bar); continue; }
        if (REP_N > 1) c.qoff = 0;
        if (ph + 1 < hi) xcd_barrier(bar);
    }
}

#ifndef MK_ONE_LAUNCH
#define MK_ONE_LAUNCH 1
#endif
extern "C" void kernel_launch(void* const* d_in, const int* in_sizes, int n_in, void* d_out, int out_size, void* d_ws, size_t ws_size, hipStream_t stream) {
    static int grid = 0;
    if (grid == 0) {
        if (n_in != 29 || out_size != (int)O_END || ws_size < WS_END) { fprintf(stderr, "kernel_launch: unexpected problem (n_in %d, out %d, ws %zu)\n", n_in, out_size, ws_size); grid = -1; return; }
        int dev = 0, cus = 0;
        if (hipGetDevice(&dev) != hipSuccess || hipDeviceGetAttribute(&cus, hipDeviceAttributeMultiprocessorCount, dev) != hipSuccess) { grid = -1; return; }
        if (hipFuncSetAttribute((const void*)fwd_kernel, hipFuncAttributeMaxDynamicSharedMemorySize, LDS_BYTES) != hipSuccess) { fprintf(stderr, "kernel_launch: hipFuncSetAttribute failed\n"); grid = -1; return; }
        (void)hipGetLastError();
        grid = cus;
    }
    if (grid < 0) return;
    if (hipMemsetAsync((char*)d_ws + WS_CTL, 0, CTL_ZERO_BYTES, stream) != hipSuccess) { fprintf(stderr, "kernel_launch: memset failed\n"); return; }
    Args a{};
    for (int i = 0; i < 29; ++i) a.in[i] = (const float*)d_in[i];
    a.page_table = (const int*)d_in[9]; a.out = (float*)d_out; a.ws = (unsigned char*)d_ws;
#if MK_ONE_LAUNCH
    a.ph_lo = 0; a.ph_hi = NPHASE;
    hipLaunchKernelGGL(fwd_kernel, dim3(grid), dim3(NWAVES * 64), LDS_BYTES, stream, a);
#else
    for (int ph = 0; ph < NPHASE; ++ph) { a.ph_lo = ph; a.ph_hi = ph + 1; hipLaunchKernelGGL(fwd_kernel, dim3(grid), dim3(NWAVES * 64), LDS_BYTES, stream, a); }
#endif
}
```

```cpp
#include <hip/hip_runtime.h>
#include <cstdio>
#include <cstdint>


namespace pg8 {
#define PG8_LAS __attribute__((address_space(3)))
typedef unsigned short bf16_t;
typedef short bf16x8 __attribute__((ext_vector_type(8)));
typedef float f32x4 __attribute__((ext_vector_type(4)));
typedef unsigned u32x4 __attribute__((ext_vector_type(4)));
constexpr int BM = 256, BK = 64, HALF = 128, HTB = HALF * BK * 2  , STAGE_BYTES = 8 * HTB, NXCD = 8, WGM = 8;

__host__ __device__ __forceinline__ int lds_byte(int r, int c) { const int st = (r >> 4) * 2 + (c >> 5), rr = r & 15, cc = c & 31, ob = rr * 64 + cc * 2; return st * 1024 + (ob ^ (((ob >> 9) & 1) << 5)); }
__host__ __device__ __forceinline__ void stage_rc(int b, int& R, int& C) { const int st = b / 1024, sb = b % 1024, swz = sb ^ (((sb >> 9) & 1) << 5); R = (st >> 1) * 16 + swz / 64; C = (st & 1) * 32 + (swz % 64) / 2; }
__host__ __device__ __forceinline__ int perm32(int rho) { const int n = rho >> 4, i = rho & 15; return 8 * (i >> 2) + 4 * n + (i & 3); }

struct Unit { int pm, pn; };
struct Gemm { const bf16_t* A; const bf16_t* Bt; int M, N, K; };

struct StaticOrder {
    int nM, nN, nwg, G, c;
    __host__ __device__ __forceinline__ void init(int M, int N, int G_, int c_) { nM = M / BM; nN = N / BM; nwg = nM * nN; G = G_; c = c_; }
    __host__ __device__ __forceinline__ bool next(int i, Unit& u) const {
        const long L = (long)i * G + c; if (L >= nwg) return false;
        int wgid = (int)L; { const int q = nwg / NXCD, r = nwg % NXCD, xcd = wgid % NXCD, off = wgid / NXCD; wgid = (xcd < r ? xcd * (q + 1) : r * (q + 1) + (xcd - r) * q) + off; }
        const int nig = WGM * nN, gid = wgid / nig, fm = gid * WGM, gsz = (nM - fm) < WGM ? (nM - fm) : WGM;
        u.pm = fm + ((wgid % nig) % gsz); u.pn = (wgid % nig) / gsz; return true;
    }
    __device__ __forceinline__ void a_ready(const Unit&) const {}
    __device__ __forceinline__ void done(const Unit&) const {}
};


constexpr int MP = 16384, MS = 128, MVALID = MP + MS, MT = 16640, DM = 1024, DFF = 2816;
constexpr float RMS_EPS = 1e-6f;
__device__ __forceinline__ unsigned cvt_pk_bf16(float lo, float hi) { unsigned r; asm volatile("v_cvt_pk_bf16_f32 %0, %1, %2" : "=v"(r) : "v"(lo), "v"(hi)); return r; }

struct SchedX {
    StaticOrder so; int nextra, e_pm0, e_nm, e_pn0;
    __device__ __forceinline__ void init(int M, int N, int G_, int c_, int nextra_, int e_pm0_, int e_nm_, int e_pn0_) { so.init(M, N, G_, c_); nextra = nextra_; e_pm0 = e_pm0_; e_nm = e_nm_; e_pn0 = e_pn0_; }
    __device__ __forceinline__ bool next(int i, Unit& u) const {
        const long L = (long)i * so.G + so.c;
        if (L < so.nwg) return so.next(i, u);
        const int e = (int)(L - so.nwg); if (e >= nextra) return false;
        u.pm = e_pm0 + e % e_nm; u.pn = e_pn0 + e / e_nm; return true;
    }
    __device__ __forceinline__ void a_ready(const Unit&) const {}
    __device__ __forceinline__ void done(const Unit&) const {}
};

struct EpiZ {
    static constexpr bool PERM = true, AFTER_DRAIN = false;
    bf16_t* Z; int ldz; const float* ss; int nmain; float* memkv; int memrow0;
    __device__ __forceinline__ void operator()(const f32x4 (&acc)[2][2][4][2], const Unit& u, int wr, int wc, int fr, int fq) const {
        const int row0 = u.pm * BM + wr * 64 + fr;
        if (u.pn < nmain) {
            const int col0 = u.pn * BM + wc * 32 + 8 * fq;
#pragma unroll
            for (int ai = 0; ai < 2; ++ai)
#pragma unroll
                for (int m = 0; m < 4; ++m) { const int row = row0 + ai * HALF + m * 16; const float rs = rsqrtf(ss[row] * (1.0f / DM) + RMS_EPS);
#pragma unroll
                    for (int bj = 0; bj < 2; ++bj) { const f32x4 v0 = acc[ai][bj][m][0] * rs, v1 = acc[ai][bj][m][1] * rs;
                        u32x4 w; w.x = cvt_pk_bf16(v0[0], v0[1]); w.y = cvt_pk_bf16(v0[2], v0[3]); w.z = cvt_pk_bf16(v1[0], v1[1]); w.w = cvt_pk_bf16(v1[2], v1[3]);
                        *(u32x4*)(Z + (size_t)row * ldz + col0 + bj * HALF) = w; } }
        } else {
            const int col0 = (u.pn - nmain) * BM + wc * 32 + 8 * fq;
#pragma unroll
            for (int ai = 0; ai < 2; ++ai)
#pragma unroll
                for (int m = 0; m < 4; ++m) { const int row = row0 + ai * HALF + m * 16 - memrow0;
#pragma unroll
                    for (int bj = 0; bj < 2; ++bj) { float* p = memkv + (size_t)row * 1024 + col0 + bj * HALF; *(f32x4*)p = acc[ai][bj][m][0]; *(f32x4*)(p + 4) = acc[ai][bj][m][1]; } }
        }
    }
};

struct EpiResid {
    static constexpr bool PERM = true, AFTER_DRAIN = false;
    const float* rp; const bf16_t* rb; float* y; bf16_t* xb; float* ssout;
    __device__ __forceinline__ void operator()(const f32x4 (&acc)[2][2][4][2], const Unit& u, int wr, int wc, int fr, int fq) const {
        const int row0 = u.pm * BM + wr * 64 + fr, col0 = u.pn * BM + wc * 32 + 8 * fq;
#pragma unroll
        for (int ai = 0; ai < 2; ++ai)
#pragma unroll
            for (int m = 0; m < 4; ++m) { const int row = row0 + ai * HALF + m * 16; float part = 0.f;
#pragma unroll
                for (int bj = 0; bj < 2; ++bj) { const int c = col0 + bj * HALF; f32x4 r0, r1;
                    if (rp) { r0 = *(const f32x4*)(rp + (size_t)row * DM + c); r1 = *(const f32x4*)(rp + (size_t)row * DM + c + 4); }
                    else { const u32x4 q = *(const u32x4*)(rb + (size_t)row * DM + c);
                        r0 = (f32x4){__builtin_bit_cast(float, q.x << 16), __builtin_bit_cast(float, q.x & 0xffff0000u), __builtin_bit_cast(float, q.y << 16), __builtin_bit_cast(float, q.y & 0xffff0000u)};
                        r1 = (f32x4){__builtin_bit_cast(float, q.z << 16), __builtin_bit_cast(float, q.z & 0xffff0000u), __builtin_bit_cast(float, q.w << 16), __builtin_bit_cast(float, q.w & 0xffff0000u)}; }
                    const f32x4 v0 = acc[ai][bj][m][0] + r0, v1 = acc[ai][bj][m][1] + r1;
                    if (y) { *(f32x4*)(y + (size_t)row * DM + c) = v0; *(f32x4*)(y + (size_t)row * DM + c + 4) = v1; }
                    part += (v0[0] * v0[0] + v0[1] * v0[1]) + (v0[2] * v0[2] + v0[3] * v0[3]) + (v1[0] * v1[0] + v1[1] * v1[1]) + (v1[2] * v1[2] + v1[3] * v1[3]);
                    if (xb) { u32x4 w; w.x = cvt_pk_bf16(v0[0], v0[1]); w.y = cvt_pk_bf16(v0[2], v0[3]); w.z = cvt_pk_bf16(v1[0], v1[1]); w.w = cvt_pk_bf16(v1[2], v1[3]);
                        *(u32x4*)(xb + (size_t)row * DM + c) = w; } }
                part += __shfl_xor(part, 16); part += __shfl_xor(part, 32);
                if (ssout && fq == 0) atomicAdd(ssout + row, part); }
    }
};

__device__ __forceinline__ void dpp_ror12(const f32x4& v, f32x4& r1, f32x4& r2) {
    float a0, a1, a2, a3, b0, b1, b2, b3;
    asm volatile("s_nop 1\n\t"
                 "v_mov_b32_dpp %0, %8 row_ror:1 row_mask:0xf bank_mask:0xf\n\tv_mov_b32_dpp %1, %9 row_ror:1 row_mask:0xf bank_mask:0xf\n\t"
                 "v_mov_b32_dpp %2, %10 row_ror:1 row_mask:0xf bank_mask:0xf\n\tv_mov_b32_dpp %3, %11 row_ror:1 row_mask:0xf bank_mask:0xf\n\t"
                 "v_mov_b32_dpp %4, %8 row_ror:2 row_mask:0xf bank_mask:0xf\n\tv_mov_b32_dpp %5, %9 row_ror:2 row_mask:0xf bank_mask:0xf\n\t"
                 "v_mov_b32_dpp %6, %10 row_ror:2 row_mask:0xf bank_mask:0xf\n\tv_mov_b32_dpp %7, %11 row_ror:2 row_mask:0xf bank_mask:0xf"
                 : "=&v"(a0), "=&v"(a1), "=&v"(a2), "=&v"(a3), "=&v"(b0), "=&v"(b1), "=&v"(b2), "=&v"(b3) : "v"(v[0]), "v"(v[1]), "v"(v[2]), "v"(v[3]));
    r1 = (f32x4){a0, a1, a2, a3}; r2 = (f32x4){b0, b1, b2, b3};
}
struct EpiGU {
    static constexpr bool PERM = true, AFTER_DRAIN = false;
    bf16_t* ACT; const float* ss; float* cvp; const float* cw; const float* cb; float* G4; float* UP2;
    __device__ __forceinline__ void operator()(const f32x4 (&acc)[2][2][4][2], const Unit& u, int wr, int wc, int fr, int fq) const {
        const int row0 = u.pm * BM + wr * 64 + fr, colg = u.pn * HALF + wc * 32 + 8 * fq;
        f32x4 w0[2], w1[2], w2[2], bb[2];
#pragma unroll
        for (int n = 0; n < 2; ++n) { const int col = colg + 4 * n; w0[n] = *(const f32x4*)(cw + col); w1[n] = *(const f32x4*)(cw + DFF + col); w2[n] = *(const f32x4*)(cw + 2 * DFF + col); bb[n] = *(const f32x4*)(cb + col); }
#pragma unroll
        for (int ai = 0; ai < 2; ++ai) { f32x4 r1p[2] = {{0.f, 0.f, 0.f, 0.f}, {0.f, 0.f, 0.f, 0.f}}, r2p[2] = {{0.f, 0.f, 0.f, 0.f}, {0.f, 0.f, 0.f, 0.f}}; const int slab = (u.pm * BM + ai * HALF + wr * 64) >> 6;
#pragma unroll
            for (int m = 0; m < 4; ++m) { const int row = row0 + ai * HALF + m * 16; const float rs = rsqrtf(ss[row] * (1.0f / DM) + RMS_EPS);
                f32x4 y[2], g[2], up[2];
#pragma unroll
                for (int n = 0; n < 2; ++n) { g[n] = acc[ai][0][m][n] * rs; up[n] = acc[ai][1][m][n] * rs;
                    f32x4 r1, r2; dpp_ror12(g[n], r1, r2);
                    const f32x4 p1 = fr >= 1 ? r1 : r1p[n], p2 = fr >= 2 ? r2 : r2p[n];
                    const f32x4 cv = bb[n] + w0[n] * p2 + w1[n] * p1 + w2[n] * g[n];
#pragma unroll
                    for (int i = 0; i < 4; ++i) y[n][i] = cv[i] * __builtin_amdgcn_rcpf(1.0f + __expf(-cv[i])) * up[n][i];
                    r1p[n] = r1; r2p[n] = r2; }
                if (m == 0 && fr < 2) {
#pragma unroll
                    for (int n = 0; n < 2; ++n) { *(f32x4*)(G4 + (size_t)(slab * 4 + fr) * DFF + colg + 4 * n) = g[n]; *(f32x4*)(UP2 + (size_t)(slab * 2 + fr) * DFF + colg + 4 * n) = up[n]; } }
                else { u32x4 w; w.x = cvt_pk_bf16(y[0][0], y[0][1]); w.y = cvt_pk_bf16(y[0][2], y[0][3]); w.z = cvt_pk_bf16(y[1][0], y[1][1]); w.w = cvt_pk_bf16(y[1][2], y[1][3]); *(u32x4*)(ACT + (size_t)row * DFF + colg) = w; }
                if (m == 3 && fr >= 14) {
#pragma unroll
                    for (int n = 0; n < 2; ++n) { *(f32x4*)(G4 + (size_t)(slab * 4 + 2 + (fr - 14)) * DFF + colg + 4 * n) = g[n];
                        const int t = row & 4095; if (t >= 4094) *(f32x4*)(cvp + (size_t)((row >> 12) * 2 + (t - 4094)) * DFF + colg + 4 * n) = g[n]; } } } }
    }
};

template <class Epi, class Sched, bool ALIGN_EPI = false, bool SP2 = false>
__device__ __forceinline__ void gemm_phase(PG8_LAS unsigned char* lds, const Gemm g, const Sched& S, const Epi& E) {
    int tid_ = threadIdx.x; asm volatile("" : "+v"(tid_));
    const int tid = tid_, wid = __builtin_amdgcn_readfirstlane(tid >> 6), lane = tid & 63, wr = wid >> 2, wc = wid & 3, fr = lane & 15, fq = lane >> 4;
    const int K = g.K, nt = K / BK;
    unsigned voffA[2], voffB[2];
#pragma unroll
    for (int i = 0; i < 2; ++i) { int R, C; stage_rc(tid * 16 + i * 8192, R, C); const int Rb = Epi::PERM ? ((R & ~31) + perm32(R & 31)) : R;
        voffA[i] = (unsigned)(R * K + C) * 2u; voffB[i] = (unsigned)(Rb * K + C) * 2u; }
    const size_t kstep = (size_t)(BK * 2);
    const size_t hstep = (size_t)HALF * K * 2;
    const size_t tstep = 2 * hstep;
    const unsigned ldsw = (unsigned)wid * 1024u;
    const int aoff = lds_byte(wr * 64 + fr, fq * 8), boff = lds_byte(wc * 32 + fr, fq * 8);
#define PG8_SA(b, h) (((b) * 2 + (h)) * HTB)
#define PG8_SB(b, h) ((4 + (b) * 2 + (h)) * HTB)
#define PG8_STAGE(bufoff, gbase, voff) do { _Pragma("unroll") for (int _i = 0; _i < 2; ++_i) \
        __builtin_amdgcn_global_load_lds((const unsigned*)((const char*)(gbase) + (voff)[_i]), (PG8_LAS unsigned*)(lds + (bufoff) + ldsw + _i * 8192), 16, 0, 0); } while (0)
#define PG8_LDA(dst, b, h) do { _Pragma("unroll") for (int m = 0; m < 4; ++m) _Pragma("unroll") for (int k = 0; k < 2; ++k) dst[m][k] = *(const PG8_LAS bf16x8*)(lds + PG8_SA(b, h) + aoff + m * 2048 + k * 1024); } while (0)
#define PG8_LDB(dst, b, h) do { _Pragma("unroll") for (int n = 0; n < 2; ++n) _Pragma("unroll") for (int k = 0; k < 2; ++k) dst[n][k] = *(const PG8_LAS bf16x8*)(lds + PG8_SB(b, h) + boff + n * 2048 + k * 1024); } while (0)
#define PG8_MMA(ai, bj, At, Bt) do { __builtin_amdgcn_s_setprio(1); _Pragma("unroll") for (int m = 0; m < 4; ++m) _Pragma("unroll") for (int n = 0; n < 2; ++n) _Pragma("unroll") for (int k = 0; k < 2; ++k) \
        acc[ai][bj][m][n] = __builtin_amdgcn_mfma_f32_16x16x32_bf16(Bt[n][k], At[m][k], acc[ai][bj][m][n], 0, 0, 0); __builtin_amdgcn_s_setprio(0); } while (0)
#define PG8_WAIT_V(n) asm volatile("s_waitcnt vmcnt(" #n ")" ::: "memory")
#define PG8_WAIT_L(n) asm volatile("s_waitcnt lgkmcnt(" #n ")" ::: "memory")
#define PG8_BAR __builtin_amdgcn_s_barrier()
#define PG8_SCHED __builtin_amdgcn_sched_barrier(0)
    Unit cur, nxt; int ui = 0;
    if (!S.next(0, cur)) return;
    f32x4 acc[2][2][4][2];
#pragma unroll
    for (int a = 0; a < 2; ++a)
#pragma unroll
        for (int b = 0; b < 2; ++b)
#pragma unroll
            for (int m = 0; m < 4; ++m)
#pragma unroll
                for (int n = 0; n < 2; ++n) acc[a][b][m][n] = (f32x4){0.f, 0.f, 0.f, 0.f};
    bf16x8 At[4][2], B0[2][2], B1[2][2];
    const char* cA = (const char*)g.A + (size_t)cur.pm * tstep; const char* cB = (const char*)g.Bt + (size_t)cur.pn * tstep;
    S.a_ready(cur);
    if constexpr (SP2) {
        PG8_STAGE(PG8_SB(0, 0), cB, voffB); PG8_STAGE(PG8_SB(0, 1), cB + hstep, voffB); PG8_STAGE(PG8_SA(0, 0), cA, voffA); PG8_STAGE(PG8_SA(0, 1), cA + hstep, voffA);
        if (wr == 1) PG8_BAR;
        PG8_WAIT_V(2); PG8_BAR;
        PG8_STAGE(PG8_SB(1, 0), cB + kstep, voffB); PG8_STAGE(PG8_SA(1, 0), cA + kstep, voffA); PG8_STAGE(PG8_SB(1, 1), cB + hstep + kstep, voffB);
        PG8_WAIT_V(6); PG8_BAR;
    } else {
        PG8_STAGE(PG8_SB(0, 0), cB, voffB); PG8_STAGE(PG8_SA(0, 0), cA, voffA); PG8_STAGE(PG8_SB(0, 1), cB + hstep, voffB); PG8_STAGE(PG8_SA(0, 1), cA + hstep, voffA);
        if (wr == 1) PG8_BAR;
        PG8_WAIT_V(4); PG8_BAR;
        PG8_STAGE(PG8_SB(1, 0), cB + kstep, voffB); PG8_STAGE(PG8_SA(1, 0), cA + kstep, voffA); PG8_STAGE(PG8_SB(1, 1), cB + hstep + kstep, voffB);
        PG8_WAIT_V(6); PG8_BAR;
    }
    for (;;) {
        const bool has_next = S.next(ui + 1, nxt);
        const char* nA = has_next ? (const char*)g.A + (size_t)nxt.pm * tstep : cA; const char* nB = has_next ? (const char*)g.Bt + (size_t)nxt.pn * tstep : cB;
        for (int t = 0; t < nt; t += 2) {
            const bool last = (t == nt - 2);
            const char* a1 = cA + (size_t)(t + 1) * kstep;
            const char* a2 = last ? nA : cA + (size_t)(t + 2) * kstep; const char* b2 = last ? nB : cB + (size_t)(t + 2) * kstep;
            const char* a3 = a2 + kstep; const char* b3 = b2 + kstep;
            if (last && has_next) S.a_ready(nxt);
            if constexpr (SP2) {
            PG8_LDB(B0, 0, 0); PG8_LDB(B1, 0, 1); PG8_SCHED; PG8_LDA(At, 0, 0); PG8_STAGE(PG8_SA(1, 1), a1 + hstep, voffA);
            PG8_WAIT_V(8); PG8_WAIT_L(0); PG8_BAR; PG8_MMA(0, 0, At, B0); PG8_MMA(0, 1, At, B1); PG8_BAR; PG8_SCHED;
            PG8_LDA(At, 0, 1); PG8_STAGE(PG8_SB(0, 0), b2, voffB); PG8_STAGE(PG8_SB(0, 1), b2 + hstep, voffB); PG8_STAGE(PG8_SA(0, 0), a2, voffA);
            PG8_WAIT_V(8); PG8_WAIT_L(0); PG8_BAR; PG8_MMA(1, 0, At, B0); PG8_MMA(1, 1, At, B1); PG8_BAR; PG8_SCHED;
            PG8_LDB(B0, 1, 0); PG8_LDB(B1, 1, 1); PG8_SCHED; PG8_LDA(At, 1, 0); PG8_STAGE(PG8_SA(0, 1), a2 + hstep, voffA);
            PG8_WAIT_V(8); PG8_WAIT_L(0); PG8_BAR; PG8_MMA(0, 0, At, B0); PG8_MMA(0, 1, At, B1); PG8_BAR; PG8_SCHED;
            PG8_LDA(At, 1, 1); PG8_STAGE(PG8_SB(1, 0), b3, voffB); PG8_STAGE(PG8_SB(1, 1), b3 + hstep, voffB); PG8_STAGE(PG8_SA(1, 0), a3, voffA);
            PG8_WAIT_V(8); PG8_WAIT_L(0); PG8_BAR; PG8_MMA(1, 0, At, B0); PG8_MMA(1, 1, At, B1); PG8_BAR; PG8_SCHED;
            } else {
            PG8_LDB(B0, 0, 0); PG8_SCHED; PG8_LDA(At, 0, 0); PG8_STAGE(PG8_SA(1, 1), a1 + hstep, voffA);
            PG8_WAIT_L(8); PG8_BAR; PG8_WAIT_L(0); PG8_MMA(0, 0, At, B0); PG8_BAR; PG8_SCHED;
            PG8_LDB(B1, 0, 1); PG8_STAGE(PG8_SB(0, 0), b2, voffB);
            PG8_BAR; PG8_WAIT_L(0); PG8_MMA(0, 1, At, B1); PG8_BAR;
            PG8_LDA(At, 0, 1); PG8_STAGE(PG8_SA(0, 0), a2, voffA);
            PG8_BAR; PG8_WAIT_L(0); PG8_MMA(1, 0, At, B0); PG8_BAR; PG8_SCHED;
            PG8_STAGE(PG8_SB(0, 1), b2 + hstep, voffB);
            PG8_WAIT_V(6); PG8_BAR; PG8_MMA(1, 1, At, B1); PG8_BAR;
            PG8_LDB(B0, 1, 0); PG8_SCHED; PG8_LDA(At, 1, 0); PG8_STAGE(PG8_SA(0, 1), a2 + hstep, voffA);
            PG8_WAIT_L(8); PG8_BAR; PG8_WAIT_L(0); PG8_MMA(0, 0, At, B0); PG8_BAR; PG8_SCHED;
            PG8_LDB(B1, 1, 1); PG8_STAGE(PG8_SB(1, 0), b3, voffB);
            PG8_BAR; PG8_WAIT_L(0); PG8_MMA(0, 1, At, B1); PG8_BAR;
            PG8_LDA(At, 1, 1); PG8_STAGE(PG8_SA(1, 0), a3, voffA);
            PG8_BAR; PG8_WAIT_L(0); PG8_MMA(1, 0, At, B0); PG8_BAR; PG8_SCHED;
            PG8_STAGE(PG8_SB(1, 1), b3 + hstep, voffB);
            PG8_WAIT_V(6); PG8_BAR; PG8_MMA(1, 1, At, B1); PG8_BAR;
            }
        }
        if constexpr (ALIGN_EPI) { if (wr == 0) PG8_BAR; }
        if constexpr (!Epi::AFTER_DRAIN) { E(acc, cur, wr, wc, fr, fq); S.done(cur); }
        if (!has_next) break;
#pragma unroll
        for (int a = 0; a < 2; ++a)
#pragma unroll
            for (int b = 0; b < 2; ++b)
#pragma unroll
                for (int m = 0; m < 4; ++m)
#pragma unroll
                    for (int n = 0; n < 2; ++n) acc[a][b][m][n] = (f32x4){0.f, 0.f, 0.f, 0.f};
        cur = nxt; cA = nA; cB = nB; ++ui;
        if constexpr (ALIGN_EPI) { if (wr == 1) PG8_BAR; }
    }
    PG8_WAIT_V(0);
    if constexpr (!ALIGN_EPI) { if (wr == 0) PG8_BAR; }
    PG8_BAR;
    if constexpr (Epi::AFTER_DRAIN) { E.fused(acc, cur, wr, wc, fr, fq, lds, wid, lane); S.done(cur); }
#undef PG8_SA
#undef PG8_SB
#undef PG8_STAGE
#undef PG8_LDA
#undef PG8_LDB
#undef PG8_MMA
#undef PG8_WAIT_V
#undef PG8_WAIT_L
#undef PG8_BAR
#undef PG8_SCHED
}
}


#ifndef PG8_SP2
#define PG8_SP2 true
#endif
#ifndef PG8_ALIGN
#define PG8_ALIGN true
#endif
constexpr int NWAVES = 8;
constexpr int MP = pg8::MP, MS = pg8::MS, MVALID = pg8::MVALID, MT = pg8::MT, DM = 1024, DFF = 2816;
constexpr int SEQ = 4096, NB = 4, NSB = 32, PAST = 8192, NPOOL = 2560;
constexpr int ZC0 = 3328, ZC1 = 2304;
constexpr int Z1_Q = 0, Z1_K = 768, Z1_V = 1024, Z1_IQ = 1280, Z1_IK = 1792, Z1_IW = 1856, Z1_MQ = 1920;
constexpr int NMEMROWS = 1024, MEMROW0 = MT;
constexpr float EPS = 1e-6f;
constexpr size_t MiB = 1u << 20;
constexpr size_t WS_CTL = 0, CTL_ZERO_BYTES = 2 * MiB;
constexpr size_t WS_WIN0 = 2 * MiB, WS_WIN1 = 11 * MiB, WS_WOUT = 16 * MiB, WS_WGU = 20 * MiB, WS_WD = 42 * MiB;
constexpr size_t WS_XB = 54 * MiB, WS_MEMKV = 89 * MiB, WS_MIX = 94 * MiB, WS_Z = 128 * MiB, WS_U = 234 * MiB, WS_UP = 324 * MiB, WS_ACT = 414 * MiB;
constexpr size_t WS_QB = 504 * MiB, WS_KB = 528 * MiB, WS_VB = 536 * MiB, WS_IQB = 544 * MiB, WS_IKB = 560 * MiB, WS_IW = 562 * MiB;
constexpr size_t WS_SQ = 563 * MiB, WS_SIQ = WS_SQ + 512 * 1024, WS_SIW = WS_SIQ + 384 * 1024, WS_SSC = 564 * MiB, WS_SIDX = 569 * MiB, WS_MASK = 570 * MiB, WS_SC = 578 * MiB, WS_END = 834 * MiB;
constexpr int SSC_LD = 8256;
constexpr int CW_TMO = 0, CW_BAR = 4096, CW_Q = 8192, CW_SS = 16384;
constexpr size_t O_YP = 0, O_YS = O_YP + (size_t)MP * DM, O_HP = O_YS + (size_t)MS * DM, O_HS = O_HP + 4 * 6 * 16384, O_KP = O_HS + 32 * 6 * 16384,
    O_VP = O_KP + (size_t)MP * 256, O_IKP = O_VP + (size_t)MP * 256, O_KS = O_IKP + (size_t)MP * 64, O_VS = O_KS + MS * 256, O_IKS = O_VS + MS * 256,
    O_MK = O_IKS + MS * 64, O_MV = O_MK + 2 * 1024 * 256, O_CVP = O_MV + 2 * 1024 * 256, O_CVS = O_CVP + 2 * 4 * 2 * DFF, O_END = O_CVS + 2 * 32 * 2 * DFF;
static_assert(O_END == 31412224, "output size");
constexpr int RING_OFF = 0, RING_BYTES = 131072;
constexpr int LDSCTL_OFF = RING_BYTES, MISC_OFF = LDSCTL_OFF + 320;
constexpr int LDS_BYTES = 147456;

#define GAS __attribute__((address_space(1)))
#define LAS __attribute__((address_space(3)))
typedef unsigned short bf16;
typedef unsigned v4u __attribute__((ext_vector_type(4)));
typedef float f32x4 __attribute__((ext_vector_type(4)));
typedef short bf16x8 __attribute__((ext_vector_type(8)));
typedef GAS unsigned gu32;
typedef GAS unsigned long long gu64;
#define RLX_AGENT __ATOMIC_RELAXED, __HIP_MEMORY_SCOPE_AGENT
#define LDS_WAIT() asm volatile("s_waitcnt lgkmcnt(0)" ::: "memory")
#define VM_WAIT() asm volatile("s_waitcnt vmcnt(0)" ::: "memory")
__device__ __forceinline__ unsigned long long rt() { return __builtin_amdgcn_s_memrealtime(); }
__device__ __forceinline__ unsigned f2bf(float f) { unsigned u = __builtin_bit_cast(unsigned, f); return (u + 0x7fffu + ((u >> 16) & 1u)) >> 16; }
__device__ __forceinline__ unsigned pk2(float lo, float hi) { return f2bf(lo) | (f2bf(hi) << 16); }

#define XB_TMO      128
#define XB_XCNT(j)  (256  + 64 * (j))
#define XB_XSUB(j)  (1280 + 64 * (j))
#define XB_XGEN(j)  (2304 + 64 * (j))
#define XB_TOP      3328
#define XB_TOPGEN   3392
#define XCD_BAR_WORDS 3456
#define XB_SPIN_CAP (1u << 18)

__device__ __forceinline__ unsigned xb_ld(unsigned* p)              { return __hip_atomic_load(p, __ATOMIC_RELAXED, __HIP_MEMORY_SCOPE_AGENT); }
__device__ __forceinline__ unsigned xb_add(unsigned* p, unsigned v) { return __hip_atomic_fetch_add(p, v, __ATOMIC_RELAXED, __HIP_MEMORY_SCOPE_AGENT); }
__device__ __forceinline__ unsigned xb_xcc_id() { return (unsigned)__builtin_amdgcn_s_getreg((3 << 11) | 20) & 0xFu; }
#define XB_SPIN(cond, bar) do { unsigned _sp = 0; while (cond) { __builtin_amdgcn_s_sleep(1); \
    if ((++_sp & 255u) == 0u) { if (xb_ld(&(bar)[XB_TMO])) break; if (_sp > XB_SPIN_CAP) { atomicAdd(&(bar)[XB_TMO], 1u); break; } } } } while (0)

struct XcdBarrier {
    unsigned* bar; unsigned x;
    volatile LAS unsigned* st;
};

__device__ __forceinline__ XcdBarrier xcd_barrier_post(unsigned* bar, volatile LAS unsigned* st) {
    XcdBarrier b; b.bar = bar; b.x = xb_xcc_id(); b.st = st;
    if (threadIdx.x == 0) (void)xb_add(&bar[XB_XCNT(b.x)], 1u);
    return b;
}
__device__ __forceinline__ void xcd_barrier_complete(unsigned* bar, unsigned x, unsigned& nloc, unsigned& nx) {
    const unsigned G = gridDim.x * gridDim.y * gridDim.z;
    unsigned sum, cnt, mine, sp = 0u;
    for (;;) {
        sum = 0u; cnt = 0u; mine = 0u;
#pragma unroll
        for (unsigned j = 0; j < 16; ++j) { const unsigned c = xb_ld(&bar[XB_XCNT(j)]); sum += c; cnt += (c > 0u) ? 1u : 0u; mine = (j == x) ? c : mine; }
        if (sum == G) break;
        __builtin_amdgcn_s_sleep(1);
        if ((++sp & 255u) == 0u) { if (xb_ld(&bar[XB_TMO])) break; if (sp > XB_SPIN_CAP) { atomicAdd(&bar[XB_TMO], 1u); break; } }
    }
    nloc = mine > 0u ? mine : 1u; nx = cnt > 0u ? cnt : 1u;
}

__device__ __forceinline__ void xcd_barrier(const XcdBarrier& b) {
    asm volatile("s_waitcnt vmcnt(0)" ::: "memory");
    __syncthreads();
    if (threadIdx.x == 0) {
        unsigned* bar = b.bar;
        __builtin_amdgcn_s_waitcnt(0);
        unsigned nloc = b.st[0], nx = b.st[1];
        if (nloc == 0u) { xcd_barrier_complete(bar, b.x, nloc, nx); b.st[0] = nloc; b.st[1] = nx; }
        const unsigned old = xb_add(&bar[XB_XSUB(b.x)], 1u);
        const unsigned gen = old / nloc;
        if (old + 1u == (gen + 1u) * nloc) {
            __builtin_amdgcn_fence(__ATOMIC_RELEASE, "agent");
            asm volatile("s_waitcnt vmcnt(0)" ::: "memory");
            const unsigned og = xb_add(&bar[XB_TOP], 1u);
            const unsigned tg = og / nx;
            if (og + 1u == (tg + 1u) * nx) xb_add(&bar[XB_TOPGEN], 1u);
            else XB_SPIN(xb_ld(&bar[XB_TOPGEN]) == tg, bar);
            __builtin_amdgcn_fence(__ATOMIC_ACQUIRE, "agent");
            xb_add(&bar[XB_XGEN(b.x)], 1u);
            asm volatile("s_waitcnt vmcnt(0)" ::: "memory");
        } else {
            XB_SPIN(xb_ld(&bar[XB_XGEN(b.x)]) == gen, bar);
            __builtin_amdgcn_fence(__ATOMIC_ACQUIRE, "agent");
            asm volatile("s_waitcnt vmcnt(0)" ::: "memory");
        }
    }
    __syncthreads();
}


struct Args { const float* in[29]; const int* page_table; float* out; unsigned char* ws; int ph_lo, ph_hi; };
typedef const __attribute__((address_space(4))) Args& ARGREF;
struct Ctx { LAS unsigned char* lds; volatile LAS unsigned* MISC; gu32* ctl; int tid, lane, wave, vcu, G, qoff; };
typedef float f32x16 __attribute__((ext_vector_type(16)));
typedef unsigned long long u64;

__device__ __forceinline__ float bf2f(unsigned b) { return __builtin_bit_cast(float, b << 16); }
__device__ __forceinline__ float wave_sum(float v) {
#pragma unroll
    for (int o = 1; o < 64; o <<= 1) v += __shfl_xor(v, o);
    return v;
}
__device__ __forceinline__ float wave_sum_fast(float x) {
    x += __builtin_bit_cast(float, __builtin_amdgcn_update_dpp(0, __builtin_bit_cast(int, x), 0xB1, 0xF, 0xF, false));
    x += __builtin_bit_cast(float, __builtin_amdgcn_update_dpp(0, __builtin_bit_cast(int, x), 0x4E, 0xF, 0xF, false));
    x += __builtin_bit_cast(float, __builtin_amdgcn_update_dpp(0, __builtin_bit_cast(int, x), 0x141, 0xF, 0xF, false));
    x += __builtin_bit_cast(float, __builtin_amdgcn_update_dpp(0, __builtin_bit_cast(int, x), 0x140, 0xF, 0xF, false));
    const int xi = __builtin_bit_cast(int, x);
    return (__builtin_bit_cast(float, __builtin_amdgcn_readlane(xi, 0)) + __builtin_bit_cast(float, __builtin_amdgcn_readlane(xi, 16))) +
           (__builtin_bit_cast(float, __builtin_amdgcn_readlane(xi, 32)) + __builtin_bit_cast(float, __builtin_amdgcn_readlane(xi, 48)));
}
__device__ __forceinline__ int crow(int r, int hi) { return (r & 3) + 8 * (r >> 2) + 4 * hi; }
__device__ __forceinline__ float sigmoidf_(float x) { return 1.0f / (1.0f + __expf(-x)); }
__device__ __forceinline__ float* ssptr(const Ctx& c, int i) { return (float*)(c.ctl + CW_SS) + (size_t)i * MT; }

__device__ __forceinline__ int q_next(Ctx& c, int qi) {
    __syncthreads();
    if (c.tid == 0) c.MISC[16] = atomicAdd((unsigned*)(c.ctl + CW_Q + 64 * (qi + c.qoff)), 1u);
    __syncthreads();
    return (int)c.MISC[16];
}

template <int K>
__device__ __forceinline__ f32x16 mm32(const LAS bf16* A, int lda, const LAS bf16* Bt, int ldb, f32x16 acc, int lane) {
    const int r = lane & 31, h = lane >> 5;
#pragma unroll
    for (int ks = 0; ks < K; ks += 16) {
        const bf16x8 a = *(const LAS bf16x8*)(A + r * lda + ks + 8 * h);
        const bf16x8 b = *(const LAS bf16x8*)(Bt + r * ldb + ks + 8 * h);
        acc = __builtin_amdgcn_mfma_f32_32x32x16_bf16(a, b, acc, 0, 0, 0);
    }
    return acc;
}

__device__ __forceinline__ int map_row(int mapid, int n, int row_off) {
    if (mapid == 0) return n + row_off;
    if (mapid == 1) return n < 1864 ? n : n + 56;
    if (mapid == 2) return (n >> 7) * 256 + (n & 127);
    return (n >> 7) * 256 + 128 + (n & 127);
}
__device__ __forceinline__ void transpose_item(const float* W, int K, int N, const float* kscale, bf16* WT, int mapid, int row_off, LAS float* scr, int item, int lane) {
    const int nblk = (N + 31) / 32, kb = item / nblk, nb = item % nblk, k0 = 64 * kb, n0 = 32 * nb;
    { const int n4 = (lane & 7) * 4, nn = n0 + n4 < N ? n0 + n4 : N - 4; f32x4 v[8];
#pragma unroll
      for (int i = 0; i < 8; ++i) v[i] = *(const f32x4*)(W + (size_t)(k0 + 8 * i + (lane >> 3)) * N + nn);
#pragma unroll
      for (int i = 0; i < 8; ++i) { const int kk = 8 * i + (lane >> 3); const float sc = kscale ? kscale[k0 + kk] : 1.0f; LAS float* d = scr + kk * 33 + n4;
          d[0] = v[i].x * sc; d[1] = v[i].y * sc; d[2] = v[i].z * sc; d[3] = v[i].w * sc; } }
    LDS_WAIT(); asm volatile("" ::: "memory");
    const int cc = lane & 7;
#pragma unroll
    for (int j = 0; j < 4; ++j) { const int nl = (lane >> 3) + 8 * j, n = n0 + nl; const LAS float* s = scr + (8 * cc) * 33 + nl;
        v4u o; o.x = pk2(s[0 * 33], s[1 * 33]); o.y = pk2(s[2 * 33], s[3 * 33]); o.z = pk2(s[4 * 33], s[5 * 33]); o.w = pk2(s[6 * 33], s[7 * 33]);
        if (n < N) *(GAS v4u*)(WT + (size_t)map_row(mapid, n, row_off) * K + k0 + 8 * cc) = o; }
    LDS_WAIT(); asm volatile("" ::: "memory");
}
constexpr int I_INH = 16 * 104, I_MKV = 16 * 16, I_DSA = 16 * 67, I_OUT = 16 * 32, I_G = 16 * 88, I_D = 44 * 32;
constexpr int W_N0 = I_INH + 2 * I_MKV + I_OUT + 2 * I_G + I_D, W_NITEMS = W_N0 + I_DSA + I_OUT + 2 * I_G + I_D;
__device__ __forceinline__ void convert_item(ARGREF a, int it, LAS float* scr, int lane) {
    unsigned char* ws = a.ws; int r = it;
    if (r < I_INH) { transpose_item(a.in[13], 1024, 3328, a.in[11], (bf16*)(ws + WS_WIN0), 0, 0, scr, r, lane); return; } r -= I_INH;
    if (r < 2 * I_MKV) { const int l = r / I_MKV; transpose_item(a.in[20] + (size_t)l * 1024 * 512, 1024, 512, nullptr, (bf16*)(ws + WS_WIN0), 0, 3328 + 512 * l, scr, r % I_MKV, lane); return; } r -= 2 * I_MKV;
    int l = 0;
    if (r >= I_OUT + 2 * I_G + I_D) { r -= I_OUT + 2 * I_G + I_D; l = 1;
        if (r < I_DSA) { transpose_item(a.in[16], 1024, 2120, a.in[11] + 1024, (bf16*)(ws + WS_WIN1), 1, 0, scr, r, lane); return; } r -= I_DSA; }
    if (r < I_OUT) { transpose_item(a.in[23] + (size_t)l * 1024 * 1024, 1024, 1024, nullptr, (bf16*)(ws + WS_WOUT) + (size_t)l * 1024 * 1024, 0, 0, scr, r, lane); return; } r -= I_OUT;
    if (r < I_G) { transpose_item(a.in[24] + (size_t)l * 1024 * DFF, 1024, DFF, a.in[12] + l * 1024, (bf16*)(ws + WS_WGU) + (size_t)l * 5632 * 1024, 2, 0, scr, r, lane); return; } r -= I_G;
    if (r < I_G) { transpose_item(a.in[25] + (size_t)l * 1024 * DFF, 1024, DFF, a.in[12] + l * 1024, (bf16*)(ws + WS_WGU) + (size_t)l * 5632 * 1024, 3, 0, scr, r, lane); return; } r -= I_G;
    transpose_item(a.in[28] + (size_t)l * DFF * 1024, DFF, 1024, nullptr, (bf16*)(ws + WS_WD) + (size_t)l * 1024 * DFF, 0, 0, scr, r, lane);
}
__device__ __forceinline__ void convert_layer1_tail(Ctx& c, ARGREF a, int first_idle) {
    LAS float* scr = (LAS float*)(c.lds + RING_OFF + c.wave * 16384);
    const int bx = (int)blockIdx.x; if (bx < first_idle) return;
    const int nw = (c.G - first_idle) * NWAVES;
    for (int it = W_N0 + (bx - first_idle) * NWAVES + c.wave; it < W_NITEMS; it += nw) convert_item(a, it, scr, c.lane);
}
__device__ __forceinline__ void p0_prologue(Ctx& c, ARGREF a) {
    LAS float* scr = (LAS float*)(c.lds + RING_OFF + c.wave * 16384);
    const int gw = c.vcu * NWAVES + c.wave, NGW = c.G * NWAVES, lane = c.lane;
    unsigned char* ws = a.ws;
    for (int it = gw; it < W_N0; it += NGW) convert_item(a, it, scr, lane);
    for (int rr = gw; rr < 184; rr += NGW) { const int row = rr < 56 ? 1864 + rr : 2176 + (rr - 56);
        GAS v4u* p = (GAS v4u*)((bf16*)(ws + WS_WIN1) + (size_t)row * 1024); p[lane] = (v4u){0u, 0u, 0u, 0u}; p[64 + lane] = (v4u){0u, 0u, 0u, 0u}; }
    float* ss0 = ssptr(c, 0);
    for (int m = gw; m < MT + NMEMROWS; m += NGW) {
        GAS u64* o8 = (GAS u64*)((bf16*)(ws + WS_XB) + (size_t)m * DM) + lane;
        if (m >= MVALID && m < MT) {
#pragma unroll
            for (int j = 0; j < 4; ++j) o8[64 * j] = 0ull;
            continue; }
        const float* src = m < MP ? a.in[0] + (size_t)m * DM : (m < MVALID ? a.in[1] + (size_t)(m - MP) * DM : a.in[10] + (size_t)(m - MT) * DM);
        const GAS f32x4* xr = (const GAS f32x4*)src + lane; f32x4 v[4]; float s = 0.f;
#pragma unroll
        for (int j = 0; j < 4; ++j) { v[j] = xr[64 * j]; s += (v[j].x * v[j].x + v[j].y * v[j].y) + (v[j].z * v[j].z + v[j].w * v[j].w); }
        s = wave_sum_fast(s);
#pragma unroll
        for (int j = 0; j < 4; ++j) o8[64 * j] = (u64)pk2(v[j].x, v[j].y) | ((u64)pk2(v[j].z, v[j].w) << 32);
        if (m < MVALID && lane == 0) ss0[m] = s;
    }
}

__device__ __forceinline__ void memattn_unit(Ctx& c, const bf16* Zq  , int ldz, int nrows_valid, const float* Kp, const float* Vp, int kstride,
                                             bool normk, const float* kgain, const float* qgain, bf16* Out  ) {
    LAS bf16* KN = (LAS bf16*)(c.lds);
    LAS bf16* VTm = (LAS bf16*)(c.lds + 36864);
    LAS bf16* QN = (LAS bf16*)(c.lds + 70656) + c.wave * (32 * 72);
    LAS float* LI = (LAS float*)(c.lds + 107520) + c.wave * 32;
    int tid = c.tid; asm volatile("" : "+v"(tid));
    const int lane = tid & 63, w = c.wave;
    {
        const int m = tid >> 1, dh = (tid & 1) * 32;
        f32x4 kv[8]; float s = 0.f;
#pragma unroll
        for (int j = 0; j < 8; ++j) { kv[j] = *(const f32x4*)(Kp + (size_t)m * kstride + dh + 4 * j); s += (kv[j].x * kv[j].x + kv[j].y * kv[j].y) + (kv[j].z * kv[j].z + kv[j].w * kv[j].w); }
        s += __shfl_xor(s, 1);
        const float rs = normk ? rsqrtf(s * (1.0f / 64.0f) + EPS) : 1.0f;
#pragma unroll
        for (int j = 0; j < 8; j += 2) { f32x4 g0 = {1.f, 1.f, 1.f, 1.f}, g1 = g0;
            if (normk) { g0 = *(const f32x4*)(kgain + dh + 4 * j); g1 = *(const f32x4*)(kgain + dh + 4 * j + 4); }
            const f32x4 x0 = kv[j] * rs * g0, x1 = kv[j + 1] * rs * g1;
            v4u o; o.x = pk2(x0.x, x0.y); o.y = pk2(x0.z, x0.w); o.z = pk2(x1.x, x1.y); o.w = pk2(x1.z, x1.w);
            *(LAS v4u*)(KN + m * 72 + dh + 4 * j) = o; }
#pragma unroll
        for (int j = 0; j < 8; ++j) { const f32x4 vv = *(const f32x4*)(Vp + (size_t)m * kstride + dh + 4 * j);
            VTm[(dh + 4 * j + 0) * 264 + m] = (bf16)f2bf(vv.x); VTm[(dh + 4 * j + 1) * 264 + m] = (bf16)f2bf(vv.y);
            VTm[(dh + 4 * j + 2) * 264 + m] = (bf16)f2bf(vv.z); VTm[(dh + 4 * j + 3) * 264 + m] = (bf16)f2bf(vv.w); }
    }
    {
        const int row = lane >> 1, hf = lane & 1, grow = w * 32 + row;
        float x[32]; float s = 0.f;
        if (grow < nrows_valid) {
#pragma unroll
            for (int j = 0; j < 4; ++j) { const v4u q = *(const v4u*)(Zq + (size_t)grow * ldz + hf * 32 + 8 * j);
                x[8 * j + 0] = bf2f(q.x & 0xffffu); x[8 * j + 1] = bf2f(q.x >> 16); x[8 * j + 2] = bf2f(q.y & 0xffffu); x[8 * j + 3] = bf2f(q.y >> 16);
                x[8 * j + 4] = bf2f(q.z & 0xffffu); x[8 * j + 5] = bf2f(q.z >> 16); x[8 * j + 6] = bf2f(q.w & 0xffffu); x[8 * j + 7] = bf2f(q.w >> 16); }
        } else {
#pragma unroll
            for (int j = 0; j < 32; ++j) x[j] = 0.f;
        }
#pragma unroll
        for (int j = 0; j < 32; ++j) s += x[j] * x[j];
        s += __shfl_xor(s, 1);
        const float rs = rsqrtf(s * (1.0f / 64.0f) + EPS) * 0.125f;
#pragma unroll
        for (int j = 0; j < 32; j += 8) { v4u o;
            o.x = pk2(x[j] * rs * qgain[hf * 32 + j], x[j + 1] * rs * qgain[hf * 32 + j + 1]); o.y = pk2(x[j + 2] * rs * qgain[hf * 32 + j + 2], x[j + 3] * rs * qgain[hf * 32 + j + 3]);
            o.z = pk2(x[j + 4] * rs * qgain[hf * 32 + j + 4], x[j + 5] * rs * qgain[hf * 32 + j + 5]); o.w = pk2(x[j + 6] * rs * qgain[hf * 32 + j + 6], x[j + 7] * rs * qgain[hf * 32 + j + 7]);
            *(LAS v4u*)(QN + row * 72 + hf * 32 + j) = o; }
    }
    __syncthreads();
    if (w * 32 < nrows_valid) {
        const int r32 = lane & 31, hh = lane >> 5;
        f32x16 s[8];
#pragma unroll
        for (int mt = 0; mt < 8; ++mt) { f32x16 z = {}; s[mt] = mm32<64>(KN + mt * 32 * 72, 72, QN, 72, z, lane); }
        float mx = -1e30f;
#pragma unroll
        for (int mt = 0; mt < 8; ++mt)
#pragma unroll
            for (int r = 0; r < 16; ++r) mx = fmaxf(mx, s[mt][r]);
        mx = fmaxf(mx, __shfl_xor(mx, 32));
        float l = 0.f;
#pragma unroll
        for (int mt = 0; mt < 8; ++mt)
#pragma unroll
            for (int r = 0; r < 16; ++r) { const float p = __expf(s[mt][r] - mx); s[mt][r] = p; l += p; }
        l += __shfl_xor(l, 32);
        if (hh == 0) LI[r32] = l;
        f32x16 o[2] = {};
#pragma unroll
        for (int mt = 0; mt < 8; ++mt)
#pragma unroll
            for (int sx = 0; sx < 2; ++sx) {
                v4u pa; pa.x = pk2(s[mt][8 * sx + 0], s[mt][8 * sx + 1]); pa.y = pk2(s[mt][8 * sx + 2], s[mt][8 * sx + 3]);
                pa.z = pk2(s[mt][8 * sx + 4], s[mt][8 * sx + 5]); pa.w = pk2(s[mt][8 * sx + 6], s[mt][8 * sx + 7]);
                const bf16x8 af = __builtin_bit_cast(bf16x8, pa);
#pragma unroll
                for (int dt = 0; dt < 2; ++dt) { const LAS bf16* vp = VTm + (dt * 32 + r32) * 264 + mt * 32 + 16 * sx + 4 * hh;
                    const u64 lo = *(const LAS u64*)vp, hi = *(const LAS u64*)(vp + 8);
                    v4u bw; bw.x = (unsigned)lo; bw.y = (unsigned)(lo >> 32); bw.z = (unsigned)hi; bw.w = (unsigned)(hi >> 32);
                    o[dt] = __builtin_amdgcn_mfma_f32_32x32x16_bf16(af, __builtin_bit_cast(bf16x8, bw), o[dt], 0, 0, 0); }
            }
        LDS_WAIT();
#pragma unroll
        for (int r = 0; r < 16; ++r) { const int qr = crow(r, hh), grow = w * 32 + qr; const float il = 1.0f / LI[qr];
            if (grow < nrows_valid) {
#pragma unroll
                for (int dt = 0; dt < 2; ++dt) Out[(size_t)grow * DM + dt * 32 + r32] = (bf16)f2bf(o[dt][r] * il); } }
    }
}

constexpr int HG_GS = 4, HG_NG = SEQ / (32 * HG_GS);
constexpr size_t WS_HOL = WS_U, WS_HQC = WS_UP, WS_HUT = WS_ACT, WS_HST = WS_ACT + 64 * MiB, WS_HDG = WS_ACT + 50 * MiB;
template <bool PROMPT>
__device__ __forceinline__ void hgrn_unit(Ctx& c, ARGREF a, int b, int h, int g) {
    LAS unsigned char* L = c.lds;
    LAS float* LFt = (LAS float*)(L + 0);
    LAS float* OB = (LAS float*)(L + 0);
    LAS float* SEG = (LAS float*)(L + 16896);
    LAS float* DVv = (LAS float*)(L + 18944);
    LAS bf16* QD = (LAS bf16*)(L + 19456);
    LAS bf16* KD = (LAS bf16*)(L + 28160);
    LAS bf16* KET = (LAS bf16*)(L + 36864);
    LAS bf16* VT = (LAS bf16*)(L + 47104);
    LAS bf16* SCB = (LAS bf16*)(L + 57344);
    LAS bf16* STt = (LAS bf16*)(L + 59904);
    LAS float* BOFF = (LAS float*)(L + 94720);
    int tid = c.tid; asm volatile("" : "+v"(tid));
    const int lane = tid & 63, w = c.wave, r32 = lane & 31, hh = lane >> 5;
    const int te = tid & 31, k8 = (tid >> 5) * 8;
    const int tf = tid >> 4, v8 = (tid & 15) * 8;
    const bf16* Z = (const bf16*)(a.ws + WS_Z);
    bf16* MIX = (bf16*)(a.ws + WS_MIX);
    const int nch = PROMPT ? HG_GS : 1, nvalid = PROMPT ? 32 : 4;
    const int kt = w >> 1, vt0 = 2 * (w & 1);
    const int unit = (b * 6 + h) * HG_NG + g;
    f32x16 S0 = {}, S1 = {};
    if (!PROMPT) { const float* sp = a.in[7] + (size_t)(b * 6 + h) * 16384;
#pragma unroll
        for (int r = 0; r < 16; ++r) { const int k = 32 * kt + crow(r, hh); S0[r] = sp[k * 128 + 32 * vt0 + r32]; S1[r] = sp[k * 128 + 32 * (vt0 + 1) + r32]; } }
    float lbv[8];
#pragma unroll
    for (int j = 0; j < 8; ++j) { const float l0 = a.in[14][h * 128 + k8 + j], l1 = a.in[14][768 + h * 128 + k8 + j]; lbv[j] = 1.0f / (1.0f + __expf(l1 - l0)); }
    __syncthreads();
    if (tid < 128) BOFF[tid] = 0.f;
#define HG_WRITE_ST() do { _Pragma("unroll") for (int g4 = 0; g4 < 4; ++g4) { const int k0 = 32 * kt + 8 * g4 + 4 * hh; \
        *(LAS u64*)(STt + (32 * vt0 + r32) * 136 + k0) = (u64)pk2(S0[4 * g4], S0[4 * g4 + 1]) | ((u64)pk2(S0[4 * g4 + 2], S0[4 * g4 + 3]) << 32); \
        *(LAS u64*)(STt + (32 * (vt0 + 1) + r32) * 136 + k0) = (u64)pk2(S1[4 * g4], S1[4 * g4 + 1]) | ((u64)pk2(S1[4 * g4 + 2], S1[4 * g4 + 3]) << 32); } } while (0)
    HG_WRITE_ST();
    v4u zq = {0u, 0u, 0u, 0u}, zf = zq, zi = zq;
    { const int row = (PROMPT ? b * SEQ + (g * HG_GS) * 32 : MP + 4 * b) + te;
      if (te < nvalid) { const bf16* zr = Z + (size_t)row * ZC0 + h * 128 + k8; zq = *(const v4u*)zr; zf = *(const v4u*)(zr + 768); zi = *(const v4u*)(zr + 1536); } }
#pragma unroll 1
    for (int ch = 0; ch < nch; ++ch) {
        const int row0 = PROMPT ? b * SEQ + (g * HG_GS + ch) * 32 : MP + 4 * b, row = row0 + te;
        const bool valid = te < nvalid;
        float qs[8], kk[8];
        {
            const unsigned qw[4] = {zq.x, zq.y, zq.z, zq.w}, fw[4] = {zf.x, zf.y, zf.z, zf.w}, iw[4] = {zi.x, zi.y, zi.z, zi.w};
#pragma unroll
            for (int j = 0; j < 8; ++j) { const float q = bf2f((qw[j >> 1] >> (16 * (j & 1))) & 0xffffu), fp = bf2f((fw[j >> 1] >> (16 * (j & 1))) & 0xffffu);
                const float sg = sigmoidf_(fp), f = lbv[j] + (1.0f - lbv[j]) * sg;
                qs[j] = valid ? q * sigmoidf_(q) : 0.f; kk[j] = valid ? (1.0f - f) : 0.f;
                LFt[(k8 + j) * 33 + te] = valid ? __logf(f) : 0.f;
                VT[(k8 + j) * 40 + te] = (bf16)((iw[j >> 1] >> (16 * (j & 1))) & 0xffffu); }
            if (PROMPT && ch + 1 < nch) { const bf16* zr = Z + (size_t)(row + 32) * ZC0 + h * 128 + k8; zq = *(const v4u*)zr; zf = *(const v4u*)(zr + 768); zi = *(const v4u*)(zr + 1536); }
        }
        __syncthreads();
        {
            const int k = tid & 127, sg_ = tid >> 7; float bsum = 0.f;
#pragma unroll
            for (int i = 0; i < 8; ++i) { bsum += LFt[k * 33 + 8 * sg_ + i]; LFt[k * 33 + 8 * sg_ + i] = bsum; }
            SEG[sg_ * 128 + k] = bsum; }
        __syncthreads();
        {
            float bb[8], bl[8];
            { f32x4 t0[4], t1[4];
#pragma unroll
              for (int s_ = 0; s_ < 4; ++s_) { t0[s_] = *(const LAS f32x4*)(SEG + s_ * 128 + k8); t1[s_] = *(const LAS f32x4*)(SEG + s_ * 128 + k8 + 4); }
              const int sgt = te >> 3; f32x4 o0 = {0.f, 0.f, 0.f, 0.f}, o1 = o0;
#pragma unroll
              for (int s_ = 0; s_ < 3; ++s_) if (s_ < sgt) { o0 += t0[s_]; o1 += t1[s_]; }
              const f32x4 l0 = (t0[0] + t0[1]) + (t0[2] + t0[3]), l1 = (t1[0] + t1[1]) + (t1[2] + t1[3]);
              const float of[8] = {o0.x, o0.y, o0.z, o0.w, o1.x, o1.y, o1.z, o1.w}; const float lt[8] = {l0.x, l0.y, l0.z, l0.w, l1.x, l1.y, l1.z, l1.w};
#pragma unroll
              for (int j = 0; j < 8; ++j) { bb[j] = LFt[(k8 + j) * 33 + te] + of[j]; bl[j] = lt[j]; } }
            float qd[8], kd[8];
#pragma unroll
            for (int j = 0; j < 8; ++j) { qd[j] = qs[j] * __expf(bb[j]); kd[j] = kk[j] * __expf(-bb[j]); KET[(k8 + j) * 40 + te] = (bf16)f2bf(kk[j] * __expf(bl[j] - bb[j])); }
            v4u o; o.x = pk2(qd[0], qd[1]); o.y = pk2(qd[2], qd[3]); o.z = pk2(qd[4], qd[5]); o.w = pk2(qd[6], qd[7]); *(LAS v4u*)(QD + te * 136 + k8) = o;
            if (PROMPT) { const f32x4 f0 = *(const LAS f32x4*)(BOFF + k8), f1 = *(const LAS f32x4*)(BOFF + k8 + 4);
                const float bo[8] = {f0.x, f0.y, f0.z, f0.w, f1.x, f1.y, f1.z, f1.w}; float qc[8];
#pragma unroll
                for (int j = 0; j < 8; ++j) qc[j] = qd[j] * __expf(bo[j]);
                v4u oc; oc.x = pk2(qc[0], qc[1]); oc.y = pk2(qc[2], qc[3]); oc.z = pk2(qc[4], qc[5]); oc.w = pk2(qc[6], qc[7]);
                *(v4u*)((bf16*)(a.ws + WS_HQC) + (size_t)row * 768 + h * 128 + k8) = oc; }
            o.x = pk2(kd[0], kd[1]); o.y = pk2(kd[2], kd[3]); o.z = pk2(kd[4], kd[5]); o.w = pk2(kd[6], kd[7]); *(LAS v4u*)(KD + te * 136 + k8) = o;
            if (te == 0) {
#pragma unroll
                for (int j = 0; j < 8; ++j) DVv[k8 + j] = __expf(bl[j]); }
        }
        __syncthreads();
        f32x16 oacc = {};
        if (w == 4) { f32x16 z = {}; const f32x16 sc = mm32<128>(QD, 136, KD, 136, z, lane);
#pragma unroll
            for (int r = 0; r < 16; ++r) { const int t = crow(r, hh); SCB[t * 40 + r32] = (bf16)f2bf(r32 <= t ? sc[r] : 0.f); } }
        if (w < 4) oacc = mm32<128>(QD, 136, STt + (w * 32) * 136, 136, oacc, lane);
        if (PROMPT && tid >= 384) { const int k = tid - 384; BOFF[k] += (SEG[k] + SEG[128 + k]) + (SEG[256 + k] + SEG[384 + k]); }
        __syncthreads();
        if (w < 4) { oacc = mm32<32>(SCB, 40, VT + (w * 32) * 40, 40, oacc, lane);
#pragma unroll
            for (int r = 0; r < 16; ++r) OB[crow(r, hh) * 128 + w * 32 + r32] = oacc[r]; }
        {
#pragma unroll
            for (int r = 0; r < 16; ++r) { const float d = DVv[32 * kt + crow(r, hh)]; S0[r] *= d; S1[r] *= d; }
            S0 = mm32<32>(KET + (kt * 32) * 40, 40, VT + (vt0 * 32) * 40, 40, S0, lane);
            S1 = mm32<32>(KET + (kt * 32) * 40, 40, VT + ((vt0 + 1) * 32) * 40, 40, S1, lane);
        }
        __syncthreads();
        HG_WRITE_ST();
        {
            const int orow = row0 + tf;
            const f32x4 o0 = *(const LAS f32x4*)(OB + tf * 128 + v8), o1 = *(const LAS f32x4*)(OB + tf * 128 + v8 + 4);
            if (PROMPT) { float* ol = (float*)(a.ws + WS_HOL) + (size_t)orow * 768 + h * 128 + v8; *(f32x4*)ol = o0; *(f32x4*)(ol + 4) = o1; }
            else {
                float ov[8] = {o0.x, o0.y, o0.z, o0.w, o1.x, o1.y, o1.z, o1.w}; float s = 0.f;
#pragma unroll
                for (int j = 0; j < 8; ++j) s += ov[j] * ov[j];
                s += __shfl_xor(s, 1); s += __shfl_xor(s, 2); s += __shfl_xor(s, 4); s += __shfl_xor(s, 8);
                const float rs = rsqrtf(s * (1.0f / 128.0f) + EPS);
                if (tf < nvalid) { const v4u gz = *(const v4u*)(Z + (size_t)orow * ZC0 + 2304 + h * 128 + v8); const unsigned gw_[4] = {gz.x, gz.y, gz.z, gz.w}; float y[8];
#pragma unroll
                    for (int j = 0; j < 8; ++j) { const float gg = bf2f((gw_[j >> 1] >> (16 * (j & 1))) & 0xffffu); y[j] = ov[j] * rs * a.in[15][v8 + j] * (gg * sigmoidf_(gg)); }
                    v4u o; o.x = pk2(y[0], y[1]); o.y = pk2(y[2], y[3]); o.z = pk2(y[4], y[5]); o.w = pk2(y[6], y[7]); *(v4u*)(MIX + (size_t)orow * DM + h * 128 + v8) = o; }
            }
        }
        __syncthreads();
    }
#undef HG_WRITE_ST
    if (PROMPT) {
        float* ut = (float*)(a.ws + WS_HUT) + (size_t)unit * 16384;
#pragma unroll
        for (int g4 = 0; g4 < 4; ++g4) { const int k0 = 32 * kt + 8 * g4 + 4 * hh;
            *(f32x4*)(ut + (32 * vt0 + r32) * 128 + k0) = (f32x4){S0[4 * g4], S0[4 * g4 + 1], S0[4 * g4 + 2], S0[4 * g4 + 3]};
            *(f32x4*)(ut + (32 * (vt0 + 1) + r32) * 128 + k0) = (f32x4){S1[4 * g4], S1[4 * g4 + 1], S1[4 * g4 + 2], S1[4 * g4 + 3]}; }
        if (tid < 128) ((float*)(a.ws + WS_HDG))[(size_t)unit * 128 + tid] = __expf(BOFF[tid]);
    } else {
        float* so = a.out + O_HS + (size_t)(b * 6 + h) * 16384;
#pragma unroll
        for (int r = 0; r < 16; ++r) { const int k = 32 * kt + crow(r, hh); so[k * 128 + 32 * vt0 + r32] = S0[r]; so[k * 128 + 32 * (vt0 + 1) + r32] = S1[r]; }
    }
}
__device__ __forceinline__ void hgrn_scan(Ctx& c, ARGREF a) {
    const float* UT = (const float*)(a.ws + WS_HUT); const float* DG = (const float*)(a.ws + WS_HDG); bf16* STo = (bf16*)(a.ws + WS_HST);
    for (int idx = c.vcu * 512 + c.tid; idx < 24 * 16384; idx += c.G * 512) {
        const int bh = idx >> 14, e = idx & 16383, k = e & 127, v = e >> 7;
        float s = 0.f, ut[HG_NG], dg[HG_NG];
#pragma unroll
        for (int g = 0; g < HG_NG; ++g) { const size_t u = (size_t)(bh * HG_NG + g); ut[g] = UT[u * 16384 + e]; dg[g] = DG[u * 128 + k]; }
#pragma unroll
        for (int g = 0; g < HG_NG; ++g) { const size_t u = (size_t)(bh * HG_NG + g); STo[u * 16384 + e] = (bf16)f2bf(s); s = dg[g] * s + ut[g]; }
        a.out[O_HP + (size_t)bh * 16384 + k * 128 + v] = s;
    }
}
__device__ __forceinline__ void hgrn_fix_unit(Ctx& c, ARGREF a, int b, int h, int g) {
    LAS bf16* STt = (LAS bf16*)(c.lds);
    LAS bf16* QCl = (LAS bf16*)(c.lds + 34816);
    LAS float* OB = (LAS float*)(c.lds + 34816 + 17408);
    int tid = c.tid; asm volatile("" : "+v"(tid));
    const int lane = tid & 63, w = c.wave, r32 = lane & 31, hh = lane >> 5;
    const int unit = (b * 6 + h) * HG_NG + g, row0 = b * SEQ + g * 128;
    const bf16* Z = (const bf16*)(a.ws + WS_Z); bf16* MIX = (bf16*)(a.ws + WS_MIX);
    const bf16* QC = (const bf16*)(a.ws + WS_HQC); const float* OL = (const float*)(a.ws + WS_HOL);
    const bf16* stg = (const bf16*)(a.ws + WS_HST) + (size_t)unit * 16384;
    __syncthreads();
#pragma unroll
    for (int i = 0; i < 4; ++i) { const int cidx = tid + 512 * i, v = cidx >> 4, kc = (cidx & 15) * 8; *(LAS v4u*)(STt + v * 136 + kc) = *(const v4u*)(stg + v * 128 + kc); }
    const int te = tid >> 4, k8 = (tid & 15) * 8;
    float onv[8];
#pragma unroll
    for (int j = 0; j < 8; ++j) onv[j] = a.in[15][k8 + j];
#pragma unroll 1
    for (int hf = 0; hf < 2; ++hf) {
        const int rb = row0 + hf * 64;
#pragma unroll
        for (int i = 0; i < 2; ++i) { const int cidx = tid + 512 * i, r = cidx >> 4, kc = (cidx & 15) * 8; *(LAS v4u*)(QCl + r * 136 + kc) = *(const v4u*)(QC + (size_t)(rb + r) * 768 + h * 128 + kc); }
        f32x4 pl0[2], pl1[2]; v4u pgz[2];
#pragma unroll
        for (int ps = 0; ps < 2; ++ps) { const int row = rb + ps * 32 + te; const float* ol = OL + (size_t)row * 768 + h * 128 + k8; pl0[ps] = *(const f32x4*)ol; pl1[ps] = *(const f32x4*)(ol + 4);
            pgz[ps] = *(const v4u*)(Z + (size_t)row * ZC0 + 2304 + h * 128 + k8); }
        __syncthreads();
        { const int rt = w >> 2, vt = w & 3; f32x16 o = {};
          o = mm32<128>(QCl + (rt * 32) * 136, 136, STt + (vt * 32) * 136, 136, o, lane);
#pragma unroll
          for (int r = 0; r < 16; ++r) OB[(rt * 32 + crow(r, hh)) * 128 + vt * 32 + r32] = o[r]; }
        __syncthreads();
#pragma unroll
        for (int ps = 0; ps < 2; ++ps) { const int r = ps * 32 + te, row = rb + r;
            const f32x4 c0 = *(const LAS f32x4*)(OB + r * 128 + k8), c1 = *(const LAS f32x4*)(OB + r * 128 + k8 + 4);
            const f32x4 l0 = pl0[ps], l1 = pl1[ps]; const v4u gz = pgz[ps];
            float ov[8] = {c0.x + l0.x, c0.y + l0.y, c0.z + l0.z, c0.w + l0.w, c1.x + l1.x, c1.y + l1.y, c1.z + l1.z, c1.w + l1.w}; float s = 0.f;
#pragma unroll
            for (int j = 0; j < 8; ++j) s += ov[j] * ov[j];
            s += __shfl_xor(s, 1); s += __shfl_xor(s, 2); s += __shfl_xor(s, 4); s += __shfl_xor(s, 8);
            const float rs = rsqrtf(s * (1.0f / 128.0f) + EPS);
            const unsigned gw_[4] = {gz.x, gz.y, gz.z, gz.w}; float y[8];
#pragma unroll
            for (int j = 0; j < 8; ++j) { const float gg = bf2f((gw_[j >> 1] >> (16 * (j & 1))) & 0xffffu); y[j] = ov[j] * rs * onv[j] * (gg * sigmoidf_(gg)); }
            v4u o; o.x = pk2(y[0], y[1]); o.y = pk2(y[2], y[3]); o.z = pk2(y[4], y[5]); o.w = pk2(y[6], y[7]); *(v4u*)(MIX + (size_t)row * DM + h * 128 + k8) = o; }
        __syncthreads();
    }
}

__device__ __forceinline__ void memkv_finalize_row(ARGREF a, int layer, int row, int lane) {
    const float* src = (const float*)(a.ws + WS_MEMKV) + (size_t)row * 1024 + layer * 512;
    const int hd = lane >> 4, d4 = (lane & 15) * 4;
    const f32x4 k = *(const f32x4*)(src + hd * 64 + d4), v = *(const f32x4*)(src + 256 + hd * 64 + d4);
    float s = (k.x * k.x + k.y * k.y) + (k.z * k.z + k.w * k.w);
    s += __shfl_xor(s, 1); s += __shfl_xor(s, 2); s += __shfl_xor(s, 4); s += __shfl_xor(s, 8);
    const float rs = rsqrtf(s * (1.0f / 64.0f) + EPS); const f32x4 g = *(const f32x4*)(a.in[22] + layer * 64 + d4);
    *(f32x4*)(a.out + O_MK + ((size_t)layer * 1024 + row) * 256 + hd * 64 + d4) = k * rs * g;
    *(f32x4*)(a.out + O_MV + ((size_t)layer * 1024 + row) * 256 + hd * 64 + d4) = v;
}

__device__ __forceinline__ void memattn_prompt_unit(Ctx& c, ARGREF a, int layer, int u) {
    const int blk = u & 15, hd = (u >> 4) & 3, b = u >> 6;
    const bf16* Z = (const bf16*)(a.ws + WS_Z); const int ldz = layer ? ZC1 : ZC0, qc = layer ? Z1_MQ : 3072;
    const float* kv = (const float*)(a.ws + WS_MEMKV) + (size_t)(b * 256) * 1024 + layer * 512 + hd * 64;
    const int row0 = b * SEQ + blk * 256;
    memattn_unit(c, Z + (size_t)row0 * ldz + qc + hd * 64, ldz, 256, kv, kv + 256, 1024, true, a.in[22] + layer * 64, a.in[21] + layer * 64,
                 (bf16*)(a.ws + WS_MIX) + (size_t)row0 * DM + 768 + hd * 64);
}
__device__ __forceinline__ void memattn_sample_unit(Ctx& c, ARGREF a, int layer, int u) {
    const int hd = u & 3, sb = u >> 2;
    const bf16* Z = (const bf16*)(a.ws + WS_Z); const int ldz = layer ? ZC1 : ZC0, qc = layer ? Z1_MQ : 3072;
    const size_t off = ((size_t)(layer * 32 + sb) * 256) * 256 + hd * 64;
    const int row0 = MP + sb * 4;
    memattn_unit(c, Z + (size_t)row0 * ldz + qc + hd * 64, ldz, 4, a.in[5] + off, a.in[6] + off, 256, false, nullptr, a.in[21] + layer * 64,
                 (bf16*)(a.ws + WS_MIX) + (size_t)row0 * DM + 768 + hd * 64);
}

__device__ __forceinline__ void p2_mixer0(Ctx& c, ARGREF a) {
    constexpr int U_HP = 24 * HG_NG, U_MAP = U_HP + 256, U_HS = U_MAP + 192, U_MAS = U_HS + 128, U_FIN = U_MAS + 256;
    for (;;) {
        const int u = q_next(c, 0);
        if (u >= U_FIN) break;
        if (u < U_HP) hgrn_unit<true>(c, a, u / (6 * HG_NG), (u / HG_NG) % 6, u % HG_NG);
        else if (u < U_MAP) memattn_prompt_unit(c, a, 0, u - U_HP);
        else if (u < U_HS) { const int v = u - U_MAP; hgrn_unit<false>(c, a, v / 6, v % 6, 0); }
        else if (u < U_MAS) memattn_sample_unit(c, a, 0, u - U_HS);
        else { const int v = (u - U_MAS) * 8 + c.wave; memkv_finalize_row(a, v >> 10, v & 1023, c.lane); }
    }
}
__device__ __forceinline__ void p2c_hgrn_fix(Ctx& c, ARGREF a) {
    for (int u = c.vcu; u < 24 * HG_NG; u += c.G) hgrn_fix_unit(c, a, u / (6 * HG_NG), (u / HG_NG) % 6, u % HG_NG);
}

constexpr size_t WS_G4 = WS_UP + 64 * MiB, WS_UP2 = WS_UP + 80 * MiB;
__device__ __forceinline__ void conv_fixup_tile(Ctx& c, ARGREF a, int layer, int pm) {
    const float* G4 = (const float*)(a.ws + WS_G4); const float* UP2 = (const float*)(a.ws + WS_UP2); bf16* ACT = (bf16*)(a.ws + WS_ACT);
    const float* cw = a.in[26] + (size_t)layer * 3 * DFF; const float* cb = a.in[27] + (size_t)layer * DFF;
    for (int idx = c.tid; idx < 8 * (DFF / 4); idx += 512) {
        const int rr = idx / (DFF / 4), c4 = (idx - rr * (DFF / 4)) * 4;
        const int slab = 4 * pm + (rr >> 1), fr = rr & 1, row = slab * 64 + fr, t = row & 4095, sl1 = slab > 0 ? slab - 1 : 0;
        const f32x4 ut = *(const f32x4*)(G4 + (size_t)(slab * 4 + fr) * DFF + c4), up = *(const f32x4*)(UP2 + (size_t)(slab * 2 + fr) * DFF + c4);
        const f32x4 a0 = *(const f32x4*)(G4 + (size_t)(slab * 4 + 0) * DFF + c4), b3 = *(const f32x4*)(G4 + (size_t)(sl1 * 4 + 3) * DFF + c4), b2 = *(const f32x4*)(G4 + (size_t)(sl1 * 4 + 2) * DFF + c4);
        f32x4 u1, u2;
        { const bool f1 = fr == 1, t0 = t == 0, t1 = t == 1;
          u1.x = f1 ? a0.x : (t0 ? 0.f : b3.x); u1.y = f1 ? a0.y : (t0 ? 0.f : b3.y); u1.z = f1 ? a0.z : (t0 ? 0.f : b3.z); u1.w = f1 ? a0.w : (t0 ? 0.f : b3.w);
          u2.x = f1 ? (t1 ? 0.f : b3.x) : (t0 ? 0.f : b2.x); u2.y = f1 ? (t1 ? 0.f : b3.y) : (t0 ? 0.f : b2.y); u2.z = f1 ? (t1 ? 0.f : b3.z) : (t0 ? 0.f : b2.z); u2.w = f1 ? (t1 ? 0.f : b3.w) : (t0 ? 0.f : b2.w); }
        const f32x4 w0 = *(const f32x4*)(cw + c4), w1 = *(const f32x4*)(cw + DFF + c4), w2 = *(const f32x4*)(cw + 2 * DFF + c4), bb = *(const f32x4*)(cb + c4);
        const f32x4 cv = bb + w0 * u2 + w1 * u1 + w2 * ut;
        const float y0 = cv.x * sigmoidf_(cv.x) * up.x, y1 = cv.y * sigmoidf_(cv.y) * up.y, y2 = cv.z * sigmoidf_(cv.z) * up.z, y3 = cv.w * sigmoidf_(cv.w) * up.w;
        *(u64*)(ACT + (size_t)row * DFF + c4) = (u64)pk2(y0, y1) | ((u64)pk2(y2, y3) << 32);
    }
}


struct SgArgs { const bf16* A; const bf16* Bt; int K; int mode; bf16* Z; int ldz; const float* ssin; const float* resid; const bf16* rb; float* y; bf16* xb; float* ssout; bf16* ACT; float* cvs; const float* cst; const float* cw; const float* cb; };
__device__ __forceinline__ void sgemm_unit(Ctx& c, const SgArgs& g, int n0) {
    int tid = c.tid; asm volatile("" : "+v"(tid));
    const int lane = tid & 63, w = c.wave, r32 = lane & 31, hh = lane >> 5;
    const int K = g.K, ks = K >> 3;
    const int f2 = (n0 >> 1) + (r32 & 15), brow = g.mode == 2 ? (f2 >> 7) * 256 + (f2 & 127) + (r32 >= 16 ? 128 : 0) : n0 + r32;
    const bf16* bp = g.Bt + (size_t)brow * K + w * ks + 8 * hh;
    const bf16* ap = g.A + (size_t)r32 * K + w * ks + 8 * hh;
    f32x16 acc[4] = {};
    bf16x8 afA[4][2], bfA[2], afB[4][2], bfB[2];
#define SG_LOAD(AF, BF, kk) do { _Pragma("unroll") for (int i = 0; i < 2; ++i) { BF[i] = *(const bf16x8*)(bp + (kk) + 16 * i); \
        _Pragma("unroll") for (int rt = 0; rt < 4; ++rt) AF[rt][i] = *(const bf16x8*)(ap + (size_t)(rt * 32) * K + (kk) + 16 * i); } } while (0)
#define SG_MMA(AF, BF) do { _Pragma("unroll") for (int i = 0; i < 2; ++i) _Pragma("unroll") for (int rt = 0; rt < 4; ++rt) acc[rt] = __builtin_amdgcn_mfma_f32_32x32x16_bf16(AF[rt][i], BF[i], acc[rt], 0, 0, 0); } while (0)
    SG_LOAD(afA, bfA, 0);
#pragma unroll 1
    for (int k = 0; k < ks; k += 64) {
        if (k + 32 < ks) SG_LOAD(afB, bfB, k + 32);
        SG_MMA(afA, bfA);
        if (k + 32 < ks) { if (k + 64 < ks) SG_LOAD(afA, bfA, k + 64); SG_MMA(afB, bfB); }
    }
#undef SG_LOAD
#undef SG_MMA
    LAS float* RED = (LAS float*)(c.lds);
    __syncthreads();
#pragma unroll
    for (int rt = 0; rt < 4; ++rt)
#pragma unroll
        for (int r = 0; r < 16; ++r) RED[((w * 4 + rt) * 16 + r) * 64 + lane] = acc[rt][r];
    __syncthreads();
    const int rt = w & 3, rh = w >> 2, col = n0 + r32;
    float v[8];
#pragma unroll
    for (int i = 0; i < 8; ++i) { float s = 0.f;
#pragma unroll
        for (int ww = 0; ww < 8; ++ww) s += RED[((ww * 4 + rt) * 16 + 8 * rh + i) * 64 + lane];
        v[i] = s; }
    if (g.mode == 0) {
#pragma unroll
        for (int i = 0; i < 8; ++i) { const int row = MP + rt * 32 + crow(8 * rh + i, hh); const float rs = rsqrtf(g.ssin[row] * (1.0f / DM) + EPS); g.Z[(size_t)row * g.ldz + col] = (bf16)f2bf(v[i] * rs); }
    } else if (g.mode == 1) {
#pragma unroll
        for (int i = 0; i < 8; ++i) { const int lr = rt * 32 + crow(8 * rh + i, hh), row = MP + lr;
            const float x = v[i] + (g.resid ? g.resid[(size_t)lr * DM + col] : bf2f(g.rb[(size_t)row * DM + col]));
            if (g.y) g.y[(size_t)lr * DM + col] = x; if (g.xb) g.xb[(size_t)row * DM + col] = (bf16)f2bf(x);
            float s = x * x; s += __shfl_xor(s, 1); s += __shfl_xor(s, 2); s += __shfl_xor(s, 4); s += __shfl_xor(s, 8); s += __shfl_xor(s, 16);
            if (g.ssout && r32 == 0) atomicAdd(g.ssout + row, s); }
    } else {
        float gu[8], upv[8];
#pragma unroll
        for (int i = 0; i < 8; ++i) { const int row = MP + rt * 32 + crow(8 * rh + i, hh); gu[i] = v[i] * rsqrtf(g.ssin[row] * (1.0f / DM) + EPS); upv[i] = __shfl_xor(gu[i], 16); }
        if (r32 < 16) { const float w0 = g.cw[f2], w1 = g.cw[DFF + f2], w2 = g.cw[2 * DFF + f2], bb = g.cb[f2];
#pragma unroll
            for (int aa = 0; aa < 2; ++aa) { const int lr0 = rt * 32 + 8 * (2 * rh + aa) + 4 * hh, sb = lr0 >> 2;
                const float s0 = g.cst[(size_t)(sb * 2) * DFF + f2], s1 = g.cst[(size_t)(sb * 2 + 1) * DFF + f2];
                const float u0 = gu[4 * aa], u1 = gu[4 * aa + 1], u2 = gu[4 * aa + 2], u3 = gu[4 * aa + 3];
                const float cv[4] = {bb + w0 * s0 + w1 * s1 + w2 * u0, bb + w0 * s1 + w1 * u0 + w2 * u1, bb + w0 * u0 + w1 * u1 + w2 * u2, bb + w0 * u1 + w1 * u2 + w2 * u3};
#pragma unroll
                for (int t = 0; t < 4; ++t) g.ACT[(size_t)(MP + lr0 + t) * DFF + f2] = (bf16)f2bf(cv[t] * sigmoidf_(cv[t]) * upv[4 * aa + t]);
                g.cvs[(size_t)(sb * 2) * DFF + f2] = u2; g.cvs[(size_t)(sb * 2 + 1) * DFF + f2] = u3; } }
    }
}
__device__ __forceinline__ void sgemm_phase(Ctx& c, const SgArgs& g, int N) {
#pragma unroll 1
    for (int u = c.G - 1 - (int)blockIdx.x; u < N / 32; u += c.G) sgemm_unit(c, g, u * 32);
}


__device__ __forceinline__ float wave_sum_f(float x) {
    x += __builtin_bit_cast(float, __builtin_amdgcn_update_dpp(0, __builtin_bit_cast(int, x), 0xB1, 0xF, 0xF, false));
    x += __builtin_bit_cast(float, __builtin_amdgcn_update_dpp(0, __builtin_bit_cast(int, x), 0x4E, 0xF, 0xF, false));
    x += __builtin_bit_cast(float, __builtin_amdgcn_update_dpp(0, __builtin_bit_cast(int, x), 0x141, 0xF, 0xF, false));
    x += __builtin_bit_cast(float, __builtin_amdgcn_update_dpp(0, __builtin_bit_cast(int, x), 0x140, 0xF, 0xF, false));
    const int xi = __builtin_bit_cast(int, x);
    return (__builtin_bit_cast(float, __builtin_amdgcn_readlane(xi, 0)) + __builtin_bit_cast(float, __builtin_amdgcn_readlane(xi, 16))) +
           (__builtin_bit_cast(float, __builtin_amdgcn_readlane(xi, 32)) + __builtin_bit_cast(float, __builtin_amdgcn_readlane(xi, 48)));
}
__device__ __forceinline__ void dsa_post_row(ARGREF a, int row, int lane_) {
    int lane = lane_; asm volatile("" : "+v"(lane));
    const bf16* z = (const bf16*)(a.ws + WS_Z) + (size_t)row * ZC1;
    const bool smp = row >= MP; const int b = smp ? (row - MP) >> 2 : row >> 12, t = smp ? (row - MP) & 3 : row & 4095;
    const float pos = (float)(smp ? PAST + t : t);
    const int i = lane & 31;
    float x1[8], x2[8], q1[4], q2[4], k1 = 0.f, k2 = 0.f;
#pragma unroll
    for (int hd = 0; hd < 8; ++hd) { x1[hd] = bf2f(z[hd * 128 + lane]); x2[hd] = bf2f(z[hd * 128 + 64 + lane]); }
    const u64 vv = *(const u64*)(z + Z1_V + 4 * lane);
#pragma unroll
    for (int p = 0; p < 4; ++p) { const int hd = 2 * p + (lane >> 5); q1[p] = bf2f(z[Z1_IQ + hd * 64 + i]); q2[p] = bf2f(z[Z1_IQ + hd * 64 + 32 + i]); }
    if (lane < 32) { k1 = bf2f(z[Z1_IK + i]); k2 = bf2f(z[Z1_IK + 32 + i]); }
    const float wraw = bf2f(z[Z1_IW + (lane & 7)]);
    float c128, s128, c64, s64;
    { const float r1 = pos * (exp2f(-(float)lane * (13.287712379549449f / 64.0f)) * 0.15915494309189535f), f1 = r1 - floorf(r1); s128 = __builtin_amdgcn_sinf(f1); c128 = __builtin_amdgcn_cosf(f1);
      const float r2 = pos * (exp2f(-(float)i * (13.287712379549449f / 32.0f)) * 0.15915494309189535f), f2 = r2 - floorf(r2); s64 = __builtin_amdgcn_sinf(f2); c64 = __builtin_amdgcn_cosf(f2); }
#pragma unroll
    for (int hd = 0; hd < 8; ++hd) {
        const float rs = rsqrtf(wave_sum_f(x1[hd] * x1[hd] + x2[hd] * x2[hd]) * (1.0f / 128.0f) + EPS);
        const float* gn = hd < 6 ? a.in[17] : a.in[18];
        const float y1 = x1[hd] * rs * gn[lane], y2 = x2[hd] * rs * gn[64 + lane];
        const float o1 = y1 * c128 - y2 * s128, o2 = y2 * c128 + y1 * s128;
        if (hd < 6) {
            if (smp) { float* q = (float*)(a.ws + WS_SQ) + (size_t)(row - MP) * 768 + hd * 128; q[lane] = o1; q[64 + lane] = o2; }
            else { bf16* q = (bf16*)(a.ws + WS_QB) + ((size_t)(b * 6 + hd) * SEQ + t) * 128; q[lane] = (bf16)f2bf(o1); q[64 + lane] = (bf16)f2bf(o2); }
        } else {
            const int kvh = hd - 6;
            float* ko = smp ? a.out + O_KS + (size_t)(row - MP) * 256 + kvh * 128 : a.out + O_KP + (size_t)row * 256 + kvh * 128;
            ko[lane] = o1; ko[64 + lane] = o2;
            if (!smp) { bf16* kb = (bf16*)(a.ws + WS_KB) + ((size_t)(b * 2 + kvh) * SEQ + t) * 128; kb[lane] = (bf16)f2bf(o1); kb[64 + lane] = (bf16)f2bf(o2); }
        }
    }
    {
        const f32x4 v = {bf2f((unsigned)vv & 0xffffu), bf2f(((unsigned)vv) >> 16), bf2f((unsigned)(vv >> 32) & 0xffffu), bf2f((unsigned)(vv >> 48))};
        float* vo = smp ? a.out + O_VS + (size_t)(row - MP) * 256 : a.out + O_VP + (size_t)row * 256;
        *(f32x4*)(vo + 4 * lane) = v;
        if (!smp) { const int kvh = lane >> 5, d = (lane & 31) * 4; *(u64*)((bf16*)(a.ws + WS_VB) + ((size_t)(b * 2 + kvh) * SEQ + t) * 128 + d) = vv; }
    }
    {
#pragma unroll
        for (int p = 0; p < 4; ++p) { const int hd = 2 * p + (lane >> 5);
            const float o1 = q1[p] * c64 - q2[p] * s64, o2 = q2[p] * c64 + q1[p] * s64;
            if (smp) { float* q = (float*)(a.ws + WS_SIQ) + (size_t)(row - MP) * 512 + hd * 64; q[i] = o1; q[32 + i] = o2; }
            else { bf16* q = (bf16*)(a.ws + WS_IQB) + (size_t)row * 512 + hd * 64; q[i] = (bf16)f2bf(o1); q[32 + i] = (bf16)f2bf(o2); } }
        const float rs = rsqrtf(wave_sum_f(k1 * k1 + k2 * k2) * (1.0f / 64.0f) + EPS);
        const float y1 = k1 * rs * a.in[19][i], y2 = k2 * rs * a.in[19][32 + i];
        const float o1 = y1 * c64 - y2 * s64, o2 = y2 * c64 + y1 * s64;
        if (lane < 32) {
            float* ko = smp ? a.out + O_IKS + (size_t)(row - MP) * 64 : a.out + O_IKP + (size_t)row * 64; ko[i] = o1; ko[32 + i] = o2;
            if (!smp) { bf16* kb = (bf16*)(a.ws + WS_IKB) + (size_t)row * 64; kb[i] = (bf16)f2bf(o1); kb[32 + i] = (bf16)f2bf(o2); } }
        if (lane < 8) { const float wv = wraw * (0.35355339059327373f * 0.125f);
            if (smp) ((float*)(a.ws + WS_SIW))[(row - MP) * 8 + lane] = wv; else ((float*)(a.ws + WS_IW))[(size_t)row * 8 + lane] = wv; }
    }
}
__device__ __forceinline__ void p8_dsa_post(Ctx& c, ARGREF a) {
    constexpr int NRB = (MVALID + 63) / 64;
    for (;;) { const int u = q_next(c, 1); if (u >= 384 + NRB) break;
        if (u < 256) memattn_prompt_unit(c, a, 1, u);
        else if (u < 256 + NRB) { const int r0 = (u - 256) * 64 + c.wave;
#pragma unroll 1
            for (int i = 0; i < 8; ++i) { const int row = r0 + 8 * i; if (row < MVALID) dsa_post_row(a, row, c.lane); } }
        else memattn_sample_unit(c, a, 1, u - 256 - NRB); }
}

__device__ __forceinline__ void idx_prompt_unit(Ctx& c, ARGREF a, int b, int qb) {
    int tid = c.tid; asm volatile("" : "+v"(tid));
    const int lane = tid & 63, r32 = lane & 31, hh = lane >> 5, w = c.wave;
    const int q0 = b * SEQ + qb * 32;
    LAS bf16* IQL = (LAS bf16*)(c.lds);
    { const bf16* src = (const bf16*)(a.ws + WS_IQB) + (size_t)q0 * 512;
#pragma unroll
      for (int i = 0; i < 4; ++i) { const int row = tid >> 4, ch = (tid & 15) + 16 * i; *(LAS v4u*)(IQL + row * 520 + ch * 8) = *(const v4u*)(src + (size_t)row * 512 + ch * 8); } }
    __syncthreads();
    const bf16* IK = (const bf16*)(a.ws + WS_IKB) + (size_t)(b * SEQ) * 64 + (size_t)r32 * 64 + 8 * hh;
    float* SC = (float*)(a.ws + WS_SC) + (size_t)(q0 + r32) * SEQ;
    float wv[8];
#pragma unroll
    for (int h = 0; h < 8; ++h) wv[h] = ((const float*)(a.ws + WS_IW))[(size_t)(q0 + r32) * 8 + h];
    bf16x8 ak[4], an[4];
    if (w <= qb) {
#pragma unroll
        for (int ks = 0; ks < 4; ++ks) ak[ks] = *(const bf16x8*)(IK + (size_t)(w * 32) * 64 + ks * 16); }
#pragma unroll 1
    for (int kt = w; kt <= qb; kt += 8) {
        if (kt + 8 <= qb) {
#pragma unroll
            for (int ks = 0; ks < 4; ++ks) an[ks] = *(const bf16x8*)(IK + (size_t)((kt + 8) * 32) * 64 + ks * 16); }
        f32x16 sc = {};
        int qoff = r32 * 520 + 8 * hh; asm volatile("" : "+v"(qoff));
#pragma unroll
        for (int h = 0; h < 8; ++h) { f32x16 d = {};
#pragma unroll
            for (int ks = 0; ks < 4; ++ks) d = __builtin_amdgcn_mfma_f32_32x32x16_bf16(ak[ks], *(const LAS bf16x8*)(IQL + qoff + h * 64 + ks * 16), d, 0, 0, 0);
#pragma unroll
            for (int r = 0; r < 16; ++r) sc[r] = fmaf(wv[h], fmaxf(d[r], 0.f), sc[r]); }
#pragma unroll
        for (int g = 0; g < 4; ++g) *(f32x4*)(SC + kt * 32 + 8 * g + 4 * hh) = (f32x4){sc[4 * g], sc[4 * g + 1], sc[4 * g + 2], sc[4 * g + 3]};
#pragma unroll
        for (int ks = 0; ks < 4; ++ks) ak[ks] = an[ks];
    }
}
__device__ __forceinline__ v4u pack8f(const float* p) { const f32x4 x = *(const f32x4*)p, y = *(const f32x4*)(p + 4); v4u o; o.x = pk2(x.x, x.y); o.y = pk2(x.z, x.w); o.z = pk2(y.x, y.y); o.w = pk2(y.z, y.w); return o; }
__device__ __forceinline__ void idx_sample_tile(ARGREF a, int sb, int tl, int lane_) {
    int lane = lane_; asm volatile("" : "+v"(lane));
    const int r32 = lane & 31, hh = lane >> 5, tk = r32 >> 3, hd = r32 & 7;
    const float* iq = (const float*)(a.ws + WS_SIQ) + (size_t)(sb * 4 + tk) * 512 + hd * 64 + 8 * hh;
    const float wv = ((const float*)(a.ws + WS_SIW))[(sb * 4 + tk) * 8 + hd];
    const float* src;
    if (tl < 256) src = a.in[4] + ((size_t)a.page_table[sb * 64 + (tl >> 2)] * 128 + (tl & 3) * 32 + r32) * 64 + 8 * hh;
    else src = a.out + O_IKS + (size_t)(sb * 4 + (r32 & 3)) * 64 + 8 * hh;
    v4u af[4], bf_[4];
#pragma unroll
    for (int ks = 0; ks < 4; ++ks) { af[ks] = pack8f(src + 16 * ks); bf_[ks] = pack8f(iq + 16 * ks); }
    if (tl == 256 && r32 >= 4) {
#pragma unroll
        for (int ks = 0; ks < 4; ++ks) af[ks] = (v4u){0u, 0u, 0u, 0u}; }
    f32x16 d = {};
#pragma unroll
    for (int ks = 0; ks < 4; ++ks) d = __builtin_amdgcn_mfma_f32_32x32x16_bf16(__builtin_bit_cast(bf16x8, af[ks]), __builtin_bit_cast(bf16x8, bf_[ks]), d, 0, 0, 0);
    float* dst = (float*)(a.ws + WS_SSC) + (size_t)(sb * 4 + tk) * SSC_LD + tl * 32;
#pragma unroll
    for (int r = 0; r < 16; ++r) { float v = wv * fmaxf(d[r], 0.f);
        v += __builtin_bit_cast(float, __builtin_amdgcn_update_dpp(0, __builtin_bit_cast(int, v), 0xB1, 0xF, 0xF, false));
        v += __builtin_bit_cast(float, __builtin_amdgcn_update_dpp(0, __builtin_bit_cast(int, v), 0x4E, 0xF, 0xF, false));
        v += __builtin_bit_cast(float, __builtin_amdgcn_update_dpp(0, __builtin_bit_cast(int, v), 0x141, 0xF, 0xF, false));
        if (hd == 0) dst[crow(r, hh)] = v; }
}
__device__ __forceinline__ void p9_indexer(Ctx& c, ARGREF a) {
    const int gw = c.vcu * NWAVES + c.wave, NGW = c.G * NWAVES;
#pragma unroll 1
    for (int wt = gw; wt < 32 * 257; wt += NGW) idx_sample_tile(a, wt / 257, wt % 257, c.lane);
    for (;;) { const int u = q_next(c, 2); if (u >= 512) break; idx_prompt_unit(c, a, u & 3, 127 - (u >> 2)); }
}


__device__ __forceinline__ unsigned fkey(float f) { const unsigned u = __builtin_bit_cast(unsigned, f + 0.0f); return (u & 0x80000000u) ? ~u : (u | 0x80000000u); }
__device__ __forceinline__ void acc_ge(int& cnt, unsigned key, unsigned cand) { asm volatile("v_cmp_le_u32_e32 vcc, %1, %2\n\tv_addc_co_u32_e32 %0, vcc, 0, %0, vcc" : "+v"(cnt) : "s"(cand), "v"(key) : "vcc"); }
__device__ __forceinline__ void acc_ge4(int& c0, int& c1, int& c2, int& c3, unsigned k0, unsigned k1, unsigned k2, unsigned k3, unsigned cand) {
    u64 m0, m1, m2, m3;
    asm volatile("v_cmp_le_u32_e64 %4, %8, %9\n\tv_cmp_le_u32_e64 %5, %8, %10\n\tv_cmp_le_u32_e64 %6, %8, %11\n\tv_cmp_le_u32_e64 %7, %8, %12\n\t"
                 "v_addc_co_u32_e64 %0, %4, 0, %0, %4\n\tv_addc_co_u32_e64 %1, %5, 0, %1, %5\n\tv_addc_co_u32_e64 %2, %6, 0, %2, %6\n\tv_addc_co_u32_e64 %3, %7, 0, %3, %7"
                 : "+v"(c0), "+v"(c1), "+v"(c2), "+v"(c3), "=&s"(m0), "=&s"(m1), "=&s"(m2), "=&s"(m3) : "s"(cand), "v"(k0), "v"(k1), "v"(k2), "v"(k3));
}
__device__ __forceinline__ u64 ballot_nz(unsigned v) { u64 m; asm volatile("v_cmp_ne_u32_e64 %0, 0, %1" : "=s"(m) : "v"(v)); return m; }
__device__ __forceinline__ int wave_sum_dpp(int x) {
    x += __builtin_amdgcn_update_dpp(0, x, 0xB1, 0xF, 0xF, false);
    x += __builtin_amdgcn_update_dpp(0, x, 0x4E, 0xF, 0xF, false);
    x += __builtin_amdgcn_update_dpp(0, x, 0x141, 0xF, 0xF, false);
    x += __builtin_amdgcn_update_dpp(0, x, 0x140, 0xF, 0xF, false);
    return (__builtin_amdgcn_readlane(x, 0) + __builtin_amdgcn_readlane(x, 16)) + (__builtin_amdgcn_readlane(x, 32) + __builtin_amdgcn_readlane(x, 48));
}
__device__ __forceinline__ int mbcnt64(u64 m) { return (int)__builtin_amdgcn_mbcnt_hi((unsigned)(m >> 32), __builtin_amdgcn_mbcnt_lo((unsigned)m, 0u)); }
constexpr int TK_LOWBITS = 18;
__device__ __forceinline__ void topk_finish(unsigned ck, int cp, int A, int posmax, unsigned& T, int& P) {
#pragma unroll 1
    for (int bit = TK_LOWBITS - 1; bit >= 0; --bit) { const unsigned cand = T | (1u << bit); if (A + __builtin_popcountll(__ballot(ck >= cand)) >= 256) T = cand; }
    const int need = 256 - (A + __builtin_popcountll(__ballot(ck > T))), ceq = __builtin_popcountll(__ballot(ck == T));
    P = posmax;
    if (ceq != need) { P = 0;
#pragma unroll 1
        for (int bit = 13; bit >= 0; --bit) { const int cand = P | (1 << bit); if (__builtin_popcountll(__ballot(ck == T && cp < cand)) < need) P = cand; } }
}
__device__ __forceinline__ unsigned wave_min_u(unsigned x) {
    x = min(x, (unsigned)__builtin_amdgcn_update_dpp(0, (int)x, 0xB1, 0xF, 0xF, false)); x = min(x, (unsigned)__builtin_amdgcn_update_dpp(0, (int)x, 0x4E, 0xF, 0xF, false));
    x = min(x, (unsigned)__builtin_amdgcn_update_dpp(0, (int)x, 0x141, 0xF, 0xF, false)); x = min(x, (unsigned)__builtin_amdgcn_update_dpp(0, (int)x, 0x140, 0xF, 0xF, false));
    return min(min((unsigned)__builtin_amdgcn_readlane((int)x, 0), (unsigned)__builtin_amdgcn_readlane((int)x, 16)), min((unsigned)__builtin_amdgcn_readlane((int)x, 32), (unsigned)__builtin_amdgcn_readlane((int)x, 48)));
}
__device__ __forceinline__ unsigned wave_max_u(unsigned x) {
    x = max(x, (unsigned)__builtin_amdgcn_update_dpp(0, (int)x, 0xB1, 0xF, 0xF, false)); x = max(x, (unsigned)__builtin_amdgcn_update_dpp(0, (int)x, 0x4E, 0xF, 0xF, false));
    x = max(x, (unsigned)__builtin_amdgcn_update_dpp(0, (int)x, 0x141, 0xF, 0xF, false)); x = max(x, (unsigned)__builtin_amdgcn_update_dpp(0, (int)x, 0x140, 0xF, 0xF, false));
    return max(max((unsigned)__builtin_amdgcn_readlane((int)x, 0), (unsigned)__builtin_amdgcn_readlane((int)x, 16)), max((unsigned)__builtin_amdgcn_readlane((int)x, 32), (unsigned)__builtin_amdgcn_readlane((int)x, 48)));
}
__device__ __forceinline__ void topk_prompt_rows(ARGREF a, int row0, int stride, int lane_, LAS unsigned* cl) {
    int lane = lane_; asm volatile("" : "+v"(lane));
    const float* SCb = (const float*)(a.ws + WS_SC);
#pragma unroll 1
    for (int row = row0; row < MP; row += stride) {
        const int t = row & 4095;
        u64* mk = (u64*)(a.ws + WS_MASK) + (size_t)row * 64;
        if (t < 256) { u64 myword = 0ull;
#pragma unroll 1
            for (int j = 0; j < 64; ++j) { const u64 m = __ballot(64 * j + lane <= t); if (lane == j) myword = m; }
            mk[lane] = myword;
            continue; }
        unsigned key[64];
        { const float* sc_ = SCb + (size_t)row * SEQ + lane; const int tj_ = t >> 6;
          float v[64];
#pragma unroll
          for (int j = 0; j < 64; ++j) v[j] = sc_[64 * (j < tj_ ? j : tj_)];
          int pj = lane;
#pragma unroll
          for (int j = 0; j < 64; ++j) { const int u = __builtin_bit_cast(int, v[j] + 0.0f); const unsigned k = (unsigned)u ^ ((unsigned)(u >> 31) | 0x80000000u); key[j] = (pj <= t) ? k : 0u; pj += 64; asm volatile("" : "+v"(pj)); } }
        unsigned kh[64];
#pragma unroll
        for (int j = 0; j < 64; ++j) { kh[j] = key[j] >> 1; asm volatile("" : "+v"(kh[j])); }
        unsigned T; int hb;
        {
            unsigned b0 = 0u, b1 = 0u, b2 = 0u, b3 = 0u;
#pragma unroll
            for (int j = 0; j < 64; ++j) { unsigned x = key[j]; const unsigned m0 = max(b0, x); x = min(b0, x); b0 = m0; const unsigned m1 = max(b1, x); x = min(b1, x); b1 = m1; const unsigned m2 = max(b2, x); x = min(b2, x); b2 = m2; b3 = max(b3, x); }
            const unsigned L = wave_min_u(b3), H = wave_max_u(b3), df = L ^ H;
            hb = df ? 31 - __builtin_clz(df) : -1;
            T = hb >= 31 ? 0u : (L & ~((2u << (hb < 0 ? 0 : hb)) - 1u)); if (hb < 0) T = L;
        }
#define TK_FULLCOUNT(CAND, OUT) do { const unsigned cs_ = __builtin_amdgcn_readfirstlane(CAND); int c0_ = 0, c1_ = 0, c2_ = 0, c3_ = 0; \
        _Pragma("unroll") for (int j = 0; j < 64; j += 4) acc_ge4(c0_, c1_, c2_, c3_, key[j], key[j + 1], key[j + 2], key[j + 3], cs_); OUT = wave_sum_dpp((c0_ + c1_) + (c2_ + c3_)); } while (0)
#define TK_FASTCOUNT(CAND, OUT) do { const unsigned ch_ = __builtin_amdgcn_readfirstlane((CAND) >> 1); unsigned a_[8] = {0u, 0u, 0u, 0u, 0u, 0u, 0u, 0u}; \
        _Pragma("unroll") for (int j = 0; j < 64; j += 8) { unsigned d_[8]; _Pragma("unroll") for (int i = 0; i < 8; ++i) d_[i] = kh[j + i] - ch_; \
            _Pragma("unroll") for (int i = 0; i < 8; ++i) a_[i] = __builtin_amdgcn_alignbit(a_[i], d_[i], 31); } \
        OUT = 4096 - wave_sum_dpp(((__builtin_popcount(a_[0]) + __builtin_popcount(a_[1])) + (__builtin_popcount(a_[2]) + __builtin_popcount(a_[3]))) + \
                                  ((__builtin_popcount(a_[4]) + __builtin_popcount(a_[5])) + (__builtin_popcount(a_[6]) + __builtin_popcount(a_[7])))); } while (0)
#pragma unroll 1
        for (int bit = hb; bit >= TK_LOWBITS; --bit) { const unsigned cand = T | (1u << bit); int tot; TK_FASTCOUNT(cand, tot); if (tot >= 256) T = cand; }
        const unsigned Tb = T & ~((1u << TK_LOWBITS) - 1u), hib = Tb + (1u << TK_LOWBITS);
        int A = 0, cT; if (hib != 0u) TK_FASTCOUNT(hib, A); TK_FASTCOUNT(Tb, cT);
#undef TK_FASTCOUNT
        int P;
        if (cT - A <= 64) {
            if (lane == 0) cl[128] = 0u;
            int pj = lane;
#pragma unroll
            for (int j = 0; j < 64; ++j) { if ((key[j] - Tb) < (1u << TK_LOWBITS)) { const unsigned pos = __hip_atomic_fetch_add(cl + 128, 1u, __ATOMIC_RELAXED, __HIP_MEMORY_SCOPE_WORKGROUP); if (pos < 64u) { cl[pos] = key[j]; cl[64 + pos] = (unsigned)pj; } }
                pj += 64; asm volatile("" : "+v"(pj)); }
            const int nund = cT - A;
            const unsigned ck = lane < nund ? cl[lane] : 0u; const int cp = (int)cl[64 + lane];
            topk_finish(ck, cp, A, 4095, T, P);
        } else {
#pragma unroll 1
            for (int bit = TK_LOWBITS - 1; bit >= 0; --bit) { const unsigned cand = T | (1u << bit); int tot; TK_FULLCOUNT(cand, tot); if (tot >= 256) T = cand; }
            int cge, cgt; TK_FULLCOUNT(T, cge); cgt = 0; if (T != 0xffffffffu) TK_FULLCOUNT(T + 1u, cgt);
            const int need = 256 - cgt, ceq = cge - cgt; P = 4095;
            if (ceq != need) { P = 0;
#pragma unroll 1
                for (int bit = 11; bit >= 0; --bit) { const int cand = P | (1 << bit); int cnt = 0; int pj = lane;
#pragma unroll
                    for (int j = 0; j < 64; ++j) { cnt += (key[j] == T && pj < cand) ? 1 : 0; pj += 64; asm volatile("" : "+v"(pj)); }
                    if (wave_sum_dpp(cnt) < need) P = cand; } }
        }
#undef TK_FULLCOUNT
        if (P != 4095) {
            int pq = lane;
#pragma unroll
            for (int j = 0; j < 64; ++j) { if (key[j] == T && pq > P) key[j] = 0u; pq += 64; asm volatile("" : "+v"(pq)); } }
        unsigned wlo = 0u, whi = 0u; const unsigned Ts = __builtin_amdgcn_readfirstlane(T);
#pragma unroll
        for (int j = 0; j < 64; ++j) asm volatile("v_cmp_le_u32_e32 vcc, %2, %3\n\ts_nop 3\n\tv_writelane_b32 %0, vcc_lo, %4\n\tv_writelane_b32 %1, vcc_hi, %4" : "+v"(wlo), "+v"(whi) : "s"(Ts), "v"(key[j]), "i"(j) : "vcc");
        mk[lane] = ((u64)whi << 32) | (u64)wlo;
    }
}
__device__ __forceinline__ void topk_sample_row(ARGREF a, int q, int lane_, LAS unsigned* K, LAS unsigned* cl) {
    int lane = lane_; asm volatile("" : "+v"(lane));
    const int t = q & 3, n = PAST + t + 1; const float* sc = (const float*)(a.ws + WS_SSC) + (size_t)q * SSC_LD;
    int* out = (int*)(a.ws + WS_SIDX) + q * 256;
    unsigned key[129];
#pragma unroll
    for (int j = 0; j < 129; ++j) { const float v = sc[64 * j + lane]; key[j] = (j < 128 || lane < n - 8192) ? fkey(v) : 0u; }
#pragma unroll
    for (int j = 0; j < 129; ++j) K[64 * j + lane] = key[j];
#define TK_FULLCOUNT(CAND, OUT) do { const unsigned cs_ = __builtin_amdgcn_readfirstlane(CAND); int c0_ = 0, c1_ = 0, c2_ = 0, c3_ = 0; \
        _Pragma("unroll") for (int j = 0; j < 128; j += 4) acc_ge4(c0_, c1_, c2_, c3_, key[j], key[j + 1], key[j + 2], key[j + 3], cs_); acc_ge(c0_, key[128], cs_); OUT = wave_sum_dpp((c0_ + c1_) + (c2_ + c3_)); } while (0)
    unsigned T = 0u;
#pragma unroll 1
    for (int bit = 31; bit >= TK_LOWBITS; --bit) { const unsigned cand = T | (1u << bit); int tot; TK_FULLCOUNT(cand, tot); if (tot >= 256) T = cand; }
    const unsigned hib = T + (1u << TK_LOWBITS);
    int A = 0, cT; if (hib != 0u) TK_FULLCOUNT(hib, A); TK_FULLCOUNT(T, cT);
    int P;
    if (cT - A <= 64) {
        int base = 0;
#pragma unroll 1
        for (int j0 = 0; j0 < 128; j0 += 8) { unsigned kk[8];
#pragma unroll
            for (int i = 0; i < 8; ++i) kk[i] = K[64 * (j0 + i) + lane];
#pragma unroll
            for (int i = 0; i < 8; ++i) { const unsigned und = (kk[i] - T) < (1u << TK_LOWBITS) ? 1u : 0u; const u64 m = ballot_nz(und); const int pos = base + mbcnt64(m);
                if (und) { cl[pos] = kk[i]; cl[64 + pos] = (unsigned)(64 * (j0 + i) + lane); }
                base += __builtin_popcountll(m); } }
        { const unsigned kj = K[64 * 128 + lane]; const unsigned und = (kj - T) < (1u << TK_LOWBITS) ? 1u : 0u; const u64 m = ballot_nz(und); const int pos = base + mbcnt64(m);
          if (und) { cl[pos] = kj; cl[64 + pos] = (unsigned)(64 * 128 + lane); } base += __builtin_popcountll(m); }
        const unsigned ck = lane < base ? cl[lane] : 0u; const int cp = (int)cl[64 + lane];
        topk_finish(ck, cp, A, 16383, T, P);
    } else {
#pragma unroll 1
        for (int bit = TK_LOWBITS - 1; bit >= 0; --bit) { const unsigned cand = T | (1u << bit); int tot; TK_FULLCOUNT(cand, tot); if (tot >= 256) T = cand; }
        int cge, cgt; TK_FULLCOUNT(T, cge); cgt = 0; if (T != 0xffffffffu) TK_FULLCOUNT(T + 1u, cgt);
        const int need = 256 - cgt, ceq = cge - cgt; P = 16383;
        if (ceq != need) { P = 0;
#pragma unroll 1
            for (int bit = 13; bit >= 0; --bit) { const int cand = P | (1 << bit); int cnt = 0;
#pragma unroll 4
                for (int j = 0; j < 129; ++j) cnt += (K[64 * j + lane] == T && 64 * j + lane < cand) ? 1 : 0;
                if (wave_sum_dpp(cnt) < need) P = cand; } }
    }
#undef TK_FULLCOUNT
    int base = 0;
#pragma unroll 1
    for (int j0 = 0; j0 < 136; j0 += 8) { unsigned kk[8];
#pragma unroll
        for (int i = 0; i < 8; ++i) kk[i] = (j0 + i < 129) ? K[64 * (j0 + i) + lane] : 0u;
#pragma unroll
        for (int i = 0; i < 8; ++i) { const int ps = 64 * (j0 + i) + lane; const unsigned selv = (kk[i] > T || (kk[i] == T && ps <= P)) ? 1u : 0u; const u64 m = ballot_nz(selv);
            const int pos = base + mbcnt64(m);
            if (selv && pos < 256) out[pos] = ps;
            base += __builtin_popcountll(m); } }
}
__device__ __forceinline__ void p10_topk(Ctx& c, ARGREF a) {
    const int gw = c.vcu * NWAVES + c.wave, NGW = c.G * NWAVES;
    LAS unsigned* cl = (LAS unsigned*)(c.lds) + c.wave * 192;
    if (c.wave == 0 && c.vcu < MS) topk_sample_row(a, c.vcu, c.lane, (LAS unsigned*)(c.lds + 8192), cl);
    topk_prompt_rows(a, gw, NGW, c.lane, cl);
}


__device__ __forceinline__ void attn_sample_unit(Ctx& c, ARGREF a, int sb, int t) {
    LAS bf16* KV = (LAS bf16*)(c.lds);
    LAS float* QL = (LAS float*)(c.lds + 69632);
    LAS float* SL = (LAS float*)(c.lds + 69632 + 3072);
    LAS float* OL = (LAS float*)(c.lds + 69632 + 6144);
    LAS int* IL = (LAS int*)(c.lds + 69632 + 12288);
    LAS unsigned* OFFL = (LAS unsigned*)(c.lds + 69632 + 12288 + 1024);
    int tid = c.tid; asm volatile("" : "+v"(tid));
    const int lane = tid & 63, w = c.wave, q = sb * 4 + t;
    __syncthreads();
    if (tid < 256) IL[tid] = ((const int*)(a.ws + WS_SIDX))[q * 256 + tid];
    for (int i = tid; i < 768; i += 512) QL[i] = ((const float*)(a.ws + WS_SQ))[(size_t)q * 768 + i];
    __syncthreads();
    if (tid < 256) { const int idx = IL[tid];
        OFFL[tid] = idx < PAST ? (unsigned)(((a.page_table[sb * 64 + (idx >> 7)] * 128 + (idx & 127)) * 2) * 128) : (0x80000000u | (unsigned)((sb * 4 + (idx - PAST)) * 256)); }
    __syncthreads();
    bf16* MIX = (bf16*)(a.ws + WS_MIX) + (size_t)(MP + q) * DM;
#pragma unroll 1
    for (int kvh = 0; kvh < 2; ++kvh) {
#pragma unroll 1
        for (int pass = 0; pass < 2; ++pass) {
            const float* pool = pass ? a.in[3] : a.in[2]; const float* nw = a.out + (pass ? O_VS : O_KS);
            { f32x4 gv[16];
#pragma unroll
              for (int r = 0; r < 16; ++r) { const int i = (tid >> 5) + 16 * r; const unsigned off = OFFL[i]; const float* src = (off & 0x80000000u) ? nw + (size_t)(off & 0x7fffffffu) : pool + (size_t)off;
                  gv[r] = *(const f32x4*)(src + kvh * 128 + (tid & 31) * 4); }
#pragma unroll
              for (int r = 0; r < 16; ++r) { const int i = (tid >> 5) + 16 * r; *(LAS u64*)(KV + i * 136 + (tid & 31) * 4) = (u64)pk2(gv[r].x, gv[r].y) | ((u64)pk2(gv[r].z, gv[r].w) << 32); } }
            __syncthreads();
            if (pass == 0) {
                const int i = tid >> 1, dh = (tid & 1) * 64; float s0 = 0.f, s1 = 0.f, s2 = 0.f;
#pragma unroll 8
                for (int d = 0; d < 64; ++d) { const float kx = bf2f(KV[i * 136 + dh + d]);
                    s0 = fmaf(QL[(3 * kvh + 0) * 128 + dh + d], kx, s0); s1 = fmaf(QL[(3 * kvh + 1) * 128 + dh + d], kx, s1); s2 = fmaf(QL[(3 * kvh + 2) * 128 + dh + d], kx, s2); }
                s0 += __shfl_xor(s0, 1); s1 += __shfl_xor(s1, 1); s2 += __shfl_xor(s2, 1);
                if ((tid & 1) == 0) { SL[i] = s0 * 0.08838834764831845f; SL[256 + i] = s1 * 0.08838834764831845f; SL[512 + i] = s2 * 0.08838834764831845f; }
                __syncthreads();
                if (w < 3) { float v[4], mx = -1e30f;
#pragma unroll
                    for (int j = 0; j < 4; ++j) { v[j] = SL[w * 256 + 64 * j + lane]; mx = fmaxf(mx, v[j]); }
#pragma unroll
                    for (int o = 1; o < 64; o <<= 1) mx = fmaxf(mx, __shfl_xor(mx, o));
                    float l = 0.f;
#pragma unroll
                    for (int j = 0; j < 4; ++j) { v[j] = __expf(v[j] - mx); l += v[j]; }
                    l = wave_sum(l); const float il = 1.0f / l;
#pragma unroll
                    for (int j = 0; j < 4; ++j) SL[w * 256 + 64 * j + lane] = v[j] * il; }
                __syncthreads();
            } else {
                const int d = tid & 127, part = tid >> 7; float o0 = 0.f, o1 = 0.f, o2 = 0.f;
#pragma unroll 8
                for (int i = part * 64; i < part * 64 + 64; ++i) { const float vx = bf2f(KV[i * 136 + d]); o0 = fmaf(SL[i], vx, o0); o1 = fmaf(SL[256 + i], vx, o1); o2 = fmaf(SL[512 + i], vx, o2); }
                OL[(part * 3 + 0) * 128 + d] = o0; OL[(part * 3 + 1) * 128 + d] = o1; OL[(part * 3 + 2) * 128 + d] = o2;
                __syncthreads();
                if (tid < 384) { const int hq = tid >> 7, dd = tid & 127; const float o = (OL[hq * 128 + dd] + OL[(3 + hq) * 128 + dd]) + (OL[(6 + hq) * 128 + dd] + OL[(9 + hq) * 128 + dd]);
                    MIX[(3 * kvh + hq) * 128 + dd] = (bf16)f2bf(o); }
                __syncthreads();
            }
        }
    }
}


namespace attn {
using bf16 = unsigned short;
typedef short bf16x8 __attribute__((ext_vector_type(8)));
typedef short s16x4 __attribute__((ext_vector_type(4)));
typedef float f32x16 __attribute__((ext_vector_type(16)));
typedef float f32x4 __attribute__((ext_vector_type(4)));
typedef unsigned u32x4 __attribute__((ext_vector_type(4)));
typedef unsigned u32x2 __attribute__((ext_vector_type(2)));
constexpr int D = 128, OS = 1024;
constexpr float THR = 8.f;
constexpr float SCALE = 0.08838834764831845f;
constexpr int NW = 8, QBLK = 32, KVBLK = 64, QB = NW * QBLK;
constexpr int SHM_V = KVBLK * D * 2, SHM_K = KVBLK * D * 2;
constexpr int LDS_BYTES = 2 * SHM_V + 2 * SHM_K + NW * 64 * 4;

#define KSWZ(row, colB) ((row) * 256 + ((colB) ^ (((row) & 7) << 4)))
#define SBAR() __builtin_amdgcn_sched_barrier(0)
__device__ __forceinline__ int v_st(int k, int c) { const int kk = (k & ~0xC) | ((k & 4) << 1) | ((k & 8) >> 1); return ((kk >> 3) * 4 + (c >> 5)) * 512 + ((kk & 7) * 32 + (c & 31)) * 2; }
__device__ __forceinline__ int v_rd_base(int lane) { return ((lane & 3) << 3) | (((lane >> 2) & 3) << 6) | (((lane >> 4) & 1) << 5) | (((lane >> 5) & 1) << 8); }
constexpr int v_rd_off(int d0, int ks, int half) { return d0 * 512 + ks * 4096 + half * 2048; }
__device__ __forceinline__ int crow(int r, int hi) { return (r & 3) + 8 * (r >> 2) + 4 * hi; }
__device__ __forceinline__ unsigned cvtpk(float lo, float hi) {
    unsigned r; asm volatile("v_cvt_pk_bf16_f32 %0, %1, %2" : "=v"(r) : "v"(lo), "v"(hi)); return r;
}
__device__ __forceinline__ bf16x8 pack8(f32x4 a, f32x4 b) {
    u32x4 w = {cvtpk(a[0], a[1]), cvtpk(a[2], a[3]), cvtpk(b[0], b[1]), cvtpk(b[2], b[3])};
    return *reinterpret_cast<bf16x8*>(&w);
}

__device__ __forceinline__ void partialSM(f32x16& p0, f32x16& p1, float& m_reg, float& mn, float& alpha) {
    float pmax = p0[0]; for (int r = 1; r < 16; ++r) pmax = fmaxf(pmax, p0[r]); for (int r = 0; r < 16; ++r) pmax = fmaxf(pmax, p1[r]);
    { auto rr = __builtin_amdgcn_permlane32_swap(__float_as_uint(pmax), __float_as_uint(pmax), false, false);
      pmax = fmaxf(__uint_as_float(rr[0]), __uint_as_float(rr[1])); }
    constexpr float C2 = 1.4426950408889634f * SCALE;
    if (__builtin_expect(__all((pmax - m_reg) * SCALE <= THR), 1)) { mn = m_reg; alpha = 1.f; }
    else { mn = fmaxf(m_reg, pmax); alpha = __builtin_amdgcn_exp2f((m_reg - mn) * C2); m_reg = mn; }
    const float mnL = -mn * C2;
    for (int r = 0; r < 16; ++r) p0[r] = fmaf(p0[r], C2, mnL); for (int r = 0; r < 16; ++r) p1[r] = fmaf(p1[r], C2, mnL);
    for (int r = 0; r < 16; ++r) p0[r] = __builtin_amdgcn_exp2f(p0[r]);
}
__device__ __forceinline__ void finishSM(f32x16& p0, f32x16& p1, float alpha, float& l_reg, bf16x8& pa0, bf16x8& pa1, bf16x8& pa2, bf16x8& pa3) {
    for (int r = 0; r < 16; ++r) p1[r] = __builtin_amdgcn_exp2f(p1[r]);
    float ps = 0; for (int r = 0; r < 16; ++r) ps += p0[r]; for (int r = 0; r < 16; ++r) ps += p1[r];
    { auto rr = __builtin_amdgcn_permlane32_swap(__float_as_uint(ps), __float_as_uint(ps), false, false);
      ps = __uint_as_float(rr[0]) + __uint_as_float(rr[1]); }
    l_reg = l_reg * alpha + ps;
#define PK4(P, B_, OUT) do { unsigned a0 = cvtpk(P[B_+0], P[B_+1]), a1 = cvtpk(P[B_+2], P[B_+3]);                          \
        unsigned b0 = cvtpk(P[B_+4], P[B_+5]), b1 = cvtpk(P[B_+6], P[B_+7]);                                             \
        auto r0 = __builtin_amdgcn_permlane32_swap(a0, b0, false, false); auto r1 = __builtin_amdgcn_permlane32_swap(a1, b1, false, false); \
        u32x4 w = {r0[0], r1[0], r0[1], r1[1]}; OUT = *reinterpret_cast<bf16x8*>(&w); } while (0)
    PK4(p0, 0, pa0); PK4(p0, 8, pa1); PK4(p1, 0, pa2); PK4(p1, 8, pa3);
#undef PK4
}
template <int KB, bool SK>
__device__ __forceinline__ void qkt(f32x16& p0, f32x16& p1, const char* K_lds, int r32, int hi, const bf16x8* qr, bool act) {
    if (SK && !act) { const float NEG = -__builtin_inff();
#pragma unroll
        for (int r = 0; r < 16; ++r) { p0[r] = NEG; p1[r] = NEG; } return; }
    p0 = f32x16{}; p1 = f32x16{};
    const char* kb[4];
#pragma unroll
    for (int dd = 0; dd < 4; ++dd) kb[dd] = K_lds + KB * SHM_K + KSWZ(r32, (dd * 16 + hi * 8) * 2);
#pragma unroll
    for (int d0 = 0; d0 < 8; ++d0) { const char* a = kb[d0 & 3] + (d0 >> 2) * 128;
        bf16x8 b0 = *reinterpret_cast<const bf16x8*>(a);
        bf16x8 b1 = *reinterpret_cast<const bf16x8*>(a + 32 * 256);
        p0 = __builtin_amdgcn_mfma_f32_32x32x16_bf16(b0, qr[d0], p0, 0, 0, 0);
        p1 = __builtin_amdgcn_mfma_f32_32x32x16_bf16(b1, qr[d0], p1, 0, 0, 0); }
}
template <int VB, bool SK>
__device__ __forceinline__ void pv_tile(f32x16* o, int vb0, bf16x8 pa0, bf16x8 pa1, bf16x8 pa2, bf16x8 pa3, bool act) {
    if (SK && !act) return;
#define TRRD(dst, off) asm volatile("ds_read_b64_tr_b16 %0, %1 offset:%2" : "=&v"(dst) : "v"(vb0), "i"(off) : "memory")
#define PV_D0(d0) do { s16x4 l0, l1, l2, l3, h0, h1, h2, h3; constexpr int b_ = VB * SHM_V + v_rd_off(d0, 0, 0);     \
        TRRD(l0, b_); TRRD(h0, b_ + 2048); TRRD(l1, b_ + 4096); TRRD(h1, b_ + 6144); TRRD(l2, b_ + 8192); TRRD(h2, b_ + 10240); TRRD(l3, b_ + 12288); TRRD(h3, b_ + 14336); \
        asm volatile("s_waitcnt lgkmcnt(0)" ::: "memory"); SBAR();                 \
        o[d0] = __builtin_amdgcn_mfma_f32_32x32x16_bf16(pa0, (bf16x8){l0[0], l0[1], l0[2], l0[3], h0[0], h0[1], h0[2], h0[3]}, o[d0], 0, 0, 0);   \
        o[d0] = __builtin_amdgcn_mfma_f32_32x32x16_bf16(pa1, (bf16x8){l1[0], l1[1], l1[2], l1[3], h1[0], h1[1], h1[2], h1[3]}, o[d0], 0, 0, 0);   \
        o[d0] = __builtin_amdgcn_mfma_f32_32x32x16_bf16(pa2, (bf16x8){l2[0], l2[1], l2[2], l2[3], h2[0], h2[1], h2[2], h2[3]}, o[d0], 0, 0, 0);   \
        o[d0] = __builtin_amdgcn_mfma_f32_32x32x16_bf16(pa3, (bf16x8){l3[0], l3[1], l3[2], l3[3], h3[0], h3[1], h3[2], h3[3]}, o[d0], 0, 0, 0); } while (0)
    PV_D0(0); PV_D0(1); PV_D0(2); PV_D0(3);
#undef PV_D0
#undef TRRD
}

__device__ __forceinline__ bf16x8 load8(const bf16* p) { return *reinterpret_cast<const bf16x8*>(p); }
__device__ __forceinline__ void mask_bits(f32x16& p0, f32x16& p1, u32x2 w, int hi) {
    const float NEG = -__builtin_inff();
    asm volatile("" : "+v"(w.x), "+v"(w.y));
    const unsigned lo = w.x >> (4 * hi), up = w.y >> (4 * hi);
#pragma unroll
    for (int r = 0; r < 16; ++r) { const int c = (r & 3) + 8 * (r >> 2);
        if (!((lo >> c) & 1u)) p0[r] = NEG;
        if (!((up >> c) & 1u)) p1[r] = NEG; }
}
struct BlockRef { const bf16* Q; const bf16* K; const bf16* V; bf16* O; const u32x2* M; int P0; };
struct Seam { bf16x8 qr[8]; bf16x8 st_v0, st_v1, st_k0, st_k1; };
#define ROW(p, k0, rr) ((p) + (size_t)((k0) + (rr)) * D + sc)
#define VMW() asm volatile("s_waitcnt vmcnt(0)" ::: "memory")
#define VMWN(n) asm volatile("s_waitcnt vmcnt(%0)" :: "i"(n) : "memory")
#define SLOAD_H(Kp, Vp, k0) do { S.st_v0 = load8(ROW(Vp, k0, sr)); S.st_v1 = load8(ROW(Vp, k0, 32 + sr));              \
                         S.st_k0 = load8(ROW(Kp, k0, sr)); S.st_k1 = load8(ROW(Kp, k0, 32 + sr)); } while (0)
#define SWRITE_HK(bf) do { *(bf16x8*)(K_lds + (bf) * SHM_K + kws) = S.st_k0; *(bf16x8*)(K_lds + (bf) * SHM_K + kws + 32 * 256) = S.st_k1; } while (0)
#define SWRITE_HV(bf) do { *(bf16x8*)(V_lds + (bf) * SHM_V + vst0) = S.st_v0; *(bf16x8*)(V_lds + (bf) * SHM_V + vst1) = S.st_v1; } while (0)
#define SWRITE_H(bf) do { SWRITE_HV(bf); SWRITE_HK(bf); } while (0)
__device__ __forceinline__ void sel_prime(const BlockRef& cur, char* lds, Seam& S) {
    int tid_ = threadIdx.x; asm volatile("" : "+v"(tid_));
    const int tid = tid_, wid = __builtin_amdgcn_readfirstlane(tid >> 6), lane = tid & 63, r32 = lane & 31, hi = lane >> 5;
    const int sr = tid >> 4, sc = (tid & 15) * 8, kws = KSWZ(sr, sc * 2); char* K_lds = lds + 2 * SHM_V;
    for (int d0 = 0; d0 < 8; ++d0) S.qr[d0] = load8(cur.Q + (size_t)(wid * QBLK + r32) * D + d0 * 16 + hi * 8);
    SLOAD_H(cur.K, cur.V, 0); VMW(); SWRITE_HK(0);
    __syncthreads();
}
__device__ __forceinline__ void sel_block(const BlockRef& cur, const BlockRef& nxt, char* lds, Seam& S) {
    int tid_ = threadIdx.x; asm volatile("" : "+v"(tid_));
    const int tid = tid_, wid = __builtin_amdgcn_readfirstlane(tid >> 6), lane = tid & 63, r32 = lane & 31, hi = lane >> 5;
    const int NT = (cur.P0 + QB) / KVBLK;
    char* V_lds = lds; char* K_lds = lds + 2 * SHM_V;
    float* ws = (float*)(lds + 2 * SHM_V + 2 * SHM_K) + wid * 64; float* li_l = ws, * al_l = ws + 32;
    float m_reg = -1e30f, l_reg = 0; f32x16 o[4] = {};
    const int sr = tid >> 4, sc = (tid & 15) * 8, vst0 = v_st(sr, sc), vst1 = v_st(32 + sr, sc), kws = KSWZ(sr, sc * 2);
    const int vb0 = (int)(uintptr_t)V_lds + v_rd_base(lane);
    const bf16* Kh = cur.K; const bf16* Vh = cur.V;
    const char* Mbase = (const char*)cur.M; const unsigned moff = (unsigned)(wid * QBLK + r32) * 512u;
#define MROW(t) (*(const u32x2*)(Mbase + (moff + (unsigned)(t) * 8u)))
#define RESC(a) do { if (__any((a) < 1.f)) { if (hi == 0) al_l[r32] = (a); asm volatile("s_waitcnt lgkmcnt(0)" ::: "memory");              \
                     for (int d_ = 0; d_ < 4; ++d_) for (int r = 0; r < 16; ++r) o[d_][r] *= al_l[crow(r, hi)]; } } while (0)
#define KBASE(t) ((t) * KVBLK)
    f32x16 pA0, pA1, pB0, pB1; float mnA, mnB, alA, alB; bf16x8 pa0, pa1, pa2, pa3; u32x2 mw;
    SWRITE_HV(0); SBAR();
    if (NT > 1) SLOAD_H(Kh, Vh, KBASE(1));
    mw = MROW(0);
    SBAR(); qkt<0, false>(pA0, pA1, K_lds, r32, hi, S.qr, true);
    mask_bits(pA0, pA1, mw, hi); partialSM(pA0, pA1, m_reg, mnA, alA);
    if (NT > 1) { VMW(); SWRITE_H(1); }
    __syncthreads();
#define HALF_STEP(PX0, PX1, mnX, alX, PY0, PY1, alY, t, KB, VB, SB) do {                                                      \
        SBAR(); mw = MROW(t); qkt<KB, false>(PX0, PX1, K_lds, r32, hi, S.qr, true);                                          \
        finishSM(PY0, PY1, alY, l_reg, pa0, pa1, pa2, pa3); SBAR();                                                           \
        if ((t) + 1 < NT) { SLOAD_H(Kh, Vh, KBASE((t) + 1)); SBAR(); }                                                        \
        pv_tile<VB, false>(o, vb0, pa0, pa1, pa2, pa3, true); mask_bits(PX0, PX1, mw, hi); partialSM(PX0, PX1, m_reg, mnX, alX); \
        __syncthreads();                                                                                                      \
        if ((t) + 1 < NT) { VMW(); SWRITE_H(SB); }                                                                            \
        RESC(alX); __syncthreads(); } while (0)
    for (int t = 1; t + 1 < NT; t += 2) {
        HALF_STEP(pB0, pB1, mnB, alB, pA0, pA1, alA, t, 1, 0, 0);
        HALF_STEP(pA0, pA1, mnA, alA, pB0, pB1, alB, t + 1, 0, 1, 1);
    }
    const bool even = (NT & 1) == 0;
    if (even) { SBAR(); mw = MROW(NT - 1); qkt<1, false>(pB0, pB1, K_lds, r32, hi, S.qr, true); SBAR(); }
    SLOAD_H(nxt.K, nxt.V, 0); SBAR();
#pragma unroll
    for (int d0 = 0; d0 < 8; ++d0) S.qr[d0] = load8(nxt.Q + (size_t)(wid * QBLK + r32) * D + d0 * 16 + hi * 8);
    SBAR();
    finishSM(pA0, pA1, alA, l_reg, pa0, pa1, pa2, pa3); SBAR();
    pv_tile<0, false>(o, vb0, pa0, pa1, pa2, pa3, true);
    if (even) { mask_bits(pB0, pB1, mw, hi); partialSM(pB0, pB1, m_reg, mnB, alB); __syncthreads(); RESC(alB);
        finishSM(pB0, pB1, alB, l_reg, pa0, pa1, pa2, pa3); SBAR(); pv_tile<1, false>(o, vb0, pa0, pa1, pa2, pa3, true); }
    SBAR(); VMWN(8); SWRITE_HK(0); SBAR();
    if (hi == 0) li_l[r32] = l_reg; asm volatile("s_waitcnt lgkmcnt(0)" ::: "memory");
    float rli[16];
#pragma unroll
    for (int r = 0; r < 16; ++r) rli[r] = __builtin_amdgcn_rcpf(li_l[crow(r, hi)]);
    bf16* Ow = cur.O + (size_t)(wid * QBLK) * OS;
#pragma unroll
    for (int r = 0; r < 16; ++r) { const int orow = crow(r, hi);
#pragma unroll
        for (int d0 = 0; d0 < 4; ++d0) { const float v = o[d0][r] * rli[r];
            const float vn = __shfl_xor(v, 1);
            if ((r32 & 1) == 0) *(unsigned*)(Ow + (size_t)orow * OS + d0 * 32 + r32) = cvtpk(v, vn); } }
    __syncthreads();
#undef RESC
#undef KBASE
#undef HALF_STEP
#undef MROW
}
#undef ROW
#undef VMW
#undef VMWN
#undef SLOAD_H
#undef SWRITE_HK
#undef SWRITE_HV
#undef SWRITE_H
#undef KSWZ
#undef SBAR
}


__device__ __forceinline__ attn::BlockRef attn_ref(ARGREF a, int b, int h, int qb) {
    attn::BlockRef r; const int kvh = h / 3;
    r.Q = (const attn::bf16*)(a.ws + WS_QB) + ((size_t)(b * 6 + h) * SEQ + (size_t)qb * 256) * 128;
    r.K = (const attn::bf16*)(a.ws + WS_KB) + (size_t)(b * 2 + kvh) * SEQ * 128;
    r.V = (const attn::bf16*)(a.ws + WS_VB) + (size_t)(b * 2 + kvh) * SEQ * 128;
    r.O = (attn::bf16*)(a.ws + WS_MIX) + (size_t)(b * SEQ + qb * 256) * DM + h * 128;
    r.M = (const attn::u32x2*)(a.ws + WS_MASK) + (size_t)(b * SEQ + qb * 256) * 64;
    r.P0 = qb * 256; return r;
}
__device__ __forceinline__ void p11_attention(Ctx& c, ARGREF a) {
    constexpr int NITEM = 240;
#pragma unroll 1
    for (int it = c.vcu; it < NITEM; it += c.G) {
        const int bh = it / 10, slot = it % 10, b = bh / 6, h = bh % 6;
        const int q0 = slot < 3 ? 15 - slot : (slot == 9 ? 6 : slot - 3), q1 = slot < 3 ? q0 : (slot == 9 ? 6 : 15 - slot);
        attn::Seam S;
        attn::BlockRef cur = attn_ref(a, b, h, q0), nxt = attn_ref(a, b, h, q1);
        __syncthreads();
        attn::sel_prime(cur, (char*)c.lds, S);
        if (q0 != q1) attn::sel_block(cur, nxt, (char*)c.lds, S);
        attn::sel_block(nxt, nxt, (char*)c.lds, S);
    }
    if (c.G == 256) {
        if (c.vcu >= NITEM) { for (int j = 0; j < 4; ++j) { const int u = (c.vcu - NITEM) * 4 + j; attn_sample_unit(c, a, u >> 2, u & 3); } }
        else if (c.vcu % 10 == 9) { for (int j = 0; j < 3; ++j) { const int u = 64 + (c.vcu / 10) * 3 + j; if (u < MS) attn_sample_unit(c, a, u >> 2, u & 3); } }
    } else for (int u = c.vcu; u < MS; u += c.G) attn_sample_unit(c, a, u >> 2, u & 3);
}

enum { PH_PRO = 0, PH_IN0, PH_MIX0, PH_HSCAN, PH_HFIX, PH_OUT0, PH_GU0, PH_DOWN0, PH_IN1, PH_POST, PH_IDX, PH_TOPK, PH_ATTN, PH_OUT1, PH_GU1, PH_DOWN1, NPHASE };
#ifndef ONLYPH
#define ONLYPH -1
#endif
#define PHON(x) (ONLYPH < 0 || ONLYPH == (x))
#ifndef REP_PH
#define REP_PH -1
#endif
#ifndef REP_N
#define REP_N 1
#endif
__global__ void __launch_bounds__(NWAVES * 64, 2) fwd_kernel(Args args) {
    extern __shared__ __attribute__((aligned(16))) unsigned char lds[];
    Ctx c;
    c.lds = (LAS unsigned char*)lds;
    c.MISC = (volatile LAS unsigned*)(c.lds + MISC_OFF);
    c.tid = threadIdx.x; c.lane = c.tid & 63; c.wave = __builtin_amdgcn_readfirstlane(c.tid >> 6);
    c.G = gridDim.x; { const int bx = blockIdx.x; c.vcu = (c.G % 8 == 0) ? (bx % 8) * (c.G / 8) + bx / 8 : bx; }
    c.ctl = (gu32*)(args.ws + WS_CTL);
    for (int u = c.tid; u < (LDS_BYTES - LDSCTL_OFF) / 4; u += NWAVES * 64) ((LAS unsigned*)(c.lds + LDSCTL_OFF))[u] = 0u;
    __syncthreads();
    const int lo = args.ph_lo, hi = args.ph_hi;
    XcdBarrier bar; bar.bar = (unsigned*)(c.ctl + CW_BAR); bar.x = 0; bar.st = nullptr;
    if (hi - lo > 1 || REP_N > 1) bar = xcd_barrier_post((unsigned*)(c.ctl + CW_BAR), c.MISC + 8);
    c.qoff = 0;
#pragma unroll 1
    for (int ph = lo; ph < hi; ++ph) {
        const int layer = ph >= PH_IN1 ? 1 : 0;
        const __attribute__((address_space(4))) Args* ap = (const __attribute__((address_space(4))) Args*)__builtin_amdgcn_kernarg_segment_ptr(); asm volatile("" : "+s"(ap));
        ARGREF la = *ap; unsigned char* const ws = la.ws; float* const out = la.out;
        { int t_ = threadIdx.x; asm volatile("" : "+v"(t_)); c.tid = t_; c.lane = t_ & 63; c.wave = __builtin_amdgcn_readfirstlane(t_ >> 6); }
        if ((ph == PH_DOWN0 || ph == PH_DOWN1) && PHON(PH_OUT0)) {
            pg8::SchedX S0; S0.init(MP, 1024, c.G, (int)blockIdx.x, 0, 0, 1, 0); pg8::Unit u0; if (S0.next(0, u0)) conv_fixup_tile(c, la, layer, u0.pm); VM_WAIT(); __syncthreads(); }
        if (ph == PH_PRO && PHON(PH_PRO)) p0_prologue(c, la);
        else if ((ph == PH_IN0 || ph == PH_IN1) && PHON(PH_IN0)) {
            pg8::Gemm g{(const pg8::bf16_t*)(ws + WS_XB), (const pg8::bf16_t*)(ws + (ph == PH_IN0 ? WS_WIN0 : WS_WIN1)), MT, 0, 1024};
            pg8::SchedX S; if (ph == PH_IN0) S.init(MP, ZC0, c.G, (int)blockIdx.x, 16, MT / 256, 4, 13); else S.init(MP, ZC1, c.G, (int)blockIdx.x, 0, 0, 1, 0);
            pg8::EpiZ E{(pg8::bf16_t*)(ws + WS_Z), ph == PH_IN0 ? ZC0 : ZC1, ssptr(c, ph == PH_IN0 ? 0 : 2), ph == PH_IN0 ? 13 : 9, (float*)(ws + WS_MEMKV), MEMROW0};
            pg8::gemm_phase<pg8::EpiZ, pg8::SchedX, PG8_ALIGN, PG8_SP2>(c.lds + RING_OFF, g, S, E);
            { SgArgs sg{}; sg.A = (const bf16*)(ws + WS_XB) + (size_t)MP * DM; sg.Bt = (const bf16*)(ws + (ph == PH_IN0 ? WS_WIN0 : WS_WIN1)); sg.K = 1024; sg.mode = 0; sg.Z = (bf16*)(ws + WS_Z); sg.ldz = ph == PH_IN0 ? ZC0 : ZC1; sg.ssin = ssptr(c, ph == PH_IN0 ? 0 : 2);
              sgemm_phase(c, sg, ph == PH_IN0 ? ZC0 : ZC1); }
            if (ph == PH_IN0) { __syncthreads(); convert_layer1_tail(c, la, (64 * 13 + 16) % c.G); }
        }
        else if (ph == PH_MIX0 && PHON(PH_MIX0)) p2_mixer0(c, la);
        else if (ph == PH_HSCAN && PHON(PH_HSCAN)) hgrn_scan(c, la);
        else if (ph == PH_HFIX && PHON(PH_HFIX)) p2c_hgrn_fix(c, la);
        else if ((ph == PH_OUT0 || ph == PH_DOWN0 || ph == PH_OUT1 || ph == PH_DOWN1) && PHON(PH_OUT0)) {
            const bool isout = (ph == PH_OUT0 || ph == PH_OUT1);
            pg8::Gemm g{(const pg8::bf16_t*)(ws + (isout ? WS_MIX : WS_ACT)), (const pg8::bf16_t*)(ws + (isout ? WS_WOUT + (size_t)layer * 1024 * 1024 * 2 : WS_WD + (size_t)layer * 1024 * DFF * 2)), MT, 1024, isout ? 1024 : DFF};
            pg8::SchedX S; S.init(MP, 1024, c.G, (int)blockIdx.x, 0, 0, 1, 0);
            pg8::EpiResid E;
            E.rp = ph == PH_OUT0 ? la.in[0] : nullptr; E.rb = (const pg8::bf16_t*)(ws + WS_XB); E.y = ph == PH_DOWN1 ? out + O_YP : nullptr;
            E.xb = ph == PH_DOWN1 ? nullptr : (pg8::bf16_t*)(ws + WS_XB); E.ssout = ph == PH_DOWN1 ? nullptr : ssptr(c, ph == PH_OUT0 ? 1 : (ph == PH_DOWN0 ? 2 : 3));
            pg8::gemm_phase<pg8::EpiResid, pg8::SchedX, PG8_ALIGN, PG8_SP2>(c.lds + RING_OFF, g, S, E);
            { SgArgs sg{}; sg.A = (const bf16*)(ws + (isout ? WS_MIX : WS_ACT)) + (size_t)MP * (isout ? 1024 : DFF); sg.Bt = (const bf16*)g.Bt; sg.K = isout ? 1024 : DFF; sg.mode = 1; sg.rb = (const bf16*)(ws + WS_XB); sg.resid = ph == PH_OUT0 ? la.in[1] : nullptr; sg.y = ph == PH_DOWN1 ? out + O_YS : nullptr; sg.xb = (bf16*)E.xb; sg.ssout = E.ssout;
              sgemm_phase(c, sg, 1024); }
        }
        else if ((ph == PH_GU0 || ph == PH_GU1) && PHON(PH_GU0)) {
            pg8::Gemm g{(const pg8::bf16_t*)(ws + WS_XB), (const pg8::bf16_t*)(ws + WS_WGU + (size_t)layer * 5632 * 1024 * 2), MT, 5632, 1024};
            pg8::SchedX S; S.init(MP, 5632, c.G, (int)blockIdx.x, 0, 0, 1, 0);
            pg8::EpiGU E{(pg8::bf16_t*)(ws + WS_ACT), ssptr(c, layer ? 3 : 1), out + O_CVP + (size_t)layer * 4 * 2 * DFF, la.in[26] + (size_t)layer * 3 * DFF, la.in[27] + (size_t)layer * DFF, (float*)(ws + WS_G4), (float*)(ws + WS_UP2)};
            pg8::gemm_phase<pg8::EpiGU, pg8::SchedX, PG8_ALIGN, PG8_SP2>(c.lds + RING_OFF, g, S, E);
            { SgArgs sg{}; sg.A = (const bf16*)(ws + WS_XB) + (size_t)MP * DM; sg.Bt = (const bf16*)g.Bt; sg.K = 1024; sg.mode = 2; sg.ssin = E.ss; sg.ACT = (bf16*)E.ACT; sg.cvs = out + O_CVS + (size_t)layer * 32 * 2 * DFF; sg.cst = la.in[8] + (size_t)layer * 32 * 2 * DFF; sg.cw = E.cw; sg.cb = E.cb;
              sgemm_phase(c, sg, 5632); }
        }
        else if (ph == PH_POST && PHON(PH_POST)) p8_dsa_post(c, la);
        else if (ph == PH_IDX && PHON(PH_IDX)) p9_indexer(c, la);
        else if (ph == PH_TOPK && PHON(PH_TOPK)) p10_topk(c, la);
        else if (ph == PH_ATTN && PHON(PH_ATTN)) p11_attention(c, la);
        if (REP_N > 1 && ph == REP_PH && c.qoff < 4 * (REP_N - 1)) { c.qoff += 4; --ph; xcd_barrier(bar); continue; }
        if (REP_N > 1) c.qoff = 0;
        if (ph + 1 < hi) xcd_barrier(bar);
    }
}

#ifndef MK_ONE_LAUNCH
#define MK_ONE_LAUNCH 1
#endif
extern "C" void kernel_launch(void* const* d_in, const int* in_sizes, int n_in, void* d_out, int out_size, void* d_ws, size_t ws_size, hipStream_t stream) {
    static int grid = 0;
    if (grid == 0) {
        if (n_in != 29 || out_size != (int)O_END || ws_size < WS_END) { fprintf(stderr, "kernel_launch: unexpected problem (n_in %d, out %d, ws %zu)\n", n_in, out_size, ws_size); grid = -1; return; }
        int dev = 0, cus = 0;
        if (hipGetDevice(&dev) != hipSuccess || hipDeviceGetAttribute(&cus, hipDeviceAttributeMultiprocessorCount, dev) != hipSuccess) { grid = -1; return; }
        if (hipFuncSetAttribute((const void*)fwd_kernel, hipFuncAttributeMaxDynamicSharedMemorySize, LDS_BYTES) != hipSuccess) { fprintf(stderr, "kernel_launch: hipFuncSetAttribute failed\n"); grid = -1; return; }
        (void)hipGetLastError();
        grid = cus;
    }
    if (grid < 0) return;
    if (hipMemsetAsync((char*)d_ws + WS_CTL, 0, CTL_ZERO_BYTES, stream) != hipSuccess) { fprintf(stderr, "kernel_launch: memset failed\n"); return; }
    Args a{};
    for (int i = 0; i < 29; ++i) a.in[i] = (const float*)d_in[i];
    a.page_table = (const int*)d_in[9]; a.out = (float*)d_out; a.ws = (unsigned char*)d_ws;
#if MK_ONE_LAUNCH
    a.ph_lo = 0; a.ph_hi = NPHASE;
    hipLaunchKernelGGL(fwd_kernel, dim3(grid), dim3(NWAVES * 64), LDS_BYTES, stream, a);
#else
    for (int ph = 0; ph < NPHASE; ++ph) { a.ph_lo = ph; a.ph_hi = ph + 1; hipLaunchKernelGGL(fwd_kernel, dim3(grid), dim3(NWAVES * 64), LDS_BYTES, stream, a); }
#endif
}
```

```cpp
#include <hip/hip_runtime.h>
#include <cstdio>
#include <cstdint>


namespace pg8 {
#define PG8_LAS __attribute__((address_space(3)))
typedef unsigned short bf16_t;
typedef short bf16x8 __attribute__((ext_vector_type(8)));
typedef float f32x4 __attribute__((ext_vector_type(4)));
typedef unsigned u32x4 __attribute__((ext_vector_type(4)));
constexpr int BM = 256, BK = 64, HALF = 128, HTB = HALF * BK * 2  , STAGE_BYTES = 8 * HTB, NXCD = 8, WGM = 8;

__host__ __device__ __forceinline__ int lds_byte(int r, int c) { const int st = (r >> 4) * 2 + (c >> 5), rr = r & 15, cc = c & 31, ob = rr * 64 + cc * 2; return st * 1024 + (ob ^ (((ob >> 9) & 1) << 5)); }
__host__ __device__ __forceinline__ void stage_rc(int b, int& R, int& C) { const int st = b / 1024, sb = b % 1024, swz = sb ^ (((sb >> 9) & 1) << 5); R = (st >> 1) * 16 + swz / 64; C = (st & 1) * 32 + (swz % 64) / 2; }
__host__ __device__ __forceinline__ int perm32(int rho) { const int n = rho >> 4, i = rho & 15; return 8 * (i >> 2) + 4 * n + (i & 3); }

struct Unit { int pm, pn; };
struct Gemm { const bf16_t* A; const bf16_t* Bt; int M, N, K; };

struct StaticOrder {
    int nM, nN, nwg, G, c;
    __host__ __device__ __forceinline__ void init(int M, int N, int G_, int c_) { nM = M / BM; nN = N / BM; nwg = nM * nN; G = G_; c = c_; }
    __host__ __device__ __forceinline__ bool next(int i, Unit& u) const {
        const long L = (long)i * G + c; if (L >= nwg) return false;
        int wgid = (int)L; { const int q = nwg / NXCD, r = nwg % NXCD, xcd = wgid % NXCD, off = wgid / NXCD; wgid = (xcd < r ? xcd * (q + 1) : r * (q + 1) + (xcd - r) * q) + off; }
        const int nig = WGM * nN, gid = wgid / nig, fm = gid * WGM, gsz = (nM - fm) < WGM ? (nM - fm) : WGM;
        u.pm = fm + ((wgid % nig) % gsz); u.pn = (wgid % nig) / gsz; return true;
    }
    __device__ __forceinline__ void a_ready(const Unit&) const {}
    __device__ __forceinline__ void done(const Unit&) const {}
};


constexpr int MP = 16384, MS = 128, MVALID = MP + MS, MT = 16640, DM = 1024, DFF = 2816;
constexpr float RMS_EPS = 1e-6f;
__device__ __forceinline__ unsigned cvt_pk_bf16(float lo, float hi) { unsigned r; asm volatile("v_cvt_pk_bf16_f32 %0, %1, %2" : "=v"(r) : "v"(lo), "v"(hi)); return r; }

struct SchedX {
    StaticOrder so; int nextra, e_pm0, e_nm, e_pn0;
    __device__ __forceinline__ void init(int M, int N, int G_, int c_, int nextra_, int e_pm0_, int e_nm_, int e_pn0_) { so.init(M, N, G_, c_); nextra = nextra_; e_pm0 = e_pm0_; e_nm = e_nm_; e_pn0 = e_pn0_; }
    __device__ __forceinline__ bool next(int i, Unit& u) const {
        const long L = (long)i * so.G + so.c;
        if (L < so.nwg) return so.next(i, u);
        const int e = (int)(L - so.nwg); if (e >= nextra) return false;
        u.pm = e_pm0 + e % e_nm; u.pn = e_pn0 + e / e_nm; return true;
    }
    __device__ __forceinline__ void a_ready(const Unit&) const {}
    __device__ __forceinline__ void done(const Unit&) const {}
};

struct EpiZ {
    static constexpr bool PERM = true, AFTER_DRAIN = false;
    bf16_t* Z; int ldz; const float* ss; int nmain; float* memkv; int memrow0;
    __device__ __forceinline__ void operator()(const f32x4 (&acc)[2][2][4][2], const Unit& u, int wr, int wc, int fr, int fq) const {
        const int row0 = u.pm * BM + wr * 64 + fr;
        if (u.pn < nmain) {
            const int col0 = u.pn * BM + wc * 32 + 8 * fq;
#pragma unroll
            for (int ai = 0; ai < 2; ++ai)
#pragma unroll
                for (int m = 0; m < 4; ++m) { const int row = row0 + ai * HALF + m * 16; const float rs = rsqrtf(ss[row] * (1.0f / DM) + RMS_EPS);
#pragma unroll
                    for (int bj = 0; bj < 2; ++bj) { const f32x4 v0 = acc[ai][bj][m][0] * rs, v1 = acc[ai][bj][m][1] * rs;
                        u32x4 w; w.x = cvt_pk_bf16(v0[0], v0[1]); w.y = cvt_pk_bf16(v0[2], v0[3]); w.z = cvt_pk_bf16(v1[0], v1[1]); w.w = cvt_pk_bf16(v1[2], v1[3]);
                        *(u32x4*)(Z + (size_t)row * ldz + col0 + bj * HALF) = w; } }
        } else {
            const int col0 = (u.pn - nmain) * BM + wc * 32 + 8 * fq;
#pragma unroll
            for (int ai = 0; ai < 2; ++ai)
#pragma unroll
                for (int m = 0; m < 4; ++m) { const int row = row0 + ai * HALF + m * 16 - memrow0;
#pragma unroll
                    for (int bj = 0; bj < 2; ++bj) { float* p = memkv + (size_t)row * 1024 + col0 + bj * HALF; *(f32x4*)p = acc[ai][bj][m][0]; *(f32x4*)(p + 4) = acc[ai][bj][m][1]; } }
        }
    }
};

struct EpiResid {
    static constexpr bool PERM = true, AFTER_DRAIN = false;
    const float* rp; const bf16_t* rb; float* y; bf16_t* xb; float* ssout;
    __device__ __forceinline__ void operator()(const f32x4 (&acc)[2][2][4][2], const Unit& u, int wr, int wc, int fr, int fq) const {
        const int row0 = u.pm * BM + wr * 64 + fr, col0 = u.pn * BM + wc * 32 + 8 * fq;
#pragma unroll
        for (int ai = 0; ai < 2; ++ai)
#pragma unroll
            for (int m = 0; m < 4; ++m) { const int row = row0 + ai * HALF + m * 16; float part = 0.f;
#pragma unroll
                for (int bj = 0; bj < 2; ++bj) { const int c = col0 + bj * HALF; f32x4 r0, r1;
                    if (rp) { r0 = *(const f32x4*)(rp + (size_t)row * DM + c); r1 = *(const f32x4*)(rp + (size_t)row * DM + c + 4); }
                    else { const u32x4 q = *(const u32x4*)(rb + (size_t)row * DM + c);
                        r0 = (f32x4){__builtin_bit_cast(float, q.x << 16), __builtin_bit_cast(float, q.x & 0xffff0000u), __builtin_bit_cast(float, q.y << 16), __builtin_bit_cast(float, q.y & 0xffff0000u)};
                        r1 = (f32x4){__builtin_bit_cast(float, q.z << 16), __builtin_bit_cast(float, q.z & 0xffff0000u), __builtin_bit_cast(float, q.w << 16), __builtin_bit_cast(float, q.w & 0xffff0000u)}; }
                    const f32x4 v0 = acc[ai][bj][m][0] + r0, v1 = acc[ai][bj][m][1] + r1;
                    if (y) { *(f32x4*)(y + (size_t)row * DM + c) = v0; *(f32x4*)(y + (size_t)row * DM + c + 4) = v1; }
                    part += (v0[0] * v0[0] + v0[1] * v0[1]) + (v0[2] * v0[2] + v0[3] * v0[3]) + (v1[0] * v1[0] + v1[1] * v1[1]) + (v1[2] * v1[2] + v1[3] * v1[3]);
                    if (xb) { u32x4 w; w.x = cvt_pk_bf16(v0[0], v0[1]); w.y = cvt_pk_bf16(v0[2], v0[3]); w.z = cvt_pk_bf16(v1[0], v1[1]); w.w = cvt_pk_bf16(v1[2], v1[3]);
                        *(u32x4*)(xb + (size_t)row * DM + c) = w; } }
                part += __shfl_xor(part, 16); part += __shfl_xor(part, 32);
                if (ssout && fq == 0) atomicAdd(ssout + row, part); }
    }
};

__device__ __forceinline__ void dpp_ror12(const f32x4& v, f32x4& r1, f32x4& r2) {
    float a0, a1, a2, a3, b0, b1, b2, b3;
    asm volatile("s_nop 1\n\t"
                 "v_mov_b32_dpp %0, %8 row_ror:1 row_mask:0xf bank_mask:0xf\n\tv_mov_b32_dpp %1, %9 row_ror:1 row_mask:0xf bank_mask:0xf\n\t"
                 "v_mov_b32_dpp %2, %10 row_ror:1 row_mask:0xf bank_mask:0xf\n\tv_mov_b32_dpp %3, %11 row_ror:1 row_mask:0xf bank_mask:0xf\n\t"
                 "v_mov_b32_dpp %4, %8 row_ror:2 row_mask:0xf bank_mask:0xf\n\tv_mov_b32_dpp %5, %9 row_ror:2 row_mask:0xf bank_mask:0xf\n\t"
                 "v_mov_b32_dpp %6, %10 row_ror:2 row_mask:0xf bank_mask:0xf\n\tv_mov_b32_dpp %7, %11 row_ror:2 row_mask:0xf bank_mask:0xf"
                 : "=&v"(a0), "=&v"(a1), "=&v"(a2), "=&v"(a3), "=&v"(b0), "=&v"(b1), "=&v"(b2), "=&v"(b3) : "v"(v[0]), "v"(v[1]), "v"(v[2]), "v"(v[3]));
    r1 = (f32x4){a0, a1, a2, a3}; r2 = (f32x4){b0, b1, b2, b3};
}
struct EpiGU {
    static constexpr bool PERM = true, AFTER_DRAIN = false;
    bf16_t* ACT; const float* ss; float* cvp; const float* cw; const float* cb; float* G4; float* UP2;
    __device__ __forceinline__ void operator()(const f32x4 (&acc)[2][2][4][2], const Unit& u, int wr, int wc, int fr, int fq) const {
        const int row0 = u.pm * BM + wr * 64 + fr, colg = u.pn * HALF + wc * 32 + 8 * fq;
        f32x4 w0[2], w1[2], w2[2], bb[2];
#pragma unroll
        for (int n = 0; n < 2; ++n) { const int col = colg + 4 * n; w0[n] = *(const f32x4*)(cw + col); w1[n] = *(const f32x4*)(cw + DFF + col); w2[n] = *(const f32x4*)(cw + 2 * DFF + col); bb[n] = *(const f32x4*)(cb + col); }
#pragma unroll
        for (int ai = 0; ai < 2; ++ai) { f32x4 r1p[2] = {{0.f, 0.f, 0.f, 0.f}, {0.f, 0.f, 0.f, 0.f}}, r2p[2] = {{0.f, 0.f, 0.f, 0.f}, {0.f, 0.f, 0.f, 0.f}}; const int slab = (u.pm * BM + ai * HALF + wr * 64) >> 6;
#pragma unroll
            for (int m = 0; m < 4; ++m) { const int row = row0 + ai * HALF + m * 16; const float rs = rsqrtf(ss[row] * (1.0f / DM) + RMS_EPS);
                f32x4 y[2], g[2], up[2];
#pragma unroll
                for (int n = 0; n < 2; ++n) { g[n] = acc[ai][0][m][n] * rs; up[n] = acc[ai][1][m][n] * rs;
                    f32x4 r1, r2; dpp_ror12(g[n], r1, r2);
                    const f32x4 p1 = fr >= 1 ? r1 : r1p[n], p2 = fr >= 2 ? r2 : r2p[n];
                    const f32x4 cv = bb[n] + w0[n] * p2 + w1[n] * p1 + w2[n] * g[n];
#pragma unroll
                    for (int i = 0; i < 4; ++i) y[n][i] = cv[i] * __builtin_amdgcn_rcpf(1.0f + __expf(-cv[i])) * up[n][i];
                    r1p[n] = r1; r2p[n] = r2; }
                if (m == 0 && fr < 2) {
#pragma unroll
                    for (int n = 0; n < 2; ++n) { *(f32x4*)(G4 + (size_t)(slab * 4 + fr) * DFF + colg + 4 * n) = g[n]; *(f32x4*)(UP2 + (size_t)(slab * 2 + fr) * DFF + colg + 4 * n) = up[n]; } }
                else { u32x4 w; w.x = cvt_pk_bf16(y[0][0], y[0][1]); w.y = cvt_pk_bf16(y[0][2], y[0][3]); w.z = cvt_pk_bf16(y[1][0], y[1][1]); w.w = cvt_pk_bf16(y[1][2], y[1][3]); *(u32x4*)(ACT + (size_t)row * DFF + colg) = w; }
                if (m == 3 && fr >= 14) {
#pragma unroll
                    for (int n = 0; n < 2; ++n) { *(f32x4*)(G4 + (size_t)(slab * 4 + 2 + (fr - 14)) * DFF + colg + 4 * n) = g[n];
                        const int t = row & 4095; if (t >= 4094) *(f32x4*)(cvp + (size_t)((row >> 12) * 2 + (t - 4094)) * DFF + colg + 4 * n) = g[n]; } } } }
    }
};

template <class Epi, class Sched, bool ALIGN_EPI = false, bool SP2 = false>
__device__ __forceinline__ void gemm_phase(PG8_LAS unsigned char* lds, const Gemm g, const Sched& S, const Epi& E) {
    int tid_ = threadIdx.x; asm volatile("" : "+v"(tid_));
    const int tid = tid_, wid = __builtin_amdgcn_readfirstlane(tid >> 6), lane = tid & 63, wr = wid >> 2, wc = wid & 3, fr = lane & 15, fq = lane >> 4;
    const int K = g.K, nt = K / BK;
    unsigned voffA[2], voffB[2];
#pragma unroll
    for (int i = 0; i < 2; ++i) { int R, C; stage_rc(tid * 16 + i * 8192, R, C); const int Rb = Epi::PERM ? ((R & ~31) + perm32(R & 31)) : R;
        voffA[i] = (unsigned)(R * K + C) * 2u; voffB[i] = (unsigned)(Rb * K + C) * 2u; }
    const size_t kstep = (size_t)(BK * 2);
    const size_t hstep = (size_t)HALF * K * 2;
    const size_t tstep = 2 * hstep;
    const unsigned ldsw = (unsigned)wid * 1024u;
    const int aoff = lds_byte(wr * 64 + fr, fq * 8), boff = lds_byte(wc * 32 + fr, fq * 8);
#define PG8_SA(b, h) (((b) * 2 + (h)) * HTB)
#define PG8_SB(b, h) ((4 + (b) * 2 + (h)) * HTB)
#define PG8_STAGE(bufoff, gbase, voff) do { _Pragma("unroll") for (int _i = 0; _i < 2; ++_i) \
        __builtin_amdgcn_global_load_lds((const unsigned*)((const char*)(gbase) + (voff)[_i]), (PG8_LAS unsigned*)(lds + (bufoff) + ldsw + _i * 8192), 16, 0, 0); } while (0)
#define PG8_LDA(dst, b, h) do { _Pragma("unroll") for (int m = 0; m < 4; ++m) _Pragma("unroll") for (int k = 0; k < 2; ++k) dst[m][k] = *(const PG8_LAS bf16x8*)(lds + PG8_SA(b, h) + aoff + m * 2048 + k * 1024); } while (0)
#define PG8_LDB(dst, b, h) do { _Pragma("unroll") for (int n = 0; n < 2; ++n) _Pragma("unroll") for (int k = 0; k < 2; ++k) dst[n][k] = *(const PG8_LAS bf16x8*)(lds + PG8_SB(b, h) + boff + n * 2048 + k * 1024); } while (0)
#define PG8_MMA(ai, bj, At, Bt) do { __builtin_amdgcn_s_setprio(1); _Pragma("unroll") for (int m = 0; m < 4; ++m) _Pragma("unroll") for (int n = 0; n < 2; ++n) _Pragma("unroll") for (int k = 0; k < 2; ++k) \
        acc[ai][bj][m][n] = __builtin_amdgcn_mfma_f32_16x16x32_bf16(Bt[n][k], At[m][k], acc[ai][bj][m][n], 0, 0, 0); __builtin_amdgcn_s_setprio(0); } while (0)
#define PG8_WAIT_V(n) asm volatile("s_waitcnt vmcnt(" #n ")" ::: "memory")
#define PG8_WAIT_L(n) asm volatile("s_waitcnt lgkmcnt(" #n ")" ::: "memory")
#define PG8_BAR __builtin_amdgcn_s_barrier()
#define PG8_SCHED __builtin_amdgcn_sched_barrier(0)
    Unit cur, nxt; int ui = 0;
    if (!S.next(0, cur)) return;
    f32x4 acc[2][2][4][2];
#pragma unroll
    for (int a = 0; a < 2; ++a)
#pragma unroll
        for (int b = 0; b < 2; ++b)
#pragma unroll
            for (int m = 0; m < 4; ++m)
#pragma unroll
                for (int n = 0; n < 2; ++n) acc[a][b][m][n] = (f32x4){0.f, 0.f, 0.f, 0.f};
    bf16x8 At[4][2], B0[2][2], B1[2][2];
    const char* cA = (const char*)g.A + (size_t)cur.pm * tstep; const char* cB = (const char*)g.Bt + (size_t)cur.pn * tstep;
    S.a_ready(cur);
    if constexpr (SP2) {
        PG8_STAGE(PG8_SB(0, 0), cB, voffB); PG8_STAGE(PG8_SB(0, 1), cB + hstep, voffB); PG8_STAGE(PG8_SA(0, 0), cA, voffA); PG8_STAGE(PG8_SA(0, 1), cA + hstep, voffA);
        if (wr == 1) PG8_BAR;
        PG8_WAIT_V(2); PG8_BAR;
        PG8_STAGE(PG8_SB(1, 0), cB + kstep, voffB); PG8_STAGE(PG8_SA(1, 0), cA + kstep, voffA); PG8_STAGE(PG8_SB(1, 1), cB + hstep + kstep, voffB);
        PG8_WAIT_V(6); PG8_BAR;
    } else {
        PG8_STAGE(PG8_SB(0, 0), cB, voffB); PG8_STAGE(PG8_SA(0, 0), cA, voffA); PG8_STAGE(PG8_SB(0, 1), cB + hstep, voffB); PG8_STAGE(PG8_SA(0, 1), cA + hstep, voffA);
        if (wr == 1) PG8_BAR;
        PG8_WAIT_V(4); PG8_BAR;
        PG8_STAGE(PG8_SB(1, 0), cB + kstep, voffB); PG8_STAGE(PG8_SA(1, 0), cA + kstep, voffA); PG8_STAGE(PG8_SB(1, 1), cB + hstep + kstep, voffB);
        PG8_WAIT_V(6); PG8_BAR;
    }
    for (;;) {
        const bool has_next = S.next(ui + 1, nxt);
        const char* nA = has_next ? (const char*)g.A + (size_t)nxt.pm * tstep : cA; const char* nB = has_next ? (const char*)g.Bt + (size_t)nxt.pn * tstep : cB;
        for (int t = 0; t < nt; t += 2) {
            const bool last = (t == nt - 2);
            const char* a1 = cA + (size_t)(t + 1) * kstep;
            const char* a2 = last ? nA : cA + (size_t)(t + 2) * kstep; const char* b2 = last ? nB : cB + (size_t)(t + 2) * kstep;
            const char* a3 = a2 + kstep; const char* b3 = b2 + kstep;
            if (last && has_next) S.a_ready(nxt);
            if constexpr (SP2) {
            PG8_LDB(B0, 0, 0); PG8_LDB(B1, 0, 1); PG8_SCHED; PG8_LDA(At, 0, 0); PG8_STAGE(PG8_SA(1, 1), a1 + hstep, voffA);
            PG8_WAIT_V(8); PG8_WAIT_L(0); PG8_BAR; PG8_MMA(0, 0, At, B0); PG8_MMA(0, 1, At, B1); PG8_BAR; PG8_SCHED;
            PG8_LDA(At, 0, 1); PG8_STAGE(PG8_SB(0, 0), b2, voffB); PG8_STAGE(PG8_SB(0, 1), b2 + hstep, voffB); PG8_STAGE(PG8_SA(0, 0), a2, voffA);
            PG8_WAIT_V(8); PG8_WAIT_L(0); PG8_BAR; PG8_MMA(1, 0, At, B0); PG8_MMA(1, 1, At, B1); PG8_BAR; PG8_SCHED;
            PG8_LDB(B0, 1, 0); PG8_LDB(B1, 1, 1); PG8_SCHED; PG8_LDA(At, 1, 0); PG8_STAGE(PG8_SA(0, 1), a2 + hstep, voffA);
            PG8_WAIT_V(8); PG8_WAIT_L(0); PG8_BAR; PG8_MMA(0, 0, At, B0); PG8_MMA(0, 1, At, B1); PG8_BAR; PG8_SCHED;
            PG8_LDA(At, 1, 1); PG8_STAGE(PG8_SB(1, 0), b3, voffB); PG8_STAGE(PG8_SB(1, 1), b3 + hstep, voffB); PG8_STAGE(PG8_SA(1, 0), a3, voffA);
            PG8_WAIT_V(8); PG8_WAIT_L(0); PG8_BAR; PG8_MMA(1, 0, At, B0); PG8_MMA(1, 1, At, B1); PG8_BAR; PG8_SCHED;
            } else {
            PG8_LDB(B0, 0, 0); PG8_SCHED; PG8_LDA(At, 0, 0); PG8_STAGE(PG8_SA(1, 1), a1 + hstep, voffA);
            PG8_WAIT_L(8); PG8_BAR; PG8_WAIT_L(0); PG8_MMA(0, 0, At, B0); PG8_BAR; PG8_SCHED;
            PG8_LDB(B1, 0, 1); PG8_STAGE(PG8_SB(0, 0), b2, voffB);
            PG8_BAR; PG8_WAIT_L(0); PG8_MMA(0, 1, At, B1); PG8_BAR;
            PG8_LDA(At, 0, 1); PG8_STAGE(PG8_SA(0, 0), a2, voffA);
            PG8_BAR; PG8_WAIT_L(0); PG8_MMA(1, 0, At, B0); PG8_BAR; PG8_SCHED;
            PG8_STAGE(PG8_SB(0, 1), b2 + hstep, voffB);
            PG8_WAIT_V(6); PG8_BAR; PG8_MMA(1, 1, At, B1); PG8_BAR;
            PG8_LDB(B0, 1, 0); PG8_SCHED; PG8_LDA(At, 1, 0); PG8_STAGE(PG8_SA(0, 1), a2 + hstep, voffA);
            PG8_WAIT_L(8); PG8_BAR; PG8_WAIT_L(0); PG8_MMA(0, 0, At, B0); PG8_BAR; PG8_SCHED;
            PG8_LDB(B1, 1, 1); PG8_STAGE(PG8_SB(1, 0), b3, voffB);
            PG8_BAR; PG8_WAIT_L(0); PG8_MMA(0, 1, At, B1); PG8_BAR;
            PG8_LDA(At, 1, 1); PG8_STAGE(PG8_SA(1, 0), a3, voffA);
            PG8_BAR; PG8_WAIT_L(0); PG8_MMA(1, 0, At, B0); PG8_BAR; PG8_SCHED;
            PG8_STAGE(PG8_SB(1, 1), b3 + hstep, voffB);
            PG8_WAIT_V(6); PG8_BAR; PG8_MMA(1, 1, At, B1); PG8_BAR;
            }
        }
        if constexpr (ALIGN_EPI) { if (wr == 0) PG8_BAR; }
        if constexpr (!Epi::AFTER_DRAIN) { E(acc, cur, wr, wc, fr, fq); S.done(cur); }
        if (!has_next) break;
#pragma unroll
        for (int a = 0; a < 2; ++a)
#pragma unroll
            for (int b = 0; b < 2; ++b)
#pragma unroll
                for (int m = 0; m < 4; ++m)
#pragma unroll
                    for (int n = 0; n < 2; ++n) acc[a][b][m][n] = (f32x4){0.f, 0.f, 0.f, 0.f};
        cur = nxt; cA = nA; cB = nB; ++ui;
        if constexpr (ALIGN_EPI) { if (wr == 1) PG8_BAR; }
    }
    PG8_WAIT_V(0);
    if constexpr (!ALIGN_EPI) { if (wr == 0) PG8_BAR; }
    PG8_BAR;
    if constexpr (Epi::AFTER_DRAIN) { E.fused(acc, cur, wr, wc, fr, fq, lds, wid, lane); S.done(cur); }
#undef PG8_SA
#undef PG8_SB
#undef PG8_STAGE
#undef PG8_LDA
#undef PG8_LDB
#undef PG8_MMA
#undef PG8_WAIT_V
#undef PG8_WAIT_L
#undef PG8_BAR
#undef PG8_SCHED
}
}


#ifndef PG8_SP2
#define PG8_SP2 true
#endif
#ifndef PG8_ALIGN
#define PG8_ALIGN true
#endif
constexpr int NWAVES = 8;
constexpr int MP = pg8::MP, MS = pg8::MS, MVALID = pg8::MVALID, MT = pg8::MT, DM = 1024, DFF = 2816;
constexpr int SEQ = 4096, NB = 4, NSB = 32, PAST = 8192, NPOOL = 2560;
constexpr int ZC0 = 3328, ZC1 = 2304;
constexpr int Z1_Q = 0, Z1_K = 768, Z1_V = 1024, Z1_IQ = 1280, Z1_IK = 1792, Z1_IW = 1856, Z1_MQ = 1920;
constexpr int NMEMROWS = 1024, MEMROW0 = MT;
constexpr float EPS = 1e-6f;
constexpr size_t MiB = 1u << 20;
constexpr size_t WS_CTL = 0, CTL_ZERO_BYTES = 2 * MiB;
constexpr size_t WS_WIN0 = 2 * MiB, WS_WIN1 = 11 * MiB, WS_WOUT = 16 * MiB, WS_WGU = 20 * MiB, WS_WD = 42 * MiB;
constexpr size_t WS_XB = 54 * MiB, WS_MEMKV = 89 * MiB, WS_MIX = 94 * MiB, WS_Z = 128 * MiB, WS_U = 234 * MiB, WS_UP = 324 * MiB, WS_ACT = 414 * MiB;
constexpr size_t WS_QB = 504 * MiB, WS_KB = 528 * MiB, WS_VB = 536 * MiB, WS_IQB = 544 * MiB, WS_IKB = 560 * MiB, WS_IW = 562 * MiB;
constexpr size_t WS_SQ = 563 * MiB, WS_SIQ = WS_SQ + 512 * 1024, WS_SIW = WS_SIQ + 384 * 1024, WS_SSC = 564 * MiB, WS_SIDX = 569 * MiB, WS_MASK = 570 * MiB, WS_SC = 578 * MiB, WS_END = 834 * MiB;
constexpr int SSC_LD = 8256;
constexpr int CW_TMO = 0, CW_BAR = 4096, CW_Q = 8192, CW_SS = 16384;
constexpr size_t O_YP = 0, O_YS = O_YP + (size_t)MP * DM, O_HP = O_YS + (size_t)MS * DM, O_HS = O_HP + 4 * 6 * 16384, O_KP = O_HS + 32 * 6 * 16384,
    O_VP = O_KP + (size_t)MP * 256, O_IKP = O_VP + (size_t)MP * 256, O_KS = O_IKP + (size_t)MP * 64, O_VS = O_KS + MS * 256, O_IKS = O_VS + MS * 256,
    O_MK = O_IKS + MS * 64, O_MV = O_MK + 2 * 1024 * 256, O_CVP = O_MV + 2 * 1024 * 256, O_CVS = O_CVP + 2 * 4 * 2 * DFF, O_END = O_CVS + 2 * 32 * 2 * DFF;
static_assert(O_END == 31412224, "output size");
constexpr int RING_OFF = 0, RING_BYTES = 131072;
constexpr int LDSCTL_OFF = RING_BYTES, MISC_OFF = LDSCTL_OFF + 320;
constexpr int LDS_BYTES = 147456;

#define GAS __attribute__((address_space(1)))
#define LAS __attribute__((address_space(3)))
typedef unsigned short bf16;
typedef unsigned v4u __attribute__((ext_vector_type(4)));
typedef float f32x4 __attribute__((ext_vector_type(4)));
typedef short bf16x8 __attribute__((ext_vector_type(8)));
typedef GAS unsigned gu32;
typedef GAS unsigned long long gu64;
#define RLX_AGENT __ATOMIC_RELAXED, __HIP_MEMORY_SCOPE_AGENT
#define LDS_WAIT() asm volatile("s_waitcnt lgkmcnt(0)" ::: "memory")
#define VM_WAIT() asm volatile("s_waitcnt vmcnt(0)" ::: "memory")
__device__ __forceinline__ unsigned long long rt() { return __builtin_amdgcn_s_memrealtime(); }
__device__ __forceinline__ unsigned f2bf(float f) { unsigned u = __builtin_bit_cast(unsigned, f); return (u + 0x7fffu + ((u >> 16) & 1u)) >> 16; }
__device__ __forceinline__ unsigned pk2(float lo, float hi) { return f2bf(lo) | (f2bf(hi) << 16); }

#define XB_TMO      128
#define XB_XCNT(j)  (256  + 64 * (j))
#define XB_XSUB(j)  (1280 + 64 * (j))
#define XB_XGEN(j)  (2304 + 64 * (j))
#define XB_TOP      3328
#define XB_TOPGEN   3392
#define XCD_BAR_WORDS 3456
#define XB_SPIN_CAP (1u << 18)

__device__ __forceinline__ unsigned xb_ld(unsigned* p)              { return __hip_atomic_load(p, __ATOMIC_RELAXED, __HIP_MEMORY_SCOPE_AGENT); }
__device__ __forceinline__ unsigned xb_add(unsigned* p, unsigned v) { return __hip_atomic_fetch_add(p, v, __ATOMIC_RELAXED, __HIP_MEMORY_SCOPE_AGENT); }
__device__ __forceinline__ unsigned xb_xcc_id() { return (unsigned)__builtin_amdgcn_s_getreg((3 << 11) | 20) & 0xFu; }
#define XB_SPIN(cond, bar) do { unsigned _sp = 0; while (cond) { __builtin_amdgcn_s_sleep(1); \
    if ((++_sp & 255u) == 0u) { if (xb_ld(&(bar)[XB_TMO])) break; if (_sp > XB_SPIN_CAP) { atomicAdd(&(bar)[XB_TMO], 1u); break; } } } } while (0)

struct XcdBarrier {
    unsigned* bar; unsigned x;
    volatile LAS unsigned* st;
};

__device__ __forceinline__ XcdBarrier xcd_barrier_post(unsigned* bar, volatile LAS unsigned* st) {
    XcdBarrier b; b.bar = bar; b.x = xb_xcc_id(); b.st = st;
    if (threadIdx.x == 0) (void)xb_add(&bar[XB_XCNT(b.x)], 1u);
    return b;
}
__device__ __forceinline__ void xcd_barrier_complete(unsigned* bar, unsigned x, unsigned& nloc, unsigned& nx) {
    const unsigned G = gridDim.x * gridDim.y * gridDim.z;
    unsigned sum, cnt, mine, sp = 0u;
    for (;;) {
        sum = 0u; cnt = 0u; mine = 0u;
#pragma unroll
        for (unsigned j = 0; j < 16; ++j) { const unsigned c = xb_ld(&bar[XB_XCNT(j)]); sum += c; cnt += (c > 0u) ? 1u : 0u; mine = (j == x) ? c : mine; }
        if (sum == G) break;
        __builtin_amdgcn_s_sleep(1);
        if ((++sp & 255u) == 0u) { if (xb_ld(&bar[XB_TMO])) break; if (sp > XB_SPIN_CAP) { atomicAdd(&bar[XB_TMO], 1u); break; } }
    }
    nloc = mine > 0u ? mine : 1u; nx = cnt > 0u ? cnt : 1u;
}

__device__ __forceinline__ void xcd_barrier(const XcdBarrier& b) {
    asm volatile("s_waitcnt vmcnt(0)" ::: "memory");
    __syncthreads();
    if (threadIdx.x == 0) {
        unsigned* bar = b.bar;
        __builtin_amdgcn_s_waitcnt(0);
        unsigned nloc = b.st[0], nx = b.st[1];
        if (nloc == 0u) { xcd_barrier_complete(bar, b.x, nloc, nx); b.st[0] = nloc; b.st[1] = nx; }
        const unsigned old = xb_add(&bar[XB_XSUB(b.x)], 1u);
        const unsigned gen = old / nloc;
        if (old + 1u == (gen + 1u) * nloc) {
            __builtin_amdgcn_fence(__ATOMIC_RELEASE, "agent");
            asm volatile("s_waitcnt vmcnt(0)" ::: "memory");
            const unsigned og = xb_add(&bar[XB_TOP], 1u);
            const unsigned tg = og / nx;
            if (og + 1u == (tg + 1u) * nx) xb_add(&bar[XB_TOPGEN], 1u);
            else XB_SPIN(xb_ld(&bar[XB_TOPGEN]) == tg, bar);
            __builtin_amdgcn_fence(__ATOMIC_ACQUIRE, "agent");
            xb_add(&bar[XB_XGEN(b.x)], 1u);
            asm volatile("s_waitcnt vmcnt(0)" ::: "memory");
        } else {
            XB_SPIN(xb_ld(&bar[XB_XGEN(b.x)]) == gen, bar);
            __builtin_amdgcn_fence(__ATOMIC_ACQUIRE, "agent");
            asm volatile("s_waitcnt vmcnt(0)" ::: "memory");
        }
    }
    __syncthreads();
}


struct Args { const float* in[29]; const int* page_table; float* out; unsigned char* ws; int ph_lo, ph_hi; };
typedef const __attribute__((address_space(4))) Args& ARGREF;
struct Ctx { LAS unsigned char* lds; volatile LAS unsigned* MISC; gu32* ctl; int tid, lane, wave, vcu, G, qoff; };
typedef float f32x16 __attribute__((ext_vector_type(16)));
typedef unsigned long long u64;

__device__ __forceinline__ float bf2f(unsigned b) { return __builtin_bit_cast(float, b << 16); }
__device__ __forceinline__ float wave_sum(float v) {
#pragma unroll
    for (int o = 1; o < 64; o <<= 1) v += __shfl_xor(v, o);
    return v;
}
__device__ __forceinline__ float wave_sum_fast(float x) {
    x += __builtin_bit_cast(float, __builtin_amdgcn_update_dpp(0, __builtin_bit_cast(int, x), 0xB1, 0xF, 0xF, false));
    x += __builtin_bit_cast(float, __builtin_amdgcn_update_dpp(0, __builtin_bit_cast(int, x), 0x4E, 0xF, 0xF, false));
    x += __builtin_bit_cast(float, __builtin_amdgcn_update_dpp(0, __builtin_bit_cast(int, x), 0x141, 0xF, 0xF, false));
    x += __builtin_bit_cast(float, __builtin_amdgcn_update_dpp(0, __builtin_bit_cast(int, x), 0x140, 0xF, 0xF, false));
    const int xi = __builtin_bit_cast(int, x);
    return (__builtin_bit_cast(float, __builtin_amdgcn_readlane(xi, 0)) + __builtin_bit_cast(float, __builtin_amdgcn_readlane(xi, 16))) +
           (__builtin_bit_cast(float, __builtin_amdgcn_readlane(xi, 32)) + __builtin_bit_cast(float, __builtin_amdgcn_readlane(xi, 48)));
}
__device__ __forceinline__ int crow(int r, int hi) { return (r & 3) + 8 * (r >> 2) + 4 * hi; }
__device__ __forceinline__ float sigmoidf_(float x) { return __builtin_amdgcn_rcpf(1.0f + __expf(-x)); }
__device__ __forceinline__ float* ssptr(const Ctx& c, int i) { return (float*)(c.ctl + CW_SS) + (size_t)i * MT; }

__device__ __forceinline__ int q_next(Ctx& c, int qi) {
    __syncthreads();
    if (c.tid == 0) c.MISC[16] = atomicAdd((unsigned*)(c.ctl + CW_Q + 64 * (qi + c.qoff)), 1u);
    __syncthreads();
    return (int)c.MISC[16];
}

template <int K>
__device__ __forceinline__ f32x16 mm32(const LAS bf16* A, int lda, const LAS bf16* Bt, int ldb, f32x16 acc, int lane) {
    const int r = lane & 31, h = lane >> 5;
#pragma unroll
    for (int ks = 0; ks < K; ks += 16) {
        const bf16x8 a = *(const LAS bf16x8*)(A + r * lda + ks + 8 * h);
        const bf16x8 b = *(const LAS bf16x8*)(Bt + r * ldb + ks + 8 * h);
        acc = __builtin_amdgcn_mfma_f32_32x32x16_bf16(a, b, acc, 0, 0, 0);
    }
    return acc;
}

__device__ __forceinline__ int map_row(int mapid, int n, int row_off) {
    if (mapid == 0) return n + row_off;
    if (mapid == 1) return n < 1864 ? n : n + 56;
    if (mapid == 2) return (n >> 7) * 256 + (n & 127);
    return (n >> 7) * 256 + 128 + (n & 127);
}
__device__ __forceinline__ void transpose_item(const float* W, int K, int N, const float* kscale, bf16* WT, int mapid, int row_off, LAS float* scr, int item, int lane) {
    const int nblk = (N + 31) / 32, kb = item / nblk, nb = item % nblk, k0 = 64 * kb, n0 = 32 * nb;
    { const int n4 = (lane & 7) * 4, nn = n0 + n4 < N ? n0 + n4 : N - 4; f32x4 v[8];
#pragma unroll
      for (int i = 0; i < 8; ++i) v[i] = *(const f32x4*)(W + (size_t)(k0 + 8 * i + (lane >> 3)) * N + nn);
#pragma unroll
      for (int i = 0; i < 8; ++i) { const int kk = 8 * i + (lane >> 3); const float sc = kscale ? kscale[k0 + kk] : 1.0f; LAS float* d = scr + kk * 33 + n4;
          d[0] = v[i].x * sc; d[1] = v[i].y * sc; d[2] = v[i].z * sc; d[3] = v[i].w * sc; } }
    LDS_WAIT(); asm volatile("" ::: "memory");
    const int cc = lane & 7;
#pragma unroll
    for (int j = 0; j < 4; ++j) { const int nl = (lane >> 3) + 8 * j, n = n0 + nl; const LAS float* s = scr + (8 * cc) * 33 + nl;
        v4u o; o.x = pk2(s[0 * 33], s[1 * 33]); o.y = pk2(s[2 * 33], s[3 * 33]); o.z = pk2(s[4 * 33], s[5 * 33]); o.w = pk2(s[6 * 33], s[7 * 33]);
        if (n < N) *(GAS v4u*)(WT + (size_t)map_row(mapid, n, row_off) * K + k0 + 8 * cc) = o; }
    LDS_WAIT(); asm volatile("" ::: "memory");
}
constexpr int I_INH = 16 * 104, I_MKV = 16 * 16, I_DSA = 16 * 67, I_OUT = 16 * 32, I_G = 16 * 88, I_D = 44 * 32;
constexpr int W_N0 = I_INH + 2 * I_MKV + I_OUT + 2 * I_G + I_D, W_NITEMS = W_N0 + I_DSA + I_OUT + 2 * I_G + I_D;
__device__ __forceinline__ void convert_item(ARGREF a, int it, LAS float* scr, int lane) {
    unsigned char* ws = a.ws; int r = it;
    if (r < I_INH) { transpose_item(a.in[13], 1024, 3328, a.in[11], (bf16*)(ws + WS_WIN0), 0, 0, scr, r, lane); return; } r -= I_INH;
    if (r < 2 * I_MKV) { const int l = r / I_MKV; transpose_item(a.in[20] + (size_t)l * 1024 * 512, 1024, 512, nullptr, (bf16*)(ws + WS_WIN0), 0, 3328 + 512 * l, scr, r % I_MKV, lane); return; } r -= 2 * I_MKV;
    int l = 0;
    if (r >= I_OUT + 2 * I_G + I_D) { r -= I_OUT + 2 * I_G + I_D; l = 1;
        if (r < I_DSA) { transpose_item(a.in[16], 1024, 2120, a.in[11] + 1024, (bf16*)(ws + WS_WIN1), 1, 0, scr, r, lane); return; } r -= I_DSA; }
    if (r < I_OUT) { transpose_item(a.in[23] + (size_t)l * 1024 * 1024, 1024, 1024, nullptr, (bf16*)(ws + WS_WOUT) + (size_t)l * 1024 * 1024, 0, 0, scr, r, lane); return; } r -= I_OUT;
    if (r < I_G) { transpose_item(a.in[24] + (size_t)l * 1024 * DFF, 1024, DFF, a.in[12] + l * 1024, (bf16*)(ws + WS_WGU) + (size_t)l * 5632 * 1024, 2, 0, scr, r, lane); return; } r -= I_G;
    if (r < I_G) { transpose_item(a.in[25] + (size_t)l * 1024 * DFF, 1024, DFF, a.in[12] + l * 1024, (bf16*)(ws + WS_WGU) + (size_t)l * 5632 * 1024, 3, 0, scr, r, lane); return; } r -= I_G;
    transpose_item(a.in[28] + (size_t)l * DFF * 1024, DFF, 1024, nullptr, (bf16*)(ws + WS_WD) + (size_t)l * 1024 * DFF, 0, 0, scr, r, lane);
}
__device__ __forceinline__ void convert_layer1_tail(Ctx& c, ARGREF a, int first_idle) {
    LAS float* scr = (LAS float*)(c.lds + RING_OFF + c.wave * 16384);
    const int bx = (int)blockIdx.x; if (bx < first_idle) return;
    const int nw = (c.G - first_idle) * NWAVES;
    for (int it = W_N0 + (bx - first_idle) * NWAVES + c.wave; it < W_NITEMS; it += nw) convert_item(a, it, scr, c.lane);
}
__device__ __forceinline__ void p0_prologue(Ctx& c, ARGREF a) {
    LAS float* scr = (LAS float*)(c.lds + RING_OFF + c.wave * 16384);
    const int gw = c.vcu * NWAVES + c.wave, NGW = c.G * NWAVES, lane = c.lane;
    unsigned char* ws = a.ws;
    for (int it = gw; it < W_N0; it += NGW) convert_item(a, it, scr, lane);
    for (int rr = gw; rr < 184; rr += NGW) { const int row = rr < 56 ? 1864 + rr : 2176 + (rr - 56);
        GAS v4u* p = (GAS v4u*)((bf16*)(ws + WS_WIN1) + (size_t)row * 1024); p[lane] = (v4u){0u, 0u, 0u, 0u}; p[64 + lane] = (v4u){0u, 0u, 0u, 0u}; }
    float* ss0 = ssptr(c, 0);
    for (int m = gw; m < MT + NMEMROWS; m += NGW) {
        GAS u64* o8 = (GAS u64*)((bf16*)(ws + WS_XB) + (size_t)m * DM) + lane;
        if (m >= MVALID && m < MT) {
#pragma unroll
            for (int j = 0; j < 4; ++j) o8[64 * j] = 0ull;
            continue; }
        const float* src = m < MP ? a.in[0] + (size_t)m * DM : (m < MVALID ? a.in[1] + (size_t)(m - MP) * DM : a.in[10] + (size_t)(m - MT) * DM);
        const GAS f32x4* xr = (const GAS f32x4*)src + lane; f32x4 v[4]; float s = 0.f;
#pragma unroll
        for (int j = 0; j < 4; ++j) { v[j] = xr[64 * j]; s += (v[j].x * v[j].x + v[j].y * v[j].y) + (v[j].z * v[j].z + v[j].w * v[j].w); }
        s = wave_sum_fast(s);
#pragma unroll
        for (int j = 0; j < 4; ++j) o8[64 * j] = (u64)pk2(v[j].x, v[j].y) | ((u64)pk2(v[j].z, v[j].w) << 32);
        if (m < MVALID && lane == 0) ss0[m] = s;
    }
}

__device__ __forceinline__ void memattn_unit(Ctx& c, const bf16* Zq  , int ldz, int nrows_valid, const float* Kp, const float* Vp, int kstride,
                                             bool normk, const float* kgain, const float* qgain, bf16* Out  ) {
    LAS bf16* KN = (LAS bf16*)(c.lds);
    LAS bf16* VTm = (LAS bf16*)(c.lds + 36864);
    LAS bf16* QN = (LAS bf16*)(c.lds + 70656) + c.wave * (32 * 72);
    LAS float* LI = (LAS float*)(c.lds + 107520) + c.wave * 32;
    int tid = c.tid; asm volatile("" : "+v"(tid));
    const int lane = tid & 63, w = c.wave;
    {
        const int m = tid >> 1, dh = (tid & 1) * 32;
        f32x4 kv[8]; float s = 0.f;
#pragma unroll
        for (int j = 0; j < 8; ++j) { kv[j] = *(const f32x4*)(Kp + (size_t)m * kstride + dh + 4 * j); s += (kv[j].x * kv[j].x + kv[j].y * kv[j].y) + (kv[j].z * kv[j].z + kv[j].w * kv[j].w); }
        s += __shfl_xor(s, 1);
        const float rs = normk ? rsqrtf(s * (1.0f / 64.0f) + EPS) : 1.0f;
#pragma unroll
        for (int j = 0; j < 8; j += 2) { f32x4 g0 = {1.f, 1.f, 1.f, 1.f}, g1 = g0;
            if (normk) { g0 = *(const f32x4*)(kgain + dh + 4 * j); g1 = *(const f32x4*)(kgain + dh + 4 * j + 4); }
            const f32x4 x0 = kv[j] * rs * g0, x1 = kv[j + 1] * rs * g1;
            v4u o; o.x = pk2(x0.x, x0.y); o.y = pk2(x0.z, x0.w); o.z = pk2(x1.x, x1.y); o.w = pk2(x1.z, x1.w);
            *(LAS v4u*)(KN + m * 72 + dh + 4 * j) = o; }
#pragma unroll
        for (int j = 0; j < 8; ++j) { const f32x4 vv = *(const f32x4*)(Vp + (size_t)m * kstride + dh + 4 * j);
            VTm[(dh + 4 * j + 0) * 264 + m] = (bf16)f2bf(vv.x); VTm[(dh + 4 * j + 1) * 264 + m] = (bf16)f2bf(vv.y);
            VTm[(dh + 4 * j + 2) * 264 + m] = (bf16)f2bf(vv.z); VTm[(dh + 4 * j + 3) * 264 + m] = (bf16)f2bf(vv.w); }
    }
    {
        const int row = lane >> 1, hf = lane & 1, grow = w * 32 + row;
        float x[32]; float s = 0.f;
        if (grow < nrows_valid) {
#pragma unroll
            for (int j = 0; j < 4; ++j) { const v4u q = *(const v4u*)(Zq + (size_t)grow * ldz + hf * 32 + 8 * j);
                x[8 * j + 0] = bf2f(q.x & 0xffffu); x[8 * j + 1] = bf2f(q.x >> 16); x[8 * j + 2] = bf2f(q.y & 0xffffu); x[8 * j + 3] = bf2f(q.y >> 16);
                x[8 * j + 4] = bf2f(q.z & 0xffffu); x[8 * j + 5] = bf2f(q.z >> 16); x[8 * j + 6] = bf2f(q.w & 0xffffu); x[8 * j + 7] = bf2f(q.w >> 16); }
        } else {
#pragma unroll
            for (int j = 0; j < 32; ++j) x[j] = 0.f;
        }
#pragma unroll
        for (int j = 0; j < 32; ++j) s += x[j] * x[j];
        s += __shfl_xor(s, 1);
        const float rs = rsqrtf(s * (1.0f / 64.0f) + EPS) * 0.125f;
#pragma unroll
        for (int j = 0; j < 32; j += 8) { v4u o;
            o.x = pk2(x[j] * rs * qgain[hf * 32 + j], x[j + 1] * rs * qgain[hf * 32 + j + 1]); o.y = pk2(x[j + 2] * rs * qgain[hf * 32 + j + 2], x[j + 3] * rs * qgain[hf * 32 + j + 3]);
            o.z = pk2(x[j + 4] * rs * qgain[hf * 32 + j + 4], x[j + 5] * rs * qgain[hf * 32 + j + 5]); o.w = pk2(x[j + 6] * rs * qgain[hf * 32 + j + 6], x[j + 7] * rs * qgain[hf * 32 + j + 7]);
            *(LAS v4u*)(QN + row * 72 + hf * 32 + j) = o; }
    }
    __syncthreads();
    if (w * 32 < nrows_valid) {
        const int r32 = lane & 31, hh = lane >> 5;
        f32x16 s[8];
#pragma unroll
        for (int mt = 0; mt < 8; ++mt) { f32x16 z = {}; s[mt] = mm32<64>(KN + mt * 32 * 72, 72, QN, 72, z, lane); }
        float mx = -1e30f;
#pragma unroll
        for (int mt = 0; mt < 8; ++mt)
#pragma unroll
            for (int r = 0; r < 16; ++r) mx = fmaxf(mx, s[mt][r]);
        mx = fmaxf(mx, __shfl_xor(mx, 32));
        float l = 0.f;
#pragma unroll
        for (int mt = 0; mt < 8; ++mt)
#pragma unroll
            for (int r = 0; r < 16; ++r) { const float p = __expf(s[mt][r] - mx); s[mt][r] = p; l += p; }
        l += __shfl_xor(l, 32);
        if (hh == 0) LI[r32] = l;
        f32x16 o[2] = {};
#pragma unroll
        for (int mt = 0; mt < 8; ++mt)
#pragma unroll
            for (int sx = 0; sx < 2; ++sx) {
                v4u pa; pa.x = pk2(s[mt][8 * sx + 0], s[mt][8 * sx + 1]); pa.y = pk2(s[mt][8 * sx + 2], s[mt][8 * sx + 3]);
                pa.z = pk2(s[mt][8 * sx + 4], s[mt][8 * sx + 5]); pa.w = pk2(s[mt][8 * sx + 6], s[mt][8 * sx + 7]);
                const bf16x8 af = __builtin_bit_cast(bf16x8, pa);
#pragma unroll
                for (int dt = 0; dt < 2; ++dt) { const LAS bf16* vp = VTm + (dt * 32 + r32) * 264 + mt * 32 + 16 * sx + 4 * hh;
                    const u64 lo = *(const LAS u64*)vp, hi = *(const LAS u64*)(vp + 8);
                    v4u bw; bw.x = (unsigned)lo; bw.y = (unsigned)(lo >> 32); bw.z = (unsigned)hi; bw.w = (unsigned)(hi >> 32);
                    o[dt] = __builtin_amdgcn_mfma_f32_32x32x16_bf16(af, __builtin_bit_cast(bf16x8, bw), o[dt], 0, 0, 0); }
            }
        LDS_WAIT();
#pragma unroll
        for (int r = 0; r < 16; ++r) { const int qr = crow(r, hh), grow = w * 32 + qr; const float il = __builtin_amdgcn_rcpf(LI[qr]);
            if (grow < nrows_valid) {
#pragma unroll
                for (int dt = 0; dt < 2; ++dt) Out[(size_t)grow * DM + dt * 32 + r32] = (bf16)f2bf(o[dt][r] * il); } }
    }
}

constexpr int HG_GS = 4, HG_NG = SEQ / (32 * HG_GS);
constexpr size_t WS_HOL = WS_U, WS_HQC = WS_UP, WS_HUT = WS_ACT, WS_HST = WS_ACT + 64 * MiB, WS_HDG = WS_ACT + 50 * MiB;
template <bool PROMPT>
__device__ __forceinline__ void hgrn_unit(Ctx& c, ARGREF a, int b, int h, int g) {
    LAS unsigned char* L = c.lds;
    LAS float* LFt = (LAS float*)(L + 0);
    LAS float* OB = (LAS float*)(L + 0);
    LAS float* SEG = (LAS float*)(L + 16896);
    LAS float* DVv = (LAS float*)(L + 18944);
    LAS bf16* QD = (LAS bf16*)(L + 19456);
    LAS bf16* KD = (LAS bf16*)(L + 28160);
    LAS bf16* KET = (LAS bf16*)(L + 36864);
    LAS bf16* VT = (LAS bf16*)(L + 47104);
    LAS bf16* SCB = (LAS bf16*)(L + 57344);
    LAS bf16* STt = (LAS bf16*)(L + 59904);
    LAS float* BOFF = (LAS float*)(L + 94720);
    int tid = c.tid; asm volatile("" : "+v"(tid));
    const int lane = tid & 63, w = c.wave, r32 = lane & 31, hh = lane >> 5;
    const int te = tid & 31, k8 = (tid >> 5) * 8;
    const int tf = tid >> 4, v8 = (tid & 15) * 8;
    const bf16* Z = (const bf16*)(a.ws + WS_Z);
    bf16* MIX = (bf16*)(a.ws + WS_MIX);
    const int nch = PROMPT ? HG_GS : 1, nvalid = PROMPT ? 32 : 4;
    const int kt = w >> 1, vt0 = 2 * (w & 1);
    const int unit = (b * 6 + h) * HG_NG + g;
    f32x16 S0 = {}, S1 = {};
    if (!PROMPT) { const float* sp = a.in[7] + (size_t)(b * 6 + h) * 16384;
#pragma unroll
        for (int r = 0; r < 16; ++r) { const int k = 32 * kt + crow(r, hh); S0[r] = sp[k * 128 + 32 * vt0 + r32]; S1[r] = sp[k * 128 + 32 * (vt0 + 1) + r32]; } }
    float lbv[8];
#pragma unroll
    for (int j = 0; j < 8; ++j) { const float l0 = a.in[14][h * 128 + k8 + j], l1 = a.in[14][768 + h * 128 + k8 + j]; lbv[j] = 1.0f / (1.0f + __expf(l1 - l0)); }
    __syncthreads();
    if (tid < 128) BOFF[tid] = 0.f;
#define HG_WRITE_ST() do { _Pragma("unroll") for (int g4 = 0; g4 < 4; ++g4) { const int k0 = 32 * kt + 8 * g4 + 4 * hh; \
        *(LAS u64*)(STt + (32 * vt0 + r32) * 136 + k0) = (u64)pk2(S0[4 * g4], S0[4 * g4 + 1]) | ((u64)pk2(S0[4 * g4 + 2], S0[4 * g4 + 3]) << 32); \
        *(LAS u64*)(STt + (32 * (vt0 + 1) + r32) * 136 + k0) = (u64)pk2(S1[4 * g4], S1[4 * g4 + 1]) | ((u64)pk2(S1[4 * g4 + 2], S1[4 * g4 + 3]) << 32); } } while (0)
    HG_WRITE_ST();
    v4u zq = {0u, 0u, 0u, 0u}, zf = zq, zi = zq;
    { const int row = (PROMPT ? b * SEQ + (g * HG_GS) * 32 : MP + 4 * b) + te;
      if (te < nvalid) { const bf16* zr = Z + (size_t)row * ZC0 + h * 128 + k8; zq = *(const v4u*)zr; zf = *(const v4u*)(zr + 768); zi = *(const v4u*)(zr + 1536); } }
#pragma unroll 1
    for (int ch = 0; ch < nch; ++ch) {
        const int row0 = PROMPT ? b * SEQ + (g * HG_GS + ch) * 32 : MP + 4 * b, row = row0 + te;
        const bool valid = te < nvalid;
        float qs[8], kk[8];
        {
            const unsigned qw[4] = {zq.x, zq.y, zq.z, zq.w}, fw[4] = {zf.x, zf.y, zf.z, zf.w}, iw[4] = {zi.x, zi.y, zi.z, zi.w};
#pragma unroll
            for (int j = 0; j < 8; ++j) { const float q = bf2f((qw[j >> 1] >> (16 * (j & 1))) & 0xffffu), fp = bf2f((fw[j >> 1] >> (16 * (j & 1))) & 0xffffu);
                const float sg = sigmoidf_(fp), f = lbv[j] + (1.0f - lbv[j]) * sg;
                qs[j] = valid ? q * sigmoidf_(q) : 0.f; kk[j] = valid ? (1.0f - f) : 0.f;
                LFt[(k8 + j) * 33 + te] = valid ? __logf(f) : 0.f;
                VT[(k8 + j) * 40 + te] = (bf16)((iw[j >> 1] >> (16 * (j & 1))) & 0xffffu); }
            if (PROMPT && ch + 1 < nch) { const bf16* zr = Z + (size_t)(row + 32) * ZC0 + h * 128 + k8; zq = *(const v4u*)zr; zf = *(const v4u*)(zr + 768); zi = *(const v4u*)(zr + 1536); }
        }
        __syncthreads();
        {
            const int k = tid & 127, sg_ = tid >> 7; float bsum = 0.f;
#pragma unroll
            for (int i = 0; i < 8; ++i) { bsum += LFt[k * 33 + 8 * sg_ + i]; LFt[k * 33 + 8 * sg_ + i] = bsum; }
            SEG[sg_ * 128 + k] = bsum; }
        __syncthreads();
        {
            float bb[8], bl[8];
            { f32x4 t0[4], t1[4];
#pragma unroll
              for (int s_ = 0; s_ < 4; ++s_) { t0[s_] = *(const LAS f32x4*)(SEG + s_ * 128 + k8); t1[s_] = *(const LAS f32x4*)(SEG + s_ * 128 + k8 + 4); }
              const int sgt = te >> 3; f32x4 o0 = {0.f, 0.f, 0.f, 0.f}, o1 = o0;
#pragma unroll
              for (int s_ = 0; s_ < 3; ++s_) if (s_ < sgt) { o0 += t0[s_]; o1 += t1[s_]; }
              const f32x4 l0 = (t0[0] + t0[1]) + (t0[2] + t0[3]), l1 = (t1[0] + t1[1]) + (t1[2] + t1[3]);
              const float of[8] = {o0.x, o0.y, o0.z, o0.w, o1.x, o1.y, o1.z, o1.w}; const float lt[8] = {l0.x, l0.y, l0.z, l0.w, l1.x, l1.y, l1.z, l1.w};
#pragma unroll
              for (int j = 0; j < 8; ++j) { bb[j] = LFt[(k8 + j) * 33 + te] + of[j]; bl[j] = lt[j]; } }
            float qd[8], kd[8];
#pragma unroll
            for (int j = 0; j < 8; ++j) { qd[j] = qs[j] * __expf(bb[j]); kd[j] = kk[j] * __expf(-bb[j]); KET[(k8 + j) * 40 + te] = (bf16)f2bf(kk[j] * __expf(bl[j] - bb[j])); }
            v4u o; o.x = pk2(qd[0], qd[1]); o.y = pk2(qd[2], qd[3]); o.z = pk2(qd[4], qd[5]); o.w = pk2(qd[6], qd[7]); *(LAS v4u*)(QD + te * 136 + k8) = o;
            if (PROMPT) { const f32x4 f0 = *(const LAS f32x4*)(BOFF + k8), f1 = *(const LAS f32x4*)(BOFF + k8 + 4);
                const float bo[8] = {f0.x, f0.y, f0.z, f0.w, f1.x, f1.y, f1.z, f1.w}; float qc[8];
#pragma unroll
                for (int j = 0; j < 8; ++j) qc[j] = qd[j] * __expf(bo[j]);
                v4u oc; oc.x = pk2(qc[0], qc[1]); oc.y = pk2(qc[2], qc[3]); oc.z = pk2(qc[4], qc[5]); oc.w = pk2(qc[6], qc[7]);
                *(v4u*)((bf16*)(a.ws + WS_HQC) + (size_t)row * 768 + h * 128 + k8) = oc; }
            o.x = pk2(kd[0], kd[1]); o.y = pk2(kd[2], kd[3]); o.z = pk2(kd[4], kd[5]); o.w = pk2(kd[6], kd[7]); *(LAS v4u*)(KD + te * 136 + k8) = o;
            if (te == 0) {
#pragma unroll
                for (int j = 0; j < 8; ++j) DVv[k8 + j] = __expf(bl[j]); }
        }
        __syncthreads();
        f32x16 oacc = {};
        if (w == 4) { f32x16 z = {}; const f32x16 sc = mm32<128>(QD, 136, KD, 136, z, lane);
#pragma unroll
            for (int r = 0; r < 16; ++r) { const int t = crow(r, hh); SCB[t * 40 + r32] = (bf16)f2bf(r32 <= t ? sc[r] : 0.f); } }
        if (w < 4) oacc = mm32<128>(QD, 136, STt + (w * 32) * 136, 136, oacc, lane);
        if (PROMPT && tid >= 384) { const int k = tid - 384; BOFF[k] += (SEG[k] + SEG[128 + k]) + (SEG[256 + k] + SEG[384 + k]); }
        __syncthreads();
        if (w < 4) { oacc = mm32<32>(SCB, 40, VT + (w * 32) * 40, 40, oacc, lane);
#pragma unroll
            for (int r = 0; r < 16; ++r) OB[crow(r, hh) * 128 + w * 32 + r32] = oacc[r]; }
        {
#pragma unroll
            for (int r = 0; r < 16; ++r) { const float d = DVv[32 * kt + crow(r, hh)]; S0[r] *= d; S1[r] *= d; }
            S0 = mm32<32>(KET + (kt * 32) * 40, 40, VT + (vt0 * 32) * 40, 40, S0, lane);
            S1 = mm32<32>(KET + (kt * 32) * 40, 40, VT + ((vt0 + 1) * 32) * 40, 40, S1, lane);
        }
        __syncthreads();
        HG_WRITE_ST();
        {
            const int orow = row0 + tf;
            const f32x4 o0 = *(const LAS f32x4*)(OB + tf * 128 + v8), o1 = *(const LAS f32x4*)(OB + tf * 128 + v8 + 4);
            if (PROMPT) { float* ol = (float*)(a.ws + WS_HOL) + (size_t)orow * 768 + h * 128 + v8; *(f32x4*)ol = o0; *(f32x4*)(ol + 4) = o1; }
            else {
                float ov[8] = {o0.x, o0.y, o0.z, o0.w, o1.x, o1.y, o1.z, o1.w}; float s = 0.f;
#pragma unroll
                for (int j = 0; j < 8; ++j) s += ov[j] * ov[j];
                s += __shfl_xor(s, 1); s += __shfl_xor(s, 2); s += __shfl_xor(s, 4); s += __shfl_xor(s, 8);
                const float rs = rsqrtf(s * (1.0f / 128.0f) + EPS);
                if (tf < nvalid) { const v4u gz = *(const v4u*)(Z + (size_t)orow * ZC0 + 2304 + h * 128 + v8); const unsigned gw_[4] = {gz.x, gz.y, gz.z, gz.w}; float y[8];
#pragma unroll
                    for (int j = 0; j < 8; ++j) { const float gg = bf2f((gw_[j >> 1] >> (16 * (j & 1))) & 0xffffu); y[j] = ov[j] * rs * a.in[15][v8 + j] * (gg * sigmoidf_(gg)); }
                    v4u o; o.x = pk2(y[0], y[1]); o.y = pk2(y[2], y[3]); o.z = pk2(y[4], y[5]); o.w = pk2(y[6], y[7]); *(v4u*)(MIX + (size_t)orow * DM + h * 128 + v8) = o; }
            }
        }
        __syncthreads();
    }
#undef HG_WRITE_ST
    if (PROMPT) {
        float* ut = (float*)(a.ws + WS_HUT) + (size_t)unit * 16384;
#pragma unroll
        for (int g4 = 0; g4 < 4; ++g4) { const int k0 = 32 * kt + 8 * g4 + 4 * hh;
            *(f32x4*)(ut + (32 * vt0 + r32) * 128 + k0) = (f32x4){S0[4 * g4], S0[4 * g4 + 1], S0[4 * g4 + 2], S0[4 * g4 + 3]};
            *(f32x4*)(ut + (32 * (vt0 + 1) + r32) * 128 + k0) = (f32x4){S1[4 * g4], S1[4 * g4 + 1], S1[4 * g4 + 2], S1[4 * g4 + 3]}; }
        if (tid < 128) ((float*)(a.ws + WS_HDG))[(size_t)unit * 128 + tid] = __expf(BOFF[tid]);
    } else {
        float* so = a.out + O_HS + (size_t)(b * 6 + h) * 16384;
#pragma unroll
        for (int r = 0; r < 16; ++r) { const int k = 32 * kt + crow(r, hh); so[k * 128 + 32 * vt0 + r32] = S0[r]; so[k * 128 + 32 * (vt0 + 1) + r32] = S1[r]; }
    }
}
__device__ __forceinline__ void hgrn_scan(Ctx& c, ARGREF a) {
    const float* UT = (const float*)(a.ws + WS_HUT); const float* DG = (const float*)(a.ws + WS_HDG); bf16* STo = (bf16*)(a.ws + WS_HST);
    for (int idx = c.vcu * 512 + c.tid; idx < 24 * 16384; idx += c.G * 512) {
        const int bh = idx >> 14, e = idx & 16383, k = e & 127, v = e >> 7;
        float s = 0.f, ut[HG_NG], dg[HG_NG];
#pragma unroll
        for (int g = 0; g < HG_NG; ++g) { const size_t u = (size_t)(bh * HG_NG + g); ut[g] = UT[u * 16384 + e]; dg[g] = DG[u * 128 + k]; }
#pragma unroll
        for (int g = 0; g < HG_NG; ++g) { const size_t u = (size_t)(bh * HG_NG + g); STo[u * 16384 + e] = (bf16)f2bf(s); s = dg[g] * s + ut[g]; }
        a.out[O_HP + (size_t)bh * 16384 + k * 128 + v] = s;
    }
}
__device__ __forceinline__ void hgrn_fix_unit(Ctx& c, ARGREF a, int b, int h, int g) {
    LAS bf16* STt = (LAS bf16*)(c.lds);
    LAS bf16* QCl = (LAS bf16*)(c.lds + 34816);
    LAS float* OB = (LAS float*)(c.lds + 34816 + 17408);
    int tid = c.tid; asm volatile("" : "+v"(tid));
    const int lane = tid & 63, w = c.wave, r32 = lane & 31, hh = lane >> 5;
    const int unit = (b * 6 + h) * HG_NG + g, row0 = b * SEQ + g * 128;
    const bf16* Z = (const bf16*)(a.ws + WS_Z); bf16* MIX = (bf16*)(a.ws + WS_MIX);
    const bf16* QC = (const bf16*)(a.ws + WS_HQC); const float* OL = (const float*)(a.ws + WS_HOL);
    const bf16* stg = (const bf16*)(a.ws + WS_HST) + (size_t)unit * 16384;
    __syncthreads();
#pragma unroll
    for (int i = 0; i < 4; ++i) { const int cidx = tid + 512 * i, v = cidx >> 4, kc = (cidx & 15) * 8; *(LAS v4u*)(STt + v * 136 + kc) = *(const v4u*)(stg + v * 128 + kc); }
    const int te = tid >> 4, k8 = (tid & 15) * 8;
    float onv[8];
#pragma unroll
    for (int j = 0; j < 8; ++j) onv[j] = a.in[15][k8 + j];
#pragma unroll 1
    for (int hf = 0; hf < 2; ++hf) {
        const int rb = row0 + hf * 64;
#pragma unroll
        for (int i = 0; i < 2; ++i) { const int cidx = tid + 512 * i, r = cidx >> 4, kc = (cidx & 15) * 8; *(LAS v4u*)(QCl + r * 136 + kc) = *(const v4u*)(QC + (size_t)(rb + r) * 768 + h * 128 + kc); }
        f32x4 pl0[2], pl1[2]; v4u pgz[2];
#pragma unroll
        for (int ps = 0; ps < 2; ++ps) { const int row = rb + ps * 32 + te; const float* ol = OL + (size_t)row * 768 + h * 128 + k8; pl0[ps] = *(const f32x4*)ol; pl1[ps] = *(const f32x4*)(ol + 4);
            pgz[ps] = *(const v4u*)(Z + (size_t)row * ZC0 + 2304 + h * 128 + k8); }
        __syncthreads();
        { const int rt = w >> 2, vt = w & 3; f32x16 o = {};
          o = mm32<128>(QCl + (rt * 32) * 136, 136, STt + (vt * 32) * 136, 136, o, lane);
#pragma unroll
          for (int r = 0; r < 16; ++r) OB[(rt * 32 + crow(r, hh)) * 128 + vt * 32 + r32] = o[r]; }
        __syncthreads();
#pragma unroll
        for (int ps = 0; ps < 2; ++ps) { const int r = ps * 32 + te, row = rb + r;
            const f32x4 c0 = *(const LAS f32x4*)(OB + r * 128 + k8), c1 = *(const LAS f32x4*)(OB + r * 128 + k8 + 4);
            const f32x4 l0 = pl0[ps], l1 = pl1[ps]; const v4u gz = pgz[ps];
            float ov[8] = {c0.x + l0.x, c0.y + l0.y, c0.z + l0.z, c0.w + l0.w, c1.x + l1.x, c1.y + l1.y, c1.z + l1.z, c1.w + l1.w}; float s = 0.f;
#pragma unroll
            for (int j = 0; j < 8; ++j) s += ov[j] * ov[j];
            s += __shfl_xor(s, 1); s += __shfl_xor(s, 2); s += __shfl_xor(s, 4); s += __shfl_xor(s, 8);
            const float rs = rsqrtf(s * (1.0f / 128.0f) + EPS);
            const unsigned gw_[4] = {gz.x, gz.y, gz.z, gz.w}; float y[8];
#pragma unroll
            for (int j = 0; j < 8; ++j) { const float gg = bf2f((gw_[j >> 1] >> (16 * (j & 1))) & 0xffffu); y[j] = ov[j] * rs * onv[j] * (gg * sigmoidf_(gg)); }
            v4u o; o.x = pk2(y[0], y[1]); o.y = pk2(y[2], y[3]); o.z = pk2(y[4], y[5]); o.w = pk2(y[6], y[7]); *(v4u*)(MIX + (size_t)row * DM + h * 128 + k8) = o; }
        __syncthreads();
    }
}

__device__ __forceinline__ void memkv_finalize_row(ARGREF a, int layer, int row, int lane) {
    const float* src = (const float*)(a.ws + WS_MEMKV) + (size_t)row * 1024 + layer * 512;
    const int hd = lane >> 4, d4 = (lane & 15) * 4;
    const f32x4 k = *(const f32x4*)(src + hd * 64 + d4), v = *(const f32x4*)(src + 256 + hd * 64 + d4);
    float s = (k.x * k.x + k.y * k.y) + (k.z * k.z + k.w * k.w);
    s += __shfl_xor(s, 1); s += __shfl_xor(s, 2); s += __shfl_xor(s, 4); s += __shfl_xor(s, 8);
    const float rs = rsqrtf(s * (1.0f / 64.0f) + EPS); const f32x4 g = *(const f32x4*)(a.in[22] + layer * 64 + d4);
    *(f32x4*)(a.out + O_MK + ((size_t)layer * 1024 + row) * 256 + hd * 64 + d4) = k * rs * g;
    *(f32x4*)(a.out + O_MV + ((size_t)layer * 1024 + row) * 256 + hd * 64 + d4) = v;
}

__device__ __forceinline__ void memattn_prompt_unit(Ctx& c, ARGREF a, int layer, int u) {
    const int blk = u & 15, hd = (u >> 4) & 3, b = u >> 6;
    const bf16* Z = (const bf16*)(a.ws + WS_Z); const int ldz = layer ? ZC1 : ZC0, qc = layer ? Z1_MQ : 3072;
    const float* kv = (const float*)(a.ws + WS_MEMKV) + (size_t)(b * 256) * 1024 + layer * 512 + hd * 64;
    const int row0 = b * SEQ + blk * 256;
    memattn_unit(c, Z + (size_t)row0 * ldz + qc + hd * 64, ldz, 256, kv, kv + 256, 1024, true, a.in[22] + layer * 64, a.in[21] + layer * 64,
                 (bf16*)(a.ws + WS_MIX) + (size_t)row0 * DM + 768 + hd * 64);
}
__device__ __forceinline__ void memattn_sample_unit(Ctx& c, ARGREF a, int layer, int u) {
    const int hd = u & 3, sb = u >> 2;
    const bf16* Z = (const bf16*)(a.ws + WS_Z); const int ldz = layer ? ZC1 : ZC0, qc = layer ? Z1_MQ : 3072;
    const size_t off = ((size_t)(layer * 32 + sb) * 256) * 256 + hd * 64;
    const int row0 = MP + sb * 4;
    memattn_unit(c, Z + (size_t)row0 * ldz + qc + hd * 64, ldz, 4, a.in[5] + off, a.in[6] + off, 256, false, nullptr, a.in[21] + layer * 64,
                 (bf16*)(a.ws + WS_MIX) + (size_t)row0 * DM + 768 + hd * 64);
}

__device__ __forceinline__ void p2_mixer0(Ctx& c, ARGREF a) {
    constexpr int U_HP = 24 * HG_NG, U_MAP = U_HP + 256, U_HS = U_MAP + 192, U_MAS = U_HS + 128, U_FIN = U_MAS + 256;
    for (;;) {
        const int u = q_next(c, 0);
        if (u >= U_FIN) break;
        if (u < U_HP) hgrn_unit<true>(c, a, u / (6 * HG_NG), (u / HG_NG) % 6, u % HG_NG);
        else if (u < U_MAP) memattn_prompt_unit(c, a, 0, u - U_HP);
        else if (u < U_HS) { const int v = u - U_MAP; hgrn_unit<false>(c, a, v / 6, v % 6, 0); }
        else if (u < U_MAS) memattn_sample_unit(c, a, 0, u - U_HS);
        else { const int v = (u - U_MAS) * 8 + c.wave; memkv_finalize_row(a, v >> 10, v & 1023, c.lane); }
    }
}
__device__ __forceinline__ void p2c_hgrn_fix(Ctx& c, ARGREF a) {
    for (int u = c.vcu; u < 24 * HG_NG; u += c.G) hgrn_fix_unit(c, a, u / (6 * HG_NG), (u / HG_NG) % 6, u % HG_NG);
}

constexpr size_t WS_G4 = WS_UP + 64 * MiB, WS_UP2 = WS_UP + 80 * MiB;
__device__ __forceinline__ void conv_fixup_tile(Ctx& c, ARGREF a, int layer, int pm) {
    const float* G4 = (const float*)(a.ws + WS_G4); const float* UP2 = (const float*)(a.ws + WS_UP2); bf16* ACT = (bf16*)(a.ws + WS_ACT);
    const float* cw = a.in[26] + (size_t)layer * 3 * DFF; const float* cb = a.in[27] + (size_t)layer * DFF;
    for (int idx = c.tid; idx < 8 * (DFF / 4); idx += 512) {
        const int rr = idx / (DFF / 4), c4 = (idx - rr * (DFF / 4)) * 4;
        const int slab = 4 * pm + (rr >> 1), fr = rr & 1, row = slab * 64 + fr, t = row & 4095, sl1 = slab > 0 ? slab - 1 : 0;
        const f32x4 ut = *(const f32x4*)(G4 + (size_t)(slab * 4 + fr) * DFF + c4), up = *(const f32x4*)(UP2 + (size_t)(slab * 2 + fr) * DFF + c4);
        const f32x4 a0 = *(const f32x4*)(G4 + (size_t)(slab * 4 + 0) * DFF + c4), b3 = *(const f32x4*)(G4 + (size_t)(sl1 * 4 + 3) * DFF + c4), b2 = *(const f32x4*)(G4 + (size_t)(sl1 * 4 + 2) * DFF + c4);
        f32x4 u1, u2;
        { const bool f1 = fr == 1, t0 = t == 0, t1 = t == 1;
          u1.x = f1 ? a0.x : (t0 ? 0.f : b3.x); u1.y = f1 ? a0.y : (t0 ? 0.f : b3.y); u1.z = f1 ? a0.z : (t0 ? 0.f : b3.z); u1.w = f1 ? a0.w : (t0 ? 0.f : b3.w);
          u2.x = f1 ? (t1 ? 0.f : b3.x) : (t0 ? 0.f : b2.x); u2.y = f1 ? (t1 ? 0.f : b3.y) : (t0 ? 0.f : b2.y); u2.z = f1 ? (t1 ? 0.f : b3.z) : (t0 ? 0.f : b2.z); u2.w = f1 ? (t1 ? 0.f : b3.w) : (t0 ? 0.f : b2.w); }
        const f32x4 w0 = *(const f32x4*)(cw + c4), w1 = *(const f32x4*)(cw + DFF + c4), w2 = *(const f32x4*)(cw + 2 * DFF + c4), bb = *(const f32x4*)(cb + c4);
        const f32x4 cv = bb + w0 * u2 + w1 * u1 + w2 * ut;
        const float y0 = cv.x * sigmoidf_(cv.x) * up.x, y1 = cv.y * sigmoidf_(cv.y) * up.y, y2 = cv.z * sigmoidf_(cv.z) * up.z, y3 = cv.w * sigmoidf_(cv.w) * up.w;
        *(u64*)(ACT + (size_t)row * DFF + c4) = (u64)pk2(y0, y1) | ((u64)pk2(y2, y3) << 32);
    }
}


struct SgArgs { const bf16* A; const bf16* Bt; int K; int mode; bf16* Z; int ldz; const float* ssin; const float* resid; const bf16* rb; float* y; bf16* xb; float* ssout; bf16* ACT; float* cvs; const float* cst; const float* cw; const float* cb; };
__device__ __forceinline__ void sgemm_unit(Ctx& c, const SgArgs& g, int n0) {
    int tid = c.tid; asm volatile("" : "+v"(tid));
    const int lane = tid & 63, w = c.wave, r32 = lane & 31, hh = lane >> 5;
    const int K = g.K, ks = K >> 3;
    const int f2 = (n0 >> 1) + (r32 & 15), brow = g.mode == 2 ? (f2 >> 7) * 256 + (f2 & 127) + (r32 >= 16 ? 128 : 0) : n0 + r32;
    const bf16* bp = g.Bt + (size_t)brow * K + w * ks + 8 * hh;
    const bf16* ap = g.A + (size_t)r32 * K + w * ks + 8 * hh;
    f32x16 acc[4] = {};
    bf16x8 afA[4][2], bfA[2], afB[4][2], bfB[2];
#define SG_LOAD(AF, BF, kk) do { _Pragma("unroll") for (int i = 0; i < 2; ++i) { BF[i] = *(const bf16x8*)(bp + (kk) + 16 * i); \
        _Pragma("unroll") for (int rt = 0; rt < 4; ++rt) AF[rt][i] = *(const bf16x8*)(ap + (size_t)(rt * 32) * K + (kk) + 16 * i); } } while (0)
#define SG_MMA(AF, BF) do { _Pragma("unroll") for (int i = 0; i < 2; ++i) _Pragma("unroll") for (int rt = 0; rt < 4; ++rt) acc[rt] = __builtin_amdgcn_mfma_f32_32x32x16_bf16(AF[rt][i], BF[i], acc[rt], 0, 0, 0); } while (0)
    SG_LOAD(afA, bfA, 0);
#pragma unroll 1
    for (int k = 0; k < ks; k += 64) {
        if (k + 32 < ks) SG_LOAD(afB, bfB, k + 32);
        SG_MMA(afA, bfA);
        if (k + 32 < ks) { if (k + 64 < ks) SG_LOAD(afA, bfA, k + 64); SG_MMA(afB, bfB); }
    }
#undef SG_LOAD
#undef SG_MMA
    LAS float* RED = (LAS float*)(c.lds);
    __syncthreads();
#pragma unroll
    for (int rt = 0; rt < 4; ++rt)
#pragma unroll
        for (int r = 0; r < 16; ++r) RED[((w * 4 + rt) * 16 + r) * 64 + lane] = acc[rt][r];
    __syncthreads();
    const int rt = w & 3, rh = w >> 2, col = n0 + r32;
    float v[8];
#pragma unroll
    for (int i = 0; i < 8; ++i) { float s = 0.f;
#pragma unroll
        for (int ww = 0; ww < 8; ++ww) s += RED[((ww * 4 + rt) * 16 + 8 * rh + i) * 64 + lane];
        v[i] = s; }
    if (g.mode == 0) {
#pragma unroll
        for (int i = 0; i < 8; ++i) { const int row = MP + rt * 32 + crow(8 * rh + i, hh); const float rs = rsqrtf(g.ssin[row] * (1.0f / DM) + EPS); g.Z[(size_t)row * g.ldz + col] = (bf16)f2bf(v[i] * rs); }
    } else if (g.mode == 1) {
#pragma unroll
        for (int i = 0; i < 8; ++i) { const int lr = rt * 32 + crow(8 * rh + i, hh), row = MP + lr;
            const float x = v[i] + (g.resid ? g.resid[(size_t)lr * DM + col] : bf2f(g.rb[(size_t)row * DM + col]));
            if (g.y) g.y[(size_t)lr * DM + col] = x; if (g.xb) g.xb[(size_t)row * DM + col] = (bf16)f2bf(x);
            float s = x * x; s += __shfl_xor(s, 1); s += __shfl_xor(s, 2); s += __shfl_xor(s, 4); s += __shfl_xor(s, 8); s += __shfl_xor(s, 16);
            if (g.ssout && r32 == 0) atomicAdd(g.ssout + row, s); }
    } else {
        float gu[8], upv[8];
#pragma unroll
        for (int i = 0; i < 8; ++i) { const int row = MP + rt * 32 + crow(8 * rh + i, hh); gu[i] = v[i] * rsqrtf(g.ssin[row] * (1.0f / DM) + EPS); upv[i] = __shfl_xor(gu[i], 16); }
        if (r32 < 16) { const float w0 = g.cw[f2], w1 = g.cw[DFF + f2], w2 = g.cw[2 * DFF + f2], bb = g.cb[f2];
#pragma unroll
            for (int aa = 0; aa < 2; ++aa) { const int lr0 = rt * 32 + 8 * (2 * rh + aa) + 4 * hh, sb = lr0 >> 2;
                const float s0 = g.cst[(size_t)(sb * 2) * DFF + f2], s1 = g.cst[(size_t)(sb * 2 + 1) * DFF + f2];
                const float u0 = gu[4 * aa], u1 = gu[4 * aa + 1], u2 = gu[4 * aa + 2], u3 = gu[4 * aa + 3];
                const float cv[4] = {bb + w0 * s0 + w1 * s1 + w2 * u0, bb + w0 * s1 + w1 * u0 + w2 * u1, bb + w0 * u0 + w1 * u1 + w2 * u2, bb + w0 * u1 + w1 * u2 + w2 * u3};
#pragma unroll
                for (int t = 0; t < 4; ++t) g.ACT[(size_t)(MP + lr0 + t) * DFF + f2] = (bf16)f2bf(cv[t] * sigmoidf_(cv[t]) * upv[4 * aa + t]);
                g.cvs[(size_t)(sb * 2) * DFF + f2] = u2; g.cvs[(size_t)(sb * 2 + 1) * DFF + f2] = u3; } }
    }
}
__device__ __forceinline__ void sgemm_phase(Ctx& c, const SgArgs& g, int N) {
#pragma unroll 1
    for (int u = c.G - 1 - (int)blockIdx.x; u < N / 32; u += c.G) sgemm_unit(c, g, u * 32);
}


__device__ __forceinline__ float wave_sum_f(float x) {
    x += __builtin_bit_cast(float, __builtin_amdgcn_update_dpp(0, __builtin_bit_cast(int, x), 0xB1, 0xF, 0xF, false));
    x += __builtin_bit_cast(float, __builtin_amdgcn_update_dpp(0, __builtin_bit_cast(int, x), 0x4E, 0xF, 0xF, false));
    x += __builtin_bit_cast(float, __builtin_amdgcn_update_dpp(0, __builtin_bit_cast(int, x), 0x141, 0xF, 0xF, false));
    x += __builtin_bit_cast(float, __builtin_amdgcn_update_dpp(0, __builtin_bit_cast(int, x), 0x140, 0xF, 0xF, false));
    const int xi = __builtin_bit_cast(int, x);
    return (__builtin_bit_cast(float, __builtin_amdgcn_readlane(xi, 0)) + __builtin_bit_cast(float, __builtin_amdgcn_readlane(xi, 16))) +
           (__builtin_bit_cast(float, __builtin_amdgcn_readlane(xi, 32)) + __builtin_bit_cast(float, __builtin_amdgcn_readlane(xi, 48)));
}
__device__ __forceinline__ void dsa_post_row(ARGREF a, int row, int lane_) {
    int lane = lane_; asm volatile("" : "+v"(lane));
    const bf16* z = (const bf16*)(a.ws + WS_Z) + (size_t)row * ZC1;
    const bool smp = row >= MP; const int b = smp ? (row - MP) >> 2 : row >> 12, t = smp ? (row - MP) & 3 : row & 4095;
    const float pos = (float)(smp ? PAST + t : t);
    const int i = lane & 31;
    float x1[8], x2[8], q1[4], q2[4], k1 = 0.f, k2 = 0.f;
#pragma unroll
    for (int hd = 0; hd < 8; ++hd) { x1[hd] = bf2f(z[hd * 128 + lane]); x2[hd] = bf2f(z[hd * 128 + 64 + lane]); }
    const u64 vv = *(const u64*)(z + Z1_V + 4 * lane);
#pragma unroll
    for (int p = 0; p < 4; ++p) { const int hd = 2 * p + (lane >> 5); q1[p] = bf2f(z[Z1_IQ + hd * 64 + i]); q2[p] = bf2f(z[Z1_IQ + hd * 64 + 32 + i]); }
    if (lane < 32) { k1 = bf2f(z[Z1_IK + i]); k2 = bf2f(z[Z1_IK + 32 + i]); }
    const float wraw = bf2f(z[Z1_IW + (lane & 7)]);
    float c128, s128, c64, s64;
    { const float r1 = pos * (exp2f(-(float)lane * (13.287712379549449f / 64.0f)) * 0.15915494309189535f), f1 = r1 - floorf(r1); s128 = __builtin_amdgcn_sinf(f1); c128 = __builtin_amdgcn_cosf(f1);
      const float r2 = pos * (exp2f(-(float)i * (13.287712379549449f / 32.0f)) * 0.15915494309189535f), f2 = r2 - floorf(r2); s64 = __builtin_amdgcn_sinf(f2); c64 = __builtin_amdgcn_cosf(f2); }
#pragma unroll
    for (int hd = 0; hd < 8; ++hd) {
        const float rs = rsqrtf(wave_sum_f(x1[hd] * x1[hd] + x2[hd] * x2[hd]) * (1.0f / 128.0f) + EPS);
        const float* gn = hd < 6 ? a.in[17] : a.in[18];
        const float y1 = x1[hd] * rs * gn[lane], y2 = x2[hd] * rs * gn[64 + lane];
        const float o1 = y1 * c128 - y2 * s128, o2 = y2 * c128 + y1 * s128;
        if (hd < 6) {
            if (smp) { float* q = (float*)(a.ws + WS_SQ) + (size_t)(row - MP) * 768 + hd * 128; q[lane] = o1; q[64 + lane] = o2; }
            else { bf16* q = (bf16*)(a.ws + WS_QB) + ((size_t)(b * 6 + hd) * SEQ + t) * 128; q[lane] = (bf16)f2bf(o1); q[64 + lane] = (bf16)f2bf(o2); }
        } else {
            const int kvh = hd - 6;
            float* ko = smp ? a.out + O_KS + (size_t)(row - MP) * 256 + kvh * 128 : a.out + O_KP + (size_t)row * 256 + kvh * 128;
            ko[lane] = o1; ko[64 + lane] = o2;
            if (!smp) { bf16* kb = (bf16*)(a.ws + WS_KB) + ((size_t)(b * 2 + kvh) * SEQ + t) * 128; kb[lane] = (bf16)f2bf(o1); kb[64 + lane] = (bf16)f2bf(o2); }
        }
    }
    {
        const f32x4 v = {bf2f((unsigned)vv & 0xffffu), bf2f(((unsigned)vv) >> 16), bf2f((unsigned)(vv >> 32) & 0xffffu), bf2f((unsigned)(vv >> 48))};
        float* vo = smp ? a.out + O_VS + (size_t)(row - MP) * 256 : a.out + O_VP + (size_t)row * 256;
        *(f32x4*)(vo + 4 * lane) = v;
        if (!smp) { const int kvh = lane >> 5, d = (lane & 31) * 4; *(u64*)((bf16*)(a.ws + WS_VB) + ((size_t)(b * 2 + kvh) * SEQ + t) * 128 + d) = vv; }
    }
    {
#pragma unroll
        for (int p = 0; p < 4; ++p) { const int hd = 2 * p + (lane >> 5);
            const float o1 = q1[p] * c64 - q2[p] * s64, o2 = q2[p] * c64 + q1[p] * s64;
            if (smp) { float* q = (float*)(a.ws + WS_SIQ) + (size_t)(row - MP) * 512 + hd * 64; q[i] = o1; q[32 + i] = o2; }
            else { bf16* q = (bf16*)(a.ws + WS_IQB) + (size_t)row * 512 + hd * 64; q[i] = (bf16)f2bf(o1); q[32 + i] = (bf16)f2bf(o2); } }
        const float rs = rsqrtf(wave_sum_f(k1 * k1 + k2 * k2) * (1.0f / 64.0f) + EPS);
        const float y1 = k1 * rs * a.in[19][i], y2 = k2 * rs * a.in[19][32 + i];
        const float o1 = y1 * c64 - y2 * s64, o2 = y2 * c64 + y1 * s64;
        if (lane < 32) {
            float* ko = smp ? a.out + O_IKS + (size_t)(row - MP) * 64 : a.out + O_IKP + (size_t)row * 64; ko[i] = o1; ko[32 + i] = o2;
            if (!smp) { bf16* kb = (bf16*)(a.ws + WS_IKB) + (size_t)row * 64; kb[i] = (bf16)f2bf(o1); kb[32 + i] = (bf16)f2bf(o2); } }
        if (lane < 8) { const float wv = wraw * (0.35355339059327373f * 0.125f);
            if (smp) ((float*)(a.ws + WS_SIW))[(row - MP) * 8 + lane] = wv; else ((float*)(a.ws + WS_IW))[(size_t)row * 8 + lane] = wv; }
    }
}
__device__ __forceinline__ void p8_dsa_post(Ctx& c, ARGREF a) {
    constexpr int NRB = (MVALID + 63) / 64;
    for (;;) { const int u = q_next(c, 1); if (u >= 384 + NRB) break;
        if (u < 256) memattn_prompt_unit(c, a, 1, u);
        else if (u < 256 + NRB) { const int r0 = (u - 256) * 64 + c.wave;
#pragma unroll 1
            for (int i = 0; i < 8; ++i) { const int row = r0 + 8 * i; if (row < MVALID) dsa_post_row(a, row, c.lane); } }
        else memattn_sample_unit(c, a, 1, u - 256 - NRB); }
}

__device__ __forceinline__ void idx_prompt_unit(Ctx& c, ARGREF a, int b, int qb) {
    int tid = c.tid; asm volatile("" : "+v"(tid));
    const int lane = tid & 63, r32 = lane & 31, hh = lane >> 5, w = c.wave;
    const int q0 = b * SEQ + qb * 32;
    LAS bf16* IQL = (LAS bf16*)(c.lds);
    { const bf16* src = (const bf16*)(a.ws + WS_IQB) + (size_t)q0 * 512;
#pragma unroll
      for (int i = 0; i < 4; ++i) { const int row = tid >> 4, ch = (tid & 15) + 16 * i; *(LAS v4u*)(IQL + row * 520 + ch * 8) = *(const v4u*)(src + (size_t)row * 512 + ch * 8); } }
    __syncthreads();
    const bf16* IK = (const bf16*)(a.ws + WS_IKB) + (size_t)(b * SEQ) * 64 + (size_t)r32 * 64 + 8 * hh;
    float* SC = (float*)(a.ws + WS_SC) + (size_t)(q0 + r32) * SEQ;
    float wv[8];
#pragma unroll
    for (int h = 0; h < 8; ++h) wv[h] = ((const float*)(a.ws + WS_IW))[(size_t)(q0 + r32) * 8 + h];
    bf16x8 ak[4], an[4];
    if (w <= qb) {
#pragma unroll
        for (int ks = 0; ks < 4; ++ks) ak[ks] = *(const bf16x8*)(IK + (size_t)(w * 32) * 64 + ks * 16); }
#pragma unroll 1
    for (int kt = w; kt <= qb; kt += 8) {
        if (kt + 8 <= qb) {
#pragma unroll
            for (int ks = 0; ks < 4; ++ks) an[ks] = *(const bf16x8*)(IK + (size_t)((kt + 8) * 32) * 64 + ks * 16); }
        f32x16 sc = {};
        int qoff = r32 * 520 + 8 * hh; asm volatile("" : "+v"(qoff));
#pragma unroll
        for (int h = 0; h < 8; ++h) { f32x16 d = {};
#pragma unroll
            for (int ks = 0; ks < 4; ++ks) d = __builtin_amdgcn_mfma_f32_32x32x16_bf16(ak[ks], *(const LAS bf16x8*)(IQL + qoff + h * 64 + ks * 16), d, 0, 0, 0);
#pragma unroll
            for (int r = 0; r < 16; ++r) sc[r] = fmaf(wv[h], fmaxf(d[r], 0.f), sc[r]); }
#pragma unroll
        for (int g = 0; g < 4; ++g) *(f32x4*)(SC + kt * 32 + 8 * g + 4 * hh) = (f32x4){sc[4 * g], sc[4 * g + 1], sc[4 * g + 2], sc[4 * g + 3]};
#pragma unroll
        for (int ks = 0; ks < 4; ++ks) ak[ks] = an[ks];
    }
}
__device__ __forceinline__ v4u pack8f(const float* p) { const f32x4 x = *(const f32x4*)p, y = *(const f32x4*)(p + 4); v4u o; o.x = pk2(x.x, x.y); o.y = pk2(x.z, x.w); o.z = pk2(y.x, y.y); o.w = pk2(y.z, y.w); return o; }
__device__ __forceinline__ void idx_sample_tile(ARGREF a, int sb, int tl, int lane_) {
    int lane = lane_; asm volatile("" : "+v"(lane));
    const int r32 = lane & 31, hh = lane >> 5, tk = r32 >> 3, hd = r32 & 7;
    const float* iq = (const float*)(a.ws + WS_SIQ) + (size_t)(sb * 4 + tk) * 512 + hd * 64 + 8 * hh;
    const float wv = ((const float*)(a.ws + WS_SIW))[(sb * 4 + tk) * 8 + hd];
    const float* src;
    if (tl < 256) src = a.in[4] + ((size_t)a.page_table[sb * 64 + (tl >> 2)] * 128 + (tl & 3) * 32 + r32) * 64 + 8 * hh;
    else src = a.out + O_IKS + (size_t)(sb * 4 + (r32 & 3)) * 64 + 8 * hh;
    v4u af[4], bf_[4];
#pragma unroll
    for (int ks = 0; ks < 4; ++ks) { af[ks] = pack8f(src + 16 * ks); bf_[ks] = pack8f(iq + 16 * ks); }
    if (tl == 256 && r32 >= 4) {
#pragma unroll
        for (int ks = 0; ks < 4; ++ks) af[ks] = (v4u){0u, 0u, 0u, 0u}; }
    f32x16 d = {};
#pragma unroll
    for (int ks = 0; ks < 4; ++ks) d = __builtin_amdgcn_mfma_f32_32x32x16_bf16(__builtin_bit_cast(bf16x8, af[ks]), __builtin_bit_cast(bf16x8, bf_[ks]), d, 0, 0, 0);
    float* dst = (float*)(a.ws + WS_SSC) + (size_t)(sb * 4 + tk) * SSC_LD + tl * 32;
#pragma unroll
    for (int r = 0; r < 16; ++r) { float v = wv * fmaxf(d[r], 0.f);
        v += __builtin_bit_cast(float, __builtin_amdgcn_update_dpp(0, __builtin_bit_cast(int, v), 0xB1, 0xF, 0xF, false));
        v += __builtin_bit_cast(float, __builtin_amdgcn_update_dpp(0, __builtin_bit_cast(int, v), 0x4E, 0xF, 0xF, false));
        v += __builtin_bit_cast(float, __builtin_amdgcn_update_dpp(0, __builtin_bit_cast(int, v), 0x141, 0xF, 0xF, false));
        if (hd == 0) dst[crow(r, hh)] = v; }
}
__device__ __forceinline__ void p9_indexer(Ctx& c, ARGREF a) {
    const int gw = c.vcu * NWAVES + c.wave, NGW = c.G * NWAVES;
#pragma unroll 1
    for (int wt = gw; wt < 32 * 257; wt += NGW) idx_sample_tile(a, wt / 257, wt % 257, c.lane);
    for (;;) { const int u = q_next(c, 2); if (u >= 512) break; idx_prompt_unit(c, a, u & 3, 127 - (u >> 2)); }
}


__device__ __forceinline__ unsigned fkey(float f) { const unsigned u = __builtin_bit_cast(unsigned, f + 0.0f); return (u & 0x80000000u) ? ~u : (u | 0x80000000u); }
__device__ __forceinline__ void acc_ge(int& cnt, unsigned key, unsigned cand) { asm volatile("v_cmp_le_u32_e32 vcc, %1, %2\n\tv_addc_co_u32_e32 %0, vcc, 0, %0, vcc" : "+v"(cnt) : "s"(cand), "v"(key) : "vcc"); }
__device__ __forceinline__ void acc_ge4(int& c0, int& c1, int& c2, int& c3, unsigned k0, unsigned k1, unsigned k2, unsigned k3, unsigned cand) {
    u64 m0, m1, m2, m3;
    asm volatile("v_cmp_le_u32_e64 %4, %8, %9\n\tv_cmp_le_u32_e64 %5, %8, %10\n\tv_cmp_le_u32_e64 %6, %8, %11\n\tv_cmp_le_u32_e64 %7, %8, %12\n\t"
                 "v_addc_co_u32_e64 %0, %4, 0, %0, %4\n\tv_addc_co_u32_e64 %1, %5, 0, %1, %5\n\tv_addc_co_u32_e64 %2, %6, 0, %2, %6\n\tv_addc_co_u32_e64 %3, %7, 0, %3, %7"
                 : "+v"(c0), "+v"(c1), "+v"(c2), "+v"(c3), "=&s"(m0), "=&s"(m1), "=&s"(m2), "=&s"(m3) : "s"(cand), "v"(k0), "v"(k1), "v"(k2), "v"(k3));
}
__device__ __forceinline__ u64 ballot_nz(unsigned v) { u64 m; asm volatile("v_cmp_ne_u32_e64 %0, 0, %1" : "=s"(m) : "v"(v)); return m; }
__device__ __forceinline__ int wave_sum_dpp(int x) {
    x += __builtin_amdgcn_update_dpp(0, x, 0xB1, 0xF, 0xF, false);
    x += __builtin_amdgcn_update_dpp(0, x, 0x4E, 0xF, 0xF, false);
    x += __builtin_amdgcn_update_dpp(0, x, 0x141, 0xF, 0xF, false);
    x += __builtin_amdgcn_update_dpp(0, x, 0x140, 0xF, 0xF, false);
    return (__builtin_amdgcn_readlane(x, 0) + __builtin_amdgcn_readlane(x, 16)) + (__builtin_amdgcn_readlane(x, 32) + __builtin_amdgcn_readlane(x, 48));
}
__device__ __forceinline__ int mbcnt64(u64 m) { return (int)__builtin_amdgcn_mbcnt_hi((unsigned)(m >> 32), __builtin_amdgcn_mbcnt_lo((unsigned)m, 0u)); }
constexpr int TK_LOWBITS = 18;
__device__ __forceinline__ void topk_finish(unsigned ck, int cp, int A, int posmax, unsigned& T, int& P) {
#pragma unroll 1
    for (int bit = TK_LOWBITS - 1; bit >= 0; --bit) { const unsigned cand = T | (1u << bit); if (A + __builtin_popcountll(__ballot(ck >= cand)) >= 256) T = cand; }
    const int need = 256 - (A + __builtin_popcountll(__ballot(ck > T))), ceq = __builtin_popcountll(__ballot(ck == T));
    P = posmax;
    if (ceq != need) { P = 0;
#pragma unroll 1
        for (int bit = 13; bit >= 0; --bit) { const int cand = P | (1 << bit); if (__builtin_popcountll(__ballot(ck == T && cp < cand)) < need) P = cand; } }
}
__device__ __forceinline__ unsigned wave_min_u(unsigned x) {
    x = min(x, (unsigned)__builtin_amdgcn_update_dpp(0, (int)x, 0xB1, 0xF, 0xF, false)); x = min(x, (unsigned)__builtin_amdgcn_update_dpp(0, (int)x, 0x4E, 0xF, 0xF, false));
    x = min(x, (unsigned)__builtin_amdgcn_update_dpp(0, (int)x, 0x141, 0xF, 0xF, false)); x = min(x, (unsigned)__builtin_amdgcn_update_dpp(0, (int)x, 0x140, 0xF, 0xF, false));
    return min(min((unsigned)__builtin_amdgcn_readlane((int)x, 0), (unsigned)__builtin_amdgcn_readlane((int)x, 16)), min((unsigned)__builtin_amdgcn_readlane((int)x, 32), (unsigned)__builtin_amdgcn_readlane((int)x, 48)));
}
__device__ __forceinline__ unsigned wave_max_u(unsigned x) {
    x = max(x, (unsigned)__builtin_amdgcn_update_dpp(0, (int)x, 0xB1, 0xF, 0xF, false)); x = max(x, (unsigned)__builtin_amdgcn_update_dpp(0, (int)x, 0x4E, 0xF, 0xF, false));
    x = max(x, (unsigned)__builtin_amdgcn_update_dpp(0, (int)x, 0x141, 0xF, 0xF, false)); x = max(x, (unsigned)__builtin_amdgcn_update_dpp(0, (int)x, 0x140, 0xF, 0xF, false));
    return max(max((unsigned)__builtin_amdgcn_readlane((int)x, 0), (unsigned)__builtin_amdgcn_readlane((int)x, 16)), max((unsigned)__builtin_amdgcn_readlane((int)x, 32), (unsigned)__builtin_amdgcn_readlane((int)x, 48)));
}
__device__ __forceinline__ void topk_prompt_rows(ARGREF a, int row0, int stride, int lane_, LAS unsigned* cl) {
    int lane = lane_; asm volatile("" : "+v"(lane));
    const float* SCb = (const float*)(a.ws + WS_SC);
#pragma unroll 1
    for (int row = row0; row < MP; row += stride) {
        const int t = row & 4095;
        u64* mk = (u64*)(a.ws + WS_MASK) + (size_t)row * 64;
        if (t < 256) { u64 myword = 0ull;
#pragma unroll 1
            for (int j = 0; j < 64; ++j) { const u64 m = __ballot(64 * j + lane <= t); if (lane == j) myword = m; }
            mk[lane] = myword;
            continue; }
        unsigned key[64];
        { const float* sc_ = SCb + (size_t)row * SEQ + lane; const int tj_ = t >> 6;
          float v[64];
#pragma unroll
          for (int j = 0; j < 64; ++j) v[j] = sc_[64 * (j < tj_ ? j : tj_)];
          int pj = lane;
#pragma unroll
          for (int j = 0; j < 64; ++j) { const int u = __builtin_bit_cast(int, v[j] + 0.0f); const unsigned k = (unsigned)u ^ ((unsigned)(u >> 31) | 0x80000000u); key[j] = (pj <= t) ? k : 0u; pj += 64; asm volatile("" : "+v"(pj)); } }
        unsigned kh[64];
#pragma unroll
        for (int j = 0; j < 64; ++j) { kh[j] = key[j] >> 1; asm volatile("" : "+v"(kh[j])); }
        unsigned T; int hb;
        {
            unsigned b0 = 0u, b1 = 0u, b2 = 0u, b3 = 0u;
#pragma unroll
            for (int j = 0; j < 64; ++j) { unsigned x = key[j]; const unsigned m0 = max(b0, x); x = min(b0, x); b0 = m0; const unsigned m1 = max(b1, x); x = min(b1, x); b1 = m1; const unsigned m2 = max(b2, x); x = min(b2, x); b2 = m2; b3 = max(b3, x); }
            const unsigned L = wave_min_u(b3), H = wave_max_u(b3), df = L ^ H;
            hb = df ? 31 - __builtin_clz(df) : -1;
            T = hb >= 31 ? 0u : (L & ~((2u << (hb < 0 ? 0 : hb)) - 1u)); if (hb < 0) T = L;
        }
#define TK_FULLCOUNT(CAND, OUT) do { const unsigned cs_ = __builtin_amdgcn_readfirstlane(CAND); int c0_ = 0, c1_ = 0, c2_ = 0, c3_ = 0; \
        _Pragma("unroll") for (int j = 0; j < 64; j += 4) acc_ge4(c0_, c1_, c2_, c3_, key[j], key[j + 1], key[j + 2], key[j + 3], cs_); OUT = wave_sum_dpp((c0_ + c1_) + (c2_ + c3_)); } while (0)
#define TK_FASTCOUNT(CAND, OUT) do { const unsigned ch_ = __builtin_amdgcn_readfirstlane((CAND) >> 1); unsigned a_[8] = {0u, 0u, 0u, 0u, 0u, 0u, 0u, 0u}; \
        _Pragma("unroll") for (int j = 0; j < 64; j += 8) { unsigned d_[8]; _Pragma("unroll") for (int i = 0; i < 8; ++i) d_[i] = kh[j + i] - ch_; \
            _Pragma("unroll") for (int i = 0; i < 8; ++i) a_[i] = __builtin_amdgcn_alignbit(a_[i], d_[i], 31); } \
        OUT = 4096 - wave_sum_dpp(((__builtin_popcount(a_[0]) + __builtin_popcount(a_[1])) + (__builtin_popcount(a_[2]) + __builtin_popcount(a_[3]))) + \
                                  ((__builtin_popcount(a_[4]) + __builtin_popcount(a_[5])) + (__builtin_popcount(a_[6]) + __builtin_popcount(a_[7])))); } while (0)
#pragma unroll 1
        for (int bit = hb; bit >= TK_LOWBITS; --bit) { const unsigned cand = T | (1u << bit); int tot; TK_FASTCOUNT(cand, tot); if (tot >= 256) T = cand; }
        const unsigned Tb = T & ~((1u << TK_LOWBITS) - 1u), hib = Tb + (1u << TK_LOWBITS);
        int A = 0, cT; if (hib != 0u) TK_FASTCOUNT(hib, A); TK_FASTCOUNT(Tb, cT);
#undef TK_FASTCOUNT
        int P;
        if (cT - A <= 64) {
            if (lane == 0) cl[128] = 0u;
            int pj = lane;
#pragma unroll
            for (int j = 0; j < 64; ++j) { if ((key[j] - Tb) < (1u << TK_LOWBITS)) { const unsigned pos = __hip_atomic_fetch_add(cl + 128, 1u, __ATOMIC_RELAXED, __HIP_MEMORY_SCOPE_WORKGROUP); if (pos < 64u) { cl[pos] = key[j]; cl[64 + pos] = (unsigned)pj; } }
                pj += 64; asm volatile("" : "+v"(pj)); }
            const int nund = cT - A;
            const unsigned ck = lane < nund ? cl[lane] : 0u; const int cp = (int)cl[64 + lane];
            topk_finish(ck, cp, A, 4095, T, P);
        } else {
#pragma unroll 1
            for (int bit = TK_LOWBITS - 1; bit >= 0; --bit) { const unsigned cand = T | (1u << bit); int tot; TK_FULLCOUNT(cand, tot); if (tot >= 256) T = cand; }
            int cge, cgt; TK_FULLCOUNT(T, cge); cgt = 0; if (T != 0xffffffffu) TK_FULLCOUNT(T + 1u, cgt);
            const int need = 256 - cgt, ceq = cge - cgt; P = 4095;
            if (ceq != need) { P = 0;
#pragma unroll 1
                for (int bit = 11; bit >= 0; --bit) { const int cand = P | (1 << bit); int cnt = 0; int pj = lane;
#pragma unroll
                    for (int j = 0; j < 64; ++j) { cnt += (key[j] == T && pj < cand) ? 1 : 0; pj += 64; asm volatile("" : "+v"(pj)); }
                    if (wave_sum_dpp(cnt) < need) P = cand; } }
        }
#undef TK_FULLCOUNT
        if (P != 4095) {
            int pq = lane;
#pragma unroll
            for (int j = 0; j < 64; ++j) { if (key[j] == T && pq > P) key[j] = 0u; pq += 64; asm volatile("" : "+v"(pq)); } }
        unsigned wlo = 0u, whi = 0u; const unsigned Ts = __builtin_amdgcn_readfirstlane(T);
#pragma unroll
        for (int j = 0; j < 64; ++j) asm volatile("v_cmp_le_u32_e32 vcc, %2, %3\n\ts_nop 3\n\tv_writelane_b32 %0, vcc_lo, %4\n\tv_writelane_b32 %1, vcc_hi, %4" : "+v"(wlo), "+v"(whi) : "s"(Ts), "v"(key[j]), "i"(j) : "vcc");
        mk[lane] = ((u64)whi << 32) | (u64)wlo;
    }
}
__device__ __forceinline__ void topk_sample_row(ARGREF a, int q, int lane_, LAS unsigned* K, LAS unsigned* cl) {
    int lane = lane_; asm volatile("" : "+v"(lane));
    const int t = q & 3, n = PAST + t + 1; const float* sc = (const float*)(a.ws + WS_SSC) + (size_t)q * SSC_LD;
    int* out = (int*)(a.ws + WS_SIDX) + q * 256;
    unsigned key[129];
#pragma unroll
    for (int j = 0; j < 129; ++j) { const float v = sc[64 * j + lane]; key[j] = (j < 128 || lane < n - 8192) ? fkey(v) : 0u; }
#pragma unroll
    for (int j = 0; j < 129; ++j) K[64 * j + lane] = key[j];
#define TK_FULLCOUNT(CAND, OUT) do { const unsigned cs_ = __builtin_amdgcn_readfirstlane(CAND); int c0_ = 0, c1_ = 0, c2_ = 0, c3_ = 0; \
        _Pragma("unroll") for (int j = 0; j < 128; j += 4) acc_ge4(c0_, c1_, c2_, c3_, key[j], key[j + 1], key[j + 2], key[j + 3], cs_); acc_ge(c0_, key[128], cs_); OUT = wave_sum_dpp((c0_ + c1_) + (c2_ + c3_)); } while (0)
    unsigned T = 0u;
#pragma unroll 1
    for (int bit = 31; bit >= TK_LOWBITS; --bit) { const unsigned cand = T | (1u << bit); int tot; TK_FULLCOUNT(cand, tot); if (tot >= 256) T = cand; }
    const unsigned hib = T + (1u << TK_LOWBITS);
    int A = 0, cT; if (hib != 0u) TK_FULLCOUNT(hib, A); TK_FULLCOUNT(T, cT);
    int P;
    if (cT - A <= 64) {
        int base = 0;
#pragma unroll 1
        for (int j0 = 0; j0 < 128; j0 += 8) { unsigned kk[8];
#pragma unroll
            for (int i = 0; i < 8; ++i) kk[i] = K[64 * (j0 + i) + lane];
#pragma unroll
            for (int i = 0; i < 8; ++i) { const unsigned und = (kk[i] - T) < (1u << TK_LOWBITS) ? 1u : 0u; const u64 m = ballot_nz(und); const int pos = base + mbcnt64(m);
                if (und) { cl[pos] = kk[i]; cl[64 + pos] = (unsigned)(64 * (j0 + i) + lane); }
                base += __builtin_popcountll(m); } }
        { const unsigned kj = K[64 * 128 + lane]; const unsigned und = (kj - T) < (1u << TK_LOWBITS) ? 1u : 0u; const u64 m = ballot_nz(und); const int pos = base + mbcnt64(m);
          if (und) { cl[pos] = kj; cl[64 + pos] = (unsigned)(64 * 128 + lane); } base += __builtin_popcountll(m); }
        const unsigned ck = lane < base ? cl[lane] : 0u; const int cp = (int)cl[64 + lane];
        topk_finish(ck, cp, A, 16383, T, P);
    } else {
#pragma unroll 1
        for (int bit = TK_LOWBITS - 1; bit >= 0; --bit) { const unsigned cand = T | (1u << bit); int tot; TK_FULLCOUNT(cand, tot); if (tot >= 256) T = cand; }
        int cge, cgt; TK_FULLCOUNT(T, cge); cgt = 0; if (T != 0xffffffffu) TK_FULLCOUNT(T + 1u, cgt);
        const int need = 256 - cgt, ceq = cge - cgt; P = 16383;
        if (ceq != need) { P = 0;
#pragma unroll 1
            for (int bit = 13; bit >= 0; --bit) { const int cand = P | (1 << bit); int cnt = 0;
#pragma unroll 4
                for (int j = 0; j < 129; ++j) cnt += (K[64 * j + lane] == T && 64 * j + lane < cand) ? 1 : 0;
                if (wave_sum_dpp(cnt) < need) P = cand; } }
    }
#undef TK_FULLCOUNT
    int base = 0;
#pragma unroll 1
    for (int j0 = 0; j0 < 136; j0 += 8) { unsigned kk[8];
#pragma unroll
        for (int i = 0; i < 8; ++i) kk[i] = (j0 + i < 129) ? K[64 * (j0 + i) + lane] : 0u;
#pragma unroll
        for (int i = 0; i < 8; ++i) { const int ps = 64 * (j0 + i) + lane; const unsigned selv = (kk[i] > T || (kk[i] == T && ps <= P)) ? 1u : 0u; const u64 m = ballot_nz(selv);
            const int pos = base + mbcnt64(m);
            if (selv && pos < 256) out[pos] = ps;
            base += __builtin_popcountll(m); } }
}
__device__ __forceinline__ void p10_topk(Ctx& c, ARGREF a) {
    const int gw = c.vcu * NWAVES + c.wave, NGW = c.G * NWAVES;
    LAS unsigned* cl = (LAS unsigned*)(c.lds) + c.wave * 192;
    if (c.wave == 0 && c.vcu < MS) topk_sample_row(a, c.vcu, c.lane, (LAS unsigned*)(c.lds + 8192), cl);
    topk_prompt_rows(a, gw, NGW, c.lane, cl);
}


__device__ __forceinline__ void attn_sample_unit(Ctx& c, ARGREF a, int sb, int t) {
    LAS bf16* KV = (LAS bf16*)(c.lds);
    LAS float* QL = (LAS float*)(c.lds + 69632);
    LAS float* SL = (LAS float*)(c.lds + 69632 + 3072);
    LAS float* OL = (LAS float*)(c.lds + 69632 + 6144);
    LAS int* IL = (LAS int*)(c.lds + 69632 + 12288);
    LAS unsigned* OFFL = (LAS unsigned*)(c.lds + 69632 + 12288 + 1024);
    int tid = c.tid; asm volatile("" : "+v"(tid));
    const int lane = tid & 63, w = c.wave, q = sb * 4 + t;
    __syncthreads();
    if (tid < 256) IL[tid] = ((const int*)(a.ws + WS_SIDX))[q * 256 + tid];
    for (int i = tid; i < 768; i += 512) QL[i] = ((const float*)(a.ws + WS_SQ))[(size_t)q * 768 + i];
    __syncthreads();
    if (tid < 256) { const int idx = IL[tid];
        OFFL[tid] = idx < PAST ? (unsigned)(((a.page_table[sb * 64 + (idx >> 7)] * 128 + (idx & 127)) * 2) * 128) : (0x80000000u | (unsigned)((sb * 4 + (idx - PAST)) * 256)); }
    __syncthreads();
    bf16* MIX = (bf16*)(a.ws + WS_MIX) + (size_t)(MP + q) * DM;
#pragma unroll 1
    for (int kvh = 0; kvh < 2; ++kvh) {
#pragma unroll 1
        for (int pass = 0; pass < 2; ++pass) {
            const float* pool = pass ? a.in[3] : a.in[2]; const float* nw = a.out + (pass ? O_VS : O_KS);
            { f32x4 gv[16];
#pragma unroll
              for (int r = 0; r < 16; ++r) { const int i = (tid >> 5) + 16 * r; const unsigned off = OFFL[i]; const float* src = (off & 0x80000000u) ? nw + (size_t)(off & 0x7fffffffu) : pool + (size_t)off;
                  gv[r] = *(const f32x4*)(src + kvh * 128 + (tid & 31) * 4); }
#pragma unroll
              for (int r = 0; r < 16; ++r) { const int i = (tid >> 5) + 16 * r; *(LAS u64*)(KV + i * 136 + (tid & 31) * 4) = (u64)pk2(gv[r].x, gv[r].y) | ((u64)pk2(gv[r].z, gv[r].w) << 32); } }
            __syncthreads();
            if (pass == 0) {
                const int i = tid >> 1, dh = (tid & 1) * 64; float s0 = 0.f, s1 = 0.f, s2 = 0.f;
#pragma unroll 8
                for (int d = 0; d < 64; ++d) { const float kx = bf2f(KV[i * 136 + dh + d]);
                    s0 = fmaf(QL[(3 * kvh + 0) * 128 + dh + d], kx, s0); s1 = fmaf(QL[(3 * kvh + 1) * 128 + dh + d], kx, s1); s2 = fmaf(QL[(3 * kvh + 2) * 128 + dh + d], kx, s2); }
                s0 += __shfl_xor(s0, 1); s1 += __shfl_xor(s1, 1); s2 += __shfl_xor(s2, 1);
                if ((tid & 1) == 0) { SL[i] = s0 * 0.08838834764831845f; SL[256 + i] = s1 * 0.08838834764831845f; SL[512 + i] = s2 * 0.08838834764831845f; }
                __syncthreads();
                if (w < 3) { float v[4], mx = -1e30f;
#pragma unroll
                    for (int j = 0; j < 4; ++j) { v[j] = SL[w * 256 + 64 * j + lane]; mx = fmaxf(mx, v[j]); }
#pragma unroll
                    for (int o = 1; o < 64; o <<= 1) mx = fmaxf(mx, __shfl_xor(mx, o));
                    float l = 0.f;
#pragma unroll
                    for (int j = 0; j < 4; ++j) { v[j] = __expf(v[j] - mx); l += v[j]; }
                    l = wave_sum(l); const float il = 1.0f / l;
#pragma unroll
                    for (int j = 0; j < 4; ++j) SL[w * 256 + 64 * j + lane] = v[j] * il; }
                __syncthreads();
            } else {
                const int d = tid & 127, part = tid >> 7; float o0 = 0.f, o1 = 0.f, o2 = 0.f;
#pragma unroll 8
                for (int i = part * 64; i < part * 64 + 64; ++i) { const float vx = bf2f(KV[i * 136 + d]); o0 = fmaf(SL[i], vx, o0); o1 = fmaf(SL[256 + i], vx, o1); o2 = fmaf(SL[512 + i], vx, o2); }
                OL[(part * 3 + 0) * 128 + d] = o0; OL[(part * 3 + 1) * 128 + d] = o1; OL[(part * 3 + 2) * 128 + d] = o2;
                __syncthreads();
                if (tid < 384) { const int hq = tid >> 7, dd = tid & 127; const float o = (OL[hq * 128 + dd] + OL[(3 + hq) * 128 + dd]) + (OL[(6 + hq) * 128 + dd] + OL[(9 + hq) * 128 + dd]);
                    MIX[(3 * kvh + hq) * 128 + dd] = (bf16)f2bf(o); }
                __syncthreads();
            }
        }
    }
}


namespace attn {
using bf16 = unsigned short;
typedef short bf16x8 __attribute__((ext_vector_type(8)));
typedef short s16x4 __attribute__((ext_vector_type(4)));
typedef float f32x16 __attribute__((ext_vector_type(16)));
typedef float f32x4 __attribute__((ext_vector_type(4)));
typedef unsigned u32x4 __attribute__((ext_vector_type(4)));
typedef unsigned u32x2 __attribute__((ext_vector_type(2)));
constexpr int D = 128, OS = 1024;
constexpr float THR = 8.f;
constexpr float SCALE = 0.08838834764831845f;
constexpr int NW = 8, QBLK = 32, KVBLK = 64, QB = NW * QBLK;
constexpr int SHM_V = KVBLK * D * 2, SHM_K = KVBLK * D * 2;
constexpr int LDS_BYTES = 2 * SHM_V + 2 * SHM_K + NW * 64 * 4;

#define KSWZ(row, colB) ((row) * 256 + ((colB) ^ (((row) & 7) << 4)))
#define SBAR() __builtin_amdgcn_sched_barrier(0)
__device__ __forceinline__ int v_st(int k, int c) { const int kk = (k & ~0xC) | ((k & 4) << 1) | ((k & 8) >> 1); return ((kk >> 3) * 4 + (c >> 5)) * 512 + ((kk & 7) * 32 + (c & 31)) * 2; }
__device__ __forceinline__ int v_rd_base(int lane) { return ((lane & 3) << 3) | (((lane >> 2) & 3) << 6) | (((lane >> 4) & 1) << 5) | (((lane >> 5) & 1) << 8); }
constexpr int v_rd_off(int d0, int ks, int half) { return d0 * 512 + ks * 4096 + half * 2048; }
__device__ __forceinline__ int crow(int r, int hi) { return (r & 3) + 8 * (r >> 2) + 4 * hi; }
__device__ __forceinline__ unsigned cvtpk(float lo, float hi) {
    unsigned r; asm volatile("v_cvt_pk_bf16_f32 %0, %1, %2" : "=v"(r) : "v"(lo), "v"(hi)); return r;
}
__device__ __forceinline__ bf16x8 pack8(f32x4 a, f32x4 b) {
    u32x4 w = {cvtpk(a[0], a[1]), cvtpk(a[2], a[3]), cvtpk(b[0], b[1]), cvtpk(b[2], b[3])};
    return *reinterpret_cast<bf16x8*>(&w);
}

__device__ __forceinline__ void partialSM(f32x16& p0, f32x16& p1, float& m_reg, float& mn, float& alpha) {
    float pmax = p0[0]; for (int r = 1; r < 16; ++r) pmax = fmaxf(pmax, p0[r]); for (int r = 0; r < 16; ++r) pmax = fmaxf(pmax, p1[r]);
    { auto rr = __builtin_amdgcn_permlane32_swap(__float_as_uint(pmax), __float_as_uint(pmax), false, false);
      pmax = fmaxf(__uint_as_float(rr[0]), __uint_as_float(rr[1])); }
    constexpr float C2 = 1.4426950408889634f * SCALE;
    if (__builtin_expect(__all((pmax - m_reg) * SCALE <= THR), 1)) { mn = m_reg; alpha = 1.f; }
    else { mn = fmaxf(m_reg, pmax); alpha = __builtin_amdgcn_exp2f((m_reg - mn) * C2); m_reg = mn; }
    const float mnL = -mn * C2;
    for (int r = 0; r < 16; ++r) p0[r] = fmaf(p0[r], C2, mnL); for (int r = 0; r < 16; ++r) p1[r] = fmaf(p1[r], C2, mnL);
    for (int r = 0; r < 16; ++r) p0[r] = __builtin_amdgcn_exp2f(p0[r]);
}
__device__ __forceinline__ void finishSM(f32x16& p0, f32x16& p1, float alpha, float& l_reg, bf16x8& pa0, bf16x8& pa1, bf16x8& pa2, bf16x8& pa3) {
    for (int r = 0; r < 16; ++r) p1[r] = __builtin_amdgcn_exp2f(p1[r]);
    float ps = 0; for (int r = 0; r < 16; ++r) ps += p0[r]; for (int r = 0; r < 16; ++r) ps += p1[r];
    { auto rr = __builtin_amdgcn_permlane32_swap(__float_as_uint(ps), __float_as_uint(ps), false, false);
      ps = __uint_as_float(rr[0]) + __uint_as_float(rr[1]); }
    l_reg = l_reg * alpha + ps;
#define PK4(P, B_, OUT) do { unsigned a0 = cvtpk(P[B_+0], P[B_+1]), a1 = cvtpk(P[B_+2], P[B_+3]);                          \
        unsigned b0 = cvtpk(P[B_+4], P[B_+5]), b1 = cvtpk(P[B_+6], P[B_+7]);                                             \
        auto r0 = __builtin_amdgcn_permlane32_swap(a0, b0, false, false); auto r1 = __builtin_amdgcn_permlane32_swap(a1, b1, false, false); \
        u32x4 w = {r0[0], r1[0], r0[1], r1[1]}; OUT = *reinterpret_cast<bf16x8*>(&w); } while (0)
    PK4(p0, 0, pa0); PK4(p0, 8, pa1); PK4(p1, 0, pa2); PK4(p1, 8, pa3);
#undef PK4
}
template <int KB, bool SK>
__device__ __forceinline__ void qkt(f32x16& p0, f32x16& p1, const char* K_lds, int r32, int hi, const bf16x8* qr, bool act) {
    if (SK && !act) { const float NEG = -__builtin_inff();
#pragma unroll
        for (int r = 0; r < 16; ++r) { p0[r] = NEG; p1[r] = NEG; } return; }
    p0 = f32x16{}; p1 = f32x16{};
    const char* kb[4];
#pragma unroll
    for (int dd = 0; dd < 4; ++dd) kb[dd] = K_lds + KB * SHM_K + KSWZ(r32, (dd * 16 + hi * 8) * 2);
#pragma unroll
    for (int d0 = 0; d0 < 8; ++d0) { const char* a = kb[d0 & 3] + (d0 >> 2) * 128;
        bf16x8 b0 = *reinterpret_cast<const bf16x8*>(a);
        bf16x8 b1 = *reinterpret_cast<const bf16x8*>(a + 32 * 256);
        p0 = __builtin_amdgcn_mfma_f32_32x32x16_bf16(b0, qr[d0], p0, 0, 0, 0);
        p1 = __builtin_amdgcn_mfma_f32_32x32x16_bf16(b1, qr[d0], p1, 0, 0, 0); }
}
template <int VB, bool SK>
__device__ __forceinline__ void pv_tile(f32x16* o, int vb0, bf16x8 pa0, bf16x8 pa1, bf16x8 pa2, bf16x8 pa3, bool act) {
    if (SK && !act) return;
#define TRRD(dst, off) asm volatile("ds_read_b64_tr_b16 %0, %1 offset:%2" : "=&v"(dst) : "v"(vb0), "i"(off) : "memory")
#define PV_D0(d0) do { s16x4 l0, l1, l2, l3, h0, h1, h2, h3; constexpr int b_ = VB * SHM_V + v_rd_off(d0, 0, 0);     \
        TRRD(l0, b_); TRRD(h0, b_ + 2048); TRRD(l1, b_ + 4096); TRRD(h1, b_ + 6144); TRRD(l2, b_ + 8192); TRRD(h2, b_ + 10240); TRRD(l3, b_ + 12288); TRRD(h3, b_ + 14336); \
        asm volatile("s_waitcnt lgkmcnt(0)" ::: "memory"); SBAR();                 \
        o[d0] = __builtin_amdgcn_mfma_f32_32x32x16_bf16(pa0, (bf16x8){l0[0], l0[1], l0[2], l0[3], h0[0], h0[1], h0[2], h0[3]}, o[d0], 0, 0, 0);   \
        o[d0] = __builtin_amdgcn_mfma_f32_32x32x16_bf16(pa1, (bf16x8){l1[0], l1[1], l1[2], l1[3], h1[0], h1[1], h1[2], h1[3]}, o[d0], 0, 0, 0);   \
        o[d0] = __builtin_amdgcn_mfma_f32_32x32x16_bf16(pa2, (bf16x8){l2[0], l2[1], l2[2], l2[3], h2[0], h2[1], h2[2], h2[3]}, o[d0], 0, 0, 0);   \
        o[d0] = __builtin_amdgcn_mfma_f32_32x32x16_bf16(pa3, (bf16x8){l3[0], l3[1], l3[2], l3[3], h3[0], h3[1], h3[2], h3[3]}, o[d0], 0, 0, 0); } while (0)
    PV_D0(0); PV_D0(1); PV_D0(2); PV_D0(3);
#undef PV_D0
#undef TRRD
}

__device__ __forceinline__ bf16x8 load8(const bf16* p) { return *reinterpret_cast<const bf16x8*>(p); }
__device__ __forceinline__ void mask_bits(f32x16& p0, f32x16& p1, u32x2 w, int hi) {
    const float NEG = -__builtin_inff();
    asm volatile("" : "+v"(w.x), "+v"(w.y));
    const unsigned lo = w.x >> (4 * hi), up = w.y >> (4 * hi);
#pragma unroll
    for (int r = 0; r < 16; ++r) { const int c = (r & 3) + 8 * (r >> 2);
        if (!((lo >> c) & 1u)) p0[r] = NEG;
        if (!((up >> c) & 1u)) p1[r] = NEG; }
}
struct BlockRef { const bf16* Q; const bf16* K; const bf16* V; bf16* O; const u32x2* M; int P0; };
struct Seam { bf16x8 qr[8]; bf16x8 st_v0, st_v1, st_k0, st_k1; };
#define ROW(p, k0, rr) ((p) + (size_t)((k0) + (rr)) * D + sc)
#define VMW() asm volatile("s_waitcnt vmcnt(0)" ::: "memory")
#define VMWN(n) asm volatile("s_waitcnt vmcnt(%0)" :: "i"(n) : "memory")
#define SLOAD_H(Kp, Vp, k0) do { S.st_v0 = load8(ROW(Vp, k0, sr)); S.st_v1 = load8(ROW(Vp, k0, 32 + sr));              \
                         S.st_k0 = load8(ROW(Kp, k0, sr)); S.st_k1 = load8(ROW(Kp, k0, 32 + sr)); } while (0)
#define SWRITE_HK(bf) do { *(bf16x8*)(K_lds + (bf) * SHM_K + kws) = S.st_k0; *(bf16x8*)(K_lds + (bf) * SHM_K + kws + 32 * 256) = S.st_k1; } while (0)
#define SWRITE_HV(bf) do { *(bf16x8*)(V_lds + (bf) * SHM_V + vst0) = S.st_v0; *(bf16x8*)(V_lds + (bf) * SHM_V + vst1) = S.st_v1; } while (0)
#define SWRITE_H(bf) do { SWRITE_HV(bf); SWRITE_HK(bf); } while (0)
__device__ __forceinline__ void sel_prime(const BlockRef& cur, char* lds, Seam& S) {
    int tid_ = threadIdx.x; asm volatile("" : "+v"(tid_));
    const int tid = tid_, wid = __builtin_amdgcn_readfirstlane(tid >> 6), lane = tid & 63, r32 = lane & 31, hi = lane >> 5;
    const int sr = tid >> 4, sc = (tid & 15) * 8, kws = KSWZ(sr, sc * 2); char* K_lds = lds + 2 * SHM_V;
    for (int d0 = 0; d0 < 8; ++d0) S.qr[d0] = load8(cur.Q + (size_t)(wid * QBLK + r32) * D + d0 * 16 + hi * 8);
    SLOAD_H(cur.K, cur.V, 0); VMW(); SWRITE_HK(0);
    __syncthreads();
}
__device__ __forceinline__ void sel_block(const BlockRef& cur, const BlockRef& nxt, char* lds, Seam& S) {
    int tid_ = threadIdx.x; asm volatile("" : "+v"(tid_));
    const int tid = tid_, wid = __builtin_amdgcn_readfirstlane(tid >> 6), lane = tid & 63, r32 = lane & 31, hi = lane >> 5;
    const int NT = (cur.P0 + QB) / KVBLK;
    char* V_lds = lds; char* K_lds = lds + 2 * SHM_V;
    float* ws = (float*)(lds + 2 * SHM_V + 2 * SHM_K) + wid * 64; float* li_l = ws, * al_l = ws + 32;
    float m_reg = -1e30f, l_reg = 0; f32x16 o[4] = {};
    const int sr = tid >> 4, sc = (tid & 15) * 8, vst0 = v_st(sr, sc), vst1 = v_st(32 + sr, sc), kws = KSWZ(sr, sc * 2);
    const int vb0 = (int)(uintptr_t)V_lds + v_rd_base(lane);
    const bf16* Kh = cur.K; const bf16* Vh = cur.V;
    const char* Mbase = (const char*)cur.M; const unsigned moff = (unsigned)(wid * QBLK + r32) * 512u;
#define MROW(t) (*(const u32x2*)(Mbase + (moff + (unsigned)(t) * 8u)))
#define RESC(a) do { if (__any((a) < 1.f)) { if (hi == 0) al_l[r32] = (a); asm volatile("s_waitcnt lgkmcnt(0)" ::: "memory");              \
                     for (int d_ = 0; d_ < 4; ++d_) for (int r = 0; r < 16; ++r) o[d_][r] *= al_l[crow(r, hi)]; } } while (0)
#define KBASE(t) ((t) * KVBLK)
    f32x16 pA0, pA1, pB0, pB1; float mnA, mnB, alA, alB; bf16x8 pa0, pa1, pa2, pa3; u32x2 mw;
    SWRITE_HV(0); SBAR();
    if (NT > 1) SLOAD_H(Kh, Vh, KBASE(1));
    mw = MROW(0);
    SBAR(); qkt<0, false>(pA0, pA1, K_lds, r32, hi, S.qr, true);
    mask_bits(pA0, pA1, mw, hi); partialSM(pA0, pA1, m_reg, mnA, alA);
    if (NT > 1) { VMW(); SWRITE_H(1); }
    __syncthreads();
#define HALF_STEP(PX0, PX1, mnX, alX, PY0, PY1, alY, t, KB, VB, SB) do {                                                      \
        SBAR(); mw = MROW(t); qkt<KB, false>(PX0, PX1, K_lds, r32, hi, S.qr, true);                                          \
        finishSM(PY0, PY1, alY, l_reg, pa0, pa1, pa2, pa3); SBAR();                                                           \
        if ((t) + 1 < NT) { SLOAD_H(Kh, Vh, KBASE((t) + 1)); SBAR(); }                                                        \
        pv_tile<VB, false>(o, vb0, pa0, pa1, pa2, pa3, true); mask_bits(PX0, PX1, mw, hi); partialSM(PX0, PX1, m_reg, mnX, alX); \
        __syncthreads();                                                                                                      \
        if ((t) + 1 < NT) { VMW(); SWRITE_H(SB); }                                                                            \
        RESC(alX); __syncthreads(); } while (0)
    for (int t = 1; t + 1 < NT; t += 2) {
        HALF_STEP(pB0, pB1, mnB, alB, pA0, pA1, alA, t, 1, 0, 0);
        HALF_STEP(pA0, pA1, mnA, alA, pB0, pB1, alB, t + 1, 0, 1, 1);
    }
    const bool even = (NT & 1) == 0;
    if (even) { SBAR(); mw = MROW(NT - 1); qkt<1, false>(pB0, pB1, K_lds, r32, hi, S.qr, true); SBAR(); }
    SLOAD_H(nxt.K, nxt.V, 0); SBAR();
#pragma unroll
    for (int d0 = 0; d0 < 8; ++d0) S.qr[d0] = load8(nxt.Q + (size_t)(wid * QBLK + r32) * D + d0 * 16 + hi * 8);
    SBAR();
    finishSM(pA0, pA1, alA, l_reg, pa0, pa1, pa2, pa3); SBAR();
    pv_tile<0, false>(o, vb0, pa0, pa1, pa2, pa3, true);
    if (even) { mask_bits(pB0, pB1, mw, hi); partialSM(pB0, pB1, m_reg, mnB, alB); __syncthreads(); RESC(alB);
        finishSM(pB0, pB1, alB, l_reg, pa0, pa1, pa2, pa3); SBAR(); pv_tile<1, false>(o, vb0, pa0, pa1, pa2, pa3, true); }
    SBAR(); VMWN(8); SWRITE_HK(0); SBAR();
    if (hi == 0) li_l[r32] = l_reg; asm volatile("s_waitcnt lgkmcnt(0)" ::: "memory");
    float rli[16];
#pragma unroll
    for (int r = 0; r < 16; ++r) rli[r] = __builtin_amdgcn_rcpf(li_l[crow(r, hi)]);
    bf16* Ow = cur.O + (size_t)(wid * QBLK) * OS;
#pragma unroll
    for (int r = 0; r < 16; ++r) { const int orow = crow(r, hi);
#pragma unroll
        for (int d0 = 0; d0 < 4; ++d0) { const float v = o[d0][r] * rli[r];
            const float vn = __shfl_xor(v, 1);
            if ((r32 & 1) == 0) *(unsigned*)(Ow + (size_t)orow * OS + d0 * 32 + r32) = cvtpk(v, vn); } }
    __syncthreads();
#undef RESC
#undef KBASE
#undef HALF_STEP
#undef MROW
}
#undef ROW
#undef VMW
#undef VMWN
#undef SLOAD_H
#undef SWRITE_HK
#undef SWRITE_HV
#undef SWRITE_H
#undef KSWZ
#undef SBAR
}


__device__ __forceinline__ attn::BlockRef attn_ref(ARGREF a, int b, int h, int qb) {
    attn::BlockRef r; const int kvh = h / 3;
    r.Q = (const attn::bf16*)(a.ws + WS_QB) + ((size_t)(b * 6 + h) * SEQ + (size_t)qb * 256) * 128;
    r.K = (const attn::bf16*)(a.ws + WS_KB) + (size_t)(b * 2 + kvh) * SEQ * 128;
    r.V = (const attn::bf16*)(a.ws + WS_VB) + (size_t)(b * 2 + kvh) * SEQ * 128;
    r.O = (attn::bf16*)(a.ws + WS_MIX) + (size_t)(b * SEQ + qb * 256) * DM + h * 128;
    r.M = (const attn::u32x2*)(a.ws + WS_MASK) + (size_t)(b * SEQ + qb * 256) * 64;
    r.P0 = qb * 256; return r;
}
__device__ __forceinline__ void p11_attention(Ctx& c, ARGREF a) {
    constexpr int NITEM = 240;
#pragma unroll 1
    for (int it = c.vcu; it < NITEM; it += c.G) {
        const int bh = it / 10, slot = it % 10, b = bh / 6, h = bh % 6;
        const int q0 = slot < 3 ? 15 - slot : (slot == 9 ? 6 : slot - 3), q1 = slot < 3 ? q0 : (slot == 9 ? 6 : 15 - slot);
        attn::Seam S;
        attn::BlockRef cur = attn_ref(a, b, h, q0), nxt = attn_ref(a, b, h, q1);
        __syncthreads();
        attn::sel_prime(cur, (char*)c.lds, S);
        if (q0 != q1) attn::sel_block(cur, nxt, (char*)c.lds, S);
        attn::sel_block(nxt, nxt, (char*)c.lds, S);
    }
    if (c.G == 256) {
        if (c.vcu >= NITEM) { for (int j = 0; j < 4; ++j) { const int u = (c.vcu - NITEM) * 4 + j; attn_sample_unit(c, a, u >> 2, u & 3); } }
        else if (c.vcu % 10 == 9) { for (int j = 0; j < 3; ++j) { const int u = 64 + (c.vcu / 10) * 3 + j; if (u < MS) attn_sample_unit(c, a, u >> 2, u & 3); } }
    } else for (int u = c.vcu; u < MS; u += c.G) attn_sample_unit(c, a, u >> 2, u & 3);
}

enum { PH_PRO = 0, PH_IN0, PH_MIX0, PH_HSCAN, PH_HFIX, PH_OUT0, PH_GU0, PH_DOWN0, PH_IN1, PH_POST, PH_IDX, PH_TOPK, PH_ATTN, PH_OUT1, PH_GU1, PH_DOWN1, NPHASE };
#ifndef ONLYPH
#define ONLYPH -1
#endif
#define PHON(x) (ONLYPH < 0 || ONLYPH == (x))
#ifndef REP_PH
#define REP_PH -1
#endif
#ifndef REP_N
#define REP_N 1
#endif
__global__ void __launch_bounds__(NWAVES * 64, 2) fwd_kernel(Args args) {
    extern __shared__ __attribute__((aligned(16))) unsigned char lds[];
    Ctx c;
    c.lds = (LAS unsigned char*)lds;
    c.MISC = (volatile LAS unsigned*)(c.lds + MISC_OFF);
    c.tid = threadIdx.x; c.lane = c.tid & 63; c.wave = __builtin_amdgcn_readfirstlane(c.tid >> 6);
    c.G = gridDim.x; { const int bx = blockIdx.x; c.vcu = (c.G % 8 == 0) ? (bx % 8) * (c.G / 8) + bx / 8 : bx; }
    c.ctl = (gu32*)(args.ws + WS_CTL);
    for (int u = c.tid; u < (LDS_BYTES - LDSCTL_OFF) / 4; u += NWAVES * 64) ((LAS unsigned*)(c.lds + LDSCTL_OFF))[u] = 0u;
    __syncthreads();
    const int lo = args.ph_lo, hi = args.ph_hi;
    XcdBarrier bar; bar.bar = (unsigned*)(c.ctl + CW_BAR); bar.x = 0; bar.st = nullptr;
    if (hi - lo > 1 || REP_N > 1) bar = xcd_barrier_post((unsigned*)(c.ctl + CW_BAR), c.MISC + 8);
    c.qoff = 0;
#pragma unroll 1
    for (int ph = lo; ph < hi; ++ph) {
        const int layer = ph >= PH_IN1 ? 1 : 0;
        const __attribute__((address_space(4))) Args* ap = (const __attribute__((address_space(4))) Args*)__builtin_amdgcn_kernarg_segment_ptr(); asm volatile("" : "+s"(ap));
        ARGREF la = *ap; unsigned char* const ws = la.ws; float* const out = la.out;
        { int t_ = threadIdx.x; asm volatile("" : "+v"(t_)); c.tid = t_; c.lane = t_ & 63; c.wave = __builtin_amdgcn_readfirstlane(t_ >> 6); }
        if ((ph == PH_DOWN0 || ph == PH_DOWN1) && PHON(PH_OUT0)) {
            pg8::SchedX S0; S0.init(MP, 1024, c.G, (int)blockIdx.x, 0, 0, 1, 0); pg8::Unit u0; if (S0.next(0, u0)) conv_fixup_tile(c, la, layer, u0.pm); VM_WAIT(); __syncthreads(); }
        if (ph == PH_PRO && PHON(PH_PRO)) p0_prologue(c, la);
        else if ((ph == PH_IN0 || ph == PH_IN1) && PHON(PH_IN0)) {
            pg8::Gemm g{(const pg8::bf16_t*)(ws + WS_XB), (const pg8::bf16_t*)(ws + (ph == PH_IN0 ? WS_WIN0 : WS_WIN1)), MT, 0, 1024};
            pg8::SchedX S; if (ph == PH_IN0) S.init(MP, ZC0, c.G, (int)blockIdx.x, 16, MT / 256, 4, 13); else S.init(MP, ZC1, c.G, (int)blockIdx.x, 0, 0, 1, 0);
            pg8::EpiZ E{(pg8::bf16_t*)(ws + WS_Z), ph == PH_IN0 ? ZC0 : ZC1, ssptr(c, ph == PH_IN0 ? 0 : 2), ph == PH_IN0 ? 13 : 9, (float*)(ws + WS_MEMKV), MEMROW0};
            pg8::gemm_phase<pg8::EpiZ, pg8::SchedX, PG8_ALIGN, PG8_SP2>(c.lds + RING_OFF, g, S, E);
            { SgArgs sg{}; sg.A = (const bf16*)(ws + WS_XB) + (size_t)MP * DM; sg.Bt = (const bf16*)(ws + (ph == PH_IN0 ? WS_WIN0 : WS_WIN1)); sg.K = 1024; sg.mode = 0; sg.Z = (bf16*)(ws + WS_Z); sg.ldz = ph == PH_IN0 ? ZC0 : ZC1; sg.ssin = ssptr(c, ph == PH_IN0 ? 0 : 2);
              sgemm_phase(c, sg, ph == PH_IN0 ? ZC0 : ZC1); }
            if (ph == PH_IN0) { __syncthreads(); convert_layer1_tail(c, la, (64 * 13 + 16) % c.G); }
        }
        else if (ph == PH_MIX0 && PHON(PH_MIX0)) p2_mixer0(c, la);
        else if (ph == PH_HSCAN && PHON(PH_HSCAN)) hgrn_scan(c, la);
        else if (ph == PH_HFIX && PHON(PH_HFIX)) p2c_hgrn_fix(c, la);
        else if ((ph == PH_OUT0 || ph == PH_DOWN0 || ph == PH_OUT1 || ph == PH_DOWN1) && PHON(PH_OUT0)) {
            const bool isout = (ph == PH_OUT0 || ph == PH_OUT1);
            pg8::Gemm g{(const pg8::bf16_t*)(ws + (isout ? WS_MIX : WS_ACT)), (const pg8::bf16_t*)(ws + (isout ? WS_WOUT + (size_t)layer * 1024 * 1024 * 2 : WS_WD + (size_t)layer * 1024 * DFF * 2)), MT, 1024, isout ? 1024 : DFF};
            pg8::SchedX S; S.init(MP, 1024, c.G, (int)blockIdx.x, 0, 0, 1, 0);
            pg8::EpiResid E;
            E.rp = ph == PH_OUT0 ? la.in[0] : nullptr; E.rb = (const pg8::bf16_t*)(ws + WS_XB); E.y = ph == PH_DOWN1 ? out + O_YP : nullptr;
            E.xb = ph == PH_DOWN1 ? nullptr : (pg8::bf16_t*)(ws + WS_XB); E.ssout = ph == PH_DOWN1 ? nullptr : ssptr(c, ph == PH_OUT0 ? 1 : (ph == PH_DOWN0 ? 2 : 3));
            pg8::gemm_phase<pg8::EpiResid, pg8::SchedX, PG8_ALIGN, PG8_SP2>(c.lds + RING_OFF, g, S, E);
            { SgArgs sg{}; sg.A = (const bf16*)(ws + (isout ? WS_MIX : WS_ACT)) + (size_t)MP * (isout ? 1024 : DFF); sg.Bt = (const bf16*)g.Bt; sg.K = isout ? 1024 : DFF; sg.mode = 1; sg.rb = (const bf16*)(ws + WS_XB); sg.resid = ph == PH_OUT0 ? la.in[1] : nullptr; sg.y = ph == PH_DOWN1 ? out + O_YS : nullptr; sg.xb = (bf16*)E.xb; sg.ssout = E.ssout;
              sgemm_phase(c, sg, 1024); }
        }
        else if ((ph == PH_GU0 || ph == PH_GU1) && PHON(PH_GU0)) {
            pg8::Gemm g{(const pg8::bf16_t*)(ws + WS_XB), (const pg8::bf16_t*)(ws + WS_WGU + (size_t)layer * 5632 * 1024 * 2), MT, 5632, 1024};
            pg8::SchedX S; S.init(MP, 5632, c.G, (int)blockIdx.x, 0, 0, 1, 0);
            pg8::EpiGU E{(pg8::bf16_t*)(ws + WS_ACT), ssptr(c, layer ? 3 : 1), out + O_CVP + (size_t)layer * 4 * 2 * DFF, la.in[26] + (size_t)layer * 3 * DFF, la.in[27] + (size_t)layer * DFF, (float*)(ws + WS_G4), (float*)(ws + WS_UP2)};
            pg8::gemm_phase<pg8::EpiGU, pg8::SchedX, PG8_ALIGN, PG8_SP2>(c.lds + RING_OFF, g, S, E);
            { SgArgs sg{}; sg.A = (const bf16*)(ws + WS_XB) + (size_t)MP * DM; sg.Bt = (const bf16*)g.Bt; sg.K = 1024; sg.mode = 2; sg.ssin = E.ss; sg.ACT = (bf16*)E.ACT; sg.cvs = out + O_CVS + (size_t)layer * 32 * 2 * DFF; sg.cst = la.in[8] + (size_t)layer * 32 * 2 * DFF; sg.cw = E.cw; sg.cb = E.cb;
              sgemm_phase(c, sg, 5632); }
        }
        else if (ph == PH_POST && PHON(PH_POST)) p8_dsa_post(c, la);
        else if (ph == PH_IDX && PHON(PH_IDX)) p9_indexer(c, la);
        else if (ph == PH_TOPK && PHON(PH_TOPK)) p10_topk(c, la);
        else if (ph == PH_ATTN && PHON(PH_ATTN)) p11_attention(c, la);
        if (REP_N > 1 && ph == REP_PH && c.qoff < 4 * (REP_N - 1)) { c.qoff += 4; --ph; xcd_barrier(bar); continue; }
        if (REP_N > 1) c.qoff = 0;
        if (ph + 1 < hi) xcd_barrier(bar);
    }
}

#ifndef MK_ONE_LAUNCH
#define MK_ONE_LAUNCH 1
#endif
extern "C" void kernel_launch(void* const* d_in, const int* in_sizes, int n_in, void* d_out, int out_size, void* d_ws, size_t ws_size, hipStream_t stream) {
    static int grid = 0;
    if (grid == 0) {
        if (n_in != 29 || out_size != (int)O_END || ws_size < WS_END) { fprintf(stderr, "kernel_launch: unexpected problem (n_in %d, out %d, ws %zu)\n", n_in, out_size, ws_size); grid = -1; return; }
        int dev = 0, cus = 0;
        if (hipGetDevice(&dev) != hipSuccess || hipDeviceGetAttribute(&cus, hipDeviceAttributeMultiprocessorCount, dev) != hipSuccess) { grid = -1; return; }
        if (hipFuncSetAttribute((const void*)fwd_kernel, hipFuncAttributeMaxDynamicSharedMemorySize, LDS_BYTES) != hipSuccess) { fprintf(stderr, "kernel_launch: hipFuncSetAttribute failed\n"); grid = -1; return; }
        (void)hipGetLastError();
        grid = cus;
    }
    if (grid < 0) return;
    if (hipMemsetAsync((char*)d_ws + WS_CTL, 0, CTL_ZERO_BYTES, stream) != hipSuccess) { fprintf(stderr, "kernel_launch: memset failed\n"); return; }
    Args a{};
    for (int i = 0; i < 29; ++i) a.in[i] = (const float*)d_in[i];
    a.page_table = (const int*)d_in[9]; a.out = (float*)d_out; a.ws = (unsigned char*)d_ws;
#if MK_ONE_LAUNCH
    a.ph_lo = 0; a.ph_hi = NPHASE;
    hipLaunchKernelGGL(fwd_kernel, dim3(grid), dim3(NWAVES * 64), LDS_BYTES, stream, a);
#else
    for (int ph = 0; ph < NPHASE; ++ph) { a.ph_lo = ph; a.ph_hi = ph + 1; hipLaunchKernelGGL(fwd_kernel, dim3(grid), dim3(NWAVES * 64), LDS_BYTES, stream, a); }
#endif
}
```

```cpp
#include <hip/hip_runtime.h>
#include <cstdio>
#include <cstdint>


namespace pg8 {
#define PG8_LAS __attribute__((address_space(3)))
typedef unsigned short bf16_t;
typedef short bf16x8 __attribute__((ext_vector_type(8)));
typedef float f32x4 __attribute__((ext_vector_type(4)));
typedef unsigned u32x4 __attribute__((ext_vector_type(4)));
constexpr int BM = 256, BK = 64, HALF = 128, HTB = HALF * BK * 2  , STAGE_BYTES = 8 * HTB, NXCD = 8, WGM = 4;

__host__ __device__ __forceinline__ int lds_byte(int r, int c) { const int st = (r >> 4) * 2 + (c >> 5), rr = r & 15, cc = c & 31, ob = rr * 64 + cc * 2; return st * 1024 + (ob ^ (((ob >> 9) & 1) << 5)); }
__host__ __device__ __forceinline__ void stage_rc(int b, int& R, int& C) { const int st = b / 1024, sb = b % 1024, swz = sb ^ (((sb >> 9) & 1) << 5); R = (st >> 1) * 16 + swz / 64; C = (st & 1) * 32 + (swz % 64) / 2; }
__host__ __device__ __forceinline__ int perm32(int rho) { const int n = rho >> 4, i = rho & 15; return 8 * (i >> 2) + 4 * n + (i & 3); }

struct Unit { int pm, pn, roff, nai; };
struct Gemm { const bf16_t* A; const bf16_t* Bt; int M, N, K; };

struct StaticOrder {
    int nM, nN, nwg, G, c;
    __host__ __device__ __forceinline__ void init(int M, int N, int G_, int c_) { nM = M / BM; nN = N / BM; nwg = nM * nN; G = G_; c = c_; }
    __host__ __device__ __forceinline__ bool next(int i, Unit& u) const { const long L = (long)i * G + c; if (L >= nwg) return false; map(L, u); return true; }
    __host__ __device__ __forceinline__ void map(long L, Unit& u) const {
        u.roff = 0; u.nai = 2;
        int wgid = (int)L; { const int q = nwg / NXCD, r = nwg % NXCD, xcd = wgid % NXCD, off = wgid / NXCD; wgid = (xcd < r ? xcd * (q + 1) : r * (q + 1) + (xcd - r) * q) + off; }
        const int nig = WGM * nN, gid = wgid / nig, fm = gid * WGM, gsz = (nM - fm) < WGM ? (nM - fm) : WGM;
        u.pm = fm + ((wgid % nig) % gsz); u.pn = (wgid % nig) / gsz;
    }
    __device__ __forceinline__ void a_ready(const Unit&) const {}
    __device__ __forceinline__ void done(const Unit&) const {}
};


constexpr int MP = 16384, MS = 128, MVALID = MP + MS, MT = 16640, DM = 1024, DFF = 2816;
constexpr float RMS_EPS = 1e-6f;
__device__ __forceinline__ unsigned cvt_pk_bf16(float lo, float hi) { unsigned r; asm volatile("v_cvt_pk_bf16_f32 %0, %1, %2" : "=v"(r) : "v"(lo), "v"(hi)); return r; }

struct SchedX {
    StaticOrder so; int nextra, e_pm0, e_nm, e_pn0, rs, rem; bool split;
    __device__ __forceinline__ void init(int M, int N, int G_, int c_, int nextra_, int e_pm0_, int e_nm_, int e_pn0_, bool split_last = false) {
        so.init(M, N, G_, c_); nextra = nextra_; e_pm0 = e_pm0_; e_nm = e_nm_; e_pn0 = e_pn0_; rs = so.nwg / G_; rem = so.nwg % G_; split = split_last && nextra_ == 0 && rem > 0 && 2 * rem <= G_;
    }
    __device__ __forceinline__ bool next(int i, Unit& u) const {
        if (split && i >= rs) {
            if (i > rs || so.c >= 2 * rem) return false;
            const int hf = so.c / rem; so.map((long)rs * so.G + (so.c - hf * rem), u); u.roff = hf * HALF; u.nai = 1; return true;
        }
        const long L = (long)i * so.G + so.c;
        if (L < so.nwg) { so.map(L, u); return true; }
        const int e = (int)(L - so.nwg); if (e >= nextra) return false;
        u.roff = 0; u.nai = 2; u.pm = e_pm0 + e % e_nm; u.pn = e_pn0 + e / e_nm; return true;
    }
    __device__ __forceinline__ void a_ready(const Unit&) const {}
    __device__ __forceinline__ void done(const Unit&) const {}
};

struct EpiZ {
    static constexpr bool PERM = true, AFTER_DRAIN = false;
    bf16_t* Z; int ldz; const float* ss; int nmain; float* memkv; int memrow0;
    __device__ __forceinline__ void operator()(const f32x4 (&acc)[2][2][4][2], const Unit& u, int wr, int wc, int fr, int fq) const {
        const int row0 = u.pm * BM + u.roff + wr * 64 + fr;
        if (u.pn < nmain) {
            const int col0 = u.pn * BM + wc * 32 + 8 * fq;
#pragma unroll
            for (int ai = 0; ai < 2; ++ai) if (ai < u.nai)
#pragma unroll
                for (int m = 0; m < 4; ++m) { const int row = row0 + ai * HALF + m * 16; const float rs = rsqrtf(ss[row] * (1.0f / DM) + RMS_EPS);
#pragma unroll
                    for (int bj = 0; bj < 2; ++bj) { const f32x4 v0 = acc[ai][bj][m][0] * rs, v1 = acc[ai][bj][m][1] * rs;
                        u32x4 w; w.x = cvt_pk_bf16(v0[0], v0[1]); w.y = cvt_pk_bf16(v0[2], v0[3]); w.z = cvt_pk_bf16(v1[0], v1[1]); w.w = cvt_pk_bf16(v1[2], v1[3]);
                        *(u32x4*)(Z + (size_t)row * ldz + col0 + bj * HALF) = w; } }
        } else {
            const int col0 = (u.pn - nmain) * BM + wc * 32 + 8 * fq;
#pragma unroll
            for (int ai = 0; ai < 2; ++ai)
#pragma unroll
                for (int m = 0; m < 4; ++m) { const int row = row0 + ai * HALF + m * 16 - memrow0;
#pragma unroll
                    for (int bj = 0; bj < 2; ++bj) { float* p = memkv + (size_t)row * 1024 + col0 + bj * HALF; *(f32x4*)p = acc[ai][bj][m][0]; *(f32x4*)(p + 4) = acc[ai][bj][m][1]; } }
        }
    }
};

struct EpiResid {
    static constexpr bool PERM = true, AFTER_DRAIN = false;
    const float* rp; const bf16_t* rb; float* y; bf16_t* xb; float* ssout;
    __device__ __forceinline__ void operator()(const f32x4 (&acc)[2][2][4][2], const Unit& u, int wr, int wc, int fr, int fq) const {
        const int row0 = u.pm * BM + wr * 64 + fr, col0 = u.pn * BM + wc * 32 + 8 * fq;
#pragma unroll
        for (int ai = 0; ai < 2; ++ai)
#pragma unroll
            for (int m = 0; m < 4; ++m) { const int row = row0 + ai * HALF + m * 16; float part = 0.f;
#pragma unroll
                for (int bj = 0; bj < 2; ++bj) { const int c = col0 + bj * HALF; f32x4 r0, r1;
                    if (rp) { r0 = *(const f32x4*)(rp + (size_t)row * DM + c); r1 = *(const f32x4*)(rp + (size_t)row * DM + c + 4); }
                    else { const u32x4 q = *(const u32x4*)(rb + (size_t)row * DM + c);
                        r0 = (f32x4){__builtin_bit_cast(float, q.x << 16), __builtin_bit_cast(float, q.x & 0xffff0000u), __builtin_bit_cast(float, q.y << 16), __builtin_bit_cast(float, q.y & 0xffff0000u)};
                        r1 = (f32x4){__builtin_bit_cast(float, q.z << 16), __builtin_bit_cast(float, q.z & 0xffff0000u), __builtin_bit_cast(float, q.w << 16), __builtin_bit_cast(float, q.w & 0xffff0000u)}; }
                    const f32x4 v0 = acc[ai][bj][m][0] + r0, v1 = acc[ai][bj][m][1] + r1;
                    if (y) { *(f32x4*)(y + (size_t)row * DM + c) = v0; *(f32x4*)(y + (size_t)row * DM + c + 4) = v1; }
                    part += (v0[0] * v0[0] + v0[1] * v0[1]) + (v0[2] * v0[2] + v0[3] * v0[3]) + (v1[0] * v1[0] + v1[1] * v1[1]) + (v1[2] * v1[2] + v1[3] * v1[3]);
                    if (xb) { u32x4 w; w.x = cvt_pk_bf16(v0[0], v0[1]); w.y = cvt_pk_bf16(v0[2], v0[3]); w.z = cvt_pk_bf16(v1[0], v1[1]); w.w = cvt_pk_bf16(v1[2], v1[3]);
                        *(u32x4*)(xb + (size_t)row * DM + c) = w; } }
                part += __shfl_xor(part, 16); part += __shfl_xor(part, 32);
                if (ssout && fq == 0) atomicAdd(ssout + row, part); }
    }
};

__device__ __forceinline__ void dpp_ror12(const f32x4& v, f32x4& r1, f32x4& r2) {
    float a0, a1, a2, a3, b0, b1, b2, b3;
    asm volatile("s_nop 1\n\t"
                 "v_mov_b32_dpp %0, %8 row_ror:1 row_mask:0xf bank_mask:0xf\n\tv_mov_b32_dpp %1, %9 row_ror:1 row_mask:0xf bank_mask:0xf\n\t"
                 "v_mov_b32_dpp %2, %10 row_ror:1 row_mask:0xf bank_mask:0xf\n\tv_mov_b32_dpp %3, %11 row_ror:1 row_mask:0xf bank_mask:0xf\n\t"
                 "v_mov_b32_dpp %4, %8 row_ror:2 row_mask:0xf bank_mask:0xf\n\tv_mov_b32_dpp %5, %9 row_ror:2 row_mask:0xf bank_mask:0xf\n\t"
                 "v_mov_b32_dpp %6, %10 row_ror:2 row_mask:0xf bank_mask:0xf\n\tv_mov_b32_dpp %7, %11 row_ror:2 row_mask:0xf bank_mask:0xf"
                 : "=&v"(a0), "=&v"(a1), "=&v"(a2), "=&v"(a3), "=&v"(b0), "=&v"(b1), "=&v"(b2), "=&v"(b3) : "v"(v[0]), "v"(v[1]), "v"(v[2]), "v"(v[3]));
    r1 = (f32x4){a0, a1, a2, a3}; r2 = (f32x4){b0, b1, b2, b3};
}
struct EpiGU {
    static constexpr bool PERM = true, AFTER_DRAIN = false;
    bf16_t* ACT; const float* ss; float* cvp; const float* cw; const float* cb; float* G4; float* UP2;
    __device__ __forceinline__ void operator()(const f32x4 (&acc)[2][2][4][2], const Unit& u, int wr, int wc, int fr, int fq) const {
        const int row0 = u.pm * BM + u.roff + wr * 64 + fr, colg = u.pn * HALF + wc * 32 + 8 * fq;
        f32x4 w0[2], w1[2], w2[2], bb[2];
#pragma unroll
        for (int n = 0; n < 2; ++n) { const int col = colg + 4 * n; w0[n] = *(const f32x4*)(cw + col); w1[n] = *(const f32x4*)(cw + DFF + col); w2[n] = *(const f32x4*)(cw + 2 * DFF + col); bb[n] = *(const f32x4*)(cb + col); }
#pragma unroll
        for (int ai = 0; ai < 2; ++ai) if (ai < u.nai) { f32x4 r1p[2] = {{0.f, 0.f, 0.f, 0.f}, {0.f, 0.f, 0.f, 0.f}}, r2p[2] = {{0.f, 0.f, 0.f, 0.f}, {0.f, 0.f, 0.f, 0.f}}; const int slab = (u.pm * BM + u.roff + ai * HALF + wr * 64) >> 6;
#pragma unroll
            for (int m = 0; m < 4; ++m) { const int row = row0 + ai * HALF + m * 16; const float rs = rsqrtf(ss[row] * (1.0f / DM) + RMS_EPS);
                f32x4 y[2], g[2], up[2];
#pragma unroll
                for (int n = 0; n < 2; ++n) { g[n] = acc[ai][0][m][n] * rs; up[n] = acc[ai][1][m][n] * rs;
                    f32x4 r1, r2; dpp_ror12(g[n], r1, r2);
                    const f32x4 p1 = fr >= 1 ? r1 : r1p[n], p2 = fr >= 2 ? r2 : r2p[n];
                    const f32x4 cv = bb[n] + w0[n] * p2 + w1[n] * p1 + w2[n] * g[n];
#pragma unroll
                    for (int i = 0; i < 4; ++i) y[n][i] = cv[i] * __builtin_amdgcn_rcpf(1.0f + __expf(-cv[i])) * up[n][i];
                    r1p[n] = r1; r2p[n] = r2; }
                if (m == 0 && fr < 2) {
#pragma unroll
                    for (int n = 0; n < 2; ++n) { *(f32x4*)(G4 + (size_t)(slab * 4 + fr) * DFF + colg + 4 * n) = g[n]; *(f32x4*)(UP2 + (size_t)(slab * 2 + fr) * DFF + colg + 4 * n) = up[n]; } }
                else { u32x4 w; w.x = cvt_pk_bf16(y[0][0], y[0][1]); w.y = cvt_pk_bf16(y[0][2], y[0][3]); w.z = cvt_pk_bf16(y[1][0], y[1][1]); w.w = cvt_pk_bf16(y[1][2], y[1][3]); *(u32x4*)(ACT + (size_t)row * DFF + colg) = w; }
                if (m == 3 && fr >= 14) {
#pragma unroll
                    for (int n = 0; n < 2; ++n) { *(f32x4*)(G4 + (size_t)(slab * 4 + 2 + (fr - 14)) * DFF + colg + 4 * n) = g[n];
                        const int t = row & 4095; if (t >= 4094) *(f32x4*)(cvp + (size_t)((row >> 12) * 2 + (t - 4094)) * DFF + colg + 4 * n) = g[n]; } } } }
    }
};

template <class Epi, class Sched, bool ALIGN_EPI = false, bool SP2 = false, bool HALFOK = false>
__device__ __forceinline__ void gemm_phase(PG8_LAS unsigned char* lds, const Gemm g, const Sched& S, const Epi& E) {
    int tid_ = threadIdx.x; asm volatile("" : "+v"(tid_));
    const int tid = tid_, wid = __builtin_amdgcn_readfirstlane(tid >> 6), lane = tid & 63, wr = wid >> 2, wc = wid & 3, fr = lane & 15, fq = lane >> 4;
    const int K = g.K, nt = K / BK;
    unsigned voffA[2], voffB[2];
#pragma unroll
    for (int i = 0; i < 2; ++i) { int R, C; stage_rc(tid * 16 + i * 8192, R, C); const int Rb = Epi::PERM ? ((R & ~31) + perm32(R & 31)) : R;
        voffA[i] = (unsigned)(R * K + C) * 2u; voffB[i] = (unsigned)(Rb * K + C) * 2u; }
    const size_t kstep = (size_t)(BK * 2);
    const size_t hstep = (size_t)HALF * K * 2;
    const size_t tstep = 2 * hstep;
    const unsigned ldsw = (unsigned)wid * 1024u;
    const int aoff = lds_byte(wr * 64 + fr, fq * 8), boff = lds_byte(wc * 32 + fr, fq * 8);
#define PG8_SA(b, h) (((b) * 2 + (h)) * HTB)
#define PG8_SB(b, h) ((4 + (b) * 2 + (h)) * HTB)
#define PG8_STAGE(bufoff, gbase, voff) do { _Pragma("unroll") for (int _i = 0; _i < 2; ++_i) \
        __builtin_amdgcn_global_load_lds((const unsigned*)((const char*)(gbase) + (voff)[_i]), (PG8_LAS unsigned*)(lds + (bufoff) + ldsw + _i * 8192), 16, 0, 0); } while (0)
#define PG8_LDA(dst, b, h) do { _Pragma("unroll") for (int m = 0; m < 4; ++m) _Pragma("unroll") for (int k = 0; k < 2; ++k) dst[m][k] = *(const PG8_LAS bf16x8*)(lds + PG8_SA(b, h) + aoff + m * 2048 + k * 1024); } while (0)
#define PG8_LDB(dst, b, h) do { _Pragma("unroll") for (int n = 0; n < 2; ++n) _Pragma("unroll") for (int k = 0; k < 2; ++k) dst[n][k] = *(const PG8_LAS bf16x8*)(lds + PG8_SB(b, h) + boff + n * 2048 + k * 1024); } while (0)
#define PG8_MMA(ai, bj, At, Bt) do { __builtin_amdgcn_s_setprio(1); _Pragma("unroll") for (int m = 0; m < 4; ++m) _Pragma("unroll") for (int n = 0; n < 2; ++n) _Pragma("unroll") for (int k = 0; k < 2; ++k) \
        acc[ai][bj][m][n] = __builtin_amdgcn_mfma_f32_16x16x32_bf16(Bt[n][k], At[m][k], acc[ai][bj][m][n], 0, 0, 0); __builtin_amdgcn_s_setprio(0); } while (0)
#define PG8_WAIT_V(n) asm volatile("s_waitcnt vmcnt(" #n ")" ::: "memory")
#define PG8_WAIT_L(n) asm volatile("s_waitcnt lgkmcnt(" #n ")" ::: "memory")
#define PG8_BAR __builtin_amdgcn_s_barrier()
#define PG8_SCHED __builtin_amdgcn_sched_barrier(0)
    Unit cur, nxt; int ui = 0;
    if (!S.next(0, cur)) return;
    f32x4 acc[2][2][4][2];
#pragma unroll
    for (int a = 0; a < 2; ++a)
#pragma unroll
        for (int b = 0; b < 2; ++b)
#pragma unroll
            for (int m = 0; m < 4; ++m)
#pragma unroll
                for (int n = 0; n < 2; ++n) acc[a][b][m][n] = (f32x4){0.f, 0.f, 0.f, 0.f};
    bf16x8 At[4][2], B0[2][2], B1[2][2];
    const char* cA = (const char*)g.A + (size_t)cur.pm * tstep + (size_t)cur.roff * K * 2; const char* cB = (const char*)g.Bt + (size_t)cur.pn * tstep;
    S.a_ready(cur);
    if constexpr (SP2) {
        PG8_STAGE(PG8_SB(0, 0), cB, voffB); PG8_STAGE(PG8_SB(0, 1), cB + hstep, voffB); PG8_STAGE(PG8_SA(0, 0), cA, voffA); PG8_STAGE(PG8_SA(0, 1), cA + hstep, voffA);
        if (wr == 1) PG8_BAR;
        PG8_WAIT_V(2); PG8_BAR;
        PG8_STAGE(PG8_SB(1, 0), cB + kstep, voffB); PG8_STAGE(PG8_SA(1, 0), cA + kstep, voffA); PG8_STAGE(PG8_SB(1, 1), cB + hstep + kstep, voffB);
        PG8_WAIT_V(6); PG8_BAR;
    } else {
        PG8_STAGE(PG8_SB(0, 0), cB, voffB); PG8_STAGE(PG8_SA(0, 0), cA, voffA); PG8_STAGE(PG8_SB(0, 1), cB + hstep, voffB); PG8_STAGE(PG8_SA(0, 1), cA + hstep, voffA);
        if (wr == 1) PG8_BAR;
        PG8_WAIT_V(4); PG8_BAR;
        PG8_STAGE(PG8_SB(1, 0), cB + kstep, voffB); PG8_STAGE(PG8_SA(1, 0), cA + kstep, voffA); PG8_STAGE(PG8_SB(1, 1), cB + hstep + kstep, voffB);
        PG8_WAIT_V(6); PG8_BAR;
    }
    for (;;) {
        const bool has_next = S.next(ui + 1, nxt);
        const char* nA = has_next ? (const char*)g.A + (size_t)nxt.pm * tstep + (size_t)nxt.roff * K * 2 : cA; const char* nB = has_next ? (const char*)g.Bt + (size_t)nxt.pn * tstep : cB;
        const bool full = !HALFOK || cur.nai == 2;
        for (int t = 0; t < nt; t += 2) {
            const bool last = (t == nt - 2);
            const char* a1 = cA + (size_t)(t + 1) * kstep;
            const char* a2 = last ? nA : cA + (size_t)(t + 2) * kstep; const char* b2 = last ? nB : cB + (size_t)(t + 2) * kstep;
            const char* a3 = a2 + kstep; const char* b3 = b2 + kstep;
            if (last && has_next) S.a_ready(nxt);
            if constexpr (SP2) {
            PG8_LDB(B0, 0, 0); PG8_LDB(B1, 0, 1); PG8_SCHED; PG8_LDA(At, 0, 0); PG8_STAGE(PG8_SA(1, 1), a1 + hstep, voffA);
            PG8_WAIT_V(8); PG8_WAIT_L(0); PG8_BAR; PG8_MMA(0, 0, At, B0); PG8_MMA(0, 1, At, B1); PG8_BAR; PG8_SCHED;
            if (full) PG8_LDA(At, 0, 1); PG8_STAGE(PG8_SB(0, 0), b2, voffB); PG8_STAGE(PG8_SB(0, 1), b2 + hstep, voffB); PG8_STAGE(PG8_SA(0, 0), a2, voffA);
            PG8_WAIT_V(8); PG8_WAIT_L(0); PG8_BAR; if (full) { PG8_MMA(1, 0, At, B0); PG8_MMA(1, 1, At, B1); } PG8_BAR; PG8_SCHED;
            PG8_LDB(B0, 1, 0); PG8_LDB(B1, 1, 1); PG8_SCHED; PG8_LDA(At, 1, 0); PG8_STAGE(PG8_SA(0, 1), a2 + hstep, voffA);
            PG8_WAIT_V(8); PG8_WAIT_L(0); PG8_BAR; PG8_MMA(0, 0, At, B0); PG8_MMA(0, 1, At, B1); PG8_BAR; PG8_SCHED;
            if (full) PG8_LDA(At, 1, 1); PG8_STAGE(PG8_SB(1, 0), b3, voffB); PG8_STAGE(PG8_SB(1, 1), b3 + hstep, voffB); PG8_STAGE(PG8_SA(1, 0), a3, voffA);
            PG8_WAIT_V(8); PG8_WAIT_L(0); PG8_BAR; if (full) { PG8_MMA(1, 0, At, B0); PG8_MMA(1, 1, At, B1); } PG8_BAR; PG8_SCHED;
            } else {
            PG8_LDB(B0, 0, 0); PG8_SCHED; PG8_LDA(At, 0, 0); PG8_STAGE(PG8_SA(1, 1), a1 + hstep, voffA);
            PG8_WAIT_L(8); PG8_BAR; PG8_WAIT_L(0); PG8_MMA(0, 0, At, B0); PG8_BAR; PG8_SCHED;
            PG8_LDB(B1, 0, 1); PG8_STAGE(PG8_SB(0, 0), b2, voffB);
            PG8_BAR; PG8_WAIT_L(0); PG8_MMA(0, 1, At, B1); PG8_BAR;
            PG8_LDA(At, 0, 1); PG8_STAGE(PG8_SA(0, 0), a2, voffA);
            PG8_BAR; PG8_WAIT_L(0); PG8_MMA(1, 0, At, B0); PG8_BAR; PG8_SCHED;
            PG8_STAGE(PG8_SB(0, 1), b2 + hstep, voffB);
            PG8_WAIT_V(6); PG8_BAR; PG8_MMA(1, 1, At, B1); PG8_BAR;
            PG8_LDB(B0, 1, 0); PG8_SCHED; PG8_LDA(At, 1, 0); PG8_STAGE(PG8_SA(0, 1), a2 + hstep, voffA);
            PG8_WAIT_L(8); PG8_BAR; PG8_WAIT_L(0); PG8_MMA(0, 0, At, B0); PG8_BAR; PG8_SCHED;
            PG8_LDB(B1, 1, 1); PG8_STAGE(PG8_SB(1, 0), b3, voffB);
            PG8_BAR; PG8_WAIT_L(0); PG8_MMA(0, 1, At, B1); PG8_BAR;
            PG8_LDA(At, 1, 1); PG8_STAGE(PG8_SA(1, 0), a3, voffA);
            PG8_BAR; PG8_WAIT_L(0); PG8_MMA(1, 0, At, B0); PG8_BAR; PG8_SCHED;
            PG8_STAGE(PG8_SB(1, 1), b3 + hstep, voffB);
            PG8_WAIT_V(6); PG8_BAR; PG8_MMA(1, 1, At, B1); PG8_BAR;
            }
        }
        if constexpr (ALIGN_EPI) { if (wr == 0) PG8_BAR; }
        if constexpr (!Epi::AFTER_DRAIN) { E(acc, cur, wr, wc, fr, fq); S.done(cur); }
        if (!has_next) break;
#pragma unroll
        for (int a = 0; a < 2; ++a)
#pragma unroll
            for (int b = 0; b < 2; ++b)
#pragma unroll
                for (int m = 0; m < 4; ++m)
#pragma unroll
                    for (int n = 0; n < 2; ++n) acc[a][b][m][n] = (f32x4){0.f, 0.f, 0.f, 0.f};
        cur = nxt; cA = nA; cB = nB; ++ui;
        if constexpr (ALIGN_EPI) { if (wr == 1) PG8_BAR; }
    }
    PG8_WAIT_V(0);
    if constexpr (!ALIGN_EPI) { if (wr == 0) PG8_BAR; }
    PG8_BAR;
    if constexpr (Epi::AFTER_DRAIN) { E.fused(acc, cur, wr, wc, fr, fq, lds, wid, lane); S.done(cur); }
#undef PG8_SA
#undef PG8_SB
#undef PG8_STAGE
#undef PG8_LDA
#undef PG8_LDB
#undef PG8_MMA
#undef PG8_WAIT_V
#undef PG8_WAIT_L
#undef PG8_BAR
#undef PG8_SCHED
}
}


#ifndef PG8_SP2
#define PG8_SP2 true
#endif
#ifndef PG8_ALIGN
#define PG8_ALIGN true
#endif
constexpr int NWAVES = 8;
constexpr int MP = pg8::MP, MS = pg8::MS, MVALID = pg8::MVALID, MT = pg8::MT, DM = 1024, DFF = 2816;
constexpr int SEQ = 4096, NB = 4, NSB = 32, PAST = 8192, NPOOL = 2560;
constexpr int ZC0 = 3328, ZC1 = 2304;
constexpr int Z1_Q = 0, Z1_K = 768, Z1_V = 1024, Z1_IQ = 1280, Z1_IK = 1792, Z1_IW = 1856, Z1_MQ = 1920;
constexpr int NMEMROWS = 1024, MEMROW0 = MT;
constexpr float EPS = 1e-6f;
constexpr size_t MiB = 1u << 20;
constexpr size_t WS_CTL = 0, CTL_ZERO_BYTES = 2 * MiB;
constexpr size_t WS_WIN0 = 2 * MiB, WS_WIN1 = 11 * MiB, WS_WOUT = 16 * MiB, WS_WGU = 20 * MiB, WS_WD = 42 * MiB;
constexpr size_t WS_XB = 54 * MiB, WS_MEMKV = 89 * MiB, WS_MIX = 94 * MiB, WS_Z = 128 * MiB, WS_U = 234 * MiB, WS_UP = 324 * MiB, WS_ACT = 414 * MiB;
constexpr size_t WS_QB = 504 * MiB, WS_KB = 528 * MiB, WS_VB = 536 * MiB, WS_IQB = 544 * MiB, WS_IKB = 560 * MiB, WS_IW = 562 * MiB;
constexpr size_t WS_SQ = 563 * MiB, WS_SIQ = WS_SQ + 512 * 1024, WS_SIW = WS_SIQ + 384 * 1024, WS_SSC = 564 * MiB, WS_SIDX = 569 * MiB, WS_MASK = 570 * MiB, WS_SC = 578 * MiB, WS_END = 834 * MiB;
constexpr int SSC_LD = 8256;
constexpr int CW_TMO = 0, CW_BAR = 4096, CW_Q = 8192, CW_SS = 16384;
constexpr size_t O_YP = 0, O_YS = O_YP + (size_t)MP * DM, O_HP = O_YS + (size_t)MS * DM, O_HS = O_HP + 4 * 6 * 16384, O_KP = O_HS + 32 * 6 * 16384,
    O_VP = O_KP + (size_t)MP * 256, O_IKP = O_VP + (size_t)MP * 256, O_KS = O_IKP + (size_t)MP * 64, O_VS = O_KS + MS * 256, O_IKS = O_VS + MS * 256,
    O_MK = O_IKS + MS * 64, O_MV = O_MK + 2 * 1024 * 256, O_CVP = O_MV + 2 * 1024 * 256, O_CVS = O_CVP + 2 * 4 * 2 * DFF, O_END = O_CVS + 2 * 32 * 2 * DFF;
static_assert(O_END == 31412224, "output size");
constexpr int RING_OFF = 0, RING_BYTES = 131072;
constexpr int LDSCTL_OFF = RING_BYTES, MISC_OFF = LDSCTL_OFF + 320;
constexpr int LDS_BYTES = 147456;

#define GAS __attribute__((address_space(1)))
#define LAS __attribute__((address_space(3)))
typedef unsigned short bf16;
typedef unsigned v4u __attribute__((ext_vector_type(4)));
typedef float f32x4 __attribute__((ext_vector_type(4)));
typedef short bf16x8 __attribute__((ext_vector_type(8)));
typedef GAS unsigned gu32;
typedef GAS unsigned long long gu64;
#define RLX_AGENT __ATOMIC_RELAXED, __HIP_MEMORY_SCOPE_AGENT
#define LDS_WAIT() asm volatile("s_waitcnt lgkmcnt(0)" ::: "memory")
#define VM_WAIT() asm volatile("s_waitcnt vmcnt(0)" ::: "memory")
__device__ __forceinline__ unsigned long long rt() { return __builtin_amdgcn_s_memrealtime(); }
__device__ __forceinline__ unsigned f2bf(float f) { unsigned u = __builtin_bit_cast(unsigned, f); return (u + 0x7fffu + ((u >> 16) & 1u)) >> 16; }
__device__ __forceinline__ unsigned pk2(float lo, float hi) { return f2bf(lo) | (f2bf(hi) << 16); }

#define XB_TMO      128
#define XB_XCNT(j)  (256  + 64 * (j))
#define XB_XSUB(j)  (1280 + 64 * (j))
#define XB_XGEN(j)  (2304 + 64 * (j))
#define XB_TOP      3328
#define XB_TOPGEN   3392
#define XCD_BAR_WORDS 3456
#define XB_SPIN_CAP (1u << 18)

__device__ __forceinline__ unsigned xb_ld(unsigned* p)              { return __hip_atomic_load(p, __ATOMIC_RELAXED, __HIP_MEMORY_SCOPE_AGENT); }
__device__ __forceinline__ unsigned xb_add(unsigned* p, unsigned v) { return __hip_atomic_fetch_add(p, v, __ATOMIC_RELAXED, __HIP_MEMORY_SCOPE_AGENT); }
__device__ __forceinline__ unsigned xb_xcc_id() { return (unsigned)__builtin_amdgcn_s_getreg((3 << 11) | 20) & 0xFu; }
#define XB_SPIN(cond, bar) do { unsigned _sp = 0; while (cond) { __builtin_amdgcn_s_sleep(1); \
    if ((++_sp & 255u) == 0u) { if (xb_ld(&(bar)[XB_TMO])) break; if (_sp > XB_SPIN_CAP) { atomicAdd(&(bar)[XB_TMO], 1u); break; } } } } while (0)

struct XcdBarrier {
    unsigned* bar; unsigned x;
    volatile LAS unsigned* st;
};

__device__ __forceinline__ XcdBarrier xcd_barrier_post(unsigned* bar, volatile LAS unsigned* st) {
    XcdBarrier b; b.bar = bar; b.x = xb_xcc_id(); b.st = st;
    if (threadIdx.x == 0) (void)xb_add(&bar[XB_XCNT(b.x)], 1u);
    return b;
}
__device__ __forceinline__ void xcd_barrier_complete(unsigned* bar, unsigned x, unsigned& nloc, unsigned& nx) {
    const unsigned G = gridDim.x * gridDim.y * gridDim.z;
    unsigned sum, cnt, mine, sp = 0u;
    for (;;) {
        sum = 0u; cnt = 0u; mine = 0u;
#pragma unroll
        for (unsigned j = 0; j < 16; ++j) { const unsigned c = xb_ld(&bar[XB_XCNT(j)]); sum += c; cnt += (c > 0u) ? 1u : 0u; mine = (j == x) ? c : mine; }
        if (sum == G) break;
        __builtin_amdgcn_s_sleep(1);
        if ((++sp & 255u) == 0u) { if (xb_ld(&bar[XB_TMO])) break; if (sp > XB_SPIN_CAP) { atomicAdd(&bar[XB_TMO], 1u); break; } }
    }
    nloc = mine > 0u ? mine : 1u; nx = cnt > 0u ? cnt : 1u;
}

__device__ __forceinline__ void xcd_barrier(const XcdBarrier& b) {
    asm volatile("s_waitcnt vmcnt(0)" ::: "memory");
    __syncthreads();
    if (threadIdx.x == 0) {
        unsigned* bar = b.bar;
        __builtin_amdgcn_s_waitcnt(0);
        unsigned nloc = b.st[0], nx = b.st[1];
        if (nloc == 0u) { xcd_barrier_complete(bar, b.x, nloc, nx); b.st[0] = nloc; b.st[1] = nx; }
        const unsigned old = xb_add(&bar[XB_XSUB(b.x)], 1u);
        const unsigned gen = old / nloc;
        if (old + 1u == (gen + 1u) * nloc) {
            __builtin_amdgcn_fence(__ATOMIC_RELEASE, "agent");
            asm volatile("s_waitcnt vmcnt(0)" ::: "memory");
            const unsigned og = xb_add(&bar[XB_TOP], 1u);
            const unsigned tg = og / nx;
            if (og + 1u == (tg + 1u) * nx) xb_add(&bar[XB_TOPGEN], 1u);
            else XB_SPIN(xb_ld(&bar[XB_TOPGEN]) == tg, bar);
            __builtin_amdgcn_fence(__ATOMIC_ACQUIRE, "agent");
            xb_add(&bar[XB_XGEN(b.x)], 1u);
            asm volatile("s_waitcnt vmcnt(0)" ::: "memory");
        } else {
            XB_SPIN(xb_ld(&bar[XB_XGEN(b.x)]) == gen, bar);
            __builtin_amdgcn_fence(__ATOMIC_ACQUIRE, "agent");
            asm volatile("s_waitcnt vmcnt(0)" ::: "memory");
        }
    }
    __syncthreads();
}


struct Args { const float* in[29]; const int* page_table; float* out; unsigned char* ws; int ph_lo, ph_hi; };
typedef const __attribute__((address_space(4))) Args& ARGREF;
struct Ctx { LAS unsigned char* lds; volatile LAS unsigned* MISC; gu32* ctl; int tid, lane, wave, vcu, G, qoff; };
typedef float f32x16 __attribute__((ext_vector_type(16)));
typedef unsigned long long u64;

__device__ __forceinline__ float bf2f(unsigned b) { return __builtin_bit_cast(float, b << 16); }
__device__ __forceinline__ float wave_sum(float v) {
#pragma unroll
    for (int o = 1; o < 64; o <<= 1) v += __shfl_xor(v, o);
    return v;
}
__device__ __forceinline__ float wave_sum_fast(float x) {
    x += __builtin_bit_cast(float, __builtin_amdgcn_update_dpp(0, __builtin_bit_cast(int, x), 0xB1, 0xF, 0xF, false));
    x += __builtin_bit_cast(float, __builtin_amdgcn_update_dpp(0, __builtin_bit_cast(int, x), 0x4E, 0xF, 0xF, false));
    x += __builtin_bit_cast(float, __builtin_amdgcn_update_dpp(0, __builtin_bit_cast(int, x), 0x141, 0xF, 0xF, false));
    x += __builtin_bit_cast(float, __builtin_amdgcn_update_dpp(0, __builtin_bit_cast(int, x), 0x140, 0xF, 0xF, false));
    const int xi = __builtin_bit_cast(int, x);
    return (__builtin_bit_cast(float, __builtin_amdgcn_readlane(xi, 0)) + __builtin_bit_cast(float, __builtin_amdgcn_readlane(xi, 16))) +
           (__builtin_bit_cast(float, __builtin_amdgcn_readlane(xi, 32)) + __builtin_bit_cast(float, __builtin_amdgcn_readlane(xi, 48)));
}
__device__ __forceinline__ int crow(int r, int hi) { return (r & 3) + 8 * (r >> 2) + 4 * hi; }
__device__ __forceinline__ float sigmoidf_(float x) { return __builtin_amdgcn_rcpf(1.0f + __expf(-x)); }
__device__ __forceinline__ float* ssptr(const Ctx& c, int i) { return (float*)(c.ctl + CW_SS) + (size_t)i * MT; }

__device__ __forceinline__ int q_next(Ctx& c, int qi) {
    __syncthreads();
    if (c.tid == 0) c.MISC[16] = atomicAdd((unsigned*)(c.ctl + CW_Q + 64 * (qi + c.qoff)), 1u);
    __syncthreads();
    return (int)c.MISC[16];
}

template <int K>
__device__ __forceinline__ f32x16 mm32(const LAS bf16* A, int lda, const LAS bf16* Bt, int ldb, f32x16 acc, int lane) {
    const int r = lane & 31, h = lane >> 5;
#pragma unroll
    for (int ks = 0; ks < K; ks += 16) {
        const bf16x8 a = *(const LAS bf16x8*)(A + r * lda + ks + 8 * h);
        const bf16x8 b = *(const LAS bf16x8*)(Bt + r * ldb + ks + 8 * h);
        acc = __builtin_amdgcn_mfma_f32_32x32x16_bf16(a, b, acc, 0, 0, 0);
    }
    return acc;
}

__device__ __forceinline__ int map_row(int mapid, int n, int row_off) {
    if (mapid == 0) return n + row_off;
    if (mapid == 1) return n < 1864 ? n : n + 56;
    if (mapid == 2) return (n >> 7) * 256 + (n & 127);
    return (n >> 7) * 256 + 128 + (n & 127);
}
template <int MODE>
__device__ __forceinline__ void transpose_item(const float* W, int K, int N, const float* kscale, bf16* WT, int mapid, int row_off, LAS float* scr, int item, int lane, f32x4 (&v)[8], float (&sc)[8]) {
    const int nblk = (N + 31) / 32, kb = item / nblk, nb = item % nblk, k0 = 64 * kb, n0 = 32 * nb;
    const int n4 = (lane & 7) * 4;
    if (MODE != 2) { const int nn = n0 + n4 < N ? n0 + n4 : N - 4;
#pragma unroll
      for (int i = 0; i < 8; ++i) v[i] = *(const f32x4*)(W + (size_t)(k0 + 8 * i + (lane >> 3)) * N + nn);
#pragma unroll
      for (int i = 0; i < 8; ++i) sc[i] = kscale ? kscale[k0 + 8 * i + (lane >> 3)] : 1.0f; }
    if (MODE == 1) return;
#pragma unroll
    for (int i = 0; i < 8; ++i) { const int kk = 8 * i + (lane >> 3); LAS float* d = scr + kk * 33 + n4;
        d[0] = v[i].x * sc[i]; d[1] = v[i].y * sc[i]; d[2] = v[i].z * sc[i]; d[3] = v[i].w * sc[i]; }
    LDS_WAIT(); asm volatile("" ::: "memory");
    const int cc = lane & 7;
#pragma unroll
    for (int j = 0; j < 4; ++j) { const int nl = (lane >> 3) + 8 * j, n = n0 + nl; const LAS float* s = scr + (8 * cc) * 33 + nl;
        v4u o; o.x = pk2(s[0 * 33], s[1 * 33]); o.y = pk2(s[2 * 33], s[3 * 33]); o.z = pk2(s[4 * 33], s[5 * 33]); o.w = pk2(s[6 * 33], s[7 * 33]);
        if (n < N) *(GAS v4u*)(WT + (size_t)map_row(mapid, n, row_off) * K + k0 + 8 * cc) = o; }
    LDS_WAIT(); asm volatile("" ::: "memory");
}
constexpr int I_INH = 16 * 104, I_MKV = 16 * 16, I_DSA = 16 * 67, I_OUT = 16 * 32, I_G = 16 * 88, I_D = 44 * 32;
constexpr int W_N0 = I_INH + 2 * I_MKV + I_OUT + 2 * I_G + I_D, W_NITEMS = W_N0 + I_DSA + I_OUT + 2 * I_G + I_D;
template <int MODE>
__device__ __forceinline__ void convert_item(ARGREF a, int it, LAS float* scr, int lane, f32x4 (&v)[8], float (&sc)[8]) {
    unsigned char* ws = a.ws; int r = it;
    if (r < I_INH) { transpose_item<MODE>(a.in[13], 1024, 3328, a.in[11], (bf16*)(ws + WS_WIN0), 0, 0, scr, r, lane, v, sc); return; } r -= I_INH;
    if (r < 2 * I_MKV) { const int l = r / I_MKV; transpose_item<MODE>(a.in[20] + (size_t)l * 1024 * 512, 1024, 512, nullptr, (bf16*)(ws + WS_WIN0), 0, 3328 + 512 * l, scr, r % I_MKV, lane, v, sc); return; } r -= 2 * I_MKV;
    int l = 0;
    if (r >= I_OUT + 2 * I_G + I_D) { r -= I_OUT + 2 * I_G + I_D; l = 1;
        if (r < I_DSA) { transpose_item<MODE>(a.in[16], 1024, 2120, a.in[11] + 1024, (bf16*)(ws + WS_WIN1), 1, 0, scr, r, lane, v, sc); return; } r -= I_DSA; }
    if (r < I_OUT) { transpose_item<MODE>(a.in[23] + (size_t)l * 1024 * 1024, 1024, 1024, nullptr, (bf16*)(ws + WS_WOUT) + (size_t)l * 1024 * 1024, 0, 0, scr, r, lane, v, sc); return; } r -= I_OUT;
    if (r < I_G) { transpose_item<MODE>(a.in[24] + (size_t)l * 1024 * DFF, 1024, DFF, a.in[12] + l * 1024, (bf16*)(ws + WS_WGU) + (size_t)l * 5632 * 1024, 2, 0, scr, r, lane, v, sc); return; } r -= I_G;
    if (r < I_G) { transpose_item<MODE>(a.in[25] + (size_t)l * 1024 * DFF, 1024, DFF, a.in[12] + l * 1024, (bf16*)(ws + WS_WGU) + (size_t)l * 5632 * 1024, 3, 0, scr, r, lane, v, sc); return; } r -= I_G;
    transpose_item<MODE>(a.in[28] + (size_t)l * DFF * 1024, DFF, 1024, nullptr, (bf16*)(ws + WS_WD) + (size_t)l * 1024 * DFF, 0, 0, scr, r, lane, v, sc);
}
constexpr int W_PRO = I_INH + 2 * I_MKV + I_OUT + I_G, W_T0 = W_N0 + I_DSA, W_T1 = W_T0 + I_OUT + I_G;
__device__ __forceinline__ void convert_tail(Ctx& c, ARGREF a, int first_idle, int it0, int it1, int nlight = 0) {
    LAS float* scr = (LAS float*)(c.lds + RING_OFF + c.wave * 16384);
    const int bx = (int)blockIdx.x; if (bx < first_idle) return;
    const int nidle = c.G - first_idle, nheavy = nidle - (nlight < nidle ? nlight : nidle), bi = bx - first_idle;
    const int nslots = nheavy * NWAVES * 3 + (nidle - nheavy) * NWAVES * 2;
    const int my0 = bi < nheavy ? (bi * NWAVES + c.wave) * 3 : nheavy * NWAVES * 3 + ((bi - nheavy) * NWAVES + c.wave) * 2, myn = bi < nheavy ? 3 : 2;
    f32x4 vA[8], vB[8]; float sA[8], sB[8];
    int q = 0, it = it0 + my0;
    if (it < it1) convert_item<1>(a, it, scr, c.lane, vA, sA);
#pragma unroll 1
    while (it < it1) { ++q; const int nx = it0 + (q / myn) * nslots + my0 + q % myn;
        if (nx < it1) convert_item<1>(a, nx, scr, c.lane, vB, sB);
        convert_item<2>(a, it, scr, c.lane, vA, sA);
#pragma unroll
        for (int i = 0; i < 8; ++i) { vA[i] = vB[i]; sA[i] = sB[i]; }
        it = nx; }
}
__device__ __forceinline__ void p0_prologue(Ctx& c, ARGREF a) {
    LAS float* scr = (LAS float*)(c.lds + RING_OFF + c.wave * 16384);
    const int gw = c.vcu * NWAVES + c.wave, NGW = c.G * NWAVES, lane = c.lane;
    unsigned char* ws = a.ws;
    { f32x4 vA[8], vB[8]; float sA[8], sB[8]; int it = gw;
      if (it < W_PRO) convert_item<1>(a, it, scr, lane, vA, sA);
#pragma unroll 1
      while (it < W_PRO) { const int nx = it + NGW;
          if (nx < W_PRO) convert_item<1>(a, nx, scr, lane, vB, sB);
          convert_item<2>(a, it, scr, lane, vA, sA);
#pragma unroll
          for (int i = 0; i < 8; ++i) { vA[i] = vB[i]; sA[i] = sB[i]; }
          it = nx; } }
    for (int rr = gw; rr < 184; rr += NGW) { const int row = rr < 56 ? 1864 + rr : 2176 + (rr - 56);
        GAS v4u* p = (GAS v4u*)((bf16*)(ws + WS_WIN1) + (size_t)row * 1024); p[lane] = (v4u){0u, 0u, 0u, 0u}; p[64 + lane] = (v4u){0u, 0u, 0u, 0u}; }
    float* ss0 = ssptr(c, 0);
    for (int m = gw; m < MT + NMEMROWS; m += NGW) {
        GAS u64* o8 = (GAS u64*)((bf16*)(ws + WS_XB) + (size_t)m * DM) + lane;
        if (m >= MVALID && m < MT) {
#pragma unroll
            for (int j = 0; j < 4; ++j) o8[64 * j] = 0ull;
            continue; }
        const float* src = m < MP ? a.in[0] + (size_t)m * DM : (m < MVALID ? a.in[1] + (size_t)(m - MP) * DM : a.in[10] + (size_t)(m - MT) * DM);
        const GAS f32x4* xr = (const GAS f32x4*)src + lane; f32x4 v[4]; float s = 0.f;
#pragma unroll
        for (int j = 0; j < 4; ++j) { v[j] = xr[64 * j]; s += (v[j].x * v[j].x + v[j].y * v[j].y) + (v[j].z * v[j].z + v[j].w * v[j].w); }
        s = wave_sum_fast(s);
#pragma unroll
        for (int j = 0; j < 4; ++j) o8[64 * j] = (u64)pk2(v[j].x, v[j].y) | ((u64)pk2(v[j].z, v[j].w) << 32);
        if (m < MVALID && lane == 0) ss0[m] = s;
    }
}

__device__ __forceinline__ void memattn_unit(Ctx& c, const bf16* Zq  , int ldz, int nrows_valid, const float* Kp, const float* Vp, int kstride,
                                             bool normk, const float* kgain, const float* qgain, bf16* Out  ) {
    LAS bf16* KN = (LAS bf16*)(c.lds);
    LAS bf16* VTm = (LAS bf16*)(c.lds + 36864);
    LAS bf16* QN = (LAS bf16*)(c.lds + 70656) + c.wave * (32 * 72);
    LAS float* LI = (LAS float*)(c.lds + 107520) + c.wave * 32;
    int tid = c.tid; asm volatile("" : "+v"(tid));
    const int lane = tid & 63, w = c.wave;
    {
        const int m = tid >> 1, dh = (tid & 1) * 32;
        f32x4 kv[8]; float s = 0.f;
#pragma unroll
        for (int j = 0; j < 8; ++j) { kv[j] = *(const f32x4*)(Kp + (size_t)m * kstride + dh + 4 * j); s += (kv[j].x * kv[j].x + kv[j].y * kv[j].y) + (kv[j].z * kv[j].z + kv[j].w * kv[j].w); }
        s += __shfl_xor(s, 1);
        const float rs = normk ? rsqrtf(s * (1.0f / 64.0f) + EPS) : 1.0f;
#pragma unroll
        for (int j = 0; j < 8; j += 2) { f32x4 g0 = {1.f, 1.f, 1.f, 1.f}, g1 = g0;
            if (normk) { g0 = *(const f32x4*)(kgain + dh + 4 * j); g1 = *(const f32x4*)(kgain + dh + 4 * j + 4); }
            const f32x4 x0 = kv[j] * rs * g0, x1 = kv[j + 1] * rs * g1;
            v4u o; o.x = pk2(x0.x, x0.y); o.y = pk2(x0.z, x0.w); o.z = pk2(x1.x, x1.y); o.w = pk2(x1.z, x1.w);
            *(LAS v4u*)(KN + m * 72 + dh + 4 * j) = o; }
#pragma unroll
        for (int j = 0; j < 8; ++j) { const f32x4 vv = *(const f32x4*)(Vp + (size_t)m * kstride + dh + 4 * j);
            VTm[(dh + 4 * j + 0) * 264 + m] = (bf16)f2bf(vv.x); VTm[(dh + 4 * j + 1) * 264 + m] = (bf16)f2bf(vv.y);
            VTm[(dh + 4 * j + 2) * 264 + m] = (bf16)f2bf(vv.z); VTm[(dh + 4 * j + 3) * 264 + m] = (bf16)f2bf(vv.w); }
    }
    {
        const int row = lane >> 1, hf = lane & 1, grow = w * 32 + row;
        float x[32]; float s = 0.f;
        if (grow < nrows_valid) {
#pragma unroll
            for (int j = 0; j < 4; ++j) { const v4u q = *(const v4u*)(Zq + (size_t)grow * ldz + hf * 32 + 8 * j);
                x[8 * j + 0] = bf2f(q.x & 0xffffu); x[8 * j + 1] = bf2f(q.x >> 16); x[8 * j + 2] = bf2f(q.y & 0xffffu); x[8 * j + 3] = bf2f(q.y >> 16);
                x[8 * j + 4] = bf2f(q.z & 0xffffu); x[8 * j + 5] = bf2f(q.z >> 16); x[8 * j + 6] = bf2f(q.w & 0xffffu); x[8 * j + 7] = bf2f(q.w >> 16); }
        } else {
#pragma unroll
            for (int j = 0; j < 32; ++j) x[j] = 0.f;
        }
#pragma unroll
        for (int j = 0; j < 32; ++j) s += x[j] * x[j];
        s += __shfl_xor(s, 1);
        const float rs = rsqrtf(s * (1.0f / 64.0f) + EPS) * 0.125f;
#pragma unroll
        for (int j = 0; j < 32; j += 8) { v4u o;
            o.x = pk2(x[j] * rs * qgain[hf * 32 + j], x[j + 1] * rs * qgain[hf * 32 + j + 1]); o.y = pk2(x[j + 2] * rs * qgain[hf * 32 + j + 2], x[j + 3] * rs * qgain[hf * 32 + j + 3]);
            o.z = pk2(x[j + 4] * rs * qgain[hf * 32 + j + 4], x[j + 5] * rs * qgain[hf * 32 + j + 5]); o.w = pk2(x[j + 6] * rs * qgain[hf * 32 + j + 6], x[j + 7] * rs * qgain[hf * 32 + j + 7]);
            *(LAS v4u*)(QN + row * 72 + hf * 32 + j) = o; }
    }
    __syncthreads();
    if (w * 32 < nrows_valid) {
        const int r32 = lane & 31, hh = lane >> 5;
        f32x16 s[8];
#pragma unroll
        for (int mt = 0; mt < 8; ++mt) { f32x16 z = {}; s[mt] = mm32<64>(KN + mt * 32 * 72, 72, QN, 72, z, lane); }
        float mx = -1e30f;
#pragma unroll
        for (int mt = 0; mt < 8; ++mt)
#pragma unroll
            for (int r = 0; r < 16; ++r) mx = fmaxf(mx, s[mt][r]);
        mx = fmaxf(mx, __shfl_xor(mx, 32));
        float l = 0.f;
#pragma unroll
        for (int mt = 0; mt < 8; ++mt)
#pragma unroll
            for (int r = 0; r < 16; ++r) { const float p = __expf(s[mt][r] - mx); s[mt][r] = p; l += p; }
        l += __shfl_xor(l, 32);
        if (hh == 0) LI[r32] = l;
        f32x16 o[2] = {};
#pragma unroll
        for (int mt = 0; mt < 8; ++mt)
#pragma unroll
            for (int sx = 0; sx < 2; ++sx) {
                v4u pa; pa.x = pk2(s[mt][8 * sx + 0], s[mt][8 * sx + 1]); pa.y = pk2(s[mt][8 * sx + 2], s[mt][8 * sx + 3]);
                pa.z = pk2(s[mt][8 * sx + 4], s[mt][8 * sx + 5]); pa.w = pk2(s[mt][8 * sx + 6], s[mt][8 * sx + 7]);
                const bf16x8 af = __builtin_bit_cast(bf16x8, pa);
#pragma unroll
                for (int dt = 0; dt < 2; ++dt) { const LAS bf16* vp = VTm + (dt * 32 + r32) * 264 + mt * 32 + 16 * sx + 4 * hh;
                    const u64 lo = *(const LAS u64*)vp, hi = *(const LAS u64*)(vp + 8);
                    v4u bw; bw.x = (unsigned)lo; bw.y = (unsigned)(lo >> 32); bw.z = (unsigned)hi; bw.w = (unsigned)(hi >> 32);
                    o[dt] = __builtin_amdgcn_mfma_f32_32x32x16_bf16(af, __builtin_bit_cast(bf16x8, bw), o[dt], 0, 0, 0); }
            }
        LDS_WAIT();
#pragma unroll
        for (int r = 0; r < 16; ++r) { const int qr = crow(r, hh), grow = w * 32 + qr; const float il = __builtin_amdgcn_rcpf(LI[qr]);
            if (grow < nrows_valid) {
#pragma unroll
                for (int dt = 0; dt < 2; ++dt) Out[(size_t)grow * DM + dt * 32 + r32] = (bf16)f2bf(o[dt][r] * il); } }
    }
}

constexpr int HG_GS = 4, HG_NG = SEQ / (32 * HG_GS);
constexpr size_t WS_HOL = WS_U, WS_HQC = WS_UP, WS_HUT = WS_ACT, WS_HST = WS_ACT + 64 * MiB, WS_HDG = WS_ACT + 50 * MiB;
template <bool PROMPT>
__device__ __forceinline__ void hgrn_unit(Ctx& c, ARGREF a, int b, int h, int g) {
    LAS unsigned char* L = c.lds;
    LAS float* LFt = (LAS float*)(L + 0);
    LAS float* OB = (LAS float*)(L + 0);
    LAS float* SEG = (LAS float*)(L + 16896);
    LAS float* DVv = (LAS float*)(L + 18944);
    LAS bf16* QD = (LAS bf16*)(L + 19456);
    LAS bf16* KD = (LAS bf16*)(L + 28160);
    LAS bf16* KET = (LAS bf16*)(L + 36864);
    LAS bf16* VT = (LAS bf16*)(L + 47104);
    LAS bf16* SCB = (LAS bf16*)(L + 57344);
    LAS bf16* STt = (LAS bf16*)(L + 59904);
    LAS float* BOFF = (LAS float*)(L + 94720);
    int tid = c.tid; asm volatile("" : "+v"(tid));
    const int lane = tid & 63, w = c.wave, r32 = lane & 31, hh = lane >> 5;
    const int te = tid & 31, k8 = (tid >> 5) * 8;
    const int tf = tid >> 4, v8 = (tid & 15) * 8;
    const bf16* Z = (const bf16*)(a.ws + WS_Z);
    bf16* MIX = (bf16*)(a.ws + WS_MIX);
    const int nch = PROMPT ? HG_GS : 1, nvalid = PROMPT ? 32 : 4;
    const int kt = w >> 1, vt0 = 2 * (w & 1);
    const int unit = (b * 6 + h) * HG_NG + g;
    f32x16 S0 = {}, S1 = {};
    if (!PROMPT) { const float* sp = a.in[7] + (size_t)(b * 6 + h) * 16384;
#pragma unroll
        for (int r = 0; r < 16; ++r) { const int k = 32 * kt + crow(r, hh); S0[r] = sp[k * 128 + 32 * vt0 + r32]; S1[r] = sp[k * 128 + 32 * (vt0 + 1) + r32]; } }
    float lbv[8];
#pragma unroll
    for (int j = 0; j < 8; ++j) { const float l0 = a.in[14][h * 128 + k8 + j], l1 = a.in[14][768 + h * 128 + k8 + j]; lbv[j] = 1.0f / (1.0f + __expf(l1 - l0)); }
    __syncthreads();
    if (tid < 128) BOFF[tid] = 0.f;
#define HG_WRITE_ST() do { _Pragma("unroll") for (int g4 = 0; g4 < 4; ++g4) { const int k0 = 32 * kt + 8 * g4 + 4 * hh; \
        *(LAS u64*)(STt + (32 * vt0 + r32) * 136 + k0) = (u64)pk2(S0[4 * g4], S0[4 * g4 + 1]) | ((u64)pk2(S0[4 * g4 + 2], S0[4 * g4 + 3]) << 32); \
        *(LAS u64*)(STt + (32 * (vt0 + 1) + r32) * 136 + k0) = (u64)pk2(S1[4 * g4], S1[4 * g4 + 1]) | ((u64)pk2(S1[4 * g4 + 2], S1[4 * g4 + 3]) << 32); } } while (0)
    HG_WRITE_ST();
    v4u zq = {0u, 0u, 0u, 0u}, zf = zq, zi = zq;
    { const int row = (PROMPT ? b * SEQ + (g * HG_GS) * 32 : MP + 4 * b) + te;
      if (te < nvalid) { const bf16* zr = Z + (size_t)row * ZC0 + h * 128 + k8; zq = *(const v4u*)zr; zf = *(const v4u*)(zr + 768); zi = *(const v4u*)(zr + 1536); } }
#pragma unroll 1
    for (int ch = 0; ch < nch; ++ch) {
        const int row0 = PROMPT ? b * SEQ + (g * HG_GS + ch) * 32 : MP + 4 * b, row = row0 + te;
        const bool valid = te < nvalid;
        float qs[8], kk[8];
        {
            const unsigned qw[4] = {zq.x, zq.y, zq.z, zq.w}, fw[4] = {zf.x, zf.y, zf.z, zf.w}, iw[4] = {zi.x, zi.y, zi.z, zi.w};
#pragma unroll
            for (int j = 0; j < 8; ++j) { const float q = bf2f((qw[j >> 1] >> (16 * (j & 1))) & 0xffffu), fp = bf2f((fw[j >> 1] >> (16 * (j & 1))) & 0xffffu);
                const float sg = sigmoidf_(fp), f = lbv[j] + (1.0f - lbv[j]) * sg;
                qs[j] = valid ? q * sigmoidf_(q) : 0.f; kk[j] = valid ? (1.0f - f) : 0.f;
                LFt[(k8 + j) * 33 + te] = valid ? __logf(f) : 0.f;
                VT[(k8 + j) * 40 + te] = (bf16)((iw[j >> 1] >> (16 * (j & 1))) & 0xffffu); }
            if (PROMPT && ch + 1 < nch) { const bf16* zr = Z + (size_t)(row + 32) * ZC0 + h * 128 + k8; zq = *(const v4u*)zr; zf = *(const v4u*)(zr + 768); zi = *(const v4u*)(zr + 1536); }
        }
        __syncthreads();
        {
            const int k = tid & 127, sg_ = tid >> 7; float bsum = 0.f;
#pragma unroll
            for (int i = 0; i < 8; ++i) { bsum += LFt[k * 33 + 8 * sg_ + i]; LFt[k * 33 + 8 * sg_ + i] = bsum; }
            SEG[sg_ * 128 + k] = bsum; }
        __syncthreads();
        {
            float bb[8], bl[8];
            { f32x4 t0[4], t1[4];
#pragma unroll
              for (int s_ = 0; s_ < 4; ++s_) { t0[s_] = *(const LAS f32x4*)(SEG + s_ * 128 + k8); t1[s_] = *(const LAS f32x4*)(SEG + s_ * 128 + k8 + 4); }
              const int sgt = te >> 3; f32x4 o0 = {0.f, 0.f, 0.f, 0.f}, o1 = o0;
#pragma unroll
              for (int s_ = 0; s_ < 3; ++s_) if (s_ < sgt) { o0 += t0[s_]; o1 += t1[s_]; }
              const f32x4 l0 = (t0[0] + t0[1]) + (t0[2] + t0[3]), l1 = (t1[0] + t1[1]) + (t1[2] + t1[3]);
              const float of[8] = {o0.x, o0.y, o0.z, o0.w, o1.x, o1.y, o1.z, o1.w}; const float lt[8] = {l0.x, l0.y, l0.z, l0.w, l1.x, l1.y, l1.z, l1.w};
#pragma unroll
              for (int j = 0; j < 8; ++j) { bb[j] = LFt[(k8 + j) * 33 + te] + of[j]; bl[j] = lt[j]; } }
            float qd[8], kd[8];
#pragma unroll
            for (int j = 0; j < 8; ++j) { qd[j] = qs[j] * __expf(bb[j]); kd[j] = kk[j] * __expf(-bb[j]); KET[(k8 + j) * 40 + te] = (bf16)f2bf(kk[j] * __expf(bl[j] - bb[j])); }
            v4u o; o.x = pk2(qd[0], qd[1]); o.y = pk2(qd[2], qd[3]); o.z = pk2(qd[4], qd[5]); o.w = pk2(qd[6], qd[7]); *(LAS v4u*)(QD + te * 136 + k8) = o;
            if (PROMPT) { const f32x4 f0 = *(const LAS f32x4*)(BOFF + k8), f1 = *(const LAS f32x4*)(BOFF + k8 + 4);
                const float bo[8] = {f0.x, f0.y, f0.z, f0.w, f1.x, f1.y, f1.z, f1.w}; float qc[8];
#pragma unroll
                for (int j = 0; j < 8; ++j) qc[j] = qd[j] * __expf(bo[j]);
                v4u oc; oc.x = pk2(qc[0], qc[1]); oc.y = pk2(qc[2], qc[3]); oc.z = pk2(qc[4], qc[5]); oc.w = pk2(qc[6], qc[7]);
                *(v4u*)((bf16*)(a.ws + WS_HQC) + (size_t)row * 768 + h * 128 + k8) = oc; }
            o.x = pk2(kd[0], kd[1]); o.y = pk2(kd[2], kd[3]); o.z = pk2(kd[4], kd[5]); o.w = pk2(kd[6], kd[7]); *(LAS v4u*)(KD + te * 136 + k8) = o;
            if (te == 0) {
#pragma unroll
                for (int j = 0; j < 8; ++j) DVv[k8 + j] = __expf(bl[j]); }
        }
        __syncthreads();
        f32x16 oacc = {};
        if (w == 4) { f32x16 z = {}; const f32x16 sc = mm32<128>(QD, 136, KD, 136, z, lane);
#pragma unroll
            for (int r = 0; r < 16; ++r) { const int t = crow(r, hh); SCB[t * 40 + r32] = (bf16)f2bf(r32 <= t ? sc[r] : 0.f); } }
        if (w < 4) oacc = mm32<128>(QD, 136, STt + (w * 32) * 136, 136, oacc, lane);
        if (PROMPT && tid >= 384) { const int k = tid - 384; BOFF[k] += (SEG[k] + SEG[128 + k]) + (SEG[256 + k] + SEG[384 + k]); }
        __syncthreads();
        if (w < 4) { oacc = mm32<32>(SCB, 40, VT + (w * 32) * 40, 40, oacc, lane);
#pragma unroll
            for (int r = 0; r < 16; ++r) OB[crow(r, hh) * 128 + w * 32 + r32] = oacc[r]; }
        {
#pragma unroll
            for (int r = 0; r < 16; ++r) { const float d = DVv[32 * kt + crow(r, hh)]; S0[r] *= d; S1[r] *= d; }
            S0 = mm32<32>(KET + (kt * 32) * 40, 40, VT + (vt0 * 32) * 40, 40, S0, lane);
            S1 = mm32<32>(KET + (kt * 32) * 40, 40, VT + ((vt0 + 1) * 32) * 40, 40, S1, lane);
        }
        __syncthreads();
        HG_WRITE_ST();
        {
            const int orow = row0 + tf;
            const f32x4 o0 = *(const LAS f32x4*)(OB + tf * 128 + v8), o1 = *(const LAS f32x4*)(OB + tf * 128 + v8 + 4);
            if (PROMPT) { float* ol = (float*)(a.ws + WS_HOL) + (size_t)orow * 768 + h * 128 + v8; *(f32x4*)ol = o0; *(f32x4*)(ol + 4) = o1; }
            else {
                float ov[8] = {o0.x, o0.y, o0.z, o0.w, o1.x, o1.y, o1.z, o1.w}; float s = 0.f;
#pragma unroll
                for (int j = 0; j < 8; ++j) s += ov[j] * ov[j];
                s += __shfl_xor(s, 1); s += __shfl_xor(s, 2); s += __shfl_xor(s, 4); s += __shfl_xor(s, 8);
                const float rs = rsqrtf(s * (1.0f / 128.0f) + EPS);
                if (tf < nvalid) { const v4u gz = *(const v4u*)(Z + (size_t)orow * ZC0 + 2304 + h * 128 + v8); const unsigned gw_[4] = {gz.x, gz.y, gz.z, gz.w}; float y[8];
#pragma unroll
                    for (int j = 0; j < 8; ++j) { const float gg = bf2f((gw_[j >> 1] >> (16 * (j & 1))) & 0xffffu); y[j] = ov[j] * rs * a.in[15][v8 + j] * (gg * sigmoidf_(gg)); }
                    v4u o; o.x = pk2(y[0], y[1]); o.y = pk2(y[2], y[3]); o.z = pk2(y[4], y[5]); o.w = pk2(y[6], y[7]); *(v4u*)(MIX + (size_t)orow * DM + h * 128 + v8) = o; }
            }
        }
        __syncthreads();
    }
#undef HG_WRITE_ST
    if (PROMPT) {
        float* ut = (float*)(a.ws + WS_HUT) + (size_t)unit * 16384;
#pragma unroll
        for (int g4 = 0; g4 < 4; ++g4) { const int k0 = 32 * kt + 8 * g4 + 4 * hh;
            *(f32x4*)(ut + (32 * vt0 + r32) * 128 + k0) = (f32x4){S0[4 * g4], S0[4 * g4 + 1], S0[4 * g4 + 2], S0[4 * g4 + 3]};
            *(f32x4*)(ut + (32 * (vt0 + 1) + r32) * 128 + k0) = (f32x4){S1[4 * g4], S1[4 * g4 + 1], S1[4 * g4 + 2], S1[4 * g4 + 3]}; }
        if (tid < 128) ((float*)(a.ws + WS_HDG))[(size_t)unit * 128 + tid] = __expf(BOFF[tid]);
    } else {
        float* so = a.out + O_HS + (size_t)(b * 6 + h) * 16384;
#pragma unroll
        for (int r = 0; r < 16; ++r) { const int k = 32 * kt + crow(r, hh); so[k * 128 + 32 * vt0 + r32] = S0[r]; so[k * 128 + 32 * (vt0 + 1) + r32] = S1[r]; }
    }
}
__device__ __forceinline__ void hgrn_scan(Ctx& c, ARGREF a) {
    const float* UT = (const float*)(a.ws + WS_HUT); const float* DG = (const float*)(a.ws + WS_HDG); bf16* STo = (bf16*)(a.ws + WS_HST);
    for (int idx = c.vcu * 512 + c.tid; idx < 24 * 16384; idx += c.G * 512) {
        const int bh = idx >> 14, e = idx & 16383, k = e & 127, v = e >> 7;
        float s = 0.f, ut[HG_NG], dg[HG_NG];
#pragma unroll
        for (int g = 0; g < HG_NG; ++g) { const size_t u = (size_t)(bh * HG_NG + g); ut[g] = UT[u * 16384 + e]; dg[g] = DG[u * 128 + k]; }
#pragma unroll
        for (int g = 0; g < HG_NG; ++g) { const size_t u = (size_t)(bh * HG_NG + g); STo[u * 16384 + e] = (bf16)f2bf(s); s = dg[g] * s + ut[g]; }
        a.out[O_HP + (size_t)bh * 16384 + k * 128 + v] = s;
    }
}
__device__ __forceinline__ void hgrn_fix_unit(Ctx& c, ARGREF a, int b, int h, int g) {
    LAS bf16* STt = (LAS bf16*)(c.lds);
    LAS bf16* QCl = (LAS bf16*)(c.lds + 34816);
    LAS float* OB = (LAS float*)(c.lds + 34816 + 17408);
    int tid = c.tid; asm volatile("" : "+v"(tid));
    const int lane = tid & 63, w = c.wave, r32 = lane & 31, hh = lane >> 5;
    const int unit = (b * 6 + h) * HG_NG + g, row0 = b * SEQ + g * 128;
    const bf16* Z = (const bf16*)(a.ws + WS_Z); bf16* MIX = (bf16*)(a.ws + WS_MIX);
    const bf16* QC = (const bf16*)(a.ws + WS_HQC); const float* OL = (const float*)(a.ws + WS_HOL);
    const bf16* stg = (const bf16*)(a.ws + WS_HST) + (size_t)unit * 16384;
    __syncthreads();
#pragma unroll
    for (int i = 0; i < 4; ++i) { const int cidx = tid + 512 * i, v = cidx >> 4, kc = (cidx & 15) * 8; *(LAS v4u*)(STt + v * 136 + kc) = *(const v4u*)(stg + v * 128 + kc); }
    const int te = tid >> 4, k8 = (tid & 15) * 8;
    float onv[8];
#pragma unroll
    for (int j = 0; j < 8; ++j) onv[j] = a.in[15][k8 + j];
#pragma unroll 1
    for (int hf = 0; hf < 2; ++hf) {
        const int rb = row0 + hf * 64;
#pragma unroll
        for (int i = 0; i < 2; ++i) { const int cidx = tid + 512 * i, r = cidx >> 4, kc = (cidx & 15) * 8; *(LAS v4u*)(QCl + r * 136 + kc) = *(const v4u*)(QC + (size_t)(rb + r) * 768 + h * 128 + kc); }
        f32x4 pl0[2], pl1[2]; v4u pgz[2];
#pragma unroll
        for (int ps = 0; ps < 2; ++ps) { const int row = rb + ps * 32 + te; const float* ol = OL + (size_t)row * 768 + h * 128 + k8; pl0[ps] = *(const f32x4*)ol; pl1[ps] = *(const f32x4*)(ol + 4);
            pgz[ps] = *(const v4u*)(Z + (size_t)row * ZC0 + 2304 + h * 128 + k8); }
        __syncthreads();
        { const int rt = w >> 2, vt = w & 3; f32x16 o = {};
          o = mm32<128>(QCl + (rt * 32) * 136, 136, STt + (vt * 32) * 136, 136, o, lane);
#pragma unroll
          for (int r = 0; r < 16; ++r) OB[(rt * 32 + crow(r, hh)) * 128 + vt * 32 + r32] = o[r]; }
        __syncthreads();
#pragma unroll
        for (int ps = 0; ps < 2; ++ps) { const int r = ps * 32 + te, row = rb + r;
            const f32x4 c0 = *(const LAS f32x4*)(OB + r * 128 + k8), c1 = *(const LAS f32x4*)(OB + r * 128 + k8 + 4);
            const f32x4 l0 = pl0[ps], l1 = pl1[ps]; const v4u gz = pgz[ps];
            float ov[8] = {c0.x + l0.x, c0.y + l0.y, c0.z + l0.z, c0.w + l0.w, c1.x + l1.x, c1.y + l1.y, c1.z + l1.z, c1.w + l1.w}; float s = 0.f;
#pragma unroll
            for (int j = 0; j < 8; ++j) s += ov[j] * ov[j];
            s += __shfl_xor(s, 1); s += __shfl_xor(s, 2); s += __shfl_xor(s, 4); s += __shfl_xor(s, 8);
            const float rs = rsqrtf(s * (1.0f / 128.0f) + EPS);
            const unsigned gw_[4] = {gz.x, gz.y, gz.z, gz.w}; float y[8];
#pragma unroll
            for (int j = 0; j < 8; ++j) { const float gg = bf2f((gw_[j >> 1] >> (16 * (j & 1))) & 0xffffu); y[j] = ov[j] * rs * onv[j] * (gg * sigmoidf_(gg)); }
            v4u o; o.x = pk2(y[0], y[1]); o.y = pk2(y[2], y[3]); o.z = pk2(y[4], y[5]); o.w = pk2(y[6], y[7]); *(v4u*)(MIX + (size_t)row * DM + h * 128 + k8) = o; }
        __syncthreads();
    }
}

__device__ __forceinline__ void memkv_finalize_row(ARGREF a, int layer, int row, int lane) {
    const float* src = (const float*)(a.ws + WS_MEMKV) + (size_t)row * 1024 + layer * 512;
    const int hd = lane >> 4, d4 = (lane & 15) * 4;
    const f32x4 k = *(const f32x4*)(src + hd * 64 + d4), v = *(const f32x4*)(src + 256 + hd * 64 + d4);
    float s = (k.x * k.x + k.y * k.y) + (k.z * k.z + k.w * k.w);
    s += __shfl_xor(s, 1); s += __shfl_xor(s, 2); s += __shfl_xor(s, 4); s += __shfl_xor(s, 8);
    const float rs = rsqrtf(s * (1.0f / 64.0f) + EPS); const f32x4 g = *(const f32x4*)(a.in[22] + layer * 64 + d4);
    *(f32x4*)(a.out + O_MK + ((size_t)layer * 1024 + row) * 256 + hd * 64 + d4) = k * rs * g;
    *(f32x4*)(a.out + O_MV + ((size_t)layer * 1024 + row) * 256 + hd * 64 + d4) = v;
}

__device__ __forceinline__ void memattn_prompt_unit(Ctx& c, ARGREF a, int layer, int u) {
    const int blk = u & 15, hd = (u >> 4) & 3, b = u >> 6;
    const bf16* Z = (const bf16*)(a.ws + WS_Z); const int ldz = layer ? ZC1 : ZC0, qc = layer ? Z1_MQ : 3072;
    const float* kv = (const float*)(a.ws + WS_MEMKV) + (size_t)(b * 256) * 1024 + layer * 512 + hd * 64;
    const int row0 = b * SEQ + blk * 256;
    memattn_unit(c, Z + (size_t)row0 * ldz + qc + hd * 64, ldz, 256, kv, kv + 256, 1024, true, a.in[22] + layer * 64, a.in[21] + layer * 64,
                 (bf16*)(a.ws + WS_MIX) + (size_t)row0 * DM + 768 + hd * 64);
}
__device__ __forceinline__ void memattn_sample_unit(Ctx& c, ARGREF a, int layer, int u) {
    const int hd = u & 3, sb = u >> 2;
    const bf16* Z = (const bf16*)(a.ws + WS_Z); const int ldz = layer ? ZC1 : ZC0, qc = layer ? Z1_MQ : 3072;
    const size_t off = ((size_t)(layer * 32 + sb) * 256) * 256 + hd * 64;
    const int row0 = MP + sb * 4;
    memattn_unit(c, Z + (size_t)row0 * ldz + qc + hd * 64, ldz, 4, a.in[5] + off, a.in[6] + off, 256, false, nullptr, a.in[21] + layer * 64,
                 (bf16*)(a.ws + WS_MIX) + (size_t)row0 * DM + 768 + hd * 64);
}

__device__ __forceinline__ void p2_mixer0(Ctx& c, ARGREF a) {
    constexpr int U_HP = 24 * HG_NG, U_MAP = U_HP + 256, U_HS = U_MAP + 192, U_MAS = U_HS + 128, U_FIN = U_MAS + 256;
    for (;;) {
        const int u = q_next(c, 0);
        if (u >= U_FIN) break;
        if (u < U_HP) hgrn_unit<true>(c, a, u / (6 * HG_NG), (u / HG_NG) % 6, u % HG_NG);
        else if (u < U_MAP) memattn_prompt_unit(c, a, 0, u - U_HP);
        else if (u < U_HS) { const int v = u - U_MAP; hgrn_unit<false>(c, a, v / 6, v % 6, 0); }
        else if (u < U_MAS) memattn_sample_unit(c, a, 0, u - U_HS);
        else { const int v = (u - U_MAS) * 8 + c.wave; memkv_finalize_row(a, v >> 10, v & 1023, c.lane); }
    }
}
__device__ __forceinline__ void p2c_hgrn_fix(Ctx& c, ARGREF a) {
    for (int u = c.vcu; u < 24 * HG_NG; u += c.G) hgrn_fix_unit(c, a, u / (6 * HG_NG), (u / HG_NG) % 6, u % HG_NG);
}

constexpr size_t WS_G4 = WS_UP + 64 * MiB, WS_UP2 = WS_UP + 80 * MiB;
__device__ __forceinline__ void conv_fixup_tile(Ctx& c, ARGREF a, int layer, int pm) {
    const float* G4 = (const float*)(a.ws + WS_G4); const float* UP2 = (const float*)(a.ws + WS_UP2); bf16* ACT = (bf16*)(a.ws + WS_ACT);
    const float* cw = a.in[26] + (size_t)layer * 3 * DFF; const float* cb = a.in[27] + (size_t)layer * DFF;
    int tid = c.tid; asm volatile("" : "+v"(tid));
#pragma unroll 1
    for (int i0 = 0; i0 < 12; i0 += 4) {
        f32x4 ut[4], up[4], s1[4], s2[4], w0[4], w1[4], w2[4], bb[4]; int rowv[4], c4v[4]; bool z1[4], z2[4];
#pragma unroll
        for (int j = 0; j < 4; ++j) { const int i = i0 + j < 11 ? i0 + j : 10, idx = tid + 512 * i;
            const int rr = idx / (DFF / 4), c4 = (idx - rr * (DFF / 4)) * 4;
            const int slab = 4 * pm + (rr >> 1), fr = rr & 1, row = slab * 64 + fr, t = row & 4095, sl1 = slab > 0 ? slab - 1 : 0;
            ut[j] = *(const f32x4*)(G4 + (size_t)(slab * 4 + fr) * DFF + c4); up[j] = *(const f32x4*)(UP2 + (size_t)(slab * 2 + fr) * DFF + c4);
            s1[j] = *(const f32x4*)(G4 + (size_t)(fr ? slab * 4 : sl1 * 4 + 3) * DFF + c4);
            s2[j] = *(const f32x4*)(G4 + (size_t)(fr ? sl1 * 4 + 3 : sl1 * 4 + 2) * DFF + c4);
            z1[j] = !fr && t == 0; z2[j] = fr ? t == 1 : t == 0;
            w0[j] = *(const f32x4*)(cw + c4); w1[j] = *(const f32x4*)(cw + DFF + c4); w2[j] = *(const f32x4*)(cw + 2 * DFF + c4); bb[j] = *(const f32x4*)(cb + c4);
            rowv[j] = row; c4v[j] = c4; }
#pragma unroll
        for (int j = 0; j < 4; ++j) { const f32x4 zero = {0.f, 0.f, 0.f, 0.f};
            const f32x4 u1 = z1[j] ? zero : s1[j], u2 = z2[j] ? zero : s2[j];
            const f32x4 cv = bb[j] + w0[j] * u2 + w1[j] * u1 + w2[j] * ut[j];
            const float y0 = cv.x * sigmoidf_(cv.x) * up[j].x, y1 = cv.y * sigmoidf_(cv.y) * up[j].y, y2 = cv.z * sigmoidf_(cv.z) * up[j].z, y3 = cv.w * sigmoidf_(cv.w) * up[j].w;
            *(u64*)(ACT + (size_t)rowv[j] * DFF + c4v[j]) = (u64)pk2(y0, y1) | ((u64)pk2(y2, y3) << 32); }
    }
}


struct SgArgs { const bf16* A; const bf16* Bt; int K; int mode; bf16* Z; int ldz; const float* ssin; const float* resid; const bf16* rb; float* y; bf16* xb; float* ssout; bf16* ACT; float* cvs; const float* cst; const float* cw; const float* cb; };
__device__ __forceinline__ void sgemm_unit(Ctx& c, const SgArgs& g, int n0) {
    int tid = c.tid; asm volatile("" : "+v"(tid));
    const int lane = tid & 63, w = c.wave, r32 = lane & 31, hh = lane >> 5;
    const int K = g.K, ks = K >> 3;
    const int f2 = (n0 >> 1) + (r32 & 15), brow = g.mode == 2 ? (f2 >> 7) * 256 + (f2 & 127) + (r32 >= 16 ? 128 : 0) : n0 + r32;
    const bf16* bp = g.Bt + (size_t)brow * K + w * ks + 8 * hh;
    const bf16* ap = g.A + (size_t)r32 * K + w * ks + 8 * hh;
    f32x16 acc[4] = {};
    bf16x8 afA[4][2], bfA[2], afB[4][2], bfB[2];
#define SG_LOAD(AF, BF, kk) do { _Pragma("unroll") for (int i = 0; i < 2; ++i) { BF[i] = *(const bf16x8*)(bp + (kk) + 16 * i); \
        _Pragma("unroll") for (int rt = 0; rt < 4; ++rt) AF[rt][i] = *(const bf16x8*)(ap + (size_t)(rt * 32) * K + (kk) + 16 * i); } } while (0)
#define SG_MMA(AF, BF) do { _Pragma("unroll") for (int i = 0; i < 2; ++i) _Pragma("unroll") for (int rt = 0; rt < 4; ++rt) acc[rt] = __builtin_amdgcn_mfma_f32_32x32x16_bf16(AF[rt][i], BF[i], acc[rt], 0, 0, 0); } while (0)
    SG_LOAD(afA, bfA, 0);
#pragma unroll 1
    for (int k = 0; k < ks; k += 64) {
        if (k + 32 < ks) SG_LOAD(afB, bfB, k + 32);
        SG_MMA(afA, bfA);
        if (k + 32 < ks) { if (k + 64 < ks) SG_LOAD(afA, bfA, k + 64); SG_MMA(afB, bfB); }
    }
#undef SG_LOAD
#undef SG_MMA
    LAS float* RED = (LAS float*)(c.lds);
    __syncthreads();
#pragma unroll
    for (int rt = 0; rt < 4; ++rt)
#pragma unroll
        for (int r = 0; r < 16; ++r) RED[((w * 4 + rt) * 16 + r) * 64 + lane] = acc[rt][r];
    __syncthreads();
    const int rt = w & 3, rh = w >> 2, col = n0 + r32;
    float v[8];
#pragma unroll
    for (int i = 0; i < 8; ++i) { float s = 0.f;
#pragma unroll
        for (int ww = 0; ww < 8; ++ww) s += RED[((ww * 4 + rt) * 16 + 8 * rh + i) * 64 + lane];
        v[i] = s; }
    if (g.mode == 0) {
#pragma unroll
        for (int i = 0; i < 8; ++i) { const int row = MP + rt * 32 + crow(8 * rh + i, hh); const float rs = rsqrtf(g.ssin[row] * (1.0f / DM) + EPS); g.Z[(size_t)row * g.ldz + col] = (bf16)f2bf(v[i] * rs); }
    } else if (g.mode == 1) {
#pragma unroll
        for (int i = 0; i < 8; ++i) { const int lr = rt * 32 + crow(8 * rh + i, hh), row = MP + lr;
            const float x = v[i] + (g.resid ? g.resid[(size_t)lr * DM + col] : bf2f(g.rb[(size_t)row * DM + col]));
            if (g.y) g.y[(size_t)lr * DM + col] = x; if (g.xb) g.xb[(size_t)row * DM + col] = (bf16)f2bf(x);
            float s = x * x; s += __shfl_xor(s, 1); s += __shfl_xor(s, 2); s += __shfl_xor(s, 4); s += __shfl_xor(s, 8); s += __shfl_xor(s, 16);
            if (g.ssout && r32 == 0) atomicAdd(g.ssout + row, s); }
    } else {
        float gu[8], upv[8];
#pragma unroll
        for (int i = 0; i < 8; ++i) { const int row = MP + rt * 32 + crow(8 * rh + i, hh); gu[i] = v[i] * rsqrtf(g.ssin[row] * (1.0f / DM) + EPS); upv[i] = __shfl_xor(gu[i], 16); }
        if (r32 < 16) { const float w0 = g.cw[f2], w1 = g.cw[DFF + f2], w2 = g.cw[2 * DFF + f2], bb = g.cb[f2];
#pragma unroll
            for (int aa = 0; aa < 2; ++aa) { const int lr0 = rt * 32 + 8 * (2 * rh + aa) + 4 * hh, sb = lr0 >> 2;
                const float s0 = g.cst[(size_t)(sb * 2) * DFF + f2], s1 = g.cst[(size_t)(sb * 2 + 1) * DFF + f2];
                const float u0 = gu[4 * aa], u1 = gu[4 * aa + 1], u2 = gu[4 * aa + 2], u3 = gu[4 * aa + 3];
                const float cv[4] = {bb + w0 * s0 + w1 * s1 + w2 * u0, bb + w0 * s1 + w1 * u0 + w2 * u1, bb + w0 * u0 + w1 * u1 + w2 * u2, bb + w0 * u1 + w1 * u2 + w2 * u3};
#pragma unroll
                for (int t = 0; t < 4; ++t) g.ACT[(size_t)(MP + lr0 + t) * DFF + f2] = (bf16)f2bf(cv[t] * sigmoidf_(cv[t]) * upv[4 * aa + t]);
                g.cvs[(size_t)(sb * 2) * DFF + f2] = u2; g.cvs[(size_t)(sb * 2 + 1) * DFF + f2] = u3; } }
    }
}
template <int NST>
__device__ __forceinline__ void sgemm_unit_r1(Ctx& c, const SgArgs& g, int n0, int rt) {
    int tid = c.tid; asm volatile("" : "+v"(tid));
    const int lane = tid & 63, w = c.wave, r32 = lane & 31, hh = lane >> 5;
    const int K = g.K, ks = K >> 3;
    const bf16* bp = g.Bt + (size_t)(n0 + r32) * K + w * ks + 8 * hh;
    const bf16* ap = g.A + (size_t)(rt * 32 + r32) * K + w * ks + 8 * hh;
    f32x16 acc = {};
    bf16x8 af[NST][2], bf_[NST][2];
#pragma unroll
    for (int s = 0; s < NST; ++s)
#pragma unroll
        for (int i = 0; i < 2; ++i) { af[s][i] = *(const bf16x8*)(ap + 32 * s + 16 * i); bf_[s][i] = *(const bf16x8*)(bp + 32 * s + 16 * i); }
#pragma unroll
    for (int s = 0; s < NST; ++s)
#pragma unroll
        for (int i = 0; i < 2; ++i) acc = __builtin_amdgcn_mfma_f32_32x32x16_bf16(af[s][i], bf_[s][i], acc, 0, 0, 0);
    LAS float* RED = (LAS float*)(c.lds);
    __syncthreads();
#pragma unroll
    for (int r = 0; r < 16; ++r) RED[(w * 16 + r) * 64 + lane] = acc[r];
    __syncthreads();
    const int col = n0 + r32;
#pragma unroll
    for (int i = 0; i < 2; ++i) { float v = 0.f;
#pragma unroll
        for (int ww = 0; ww < 8; ++ww) v += RED[(ww * 16 + 2 * w + i) * 64 + lane];
        const int lr = rt * 32 + crow(2 * w + i, hh), row = MP + lr;
        const float x = v + (g.resid ? g.resid[(size_t)lr * DM + col] : bf2f(g.rb[(size_t)row * DM + col]));
        if (g.y) g.y[(size_t)lr * DM + col] = x; if (g.xb) g.xb[(size_t)row * DM + col] = (bf16)f2bf(x);
        float s = x * x; s += __shfl_xor(s, 1); s += __shfl_xor(s, 2); s += __shfl_xor(s, 4); s += __shfl_xor(s, 8); s += __shfl_xor(s, 16);
        if (g.ssout && r32 == 0) atomicAdd(g.ssout + row, s); }
}
__device__ __forceinline__ void sgemm_phase(Ctx& c, const SgArgs& g, int N, int nidle) {
    const int r = c.G - 1 - (int)blockIdx.x; if (r >= nidle) return;
    if (g.mode == 1) {
#pragma unroll 1
        for (int u = r; u < (N / 32) * 4; u += nidle) { if (g.K == 1024) sgemm_unit_r1<4>(c, g, (u % (N / 32)) * 32, u / (N / 32)); else sgemm_unit_r1<DFF / 256>(c, g, (u % (N / 32)) * 32, u / (N / 32)); }
        return; }
#pragma unroll 1
    for (int u = r; u < N / 32; u += nidle) sgemm_unit(c, g, u * 32);
}


__device__ __forceinline__ float wave_sum_f(float x) {
    x += __builtin_bit_cast(float, __builtin_amdgcn_update_dpp(0, __builtin_bit_cast(int, x), 0xB1, 0xF, 0xF, false));
    x += __builtin_bit_cast(float, __builtin_amdgcn_update_dpp(0, __builtin_bit_cast(int, x), 0x4E, 0xF, 0xF, false));
    x += __builtin_bit_cast(float, __builtin_amdgcn_update_dpp(0, __builtin_bit_cast(int, x), 0x141, 0xF, 0xF, false));
    x += __builtin_bit_cast(float, __builtin_amdgcn_update_dpp(0, __builtin_bit_cast(int, x), 0x140, 0xF, 0xF, false));
    const int xi = __builtin_bit_cast(int, x);
    return (__builtin_bit_cast(float, __builtin_amdgcn_readlane(xi, 0)) + __builtin_bit_cast(float, __builtin_amdgcn_readlane(xi, 16))) +
           (__builtin_bit_cast(float, __builtin_amdgcn_readlane(xi, 32)) + __builtin_bit_cast(float, __builtin_amdgcn_readlane(xi, 48)));
}
__device__ __forceinline__ float sum8_dpp(float x) {
    x += __builtin_bit_cast(float, __builtin_amdgcn_update_dpp(0, __builtin_bit_cast(int, x), 0xB1, 0xF, 0xF, false));
    x += __builtin_bit_cast(float, __builtin_amdgcn_update_dpp(0, __builtin_bit_cast(int, x), 0x4E, 0xF, 0xF, false));
    x += __builtin_bit_cast(float, __builtin_amdgcn_update_dpp(0, __builtin_bit_cast(int, x), 0x141, 0xF, 0xF, false));
    return x;
}
__device__ __forceinline__ void unpack8(v4u q, float (&x)[8]) {
    x[0] = bf2f(q.x & 0xffffu); x[1] = bf2f(q.x >> 16); x[2] = bf2f(q.y & 0xffffu); x[3] = bf2f(q.y >> 16); x[4] = bf2f(q.z & 0xffffu); x[5] = bf2f(q.z >> 16); x[6] = bf2f(q.w & 0xffffu); x[7] = bf2f(q.w >> 16);
}
__device__ __forceinline__ void dsa_post_row(ARGREF a, int row, int lane_, LAS float* tb) {
    int lane = lane_; asm volatile("" : "+v"(lane));
    const bf16* z = (const bf16*)(a.ws + WS_Z) + (size_t)row * ZC1;
    const bool smp = row >= MP; const int b = smp ? (row - MP) >> 2 : row >> 12, t = smp ? (row - MP) & 3 : row & 4095;
    const float pos = (float)(smp ? PAST + t : t);
    const int hd = lane >> 3, c8 = (lane & 7) * 8, c4 = (lane & 7) * 4;
    const v4u xa = *(const v4u*)(z + hd * 128 + c8), xb = *(const v4u*)(z + hd * 128 + 64 + c8);
    const u64 vv = *(const u64*)(z + Z1_V + 4 * lane);
    const u64 qa = *(const u64*)(z + Z1_IQ + hd * 64 + c4), qb = *(const u64*)(z + Z1_IQ + hd * 64 + 32 + c4);
    const u64 ka = *(const u64*)(z + Z1_IK + c4), kb_ = *(const u64*)(z + Z1_IK + 32 + c4);
    const float wraw = bf2f(z[Z1_IW + (lane & 7)]);
    const float* gp = hd < 6 ? a.in[17] : a.in[18];
    const f32x4 g1a = *(const f32x4*)(gp + c8), g1b = *(const f32x4*)(gp + c8 + 4), g2a = *(const f32x4*)(gp + 64 + c8), g2b = *(const f32x4*)(gp + 64 + c8 + 4);
    const f32x4 gk1 = *(const f32x4*)(a.in[19] + c4), gk2 = *(const f32x4*)(a.in[19] + 32 + c4);
    {
        const float r1 = pos * (exp2f(-(float)lane * (13.287712379549449f / 64.0f)) * 0.15915494309189535f), f1 = r1 - floorf(r1);
        tb[lane] = __builtin_amdgcn_cosf(f1); tb[64 + lane] = __builtin_amdgcn_sinf(f1);
        const float r2 = pos * (exp2f(-(float)(lane & 31) * (13.287712379549449f / 32.0f)) * 0.15915494309189535f), f2 = r2 - floorf(r2);
        if (lane < 32) { tb[128 + lane] = __builtin_amdgcn_cosf(f2); tb[160 + lane] = __builtin_amdgcn_sinf(f2); } }
    {
        float x1[8], x2[8]; unpack8(xa, x1); unpack8(xb, x2);
        float s = 0.f;
#pragma unroll
        for (int j = 0; j < 8; ++j) s += x1[j] * x1[j] + x2[j] * x2[j];
        const float rs = rsqrtf(sum8_dpp(s) * (1.0f / 128.0f) + EPS);
        const f32x4 ca = *(const LAS f32x4*)(tb + c8), cb = *(const LAS f32x4*)(tb + c8 + 4), sa = *(const LAS f32x4*)(tb + 64 + c8), sb = *(const LAS f32x4*)(tb + 64 + c8 + 4);
        const float cs[8] = {ca.x, ca.y, ca.z, ca.w, cb.x, cb.y, cb.z, cb.w}, sn[8] = {sa.x, sa.y, sa.z, sa.w, sb.x, sb.y, sb.z, sb.w};
        const float g1[8] = {g1a.x, g1a.y, g1a.z, g1a.w, g1b.x, g1b.y, g1b.z, g1b.w}, g2[8] = {g2a.x, g2a.y, g2a.z, g2a.w, g2b.x, g2b.y, g2b.z, g2b.w};
        float o1[8], o2[8];
#pragma unroll
        for (int j = 0; j < 8; ++j) { const float y1 = x1[j] * rs * g1[j], y2 = x2[j] * rs * g2[j]; o1[j] = y1 * cs[j] - y2 * sn[j]; o2[j] = y2 * cs[j] + y1 * sn[j]; }
        v4u p1, p2; p1.x = pk2(o1[0], o1[1]); p1.y = pk2(o1[2], o1[3]); p1.z = pk2(o1[4], o1[5]); p1.w = pk2(o1[6], o1[7]); p2.x = pk2(o2[0], o2[1]); p2.y = pk2(o2[2], o2[3]); p2.z = pk2(o2[4], o2[5]); p2.w = pk2(o2[6], o2[7]);
        if (hd < 6) {
            if (smp) { float* q = (float*)(a.ws + WS_SQ) + (size_t)(row - MP) * 768 + hd * 128 + c8;
                *(f32x4*)q = (f32x4){o1[0], o1[1], o1[2], o1[3]}; *(f32x4*)(q + 4) = (f32x4){o1[4], o1[5], o1[6], o1[7]}; *(f32x4*)(q + 64) = (f32x4){o2[0], o2[1], o2[2], o2[3]}; *(f32x4*)(q + 68) = (f32x4){o2[4], o2[5], o2[6], o2[7]}; }
            else { bf16* q = (bf16*)(a.ws + WS_QB) + ((size_t)(b * 6 + hd) * SEQ + t) * 128 + c8; *(v4u*)q = p1; *(v4u*)(q + 64) = p2; }
        } else {
            const int kvh = hd - 6;
            float* ko = (smp ? a.out + O_KS + (size_t)(row - MP) * 256 : a.out + O_KP + (size_t)row * 256) + kvh * 128 + c8;
            *(f32x4*)ko = (f32x4){o1[0], o1[1], o1[2], o1[3]}; *(f32x4*)(ko + 4) = (f32x4){o1[4], o1[5], o1[6], o1[7]}; *(f32x4*)(ko + 64) = (f32x4){o2[0], o2[1], o2[2], o2[3]}; *(f32x4*)(ko + 68) = (f32x4){o2[4], o2[5], o2[6], o2[7]};
            if (!smp) { bf16* kb = (bf16*)(a.ws + WS_KB) + ((size_t)(b * 2 + kvh) * SEQ + t) * 128 + c8; *(v4u*)kb = p1; *(v4u*)(kb + 64) = p2; }
        }
    }
    {
        const f32x4 v = {bf2f((unsigned)vv & 0xffffu), bf2f(((unsigned)vv) >> 16), bf2f((unsigned)(vv >> 32) & 0xffffu), bf2f((unsigned)(vv >> 48))};
        float* vo = smp ? a.out + O_VS + (size_t)(row - MP) * 256 : a.out + O_VP + (size_t)row * 256;
        *(f32x4*)(vo + 4 * lane) = v;
        if (!smp) { const int kvh = lane >> 5, dd = (lane & 31) * 4; *(u64*)((bf16*)(a.ws + WS_VB) + ((size_t)(b * 2 + kvh) * SEQ + t) * 128 + dd) = vv; }
    }
    const f32x4 c6 = *(const LAS f32x4*)(tb + 128 + c4), s6 = *(const LAS f32x4*)(tb + 160 + c4);
    {
        const float x1[4] = {bf2f((unsigned)qa & 0xffffu), bf2f(((unsigned)qa) >> 16), bf2f((unsigned)(qa >> 32) & 0xffffu), bf2f((unsigned)(qa >> 48))};
        const float x2[4] = {bf2f((unsigned)qb & 0xffffu), bf2f(((unsigned)qb) >> 16), bf2f((unsigned)(qb >> 32) & 0xffffu), bf2f((unsigned)(qb >> 48))};
        float o1[4], o2[4];
#pragma unroll
        for (int j = 0; j < 4; ++j) { o1[j] = x1[j] * c6[j] - x2[j] * s6[j]; o2[j] = x2[j] * c6[j] + x1[j] * s6[j]; }
        if (smp) { float* q = (float*)(a.ws + WS_SIQ) + (size_t)(row - MP) * 512 + hd * 64 + c4; *(f32x4*)q = (f32x4){o1[0], o1[1], o1[2], o1[3]}; *(f32x4*)(q + 32) = (f32x4){o2[0], o2[1], o2[2], o2[3]}; }
        else { bf16* q = (bf16*)(a.ws + WS_IQB) + (size_t)row * 512 + hd * 64 + c4; *(u64*)q = (u64)pk2(o1[0], o1[1]) | ((u64)pk2(o1[2], o1[3]) << 32); *(u64*)(q + 32) = (u64)pk2(o2[0], o2[1]) | ((u64)pk2(o2[2], o2[3]) << 32); }
    }
    {
        const float x1[4] = {bf2f((unsigned)ka & 0xffffu), bf2f(((unsigned)ka) >> 16), bf2f((unsigned)(ka >> 32) & 0xffffu), bf2f((unsigned)(ka >> 48))};
        const float x2[4] = {bf2f((unsigned)kb_ & 0xffffu), bf2f(((unsigned)kb_) >> 16), bf2f((unsigned)(kb_ >> 32) & 0xffffu), bf2f((unsigned)(kb_ >> 48))};
        float s = 0.f;
#pragma unroll
        for (int j = 0; j < 4; ++j) s += x1[j] * x1[j] + x2[j] * x2[j];
        const float rs = rsqrtf(sum8_dpp(s) * (1.0f / 64.0f) + EPS);
        float o1[4], o2[4];
#pragma unroll
        for (int j = 0; j < 4; ++j) { const float y1 = x1[j] * rs * gk1[j], y2 = x2[j] * rs * gk2[j]; o1[j] = y1 * c6[j] - y2 * s6[j]; o2[j] = y2 * c6[j] + y1 * s6[j]; }
        if (lane < 8) {
            float* ko = (smp ? a.out + O_IKS + (size_t)(row - MP) * 64 : a.out + O_IKP + (size_t)row * 64) + c4; *(f32x4*)ko = (f32x4){o1[0], o1[1], o1[2], o1[3]}; *(f32x4*)(ko + 32) = (f32x4){o2[0], o2[1], o2[2], o2[3]};
            if (!smp) { bf16* kb = (bf16*)(a.ws + WS_IKB) + (size_t)row * 64 + c4; *(u64*)kb = (u64)pk2(o1[0], o1[1]) | ((u64)pk2(o1[2], o1[3]) << 32); *(u64*)(kb + 32) = (u64)pk2(o2[0], o2[1]) | ((u64)pk2(o2[2], o2[3]) << 32); }
            const float wv = wraw * (0.35355339059327373f * 0.125f);
            if (smp) ((float*)(a.ws + WS_SIW))[(row - MP) * 8 + lane] = wv; else ((float*)(a.ws + WS_IW))[(size_t)row * 8 + lane] = wv; }
    }
}
__device__ __forceinline__ void p8_dsa_post(Ctx& c, ARGREF a) {
    constexpr int NRB = (MVALID + 63) / 64;
    for (;;) { const int u = q_next(c, 1); if (u >= 384 + NRB) break;
        if (u < 256) memattn_prompt_unit(c, a, 1, u);
        else if (u < 256 + NRB) { const int r0 = (u - 256) * 64 + c.wave;
#pragma unroll 1
            for (int i = 0; i < 8; ++i) { const int row = r0 + 8 * i; if (row < MVALID) dsa_post_row(a, row, c.lane, (LAS float*)(c.lds) + c.wave * 256); } }
        else memattn_sample_unit(c, a, 1, u - 256 - NRB); }
}

__device__ __forceinline__ void idx_prompt_unit(Ctx& c, ARGREF a, int b, int qb) {
    int tid = c.tid; asm volatile("" : "+v"(tid));
    const int lane = tid & 63, r32 = lane & 31, hh = lane >> 5, w = c.wave;
    const int q0 = b * SEQ + qb * 32;
    LAS bf16* IQL = (LAS bf16*)(c.lds);
    { const bf16* src = (const bf16*)(a.ws + WS_IQB) + (size_t)q0 * 512;
#pragma unroll
      for (int i = 0; i < 4; ++i) { const int row = tid >> 4, ch = (tid & 15) + 16 * i; *(LAS v4u*)(IQL + row * 520 + ch * 8) = *(const v4u*)(src + (size_t)row * 512 + ch * 8); } }
    __syncthreads();
    const bf16* IK = (const bf16*)(a.ws + WS_IKB) + (size_t)(b * SEQ) * 64 + (size_t)r32 * 64 + 8 * hh;
    float* SC = (float*)(a.ws + WS_SC) + (size_t)(q0 + r32) * SEQ;
    float wv[8];
#pragma unroll
    for (int h = 0; h < 8; ++h) wv[h] = ((const float*)(a.ws + WS_IW))[(size_t)(q0 + r32) * 8 + h];
    bf16x8 ak[4], an[4];
    if (w <= qb) {
#pragma unroll
        for (int ks = 0; ks < 4; ++ks) ak[ks] = *(const bf16x8*)(IK + (size_t)(w * 32) * 64 + ks * 16); }
#pragma unroll 1
    for (int kt = w; kt <= qb; kt += 8) {
        if (kt + 8 <= qb) {
#pragma unroll
            for (int ks = 0; ks < 4; ++ks) an[ks] = *(const bf16x8*)(IK + (size_t)((kt + 8) * 32) * 64 + ks * 16); }
        f32x16 sc = {};
        int qoff = r32 * 520 + 8 * hh; asm volatile("" : "+v"(qoff));
#pragma unroll
        for (int h = 0; h < 8; ++h) { f32x16 d = {};
#pragma unroll
            for (int ks = 0; ks < 4; ++ks) d = __builtin_amdgcn_mfma_f32_32x32x16_bf16(ak[ks], *(const LAS bf16x8*)(IQL + qoff + h * 64 + ks * 16), d, 0, 0, 0);
#pragma unroll
            for (int r = 0; r < 16; ++r) sc[r] = fmaf(wv[h], fmaxf(d[r], 0.f), sc[r]); }
        {
            LAS float* TP = (LAS float*)(c.lds + 36864) + w * (32 * 36);
#pragma unroll
            for (int g = 0; g < 4; ++g) *(LAS f32x4*)(TP + r32 * 36 + 8 * g + 4 * hh) = (f32x4){sc[4 * g], sc[4 * g + 1], sc[4 * g + 2], sc[4 * g + 3]};
            float* SCt = (float*)(a.ws + WS_SC) + (size_t)q0 * SEQ + kt * 32 + (lane & 7) * 4;
#pragma unroll
            for (int ps = 0; ps < 4; ++ps) { const int rr = (lane >> 3) + 8 * ps; *(f32x4*)(SCt + (size_t)rr * SEQ) = *(const LAS f32x4*)(TP + rr * 36 + (lane & 7) * 4); } }
#pragma unroll
        for (int ks = 0; ks < 4; ++ks) ak[ks] = an[ks];
    }
}
__device__ __forceinline__ v4u pack8f(const float* p) { const f32x4 x = *(const f32x4*)p, y = *(const f32x4*)(p + 4); v4u o; o.x = pk2(x.x, x.y); o.y = pk2(x.z, x.w); o.z = pk2(y.x, y.y); o.w = pk2(y.z, y.w); return o; }
__device__ __forceinline__ void idx_sample_tile(ARGREF a, int sb, int tl, int lane_) {
    int lane = lane_; asm volatile("" : "+v"(lane));
    const int r32 = lane & 31, hh = lane >> 5, tk = r32 >> 3, hd = r32 & 7;
    const float* iq = (const float*)(a.ws + WS_SIQ) + (size_t)(sb * 4 + tk) * 512 + hd * 64 + 8 * hh;
    const float wv = ((const float*)(a.ws + WS_SIW))[(sb * 4 + tk) * 8 + hd];
    const float* src;
    if (tl < 256) src = a.in[4] + ((size_t)a.page_table[sb * 64 + (tl >> 2)] * 128 + (tl & 3) * 32 + r32) * 64 + 8 * hh;
    else src = a.out + O_IKS + (size_t)(sb * 4 + (r32 & 3)) * 64 + 8 * hh;
    v4u af[4], bf_[4];
#pragma unroll
    for (int ks = 0; ks < 4; ++ks) { af[ks] = pack8f(src + 16 * ks); bf_[ks] = pack8f(iq + 16 * ks); }
    if (tl == 256 && r32 >= 4) {
#pragma unroll
        for (int ks = 0; ks < 4; ++ks) af[ks] = (v4u){0u, 0u, 0u, 0u}; }
    f32x16 d = {};
#pragma unroll
    for (int ks = 0; ks < 4; ++ks) d = __builtin_amdgcn_mfma_f32_32x32x16_bf16(__builtin_bit_cast(bf16x8, af[ks]), __builtin_bit_cast(bf16x8, bf_[ks]), d, 0, 0, 0);
    float* dst = (float*)(a.ws + WS_SSC) + (size_t)(sb * 4 + tk) * SSC_LD + tl * 32;
#pragma unroll
    for (int r = 0; r < 16; ++r) { float v = wv * fmaxf(d[r], 0.f);
        v += __builtin_bit_cast(float, __builtin_amdgcn_update_dpp(0, __builtin_bit_cast(int, v), 0xB1, 0xF, 0xF, false));
        v += __builtin_bit_cast(float, __builtin_amdgcn_update_dpp(0, __builtin_bit_cast(int, v), 0x4E, 0xF, 0xF, false));
        v += __builtin_bit_cast(float, __builtin_amdgcn_update_dpp(0, __builtin_bit_cast(int, v), 0x141, 0xF, 0xF, false));
        if (hd == 0) dst[crow(r, hh)] = v; }
}
__device__ __forceinline__ void idx_sample_page(ARGREF a, int sb, int g, int lane_) {
    int lane = lane_; asm volatile("" : "+v"(lane));
    const int r32 = lane & 31, hh = lane >> 5, tk = r32 >> 3, hd = r32 & 7;
    const float* iq = (const float*)(a.ws + WS_SIQ) + (size_t)(sb * 4 + tk) * 512 + hd * 64 + 8 * hh;
    const float wv = ((const float*)(a.ws + WS_SIW))[(sb * 4 + tk) * 8 + hd];
    const float* src = a.in[4] + ((size_t)a.page_table[sb * 64 + g] * 128 + r32) * 64 + 8 * hh;
    f32x4 kr[4][8], qr[8];
#pragma unroll
    for (int t = 0; t < 4; ++t)
#pragma unroll
        for (int ks = 0; ks < 4; ++ks) { kr[t][2 * ks] = *(const f32x4*)(src + (size_t)t * 32 * 64 + 16 * ks); kr[t][2 * ks + 1] = *(const f32x4*)(src + (size_t)t * 32 * 64 + 16 * ks + 4); }
#pragma unroll
    for (int ks = 0; ks < 4; ++ks) { qr[2 * ks] = *(const f32x4*)(iq + 16 * ks); qr[2 * ks + 1] = *(const f32x4*)(iq + 16 * ks + 4); }
    v4u bf_[4];
#pragma unroll
    for (int ks = 0; ks < 4; ++ks) { const f32x4 x = qr[2 * ks], y = qr[2 * ks + 1]; bf_[ks].x = pk2(x.x, x.y); bf_[ks].y = pk2(x.z, x.w); bf_[ks].z = pk2(y.x, y.y); bf_[ks].w = pk2(y.z, y.w); }
    float* dst = (float*)(a.ws + WS_SSC) + (size_t)(sb * 4 + tk) * SSC_LD + g * 128;
#pragma unroll
    for (int t = 0; t < 4; ++t) { f32x16 d = {};
#pragma unroll
        for (int ks = 0; ks < 4; ++ks) { const f32x4 x = kr[t][2 * ks], y = kr[t][2 * ks + 1]; v4u af; af.x = pk2(x.x, x.y); af.y = pk2(x.z, x.w); af.z = pk2(y.x, y.y); af.w = pk2(y.z, y.w);
            d = __builtin_amdgcn_mfma_f32_32x32x16_bf16(__builtin_bit_cast(bf16x8, af), __builtin_bit_cast(bf16x8, bf_[ks]), d, 0, 0, 0); }
        float vv[16];
#pragma unroll
        for (int r = 0; r < 16; ++r) { float v = wv * fmaxf(d[r], 0.f);
            v += __builtin_bit_cast(float, __builtin_amdgcn_update_dpp(0, __builtin_bit_cast(int, v), 0xB1, 0xF, 0xF, false));
            v += __builtin_bit_cast(float, __builtin_amdgcn_update_dpp(0, __builtin_bit_cast(int, v), 0x4E, 0xF, 0xF, false));
            v += __builtin_bit_cast(float, __builtin_amdgcn_update_dpp(0, __builtin_bit_cast(int, v), 0x141, 0xF, 0xF, false));
            vv[r] = v; }
        if (hd == 0) {
#pragma unroll
            for (int g = 0; g < 4; ++g) *(f32x4*)(dst + t * 32 + 8 * g + 4 * hh) = (f32x4){vv[4 * g], vv[4 * g + 1], vv[4 * g + 2], vv[4 * g + 3]}; } }
}
__device__ __forceinline__ void p9_indexer(Ctx& c, ARGREF a) {
    const int gw = c.vcu * NWAVES + c.wave, NGW = c.G * NWAVES;
#pragma unroll 1
    for (int e = gw; e < 32 * 64; e += NGW) { idx_sample_page(a, e >> 6, e & 63, c.lane); if ((e & 63) == 63) idx_sample_tile(a, e >> 6, 256, c.lane); }
    for (;;) { const int u = q_next(c, 2); if (u >= 512) break; idx_prompt_unit(c, a, u & 3, 127 - (u >> 2)); }
}


#ifndef TKREP_C
#define TKREP_C 1
#endif
#ifndef TKREP_D
#define TKREP_D 1
#endif
__device__ __forceinline__ unsigned fkey(float f) { const unsigned u = __builtin_bit_cast(unsigned, f + 0.0f); return (u & 0x80000000u) ? ~u : (u | 0x80000000u); }
__device__ __forceinline__ void acc_ge(int& cnt, unsigned key, unsigned cand) { asm volatile("v_cmp_le_u32_e32 vcc, %1, %2\n\tv_addc_co_u32_e32 %0, vcc, 0, %0, vcc" : "+v"(cnt) : "s"(cand), "v"(key) : "vcc"); }
__device__ __forceinline__ void acc_ge4(int& c0, int& c1, int& c2, int& c3, unsigned k0, unsigned k1, unsigned k2, unsigned k3, unsigned cand) {
    u64 m0, m1, m2, m3;
    asm volatile("v_cmp_le_u32_e64 %4, %8, %9\n\tv_cmp_le_u32_e64 %5, %8, %10\n\tv_cmp_le_u32_e64 %6, %8, %11\n\tv_cmp_le_u32_e64 %7, %8, %12\n\t"
                 "v_addc_co_u32_e64 %0, %4, 0, %0, %4\n\tv_addc_co_u32_e64 %1, %5, 0, %1, %5\n\tv_addc_co_u32_e64 %2, %6, 0, %2, %6\n\tv_addc_co_u32_e64 %3, %7, 0, %3, %7"
                 : "+v"(c0), "+v"(c1), "+v"(c2), "+v"(c3), "=&s"(m0), "=&s"(m1), "=&s"(m2), "=&s"(m3) : "s"(cand), "v"(k0), "v"(k1), "v"(k2), "v"(k3));
}
__device__ __forceinline__ u64 ballot_nz(unsigned v) { u64 m; asm volatile("v_cmp_ne_u32_e64 %0, 0, %1" : "=s"(m) : "v"(v)); return m; }
__device__ __forceinline__ int wave_sum_dpp(int x) {
    x += __builtin_amdgcn_update_dpp(0, x, 0xB1, 0xF, 0xF, false);
    x += __builtin_amdgcn_update_dpp(0, x, 0x4E, 0xF, 0xF, false);
    x += __builtin_amdgcn_update_dpp(0, x, 0x141, 0xF, 0xF, false);
    x += __builtin_amdgcn_update_dpp(0, x, 0x140, 0xF, 0xF, false);
    return (__builtin_amdgcn_readlane(x, 0) + __builtin_amdgcn_readlane(x, 16)) + (__builtin_amdgcn_readlane(x, 32) + __builtin_amdgcn_readlane(x, 48));
}
__device__ __forceinline__ int mbcnt64(u64 m) { return (int)__builtin_amdgcn_mbcnt_hi((unsigned)(m >> 32), __builtin_amdgcn_mbcnt_lo((unsigned)m, 0u)); }
constexpr int TK_LOWBITS = 18;
__device__ __forceinline__ void topk_finish(unsigned ck, int cp, int A, int posmax, unsigned& T, int& P, int nbits = TK_LOWBITS) {
#pragma unroll 1
    for (int bit = nbits - 1; bit >= 0; --bit) { const unsigned cand = T | (1u << bit); if (A + __builtin_popcountll(__ballot(ck >= cand)) >= 256) T = cand; }
    const int need = 256 - (A + __builtin_popcountll(__ballot(ck > T))), ceq = __builtin_popcountll(__ballot(ck == T));
    P = posmax;
    if (ceq != need) { P = 0;
#pragma unroll 1
        for (int bit = 13; bit >= 0; --bit) { const int cand = P | (1 << bit); if (__builtin_popcountll(__ballot(ck == T && cp < cand)) < need) P = cand; } }
}
__device__ __forceinline__ unsigned wave_min_u(unsigned x) {
    x = min(x, (unsigned)__builtin_amdgcn_update_dpp(0, (int)x, 0xB1, 0xF, 0xF, false)); x = min(x, (unsigned)__builtin_amdgcn_update_dpp(0, (int)x, 0x4E, 0xF, 0xF, false));
    x = min(x, (unsigned)__builtin_amdgcn_update_dpp(0, (int)x, 0x141, 0xF, 0xF, false)); x = min(x, (unsigned)__builtin_amdgcn_update_dpp(0, (int)x, 0x140, 0xF, 0xF, false));
    return min(min((unsigned)__builtin_amdgcn_readlane((int)x, 0), (unsigned)__builtin_amdgcn_readlane((int)x, 16)), min((unsigned)__builtin_amdgcn_readlane((int)x, 32), (unsigned)__builtin_amdgcn_readlane((int)x, 48)));
}
__device__ __forceinline__ unsigned wave_max_u(unsigned x) {
    x = max(x, (unsigned)__builtin_amdgcn_update_dpp(0, (int)x, 0xB1, 0xF, 0xF, false)); x = max(x, (unsigned)__builtin_amdgcn_update_dpp(0, (int)x, 0x4E, 0xF, 0xF, false));
    x = max(x, (unsigned)__builtin_amdgcn_update_dpp(0, (int)x, 0x141, 0xF, 0xF, false)); x = max(x, (unsigned)__builtin_amdgcn_update_dpp(0, (int)x, 0x140, 0xF, 0xF, false));
    return max(max((unsigned)__builtin_amdgcn_readlane((int)x, 0), (unsigned)__builtin_amdgcn_readlane((int)x, 16)), max((unsigned)__builtin_amdgcn_readlane((int)x, 32), (unsigned)__builtin_amdgcn_readlane((int)x, 48)));
}
template <int NJ>
__device__ __forceinline__ void topk_prompt_row(ARGREF a, const float* SCb, int row, int lane, LAS unsigned* cl) {
        const int t = row & 4095;
        u64* mk = (u64*)(a.ws + WS_MASK) + (size_t)row * 64;
        unsigned key[NJ];
        { const float* sc_ = SCb + (size_t)row * SEQ + lane; const int tj_ = t >> 6;
          float v[NJ];
#pragma unroll
          for (int j = 0; j < NJ; ++j) v[j] = sc_[64 * (j < tj_ ? j : tj_)];
          const u64 dmask = (2ull << (t & 63)) - 1ull;
#pragma unroll
          for (int j = 0; j < NJ; ++j) { const int u = __builtin_bit_cast(int, v[j] + 0.0f); const unsigned k = (unsigned)u ^ ((unsigned)(u >> 31) | 0x80000000u);
              const u64 vm = j < tj_ ? ~0ull : (j == tj_ ? dmask : 0ull); asm("v_cndmask_b32_e64 %0, 0, %1, %2" : "=v"(key[j]) : "v"(k), "s"(vm)); } }
        unsigned kh[NJ];
#pragma unroll
        for (int j = 0; j < NJ; ++j) { kh[j] = key[j] >> 1; asm volatile("" : "+v"(kh[j])); }
        unsigned T; int hb;
        {
            unsigned b0 = 0u, b1 = 0u, b2 = 0u, b3 = 0u;
#pragma unroll
            for (int j = 0; j < NJ; ++j) { const unsigned x = key[j]; unsigned n1, n2, n3;
                asm("v_med3_u32 %0, %1, %2, %3" : "=v"(n3) : "v"(b2), "v"(b3), "v"(x)); asm("v_med3_u32 %0, %1, %2, %3" : "=v"(n2) : "v"(b1), "v"(b2), "v"(x)); asm("v_med3_u32 %0, %1, %2, %3" : "=v"(n1) : "v"(b0), "v"(b1), "v"(x));
                b0 = max(b0, x); b1 = n1; b2 = n2; b3 = n3; }
            const unsigned L = wave_min_u(b3), H = wave_max_u(b3), df = L ^ H;
            hb = df ? 31 - __builtin_clz(df) : -1;
            T = hb >= 31 ? 0u : (L & ~((2u << (hb < 0 ? 0 : hb)) - 1u)); if (hb < 0) T = L;
        }
#define TK_FULLCOUNT(CAND, OUT) do { const unsigned cs_ = __builtin_amdgcn_readfirstlane(CAND); int c0_ = 0, c1_ = 0, c2_ = 0, c3_ = 0; \
        _Pragma("unroll") for (int j = 0; j < NJ; j += 4) acc_ge4(c0_, c1_, c2_, c3_, key[j], key[j + 1], key[j + 2], key[j + 3], cs_); OUT = wave_sum_dpp((c0_ + c1_) + (c2_ + c3_)); } while (0)
#define TK_FASTCOUNT(CAND, OUT, PC) do { const unsigned ch_ = __builtin_amdgcn_readfirstlane((CAND) >> 1); unsigned a_[8] = {0u, 0u, 0u, 0u, 0u, 0u, 0u, 0u}; \
        _Pragma("unroll") for (int j = 0; j < NJ; j += 8) { unsigned d_[8]; _Pragma("unroll") for (int i = 0; i < 8; ++i) d_[i] = kh[j + i] - ch_; \
            _Pragma("unroll") for (int i = 0; i < 8; ++i) a_[i] = __builtin_amdgcn_alignbit(a_[i], d_[i], 31); } \
        PC = ((__builtin_popcount(a_[0]) + __builtin_popcount(a_[1])) + (__builtin_popcount(a_[2]) + __builtin_popcount(a_[3]))) + \
             ((__builtin_popcount(a_[4]) + __builtin_popcount(a_[5])) + (__builtin_popcount(a_[6]) + __builtin_popcount(a_[7]))); OUT = 64 * NJ - wave_sum_dpp(PC); } while (0)
        int nb = hb + 1, clo = -1, chi = -1, pclo = 0, pchi = NJ;
#pragma unroll 1
        while (nb > 1 && (clo < 0 || chi < 0 || clo - chi > 64)) { const int bit = nb - 1; const unsigned cand = T | (1u << bit); int tot, pc; TK_FASTCOUNT(cand, tot, pc); if (tot >= 256) { T = cand; clo = tot; pclo = pc; } else { chi = tot; pchi = pc; } nb = bit; }
        int A = 0, cT = 4096;
        if (nb >= 1) { const unsigned hib = T + (1u << nb); if (chi >= 0) A = chi; else if (hib != 0u) TK_FASTCOUNT(hib, A, pchi); if (clo >= 0) cT = clo; else TK_FASTCOUNT(T, cT, pclo); }
#undef TK_FASTCOUNT
        int P;
        if (cT - A <= 64) {
            const unsigned bw = 1u << nb; const int mine = pchi - pclo;
            int inc = mine;
            inc += __builtin_amdgcn_update_dpp(0, inc, 0x111, 0xF, 0xF, true); inc += __builtin_amdgcn_update_dpp(0, inc, 0x112, 0xF, 0xF, true);
            inc += __builtin_amdgcn_update_dpp(0, inc, 0x114, 0xF, 0xF, true); inc += __builtin_amdgcn_update_dpp(0, inc, 0x118, 0xF, 0xF, true);
            { const int r0 = __builtin_amdgcn_readlane(inc, 15), r1 = __builtin_amdgcn_readlane(inc, 31), r2 = __builtin_amdgcn_readlane(inc, 47);
              inc += lane >= 48 ? r0 + r1 + r2 : (lane >= 32 ? r0 + r1 : (lane >= 16 ? r0 : 0)); }
            LAS unsigned* wp = cl + (inc - mine); LAS unsigned* const tr = cl + 128 + lane;
            int pj = lane;
#pragma unroll
            for (int j = 0; j < NJ; ++j) { const bool und = (key[j] - T) < bw; LAS unsigned* q = und ? wp : tr; q[0] = key[j]; q[64] = (unsigned)pj; wp += und ? 1 : 0;
                pj += 64; asm volatile("" : "+v"(pj)); }
            const int nund = cT - A;
            const unsigned ck = lane < nund ? cl[lane] : 0u; const int cp = (int)cl[64 + lane];
            topk_finish(ck, cp, A, 4095, T, P, nb);
        } else {
#pragma unroll 1
            for (int bit = nb - 1; bit >= 0; --bit) { const unsigned cand = T | (1u << bit); int tot; TK_FULLCOUNT(cand, tot); if (tot >= 256) T = cand; }
            int cge, cgt; TK_FULLCOUNT(T, cge); cgt = 0; if (T != 0xffffffffu) TK_FULLCOUNT(T + 1u, cgt);
            const int need = 256 - cgt, ceq = cge - cgt; P = 4095;
            if (ceq != need) { P = 0;
#pragma unroll 1
                for (int bit = 11; bit >= 0; --bit) { const int cand = P | (1 << bit); int cnt = 0; int pj = lane;
#pragma unroll
                    for (int j = 0; j < NJ; ++j) { cnt += (key[j] == T && pj < cand) ? 1 : 0; pj += 64; asm volatile("" : "+v"(pj)); }
                    if (wave_sum_dpp(cnt) < need) P = cand; } }
        }
#undef TK_FULLCOUNT
        if (P != 4095) {
            int pq = lane;
#pragma unroll
            for (int j = 0; j < NJ; ++j) { if (key[j] == T && pq > P) key[j] = 0u; pq += 64; asm volatile("" : "+v"(pq)); } }
        unsigned wlo = 0u, whi = 0u; const unsigned Ts = __builtin_amdgcn_readfirstlane(T);
#pragma unroll 1
        for (int rep_ = 0; rep_ < TKREP_D; ++rep_)
#pragma unroll
        for (int j = 0; j < NJ; ++j) asm volatile("v_cmp_le_u32_e32 vcc, %2, %3\n\ts_nop 3\n\tv_writelane_b32 %0, vcc_lo, %4\n\tv_writelane_b32 %1, vcc_hi, %4" : "+v"(wlo), "+v"(whi) : "s"(Ts), "v"(key[j]), "i"(j) : "vcc");
        mk[lane] = ((u64)whi << 32) | (u64)wlo;
}
__device__ __forceinline__ int topk_row_of(int gw, int NGW, int i) { const int idx = gw + (i >> 1) * NGW, b = idx >> 11, u = idx & 2047; return b * 4096 + ((i & 1) ? 4095 - u : u); }
__device__ __forceinline__ void topk_prompt_rows(ARGREF a, int gw, int NGW, int count, unsigned mask, int e0, int e1, int lane_, LAS unsigned* cl) {
    int lane = lane_; asm volatile("" : "+v"(lane));
    const float* SCb = (const float*)(a.ws + WS_SC);
#pragma unroll 1
    for (int i_ = 0; i_ < count + 2; ++i_) { int row;
        if (i_ < count) { if (!((mask >> i_) & 1u)) continue; row = topk_row_of(gw, NGW, i_); } else { row = i_ == count ? e0 : e1; if (row < 0) continue; }
        const int t = row & 4095;
        if (t < 256) { u64 myword = 0ull; u64* mk = (u64*)(a.ws + WS_MASK) + (size_t)row * 64;
#pragma unroll 1
            for (int j = 0; j < 64; ++j) { const u64 m = __ballot(64 * j + lane <= t); if (lane == j) myword = m; }
            mk[lane] = myword; }
        else if (t < 1024) topk_prompt_row<16>(a, SCb, row, lane, cl);
        else if (t < 2048) topk_prompt_row<32>(a, SCb, row, lane, cl);
        else if (t < 3072) topk_prompt_row<48>(a, SCb, row, lane, cl);
        else topk_prompt_row<64>(a, SCb, row, lane, cl);
    }
}
__device__ __forceinline__ void topk_sample_row(ARGREF a, int q, int lane_, LAS unsigned* K, LAS unsigned* cl) {
    int lane = lane_; asm volatile("" : "+v"(lane));
    const int t = q & 3, n = PAST + t + 1; const float* sc = (const float*)(a.ws + WS_SSC) + (size_t)q * SSC_LD;
    int* out = (int*)(a.ws + WS_SIDX) + q * 256;
    unsigned key[129];
#pragma unroll
    for (int j = 0; j < 129; ++j) { const float v = sc[64 * j + lane]; key[j] = (j < 128 || lane < n - 8192) ? fkey(v) : 0u; }
#pragma unroll
    for (int j = 0; j < 129; ++j) K[64 * j + lane] = key[j];
#define TK_FULLCOUNT(CAND, OUT) do { const unsigned cs_ = __builtin_amdgcn_readfirstlane(CAND); int c0_ = 0, c1_ = 0, c2_ = 0, c3_ = 0; \
        _Pragma("unroll") for (int j = 0; j < 128; j += 4) acc_ge4(c0_, c1_, c2_, c3_, key[j], key[j + 1], key[j + 2], key[j + 3], cs_); acc_ge(c0_, key[128], cs_); OUT = wave_sum_dpp((c0_ + c1_) + (c2_ + c3_)); } while (0)
    unsigned T = 0u;
#pragma unroll 1
    for (int bit = 31; bit >= TK_LOWBITS; --bit) { const unsigned cand = T | (1u << bit); int tot; TK_FULLCOUNT(cand, tot); if (tot >= 256) T = cand; }
    const unsigned hib = T + (1u << TK_LOWBITS);
    int A = 0, cT; if (hib != 0u) TK_FULLCOUNT(hib, A); TK_FULLCOUNT(T, cT);
    int P;
    if (cT - A <= 64) {
        int base = 0;
#pragma unroll 1
        for (int j0 = 0; j0 < 128; j0 += 8) { unsigned kk[8];
#pragma unroll
            for (int i = 0; i < 8; ++i) kk[i] = K[64 * (j0 + i) + lane];
#pragma unroll
            for (int i = 0; i < 8; ++i) { const unsigned und = (kk[i] - T) < (1u << TK_LOWBITS) ? 1u : 0u; const u64 m = ballot_nz(und); const int pos = base + mbcnt64(m);
                if (und) { cl[pos] = kk[i]; cl[64 + pos] = (unsigned)(64 * (j0 + i) + lane); }
                base += __builtin_popcountll(m); } }
        { const unsigned kj = K[64 * 128 + lane]; const unsigned und = (kj - T) < (1u << TK_LOWBITS) ? 1u : 0u; const u64 m = ballot_nz(und); const int pos = base + mbcnt64(m);
          if (und) { cl[pos] = kj; cl[64 + pos] = (unsigned)(64 * 128 + lane); } base += __builtin_popcountll(m); }
        const unsigned ck = lane < base ? cl[lane] : 0u; const int cp = (int)cl[64 + lane];
        topk_finish(ck, cp, A, 16383, T, P);
    } else {
#pragma unroll 1
        for (int bit = TK_LOWBITS - 1; bit >= 0; --bit) { const unsigned cand = T | (1u << bit); int tot; TK_FULLCOUNT(cand, tot); if (tot >= 256) T = cand; }
        int cge, cgt; TK_FULLCOUNT(T, cge); cgt = 0; if (T != 0xffffffffu) TK_FULLCOUNT(T + 1u, cgt);
        const int need = 256 - cgt, ceq = cge - cgt; P = 16383;
        if (ceq != need) { P = 0;
#pragma unroll 1
            for (int bit = 13; bit >= 0; --bit) { const int cand = P | (1 << bit); int cnt = 0;
#pragma unroll 4
                for (int j = 0; j < 129; ++j) cnt += (K[64 * j + lane] == T && 64 * j + lane < cand) ? 1 : 0;
                if (wave_sum_dpp(cnt) < need) P = cand; } }
    }
#undef TK_FULLCOUNT
    int base = 0;
#pragma unroll 1
    for (int j0 = 0; j0 < 136; j0 += 8) { unsigned kk[8];
#pragma unroll
        for (int i = 0; i < 8; ++i) kk[i] = (j0 + i < 129) ? K[64 * (j0 + i) + lane] : 0u;
#pragma unroll
        for (int i = 0; i < 8; ++i) { const int ps = 64 * (j0 + i) + lane; const unsigned selv = (kk[i] > T || (kk[i] == T && ps <= P)) ? 1u : 0u; const u64 m = ballot_nz(selv);
            const int pos = base + mbcnt64(m);
            if (selv && pos < 256) out[pos] = ps;
            base += __builtin_popcountll(m); } }
}
__device__ __forceinline__ void p10_topk(Ctx& c, ARGREF a) {
    const int gw = c.vcu * NWAVES + c.wave, NGW = c.G * NWAVES;
    LAS unsigned* cl = (LAS unsigned*)(c.lds) + c.wave * 256;
    if (c.wave == 0 && c.vcu < MS) topk_sample_row(a, c.vcu, c.lane, (LAS unsigned*)(c.lds + 8192), cl);
    const int NPAIR = MP / 2;
    int count = gw < NPAIR ? 2 * ((NPAIR - gw + NGW - 1) / NGW) : 0, e0 = -1, e1 = -1; unsigned mask = 0xffffffffu;
    if (c.G == 256 && c.vcu < MS) { const int g0 = c.vcu * NWAVES, w = c.wave;
        if (w == 0) mask = 0x1fu;
        else if (w <= 2) { mask = 0xaau; e0 = topk_row_of(g0, NGW, w == 1 ? 5 : 7); }
        else if (w <= 5) { e0 = topk_row_of(g0 + 1, NGW, 2 * (w - 3)); e1 = topk_row_of(g0 + 2, NGW, 2 * (w - 2)); }
        else if (w == 6) { e0 = topk_row_of(g0 + 1, NGW, 6); e1 = topk_row_of(g0, NGW, 6); }
        else e0 = topk_row_of(g0 + 2, NGW, 0); }
    topk_prompt_rows(a, gw, NGW, count, mask, e0, e1, c.lane, cl);
}


__device__ __forceinline__ void attn_sample_unit(Ctx& c, ARGREF a, int sb, int t) {
    LAS bf16* KV = (LAS bf16*)(c.lds);
    LAS float* QL = (LAS float*)(c.lds + 69632);
    LAS float* SL = (LAS float*)(c.lds + 69632 + 3072);
    LAS float* OL = (LAS float*)(c.lds + 69632 + 6144);
    LAS int* IL = (LAS int*)(c.lds + 69632 + 12288);
    LAS unsigned* OFFL = (LAS unsigned*)(c.lds + 69632 + 12288 + 1024);
    int tid = c.tid; asm volatile("" : "+v"(tid));
    const int lane = tid & 63, w = c.wave, q = sb * 4 + t;
    __syncthreads();
    if (tid < 256) IL[tid] = ((const int*)(a.ws + WS_SIDX))[q * 256 + tid];
    for (int i = tid; i < 768; i += 512) QL[i] = ((const float*)(a.ws + WS_SQ))[(size_t)q * 768 + i];
    __syncthreads();
    if (tid < 256) { const int idx = IL[tid];
        OFFL[tid] = idx < PAST ? (unsigned)(((a.page_table[sb * 64 + (idx >> 7)] * 128 + (idx & 127)) * 2) * 128) : (0x80000000u | (unsigned)((sb * 4 + (idx - PAST)) * 256)); }
    __syncthreads();
    bf16* MIX = (bf16*)(a.ws + WS_MIX) + (size_t)(MP + q) * DM;
#pragma unroll 1
    for (int kvh = 0; kvh < 2; ++kvh) {
#pragma unroll 1
        for (int pass = 0; pass < 2; ++pass) {
            const float* pool = pass ? a.in[3] : a.in[2]; const float* nw = a.out + (pass ? O_VS : O_KS);
            { f32x4 gv[16];
#pragma unroll
              for (int r = 0; r < 16; ++r) { const int i = (tid >> 5) + 16 * r; const unsigned off = OFFL[i]; const float* src = (off & 0x80000000u) ? nw + (size_t)(off & 0x7fffffffu) : pool + (size_t)off;
                  gv[r] = *(const f32x4*)(src + kvh * 128 + (tid & 31) * 4); }
#pragma unroll
              for (int r = 0; r < 16; ++r) { const int i = (tid >> 5) + 16 * r; *(LAS u64*)(KV + i * 136 + (tid & 31) * 4) = (u64)pk2(gv[r].x, gv[r].y) | ((u64)pk2(gv[r].z, gv[r].w) << 32); } }
            __syncthreads();
            if (pass == 0) {
                const int i = tid >> 1, dh = (tid & 1) * 64; float s0 = 0.f, s1 = 0.f, s2 = 0.f;
#pragma unroll 8
                for (int d = 0; d < 64; ++d) { const float kx = bf2f(KV[i * 136 + dh + d]);
                    s0 = fmaf(QL[(3 * kvh + 0) * 128 + dh + d], kx, s0); s1 = fmaf(QL[(3 * kvh + 1) * 128 + dh + d], kx, s1); s2 = fmaf(QL[(3 * kvh + 2) * 128 + dh + d], kx, s2); }
                s0 += __shfl_xor(s0, 1); s1 += __shfl_xor(s1, 1); s2 += __shfl_xor(s2, 1);
                if ((tid & 1) == 0) { SL[i] = s0 * 0.08838834764831845f; SL[256 + i] = s1 * 0.08838834764831845f; SL[512 + i] = s2 * 0.08838834764831845f; }
                __syncthreads();
                if (w < 3) { float v[4], mx = -1e30f;
#pragma unroll
                    for (int j = 0; j < 4; ++j) { v[j] = SL[w * 256 + 64 * j + lane]; mx = fmaxf(mx, v[j]); }
#pragma unroll
                    for (int o = 1; o < 64; o <<= 1) mx = fmaxf(mx, __shfl_xor(mx, o));
                    float l = 0.f;
#pragma unroll
                    for (int j = 0; j < 4; ++j) { v[j] = __expf(v[j] - mx); l += v[j]; }
                    l = wave_sum(l); const float il = 1.0f / l;
#pragma unroll
                    for (int j = 0; j < 4; ++j) SL[w * 256 + 64 * j + lane] = v[j] * il; }
                __syncthreads();
            } else {
                const int d = tid & 127, part = tid >> 7; float o0 = 0.f, o1 = 0.f, o2 = 0.f;
#pragma unroll 8
                for (int i = part * 64; i < part * 64 + 64; ++i) { const float vx = bf2f(KV[i * 136 + d]); o0 = fmaf(SL[i], vx, o0); o1 = fmaf(SL[256 + i], vx, o1); o2 = fmaf(SL[512 + i], vx, o2); }
                OL[(part * 3 + 0) * 128 + d] = o0; OL[(part * 3 + 1) * 128 + d] = o1; OL[(part * 3 + 2) * 128 + d] = o2;
                __syncthreads();
                if (tid < 384) { const int hq = tid >> 7, dd = tid & 127; const float o = (OL[hq * 128 + dd] + OL[(3 + hq) * 128 + dd]) + (OL[(6 + hq) * 128 + dd] + OL[(9 + hq) * 128 + dd]);
                    MIX[(3 * kvh + hq) * 128 + dd] = (bf16)f2bf(o); }
                __syncthreads();
            }
        }
    }
}


namespace attn {
using bf16 = unsigned short;
typedef short bf16x8 __attribute__((ext_vector_type(8)));
typedef short s16x4 __attribute__((ext_vector_type(4)));
typedef float f32x16 __attribute__((ext_vector_type(16)));
typedef float f32x4 __attribute__((ext_vector_type(4)));
typedef unsigned u32x4 __attribute__((ext_vector_type(4)));
typedef unsigned u32x2 __attribute__((ext_vector_type(2)));
constexpr int D = 128, OS = 1024;
constexpr float THR = 8.f;
constexpr float SCALE = 0.08838834764831845f;
constexpr int NW = 8, QBLK = 32, KVBLK = 64, QB = NW * QBLK;
constexpr int SHM_V = KVBLK * D * 2, SHM_K = KVBLK * D * 2;
constexpr int LDS_BYTES = 2 * SHM_V + 2 * SHM_K + NW * 64 * 4;

#define KSWZ(row, colB) ((row) * 256 + ((colB) ^ (((row) & 7) << 4)))
#define SBAR() __builtin_amdgcn_sched_barrier(0)
__device__ __forceinline__ int v_st(int k, int c) { const int kk = (k & ~0xC) | ((k & 4) << 1) | ((k & 8) >> 1); return ((kk >> 3) * 4 + (c >> 5)) * 512 + ((kk & 7) * 32 + (c & 31)) * 2; }
__device__ __forceinline__ int v_rd_base(int lane) { return ((lane & 3) << 3) | (((lane >> 2) & 3) << 6) | (((lane >> 4) & 1) << 5) | (((lane >> 5) & 1) << 8); }
constexpr int v_rd_off(int d0, int ks, int half) { return d0 * 512 + ks * 4096 + half * 2048; }
__device__ __forceinline__ int crow(int r, int hi) { return (r & 3) + 8 * (r >> 2) + 4 * hi; }
__device__ __forceinline__ unsigned cvtpk(float lo, float hi) {
    unsigned r; asm volatile("v_cvt_pk_bf16_f32 %0, %1, %2" : "=v"(r) : "v"(lo), "v"(hi)); return r;
}
__device__ __forceinline__ bf16x8 pack8(f32x4 a, f32x4 b) {
    u32x4 w = {cvtpk(a[0], a[1]), cvtpk(a[2], a[3]), cvtpk(b[0], b[1]), cvtpk(b[2], b[3])};
    return *reinterpret_cast<bf16x8*>(&w);
}

__device__ __forceinline__ void partialSM(f32x16& p0, f32x16& p1, float& m_reg, float& mn, float& alpha) {
    float pmax = p0[0]; for (int r = 1; r < 16; ++r) pmax = fmaxf(pmax, p0[r]); for (int r = 0; r < 16; ++r) pmax = fmaxf(pmax, p1[r]);
    { auto rr = __builtin_amdgcn_permlane32_swap(__float_as_uint(pmax), __float_as_uint(pmax), false, false);
      pmax = fmaxf(__uint_as_float(rr[0]), __uint_as_float(rr[1])); }
    constexpr float C2 = 1.4426950408889634f * SCALE;
    if (__builtin_expect(__all((pmax - m_reg) * SCALE <= THR), 1)) { mn = m_reg; alpha = 1.f; }
    else { mn = fmaxf(m_reg, pmax); alpha = __builtin_amdgcn_exp2f((m_reg - mn) * C2); m_reg = mn; }
    const float mnL = -mn * C2;
    for (int r = 0; r < 16; ++r) p0[r] = fmaf(p0[r], C2, mnL); for (int r = 0; r < 16; ++r) p1[r] = fmaf(p1[r], C2, mnL);
    for (int r = 0; r < 16; ++r) p0[r] = __builtin_amdgcn_exp2f(p0[r]);
}
__device__ __forceinline__ void finishSM(f32x16& p0, f32x16& p1, float alpha, float& l_reg, bf16x8& pa0, bf16x8& pa1, bf16x8& pa2, bf16x8& pa3) {
    for (int r = 0; r < 16; ++r) p1[r] = __builtin_amdgcn_exp2f(p1[r]);
    float ps = 0; for (int r = 0; r < 16; ++r) ps += p0[r]; for (int r = 0; r < 16; ++r) ps += p1[r];
    { auto rr = __builtin_amdgcn_permlane32_swap(__float_as_uint(ps), __float_as_uint(ps), false, false);
      ps = __uint_as_float(rr[0]) + __uint_as_float(rr[1]); }
    l_reg = l_reg * alpha + ps;
#define PK4(P, B_, OUT) do { unsigned a0 = cvtpk(P[B_+0], P[B_+1]), a1 = cvtpk(P[B_+2], P[B_+3]);                          \
        unsigned b0 = cvtpk(P[B_+4], P[B_+5]), b1 = cvtpk(P[B_+6], P[B_+7]);                                             \
        auto r0 = __builtin_amdgcn_permlane32_swap(a0, b0, false, false); auto r1 = __builtin_amdgcn_permlane32_swap(a1, b1, false, false); \
        u32x4 w = {r0[0], r1[0], r0[1], r1[1]}; OUT = *reinterpret_cast<bf16x8*>(&w); } while (0)
    PK4(p0, 0, pa0); PK4(p0, 8, pa1); PK4(p1, 0, pa2); PK4(p1, 8, pa3);
#undef PK4
}
template <int KB, bool SK>
__device__ __forceinline__ void qkt(f32x16& p0, f32x16& p1, const char* K_lds, int r32, int hi, const bf16x8* qr, bool act) {
    if (SK && !act) { const float NEG = -__builtin_inff();
#pragma unroll
        for (int r = 0; r < 16; ++r) { p0[r] = NEG; p1[r] = NEG; } return; }
    p0 = f32x16{}; p1 = f32x16{};
    const char* kb[4];
#pragma unroll
    for (int dd = 0; dd < 4; ++dd) kb[dd] = K_lds + KB * SHM_K + KSWZ(r32, (dd * 16 + hi * 8) * 2);
#pragma unroll
    for (int d0 = 0; d0 < 8; ++d0) { const char* a = kb[d0 & 3] + (d0 >> 2) * 128;
        bf16x8 b0 = *reinterpret_cast<const bf16x8*>(a);
        bf16x8 b1 = *reinterpret_cast<const bf16x8*>(a + 32 * 256);
        p0 = __builtin_amdgcn_mfma_f32_32x32x16_bf16(b0, qr[d0], p0, 0, 0, 0);
        p1 = __builtin_amdgcn_mfma_f32_32x32x16_bf16(b1, qr[d0], p1, 0, 0, 0); }
}
template <int VB, bool SK>
__device__ __forceinline__ void pv_tile(f32x16* o, int vb0, bf16x8 pa0, bf16x8 pa1, bf16x8 pa2, bf16x8 pa3, bool act) {
    if (SK && !act) return;
#define TRRD(dst, off) asm volatile("ds_read_b64_tr_b16 %0, %1 offset:%2" : "=&v"(dst) : "v"(vb0), "i"(off) : "memory")
#define PV_D0(d0) do { s16x4 l0, l1, l2, l3, h0, h1, h2, h3; constexpr int b_ = VB * SHM_V + v_rd_off(d0, 0, 0);     \
        TRRD(l0, b_); TRRD(h0, b_ + 2048); TRRD(l1, b_ + 4096); TRRD(h1, b_ + 6144); TRRD(l2, b_ + 8192); TRRD(h2, b_ + 10240); TRRD(l3, b_ + 12288); TRRD(h3, b_ + 14336); \
        asm volatile("s_waitcnt lgkmcnt(0)" ::: "memory"); SBAR();                 \
        o[d0] = __builtin_amdgcn_mfma_f32_32x32x16_bf16(pa0, (bf16x8){l0[0], l0[1], l0[2], l0[3], h0[0], h0[1], h0[2], h0[3]}, o[d0], 0, 0, 0);   \
        o[d0] = __builtin_amdgcn_mfma_f32_32x32x16_bf16(pa1, (bf16x8){l1[0], l1[1], l1[2], l1[3], h1[0], h1[1], h1[2], h1[3]}, o[d0], 0, 0, 0);   \
        o[d0] = __builtin_amdgcn_mfma_f32_32x32x16_bf16(pa2, (bf16x8){l2[0], l2[1], l2[2], l2[3], h2[0], h2[1], h2[2], h2[3]}, o[d0], 0, 0, 0);   \
        o[d0] = __builtin_amdgcn_mfma_f32_32x32x16_bf16(pa3, (bf16x8){l3[0], l3[1], l3[2], l3[3], h3[0], h3[1], h3[2], h3[3]}, o[d0], 0, 0, 0); } while (0)
    PV_D0(0); PV_D0(1); PV_D0(2); PV_D0(3);
#undef PV_D0
#undef TRRD
}

__device__ __forceinline__ bf16x8 load8(const bf16* p) { return *reinterpret_cast<const bf16x8*>(p); }
__device__ __forceinline__ void mask_bits(f32x16& p0, f32x16& p1, u32x2 w, int hi) {
    const float NEG = -__builtin_inff();
    asm volatile("" : "+v"(w.x), "+v"(w.y));
    const unsigned lo = w.x >> (4 * hi), up = w.y >> (4 * hi);
#pragma unroll
    for (int r = 0; r < 16; ++r) { const int c = (r & 3) + 8 * (r >> 2);
        if (!((lo >> c) & 1u)) p0[r] = NEG;
        if (!((up >> c) & 1u)) p1[r] = NEG; }
}
struct BlockRef { const bf16* Q; const bf16* K; const bf16* V; bf16* O; const u32x2* M; int P0; };
struct Seam { bf16x8 qr[8]; bf16x8 st_v0, st_v1, st_k0, st_k1; };
#define ROW(p, k0, rr) ((p) + (size_t)((k0) + (rr)) * D + sc)
#define VMW() asm volatile("s_waitcnt vmcnt(0)" ::: "memory")
#define VMWN(n) asm volatile("s_waitcnt vmcnt(%0)" :: "i"(n) : "memory")
#define SLOAD_H(Kp, Vp, k0) do { S.st_v0 = load8(ROW(Vp, k0, sr)); S.st_v1 = load8(ROW(Vp, k0, 32 + sr));              \
                         S.st_k0 = load8(ROW(Kp, k0, sr)); S.st_k1 = load8(ROW(Kp, k0, 32 + sr)); } while (0)
#define SWRITE_HK(bf) do { *(bf16x8*)(K_lds + (bf) * SHM_K + kws) = S.st_k0; *(bf16x8*)(K_lds + (bf) * SHM_K + kws + 32 * 256) = S.st_k1; } while (0)
#define SWRITE_HV(bf) do { *(bf16x8*)(V_lds + (bf) * SHM_V + vst0) = S.st_v0; *(bf16x8*)(V_lds + (bf) * SHM_V + vst1) = S.st_v1; } while (0)
#define SWRITE_H(bf) do { SWRITE_HV(bf); SWRITE_HK(bf); } while (0)
__device__ __forceinline__ void sel_prime(const BlockRef& cur, char* lds, Seam& S) {
    int tid_ = threadIdx.x; asm volatile("" : "+v"(tid_));
    const int tid = tid_, wid = __builtin_amdgcn_readfirstlane(tid >> 6), lane = tid & 63, r32 = lane & 31, hi = lane >> 5;
    const int sr = tid >> 4, sc = (tid & 15) * 8, kws = KSWZ(sr, sc * 2); char* K_lds = lds + 2 * SHM_V;
    for (int d0 = 0; d0 < 8; ++d0) S.qr[d0] = load8(cur.Q + (size_t)(wid * QBLK + r32) * D + d0 * 16 + hi * 8);
    SLOAD_H(cur.K, cur.V, 0); VMW(); SWRITE_HK(0);
    __syncthreads();
}
__device__ __forceinline__ void sel_block(const BlockRef& cur, const BlockRef& nxt, char* lds, Seam& S) {
    int tid_ = threadIdx.x; asm volatile("" : "+v"(tid_));
    const int tid = tid_, wid = __builtin_amdgcn_readfirstlane(tid >> 6), lane = tid & 63, r32 = lane & 31, hi = lane >> 5;
    const int NT = (cur.P0 + QB) / KVBLK;
    char* V_lds = lds; char* K_lds = lds + 2 * SHM_V;
    float* ws = (float*)(lds + 2 * SHM_V + 2 * SHM_K) + wid * 64; float* li_l = ws, * al_l = ws + 32;
    float m_reg = -1e30f, l_reg = 0; f32x16 o[4] = {};
    const int sr = tid >> 4, sc = (tid & 15) * 8, vst0 = v_st(sr, sc), vst1 = v_st(32 + sr, sc), kws = KSWZ(sr, sc * 2);
    const int vb0 = (int)(uintptr_t)V_lds + v_rd_base(lane);
    const bf16* Kh = cur.K; const bf16* Vh = cur.V;
    const char* Mbase = (const char*)cur.M; const unsigned moff = (unsigned)(wid * QBLK + r32) * 512u;
#define MROW(t) (*(const u32x2*)(Mbase + (moff + (unsigned)(t) * 8u)))
#define RESC(a) do { if (__any((a) < 1.f)) { if (hi == 0) al_l[r32] = (a); asm volatile("s_waitcnt lgkmcnt(0)" ::: "memory");              \
                     for (int d_ = 0; d_ < 4; ++d_) for (int r = 0; r < 16; ++r) o[d_][r] *= al_l[crow(r, hi)]; } } while (0)
#define KBASE(t) ((t) * KVBLK)
    f32x16 pA0, pA1, pB0, pB1; float mnA, mnB, alA, alB; bf16x8 pa0, pa1, pa2, pa3; u32x2 mw;
    SWRITE_HV(0); SBAR();
    if (NT > 1) SLOAD_H(Kh, Vh, KBASE(1));
    mw = MROW(0);
    SBAR(); qkt<0, false>(pA0, pA1, K_lds, r32, hi, S.qr, true);
    mask_bits(pA0, pA1, mw, hi); partialSM(pA0, pA1, m_reg, mnA, alA);
    if (NT > 1) { VMW(); SWRITE_H(1); }
    __syncthreads();
#define HALF_STEP(PX0, PX1, mnX, alX, PY0, PY1, alY, t, KB, VB, SB) do {                                                      \
        SBAR(); mw = MROW(t); qkt<KB, false>(PX0, PX1, K_lds, r32, hi, S.qr, true);                                          \
        finishSM(PY0, PY1, alY, l_reg, pa0, pa1, pa2, pa3); SBAR();                                                           \
        if ((t) + 1 < NT) { SLOAD_H(Kh, Vh, KBASE((t) + 1)); SBAR(); }                                                        \
        pv_tile<VB, false>(o, vb0, pa0, pa1, pa2, pa3, true); mask_bits(PX0, PX1, mw, hi); partialSM(PX0, PX1, m_reg, mnX, alX); \
        __syncthreads();                                                                                                      \
        if ((t) + 1 < NT) { VMW(); SWRITE_H(SB); }                                                                            \
        RESC(alX); __syncthreads(); } while (0)
    for (int t = 1; t + 1 < NT; t += 2) {
        HALF_STEP(pB0, pB1, mnB, alB, pA0, pA1, alA, t, 1, 0, 0);
        HALF_STEP(pA0, pA1, mnA, alA, pB0, pB1, alB, t + 1, 0, 1, 1);
    }
    const bool even = (NT & 1) == 0;
    if (even) { SBAR(); mw = MROW(NT - 1); qkt<1, false>(pB0, pB1, K_lds, r32, hi, S.qr, true); SBAR(); }
    SLOAD_H(nxt.K, nxt.V, 0); SBAR();
#pragma unroll
    for (int d0 = 0; d0 < 8; ++d0) S.qr[d0] = load8(nxt.Q + (size_t)(wid * QBLK + r32) * D + d0 * 16 + hi * 8);
    SBAR();
    finishSM(pA0, pA1, alA, l_reg, pa0, pa1, pa2, pa3); SBAR();
    pv_tile<0, false>(o, vb0, pa0, pa1, pa2, pa3, true);
    if (even) { mask_bits(pB0, pB1, mw, hi); partialSM(pB0, pB1, m_reg, mnB, alB); __syncthreads(); RESC(alB);
        finishSM(pB0, pB1, alB, l_reg, pa0, pa1, pa2, pa3); SBAR(); pv_tile<1, false>(o, vb0, pa0, pa1, pa2, pa3, true); }
    SBAR(); VMWN(8); SWRITE_HK(0); SBAR();
    if (hi == 0) li_l[r32] = l_reg; asm volatile("s_waitcnt lgkmcnt(0)" ::: "memory");
    float rli[16];
#pragma unroll
    for (int r = 0; r < 16; ++r) rli[r] = __builtin_amdgcn_rcpf(li_l[crow(r, hi)]);
    bf16* Ow = cur.O + (size_t)(wid * QBLK) * OS;
#pragma unroll
    for (int r = 0; r < 16; ++r) { const int orow = crow(r, hi);
#pragma unroll
        for (int d0 = 0; d0 < 4; ++d0) { const float v = o[d0][r] * rli[r];
            const float vn = __shfl_xor(v, 1);
            if ((r32 & 1) == 0) *(unsigned*)(Ow + (size_t)orow * OS + d0 * 32 + r32) = cvtpk(v, vn); } }
    __syncthreads();
#undef RESC
#undef KBASE
#undef HALF_STEP
#undef MROW
}
#undef ROW
#undef VMW
#undef VMWN
#undef SLOAD_H
#undef SWRITE_HK
#undef SWRITE_HV
#undef SWRITE_H
#undef KSWZ
#undef SBAR
}


__device__ __forceinline__ attn::BlockRef attn_ref(ARGREF a, int b, int h, int qb) {
    attn::BlockRef r; const int kvh = h / 3;
    r.Q = (const attn::bf16*)(a.ws + WS_QB) + ((size_t)(b * 6 + h) * SEQ + (size_t)qb * 256) * 128;
    r.K = (const attn::bf16*)(a.ws + WS_KB) + (size_t)(b * 2 + kvh) * SEQ * 128;
    r.V = (const attn::bf16*)(a.ws + WS_VB) + (size_t)(b * 2 + kvh) * SEQ * 128;
    r.O = (attn::bf16*)(a.ws + WS_MIX) + (size_t)(b * SEQ + qb * 256) * DM + h * 128;
    r.M = (const attn::u32x2*)(a.ws + WS_MASK) + (size_t)(b * SEQ + qb * 256) * 64;
    r.P0 = qb * 256; return r;
}
__device__ __forceinline__ void p11_attention(Ctx& c, ARGREF a) {
    constexpr int NITEM = 240;
#pragma unroll 1
    for (int it = c.vcu; it < NITEM; it += c.G) {
        const int bh = it / 10, slot = it % 10, b = bh / 6, h = bh % 6;
        const int q0 = slot < 3 ? 15 - slot : (slot == 9 ? 6 : slot - 3), q1 = slot < 3 ? q0 : (slot == 9 ? 6 : 15 - slot);
        attn::Seam S;
        attn::BlockRef cur = attn_ref(a, b, h, q0), nxt = attn_ref(a, b, h, q1);
        __syncthreads();
        attn::sel_prime(cur, (char*)c.lds, S);
        if (q0 != q1) attn::sel_block(cur, nxt, (char*)c.lds, S);
        attn::sel_block(nxt, nxt, (char*)c.lds, S);
    }
    if (c.G == 256) {
        if (c.vcu >= NITEM) { for (int j = 0; j < 4; ++j) { const int u = (c.vcu - NITEM) * 4 + j; attn_sample_unit(c, a, u >> 2, u & 3); } }
        else if (c.vcu % 10 == 9) { for (int j = 0; j < 3; ++j) { const int u = 64 + (c.vcu / 10) * 3 + j; if (u < MS) attn_sample_unit(c, a, u >> 2, u & 3); } }
    } else for (int u = c.vcu; u < MS; u += c.G) attn_sample_unit(c, a, u >> 2, u & 3);
}

enum { PH_PRO = 0, PH_IN0, PH_MIX0, PH_HSCAN, PH_HFIX, PH_OUT0, PH_GU0, PH_DOWN0, PH_IN1, PH_POST, PH_IDX, PH_TOPK, PH_ATTN, PH_OUT1, PH_GU1, PH_DOWN1, NPHASE };
#ifndef ONLYPH
#define ONLYPH -1
#endif
#define PHON(x) (ONLYPH < 0 || ONLYPH == (x))
#ifndef REP_PH
#define REP_PH -1
#endif
#ifndef REP_N
#define REP_N 1
#endif
__global__ void __launch_bounds__(NWAVES * 64, 2) fwd_kernel(Args args) {
    extern __shared__ __attribute__((aligned(16))) unsigned char lds[];
    Ctx c;
    c.lds = (LAS unsigned char*)lds;
    c.MISC = (volatile LAS unsigned*)(c.lds + MISC_OFF);
    c.tid = threadIdx.x; c.lane = c.tid & 63; c.wave = __builtin_amdgcn_readfirstlane(c.tid >> 6);
    c.G = gridDim.x; { const int bx = blockIdx.x; c.vcu = (c.G % 8 == 0) ? (bx % 8) * (c.G / 8) + bx / 8 : bx; }
    c.ctl = (gu32*)(args.ws + WS_CTL);
    for (int u = c.tid; u < (LDS_BYTES - LDSCTL_OFF) / 4; u += NWAVES * 64) ((LAS unsigned*)(c.lds + LDSCTL_OFF))[u] = 0u;
    __syncthreads();
    const int lo = args.ph_lo, hi = args.ph_hi;
    XcdBarrier bar; bar.bar = (unsigned*)(c.ctl + CW_BAR); bar.x = 0; bar.st = nullptr;
    if (hi - lo > 1 || REP_N > 1) bar = xcd_barrier_post((unsigned*)(c.ctl + CW_BAR), c.MISC + 8);
    c.qoff = 0;
#pragma unroll 1
    for (int ph = lo; ph < hi; ++ph) {
        const int layer = ph >= PH_IN1 ? 1 : 0;
        const __attribute__((address_space(4))) Args* ap = (const __attribute__((address_space(4))) Args*)__builtin_amdgcn_kernarg_segment_ptr(); asm volatile("" : "+s"(ap));
        ARGREF la = *ap; unsigned char* const ws = la.ws; float* const out = la.out;
        { int t_ = threadIdx.x; asm volatile("" : "+v"(t_)); c.tid = t_; c.lane = t_ & 63; c.wave = __builtin_amdgcn_readfirstlane(t_ >> 6); }
        if ((ph == PH_DOWN0 || ph == PH_DOWN1) && PHON(PH_OUT0)) {
            pg8::SchedX S0; S0.init(MP, 1024, c.G, (int)blockIdx.x, 0, 0, 1, 0); pg8::Unit u0; if (S0.next(0, u0)) conv_fixup_tile(c, la, layer, u0.pm); VM_WAIT(); __syncthreads(); }
        if (ph == PH_PRO && PHON(PH_PRO)) p0_prologue(c, la);
        else if ((ph == PH_IN0 || ph == PH_IN1) && PHON(PH_IN0)) {
            pg8::Gemm g{(const pg8::bf16_t*)(ws + WS_XB), (const pg8::bf16_t*)(ws + (ph == PH_IN0 ? WS_WIN0 : WS_WIN1)), MT, 0, 1024};
            pg8::SchedX S; if (ph == PH_IN0) S.init(MP, ZC0, c.G, (int)blockIdx.x, 16, MT / 256, 4, 13); else S.init(MP, ZC1, c.G, (int)blockIdx.x, 0, 0, 1, 0, true);
            pg8::EpiZ E{(pg8::bf16_t*)(ws + WS_Z), ph == PH_IN0 ? ZC0 : ZC1, ssptr(c, ph == PH_IN0 ? 0 : 2), ph == PH_IN0 ? 13 : 9, (float*)(ws + WS_MEMKV), MEMROW0};
            pg8::gemm_phase<pg8::EpiZ, pg8::SchedX, PG8_ALIGN, PG8_SP2, true>(c.lds + RING_OFF, g, S, E);
            { SgArgs sg{}; sg.A = (const bf16*)(ws + WS_XB) + (size_t)MP * DM; sg.Bt = (const bf16*)(ws + (ph == PH_IN0 ? WS_WIN0 : WS_WIN1)); sg.K = 1024; sg.mode = 0; sg.Z = (bf16*)(ws + WS_Z); sg.ldz = ph == PH_IN0 ? ZC0 : ZC1; sg.ssin = ssptr(c, ph == PH_IN0 ? 0 : 2);
              { const int nu = ph == PH_IN0 ? 64 * 13 + 16 : 64 * 9, rem = nu % c.G, busy = S.split ? 2 * rem : rem; sgemm_phase(c, sg, ph == PH_IN0 ? ZC0 : ZC1, busy && busy < c.G ? c.G - busy : c.G); } }
            __syncthreads();
            if (ph == PH_IN0) convert_tail(c, la, (64 * 13 + 16) % c.G, W_PRO, W_T1, ZC0 / 32);
            else if (S.split) convert_tail(c, la, 2 * S.rem, W_T1, W_NITEMS);
            else convert_tail(c, la, 0, W_T1, W_NITEMS);
        }
        else if (ph == PH_MIX0 && PHON(PH_MIX0)) p2_mixer0(c, la);
        else if (ph == PH_HSCAN && PHON(PH_HSCAN)) hgrn_scan(c, la);
        else if (ph == PH_HFIX && PHON(PH_HFIX)) p2c_hgrn_fix(c, la);
        else if ((ph == PH_OUT0 || ph == PH_DOWN0 || ph == PH_OUT1 || ph == PH_DOWN1) && PHON(PH_OUT0)) {
            const bool isout = (ph == PH_OUT0 || ph == PH_OUT1);
            pg8::Gemm g{(const pg8::bf16_t*)(ws + (isout ? WS_MIX : WS_ACT)), (const pg8::bf16_t*)(ws + (isout ? WS_WOUT + (size_t)layer * 1024 * 1024 * 2 : WS_WD + (size_t)layer * 1024 * DFF * 2)), MT, 1024, isout ? 1024 : DFF};
            pg8::SchedX S; S.init(MP, 1024, c.G, (int)blockIdx.x, 0, 0, 1, 0);
            pg8::EpiResid E;
            E.rp = ph == PH_OUT0 ? la.in[0] : nullptr; E.rb = (const pg8::bf16_t*)(ws + WS_XB); E.y = ph == PH_DOWN1 ? out + O_YP : nullptr;
            E.xb = ph == PH_DOWN1 ? nullptr : (pg8::bf16_t*)(ws + WS_XB); E.ssout = ph == PH_DOWN1 ? nullptr : ssptr(c, ph == PH_OUT0 ? 1 : (ph == PH_DOWN0 ? 2 : 3));
            pg8::gemm_phase<pg8::EpiResid, pg8::SchedX, PG8_ALIGN, PG8_SP2>(c.lds + RING_OFF, g, S, E);
            { SgArgs sg{}; sg.A = (const bf16*)(ws + (isout ? WS_MIX : WS_ACT)) + (size_t)MP * (isout ? 1024 : DFF); sg.Bt = (const bf16*)g.Bt; sg.K = isout ? 1024 : DFF; sg.mode = 1; sg.rb = (const bf16*)(ws + WS_XB); sg.resid = ph == PH_OUT0 ? la.in[1] : nullptr; sg.y = ph == PH_DOWN1 ? out + O_YS : nullptr; sg.xb = (bf16*)E.xb; sg.ssout = E.ssout;
              { const int rem = (64 * 4) % c.G; sgemm_phase(c, sg, 1024, rem ? c.G - rem : c.G); } }
        }
        else if ((ph == PH_GU0 || ph == PH_GU1) && PHON(PH_GU0)) {
            pg8::Gemm g{(const pg8::bf16_t*)(ws + WS_XB), (const pg8::bf16_t*)(ws + WS_WGU + (size_t)layer * 5632 * 1024 * 2), MT, 5632, 1024};
            pg8::SchedX S; S.init(MP, 5632, c.G, (int)blockIdx.x, 0, 0, 1, 0);
            pg8::EpiGU E{(pg8::bf16_t*)(ws + WS_ACT), ssptr(c, layer ? 3 : 1), out + O_CVP + (size_t)layer * 4 * 2 * DFF, la.in[26] + (size_t)layer * 3 * DFF, la.in[27] + (size_t)layer * DFF, (float*)(ws + WS_G4), (float*)(ws + WS_UP2)};
            pg8::gemm_phase<pg8::EpiGU, pg8::SchedX, PG8_ALIGN, PG8_SP2>(c.lds + RING_OFF, g, S, E);
            { SgArgs sg{}; sg.A = (const bf16*)(ws + WS_XB) + (size_t)MP * DM; sg.Bt = (const bf16*)g.Bt; sg.K = 1024; sg.mode = 2; sg.ssin = E.ss; sg.ACT = (bf16*)E.ACT; sg.cvs = out + O_CVS + (size_t)layer * 32 * 2 * DFF; sg.cst = la.in[8] + (size_t)layer * 32 * 2 * DFF; sg.cw = E.cw; sg.cb = E.cb;
              { const int rem = (64 * 22) % c.G; sgemm_phase(c, sg, 5632, rem ? c.G - rem : c.G);
 } }
        }
        else if (ph == PH_POST && PHON(PH_POST)) p8_dsa_post(c, la);
        else if (ph == PH_IDX && PHON(PH_IDX)) p9_indexer(c, la);
        else if (ph == PH_TOPK && PHON(PH_TOPK)) p10_topk(c, la);
        else if (ph == PH_ATTN && PHON(PH_ATTN)) p11_attention(c, la);
        if (REP_N > 1 && ph == REP_PH && c.qoff < 4 * (REP_N - 1)) { c.qoff += 4; --ph; xcd_barrier(bar); continue; }
        if (REP_N > 1) c.qoff = 0;
        if (ph + 1 < hi) xcd_barrier(bar);
    }
}

#ifndef MK_ONE_LAUNCH
#define MK_ONE_LAUNCH 1
#endif
extern "C" void kernel_launch(void* const* d_in, const int* in_sizes, int n_in, void* d_out, int out_size, void* d_ws, size_t ws_size, hipStream_t stream) {
    static int grid = 0;
    if (grid == 0) {
        if (n_in != 29 || out_size != (int)O_END || ws_size < WS_END) { fprintf(stderr, "kernel_launch: unexpected problem (n_in %d, out %d, ws %zu)\n", n_in, out_size, ws_size); grid = -1; return; }
        int dev = 0, cus = 0;
        if (hipGetDevice(&dev) != hipSuccess || hipDeviceGetAttribute(&cus, hipDeviceAttributeMultiprocessorCount, dev) != hipSuccess) { grid = -1; return; }
        if (hipFuncSetAttribute((const void*)fwd_kernel, hipFuncAttributeMaxDynamicSharedMemorySize, LDS_BYTES) != hipSuccess) { fprintf(stderr, "kernel_launch: hipFuncSetAttribute failed\n"); grid = -1; return; }
        (void)hipGetLastError();
        grid = cus;
    }
    if (grid < 0) return;
    if (hipMemsetAsync((char*)d_ws + WS_CTL, 0, CTL_ZERO_BYTES, stream) != hipSuccess) { fprintf(stderr, "kernel_launch: memset failed\n"); return; }
    Args a{};
    for (int i = 0; i < 29; ++i) a.in[i] = (const float*)d_in[i];
    a.page_table = (const int*)d_in[9]; a.out = (float*)d_out; a.ws = (unsigned char*)d_ws;
#if MK_ONE_LAUNCH
    a.ph_lo = 0; a.ph_hi = NPHASE;
    hipLaunchKernelGGL(fwd_kernel, dim3(grid), dim3(NWAVES * 64), LDS_BYTES, stream, a);
#else
    for (int ph = 0; ph < NPHASE; ++ph) { a.ph_lo = ph; a.ph_hi = ph + 1; hipLaunchKernelGGL(fwd_kernel, dim3(grid), dim3(NWAVES * 64), LDS_BYTES, stream, a); }
#endif
}
```

```cpp
#include <hip/hip_runtime.h>
#include <cstdio>
#include <cstdint>


namespace pg8 {
#define PG8_LAS __attribute__((address_space(3)))
typedef unsigned short bf16_t;
typedef short bf16x8 __attribute__((ext_vector_type(8)));
typedef float f32x4 __attribute__((ext_vector_type(4)));
typedef unsigned u32x4 __attribute__((ext_vector_type(4)));
constexpr int BM = 256, BK = 64, HALF = 128, HTB = HALF * BK * 2  , STAGE_BYTES = 8 * HTB, NXCD = 8, WGM = 4;

__host__ __device__ __forceinline__ int lds_byte(int r, int c) { const int st = (r >> 4) * 2 + (c >> 5), rr = r & 15, cc = c & 31, ob = rr * 64 + cc * 2; return st * 1024 + (ob ^ (((ob >> 9) & 1) << 5)); }
__host__ __device__ __forceinline__ void stage_rc(int b, int& R, int& C) { const int st = b / 1024, sb = b % 1024, swz = sb ^ (((sb >> 9) & 1) << 5); R = (st >> 1) * 16 + swz / 64; C = (st & 1) * 32 + (swz % 64) / 2; }
__host__ __device__ __forceinline__ int perm32(int rho) { const int n = rho >> 4, i = rho & 15; return 8 * (i >> 2) + 4 * n + (i & 3); }

struct Unit { int pm, pn, roff, nai; };
struct Gemm { const bf16_t* A; const bf16_t* Bt; int M, N, K; };

struct StaticOrder {
    int nM, nN, nwg, G, c;
    __host__ __device__ __forceinline__ void init(int M, int N, int G_, int c_) { nM = M / BM; nN = N / BM; nwg = nM * nN; G = G_; c = c_; }
    __host__ __device__ __forceinline__ bool next(int i, Unit& u) const { const long L = (long)i * G + c; if (L >= nwg) return false; map(L, u); return true; }
    __host__ __device__ __forceinline__ void map(long L, Unit& u) const {
        u.roff = 0; u.nai = 2;
        int wgid = (int)L; { const int q = nwg / NXCD, r = nwg % NXCD, xcd = wgid % NXCD, off = wgid / NXCD; wgid = (xcd < r ? xcd * (q + 1) : r * (q + 1) + (xcd - r) * q) + off; }
        const int nig = WGM * nN, gid = wgid / nig, fm = gid * WGM, gsz = (nM - fm) < WGM ? (nM - fm) : WGM;
        u.pm = fm + ((wgid % nig) % gsz); u.pn = (wgid % nig) / gsz;
    }
    __device__ __forceinline__ void a_ready(const Unit&) const {}
    __device__ __forceinline__ void done(const Unit&) const {}
};


constexpr int MP = 16384, MS = 128, MVALID = MP + MS, MT = 16640, DM = 1024, DFF = 2816;
constexpr float RMS_EPS = 1e-6f;
__device__ __forceinline__ unsigned cvt_pk_bf16(float lo, float hi) { unsigned r; asm volatile("v_cvt_pk_bf16_f32 %0, %1, %2" : "=v"(r) : "v"(lo), "v"(hi)); return r; }

struct SchedX {
    StaticOrder so; int nextra, e_pm0, e_nm, e_pn0, rs, rem; bool split;
    __device__ __forceinline__ void init(int M, int N, int G_, int c_, int nextra_, int e_pm0_, int e_nm_, int e_pn0_, bool split_last = false) {
        so.init(M, N, G_, c_); nextra = nextra_; e_pm0 = e_pm0_; e_nm = e_nm_; e_pn0 = e_pn0_; rs = so.nwg / G_; rem = so.nwg % G_; split = split_last && nextra_ == 0 && rem > 0 && 2 * rem <= G_;
    }
    __device__ __forceinline__ bool next(int i, Unit& u) const {
        if (split && i >= rs) {
            if (i > rs || so.c >= 2 * rem) return false;
            const int hf = so.c / rem; so.map((long)rs * so.G + (so.c - hf * rem), u); u.roff = hf * HALF; u.nai = 1; return true;
        }
        const long L = (long)i * so.G + so.c;
        if (L < so.nwg) { so.map(L, u); return true; }
        const int e = (int)(L - so.nwg); if (e >= nextra) return false;
        u.roff = 0; u.nai = 2; u.pm = e_pm0 + e % e_nm; u.pn = e_pn0 + e / e_nm; return true;
    }
    __device__ __forceinline__ void a_ready(const Unit&) const {}
    __device__ __forceinline__ void done(const Unit&) const {}
};

struct EpiZ {
    static constexpr bool PERM = true, AFTER_DRAIN = false;
    bf16_t* Z; int ldz; const float* ss; int nmain; float* memkv; int memrow0;
    __device__ __forceinline__ void operator()(const f32x4 (&acc)[2][2][4][2], const Unit& u, int wr, int wc, int fr, int fq) const {
        const int row0 = u.pm * BM + u.roff + wr * 64 + fr;
        if (u.pn < nmain) {
            const int col0 = u.pn * BM + wc * 32 + 8 * fq;
#pragma unroll
            for (int ai = 0; ai < 2; ++ai) if (ai < u.nai)
#pragma unroll
                for (int m = 0; m < 4; ++m) { const int row = row0 + ai * HALF + m * 16; const float rs = rsqrtf(ss[row] * (1.0f / DM) + RMS_EPS);
#pragma unroll
                    for (int bj = 0; bj < 2; ++bj) { const f32x4 v0 = acc[ai][bj][m][0] * rs, v1 = acc[ai][bj][m][1] * rs;
                        u32x4 w; w.x = cvt_pk_bf16(v0[0], v0[1]); w.y = cvt_pk_bf16(v0[2], v0[3]); w.z = cvt_pk_bf16(v1[0], v1[1]); w.w = cvt_pk_bf16(v1[2], v1[3]);
                        *(u32x4*)(Z + (size_t)row * ldz + col0 + bj * HALF) = w; } }
        } else {
            const int col0 = (u.pn - nmain) * BM + wc * 32 + 8 * fq;
#pragma unroll
            for (int ai = 0; ai < 2; ++ai)
#pragma unroll
                for (int m = 0; m < 4; ++m) { const int row = row0 + ai * HALF + m * 16 - memrow0;
#pragma unroll
                    for (int bj = 0; bj < 2; ++bj) { float* p = memkv + (size_t)row * 1024 + col0 + bj * HALF; *(f32x4*)p = acc[ai][bj][m][0]; *(f32x4*)(p + 4) = acc[ai][bj][m][1]; } }
        }
    }
};

struct EpiResid {
    static constexpr bool PERM = true, AFTER_DRAIN = false;
    const float* rp; const bf16_t* rb; float* y; bf16_t* xb; float* ssout;
    __device__ __forceinline__ void operator()(const f32x4 (&acc)[2][2][4][2], const Unit& u, int wr, int wc, int fr, int fq) const {
        const int row0 = u.pm * BM + wr * 64 + fr, col0 = u.pn * BM + wc * 32 + 8 * fq;
#pragma unroll
        for (int ai = 0; ai < 2; ++ai)
#pragma unroll
            for (int m = 0; m < 4; ++m) { const int row = row0 + ai * HALF + m * 16; float part = 0.f;
#pragma unroll
                for (int bj = 0; bj < 2; ++bj) { const int c = col0 + bj * HALF; f32x4 r0, r1;
                    if (rp) { r0 = *(const f32x4*)(rp + (size_t)row * DM + c); r1 = *(const f32x4*)(rp + (size_t)row * DM + c + 4); }
                    else { const u32x4 q = *(const u32x4*)(rb + (size_t)row * DM + c);
                        r0 = (f32x4){__builtin_bit_cast(float, q.x << 16), __builtin_bit_cast(float, q.x & 0xffff0000u), __builtin_bit_cast(float, q.y << 16), __builtin_bit_cast(float, q.y & 0xffff0000u)};
                        r1 = (f32x4){__builtin_bit_cast(float, q.z << 16), __builtin_bit_cast(float, q.z & 0xffff0000u), __builtin_bit_cast(float, q.w << 16), __builtin_bit_cast(float, q.w & 0xffff0000u)}; }
                    const f32x4 v0 = acc[ai][bj][m][0] + r0, v1 = acc[ai][bj][m][1] + r1;
                    if (y) { *(f32x4*)(y + (size_t)row * DM + c) = v0; *(f32x4*)(y + (size_t)row * DM + c + 4) = v1; }
                    part += (v0[0] * v0[0] + v0[1] * v0[1]) + (v0[2] * v0[2] + v0[3] * v0[3]) + (v1[0] * v1[0] + v1[1] * v1[1]) + (v1[2] * v1[2] + v1[3] * v1[3]);
                    if (xb) { u32x4 w; w.x = cvt_pk_bf16(v0[0], v0[1]); w.y = cvt_pk_bf16(v0[2], v0[3]); w.z = cvt_pk_bf16(v1[0], v1[1]); w.w = cvt_pk_bf16(v1[2], v1[3]);
                        *(u32x4*)(xb + (size_t)row * DM + c) = w; } }
                part += __shfl_xor(part, 16); part += __shfl_xor(part, 32);
                if (ssout && fq == 0) atomicAdd(ssout + row, part); }
    }
};

__device__ __forceinline__ void dpp_ror12(const f32x4& v, f32x4& r1, f32x4& r2) {
    float a0, a1, a2, a3, b0, b1, b2, b3;
    asm volatile("s_nop 1\n\t"
                 "v_mov_b32_dpp %0, %8 row_ror:1 row_mask:0xf bank_mask:0xf\n\tv_mov_b32_dpp %1, %9 row_ror:1 row_mask:0xf bank_mask:0xf\n\t"
                 "v_mov_b32_dpp %2, %10 row_ror:1 row_mask:0xf bank_mask:0xf\n\tv_mov_b32_dpp %3, %11 row_ror:1 row_mask:0xf bank_mask:0xf\n\t"
                 "v_mov_b32_dpp %4, %8 row_ror:2 row_mask:0xf bank_mask:0xf\n\tv_mov_b32_dpp %5, %9 row_ror:2 row_mask:0xf bank_mask:0xf\n\t"
                 "v_mov_b32_dpp %6, %10 row_ror:2 row_mask:0xf bank_mask:0xf\n\tv_mov_b32_dpp %7, %11 row_ror:2 row_mask:0xf bank_mask:0xf"
                 : "=&v"(a0), "=&v"(a1), "=&v"(a2), "=&v"(a3), "=&v"(b0), "=&v"(b1), "=&v"(b2), "=&v"(b3) : "v"(v[0]), "v"(v[1]), "v"(v[2]), "v"(v[3]));
    r1 = (f32x4){a0, a1, a2, a3}; r2 = (f32x4){b0, b1, b2, b3};
}
struct EpiGU {
    static constexpr bool PERM = true, AFTER_DRAIN = false;
    bf16_t* ACT; const float* ss; float* cvp; const float* cw; const float* cb; float* G4; float* UP2;
    __device__ __forceinline__ void operator()(const f32x4 (&acc)[2][2][4][2], const Unit& u, int wr, int wc, int fr, int fq) const {
        const int row0 = u.pm * BM + u.roff + wr * 64 + fr, colg = u.pn * HALF + wc * 32 + 8 * fq;
        f32x4 w0[2], w1[2], w2[2], bb[2];
#pragma unroll
        for (int n = 0; n < 2; ++n) { const int col = colg + 4 * n; w0[n] = *(const f32x4*)(cw + col); w1[n] = *(const f32x4*)(cw + DFF + col); w2[n] = *(const f32x4*)(cw + 2 * DFF + col); bb[n] = *(const f32x4*)(cb + col); }
#pragma unroll
        for (int ai = 0; ai < 2; ++ai) if (ai < u.nai) { f32x4 r1p[2] = {{0.f, 0.f, 0.f, 0.f}, {0.f, 0.f, 0.f, 0.f}}, r2p[2] = {{0.f, 0.f, 0.f, 0.f}, {0.f, 0.f, 0.f, 0.f}}; const int slab = (u.pm * BM + u.roff + ai * HALF + wr * 64) >> 6;
#pragma unroll
            for (int m = 0; m < 4; ++m) { const int row = row0 + ai * HALF + m * 16; const float rs = rsqrtf(ss[row] * (1.0f / DM) + RMS_EPS);
                f32x4 y[2], g[2], up[2];
#pragma unroll
                for (int n = 0; n < 2; ++n) { g[n] = acc[ai][0][m][n] * rs; up[n] = acc[ai][1][m][n] * rs;
                    f32x4 r1, r2; dpp_ror12(g[n], r1, r2);
                    const f32x4 p1 = fr >= 1 ? r1 : r1p[n], p2 = fr >= 2 ? r2 : r2p[n];
                    const f32x4 cv = bb[n] + w0[n] * p2 + w1[n] * p1 + w2[n] * g[n];
#pragma unroll
                    for (int i = 0; i < 4; ++i) y[n][i] = cv[i] * __builtin_amdgcn_rcpf(1.0f + __expf(-cv[i])) * up[n][i];
                    r1p[n] = r1; r2p[n] = r2; }
                if (m == 0 && fr < 2) {
#pragma unroll
                    for (int n = 0; n < 2; ++n) { *(f32x4*)(G4 + (size_t)(slab * 4 + fr) * DFF + colg + 4 * n) = g[n]; *(f32x4*)(UP2 + (size_t)(slab * 2 + fr) * DFF + colg + 4 * n) = up[n]; } }
                else { u32x4 w; w.x = cvt_pk_bf16(y[0][0], y[0][1]); w.y = cvt_pk_bf16(y[0][2], y[0][3]); w.z = cvt_pk_bf16(y[1][0], y[1][1]); w.w = cvt_pk_bf16(y[1][2], y[1][3]); *(u32x4*)(ACT + (size_t)row * DFF + colg) = w; }
                if (m == 3 && fr >= 14) {
#pragma unroll
                    for (int n = 0; n < 2; ++n) { *(f32x4*)(G4 + (size_t)(slab * 4 + 2 + (fr - 14)) * DFF + colg + 4 * n) = g[n];
                        const int t = row & 4095; if (t >= 4094) *(f32x4*)(cvp + (size_t)((row >> 12) * 2 + (t - 4094)) * DFF + colg + 4 * n) = g[n]; } } } }
    }
};

template <class Epi, class Sched, bool ALIGN_EPI = false, bool SP2 = false, bool HALFOK = false>
__device__ __forceinline__ void gemm_phase(PG8_LAS unsigned char* lds, const Gemm g, const Sched& S, const Epi& E) {
    int tid_ = threadIdx.x; asm volatile("" : "+v"(tid_));
    const int tid = tid_, wid = __builtin_amdgcn_readfirstlane(tid >> 6), lane = tid & 63, wr = wid >> 2, wc = wid & 3, fr = lane & 15, fq = lane >> 4;
    const int K = g.K, nt = K / BK;
    unsigned voffA[2], voffB[2];
#pragma unroll
    for (int i = 0; i < 2; ++i) { int R, C; stage_rc(tid * 16 + i * 8192, R, C); const int Rb = Epi::PERM ? ((R & ~31) + perm32(R & 31)) : R;
        voffA[i] = (unsigned)(R * K + C) * 2u; voffB[i] = (unsigned)(Rb * K + C) * 2u; }
    const size_t kstep = (size_t)(BK * 2);
    const size_t hstep = (size_t)HALF * K * 2;
    const size_t tstep = 2 * hstep;
    const unsigned ldsw = (unsigned)wid * 1024u;
    const int aoff = lds_byte(wr * 64 + fr, fq * 8), boff = lds_byte(wc * 32 + fr, fq * 8);
#define PG8_SA(b, h) (((b) * 2 + (h)) * HTB)
#define PG8_SB(b, h) ((4 + (b) * 2 + (h)) * HTB)
#define PG8_STAGE(bufoff, gbase, voff) do { _Pragma("unroll") for (int _i = 0; _i < 2; ++_i) \
        __builtin_amdgcn_global_load_lds((const unsigned*)((const char*)(gbase) + (voff)[_i]), (PG8_LAS unsigned*)(lds + (bufoff) + ldsw + _i * 8192), 16, 0, 0); } while (0)
#define PG8_LDA(dst, b, h) do { _Pragma("unroll") for (int m = 0; m < 4; ++m) _Pragma("unroll") for (int k = 0; k < 2; ++k) dst[m][k] = *(const PG8_LAS bf16x8*)(lds + PG8_SA(b, h) + aoff + m * 2048 + k * 1024); } while (0)
#define PG8_LDB(dst, b, h) do { _Pragma("unroll") for (int n = 0; n < 2; ++n) _Pragma("unroll") for (int k = 0; k < 2; ++k) dst[n][k] = *(const PG8_LAS bf16x8*)(lds + PG8_SB(b, h) + boff + n * 2048 + k * 1024); } while (0)
#define PG8_MMA(ai, bj, At, Bt) do { __builtin_amdgcn_s_setprio(1); _Pragma("unroll") for (int m = 0; m < 4; ++m) _Pragma("unroll") for (int n = 0; n < 2; ++n) _Pragma("unroll") for (int k = 0; k < 2; ++k) \
        acc[ai][bj][m][n] = __builtin_amdgcn_mfma_f32_16x16x32_bf16(Bt[n][k], At[m][k], acc[ai][bj][m][n], 0, 0, 0); __builtin_amdgcn_s_setprio(0); } while (0)
#define PG8_WAIT_V(n) asm volatile("s_waitcnt vmcnt(" #n ")" ::: "memory")
#define PG8_WAIT_L(n) asm volatile("s_waitcnt lgkmcnt(" #n ")" ::: "memory")
#define PG8_BAR __builtin_amdgcn_s_barrier()
#define PG8_SCHED __builtin_amdgcn_sched_barrier(0)
    Unit cur, nxt; int ui = 0;
    if (!S.next(0, cur)) return;
    f32x4 acc[2][2][4][2];
#pragma unroll
    for (int a = 0; a < 2; ++a)
#pragma unroll
        for (int b = 0; b < 2; ++b)
#pragma unroll
            for (int m = 0; m < 4; ++m)
#pragma unroll
                for (int n = 0; n < 2; ++n) acc[a][b][m][n] = (f32x4){0.f, 0.f, 0.f, 0.f};
    bf16x8 At[4][2], B0[2][2], B1[2][2];
    const char* cA = (const char*)g.A + (size_t)cur.pm * tstep + (size_t)cur.roff * K * 2; const char* cB = (const char*)g.Bt + (size_t)cur.pn * tstep;
    S.a_ready(cur);
    if constexpr (SP2) {
        PG8_STAGE(PG8_SB(0, 0), cB, voffB); PG8_STAGE(PG8_SB(0, 1), cB + hstep, voffB); PG8_STAGE(PG8_SA(0, 0), cA, voffA); PG8_STAGE(PG8_SA(0, 1), cA + hstep, voffA);
        if (wr == 1) PG8_BAR;
        PG8_WAIT_V(2); PG8_BAR;
        PG8_STAGE(PG8_SB(1, 0), cB + kstep, voffB); PG8_STAGE(PG8_SA(1, 0), cA + kstep, voffA); PG8_STAGE(PG8_SB(1, 1), cB + hstep + kstep, voffB);
        PG8_WAIT_V(6); PG8_BAR;
    } else {
        PG8_STAGE(PG8_SB(0, 0), cB, voffB); PG8_STAGE(PG8_SA(0, 0), cA, voffA); PG8_STAGE(PG8_SB(0, 1), cB + hstep, voffB); PG8_STAGE(PG8_SA(0, 1), cA + hstep, voffA);
        if (wr == 1) PG8_BAR;
        PG8_WAIT_V(4); PG8_BAR;
        PG8_STAGE(PG8_SB(1, 0), cB + kstep, voffB); PG8_STAGE(PG8_SA(1, 0), cA + kstep, voffA); PG8_STAGE(PG8_SB(1, 1), cB + hstep + kstep, voffB);
        PG8_WAIT_V(6); PG8_BAR;
    }
    for (;;) {
        const bool has_next = S.next(ui + 1, nxt);
        const char* nA = has_next ? (const char*)g.A + (size_t)nxt.pm * tstep + (size_t)nxt.roff * K * 2 : cA; const char* nB = has_next ? (const char*)g.Bt + (size_t)nxt.pn * tstep : cB;
        const bool full = !HALFOK || cur.nai == 2;
        for (int t = 0; t < nt; t += 2) {
            const bool last = (t == nt - 2);
            const char* a1 = cA + (size_t)(t + 1) * kstep;
            const char* a2 = last ? nA : cA + (size_t)(t + 2) * kstep; const char* b2 = last ? nB : cB + (size_t)(t + 2) * kstep;
            const char* a3 = a2 + kstep; const char* b3 = b2 + kstep;
            if (last && has_next) S.a_ready(nxt);
            if constexpr (SP2) {
            PG8_LDB(B0, 0, 0); PG8_LDB(B1, 0, 1); PG8_SCHED; PG8_LDA(At, 0, 0); PG8_STAGE(PG8_SA(1, 1), a1 + hstep, voffA);
            PG8_WAIT_V(8); PG8_WAIT_L(0); PG8_BAR; PG8_MMA(0, 0, At, B0); PG8_MMA(0, 1, At, B1); PG8_BAR; PG8_SCHED;
            if (full) PG8_LDA(At, 0, 1); PG8_STAGE(PG8_SB(0, 0), b2, voffB); PG8_STAGE(PG8_SB(0, 1), b2 + hstep, voffB); PG8_STAGE(PG8_SA(0, 0), a2, voffA);
            PG8_WAIT_V(8); PG8_WAIT_L(0); PG8_BAR; if (full) { PG8_MMA(1, 0, At, B0); PG8_MMA(1, 1, At, B1); } PG8_BAR; PG8_SCHED;
            PG8_LDB(B0, 1, 0); PG8_LDB(B1, 1, 1); PG8_SCHED; PG8_LDA(At, 1, 0); PG8_STAGE(PG8_SA(0, 1), a2 + hstep, voffA);
            PG8_WAIT_V(8); PG8_WAIT_L(0); PG8_BAR; PG8_MMA(0, 0, At, B0); PG8_MMA(0, 1, At, B1); PG8_BAR; PG8_SCHED;
            if (full) PG8_LDA(At, 1, 1); PG8_STAGE(PG8_SB(1, 0), b3, voffB); PG8_STAGE(PG8_SB(1, 1), b3 + hstep, voffB); PG8_STAGE(PG8_SA(1, 0), a3, voffA);
            PG8_WAIT_V(8); PG8_WAIT_L(0); PG8_BAR; if (full) { PG8_MMA(1, 0, At, B0); PG8_MMA(1, 1, At, B1); } PG8_BAR; PG8_SCHED;
            } else {
            PG8_LDB(B0, 0, 0); PG8_SCHED; PG8_LDA(At, 0, 0); PG8_STAGE(PG8_SA(1, 1), a1 + hstep, voffA);
            PG8_WAIT_L(8); PG8_BAR; PG8_WAIT_L(0); PG8_MMA(0, 0, At, B0); PG8_BAR; PG8_SCHED;
            PG8_LDB(B1, 0, 1); PG8_STAGE(PG8_SB(0, 0), b2, voffB);
            PG8_BAR; PG8_WAIT_L(0); PG8_MMA(0, 1, At, B1); PG8_BAR;
            PG8_LDA(At, 0, 1); PG8_STAGE(PG8_SA(0, 0), a2, voffA);
            PG8_BAR; PG8_WAIT_L(0); PG8_MMA(1, 0, At, B0); PG8_BAR; PG8_SCHED;
            PG8_STAGE(PG8_SB(0, 1), b2 + hstep, voffB);
            PG8_WAIT_V(6); PG8_BAR; PG8_MMA(1, 1, At, B1); PG8_BAR;
            PG8_LDB(B0, 1, 0); PG8_SCHED; PG8_LDA(At, 1, 0); PG8_STAGE(PG8_SA(0, 1), a2 + hstep, voffA);
            PG8_WAIT_L(8); PG8_BAR; PG8_WAIT_L(0); PG8_MMA(0, 0, At, B0); PG8_BAR; PG8_SCHED;
            PG8_LDB(B1, 1, 1); PG8_STAGE(PG8_SB(1, 0), b3, voffB);
            PG8_BAR; PG8_WAIT_L(0); PG8_MMA(0, 1, At, B1); PG8_BAR;
            PG8_LDA(At, 1, 1); PG8_STAGE(PG8_SA(1, 0), a3, voffA);
            PG8_BAR; PG8_WAIT_L(0); PG8_MMA(1, 0, At, B0); PG8_BAR; PG8_SCHED;
            PG8_STAGE(PG8_SB(1, 1), b3 + hstep, voffB);
            PG8_WAIT_V(6); PG8_BAR; PG8_MMA(1, 1, At, B1); PG8_BAR;
            }
        }
        if constexpr (ALIGN_EPI) { if (wr == 0) PG8_BAR; }
        if constexpr (!Epi::AFTER_DRAIN) { E(acc, cur, wr, wc, fr, fq); S.done(cur); }
        if (!has_next) break;
#pragma unroll
        for (int a = 0; a < 2; ++a)
#pragma unroll
            for (int b = 0; b < 2; ++b)
#pragma unroll
                for (int m = 0; m < 4; ++m)
#pragma unroll
                    for (int n = 0; n < 2; ++n) acc[a][b][m][n] = (f32x4){0.f, 0.f, 0.f, 0.f};
        cur = nxt; cA = nA; cB = nB; ++ui;
        if constexpr (ALIGN_EPI) { if (wr == 1) PG8_BAR; }
    }
    PG8_WAIT_V(0);
    if constexpr (!ALIGN_EPI) { if (wr == 0) PG8_BAR; }
    PG8_BAR;
    if constexpr (Epi::AFTER_DRAIN) { E.fused(acc, cur, wr, wc, fr, fq, lds, wid, lane); S.done(cur); }
#undef PG8_SA
#undef PG8_SB
#undef PG8_STAGE
#undef PG8_LDA
#undef PG8_LDB
#undef PG8_MMA
#undef PG8_WAIT_V
#undef PG8_WAIT_L
#undef PG8_BAR
#undef PG8_SCHED
}
}


#ifndef PG8_SP2
#define PG8_SP2 true
#endif
#ifndef PG8_ALIGN
#define PG8_ALIGN true
#endif
constexpr int NWAVES = 8;
constexpr int MP = pg8::MP, MS = pg8::MS, MVALID = pg8::MVALID, MT = pg8::MT, DM = 1024, DFF = 2816;
constexpr int SEQ = 4096, NB = 4, NSB = 32, PAST = 8192, NPOOL = 2560;
constexpr int ZC0 = 3328, ZC1 = 2304;
constexpr int Z1_Q = 0, Z1_K = 768, Z1_V = 1024, Z1_IQ = 1280, Z1_IK = 1792, Z1_IW = 1856, Z1_MQ = 1920;
constexpr int NMEMROWS = 1024, MEMROW0 = MT;
constexpr float EPS = 1e-6f;
constexpr size_t MiB = 1u << 20;
constexpr size_t WS_CTL = 0, CTL_ZERO_BYTES = 2 * MiB;
constexpr size_t WS_WIN0 = 2 * MiB, WS_WIN1 = 11 * MiB, WS_WOUT = 16 * MiB, WS_WGU = 20 * MiB, WS_WD = 42 * MiB;
constexpr size_t WS_XB = 54 * MiB, WS_MEMKV = 89 * MiB, WS_MIX = 94 * MiB, WS_Z = 128 * MiB, WS_U = 234 * MiB, WS_UP = 324 * MiB, WS_ACT = 414 * MiB;
constexpr size_t WS_QB = 504 * MiB, WS_KB = 528 * MiB, WS_VB = 536 * MiB, WS_IQB = 544 * MiB, WS_IKB = 560 * MiB, WS_IW = 562 * MiB;
constexpr size_t WS_SQ = 563 * MiB, WS_SIQ = WS_SQ + 512 * 1024, WS_SIW = WS_SIQ + 384 * 1024, WS_SSC = 564 * MiB, WS_SIDX = 569 * MiB, WS_MASK = 570 * MiB, WS_SC = 578 * MiB, WS_END = 834 * MiB;
constexpr int SSC_LD = 8256;
constexpr int CW_TMO = 0, CW_BAR = 4096, CW_Q = 8192, CW_SS = 16384;
constexpr size_t O_YP = 0, O_YS = O_YP + (size_t)MP * DM, O_HP = O_YS + (size_t)MS * DM, O_HS = O_HP + 4 * 6 * 16384, O_KP = O_HS + 32 * 6 * 16384,
    O_VP = O_KP + (size_t)MP * 256, O_IKP = O_VP + (size_t)MP * 256, O_KS = O_IKP + (size_t)MP * 64, O_VS = O_KS + MS * 256, O_IKS = O_VS + MS * 256,
    O_MK = O_IKS + MS * 64, O_MV = O_MK + 2 * 1024 * 256, O_CVP = O_MV + 2 * 1024 * 256, O_CVS = O_CVP + 2 * 4 * 2 * DFF, O_END = O_CVS + 2 * 32 * 2 * DFF;
static_assert(O_END == 31412224, "output size");
constexpr int RING_OFF = 0, RING_BYTES = 131072;
constexpr int LDSCTL_OFF = RING_BYTES, MISC_OFF = LDSCTL_OFF + 320;
constexpr int LDS_BYTES = 147456;

#define GAS __attribute__((address_space(1)))
#define LAS __attribute__((address_space(3)))
typedef unsigned short bf16;
typedef unsigned v4u __attribute__((ext_vector_type(4)));
typedef float f32x4 __attribute__((ext_vector_type(4)));
typedef short bf16x8 __attribute__((ext_vector_type(8)));
typedef GAS unsigned gu32;
typedef GAS unsigned long long gu64;
#define RLX_AGENT __ATOMIC_RELAXED, __HIP_MEMORY_SCOPE_AGENT
#define LDS_WAIT() asm volatile("s_waitcnt lgkmcnt(0)" ::: "memory")
#define VM_WAIT() asm volatile("s_waitcnt vmcnt(0)" ::: "memory")
__device__ __forceinline__ unsigned long long rt() { return __builtin_amdgcn_s_memrealtime(); }
__device__ __forceinline__ unsigned f2bf(float f) { unsigned u = __builtin_bit_cast(unsigned, f); return (u + 0x7fffu + ((u >> 16) & 1u)) >> 16; }
__device__ __forceinline__ unsigned pk2(float lo, float hi) { return f2bf(lo) | (f2bf(hi) << 16); }

#define XB_TMO      128
#define XB_XCNT(j)  (256  + 64 * (j))
#define XB_XSUB(j)  (1280 + 64 * (j))
#define XB_XGEN(j)  (2304 + 64 * (j))
#define XB_TOP      3328
#define XB_TOPGEN   3392
#define XCD_BAR_WORDS 3456
#define XB_SPIN_CAP (1u << 18)

__device__ __forceinline__ unsigned xb_ld(unsigned* p)              { return __hip_atomic_load(p, __ATOMIC_RELAXED, __HIP_MEMORY_SCOPE_AGENT); }
__device__ __forceinline__ unsigned xb_add(unsigned* p, unsigned v) { return __hip_atomic_fetch_add(p, v, __ATOMIC_RELAXED, __HIP_MEMORY_SCOPE_AGENT); }
__device__ __forceinline__ unsigned xb_xcc_id() { return (unsigned)__builtin_amdgcn_s_getreg((3 << 11) | 20) & 0xFu; }
#define XB_SPIN(cond, bar) do { unsigned _sp = 0; while (cond) { __builtin_amdgcn_s_sleep(1); \
    if ((++_sp & 255u) == 0u) { if (xb_ld(&(bar)[XB_TMO])) break; if (_sp > XB_SPIN_CAP) { atomicAdd(&(bar)[XB_TMO], 1u); break; } } } } while (0)

struct XcdBarrier {
    unsigned* bar; unsigned x;
    volatile LAS unsigned* st;
};

__device__ __forceinline__ XcdBarrier xcd_barrier_post(unsigned* bar, volatile LAS unsigned* st) {
    XcdBarrier b; b.bar = bar; b.x = xb_xcc_id(); b.st = st;
    if (threadIdx.x == 0) (void)xb_add(&bar[XB_XCNT(b.x)], 1u);
    return b;
}
__device__ __forceinline__ void xcd_barrier_complete(unsigned* bar, unsigned x, unsigned& nloc, unsigned& nx) {
    const unsigned G = gridDim.x * gridDim.y * gridDim.z;
    unsigned sum, cnt, mine, sp = 0u;
    for (;;) {
        sum = 0u; cnt = 0u; mine = 0u;
#pragma unroll
        for (unsigned j = 0; j < 16; ++j) { const unsigned c = xb_ld(&bar[XB_XCNT(j)]); sum += c; cnt += (c > 0u) ? 1u : 0u; mine = (j == x) ? c : mine; }
        if (sum == G) break;
        __builtin_amdgcn_s_sleep(1);
        if ((++sp & 255u) == 0u) { if (xb_ld(&bar[XB_TMO])) break; if (sp > XB_SPIN_CAP) { atomicAdd(&bar[XB_TMO], 1u); break; } }
    }
    nloc = mine > 0u ? mine : 1u; nx = cnt > 0u ? cnt : 1u;
}

__device__ __forceinline__ void xcd_barrier(const XcdBarrier& b) {
    asm volatile("s_waitcnt vmcnt(0)" ::: "memory");
    __syncthreads();
    if (threadIdx.x == 0) {
        unsigned* bar = b.bar;
        __builtin_amdgcn_s_waitcnt(0);
        unsigned nloc = b.st[0], nx = b.st[1];
        if (nloc == 0u) { xcd_barrier_complete(bar, b.x, nloc, nx); b.st[0] = nloc; b.st[1] = nx; }
        const unsigned old = xb_add(&bar[XB_XSUB(b.x)], 1u);
        const unsigned gen = old / nloc;
        if (old + 1u == (gen + 1u) * nloc) {
            __builtin_amdgcn_fence(__ATOMIC_RELEASE, "agent");
            asm volatile("s_waitcnt vmcnt(0)" ::: "memory");
            const unsigned og = xb_add(&bar[XB_TOP], 1u);
            const unsigned tg = og / nx;
            if (og + 1u == (tg + 1u) * nx) xb_add(&bar[XB_TOPGEN], 1u);
            else XB_SPIN(xb_ld(&bar[XB_TOPGEN]) == tg, bar);
            __builtin_amdgcn_fence(__ATOMIC_ACQUIRE, "agent");
            xb_add(&bar[XB_XGEN(b.x)], 1u);
            asm volatile("s_waitcnt vmcnt(0)" ::: "memory");
        } else {
            XB_SPIN(xb_ld(&bar[XB_XGEN(b.x)]) == gen, bar);
            __builtin_amdgcn_fence(__ATOMIC_ACQUIRE, "agent");
            asm volatile("s_waitcnt vmcnt(0)" ::: "memory");
        }
    }
    __syncthreads();
}


struct Args { const float* in[29]; const int* page_table; float* out; unsigned char* ws; int ph_lo, ph_hi; };
typedef const __attribute__((address_space(4))) Args& ARGREF;
struct Ctx { LAS unsigned char* lds; volatile LAS unsigned* MISC; gu32* ctl; int tid, lane, wave, vcu, G, qoff; };
typedef float f32x16 __attribute__((ext_vector_type(16)));
typedef unsigned long long u64;

__device__ __forceinline__ float bf2f(unsigned b) { return __builtin_bit_cast(float, b << 16); }
__device__ __forceinline__ float wave_sum(float v) {
#pragma unroll
    for (int o = 1; o < 64; o <<= 1) v += __shfl_xor(v, o);
    return v;
}
__device__ __forceinline__ float wave_sum_fast(float x) {
    x += __builtin_bit_cast(float, __builtin_amdgcn_update_dpp(0, __builtin_bit_cast(int, x), 0xB1, 0xF, 0xF, false));
    x += __builtin_bit_cast(float, __builtin_amdgcn_update_dpp(0, __builtin_bit_cast(int, x), 0x4E, 0xF, 0xF, false));
    x += __builtin_bit_cast(float, __builtin_amdgcn_update_dpp(0, __builtin_bit_cast(int, x), 0x141, 0xF, 0xF, false));
    x += __builtin_bit_cast(float, __builtin_amdgcn_update_dpp(0, __builtin_bit_cast(int, x), 0x140, 0xF, 0xF, false));
    const int xi = __builtin_bit_cast(int, x);
    return (__builtin_bit_cast(float, __builtin_amdgcn_readlane(xi, 0)) + __builtin_bit_cast(float, __builtin_amdgcn_readlane(xi, 16))) +
           (__builtin_bit_cast(float, __builtin_amdgcn_readlane(xi, 32)) + __builtin_bit_cast(float, __builtin_amdgcn_readlane(xi, 48)));
}
__device__ __forceinline__ int crow(int r, int hi) { return (r & 3) + 8 * (r >> 2) + 4 * hi; }
__device__ __forceinline__ float sigmoidf_(float x) { return __builtin_amdgcn_rcpf(1.0f + __expf(-x)); }
__device__ __forceinline__ float* ssptr(const Ctx& c, int i) { return (float*)(c.ctl + CW_SS) + (size_t)i * MT; }

__device__ __forceinline__ int q_next(Ctx& c, int qi) {
    __syncthreads();
    if (c.tid == 0) c.MISC[16] = atomicAdd((unsigned*)(c.ctl + CW_Q + 64 * (qi + c.qoff)), 1u);
    __syncthreads();
    return (int)c.MISC[16];
}

template <int K>
__device__ __forceinline__ f32x16 mm32(const LAS bf16* A, int lda, const LAS bf16* Bt, int ldb, f32x16 acc, int lane) {
    const int r = lane & 31, h = lane >> 5;
#pragma unroll
    for (int ks = 0; ks < K; ks += 16) {
        const bf16x8 a = *(const LAS bf16x8*)(A + r * lda + ks + 8 * h);
        const bf16x8 b = *(const LAS bf16x8*)(Bt + r * ldb + ks + 8 * h);
        acc = __builtin_amdgcn_mfma_f32_32x32x16_bf16(a, b, acc, 0, 0, 0);
    }
    return acc;
}

__device__ __forceinline__ int map_row(int mapid, int n, int row_off) {
    if (mapid == 0) return n + row_off;
    if (mapid == 1) return n < 1864 ? n : n + 56;
    if (mapid == 2) return (n >> 7) * 256 + (n & 127);
    return (n >> 7) * 256 + 128 + (n & 127);
}
template <int MODE>
__device__ __forceinline__ void transpose_item(const float* W, int K, int N, const float* kscale, bf16* WT, int mapid, int row_off, LAS float* scr, int item, int lane, f32x4 (&v)[8], float (&sc)[8]) {
    const int nblk = (N + 31) / 32, kb = item / nblk, nb = item % nblk, k0 = 64 * kb, n0 = 32 * nb;
    const int n4 = (lane & 7) * 4;
    if (MODE != 2) { const int nn = n0 + n4 < N ? n0 + n4 : N - 4;
#pragma unroll
      for (int i = 0; i < 8; ++i) v[i] = *(const f32x4*)(W + (size_t)(k0 + 8 * i + (lane >> 3)) * N + nn);
#pragma unroll
      for (int i = 0; i < 8; ++i) sc[i] = kscale ? kscale[k0 + 8 * i + (lane >> 3)] : 1.0f; }
    if (MODE == 1) return;
#pragma unroll
    for (int i = 0; i < 8; ++i) { const int kk = 8 * i + (lane >> 3); LAS float* d = scr + kk * 33 + n4;
        d[0] = v[i].x * sc[i]; d[1] = v[i].y * sc[i]; d[2] = v[i].z * sc[i]; d[3] = v[i].w * sc[i]; }
    LDS_WAIT(); asm volatile("" ::: "memory");
    const int cc = lane & 7;
#pragma unroll
    for (int j = 0; j < 4; ++j) { const int nl = (lane >> 3) + 8 * j, n = n0 + nl; const LAS float* s = scr + (8 * cc) * 33 + nl;
        v4u o; o.x = pk2(s[0 * 33], s[1 * 33]); o.y = pk2(s[2 * 33], s[3 * 33]); o.z = pk2(s[4 * 33], s[5 * 33]); o.w = pk2(s[6 * 33], s[7 * 33]);
        if (n < N) *(GAS v4u*)(WT + (size_t)map_row(mapid, n, row_off) * K + k0 + 8 * cc) = o; }
    LDS_WAIT(); asm volatile("" ::: "memory");
}
constexpr int I_INH = 16 * 104, I_MKV = 16 * 16, I_DSA = 16 * 67, I_OUT = 16 * 32, I_G = 16 * 88, I_D = 44 * 32;
constexpr int W_N0 = I_INH + 2 * I_MKV + I_OUT + 2 * I_G + I_D, W_NITEMS = W_N0 + I_DSA + I_OUT + 2 * I_G + I_D;
template <int MODE>
__device__ __forceinline__ void convert_item(ARGREF a, int it, LAS float* scr, int lane, f32x4 (&v)[8], float (&sc)[8]) {
    unsigned char* ws = a.ws; int r = it;
    if (r < I_INH) { transpose_item<MODE>(a.in[13], 1024, 3328, a.in[11], (bf16*)(ws + WS_WIN0), 0, 0, scr, r, lane, v, sc); return; } r -= I_INH;
    if (r < 2 * I_MKV) { const int l = r / I_MKV; transpose_item<MODE>(a.in[20] + (size_t)l * 1024 * 512, 1024, 512, nullptr, (bf16*)(ws + WS_WIN0), 0, 3328 + 512 * l, scr, r % I_MKV, lane, v, sc); return; } r -= 2 * I_MKV;
    int l = 0;
    if (r >= I_OUT + 2 * I_G + I_D) { r -= I_OUT + 2 * I_G + I_D; l = 1;
        if (r < I_DSA) { transpose_item<MODE>(a.in[16], 1024, 2120, a.in[11] + 1024, (bf16*)(ws + WS_WIN1), 1, 0, scr, r, lane, v, sc); return; } r -= I_DSA; }
    if (r < I_OUT) { transpose_item<MODE>(a.in[23] + (size_t)l * 1024 * 1024, 1024, 1024, nullptr, (bf16*)(ws + WS_WOUT) + (size_t)l * 1024 * 1024, 0, 0, scr, r, lane, v, sc); return; } r -= I_OUT;
    if (r < I_G) { transpose_item<MODE>(a.in[24] + (size_t)l * 1024 * DFF, 1024, DFF, a.in[12] + l * 1024, (bf16*)(ws + WS_WGU) + (size_t)l * 5632 * 1024, 2, 0, scr, r, lane, v, sc); return; } r -= I_G;
    if (r < I_G) { transpose_item<MODE>(a.in[25] + (size_t)l * 1024 * DFF, 1024, DFF, a.in[12] + l * 1024, (bf16*)(ws + WS_WGU) + (size_t)l * 5632 * 1024, 3, 0, scr, r, lane, v, sc); return; } r -= I_G;
    transpose_item<MODE>(a.in[28] + (size_t)l * DFF * 1024, DFF, 1024, nullptr, (bf16*)(ws + WS_WD) + (size_t)l * 1024 * DFF, 0, 0, scr, r, lane, v, sc);
}
constexpr int W_PRO = I_INH + 2 * I_MKV + I_OUT + I_G, W_T0 = W_N0 + I_DSA, W_T1 = W_T0 + I_OUT + I_G;
__device__ __forceinline__ void convert_tail(Ctx& c, ARGREF a, int first_idle, int it0, int it1, int nlight = 0) {
    LAS float* scr = (LAS float*)(c.lds + RING_OFF + c.wave * 16384);
    const int bx = (int)blockIdx.x; if (bx < first_idle) return;
    const int nidle = c.G - first_idle, nheavy = nidle - (nlight < nidle ? nlight : nidle), bi = bx - first_idle;
    const int nslots = nheavy * NWAVES * 3 + (nidle - nheavy) * NWAVES * 2;
    const int my0 = bi < nheavy ? (bi * NWAVES + c.wave) * 3 : nheavy * NWAVES * 3 + ((bi - nheavy) * NWAVES + c.wave) * 2, myn = bi < nheavy ? 3 : 2;
    f32x4 vA[8], vB[8]; float sA[8], sB[8];
    int q = 0, it = it0 + my0;
    if (it < it1) convert_item<1>(a, it, scr, c.lane, vA, sA);
#pragma unroll 1
    while (it < it1) { ++q; const int nx = it0 + (q / myn) * nslots + my0 + q % myn;
        if (nx < it1) convert_item<1>(a, nx, scr, c.lane, vB, sB);
        convert_item<2>(a, it, scr, c.lane, vA, sA);
#pragma unroll
        for (int i = 0; i < 8; ++i) { vA[i] = vB[i]; sA[i] = sB[i]; }
        it = nx; }
}
__device__ __forceinline__ void p0_prologue(Ctx& c, ARGREF a) {
    LAS float* scr = (LAS float*)(c.lds + RING_OFF + c.wave * 16384);
    const int gw = c.vcu * NWAVES + c.wave, NGW = c.G * NWAVES, lane = c.lane;
    unsigned char* ws = a.ws;
    { f32x4 vA[8], vB[8]; float sA[8], sB[8]; int it = gw;
      if (it < W_PRO) convert_item<1>(a, it, scr, lane, vA, sA);
#pragma unroll 1
      while (it < W_PRO) { const int nx = it + NGW;
          if (nx < W_PRO) convert_item<1>(a, nx, scr, lane, vB, sB);
          convert_item<2>(a, it, scr, lane, vA, sA);
#pragma unroll
          for (int i = 0; i < 8; ++i) { vA[i] = vB[i]; sA[i] = sB[i]; }
          it = nx; } }
    for (int rr = gw; rr < 184; rr += NGW) { const int row = rr < 56 ? 1864 + rr : 2176 + (rr - 56);
        GAS v4u* p = (GAS v4u*)((bf16*)(ws + WS_WIN1) + (size_t)row * 1024); p[lane] = (v4u){0u, 0u, 0u, 0u}; p[64 + lane] = (v4u){0u, 0u, 0u, 0u}; }
    float* ss0 = ssptr(c, 0);
    for (int m = gw; m < MT + NMEMROWS; m += NGW) {
        GAS u64* o8 = (GAS u64*)((bf16*)(ws + WS_XB) + (size_t)m * DM) + lane;
        if (m >= MVALID && m < MT) {
#pragma unroll
            for (int j = 0; j < 4; ++j) o8[64 * j] = 0ull;
            continue; }
        const float* src = m < MP ? a.in[0] + (size_t)m * DM : (m < MVALID ? a.in[1] + (size_t)(m - MP) * DM : a.in[10] + (size_t)(m - MT) * DM);
        const GAS f32x4* xr = (const GAS f32x4*)src + lane; f32x4 v[4]; float s = 0.f;
#pragma unroll
        for (int j = 0; j < 4; ++j) { v[j] = xr[64 * j]; s += (v[j].x * v[j].x + v[j].y * v[j].y) + (v[j].z * v[j].z + v[j].w * v[j].w); }
        s = wave_sum_fast(s);
#pragma unroll
        for (int j = 0; j < 4; ++j) o8[64 * j] = (u64)pk2(v[j].x, v[j].y) | ((u64)pk2(v[j].z, v[j].w) << 32);
        if (m < MVALID && lane == 0) ss0[m] = s;
    }
}

__device__ __forceinline__ void memattn_unit(Ctx& c, const bf16* Zq  , int ldz, int nrows_valid, const float* Kp, const float* Vp, int kstride,
                                             bool normk, const float* kgain, const float* qgain, bf16* Out  ) {
    LAS bf16* KN = (LAS bf16*)(c.lds);
    LAS bf16* VTm = (LAS bf16*)(c.lds + 36864);
    LAS bf16* QN = (LAS bf16*)(c.lds + 70656) + c.wave * (32 * 72);
    LAS float* LI = (LAS float*)(c.lds + 107520) + c.wave * 32;
    int tid = c.tid; asm volatile("" : "+v"(tid));
    const int lane = tid & 63, w = c.wave;
    {
        const int m = tid >> 1, dh = (tid & 1) * 32;
        f32x4 kv[8]; float s = 0.f;
#pragma unroll
        for (int j = 0; j < 8; ++j) { kv[j] = *(const f32x4*)(Kp + (size_t)m * kstride + dh + 4 * j); s += (kv[j].x * kv[j].x + kv[j].y * kv[j].y) + (kv[j].z * kv[j].z + kv[j].w * kv[j].w); }
        s += __shfl_xor(s, 1);
        const float rs = normk ? rsqrtf(s * (1.0f / 64.0f) + EPS) : 1.0f;
#pragma unroll
        for (int j = 0; j < 8; j += 2) { f32x4 g0 = {1.f, 1.f, 1.f, 1.f}, g1 = g0;
            if (normk) { g0 = *(const f32x4*)(kgain + dh + 4 * j); g1 = *(const f32x4*)(kgain + dh + 4 * j + 4); }
            const f32x4 x0 = kv[j] * rs * g0, x1 = kv[j + 1] * rs * g1;
            v4u o; o.x = pk2(x0.x, x0.y); o.y = pk2(x0.z, x0.w); o.z = pk2(x1.x, x1.y); o.w = pk2(x1.z, x1.w);
            *(LAS v4u*)(KN + m * 72 + dh + 4 * j) = o; }
#pragma unroll
        for (int j = 0; j < 8; ++j) { const f32x4 vv = *(const f32x4*)(Vp + (size_t)m * kstride + dh + 4 * j);
            VTm[(dh + 4 * j + 0) * 264 + m] = (bf16)f2bf(vv.x); VTm[(dh + 4 * j + 1) * 264 + m] = (bf16)f2bf(vv.y);
            VTm[(dh + 4 * j + 2) * 264 + m] = (bf16)f2bf(vv.z); VTm[(dh + 4 * j + 3) * 264 + m] = (bf16)f2bf(vv.w); }
    }
    {
        const int row = lane >> 1, hf = lane & 1, grow = w * 32 + row;
        float x[32]; float s = 0.f;
        if (grow < nrows_valid) {
#pragma unroll
            for (int j = 0; j < 4; ++j) { const v4u q = *(const v4u*)(Zq + (size_t)grow * ldz + hf * 32 + 8 * j);
                x[8 * j + 0] = bf2f(q.x & 0xffffu); x[8 * j + 1] = bf2f(q.x >> 16); x[8 * j + 2] = bf2f(q.y & 0xffffu); x[8 * j + 3] = bf2f(q.y >> 16);
                x[8 * j + 4] = bf2f(q.z & 0xffffu); x[8 * j + 5] = bf2f(q.z >> 16); x[8 * j + 6] = bf2f(q.w & 0xffffu); x[8 * j + 7] = bf2f(q.w >> 16); }
        } else {
#pragma unroll
            for (int j = 0; j < 32; ++j) x[j] = 0.f;
        }
#pragma unroll
        for (int j = 0; j < 32; ++j) s += x[j] * x[j];
        s += __shfl_xor(s, 1);
        const float rs = rsqrtf(s * (1.0f / 64.0f) + EPS) * 0.125f;
#pragma unroll
        for (int j = 0; j < 32; j += 8) { v4u o;
            o.x = pk2(x[j] * rs * qgain[hf * 32 + j], x[j + 1] * rs * qgain[hf * 32 + j + 1]); o.y = pk2(x[j + 2] * rs * qgain[hf * 32 + j + 2], x[j + 3] * rs * qgain[hf * 32 + j + 3]);
            o.z = pk2(x[j + 4] * rs * qgain[hf * 32 + j + 4], x[j + 5] * rs * qgain[hf * 32 + j + 5]); o.w = pk2(x[j + 6] * rs * qgain[hf * 32 + j + 6], x[j + 7] * rs * qgain[hf * 32 + j + 7]);
            *(LAS v4u*)(QN + row * 72 + hf * 32 + j) = o; }
    }
    __syncthreads();
    if (w * 32 < nrows_valid) {
        const int r32 = lane & 31, hh = lane >> 5;
        f32x16 s[8];
#pragma unroll
        for (int mt = 0; mt < 8; ++mt) { f32x16 z = {}; s[mt] = mm32<64>(KN + mt * 32 * 72, 72, QN, 72, z, lane); }
        float mx = -1e30f;
#pragma unroll
        for (int mt = 0; mt < 8; ++mt)
#pragma unroll
            for (int r = 0; r < 16; ++r) mx = fmaxf(mx, s[mt][r]);
        mx = fmaxf(mx, __shfl_xor(mx, 32));
        float l = 0.f;
#pragma unroll
        for (int mt = 0; mt < 8; ++mt)
#pragma unroll
            for (int r = 0; r < 16; ++r) { const float p = __expf(s[mt][r] - mx); s[mt][r] = p; l += p; }
        l += __shfl_xor(l, 32);
        if (hh == 0) LI[r32] = l;
        f32x16 o[2] = {};
#pragma unroll
        for (int mt = 0; mt < 8; ++mt)
#pragma unroll
            for (int sx = 0; sx < 2; ++sx) {
                v4u pa; pa.x = pk2(s[mt][8 * sx + 0], s[mt][8 * sx + 1]); pa.y = pk2(s[mt][8 * sx + 2], s[mt][8 * sx + 3]);
                pa.z = pk2(s[mt][8 * sx + 4], s[mt][8 * sx + 5]); pa.w = pk2(s[mt][8 * sx + 6], s[mt][8 * sx + 7]);
                const bf16x8 af = __builtin_bit_cast(bf16x8, pa);
#pragma unroll
                for (int dt = 0; dt < 2; ++dt) { const LAS bf16* vp = VTm + (dt * 32 + r32) * 264 + mt * 32 + 16 * sx + 4 * hh;
                    const u64 lo = *(const LAS u64*)vp, hi = *(const LAS u64*)(vp + 8);
                    v4u bw; bw.x = (unsigned)lo; bw.y = (unsigned)(lo >> 32); bw.z = (unsigned)hi; bw.w = (unsigned)(hi >> 32);
                    o[dt] = __builtin_amdgcn_mfma_f32_32x32x16_bf16(af, __builtin_bit_cast(bf16x8, bw), o[dt], 0, 0, 0); }
            }
        LDS_WAIT();
#pragma unroll
        for (int r = 0; r < 16; ++r) { const int qr = crow(r, hh), grow = w * 32 + qr; const float il = __builtin_amdgcn_rcpf(LI[qr]);
            if (grow < nrows_valid) {
#pragma unroll
                for (int dt = 0; dt < 2; ++dt) Out[(size_t)grow * DM + dt * 32 + r32] = (bf16)f2bf(o[dt][r] * il); } }
    }
}

constexpr int HG_GS = 4, HG_NG = SEQ / (32 * HG_GS);
constexpr size_t WS_HOL = WS_U, WS_HQC = WS_UP, WS_HUT = WS_ACT, WS_HST = WS_ACT + 64 * MiB, WS_HDG = WS_ACT + 50 * MiB;
template <bool PROMPT>
__device__ __forceinline__ void hgrn_unit(Ctx& c, ARGREF a, int b, int h, int g) {
    LAS unsigned char* L = c.lds;
    LAS float* LFt = (LAS float*)(L + 0);
    LAS float* OB = (LAS float*)(L + 0);
    LAS float* SEG = (LAS float*)(L + 16896);
    LAS float* DVv = (LAS float*)(L + 18944);
    LAS bf16* QD = (LAS bf16*)(L + 19456);
    LAS bf16* KD = (LAS bf16*)(L + 28160);
    LAS bf16* KET = (LAS bf16*)(L + 36864);
    LAS bf16* VT = (LAS bf16*)(L + 47104);
    LAS bf16* SCB = (LAS bf16*)(L + 57344);
    LAS bf16* STt = (LAS bf16*)(L + 59904);
    LAS float* BOFF = (LAS float*)(L + 94720);
    int tid = c.tid; asm volatile("" : "+v"(tid));
    const int lane = tid & 63, w = c.wave, r32 = lane & 31, hh = lane >> 5;
    const int te = tid & 31, k8 = (tid >> 5) * 8;
    const int tf = tid >> 4, v8 = (tid & 15) * 8;
    const bf16* Z = (const bf16*)(a.ws + WS_Z);
    bf16* MIX = (bf16*)(a.ws + WS_MIX);
    const int nch = PROMPT ? HG_GS : 1, nvalid = PROMPT ? 32 : 4;
    const int kt = w >> 1, vt0 = 2 * (w & 1);
    const int unit = (b * 6 + h) * HG_NG + g;
    f32x16 S0 = {}, S1 = {};
    if (!PROMPT) { const float* sp = a.in[7] + (size_t)(b * 6 + h) * 16384;
#pragma unroll
        for (int r = 0; r < 16; ++r) { const int k = 32 * kt + crow(r, hh); S0[r] = sp[k * 128 + 32 * vt0 + r32]; S1[r] = sp[k * 128 + 32 * (vt0 + 1) + r32]; } }
    float lbv[8];
#pragma unroll
    for (int j = 0; j < 8; ++j) { const float l0 = a.in[14][h * 128 + k8 + j], l1 = a.in[14][768 + h * 128 + k8 + j]; lbv[j] = 1.0f / (1.0f + __expf(l1 - l0)); }
    __syncthreads();
    if (tid < 128) BOFF[tid] = 0.f;
#define HG_WRITE_ST() do { _Pragma("unroll") for (int g4 = 0; g4 < 4; ++g4) { const int k0 = 32 * kt + 8 * g4 + 4 * hh; \
        *(LAS u64*)(STt + (32 * vt0 + r32) * 136 + k0) = (u64)pk2(S0[4 * g4], S0[4 * g4 + 1]) | ((u64)pk2(S0[4 * g4 + 2], S0[4 * g4 + 3]) << 32); \
        *(LAS u64*)(STt + (32 * (vt0 + 1) + r32) * 136 + k0) = (u64)pk2(S1[4 * g4], S1[4 * g4 + 1]) | ((u64)pk2(S1[4 * g4 + 2], S1[4 * g4 + 3]) << 32); } } while (0)
    HG_WRITE_ST();
    v4u zq = {0u, 0u, 0u, 0u}, zf = zq, zi = zq;
    { const int row = (PROMPT ? b * SEQ + (g * HG_GS) * 32 : MP + 4 * b) + te;
      if (te < nvalid) { const bf16* zr = Z + (size_t)row * ZC0 + h * 128 + k8; zq = *(const v4u*)zr; zf = *(const v4u*)(zr + 768); zi = *(const v4u*)(zr + 1536); } }
#pragma unroll 1
    for (int ch = 0; ch < nch; ++ch) {
        const int row0 = PROMPT ? b * SEQ + (g * HG_GS + ch) * 32 : MP + 4 * b, row = row0 + te;
        const bool valid = te < nvalid;
        float qs[8], kk[8];
        {
            const unsigned qw[4] = {zq.x, zq.y, zq.z, zq.w}, fw[4] = {zf.x, zf.y, zf.z, zf.w}, iw[4] = {zi.x, zi.y, zi.z, zi.w};
#pragma unroll
            for (int j = 0; j < 8; ++j) { const float q = bf2f((qw[j >> 1] >> (16 * (j & 1))) & 0xffffu), fp = bf2f((fw[j >> 1] >> (16 * (j & 1))) & 0xffffu);
                const float sg = sigmoidf_(fp), f = lbv[j] + (1.0f - lbv[j]) * sg;
                qs[j] = valid ? q * sigmoidf_(q) : 0.f; kk[j] = valid ? (1.0f - f) : 0.f;
                LFt[(k8 + j) * 33 + te] = valid ? __logf(f) : 0.f;
                VT[(k8 + j) * 40 + te] = (bf16)((iw[j >> 1] >> (16 * (j & 1))) & 0xffffu); }
            if (PROMPT && ch + 1 < nch) { const bf16* zr = Z + (size_t)(row + 32) * ZC0 + h * 128 + k8; zq = *(const v4u*)zr; zf = *(const v4u*)(zr + 768); zi = *(const v4u*)(zr + 1536); }
        }
        __syncthreads();
        {
            const int k = tid & 127, sg_ = tid >> 7; float bsum = 0.f;
#pragma unroll
            for (int i = 0; i < 8; ++i) { bsum += LFt[k * 33 + 8 * sg_ + i]; LFt[k * 33 + 8 * sg_ + i] = bsum; }
            SEG[sg_ * 128 + k] = bsum; }
        __syncthreads();
        {
            float bb[8], bl[8];
            { f32x4 t0[4], t1[4];
#pragma unroll
              for (int s_ = 0; s_ < 4; ++s_) { t0[s_] = *(const LAS f32x4*)(SEG + s_ * 128 + k8); t1[s_] = *(const LAS f32x4*)(SEG + s_ * 128 + k8 + 4); }
              const int sgt = te >> 3; f32x4 o0 = {0.f, 0.f, 0.f, 0.f}, o1 = o0;
#pragma unroll
              for (int s_ = 0; s_ < 3; ++s_) if (s_ < sgt) { o0 += t0[s_]; o1 += t1[s_]; }
              const f32x4 l0 = (t0[0] + t0[1]) + (t0[2] + t0[3]), l1 = (t1[0] + t1[1]) + (t1[2] + t1[3]);
              const float of[8] = {o0.x, o0.y, o0.z, o0.w, o1.x, o1.y, o1.z, o1.w}; const float lt[8] = {l0.x, l0.y, l0.z, l0.w, l1.x, l1.y, l1.z, l1.w};
#pragma unroll
              for (int j = 0; j < 8; ++j) { bb[j] = LFt[(k8 + j) * 33 + te] + of[j]; bl[j] = lt[j]; } }
            float qd[8], kd[8];
#pragma unroll
            for (int j = 0; j < 8; ++j) { qd[j] = qs[j] * __expf(bb[j]); kd[j] = kk[j] * __expf(-bb[j]); KET[(k8 + j) * 40 + te] = (bf16)f2bf(kk[j] * __expf(bl[j] - bb[j])); }
            v4u o; o.x = pk2(qd[0], qd[1]); o.y = pk2(qd[2], qd[3]); o.z = pk2(qd[4], qd[5]); o.w = pk2(qd[6], qd[7]); *(LAS v4u*)(QD + te * 136 + k8) = o;
            if (PROMPT) { const f32x4 f0 = *(const LAS f32x4*)(BOFF + k8), f1 = *(const LAS f32x4*)(BOFF + k8 + 4);
                const float bo[8] = {f0.x, f0.y, f0.z, f0.w, f1.x, f1.y, f1.z, f1.w}; float qc[8];
#pragma unroll
                for (int j = 0; j < 8; ++j) qc[j] = qd[j] * __expf(bo[j]);
                v4u oc; oc.x = pk2(qc[0], qc[1]); oc.y = pk2(qc[2], qc[3]); oc.z = pk2(qc[4], qc[5]); oc.w = pk2(qc[6], qc[7]);
                *(v4u*)((bf16*)(a.ws + WS_HQC) + (size_t)row * 768 + h * 128 + k8) = oc; }
            o.x = pk2(kd[0], kd[1]); o.y = pk2(kd[2], kd[3]); o.z = pk2(kd[4], kd[5]); o.w = pk2(kd[6], kd[7]); *(LAS v4u*)(KD + te * 136 + k8) = o;
            if (te == 0) {
#pragma unroll
                for (int j = 0; j < 8; ++j) DVv[k8 + j] = __expf(bl[j]); }
        }
        __syncthreads();
        f32x16 oacc = {};
        if (w == 4) { f32x16 z = {}; const f32x16 sc = mm32<128>(QD, 136, KD, 136, z, lane);
#pragma unroll
            for (int r = 0; r < 16; ++r) { const int t = crow(r, hh); SCB[t * 40 + r32] = (bf16)f2bf(r32 <= t ? sc[r] : 0.f); } }
        if (w < 4) oacc = mm32<128>(QD, 136, STt + (w * 32) * 136, 136, oacc, lane);
        if (PROMPT && tid >= 384) { const int k = tid - 384; BOFF[k] += (SEG[k] + SEG[128 + k]) + (SEG[256 + k] + SEG[384 + k]); }
        __syncthreads();
        if (w < 4) { oacc = mm32<32>(SCB, 40, VT + (w * 32) * 40, 40, oacc, lane);
#pragma unroll
            for (int r = 0; r < 16; ++r) OB[crow(r, hh) * 128 + w * 32 + r32] = oacc[r]; }
        {
#pragma unroll
            for (int r = 0; r < 16; ++r) { const float d = DVv[32 * kt + crow(r, hh)]; S0[r] *= d; S1[r] *= d; }
            S0 = mm32<32>(KET + (kt * 32) * 40, 40, VT + (vt0 * 32) * 40, 40, S0, lane);
            S1 = mm32<32>(KET + (kt * 32) * 40, 40, VT + ((vt0 + 1) * 32) * 40, 40, S1, lane);
        }
        __syncthreads();
        HG_WRITE_ST();
        {
            const int orow = row0 + tf;
            const f32x4 o0 = *(const LAS f32x4*)(OB + tf * 128 + v8), o1 = *(const LAS f32x4*)(OB + tf * 128 + v8 + 4);
            if (PROMPT) { float* ol = (float*)(a.ws + WS_HOL) + (size_t)orow * 768 + h * 128 + v8; *(f32x4*)ol = o0; *(f32x4*)(ol + 4) = o1; }
            else {
                float ov[8] = {o0.x, o0.y, o0.z, o0.w, o1.x, o1.y, o1.z, o1.w}; float s = 0.f;
#pragma unroll
                for (int j = 0; j < 8; ++j) s += ov[j] * ov[j];
                s += __shfl_xor(s, 1); s += __shfl_xor(s, 2); s += __shfl_xor(s, 4); s += __shfl_xor(s, 8);
                const float rs = rsqrtf(s * (1.0f / 128.0f) + EPS);
                if (tf < nvalid) { const v4u gz = *(const v4u*)(Z + (size_t)orow * ZC0 + 2304 + h * 128 + v8); const unsigned gw_[4] = {gz.x, gz.y, gz.z, gz.w}; float y[8];
#pragma unroll
                    for (int j = 0; j < 8; ++j) { const float gg = bf2f((gw_[j >> 1] >> (16 * (j & 1))) & 0xffffu); y[j] = ov[j] * rs * a.in[15][v8 + j] * (gg * sigmoidf_(gg)); }
                    v4u o; o.x = pk2(y[0], y[1]); o.y = pk2(y[2], y[3]); o.z = pk2(y[4], y[5]); o.w = pk2(y[6], y[7]); *(v4u*)(MIX + (size_t)orow * DM + h * 128 + v8) = o; }
            }
        }
        __syncthreads();
    }
#undef HG_WRITE_ST
    if (PROMPT) {
        float* ut = (float*)(a.ws + WS_HUT) + (size_t)unit * 16384;
#pragma unroll
        for (int g4 = 0; g4 < 4; ++g4) { const int k0 = 32 * kt + 8 * g4 + 4 * hh;
            *(f32x4*)(ut + (32 * vt0 + r32) * 128 + k0) = (f32x4){S0[4 * g4], S0[4 * g4 + 1], S0[4 * g4 + 2], S0[4 * g4 + 3]};
            *(f32x4*)(ut + (32 * (vt0 + 1) + r32) * 128 + k0) = (f32x4){S1[4 * g4], S1[4 * g4 + 1], S1[4 * g4 + 2], S1[4 * g4 + 3]}; }
        if (tid < 128) ((float*)(a.ws + WS_HDG))[(size_t)unit * 128 + tid] = __expf(BOFF[tid]);
    } else {
        float* so = a.out + O_HS + (size_t)(b * 6 + h) * 16384;
#pragma unroll
        for (int r = 0; r < 16; ++r) { const int k = 32 * kt + crow(r, hh); so[k * 128 + 32 * vt0 + r32] = S0[r]; so[k * 128 + 32 * (vt0 + 1) + r32] = S1[r]; }
    }
}
__device__ __forceinline__ void hgrn_scan(Ctx& c, ARGREF a) {
    const float* UT = (const float*)(a.ws + WS_HUT); const float* DG = (const float*)(a.ws + WS_HDG); bf16* STo = (bf16*)(a.ws + WS_HST);
    for (int idx = c.vcu * 512 + c.tid; idx < 24 * 16384; idx += c.G * 512) {
        const int bh = idx >> 14, e = idx & 16383, k = e & 127, v = e >> 7;
        float s = 0.f, ut[HG_NG], dg[HG_NG];
#pragma unroll
        for (int g = 0; g < HG_NG; ++g) { const size_t u = (size_t)(bh * HG_NG + g); ut[g] = UT[u * 16384 + e]; dg[g] = DG[u * 128 + k]; }
#pragma unroll
        for (int g = 0; g < HG_NG; ++g) { const size_t u = (size_t)(bh * HG_NG + g); STo[u * 16384 + e] = (bf16)f2bf(s); s = dg[g] * s + ut[g]; }
        a.out[O_HP + (size_t)bh * 16384 + k * 128 + v] = s;
    }
}
__device__ __forceinline__ void hgrn_fix_unit(Ctx& c, ARGREF a, int b, int h, int g) {
    LAS bf16* STt = (LAS bf16*)(c.lds);
    LAS bf16* QCl = (LAS bf16*)(c.lds + 34816);
    LAS float* OB = (LAS float*)(c.lds + 34816 + 17408);
    int tid = c.tid; asm volatile("" : "+v"(tid));
    const int lane = tid & 63, w = c.wave, r32 = lane & 31, hh = lane >> 5;
    const int unit = (b * 6 + h) * HG_NG + g, row0 = b * SEQ + g * 128;
    const bf16* Z = (const bf16*)(a.ws + WS_Z); bf16* MIX = (bf16*)(a.ws + WS_MIX);
    const bf16* QC = (const bf16*)(a.ws + WS_HQC); const float* OL = (const float*)(a.ws + WS_HOL);
    const bf16* stg = (const bf16*)(a.ws + WS_HST) + (size_t)unit * 16384;
    __syncthreads();
#pragma unroll
    for (int i = 0; i < 4; ++i) { const int cidx = tid + 512 * i, v = cidx >> 4, kc = (cidx & 15) * 8; *(LAS v4u*)(STt + v * 136 + kc) = *(const v4u*)(stg + v * 128 + kc); }
    const int te = tid >> 4, k8 = (tid & 15) * 8;
    float onv[8];
#pragma unroll
    for (int j = 0; j < 8; ++j) onv[j] = a.in[15][k8 + j];
#pragma unroll 1
    for (int hf = 0; hf < 2; ++hf) {
        const int rb = row0 + hf * 64;
#pragma unroll
        for (int i = 0; i < 2; ++i) { const int cidx = tid + 512 * i, r = cidx >> 4, kc = (cidx & 15) * 8; *(LAS v4u*)(QCl + r * 136 + kc) = *(const v4u*)(QC + (size_t)(rb + r) * 768 + h * 128 + kc); }
        f32x4 pl0[2], pl1[2]; v4u pgz[2];
#pragma unroll
        for (int ps = 0; ps < 2; ++ps) { const int row = rb + ps * 32 + te; const float* ol = OL + (size_t)row * 768 + h * 128 + k8; pl0[ps] = *(const f32x4*)ol; pl1[ps] = *(const f32x4*)(ol + 4);
            pgz[ps] = *(const v4u*)(Z + (size_t)row * ZC0 + 2304 + h * 128 + k8); }
        __syncthreads();
        { const int rt = w >> 2, vt = w & 3; f32x16 o = {};
          o = mm32<128>(QCl + (rt * 32) * 136, 136, STt + (vt * 32) * 136, 136, o, lane);
#pragma unroll
          for (int r = 0; r < 16; ++r) OB[(rt * 32 + crow(r, hh)) * 128 + vt * 32 + r32] = o[r]; }
        __syncthreads();
#pragma unroll
        for (int ps = 0; ps < 2; ++ps) { const int r = ps * 32 + te, row = rb + r;
            const f32x4 c0 = *(const LAS f32x4*)(OB + r * 128 + k8), c1 = *(const LAS f32x4*)(OB + r * 128 + k8 + 4);
            const f32x4 l0 = pl0[ps], l1 = pl1[ps]; const v4u gz = pgz[ps];
            float ov[8] = {c0.x + l0.x, c0.y + l0.y, c0.z + l0.z, c0.w + l0.w, c1.x + l1.x, c1.y + l1.y, c1.z + l1.z, c1.w + l1.w}; float s = 0.f;
#pragma unroll
            for (int j = 0; j < 8; ++j) s += ov[j] * ov[j];
            s += __shfl_xor(s, 1); s += __shfl_xor(s, 2); s += __shfl_xor(s, 4); s += __shfl_xor(s, 8);
            const float rs = rsqrtf(s * (1.0f / 128.0f) + EPS);
            const unsigned gw_[4] = {gz.x, gz.y, gz.z, gz.w}; float y[8];
#pragma unroll
            for (int j = 0; j < 8; ++j) { const float gg = bf2f((gw_[j >> 1] >> (16 * (j & 1))) & 0xffffu); y[j] = ov[j] * rs * onv[j] * (gg * sigmoidf_(gg)); }
            v4u o; o.x = pk2(y[0], y[1]); o.y = pk2(y[2], y[3]); o.z = pk2(y[4], y[5]); o.w = pk2(y[6], y[7]); *(v4u*)(MIX + (size_t)row * DM + h * 128 + k8) = o; }
        __syncthreads();
    }
}

__device__ __forceinline__ void memkv_finalize_row(ARGREF a, int layer, int row, int lane) {
    const float* src = (const float*)(a.ws + WS_MEMKV) + (size_t)row * 1024 + layer * 512;
    const int hd = lane >> 4, d4 = (lane & 15) * 4;
    const f32x4 k = *(const f32x4*)(src + hd * 64 + d4), v = *(const f32x4*)(src + 256 + hd * 64 + d4);
    float s = (k.x * k.x + k.y * k.y) + (k.z * k.z + k.w * k.w);
    s += __shfl_xor(s, 1); s += __shfl_xor(s, 2); s += __shfl_xor(s, 4); s += __shfl_xor(s, 8);
    const float rs = rsqrtf(s * (1.0f / 64.0f) + EPS); const f32x4 g = *(const f32x4*)(a.in[22] + layer * 64 + d4);
    *(f32x4*)(a.out + O_MK + ((size_t)layer * 1024 + row) * 256 + hd * 64 + d4) = k * rs * g;
    *(f32x4*)(a.out + O_MV + ((size_t)layer * 1024 + row) * 256 + hd * 64 + d4) = v;
}

__device__ __forceinline__ void memattn_prompt_unit(Ctx& c, ARGREF a, int layer, int u) {
    const int blk = u & 15, hd = (u >> 4) & 3, b = u >> 6;
    const bf16* Z = (const bf16*)(a.ws + WS_Z); const int ldz = layer ? ZC1 : ZC0, qc = layer ? Z1_MQ : 3072;
    const float* kv = (const float*)(a.ws + WS_MEMKV) + (size_t)(b * 256) * 1024 + layer * 512 + hd * 64;
    const int row0 = b * SEQ + blk * 256;
    memattn_unit(c, Z + (size_t)row0 * ldz + qc + hd * 64, ldz, 256, kv, kv + 256, 1024, true, a.in[22] + layer * 64, a.in[21] + layer * 64,
                 (bf16*)(a.ws + WS_MIX) + (size_t)row0 * DM + 768 + hd * 64);
}
__device__ __forceinline__ void memattn_sample_unit(Ctx& c, ARGREF a, int layer, int u) {
    const int hd = u & 3, sb = u >> 2;
    const bf16* Z = (const bf16*)(a.ws + WS_Z); const int ldz = layer ? ZC1 : ZC0, qc = layer ? Z1_MQ : 3072;
    const size_t off = ((size_t)(layer * 32 + sb) * 256) * 256 + hd * 64;
    const int row0 = MP + sb * 4;
    memattn_unit(c, Z + (size_t)row0 * ldz + qc + hd * 64, ldz, 4, a.in[5] + off, a.in[6] + off, 256, false, nullptr, a.in[21] + layer * 64,
                 (bf16*)(a.ws + WS_MIX) + (size_t)row0 * DM + 768 + hd * 64);
}

__device__ __forceinline__ void p2_mixer0(Ctx& c, ARGREF a) {
    constexpr int U_HP = 24 * HG_NG, U_MAP = U_HP + 256, U_HS = U_MAP + 192, U_MAS = U_HS + 128, U_FIN = U_MAS + 256;
    for (;;) {
        const int u = q_next(c, 0);
        if (u >= U_FIN) break;
        if (u < U_HP) hgrn_unit<true>(c, a, u / (6 * HG_NG), (u / HG_NG) % 6, u % HG_NG);
        else if (u < U_MAP) memattn_prompt_unit(c, a, 0, u - U_HP);
        else if (u < U_HS) { const int v = u - U_MAP; hgrn_unit<false>(c, a, v / 6, v % 6, 0); }
        else if (u < U_MAS) memattn_sample_unit(c, a, 0, u - U_HS);
        else { const int v = (u - U_MAS) * 8 + c.wave; memkv_finalize_row(a, v >> 10, v & 1023, c.lane); }
    }
}
__device__ __forceinline__ void p2c_hgrn_fix(Ctx& c, ARGREF a) {
    for (int u = c.vcu; u < 24 * HG_NG; u += c.G) hgrn_fix_unit(c, a, u / (6 * HG_NG), (u / HG_NG) % 6, u % HG_NG);
}

constexpr size_t WS_G4 = WS_UP + 64 * MiB, WS_UP2 = WS_UP + 80 * MiB;
__device__ __forceinline__ void conv_fixup_tile(Ctx& c, ARGREF a, int layer, int pm) {
    const float* G4 = (const float*)(a.ws + WS_G4); const float* UP2 = (const float*)(a.ws + WS_UP2); bf16* ACT = (bf16*)(a.ws + WS_ACT);
    const float* cw = a.in[26] + (size_t)layer * 3 * DFF; const float* cb = a.in[27] + (size_t)layer * DFF;
    int tid = c.tid; asm volatile("" : "+v"(tid));
#pragma unroll 1
    for (int i0 = 0; i0 < 12; i0 += 4) {
        f32x4 ut[4], up[4], s1[4], s2[4], w0[4], w1[4], w2[4], bb[4]; int rowv[4], c4v[4]; bool z1[4], z2[4];
#pragma unroll
        for (int j = 0; j < 4; ++j) { const int i = i0 + j < 11 ? i0 + j : 10, idx = tid + 512 * i;
            const int rr = idx / (DFF / 4), c4 = (idx - rr * (DFF / 4)) * 4;
            const int slab = 4 * pm + (rr >> 1), fr = rr & 1, row = slab * 64 + fr, t = row & 4095, sl1 = slab > 0 ? slab - 1 : 0;
            ut[j] = *(const f32x4*)(G4 + (size_t)(slab * 4 + fr) * DFF + c4); up[j] = *(const f32x4*)(UP2 + (size_t)(slab * 2 + fr) * DFF + c4);
            s1[j] = *(const f32x4*)(G4 + (size_t)(fr ? slab * 4 : sl1 * 4 + 3) * DFF + c4);
            s2[j] = *(const f32x4*)(G4 + (size_t)(fr ? sl1 * 4 + 3 : sl1 * 4 + 2) * DFF + c4);
            z1[j] = !fr && t == 0; z2[j] = fr ? t == 1 : t == 0;
            w0[j] = *(const f32x4*)(cw + c4); w1[j] = *(const f32x4*)(cw + DFF + c4); w2[j] = *(const f32x4*)(cw + 2 * DFF + c4); bb[j] = *(const f32x4*)(cb + c4);
            rowv[j] = row; c4v[j] = c4; }
#pragma unroll
        for (int j = 0; j < 4; ++j) { const f32x4 zero = {0.f, 0.f, 0.f, 0.f};
            const f32x4 u1 = z1[j] ? zero : s1[j], u2 = z2[j] ? zero : s2[j];
            const f32x4 cv = bb[j] + w0[j] * u2 + w1[j] * u1 + w2[j] * ut[j];
            const float y0 = cv.x * sigmoidf_(cv.x) * up[j].x, y1 = cv.y * sigmoidf_(cv.y) * up[j].y, y2 = cv.z * sigmoidf_(cv.z) * up[j].z, y3 = cv.w * sigmoidf_(cv.w) * up[j].w;
            *(u64*)(ACT + (size_t)rowv[j] * DFF + c4v[j]) = (u64)pk2(y0, y1) | ((u64)pk2(y2, y3) << 32); }
    }
}


struct SgArgs { const bf16* A; const bf16* Bt; int K; int mode; bf16* Z; int ldz; const float* ssin; const float* resid; const bf16* rb; float* y; bf16* xb; float* ssout; bf16* ACT; float* cvs; const float* cst; const float* cw; const float* cb; };
__device__ __forceinline__ void sgemm_unit(Ctx& c, const SgArgs& g, int n0) {
    int tid = c.tid; asm volatile("" : "+v"(tid));
    const int lane = tid & 63, w = c.wave, r32 = lane & 31, hh = lane >> 5;
    const int K = g.K, ks = K >> 3;
    const int f2 = (n0 >> 1) + (r32 & 15), brow = g.mode == 2 ? (f2 >> 7) * 256 + (f2 & 127) + (r32 >= 16 ? 128 : 0) : n0 + r32;
    const bf16* bp = g.Bt + (size_t)brow * K + w * ks + 8 * hh;
    const bf16* ap = g.A + (size_t)r32 * K + w * ks + 8 * hh;
    f32x16 acc[4] = {};
    bf16x8 afA[4][2], bfA[2], afB[4][2], bfB[2];
#define SG_LOAD(AF, BF, kk) do { _Pragma("unroll") for (int i = 0; i < 2; ++i) { BF[i] = *(const bf16x8*)(bp + (kk) + 16 * i); \
        _Pragma("unroll") for (int rt = 0; rt < 4; ++rt) AF[rt][i] = *(const bf16x8*)(ap + (size_t)(rt * 32) * K + (kk) + 16 * i); } } while (0)
#define SG_MMA(AF, BF) do { _Pragma("unroll") for (int i = 0; i < 2; ++i) _Pragma("unroll") for (int rt = 0; rt < 4; ++rt) acc[rt] = __builtin_amdgcn_mfma_f32_32x32x16_bf16(AF[rt][i], BF[i], acc[rt], 0, 0, 0); } while (0)
    SG_LOAD(afA, bfA, 0);
#pragma unroll 1
    for (int k = 0; k < ks; k += 64) {
        if (k + 32 < ks) SG_LOAD(afB, bfB, k + 32);
        SG_MMA(afA, bfA);
        if (k + 32 < ks) { if (k + 64 < ks) SG_LOAD(afA, bfA, k + 64); SG_MMA(afB, bfB); }
    }
#undef SG_LOAD
#undef SG_MMA
    LAS float* RED = (LAS float*)(c.lds);
    __syncthreads();
#pragma unroll
    for (int rt = 0; rt < 4; ++rt)
#pragma unroll
        for (int r = 0; r < 16; ++r) RED[((w * 4 + rt) * 16 + r) * 64 + lane] = acc[rt][r];
    __syncthreads();
    const int rt = w & 3, rh = w >> 2, col = n0 + r32;
    float v[8];
#pragma unroll
    for (int i = 0; i < 8; ++i) { float s = 0.f;
#pragma unroll
        for (int ww = 0; ww < 8; ++ww) s += RED[((ww * 4 + rt) * 16 + 8 * rh + i) * 64 + lane];
        v[i] = s; }
    if (g.mode == 0) {
#pragma unroll
        for (int i = 0; i < 8; ++i) { const int row = MP + rt * 32 + crow(8 * rh + i, hh); const float rs = rsqrtf(g.ssin[row] * (1.0f / DM) + EPS); g.Z[(size_t)row * g.ldz + col] = (bf16)f2bf(v[i] * rs); }
    } else if (g.mode == 1) {
#pragma unroll
        for (int i = 0; i < 8; ++i) { const int lr = rt * 32 + crow(8 * rh + i, hh), row = MP + lr;
            const float x = v[i] + (g.resid ? g.resid[(size_t)lr * DM + col] : bf2f(g.rb[(size_t)row * DM + col]));
            if (g.y) g.y[(size_t)lr * DM + col] = x; if (g.xb) g.xb[(size_t)row * DM + col] = (bf16)f2bf(x);
            float s = x * x; s += __shfl_xor(s, 1); s += __shfl_xor(s, 2); s += __shfl_xor(s, 4); s += __shfl_xor(s, 8); s += __shfl_xor(s, 16);
            if (g.ssout && r32 == 0) atomicAdd(g.ssout + row, s); }
    } else {
        float gu[8], upv[8];
#pragma unroll
        for (int i = 0; i < 8; ++i) { const int row = MP + rt * 32 + crow(8 * rh + i, hh); gu[i] = v[i] * rsqrtf(g.ssin[row] * (1.0f / DM) + EPS); upv[i] = __shfl_xor(gu[i], 16); }
        if (r32 < 16) { const float w0 = g.cw[f2], w1 = g.cw[DFF + f2], w2 = g.cw[2 * DFF + f2], bb = g.cb[f2];
#pragma unroll
            for (int aa = 0; aa < 2; ++aa) { const int lr0 = rt * 32 + 8 * (2 * rh + aa) + 4 * hh, sb = lr0 >> 2;
                const float s0 = g.cst[(size_t)(sb * 2) * DFF + f2], s1 = g.cst[(size_t)(sb * 2 + 1) * DFF + f2];
                const float u0 = gu[4 * aa], u1 = gu[4 * aa + 1], u2 = gu[4 * aa + 2], u3 = gu[4 * aa + 3];
                const float cv[4] = {bb + w0 * s0 + w1 * s1 + w2 * u0, bb + w0 * s1 + w1 * u0 + w2 * u1, bb + w0 * u0 + w1 * u1 + w2 * u2, bb + w0 * u1 + w1 * u2 + w2 * u3};
#pragma unroll
                for (int t = 0; t < 4; ++t) g.ACT[(size_t)(MP + lr0 + t) * DFF + f2] = (bf16)f2bf(cv[t] * sigmoidf_(cv[t]) * upv[4 * aa + t]);
                g.cvs[(size_t)(sb * 2) * DFF + f2] = u2; g.cvs[(size_t)(sb * 2 + 1) * DFF + f2] = u3; } }
    }
}
template <int NST>
__device__ __forceinline__ void sgemm_unit_r1(Ctx& c, const SgArgs& g, int n0, int rt) {
    int tid = c.tid; asm volatile("" : "+v"(tid));
    const int lane = tid & 63, w = c.wave, r32 = lane & 31, hh = lane >> 5;
    const int K = g.K, ks = K >> 3;
    const bf16* bp = g.Bt + (size_t)(n0 + r32) * K + w * ks + 8 * hh;
    const bf16* ap = g.A + (size_t)(rt * 32 + r32) * K + w * ks + 8 * hh;
    f32x16 acc = {};
    bf16x8 af[NST][2], bf_[NST][2];
#pragma unroll
    for (int s = 0; s < NST; ++s)
#pragma unroll
        for (int i = 0; i < 2; ++i) { af[s][i] = *(const bf16x8*)(ap + 32 * s + 16 * i); bf_[s][i] = *(const bf16x8*)(bp + 32 * s + 16 * i); }
#pragma unroll
    for (int s = 0; s < NST; ++s)
#pragma unroll
        for (int i = 0; i < 2; ++i) acc = __builtin_amdgcn_mfma_f32_32x32x16_bf16(af[s][i], bf_[s][i], acc, 0, 0, 0);
    LAS float* RED = (LAS float*)(c.lds);
    __syncthreads();
#pragma unroll
    for (int r = 0; r < 16; ++r) RED[(w * 16 + r) * 64 + lane] = acc[r];
    __syncthreads();
    const int col = n0 + r32;
#pragma unroll
    for (int i = 0; i < 2; ++i) { float v = 0.f;
#pragma unroll
        for (int ww = 0; ww < 8; ++ww) v += RED[(ww * 16 + 2 * w + i) * 64 + lane];
        const int lr = rt * 32 + crow(2 * w + i, hh), row = MP + lr;
        const float x = v + (g.resid ? g.resid[(size_t)lr * DM + col] : bf2f(g.rb[(size_t)row * DM + col]));
        if (g.y) g.y[(size_t)lr * DM + col] = x; if (g.xb) g.xb[(size_t)row * DM + col] = (bf16)f2bf(x);
        float s = x * x; s += __shfl_xor(s, 1); s += __shfl_xor(s, 2); s += __shfl_xor(s, 4); s += __shfl_xor(s, 8); s += __shfl_xor(s, 16);
        if (g.ssout && r32 == 0) atomicAdd(g.ssout + row, s); }
}
__device__ __forceinline__ void sgemm_phase(Ctx& c, const SgArgs& g, int N, int nidle) {
    const int r = c.G - 1 - (int)blockIdx.x; if (r >= nidle) return;
    if (g.mode == 1) {
#pragma unroll 1
        for (int u = r; u < (N / 32) * 4; u += nidle) { if (g.K == 1024) sgemm_unit_r1<4>(c, g, (u % (N / 32)) * 32, u / (N / 32)); else sgemm_unit_r1<DFF / 256>(c, g, (u % (N / 32)) * 32, u / (N / 32)); }
        return; }
#pragma unroll 1
    for (int u = r; u < N / 32; u += nidle) sgemm_unit(c, g, u * 32);
}


__device__ __forceinline__ float wave_sum_f(float x) {
    x += __builtin_bit_cast(float, __builtin_amdgcn_update_dpp(0, __builtin_bit_cast(int, x), 0xB1, 0xF, 0xF, false));
    x += __builtin_bit_cast(float, __builtin_amdgcn_update_dpp(0, __builtin_bit_cast(int, x), 0x4E, 0xF, 0xF, false));
    x += __builtin_bit_cast(float, __builtin_amdgcn_update_dpp(0, __builtin_bit_cast(int, x), 0x141, 0xF, 0xF, false));
    x += __builtin_bit_cast(float, __builtin_amdgcn_update_dpp(0, __builtin_bit_cast(int, x), 0x140, 0xF, 0xF, false));
    const int xi = __builtin_bit_cast(int, x);
    return (__builtin_bit_cast(float, __builtin_amdgcn_readlane(xi, 0)) + __builtin_bit_cast(float, __builtin_amdgcn_readlane(xi, 16))) +
           (__builtin_bit_cast(float, __builtin_amdgcn_readlane(xi, 32)) + __builtin_bit_cast(float, __builtin_amdgcn_readlane(xi, 48)));
}
__device__ __forceinline__ float sum8_dpp(float x) {
    x += __builtin_bit_cast(float, __builtin_amdgcn_update_dpp(0, __builtin_bit_cast(int, x), 0xB1, 0xF, 0xF, false));
    x += __builtin_bit_cast(float, __builtin_amdgcn_update_dpp(0, __builtin_bit_cast(int, x), 0x4E, 0xF, 0xF, false));
    x += __builtin_bit_cast(float, __builtin_amdgcn_update_dpp(0, __builtin_bit_cast(int, x), 0x141, 0xF, 0xF, false));
    return x;
}
__device__ __forceinline__ void unpack8(v4u q, float (&x)[8]) {
    x[0] = bf2f(q.x & 0xffffu); x[1] = bf2f(q.x >> 16); x[2] = bf2f(q.y & 0xffffu); x[3] = bf2f(q.y >> 16); x[4] = bf2f(q.z & 0xffffu); x[5] = bf2f(q.z >> 16); x[6] = bf2f(q.w & 0xffffu); x[7] = bf2f(q.w >> 16);
}
__device__ __forceinline__ void dsa_post_row(ARGREF a, int row, int lane_, LAS float* tb) {
    int lane = lane_; asm volatile("" : "+v"(lane));
    const bf16* z = (const bf16*)(a.ws + WS_Z) + (size_t)row * ZC1;
    const bool smp = row >= MP; const int b = smp ? (row - MP) >> 2 : row >> 12, t = smp ? (row - MP) & 3 : row & 4095;
    const float pos = (float)(smp ? PAST + t : t);
    const int hd = lane >> 3, c8 = (lane & 7) * 8, c4 = (lane & 7) * 4;
    const v4u xa = *(const v4u*)(z + hd * 128 + c8), xb = *(const v4u*)(z + hd * 128 + 64 + c8);
    const u64 vv = *(const u64*)(z + Z1_V + 4 * lane);
    const u64 qa = *(const u64*)(z + Z1_IQ + hd * 64 + c4), qb = *(const u64*)(z + Z1_IQ + hd * 64 + 32 + c4);
    const u64 ka = *(const u64*)(z + Z1_IK + c4), kb_ = *(const u64*)(z + Z1_IK + 32 + c4);
    const float wraw = bf2f(z[Z1_IW + (lane & 7)]);
    const float* gp = hd < 6 ? a.in[17] : a.in[18];
    const f32x4 g1a = *(const f32x4*)(gp + c8), g1b = *(const f32x4*)(gp + c8 + 4), g2a = *(const f32x4*)(gp + 64 + c8), g2b = *(const f32x4*)(gp + 64 + c8 + 4);
    const f32x4 gk1 = *(const f32x4*)(a.in[19] + c4), gk2 = *(const f32x4*)(a.in[19] + 32 + c4);
    {
        const float r1 = pos * (exp2f(-(float)lane * (13.287712379549449f / 64.0f)) * 0.15915494309189535f), f1 = r1 - floorf(r1);
        tb[lane] = __builtin_amdgcn_cosf(f1); tb[64 + lane] = __builtin_amdgcn_sinf(f1);
        const float r2 = pos * (exp2f(-(float)(lane & 31) * (13.287712379549449f / 32.0f)) * 0.15915494309189535f), f2 = r2 - floorf(r2);
        if (lane < 32) { tb[128 + lane] = __builtin_amdgcn_cosf(f2); tb[160 + lane] = __builtin_amdgcn_sinf(f2); } }
    {
        float x1[8], x2[8]; unpack8(xa, x1); unpack8(xb, x2);
        float s = 0.f;
#pragma unroll
        for (int j = 0; j < 8; ++j) s += x1[j] * x1[j] + x2[j] * x2[j];
        const float rs = rsqrtf(sum8_dpp(s) * (1.0f / 128.0f) + EPS);
        const f32x4 ca = *(const LAS f32x4*)(tb + c8), cb = *(const LAS f32x4*)(tb + c8 + 4), sa = *(const LAS f32x4*)(tb + 64 + c8), sb = *(const LAS f32x4*)(tb + 64 + c8 + 4);
        const float cs[8] = {ca.x, ca.y, ca.z, ca.w, cb.x, cb.y, cb.z, cb.w}, sn[8] = {sa.x, sa.y, sa.z, sa.w, sb.x, sb.y, sb.z, sb.w};
        const float g1[8] = {g1a.x, g1a.y, g1a.z, g1a.w, g1b.x, g1b.y, g1b.z, g1b.w}, g2[8] = {g2a.x, g2a.y, g2a.z, g2a.w, g2b.x, g2b.y, g2b.z, g2b.w};
        float o1[8], o2[8];
#pragma unroll
        for (int j = 0; j < 8; ++j) { const float y1 = x1[j] * rs * g1[j], y2 = x2[j] * rs * g2[j]; o1[j] = y1 * cs[j] - y2 * sn[j]; o2[j] = y2 * cs[j] + y1 * sn[j]; }
        v4u p1, p2; p1.x = pk2(o1[0], o1[1]); p1.y = pk2(o1[2], o1[3]); p1.z = pk2(o1[4], o1[5]); p1.w = pk2(o1[6], o1[7]); p2.x = pk2(o2[0], o2[1]); p2.y = pk2(o2[2], o2[3]); p2.z = pk2(o2[4], o2[5]); p2.w = pk2(o2[6], o2[7]);
        if (hd < 6) {
            if (smp) { float* q = (float*)(a.ws + WS_SQ) + (size_t)(row - MP) * 768 + hd * 128 + c8;
                *(f32x4*)q = (f32x4){o1[0], o1[1], o1[2], o1[3]}; *(f32x4*)(q + 4) = (f32x4){o1[4], o1[5], o1[6], o1[7]}; *(f32x4*)(q + 64) = (f32x4){o2[0], o2[1], o2[2], o2[3]}; *(f32x4*)(q + 68) = (f32x4){o2[4], o2[5], o2[6], o2[7]}; }
            else { bf16* q = (bf16*)(a.ws + WS_QB) + ((size_t)(b * 6 + hd) * SEQ + t) * 128 + c8; *(v4u*)q = p1; *(v4u*)(q + 64) = p2; }
        } else {
            const int kvh = hd - 6;
            float* ko = (smp ? a.out + O_KS + (size_t)(row - MP) * 256 : a.out + O_KP + (size_t)row * 256) + kvh * 128 + c8;
            *(f32x4*)ko = (f32x4){o1[0], o1[1], o1[2], o1[3]}; *(f32x4*)(ko + 4) = (f32x4){o1[4], o1[5], o1[6], o1[7]}; *(f32x4*)(ko + 64) = (f32x4){o2[0], o2[1], o2[2], o2[3]}; *(f32x4*)(ko + 68) = (f32x4){o2[4], o2[5], o2[6], o2[7]};
            if (!smp) { bf16* kb = (bf16*)(a.ws + WS_KB) + ((size_t)(b * 2 + kvh) * SEQ + t) * 128 + c8; *(v4u*)kb = p1; *(v4u*)(kb + 64) = p2; }
        }
    }
    {
        const f32x4 v = {bf2f((unsigned)vv & 0xffffu), bf2f(((unsigned)vv) >> 16), bf2f((unsigned)(vv >> 32) & 0xffffu), bf2f((unsigned)(vv >> 48))};
        float* vo = smp ? a.out + O_VS + (size_t)(row - MP) * 256 : a.out + O_VP + (size_t)row * 256;
        *(f32x4*)(vo + 4 * lane) = v;
        if (!smp) { const int kvh = lane >> 5, dd = (lane & 31) * 4; *(u64*)((bf16*)(a.ws + WS_VB) + ((size_t)(b * 2 + kvh) * SEQ + t) * 128 + dd) = vv; }
    }
    const f32x4 c6 = *(const LAS f32x4*)(tb + 128 + c4), s6 = *(const LAS f32x4*)(tb + 160 + c4);
    {
        const float x1[4] = {bf2f((unsigned)qa & 0xffffu), bf2f(((unsigned)qa) >> 16), bf2f((unsigned)(qa >> 32) & 0xffffu), bf2f((unsigned)(qa >> 48))};
        const float x2[4] = {bf2f((unsigned)qb & 0xffffu), bf2f(((unsigned)qb) >> 16), bf2f((unsigned)(qb >> 32) & 0xffffu), bf2f((unsigned)(qb >> 48))};
        float o1[4], o2[4];
#pragma unroll
        for (int j = 0; j < 4; ++j) { o1[j] = x1[j] * c6[j] - x2[j] * s6[j]; o2[j] = x2[j] * c6[j] + x1[j] * s6[j]; }
        if (smp) { float* q = (float*)(a.ws + WS_SIQ) + (size_t)(row - MP) * 512 + hd * 64 + c4; *(f32x4*)q = (f32x4){o1[0], o1[1], o1[2], o1[3]}; *(f32x4*)(q + 32) = (f32x4){o2[0], o2[1], o2[2], o2[3]}; }
        else { bf16* q = (bf16*)(a.ws + WS_IQB) + (size_t)row * 512 + hd * 64 + c4; *(u64*)q = (u64)pk2(o1[0], o1[1]) | ((u64)pk2(o1[2], o1[3]) << 32); *(u64*)(q + 32) = (u64)pk2(o2[0], o2[1]) | ((u64)pk2(o2[2], o2[3]) << 32); }
    }
    {
        const float x1[4] = {bf2f((unsigned)ka & 0xffffu), bf2f(((unsigned)ka) >> 16), bf2f((unsigned)(ka >> 32) & 0xffffu), bf2f((unsigned)(ka >> 48))};
        const float x2[4] = {bf2f((unsigned)kb_ & 0xffffu), bf2f(((unsigned)kb_) >> 16), bf2f((unsigned)(kb_ >> 32) & 0xffffu), bf2f((unsigned)(kb_ >> 48))};
        float s = 0.f;
#pragma unroll
        for (int j = 0; j < 4; ++j) s += x1[j] * x1[j] + x2[j] * x2[j];
        const float rs = rsqrtf(sum8_dpp(s) * (1.0f / 64.0f) + EPS);
        float o1[4], o2[4];
#pragma unroll
        for (int j = 0; j < 4; ++j) { const float y1 = x1[j] * rs * gk1[j], y2 = x2[j] * rs * gk2[j]; o1[j] = y1 * c6[j] - y2 * s6[j]; o2[j] = y2 * c6[j] + y1 * s6[j]; }
        if (lane < 8) {
            float* ko = (smp ? a.out + O_IKS + (size_t)(row - MP) * 64 : a.out + O_IKP + (size_t)row * 64) + c4; *(f32x4*)ko = (f32x4){o1[0], o1[1], o1[2], o1[3]}; *(f32x4*)(ko + 32) = (f32x4){o2[0], o2[1], o2[2], o2[3]};
            if (!smp) { bf16* kb = (bf16*)(a.ws + WS_IKB) + (size_t)row * 64 + c4; *(u64*)kb = (u64)pk2(o1[0], o1[1]) | ((u64)pk2(o1[2], o1[3]) << 32); *(u64*)(kb + 32) = (u64)pk2(o2[0], o2[1]) | ((u64)pk2(o2[2], o2[3]) << 32); }
            const float wv = wraw * (0.35355339059327373f * 0.125f);
            if (smp) ((float*)(a.ws + WS_SIW))[(row - MP) * 8 + lane] = wv; else ((float*)(a.ws + WS_IW))[(size_t)row * 8 + lane] = wv; }
    }
}
__device__ __forceinline__ void p8_dsa_post(Ctx& c, ARGREF a) {
    constexpr int NRB = (MVALID + 63) / 64;
    for (;;) { const int u = q_next(c, 1); if (u >= 384 + NRB) break;
        if (u < 256) memattn_prompt_unit(c, a, 1, u);
        else if (u < 256 + NRB) { const int r0 = (u - 256) * 64 + c.wave;
#pragma unroll 1
            for (int i = 0; i < 8; ++i) { const int row = r0 + 8 * i; if (row < MVALID) dsa_post_row(a, row, c.lane, (LAS float*)(c.lds) + c.wave * 256); } }
        else memattn_sample_unit(c, a, 1, u - 256 - NRB); }
}

__device__ __forceinline__ void idx_prompt_unit(Ctx& c, ARGREF a, int b, int qb) {
    int tid = c.tid; asm volatile("" : "+v"(tid));
    const int lane = tid & 63, r32 = lane & 31, hh = lane >> 5, w = c.wave;
    const int q0 = b * SEQ + qb * 32;
    LAS bf16* IQL = (LAS bf16*)(c.lds);
    const bf16* IK = (const bf16*)(a.ws + WS_IKB) + (size_t)(b * SEQ) * 64 + (size_t)r32 * 64 + 8 * hh;
    float* SC = (float*)(a.ws + WS_SC) + (size_t)(q0 + r32) * SEQ;
    float wv[8];
    bf16x8 ak[4], an[4];
    if (w <= qb) {
#pragma unroll
        for (int ks = 0; ks < 4; ++ks) ak[ks] = *(const bf16x8*)(IK + (size_t)(w * 32) * 64 + ks * 16); }
#pragma unroll
    for (int h = 0; h < 8; ++h) wv[h] = ((const float*)(a.ws + WS_IW))[(size_t)(q0 + r32) * 8 + h];
    { const bf16* src = (const bf16*)(a.ws + WS_IQB) + (size_t)q0 * 512;
#pragma unroll
      for (int i = 0; i < 4; ++i) { const int row = tid >> 4, ch = (tid & 15) + 16 * i; *(LAS v4u*)(IQL + row * 520 + ch * 8) = *(const v4u*)(src + (size_t)row * 512 + ch * 8); } }
    __syncthreads();
#pragma unroll 1
    for (int kt = w; kt <= qb; kt += 8) {
        if (kt + 8 <= qb) {
#pragma unroll
            for (int ks = 0; ks < 4; ++ks) an[ks] = *(const bf16x8*)(IK + (size_t)((kt + 8) * 32) * 64 + ks * 16); }
        f32x16 sc = {};
        int qoff = r32 * 520 + 8 * hh; asm volatile("" : "+v"(qoff));
#pragma unroll
        for (int h = 0; h < 8; ++h) { f32x16 d = {};
#pragma unroll
            for (int ks = 0; ks < 4; ++ks) d = __builtin_amdgcn_mfma_f32_32x32x16_bf16(ak[ks], *(const LAS bf16x8*)(IQL + qoff + h * 64 + ks * 16), d, 0, 0, 0);
#pragma unroll
            for (int r = 0; r < 16; ++r) sc[r] = fmaf(wv[h], fmaxf(d[r], 0.f), sc[r]); }
        {
            LAS float* TP = (LAS float*)(c.lds + 36864) + w * (32 * 36);
#pragma unroll
            for (int g = 0; g < 4; ++g) *(LAS f32x4*)(TP + r32 * 36 + 8 * g + 4 * hh) = (f32x4){sc[4 * g], sc[4 * g + 1], sc[4 * g + 2], sc[4 * g + 3]};
            float* SCt = (float*)(a.ws + WS_SC) + (size_t)q0 * SEQ + kt * 32 + (lane & 7) * 4;
#pragma unroll
            for (int ps = 0; ps < 4; ++ps) { const int rr = (lane >> 3) + 8 * ps; *(f32x4*)(SCt + (size_t)rr * SEQ) = *(const LAS f32x4*)(TP + rr * 36 + (lane & 7) * 4); } }
#pragma unroll
        for (int ks = 0; ks < 4; ++ks) ak[ks] = an[ks];
    }
}
__device__ __forceinline__ v4u pack8f(const float* p) { const f32x4 x = *(const f32x4*)p, y = *(const f32x4*)(p + 4); v4u o; o.x = pk2(x.x, x.y); o.y = pk2(x.z, x.w); o.z = pk2(y.x, y.y); o.w = pk2(y.z, y.w); return o; }
__device__ __forceinline__ void idx_sample_tile(ARGREF a, int sb, int tl, int lane_) {
    int lane = lane_; asm volatile("" : "+v"(lane));
    const int r32 = lane & 31, hh = lane >> 5, tk = r32 >> 3, hd = r32 & 7;
    const float* iq = (const float*)(a.ws + WS_SIQ) + (size_t)(sb * 4 + tk) * 512 + hd * 64 + 8 * hh;
    const float wv = ((const float*)(a.ws + WS_SIW))[(sb * 4 + tk) * 8 + hd];
    const float* src;
    if (tl < 256) src = a.in[4] + ((size_t)a.page_table[sb * 64 + (tl >> 2)] * 128 + (tl & 3) * 32 + r32) * 64 + 8 * hh;
    else src = a.out + O_IKS + (size_t)(sb * 4 + (r32 & 3)) * 64 + 8 * hh;
    v4u af[4], bf_[4];
#pragma unroll
    for (int ks = 0; ks < 4; ++ks) { af[ks] = pack8f(src + 16 * ks); bf_[ks] = pack8f(iq + 16 * ks); }
    if (tl == 256 && r32 >= 4) {
#pragma unroll
        for (int ks = 0; ks < 4; ++ks) af[ks] = (v4u){0u, 0u, 0u, 0u}; }
    f32x16 d = {};
#pragma unroll
    for (int ks = 0; ks < 4; ++ks) d = __builtin_amdgcn_mfma_f32_32x32x16_bf16(__builtin_bit_cast(bf16x8, af[ks]), __builtin_bit_cast(bf16x8, bf_[ks]), d, 0, 0, 0);
    float* dst = (float*)(a.ws + WS_SSC) + (size_t)(sb * 4 + tk) * SSC_LD + tl * 32;
#pragma unroll
    for (int r = 0; r < 16; ++r) { float v = wv * fmaxf(d[r], 0.f);
        v += __builtin_bit_cast(float, __builtin_amdgcn_update_dpp(0, __builtin_bit_cast(int, v), 0xB1, 0xF, 0xF, false));
        v += __builtin_bit_cast(float, __builtin_amdgcn_update_dpp(0, __builtin_bit_cast(int, v), 0x4E, 0xF, 0xF, false));
        v += __builtin_bit_cast(float, __builtin_amdgcn_update_dpp(0, __builtin_bit_cast(int, v), 0x141, 0xF, 0xF, false));
        if (hd == 0) dst[crow(r, hh)] = v; }
}
__device__ __forceinline__ void idx_sample_page(ARGREF a, int sb, int g, int lane_) {
    int lane = lane_; asm volatile("" : "+v"(lane));
    const int r32 = lane & 31, hh = lane >> 5, tk = r32 >> 3, hd = r32 & 7;
    const float* iq = (const float*)(a.ws + WS_SIQ) + (size_t)(sb * 4 + tk) * 512 + hd * 64 + 8 * hh;
    const float wv = ((const float*)(a.ws + WS_SIW))[(sb * 4 + tk) * 8 + hd];
    const float* src = a.in[4] + ((size_t)a.page_table[sb * 64 + g] * 128 + r32) * 64 + 8 * hh;
    f32x4 kr[4][8], qr[8];
#pragma unroll
    for (int t = 0; t < 4; ++t)
#pragma unroll
        for (int ks = 0; ks < 4; ++ks) { kr[t][2 * ks] = *(const f32x4*)(src + (size_t)t * 32 * 64 + 16 * ks); kr[t][2 * ks + 1] = *(const f32x4*)(src + (size_t)t * 32 * 64 + 16 * ks + 4); }
#pragma unroll
    for (int ks = 0; ks < 4; ++ks) { qr[2 * ks] = *(const f32x4*)(iq + 16 * ks); qr[2 * ks + 1] = *(const f32x4*)(iq + 16 * ks + 4); }
    v4u bf_[4];
#pragma unroll
    for (int ks = 0; ks < 4; ++ks) { const f32x4 x = qr[2 * ks], y = qr[2 * ks + 1]; bf_[ks].x = pk2(x.x, x.y); bf_[ks].y = pk2(x.z, x.w); bf_[ks].z = pk2(y.x, y.y); bf_[ks].w = pk2(y.z, y.w); }
    float* dst = (float*)(a.ws + WS_SSC) + (size_t)(sb * 4 + tk) * SSC_LD + g * 128;
#pragma unroll
    for (int t = 0; t < 4; ++t) { f32x16 d = {};
#pragma unroll
        for (int ks = 0; ks < 4; ++ks) { const f32x4 x = kr[t][2 * ks], y = kr[t][2 * ks + 1]; v4u af; af.x = pk2(x.x, x.y); af.y = pk2(x.z, x.w); af.z = pk2(y.x, y.y); af.w = pk2(y.z, y.w);
            d = __builtin_amdgcn_mfma_f32_32x32x16_bf16(__builtin_bit_cast(bf16x8, af), __builtin_bit_cast(bf16x8, bf_[ks]), d, 0, 0, 0); }
        float vv[16];
#pragma unroll
        for (int r = 0; r < 16; ++r) { float v = wv * fmaxf(d[r], 0.f);
            v += __builtin_bit_cast(float, __builtin_amdgcn_update_dpp(0, __builtin_bit_cast(int, v), 0xB1, 0xF, 0xF, false));
            v += __builtin_bit_cast(float, __builtin_amdgcn_update_dpp(0, __builtin_bit_cast(int, v), 0x4E, 0xF, 0xF, false));
            v += __builtin_bit_cast(float, __builtin_amdgcn_update_dpp(0, __builtin_bit_cast(int, v), 0x141, 0xF, 0xF, false));
            vv[r] = v; }
        if (hd == 0) {
#pragma unroll
            for (int g = 0; g < 4; ++g) *(f32x4*)(dst + t * 32 + 8 * g + 4 * hh) = (f32x4){vv[4 * g], vv[4 * g + 1], vv[4 * g + 2], vv[4 * g + 3]}; } }
}
__device__ __forceinline__ void p9_indexer(Ctx& c, ARGREF a) {
    const int gw = c.vcu * NWAVES + c.wave, NGW = c.G * NWAVES;
#pragma unroll 1
    for (int e = gw; e < 32 * 64; e += NGW) { idx_sample_page(a, e >> 6, e & 63, c.lane); if ((e & 63) == 63) idx_sample_tile(a, e >> 6, 256, c.lane); }
    for (;;) { const int u = q_next(c, 2); if (u >= 512) break; idx_prompt_unit(c, a, u & 3, 127 - (u >> 2)); }
}


#ifndef TKREP_C
#define TKREP_C 1
#endif
#ifndef TKREP_D
#define TKREP_D 1
#endif
__device__ __forceinline__ unsigned fkey(float f) { const unsigned u = __builtin_bit_cast(unsigned, f + 0.0f); return (u & 0x80000000u) ? ~u : (u | 0x80000000u); }
__device__ __forceinline__ void acc_ge(int& cnt, unsigned key, unsigned cand) { asm volatile("v_cmp_le_u32_e32 vcc, %1, %2\n\tv_addc_co_u32_e32 %0, vcc, 0, %0, vcc" : "+v"(cnt) : "s"(cand), "v"(key) : "vcc"); }
__device__ __forceinline__ void acc_ge4(int& c0, int& c1, int& c2, int& c3, unsigned k0, unsigned k1, unsigned k2, unsigned k3, unsigned cand) {
    u64 m0, m1, m2, m3;
    asm volatile("v_cmp_le_u32_e64 %4, %8, %9\n\tv_cmp_le_u32_e64 %5, %8, %10\n\tv_cmp_le_u32_e64 %6, %8, %11\n\tv_cmp_le_u32_e64 %7, %8, %12\n\t"
                 "v_addc_co_u32_e64 %0, %4, 0, %0, %4\n\tv_addc_co_u32_e64 %1, %5, 0, %1, %5\n\tv_addc_co_u32_e64 %2, %6, 0, %2, %6\n\tv_addc_co_u32_e64 %3, %7, 0, %3, %7"
                 : "+v"(c0), "+v"(c1), "+v"(c2), "+v"(c3), "=&s"(m0), "=&s"(m1), "=&s"(m2), "=&s"(m3) : "s"(cand), "v"(k0), "v"(k1), "v"(k2), "v"(k3));
}
__device__ __forceinline__ u64 ballot_nz(unsigned v) { u64 m; asm volatile("v_cmp_ne_u32_e64 %0, 0, %1" : "=s"(m) : "v"(v)); return m; }
__device__ __forceinline__ int wave_sum_dpp(int x) {
    x += __builtin_amdgcn_update_dpp(0, x, 0xB1, 0xF, 0xF, false);
    x += __builtin_amdgcn_update_dpp(0, x, 0x4E, 0xF, 0xF, false);
    x += __builtin_amdgcn_update_dpp(0, x, 0x141, 0xF, 0xF, false);
    x += __builtin_amdgcn_update_dpp(0, x, 0x140, 0xF, 0xF, false);
    return (__builtin_amdgcn_readlane(x, 0) + __builtin_amdgcn_readlane(x, 16)) + (__builtin_amdgcn_readlane(x, 32) + __builtin_amdgcn_readlane(x, 48));
}
__device__ __forceinline__ int mbcnt64(u64 m) { return (int)__builtin_amdgcn_mbcnt_hi((unsigned)(m >> 32), __builtin_amdgcn_mbcnt_lo((unsigned)m, 0u)); }
constexpr int TK_LOWBITS = 18;
__device__ __forceinline__ void topk_finish(unsigned ck, int cp, int A, int posmax, unsigned& T, int& P, int nbits = TK_LOWBITS) {
#pragma unroll 1
    for (int bit = nbits - 1; bit >= 0; --bit) { const unsigned cand = T | (1u << bit); if (A + __builtin_popcountll(__ballot(ck >= cand)) >= 256) T = cand; }
    const int need = 256 - (A + __builtin_popcountll(__ballot(ck > T))), ceq = __builtin_popcountll(__ballot(ck == T));
    P = posmax;
    if (ceq != need) { P = 0;
#pragma unroll 1
        for (int bit = 13; bit >= 0; --bit) { const int cand = P | (1 << bit); if (__builtin_popcountll(__ballot(ck == T && cp < cand)) < need) P = cand; } }
}
__device__ __forceinline__ unsigned wave_min_u(unsigned x) {
    x = min(x, (unsigned)__builtin_amdgcn_update_dpp(0, (int)x, 0xB1, 0xF, 0xF, false)); x = min(x, (unsigned)__builtin_amdgcn_update_dpp(0, (int)x, 0x4E, 0xF, 0xF, false));
    x = min(x, (unsigned)__builtin_amdgcn_update_dpp(0, (int)x, 0x141, 0xF, 0xF, false)); x = min(x, (unsigned)__builtin_amdgcn_update_dpp(0, (int)x, 0x140, 0xF, 0xF, false));
    return min(min((unsigned)__builtin_amdgcn_readlane((int)x, 0), (unsigned)__builtin_amdgcn_readlane((int)x, 16)), min((unsigned)__builtin_amdgcn_readlane((int)x, 32), (unsigned)__builtin_amdgcn_readlane((int)x, 48)));
}
__device__ __forceinline__ unsigned wave_max_u(unsigned x) {
    x = max(x, (unsigned)__builtin_amdgcn_update_dpp(0, (int)x, 0xB1, 0xF, 0xF, false)); x = max(x, (unsigned)__builtin_amdgcn_update_dpp(0, (int)x, 0x4E, 0xF, 0xF, false));
    x = max(x, (unsigned)__builtin_amdgcn_update_dpp(0, (int)x, 0x141, 0xF, 0xF, false)); x = max(x, (unsigned)__builtin_amdgcn_update_dpp(0, (int)x, 0x140, 0xF, 0xF, false));
    return max(max((unsigned)__builtin_amdgcn_readlane((int)x, 0), (unsigned)__builtin_amdgcn_readlane((int)x, 16)), max((unsigned)__builtin_amdgcn_readlane((int)x, 32), (unsigned)__builtin_amdgcn_readlane((int)x, 48)));
}
template <int NJ>
__device__ __forceinline__ void topk_prompt_row(ARGREF a, const float* SCb, int row, int lane, LAS unsigned* cl) {
        const int t = row & 4095;
        u64* mk = (u64*)(a.ws + WS_MASK) + (size_t)row * 64;
        unsigned key[NJ];
        { const float* sc_ = SCb + (size_t)row * SEQ + lane; const int tj_ = t >> 6;
          float v[NJ];
#pragma unroll
          for (int j = 0; j < NJ; ++j) v[j] = sc_[64 * (j < tj_ ? j : tj_)];
          const u64 dmask = (2ull << (t & 63)) - 1ull;
#pragma unroll
          for (int j = 0; j < NJ; ++j) { const int u = __builtin_bit_cast(int, v[j] + 0.0f); const unsigned k = (unsigned)u ^ ((unsigned)(u >> 31) | 0x80000000u);
              const u64 vm = j < tj_ ? ~0ull : (j == tj_ ? dmask : 0ull); asm("v_cndmask_b32_e64 %0, 0, %1, %2" : "=v"(key[j]) : "v"(k), "s"(vm)); } }
        unsigned kh[NJ];
#pragma unroll
        for (int j = 0; j < NJ; ++j) { kh[j] = key[j] >> 1; asm volatile("" : "+v"(kh[j])); }
        unsigned T; int hb;
        {
            unsigned b0 = 0u, b1 = 0u, b2 = 0u, b3 = 0u;
#pragma unroll
            for (int j = 0; j < NJ; ++j) { const unsigned x = key[j]; unsigned n1, n2, n3;
                asm("v_med3_u32 %0, %1, %2, %3" : "=v"(n3) : "v"(b2), "v"(b3), "v"(x)); asm("v_med3_u32 %0, %1, %2, %3" : "=v"(n2) : "v"(b1), "v"(b2), "v"(x)); asm("v_med3_u32 %0, %1, %2, %3" : "=v"(n1) : "v"(b0), "v"(b1), "v"(x));
                b0 = max(b0, x); b1 = n1; b2 = n2; b3 = n3; }
            const unsigned L = wave_min_u(b3), H = wave_max_u(b3), df = L ^ H;
            hb = df ? 31 - __builtin_clz(df) : -1;
            T = hb >= 31 ? 0u : (L & ~((2u << (hb < 0 ? 0 : hb)) - 1u)); if (hb < 0) T = L;
        }
#define TK_FULLCOUNT(CAND, OUT) do { const unsigned cs_ = __builtin_amdgcn_readfirstlane(CAND); int c0_ = 0, c1_ = 0, c2_ = 0, c3_ = 0; \
        _Pragma("unroll") for (int j = 0; j < NJ; j += 4) acc_ge4(c0_, c1_, c2_, c3_, key[j], key[j + 1], key[j + 2], key[j + 3], cs_); OUT = wave_sum_dpp((c0_ + c1_) + (c2_ + c3_)); } while (0)
#define TK_FASTCOUNT(CAND, OUT, PC) do { const unsigned ch_ = __builtin_amdgcn_readfirstlane((CAND) >> 1); unsigned a_[8] = {0u, 0u, 0u, 0u, 0u, 0u, 0u, 0u}; \
        _Pragma("unroll") for (int j = 0; j < NJ; j += 8) { unsigned d_[8]; _Pragma("unroll") for (int i = 0; i < 8; ++i) d_[i] = kh[j + i] - ch_; \
            _Pragma("unroll") for (int i = 0; i < 8; ++i) a_[i] = __builtin_amdgcn_alignbit(a_[i], d_[i], 31); } \
        PC = ((__builtin_popcount(a_[0]) + __builtin_popcount(a_[1])) + (__builtin_popcount(a_[2]) + __builtin_popcount(a_[3]))) + \
             ((__builtin_popcount(a_[4]) + __builtin_popcount(a_[5])) + (__builtin_popcount(a_[6]) + __builtin_popcount(a_[7]))); OUT = 64 * NJ - wave_sum_dpp(PC); } while (0)
        int nb = hb + 1, clo = -1, chi = -1, pclo = 0, pchi = NJ;
#pragma unroll 1
        while (nb > 1 && (clo < 0 || chi < 0 || clo - chi > 64)) { const int bit = nb - 1; const unsigned cand = T | (1u << bit); int tot, pc; TK_FASTCOUNT(cand, tot, pc); if (tot >= 256) { T = cand; clo = tot; pclo = pc; } else { chi = tot; pchi = pc; } nb = bit; }
        int A = 0, cT = 4096;
        if (nb >= 1) { const unsigned hib = T + (1u << nb); if (chi >= 0) A = chi; else if (hib != 0u) TK_FASTCOUNT(hib, A, pchi); if (clo >= 0) cT = clo; else TK_FASTCOUNT(T, cT, pclo); }
#undef TK_FASTCOUNT
        int P;
        if (cT - A <= 64) {
            const unsigned bw = 1u << nb; const int mine = pchi - pclo;
            int inc = mine;
            inc += __builtin_amdgcn_update_dpp(0, inc, 0x111, 0xF, 0xF, true); inc += __builtin_amdgcn_update_dpp(0, inc, 0x112, 0xF, 0xF, true);
            inc += __builtin_amdgcn_update_dpp(0, inc, 0x114, 0xF, 0xF, true); inc += __builtin_amdgcn_update_dpp(0, inc, 0x118, 0xF, 0xF, true);
            { const int r0 = __builtin_amdgcn_readlane(inc, 15), r1 = __builtin_amdgcn_readlane(inc, 31), r2 = __builtin_amdgcn_readlane(inc, 47);
              inc += lane >= 48 ? r0 + r1 + r2 : (lane >= 32 ? r0 + r1 : (lane >= 16 ? r0 : 0)); }
            LAS unsigned* wp = cl + (inc - mine); LAS unsigned* const tr = cl + 128 + lane;
            int pj = lane;
#pragma unroll
            for (int j = 0; j < NJ; ++j) { const bool und = (key[j] - T) < bw; LAS unsigned* q = und ? wp : tr; q[0] = key[j]; q[64] = (unsigned)pj; wp += und ? 1 : 0;
                pj += 64; asm volatile("" : "+v"(pj)); }
            const int nund = cT - A;
            const unsigned ck = lane < nund ? cl[lane] : 0u; const int cp = (int)cl[64 + lane];
            topk_finish(ck, cp, A, 4095, T, P, nb);
        } else {
#pragma unroll 1
            for (int bit = nb - 1; bit >= 0; --bit) { const unsigned cand = T | (1u << bit); int tot; TK_FULLCOUNT(cand, tot); if (tot >= 256) T = cand; }
            int cge, cgt; TK_FULLCOUNT(T, cge); cgt = 0; if (T != 0xffffffffu) TK_FULLCOUNT(T + 1u, cgt);
            const int need = 256 - cgt, ceq = cge - cgt; P = 4095;
            if (ceq != need) { P = 0;
#pragma unroll 1
                for (int bit = 11; bit >= 0; --bit) { const int cand = P | (1 << bit); int cnt = 0; int pj = lane;
#pragma unroll
                    for (int j = 0; j < NJ; ++j) { cnt += (key[j] == T && pj < cand) ? 1 : 0; pj += 64; asm volatile("" : "+v"(pj)); }
                    if (wave_sum_dpp(cnt) < need) P = cand; } }
        }
#undef TK_FULLCOUNT
        if (P != 4095) {
            int pq = lane;
#pragma unroll
            for (int j = 0; j < NJ; ++j) { if (key[j] == T && pq > P) key[j] = 0u; pq += 64; asm volatile("" : "+v"(pq)); } }
        unsigned wlo = 0u, whi = 0u; const unsigned Ts = __builtin_amdgcn_readfirstlane(T);
#pragma unroll 1
        for (int rep_ = 0; rep_ < TKREP_D; ++rep_)
#pragma unroll
        for (int j = 0; j < NJ; ++j) asm volatile("v_cmp_le_u32_e32 vcc, %2, %3\n\ts_nop 3\n\tv_writelane_b32 %0, vcc_lo, %4\n\tv_writelane_b32 %1, vcc_hi, %4" : "+v"(wlo), "+v"(whi) : "s"(Ts), "v"(key[j]), "i"(j) : "vcc");
        mk[lane] = ((u64)whi << 32) | (u64)wlo;
}
__device__ __forceinline__ int topk_row_of(int gw, int NGW, int i) { const int idx = gw + (i >> 1) * NGW, b = idx >> 11, u = idx & 2047; return b * 4096 + ((i & 1) ? 4095 - u : u); }
__device__ __forceinline__ void topk_prompt_rows(ARGREF a, int gw, int NGW, int count, unsigned mask, int e0, int e1, int lane_, LAS unsigned* cl) {
    int lane = lane_; asm volatile("" : "+v"(lane));
    const float* SCb = (const float*)(a.ws + WS_SC);
#pragma unroll 1
    for (int i_ = 0; i_ < count + 2; ++i_) { int row;
        if (i_ < count) { if (!((mask >> i_) & 1u)) continue; row = topk_row_of(gw, NGW, i_); } else { row = i_ == count ? e0 : e1; if (row < 0) continue; }
        const int t = row & 4095;
        if (t < 256) { u64 myword = 0ull; u64* mk = (u64*)(a.ws + WS_MASK) + (size_t)row * 64;
#pragma unroll 1
            for (int j = 0; j < 64; ++j) { const u64 m = __ballot(64 * j + lane <= t); if (lane == j) myword = m; }
            mk[lane] = myword; }
        else if (t < 1024) topk_prompt_row<16>(a, SCb, row, lane, cl);
        else if (t < 2048) topk_prompt_row<32>(a, SCb, row, lane, cl);
        else if (t < 3072) topk_prompt_row<48>(a, SCb, row, lane, cl);
        else topk_prompt_row<64>(a, SCb, row, lane, cl);
    }
}
__device__ __forceinline__ void topk_sample_row(ARGREF a, int q, int lane_, LAS unsigned* K, LAS unsigned* cl) {
    int lane = lane_; asm volatile("" : "+v"(lane));
    const int t = q & 3, n = PAST + t + 1; const float* sc = (const float*)(a.ws + WS_SSC) + (size_t)q * SSC_LD;
    int* out = (int*)(a.ws + WS_SIDX) + q * 256;
    unsigned key[129];
#pragma unroll
    for (int j = 0; j < 129; ++j) { const float v = sc[64 * j + lane]; key[j] = (j < 128 || lane < n - 8192) ? fkey(v) : 0u; }
#pragma unroll
    for (int j = 0; j < 129; ++j) K[64 * j + lane] = key[j];
#define TK_FULLCOUNT(CAND, OUT) do { const unsigned cs_ = __builtin_amdgcn_readfirstlane(CAND); int c0_ = 0, c1_ = 0, c2_ = 0, c3_ = 0; \
        _Pragma("unroll") for (int j = 0; j < 128; j += 4) acc_ge4(c0_, c1_, c2_, c3_, key[j], key[j + 1], key[j + 2], key[j + 3], cs_); acc_ge(c0_, key[128], cs_); OUT = wave_sum_dpp((c0_ + c1_) + (c2_ + c3_)); } while (0)
    unsigned T = 0u;
#pragma unroll 1
    for (int bit = 31; bit >= TK_LOWBITS; --bit) { const unsigned cand = T | (1u << bit); int tot; TK_FULLCOUNT(cand, tot); if (tot >= 256) T = cand; }
    const unsigned hib = T + (1u << TK_LOWBITS);
    int A = 0, cT; if (hib != 0u) TK_FULLCOUNT(hib, A); TK_FULLCOUNT(T, cT);
    int P;
    if (cT - A <= 64) {
        int base = 0;
#pragma unroll 1
        for (int j0 = 0; j0 < 128; j0 += 8) { unsigned kk[8];
#pragma unroll
            for (int i = 0; i < 8; ++i) kk[i] = K[64 * (j0 + i) + lane];
#pragma unroll
            for (int i = 0; i < 8; ++i) { const unsigned und = (kk[i] - T) < (1u << TK_LOWBITS) ? 1u : 0u; const u64 m = ballot_nz(und); const int pos = base + mbcnt64(m);
                if (und) { cl[pos] = kk[i]; cl[64 + pos] = (unsigned)(64 * (j0 + i) + lane); }
                base += __builtin_popcountll(m); } }
        { const unsigned kj = K[64 * 128 + lane]; const unsigned und = (kj - T) < (1u << TK_LOWBITS) ? 1u : 0u; const u64 m = ballot_nz(und); const int pos = base + mbcnt64(m);
          if (und) { cl[pos] = kj; cl[64 + pos] = (unsigned)(64 * 128 + lane); } base += __builtin_popcountll(m); }
        const unsigned ck = lane < base ? cl[lane] : 0u; const int cp = (int)cl[64 + lane];
        topk_finish(ck, cp, A, 16383, T, P);
    } else {
#pragma unroll 1
        for (int bit = TK_LOWBITS - 1; bit >= 0; --bit) { const unsigned cand = T | (1u << bit); int tot; TK_FULLCOUNT(cand, tot); if (tot >= 256) T = cand; }
        int cge, cgt; TK_FULLCOUNT(T, cge); cgt = 0; if (T != 0xffffffffu) TK_FULLCOUNT(T + 1u, cgt);
        const int need = 256 - cgt, ceq = cge - cgt; P = 16383;
        if (ceq != need) { P = 0;
#pragma unroll 1
            for (int bit = 13; bit >= 0; --bit) { const int cand = P | (1 << bit); int cnt = 0;
#pragma unroll 4
                for (int j = 0; j < 129; ++j) cnt += (K[64 * j + lane] == T && 64 * j + lane < cand) ? 1 : 0;
                if (wave_sum_dpp(cnt) < need) P = cand; } }
    }
#undef TK_FULLCOUNT
    int base = 0;
#pragma unroll 1
    for (int j0 = 0; j0 < 136; j0 += 8) { unsigned kk[8];
#pragma unroll
        for (int i = 0; i < 8; ++i) kk[i] = (j0 + i < 129) ? K[64 * (j0 + i) + lane] : 0u;
#pragma unroll
        for (int i = 0; i < 8; ++i) { const int ps = 64 * (j0 + i) + lane; const unsigned selv = (kk[i] > T || (kk[i] == T && ps <= P)) ? 1u : 0u; const u64 m = ballot_nz(selv);
            const int pos = base + mbcnt64(m);
            if (selv && pos < 256) out[pos] = ps;
            base += __builtin_popcountll(m); } }
}
__device__ __forceinline__ void p10_topk(Ctx& c, ARGREF a) {
    const int gw = c.vcu * NWAVES + c.wave, NGW = c.G * NWAVES;
    LAS unsigned* cl = (LAS unsigned*)(c.lds) + c.wave * 256;
    if (c.wave == 0 && c.vcu < MS) topk_sample_row(a, c.vcu, c.lane, (LAS unsigned*)(c.lds + 8192), cl);
    const int NPAIR = MP / 2;
    int count = gw < NPAIR ? 2 * ((NPAIR - gw + NGW - 1) / NGW) : 0, e0 = -1, e1 = -1; unsigned mask = 0xffffffffu;
    if (c.G == 256 && c.vcu < MS) { const int g0 = c.vcu * NWAVES, w = c.wave;
        if (w == 0) mask = 0x1fu;
        else if (w <= 2) { mask = 0xaau; e0 = topk_row_of(g0, NGW, w == 1 ? 5 : 7); }
        else if (w <= 5) { e0 = topk_row_of(g0 + 1, NGW, 2 * (w - 3)); e1 = topk_row_of(g0 + 2, NGW, 2 * (w - 2)); }
        else if (w == 6) { e0 = topk_row_of(g0 + 1, NGW, 6); e1 = topk_row_of(g0, NGW, 6); }
        else e0 = topk_row_of(g0 + 2, NGW, 0); }
    topk_prompt_rows(a, gw, NGW, count, mask, e0, e1, c.lane, cl);
}


__device__ __forceinline__ void attn_sample_unit(Ctx& c, ARGREF a, int sb, int t) {
    LAS bf16* KV = (LAS bf16*)(c.lds);
    LAS float* QL = (LAS float*)(c.lds + 69632);
    LAS float* SL = (LAS float*)(c.lds + 69632 + 3072);
    LAS float* OL = (LAS float*)(c.lds + 69632 + 6144);
    LAS int* IL = (LAS int*)(c.lds + 69632 + 12288);
    LAS unsigned* OFFL = (LAS unsigned*)(c.lds + 69632 + 12288 + 1024);
    int tid = c.tid; asm volatile("" : "+v"(tid));
    const int lane = tid & 63, w = c.wave, q = sb * 4 + t;
    __syncthreads();
    if (tid < 256) IL[tid] = ((const int*)(a.ws + WS_SIDX))[q * 256 + tid];
    for (int i = tid; i < 768; i += 512) QL[i] = ((const float*)(a.ws + WS_SQ))[(size_t)q * 768 + i];
    __syncthreads();
    if (tid < 256) { const int idx = IL[tid];
        OFFL[tid] = idx < PAST ? (unsigned)(((a.page_table[sb * 64 + (idx >> 7)] * 128 + (idx & 127)) * 2) * 128) : (0x80000000u | (unsigned)((sb * 4 + (idx - PAST)) * 256)); }
    __syncthreads();
    bf16* MIX = (bf16*)(a.ws + WS_MIX) + (size_t)(MP + q) * DM;
#pragma unroll 1
    for (int kvh = 0; kvh < 2; ++kvh) {
#pragma unroll 1
        for (int pass = 0; pass < 2; ++pass) {
            const float* pool = pass ? a.in[3] : a.in[2]; const float* nw = a.out + (pass ? O_VS : O_KS);
            { f32x4 gv[16];
#pragma unroll
              for (int r = 0; r < 16; ++r) { const int i = (tid >> 5) + 16 * r; const unsigned off = OFFL[i]; const float* src = (off & 0x80000000u) ? nw + (size_t)(off & 0x7fffffffu) : pool + (size_t)off;
                  gv[r] = *(const f32x4*)(src + kvh * 128 + (tid & 31) * 4); }
#pragma unroll
              for (int r = 0; r < 16; ++r) { const int i = (tid >> 5) + 16 * r; *(LAS u64*)(KV + i * 136 + (tid & 31) * 4) = (u64)pk2(gv[r].x, gv[r].y) | ((u64)pk2(gv[r].z, gv[r].w) << 32); } }
            __syncthreads();
            if (pass == 0) {
                const int i = tid >> 1, dh = (tid & 1) * 64; float s0 = 0.f, s1 = 0.f, s2 = 0.f;
#pragma unroll 8
                for (int d = 0; d < 64; ++d) { const float kx = bf2f(KV[i * 136 + dh + d]);
                    s0 = fmaf(QL[(3 * kvh + 0) * 128 + dh + d], kx, s0); s1 = fmaf(QL[(3 * kvh + 1) * 128 + dh + d], kx, s1); s2 = fmaf(QL[(3 * kvh + 2) * 128 + dh + d], kx, s2); }
                s0 += __shfl_xor(s0, 1); s1 += __shfl_xor(s1, 1); s2 += __shfl_xor(s2, 1);
                if ((tid & 1) == 0) { SL[i] = s0 * 0.08838834764831845f; SL[256 + i] = s1 * 0.08838834764831845f; SL[512 + i] = s2 * 0.08838834764831845f; }
                __syncthreads();
                if (w < 3) { float v[4], mx = -1e30f;
#pragma unroll
                    for (int j = 0; j < 4; ++j) { v[j] = SL[w * 256 + 64 * j + lane]; mx = fmaxf(mx, v[j]); }
#pragma unroll
                    for (int o = 1; o < 64; o <<= 1) mx = fmaxf(mx, __shfl_xor(mx, o));
                    float l = 0.f;
#pragma unroll
                    for (int j = 0; j < 4; ++j) { v[j] = __expf(v[j] - mx); l += v[j]; }
                    l = wave_sum(l); const float il = 1.0f / l;
#pragma unroll
                    for (int j = 0; j < 4; ++j) SL[w * 256 + 64 * j + lane] = v[j] * il; }
                __syncthreads();
            } else {
                const int d = tid & 127, part = tid >> 7; float o0 = 0.f, o1 = 0.f, o2 = 0.f;
#pragma unroll 8
                for (int i = part * 64; i < part * 64 + 64; ++i) { const float vx = bf2f(KV[i * 136 + d]); o0 = fmaf(SL[i], vx, o0); o1 = fmaf(SL[256 + i], vx, o1); o2 = fmaf(SL[512 + i], vx, o2); }
                OL[(part * 3 + 0) * 128 + d] = o0; OL[(part * 3 + 1) * 128 + d] = o1; OL[(part * 3 + 2) * 128 + d] = o2;
                __syncthreads();
                if (tid < 384) { const int hq = tid >> 7, dd = tid & 127; const float o = (OL[hq * 128 + dd] + OL[(3 + hq) * 128 + dd]) + (OL[(6 + hq) * 128 + dd] + OL[(9 + hq) * 128 + dd]);
                    MIX[(3 * kvh + hq) * 128 + dd] = (bf16)f2bf(o); }
                __syncthreads();
            }
        }
    }
}


namespace attn {
using bf16 = unsigned short;
typedef short bf16x8 __attribute__((ext_vector_type(8)));
typedef short s16x4 __attribute__((ext_vector_type(4)));
typedef float f32x16 __attribute__((ext_vector_type(16)));
typedef float f32x4 __attribute__((ext_vector_type(4)));
typedef unsigned u32x4 __attribute__((ext_vector_type(4)));
typedef unsigned u32x2 __attribute__((ext_vector_type(2)));
constexpr int D = 128, OS = 1024;
constexpr float THR = 8.f;
constexpr float SCALE = 0.08838834764831845f;
constexpr int NW = 8, QBLK = 32, KVBLK = 64, QB = NW * QBLK;
constexpr int SHM_V = KVBLK * D * 2, SHM_K = KVBLK * D * 2;
constexpr int LDS_BYTES = 2 * SHM_V + 2 * SHM_K + NW * 64 * 4;

#define KSWZ(row, colB) ((row) * 256 + ((colB) ^ (((row) & 7) << 4)))
#define SBAR() __builtin_amdgcn_sched_barrier(0)
__device__ __forceinline__ int v_st(int k, int c) { const int kk = (k & ~0xC) | ((k & 4) << 1) | ((k & 8) >> 1); return ((kk >> 3) * 4 + (c >> 5)) * 512 + ((kk & 7) * 32 + (c & 31)) * 2; }
__device__ __forceinline__ int v_rd_base(int lane) { return ((lane & 3) << 3) | (((lane >> 2) & 3) << 6) | (((lane >> 4) & 1) << 5) | (((lane >> 5) & 1) << 8); }
constexpr int v_rd_off(int d0, int ks, int half) { return d0 * 512 + ks * 4096 + half * 2048; }
__device__ __forceinline__ int crow(int r, int hi) { return (r & 3) + 8 * (r >> 2) + 4 * hi; }
__device__ __forceinline__ unsigned cvtpk(float lo, float hi) {
    unsigned r; asm volatile("v_cvt_pk_bf16_f32 %0, %1, %2" : "=v"(r) : "v"(lo), "v"(hi)); return r;
}
__device__ __forceinline__ bf16x8 pack8(f32x4 a, f32x4 b) {
    u32x4 w = {cvtpk(a[0], a[1]), cvtpk(a[2], a[3]), cvtpk(b[0], b[1]), cvtpk(b[2], b[3])};
    return *reinterpret_cast<bf16x8*>(&w);
}

__device__ __forceinline__ void partialSM(f32x16& p0, f32x16& p1, float& m_reg, float& mn, float& alpha) {
    float pmax = p0[0]; for (int r = 1; r < 16; ++r) pmax = fmaxf(pmax, p0[r]); for (int r = 0; r < 16; ++r) pmax = fmaxf(pmax, p1[r]);
    { auto rr = __builtin_amdgcn_permlane32_swap(__float_as_uint(pmax), __float_as_uint(pmax), false, false);
      pmax = fmaxf(__uint_as_float(rr[0]), __uint_as_float(rr[1])); }
    constexpr float C2 = 1.4426950408889634f * SCALE;
    if (__builtin_expect(__all((pmax - m_reg) * SCALE <= THR), 1)) { mn = m_reg; alpha = 1.f; }
    else { mn = fmaxf(m_reg, pmax); alpha = __builtin_amdgcn_exp2f((m_reg - mn) * C2); m_reg = mn; }
    const float mnL = -mn * C2;
    for (int r = 0; r < 16; ++r) p0[r] = fmaf(p0[r], C2, mnL); for (int r = 0; r < 16; ++r) p1[r] = fmaf(p1[r], C2, mnL);
    for (int r = 0; r < 16; ++r) p0[r] = __builtin_amdgcn_exp2f(p0[r]);
}
__device__ __forceinline__ void finishSM(f32x16& p0, f32x16& p1, float alpha, float& l_reg, bf16x8& pa0, bf16x8& pa1, bf16x8& pa2, bf16x8& pa3) {
    for (int r = 0; r < 16; ++r) p1[r] = __builtin_amdgcn_exp2f(p1[r]);
    float ps = 0; for (int r = 0; r < 16; ++r) ps += p0[r]; for (int r = 0; r < 16; ++r) ps += p1[r];
    { auto rr = __builtin_amdgcn_permlane32_swap(__float_as_uint(ps), __float_as_uint(ps), false, false);
      ps = __uint_as_float(rr[0]) + __uint_as_float(rr[1]); }
    l_reg = l_reg * alpha + ps;
#define PK4(P, B_, OUT) do { unsigned a0 = cvtpk(P[B_+0], P[B_+1]), a1 = cvtpk(P[B_+2], P[B_+3]);                          \
        unsigned b0 = cvtpk(P[B_+4], P[B_+5]), b1 = cvtpk(P[B_+6], P[B_+7]);                                             \
        auto r0 = __builtin_amdgcn_permlane32_swap(a0, b0, false, false); auto r1 = __builtin_amdgcn_permlane32_swap(a1, b1, false, false); \
        u32x4 w = {r0[0], r1[0], r0[1], r1[1]}; OUT = *reinterpret_cast<bf16x8*>(&w); } while (0)
    PK4(p0, 0, pa0); PK4(p0, 8, pa1); PK4(p1, 0, pa2); PK4(p1, 8, pa3);
#undef PK4
}
template <int KB, bool SK>
__device__ __forceinline__ void qkt(f32x16& p0, f32x16& p1, const char* K_lds, int r32, int hi, const bf16x8* qr, bool act) {
    if (SK && !act) { const float NEG = -__builtin_inff();
#pragma unroll
        for (int r = 0; r < 16; ++r) { p0[r] = NEG; p1[r] = NEG; } return; }
    p0 = f32x16{}; p1 = f32x16{};
    const char* kb[4];
#pragma unroll
    for (int dd = 0; dd < 4; ++dd) kb[dd] = K_lds + KB * SHM_K + KSWZ(r32, (dd * 16 + hi * 8) * 2);
#pragma unroll
    for (int d0 = 0; d0 < 8; ++d0) { const char* a = kb[d0 & 3] + (d0 >> 2) * 128;
        bf16x8 b0 = *reinterpret_cast<const bf16x8*>(a);
        bf16x8 b1 = *reinterpret_cast<const bf16x8*>(a + 32 * 256);
        p0 = __builtin_amdgcn_mfma_f32_32x32x16_bf16(b0, qr[d0], p0, 0, 0, 0);
        p1 = __builtin_amdgcn_mfma_f32_32x32x16_bf16(b1, qr[d0], p1, 0, 0, 0); }
}
template <int VB, bool SK>
__device__ __forceinline__ void pv_tile(f32x16* o, int vb0, bf16x8 pa0, bf16x8 pa1, bf16x8 pa2, bf16x8 pa3, bool act) {
    if (SK && !act) return;
#define TRRD(dst, off) asm volatile("ds_read_b64_tr_b16 %0, %1 offset:%2" : "=&v"(dst) : "v"(vb0), "i"(off) : "memory")
#define PV_D0(d0) do { s16x4 l0, l1, l2, l3, h0, h1, h2, h3; constexpr int b_ = VB * SHM_V + v_rd_off(d0, 0, 0);     \
        TRRD(l0, b_); TRRD(h0, b_ + 2048); TRRD(l1, b_ + 4096); TRRD(h1, b_ + 6144); TRRD(l2, b_ + 8192); TRRD(h2, b_ + 10240); TRRD(l3, b_ + 12288); TRRD(h3, b_ + 14336); \
        asm volatile("s_waitcnt lgkmcnt(0)" ::: "memory"); SBAR();                 \
        o[d0] = __builtin_amdgcn_mfma_f32_32x32x16_bf16(pa0, (bf16x8){l0[0], l0[1], l0[2], l0[3], h0[0], h0[1], h0[2], h0[3]}, o[d0], 0, 0, 0);   \
        o[d0] = __builtin_amdgcn_mfma_f32_32x32x16_bf16(pa1, (bf16x8){l1[0], l1[1], l1[2], l1[3], h1[0], h1[1], h1[2], h1[3]}, o[d0], 0, 0, 0);   \
        o[d0] = __builtin_amdgcn_mfma_f32_32x32x16_bf16(pa2, (bf16x8){l2[0], l2[1], l2[2], l2[3], h2[0], h2[1], h2[2], h2[3]}, o[d0], 0, 0, 0);   \
        o[d0] = __builtin_amdgcn_mfma_f32_32x32x16_bf16(pa3, (bf16x8){l3[0], l3[1], l3[2], l3[3], h3[0], h3[1], h3[2], h3[3]}, o[d0], 0, 0, 0); } while (0)
    PV_D0(0); PV_D0(1); PV_D0(2); PV_D0(3);
#undef PV_D0
#undef TRRD
}

__device__ __forceinline__ bf16x8 load8(const bf16* p) { return *reinterpret_cast<const bf16x8*>(p); }
__device__ __forceinline__ void mask_bits(f32x16& p0, f32x16& p1, u32x2 w, int hi) {
    const float NEG = -__builtin_inff();
    asm volatile("" : "+v"(w.x), "+v"(w.y));
    const unsigned lo = w.x >> (4 * hi), up = w.y >> (4 * hi);
#pragma unroll
    for (int r = 0; r < 16; ++r) { const int c = (r & 3) + 8 * (r >> 2);
        if (!((lo >> c) & 1u)) p0[r] = NEG;
        if (!((up >> c) & 1u)) p1[r] = NEG; }
}
struct BlockRef { const bf16* Q; const bf16* K; const bf16* V; bf16* O; const u32x2* M; int P0; };
struct Seam { bf16x8 qr[8]; bf16x8 st_v0, st_v1, st_k0, st_k1; };
#define ROW(p, k0, rr) ((p) + (size_t)((k0) + (rr)) * D + sc)
#define VMW() asm volatile("s_waitcnt vmcnt(0)" ::: "memory")
#define VMWN(n) asm volatile("s_waitcnt vmcnt(%0)" :: "i"(n) : "memory")
#define SLOAD_H(Kp, Vp, k0) do { S.st_v0 = load8(ROW(Vp, k0, sr)); S.st_v1 = load8(ROW(Vp, k0, 32 + sr));              \
                         S.st_k0 = load8(ROW(Kp, k0, sr)); S.st_k1 = load8(ROW(Kp, k0, 32 + sr)); } while (0)
#define SWRITE_HK(bf) do { *(bf16x8*)(K_lds + (bf) * SHM_K + kws) = S.st_k0; *(bf16x8*)(K_lds + (bf) * SHM_K + kws + 32 * 256) = S.st_k1; } while (0)
#define SWRITE_HV(bf) do { *(bf16x8*)(V_lds + (bf) * SHM_V + vst0) = S.st_v0; *(bf16x8*)(V_lds + (bf) * SHM_V + vst1) = S.st_v1; } while (0)
#define SWRITE_H(bf) do { SWRITE_HV(bf); SWRITE_HK(bf); } while (0)
__device__ __forceinline__ void sel_prime(const BlockRef& cur, char* lds, Seam& S) {
    int tid_ = threadIdx.x; asm volatile("" : "+v"(tid_));
    const int tid = tid_, wid = __builtin_amdgcn_readfirstlane(tid >> 6), lane = tid & 63, r32 = lane & 31, hi = lane >> 5;
    const int sr = tid >> 4, sc = (tid & 15) * 8, kws = KSWZ(sr, sc * 2); char* K_lds = lds + 2 * SHM_V;
    for (int d0 = 0; d0 < 8; ++d0) S.qr[d0] = load8(cur.Q + (size_t)(wid * QBLK + r32) * D + d0 * 16 + hi * 8);
    SLOAD_H(cur.K, cur.V, 0); VMW(); SWRITE_HK(0);
    __syncthreads();
}
__device__ __forceinline__ void sel_block(const BlockRef& cur, const BlockRef& nxt, char* lds, Seam& S) {
    int tid_ = threadIdx.x; asm volatile("" : "+v"(tid_));
    const int tid = tid_, wid = __builtin_amdgcn_readfirstlane(tid >> 6), lane = tid & 63, r32 = lane & 31, hi = lane >> 5;
    const int NT = (cur.P0 + QB) / KVBLK;
    char* V_lds = lds; char* K_lds = lds + 2 * SHM_V;
    float* ws = (float*)(lds + 2 * SHM_V + 2 * SHM_K) + wid * 64; float* li_l = ws, * al_l = ws + 32;
    float m_reg = -1e30f, l_reg = 0; f32x16 o[4] = {};
    const int sr = tid >> 4, sc = (tid & 15) * 8, vst0 = v_st(sr, sc), vst1 = v_st(32 + sr, sc), kws = KSWZ(sr, sc * 2);
    const int vb0 = (int)(uintptr_t)V_lds + v_rd_base(lane);
    const bf16* Kh = cur.K; const bf16* Vh = cur.V;
    const char* Mbase = (const char*)cur.M; const unsigned moff = (unsigned)(wid * QBLK + r32) * 512u;
#define MROW(t) (*(const u32x2*)(Mbase + (moff + (unsigned)(t) * 8u)))
#define RESC(a) do { if (__any((a) < 1.f)) { if (hi == 0) al_l[r32] = (a); asm volatile("s_waitcnt lgkmcnt(0)" ::: "memory");              \
                     for (int d_ = 0; d_ < 4; ++d_) for (int r = 0; r < 16; ++r) o[d_][r] *= al_l[crow(r, hi)]; } } while (0)
#define KBASE(t) ((t) * KVBLK)
    f32x16 pA0, pA1, pB0, pB1; float mnA, mnB, alA, alB; bf16x8 pa0, pa1, pa2, pa3; u32x2 mw;
    SWRITE_HV(0); SBAR();
    if (NT > 1) SLOAD_H(Kh, Vh, KBASE(1));
    mw = MROW(0);
    SBAR(); qkt<0, false>(pA0, pA1, K_lds, r32, hi, S.qr, true);
    mask_bits(pA0, pA1, mw, hi); partialSM(pA0, pA1, m_reg, mnA, alA);
    if (NT > 1) { VMW(); SWRITE_H(1); }
    __syncthreads();
#define HALF_STEP(PX0, PX1, mnX, alX, PY0, PY1, alY, t, KB, VB, SB) do {                                                      \
        SBAR(); mw = MROW(t); qkt<KB, false>(PX0, PX1, K_lds, r32, hi, S.qr, true);                                          \
        finishSM(PY0, PY1, alY, l_reg, pa0, pa1, pa2, pa3); SBAR();                                                           \
        if ((t) + 1 < NT) { SLOAD_H(Kh, Vh, KBASE((t) + 1)); SBAR(); }                                                        \
        pv_tile<VB, false>(o, vb0, pa0, pa1, pa2, pa3, true); mask_bits(PX0, PX1, mw, hi); partialSM(PX0, PX1, m_reg, mnX, alX); \
        __syncthreads();                                                                                                      \
        if ((t) + 1 < NT) { VMW(); SWRITE_H(SB); }                                                                            \
        RESC(alX); __syncthreads(); } while (0)
    for (int t = 1; t + 1 < NT; t += 2) {
        HALF_STEP(pB0, pB1, mnB, alB, pA0, pA1, alA, t, 1, 0, 0);
        HALF_STEP(pA0, pA1, mnA, alA, pB0, pB1, alB, t + 1, 0, 1, 1);
    }
    const bool even = (NT & 1) == 0;
    if (even) { SBAR(); mw = MROW(NT - 1); qkt<1, false>(pB0, pB1, K_lds, r32, hi, S.qr, true); SBAR(); }
    SLOAD_H(nxt.K, nxt.V, 0); SBAR();
#pragma unroll
    for (int d0 = 0; d0 < 8; ++d0) S.qr[d0] = load8(nxt.Q + (size_t)(wid * QBLK + r32) * D + d0 * 16 + hi * 8);
    SBAR();
    finishSM(pA0, pA1, alA, l_reg, pa0, pa1, pa2, pa3); SBAR();
    pv_tile<0, false>(o, vb0, pa0, pa1, pa2, pa3, true);
    if (even) { mask_bits(pB0, pB1, mw, hi); partialSM(pB0, pB1, m_reg, mnB, alB); __syncthreads(); RESC(alB);
        finishSM(pB0, pB1, alB, l_reg, pa0, pa1, pa2, pa3); SBAR(); pv_tile<1, false>(o, vb0, pa0, pa1, pa2, pa3, true); }
    SBAR(); VMWN(8); SWRITE_HK(0); SBAR();
    if (hi == 0) li_l[r32] = l_reg; asm volatile("s_waitcnt lgkmcnt(0)" ::: "memory");
    float rli[16];
#pragma unroll
    for (int r = 0; r < 16; ++r) rli[r] = __builtin_amdgcn_rcpf(li_l[crow(r, hi)]);
    bf16* Ow = cur.O + (size_t)(wid * QBLK) * OS;
#pragma unroll
    for (int r = 0; r < 16; ++r) { const int orow = crow(r, hi);
#pragma unroll
        for (int d0 = 0; d0 < 4; ++d0) { const float v = o[d0][r] * rli[r];
            const float vn = __shfl_xor(v, 1);
            if ((r32 & 1) == 0) *(unsigned*)(Ow + (size_t)orow * OS + d0 * 32 + r32) = cvtpk(v, vn); } }
    __syncthreads();
#undef RESC
#undef KBASE
#undef HALF_STEP
#undef MROW
}
#undef ROW
#undef VMW
#undef VMWN
#undef SLOAD_H
#undef SWRITE_HK
#undef SWRITE_HV
#undef SWRITE_H
#undef KSWZ
#undef SBAR
}


__device__ __forceinline__ attn::BlockRef attn_ref(ARGREF a, int b, int h, int qb) {
    attn::BlockRef r; const int kvh = h / 3;
    r.Q = (const attn::bf16*)(a.ws + WS_QB) + ((size_t)(b * 6 + h) * SEQ + (size_t)qb * 256) * 128;
    r.K = (const attn::bf16*)(a.ws + WS_KB) + (size_t)(b * 2 + kvh) * SEQ * 128;
    r.V = (const attn::bf16*)(a.ws + WS_VB) + (size_t)(b * 2 + kvh) * SEQ * 128;
    r.O = (attn::bf16*)(a.ws + WS_MIX) + (size_t)(b * SEQ + qb * 256) * DM + h * 128;
    r.M = (const attn::u32x2*)(a.ws + WS_MASK) + (size_t)(b * SEQ + qb * 256) * 64;
    r.P0 = qb * 256; return r;
}
__device__ __forceinline__ void p11_attention(Ctx& c, ARGREF a) {
    constexpr int NITEM = 240;
#pragma unroll 1
    for (int it = c.vcu; it < NITEM; it += c.G) {
        const int bh = it / 10, slot = it % 10, b = bh / 6, h = bh % 6;
        const int q0 = slot < 3 ? 15 - slot : (slot == 9 ? 6 : slot - 3), q1 = slot < 3 ? q0 : (slot == 9 ? 6 : 15 - slot);
        attn::Seam S;
        attn::BlockRef cur = attn_ref(a, b, h, q0), nxt = attn_ref(a, b, h, q1);
        __syncthreads();
        attn::sel_prime(cur, (char*)c.lds, S);
        if (q0 != q1) attn::sel_block(cur, nxt, (char*)c.lds, S);
        attn::sel_block(nxt, nxt, (char*)c.lds, S);
    }
    if (c.G == 256) {
        if (c.vcu >= NITEM) { for (int j = 0; j < 4; ++j) { const int u = (c.vcu - NITEM) * 4 + j; attn_sample_unit(c, a, u >> 2, u & 3); } }
        else if (c.vcu % 10 == 9) { for (int j = 0; j < 3; ++j) { const int u = 64 + (c.vcu / 10) * 3 + j; if (u < MS) attn_sample_unit(c, a, u >> 2, u & 3); } }
    } else for (int u = c.vcu; u < MS; u += c.G) attn_sample_unit(c, a, u >> 2, u & 3);
}

enum { PH_PRO = 0, PH_IN0, PH_MIX0, PH_HSCAN, PH_HFIX, PH_OUT0, PH_GU0, PH_DOWN0, PH_IN1, PH_POST, PH_IDX, PH_TOPK, PH_ATTN, PH_OUT1, PH_GU1, PH_DOWN1, NPHASE };
#ifndef ONLYPH
#define ONLYPH -1
#endif
#define PHON(x) (ONLYPH < 0 || ONLYPH == (x))
#ifndef REP_PH
#define REP_PH -1
#endif
#ifndef REP_N
#define REP_N 1
#endif
__global__ void __launch_bounds__(NWAVES * 64, 2) fwd_kernel(Args args) {
    extern __shared__ __attribute__((aligned(16))) unsigned char lds[];
    Ctx c;
    c.lds = (LAS unsigned char*)lds;
    c.MISC = (volatile LAS unsigned*)(c.lds + MISC_OFF);
    c.tid = threadIdx.x; c.lane = c.tid & 63; c.wave = __builtin_amdgcn_readfirstlane(c.tid >> 6);
    c.G = gridDim.x; { const int bx = blockIdx.x; c.vcu = (c.G % 8 == 0) ? (bx % 8) * (c.G / 8) + bx / 8 : bx; }
    c.ctl = (gu32*)(args.ws + WS_CTL);
    for (int u = c.tid; u < (LDS_BYTES - LDSCTL_OFF) / 4; u += NWAVES * 64) ((LAS unsigned*)(c.lds + LDSCTL_OFF))[u] = 0u;
    __syncthreads();
    const int lo = args.ph_lo, hi = args.ph_hi;
    XcdBarrier bar; bar.bar = (unsigned*)(c.ctl + CW_BAR); bar.x = 0; bar.st = nullptr;
    if (hi - lo > 1 || REP_N > 1) bar = xcd_barrier_post((unsigned*)(c.ctl + CW_BAR), c.MISC + 8);
    c.qoff = 0;
#pragma unroll 1
    for (int ph = lo; ph < hi; ++ph) {
        const int layer = ph >= PH_IN1 ? 1 : 0;
        const __attribute__((address_space(4))) Args* ap = (const __attribute__((address_space(4))) Args*)__builtin_amdgcn_kernarg_segment_ptr(); asm volatile("" : "+s"(ap));
        ARGREF la = *ap; unsigned char* const ws = la.ws; float* const out = la.out;
        { int t_ = threadIdx.x; asm volatile("" : "+v"(t_)); c.tid = t_; c.lane = t_ & 63; c.wave = __builtin_amdgcn_readfirstlane(t_ >> 6); }
        if ((ph == PH_DOWN0 || ph == PH_DOWN1) && PHON(PH_OUT0)) {
            pg8::SchedX S0; S0.init(MP, 1024, c.G, (int)blockIdx.x, 0, 0, 1, 0); pg8::Unit u0; if (S0.next(0, u0)) conv_fixup_tile(c, la, layer, u0.pm); VM_WAIT(); __syncthreads(); }
        if (ph == PH_PRO && PHON(PH_PRO)) p0_prologue(c, la);
        else if ((ph == PH_IN0 || ph == PH_IN1) && PHON(PH_IN0)) {
            pg8::Gemm g{(const pg8::bf16_t*)(ws + WS_XB), (const pg8::bf16_t*)(ws + (ph == PH_IN0 ? WS_WIN0 : WS_WIN1)), MT, 0, 1024};
            pg8::SchedX S; if (ph == PH_IN0) S.init(MP, ZC0, c.G, (int)blockIdx.x, 16, MT / 256, 4, 13); else S.init(MP, ZC1, c.G, (int)blockIdx.x, 0, 0, 1, 0, true);
            pg8::EpiZ E{(pg8::bf16_t*)(ws + WS_Z), ph == PH_IN0 ? ZC0 : ZC1, ssptr(c, ph == PH_IN0 ? 0 : 2), ph == PH_IN0 ? 13 : 9, (float*)(ws + WS_MEMKV), MEMROW0};
            pg8::gemm_phase<pg8::EpiZ, pg8::SchedX, PG8_ALIGN, PG8_SP2, true>(c.lds + RING_OFF, g, S, E);
            { SgArgs sg{}; sg.A = (const bf16*)(ws + WS_XB) + (size_t)MP * DM; sg.Bt = (const bf16*)(ws + (ph == PH_IN0 ? WS_WIN0 : WS_WIN1)); sg.K = 1024; sg.mode = 0; sg.Z = (bf16*)(ws + WS_Z); sg.ldz = ph == PH_IN0 ? ZC0 : ZC1; sg.ssin = ssptr(c, ph == PH_IN0 ? 0 : 2);
              { const int nu = ph == PH_IN0 ? 64 * 13 + 16 : 64 * 9, rem = nu % c.G, busy = S.split ? 2 * rem : rem; sgemm_phase(c, sg, ph == PH_IN0 ? ZC0 : ZC1, busy && busy < c.G ? c.G - busy : c.G); } }
            __syncthreads();
            if (ph == PH_IN0) convert_tail(c, la, (64 * 13 + 16) % c.G, W_PRO, W_T1, ZC0 / 32);
            else if (S.split) convert_tail(c, la, 2 * S.rem, W_T1, W_NITEMS);
            else convert_tail(c, la, 0, W_T1, W_NITEMS);
        }
        else if (ph == PH_MIX0 && PHON(PH_MIX0)) p2_mixer0(c, la);
        else if (ph == PH_HSCAN && PHON(PH_HSCAN)) hgrn_scan(c, la);
        else if (ph == PH_HFIX && PHON(PH_HFIX)) p2c_hgrn_fix(c, la);
        else if ((ph == PH_OUT0 || ph == PH_DOWN0 || ph == PH_OUT1 || ph == PH_DOWN1) && PHON(PH_OUT0)) {
            const bool isout = (ph == PH_OUT0 || ph == PH_OUT1);
            pg8::Gemm g{(const pg8::bf16_t*)(ws + (isout ? WS_MIX : WS_ACT)), (const pg8::bf16_t*)(ws + (isout ? WS_WOUT + (size_t)layer * 1024 * 1024 * 2 : WS_WD + (size_t)layer * 1024 * DFF * 2)), MT, 1024, isout ? 1024 : DFF};
            pg8::SchedX S; S.init(MP, 1024, c.G, (int)blockIdx.x, 0, 0, 1, 0);
            pg8::EpiResid E;
            E.rp = ph == PH_OUT0 ? la.in[0] : nullptr; E.rb = (const pg8::bf16_t*)(ws + WS_XB); E.y = ph == PH_DOWN1 ? out + O_YP : nullptr;
            E.xb = ph == PH_DOWN1 ? nullptr : (pg8::bf16_t*)(ws + WS_XB); E.ssout = ph == PH_DOWN1 ? nullptr : ssptr(c, ph == PH_OUT0 ? 1 : (ph == PH_DOWN0 ? 2 : 3));
            pg8::gemm_phase<pg8::EpiResid, pg8::SchedX, PG8_ALIGN, PG8_SP2>(c.lds + RING_OFF, g, S, E);
            { SgArgs sg{}; sg.A = (const bf16*)(ws + (isout ? WS_MIX : WS_ACT)) + (size_t)MP * (isout ? 1024 : DFF); sg.Bt = (const bf16*)g.Bt; sg.K = isout ? 1024 : DFF; sg.mode = 1; sg.rb = (const bf16*)(ws + WS_XB); sg.resid = ph == PH_OUT0 ? la.in[1] : nullptr; sg.y = ph == PH_DOWN1 ? out + O_YS : nullptr; sg.xb = (bf16*)E.xb; sg.ssout = E.ssout;
              { const int rem = (64 * 4) % c.G; sgemm_phase(c, sg, 1024, rem ? c.G - rem : c.G); } }
        }
        else if ((ph == PH_GU0 || ph == PH_GU1) && PHON(PH_GU0)) {
            pg8::Gemm g{(const pg8::bf16_t*)(ws + WS_XB), (const pg8::bf16_t*)(ws + WS_WGU + (size_t)layer * 5632 * 1024 * 2), MT, 5632, 1024};
            pg8::SchedX S; S.init(MP, 5632, c.G, (int)blockIdx.x, 0, 0, 1, 0);
            pg8::EpiGU E{(pg8::bf16_t*)(ws + WS_ACT), ssptr(c, layer ? 3 : 1), out + O_CVP + (size_t)layer * 4 * 2 * DFF, la.in[26] + (size_t)layer * 3 * DFF, la.in[27] + (size_t)layer * DFF, (float*)(ws + WS_G4), (float*)(ws + WS_UP2)};
            pg8::gemm_phase<pg8::EpiGU, pg8::SchedX, PG8_ALIGN, PG8_SP2>(c.lds + RING_OFF, g, S, E);
            { SgArgs sg{}; sg.A = (const bf16*)(ws + WS_XB) + (size_t)MP * DM; sg.Bt = (const bf16*)g.Bt; sg.K = 1024; sg.mode = 2; sg.ssin = E.ss; sg.ACT = (bf16*)E.ACT; sg.cvs = out + O_CVS + (size_t)layer * 32 * 2 * DFF; sg.cst = la.in[8] + (size_t)layer * 32 * 2 * DFF; sg.cw = E.cw; sg.cb = E.cb;
              { const int rem = (64 * 22) % c.G; sgemm_phase(c, sg, 5632, rem ? c.G - rem : c.G);
 } }
        }
        else if (ph == PH_POST && PHON(PH_POST)) p8_dsa_post(c, la);
        else if (ph == PH_IDX && PHON(PH_IDX)) p9_indexer(c, la);
        else if (ph == PH_TOPK && PHON(PH_TOPK)) p10_topk(c, la);
        else if (ph == PH_ATTN && PHON(PH_ATTN)) p11_attention(c, la);
        if (REP_N > 1 && ph == REP_PH && c.qoff < 4 * (REP_N - 1)) { c.qoff += 4; --ph; xcd_barrier(bar); continue; }
        if (REP_N > 1) c.qoff = 0;
        if (ph + 1 < hi) xcd_barrier(bar);
    }
}

#ifndef MK_ONE_LAUNCH
#define MK_ONE_LAUNCH 1
#endif
extern "C" void kernel_launch(void* const* d_in, const int* in_sizes, int n_in, void* d_out, int out_size, void* d_ws, size_t ws_size, hipStream_t stream) {
    static int grid = 0;
    if (grid == 0) {
        if (n_in != 29 || out_size != (int)O_END || ws_size < WS_END) { fprintf(stderr, "kernel_launch: unexpected problem (n_in %d, out %d, ws %zu)\n", n_in, out_size, ws_size); grid = -1; return; }
        int dev = 0, cus = 0;
        if (hipGetDevice(&dev) != hipSuccess || hipDeviceGetAttribute(&cus, hipDeviceAttributeMultiprocessorCount, dev) != hipSuccess) { grid = -1; return; }
        if (hipFuncSetAttribute((const void*)fwd_kernel, hipFuncAttributeMaxDynamicSharedMemorySize, LDS_BYTES) != hipSuccess) { fprintf(stderr, "kernel_launch: hipFuncSetAttribute failed\n"); grid = -1; return; }
        (void)hipGetLastError();
        grid = cus;
    }
    if (grid < 0) return;
    if (hipMemsetAsync((char*)d_ws + WS_CTL, 0, CTL_ZERO_BYTES, stream) != hipSuccess) { fprintf(stderr, "kernel_launch: memset failed\n"); return; }
    Args a{};
    for (int i = 0; i < 29; ++i) a.in[i] = (const float*)d_in[i];
    a.page_table = (const int*)d_in[9]; a.out = (float*)d_out; a.ws = (unsigned char*)d_ws;
#if MK_ONE_LAUNCH
    a.ph_lo = 0; a.ph_hi = NPHASE;
    hipLaunchKernelGGL(fwd_kernel, dim3(grid), dim3(NWAVES * 64), LDS_BYTES, stream, a);
#else
    for (int ph = 0; ph < NPHASE; ++ph) { a.ph_lo = ph; a.ph_hi = ph + 1; hipLaunchKernelGGL(fwd_kernel, dim3(grid), dim3(NWAVES * 64), LDS_BYTES, stream, a); }
#endif
}
```

```cpp
#include <hip/hip_runtime.h>
#include <cstdio>
#include <cstdint>


namespace pg8 {
#define PG8_LAS __attribute__((address_space(3)))
typedef unsigned short bf16_t;
typedef short bf16x8 __attribute__((ext_vector_type(8)));
typedef float f32x4 __attribute__((ext_vector_type(4)));
typedef unsigned u32x4 __attribute__((ext_vector_type(4)));
constexpr int BM = 256, BK = 64, HALF = 128, HTB = HALF * BK * 2  , STAGE_BYTES = 8 * HTB, NXCD = 8, WGM = 4;

__host__ __device__ __forceinline__ int lds_byte(int r, int c) { const int st = (r >> 4) * 2 + (c >> 5), rr = r & 15, cc = c & 31, ob = rr * 64 + cc * 2; return st * 1024 + (ob ^ (((ob >> 9) & 1) << 5)); }
__host__ __device__ __forceinline__ void stage_rc(int b, int& R, int& C) { const int st = b / 1024, sb = b % 1024, swz = sb ^ (((sb >> 9) & 1) << 5); R = (st >> 1) * 16 + swz / 64; C = (st & 1) * 32 + (swz % 64) / 2; }
__host__ __device__ __forceinline__ int perm32(int rho) { const int n = rho >> 4, i = rho & 15; return 8 * (i >> 2) + 4 * n + (i & 3); }

struct Unit { int pm, pn, roff, nai; };
struct Gemm { const bf16_t* A; const bf16_t* Bt; int M, N, K; };

struct StaticOrder {
    int nM, nN, nwg, G, c;
    __host__ __device__ __forceinline__ void init(int M, int N, int G_, int c_) { nM = M / BM; nN = N / BM; nwg = nM * nN; G = G_; c = c_; }
    __host__ __device__ __forceinline__ bool next(int i, Unit& u) const { const long L = (long)i * G + c; if (L >= nwg) return false; map(L, u); return true; }
    __host__ __device__ __forceinline__ void map(long L, Unit& u) const {
        u.roff = 0; u.nai = 2;
        int wgid = (int)L; { const int q = nwg / NXCD, r = nwg % NXCD, xcd = wgid % NXCD, off = wgid / NXCD; wgid = (xcd < r ? xcd * (q + 1) : r * (q + 1) + (xcd - r) * q) + off; }
        const int nig = WGM * nN, gid = wgid / nig, fm = gid * WGM, gsz = (nM - fm) < WGM ? (nM - fm) : WGM;
        u.pm = fm + ((wgid % nig) % gsz); u.pn = (wgid % nig) / gsz;
    }
    __device__ __forceinline__ void a_ready(const Unit&) const {}
    __device__ __forceinline__ void done(const Unit&) const {}
};


constexpr int MP = 16384, MS = 128, MVALID = MP + MS, MT = 16640, DM = 1024, DFF = 2816;
constexpr float RMS_EPS = 1e-6f;
__device__ __forceinline__ unsigned cvt_pk_bf16(float lo, float hi) { unsigned r; asm volatile("v_cvt_pk_bf16_f32 %0, %1, %2" : "=v"(r) : "v"(lo), "v"(hi)); return r; }

struct SchedX {
    StaticOrder so; int nextra, e_pm0, e_nm, e_pn0, rs, rem; bool split;
    __device__ __forceinline__ void init(int M, int N, int G_, int c_, int nextra_, int e_pm0_, int e_nm_, int e_pn0_, bool split_last = false) {
        so.init(M, N, G_, c_); nextra = nextra_; e_pm0 = e_pm0_; e_nm = e_nm_; e_pn0 = e_pn0_; rs = so.nwg / G_; rem = so.nwg % G_; split = split_last && nextra_ == 0 && rem > 0 && 2 * rem <= G_;
    }
    __device__ __forceinline__ bool next(int i, Unit& u) const {
        if (split && i >= rs) {
            if (i > rs || so.c >= 2 * rem) return false;
            const int hf = so.c / rem; so.map((long)rs * so.G + (so.c - hf * rem), u); u.roff = hf * HALF; u.nai = 1; return true;
        }
        const long L = (long)i * so.G + so.c;
        if (L < so.nwg) { so.map(L, u); return true; }
        const int e = (int)(L - so.nwg); if (e >= nextra) return false;
        u.roff = 0; u.nai = 2; u.pm = e_pm0 + e % e_nm; u.pn = e_pn0 + e / e_nm; return true;
    }
    __device__ __forceinline__ void a_ready(const Unit&) const {}
    __device__ __forceinline__ void done(const Unit&) const {}
};

struct EpiZ {
    static constexpr bool PERM = true, AFTER_DRAIN = false;
    bf16_t* Z; int ldz; const float* ss; int nmain; float* memkv; int memrow0;
    __device__ __forceinline__ void operator()(const f32x4 (&acc)[2][2][4][2], const Unit& u, int wr, int wc, int fr, int fq) const {
        const int row0 = u.pm * BM + u.roff + wr * 64 + fr;
        if (u.pn < nmain) {
            const int col0 = u.pn * BM + wc * 32 + 8 * fq;
#pragma unroll
            for (int ai = 0; ai < 2; ++ai) if (ai < u.nai)
#pragma unroll
                for (int m = 0; m < 4; ++m) { const int row = row0 + ai * HALF + m * 16; const float rs = rsqrtf(ss[row] * (1.0f / DM) + RMS_EPS);
#pragma unroll
                    for (int bj = 0; bj < 2; ++bj) { const f32x4 v0 = acc[ai][bj][m][0] * rs, v1 = acc[ai][bj][m][1] * rs;
                        u32x4 w; w.x = cvt_pk_bf16(v0[0], v0[1]); w.y = cvt_pk_bf16(v0[2], v0[3]); w.z = cvt_pk_bf16(v1[0], v1[1]); w.w = cvt_pk_bf16(v1[2], v1[3]);
                        *(u32x4*)(Z + (size_t)row * ldz + col0 + bj * HALF) = w; } }
        } else {
            const int col0 = (u.pn - nmain) * BM + wc * 32 + 8 * fq;
#pragma unroll
            for (int ai = 0; ai < 2; ++ai)
#pragma unroll
                for (int m = 0; m < 4; ++m) { const int row = row0 + ai * HALF + m * 16 - memrow0;
#pragma unroll
                    for (int bj = 0; bj < 2; ++bj) { float* p = memkv + (size_t)row * 1024 + col0 + bj * HALF; *(f32x4*)p = acc[ai][bj][m][0]; *(f32x4*)(p + 4) = acc[ai][bj][m][1]; } }
        }
    }
};

struct EpiResid {
    static constexpr bool PERM = true, AFTER_DRAIN = false;
    const float* rp; const bf16_t* rb; float* y; bf16_t* xb; float* ssout;
    __device__ __forceinline__ void operator()(const f32x4 (&acc)[2][2][4][2], const Unit& u, int wr, int wc, int fr, int fq) const {
        const int row0 = u.pm * BM + wr * 64 + fr, col0 = u.pn * BM + wc * 32 + 8 * fq;
#pragma unroll
        for (int ai = 0; ai < 2; ++ai)
#pragma unroll
            for (int m = 0; m < 4; ++m) { const int row = row0 + ai * HALF + m * 16; float part = 0.f;
#pragma unroll
                for (int bj = 0; bj < 2; ++bj) { const int c = col0 + bj * HALF; f32x4 r0, r1;
                    if (rp) { r0 = *(const f32x4*)(rp + (size_t)row * DM + c); r1 = *(const f32x4*)(rp + (size_t)row * DM + c + 4); }
                    else { const u32x4 q = *(const u32x4*)(rb + (size_t)row * DM + c);
                        r0 = (f32x4){__builtin_bit_cast(float, q.x << 16), __builtin_bit_cast(float, q.x & 0xffff0000u), __builtin_bit_cast(float, q.y << 16), __builtin_bit_cast(float, q.y & 0xffff0000u)};
                        r1 = (f32x4){__builtin_bit_cast(float, q.z << 16), __builtin_bit_cast(float, q.z & 0xffff0000u), __builtin_bit_cast(float, q.w << 16), __builtin_bit_cast(float, q.w & 0xffff0000u)}; }
                    const f32x4 v0 = acc[ai][bj][m][0] + r0, v1 = acc[ai][bj][m][1] + r1;
                    if (y) { *(f32x4*)(y + (size_t)row * DM + c) = v0; *(f32x4*)(y + (size_t)row * DM + c + 4) = v1; }
                    part += (v0[0] * v0[0] + v0[1] * v0[1]) + (v0[2] * v0[2] + v0[3] * v0[3]) + (v1[0] * v1[0] + v1[1] * v1[1]) + (v1[2] * v1[2] + v1[3] * v1[3]);
                    if (xb) { u32x4 w; w.x = cvt_pk_bf16(v0[0], v0[1]); w.y = cvt_pk_bf16(v0[2], v0[3]); w.z = cvt_pk_bf16(v1[0], v1[1]); w.w = cvt_pk_bf16(v1[2], v1[3]);
                        *(u32x4*)(xb + (size_t)row * DM + c) = w; } }
                part += __shfl_xor(part, 16); part += __shfl_xor(part, 32);
                if (ssout && fq == 0) atomicAdd(ssout + row, part); }
    }
};

__device__ __forceinline__ void dpp_ror12(const f32x4& v, f32x4& r1, f32x4& r2) {
    float a0, a1, a2, a3, b0, b1, b2, b3;
    asm volatile("s_nop 1\n\t"
                 "v_mov_b32_dpp %0, %8 row_ror:1 row_mask:0xf bank_mask:0xf\n\tv_mov_b32_dpp %1, %9 row_ror:1 row_mask:0xf bank_mask:0xf\n\t"
                 "v_mov_b32_dpp %2, %10 row_ror:1 row_mask:0xf bank_mask:0xf\n\tv_mov_b32_dpp %3, %11 row_ror:1 row_mask:0xf bank_mask:0xf\n\t"
                 "v_mov_b32_dpp %4, %8 row_ror:2 row_mask:0xf bank_mask:0xf\n\tv_mov_b32_dpp %5, %9 row_ror:2 row_mask:0xf bank_mask:0xf\n\t"
                 "v_mov_b32_dpp %6, %10 row_ror:2 row_mask:0xf bank_mask:0xf\n\tv_mov_b32_dpp %7, %11 row_ror:2 row_mask:0xf bank_mask:0xf"
                 : "=&v"(a0), "=&v"(a1), "=&v"(a2), "=&v"(a3), "=&v"(b0), "=&v"(b1), "=&v"(b2), "=&v"(b3) : "v"(v[0]), "v"(v[1]), "v"(v[2]), "v"(v[3]));
    r1 = (f32x4){a0, a1, a2, a3}; r2 = (f32x4){b0, b1, b2, b3};
}
struct EpiGU {
    static constexpr bool PERM = true, AFTER_DRAIN = false;
    bf16_t* ACT; const float* ss; float* cvp; const float* cw; const float* cb; float* G4; float* UP2;
    __device__ __forceinline__ void operator()(const f32x4 (&acc)[2][2][4][2], const Unit& u, int wr, int wc, int fr, int fq) const {
        const int row0 = u.pm * BM + u.roff + wr * 64 + fr, colg = u.pn * HALF + wc * 32 + 8 * fq;
        f32x4 w0[2], w1[2], w2[2], bb[2];
#pragma unroll
        for (int n = 0; n < 2; ++n) { const int col = colg + 4 * n; w0[n] = *(const f32x4*)(cw + col); w1[n] = *(const f32x4*)(cw + DFF + col); w2[n] = *(const f32x4*)(cw + 2 * DFF + col); bb[n] = *(const f32x4*)(cb + col); }
#pragma unroll
        for (int ai = 0; ai < 2; ++ai) if (ai < u.nai) { f32x4 r1p[2] = {{0.f, 0.f, 0.f, 0.f}, {0.f, 0.f, 0.f, 0.f}}, r2p[2] = {{0.f, 0.f, 0.f, 0.f}, {0.f, 0.f, 0.f, 0.f}}; const int slab = (u.pm * BM + u.roff + ai * HALF + wr * 64) >> 6;
#pragma unroll
            for (int m = 0; m < 4; ++m) { const int row = row0 + ai * HALF + m * 16; const float rs = rsqrtf(ss[row] * (1.0f / DM) + RMS_EPS);
                f32x4 y[2], g[2], up[2];
#pragma unroll
                for (int n = 0; n < 2; ++n) { g[n] = acc[ai][0][m][n] * rs; up[n] = acc[ai][1][m][n] * rs;
                    f32x4 r1, r2; dpp_ror12(g[n], r1, r2);
                    const f32x4 p1 = fr >= 1 ? r1 : r1p[n], p2 = fr >= 2 ? r2 : r2p[n];
                    const f32x4 cv = bb[n] + w0[n] * p2 + w1[n] * p1 + w2[n] * g[n];
#pragma unroll
                    for (int i = 0; i < 4; ++i) y[n][i] = cv[i] * __builtin_amdgcn_rcpf(1.0f + __expf(-cv[i])) * up[n][i];
                    r1p[n] = r1; r2p[n] = r2; }
                if (m == 0 && fr < 2) {
#pragma unroll
                    for (int n = 0; n < 2; ++n) { *(f32x4*)(G4 + (size_t)(slab * 4 + fr) * DFF + colg + 4 * n) = g[n]; *(f32x4*)(UP2 + (size_t)(slab * 2 + fr) * DFF + colg + 4 * n) = up[n]; } }
                else { u32x4 w; w.x = cvt_pk_bf16(y[0][0], y[0][1]); w.y = cvt_pk_bf16(y[0][2], y[0][3]); w.z = cvt_pk_bf16(y[1][0], y[1][1]); w.w = cvt_pk_bf16(y[1][2], y[1][3]); *(u32x4*)(ACT + (size_t)row * DFF + colg) = w; }
                if (m == 3 && fr >= 14) {
#pragma unroll
                    for (int n = 0; n < 2; ++n) { *(f32x4*)(G4 + (size_t)(slab * 4 + 2 + (fr - 14)) * DFF + colg + 4 * n) = g[n];
                        const int t = row & 4095; if (t >= 4094) *(f32x4*)(cvp + (size_t)((row >> 12) * 2 + (t - 4094)) * DFF + colg + 4 * n) = g[n]; } } } }
    }
};

template <class Epi, class Sched, bool ALIGN_EPI = false, bool SP2 = false, bool HALFOK = false>
__device__ __forceinline__ void gemm_phase(PG8_LAS unsigned char* lds, const Gemm g, const Sched& S, const Epi& E) {
    int tid_ = threadIdx.x; asm volatile("" : "+v"(tid_));
    const int tid = tid_, wid = __builtin_amdgcn_readfirstlane(tid >> 6), lane = tid & 63, wr = wid >> 2, wc = wid & 3, fr = lane & 15, fq = lane >> 4;
    const int K = g.K, nt = K / BK;
    unsigned voffA[2], voffB[2];
#pragma unroll
    for (int i = 0; i < 2; ++i) { int R, C; stage_rc(tid * 16 + i * 8192, R, C); const int Rb = Epi::PERM ? ((R & ~31) + perm32(R & 31)) : R;
        voffA[i] = (unsigned)(R * K + C) * 2u; voffB[i] = (unsigned)(Rb * K + C) * 2u; }
    const size_t kstep = (size_t)(BK * 2);
    const size_t hstep = (size_t)HALF * K * 2;
    const size_t tstep = 2 * hstep;
    const unsigned ldsw = (unsigned)wid * 1024u;
    const int aoff = lds_byte(wr * 64 + fr, fq * 8), boff = lds_byte(wc * 32 + fr, fq * 8);
#define PG8_SA(b, h) (((b) * 2 + (h)) * HTB)
#define PG8_SB(b, h) ((4 + (b) * 2 + (h)) * HTB)
#define PG8_STAGE(bufoff, gbase, voff) do { _Pragma("unroll") for (int _i = 0; _i < 2; ++_i) \
        __builtin_amdgcn_global_load_lds((const unsigned*)((const char*)(gbase) + (voff)[_i]), (PG8_LAS unsigned*)(lds + (bufoff) + ldsw + _i * 8192), 16, 0, 0); } while (0)
#define PG8_LDA(dst, b, h) do { _Pragma("unroll") for (int m = 0; m < 4; ++m) _Pragma("unroll") for (int k = 0; k < 2; ++k) dst[m][k] = *(const PG8_LAS bf16x8*)(lds + PG8_SA(b, h) + aoff + m * 2048 + k * 1024); } while (0)
#define PG8_LDB(dst, b, h) do { _Pragma("unroll") for (int n = 0; n < 2; ++n) _Pragma("unroll") for (int k = 0; k < 2; ++k) dst[n][k] = *(const PG8_LAS bf16x8*)(lds + PG8_SB(b, h) + boff + n * 2048 + k * 1024); } while (0)
#define PG8_MMA(ai, bj, At, Bt) do { __builtin_amdgcn_s_setprio(1); _Pragma("unroll") for (int m = 0; m < 4; ++m) _Pragma("unroll") for (int n = 0; n < 2; ++n) _Pragma("unroll") for (int k = 0; k < 2; ++k) \
        acc[ai][bj][m][n] = __builtin_amdgcn_mfma_f32_16x16x32_bf16(Bt[n][k], At[m][k], acc[ai][bj][m][n], 0, 0, 0); __builtin_amdgcn_s_setprio(0); } while (0)
#define PG8_WAIT_V(n) asm volatile("s_waitcnt vmcnt(" #n ")" ::: "memory")
#define PG8_WAIT_L(n) asm volatile("s_waitcnt lgkmcnt(" #n ")" ::: "memory")
#define PG8_BAR __builtin_amdgcn_s_barrier()
#define PG8_SCHED __builtin_amdgcn_sched_barrier(0)
    Unit cur, nxt; int ui = 0;
    if (!S.next(0, cur)) return;
    f32x4 acc[2][2][4][2];
#pragma unroll
    for (int a = 0; a < 2; ++a)
#pragma unroll
        for (int b = 0; b < 2; ++b)
#pragma unroll
            for (int m = 0; m < 4; ++m)
#pragma unroll
                for (int n = 0; n < 2; ++n) acc[a][b][m][n] = (f32x4){0.f, 0.f, 0.f, 0.f};
    bf16x8 At[4][2], B0[2][2], B1[2][2];
    const char* cA = (const char*)g.A + (size_t)cur.pm * tstep + (size_t)cur.roff * K * 2; const char* cB = (const char*)g.Bt + (size_t)cur.pn * tstep;
    S.a_ready(cur);
    if constexpr (SP2) {
        PG8_STAGE(PG8_SB(0, 0), cB, voffB); PG8_STAGE(PG8_SB(0, 1), cB + hstep, voffB); PG8_STAGE(PG8_SA(0, 0), cA, voffA); PG8_STAGE(PG8_SA(0, 1), cA + hstep, voffA);
        if (wr == 1) PG8_BAR;
        PG8_WAIT_V(2); PG8_BAR;
        PG8_STAGE(PG8_SB(1, 0), cB + kstep, voffB); PG8_STAGE(PG8_SA(1, 0), cA + kstep, voffA); PG8_STAGE(PG8_SB(1, 1), cB + hstep + kstep, voffB);
        PG8_WAIT_V(6); PG8_BAR;
    } else {
        PG8_STAGE(PG8_SB(0, 0), cB, voffB); PG8_STAGE(PG8_SA(0, 0), cA, voffA); PG8_STAGE(PG8_SB(0, 1), cB + hstep, voffB); PG8_STAGE(PG8_SA(0, 1), cA + hstep, voffA);
        if (wr == 1) PG8_BAR;
        PG8_WAIT_V(4); PG8_BAR;
        PG8_STAGE(PG8_SB(1, 0), cB + kstep, voffB); PG8_STAGE(PG8_SA(1, 0), cA + kstep, voffA); PG8_STAGE(PG8_SB(1, 1), cB + hstep + kstep, voffB);
        PG8_WAIT_V(6); PG8_BAR;
    }
    for (;;) {
        const bool has_next = S.next(ui + 1, nxt);
        const char* nA = has_next ? (const char*)g.A + (size_t)nxt.pm * tstep + (size_t)nxt.roff * K * 2 : cA; const char* nB = has_next ? (const char*)g.Bt + (size_t)nxt.pn * tstep : cB;
        const bool full = !HALFOK || cur.nai == 2;
        for (int t = 0; t < nt; t += 2) {
            const bool last = (t == nt - 2);
            const char* a1 = cA + (size_t)(t + 1) * kstep;
            const char* a2 = last ? nA : cA + (size_t)(t + 2) * kstep; const char* b2 = last ? nB : cB + (size_t)(t + 2) * kstep;
            const char* a3 = a2 + kstep; const char* b3 = b2 + kstep;
            if (last && has_next) S.a_ready(nxt);
            if constexpr (SP2) {
            PG8_LDB(B0, 0, 0); PG8_LDB(B1, 0, 1); PG8_SCHED; PG8_LDA(At, 0, 0); PG8_STAGE(PG8_SA(1, 1), a1 + hstep, voffA);
            PG8_WAIT_V(8); PG8_WAIT_L(0); PG8_BAR; PG8_MMA(0, 0, At, B0); PG8_MMA(0, 1, At, B1); PG8_BAR; PG8_SCHED;
            if (full) PG8_LDA(At, 0, 1); PG8_STAGE(PG8_SB(0, 0), b2, voffB); PG8_STAGE(PG8_SB(0, 1), b2 + hstep, voffB); PG8_STAGE(PG8_SA(0, 0), a2, voffA);
            PG8_WAIT_V(8); PG8_WAIT_L(0); PG8_BAR; if (full) { PG8_MMA(1, 0, At, B0); PG8_MMA(1, 1, At, B1); } PG8_BAR; PG8_SCHED;
            PG8_LDB(B0, 1, 0); PG8_LDB(B1, 1, 1); PG8_SCHED; PG8_LDA(At, 1, 0); PG8_STAGE(PG8_SA(0, 1), a2 + hstep, voffA);
            PG8_WAIT_V(8); PG8_WAIT_L(0); PG8_BAR; PG8_MMA(0, 0, At, B0); PG8_MMA(0, 1, At, B1); PG8_BAR; PG8_SCHED;
            if (full) PG8_LDA(At, 1, 1); PG8_STAGE(PG8_SB(1, 0), b3, voffB); PG8_STAGE(PG8_SB(1, 1), b3 + hstep, voffB); PG8_STAGE(PG8_SA(1, 0), a3, voffA);
            PG8_WAIT_V(8); PG8_WAIT_L(0); PG8_BAR; if (full) { PG8_MMA(1, 0, At, B0); PG8_MMA(1, 1, At, B1); } PG8_BAR; PG8_SCHED;
            } else {
            PG8_LDB(B0, 0, 0); PG8_SCHED; PG8_LDA(At, 0, 0); PG8_STAGE(PG8_SA(1, 1), a1 + hstep, voffA);
            PG8_WAIT_L(8); PG8_BAR; PG8_WAIT_L(0); PG8_MMA(0, 0, At, B0); PG8_BAR; PG8_SCHED;
            PG8_LDB(B1, 0, 1); PG8_STAGE(PG8_SB(0, 0), b2, voffB);
            PG8_BAR; PG8_WAIT_L(0); PG8_MMA(0, 1, At, B1); PG8_BAR;
            PG8_LDA(At, 0, 1); PG8_STAGE(PG8_SA(0, 0), a2, voffA);
            PG8_BAR; PG8_WAIT_L(0); PG8_MMA(1, 0, At, B0); PG8_BAR; PG8_SCHED;
            PG8_STAGE(PG8_SB(0, 1), b2 + hstep, voffB);
            PG8_WAIT_V(6); PG8_BAR; PG8_MMA(1, 1, At, B1); PG8_BAR;
            PG8_LDB(B0, 1, 0); PG8_SCHED; PG8_LDA(At, 1, 0); PG8_STAGE(PG8_SA(0, 1), a2 + hstep, voffA);
            PG8_WAIT_L(8); PG8_BAR; PG8_WAIT_L(0); PG8_MMA(0, 0, At, B0); PG8_BAR; PG8_SCHED;
            PG8_LDB(B1, 1, 1); PG8_STAGE(PG8_SB(1, 0), b3, voffB);
            PG8_BAR; PG8_WAIT_L(0); PG8_MMA(0, 1, At, B1); PG8_BAR;
            PG8_LDA(At, 1, 1); PG8_STAGE(PG8_SA(1, 0), a3, voffA);
            PG8_BAR; PG8_WAIT_L(0); PG8_MMA(1, 0, At, B0); PG8_BAR; PG8_SCHED;
            PG8_STAGE(PG8_SB(1, 1), b3 + hstep, voffB);
            PG8_WAIT_V(6); PG8_BAR; PG8_MMA(1, 1, At, B1); PG8_BAR;
            }
        }
        if constexpr (ALIGN_EPI) { if (wr == 0) PG8_BAR; }
        if constexpr (!Epi::AFTER_DRAIN) { E(acc, cur, wr, wc, fr, fq); S.done(cur); }
        if (!has_next) break;
#pragma unroll
        for (int a = 0; a < 2; ++a)
#pragma unroll
            for (int b = 0; b < 2; ++b)
#pragma unroll
                for (int m = 0; m < 4; ++m)
#pragma unroll
                    for (int n = 0; n < 2; ++n) acc[a][b][m][n] = (f32x4){0.f, 0.f, 0.f, 0.f};
        cur = nxt; cA = nA; cB = nB; ++ui;
        if constexpr (ALIGN_EPI) { if (wr == 1) PG8_BAR; }
    }
    PG8_WAIT_V(0);
    if constexpr (!ALIGN_EPI) { if (wr == 0) PG8_BAR; }
    PG8_BAR;
    if constexpr (Epi::AFTER_DRAIN) { E.fused(acc, cur, wr, wc, fr, fq, lds, wid, lane); S.done(cur); }
#undef PG8_SA
#undef PG8_SB
#undef PG8_STAGE
#undef PG8_LDA
#undef PG8_LDB
#undef PG8_MMA
#undef PG8_WAIT_V
#undef PG8_WAIT_L
#undef PG8_BAR
#undef PG8_SCHED
}
}


#ifndef PG8_SP2
#define PG8_SP2 true
#endif
#ifndef PG8_ALIGN
#define PG8_ALIGN true
#endif
constexpr int NWAVES = 8;
constexpr int MP = pg8::MP, MS = pg8::MS, MVALID = pg8::MVALID, MT = pg8::MT, DM = 1024, DFF = 2816;
constexpr int SEQ = 4096, NB = 4, NSB = 32, PAST = 8192, NPOOL = 2560;
constexpr int ZC0 = 3328, ZC1 = 2304;
constexpr int Z1_Q = 0, Z1_K = 768, Z1_V = 1024, Z1_IQ = 1280, Z1_IK = 1792, Z1_IW = 1856, Z1_MQ = 1920;
constexpr int NMEMROWS = 1024, MEMROW0 = MT;
constexpr float EPS = 1e-6f;
constexpr size_t MiB = 1u << 20;
constexpr size_t WS_CTL = 0, CTL_ZERO_BYTES = 2 * MiB;
constexpr size_t WS_WIN0 = 2 * MiB, WS_WIN1 = 11 * MiB, WS_WOUT = 16 * MiB, WS_WGU = 20 * MiB, WS_WD = 42 * MiB;
constexpr size_t WS_XB = 54 * MiB, WS_MEMKV = 89 * MiB, WS_MIX = 94 * MiB, WS_Z = 128 * MiB, WS_U = 234 * MiB, WS_UP = 324 * MiB, WS_ACT = 414 * MiB;
constexpr size_t WS_QB = 504 * MiB, WS_KB = 528 * MiB, WS_VB = 536 * MiB, WS_IQB = 544 * MiB, WS_IKB = 560 * MiB, WS_IW = 562 * MiB;
constexpr size_t WS_SQ = 563 * MiB, WS_SIQ = WS_SQ + 512 * 1024, WS_SIW = WS_SIQ + 384 * 1024, WS_SSC = 564 * MiB, WS_SIDX = 569 * MiB, WS_MASK = 570 * MiB, WS_SC = 578 * MiB, WS_END = 834 * MiB;
constexpr int SSC_LD = 8256;
constexpr int CW_TMO = 0, CW_BAR = 4096, CW_Q = 8192, CW_SS = 16384;
constexpr size_t O_YP = 0, O_YS = O_YP + (size_t)MP * DM, O_HP = O_YS + (size_t)MS * DM, O_HS = O_HP + 4 * 6 * 16384, O_KP = O_HS + 32 * 6 * 16384,
    O_VP = O_KP + (size_t)MP * 256, O_IKP = O_VP + (size_t)MP * 256, O_KS = O_IKP + (size_t)MP * 64, O_VS = O_KS + MS * 256, O_IKS = O_VS + MS * 256,
    O_MK = O_IKS + MS * 64, O_MV = O_MK + 2 * 1024 * 256, O_CVP = O_MV + 2 * 1024 * 256, O_CVS = O_CVP + 2 * 4 * 2 * DFF, O_END = O_CVS + 2 * 32 * 2 * DFF;
static_assert(O_END == 31412224, "output size");
constexpr int RING_OFF = 0, RING_BYTES = 131072;
constexpr int LDSCTL_OFF = RING_BYTES, MISC_OFF = LDSCTL_OFF + 320;
constexpr int LDS_BYTES = 147456;

#define GAS __attribute__((address_space(1)))
#define LAS __attribute__((address_space(3)))
typedef unsigned short bf16;
typedef unsigned v4u __attribute__((ext_vector_type(4)));
typedef float f32x4 __attribute__((ext_vector_type(4)));
typedef short bf16x8 __attribute__((ext_vector_type(8)));
typedef GAS unsigned gu32;
typedef GAS unsigned long long gu64;
#define RLX_AGENT __ATOMIC_RELAXED, __HIP_MEMORY_SCOPE_AGENT
#define LDS_WAIT() asm volatile("s_waitcnt lgkmcnt(0)" ::: "memory")
#define VM_WAIT() asm volatile("s_waitcnt vmcnt(0)" ::: "memory")
__device__ __forceinline__ unsigned long long rt() { return __builtin_amdgcn_s_memrealtime(); }
__device__ __forceinline__ unsigned f2bf(float f) { unsigned u = __builtin_bit_cast(unsigned, f); return (u + 0x7fffu + ((u >> 16) & 1u)) >> 16; }
__device__ __forceinline__ unsigned pk2(float lo, float hi) { return f2bf(lo) | (f2bf(hi) << 16); }

#define XB_TMO      128
#define XB_XCNT(j)  (256  + 64 * (j))
#define XB_XSUB(j)  (1280 + 64 * (j))
#define XB_XGEN(j)  (2304 + 64 * (j))
#define XB_TOP      3328
#define XB_TOPGEN   3392
#define XCD_BAR_WORDS 3456
#define XB_SPIN_CAP (1u << 18)

__device__ __forceinline__ unsigned xb_ld(unsigned* p)              { return __hip_atomic_load(p, __ATOMIC_RELAXED, __HIP_MEMORY_SCOPE_AGENT); }
__device__ __forceinline__ unsigned xb_add(unsigned* p, unsigned v) { return __hip_atomic_fetch_add(p, v, __ATOMIC_RELAXED, __HIP_MEMORY_SCOPE_AGENT); }
__device__ __forceinline__ unsigned xb_xcc_id() { return (unsigned)__builtin_amdgcn_s_getreg((3 << 11) | 20) & 0xFu; }
#define XB_SPIN(cond, bar) do { unsigned _sp = 0; while (cond) { __builtin_amdgcn_s_sleep(1); \
    if ((++_sp & 255u) == 0u) { if (xb_ld(&(bar)[XB_TMO])) break; if (_sp > XB_SPIN_CAP) { atomicAdd(&(bar)[XB_TMO], 1u); break; } } } } while (0)

struct XcdBarrier {
    unsigned* bar; unsigned x;
    volatile LAS unsigned* st;
};

__device__ __forceinline__ XcdBarrier xcd_barrier_post(unsigned* bar, volatile LAS unsigned* st) {
    XcdBarrier b; b.bar = bar; b.x = xb_xcc_id(); b.st = st;
    if (threadIdx.x == 0) (void)xb_add(&bar[XB_XCNT(b.x)], 1u);
    return b;
}
__device__ __forceinline__ void xcd_barrier_complete(unsigned* bar, unsigned x, unsigned& nloc, unsigned& nx) {
    const unsigned G = gridDim.x * gridDim.y * gridDim.z;
    unsigned sum, cnt, mine, sp = 0u;
    for (;;) {
        sum = 0u; cnt = 0u; mine = 0u;
#pragma unroll
        for (unsigned j = 0; j < 16; ++j) { const unsigned c = xb_ld(&bar[XB_XCNT(j)]); sum += c; cnt += (c > 0u) ? 1u : 0u; mine = (j == x) ? c : mine; }
        if (sum == G) break;
        __builtin_amdgcn_s_sleep(1);
        if ((++sp & 255u) == 0u) { if (xb_ld(&bar[XB_TMO])) break; if (sp > XB_SPIN_CAP) { atomicAdd(&bar[XB_TMO], 1u); break; } }
    }
    nloc = mine > 0u ? mine : 1u; nx = cnt > 0u ? cnt : 1u;
}

__device__ __forceinline__ void xcd_barrier(const XcdBarrier& b) {
    asm volatile("s_waitcnt vmcnt(0)" ::: "memory");
    __syncthreads();
    if (threadIdx.x == 0) {
        unsigned* bar = b.bar;
        __builtin_amdgcn_s_waitcnt(0);
        unsigned nloc = b.st[0], nx = b.st[1];
        if (nloc == 0u) { xcd_barrier_complete(bar, b.x, nloc, nx); b.st[0] = nloc; b.st[1] = nx; }
        const unsigned old = xb_add(&bar[XB_XSUB(b.x)], 1u);
        const unsigned gen = old / nloc;
        if (old + 1u == (gen + 1u) * nloc) {
            __builtin_amdgcn_fence(__ATOMIC_RELEASE, "agent");
            asm volatile("s_waitcnt vmcnt(0)" ::: "memory");
            const unsigned og = xb_add(&bar[XB_TOP], 1u);
            const unsigned tg = og / nx;
            if (og + 1u == (tg + 1u) * nx) xb_add(&bar[XB_TOPGEN], 1u);
            else XB_SPIN(xb_ld(&bar[XB_TOPGEN]) == tg, bar);
            __builtin_amdgcn_fence(__ATOMIC_ACQUIRE, "agent");
            xb_add(&bar[XB_XGEN(b.x)], 1u);
            asm volatile("s_waitcnt vmcnt(0)" ::: "memory");
        } else {
            XB_SPIN(xb_ld(&bar[XB_XGEN(b.x)]) == gen, bar);
            __builtin_amdgcn_fence(__ATOMIC_ACQUIRE, "agent");
            asm volatile("s_waitcnt vmcnt(0)" ::: "memory");
        }
    }
    __syncthreads();
}


struct Args { const float* in[29]; const int* page_table; float* out; unsigned char* ws; int ph_lo, ph_hi; };
typedef const __attribute__((address_space(4))) Args& ARGREF;
struct Ctx { LAS unsigned char* lds; volatile LAS unsigned* MISC; gu32* ctl; int tid, lane, wave, vcu, G, qoff; };
typedef float f32x16 __attribute__((ext_vector_type(16)));
typedef unsigned long long u64;

__device__ __forceinline__ float bf2f(unsigned b) { return __builtin_bit_cast(float, b << 16); }
__device__ __forceinline__ float wave_sum(float v) {
#pragma unroll
    for (int o = 1; o < 64; o <<= 1) v += __shfl_xor(v, o);
    return v;
}
__device__ __forceinline__ float wave_sum_fast(float x) {
    x += __builtin_bit_cast(float, __builtin_amdgcn_update_dpp(0, __builtin_bit_cast(int, x), 0xB1, 0xF, 0xF, false));
    x += __builtin_bit_cast(float, __builtin_amdgcn_update_dpp(0, __builtin_bit_cast(int, x), 0x4E, 0xF, 0xF, false));
    x += __builtin_bit_cast(float, __builtin_amdgcn_update_dpp(0, __builtin_bit_cast(int, x), 0x141, 0xF, 0xF, false));
    x += __builtin_bit_cast(float, __builtin_amdgcn_update_dpp(0, __builtin_bit_cast(int, x), 0x140, 0xF, 0xF, false));
    const int xi = __builtin_bit_cast(int, x);
    return (__builtin_bit_cast(float, __builtin_amdgcn_readlane(xi, 0)) + __builtin_bit_cast(float, __builtin_amdgcn_readlane(xi, 16))) +
           (__builtin_bit_cast(float, __builtin_amdgcn_readlane(xi, 32)) + __builtin_bit_cast(float, __builtin_amdgcn_readlane(xi, 48)));
}
__device__ __forceinline__ int crow(int r, int hi) { return (r & 3) + 8 * (r >> 2) + 4 * hi; }
__device__ __forceinline__ float sigmoidf_(float x) { return __builtin_amdgcn_rcpf(1.0f + __expf(-x)); }
__device__ __forceinline__ float* ssptr(const Ctx& c, int i) { return (float*)(c.ctl + CW_SS) + (size_t)i * MT; }

__device__ __forceinline__ int q_next(Ctx& c, int qi) {
    __syncthreads();
    if (c.tid == 0) c.MISC[16] = atomicAdd((unsigned*)(c.ctl + CW_Q + 64 * (qi + c.qoff)), 1u);
    __syncthreads();
    return (int)c.MISC[16];
}

template <int K>
__device__ __forceinline__ f32x16 mm32(const LAS bf16* A, int lda, const LAS bf16* Bt, int ldb, f32x16 acc, int lane) {
    const int r = lane & 31, h = lane >> 5;
#pragma unroll
    for (int ks = 0; ks < K; ks += 16) {
        const bf16x8 a = *(const LAS bf16x8*)(A + r * lda + ks + 8 * h);
        const bf16x8 b = *(const LAS bf16x8*)(Bt + r * ldb + ks + 8 * h);
        acc = __builtin_amdgcn_mfma_f32_32x32x16_bf16(a, b, acc, 0, 0, 0);
    }
    return acc;
}

__device__ __forceinline__ int map_row(int mapid, int n, int row_off) {
    if (mapid == 0) return n + row_off;
    if (mapid == 1) return n < 1864 ? n : n + 56;
    if (mapid == 2) return (n >> 7) * 256 + (n & 127);
    return (n >> 7) * 256 + 128 + (n & 127);
}
template <int MODE>
__device__ __forceinline__ void transpose_item(const float* W, int K, int N, const float* kscale, bf16* WT, int mapid, int row_off, LAS float* scr, int item, int lane, f32x4 (&v)[8], float (&sc)[8]) {
    const int nblk = (N + 31) / 32, kb = item / nblk, nb = item % nblk, k0 = 64 * kb, n0 = 32 * nb;
    const int n4 = (lane & 7) * 4;
    if (MODE != 2) { const int nn = n0 + n4 < N ? n0 + n4 : N - 4;
#pragma unroll
      for (int i = 0; i < 8; ++i) v[i] = *(const f32x4*)(W + (size_t)(k0 + 8 * i + (lane >> 3)) * N + nn);
#pragma unroll
      for (int i = 0; i < 8; ++i) sc[i] = kscale ? kscale[k0 + 8 * i + (lane >> 3)] : 1.0f; }
    if (MODE == 1) return;
#pragma unroll
    for (int i = 0; i < 8; ++i) { const int kk = 8 * i + (lane >> 3); LAS float* d = scr + kk * 33 + n4;
        d[0] = v[i].x * sc[i]; d[1] = v[i].y * sc[i]; d[2] = v[i].z * sc[i]; d[3] = v[i].w * sc[i]; }
    LDS_WAIT(); asm volatile("" ::: "memory");
    const int cc = lane & 7;
#pragma unroll
    for (int j = 0; j < 4; ++j) { const int nl = (lane >> 3) + 8 * j, n = n0 + nl; const LAS float* s = scr + (8 * cc) * 33 + nl;
        v4u o; o.x = pk2(s[0 * 33], s[1 * 33]); o.y = pk2(s[2 * 33], s[3 * 33]); o.z = pk2(s[4 * 33], s[5 * 33]); o.w = pk2(s[6 * 33], s[7 * 33]);
        if (n < N) *(GAS v4u*)(WT + (size_t)map_row(mapid, n, row_off) * K + k0 + 8 * cc) = o; }
    LDS_WAIT(); asm volatile("" ::: "memory");
}
constexpr int I_INH = 16 * 104, I_MKV = 16 * 16, I_DSA = 16 * 67, I_OUT = 16 * 32, I_G = 16 * 88, I_D = 44 * 32;
constexpr int W_N0 = I_INH + 2 * I_MKV + I_OUT + 2 * I_G + I_D, W_NITEMS = W_N0 + I_DSA + I_OUT + 2 * I_G + I_D;
template <int MODE>
__device__ __forceinline__ void convert_item(ARGREF a, int it, LAS float* scr, int lane, f32x4 (&v)[8], float (&sc)[8]) {
    unsigned char* ws = a.ws; int r = it;
    if (r < I_INH) { transpose_item<MODE>(a.in[13], 1024, 3328, a.in[11], (bf16*)(ws + WS_WIN0), 0, 0, scr, r, lane, v, sc); return; } r -= I_INH;
    if (r < 2 * I_MKV) { const int l = r / I_MKV; transpose_item<MODE>(a.in[20] + (size_t)l * 1024 * 512, 1024, 512, nullptr, (bf16*)(ws + WS_WIN0), 0, 3328 + 512 * l, scr, r % I_MKV, lane, v, sc); return; } r -= 2 * I_MKV;
    int l = 0;
    if (r >= I_OUT + 2 * I_G + I_D) { r -= I_OUT + 2 * I_G + I_D; l = 1;
        if (r < I_DSA) { transpose_item<MODE>(a.in[16], 1024, 2120, a.in[11] + 1024, (bf16*)(ws + WS_WIN1), 1, 0, scr, r, lane, v, sc); return; } r -= I_DSA; }
    if (r < I_OUT) { transpose_item<MODE>(a.in[23] + (size_t)l * 1024 * 1024, 1024, 1024, nullptr, (bf16*)(ws + WS_WOUT) + (size_t)l * 1024 * 1024, 0, 0, scr, r, lane, v, sc); return; } r -= I_OUT;
    if (r < I_G) { transpose_item<MODE>(a.in[24] + (size_t)l * 1024 * DFF, 1024, DFF, a.in[12] + l * 1024, (bf16*)(ws + WS_WGU) + (size_t)l * 5632 * 1024, 2, 0, scr, r, lane, v, sc); return; } r -= I_G;
    if (r < I_G) { transpose_item<MODE>(a.in[25] + (size_t)l * 1024 * DFF, 1024, DFF, a.in[12] + l * 1024, (bf16*)(ws + WS_WGU) + (size_t)l * 5632 * 1024, 3, 0, scr, r, lane, v, sc); return; } r -= I_G;
    transpose_item<MODE>(a.in[28] + (size_t)l * DFF * 1024, DFF, 1024, nullptr, (bf16*)(ws + WS_WD) + (size_t)l * 1024 * DFF, 0, 0, scr, r, lane, v, sc);
}
constexpr int W_PRO = I_INH + 2 * I_MKV + I_OUT + I_G, W_T0 = W_N0 + I_DSA, W_T1 = W_T0 + I_OUT + I_G;
__device__ __forceinline__ void convert_tail(Ctx& c, ARGREF a, int first_idle, int it0, int it1, int nlight = 0) {
    LAS float* scr = (LAS float*)(c.lds + RING_OFF + c.wave * 16384);
    const int bx = (int)blockIdx.x; if (bx < first_idle) return;
    const int nidle = c.G - first_idle, nheavy = nidle - (nlight < nidle ? nlight : nidle), bi = bx - first_idle;
    const int nslots = nheavy * NWAVES * 3 + (nidle - nheavy) * NWAVES * 2;
    const int my0 = bi < nheavy ? (bi * NWAVES + c.wave) * 3 : nheavy * NWAVES * 3 + ((bi - nheavy) * NWAVES + c.wave) * 2, myn = bi < nheavy ? 3 : 2;
    f32x4 vA[8], vB[8]; float sA[8], sB[8];
    int q = 0, it = it0 + my0;
    if (it < it1) convert_item<1>(a, it, scr, c.lane, vA, sA);
#pragma unroll 1
    while (it < it1) { ++q; const int nx = it0 + (q / myn) * nslots + my0 + q % myn;
        if (nx < it1) convert_item<1>(a, nx, scr, c.lane, vB, sB);
        convert_item<2>(a, it, scr, c.lane, vA, sA);
#pragma unroll
        for (int i = 0; i < 8; ++i) { vA[i] = vB[i]; sA[i] = sB[i]; }
        it = nx; }
}
__device__ __forceinline__ void p0_prologue(Ctx& c, ARGREF a) {
    LAS float* scr = (LAS float*)(c.lds + RING_OFF + c.wave * 16384);
    const int gw = c.vcu * NWAVES + c.wave, NGW = c.G * NWAVES, lane = c.lane;
    unsigned char* ws = a.ws;
    { f32x4 vA[8], vB[8]; float sA[8], sB[8]; int it = gw;
      if (it < W_PRO) convert_item<1>(a, it, scr, lane, vA, sA);
#pragma unroll 1
      while (it < W_PRO) { const int nx = it + NGW;
          if (nx < W_PRO) convert_item<1>(a, nx, scr, lane, vB, sB);
          convert_item<2>(a, it, scr, lane, vA, sA);
#pragma unroll
          for (int i = 0; i < 8; ++i) { vA[i] = vB[i]; sA[i] = sB[i]; }
          it = nx; } }
    for (int rr = gw; rr < 184; rr += NGW) { const int row = rr < 56 ? 1864 + rr : 2176 + (rr - 56);
        GAS v4u* p = (GAS v4u*)((bf16*)(ws + WS_WIN1) + (size_t)row * 1024); p[lane] = (v4u){0u, 0u, 0u, 0u}; p[64 + lane] = (v4u){0u, 0u, 0u, 0u}; }
    float* ss0 = ssptr(c, 0);
    for (int m = gw; m < MT + NMEMROWS; m += NGW) {
        GAS u64* o8 = (GAS u64*)((bf16*)(ws + WS_XB) + (size_t)m * DM) + lane;
        if (m >= MVALID && m < MT) {
#pragma unroll
            for (int j = 0; j < 4; ++j) o8[64 * j] = 0ull;
            continue; }
        const float* src = m < MP ? a.in[0] + (size_t)m * DM : (m < MVALID ? a.in[1] + (size_t)(m - MP) * DM : a.in[10] + (size_t)(m - MT) * DM);
        const GAS f32x4* xr = (const GAS f32x4*)src + lane; f32x4 v[4]; float s = 0.f;
#pragma unroll
        for (int j = 0; j < 4; ++j) { v[j] = xr[64 * j]; s += (v[j].x * v[j].x + v[j].y * v[j].y) + (v[j].z * v[j].z + v[j].w * v[j].w); }
        s = wave_sum_fast(s);
#pragma unroll
        for (int j = 0; j < 4; ++j) o8[64 * j] = (u64)pk2(v[j].x, v[j].y) | ((u64)pk2(v[j].z, v[j].w) << 32);
        if (m < MVALID && lane == 0) ss0[m] = s;
    }
}

__device__ __forceinline__ void memattn_unit(Ctx& c, const bf16* Zq  , int ldz, int nrows_valid, const float* Kp, const float* Vp, int kstride,
                                             bool normk, const float* kgain, const float* qgain, bf16* Out  ) {
    LAS bf16* KN = (LAS bf16*)(c.lds);
    LAS bf16* VTm = (LAS bf16*)(c.lds + 36864);
    LAS bf16* QN = (LAS bf16*)(c.lds + 70656) + c.wave * (32 * 72);
    LAS float* LI = (LAS float*)(c.lds + 107520) + c.wave * 32;
    int tid = c.tid; asm volatile("" : "+v"(tid));
    const int lane = tid & 63, w = c.wave;
    {
        const int m = tid >> 1, dh = (tid & 1) * 32;
        f32x4 kv[8]; float s = 0.f;
#pragma unroll
        for (int j = 0; j < 8; ++j) { kv[j] = *(const f32x4*)(Kp + (size_t)m * kstride + dh + 4 * j); s += (kv[j].x * kv[j].x + kv[j].y * kv[j].y) + (kv[j].z * kv[j].z + kv[j].w * kv[j].w); }
        s += __shfl_xor(s, 1);
        const float rs = normk ? rsqrtf(s * (1.0f / 64.0f) + EPS) : 1.0f;
#pragma unroll
        for (int j = 0; j < 8; j += 2) { f32x4 g0 = {1.f, 1.f, 1.f, 1.f}, g1 = g0;
            if (normk) { g0 = *(const f32x4*)(kgain + dh + 4 * j); g1 = *(const f32x4*)(kgain + dh + 4 * j + 4); }
            const f32x4 x0 = kv[j] * rs * g0, x1 = kv[j + 1] * rs * g1;
            v4u o; o.x = pk2(x0.x, x0.y); o.y = pk2(x0.z, x0.w); o.z = pk2(x1.x, x1.y); o.w = pk2(x1.z, x1.w);
            *(LAS v4u*)(KN + m * 72 + dh + 4 * j) = o; }
#pragma unroll
        for (int j = 0; j < 8; ++j) { const f32x4 vv = *(const f32x4*)(Vp + (size_t)m * kstride + dh + 4 * j);
            VTm[(dh + 4 * j + 0) * 264 + m] = (bf16)f2bf(vv.x); VTm[(dh + 4 * j + 1) * 264 + m] = (bf16)f2bf(vv.y);
            VTm[(dh + 4 * j + 2) * 264 + m] = (bf16)f2bf(vv.z); VTm[(dh + 4 * j + 3) * 264 + m] = (bf16)f2bf(vv.w); }
    }
    {
        const int row = lane >> 1, hf = lane & 1, grow = w * 32 + row;
        float x[32]; float s = 0.f;
        if (grow < nrows_valid) {
#pragma unroll
            for (int j = 0; j < 4; ++j) { const v4u q = *(const v4u*)(Zq + (size_t)grow * ldz + hf * 32 + 8 * j);
                x[8 * j + 0] = bf2f(q.x & 0xffffu); x[8 * j + 1] = bf2f(q.x >> 16); x[8 * j + 2] = bf2f(q.y & 0xffffu); x[8 * j + 3] = bf2f(q.y >> 16);
                x[8 * j + 4] = bf2f(q.z & 0xffffu); x[8 * j + 5] = bf2f(q.z >> 16); x[8 * j + 6] = bf2f(q.w & 0xffffu); x[8 * j + 7] = bf2f(q.w >> 16); }
        } else {
#pragma unroll
            for (int j = 0; j < 32; ++j) x[j] = 0.f;
        }
#pragma unroll
        for (int j = 0; j < 32; ++j) s += x[j] * x[j];
        s += __shfl_xor(s, 1);
        const float rs = rsqrtf(s * (1.0f / 64.0f) + EPS) * 0.125f;
#pragma unroll
        for (int j = 0; j < 32; j += 8) { v4u o;
            o.x = pk2(x[j] * rs * qgain[hf * 32 + j], x[j + 1] * rs * qgain[hf * 32 + j + 1]); o.y = pk2(x[j + 2] * rs * qgain[hf * 32 + j + 2], x[j + 3] * rs * qgain[hf * 32 + j + 3]);
            o.z = pk2(x[j + 4] * rs * qgain[hf * 32 + j + 4], x[j + 5] * rs * qgain[hf * 32 + j + 5]); o.w = pk2(x[j + 6] * rs * qgain[hf * 32 + j + 6], x[j + 7] * rs * qgain[hf * 32 + j + 7]);
            *(LAS v4u*)(QN + row * 72 + hf * 32 + j) = o; }
    }
    __syncthreads();
    if (w * 32 < nrows_valid) {
        const int r32 = lane & 31, hh = lane >> 5;
        f32x16 s[8];
#pragma unroll
        for (int mt = 0; mt < 8; ++mt) { f32x16 z = {}; s[mt] = mm32<64>(KN + mt * 32 * 72, 72, QN, 72, z, lane); }
        float mx = -1e30f;
#pragma unroll
        for (int mt = 0; mt < 8; ++mt)
#pragma unroll
            for (int r = 0; r < 16; ++r) mx = fmaxf(mx, s[mt][r]);
        mx = fmaxf(mx, __shfl_xor(mx, 32));
        float l = 0.f;
#pragma unroll
        for (int mt = 0; mt < 8; ++mt)
#pragma unroll
            for (int r = 0; r < 16; ++r) { const float p = __expf(s[mt][r] - mx); s[mt][r] = p; l += p; }
        l += __shfl_xor(l, 32);
        if (hh == 0) LI[r32] = l;
        f32x16 o[2] = {};
#pragma unroll
        for (int mt = 0; mt < 8; ++mt)
#pragma unroll
            for (int sx = 0; sx < 2; ++sx) {
                v4u pa; pa.x = pk2(s[mt][8 * sx + 0], s[mt][8 * sx + 1]); pa.y = pk2(s[mt][8 * sx + 2], s[mt][8 * sx + 3]);
                pa.z = pk2(s[mt][8 * sx + 4], s[mt][8 * sx + 5]); pa.w = pk2(s[mt][8 * sx + 6], s[mt][8 * sx + 7]);
                const bf16x8 af = __builtin_bit_cast(bf16x8, pa);
#pragma unroll
                for (int dt = 0; dt < 2; ++dt) { const LAS bf16* vp = VTm + (dt * 32 + r32) * 264 + mt * 32 + 16 * sx + 4 * hh;
                    const u64 lo = *(const LAS u64*)vp, hi = *(const LAS u64*)(vp + 8);
                    v4u bw; bw.x = (unsigned)lo; bw.y = (unsigned)(lo >> 32); bw.z = (unsigned)hi; bw.w = (unsigned)(hi >> 32);
                    o[dt] = __builtin_amdgcn_mfma_f32_32x32x16_bf16(af, __builtin_bit_cast(bf16x8, bw), o[dt], 0, 0, 0); }
            }
        LDS_WAIT();
#pragma unroll
        for (int r = 0; r < 16; ++r) { const int qr = crow(r, hh), grow = w * 32 + qr; const float il = __builtin_amdgcn_rcpf(LI[qr]);
            if (grow < nrows_valid) {
#pragma unroll
                for (int dt = 0; dt < 2; ++dt) Out[(size_t)grow * DM + dt * 32 + r32] = (bf16)f2bf(o[dt][r] * il); } }
    }
}

constexpr int HG_GS = 4, HG_NG = SEQ / (32 * HG_GS);
constexpr size_t WS_HOL = WS_U, WS_HQC = WS_UP, WS_HUT = WS_ACT, WS_HST = WS_ACT + 64 * MiB, WS_HDG = WS_ACT + 50 * MiB;
template <bool PROMPT>
__device__ __forceinline__ void hgrn_unit(Ctx& c, ARGREF a, int b, int h, int g) {
    LAS unsigned char* L = c.lds;
    LAS float* LFt = (LAS float*)(L + 0);
    LAS float* OB = (LAS float*)(L + 0);
    LAS float* SEG = (LAS float*)(L + 16896);
    LAS float* DVv = (LAS float*)(L + 18944);
    LAS bf16* QD = (LAS bf16*)(L + 19456);
    LAS bf16* KD = (LAS bf16*)(L + 28160);
    LAS bf16* KET = (LAS bf16*)(L + 36864);
    LAS bf16* VT = (LAS bf16*)(L + 47104);
    LAS bf16* SCB = (LAS bf16*)(L + 57344);
    LAS bf16* STt = (LAS bf16*)(L + 59904);
    LAS float* BOFF = (LAS float*)(L + 94720);
    int tid = c.tid; asm volatile("" : "+v"(tid));
    const int lane = tid & 63, w = c.wave, r32 = lane & 31, hh = lane >> 5;
    const int te = tid & 31, k8 = (tid >> 5) * 8;
    const int tf = tid >> 4, v8 = (tid & 15) * 8;
    const bf16* Z = (const bf16*)(a.ws + WS_Z);
    bf16* MIX = (bf16*)(a.ws + WS_MIX);
    const int nch = PROMPT ? HG_GS : 1, nvalid = PROMPT ? 32 : 4;
    const int kt = w >> 1, vt0 = 2 * (w & 1);
    const int unit = (b * 6 + h) * HG_NG + g;
    f32x16 S0 = {}, S1 = {};
    if (!PROMPT) { const float* sp = a.in[7] + (size_t)(b * 6 + h) * 16384;
#pragma unroll
        for (int r = 0; r < 16; ++r) { const int k = 32 * kt + crow(r, hh); S0[r] = sp[k * 128 + 32 * vt0 + r32]; S1[r] = sp[k * 128 + 32 * (vt0 + 1) + r32]; } }
    float lbv[8];
#pragma unroll
    for (int j = 0; j < 8; ++j) { const float l0 = a.in[14][h * 128 + k8 + j], l1 = a.in[14][768 + h * 128 + k8 + j]; lbv[j] = 1.0f / (1.0f + __expf(l1 - l0)); }
    __syncthreads();
    if (tid < 128) BOFF[tid] = 0.f;
#define HG_WRITE_ST() do { _Pragma("unroll") for (int g4 = 0; g4 < 4; ++g4) { const int k0 = 32 * kt + 8 * g4 + 4 * hh; \
        *(LAS u64*)(STt + (32 * vt0 + r32) * 136 + k0) = (u64)pk2(S0[4 * g4], S0[4 * g4 + 1]) | ((u64)pk2(S0[4 * g4 + 2], S0[4 * g4 + 3]) << 32); \
        *(LAS u64*)(STt + (32 * (vt0 + 1) + r32) * 136 + k0) = (u64)pk2(S1[4 * g4], S1[4 * g4 + 1]) | ((u64)pk2(S1[4 * g4 + 2], S1[4 * g4 + 3]) << 32); } } while (0)
    HG_WRITE_ST();
    v4u zq = {0u, 0u, 0u, 0u}, zf = zq, zi = zq;
    { const int row = (PROMPT ? b * SEQ + (g * HG_GS) * 32 : MP + 4 * b) + te;
      if (te < nvalid) { const bf16* zr = Z + (size_t)row * ZC0 + h * 128 + k8; zq = *(const v4u*)zr; zf = *(const v4u*)(zr + 768); zi = *(const v4u*)(zr + 1536); } }
#pragma unroll 1
    for (int ch = 0; ch < nch; ++ch) {
        const int row0 = PROMPT ? b * SEQ + (g * HG_GS + ch) * 32 : MP + 4 * b, row = row0 + te;
        const bool valid = te < nvalid;
        float qs[8], kk[8];
        {
            const unsigned qw[4] = {zq.x, zq.y, zq.z, zq.w}, fw[4] = {zf.x, zf.y, zf.z, zf.w}, iw[4] = {zi.x, zi.y, zi.z, zi.w};
#pragma unroll
            for (int j = 0; j < 8; ++j) { const float q = bf2f((qw[j >> 1] >> (16 * (j & 1))) & 0xffffu), fp = bf2f((fw[j >> 1] >> (16 * (j & 1))) & 0xffffu);
                const float sg = sigmoidf_(fp), f = lbv[j] + (1.0f - lbv[j]) * sg;
                qs[j] = valid ? q * sigmoidf_(q) : 0.f; kk[j] = valid ? (1.0f - f) : 0.f;
                LFt[(k8 + j) * 33 + te] = valid ? __logf(f) : 0.f;
                VT[(k8 + j) * 40 + te] = (bf16)((iw[j >> 1] >> (16 * (j & 1))) & 0xffffu); }
            if (PROMPT && ch + 1 < nch) { const bf16* zr = Z + (size_t)(row + 32) * ZC0 + h * 128 + k8; zq = *(const v4u*)zr; zf = *(const v4u*)(zr + 768); zi = *(const v4u*)(zr + 1536); }
        }
        __syncthreads();
        {
            const int k = tid & 127, sg_ = tid >> 7; float bsum = 0.f;
#pragma unroll
            for (int i = 0; i < 8; ++i) { bsum += LFt[k * 33 + 8 * sg_ + i]; LFt[k * 33 + 8 * sg_ + i] = bsum; }
            SEG[sg_ * 128 + k] = bsum; }
        __syncthreads();
        {
            float bb[8], bl[8];
            { f32x4 t0[4], t1[4];
#pragma unroll
              for (int s_ = 0; s_ < 4; ++s_) { t0[s_] = *(const LAS f32x4*)(SEG + s_ * 128 + k8); t1[s_] = *(const LAS f32x4*)(SEG + s_ * 128 + k8 + 4); }
              const int sgt = te >> 3; f32x4 o0 = {0.f, 0.f, 0.f, 0.f}, o1 = o0;
#pragma unroll
              for (int s_ = 0; s_ < 3; ++s_) if (s_ < sgt) { o0 += t0[s_]; o1 += t1[s_]; }
              const f32x4 l0 = (t0[0] + t0[1]) + (t0[2] + t0[3]), l1 = (t1[0] + t1[1]) + (t1[2] + t1[3]);
              const float of[8] = {o0.x, o0.y, o0.z, o0.w, o1.x, o1.y, o1.z, o1.w}; const float lt[8] = {l0.x, l0.y, l0.z, l0.w, l1.x, l1.y, l1.z, l1.w};
#pragma unroll
              for (int j = 0; j < 8; ++j) { bb[j] = LFt[(k8 + j) * 33 + te] + of[j]; bl[j] = lt[j]; } }
            float qd[8], kd[8];
#pragma unroll
            for (int j = 0; j < 8; ++j) { qd[j] = qs[j] * __expf(bb[j]); kd[j] = kk[j] * __expf(-bb[j]); KET[(k8 + j) * 40 + te] = (bf16)f2bf(kk[j] * __expf(bl[j] - bb[j])); }
            v4u o; o.x = pk2(qd[0], qd[1]); o.y = pk2(qd[2], qd[3]); o.z = pk2(qd[4], qd[5]); o.w = pk2(qd[6], qd[7]); *(LAS v4u*)(QD + te * 136 + k8) = o;
            if (PROMPT) { const f32x4 f0 = *(const LAS f32x4*)(BOFF + k8), f1 = *(const LAS f32x4*)(BOFF + k8 + 4);
                const float bo[8] = {f0.x, f0.y, f0.z, f0.w, f1.x, f1.y, f1.z, f1.w}; float qc[8];
#pragma unroll
                for (int j = 0; j < 8; ++j) qc[j] = qd[j] * __expf(bo[j]);
                v4u oc; oc.x = pk2(qc[0], qc[1]); oc.y = pk2(qc[2], qc[3]); oc.z = pk2(qc[4], qc[5]); oc.w = pk2(qc[6], qc[7]);
                *(v4u*)((bf16*)(a.ws + WS_HQC) + (size_t)row * 768 + h * 128 + k8) = oc; }
            o.x = pk2(kd[0], kd[1]); o.y = pk2(kd[2], kd[3]); o.z = pk2(kd[4], kd[5]); o.w = pk2(kd[6], kd[7]); *(LAS v4u*)(KD + te * 136 + k8) = o;
            if (te == 0) {
#pragma unroll
                for (int j = 0; j < 8; ++j) DVv[k8 + j] = __expf(bl[j]); }
        }
        __syncthreads();
        f32x16 oacc = {};
        if (w == 4) { f32x16 z = {}; const f32x16 sc = mm32<128>(QD, 136, KD, 136, z, lane);
#pragma unroll
            for (int r = 0; r < 16; ++r) { const int t = crow(r, hh); SCB[t * 40 + r32] = (bf16)f2bf(r32 <= t ? sc[r] : 0.f); } }
        if (w < 4) oacc = mm32<128>(QD, 136, STt + (w * 32) * 136, 136, oacc, lane);
        if (PROMPT && tid >= 384) { const int k = tid - 384; BOFF[k] += (SEG[k] + SEG[128 + k]) + (SEG[256 + k] + SEG[384 + k]); }
        __syncthreads();
        if (w < 4) { oacc = mm32<32>(SCB, 40, VT + (w * 32) * 40, 40, oacc, lane);
#pragma unroll
            for (int r = 0; r < 16; ++r) OB[crow(r, hh) * 128 + w * 32 + r32] = oacc[r]; }
        {
#pragma unroll
            for (int r = 0; r < 16; ++r) { const float d = DVv[32 * kt + crow(r, hh)]; S0[r] *= d; S1[r] *= d; }
            S0 = mm32<32>(KET + (kt * 32) * 40, 40, VT + (vt0 * 32) * 40, 40, S0, lane);
            S1 = mm32<32>(KET + (kt * 32) * 40, 40, VT + ((vt0 + 1) * 32) * 40, 40, S1, lane);
        }
        __syncthreads();
        HG_WRITE_ST();
        {
            const int orow = row0 + tf;
            const f32x4 o0 = *(const LAS f32x4*)(OB + tf * 128 + v8), o1 = *(const LAS f32x4*)(OB + tf * 128 + v8 + 4);
            if (PROMPT) { float* ol = (float*)(a.ws + WS_HOL) + (size_t)orow * 768 + h * 128 + v8; *(f32x4*)ol = o0; *(f32x4*)(ol + 4) = o1; }
            else {
                float ov[8] = {o0.x, o0.y, o0.z, o0.w, o1.x, o1.y, o1.z, o1.w}; float s = 0.f;
#pragma unroll
                for (int j = 0; j < 8; ++j) s += ov[j] * ov[j];
                s += __shfl_xor(s, 1); s += __shfl_xor(s, 2); s += __shfl_xor(s, 4); s += __shfl_xor(s, 8);
                const float rs = rsqrtf(s * (1.0f / 128.0f) + EPS);
                if (tf < nvalid) { const v4u gz = *(const v4u*)(Z + (size_t)orow * ZC0 + 2304 + h * 128 + v8); const unsigned gw_[4] = {gz.x, gz.y, gz.z, gz.w}; float y[8];
#pragma unroll
                    for (int j = 0; j < 8; ++j) { const float gg = bf2f((gw_[j >> 1] >> (16 * (j & 1))) & 0xffffu); y[j] = ov[j] * rs * a.in[15][v8 + j] * (gg * sigmoidf_(gg)); }
                    v4u o; o.x = pk2(y[0], y[1]); o.y = pk2(y[2], y[3]); o.z = pk2(y[4], y[5]); o.w = pk2(y[6], y[7]); *(v4u*)(MIX + (size_t)orow * DM + h * 128 + v8) = o; }
            }
        }
        __syncthreads();
    }
#undef HG_WRITE_ST
    if (PROMPT) {
        float* ut = (float*)(a.ws + WS_HUT) + (size_t)unit * 16384;
#pragma unroll
        for (int g4 = 0; g4 < 4; ++g4) { const int k0 = 32 * kt + 8 * g4 + 4 * hh;
            *(f32x4*)(ut + (32 * vt0 + r32) * 128 + k0) = (f32x4){S0[4 * g4], S0[4 * g4 + 1], S0[4 * g4 + 2], S0[4 * g4 + 3]};
            *(f32x4*)(ut + (32 * (vt0 + 1) + r32) * 128 + k0) = (f32x4){S1[4 * g4], S1[4 * g4 + 1], S1[4 * g4 + 2], S1[4 * g4 + 3]}; }
        if (tid < 128) ((float*)(a.ws + WS_HDG))[(size_t)unit * 128 + tid] = __expf(BOFF[tid]);
    } else {
        float* so = a.out + O_HS + (size_t)(b * 6 + h) * 16384;
#pragma unroll
        for (int r = 0; r < 16; ++r) { const int k = 32 * kt + crow(r, hh); so[k * 128 + 32 * vt0 + r32] = S0[r]; so[k * 128 + 32 * (vt0 + 1) + r32] = S1[r]; }
    }
}
__device__ __forceinline__ void hgrn_scan(Ctx& c, ARGREF a) {
    const float* UT = (const float*)(a.ws + WS_HUT); const float* DG = (const float*)(a.ws + WS_HDG); bf16* STo = (bf16*)(a.ws + WS_HST);
    for (int idx = c.vcu * 512 + c.tid; idx < 24 * 16384; idx += c.G * 512) {
        const int bh = idx >> 14, e = idx & 16383, k = e & 127, v = e >> 7;
        float s = 0.f, ut[HG_NG], dg[HG_NG];
#pragma unroll
        for (int g = 0; g < HG_NG; ++g) { const size_t u = (size_t)(bh * HG_NG + g); ut[g] = UT[u * 16384 + e]; dg[g] = DG[u * 128 + k]; }
#pragma unroll
        for (int g = 0; g < HG_NG; ++g) { const size_t u = (size_t)(bh * HG_NG + g); STo[u * 16384 + e] = (bf16)f2bf(s); s = dg[g] * s + ut[g]; }
        a.out[O_HP + (size_t)bh * 16384 + k * 128 + v] = s;
    }
}
__device__ __forceinline__ void hgrn_fix_unit(Ctx& c, ARGREF a, int b, int h, int g) {
    LAS bf16* STt = (LAS bf16*)(c.lds);
    LAS bf16* QCl = (LAS bf16*)(c.lds + 34816);
    LAS float* OB = (LAS float*)(c.lds + 34816 + 17408);
    int tid = c.tid; asm volatile("" : "+v"(tid));
    const int lane = tid & 63, w = c.wave, r32 = lane & 31, hh = lane >> 5;
    const int unit = (b * 6 + h) * HG_NG + g, row0 = b * SEQ + g * 128;
    const bf16* Z = (const bf16*)(a.ws + WS_Z); bf16* MIX = (bf16*)(a.ws + WS_MIX);
    const bf16* QC = (const bf16*)(a.ws + WS_HQC); const float* OL = (const float*)(a.ws + WS_HOL);
    const bf16* stg = (const bf16*)(a.ws + WS_HST) + (size_t)unit * 16384;
    v4u stv[4];
#pragma unroll
    for (int i = 0; i < 4; ++i) { const int cidx = tid + 512 * i, v = cidx >> 4, kc = (cidx & 15) * 8; stv[i] = *(const v4u*)(stg + v * 128 + kc); }
    __syncthreads();
#pragma unroll
    for (int i = 0; i < 4; ++i) { const int cidx = tid + 512 * i, v = cidx >> 4, kc = (cidx & 15) * 8; *(LAS v4u*)(STt + v * 136 + kc) = stv[i]; }
    const int te = tid >> 4, k8 = (tid & 15) * 8;
    float onv[8];
#pragma unroll
    for (int j = 0; j < 8; ++j) onv[j] = a.in[15][k8 + j];
#pragma unroll 1
    for (int hf = 0; hf < 2; ++hf) {
        const int rb = row0 + hf * 64;
#pragma unroll
        for (int i = 0; i < 2; ++i) { const int cidx = tid + 512 * i, r = cidx >> 4, kc = (cidx & 15) * 8; *(LAS v4u*)(QCl + r * 136 + kc) = *(const v4u*)(QC + (size_t)(rb + r) * 768 + h * 128 + kc); }
        f32x4 pl0[2], pl1[2]; v4u pgz[2];
#pragma unroll
        for (int ps = 0; ps < 2; ++ps) { const int row = rb + ps * 32 + te; const float* ol = OL + (size_t)row * 768 + h * 128 + k8; pl0[ps] = *(const f32x4*)ol; pl1[ps] = *(const f32x4*)(ol + 4);
            pgz[ps] = *(const v4u*)(Z + (size_t)row * ZC0 + 2304 + h * 128 + k8); }
        __syncthreads();
        { const int rt = w >> 2, vt = w & 3; f32x16 o = {};
          o = mm32<128>(QCl + (rt * 32) * 136, 136, STt + (vt * 32) * 136, 136, o, lane);
#pragma unroll
          for (int r = 0; r < 16; ++r) OB[(rt * 32 + crow(r, hh)) * 128 + vt * 32 + r32] = o[r]; }
        __syncthreads();
#pragma unroll
        for (int ps = 0; ps < 2; ++ps) { const int r = ps * 32 + te, row = rb + r;
            const f32x4 c0 = *(const LAS f32x4*)(OB + r * 128 + k8), c1 = *(const LAS f32x4*)(OB + r * 128 + k8 + 4);
            const f32x4 l0 = pl0[ps], l1 = pl1[ps]; const v4u gz = pgz[ps];
            float ov[8] = {c0.x + l0.x, c0.y + l0.y, c0.z + l0.z, c0.w + l0.w, c1.x + l1.x, c1.y + l1.y, c1.z + l1.z, c1.w + l1.w}; float s = 0.f;
#pragma unroll
            for (int j = 0; j < 8; ++j) s += ov[j] * ov[j];
            s += __shfl_xor(s, 1); s += __shfl_xor(s, 2); s += __shfl_xor(s, 4); s += __shfl_xor(s, 8);
            const float rs = rsqrtf(s * (1.0f / 128.0f) + EPS);
            const unsigned gw_[4] = {gz.x, gz.y, gz.z, gz.w}; float y[8];
#pragma unroll
            for (int j = 0; j < 8; ++j) { const float gg = bf2f((gw_[j >> 1] >> (16 * (j & 1))) & 0xffffu); y[j] = ov[j] * rs * onv[j] * (gg * sigmoidf_(gg)); }
            v4u o; o.x = pk2(y[0], y[1]); o.y = pk2(y[2], y[3]); o.z = pk2(y[4], y[5]); o.w = pk2(y[6], y[7]); *(v4u*)(MIX + (size_t)row * DM + h * 128 + k8) = o; }
        __syncthreads();
    }
}

__device__ __forceinline__ void memkv_finalize_row(ARGREF a, int layer, int row, int lane) {
    const float* src = (const float*)(a.ws + WS_MEMKV) + (size_t)row * 1024 + layer * 512;
    const int hd = lane >> 4, d4 = (lane & 15) * 4;
    const f32x4 k = *(const f32x4*)(src + hd * 64 + d4), v = *(const f32x4*)(src + 256 + hd * 64 + d4);
    float s = (k.x * k.x + k.y * k.y) + (k.z * k.z + k.w * k.w);
    s += __shfl_xor(s, 1); s += __shfl_xor(s, 2); s += __shfl_xor(s, 4); s += __shfl_xor(s, 8);
    const float rs = rsqrtf(s * (1.0f / 64.0f) + EPS); const f32x4 g = *(const f32x4*)(a.in[22] + layer * 64 + d4);
    *(f32x4*)(a.out + O_MK + ((size_t)layer * 1024 + row) * 256 + hd * 64 + d4) = k * rs * g;
    *(f32x4*)(a.out + O_MV + ((size_t)layer * 1024 + row) * 256 + hd * 64 + d4) = v;
}

__device__ __forceinline__ void memattn_prompt_unit(Ctx& c, ARGREF a, int layer, int u) {
    const int blk = u & 15, hd = (u >> 4) & 3, b = u >> 6;
    const bf16* Z = (const bf16*)(a.ws + WS_Z); const int ldz = layer ? ZC1 : ZC0, qc = layer ? Z1_MQ : 3072;
    const float* kv = (const float*)(a.ws + WS_MEMKV) + (size_t)(b * 256) * 1024 + layer * 512 + hd * 64;
    const int row0 = b * SEQ + blk * 256;
    memattn_unit(c, Z + (size_t)row0 * ldz + qc + hd * 64, ldz, 256, kv, kv + 256, 1024, true, a.in[22] + layer * 64, a.in[21] + layer * 64,
                 (bf16*)(a.ws + WS_MIX) + (size_t)row0 * DM + 768 + hd * 64);
}
__device__ __forceinline__ void memattn_sample_unit(Ctx& c, ARGREF a, int layer, int u) {
    const int hd = u & 3, sb = u >> 2;
    const bf16* Z = (const bf16*)(a.ws + WS_Z); const int ldz = layer ? ZC1 : ZC0, qc = layer ? Z1_MQ : 3072;
    const size_t off = ((size_t)(layer * 32 + sb) * 256) * 256 + hd * 64;
    const int row0 = MP + sb * 4;
    memattn_unit(c, Z + (size_t)row0 * ldz + qc + hd * 64, ldz, 4, a.in[5] + off, a.in[6] + off, 256, false, nullptr, a.in[21] + layer * 64,
                 (bf16*)(a.ws + WS_MIX) + (size_t)row0 * DM + 768 + hd * 64);
}

__device__ __forceinline__ void p2_mixer0(Ctx& c, ARGREF a) {
    constexpr int U_HP = 24 * HG_NG, U_MAP = U_HP + 256, U_HS = U_MAP + 192, U_MAS = U_HS + 128, U_FIN = U_MAS + 256;
    for (;;) {
        const int u = q_next(c, 0);
        if (u >= U_FIN) break;
        if (u < U_HP) hgrn_unit<true>(c, a, u / (6 * HG_NG), (u / HG_NG) % 6, u % HG_NG);
        else if (u < U_MAP) memattn_prompt_unit(c, a, 0, u - U_HP);
        else if (u < U_HS) { const int v = u - U_MAP; hgrn_unit<false>(c, a, v / 6, v % 6, 0); }
        else if (u < U_MAS) memattn_sample_unit(c, a, 0, u - U_HS);
        else { const int v = (u - U_MAS) * 8 + c.wave; memkv_finalize_row(a, v >> 10, v & 1023, c.lane); }
    }
}
__device__ __forceinline__ void p2c_hgrn_fix(Ctx& c, ARGREF a) {
    for (int u = c.vcu; u < 24 * HG_NG; u += c.G) hgrn_fix_unit(c, a, u / (6 * HG_NG), (u / HG_NG) % 6, u % HG_NG);
}

constexpr size_t WS_G4 = WS_UP + 64 * MiB, WS_UP2 = WS_UP + 80 * MiB;
__device__ __forceinline__ void conv_fixup_tile(Ctx& c, ARGREF a, int layer, int pm) {
    const float* G4 = (const float*)(a.ws + WS_G4); const float* UP2 = (const float*)(a.ws + WS_UP2); bf16* ACT = (bf16*)(a.ws + WS_ACT);
    const float* cw = a.in[26] + (size_t)layer * 3 * DFF; const float* cb = a.in[27] + (size_t)layer * DFF;
    int tid = c.tid; asm volatile("" : "+v"(tid));
#pragma unroll 1
    for (int i0 = 0; i0 < 12; i0 += 4) {
        f32x4 ut[4], up[4], s1[4], s2[4], w0[4], w1[4], w2[4], bb[4]; int rowv[4], c4v[4]; bool z1[4], z2[4];
#pragma unroll
        for (int j = 0; j < 4; ++j) { const int i = i0 + j < 11 ? i0 + j : 10, idx = tid + 512 * i;
            const int rr = idx / (DFF / 4), c4 = (idx - rr * (DFF / 4)) * 4;
            const int slab = 4 * pm + (rr >> 1), fr = rr & 1, row = slab * 64 + fr, t = row & 4095, sl1 = slab > 0 ? slab - 1 : 0;
            ut[j] = *(const f32x4*)(G4 + (size_t)(slab * 4 + fr) * DFF + c4); up[j] = *(const f32x4*)(UP2 + (size_t)(slab * 2 + fr) * DFF + c4);
            s1[j] = *(const f32x4*)(G4 + (size_t)(fr ? slab * 4 : sl1 * 4 + 3) * DFF + c4);
            s2[j] = *(const f32x4*)(G4 + (size_t)(fr ? sl1 * 4 + 3 : sl1 * 4 + 2) * DFF + c4);
            z1[j] = !fr && t == 0; z2[j] = fr ? t == 1 : t == 0;
            w0[j] = *(const f32x4*)(cw + c4); w1[j] = *(const f32x4*)(cw + DFF + c4); w2[j] = *(const f32x4*)(cw + 2 * DFF + c4); bb[j] = *(const f32x4*)(cb + c4);
            rowv[j] = row; c4v[j] = c4; }
#pragma unroll
        for (int j = 0; j < 4; ++j) { const f32x4 zero = {0.f, 0.f, 0.f, 0.f};
            const f32x4 u1 = z1[j] ? zero : s1[j], u2 = z2[j] ? zero : s2[j];
            const f32x4 cv = bb[j] + w0[j] * u2 + w1[j] * u1 + w2[j] * ut[j];
            const float y0 = cv.x * sigmoidf_(cv.x) * up[j].x, y1 = cv.y * sigmoidf_(cv.y) * up[j].y, y2 = cv.z * sigmoidf_(cv.z) * up[j].z, y3 = cv.w * sigmoidf_(cv.w) * up[j].w;
            *(u64*)(ACT + (size_t)rowv[j] * DFF + c4v[j]) = (u64)pk2(y0, y1) | ((u64)pk2(y2, y3) << 32); }
    }
}


struct SgArgs { const bf16* A; const bf16* Bt; int K; int mode; bf16* Z; int ldz; const float* ssin; const float* resid; const bf16* rb; float* y; bf16* xb; float* ssout; bf16* ACT; float* cvs; const float* cst; const float* cw; const float* cb; };
__device__ __forceinline__ void sgemm_unit(Ctx& c, const SgArgs& g, int n0) {
    int tid = c.tid; asm volatile("" : "+v"(tid));
    const int lane = tid & 63, w = c.wave, r32 = lane & 31, hh = lane >> 5;
    const int K = g.K, ks = K >> 3;
    const int f2 = (n0 >> 1) + (r32 & 15), brow = g.mode == 2 ? (f2 >> 7) * 256 + (f2 & 127) + (r32 >= 16 ? 128 : 0) : n0 + r32;
    const bf16* bp = g.Bt + (size_t)brow * K + w * ks + 8 * hh;
    const bf16* ap = g.A + (size_t)r32 * K + w * ks + 8 * hh;
    f32x16 acc[4] = {};
    bf16x8 afA[4][2], bfA[2], afB[4][2], bfB[2];
#define SG_LOAD(AF, BF, kk) do { _Pragma("unroll") for (int i = 0; i < 2; ++i) { BF[i] = *(const bf16x8*)(bp + (kk) + 16 * i); \
        _Pragma("unroll") for (int rt = 0; rt < 4; ++rt) AF[rt][i] = *(const bf16x8*)(ap + (size_t)(rt * 32) * K + (kk) + 16 * i); } } while (0)
#define SG_MMA(AF, BF) do { _Pragma("unroll") for (int i = 0; i < 2; ++i) _Pragma("unroll") for (int rt = 0; rt < 4; ++rt) acc[rt] = __builtin_amdgcn_mfma_f32_32x32x16_bf16(AF[rt][i], BF[i], acc[rt], 0, 0, 0); } while (0)
    SG_LOAD(afA, bfA, 0);
#pragma unroll 1
    for (int k = 0; k < ks; k += 64) {
        if (k + 32 < ks) SG_LOAD(afB, bfB, k + 32);
        SG_MMA(afA, bfA);
        if (k + 32 < ks) { if (k + 64 < ks) SG_LOAD(afA, bfA, k + 64); SG_MMA(afB, bfB); }
    }
#undef SG_LOAD
#undef SG_MMA
    LAS float* RED = (LAS float*)(c.lds);
    __syncthreads();
#pragma unroll
    for (int rt = 0; rt < 4; ++rt)
#pragma unroll
        for (int r = 0; r < 16; ++r) RED[((w * 4 + rt) * 16 + r) * 64 + lane] = acc[rt][r];
    __syncthreads();
    const int rt = w & 3, rh = w >> 2, col = n0 + r32;
    float v[8];
#pragma unroll
    for (int i = 0; i < 8; ++i) { float s = 0.f;
#pragma unroll
        for (int ww = 0; ww < 8; ++ww) s += RED[((ww * 4 + rt) * 16 + 8 * rh + i) * 64 + lane];
        v[i] = s; }
    if (g.mode == 0) {
#pragma unroll
        for (int i = 0; i < 8; ++i) { const int row = MP + rt * 32 + crow(8 * rh + i, hh); const float rs = rsqrtf(g.ssin[row] * (1.0f / DM) + EPS); g.Z[(size_t)row * g.ldz + col] = (bf16)f2bf(v[i] * rs); }
    } else if (g.mode == 1) {
#pragma unroll
        for (int i = 0; i < 8; ++i) { const int lr = rt * 32 + crow(8 * rh + i, hh), row = MP + lr;
            const float x = v[i] + (g.resid ? g.resid[(size_t)lr * DM + col] : bf2f(g.rb[(size_t)row * DM + col]));
            if (g.y) g.y[(size_t)lr * DM + col] = x; if (g.xb) g.xb[(size_t)row * DM + col] = (bf16)f2bf(x);
            float s = x * x; s += __shfl_xor(s, 1); s += __shfl_xor(s, 2); s += __shfl_xor(s, 4); s += __shfl_xor(s, 8); s += __shfl_xor(s, 16);
            if (g.ssout && r32 == 0) atomicAdd(g.ssout + row, s); }
    } else {
        float gu[8], upv[8];
#pragma unroll
        for (int i = 0; i < 8; ++i) { const int row = MP + rt * 32 + crow(8 * rh + i, hh); gu[i] = v[i] * rsqrtf(g.ssin[row] * (1.0f / DM) + EPS); upv[i] = __shfl_xor(gu[i], 16); }
        if (r32 < 16) { const float w0 = g.cw[f2], w1 = g.cw[DFF + f2], w2 = g.cw[2 * DFF + f2], bb = g.cb[f2];
#pragma unroll
            for (int aa = 0; aa < 2; ++aa) { const int lr0 = rt * 32 + 8 * (2 * rh + aa) + 4 * hh, sb = lr0 >> 2;
                const float s0 = g.cst[(size_t)(sb * 2) * DFF + f2], s1 = g.cst[(size_t)(sb * 2 + 1) * DFF + f2];
                const float u0 = gu[4 * aa], u1 = gu[4 * aa + 1], u2 = gu[4 * aa + 2], u3 = gu[4 * aa + 3];
                const float cv[4] = {bb + w0 * s0 + w1 * s1 + w2 * u0, bb + w0 * s1 + w1 * u0 + w2 * u1, bb + w0 * u0 + w1 * u1 + w2 * u2, bb + w0 * u1 + w1 * u2 + w2 * u3};
#pragma unroll
                for (int t = 0; t < 4; ++t) g.ACT[(size_t)(MP + lr0 + t) * DFF + f2] = (bf16)f2bf(cv[t] * sigmoidf_(cv[t]) * upv[4 * aa + t]);
                g.cvs[(size_t)(sb * 2) * DFF + f2] = u2; g.cvs[(size_t)(sb * 2 + 1) * DFF + f2] = u3; } }
    }
}
template <int NST>
__device__ __forceinline__ void sgemm_unit_r1(Ctx& c, const SgArgs& g, int n0, int rt) {
    int tid = c.tid; asm volatile("" : "+v"(tid));
    const int lane = tid & 63, w = c.wave, r32 = lane & 31, hh = lane >> 5;
    const int K = g.K, ks = K >> 3;
    const bf16* bp = g.Bt + (size_t)(n0 + r32) * K + w * ks + 8 * hh;
    const bf16* ap = g.A + (size_t)(rt * 32 + r32) * K + w * ks + 8 * hh;
    f32x16 acc = {};
    bf16x8 af[NST][2], bf_[NST][2];
#pragma unroll
    for (int s = 0; s < NST; ++s)
#pragma unroll
        for (int i = 0; i < 2; ++i) { af[s][i] = *(const bf16x8*)(ap + 32 * s + 16 * i); bf_[s][i] = *(const bf16x8*)(bp + 32 * s + 16 * i); }
#pragma unroll
    for (int s = 0; s < NST; ++s)
#pragma unroll
        for (int i = 0; i < 2; ++i) acc = __builtin_amdgcn_mfma_f32_32x32x16_bf16(af[s][i], bf_[s][i], acc, 0, 0, 0);
    LAS float* RED = (LAS float*)(c.lds);
    __syncthreads();
#pragma unroll
    for (int r = 0; r < 16; ++r) RED[(w * 16 + r) * 64 + lane] = acc[r];
    __syncthreads();
    const int col = n0 + r32;
#pragma unroll
    for (int i = 0; i < 2; ++i) { float v = 0.f;
#pragma unroll
        for (int ww = 0; ww < 8; ++ww) v += RED[(ww * 16 + 2 * w + i) * 64 + lane];
        const int lr = rt * 32 + crow(2 * w + i, hh), row = MP + lr;
        const float x = v + (g.resid ? g.resid[(size_t)lr * DM + col] : bf2f(g.rb[(size_t)row * DM + col]));
        if (g.y) g.y[(size_t)lr * DM + col] = x; if (g.xb) g.xb[(size_t)row * DM + col] = (bf16)f2bf(x);
        float s = x * x; s += __shfl_xor(s, 1); s += __shfl_xor(s, 2); s += __shfl_xor(s, 4); s += __shfl_xor(s, 8); s += __shfl_xor(s, 16);
        if (g.ssout && r32 == 0) atomicAdd(g.ssout + row, s); }
}
__device__ __forceinline__ void sgemm_phase(Ctx& c, const SgArgs& g, int N, int nidle) {
    const int r = c.G - 1 - (int)blockIdx.x; if (r >= nidle) return;
    if (g.mode == 1) {
#pragma unroll 1
        for (int u = r; u < (N / 32) * 4; u += nidle) { if (g.K == 1024) sgemm_unit_r1<4>(c, g, (u % (N / 32)) * 32, u / (N / 32)); else sgemm_unit_r1<DFF / 256>(c, g, (u % (N / 32)) * 32, u / (N / 32)); }
        return; }
#pragma unroll 1
    for (int u = r; u < N / 32; u += nidle) sgemm_unit(c, g, u * 32);
}


__device__ __forceinline__ float wave_sum_f(float x) {
    x += __builtin_bit_cast(float, __builtin_amdgcn_update_dpp(0, __builtin_bit_cast(int, x), 0xB1, 0xF, 0xF, false));
    x += __builtin_bit_cast(float, __builtin_amdgcn_update_dpp(0, __builtin_bit_cast(int, x), 0x4E, 0xF, 0xF, false));
    x += __builtin_bit_cast(float, __builtin_amdgcn_update_dpp(0, __builtin_bit_cast(int, x), 0x141, 0xF, 0xF, false));
    x += __builtin_bit_cast(float, __builtin_amdgcn_update_dpp(0, __builtin_bit_cast(int, x), 0x140, 0xF, 0xF, false));
    const int xi = __builtin_bit_cast(int, x);
    return (__builtin_bit_cast(float, __builtin_amdgcn_readlane(xi, 0)) + __builtin_bit_cast(float, __builtin_amdgcn_readlane(xi, 16))) +
           (__builtin_bit_cast(float, __builtin_amdgcn_readlane(xi, 32)) + __builtin_bit_cast(float, __builtin_amdgcn_readlane(xi, 48)));
}
__device__ __forceinline__ float sum8_dpp(float x) {
    x += __builtin_bit_cast(float, __builtin_amdgcn_update_dpp(0, __builtin_bit_cast(int, x), 0xB1, 0xF, 0xF, false));
    x += __builtin_bit_cast(float, __builtin_amdgcn_update_dpp(0, __builtin_bit_cast(int, x), 0x4E, 0xF, 0xF, false));
    x += __builtin_bit_cast(float, __builtin_amdgcn_update_dpp(0, __builtin_bit_cast(int, x), 0x141, 0xF, 0xF, false));
    return x;
}
__device__ __forceinline__ void unpack8(v4u q, float (&x)[8]) {
    x[0] = bf2f(q.x & 0xffffu); x[1] = bf2f(q.x >> 16); x[2] = bf2f(q.y & 0xffffu); x[3] = bf2f(q.y >> 16); x[4] = bf2f(q.z & 0xffffu); x[5] = bf2f(q.z >> 16); x[6] = bf2f(q.w & 0xffffu); x[7] = bf2f(q.w >> 16);
}
__device__ __forceinline__ void dsa_post_row(ARGREF a, int row, int lane_, LAS float* tb) {
    int lane = lane_; asm volatile("" : "+v"(lane));
    const bf16* z = (const bf16*)(a.ws + WS_Z) + (size_t)row * ZC1;
    const bool smp = row >= MP; const int b = smp ? (row - MP) >> 2 : row >> 12, t = smp ? (row - MP) & 3 : row & 4095;
    const float pos = (float)(smp ? PAST + t : t);
    const int hd = lane >> 3, c8 = (lane & 7) * 8, c4 = (lane & 7) * 4;
    const v4u xa = *(const v4u*)(z + hd * 128 + c8), xb = *(const v4u*)(z + hd * 128 + 64 + c8);
    const u64 vv = *(const u64*)(z + Z1_V + 4 * lane);
    const u64 qa = *(const u64*)(z + Z1_IQ + hd * 64 + c4), qb = *(const u64*)(z + Z1_IQ + hd * 64 + 32 + c4);
    const u64 ka = *(const u64*)(z + Z1_IK + c4), kb_ = *(const u64*)(z + Z1_IK + 32 + c4);
    const float wraw = bf2f(z[Z1_IW + (lane & 7)]);
    const float* gp = hd < 6 ? a.in[17] : a.in[18];
    const f32x4 g1a = *(const f32x4*)(gp + c8), g1b = *(const f32x4*)(gp + c8 + 4), g2a = *(const f32x4*)(gp + 64 + c8), g2b = *(const f32x4*)(gp + 64 + c8 + 4);
    const f32x4 gk1 = *(const f32x4*)(a.in[19] + c4), gk2 = *(const f32x4*)(a.in[19] + 32 + c4);
    {
        const float r1 = pos * (exp2f(-(float)lane * (13.287712379549449f / 64.0f)) * 0.15915494309189535f), f1 = r1 - floorf(r1);
        tb[lane] = __builtin_amdgcn_cosf(f1); tb[64 + lane] = __builtin_amdgcn_sinf(f1);
        const float r2 = pos * (exp2f(-(float)(lane & 31) * (13.287712379549449f / 32.0f)) * 0.15915494309189535f), f2 = r2 - floorf(r2);
        if (lane < 32) { tb[128 + lane] = __builtin_amdgcn_cosf(f2); tb[160 + lane] = __builtin_amdgcn_sinf(f2); } }
    {
        float x1[8], x2[8]; unpack8(xa, x1); unpack8(xb, x2);
        float s = 0.f;
#pragma unroll
        for (int j = 0; j < 8; ++j) s += x1[j] * x1[j] + x2[j] * x2[j];
        const float rs = rsqrtf(sum8_dpp(s) * (1.0f / 128.0f) + EPS);
        const f32x4 ca = *(const LAS f32x4*)(tb + c8), cb = *(const LAS f32x4*)(tb + c8 + 4), sa = *(const LAS f32x4*)(tb + 64 + c8), sb = *(const LAS f32x4*)(tb + 64 + c8 + 4);
        const float cs[8] = {ca.x, ca.y, ca.z, ca.w, cb.x, cb.y, cb.z, cb.w}, sn[8] = {sa.x, sa.y, sa.z, sa.w, sb.x, sb.y, sb.z, sb.w};
        const float g1[8] = {g1a.x, g1a.y, g1a.z, g1a.w, g1b.x, g1b.y, g1b.z, g1b.w}, g2[8] = {g2a.x, g2a.y, g2a.z, g2a.w, g2b.x, g2b.y, g2b.z, g2b.w};
        float o1[8], o2[8];
#pragma unroll
        for (int j = 0; j < 8; ++j) { const float y1 = x1[j] * rs * g1[j], y2 = x2[j] * rs * g2[j]; o1[j] = y1 * cs[j] - y2 * sn[j]; o2[j] = y2 * cs[j] + y1 * sn[j]; }
        v4u p1, p2; p1.x = pk2(o1[0], o1[1]); p1.y = pk2(o1[2], o1[3]); p1.z = pk2(o1[4], o1[5]); p1.w = pk2(o1[6], o1[7]); p2.x = pk2(o2[0], o2[1]); p2.y = pk2(o2[2], o2[3]); p2.z = pk2(o2[4], o2[5]); p2.w = pk2(o2[6], o2[7]);
        if (hd < 6) {
            if (smp) { float* q = (float*)(a.ws + WS_SQ) + (size_t)(row - MP) * 768 + hd * 128 + c8;
                *(f32x4*)q = (f32x4){o1[0], o1[1], o1[2], o1[3]}; *(f32x4*)(q + 4) = (f32x4){o1[4], o1[5], o1[6], o1[7]}; *(f32x4*)(q + 64) = (f32x4){o2[0], o2[1], o2[2], o2[3]}; *(f32x4*)(q + 68) = (f32x4){o2[4], o2[5], o2[6], o2[7]}; }
            else { bf16* q = (bf16*)(a.ws + WS_QB) + ((size_t)(b * 6 + hd) * SEQ + t) * 128 + c8; *(v4u*)q = p1; *(v4u*)(q + 64) = p2; }
        } else {
            const int kvh = hd - 6;
            float* ko = (smp ? a.out + O_KS + (size_t)(row - MP) * 256 : a.out + O_KP + (size_t)row * 256) + kvh * 128 + c8;
            *(f32x4*)ko = (f32x4){o1[0], o1[1], o1[2], o1[3]}; *(f32x4*)(ko + 4) = (f32x4){o1[4], o1[5], o1[6], o1[7]}; *(f32x4*)(ko + 64) = (f32x4){o2[0], o2[1], o2[2], o2[3]}; *(f32x4*)(ko + 68) = (f32x4){o2[4], o2[5], o2[6], o2[7]};
            if (!smp) { bf16* kb = (bf16*)(a.ws + WS_KB) + ((size_t)(b * 2 + kvh) * SEQ + t) * 128 + c8; *(v4u*)kb = p1; *(v4u*)(kb + 64) = p2; }
        }
    }
    {
        const f32x4 v = {bf2f((unsigned)vv & 0xffffu), bf2f(((unsigned)vv) >> 16), bf2f((unsigned)(vv >> 32) & 0xffffu), bf2f((unsigned)(vv >> 48))};
        float* vo = smp ? a.out + O_VS + (size_t)(row - MP) * 256 : a.out + O_VP + (size_t)row * 256;
        *(f32x4*)(vo + 4 * lane) = v;
        if (!smp) { const int kvh = lane >> 5, dd = (lane & 31) * 4; *(u64*)((bf16*)(a.ws + WS_VB) + ((size_t)(b * 2 + kvh) * SEQ + t) * 128 + dd) = vv; }
    }
    const f32x4 c6 = *(const LAS f32x4*)(tb + 128 + c4), s6 = *(const LAS f32x4*)(tb + 160 + c4);
    {
        const float x1[4] = {bf2f((unsigned)qa & 0xffffu), bf2f(((unsigned)qa) >> 16), bf2f((unsigned)(qa >> 32) & 0xffffu), bf2f((unsigned)(qa >> 48))};
        const float x2[4] = {bf2f((unsigned)qb & 0xffffu), bf2f(((unsigned)qb) >> 16), bf2f((unsigned)(qb >> 32) & 0xffffu), bf2f((unsigned)(qb >> 48))};
        float o1[4], o2[4];
#pragma unroll
        for (int j = 0; j < 4; ++j) { o1[j] = x1[j] * c6[j] - x2[j] * s6[j]; o2[j] = x2[j] * c6[j] + x1[j] * s6[j]; }
        if (smp) { float* q = (float*)(a.ws + WS_SIQ) + (size_t)(row - MP) * 512 + hd * 64 + c4; *(f32x4*)q = (f32x4){o1[0], o1[1], o1[2], o1[3]}; *(f32x4*)(q + 32) = (f32x4){o2[0], o2[1], o2[2], o2[3]}; }
        else { bf16* q = (bf16*)(a.ws + WS_IQB) + (size_t)row * 512 + hd * 64 + c4; *(u64*)q = (u64)pk2(o1[0], o1[1]) | ((u64)pk2(o1[2], o1[3]) << 32); *(u64*)(q + 32) = (u64)pk2(o2[0], o2[1]) | ((u64)pk2(o2[2], o2[3]) << 32); }
    }
    {
        const float x1[4] = {bf2f((unsigned)ka & 0xffffu), bf2f(((unsigned)ka) >> 16), bf2f((unsigned)(ka >> 32) & 0xffffu), bf2f((unsigned)(ka >> 48))};
        const float x2[4] = {bf2f((unsigned)kb_ & 0xffffu), bf2f(((unsigned)kb_) >> 16), bf2f((unsigned)(kb_ >> 32) & 0xffffu), bf2f((unsigned)(kb_ >> 48))};
        float s = 0.f;
#pragma unroll
        for (int j = 0; j < 4; ++j) s += x1[j] * x1[j] + x2[j] * x2[j];
        const float rs = rsqrtf(sum8_dpp(s) * (1.0f / 64.0f) + EPS);
        float o1[4], o2[4];
#pragma unroll
        for (int j = 0; j < 4; ++j) { const float y1 = x1[j] * rs * gk1[j], y2 = x2[j] * rs * gk2[j]; o1[j] = y1 * c6[j] - y2 * s6[j]; o2[j] = y2 * c6[j] + y1 * s6[j]; }
        if (lane < 8) {
            float* ko = (smp ? a.out + O_IKS + (size_t)(row - MP) * 64 : a.out + O_IKP + (size_t)row * 64) + c4; *(f32x4*)ko = (f32x4){o1[0], o1[1], o1[2], o1[3]}; *(f32x4*)(ko + 32) = (f32x4){o2[0], o2[1], o2[2], o2[3]};
            if (!smp) { bf16* kb = (bf16*)(a.ws + WS_IKB) + (size_t)row * 64 + c4; *(u64*)kb = (u64)pk2(o1[0], o1[1]) | ((u64)pk2(o1[2], o1[3]) << 32); *(u64*)(kb + 32) = (u64)pk2(o2[0], o2[1]) | ((u64)pk2(o2[2], o2[3]) << 32); }
            const float wv = wraw * (0.35355339059327373f * 0.125f);
            if (smp) ((float*)(a.ws + WS_SIW))[(row - MP) * 8 + lane] = wv; else ((float*)(a.ws + WS_IW))[(size_t)row * 8 + lane] = wv; }
    }
}
__device__ __forceinline__ void p8_dsa_post(Ctx& c, ARGREF a) {
    constexpr int NRB = (MVALID + 63) / 64;
    for (;;) { const int u = q_next(c, 1); if (u >= 384 + NRB) break;
        if (u < 256) memattn_prompt_unit(c, a, 1, u);
        else if (u < 256 + NRB) { const int r0 = (u - 256) * 64 + c.wave;
#pragma unroll 1
            for (int i = 0; i < 8; ++i) { const int row = r0 + 8 * i; if (row < MVALID) dsa_post_row(a, row, c.lane, (LAS float*)(c.lds) + c.wave * 256); } }
        else memattn_sample_unit(c, a, 1, u - 256 - NRB); }
}

__device__ __forceinline__ void idx_prompt_unit(Ctx& c, ARGREF a, int b, int qb) {
    int tid = c.tid; asm volatile("" : "+v"(tid));
    const int lane = tid & 63, r32 = lane & 31, hh = lane >> 5, w = c.wave;
    const int q0 = b * SEQ + qb * 32;
    LAS bf16* IQL = (LAS bf16*)(c.lds);
    const bf16* IK = (const bf16*)(a.ws + WS_IKB) + (size_t)(b * SEQ) * 64 + (size_t)r32 * 64 + 8 * hh;
    float* SC = (float*)(a.ws + WS_SC) + (size_t)(q0 + r32) * SEQ;
    float wv[8];
    bf16x8 ak[4], an[4];
    if (w <= qb) {
#pragma unroll
        for (int ks = 0; ks < 4; ++ks) ak[ks] = *(const bf16x8*)(IK + (size_t)(w * 32) * 64 + ks * 16); }
#pragma unroll
    for (int h = 0; h < 8; ++h) wv[h] = ((const float*)(a.ws + WS_IW))[(size_t)(q0 + r32) * 8 + h];
    { const bf16* src = (const bf16*)(a.ws + WS_IQB) + (size_t)q0 * 512;
#pragma unroll
      for (int i = 0; i < 4; ++i) { const int row = tid >> 4, ch = (tid & 15) + 16 * i; *(LAS v4u*)(IQL + row * 520 + ch * 8) = *(const v4u*)(src + (size_t)row * 512 + ch * 8); } }
    __syncthreads();
#pragma unroll 1
    for (int kt = w; kt <= qb; kt += 8) {
        if (kt + 8 <= qb) {
#pragma unroll
            for (int ks = 0; ks < 4; ++ks) an[ks] = *(const bf16x8*)(IK + (size_t)((kt + 8) * 32) * 64 + ks * 16); }
        f32x16 sc = {};
        int qoff = r32 * 520 + 8 * hh; asm volatile("" : "+v"(qoff));
#pragma unroll
        for (int h = 0; h < 8; ++h) { f32x16 d = {};
#pragma unroll
            for (int ks = 0; ks < 4; ++ks) d = __builtin_amdgcn_mfma_f32_32x32x16_bf16(ak[ks], *(const LAS bf16x8*)(IQL + qoff + h * 64 + ks * 16), d, 0, 0, 0);
#pragma unroll
            for (int r = 0; r < 16; ++r) sc[r] = fmaf(wv[h], fmaxf(d[r], 0.f), sc[r]); }
        {
            LAS float* TP = (LAS float*)(c.lds + 36864) + w * (32 * 36);
#pragma unroll
            for (int g = 0; g < 4; ++g) *(LAS f32x4*)(TP + r32 * 36 + 8 * g + 4 * hh) = (f32x4){sc[4 * g], sc[4 * g + 1], sc[4 * g + 2], sc[4 * g + 3]};
            float* SCt = (float*)(a.ws + WS_SC) + (size_t)q0 * SEQ + kt * 32 + (lane & 7) * 4;
#pragma unroll
            for (int ps = 0; ps < 4; ++ps) { const int rr = (lane >> 3) + 8 * ps; *(f32x4*)(SCt + (size_t)rr * SEQ) = *(const LAS f32x4*)(TP + rr * 36 + (lane & 7) * 4); } }
#pragma unroll
        for (int ks = 0; ks < 4; ++ks) ak[ks] = an[ks];
    }
}
__device__ __forceinline__ v4u pack8f(const float* p) { const f32x4 x = *(const f32x4*)p, y = *(const f32x4*)(p + 4); v4u o; o.x = pk2(x.x, x.y); o.y = pk2(x.z, x.w); o.z = pk2(y.x, y.y); o.w = pk2(y.z, y.w); return o; }
__device__ __forceinline__ void idx_sample_tile(ARGREF a, int sb, int tl, int lane_) {
    int lane = lane_; asm volatile("" : "+v"(lane));
    const int r32 = lane & 31, hh = lane >> 5, tk = r32 >> 3, hd = r32 & 7;
    const float* iq = (const float*)(a.ws + WS_SIQ) + (size_t)(sb * 4 + tk) * 512 + hd * 64 + 8 * hh;
    const float wv = ((const float*)(a.ws + WS_SIW))[(sb * 4 + tk) * 8 + hd];
    const float* src;
    if (tl < 256) src = a.in[4] + ((size_t)a.page_table[sb * 64 + (tl >> 2)] * 128 + (tl & 3) * 32 + r32) * 64 + 8 * hh;
    else src = a.out + O_IKS + (size_t)(sb * 4 + (r32 & 3)) * 64 + 8 * hh;
    v4u af[4], bf_[4];
#pragma unroll
    for (int ks = 0; ks < 4; ++ks) { af[ks] = pack8f(src + 16 * ks); bf_[ks] = pack8f(iq + 16 * ks); }
    if (tl == 256 && r32 >= 4) {
#pragma unroll
        for (int ks = 0; ks < 4; ++ks) af[ks] = (v4u){0u, 0u, 0u, 0u}; }
    f32x16 d = {};
#pragma unroll
    for (int ks = 0; ks < 4; ++ks) d = __builtin_amdgcn_mfma_f32_32x32x16_bf16(__builtin_bit_cast(bf16x8, af[ks]), __builtin_bit_cast(bf16x8, bf_[ks]), d, 0, 0, 0);
    float* dst = (float*)(a.ws + WS_SSC) + (size_t)(sb * 4 + tk) * SSC_LD + tl * 32;
#pragma unroll
    for (int r = 0; r < 16; ++r) { float v = wv * fmaxf(d[r], 0.f);
        v += __builtin_bit_cast(float, __builtin_amdgcn_update_dpp(0, __builtin_bit_cast(int, v), 0xB1, 0xF, 0xF, false));
        v += __builtin_bit_cast(float, __builtin_amdgcn_update_dpp(0, __builtin_bit_cast(int, v), 0x4E, 0xF, 0xF, false));
        v += __builtin_bit_cast(float, __builtin_amdgcn_update_dpp(0, __builtin_bit_cast(int, v), 0x141, 0xF, 0xF, false));
        if (hd == 0) dst[crow(r, hh)] = v; }
}
__device__ __forceinline__ void idx_sample_page(ARGREF a, int sb, int g, int lane_) {
    int lane = lane_; asm volatile("" : "+v"(lane));
    const int r32 = lane & 31, hh = lane >> 5, tk = r32 >> 3, hd = r32 & 7;
    const float* iq = (const float*)(a.ws + WS_SIQ) + (size_t)(sb * 4 + tk) * 512 + hd * 64 + 8 * hh;
    const float wv = ((const float*)(a.ws + WS_SIW))[(sb * 4 + tk) * 8 + hd];
    const float* src = a.in[4] + ((size_t)a.page_table[sb * 64 + g] * 128 + r32) * 64 + 8 * hh;
    f32x4 kr[4][8], qr[8];
#pragma unroll
    for (int t = 0; t < 4; ++t)
#pragma unroll
        for (int ks = 0; ks < 4; ++ks) { kr[t][2 * ks] = *(const f32x4*)(src + (size_t)t * 32 * 64 + 16 * ks); kr[t][2 * ks + 1] = *(const f32x4*)(src + (size_t)t * 32 * 64 + 16 * ks + 4); }
#pragma unroll
    for (int ks = 0; ks < 4; ++ks) { qr[2 * ks] = *(const f32x4*)(iq + 16 * ks); qr[2 * ks + 1] = *(const f32x4*)(iq + 16 * ks + 4); }
    v4u bf_[4];
#pragma unroll
    for (int ks = 0; ks < 4; ++ks) { const f32x4 x = qr[2 * ks], y = qr[2 * ks + 1]; bf_[ks].x = pk2(x.x, x.y); bf_[ks].y = pk2(x.z, x.w); bf_[ks].z = pk2(y.x, y.y); bf_[ks].w = pk2(y.z, y.w); }
    float* dst = (float*)(a.ws + WS_SSC) + (size_t)(sb * 4 + tk) * SSC_LD + g * 128;
#pragma unroll
    for (int t = 0; t < 4; ++t) { f32x16 d = {};
#pragma unroll
        for (int ks = 0; ks < 4; ++ks) { const f32x4 x = kr[t][2 * ks], y = kr[t][2 * ks + 1]; v4u af; af.x = pk2(x.x, x.y); af.y = pk2(x.z, x.w); af.z = pk2(y.x, y.y); af.w = pk2(y.z, y.w);
            d = __builtin_amdgcn_mfma_f32_32x32x16_bf16(__builtin_bit_cast(bf16x8, af), __builtin_bit_cast(bf16x8, bf_[ks]), d, 0, 0, 0); }
        float vv[16];
#pragma unroll
        for (int r = 0; r < 16; ++r) { float v = wv * fmaxf(d[r], 0.f);
            v += __builtin_bit_cast(float, __builtin_amdgcn_update_dpp(0, __builtin_bit_cast(int, v), 0xB1, 0xF, 0xF, false));
            v += __builtin_bit_cast(float, __builtin_amdgcn_update_dpp(0, __builtin_bit_cast(int, v), 0x4E, 0xF, 0xF, false));
            v += __builtin_bit_cast(float, __builtin_amdgcn_update_dpp(0, __builtin_bit_cast(int, v), 0x141, 0xF, 0xF, false));
            vv[r] = v; }
        if (hd == 0) {
#pragma unroll
            for (int g = 0; g < 4; ++g) *(f32x4*)(dst + t * 32 + 8 * g + 4 * hh) = (f32x4){vv[4 * g], vv[4 * g + 1], vv[4 * g + 2], vv[4 * g + 3]}; } }
}
__device__ __forceinline__ void p9_indexer(Ctx& c, ARGREF a) {
    const int gw = c.vcu * NWAVES + c.wave, NGW = c.G * NWAVES;
#pragma unroll 1
    for (int e = gw; e < 32 * 64; e += NGW) { idx_sample_page(a, e >> 6, e & 63, c.lane); if ((e & 63) == 63) idx_sample_tile(a, e >> 6, 256, c.lane); }
    for (;;) { const int u = q_next(c, 2); if (u >= 512) break; idx_prompt_unit(c, a, u & 3, 127 - (u >> 2)); }
}


#ifndef TKREP_C
#define TKREP_C 1
#endif
#ifndef TKREP_D
#define TKREP_D 1
#endif
__device__ __forceinline__ unsigned fkey(float f) { const unsigned u = __builtin_bit_cast(unsigned, f + 0.0f); return (u & 0x80000000u) ? ~u : (u | 0x80000000u); }
__device__ __forceinline__ void acc_ge(int& cnt, unsigned key, unsigned cand) { asm volatile("v_cmp_le_u32_e32 vcc, %1, %2\n\tv_addc_co_u32_e32 %0, vcc, 0, %0, vcc" : "+v"(cnt) : "s"(cand), "v"(key) : "vcc"); }
__device__ __forceinline__ void acc_ge4(int& c0, int& c1, int& c2, int& c3, unsigned k0, unsigned k1, unsigned k2, unsigned k3, unsigned cand) {
    u64 m0, m1, m2, m3;
    asm volatile("v_cmp_le_u32_e64 %4, %8, %9\n\tv_cmp_le_u32_e64 %5, %8, %10\n\tv_cmp_le_u32_e64 %6, %8, %11\n\tv_cmp_le_u32_e64 %7, %8, %12\n\t"
                 "v_addc_co_u32_e64 %0, %4, 0, %0, %4\n\tv_addc_co_u32_e64 %1, %5, 0, %1, %5\n\tv_addc_co_u32_e64 %2, %6, 0, %2, %6\n\tv_addc_co_u32_e64 %3, %7, 0, %3, %7"
                 : "+v"(c0), "+v"(c1), "+v"(c2), "+v"(c3), "=&s"(m0), "=&s"(m1), "=&s"(m2), "=&s"(m3) : "s"(cand), "v"(k0), "v"(k1), "v"(k2), "v"(k3));
}
__device__ __forceinline__ u64 ballot_nz(unsigned v) { u64 m; asm volatile("v_cmp_ne_u32_e64 %0, 0, %1" : "=s"(m) : "v"(v)); return m; }
__device__ __forceinline__ int wave_sum_dpp(int x) {
    x += __builtin_amdgcn_update_dpp(0, x, 0xB1, 0xF, 0xF, false);
    x += __builtin_amdgcn_update_dpp(0, x, 0x4E, 0xF, 0xF, false);
    x += __builtin_amdgcn_update_dpp(0, x, 0x141, 0xF, 0xF, false);
    x += __builtin_amdgcn_update_dpp(0, x, 0x140, 0xF, 0xF, false);
    return (__builtin_amdgcn_readlane(x, 0) + __builtin_amdgcn_readlane(x, 16)) + (__builtin_amdgcn_readlane(x, 32) + __builtin_amdgcn_readlane(x, 48));
}
__device__ __forceinline__ int mbcnt64(u64 m) { return (int)__builtin_amdgcn_mbcnt_hi((unsigned)(m >> 32), __builtin_amdgcn_mbcnt_lo((unsigned)m, 0u)); }
constexpr int TK_LOWBITS = 18;
__device__ __forceinline__ void topk_finish(unsigned ck, int cp, int A, int posmax, unsigned& T, int& P, int nbits = TK_LOWBITS) {
#pragma unroll 1
    for (int bit = nbits - 1; bit >= 0; --bit) { const unsigned cand = T | (1u << bit); if (A + __builtin_popcountll(__ballot(ck >= cand)) >= 256) T = cand; }
    const int need = 256 - (A + __builtin_popcountll(__ballot(ck > T))), ceq = __builtin_popcountll(__ballot(ck == T));
    P = posmax;
    if (ceq != need) { P = 0;
#pragma unroll 1
        for (int bit = 13; bit >= 0; --bit) { const int cand = P | (1 << bit); if (__builtin_popcountll(__ballot(ck == T && cp < cand)) < need) P = cand; } }
}
__device__ __forceinline__ unsigned wave_min_u(unsigned x) {
    x = min(x, (unsigned)__builtin_amdgcn_update_dpp(0, (int)x, 0xB1, 0xF, 0xF, false)); x = min(x, (unsigned)__builtin_amdgcn_update_dpp(0, (int)x, 0x4E, 0xF, 0xF, false));
    x = min(x, (unsigned)__builtin_amdgcn_update_dpp(0, (int)x, 0x141, 0xF, 0xF, false)); x = min(x, (unsigned)__builtin_amdgcn_update_dpp(0, (int)x, 0x140, 0xF, 0xF, false));
    return min(min((unsigned)__builtin_amdgcn_readlane((int)x, 0), (unsigned)__builtin_amdgcn_readlane((int)x, 16)), min((unsigned)__builtin_amdgcn_readlane((int)x, 32), (unsigned)__builtin_amdgcn_readlane((int)x, 48)));
}
__device__ __forceinline__ unsigned wave_max_u(unsigned x) {
    x = max(x, (unsigned)__builtin_amdgcn_update_dpp(0, (int)x, 0xB1, 0xF, 0xF, false)); x = max(x, (unsigned)__builtin_amdgcn_update_dpp(0, (int)x, 0x4E, 0xF, 0xF, false));
    x = max(x, (unsigned)__builtin_amdgcn_update_dpp(0, (int)x, 0x141, 0xF, 0xF, false)); x = max(x, (unsigned)__builtin_amdgcn_update_dpp(0, (int)x, 0x140, 0xF, 0xF, false));
    return max(max((unsigned)__builtin_amdgcn_readlane((int)x, 0), (unsigned)__builtin_amdgcn_readlane((int)x, 16)), max((unsigned)__builtin_amdgcn_readlane((int)x, 32), (unsigned)__builtin_amdgcn_readlane((int)x, 48)));
}
template <int NJ>
__device__ __forceinline__ void topk_prompt_row(ARGREF a, const float* SCb, int row, int lane, LAS unsigned* cl) {
        const int t = row & 4095;
        u64* mk = (u64*)(a.ws + WS_MASK) + (size_t)row * 64;
        unsigned key[NJ];
        { const float* sc_ = SCb + (size_t)row * SEQ + lane; const int tj_ = t >> 6;
          float v[NJ];
#pragma unroll
          for (int j = 0; j < NJ; ++j) v[j] = sc_[64 * (j < tj_ ? j : tj_)];
          const u64 dmask = (2ull << (t & 63)) - 1ull;
#pragma unroll
          for (int j = 0; j < NJ; ++j) { const int u = __builtin_bit_cast(int, v[j] + 0.0f); const unsigned k = (unsigned)u ^ ((unsigned)(u >> 31) | 0x80000000u);
              const u64 vm = j < tj_ ? ~0ull : (j == tj_ ? dmask : 0ull); asm("v_cndmask_b32_e64 %0, 0, %1, %2" : "=v"(key[j]) : "v"(k), "s"(vm)); } }
        unsigned kh[NJ];
#pragma unroll
        for (int j = 0; j < NJ; ++j) { kh[j] = key[j] >> 1; asm volatile("" : "+v"(kh[j])); }
        unsigned T; int hb;
        {
            unsigned b0 = 0u, b1 = 0u, b2 = 0u, b3 = 0u;
#pragma unroll
            for (int j = 0; j < NJ; ++j) { const unsigned x = key[j]; unsigned n1, n2, n3;
                asm("v_med3_u32 %0, %1, %2, %3" : "=v"(n3) : "v"(b2), "v"(b3), "v"(x)); asm("v_med3_u32 %0, %1, %2, %3" : "=v"(n2) : "v"(b1), "v"(b2), "v"(x)); asm("v_med3_u32 %0, %1, %2, %3" : "=v"(n1) : "v"(b0), "v"(b1), "v"(x));
                b0 = max(b0, x); b1 = n1; b2 = n2; b3 = n3; }
            const unsigned L = wave_min_u(b3), H = wave_max_u(b3), df = L ^ H;
            hb = df ? 31 - __builtin_clz(df) : -1;
            T = hb >= 31 ? 0u : (L & ~((2u << (hb < 0 ? 0 : hb)) - 1u)); if (hb < 0) T = L;
        }
#define TK_FULLCOUNT(CAND, OUT) do { const unsigned cs_ = __builtin_amdgcn_readfirstlane(CAND); int c0_ = 0, c1_ = 0, c2_ = 0, c3_ = 0; \
        _Pragma("unroll") for (int j = 0; j < NJ; j += 4) acc_ge4(c0_, c1_, c2_, c3_, key[j], key[j + 1], key[j + 2], key[j + 3], cs_); OUT = wave_sum_dpp((c0_ + c1_) + (c2_ + c3_)); } while (0)
#define TK_FASTCOUNT(CAND, OUT, PC) do { const unsigned ch_ = __builtin_amdgcn_readfirstlane((CAND) >> 1); unsigned a_[8] = {0u, 0u, 0u, 0u, 0u, 0u, 0u, 0u}; \
        _Pragma("unroll") for (int j = 0; j < NJ; j += 8) { unsigned d_[8]; _Pragma("unroll") for (int i = 0; i < 8; ++i) d_[i] = kh[j + i] - ch_; \
            _Pragma("unroll") for (int i = 0; i < 8; ++i) a_[i] = __builtin_amdgcn_alignbit(a_[i], d_[i], 31); } \
        PC = ((__builtin_popcount(a_[0]) + __builtin_popcount(a_[1])) + (__builtin_popcount(a_[2]) + __builtin_popcount(a_[3]))) + \
             ((__builtin_popcount(a_[4]) + __builtin_popcount(a_[5])) + (__builtin_popcount(a_[6]) + __builtin_popcount(a_[7]))); OUT = 64 * NJ - wave_sum_dpp(PC); } while (0)
        int nb = hb + 1, clo = -1, chi = -1, pclo = 0, pchi = NJ;
#pragma unroll 1
        while (nb > 1 && (clo < 0 || chi < 0 || clo - chi > 64)) { const int bit = nb - 1; const unsigned cand = T | (1u << bit); int tot, pc; TK_FASTCOUNT(cand, tot, pc); if (tot >= 256) { T = cand; clo = tot; pclo = pc; } else { chi = tot; pchi = pc; } nb = bit; }
        int A = 0, cT = 4096;
        if (nb >= 1) { const unsigned hib = T + (1u << nb); if (chi >= 0) A = chi; else if (hib != 0u) TK_FASTCOUNT(hib, A, pchi); if (clo >= 0) cT = clo; else TK_FASTCOUNT(T, cT, pclo); }
#undef TK_FASTCOUNT
        int P;
        if (cT - A <= 64) {
            const unsigned bw = 1u << nb; const int mine = pchi - pclo;
            int inc = mine;
            inc += __builtin_amdgcn_update_dpp(0, inc, 0x111, 0xF, 0xF, true); inc += __builtin_amdgcn_update_dpp(0, inc, 0x112, 0xF, 0xF, true);
            inc += __builtin_amdgcn_update_dpp(0, inc, 0x114, 0xF, 0xF, true); inc += __builtin_amdgcn_update_dpp(0, inc, 0x118, 0xF, 0xF, true);
            { const int r0 = __builtin_amdgcn_readlane(inc, 15), r1 = __builtin_amdgcn_readlane(inc, 31), r2 = __builtin_amdgcn_readlane(inc, 47);
              inc += lane >= 48 ? r0 + r1 + r2 : (lane >= 32 ? r0 + r1 : (lane >= 16 ? r0 : 0)); }
            LAS unsigned* wp = cl + (inc - mine); LAS unsigned* const tr = cl + 128 + lane;
            int pj = lane;
#pragma unroll
            for (int j = 0; j < NJ; ++j) { const bool und = (key[j] - T) < bw; LAS unsigned* q = und ? wp : tr; q[0] = key[j]; q[64] = (unsigned)pj; wp += und ? 1 : 0;
                pj += 64; asm volatile("" : "+v"(pj)); }
            const int nund = cT - A;
            const unsigned ck = lane < nund ? cl[lane] : 0u; const int cp = (int)cl[64 + lane];
            topk_finish(ck, cp, A, 4095, T, P, nb);
        } else {
#pragma unroll 1
            for (int bit = nb - 1; bit >= 0; --bit) { const unsigned cand = T | (1u << bit); int tot; TK_FULLCOUNT(cand, tot); if (tot >= 256) T = cand; }
            int cge, cgt; TK_FULLCOUNT(T, cge); cgt = 0; if (T != 0xffffffffu) TK_FULLCOUNT(T + 1u, cgt);
            const int need = 256 - cgt, ceq = cge - cgt; P = 4095;
            if (ceq != need) { P = 0;
#pragma unroll 1
                for (int bit = 11; bit >= 0; --bit) { const int cand = P | (1 << bit); int cnt = 0; int pj = lane;
#pragma unroll
                    for (int j = 0; j < NJ; ++j) { cnt += (key[j] == T && pj < cand) ? 1 : 0; pj += 64; asm volatile("" : "+v"(pj)); }
                    if (wave_sum_dpp(cnt) < need) P = cand; } }
        }
#undef TK_FULLCOUNT
        if (P != 4095) {
            int pq = lane;
#pragma unroll
            for (int j = 0; j < NJ; ++j) { if (key[j] == T && pq > P) key[j] = 0u; pq += 64; asm volatile("" : "+v"(pq)); } }
        unsigned wlo = 0u, whi = 0u; const unsigned Ts = __builtin_amdgcn_readfirstlane(T);
#pragma unroll 1
        for (int rep_ = 0; rep_ < TKREP_D; ++rep_)
#pragma unroll
        for (int j = 0; j < NJ; ++j) asm volatile("v_cmp_le_u32_e32 vcc, %2, %3\n\ts_nop 3\n\tv_writelane_b32 %0, vcc_lo, %4\n\tv_writelane_b32 %1, vcc_hi, %4" : "+v"(wlo), "+v"(whi) : "s"(Ts), "v"(key[j]), "i"(j) : "vcc");
        mk[lane] = ((u64)whi << 32) | (u64)wlo;
}
__device__ __forceinline__ int topk_row_of(int gw, int NGW, int i) { const int idx = gw + (i >> 1) * NGW, b = idx >> 11, u = idx & 2047; return b * 4096 + ((i & 1) ? 4095 - u : u); }
__device__ __forceinline__ void topk_prompt_rows(ARGREF a, int gw, int NGW, int count, unsigned mask, int e0, int e1, int lane_, LAS unsigned* cl) {
    int lane = lane_; asm volatile("" : "+v"(lane));
    const float* SCb = (const float*)(a.ws + WS_SC);
#pragma unroll 1
    for (int i_ = 0; i_ < count + 2; ++i_) { int row;
        if (i_ < count) { if (!((mask >> i_) & 1u)) continue; row = topk_row_of(gw, NGW, i_); } else { row = i_ == count ? e0 : e1; if (row < 0) continue; }
        const int t = row & 4095;
        if (t < 256) { u64 myword = 0ull; u64* mk = (u64*)(a.ws + WS_MASK) + (size_t)row * 64;
#pragma unroll 1
            for (int j = 0; j < 64; ++j) { const u64 m = __ballot(64 * j + lane <= t); if (lane == j) myword = m; }
            mk[lane] = myword; }
        else if (t < 1024) topk_prompt_row<16>(a, SCb, row, lane, cl);
        else if (t < 2048) topk_prompt_row<32>(a, SCb, row, lane, cl);
        else if (t < 3072) topk_prompt_row<48>(a, SCb, row, lane, cl);
        else topk_prompt_row<64>(a, SCb, row, lane, cl);
    }
}
__device__ __forceinline__ void topk_sample_row(ARGREF a, int q, int lane_, LAS unsigned* K, LAS unsigned* cl) {
    int lane = lane_; asm volatile("" : "+v"(lane));
    const int t = q & 3, n = PAST + t + 1; const float* sc = (const float*)(a.ws + WS_SSC) + (size_t)q * SSC_LD;
    int* out = (int*)(a.ws + WS_SIDX) + q * 256;
    unsigned key[129];
#pragma unroll
    for (int j = 0; j < 129; ++j) { const float v = sc[64 * j + lane]; key[j] = (j < 128 || lane < n - 8192) ? fkey(v) : 0u; }
#pragma unroll
    for (int j = 0; j < 129; ++j) K[64 * j + lane] = key[j];
#define TK_FULLCOUNT(CAND, OUT) do { const unsigned cs_ = __builtin_amdgcn_readfirstlane(CAND); int c0_ = 0, c1_ = 0, c2_ = 0, c3_ = 0; \
        _Pragma("unroll") for (int j = 0; j < 128; j += 4) acc_ge4(c0_, c1_, c2_, c3_, key[j], key[j + 1], key[j + 2], key[j + 3], cs_); acc_ge(c0_, key[128], cs_); OUT = wave_sum_dpp((c0_ + c1_) + (c2_ + c3_)); } while (0)
    unsigned T = 0u;
#pragma unroll 1
    for (int bit = 31; bit >= TK_LOWBITS; --bit) { const unsigned cand = T | (1u << bit); int tot; TK_FULLCOUNT(cand, tot); if (tot >= 256) T = cand; }
    const unsigned hib = T + (1u << TK_LOWBITS);
    int A = 0, cT; if (hib != 0u) TK_FULLCOUNT(hib, A); TK_FULLCOUNT(T, cT);
    int P;
    if (cT - A <= 64) {
        int base = 0;
#pragma unroll 1
        for (int j0 = 0; j0 < 128; j0 += 8) { unsigned kk[8];
#pragma unroll
            for (int i = 0; i < 8; ++i) kk[i] = K[64 * (j0 + i) + lane];
#pragma unroll
            for (int i = 0; i < 8; ++i) { const unsigned und = (kk[i] - T) < (1u << TK_LOWBITS) ? 1u : 0u; const u64 m = ballot_nz(und); const int pos = base + mbcnt64(m);
                if (und) { cl[pos] = kk[i]; cl[64 + pos] = (unsigned)(64 * (j0 + i) + lane); }
                base += __builtin_popcountll(m); } }
        { const unsigned kj = K[64 * 128 + lane]; const unsigned und = (kj - T) < (1u << TK_LOWBITS) ? 1u : 0u; const u64 m = ballot_nz(und); const int pos = base + mbcnt64(m);
          if (und) { cl[pos] = kj; cl[64 + pos] = (unsigned)(64 * 128 + lane); } base += __builtin_popcountll(m); }
        const unsigned ck = lane < base ? cl[lane] : 0u; const int cp = (int)cl[64 + lane];
        topk_finish(ck, cp, A, 16383, T, P);
    } else {
#pragma unroll 1
        for (int bit = TK_LOWBITS - 1; bit >= 0; --bit) { const unsigned cand = T | (1u << bit); int tot; TK_FULLCOUNT(cand, tot); if (tot >= 256) T = cand; }
        int cge, cgt; TK_FULLCOUNT(T, cge); cgt = 0; if (T != 0xffffffffu) TK_FULLCOUNT(T + 1u, cgt);
        const int need = 256 - cgt, ceq = cge - cgt; P = 16383;
        if (ceq != need) { P = 0;
#pragma unroll 1
            for (int bit = 13; bit >= 0; --bit) { const int cand = P | (1 << bit); int cnt = 0;
#pragma unroll 4
                for (int j = 0; j < 129; ++j) cnt += (K[64 * j + lane] == T && 64 * j + lane < cand) ? 1 : 0;
                if (wave_sum_dpp(cnt) < need) P = cand; } }
    }
#undef TK_FULLCOUNT
    int base = 0;
#pragma unroll 1
    for (int j0 = 0; j0 < 136; j0 += 8) { unsigned kk[8];
#pragma unroll
        for (int i = 0; i < 8; ++i) kk[i] = (j0 + i < 129) ? K[64 * (j0 + i) + lane] : 0u;
#pragma unroll
        for (int i = 0; i < 8; ++i) { const int ps = 64 * (j0 + i) + lane; const unsigned selv = (kk[i] > T || (kk[i] == T && ps <= P)) ? 1u : 0u; const u64 m = ballot_nz(selv);
            const int pos = base + mbcnt64(m);
            if (selv && pos < 256) out[pos] = ps;
            base += __builtin_popcountll(m); } }
}
__device__ __forceinline__ void p10_topk(Ctx& c, ARGREF a) {
    const int gw = c.vcu * NWAVES + c.wave, NGW = c.G * NWAVES;
    LAS unsigned* cl = (LAS unsigned*)(c.lds) + c.wave * 256;
    if (c.wave == 0 && c.vcu < MS) topk_sample_row(a, c.vcu, c.lane, (LAS unsigned*)(c.lds + 8192), cl);
    const int NPAIR = MP / 2;
    int count = gw < NPAIR ? 2 * ((NPAIR - gw + NGW - 1) / NGW) : 0, e0 = -1, e1 = -1; unsigned mask = 0xffffffffu;
    if (c.G == 256 && c.vcu < MS) { const int g0 = c.vcu * NWAVES, w = c.wave;
        if (w == 0) mask = 0x1fu;
        else if (w <= 2) { mask = 0xaau; e0 = topk_row_of(g0, NGW, w == 1 ? 5 : 7); }
        else if (w <= 5) { e0 = topk_row_of(g0 + 1, NGW, 2 * (w - 3)); e1 = topk_row_of(g0 + 2, NGW, 2 * (w - 2)); }
        else if (w == 6) { e0 = topk_row_of(g0 + 1, NGW, 6); e1 = topk_row_of(g0, NGW, 6); }
        else e0 = topk_row_of(g0 + 2, NGW, 0); }
    topk_prompt_rows(a, gw, NGW, count, mask, e0, e1, c.lane, cl);
}


__device__ __forceinline__ void attn_sample_unit(Ctx& c, ARGREF a, int sb, int t) {
    LAS bf16* KV = (LAS bf16*)(c.lds);
    LAS float* QL = (LAS float*)(c.lds + 69632);
    LAS float* SL = (LAS float*)(c.lds + 69632 + 3072);
    LAS float* OL = (LAS float*)(c.lds + 69632 + 6144);
    LAS int* IL = (LAS int*)(c.lds + 69632 + 12288);
    LAS unsigned* OFFL = (LAS unsigned*)(c.lds + 69632 + 12288 + 1024);
    int tid = c.tid; asm volatile("" : "+v"(tid));
    const int lane = tid & 63, w = c.wave, q = sb * 4 + t;
    __syncthreads();
    if (tid < 256) IL[tid] = ((const int*)(a.ws + WS_SIDX))[q * 256 + tid];
    for (int i = tid; i < 768; i += 512) QL[i] = ((const float*)(a.ws + WS_SQ))[(size_t)q * 768 + i];
    __syncthreads();
    if (tid < 256) { const int idx = IL[tid];
        OFFL[tid] = idx < PAST ? (unsigned)(((a.page_table[sb * 64 + (idx >> 7)] * 128 + (idx & 127)) * 2) * 128) : (0x80000000u | (unsigned)((sb * 4 + (idx - PAST)) * 256)); }
    __syncthreads();
    bf16* MIX = (bf16*)(a.ws + WS_MIX) + (size_t)(MP + q) * DM;
#pragma unroll 1
    for (int kvh = 0; kvh < 2; ++kvh) {
#pragma unroll 1
        for (int pass = 0; pass < 2; ++pass) {
            const float* pool = pass ? a.in[3] : a.in[2]; const float* nw = a.out + (pass ? O_VS : O_KS);
            { f32x4 gv[16];
#pragma unroll
              for (int r = 0; r < 16; ++r) { const int i = (tid >> 5) + 16 * r; const unsigned off = OFFL[i]; const float* src = (off & 0x80000000u) ? nw + (size_t)(off & 0x7fffffffu) : pool + (size_t)off;
                  gv[r] = *(const f32x4*)(src + kvh * 128 + (tid & 31) * 4); }
#pragma unroll
              for (int r = 0; r < 16; ++r) { const int i = (tid >> 5) + 16 * r; *(LAS u64*)(KV + i * 136 + (tid & 31) * 4) = (u64)pk2(gv[r].x, gv[r].y) | ((u64)pk2(gv[r].z, gv[r].w) << 32); } }
            __syncthreads();
            if (pass == 0) {
                const int i = tid >> 1, dh = (tid & 1) * 64; float s0 = 0.f, s1 = 0.f, s2 = 0.f;
#pragma unroll 8
                for (int d = 0; d < 64; ++d) { const float kx = bf2f(KV[i * 136 + dh + d]);
                    s0 = fmaf(QL[(3 * kvh + 0) * 128 + dh + d], kx, s0); s1 = fmaf(QL[(3 * kvh + 1) * 128 + dh + d], kx, s1); s2 = fmaf(QL[(3 * kvh + 2) * 128 + dh + d], kx, s2); }
                s0 += __shfl_xor(s0, 1); s1 += __shfl_xor(s1, 1); s2 += __shfl_xor(s2, 1);
                if ((tid & 1) == 0) { SL[i] = s0 * 0.08838834764831845f; SL[256 + i] = s1 * 0.08838834764831845f; SL[512 + i] = s2 * 0.08838834764831845f; }
                __syncthreads();
                if (w < 3) { float v[4], mx = -1e30f;
#pragma unroll
                    for (int j = 0; j < 4; ++j) { v[j] = SL[w * 256 + 64 * j + lane]; mx = fmaxf(mx, v[j]); }
#pragma unroll
                    for (int o = 1; o < 64; o <<= 1) mx = fmaxf(mx, __shfl_xor(mx, o));
                    float l = 0.f;
#pragma unroll
                    for (int j = 0; j < 4; ++j) { v[j] = __expf(v[j] - mx); l += v[j]; }
                    l = wave_sum(l); const float il = 1.0f / l;
#pragma unroll
                    for (int j = 0; j < 4; ++j) SL[w * 256 + 64 * j + lane] = v[j] * il; }
                __syncthreads();
            } else {
                const int d = tid & 127, part = tid >> 7; float o0 = 0.f, o1 = 0.f, o2 = 0.f;
#pragma unroll 8
                for (int i = part * 64; i < part * 64 + 64; ++i) { const float vx = bf2f(KV[i * 136 + d]); o0 = fmaf(SL[i], vx, o0); o1 = fmaf(SL[256 + i], vx, o1); o2 = fmaf(SL[512 + i], vx, o2); }
                OL[(part * 3 + 0) * 128 + d] = o0; OL[(part * 3 + 1) * 128 + d] = o1; OL[(part * 3 + 2) * 128 + d] = o2;
                __syncthreads();
                if (tid < 384) { const int hq = tid >> 7, dd = tid & 127; const float o = (OL[hq * 128 + dd] + OL[(3 + hq) * 128 + dd]) + (OL[(6 + hq) * 128 + dd] + OL[(9 + hq) * 128 + dd]);
                    MIX[(3 * kvh + hq) * 128 + dd] = (bf16)f2bf(o); }
                __syncthreads();
            }
        }
    }
}


namespace attn {
using bf16 = unsigned short;
typedef short bf16x8 __attribute__((ext_vector_type(8)));
typedef short s16x4 __attribute__((ext_vector_type(4)));
typedef float f32x16 __attribute__((ext_vector_type(16)));
typedef float f32x4 __attribute__((ext_vector_type(4)));
typedef unsigned u32x4 __attribute__((ext_vector_type(4)));
typedef unsigned u32x2 __attribute__((ext_vector_type(2)));
constexpr int D = 128, OS = 1024;
constexpr float THR = 8.f;
constexpr float SCALE = 0.08838834764831845f;
constexpr int NW = 8, QBLK = 32, KVBLK = 64, QB = NW * QBLK;
constexpr int SHM_V = KVBLK * D * 2, SHM_K = KVBLK * D * 2;
constexpr int LDS_BYTES = 2 * SHM_V + 2 * SHM_K + NW * 64 * 4;

#define KSWZ(row, colB) ((row) * 256 + ((colB) ^ (((row) & 7) << 4)))
#define SBAR() __builtin_amdgcn_sched_barrier(0)
__device__ __forceinline__ int v_st(int k, int c) { const int kk = (k & ~0xC) | ((k & 4) << 1) | ((k & 8) >> 1); return ((kk >> 3) * 4 + (c >> 5)) * 512 + ((kk & 7) * 32 + (c & 31)) * 2; }
__device__ __forceinline__ int v_rd_base(int lane) { return ((lane & 3) << 3) | (((lane >> 2) & 3) << 6) | (((lane >> 4) & 1) << 5) | (((lane >> 5) & 1) << 8); }
constexpr int v_rd_off(int d0, int ks, int half) { return d0 * 512 + ks * 4096 + half * 2048; }
__device__ __forceinline__ int crow(int r, int hi) { return (r & 3) + 8 * (r >> 2) + 4 * hi; }
__device__ __forceinline__ unsigned cvtpk(float lo, float hi) {
    unsigned r; asm volatile("v_cvt_pk_bf16_f32 %0, %1, %2" : "=v"(r) : "v"(lo), "v"(hi)); return r;
}
__device__ __forceinline__ bf16x8 pack8(f32x4 a, f32x4 b) {
    u32x4 w = {cvtpk(a[0], a[1]), cvtpk(a[2], a[3]), cvtpk(b[0], b[1]), cvtpk(b[2], b[3])};
    return *reinterpret_cast<bf16x8*>(&w);
}

__device__ __forceinline__ void partialSM(f32x16& p0, f32x16& p1, float& m_reg, float& mn, float& alpha) {
    float pmax = p0[0]; for (int r = 1; r < 16; ++r) pmax = fmaxf(pmax, p0[r]); for (int r = 0; r < 16; ++r) pmax = fmaxf(pmax, p1[r]);
    { auto rr = __builtin_amdgcn_permlane32_swap(__float_as_uint(pmax), __float_as_uint(pmax), false, false);
      pmax = fmaxf(__uint_as_float(rr[0]), __uint_as_float(rr[1])); }
    constexpr float C2 = 1.4426950408889634f * SCALE;
    if (__builtin_expect(__all((pmax - m_reg) * SCALE <= THR), 1)) { mn = m_reg; alpha = 1.f; }
    else { mn = fmaxf(m_reg, pmax); alpha = __builtin_amdgcn_exp2f((m_reg - mn) * C2); m_reg = mn; }
    const float mnL = -mn * C2;
    for (int r = 0; r < 16; ++r) p0[r] = fmaf(p0[r], C2, mnL); for (int r = 0; r < 16; ++r) p1[r] = fmaf(p1[r], C2, mnL);
    for (int r = 0; r < 16; ++r) p0[r] = __builtin_amdgcn_exp2f(p0[r]);
}
__device__ __forceinline__ void finishSM(f32x16& p0, f32x16& p1, float alpha, float& l_reg, bf16x8& pa0, bf16x8& pa1, bf16x8& pa2, bf16x8& pa3) {
    for (int r = 0; r < 16; ++r) p1[r] = __builtin_amdgcn_exp2f(p1[r]);
    float ps = 0; for (int r = 0; r < 16; ++r) ps += p0[r]; for (int r = 0; r < 16; ++r) ps += p1[r];
    { auto rr = __builtin_amdgcn_permlane32_swap(__float_as_uint(ps), __float_as_uint(ps), false, false);
      ps = __uint_as_float(rr[0]) + __uint_as_float(rr[1]); }
    l_reg = l_reg * alpha + ps;
#define PK4(P, B_, OUT) do { unsigned a0 = cvtpk(P[B_+0], P[B_+1]), a1 = cvtpk(P[B_+2], P[B_+3]);                          \
        unsigned b0 = cvtpk(P[B_+4], P[B_+5]), b1 = cvtpk(P[B_+6], P[B_+7]);                                             \
        auto r0 = __builtin_amdgcn_permlane32_swap(a0, b0, false, false); auto r1 = __builtin_amdgcn_permlane32_swap(a1, b1, false, false); \
        u32x4 w = {r0[0], r1[0], r0[1], r1[1]}; OUT = *reinterpret_cast<bf16x8*>(&w); } while (0)
    PK4(p0, 0, pa0); PK4(p0, 8, pa1); PK4(p1, 0, pa2); PK4(p1, 8, pa3);
#undef PK4
}
template <int KB, bool SK>
__device__ __forceinline__ void qkt(f32x16& p0, f32x16& p1, const char* K_lds, int r32, int hi, const bf16x8* qr, bool act) {
    if (SK && !act) { const float NEG = -__builtin_inff();
#pragma unroll
        for (int r = 0; r < 16; ++r) { p0[r] = NEG; p1[r] = NEG; } return; }
    p0 = f32x16{}; p1 = f32x16{};
    const char* kb[4];
#pragma unroll
    for (int dd = 0; dd < 4; ++dd) kb[dd] = K_lds + KB * SHM_K + KSWZ(r32, (dd * 16 + hi * 8) * 2);
#pragma unroll
    for (int d0 = 0; d0 < 8; ++d0) { const char* a = kb[d0 & 3] + (d0 >> 2) * 128;
        bf16x8 b0 = *reinterpret_cast<const bf16x8*>(a);
        bf16x8 b1 = *reinterpret_cast<const bf16x8*>(a + 32 * 256);
        p0 = __builtin_amdgcn_mfma_f32_32x32x16_bf16(b0, qr[d0], p0, 0, 0, 0);
        p1 = __builtin_amdgcn_mfma_f32_32x32x16_bf16(b1, qr[d0], p1, 0, 0, 0); }
}
template <int VB, bool SK>
__device__ __forceinline__ void pv_tile(f32x16* o, int vb0, bf16x8 pa0, bf16x8 pa1, bf16x8 pa2, bf16x8 pa3, bool act) {
    if (SK && !act) return;
#define TRRD(dst, off) asm volatile("ds_read_b64_tr_b16 %0, %1 offset:%2" : "=&v"(dst) : "v"(vb0), "i"(off) : "memory")
#define PV_D0(d0) do { s16x4 l0, l1, l2, l3, h0, h1, h2, h3; constexpr int b_ = VB * SHM_V + v_rd_off(d0, 0, 0);     \
        TRRD(l0, b_); TRRD(h0, b_ + 2048); TRRD(l1, b_ + 4096); TRRD(h1, b_ + 6144); TRRD(l2, b_ + 8192); TRRD(h2, b_ + 10240); TRRD(l3, b_ + 12288); TRRD(h3, b_ + 14336); \
        asm volatile("s_waitcnt lgkmcnt(0)" ::: "memory"); SBAR();                 \
        o[d0] = __builtin_amdgcn_mfma_f32_32x32x16_bf16(pa0, (bf16x8){l0[0], l0[1], l0[2], l0[3], h0[0], h0[1], h0[2], h0[3]}, o[d0], 0, 0, 0);   \
        o[d0] = __builtin_amdgcn_mfma_f32_32x32x16_bf16(pa1, (bf16x8){l1[0], l1[1], l1[2], l1[3], h1[0], h1[1], h1[2], h1[3]}, o[d0], 0, 0, 0);   \
        o[d0] = __builtin_amdgcn_mfma_f32_32x32x16_bf16(pa2, (bf16x8){l2[0], l2[1], l2[2], l2[3], h2[0], h2[1], h2[2], h2[3]}, o[d0], 0, 0, 0);   \
        o[d0] = __builtin_amdgcn_mfma_f32_32x32x16_bf16(pa3, (bf16x8){l3[0], l3[1], l3[2], l3[3], h3[0], h3[1], h3[2], h3[3]}, o[d0], 0, 0, 0); } while (0)
    PV_D0(0); PV_D0(1); PV_D0(2); PV_D0(3);
#undef PV_D0
#undef TRRD
}

__device__ __forceinline__ bf16x8 load8(const bf16* p) { return *reinterpret_cast<const bf16x8*>(p); }
__device__ __forceinline__ void mask_bits(f32x16& p0, f32x16& p1, u32x2 w, int hi) {
    const float NEG = -__builtin_inff();
    asm volatile("" : "+v"(w.x), "+v"(w.y));
    const unsigned lo = w.x >> (4 * hi), up = w.y >> (4 * hi);
#pragma unroll
    for (int r = 0; r < 16; ++r) { const int c = (r & 3) + 8 * (r >> 2);
        if (!((lo >> c) & 1u)) p0[r] = NEG;
        if (!((up >> c) & 1u)) p1[r] = NEG; }
}
struct BlockRef { const bf16* Q; const bf16* K; const bf16* V; bf16* O; const u32x2* M; int P0; };
struct Seam { bf16x8 qr[8]; bf16x8 st_v0, st_v1, st_k0, st_k1; };
#define ROW(p, k0, rr) ((p) + (size_t)((k0) + (rr)) * D + sc)
#define VMW() asm volatile("s_waitcnt vmcnt(0)" ::: "memory")
#define VMWN(n) asm volatile("s_waitcnt vmcnt(%0)" :: "i"(n) : "memory")
#define SLOAD_H(Kp, Vp, k0) do { S.st_v0 = load8(ROW(Vp, k0, sr)); S.st_v1 = load8(ROW(Vp, k0, 32 + sr));              \
                         S.st_k0 = load8(ROW(Kp, k0, sr)); S.st_k1 = load8(ROW(Kp, k0, 32 + sr)); } while (0)
#define SWRITE_HK(bf) do { *(bf16x8*)(K_lds + (bf) * SHM_K + kws) = S.st_k0; *(bf16x8*)(K_lds + (bf) * SHM_K + kws + 32 * 256) = S.st_k1; } while (0)
#define SWRITE_HV(bf) do { *(bf16x8*)(V_lds + (bf) * SHM_V + vst0) = S.st_v0; *(bf16x8*)(V_lds + (bf) * SHM_V + vst1) = S.st_v1; } while (0)
#define SWRITE_H(bf) do { SWRITE_HV(bf); SWRITE_HK(bf); } while (0)
__device__ __forceinline__ void sel_prime(const BlockRef& cur, char* lds, Seam& S) {
    int tid_ = threadIdx.x; asm volatile("" : "+v"(tid_));
    const int tid = tid_, wid = __builtin_amdgcn_readfirstlane(tid >> 6), lane = tid & 63, r32 = lane & 31, hi = lane >> 5;
    const int sr = tid >> 4, sc = (tid & 15) * 8, kws = KSWZ(sr, sc * 2); char* K_lds = lds + 2 * SHM_V;
    for (int d0 = 0; d0 < 8; ++d0) S.qr[d0] = load8(cur.Q + (size_t)(wid * QBLK + r32) * D + d0 * 16 + hi * 8);
    SLOAD_H(cur.K, cur.V, 0); VMW(); SWRITE_HK(0);
    __syncthreads();
}
__device__ __forceinline__ void sel_block(const BlockRef& cur, const BlockRef& nxt, char* lds, Seam& S) {
    int tid_ = threadIdx.x; asm volatile("" : "+v"(tid_));
    const int tid = tid_, wid = __builtin_amdgcn_readfirstlane(tid >> 6), lane = tid & 63, r32 = lane & 31, hi = lane >> 5;
    const int NT = (cur.P0 + QB) / KVBLK;
    char* V_lds = lds; char* K_lds = lds + 2 * SHM_V;
    float* ws = (float*)(lds + 2 * SHM_V + 2 * SHM_K) + wid * 64; float* li_l = ws, * al_l = ws + 32;
    float m_reg = -1e30f, l_reg = 0; f32x16 o[4] = {};
    const int sr = tid >> 4, sc = (tid & 15) * 8, vst0 = v_st(sr, sc), vst1 = v_st(32 + sr, sc), kws = KSWZ(sr, sc * 2);
    const int vb0 = (int)(uintptr_t)V_lds + v_rd_base(lane);
    const bf16* Kh = cur.K; const bf16* Vh = cur.V;
    const char* Mbase = (const char*)cur.M; const unsigned moff = (unsigned)(wid * QBLK + r32) * 512u;
#define MROW(t) (*(const u32x2*)(Mbase + (moff + (unsigned)(t) * 8u)))
#define RESC(a) do { if (__any((a) < 1.f)) { if (hi == 0) al_l[r32] = (a); asm volatile("s_waitcnt lgkmcnt(0)" ::: "memory");              \
                     for (int d_ = 0; d_ < 4; ++d_) for (int r = 0; r < 16; ++r) o[d_][r] *= al_l[crow(r, hi)]; } } while (0)
#define KBASE(t) ((t) * KVBLK)
    f32x16 pA0, pA1, pB0, pB1; float mnA, mnB, alA, alB; bf16x8 pa0, pa1, pa2, pa3; u32x2 mw;
    SWRITE_HV(0); SBAR();
    if (NT > 1) SLOAD_H(Kh, Vh, KBASE(1));
    mw = MROW(0);
    SBAR(); qkt<0, false>(pA0, pA1, K_lds, r32, hi, S.qr, true);
    mask_bits(pA0, pA1, mw, hi); partialSM(pA0, pA1, m_reg, mnA, alA);
    if (NT > 1) { VMW(); SWRITE_H(1); }
    __syncthreads();
#define HALF_STEP(PX0, PX1, mnX, alX, PY0, PY1, alY, t, KB, VB, SB) do {                                                      \
        SBAR(); mw = MROW(t); qkt<KB, false>(PX0, PX1, K_lds, r32, hi, S.qr, true);                                          \
        finishSM(PY0, PY1, alY, l_reg, pa0, pa1, pa2, pa3); SBAR();                                                           \
        if ((t) + 1 < NT) { SLOAD_H(Kh, Vh, KBASE((t) + 1)); SBAR(); }                                                        \
        pv_tile<VB, false>(o, vb0, pa0, pa1, pa2, pa3, true); mask_bits(PX0, PX1, mw, hi); partialSM(PX0, PX1, m_reg, mnX, alX); \
        __syncthreads();                                                                                                      \
        if ((t) + 1 < NT) { VMW(); SWRITE_H(SB); }                                                                            \
        RESC(alX); __syncthreads(); } while (0)
    for (int t = 1; t + 1 < NT; t += 2) {
        HALF_STEP(pB0, pB1, mnB, alB, pA0, pA1, alA, t, 1, 0, 0);
        HALF_STEP(pA0, pA1, mnA, alA, pB0, pB1, alB, t + 1, 0, 1, 1);
    }
    const bool even = (NT & 1) == 0;
    if (even) { SBAR(); mw = MROW(NT - 1); qkt<1, false>(pB0, pB1, K_lds, r32, hi, S.qr, true); SBAR(); }
    SLOAD_H(nxt.K, nxt.V, 0); SBAR();
#pragma unroll
    for (int d0 = 0; d0 < 8; ++d0) S.qr[d0] = load8(nxt.Q + (size_t)(wid * QBLK + r32) * D + d0 * 16 + hi * 8);
    SBAR();
    finishSM(pA0, pA1, alA, l_reg, pa0, pa1, pa2, pa3); SBAR();
    pv_tile<0, false>(o, vb0, pa0, pa1, pa2, pa3, true);
    if (even) { mask_bits(pB0, pB1, mw, hi); partialSM(pB0, pB1, m_reg, mnB, alB); __syncthreads(); RESC(alB);
        finishSM(pB0, pB1, alB, l_reg, pa0, pa1, pa2, pa3); SBAR(); pv_tile<1, false>(o, vb0, pa0, pa1, pa2, pa3, true); }
    SBAR(); VMWN(8); SWRITE_HK(0); SBAR();
    if (hi == 0) li_l[r32] = l_reg; asm volatile("s_waitcnt lgkmcnt(0)" ::: "memory");
    float rli[16];
#pragma unroll
    for (int r = 0; r < 16; ++r) rli[r] = __builtin_amdgcn_rcpf(li_l[crow(r, hi)]);
    bf16* Ow = cur.O + (size_t)(wid * QBLK) * OS;
#pragma unroll
    for (int r = 0; r < 16; ++r) { const int orow = crow(r, hi);
#pragma unroll
        for (int d0 = 0; d0 < 4; ++d0) { const float v = o[d0][r] * rli[r];
            const float vn = __shfl_xor(v, 1);
            if ((r32 & 1) == 0) *(unsigned*)(Ow + (size_t)orow * OS + d0 * 32 + r32) = cvtpk(v, vn); } }
    __syncthreads();
#undef RESC
#undef KBASE
#undef HALF_STEP
#undef MROW
}
#undef ROW
#undef VMW
#undef VMWN
#undef SLOAD_H
#undef SWRITE_HK
#undef SWRITE_HV
#undef SWRITE_H
#undef KSWZ
#undef SBAR
}


__device__ __forceinline__ attn::BlockRef attn_ref(ARGREF a, int b, int h, int qb) {
    attn::BlockRef r; const int kvh = h / 3;
    r.Q = (const attn::bf16*)(a.ws + WS_QB) + ((size_t)(b * 6 + h) * SEQ + (size_t)qb * 256) * 128;
    r.K = (const attn::bf16*)(a.ws + WS_KB) + (size_t)(b * 2 + kvh) * SEQ * 128;
    r.V = (const attn::bf16*)(a.ws + WS_VB) + (size_t)(b * 2 + kvh) * SEQ * 128;
    r.O = (attn::bf16*)(a.ws + WS_MIX) + (size_t)(b * SEQ + qb * 256) * DM + h * 128;
    r.M = (const attn::u32x2*)(a.ws + WS_MASK) + (size_t)(b * SEQ + qb * 256) * 64;
    r.P0 = qb * 256; return r;
}
__device__ __forceinline__ void p11_attention(Ctx& c, ARGREF a) {
    constexpr int NITEM = 240;
#pragma unroll 1
    for (int it = c.vcu; it < NITEM; it += c.G) {
        const int bh = it / 10, slot = it % 10, b = bh / 6, h = bh % 6;
        const int q0 = slot < 3 ? 15 - slot : (slot == 9 ? 6 : slot - 3), q1 = slot < 3 ? q0 : (slot == 9 ? 6 : 15 - slot);
        attn::Seam S;
        attn::BlockRef cur = attn_ref(a, b, h, q0), nxt = attn_ref(a, b, h, q1);
        __syncthreads();
        attn::sel_prime(cur, (char*)c.lds, S);
        if (q0 != q1) attn::sel_block(cur, nxt, (char*)c.lds, S);
        attn::sel_block(nxt, nxt, (char*)c.lds, S);
    }
    if (c.G == 256) {
        if (c.vcu >= NITEM) { for (int j = 0; j < 4; ++j) { const int u = (c.vcu - NITEM) * 4 + j; attn_sample_unit(c, a, u >> 2, u & 3); } }
        else if (c.vcu % 10 == 9) { for (int j = 0; j < 3; ++j) { const int u = 64 + (c.vcu / 10) * 3 + j; if (u < MS) attn_sample_unit(c, a, u >> 2, u & 3); } }
    } else for (int u = c.vcu; u < MS; u += c.G) attn_sample_unit(c, a, u >> 2, u & 3);
}

enum { PH_PRO = 0, PH_IN0, PH_MIX0, PH_HSCAN, PH_HFIX, PH_OUT0, PH_GU0, PH_DOWN0, PH_IN1, PH_POST, PH_IDX, PH_TOPK, PH_ATTN, PH_OUT1, PH_GU1, PH_DOWN1, NPHASE };
#ifndef ONLYPH
#define ONLYPH -1
#endif
#define PHON(x) (ONLYPH < 0 || ONLYPH == (x))
#ifndef REP_PH
#define REP_PH -1
#endif
#ifndef REP_N
#define REP_N 1
#endif
__global__ void __launch_bounds__(NWAVES * 64, 2) fwd_kernel(Args args) {
    extern __shared__ __attribute__((aligned(16))) unsigned char lds[];
    Ctx c;
    c.lds = (LAS unsigned char*)lds;
    c.MISC = (volatile LAS unsigned*)(c.lds + MISC_OFF);
    c.tid = threadIdx.x; c.lane = c.tid & 63; c.wave = __builtin_amdgcn_readfirstlane(c.tid >> 6);
    c.G = gridDim.x; { const int bx = blockIdx.x; c.vcu = (c.G % 8 == 0) ? (bx % 8) * (c.G / 8) + bx / 8 : bx; }
    c.ctl = (gu32*)(args.ws + WS_CTL);
    for (int u = c.tid; u < (LDS_BYTES - LDSCTL_OFF) / 4; u += NWAVES * 64) ((LAS unsigned*)(c.lds + LDSCTL_OFF))[u] = 0u;
    __syncthreads();
    const int lo = args.ph_lo, hi = args.ph_hi;
    XcdBarrier bar; bar.bar = (unsigned*)(c.ctl + CW_BAR); bar.x = 0; bar.st = nullptr;
    if (hi - lo > 1 || REP_N > 1) bar = xcd_barrier_post((unsigned*)(c.ctl + CW_BAR), c.MISC + 8);
    c.qoff = 0;
#pragma unroll 1
    for (int ph = lo; ph < hi; ++ph) {
        const int layer = ph >= PH_IN1 ? 1 : 0;
        const __attribute__((address_space(4))) Args* ap = (const __attribute__((address_space(4))) Args*)__builtin_amdgcn_kernarg_segment_ptr(); asm volatile("" : "+s"(ap));
        ARGREF la = *ap; unsigned char* const ws = la.ws; float* const out = la.out;
        { int t_ = threadIdx.x; asm volatile("" : "+v"(t_)); c.tid = t_; c.lane = t_ & 63; c.wave = __builtin_amdgcn_readfirstlane(t_ >> 6); }
        if ((ph == PH_DOWN0 || ph == PH_DOWN1) && PHON(PH_OUT0)) {
            pg8::SchedX S0; S0.init(MP, 1024, c.G, (int)blockIdx.x, 0, 0, 1, 0); pg8::Unit u0; if (S0.next(0, u0)) conv_fixup_tile(c, la, layer, u0.pm); VM_WAIT(); __syncthreads(); }
        if (ph == PH_PRO && PHON(PH_PRO)) p0_prologue(c, la);
        else if ((ph == PH_IN0 || ph == PH_IN1) && PHON(PH_IN0)) {
            pg8::Gemm g{(const pg8::bf16_t*)(ws + WS_XB), (const pg8::bf16_t*)(ws + (ph == PH_IN0 ? WS_WIN0 : WS_WIN1)), MT, 0, 1024};
            pg8::SchedX S; if (ph == PH_IN0) S.init(MP, ZC0, c.G, (int)blockIdx.x, 16, MT / 256, 4, 13); else S.init(MP, ZC1, c.G, (int)blockIdx.x, 0, 0, 1, 0, true);
            pg8::EpiZ E{(pg8::bf16_t*)(ws + WS_Z), ph == PH_IN0 ? ZC0 : ZC1, ssptr(c, ph == PH_IN0 ? 0 : 2), ph == PH_IN0 ? 13 : 9, (float*)(ws + WS_MEMKV), MEMROW0};
            pg8::gemm_phase<pg8::EpiZ, pg8::SchedX, PG8_ALIGN, PG8_SP2, true>(c.lds + RING_OFF, g, S, E);
            { SgArgs sg{}; sg.A = (const bf16*)(ws + WS_XB) + (size_t)MP * DM; sg.Bt = (const bf16*)(ws + (ph == PH_IN0 ? WS_WIN0 : WS_WIN1)); sg.K = 1024; sg.mode = 0; sg.Z = (bf16*)(ws + WS_Z); sg.ldz = ph == PH_IN0 ? ZC0 : ZC1; sg.ssin = ssptr(c, ph == PH_IN0 ? 0 : 2);
              { const int nu = ph == PH_IN0 ? 64 * 13 + 16 : 64 * 9, rem = nu % c.G, busy = S.split ? 2 * rem : rem; sgemm_phase(c, sg, ph == PH_IN0 ? ZC0 : ZC1, busy && busy < c.G ? c.G - busy : c.G); } }
            __syncthreads();
            if (ph == PH_IN0) convert_tail(c, la, (64 * 13 + 16) % c.G, W_PRO, W_T1, ZC0 / 32);
            else if (S.split) convert_tail(c, la, 2 * S.rem, W_T1, W_NITEMS);
            else convert_tail(c, la, 0, W_T1, W_NITEMS);
        }
        else if (ph == PH_MIX0 && PHON(PH_MIX0)) p2_mixer0(c, la);
        else if (ph == PH_HSCAN && PHON(PH_HSCAN)) hgrn_scan(c, la);
        else if (ph == PH_HFIX && PHON(PH_HFIX)) p2c_hgrn_fix(c, la);
        else if ((ph == PH_OUT0 || ph == PH_DOWN0 || ph == PH_OUT1 || ph == PH_DOWN1) && PHON(PH_OUT0)) {
            const bool isout = (ph == PH_OUT0 || ph == PH_OUT1);
            pg8::Gemm g{(const pg8::bf16_t*)(ws + (isout ? WS_MIX : WS_ACT)), (const pg8::bf16_t*)(ws + (isout ? WS_WOUT + (size_t)layer * 1024 * 1024 * 2 : WS_WD + (size_t)layer * 1024 * DFF * 2)), MT, 1024, isout ? 1024 : DFF};
            pg8::SchedX S; S.init(MP, 1024, c.G, (int)blockIdx.x, 0, 0, 1, 0);
            pg8::EpiResid E;
            E.rp = ph == PH_OUT0 ? la.in[0] : nullptr; E.rb = (const pg8::bf16_t*)(ws + WS_XB); E.y = ph == PH_DOWN1 ? out + O_YP : nullptr;
            E.xb = ph == PH_DOWN1 ? nullptr : (pg8::bf16_t*)(ws + WS_XB); E.ssout = ph == PH_DOWN1 ? nullptr : ssptr(c, ph == PH_OUT0 ? 1 : (ph == PH_DOWN0 ? 2 : 3));
            pg8::gemm_phase<pg8::EpiResid, pg8::SchedX, PG8_ALIGN, PG8_SP2>(c.lds + RING_OFF, g, S, E);
            { SgArgs sg{}; sg.A = (const bf16*)(ws + (isout ? WS_MIX : WS_ACT)) + (size_t)MP * (isout ? 1024 : DFF); sg.Bt = (const bf16*)g.Bt; sg.K = isout ? 1024 : DFF; sg.mode = 1; sg.rb = (const bf16*)(ws + WS_XB); sg.resid = ph == PH_OUT0 ? la.in[1] : nullptr; sg.y = ph == PH_DOWN1 ? out + O_YS : nullptr; sg.xb = (bf16*)E.xb; sg.ssout = E.ssout;
              { const int rem = (64 * 4) % c.G; sgemm_phase(c, sg, 1024, rem ? c.G - rem : c.G); } }
        }
        else if ((ph == PH_GU0 || ph == PH_GU1) && PHON(PH_GU0)) {
            pg8::Gemm g{(const pg8::bf16_t*)(ws + WS_XB), (const pg8::bf16_t*)(ws + WS_WGU + (size_t)layer * 5632 * 1024 * 2), MT, 5632, 1024};
            pg8::SchedX S; S.init(MP, 5632, c.G, (int)blockIdx.x, 0, 0, 1, 0);
            pg8::EpiGU E{(pg8::bf16_t*)(ws + WS_ACT), ssptr(c, layer ? 3 : 1), out + O_CVP + (size_t)layer * 4 * 2 * DFF, la.in[26] + (size_t)layer * 3 * DFF, la.in[27] + (size_t)layer * DFF, (float*)(ws + WS_G4), (float*)(ws + WS_UP2)};
            pg8::gemm_phase<pg8::EpiGU, pg8::SchedX, PG8_ALIGN, PG8_SP2>(c.lds + RING_OFF, g, S, E);
            { SgArgs sg{}; sg.A = (const bf16*)(ws + WS_XB) + (size_t)MP * DM; sg.Bt = (const bf16*)g.Bt; sg.K = 1024; sg.mode = 2; sg.ssin = E.ss; sg.ACT = (bf16*)E.ACT; sg.cvs = out + O_CVS + (size_t)layer * 32 * 2 * DFF; sg.cst = la.in[8] + (size_t)layer * 32 * 2 * DFF; sg.cw = E.cw; sg.cb = E.cb;
              { const int rem = (64 * 22) % c.G; sgemm_phase(c, sg, 5632, rem ? c.G - rem : c.G);
 } }
        }
        else if (ph == PH_POST && PHON(PH_POST)) p8_dsa_post(c, la);
        else if (ph == PH_IDX && PHON(PH_IDX)) p9_indexer(c, la);
        else if (ph == PH_TOPK && PHON(PH_TOPK)) p10_topk(c, la);
        else if (ph == PH_ATTN && PHON(PH_ATTN)) p11_attention(c, la);
        if (REP_N > 1 && ph == REP_PH && c.qoff < 4 * (REP_N - 1)) { c.qoff += 4; --ph; xcd_barrier(bar); continue; }
        if (REP_N > 1) c.qoff = 0;
        if (ph + 1 < hi) xcd_barrier(bar);
    }
}

#ifndef MK_ONE_LAUNCH
#define MK_ONE_LAUNCH 1
#endif
extern "C" void kernel_launch(void* const* d_in, const int* in_sizes, int n_in, void* d_out, int out_size, void* d_ws, size_t ws_size, hipStream_t stream) {
    static int grid = 0;
    if (grid == 0) {
        if (n_in != 29 || out_size != (int)O_END || ws_size < WS_END) { fprintf(stderr, "kernel_launch: unexpected problem (n_in %d, out %d, ws %zu)\n", n_in, out_size, ws_size); grid = -1; return; }
        int dev = 0, cus = 0;
        if (hipGetDevice(&dev) != hipSuccess || hipDeviceGetAttribute(&cus, hipDeviceAttributeMultiprocessorCount, dev) != hipSuccess) { grid = -1; return; }
        if (hipFuncSetAttribute((const void*)fwd_kernel, hipFuncAttributeMaxDynamicSharedMemorySize, LDS_BYTES) != hipSuccess) { fprintf(stderr, "kernel_launch: hipFuncSetAttribute failed\n"); grid = -1; return; }
        (void)hipGetLastError();
        grid = cus;
    }
    if (grid < 0) return;
    if (hipMemsetAsync((char*)d_ws + WS_CTL, 0, CTL_ZERO_BYTES, stream) != hipSuccess) { fprintf(stderr, "kernel_launch: memset failed\n"); return; }
    Args a{};
    for (int i = 0; i < 29; ++i) a.in[i] = (const float*)d_in[i];
    a.page_table = (const int*)d_in[9]; a.out = (float*)d_out; a.ws = (unsigned char*)d_ws;
#if MK_ONE_LAUNCH
    a.ph_lo = 0; a.ph_hi = NPHASE;
    hipLaunchKernelGGL(fwd_kernel, dim3(grid), dim3(NWAVES * 64), LDS_BYTES, stream, a);
#else
    for (int ph = 0; ph < NPHASE; ++ph) { a.ph_lo = ph; a.ph_hi = ph + 1; hipLaunchKernelGGL(fwd_kernel, dim3(grid), dim3(NWAVES * 64), LDS_BYTES, stream, a); }
#endif
}
```
